# Optimizing an MI355X kernel written in HIP

```python
import math
import jax
import jax.numpy as jnp
from jax import lax
import numpy as np

D_MODEL = 2048
BATCH = 1
SEQ = 16384
DEPTH = 2

GRID_W = 64
CTX_LEN = 256
ROPE_BASE = 10000.0
LN_EPS = 1e-6
DEEPNORM_ALPHA = (2 * DEPTH) ** 0.25
DEEPNORM_BETA = (8 * DEPTH) ** -0.25
N_EVEN = (DEPTH + 1) // 2
N_ODD = DEPTH // 2

RET_HEADS = 4
RET_QK_DIM = 256
RET_V_DIM = 256
RET_CHUNK = 128
S5_CHANNELS = D_MODEL // 2
S5_GROUP = 16
S5_GROUPS = S5_CHANNELS // S5_GROUP
S5_STATE = 64
S5_CHUNK = 128
EVEN_IN = 2 * RET_HEADS * RET_QK_DIM + 2 * RET_HEADS * RET_V_DIM + S5_CHANNELS

HEAD_DIM = 128
GQA_HEADS = 8
GQA_KV_HEADS = 2
GQA_GROUP = GQA_HEADS // GQA_KV_HEADS
DIFF_HEADS = 4
DIFF_V_DIM = 2 * HEAD_DIM
ATT_BLOCK = 128
ODD_IN = GQA_HEADS * HEAD_DIM + 2 * GQA_KV_HEADS * HEAD_DIM + 2 * DIFF_HEADS * 2 * HEAD_DIM + DIFF_HEADS * DIFF_V_DIM

N_EXPERTS = 64
TOP_K = 8
N_EXPERT_GROUPS = 8
TOPK_GROUPS = 4
EXPERT_HIDDEN = 512
SHARED_HIDDEN = 512
ROUTED_SCALE = 2.5
MOE_BLOCK = 128

kernel_name = 'hybrid_retention_s5_gqa_diffattn_moe_prefix_dit'


def layer_norm(x, g, b):
    xf = x.astype(jnp.float32)
    mu = jnp.mean(xf, -1, keepdims=True)
    var = jnp.mean(jnp.square(xf - mu), -1, keepdims=True)
    return ((xf - mu) * lax.rsqrt(var + LN_EPS)).astype(x.dtype) * g + b


def rms_norm(x, g):
    xf = x.astype(jnp.float32)
    y = xf * lax.rsqrt(jnp.mean(jnp.square(xf), -1, keepdims=True) + LN_EPS)
    return y.astype(x.dtype) * g


def head_group_norm(o):
    of = o.astype(jnp.float32)
    mu = jnp.mean(of, -1, keepdims=True)
    var = jnp.mean(jnp.square(of - mu), -1, keepdims=True)
    return ((of - mu) * lax.rsqrt(var + LN_EPS)).astype(o.dtype)


def rope_1d(x, pos):
    half = x.shape[-1] // 2
    freqs = ROPE_BASE ** (-jnp.arange(half, dtype=jnp.float32) / half)
    ang = pos.astype(jnp.float32)[:, None] * freqs[None, :]
    cos = jnp.cos(ang).astype(x.dtype)
    sin = jnp.sin(ang).astype(x.dtype)
    x1, x2 = x[..., :half], x[..., half:]
    return jnp.concatenate([x1 * cos - x2 * sin, x1 * sin + x2 * cos], axis=-1)


def rope_2d(x, row, col):
    h = x.shape[-1] // 2
    return jnp.concatenate([rope_1d(x[..., :h], row), rope_1d(x[..., h:], col)], axis=-1)


def to_heads(t, n_heads):
    b_, L, _ = t.shape
    return t.reshape(b_, L, n_heads, -1).transpose(0, 2, 1, 3)


def from_heads(o):
    b_, h, L, d = o.shape
    return o.transpose(0, 2, 1, 3).reshape(b_, L, h * d)


def modulation(v, w, b):
    m = (jax.nn.silu(v) @ w + b)[:, None, :]
    return jnp.split(m, 6, axis=-1)


def retention_chunkwise(q, k, v, log_g, s0):
    b_, h, L, dk = q.shape
    dv = v.shape[-1]
    n = L // RET_CHUNK
    dt = q.dtype
    lg = log_g.astype(jnp.float32)
    idx = jnp.arange(RET_CHUNK, dtype=jnp.float32)
    diff = idx[:, None] - idx[None, :]
    intra = jnp.where(diff[None] >= 0, jnp.exp(jnp.maximum(diff, 0.0)[None] * lg[:, None, None]), 0.0).astype(dt)
    k_dec = jnp.exp((RET_CHUNK - 1 - idx)[None, :] * lg[:, None]).astype(dt)
    q_dec = jnp.exp((idx + 1)[None, :] * lg[:, None]).astype(dt)
    g_chunk = jnp.exp(RET_CHUNK * lg).astype(dt)
    qc = q.reshape(b_, h, n, RET_CHUNK, dk)
    kc = k.reshape(b_, h, n, RET_CHUNK, dk)
    vc = v.reshape(b_, h, n, RET_CHUNK, dv)
    scores = jnp.einsum('bhnid,bhnjd->bhnij', qc, kc) * intra[None, :, None]
    inner = jnp.einsum('bhnij,bhnje->bhnie', scores, vc)
    chunk_kv = jnp.einsum('bhnjd,bhnje->nbhde', kc * k_dec[None, :, None, :, None], vc)

    def step(s, kv):
        return g_chunk[None, :, None, None] * s + kv, s

    s_final, s_prev = lax.scan(step, s0, chunk_kv)
    cross = jnp.einsum('bhnid,nbhde->bhnie', qc * q_dec[None, :, None, :, None], s_prev)
    return (inner + cross).reshape(b_, h, L, dv), s_final


def bidir_retention(qc, kc, vc, ql, kl, vl, log_decay):
    b_, h, _, dk = qc.shape
    dv = vc.shape[-1]
    s0 = jnp.zeros((b_, h, dk, dv), vc.dtype)
    flip = lambda t: jnp.flip(t, axis=2)
    oc_f, sc_f = retention_chunkwise(qc, kc, vc, log_decay[0], s0)
    ol_f, _ = retention_chunkwise(ql, kl, vl, log_decay[0], sc_f)
    oc_b, sc_b = retention_chunkwise(flip(qc), flip(kc), flip(vc), log_decay[1], s0)
    ol_b, _ = retention_chunkwise(flip(ql), flip(kl), flip(vl), log_decay[1], sc_b)
    return oc_f + flip(oc_b), ol_f + flip(ol_b)


def s5_discretize(a_re, a_im, log_dt, b_re, b_im):
    dt = jnp.exp(log_dt)[:, None]
    zr, zi = a_re * dt, a_im * dt
    mag = jnp.exp(zr)
    ab_re, ab_im = mag * jnp.cos(zi), mag * jnp.sin(zi)
    den = jnp.square(a_re) + jnp.square(a_im)
    nr, ni = ab_re - 1.0, ab_im
    f_re = (nr * a_re + ni * a_im) / den
    f_im = (ni * a_re - nr * a_im) / den
    bb_re = f_re[..., None] * b_re - f_im[..., None] * b_im
    bb_im = f_re[..., None] * b_im + f_im[..., None] * b_re
    return ab_re, ab_im, bb_re, bb_im


def s5_combine(e1, e2):
    a1r, a1i, b1r, b1i = e1
    a2r, a2i, b2r, b2i = e2
    return (a2r * a1r - a2i * a1i, a2r * a1i + a2i * a1r,
            a2r * b1r - a2i * b1i + b2r, a2r * b1i + a2i * b1r + b2i)


def s5_scan(u, ab_re, ab_im, bb_re, bb_im, c_re, c_im, h0_re, h0_im):
    b_, L = u.shape[:2]
    n = L // S5_CHUNK
    uc = jnp.swapaxes(u.reshape(b_, n, S5_CHUNK, S5_GROUPS, S5_GROUP), 0, 1)

    def chunk_step(carry, u_blk):
        h_re, h_im = carry
        bu_re = jnp.einsum('bcgs,gps->bcgp', u_blk, bb_re)
        bu_im = jnp.einsum('bcgs,gps->bcgp', u_blk, bb_im)
        bu_re = bu_re.at[:, 0].add(ab_re * h_re - ab_im * h_im)
        bu_im = bu_im.at[:, 0].add(ab_re * h_im + ab_im * h_re)
        a_r = jnp.broadcast_to(ab_re, bu_re.shape)
        a_i = jnp.broadcast_to(ab_im, bu_im.shape)
        _, _, xr, xi = lax.associative_scan(s5_combine, (a_r, a_i, bu_re, bu_im), axis=1)
        y = jnp.einsum('bcgp,gsp->bcgs', xr, c_re) - jnp.einsum('bcgp,gsp->bcgs', xi, c_im)
        return (xr[:, -1], xi[:, -1]), y

    (hr, hi), y = lax.scan(chunk_step, (h0_re, h0_im), uc)
    return jnp.swapaxes(y, 0, 1).reshape(b_, L, S5_GROUPS, S5_GROUP), hr, hi


def bidir_s5(uc, ul, a_re, a_im, log_dt, b_re, b_im, c_re, c_im, d_skip):
    f32 = jnp.float32
    dt = ul.dtype
    b_ = ul.shape[0]
    u_c = uc.astype(f32).reshape(b_, -1, S5_GROUPS, S5_GROUP)
    u_l = ul.astype(f32).reshape(b_, -1, S5_GROUPS, S5_GROUP)
    cr, ci = c_re.astype(f32), c_im.astype(f32)
    dsk = d_skip.astype(f32).reshape(S5_GROUPS, S5_GROUP)
    h0 = jnp.zeros((b_, S5_GROUPS, S5_STATE), f32)
    yc = u_c * dsk
    yl = u_l * dsk
    for direction in range(2):
        abr, abi, bbr, bbi = s5_discretize(a_re[direction].astype(f32), a_im[direction].astype(f32),
                                           log_dt[direction].astype(f32), b_re.astype(f32), b_im.astype(f32))
        sc = u_c if direction == 0 else jnp.flip(u_c, 1)
        sl = u_l if direction == 0 else jnp.flip(u_l, 1)
        y_c, hr, hi = s5_scan(sc, abr, abi, bbr, bbi, cr, ci, h0, h0)
        y_l, _, _ = s5_scan(sl, abr, abi, bbr, bbi, cr, ci, hr, hi)
        if direction == 1:
            y_c, y_l = jnp.flip(y_c, 1), jnp.flip(y_l, 1)
        yc = yc + y_c
        yl = yl + y_l
    return yc.reshape(b_, -1, S5_CHANNELS).astype(dt), yl.reshape(b_, -1, S5_CHANNELS).astype(dt)


def even_mixer(xc, xl, row, col, w_in, w_out, ret_log_decay, s5_a_re, s5_a_im, s5_log_dt,
               s5_b_re, s5_b_im, s5_c_re, s5_c_im, s5_d, s5_w_glu, s5_b_glu, need_ctx):
    hq = RET_HEADS * RET_QK_DIM
    hv = RET_HEADS * RET_V_DIM
    cuts = [hq, 2 * hq, 2 * hq + hv, 2 * hq + 2 * hv]
    qc, kc, vc, gc, uc = jnp.split(xc @ w_in, cuts, axis=-1)
    ql, kl, vl, gl, ul = jnp.split(xl @ w_in, cuts, axis=-1)
    scale = RET_QK_DIM ** -0.5
    qc_h = to_heads(qc, RET_HEADS) * scale
    kc_h = to_heads(kc, RET_HEADS)
    ql_h = rope_2d(to_heads(ql, RET_HEADS), row, col) * scale
    kl_h = rope_2d(to_heads(kl, RET_HEADS), row, col)
    rc, rl = bidir_retention(qc_h, kc_h, to_heads(vc, RET_HEADS), ql_h, kl_h, to_heads(vl, RET_HEADS), ret_log_decay)
    sc, sl = bidir_s5(uc, ul, s5_a_re, s5_a_im, s5_log_dt, s5_b_re, s5_b_im, s5_c_re, s5_c_im, s5_d)

    def finish(r, g, s):
        ret = from_heads(head_group_norm(r)) * jax.nn.silu(g)
        z = jax.nn.gelu(s)
        s5o = z * jax.nn.sigmoid(z @ s5_w_glu + s5_b_glu)
        return jnp.concatenate([ret, s5o], axis=-1) @ w_out

    out_l = finish(rl, gl, sl)
    out_c = finish(rc, gc, sc) if need_ctx else None
    return out_c, out_l


def gqa_attend(q, k, v):
    s = jnp.einsum('bkgqd,bksd->bkgqs', q, k) * (HEAD_DIM ** -0.5)
    p = jax.nn.softmax(s.astype(jnp.float32), axis=-1).astype(v.dtype)
    return jnp.einsum('bkgqs,bksd->bkgqd', p, v)


def diff_attend(q, k, v, lam):
    s = jnp.einsum('bhmqd,bhmsd->bhmqs', q, k) * (HEAD_DIM ** -0.5)
    p = jax.nn.softmax(s.astype(jnp.float32), axis=-1)
    w = (p[:, :, 0] - lam * p[:, :, 1]).astype(v.dtype)
    return jnp.einsum('bhqs,bhsd->bhqd', w, v)


def odd_mixer(xc, xl, row, col, w_in, w_out, qk_norm_g, diff_lambda, diff_subln_g, lambda_init, need_ctx):
    gq_w = GQA_HEADS * HEAD_DIM
    gk_w = GQA_KV_HEADS * HEAD_DIM
    dq_w = DIFF_HEADS * 2 * HEAD_DIM
    cuts = [gq_w, gq_w + gk_w, gq_w + 2 * gk_w, gq_w + 2 * gk_w + dq_w, gq_w + 2 * gk_w + 2 * dq_w]

    def diff_heads(t):
        b_, L, _ = t.shape
        return t.reshape(b_, L, DIFF_HEADS, 2, HEAD_DIM).transpose(0, 2, 3, 1, 4)

    def project(x, rotate):
        gq, gk, gv, dq, dk, dv = jnp.split(x @ w_in, cuts, axis=-1)
        gq = rms_norm(to_heads(gq, GQA_HEADS), qk_norm_g[0])
        gk = rms_norm(to_heads(gk, GQA_KV_HEADS), qk_norm_g[1])
        dq = diff_heads(dq)
        dk = diff_heads(dk)
        if rotate:
            gq, gk, dq, dk = rope_2d(gq, row, col), rope_2d(gk, row, col), rope_2d(dq, row, col), rope_2d(dk, row, col)
        b_, _, L, _ = gq.shape
        gq = gq.reshape(b_, GQA_KV_HEADS, GQA_GROUP, L, HEAD_DIM)
        return gq, gk, to_heads(gv, GQA_KV_HEADS), dq, dk, to_heads(dv, DIFF_HEADS)

    lf = diff_lambda.astype(jnp.float32)
    lam = jnp.exp(jnp.sum(lf[0] * lf[1])) - jnp.exp(jnp.sum(lf[2] * lf[3])) + lambda_init

    cq_g, ck_g, cv_g, cq_d, ck_d, cv_d = project(xc, False)
    lq_g, lk_g, lv_g, lq_d, lk_d, lv_d = project(xl, True)
    kg_all = jnp.concatenate([ck_g, lk_g], axis=2)
    vg_all = jnp.concatenate([cv_g, lv_g], axis=2)
    kd_all = jnp.concatenate([ck_d, lk_d], axis=3)
    vd_all = jnp.concatenate([cv_d, lv_d], axis=2)

    def merge(og, od):
        b_, L = og.shape[0], og.shape[3]
        og = og.reshape(b_, GQA_HEADS, L, HEAD_DIM)
        od = rms_norm(od, diff_subln_g) * (1.0 - lambda_init)
        return jnp.concatenate([from_heads(og), from_heads(od)], axis=-1) @ w_out

    b_, L = xl.shape[:2]
    nb = L // ATT_BLOCK
    qg_b = jnp.moveaxis(lq_g.reshape(b_, GQA_KV_HEADS, GQA_GROUP, nb, ATT_BLOCK, HEAD_DIM), 3, 0)
    qd_b = jnp.moveaxis(lq_d.reshape(b_, DIFF_HEADS, 2, nb, ATT_BLOCK, HEAD_DIM), 3, 0)
    og_b, od_b = lax.map(lambda qs: (gqa_attend(qs[0], kg_all, vg_all), diff_attend(qs[1], kd_all, vd_all, lam)),
                         (qg_b, qd_b))
    og = jnp.moveaxis(og_b, 0, 3).reshape(b_, GQA_KV_HEADS, GQA_GROUP, L, HEAD_DIM)
    od = jnp.moveaxis(od_b, 0, 2).reshape(b_, DIFF_HEADS, L, DIFF_V_DIM)
    out_l = merge(og, od)
    out_c = merge(gqa_attend(cq_g, ck_g, cv_g), diff_attend(cq_d, ck_d, cv_d, lam)) if need_ctx else None
    return out_c, out_l


def moe(t, router_w, router_bias, w_gate, w_up, w_down, sw_gate, sw_up, sw_down):
    T, D = t.shape
    s = jax.nn.sigmoid((t @ router_w).astype(jnp.float32))
    sel = s + router_bias.astype(jnp.float32)
    grp_score = jnp.sum(lax.top_k(sel.reshape(T, N_EXPERT_GROUPS, N_EXPERTS // N_EXPERT_GROUPS), 2)[0], -1)
    _, gidx = lax.top_k(grp_score, TOPK_GROUPS)
    gmask = jnp.any(gidx[:, :, None] == jnp.arange(N_EXPERT_GROUPS)[None, None, :], axis=1)
    emask = jnp.repeat(gmask, N_EXPERTS // N_EXPERT_GROUPS, axis=1)
    _, eidx = lax.top_k(jnp.where(emask, sel, -jnp.inf), TOP_K)
    wsel = jnp.take_along_axis(s, eidx, axis=-1)
    wsel = wsel / jnp.sum(wsel, -1, keepdims=True) * ROUTED_SCALE

    n_assign = T * TOP_K
    flat_e = eidx.reshape(-1)
    flat_w = wsel.reshape(-1)
    flat_tok = jnp.repeat(jnp.arange(T, dtype=jnp.int32), TOP_K)
    order = jnp.argsort(flat_e)
    se, stok, sw = flat_e[order], flat_tok[order], flat_w[order]
    counts = jnp.bincount(flat_e, length=N_EXPERTS).astype(jnp.int32)
    padded = (counts + MOE_BLOCK - 1) // MOE_BLOCK * MOE_BLOCK
    pad_end = jnp.cumsum(padded)
    pad_start = pad_end - padded
    start = jnp.cumsum(counts) - counts
    dest = pad_start[se] + (jnp.arange(n_assign, dtype=jnp.int32) - start[se])
    n_blocks = (n_assign + N_EXPERTS * (MOE_BLOCK - 1) + MOE_BLOCK - 1) // MOE_BLOCK
    n_pad = n_blocks * MOE_BLOCK
    tok_buf = jnp.zeros((n_pad,), jnp.int32).at[dest].set(stok)
    w_buf = jnp.zeros((n_pad,), jnp.float32).at[dest].set(sw)
    blk_start = jnp.arange(n_blocks, dtype=jnp.int32) * MOE_BLOCK
    blk_expert = jnp.minimum(jnp.searchsorted(pad_end, blk_start, side='right'), N_EXPERTS - 1)

    def expert_block(args):
        e, tok, wt = args
        xb = t[tok]
        hdn = jax.nn.silu(xb @ w_gate[e]) * (xb @ w_up[e])
        return (hdn @ w_down[e]) * wt[:, None].astype(t.dtype)

    yb = lax.map(expert_block, (blk_expert, tok_buf.reshape(n_blocks, MOE_BLOCK), w_buf.reshape(n_blocks, MOE_BLOCK)))
    routed = jnp.zeros_like(t).at[tok_buf].add(yb.reshape(n_pad, D))
    shared = (jax.nn.silu(t @ sw_gate) * (t @ sw_up)) @ sw_down
    return shared + routed


def setup_inputs(seed: int = 0) -> dict:
    key = jax.random.key(seed)
    ks = iter(jax.random.split(key, 48))
    f32 = jnp.float32
    D = D_MODEL
    nrm = lambda shape, std: jax.random.normal(next(ks), shape, f32) * std
    mix_out = 2048
    base_decay = jnp.log1p(-(2.0 ** (-5.0 - jnp.arange(RET_HEADS, dtype=f32))))
    a_im_base = jnp.pi * jnp.arange(S5_STATE, dtype=f32)
    return {
        'x': nrm((BATCH, SEQ, D), 1.0),
        'c': nrm((BATCH, D), 1.0),
        'ctx': nrm((BATCH, CTX_LEN, D), 1.0),
        'c_ctx': nrm((D,), 1.0),
        'mod_w': nrm((DEPTH, D, 6 * D), 0.5 * D ** -0.5),
        'mod_b': nrm((DEPTH, 6 * D), 0.01),
        'ln_g': 1.0 + nrm((DEPTH, 2, D), 0.02),
        'ln_b': nrm((DEPTH, 2, D), 0.02),
        'ev_w_in': nrm((N_EVEN, D, EVEN_IN), D ** -0.5),
        'ev_w_out': nrm((N_EVEN, mix_out, D), mix_out ** -0.5 * DEEPNORM_BETA),
        'ret_log_decay': base_decay * (1.0 + nrm((N_EVEN, 2, RET_HEADS), 0.01)),
        's5_a_re': -0.5 + nrm((N_EVEN, 2, S5_GROUPS, S5_STATE), 0.01),
        's5_a_im': a_im_base + nrm((N_EVEN, 2, S5_GROUPS, S5_STATE), 0.01),
        's5_log_dt': jax.random.uniform(next(ks), (N_EVEN, 2, S5_GROUPS), f32, math.log(1e-3), math.log(1e-1)),
        's5_b_re': nrm((N_EVEN, S5_GROUPS, S5_STATE, S5_GROUP), (2 * S5_GROUP) ** -0.5),
        's5_b_im': nrm((N_EVEN, S5_GROUPS, S5_STATE, S5_GROUP), (2 * S5_GROUP) ** -0.5),
        's5_c_re': nrm((N_EVEN, S5_GROUPS, S5_GROUP, S5_STATE), 2.0 * S5_STATE ** -0.5),
        's5_c_im': nrm((N_EVEN, S5_GROUPS, S5_GROUP, S5_STATE), 2.0 * S5_STATE ** -0.5),
        's5_d': nrm((N_EVEN, S5_CHANNELS), 1.0),
        's5_w_glu': nrm((N_EVEN, S5_CHANNELS, S5_CHANNELS), S5_CHANNELS ** -0.5),
        's5_b_glu': nrm((N_EVEN, S5_CHANNELS), 0.01),
        'od_w_in': nrm((N_ODD, D, ODD_IN), D ** -0.5),
        'od_w_out': nrm((N_ODD, mix_out, D), mix_out ** -0.5 * DEEPNORM_BETA),
        'qk_norm_g': 1.0 + nrm((N_ODD, 2, HEAD_DIM), 0.02),
        'diff_lambda': nrm((N_ODD, 4, HEAD_DIM), 0.1),
        'diff_subln_g': 1.0 + nrm((N_ODD, DIFF_V_DIM), 0.02),
        'router_w': nrm((DEPTH, D, N_EXPERTS), D ** -0.5),
        'router_bias': nrm((DEPTH, N_EXPERTS), 0.01),
        'exp_w_gate': nrm((DEPTH, N_EXPERTS, D, EXPERT_HIDDEN), D ** -0.5),
        'exp_w_up': nrm((DEPTH, N_EXPERTS, D, EXPERT_HIDDEN), D ** -0.5),
        'exp_w_down': nrm((DEPTH, N_EXPERTS, EXPERT_HIDDEN, D), EXPERT_HIDDEN ** -0.5 * DEEPNORM_BETA),
        'sh_w_gate': nrm((DEPTH, D, SHARED_HIDDEN), D ** -0.5),
        'sh_w_up': nrm((DEPTH, D, SHARED_HIDDEN), D ** -0.5),
        'sh_w_down': nrm((DEPTH, SHARED_HIDDEN, D), SHARED_HIDDEN ** -0.5 * DEEPNORM_BETA),
    }


def reference(x, c, ctx, c_ctx, mod_w, mod_b, ln_g, ln_b, ev_w_in, ev_w_out, ret_log_decay,
              s5_a_re, s5_a_im, s5_log_dt, s5_b_re, s5_b_im, s5_c_re, s5_c_im, s5_d, s5_w_glu, s5_b_glu,
              od_w_in, od_w_out, qk_norm_g, diff_lambda, diff_subln_g,
              router_w, router_bias, exp_w_gate, exp_w_up, exp_w_down, sh_w_gate, sh_w_up, sh_w_down):
    b_, L, D = x.shape
    ROWS = L // GRID_W
    row = jnp.repeat(jnp.arange(ROWS, dtype=jnp.int32), GRID_W)
    col = jnp.tile(jnp.arange(GRID_W, dtype=jnp.int32), ROWS)
    for i in range(DEPTH):
        need_ctx = i < DEPTH - 1
        j = i // 2
        sh1, sc1, g1, sh2, sc2, g2 = modulation(c, mod_w[i], mod_b[i])
        csh1, csc1, cg1, csh2, csc2, cg2 = modulation(c_ctx[None], mod_w[i], mod_b[i])
        xl_in = x * (1.0 + sc1) + sh1
        xc_in = ctx * (1.0 + csc1) + csh1
        if i % 2 == 0:
            yc, yl = even_mixer(xc_in, xl_in, row, col, ev_w_in[j], ev_w_out[j], ret_log_decay[j],
                                s5_a_re[j], s5_a_im[j], s5_log_dt[j], s5_b_re[j], s5_b_im[j],
                                s5_c_re[j], s5_c_im[j], s5_d[j], s5_w_glu[j], s5_b_glu[j], need_ctx)
        else:
            yc, yl = odd_mixer(xc_in, xl_in, row, col, od_w_in[j], od_w_out[j], qk_norm_g[j],
                               diff_lambda[j], diff_subln_g[j], 0.8 - 0.6 * math.exp(-0.3 * i), need_ctx)
        x = layer_norm(DEEPNORM_ALPHA * x + g1 * yl, ln_g[i, 0], ln_b[i, 0])
        xl2 = x * (1.0 + sc2) + sh2
        if need_ctx:
            ctx = layer_norm(DEEPNORM_ALPHA * ctx + cg1 * yc, ln_g[i, 0], ln_b[i, 0])
            xc2 = ctx * (1.0 + csc2) + csh2
            n_c = xc2.shape[0] * xc2.shape[1]
            f = moe(jnp.concatenate([xc2.reshape(-1, D), xl2.reshape(-1, D)], axis=0),
                    router_w[i], router_bias[i], exp_w_gate[i], exp_w_up[i], exp_w_down[i],
                    sh_w_gate[i], sh_w_up[i], sh_w_down[i])
            fc = f[:n_c].reshape(ctx.shape)
            fl = f[n_c:].reshape(x.shape)
            ctx = layer_norm(DEEPNORM_ALPHA * ctx + cg2 * fc, ln_g[i, 1], ln_b[i, 1])
        else:
            fl = moe(xl2.reshape(-1, D), router_w[i], router_bias[i], exp_w_gate[i], exp_w_up[i],
                     exp_w_down[i], sh_w_gate[i], sh_w_up[i], sh_w_down[i]).reshape(x.shape)
        x = layer_norm(DEEPNORM_ALPHA * x + g2 * fl, ln_g[i, 1], ln_b[i, 1])
    return x
```

```cpp
#define MK_PER_PHASE 0
#define DBL_PHASE 14
#include <hip/hip_runtime.h>
#include <cstdio>
#include <cstdint>

#define GAS __attribute__((address_space(1)))
#define LAS __attribute__((address_space(3)))
typedef unsigned short bf16_t;
typedef short bf16x8 __attribute__((ext_vector_type(8)));
typedef short s16x4 __attribute__((ext_vector_type(4)));
typedef float f32x4 __attribute__((ext_vector_type(4)));
typedef float f32x2 __attribute__((ext_vector_type(2)));
typedef float f32x16 __attribute__((ext_vector_type(16)));
typedef unsigned u32x4 __attribute__((ext_vector_type(4)));
typedef unsigned u32x2 __attribute__((ext_vector_type(2)));

constexpr int DM = 2048, SEQ = 16384, CTXL = 256, TT = SEQ + CTXL;
constexpr int NEXP = 64, NEX1 = 65, EHID = 512, TOPK = 8;
constexpr int EV_IN = 5120, OD_IN = 4608;
constexpr float LN_EPS = 1e-6f;
constexpr float ALPHA = 1.4142135623730951f;
constexpr float LAMBDA_INIT = 0.35550906759f;
constexpr int NTHR = 512, NWAVES = 8;

constexpr size_t al256(size_t x) { return (x + 255) / 256 * 256; }
constexpr size_t WS_CTL   = 0;
constexpr size_t CTL_BYTES = 1u << 20;
constexpr size_t WS_MODP  = WS_CTL + CTL_BYTES;
constexpr size_t WS_MODF  = WS_MODP + al256((size_t)2 * 32 * 2 * 12288 * 4);
constexpr size_t WS_ROPE128 = WS_MODF + al256((size_t)2 * 2 * 12288 * 4);
constexpr size_t WS_ROPE64  = WS_ROPE128 + al256((size_t)256 * 64 * 2 * 4);
constexpr size_t WS_KN    = WS_ROPE64 + al256((size_t)256 * 32 * 2 * 4);
constexpr size_t WS_WT    = WS_KN + al256((size_t)2 * 64 * 16 * 1024 * 2);
constexpr size_t WS_APOW  = WS_WT + al256((size_t)2 * 64 * 128 * 1024 * 2);
constexpr size_t WS_AL    = WS_APOW + al256((size_t)2 * 64 * 64 * 128 * 4);
constexpr size_t WS_CC    = WS_AL + al256((size_t)2 * 64 * 128 * 4);
constexpr size_t WS_S5E   = WS_CC + al256((size_t)64 * 16 * 128 * 2);
constexpr size_t WS_HST   = WS_S5E + al256((size_t)2 * 64 * 260 * 128 * 4);
constexpr size_t WS_WIN0  = WS_HST + al256((size_t)2 * 64 * 260 * 128 * 4);
constexpr size_t WS_WOUT0 = WS_WIN0 + al256((size_t)EV_IN * DM * 2);
constexpr size_t WS_WGLU  = WS_WOUT0 + al256((size_t)DM * DM * 2);
constexpr size_t WS_WIN1  = WS_WGLU + al256((size_t)1024 * 1024 * 2);
constexpr size_t WS_WOUT1 = WS_WIN1 + al256((size_t)OD_IN * DM * 2);
constexpr size_t WS_RWT   = WS_WOUT1 + al256((size_t)DM * DM * 2);
constexpr size_t WS_GU    = WS_RWT + al256((size_t)2 * 2 * 64 * DM * 2);
constexpr size_t WS_DT    = WS_GU + al256((size_t)NEX1 * 1024 * DM * 2);
constexpr size_t WS_XA    = WS_DT + al256((size_t)NEX1 * DM * EHID * 2);
constexpr size_t WS_Z     = WS_XA + al256((size_t)TT * DM * 2);
constexpr size_t WS_YMIX  = WS_Z + al256((size_t)TT * 1024 * 2);
constexpr size_t WS_X1    = WS_YMIX + al256((size_t)TT * DM * 2);
constexpr size_t WS_HX2   = WS_X1 + al256((size_t)TT * DM * 4);
constexpr size_t WS_LIST  = WS_HX2 + al256((size_t)9 * TT * EHID * 2);
constexpr size_t WS_WGT   = WS_LIST + al256((size_t)NEX1 * TT * 4);
constexpr size_t WS_LW    = WS_WGT + al256((size_t)8 * TT * 4);
constexpr size_t WS_BIG   = WS_LW + al256((size_t)NEX1 * TT * 4);
constexpr size_t BG_QKV   = 0;
constexpr size_t BG_CKV   = BG_QKV + al256((size_t)TT * EV_IN * 2);
constexpr size_t BG_SPREV = BG_CKV + al256((size_t)8 * 130 * 65536 * 4);
constexpr size_t BG_MIX   = BG_SPREV + al256((size_t)8 * 130 * 65536 * 2);
constexpr size_t BG_END0  = BG_MIX + al256((size_t)TT * DM * 2);
constexpr size_t BG_ATT   = BG_CKV;
constexpr size_t BG_YMOE  = 0;
constexpr size_t BG_END1  = al256((size_t)9 * TT * DM * 2);
constexpr size_t BG_SIZE  = BG_END0 > BG_END1 ? BG_END0 : BG_END1;
constexpr size_t WS_END   = WS_BIG + BG_SIZE;

constexpr int CW_BAR = 4096;
constexpr int CW_CNT = 16384;
constexpr int CW_QUEUE = 20480;

constexpr int RING_BYTES = 139264;
constexpr int MISC_OFF = RING_BYTES;
constexpr int LDS_BYTES = 147456;

typedef __bf16 bf16x2_t __attribute__((ext_vector_type(2)));
__device__ __forceinline__ unsigned cvt_pk_bf16(float lo, float hi) { const f32x2 v = {lo, hi}; return __builtin_bit_cast(unsigned, __builtin_convertvector(v, bf16x2_t)); }
__device__ __forceinline__ bf16_t f2bf(float f) { unsigned u = __builtin_bit_cast(unsigned, f); return (bf16_t)((u + 0x7fffu + ((u >> 16) & 1u)) >> 16); }
__device__ __forceinline__ float bf2f(bf16_t b) { return __builtin_bit_cast(float, ((unsigned)b) << 16); }
__device__ __forceinline__ float bflo(unsigned w) { return __builtin_bit_cast(float, w << 16); }
__device__ __forceinline__ float bfhi(unsigned w) { return __builtin_bit_cast(float, w & 0xffff0000u); }
__device__ __forceinline__ float wave_sum(float v) {
#pragma unroll
    for (int o = 1; o < 64; o <<= 1) v += __shfl_xor(v, o);
    return v;
}
__device__ __forceinline__ float fast_exp(float x) { return __builtin_amdgcn_exp2f(x * 1.4426950408889634f); }
__device__ __forceinline__ float sigmoidf_(float x) { return 1.0f / (1.0f + __expf(-x)); }
__device__ __forceinline__ float siluf_(float x) { return x / (1.0f + __expf(-x)); }
__device__ __forceinline__ float gelu_tanh(float x) {
    const float u = 0.7978845608028654f * (x + 0.044715f * x * x * x);
    const float e = __expf(2.0f * u);
    const float t = 1.0f - 2.0f / (e + 1.0f);
    return 0.5f * x * (1.0f + t);
}
#define LDS_WAIT() asm volatile("s_waitcnt lgkmcnt(0)" ::: "memory")
#define VM_WAIT() asm volatile("s_waitcnt vmcnt(0)" ::: "memory")

#define XB_TMO      128
#define XB_XCNT(j)  (256  + 64 * (j))
#define XB_XSUB(j)  (1280 + 64 * (j))
#define XB_XGEN(j)  (2304 + 64 * (j))
#define XB_TOP      3328
#define XB_TOPGEN   3392
#define XCD_BAR_WORDS 3456
#define XB_SPIN_CAP (1u << 22)

__device__ __forceinline__ unsigned xb_ld(unsigned* p)              { return __hip_atomic_load(p, __ATOMIC_RELAXED, __HIP_MEMORY_SCOPE_AGENT); }
__device__ __forceinline__ unsigned xb_add(unsigned* p, unsigned v) { return __hip_atomic_fetch_add(p, v, __ATOMIC_RELAXED, __HIP_MEMORY_SCOPE_AGENT); }
__device__ __forceinline__ unsigned xb_xcc_id() { return (unsigned)__builtin_amdgcn_s_getreg((3 << 11) | 20) & 0xFu; }
#define XB_SPIN(cond, bar) do { unsigned _sp = 0; while (cond) { __builtin_amdgcn_s_sleep(1); \
    if ((++_sp & 255u) == 0u) { if (xb_ld(&(bar)[XB_TMO])) break; if (_sp > XB_SPIN_CAP) { atomicAdd(&(bar)[XB_TMO], 1u); break; } } } } while (0)

struct XcdBarrier { unsigned* bar; unsigned x; volatile LAS unsigned* st; };

__device__ __forceinline__ XcdBarrier xcd_barrier_post(unsigned* bar, volatile LAS unsigned* st) {
    XcdBarrier b; b.bar = bar; b.x = xb_xcc_id(); b.st = st;
    if (threadIdx.x == 0) { st[2] = xb_add(&bar[XB_XCNT(b.x)], 1u); st[3] = b.x; }
    return b;
}
__device__ __forceinline__ void xcd_barrier_complete(unsigned* bar, unsigned x, unsigned& nloc, unsigned& nx) {
    const unsigned G = gridDim.x * gridDim.y * gridDim.z;
    unsigned sum, cnt, mine, sp = 0u;
    for (;;) {
        sum = 0u; cnt = 0u; mine = 0u;
#pragma unroll
        for (unsigned j = 0; j < 16; ++j) { const unsigned c = xb_ld(&bar[XB_XCNT(j)]); sum += c; cnt += (c > 0u) ? 1u : 0u; mine = (j == x) ? c : mine; }
        if (sum == G) break;
        __builtin_amdgcn_s_sleep(1);
        if ((++sp & 255u) == 0u) { if (xb_ld(&bar[XB_TMO])) break; if (sp > XB_SPIN_CAP) { atomicAdd(&bar[XB_TMO], 1u); break; } }
    }
    nloc = mine > 0u ? mine : 1u; nx = cnt > 0u ? cnt : 1u;
}
__device__ __forceinline__ void xcd_barrier(const XcdBarrier& b, int wave_id) {
    const bool leader_thread = (wave_id == 0) && (__builtin_amdgcn_mbcnt_hi(~0u, __builtin_amdgcn_mbcnt_lo(~0u, 0u)) == 0u);
    asm volatile("s_waitcnt vmcnt(0)" ::: "memory");
    __syncthreads();
    if (leader_thread) {
        unsigned* bar = b.bar;
        __builtin_amdgcn_s_waitcnt(0);
        unsigned nloc = b.st[0], nx = b.st[1];
        if (nloc == 0u) { xcd_barrier_complete(bar, b.x, nloc, nx); b.st[0] = nloc; b.st[1] = nx; }
        const unsigned old = xb_add(&bar[XB_XSUB(b.x)], 1u);
        const unsigned gen = old / nloc;
        if (old + 1u == (gen + 1u) * nloc) {
            __builtin_amdgcn_fence(__ATOMIC_RELEASE, "agent");
            asm volatile("s_waitcnt vmcnt(0)" ::: "memory");
            const unsigned og = xb_add(&bar[XB_TOP], 1u);
            const unsigned tg = og / nx;
            if (og + 1u == (tg + 1u) * nx) xb_add(&bar[XB_TOPGEN], 1u);
            else XB_SPIN(xb_ld(&bar[XB_TOPGEN]) == tg, bar);
            __builtin_amdgcn_fence(__ATOMIC_ACQUIRE, "agent");
            xb_add(&bar[XB_XGEN(b.x)], 1u);
            asm volatile("s_waitcnt vmcnt(0)" ::: "memory");
        } else {
            XB_SPIN(xb_ld(&bar[XB_XGEN(b.x)]) == gen, bar);
            __builtin_amdgcn_fence(__ATOMIC_ACQUIRE, "agent");
            asm volatile("s_waitcnt vmcnt(0)" ::: "memory");
        }
    }
    __syncthreads();
}

__device__ __forceinline__ bf16x8 frag_rowk_l(const LAS bf16_t* p, int ld, int lane) {
    return *(const LAS bf16x8*)(p + (lane & 15) * ld + (lane >> 4) * 8);
}
__device__ __forceinline__ bf16x8 frag_rowk_g(const bf16_t* p, long ld, int lane) {
    return *(const bf16x8*)(p + (long)(lane & 15) * ld + (lane >> 4) * 8);
}
__device__ __forceinline__ bf16x8 frag_colk_l(unsigned p, int ldb, int lane) {
    const unsigned a0 = p + (unsigned)((8 * (lane >> 4) + ((lane & 15) >> 2)) * ldb + (lane & 3) * 8);
    const unsigned a1 = a0 + 4u * (unsigned)ldb;
    s16x4 lo, hi;
    asm volatile("ds_read_b64_tr_b16 %0, %2\n\tds_read_b64_tr_b16 %1, %3\n\ts_waitcnt lgkmcnt(0)" : "=&v"(lo), "=&v"(hi) : "v"(a0), "v"(a1) : "memory");
    return (bf16x8){lo[0], lo[1], lo[2], lo[3], hi[0], hi[1], hi[2], hi[3]};
}
#define MFMA16(a, b, c) __builtin_amdgcn_mfma_f32_16x16x32_bf16((a), (b), (c), 0, 0, 0)
namespace pg8 {
constexpr int BM = 256, BK = 64, HALF = 128, HTB = HALF * BK * 2, STAGE_BYTES = 8 * HTB, NXCD = 8, WGM = 8;
__device__ __forceinline__ int lds_byte(int r, int c) { const int st = (r >> 4) * 2 + (c >> 5), rr = r & 15, cc = c & 31, ob = rr * 64 + cc * 2; return st * 1024 + (ob ^ (((ob >> 9) & 1) << 5)); }
__device__ __forceinline__ void stage_rc(int b, int& R, int& C) { const int st = b / 1024, sb = b % 1024, swz = sb ^ (((sb >> 9) & 1) << 5); R = (st >> 1) * 16 + swz / 64; C = (st & 1) * 32 + (swz % 64) / 2; }
__device__ __forceinline__ int perm32(int rho) { const int n = rho >> 4, i = rho & 15; return 8 * (i >> 2) + 4 * n + (i & 3); }

struct Unit { int pm, pn, e; };
constexpr float WSCALE = 32.0f, WSCALE_INV = 1.0f / 32.0f;

struct DenseOrder {
    const bf16_t* A; const bf16_t* Bt; int ldab, kb, nM, nN, nwg, G, c;
    __device__ __forceinline__ void init(const bf16_t* A_, int lda_, const bf16_t* Bt_, int M, int N, int K_, int G_, int c_) { A = A_; ldab = lda_ * 2; Bt = Bt_; kb = K_ * 2; nM = M / BM; nN = N / BM; nwg = nM * nN; G = G_; c = c_; }
    __device__ __forceinline__ void prep(LAS unsigned char*) const {}
    __device__ __forceinline__ bool next(int i, Unit& u) const {
        const long L = (long)i * G + c; if (L >= nwg) return false;
        int wgid = (int)L; { const int q = nwg / NXCD, r = nwg % NXCD, xcd = wgid % NXCD, off = wgid / NXCD; wgid = (xcd < r ? xcd * (q + 1) : r * (q + 1) + (xcd - r) * q) + off; }
        const int nig = WGM * nN, gid = wgid / nig, fm = gid * WGM, gsz = (nM - fm) < WGM ? (nM - fm) : WGM;
        u.pm = fm + ((wgid % nig) % gsz); u.pn = (wgid % nig) / gsz; u.e = 0; return true;
    }
    __device__ __forceinline__ const char* a_base() const { return (const char*)A; }
    __device__ __forceinline__ unsigned a_off(const Unit& u, int r) const { return (unsigned)(u.pm * BM + r) * (unsigned)ldab; }
    __device__ __forceinline__ const char* b_ptr(const Unit& u) const { return (const char*)Bt + (size_t)u.pn * BM * kb; }
};

template <int MODE  >
struct MoeOrder {
    const void* A; const void* Bt; const int* list; const int* cnt; int ldab, kb, nN, G, c; size_t bstride;
    LAS int* tp; LAS int* cn;
    __device__ __forceinline__ void prep(LAS unsigned char* misc, int tid) {
        tp = (LAS int*)(misc + 64); cn = tp + 72;
        if (tid < NEX1) cn[tid] = cnt[tid];
        __syncthreads();
        if (tid == 0) { int s = 0; for (int e = 0; e < NEX1; ++e) { tp[e] = s; s += (cn[e] + BM - 1) / BM; } tp[NEX1] = s; }
        __syncthreads();
    }
    __device__ __forceinline__ bool next(int i, Unit& u) const {
        const int total = tp[NEX1]; const long nu = (long)total * nN; const int per = (int)((nu + G - 1) / G);
        const int vc = ((G & 7) == 0) ? (c & 7) * (G >> 3) + (c >> 3) : c;
        const long L = (long)vc * per + i;
        if (i >= per || L >= nu) return false;
        const int tile = (int)(L / nN); u.pn = (int)(L % nN);
        int e = 0;
        for (int k = 1; k < NEX1; ++k) e += (tp[k] <= tile) ? 1 : 0;
        u.e = e; u.pm = tile - tp[e]; return true;
    }
    __device__ __forceinline__ const char* a_base() const { return (const char*)A; }
    __device__ __forceinline__ unsigned a_off(const Unit& u, int r) const {
        int pos = u.pm * BM + r; const int n = cn[u.e]; pos = pos < n ? pos : n - 1;
        const int a = list[u.e * TT + pos];
        const int row = (MODE == 0) ? (a < 8 * TT ? (a >> 3) : a - 8 * TT) : a;
        return (unsigned)row * (unsigned)ldab;
    }
    __device__ __forceinline__ const char* b_ptr(const Unit& u) const { return (const char*)Bt + (size_t)u.e * bstride + (size_t)u.pn * BM * kb; }
};

typedef int v8i32 __attribute__((ext_vector_type(8)));
typedef int v4i32_ __attribute__((ext_vector_type(4)));
__device__ __forceinline__ v8i32 cat8(bf16x8 a, bf16x8 b) { const u32x4 x = __builtin_bit_cast(u32x4, a), y = __builtin_bit_cast(u32x4, b); return (v8i32){(int)x.x, (int)x.y, (int)x.z, (int)x.w, (int)y.x, (int)y.y, (int)y.z, (int)y.w}; }
template <bool FP8, class Epi, class Sched>
__device__ __forceinline__ void gemm_phase(LAS unsigned char* lds, const Sched& S, const Epi& E, int wave_id) {
    const int wid = wave_id; int lane = (int)__builtin_amdgcn_mbcnt_hi(~0u, __builtin_amdgcn_mbcnt_lo(~0u, 0u)); asm volatile("" : "+v"(lane));
    const int tid = wid * 64 + lane, wr = wid >> 2, wc = wid & 3, fr = lane & 15, fq = lane >> 4;
    const int kb = S.kb; int nt = kb / 128; asm volatile("" : "+s"(nt));
    unsigned voffB[2];
#pragma unroll
    for (int i = 0; i < 2; ++i) { int R, C; stage_rc(tid * 16 + i * 8192, R, C); const int Rb = (R & ~31) + perm32(R & 31);
        voffB[i] = (unsigned)(Rb * kb) + (unsigned)C * 2u; }
#define PG8_AOFF(u, h, i) ({ int _tz = tid; asm volatile("" : "+v"(_tz)); int _R, _C; stage_rc(_tz * 16 + (i) * 8192, _R, _C); S.a_off((u), (h) * HALF + _R) + (unsigned)_C * 2u; })
    const size_t kstep = (size_t)(BK * 2);
    const size_t hstepB = (size_t)HALF * kb;
    const unsigned ldsw = (unsigned)wid * 1024u;
    const int aoff = lds_byte(wr * 64 + fr, fq * 8), boff = lds_byte(wc * 32 + fr, fq * 8);
#define PG8_SA(b, h) (((b) * 2 + (h)) * HTB)
#define PG8_SB(b, h) ((4 + (b) * 2 + (h)) * HTB)
#define PG8_STAGE(bufoff, gbase, v0, v1) do { \
        __builtin_amdgcn_global_load_lds((const unsigned*)((const char*)(gbase) + (v0)), (LAS unsigned*)(lds + (bufoff) + ldsw), 16, 0, 0); \
        __builtin_amdgcn_global_load_lds((const unsigned*)((const char*)(gbase) + (v1)), (LAS unsigned*)(lds + (bufoff) + ldsw + 8192), 16, 0, 0); } while (0)
#define PG8_VOFFB(i) ({ int _tz = tid; asm volatile("" : "+v"(_tz)); int _R, _C; stage_rc(_tz * 16 + (i) * 8192, _R, _C); (unsigned)(((_R & ~31) + perm32(_R & 31)) * kb) + (unsigned)_C * 2u; })
#define PG8_STAGE_B(bufoff, gbase) do { if constexpr (FP8) { const unsigned _v0 = PG8_VOFFB(0), _v1 = PG8_VOFFB(1); PG8_STAGE(bufoff, gbase, _v0, _v1); } else PG8_STAGE(bufoff, gbase, voffB[0], voffB[1]); } while (0)
#define PG8_LD8(off) __builtin_shufflevector(*(const LAS v4i32_*)(lds + (off)), *(const LAS v4i32_*)(lds + (off) + 1024), 0, 1, 2, 3, 4, 5, 6, 7)
#define PG8_LDA(dst, b, h) do { _Pragma("unroll") for (int m = 0; m < 4; ++m) { if constexpr (FP8) dst##8[m] = PG8_LD8(PG8_SA(b, h) + aoff + m * 2048); else { _Pragma("unroll") for (int k = 0; k < 2; ++k) dst[m][k] = *(const LAS bf16x8*)(lds + PG8_SA(b, h) + aoff + m * 2048 + k * 1024); } } } while (0)
#define PG8_LDB(dst, b, h) do { _Pragma("unroll") for (int n = 0; n < 2; ++n) { if constexpr (FP8) dst##8[n] = PG8_LD8(PG8_SB(b, h) + boff + n * 2048); else { _Pragma("unroll") for (int k = 0; k < 2; ++k) dst[n][k] = *(const LAS bf16x8*)(lds + PG8_SB(b, h) + boff + n * 2048 + k * 1024); } } } while (0)
#define PG8_MMA(ai, bj, At, Bt) do { __builtin_amdgcn_s_setprio(1); _Pragma("unroll") for (int m = 0; m < 4; ++m) _Pragma("unroll") for (int n = 0; n < 2; ++n) { \
        if constexpr (FP8) asm volatile("v_mfma_f32_16x16x128_f8f6f4 %0, %1, %2, %0" : "+v"(acc[ai][bj][m][n]) : "v"(Bt##8[n]), "v"(At##8[m])); \
        else { _Pragma("unroll") for (int k = 0; k < 2; ++k) acc[ai][bj][m][n] = __builtin_amdgcn_mfma_f32_16x16x32_bf16(Bt[n][k], At[m][k], acc[ai][bj][m][n], 0, 0, 0); } } \
        __builtin_amdgcn_s_setprio(0); } while (0)
#define PG8_WAIT_V(n) asm volatile("s_waitcnt vmcnt(" #n ")" ::: "memory")
#define PG8_WAIT_L(n) asm volatile("s_waitcnt lgkmcnt(" #n ")" ::: "memory")
#define PG8_BAR __builtin_amdgcn_s_barrier()
#define PG8_SCHED __builtin_amdgcn_sched_barrier(0)
    Unit cur, nxt; int ui = 0;
    if (!S.next(0, cur)) return;
    f32x4 acc[2][2][4][2];
#pragma unroll
    for (int a = 0; a < 2; ++a)
#pragma unroll
        for (int b = 0; b < 2; ++b)
#pragma unroll
            for (int m = 0; m < 4; ++m)
#pragma unroll
                for (int n = 0; n < 2; ++n) acc[a][b][m][n] = (f32x4){0.f, 0.f, 0.f, 0.f};
    bf16x8 At[4][2], B0[2][2], B1[2][2]; v8i32 At8[4], B08[2], B18[2];
    const char* const gA = S.a_base();
    const char* cB = S.b_ptr(cur);
    unsigned oc00, oc01, oc10, oc11;
    oc00 = PG8_AOFF(cur, 0, 0); oc01 = PG8_AOFF(cur, 0, 1); oc10 = PG8_AOFF(cur, 1, 0); oc11 = PG8_AOFF(cur, 1, 1);
    PG8_STAGE_B(PG8_SB(0, 0), cB); PG8_STAGE_B(PG8_SB(0, 1), cB + hstepB); PG8_STAGE(PG8_SA(0, 0), gA, oc00, oc01); PG8_STAGE(PG8_SA(0, 1), gA, oc10, oc11);
    if (wr == 1) PG8_BAR;
    PG8_WAIT_V(2); PG8_BAR;
    PG8_STAGE_B(PG8_SB(1, 0), cB + kstep); PG8_STAGE(PG8_SA(1, 0), gA + kstep, oc00, oc01); PG8_STAGE_B(PG8_SB(1, 1), cB + hstepB + kstep);
    PG8_WAIT_V(6); PG8_BAR;
    for (;;) {
        const bool has_next = S.next(ui + 1, nxt);
        const char* nB = cB;
        {
            u32x4 on = {oc00, oc01, oc10, oc11};
            if (has_next) { on.x = PG8_AOFF(nxt, 0, 0); on.y = PG8_AOFF(nxt, 0, 1); on.z = PG8_AOFF(nxt, 1, 0); on.w = PG8_AOFF(nxt, 1, 1); nB = S.b_ptr(nxt); }
            *(LAS u32x4*)(lds + STAGE_BYTES + tid * 16) = on;
        }
        for (int t = 0; t < nt; t += 2) {
            const bool last = (t == nt - 2);
            const char* a1 = gA + (size_t)(t + 1) * kstep;
            const char* a2 = last ? gA : gA + (size_t)(t + 2) * kstep; const char* b2 = last ? nB : cB + (size_t)(t + 2) * kstep;
            const char* a3 = a2 + kstep; const char* b3 = b2 + kstep;
            unsigned s00 = oc00, s01 = oc01, s10 = oc10, s11 = oc11;
            if (last) { const u32x4 on = *(const LAS u32x4*)(lds + STAGE_BYTES + tid * 16); s00 = on.x; s01 = on.y; s10 = on.z; s11 = on.w; }
            PG8_LDB(B0, 0, 0); PG8_LDB(B1, 0, 1); PG8_SCHED; PG8_LDA(At, 0, 0); PG8_STAGE(PG8_SA(1, 1), a1, oc10, oc11);
            PG8_WAIT_V(8); PG8_WAIT_L(0); PG8_BAR; PG8_MMA(0, 0, At, B0); PG8_MMA(0, 1, At, B1); PG8_BAR; PG8_SCHED;
            PG8_LDA(At, 0, 1); PG8_STAGE_B(PG8_SB(0, 0), b2); PG8_STAGE_B(PG8_SB(0, 1), b2 + hstepB); PG8_STAGE(PG8_SA(0, 0), a2, s00, s01);
            PG8_WAIT_V(8); PG8_WAIT_L(0); PG8_BAR; PG8_MMA(1, 0, At, B0); PG8_MMA(1, 1, At, B1); PG8_BAR; PG8_SCHED;
            PG8_LDB(B0, 1, 0); PG8_LDB(B1, 1, 1); PG8_SCHED; PG8_LDA(At, 1, 0); PG8_STAGE(PG8_SA(0, 1), a2, s10, s11);
            PG8_WAIT_V(8); PG8_WAIT_L(0); PG8_BAR; PG8_MMA(0, 0, At, B0); PG8_MMA(0, 1, At, B1); PG8_BAR; PG8_SCHED;
            PG8_LDA(At, 1, 1); PG8_STAGE_B(PG8_SB(1, 0), b3); PG8_STAGE_B(PG8_SB(1, 1), b3 + hstepB); PG8_STAGE(PG8_SA(1, 0), a3, s00, s01);
            PG8_WAIT_V(8); PG8_WAIT_L(0); PG8_BAR; PG8_MMA(1, 0, At, B0); PG8_MMA(1, 1, At, B1); PG8_BAR; PG8_SCHED;
        }
        if (wr == 0) PG8_BAR;
        E(acc, cur, wr, wc, fr, fq);
        if (!has_next) break;
#pragma unroll
        for (int a = 0; a < 2; ++a)
#pragma unroll
            for (int b = 0; b < 2; ++b)
#pragma unroll
                for (int m = 0; m < 4; ++m)
#pragma unroll
                    for (int n = 0; n < 2; ++n) acc[a][b][m][n] = (f32x4){0.f, 0.f, 0.f, 0.f};
        { const u32x4 on = *(const LAS u32x4*)(lds + STAGE_BYTES + tid * 16); oc00 = on.x; oc01 = on.y; oc10 = on.z; oc11 = on.w; }
        cur = nxt; cB = nB; ++ui;
        if (wr == 1) PG8_BAR;
    }
    PG8_WAIT_V(0);
    PG8_BAR;
#undef PG8_SA
#undef PG8_SB
#undef PG8_STAGE
#undef PG8_STAGE_B
#undef PG8_AOFF
#undef PG8_VOFFB
#undef PG8_LD8
#undef PG8_LDA
#undef PG8_LDB
#undef PG8_MMA
#undef PG8_WAIT_V
#undef PG8_WAIT_L
#undef PG8_BAR
#undef PG8_SCHED
}

struct EpiStore {
    bf16_t* O; int ldc;
    __device__ __forceinline__ void operator()(const f32x4 (&acc)[2][2][4][2], const Unit& u, int wr, int wc, int fr, int fq) const {
        const int row0 = u.pm * BM + wr * 64 + fr, col0 = u.pn * BM + wc * 32 + 8 * fq;
#pragma unroll
        for (int ai = 0; ai < 2; ++ai)
#pragma unroll
            for (int m = 0; m < 4; ++m) { bf16_t* rowp = O + (size_t)(row0 + ai * HALF + m * 16) * ldc + col0;
#pragma unroll
                for (int bj = 0; bj < 2; ++bj) { const f32x4 v0 = acc[ai][bj][m][0], v1 = acc[ai][bj][m][1];
                    u32x4 w; w.x = cvt_pk_bf16(v0[0], v0[1]); w.y = cvt_pk_bf16(v0[2], v0[3]); w.z = cvt_pk_bf16(v1[0], v1[1]); w.w = cvt_pk_bf16(v1[2], v1[3]);
                    *(u32x4*)(rowp + bj * HALF) = w; } }
    }
};
struct EpiGlu {
    const bf16_t* Z; const float* b; bf16_t* MIX;
    __device__ __forceinline__ void operator()(const f32x4 (&acc)[2][2][4][2], const Unit& u, int wr, int wc, int fr, int fq) const {
        const int row0 = u.pm * BM + wr * 64 + fr, col0 = u.pn * BM + wc * 32 + 8 * fq;
#pragma unroll
        for (int bj = 0; bj < 2; ++bj) {
            const f32x4 b0 = *(const f32x4*)(b + col0 + bj * HALF), b1 = *(const f32x4*)(b + col0 + bj * HALF + 4);
#pragma unroll
            for (int ai = 0; ai < 2; ++ai)
#pragma unroll
                for (int m = 0; m < 4; ++m) { const size_t row = (size_t)(row0 + ai * HALF + m * 16);
                    const u32x4 zz = *(const u32x4*)(Z + row * 1024 + col0 + bj * HALF);
                    const f32x4 v0 = acc[ai][bj][m][0] + b0, v1 = acc[ai][bj][m][1] + b1;
                    u32x4 w;
                    w.x = cvt_pk_bf16(bflo(zz.x) * sigmoidf_(v0[0]), bfhi(zz.x) * sigmoidf_(v0[1]));
                    w.y = cvt_pk_bf16(bflo(zz.y) * sigmoidf_(v0[2]), bfhi(zz.y) * sigmoidf_(v0[3]));
                    w.z = cvt_pk_bf16(bflo(zz.z) * sigmoidf_(v1[0]), bfhi(zz.z) * sigmoidf_(v1[1]));
                    w.w = cvt_pk_bf16(bflo(zz.w) * sigmoidf_(v1[2]), bfhi(zz.w) * sigmoidf_(v1[3]));
                    *(u32x4*)(MIX + row * DM + 1024 + col0 + bj * HALF) = w; }
        }
    }
};
struct EpiE1 {
    unsigned char* H; const int* list; const LAS int* cn;
    __device__ __forceinline__ void operator()(const f32x4 (&acc)[2][2][4][2], const Unit& u, int wr, int wc, int fr, int fq) const {
        const int n = cn[u.e]; const int colh = u.pn * 128 + wc * 32 + 8 * fq;
#pragma unroll
        for (int ai = 0; ai < 2; ++ai)
#pragma unroll
            for (int m = 0; m < 4; ++m) { const int pos = u.pm * BM + ai * HALF + wr * 64 + m * 16 + fr;
                if (pos < n) { const int a = list[u.e * TT + pos];
                    float sc = WSCALE_INV; asm volatile("" : "+v"(sc));
                    const f32x4 g0 = acc[ai][0][m][0] * sc, g1 = acc[ai][0][m][1] * sc, u0 = acc[ai][1][m][0] * sc, u1 = acc[ai][1][m][1] * sc;
                    u32x2 w;
                    w.x = (unsigned)__builtin_amdgcn_cvt_pk_fp8_f32(siluf_(g0[0]) * u0[0], siluf_(g0[1]) * u0[1], 0, false);
                    w.x = (unsigned)__builtin_amdgcn_cvt_pk_fp8_f32(siluf_(g0[2]) * u0[2], siluf_(g0[3]) * u0[3], (int)w.x, true);
                    w.y = (unsigned)__builtin_amdgcn_cvt_pk_fp8_f32(siluf_(g1[0]) * u1[0], siluf_(g1[1]) * u1[1], 0, false);
                    w.y = (unsigned)__builtin_amdgcn_cvt_pk_fp8_f32(siluf_(g1[2]) * u1[2], siluf_(g1[3]) * u1[3], (int)w.y, true);
                    *(u32x2*)(H + (size_t)a * EHID + colh) = w; }
                __builtin_amdgcn_sched_barrier(0); }
    }
};
struct EpiE2 {
    unsigned char* Y; const int* list; const float* wgt; const LAS int* cn;
    __device__ __forceinline__ void operator()(const f32x4 (&acc)[2][2][4][2], const Unit& u, int wr, int wc, int fr, int fq) const {
        const int n = cn[u.e]; const int col0 = u.pn * BM + wc * 32 + 8 * fq;
#pragma unroll
        for (int ai = 0; ai < 2; ++ai)
#pragma unroll
            for (int m = 0; m < 4; ++m) { const int pos = u.pm * BM + ai * HALF + wr * 64 + m * 16 + fr;
                if (pos < n) { const int a = list[u.e * TT + pos]; float ws = wgt[u.e * TT + pos] * WSCALE_INV; asm volatile("" : "+v"(ws));
                    unsigned char* rowp = Y + (size_t)a * DM + col0;
#pragma unroll
                    for (int bj = 0; bj < 2; ++bj) { const f32x4 v0 = acc[ai][bj][m][0] * ws, v1 = acc[ai][bj][m][1] * ws;
                        u32x2 w;
                        w.x = (unsigned)__builtin_amdgcn_cvt_pk_fp8_f32(v0[0], v0[1], 0, false); w.x = (unsigned)__builtin_amdgcn_cvt_pk_fp8_f32(v0[2], v0[3], (int)w.x, true);
                        w.y = (unsigned)__builtin_amdgcn_cvt_pk_fp8_f32(v1[0], v1[1], 0, false); w.y = (unsigned)__builtin_amdgcn_cvt_pk_fp8_f32(v1[2], v1[3], (int)w.y, true);
                        *(u32x2*)(rowp + bj * HALF) = w; } }
                __builtin_amdgcn_sched_barrier(0); }
    }
};
}
struct KArgs {
    const float* in[34];
    float* out;
    unsigned char* ws;
    int ph_lo, ph_hi;
};
struct Params {
    float* out;
    unsigned char* ws;
    LAS unsigned long long* ptab;
    int ph_lo, ph_hi;
    __device__ __forceinline__ const float* inp(int k) const {
        const unsigned long long v = ptab[k];
        const unsigned lo = __builtin_amdgcn_readfirstlane((unsigned)v), hi = __builtin_amdgcn_readfirstlane((unsigned)(v >> 32));
        return (const float*)(((unsigned long long)hi << 32) | lo);
    }
};
struct Ctx {
    LAS unsigned char* lds;
    int tid, lane, wave, G, bid;
    int gw, ngw;
};

__device__ __forceinline__ void tr_item(const float* W, int N, bf16_t* WT, int ldt, int k0, int n0, int orow0, LAS float* scr, int lane) {
#pragma unroll 8
    for (int i = 0; i < 32; ++i) { const int kk = 2 * i + (lane >> 5); scr[kk * 33 + (lane & 31)] = W[(size_t)(k0 + kk) * N + n0 + (lane & 31)]; }
    LDS_WAIT(); asm volatile("" ::: "memory");
    const int c = lane & 7;
#pragma unroll
    for (int j = 0; j < 4; ++j) { const int n = (lane >> 3) + 8 * j; const LAS float* s = scr + (8 * c) * 33 + n;
        u32x4 o; o.x = cvt_pk_bf16(s[0 * 33], s[1 * 33]); o.y = cvt_pk_bf16(s[2 * 33], s[3 * 33]); o.z = cvt_pk_bf16(s[4 * 33], s[5 * 33]); o.w = cvt_pk_bf16(s[6 * 33], s[7 * 33]);
        *(u32x4*)(WT + (size_t)(orow0 + n) * ldt + k0 + 8 * c) = o; }
    LDS_WAIT(); asm volatile("" ::: "memory");
}
__device__ __forceinline__ void tr_item64(const float* W, int N, bf16_t* WT, int ldt, int k0, int n0, int orow0, LAS float* scr, int lane) {
    f32x4 v[16];
    const float* src = W + (size_t)(k0 + (lane >> 4)) * N + n0 + 4 * (lane & 15);
#pragma unroll
    for (int i = 0; i < 16; ++i) v[i] = __builtin_nontemporal_load((const f32x4*)(src + (size_t)(4 * i) * N));
#pragma unroll
    for (int i = 0; i < 16; ++i) { LAS float* d = scr + (4 * i + (lane >> 4)) * 65 + 4 * (lane & 15); d[0] = v[i][0]; d[1] = v[i][1]; d[2] = v[i][2]; d[3] = v[i][3]; }
    LDS_WAIT(); asm volatile("" ::: "memory");
    const int c = lane & 7;
#pragma unroll
    for (int j = 0; j < 8; ++j) { const int n = (lane >> 3) + 8 * j; const LAS float* s = scr + (8 * c) * 65 + n;
        u32x4 o; o.x = cvt_pk_bf16(s[0 * 65], s[1 * 65]); o.y = cvt_pk_bf16(s[2 * 65], s[3 * 65]); o.z = cvt_pk_bf16(s[4 * 65], s[5 * 65]); o.w = cvt_pk_bf16(s[6 * 65], s[7 * 65]);
        *(u32x4*)(WT + (size_t)(orow0 + n) * ldt + k0 + 8 * c) = o; }
    LDS_WAIT(); asm volatile("" ::: "memory");
}
__device__ __forceinline__ void tr_item64_fp8(const float* W, int N, unsigned char* WT, int ldt, int k0, int n0, int orow0, LAS float* scr, int lane) {
    f32x4 v[16];
    const float* src = W + (size_t)(k0 + (lane >> 4)) * N + n0 + 4 * (lane & 15);
#pragma unroll
    for (int i = 0; i < 16; ++i) v[i] = __builtin_nontemporal_load((const f32x4*)(src + (size_t)(4 * i) * N));
#pragma unroll
    for (int i = 0; i < 16; ++i) { LAS float* d = scr + (4 * i + (lane >> 4)) * 65 + 4 * (lane & 15); d[0] = v[i][0]; d[1] = v[i][1]; d[2] = v[i][2]; d[3] = v[i][3]; }
    LDS_WAIT(); asm volatile("" ::: "memory");
    const int c = lane & 7;
#pragma unroll
    for (int j = 0; j < 8; ++j) { const int n = (lane >> 3) + 8 * j; const LAS float* s = scr + (8 * c) * 65 + n;
        u32x2 o;
        o.x = (unsigned)__builtin_amdgcn_cvt_pk_fp8_f32(s[0 * 65] * pg8::WSCALE, s[1 * 65] * pg8::WSCALE, 0, false);
        o.x = (unsigned)__builtin_amdgcn_cvt_pk_fp8_f32(s[2 * 65] * pg8::WSCALE, s[3 * 65] * pg8::WSCALE, (int)o.x, true);
        o.y = (unsigned)__builtin_amdgcn_cvt_pk_fp8_f32(s[4 * 65] * pg8::WSCALE, s[5 * 65] * pg8::WSCALE, 0, false);
        o.y = (unsigned)__builtin_amdgcn_cvt_pk_fp8_f32(s[6 * 65] * pg8::WSCALE, s[7 * 65] * pg8::WSCALE, (int)o.y, true);
        *(u32x2*)(WT + (size_t)(orow0 + n) * ldt + k0 + 8 * c) = o; }
    LDS_WAIT(); asm volatile("" ::: "memory");
}
__device__ __forceinline__ void tr_dense(const float* W, int K, int N, bf16_t* WT, int item, LAS float* scr, int lane) {
    const int nblk = N / 32, kb = item / nblk, nb = item % nblk;
    tr_item(W, N, WT, K, 64 * kb, 32 * nb, 32 * nb, scr, lane);
}

__device__ __forceinline__ void s5_tables(const Params& p, Ctx& C, int dir, int g) {
    LAS f32x2* PW = (LAS f32x2*)C.lds;
    LAS f32x2* BB = PW + 65 * 64;
    LAS f32x2* CX = BB + 64 * 16;
    const float* a_re = p.inp(11); const float* a_im = p.inp(12); const float* log_dt = p.inp(13);
    const float* b_re = p.inp(14); const float* b_im = p.inp(15); const float* c_re = p.inp(16); const float* c_im = p.inp(17);
    const int tid = C.tid;
    if (tid < 64) {
        const int pp = tid;
        const float dt = __expf(log_dt[dir * 64 + g]);
        const float are = a_re[(dir * 64 + g) * 64 + pp], aim = a_im[(dir * 64 + g) * 64 + pp];
        const float zr = are * dt, zi = aim * dt;
        const float mag = __expf(zr);
        double rev = (double)zi * 0.15915494309189535; rev -= floor(rev);
        const float cs = __builtin_amdgcn_cosf((float)rev), sn = __builtin_amdgcn_sinf((float)rev);
        const float abr = mag * cs, abi = mag * sn;
        const float den = are * are + aim * aim, nr = abr - 1.0f, ni = abi;
        const float fre = (nr * are + ni * aim) / den, fim = (ni * are - nr * aim) / den;
        float pr = 1.0f, pi = 0.0f;
#pragma unroll 1
        for (int n = 0; n <= 64; ++n) { PW[n * 64 + pp] = (f32x2){pr, pi}; const float t = pr * abr - pi * abi; pi = pr * abi + pi * abr; pr = t; }
        for (int j = 0; j < 16; ++j) { const float br = b_re[(g * 64 + pp) * 16 + j], bi = b_im[(g * 64 + pp) * 16 + j];
            BB[pp * 16 + j] = (f32x2){fre * br - fim * bi, fre * bi + fim * br}; }
    }
    for (int q = tid; q < 1024; q += NTHR) { const int i = q >> 6, pp = q & 63; CX[i * 64 + pp] = (f32x2){c_re[(g * 16 + i) * 64 + pp], c_im[(g * 16 + i) * 64 + pp]}; }
    __syncthreads();
    bf16_t* KN = (bf16_t*)(p.ws + WS_KN) + (size_t)(dir * 64 + g) * 16 * 1024;
    bf16_t* WTt = (bf16_t*)(p.ws + WS_WT) + (size_t)(dir * 64 + g) * 128 * 1024;
    float* APOW = (float*)(p.ws + WS_APOW) + (size_t)(dir * 64 + g) * 64 * 128;
    float* AL = (float*)(p.ws + WS_AL) + (size_t)(dir * 64 + g) * 128;
#pragma unroll 1
    for (int q = 0; q < 32; ++q) { const int idx = tid + NTHR * q; const int n = idx >> 8, i = (idx >> 4) & 15, j = idx & 15;
        float s = 0.f;
#pragma unroll 4
        for (int pp = 0; pp < 64; ++pp) { const f32x2 c = CX[i * 64 + pp], w = PW[n * 64 + pp], b = BB[pp * 16 + j];
            const float gr = c.x * b.x - c.y * b.y, gi = c.x * b.y + c.y * b.x;
            s += gr * w.x - gi * w.y; }
        KN[(size_t)i * 1024 + n * 16 + j] = f2bf(s); }
#pragma unroll 2
    for (int q = 0; q < 256; ++q) { const int idx = tid + NTHR * q; const int j = idx & 15, s = (idx >> 4) & 63, pq = idx >> 10; const int pp = pq & 63;
        const f32x2 w = PW[(63 - s) * 64 + pp], b = BB[pp * 16 + j];
        const float v = (pq < 64) ? (w.x * b.x - w.y * b.y) : (w.x * b.y + w.y * b.x);
        WTt[(size_t)pq * 1024 + s * 16 + j] = f2bf(v); }
    for (int q = tid; q < 4096; q += NTHR) { const int t = q >> 6, pp = q & 63; const f32x2 w = PW[(t + 1) * 64 + pp]; *(f32x2*)(APOW + (size_t)t * 128 + 2 * pp) = w; }
    if (tid < 64) { const f32x2 w = PW[64 * 64 + tid]; *(f32x2*)(AL + 2 * tid) = w; }
    if (dir == 0) { bf16_t* CCt = (bf16_t*)(p.ws + WS_CC) + (size_t)g * 16 * 128;
        for (int q = tid; q < 2048; q += NTHR) { const int i = q >> 7, pq = q & 127; const f32x2 c = CX[i * 64 + (pq & 63)]; CCt[i * 128 + pq] = f2bf(pq < 64 ? c.x : -c.y); } }
    __syncthreads();
}

__device__ __forceinline__ void phase_p0(const Params& p, Ctx& C) {
    for (int task = C.bid; task < 128; task += C.G) s5_tables(p, C, task >> 6, task & 63);
    {
        const int gt = C.bid * NTHR + C.tid, ngt = C.G * NTHR;
        float* R128 = (float*)(p.ws + WS_ROPE128); float* R64 = (float*)(p.ws + WS_ROPE64);
        for (int q = gt; q < 256 * 64 + 256 * 32; q += ngt) {
            int pos, i, half; float* dst;
            if (q < 256 * 64) { pos = q >> 6; i = q & 63; half = 64; dst = R128 + (size_t)q * 2; }
            else { const int r = q - 256 * 64; pos = r >> 5; i = r & 31; half = 32; dst = R64 + (size_t)r * 2; }
            const float freq = exp2f(-(float)i / (float)half * 13.287712379549449f);
            const float ang = (float)pos * freq;
            double rev = (double)ang * 0.15915494309189535; rev -= floor(rev);
            dst[0] = __builtin_amdgcn_cosf((float)rev); dst[1] = __builtin_amdgcn_sinf((float)rev);
        }
        bf16_t* RWT = (bf16_t*)(p.ws + WS_RWT); const float* rw = p.inp(26);
        for (int q = gt; q < 2 * 64 * DM; q += ngt) { const int L = q / (64 * DM), r = q % (64 * DM), e = r / DM, k = r % DM;
            const float w = rw[((size_t)L * DM + k) * 64 + e]; const bf16_t hi = f2bf(w); const bf16_t lo = f2bf(w - bf2f(hi));
            RWT[((size_t)(L * 2 + 0) * 64 + e) * DM + k] = hi; RWT[((size_t)(L * 2 + 1) * 64 + e) * DM + k] = lo; }
    }
    {
        const float* cvec = p.inp(1); const float* cctx = p.inp(3); const float* mw = p.inp(4);
        float* MODP = (float*)(p.ws + WS_MODP);
        for (int task = C.gw; task < 2 * 32 * 48; task += C.ngw) {
            const int L = task / (32 * 48), r = task % (32 * 48), kb = r / 48, cb = r % 48;
            const float sc = siluf_(cvec[64 * kb + C.lane]), sx = siluf_(cctx[64 * kb + C.lane]);
            f32x4 a0 = {0.f, 0.f, 0.f, 0.f}, a1 = {0.f, 0.f, 0.f, 0.f};
            const float* wp = mw + ((size_t)L * DM + 64 * kb) * 12288 + 256 * cb + 4 * C.lane;
#pragma unroll 8
            for (int kk = 0; kk < 64; ++kk) { const f32x4 w = *(const f32x4*)(wp + (size_t)kk * 12288);
                const float s0 = __shfl(sc, kk), s1 = __shfl(sx, kk);
                a0 += w * s0; a1 += w * s1; }
            *(f32x4*)(MODP + ((size_t)((L * 32 + kb) * 2 + 0)) * 12288 + 256 * cb + 4 * C.lane) = a0;
            *(f32x4*)(MODP + ((size_t)((L * 32 + kb) * 2 + 1)) * 12288 + 256 * cb + 4 * C.lane) = a1;
        }
    }
    {
        LAS float* scr = (LAS float*)(C.lds + C.wave * 16384);
        constexpr int I0 = (DM / 64) * (EV_IN / 32), I1 = (DM / 64) * (DM / 32), I2 = (1024 / 64) * (1024 / 32), I3 = (DM / 64) * (OD_IN / 32), I4 = I1;
        for (int it = C.gw; it < I0 + I1 + I2 + I3 + I4; it += C.ngw) {
            int r = it;
            if (r < I0) { tr_dense(p.inp(8), DM, EV_IN, (bf16_t*)(p.ws + WS_WIN0), r, scr, C.lane); continue; } r -= I0;
            if (r < I1) { tr_dense(p.inp(9), DM, DM, (bf16_t*)(p.ws + WS_WOUT0), r, scr, C.lane); continue; } r -= I1;
            if (r < I2) { tr_dense(p.inp(19), 1024, 1024, (bf16_t*)(p.ws + WS_WGLU), r, scr, C.lane); continue; } r -= I2;
            if (r < I3) { tr_dense(p.inp(21), DM, OD_IN, (bf16_t*)(p.ws + WS_WIN1), r, scr, C.lane); continue; } r -= I3;
            tr_dense(p.inp(22), DM, DM, (bf16_t*)(p.ws + WS_WOUT1), r, scr, C.lane);
        }
    }
}
__device__ __forceinline__ void phase_p1(const Params& p, Ctx& C) {
    const float* MODP = (const float*)(p.ws + WS_MODP); float* MODF = (float*)(p.ws + WS_MODF); const float* mb = p.inp(5);
    for (int q = C.bid * NTHR + C.tid; q < 2 * 2 * 12288; q += C.G * NTHR) { const int L = q / (2 * 12288), v = (q / 12288) & 1, col = q % 12288;
        float s = mb[L * 12288 + col];
        for (int kb = 0; kb < 32; ++kb) s += MODP[((size_t)((L * 32 + kb) * 2 + v)) * 12288 + col];
        MODF[q] = s; }
}
__device__ __forceinline__ const float* modv(const Params& p, int L, int v, int k) { return (const float*)(p.ws + WS_MODF) + (size_t)(L * 2 + v) * 12288 + k * DM; }

__device__ __forceinline__ void phase_modulate(const Params& p, Ctx& C, int L) {
    bf16_t* XA = (bf16_t*)(p.ws + WS_XA);
    const float* X2 = (const float*)(p.ws + WS_HX2);
    for (int r = C.gw; r < TT; r += C.ngw) {
        const int v = r < CTXL ? 1 : 0;
        const float* src = (L == 0) ? (r < CTXL ? p.inp(2) + (size_t)r * DM : p.inp(0) + (size_t)(r - CTXL) * DM) : X2 + (size_t)r * DM;
        const float* sh = modv(p, L, v, 0); const float* sc = modv(p, L, v, 1);
#pragma unroll
        for (int j = 0; j < 8; ++j) { const int c = 4 * (C.lane + 64 * j);
            const f32x4 x = *(const f32x4*)(src + c), a = *(const f32x4*)(sc + c), b = *(const f32x4*)(sh + c);
            const f32x4 y = x * (a + 1.0f) + b;
            u32x2 w; w.x = cvt_pk_bf16(y[0], y[1]); w.y = cvt_pk_bf16(y[2], y[3]);
            *(u32x2*)(XA + (size_t)r * DM + c) = w; }
    }
    LAS float* scr = (LAS float*)(C.lds + C.wave * 17408);
    unsigned char* GU = (unsigned char*)(p.ws + WS_GU); unsigned char* DT = (unsigned char*)(p.ws + WS_DT);
    for (int it = C.gw; it < NEX1 * 768; it += C.ngw) {
        const int e = it / 768, r = it % 768, which = r >> 8, q = r & 255;
        if (which < 2) {
            const float* W = (e < 64) ? p.inp(28 + which) + ((size_t)(L * 64 + e)) * DM * EHID : p.inp(31 + which) + (size_t)L * DM * EHID;
            const int kb = q >> 3, nb = q & 7, n0 = 64 * nb;
            tr_item64_fp8(W, EHID, GU + (size_t)e * 1024 * DM, DM, 64 * kb, n0, 256 * (n0 >> 7) + (n0 & 127) + (which ? 128 : 0), scr, C.lane);
        } else {
            const float* W = (e < 64) ? p.inp(30) + ((size_t)(L * 64 + e)) * EHID * DM : p.inp(33) + (size_t)L * EHID * DM;
            const int kb = q >> 5, nb = q & 31;
            tr_item64_fp8(W, DM, DT + (size_t)e * DM * EHID, EHID, 64 * kb, 64 * nb, 64 * nb, scr, C.lane);
        }
    }
}

__device__ __forceinline__ void phase_rope0(const Params& p, Ctx& C) {
    bf16_t* QKV = (bf16_t*)(p.ws + WS_BIG + BG_QKV);
    const f32x2* R128 = (const f32x2*)(p.ws + WS_ROPE128);
    for (int r = C.gw; r < TT; r += C.ngw) {
        bf16_t* row = QKV + (size_t)r * EV_IN;
        if (r < CTXL) {
#pragma unroll
            for (int j = 0; j < 2; ++j) { u32x4* q = (u32x4*)(row + 8 * (C.lane + 64 * j)); u32x4 w = *q;
                w.x = cvt_pk_bf16(bflo(w.x) * 0.0625f, bfhi(w.x) * 0.0625f); w.y = cvt_pk_bf16(bflo(w.y) * 0.0625f, bfhi(w.y) * 0.0625f);
                w.z = cvt_pk_bf16(bflo(w.z) * 0.0625f, bfhi(w.z) * 0.0625f); w.w = cvt_pk_bf16(bflo(w.w) * 0.0625f, bfhi(w.w) * 0.0625f); *q = w; }
        } else {
            const int l = r - CTXL, rp = l >> 6, cp = l & 63;
#pragma unroll
            for (int qk = 0; qk < 2; ++qk)
#pragma unroll
                for (int m = 0; m < 8; ++m) { const int pi = C.lane + 64 * m, head = pi >> 7, blk = (pi >> 6) & 1, i = pi & 63;
                    bf16_t* b = row + qk * 1024 + head * 256 + blk * 128 + i;
                    const f32x2 cs = R128[(blk ? cp : rp) * 64 + i];
                    const float x1 = bf2f(b[0]), x2 = bf2f(b[64]); const float sc = qk ? 1.0f : 0.0625f;
                    b[0] = f2bf((x1 * cs.x - x2 * cs.y) * sc); b[64] = f2bf((x1 * cs.y + x2 * cs.x) * sc); }
        }
    }
}

__device__ __forceinline__ void phase_normrope1(const Params& p, Ctx& C) {
    bf16_t* QKV = (bf16_t*)(p.ws + WS_BIG + BG_QKV);
    const f32x2* R64 = (const f32x2*)(p.ws + WS_ROPE64);
    const float* qg = p.inp(23);
    const int lane = C.lane, i32 = lane & 31; const bool up = lane >= 32;
    const float g00 = qg[lane], g01 = qg[64 + lane], g10 = qg[128 + lane], g11 = qg[128 + 64 + lane];
    for (int r = C.gw; r < TT; r += C.ngw) {
        bf16_t* row = QKV + (size_t)r * OD_IN;
        const bool lat = r >= CTXL; const int l = r - CTXL, rp = lat ? (l >> 6) : 0, cp = lat ? (l & 63) : 0;
        const f32x2 cr = R64[rp * 32 + i32], cc = R64[cp * 32 + i32];
#pragma unroll 2
        for (int h = 0; h < 26; ++h) {
            const int col = h < 8 ? 128 * h : (h < 10 ? 1024 + 128 * (h - 8) : (h < 18 ? 1536 + 128 * (h - 10) : 2560 + 128 * (h - 18)));
            bf16_t* b = row + col;
            float v0 = bf2f(b[lane]), v1 = bf2f(b[64 + lane]);
            if (h < 10) { const float ss = wave_sum(v0 * v0 + v1 * v1); const float rs = rsqrtf(ss * (1.0f / 128.0f) + LN_EPS);
                v0 = bf2f(f2bf(v0 * rs)) * (h < 8 ? g00 : g10); v1 = bf2f(f2bf(v1 * rs)) * (h < 8 ? g01 : g11); }
            if (lat) { const float p0 = __shfl_xor(v0, 32), p1 = __shfl_xor(v1, 32);
                v0 = up ? (p0 * cr.y + v0 * cr.x) : (v0 * cr.x - p0 * cr.y);
                v1 = up ? (p1 * cc.y + v1 * cc.x) : (v1 * cc.x - p1 * cc.y); }
            b[lane] = f2bf(v0); b[64 + lane] = f2bf(v1);
        }
    }
}

__device__ __forceinline__ void phase_merge1(const Params& p, Ctx& C) {
    bf16_t* ATT = (bf16_t*)(p.ws + WS_BIG + BG_ATT);
    const float* dl = p.inp(24); const float* sg = p.inp(25);
    const int lane = C.lane;
    float d0 = dl[lane] * dl[128 + lane] + dl[64 + lane] * dl[128 + 64 + lane];
    float d1 = dl[256 + lane] * dl[384 + lane] + dl[256 + 64 + lane] * dl[384 + 64 + lane];
    const float lam = __expf(wave_sum(d0)) - __expf(wave_sum(d1)) + LAMBDA_INIT;
    const f32x4 gg = *(const f32x4*)(sg + 4 * lane);
    for (int l = C.gw; l < SEQ; l += C.ngw) {
        bf16_t* row = ATT + (size_t)l * 3072;
#pragma unroll
        for (int h = 0; h < 4; ++h) {
            const u32x2 a = *(const u32x2*)(row + 1024 + 256 * h + 4 * lane), b = *(const u32x2*)(row + 2048 + 256 * h + 4 * lane);
            f32x4 o = {bflo(a.x) - lam * bflo(b.x), bfhi(a.x) - lam * bfhi(b.x), bflo(a.y) - lam * bflo(b.y), bfhi(a.y) - lam * bfhi(b.y)};
            const float ss = wave_sum(o[0] * o[0] + o[1] * o[1] + o[2] * o[2] + o[3] * o[3]);
            const float rs = rsqrtf(ss * (1.0f / 256.0f) + LN_EPS) * (1.0f - LAMBDA_INIT);
            o = o * rs * gg;
            u32x2 w; w.x = cvt_pk_bf16(o[0], o[1]); w.y = cvt_pk_bf16(o[2], o[3]);
            *(u32x2*)(row + 1024 + 256 * h + 4 * lane) = w;
        }
    }
}

__device__ __forceinline__ void phase_ln1(const Params& p, Ctx& C, int L) {
    const bf16_t* Y = (const bf16_t*)(p.ws + WS_YMIX); float* X1 = (float*)(p.ws + WS_X1); unsigned char* XA8 = (unsigned char*)(p.ws + WS_XA);
    const float* X2 = (const float*)(p.ws + WS_HX2);
    const float* lg = p.inp(6) + (size_t)(L * 2 + 0) * DM; const float* lb = p.inp(7) + (size_t)(L * 2 + 0) * DM;
    const int r0 = (L == 0) ? 0 : CTXL;
    for (int r = r0 + C.gw; r < TT; r += C.ngw) {
        const int v = r < CTXL ? 1 : 0;
        const float* src = (L == 0) ? (r < CTXL ? p.inp(2) + (size_t)r * DM : p.inp(0) + (size_t)(r - CTXL) * DM) : X2 + (size_t)r * DM;
        const float* g1 = modv(p, L, v, 2); const float* sh2 = modv(p, L, v, 3); const float* sc2 = modv(p, L, v, 4);
        f32x4 t[8]; float s = 0.f;
#pragma unroll
        for (int j = 0; j < 8; ++j) { const int c = 4 * (C.lane + 64 * j);
            const f32x4 x = *(const f32x4*)(src + c), g = *(const f32x4*)(g1 + c); const u32x2 yy = *(const u32x2*)(Y + (size_t)r * DM + c);
            const f32x4 y = {bflo(yy.x), bfhi(yy.x), bflo(yy.y), bfhi(yy.y)};
            t[j] = x * ALPHA + g * y; s += (t[j][0] + t[j][1]) + (t[j][2] + t[j][3]); }
        const float mean = wave_sum(s) * (1.0f / DM); float s2 = 0.f;
#pragma unroll
        for (int j = 0; j < 8; ++j) { t[j] = t[j] - mean; s2 += (t[j][0] * t[j][0] + t[j][1] * t[j][1]) + (t[j][2] * t[j][2] + t[j][3] * t[j][3]); }
        const float rstd = rsqrtf(wave_sum(s2) * (1.0f / DM) + LN_EPS);
#pragma unroll
        for (int j = 0; j < 8; ++j) { const int c = 4 * (C.lane + 64 * j);
            const f32x4 x1 = t[j] * rstd * *(const f32x4*)(lg + c) + *(const f32x4*)(lb + c);
            *(f32x4*)(X1 + (size_t)r * DM + c) = x1;
            const f32x4 z = x1 * (*(const f32x4*)(sc2 + c) + 1.0f) + *(const f32x4*)(sh2 + c);
            unsigned w = (unsigned)__builtin_amdgcn_cvt_pk_fp8_f32(z[0], z[1], 0, false); w = (unsigned)__builtin_amdgcn_cvt_pk_fp8_f32(z[2], z[3], (int)w, true);
            *(unsigned*)(XA8 + (size_t)r * DM + c) = w; }
    }
}

__device__ __forceinline__ void phase_combine(const Params& p, Ctx& C, int L) {
    const unsigned char* YM = (const unsigned char*)(p.ws + WS_BIG + BG_YMOE); const float* X1 = (const float*)(p.ws + WS_X1);
    float* X2 = (float*)(p.ws + WS_HX2);
    const float* lg = p.inp(6) + (size_t)(L * 2 + 1) * DM; const float* lb = p.inp(7) + (size_t)(L * 2 + 1) * DM;
    const int r0 = (L == 0) ? 0 : CTXL;
    for (int r = r0 + C.gw; r < TT; r += C.ngw) {
        const int v = r < CTXL ? 1 : 0;
        const float* g2 = modv(p, L, v, 5);
        int ln = C.lane; asm volatile("" : "+v"(ln));
        f32x4 t[2][4]; float s = 0.f;
#pragma unroll
        for (int j = 0; j < 2; ++j) { const int c = 16 * (ln + 64 * j);
            u32x4 yy[9];
#pragma unroll
            for (int k = 0; k < 9; ++k) { const size_t a = (k < 8) ? (size_t)r * 8 + k : (size_t)8 * TT + r; yy[k] = __builtin_nontemporal_load((const u32x4*)(YM + a * DM + c)); }
            f32x2 f[8];
#pragma unroll
            for (int q = 0; q < 8; ++q) f[q] = (f32x2){0.f, 0.f};
#pragma unroll
            for (int k = 0; k < 9; ++k) {
                f[0] += __builtin_amdgcn_cvt_pk_f32_fp8((int)yy[k].x, false); f[1] += __builtin_amdgcn_cvt_pk_f32_fp8((int)yy[k].x, true);
                f[2] += __builtin_amdgcn_cvt_pk_f32_fp8((int)yy[k].y, false); f[3] += __builtin_amdgcn_cvt_pk_f32_fp8((int)yy[k].y, true);
                f[4] += __builtin_amdgcn_cvt_pk_f32_fp8((int)yy[k].z, false); f[5] += __builtin_amdgcn_cvt_pk_f32_fp8((int)yy[k].z, true);
                f[6] += __builtin_amdgcn_cvt_pk_f32_fp8((int)yy[k].w, false); f[7] += __builtin_amdgcn_cvt_pk_f32_fp8((int)yy[k].w, true); }
#pragma unroll
            for (int q = 0; q < 4; ++q) { const f32x4 x = *(const f32x4*)(X1 + (size_t)r * DM + c + 4 * q), g = *(const f32x4*)(g2 + c + 4 * q);
                const f32x4 ff = {f[2 * q][0], f[2 * q][1], f[2 * q + 1][0], f[2 * q + 1][1]};
                t[j][q] = x * ALPHA + g * ff; s += (t[j][q][0] + t[j][q][1]) + (t[j][q][2] + t[j][q][3]); } }
        const float mean = wave_sum(s) * (1.0f / DM); float s2 = 0.f;
#pragma unroll
        for (int j = 0; j < 2; ++j)
#pragma unroll
            for (int q = 0; q < 4; ++q) { t[j][q] = t[j][q] - mean; s2 += (t[j][q][0] * t[j][q][0] + t[j][q][1] * t[j][q][1]) + (t[j][q][2] * t[j][q][2] + t[j][q][3] * t[j][q][3]); }
        const float rstd = rsqrtf(wave_sum(s2) * (1.0f / DM) + LN_EPS);
        float* dst = (L == 0) ? X2 + (size_t)r * DM : p.out + (size_t)(r - CTXL) * DM;
#pragma unroll
        for (int j = 0; j < 2; ++j)
#pragma unroll
            for (int q = 0; q < 4; ++q) { const int c = 16 * (ln + 64 * j) + 4 * q;
                *(f32x4*)(dst + c) = t[j][q] * rstd * *(const f32x4*)(lg + c) + *(const f32x4*)(lb + c); }
    }
}
constexpr int RLD = 264;
constexpr int SLD = 136;

template <bool SCALE>
__device__ __forceinline__ void stage_chunk(const bf16_t* QKV, int row0, int col0, LAS bf16_t* dst, int tid, float lg  , int dirb) {
#pragma unroll
    for (int q = 0; q < 8; ++q) { const int idx = tid + NTHR * q, r = idx >> 5, c = idx & 31;
        u32x4 w = *(const u32x4*)(QKV + (size_t)(row0 + r) * EV_IN + col0 + 8 * c);
        if (SCALE) { const float sc = fast_exp((dirb ? (float)r : (float)(127 - r)) * lg);
            w.x = cvt_pk_bf16(bflo(w.x) * sc, bfhi(w.x) * sc); w.y = cvt_pk_bf16(bflo(w.y) * sc, bfhi(w.y) * sc);
            w.z = cvt_pk_bf16(bflo(w.z) * sc, bfhi(w.z) * sc); w.w = cvt_pk_bf16(bflo(w.w) * sc, bfhi(w.w) * sc); }
        *(LAS u32x4*)(dst + r * RLD + 8 * c) = w; }
}

__device__ __forceinline__ void ret_chunk_kv(const Params& p, Ctx& C) {
    const bf16_t* QKV = (const bf16_t*)(p.ws + WS_BIG + BG_QKV); float* CKV = (float*)(p.ws + WS_BIG + BG_CKV);
    const float* rld = p.inp(10);
    LAS bf16_t* Vs = (LAS bf16_t*)C.lds; LAS bf16_t* Ks = Vs + 128 * RLD;
    const int lane = C.lane, w = C.wave;
    for (int unit = C.bid; unit < 130 * 8; unit += C.G) {
        const int u = unit >> 3, h = (unit >> 1) & 3, dir = unit & 1;
        const float lg = rld[dir * 4 + h];
        __syncthreads();
        stage_chunk<false>(QKV, 128 * u, 2048 + 256 * h, Vs, C.tid, 0.f, 0);
        stage_chunk<true>(QKV, 128 * u, 1024 + 256 * h, Ks, C.tid, lg, dir);
        __syncthreads();
        f32x4 acc[2][16];
#pragma unroll
        for (int a = 0; a < 2; ++a)
#pragma unroll
            for (int b = 0; b < 16; ++b) acc[a][b] = (f32x4){0.f, 0.f, 0.f, 0.f};
        const unsigned vbase = (unsigned)(uintptr_t)Vs, kbase = (unsigned)(uintptr_t)Ks;
#pragma unroll 1
        for (int ks = 0; ks < 4; ++ks) {
            bf16x8 af[2];
#pragma unroll
            for (int a = 0; a < 2; ++a) af[a] = frag_colk_l(vbase + (unsigned)((32 * ks) * RLD + 32 * w + 16 * a) * 2u, RLD * 2, lane);
#pragma unroll
            for (int b = 0; b < 16; ++b) { const bf16x8 bf = frag_colk_l(kbase + (unsigned)((32 * ks) * RLD + 16 * b) * 2u, RLD * 2, lane);
                acc[0][b] = MFMA16(af[0], bf, acc[0][b]); acc[1][b] = MFMA16(af[1], bf, acc[1][b]); }
        }
        float* dst = CKV + ((size_t)((dir * 4 + h) * 130 + u)) * 65536;
#pragma unroll
        for (int a = 0; a < 2; ++a)
#pragma unroll
            for (int b = 0; b < 16; ++b)
#pragma unroll
                for (int j = 0; j < 4; ++j) dst[(size_t)(32 * w + 16 * a + 4 * (lane >> 4) + j) * 256 + 16 * b + (lane & 15)] = acc[a][b][j];
    }
    __syncthreads();
}

__device__ __forceinline__ int s5_row(int dir, int c, int s) { return dir == 0 ? 64 * c + s : (c < 4 ? 255 - (64 * c + s) : 16639 - 64 * (c - 4) - s); }

__device__ __forceinline__ void s5_end_states(const Params& p, Ctx& C) {
    const bf16_t* QKV = (const bf16_t*)(p.ws + WS_BIG + BG_QKV); const bf16_t* WTt = (const bf16_t*)(p.ws + WS_WT); float* E = (float*)(p.ws + WS_S5E);
    const int lane = C.lane, kq = lane >> 4;
    for (int task = C.gw; task < 2 * 64 * 17; task += C.ngw) {
        const int dir = task / (64 * 17), r = task % (64 * 17), g = r / 17, ct = r % 17;
        int cc = 16 * ct + (lane & 15); const bool valid = cc < 260; cc = valid ? cc : 259;
        const bf16_t* wt = WTt + (size_t)(dir * 64 + g) * 128 * 1024;
        f32x4 acc[8];
#pragma unroll
        for (int t = 0; t < 8; ++t) acc[t] = (f32x4){0.f, 0.f, 0.f, 0.f};
#pragma unroll 2
        for (int ks = 0; ks < 32; ++ks) {
            const int s = 2 * ks + (kq >> 1);
            const bf16x8 bf = *(const bf16x8*)(QKV + (size_t)s5_row(dir, cc, s) * EV_IN + 4096 + 16 * g + 8 * (kq & 1));
#pragma unroll
            for (int t = 0; t < 8; ++t) { const bf16x8 af = frag_rowk_g(wt + (size_t)(16 * t) * 1024 + 32 * ks, 1024, lane); acc[t] = MFMA16(af, bf, acc[t]); }
        }
        if (valid) { float* dst = E + ((size_t)((dir * 64 + g) * 260 + cc)) * 128;
#pragma unroll
            for (int t = 0; t < 8; ++t) *(f32x4*)(dst + 16 * t + 4 * kq) = acc[t]; }
    }
}

__device__ __forceinline__ void phase_scans(const Params& p, Ctx& C) {
    const float* CKV = (const float*)(p.ws + WS_BIG + BG_CKV); bf16_t* SP = (bf16_t*)(p.ws + WS_BIG + BG_SPREV);
    const float* rld = p.inp(10);
    for (int q = C.bid * NTHR + C.tid; q < 8 * 16384; q += C.G * NTHR) {
        const int dh = q >> 14, el = (q & 16383) * 4, dir = dh >> 2, h = dh & 3;
        const float gch = fast_exp(128.0f * rld[dir * 4 + h]);
        const float* src = CKV + (size_t)dh * 130 * 65536 + el; bf16_t* dst = SP + (size_t)dh * 130 * 65536 + el;
        f32x4 s = {0.f, 0.f, 0.f, 0.f};
        for (int st0 = 0; st0 < 130; st0 += 10) {
            f32x4 kv[10];
#pragma unroll
            for (int k = 0; k < 10; ++k) { const int st = st0 + k; const int u = dir == 0 ? st : (st == 0 ? 1 : (st == 1 ? 0 : 131 - st)); kv[k] = *(const f32x4*)(src + (size_t)u * 65536); }
#pragma unroll
            for (int k = 0; k < 10; ++k) { const int st = st0 + k; const int u = dir == 0 ? st : (st == 0 ? 1 : (st == 1 ? 0 : 131 - st));
                u32x2 w; w.x = cvt_pk_bf16(s[0], s[1]); w.y = cvt_pk_bf16(s[2], s[3]); *(u32x2*)(dst + (size_t)u * 65536) = w;
                s = s * gch + kv[k]; }
        }
    }
    const float* E = (const float*)(p.ws + WS_S5E); float* HST = (float*)(p.ws + WS_HST); const float* AL = (const float*)(p.ws + WS_AL);
    for (int q = C.bid * NTHR + C.tid; q < 2 * 64 * 64; q += C.G * NTHR) {
        const int dg = q >> 6, pp = q & 63;
        const f32x2 al = *(const f32x2*)(AL + (size_t)dg * 128 + 2 * pp);
        const float* e = E + (size_t)dg * 260 * 128; float* hs = HST + (size_t)dg * 260 * 128;
        float hr = 0.f, hi = 0.f;
        for (int c0 = 0; c0 < 260; c0 += 10) {
            float er[10], ei[10];
#pragma unroll
            for (int k = 0; k < 10; ++k) { er[k] = e[(size_t)(c0 + k) * 128 + pp]; ei[k] = e[(size_t)(c0 + k) * 128 + 64 + pp]; }
#pragma unroll
            for (int k = 0; k < 10; ++k) { *(f32x2*)(hs + (size_t)(c0 + k) * 128 + 2 * pp) = (f32x2){hr, hi};
                const float t = al.x * hr - al.y * hi + er[k]; hi = al.x * hi + al.y * hr + ei[k]; hr = t; }
        }
    }
}

__device__ __forceinline__ void ret_output_unit(const Params& p, Ctx& C, int unit) {
    const bf16_t* QKV = (const bf16_t*)(p.ws + WS_BIG + BG_QKV); const bf16_t* SP = (const bf16_t*)(p.ws + WS_BIG + BG_SPREV);
    bf16_t* MIX = (bf16_t*)(p.ws + WS_BIG + BG_MIX);
    const float* rld = p.inp(10);
    LAS bf16_t* RA = (LAS bf16_t*)C.lds; LAS bf16_t* RB = RA + 128 * RLD;
    int tid = C.tid; asm volatile("" : "+v"(tid));
    const int lane = tid & 63, w = C.wave, kq = lane >> 4, fr = lane & 15;
    const int u = unit >> 2, h = unit & 3;
    const float lgf = rld[h], lgb = rld[4 + h];
    stage_chunk<false>(QKV, 128 * u, 256 * h, RA, tid, 0.f, 0);
    int ib = 16 * w + 4 * kq, jb = fr; asm volatile("" : "+v"(ib), "+v"(jb));
    f32x4 acc[16];
#pragma unroll
    for (int t = 0; t < 16; ++t) acc[t] = (f32x4){0.f, 0.f, 0.f, 0.f};
#pragma unroll
    for (int dir = 0; dir < 2; ++dir) {
        const bf16_t* Sd = SP + ((size_t)((dir * 4 + h) * 130 + u)) * 65536;
#pragma unroll
        for (int eh = 0; eh < 2; ++eh) {
            __syncthreads();
#pragma unroll
            for (int q = 0; q < 8; ++q) { const int idx = tid + NTHR * q, rr = idx >> 5, c = idx & 31;
                *(LAS u32x4*)(RB + rr * RLD + 8 * c) = *(const u32x4*)(Sd + (size_t)(128 * eh + rr) * 256 + 8 * c);
                if (q == 3) asm volatile("" ::: "memory"); }
            __syncthreads();
#pragma unroll 1
            for (int ks = 0; ks < 8; ++ks) { const bf16x8 af = frag_rowk_l(RA + (16 * w) * RLD + 32 * ks, RLD, lane);
#pragma unroll
                for (int t = 0; t < 8; ++t) { const bf16x8 bf = frag_rowk_l(RB + (16 * t) * RLD + 32 * ks, RLD, lane); acc[8 * eh + t] = MFMA16(af, bf, acc[8 * eh + t]); } }
        }
#pragma unroll
        for (int r = 0; r < 4; ++r) { const int i = ib + r; const float qd = fast_exp((float)(128 - i) * lgb);
            const float f = (dir == 0) ? fast_exp((float)(i + 1) * lgf) / qd : qd;
#pragma unroll
            for (int t = 0; t < 16; ++t) acc[t][r] *= f; }
    }
    __syncthreads();
    stage_chunk<false>(QKV, 128 * u, 1024 + 256 * h, RB, tid, 0.f, 0);
    __syncthreads();
    f32x4 sc[8];
#pragma unroll
    for (int t = 0; t < 8; ++t) sc[t] = (f32x4){0.f, 0.f, 0.f, 0.f};
#pragma unroll 1
    for (int ks = 0; ks < 8; ++ks) { const bf16x8 af = frag_rowk_l(RA + (16 * w) * RLD + 32 * ks, RLD, lane);
#pragma unroll
        for (int t = 0; t < 8; ++t) { const bf16x8 bf = frag_rowk_l(RB + (16 * t) * RLD + 32 * ks, RLD, lane); sc[t] = MFMA16(af, bf, sc[t]); } }
#pragma unroll
    for (int t = 0; t < 8; ++t)
#pragma unroll
        for (int r = 0; r < 4; ++r) { const int i = ib + r, j = 16 * t + jb; const float d = (float)(i - j);
            const float m = (i >= j ? fast_exp(d * lgf) : 0.f) + (j >= i ? fast_exp(-d * lgb) : 0.f); sc[t][r] *= m; }
    __syncthreads();
    stage_chunk<false>(QKV, 128 * u, 2048 + 256 * h, RA, tid, 0.f, 0);
#pragma unroll
    for (int t = 0; t < 8; ++t)
#pragma unroll
        for (int r = 0; r < 4; ++r) RB[(16 * w + 4 * kq + r) * SLD + 16 * t + fr] = f2bf(sc[t][r]);
    __syncthreads();
    const unsigned vbase = (unsigned)(uintptr_t)RA;
#pragma unroll 1
    for (int ks = 0; ks < 4; ++ks) { const bf16x8 af = frag_rowk_l(RB + (16 * w) * SLD + 32 * ks, SLD, lane);
#pragma unroll
        for (int t = 0; t < 16; ++t) { const bf16x8 bf = frag_colk_l(vbase + (unsigned)((32 * ks) * RLD + 16 * t) * 2u, RLD * 2, lane); acc[t] = MFMA16(af, bf, acc[t]); } }
    __syncthreads();
#pragma unroll
    for (int r = 0; r < 4; ++r) {
        float s = 0.f;
#pragma unroll
        for (int t = 0; t < 16; ++t) s += acc[t][r];
        s += __shfl_xor(s, 1); s += __shfl_xor(s, 2); s += __shfl_xor(s, 4); s += __shfl_xor(s, 8);
        const float mean = s * (1.0f / 256.0f); float q = 0.f;
#pragma unroll
        for (int t = 0; t < 16; ++t) { const float d = acc[t][r] - mean; q += d * d; }
        q += __shfl_xor(q, 1); q += __shfl_xor(q, 2); q += __shfl_xor(q, 4); q += __shfl_xor(q, 8);
        const float rstd = rsqrtf(q * (1.0f / 256.0f) + LN_EPS);
#pragma unroll
        for (int t = 0; t < 16; ++t) RA[(16 * w + 4 * kq + r) * RLD + 16 * t + fr] = f2bf((acc[t][r] - mean) * rstd);
    }
    __syncthreads();
#pragma unroll
    for (int q = 0; q < 8; ++q) { const int idx = tid + NTHR * q, rr = idx >> 5, c = idx & 31; const size_t row = (size_t)(128 * u + rr);
        const u32x4 o = *(const LAS u32x4*)(RA + rr * RLD + 8 * c), g = *(const u32x4*)(QKV + row * EV_IN + 3072 + 256 * h + 8 * c);
        u32x4 w4;
        w4.x = cvt_pk_bf16(bflo(o.x) * siluf_(bflo(g.x)), bfhi(o.x) * siluf_(bfhi(g.x))); w4.y = cvt_pk_bf16(bflo(o.y) * siluf_(bflo(g.y)), bfhi(o.y) * siluf_(bfhi(g.y)));
        w4.z = cvt_pk_bf16(bflo(o.z) * siluf_(bflo(g.z)), bfhi(o.z) * siluf_(bfhi(g.z))); w4.w = cvt_pk_bf16(bflo(o.w) * siluf_(bflo(g.w)), bfhi(o.w) * siluf_(bfhi(g.w)));
        *(u32x4*)(MIX + row * DM + 256 * h + 8 * c) = w4; }
    __syncthreads();
}

constexpr int KLD = 1032;
__device__ __forceinline__ void s5_output_task(const Params& p, Ctx& C, int bt) {
    const bf16_t* QKV = (const bf16_t*)(p.ws + WS_BIG + BG_QKV); bf16_t* Z = (bf16_t*)(p.ws + WS_Z);
    const bf16_t* KN = (const bf16_t*)(p.ws + WS_KN); const bf16_t* CCt = (const bf16_t*)(p.ws + WS_CC);
    const float* APOW = (const float*)(p.ws + WS_APOW); const float* HST = (const float*)(p.ws + WS_HST); const float* dsk = p.inp(18);
    int tid = C.tid; asm volatile("" : "+v"(tid));
    const int lane = tid & 63, kq = lane >> 4, fr = lane & 15;
    LAS bf16_t* KF = (LAS bf16_t*)C.lds; LAS bf16_t* KB = KF + 16 * KLD;
    LAS bf16_t* U = KB + 16 * KLD + C.wave * 3072;
    LAS float* PW0 = (LAS float*)(KB + 16 * KLD + 8 * 3072);
    LAS float* PW16 = PW0 + 2 * 16 * 128;
    {
        const int g = bt >> 3, k0 = (260 * (bt & 7)) >> 3, k1 = (260 * ((bt & 7) + 1)) >> 3;
#pragma unroll
        for (int q = 0; q < 8; ++q) { const int idx = tid + NTHR * q, dir = idx >> 11, rr = (idx >> 7) & 15, c = idx & 127;
            *(LAS u32x4*)((dir ? KB : KF) + rr * KLD + 8 * c) = *(const u32x4*)(KN + ((size_t)(dir * 64 + g) * 16 + rr) * 1024 + 8 * c); }
        for (int q = lane; q < 192 * 2; q += 64) *(LAS u32x4*)(U + 8 * q) = (u32x4){0u, 0u, 0u, 0u};
#pragma unroll
        for (int q = 0; q < 2; ++q) { const int idx = tid + NTHR * q, dir = idx >> 9, f = (idx >> 5) & 15, c4 = idx & 31;
            *(LAS f32x4*)(PW0 + dir * 2048 + f * 128 + 4 * c4) = *(const f32x4*)(APOW + ((size_t)(dir * 64 + g) * 64 + (dir == 0 ? f : 15 - f)) * 128 + 4 * c4); }
        if (tid < 64) { const int dir = tid >> 5, c4 = tid & 31; *(LAS f32x4*)(PW16 + dir * 128 + 4 * c4) = *(const f32x4*)(APOW + ((size_t)(dir * 64 + g) * 64 + 15) * 128 + 4 * c4); }
        __syncthreads();
        const f32x4 dv = *(const f32x4*)(dsk + 16 * g + 4 * kq);
        bf16x8 ccr[2], cci[2];
#pragma unroll
        for (int hb = 0; hb < 2; ++hb) { ccr[hb] = frag_rowk_g(CCt + (size_t)g * 16 * 128 + 32 * hb, 128, lane); cci[hb] = frag_rowk_g(CCt + (size_t)g * 16 * 128 + 64 + 32 * hb, 128, lane); }
        const LAS float* pw0l = PW0 + (size_t)fr * 128 + 16 * kq;
        const LAS float* pw16l = PW16 + 16 * kq;
        for (int k = k0 + C.wave; k < k1; k += 8) {
            LDS_WAIT(); asm volatile("" ::: "memory");
            for (int q = lane; q < 128; q += 64) { const int t = q >> 1, hf = q & 1;
                *(LAS u32x4*)(U + (64 + t) * 16 + 8 * hf) = *(const u32x4*)(QKV + (size_t)(64 * k + t) * EV_IN + 4096 + 16 * g + 8 * hf); }
            LDS_WAIT(); asm volatile("" ::: "memory");
            const int cf = k, cb = k < 4 ? 3 - k : 263 - k;
            f32x4 acc[4];
#pragma unroll
            for (int tt = 0; tt < 4; ++tt) acc[tt] = (f32x4){0.f, 0.f, 0.f, 0.f};
            const LAS bf16_t* ubf = U + (64 + fr - (kq >> 1)) * 16 + 8 * (kq & 1);
            const LAS bf16_t* ubb = U + (64 + fr + (kq >> 1)) * 16 + 8 * (kq & 1);
#pragma unroll
            for (int n0 = 0; n0 < 64; n0 += 2) {
                const bf16x8 af = frag_rowk_l(KF + n0 * 16, KLD, lane), ab = frag_rowk_l(KB + n0 * 16, KLD, lane);
#pragma unroll
                for (int tt = 0; tt < 4; ++tt) {
                    if (n0 <= 16 * tt + 14) acc[tt] = MFMA16(af, *(const LAS bf16x8*)(ubf + (16 * tt - n0) * 16), acc[tt]);
                    if (n0 <= 62 - 16 * tt) acc[tt] = MFMA16(ab, *(const LAS bf16x8*)(ubb + (16 * tt + n0) * 16), acc[tt]);
                }
                asm volatile("" ::: "memory");
            }
#pragma unroll
            for (int dir = 0; dir < 2; ++dir) {
                const float* hp = HST + ((size_t)(dir * 64 + g) * 260 + (dir == 0 ? cf : cb)) * 128;
#pragma unroll
                for (int hb = 0; hb < 2; ++hb) {
                    float xr[8], xi[8];
#pragma unroll
                    for (int e2 = 0; e2 < 4; ++e2) { const f32x4 h4 = *(const f32x4*)(hp + 2 * (32 * hb + 8 * kq) + 4 * e2), b4 = *(const LAS f32x4*)(pw0l + dir * 2048 + hb * 64 + 4 * e2);
                        xr[2 * e2] = b4[0] * h4[0] - b4[1] * h4[1]; xi[2 * e2] = b4[0] * h4[1] + b4[1] * h4[0];
                        xr[2 * e2 + 1] = b4[2] * h4[2] - b4[3] * h4[3]; xi[2 * e2 + 1] = b4[2] * h4[3] + b4[3] * h4[2]; }
#pragma unroll
                    for (int st = 0; st < 4; ++st) {
                        const int tt = dir == 0 ? st : 3 - st;
                        u32x4 br, bi;
                        br.x = cvt_pk_bf16(xr[0], xr[1]); br.y = cvt_pk_bf16(xr[2], xr[3]); br.z = cvt_pk_bf16(xr[4], xr[5]); br.w = cvt_pk_bf16(xr[6], xr[7]);
                        bi.x = cvt_pk_bf16(xi[0], xi[1]); bi.y = cvt_pk_bf16(xi[2], xi[3]); bi.z = cvt_pk_bf16(xi[4], xi[5]); bi.w = cvt_pk_bf16(xi[6], xi[7]);
                        acc[tt] = MFMA16(ccr[hb], __builtin_bit_cast(bf16x8, br), acc[tt]);
                        acc[tt] = MFMA16(cci[hb], __builtin_bit_cast(bf16x8, bi), acc[tt]);
                        if (st < 3) {
#pragma unroll
                            for (int e2 = 0; e2 < 4; ++e2) { const f32x4 a4 = *(const LAS f32x4*)(pw16l + dir * 128 + hb * 64 + 4 * e2);
                                float t0 = xr[2 * e2] * a4[0] - xi[2 * e2] * a4[1]; xi[2 * e2] = xr[2 * e2] * a4[1] + xi[2 * e2] * a4[0]; xr[2 * e2] = t0;
                                t0 = xr[2 * e2 + 1] * a4[2] - xi[2 * e2 + 1] * a4[3]; xi[2 * e2 + 1] = xr[2 * e2 + 1] * a4[3] + xi[2 * e2 + 1] * a4[2]; xr[2 * e2 + 1] = t0; }
                        }
                    }
                }
            }
#pragma unroll
            for (int tt = 0; tt < 4; ++tt) { const int t = 16 * tt + fr;
                const u32x2 uu = *(const LAS u32x2*)(U + (64 + t) * 16 + 4 * kq);
                const float y0 = acc[tt][0] + bflo(uu.x) * dv[0], y1 = acc[tt][1] + bfhi(uu.x) * dv[1], y2 = acc[tt][2] + bflo(uu.y) * dv[2], y3 = acc[tt][3] + bfhi(uu.y) * dv[3];
                u32x2 w; w.x = cvt_pk_bf16(gelu_tanh(y0), gelu_tanh(y1)); w.y = cvt_pk_bf16(gelu_tanh(y2), gelu_tanh(y3));
                *(u32x2*)(Z + (size_t)(64 * k + t) * 1024 + 16 * g + 4 * kq) = w; }
        }
    }
    __syncthreads();
}

__device__ __forceinline__ void phase_ret_s5_outputs(const Params& p, Ctx& C, LAS unsigned char* misc) {
    unsigned* head = (unsigned*)(p.ws + WS_CTL) + CW_QUEUE;
    volatile LAS int* slot = (volatile LAS int*)(misc + 32);
    for (;;) {
        __syncthreads();
        if (C.tid == 0) slot[0] = (int)atomicAdd(head, 1u);
        __syncthreads();
        const int item = __builtin_amdgcn_readfirstlane(slot[0]);
        if (item >= 520) break;
        ret_output_unit(p, C, item);
    }
    for (;;) {
        __syncthreads();
        if (C.tid == 0) slot[0] = (int)atomicAdd(head + 64, 1u);
        __syncthreads();
        const int item = __builtin_amdgcn_readfirstlane(slot[0]);
        if (item >= 512) break;
        s5_output_task(p, C, item);
    }
}
__device__ __forceinline__ void phase_router(const Params& p, Ctx& C, int L) {
    const float* X1 = (const float*)(p.ws + WS_X1);
    const bf16_t* RWh = (const bf16_t*)(p.ws + WS_RWT) + (size_t)(L * 2 + 0) * 64 * DM; const bf16_t* RWl = (const bf16_t*)(p.ws + WS_RWT) + (size_t)(L * 2 + 1) * 64 * DM;
    const float* rbias = p.inp(27) + L * 64;
    int* cnt = (int*)(p.ws + WS_CTL) + CW_CNT + L * 128; int* LIST = (int*)(p.ws + WS_LIST); float* WGT = (float*)(p.ws + WS_WGT); float* LW = (float*)(p.ws + WS_LW);
    const int lane = C.lane, kq = lane >> 4, fr = lane & 15;
    LAS float* Lg = (LAS float*)(C.lds + C.wave * 8192);
    const int r0 = (L == 0) ? 0 : CTXL, nrows = TT - r0;
    if (C.bid == 0 && C.tid == 0) cnt[64] = nrows;
    for (int task = C.gw; task < nrows / 16; task += C.ngw) {
        const int rbase = r0 + 16 * task, row = rbase + fr;
        const int v = row < CTXL ? 1 : 0;
        const float* xr = X1 + (size_t)row * DM; const float* sc2 = modv(p, L, v, 4); const float* sh2 = modv(p, L, v, 3);
        f32x4 acc[4];
#pragma unroll
        for (int t = 0; t < 4; ++t) acc[t] = (f32x4){0.f, 0.f, 0.f, 0.f};
#pragma unroll 2
        for (int ks = 0; ks < 64; ++ks) { const int c0 = 32 * ks + 8 * kq;
            const f32x4 x0 = *(const f32x4*)(xr + c0), x1 = *(const f32x4*)(xr + c0 + 4);
            const f32x4 a0 = *(const f32x4*)(sc2 + c0), a1 = *(const f32x4*)(sc2 + c0 + 4), b0 = *(const f32x4*)(sh2 + c0), b1 = *(const f32x4*)(sh2 + c0 + 4);
            const f32x4 y0 = x0 * (a0 + 1.0f) + b0, y1 = x1 * (a1 + 1.0f) + b1;
            u32x4 hi; hi.x = cvt_pk_bf16(y0[0], y0[1]); hi.y = cvt_pk_bf16(y0[2], y0[3]); hi.z = cvt_pk_bf16(y1[0], y1[1]); hi.w = cvt_pk_bf16(y1[2], y1[3]);
            u32x4 lo; lo.x = cvt_pk_bf16(y0[0] - bflo(hi.x), y0[1] - bfhi(hi.x)); lo.y = cvt_pk_bf16(y0[2] - bflo(hi.y), y0[3] - bfhi(hi.y));
            lo.z = cvt_pk_bf16(y1[0] - bflo(hi.z), y1[1] - bfhi(hi.z)); lo.w = cvt_pk_bf16(y1[2] - bflo(hi.w), y1[3] - bfhi(hi.w));
            const bf16x8 ah = __builtin_bit_cast(bf16x8, hi), al = __builtin_bit_cast(bf16x8, lo);
#pragma unroll
            for (int t = 0; t < 4; ++t) { const bf16x8 bh = frag_rowk_g(RWh + (size_t)(16 * t) * DM + 32 * ks, DM, lane), bl = frag_rowk_g(RWl + (size_t)(16 * t) * DM + 32 * ks, DM, lane);
                acc[t] = MFMA16(ah, bh, acc[t]); acc[t] = MFMA16(al, bh, acc[t]); acc[t] = MFMA16(ah, bl, acc[t]); } }
        LDS_WAIT(); asm volatile("" ::: "memory");
#pragma unroll
        for (int t = 0; t < 4; ++t)
#pragma unroll
            for (int r = 0; r < 4; ++r) Lg[(4 * kq + r) * 65 + 16 * t + fr] = acc[t][r];
        LDS_WAIT(); asm volatile("" ::: "memory");
        if (lane < 16) {
            LAS float* sr = Lg + lane * 65; const int trow = rbase + lane;
            float gs[8];
#pragma unroll
            for (int g = 0; g < 8; ++g) { float m1 = -1e30f, m2 = -1e30f;
                for (int j = 0; j < 8; ++j) { const int e = 8 * g + j; const float s = sigmoidf_(sr[e]); sr[e] = s; const float vv = s + rbias[e];
                    if (vv > m1) { m2 = m1; m1 = vv; } else if (vv > m2) m2 = vv; }
                gs[g] = m1 + m2; }
            unsigned gmask = 0u;
#pragma unroll
            for (int it = 0; it < 4; ++it) { float best = -1e30f; int bi = 0;
#pragma unroll
                for (int g = 0; g < 8; ++g) { const bool ok = !((gmask >> g) & 1u) && gs[g] > best; best = ok ? gs[g] : best; bi = ok ? g : bi; }
                gmask |= 1u << bi; }
            unsigned long long taken = 0ull; int sel[8]; float sw[8]; float wsum = 0.f;
#pragma unroll
            for (int k = 0; k < 8; ++k) { float best = -1e30f; int bi = 0;
                for (int e = 0; e < 64; ++e) { const bool cand = ((gmask >> (e >> 3)) & 1u) && !((taken >> e) & 1ull); const float vv = sr[e] + rbias[e];
                    if (cand && vv > best) { best = vv; bi = e; } }
                taken |= 1ull << bi; sel[k] = bi; sw[k] = sr[bi]; wsum += sw[k]; }
            const float inv = 2.5f / wsum;
#pragma unroll
            for (int k = 0; k < 8; ++k) { const int a = trow * 8 + k; const int pos = atomicAdd(&cnt[sel[k]], 1);
                LIST[(size_t)sel[k] * TT + pos] = a; WGT[a] = sw[k] * inv; LW[(size_t)sel[k] * TT + pos] = sw[k] * inv; }
            LIST[(size_t)64 * TT + (trow - r0)] = 8 * TT + trow; LW[(size_t)64 * TT + (trow - r0)] = 1.0f;
        }
    }
}
namespace att {
constexpr int D = 128, NW = 8, QBLK = 32, KVBLK = 64;
constexpr float SCALE = 0.088388347648318440f;
constexpr float THR = 8.f;
constexpr int SHM_V = KVBLK * D * 2, SHM_K = KVBLK * D * 2, SHM_ATTN = 2 * SHM_V + 2 * SHM_K + NW * 64 * 4;
#define KSWZ(row, colB) ((row) * 256 + ((colB) ^ (((row) & 7) << 4)))
#define SBAR() __builtin_amdgcn_sched_barrier(0)
__device__ __forceinline__ int crow(int r, int hi) { return (r & 3) + 8 * (r >> 2) + 4 * hi; }
__device__ __forceinline__ unsigned cvtpk(float lo, float hi) { unsigned r; asm volatile("v_cvt_pk_bf16_f32 %0, %1, %2" : "=v"(r) : "v"(lo), "v"(hi)); return r; }

__device__ __forceinline__ void partialSM(f32x16& p0, f32x16& p1, float& m_reg, float& mn, float& alpha) {
  constexpr float Cc = SCALE * 1.4426950408889634f;
  float pmax = p0[0]; for (int r = 1; r < 16; ++r) pmax = fmaxf(pmax, p0[r]); for (int r = 0; r < 16; ++r) pmax = fmaxf(pmax, p1[r]);
  { auto rr = __builtin_amdgcn_permlane32_swap(__float_as_uint(pmax), __float_as_uint(pmax), false, false);
    pmax = fmaxf(__uint_as_float(rr[0]), __uint_as_float(rr[1])); }
  if (__builtin_expect(__all(pmax - m_reg <= THR / SCALE), 1)) { mn = m_reg; alpha = 1.f; }
  else { mn = fmaxf(m_reg, pmax); alpha = __builtin_amdgcn_exp2f((m_reg - mn) * Cc); m_reg = mn; }
  float mnC = -mn * Cc;
  for (int r = 0; r < 16; ++r) p0[r] = fmaf(p0[r], Cc, mnC); for (int r = 0; r < 16; ++r) p1[r] = fmaf(p1[r], Cc, mnC);
  for (int r = 0; r < 16; ++r) p0[r] = __builtin_amdgcn_exp2f(p0[r]);
}
__device__ __forceinline__ void finishSM(f32x16& p0, f32x16& p1, float alpha, float& l_reg, bf16x8& pa0, bf16x8& pa1, bf16x8& pa2, bf16x8& pa3) {
  for (int r = 0; r < 16; ++r) p1[r] = __builtin_amdgcn_exp2f(p1[r]);
  float ps = 0; for (int r = 0; r < 16; ++r) ps += p0[r]; for (int r = 0; r < 16; ++r) ps += p1[r];
  { auto rr = __builtin_amdgcn_permlane32_swap(__float_as_uint(ps), __float_as_uint(ps), false, false);
    ps = __uint_as_float(rr[0]) + __uint_as_float(rr[1]); }
  l_reg = l_reg * alpha + ps;
#define PK4(P, BASE, OUT) do { unsigned a0 = cvtpk(P[BASE + 0], P[BASE + 1]), a1 = cvtpk(P[BASE + 2], P[BASE + 3]);   \
    unsigned b0 = cvtpk(P[BASE + 4], P[BASE + 5]), b1 = cvtpk(P[BASE + 6], P[BASE + 7]);                              \
    auto r0 = __builtin_amdgcn_permlane32_swap(a0, b0, false, false); auto r1 = __builtin_amdgcn_permlane32_swap(a1, b1, false, false); \
    u32x4 w = {r0[0], r1[0], r0[1], r1[1]}; OUT = *reinterpret_cast<bf16x8*>(&w); } while (0)
  PK4(p0, 0, pa0); PK4(p0, 8, pa1); PK4(p1, 0, pa2); PK4(p1, 8, pa3);
#undef PK4
}
__device__ __forceinline__ void qkt(f32x16& p0, f32x16& p1, const LAS char* Ks, const bf16x8* qr, int r32, int hi) {
  p0 = f32x16{}; p1 = f32x16{};
  for (int d0 = 0; d0 < 8; ++d0) { int cb = (d0 * 16 + hi * 8) * 2;
    bf16x8 b0 = *reinterpret_cast<const LAS bf16x8*>(Ks + KSWZ(r32, cb));
    bf16x8 b1 = *reinterpret_cast<const LAS bf16x8*>(Ks + KSWZ(32 + r32, cb));
    p0 = __builtin_amdgcn_mfma_f32_32x32x16_bf16(b0, qr[d0], p0, 0, 0, 0);
    p1 = __builtin_amdgcn_mfma_f32_32x32x16_bf16(b1, qr[d0], p1, 0, 0, 0); }
}
__device__ __forceinline__ int v_st(int k, int c) { const int kk = (k & ~0xC) | ((k & 4) << 1) | ((k & 8) >> 1); return ((kk >> 3) * 4 + (c >> 5)) * 512 + ((kk & 7) * 32 + (c & 31)) * 2; }
__device__ __forceinline__ int v_rd_base(int lane) { return ((lane & 3) << 3) | (((lane >> 2) & 3) << 6) | (((lane >> 4) & 1) << 5) | (((lane >> 5) & 1) << 8); }
constexpr int v_rd_off(int d0, int ks, int half) { return d0 * 512 + ks * 4096 + half * 2048; }
template <int OFF> __device__ __forceinline__ s16x4 tr_read(int vb) {
  s16x4 r; asm volatile("ds_read_b64_tr_b16 %0, %1 offset:%2" : "=&v"(r) : "v"(vb), "i"(OFF) : "memory"); return r;
}
template <int D0> __device__ __forceinline__ void pv_one(f32x16& od, int vb, bf16x8 pa0, bf16x8 pa1, bf16x8 pa2, bf16x8 pa3) {
  const s16x4 l0 = tr_read<v_rd_off(D0, 0, 0)>(vb), h0 = tr_read<v_rd_off(D0, 0, 1)>(vb), l1 = tr_read<v_rd_off(D0, 1, 0)>(vb), h1 = tr_read<v_rd_off(D0, 1, 1)>(vb);
  const s16x4 l2 = tr_read<v_rd_off(D0, 2, 0)>(vb), h2 = tr_read<v_rd_off(D0, 2, 1)>(vb), l3 = tr_read<v_rd_off(D0, 3, 0)>(vb), h3 = tr_read<v_rd_off(D0, 3, 1)>(vb);
  asm volatile("s_waitcnt lgkmcnt(0)" ::: "memory"); SBAR();
#define PK(L, H) (bf16x8){L[0], L[1], L[2], L[3], H[0], H[1], H[2], H[3]}
  od = __builtin_amdgcn_mfma_f32_32x32x16_bf16(pa0, PK(l0, h0), od, 0, 0, 0);
  od = __builtin_amdgcn_mfma_f32_32x32x16_bf16(pa1, PK(l1, h1), od, 0, 0, 0);
  od = __builtin_amdgcn_mfma_f32_32x32x16_bf16(pa2, PK(l2, h2), od, 0, 0, 0);
  od = __builtin_amdgcn_mfma_f32_32x32x16_bf16(pa3, PK(l3, h3), od, 0, 0, 0);
#undef PK
}
__device__ __forceinline__ void pv_d0(f32x16* o, int vb, bf16x8 pa0, bf16x8 pa1, bf16x8 pa2, bf16x8 pa3) {
  pv_one<0>(o[0], vb, pa0, pa1, pa2, pa3); pv_one<1>(o[1], vb, pa0, pa1, pa2, pa3); pv_one<2>(o[2], vb, pa0, pa1, pa2, pa3); pv_one<3>(o[3], vb, pa0, pa1, pa2, pa3);
}

template <int LDQ, int LDK, int LDO>
__device__ __forceinline__ void attn_dense_body(const bf16_t* __restrict__ Qb, const bf16_t* __restrict__ Kh, const bf16_t* __restrict__ Vh, bf16_t* __restrict__ Ob, int seq, LAS char* lds, int tid) {
  const int wid = tid >> 6, lane = tid & 63, r32 = lane & 31, hi = lane >> 5;
  LAS char* V_lds = lds; LAS char* K_lds = lds + 2 * SHM_V;
  LAS float* ws = (LAS float*)(lds + 2 * SHM_V + 2 * SHM_K) + wid * 64; LAS float* li_l = ws; LAS float* al_l = ws + 32;
  float m_reg = -1e30f, l_reg = 0; f32x16 o[4] = {}; bf16x8 qr[8];
  const bf16_t* Qw = Qb + (long)(wid * QBLK + r32) * LDQ + hi * 8;
#pragma unroll
  for (int d0 = 0; d0 < 8; ++d0) qr[d0] = *reinterpret_cast<const bf16x8*>(Qw + d0 * 16);
  const int sr = tid >> 4, sc = (tid & 15) * 8, vst0 = v_st(sr, sc), vst1 = v_st(32 + sr, sc);
  const int vb0 = (int)(uintptr_t)V_lds + v_rd_base(lane);
  struct { bf16x8 vs0, vs1, ks0, ks1; } sr_[2];
#define SLOAD(i, k0) do { sr_[i].vs0 = *reinterpret_cast<const bf16x8*>(&Vh[(long)((k0) + sr) * LDK + sc]); sr_[i].vs1 = *reinterpret_cast<const bf16x8*>(&Vh[(long)((k0) + 32 + sr) * LDK + sc]); \
    sr_[i].ks0 = *reinterpret_cast<const bf16x8*>(&Kh[(long)((k0) + sr) * LDK + sc]); sr_[i].ks1 = *reinterpret_cast<const bf16x8*>(&Kh[(long)((k0) + 32 + sr) * LDK + sc]); } while (0)
#define SWRITE(b, i) do { *(LAS bf16x8*)(V_lds + (b) * SHM_V + vst0) = sr_[i].vs0;          \
    *(LAS bf16x8*)(V_lds + (b) * SHM_V + vst1) = sr_[i].vs1; int kc = sc * 2;               \
    *(LAS bf16x8*)(K_lds + (b) * SHM_K + KSWZ(sr, kc)) = sr_[i].ks0;                       \
    *(LAS bf16x8*)(K_lds + (b) * SHM_K + KSWZ(32 + sr, kc)) = sr_[i].ks1; } while (0)
#define SWAIT() asm volatile("s_waitcnt vmcnt(4)" ::: "memory")
#define RESC(a) do { if (__any((a) < 1.f)) { if (hi == 0) al_l[r32] = (a); asm volatile("s_waitcnt lgkmcnt(0)" ::: "memory"); \
    for (int d = 0; d < 4; ++d) for (int r = 0; r < 16; ++r) o[d][r] *= al_l[crow(r, hi)]; } } while (0)
  f32x16 pA0, pA1, pB0, pB1; float mnA, mnB, alA, alB; bf16x8 pa0, pa1, pa2, pa3; const int NT = seq / KVBLK;
  constexpr int SE = 0, SO = 1;
  SLOAD(SE, 0); asm volatile("s_waitcnt vmcnt(0)" ::: "memory"); SWRITE(0, SE); __syncthreads();
  qkt(pA0, pA1, K_lds, qr, r32, hi); partialSM(pA0, pA1, m_reg, mnA, alA);
  SLOAD(SO, KVBLK); if (2 < NT) SLOAD(SE, 2 * KVBLK);
  SWAIT(); SWRITE(1, SO); __syncthreads();
  for (int j = 1; j + 1 < NT; j += 2) {
    SBAR(); qkt(pB0, pB1, K_lds + SHM_K, qr, r32, hi);
    finishSM(pA0, pA1, alA, l_reg, pa0, pa1, pa2, pa3); SBAR();
    SLOAD(SO, (j + 2) * KVBLK); SBAR();
    pv_d0(o, vb0, pa0, pa1, pa2, pa3); partialSM(pB0, pB1, m_reg, mnB, alB);
    __syncthreads(); SWAIT(); SWRITE(0, SE);
    RESC(alB); __syncthreads();
    SBAR(); qkt(pA0, pA1, K_lds, qr, r32, hi);
    finishSM(pB0, pB1, alB, l_reg, pa0, pa1, pa2, pa3); SBAR();
    if (j + 3 < NT) SLOAD(SE, (j + 3) * KVBLK); SBAR();
    pv_d0(o, vb0 + (int)SHM_V, pa0, pa1, pa2, pa3); partialSM(pA0, pA1, m_reg, mnA, alA);
    __syncthreads(); SWAIT(); SWRITE(1, SO);
    RESC(alA); __syncthreads();
  }
  SBAR(); qkt(pB0, pB1, K_lds + SHM_K, qr, r32, hi);
  finishSM(pA0, pA1, alA, l_reg, pa0, pa1, pa2, pa3); SBAR();
  pv_d0(o, vb0, pa0, pa1, pa2, pa3); partialSM(pB0, pB1, m_reg, mnB, alB);
  __syncthreads(); RESC(alB);
  finishSM(pB0, pB1, alB, l_reg, pa0, pa1, pa2, pa3); SBAR();
  pv_d0(o, vb0 + (int)SHM_V, pa0, pa1, pa2, pa3);
  if (hi == 0) li_l[r32] = l_reg; asm volatile("s_waitcnt lgkmcnt(0)" ::: "memory");
  float rli[16];
#pragma unroll
  for (int r = 0; r < 16; ++r) rli[r] = __builtin_amdgcn_rcpf(li_l[crow(r, hi)]);
  bf16_t* Ow = Ob + (long)(wid * QBLK) * LDO;
#pragma unroll
  for (int r = 0; r < 16; ++r) { int orow = crow(r, hi);
    for (int d0 = 0; d0 < 4; ++d0) Ow[(long)orow * LDO + d0 * 32 + r32] = (bf16_t)(cvtpk(o[d0][r] * rli[r], 0.f) & 0xffffu); }
#undef SLOAD
#undef SWRITE
#undef SWAIT
#undef RESC
}
#undef KSWZ
}

__device__ __forceinline__ void phase_attention(const Params& p, Ctx& C) {
    const bf16_t* QKV = (const bf16_t*)(p.ws + WS_BIG + BG_QKV); bf16_t* ATT = (bf16_t*)(p.ws + WS_BIG + BG_ATT);
    const int nunits = 24 * 64;
    for (int i = 0;; ++i) {
        int unit;
        if (C.G == 256) { const int xcd = C.bid & 7, slot = C.bid >> 3; if (i >= 6) break; unit = (xcd * 3 + (i >> 1)) * 64 + (i & 1) * 32 + slot; }
        else { unit = i * C.G + C.bid; if (unit >= nunits) break; }
        const int prob = unit >> 6, qb = unit & 63;
        int qc, kc, vc, oc;
        if (prob < 8) { qc = 128 * prob; kc = 1024 + 128 * (prob >> 2); vc = 1280 + 128 * (prob >> 2); oc = 128 * prob; }
        else { const int d = prob - 8, h = d >> 2, m = (d >> 1) & 1, vh = d & 1; qc = 1536 + 256 * h + 128 * m; kc = 2560 + 256 * h + 128 * m; vc = 3584 + 256 * h + 128 * vh; oc = 1024 + 1024 * m + 256 * h + 128 * vh; }
        __syncthreads();
        att::attn_dense_body<OD_IN, OD_IN, 3072>(QKV + (size_t)(CTXL + 256 * qb) * OD_IN + qc, QKV + kc, QKV + vc, ATT + (size_t)(256 * qb) * 3072 + oc, TT, (LAS char*)C.lds, C.tid);
    }
    __syncthreads();
}
constexpr int PH_PER_LAYER = 13, N_PHASES = 2 + 2 * PH_PER_LAYER;
#ifndef DBL_PHASE
#define DBL_PHASE -1
#endif
#ifndef MK_PER_PHASE
#define MK_PER_PHASE 0
#endif

template <int L>
__device__ __forceinline__ void layer_body(const Params& p, Ctx& C0, const XcdBarrier& bar, LAS unsigned char* misc, int lo, int hi) {
#define IN(k) (lo <= (k) && (k) < hi)
#define SEAM(k) do { if (IN(k) && IN((k) + 1)) xcd_barrier(bar, C0.wave); } while (0)
#define PHASE(k, ...) if (IN(k)) { FRESH(); __VA_ARGS__ } if (DBL_PHASE == (k)) { xcd_barrier(bar, C0.wave); { FRESH(); __VA_ARGS__ } } SEAM(k);
#define FRESH() Ctx C = C0; { int ln = (int)__builtin_amdgcn_mbcnt_hi(~0u, __builtin_amdgcn_mbcnt_lo(~0u, 0u)); asm volatile("" : "+v"(ln)); C.lane = ln; C.tid = C.wave * 64 + ln; }
        const int b = 2 + PH_PER_LAYER * L;
        bf16_t* QKV = (bf16_t*)(p.ws + WS_BIG + BG_QKV);
        bf16_t* XA = (bf16_t*)(p.ws + WS_XA);
        int* cnt = (int*)(p.ws + WS_CTL) + CW_CNT + L * 128; const int* LIST = (const int*)(p.ws + WS_LIST);
        PHASE(b + 0, phase_modulate(p, C, L); )
        PHASE(b + 1,
            const int N = L ? OD_IN : EV_IN;
            pg8::DenseOrder S; S.init(XA, DM, (const bf16_t*)(p.ws + (L ? WS_WIN1 : WS_WIN0)), TT, N, DM, C.G, C.bid);
            pg8::EpiStore E{QKV, N};
            pg8::gemm_phase<false>(C.lds, S, E, C.wave);
        )
        PHASE(b + 2, if (L == 0) phase_rope0(p, C); else phase_normrope1(p, C); )
        PHASE(b + 3, if (L == 0) { ret_chunk_kv(p, C); s5_end_states(p, C); } else phase_attention(p, C); )
        PHASE(b + 4, if (L == 0) phase_scans(p, C); else phase_merge1(p, C); )
        if (L == 0) {
            PHASE(b + 5, phase_ret_s5_outputs(p, C, misc); )
            PHASE(b + 6,
                pg8::DenseOrder S; S.init((const bf16_t*)(p.ws + WS_Z), 1024, (const bf16_t*)(p.ws + WS_WGLU), TT, 1024, 1024, C.G, C.bid);
                pg8::EpiGlu E{(const bf16_t*)(p.ws + WS_Z), p.inp(20), (bf16_t*)(p.ws + WS_BIG + BG_MIX)};
                pg8::gemm_phase<false>(C.lds, S, E, C.wave);
            )
        }
        PHASE(b + 7,
            pg8::DenseOrder S;
            if (L == 0) S.init((const bf16_t*)(p.ws + WS_BIG + BG_MIX), DM, (const bf16_t*)(p.ws + WS_WOUT0), TT, DM, DM, C.G, C.bid);
            else S.init((const bf16_t*)(p.ws + WS_BIG + BG_ATT), 3072, (const bf16_t*)(p.ws + WS_WOUT1), SEQ, DM, DM, C.G, C.bid);
            pg8::EpiStore E{(bf16_t*)(p.ws + WS_YMIX) + (L ? (size_t)CTXL * DM : 0), DM};
            pg8::gemm_phase<false>(C.lds, S, E, C.wave);
        )
        PHASE(b + 8, phase_ln1(p, C, L); )
        PHASE(b + 9, phase_router(p, C, L); )
        PHASE(b + 10,
            pg8::MoeOrder<0> S; S.A = (const void*)XA; S.Bt = (const void*)(p.ws + WS_GU); S.list = LIST; S.cnt = cnt; S.ldab = DM; S.kb = DM; S.nN = 4; S.G = C.G; S.c = C.bid; S.bstride = (size_t)1024 * DM;
            S.prep(misc, C.tid);
            pg8::EpiE1 E{(unsigned char*)(p.ws + WS_HX2), LIST, S.cn};
            pg8::gemm_phase<true>(C.lds, S, E, C.wave);
        )
        PHASE(b + 11,
            pg8::MoeOrder<1> S; S.A = (const void*)(p.ws + WS_HX2); S.Bt = (const void*)(p.ws + WS_DT); S.list = LIST; S.cnt = cnt; S.ldab = EHID; S.kb = EHID; S.nN = 8; S.G = C.G; S.c = C.bid; S.bstride = (size_t)DM * EHID;
            S.prep(misc, C.tid);
            pg8::EpiE2 E{(unsigned char*)(p.ws + WS_BIG + BG_YMOE), LIST, (const float*)(p.ws + WS_LW), S.cn};
            pg8::gemm_phase<true>(C.lds, S, E, C.wave);
        )
        PHASE(b + 12, phase_combine(p, C, L); )
    #undef IN
#undef SEAM
#undef FRESH
#undef PHASE
}

__global__ void __launch_bounds__(NTHR, 2) mega_fwd(KArgs ka) {
    extern __shared__ __attribute__((aligned(16))) unsigned char lds_raw[];
    Ctx C;
    C.lds = (LAS unsigned char*)lds_raw;
    C.tid = threadIdx.x; C.lane = C.tid & 63; C.wave = __builtin_amdgcn_readfirstlane(C.tid >> 6);
    C.G = gridDim.x; C.bid = blockIdx.x; C.gw = C.bid * NWAVES + C.wave; C.ngw = C.G * NWAVES;
    LAS unsigned char* misc = C.lds + MISC_OFF;
    if (C.tid < 8) ((volatile LAS unsigned*)misc)[C.tid] = 0u;
    Params p; p.out = ka.out; p.ws = ka.ws; p.ph_lo = ka.ph_lo; p.ph_hi = ka.ph_hi; p.ptab = (LAS unsigned long long*)(misc + 1024);
    if (C.tid < 34) p.ptab[C.tid] = (unsigned long long)ka.in[C.tid];
    __syncthreads();
    const int lo = p.ph_lo, hi = p.ph_hi;
    XcdBarrier bar; bar.bar = (unsigned*)(p.ws + WS_CTL) + CW_BAR; bar.x = 0; bar.st = (volatile LAS unsigned*)misc;
    if (hi - lo > 1) bar = xcd_barrier_post((unsigned*)(p.ws + WS_CTL) + CW_BAR, (volatile LAS unsigned*)misc);
#define IN(k) (lo <= (k) && (k) < hi)
#define SEAM(k) do { if (IN(k) && IN((k) + 1)) xcd_barrier(bar, C.wave); } while (0)

    if (IN(0)) { phase_p0(p, C); } SEAM(0);
    if (IN(1)) { phase_p1(p, C); } SEAM(1);
    if (IN(0) && IN(2) && (C.G & 7) == 0) {
        volatile LAS unsigned* st = (volatile LAS unsigned*)misc;
        if (C.tid == 0) { unsigned pre = 0u; const unsigned x = st[3];
            for (unsigned j = 0; j < 16; ++j) { const unsigned cj = xb_ld(&bar.bar[XB_XCNT(j)]); pre += (j < x) ? cj : 0u; }
            st[4] = pre + st[2]; }
        __syncthreads();
        const int vcu = (int)st[4], g8 = C.G >> 3;
        C.bid = __builtin_amdgcn_readfirstlane((vcu % g8) * 8 + vcu / g8); C.gw = C.bid * NWAVES + C.wave;
    }

    layer_body<0>(p, C, bar, misc, lo, hi);
    layer_body<1>(p, C, bar, misc, lo, hi);
#undef IN
#undef SEAM
}

extern "C" void kernel_launch(void* const* d_in, const int* in_sizes, int n_in, void* d_out, int out_size, void* d_ws, size_t ws_size, hipStream_t stream) {
    static int grid = 0;
    if (grid == 0) {
        if (n_in != 34 || out_size != SEQ * DM || ws_size < WS_END) { fprintf(stderr, "kernel_launch: unexpected shapes: n_in %d out %d ws %zu (need %zu)\n", n_in, out_size, ws_size, (size_t)WS_END); grid = -1; return; }
        int dev = 0, cus = 0, per_cu = 0;
        if (hipGetDevice(&dev) != hipSuccess || hipDeviceGetAttribute(&cus, hipDeviceAttributeMultiprocessorCount, dev) != hipSuccess) { grid = -1; return; }
        if (hipFuncSetAttribute((const void*)mega_fwd, hipFuncAttributeMaxDynamicSharedMemorySize, LDS_BYTES) != hipSuccess) { fprintf(stderr, "kernel_launch: hipFuncSetAttribute failed\n"); grid = -1; return; }
        if (hipOccupancyMaxActiveBlocksPerMultiprocessor(&per_cu, (const void*)mega_fwd, NTHR, LDS_BYTES) != hipSuccess || per_cu < 1) { fprintf(stderr, "kernel_launch: occupancy query says %d blocks per CU\n", per_cu); grid = -1; return; }
        (void)hipGetLastError();
        grid = cus;
    }
    if (grid < 0) return;
    (void)hipMemsetAsync((char*)d_ws + WS_CTL, 0, CTL_BYTES, stream);
    KArgs p{};
    for (int i = 0; i < 34; ++i) p.in[i] = (const float*)d_in[i];
    p.out = (float*)d_out; p.ws = (unsigned char*)d_ws;
#if MK_PER_PHASE
    for (int ph = 0; ph < N_PHASES; ++ph) {
        if (ph == 2 + PH_PER_LAYER + 5 || ph == 2 + PH_PER_LAYER + 6) continue;
        p.ph_lo = ph; p.ph_hi = ph + 1;
        hipLaunchKernelGGL(mega_fwd, dim3(grid), dim3(NTHR), LDS_BYTES, stream, p);
    }
#else
    p.ph_lo = 0; p.ph_hi = N_PHASES;
    hipLaunchKernelGGL(mega_fwd, dim3(grid), dim3(NTHR), LDS_BYTES, stream, p);
#endif
    const hipError_t le = hipPeekAtLastError();
    if (le != hipSuccess) fprintf(stderr, "kernel_launch: launch failed: %s\n", hipGetErrorName(le));
}
```

```cpp
#define MK_PER_PHASE 0
#include <hip/hip_runtime.h>
#include <cstdio>
#include <cstdint>

#define GAS __attribute__((address_space(1)))
#define LAS __attribute__((address_space(3)))
typedef unsigned short bf16_t;
typedef short bf16x8 __attribute__((ext_vector_type(8)));
typedef short s16x4 __attribute__((ext_vector_type(4)));
typedef float f32x4 __attribute__((ext_vector_type(4)));
typedef float f32x2 __attribute__((ext_vector_type(2)));
typedef float f32x16 __attribute__((ext_vector_type(16)));
typedef unsigned u32x4 __attribute__((ext_vector_type(4)));
typedef unsigned u32x2 __attribute__((ext_vector_type(2)));

constexpr int DM = 2048, SEQ = 16384, CTXL = 256, TT = SEQ + CTXL;
constexpr int NEXP = 64, NEX1 = 65, EHID = 512, TOPK = 8;
constexpr int EV_IN = 5120, OD_IN = 4608;
constexpr float LN_EPS = 1e-6f;
constexpr float ALPHA = 1.4142135623730951f;
constexpr float LAMBDA_INIT = 0.35550906759f;
constexpr int NTHR = 512, NWAVES = 8;

constexpr size_t al256(size_t x) { return (x + 255) / 256 * 256; }
constexpr size_t WS_CTL   = 0;
constexpr size_t CTL_BYTES = 1u << 20;
constexpr size_t WS_MODP  = WS_CTL + CTL_BYTES;
constexpr size_t WS_MODF  = WS_MODP + al256((size_t)2 * 32 * 2 * 12288 * 4);
constexpr size_t WS_ROPE128 = WS_MODF + al256((size_t)2 * 2 * 12288 * 4);
constexpr size_t WS_ROPE64  = WS_ROPE128 + al256((size_t)256 * 64 * 2 * 4);
constexpr size_t WS_KN    = WS_ROPE64 + al256((size_t)256 * 32 * 2 * 4);
constexpr size_t WS_WT    = WS_KN + al256((size_t)2 * 64 * 16 * 1024 * 2);
constexpr size_t WS_APOW  = WS_WT + al256((size_t)2 * 64 * 128 * 1024 * 2);
constexpr size_t WS_AL    = WS_APOW + al256((size_t)2 * 64 * 64 * 128 * 4);
constexpr size_t WS_CC    = WS_AL + al256((size_t)2 * 64 * 128 * 4);
constexpr size_t WS_S5E   = WS_CC + al256((size_t)64 * 16 * 128 * 2);
constexpr size_t WS_HST   = WS_S5E + al256((size_t)2 * 64 * 260 * 128 * 4);
constexpr size_t WS_WIN0  = WS_HST + al256((size_t)2 * 64 * 260 * 128 * 4);
constexpr size_t WS_WOUT0 = WS_WIN0 + al256((size_t)EV_IN * DM * 2);
constexpr size_t WS_WGLU  = WS_WOUT0 + al256((size_t)DM * DM * 2);
constexpr size_t WS_WIN1  = WS_WGLU + al256((size_t)1024 * 1024 * 2);
constexpr size_t WS_WOUT1 = WS_WIN1 + al256((size_t)OD_IN * DM * 2);
constexpr size_t WS_RWT   = WS_WOUT1 + al256((size_t)DM * DM * 2);
constexpr size_t WS_GU    = WS_RWT + al256((size_t)2 * 2 * 64 * DM * 2);
constexpr size_t WS_DT    = WS_GU + al256((size_t)NEX1 * 1024 * DM * 2);
constexpr size_t WS_XA    = WS_DT + al256((size_t)NEX1 * DM * EHID * 2);
constexpr size_t WS_Z     = WS_XA + al256((size_t)TT * DM * 2);
constexpr size_t WS_YMIX  = WS_Z + al256((size_t)TT * 1024 * 2);
constexpr size_t WS_X1    = WS_YMIX + al256((size_t)TT * DM * 2);
constexpr size_t WS_HX2   = WS_X1 + al256((size_t)TT * DM * 4);
constexpr size_t WS_LIST  = WS_HX2 + al256((size_t)9 * TT * EHID * 2);
constexpr size_t WS_WGT   = WS_LIST + al256((size_t)NEX1 * TT * 4);
constexpr size_t WS_LW    = WS_WGT + al256((size_t)8 * TT * 4);
constexpr size_t WS_BIG   = WS_LW + al256((size_t)NEX1 * TT * 4);
constexpr size_t BG_QKV   = 0;
constexpr size_t BG_CKV   = BG_QKV + al256((size_t)TT * EV_IN * 2);
constexpr size_t BG_SPREV = BG_CKV + al256((size_t)8 * 130 * 65536 * 4);
constexpr size_t BG_MIX   = BG_SPREV + al256((size_t)8 * 130 * 65536 * 2);
constexpr size_t BG_END0  = BG_MIX + al256((size_t)TT * DM * 2);
constexpr size_t BG_ATT   = BG_CKV;
constexpr size_t BG_YMOE  = 0;
constexpr size_t BG_END1  = al256((size_t)9 * TT * DM * 2);
constexpr size_t BG_SIZE  = BG_END0 > BG_END1 ? BG_END0 : BG_END1;
constexpr size_t WS_END   = WS_BIG + BG_SIZE;

constexpr int CW_BAR = 4096;
constexpr int CW_CNT = 16384;
constexpr int CW_QUEUE = 20480;

constexpr int RING_BYTES = 139264;
constexpr int MISC_OFF = RING_BYTES;
constexpr int LDS_BYTES = 147456;

typedef __bf16 bf16x2_t __attribute__((ext_vector_type(2)));
__device__ __forceinline__ unsigned cvt_pk_bf16(float lo, float hi) { const f32x2 v = {lo, hi}; return __builtin_bit_cast(unsigned, __builtin_convertvector(v, bf16x2_t)); }
__device__ __forceinline__ bf16_t f2bf(float f) { unsigned u = __builtin_bit_cast(unsigned, f); return (bf16_t)((u + 0x7fffu + ((u >> 16) & 1u)) >> 16); }
__device__ __forceinline__ float bf2f(bf16_t b) { return __builtin_bit_cast(float, ((unsigned)b) << 16); }
__device__ __forceinline__ float bflo(unsigned w) { return __builtin_bit_cast(float, w << 16); }
__device__ __forceinline__ float bfhi(unsigned w) { return __builtin_bit_cast(float, w & 0xffff0000u); }
__device__ __forceinline__ float wave_sum(float v) {
#pragma unroll
    for (int o = 1; o < 64; o <<= 1) v += __shfl_xor(v, o);
    return v;
}
__device__ __forceinline__ float fast_exp(float x) { return __builtin_amdgcn_exp2f(x * 1.4426950408889634f); }
__device__ __forceinline__ float sigmoidf_(float x) { return 1.0f / (1.0f + __expf(-x)); }
__device__ __forceinline__ float siluf_(float x) { return x / (1.0f + __expf(-x)); }
__device__ __forceinline__ float gelu_tanh(float x) {
    const float u = 0.7978845608028654f * (x + 0.044715f * x * x * x);
    const float e = __expf(2.0f * u);
    const float t = 1.0f - 2.0f / (e + 1.0f);
    return 0.5f * x * (1.0f + t);
}
#define LDS_WAIT() asm volatile("s_waitcnt lgkmcnt(0)" ::: "memory")
#define VM_WAIT() asm volatile("s_waitcnt vmcnt(0)" ::: "memory")

#define XB_TMO      128
#define XB_XCNT(j)  (256  + 64 * (j))
#define XB_XSUB(j)  (1280 + 64 * (j))
#define XB_XGEN(j)  (2304 + 64 * (j))
#define XB_TOP      3328
#define XB_TOPGEN   3392
#define XCD_BAR_WORDS 3456
#define XB_SPIN_CAP (1u << 22)

__device__ __forceinline__ unsigned xb_ld(unsigned* p)              { return __hip_atomic_load(p, __ATOMIC_RELAXED, __HIP_MEMORY_SCOPE_AGENT); }
__device__ __forceinline__ unsigned xb_add(unsigned* p, unsigned v) { return __hip_atomic_fetch_add(p, v, __ATOMIC_RELAXED, __HIP_MEMORY_SCOPE_AGENT); }
__device__ __forceinline__ unsigned xb_xcc_id() { return (unsigned)__builtin_amdgcn_s_getreg((3 << 11) | 20) & 0xFu; }
#define XB_SPIN(cond, bar) do { unsigned _sp = 0; while (cond) { __builtin_amdgcn_s_sleep(1); \
    if ((++_sp & 255u) == 0u) { if (xb_ld(&(bar)[XB_TMO])) break; if (_sp > XB_SPIN_CAP) { atomicAdd(&(bar)[XB_TMO], 1u); break; } } } } while (0)

struct XcdBarrier { unsigned* bar; unsigned x; volatile LAS unsigned* st; };

__device__ __forceinline__ XcdBarrier xcd_barrier_post(unsigned* bar, volatile LAS unsigned* st) {
    XcdBarrier b; b.bar = bar; b.x = xb_xcc_id(); b.st = st;
    if (threadIdx.x == 0) { st[2] = xb_add(&bar[XB_XCNT(b.x)], 1u); st[3] = b.x; }
    return b;
}
__device__ __forceinline__ void xcd_barrier_complete(unsigned* bar, unsigned x, unsigned& nloc, unsigned& nx) {
    const unsigned G = gridDim.x * gridDim.y * gridDim.z;
    unsigned sum, cnt, mine, sp = 0u;
    for (;;) {
        sum = 0u; cnt = 0u; mine = 0u;
#pragma unroll
        for (unsigned j = 0; j < 16; ++j) { const unsigned c = xb_ld(&bar[XB_XCNT(j)]); sum += c; cnt += (c > 0u) ? 1u : 0u; mine = (j == x) ? c : mine; }
        if (sum == G) break;
        __builtin_amdgcn_s_sleep(1);
        if ((++sp & 255u) == 0u) { if (xb_ld(&bar[XB_TMO])) break; if (sp > XB_SPIN_CAP) { atomicAdd(&bar[XB_TMO], 1u); break; } }
    }
    nloc = mine > 0u ? mine : 1u; nx = cnt > 0u ? cnt : 1u;
}
__device__ __forceinline__ void xcd_barrier(const XcdBarrier& b, int wave_id) {
    const bool leader_thread = (wave_id == 0) && (__builtin_amdgcn_mbcnt_hi(~0u, __builtin_amdgcn_mbcnt_lo(~0u, 0u)) == 0u);
    asm volatile("s_waitcnt vmcnt(0)" ::: "memory");
    __syncthreads();
    if (leader_thread) {
        unsigned* bar = b.bar;
        __builtin_amdgcn_s_waitcnt(0);
        unsigned nloc = b.st[0], nx = b.st[1];
        if (nloc == 0u) { xcd_barrier_complete(bar, b.x, nloc, nx); b.st[0] = nloc; b.st[1] = nx; }
        const unsigned old = xb_add(&bar[XB_XSUB(b.x)], 1u);
        const unsigned gen = old / nloc;
        if (old + 1u == (gen + 1u) * nloc) {
            __builtin_amdgcn_fence(__ATOMIC_RELEASE, "agent");
            asm volatile("s_waitcnt vmcnt(0)" ::: "memory");
            const unsigned og = xb_add(&bar[XB_TOP], 1u);
            const unsigned tg = og / nx;
            if (og + 1u == (tg + 1u) * nx) xb_add(&bar[XB_TOPGEN], 1u);
            else XB_SPIN(xb_ld(&bar[XB_TOPGEN]) == tg, bar);
            __builtin_amdgcn_fence(__ATOMIC_ACQUIRE, "agent");
            xb_add(&bar[XB_XGEN(b.x)], 1u);
            asm volatile("s_waitcnt vmcnt(0)" ::: "memory");
        } else {
            XB_SPIN(xb_ld(&bar[XB_XGEN(b.x)]) == gen, bar);
            __builtin_amdgcn_fence(__ATOMIC_ACQUIRE, "agent");
            asm volatile("s_waitcnt vmcnt(0)" ::: "memory");
        }
    }
    __syncthreads();
}

__device__ __forceinline__ bf16x8 frag_rowk_l(const LAS bf16_t* p, int ld, int lane) {
    return *(const LAS bf16x8*)(p + (lane & 15) * ld + (lane >> 4) * 8);
}
__device__ __forceinline__ bf16x8 frag_rowk_g(const bf16_t* p, long ld, int lane) {
    return *(const bf16x8*)(p + (long)(lane & 15) * ld + (lane >> 4) * 8);
}
__device__ __forceinline__ bf16x8 frag_colk_l(unsigned p, int ldb, int lane) {
    const unsigned a0 = p + (unsigned)((8 * (lane >> 4) + ((lane & 15) >> 2)) * ldb + (lane & 3) * 8);
    const unsigned a1 = a0 + 4u * (unsigned)ldb;
    s16x4 lo, hi;
    asm volatile("ds_read_b64_tr_b16 %0, %2\n\tds_read_b64_tr_b16 %1, %3\n\ts_waitcnt lgkmcnt(0)" : "=&v"(lo), "=&v"(hi) : "v"(a0), "v"(a1) : "memory");
    return (bf16x8){lo[0], lo[1], lo[2], lo[3], hi[0], hi[1], hi[2], hi[3]};
}
#define MFMA16(a, b, c) __builtin_amdgcn_mfma_f32_16x16x32_bf16((a), (b), (c), 0, 0, 0)
namespace pg8 {
constexpr int BM = 256, BK = 64, HALF = 128, HTB = HALF * BK * 2, STAGE_BYTES = 8 * HTB, NXCD = 8, WGM = 8;
__device__ __forceinline__ int lds_byte(int r, int c) { const int st = (r >> 4) * 2 + (c >> 5), rr = r & 15, cc = c & 31, ob = rr * 64 + cc * 2; return st * 1024 + (ob ^ (((ob >> 9) & 1) << 5)); }
__device__ __forceinline__ void stage_rc(int b, int& R, int& C) { const int st = b / 1024, sb = b % 1024, swz = sb ^ (((sb >> 9) & 1) << 5); R = (st >> 1) * 16 + swz / 64; C = (st & 1) * 32 + (swz % 64) / 2; }
__device__ __forceinline__ int perm32(int rho) { const int n = rho >> 4, i = rho & 15; return 8 * (i >> 2) + 4 * n + (i & 3); }

struct Unit { int pm, pn, e; };
constexpr float WSCALE = 32.0f, WSCALE_INV = 1.0f / 32.0f;

struct DenseOrder {
    const bf16_t* A; const bf16_t* Bt; int ldab, kb, nM, nN, nwg, G, c;
    __device__ __forceinline__ void init(const bf16_t* A_, int lda_, const bf16_t* Bt_, int M, int N, int K_, int G_, int c_) { A = A_; ldab = lda_ * 2; Bt = Bt_; kb = K_ * 2; nM = M / BM; nN = N / BM; nwg = nM * nN; G = G_; c = c_; }
    __device__ __forceinline__ void init8(const void* A_, int ldab_, const void* Bt_, int M, int N, int K_, int G_, int c_) { A = (const bf16_t*)A_; ldab = ldab_; Bt = (const bf16_t*)Bt_; kb = K_; nM = M / BM; nN = N / BM; nwg = nM * nN; G = G_; c = c_; }
    __device__ __forceinline__ void prep(LAS unsigned char*) const {}
    __device__ __forceinline__ bool next(int i, Unit& u) const {
        const long L = (long)i * G + c; if (L >= nwg) return false;
        int wgid = (int)L; { const int q = nwg / NXCD, r = nwg % NXCD, xcd = wgid % NXCD, off = wgid / NXCD; wgid = (xcd < r ? xcd * (q + 1) : r * (q + 1) + (xcd - r) * q) + off; }
        const int nig = WGM * nN, gid = wgid / nig, fm = gid * WGM, gsz = (nM - fm) < WGM ? (nM - fm) : WGM;
        u.pm = fm + ((wgid % nig) % gsz); u.pn = (wgid % nig) / gsz; u.e = 0; return true;
    }
    __device__ __forceinline__ const char* a_base() const { return (const char*)A; }
    __device__ __forceinline__ unsigned a_off(const Unit& u, int r) const { return (unsigned)(u.pm * BM + r) * (unsigned)ldab; }
    __device__ __forceinline__ const char* b_ptr(const Unit& u) const { return (const char*)Bt + (size_t)u.pn * BM * kb; }
};

template <int MODE  >
struct MoeOrder {
    const void* A; const void* Bt; const int* list; const int* cnt; int ldab, kb, nN, G, c; size_t bstride;
    LAS int* tp; LAS int* cn;
    __device__ __forceinline__ void prep(LAS unsigned char* misc, int tid) {
        tp = (LAS int*)(misc + 64); cn = tp + 72;
        if (tid < NEX1) cn[tid] = cnt[tid];
        __syncthreads();
        if (tid == 0) { int s = 0; for (int e = 0; e < NEX1; ++e) { tp[e] = s; s += (cn[e] + BM - 1) / BM; } tp[NEX1] = s; }
        __syncthreads();
    }
    __device__ __forceinline__ bool next(int i, Unit& u) const {
        const int total = tp[NEX1]; const long nu = (long)total * nN; const int per = (int)((nu + G - 1) / G);
        const int vc = ((G & 7) == 0) ? (c & 7) * (G >> 3) + (c >> 3) : c;
        const long L = (long)vc * per + i;
        if (i >= per || L >= nu) return false;
        const int tile = (int)(L / nN); u.pn = (int)(L % nN);
        int e = 0;
        for (int k = 1; k < NEX1; ++k) e += (tp[k] <= tile) ? 1 : 0;
        u.e = e; u.pm = tile - tp[e]; return true;
    }
    __device__ __forceinline__ const char* a_base() const { return (const char*)A; }
    __device__ __forceinline__ unsigned a_off(const Unit& u, int r) const {
        int pos = u.pm * BM + r; const int n = cn[u.e]; pos = pos < n ? pos : n - 1;
        const int a = list[u.e * TT + pos];
        const int row = (MODE == 0) ? (a < 8 * TT ? (a >> 3) : a - 8 * TT) : a;
        return (unsigned)row * (unsigned)ldab;
    }
    __device__ __forceinline__ const char* b_ptr(const Unit& u) const { return (const char*)Bt + (size_t)u.e * bstride + (size_t)u.pn * BM * kb; }
};

typedef int v8i32 __attribute__((ext_vector_type(8)));
typedef int v4i32_ __attribute__((ext_vector_type(4)));
__device__ __forceinline__ v8i32 cat8(bf16x8 a, bf16x8 b) { const u32x4 x = __builtin_bit_cast(u32x4, a), y = __builtin_bit_cast(u32x4, b); return (v8i32){(int)x.x, (int)x.y, (int)x.z, (int)x.w, (int)y.x, (int)y.y, (int)y.z, (int)y.w}; }
template <bool FP8, class Epi, class Sched>
__device__ __forceinline__ void gemm_phase(LAS unsigned char* lds, const Sched& S, const Epi& E, int wave_id) {
    const int wid = wave_id; int lane = (int)__builtin_amdgcn_mbcnt_hi(~0u, __builtin_amdgcn_mbcnt_lo(~0u, 0u)); asm volatile("" : "+v"(lane));
    const int tid = wid * 64 + lane, wr = wid >> 2, wc = wid & 3, fr = lane & 15, fq = lane >> 4;
    const int kb = S.kb; int nt = kb / 128; asm volatile("" : "+s"(nt));
    unsigned voffB[2];
#pragma unroll
    for (int i = 0; i < 2; ++i) { int R, C; stage_rc(tid * 16 + i * 8192, R, C); const int Rb = (R & ~31) + perm32(R & 31);
        voffB[i] = (unsigned)(Rb * kb) + (unsigned)C * 2u; }
#define PG8_AOFF(u, h, i) ({ int _tz = tid; asm volatile("" : "+v"(_tz)); int _R, _C; stage_rc(_tz * 16 + (i) * 8192, _R, _C); S.a_off((u), (h) * HALF + _R) + (unsigned)_C * 2u; })
    const size_t kstep = (size_t)(BK * 2);
    const size_t hstepB = (size_t)HALF * kb;
    const unsigned ldsw = (unsigned)wid * 1024u;
    const int aoff = lds_byte(wr * 64 + fr, fq * 8), boff = lds_byte(wc * 32 + fr, fq * 8);
#define PG8_SA(b, h) (((b) * 2 + (h)) * HTB)
#define PG8_SB(b, h) ((4 + (b) * 2 + (h)) * HTB)
#define PG8_STAGE(bufoff, gbase, v0, v1) do { \
        __builtin_amdgcn_global_load_lds((const unsigned*)((const char*)(gbase) + (v0)), (LAS unsigned*)(lds + (bufoff) + ldsw), 16, 0, 0); \
        __builtin_amdgcn_global_load_lds((const unsigned*)((const char*)(gbase) + (v1)), (LAS unsigned*)(lds + (bufoff) + ldsw + 8192), 16, 0, 0); } while (0)
#define PG8_VOFFB(i) ({ int _tz = tid; asm volatile("" : "+v"(_tz)); int _R, _C; stage_rc(_tz * 16 + (i) * 8192, _R, _C); (unsigned)(((_R & ~31) + perm32(_R & 31)) * kb) + (unsigned)_C * 2u; })
#define PG8_STAGE_B(bufoff, gbase) do { if constexpr (FP8) { const unsigned _v0 = PG8_VOFFB(0), _v1 = PG8_VOFFB(1); PG8_STAGE(bufoff, gbase, _v0, _v1); } else PG8_STAGE(bufoff, gbase, voffB[0], voffB[1]); } while (0)
#define PG8_LD8(off) __builtin_shufflevector(*(const LAS v4i32_*)(lds + (off)), *(const LAS v4i32_*)(lds + (off) + 1024), 0, 1, 2, 3, 4, 5, 6, 7)
#define PG8_LDA(dst, b, h) do { _Pragma("unroll") for (int m = 0; m < 4; ++m) { if constexpr (FP8) dst##8[m] = PG8_LD8(PG8_SA(b, h) + aoff + m * 2048); else { _Pragma("unroll") for (int k = 0; k < 2; ++k) dst[m][k] = *(const LAS bf16x8*)(lds + PG8_SA(b, h) + aoff + m * 2048 + k * 1024); } } } while (0)
#define PG8_LDB(dst, b, h) do { _Pragma("unroll") for (int n = 0; n < 2; ++n) { if constexpr (FP8) dst##8[n] = PG8_LD8(PG8_SB(b, h) + boff + n * 2048); else { _Pragma("unroll") for (int k = 0; k < 2; ++k) dst[n][k] = *(const LAS bf16x8*)(lds + PG8_SB(b, h) + boff + n * 2048 + k * 1024); } } } while (0)
#define PG8_MMA(ai, bj, At, Bt) do { __builtin_amdgcn_s_setprio(1); _Pragma("unroll") for (int m = 0; m < 4; ++m) _Pragma("unroll") for (int n = 0; n < 2; ++n) { \
        if constexpr (FP8) asm volatile("v_mfma_f32_16x16x128_f8f6f4 %0, %1, %2, %0" : "+v"(acc[ai][bj][m][n]) : "v"(Bt##8[n]), "v"(At##8[m])); \
        else { _Pragma("unroll") for (int k = 0; k < 2; ++k) acc[ai][bj][m][n] = __builtin_amdgcn_mfma_f32_16x16x32_bf16(Bt[n][k], At[m][k], acc[ai][bj][m][n], 0, 0, 0); } } \
        __builtin_amdgcn_s_setprio(0); } while (0)
#define PG8_WAIT_V(n) asm volatile("s_waitcnt vmcnt(" #n ")" ::: "memory")
#define PG8_WAIT_L(n) asm volatile("s_waitcnt lgkmcnt(" #n ")" ::: "memory")
#define PG8_BAR __builtin_amdgcn_s_barrier()
#define PG8_SCHED __builtin_amdgcn_sched_barrier(0)
    Unit cur, nxt; int ui = 0;
    if (!S.next(0, cur)) return;
    f32x4 acc[2][2][4][2];
#pragma unroll
    for (int a = 0; a < 2; ++a)
#pragma unroll
        for (int b = 0; b < 2; ++b)
#pragma unroll
            for (int m = 0; m < 4; ++m)
#pragma unroll
                for (int n = 0; n < 2; ++n) acc[a][b][m][n] = (f32x4){0.f, 0.f, 0.f, 0.f};
    bf16x8 At[4][2], B0[2][2], B1[2][2]; v8i32 At8[4], B08[2], B18[2];
    const char* const gA = S.a_base();
    const char* cB = S.b_ptr(cur);
    unsigned oc00, oc01, oc10, oc11;
    oc00 = PG8_AOFF(cur, 0, 0); oc01 = PG8_AOFF(cur, 0, 1); oc10 = PG8_AOFF(cur, 1, 0); oc11 = PG8_AOFF(cur, 1, 1);
    PG8_STAGE_B(PG8_SB(0, 0), cB); PG8_STAGE_B(PG8_SB(0, 1), cB + hstepB); PG8_STAGE(PG8_SA(0, 0), gA, oc00, oc01); PG8_STAGE(PG8_SA(0, 1), gA, oc10, oc11);
    if (wr == 1) PG8_BAR;
    PG8_WAIT_V(2); PG8_BAR;
    PG8_STAGE_B(PG8_SB(1, 0), cB + kstep); PG8_STAGE(PG8_SA(1, 0), gA + kstep, oc00, oc01); PG8_STAGE_B(PG8_SB(1, 1), cB + hstepB + kstep);
    PG8_WAIT_V(6); PG8_BAR;
    for (;;) {
        const bool has_next = S.next(ui + 1, nxt);
        const char* nB = cB;
        {
            u32x4 on = {oc00, oc01, oc10, oc11};
            if (has_next) { on.x = PG8_AOFF(nxt, 0, 0); on.y = PG8_AOFF(nxt, 0, 1); on.z = PG8_AOFF(nxt, 1, 0); on.w = PG8_AOFF(nxt, 1, 1); nB = S.b_ptr(nxt); }
            *(LAS u32x4*)(lds + STAGE_BYTES + tid * 16) = on;
        }
        for (int t = 0; t < nt; t += 2) {
            const bool last = (t == nt - 2);
            const char* a1 = gA + (size_t)(t + 1) * kstep;
            const char* a2 = last ? gA : gA + (size_t)(t + 2) * kstep; const char* b2 = last ? nB : cB + (size_t)(t + 2) * kstep;
            const char* a3 = a2 + kstep; const char* b3 = b2 + kstep;
            unsigned s00 = oc00, s01 = oc01, s10 = oc10, s11 = oc11;
            if (last) { const u32x4 on = *(const LAS u32x4*)(lds + STAGE_BYTES + tid * 16); s00 = on.x; s01 = on.y; s10 = on.z; s11 = on.w; }
            PG8_LDB(B0, 0, 0); PG8_LDB(B1, 0, 1); PG8_SCHED; PG8_LDA(At, 0, 0); PG8_STAGE(PG8_SA(1, 1), a1, oc10, oc11);
            PG8_WAIT_V(8); PG8_WAIT_L(0); PG8_BAR; PG8_MMA(0, 0, At, B0); PG8_MMA(0, 1, At, B1); PG8_BAR; PG8_SCHED;
            PG8_LDA(At, 0, 1); PG8_STAGE_B(PG8_SB(0, 0), b2); PG8_STAGE_B(PG8_SB(0, 1), b2 + hstepB); PG8_STAGE(PG8_SA(0, 0), a2, s00, s01);
            PG8_WAIT_V(8); PG8_WAIT_L(0); PG8_BAR; PG8_MMA(1, 0, At, B0); PG8_MMA(1, 1, At, B1); PG8_BAR; PG8_SCHED;
            PG8_LDB(B0, 1, 0); PG8_LDB(B1, 1, 1); PG8_SCHED; PG8_LDA(At, 1, 0); PG8_STAGE(PG8_SA(0, 1), a2, s10, s11);
            PG8_WAIT_V(8); PG8_WAIT_L(0); PG8_BAR; PG8_MMA(0, 0, At, B0); PG8_MMA(0, 1, At, B1); PG8_BAR; PG8_SCHED;
            PG8_LDA(At, 1, 1); PG8_STAGE_B(PG8_SB(1, 0), b3); PG8_STAGE_B(PG8_SB(1, 1), b3 + hstepB); PG8_STAGE(PG8_SA(1, 0), a3, s00, s01);
            PG8_WAIT_V(8); PG8_WAIT_L(0); PG8_BAR; PG8_MMA(1, 0, At, B0); PG8_MMA(1, 1, At, B1); PG8_BAR; PG8_SCHED;
        }
        if (wr == 0) PG8_BAR;
        E(acc, cur, wr, wc, fr, fq);
        if (!has_next) break;
#pragma unroll
        for (int a = 0; a < 2; ++a)
#pragma unroll
            for (int b = 0; b < 2; ++b)
#pragma unroll
                for (int m = 0; m < 4; ++m)
#pragma unroll
                    for (int n = 0; n < 2; ++n) acc[a][b][m][n] = (f32x4){0.f, 0.f, 0.f, 0.f};
        { const u32x4 on = *(const LAS u32x4*)(lds + STAGE_BYTES + tid * 16); oc00 = on.x; oc01 = on.y; oc10 = on.z; oc11 = on.w; }
        cur = nxt; cB = nB; ++ui;
        if (wr == 1) PG8_BAR;
    }
    PG8_WAIT_V(0);
    PG8_BAR;
#undef PG8_SA
#undef PG8_SB
#undef PG8_STAGE
#undef PG8_STAGE_B
#undef PG8_AOFF
#undef PG8_VOFFB
#undef PG8_LD8
#undef PG8_LDA
#undef PG8_LDB
#undef PG8_MMA
#undef PG8_WAIT_V
#undef PG8_WAIT_L
#undef PG8_BAR
#undef PG8_SCHED
}

struct EpiStore {
    bf16_t* O; int ldc; float scale;
    __device__ __forceinline__ void operator()(const f32x4 (&acc)[2][2][4][2], const Unit& u, int wr, int wc, int fr, int fq) const {
        const int row0 = u.pm * BM + wr * 64 + fr, col0 = u.pn * BM + wc * 32 + 8 * fq;
#pragma unroll
        for (int ai = 0; ai < 2; ++ai)
#pragma unroll
            for (int m = 0; m < 4; ++m) { bf16_t* rowp = O + (size_t)(row0 + ai * HALF + m * 16) * ldc + col0;
#pragma unroll
                for (int bj = 0; bj < 2; ++bj) { const f32x4 v0 = acc[ai][bj][m][0] * scale, v1 = acc[ai][bj][m][1] * scale;
                    u32x4 w; w.x = cvt_pk_bf16(v0[0], v0[1]); w.y = cvt_pk_bf16(v0[2], v0[3]); w.z = cvt_pk_bf16(v1[0], v1[1]); w.w = cvt_pk_bf16(v1[2], v1[3]);
                    *(u32x4*)(rowp + bj * HALF) = w; } }
    }
};
struct EpiGlu {
    const bf16_t* Z; const float* b; bf16_t* MIX;
    __device__ __forceinline__ void operator()(const f32x4 (&acc)[2][2][4][2], const Unit& u, int wr, int wc, int fr, int fq) const {
        const int row0 = u.pm * BM + wr * 64 + fr, col0 = u.pn * BM + wc * 32 + 8 * fq;
#pragma unroll
        for (int bj = 0; bj < 2; ++bj) {
            const f32x4 b0 = *(const f32x4*)(b + col0 + bj * HALF), b1 = *(const f32x4*)(b + col0 + bj * HALF + 4);
#pragma unroll
            for (int ai = 0; ai < 2; ++ai)
#pragma unroll
                for (int m = 0; m < 4; ++m) { const size_t row = (size_t)(row0 + ai * HALF + m * 16);
                    const u32x4 zz = *(const u32x4*)(Z + row * 1024 + col0 + bj * HALF);
                    const f32x4 v0 = acc[ai][bj][m][0] + b0, v1 = acc[ai][bj][m][1] + b1;
                    u32x4 w;
                    w.x = cvt_pk_bf16(bflo(zz.x) * sigmoidf_(v0[0]), bfhi(zz.x) * sigmoidf_(v0[1]));
                    w.y = cvt_pk_bf16(bflo(zz.y) * sigmoidf_(v0[2]), bfhi(zz.y) * sigmoidf_(v0[3]));
                    w.z = cvt_pk_bf16(bflo(zz.z) * sigmoidf_(v1[0]), bfhi(zz.z) * sigmoidf_(v1[1]));
                    w.w = cvt_pk_bf16(bflo(zz.w) * sigmoidf_(v1[2]), bfhi(zz.w) * sigmoidf_(v1[3]));
                    *(u32x4*)(MIX + row * DM + 1024 + col0 + bj * HALF) = w; }
        }
    }
};
struct EpiE1 {
    unsigned char* H; const int* list; const LAS int* cn;
    __device__ __forceinline__ void operator()(const f32x4 (&acc)[2][2][4][2], const Unit& u, int wr, int wc, int fr, int fq) const {
        const int n = cn[u.e]; const int colh = u.pn * 128 + wc * 32 + 8 * fq;
#pragma unroll
        for (int ai = 0; ai < 2; ++ai)
#pragma unroll
            for (int m = 0; m < 4; ++m) { const int pos = u.pm * BM + ai * HALF + wr * 64 + m * 16 + fr;
                if (pos < n) { const int a = list[u.e * TT + pos];
                    float sc = WSCALE_INV; asm volatile("" : "+v"(sc));
                    const f32x4 g0 = acc[ai][0][m][0] * sc, g1 = acc[ai][0][m][1] * sc, u0 = acc[ai][1][m][0] * sc, u1 = acc[ai][1][m][1] * sc;
                    u32x2 w;
                    w.x = (unsigned)__builtin_amdgcn_cvt_pk_fp8_f32(siluf_(g0[0]) * u0[0], siluf_(g0[1]) * u0[1], 0, false);
                    w.x = (unsigned)__builtin_amdgcn_cvt_pk_fp8_f32(siluf_(g0[2]) * u0[2], siluf_(g0[3]) * u0[3], (int)w.x, true);
                    w.y = (unsigned)__builtin_amdgcn_cvt_pk_fp8_f32(siluf_(g1[0]) * u1[0], siluf_(g1[1]) * u1[1], 0, false);
                    w.y = (unsigned)__builtin_amdgcn_cvt_pk_fp8_f32(siluf_(g1[2]) * u1[2], siluf_(g1[3]) * u1[3], (int)w.y, true);
                    *(u32x2*)(H + (size_t)a * EHID + colh) = w; }
                __builtin_amdgcn_sched_barrier(0); }
    }
};
struct EpiE2 {
    unsigned char* Y; const int* list; const float* wgt; const LAS int* cn;
    __device__ __forceinline__ void operator()(const f32x4 (&acc)[2][2][4][2], const Unit& u, int wr, int wc, int fr, int fq) const {
        const int n = cn[u.e]; const int col0 = u.pn * BM + wc * 32 + 8 * fq;
#pragma unroll
        for (int ai = 0; ai < 2; ++ai)
#pragma unroll
            for (int m = 0; m < 4; ++m) { const int pos = u.pm * BM + ai * HALF + wr * 64 + m * 16 + fr;
                if (pos < n) { const int a = list[u.e * TT + pos]; float ws = wgt[u.e * TT + pos] * WSCALE_INV; asm volatile("" : "+v"(ws));
                    unsigned char* rowp = Y + (size_t)a * DM + col0;
#pragma unroll
                    for (int bj = 0; bj < 2; ++bj) { const f32x4 v0 = acc[ai][bj][m][0] * ws, v1 = acc[ai][bj][m][1] * ws;
                        u32x2 w;
                        w.x = (unsigned)__builtin_amdgcn_cvt_pk_fp8_f32(v0[0], v0[1], 0, false); w.x = (unsigned)__builtin_amdgcn_cvt_pk_fp8_f32(v0[2], v0[3], (int)w.x, true);
                        w.y = (unsigned)__builtin_amdgcn_cvt_pk_fp8_f32(v1[0], v1[1], 0, false); w.y = (unsigned)__builtin_amdgcn_cvt_pk_fp8_f32(v1[2], v1[3], (int)w.y, true);
                        *(u32x2*)(rowp + bj * HALF) = w; } }
                __builtin_amdgcn_sched_barrier(0); }
    }
};
}
struct KArgs {
    const float* in[34];
    float* out;
    unsigned char* ws;
    int ph_lo, ph_hi;
};
struct Params {
    float* out;
    unsigned char* ws;
    LAS unsigned long long* ptab;
    int ph_lo, ph_hi;
    __device__ __forceinline__ const float* inp(int k) const {
        const unsigned long long v = ptab[k];
        const unsigned lo = __builtin_amdgcn_readfirstlane((unsigned)v), hi = __builtin_amdgcn_readfirstlane((unsigned)(v >> 32));
        return (const float*)(((unsigned long long)hi << 32) | lo);
    }
};
struct Ctx {
    LAS unsigned char* lds;
    int tid, lane, wave, G, bid;
    int gw, ngw;
};

__device__ __forceinline__ void tr_item(const float* W, int N, bf16_t* WT, int ldt, int k0, int n0, int orow0, LAS float* scr, int lane) {
#pragma unroll 8
    for (int i = 0; i < 32; ++i) { const int kk = 2 * i + (lane >> 5); scr[kk * 33 + (lane & 31)] = W[(size_t)(k0 + kk) * N + n0 + (lane & 31)]; }
    LDS_WAIT(); asm volatile("" ::: "memory");
    const int c = lane & 7;
#pragma unroll
    for (int j = 0; j < 4; ++j) { const int n = (lane >> 3) + 8 * j; const LAS float* s = scr + (8 * c) * 33 + n;
        u32x4 o; o.x = cvt_pk_bf16(s[0 * 33], s[1 * 33]); o.y = cvt_pk_bf16(s[2 * 33], s[3 * 33]); o.z = cvt_pk_bf16(s[4 * 33], s[5 * 33]); o.w = cvt_pk_bf16(s[6 * 33], s[7 * 33]);
        *(u32x4*)(WT + (size_t)(orow0 + n) * ldt + k0 + 8 * c) = o; }
    LDS_WAIT(); asm volatile("" ::: "memory");
}
__device__ __forceinline__ void tr_item64(const float* W, int N, bf16_t* WT, int ldt, int k0, int n0, int orow0, LAS float* scr, int lane) {
    f32x4 v[16];
    const float* src = W + (size_t)(k0 + (lane >> 4)) * N + n0 + 4 * (lane & 15);
#pragma unroll
    for (int i = 0; i < 16; ++i) v[i] = __builtin_nontemporal_load((const f32x4*)(src + (size_t)(4 * i) * N));
#pragma unroll
    for (int i = 0; i < 16; ++i) { LAS float* d = scr + (4 * i + (lane >> 4)) * 65 + 4 * (lane & 15); d[0] = v[i][0]; d[1] = v[i][1]; d[2] = v[i][2]; d[3] = v[i][3]; }
    LDS_WAIT(); asm volatile("" ::: "memory");
    const int c = lane & 7;
#pragma unroll
    for (int j = 0; j < 8; ++j) { const int n = (lane >> 3) + 8 * j; const LAS float* s = scr + (8 * c) * 65 + n;
        u32x4 o; o.x = cvt_pk_bf16(s[0 * 65], s[1 * 65]); o.y = cvt_pk_bf16(s[2 * 65], s[3 * 65]); o.z = cvt_pk_bf16(s[4 * 65], s[5 * 65]); o.w = cvt_pk_bf16(s[6 * 65], s[7 * 65]);
        *(u32x4*)(WT + (size_t)(orow0 + n) * ldt + k0 + 8 * c) = o; }
    LDS_WAIT(); asm volatile("" ::: "memory");
}
__device__ __forceinline__ void tr_item64_fp8(const float* W, int N, unsigned char* WT, int ldt, int k0, int n0, int orow0, LAS float* scr, int lane, float wscale = pg8::WSCALE) {
    f32x4 v[16];
    const float* src = W + (size_t)(k0 + (lane >> 4)) * N + n0 + 4 * (lane & 15);
#pragma unroll
    for (int i = 0; i < 16; ++i) v[i] = __builtin_nontemporal_load((const f32x4*)(src + (size_t)(4 * i) * N));
#pragma unroll
    for (int i = 0; i < 16; ++i) { LAS float* d = scr + (4 * i + (lane >> 4)) * 65 + 4 * (lane & 15); d[0] = v[i][0]; d[1] = v[i][1]; d[2] = v[i][2]; d[3] = v[i][3]; }
    LDS_WAIT(); asm volatile("" ::: "memory");
    const int c = lane & 7;
#pragma unroll
    for (int j = 0; j < 8; ++j) { const int n = (lane >> 3) + 8 * j; const LAS float* s = scr + (8 * c) * 65 + n;
        u32x2 o;
        o.x = (unsigned)__builtin_amdgcn_cvt_pk_fp8_f32(s[0 * 65] * wscale, s[1 * 65] * wscale, 0, false);
        o.x = (unsigned)__builtin_amdgcn_cvt_pk_fp8_f32(s[2 * 65] * wscale, s[3 * 65] * wscale, (int)o.x, true);
        o.y = (unsigned)__builtin_amdgcn_cvt_pk_fp8_f32(s[4 * 65] * wscale, s[5 * 65] * wscale, 0, false);
        o.y = (unsigned)__builtin_amdgcn_cvt_pk_fp8_f32(s[6 * 65] * wscale, s[7 * 65] * wscale, (int)o.y, true);
        *(u32x2*)(WT + (size_t)(orow0 + n) * ldt + k0 + 8 * c) = o; }
    LDS_WAIT(); asm volatile("" ::: "memory");
}
__device__ __forceinline__ void tr_dense(const float* W, int K, int N, bf16_t* WT, int item, LAS float* scr, int lane) {
    const int nblk = N / 32, kb = item / nblk, nb = item % nblk;
    tr_item(W, N, WT, K, 64 * kb, 32 * nb, 32 * nb, scr, lane);
}

__device__ __forceinline__ void s5_tables(const Params& p, Ctx& C, int dir, int g) {
    LAS f32x2* PW = (LAS f32x2*)C.lds;
    LAS f32x2* BB = PW + 65 * 64;
    LAS f32x2* CX = BB + 64 * 16;
    const float* a_re = p.inp(11); const float* a_im = p.inp(12); const float* log_dt = p.inp(13);
    const float* b_re = p.inp(14); const float* b_im = p.inp(15); const float* c_re = p.inp(16); const float* c_im = p.inp(17);
    const int tid = C.tid;
    if (tid < 64) {
        const int pp = tid;
        const float dt = __expf(log_dt[dir * 64 + g]);
        const float are = a_re[(dir * 64 + g) * 64 + pp], aim = a_im[(dir * 64 + g) * 64 + pp];
        const float zr = are * dt, zi = aim * dt;
        const float mag = __expf(zr);
        double rev = (double)zi * 0.15915494309189535; rev -= floor(rev);
        const float cs = __builtin_amdgcn_cosf((float)rev), sn = __builtin_amdgcn_sinf((float)rev);
        const float abr = mag * cs, abi = mag * sn;
        const float den = are * are + aim * aim, nr = abr - 1.0f, ni = abi;
        const float fre = (nr * are + ni * aim) / den, fim = (ni * are - nr * aim) / den;
        float pr = 1.0f, pi = 0.0f;
#pragma unroll 1
        for (int n = 0; n <= 64; ++n) { PW[n * 64 + pp] = (f32x2){pr, pi}; const float t = pr * abr - pi * abi; pi = pr * abi + pi * abr; pr = t; }
        for (int j = 0; j < 16; ++j) { const float br = b_re[(g * 64 + pp) * 16 + j], bi = b_im[(g * 64 + pp) * 16 + j];
            BB[pp * 16 + j] = (f32x2){fre * br - fim * bi, fre * bi + fim * br}; }
    }
    for (int q = tid; q < 1024; q += NTHR) { const int i = q >> 6, pp = q & 63; CX[i * 64 + pp] = (f32x2){c_re[(g * 16 + i) * 64 + pp], c_im[(g * 16 + i) * 64 + pp]}; }
    __syncthreads();
    bf16_t* KN = (bf16_t*)(p.ws + WS_KN) + (size_t)(dir * 64 + g) * 16 * 1024;
    bf16_t* WTt = (bf16_t*)(p.ws + WS_WT) + (size_t)(dir * 64 + g) * 128 * 1024;
    float* APOW = (float*)(p.ws + WS_APOW) + (size_t)(dir * 64 + g) * 64 * 128;
    float* AL = (float*)(p.ws + WS_AL) + (size_t)(dir * 64 + g) * 128;
#pragma unroll 1
    for (int q = 0; q < 32; ++q) { const int idx = tid + NTHR * q; const int n = idx >> 8, i = (idx >> 4) & 15, j = idx & 15;
        float s = 0.f;
#pragma unroll 4
        for (int pp = 0; pp < 64; ++pp) { const f32x2 c = CX[i * 64 + pp], w = PW[n * 64 + pp], b = BB[pp * 16 + j];
            const float gr = c.x * b.x - c.y * b.y, gi = c.x * b.y + c.y * b.x;
            s += gr * w.x - gi * w.y; }
        KN[(size_t)i * 1024 + n * 16 + j] = f2bf(s); }
#pragma unroll 2
    for (int q = 0; q < 256; ++q) { const int idx = tid + NTHR * q; const int j = idx & 15, s = (idx >> 4) & 63, pq = idx >> 10; const int pp = pq & 63;
        const f32x2 w = PW[(63 - s) * 64 + pp], b = BB[pp * 16 + j];
        const float v = (pq < 64) ? (w.x * b.x - w.y * b.y) : (w.x * b.y + w.y * b.x);
        WTt[(size_t)pq * 1024 + s * 16 + j] = f2bf(v); }
    for (int q = tid; q < 4096; q += NTHR) { const int t = q >> 6, pp = q & 63; const f32x2 w = PW[(t + 1) * 64 + pp]; *(f32x2*)(APOW + (size_t)t * 128 + 2 * pp) = w; }
    if (tid < 64) { const f32x2 w = PW[64 * 64 + tid]; *(f32x2*)(AL + 2 * tid) = w; }
    if (dir == 0) { bf16_t* CCt = (bf16_t*)(p.ws + WS_CC) + (size_t)g * 16 * 128;
        for (int q = tid; q < 2048; q += NTHR) { const int i = q >> 7, pq = q & 127; const f32x2 c = CX[i * 64 + (pq & 63)]; CCt[i * 128 + pq] = f2bf(pq < 64 ? c.x : -c.y); } }
    __syncthreads();
}

__device__ __forceinline__ void phase_p0(const Params& p, Ctx& C) {
    for (int task = C.bid; task < 128; task += C.G) s5_tables(p, C, task >> 6, task & 63);
    {
        const int gt = C.bid * NTHR + C.tid, ngt = C.G * NTHR;
        float* R128 = (float*)(p.ws + WS_ROPE128); float* R64 = (float*)(p.ws + WS_ROPE64);
        for (int q = gt; q < 256 * 64 + 256 * 32; q += ngt) {
            int pos, i, half; float* dst;
            if (q < 256 * 64) { pos = q >> 6; i = q & 63; half = 64; dst = R128 + (size_t)q * 2; }
            else { const int r = q - 256 * 64; pos = r >> 5; i = r & 31; half = 32; dst = R64 + (size_t)r * 2; }
            const float freq = exp2f(-(float)i / (float)half * 13.287712379549449f);
            const float ang = (float)pos * freq;
            double rev = (double)ang * 0.15915494309189535; rev -= floor(rev);
            dst[0] = __builtin_amdgcn_cosf((float)rev); dst[1] = __builtin_amdgcn_sinf((float)rev);
        }
        bf16_t* RWT = (bf16_t*)(p.ws + WS_RWT); const float* rw = p.inp(26);
        for (int q = gt; q < 2 * 64 * DM; q += ngt) { const int L = q / (64 * DM), r = q % (64 * DM), e = r / DM, k = r % DM;
            const float w = rw[((size_t)L * DM + k) * 64 + e]; const bf16_t hi = f2bf(w); const bf16_t lo = f2bf(w - bf2f(hi));
            RWT[((size_t)(L * 2 + 0) * 64 + e) * DM + k] = hi; RWT[((size_t)(L * 2 + 1) * 64 + e) * DM + k] = lo; }
    }
    {
        const float* cvec = p.inp(1); const float* cctx = p.inp(3); const float* mw = p.inp(4);
        float* MODP = (float*)(p.ws + WS_MODP);
        for (int task = C.gw; task < 2 * 32 * 48; task += C.ngw) {
            const int L = task / (32 * 48), r = task % (32 * 48), kb = r / 48, cb = r % 48;
            const float sc = siluf_(cvec[64 * kb + C.lane]), sx = siluf_(cctx[64 * kb + C.lane]);
            f32x4 a0 = {0.f, 0.f, 0.f, 0.f}, a1 = {0.f, 0.f, 0.f, 0.f};
            const float* wp = mw + ((size_t)L * DM + 64 * kb) * 12288 + 256 * cb + 4 * C.lane;
#pragma unroll 8
            for (int kk = 0; kk < 64; ++kk) { const f32x4 w = *(const f32x4*)(wp + (size_t)kk * 12288);
                const float s0 = __shfl(sc, kk), s1 = __shfl(sx, kk);
                a0 += w * s0; a1 += w * s1; }
            *(f32x4*)(MODP + ((size_t)((L * 32 + kb) * 2 + 0)) * 12288 + 256 * cb + 4 * C.lane) = a0;
            *(f32x4*)(MODP + ((size_t)((L * 32 + kb) * 2 + 1)) * 12288 + 256 * cb + 4 * C.lane) = a1;
        }
    }
    {
        LAS float* scr = (LAS float*)(C.lds + C.wave * 17408);
        constexpr int J0 = (DM / 64) * (EV_IN / 64), J3 = (DM / 64) * (OD_IN / 64);
        for (int it = C.gw; it < J0 + J3; it += C.ngw) {
            const bool l1 = it >= J0; const int r = l1 ? it - J0 : it; const int N = l1 ? OD_IN : EV_IN; const int nblk = N / 64, kb = r / nblk, nb = r % nblk;
            tr_item64_fp8(p.inp(l1 ? 21 : 8), N, (unsigned char*)(p.ws + (l1 ? WS_WIN1 : WS_WIN0)), DM, 64 * kb, 64 * nb, 64 * nb, scr, C.lane, 32.0f);
        }
        LAS float* scr2 = (LAS float*)(C.lds + C.wave * 17408);
        constexpr int I1 = (DM / 64) * (DM / 32), I2 = (1024 / 64) * (1024 / 32), I4 = I1;
        for (int it = C.gw; it < I1 + I2 + I4; it += C.ngw) {
            int r = it;
            if (r < I1) { tr_dense(p.inp(9), DM, DM, (bf16_t*)(p.ws + WS_WOUT0), r, scr2, C.lane); continue; } r -= I1;
            if (r < I2) { tr_dense(p.inp(19), 1024, 1024, (bf16_t*)(p.ws + WS_WGLU), r, scr2, C.lane); continue; } r -= I2;
            tr_dense(p.inp(22), DM, DM, (bf16_t*)(p.ws + WS_WOUT1), r, scr2, C.lane);
        }
    }
}
__device__ __forceinline__ void phase_p1(const Params& p, Ctx& C) {
    const float* MODP = (const float*)(p.ws + WS_MODP); float* MODF = (float*)(p.ws + WS_MODF); const float* mb = p.inp(5);
    for (int q = C.bid * NTHR + C.tid; q < 2 * 2 * 12288; q += C.G * NTHR) { const int L = q / (2 * 12288), v = (q / 12288) & 1, col = q % 12288;
        float s = mb[L * 12288 + col];
        for (int kb = 0; kb < 32; ++kb) s += MODP[((size_t)((L * 32 + kb) * 2 + v)) * 12288 + col];
        MODF[q] = s; }
}
__device__ __forceinline__ const float* modv(const Params& p, int L, int v, int k) { return (const float*)(p.ws + WS_MODF) + (size_t)(L * 2 + v) * 12288 + k * DM; }

__device__ __forceinline__ void phase_modulate(const Params& p, Ctx& C, int L) {
    unsigned char* XA8 = (unsigned char*)(p.ws + WS_XA);
    const float* X2 = (const float*)(p.ws + WS_HX2);
    for (int r = C.gw; r < TT; r += C.ngw) {
        const int v = r < CTXL ? 1 : 0;
        const float* src = (L == 0) ? (r < CTXL ? p.inp(2) + (size_t)r * DM : p.inp(0) + (size_t)(r - CTXL) * DM) : X2 + (size_t)r * DM;
        const float* sh = modv(p, L, v, 0); const float* sc = modv(p, L, v, 1);
#pragma unroll
        for (int j = 0; j < 8; ++j) { const int c = 4 * (C.lane + 64 * j);
            const f32x4 x = *(const f32x4*)(src + c), a = *(const f32x4*)(sc + c), b = *(const f32x4*)(sh + c);
            const f32x4 y = x * (a + 1.0f) + b;
            unsigned w = (unsigned)__builtin_amdgcn_cvt_pk_fp8_f32(y[0], y[1], 0, false); w = (unsigned)__builtin_amdgcn_cvt_pk_fp8_f32(y[2], y[3], (int)w, true);
            *(unsigned*)(XA8 + (size_t)r * DM + c) = w; }
    }
    LAS float* scr = (LAS float*)(C.lds + C.wave * 17408);
    unsigned char* GU = (unsigned char*)(p.ws + WS_GU); unsigned char* DT = (unsigned char*)(p.ws + WS_DT);
    for (int it = C.gw; it < NEX1 * 768; it += C.ngw) {
        const int e = it / 768, r = it % 768, which = r >> 8, q = r & 255;
        if (which < 2) {
            const float* W = (e < 64) ? p.inp(28 + which) + ((size_t)(L * 64 + e)) * DM * EHID : p.inp(31 + which) + (size_t)L * DM * EHID;
            const int kb = q >> 3, nb = q & 7, n0 = 64 * nb;
            tr_item64_fp8(W, EHID, GU + (size_t)e * 1024 * DM, DM, 64 * kb, n0, 256 * (n0 >> 7) + (n0 & 127) + (which ? 128 : 0), scr, C.lane);
        } else {
            const float* W = (e < 64) ? p.inp(30) + ((size_t)(L * 64 + e)) * EHID * DM : p.inp(33) + (size_t)L * EHID * DM;
            const int kb = q >> 5, nb = q & 31;
            tr_item64_fp8(W, DM, DT + (size_t)e * DM * EHID, EHID, 64 * kb, 64 * nb, 64 * nb, scr, C.lane);
        }
    }
}

__device__ __forceinline__ void phase_rope0(const Params& p, Ctx& C) {
    bf16_t* QKV = (bf16_t*)(p.ws + WS_BIG + BG_QKV);
    const f32x2* R128 = (const f32x2*)(p.ws + WS_ROPE128);
    for (int r = C.gw; r < TT; r += C.ngw) {
        bf16_t* row = QKV + (size_t)r * EV_IN;
        if (r < CTXL) {
#pragma unroll
            for (int j = 0; j < 2; ++j) { u32x4* q = (u32x4*)(row + 8 * (C.lane + 64 * j)); u32x4 w = *q;
                w.x = cvt_pk_bf16(bflo(w.x) * 0.0625f, bfhi(w.x) * 0.0625f); w.y = cvt_pk_bf16(bflo(w.y) * 0.0625f, bfhi(w.y) * 0.0625f);
                w.z = cvt_pk_bf16(bflo(w.z) * 0.0625f, bfhi(w.z) * 0.0625f); w.w = cvt_pk_bf16(bflo(w.w) * 0.0625f, bfhi(w.w) * 0.0625f); *q = w; }
        } else {
            const int l = r - CTXL, rp = l >> 6, cp = l & 63;
#pragma unroll
            for (int qk = 0; qk < 2; ++qk)
#pragma unroll
                for (int m = 0; m < 8; ++m) { const int pi = C.lane + 64 * m, head = pi >> 7, blk = (pi >> 6) & 1, i = pi & 63;
                    bf16_t* b = row + qk * 1024 + head * 256 + blk * 128 + i;
                    const f32x2 cs = R128[(blk ? cp : rp) * 64 + i];
                    const float x1 = bf2f(b[0]), x2 = bf2f(b[64]); const float sc = qk ? 1.0f : 0.0625f;
                    b[0] = f2bf((x1 * cs.x - x2 * cs.y) * sc); b[64] = f2bf((x1 * cs.y + x2 * cs.x) * sc); }
        }
    }
}

__device__ __forceinline__ void phase_normrope1(const Params& p, Ctx& C) {
    bf16_t* QKV = (bf16_t*)(p.ws + WS_BIG + BG_QKV);
    const f32x2* R64 = (const f32x2*)(p.ws + WS_ROPE64);
    const float* qg = p.inp(23);
    const int lane = C.lane, i32 = lane & 31; const bool up = lane >= 32;
    const float g00 = qg[lane], g01 = qg[64 + lane], g10 = qg[128 + lane], g11 = qg[128 + 64 + lane];
    for (int r = C.gw; r < TT; r += C.ngw) {
        bf16_t* row = QKV + (size_t)r * OD_IN;
        const bool lat = r >= CTXL; const int l = r - CTXL, rp = lat ? (l >> 6) : 0, cp = lat ? (l & 63) : 0;
        const f32x2 cr = R64[rp * 32 + i32], cc = R64[cp * 32 + i32];
#pragma unroll 2
        for (int h = 0; h < 26; ++h) {
            const int col = h < 8 ? 128 * h : (h < 10 ? 1024 + 128 * (h - 8) : (h < 18 ? 1536 + 128 * (h - 10) : 2560 + 128 * (h - 18)));
            bf16_t* b = row + col;
            float v0 = bf2f(b[lane]), v1 = bf2f(b[64 + lane]);
            if (h < 10) { const float ss = wave_sum(v0 * v0 + v1 * v1); const float rs = rsqrtf(ss * (1.0f / 128.0f) + LN_EPS);
                v0 = bf2f(f2bf(v0 * rs)) * (h < 8 ? g00 : g10); v1 = bf2f(f2bf(v1 * rs)) * (h < 8 ? g01 : g11); }
            if (lat) { const float p0 = __shfl_xor(v0, 32), p1 = __shfl_xor(v1, 32);
                v0 = up ? (p0 * cr.y + v0 * cr.x) : (v0 * cr.x - p0 * cr.y);
                v1 = up ? (p1 * cc.y + v1 * cc.x) : (v1 * cc.x - p1 * cc.y); }
            b[lane] = f2bf(v0); b[64 + lane] = f2bf(v1);
        }
    }
}

__device__ __forceinline__ void phase_merge1(const Params& p, Ctx& C) {
    bf16_t* ATT = (bf16_t*)(p.ws + WS_BIG + BG_ATT);
    const float* dl = p.inp(24); const float* sg = p.inp(25);
    const int lane = C.lane;
    float d0 = dl[lane] * dl[128 + lane] + dl[64 + lane] * dl[128 + 64 + lane];
    float d1 = dl[256 + lane] * dl[384 + lane] + dl[256 + 64 + lane] * dl[384 + 64 + lane];
    const float lam = __expf(wave_sum(d0)) - __expf(wave_sum(d1)) + LAMBDA_INIT;
    const f32x4 gg = *(const f32x4*)(sg + 4 * lane);
    for (int l = C.gw; l < SEQ; l += C.ngw) {
        bf16_t* row = ATT + (size_t)l * 3072;
#pragma unroll
        for (int h = 0; h < 4; ++h) {
            const u32x2 a = *(const u32x2*)(row + 1024 + 256 * h + 4 * lane), b = *(const u32x2*)(row + 2048 + 256 * h + 4 * lane);
            f32x4 o = {bflo(a.x) - lam * bflo(b.x), bfhi(a.x) - lam * bfhi(b.x), bflo(a.y) - lam * bflo(b.y), bfhi(a.y) - lam * bfhi(b.y)};
            const float ss = wave_sum(o[0] * o[0] + o[1] * o[1] + o[2] * o[2] + o[3] * o[3]);
            const float rs = rsqrtf(ss * (1.0f / 256.0f) + LN_EPS) * (1.0f - LAMBDA_INIT);
            o = o * rs * gg;
            u32x2 w; w.x = cvt_pk_bf16(o[0], o[1]); w.y = cvt_pk_bf16(o[2], o[3]);
            *(u32x2*)(row + 1024 + 256 * h + 4 * lane) = w;
        }
    }
}

__device__ __forceinline__ void phase_ln1(const Params& p, Ctx& C, int L) {
    const bf16_t* Y = (const bf16_t*)(p.ws + WS_YMIX); float* X1 = (float*)(p.ws + WS_X1); unsigned char* XA8 = (unsigned char*)(p.ws + WS_XA);
    const float* X2 = (const float*)(p.ws + WS_HX2);
    const float* lg = p.inp(6) + (size_t)(L * 2 + 0) * DM; const float* lb = p.inp(7) + (size_t)(L * 2 + 0) * DM;
    const int r0 = (L == 0) ? 0 : CTXL;
    for (int r = r0 + C.gw; r < TT; r += C.ngw) {
        const int v = r < CTXL ? 1 : 0;
        const float* src = (L == 0) ? (r < CTXL ? p.inp(2) + (size_t)r * DM : p.inp(0) + (size_t)(r - CTXL) * DM) : X2 + (size_t)r * DM;
        const float* g1 = modv(p, L, v, 2); const float* sh2 = modv(p, L, v, 3); const float* sc2 = modv(p, L, v, 4);
        f32x4 t[8]; float s = 0.f;
#pragma unroll
        for (int j = 0; j < 8; ++j) { const int c = 4 * (C.lane + 64 * j);
            const f32x4 x = *(const f32x4*)(src + c), g = *(const f32x4*)(g1 + c); const u32x2 yy = *(const u32x2*)(Y + (size_t)r * DM + c);
            const f32x4 y = {bflo(yy.x), bfhi(yy.x), bflo(yy.y), bfhi(yy.y)};
            t[j] = x * ALPHA + g * y; s += (t[j][0] + t[j][1]) + (t[j][2] + t[j][3]); }
        const float mean = wave_sum(s) * (1.0f / DM); float s2 = 0.f;
#pragma unroll
        for (int j = 0; j < 8; ++j) { t[j] = t[j] - mean; s2 += (t[j][0] * t[j][0] + t[j][1] * t[j][1]) + (t[j][2] * t[j][2] + t[j][3] * t[j][3]); }
        const float rstd = rsqrtf(wave_sum(s2) * (1.0f / DM) + LN_EPS);
#pragma unroll
        for (int j = 0; j < 8; ++j) { const int c = 4 * (C.lane + 64 * j);
            const f32x4 x1 = t[j] * rstd * *(const f32x4*)(lg + c) + *(const f32x4*)(lb + c);
            *(f32x4*)(X1 + (size_t)r * DM + c) = x1;
            const f32x4 z = x1 * (*(const f32x4*)(sc2 + c) + 1.0f) + *(const f32x4*)(sh2 + c);
            unsigned w = (unsigned)__builtin_amdgcn_cvt_pk_fp8_f32(z[0], z[1], 0, false); w = (unsigned)__builtin_amdgcn_cvt_pk_fp8_f32(z[2], z[3], (int)w, true);
            *(unsigned*)(XA8 + (size_t)r * DM + c) = w; }
    }
}

__device__ __forceinline__ void phase_combine(const Params& p, Ctx& C, int L) {
    const unsigned char* YM = (const unsigned char*)(p.ws + WS_BIG + BG_YMOE); const float* X1 = (const float*)(p.ws + WS_X1);
    float* X2 = (float*)(p.ws + WS_HX2);
    const float* lg = p.inp(6) + (size_t)(L * 2 + 1) * DM; const float* lb = p.inp(7) + (size_t)(L * 2 + 1) * DM;
    const int r0 = (L == 0) ? 0 : CTXL;
    for (int r = r0 + C.gw; r < TT; r += C.ngw) {
        const int v = r < CTXL ? 1 : 0;
        const float* g2 = modv(p, L, v, 5);
        int ln = C.lane; asm volatile("" : "+v"(ln));
        f32x4 t[2][4]; float s = 0.f;
#pragma unroll
        for (int j = 0; j < 2; ++j) { const int c = 16 * (ln + 64 * j);
            u32x4 yy[9];
#pragma unroll
            for (int k = 0; k < 9; ++k) { const size_t a = (k < 8) ? (size_t)r * 8 + k : (size_t)8 * TT + r; yy[k] = __builtin_nontemporal_load((const u32x4*)(YM + a * DM + c)); }
            f32x2 f[8];
#pragma unroll
            for (int q = 0; q < 8; ++q) f[q] = (f32x2){0.f, 0.f};
#pragma unroll
            for (int k = 0; k < 9; ++k) {
                f[0] += __builtin_amdgcn_cvt_pk_f32_fp8((int)yy[k].x, false); f[1] += __builtin_amdgcn_cvt_pk_f32_fp8((int)yy[k].x, true);
                f[2] += __builtin_amdgcn_cvt_pk_f32_fp8((int)yy[k].y, false); f[3] += __builtin_amdgcn_cvt_pk_f32_fp8((int)yy[k].y, true);
                f[4] += __builtin_amdgcn_cvt_pk_f32_fp8((int)yy[k].z, false); f[5] += __builtin_amdgcn_cvt_pk_f32_fp8((int)yy[k].z, true);
                f[6] += __builtin_amdgcn_cvt_pk_f32_fp8((int)yy[k].w, false); f[7] += __builtin_amdgcn_cvt_pk_f32_fp8((int)yy[k].w, true); }
#pragma unroll
            for (int q = 0; q < 4; ++q) { const f32x4 x = *(const f32x4*)(X1 + (size_t)r * DM + c + 4 * q), g = *(const f32x4*)(g2 + c + 4 * q);
                const f32x4 ff = {f[2 * q][0], f[2 * q][1], f[2 * q + 1][0], f[2 * q + 1][1]};
                t[j][q] = x * ALPHA + g * ff; s += (t[j][q][0] + t[j][q][1]) + (t[j][q][2] + t[j][q][3]); } }
        const float mean = wave_sum(s) * (1.0f / DM); float s2 = 0.f;
#pragma unroll
        for (int j = 0; j < 2; ++j)
#pragma unroll
            for (int q = 0; q < 4; ++q) { t[j][q] = t[j][q] - mean; s2 += (t[j][q][0] * t[j][q][0] + t[j][q][1] * t[j][q][1]) + (t[j][q][2] * t[j][q][2] + t[j][q][3] * t[j][q][3]); }
        const float rstd = rsqrtf(wave_sum(s2) * (1.0f / DM) + LN_EPS);
        float* dst = (L == 0) ? X2 + (size_t)r * DM : p.out + (size_t)(r - CTXL) * DM;
#pragma unroll
        for (int j = 0; j < 2; ++j)
#pragma unroll
            for (int q = 0; q < 4; ++q) { const int c = 16 * (ln + 64 * j) + 4 * q;
                *(f32x4*)(dst + c) = t[j][q] * rstd * *(const f32x4*)(lg + c) + *(const f32x4*)(lb + c); }
    }
}
constexpr int RLD = 264;
constexpr int SLD = 136;

template <bool SCALE>
__device__ __forceinline__ void stage_chunk(const bf16_t* QKV, int row0, int col0, LAS bf16_t* dst, int tid, float lg  , int dirb) {
#pragma unroll
    for (int q = 0; q < 8; ++q) { const int idx = tid + NTHR * q, r = idx >> 5, c = idx & 31;
        u32x4 w = *(const u32x4*)(QKV + (size_t)(row0 + r) * EV_IN + col0 + 8 * c);
        if (SCALE) { const float sc = fast_exp((dirb ? (float)r : (float)(127 - r)) * lg);
            w.x = cvt_pk_bf16(bflo(w.x) * sc, bfhi(w.x) * sc); w.y = cvt_pk_bf16(bflo(w.y) * sc, bfhi(w.y) * sc);
            w.z = cvt_pk_bf16(bflo(w.z) * sc, bfhi(w.z) * sc); w.w = cvt_pk_bf16(bflo(w.w) * sc, bfhi(w.w) * sc); }
        *(LAS u32x4*)(dst + r * RLD + 8 * c) = w; }
}

__device__ __forceinline__ void ret_chunk_kv(const Params& p, Ctx& C) {
    const bf16_t* QKV = (const bf16_t*)(p.ws + WS_BIG + BG_QKV); float* CKV = (float*)(p.ws + WS_BIG + BG_CKV);
    const float* rld = p.inp(10);
    LAS bf16_t* Vs = (LAS bf16_t*)C.lds; LAS bf16_t* Ks = Vs + 128 * RLD;
    const int lane = C.lane, w = C.wave;
    for (int unit = C.bid; unit < 130 * 8; unit += C.G) {
        const int u = unit >> 3, h = (unit >> 1) & 3, dir = unit & 1;
        const float lg = rld[dir * 4 + h];
        __syncthreads();
        stage_chunk<false>(QKV, 128 * u, 2048 + 256 * h, Vs, C.tid, 0.f, 0);
        stage_chunk<true>(QKV, 128 * u, 1024 + 256 * h, Ks, C.tid, lg, dir);
        __syncthreads();
        f32x4 acc[2][16];
#pragma unroll
        for (int a = 0; a < 2; ++a)
#pragma unroll
            for (int b = 0; b < 16; ++b) acc[a][b] = (f32x4){0.f, 0.f, 0.f, 0.f};
        const unsigned vbase = (unsigned)(uintptr_t)Vs, kbase = (unsigned)(uintptr_t)Ks;
#pragma unroll 1
        for (int ks = 0; ks < 4; ++ks) {
            bf16x8 af[2];
#pragma unroll
            for (int a = 0; a < 2; ++a) af[a] = frag_colk_l(vbase + (unsigned)((32 * ks) * RLD + 32 * w + 16 * a) * 2u, RLD * 2, lane);
#pragma unroll
            for (int b = 0; b < 16; ++b) { const bf16x8 bf = frag_colk_l(kbase + (unsigned)((32 * ks) * RLD + 16 * b) * 2u, RLD * 2, lane);
                acc[0][b] = MFMA16(af[0], bf, acc[0][b]); acc[1][b] = MFMA16(af[1], bf, acc[1][b]); }
        }
        float* dst = CKV + ((size_t)((dir * 4 + h) * 130 + u)) * 65536;
#pragma unroll
        for (int a = 0; a < 2; ++a)
#pragma unroll
            for (int b = 0; b < 16; ++b)
#pragma unroll
                for (int j = 0; j < 4; ++j) dst[(size_t)(32 * w + 16 * a + 4 * (lane >> 4) + j) * 256 + 16 * b + (lane & 15)] = acc[a][b][j];
    }
    __syncthreads();
}

__device__ __forceinline__ int s5_row(int dir, int c, int s) { return dir == 0 ? 64 * c + s : (c < 4 ? 255 - (64 * c + s) : 16639 - 64 * (c - 4) - s); }

__device__ __forceinline__ void s5_end_states(const Params& p, Ctx& C) {
    const bf16_t* QKV = (const bf16_t*)(p.ws + WS_BIG + BG_QKV); const bf16_t* WTt = (const bf16_t*)(p.ws + WS_WT); float* E = (float*)(p.ws + WS_S5E);
    const int lane = C.lane, kq = lane >> 4;
    for (int task = C.gw; task < 2 * 64 * 17; task += C.ngw) {
        const int dir = task / (64 * 17), r = task % (64 * 17), g = r / 17, ct = r % 17;
        int cc = 16 * ct + (lane & 15); const bool valid = cc < 260; cc = valid ? cc : 259;
        const bf16_t* wt = WTt + (size_t)(dir * 64 + g) * 128 * 1024;
        f32x4 acc[8];
#pragma unroll
        for (int t = 0; t < 8; ++t) acc[t] = (f32x4){0.f, 0.f, 0.f, 0.f};
#pragma unroll 2
        for (int ks = 0; ks < 32; ++ks) {
            const int s = 2 * ks + (kq >> 1);
            const bf16x8 bf = *(const bf16x8*)(QKV + (size_t)s5_row(dir, cc, s) * EV_IN + 4096 + 16 * g + 8 * (kq & 1));
#pragma unroll
            for (int t = 0; t < 8; ++t) { const bf16x8 af = frag_rowk_g(wt + (size_t)(16 * t) * 1024 + 32 * ks, 1024, lane); acc[t] = MFMA16(af, bf, acc[t]); }
        }
        if (valid) { float* dst = E + ((size_t)((dir * 64 + g) * 260 + cc)) * 128;
#pragma unroll
            for (int t = 0; t < 8; ++t) *(f32x4*)(dst + 16 * t + 4 * kq) = acc[t]; }
    }
}

__device__ __forceinline__ void phase_scans(const Params& p, Ctx& C) {
    const float* CKV = (const float*)(p.ws + WS_BIG + BG_CKV); bf16_t* SP = (bf16_t*)(p.ws + WS_BIG + BG_SPREV);
    const float* rld = p.inp(10);
    for (int q = C.bid * NTHR + C.tid; q < 8 * 16384; q += C.G * NTHR) {
        const int dh = q >> 14, el = (q & 16383) * 4, dir = dh >> 2, h = dh & 3;
        const float gch = fast_exp(128.0f * rld[dir * 4 + h]);
        const float* src = CKV + (size_t)dh * 130 * 65536 + el; bf16_t* dst = SP + (size_t)dh * 130 * 65536 + el;
        f32x4 s = {0.f, 0.f, 0.f, 0.f};
        for (int st0 = 0; st0 < 130; st0 += 10) {
            f32x4 kv[10];
#pragma unroll
            for (int k = 0; k < 10; ++k) { const int st = st0 + k; const int u = dir == 0 ? st : (st == 0 ? 1 : (st == 1 ? 0 : 131 - st)); kv[k] = *(const f32x4*)(src + (size_t)u * 65536); }
#pragma unroll
            for (int k = 0; k < 10; ++k) { const int st = st0 + k; const int u = dir == 0 ? st : (st == 0 ? 1 : (st == 1 ? 0 : 131 - st));
                u32x2 w; w.x = cvt_pk_bf16(s[0], s[1]); w.y = cvt_pk_bf16(s[2], s[3]); *(u32x2*)(dst + (size_t)u * 65536) = w;
                s = s * gch + kv[k]; }
        }
    }
    const float* E = (const float*)(p.ws + WS_S5E); float* HST = (float*)(p.ws + WS_HST); const float* AL = (const float*)(p.ws + WS_AL);
    for (int q = C.bid * NTHR + C.tid; q < 2 * 64 * 64; q += C.G * NTHR) {
        const int dg = q >> 6, pp = q & 63;
        const f32x2 al = *(const f32x2*)(AL + (size_t)dg * 128 + 2 * pp);
        const float* e = E + (size_t)dg * 260 * 128; float* hs = HST + (size_t)dg * 260 * 128;
        float hr = 0.f, hi = 0.f;
        for (int c0 = 0; c0 < 260; c0 += 10) {
            float er[10], ei[10];
#pragma unroll
            for (int k = 0; k < 10; ++k) { er[k] = e[(size_t)(c0 + k) * 128 + pp]; ei[k] = e[(size_t)(c0 + k) * 128 + 64 + pp]; }
#pragma unroll
            for (int k = 0; k < 10; ++k) { *(f32x2*)(hs + (size_t)(c0 + k) * 128 + 2 * pp) = (f32x2){hr, hi};
                const float t = al.x * hr - al.y * hi + er[k]; hi = al.x * hi + al.y * hr + ei[k]; hr = t; }
        }
    }
}

__device__ __forceinline__ void ret_output_unit(const Params& p, Ctx& C, int unit) {
    const bf16_t* QKV = (const bf16_t*)(p.ws + WS_BIG + BG_QKV); const bf16_t* SP = (const bf16_t*)(p.ws + WS_BIG + BG_SPREV);
    bf16_t* MIX = (bf16_t*)(p.ws + WS_BIG + BG_MIX);
    const float* rld = p.inp(10);
    LAS bf16_t* RA = (LAS bf16_t*)C.lds; LAS bf16_t* RB = RA + 128 * RLD;
    int tid = C.tid; asm volatile("" : "+v"(tid));
    const int lane = tid & 63, w = C.wave, kq = lane >> 4, fr = lane & 15;
    const int u = unit >> 2, h = unit & 3;
    const float lgf = rld[h], lgb = rld[4 + h];
    stage_chunk<false>(QKV, 128 * u, 256 * h, RA, tid, 0.f, 0);
    int ib = 16 * w + 4 * kq, jb = fr; asm volatile("" : "+v"(ib), "+v"(jb));
    f32x4 acc[16];
#pragma unroll
    for (int t = 0; t < 16; ++t) acc[t] = (f32x4){0.f, 0.f, 0.f, 0.f};
#pragma unroll
    for (int dir = 0; dir < 2; ++dir) {
        const bf16_t* Sd = SP + ((size_t)((dir * 4 + h) * 130 + u)) * 65536;
#pragma unroll
        for (int eh = 0; eh < 2; ++eh) {
            __syncthreads();
#pragma unroll
            for (int q = 0; q < 8; ++q) { const int idx = tid + NTHR * q, rr = idx >> 5, c = idx & 31;
                *(LAS u32x4*)(RB + rr * RLD + 8 * c) = *(const u32x4*)(Sd + (size_t)(128 * eh + rr) * 256 + 8 * c);
                if (q == 3) asm volatile("" ::: "memory"); }
            __syncthreads();
#pragma unroll 1
            for (int ks = 0; ks < 8; ++ks) { const bf16x8 af = frag_rowk_l(RA + (16 * w) * RLD + 32 * ks, RLD, lane);
#pragma unroll
                for (int t = 0; t < 8; ++t) { const bf16x8 bf = frag_rowk_l(RB + (16 * t) * RLD + 32 * ks, RLD, lane); acc[8 * eh + t] = MFMA16(af, bf, acc[8 * eh + t]); } }
        }
#pragma unroll
        for (int r = 0; r < 4; ++r) { const int i = ib + r; const float qd = fast_exp((float)(128 - i) * lgb);
            const float f = (dir == 0) ? fast_exp((float)(i + 1) * lgf) / qd : qd;
#pragma unroll
            for (int t = 0; t < 16; ++t) acc[t][r] *= f; }
    }
    __syncthreads();
    stage_chunk<false>(QKV, 128 * u, 1024 + 256 * h, RB, tid, 0.f, 0);
    __syncthreads();
    f32x4 sc[8];
#pragma unroll
    for (int t = 0; t < 8; ++t) sc[t] = (f32x4){0.f, 0.f, 0.f, 0.f};
#pragma unroll 1
    for (int ks = 0; ks < 8; ++ks) { const bf16x8 af = frag_rowk_l(RA + (16 * w) * RLD + 32 * ks, RLD, lane);
#pragma unroll
        for (int t = 0; t < 8; ++t) { const bf16x8 bf = frag_rowk_l(RB + (16 * t) * RLD + 32 * ks, RLD, lane); sc[t] = MFMA16(af, bf, sc[t]); } }
#pragma unroll
    for (int t = 0; t < 8; ++t)
#pragma unroll
        for (int r = 0; r < 4; ++r) { const int i = ib + r, j = 16 * t + jb; const float d = (float)(i - j);
            const float m = (i >= j ? fast_exp(d * lgf) : 0.f) + (j >= i ? fast_exp(-d * lgb) : 0.f); sc[t][r] *= m; }
    __syncthreads();
    stage_chunk<false>(QKV, 128 * u, 2048 + 256 * h, RA, tid, 0.f, 0);
#pragma unroll
    for (int t = 0; t < 8; ++t)
#pragma unroll
        for (int r = 0; r < 4; ++r) RB[(16 * w + 4 * kq + r) * SLD + 16 * t + fr] = f2bf(sc[t][r]);
    __syncthreads();
    const unsigned vbase = (unsigned)(uintptr_t)RA;
#pragma unroll 1
    for (int ks = 0; ks < 4; ++ks) { const bf16x8 af = frag_rowk_l(RB + (16 * w) * SLD + 32 * ks, SLD, lane);
#pragma unroll
        for (int t = 0; t < 16; ++t) { const bf16x8 bf = frag_colk_l(vbase + (unsigned)((32 * ks) * RLD + 16 * t) * 2u, RLD * 2, lane); acc[t] = MFMA16(af, bf, acc[t]); } }
    __syncthreads();
#pragma unroll
    for (int r = 0; r < 4; ++r) {
        float s = 0.f;
#pragma unroll
        for (int t = 0; t < 16; ++t) s += acc[t][r];
        s += __shfl_xor(s, 1); s += __shfl_xor(s, 2); s += __shfl_xor(s, 4); s += __shfl_xor(s, 8);
        const float mean = s * (1.0f / 256.0f); float q = 0.f;
#pragma unroll
        for (int t = 0; t < 16; ++t) { const float d = acc[t][r] - mean; q += d * d; }
        q += __shfl_xor(q, 1); q += __shfl_xor(q, 2); q += __shfl_xor(q, 4); q += __shfl_xor(q, 8);
        const float rstd = rsqrtf(q * (1.0f / 256.0f) + LN_EPS);
#pragma unroll
        for (int t = 0; t < 16; ++t) RA[(16 * w + 4 * kq + r) * RLD + 16 * t + fr] = f2bf((acc[t][r] - mean) * rstd);
    }
    __syncthreads();
#pragma unroll
    for (int q = 0; q < 8; ++q) { const int idx = tid + NTHR * q, rr = idx >> 5, c = idx & 31; const size_t row = (size_t)(128 * u + rr);
        const u32x4 o = *(const LAS u32x4*)(RA + rr * RLD + 8 * c), g = *(const u32x4*)(QKV + row * EV_IN + 3072 + 256 * h + 8 * c);
        u32x4 w4;
        w4.x = cvt_pk_bf16(bflo(o.x) * siluf_(bflo(g.x)), bfhi(o.x) * siluf_(bfhi(g.x))); w4.y = cvt_pk_bf16(bflo(o.y) * siluf_(bflo(g.y)), bfhi(o.y) * siluf_(bfhi(g.y)));
        w4.z = cvt_pk_bf16(bflo(o.z) * siluf_(bflo(g.z)), bfhi(o.z) * siluf_(bfhi(g.z))); w4.w = cvt_pk_bf16(bflo(o.w) * siluf_(bflo(g.w)), bfhi(o.w) * siluf_(bfhi(g.w)));
        *(u32x4*)(MIX + row * DM + 256 * h + 8 * c) = w4; }
    __syncthreads();
}

constexpr int KLD = 1032;
__device__ __forceinline__ void s5_output_task(const Params& p, Ctx& C, int bt) {
    const bf16_t* QKV = (const bf16_t*)(p.ws + WS_BIG + BG_QKV); bf16_t* Z = (bf16_t*)(p.ws + WS_Z);
    const bf16_t* KN = (const bf16_t*)(p.ws + WS_KN); const bf16_t* CCt = (const bf16_t*)(p.ws + WS_CC);
    const float* APOW = (const float*)(p.ws + WS_APOW); const float* HST = (const float*)(p.ws + WS_HST); const float* dsk = p.inp(18);
    int tid = C.tid; asm volatile("" : "+v"(tid));
    const int lane = tid & 63, kq = lane >> 4, fr = lane & 15;
    LAS bf16_t* KF = (LAS bf16_t*)C.lds; LAS bf16_t* KB = KF + 16 * KLD;
    LAS bf16_t* U = KB + 16 * KLD + C.wave * 3072;
    LAS float* PW0 = (LAS float*)(KB + 16 * KLD + 8 * 3072);
    LAS float* PW16 = PW0 + 2 * 16 * 128;
    {
        const int g = bt >> 3, k0 = (260 * (bt & 7)) >> 3, k1 = (260 * ((bt & 7) + 1)) >> 3;
#pragma unroll
        for (int q = 0; q < 8; ++q) { const int idx = tid + NTHR * q, dir = idx >> 11, rr = (idx >> 7) & 15, c = idx & 127;
            *(LAS u32x4*)((dir ? KB : KF) + rr * KLD + 8 * c) = *(const u32x4*)(KN + ((size_t)(dir * 64 + g) * 16 + rr) * 1024 + 8 * c); }
        for (int q = lane; q < 192 * 2; q += 64) *(LAS u32x4*)(U + 8 * q) = (u32x4){0u, 0u, 0u, 0u};
#pragma unroll
        for (int q = 0; q < 2; ++q) { const int idx = tid + NTHR * q, dir = idx >> 9, f = (idx >> 5) & 15, c4 = idx & 31;
            *(LAS f32x4*)(PW0 + dir * 2048 + f * 128 + 4 * c4) = *(const f32x4*)(APOW + ((size_t)(dir * 64 + g) * 64 + (dir == 0 ? f : 15 - f)) * 128 + 4 * c4); }
        if (tid < 64) { const int dir = tid >> 5, c4 = tid & 31; *(LAS f32x4*)(PW16 + dir * 128 + 4 * c4) = *(const f32x4*)(APOW + ((size_t)(dir * 64 + g) * 64 + 15) * 128 + 4 * c4); }
        __syncthreads();
        const f32x4 dv = *(const f32x4*)(dsk + 16 * g + 4 * kq);
        bf16x8 ccr[2], cci[2];
#pragma unroll
        for (int hb = 0; hb < 2; ++hb) { ccr[hb] = frag_rowk_g(CCt + (size_t)g * 16 * 128 + 32 * hb, 128, lane); cci[hb] = frag_rowk_g(CCt + (size_t)g * 16 * 128 + 64 + 32 * hb, 128, lane); }
        const LAS float* pw0l = PW0 + (size_t)fr * 128 + 16 * kq;
        const LAS float* pw16l = PW16 + 16 * kq;
        for (int k = k0 + C.wave; k < k1; k += 8) {
            LDS_WAIT(); asm volatile("" ::: "memory");
            for (int q = lane; q < 128; q += 64) { const int t = q >> 1, hf = q & 1;
                *(LAS u32x4*)(U + (64 + t) * 16 + 8 * hf) = *(const u32x4*)(QKV + (size_t)(64 * k + t) * EV_IN + 4096 + 16 * g + 8 * hf); }
            LDS_WAIT(); asm volatile("" ::: "memory");
            const int cf = k, cb = k < 4 ? 3 - k : 263 - k;
            f32x4 acc[4];
#pragma unroll
            for (int tt = 0; tt < 4; ++tt) acc[tt] = (f32x4){0.f, 0.f, 0.f, 0.f};
            const LAS bf16_t* ubf = U + (64 + fr - (kq >> 1)) * 16 + 8 * (kq & 1);
            const LAS bf16_t* ubb = U + (64 + fr + (kq >> 1)) * 16 + 8 * (kq & 1);
#pragma unroll
            for (int n0 = 0; n0 < 64; n0 += 2) {
                const bf16x8 af = frag_rowk_l(KF + n0 * 16, KLD, lane), ab = frag_rowk_l(KB + n0 * 16, KLD, lane);
#pragma unroll
                for (int tt = 0; tt < 4; ++tt) {
                    if (n0 <= 16 * tt + 14) acc[tt] = MFMA16(af, *(const LAS bf16x8*)(ubf + (16 * tt - n0) * 16), acc[tt]);
                    if (n0 <= 62 - 16 * tt) acc[tt] = MFMA16(ab, *(const LAS bf16x8*)(ubb + (16 * tt + n0) * 16), acc[tt]);
                }
                asm volatile("" ::: "memory");
            }
#pragma unroll
            for (int dir = 0; dir < 2; ++dir) {
                const float* hp = HST + ((size_t)(dir * 64 + g) * 260 + (dir == 0 ? cf : cb)) * 128;
#pragma unroll
                for (int hb = 0; hb < 2; ++hb) {
                    float xr[8], xi[8];
#pragma unroll
                    for (int e2 = 0; e2 < 4; ++e2) { const f32x4 h4 = *(const f32x4*)(hp + 2 * (32 * hb + 8 * kq) + 4 * e2), b4 = *(const LAS f32x4*)(pw0l + dir * 2048 + hb * 64 + 4 * e2);
                        xr[2 * e2] = b4[0] * h4[0] - b4[1] * h4[1]; xi[2 * e2] = b4[0] * h4[1] + b4[1] * h4[0];
                        xr[2 * e2 + 1] = b4[2] * h4[2] - b4[3] * h4[3]; xi[2 * e2 + 1] = b4[2] * h4[3] + b4[3] * h4[2]; }
#pragma unroll
                    for (int st = 0; st < 4; ++st) {
                        const int tt = dir == 0 ? st : 3 - st;
                        u32x4 br, bi;
                        br.x = cvt_pk_bf16(xr[0], xr[1]); br.y = cvt_pk_bf16(xr[2], xr[3]); br.z = cvt_pk_bf16(xr[4], xr[5]); br.w = cvt_pk_bf16(xr[6], xr[7]);
                        bi.x = cvt_pk_bf16(xi[0], xi[1]); bi.y = cvt_pk_bf16(xi[2], xi[3]); bi.z = cvt_pk_bf16(xi[4], xi[5]); bi.w = cvt_pk_bf16(xi[6], xi[7]);
                        acc[tt] = MFMA16(ccr[hb], __builtin_bit_cast(bf16x8, br), acc[tt]);
                        acc[tt] = MFMA16(cci[hb], __builtin_bit_cast(bf16x8, bi), acc[tt]);
                        if (st < 3) {
#pragma unroll
                            for (int e2 = 0; e2 < 4; ++e2) { const f32x4 a4 = *(const LAS f32x4*)(pw16l + dir * 128 + hb * 64 + 4 * e2);
                                float t0 = xr[2 * e2] * a4[0] - xi[2 * e2] * a4[1]; xi[2 * e2] = xr[2 * e2] * a4[1] + xi[2 * e2] * a4[0]; xr[2 * e2] = t0;
                                t0 = xr[2 * e2 + 1] * a4[2] - xi[2 * e2 + 1] * a4[3]; xi[2 * e2 + 1] = xr[2 * e2 + 1] * a4[3] + xi[2 * e2 + 1] * a4[2]; xr[2 * e2 + 1] = t0; }
                        }
                    }
                }
            }
#pragma unroll
            for (int tt = 0; tt < 4; ++tt) { const int t = 16 * tt + fr;
                const u32x2 uu = *(const LAS u32x2*)(U + (64 + t) * 16 + 4 * kq);
                const float y0 = acc[tt][0] + bflo(uu.x) * dv[0], y1 = acc[tt][1] + bfhi(uu.x) * dv[1], y2 = acc[tt][2] + bflo(uu.y) * dv[2], y3 = acc[tt][3] + bfhi(uu.y) * dv[3];
                u32x2 w; w.x = cvt_pk_bf16(gelu_tanh(y0), gelu_tanh(y1)); w.y = cvt_pk_bf16(gelu_tanh(y2), gelu_tanh(y3));
                *(u32x2*)(Z + (size_t)(64 * k + t) * 1024 + 16 * g + 4 * kq) = w; }
        }
    }
    __syncthreads();
}

__device__ __forceinline__ void phase_ret_s5_outputs(const Params& p, Ctx& C, LAS unsigned char* misc) {
    unsigned* head = (unsigned*)(p.ws + WS_CTL) + CW_QUEUE;
    volatile LAS int* slot = (volatile LAS int*)(misc + 32);
    for (;;) {
        __syncthreads();
        if (C.tid == 0) slot[0] = (int)atomicAdd(head, 1u);
        __syncthreads();
        const int item = __builtin_amdgcn_readfirstlane(slot[0]);
        if (item >= 520) break;
        ret_output_unit(p, C, item);
    }
    for (;;) {
        __syncthreads();
        if (C.tid == 0) slot[0] = (int)atomicAdd(head + 64, 1u);
        __syncthreads();
        const int item = __builtin_amdgcn_readfirstlane(slot[0]);
        if (item >= 512) break;
        s5_output_task(p, C, item);
    }
}
__device__ __forceinline__ void phase_router(const Params& p, Ctx& C, int L) {
    const float* X1 = (const float*)(p.ws + WS_X1);
    const bf16_t* RWh = (const bf16_t*)(p.ws + WS_RWT) + (size_t)(L * 2 + 0) * 64 * DM; const bf16_t* RWl = (const bf16_t*)(p.ws + WS_RWT) + (size_t)(L * 2 + 1) * 64 * DM;
    const float* rbias = p.inp(27) + L * 64;
    int* cnt = (int*)(p.ws + WS_CTL) + CW_CNT + L * 128; int* LIST = (int*)(p.ws + WS_LIST); float* WGT = (float*)(p.ws + WS_WGT); float* LW = (float*)(p.ws + WS_LW);
    const int lane = C.lane, kq = lane >> 4, fr = lane & 15;
    LAS float* Lg = (LAS float*)(C.lds + C.wave * 8192);
    const int r0 = (L == 0) ? 0 : CTXL, nrows = TT - r0;
    if (C.bid == 0 && C.tid == 0) cnt[64] = nrows;
    for (int task = C.gw; task < nrows / 16; task += C.ngw) {
        const int rbase = r0 + 16 * task, row = rbase + fr;
        const int v = row < CTXL ? 1 : 0;
        const float* xr = X1 + (size_t)row * DM; const float* sc2 = modv(p, L, v, 4); const float* sh2 = modv(p, L, v, 3);
        f32x4 acc[4];
#pragma unroll
        for (int t = 0; t < 4; ++t) acc[t] = (f32x4){0.f, 0.f, 0.f, 0.f};
#pragma unroll 2
        for (int ks = 0; ks < 64; ++ks) { const int c0 = 32 * ks + 8 * kq;
            const f32x4 x0 = *(const f32x4*)(xr + c0), x1 = *(const f32x4*)(xr + c0 + 4);
            const f32x4 a0 = *(const f32x4*)(sc2 + c0), a1 = *(const f32x4*)(sc2 + c0 + 4), b0 = *(const f32x4*)(sh2 + c0), b1 = *(const f32x4*)(sh2 + c0 + 4);
            const f32x4 y0 = x0 * (a0 + 1.0f) + b0, y1 = x1 * (a1 + 1.0f) + b1;
            u32x4 hi; hi.x = cvt_pk_bf16(y0[0], y0[1]); hi.y = cvt_pk_bf16(y0[2], y0[3]); hi.z = cvt_pk_bf16(y1[0], y1[1]); hi.w = cvt_pk_bf16(y1[2], y1[3]);
            u32x4 lo; lo.x = cvt_pk_bf16(y0[0] - bflo(hi.x), y0[1] - bfhi(hi.x)); lo.y = cvt_pk_bf16(y0[2] - bflo(hi.y), y0[3] - bfhi(hi.y));
            lo.z = cvt_pk_bf16(y1[0] - bflo(hi.z), y1[1] - bfhi(hi.z)); lo.w = cvt_pk_bf16(y1[2] - bflo(hi.w), y1[3] - bfhi(hi.w));
            const bf16x8 ah = __builtin_bit_cast(bf16x8, hi), al = __builtin_bit_cast(bf16x8, lo);
#pragma unroll
            for (int t = 0; t < 4; ++t) { const bf16x8 bh = frag_rowk_g(RWh + (size_t)(16 * t) * DM + 32 * ks, DM, lane), bl = frag_rowk_g(RWl + (size_t)(16 * t) * DM + 32 * ks, DM, lane);
                acc[t] = MFMA16(ah, bh, acc[t]); acc[t] = MFMA16(al, bh, acc[t]); acc[t] = MFMA16(ah, bl, acc[t]); } }
        LDS_WAIT(); asm volatile("" ::: "memory");
#pragma unroll
        for (int t = 0; t < 4; ++t)
#pragma unroll
            for (int r = 0; r < 4; ++r) Lg[(4 * kq + r) * 65 + 16 * t + fr] = acc[t][r];
        LDS_WAIT(); asm volatile("" ::: "memory");
        if (lane < 16) {
            LAS float* sr = Lg + lane * 65; const int trow = rbase + lane;
            float gs[8];
#pragma unroll
            for (int g = 0; g < 8; ++g) { float m1 = -1e30f, m2 = -1e30f;
                for (int j = 0; j < 8; ++j) { const int e = 8 * g + j; const float s = sigmoidf_(sr[e]); sr[e] = s; const float vv = s + rbias[e];
                    if (vv > m1) { m2 = m1; m1 = vv; } else if (vv > m2) m2 = vv; }
                gs[g] = m1 + m2; }
            unsigned gmask = 0u;
#pragma unroll
            for (int it = 0; it < 4; ++it) { float best = -1e30f; int bi = 0;
#pragma unroll
                for (int g = 0; g < 8; ++g) { const bool ok = !((gmask >> g) & 1u) && gs[g] > best; best = ok ? gs[g] : best; bi = ok ? g : bi; }
                gmask |= 1u << bi; }
            unsigned long long taken = 0ull; int sel[8]; float sw[8]; float wsum = 0.f;
#pragma unroll
            for (int k = 0; k < 8; ++k) { float best = -1e30f; int bi = 0;
                for (int e = 0; e < 64; ++e) { const bool cand = ((gmask >> (e >> 3)) & 1u) && !((taken >> e) & 1ull); const float vv = sr[e] + rbias[e];
                    if (cand && vv > best) { best = vv; bi = e; } }
                taken |= 1ull << bi; sel[k] = bi; sw[k] = sr[bi]; wsum += sw[k]; }
            const float inv = 2.5f / wsum;
#pragma unroll
            for (int k = 0; k < 8; ++k) { const int a = trow * 8 + k; const int pos = atomicAdd(&cnt[sel[k]], 1);
                LIST[(size_t)sel[k] * TT + pos] = a; WGT[a] = sw[k] * inv; LW[(size_t)sel[k] * TT + pos] = sw[k] * inv; }
            LIST[(size_t)64 * TT + (trow - r0)] = 8 * TT + trow; LW[(size_t)64 * TT + (trow - r0)] = 1.0f;
        }
    }
}
namespace att {
constexpr int D = 128, NW = 8, QBLK = 32, KVBLK = 64;
constexpr float SCALE = 0.088388347648318440f;
constexpr float THR = 8.f;
constexpr int SHM_V = KVBLK * D * 2, SHM_K = KVBLK * D * 2, SHM_ATTN = 2 * SHM_V + 2 * SHM_K + NW * 64 * 4;
#define KSWZ(row, colB) ((row) * 256 + ((colB) ^ (((row) & 7) << 4)))
#define SBAR() __builtin_amdgcn_sched_barrier(0)
__device__ __forceinline__ int crow(int r, int hi) { return (r & 3) + 8 * (r >> 2) + 4 * hi; }
__device__ __forceinline__ unsigned cvtpk(float lo, float hi) { unsigned r; asm volatile("v_cvt_pk_bf16_f32 %0, %1, %2" : "=v"(r) : "v"(lo), "v"(hi)); return r; }

__device__ __forceinline__ void partialSM(f32x16& p0, f32x16& p1, float& m_reg, float& mn, float& alpha) {
  constexpr float Cc = SCALE * 1.4426950408889634f;
  float pmax = p0[0]; for (int r = 1; r < 16; ++r) pmax = fmaxf(pmax, p0[r]); for (int r = 0; r < 16; ++r) pmax = fmaxf(pmax, p1[r]);
  { auto rr = __builtin_amdgcn_permlane32_swap(__float_as_uint(pmax), __float_as_uint(pmax), false, false);
    pmax = fmaxf(__uint_as_float(rr[0]), __uint_as_float(rr[1])); }
  if (__builtin_expect(__all(pmax - m_reg <= THR / SCALE), 1)) { mn = m_reg; alpha = 1.f; }
  else { mn = fmaxf(m_reg, pmax); alpha = __builtin_amdgcn_exp2f((m_reg - mn) * Cc); m_reg = mn; }
  float mnC = -mn * Cc;
  for (int r = 0; r < 16; ++r) p0[r] = fmaf(p0[r], Cc, mnC); for (int r = 0; r < 16; ++r) p1[r] = fmaf(p1[r], Cc, mnC);
  for (int r = 0; r < 16; ++r) p0[r] = __builtin_amdgcn_exp2f(p0[r]);
}
__device__ __forceinline__ void finishSM(f32x16& p0, f32x16& p1, float alpha, float& l_reg, bf16x8& pa0, bf16x8& pa1, bf16x8& pa2, bf16x8& pa3) {
  for (int r = 0; r < 16; ++r) p1[r] = __builtin_amdgcn_exp2f(p1[r]);
  float ps = 0; for (int r = 0; r < 16; ++r) ps += p0[r]; for (int r = 0; r < 16; ++r) ps += p1[r];
  { auto rr = __builtin_amdgcn_permlane32_swap(__float_as_uint(ps), __float_as_uint(ps), false, false);
    ps = __uint_as_float(rr[0]) + __uint_as_float(rr[1]); }
  l_reg = l_reg * alpha + ps;
#define PK4(P, BASE, OUT) do { unsigned a0 = cvtpk(P[BASE + 0], P[BASE + 1]), a1 = cvtpk(P[BASE + 2], P[BASE + 3]);   \
    unsigned b0 = cvtpk(P[BASE + 4], P[BASE + 5]), b1 = cvtpk(P[BASE + 6], P[BASE + 7]);                              \
    auto r0 = __builtin_amdgcn_permlane32_swap(a0, b0, false, false); auto r1 = __builtin_amdgcn_permlane32_swap(a1, b1, false, false); \
    u32x4 w = {r0[0], r1[0], r0[1], r1[1]}; OUT = *reinterpret_cast<bf16x8*>(&w); } while (0)
  PK4(p0, 0, pa0); PK4(p0, 8, pa1); PK4(p1, 0, pa2); PK4(p1, 8, pa3);
#undef PK4
}
__device__ __forceinline__ void qkt(f32x16& p0, f32x16& p1, const LAS char* Ks, const bf16x8* qr, int r32, int hi) {
  p0 = f32x16{}; p1 = f32x16{};
  for (int d0 = 0; d0 < 8; ++d0) { int cb = (d0 * 16 + hi * 8) * 2;
    bf16x8 b0 = *reinterpret_cast<const LAS bf16x8*>(Ks + KSWZ(r32, cb));
    bf16x8 b1 = *reinterpret_cast<const LAS bf16x8*>(Ks + KSWZ(32 + r32, cb));
    p0 = __builtin_amdgcn_mfma_f32_32x32x16_bf16(b0, qr[d0], p0, 0, 0, 0);
    p1 = __builtin_amdgcn_mfma_f32_32x32x16_bf16(b1, qr[d0], p1, 0, 0, 0); }
}
__device__ __forceinline__ int v_st(int k, int c) { const int kk = (k & ~0xC) | ((k & 4) << 1) | ((k & 8) >> 1); return ((kk >> 3) * 4 + (c >> 5)) * 512 + ((kk & 7) * 32 + (c & 31)) * 2; }
__device__ __forceinline__ int v_rd_base(int lane) { return ((lane & 3) << 3) | (((lane >> 2) & 3) << 6) | (((lane >> 4) & 1) << 5) | (((lane >> 5) & 1) << 8); }
constexpr int v_rd_off(int d0, int ks, int half) { return d0 * 512 + ks * 4096 + half * 2048; }
template <int OFF> __device__ __forceinline__ s16x4 tr_read(int vb) {
  s16x4 r; asm volatile("ds_read_b64_tr_b16 %0, %1 offset:%2" : "=&v"(r) : "v"(vb), "i"(OFF) : "memory"); return r;
}
template <int D0> __device__ __forceinline__ void pv_one(f32x16& od, int vb, bf16x8 pa0, bf16x8 pa1, bf16x8 pa2, bf16x8 pa3) {
  const s16x4 l0 = tr_read<v_rd_off(D0, 0, 0)>(vb), h0 = tr_read<v_rd_off(D0, 0, 1)>(vb), l1 = tr_read<v_rd_off(D0, 1, 0)>(vb), h1 = tr_read<v_rd_off(D0, 1, 1)>(vb);
  const s16x4 l2 = tr_read<v_rd_off(D0, 2, 0)>(vb), h2 = tr_read<v_rd_off(D0, 2, 1)>(vb), l3 = tr_read<v_rd_off(D0, 3, 0)>(vb), h3 = tr_read<v_rd_off(D0, 3, 1)>(vb);
  asm volatile("s_waitcnt lgkmcnt(0)" ::: "memory"); SBAR();
#define PK(L, H) (bf16x8){L[0], L[1], L[2], L[3], H[0], H[1], H[2], H[3]}
  od = __builtin_amdgcn_mfma_f32_32x32x16_bf16(pa0, PK(l0, h0), od, 0, 0, 0);
  od = __builtin_amdgcn_mfma_f32_32x32x16_bf16(pa1, PK(l1, h1), od, 0, 0, 0);
  od = __builtin_amdgcn_mfma_f32_32x32x16_bf16(pa2, PK(l2, h2), od, 0, 0, 0);
  od = __builtin_amdgcn_mfma_f32_32x32x16_bf16(pa3, PK(l3, h3), od, 0, 0, 0);
#undef PK
}
__device__ __forceinline__ void pv_d0(f32x16* o, int vb, bf16x8 pa0, bf16x8 pa1, bf16x8 pa2, bf16x8 pa3) {
  pv_one<0>(o[0], vb, pa0, pa1, pa2, pa3); pv_one<1>(o[1], vb, pa0, pa1, pa2, pa3); pv_one<2>(o[2], vb, pa0, pa1, pa2, pa3); pv_one<3>(o[3], vb, pa0, pa1, pa2, pa3);
}

template <int LDQ, int LDK, int LDO>
__device__ __forceinline__ void attn_dense_body(const bf16_t* __restrict__ Qb, const bf16_t* __restrict__ Kh, const bf16_t* __restrict__ Vh, bf16_t* __restrict__ Ob, int seq, LAS char* lds, int tid) {
  const int wid = tid >> 6, lane = tid & 63, r32 = lane & 31, hi = lane >> 5;
  LAS char* V_lds = lds; LAS char* K_lds = lds + 2 * SHM_V;
  LAS float* ws = (LAS float*)(lds + 2 * SHM_V + 2 * SHM_K) + wid * 64; LAS float* li_l = ws; LAS float* al_l = ws + 32;
  float m_reg = -1e30f, l_reg = 0; f32x16 o[4] = {}; bf16x8 qr[8];
  const bf16_t* Qw = Qb + (long)(wid * QBLK + r32) * LDQ + hi * 8;
#pragma unroll
  for (int d0 = 0; d0 < 8; ++d0) qr[d0] = *reinterpret_cast<const bf16x8*>(Qw + d0 * 16);
  const int sr = tid >> 4, sc = (tid & 15) * 8, vst0 = v_st(sr, sc), vst1 = v_st(32 + sr, sc);
  const int vb0 = (int)(uintptr_t)V_lds + v_rd_base(lane);
  struct { bf16x8 vs0, vs1, ks0, ks1; } sr_[2];
#define SLOAD(i, k0) do { sr_[i].vs0 = *reinterpret_cast<const bf16x8*>(&Vh[(long)((k0) + sr) * LDK + sc]); sr_[i].vs1 = *reinterpret_cast<const bf16x8*>(&Vh[(long)((k0) + 32 + sr) * LDK + sc]); \
    sr_[i].ks0 = *reinterpret_cast<const bf16x8*>(&Kh[(long)((k0) + sr) * LDK + sc]); sr_[i].ks1 = *reinterpret_cast<const bf16x8*>(&Kh[(long)((k0) + 32 + sr) * LDK + sc]); } while (0)
#define SWRITE(b, i) do { *(LAS bf16x8*)(V_lds + (b) * SHM_V + vst0) = sr_[i].vs0;          \
    *(LAS bf16x8*)(V_lds + (b) * SHM_V + vst1) = sr_[i].vs1; int kc = sc * 2;               \
    *(LAS bf16x8*)(K_lds + (b) * SHM_K + KSWZ(sr, kc)) = sr_[i].ks0;                       \
    *(LAS bf16x8*)(K_lds + (b) * SHM_K + KSWZ(32 + sr, kc)) = sr_[i].ks1; } while (0)
#define SWAIT() asm volatile("s_waitcnt vmcnt(4)" ::: "memory")
#define RESC(a) do { if (__any((a) < 1.f)) { if (hi == 0) al_l[r32] = (a); asm volatile("s_waitcnt lgkmcnt(0)" ::: "memory"); \
    for (int d = 0; d < 4; ++d) for (int r = 0; r < 16; ++r) o[d][r] *= al_l[crow(r, hi)]; } } while (0)
  f32x16 pA0, pA1, pB0, pB1; float mnA, mnB, alA, alB; bf16x8 pa0, pa1, pa2, pa3; const int NT = seq / KVBLK;
  constexpr int SE = 0, SO = 1;
  SLOAD(SE, 0); asm volatile("s_waitcnt vmcnt(0)" ::: "memory"); SWRITE(0, SE); __syncthreads();
  qkt(pA0, pA1, K_lds, qr, r32, hi); partialSM(pA0, pA1, m_reg, mnA, alA);
  SLOAD(SO, KVBLK); if (2 < NT) SLOAD(SE, 2 * KVBLK);
  SWAIT(); SWRITE(1, SO); __syncthreads();
  for (int j = 1; j + 1 < NT; j += 2) {
    SBAR(); qkt(pB0, pB1, K_lds + SHM_K, qr, r32, hi);
    finishSM(pA0, pA1, alA, l_reg, pa0, pa1, pa2, pa3); SBAR();
    SLOAD(SO, (j + 2) * KVBLK); SBAR();
    pv_d0(o, vb0, pa0, pa1, pa2, pa3); partialSM(pB0, pB1, m_reg, mnB, alB);
    __syncthreads(); SWAIT(); SWRITE(0, SE);
    RESC(alB); __syncthreads();
    SBAR(); qkt(pA0, pA1, K_lds, qr, r32, hi);
    finishSM(pB0, pB1, alB, l_reg, pa0, pa1, pa2, pa3); SBAR();
    if (j + 3 < NT) SLOAD(SE, (j + 3) * KVBLK); SBAR();
    pv_d0(o, vb0 + (int)SHM_V, pa0, pa1, pa2, pa3); partialSM(pA0, pA1, m_reg, mnA, alA);
    __syncthreads(); SWAIT(); SWRITE(1, SO);
    RESC(alA); __syncthreads();
  }
  SBAR(); qkt(pB0, pB1, K_lds + SHM_K, qr, r32, hi);
  finishSM(pA0, pA1, alA, l_reg, pa0, pa1, pa2, pa3); SBAR();
  pv_d0(o, vb0, pa0, pa1, pa2, pa3); partialSM(pB0, pB1, m_reg, mnB, alB);
  __syncthreads(); RESC(alB);
  finishSM(pB0, pB1, alB, l_reg, pa0, pa1, pa2, pa3); SBAR();
  pv_d0(o, vb0 + (int)SHM_V, pa0, pa1, pa2, pa3);
  if (hi == 0) li_l[r32] = l_reg; asm volatile("s_waitcnt lgkmcnt(0)" ::: "memory");
  float rli[16];
#pragma unroll
  for (int r = 0; r < 16; ++r) rli[r] = __builtin_amdgcn_rcpf(li_l[crow(r, hi)]);
  bf16_t* Ow = Ob + (long)(wid * QBLK) * LDO;
#pragma unroll
  for (int r = 0; r < 16; ++r) { int orow = crow(r, hi);
    for (int d0 = 0; d0 < 4; ++d0) Ow[(long)orow * LDO + d0 * 32 + r32] = (bf16_t)(cvtpk(o[d0][r] * rli[r], 0.f) & 0xffffu); }
#undef SLOAD
#undef SWRITE
#undef SWAIT
#undef RESC
}
#undef KSWZ
}

__device__ __forceinline__ void phase_attention(const Params& p, Ctx& C) {
    const bf16_t* QKV = (const bf16_t*)(p.ws + WS_BIG + BG_QKV); bf16_t* ATT = (bf16_t*)(p.ws + WS_BIG + BG_ATT);
    const int nunits = 24 * 64;
    for (int i = 0;; ++i) {
        int unit;
        if (C.G == 256) { const int xcd = C.bid & 7, slot = C.bid >> 3; if (i >= 6) break; unit = (xcd * 3 + (i >> 1)) * 64 + (i & 1) * 32 + slot; }
        else { unit = i * C.G + C.bid; if (unit >= nunits) break; }
        const int prob = unit >> 6, qb = unit & 63;
        int qc, kc, vc, oc;
        if (prob < 8) { qc = 128 * prob; kc = 1024 + 128 * (prob >> 2); vc = 1280 + 128 * (prob >> 2); oc = 128 * prob; }
        else { const int d = prob - 8, h = d >> 2, m = (d >> 1) & 1, vh = d & 1; qc = 1536 + 256 * h + 128 * m; kc = 2560 + 256 * h + 128 * m; vc = 3584 + 256 * h + 128 * vh; oc = 1024 + 1024 * m + 256 * h + 128 * vh; }
        __syncthreads();
        att::attn_dense_body<OD_IN, OD_IN, 3072>(QKV + (size_t)(CTXL + 256 * qb) * OD_IN + qc, QKV + kc, QKV + vc, ATT + (size_t)(256 * qb) * 3072 + oc, TT, (LAS char*)C.lds, C.tid);
    }
    __syncthreads();
}
constexpr int PH_PER_LAYER = 13, N_PHASES = 2 + 2 * PH_PER_LAYER;
#ifndef DBL_PHASE
#define DBL_PHASE -1
#endif
#ifndef MK_PER_PHASE
#define MK_PER_PHASE 0
#endif

template <int L>
__device__ __forceinline__ void layer_body(const Params& p, Ctx& C0, const XcdBarrier& bar, LAS unsigned char* misc, int lo, int hi) {
#define IN(k) (lo <= (k) && (k) < hi)
#define SEAM(k) do { if (IN(k) && IN((k) + 1)) xcd_barrier(bar, C0.wave); } while (0)
#define PHASE(k, ...) if (IN(k)) { FRESH(); __VA_ARGS__ } if (DBL_PHASE == (k)) { xcd_barrier(bar, C0.wave); { FRESH(); __VA_ARGS__ } } SEAM(k);
#define FRESH() Ctx C = C0; { int ln = (int)__builtin_amdgcn_mbcnt_hi(~0u, __builtin_amdgcn_mbcnt_lo(~0u, 0u)); asm volatile("" : "+v"(ln)); C.lane = ln; C.tid = C.wave * 64 + ln; }
        const int b = 2 + PH_PER_LAYER * L;
        bf16_t* QKV = (bf16_t*)(p.ws + WS_BIG + BG_QKV);
        bf16_t* XA = (bf16_t*)(p.ws + WS_XA);
        int* cnt = (int*)(p.ws + WS_CTL) + CW_CNT + L * 128; const int* LIST = (const int*)(p.ws + WS_LIST);
        PHASE(b + 0, phase_modulate(p, C, L); )
        PHASE(b + 1,
            const int N = L ? OD_IN : EV_IN;
            pg8::DenseOrder S; S.init8((const void*)XA, DM, (const void*)(p.ws + (L ? WS_WIN1 : WS_WIN0)), TT, N, DM, C.G, C.bid);
            pg8::EpiStore E{QKV, N, 1.0f / 32.0f};
            pg8::gemm_phase<true>(C.lds, S, E, C.wave);
        )
        PHASE(b + 2, if (L == 0) phase_rope0(p, C); else phase_normrope1(p, C); )
        PHASE(b + 3, if (L == 0) { ret_chunk_kv(p, C); s5_end_states(p, C); } else phase_attention(p, C); )
        PHASE(b + 4, if (L == 0) phase_scans(p, C); else phase_merge1(p, C); )
        if (L == 0) {
            PHASE(b + 5, phase_ret_s5_outputs(p, C, misc); )
            PHASE(b + 6,
                pg8::DenseOrder S; S.init((const bf16_t*)(p.ws + WS_Z), 1024, (const bf16_t*)(p.ws + WS_WGLU), TT, 1024, 1024, C.G, C.bid);
                pg8::EpiGlu E{(const bf16_t*)(p.ws + WS_Z), p.inp(20), (bf16_t*)(p.ws + WS_BIG + BG_MIX)};
                pg8::gemm_phase<false>(C.lds, S, E, C.wave);
            )
        }
        PHASE(b + 7,
            pg8::DenseOrder S;
            if (L == 0) S.init((const bf16_t*)(p.ws + WS_BIG + BG_MIX), DM, (const bf16_t*)(p.ws + WS_WOUT0), TT, DM, DM, C.G, C.bid);
            else S.init((const bf16_t*)(p.ws + WS_BIG + BG_ATT), 3072, (const bf16_t*)(p.ws + WS_WOUT1), SEQ, DM, DM, C.G, C.bid);
            pg8::EpiStore E{(bf16_t*)(p.ws + WS_YMIX) + (L ? (size_t)CTXL * DM : 0), DM, 1.0f};
            pg8::gemm_phase<false>(C.lds, S, E, C.wave);
        )
        PHASE(b + 8, phase_ln1(p, C, L); )
        PHASE(b + 9, phase_router(p, C, L); )
        PHASE(b + 10,
            pg8::MoeOrder<0> S; S.A = (const void*)XA; S.Bt = (const void*)(p.ws + WS_GU); S.list = LIST; S.cnt = cnt; S.ldab = DM; S.kb = DM; S.nN = 4; S.G = C.G; S.c = C.bid; S.bstride = (size_t)1024 * DM;
            S.prep(misc, C.tid);
            pg8::EpiE1 E{(unsigned char*)(p.ws + WS_HX2), LIST, S.cn};
            pg8::gemm_phase<true>(C.lds, S, E, C.wave);
        )
        PHASE(b + 11,
            pg8::MoeOrder<1> S; S.A = (const void*)(p.ws + WS_HX2); S.Bt = (const void*)(p.ws + WS_DT); S.list = LIST; S.cnt = cnt; S.ldab = EHID; S.kb = EHID; S.nN = 8; S.G = C.G; S.c = C.bid; S.bstride = (size_t)DM * EHID;
            S.prep(misc, C.tid);
            pg8::EpiE2 E{(unsigned char*)(p.ws + WS_BIG + BG_YMOE), LIST, (const float*)(p.ws + WS_LW), S.cn};
            pg8::gemm_phase<true>(C.lds, S, E, C.wave);
        )
        PHASE(b + 12, phase_combine(p, C, L); )
    #undef IN
#undef SEAM
#undef FRESH
#undef PHASE
}

__global__ void __launch_bounds__(NTHR, 2) mega_fwd(KArgs ka) {
    extern __shared__ __attribute__((aligned(16))) unsigned char lds_raw[];
    Ctx C;
    C.lds = (LAS unsigned char*)lds_raw;
    C.tid = threadIdx.x; C.lane = C.tid & 63; C.wave = __builtin_amdgcn_readfirstlane(C.tid >> 6);
    C.G = gridDim.x; C.bid = blockIdx.x; C.gw = C.bid * NWAVES + C.wave; C.ngw = C.G * NWAVES;
    LAS unsigned char* misc = C.lds + MISC_OFF;
    if (C.tid < 8) ((volatile LAS unsigned*)misc)[C.tid] = 0u;
    Params p; p.out = ka.out; p.ws = ka.ws; p.ph_lo = ka.ph_lo; p.ph_hi = ka.ph_hi; p.ptab = (LAS unsigned long long*)(misc + 1024);
    if (C.tid < 34) p.ptab[C.tid] = (unsigned long long)ka.in[C.tid];
    __syncthreads();
    const int lo = p.ph_lo, hi = p.ph_hi;
    XcdBarrier bar; bar.bar = (unsigned*)(p.ws + WS_CTL) + CW_BAR; bar.x = 0; bar.st = (volatile LAS unsigned*)misc;
    if (hi - lo > 1) bar = xcd_barrier_post((unsigned*)(p.ws + WS_CTL) + CW_BAR, (volatile LAS unsigned*)misc);
#define IN(k) (lo <= (k) && (k) < hi)
#define SEAM(k) do { if (IN(k) && IN((k) + 1)) xcd_barrier(bar, C.wave); } while (0)

    if (IN(0)) { phase_p0(p, C); } SEAM(0);
    if (IN(1)) { phase_p1(p, C); } SEAM(1);
    if (IN(0) && IN(2) && (C.G & 7) == 0) {
        volatile LAS unsigned* st = (volatile LAS unsigned*)misc;
        if (C.tid == 0) { unsigned pre = 0u; const unsigned x = st[3];
            for (unsigned j = 0; j < 16; ++j) { const unsigned cj = xb_ld(&bar.bar[XB_XCNT(j)]); pre += (j < x) ? cj : 0u; }
            st[4] = pre + st[2]; }
        __syncthreads();
        const int vcu = (int)st[4], g8 = C.G >> 3;
        C.bid = __builtin_amdgcn_readfirstlane((vcu % g8) * 8 + vcu / g8); C.gw = C.bid * NWAVES + C.wave;
    }

    layer_body<0>(p, C, bar, misc, lo, hi);
    layer_body<1>(p, C, bar, misc, lo, hi);
#undef IN
#undef SEAM
}

extern "C" void kernel_launch(void* const* d_in, const int* in_sizes, int n_in, void* d_out, int out_size, void* d_ws, size_t ws_size, hipStream_t stream) {
    static int grid = 0;
    if (grid == 0) {
        if (n_in != 34 || out_size != SEQ * DM || ws_size < WS_END) { fprintf(stderr, "kernel_launch: unexpected shapes: n_in %d out %d ws %zu (need %zu)\n", n_in, out_size, ws_size, (size_t)WS_END); grid = -1; return; }
        int dev = 0, cus = 0, per_cu = 0;
        if (hipGetDevice(&dev) != hipSuccess || hipDeviceGetAttribute(&cus, hipDeviceAttributeMultiprocessorCount, dev) != hipSuccess) { grid = -1; return; }
        if (hipFuncSetAttribute((const void*)mega_fwd, hipFuncAttributeMaxDynamicSharedMemorySize, LDS_BYTES) != hipSuccess) { fprintf(stderr, "kernel_launch: hipFuncSetAttribute failed\n"); grid = -1; return; }
        if (hipOccupancyMaxActiveBlocksPerMultiprocessor(&per_cu, (const void*)mega_fwd, NTHR, LDS_BYTES) != hipSuccess || per_cu < 1) { fprintf(stderr, "kernel_launch: occupancy query says %d blocks per CU\n", per_cu); grid = -1; return; }
        (void)hipGetLastError();
        grid = cus;
    }
    if (grid < 0) return;
    (void)hipMemsetAsync((char*)d_ws + WS_CTL, 0, CTL_BYTES, stream);
    KArgs p{};
    for (int i = 0; i < 34; ++i) p.in[i] = (const float*)d_in[i];
    p.out = (float*)d_out; p.ws = (unsigned char*)d_ws;
#if MK_PER_PHASE
    for (int ph = 0; ph < N_PHASES; ++ph) {
        if (ph == 2 + PH_PER_LAYER + 5 || ph == 2 + PH_PER_LAYER + 6) continue;
        p.ph_lo = ph; p.ph_hi = ph + 1;
        hipLaunchKernelGGL(mega_fwd, dim3(grid), dim3(NTHR), LDS_BYTES, stream, p);
    }
#else
    p.ph_lo = 0; p.ph_hi = N_PHASES;
    hipLaunchKernelGGL(mega_fwd, dim3(grid), dim3(NTHR), LDS_BYTES, stream, p);
#endif
    const hipError_t le = hipPeekAtLastError();
    if (le != hipSuccess) fprintf(stderr, "kernel_launch: launch failed: %s\n", hipGetErrorName(le));
}
```

```cpp
#define MK_PER_PHASE 0
#include <hip/hip_runtime.h>
#include <cstdio>
#include <cstdint>

#define GAS __attribute__((address_space(1)))
#define LAS __attribute__((address_space(3)))
typedef unsigned short bf16_t;
typedef short bf16x8 __attribute__((ext_vector_type(8)));
typedef short s16x4 __attribute__((ext_vector_type(4)));
typedef float f32x4 __attribute__((ext_vector_type(4)));
typedef float f32x2 __attribute__((ext_vector_type(2)));
typedef float f32x16 __attribute__((ext_vector_type(16)));
typedef unsigned u32x4 __attribute__((ext_vector_type(4)));
typedef unsigned u32x2 __attribute__((ext_vector_type(2)));

constexpr int DM = 2048, SEQ = 16384, CTXL = 256, TT = SEQ + CTXL;
constexpr int NEXP = 64, NEX1 = 65, EHID = 512, TOPK = 8;
constexpr int EV_IN = 5120, OD_IN = 4608;
constexpr float LN_EPS = 1e-6f;
constexpr float ALPHA = 1.4142135623730951f;
constexpr float LAMBDA_INIT = 0.35550906759f;
constexpr int NTHR = 512, NWAVES = 8;

constexpr size_t al256(size_t x) { return (x + 255) / 256 * 256; }
constexpr size_t WS_CTL   = 0;
constexpr size_t CTL_BYTES = 1u << 20;
constexpr size_t WS_MODP  = WS_CTL + CTL_BYTES;
constexpr size_t WS_MODF  = WS_MODP + al256((size_t)2 * 32 * 2 * 12288 * 4);
constexpr size_t WS_ROPE128 = WS_MODF + al256((size_t)2 * 2 * 12288 * 4);
constexpr size_t WS_ROPE64  = WS_ROPE128 + al256((size_t)256 * 64 * 2 * 4);
constexpr size_t WS_KN    = WS_ROPE64 + al256((size_t)256 * 32 * 2 * 4);
constexpr size_t WS_WT    = WS_KN + al256((size_t)2 * 64 * 16 * 1024 * 2);
constexpr size_t WS_APOW  = WS_WT + al256((size_t)2 * 64 * 128 * 1024 * 2);
constexpr size_t WS_AL    = WS_APOW + al256((size_t)2 * 64 * 64 * 128 * 4);
constexpr size_t WS_CC    = WS_AL + al256((size_t)2 * 64 * 128 * 4);
constexpr size_t WS_S5E   = WS_CC + al256((size_t)64 * 16 * 128 * 2);
constexpr size_t WS_HST   = WS_S5E + al256((size_t)2 * 64 * 260 * 128 * 4);
constexpr size_t WS_WIN0  = WS_HST + al256((size_t)2 * 64 * 260 * 128 * 4);
constexpr size_t WS_WOUT0 = WS_WIN0 + al256((size_t)EV_IN * DM * 2);
constexpr size_t WS_WGLU  = WS_WOUT0 + al256((size_t)DM * DM * 2);
constexpr size_t WS_WIN1  = WS_WGLU + al256((size_t)1024 * 1024 * 2);
constexpr size_t WS_WOUT1 = WS_WIN1 + al256((size_t)OD_IN * DM * 2);
constexpr size_t WS_RWT   = WS_WOUT1 + al256((size_t)DM * DM * 2);
constexpr size_t WS_GU    = WS_RWT + al256((size_t)2 * 2 * 64 * DM * 2);
constexpr size_t WS_DT    = WS_GU + al256((size_t)NEX1 * 1024 * DM * 2);
constexpr size_t WS_XA    = WS_DT + al256((size_t)NEX1 * DM * EHID * 2);
constexpr size_t WS_Z     = WS_XA + al256((size_t)TT * DM * 2);
constexpr size_t WS_YMIX  = WS_Z + al256((size_t)TT * 1024 * 2);
constexpr size_t WS_X1    = WS_YMIX + al256((size_t)TT * DM * 2);
constexpr size_t WS_HX2   = WS_X1 + al256((size_t)TT * DM * 4);
constexpr size_t WS_LIST  = WS_HX2 + al256((size_t)9 * TT * EHID * 2);
constexpr size_t WS_WGT   = WS_LIST + al256((size_t)NEX1 * TT * 4);
constexpr size_t WS_LW    = WS_WGT + al256((size_t)8 * TT * 4);
constexpr size_t WS_BIG   = WS_LW + al256((size_t)NEX1 * TT * 4);
constexpr size_t BG_QKV   = 0;
constexpr size_t BG_CKV   = BG_QKV + al256((size_t)TT * EV_IN * 2);
constexpr size_t BG_SPREV = BG_CKV + al256((size_t)8 * 130 * 65536 * 4);
constexpr size_t BG_MIX   = BG_SPREV + al256((size_t)8 * 130 * 65536 * 2);
constexpr size_t BG_END0  = BG_MIX + al256((size_t)TT * DM * 2);
constexpr size_t BG_ATT   = BG_CKV;
constexpr size_t BG_YMOE  = 0;
constexpr size_t BG_END1  = al256((size_t)9 * TT * DM * 2);
constexpr size_t BG_SIZE  = BG_END0 > BG_END1 ? BG_END0 : BG_END1;
constexpr size_t WS_END   = WS_BIG + BG_SIZE;

constexpr int CW_BAR = 4096;
constexpr int CW_CNT = 16384;
constexpr int CW_QUEUE = 20480;

constexpr int RING_BYTES = 139264;
constexpr int MISC_OFF = RING_BYTES;
constexpr int LDS_BYTES = 147456;

typedef __bf16 bf16x2_t __attribute__((ext_vector_type(2)));
__device__ __forceinline__ unsigned cvt_pk_bf16(float lo, float hi) { const f32x2 v = {lo, hi}; return __builtin_bit_cast(unsigned, __builtin_convertvector(v, bf16x2_t)); }
__device__ __forceinline__ bf16_t f2bf(float f) { unsigned u = __builtin_bit_cast(unsigned, f); return (bf16_t)((u + 0x7fffu + ((u >> 16) & 1u)) >> 16); }
__device__ __forceinline__ float bf2f(bf16_t b) { return __builtin_bit_cast(float, ((unsigned)b) << 16); }
__device__ __forceinline__ float bflo(unsigned w) { return __builtin_bit_cast(float, w << 16); }
__device__ __forceinline__ float bfhi(unsigned w) { return __builtin_bit_cast(float, w & 0xffff0000u); }
__device__ __forceinline__ float wave_sum(float v) {
#pragma unroll
    for (int o = 1; o < 64; o <<= 1) v += __shfl_xor(v, o);
    return v;
}
__device__ __forceinline__ float fast_exp(float x) { return __builtin_amdgcn_exp2f(x * 1.4426950408889634f); }
__device__ __forceinline__ float sigmoidf_(float x) { return 1.0f / (1.0f + __expf(-x)); }
__device__ __forceinline__ float siluf_(float x) { return x / (1.0f + __expf(-x)); }
__device__ __forceinline__ float gelu_tanh(float x) {
    const float u = 0.7978845608028654f * (x + 0.044715f * x * x * x);
    const float e = __expf(2.0f * u);
    const float t = 1.0f - 2.0f / (e + 1.0f);
    return 0.5f * x * (1.0f + t);
}
#define LDS_WAIT() asm volatile("s_waitcnt lgkmcnt(0)" ::: "memory")
#define VM_WAIT() asm volatile("s_waitcnt vmcnt(0)" ::: "memory")

#define XB_TMO      128
#define XB_XCNT(j)  (256  + 64 * (j))
#define XB_XSUB(j)  (1280 + 64 * (j))
#define XB_XGEN(j)  (2304 + 64 * (j))
#define XB_TOP      3328
#define XB_TOPGEN   3392
#define XCD_BAR_WORDS 3456
#define XB_SPIN_CAP (1u << 22)

__device__ __forceinline__ unsigned xb_ld(unsigned* p)              { return __hip_atomic_load(p, __ATOMIC_RELAXED, __HIP_MEMORY_SCOPE_AGENT); }
__device__ __forceinline__ unsigned xb_add(unsigned* p, unsigned v) { return __hip_atomic_fetch_add(p, v, __ATOMIC_RELAXED, __HIP_MEMORY_SCOPE_AGENT); }
__device__ __forceinline__ unsigned xb_xcc_id() { return (unsigned)__builtin_amdgcn_s_getreg((3 << 11) | 20) & 0xFu; }
#define XB_SPIN(cond, bar) do { unsigned _sp = 0; while (cond) { __builtin_amdgcn_s_sleep(1); \
    if ((++_sp & 255u) == 0u) { if (xb_ld(&(bar)[XB_TMO])) break; if (_sp > XB_SPIN_CAP) { atomicAdd(&(bar)[XB_TMO], 1u); break; } } } } while (0)

struct XcdBarrier { unsigned* bar; unsigned x; volatile LAS unsigned* st; };

__device__ __forceinline__ XcdBarrier xcd_barrier_post(unsigned* bar, volatile LAS unsigned* st) {
    XcdBarrier b; b.bar = bar; b.x = xb_xcc_id(); b.st = st;
    if (threadIdx.x == 0) { st[2] = xb_add(&bar[XB_XCNT(b.x)], 1u); st[3] = b.x; }
    return b;
}
__device__ __forceinline__ void xcd_barrier_complete(unsigned* bar, unsigned x, unsigned& nloc, unsigned& nx) {
    const unsigned G = gridDim.x * gridDim.y * gridDim.z;
    unsigned sum, cnt, mine, sp = 0u;
    for (;;) {
        sum = 0u; cnt = 0u; mine = 0u;
#pragma unroll
        for (unsigned j = 0; j < 16; ++j) { const unsigned c = xb_ld(&bar[XB_XCNT(j)]); sum += c; cnt += (c > 0u) ? 1u : 0u; mine = (j == x) ? c : mine; }
        if (sum == G) break;
        __builtin_amdgcn_s_sleep(1);
        if ((++sp & 255u) == 0u) { if (xb_ld(&bar[XB_TMO])) break; if (sp > XB_SPIN_CAP) { atomicAdd(&bar[XB_TMO], 1u); break; } }
    }
    nloc = mine > 0u ? mine : 1u; nx = cnt > 0u ? cnt : 1u;
}
__device__ __forceinline__ void xcd_barrier(const XcdBarrier& b, int wave_id) {
    const bool leader_thread = (wave_id == 0) && (__builtin_amdgcn_mbcnt_hi(~0u, __builtin_amdgcn_mbcnt_lo(~0u, 0u)) == 0u);
    asm volatile("s_waitcnt vmcnt(0)" ::: "memory");
    __syncthreads();
    if (leader_thread) {
        unsigned* bar = b.bar;
        __builtin_amdgcn_s_waitcnt(0);
        unsigned nloc = b.st[0], nx = b.st[1];
        if (nloc == 0u) { xcd_barrier_complete(bar, b.x, nloc, nx); b.st[0] = nloc; b.st[1] = nx; }
        const unsigned old = xb_add(&bar[XB_XSUB(b.x)], 1u);
        const unsigned gen = old / nloc;
        if (old + 1u == (gen + 1u) * nloc) {
            __builtin_amdgcn_fence(__ATOMIC_RELEASE, "agent");
            asm volatile("s_waitcnt vmcnt(0)" ::: "memory");
            const unsigned og = xb_add(&bar[XB_TOP], 1u);
            const unsigned tg = og / nx;
            if (og + 1u == (tg + 1u) * nx) xb_add(&bar[XB_TOPGEN], 1u);
            else XB_SPIN(xb_ld(&bar[XB_TOPGEN]) == tg, bar);
            __builtin_amdgcn_fence(__ATOMIC_ACQUIRE, "agent");
            xb_add(&bar[XB_XGEN(b.x)], 1u);
            asm volatile("s_waitcnt vmcnt(0)" ::: "memory");
        } else {
            XB_SPIN(xb_ld(&bar[XB_XGEN(b.x)]) == gen, bar);
            __builtin_amdgcn_fence(__ATOMIC_ACQUIRE, "agent");
            asm volatile("s_waitcnt vmcnt(0)" ::: "memory");
        }
    }
    __syncthreads();
}

__device__ __forceinline__ bf16x8 frag_rowk_l(const LAS bf16_t* p, int ld, int lane) {
    return *(const LAS bf16x8*)(p + (lane & 15) * ld + (lane >> 4) * 8);
}
__device__ __forceinline__ bf16x8 frag_rowk_g(const bf16_t* p, long ld, int lane) {
    return *(const bf16x8*)(p + (long)(lane & 15) * ld + (lane >> 4) * 8);
}
__device__ __forceinline__ bf16x8 frag_colk_l(unsigned p, int ldb, int lane) {
    const unsigned a0 = p + (unsigned)((8 * (lane >> 4) + ((lane & 15) >> 2)) * ldb + (lane & 3) * 8);
    const unsigned a1 = a0 + 4u * (unsigned)ldb;
    s16x4 lo, hi;
    asm volatile("ds_read_b64_tr_b16 %0, %2\n\tds_read_b64_tr_b16 %1, %3\n\ts_waitcnt lgkmcnt(0)" : "=&v"(lo), "=&v"(hi) : "v"(a0), "v"(a1) : "memory");
    return (bf16x8){lo[0], lo[1], lo[2], lo[3], hi[0], hi[1], hi[2], hi[3]};
}
#define MFMA16(a, b, c) __builtin_amdgcn_mfma_f32_16x16x32_bf16((a), (b), (c), 0, 0, 0)
namespace pg8 {
constexpr int BM = 256, BK = 64, HALF = 128, HTB = HALF * BK * 2, STAGE_BYTES = 8 * HTB, NXCD = 8, WGM = 8;
__device__ __forceinline__ int lds_byte(int r, int c) { const int st = (r >> 4) * 2 + (c >> 5), rr = r & 15, cc = c & 31, ob = rr * 64 + cc * 2; return st * 1024 + (ob ^ (((ob >> 9) & 1) << 5)); }
__device__ __forceinline__ void stage_rc(int b, int& R, int& C) { const int st = b / 1024, sb = b % 1024, swz = sb ^ (((sb >> 9) & 1) << 5); R = (st >> 1) * 16 + swz / 64; C = (st & 1) * 32 + (swz % 64) / 2; }
__device__ __forceinline__ int perm32(int rho) { const int n = rho >> 4, i = rho & 15; return 8 * (i >> 2) + 4 * n + (i & 3); }

struct Unit { int pm, pn, e; };
constexpr float WSCALE = 32.0f, WSCALE_INV = 1.0f / 32.0f;

struct DenseOrder {
    const bf16_t* A; const bf16_t* Bt; int ldab, kb, nM, nN, nwg, G, c;
    __device__ __forceinline__ void init(const bf16_t* A_, int lda_, const bf16_t* Bt_, int M, int N, int K_, int G_, int c_) { A = A_; ldab = lda_ * 2; Bt = Bt_; kb = K_ * 2; nM = M / BM; nN = N / BM; nwg = nM * nN; G = G_; c = c_; }
    __device__ __forceinline__ void init8(const void* A_, int ldab_, const void* Bt_, int M, int N, int K_, int G_, int c_) { A = (const bf16_t*)A_; ldab = ldab_; Bt = (const bf16_t*)Bt_; kb = K_; nM = M / BM; nN = N / BM; nwg = nM * nN; G = G_; c = c_; }
    __device__ __forceinline__ void prep(LAS unsigned char*) const {}
    __device__ __forceinline__ bool next(int i, Unit& u) const {
        const long L = (long)i * G + c; if (L >= nwg) return false;
        int wgid = (int)L; { const int q = nwg / NXCD, r = nwg % NXCD, xcd = wgid % NXCD, off = wgid / NXCD; wgid = (xcd < r ? xcd * (q + 1) : r * (q + 1) + (xcd - r) * q) + off; }
        const int nig = WGM * nN, gid = wgid / nig, fm = gid * WGM, gsz = (nM - fm) < WGM ? (nM - fm) : WGM;
        u.pm = fm + ((wgid % nig) % gsz); u.pn = (wgid % nig) / gsz; u.e = 0; return true;
    }
    __device__ __forceinline__ const char* a_base() const { return (const char*)A; }
    __device__ __forceinline__ unsigned a_off(const Unit& u, int r) const { return (unsigned)(u.pm * BM + r) * (unsigned)ldab; }
    __device__ __forceinline__ const char* b_ptr(const Unit& u) const { return (const char*)Bt + (size_t)u.pn * BM * kb; }
};

template <int MODE  >
struct MoeOrder {
    const void* A; const void* Bt; const int* list; const int* cnt; int ldab, kb, nN, G, c; size_t bstride;
    LAS int* tp; LAS int* cn; LAS int* rb;
    __device__ __forceinline__ void prep(LAS unsigned char* misc, int tid) {
        tp = (LAS int*)(misc + 64); cn = tp + 72; rb = cn + 72;
        if (tid < NEX1) cn[tid] = cnt[tid];
        __syncthreads();
        if (tid == 0) { int s = 0, q = 0; for (int e = 0; e < NEX1; ++e) { tp[e] = s; rb[e] = q; s += (cn[e] + BM - 1) / BM; q += cn[e]; } tp[NEX1] = s; rb[NEX1] = q; }
        __syncthreads();
    }
    __device__ __forceinline__ bool next(int i, Unit& u) const {
        const int total = tp[NEX1]; const long nu = (long)total * nN; const int per = (int)((nu + G - 1) / G);
        const int vc = ((G & 7) == 0) ? (c & 7) * (G >> 3) + (c >> 3) : c;
        const long L = (long)vc * per + i;
        if (i >= per || L >= nu) return false;
        const int tile = (int)(L / nN); u.pn = (int)(L % nN);
        int e = 0;
        for (int k = 1; k < NEX1; ++k) e += (tp[k] <= tile) ? 1 : 0;
        u.e = e; u.pm = tile - tp[e]; return true;
    }
    __device__ __forceinline__ const char* a_base() const { return (const char*)A; }
    __device__ __forceinline__ unsigned a_off(const Unit& u, int r) const {
        int pos = u.pm * BM + r; const int n = cn[u.e]; pos = pos < n ? pos : n - 1;
        if (MODE == 1) return (unsigned)(rb[u.e] + pos) * (unsigned)ldab;
        const int a = list[u.e * TT + pos];
        const int row = a < 8 * TT ? (a >> 3) : a - 8 * TT;
        return (unsigned)row * (unsigned)ldab;
    }
    __device__ __forceinline__ const char* b_ptr(const Unit& u) const { return (const char*)Bt + (size_t)u.e * bstride + (size_t)u.pn * BM * kb; }
};

typedef int v8i32 __attribute__((ext_vector_type(8)));
typedef int v4i32_ __attribute__((ext_vector_type(4)));
__device__ __forceinline__ v8i32 cat8(bf16x8 a, bf16x8 b) { const u32x4 x = __builtin_bit_cast(u32x4, a), y = __builtin_bit_cast(u32x4, b); return (v8i32){(int)x.x, (int)x.y, (int)x.z, (int)x.w, (int)y.x, (int)y.y, (int)y.z, (int)y.w}; }
template <bool FP8, class Epi, class Sched>
__device__ __forceinline__ void gemm_phase(LAS unsigned char* lds, const Sched& S, const Epi& E, int wave_id) {
    const int wid = wave_id; int lane = (int)__builtin_amdgcn_mbcnt_hi(~0u, __builtin_amdgcn_mbcnt_lo(~0u, 0u)); asm volatile("" : "+v"(lane));
    const int tid = wid * 64 + lane, wr = wid >> 2, wc = wid & 3, fr = lane & 15, fq = lane >> 4;
    const int kb = S.kb; int nt = kb / 128; asm volatile("" : "+s"(nt));
    unsigned voffB[2];
#pragma unroll
    for (int i = 0; i < 2; ++i) { int R, C; stage_rc(tid * 16 + i * 8192, R, C); const int Rb = (R & ~31) + perm32(R & 31);
        voffB[i] = (unsigned)(Rb * kb) + (unsigned)C * 2u; }
#define PG8_AOFF(u, h, i) ({ int _tz = tid; asm volatile("" : "+v"(_tz)); int _R, _C; stage_rc(_tz * 16 + (i) * 8192, _R, _C); S.a_off((u), (h) * HALF + _R) + (unsigned)_C * 2u; })
    const size_t kstep = (size_t)(BK * 2);
    const size_t hstepB = (size_t)HALF * kb;
    const unsigned ldsw = (unsigned)wid * 1024u;
    const int aoff = lds_byte(wr * 64 + fr, fq * 8), boff = lds_byte(wc * 32 + fr, fq * 8);
#define PG8_SA(b, h) (((b) * 2 + (h)) * HTB)
#define PG8_SB(b, h) ((4 + (b) * 2 + (h)) * HTB)
#define PG8_STAGE(bufoff, gbase, v0, v1) do { \
        __builtin_amdgcn_global_load_lds((const unsigned*)((const char*)(gbase) + (v0)), (LAS unsigned*)(lds + (bufoff) + ldsw), 16, 0, 0); \
        __builtin_amdgcn_global_load_lds((const unsigned*)((const char*)(gbase) + (v1)), (LAS unsigned*)(lds + (bufoff) + ldsw + 8192), 16, 0, 0); } while (0)
#define PG8_VOFFB(i) ({ int _tz = tid; asm volatile("" : "+v"(_tz)); int _R, _C; stage_rc(_tz * 16 + (i) * 8192, _R, _C); (unsigned)(((_R & ~31) + perm32(_R & 31)) * kb) + (unsigned)_C * 2u; })
#define PG8_STAGE_B(bufoff, gbase) do { if constexpr (FP8) { const unsigned _v0 = PG8_VOFFB(0), _v1 = PG8_VOFFB(1); PG8_STAGE(bufoff, gbase, _v0, _v1); } else PG8_STAGE(bufoff, gbase, voffB[0], voffB[1]); } while (0)
#define PG8_LD8(off) __builtin_shufflevector(*(const LAS v4i32_*)(lds + (off)), *(const LAS v4i32_*)(lds + (off) + 1024), 0, 1, 2, 3, 4, 5, 6, 7)
#define PG8_LDA(dst, b, h) do { _Pragma("unroll") for (int m = 0; m < 4; ++m) { if constexpr (FP8) dst##8[m] = PG8_LD8(PG8_SA(b, h) + aoff + m * 2048); else { _Pragma("unroll") for (int k = 0; k < 2; ++k) dst[m][k] = *(const LAS bf16x8*)(lds + PG8_SA(b, h) + aoff + m * 2048 + k * 1024); } } } while (0)
#define PG8_LDB(dst, b, h) do { _Pragma("unroll") for (int n = 0; n < 2; ++n) { if constexpr (FP8) dst##8[n] = PG8_LD8(PG8_SB(b, h) + boff + n * 2048); else { _Pragma("unroll") for (int k = 0; k < 2; ++k) dst[n][k] = *(const LAS bf16x8*)(lds + PG8_SB(b, h) + boff + n * 2048 + k * 1024); } } } while (0)
#define PG8_MMA(ai, bj, At, Bt) do { __builtin_amdgcn_s_setprio(1); _Pragma("unroll") for (int m = 0; m < 4; ++m) _Pragma("unroll") for (int n = 0; n < 2; ++n) { \
        if constexpr (FP8) asm volatile("v_mfma_f32_16x16x128_f8f6f4 %0, %1, %2, %0" : "+v"(acc[ai][bj][m][n]) : "v"(Bt##8[n]), "v"(At##8[m])); \
        else { _Pragma("unroll") for (int k = 0; k < 2; ++k) acc[ai][bj][m][n] = __builtin_amdgcn_mfma_f32_16x16x32_bf16(Bt[n][k], At[m][k], acc[ai][bj][m][n], 0, 0, 0); } } \
        __builtin_amdgcn_s_setprio(0); } while (0)
#define PG8_WAIT_V(n) asm volatile("s_waitcnt vmcnt(" #n ")" ::: "memory")
#define PG8_WAIT_L(n) asm volatile("s_waitcnt lgkmcnt(" #n ")" ::: "memory")
#define PG8_BAR __builtin_amdgcn_s_barrier()
#define PG8_SCHED __builtin_amdgcn_sched_barrier(0)
    Unit cur, nxt; int ui = 0;
    if (!S.next(0, cur)) return;
    f32x4 acc[2][2][4][2];
#pragma unroll
    for (int a = 0; a < 2; ++a)
#pragma unroll
        for (int b = 0; b < 2; ++b)
#pragma unroll
            for (int m = 0; m < 4; ++m)
#pragma unroll
                for (int n = 0; n < 2; ++n) acc[a][b][m][n] = (f32x4){0.f, 0.f, 0.f, 0.f};
    bf16x8 At[4][2], B0[2][2], B1[2][2]; v8i32 At8[4], B08[2], B18[2];
    const char* const gA = S.a_base();
    const char* cB = S.b_ptr(cur);
    unsigned oc00, oc01, oc10, oc11;
    oc00 = PG8_AOFF(cur, 0, 0); oc01 = PG8_AOFF(cur, 0, 1); oc10 = PG8_AOFF(cur, 1, 0); oc11 = PG8_AOFF(cur, 1, 1);
    PG8_STAGE_B(PG8_SB(0, 0), cB); PG8_STAGE_B(PG8_SB(0, 1), cB + hstepB); PG8_STAGE(PG8_SA(0, 0), gA, oc00, oc01); PG8_STAGE(PG8_SA(0, 1), gA, oc10, oc11);
    if (wr == 1) PG8_BAR;
    PG8_WAIT_V(2); PG8_BAR;
    PG8_STAGE_B(PG8_SB(1, 0), cB + kstep); PG8_STAGE(PG8_SA(1, 0), gA + kstep, oc00, oc01); PG8_STAGE_B(PG8_SB(1, 1), cB + hstepB + kstep);
    PG8_WAIT_V(6); PG8_BAR;
    for (;;) {
        const bool has_next = S.next(ui + 1, nxt);
        const char* nB = cB;
        {
            u32x4 on = {oc00, oc01, oc10, oc11};
            if (has_next) { on.x = PG8_AOFF(nxt, 0, 0); on.y = PG8_AOFF(nxt, 0, 1); on.z = PG8_AOFF(nxt, 1, 0); on.w = PG8_AOFF(nxt, 1, 1); nB = S.b_ptr(nxt); }
            *(LAS u32x4*)(lds + STAGE_BYTES + tid * 16) = on;
        }
        for (int t = 0; t < nt; t += 2) {
            const bool last = (t == nt - 2);
            const char* a1 = gA + (size_t)(t + 1) * kstep;
            const char* a2 = last ? gA : gA + (size_t)(t + 2) * kstep; const char* b2 = last ? nB : cB + (size_t)(t + 2) * kstep;
            const char* a3 = a2 + kstep; const char* b3 = b2 + kstep;
            unsigned s00 = oc00, s01 = oc01, s10 = oc10, s11 = oc11;
            if (last) { const u32x4 on = *(const LAS u32x4*)(lds + STAGE_BYTES + tid * 16); s00 = on.x; s01 = on.y; s10 = on.z; s11 = on.w; }
            PG8_LDB(B0, 0, 0); PG8_LDB(B1, 0, 1); PG8_SCHED; PG8_LDA(At, 0, 0); PG8_STAGE(PG8_SA(1, 1), a1, oc10, oc11);
            PG8_WAIT_V(8); PG8_WAIT_L(0); PG8_BAR; PG8_MMA(0, 0, At, B0); PG8_MMA(0, 1, At, B1); PG8_BAR; PG8_SCHED;
            PG8_LDA(At, 0, 1); PG8_STAGE_B(PG8_SB(0, 0), b2); PG8_STAGE_B(PG8_SB(0, 1), b2 + hstepB); PG8_STAGE(PG8_SA(0, 0), a2, s00, s01);
            PG8_WAIT_V(8); PG8_WAIT_L(0); PG8_BAR; PG8_MMA(1, 0, At, B0); PG8_MMA(1, 1, At, B1); PG8_BAR; PG8_SCHED;
            PG8_LDB(B0, 1, 0); PG8_LDB(B1, 1, 1); PG8_SCHED; PG8_LDA(At, 1, 0); PG8_STAGE(PG8_SA(0, 1), a2, s10, s11);
            PG8_WAIT_V(8); PG8_WAIT_L(0); PG8_BAR; PG8_MMA(0, 0, At, B0); PG8_MMA(0, 1, At, B1); PG8_BAR; PG8_SCHED;
            PG8_LDA(At, 1, 1); PG8_STAGE_B(PG8_SB(1, 0), b3); PG8_STAGE_B(PG8_SB(1, 1), b3 + hstepB); PG8_STAGE(PG8_SA(1, 0), a3, s00, s01);
            PG8_WAIT_V(8); PG8_WAIT_L(0); PG8_BAR; PG8_MMA(1, 0, At, B0); PG8_MMA(1, 1, At, B1); PG8_BAR; PG8_SCHED;
        }
        if (wr == 0) PG8_BAR;
        E(acc, cur, wr, wc, fr, fq);
        if (!has_next) break;
#pragma unroll
        for (int a = 0; a < 2; ++a)
#pragma unroll
            for (int b = 0; b < 2; ++b)
#pragma unroll
                for (int m = 0; m < 4; ++m)
#pragma unroll
                    for (int n = 0; n < 2; ++n) acc[a][b][m][n] = (f32x4){0.f, 0.f, 0.f, 0.f};
        { const u32x4 on = *(const LAS u32x4*)(lds + STAGE_BYTES + tid * 16); oc00 = on.x; oc01 = on.y; oc10 = on.z; oc11 = on.w; }
        cur = nxt; cB = nB; ++ui;
        if (wr == 1) PG8_BAR;
    }
    PG8_WAIT_V(0);
    PG8_BAR;
#undef PG8_SA
#undef PG8_SB
#undef PG8_STAGE
#undef PG8_STAGE_B
#undef PG8_AOFF
#undef PG8_VOFFB
#undef PG8_LD8
#undef PG8_LDA
#undef PG8_LDB
#undef PG8_MMA
#undef PG8_WAIT_V
#undef PG8_WAIT_L
#undef PG8_BAR
#undef PG8_SCHED
}

struct EpiStore {
    bf16_t* O; int ldc; float scale;
    __device__ __forceinline__ void operator()(const f32x4 (&acc)[2][2][4][2], const Unit& u, int wr, int wc, int fr, int fq) const {
        const int row0 = u.pm * BM + wr * 64 + fr, col0 = u.pn * BM + wc * 32 + 8 * fq;
#pragma unroll
        for (int ai = 0; ai < 2; ++ai)
#pragma unroll
            for (int m = 0; m < 4; ++m) { bf16_t* rowp = O + (size_t)(row0 + ai * HALF + m * 16) * ldc + col0;
#pragma unroll
                for (int bj = 0; bj < 2; ++bj) { const f32x4 v0 = acc[ai][bj][m][0] * scale, v1 = acc[ai][bj][m][1] * scale;
                    u32x4 w; w.x = cvt_pk_bf16(v0[0], v0[1]); w.y = cvt_pk_bf16(v0[2], v0[3]); w.z = cvt_pk_bf16(v1[0], v1[1]); w.w = cvt_pk_bf16(v1[2], v1[3]);
                    *(u32x4*)(rowp + bj * HALF) = w; } }
    }
};
struct EpiGlu {
    const bf16_t* Z; const float* b; bf16_t* MIX;
    __device__ __forceinline__ void operator()(const f32x4 (&acc)[2][2][4][2], const Unit& u, int wr, int wc, int fr, int fq) const {
        const int row0 = u.pm * BM + wr * 64 + fr, col0 = u.pn * BM + wc * 32 + 8 * fq;
#pragma unroll
        for (int bj = 0; bj < 2; ++bj) {
            const f32x4 b0 = *(const f32x4*)(b + col0 + bj * HALF), b1 = *(const f32x4*)(b + col0 + bj * HALF + 4);
#pragma unroll
            for (int ai = 0; ai < 2; ++ai)
#pragma unroll
                for (int m = 0; m < 4; ++m) { const size_t row = (size_t)(row0 + ai * HALF + m * 16);
                    const u32x4 zz = *(const u32x4*)(Z + row * 1024 + col0 + bj * HALF);
                    const f32x4 v0 = acc[ai][bj][m][0] + b0, v1 = acc[ai][bj][m][1] + b1;
                    u32x4 w;
                    w.x = cvt_pk_bf16(bflo(zz.x) * sigmoidf_(v0[0]), bfhi(zz.x) * sigmoidf_(v0[1]));
                    w.y = cvt_pk_bf16(bflo(zz.y) * sigmoidf_(v0[2]), bfhi(zz.y) * sigmoidf_(v0[3]));
                    w.z = cvt_pk_bf16(bflo(zz.z) * sigmoidf_(v1[0]), bfhi(zz.z) * sigmoidf_(v1[1]));
                    w.w = cvt_pk_bf16(bflo(zz.w) * sigmoidf_(v1[2]), bfhi(zz.w) * sigmoidf_(v1[3]));
                    *(u32x4*)(MIX + row * DM + 1024 + col0 + bj * HALF) = w; }
        }
    }
};
struct EpiE1 {
    unsigned char* H; const LAS int* cn; const LAS int* rb;
    __device__ __forceinline__ void operator()(const f32x4 (&acc)[2][2][4][2], const Unit& u, int wr, int wc, int fr, int fq) const {
        const int n = cn[u.e]; const int colh = u.pn * 128 + wc * 32 + 8 * fq;
#pragma unroll
        for (int ai = 0; ai < 2; ++ai)
#pragma unroll
            for (int m = 0; m < 4; ++m) { const int pos = u.pm * BM + ai * HALF + wr * 64 + m * 16 + fr;
                if (pos < n) { const int a = rb[u.e] + pos;
                    float sc = WSCALE_INV; asm volatile("" : "+v"(sc));
                    const f32x4 g0 = acc[ai][0][m][0] * sc, g1 = acc[ai][0][m][1] * sc, u0 = acc[ai][1][m][0] * sc, u1 = acc[ai][1][m][1] * sc;
                    u32x2 w;
                    w.x = (unsigned)__builtin_amdgcn_cvt_pk_fp8_f32(siluf_(g0[0]) * u0[0], siluf_(g0[1]) * u0[1], 0, false);
                    w.x = (unsigned)__builtin_amdgcn_cvt_pk_fp8_f32(siluf_(g0[2]) * u0[2], siluf_(g0[3]) * u0[3], (int)w.x, true);
                    w.y = (unsigned)__builtin_amdgcn_cvt_pk_fp8_f32(siluf_(g1[0]) * u1[0], siluf_(g1[1]) * u1[1], 0, false);
                    w.y = (unsigned)__builtin_amdgcn_cvt_pk_fp8_f32(siluf_(g1[2]) * u1[2], siluf_(g1[3]) * u1[3], (int)w.y, true);
                    *(u32x2*)(H + (size_t)a * EHID + colh) = w; }
                __builtin_amdgcn_sched_barrier(0); }
    }
};
struct EpiE2 {
    unsigned char* Y; const float* wgt; const LAS int* cn; const LAS int* rb;
    __device__ __forceinline__ void operator()(const f32x4 (&acc)[2][2][4][2], const Unit& u, int wr, int wc, int fr, int fq) const {
        const int n = cn[u.e]; const int col0 = u.pn * BM + wc * 32 + 8 * fq;
#pragma unroll
        for (int ai = 0; ai < 2; ++ai)
#pragma unroll
            for (int m = 0; m < 4; ++m) { const int pos = u.pm * BM + ai * HALF + wr * 64 + m * 16 + fr;
                if (pos < n) { const int a = rb[u.e] + pos; float ws = wgt[u.e * TT + pos] * WSCALE_INV; asm volatile("" : "+v"(ws));
                    unsigned char* rowp = Y + (size_t)a * DM + col0;
#pragma unroll
                    for (int bj = 0; bj < 2; ++bj) { const f32x4 v0 = acc[ai][bj][m][0] * ws, v1 = acc[ai][bj][m][1] * ws;
                        u32x2 w;
                        w.x = (unsigned)__builtin_amdgcn_cvt_pk_fp8_f32(v0[0], v0[1], 0, false); w.x = (unsigned)__builtin_amdgcn_cvt_pk_fp8_f32(v0[2], v0[3], (int)w.x, true);
                        w.y = (unsigned)__builtin_amdgcn_cvt_pk_fp8_f32(v1[0], v1[1], 0, false); w.y = (unsigned)__builtin_amdgcn_cvt_pk_fp8_f32(v1[2], v1[3], (int)w.y, true);
                        *(u32x2*)(rowp + bj * HALF) = w; } }
                __builtin_amdgcn_sched_barrier(0); }
    }
};
}
struct KArgs {
    const float* in[34];
    float* out;
    unsigned char* ws;
    int ph_lo, ph_hi;
};
struct Params {
    float* out;
    unsigned char* ws;
    LAS unsigned long long* ptab;
    int ph_lo, ph_hi;
    __device__ __forceinline__ const float* inp(int k) const {
        const unsigned long long v = ptab[k];
        const unsigned lo = __builtin_amdgcn_readfirstlane((unsigned)v), hi = __builtin_amdgcn_readfirstlane((unsigned)(v >> 32));
        return (const float*)(((unsigned long long)hi << 32) | lo);
    }
};
struct Ctx {
    LAS unsigned char* lds;
    int tid, lane, wave, G, bid;
    int gw, ngw;
};

__device__ __forceinline__ void tr_item(const float* W, int N, bf16_t* WT, int ldt, int k0, int n0, int orow0, LAS float* scr, int lane) {
#pragma unroll 8
    for (int i = 0; i < 32; ++i) { const int kk = 2 * i + (lane >> 5); scr[kk * 33 + (lane & 31)] = W[(size_t)(k0 + kk) * N + n0 + (lane & 31)]; }
    LDS_WAIT(); asm volatile("" ::: "memory");
    const int c = lane & 7;
#pragma unroll
    for (int j = 0; j < 4; ++j) { const int n = (lane >> 3) + 8 * j; const LAS float* s = scr + (8 * c) * 33 + n;
        u32x4 o; o.x = cvt_pk_bf16(s[0 * 33], s[1 * 33]); o.y = cvt_pk_bf16(s[2 * 33], s[3 * 33]); o.z = cvt_pk_bf16(s[4 * 33], s[5 * 33]); o.w = cvt_pk_bf16(s[6 * 33], s[7 * 33]);
        *(u32x4*)(WT + (size_t)(orow0 + n) * ldt + k0 + 8 * c) = o; }
    LDS_WAIT(); asm volatile("" ::: "memory");
}
__device__ __forceinline__ void tr_item64(const float* W, int N, bf16_t* WT, int ldt, int k0, int n0, int orow0, LAS float* scr, int lane) {
    f32x4 v[16];
    const float* src = W + (size_t)(k0 + (lane >> 4)) * N + n0 + 4 * (lane & 15);
#pragma unroll
    for (int i = 0; i < 16; ++i) v[i] = __builtin_nontemporal_load((const f32x4*)(src + (size_t)(4 * i) * N));
#pragma unroll
    for (int i = 0; i < 16; ++i) { LAS float* d = scr + (4 * i + (lane >> 4)) * 65 + 4 * (lane & 15); d[0] = v[i][0]; d[1] = v[i][1]; d[2] = v[i][2]; d[3] = v[i][3]; }
    LDS_WAIT(); asm volatile("" ::: "memory");
    const int c = lane & 7;
#pragma unroll
    for (int j = 0; j < 8; ++j) { const int n = (lane >> 3) + 8 * j; const LAS float* s = scr + (8 * c) * 65 + n;
        u32x4 o; o.x = cvt_pk_bf16(s[0 * 65], s[1 * 65]); o.y = cvt_pk_bf16(s[2 * 65], s[3 * 65]); o.z = cvt_pk_bf16(s[4 * 65], s[5 * 65]); o.w = cvt_pk_bf16(s[6 * 65], s[7 * 65]);
        *(u32x4*)(WT + (size_t)(orow0 + n) * ldt + k0 + 8 * c) = o; }
    LDS_WAIT(); asm volatile("" ::: "memory");
}
__device__ __forceinline__ void tr_item64_fp8(const float* W, int N, unsigned char* WT, int ldt, int k0, int n0, int orow0, LAS float* scr, int lane, float wscale = pg8::WSCALE) {
    f32x4 v[16];
    const float* src = W + (size_t)(k0 + (lane >> 4)) * N + n0 + 4 * (lane & 15);
#pragma unroll
    for (int i = 0; i < 16; ++i) v[i] = __builtin_nontemporal_load((const f32x4*)(src + (size_t)(4 * i) * N));
#pragma unroll
    for (int i = 0; i < 16; ++i) { LAS float* d = scr + (4 * i + (lane >> 4)) * 65 + 4 * (lane & 15); d[0] = v[i][0]; d[1] = v[i][1]; d[2] = v[i][2]; d[3] = v[i][3]; }
    LDS_WAIT(); asm volatile("" ::: "memory");
    const int c = lane & 7;
#pragma unroll
    for (int j = 0; j < 8; ++j) { const int n = (lane >> 3) + 8 * j; const LAS float* s = scr + (8 * c) * 65 + n;
        u32x2 o;
        o.x = (unsigned)__builtin_amdgcn_cvt_pk_fp8_f32(s[0 * 65] * wscale, s[1 * 65] * wscale, 0, false);
        o.x = (unsigned)__builtin_amdgcn_cvt_pk_fp8_f32(s[2 * 65] * wscale, s[3 * 65] * wscale, (int)o.x, true);
        o.y = (unsigned)__builtin_amdgcn_cvt_pk_fp8_f32(s[4 * 65] * wscale, s[5 * 65] * wscale, 0, false);
        o.y = (unsigned)__builtin_amdgcn_cvt_pk_fp8_f32(s[6 * 65] * wscale, s[7 * 65] * wscale, (int)o.y, true);
        *(u32x2*)(WT + (size_t)(orow0 + n) * ldt + k0 + 8 * c) = o; }
    LDS_WAIT(); asm volatile("" ::: "memory");
}
__device__ __forceinline__ void tr_dense(const float* W, int K, int N, bf16_t* WT, int item, LAS float* scr, int lane) {
    const int nblk = N / 32, kb = item / nblk, nb = item % nblk;
    tr_item(W, N, WT, K, 64 * kb, 32 * nb, 32 * nb, scr, lane);
}

__device__ __forceinline__ void s5_tables(const Params& p, Ctx& C, int dir, int g) {
    LAS f32x2* PW = (LAS f32x2*)C.lds;
    LAS f32x2* BB = PW + 65 * 64;
    LAS f32x2* CX = BB + 64 * 16;
    const float* a_re = p.inp(11); const float* a_im = p.inp(12); const float* log_dt = p.inp(13);
    const float* b_re = p.inp(14); const float* b_im = p.inp(15); const float* c_re = p.inp(16); const float* c_im = p.inp(17);
    const int tid = C.tid;
    if (tid < 64) {
        const int pp = tid;
        const float dt = __expf(log_dt[dir * 64 + g]);
        const float are = a_re[(dir * 64 + g) * 64 + pp], aim = a_im[(dir * 64 + g) * 64 + pp];
        const float zr = are * dt, zi = aim * dt;
        const float mag = __expf(zr);
        double rev = (double)zi * 0.15915494309189535; rev -= floor(rev);
        const float cs = __builtin_amdgcn_cosf((float)rev), sn = __builtin_amdgcn_sinf((float)rev);
        const float abr = mag * cs, abi = mag * sn;
        const float den = are * are + aim * aim, nr = abr - 1.0f, ni = abi;
        const float fre = (nr * are + ni * aim) / den, fim = (ni * are - nr * aim) / den;
        float pr = 1.0f, pi = 0.0f;
#pragma unroll 1
        for (int n = 0; n <= 64; ++n) { PW[n * 64 + pp] = (f32x2){pr, pi}; const float t = pr * abr - pi * abi; pi = pr * abi + pi * abr; pr = t; }
        for (int j = 0; j < 16; ++j) { const float br = b_re[(g * 64 + pp) * 16 + j], bi = b_im[(g * 64 + pp) * 16 + j];
            BB[pp * 16 + j] = (f32x2){fre * br - fim * bi, fre * bi + fim * br}; }
    }
    for (int q = tid; q < 1024; q += NTHR) { const int i = q >> 6, pp = q & 63; CX[i * 64 + pp] = (f32x2){c_re[(g * 16 + i) * 64 + pp], c_im[(g * 16 + i) * 64 + pp]}; }
    __syncthreads();
    bf16_t* KN = (bf16_t*)(p.ws + WS_KN) + (size_t)(dir * 64 + g) * 16 * 1024;
    bf16_t* WTt = (bf16_t*)(p.ws + WS_WT) + (size_t)(dir * 64 + g) * 128 * 1024;
    float* APOW = (float*)(p.ws + WS_APOW) + (size_t)(dir * 64 + g) * 64 * 128;
    float* AL = (float*)(p.ws + WS_AL) + (size_t)(dir * 64 + g) * 128;
#pragma unroll 1
    for (int q = 0; q < 32; ++q) { const int idx = tid + NTHR * q; const int n = idx >> 8, i = (idx >> 4) & 15, j = idx & 15;
        float s = 0.f;
#pragma unroll 4
        for (int pp = 0; pp < 64; ++pp) { const f32x2 c = CX[i * 64 + pp], w = PW[n * 64 + pp], b = BB[pp * 16 + j];
            const float gr = c.x * b.x - c.y * b.y, gi = c.x * b.y + c.y * b.x;
            s += gr * w.x - gi * w.y; }
        KN[(size_t)i * 1024 + n * 16 + j] = f2bf(s); }
#pragma unroll 2
    for (int q = 0; q < 256; ++q) { const int idx = tid + NTHR * q; const int j = idx & 15, s = (idx >> 4) & 63, pq = idx >> 10; const int pp = pq & 63;
        const f32x2 w = PW[(63 - s) * 64 + pp], b = BB[pp * 16 + j];
        const float v = (pq < 64) ? (w.x * b.x - w.y * b.y) : (w.x * b.y + w.y * b.x);
        WTt[(size_t)pq * 1024 + s * 16 + j] = f2bf(v); }
    for (int q = tid; q < 4096; q += NTHR) { const int t = q >> 6, pp = q & 63; const f32x2 w = PW[(t + 1) * 64 + pp]; *(f32x2*)(APOW + (size_t)t * 128 + 2 * pp) = w; }
    if (tid < 64) { const f32x2 w = PW[64 * 64 + tid]; *(f32x2*)(AL + 2 * tid) = w; }
    if (dir == 0) { bf16_t* CCt = (bf16_t*)(p.ws + WS_CC) + (size_t)g * 16 * 128;
        for (int q = tid; q < 2048; q += NTHR) { const int i = q >> 7, pq = q & 127; const f32x2 c = CX[i * 64 + (pq & 63)]; CCt[i * 128 + pq] = f2bf(pq < 64 ? c.x : -c.y); } }
    __syncthreads();
}

__device__ __forceinline__ void phase_p0(const Params& p, Ctx& C) {
    for (int task = C.bid; task < 128; task += C.G) s5_tables(p, C, task >> 6, task & 63);
    {
        const int gt = C.bid * NTHR + C.tid, ngt = C.G * NTHR;
        float* R128 = (float*)(p.ws + WS_ROPE128); float* R64 = (float*)(p.ws + WS_ROPE64);
        for (int q = gt; q < 256 * 64 + 256 * 32; q += ngt) {
            int pos, i, half; float* dst;
            if (q < 256 * 64) { pos = q >> 6; i = q & 63; half = 64; dst = R128 + (size_t)q * 2; }
            else { const int r = q - 256 * 64; pos = r >> 5; i = r & 31; half = 32; dst = R64 + (size_t)r * 2; }
            const float freq = exp2f(-(float)i / (float)half * 13.287712379549449f);
            const float ang = (float)pos * freq;
            double rev = (double)ang * 0.15915494309189535; rev -= floor(rev);
            dst[0] = __builtin_amdgcn_cosf((float)rev); dst[1] = __builtin_amdgcn_sinf((float)rev);
        }
        bf16_t* RWT = (bf16_t*)(p.ws + WS_RWT); const float* rw = p.inp(26);
        for (int q = gt; q < 2 * 64 * DM; q += ngt) { const int L = q / (64 * DM), r = q % (64 * DM), e = r / DM, k = r % DM;
            const float w = rw[((size_t)L * DM + k) * 64 + e]; const bf16_t hi = f2bf(w); const bf16_t lo = f2bf(w - bf2f(hi));
            RWT[((size_t)(L * 2 + 0) * 64 + e) * DM + k] = hi; RWT[((size_t)(L * 2 + 1) * 64 + e) * DM + k] = lo; }
    }
    {
        const float* cvec = p.inp(1); const float* cctx = p.inp(3); const float* mw = p.inp(4);
        float* MODP = (float*)(p.ws + WS_MODP);
        for (int task = C.gw; task < 2 * 32 * 48; task += C.ngw) {
            const int L = task / (32 * 48), r = task % (32 * 48), kb = r / 48, cb = r % 48;
            const float sc = siluf_(cvec[64 * kb + C.lane]), sx = siluf_(cctx[64 * kb + C.lane]);
            f32x4 a0 = {0.f, 0.f, 0.f, 0.f}, a1 = {0.f, 0.f, 0.f, 0.f};
            const float* wp = mw + ((size_t)L * DM + 64 * kb) * 12288 + 256 * cb + 4 * C.lane;
#pragma unroll 8
            for (int kk = 0; kk < 64; ++kk) { const f32x4 w = *(const f32x4*)(wp + (size_t)kk * 12288);
                const float s0 = __shfl(sc, kk), s1 = __shfl(sx, kk);
                a0 += w * s0; a1 += w * s1; }
            *(f32x4*)(MODP + ((size_t)((L * 32 + kb) * 2 + 0)) * 12288 + 256 * cb + 4 * C.lane) = a0;
            *(f32x4*)(MODP + ((size_t)((L * 32 + kb) * 2 + 1)) * 12288 + 256 * cb + 4 * C.lane) = a1;
        }
    }
    {
        LAS float* scr = (LAS float*)(C.lds + C.wave * 17408);
        constexpr int J0 = (DM / 64) * (EV_IN / 64), J3 = (DM / 64) * (OD_IN / 64);
        for (int it = C.gw; it < J0 + J3; it += C.ngw) {
            const bool l1 = it >= J0; const int r = l1 ? it - J0 : it; const int N = l1 ? OD_IN : EV_IN; const int nblk = N / 64, kb = r / nblk, nb = r % nblk;
            tr_item64_fp8(p.inp(l1 ? 21 : 8), N, (unsigned char*)(p.ws + (l1 ? WS_WIN1 : WS_WIN0)), DM, 64 * kb, 64 * nb, 64 * nb, scr, C.lane, 32.0f);
        }
        LAS float* scr2 = (LAS float*)(C.lds + C.wave * 17408);
        constexpr int I1 = (DM / 64) * (DM / 32), I2 = (1024 / 64) * (1024 / 32), I4 = I1;
        for (int it = C.gw; it < I1 + I2 + I4; it += C.ngw) {
            int r = it;
            if (r < I1) { tr_dense(p.inp(9), DM, DM, (bf16_t*)(p.ws + WS_WOUT0), r, scr2, C.lane); continue; } r -= I1;
            if (r < I2) { tr_dense(p.inp(19), 1024, 1024, (bf16_t*)(p.ws + WS_WGLU), r, scr2, C.lane); continue; } r -= I2;
            tr_dense(p.inp(22), DM, DM, (bf16_t*)(p.ws + WS_WOUT1), r, scr2, C.lane);
        }
    }
}
__device__ __forceinline__ void phase_p1(const Params& p, Ctx& C) {
    const float* MODP = (const float*)(p.ws + WS_MODP); float* MODF = (float*)(p.ws + WS_MODF); const float* mb = p.inp(5);
    for (int q = C.bid * NTHR + C.tid; q < 2 * 2 * 12288; q += C.G * NTHR) { const int L = q / (2 * 12288), v = (q / 12288) & 1, col = q % 12288;
        float s = mb[L * 12288 + col];
        for (int kb = 0; kb < 32; ++kb) s += MODP[((size_t)((L * 32 + kb) * 2 + v)) * 12288 + col];
        MODF[q] = s; }
}
__device__ __forceinline__ const float* modv(const Params& p, int L, int v, int k) { return (const float*)(p.ws + WS_MODF) + (size_t)(L * 2 + v) * 12288 + k * DM; }

__device__ __forceinline__ void phase_modulate(const Params& p, Ctx& C, int L) {
    unsigned char* XA8 = (unsigned char*)(p.ws + WS_XA);
    const float* X2 = (const float*)(p.ws + WS_HX2);
    for (int r = C.gw; r < TT; r += C.ngw) {
        const int v = r < CTXL ? 1 : 0;
        const float* src = (L == 0) ? (r < CTXL ? p.inp(2) + (size_t)r * DM : p.inp(0) + (size_t)(r - CTXL) * DM) : X2 + (size_t)r * DM;
        const float* sh = modv(p, L, v, 0); const float* sc = modv(p, L, v, 1);
#pragma unroll
        for (int j = 0; j < 8; ++j) { const int c = 4 * (C.lane + 64 * j);
            const f32x4 x = *(const f32x4*)(src + c), a = *(const f32x4*)(sc + c), b = *(const f32x4*)(sh + c);
            const f32x4 y = x * (a + 1.0f) + b;
            unsigned w = (unsigned)__builtin_amdgcn_cvt_pk_fp8_f32(y[0], y[1], 0, false); w = (unsigned)__builtin_amdgcn_cvt_pk_fp8_f32(y[2], y[3], (int)w, true);
            *(unsigned*)(XA8 + (size_t)r * DM + c) = w; }
    }
    LAS float* scr = (LAS float*)(C.lds + C.wave * 17408);
    unsigned char* GU = (unsigned char*)(p.ws + WS_GU); unsigned char* DT = (unsigned char*)(p.ws + WS_DT);
    for (int it = C.gw; it < NEX1 * 768; it += C.ngw) {
        const int e = it / 768, r = it % 768, which = r >> 8, q = r & 255;
        if (which < 2) {
            const float* W = (e < 64) ? p.inp(28 + which) + ((size_t)(L * 64 + e)) * DM * EHID : p.inp(31 + which) + (size_t)L * DM * EHID;
            const int kb = q >> 3, nb = q & 7, n0 = 64 * nb;
            tr_item64_fp8(W, EHID, GU + (size_t)e * 1024 * DM, DM, 64 * kb, n0, 256 * (n0 >> 7) + (n0 & 127) + (which ? 128 : 0), scr, C.lane);
        } else {
            const float* W = (e < 64) ? p.inp(30) + ((size_t)(L * 64 + e)) * EHID * DM : p.inp(33) + (size_t)L * EHID * DM;
            const int kb = q >> 5, nb = q & 31;
            tr_item64_fp8(W, DM, DT + (size_t)e * DM * EHID, EHID, 64 * kb, 64 * nb, 64 * nb, scr, C.lane);
        }
    }
}

__device__ __forceinline__ void phase_rope0(const Params& p, Ctx& C) {
    bf16_t* QKV = (bf16_t*)(p.ws + WS_BIG + BG_QKV);
    const f32x2* R128 = (const f32x2*)(p.ws + WS_ROPE128);
    for (int r = C.gw; r < TT; r += C.ngw) {
        bf16_t* row = QKV + (size_t)r * EV_IN;
        if (r < CTXL) {
#pragma unroll
            for (int j = 0; j < 2; ++j) { u32x4* q = (u32x4*)(row + 8 * (C.lane + 64 * j)); u32x4 w = *q;
                w.x = cvt_pk_bf16(bflo(w.x) * 0.0625f, bfhi(w.x) * 0.0625f); w.y = cvt_pk_bf16(bflo(w.y) * 0.0625f, bfhi(w.y) * 0.0625f);
                w.z = cvt_pk_bf16(bflo(w.z) * 0.0625f, bfhi(w.z) * 0.0625f); w.w = cvt_pk_bf16(bflo(w.w) * 0.0625f, bfhi(w.w) * 0.0625f); *q = w; }
        } else {
            const int l = r - CTXL, rp = l >> 6, cp = l & 63;
#pragma unroll
            for (int qk = 0; qk < 2; ++qk)
#pragma unroll
                for (int m = 0; m < 8; ++m) { const int pi = C.lane + 64 * m, head = pi >> 7, blk = (pi >> 6) & 1, i = pi & 63;
                    bf16_t* b = row + qk * 1024 + head * 256 + blk * 128 + i;
                    const f32x2 cs = R128[(blk ? cp : rp) * 64 + i];
                    const float x1 = bf2f(b[0]), x2 = bf2f(b[64]); const float sc = qk ? 1.0f : 0.0625f;
                    b[0] = f2bf((x1 * cs.x - x2 * cs.y) * sc); b[64] = f2bf((x1 * cs.y + x2 * cs.x) * sc); }
        }
    }
}

__device__ __forceinline__ void phase_normrope1(const Params& p, Ctx& C) {
    bf16_t* QKV = (bf16_t*)(p.ws + WS_BIG + BG_QKV);
    const f32x2* R64 = (const f32x2*)(p.ws + WS_ROPE64);
    const float* qg = p.inp(23);
    const int lane = C.lane, i32 = lane & 31; const bool up = lane >= 32;
    const float g00 = qg[lane], g01 = qg[64 + lane], g10 = qg[128 + lane], g11 = qg[128 + 64 + lane];
    for (int r = C.gw; r < TT; r += C.ngw) {
        bf16_t* row = QKV + (size_t)r * OD_IN;
        const bool lat = r >= CTXL; const int l = r - CTXL, rp = lat ? (l >> 6) : 0, cp = lat ? (l & 63) : 0;
        const f32x2 cr = R64[rp * 32 + i32], cc = R64[cp * 32 + i32];
#pragma unroll 2
        for (int h = 0; h < 26; ++h) {
            const int col = h < 8 ? 128 * h : (h < 10 ? 1024 + 128 * (h - 8) : (h < 18 ? 1536 + 128 * (h - 10) : 2560 + 128 * (h - 18)));
            bf16_t* b = row + col;
            float v0 = bf2f(b[lane]), v1 = bf2f(b[64 + lane]);
            if (h < 10) { const float ss = wave_sum(v0 * v0 + v1 * v1); const float rs = rsqrtf(ss * (1.0f / 128.0f) + LN_EPS);
                v0 = bf2f(f2bf(v0 * rs)) * (h < 8 ? g00 : g10); v1 = bf2f(f2bf(v1 * rs)) * (h < 8 ? g01 : g11); }
            if (lat) { const float p0 = __shfl_xor(v0, 32), p1 = __shfl_xor(v1, 32);
                v0 = up ? (p0 * cr.y + v0 * cr.x) : (v0 * cr.x - p0 * cr.y);
                v1 = up ? (p1 * cc.y + v1 * cc.x) : (v1 * cc.x - p1 * cc.y); }
            b[lane] = f2bf(v0); b[64 + lane] = f2bf(v1);
        }
    }
}

__device__ __forceinline__ void phase_merge1(const Params& p, Ctx& C) {
    bf16_t* ATT = (bf16_t*)(p.ws + WS_BIG + BG_ATT);
    const float* dl = p.inp(24); const float* sg = p.inp(25);
    const int lane = C.lane;
    float d0 = dl[lane] * dl[128 + lane] + dl[64 + lane] * dl[128 + 64 + lane];
    float d1 = dl[256 + lane] * dl[384 + lane] + dl[256 + 64 + lane] * dl[384 + 64 + lane];
    const float lam = __expf(wave_sum(d0)) - __expf(wave_sum(d1)) + LAMBDA_INIT;
    const f32x4 gg = *(const f32x4*)(sg + 4 * lane);
    for (int l = C.gw; l < SEQ; l += C.ngw) {
        bf16_t* row = ATT + (size_t)l * 3072;
#pragma unroll
        for (int h = 0; h < 4; ++h) {
            const u32x2 a = *(const u32x2*)(row + 1024 + 256 * h + 4 * lane), b = *(const u32x2*)(row + 2048 + 256 * h + 4 * lane);
            f32x4 o = {bflo(a.x) - lam * bflo(b.x), bfhi(a.x) - lam * bfhi(b.x), bflo(a.y) - lam * bflo(b.y), bfhi(a.y) - lam * bfhi(b.y)};
            const float ss = wave_sum(o[0] * o[0] + o[1] * o[1] + o[2] * o[2] + o[3] * o[3]);
            const float rs = rsqrtf(ss * (1.0f / 256.0f) + LN_EPS) * (1.0f - LAMBDA_INIT);
            o = o * rs * gg;
            u32x2 w; w.x = cvt_pk_bf16(o[0], o[1]); w.y = cvt_pk_bf16(o[2], o[3]);
            *(u32x2*)(row + 1024 + 256 * h + 4 * lane) = w;
        }
    }
}

__device__ __forceinline__ void phase_ln1(const Params& p, Ctx& C, int L) {
    const bf16_t* Y = (const bf16_t*)(p.ws + WS_YMIX); float* X1 = (float*)(p.ws + WS_X1); unsigned char* XA8 = (unsigned char*)(p.ws + WS_XA);
    const float* X2 = (const float*)(p.ws + WS_HX2);
    const float* lg = p.inp(6) + (size_t)(L * 2 + 0) * DM; const float* lb = p.inp(7) + (size_t)(L * 2 + 0) * DM;
    const int r0 = (L == 0) ? 0 : CTXL;
    for (int r = r0 + C.gw; r < TT; r += C.ngw) {
        const int v = r < CTXL ? 1 : 0;
        const float* src = (L == 0) ? (r < CTXL ? p.inp(2) + (size_t)r * DM : p.inp(0) + (size_t)(r - CTXL) * DM) : X2 + (size_t)r * DM;
        const float* g1 = modv(p, L, v, 2); const float* sh2 = modv(p, L, v, 3); const float* sc2 = modv(p, L, v, 4);
        f32x4 t[8]; float s = 0.f;
#pragma unroll
        for (int j = 0; j < 8; ++j) { const int c = 4 * (C.lane + 64 * j);
            const f32x4 x = *(const f32x4*)(src + c), g = *(const f32x4*)(g1 + c); const u32x2 yy = *(const u32x2*)(Y + (size_t)r * DM + c);
            const f32x4 y = {bflo(yy.x), bfhi(yy.x), bflo(yy.y), bfhi(yy.y)};
            t[j] = x * ALPHA + g * y; s += (t[j][0] + t[j][1]) + (t[j][2] + t[j][3]); }
        const float mean = wave_sum(s) * (1.0f / DM); float s2 = 0.f;
#pragma unroll
        for (int j = 0; j < 8; ++j) { t[j] = t[j] - mean; s2 += (t[j][0] * t[j][0] + t[j][1] * t[j][1]) + (t[j][2] * t[j][2] + t[j][3] * t[j][3]); }
        const float rstd = rsqrtf(wave_sum(s2) * (1.0f / DM) + LN_EPS);
#pragma unroll
        for (int j = 0; j < 8; ++j) { const int c = 4 * (C.lane + 64 * j);
            const f32x4 x1 = t[j] * rstd * *(const f32x4*)(lg + c) + *(const f32x4*)(lb + c);
            *(f32x4*)(X1 + (size_t)r * DM + c) = x1;
            const f32x4 z = x1 * (*(const f32x4*)(sc2 + c) + 1.0f) + *(const f32x4*)(sh2 + c);
            unsigned w = (unsigned)__builtin_amdgcn_cvt_pk_fp8_f32(z[0], z[1], 0, false); w = (unsigned)__builtin_amdgcn_cvt_pk_fp8_f32(z[2], z[3], (int)w, true);
            *(unsigned*)(XA8 + (size_t)r * DM + c) = w; }
    }
}

__device__ __forceinline__ void phase_combine(const Params& p, Ctx& C, int L, LAS unsigned char* misc) {
    const unsigned char* YM = (const unsigned char*)(p.ws + WS_BIG + BG_YMOE); const float* X1 = (const float*)(p.ws + WS_X1);
    float* X2 = (float*)(p.ws + WS_HX2);
    const float* lg = p.inp(6) + (size_t)(L * 2 + 1) * DM; const float* lb = p.inp(7) + (size_t)(L * 2 + 1) * DM;
    const unsigned* PK = (const unsigned*)(p.ws + WS_WGT); const int* cnt = (const int*)(p.ws + WS_CTL) + CW_CNT + L * 128;
    const int r0 = (L == 0) ? 0 : CTXL;
    LAS int* rb = (LAS int*)(misc + 64);
    __syncthreads();
    if (C.tid == 0) { int q = 0; for (int e = 0; e < NEX1; ++e) { rb[e] = q; q += cnt[e]; } }
    __syncthreads();
    for (int r = r0 + C.gw; r < TT; r += C.ngw) {
        const int v = r < CTXL ? 1 : 0;
        const float* g2 = modv(p, L, v, 5);
        int ln = C.lane; asm volatile("" : "+v"(ln));
        int slot = rb[64] + (r - r0);
        if (ln < 8) { const unsigned pk = PK[(size_t)r * 8 + ln]; slot = rb[pk >> 16] + (int)(pk & 0xffffu); }
        f32x4 t[2][4]; float s = 0.f;
#pragma unroll
        for (int j = 0; j < 2; ++j) { const int c = 16 * (ln + 64 * j);
            u32x4 yy[9];
#pragma unroll
            for (int k = 0; k < 9; ++k) { const size_t a = (size_t)__builtin_amdgcn_readlane(slot, k); yy[k] = __builtin_nontemporal_load((const u32x4*)(YM + a * DM + c)); }
            f32x2 f[8];
#pragma unroll
            for (int q = 0; q < 8; ++q) f[q] = (f32x2){0.f, 0.f};
#pragma unroll
            for (int k = 0; k < 9; ++k) {
                f[0] += __builtin_amdgcn_cvt_pk_f32_fp8((int)yy[k].x, false); f[1] += __builtin_amdgcn_cvt_pk_f32_fp8((int)yy[k].x, true);
                f[2] += __builtin_amdgcn_cvt_pk_f32_fp8((int)yy[k].y, false); f[3] += __builtin_amdgcn_cvt_pk_f32_fp8((int)yy[k].y, true);
                f[4] += __builtin_amdgcn_cvt_pk_f32_fp8((int)yy[k].z, false); f[5] += __builtin_amdgcn_cvt_pk_f32_fp8((int)yy[k].z, true);
                f[6] += __builtin_amdgcn_cvt_pk_f32_fp8((int)yy[k].w, false); f[7] += __builtin_amdgcn_cvt_pk_f32_fp8((int)yy[k].w, true); }
#pragma unroll
            for (int q = 0; q < 4; ++q) { const f32x4 x = *(const f32x4*)(X1 + (size_t)r * DM + c + 4 * q), g = *(const f32x4*)(g2 + c + 4 * q);
                const f32x4 ff = {f[2 * q][0], f[2 * q][1], f[2 * q + 1][0], f[2 * q + 1][1]};
                t[j][q] = x * ALPHA + g * ff; s += (t[j][q][0] + t[j][q][1]) + (t[j][q][2] + t[j][q][3]); } }
        const float mean = wave_sum(s) * (1.0f / DM); float s2 = 0.f;
#pragma unroll
        for (int j = 0; j < 2; ++j)
#pragma unroll
            for (int q = 0; q < 4; ++q) { t[j][q] = t[j][q] - mean; s2 += (t[j][q][0] * t[j][q][0] + t[j][q][1] * t[j][q][1]) + (t[j][q][2] * t[j][q][2] + t[j][q][3] * t[j][q][3]); }
        const float rstd = rsqrtf(wave_sum(s2) * (1.0f / DM) + LN_EPS);
        float* dst = (L == 0) ? X2 + (size_t)r * DM : p.out + (size_t)(r - CTXL) * DM;
#pragma unroll
        for (int j = 0; j < 2; ++j)
#pragma unroll
            for (int q = 0; q < 4; ++q) { const int c = 16 * (ln + 64 * j) + 4 * q;
                *(f32x4*)(dst + c) = t[j][q] * rstd * *(const f32x4*)(lg + c) + *(const f32x4*)(lb + c); }
    }
}
constexpr int RLD = 264;
constexpr int SLD = 136;

template <bool SCALE>
__device__ __forceinline__ void stage_chunk(const bf16_t* QKV, int row0, int col0, LAS bf16_t* dst, int tid, float lg  , int dirb) {
#pragma unroll
    for (int q = 0; q < 8; ++q) { const int idx = tid + NTHR * q, r = idx >> 5, c = idx & 31;
        u32x4 w = *(const u32x4*)(QKV + (size_t)(row0 + r) * EV_IN + col0 + 8 * c);
        if (SCALE) { const float sc = fast_exp((dirb ? (float)r : (float)(127 - r)) * lg);
            w.x = cvt_pk_bf16(bflo(w.x) * sc, bfhi(w.x) * sc); w.y = cvt_pk_bf16(bflo(w.y) * sc, bfhi(w.y) * sc);
            w.z = cvt_pk_bf16(bflo(w.z) * sc, bfhi(w.z) * sc); w.w = cvt_pk_bf16(bflo(w.w) * sc, bfhi(w.w) * sc); }
        *(LAS u32x4*)(dst + r * RLD + 8 * c) = w; }
}

__device__ __forceinline__ void ret_chunk_kv(const Params& p, Ctx& C) {
    const bf16_t* QKV = (const bf16_t*)(p.ws + WS_BIG + BG_QKV); float* CKV = (float*)(p.ws + WS_BIG + BG_CKV);
    const float* rld = p.inp(10);
    LAS bf16_t* Vs = (LAS bf16_t*)C.lds; LAS bf16_t* Ks = Vs + 128 * RLD;
    const int lane = C.lane, w = C.wave;
    for (int unit = C.bid; unit < 130 * 8; unit += C.G) {
        const int u = unit >> 3, h = (unit >> 1) & 3, dir = unit & 1;
        const float lg = rld[dir * 4 + h];
        __syncthreads();
        stage_chunk<false>(QKV, 128 * u, 2048 + 256 * h, Vs, C.tid, 0.f, 0);
        stage_chunk<true>(QKV, 128 * u, 1024 + 256 * h, Ks, C.tid, lg, dir);
        __syncthreads();
        f32x4 acc[2][16];
#pragma unroll
        for (int a = 0; a < 2; ++a)
#pragma unroll
            for (int b = 0; b < 16; ++b) acc[a][b] = (f32x4){0.f, 0.f, 0.f, 0.f};
        const unsigned vbase = (unsigned)(uintptr_t)Vs, kbase = (unsigned)(uintptr_t)Ks;
#pragma unroll 1
        for (int ks = 0; ks < 4; ++ks) {
            bf16x8 af[2];
#pragma unroll
            for (int a = 0; a < 2; ++a) af[a] = frag_colk_l(vbase + (unsigned)((32 * ks) * RLD + 32 * w + 16 * a) * 2u, RLD * 2, lane);
#pragma unroll
            for (int b = 0; b < 16; ++b) { const bf16x8 bf = frag_colk_l(kbase + (unsigned)((32 * ks) * RLD + 16 * b) * 2u, RLD * 2, lane);
                acc[0][b] = MFMA16(af[0], bf, acc[0][b]); acc[1][b] = MFMA16(af[1], bf, acc[1][b]); }
        }
        float* dst = CKV + ((size_t)((dir * 4 + h) * 130 + u)) * 65536;
#pragma unroll
        for (int a = 0; a < 2; ++a)
#pragma unroll
            for (int b = 0; b < 16; ++b)
#pragma unroll
                for (int j = 0; j < 4; ++j) dst[(size_t)(32 * w + 16 * a + 4 * (lane >> 4) + j) * 256 + 16 * b + (lane & 15)] = acc[a][b][j];
    }
    __syncthreads();
}

__device__ __forceinline__ int s5_row(int dir, int c, int s) { return dir == 0 ? 64 * c + s : (c < 4 ? 255 - (64 * c + s) : 16639 - 64 * (c - 4) - s); }

__device__ __forceinline__ void s5_end_states(const Params& p, Ctx& C) {
    const bf16_t* QKV = (const bf16_t*)(p.ws + WS_BIG + BG_QKV); const bf16_t* WTt = (const bf16_t*)(p.ws + WS_WT); float* E = (float*)(p.ws + WS_S5E);
    const int lane = C.lane, kq = lane >> 4;
    for (int task = C.gw; task < 2 * 64 * 17; task += C.ngw) {
        const int dir = task / (64 * 17), r = task % (64 * 17), g = r / 17, ct = r % 17;
        int cc = 16 * ct + (lane & 15); const bool valid = cc < 260; cc = valid ? cc : 259;
        const bf16_t* wt = WTt + (size_t)(dir * 64 + g) * 128 * 1024;
        f32x4 acc[8];
#pragma unroll
        for (int t = 0; t < 8; ++t) acc[t] = (f32x4){0.f, 0.f, 0.f, 0.f};
#pragma unroll 2
        for (int ks = 0; ks < 32; ++ks) {
            const int s = 2 * ks + (kq >> 1);
            const bf16x8 bf = *(const bf16x8*)(QKV + (size_t)s5_row(dir, cc, s) * EV_IN + 4096 + 16 * g + 8 * (kq & 1));
#pragma unroll
            for (int t = 0; t < 8; ++t) { const bf16x8 af = frag_rowk_g(wt + (size_t)(16 * t) * 1024 + 32 * ks, 1024, lane); acc[t] = MFMA16(af, bf, acc[t]); }
        }
        if (valid) { float* dst = E + ((size_t)((dir * 64 + g) * 260 + cc)) * 128;
#pragma unroll
            for (int t = 0; t < 8; ++t) *(f32x4*)(dst + 16 * t + 4 * kq) = acc[t]; }
    }
}

__device__ __forceinline__ void phase_scans(const Params& p, Ctx& C) {
    const float* CKV = (const float*)(p.ws + WS_BIG + BG_CKV); bf16_t* SP = (bf16_t*)(p.ws + WS_BIG + BG_SPREV);
    const float* rld = p.inp(10);
    for (int q = C.bid * NTHR + C.tid; q < 8 * 16384; q += C.G * NTHR) {
        const int dh = q >> 14, el = (q & 16383) * 4, dir = dh >> 2, h = dh & 3;
        const float gch = fast_exp(128.0f * rld[dir * 4 + h]);
        const float* src = CKV + (size_t)dh * 130 * 65536 + el; bf16_t* dst = SP + (size_t)dh * 130 * 65536 + el;
        f32x4 s = {0.f, 0.f, 0.f, 0.f};
        for (int st0 = 0; st0 < 130; st0 += 10) {
            f32x4 kv[10];
#pragma unroll
            for (int k = 0; k < 10; ++k) { const int st = st0 + k; const int u = dir == 0 ? st : (st == 0 ? 1 : (st == 1 ? 0 : 131 - st)); kv[k] = *(const f32x4*)(src + (size_t)u * 65536); }
#pragma unroll
            for (int k = 0; k < 10; ++k) { const int st = st0 + k; const int u = dir == 0 ? st : (st == 0 ? 1 : (st == 1 ? 0 : 131 - st));
                u32x2 w; w.x = cvt_pk_bf16(s[0], s[1]); w.y = cvt_pk_bf16(s[2], s[3]); *(u32x2*)(dst + (size_t)u * 65536) = w;
                s = s * gch + kv[k]; }
        }
    }
    const float* E = (const float*)(p.ws + WS_S5E); float* HST = (float*)(p.ws + WS_HST); const float* AL = (const float*)(p.ws + WS_AL);
    for (int q = C.bid * NTHR + C.tid; q < 2 * 64 * 64; q += C.G * NTHR) {
        const int dg = q >> 6, pp = q & 63;
        const f32x2 al = *(const f32x2*)(AL + (size_t)dg * 128 + 2 * pp);
        const float* e = E + (size_t)dg * 260 * 128; float* hs = HST + (size_t)dg * 260 * 128;
        float hr = 0.f, hi = 0.f;
        for (int c0 = 0; c0 < 260; c0 += 10) {
            float er[10], ei[10];
#pragma unroll
            for (int k = 0; k < 10; ++k) { er[k] = e[(size_t)(c0 + k) * 128 + pp]; ei[k] = e[(size_t)(c0 + k) * 128 + 64 + pp]; }
#pragma unroll
            for (int k = 0; k < 10; ++k) { *(f32x2*)(hs + (size_t)(c0 + k) * 128 + 2 * pp) = (f32x2){hr, hi};
                const float t = al.x * hr - al.y * hi + er[k]; hi = al.x * hi + al.y * hr + ei[k]; hr = t; }
        }
    }
}

__device__ __forceinline__ void ret_output_unit(const Params& p, Ctx& C, int unit) {
    const bf16_t* QKV = (const bf16_t*)(p.ws + WS_BIG + BG_QKV); const bf16_t* SP = (const bf16_t*)(p.ws + WS_BIG + BG_SPREV);
    bf16_t* MIX = (bf16_t*)(p.ws + WS_BIG + BG_MIX);
    const float* rld = p.inp(10);
    LAS bf16_t* RA = (LAS bf16_t*)C.lds; LAS bf16_t* RB = RA + 128 * RLD;
    int tid = C.tid; asm volatile("" : "+v"(tid));
    const int lane = tid & 63, w = C.wave, kq = lane >> 4, fr = lane & 15;
    const int u = unit >> 2, h = unit & 3;
    const float lgf = rld[h], lgb = rld[4 + h];
    stage_chunk<false>(QKV, 128 * u, 256 * h, RA, tid, 0.f, 0);
    int ib = 16 * w + 4 * kq, jb = fr; asm volatile("" : "+v"(ib), "+v"(jb));
    f32x4 acc[16];
#pragma unroll
    for (int t = 0; t < 16; ++t) acc[t] = (f32x4){0.f, 0.f, 0.f, 0.f};
#pragma unroll
    for (int dir = 0; dir < 2; ++dir) {
        const bf16_t* Sd = SP + ((size_t)((dir * 4 + h) * 130 + u)) * 65536;
#pragma unroll
        for (int eh = 0; eh < 2; ++eh) {
            __syncthreads();
#pragma unroll
            for (int q = 0; q < 8; ++q) { const int idx = tid + NTHR * q, rr = idx >> 5, c = idx & 31;
                *(LAS u32x4*)(RB + rr * RLD + 8 * c) = *(const u32x4*)(Sd + (size_t)(128 * eh + rr) * 256 + 8 * c);
                if (q == 3) asm volatile("" ::: "memory"); }
            __syncthreads();
#pragma unroll 1
            for (int ks = 0; ks < 8; ++ks) { const bf16x8 af = frag_rowk_l(RA + (16 * w) * RLD + 32 * ks, RLD, lane);
#pragma unroll
                for (int t = 0; t < 8; ++t) { const bf16x8 bf = frag_rowk_l(RB + (16 * t) * RLD + 32 * ks, RLD, lane); acc[8 * eh + t] = MFMA16(af, bf, acc[8 * eh + t]); } }
        }
#pragma unroll
        for (int r = 0; r < 4; ++r) { const int i = ib + r; const float qd = fast_exp((float)(128 - i) * lgb);
            const float f = (dir == 0) ? fast_exp((float)(i + 1) * lgf) / qd : qd;
#pragma unroll
            for (int t = 0; t < 16; ++t) acc[t][r] *= f; }
    }
    __syncthreads();
    stage_chunk<false>(QKV, 128 * u, 1024 + 256 * h, RB, tid, 0.f, 0);
    __syncthreads();
    f32x4 sc[8];
#pragma unroll
    for (int t = 0; t < 8; ++t) sc[t] = (f32x4){0.f, 0.f, 0.f, 0.f};
#pragma unroll 1
    for (int ks = 0; ks < 8; ++ks) { const bf16x8 af = frag_rowk_l(RA + (16 * w) * RLD + 32 * ks, RLD, lane);
#pragma unroll
        for (int t = 0; t < 8; ++t) { const bf16x8 bf = frag_rowk_l(RB + (16 * t) * RLD + 32 * ks, RLD, lane); sc[t] = MFMA16(af, bf, sc[t]); } }
#pragma unroll
    for (int t = 0; t < 8; ++t)
#pragma unroll
        for (int r = 0; r < 4; ++r) { const int i = ib + r, j = 16 * t + jb; const float d = (float)(i - j);
            const float m = (i >= j ? fast_exp(d * lgf) : 0.f) + (j >= i ? fast_exp(-d * lgb) : 0.f); sc[t][r] *= m; }
    __syncthreads();
    stage_chunk<false>(QKV, 128 * u, 2048 + 256 * h, RA, tid, 0.f, 0);
#pragma unroll
    for (int t = 0; t < 8; ++t)
#pragma unroll
        for (int r = 0; r < 4; ++r) RB[(16 * w + 4 * kq + r) * SLD + 16 * t + fr] = f2bf(sc[t][r]);
    __syncthreads();
    const unsigned vbase = (unsigned)(uintptr_t)RA;
#pragma unroll 1
    for (int ks = 0; ks < 4; ++ks) { const bf16x8 af = frag_rowk_l(RB + (16 * w) * SLD + 32 * ks, SLD, lane);
#pragma unroll
        for (int t = 0; t < 16; ++t) { const bf16x8 bf = frag_colk_l(vbase + (unsigned)((32 * ks) * RLD + 16 * t) * 2u, RLD * 2, lane); acc[t] = MFMA16(af, bf, acc[t]); } }
    __syncthreads();
#pragma unroll
    for (int r = 0; r < 4; ++r) {
        float s = 0.f;
#pragma unroll
        for (int t = 0; t < 16; ++t) s += acc[t][r];
        s += __shfl_xor(s, 1); s += __shfl_xor(s, 2); s += __shfl_xor(s, 4); s += __shfl_xor(s, 8);
        const float mean = s * (1.0f / 256.0f); float q = 0.f;
#pragma unroll
        for (int t = 0; t < 16; ++t) { const float d = acc[t][r] - mean; q += d * d; }
        q += __shfl_xor(q, 1); q += __shfl_xor(q, 2); q += __shfl_xor(q, 4); q += __shfl_xor(q, 8);
        const float rstd = rsqrtf(q * (1.0f / 256.0f) + LN_EPS);
#pragma unroll
        for (int t = 0; t < 16; ++t) RA[(16 * w + 4 * kq + r) * RLD + 16 * t + fr] = f2bf((acc[t][r] - mean) * rstd);
    }
    __syncthreads();
#pragma unroll
    for (int q = 0; q < 8; ++q) { const int idx = tid + NTHR * q, rr = idx >> 5, c = idx & 31; const size_t row = (size_t)(128 * u + rr);
        const u32x4 o = *(const LAS u32x4*)(RA + rr * RLD + 8 * c), g = *(const u32x4*)(QKV + row * EV_IN + 3072 + 256 * h + 8 * c);
        u32x4 w4;
        w4.x = cvt_pk_bf16(bflo(o.x) * siluf_(bflo(g.x)), bfhi(o.x) * siluf_(bfhi(g.x))); w4.y = cvt_pk_bf16(bflo(o.y) * siluf_(bflo(g.y)), bfhi(o.y) * siluf_(bfhi(g.y)));
        w4.z = cvt_pk_bf16(bflo(o.z) * siluf_(bflo(g.z)), bfhi(o.z) * siluf_(bfhi(g.z))); w4.w = cvt_pk_bf16(bflo(o.w) * siluf_(bflo(g.w)), bfhi(o.w) * siluf_(bfhi(g.w)));
        *(u32x4*)(MIX + row * DM + 256 * h + 8 * c) = w4; }
    __syncthreads();
}

constexpr int KLD = 1032;
__device__ __forceinline__ void s5_output_task(const Params& p, Ctx& C, int bt) {
    const bf16_t* QKV = (const bf16_t*)(p.ws + WS_BIG + BG_QKV); bf16_t* Z = (bf16_t*)(p.ws + WS_Z);
    const bf16_t* KN = (const bf16_t*)(p.ws + WS_KN); const bf16_t* CCt = (const bf16_t*)(p.ws + WS_CC);
    const float* APOW = (const float*)(p.ws + WS_APOW); const float* HST = (const float*)(p.ws + WS_HST); const float* dsk = p.inp(18);
    int tid = C.tid; asm volatile("" : "+v"(tid));
    const int lane = tid & 63, kq = lane >> 4, fr = lane & 15;
    LAS bf16_t* KF = (LAS bf16_t*)C.lds; LAS bf16_t* KB = KF + 16 * KLD;
    LAS bf16_t* U = KB + 16 * KLD + C.wave * 3072;
    LAS float* PW0 = (LAS float*)(KB + 16 * KLD + 8 * 3072);
    LAS float* PW16 = PW0 + 2 * 16 * 128;
    {
        const int g = bt >> 3, k0 = (260 * (bt & 7)) >> 3, k1 = (260 * ((bt & 7) + 1)) >> 3;
#pragma unroll
        for (int q = 0; q < 8; ++q) { const int idx = tid + NTHR * q, dir = idx >> 11, rr = (idx >> 7) & 15, c = idx & 127;
            *(LAS u32x4*)((dir ? KB : KF) + rr * KLD + 8 * c) = *(const u32x4*)(KN + ((size_t)(dir * 64 + g) * 16 + rr) * 1024 + 8 * c); }
        for (int q = lane; q < 192 * 2; q += 64) *(LAS u32x4*)(U + 8 * q) = (u32x4){0u, 0u, 0u, 0u};
#pragma unroll
        for (int q = 0; q < 2; ++q) { const int idx = tid + NTHR * q, dir = idx >> 9, f = (idx >> 5) & 15, c4 = idx & 31;
            *(LAS f32x4*)(PW0 + dir * 2048 + f * 128 + 4 * c4) = *(const f32x4*)(APOW + ((size_t)(dir * 64 + g) * 64 + (dir == 0 ? f : 15 - f)) * 128 + 4 * c4); }
        if (tid < 64) { const int dir = tid >> 5, c4 = tid & 31; *(LAS f32x4*)(PW16 + dir * 128 + 4 * c4) = *(const f32x4*)(APOW + ((size_t)(dir * 64 + g) * 64 + 15) * 128 + 4 * c4); }
        __syncthreads();
        const f32x4 dv = *(const f32x4*)(dsk + 16 * g + 4 * kq);
        bf16x8 ccr[2], cci[2];
#pragma unroll
        for (int hb = 0; hb < 2; ++hb) { ccr[hb] = frag_rowk_g(CCt + (size_t)g * 16 * 128 + 32 * hb, 128, lane); cci[hb] = frag_rowk_g(CCt + (size_t)g * 16 * 128 + 64 + 32 * hb, 128, lane); }
        const LAS float* pw0l = PW0 + (size_t)fr * 128 + 16 * kq;
        const LAS float* pw16l = PW16 + 16 * kq;
        for (int k = k0 + C.wave; k < k1; k += 8) {
            LDS_WAIT(); asm volatile("" ::: "memory");
            for (int q = lane; q < 128; q += 64) { const int t = q >> 1, hf = q & 1;
                *(LAS u32x4*)(U + (64 + t) * 16 + 8 * hf) = *(const u32x4*)(QKV + (size_t)(64 * k + t) * EV_IN + 4096 + 16 * g + 8 * hf); }
            LDS_WAIT(); asm volatile("" ::: "memory");
            const int cf = k, cb = k < 4 ? 3 - k : 263 - k;
            f32x4 acc[4];
#pragma unroll
            for (int tt = 0; tt < 4; ++tt) acc[tt] = (f32x4){0.f, 0.f, 0.f, 0.f};
            const LAS bf16_t* ubf = U + (64 + fr - (kq >> 1)) * 16 + 8 * (kq & 1);
            const LAS bf16_t* ubb = U + (64 + fr + (kq >> 1)) * 16 + 8 * (kq & 1);
#pragma unroll
            for (int n0 = 0; n0 < 64; n0 += 2) {
                const bf16x8 af = frag_rowk_l(KF + n0 * 16, KLD, lane), ab = frag_rowk_l(KB + n0 * 16, KLD, lane);
#pragma unroll
                for (int tt = 0; tt < 4; ++tt) {
                    if (n0 <= 16 * tt + 14) acc[tt] = MFMA16(af, *(const LAS bf16x8*)(ubf + (16 * tt - n0) * 16), acc[tt]);
                    if (n0 <= 62 - 16 * tt) acc[tt] = MFMA16(ab, *(const LAS bf16x8*)(ubb + (16 * tt + n0) * 16), acc[tt]);
                }
                asm volatile("" ::: "memory");
            }
#pragma unroll
            for (int dir = 0; dir < 2; ++dir) {
                const float* hp = HST + ((size_t)(dir * 64 + g) * 260 + (dir == 0 ? cf : cb)) * 128;
#pragma unroll
                for (int hb = 0; hb < 2; ++hb) {
                    float xr[8], xi[8];
#pragma unroll
                    for (int e2 = 0; e2 < 4; ++e2) { const f32x4 h4 = *(const f32x4*)(hp + 2 * (32 * hb + 8 * kq) + 4 * e2), b4 = *(const LAS f32x4*)(pw0l + dir * 2048 + hb * 64 + 4 * e2);
                        xr[2 * e2] = b4[0] * h4[0] - b4[1] * h4[1]; xi[2 * e2] = b4[0] * h4[1] + b4[1] * h4[0];
                        xr[2 * e2 + 1] = b4[2] * h4[2] - b4[3] * h4[3]; xi[2 * e2 + 1] = b4[2] * h4[3] + b4[3] * h4[2]; }
#pragma unroll
                    for (int st = 0; st < 4; ++st) {
                        const int tt = dir == 0 ? st : 3 - st;
                        u32x4 br, bi;
                        br.x = cvt_pk_bf16(xr[0], xr[1]); br.y = cvt_pk_bf16(xr[2], xr[3]); br.z = cvt_pk_bf16(xr[4], xr[5]); br.w = cvt_pk_bf16(xr[6], xr[7]);
                        bi.x = cvt_pk_bf16(xi[0], xi[1]); bi.y = cvt_pk_bf16(xi[2], xi[3]); bi.z = cvt_pk_bf16(xi[4], xi[5]); bi.w = cvt_pk_bf16(xi[6], xi[7]);
                        acc[tt] = MFMA16(ccr[hb], __builtin_bit_cast(bf16x8, br), acc[tt]);
                        acc[tt] = MFMA16(cci[hb], __builtin_bit_cast(bf16x8, bi), acc[tt]);
                        if (st < 3) {
#pragma unroll
                            for (int e2 = 0; e2 < 4; ++e2) { const f32x4 a4 = *(const LAS f32x4*)(pw16l + dir * 128 + hb * 64 + 4 * e2);
                                float t0 = xr[2 * e2] * a4[0] - xi[2 * e2] * a4[1]; xi[2 * e2] = xr[2 * e2] * a4[1] + xi[2 * e2] * a4[0]; xr[2 * e2] = t0;
                                t0 = xr[2 * e2 + 1] * a4[2] - xi[2 * e2 + 1] * a4[3]; xi[2 * e2 + 1] = xr[2 * e2 + 1] * a4[3] + xi[2 * e2 + 1] * a4[2]; xr[2 * e2 + 1] = t0; }
                        }
                    }
                }
            }
#pragma unroll
            for (int tt = 0; tt < 4; ++tt) { const int t = 16 * tt + fr;
                const u32x2 uu = *(const LAS u32x2*)(U + (64 + t) * 16 + 4 * kq);
                const float y0 = acc[tt][0] + bflo(uu.x) * dv[0], y1 = acc[tt][1] + bfhi(uu.x) * dv[1], y2 = acc[tt][2] + bflo(uu.y) * dv[2], y3 = acc[tt][3] + bfhi(uu.y) * dv[3];
                u32x2 w; w.x = cvt_pk_bf16(gelu_tanh(y0), gelu_tanh(y1)); w.y = cvt_pk_bf16(gelu_tanh(y2), gelu_tanh(y3));
                *(u32x2*)(Z + (size_t)(64 * k + t) * 1024 + 16 * g + 4 * kq) = w; }
        }
    }
    __syncthreads();
}

__device__ __forceinline__ void phase_ret_s5_outputs(const Params& p, Ctx& C, LAS unsigned char* misc) {
    unsigned* head = (unsigned*)(p.ws + WS_CTL) + CW_QUEUE;
    volatile LAS int* slot = (volatile LAS int*)(misc + 32);
    for (;;) {
        __syncthreads();
        if (C.tid == 0) slot[0] = (int)atomicAdd(head, 1u);
        __syncthreads();
        const int item = __builtin_amdgcn_readfirstlane(slot[0]);
        if (item >= 520) break;
        ret_output_unit(p, C, item);
    }
    for (;;) {
        __syncthreads();
        if (C.tid == 0) slot[0] = (int)atomicAdd(head + 64, 1u);
        __syncthreads();
        const int item = __builtin_amdgcn_readfirstlane(slot[0]);
        if (item >= 512) break;
        s5_output_task(p, C, item);
    }
}
__device__ __forceinline__ void phase_router(const Params& p, Ctx& C, int L) {
    const float* X1 = (const float*)(p.ws + WS_X1);
    const bf16_t* RWh = (const bf16_t*)(p.ws + WS_RWT) + (size_t)(L * 2 + 0) * 64 * DM; const bf16_t* RWl = (const bf16_t*)(p.ws + WS_RWT) + (size_t)(L * 2 + 1) * 64 * DM;
    const float* rbias = p.inp(27) + L * 64;
    int* cnt = (int*)(p.ws + WS_CTL) + CW_CNT + L * 128; int* LIST = (int*)(p.ws + WS_LIST); unsigned* PK = (unsigned*)(p.ws + WS_WGT); float* LW = (float*)(p.ws + WS_LW);
    const int lane = C.lane, kq = lane >> 4, fr = lane & 15;
    LAS float* Lg = (LAS float*)(C.lds + C.wave * 8192);
    const int r0 = (L == 0) ? 0 : CTXL, nrows = TT - r0;
    if (C.bid == 0 && C.tid == 0) cnt[64] = nrows;
    for (int task = C.gw; task < nrows / 16; task += C.ngw) {
        const int rbase = r0 + 16 * task, row = rbase + fr;
        const int v = row < CTXL ? 1 : 0;
        const float* xr = X1 + (size_t)row * DM; const float* sc2 = modv(p, L, v, 4); const float* sh2 = modv(p, L, v, 3);
        f32x4 acc[4];
#pragma unroll
        for (int t = 0; t < 4; ++t) acc[t] = (f32x4){0.f, 0.f, 0.f, 0.f};
#pragma unroll 2
        for (int ks = 0; ks < 64; ++ks) { const int c0 = 32 * ks + 8 * kq;
            const f32x4 x0 = *(const f32x4*)(xr + c0), x1 = *(const f32x4*)(xr + c0 + 4);
            const f32x4 a0 = *(const f32x4*)(sc2 + c0), a1 = *(const f32x4*)(sc2 + c0 + 4), b0 = *(const f32x4*)(sh2 + c0), b1 = *(const f32x4*)(sh2 + c0 + 4);
            const f32x4 y0 = x0 * (a0 + 1.0f) + b0, y1 = x1 * (a1 + 1.0f) + b1;
            u32x4 hi; hi.x = cvt_pk_bf16(y0[0], y0[1]); hi.y = cvt_pk_bf16(y0[2], y0[3]); hi.z = cvt_pk_bf16(y1[0], y1[1]); hi.w = cvt_pk_bf16(y1[2], y1[3]);
            u32x4 lo; lo.x = cvt_pk_bf16(y0[0] - bflo(hi.x), y0[1] - bfhi(hi.x)); lo.y = cvt_pk_bf16(y0[2] - bflo(hi.y), y0[3] - bfhi(hi.y));
            lo.z = cvt_pk_bf16(y1[0] - bflo(hi.z), y1[1] - bfhi(hi.z)); lo.w = cvt_pk_bf16(y1[2] - bflo(hi.w), y1[3] - bfhi(hi.w));
            const bf16x8 ah = __builtin_bit_cast(bf16x8, hi), al = __builtin_bit_cast(bf16x8, lo);
#pragma unroll
            for (int t = 0; t < 4; ++t) { const bf16x8 bh = frag_rowk_g(RWh + (size_t)(16 * t) * DM + 32 * ks, DM, lane), bl = frag_rowk_g(RWl + (size_t)(16 * t) * DM + 32 * ks, DM, lane);
                acc[t] = MFMA16(ah, bh, acc[t]); acc[t] = MFMA16(al, bh, acc[t]); acc[t] = MFMA16(ah, bl, acc[t]); } }
        LDS_WAIT(); asm volatile("" ::: "memory");
#pragma unroll
        for (int t = 0; t < 4; ++t)
#pragma unroll
            for (int r = 0; r < 4; ++r) Lg[(4 * kq + r) * 65 + 16 * t + fr] = acc[t][r];
        LDS_WAIT(); asm volatile("" ::: "memory");
        if (lane < 16) {
            LAS float* sr = Lg + lane * 65; const int trow = rbase + lane;
            float gs[8];
#pragma unroll
            for (int g = 0; g < 8; ++g) { float m1 = -1e30f, m2 = -1e30f;
                for (int j = 0; j < 8; ++j) { const int e = 8 * g + j; const float s = sigmoidf_(sr[e]); sr[e] = s; const float vv = s + rbias[e];
                    if (vv > m1) { m2 = m1; m1 = vv; } else if (vv > m2) m2 = vv; }
                gs[g] = m1 + m2; }
            unsigned gmask = 0u;
#pragma unroll
            for (int it = 0; it < 4; ++it) { float best = -1e30f; int bi = 0;
#pragma unroll
                for (int g = 0; g < 8; ++g) { const bool ok = !((gmask >> g) & 1u) && gs[g] > best; best = ok ? gs[g] : best; bi = ok ? g : bi; }
                gmask |= 1u << bi; }
            unsigned long long taken = 0ull; int sel[8]; float sw[8]; float wsum = 0.f;
#pragma unroll
            for (int k = 0; k < 8; ++k) { float best = -1e30f; int bi = 0;
                for (int e = 0; e < 64; ++e) { const bool cand = ((gmask >> (e >> 3)) & 1u) && !((taken >> e) & 1ull); const float vv = sr[e] + rbias[e];
                    if (cand && vv > best) { best = vv; bi = e; } }
                taken |= 1ull << bi; sel[k] = bi; sw[k] = sr[bi]; wsum += sw[k]; }
            const float inv = 2.5f / wsum;
#pragma unroll
            for (int k = 0; k < 8; ++k) { const int a = trow * 8 + k; const int pos = atomicAdd(&cnt[sel[k]], 1);
                LIST[(size_t)sel[k] * TT + pos] = a; PK[a] = ((unsigned)sel[k] << 16) | (unsigned)pos; LW[(size_t)sel[k] * TT + pos] = sw[k] * inv; }
            LIST[(size_t)64 * TT + (trow - r0)] = 8 * TT + trow; LW[(size_t)64 * TT + (trow - r0)] = 1.0f;
        }
    }
}
namespace att {
constexpr int D = 128, NW = 8, QBLK = 32, KVBLK = 64;
constexpr float SCALE = 0.088388347648318440f;
constexpr float THR = 8.f;
constexpr int SHM_V = KVBLK * D * 2, SHM_K = KVBLK * D * 2, SHM_ATTN = 2 * SHM_V + 2 * SHM_K + NW * 64 * 4;
#define KSWZ(row, colB) ((row) * 256 + ((colB) ^ (((row) & 7) << 4)))
#define SBAR() __builtin_amdgcn_sched_barrier(0)
__device__ __forceinline__ int crow(int r, int hi) { return (r & 3) + 8 * (r >> 2) + 4 * hi; }
__device__ __forceinline__ unsigned cvtpk(float lo, float hi) { unsigned r; asm volatile("v_cvt_pk_bf16_f32 %0, %1, %2" : "=v"(r) : "v"(lo), "v"(hi)); return r; }

__device__ __forceinline__ void partialSM(f32x16& p0, f32x16& p1, float& m_reg, float& mn, float& alpha) {
  constexpr float Cc = SCALE * 1.4426950408889634f;
  float pmax = p0[0]; for (int r = 1; r < 16; ++r) pmax = fmaxf(pmax, p0[r]); for (int r = 0; r < 16; ++r) pmax = fmaxf(pmax, p1[r]);
  { auto rr = __builtin_amdgcn_permlane32_swap(__float_as_uint(pmax), __float_as_uint(pmax), false, false);
    pmax = fmaxf(__uint_as_float(rr[0]), __uint_as_float(rr[1])); }
  if (__builtin_expect(__all(pmax - m_reg <= THR / SCALE), 1)) { mn = m_reg; alpha = 1.f; }
  else { mn = fmaxf(m_reg, pmax); alpha = __builtin_amdgcn_exp2f((m_reg - mn) * Cc); m_reg = mn; }
  float mnC = -mn * Cc;
  for (int r = 0; r < 16; ++r) p0[r] = fmaf(p0[r], Cc, mnC); for (int r = 0; r < 16; ++r) p1[r] = fmaf(p1[r], Cc, mnC);
  for (int r = 0; r < 16; ++r) p0[r] = __builtin_amdgcn_exp2f(p0[r]);
}
__device__ __forceinline__ void finishSM(f32x16& p0, f32x16& p1, float alpha, float& l_reg, bf16x8& pa0, bf16x8& pa1, bf16x8& pa2, bf16x8& pa3) {
  for (int r = 0; r < 16; ++r) p1[r] = __builtin_amdgcn_exp2f(p1[r]);
  float ps = 0; for (int r = 0; r < 16; ++r) ps += p0[r]; for (int r = 0; r < 16; ++r) ps += p1[r];
  { auto rr = __builtin_amdgcn_permlane32_swap(__float_as_uint(ps), __float_as_uint(ps), false, false);
    ps = __uint_as_float(rr[0]) + __uint_as_float(rr[1]); }
  l_reg = l_reg * alpha + ps;
#define PK4(P, BASE, OUT) do { unsigned a0 = cvtpk(P[BASE + 0], P[BASE + 1]), a1 = cvtpk(P[BASE + 2], P[BASE + 3]);   \
    unsigned b0 = cvtpk(P[BASE + 4], P[BASE + 5]), b1 = cvtpk(P[BASE + 6], P[BASE + 7]);                              \
    auto r0 = __builtin_amdgcn_permlane32_swap(a0, b0, false, false); auto r1 = __builtin_amdgcn_permlane32_swap(a1, b1, false, false); \
    u32x4 w = {r0[0], r1[0], r0[1], r1[1]}; OUT = *reinterpret_cast<bf16x8*>(&w); } while (0)
  PK4(p0, 0, pa0); PK4(p0, 8, pa1); PK4(p1, 0, pa2); PK4(p1, 8, pa3);
#undef PK4
}
__device__ __forceinline__ void qkt(f32x16& p0, f32x16& p1, const LAS char* Ks, const bf16x8* qr, int r32, int hi) {
  p0 = f32x16{}; p1 = f32x16{};
  for (int d0 = 0; d0 < 8; ++d0) { int cb = (d0 * 16 + hi * 8) * 2;
    bf16x8 b0 = *reinterpret_cast<const LAS bf16x8*>(Ks + KSWZ(r32, cb));
    bf16x8 b1 = *reinterpret_cast<const LAS bf16x8*>(Ks + KSWZ(32 + r32, cb));
    p0 = __builtin_amdgcn_mfma_f32_32x32x16_bf16(b0, qr[d0], p0, 0, 0, 0);
    p1 = __builtin_amdgcn_mfma_f32_32x32x16_bf16(b1, qr[d0], p1, 0, 0, 0); }
}
__device__ __forceinline__ int v_st(int k, int c) { const int kk = (k & ~0xC) | ((k & 4) << 1) | ((k & 8) >> 1); return ((kk >> 3) * 4 + (c >> 5)) * 512 + ((kk & 7) * 32 + (c & 31)) * 2; }
__device__ __forceinline__ int v_rd_base(int lane) { return ((lane & 3) << 3) | (((lane >> 2) & 3) << 6) | (((lane >> 4) & 1) << 5) | (((lane >> 5) & 1) << 8); }
constexpr int v_rd_off(int d0, int ks, int half) { return d0 * 512 + ks * 4096 + half * 2048; }
template <int OFF> __device__ __forceinline__ s16x4 tr_read(int vb) {
  s16x4 r; asm volatile("ds_read_b64_tr_b16 %0, %1 offset:%2" : "=&v"(r) : "v"(vb), "i"(OFF) : "memory"); return r;
}
template <int D0> __device__ __forceinline__ void pv_one(f32x16& od, int vb, bf16x8 pa0, bf16x8 pa1, bf16x8 pa2, bf16x8 pa3) {
  const s16x4 l0 = tr_read<v_rd_off(D0, 0, 0)>(vb), h0 = tr_read<v_rd_off(D0, 0, 1)>(vb), l1 = tr_read<v_rd_off(D0, 1, 0)>(vb), h1 = tr_read<v_rd_off(D0, 1, 1)>(vb);
  const s16x4 l2 = tr_read<v_rd_off(D0, 2, 0)>(vb), h2 = tr_read<v_rd_off(D0, 2, 1)>(vb), l3 = tr_read<v_rd_off(D0, 3, 0)>(vb), h3 = tr_read<v_rd_off(D0, 3, 1)>(vb);
  asm volatile("s_waitcnt lgkmcnt(0)" ::: "memory"); SBAR();
#define PK(L, H) (bf16x8){L[0], L[1], L[2], L[3], H[0], H[1], H[2], H[3]}
  od = __builtin_amdgcn_mfma_f32_32x32x16_bf16(pa0, PK(l0, h0), od, 0, 0, 0);
  od = __builtin_amdgcn_mfma_f32_32x32x16_bf16(pa1, PK(l1, h1), od, 0, 0, 0);
  od = __builtin_amdgcn_mfma_f32_32x32x16_bf16(pa2, PK(l2, h2), od, 0, 0, 0);
  od = __builtin_amdgcn_mfma_f32_32x32x16_bf16(pa3, PK(l3, h3), od, 0, 0, 0);
#undef PK
}
__device__ __forceinline__ void pv_d0(f32x16* o, int vb, bf16x8 pa0, bf16x8 pa1, bf16x8 pa2, bf16x8 pa3) {
  pv_one<0>(o[0], vb, pa0, pa1, pa2, pa3); pv_one<1>(o[1], vb, pa0, pa1, pa2, pa3); pv_one<2>(o[2], vb, pa0, pa1, pa2, pa3); pv_one<3>(o[3], vb, pa0, pa1, pa2, pa3);
}

template <int LDQ, int LDK, int LDO>
__device__ __forceinline__ void attn_dense_body(const bf16_t* __restrict__ Qb, const bf16_t* __restrict__ Kh, const bf16_t* __restrict__ Vh, bf16_t* __restrict__ Ob, int seq, LAS char* lds, int tid) {
  const int wid = tid >> 6, lane = tid & 63, r32 = lane & 31, hi = lane >> 5;
  LAS char* V_lds = lds; LAS char* K_lds = lds + 2 * SHM_V;
  LAS float* ws = (LAS float*)(lds + 2 * SHM_V + 2 * SHM_K) + wid * 64; LAS float* li_l = ws; LAS float* al_l = ws + 32;
  float m_reg = -1e30f, l_reg = 0; f32x16 o[4] = {}; bf16x8 qr[8];
  const bf16_t* Qw = Qb + (long)(wid * QBLK + r32) * LDQ + hi * 8;
#pragma unroll
  for (int d0 = 0; d0 < 8; ++d0) qr[d0] = *reinterpret_cast<const bf16x8*>(Qw + d0 * 16);
  const int sr = tid >> 4, sc = (tid & 15) * 8, vst0 = v_st(sr, sc), vst1 = v_st(32 + sr, sc);
  const int vb0 = (int)(uintptr_t)V_lds + v_rd_base(lane);
  struct { bf16x8 vs0, vs1, ks0, ks1; } sr_[2];
#define SLOAD(i, k0) do { sr_[i].vs0 = *reinterpret_cast<const bf16x8*>(&Vh[(long)((k0) + sr) * LDK + sc]); sr_[i].vs1 = *reinterpret_cast<const bf16x8*>(&Vh[(long)((k0) + 32 + sr) * LDK + sc]); \
    sr_[i].ks0 = *reinterpret_cast<const bf16x8*>(&Kh[(long)((k0) + sr) * LDK + sc]); sr_[i].ks1 = *reinterpret_cast<const bf16x8*>(&Kh[(long)((k0) + 32 + sr) * LDK + sc]); } while (0)
#define SWRITE(b, i) do { *(LAS bf16x8*)(V_lds + (b) * SHM_V + vst0) = sr_[i].vs0;          \
    *(LAS bf16x8*)(V_lds + (b) * SHM_V + vst1) = sr_[i].vs1; int kc = sc * 2;               \
    *(LAS bf16x8*)(K_lds + (b) * SHM_K + KSWZ(sr, kc)) = sr_[i].ks0;                       \
    *(LAS bf16x8*)(K_lds + (b) * SHM_K + KSWZ(32 + sr, kc)) = sr_[i].ks1; } while (0)
#define SWAIT() asm volatile("s_waitcnt vmcnt(4)" ::: "memory")
#define RESC(a) do { if (__any((a) < 1.f)) { if (hi == 0) al_l[r32] = (a); asm volatile("s_waitcnt lgkmcnt(0)" ::: "memory"); \
    for (int d = 0; d < 4; ++d) for (int r = 0; r < 16; ++r) o[d][r] *= al_l[crow(r, hi)]; } } while (0)
  f32x16 pA0, pA1, pB0, pB1; float mnA, mnB, alA, alB; bf16x8 pa0, pa1, pa2, pa3; const int NT = seq / KVBLK;
  constexpr int SE = 0, SO = 1;
  SLOAD(SE, 0); asm volatile("s_waitcnt vmcnt(0)" ::: "memory"); SWRITE(0, SE); __syncthreads();
  qkt(pA0, pA1, K_lds, qr, r32, hi); partialSM(pA0, pA1, m_reg, mnA, alA);
  SLOAD(SO, KVBLK); if (2 < NT) SLOAD(SE, 2 * KVBLK);
  SWAIT(); SWRITE(1, SO); __syncthreads();
  for (int j = 1; j + 1 < NT; j += 2) {
    SBAR(); qkt(pB0, pB1, K_lds + SHM_K, qr, r32, hi);
    finishSM(pA0, pA1, alA, l_reg, pa0, pa1, pa2, pa3); SBAR();
    SLOAD(SO, (j + 2) * KVBLK); SBAR();
    pv_d0(o, vb0, pa0, pa1, pa2, pa3); partialSM(pB0, pB1, m_reg, mnB, alB);
    __syncthreads(); SWAIT(); SWRITE(0, SE);
    RESC(alB); __syncthreads();
    SBAR(); qkt(pA0, pA1, K_lds, qr, r32, hi);
    finishSM(pB0, pB1, alB, l_reg, pa0, pa1, pa2, pa3); SBAR();
    if (j + 3 < NT) SLOAD(SE, (j + 3) * KVBLK); SBAR();
    pv_d0(o, vb0 + (int)SHM_V, pa0, pa1, pa2, pa3); partialSM(pA0, pA1, m_reg, mnA, alA);
    __syncthreads(); SWAIT(); SWRITE(1, SO);
    RESC(alA); __syncthreads();
  }
  SBAR(); qkt(pB0, pB1, K_lds + SHM_K, qr, r32, hi);
  finishSM(pA0, pA1, alA, l_reg, pa0, pa1, pa2, pa3); SBAR();
  pv_d0(o, vb0, pa0, pa1, pa2, pa3); partialSM(pB0, pB1, m_reg, mnB, alB);
  __syncthreads(); RESC(alB);
  finishSM(pB0, pB1, alB, l_reg, pa0, pa1, pa2, pa3); SBAR();
  pv_d0(o, vb0 + (int)SHM_V, pa0, pa1, pa2, pa3);
  if (hi == 0) li_l[r32] = l_reg; asm volatile("s_waitcnt lgkmcnt(0)" ::: "memory");
  float rli[16];
#pragma unroll
  for (int r = 0; r < 16; ++r) rli[r] = __builtin_amdgcn_rcpf(li_l[crow(r, hi)]);
  bf16_t* Ow = Ob + (long)(wid * QBLK) * LDO;
#pragma unroll
  for (int r = 0; r < 16; ++r) { int orow = crow(r, hi);
    for (int d0 = 0; d0 < 4; ++d0) Ow[(long)orow * LDO + d0 * 32 + r32] = (bf16_t)(cvtpk(o[d0][r] * rli[r], 0.f) & 0xffffu); }
#undef SLOAD
#undef SWRITE
#undef SWAIT
#undef RESC
}
#undef KSWZ
}

__device__ __forceinline__ void phase_attention(const Params& p, Ctx& C) {
    const bf16_t* QKV = (const bf16_t*)(p.ws + WS_BIG + BG_QKV); bf16_t* ATT = (bf16_t*)(p.ws + WS_BIG + BG_ATT);
    const int nunits = 24 * 64;
    for (int i = 0;; ++i) {
        int unit;
        if (C.G == 256) { const int xcd = C.bid & 7, slot = C.bid >> 3; if (i >= 6) break; unit = (xcd * 3 + (i >> 1)) * 64 + (i & 1) * 32 + slot; }
        else { unit = i * C.G + C.bid; if (unit >= nunits) break; }
        const int prob = unit >> 6, qb = unit & 63;
        int qc, kc, vc, oc;
        if (prob < 8) { qc = 128 * prob; kc = 1024 + 128 * (prob >> 2); vc = 1280 + 128 * (prob >> 2); oc = 128 * prob; }
        else { const int d = prob - 8, h = d >> 2, m = (d >> 1) & 1, vh = d & 1; qc = 1536 + 256 * h + 128 * m; kc = 2560 + 256 * h + 128 * m; vc = 3584 + 256 * h + 128 * vh; oc = 1024 + 1024 * m + 256 * h + 128 * vh; }
        __syncthreads();
        att::attn_dense_body<OD_IN, OD_IN, 3072>(QKV + (size_t)(CTXL + 256 * qb) * OD_IN + qc, QKV + kc, QKV + vc, ATT + (size_t)(256 * qb) * 3072 + oc, TT, (LAS char*)C.lds, C.tid);
    }
    __syncthreads();
}
constexpr int PH_PER_LAYER = 13, N_PHASES = 2 + 2 * PH_PER_LAYER;
#ifndef DBL_PHASE
#define DBL_PHASE -1
#endif
#ifndef MK_PER_PHASE
#define MK_PER_PHASE 0
#endif

template <int L>
__device__ __forceinline__ void layer_body(const Params& p, Ctx& C0, const XcdBarrier& bar, LAS unsigned char* misc, int lo, int hi) {
#define IN(k) (lo <= (k) && (k) < hi)
#define SEAM(k) do { if (IN(k) && IN((k) + 1)) xcd_barrier(bar, C0.wave); } while (0)
#define PHASE(k, ...) if (IN(k)) { FRESH(); __VA_ARGS__ } if (DBL_PHASE == (k)) { xcd_barrier(bar, C0.wave); { FRESH(); __VA_ARGS__ } } SEAM(k);
#define FRESH() Ctx C = C0; { int ln = (int)__builtin_amdgcn_mbcnt_hi(~0u, __builtin_amdgcn_mbcnt_lo(~0u, 0u)); asm volatile("" : "+v"(ln)); C.lane = ln; C.tid = C.wave * 64 + ln; }
        const int b = 2 + PH_PER_LAYER * L;
        bf16_t* QKV = (bf16_t*)(p.ws + WS_BIG + BG_QKV);
        bf16_t* XA = (bf16_t*)(p.ws + WS_XA);
        int* cnt = (int*)(p.ws + WS_CTL) + CW_CNT + L * 128; const int* LIST = (const int*)(p.ws + WS_LIST);
        PHASE(b + 0, phase_modulate(p, C, L); )
        PHASE(b + 1,
            const int N = L ? OD_IN : EV_IN;
            pg8::DenseOrder S; S.init8((const void*)XA, DM, (const void*)(p.ws + (L ? WS_WIN1 : WS_WIN0)), TT, N, DM, C.G, C.bid);
            pg8::EpiStore E{QKV, N, 1.0f / 32.0f};
            pg8::gemm_phase<true>(C.lds, S, E, C.wave);
        )
        PHASE(b + 2, if (L == 0) phase_rope0(p, C); else phase_normrope1(p, C); )
        PHASE(b + 3, if (L == 0) { ret_chunk_kv(p, C); s5_end_states(p, C); } else phase_attention(p, C); )
        PHASE(b + 4, if (L == 0) phase_scans(p, C); else phase_merge1(p, C); )
        if (L == 0) {
            PHASE(b + 5, phase_ret_s5_outputs(p, C, misc); )
            PHASE(b + 6,
                pg8::DenseOrder S; S.init((const bf16_t*)(p.ws + WS_Z), 1024, (const bf16_t*)(p.ws + WS_WGLU), TT, 1024, 1024, C.G, C.bid);
                pg8::EpiGlu E{(const bf16_t*)(p.ws + WS_Z), p.inp(20), (bf16_t*)(p.ws + WS_BIG + BG_MIX)};
                pg8::gemm_phase<false>(C.lds, S, E, C.wave);
            )
        }
        PHASE(b + 7,
            pg8::DenseOrder S;
            if (L == 0) S.init((const bf16_t*)(p.ws + WS_BIG + BG_MIX), DM, (const bf16_t*)(p.ws + WS_WOUT0), TT, DM, DM, C.G, C.bid);
            else S.init((const bf16_t*)(p.ws + WS_BIG + BG_ATT), 3072, (const bf16_t*)(p.ws + WS_WOUT1), SEQ, DM, DM, C.G, C.bid);
            pg8::EpiStore E{(bf16_t*)(p.ws + WS_YMIX) + (L ? (size_t)CTXL * DM : 0), DM, 1.0f};
            pg8::gemm_phase<false>(C.lds, S, E, C.wave);
        )
        PHASE(b + 8, phase_ln1(p, C, L); )
        PHASE(b + 9, phase_router(p, C, L); )
        PHASE(b + 10,
            pg8::MoeOrder<0> S; S.A = (const void*)XA; S.Bt = (const void*)(p.ws + WS_GU); S.list = LIST; S.cnt = cnt; S.ldab = DM; S.kb = DM; S.nN = 4; S.G = C.G; S.c = C.bid; S.bstride = (size_t)1024 * DM;
            S.prep(misc, C.tid);
            pg8::EpiE1 E{(unsigned char*)(p.ws + WS_HX2), S.cn, S.rb};
            pg8::gemm_phase<true>(C.lds, S, E, C.wave);
        )
        PHASE(b + 11,
            pg8::MoeOrder<1> S; S.A = (const void*)(p.ws + WS_HX2); S.Bt = (const void*)(p.ws + WS_DT); S.list = LIST; S.cnt = cnt; S.ldab = EHID; S.kb = EHID; S.nN = 8; S.G = C.G; S.c = C.bid; S.bstride = (size_t)DM * EHID;
            S.prep(misc, C.tid);
            pg8::EpiE2 E{(unsigned char*)(p.ws + WS_BIG + BG_YMOE), (const float*)(p.ws + WS_LW), S.cn, S.rb};
            pg8::gemm_phase<true>(C.lds, S, E, C.wave);
        )
        PHASE(b + 12, phase_combine(p, C, L, misc); )
    #undef IN
#undef SEAM
#undef FRESH
#undef PHASE
}

__global__ void __launch_bounds__(NTHR, 2) mega_fwd(KArgs ka) {
    extern __shared__ __attribute__((aligned(16))) unsigned char lds_raw[];
    Ctx C;
    C.lds = (LAS unsigned char*)lds_raw;
    C.tid = threadIdx.x; C.lane = C.tid & 63; C.wave = __builtin_amdgcn_readfirstlane(C.tid >> 6);
    C.G = gridDim.x; C.bid = blockIdx.x; C.gw = C.bid * NWAVES + C.wave; C.ngw = C.G * NWAVES;
    LAS unsigned char* misc = C.lds + MISC_OFF;
    if (C.tid < 8) ((volatile LAS unsigned*)misc)[C.tid] = 0u;
    Params p; p.out = ka.out; p.ws = ka.ws; p.ph_lo = ka.ph_lo; p.ph_hi = ka.ph_hi; p.ptab = (LAS unsigned long long*)(misc + 1024);
    if (C.tid < 34) p.ptab[C.tid] = (unsigned long long)ka.in[C.tid];
    __syncthreads();
    const int lo = p.ph_lo, hi = p.ph_hi;
    XcdBarrier bar; bar.bar = (unsigned*)(p.ws + WS_CTL) + CW_BAR; bar.x = 0; bar.st = (volatile LAS unsigned*)misc;
    if (hi - lo > 1) bar = xcd_barrier_post((unsigned*)(p.ws + WS_CTL) + CW_BAR, (volatile LAS unsigned*)misc);
#define IN(k) (lo <= (k) && (k) < hi)
#define SEAM(k) do { if (IN(k) && IN((k) + 1)) xcd_barrier(bar, C.wave); } while (0)

    if (IN(0)) { phase_p0(p, C); } SEAM(0);
    if (IN(1)) { phase_p1(p, C); } SEAM(1);
    if (IN(0) && IN(2) && (C.G & 7) == 0) {
        volatile LAS unsigned* st = (volatile LAS unsigned*)misc;
        if (C.tid == 0) { unsigned pre = 0u; const unsigned x = st[3];
            for (unsigned j = 0; j < 16; ++j) { const unsigned cj = xb_ld(&bar.bar[XB_XCNT(j)]); pre += (j < x) ? cj : 0u; }
            st[4] = pre + st[2]; }
        __syncthreads();
        const int vcu = (int)st[4], g8 = C.G >> 3;
        C.bid = __builtin_amdgcn_readfirstlane((vcu % g8) * 8 + vcu / g8); C.gw = C.bid * NWAVES + C.wave;
    }

    layer_body<0>(p, C, bar, misc, lo, hi);
    layer_body<1>(p, C, bar, misc, lo, hi);
#undef IN
#undef SEAM
}

extern "C" void kernel_launch(void* const* d_in, const int* in_sizes, int n_in, void* d_out, int out_size, void* d_ws, size_t ws_size, hipStream_t stream) {
    static int grid = 0;
    if (grid == 0) {
        if (n_in != 34 || out_size != SEQ * DM || ws_size < WS_END) { fprintf(stderr, "kernel_launch: unexpected shapes: n_in %d out %d ws %zu (need %zu)\n", n_in, out_size, ws_size, (size_t)WS_END); grid = -1; return; }
        int dev = 0, cus = 0, per_cu = 0;
        if (hipGetDevice(&dev) != hipSuccess || hipDeviceGetAttribute(&cus, hipDeviceAttributeMultiprocessorCount, dev) != hipSuccess) { grid = -1; return; }
        if (hipFuncSetAttribute((const void*)mega_fwd, hipFuncAttributeMaxDynamicSharedMemorySize, LDS_BYTES) != hipSuccess) { fprintf(stderr, "kernel_launch: hipFuncSetAttribute failed\n"); grid = -1; return; }
        if (hipOccupancyMaxActiveBlocksPerMultiprocessor(&per_cu, (const void*)mega_fwd, NTHR, LDS_BYTES) != hipSuccess || per_cu < 1) { fprintf(stderr, "kernel_launch: occupancy query says %d blocks per CU\n", per_cu); grid = -1; return; }
        (void)hipGetLastError();
        grid = cus;
    }
    if (grid < 0) return;
    (void)hipMemsetAsync((char*)d_ws + WS_CTL, 0, CTL_BYTES, stream);
    KArgs p{};
    for (int i = 0; i < 34; ++i) p.in[i] = (const float*)d_in[i];
    p.out = (float*)d_out; p.ws = (unsigned char*)d_ws;
#if MK_PER_PHASE
    for (int ph = 0; ph < N_PHASES; ++ph) {
        if (ph == 2 + PH_PER_LAYER + 5 || ph == 2 + PH_PER_LAYER + 6) continue;
        p.ph_lo = ph; p.ph_hi = ph + 1;
        hipLaunchKernelGGL(mega_fwd, dim3(grid), dim3(NTHR), LDS_BYTES, stream, p);
    }
#else
    p.ph_lo = 0; p.ph_hi = N_PHASES;
    hipLaunchKernelGGL(mega_fwd, dim3(grid), dim3(NTHR), LDS_BYTES, stream, p);
#endif
    const hipError_t le = hipPeekAtLastError();
    if (le != hipSuccess) fprintf(stderr, "kernel_launch: launch failed: %s\n", hipGetErrorName(le));
}
```

```cpp
#define MK_PER_PHASE 0
#include <hip/hip_runtime.h>
#include <cstdio>
#include <cstdint>

#define GAS __attribute__((address_space(1)))
#define LAS __attribute__((address_space(3)))
typedef unsigned short bf16_t;
typedef short bf16x8 __attribute__((ext_vector_type(8)));
typedef short s16x4 __attribute__((ext_vector_type(4)));
typedef float f32x4 __attribute__((ext_vector_type(4)));
typedef float f32x2 __attribute__((ext_vector_type(2)));
typedef float f32x16 __attribute__((ext_vector_type(16)));
typedef unsigned u32x4 __attribute__((ext_vector_type(4)));
typedef unsigned u32x2 __attribute__((ext_vector_type(2)));

constexpr int DM = 2048, SEQ = 16384, CTXL = 256, TT = SEQ + CTXL;
constexpr int NEXP = 64, NEX1 = 65, EHID = 512, TOPK = 8;
constexpr int EV_IN = 5120, OD_IN = 4608;
constexpr float LN_EPS = 1e-6f;
constexpr float ALPHA = 1.4142135623730951f;
constexpr float LAMBDA_INIT = 0.35550906759f;
constexpr int NTHR = 512, NWAVES = 8;

constexpr size_t al256(size_t x) { return (x + 255) / 256 * 256; }
constexpr size_t WS_CTL   = 0;
constexpr size_t CTL_BYTES = 1u << 20;
constexpr size_t WS_MODP  = WS_CTL + CTL_BYTES;
constexpr size_t WS_MODF  = WS_MODP + al256((size_t)2 * 32 * 2 * 12288 * 4);
constexpr size_t WS_ROPE128 = WS_MODF + al256((size_t)2 * 2 * 12288 * 4);
constexpr size_t WS_ROPE64  = WS_ROPE128 + al256((size_t)256 * 64 * 2 * 4);
constexpr size_t WS_KN    = WS_ROPE64 + al256((size_t)256 * 32 * 2 * 4);
constexpr size_t WS_WT    = WS_KN + al256((size_t)2 * 64 * 16 * 1024 * 2);
constexpr size_t WS_APOW  = WS_WT + al256((size_t)2 * 64 * 128 * 1024 * 2);
constexpr size_t WS_AL    = WS_APOW + al256((size_t)2 * 64 * 64 * 128 * 4);
constexpr size_t WS_CC    = WS_AL + al256((size_t)2 * 64 * 128 * 4);
constexpr size_t WS_S5E   = WS_CC + al256((size_t)64 * 16 * 128 * 2);
constexpr size_t WS_HST   = WS_S5E + al256((size_t)2 * 64 * 260 * 128 * 4);
constexpr size_t WS_WIN0  = WS_HST + al256((size_t)2 * 64 * 260 * 128 * 4);
constexpr size_t WS_WOUT0 = WS_WIN0 + al256((size_t)EV_IN * DM * 2);
constexpr size_t WS_WGLU  = WS_WOUT0 + al256((size_t)DM * DM * 2);
constexpr size_t WS_WIN1  = WS_WGLU + al256((size_t)1024 * 1024 * 2);
constexpr size_t WS_WOUT1 = WS_WIN1 + al256((size_t)OD_IN * DM * 2);
constexpr size_t WS_RWT   = WS_WOUT1 + al256((size_t)DM * DM * 2);
constexpr size_t WS_GU    = WS_RWT + al256((size_t)2 * 2 * 64 * DM * 2);
constexpr size_t WS_DT    = WS_GU + al256((size_t)NEX1 * 1024 * DM * 2);
constexpr size_t WS_XA    = WS_DT + al256((size_t)NEX1 * DM * EHID * 2);
constexpr size_t WS_Z     = WS_XA + al256((size_t)TT * DM * 2);
constexpr size_t WS_YMIX  = WS_Z + al256((size_t)TT * 1024 * 2);
constexpr size_t WS_X1    = WS_YMIX + al256((size_t)TT * DM * 2);
constexpr size_t WS_HX2   = WS_X1 + al256((size_t)TT * DM * 4);
constexpr size_t WS_LIST  = WS_HX2 + al256((size_t)9 * TT * EHID * 2);
constexpr size_t WS_WGT   = WS_LIST + al256((size_t)NEX1 * TT * 4);
constexpr size_t WS_LW    = WS_WGT + al256((size_t)8 * TT * 4);
constexpr size_t WS_BIG   = WS_LW + al256((size_t)NEX1 * TT * 4);
constexpr size_t BG_QKV   = 0;
constexpr size_t BG_CKV   = BG_QKV + al256((size_t)TT * EV_IN * 2);
constexpr size_t BG_SPREV = BG_CKV + al256((size_t)8 * 130 * 65536 * 4);
constexpr size_t BG_MIX   = BG_SPREV + al256((size_t)8 * 130 * 65536 * 2);
constexpr size_t BG_END0  = BG_MIX + al256((size_t)TT * DM * 2);
constexpr size_t BG_ATT   = BG_CKV;
constexpr size_t BG_YMOE  = 0;
constexpr size_t BG_END1  = al256((size_t)9 * TT * DM * 2);
constexpr size_t BG_SIZE  = BG_END0 > BG_END1 ? BG_END0 : BG_END1;
constexpr size_t WS_END   = WS_BIG + BG_SIZE;

constexpr int CW_BAR = 4096;
constexpr int CW_CNT = 16384;
constexpr int CW_QUEUE = 20480;

constexpr int RING_BYTES = 139264;
constexpr int MISC_OFF = RING_BYTES;
constexpr int LDS_BYTES = 147456;

typedef __bf16 bf16x2_t __attribute__((ext_vector_type(2)));
__device__ __forceinline__ unsigned cvt_pk_bf16(float lo, float hi) { const f32x2 v = {lo, hi}; return __builtin_bit_cast(unsigned, __builtin_convertvector(v, bf16x2_t)); }
__device__ __forceinline__ bf16_t f2bf(float f) { unsigned u = __builtin_bit_cast(unsigned, f); return (bf16_t)((u + 0x7fffu + ((u >> 16) & 1u)) >> 16); }
__device__ __forceinline__ float bf2f(bf16_t b) { return __builtin_bit_cast(float, ((unsigned)b) << 16); }
__device__ __forceinline__ float bflo(unsigned w) { return __builtin_bit_cast(float, w << 16); }
__device__ __forceinline__ float bfhi(unsigned w) { return __builtin_bit_cast(float, w & 0xffff0000u); }
__device__ __forceinline__ float wave_sum(float v) {
#pragma unroll
    for (int o = 1; o < 64; o <<= 1) v += __shfl_xor(v, o);
    return v;
}
__device__ __forceinline__ float fast_exp(float x) { return __builtin_amdgcn_exp2f(x * 1.4426950408889634f); }
__device__ __forceinline__ float sigmoidf_(float x) { return 1.0f / (1.0f + __expf(-x)); }
__device__ __forceinline__ float siluf_(float x) { return x / (1.0f + __expf(-x)); }
__device__ __forceinline__ float gelu_tanh(float x) {
    const float u = 0.7978845608028654f * (x + 0.044715f * x * x * x);
    const float e = __expf(2.0f * u);
    const float t = 1.0f - 2.0f / (e + 1.0f);
    return 0.5f * x * (1.0f + t);
}
#define LDS_WAIT() asm volatile("s_waitcnt lgkmcnt(0)" ::: "memory")
#define VM_WAIT() asm volatile("s_waitcnt vmcnt(0)" ::: "memory")

#define XB_TMO      128
#define XB_XCNT(j)  (256  + 64 * (j))
#define XB_XSUB(j)  (1280 + 64 * (j))
#define XB_XGEN(j)  (2304 + 64 * (j))
#define XB_TOP      3328
#define XB_TOPGEN   3392
#define XCD_BAR_WORDS 3456
#define XB_SPIN_CAP (1u << 22)

__device__ __forceinline__ unsigned xb_ld(unsigned* p)              { return __hip_atomic_load(p, __ATOMIC_RELAXED, __HIP_MEMORY_SCOPE_AGENT); }
__device__ __forceinline__ unsigned xb_add(unsigned* p, unsigned v) { return __hip_atomic_fetch_add(p, v, __ATOMIC_RELAXED, __HIP_MEMORY_SCOPE_AGENT); }
__device__ __forceinline__ unsigned xb_xcc_id() { return (unsigned)__builtin_amdgcn_s_getreg((3 << 11) | 20) & 0xFu; }
#define XB_SPIN(cond, bar) do { unsigned _sp = 0; while (cond) { __builtin_amdgcn_s_sleep(1); \
    if ((++_sp & 255u) == 0u) { if (xb_ld(&(bar)[XB_TMO])) break; if (_sp > XB_SPIN_CAP) { atomicAdd(&(bar)[XB_TMO], 1u); break; } } } } while (0)

struct XcdBarrier { unsigned* bar; unsigned x; volatile LAS unsigned* st; };

__device__ __forceinline__ XcdBarrier xcd_barrier_post(unsigned* bar, volatile LAS unsigned* st) {
    XcdBarrier b; b.bar = bar; b.x = xb_xcc_id(); b.st = st;
    if (threadIdx.x == 0) { st[2] = xb_add(&bar[XB_XCNT(b.x)], 1u); st[3] = b.x; }
    return b;
}
__device__ __forceinline__ void xcd_barrier_complete(unsigned* bar, unsigned x, unsigned& nloc, unsigned& nx) {
    const unsigned G = gridDim.x * gridDim.y * gridDim.z;
    unsigned sum, cnt, mine, sp = 0u;
    for (;;) {
        sum = 0u; cnt = 0u; mine = 0u;
#pragma unroll
        for (unsigned j = 0; j < 16; ++j) { const unsigned c = xb_ld(&bar[XB_XCNT(j)]); sum += c; cnt += (c > 0u) ? 1u : 0u; mine = (j == x) ? c : mine; }
        if (sum == G) break;
        __builtin_amdgcn_s_sleep(1);
        if ((++sp & 255u) == 0u) { if (xb_ld(&bar[XB_TMO])) break; if (sp > XB_SPIN_CAP) { atomicAdd(&bar[XB_TMO], 1u); break; } }
    }
    nloc = mine > 0u ? mine : 1u; nx = cnt > 0u ? cnt : 1u;
}
__device__ __forceinline__ void xcd_barrier(const XcdBarrier& b, int wave_id) {
    const bool leader_thread = (wave_id == 0) && (__builtin_amdgcn_mbcnt_hi(~0u, __builtin_amdgcn_mbcnt_lo(~0u, 0u)) == 0u);
    asm volatile("s_waitcnt vmcnt(0)" ::: "memory");
    __syncthreads();
    if (leader_thread) {
        unsigned* bar = b.bar;
        __builtin_amdgcn_s_waitcnt(0);
        unsigned nloc = b.st[0], nx = b.st[1];
        if (nloc == 0u) { xcd_barrier_complete(bar, b.x, nloc, nx); b.st[0] = nloc; b.st[1] = nx; }
        const unsigned old = xb_add(&bar[XB_XSUB(b.x)], 1u);
        const unsigned gen = old / nloc;
        if (old + 1u == (gen + 1u) * nloc) {
            __builtin_amdgcn_fence(__ATOMIC_RELEASE, "agent");
            asm volatile("s_waitcnt vmcnt(0)" ::: "memory");
            const unsigned og = xb_add(&bar[XB_TOP], 1u);
            const unsigned tg = og / nx;
            if (og + 1u == (tg + 1u) * nx) xb_add(&bar[XB_TOPGEN], 1u);
            else XB_SPIN(xb_ld(&bar[XB_TOPGEN]) == tg, bar);
            __builtin_amdgcn_fence(__ATOMIC_ACQUIRE, "agent");
            xb_add(&bar[XB_XGEN(b.x)], 1u);
            asm volatile("s_waitcnt vmcnt(0)" ::: "memory");
        } else {
            XB_SPIN(xb_ld(&bar[XB_XGEN(b.x)]) == gen, bar);
            __builtin_amdgcn_fence(__ATOMIC_ACQUIRE, "agent");
            asm volatile("s_waitcnt vmcnt(0)" ::: "memory");
        }
    }
    __syncthreads();
}

__device__ __forceinline__ bf16x8 frag_rowk_l(const LAS bf16_t* p, int ld, int lane) {
    return *(const LAS bf16x8*)(p + (lane & 15) * ld + (lane >> 4) * 8);
}
__device__ __forceinline__ bf16x8 frag_rowk_g(const bf16_t* p, long ld, int lane) {
    return *(const bf16x8*)(p + (long)(lane & 15) * ld + (lane >> 4) * 8);
}
__device__ __forceinline__ bf16x8 frag_colk_l(unsigned p, int ldb, int lane) {
    const unsigned a0 = p + (unsigned)((8 * (lane >> 4) + ((lane & 15) >> 2)) * ldb + (lane & 3) * 8);
    const unsigned a1 = a0 + 4u * (unsigned)ldb;
    s16x4 lo, hi;
    asm volatile("ds_read_b64_tr_b16 %0, %2\n\tds_read_b64_tr_b16 %1, %3\n\ts_waitcnt lgkmcnt(0)" : "=&v"(lo), "=&v"(hi) : "v"(a0), "v"(a1) : "memory");
    return (bf16x8){lo[0], lo[1], lo[2], lo[3], hi[0], hi[1], hi[2], hi[3]};
}
#define MFMA16(a, b, c) __builtin_amdgcn_mfma_f32_16x16x32_bf16((a), (b), (c), 0, 0, 0)
namespace pg8 {
constexpr int BM = 256, BK = 64, HALF = 128, HTB = HALF * BK * 2, STAGE_BYTES = 8 * HTB, NXCD = 8, WGM = 8;
__device__ __forceinline__ int lds_byte(int r, int c) { const int st = (r >> 4) * 2 + (c >> 5), rr = r & 15, cc = c & 31, ob = rr * 64 + cc * 2; return st * 1024 + (ob ^ (((ob >> 9) & 1) << 5)); }
__device__ __forceinline__ void stage_rc(int b, int& R, int& C) { const int st = b / 1024, sb = b % 1024, swz = sb ^ (((sb >> 9) & 1) << 5); R = (st >> 1) * 16 + swz / 64; C = (st & 1) * 32 + (swz % 64) / 2; }
__device__ __forceinline__ int perm32(int rho) { const int n = rho >> 4, i = rho & 15; return 8 * (i >> 2) + 4 * n + (i & 3); }

struct Unit { int pm, pn, e; };
constexpr float WSCALE = 32.0f, WSCALE_INV = 1.0f / 32.0f;

struct DenseOrder {
    const bf16_t* A; const bf16_t* Bt; int ldab, kb, nM, nN, nwg, G, c;
    __device__ __forceinline__ void init(const bf16_t* A_, int lda_, const bf16_t* Bt_, int M, int N, int K_, int G_, int c_) { A = A_; ldab = lda_ * 2; Bt = Bt_; kb = K_ * 2; nM = M / BM; nN = N / BM; nwg = nM * nN; G = G_; c = c_; }
    __device__ __forceinline__ void init8(const void* A_, int ldab_, const void* Bt_, int M, int N, int K_, int G_, int c_) { A = (const bf16_t*)A_; ldab = ldab_; Bt = (const bf16_t*)Bt_; kb = K_; nM = M / BM; nN = N / BM; nwg = nM * nN; G = G_; c = c_; }
    __device__ __forceinline__ void prep(LAS unsigned char*) const {}
    __device__ __forceinline__ bool next(int i, Unit& u) const {
        const long L = (long)i * G + c; if (L >= nwg) return false;
        int wgid = (int)L; { const int q = nwg / NXCD, r = nwg % NXCD, xcd = wgid % NXCD, off = wgid / NXCD; wgid = (xcd < r ? xcd * (q + 1) : r * (q + 1) + (xcd - r) * q) + off; }
        const int nig = WGM * nN, gid = wgid / nig, fm = gid * WGM, gsz = (nM - fm) < WGM ? (nM - fm) : WGM;
        u.pm = fm + ((wgid % nig) % gsz); u.pn = (wgid % nig) / gsz; u.e = 0; return true;
    }
    __device__ __forceinline__ const char* a_base() const { return (const char*)A; }
    __device__ __forceinline__ unsigned a_off(const Unit& u, int r) const { return (unsigned)(u.pm * BM + r) * (unsigned)ldab; }
    __device__ __forceinline__ const char* b_ptr(const Unit& u) const { return (const char*)Bt + (size_t)u.pn * BM * kb; }
};

template <int MODE  >
struct MoeOrder {
    const void* A; const void* Bt; const int* list; const int* cnt; int ldab, kb, nN, G, c; size_t bstride;
    LAS int* tp; LAS int* cn; LAS int* rb;
    __device__ __forceinline__ void prep(LAS unsigned char* misc, int tid) {
        tp = (LAS int*)(misc + 64); cn = tp + 72; rb = cn + 72;
        if (tid < NEX1) cn[tid] = cnt[tid];
        __syncthreads();
        if (tid == 0) { int s = 0, q = 0; for (int e = 0; e < NEX1; ++e) { tp[e] = s; rb[e] = q; s += (cn[e] + BM - 1) / BM; q += cn[e]; } tp[NEX1] = s; rb[NEX1] = q; }
        __syncthreads();
    }
    __device__ __forceinline__ bool next(int i, Unit& u) const {
        const int total = tp[NEX1]; const long nu = (long)total * nN; const int per = (int)((nu + G - 1) / G);
        const int vc = ((G & 7) == 0) ? (c & 7) * (G >> 3) + (c >> 3) : c;
        const long L = (long)vc * per + i;
        if (i >= per || L >= nu) return false;
        const int tile = (int)(L / nN); u.pn = (int)(L % nN);
        int e = 0;
        for (int k = 1; k < NEX1; ++k) e += (tp[k] <= tile) ? 1 : 0;
        u.e = e; u.pm = tile - tp[e]; return true;
    }
    __device__ __forceinline__ const char* a_base() const { return (const char*)A; }
    __device__ __forceinline__ unsigned a_off(const Unit& u, int r) const {
        int pos = u.pm * BM + r; const int n = cn[u.e]; pos = pos < n ? pos : n - 1;
        if (MODE == 1) return (unsigned)(rb[u.e] + pos) * (unsigned)ldab;
        const int a = list[u.e * TT + pos];
        const int row = a < 8 * TT ? (a >> 3) : a - 8 * TT;
        return (unsigned)row * (unsigned)ldab;
    }
    __device__ __forceinline__ const char* b_ptr(const Unit& u) const { return (const char*)Bt + (size_t)u.e * bstride + (size_t)u.pn * BM * kb; }
};

typedef int v8i32 __attribute__((ext_vector_type(8)));
typedef int v4i32_ __attribute__((ext_vector_type(4)));
__device__ __forceinline__ v8i32 cat8(bf16x8 a, bf16x8 b) { const u32x4 x = __builtin_bit_cast(u32x4, a), y = __builtin_bit_cast(u32x4, b); return (v8i32){(int)x.x, (int)x.y, (int)x.z, (int)x.w, (int)y.x, (int)y.y, (int)y.z, (int)y.w}; }
template <bool FP8, class Epi, class Sched>
__device__ __forceinline__ void gemm_phase(LAS unsigned char* lds, const Sched& S, const Epi& E, int wave_id) {
    const int wid = wave_id; int lane = (int)__builtin_amdgcn_mbcnt_hi(~0u, __builtin_amdgcn_mbcnt_lo(~0u, 0u)); asm volatile("" : "+v"(lane));
    const int tid = wid * 64 + lane, wr = wid >> 2, wc = wid & 3, fr = lane & 15, fq = lane >> 4;
    const int kb = S.kb; int nt = kb / 128; asm volatile("" : "+s"(nt));
    unsigned voffB[2];
#pragma unroll
    for (int i = 0; i < 2; ++i) { int R, C; stage_rc(tid * 16 + i * 8192, R, C); const int Rb = (R & ~31) + perm32(R & 31);
        voffB[i] = (unsigned)(Rb * kb) + (unsigned)C * 2u; }
#define PG8_AOFF(u, h, i) ({ int _tz = tid; asm volatile("" : "+v"(_tz)); int _R, _C; stage_rc(_tz * 16 + (i) * 8192, _R, _C); S.a_off((u), (h) * HALF + _R) + (unsigned)_C * 2u; })
    const size_t kstep = (size_t)(BK * 2);
    const size_t hstepB = (size_t)HALF * kb;
    const unsigned ldsw = (unsigned)wid * 1024u;
    const int aoff = lds_byte(wr * 64 + fr, fq * 8), boff = lds_byte(wc * 32 + fr, fq * 8);
#define PG8_SA(b, h) (((b) * 2 + (h)) * HTB)
#define PG8_SB(b, h) ((4 + (b) * 2 + (h)) * HTB)
#define PG8_STAGE(bufoff, gbase, v0, v1) do { \
        __builtin_amdgcn_global_load_lds((const unsigned*)((const char*)(gbase) + (v0)), (LAS unsigned*)(lds + (bufoff) + ldsw), 16, 0, 0); \
        __builtin_amdgcn_global_load_lds((const unsigned*)((const char*)(gbase) + (v1)), (LAS unsigned*)(lds + (bufoff) + ldsw + 8192), 16, 0, 0); } while (0)
#define PG8_VOFFB(i) ({ int _tz = tid; asm volatile("" : "+v"(_tz)); int _R, _C; stage_rc(_tz * 16 + (i) * 8192, _R, _C); (unsigned)(((_R & ~31) + perm32(_R & 31)) * kb) + (unsigned)_C * 2u; })
#define PG8_STAGE_B(bufoff, gbase) do { if constexpr (FP8) { const unsigned _v0 = PG8_VOFFB(0), _v1 = PG8_VOFFB(1); PG8_STAGE(bufoff, gbase, _v0, _v1); } else PG8_STAGE(bufoff, gbase, voffB[0], voffB[1]); } while (0)
#define PG8_LD8(off) __builtin_shufflevector(*(const LAS v4i32_*)(lds + (off)), *(const LAS v4i32_*)(lds + (off) + 1024), 0, 1, 2, 3, 4, 5, 6, 7)
#define PG8_LDA(dst, b, h) do { _Pragma("unroll") for (int m = 0; m < 4; ++m) { if constexpr (FP8) dst##8[m] = PG8_LD8(PG8_SA(b, h) + aoff + m * 2048); else { _Pragma("unroll") for (int k = 0; k < 2; ++k) dst[m][k] = *(const LAS bf16x8*)(lds + PG8_SA(b, h) + aoff + m * 2048 + k * 1024); } } } while (0)
#define PG8_LDB(dst, b, h) do { _Pragma("unroll") for (int n = 0; n < 2; ++n) { if constexpr (FP8) dst##8[n] = PG8_LD8(PG8_SB(b, h) + boff + n * 2048); else { _Pragma("unroll") for (int k = 0; k < 2; ++k) dst[n][k] = *(const LAS bf16x8*)(lds + PG8_SB(b, h) + boff + n * 2048 + k * 1024); } } } while (0)
#define PG8_MMA(ai, bj, At, Bt) do { __builtin_amdgcn_s_setprio(1); _Pragma("unroll") for (int m = 0; m < 4; ++m) _Pragma("unroll") for (int n = 0; n < 2; ++n) { \
        if constexpr (FP8) asm volatile("v_mfma_f32_16x16x128_f8f6f4 %0, %1, %2, %0" : "+v"(acc[ai][bj][m][n]) : "v"(Bt##8[n]), "v"(At##8[m])); \
        else { _Pragma("unroll") for (int k = 0; k < 2; ++k) acc[ai][bj][m][n] = __builtin_amdgcn_mfma_f32_16x16x32_bf16(Bt[n][k], At[m][k], acc[ai][bj][m][n], 0, 0, 0); } } \
        __builtin_amdgcn_s_setprio(0); } while (0)
#define PG8_WAIT_V(n) asm volatile("s_waitcnt vmcnt(" #n ")" ::: "memory")
#define PG8_WAIT_L(n) asm volatile("s_waitcnt lgkmcnt(" #n ")" ::: "memory")
#define PG8_BAR __builtin_amdgcn_s_barrier()
#define PG8_SCHED __builtin_amdgcn_sched_barrier(0)
    Unit cur, nxt; int ui = 0;
    if (!S.next(0, cur)) return;
    f32x4 acc[2][2][4][2];
#pragma unroll
    for (int a = 0; a < 2; ++a)
#pragma unroll
        for (int b = 0; b < 2; ++b)
#pragma unroll
            for (int m = 0; m < 4; ++m)
#pragma unroll
                for (int n = 0; n < 2; ++n) acc[a][b][m][n] = (f32x4){0.f, 0.f, 0.f, 0.f};
    bf16x8 At[4][2], B0[2][2], B1[2][2]; v8i32 At8[4], B08[2], B18[2];
    const char* const gA = S.a_base();
    const char* cB = S.b_ptr(cur);
    unsigned oc00, oc01, oc10, oc11;
    oc00 = PG8_AOFF(cur, 0, 0); oc01 = PG8_AOFF(cur, 0, 1); oc10 = PG8_AOFF(cur, 1, 0); oc11 = PG8_AOFF(cur, 1, 1);
    PG8_STAGE_B(PG8_SB(0, 0), cB); PG8_STAGE_B(PG8_SB(0, 1), cB + hstepB); PG8_STAGE(PG8_SA(0, 0), gA, oc00, oc01); PG8_STAGE(PG8_SA(0, 1), gA, oc10, oc11);
    if (wr == 1) PG8_BAR;
    PG8_WAIT_V(2); PG8_BAR;
    PG8_STAGE_B(PG8_SB(1, 0), cB + kstep); PG8_STAGE(PG8_SA(1, 0), gA + kstep, oc00, oc01); PG8_STAGE_B(PG8_SB(1, 1), cB + hstepB + kstep);
    PG8_WAIT_V(6); PG8_BAR;
    for (;;) {
        const bool has_next = S.next(ui + 1, nxt);
        const char* nB = cB;
        {
            u32x4 on = {oc00, oc01, oc10, oc11};
            if (has_next) { on.x = PG8_AOFF(nxt, 0, 0); on.y = PG8_AOFF(nxt, 0, 1); on.z = PG8_AOFF(nxt, 1, 0); on.w = PG8_AOFF(nxt, 1, 1); nB = S.b_ptr(nxt); }
            *(LAS u32x4*)(lds + STAGE_BYTES + tid * 16) = on;
        }
        for (int t = 0; t < nt; t += 2) {
            const bool last = (t == nt - 2);
            const char* a1 = gA + (size_t)(t + 1) * kstep;
            const char* a2 = last ? gA : gA + (size_t)(t + 2) * kstep; const char* b2 = last ? nB : cB + (size_t)(t + 2) * kstep;
            const char* a3 = a2 + kstep; const char* b3 = b2 + kstep;
            unsigned s00 = oc00, s01 = oc01, s10 = oc10, s11 = oc11;
            if (last) { const u32x4 on = *(const LAS u32x4*)(lds + STAGE_BYTES + tid * 16); s00 = on.x; s01 = on.y; s10 = on.z; s11 = on.w; }
            PG8_LDB(B0, 0, 0); PG8_LDB(B1, 0, 1); PG8_SCHED; PG8_LDA(At, 0, 0); PG8_STAGE(PG8_SA(1, 1), a1, oc10, oc11);
            PG8_WAIT_V(8); PG8_WAIT_L(0); PG8_BAR; PG8_MMA(0, 0, At, B0); PG8_MMA(0, 1, At, B1); PG8_BAR; PG8_SCHED;
            PG8_LDA(At, 0, 1); PG8_STAGE_B(PG8_SB(0, 0), b2); PG8_STAGE_B(PG8_SB(0, 1), b2 + hstepB); PG8_STAGE(PG8_SA(0, 0), a2, s00, s01);
            PG8_WAIT_V(8); PG8_WAIT_L(0); PG8_BAR; PG8_MMA(1, 0, At, B0); PG8_MMA(1, 1, At, B1); PG8_BAR; PG8_SCHED;
            PG8_LDB(B0, 1, 0); PG8_LDB(B1, 1, 1); PG8_SCHED; PG8_LDA(At, 1, 0); PG8_STAGE(PG8_SA(0, 1), a2, s10, s11);
            PG8_WAIT_V(8); PG8_WAIT_L(0); PG8_BAR; PG8_MMA(0, 0, At, B0); PG8_MMA(0, 1, At, B1); PG8_BAR; PG8_SCHED;
            PG8_LDA(At, 1, 1); PG8_STAGE_B(PG8_SB(1, 0), b3); PG8_STAGE_B(PG8_SB(1, 1), b3 + hstepB); PG8_STAGE(PG8_SA(1, 0), a3, s00, s01);
            PG8_WAIT_V(8); PG8_WAIT_L(0); PG8_BAR; PG8_MMA(1, 0, At, B0); PG8_MMA(1, 1, At, B1); PG8_BAR; PG8_SCHED;
        }
        if (wr == 0) PG8_BAR;
        E(acc, cur, wr, wc, fr, fq);
        if (!has_next) break;
#pragma unroll
        for (int a = 0; a < 2; ++a)
#pragma unroll
            for (int b = 0; b < 2; ++b)
#pragma unroll
                for (int m = 0; m < 4; ++m)
#pragma unroll
                    for (int n = 0; n < 2; ++n) acc[a][b][m][n] = (f32x4){0.f, 0.f, 0.f, 0.f};
        { const u32x4 on = *(const LAS u32x4*)(lds + STAGE_BYTES + tid * 16); oc00 = on.x; oc01 = on.y; oc10 = on.z; oc11 = on.w; }
        cur = nxt; cB = nB; ++ui;
        if (wr == 1) PG8_BAR;
    }
    PG8_WAIT_V(0);
    PG8_BAR;
#undef PG8_SA
#undef PG8_SB
#undef PG8_STAGE
#undef PG8_STAGE_B
#undef PG8_AOFF
#undef PG8_VOFFB
#undef PG8_LD8
#undef PG8_LDA
#undef PG8_LDB
#undef PG8_MMA
#undef PG8_WAIT_V
#undef PG8_WAIT_L
#undef PG8_BAR
#undef PG8_SCHED
}

struct EpiStore {
    bf16_t* O; int ldc; float scale;
    __device__ __forceinline__ void operator()(const f32x4 (&acc)[2][2][4][2], const Unit& u, int wr, int wc, int fr, int fq) const {
        const int row0 = u.pm * BM + wr * 64 + fr, col0 = u.pn * BM + wc * 32 + 8 * fq;
#pragma unroll
        for (int ai = 0; ai < 2; ++ai)
#pragma unroll
            for (int m = 0; m < 4; ++m) { bf16_t* rowp = O + (size_t)(row0 + ai * HALF + m * 16) * ldc + col0;
#pragma unroll
                for (int bj = 0; bj < 2; ++bj) { const f32x4 v0 = acc[ai][bj][m][0] * scale, v1 = acc[ai][bj][m][1] * scale;
                    u32x4 w; w.x = cvt_pk_bf16(v0[0], v0[1]); w.y = cvt_pk_bf16(v0[2], v0[3]); w.z = cvt_pk_bf16(v1[0], v1[1]); w.w = cvt_pk_bf16(v1[2], v1[3]);
                    *(u32x4*)(rowp + bj * HALF) = w; } }
    }
};
struct EpiGlu {
    const bf16_t* Z; const float* b; bf16_t* MIX;
    __device__ __forceinline__ void operator()(const f32x4 (&acc)[2][2][4][2], const Unit& u, int wr, int wc, int fr, int fq) const {
        const int row0 = u.pm * BM + wr * 64 + fr, col0 = u.pn * BM + wc * 32 + 8 * fq;
#pragma unroll
        for (int bj = 0; bj < 2; ++bj) {
            const f32x4 b0 = *(const f32x4*)(b + col0 + bj * HALF), b1 = *(const f32x4*)(b + col0 + bj * HALF + 4);
#pragma unroll
            for (int ai = 0; ai < 2; ++ai)
#pragma unroll
                for (int m = 0; m < 4; ++m) { const size_t row = (size_t)(row0 + ai * HALF + m * 16);
                    const u32x4 zz = *(const u32x4*)(Z + row * 1024 + col0 + bj * HALF);
                    const f32x4 v0 = acc[ai][bj][m][0] + b0, v1 = acc[ai][bj][m][1] + b1;
                    u32x4 w;
                    w.x = cvt_pk_bf16(bflo(zz.x) * sigmoidf_(v0[0]), bfhi(zz.x) * sigmoidf_(v0[1]));
                    w.y = cvt_pk_bf16(bflo(zz.y) * sigmoidf_(v0[2]), bfhi(zz.y) * sigmoidf_(v0[3]));
                    w.z = cvt_pk_bf16(bflo(zz.z) * sigmoidf_(v1[0]), bfhi(zz.z) * sigmoidf_(v1[1]));
                    w.w = cvt_pk_bf16(bflo(zz.w) * sigmoidf_(v1[2]), bfhi(zz.w) * sigmoidf_(v1[3]));
                    *(u32x4*)(MIX + row * DM + 1024 + col0 + bj * HALF) = w; }
        }
    }
};
struct EpiE1 {
    unsigned char* H; const LAS int* cn; const LAS int* rb;
    __device__ __forceinline__ void operator()(const f32x4 (&acc)[2][2][4][2], const Unit& u, int wr, int wc, int fr, int fq) const {
        const int n = cn[u.e]; const int colh = u.pn * 128 + wc * 32 + 8 * fq;
#pragma unroll
        for (int ai = 0; ai < 2; ++ai)
#pragma unroll
            for (int m = 0; m < 4; ++m) { const int pos = u.pm * BM + ai * HALF + wr * 64 + m * 16 + fr;
                if (pos < n) { const int a = rb[u.e] + pos;
                    float sc = WSCALE_INV; asm volatile("" : "+v"(sc));
                    const f32x4 g0 = acc[ai][0][m][0] * sc, g1 = acc[ai][0][m][1] * sc, u0 = acc[ai][1][m][0] * sc, u1 = acc[ai][1][m][1] * sc;
                    u32x2 w;
                    w.x = (unsigned)__builtin_amdgcn_cvt_pk_fp8_f32(siluf_(g0[0]) * u0[0], siluf_(g0[1]) * u0[1], 0, false);
                    w.x = (unsigned)__builtin_amdgcn_cvt_pk_fp8_f32(siluf_(g0[2]) * u0[2], siluf_(g0[3]) * u0[3], (int)w.x, true);
                    w.y = (unsigned)__builtin_amdgcn_cvt_pk_fp8_f32(siluf_(g1[0]) * u1[0], siluf_(g1[1]) * u1[1], 0, false);
                    w.y = (unsigned)__builtin_amdgcn_cvt_pk_fp8_f32(siluf_(g1[2]) * u1[2], siluf_(g1[3]) * u1[3], (int)w.y, true);
                    *(u32x2*)(H + (size_t)a * EHID + colh) = w; }
                __builtin_amdgcn_sched_barrier(0); }
    }
};
struct EpiE2 {
    unsigned char* Y; const float* wgt; const LAS int* cn; const LAS int* rb;
    __device__ __forceinline__ void operator()(const f32x4 (&acc)[2][2][4][2], const Unit& u, int wr, int wc, int fr, int fq) const {
        const int n = cn[u.e]; const int col0 = u.pn * BM + wc * 32 + 8 * fq;
#pragma unroll
        for (int ai = 0; ai < 2; ++ai)
#pragma unroll
            for (int m = 0; m < 4; ++m) { const int pos = u.pm * BM + ai * HALF + wr * 64 + m * 16 + fr;
                if (pos < n) { const int a = rb[u.e] + pos; float ws = wgt[u.e * TT + pos] * WSCALE_INV; asm volatile("" : "+v"(ws));
                    unsigned char* rowp = Y + (size_t)a * DM + col0;
#pragma unroll
                    for (int bj = 0; bj < 2; ++bj) { const f32x4 v0 = acc[ai][bj][m][0] * ws, v1 = acc[ai][bj][m][1] * ws;
                        u32x2 w;
                        w.x = (unsigned)__builtin_amdgcn_cvt_pk_fp8_f32(v0[0], v0[1], 0, false); w.x = (unsigned)__builtin_amdgcn_cvt_pk_fp8_f32(v0[2], v0[3], (int)w.x, true);
                        w.y = (unsigned)__builtin_amdgcn_cvt_pk_fp8_f32(v1[0], v1[1], 0, false); w.y = (unsigned)__builtin_amdgcn_cvt_pk_fp8_f32(v1[2], v1[3], (int)w.y, true);
                        *(u32x2*)(rowp + bj * HALF) = w; } }
                __builtin_amdgcn_sched_barrier(0); }
    }
};
}
struct KArgs {
    const float* in[34];
    float* out;
    unsigned char* ws;
    int ph_lo, ph_hi;
};
struct Params {
    float* out;
    unsigned char* ws;
    LAS unsigned long long* ptab;
    int ph_lo, ph_hi;
    __device__ __forceinline__ const float* inp(int k) const {
        const unsigned long long v = ptab[k];
        const unsigned lo = __builtin_amdgcn_readfirstlane((unsigned)v), hi = __builtin_amdgcn_readfirstlane((unsigned)(v >> 32));
        return (const float*)(((unsigned long long)hi << 32) | lo);
    }
};
struct Ctx {
    LAS unsigned char* lds;
    int tid, lane, wave, G, bid;
    int gw, ngw;
};

__device__ __forceinline__ void tr_item(const float* W, int N, bf16_t* WT, int ldt, int k0, int n0, int orow0, LAS float* scr, int lane) {
#pragma unroll 8
    for (int i = 0; i < 32; ++i) { const int kk = 2 * i + (lane >> 5); scr[kk * 33 + (lane & 31)] = W[(size_t)(k0 + kk) * N + n0 + (lane & 31)]; }
    LDS_WAIT(); asm volatile("" ::: "memory");
    const int c = lane & 7;
#pragma unroll
    for (int j = 0; j < 4; ++j) { const int n = (lane >> 3) + 8 * j; const LAS float* s = scr + (8 * c) * 33 + n;
        u32x4 o; o.x = cvt_pk_bf16(s[0 * 33], s[1 * 33]); o.y = cvt_pk_bf16(s[2 * 33], s[3 * 33]); o.z = cvt_pk_bf16(s[4 * 33], s[5 * 33]); o.w = cvt_pk_bf16(s[6 * 33], s[7 * 33]);
        *(u32x4*)(WT + (size_t)(orow0 + n) * ldt + k0 + 8 * c) = o; }
    LDS_WAIT(); asm volatile("" ::: "memory");
}
__device__ __forceinline__ void tr_item64(const float* W, int N, bf16_t* WT, int ldt, int k0, int n0, int orow0, LAS float* scr, int lane) {
    f32x4 v[16];
    const float* src = W + (size_t)(k0 + (lane >> 4)) * N + n0 + 4 * (lane & 15);
#pragma unroll
    for (int i = 0; i < 16; ++i) v[i] = __builtin_nontemporal_load((const f32x4*)(src + (size_t)(4 * i) * N));
#pragma unroll
    for (int i = 0; i < 16; ++i) { LAS float* d = scr + (4 * i + (lane >> 4)) * 65 + 4 * (lane & 15); d[0] = v[i][0]; d[1] = v[i][1]; d[2] = v[i][2]; d[3] = v[i][3]; }
    LDS_WAIT(); asm volatile("" ::: "memory");
    const int c = lane & 7;
#pragma unroll
    for (int j = 0; j < 8; ++j) { const int n = (lane >> 3) + 8 * j; const LAS float* s = scr + (8 * c) * 65 + n;
        u32x4 o; o.x = cvt_pk_bf16(s[0 * 65], s[1 * 65]); o.y = cvt_pk_bf16(s[2 * 65], s[3 * 65]); o.z = cvt_pk_bf16(s[4 * 65], s[5 * 65]); o.w = cvt_pk_bf16(s[6 * 65], s[7 * 65]);
        *(u32x4*)(WT + (size_t)(orow0 + n) * ldt + k0 + 8 * c) = o; }
    LDS_WAIT(); asm volatile("" ::: "memory");
}
__device__ __forceinline__ void tr_item64_fp8(const float* W, int N, unsigned char* WT, int ldt, int k0, int n0, int orow0, LAS float* scr, int lane, float wscale = pg8::WSCALE) {
    f32x4 v[16];
    const float* src = W + (size_t)(k0 + (lane >> 4)) * N + n0 + 4 * (lane & 15);
#pragma unroll
    for (int i = 0; i < 16; ++i) v[i] = __builtin_nontemporal_load((const f32x4*)(src + (size_t)(4 * i) * N));
#pragma unroll
    for (int i = 0; i < 16; ++i) { LAS float* d = scr + (4 * i + (lane >> 4)) * 65 + 4 * (lane & 15); d[0] = v[i][0]; d[1] = v[i][1]; d[2] = v[i][2]; d[3] = v[i][3]; }
    LDS_WAIT(); asm volatile("" ::: "memory");
    const int c = lane & 7;
#pragma unroll
    for (int j = 0; j < 8; ++j) { const int n = (lane >> 3) + 8 * j; const LAS float* s = scr + (8 * c) * 65 + n;
        u32x2 o;
        o.x = (unsigned)__builtin_amdgcn_cvt_pk_fp8_f32(s[0 * 65] * wscale, s[1 * 65] * wscale, 0, false);
        o.x = (unsigned)__builtin_amdgcn_cvt_pk_fp8_f32(s[2 * 65] * wscale, s[3 * 65] * wscale, (int)o.x, true);
        o.y = (unsigned)__builtin_amdgcn_cvt_pk_fp8_f32(s[4 * 65] * wscale, s[5 * 65] * wscale, 0, false);
        o.y = (unsigned)__builtin_amdgcn_cvt_pk_fp8_f32(s[6 * 65] * wscale, s[7 * 65] * wscale, (int)o.y, true);
        *(u32x2*)(WT + (size_t)(orow0 + n) * ldt + k0 + 8 * c) = o; }
    LDS_WAIT(); asm volatile("" ::: "memory");
}
__device__ __forceinline__ void tr_dense(const float* W, int K, int N, bf16_t* WT, int item, LAS float* scr, int lane) {
    const int nblk = N / 32, kb = item / nblk, nb = item % nblk;
    tr_item(W, N, WT, K, 64 * kb, 32 * nb, 32 * nb, scr, lane);
}

__device__ __forceinline__ void s5_tables(const Params& p, Ctx& C, int dir, int g) {
    LAS f32x2* PW = (LAS f32x2*)C.lds;
    LAS f32x2* BB = PW + 65 * 64;
    LAS f32x2* CX = BB + 64 * 16;
    const float* a_re = p.inp(11); const float* a_im = p.inp(12); const float* log_dt = p.inp(13);
    const float* b_re = p.inp(14); const float* b_im = p.inp(15); const float* c_re = p.inp(16); const float* c_im = p.inp(17);
    const int tid = C.tid;
    if (tid < 64) {
        const int pp = tid;
        const float dt = __expf(log_dt[dir * 64 + g]);
        const float are = a_re[(dir * 64 + g) * 64 + pp], aim = a_im[(dir * 64 + g) * 64 + pp];
        const float zr = are * dt, zi = aim * dt;
        const float mag = __expf(zr);
        double rev = (double)zi * 0.15915494309189535; rev -= floor(rev);
        const float cs = __builtin_amdgcn_cosf((float)rev), sn = __builtin_amdgcn_sinf((float)rev);
        const float abr = mag * cs, abi = mag * sn;
        const float den = are * are + aim * aim, nr = abr - 1.0f, ni = abi;
        const float fre = (nr * are + ni * aim) / den, fim = (ni * are - nr * aim) / den;
        float pr = 1.0f, pi = 0.0f;
#pragma unroll 1
        for (int n = 0; n <= 64; ++n) { PW[n * 64 + pp] = (f32x2){pr, pi}; const float t = pr * abr - pi * abi; pi = pr * abi + pi * abr; pr = t; }
        for (int j = 0; j < 16; ++j) { const float br = b_re[(g * 64 + pp) * 16 + j], bi = b_im[(g * 64 + pp) * 16 + j];
            BB[pp * 16 + j] = (f32x2){fre * br - fim * bi, fre * bi + fim * br}; }
    }
    for (int q = tid; q < 1024; q += NTHR) { const int i = q >> 6, pp = q & 63; CX[i * 64 + pp] = (f32x2){c_re[(g * 16 + i) * 64 + pp], c_im[(g * 16 + i) * 64 + pp]}; }
    __syncthreads();
    bf16_t* KN = (bf16_t*)(p.ws + WS_KN) + (size_t)(dir * 64 + g) * 16 * 1024;
    bf16_t* WTt = (bf16_t*)(p.ws + WS_WT) + (size_t)(dir * 64 + g) * 128 * 1024;
    float* APOW = (float*)(p.ws + WS_APOW) + (size_t)(dir * 64 + g) * 64 * 128;
    float* AL = (float*)(p.ws + WS_AL) + (size_t)(dir * 64 + g) * 128;
#pragma unroll 1
    for (int q = 0; q < 32; ++q) { const int idx = tid + NTHR * q; const int n = idx >> 8, i = (idx >> 4) & 15, j = idx & 15;
        float s = 0.f;
#pragma unroll 4
        for (int pp = 0; pp < 64; ++pp) { const f32x2 c = CX[i * 64 + pp], w = PW[n * 64 + pp], b = BB[pp * 16 + j];
            const float gr = c.x * b.x - c.y * b.y, gi = c.x * b.y + c.y * b.x;
            s += gr * w.x - gi * w.y; }
        KN[(size_t)i * 1024 + n * 16 + j] = f2bf(s); }
#pragma unroll 2
    for (int q = 0; q < 256; ++q) { const int idx = tid + NTHR * q; const int j = idx & 15, s = (idx >> 4) & 63, pq = idx >> 10; const int pp = pq & 63;
        const f32x2 w = PW[(63 - s) * 64 + pp], b = BB[pp * 16 + j];
        const float v = (pq < 64) ? (w.x * b.x - w.y * b.y) : (w.x * b.y + w.y * b.x);
        WTt[(size_t)pq * 1024 + s * 16 + j] = f2bf(v); }
    for (int q = tid; q < 4096; q += NTHR) { const int t = q >> 6, pp = q & 63; const f32x2 w = PW[(t + 1) * 64 + pp]; *(f32x2*)(APOW + (size_t)t * 128 + 2 * pp) = w; }
    if (tid < 64) { const f32x2 w = PW[64 * 64 + tid]; *(f32x2*)(AL + 2 * tid) = w; }
    if (dir == 0) { bf16_t* CCt = (bf16_t*)(p.ws + WS_CC) + (size_t)g * 16 * 128;
        for (int q = tid; q < 2048; q += NTHR) { const int i = q >> 7, pq = q & 127; const f32x2 c = CX[i * 64 + (pq & 63)]; CCt[i * 128 + pq] = f2bf(pq < 64 ? c.x : -c.y); } }
    __syncthreads();
}

__device__ __forceinline__ void phase_p0(const Params& p, Ctx& C) {
    for (int task = C.bid; task < 128; task += C.G) s5_tables(p, C, task >> 6, task & 63);
    {
        const int gt = C.bid * NTHR + C.tid, ngt = C.G * NTHR;
        float* R128 = (float*)(p.ws + WS_ROPE128); float* R64 = (float*)(p.ws + WS_ROPE64);
        for (int q = gt; q < 256 * 64 + 256 * 32; q += ngt) {
            int pos, i, half; float* dst;
            if (q < 256 * 64) { pos = q >> 6; i = q & 63; half = 64; dst = R128 + (size_t)q * 2; }
            else { const int r = q - 256 * 64; pos = r >> 5; i = r & 31; half = 32; dst = R64 + (size_t)r * 2; }
            const float freq = exp2f(-(float)i / (float)half * 13.287712379549449f);
            const float ang = (float)pos * freq;
            double rev = (double)ang * 0.15915494309189535; rev -= floor(rev);
            dst[0] = __builtin_amdgcn_cosf((float)rev); dst[1] = __builtin_amdgcn_sinf((float)rev);
        }
        bf16_t* RWT = (bf16_t*)(p.ws + WS_RWT); const float* rw = p.inp(26);
        for (int q = gt; q < 2 * 64 * DM; q += ngt) { const int L = q / (64 * DM), r = q % (64 * DM), e = r / DM, k = r % DM;
            const float w = rw[((size_t)L * DM + k) * 64 + e]; const bf16_t hi = f2bf(w); const bf16_t lo = f2bf(w - bf2f(hi));
            RWT[((size_t)(L * 2 + 0) * 64 + e) * DM + k] = hi; RWT[((size_t)(L * 2 + 1) * 64 + e) * DM + k] = lo; }
    }
    {
        const float* cvec = p.inp(1); const float* cctx = p.inp(3); const float* mw = p.inp(4);
        float* MODP = (float*)(p.ws + WS_MODP);
        for (int task = C.gw; task < 2 * 32 * 48; task += C.ngw) {
            const int L = task / (32 * 48), r = task % (32 * 48), kb = r / 48, cb = r % 48;
            const float sc = siluf_(cvec[64 * kb + C.lane]), sx = siluf_(cctx[64 * kb + C.lane]);
            f32x4 a0 = {0.f, 0.f, 0.f, 0.f}, a1 = {0.f, 0.f, 0.f, 0.f};
            const float* wp = mw + ((size_t)L * DM + 64 * kb) * 12288 + 256 * cb + 4 * C.lane;
#pragma unroll 8
            for (int kk = 0; kk < 64; ++kk) { const f32x4 w = *(const f32x4*)(wp + (size_t)kk * 12288);
                const float s0 = __shfl(sc, kk), s1 = __shfl(sx, kk);
                a0 += w * s0; a1 += w * s1; }
            *(f32x4*)(MODP + ((size_t)((L * 32 + kb) * 2 + 0)) * 12288 + 256 * cb + 4 * C.lane) = a0;
            *(f32x4*)(MODP + ((size_t)((L * 32 + kb) * 2 + 1)) * 12288 + 256 * cb + 4 * C.lane) = a1;
        }
    }
    {
        LAS float* scr = (LAS float*)(C.lds + C.wave * 17408);
        constexpr int J0 = (DM / 64) * (EV_IN / 64), J3 = (DM / 64) * (OD_IN / 64);
        for (int it = C.gw; it < J0 + J3; it += C.ngw) {
            const bool l1 = it >= J0; const int r = l1 ? it - J0 : it; const int N = l1 ? OD_IN : EV_IN; const int nblk = N / 64, kb = r / nblk, nb = r % nblk;
            tr_item64_fp8(p.inp(l1 ? 21 : 8), N, (unsigned char*)(p.ws + (l1 ? WS_WIN1 : WS_WIN0)), DM, 64 * kb, 64 * nb, 64 * nb, scr, C.lane, 32.0f);
        }
        LAS float* scr2 = (LAS float*)(C.lds + C.wave * 17408);
        constexpr int I1 = (DM / 64) * (DM / 32), I2 = (1024 / 64) * (1024 / 32), I4 = I1;
        for (int it = C.gw; it < I1 + I2 + I4; it += C.ngw) {
            int r = it;
            if (r < I1) { tr_dense(p.inp(9), DM, DM, (bf16_t*)(p.ws + WS_WOUT0), r, scr2, C.lane); continue; } r -= I1;
            if (r < I2) { tr_dense(p.inp(19), 1024, 1024, (bf16_t*)(p.ws + WS_WGLU), r, scr2, C.lane); continue; } r -= I2;
            tr_dense(p.inp(22), DM, DM, (bf16_t*)(p.ws + WS_WOUT1), r, scr2, C.lane);
        }
    }
}
__device__ __forceinline__ void phase_p1(const Params& p, Ctx& C) {
    const float* MODP = (const float*)(p.ws + WS_MODP); float* MODF = (float*)(p.ws + WS_MODF); const float* mb = p.inp(5);
    for (int q = C.bid * NTHR + C.tid; q < 2 * 2 * 12288; q += C.G * NTHR) { const int L = q / (2 * 12288), v = (q / 12288) & 1, col = q % 12288;
        float s = mb[L * 12288 + col];
        for (int kb = 0; kb < 32; ++kb) s += MODP[((size_t)((L * 32 + kb) * 2 + v)) * 12288 + col];
        MODF[q] = s; }
}
__device__ __forceinline__ const float* modv(const Params& p, int L, int v, int k) { return (const float*)(p.ws + WS_MODF) + (size_t)(L * 2 + v) * 12288 + k * DM; }

__device__ __forceinline__ void stage_vec(LAS float* dst, const float* src, int tid) { *(LAS f32x4*)(dst + 4 * tid) = *(const f32x4*)(src + 4 * tid); }
__device__ __forceinline__ void phase_modulate(const Params& p, Ctx& C, int L) {
    unsigned char* XA8 = (unsigned char*)(p.ws + WS_XA);
    const float* X2 = (const float*)(p.ws + WS_HX2);
    LAS float* MV = (LAS float*)C.lds;
    for (int v = 0; v < 2; ++v) { stage_vec(MV + (v * 2 + 0) * DM, modv(p, L, v, 0), C.tid); stage_vec(MV + (v * 2 + 1) * DM, modv(p, L, v, 1), C.tid); }
    __syncthreads();
    for (int r = C.gw; r < TT; r += C.ngw) {
        const int v = r < CTXL ? 1 : 0;
        const float* src = (L == 0) ? (r < CTXL ? p.inp(2) + (size_t)r * DM : p.inp(0) + (size_t)(r - CTXL) * DM) : X2 + (size_t)r * DM;
        const LAS float* sh = MV + (v * 2 + 0) * DM; const LAS float* sc = MV + (v * 2 + 1) * DM;
#pragma unroll
        for (int j = 0; j < 8; ++j) { const int c = 4 * (C.lane + 64 * j);
            const f32x4 x = *(const f32x4*)(src + c), a = *(const LAS f32x4*)(sc + c), b = *(const LAS f32x4*)(sh + c);
            const f32x4 y = x * (a + 1.0f) + b;
            unsigned w = (unsigned)__builtin_amdgcn_cvt_pk_fp8_f32(y[0], y[1], 0, false); w = (unsigned)__builtin_amdgcn_cvt_pk_fp8_f32(y[2], y[3], (int)w, true);
            *(unsigned*)(XA8 + (size_t)r * DM + c) = w; }
    }
    __syncthreads();
    LAS float* scr = (LAS float*)(C.lds + C.wave * 17408);
    unsigned char* GU = (unsigned char*)(p.ws + WS_GU); unsigned char* DT = (unsigned char*)(p.ws + WS_DT);
    for (int it = C.gw; it < NEX1 * 768; it += C.ngw) {
        const int e = it / 768, r = it % 768, which = r >> 8, q = r & 255;
        if (which < 2) {
            const float* W = (e < 64) ? p.inp(28 + which) + ((size_t)(L * 64 + e)) * DM * EHID : p.inp(31 + which) + (size_t)L * DM * EHID;
            const int kb = q >> 3, nb = q & 7, n0 = 64 * nb;
            tr_item64_fp8(W, EHID, GU + (size_t)e * 1024 * DM, DM, 64 * kb, n0, 256 * (n0 >> 7) + (n0 & 127) + (which ? 128 : 0), scr, C.lane);
        } else {
            const float* W = (e < 64) ? p.inp(30) + ((size_t)(L * 64 + e)) * EHID * DM : p.inp(33) + (size_t)L * EHID * DM;
            const int kb = q >> 5, nb = q & 31;
            tr_item64_fp8(W, DM, DT + (size_t)e * DM * EHID, EHID, 64 * kb, 64 * nb, 64 * nb, scr, C.lane);
        }
    }
}

__device__ __forceinline__ void phase_rope0(const Params& p, Ctx& C) {
    bf16_t* QKV = (bf16_t*)(p.ws + WS_BIG + BG_QKV);
    const f32x2* R128 = (const f32x2*)(p.ws + WS_ROPE128);
    for (int r = C.gw; r < TT; r += C.ngw) {
        bf16_t* row = QKV + (size_t)r * EV_IN;
        if (r < CTXL) {
#pragma unroll
            for (int j = 0; j < 2; ++j) { u32x4* q = (u32x4*)(row + 8 * (C.lane + 64 * j)); u32x4 w = *q;
                w.x = cvt_pk_bf16(bflo(w.x) * 0.0625f, bfhi(w.x) * 0.0625f); w.y = cvt_pk_bf16(bflo(w.y) * 0.0625f, bfhi(w.y) * 0.0625f);
                w.z = cvt_pk_bf16(bflo(w.z) * 0.0625f, bfhi(w.z) * 0.0625f); w.w = cvt_pk_bf16(bflo(w.w) * 0.0625f, bfhi(w.w) * 0.0625f); *q = w; }
        } else {
            const int l = r - CTXL, rp = l >> 6, cp = l & 63;
#pragma unroll
            for (int qk = 0; qk < 2; ++qk)
#pragma unroll
                for (int m = 0; m < 8; ++m) { const int pi = C.lane + 64 * m, head = pi >> 7, blk = (pi >> 6) & 1, i = pi & 63;
                    bf16_t* b = row + qk * 1024 + head * 256 + blk * 128 + i;
                    const f32x2 cs = R128[(blk ? cp : rp) * 64 + i];
                    const float x1 = bf2f(b[0]), x2 = bf2f(b[64]); const float sc = qk ? 1.0f : 0.0625f;
                    b[0] = f2bf((x1 * cs.x - x2 * cs.y) * sc); b[64] = f2bf((x1 * cs.y + x2 * cs.x) * sc); }
        }
    }
}

__device__ __forceinline__ void phase_normrope1(const Params& p, Ctx& C) {
    bf16_t* QKV = (bf16_t*)(p.ws + WS_BIG + BG_QKV);
    const f32x2* R64 = (const f32x2*)(p.ws + WS_ROPE64);
    const float* qg = p.inp(23);
    const int lane = C.lane, i32 = lane & 31; const bool up = lane >= 32;
    const float g00 = qg[lane], g01 = qg[64 + lane], g10 = qg[128 + lane], g11 = qg[128 + 64 + lane];
    for (int r = C.gw; r < TT; r += C.ngw) {
        bf16_t* row = QKV + (size_t)r * OD_IN;
        const bool lat = r >= CTXL; const int l = r - CTXL, rp = lat ? (l >> 6) : 0, cp = lat ? (l & 63) : 0;
        const f32x2 cr = R64[rp * 32 + i32], cc = R64[cp * 32 + i32];
#pragma unroll 2
        for (int h = 0; h < 26; ++h) {
            const int col = h < 8 ? 128 * h : (h < 10 ? 1024 + 128 * (h - 8) : (h < 18 ? 1536 + 128 * (h - 10) : 2560 + 128 * (h - 18)));
            bf16_t* b = row + col;
            float v0 = bf2f(b[lane]), v1 = bf2f(b[64 + lane]);
            if (h < 10) { const float ss = wave_sum(v0 * v0 + v1 * v1); const float rs = rsqrtf(ss * (1.0f / 128.0f) + LN_EPS);
                v0 = bf2f(f2bf(v0 * rs)) * (h < 8 ? g00 : g10); v1 = bf2f(f2bf(v1 * rs)) * (h < 8 ? g01 : g11); }
            if (lat) { const float p0 = __shfl_xor(v0, 32), p1 = __shfl_xor(v1, 32);
                v0 = up ? (p0 * cr.y + v0 * cr.x) : (v0 * cr.x - p0 * cr.y);
                v1 = up ? (p1 * cc.y + v1 * cc.x) : (v1 * cc.x - p1 * cc.y); }
            b[lane] = f2bf(v0); b[64 + lane] = f2bf(v1);
        }
    }
}

__device__ __forceinline__ void phase_merge1(const Params& p, Ctx& C) {
    bf16_t* ATT = (bf16_t*)(p.ws + WS_BIG + BG_ATT);
    const float* dl = p.inp(24); const float* sg = p.inp(25);
    const int lane = C.lane;
    float d0 = dl[lane] * dl[128 + lane] + dl[64 + lane] * dl[128 + 64 + lane];
    float d1 = dl[256 + lane] * dl[384 + lane] + dl[256 + 64 + lane] * dl[384 + 64 + lane];
    const float lam = __expf(wave_sum(d0)) - __expf(wave_sum(d1)) + LAMBDA_INIT;
    const f32x4 gg = *(const f32x4*)(sg + 4 * lane);
    for (int l = C.gw; l < SEQ; l += C.ngw) {
        bf16_t* row = ATT + (size_t)l * 3072;
#pragma unroll
        for (int h = 0; h < 4; ++h) {
            const u32x2 a = *(const u32x2*)(row + 1024 + 256 * h + 4 * lane), b = *(const u32x2*)(row + 2048 + 256 * h + 4 * lane);
            f32x4 o = {bflo(a.x) - lam * bflo(b.x), bfhi(a.x) - lam * bfhi(b.x), bflo(a.y) - lam * bflo(b.y), bfhi(a.y) - lam * bfhi(b.y)};
            const float ss = wave_sum(o[0] * o[0] + o[1] * o[1] + o[2] * o[2] + o[3] * o[3]);
            const float rs = rsqrtf(ss * (1.0f / 256.0f) + LN_EPS) * (1.0f - LAMBDA_INIT);
            o = o * rs * gg;
            u32x2 w; w.x = cvt_pk_bf16(o[0], o[1]); w.y = cvt_pk_bf16(o[2], o[3]);
            *(u32x2*)(row + 1024 + 256 * h + 4 * lane) = w;
        }
    }
}

__device__ __forceinline__ void phase_ln1(const Params& p, Ctx& C, int L) {
    const bf16_t* Y = (const bf16_t*)(p.ws + WS_YMIX); float* X1 = (float*)(p.ws + WS_X1); unsigned char* XA8 = (unsigned char*)(p.ws + WS_XA);
    const float* X2 = (const float*)(p.ws + WS_HX2);
    const float* lg = p.inp(6) + (size_t)(L * 2 + 0) * DM; const float* lb = p.inp(7) + (size_t)(L * 2 + 0) * DM;
    const int r0 = (L == 0) ? 0 : CTXL;
    LAS float* MV = (LAS float*)C.lds; LAS float* LG = MV + 6 * DM; LAS float* LB = LG + DM;
    for (int v = 0; v < 2; ++v) for (int k = 0; k < 3; ++k) stage_vec(MV + (v * 3 + k) * DM, modv(p, L, v, 2 + k), C.tid);
    stage_vec(LG, lg, C.tid); stage_vec(LB, lb, C.tid);
    __syncthreads();
    for (int r = r0 + C.gw; r < TT; r += C.ngw) {
        const int v = r < CTXL ? 1 : 0;
        const float* src = (L == 0) ? (r < CTXL ? p.inp(2) + (size_t)r * DM : p.inp(0) + (size_t)(r - CTXL) * DM) : X2 + (size_t)r * DM;
        const LAS float* g1 = MV + (v * 3 + 0) * DM; const LAS float* sh2 = MV + (v * 3 + 1) * DM; const LAS float* sc2 = MV + (v * 3 + 2) * DM;
        f32x4 t[8]; float s = 0.f;
#pragma unroll
        for (int j = 0; j < 8; ++j) { const int c = 4 * (C.lane + 64 * j);
            const f32x4 x = *(const f32x4*)(src + c), g = *(const LAS f32x4*)(g1 + c); const u32x2 yy = *(const u32x2*)(Y + (size_t)r * DM + c);
            const f32x4 y = {bflo(yy.x), bfhi(yy.x), bflo(yy.y), bfhi(yy.y)};
            t[j] = x * ALPHA + g * y; s += (t[j][0] + t[j][1]) + (t[j][2] + t[j][3]); }
        const float mean = wave_sum(s) * (1.0f / DM); float s2 = 0.f;
#pragma unroll
        for (int j = 0; j < 8; ++j) { t[j] = t[j] - mean; s2 += (t[j][0] * t[j][0] + t[j][1] * t[j][1]) + (t[j][2] * t[j][2] + t[j][3] * t[j][3]); }
        const float rstd = rsqrtf(wave_sum(s2) * (1.0f / DM) + LN_EPS);
#pragma unroll
        for (int j = 0; j < 8; ++j) { const int c = 4 * (C.lane + 64 * j);
            const f32x4 x1 = t[j] * rstd * *(const LAS f32x4*)(LG + c) + *(const LAS f32x4*)(LB + c);
            *(f32x4*)(X1 + (size_t)r * DM + c) = x1;
            const f32x4 z = x1 * (*(const LAS f32x4*)(sc2 + c) + 1.0f) + *(const LAS f32x4*)(sh2 + c);
            unsigned w = (unsigned)__builtin_amdgcn_cvt_pk_fp8_f32(z[0], z[1], 0, false); w = (unsigned)__builtin_amdgcn_cvt_pk_fp8_f32(z[2], z[3], (int)w, true);
            *(unsigned*)(XA8 + (size_t)r * DM + c) = w; }
    }
    __syncthreads();
}

__device__ __forceinline__ void phase_combine(const Params& p, Ctx& C, int L, LAS unsigned char* misc) {
    const unsigned char* YM = (const unsigned char*)(p.ws + WS_BIG + BG_YMOE); const float* X1 = (const float*)(p.ws + WS_X1);
    float* X2 = (float*)(p.ws + WS_HX2);
    const float* lg = p.inp(6) + (size_t)(L * 2 + 1) * DM; const float* lb = p.inp(7) + (size_t)(L * 2 + 1) * DM;
    const unsigned* PK = (const unsigned*)(p.ws + WS_WGT); const int* cnt = (const int*)(p.ws + WS_CTL) + CW_CNT + L * 128;
    const int r0 = (L == 0) ? 0 : CTXL;
    LAS int* rb = (LAS int*)(misc + 64);
    LAS float* MV = (LAS float*)C.lds; LAS float* LG = MV + 2 * DM; LAS float* LB = LG + DM;
    __syncthreads();
    if (C.tid == 0) { int q = 0; for (int e = 0; e < NEX1; ++e) { rb[e] = q; q += cnt[e]; } }
    stage_vec(MV, modv(p, L, 0, 5), C.tid); stage_vec(MV + DM, modv(p, L, 1, 5), C.tid); stage_vec(LG, lg, C.tid); stage_vec(LB, lb, C.tid);
    __syncthreads();
    for (int r = r0 + C.gw; r < TT; r += C.ngw) {
        const int v = r < CTXL ? 1 : 0;
        const LAS float* g2 = MV + v * DM;
        int ln = C.lane; asm volatile("" : "+v"(ln));
        int slot = rb[64] + (r - r0);
        if (ln < 8) { const unsigned pk = PK[(size_t)r * 8 + ln]; slot = rb[pk >> 16] + (int)(pk & 0xffffu); }
        f32x4 t[2][4]; float s = 0.f;
#pragma unroll
        for (int j = 0; j < 2; ++j) { const int c = 16 * (ln + 64 * j);
            u32x4 yy[9];
#pragma unroll
            for (int k = 0; k < 9; ++k) { const size_t a = (size_t)__builtin_amdgcn_readlane(slot, k); yy[k] = __builtin_nontemporal_load((const u32x4*)(YM + a * DM + c)); }
            f32x2 f[8];
#pragma unroll
            for (int q = 0; q < 8; ++q) f[q] = (f32x2){0.f, 0.f};
#pragma unroll
            for (int k = 0; k < 9; ++k) {
                f[0] += __builtin_amdgcn_cvt_pk_f32_fp8((int)yy[k].x, false); f[1] += __builtin_amdgcn_cvt_pk_f32_fp8((int)yy[k].x, true);
                f[2] += __builtin_amdgcn_cvt_pk_f32_fp8((int)yy[k].y, false); f[3] += __builtin_amdgcn_cvt_pk_f32_fp8((int)yy[k].y, true);
                f[4] += __builtin_amdgcn_cvt_pk_f32_fp8((int)yy[k].z, false); f[5] += __builtin_amdgcn_cvt_pk_f32_fp8((int)yy[k].z, true);
                f[6] += __builtin_amdgcn_cvt_pk_f32_fp8((int)yy[k].w, false); f[7] += __builtin_amdgcn_cvt_pk_f32_fp8((int)yy[k].w, true); }
#pragma unroll
            for (int q = 0; q < 4; ++q) { const f32x4 x = *(const f32x4*)(X1 + (size_t)r * DM + c + 4 * q), g = *(const LAS f32x4*)(g2 + c + 4 * q);
                const f32x4 ff = {f[2 * q][0], f[2 * q][1], f[2 * q + 1][0], f[2 * q + 1][1]};
                t[j][q] = x * ALPHA + g * ff; s += (t[j][q][0] + t[j][q][1]) + (t[j][q][2] + t[j][q][3]); } }
        const float mean = wave_sum(s) * (1.0f / DM); float s2 = 0.f;
#pragma unroll
        for (int j = 0; j < 2; ++j)
#pragma unroll
            for (int q = 0; q < 4; ++q) { t[j][q] = t[j][q] - mean; s2 += (t[j][q][0] * t[j][q][0] + t[j][q][1] * t[j][q][1]) + (t[j][q][2] * t[j][q][2] + t[j][q][3] * t[j][q][3]); }
        const float rstd = rsqrtf(wave_sum(s2) * (1.0f / DM) + LN_EPS);
        float* dst = (L == 0) ? X2 + (size_t)r * DM : p.out + (size_t)(r - CTXL) * DM;
#pragma unroll
        for (int j = 0; j < 2; ++j)
#pragma unroll
            for (int q = 0; q < 4; ++q) { const int c = 16 * (ln + 64 * j) + 4 * q;
                *(f32x4*)(dst + c) = t[j][q] * rstd * *(const LAS f32x4*)(LG + c) + *(const LAS f32x4*)(LB + c); }
    }
}
constexpr int RLD = 264;
constexpr int SLD = 136;

template <bool SCALE>
__device__ __forceinline__ void stage_chunk(const bf16_t* QKV, int row0, int col0, LAS bf16_t* dst, int tid, float lg  , int dirb) {
#pragma unroll
    for (int q = 0; q < 8; ++q) { const int idx = tid + NTHR * q, r = idx >> 5, c = idx & 31;
        u32x4 w = *(const u32x4*)(QKV + (size_t)(row0 + r) * EV_IN + col0 + 8 * c);
        if (SCALE) { const float sc = fast_exp((dirb ? (float)r : (float)(127 - r)) * lg);
            w.x = cvt_pk_bf16(bflo(w.x) * sc, bfhi(w.x) * sc); w.y = cvt_pk_bf16(bflo(w.y) * sc, bfhi(w.y) * sc);
            w.z = cvt_pk_bf16(bflo(w.z) * sc, bfhi(w.z) * sc); w.w = cvt_pk_bf16(bflo(w.w) * sc, bfhi(w.w) * sc); }
        *(LAS u32x4*)(dst + r * RLD + 8 * c) = w; }
}

__device__ __forceinline__ void ret_chunk_kv(const Params& p, Ctx& C) {
    const bf16_t* QKV = (const bf16_t*)(p.ws + WS_BIG + BG_QKV); float* CKV = (float*)(p.ws + WS_BIG + BG_CKV);
    const float* rld = p.inp(10);
    LAS bf16_t* Vs = (LAS bf16_t*)C.lds; LAS bf16_t* Ks = Vs + 128 * RLD;
    const int lane = C.lane, w = C.wave;
    for (int unit = C.bid; unit < 130 * 8; unit += C.G) {
        const int u = unit >> 3, h = (unit >> 1) & 3, dir = unit & 1;
        const float lg = rld[dir * 4 + h];
        __syncthreads();
        stage_chunk<false>(QKV, 128 * u, 2048 + 256 * h, Vs, C.tid, 0.f, 0);
        stage_chunk<true>(QKV, 128 * u, 1024 + 256 * h, Ks, C.tid, lg, dir);
        __syncthreads();
        f32x4 acc[2][16];
#pragma unroll
        for (int a = 0; a < 2; ++a)
#pragma unroll
            for (int b = 0; b < 16; ++b) acc[a][b] = (f32x4){0.f, 0.f, 0.f, 0.f};
        const unsigned vbase = (unsigned)(uintptr_t)Vs, kbase = (unsigned)(uintptr_t)Ks;
#pragma unroll 1
        for (int ks = 0; ks < 4; ++ks) {
            bf16x8 af[2];
#pragma unroll
            for (int a = 0; a < 2; ++a) af[a] = frag_colk_l(vbase + (unsigned)((32 * ks) * RLD + 32 * w + 16 * a) * 2u, RLD * 2, lane);
#pragma unroll
            for (int b = 0; b < 16; ++b) { const bf16x8 bf = frag_colk_l(kbase + (unsigned)((32 * ks) * RLD + 16 * b) * 2u, RLD * 2, lane);
                acc[0][b] = MFMA16(af[0], bf, acc[0][b]); acc[1][b] = MFMA16(af[1], bf, acc[1][b]); }
        }
        float* dst = CKV + ((size_t)((dir * 4 + h) * 130 + u)) * 65536;
#pragma unroll
        for (int a = 0; a < 2; ++a)
#pragma unroll
            for (int b = 0; b < 16; ++b)
#pragma unroll
                for (int j = 0; j < 4; ++j) dst[(size_t)(32 * w + 16 * a + 4 * (lane >> 4) + j) * 256 + 16 * b + (lane & 15)] = acc[a][b][j];
    }
    __syncthreads();
}

__device__ __forceinline__ int s5_row(int dir, int c, int s) { return dir == 0 ? 64 * c + s : (c < 4 ? 255 - (64 * c + s) : 16639 - 64 * (c - 4) - s); }

__device__ __forceinline__ void s5_end_states(const Params& p, Ctx& C) {
    const bf16_t* QKV = (const bf16_t*)(p.ws + WS_BIG + BG_QKV); const bf16_t* WTt = (const bf16_t*)(p.ws + WS_WT); float* E = (float*)(p.ws + WS_S5E);
    const int lane = C.lane, kq = lane >> 4;
    for (int task = C.gw; task < 2 * 64 * 17; task += C.ngw) {
        const int dir = task / (64 * 17), r = task % (64 * 17), g = r / 17, ct = r % 17;
        int cc = 16 * ct + (lane & 15); const bool valid = cc < 260; cc = valid ? cc : 259;
        const bf16_t* wt = WTt + (size_t)(dir * 64 + g) * 128 * 1024;
        f32x4 acc[8];
#pragma unroll
        for (int t = 0; t < 8; ++t) acc[t] = (f32x4){0.f, 0.f, 0.f, 0.f};
#pragma unroll 2
        for (int ks = 0; ks < 32; ++ks) {
            const int s = 2 * ks + (kq >> 1);
            const bf16x8 bf = *(const bf16x8*)(QKV + (size_t)s5_row(dir, cc, s) * EV_IN + 4096 + 16 * g + 8 * (kq & 1));
#pragma unroll
            for (int t = 0; t < 8; ++t) { const bf16x8 af = frag_rowk_g(wt + (size_t)(16 * t) * 1024 + 32 * ks, 1024, lane); acc[t] = MFMA16(af, bf, acc[t]); }
        }
        if (valid) { float* dst = E + ((size_t)((dir * 64 + g) * 260 + cc)) * 128;
#pragma unroll
            for (int t = 0; t < 8; ++t) *(f32x4*)(dst + 16 * t + 4 * kq) = acc[t]; }
    }
}

__device__ __forceinline__ void phase_scans(const Params& p, Ctx& C) {
    const float* CKV = (const float*)(p.ws + WS_BIG + BG_CKV); bf16_t* SP = (bf16_t*)(p.ws + WS_BIG + BG_SPREV);
    const float* rld = p.inp(10);
    for (int q = C.bid * NTHR + C.tid; q < 8 * 16384; q += C.G * NTHR) {
        const int dh = q >> 14, el = (q & 16383) * 4, dir = dh >> 2, h = dh & 3;
        const float gch = fast_exp(128.0f * rld[dir * 4 + h]);
        const float* src = CKV + (size_t)dh * 130 * 65536 + el; bf16_t* dst = SP + (size_t)dh * 130 * 65536 + el;
        f32x4 s = {0.f, 0.f, 0.f, 0.f};
        for (int st0 = 0; st0 < 130; st0 += 10) {
            f32x4 kv[10];
#pragma unroll
            for (int k = 0; k < 10; ++k) { const int st = st0 + k; const int u = dir == 0 ? st : (st == 0 ? 1 : (st == 1 ? 0 : 131 - st)); kv[k] = *(const f32x4*)(src + (size_t)u * 65536); }
#pragma unroll
            for (int k = 0; k < 10; ++k) { const int st = st0 + k; const int u = dir == 0 ? st : (st == 0 ? 1 : (st == 1 ? 0 : 131 - st));
                u32x2 w; w.x = cvt_pk_bf16(s[0], s[1]); w.y = cvt_pk_bf16(s[2], s[3]); *(u32x2*)(dst + (size_t)u * 65536) = w;
                s = s * gch + kv[k]; }
        }
    }
    const float* E = (const float*)(p.ws + WS_S5E); float* HST = (float*)(p.ws + WS_HST); const float* AL = (const float*)(p.ws + WS_AL);
    for (int q = C.bid * NTHR + C.tid; q < 2 * 64 * 64; q += C.G * NTHR) {
        const int dg = q >> 6, pp = q & 63;
        const f32x2 al = *(const f32x2*)(AL + (size_t)dg * 128 + 2 * pp);
        const float* e = E + (size_t)dg * 260 * 128; float* hs = HST + (size_t)dg * 260 * 128;
        float hr = 0.f, hi = 0.f;
        for (int c0 = 0; c0 < 260; c0 += 10) {
            float er[10], ei[10];
#pragma unroll
            for (int k = 0; k < 10; ++k) { er[k] = e[(size_t)(c0 + k) * 128 + pp]; ei[k] = e[(size_t)(c0 + k) * 128 + 64 + pp]; }
#pragma unroll
            for (int k = 0; k < 10; ++k) { *(f32x2*)(hs + (size_t)(c0 + k) * 128 + 2 * pp) = (f32x2){hr, hi};
                const float t = al.x * hr - al.y * hi + er[k]; hi = al.x * hi + al.y * hr + ei[k]; hr = t; }
        }
    }
}

__device__ __forceinline__ void ret_output_unit(const Params& p, Ctx& C, int unit) {
    const bf16_t* QKV = (const bf16_t*)(p.ws + WS_BIG + BG_QKV); const bf16_t* SP = (const bf16_t*)(p.ws + WS_BIG + BG_SPREV);
    bf16_t* MIX = (bf16_t*)(p.ws + WS_BIG + BG_MIX);
    const float* rld = p.inp(10);
    LAS bf16_t* RA = (LAS bf16_t*)C.lds; LAS bf16_t* RB = RA + 128 * RLD;
    int tid = C.tid; asm volatile("" : "+v"(tid));
    const int lane = tid & 63, w = C.wave, kq = lane >> 4, fr = lane & 15;
    const int u = unit >> 2, h = unit & 3;
    const float lgf = rld[h], lgb = rld[4 + h];
    stage_chunk<false>(QKV, 128 * u, 256 * h, RA, tid, 0.f, 0);
    int ib = 16 * w + 4 * kq, jb = fr; asm volatile("" : "+v"(ib), "+v"(jb));
    f32x4 acc[16];
#pragma unroll
    for (int t = 0; t < 16; ++t) acc[t] = (f32x4){0.f, 0.f, 0.f, 0.f};
#pragma unroll
    for (int dir = 0; dir < 2; ++dir) {
        const bf16_t* Sd = SP + ((size_t)((dir * 4 + h) * 130 + u)) * 65536;
#pragma unroll
        for (int eh = 0; eh < 2; ++eh) {
            __syncthreads();
#pragma unroll
            for (int q = 0; q < 8; ++q) { const int idx = tid + NTHR * q, rr = idx >> 5, c = idx & 31;
                *(LAS u32x4*)(RB + rr * RLD + 8 * c) = *(const u32x4*)(Sd + (size_t)(128 * eh + rr) * 256 + 8 * c);
                if (q == 3) asm volatile("" ::: "memory"); }
            __syncthreads();
#pragma unroll 1
            for (int ks = 0; ks < 8; ++ks) { const bf16x8 af = frag_rowk_l(RA + (16 * w) * RLD + 32 * ks, RLD, lane);
#pragma unroll
                for (int t = 0; t < 8; ++t) { const bf16x8 bf = frag_rowk_l(RB + (16 * t) * RLD + 32 * ks, RLD, lane); acc[8 * eh + t] = MFMA16(af, bf, acc[8 * eh + t]); } }
        }
#pragma unroll
        for (int r = 0; r < 4; ++r) { const int i = ib + r; const float qd = fast_exp((float)(128 - i) * lgb);
            const float f = (dir == 0) ? fast_exp((float)(i + 1) * lgf) / qd : qd;
#pragma unroll
            for (int t = 0; t < 16; ++t) acc[t][r] *= f; }
    }
    __syncthreads();
    stage_chunk<false>(QKV, 128 * u, 1024 + 256 * h, RB, tid, 0.f, 0);
    __syncthreads();
    f32x4 sc[8];
#pragma unroll
    for (int t = 0; t < 8; ++t) sc[t] = (f32x4){0.f, 0.f, 0.f, 0.f};
#pragma unroll 1
    for (int ks = 0; ks < 8; ++ks) { const bf16x8 af = frag_rowk_l(RA + (16 * w) * RLD + 32 * ks, RLD, lane);
#pragma unroll
        for (int t = 0; t < 8; ++t) { const bf16x8 bf = frag_rowk_l(RB + (16 * t) * RLD + 32 * ks, RLD, lane); sc[t] = MFMA16(af, bf, sc[t]); } }
#pragma unroll
    for (int t = 0; t < 8; ++t)
#pragma unroll
        for (int r = 0; r < 4; ++r) { const int i = ib + r, j = 16 * t + jb; const float d = (float)(i - j);
            const float m = (i >= j ? fast_exp(d * lgf) : 0.f) + (j >= i ? fast_exp(-d * lgb) : 0.f); sc[t][r] *= m; }
    __syncthreads();
    stage_chunk<false>(QKV, 128 * u, 2048 + 256 * h, RA, tid, 0.f, 0);
#pragma unroll
    for (int t = 0; t < 8; ++t)
#pragma unroll
        for (int r = 0; r < 4; ++r) RB[(16 * w + 4 * kq + r) * SLD + 16 * t + fr] = f2bf(sc[t][r]);
    __syncthreads();
    const unsigned vbase = (unsigned)(uintptr_t)RA;
#pragma unroll 1
    for (int ks = 0; ks < 4; ++ks) { const bf16x8 af = frag_rowk_l(RB + (16 * w) * SLD + 32 * ks, SLD, lane);
#pragma unroll
        for (int t = 0; t < 16; ++t) { const bf16x8 bf = frag_colk_l(vbase + (unsigned)((32 * ks) * RLD + 16 * t) * 2u, RLD * 2, lane); acc[t] = MFMA16(af, bf, acc[t]); } }
    __syncthreads();
#pragma unroll
    for (int r = 0; r < 4; ++r) {
        float s = 0.f;
#pragma unroll
        for (int t = 0; t < 16; ++t) s += acc[t][r];
        s += __shfl_xor(s, 1); s += __shfl_xor(s, 2); s += __shfl_xor(s, 4); s += __shfl_xor(s, 8);
        const float mean = s * (1.0f / 256.0f); float q = 0.f;
#pragma unroll
        for (int t = 0; t < 16; ++t) { const float d = acc[t][r] - mean; q += d * d; }
        q += __shfl_xor(q, 1); q += __shfl_xor(q, 2); q += __shfl_xor(q, 4); q += __shfl_xor(q, 8);
        const float rstd = rsqrtf(q * (1.0f / 256.0f) + LN_EPS);
#pragma unroll
        for (int t = 0; t < 16; ++t) RA[(16 * w + 4 * kq + r) * RLD + 16 * t + fr] = f2bf((acc[t][r] - mean) * rstd);
    }
    __syncthreads();
#pragma unroll
    for (int q = 0; q < 8; ++q) { const int idx = tid + NTHR * q, rr = idx >> 5, c = idx & 31; const size_t row = (size_t)(128 * u + rr);
        const u32x4 o = *(const LAS u32x4*)(RA + rr * RLD + 8 * c), g = *(const u32x4*)(QKV + row * EV_IN + 3072 + 256 * h + 8 * c);
        u32x4 w4;
        w4.x = cvt_pk_bf16(bflo(o.x) * siluf_(bflo(g.x)), bfhi(o.x) * siluf_(bfhi(g.x))); w4.y = cvt_pk_bf16(bflo(o.y) * siluf_(bflo(g.y)), bfhi(o.y) * siluf_(bfhi(g.y)));
        w4.z = cvt_pk_bf16(bflo(o.z) * siluf_(bflo(g.z)), bfhi(o.z) * siluf_(bfhi(g.z))); w4.w = cvt_pk_bf16(bflo(o.w) * siluf_(bflo(g.w)), bfhi(o.w) * siluf_(bfhi(g.w)));
        *(u32x4*)(MIX + row * DM + 256 * h + 8 * c) = w4; }
    __syncthreads();
}

constexpr int KLD = 1032;
__device__ __forceinline__ void s5_output_task(const Params& p, Ctx& C, int bt) {
    const bf16_t* QKV = (const bf16_t*)(p.ws + WS_BIG + BG_QKV); bf16_t* Z = (bf16_t*)(p.ws + WS_Z);
    const bf16_t* KN = (const bf16_t*)(p.ws + WS_KN); const bf16_t* CCt = (const bf16_t*)(p.ws + WS_CC);
    const float* APOW = (const float*)(p.ws + WS_APOW); const float* HST = (const float*)(p.ws + WS_HST); const float* dsk = p.inp(18);
    int tid = C.tid; asm volatile("" : "+v"(tid));
    const int lane = tid & 63, kq = lane >> 4, fr = lane & 15;
    LAS bf16_t* KF = (LAS bf16_t*)C.lds; LAS bf16_t* KB = KF + 16 * KLD;
    LAS bf16_t* U = KB + 16 * KLD + C.wave * 3072;
    LAS float* PW0 = (LAS float*)(KB + 16 * KLD + 8 * 3072);
    LAS float* PW16 = PW0 + 2 * 16 * 128;
    {
        const int g = bt >> 3, k0 = (260 * (bt & 7)) >> 3, k1 = (260 * ((bt & 7) + 1)) >> 3;
#pragma unroll
        for (int q = 0; q < 8; ++q) { const int idx = tid + NTHR * q, dir = idx >> 11, rr = (idx >> 7) & 15, c = idx & 127;
            *(LAS u32x4*)((dir ? KB : KF) + rr * KLD + 8 * c) = *(const u32x4*)(KN + ((size_t)(dir * 64 + g) * 16 + rr) * 1024 + 8 * c); }
        for (int q = lane; q < 192 * 2; q += 64) *(LAS u32x4*)(U + 8 * q) = (u32x4){0u, 0u, 0u, 0u};
#pragma unroll
        for (int q = 0; q < 2; ++q) { const int idx = tid + NTHR * q, dir = idx >> 9, f = (idx >> 5) & 15, c4 = idx & 31;
            *(LAS f32x4*)(PW0 + dir * 2048 + f * 128 + 4 * c4) = *(const f32x4*)(APOW + ((size_t)(dir * 64 + g) * 64 + (dir == 0 ? f : 15 - f)) * 128 + 4 * c4); }
        if (tid < 64) { const int dir = tid >> 5, c4 = tid & 31; *(LAS f32x4*)(PW16 + dir * 128 + 4 * c4) = *(const f32x4*)(APOW + ((size_t)(dir * 64 + g) * 64 + 15) * 128 + 4 * c4); }
        __syncthreads();
        const f32x4 dv = *(const f32x4*)(dsk + 16 * g + 4 * kq);
        bf16x8 ccr[2], cci[2];
#pragma unroll
        for (int hb = 0; hb < 2; ++hb) { ccr[hb] = frag_rowk_g(CCt + (size_t)g * 16 * 128 + 32 * hb, 128, lane); cci[hb] = frag_rowk_g(CCt + (size_t)g * 16 * 128 + 64 + 32 * hb, 128, lane); }
        const LAS float* pw0l = PW0 + (size_t)fr * 128 + 16 * kq;
        const LAS float* pw16l = PW16 + 16 * kq;
        for (int k = k0 + C.wave; k < k1; k += 8) {
            LDS_WAIT(); asm volatile("" ::: "memory");
            for (int q = lane; q < 128; q += 64) { const int t = q >> 1, hf = q & 1;
                *(LAS u32x4*)(U + (64 + t) * 16 + 8 * hf) = *(const u32x4*)(QKV + (size_t)(64 * k + t) * EV_IN + 4096 + 16 * g + 8 * hf); }
            LDS_WAIT(); asm volatile("" ::: "memory");
            const int cf = k, cb = k < 4 ? 3 - k : 263 - k;
            f32x4 acc[4];
#pragma unroll
            for (int tt = 0; tt < 4; ++tt) acc[tt] = (f32x4){0.f, 0.f, 0.f, 0.f};
            const LAS bf16_t* ubf = U + (64 + fr - (kq >> 1)) * 16 + 8 * (kq & 1);
            const LAS bf16_t* ubb = U + (64 + fr + (kq >> 1)) * 16 + 8 * (kq & 1);
#pragma unroll
            for (int n0 = 0; n0 < 64; n0 += 2) {
                const bf16x8 af = frag_rowk_l(KF + n0 * 16, KLD, lane), ab = frag_rowk_l(KB + n0 * 16, KLD, lane);
#pragma unroll
                for (int tt = 0; tt < 4; ++tt) {
                    if (n0 <= 16 * tt + 14) acc[tt] = MFMA16(af, *(const LAS bf16x8*)(ubf + (16 * tt - n0) * 16), acc[tt]);
                    if (n0 <= 62 - 16 * tt) acc[tt] = MFMA16(ab, *(const LAS bf16x8*)(ubb + (16 * tt + n0) * 16), acc[tt]);
                }
                asm volatile("" ::: "memory");
            }
#pragma unroll
            for (int dir = 0; dir < 2; ++dir) {
                const float* hp = HST + ((size_t)(dir * 64 + g) * 260 + (dir == 0 ? cf : cb)) * 128;
#pragma unroll
                for (int hb = 0; hb < 2; ++hb) {
                    float xr[8], xi[8];
#pragma unroll
                    for (int e2 = 0; e2 < 4; ++e2) { const f32x4 h4 = *(const f32x4*)(hp + 2 * (32 * hb + 8 * kq) + 4 * e2), b4 = *(const LAS f32x4*)(pw0l + dir * 2048 + hb * 64 + 4 * e2);
                        xr[2 * e2] = b4[0] * h4[0] - b4[1] * h4[1]; xi[2 * e2] = b4[0] * h4[1] + b4[1] * h4[0];
                        xr[2 * e2 + 1] = b4[2] * h4[2] - b4[3] * h4[3]; xi[2 * e2 + 1] = b4[2] * h4[3] + b4[3] * h4[2]; }
#pragma unroll
                    for (int st = 0; st < 4; ++st) {
                        const int tt = dir == 0 ? st : 3 - st;
                        u32x4 br, bi;
                        br.x = cvt_pk_bf16(xr[0], xr[1]); br.y = cvt_pk_bf16(xr[2], xr[3]); br.z = cvt_pk_bf16(xr[4], xr[5]); br.w = cvt_pk_bf16(xr[6], xr[7]);
                        bi.x = cvt_pk_bf16(xi[0], xi[1]); bi.y = cvt_pk_bf16(xi[2], xi[3]); bi.z = cvt_pk_bf16(xi[4], xi[5]); bi.w = cvt_pk_bf16(xi[6], xi[7]);
                        acc[tt] = MFMA16(ccr[hb], __builtin_bit_cast(bf16x8, br), acc[tt]);
                        acc[tt] = MFMA16(cci[hb], __builtin_bit_cast(bf16x8, bi), acc[tt]);
                        if (st < 3) {
#pragma unroll
                            for (int e2 = 0; e2 < 4; ++e2) { const f32x4 a4 = *(const LAS f32x4*)(pw16l + dir * 128 + hb * 64 + 4 * e2);
                                float t0 = xr[2 * e2] * a4[0] - xi[2 * e2] * a4[1]; xi[2 * e2] = xr[2 * e2] * a4[1] + xi[2 * e2] * a4[0]; xr[2 * e2] = t0;
                                t0 = xr[2 * e2 + 1] * a4[2] - xi[2 * e2 + 1] * a4[3]; xi[2 * e2 + 1] = xr[2 * e2 + 1] * a4[3] + xi[2 * e2 + 1] * a4[2]; xr[2 * e2 + 1] = t0; }
                        }
                    }
                }
            }
#pragma unroll
            for (int tt = 0; tt < 4; ++tt) { const int t = 16 * tt + fr;
                const u32x2 uu = *(const LAS u32x2*)(U + (64 + t) * 16 + 4 * kq);
                const float y0 = acc[tt][0] + bflo(uu.x) * dv[0], y1 = acc[tt][1] + bfhi(uu.x) * dv[1], y2 = acc[tt][2] + bflo(uu.y) * dv[2], y3 = acc[tt][3] + bfhi(uu.y) * dv[3];
                u32x2 w; w.x = cvt_pk_bf16(gelu_tanh(y0), gelu_tanh(y1)); w.y = cvt_pk_bf16(gelu_tanh(y2), gelu_tanh(y3));
                *(u32x2*)(Z + (size_t)(64 * k + t) * 1024 + 16 * g + 4 * kq) = w; }
        }
    }
    __syncthreads();
}

__device__ __forceinline__ void phase_ret_s5_outputs(const Params& p, Ctx& C, LAS unsigned char* misc) {
    unsigned* head = (unsigned*)(p.ws + WS_CTL) + CW_QUEUE;
    volatile LAS int* slot = (volatile LAS int*)(misc + 32);
    for (;;) {
        __syncthreads();
        if (C.tid == 0) slot[0] = (int)atomicAdd(head, 1u);
        __syncthreads();
        const int item = __builtin_amdgcn_readfirstlane(slot[0]);
        if (item >= 520) break;
        ret_output_unit(p, C, item);
    }
    for (;;) {
        __syncthreads();
        if (C.tid == 0) slot[0] = (int)atomicAdd(head + 64, 1u);
        __syncthreads();
        const int item = __builtin_amdgcn_readfirstlane(slot[0]);
        if (item >= 512) break;
        s5_output_task(p, C, item);
    }
}
__device__ __forceinline__ void phase_router(const Params& p, Ctx& C, int L) {
    const float* X1 = (const float*)(p.ws + WS_X1);
    const bf16_t* RWh = (const bf16_t*)(p.ws + WS_RWT) + (size_t)(L * 2 + 0) * 64 * DM; const bf16_t* RWl = (const bf16_t*)(p.ws + WS_RWT) + (size_t)(L * 2 + 1) * 64 * DM;
    const float* rbias = p.inp(27) + L * 64;
    int* cnt = (int*)(p.ws + WS_CTL) + CW_CNT + L * 128; int* LIST = (int*)(p.ws + WS_LIST); unsigned* PK = (unsigned*)(p.ws + WS_WGT); float* LW = (float*)(p.ws + WS_LW);
    const int lane = C.lane, kq = lane >> 4, fr = lane & 15;
    LAS float* Lg = (LAS float*)(C.lds + C.wave * 8192);
    const int r0 = (L == 0) ? 0 : CTXL, nrows = TT - r0;
    if (C.bid == 0 && C.tid == 0) cnt[64] = nrows;
    for (int task = C.gw; task < nrows / 16; task += C.ngw) {
        const int rbase = r0 + 16 * task, row = rbase + fr;
        const int v = row < CTXL ? 1 : 0;
        const float* xr = X1 + (size_t)row * DM; const float* sc2 = modv(p, L, v, 4); const float* sh2 = modv(p, L, v, 3);
        f32x4 acc[4];
#pragma unroll
        for (int t = 0; t < 4; ++t) acc[t] = (f32x4){0.f, 0.f, 0.f, 0.f};
#pragma unroll 2
        for (int ks = 0; ks < 64; ++ks) { const int c0 = 32 * ks + 8 * kq;
            const f32x4 x0 = *(const f32x4*)(xr + c0), x1 = *(const f32x4*)(xr + c0 + 4);
            const f32x4 a0 = *(const f32x4*)(sc2 + c0), a1 = *(const f32x4*)(sc2 + c0 + 4), b0 = *(const f32x4*)(sh2 + c0), b1 = *(const f32x4*)(sh2 + c0 + 4);
            const f32x4 y0 = x0 * (a0 + 1.0f) + b0, y1 = x1 * (a1 + 1.0f) + b1;
            u32x4 hi; hi.x = cvt_pk_bf16(y0[0], y0[1]); hi.y = cvt_pk_bf16(y0[2], y0[3]); hi.z = cvt_pk_bf16(y1[0], y1[1]); hi.w = cvt_pk_bf16(y1[2], y1[3]);
            u32x4 lo; lo.x = cvt_pk_bf16(y0[0] - bflo(hi.x), y0[1] - bfhi(hi.x)); lo.y = cvt_pk_bf16(y0[2] - bflo(hi.y), y0[3] - bfhi(hi.y));
            lo.z = cvt_pk_bf16(y1[0] - bflo(hi.z), y1[1] - bfhi(hi.z)); lo.w = cvt_pk_bf16(y1[2] - bflo(hi.w), y1[3] - bfhi(hi.w));
            const bf16x8 ah = __builtin_bit_cast(bf16x8, hi), al = __builtin_bit_cast(bf16x8, lo);
#pragma unroll
            for (int t = 0; t < 4; ++t) { const bf16x8 bh = frag_rowk_g(RWh + (size_t)(16 * t) * DM + 32 * ks, DM, lane), bl = frag_rowk_g(RWl + (size_t)(16 * t) * DM + 32 * ks, DM, lane);
                acc[t] = MFMA16(ah, bh, acc[t]); acc[t] = MFMA16(al, bh, acc[t]); acc[t] = MFMA16(ah, bl, acc[t]); } }
        LDS_WAIT(); asm volatile("" ::: "memory");
#pragma unroll
        for (int t = 0; t < 4; ++t)
#pragma unroll
            for (int r = 0; r < 4; ++r) Lg[(4 * kq + r) * 65 + 16 * t + fr] = acc[t][r];
        LDS_WAIT(); asm volatile("" ::: "memory");
        if (lane < 16) {
            LAS float* sr = Lg + lane * 65; const int trow = rbase + lane;
            float gs[8];
#pragma unroll
            for (int g = 0; g < 8; ++g) { float m1 = -1e30f, m2 = -1e30f;
                for (int j = 0; j < 8; ++j) { const int e = 8 * g + j; const float s = sigmoidf_(sr[e]); sr[e] = s; const float vv = s + rbias[e];
                    if (vv > m1) { m2 = m1; m1 = vv; } else if (vv > m2) m2 = vv; }
                gs[g] = m1 + m2; }
            unsigned gmask = 0u;
#pragma unroll
            for (int it = 0; it < 4; ++it) { float best = -1e30f; int bi = 0;
#pragma unroll
                for (int g = 0; g < 8; ++g) { const bool ok = !((gmask >> g) & 1u) && gs[g] > best; best = ok ? gs[g] : best; bi = ok ? g : bi; }
                gmask |= 1u << bi; }
            unsigned long long taken = 0ull; int sel[8]; float sw[8]; float wsum = 0.f;
#pragma unroll
            for (int k = 0; k < 8; ++k) { float best = -1e30f; int bi = 0;
                for (int e = 0; e < 64; ++e) { const bool cand = ((gmask >> (e >> 3)) & 1u) && !((taken >> e) & 1ull); const float vv = sr[e] + rbias[e];
                    if (cand && vv > best) { best = vv; bi = e; } }
                taken |= 1ull << bi; sel[k] = bi; sw[k] = sr[bi]; wsum += sw[k]; }
            const float inv = 2.5f / wsum;
#pragma unroll
            for (int k = 0; k < 8; ++k) { const int a = trow * 8 + k; const int pos = atomicAdd(&cnt[sel[k]], 1);
                LIST[(size_t)sel[k] * TT + pos] = a; PK[a] = ((unsigned)sel[k] << 16) | (unsigned)pos; LW[(size_t)sel[k] * TT + pos] = sw[k] * inv; }
            LIST[(size_t)64 * TT + (trow - r0)] = 8 * TT + trow; LW[(size_t)64 * TT + (trow - r0)] = 1.0f;
        }
    }
}
namespace att {
constexpr int D = 128, NW = 8, QBLK = 32, KVBLK = 64;
constexpr float SCALE = 0.088388347648318440f;
constexpr float THR = 8.f;
constexpr int SHM_V = KVBLK * D * 2, SHM_K = KVBLK * D * 2, SHM_ATTN = 2 * SHM_V + 2 * SHM_K + NW * 64 * 4;
#define KSWZ(row, colB) ((row) * 256 + ((colB) ^ (((row) & 7) << 4)))
#define SBAR() __builtin_amdgcn_sched_barrier(0)
__device__ __forceinline__ int crow(int r, int hi) { return (r & 3) + 8 * (r >> 2) + 4 * hi; }
__device__ __forceinline__ unsigned cvtpk(float lo, float hi) { unsigned r; asm volatile("v_cvt_pk_bf16_f32 %0, %1, %2" : "=v"(r) : "v"(lo), "v"(hi)); return r; }

__device__ __forceinline__ void partialSM(f32x16& p0, f32x16& p1, float& m_reg, float& mn, float& alpha) {
  constexpr float Cc = SCALE * 1.4426950408889634f;
  float pmax = p0[0]; for (int r = 1; r < 16; ++r) pmax = fmaxf(pmax, p0[r]); for (int r = 0; r < 16; ++r) pmax = fmaxf(pmax, p1[r]);
  { auto rr = __builtin_amdgcn_permlane32_swap(__float_as_uint(pmax), __float_as_uint(pmax), false, false);
    pmax = fmaxf(__uint_as_float(rr[0]), __uint_as_float(rr[1])); }
  if (__builtin_expect(__all(pmax - m_reg <= THR / SCALE), 1)) { mn = m_reg; alpha = 1.f; }
  else { mn = fmaxf(m_reg, pmax); alpha = __builtin_amdgcn_exp2f((m_reg - mn) * Cc); m_reg = mn; }
  float mnC = -mn * Cc;
  for (int r = 0; r < 16; ++r) p0[r] = fmaf(p0[r], Cc, mnC); for (int r = 0; r < 16; ++r) p1[r] = fmaf(p1[r], Cc, mnC);
  for (int r = 0; r < 16; ++r) p0[r] = __builtin_amdgcn_exp2f(p0[r]);
}
__device__ __forceinline__ void finishSM(f32x16& p0, f32x16& p1, float alpha, float& l_reg, bf16x8& pa0, bf16x8& pa1, bf16x8& pa2, bf16x8& pa3) {
  for (int r = 0; r < 16; ++r) p1[r] = __builtin_amdgcn_exp2f(p1[r]);
  float ps = 0; for (int r = 0; r < 16; ++r) ps += p0[r]; for (int r = 0; r < 16; ++r) ps += p1[r];
  { auto rr = __builtin_amdgcn_permlane32_swap(__float_as_uint(ps), __float_as_uint(ps), false, false);
    ps = __uint_as_float(rr[0]) + __uint_as_float(rr[1]); }
  l_reg = l_reg * alpha + ps;
#define PK4(P, BASE, OUT) do { unsigned a0 = cvtpk(P[BASE + 0], P[BASE + 1]), a1 = cvtpk(P[BASE + 2], P[BASE + 3]);   \
    unsigned b0 = cvtpk(P[BASE + 4], P[BASE + 5]), b1 = cvtpk(P[BASE + 6], P[BASE + 7]);                              \
    auto r0 = __builtin_amdgcn_permlane32_swap(a0, b0, false, false); auto r1 = __builtin_amdgcn_permlane32_swap(a1, b1, false, false); \
    u32x4 w = {r0[0], r1[0], r0[1], r1[1]}; OUT = *reinterpret_cast<bf16x8*>(&w); } while (0)
  PK4(p0, 0, pa0); PK4(p0, 8, pa1); PK4(p1, 0, pa2); PK4(p1, 8, pa3);
#undef PK4
}
__device__ __forceinline__ void qkt(f32x16& p0, f32x16& p1, const LAS char* Ks, const bf16x8* qr, int r32, int hi) {
  p0 = f32x16{}; p1 = f32x16{};
  for (int d0 = 0; d0 < 8; ++d0) { int cb = (d0 * 16 + hi * 8) * 2;
    bf16x8 b0 = *reinterpret_cast<const LAS bf16x8*>(Ks + KSWZ(r32, cb));
    bf16x8 b1 = *reinterpret_cast<const LAS bf16x8*>(Ks + KSWZ(32 + r32, cb));
    p0 = __builtin_amdgcn_mfma_f32_32x32x16_bf16(b0, qr[d0], p0, 0, 0, 0);
    p1 = __builtin_amdgcn_mfma_f32_32x32x16_bf16(b1, qr[d0], p1, 0, 0, 0); }
}
__device__ __forceinline__ int v_st(int k, int c) { const int kk = (k & ~0xC) | ((k & 4) << 1) | ((k & 8) >> 1); return ((kk >> 3) * 4 + (c >> 5)) * 512 + ((kk & 7) * 32 + (c & 31)) * 2; }
__device__ __forceinline__ int v_rd_base(int lane) { return ((lane & 3) << 3) | (((lane >> 2) & 3) << 6) | (((lane >> 4) & 1) << 5) | (((lane >> 5) & 1) << 8); }
constexpr int v_rd_off(int d0, int ks, int half) { return d0 * 512 + ks * 4096 + half * 2048; }
template <int OFF> __device__ __forceinline__ s16x4 tr_read(int vb) {
  s16x4 r; asm volatile("ds_read_b64_tr_b16 %0, %1 offset:%2" : "=&v"(r) : "v"(vb), "i"(OFF) : "memory"); return r;
}
template <int D0> __device__ __forceinline__ void pv_one(f32x16& od, int vb, bf16x8 pa0, bf16x8 pa1, bf16x8 pa2, bf16x8 pa3) {
  const s16x4 l0 = tr_read<v_rd_off(D0, 0, 0)>(vb), h0 = tr_read<v_rd_off(D0, 0, 1)>(vb), l1 = tr_read<v_rd_off(D0, 1, 0)>(vb), h1 = tr_read<v_rd_off(D0, 1, 1)>(vb);
  const s16x4 l2 = tr_read<v_rd_off(D0, 2, 0)>(vb), h2 = tr_read<v_rd_off(D0, 2, 1)>(vb), l3 = tr_read<v_rd_off(D0, 3, 0)>(vb), h3 = tr_read<v_rd_off(D0, 3, 1)>(vb);
  asm volatile("s_waitcnt lgkmcnt(0)" ::: "memory"); SBAR();
#define PK(L, H) (bf16x8){L[0], L[1], L[2], L[3], H[0], H[1], H[2], H[3]}
  od = __builtin_amdgcn_mfma_f32_32x32x16_bf16(pa0, PK(l0, h0), od, 0, 0, 0);
  od = __builtin_amdgcn_mfma_f32_32x32x16_bf16(pa1, PK(l1, h1), od, 0, 0, 0);
  od = __builtin_amdgcn_mfma_f32_32x32x16_bf16(pa2, PK(l2, h2), od, 0, 0, 0);
  od = __builtin_amdgcn_mfma_f32_32x32x16_bf16(pa3, PK(l3, h3), od, 0, 0, 0);
#undef PK
}
__device__ __forceinline__ void pv_d0(f32x16* o, int vb, bf16x8 pa0, bf16x8 pa1, bf16x8 pa2, bf16x8 pa3) {
  pv_one<0>(o[0], vb, pa0, pa1, pa2, pa3); pv_one<1>(o[1], vb, pa0, pa1, pa2, pa3); pv_one<2>(o[2], vb, pa0, pa1, pa2, pa3); pv_one<3>(o[3], vb, pa0, pa1, pa2, pa3);
}

template <int LDQ, int LDK, int LDO>
__device__ __forceinline__ void attn_dense_body(const bf16_t* __restrict__ Qb, const bf16_t* __restrict__ Kh, const bf16_t* __restrict__ Vh, bf16_t* __restrict__ Ob, int seq, LAS char* lds, int tid) {
  const int wid = tid >> 6, lane = tid & 63, r32 = lane & 31, hi = lane >> 5;
  LAS char* V_lds = lds; LAS char* K_lds = lds + 2 * SHM_V;
  LAS float* ws = (LAS float*)(lds + 2 * SHM_V + 2 * SHM_K) + wid * 64; LAS float* li_l = ws; LAS float* al_l = ws + 32;
  float m_reg = -1e30f, l_reg = 0; f32x16 o[4] = {}; bf16x8 qr[8];
  const bf16_t* Qw = Qb + (long)(wid * QBLK + r32) * LDQ + hi * 8;
#pragma unroll
  for (int d0 = 0; d0 < 8; ++d0) qr[d0] = *reinterpret_cast<const bf16x8*>(Qw + d0 * 16);
  const int sr = tid >> 4, sc = (tid & 15) * 8, vst0 = v_st(sr, sc), vst1 = v_st(32 + sr, sc);
  const int vb0 = (int)(uintptr_t)V_lds + v_rd_base(lane);
  struct { bf16x8 vs0, vs1, ks0, ks1; } sr_[2];
#define SLOAD(i, k0) do { sr_[i].vs0 = *reinterpret_cast<const bf16x8*>(&Vh[(long)((k0) + sr) * LDK + sc]); sr_[i].vs1 = *reinterpret_cast<const bf16x8*>(&Vh[(long)((k0) + 32 + sr) * LDK + sc]); \
    sr_[i].ks0 = *reinterpret_cast<const bf16x8*>(&Kh[(long)((k0) + sr) * LDK + sc]); sr_[i].ks1 = *reinterpret_cast<const bf16x8*>(&Kh[(long)((k0) + 32 + sr) * LDK + sc]); } while (0)
#define SWRITE(b, i) do { *(LAS bf16x8*)(V_lds + (b) * SHM_V + vst0) = sr_[i].vs0;          \
    *(LAS bf16x8*)(V_lds + (b) * SHM_V + vst1) = sr_[i].vs1; int kc = sc * 2;               \
    *(LAS bf16x8*)(K_lds + (b) * SHM_K + KSWZ(sr, kc)) = sr_[i].ks0;                       \
    *(LAS bf16x8*)(K_lds + (b) * SHM_K + KSWZ(32 + sr, kc)) = sr_[i].ks1; } while (0)
#define SWAIT() asm volatile("s_waitcnt vmcnt(4)" ::: "memory")
#define RESC(a) do { if (__any((a) < 1.f)) { if (hi == 0) al_l[r32] = (a); asm volatile("s_waitcnt lgkmcnt(0)" ::: "memory"); \
    for (int d = 0; d < 4; ++d) for (int r = 0; r < 16; ++r) o[d][r] *= al_l[crow(r, hi)]; } } while (0)
  f32x16 pA0, pA1, pB0, pB1; float mnA, mnB, alA, alB; bf16x8 pa0, pa1, pa2, pa3; const int NT = seq / KVBLK;
  constexpr int SE = 0, SO = 1;
  SLOAD(SE, 0); asm volatile("s_waitcnt vmcnt(0)" ::: "memory"); SWRITE(0, SE); __syncthreads();
  qkt(pA0, pA1, K_lds, qr, r32, hi); partialSM(pA0, pA1, m_reg, mnA, alA);
  SLOAD(SO, KVBLK); if (2 < NT) SLOAD(SE, 2 * KVBLK);
  SWAIT(); SWRITE(1, SO); __syncthreads();
  for (int j = 1; j + 1 < NT; j += 2) {
    SBAR(); qkt(pB0, pB1, K_lds + SHM_K, qr, r32, hi);
    finishSM(pA0, pA1, alA, l_reg, pa0, pa1, pa2, pa3); SBAR();
    SLOAD(SO, (j + 2) * KVBLK); SBAR();
    pv_d0(o, vb0, pa0, pa1, pa2, pa3); partialSM(pB0, pB1, m_reg, mnB, alB);
    __syncthreads(); SWAIT(); SWRITE(0, SE);
    RESC(alB); __syncthreads();
    SBAR(); qkt(pA0, pA1, K_lds, qr, r32, hi);
    finishSM(pB0, pB1, alB, l_reg, pa0, pa1, pa2, pa3); SBAR();
    if (j + 3 < NT) SLOAD(SE, (j + 3) * KVBLK); SBAR();
    pv_d0(o, vb0 + (int)SHM_V, pa0, pa1, pa2, pa3); partialSM(pA0, pA1, m_reg, mnA, alA);
    __syncthreads(); SWAIT(); SWRITE(1, SO);
    RESC(alA); __syncthreads();
  }
  SBAR(); qkt(pB0, pB1, K_lds + SHM_K, qr, r32, hi);
  finishSM(pA0, pA1, alA, l_reg, pa0, pa1, pa2, pa3); SBAR();
  pv_d0(o, vb0, pa0, pa1, pa2, pa3); partialSM(pB0, pB1, m_reg, mnB, alB);
  __syncthreads(); RESC(alB);
  finishSM(pB0, pB1, alB, l_reg, pa0, pa1, pa2, pa3); SBAR();
  pv_d0(o, vb0 + (int)SHM_V, pa0, pa1, pa2, pa3);
  if (hi == 0) li_l[r32] = l_reg; asm volatile("s_waitcnt lgkmcnt(0)" ::: "memory");
  float rli[16];
#pragma unroll
  for (int r = 0; r < 16; ++r) rli[r] = __builtin_amdgcn_rcpf(li_l[crow(r, hi)]);
  bf16_t* Ow = Ob + (long)(wid * QBLK) * LDO;
#pragma unroll
  for (int r = 0; r < 16; ++r) { int orow = crow(r, hi);
    for (int d0 = 0; d0 < 4; ++d0) Ow[(long)orow * LDO + d0 * 32 + r32] = (bf16_t)(cvtpk(o[d0][r] * rli[r], 0.f) & 0xffffu); }
#undef SLOAD
#undef SWRITE
#undef SWAIT
#undef RESC
}
#undef KSWZ
}

__device__ __forceinline__ void phase_attention(const Params& p, Ctx& C) {
    const bf16_t* QKV = (const bf16_t*)(p.ws + WS_BIG + BG_QKV); bf16_t* ATT = (bf16_t*)(p.ws + WS_BIG + BG_ATT);
    const int nunits = 24 * 64;
    for (int i = 0;; ++i) {
        int unit;
        if (C.G == 256) { const int xcd = C.bid & 7, slot = C.bid >> 3; if (i >= 6) break; unit = (xcd * 3 + (i >> 1)) * 64 + (i & 1) * 32 + slot; }
        else { unit = i * C.G + C.bid; if (unit >= nunits) break; }
        const int prob = unit >> 6, qb = unit & 63;
        int qc, kc, vc, oc;
        if (prob < 8) { qc = 128 * prob; kc = 1024 + 128 * (prob >> 2); vc = 1280 + 128 * (prob >> 2); oc = 128 * prob; }
        else { const int d = prob - 8, h = d >> 2, m = (d >> 1) & 1, vh = d & 1; qc = 1536 + 256 * h + 128 * m; kc = 2560 + 256 * h + 128 * m; vc = 3584 + 256 * h + 128 * vh; oc = 1024 + 1024 * m + 256 * h + 128 * vh; }
        __syncthreads();
        att::attn_dense_body<OD_IN, OD_IN, 3072>(QKV + (size_t)(CTXL + 256 * qb) * OD_IN + qc, QKV + kc, QKV + vc, ATT + (size_t)(256 * qb) * 3072 + oc, TT, (LAS char*)C.lds, C.tid);
    }
    __syncthreads();
}
constexpr int PH_PER_LAYER = 13, N_PHASES = 2 + 2 * PH_PER_LAYER;
#ifndef DBL_PHASE
#define DBL_PHASE -1
#endif
#ifndef MK_PER_PHASE
#define MK_PER_PHASE 0
#endif

template <int L>
__device__ __forceinline__ void layer_body(const Params& p, Ctx& C0, const XcdBarrier& bar, LAS unsigned char* misc, int lo, int hi) {
#define IN(k) (lo <= (k) && (k) < hi)
#define SEAM(k) do { if (IN(k) && IN((k) + 1)) xcd_barrier(bar, C0.wave); } while (0)
#define PHASE(k, ...) if (IN(k)) { FRESH(); __VA_ARGS__ } if (DBL_PHASE == (k)) { xcd_barrier(bar, C0.wave); { FRESH(); __VA_ARGS__ } } SEAM(k);
#define FRESH() Ctx C = C0; { int ln = (int)__builtin_amdgcn_mbcnt_hi(~0u, __builtin_amdgcn_mbcnt_lo(~0u, 0u)); asm volatile("" : "+v"(ln)); C.lane = ln; C.tid = C.wave * 64 + ln; }
        const int b = 2 + PH_PER_LAYER * L;
        bf16_t* QKV = (bf16_t*)(p.ws + WS_BIG + BG_QKV);
        bf16_t* XA = (bf16_t*)(p.ws + WS_XA);
        int* cnt = (int*)(p.ws + WS_CTL) + CW_CNT + L * 128; const int* LIST = (const int*)(p.ws + WS_LIST);
        PHASE(b + 0, phase_modulate(p, C, L); )
        PHASE(b + 1,
            const int N = L ? OD_IN : EV_IN;
            pg8::DenseOrder S; S.init8((const void*)XA, DM, (const void*)(p.ws + (L ? WS_WIN1 : WS_WIN0)), TT, N, DM, C.G, C.bid);
            pg8::EpiStore E{QKV, N, 1.0f / 32.0f};
            pg8::gemm_phase<true>(C.lds, S, E, C.wave);
        )
        PHASE(b + 2, if (L == 0) phase_rope0(p, C); else phase_normrope1(p, C); )
        PHASE(b + 3, if (L == 0) { ret_chunk_kv(p, C); s5_end_states(p, C); } else phase_attention(p, C); )
        PHASE(b + 4, if (L == 0) phase_scans(p, C); else phase_merge1(p, C); )
        if (L == 0) {
            PHASE(b + 5, phase_ret_s5_outputs(p, C, misc); )
            PHASE(b + 6,
                pg8::DenseOrder S; S.init((const bf16_t*)(p.ws + WS_Z), 1024, (const bf16_t*)(p.ws + WS_WGLU), TT, 1024, 1024, C.G, C.bid);
                pg8::EpiGlu E{(const bf16_t*)(p.ws + WS_Z), p.inp(20), (bf16_t*)(p.ws + WS_BIG + BG_MIX)};
                pg8::gemm_phase<false>(C.lds, S, E, C.wave);
            )
        }
        PHASE(b + 7,
            pg8::DenseOrder S;
            if (L == 0) S.init((const bf16_t*)(p.ws + WS_BIG + BG_MIX), DM, (const bf16_t*)(p.ws + WS_WOUT0), TT, DM, DM, C.G, C.bid);
            else S.init((const bf16_t*)(p.ws + WS_BIG + BG_ATT), 3072, (const bf16_t*)(p.ws + WS_WOUT1), SEQ, DM, DM, C.G, C.bid);
            pg8::EpiStore E{(bf16_t*)(p.ws + WS_YMIX) + (L ? (size_t)CTXL * DM : 0), DM, 1.0f};
            pg8::gemm_phase<false>(C.lds, S, E, C.wave);
        )
        PHASE(b + 8, phase_ln1(p, C, L); )
        PHASE(b + 9, phase_router(p, C, L); )
        PHASE(b + 10,
            pg8::MoeOrder<0> S; S.A = (const void*)XA; S.Bt = (const void*)(p.ws + WS_GU); S.list = LIST; S.cnt = cnt; S.ldab = DM; S.kb = DM; S.nN = 4; S.G = C.G; S.c = C.bid; S.bstride = (size_t)1024 * DM;
            S.prep(misc, C.tid);
            pg8::EpiE1 E{(unsigned char*)(p.ws + WS_HX2), S.cn, S.rb};
            pg8::gemm_phase<true>(C.lds, S, E, C.wave);
        )
        PHASE(b + 11,
            pg8::MoeOrder<1> S; S.A = (const void*)(p.ws + WS_HX2); S.Bt = (const void*)(p.ws + WS_DT); S.list = LIST; S.cnt = cnt; S.ldab = EHID; S.kb = EHID; S.nN = 8; S.G = C.G; S.c = C.bid; S.bstride = (size_t)DM * EHID;
            S.prep(misc, C.tid);
            pg8::EpiE2 E{(unsigned char*)(p.ws + WS_BIG + BG_YMOE), (const float*)(p.ws + WS_LW), S.cn, S.rb};
            pg8::gemm_phase<true>(C.lds, S, E, C.wave);
        )
        PHASE(b + 12, phase_combine(p, C, L, misc); )
    #undef IN
#undef SEAM
#undef FRESH
#undef PHASE
}

__global__ void __launch_bounds__(NTHR, 2) mega_fwd(KArgs ka) {
    extern __shared__ __attribute__((aligned(16))) unsigned char lds_raw[];
    Ctx C;
    C.lds = (LAS unsigned char*)lds_raw;
    C.tid = threadIdx.x; C.lane = C.tid & 63; C.wave = __builtin_amdgcn_readfirstlane(C.tid >> 6);
    C.G = gridDim.x; C.bid = blockIdx.x; C.gw = C.bid * NWAVES + C.wave; C.ngw = C.G * NWAVES;
    LAS unsigned char* misc = C.lds + MISC_OFF;
    if (C.tid < 8) ((volatile LAS unsigned*)misc)[C.tid] = 0u;
    Params p; p.out = ka.out; p.ws = ka.ws; p.ph_lo = ka.ph_lo; p.ph_hi = ka.ph_hi; p.ptab = (LAS unsigned long long*)(misc + 1024);
    if (C.tid < 34) p.ptab[C.tid] = (unsigned long long)ka.in[C.tid];
    __syncthreads();
    const int lo = p.ph_lo, hi = p.ph_hi;
    XcdBarrier bar; bar.bar = (unsigned*)(p.ws + WS_CTL) + CW_BAR; bar.x = 0; bar.st = (volatile LAS unsigned*)misc;
    if (hi - lo > 1) bar = xcd_barrier_post((unsigned*)(p.ws + WS_CTL) + CW_BAR, (volatile LAS unsigned*)misc);
#define IN(k) (lo <= (k) && (k) < hi)
#define SEAM(k) do { if (IN(k) && IN((k) + 1)) xcd_barrier(bar, C.wave); } while (0)

    if (IN(0)) { phase_p0(p, C); } SEAM(0);
    if (IN(1)) { phase_p1(p, C); } SEAM(1);
    if (IN(0) && IN(2) && (C.G & 7) == 0) {
        volatile LAS unsigned* st = (volatile LAS unsigned*)misc;
        if (C.tid == 0) { unsigned pre = 0u; const unsigned x = st[3];
            for (unsigned j = 0; j < 16; ++j) { const unsigned cj = xb_ld(&bar.bar[XB_XCNT(j)]); pre += (j < x) ? cj : 0u; }
            st[4] = pre + st[2]; }
        __syncthreads();
        const int vcu = (int)st[4], g8 = C.G >> 3;
        C.bid = __builtin_amdgcn_readfirstlane((vcu % g8) * 8 + vcu / g8); C.gw = C.bid * NWAVES + C.wave;
    }

    layer_body<0>(p, C, bar, misc, lo, hi);
    layer_body<1>(p, C, bar, misc, lo, hi);
#undef IN
#undef SEAM
}

extern "C" void kernel_launch(void* const* d_in, const int* in_sizes, int n_in, void* d_out, int out_size, void* d_ws, size_t ws_size, hipStream_t stream) {
    static int grid = 0;
    if (grid == 0) {
        if (n_in != 34 || out_size != SEQ * DM || ws_size < WS_END) { fprintf(stderr, "kernel_launch: unexpected shapes: n_in %d out %d ws %zu (need %zu)\n", n_in, out_size, ws_size, (size_t)WS_END); grid = -1; return; }
        int dev = 0, cus = 0, per_cu = 0;
        if (hipGetDevice(&dev) != hipSuccess || hipDeviceGetAttribute(&cus, hipDeviceAttributeMultiprocessorCount, dev) != hipSuccess) { grid = -1; return; }
        if (hipFuncSetAttribute((const void*)mega_fwd, hipFuncAttributeMaxDynamicSharedMemorySize, LDS_BYTES) != hipSuccess) { fprintf(stderr, "kernel_launch: hipFuncSetAttribute failed\n"); grid = -1; return; }
        if (hipOccupancyMaxActiveBlocksPerMultiprocessor(&per_cu, (const void*)mega_fwd, NTHR, LDS_BYTES) != hipSuccess || per_cu < 1) { fprintf(stderr, "kernel_launch: occupancy query says %d blocks per CU\n", per_cu); grid = -1; return; }
        (void)hipGetLastError();
        grid = cus;
    }
    if (grid < 0) return;
    (void)hipMemsetAsync((char*)d_ws + WS_CTL, 0, CTL_BYTES, stream);
    KArgs p{};
    for (int i = 0; i < 34; ++i) p.in[i] = (const float*)d_in[i];
    p.out = (float*)d_out; p.ws = (unsigned char*)d_ws;
#if MK_PER_PHASE
    for (int ph = 0; ph < N_PHASES; ++ph) {
        if (ph == 2 + PH_PER_LAYER + 5 || ph == 2 + PH_PER_LAYER + 6) continue;
        p.ph_lo = ph; p.ph_hi = ph + 1;
        hipLaunchKernelGGL(mega_fwd, dim3(grid), dim3(NTHR), LDS_BYTES, stream, p);
    }
#else
    p.ph_lo = 0; p.ph_hi = N_PHASES;
    hipLaunchKernelGGL(mega_fwd, dim3(grid), dim3(NTHR), LDS_BYTES, stream, p);
#endif
    const hipError_t le = hipPeekAtLastError();
    if (le != hipSuccess) fprintf(stderr, "kernel_launch: launch failed: %s\n", hipGetErrorName(le));
}
```

```cpp
#define MK_PER_PHASE 0
#include <hip/hip_runtime.h>
#include <cstdio>
#include <cstdint>

#define GAS __attribute__((address_space(1)))
#define LAS __attribute__((address_space(3)))
typedef unsigned short bf16_t;
typedef short bf16x8 __attribute__((ext_vector_type(8)));
typedef short s16x4 __attribute__((ext_vector_type(4)));
typedef float f32x4 __attribute__((ext_vector_type(4)));
typedef float f32x2 __attribute__((ext_vector_type(2)));
typedef float f32x16 __attribute__((ext_vector_type(16)));
typedef unsigned u32x4 __attribute__((ext_vector_type(4)));
typedef unsigned u32x2 __attribute__((ext_vector_type(2)));

constexpr int DM = 2048, SEQ = 16384, CTXL = 256, TT = SEQ + CTXL;
constexpr int NEXP = 64, NEX1 = 65, EHID = 512, TOPK = 8;
constexpr int EV_IN = 5120, OD_IN = 4608;
constexpr float LN_EPS = 1e-6f;
constexpr float ALPHA = 1.4142135623730951f;
constexpr float LAMBDA_INIT = 0.35550906759f;
constexpr int NTHR = 512, NWAVES = 8;

constexpr size_t al256(size_t x) { return (x + 255) / 256 * 256; }
constexpr size_t WS_CTL   = 0;
constexpr size_t CTL_BYTES = 1u << 20;
constexpr size_t WS_MODP  = WS_CTL + CTL_BYTES;
constexpr size_t WS_MODF  = WS_MODP + al256((size_t)2 * 32 * 2 * 12288 * 4);
constexpr size_t WS_ROPE128 = WS_MODF + al256((size_t)2 * 2 * 12288 * 4);
constexpr size_t WS_ROPE64  = WS_ROPE128 + al256((size_t)256 * 64 * 2 * 4);
constexpr size_t WS_KN    = WS_ROPE64 + al256((size_t)256 * 32 * 2 * 4);
constexpr size_t WS_WT    = WS_KN + al256((size_t)2 * 64 * 16 * 1024 * 2);
constexpr size_t WS_APOW  = WS_WT + al256((size_t)2 * 64 * 128 * 1024 * 2);
constexpr size_t WS_AL    = WS_APOW + al256((size_t)2 * 64 * 64 * 128 * 4);
constexpr size_t WS_CC    = WS_AL + al256((size_t)2 * 64 * 128 * 4);
constexpr size_t WS_S5E   = WS_CC + al256((size_t)64 * 16 * 128 * 2);
constexpr size_t WS_HST   = WS_S5E + al256((size_t)2 * 64 * 260 * 128 * 4);
constexpr size_t WS_WIN0  = WS_HST + al256((size_t)2 * 64 * 260 * 128 * 4);
constexpr size_t WS_WOUT0 = WS_WIN0 + al256((size_t)EV_IN * DM * 2);
constexpr size_t WS_WGLU  = WS_WOUT0 + al256((size_t)DM * DM * 2);
constexpr size_t WS_WIN1  = WS_WGLU + al256((size_t)1024 * 1024 * 2);
constexpr size_t WS_WOUT1 = WS_WIN1 + al256((size_t)OD_IN * DM * 2);
constexpr size_t WS_RWT   = WS_WOUT1 + al256((size_t)DM * DM * 2);
constexpr size_t WS_GU    = WS_RWT + al256((size_t)2 * 2 * 64 * DM * 2);
constexpr size_t WS_DT    = WS_GU + al256((size_t)NEX1 * 1024 * DM * 2);
constexpr size_t WS_XA    = WS_DT + al256((size_t)NEX1 * DM * EHID * 2);
constexpr size_t WS_Z     = WS_XA + al256((size_t)TT * DM * 2);
constexpr size_t WS_YMIX  = WS_Z + al256((size_t)TT * 1024 * 2);
constexpr size_t WS_X1    = WS_YMIX + al256((size_t)TT * DM * 2);
constexpr size_t WS_HX2   = WS_X1 + al256((size_t)TT * DM * 4);
constexpr size_t WS_LIST  = WS_HX2 + al256((size_t)9 * TT * EHID * 2);
constexpr size_t WS_WGT   = WS_LIST + al256((size_t)NEX1 * TT * 4);
constexpr size_t WS_LW    = WS_WGT + al256((size_t)8 * TT * 4);
constexpr size_t WS_BIG   = WS_LW + al256((size_t)NEX1 * TT * 4);
constexpr size_t BG_QKV   = 0;
constexpr size_t BG_CKV   = BG_QKV + al256((size_t)TT * EV_IN * 2);
constexpr size_t BG_SPREV = BG_CKV + al256((size_t)8 * 130 * 65536 * 4);
constexpr size_t BG_MIX   = BG_SPREV + al256((size_t)8 * 130 * 65536 * 2);
constexpr size_t BG_END0  = BG_MIX + al256((size_t)TT * DM * 2);
constexpr size_t BG_ATT   = BG_CKV;
constexpr size_t BG_YMOE  = 0;
constexpr size_t BG_END1  = al256((size_t)9 * TT * DM * 2);
constexpr size_t BG_SIZE  = BG_END0 > BG_END1 ? BG_END0 : BG_END1;
constexpr size_t WS_END   = WS_BIG + BG_SIZE;

constexpr int CW_BAR = 4096;
constexpr int CW_CNT = 16384;
constexpr int CW_QUEUE = 20480;
constexpr int CW_KMAX = 24576;

constexpr int RING_BYTES = 139264;
constexpr int MISC_OFF = RING_BYTES;
constexpr int LDS_BYTES = 147456;

typedef __bf16 bf16x2_t __attribute__((ext_vector_type(2)));
__device__ __forceinline__ unsigned cvt_pk_bf16(float lo, float hi) { const f32x2 v = {lo, hi}; return __builtin_bit_cast(unsigned, __builtin_convertvector(v, bf16x2_t)); }
__device__ __forceinline__ bf16_t f2bf(float f) { unsigned u = __builtin_bit_cast(unsigned, f); return (bf16_t)((u + 0x7fffu + ((u >> 16) & 1u)) >> 16); }
__device__ __forceinline__ float bf2f(bf16_t b) { return __builtin_bit_cast(float, ((unsigned)b) << 16); }
__device__ __forceinline__ float bflo(unsigned w) { return __builtin_bit_cast(float, w << 16); }
__device__ __forceinline__ float bfhi(unsigned w) { return __builtin_bit_cast(float, w & 0xffff0000u); }
__device__ __forceinline__ float wave_sum(float v) {
#pragma unroll
    for (int o = 1; o < 64; o <<= 1) v += __shfl_xor(v, o);
    return v;
}
__device__ __forceinline__ float fast_exp(float x) { return __builtin_amdgcn_exp2f(x * 1.4426950408889634f); }
__device__ __forceinline__ float sigmoidf_(float x) { return 1.0f / (1.0f + __expf(-x)); }
__device__ __forceinline__ float siluf_(float x) { return x / (1.0f + __expf(-x)); }
__device__ __forceinline__ float gelu_tanh(float x) {
    const float u = 0.7978845608028654f * (x + 0.044715f * x * x * x);
    const float e = __expf(2.0f * u);
    const float t = 1.0f - 2.0f / (e + 1.0f);
    return 0.5f * x * (1.0f + t);
}
#define LDS_WAIT() asm volatile("s_waitcnt lgkmcnt(0)" ::: "memory")
#define VM_WAIT() asm volatile("s_waitcnt vmcnt(0)" ::: "memory")

#define XB_TMO      128
#define XB_XCNT(j)  (256  + 64 * (j))
#define XB_XSUB(j)  (1280 + 64 * (j))
#define XB_XGEN(j)  (2304 + 64 * (j))
#define XB_TOP      3328
#define XB_TOPGEN   3392
#define XCD_BAR_WORDS 3456
#define XB_SPIN_CAP (1u << 22)

__device__ __forceinline__ unsigned xb_ld(unsigned* p)              { return __hip_atomic_load(p, __ATOMIC_RELAXED, __HIP_MEMORY_SCOPE_AGENT); }
__device__ __forceinline__ unsigned xb_add(unsigned* p, unsigned v) { return __hip_atomic_fetch_add(p, v, __ATOMIC_RELAXED, __HIP_MEMORY_SCOPE_AGENT); }
__device__ __forceinline__ unsigned xb_xcc_id() { return (unsigned)__builtin_amdgcn_s_getreg((3 << 11) | 20) & 0xFu; }
#define XB_SPIN(cond, bar) do { unsigned _sp = 0; while (cond) { __builtin_amdgcn_s_sleep(1); \
    if ((++_sp & 255u) == 0u) { if (xb_ld(&(bar)[XB_TMO])) break; if (_sp > XB_SPIN_CAP) { atomicAdd(&(bar)[XB_TMO], 1u); break; } } } } while (0)

struct XcdBarrier { unsigned* bar; unsigned x; volatile LAS unsigned* st; };

__device__ __forceinline__ XcdBarrier xcd_barrier_post(unsigned* bar, volatile LAS unsigned* st) {
    XcdBarrier b; b.bar = bar; b.x = xb_xcc_id(); b.st = st;
    if (threadIdx.x == 0) { st[2] = xb_add(&bar[XB_XCNT(b.x)], 1u); st[3] = b.x; }
    return b;
}
__device__ __forceinline__ void xcd_barrier_complete(unsigned* bar, unsigned x, unsigned& nloc, unsigned& nx) {
    const unsigned G = gridDim.x * gridDim.y * gridDim.z;
    unsigned sum, cnt, mine, sp = 0u;
    for (;;) {
        sum = 0u; cnt = 0u; mine = 0u;
#pragma unroll
        for (unsigned j = 0; j < 16; ++j) { const unsigned c = xb_ld(&bar[XB_XCNT(j)]); sum += c; cnt += (c > 0u) ? 1u : 0u; mine = (j == x) ? c : mine; }
        if (sum == G) break;
        __builtin_amdgcn_s_sleep(1);
        if ((++sp & 255u) == 0u) { if (xb_ld(&bar[XB_TMO])) break; if (sp > XB_SPIN_CAP) { atomicAdd(&bar[XB_TMO], 1u); break; } }
    }
    nloc = mine > 0u ? mine : 1u; nx = cnt > 0u ? cnt : 1u;
}
__device__ __forceinline__ void xcd_barrier(const XcdBarrier& b, int wave_id) {
    const bool leader_thread = (wave_id == 0) && (__builtin_amdgcn_mbcnt_hi(~0u, __builtin_amdgcn_mbcnt_lo(~0u, 0u)) == 0u);
    asm volatile("s_waitcnt vmcnt(0)" ::: "memory");
    __syncthreads();
    if (leader_thread) {
        unsigned* bar = b.bar;
        __builtin_amdgcn_s_waitcnt(0);
        unsigned nloc = b.st[0], nx = b.st[1];
        if (nloc == 0u) { xcd_barrier_complete(bar, b.x, nloc, nx); b.st[0] = nloc; b.st[1] = nx; }
        const unsigned old = xb_add(&bar[XB_XSUB(b.x)], 1u);
        const unsigned gen = old / nloc;
        if (old + 1u == (gen + 1u) * nloc) {
            __builtin_amdgcn_fence(__ATOMIC_RELEASE, "agent");
            asm volatile("s_waitcnt vmcnt(0)" ::: "memory");
            const unsigned og = xb_add(&bar[XB_TOP], 1u);
            const unsigned tg = og / nx;
            if (og + 1u == (tg + 1u) * nx) xb_add(&bar[XB_TOPGEN], 1u);
            else XB_SPIN(xb_ld(&bar[XB_TOPGEN]) == tg, bar);
            __builtin_amdgcn_fence(__ATOMIC_ACQUIRE, "agent");
            xb_add(&bar[XB_XGEN(b.x)], 1u);
            asm volatile("s_waitcnt vmcnt(0)" ::: "memory");
        } else {
            XB_SPIN(xb_ld(&bar[XB_XGEN(b.x)]) == gen, bar);
            __builtin_amdgcn_fence(__ATOMIC_ACQUIRE, "agent");
            asm volatile("s_waitcnt vmcnt(0)" ::: "memory");
        }
    }
    __syncthreads();
}

__device__ __forceinline__ bf16x8 frag_rowk_l(const LAS bf16_t* p, int ld, int lane) {
    return *(const LAS bf16x8*)(p + (lane & 15) * ld + (lane >> 4) * 8);
}
__device__ __forceinline__ bf16x8 frag_rowk_g(const bf16_t* p, long ld, int lane) {
    return *(const bf16x8*)(p + (long)(lane & 15) * ld + (lane >> 4) * 8);
}
__device__ __forceinline__ bf16x8 frag_colk_l(unsigned p, int ldb, int lane) {
    const unsigned a0 = p + (unsigned)((8 * (lane >> 4) + ((lane & 15) >> 2)) * ldb + (lane & 3) * 8);
    const unsigned a1 = a0 + 4u * (unsigned)ldb;
    s16x4 lo, hi;
    asm volatile("ds_read_b64_tr_b16 %0, %2\n\tds_read_b64_tr_b16 %1, %3\n\ts_waitcnt lgkmcnt(0)" : "=&v"(lo), "=&v"(hi) : "v"(a0), "v"(a1) : "memory");
    return (bf16x8){lo[0], lo[1], lo[2], lo[3], hi[0], hi[1], hi[2], hi[3]};
}
#define MFMA16(a, b, c) __builtin_amdgcn_mfma_f32_16x16x32_bf16((a), (b), (c), 0, 0, 0)
namespace pg8 {
constexpr int BM = 256, BK = 64, HALF = 128, HTB = HALF * BK * 2, STAGE_BYTES = 8 * HTB, NXCD = 8, WGM = 8;
__device__ __forceinline__ int lds_byte(int r, int c) { const int st = (r >> 4) * 2 + (c >> 5), rr = r & 15, cc = c & 31, ob = rr * 64 + cc * 2; return st * 1024 + (ob ^ (((ob >> 9) & 1) << 5)); }
__device__ __forceinline__ void stage_rc(int b, int& R, int& C) { const int st = b / 1024, sb = b % 1024, swz = sb ^ (((sb >> 9) & 1) << 5); R = (st >> 1) * 16 + swz / 64; C = (st & 1) * 32 + (swz % 64) / 2; }
__device__ __forceinline__ int perm32(int rho) { const int n = rho >> 4, i = rho & 15; return 8 * (i >> 2) + 4 * n + (i & 3); }

struct Unit { int pm, pn, e; };
constexpr float WSCALE = 32.0f, WSCALE_INV = 1.0f / 32.0f;

struct DenseOrder {
    const bf16_t* A; const bf16_t* Bt; int ldab, kb, nM, nN, nwg, G, c;
    __device__ __forceinline__ void init(const bf16_t* A_, int lda_, const bf16_t* Bt_, int M, int N, int K_, int G_, int c_) { A = A_; ldab = lda_ * 2; Bt = Bt_; kb = K_ * 2; nM = M / BM; nN = N / BM; nwg = nM * nN; G = G_; c = c_; }
    __device__ __forceinline__ void init8(const void* A_, int ldab_, const void* Bt_, int M, int N, int K_, int G_, int c_) { A = (const bf16_t*)A_; ldab = ldab_; Bt = (const bf16_t*)Bt_; kb = K_; nM = M / BM; nN = N / BM; nwg = nM * nN; G = G_; c = c_; }
    __device__ __forceinline__ void prep(LAS unsigned char*) const {}
    __device__ __forceinline__ bool next(int i, Unit& u) const {
        const long L = (long)i * G + c; if (L >= nwg) return false;
        int wgid = (int)L; { const int q = nwg / NXCD, r = nwg % NXCD, xcd = wgid % NXCD, off = wgid / NXCD; wgid = (xcd < r ? xcd * (q + 1) : r * (q + 1) + (xcd - r) * q) + off; }
        const int nig = WGM * nN, gid = wgid / nig, fm = gid * WGM, gsz = (nM - fm) < WGM ? (nM - fm) : WGM;
        u.pm = fm + ((wgid % nig) % gsz); u.pn = (wgid % nig) / gsz; u.e = 0; return true;
    }
    __device__ __forceinline__ const char* a_base() const { return (const char*)A; }
    __device__ __forceinline__ unsigned a_off(const Unit& u, int r) const { return (unsigned)(u.pm * BM + r) * (unsigned)ldab; }
    __device__ __forceinline__ const char* b_ptr(const Unit& u) const { return (const char*)Bt + (size_t)u.pn * BM * kb; }
};

template <int MODE  >
struct MoeOrder {
    const void* A; const void* Bt; const int* list; const int* cnt; int ldab, kb, nN, G, c; size_t bstride;
    LAS int* tp; LAS int* cn; LAS int* rb;
    __device__ __forceinline__ void prep(LAS unsigned char* misc, int tid) {
        tp = (LAS int*)(misc + 64); cn = tp + 72; rb = cn + 72;
        if (tid < NEX1) cn[tid] = cnt[tid];
        __syncthreads();
        if (tid == 0) { int s = 0, q = 0; for (int e = 0; e < NEX1; ++e) { tp[e] = s; rb[e] = q; s += (cn[e] + BM - 1) / BM; q += cn[e]; } tp[NEX1] = s; rb[NEX1] = q; }
        __syncthreads();
    }
    __device__ __forceinline__ bool next(int i, Unit& u) const {
        const int total = tp[NEX1]; const long nu = (long)total * nN; const int per = (int)((nu + G - 1) / G);
        const int vc = ((G & 7) == 0) ? (c & 7) * (G >> 3) + (c >> 3) : c;
        const long L = (long)vc * per + i;
        if (i >= per || L >= nu) return false;
        const int tile = (int)(L / nN); u.pn = (int)(L % nN);
        int e = 0;
        for (int k = 1; k < NEX1; ++k) e += (tp[k] <= tile) ? 1 : 0;
        u.e = e; u.pm = tile - tp[e]; return true;
    }
    __device__ __forceinline__ const char* a_base() const { return (const char*)A; }
    __device__ __forceinline__ unsigned a_off(const Unit& u, int r) const {
        int pos = u.pm * BM + r; const int n = cn[u.e]; pos = pos < n ? pos : n - 1;
        if (MODE == 1) return (unsigned)(rb[u.e] + pos) * (unsigned)ldab;
        const int a = list[u.e * TT + pos];
        const int row = a < 8 * TT ? (a >> 3) : a - 8 * TT;
        return (unsigned)row * (unsigned)ldab;
    }
    __device__ __forceinline__ const char* b_ptr(const Unit& u) const { return (const char*)Bt + (size_t)u.e * bstride + (size_t)u.pn * BM * kb; }
};

typedef int v8i32 __attribute__((ext_vector_type(8)));
typedef int v4i32_ __attribute__((ext_vector_type(4)));
__device__ __forceinline__ v8i32 cat8(bf16x8 a, bf16x8 b) { const u32x4 x = __builtin_bit_cast(u32x4, a), y = __builtin_bit_cast(u32x4, b); return (v8i32){(int)x.x, (int)x.y, (int)x.z, (int)x.w, (int)y.x, (int)y.y, (int)y.z, (int)y.w}; }
template <bool FP8, class Epi, class Sched>
__device__ __forceinline__ void gemm_phase(LAS unsigned char* lds, const Sched& S, const Epi& E, int wave_id) {
    const int wid = wave_id; int lane = (int)__builtin_amdgcn_mbcnt_hi(~0u, __builtin_amdgcn_mbcnt_lo(~0u, 0u)); asm volatile("" : "+v"(lane));
    const int tid = wid * 64 + lane, wr = wid >> 2, wc = wid & 3, fr = lane & 15, fq = lane >> 4;
    const int kb = S.kb; int nt = kb / 128; asm volatile("" : "+s"(nt));
    unsigned voffB[2];
#pragma unroll
    for (int i = 0; i < 2; ++i) { int R, C; stage_rc(tid * 16 + i * 8192, R, C); const int Rb = (R & ~31) + perm32(R & 31);
        voffB[i] = (unsigned)(Rb * kb) + (unsigned)C * 2u; }
#define PG8_AOFF(u, h, i) ({ int _tz = tid; asm volatile("" : "+v"(_tz)); int _R, _C; stage_rc(_tz * 16 + (i) * 8192, _R, _C); S.a_off((u), (h) * HALF + _R) + (unsigned)_C * 2u; })
    const size_t kstep = (size_t)(BK * 2);
    const size_t hstepB = (size_t)HALF * kb;
    const unsigned ldsw = (unsigned)wid * 1024u;
    const int aoff = lds_byte(wr * 64 + fr, fq * 8), boff = lds_byte(wc * 32 + fr, fq * 8);
#define PG8_SA(b, h) (((b) * 2 + (h)) * HTB)
#define PG8_SB(b, h) ((4 + (b) * 2 + (h)) * HTB)
#define PG8_STAGE(bufoff, gbase, v0, v1) do { \
        __builtin_amdgcn_global_load_lds((const unsigned*)((const char*)(gbase) + (v0)), (LAS unsigned*)(lds + (bufoff) + ldsw), 16, 0, 0); \
        __builtin_amdgcn_global_load_lds((const unsigned*)((const char*)(gbase) + (v1)), (LAS unsigned*)(lds + (bufoff) + ldsw + 8192), 16, 0, 0); } while (0)
#define PG8_VOFFB(i) ({ int _tz = tid; asm volatile("" : "+v"(_tz)); int _R, _C; stage_rc(_tz * 16 + (i) * 8192, _R, _C); (unsigned)(((_R & ~31) + perm32(_R & 31)) * kb) + (unsigned)_C * 2u; })
#define PG8_STAGE_B(bufoff, gbase) do { if constexpr (FP8) { const unsigned _v0 = PG8_VOFFB(0), _v1 = PG8_VOFFB(1); PG8_STAGE(bufoff, gbase, _v0, _v1); } else PG8_STAGE(bufoff, gbase, voffB[0], voffB[1]); } while (0)
#define PG8_LD8(off) __builtin_shufflevector(*(const LAS v4i32_*)(lds + (off)), *(const LAS v4i32_*)(lds + (off) + 1024), 0, 1, 2, 3, 4, 5, 6, 7)
#define PG8_LDA(dst, b, h) do { _Pragma("unroll") for (int m = 0; m < 4; ++m) { if constexpr (FP8) dst##8[m] = PG8_LD8(PG8_SA(b, h) + aoff + m * 2048); else { _Pragma("unroll") for (int k = 0; k < 2; ++k) dst[m][k] = *(const LAS bf16x8*)(lds + PG8_SA(b, h) + aoff + m * 2048 + k * 1024); } } } while (0)
#define PG8_LDB(dst, b, h) do { _Pragma("unroll") for (int n = 0; n < 2; ++n) { if constexpr (FP8) dst##8[n] = PG8_LD8(PG8_SB(b, h) + boff + n * 2048); else { _Pragma("unroll") for (int k = 0; k < 2; ++k) dst[n][k] = *(const LAS bf16x8*)(lds + PG8_SB(b, h) + boff + n * 2048 + k * 1024); } } } while (0)
#define PG8_MMA(ai, bj, At, Bt) do { __builtin_amdgcn_s_setprio(1); _Pragma("unroll") for (int m = 0; m < 4; ++m) _Pragma("unroll") for (int n = 0; n < 2; ++n) { \
        if constexpr (FP8) asm volatile("v_mfma_f32_16x16x128_f8f6f4 %0, %1, %2, %0" : "+v"(acc[ai][bj][m][n]) : "v"(Bt##8[n]), "v"(At##8[m])); \
        else { _Pragma("unroll") for (int k = 0; k < 2; ++k) acc[ai][bj][m][n] = __builtin_amdgcn_mfma_f32_16x16x32_bf16(Bt[n][k], At[m][k], acc[ai][bj][m][n], 0, 0, 0); } } \
        __builtin_amdgcn_s_setprio(0); } while (0)
#define PG8_WAIT_V(n) asm volatile("s_waitcnt vmcnt(" #n ")" ::: "memory")
#define PG8_WAIT_L(n) asm volatile("s_waitcnt lgkmcnt(" #n ")" ::: "memory")
#define PG8_BAR __builtin_amdgcn_s_barrier()
#define PG8_SCHED __builtin_amdgcn_sched_barrier(0)
    Unit cur, nxt; int ui = 0;
    if (!S.next(0, cur)) return;
    f32x4 acc[2][2][4][2];
#pragma unroll
    for (int a = 0; a < 2; ++a)
#pragma unroll
        for (int b = 0; b < 2; ++b)
#pragma unroll
            for (int m = 0; m < 4; ++m)
#pragma unroll
                for (int n = 0; n < 2; ++n) acc[a][b][m][n] = (f32x4){0.f, 0.f, 0.f, 0.f};
    bf16x8 At[4][2], B0[2][2], B1[2][2]; v8i32 At8[4], B08[2], B18[2];
    const char* const gA = S.a_base();
    const char* cB = S.b_ptr(cur);
    unsigned oc00, oc01, oc10, oc11;
    oc00 = PG8_AOFF(cur, 0, 0); oc01 = PG8_AOFF(cur, 0, 1); oc10 = PG8_AOFF(cur, 1, 0); oc11 = PG8_AOFF(cur, 1, 1);
    PG8_STAGE_B(PG8_SB(0, 0), cB); PG8_STAGE_B(PG8_SB(0, 1), cB + hstepB); PG8_STAGE(PG8_SA(0, 0), gA, oc00, oc01); PG8_STAGE(PG8_SA(0, 1), gA, oc10, oc11);
    if (wr == 1) PG8_BAR;
    PG8_WAIT_V(2); PG8_BAR;
    PG8_STAGE_B(PG8_SB(1, 0), cB + kstep); PG8_STAGE(PG8_SA(1, 0), gA + kstep, oc00, oc01); PG8_STAGE_B(PG8_SB(1, 1), cB + hstepB + kstep);
    PG8_WAIT_V(6); PG8_BAR;
    for (;;) {
        const bool has_next = S.next(ui + 1, nxt);
        const char* nB = cB;
        {
            u32x4 on = {oc00, oc01, oc10, oc11};
            if (has_next) { on.x = PG8_AOFF(nxt, 0, 0); on.y = PG8_AOFF(nxt, 0, 1); on.z = PG8_AOFF(nxt, 1, 0); on.w = PG8_AOFF(nxt, 1, 1); nB = S.b_ptr(nxt); }
            *(LAS u32x4*)(lds + STAGE_BYTES + tid * 16) = on;
        }
        for (int t = 0; t < nt; t += 2) {
            const bool last = (t == nt - 2);
            const char* a1 = gA + (size_t)(t + 1) * kstep;
            const char* a2 = last ? gA : gA + (size_t)(t + 2) * kstep; const char* b2 = last ? nB : cB + (size_t)(t + 2) * kstep;
            const char* a3 = a2 + kstep; const char* b3 = b2 + kstep;
            unsigned s00 = oc00, s01 = oc01, s10 = oc10, s11 = oc11;
            if (last) { const u32x4 on = *(const LAS u32x4*)(lds + STAGE_BYTES + tid * 16); s00 = on.x; s01 = on.y; s10 = on.z; s11 = on.w; }
            PG8_LDB(B0, 0, 0); PG8_LDB(B1, 0, 1); PG8_SCHED; PG8_LDA(At, 0, 0); PG8_STAGE(PG8_SA(1, 1), a1, oc10, oc11);
            PG8_WAIT_V(8); PG8_WAIT_L(0); PG8_BAR; PG8_MMA(0, 0, At, B0); PG8_MMA(0, 1, At, B1); PG8_BAR; PG8_SCHED;
            PG8_LDA(At, 0, 1); PG8_STAGE_B(PG8_SB(0, 0), b2); PG8_STAGE_B(PG8_SB(0, 1), b2 + hstepB); PG8_STAGE(PG8_SA(0, 0), a2, s00, s01);
            PG8_WAIT_V(8); PG8_WAIT_L(0); PG8_BAR; PG8_MMA(1, 0, At, B0); PG8_MMA(1, 1, At, B1); PG8_BAR; PG8_SCHED;
            PG8_LDB(B0, 1, 0); PG8_LDB(B1, 1, 1); PG8_SCHED; PG8_LDA(At, 1, 0); PG8_STAGE(PG8_SA(0, 1), a2, s10, s11);
            PG8_WAIT_V(8); PG8_WAIT_L(0); PG8_BAR; PG8_MMA(0, 0, At, B0); PG8_MMA(0, 1, At, B1); PG8_BAR; PG8_SCHED;
            PG8_LDA(At, 1, 1); PG8_STAGE_B(PG8_SB(1, 0), b3); PG8_STAGE_B(PG8_SB(1, 1), b3 + hstepB); PG8_STAGE(PG8_SA(1, 0), a3, s00, s01);
            PG8_WAIT_V(8); PG8_WAIT_L(0); PG8_BAR; PG8_MMA(1, 0, At, B0); PG8_MMA(1, 1, At, B1); PG8_BAR; PG8_SCHED;
        }
        if (wr == 0) PG8_BAR;
        E(acc, cur, wr, wc, fr, fq);
        if (!has_next) break;
#pragma unroll
        for (int a = 0; a < 2; ++a)
#pragma unroll
            for (int b = 0; b < 2; ++b)
#pragma unroll
                for (int m = 0; m < 4; ++m)
#pragma unroll
                    for (int n = 0; n < 2; ++n) acc[a][b][m][n] = (f32x4){0.f, 0.f, 0.f, 0.f};
        { const u32x4 on = *(const LAS u32x4*)(lds + STAGE_BYTES + tid * 16); oc00 = on.x; oc01 = on.y; oc10 = on.z; oc11 = on.w; }
        cur = nxt; cB = nB; ++ui;
        if (wr == 1) PG8_BAR;
    }
    PG8_WAIT_V(0);
    PG8_BAR;
#undef PG8_SA
#undef PG8_SB
#undef PG8_STAGE
#undef PG8_STAGE_B
#undef PG8_AOFF
#undef PG8_VOFFB
#undef PG8_LD8
#undef PG8_LDA
#undef PG8_LDB
#undef PG8_MMA
#undef PG8_WAIT_V
#undef PG8_WAIT_L
#undef PG8_BAR
#undef PG8_SCHED
}

struct EpiStore {
    bf16_t* O; int ldc; float scale;
    __device__ __forceinline__ void operator()(const f32x4 (&acc)[2][2][4][2], const Unit& u, int wr, int wc, int fr, int fq) const {
        const int row0 = u.pm * BM + wr * 64 + fr, col0 = u.pn * BM + wc * 32 + 8 * fq;
#pragma unroll
        for (int ai = 0; ai < 2; ++ai)
#pragma unroll
            for (int m = 0; m < 4; ++m) { bf16_t* rowp = O + (size_t)(row0 + ai * HALF + m * 16) * ldc + col0;
#pragma unroll
                for (int bj = 0; bj < 2; ++bj) { const f32x4 v0 = acc[ai][bj][m][0] * scale, v1 = acc[ai][bj][m][1] * scale;
                    u32x4 w; w.x = cvt_pk_bf16(v0[0], v0[1]); w.y = cvt_pk_bf16(v0[2], v0[3]); w.z = cvt_pk_bf16(v1[0], v1[1]); w.w = cvt_pk_bf16(v1[2], v1[3]);
                    *(u32x4*)(rowp + bj * HALF) = w; } }
    }
};
struct EpiGlu {
    const bf16_t* Z; const float* b; bf16_t* MIX;
    __device__ __forceinline__ void operator()(const f32x4 (&acc)[2][2][4][2], const Unit& u, int wr, int wc, int fr, int fq) const {
        const int row0 = u.pm * BM + wr * 64 + fr, col0 = u.pn * BM + wc * 32 + 8 * fq;
#pragma unroll
        for (int bj = 0; bj < 2; ++bj) {
            const f32x4 b0 = *(const f32x4*)(b + col0 + bj * HALF), b1 = *(const f32x4*)(b + col0 + bj * HALF + 4);
#pragma unroll
            for (int ai = 0; ai < 2; ++ai)
#pragma unroll
                for (int m = 0; m < 4; ++m) { const size_t row = (size_t)(row0 + ai * HALF + m * 16);
                    const u32x4 zz = *(const u32x4*)(Z + row * 1024 + col0 + bj * HALF);
                    const f32x4 v0 = acc[ai][bj][m][0] + b0, v1 = acc[ai][bj][m][1] + b1;
                    u32x4 w;
                    w.x = cvt_pk_bf16(bflo(zz.x) * sigmoidf_(v0[0]), bfhi(zz.x) * sigmoidf_(v0[1]));
                    w.y = cvt_pk_bf16(bflo(zz.y) * sigmoidf_(v0[2]), bfhi(zz.y) * sigmoidf_(v0[3]));
                    w.z = cvt_pk_bf16(bflo(zz.z) * sigmoidf_(v1[0]), bfhi(zz.z) * sigmoidf_(v1[1]));
                    w.w = cvt_pk_bf16(bflo(zz.w) * sigmoidf_(v1[2]), bfhi(zz.w) * sigmoidf_(v1[3]));
                    *(u32x4*)(MIX + row * DM + 1024 + col0 + bj * HALF) = w; }
        }
    }
};
struct EpiE1 {
    unsigned char* H; const LAS int* cn; const LAS int* rb;
    __device__ __forceinline__ void operator()(const f32x4 (&acc)[2][2][4][2], const Unit& u, int wr, int wc, int fr, int fq) const {
        const int n = cn[u.e]; const int colh = u.pn * 128 + wc * 32 + 8 * fq;
#pragma unroll
        for (int ai = 0; ai < 2; ++ai)
#pragma unroll
            for (int m = 0; m < 4; ++m) { const int pos = u.pm * BM + ai * HALF + wr * 64 + m * 16 + fr;
                if (pos < n) { const int a = rb[u.e] + pos;
                    float sc = WSCALE_INV; asm volatile("" : "+v"(sc));
                    const f32x4 g0 = acc[ai][0][m][0] * sc, g1 = acc[ai][0][m][1] * sc, u0 = acc[ai][1][m][0] * sc, u1 = acc[ai][1][m][1] * sc;
                    u32x2 w;
                    w.x = (unsigned)__builtin_amdgcn_cvt_pk_fp8_f32(siluf_(g0[0]) * u0[0], siluf_(g0[1]) * u0[1], 0, false);
                    w.x = (unsigned)__builtin_amdgcn_cvt_pk_fp8_f32(siluf_(g0[2]) * u0[2], siluf_(g0[3]) * u0[3], (int)w.x, true);
                    w.y = (unsigned)__builtin_amdgcn_cvt_pk_fp8_f32(siluf_(g1[0]) * u1[0], siluf_(g1[1]) * u1[1], 0, false);
                    w.y = (unsigned)__builtin_amdgcn_cvt_pk_fp8_f32(siluf_(g1[2]) * u1[2], siluf_(g1[3]) * u1[3], (int)w.y, true);
                    *(u32x2*)(H + (size_t)a * EHID + colh) = w; }
                __builtin_amdgcn_sched_barrier(0); }
    }
};
struct EpiE2 {
    unsigned char* Y; const float* wgt; const LAS int* cn; const LAS int* rb;
    __device__ __forceinline__ void operator()(const f32x4 (&acc)[2][2][4][2], const Unit& u, int wr, int wc, int fr, int fq) const {
        const int n = cn[u.e]; const int col0 = u.pn * BM + wc * 32 + 8 * fq;
#pragma unroll
        for (int ai = 0; ai < 2; ++ai)
#pragma unroll
            for (int m = 0; m < 4; ++m) { const int pos = u.pm * BM + ai * HALF + wr * 64 + m * 16 + fr;
                if (pos < n) { const int a = rb[u.e] + pos; float ws = wgt[u.e * TT + pos] * WSCALE_INV; asm volatile("" : "+v"(ws));
                    unsigned char* rowp = Y + (size_t)a * DM + col0;
#pragma unroll
                    for (int bj = 0; bj < 2; ++bj) { const f32x4 v0 = acc[ai][bj][m][0] * ws, v1 = acc[ai][bj][m][1] * ws;
                        u32x2 w;
                        w.x = (unsigned)__builtin_amdgcn_cvt_pk_fp8_f32(v0[0], v0[1], 0, false); w.x = (unsigned)__builtin_amdgcn_cvt_pk_fp8_f32(v0[2], v0[3], (int)w.x, true);
                        w.y = (unsigned)__builtin_amdgcn_cvt_pk_fp8_f32(v1[0], v1[1], 0, false); w.y = (unsigned)__builtin_amdgcn_cvt_pk_fp8_f32(v1[2], v1[3], (int)w.y, true);
                        *(u32x2*)(rowp + bj * HALF) = w; } }
                __builtin_amdgcn_sched_barrier(0); }
    }
};
}
struct KArgs {
    const float* in[34];
    float* out;
    unsigned char* ws;
    int ph_lo, ph_hi;
};
struct Params {
    float* out;
    unsigned char* ws;
    LAS unsigned long long* ptab;
    int ph_lo, ph_hi;
    __device__ __forceinline__ const float* inp(int k) const {
        const unsigned long long v = ptab[k];
        const unsigned lo = __builtin_amdgcn_readfirstlane((unsigned)v), hi = __builtin_amdgcn_readfirstlane((unsigned)(v >> 32));
        return (const float*)(((unsigned long long)hi << 32) | lo);
    }
};
struct Ctx {
    LAS unsigned char* lds;
    int tid, lane, wave, G, bid;
    int gw, ngw;
};

__device__ __forceinline__ void tr_item(const float* W, int N, bf16_t* WT, int ldt, int k0, int n0, int orow0, LAS float* scr, int lane) {
#pragma unroll 8
    for (int i = 0; i < 32; ++i) { const int kk = 2 * i + (lane >> 5); scr[kk * 33 + (lane & 31)] = W[(size_t)(k0 + kk) * N + n0 + (lane & 31)]; }
    LDS_WAIT(); asm volatile("" ::: "memory");
    const int c = lane & 7;
#pragma unroll
    for (int j = 0; j < 4; ++j) { const int n = (lane >> 3) + 8 * j; const LAS float* s = scr + (8 * c) * 33 + n;
        u32x4 o; o.x = cvt_pk_bf16(s[0 * 33], s[1 * 33]); o.y = cvt_pk_bf16(s[2 * 33], s[3 * 33]); o.z = cvt_pk_bf16(s[4 * 33], s[5 * 33]); o.w = cvt_pk_bf16(s[6 * 33], s[7 * 33]);
        *(u32x4*)(WT + (size_t)(orow0 + n) * ldt + k0 + 8 * c) = o; }
    LDS_WAIT(); asm volatile("" ::: "memory");
}
__device__ __forceinline__ void tr_item64(const float* W, int N, bf16_t* WT, int ldt, int k0, int n0, int orow0, LAS float* scr, int lane) {
    f32x4 v[16];
    const float* src = W + (size_t)(k0 + (lane >> 4)) * N + n0 + 4 * (lane & 15);
#pragma unroll
    for (int i = 0; i < 16; ++i) v[i] = __builtin_nontemporal_load((const f32x4*)(src + (size_t)(4 * i) * N));
#pragma unroll
    for (int i = 0; i < 16; ++i) { LAS float* d = scr + (4 * i + (lane >> 4)) * 65 + 4 * (lane & 15); d[0] = v[i][0]; d[1] = v[i][1]; d[2] = v[i][2]; d[3] = v[i][3]; }
    LDS_WAIT(); asm volatile("" ::: "memory");
    const int c = lane & 7;
#pragma unroll
    for (int j = 0; j < 8; ++j) { const int n = (lane >> 3) + 8 * j; const LAS float* s = scr + (8 * c) * 65 + n;
        u32x4 o; o.x = cvt_pk_bf16(s[0 * 65], s[1 * 65]); o.y = cvt_pk_bf16(s[2 * 65], s[3 * 65]); o.z = cvt_pk_bf16(s[4 * 65], s[5 * 65]); o.w = cvt_pk_bf16(s[6 * 65], s[7 * 65]);
        *(u32x4*)(WT + (size_t)(orow0 + n) * ldt + k0 + 8 * c) = o; }
    LDS_WAIT(); asm volatile("" ::: "memory");
}
__device__ __forceinline__ void tr_item64_fp8(const float* W, int N, unsigned char* WT, int ldt, int k0, int n0, int orow0, LAS float* scr, int lane, float wscale = pg8::WSCALE) {
    f32x4 v[16];
    const float* src = W + (size_t)(k0 + (lane >> 4)) * N + n0 + 4 * (lane & 15);
#pragma unroll
    for (int i = 0; i < 16; ++i) v[i] = __builtin_nontemporal_load((const f32x4*)(src + (size_t)(4 * i) * N));
#pragma unroll
    for (int i = 0; i < 16; ++i) { LAS float* d = scr + (4 * i + (lane >> 4)) * 65 + 4 * (lane & 15); d[0] = v[i][0]; d[1] = v[i][1]; d[2] = v[i][2]; d[3] = v[i][3]; }
    LDS_WAIT(); asm volatile("" ::: "memory");
    const int c = lane & 7;
#pragma unroll
    for (int j = 0; j < 8; ++j) { const int n = (lane >> 3) + 8 * j; const LAS float* s = scr + (8 * c) * 65 + n;
        u32x2 o;
        o.x = (unsigned)__builtin_amdgcn_cvt_pk_fp8_f32(s[0 * 65] * wscale, s[1 * 65] * wscale, 0, false);
        o.x = (unsigned)__builtin_amdgcn_cvt_pk_fp8_f32(s[2 * 65] * wscale, s[3 * 65] * wscale, (int)o.x, true);
        o.y = (unsigned)__builtin_amdgcn_cvt_pk_fp8_f32(s[4 * 65] * wscale, s[5 * 65] * wscale, 0, false);
        o.y = (unsigned)__builtin_amdgcn_cvt_pk_fp8_f32(s[6 * 65] * wscale, s[7 * 65] * wscale, (int)o.y, true);
        *(u32x2*)(WT + (size_t)(orow0 + n) * ldt + k0 + 8 * c) = o; }
    LDS_WAIT(); asm volatile("" ::: "memory");
}
__device__ __forceinline__ void tr_dense(const float* W, int K, int N, bf16_t* WT, int item, LAS float* scr, int lane) {
    const int nblk = N / 32, kb = item / nblk, nb = item % nblk;
    tr_item(W, N, WT, K, 64 * kb, 32 * nb, 32 * nb, scr, lane);
}

__device__ __forceinline__ void s5_tables(const Params& p, Ctx& C, int dir, int g) {
    LAS f32x2* PW = (LAS f32x2*)C.lds;
    LAS f32x2* BB = PW + 65 * 64;
    LAS f32x2* CX = BB + 64 * 16;
    const float* a_re = p.inp(11); const float* a_im = p.inp(12); const float* log_dt = p.inp(13);
    const float* b_re = p.inp(14); const float* b_im = p.inp(15); const float* c_re = p.inp(16); const float* c_im = p.inp(17);
    const int tid = C.tid;
    if (tid < 64) {
        const int pp = tid;
        const float dt = __expf(log_dt[dir * 64 + g]);
        const float are = a_re[(dir * 64 + g) * 64 + pp], aim = a_im[(dir * 64 + g) * 64 + pp];
        const float zr = are * dt, zi = aim * dt;
        const float mag = __expf(zr);
        double rev = (double)zi * 0.15915494309189535; rev -= floor(rev);
        const float cs = __builtin_amdgcn_cosf((float)rev), sn = __builtin_amdgcn_sinf((float)rev);
        const float abr = mag * cs, abi = mag * sn;
        const float den = are * are + aim * aim, nr = abr - 1.0f, ni = abi;
        const float fre = (nr * are + ni * aim) / den, fim = (ni * are - nr * aim) / den;
        float pr = 1.0f, pi = 0.0f;
#pragma unroll 1
        for (int n = 0; n <= 64; ++n) { PW[n * 64 + pp] = (f32x2){pr, pi}; const float t = pr * abr - pi * abi; pi = pr * abi + pi * abr; pr = t; }
        for (int j = 0; j < 16; ++j) { const float br = b_re[(g * 64 + pp) * 16 + j], bi = b_im[(g * 64 + pp) * 16 + j];
            BB[pp * 16 + j] = (f32x2){fre * br - fim * bi, fre * bi + fim * br}; }
    }
    for (int q = tid; q < 1024; q += NTHR) { const int i = q >> 6, pp = q & 63; CX[i * 64 + pp] = (f32x2){c_re[(g * 16 + i) * 64 + pp], c_im[(g * 16 + i) * 64 + pp]}; }
    __syncthreads();
    bf16_t* KN = (bf16_t*)(p.ws + WS_KN) + (size_t)(dir * 64 + g) * 16 * 1024;
    bf16_t* WTt = (bf16_t*)(p.ws + WS_WT) + (size_t)(dir * 64 + g) * 128 * 1024;
    float* APOW = (float*)(p.ws + WS_APOW) + (size_t)(dir * 64 + g) * 64 * 128;
    float* AL = (float*)(p.ws + WS_AL) + (size_t)(dir * 64 + g) * 128;
#pragma unroll 1
    for (int q = 0; q < 32; ++q) { const int idx = tid + NTHR * q; const int n = idx >> 8, i = (idx >> 4) & 15, j = idx & 15;
        float s = 0.f;
#pragma unroll 4
        for (int pp = 0; pp < 64; ++pp) { const f32x2 c = CX[i * 64 + pp], w = PW[n * 64 + pp], b = BB[pp * 16 + j];
            const float gr = c.x * b.x - c.y * b.y, gi = c.x * b.y + c.y * b.x;
            s += gr * w.x - gi * w.y; }
        KN[(size_t)i * 1024 + n * 16 + j] = f2bf(s); }
#pragma unroll 2
    for (int q = 0; q < 256; ++q) { const int idx = tid + NTHR * q; const int j = idx & 15, s = (idx >> 4) & 63, pq = idx >> 10; const int pp = pq & 63;
        const f32x2 w = PW[(63 - s) * 64 + pp], b = BB[pp * 16 + j];
        const float v = (pq < 64) ? (w.x * b.x - w.y * b.y) : (w.x * b.y + w.y * b.x);
        WTt[(size_t)pq * 1024 + s * 16 + j] = f2bf(v); }
    for (int q = tid; q < 4096; q += NTHR) { const int t = q >> 6, pp = q & 63; const f32x2 w = PW[(t + 1) * 64 + pp]; *(f32x2*)(APOW + (size_t)t * 128 + 2 * pp) = w; }
    if (tid < 64) { const f32x2 w = PW[64 * 64 + tid]; *(f32x2*)(AL + 2 * tid) = w; }
    if (dir == 0) { bf16_t* CCt = (bf16_t*)(p.ws + WS_CC) + (size_t)g * 16 * 128;
        for (int q = tid; q < 2048; q += NTHR) { const int i = q >> 7, pq = q & 127; const f32x2 c = CX[i * 64 + (pq & 63)]; CCt[i * 128 + pq] = f2bf(pq < 64 ? c.x : -c.y); } }
    __syncthreads();
}

__device__ __forceinline__ void phase_p0(const Params& p, Ctx& C) {
    for (int task = C.bid; task < 128; task += C.G) s5_tables(p, C, task >> 6, task & 63);
    {
        const int gt = C.bid * NTHR + C.tid, ngt = C.G * NTHR;
        float* R128 = (float*)(p.ws + WS_ROPE128); float* R64 = (float*)(p.ws + WS_ROPE64);
        for (int q = gt; q < 256 * 64 + 256 * 32; q += ngt) {
            int pos, i, half; float* dst;
            if (q < 256 * 64) { pos = q >> 6; i = q & 63; half = 64; dst = R128 + (size_t)q * 2; }
            else { const int r = q - 256 * 64; pos = r >> 5; i = r & 31; half = 32; dst = R64 + (size_t)r * 2; }
            const float freq = exp2f(-(float)i / (float)half * 13.287712379549449f);
            const float ang = (float)pos * freq;
            double rev = (double)ang * 0.15915494309189535; rev -= floor(rev);
            dst[0] = __builtin_amdgcn_cosf((float)rev); dst[1] = __builtin_amdgcn_sinf((float)rev);
        }
        bf16_t* RWT = (bf16_t*)(p.ws + WS_RWT); const float* rw = p.inp(26);
        for (int q = gt; q < 2 * 64 * DM; q += ngt) { const int L = q / (64 * DM), r = q % (64 * DM), e = r / DM, k = r % DM;
            const float w = rw[((size_t)L * DM + k) * 64 + e]; const bf16_t hi = f2bf(w); const bf16_t lo = f2bf(w - bf2f(hi));
            RWT[((size_t)(L * 2 + 0) * 64 + e) * DM + k] = hi; RWT[((size_t)(L * 2 + 1) * 64 + e) * DM + k] = lo; }
    }
    {
        const float* cvec = p.inp(1); const float* cctx = p.inp(3); const float* mw = p.inp(4);
        float* MODP = (float*)(p.ws + WS_MODP);
        for (int task = C.gw; task < 2 * 32 * 48; task += C.ngw) {
            const int L = task / (32 * 48), r = task % (32 * 48), kb = r / 48, cb = r % 48;
            const float sc = siluf_(cvec[64 * kb + C.lane]), sx = siluf_(cctx[64 * kb + C.lane]);
            f32x4 a0 = {0.f, 0.f, 0.f, 0.f}, a1 = {0.f, 0.f, 0.f, 0.f};
            const float* wp = mw + ((size_t)L * DM + 64 * kb) * 12288 + 256 * cb + 4 * C.lane;
#pragma unroll 8
            for (int kk = 0; kk < 64; ++kk) { const f32x4 w = *(const f32x4*)(wp + (size_t)kk * 12288);
                const float s0 = __shfl(sc, kk), s1 = __shfl(sx, kk);
                a0 += w * s0; a1 += w * s1; }
            *(f32x4*)(MODP + ((size_t)((L * 32 + kb) * 2 + 0)) * 12288 + 256 * cb + 4 * C.lane) = a0;
            *(f32x4*)(MODP + ((size_t)((L * 32 + kb) * 2 + 1)) * 12288 + 256 * cb + 4 * C.lane) = a1;
        }
    }
    {
        LAS float* scr = (LAS float*)(C.lds + C.wave * 17408);
        constexpr int J0 = (DM / 64) * (EV_IN / 64), J3 = (DM / 64) * (OD_IN / 64);
        for (int it = C.gw; it < J0 + J3; it += C.ngw) {
            const bool l1 = it >= J0; const int r = l1 ? it - J0 : it; const int N = l1 ? OD_IN : EV_IN; const int nblk = N / 64, kb = r / nblk, nb = r % nblk;
            tr_item64_fp8(p.inp(l1 ? 21 : 8), N, (unsigned char*)(p.ws + (l1 ? WS_WIN1 : WS_WIN0)), DM, 64 * kb, 64 * nb, 64 * nb, scr, C.lane, 32.0f);
        }
        LAS float* scr2 = (LAS float*)(C.lds + C.wave * 17408);
        constexpr int I1 = (DM / 64) * (DM / 32), I2 = (1024 / 64) * (1024 / 32), I4 = I1;
        for (int it = C.gw; it < I1 + I2 + I4; it += C.ngw) {
            int r = it;
            if (r < I1) { tr_dense(p.inp(9), DM, DM, (bf16_t*)(p.ws + WS_WOUT0), r, scr2, C.lane); continue; } r -= I1;
            if (r < I2) { tr_dense(p.inp(19), 1024, 1024, (bf16_t*)(p.ws + WS_WGLU), r, scr2, C.lane); continue; } r -= I2;
            tr_dense(p.inp(22), DM, DM, (bf16_t*)(p.ws + WS_WOUT1), r, scr2, C.lane);
        }
    }
}
__device__ __forceinline__ void phase_p1(const Params& p, Ctx& C) {
    const float* MODP = (const float*)(p.ws + WS_MODP); float* MODF = (float*)(p.ws + WS_MODF); const float* mb = p.inp(5);
    for (int q = C.bid * NTHR + C.tid; q < 2 * 2 * 12288; q += C.G * NTHR) { const int L = q / (2 * 12288), v = (q / 12288) & 1, col = q % 12288;
        float s = mb[L * 12288 + col];
        for (int kb = 0; kb < 32; ++kb) s += MODP[((size_t)((L * 32 + kb) * 2 + v)) * 12288 + col];
        MODF[q] = s; }
}
__device__ __forceinline__ const float* modv(const Params& p, int L, int v, int k) { return (const float*)(p.ws + WS_MODF) + (size_t)(L * 2 + v) * 12288 + k * DM; }

__device__ __forceinline__ void stage_vec(LAS float* dst, const float* src, int tid) { *(LAS f32x4*)(dst + 4 * tid) = *(const f32x4*)(src + 4 * tid); }
__device__ __forceinline__ void phase_modulate(const Params& p, Ctx& C, int L) {
    unsigned char* XA8 = (unsigned char*)(p.ws + WS_XA);
    const float* X2 = (const float*)(p.ws + WS_HX2);
    LAS float* MV = (LAS float*)C.lds;
    for (int v = 0; v < 2; ++v) { stage_vec(MV + (v * 2 + 0) * DM, modv(p, L, v, 0), C.tid); stage_vec(MV + (v * 2 + 1) * DM, modv(p, L, v, 1), C.tid); }
    __syncthreads();
    for (int r = C.gw; r < TT; r += C.ngw) {
        const int v = r < CTXL ? 1 : 0;
        const float* src = (L == 0) ? (r < CTXL ? p.inp(2) + (size_t)r * DM : p.inp(0) + (size_t)(r - CTXL) * DM) : X2 + (size_t)r * DM;
        const LAS float* sh = MV + (v * 2 + 0) * DM; const LAS float* sc = MV + (v * 2 + 1) * DM;
#pragma unroll
        for (int j = 0; j < 8; ++j) { const int c = 4 * (C.lane + 64 * j);
            const f32x4 x = *(const f32x4*)(src + c), a = *(const LAS f32x4*)(sc + c), b = *(const LAS f32x4*)(sh + c);
            const f32x4 y = x * (a + 1.0f) + b;
            unsigned w = (unsigned)__builtin_amdgcn_cvt_pk_fp8_f32(y[0], y[1], 0, false); w = (unsigned)__builtin_amdgcn_cvt_pk_fp8_f32(y[2], y[3], (int)w, true);
            *(unsigned*)(XA8 + (size_t)r * DM + c) = w; }
    }
    __syncthreads();
    LAS float* scr = (LAS float*)(C.lds + C.wave * 17408);
    unsigned char* GU = (unsigned char*)(p.ws + WS_GU); unsigned char* DT = (unsigned char*)(p.ws + WS_DT);
    for (int it = C.gw; it < NEX1 * 768; it += C.ngw) {
        const int e = it / 768, r = it % 768, which = r >> 8, q = r & 255;
        if (which < 2) {
            const float* W = (e < 64) ? p.inp(28 + which) + ((size_t)(L * 64 + e)) * DM * EHID : p.inp(31 + which) + (size_t)L * DM * EHID;
            const int kb = q >> 3, nb = q & 7, n0 = 64 * nb;
            tr_item64_fp8(W, EHID, GU + (size_t)e * 1024 * DM, DM, 64 * kb, n0, 256 * (n0 >> 7) + (n0 & 127) + (which ? 128 : 0), scr, C.lane);
        } else {
            const float* W = (e < 64) ? p.inp(30) + ((size_t)(L * 64 + e)) * EHID * DM : p.inp(33) + (size_t)L * EHID * DM;
            const int kb = q >> 5, nb = q & 31;
            tr_item64_fp8(W, DM, DT + (size_t)e * DM * EHID, EHID, 64 * kb, 64 * nb, 64 * nb, scr, C.lane);
        }
    }
}

__device__ __forceinline__ void phase_rope0(const Params& p, Ctx& C) {
    bf16_t* QKV = (bf16_t*)(p.ws + WS_BIG + BG_QKV);
    const f32x2* R128 = (const f32x2*)(p.ws + WS_ROPE128);
    for (int r = C.gw; r < TT; r += C.ngw) {
        bf16_t* row = QKV + (size_t)r * EV_IN;
        if (r < CTXL) {
#pragma unroll
            for (int j = 0; j < 2; ++j) { u32x4* q = (u32x4*)(row + 8 * (C.lane + 64 * j)); u32x4 w = *q;
                w.x = cvt_pk_bf16(bflo(w.x) * 0.0625f, bfhi(w.x) * 0.0625f); w.y = cvt_pk_bf16(bflo(w.y) * 0.0625f, bfhi(w.y) * 0.0625f);
                w.z = cvt_pk_bf16(bflo(w.z) * 0.0625f, bfhi(w.z) * 0.0625f); w.w = cvt_pk_bf16(bflo(w.w) * 0.0625f, bfhi(w.w) * 0.0625f); *q = w; }
        } else {
            const int l = r - CTXL, rp = l >> 6, cp = l & 63;
#pragma unroll
            for (int qk = 0; qk < 2; ++qk)
#pragma unroll
                for (int m = 0; m < 8; ++m) { const int pi = C.lane + 64 * m, head = pi >> 7, blk = (pi >> 6) & 1, i = pi & 63;
                    bf16_t* b = row + qk * 1024 + head * 256 + blk * 128 + i;
                    const f32x2 cs = R128[(blk ? cp : rp) * 64 + i];
                    const float x1 = bf2f(b[0]), x2 = bf2f(b[64]); const float sc = qk ? 1.0f : 0.0625f;
                    b[0] = f2bf((x1 * cs.x - x2 * cs.y) * sc); b[64] = f2bf((x1 * cs.y + x2 * cs.x) * sc); }
        }
    }
}

__device__ __forceinline__ void phase_normrope1(const Params& p, Ctx& C) {
    bf16_t* QKV = (bf16_t*)(p.ws + WS_BIG + BG_QKV);
    const f32x2* R64 = (const f32x2*)(p.ws + WS_ROPE64);
    const float* qg = p.inp(23);
    unsigned* KMAX = (unsigned*)(p.ws + WS_CTL) + CW_KMAX;
    const int lane = C.lane, i32 = lane & 31; const bool up = lane >= 32;
    const float g00 = qg[lane], g01 = qg[64 + lane], g10 = qg[128 + lane], g11 = qg[128 + 64 + lane];
    for (int r = C.gw; r < TT; r += C.ngw) {
        bf16_t* row = QKV + (size_t)r * OD_IN;
        const bool lat = r >= CTXL; const int l = r - CTXL, rp = lat ? (l >> 6) : 0, cp = lat ? (l & 63) : 0;
        const f32x2 cr = R64[rp * 32 + i32], cc = R64[cp * 32 + i32];
#pragma unroll 2
        for (int h = 0; h < 26; ++h) {
            const int col = h < 8 ? 128 * h : (h < 10 ? 1024 + 128 * (h - 8) : (h < 18 ? 1536 + 128 * (h - 10) : 2560 + 128 * (h - 18)));
            bf16_t* b = row + col;
            float v0 = bf2f(b[lane]), v1 = bf2f(b[64 + lane]);
            if (h < 10) { const float ss = wave_sum(v0 * v0 + v1 * v1); const float rs = rsqrtf(ss * (1.0f / 128.0f) + LN_EPS);
                v0 = bf2f(f2bf(v0 * rs)) * (h < 8 ? g00 : g10); v1 = bf2f(f2bf(v1 * rs)) * (h < 8 ? g01 : g11); }
            if (lat) { const float p0 = __shfl_xor(v0, 32), p1 = __shfl_xor(v1, 32);
                v0 = up ? (p0 * cr.y + v0 * cr.x) : (v0 * cr.x - p0 * cr.y);
                v1 = up ? (p1 * cc.y + v1 * cc.x) : (v1 * cc.x - p1 * cc.y); }
            const bf16_t o0 = f2bf(v0), o1 = f2bf(v1);
            b[lane] = o0; b[64 + lane] = o1;
            if ((h >= 8 && h < 10) || h >= 18) {
                const float w0 = bf2f(o0), w1 = bf2f(o1); const float k2 = wave_sum(w0 * w0 + w1 * w1);
                if (lane == 0) atomicMax(KMAX + 64 * (h < 10 ? h - 8 : h - 16), __float_as_uint(k2)); }
        }
    }
}

__device__ __forceinline__ void phase_merge1(const Params& p, Ctx& C) {
    bf16_t* ATT = (bf16_t*)(p.ws + WS_BIG + BG_ATT);
    const float* dl = p.inp(24); const float* sg = p.inp(25);
    const int lane = C.lane;
    float d0 = dl[lane] * dl[128 + lane] + dl[64 + lane] * dl[128 + 64 + lane];
    float d1 = dl[256 + lane] * dl[384 + lane] + dl[256 + 64 + lane] * dl[384 + 64 + lane];
    const float lam = __expf(wave_sum(d0)) - __expf(wave_sum(d1)) + LAMBDA_INIT;
    const f32x4 gg = *(const f32x4*)(sg + 4 * lane);
    for (int l = C.gw; l < SEQ; l += C.ngw) {
        bf16_t* row = ATT + (size_t)l * 3072;
#pragma unroll
        for (int h = 0; h < 4; ++h) {
            const u32x2 a = *(const u32x2*)(row + 1024 + 256 * h + 4 * lane), b = *(const u32x2*)(row + 2048 + 256 * h + 4 * lane);
            f32x4 o = {bflo(a.x) - lam * bflo(b.x), bfhi(a.x) - lam * bfhi(b.x), bflo(a.y) - lam * bflo(b.y), bfhi(a.y) - lam * bfhi(b.y)};
            const float ss = wave_sum(o[0] * o[0] + o[1] * o[1] + o[2] * o[2] + o[3] * o[3]);
            const float rs = rsqrtf(ss * (1.0f / 256.0f) + LN_EPS) * (1.0f - LAMBDA_INIT);
            o = o * rs * gg;
            u32x2 w; w.x = cvt_pk_bf16(o[0], o[1]); w.y = cvt_pk_bf16(o[2], o[3]);
            *(u32x2*)(row + 1024 + 256 * h + 4 * lane) = w;
        }
    }
}

__device__ __forceinline__ void phase_ln1(const Params& p, Ctx& C, int L) {
    const bf16_t* Y = (const bf16_t*)(p.ws + WS_YMIX); float* X1 = (float*)(p.ws + WS_X1); unsigned char* XA8 = (unsigned char*)(p.ws + WS_XA);
    const float* X2 = (const float*)(p.ws + WS_HX2);
    const float* lg = p.inp(6) + (size_t)(L * 2 + 0) * DM; const float* lb = p.inp(7) + (size_t)(L * 2 + 0) * DM;
    const int r0 = (L == 0) ? 0 : CTXL;
    LAS float* MV = (LAS float*)C.lds; LAS float* LG = MV + 6 * DM; LAS float* LB = LG + DM;
    for (int v = 0; v < 2; ++v) for (int k = 0; k < 3; ++k) stage_vec(MV + (v * 3 + k) * DM, modv(p, L, v, 2 + k), C.tid);
    stage_vec(LG, lg, C.tid); stage_vec(LB, lb, C.tid);
    __syncthreads();
    for (int r = r0 + C.gw; r < TT; r += C.ngw) {
        const int v = r < CTXL ? 1 : 0;
        const float* src = (L == 0) ? (r < CTXL ? p.inp(2) + (size_t)r * DM : p.inp(0) + (size_t)(r - CTXL) * DM) : X2 + (size_t)r * DM;
        const LAS float* g1 = MV + (v * 3 + 0) * DM; const LAS float* sh2 = MV + (v * 3 + 1) * DM; const LAS float* sc2 = MV + (v * 3 + 2) * DM;
        f32x4 t[8]; float s = 0.f;
#pragma unroll
        for (int j = 0; j < 8; ++j) { const int c = 4 * (C.lane + 64 * j);
            const f32x4 x = *(const f32x4*)(src + c), g = *(const LAS f32x4*)(g1 + c); const u32x2 yy = *(const u32x2*)(Y + (size_t)r * DM + c);
            const f32x4 y = {bflo(yy.x), bfhi(yy.x), bflo(yy.y), bfhi(yy.y)};
            t[j] = x * ALPHA + g * y; s += (t[j][0] + t[j][1]) + (t[j][2] + t[j][3]); }
        const float mean = wave_sum(s) * (1.0f / DM); float s2 = 0.f;
#pragma unroll
        for (int j = 0; j < 8; ++j) { t[j] = t[j] - mean; s2 += (t[j][0] * t[j][0] + t[j][1] * t[j][1]) + (t[j][2] * t[j][2] + t[j][3] * t[j][3]); }
        const float rstd = rsqrtf(wave_sum(s2) * (1.0f / DM) + LN_EPS);
#pragma unroll
        for (int j = 0; j < 8; ++j) { const int c = 4 * (C.lane + 64 * j);
            const f32x4 x1 = t[j] * rstd * *(const LAS f32x4*)(LG + c) + *(const LAS f32x4*)(LB + c);
            *(f32x4*)(X1 + (size_t)r * DM + c) = x1;
            const f32x4 z = x1 * (*(const LAS f32x4*)(sc2 + c) + 1.0f) + *(const LAS f32x4*)(sh2 + c);
            unsigned w = (unsigned)__builtin_amdgcn_cvt_pk_fp8_f32(z[0], z[1], 0, false); w = (unsigned)__builtin_amdgcn_cvt_pk_fp8_f32(z[2], z[3], (int)w, true);
            *(unsigned*)(XA8 + (size_t)r * DM + c) = w; }
    }
    __syncthreads();
}

__device__ __forceinline__ void phase_combine(const Params& p, Ctx& C, int L, LAS unsigned char* misc) {
    const unsigned char* YM = (const unsigned char*)(p.ws + WS_BIG + BG_YMOE); const float* X1 = (const float*)(p.ws + WS_X1);
    float* X2 = (float*)(p.ws + WS_HX2);
    const float* lg = p.inp(6) + (size_t)(L * 2 + 1) * DM; const float* lb = p.inp(7) + (size_t)(L * 2 + 1) * DM;
    const unsigned* PK = (const unsigned*)(p.ws + WS_WGT); const int* cnt = (const int*)(p.ws + WS_CTL) + CW_CNT + L * 128;
    const int r0 = (L == 0) ? 0 : CTXL;
    LAS int* rb = (LAS int*)(misc + 64);
    LAS float* MV = (LAS float*)C.lds; LAS float* LG = MV + 2 * DM; LAS float* LB = LG + DM;
    __syncthreads();
    if (C.tid == 0) { int q = 0; for (int e = 0; e < NEX1; ++e) { rb[e] = q; q += cnt[e]; } }
    stage_vec(MV, modv(p, L, 0, 5), C.tid); stage_vec(MV + DM, modv(p, L, 1, 5), C.tid); stage_vec(LG, lg, C.tid); stage_vec(LB, lb, C.tid);
    __syncthreads();
    for (int r = r0 + C.gw; r < TT; r += C.ngw) {
        const int v = r < CTXL ? 1 : 0;
        const LAS float* g2 = MV + v * DM;
        int ln = C.lane; asm volatile("" : "+v"(ln));
        int slot = rb[64] + (r - r0);
        if (ln < 8) { const unsigned pk = PK[(size_t)r * 8 + ln]; slot = rb[pk >> 16] + (int)(pk & 0xffffu); }
        f32x4 t[2][4]; float s = 0.f;
#pragma unroll
        for (int j = 0; j < 2; ++j) { const int c = 16 * (ln + 64 * j);
            u32x4 yy[9];
#pragma unroll
            for (int k = 0; k < 9; ++k) { const size_t a = (size_t)__builtin_amdgcn_readlane(slot, k); yy[k] = __builtin_nontemporal_load((const u32x4*)(YM + a * DM + c)); }
            f32x2 f[8];
#pragma unroll
            for (int q = 0; q < 8; ++q) f[q] = (f32x2){0.f, 0.f};
#pragma unroll
            for (int k = 0; k < 9; ++k) {
                f[0] += __builtin_amdgcn_cvt_pk_f32_fp8((int)yy[k].x, false); f[1] += __builtin_amdgcn_cvt_pk_f32_fp8((int)yy[k].x, true);
                f[2] += __builtin_amdgcn_cvt_pk_f32_fp8((int)yy[k].y, false); f[3] += __builtin_amdgcn_cvt_pk_f32_fp8((int)yy[k].y, true);
                f[4] += __builtin_amdgcn_cvt_pk_f32_fp8((int)yy[k].z, false); f[5] += __builtin_amdgcn_cvt_pk_f32_fp8((int)yy[k].z, true);
                f[6] += __builtin_amdgcn_cvt_pk_f32_fp8((int)yy[k].w, false); f[7] += __builtin_amdgcn_cvt_pk_f32_fp8((int)yy[k].w, true); }
#pragma unroll
            for (int q = 0; q < 4; ++q) { const f32x4 x = *(const f32x4*)(X1 + (size_t)r * DM + c + 4 * q), g = *(const LAS f32x4*)(g2 + c + 4 * q);
                const f32x4 ff = {f[2 * q][0], f[2 * q][1], f[2 * q + 1][0], f[2 * q + 1][1]};
                t[j][q] = x * ALPHA + g * ff; s += (t[j][q][0] + t[j][q][1]) + (t[j][q][2] + t[j][q][3]); } }
        const float mean = wave_sum(s) * (1.0f / DM); float s2 = 0.f;
#pragma unroll
        for (int j = 0; j < 2; ++j)
#pragma unroll
            for (int q = 0; q < 4; ++q) { t[j][q] = t[j][q] - mean; s2 += (t[j][q][0] * t[j][q][0] + t[j][q][1] * t[j][q][1]) + (t[j][q][2] * t[j][q][2] + t[j][q][3] * t[j][q][3]); }
        const float rstd = rsqrtf(wave_sum(s2) * (1.0f / DM) + LN_EPS);
        float* dst = (L == 0) ? X2 + (size_t)r * DM : p.out + (size_t)(r - CTXL) * DM;
#pragma unroll
        for (int j = 0; j < 2; ++j)
#pragma unroll
            for (int q = 0; q < 4; ++q) { const int c = 16 * (ln + 64 * j) + 4 * q;
                *(f32x4*)(dst + c) = t[j][q] * rstd * *(const LAS f32x4*)(LG + c) + *(const LAS f32x4*)(LB + c); }
    }
}
constexpr int RLD = 264;
constexpr int SLD = 136;

template <bool SCALE>
__device__ __forceinline__ void stage_chunk(const bf16_t* QKV, int row0, int col0, LAS bf16_t* dst, int tid, float lg  , int dirb) {
#pragma unroll
    for (int q = 0; q < 8; ++q) { const int idx = tid + NTHR * q, r = idx >> 5, c = idx & 31;
        u32x4 w = *(const u32x4*)(QKV + (size_t)(row0 + r) * EV_IN + col0 + 8 * c);
        if (SCALE) { const float sc = fast_exp((dirb ? (float)r : (float)(127 - r)) * lg);
            w.x = cvt_pk_bf16(bflo(w.x) * sc, bfhi(w.x) * sc); w.y = cvt_pk_bf16(bflo(w.y) * sc, bfhi(w.y) * sc);
            w.z = cvt_pk_bf16(bflo(w.z) * sc, bfhi(w.z) * sc); w.w = cvt_pk_bf16(bflo(w.w) * sc, bfhi(w.w) * sc); }
        *(LAS u32x4*)(dst + r * RLD + 8 * c) = w; }
}

__device__ __forceinline__ void ret_chunk_kv(const Params& p, Ctx& C) {
    const bf16_t* QKV = (const bf16_t*)(p.ws + WS_BIG + BG_QKV); float* CKV = (float*)(p.ws + WS_BIG + BG_CKV);
    const float* rld = p.inp(10);
    LAS bf16_t* Vs = (LAS bf16_t*)C.lds; LAS bf16_t* Ks = Vs + 128 * RLD;
    const int lane = C.lane, w = C.wave;
    for (int unit = C.bid; unit < 130 * 8; unit += C.G) {
        const int u = unit >> 3, h = (unit >> 1) & 3, dir = unit & 1;
        const float lg = rld[dir * 4 + h];
        __syncthreads();
        stage_chunk<false>(QKV, 128 * u, 2048 + 256 * h, Vs, C.tid, 0.f, 0);
        stage_chunk<true>(QKV, 128 * u, 1024 + 256 * h, Ks, C.tid, lg, dir);
        __syncthreads();
        f32x4 acc[2][16];
#pragma unroll
        for (int a = 0; a < 2; ++a)
#pragma unroll
            for (int b = 0; b < 16; ++b) acc[a][b] = (f32x4){0.f, 0.f, 0.f, 0.f};
        const unsigned vbase = (unsigned)(uintptr_t)Vs, kbase = (unsigned)(uintptr_t)Ks;
#pragma unroll 1
        for (int ks = 0; ks < 4; ++ks) {
            bf16x8 af[2];
#pragma unroll
            for (int a = 0; a < 2; ++a) af[a] = frag_colk_l(vbase + (unsigned)((32 * ks) * RLD + 32 * w + 16 * a) * 2u, RLD * 2, lane);
#pragma unroll
            for (int b = 0; b < 16; ++b) { const bf16x8 bf = frag_colk_l(kbase + (unsigned)((32 * ks) * RLD + 16 * b) * 2u, RLD * 2, lane);
                acc[0][b] = MFMA16(af[0], bf, acc[0][b]); acc[1][b] = MFMA16(af[1], bf, acc[1][b]); }
        }
        float* dst = CKV + ((size_t)((dir * 4 + h) * 130 + u)) * 65536;
#pragma unroll
        for (int a = 0; a < 2; ++a)
#pragma unroll
            for (int b = 0; b < 16; ++b)
#pragma unroll
                for (int j = 0; j < 4; ++j) dst[(size_t)(32 * w + 16 * a + 4 * (lane >> 4) + j) * 256 + 16 * b + (lane & 15)] = acc[a][b][j];
    }
    __syncthreads();
}

__device__ __forceinline__ int s5_row(int dir, int c, int s) { return dir == 0 ? 64 * c + s : (c < 4 ? 255 - (64 * c + s) : 16639 - 64 * (c - 4) - s); }

__device__ __forceinline__ void s5_end_states(const Params& p, Ctx& C) {
    const bf16_t* QKV = (const bf16_t*)(p.ws + WS_BIG + BG_QKV); const bf16_t* WTt = (const bf16_t*)(p.ws + WS_WT); float* E = (float*)(p.ws + WS_S5E);
    const int lane = C.lane, kq = lane >> 4;
    for (int task = C.gw; task < 2 * 64 * 17; task += C.ngw) {
        const int dir = task / (64 * 17), r = task % (64 * 17), g = r / 17, ct = r % 17;
        int cc = 16 * ct + (lane & 15); const bool valid = cc < 260; cc = valid ? cc : 259;
        const bf16_t* wt = WTt + (size_t)(dir * 64 + g) * 128 * 1024;
        f32x4 acc[8];
#pragma unroll
        for (int t = 0; t < 8; ++t) acc[t] = (f32x4){0.f, 0.f, 0.f, 0.f};
#pragma unroll 2
        for (int ks = 0; ks < 32; ++ks) {
            const int s = 2 * ks + (kq >> 1);
            const bf16x8 bf = *(const bf16x8*)(QKV + (size_t)s5_row(dir, cc, s) * EV_IN + 4096 + 16 * g + 8 * (kq & 1));
#pragma unroll
            for (int t = 0; t < 8; ++t) { const bf16x8 af = frag_rowk_g(wt + (size_t)(16 * t) * 1024 + 32 * ks, 1024, lane); acc[t] = MFMA16(af, bf, acc[t]); }
        }
        if (valid) { float* dst = E + ((size_t)((dir * 64 + g) * 260 + cc)) * 128;
#pragma unroll
            for (int t = 0; t < 8; ++t) *(f32x4*)(dst + 16 * t + 4 * kq) = acc[t]; }
    }
}

__device__ __forceinline__ void phase_scans(const Params& p, Ctx& C) {
    const float* CKV = (const float*)(p.ws + WS_BIG + BG_CKV); bf16_t* SP = (bf16_t*)(p.ws + WS_BIG + BG_SPREV);
    const float* rld = p.inp(10);
    for (int q = C.bid * NTHR + C.tid; q < 8 * 16384; q += C.G * NTHR) {
        const int dh = q >> 14, el = (q & 16383) * 4, dir = dh >> 2, h = dh & 3;
        const float gch = fast_exp(128.0f * rld[dir * 4 + h]);
        const float* src = CKV + (size_t)dh * 130 * 65536 + el; bf16_t* dst = SP + (size_t)dh * 130 * 65536 + el;
        f32x4 s = {0.f, 0.f, 0.f, 0.f};
        for (int st0 = 0; st0 < 130; st0 += 10) {
            f32x4 kv[10];
#pragma unroll
            for (int k = 0; k < 10; ++k) { const int st = st0 + k; const int u = dir == 0 ? st : (st == 0 ? 1 : (st == 1 ? 0 : 131 - st)); kv[k] = *(const f32x4*)(src + (size_t)u * 65536); }
#pragma unroll
            for (int k = 0; k < 10; ++k) { const int st = st0 + k; const int u = dir == 0 ? st : (st == 0 ? 1 : (st == 1 ? 0 : 131 - st));
                u32x2 w; w.x = cvt_pk_bf16(s[0], s[1]); w.y = cvt_pk_bf16(s[2], s[3]); *(u32x2*)(dst + (size_t)u * 65536) = w;
                s = s * gch + kv[k]; }
        }
    }
    const float* E = (const float*)(p.ws + WS_S5E); float* HST = (float*)(p.ws + WS_HST); const float* AL = (const float*)(p.ws + WS_AL);
    for (int q = C.bid * NTHR + C.tid; q < 2 * 64 * 64; q += C.G * NTHR) {
        const int dg = q >> 6, pp = q & 63;
        const f32x2 al = *(const f32x2*)(AL + (size_t)dg * 128 + 2 * pp);
        const float* e = E + (size_t)dg * 260 * 128; float* hs = HST + (size_t)dg * 260 * 128;
        float hr = 0.f, hi = 0.f;
        for (int c0 = 0; c0 < 260; c0 += 10) {
            float er[10], ei[10];
#pragma unroll
            for (int k = 0; k < 10; ++k) { er[k] = e[(size_t)(c0 + k) * 128 + pp]; ei[k] = e[(size_t)(c0 + k) * 128 + 64 + pp]; }
#pragma unroll
            for (int k = 0; k < 10; ++k) { *(f32x2*)(hs + (size_t)(c0 + k) * 128 + 2 * pp) = (f32x2){hr, hi};
                const float t = al.x * hr - al.y * hi + er[k]; hi = al.x * hi + al.y * hr + ei[k]; hr = t; }
        }
    }
}

__device__ __forceinline__ void ret_output_unit(const Params& p, Ctx& C, int unit) {
    const bf16_t* QKV = (const bf16_t*)(p.ws + WS_BIG + BG_QKV); const bf16_t* SP = (const bf16_t*)(p.ws + WS_BIG + BG_SPREV);
    bf16_t* MIX = (bf16_t*)(p.ws + WS_BIG + BG_MIX);
    const float* rld = p.inp(10);
    LAS bf16_t* RA = (LAS bf16_t*)C.lds; LAS bf16_t* RB = RA + 128 * RLD;
    int tid = C.tid; asm volatile("" : "+v"(tid));
    const int lane = tid & 63, w = C.wave, kq = lane >> 4, fr = lane & 15;
    const int u = unit >> 2, h = unit & 3;
    const float lgf = rld[h], lgb = rld[4 + h];
    stage_chunk<false>(QKV, 128 * u, 256 * h, RA, tid, 0.f, 0);
    int ib = 16 * w + 4 * kq, jb = fr; asm volatile("" : "+v"(ib), "+v"(jb));
    f32x4 acc[16];
#pragma unroll
    for (int t = 0; t < 16; ++t) acc[t] = (f32x4){0.f, 0.f, 0.f, 0.f};
#pragma unroll
    for (int dir = 0; dir < 2; ++dir) {
        const bf16_t* Sd = SP + ((size_t)((dir * 4 + h) * 130 + u)) * 65536;
#pragma unroll
        for (int eh = 0; eh < 2; ++eh) {
            __syncthreads();
#pragma unroll
            for (int q = 0; q < 8; ++q) { const int idx = tid + NTHR * q, rr = idx >> 5, c = idx & 31;
                *(LAS u32x4*)(RB + rr * RLD + 8 * c) = *(const u32x4*)(Sd + (size_t)(128 * eh + rr) * 256 + 8 * c);
                if (q == 3) asm volatile("" ::: "memory"); }
            __syncthreads();
#pragma unroll 1
            for (int ks = 0; ks < 8; ++ks) { const bf16x8 af = frag_rowk_l(RA + (16 * w) * RLD + 32 * ks, RLD, lane);
#pragma unroll
                for (int t = 0; t < 8; ++t) { const bf16x8 bf = frag_rowk_l(RB + (16 * t) * RLD + 32 * ks, RLD, lane); acc[8 * eh + t] = MFMA16(af, bf, acc[8 * eh + t]); } }
        }
#pragma unroll
        for (int r = 0; r < 4; ++r) { const int i = ib + r; const float qd = fast_exp((float)(128 - i) * lgb);
            const float f = (dir == 0) ? fast_exp((float)(i + 1) * lgf) / qd : qd;
#pragma unroll
            for (int t = 0; t < 16; ++t) acc[t][r] *= f; }
    }
    __syncthreads();
    stage_chunk<false>(QKV, 128 * u, 1024 + 256 * h, RB, tid, 0.f, 0);
    __syncthreads();
    f32x4 sc[8];
#pragma unroll
    for (int t = 0; t < 8; ++t) sc[t] = (f32x4){0.f, 0.f, 0.f, 0.f};
#pragma unroll 1
    for (int ks = 0; ks < 8; ++ks) { const bf16x8 af = frag_rowk_l(RA + (16 * w) * RLD + 32 * ks, RLD, lane);
#pragma unroll
        for (int t = 0; t < 8; ++t) { const bf16x8 bf = frag_rowk_l(RB + (16 * t) * RLD + 32 * ks, RLD, lane); sc[t] = MFMA16(af, bf, sc[t]); } }
#pragma unroll
    for (int t = 0; t < 8; ++t)
#pragma unroll
        for (int r = 0; r < 4; ++r) { const int i = ib + r, j = 16 * t + jb; const float d = (float)(i - j);
            const float m = (i >= j ? fast_exp(d * lgf) : 0.f) + (j >= i ? fast_exp(-d * lgb) : 0.f); sc[t][r] *= m; }
    __syncthreads();
    stage_chunk<false>(QKV, 128 * u, 2048 + 256 * h, RA, tid, 0.f, 0);
#pragma unroll
    for (int t = 0; t < 8; ++t)
#pragma unroll
        for (int r = 0; r < 4; ++r) RB[(16 * w + 4 * kq + r) * SLD + 16 * t + fr] = f2bf(sc[t][r]);
    __syncthreads();
    const unsigned vbase = (unsigned)(uintptr_t)RA;
#pragma unroll 1
    for (int ks = 0; ks < 4; ++ks) { const bf16x8 af = frag_rowk_l(RB + (16 * w) * SLD + 32 * ks, SLD, lane);
#pragma unroll
        for (int t = 0; t < 16; ++t) { const bf16x8 bf = frag_colk_l(vbase + (unsigned)((32 * ks) * RLD + 16 * t) * 2u, RLD * 2, lane); acc[t] = MFMA16(af, bf, acc[t]); } }
    __syncthreads();
#pragma unroll
    for (int r = 0; r < 4; ++r) {
        float s = 0.f;
#pragma unroll
        for (int t = 0; t < 16; ++t) s += acc[t][r];
        s += __shfl_xor(s, 1); s += __shfl_xor(s, 2); s += __shfl_xor(s, 4); s += __shfl_xor(s, 8);
        const float mean = s * (1.0f / 256.0f); float q = 0.f;
#pragma unroll
        for (int t = 0; t < 16; ++t) { const float d = acc[t][r] - mean; q += d * d; }
        q += __shfl_xor(q, 1); q += __shfl_xor(q, 2); q += __shfl_xor(q, 4); q += __shfl_xor(q, 8);
        const float rstd = rsqrtf(q * (1.0f / 256.0f) + LN_EPS);
#pragma unroll
        for (int t = 0; t < 16; ++t) RA[(16 * w + 4 * kq + r) * RLD + 16 * t + fr] = f2bf((acc[t][r] - mean) * rstd);
    }
    __syncthreads();
#pragma unroll
    for (int q = 0; q < 8; ++q) { const int idx = tid + NTHR * q, rr = idx >> 5, c = idx & 31; const size_t row = (size_t)(128 * u + rr);
        const u32x4 o = *(const LAS u32x4*)(RA + rr * RLD + 8 * c), g = *(const u32x4*)(QKV + row * EV_IN + 3072 + 256 * h + 8 * c);
        u32x4 w4;
        w4.x = cvt_pk_bf16(bflo(o.x) * siluf_(bflo(g.x)), bfhi(o.x) * siluf_(bfhi(g.x))); w4.y = cvt_pk_bf16(bflo(o.y) * siluf_(bflo(g.y)), bfhi(o.y) * siluf_(bfhi(g.y)));
        w4.z = cvt_pk_bf16(bflo(o.z) * siluf_(bflo(g.z)), bfhi(o.z) * siluf_(bfhi(g.z))); w4.w = cvt_pk_bf16(bflo(o.w) * siluf_(bflo(g.w)), bfhi(o.w) * siluf_(bfhi(g.w)));
        *(u32x4*)(MIX + row * DM + 256 * h + 8 * c) = w4; }
    __syncthreads();
}

constexpr int KLD = 1032;
__device__ __forceinline__ void s5_output_task(const Params& p, Ctx& C, int bt) {
    const bf16_t* QKV = (const bf16_t*)(p.ws + WS_BIG + BG_QKV); bf16_t* Z = (bf16_t*)(p.ws + WS_Z);
    const bf16_t* KN = (const bf16_t*)(p.ws + WS_KN); const bf16_t* CCt = (const bf16_t*)(p.ws + WS_CC);
    const float* APOW = (const float*)(p.ws + WS_APOW); const float* HST = (const float*)(p.ws + WS_HST); const float* dsk = p.inp(18);
    int tid = C.tid; asm volatile("" : "+v"(tid));
    const int lane = tid & 63, kq = lane >> 4, fr = lane & 15;
    LAS bf16_t* KF = (LAS bf16_t*)C.lds; LAS bf16_t* KB = KF + 16 * KLD;
    LAS bf16_t* U = KB + 16 * KLD + C.wave * 3072;
    LAS float* PW0 = (LAS float*)(KB + 16 * KLD + 8 * 3072);
    LAS float* PW16 = PW0 + 2 * 16 * 128;
    {
        const int g = bt >> 3, k0 = (260 * (bt & 7)) >> 3, k1 = (260 * ((bt & 7) + 1)) >> 3;
#pragma unroll
        for (int q = 0; q < 8; ++q) { const int idx = tid + NTHR * q, dir = idx >> 11, rr = (idx >> 7) & 15, c = idx & 127;
            *(LAS u32x4*)((dir ? KB : KF) + rr * KLD + 8 * c) = *(const u32x4*)(KN + ((size_t)(dir * 64 + g) * 16 + rr) * 1024 + 8 * c); }
        for (int q = lane; q < 192 * 2; q += 64) *(LAS u32x4*)(U + 8 * q) = (u32x4){0u, 0u, 0u, 0u};
#pragma unroll
        for (int q = 0; q < 2; ++q) { const int idx = tid + NTHR * q, dir = idx >> 9, f = (idx >> 5) & 15, c4 = idx & 31;
            *(LAS f32x4*)(PW0 + dir * 2048 + f * 128 + 4 * c4) = *(const f32x4*)(APOW + ((size_t)(dir * 64 + g) * 64 + (dir == 0 ? f : 15 - f)) * 128 + 4 * c4); }
        if (tid < 64) { const int dir = tid >> 5, c4 = tid & 31; *(LAS f32x4*)(PW16 + dir * 128 + 4 * c4) = *(const f32x4*)(APOW + ((size_t)(dir * 64 + g) * 64 + 15) * 128 + 4 * c4); }
        __syncthreads();
        const f32x4 dv = *(const f32x4*)(dsk + 16 * g + 4 * kq);
        bf16x8 ccr[2], cci[2];
#pragma unroll
        for (int hb = 0; hb < 2; ++hb) { ccr[hb] = frag_rowk_g(CCt + (size_t)g * 16 * 128 + 32 * hb, 128, lane); cci[hb] = frag_rowk_g(CCt + (size_t)g * 16 * 128 + 64 + 32 * hb, 128, lane); }
        const LAS float* pw0l = PW0 + (size_t)fr * 128 + 16 * kq;
        const LAS float* pw16l = PW16 + 16 * kq;
        for (int k = k0 + C.wave; k < k1; k += 8) {
            LDS_WAIT(); asm volatile("" ::: "memory");
            for (int q = lane; q < 128; q += 64) { const int t = q >> 1, hf = q & 1;
                *(LAS u32x4*)(U + (64 + t) * 16 + 8 * hf) = *(const u32x4*)(QKV + (size_t)(64 * k + t) * EV_IN + 4096 + 16 * g + 8 * hf); }
            LDS_WAIT(); asm volatile("" ::: "memory");
            const int cf = k, cb = k < 4 ? 3 - k : 263 - k;
            f32x4 acc[4];
#pragma unroll
            for (int tt = 0; tt < 4; ++tt) acc[tt] = (f32x4){0.f, 0.f, 0.f, 0.f};
            const LAS bf16_t* ubf = U + (64 + fr - (kq >> 1)) * 16 + 8 * (kq & 1);
            const LAS bf16_t* ubb = U + (64 + fr + (kq >> 1)) * 16 + 8 * (kq & 1);
#pragma unroll
            for (int n0 = 0; n0 < 64; n0 += 2) {
                const bf16x8 af = frag_rowk_l(KF + n0 * 16, KLD, lane), ab = frag_rowk_l(KB + n0 * 16, KLD, lane);
#pragma unroll
                for (int tt = 0; tt < 4; ++tt) {
                    if (n0 <= 16 * tt + 14) acc[tt] = MFMA16(af, *(const LAS bf16x8*)(ubf + (16 * tt - n0) * 16), acc[tt]);
                    if (n0 <= 62 - 16 * tt) acc[tt] = MFMA16(ab, *(const LAS bf16x8*)(ubb + (16 * tt + n0) * 16), acc[tt]);
                }
                asm volatile("" ::: "memory");
            }
#pragma unroll
            for (int dir = 0; dir < 2; ++dir) {
                const float* hp = HST + ((size_t)(dir * 64 + g) * 260 + (dir == 0 ? cf : cb)) * 128;
#pragma unroll
                for (int hb = 0; hb < 2; ++hb) {
                    float xr[8], xi[8];
#pragma unroll
                    for (int e2 = 0; e2 < 4; ++e2) { const f32x4 h4 = *(const f32x4*)(hp + 2 * (32 * hb + 8 * kq) + 4 * e2), b4 = *(const LAS f32x4*)(pw0l + dir * 2048 + hb * 64 + 4 * e2);
                        xr[2 * e2] = b4[0] * h4[0] - b4[1] * h4[1]; xi[2 * e2] = b4[0] * h4[1] + b4[1] * h4[0];
                        xr[2 * e2 + 1] = b4[2] * h4[2] - b4[3] * h4[3]; xi[2 * e2 + 1] = b4[2] * h4[3] + b4[3] * h4[2]; }
#pragma unroll
                    for (int st = 0; st < 4; ++st) {
                        const int tt = dir == 0 ? st : 3 - st;
                        u32x4 br, bi;
                        br.x = cvt_pk_bf16(xr[0], xr[1]); br.y = cvt_pk_bf16(xr[2], xr[3]); br.z = cvt_pk_bf16(xr[4], xr[5]); br.w = cvt_pk_bf16(xr[6], xr[7]);
                        bi.x = cvt_pk_bf16(xi[0], xi[1]); bi.y = cvt_pk_bf16(xi[2], xi[3]); bi.z = cvt_pk_bf16(xi[4], xi[5]); bi.w = cvt_pk_bf16(xi[6], xi[7]);
                        acc[tt] = MFMA16(ccr[hb], __builtin_bit_cast(bf16x8, br), acc[tt]);
                        acc[tt] = MFMA16(cci[hb], __builtin_bit_cast(bf16x8, bi), acc[tt]);
                        if (st < 3) {
#pragma unroll
                            for (int e2 = 0; e2 < 4; ++e2) { const f32x4 a4 = *(const LAS f32x4*)(pw16l + dir * 128 + hb * 64 + 4 * e2);
                                float t0 = xr[2 * e2] * a4[0] - xi[2 * e2] * a4[1]; xi[2 * e2] = xr[2 * e2] * a4[1] + xi[2 * e2] * a4[0]; xr[2 * e2] = t0;
                                t0 = xr[2 * e2 + 1] * a4[2] - xi[2 * e2 + 1] * a4[3]; xi[2 * e2 + 1] = xr[2 * e2 + 1] * a4[3] + xi[2 * e2 + 1] * a4[2]; xr[2 * e2 + 1] = t0; }
                        }
                    }
                }
            }
#pragma unroll
            for (int tt = 0; tt < 4; ++tt) { const int t = 16 * tt + fr;
                const u32x2 uu = *(const LAS u32x2*)(U + (64 + t) * 16 + 4 * kq);
                const float y0 = acc[tt][0] + bflo(uu.x) * dv[0], y1 = acc[tt][1] + bfhi(uu.x) * dv[1], y2 = acc[tt][2] + bflo(uu.y) * dv[2], y3 = acc[tt][3] + bfhi(uu.y) * dv[3];
                u32x2 w; w.x = cvt_pk_bf16(gelu_tanh(y0), gelu_tanh(y1)); w.y = cvt_pk_bf16(gelu_tanh(y2), gelu_tanh(y3));
                *(u32x2*)(Z + (size_t)(64 * k + t) * 1024 + 16 * g + 4 * kq) = w; }
        }
    }
    __syncthreads();
}

__device__ __forceinline__ void phase_ret_s5_outputs(const Params& p, Ctx& C, LAS unsigned char* misc) {
    unsigned* head = (unsigned*)(p.ws + WS_CTL) + CW_QUEUE;
    volatile LAS int* slot = (volatile LAS int*)(misc + 32);
    for (;;) {
        __syncthreads();
        if (C.tid == 0) slot[0] = (int)atomicAdd(head, 1u);
        __syncthreads();
        const int item = __builtin_amdgcn_readfirstlane(slot[0]);
        if (item >= 520) break;
        ret_output_unit(p, C, item);
    }
    for (;;) {
        __syncthreads();
        if (C.tid == 0) slot[0] = (int)atomicAdd(head + 64, 1u);
        __syncthreads();
        const int item = __builtin_amdgcn_readfirstlane(slot[0]);
        if (item >= 512) break;
        s5_output_task(p, C, item);
    }
}
__device__ __forceinline__ void phase_router(const Params& p, Ctx& C, int L) {
    const float* X1 = (const float*)(p.ws + WS_X1);
    const bf16_t* RWh = (const bf16_t*)(p.ws + WS_RWT) + (size_t)(L * 2 + 0) * 64 * DM; const bf16_t* RWl = (const bf16_t*)(p.ws + WS_RWT) + (size_t)(L * 2 + 1) * 64 * DM;
    const float* rbias = p.inp(27) + L * 64;
    int* cnt = (int*)(p.ws + WS_CTL) + CW_CNT + L * 128; int* LIST = (int*)(p.ws + WS_LIST); unsigned* PK = (unsigned*)(p.ws + WS_WGT); float* LW = (float*)(p.ws + WS_LW);
    const int lane = C.lane, kq = lane >> 4, fr = lane & 15;
    LAS float* Lg = (LAS float*)(C.lds + C.wave * 8192);
    const int r0 = (L == 0) ? 0 : CTXL, nrows = TT - r0;
    if (C.bid == 0 && C.tid == 0) cnt[64] = nrows;
    for (int task = C.gw; task < nrows / 16; task += C.ngw) {
        const int rbase = r0 + 16 * task, row = rbase + fr;
        const int v = row < CTXL ? 1 : 0;
        const float* xr = X1 + (size_t)row * DM; const float* sc2 = modv(p, L, v, 4); const float* sh2 = modv(p, L, v, 3);
        f32x4 acc[4];
#pragma unroll
        for (int t = 0; t < 4; ++t) acc[t] = (f32x4){0.f, 0.f, 0.f, 0.f};
#pragma unroll 2
        for (int ks = 0; ks < 64; ++ks) { const int c0 = 32 * ks + 8 * kq;
            const f32x4 x0 = *(const f32x4*)(xr + c0), x1 = *(const f32x4*)(xr + c0 + 4);
            const f32x4 a0 = *(const f32x4*)(sc2 + c0), a1 = *(const f32x4*)(sc2 + c0 + 4), b0 = *(const f32x4*)(sh2 + c0), b1 = *(const f32x4*)(sh2 + c0 + 4);
            const f32x4 y0 = x0 * (a0 + 1.0f) + b0, y1 = x1 * (a1 + 1.0f) + b1;
            u32x4 hi; hi.x = cvt_pk_bf16(y0[0], y0[1]); hi.y = cvt_pk_bf16(y0[2], y0[3]); hi.z = cvt_pk_bf16(y1[0], y1[1]); hi.w = cvt_pk_bf16(y1[2], y1[3]);
            u32x4 lo; lo.x = cvt_pk_bf16(y0[0] - bflo(hi.x), y0[1] - bfhi(hi.x)); lo.y = cvt_pk_bf16(y0[2] - bflo(hi.y), y0[3] - bfhi(hi.y));
            lo.z = cvt_pk_bf16(y1[0] - bflo(hi.z), y1[1] - bfhi(hi.z)); lo.w = cvt_pk_bf16(y1[2] - bflo(hi.w), y1[3] - bfhi(hi.w));
            const bf16x8 ah = __builtin_bit_cast(bf16x8, hi), al = __builtin_bit_cast(bf16x8, lo);
#pragma unroll
            for (int t = 0; t < 4; ++t) { const bf16x8 bh = frag_rowk_g(RWh + (size_t)(16 * t) * DM + 32 * ks, DM, lane), bl = frag_rowk_g(RWl + (size_t)(16 * t) * DM + 32 * ks, DM, lane);
                acc[t] = MFMA16(ah, bh, acc[t]); acc[t] = MFMA16(al, bh, acc[t]); acc[t] = MFMA16(ah, bl, acc[t]); } }
        LDS_WAIT(); asm volatile("" ::: "memory");
#pragma unroll
        for (int t = 0; t < 4; ++t)
#pragma unroll
            for (int r = 0; r < 4; ++r) Lg[(4 * kq + r) * 65 + 16 * t + fr] = acc[t][r];
        LDS_WAIT(); asm volatile("" ::: "memory");
        if (lane < 16) {
            LAS float* sr = Lg + lane * 65; const int trow = rbase + lane;
            float gs[8];
#pragma unroll
            for (int g = 0; g < 8; ++g) { float m1 = -1e30f, m2 = -1e30f;
                for (int j = 0; j < 8; ++j) { const int e = 8 * g + j; const float s = sigmoidf_(sr[e]); sr[e] = s; const float vv = s + rbias[e];
                    if (vv > m1) { m2 = m1; m1 = vv; } else if (vv > m2) m2 = vv; }
                gs[g] = m1 + m2; }
            unsigned gmask = 0u;
#pragma unroll
            for (int it = 0; it < 4; ++it) { float best = -1e30f; int bi = 0;
#pragma unroll
                for (int g = 0; g < 8; ++g) { const bool ok = !((gmask >> g) & 1u) && gs[g] > best; best = ok ? gs[g] : best; bi = ok ? g : bi; }
                gmask |= 1u << bi; }
            unsigned long long taken = 0ull; int sel[8]; float sw[8]; float wsum = 0.f;
#pragma unroll
            for (int k = 0; k < 8; ++k) { float best = -1e30f; int bi = 0;
                for (int e = 0; e < 64; ++e) { const bool cand = ((gmask >> (e >> 3)) & 1u) && !((taken >> e) & 1ull); const float vv = sr[e] + rbias[e];
                    if (cand && vv > best) { best = vv; bi = e; } }
                taken |= 1ull << bi; sel[k] = bi; sw[k] = sr[bi]; wsum += sw[k]; }
            const float inv = 2.5f / wsum;
#pragma unroll
            for (int k = 0; k < 8; ++k) { const int a = trow * 8 + k; const int pos = atomicAdd(&cnt[sel[k]], 1);
                LIST[(size_t)sel[k] * TT + pos] = a; PK[a] = ((unsigned)sel[k] << 16) | (unsigned)pos; LW[(size_t)sel[k] * TT + pos] = sw[k] * inv; }
            LIST[(size_t)64 * TT + (trow - r0)] = 8 * TT + trow; LW[(size_t)64 * TT + (trow - r0)] = 1.0f;
        }
    }
}
namespace att {
constexpr int D = 128, NW = 8, QBLK = 32, KVBLK = 64;
constexpr float SCALE = 0.088388347648318440f;
constexpr float THR = 8.f;
constexpr int SHM_V = KVBLK * D * 2, SHM_K = KVBLK * D * 2, SHM_ATTN = 2 * SHM_V + 2 * SHM_K + NW * 64 * 4;
#define KSWZ(row, colB) ((row) * 256 + ((colB) ^ (((row) & 7) << 4)))
#define SBAR() __builtin_amdgcn_sched_barrier(0)
__device__ __forceinline__ int crow(int r, int hi) { return (r & 3) + 8 * (r >> 2) + 4 * hi; }
__device__ __forceinline__ unsigned cvtpk(float lo, float hi) { unsigned r; asm volatile("v_cvt_pk_bf16_f32 %0, %1, %2" : "=v"(r) : "v"(lo), "v"(hi)); return r; }

__device__ __forceinline__ void partialSM(f32x16& p0, f32x16& p1, float negMC) {
  constexpr float Cc = SCALE * 1.4426950408889634f;
  for (int r = 0; r < 16; ++r) p0[r] = fmaf(p0[r], Cc, negMC); for (int r = 0; r < 16; ++r) p1[r] = fmaf(p1[r], Cc, negMC);
  for (int r = 0; r < 16; ++r) p0[r] = __builtin_amdgcn_exp2f(p0[r]);
}
__device__ __forceinline__ void finishSM(f32x16& p0, f32x16& p1, float& l_reg, bf16x8& pa0, bf16x8& pa1, bf16x8& pa2, bf16x8& pa3) {
  for (int r = 0; r < 16; ++r) p1[r] = __builtin_amdgcn_exp2f(p1[r]);
  float ps = 0; for (int r = 0; r < 16; ++r) ps += p0[r]; for (int r = 0; r < 16; ++r) ps += p1[r];
  { auto rr = __builtin_amdgcn_permlane32_swap(__float_as_uint(ps), __float_as_uint(ps), false, false);
    ps = __uint_as_float(rr[0]) + __uint_as_float(rr[1]); }
  l_reg += ps;
#define PK4(P, BASE, OUT) do { unsigned a0 = cvtpk(P[BASE + 0], P[BASE + 1]), a1 = cvtpk(P[BASE + 2], P[BASE + 3]);   \
    unsigned b0 = cvtpk(P[BASE + 4], P[BASE + 5]), b1 = cvtpk(P[BASE + 6], P[BASE + 7]);                              \
    auto r0 = __builtin_amdgcn_permlane32_swap(a0, b0, false, false); auto r1 = __builtin_amdgcn_permlane32_swap(a1, b1, false, false); \
    u32x4 w = {r0[0], r1[0], r0[1], r1[1]}; OUT = *reinterpret_cast<bf16x8*>(&w); } while (0)
  PK4(p0, 0, pa0); PK4(p0, 8, pa1); PK4(p1, 0, pa2); PK4(p1, 8, pa3);
#undef PK4
}
__device__ __forceinline__ void qkt(f32x16& p0, f32x16& p1, const LAS char* Ks, const bf16x8* qr, int r32, int hi) {
  p0 = f32x16{}; p1 = f32x16{};
  for (int d0 = 0; d0 < 8; ++d0) { int cb = (d0 * 16 + hi * 8) * 2;
    bf16x8 b0 = *reinterpret_cast<const LAS bf16x8*>(Ks + KSWZ(r32, cb));
    bf16x8 b1 = *reinterpret_cast<const LAS bf16x8*>(Ks + KSWZ(32 + r32, cb));
    p0 = __builtin_amdgcn_mfma_f32_32x32x16_bf16(b0, qr[d0], p0, 0, 0, 0);
    p1 = __builtin_amdgcn_mfma_f32_32x32x16_bf16(b1, qr[d0], p1, 0, 0, 0); }
}
__device__ __forceinline__ int v_st(int k, int c) { const int kk = (k & ~0xC) | ((k & 4) << 1) | ((k & 8) >> 1); return ((kk >> 3) * 4 + (c >> 5)) * 512 + ((kk & 7) * 32 + (c & 31)) * 2; }
__device__ __forceinline__ int v_rd_base(int lane) { return ((lane & 3) << 3) | (((lane >> 2) & 3) << 6) | (((lane >> 4) & 1) << 5) | (((lane >> 5) & 1) << 8); }
constexpr int v_rd_off(int d0, int ks, int half) { return d0 * 512 + ks * 4096 + half * 2048; }
template <int OFF> __device__ __forceinline__ s16x4 tr_read(int vb) {
  s16x4 r; asm volatile("ds_read_b64_tr_b16 %0, %1 offset:%2" : "=&v"(r) : "v"(vb), "i"(OFF) : "memory"); return r;
}
template <int D0> __device__ __forceinline__ void pv_one(f32x16& od, int vb, bf16x8 pa0, bf16x8 pa1, bf16x8 pa2, bf16x8 pa3) {
  const s16x4 l0 = tr_read<v_rd_off(D0, 0, 0)>(vb), h0 = tr_read<v_rd_off(D0, 0, 1)>(vb), l1 = tr_read<v_rd_off(D0, 1, 0)>(vb), h1 = tr_read<v_rd_off(D0, 1, 1)>(vb);
  const s16x4 l2 = tr_read<v_rd_off(D0, 2, 0)>(vb), h2 = tr_read<v_rd_off(D0, 2, 1)>(vb), l3 = tr_read<v_rd_off(D0, 3, 0)>(vb), h3 = tr_read<v_rd_off(D0, 3, 1)>(vb);
  asm volatile("s_waitcnt lgkmcnt(0)" ::: "memory"); SBAR();
#define PK(L, H) (bf16x8){L[0], L[1], L[2], L[3], H[0], H[1], H[2], H[3]}
  od = __builtin_amdgcn_mfma_f32_32x32x16_bf16(pa0, PK(l0, h0), od, 0, 0, 0);
  od = __builtin_amdgcn_mfma_f32_32x32x16_bf16(pa1, PK(l1, h1), od, 0, 0, 0);
  od = __builtin_amdgcn_mfma_f32_32x32x16_bf16(pa2, PK(l2, h2), od, 0, 0, 0);
  od = __builtin_amdgcn_mfma_f32_32x32x16_bf16(pa3, PK(l3, h3), od, 0, 0, 0);
#undef PK
}
__device__ __forceinline__ void pv_d0(f32x16* o, int vb, bf16x8 pa0, bf16x8 pa1, bf16x8 pa2, bf16x8 pa3) {
  pv_one<0>(o[0], vb, pa0, pa1, pa2, pa3); pv_one<1>(o[1], vb, pa0, pa1, pa2, pa3); pv_one<2>(o[2], vb, pa0, pa1, pa2, pa3); pv_one<3>(o[3], vb, pa0, pa1, pa2, pa3);
}

template <int LDQ, int LDK, int LDO>
__device__ __forceinline__ void attn_dense_body(const bf16_t* __restrict__ Qb, const bf16_t* __restrict__ Kh, const bf16_t* __restrict__ Vh, bf16_t* __restrict__ Ob, int seq, LAS char* lds, int tid, float kmax2) {
  const int wid = tid >> 6, lane = tid & 63, r32 = lane & 31, hi = lane >> 5;
  LAS char* V_lds = lds; LAS char* K_lds = lds + 2 * SHM_V;
  LAS float* ws = (LAS float*)(lds + 2 * SHM_V + 2 * SHM_K) + wid * 64; LAS float* li_l = ws;
  float l_reg = 0; f32x16 o[4] = {}; bf16x8 qr[8];
  const bf16_t* Qw = Qb + (long)(wid * QBLK + r32) * LDQ + hi * 8;
#pragma unroll
  for (int d0 = 0; d0 < 8; ++d0) qr[d0] = *reinterpret_cast<const bf16x8*>(Qw + d0 * 16);
  float negMC;
  { float q2 = 0.f;
#pragma unroll
    for (int d0 = 0; d0 < 8; ++d0) { const u32x4 w = __builtin_bit_cast(u32x4, qr[d0]);
      q2 += bflo(w.x) * bflo(w.x) + bfhi(w.x) * bfhi(w.x) + bflo(w.y) * bflo(w.y) + bfhi(w.y) * bfhi(w.y) + bflo(w.z) * bflo(w.z) + bfhi(w.z) * bfhi(w.z) + bflo(w.w) * bflo(w.w) + bfhi(w.w) * bfhi(w.w); }
    auto rr = __builtin_amdgcn_permlane32_swap(__float_as_uint(q2), __float_as_uint(q2), false, false);
    q2 = __uint_as_float(rr[0]) + __uint_as_float(rr[1]);
    negMC = -(sqrtf(q2 * kmax2) * (SCALE * 1.0001f) - 30.0f) * 1.4426950408889634f; }
  const int sr = tid >> 4, sc = (tid & 15) * 8, vst0 = v_st(sr, sc), vst1 = v_st(32 + sr, sc);
  const int vb0 = (int)(uintptr_t)V_lds + v_rd_base(lane);
  struct { bf16x8 vs0, vs1, ks0, ks1; } sr_[2];
#define SLOAD(i, k0) do { sr_[i].vs0 = *reinterpret_cast<const bf16x8*>(&Vh[(long)((k0) + sr) * LDK + sc]); sr_[i].vs1 = *reinterpret_cast<const bf16x8*>(&Vh[(long)((k0) + 32 + sr) * LDK + sc]); \
    sr_[i].ks0 = *reinterpret_cast<const bf16x8*>(&Kh[(long)((k0) + sr) * LDK + sc]); sr_[i].ks1 = *reinterpret_cast<const bf16x8*>(&Kh[(long)((k0) + 32 + sr) * LDK + sc]); } while (0)
#define SWRITE(b, i) do { *(LAS bf16x8*)(V_lds + (b) * SHM_V + vst0) = sr_[i].vs0;          \
    *(LAS bf16x8*)(V_lds + (b) * SHM_V + vst1) = sr_[i].vs1; int kc = sc * 2;               \
    *(LAS bf16x8*)(K_lds + (b) * SHM_K + KSWZ(sr, kc)) = sr_[i].ks0;                       \
    *(LAS bf16x8*)(K_lds + (b) * SHM_K + KSWZ(32 + sr, kc)) = sr_[i].ks1; } while (0)
#define SWAIT() asm volatile("s_waitcnt vmcnt(4)" ::: "memory")
  f32x16 pA0, pA1, pB0, pB1; bf16x8 pa0, pa1, pa2, pa3; const int NT = seq / KVBLK;
  constexpr int SE = 0, SO = 1;
  SLOAD(SE, 0); asm volatile("s_waitcnt vmcnt(0)" ::: "memory"); SWRITE(0, SE); __syncthreads();
  qkt(pA0, pA1, K_lds, qr, r32, hi); partialSM(pA0, pA1, negMC);
  SLOAD(SO, KVBLK); if (2 < NT) SLOAD(SE, 2 * KVBLK);
  SWAIT(); SWRITE(1, SO); __syncthreads();
  for (int j = 1; j + 1 < NT; j += 2) {
    SBAR(); qkt(pB0, pB1, K_lds + SHM_K, qr, r32, hi);
    finishSM(pA0, pA1, l_reg, pa0, pa1, pa2, pa3); SBAR();
    SLOAD(SO, (j + 2) * KVBLK); SBAR();
    pv_d0(o, vb0, pa0, pa1, pa2, pa3); partialSM(pB0, pB1, negMC);
    __syncthreads(); SWAIT(); SWRITE(0, SE);
    __syncthreads();
    SBAR(); qkt(pA0, pA1, K_lds, qr, r32, hi);
    finishSM(pB0, pB1, l_reg, pa0, pa1, pa2, pa3); SBAR();
    if (j + 3 < NT) SLOAD(SE, (j + 3) * KVBLK); SBAR();
    pv_d0(o, vb0 + (int)SHM_V, pa0, pa1, pa2, pa3); partialSM(pA0, pA1, negMC);
    __syncthreads(); SWAIT(); SWRITE(1, SO);
    __syncthreads();
  }
  SBAR(); qkt(pB0, pB1, K_lds + SHM_K, qr, r32, hi);
  finishSM(pA0, pA1, l_reg, pa0, pa1, pa2, pa3); SBAR();
  pv_d0(o, vb0, pa0, pa1, pa2, pa3); partialSM(pB0, pB1, negMC);
  __syncthreads();
  finishSM(pB0, pB1, l_reg, pa0, pa1, pa2, pa3); SBAR();
  pv_d0(o, vb0 + (int)SHM_V, pa0, pa1, pa2, pa3);
  if (hi == 0) li_l[r32] = l_reg; asm volatile("s_waitcnt lgkmcnt(0)" ::: "memory");
  float rli[16];
#pragma unroll
  for (int r = 0; r < 16; ++r) rli[r] = __builtin_amdgcn_rcpf(li_l[crow(r, hi)]);
  bf16_t* Ow = Ob + (long)(wid * QBLK) * LDO;
#pragma unroll
  for (int r = 0; r < 16; ++r) { int orow = crow(r, hi);
    for (int d0 = 0; d0 < 4; ++d0) Ow[(long)orow * LDO + d0 * 32 + r32] = (bf16_t)(cvtpk(o[d0][r] * rli[r], 0.f) & 0xffffu); }
#undef SLOAD
#undef SWRITE
#undef SWAIT
}
#undef KSWZ
}

__device__ __forceinline__ void phase_attention(const Params& p, Ctx& C) {
    const bf16_t* QKV = (const bf16_t*)(p.ws + WS_BIG + BG_QKV); bf16_t* ATT = (bf16_t*)(p.ws + WS_BIG + BG_ATT);
    const unsigned* KMAX = (const unsigned*)(p.ws + WS_CTL) + CW_KMAX;
    const int nunits = 24 * 64;
    for (int i = 0;; ++i) {
        int unit;
        if (C.G == 256) { const int xcd = C.bid & 7, slot = C.bid >> 3; if (i >= 6) break; unit = (xcd * 3 + (i >> 1)) * 64 + (i & 1) * 32 + slot; }
        else { unit = i * C.G + C.bid; if (unit >= nunits) break; }
        const int prob = unit >> 6, qb = unit & 63;
        int qc, kc, vc, oc, kidx;
        if (prob < 8) { qc = 128 * prob; kc = 1024 + 128 * (prob >> 2); vc = 1280 + 128 * (prob >> 2); oc = 128 * prob; kidx = prob >> 2; }
        else { const int d = prob - 8, h = d >> 2, m = (d >> 1) & 1, vh = d & 1; qc = 1536 + 256 * h + 128 * m; kc = 2560 + 256 * h + 128 * m; vc = 3584 + 256 * h + 128 * vh; oc = 1024 + 1024 * m + 256 * h + 128 * vh; kidx = 2 + 2 * h + m; }
        const float kmax2 = __uint_as_float(KMAX[64 * kidx]);
        __syncthreads();
        att::attn_dense_body<OD_IN, OD_IN, 3072>(QKV + (size_t)(CTXL + 256 * qb) * OD_IN + qc, QKV + kc, QKV + vc, ATT + (size_t)(256 * qb) * 3072 + oc, TT, (LAS char*)C.lds, C.tid, kmax2);
    }
    __syncthreads();
}
constexpr int PH_PER_LAYER = 13, N_PHASES = 2 + 2 * PH_PER_LAYER;
#ifndef DBL_PHASE
#define DBL_PHASE -1
#endif
#ifndef MK_PER_PHASE
#define MK_PER_PHASE 0
#endif

template <int L>
__device__ __forceinline__ void layer_body(const Params& p, Ctx& C0, const XcdBarrier& bar, LAS unsigned char* misc, int lo, int hi) {
#define IN(k) (lo <= (k) && (k) < hi)
#define SEAM(k) do { if (IN(k) && IN((k) + 1)) xcd_barrier(bar, C0.wave); } while (0)
#define PHASE(k, ...) if (IN(k)) { FRESH(); __VA_ARGS__ } if (DBL_PHASE == (k)) { xcd_barrier(bar, C0.wave); { FRESH(); __VA_ARGS__ } } SEAM(k);
#define FRESH() Ctx C = C0; { int ln = (int)__builtin_amdgcn_mbcnt_hi(~0u, __builtin_amdgcn_mbcnt_lo(~0u, 0u)); asm volatile("" : "+v"(ln)); C.lane = ln; C.tid = C.wave * 64 + ln; }
        const int b = 2 + PH_PER_LAYER * L;
        bf16_t* QKV = (bf16_t*)(p.ws + WS_BIG + BG_QKV);
        bf16_t* XA = (bf16_t*)(p.ws + WS_XA);
        int* cnt = (int*)(p.ws + WS_CTL) + CW_CNT + L * 128; const int* LIST = (const int*)(p.ws + WS_LIST);
        PHASE(b + 0, phase_modulate(p, C, L); )
        PHASE(b + 1,
            const int N = L ? OD_IN : EV_IN;
            pg8::DenseOrder S; S.init8((const void*)XA, DM, (const void*)(p.ws + (L ? WS_WIN1 : WS_WIN0)), TT, N, DM, C.G, C.bid);
            pg8::EpiStore E{QKV, N, 1.0f / 32.0f};
            pg8::gemm_phase<true>(C.lds, S, E, C.wave);
        )
        PHASE(b + 2, if (L == 0) phase_rope0(p, C); else phase_normrope1(p, C); )
        PHASE(b + 3, if (L == 0) { ret_chunk_kv(p, C); s5_end_states(p, C); } else phase_attention(p, C); )
        PHASE(b + 4, if (L == 0) phase_scans(p, C); else phase_merge1(p, C); )
        if (L == 0) {
            PHASE(b + 5, phase_ret_s5_outputs(p, C, misc); )
            PHASE(b + 6,
                pg8::DenseOrder S; S.init((const bf16_t*)(p.ws + WS_Z), 1024, (const bf16_t*)(p.ws + WS_WGLU), TT, 1024, 1024, C.G, C.bid);
                pg8::EpiGlu E{(const bf16_t*)(p.ws + WS_Z), p.inp(20), (bf16_t*)(p.ws + WS_BIG + BG_MIX)};
                pg8::gemm_phase<false>(C.lds, S, E, C.wave);
            )
        }
        PHASE(b + 7,
            pg8::DenseOrder S;
            if (L == 0) S.init((const bf16_t*)(p.ws + WS_BIG + BG_MIX), DM, (const bf16_t*)(p.ws + WS_WOUT0), TT, DM, DM, C.G, C.bid);
            else S.init((const bf16_t*)(p.ws + WS_BIG + BG_ATT), 3072, (const bf16_t*)(p.ws + WS_WOUT1), SEQ, DM, DM, C.G, C.bid);
            pg8::EpiStore E{(bf16_t*)(p.ws + WS_YMIX) + (L ? (size_t)CTXL * DM : 0), DM, 1.0f};
            pg8::gemm_phase<false>(C.lds, S, E, C.wave);
        )
        PHASE(b + 8, phase_ln1(p, C, L); )
        PHASE(b + 9, phase_router(p, C, L); )
        PHASE(b + 10,
            pg8::MoeOrder<0> S; S.A = (const void*)XA; S.Bt = (const void*)(p.ws + WS_GU); S.list = LIST; S.cnt = cnt; S.ldab = DM; S.kb = DM; S.nN = 4; S.G = C.G; S.c = C.bid; S.bstride = (size_t)1024 * DM;
            S.prep(misc, C.tid);
            pg8::EpiE1 E{(unsigned char*)(p.ws + WS_HX2), S.cn, S.rb};
            pg8::gemm_phase<true>(C.lds, S, E, C.wave);
        )
        PHASE(b + 11,
            pg8::MoeOrder<1> S; S.A = (const void*)(p.ws + WS_HX2); S.Bt = (const void*)(p.ws + WS_DT); S.list = LIST; S.cnt = cnt; S.ldab = EHID; S.kb = EHID; S.nN = 8; S.G = C.G; S.c = C.bid; S.bstride = (size_t)DM * EHID;
            S.prep(misc, C.tid);
            pg8::EpiE2 E{(unsigned char*)(p.ws + WS_BIG + BG_YMOE), (const float*)(p.ws + WS_LW), S.cn, S.rb};
            pg8::gemm_phase<true>(C.lds, S, E, C.wave);
        )
        PHASE(b + 12, phase_combine(p, C, L, misc); )
    #undef IN
#undef SEAM
#undef FRESH
#undef PHASE
}

__global__ void __launch_bounds__(NTHR, 2) mega_fwd(KArgs ka) {
    extern __shared__ __attribute__((aligned(16))) unsigned char lds_raw[];
    Ctx C;
    C.lds = (LAS unsigned char*)lds_raw;
    C.tid = threadIdx.x; C.lane = C.tid & 63; C.wave = __builtin_amdgcn_readfirstlane(C.tid >> 6);
    C.G = gridDim.x; C.bid = blockIdx.x; C.gw = C.bid * NWAVES + C.wave; C.ngw = C.G * NWAVES;
    LAS unsigned char* misc = C.lds + MISC_OFF;
    if (C.tid < 8) ((volatile LAS unsigned*)misc)[C.tid] = 0u;
    Params p; p.out = ka.out; p.ws = ka.ws; p.ph_lo = ka.ph_lo; p.ph_hi = ka.ph_hi; p.ptab = (LAS unsigned long long*)(misc + 1024);
    if (C.tid < 34) p.ptab[C.tid] = (unsigned long long)ka.in[C.tid];
    __syncthreads();
    const int lo = p.ph_lo, hi = p.ph_hi;
    XcdBarrier bar; bar.bar = (unsigned*)(p.ws + WS_CTL) + CW_BAR; bar.x = 0; bar.st = (volatile LAS unsigned*)misc;
    if (hi - lo > 1) bar = xcd_barrier_post((unsigned*)(p.ws + WS_CTL) + CW_BAR, (volatile LAS unsigned*)misc);
#define IN(k) (lo <= (k) && (k) < hi)
#define SEAM(k) do { if (IN(k) && IN((k) + 1)) xcd_barrier(bar, C.wave); } while (0)

    if (IN(0)) { phase_p0(p, C); } SEAM(0);
    if (IN(1)) { phase_p1(p, C); } SEAM(1);
    if (IN(0) && IN(2) && (C.G & 7) == 0) {
        volatile LAS unsigned* st = (volatile LAS unsigned*)misc;
        if (C.tid == 0) { unsigned pre = 0u; const unsigned x = st[3];
            for (unsigned j = 0; j < 16; ++j) { const unsigned cj = xb_ld(&bar.bar[XB_XCNT(j)]); pre += (j < x) ? cj : 0u; }
            st[4] = pre + st[2]; }
        __syncthreads();
        const int vcu = (int)st[4], g8 = C.G >> 3;
        C.bid = __builtin_amdgcn_readfirstlane((vcu % g8) * 8 + vcu / g8); C.gw = C.bid * NWAVES + C.wave;
    }

    layer_body<0>(p, C, bar, misc, lo, hi);
    layer_body<1>(p, C, bar, misc, lo, hi);
#undef IN
#undef SEAM
}

extern "C" void kernel_launch(void* const* d_in, const int* in_sizes, int n_in, void* d_out, int out_size, void* d_ws, size_t ws_size, hipStream_t stream) {
    static int grid = 0;
    if (grid == 0) {
        if (n_in != 34 || out_size != SEQ * DM || ws_size < WS_END) { fprintf(stderr, "kernel_launch: unexpected shapes: n_in %d out %d ws %zu (need %zu)\n", n_in, out_size, ws_size, (size_t)WS_END); grid = -1; return; }
        int dev = 0, cus = 0, per_cu = 0;
        if (hipGetDevice(&dev) != hipSuccess || hipDeviceGetAttribute(&cus, hipDeviceAttributeMultiprocessorCount, dev) != hipSuccess) { grid = -1; return; }
        if (hipFuncSetAttribute((const void*)mega_fwd, hipFuncAttributeMaxDynamicSharedMemorySize, LDS_BYTES) != hipSuccess) { fprintf(stderr, "kernel_launch: hipFuncSetAttribute failed\n"); grid = -1; return; }
        if (hipOccupancyMaxActiveBlocksPerMultiprocessor(&per_cu, (const void*)mega_fwd, NTHR, LDS_BYTES) != hipSuccess || per_cu < 1) { fprintf(stderr, "kernel_launch: occupancy query says %d blocks per CU\n", per_cu); grid = -1; return; }
        (void)hipGetLastError();
        grid = cus;
    }
    if (grid < 0) return;
    (void)hipMemsetAsync((char*)d_ws + WS_CTL, 0, CTL_BYTES, stream);
    KArgs p{};
    for (int i = 0; i < 34; ++i) p.in[i] = (const float*)d_in[i];
    p.out = (float*)d_out; p.ws = (unsigned char*)d_ws;
#if MK_PER_PHASE
    for (int ph = 0; ph < N_PHASES; ++ph) {
        if (ph == 2 + PH_PER_LAYER + 5 || ph == 2 + PH_PER_LAYER + 6) continue;
        p.ph_lo = ph; p.ph_hi = ph + 1;
        hipLaunchKernelGGL(mega_fwd, dim3(grid), dim3(NTHR), LDS_BYTES, stream, p);
    }
#else
    p.ph_lo = 0; p.ph_hi = N_PHASES;
    hipLaunchKernelGGL(mega_fwd, dim3(grid), dim3(NTHR), LDS_BYTES, stream, p);
#endif
    const hipError_t le = hipPeekAtLastError();
    if (le != hipSuccess) fprintf(stderr, "kernel_launch: launch failed: %s\n", hipGetErrorName(le));
}
```

```cpp
#define MK_PER_PHASE 0
#include <hip/hip_runtime.h>
#include <cstdio>
#include <cstdint>

#define GAS __attribute__((address_space(1)))
#define LAS __attribute__((address_space(3)))
typedef unsigned short bf16_t;
typedef short bf16x8 __attribute__((ext_vector_type(8)));
typedef short s16x4 __attribute__((ext_vector_type(4)));
typedef float f32x4 __attribute__((ext_vector_type(4)));
typedef float f32x2 __attribute__((ext_vector_type(2)));
typedef float f32x16 __attribute__((ext_vector_type(16)));
typedef unsigned u32x4 __attribute__((ext_vector_type(4)));
typedef unsigned u32x2 __attribute__((ext_vector_type(2)));

constexpr int DM = 2048, SEQ = 16384, CTXL = 256, TT = SEQ + CTXL;
constexpr int NEXP = 64, NEX1 = 65, EHID = 512, TOPK = 8;
constexpr int EV_IN = 5120, OD_IN = 4608;
constexpr float LN_EPS = 1e-6f;
constexpr float ALPHA = 1.4142135623730951f;
constexpr float LAMBDA_INIT = 0.35550906759f;
constexpr int NTHR = 512, NWAVES = 8;

constexpr size_t al256(size_t x) { return (x + 255) / 256 * 256; }
constexpr size_t WS_CTL   = 0;
constexpr size_t CTL_BYTES = 1u << 20;
constexpr size_t WS_MODP  = WS_CTL + CTL_BYTES;
constexpr size_t WS_MODF  = WS_MODP + al256((size_t)2 * 32 * 2 * 12288 * 4);
constexpr size_t WS_ROPE128 = WS_MODF + al256((size_t)2 * 2 * 12288 * 4);
constexpr size_t WS_ROPE64  = WS_ROPE128 + al256((size_t)256 * 64 * 2 * 4);
constexpr size_t WS_KN    = WS_ROPE64 + al256((size_t)256 * 32 * 2 * 4);
constexpr size_t WS_WT    = WS_KN + al256((size_t)2 * 64 * 16 * 1024 * 2);
constexpr size_t WS_APOW  = WS_WT + al256((size_t)2 * 64 * 128 * 1024 * 2);
constexpr size_t WS_AL    = WS_APOW + al256((size_t)2 * 64 * 64 * 128 * 4);
constexpr size_t WS_CC    = WS_AL + al256((size_t)2 * 64 * 128 * 4);
constexpr size_t WS_S5E   = WS_CC + al256((size_t)64 * 16 * 128 * 2);
constexpr size_t WS_HST   = WS_S5E + al256((size_t)2 * 64 * 260 * 128 * 4);
constexpr size_t WS_WIN0  = WS_HST + al256((size_t)2 * 64 * 260 * 128 * 4);
constexpr size_t WS_WOUT0 = WS_WIN0 + al256((size_t)EV_IN * DM * 2);
constexpr size_t WS_WGLU  = WS_WOUT0 + al256((size_t)DM * DM * 2);
constexpr size_t WS_WIN1  = WS_WGLU + al256((size_t)1024 * 1024 * 2);
constexpr size_t WS_WOUT1 = WS_WIN1 + al256((size_t)OD_IN * DM * 2);
constexpr size_t WS_RWT   = WS_WOUT1 + al256((size_t)DM * DM * 2);
constexpr size_t WS_GU    = WS_RWT + al256((size_t)2 * 2 * 64 * DM * 2);
constexpr size_t WS_DT    = WS_GU + al256((size_t)NEX1 * 1024 * DM * 2);
constexpr size_t WS_XA    = WS_DT + al256((size_t)NEX1 * DM * EHID * 2);
constexpr size_t WS_Z     = WS_XA + al256((size_t)TT * DM * 2);
constexpr size_t WS_YMIX  = WS_Z + al256((size_t)TT * 1024 * 2);
constexpr size_t WS_X1    = WS_YMIX + al256((size_t)TT * DM * 2);
constexpr size_t WS_HX2   = WS_X1 + al256((size_t)TT * DM * 4);
constexpr size_t WS_LIST  = WS_HX2 + al256((size_t)9 * TT * EHID * 2);
constexpr size_t WS_WGT   = WS_LIST + al256((size_t)NEX1 * TT * 4);
constexpr size_t WS_LW    = WS_WGT + al256((size_t)8 * TT * 4);
constexpr size_t WS_BIG   = WS_LW + al256((size_t)NEX1 * TT * 4);
constexpr size_t BG_QKV   = 0;
constexpr size_t BG_CKV   = BG_QKV + al256((size_t)TT * EV_IN * 2);
constexpr size_t BG_SPREV = BG_CKV + al256((size_t)8 * 130 * 65536 * 4);
constexpr size_t BG_MIX   = BG_SPREV + al256((size_t)8 * 130 * 65536 * 2);
constexpr size_t BG_END0  = BG_MIX + al256((size_t)TT * DM * 2);
constexpr size_t BG_ATT   = BG_CKV;
constexpr size_t BG_YMOE  = 0;
constexpr size_t BG_END1  = al256((size_t)9 * TT * DM * 2);
constexpr size_t BG_SIZE  = BG_END0 > BG_END1 ? BG_END0 : BG_END1;
constexpr size_t WS_END   = WS_BIG + BG_SIZE;

constexpr int CW_BAR = 4096;
constexpr int CW_CNT = 16384;
constexpr int CW_QUEUE = 20480;
constexpr int CW_KMAX = 24576;

constexpr int RING_BYTES = 151552;
constexpr int MISC_OFF = RING_BYTES;
constexpr int LDS_BYTES = 159744;

typedef __bf16 bf16x2_t __attribute__((ext_vector_type(2)));
__device__ __forceinline__ unsigned cvt_pk_bf16(float lo, float hi) { const f32x2 v = {lo, hi}; return __builtin_bit_cast(unsigned, __builtin_convertvector(v, bf16x2_t)); }
__device__ __forceinline__ bf16_t f2bf(float f) { unsigned u = __builtin_bit_cast(unsigned, f); return (bf16_t)((u + 0x7fffu + ((u >> 16) & 1u)) >> 16); }
__device__ __forceinline__ float bf2f(bf16_t b) { return __builtin_bit_cast(float, ((unsigned)b) << 16); }
__device__ __forceinline__ float bflo(unsigned w) { return __builtin_bit_cast(float, w << 16); }
__device__ __forceinline__ float bfhi(unsigned w) { return __builtin_bit_cast(float, w & 0xffff0000u); }
__device__ __forceinline__ float wave_sum(float v) {
#pragma unroll
    for (int o = 1; o < 64; o <<= 1) v += __shfl_xor(v, o);
    return v;
}
__device__ __forceinline__ float fast_exp(float x) { return __builtin_amdgcn_exp2f(x * 1.4426950408889634f); }
__device__ __forceinline__ float sigmoidf_(float x) { return 1.0f / (1.0f + __expf(-x)); }
__device__ __forceinline__ float siluf_(float x) { return x / (1.0f + __expf(-x)); }
__device__ __forceinline__ float gelu_tanh(float x) {
    const float u = 0.7978845608028654f * (x + 0.044715f * x * x * x);
    const float e = __expf(2.0f * u);
    const float t = 1.0f - 2.0f / (e + 1.0f);
    return 0.5f * x * (1.0f + t);
}
#define LDS_WAIT() asm volatile("s_waitcnt lgkmcnt(0)" ::: "memory")
#define VM_WAIT() asm volatile("s_waitcnt vmcnt(0)" ::: "memory")

#define XB_TMO      128
#define XB_XCNT(j)  (256  + 64 * (j))
#define XB_XSUB(j)  (1280 + 64 * (j))
#define XB_XGEN(j)  (2304 + 64 * (j))
#define XB_TOP      3328
#define XB_TOPGEN   3392
#define XCD_BAR_WORDS 3456
#define XB_SPIN_CAP (1u << 22)

__device__ __forceinline__ unsigned xb_ld(unsigned* p)              { return __hip_atomic_load(p, __ATOMIC_RELAXED, __HIP_MEMORY_SCOPE_AGENT); }
__device__ __forceinline__ unsigned xb_add(unsigned* p, unsigned v) { return __hip_atomic_fetch_add(p, v, __ATOMIC_RELAXED, __HIP_MEMORY_SCOPE_AGENT); }
__device__ __forceinline__ unsigned xb_xcc_id() { return (unsigned)__builtin_amdgcn_s_getreg((3 << 11) | 20) & 0xFu; }
#define XB_SPIN(cond, bar) do { unsigned _sp = 0; while (cond) { __builtin_amdgcn_s_sleep(1); \
    if ((++_sp & 255u) == 0u) { if (xb_ld(&(bar)[XB_TMO])) break; if (_sp > XB_SPIN_CAP) { atomicAdd(&(bar)[XB_TMO], 1u); break; } } } } while (0)

struct XcdBarrier { unsigned* bar; unsigned x; volatile LAS unsigned* st; };

__device__ __forceinline__ XcdBarrier xcd_barrier_post(unsigned* bar, volatile LAS unsigned* st) {
    XcdBarrier b; b.bar = bar; b.x = xb_xcc_id(); b.st = st;
    if (threadIdx.x == 0) { st[2] = xb_add(&bar[XB_XCNT(b.x)], 1u); st[3] = b.x; }
    return b;
}
__device__ __forceinline__ void xcd_barrier_complete(unsigned* bar, unsigned x, unsigned& nloc, unsigned& nx) {
    const unsigned G = gridDim.x * gridDim.y * gridDim.z;
    unsigned sum, cnt, mine, sp = 0u;
    for (;;) {
        sum = 0u; cnt = 0u; mine = 0u;
#pragma unroll
        for (unsigned j = 0; j < 16; ++j) { const unsigned c = xb_ld(&bar[XB_XCNT(j)]); sum += c; cnt += (c > 0u) ? 1u : 0u; mine = (j == x) ? c : mine; }
        if (sum == G) break;
        __builtin_amdgcn_s_sleep(1);
        if ((++sp & 255u) == 0u) { if (xb_ld(&bar[XB_TMO])) break; if (sp > XB_SPIN_CAP) { atomicAdd(&bar[XB_TMO], 1u); break; } }
    }
    nloc = mine > 0u ? mine : 1u; nx = cnt > 0u ? cnt : 1u;
}
__device__ __forceinline__ void xcd_barrier(const XcdBarrier& b, int wave_id) {
    const bool leader_thread = (wave_id == 0) && (__builtin_amdgcn_mbcnt_hi(~0u, __builtin_amdgcn_mbcnt_lo(~0u, 0u)) == 0u);
    asm volatile("s_waitcnt vmcnt(0)" ::: "memory");
    __syncthreads();
    if (leader_thread) {
        unsigned* bar = b.bar;
        __builtin_amdgcn_s_waitcnt(0);
        unsigned nloc = b.st[0], nx = b.st[1];
        if (nloc == 0u) { xcd_barrier_complete(bar, b.x, nloc, nx); b.st[0] = nloc; b.st[1] = nx; }
        const unsigned old = xb_add(&bar[XB_XSUB(b.x)], 1u);
        const unsigned gen = old / nloc;
        if (old + 1u == (gen + 1u) * nloc) {
            __builtin_amdgcn_fence(__ATOMIC_RELEASE, "agent");
            asm volatile("s_waitcnt vmcnt(0)" ::: "memory");
            const unsigned og = xb_add(&bar[XB_TOP], 1u);
            const unsigned tg = og / nx;
            if (og + 1u == (tg + 1u) * nx) xb_add(&bar[XB_TOPGEN], 1u);
            else XB_SPIN(xb_ld(&bar[XB_TOPGEN]) == tg, bar);
            __builtin_amdgcn_fence(__ATOMIC_ACQUIRE, "agent");
            xb_add(&bar[XB_XGEN(b.x)], 1u);
            asm volatile("s_waitcnt vmcnt(0)" ::: "memory");
        } else {
            XB_SPIN(xb_ld(&bar[XB_XGEN(b.x)]) == gen, bar);
            __builtin_amdgcn_fence(__ATOMIC_ACQUIRE, "agent");
            asm volatile("s_waitcnt vmcnt(0)" ::: "memory");
        }
    }
    __syncthreads();
}

__device__ __forceinline__ bf16x8 frag_rowk_l(const LAS bf16_t* p, int ld, int lane) {
    return *(const LAS bf16x8*)(p + (lane & 15) * ld + (lane >> 4) * 8);
}
__device__ __forceinline__ bf16x8 frag_rowk_g(const bf16_t* p, long ld, int lane) {
    return *(const bf16x8*)(p + (long)(lane & 15) * ld + (lane >> 4) * 8);
}
__device__ __forceinline__ bf16x8 frag_colk_l(unsigned p, int ldb, int lane) {
    const unsigned a0 = p + (unsigned)((8 * (lane >> 4) + ((lane & 15) >> 2)) * ldb + (lane & 3) * 8);
    const unsigned a1 = a0 + 4u * (unsigned)ldb;
    s16x4 lo, hi;
    asm volatile("ds_read_b64_tr_b16 %0, %2\n\tds_read_b64_tr_b16 %1, %3\n\ts_waitcnt lgkmcnt(0)" : "=&v"(lo), "=&v"(hi) : "v"(a0), "v"(a1) : "memory");
    return (bf16x8){lo[0], lo[1], lo[2], lo[3], hi[0], hi[1], hi[2], hi[3]};
}
#define MFMA16(a, b, c) __builtin_amdgcn_mfma_f32_16x16x32_bf16((a), (b), (c), 0, 0, 0)
namespace pg8 {
constexpr int BM = 256, BK = 64, HALF = 128, HTB = HALF * BK * 2, STAGE_BYTES = 8 * HTB, NXCD = 8, WGM = 8;
__device__ __forceinline__ int lds_byte(int r, int c) { const int st = (r >> 4) * 2 + (c >> 5), rr = r & 15, cc = c & 31, ob = rr * 64 + cc * 2; return st * 1024 + (ob ^ (((ob >> 9) & 1) << 5)); }
__device__ __forceinline__ void stage_rc(int b, int& R, int& C) { const int st = b / 1024, sb = b % 1024, swz = sb ^ (((sb >> 9) & 1) << 5); R = (st >> 1) * 16 + swz / 64; C = (st & 1) * 32 + (swz % 64) / 2; }
__device__ __forceinline__ int perm32(int rho) { const int n = rho >> 4, i = rho & 15; return 8 * (i >> 2) + 4 * n + (i & 3); }

struct Unit { int pm, pn, e; };
constexpr float WSCALE = 32.0f, WSCALE_INV = 1.0f / 32.0f;

struct DenseOrder {
    const bf16_t* A; const bf16_t* Bt; int ldab, kb, nM, nN, nwg, G, c;
    __device__ __forceinline__ void init(const bf16_t* A_, int lda_, const bf16_t* Bt_, int M, int N, int K_, int G_, int c_) { A = A_; ldab = lda_ * 2; Bt = Bt_; kb = K_ * 2; nM = M / BM; nN = N / BM; nwg = nM * nN; G = G_; c = c_; }
    __device__ __forceinline__ void init8(const void* A_, int ldab_, const void* Bt_, int M, int N, int K_, int G_, int c_) { A = (const bf16_t*)A_; ldab = ldab_; Bt = (const bf16_t*)Bt_; kb = K_; nM = M / BM; nN = N / BM; nwg = nM * nN; G = G_; c = c_; }
    __device__ __forceinline__ void prep(LAS unsigned char*) const {}
    __device__ __forceinline__ bool next(int i, Unit& u) const {
        const long L = (long)i * G + c; if (L >= nwg) return false;
        int wgid = (int)L; { const int q = nwg / NXCD, r = nwg % NXCD, xcd = wgid % NXCD, off = wgid / NXCD; wgid = (xcd < r ? xcd * (q + 1) : r * (q + 1) + (xcd - r) * q) + off; }
        const int nig = WGM * nN, gid = wgid / nig, fm = gid * WGM, gsz = (nM - fm) < WGM ? (nM - fm) : WGM;
        u.pm = fm + ((wgid % nig) % gsz); u.pn = (wgid % nig) / gsz; u.e = 0; return true;
    }
    __device__ __forceinline__ const char* a_base() const { return (const char*)A; }
    __device__ __forceinline__ unsigned a_off(const Unit& u, int r) const { return (unsigned)(u.pm * BM + r) * (unsigned)ldab; }
    __device__ __forceinline__ const char* b_ptr(const Unit& u) const { return (const char*)Bt + (size_t)u.pn * BM * kb; }
};

template <int MODE  >
struct MoeOrder {
    const void* A; const void* Bt; const int* list; const int* cnt; int ldab, kb, nN, G, c; size_t bstride;
    LAS int* tp; LAS int* cn; LAS int* rb;
    __device__ __forceinline__ void prep(LAS unsigned char* misc, int tid) {
        tp = (LAS int*)(misc + 64); cn = tp + 72; rb = cn + 72;
        if (tid < NEX1) cn[tid] = cnt[tid];
        __syncthreads();
        if (tid == 0) { int s = 0, q = 0; for (int e = 0; e < NEX1; ++e) { tp[e] = s; rb[e] = q; s += (cn[e] + BM - 1) / BM; q += cn[e]; } tp[NEX1] = s; rb[NEX1] = q; }
        __syncthreads();
    }
    __device__ __forceinline__ bool next(int i, Unit& u) const {
        const int total = tp[NEX1]; const long nu = (long)total * nN; const int per = (int)((nu + G - 1) / G);
        const int vc = ((G & 7) == 0) ? (c & 7) * (G >> 3) + (c >> 3) : c;
        const long L = (long)vc * per + i;
        if (i >= per || L >= nu) return false;
        const int tile = (int)(L / nN); u.pn = (int)(L % nN);
        int e = 0;
        for (int k = 1; k < NEX1; ++k) e += (tp[k] <= tile) ? 1 : 0;
        u.e = e; u.pm = tile - tp[e]; return true;
    }
    __device__ __forceinline__ const char* a_base() const { return (const char*)A; }
    __device__ __forceinline__ unsigned a_off(const Unit& u, int r) const {
        int pos = u.pm * BM + r; const int n = cn[u.e]; pos = pos < n ? pos : n - 1;
        if (MODE == 1) return (unsigned)(rb[u.e] + pos) * (unsigned)ldab;
        const int a = list[u.e * TT + pos];
        const int row = a < 8 * TT ? (a >> 3) : a - 8 * TT;
        return (unsigned)row * (unsigned)ldab;
    }
    __device__ __forceinline__ const char* b_ptr(const Unit& u) const { return (const char*)Bt + (size_t)u.e * bstride + (size_t)u.pn * BM * kb; }
};

typedef int v8i32 __attribute__((ext_vector_type(8)));
typedef int v4i32_ __attribute__((ext_vector_type(4)));
__device__ __forceinline__ v8i32 cat8(bf16x8 a, bf16x8 b) { const u32x4 x = __builtin_bit_cast(u32x4, a), y = __builtin_bit_cast(u32x4, b); return (v8i32){(int)x.x, (int)x.y, (int)x.z, (int)x.w, (int)y.x, (int)y.y, (int)y.z, (int)y.w}; }
template <bool FP8, class Epi, class Sched>
__device__ __forceinline__ void gemm_phase(LAS unsigned char* lds, const Sched& S, const Epi& E, int wave_id) {
    const int wid = wave_id; int lane = (int)__builtin_amdgcn_mbcnt_hi(~0u, __builtin_amdgcn_mbcnt_lo(~0u, 0u)); asm volatile("" : "+v"(lane));
    const int tid = wid * 64 + lane, wr = wid >> 2, wc = wid & 3, fr = lane & 15, fq = lane >> 4;
    const int kb = S.kb; int nt = kb / 128; asm volatile("" : "+s"(nt));
    unsigned voffB[2];
#pragma unroll
    for (int i = 0; i < 2; ++i) { int R, C; stage_rc(tid * 16 + i * 8192, R, C); const int Rb = (R & ~31) + perm32(R & 31);
        voffB[i] = (unsigned)(Rb * kb) + (unsigned)C * 2u; }
#define PG8_AOFF(u, h, i) ({ int _tz = tid; asm volatile("" : "+v"(_tz)); int _R, _C; stage_rc(_tz * 16 + (i) * 8192, _R, _C); S.a_off((u), (h) * HALF + _R) + (unsigned)_C * 2u; })
    const size_t kstep = (size_t)(BK * 2);
    const size_t hstepB = (size_t)HALF * kb;
    const unsigned ldsw = (unsigned)wid * 1024u;
    const int aoff = lds_byte(wr * 64 + fr, fq * 8), boff = lds_byte(wc * 32 + fr, fq * 8);
#define PG8_SA(b, h) (((b) * 2 + (h)) * HTB)
#define PG8_SB(b, h) ((4 + (b) * 2 + (h)) * HTB)
#define PG8_STAGE(bufoff, gbase, v0, v1) do { \
        __builtin_amdgcn_global_load_lds((const unsigned*)((const char*)(gbase) + (v0)), (LAS unsigned*)(lds + (bufoff) + ldsw), 16, 0, 0); \
        __builtin_amdgcn_global_load_lds((const unsigned*)((const char*)(gbase) + (v1)), (LAS unsigned*)(lds + (bufoff) + ldsw + 8192), 16, 0, 0); } while (0)
#define PG8_VOFFB(i) ({ int _tz = tid; asm volatile("" : "+v"(_tz)); int _R, _C; stage_rc(_tz * 16 + (i) * 8192, _R, _C); (unsigned)(((_R & ~31) + perm32(_R & 31)) * kb) + (unsigned)_C * 2u; })
#define PG8_STAGE_B(bufoff, gbase) do { if constexpr (FP8) { const unsigned _v0 = PG8_VOFFB(0), _v1 = PG8_VOFFB(1); PG8_STAGE(bufoff, gbase, _v0, _v1); } else PG8_STAGE(bufoff, gbase, voffB[0], voffB[1]); } while (0)
#define PG8_LD8(off) __builtin_shufflevector(*(const LAS v4i32_*)(lds + (off)), *(const LAS v4i32_*)(lds + (off) + 1024), 0, 1, 2, 3, 4, 5, 6, 7)
#define PG8_LDA(dst, b, h) do { _Pragma("unroll") for (int m = 0; m < 4; ++m) { if constexpr (FP8) dst##8[m] = PG8_LD8(PG8_SA(b, h) + aoff + m * 2048); else { _Pragma("unroll") for (int k = 0; k < 2; ++k) dst[m][k] = *(const LAS bf16x8*)(lds + PG8_SA(b, h) + aoff + m * 2048 + k * 1024); } } } while (0)
#define PG8_LDB(dst, b, h) do { _Pragma("unroll") for (int n = 0; n < 2; ++n) { if constexpr (FP8) dst##8[n] = PG8_LD8(PG8_SB(b, h) + boff + n * 2048); else { _Pragma("unroll") for (int k = 0; k < 2; ++k) dst[n][k] = *(const LAS bf16x8*)(lds + PG8_SB(b, h) + boff + n * 2048 + k * 1024); } } } while (0)
#define PG8_MMA(ai, bj, At, Bt) do { __builtin_amdgcn_s_setprio(1); _Pragma("unroll") for (int m = 0; m < 4; ++m) _Pragma("unroll") for (int n = 0; n < 2; ++n) { \
        if constexpr (FP8) asm volatile("v_mfma_f32_16x16x128_f8f6f4 %0, %1, %2, %0" : "+v"(acc[ai][bj][m][n]) : "v"(Bt##8[n]), "v"(At##8[m])); \
        else { _Pragma("unroll") for (int k = 0; k < 2; ++k) acc[ai][bj][m][n] = __builtin_amdgcn_mfma_f32_16x16x32_bf16(Bt[n][k], At[m][k], acc[ai][bj][m][n], 0, 0, 0); } } \
        __builtin_amdgcn_s_setprio(0); } while (0)
#define PG8_WAIT_V(n) asm volatile("s_waitcnt vmcnt(" #n ")" ::: "memory")
#define PG8_WAIT_L(n) asm volatile("s_waitcnt lgkmcnt(" #n ")" ::: "memory")
#define PG8_BAR __builtin_amdgcn_s_barrier()
#define PG8_SCHED __builtin_amdgcn_sched_barrier(0)
    Unit cur, nxt; int ui = 0;
    if (!S.next(0, cur)) return;
    f32x4 acc[2][2][4][2];
#pragma unroll
    for (int a = 0; a < 2; ++a)
#pragma unroll
        for (int b = 0; b < 2; ++b)
#pragma unroll
            for (int m = 0; m < 4; ++m)
#pragma unroll
                for (int n = 0; n < 2; ++n) acc[a][b][m][n] = (f32x4){0.f, 0.f, 0.f, 0.f};
    bf16x8 At[4][2], B0[2][2], B1[2][2]; v8i32 At8[4], B08[2], B18[2];
    const char* const gA = S.a_base();
    const char* cB = S.b_ptr(cur);
    unsigned oc00, oc01, oc10, oc11;
    oc00 = PG8_AOFF(cur, 0, 0); oc01 = PG8_AOFF(cur, 0, 1); oc10 = PG8_AOFF(cur, 1, 0); oc11 = PG8_AOFF(cur, 1, 1);
    PG8_STAGE_B(PG8_SB(0, 0), cB); PG8_STAGE_B(PG8_SB(0, 1), cB + hstepB); PG8_STAGE(PG8_SA(0, 0), gA, oc00, oc01); PG8_STAGE(PG8_SA(0, 1), gA, oc10, oc11);
    if (wr == 1) PG8_BAR;
    PG8_WAIT_V(2); PG8_BAR;
    PG8_STAGE_B(PG8_SB(1, 0), cB + kstep); PG8_STAGE(PG8_SA(1, 0), gA + kstep, oc00, oc01); PG8_STAGE_B(PG8_SB(1, 1), cB + hstepB + kstep);
    PG8_WAIT_V(6); PG8_BAR;
    for (;;) {
        const bool has_next = S.next(ui + 1, nxt);
        const char* nB = cB;
        {
            u32x4 on = {oc00, oc01, oc10, oc11};
            if (has_next) { on.x = PG8_AOFF(nxt, 0, 0); on.y = PG8_AOFF(nxt, 0, 1); on.z = PG8_AOFF(nxt, 1, 0); on.w = PG8_AOFF(nxt, 1, 1); nB = S.b_ptr(nxt); }
            *(LAS u32x4*)(lds + STAGE_BYTES + tid * 16) = on;
        }
        for (int t = 0; t < nt; t += 2) {
            const bool last = (t == nt - 2);
            const char* a1 = gA + (size_t)(t + 1) * kstep;
            const char* a2 = last ? gA : gA + (size_t)(t + 2) * kstep; const char* b2 = last ? nB : cB + (size_t)(t + 2) * kstep;
            const char* a3 = a2 + kstep; const char* b3 = b2 + kstep;
            unsigned s00 = oc00, s01 = oc01, s10 = oc10, s11 = oc11;
            if (last) { const u32x4 on = *(const LAS u32x4*)(lds + STAGE_BYTES + tid * 16); s00 = on.x; s01 = on.y; s10 = on.z; s11 = on.w; }
            PG8_LDB(B0, 0, 0); PG8_LDB(B1, 0, 1); PG8_SCHED; PG8_LDA(At, 0, 0); PG8_STAGE(PG8_SA(1, 1), a1, oc10, oc11);
            PG8_WAIT_V(8); PG8_WAIT_L(0); PG8_BAR; PG8_MMA(0, 0, At, B0); PG8_MMA(0, 1, At, B1); PG8_BAR; PG8_SCHED;
            PG8_LDA(At, 0, 1); PG8_STAGE_B(PG8_SB(0, 0), b2); PG8_STAGE_B(PG8_SB(0, 1), b2 + hstepB); PG8_STAGE(PG8_SA(0, 0), a2, s00, s01);
            PG8_WAIT_V(8); PG8_WAIT_L(0); PG8_BAR; PG8_MMA(1, 0, At, B0); PG8_MMA(1, 1, At, B1); PG8_BAR; PG8_SCHED;
            PG8_LDB(B0, 1, 0); PG8_LDB(B1, 1, 1); PG8_SCHED; PG8_LDA(At, 1, 0); PG8_STAGE(PG8_SA(0, 1), a2, s10, s11);
            PG8_WAIT_V(8); PG8_WAIT_L(0); PG8_BAR; PG8_MMA(0, 0, At, B0); PG8_MMA(0, 1, At, B1); PG8_BAR; PG8_SCHED;
            PG8_LDA(At, 1, 1); PG8_STAGE_B(PG8_SB(1, 0), b3); PG8_STAGE_B(PG8_SB(1, 1), b3 + hstepB); PG8_STAGE(PG8_SA(1, 0), a3, s00, s01);
            PG8_WAIT_V(8); PG8_WAIT_L(0); PG8_BAR; PG8_MMA(1, 0, At, B0); PG8_MMA(1, 1, At, B1); PG8_BAR; PG8_SCHED;
        }
        if (wr == 0) PG8_BAR;
        E(acc, cur, wr, wc, fr, fq);
        if (!has_next) break;
#pragma unroll
        for (int a = 0; a < 2; ++a)
#pragma unroll
            for (int b = 0; b < 2; ++b)
#pragma unroll
                for (int m = 0; m < 4; ++m)
#pragma unroll
                    for (int n = 0; n < 2; ++n) acc[a][b][m][n] = (f32x4){0.f, 0.f, 0.f, 0.f};
        { const u32x4 on = *(const LAS u32x4*)(lds + STAGE_BYTES + tid * 16); oc00 = on.x; oc01 = on.y; oc10 = on.z; oc11 = on.w; }
        cur = nxt; cB = nB; ++ui;
        if (wr == 1) PG8_BAR;
    }
    PG8_WAIT_V(0);
    PG8_BAR;
#undef PG8_SA
#undef PG8_SB
#undef PG8_STAGE
#undef PG8_STAGE_B
#undef PG8_AOFF
#undef PG8_VOFFB
#undef PG8_LD8
#undef PG8_LDA
#undef PG8_LDB
#undef PG8_MMA
#undef PG8_WAIT_V
#undef PG8_WAIT_L
#undef PG8_BAR
#undef PG8_SCHED
}

struct EpiStore {
    bf16_t* O; int ldc; float scale;
    __device__ __forceinline__ void operator()(const f32x4 (&acc)[2][2][4][2], const Unit& u, int wr, int wc, int fr, int fq) const {
        const int row0 = u.pm * BM + wr * 64 + fr, col0 = u.pn * BM + wc * 32 + 8 * fq;
#pragma unroll
        for (int ai = 0; ai < 2; ++ai)
#pragma unroll
            for (int m = 0; m < 4; ++m) { bf16_t* rowp = O + (size_t)(row0 + ai * HALF + m * 16) * ldc + col0;
#pragma unroll
                for (int bj = 0; bj < 2; ++bj) { const f32x4 v0 = acc[ai][bj][m][0] * scale, v1 = acc[ai][bj][m][1] * scale;
                    u32x4 w; w.x = cvt_pk_bf16(v0[0], v0[1]); w.y = cvt_pk_bf16(v0[2], v0[3]); w.z = cvt_pk_bf16(v1[0], v1[1]); w.w = cvt_pk_bf16(v1[2], v1[3]);
                    *(u32x4*)(rowp + bj * HALF) = w; } }
    }
};
struct EpiGlu {
    const bf16_t* Z; const float* b; bf16_t* MIX;
    __device__ __forceinline__ void operator()(const f32x4 (&acc)[2][2][4][2], const Unit& u, int wr, int wc, int fr, int fq) const {
        const int row0 = u.pm * BM + wr * 64 + fr, col0 = u.pn * BM + wc * 32 + 8 * fq;
#pragma unroll
        for (int bj = 0; bj < 2; ++bj) {
            const f32x4 b0 = *(const f32x4*)(b + col0 + bj * HALF), b1 = *(const f32x4*)(b + col0 + bj * HALF + 4);
#pragma unroll
            for (int ai = 0; ai < 2; ++ai)
#pragma unroll
                for (int m = 0; m < 4; ++m) { const size_t row = (size_t)(row0 + ai * HALF + m * 16);
                    const u32x4 zz = *(const u32x4*)(Z + row * 1024 + col0 + bj * HALF);
                    const f32x4 v0 = acc[ai][bj][m][0] + b0, v1 = acc[ai][bj][m][1] + b1;
                    u32x4 w;
                    w.x = cvt_pk_bf16(bflo(zz.x) * sigmoidf_(v0[0]), bfhi(zz.x) * sigmoidf_(v0[1]));
                    w.y = cvt_pk_bf16(bflo(zz.y) * sigmoidf_(v0[2]), bfhi(zz.y) * sigmoidf_(v0[3]));
                    w.z = cvt_pk_bf16(bflo(zz.z) * sigmoidf_(v1[0]), bfhi(zz.z) * sigmoidf_(v1[1]));
                    w.w = cvt_pk_bf16(bflo(zz.w) * sigmoidf_(v1[2]), bfhi(zz.w) * sigmoidf_(v1[3]));
                    *(u32x4*)(MIX + row * DM + 1024 + col0 + bj * HALF) = w; }
        }
    }
};
struct EpiE1 {
    unsigned char* H; const LAS int* cn; const LAS int* rb;
    __device__ __forceinline__ void operator()(const f32x4 (&acc)[2][2][4][2], const Unit& u, int wr, int wc, int fr, int fq) const {
        const int n = cn[u.e]; const int colh = u.pn * 128 + wc * 32 + 8 * fq;
#pragma unroll
        for (int ai = 0; ai < 2; ++ai)
#pragma unroll
            for (int m = 0; m < 4; ++m) { const int pos = u.pm * BM + ai * HALF + wr * 64 + m * 16 + fr;
                if (pos < n) { const int a = rb[u.e] + pos;
                    float sc = WSCALE_INV; asm volatile("" : "+v"(sc));
                    const f32x4 g0 = acc[ai][0][m][0] * sc, g1 = acc[ai][0][m][1] * sc, u0 = acc[ai][1][m][0] * sc, u1 = acc[ai][1][m][1] * sc;
                    u32x2 w;
                    w.x = (unsigned)__builtin_amdgcn_cvt_pk_fp8_f32(siluf_(g0[0]) * u0[0], siluf_(g0[1]) * u0[1], 0, false);
                    w.x = (unsigned)__builtin_amdgcn_cvt_pk_fp8_f32(siluf_(g0[2]) * u0[2], siluf_(g0[3]) * u0[3], (int)w.x, true);
                    w.y = (unsigned)__builtin_amdgcn_cvt_pk_fp8_f32(siluf_(g1[0]) * u1[0], siluf_(g1[1]) * u1[1], 0, false);
                    w.y = (unsigned)__builtin_amdgcn_cvt_pk_fp8_f32(siluf_(g1[2]) * u1[2], siluf_(g1[3]) * u1[3], (int)w.y, true);
                    *(u32x2*)(H + (size_t)a * EHID + colh) = w; }
                __builtin_amdgcn_sched_barrier(0); }
    }
};
struct EpiE2 {
    unsigned char* Y; const float* wgt; const LAS int* cn; const LAS int* rb;
    __device__ __forceinline__ void operator()(const f32x4 (&acc)[2][2][4][2], const Unit& u, int wr, int wc, int fr, int fq) const {
        const int n = cn[u.e]; const int col0 = u.pn * BM + wc * 32 + 8 * fq;
#pragma unroll
        for (int ai = 0; ai < 2; ++ai)
#pragma unroll
            for (int m = 0; m < 4; ++m) { const int pos = u.pm * BM + ai * HALF + wr * 64 + m * 16 + fr;
                if (pos < n) { const int a = rb[u.e] + pos; float ws = wgt[u.e * TT + pos] * WSCALE_INV; asm volatile("" : "+v"(ws));
                    unsigned char* rowp = Y + (size_t)a * DM + col0;
#pragma unroll
                    for (int bj = 0; bj < 2; ++bj) { const f32x4 v0 = acc[ai][bj][m][0] * ws, v1 = acc[ai][bj][m][1] * ws;
                        u32x2 w;
                        w.x = (unsigned)__builtin_amdgcn_cvt_pk_fp8_f32(v0[0], v0[1], 0, false); w.x = (unsigned)__builtin_amdgcn_cvt_pk_fp8_f32(v0[2], v0[3], (int)w.x, true);
                        w.y = (unsigned)__builtin_amdgcn_cvt_pk_fp8_f32(v1[0], v1[1], 0, false); w.y = (unsigned)__builtin_amdgcn_cvt_pk_fp8_f32(v1[2], v1[3], (int)w.y, true);
                        *(u32x2*)(rowp + bj * HALF) = w; } }
                __builtin_amdgcn_sched_barrier(0); }
    }
};
}
struct KArgs {
    const float* in[34];
    float* out;
    unsigned char* ws;
    int ph_lo, ph_hi;
};
struct Params {
    float* out;
    unsigned char* ws;
    LAS unsigned long long* ptab;
    int ph_lo, ph_hi;
    __device__ __forceinline__ const float* inp(int k) const {
        const unsigned long long v = ptab[k];
        const unsigned lo = __builtin_amdgcn_readfirstlane((unsigned)v), hi = __builtin_amdgcn_readfirstlane((unsigned)(v >> 32));
        return (const float*)(((unsigned long long)hi << 32) | lo);
    }
};
struct Ctx {
    LAS unsigned char* lds;
    int tid, lane, wave, G, bid;
    int gw, ngw;
};

__device__ __forceinline__ void tr_item(const float* W, int N, bf16_t* WT, int ldt, int k0, int n0, int orow0, LAS float* scr, int lane) {
#pragma unroll 8
    for (int i = 0; i < 32; ++i) { const int kk = 2 * i + (lane >> 5); scr[kk * 33 + (lane & 31)] = W[(size_t)(k0 + kk) * N + n0 + (lane & 31)]; }
    LDS_WAIT(); asm volatile("" ::: "memory");
    const int c = lane & 7;
#pragma unroll
    for (int j = 0; j < 4; ++j) { const int n = (lane >> 3) + 8 * j; const LAS float* s = scr + (8 * c) * 33 + n;
        u32x4 o; o.x = cvt_pk_bf16(s[0 * 33], s[1 * 33]); o.y = cvt_pk_bf16(s[2 * 33], s[3 * 33]); o.z = cvt_pk_bf16(s[4 * 33], s[5 * 33]); o.w = cvt_pk_bf16(s[6 * 33], s[7 * 33]);
        *(u32x4*)(WT + (size_t)(orow0 + n) * ldt + k0 + 8 * c) = o; }
    LDS_WAIT(); asm volatile("" ::: "memory");
}
__device__ __forceinline__ void tr_item64(const float* W, int N, bf16_t* WT, int ldt, int k0, int n0, int orow0, LAS float* scr, int lane) {
    f32x4 v[16];
    const float* src = W + (size_t)(k0 + (lane >> 4)) * N + n0 + 4 * (lane & 15);
#pragma unroll
    for (int i = 0; i < 16; ++i) v[i] = __builtin_nontemporal_load((const f32x4*)(src + (size_t)(4 * i) * N));
#pragma unroll
    for (int i = 0; i < 16; ++i) { LAS float* d = scr + (4 * i + (lane >> 4)) * 65 + 4 * (lane & 15); d[0] = v[i][0]; d[1] = v[i][1]; d[2] = v[i][2]; d[3] = v[i][3]; }
    LDS_WAIT(); asm volatile("" ::: "memory");
    const int c = lane & 7;
#pragma unroll
    for (int j = 0; j < 8; ++j) { const int n = (lane >> 3) + 8 * j; const LAS float* s = scr + (8 * c) * 65 + n;
        u32x4 o; o.x = cvt_pk_bf16(s[0 * 65], s[1 * 65]); o.y = cvt_pk_bf16(s[2 * 65], s[3 * 65]); o.z = cvt_pk_bf16(s[4 * 65], s[5 * 65]); o.w = cvt_pk_bf16(s[6 * 65], s[7 * 65]);
        *(u32x4*)(WT + (size_t)(orow0 + n) * ldt + k0 + 8 * c) = o; }
    LDS_WAIT(); asm volatile("" ::: "memory");
}
__device__ __forceinline__ void tr_item64_fp8(const float* W, int N, unsigned char* WT, int ldt, int k0, int n0, int orow0, LAS float* scr, int lane, float wscale = pg8::WSCALE) {
    f32x4 v[16];
    const float* src = W + (size_t)(k0 + (lane >> 4)) * N + n0 + 4 * (lane & 15);
#pragma unroll
    for (int i = 0; i < 16; ++i) v[i] = __builtin_nontemporal_load((const f32x4*)(src + (size_t)(4 * i) * N));
#pragma unroll
    for (int i = 0; i < 16; ++i) { LAS float* d = scr + (4 * i + (lane >> 4)) * 65 + 4 * (lane & 15); d[0] = v[i][0]; d[1] = v[i][1]; d[2] = v[i][2]; d[3] = v[i][3]; }
    LDS_WAIT(); asm volatile("" ::: "memory");
    const int c = lane & 7;
#pragma unroll
    for (int j = 0; j < 8; ++j) { const int n = (lane >> 3) + 8 * j; const LAS float* s = scr + (8 * c) * 65 + n;
        u32x2 o;
        o.x = (unsigned)__builtin_amdgcn_cvt_pk_fp8_f32(s[0 * 65] * wscale, s[1 * 65] * wscale, 0, false);
        o.x = (unsigned)__builtin_amdgcn_cvt_pk_fp8_f32(s[2 * 65] * wscale, s[3 * 65] * wscale, (int)o.x, true);
        o.y = (unsigned)__builtin_amdgcn_cvt_pk_fp8_f32(s[4 * 65] * wscale, s[5 * 65] * wscale, 0, false);
        o.y = (unsigned)__builtin_amdgcn_cvt_pk_fp8_f32(s[6 * 65] * wscale, s[7 * 65] * wscale, (int)o.y, true);
        *(u32x2*)(WT + (size_t)(orow0 + n) * ldt + k0 + 8 * c) = o; }
    LDS_WAIT(); asm volatile("" ::: "memory");
}
__device__ __forceinline__ void tr_dense(const float* W, int K, int N, bf16_t* WT, int item, LAS float* scr, int lane) {
    const int nblk = N / 32, kb = item / nblk, nb = item % nblk;
    tr_item(W, N, WT, K, 64 * kb, 32 * nb, 32 * nb, scr, lane);
}

__device__ __forceinline__ void s5_tables(const Params& p, Ctx& C, int dir, int g) {
    LAS f32x2* PW = (LAS f32x2*)C.lds;
    LAS f32x2* BB = PW + 65 * 64;
    LAS f32x2* CX = BB + 64 * 16;
    const float* a_re = p.inp(11); const float* a_im = p.inp(12); const float* log_dt = p.inp(13);
    const float* b_re = p.inp(14); const float* b_im = p.inp(15); const float* c_re = p.inp(16); const float* c_im = p.inp(17);
    const int tid = C.tid;
    if (tid < 64) {
        const int pp = tid;
        const float dt = __expf(log_dt[dir * 64 + g]);
        const float are = a_re[(dir * 64 + g) * 64 + pp], aim = a_im[(dir * 64 + g) * 64 + pp];
        const float zr = are * dt, zi = aim * dt;
        const float mag = __expf(zr);
        double rev = (double)zi * 0.15915494309189535; rev -= floor(rev);
        const float cs = __builtin_amdgcn_cosf((float)rev), sn = __builtin_amdgcn_sinf((float)rev);
        const float abr = mag * cs, abi = mag * sn;
        const float den = are * are + aim * aim, nr = abr - 1.0f, ni = abi;
        const float fre = (nr * are + ni * aim) / den, fim = (ni * are - nr * aim) / den;
        float pr = 1.0f, pi = 0.0f;
#pragma unroll 1
        for (int n = 0; n <= 64; ++n) { PW[n * 64 + pp] = (f32x2){pr, pi}; const float t = pr * abr - pi * abi; pi = pr * abi + pi * abr; pr = t; }
        for (int j = 0; j < 16; ++j) { const float br = b_re[(g * 64 + pp) * 16 + j], bi = b_im[(g * 64 + pp) * 16 + j];
            BB[pp * 16 + j] = (f32x2){fre * br - fim * bi, fre * bi + fim * br}; }
    }
    for (int q = tid; q < 1024; q += NTHR) { const int i = q >> 6, pp = q & 63; CX[i * 64 + pp] = (f32x2){c_re[(g * 16 + i) * 64 + pp], c_im[(g * 16 + i) * 64 + pp]}; }
    __syncthreads();
    bf16_t* KN = (bf16_t*)(p.ws + WS_KN) + (size_t)(dir * 64 + g) * 16 * 1024;
    bf16_t* WTt = (bf16_t*)(p.ws + WS_WT) + (size_t)(dir * 64 + g) * 128 * 1024;
    float* APOW = (float*)(p.ws + WS_APOW) + (size_t)(dir * 64 + g) * 64 * 128;
    float* AL = (float*)(p.ws + WS_AL) + (size_t)(dir * 64 + g) * 128;
#pragma unroll 1
    for (int q = 0; q < 32; ++q) { const int idx = tid + NTHR * q; const int n = idx >> 8, i = (idx >> 4) & 15, j = idx & 15;
        float s = 0.f;
#pragma unroll 4
        for (int pp = 0; pp < 64; ++pp) { const f32x2 c = CX[i * 64 + pp], w = PW[n * 64 + pp], b = BB[pp * 16 + j];
            const float gr = c.x * b.x - c.y * b.y, gi = c.x * b.y + c.y * b.x;
            s += gr * w.x - gi * w.y; }
        KN[(size_t)i * 1024 + n * 16 + j] = f2bf(s); }
#pragma unroll 2
    for (int q = 0; q < 256; ++q) { const int idx = tid + NTHR * q; const int j = idx & 15, s = (idx >> 4) & 63, pq = idx >> 10; const int pp = pq & 63;
        const f32x2 w = PW[(63 - s) * 64 + pp], b = BB[pp * 16 + j];
        const float v = (pq < 64) ? (w.x * b.x - w.y * b.y) : (w.x * b.y + w.y * b.x);
        WTt[(size_t)pq * 1024 + s * 16 + j] = f2bf(v); }
    for (int q = tid; q < 4096; q += NTHR) { const int t = q >> 6, pp = q & 63; const f32x2 w = PW[(t + 1) * 64 + pp]; *(f32x2*)(APOW + (size_t)t * 128 + 2 * pp) = w; }
    if (tid < 64) { const f32x2 w = PW[64 * 64 + tid]; *(f32x2*)(AL + 2 * tid) = w; }
    if (dir == 0) { bf16_t* CCt = (bf16_t*)(p.ws + WS_CC) + (size_t)g * 16 * 128;
        for (int q = tid; q < 2048; q += NTHR) { const int i = q >> 7, pq = q & 127; const f32x2 c = CX[i * 64 + (pq & 63)]; CCt[i * 128 + pq] = f2bf(pq < 64 ? c.x : -c.y); } }
    __syncthreads();
}

__device__ __forceinline__ void phase_p0(const Params& p, Ctx& C) {
    for (int task = C.bid; task < 128; task += C.G) s5_tables(p, C, task >> 6, task & 63);
    {
        const int gt = C.bid * NTHR + C.tid, ngt = C.G * NTHR;
        float* R128 = (float*)(p.ws + WS_ROPE128); float* R64 = (float*)(p.ws + WS_ROPE64);
        for (int q = gt; q < 256 * 64 + 256 * 32; q += ngt) {
            int pos, i, half; float* dst;
            if (q < 256 * 64) { pos = q >> 6; i = q & 63; half = 64; dst = R128 + (size_t)q * 2; }
            else { const int r = q - 256 * 64; pos = r >> 5; i = r & 31; half = 32; dst = R64 + (size_t)r * 2; }
            const float freq = exp2f(-(float)i / (float)half * 13.287712379549449f);
            const float ang = (float)pos * freq;
            double rev = (double)ang * 0.15915494309189535; rev -= floor(rev);
            dst[0] = __builtin_amdgcn_cosf((float)rev); dst[1] = __builtin_amdgcn_sinf((float)rev);
        }
        bf16_t* RWT = (bf16_t*)(p.ws + WS_RWT); const float* rw = p.inp(26);
        for (int q = gt; q < 2 * 64 * DM; q += ngt) { const int L = q / (64 * DM), r = q % (64 * DM), e = r / DM, k = r % DM;
            const float w = rw[((size_t)L * DM + k) * 64 + e]; const bf16_t hi = f2bf(w); const bf16_t lo = f2bf(w - bf2f(hi));
            RWT[((size_t)(L * 2 + 0) * 64 + e) * DM + k] = hi; RWT[((size_t)(L * 2 + 1) * 64 + e) * DM + k] = lo; }
    }
    {
        const float* cvec = p.inp(1); const float* cctx = p.inp(3); const float* mw = p.inp(4);
        float* MODP = (float*)(p.ws + WS_MODP);
        for (int task = C.gw; task < 2 * 32 * 48; task += C.ngw) {
            const int L = task / (32 * 48), r = task % (32 * 48), kb = r / 48, cb = r % 48;
            const float sc = siluf_(cvec[64 * kb + C.lane]), sx = siluf_(cctx[64 * kb + C.lane]);
            f32x4 a0 = {0.f, 0.f, 0.f, 0.f}, a1 = {0.f, 0.f, 0.f, 0.f};
            const float* wp = mw + ((size_t)L * DM + 64 * kb) * 12288 + 256 * cb + 4 * C.lane;
#pragma unroll 8
            for (int kk = 0; kk < 64; ++kk) { const f32x4 w = *(const f32x4*)(wp + (size_t)kk * 12288);
                const float s0 = __shfl(sc, kk), s1 = __shfl(sx, kk);
                a0 += w * s0; a1 += w * s1; }
            *(f32x4*)(MODP + ((size_t)((L * 32 + kb) * 2 + 0)) * 12288 + 256 * cb + 4 * C.lane) = a0;
            *(f32x4*)(MODP + ((size_t)((L * 32 + kb) * 2 + 1)) * 12288 + 256 * cb + 4 * C.lane) = a1;
        }
    }
    {
        LAS float* scr = (LAS float*)(C.lds + C.wave * 17408);
        constexpr int J0 = (DM / 64) * (EV_IN / 64), J3 = (DM / 64) * (OD_IN / 64);
        for (int it = C.gw; it < J0 + J3; it += C.ngw) {
            const bool l1 = it >= J0; const int r = l1 ? it - J0 : it; const int N = l1 ? OD_IN : EV_IN; const int nblk = N / 64, kb = r / nblk, nb = r % nblk;
            tr_item64_fp8(p.inp(l1 ? 21 : 8), N, (unsigned char*)(p.ws + (l1 ? WS_WIN1 : WS_WIN0)), DM, 64 * kb, 64 * nb, 64 * nb, scr, C.lane, 32.0f);
        }
        LAS float* scr2 = (LAS float*)(C.lds + C.wave * 17408);
        constexpr int I1 = (DM / 64) * (DM / 32), I2 = (1024 / 64) * (1024 / 32), I4 = I1;
        for (int it = C.gw; it < I1 + I2 + I4; it += C.ngw) {
            int r = it;
            if (r < I1) { tr_dense(p.inp(9), DM, DM, (bf16_t*)(p.ws + WS_WOUT0), r, scr2, C.lane); continue; } r -= I1;
            if (r < I2) { tr_dense(p.inp(19), 1024, 1024, (bf16_t*)(p.ws + WS_WGLU), r, scr2, C.lane); continue; } r -= I2;
            tr_dense(p.inp(22), DM, DM, (bf16_t*)(p.ws + WS_WOUT1), r, scr2, C.lane);
        }
    }
}
__device__ __forceinline__ void phase_p1(const Params& p, Ctx& C) {
    const float* MODP = (const float*)(p.ws + WS_MODP); float* MODF = (float*)(p.ws + WS_MODF); const float* mb = p.inp(5);
    for (int q = C.bid * NTHR + C.tid; q < 2 * 2 * 12288; q += C.G * NTHR) { const int L = q / (2 * 12288), v = (q / 12288) & 1, col = q % 12288;
        float s = mb[L * 12288 + col];
        for (int kb = 0; kb < 32; ++kb) s += MODP[((size_t)((L * 32 + kb) * 2 + v)) * 12288 + col];
        MODF[q] = s; }
}
__device__ __forceinline__ const float* modv(const Params& p, int L, int v, int k) { return (const float*)(p.ws + WS_MODF) + (size_t)(L * 2 + v) * 12288 + k * DM; }

__device__ __forceinline__ void stage_vec(LAS float* dst, const float* src, int tid) { *(LAS f32x4*)(dst + 4 * tid) = *(const f32x4*)(src + 4 * tid); }
__device__ __forceinline__ void phase_modulate(const Params& p, Ctx& C, int L) {
    unsigned char* XA8 = (unsigned char*)(p.ws + WS_XA);
    const float* X2 = (const float*)(p.ws + WS_HX2);
    LAS float* MV = (LAS float*)C.lds;
    for (int v = 0; v < 2; ++v) { stage_vec(MV + (v * 2 + 0) * DM, modv(p, L, v, 0), C.tid); stage_vec(MV + (v * 2 + 1) * DM, modv(p, L, v, 1), C.tid); }
    __syncthreads();
    for (int r = C.gw; r < TT; r += C.ngw) {
        const int v = r < CTXL ? 1 : 0;
        const float* src = (L == 0) ? (r < CTXL ? p.inp(2) + (size_t)r * DM : p.inp(0) + (size_t)(r - CTXL) * DM) : X2 + (size_t)r * DM;
        const LAS float* sh = MV + (v * 2 + 0) * DM; const LAS float* sc = MV + (v * 2 + 1) * DM;
#pragma unroll
        for (int j = 0; j < 8; ++j) { const int c = 4 * (C.lane + 64 * j);
            const f32x4 x = *(const f32x4*)(src + c), a = *(const LAS f32x4*)(sc + c), b = *(const LAS f32x4*)(sh + c);
            const f32x4 y = x * (a + 1.0f) + b;
            unsigned w = (unsigned)__builtin_amdgcn_cvt_pk_fp8_f32(y[0], y[1], 0, false); w = (unsigned)__builtin_amdgcn_cvt_pk_fp8_f32(y[2], y[3], (int)w, true);
            *(unsigned*)(XA8 + (size_t)r * DM + c) = w; }
    }
    __syncthreads();
    LAS float* scr = (LAS float*)(C.lds + C.wave * 17408);
    unsigned char* GU = (unsigned char*)(p.ws + WS_GU); unsigned char* DT = (unsigned char*)(p.ws + WS_DT);
    for (int it = C.gw; it < NEX1 * 768; it += C.ngw) {
        const int e = it / 768, r = it % 768, which = r >> 8, q = r & 255;
        if (which < 2) {
            const float* W = (e < 64) ? p.inp(28 + which) + ((size_t)(L * 64 + e)) * DM * EHID : p.inp(31 + which) + (size_t)L * DM * EHID;
            const int kb = q >> 3, nb = q & 7, n0 = 64 * nb;
            tr_item64_fp8(W, EHID, GU + (size_t)e * 1024 * DM, DM, 64 * kb, n0, 256 * (n0 >> 7) + (n0 & 127) + (which ? 128 : 0), scr, C.lane);
        } else {
            const float* W = (e < 64) ? p.inp(30) + ((size_t)(L * 64 + e)) * EHID * DM : p.inp(33) + (size_t)L * EHID * DM;
            const int kb = q >> 5, nb = q & 31;
            tr_item64_fp8(W, DM, DT + (size_t)e * DM * EHID, EHID, 64 * kb, 64 * nb, 64 * nb, scr, C.lane);
        }
    }
}

__device__ __forceinline__ void phase_rope0(const Params& p, Ctx& C) {
    bf16_t* QKV = (bf16_t*)(p.ws + WS_BIG + BG_QKV);
    const f32x2* R128 = (const f32x2*)(p.ws + WS_ROPE128);
    for (int r = C.gw; r < TT; r += C.ngw) {
        bf16_t* row = QKV + (size_t)r * EV_IN;
        if (r < CTXL) {
#pragma unroll
            for (int j = 0; j < 2; ++j) { u32x4* q = (u32x4*)(row + 8 * (C.lane + 64 * j)); u32x4 w = *q;
                w.x = cvt_pk_bf16(bflo(w.x) * 0.0625f, bfhi(w.x) * 0.0625f); w.y = cvt_pk_bf16(bflo(w.y) * 0.0625f, bfhi(w.y) * 0.0625f);
                w.z = cvt_pk_bf16(bflo(w.z) * 0.0625f, bfhi(w.z) * 0.0625f); w.w = cvt_pk_bf16(bflo(w.w) * 0.0625f, bfhi(w.w) * 0.0625f); *q = w; }
        } else {
            const int l = r - CTXL, rp = l >> 6, cp = l & 63;
#pragma unroll
            for (int qk = 0; qk < 2; ++qk)
#pragma unroll
                for (int m = 0; m < 8; ++m) { const int pi = C.lane + 64 * m, head = pi >> 7, blk = (pi >> 6) & 1, i = pi & 63;
                    bf16_t* b = row + qk * 1024 + head * 256 + blk * 128 + i;
                    const f32x2 cs = R128[(blk ? cp : rp) * 64 + i];
                    const float x1 = bf2f(b[0]), x2 = bf2f(b[64]); const float sc = qk ? 1.0f : 0.0625f;
                    b[0] = f2bf((x1 * cs.x - x2 * cs.y) * sc); b[64] = f2bf((x1 * cs.y + x2 * cs.x) * sc); }
        }
    }
}

__device__ __forceinline__ void phase_normrope1(const Params& p, Ctx& C) {
    bf16_t* QKV = (bf16_t*)(p.ws + WS_BIG + BG_QKV);
    const f32x2* R64 = (const f32x2*)(p.ws + WS_ROPE64);
    const float* qg = p.inp(23);
    unsigned* KMAX = (unsigned*)(p.ws + WS_CTL) + CW_KMAX;
    const int lane = C.lane, i32 = lane & 31; const bool up = lane >= 32;
    const float g00 = qg[lane], g01 = qg[64 + lane], g10 = qg[128 + lane], g11 = qg[128 + 64 + lane];
    for (int r = C.gw; r < TT; r += C.ngw) {
        bf16_t* row = QKV + (size_t)r * OD_IN;
        const bool lat = r >= CTXL; const int l = r - CTXL, rp = lat ? (l >> 6) : 0, cp = lat ? (l & 63) : 0;
        const f32x2 cr = R64[rp * 32 + i32], cc = R64[cp * 32 + i32];
#pragma unroll 2
        for (int h = 0; h < 26; ++h) {
            const int col = h < 8 ? 128 * h : (h < 10 ? 1024 + 128 * (h - 8) : (h < 18 ? 1536 + 128 * (h - 10) : 2560 + 128 * (h - 18)));
            bf16_t* b = row + col;
            float v0 = bf2f(b[lane]), v1 = bf2f(b[64 + lane]);
            if (h < 10) { const float ss = wave_sum(v0 * v0 + v1 * v1); const float rs = rsqrtf(ss * (1.0f / 128.0f) + LN_EPS);
                v0 = bf2f(f2bf(v0 * rs)) * (h < 8 ? g00 : g10); v1 = bf2f(f2bf(v1 * rs)) * (h < 8 ? g01 : g11); }
            if (lat) { const float p0 = __shfl_xor(v0, 32), p1 = __shfl_xor(v1, 32);
                v0 = up ? (p0 * cr.y + v0 * cr.x) : (v0 * cr.x - p0 * cr.y);
                v1 = up ? (p1 * cc.y + v1 * cc.x) : (v1 * cc.x - p1 * cc.y); }
            const bf16_t o0 = f2bf(v0), o1 = f2bf(v1);
            b[lane] = o0; b[64 + lane] = o1;
            if ((h >= 8 && h < 10) || h >= 18) {
                const float w0 = bf2f(o0), w1 = bf2f(o1); const float k2 = wave_sum(w0 * w0 + w1 * w1);
                if (lane == 0) atomicMax(KMAX + 64 * (h < 10 ? h - 8 : h - 16), __float_as_uint(k2)); }
        }
    }
}

__device__ __forceinline__ void phase_merge1(const Params& p, Ctx& C) {
    bf16_t* ATT = (bf16_t*)(p.ws + WS_BIG + BG_ATT);
    const float* dl = p.inp(24); const float* sg = p.inp(25);
    const int lane = C.lane;
    float d0 = dl[lane] * dl[128 + lane] + dl[64 + lane] * dl[128 + 64 + lane];
    float d1 = dl[256 + lane] * dl[384 + lane] + dl[256 + 64 + lane] * dl[384 + 64 + lane];
    const float lam = __expf(wave_sum(d0)) - __expf(wave_sum(d1)) + LAMBDA_INIT;
    const f32x4 gg = *(const f32x4*)(sg + 4 * lane);
    for (int l = C.gw; l < SEQ; l += C.ngw) {
        bf16_t* row = ATT + (size_t)l * 3072;
#pragma unroll
        for (int h = 0; h < 4; ++h) {
            const u32x2 a = *(const u32x2*)(row + 1024 + 256 * h + 4 * lane), b = *(const u32x2*)(row + 2048 + 256 * h + 4 * lane);
            f32x4 o = {bflo(a.x) - lam * bflo(b.x), bfhi(a.x) - lam * bfhi(b.x), bflo(a.y) - lam * bflo(b.y), bfhi(a.y) - lam * bfhi(b.y)};
            const float ss = wave_sum(o[0] * o[0] + o[1] * o[1] + o[2] * o[2] + o[3] * o[3]);
            const float rs = rsqrtf(ss * (1.0f / 256.0f) + LN_EPS) * (1.0f - LAMBDA_INIT);
            o = o * rs * gg;
            u32x2 w; w.x = cvt_pk_bf16(o[0], o[1]); w.y = cvt_pk_bf16(o[2], o[3]);
            *(u32x2*)(row + 1024 + 256 * h + 4 * lane) = w;
        }
    }
}

__device__ __forceinline__ void phase_ln1(const Params& p, Ctx& C, int L) {
    const bf16_t* Y = (const bf16_t*)(p.ws + WS_YMIX); float* X1 = (float*)(p.ws + WS_X1); unsigned char* XA8 = (unsigned char*)(p.ws + WS_XA);
    const float* X2 = (const float*)(p.ws + WS_HX2);
    const float* lg = p.inp(6) + (size_t)(L * 2 + 0) * DM; const float* lb = p.inp(7) + (size_t)(L * 2 + 0) * DM;
    const int r0 = (L == 0) ? 0 : CTXL;
    LAS float* MV = (LAS float*)C.lds; LAS float* LG = MV + 6 * DM; LAS float* LB = LG + DM;
    for (int v = 0; v < 2; ++v) for (int k = 0; k < 3; ++k) stage_vec(MV + (v * 3 + k) * DM, modv(p, L, v, 2 + k), C.tid);
    stage_vec(LG, lg, C.tid); stage_vec(LB, lb, C.tid);
    __syncthreads();
    for (int r = r0 + C.gw; r < TT; r += C.ngw) {
        const int v = r < CTXL ? 1 : 0;
        const float* src = (L == 0) ? (r < CTXL ? p.inp(2) + (size_t)r * DM : p.inp(0) + (size_t)(r - CTXL) * DM) : X2 + (size_t)r * DM;
        const LAS float* g1 = MV + (v * 3 + 0) * DM; const LAS float* sh2 = MV + (v * 3 + 1) * DM; const LAS float* sc2 = MV + (v * 3 + 2) * DM;
        f32x4 t[8]; float s = 0.f;
#pragma unroll
        for (int j = 0; j < 8; ++j) { const int c = 4 * (C.lane + 64 * j);
            const f32x4 x = *(const f32x4*)(src + c), g = *(const LAS f32x4*)(g1 + c); const u32x2 yy = *(const u32x2*)(Y + (size_t)r * DM + c);
            const f32x4 y = {bflo(yy.x), bfhi(yy.x), bflo(yy.y), bfhi(yy.y)};
            t[j] = x * ALPHA + g * y; s += (t[j][0] + t[j][1]) + (t[j][2] + t[j][3]); }
        const float mean = wave_sum(s) * (1.0f / DM); float s2 = 0.f;
#pragma unroll
        for (int j = 0; j < 8; ++j) { t[j] = t[j] - mean; s2 += (t[j][0] * t[j][0] + t[j][1] * t[j][1]) + (t[j][2] * t[j][2] + t[j][3] * t[j][3]); }
        const float rstd = rsqrtf(wave_sum(s2) * (1.0f / DM) + LN_EPS);
#pragma unroll
        for (int j = 0; j < 8; ++j) { const int c = 4 * (C.lane + 64 * j);
            const f32x4 x1 = t[j] * rstd * *(const LAS f32x4*)(LG + c) + *(const LAS f32x4*)(LB + c);
            *(f32x4*)(X1 + (size_t)r * DM + c) = x1;
            const f32x4 z = x1 * (*(const LAS f32x4*)(sc2 + c) + 1.0f) + *(const LAS f32x4*)(sh2 + c);
            unsigned w = (unsigned)__builtin_amdgcn_cvt_pk_fp8_f32(z[0], z[1], 0, false); w = (unsigned)__builtin_amdgcn_cvt_pk_fp8_f32(z[2], z[3], (int)w, true);
            *(unsigned*)(XA8 + (size_t)r * DM + c) = w; }
    }
    __syncthreads();
}

__device__ __forceinline__ void phase_combine(const Params& p, Ctx& C, int L, LAS unsigned char* misc) {
    const unsigned char* YM = (const unsigned char*)(p.ws + WS_BIG + BG_YMOE); const float* X1 = (const float*)(p.ws + WS_X1);
    float* X2 = (float*)(p.ws + WS_HX2);
    const float* lg = p.inp(6) + (size_t)(L * 2 + 1) * DM; const float* lb = p.inp(7) + (size_t)(L * 2 + 1) * DM;
    const unsigned* PK = (const unsigned*)(p.ws + WS_WGT); const int* cnt = (const int*)(p.ws + WS_CTL) + CW_CNT + L * 128;
    const int r0 = (L == 0) ? 0 : CTXL;
    LAS int* rb = (LAS int*)(misc + 64);
    LAS float* MV = (LAS float*)C.lds; LAS float* LG = MV + 2 * DM; LAS float* LB = LG + DM;
    __syncthreads();
    if (C.tid == 0) { int q = 0; for (int e = 0; e < NEX1; ++e) { rb[e] = q; q += cnt[e]; } }
    stage_vec(MV, modv(p, L, 0, 5), C.tid); stage_vec(MV + DM, modv(p, L, 1, 5), C.tid); stage_vec(LG, lg, C.tid); stage_vec(LB, lb, C.tid);
    __syncthreads();
    for (int r = r0 + C.gw; r < TT; r += C.ngw) {
        const int v = r < CTXL ? 1 : 0;
        const LAS float* g2 = MV + v * DM;
        int ln = C.lane; asm volatile("" : "+v"(ln));
        int slot = rb[64] + (r - r0);
        if (ln < 8) { const unsigned pk = PK[(size_t)r * 8 + ln]; slot = rb[pk >> 16] + (int)(pk & 0xffffu); }
        f32x4 t[2][4]; float s = 0.f;
#pragma unroll
        for (int j = 0; j < 2; ++j) { const int c = 16 * (ln + 64 * j);
            u32x4 yy[9];
#pragma unroll
            for (int k = 0; k < 9; ++k) { const size_t a = (size_t)__builtin_amdgcn_readlane(slot, k); yy[k] = __builtin_nontemporal_load((const u32x4*)(YM + a * DM + c)); }
            f32x2 f[8];
#pragma unroll
            for (int q = 0; q < 8; ++q) f[q] = (f32x2){0.f, 0.f};
#pragma unroll
            for (int k = 0; k < 9; ++k) {
                f[0] += __builtin_amdgcn_cvt_pk_f32_fp8((int)yy[k].x, false); f[1] += __builtin_amdgcn_cvt_pk_f32_fp8((int)yy[k].x, true);
                f[2] += __builtin_amdgcn_cvt_pk_f32_fp8((int)yy[k].y, false); f[3] += __builtin_amdgcn_cvt_pk_f32_fp8((int)yy[k].y, true);
                f[4] += __builtin_amdgcn_cvt_pk_f32_fp8((int)yy[k].z, false); f[5] += __builtin_amdgcn_cvt_pk_f32_fp8((int)yy[k].z, true);
                f[6] += __builtin_amdgcn_cvt_pk_f32_fp8((int)yy[k].w, false); f[7] += __builtin_amdgcn_cvt_pk_f32_fp8((int)yy[k].w, true); }
#pragma unroll
            for (int q = 0; q < 4; ++q) { const f32x4 x = *(const f32x4*)(X1 + (size_t)r * DM + c + 4 * q), g = *(const LAS f32x4*)(g2 + c + 4 * q);
                const f32x4 ff = {f[2 * q][0], f[2 * q][1], f[2 * q + 1][0], f[2 * q + 1][1]};
                t[j][q] = x * ALPHA + g * ff; s += (t[j][q][0] + t[j][q][1]) + (t[j][q][2] + t[j][q][3]); } }
        const float mean = wave_sum(s) * (1.0f / DM); float s2 = 0.f;
#pragma unroll
        for (int j = 0; j < 2; ++j)
#pragma unroll
            for (int q = 0; q < 4; ++q) { t[j][q] = t[j][q] - mean; s2 += (t[j][q][0] * t[j][q][0] + t[j][q][1] * t[j][q][1]) + (t[j][q][2] * t[j][q][2] + t[j][q][3] * t[j][q][3]); }
        const float rstd = rsqrtf(wave_sum(s2) * (1.0f / DM) + LN_EPS);
        float* dst = (L == 0) ? X2 + (size_t)r * DM : p.out + (size_t)(r - CTXL) * DM;
#pragma unroll
        for (int j = 0; j < 2; ++j)
#pragma unroll
            for (int q = 0; q < 4; ++q) { const int c = 16 * (ln + 64 * j) + 4 * q;
                *(f32x4*)(dst + c) = t[j][q] * rstd * *(const LAS f32x4*)(LG + c) + *(const LAS f32x4*)(LB + c); }
    }
}
constexpr int RLD = 264;
constexpr int SLD = 136;

template <bool SCALE>
__device__ __forceinline__ void stage_chunk(const bf16_t* QKV, int row0, int col0, LAS bf16_t* dst, int tid, float lg  , int dirb) {
#pragma unroll
    for (int q = 0; q < 8; ++q) { const int idx = tid + NTHR * q, r = idx >> 5, c = idx & 31;
        u32x4 w = *(const u32x4*)(QKV + (size_t)(row0 + r) * EV_IN + col0 + 8 * c);
        if (SCALE) { const float sc = fast_exp((dirb ? (float)r : (float)(127 - r)) * lg);
            w.x = cvt_pk_bf16(bflo(w.x) * sc, bfhi(w.x) * sc); w.y = cvt_pk_bf16(bflo(w.y) * sc, bfhi(w.y) * sc);
            w.z = cvt_pk_bf16(bflo(w.z) * sc, bfhi(w.z) * sc); w.w = cvt_pk_bf16(bflo(w.w) * sc, bfhi(w.w) * sc); }
        *(LAS u32x4*)(dst + r * RLD + 8 * c) = w; }
}

__device__ __forceinline__ void ret_chunk_kv(const Params& p, Ctx& C) {
    const bf16_t* QKV = (const bf16_t*)(p.ws + WS_BIG + BG_QKV); float* CKV = (float*)(p.ws + WS_BIG + BG_CKV);
    const float* rld = p.inp(10);
    LAS bf16_t* Vs = (LAS bf16_t*)C.lds; LAS bf16_t* Ks = Vs + 128 * RLD;
    const int lane = C.lane, w = C.wave;
    for (int unit = C.bid; unit < 130 * 8; unit += C.G) {
        const int u = unit >> 3, h = (unit >> 1) & 3, dir = unit & 1;
        const float lg = rld[dir * 4 + h];
        __syncthreads();
        stage_chunk<false>(QKV, 128 * u, 2048 + 256 * h, Vs, C.tid, 0.f, 0);
        stage_chunk<true>(QKV, 128 * u, 1024 + 256 * h, Ks, C.tid, lg, dir);
        __syncthreads();
        f32x4 acc[2][16];
#pragma unroll
        for (int a = 0; a < 2; ++a)
#pragma unroll
            for (int b = 0; b < 16; ++b) acc[a][b] = (f32x4){0.f, 0.f, 0.f, 0.f};
        const unsigned vbase = (unsigned)(uintptr_t)Vs, kbase = (unsigned)(uintptr_t)Ks;
#pragma unroll 1
        for (int ks = 0; ks < 4; ++ks) {
            bf16x8 af[2];
#pragma unroll
            for (int a = 0; a < 2; ++a) af[a] = frag_colk_l(vbase + (unsigned)((32 * ks) * RLD + 32 * w + 16 * a) * 2u, RLD * 2, lane);
#pragma unroll
            for (int b = 0; b < 16; ++b) { const bf16x8 bf = frag_colk_l(kbase + (unsigned)((32 * ks) * RLD + 16 * b) * 2u, RLD * 2, lane);
                acc[0][b] = MFMA16(af[0], bf, acc[0][b]); acc[1][b] = MFMA16(af[1], bf, acc[1][b]); }
        }
        float* dst = CKV + ((size_t)((dir * 4 + h) * 130 + u)) * 65536;
#pragma unroll
        for (int a = 0; a < 2; ++a)
#pragma unroll
            for (int b = 0; b < 16; ++b)
#pragma unroll
                for (int j = 0; j < 4; ++j) dst[(size_t)(32 * w + 16 * a + 4 * (lane >> 4) + j) * 256 + 16 * b + (lane & 15)] = acc[a][b][j];
    }
    __syncthreads();
}

__device__ __forceinline__ int s5_row(int dir, int c, int s) { return dir == 0 ? 64 * c + s : (c < 4 ? 255 - (64 * c + s) : 16639 - 64 * (c - 4) - s); }

__device__ __forceinline__ void s5_end_states(const Params& p, Ctx& C) {
    const bf16_t* QKV = (const bf16_t*)(p.ws + WS_BIG + BG_QKV); const bf16_t* WTt = (const bf16_t*)(p.ws + WS_WT); float* E = (float*)(p.ws + WS_S5E);
    const int lane = C.lane, kq = lane >> 4;
    for (int task = C.gw; task < 2 * 64 * 17; task += C.ngw) {
        const int dir = task / (64 * 17), r = task % (64 * 17), g = r / 17, ct = r % 17;
        int cc = 16 * ct + (lane & 15); const bool valid = cc < 260; cc = valid ? cc : 259;
        const bf16_t* wt = WTt + (size_t)(dir * 64 + g) * 128 * 1024;
        f32x4 acc[8];
#pragma unroll
        for (int t = 0; t < 8; ++t) acc[t] = (f32x4){0.f, 0.f, 0.f, 0.f};
#pragma unroll 2
        for (int ks = 0; ks < 32; ++ks) {
            const int s = 2 * ks + (kq >> 1);
            const bf16x8 bf = *(const bf16x8*)(QKV + (size_t)s5_row(dir, cc, s) * EV_IN + 4096 + 16 * g + 8 * (kq & 1));
#pragma unroll
            for (int t = 0; t < 8; ++t) { const bf16x8 af = frag_rowk_g(wt + (size_t)(16 * t) * 1024 + 32 * ks, 1024, lane); acc[t] = MFMA16(af, bf, acc[t]); }
        }
        if (valid) { float* dst = E + ((size_t)((dir * 64 + g) * 260 + cc)) * 128;
#pragma unroll
            for (int t = 0; t < 8; ++t) *(f32x4*)(dst + 16 * t + 4 * kq) = acc[t]; }
    }
}

__device__ __forceinline__ void phase_scans(const Params& p, Ctx& C) {
    const float* CKV = (const float*)(p.ws + WS_BIG + BG_CKV); bf16_t* SP = (bf16_t*)(p.ws + WS_BIG + BG_SPREV);
    const float* rld = p.inp(10);
    for (int q = C.bid * NTHR + C.tid; q < 8 * 16384; q += C.G * NTHR) {
        const int dh = q >> 14, el = (q & 16383) * 4, dir = dh >> 2, h = dh & 3;
        const float gch = fast_exp(128.0f * rld[dir * 4 + h]);
        const float* src = CKV + (size_t)dh * 130 * 65536 + el; bf16_t* dst = SP + (size_t)dh * 130 * 65536 + el;
        f32x4 s = {0.f, 0.f, 0.f, 0.f};
        for (int st0 = 0; st0 < 130; st0 += 10) {
            f32x4 kv[10];
#pragma unroll
            for (int k = 0; k < 10; ++k) { const int st = st0 + k; const int u = dir == 0 ? st : (st == 0 ? 1 : (st == 1 ? 0 : 131 - st)); kv[k] = *(const f32x4*)(src + (size_t)u * 65536); }
#pragma unroll
            for (int k = 0; k < 10; ++k) { const int st = st0 + k; const int u = dir == 0 ? st : (st == 0 ? 1 : (st == 1 ? 0 : 131 - st));
                u32x2 w; w.x = cvt_pk_bf16(s[0], s[1]); w.y = cvt_pk_bf16(s[2], s[3]); *(u32x2*)(dst + (size_t)u * 65536) = w;
                s = s * gch + kv[k]; }
        }
    }
    const float* E = (const float*)(p.ws + WS_S5E); float* HST = (float*)(p.ws + WS_HST); const float* AL = (const float*)(p.ws + WS_AL);
    for (int q = C.bid * NTHR + C.tid; q < 2 * 64 * 64; q += C.G * NTHR) {
        const int dg = q >> 6, pp = q & 63;
        const f32x2 al = *(const f32x2*)(AL + (size_t)dg * 128 + 2 * pp);
        const float* e = E + (size_t)dg * 260 * 128; float* hs = HST + (size_t)dg * 260 * 128;
        float hr = 0.f, hi = 0.f;
        for (int c0 = 0; c0 < 260; c0 += 10) {
            float er[10], ei[10];
#pragma unroll
            for (int k = 0; k < 10; ++k) { er[k] = e[(size_t)(c0 + k) * 128 + pp]; ei[k] = e[(size_t)(c0 + k) * 128 + 64 + pp]; }
#pragma unroll
            for (int k = 0; k < 10; ++k) { *(f32x2*)(hs + (size_t)(c0 + k) * 128 + 2 * pp) = (f32x2){hr, hi};
                const float t = al.x * hr - al.y * hi + er[k]; hi = al.x * hi + al.y * hr + ei[k]; hr = t; }
        }
    }
}

__device__ __forceinline__ void ret_output_unit(const Params& p, Ctx& C, int unit) {
    const bf16_t* QKV = (const bf16_t*)(p.ws + WS_BIG + BG_QKV); const bf16_t* SP = (const bf16_t*)(p.ws + WS_BIG + BG_SPREV);
    bf16_t* MIX = (bf16_t*)(p.ws + WS_BIG + BG_MIX);
    const float* rld = p.inp(10);
    LAS bf16_t* RA = (LAS bf16_t*)C.lds; LAS bf16_t* RB = RA + 128 * RLD;
    int tid = C.tid; asm volatile("" : "+v"(tid));
    const int lane = tid & 63, w = C.wave, kq = lane >> 4, fr = lane & 15;
    const int u = unit >> 2, h = unit & 3;
    const float lgf = rld[h], lgb = rld[4 + h];
    stage_chunk<false>(QKV, 128 * u, 256 * h, RA, tid, 0.f, 0);
    int ib = 16 * w + 4 * kq, jb = fr; asm volatile("" : "+v"(ib), "+v"(jb));
    f32x4 acc[16];
#pragma unroll
    for (int t = 0; t < 16; ++t) acc[t] = (f32x4){0.f, 0.f, 0.f, 0.f};
#pragma unroll
    for (int dir = 0; dir < 2; ++dir) {
        const bf16_t* Sd = SP + ((size_t)((dir * 4 + h) * 130 + u)) * 65536;
#pragma unroll
        for (int eh = 0; eh < 2; ++eh) {
            __syncthreads();
#pragma unroll
            for (int q = 0; q < 8; ++q) { const int idx = tid + NTHR * q, rr = idx >> 5, c = idx & 31;
                *(LAS u32x4*)(RB + rr * RLD + 8 * c) = *(const u32x4*)(Sd + (size_t)(128 * eh + rr) * 256 + 8 * c);
                if (q == 3) asm volatile("" ::: "memory"); }
            __syncthreads();
#pragma unroll 1
            for (int ks = 0; ks < 8; ++ks) { const bf16x8 af = frag_rowk_l(RA + (16 * w) * RLD + 32 * ks, RLD, lane);
#pragma unroll
                for (int t = 0; t < 8; ++t) { const bf16x8 bf = frag_rowk_l(RB + (16 * t) * RLD + 32 * ks, RLD, lane); acc[8 * eh + t] = MFMA16(af, bf, acc[8 * eh + t]); } }
        }
#pragma unroll
        for (int r = 0; r < 4; ++r) { const int i = ib + r; const float qd = fast_exp((float)(128 - i) * lgb);
            const float f = (dir == 0) ? fast_exp((float)(i + 1) * lgf) / qd : qd;
#pragma unroll
            for (int t = 0; t < 16; ++t) acc[t][r] *= f; }
    }
    __syncthreads();
    stage_chunk<false>(QKV, 128 * u, 1024 + 256 * h, RB, tid, 0.f, 0);
    __syncthreads();
    f32x4 sc[8];
#pragma unroll
    for (int t = 0; t < 8; ++t) sc[t] = (f32x4){0.f, 0.f, 0.f, 0.f};
#pragma unroll 1
    for (int ks = 0; ks < 8; ++ks) { const bf16x8 af = frag_rowk_l(RA + (16 * w) * RLD + 32 * ks, RLD, lane);
#pragma unroll
        for (int t = 0; t < 8; ++t) { const bf16x8 bf = frag_rowk_l(RB + (16 * t) * RLD + 32 * ks, RLD, lane); sc[t] = MFMA16(af, bf, sc[t]); } }
#pragma unroll
    for (int t = 0; t < 8; ++t)
#pragma unroll
        for (int r = 0; r < 4; ++r) { const int i = ib + r, j = 16 * t + jb; const float d = (float)(i - j);
            const float m = (i >= j ? fast_exp(d * lgf) : 0.f) + (j >= i ? fast_exp(-d * lgb) : 0.f); sc[t][r] *= m; }
    __syncthreads();
    stage_chunk<false>(QKV, 128 * u, 2048 + 256 * h, RA, tid, 0.f, 0);
#pragma unroll
    for (int t = 0; t < 8; ++t)
#pragma unroll
        for (int r = 0; r < 4; ++r) RB[(16 * w + 4 * kq + r) * SLD + 16 * t + fr] = f2bf(sc[t][r]);
    __syncthreads();
    const unsigned vbase = (unsigned)(uintptr_t)RA;
#pragma unroll 1
    for (int ks = 0; ks < 4; ++ks) { const bf16x8 af = frag_rowk_l(RB + (16 * w) * SLD + 32 * ks, SLD, lane);
#pragma unroll
        for (int t = 0; t < 16; ++t) { const bf16x8 bf = frag_colk_l(vbase + (unsigned)((32 * ks) * RLD + 16 * t) * 2u, RLD * 2, lane); acc[t] = MFMA16(af, bf, acc[t]); } }
    __syncthreads();
#pragma unroll
    for (int r = 0; r < 4; ++r) {
        float s = 0.f;
#pragma unroll
        for (int t = 0; t < 16; ++t) s += acc[t][r];
        s += __shfl_xor(s, 1); s += __shfl_xor(s, 2); s += __shfl_xor(s, 4); s += __shfl_xor(s, 8);
        const float mean = s * (1.0f / 256.0f); float q = 0.f;
#pragma unroll
        for (int t = 0; t < 16; ++t) { const float d = acc[t][r] - mean; q += d * d; }
        q += __shfl_xor(q, 1); q += __shfl_xor(q, 2); q += __shfl_xor(q, 4); q += __shfl_xor(q, 8);
        const float rstd = rsqrtf(q * (1.0f / 256.0f) + LN_EPS);
#pragma unroll
        for (int t = 0; t < 16; ++t) RA[(16 * w + 4 * kq + r) * RLD + 16 * t + fr] = f2bf((acc[t][r] - mean) * rstd);
    }
    __syncthreads();
#pragma unroll
    for (int q = 0; q < 8; ++q) { const int idx = tid + NTHR * q, rr = idx >> 5, c = idx & 31; const size_t row = (size_t)(128 * u + rr);
        const u32x4 o = *(const LAS u32x4*)(RA + rr * RLD + 8 * c), g = *(const u32x4*)(QKV + row * EV_IN + 3072 + 256 * h + 8 * c);
        u32x4 w4;
        w4.x = cvt_pk_bf16(bflo(o.x) * siluf_(bflo(g.x)), bfhi(o.x) * siluf_(bfhi(g.x))); w4.y = cvt_pk_bf16(bflo(o.y) * siluf_(bflo(g.y)), bfhi(o.y) * siluf_(bfhi(g.y)));
        w4.z = cvt_pk_bf16(bflo(o.z) * siluf_(bflo(g.z)), bfhi(o.z) * siluf_(bfhi(g.z))); w4.w = cvt_pk_bf16(bflo(o.w) * siluf_(bflo(g.w)), bfhi(o.w) * siluf_(bfhi(g.w)));
        *(u32x4*)(MIX + row * DM + 256 * h + 8 * c) = w4; }
    __syncthreads();
}

constexpr int KLD = 1032;
__device__ __forceinline__ void s5_output_task(const Params& p, Ctx& C, int bt) {
    const bf16_t* QKV = (const bf16_t*)(p.ws + WS_BIG + BG_QKV); bf16_t* Z = (bf16_t*)(p.ws + WS_Z);
    const bf16_t* KN = (const bf16_t*)(p.ws + WS_KN); const bf16_t* CCt = (const bf16_t*)(p.ws + WS_CC);
    const float* APOW = (const float*)(p.ws + WS_APOW); const float* HST = (const float*)(p.ws + WS_HST); const float* dsk = p.inp(18);
    int tid = C.tid; asm volatile("" : "+v"(tid));
    const int lane = tid & 63, kq = lane >> 4, fr = lane & 15;
    LAS bf16_t* KF = (LAS bf16_t*)C.lds; LAS bf16_t* KB = KF + 16 * KLD;
    LAS bf16_t* U = KB + 16 * KLD + C.wave * 3072;
    LAS float* PW0 = (LAS float*)(KB + 16 * KLD + 8 * 3072);
    LAS float* PW16 = PW0 + 2 * 16 * 128;
    {
        const int g = bt >> 3, k0 = (260 * (bt & 7)) >> 3, k1 = (260 * ((bt & 7) + 1)) >> 3;
#pragma unroll
        for (int q = 0; q < 8; ++q) { const int idx = tid + NTHR * q, dir = idx >> 11, rr = (idx >> 7) & 15, c = idx & 127;
            *(LAS u32x4*)((dir ? KB : KF) + rr * KLD + 8 * c) = *(const u32x4*)(KN + ((size_t)(dir * 64 + g) * 16 + rr) * 1024 + 8 * c); }
        for (int q = lane; q < 192 * 2; q += 64) *(LAS u32x4*)(U + 8 * q) = (u32x4){0u, 0u, 0u, 0u};
#pragma unroll
        for (int q = 0; q < 2; ++q) { const int idx = tid + NTHR * q, dir = idx >> 9, f = (idx >> 5) & 15, c4 = idx & 31;
            *(LAS f32x4*)(PW0 + dir * 2048 + f * 128 + 4 * c4) = *(const f32x4*)(APOW + ((size_t)(dir * 64 + g) * 64 + (dir == 0 ? f : 15 - f)) * 128 + 4 * c4); }
        if (tid < 64) { const int dir = tid >> 5, c4 = tid & 31; *(LAS f32x4*)(PW16 + dir * 128 + 4 * c4) = *(const f32x4*)(APOW + ((size_t)(dir * 64 + g) * 64 + 15) * 128 + 4 * c4); }
        __syncthreads();
        const f32x4 dv = *(const f32x4*)(dsk + 16 * g + 4 * kq);
        bf16x8 ccr[2], cci[2];
#pragma unroll
        for (int hb = 0; hb < 2; ++hb) { ccr[hb] = frag_rowk_g(CCt + (size_t)g * 16 * 128 + 32 * hb, 128, lane); cci[hb] = frag_rowk_g(CCt + (size_t)g * 16 * 128 + 64 + 32 * hb, 128, lane); }
        const LAS float* pw0l = PW0 + (size_t)fr * 128 + 16 * kq;
        const LAS float* pw16l = PW16 + 16 * kq;
        for (int k = k0 + C.wave; k < k1; k += 8) {
            LDS_WAIT(); asm volatile("" ::: "memory");
            for (int q = lane; q < 128; q += 64) { const int t = q >> 1, hf = q & 1;
                *(LAS u32x4*)(U + (64 + t) * 16 + 8 * hf) = *(const u32x4*)(QKV + (size_t)(64 * k + t) * EV_IN + 4096 + 16 * g + 8 * hf); }
            LDS_WAIT(); asm volatile("" ::: "memory");
            const int cf = k, cb = k < 4 ? 3 - k : 263 - k;
            f32x4 acc[4];
#pragma unroll
            for (int tt = 0; tt < 4; ++tt) acc[tt] = (f32x4){0.f, 0.f, 0.f, 0.f};
            const LAS bf16_t* ubf = U + (64 + fr - (kq >> 1)) * 16 + 8 * (kq & 1);
            const LAS bf16_t* ubb = U + (64 + fr + (kq >> 1)) * 16 + 8 * (kq & 1);
#pragma unroll
            for (int n0 = 0; n0 < 64; n0 += 2) {
                const bf16x8 af = frag_rowk_l(KF + n0 * 16, KLD, lane), ab = frag_rowk_l(KB + n0 * 16, KLD, lane);
#pragma unroll
                for (int tt = 0; tt < 4; ++tt) {
                    if (n0 <= 16 * tt + 14) acc[tt] = MFMA16(af, *(const LAS bf16x8*)(ubf + (16 * tt - n0) * 16), acc[tt]);
                    if (n0 <= 62 - 16 * tt) acc[tt] = MFMA16(ab, *(const LAS bf16x8*)(ubb + (16 * tt + n0) * 16), acc[tt]);
                }
                asm volatile("" ::: "memory");
            }
#pragma unroll
            for (int dir = 0; dir < 2; ++dir) {
                const float* hp = HST + ((size_t)(dir * 64 + g) * 260 + (dir == 0 ? cf : cb)) * 128;
#pragma unroll
                for (int hb = 0; hb < 2; ++hb) {
                    float xr[8], xi[8];
#pragma unroll
                    for (int e2 = 0; e2 < 4; ++e2) { const f32x4 h4 = *(const f32x4*)(hp + 2 * (32 * hb + 8 * kq) + 4 * e2), b4 = *(const LAS f32x4*)(pw0l + dir * 2048 + hb * 64 + 4 * e2);
                        xr[2 * e2] = b4[0] * h4[0] - b4[1] * h4[1]; xi[2 * e2] = b4[0] * h4[1] + b4[1] * h4[0];
                        xr[2 * e2 + 1] = b4[2] * h4[2] - b4[3] * h4[3]; xi[2 * e2 + 1] = b4[2] * h4[3] + b4[3] * h4[2]; }
#pragma unroll
                    for (int st = 0; st < 4; ++st) {
                        const int tt = dir == 0 ? st : 3 - st;
                        u32x4 br, bi;
                        br.x = cvt_pk_bf16(xr[0], xr[1]); br.y = cvt_pk_bf16(xr[2], xr[3]); br.z = cvt_pk_bf16(xr[4], xr[5]); br.w = cvt_pk_bf16(xr[6], xr[7]);
                        bi.x = cvt_pk_bf16(xi[0], xi[1]); bi.y = cvt_pk_bf16(xi[2], xi[3]); bi.z = cvt_pk_bf16(xi[4], xi[5]); bi.w = cvt_pk_bf16(xi[6], xi[7]);
                        acc[tt] = MFMA16(ccr[hb], __builtin_bit_cast(bf16x8, br), acc[tt]);
                        acc[tt] = MFMA16(cci[hb], __builtin_bit_cast(bf16x8, bi), acc[tt]);
                        if (st < 3) {
#pragma unroll
                            for (int e2 = 0; e2 < 4; ++e2) { const f32x4 a4 = *(const LAS f32x4*)(pw16l + dir * 128 + hb * 64 + 4 * e2);
                                float t0 = xr[2 * e2] * a4[0] - xi[2 * e2] * a4[1]; xi[2 * e2] = xr[2 * e2] * a4[1] + xi[2 * e2] * a4[0]; xr[2 * e2] = t0;
                                t0 = xr[2 * e2 + 1] * a4[2] - xi[2 * e2 + 1] * a4[3]; xi[2 * e2 + 1] = xr[2 * e2 + 1] * a4[3] + xi[2 * e2 + 1] * a4[2]; xr[2 * e2 + 1] = t0; }
                        }
                    }
                }
            }
#pragma unroll
            for (int tt = 0; tt < 4; ++tt) { const int t = 16 * tt + fr;
                const u32x2 uu = *(const LAS u32x2*)(U + (64 + t) * 16 + 4 * kq);
                const float y0 = acc[tt][0] + bflo(uu.x) * dv[0], y1 = acc[tt][1] + bfhi(uu.x) * dv[1], y2 = acc[tt][2] + bflo(uu.y) * dv[2], y3 = acc[tt][3] + bfhi(uu.y) * dv[3];
                u32x2 w; w.x = cvt_pk_bf16(gelu_tanh(y0), gelu_tanh(y1)); w.y = cvt_pk_bf16(gelu_tanh(y2), gelu_tanh(y3));
                *(u32x2*)(Z + (size_t)(64 * k + t) * 1024 + 16 * g + 4 * kq) = w; }
        }
    }
    __syncthreads();
}

__device__ __forceinline__ void phase_ret_s5_outputs(const Params& p, Ctx& C, LAS unsigned char* misc) {
    unsigned* head = (unsigned*)(p.ws + WS_CTL) + CW_QUEUE;
    volatile LAS int* slot = (volatile LAS int*)(misc + 32);
    for (;;) {
        __syncthreads();
        if (C.tid == 0) slot[0] = (int)atomicAdd(head, 1u);
        __syncthreads();
        const int item = __builtin_amdgcn_readfirstlane(slot[0]);
        if (item >= 520) break;
        ret_output_unit(p, C, item);
    }
    for (;;) {
        __syncthreads();
        if (C.tid == 0) slot[0] = (int)atomicAdd(head + 64, 1u);
        __syncthreads();
        const int item = __builtin_amdgcn_readfirstlane(slot[0]);
        if (item >= 512) break;
        s5_output_task(p, C, item);
    }
}
__device__ __forceinline__ void phase_router(const Params& p, Ctx& C, int L) {
    const float* X1 = (const float*)(p.ws + WS_X1);
    const bf16_t* RWh = (const bf16_t*)(p.ws + WS_RWT) + (size_t)(L * 2 + 0) * 64 * DM; const bf16_t* RWl = (const bf16_t*)(p.ws + WS_RWT) + (size_t)(L * 2 + 1) * 64 * DM;
    const float* rbias = p.inp(27) + L * 64;
    int* cnt = (int*)(p.ws + WS_CTL) + CW_CNT + L * 128; int* LIST = (int*)(p.ws + WS_LIST); unsigned* PK = (unsigned*)(p.ws + WS_WGT); float* LW = (float*)(p.ws + WS_LW);
    const int lane = C.lane, kq = lane >> 4, fr = lane & 15;
    LAS float* Lg = (LAS float*)(C.lds + C.wave * 8192);
    const int r0 = (L == 0) ? 0 : CTXL, nrows = TT - r0;
    if (C.bid == 0 && C.tid == 0) cnt[64] = nrows;
    for (int task = C.gw; task < nrows / 16; task += C.ngw) {
        const int rbase = r0 + 16 * task, row = rbase + fr;
        const int v = row < CTXL ? 1 : 0;
        const float* xr = X1 + (size_t)row * DM; const float* sc2 = modv(p, L, v, 4); const float* sh2 = modv(p, L, v, 3);
        f32x4 acc[4];
#pragma unroll
        for (int t = 0; t < 4; ++t) acc[t] = (f32x4){0.f, 0.f, 0.f, 0.f};
#pragma unroll 2
        for (int ks = 0; ks < 64; ++ks) { const int c0 = 32 * ks + 8 * kq;
            const f32x4 x0 = *(const f32x4*)(xr + c0), x1 = *(const f32x4*)(xr + c0 + 4);
            const f32x4 a0 = *(const f32x4*)(sc2 + c0), a1 = *(const f32x4*)(sc2 + c0 + 4), b0 = *(const f32x4*)(sh2 + c0), b1 = *(const f32x4*)(sh2 + c0 + 4);
            const f32x4 y0 = x0 * (a0 + 1.0f) + b0, y1 = x1 * (a1 + 1.0f) + b1;
            u32x4 hi; hi.x = cvt_pk_bf16(y0[0], y0[1]); hi.y = cvt_pk_bf16(y0[2], y0[3]); hi.z = cvt_pk_bf16(y1[0], y1[1]); hi.w = cvt_pk_bf16(y1[2], y1[3]);
            u32x4 lo; lo.x = cvt_pk_bf16(y0[0] - bflo(hi.x), y0[1] - bfhi(hi.x)); lo.y = cvt_pk_bf16(y0[2] - bflo(hi.y), y0[3] - bfhi(hi.y));
            lo.z = cvt_pk_bf16(y1[0] - bflo(hi.z), y1[1] - bfhi(hi.z)); lo.w = cvt_pk_bf16(y1[2] - bflo(hi.w), y1[3] - bfhi(hi.w));
            const bf16x8 ah = __builtin_bit_cast(bf16x8, hi), al = __builtin_bit_cast(bf16x8, lo);
#pragma unroll
            for (int t = 0; t < 4; ++t) { const bf16x8 bh = frag_rowk_g(RWh + (size_t)(16 * t) * DM + 32 * ks, DM, lane), bl = frag_rowk_g(RWl + (size_t)(16 * t) * DM + 32 * ks, DM, lane);
                acc[t] = MFMA16(ah, bh, acc[t]); acc[t] = MFMA16(al, bh, acc[t]); acc[t] = MFMA16(ah, bl, acc[t]); } }
        LDS_WAIT(); asm volatile("" ::: "memory");
#pragma unroll
        for (int t = 0; t < 4; ++t)
#pragma unroll
            for (int r = 0; r < 4; ++r) Lg[(4 * kq + r) * 65 + 16 * t + fr] = acc[t][r];
        LDS_WAIT(); asm volatile("" ::: "memory");
        if (lane < 16) {
            LAS float* sr = Lg + lane * 65; const int trow = rbase + lane;
            float gs[8];
#pragma unroll
            for (int g = 0; g < 8; ++g) { float m1 = -1e30f, m2 = -1e30f;
                for (int j = 0; j < 8; ++j) { const int e = 8 * g + j; const float s = sigmoidf_(sr[e]); sr[e] = s; const float vv = s + rbias[e];
                    if (vv > m1) { m2 = m1; m1 = vv; } else if (vv > m2) m2 = vv; }
                gs[g] = m1 + m2; }
            unsigned gmask = 0u;
#pragma unroll
            for (int it = 0; it < 4; ++it) { float best = -1e30f; int bi = 0;
#pragma unroll
                for (int g = 0; g < 8; ++g) { const bool ok = !((gmask >> g) & 1u) && gs[g] > best; best = ok ? gs[g] : best; bi = ok ? g : bi; }
                gmask |= 1u << bi; }
            unsigned long long taken = 0ull; int sel[8]; float sw[8]; float wsum = 0.f;
#pragma unroll
            for (int k = 0; k < 8; ++k) { float best = -1e30f; int bi = 0;
                for (int e = 0; e < 64; ++e) { const bool cand = ((gmask >> (e >> 3)) & 1u) && !((taken >> e) & 1ull); const float vv = sr[e] + rbias[e];
                    if (cand && vv > best) { best = vv; bi = e; } }
                taken |= 1ull << bi; sel[k] = bi; sw[k] = sr[bi]; wsum += sw[k]; }
            const float inv = 2.5f / wsum;
#pragma unroll
            for (int k = 0; k < 8; ++k) { const int a = trow * 8 + k; const int pos = atomicAdd(&cnt[sel[k]], 1);
                LIST[(size_t)sel[k] * TT + pos] = a; PK[a] = ((unsigned)sel[k] << 16) | (unsigned)pos; LW[(size_t)sel[k] * TT + pos] = sw[k] * inv; }
            LIST[(size_t)64 * TT + (trow - r0)] = 8 * TT + trow; LW[(size_t)64 * TT + (trow - r0)] = 1.0f;
        }
    }
}
namespace att {
constexpr int D = 128, NW = 8, QBLK = 32, KVBLK = 64;
constexpr float SCALE = 0.088388347648318440f;
constexpr float THR = 8.f;
constexpr int SHM_V = KVBLK * D * 2, SHM_K = KVBLK * D * 2, SHM_ATTN = 2 * SHM_V + 2 * SHM_K + NW * 64 * 4;
#define KSWZ(row, colB) ((row) * 256 + ((colB) ^ (((row) & 7) << 4)))
#define SBAR() __builtin_amdgcn_sched_barrier(0)
__device__ __forceinline__ int crow(int r, int hi) { return (r & 3) + 8 * (r >> 2) + 4 * hi; }
__device__ __forceinline__ unsigned cvtpk(float lo, float hi) { unsigned r; asm volatile("v_cvt_pk_bf16_f32 %0, %1, %2" : "=v"(r) : "v"(lo), "v"(hi)); return r; }

__device__ __forceinline__ void partialSM(f32x16& p0, f32x16& p1, float negMC) {
  constexpr float Cc = SCALE * 1.4426950408889634f;
  for (int r = 0; r < 16; ++r) p0[r] = fmaf(p0[r], Cc, negMC); for (int r = 0; r < 16; ++r) p1[r] = fmaf(p1[r], Cc, negMC);
  for (int r = 0; r < 16; ++r) p0[r] = __builtin_amdgcn_exp2f(p0[r]);
}
__device__ __forceinline__ void finishSM(f32x16& p0, f32x16& p1, float& l_reg, bf16x8& pa0, bf16x8& pa1, bf16x8& pa2, bf16x8& pa3) {
  for (int r = 0; r < 16; ++r) p1[r] = __builtin_amdgcn_exp2f(p1[r]);
  float ps = 0; for (int r = 0; r < 16; ++r) ps += p0[r]; for (int r = 0; r < 16; ++r) ps += p1[r];
  { auto rr = __builtin_amdgcn_permlane32_swap(__float_as_uint(ps), __float_as_uint(ps), false, false);
    ps = __uint_as_float(rr[0]) + __uint_as_float(rr[1]); }
  l_reg += ps;
#define PK4(P, BASE, OUT) do { unsigned a0 = cvtpk(P[BASE + 0], P[BASE + 1]), a1 = cvtpk(P[BASE + 2], P[BASE + 3]);   \
    unsigned b0 = cvtpk(P[BASE + 4], P[BASE + 5]), b1 = cvtpk(P[BASE + 6], P[BASE + 7]);                              \
    auto r0 = __builtin_amdgcn_permlane32_swap(a0, b0, false, false); auto r1 = __builtin_amdgcn_permlane32_swap(a1, b1, false, false); \
    u32x4 w = {r0[0], r1[0], r0[1], r1[1]}; OUT = *reinterpret_cast<bf16x8*>(&w); } while (0)
  PK4(p0, 0, pa0); PK4(p0, 8, pa1); PK4(p1, 0, pa2); PK4(p1, 8, pa3);
#undef PK4
}
__device__ __forceinline__ void qkt(f32x16& p0, f32x16& p1, const LAS char* Ks, const bf16x8* qr, int r32, int hi) {
  p0 = f32x16{}; p1 = f32x16{};
  for (int d0 = 0; d0 < 8; ++d0) { int cb = (d0 * 16 + hi * 8) * 2;
    bf16x8 b0 = *reinterpret_cast<const LAS bf16x8*>(Ks + KSWZ(r32, cb));
    bf16x8 b1 = *reinterpret_cast<const LAS bf16x8*>(Ks + KSWZ(32 + r32, cb));
    p0 = __builtin_amdgcn_mfma_f32_32x32x16_bf16(b0, qr[d0], p0, 0, 0, 0);
    p1 = __builtin_amdgcn_mfma_f32_32x32x16_bf16(b1, qr[d0], p1, 0, 0, 0); }
}
__device__ __forceinline__ int v_st(int k, int c) { const int kk = (k & ~0xC) | ((k & 4) << 1) | ((k & 8) >> 1); return ((kk >> 3) * 4 + (c >> 5)) * 512 + ((kk & 7) * 32 + (c & 31)) * 2; }
__device__ __forceinline__ int v_rd_base(int lane) { return ((lane & 3) << 3) | (((lane >> 2) & 3) << 6) | (((lane >> 4) & 1) << 5) | (((lane >> 5) & 1) << 8); }
constexpr int v_rd_off(int d0, int ks, int half) { return d0 * 512 + ks * 4096 + half * 2048; }
template <int OFF> __device__ __forceinline__ s16x4 tr_read(int vb) {
  s16x4 r; asm volatile("ds_read_b64_tr_b16 %0, %1 offset:%2" : "=&v"(r) : "v"(vb), "i"(OFF) : "memory"); return r;
}
template <int D0> __device__ __forceinline__ void pv_one(f32x16& od, int vb, bf16x8 pa0, bf16x8 pa1, bf16x8 pa2, bf16x8 pa3) {
  const s16x4 l0 = tr_read<v_rd_off(D0, 0, 0)>(vb), h0 = tr_read<v_rd_off(D0, 0, 1)>(vb), l1 = tr_read<v_rd_off(D0, 1, 0)>(vb), h1 = tr_read<v_rd_off(D0, 1, 1)>(vb);
  const s16x4 l2 = tr_read<v_rd_off(D0, 2, 0)>(vb), h2 = tr_read<v_rd_off(D0, 2, 1)>(vb), l3 = tr_read<v_rd_off(D0, 3, 0)>(vb), h3 = tr_read<v_rd_off(D0, 3, 1)>(vb);
  asm volatile("s_waitcnt lgkmcnt(0)" ::: "memory"); SBAR();
#define PK(L, H) (bf16x8){L[0], L[1], L[2], L[3], H[0], H[1], H[2], H[3]}
  od = __builtin_amdgcn_mfma_f32_32x32x16_bf16(pa0, PK(l0, h0), od, 0, 0, 0);
  od = __builtin_amdgcn_mfma_f32_32x32x16_bf16(pa1, PK(l1, h1), od, 0, 0, 0);
  od = __builtin_amdgcn_mfma_f32_32x32x16_bf16(pa2, PK(l2, h2), od, 0, 0, 0);
  od = __builtin_amdgcn_mfma_f32_32x32x16_bf16(pa3, PK(l3, h3), od, 0, 0, 0);
#undef PK
}
__device__ __forceinline__ void pv_d0(f32x16* o, int vb, bf16x8 pa0, bf16x8 pa1, bf16x8 pa2, bf16x8 pa3) {
  pv_one<0>(o[0], vb, pa0, pa1, pa2, pa3); pv_one<1>(o[1], vb, pa0, pa1, pa2, pa3); pv_one<2>(o[2], vb, pa0, pa1, pa2, pa3); pv_one<3>(o[3], vb, pa0, pa1, pa2, pa3);
}

template <int LDQ, int LDK, int LDO>
__device__ __forceinline__ void attn_dense_body(const bf16_t* __restrict__ Qb, const bf16_t* __restrict__ Kh, const bf16_t* __restrict__ Vh, bf16_t* __restrict__ Ob, int seq, LAS char* lds, int tid, float kmax2) {
  const int wid = tid >> 6, lane = tid & 63, r32 = lane & 31, hi = lane >> 5;
  LAS char* V_lds = lds; LAS char* K_lds = lds + 2 * SHM_V;
  LAS float* ws = (LAS float*)(lds + 2 * SHM_V + 2 * SHM_K) + wid * 64; LAS float* li_l = ws;
  float l_reg = 0; f32x16 o[4] = {}; bf16x8 qr[8];
  const bf16_t* Qw = Qb + (long)(wid * QBLK + r32) * LDQ + hi * 8;
#pragma unroll
  for (int d0 = 0; d0 < 8; ++d0) qr[d0] = *reinterpret_cast<const bf16x8*>(Qw + d0 * 16);
  float negMC;
  { float q2 = 0.f;
#pragma unroll
    for (int d0 = 0; d0 < 8; ++d0) { const u32x4 w = __builtin_bit_cast(u32x4, qr[d0]);
      q2 += bflo(w.x) * bflo(w.x) + bfhi(w.x) * bfhi(w.x) + bflo(w.y) * bflo(w.y) + bfhi(w.y) * bfhi(w.y) + bflo(w.z) * bflo(w.z) + bfhi(w.z) * bfhi(w.z) + bflo(w.w) * bflo(w.w) + bfhi(w.w) * bfhi(w.w); }
    auto rr = __builtin_amdgcn_permlane32_swap(__float_as_uint(q2), __float_as_uint(q2), false, false);
    q2 = __uint_as_float(rr[0]) + __uint_as_float(rr[1]);
    negMC = -(sqrtf(q2 * kmax2) * (SCALE * 1.0001f) - 30.0f) * 1.4426950408889634f; }
  const int sr = tid >> 4, sc = (tid & 15) * 8, vst0 = v_st(sr, sc), vst1 = v_st(32 + sr, sc);
  const int vb0 = (int)(uintptr_t)V_lds + v_rd_base(lane);
  struct { bf16x8 vs0, vs1, ks0, ks1; } sr_[2];
#define SLOAD(i, k0) do { sr_[i].vs0 = *reinterpret_cast<const bf16x8*>(&Vh[(long)((k0) + sr) * LDK + sc]); sr_[i].vs1 = *reinterpret_cast<const bf16x8*>(&Vh[(long)((k0) + 32 + sr) * LDK + sc]); \
    sr_[i].ks0 = *reinterpret_cast<const bf16x8*>(&Kh[(long)((k0) + sr) * LDK + sc]); sr_[i].ks1 = *reinterpret_cast<const bf16x8*>(&Kh[(long)((k0) + 32 + sr) * LDK + sc]); } while (0)
#define SWRITE(b, i) do { *(LAS bf16x8*)(V_lds + (b) * SHM_V + vst0) = sr_[i].vs0;          \
    *(LAS bf16x8*)(V_lds + (b) * SHM_V + vst1) = sr_[i].vs1; int kc = sc * 2;               \
    *(LAS bf16x8*)(K_lds + (b) * SHM_K + KSWZ(sr, kc)) = sr_[i].ks0;                       \
    *(LAS bf16x8*)(K_lds + (b) * SHM_K + KSWZ(32 + sr, kc)) = sr_[i].ks1; } while (0)
#define SWAIT() asm volatile("s_waitcnt vmcnt(4)" ::: "memory")
  f32x16 pA0, pA1, pB0, pB1; bf16x8 pa0, pa1, pa2, pa3; const int NT = seq / KVBLK;
  constexpr int SE = 0, SO = 1;
  SLOAD(SE, 0); asm volatile("s_waitcnt vmcnt(0)" ::: "memory"); SWRITE(0, SE); __syncthreads();
  qkt(pA0, pA1, K_lds, qr, r32, hi); partialSM(pA0, pA1, negMC);
  SLOAD(SO, KVBLK); if (2 < NT) SLOAD(SE, 2 * KVBLK);
  SWAIT(); SWRITE(1, SO); __syncthreads();
  for (int j = 1; j + 1 < NT; j += 2) {
    SBAR(); qkt(pB0, pB1, K_lds + SHM_K, qr, r32, hi);
    finishSM(pA0, pA1, l_reg, pa0, pa1, pa2, pa3); SBAR();
    SLOAD(SO, (j + 2) * KVBLK); SBAR();
    pv_d0(o, vb0, pa0, pa1, pa2, pa3); partialSM(pB0, pB1, negMC);
    __syncthreads(); SWAIT(); SWRITE(0, SE);
    __syncthreads();
    SBAR(); qkt(pA0, pA1, K_lds, qr, r32, hi);
    finishSM(pB0, pB1, l_reg, pa0, pa1, pa2, pa3); SBAR();
    if (j + 3 < NT) SLOAD(SE, (j + 3) * KVBLK); SBAR();
    pv_d0(o, vb0 + (int)SHM_V, pa0, pa1, pa2, pa3); partialSM(pA0, pA1, negMC);
    __syncthreads(); SWAIT(); SWRITE(1, SO);
    __syncthreads();
  }
  SBAR(); qkt(pB0, pB1, K_lds + SHM_K, qr, r32, hi);
  finishSM(pA0, pA1, l_reg, pa0, pa1, pa2, pa3); SBAR();
  pv_d0(o, vb0, pa0, pa1, pa2, pa3); partialSM(pB0, pB1, negMC);
  __syncthreads();
  finishSM(pB0, pB1, l_reg, pa0, pa1, pa2, pa3); SBAR();
  pv_d0(o, vb0 + (int)SHM_V, pa0, pa1, pa2, pa3);
  if (hi == 0) li_l[r32] = l_reg; asm volatile("s_waitcnt lgkmcnt(0)" ::: "memory");
  float rli[16];
#pragma unroll
  for (int r = 0; r < 16; ++r) rli[r] = __builtin_amdgcn_rcpf(li_l[crow(r, hi)]);
  bf16_t* Ow = Ob + (long)(wid * QBLK) * LDO;
#pragma unroll
  for (int r = 0; r < 16; ++r) { int orow = crow(r, hi);
    for (int d0 = 0; d0 < 4; ++d0) Ow[(long)orow * LDO + d0 * 32 + r32] = (bf16_t)(cvtpk(o[d0][r] * rli[r], 0.f) & 0xffffu); }
#undef SLOAD
#undef SWRITE
#undef SWAIT
}

constexpr int PV_BUF = 32768, PK_BUF = 16384, P_LDS_V = 0, P_LDS_K = 2 * PV_BUF, P_LDS_X = P_LDS_K + 2 * PK_BUF, P_LDS_L = P_LDS_X + 8 * 2048, P_LDS_END = P_LDS_L + 1024;
__device__ __forceinline__ void qkt_half(f32x16& p, const LAS char* Ks, const bf16x8* qr, int krow, int hi) {
  p = f32x16{};
  for (int d0 = 0; d0 < 8; ++d0) { int cb = (d0 * 16 + hi * 8) * 2;
    bf16x8 b0 = *reinterpret_cast<const LAS bf16x8*>(Ks + KSWZ(krow, cb));
    p = __builtin_amdgcn_mfma_f32_32x32x16_bf16(b0, qr[d0], p, 0, 0, 0); }
}
__device__ __forceinline__ void smA(f32x16& p, float negMC) {
  constexpr float Cc = SCALE * 1.4426950408889634f;
  for (int r = 0; r < 16; ++r) p[r] = fmaf(p[r], Cc, negMC);
  for (int r = 0; r < 8; ++r) p[r] = __builtin_amdgcn_exp2f(p[r]);
}
__device__ __forceinline__ void smB(f32x16& p, float& l_reg, bf16x8& f0, bf16x8& f1) {
  for (int r = 8; r < 16; ++r) p[r] = __builtin_amdgcn_exp2f(p[r]);
  float ps = 0; for (int r = 0; r < 16; ++r) ps += p[r];
  { auto rr = __builtin_amdgcn_permlane32_swap(__float_as_uint(ps), __float_as_uint(ps), false, false);
    ps = __uint_as_float(rr[0]) + __uint_as_float(rr[1]); }
  l_reg += ps;
#define PK4(P, BASE, OUT) do { unsigned a0 = cvtpk(P[BASE + 0], P[BASE + 1]), a1 = cvtpk(P[BASE + 2], P[BASE + 3]);   \
    unsigned b0 = cvtpk(P[BASE + 4], P[BASE + 5]), b1 = cvtpk(P[BASE + 6], P[BASE + 7]);                              \
    auto r0 = __builtin_amdgcn_permlane32_swap(a0, b0, false, false); auto r1 = __builtin_amdgcn_permlane32_swap(a1, b1, false, false); \
    u32x4 w = {r0[0], r1[0], r0[1], r1[1]}; OUT = *reinterpret_cast<bf16x8*>(&w); } while (0)
  PK4(p, 0, f0); PK4(p, 8, f1);
#undef PK4
}
template <int LDQ, int LDK, int LDO>
__device__ __forceinline__ void attn_pair_body(const bf16_t* __restrict__ Qb, const bf16_t* __restrict__ Kh, const bf16_t* __restrict__ Vh, bf16_t* __restrict__ Ob, int seq, LAS char* lds, int tid, float kmax2) {
  const int wid = __builtin_amdgcn_readfirstlane(tid >> 6), lane = tid & 63, r32 = lane & 31, hi = lane >> 5, g = wid & 3, kb = wid >> 2;
  LAS char* V_lds = lds + P_LDS_V; LAS char* K_lds = lds + P_LDS_K;
  LAS char* xp_own = lds + P_LDS_X + wid * 2048 + lane * 16; LAS char* xp_par = lds + P_LDS_X + (wid ^ 4) * 2048 + lane * 16;
  LAS float* li = (LAS float*)(lds + P_LDS_L);
  float l_reg = 0; f32x16 o[4] = {}; bf16x8 qr[8];
  const bf16_t* Qw = Qb + (long)(g * QBLK + r32) * LDQ + hi * 8;
#pragma unroll
  for (int d0 = 0; d0 < 8; ++d0) qr[d0] = *reinterpret_cast<const bf16x8*>(Qw + d0 * 16);
  float negMC;
  { float q2 = 0.f;
#pragma unroll
    for (int d0 = 0; d0 < 8; ++d0) { const u32x4 w = __builtin_bit_cast(u32x4, qr[d0]);
      q2 += bflo(w.x) * bflo(w.x) + bfhi(w.x) * bfhi(w.x) + bflo(w.y) * bflo(w.y) + bfhi(w.y) * bfhi(w.y) + bflo(w.z) * bflo(w.z) + bfhi(w.z) * bfhi(w.z) + bflo(w.w) * bflo(w.w) + bfhi(w.w) * bfhi(w.w); }
    auto rr = __builtin_amdgcn_permlane32_swap(__float_as_uint(q2), __float_as_uint(q2), false, false);
    q2 = __uint_as_float(rr[0]) + __uint_as_float(rr[1]);
    negMC = -(sqrtf(q2 * kmax2) * (SCALE * 1.0001f) - 30.0f) * 1.4426950408889634f; }
  const int sr = tid >> 4, sc = (tid & 15) * 8, vst0 = v_st(sr, sc), vst1 = v_st(32 + sr, sc);
  const int vrd = (int)(uintptr_t)V_lds + kb * 16384 + v_rd_base(lane);
  const int krow = 32 * kb + r32;
  struct { bf16x8 v00, v01, v10, v11, k0, k1; } st_;
#define PLD16(base, off) (*reinterpret_cast<const bf16x8*>((const char*)(base) + (off)))
#define PLOAD(k0_) do { const unsigned o_ = (unsigned)(((k0_) + sr) * LDK + sc) * 2u; \
    st_.v00 = PLD16(Vh, o_); st_.v01 = PLD16(Vh, o_ + 256u); st_.v10 = PLD16(Vh, o_ + 64u * LDK); st_.v11 = PLD16(Vh, o_ + 64u * LDK + 256u); \
    st_.k0 = PLD16(Kh, o_); st_.k1 = PLD16(Kh, o_ + 64u * LDK); } while (0)
#define PWRITE(kbuf, vbuf) do { LAS char* vb_ = V_lds + (vbuf) * PV_BUF; LAS char* kb_ = K_lds + (kbuf) * PK_BUF; const int kc = sc * 2; \
    *(LAS bf16x8*)(vb_ + vst0) = st_.v00; *(LAS bf16x8*)(vb_ + 16384 + vst0) = st_.v01; *(LAS bf16x8*)(vb_ + vst1) = st_.v10; *(LAS bf16x8*)(vb_ + 16384 + vst1) = st_.v11; \
    *(LAS bf16x8*)(kb_ + KSWZ(sr, kc)) = st_.k0; *(LAS bf16x8*)(kb_ + KSWZ(32 + sr, kc)) = st_.k1; } while (0)
  const int NT = seq / KVBLK;
  f32x16 pS; bf16x8 f0, f1, g0, g1;
  PLOAD(0); asm volatile("s_waitcnt vmcnt(0)" ::: "memory"); PWRITE(0, 0); PLOAD(KVBLK);
  __syncthreads();
  for (int j = 0; j < NT; ++j) {
    SBAR();
    qkt_half(pS, K_lds + (j & 1) * PK_BUF, qr, krow, hi);
    smA(pS, negMC); smB(pS, l_reg, f0, f1); SBAR();
    *(LAS bf16x8*)(xp_own) = f0; *(LAS bf16x8*)(xp_own + 1024) = f1;
    if (j + 1 < NT) PWRITE((j + 1) & 1, (j + 1) & 1);
    if (j + 2 < NT) PLOAD((j + 2) * KVBLK);
    __syncthreads();
    g0 = *(const LAS bf16x8*)(xp_par); g1 = *(const LAS bf16x8*)(xp_par + 1024);
    { const int vb = vrd + (j & 1) * PV_BUF;
      if (kb == 0) pv_d0(o, vb, f0, f1, g0, g1); else pv_d0(o, vb, g0, g1, f0, f1); }
    __syncthreads();
  }
  if (hi == 0) li[wid * 32 + r32] = l_reg;
  __syncthreads();
#pragma unroll
  for (int r = 0; r < 16; ++r) { const int orow = crow(r, hi); const float rl = __builtin_amdgcn_rcpf(li[wid * 32 + orow] + li[(wid ^ 4) * 32 + orow]);
    bf16_t* op = Ob + (long)(g * QBLK + orow) * LDO + 128 * kb + r32;
    for (int d0 = 0; d0 < 4; ++d0) op[d0 * 32] = (bf16_t)(cvtpk(o[d0][r] * rl, 0.f) & 0xffffu); }
#undef PLD16
#undef PLOAD
#undef PWRITE
}
#undef KSWZ
}

__device__ __forceinline__ void phase_attention(const Params& p, Ctx& C) {
    const bf16_t* QKV = (const bf16_t*)(p.ws + WS_BIG + BG_QKV); bf16_t* ATT = (bf16_t*)(p.ws + WS_BIG + BG_ATT);
    const unsigned* KMAX = (const unsigned*)(p.ws + WS_CTL) + CW_KMAX;
    const bool grouped = (C.G == 256);
    for (int i = 0;; ++i) {
        int unit;
        if (grouped) { if (i >= 4) break; unit = (C.bid & 7) * 128 + i * 32 + (C.bid >> 3); } else { unit = i * C.G + C.bid; if (unit >= 1024) break; }
        const int d = unit >> 7, qb = unit & 127, h = d >> 1, m = d & 1;
        const float kmax2 = __uint_as_float(KMAX[64 * (2 + 2 * h + m)]);
        __syncthreads();
        int tz = C.tid; asm volatile("" : "+v"(tz));
        att::attn_pair_body<OD_IN, OD_IN, 3072>(QKV + (size_t)(CTXL + 128 * qb) * OD_IN + 1536 + 256 * h + 128 * m, QKV + 2560 + 256 * h + 128 * m, QKV + 3584 + 256 * h,
                                                ATT + (size_t)(128 * qb) * 3072 + 1024 + 1024 * m + 256 * h, TT, (LAS char*)C.lds, tz, kmax2);
    }
    for (int i = 0;; ++i) {
        int unit;
        if (grouped) { if (i >= 2) break; unit = (C.bid & 7) * 64 + i * 32 + (C.bid >> 3); } else { unit = i * C.G + C.bid; if (unit >= 512) break; }
        const int prob = unit >> 6, qb = unit & 63;
        const float kmax2 = __uint_as_float(KMAX[64 * (prob >> 2)]);
        __syncthreads();
        int tz = C.tid; asm volatile("" : "+v"(tz));
        att::attn_dense_body<OD_IN, OD_IN, 3072>(QKV + (size_t)(CTXL + 256 * qb) * OD_IN + 128 * prob, QKV + 1024 + 128 * (prob >> 2), QKV + 1280 + 128 * (prob >> 2),
                                                 ATT + (size_t)(256 * qb) * 3072 + 128 * prob, TT, (LAS char*)C.lds, tz, kmax2);
    }
    __syncthreads();
}
constexpr int PH_PER_LAYER = 13, N_PHASES = 2 + 2 * PH_PER_LAYER;
#ifndef DBL_PHASE
#define DBL_PHASE -1
#endif
#ifndef MK_PER_PHASE
#define MK_PER_PHASE 0
#endif

template <int L>
__device__ __forceinline__ void layer_body(const Params& p, Ctx& C0, const XcdBarrier& bar, LAS unsigned char* misc, int lo, int hi) {
#define IN(k) (lo <= (k) && (k) < hi)
#define SEAM(k) do { if (IN(k) && IN((k) + 1)) xcd_barrier(bar, C0.wave); } while (0)
#define PHASE(k, ...) if (IN(k)) { FRESH(); __VA_ARGS__ } if (DBL_PHASE == (k)) { xcd_barrier(bar, C0.wave); { FRESH(); __VA_ARGS__ } } SEAM(k);
#define FRESH() Ctx C = C0; { int ln = (int)__builtin_amdgcn_mbcnt_hi(~0u, __builtin_amdgcn_mbcnt_lo(~0u, 0u)); asm volatile("" : "+v"(ln)); C.lane = ln; C.tid = C.wave * 64 + ln; }
        const int b = 2 + PH_PER_LAYER * L;
        bf16_t* QKV = (bf16_t*)(p.ws + WS_BIG + BG_QKV);
        bf16_t* XA = (bf16_t*)(p.ws + WS_XA);
        int* cnt = (int*)(p.ws + WS_CTL) + CW_CNT + L * 128; const int* LIST = (const int*)(p.ws + WS_LIST);
        PHASE(b + 0, phase_modulate(p, C, L); )
        PHASE(b + 1,
            const int N = L ? OD_IN : EV_IN;
            pg8::DenseOrder S; S.init8((const void*)XA, DM, (const void*)(p.ws + (L ? WS_WIN1 : WS_WIN0)), TT, N, DM, C.G, C.bid);
            pg8::EpiStore E{QKV, N, 1.0f / 32.0f};
            pg8::gemm_phase<true>(C.lds, S, E, C.wave);
        )
        PHASE(b + 2, if (L == 0) phase_rope0(p, C); else phase_normrope1(p, C); )
        PHASE(b + 3, if (L == 0) { ret_chunk_kv(p, C); s5_end_states(p, C); } else phase_attention(p, C); )
        PHASE(b + 4, if (L == 0) phase_scans(p, C); else phase_merge1(p, C); )
        if (L == 0) {
            PHASE(b + 5, phase_ret_s5_outputs(p, C, misc); )
            PHASE(b + 6,
                pg8::DenseOrder S; S.init((const bf16_t*)(p.ws + WS_Z), 1024, (const bf16_t*)(p.ws + WS_WGLU), TT, 1024, 1024, C.G, C.bid);
                pg8::EpiGlu E{(const bf16_t*)(p.ws + WS_Z), p.inp(20), (bf16_t*)(p.ws + WS_BIG + BG_MIX)};
                pg8::gemm_phase<false>(C.lds, S, E, C.wave);
            )
        }
        PHASE(b + 7,
            pg8::DenseOrder S;
            if (L == 0) S.init((const bf16_t*)(p.ws + WS_BIG + BG_MIX), DM, (const bf16_t*)(p.ws + WS_WOUT0), TT, DM, DM, C.G, C.bid);
            else S.init((const bf16_t*)(p.ws + WS_BIG + BG_ATT), 3072, (const bf16_t*)(p.ws + WS_WOUT1), SEQ, DM, DM, C.G, C.bid);
            pg8::EpiStore E{(bf16_t*)(p.ws + WS_YMIX) + (L ? (size_t)CTXL * DM : 0), DM, 1.0f};
            pg8::gemm_phase<false>(C.lds, S, E, C.wave);
        )
        PHASE(b + 8, phase_ln1(p, C, L); )
        PHASE(b + 9, phase_router(p, C, L); )
        PHASE(b + 10,
            pg8::MoeOrder<0> S; S.A = (const void*)XA; S.Bt = (const void*)(p.ws + WS_GU); S.list = LIST; S.cnt = cnt; S.ldab = DM; S.kb = DM; S.nN = 4; S.G = C.G; S.c = C.bid; S.bstride = (size_t)1024 * DM;
            S.prep(misc, C.tid);
            pg8::EpiE1 E{(unsigned char*)(p.ws + WS_HX2), S.cn, S.rb};
            pg8::gemm_phase<true>(C.lds, S, E, C.wave);
        )
        PHASE(b + 11,
            pg8::MoeOrder<1> S; S.A = (const void*)(p.ws + WS_HX2); S.Bt = (const void*)(p.ws + WS_DT); S.list = LIST; S.cnt = cnt; S.ldab = EHID; S.kb = EHID; S.nN = 8; S.G = C.G; S.c = C.bid; S.bstride = (size_t)DM * EHID;
            S.prep(misc, C.tid);
            pg8::EpiE2 E{(unsigned char*)(p.ws + WS_BIG + BG_YMOE), (const float*)(p.ws + WS_LW), S.cn, S.rb};
            pg8::gemm_phase<true>(C.lds, S, E, C.wave);
        )
        PHASE(b + 12, phase_combine(p, C, L, misc); )
    #undef IN
#undef SEAM
#undef FRESH
#undef PHASE
}

__global__ void __launch_bounds__(NTHR, 2) mega_fwd(KArgs ka) {
    extern __shared__ __attribute__((aligned(16))) unsigned char lds_raw[];
    Ctx C;
    C.lds = (LAS unsigned char*)lds_raw;
    C.tid = threadIdx.x; C.lane = C.tid & 63; C.wave = __builtin_amdgcn_readfirstlane(C.tid >> 6);
    C.G = gridDim.x; C.bid = blockIdx.x; C.gw = C.bid * NWAVES + C.wave; C.ngw = C.G * NWAVES;
    LAS unsigned char* misc = C.lds + MISC_OFF;
    if (C.tid < 8) ((volatile LAS unsigned*)misc)[C.tid] = 0u;
    Params p; p.out = ka.out; p.ws = ka.ws; p.ph_lo = ka.ph_lo; p.ph_hi = ka.ph_hi; p.ptab = (LAS unsigned long long*)(misc + 1024);
    if (C.tid < 34) p.ptab[C.tid] = (unsigned long long)ka.in[C.tid];
    __syncthreads();
    const int lo = p.ph_lo, hi = p.ph_hi;
    XcdBarrier bar; bar.bar = (unsigned*)(p.ws + WS_CTL) + CW_BAR; bar.x = 0; bar.st = (volatile LAS unsigned*)misc;
    if (hi - lo > 1) bar = xcd_barrier_post((unsigned*)(p.ws + WS_CTL) + CW_BAR, (volatile LAS unsigned*)misc);
#define IN(k) (lo <= (k) && (k) < hi)
#define SEAM(k) do { if (IN(k) && IN((k) + 1)) xcd_barrier(bar, C.wave); } while (0)

    if (IN(0)) { phase_p0(p, C); } SEAM(0);
    if (IN(1)) { phase_p1(p, C); } SEAM(1);
    if (IN(0) && IN(2) && (C.G & 7) == 0) {
        volatile LAS unsigned* st = (volatile LAS unsigned*)misc;
        if (C.tid == 0) { unsigned pre = 0u; const unsigned x = st[3];
            for (unsigned j = 0; j < 16; ++j) { const unsigned cj = xb_ld(&bar.bar[XB_XCNT(j)]); pre += (j < x) ? cj : 0u; }
            st[4] = pre + st[2]; }
        __syncthreads();
        const int vcu = (int)st[4], g8 = C.G >> 3;
        C.bid = __builtin_amdgcn_readfirstlane((vcu % g8) * 8 + vcu / g8); C.gw = C.bid * NWAVES + C.wave;
    }

    layer_body<0>(p, C, bar, misc, lo, hi);
    layer_body<1>(p, C, bar, misc, lo, hi);
#undef IN
#undef SEAM
}

extern "C" void kernel_launch(void* const* d_in, const int* in_sizes, int n_in, void* d_out, int out_size, void* d_ws, size_t ws_size, hipStream_t stream) {
    static int grid = 0;
    if (grid == 0) {
        if (n_in != 34 || out_size != SEQ * DM || ws_size < WS_END) { fprintf(stderr, "kernel_launch: unexpected shapes: n_in %d out %d ws %zu (need %zu)\n", n_in, out_size, ws_size, (size_t)WS_END); grid = -1; return; }
        int dev = 0, cus = 0, per_cu = 0;
        if (hipGetDevice(&dev) != hipSuccess || hipDeviceGetAttribute(&cus, hipDeviceAttributeMultiprocessorCount, dev) != hipSuccess) { grid = -1; return; }
        if (hipFuncSetAttribute((const void*)mega_fwd, hipFuncAttributeMaxDynamicSharedMemorySize, LDS_BYTES) != hipSuccess) { fprintf(stderr, "kernel_launch: hipFuncSetAttribute failed\n"); grid = -1; return; }
        if (hipOccupancyMaxActiveBlocksPerMultiprocessor(&per_cu, (const void*)mega_fwd, NTHR, LDS_BYTES) != hipSuccess || per_cu < 1) { fprintf(stderr, "kernel_launch: occupancy query says %d blocks per CU\n", per_cu); grid = -1; return; }
        (void)hipGetLastError();
        grid = cus;
    }
    if (grid < 0) return;
    (void)hipMemsetAsync((char*)d_ws + WS_CTL, 0, CTL_BYTES, stream);
    KArgs p{};
    for (int i = 0; i < 34; ++i) p.in[i] = (const float*)d_in[i];
    p.out = (float*)d_out; p.ws = (unsigned char*)d_ws;
#if MK_PER_PHASE
    for (int ph = 0; ph < N_PHASES; ++ph) {
        if (ph == 2 + PH_PER_LAYER + 5 || ph == 2 + PH_PER_LAYER + 6) continue;
        p.ph_lo = ph; p.ph_hi = ph + 1;
        hipLaunchKernelGGL(mega_fwd, dim3(grid), dim3(NTHR), LDS_BYTES, stream, p);
    }
#else
    p.ph_lo = 0; p.ph_hi = N_PHASES;
    hipLaunchKernelGGL(mega_fwd, dim3(grid), dim3(NTHR), LDS_BYTES, stream, p);
#endif
    const hipError_t le = hipPeekAtLastError();
    if (le != hipSuccess) fprintf(stderr, "kernel_launch: launch failed: %s\n", hipGetErrorName(le));
}
```

```cpp
#define MK_PER_PHASE 0
#include <hip/hip_runtime.h>
#include <cstdio>
#include <cstdint>

#define GAS __attribute__((address_space(1)))
#define LAS __attribute__((address_space(3)))
typedef unsigned short bf16_t;
typedef short bf16x8 __attribute__((ext_vector_type(8)));
typedef short s16x4 __attribute__((ext_vector_type(4)));
typedef float f32x4 __attribute__((ext_vector_type(4)));
typedef float f32x2 __attribute__((ext_vector_type(2)));
typedef float f32x16 __attribute__((ext_vector_type(16)));
typedef unsigned u32x4 __attribute__((ext_vector_type(4)));
typedef unsigned u32x2 __attribute__((ext_vector_type(2)));

constexpr int DM = 2048, SEQ = 16384, CTXL = 256, TT = SEQ + CTXL;
constexpr int NEXP = 64, NEX1 = 65, EHID = 512, TOPK = 8;
constexpr int EV_IN = 5120, OD_IN = 4608;
constexpr float LN_EPS = 1e-6f;
constexpr float ALPHA = 1.4142135623730951f;
constexpr float LAMBDA_INIT = 0.35550906759f;
constexpr int NTHR = 512, NWAVES = 8;

constexpr size_t al256(size_t x) { return (x + 255) / 256 * 256; }
constexpr size_t WS_CTL   = 0;
constexpr size_t CTL_BYTES = 1u << 20;
constexpr size_t WS_MODP  = WS_CTL + CTL_BYTES;
constexpr size_t WS_MODF  = WS_MODP + al256((size_t)2 * 32 * 2 * 12288 * 4);
constexpr size_t WS_ROPE128 = WS_MODF + al256((size_t)2 * 2 * 12288 * 4);
constexpr size_t WS_ROPE64  = WS_ROPE128 + al256((size_t)256 * 64 * 2 * 4);
constexpr size_t WS_KN    = WS_ROPE64 + al256((size_t)256 * 32 * 2 * 4);
constexpr size_t WS_WT    = WS_KN + al256((size_t)2 * 64 * 16 * 1024 * 2);
constexpr size_t WS_APOW  = WS_WT + al256((size_t)2 * 64 * 128 * 1024 * 2);
constexpr size_t WS_AL    = WS_APOW + al256((size_t)2 * 64 * 64 * 128 * 4);
constexpr size_t WS_CC    = WS_AL + al256((size_t)2 * 64 * 128 * 4);
constexpr size_t WS_S5E   = WS_CC + al256((size_t)64 * 16 * 128 * 2);
constexpr size_t WS_HST   = WS_S5E + al256((size_t)2 * 64 * 260 * 128 * 4);
constexpr size_t WS_WIN0  = WS_HST + al256((size_t)2 * 64 * 260 * 128 * 4);
constexpr size_t WS_WOUT0 = WS_WIN0 + al256((size_t)EV_IN * DM * 2);
constexpr size_t WS_WGLU  = WS_WOUT0 + al256((size_t)DM * DM * 2);
constexpr size_t WS_WIN1  = WS_WGLU + al256((size_t)1024 * 1024 * 2);
constexpr size_t WS_WOUT1 = WS_WIN1 + al256((size_t)OD_IN * DM * 2);
constexpr size_t WS_RWT   = WS_WOUT1 + al256((size_t)DM * DM * 2);
constexpr size_t WS_GU    = WS_RWT + al256((size_t)2 * 2 * 64 * DM * 2);
constexpr size_t WS_DT    = WS_GU + al256((size_t)NEX1 * 1024 * DM * 2);
constexpr size_t WS_XA    = WS_DT + al256((size_t)NEX1 * DM * EHID * 2);
constexpr size_t WS_Z     = WS_XA + al256((size_t)TT * DM * 2);
constexpr size_t WS_YMIX  = WS_Z + al256((size_t)TT * 1024 * 2);
constexpr size_t WS_X1    = WS_YMIX + al256((size_t)TT * DM * 2);
constexpr size_t WS_HX2   = WS_X1 + al256((size_t)TT * DM * 4);
constexpr size_t WS_LIST  = WS_HX2 + al256((size_t)9 * TT * EHID * 2);
constexpr size_t WS_WGT   = WS_LIST + al256((size_t)NEX1 * TT * 4);
constexpr size_t WS_LW    = WS_WGT + al256((size_t)8 * TT * 4);
constexpr size_t WS_BIG   = WS_LW + al256((size_t)NEX1 * TT * 4);
constexpr size_t BG_QKV   = 0;
constexpr size_t BG_CKV   = BG_QKV + al256((size_t)TT * EV_IN * 2);
constexpr size_t BG_SPREV = BG_CKV + al256((size_t)8 * 130 * 65536 * 4);
constexpr size_t BG_MIX   = BG_SPREV + al256((size_t)8 * 130 * 65536 * 2);
constexpr size_t BG_END0  = BG_MIX + al256((size_t)TT * DM * 2);
constexpr size_t BG_ATT   = BG_CKV;
constexpr size_t BG_YMOE  = 0;
constexpr size_t BG_END1  = al256((size_t)9 * TT * DM * 2);
constexpr size_t BG_SIZE  = BG_END0 > BG_END1 ? BG_END0 : BG_END1;
constexpr size_t WS_END   = WS_BIG + BG_SIZE;

constexpr int CW_BAR = 4096;
constexpr int CW_CNT = 16384;
constexpr int CW_QUEUE = 20480;
constexpr int CW_KMAX = 24576;

constexpr int RING_BYTES = 151552;
constexpr int MISC_OFF = RING_BYTES;
constexpr int LDS_BYTES = 159744;

typedef __bf16 bf16x2_t __attribute__((ext_vector_type(2)));
__device__ __forceinline__ unsigned cvt_pk_bf16(float lo, float hi) { const f32x2 v = {lo, hi}; return __builtin_bit_cast(unsigned, __builtin_convertvector(v, bf16x2_t)); }
__device__ __forceinline__ bf16_t f2bf(float f) { unsigned u = __builtin_bit_cast(unsigned, f); return (bf16_t)((u + 0x7fffu + ((u >> 16) & 1u)) >> 16); }
__device__ __forceinline__ float bf2f(bf16_t b) { return __builtin_bit_cast(float, ((unsigned)b) << 16); }
__device__ __forceinline__ float bflo(unsigned w) { return __builtin_bit_cast(float, w << 16); }
__device__ __forceinline__ float bfhi(unsigned w) { return __builtin_bit_cast(float, w & 0xffff0000u); }
__device__ __forceinline__ float wave_sum(float v) {
#pragma unroll
    for (int o = 1; o < 64; o <<= 1) v += __shfl_xor(v, o);
    return v;
}
__device__ __forceinline__ float fast_exp(float x) { return __builtin_amdgcn_exp2f(x * 1.4426950408889634f); }
__device__ __forceinline__ float sigmoidf_(float x) { return 1.0f / (1.0f + __expf(-x)); }
__device__ __forceinline__ float siluf_(float x) { return x / (1.0f + __expf(-x)); }
__device__ __forceinline__ float gelu_tanh(float x) {
    const float u = 0.7978845608028654f * (x + 0.044715f * x * x * x);
    const float e = __expf(2.0f * u);
    const float t = 1.0f - 2.0f / (e + 1.0f);
    return 0.5f * x * (1.0f + t);
}
#define LDS_WAIT() asm volatile("s_waitcnt lgkmcnt(0)" ::: "memory")
#define VM_WAIT() asm volatile("s_waitcnt vmcnt(0)" ::: "memory")

#define XB_TMO      128
#define XB_XCNT(j)  (256  + 64 * (j))
#define XB_XSUB(j)  (1280 + 64 * (j))
#define XB_XGEN(j)  (2304 + 64 * (j))
#define XB_TOP      3328
#define XB_TOPGEN   3392
#define XCD_BAR_WORDS 3456
#define XB_SPIN_CAP (1u << 22)

__device__ __forceinline__ unsigned xb_ld(unsigned* p)              { return __hip_atomic_load(p, __ATOMIC_RELAXED, __HIP_MEMORY_SCOPE_AGENT); }
__device__ __forceinline__ unsigned xb_add(unsigned* p, unsigned v) { return __hip_atomic_fetch_add(p, v, __ATOMIC_RELAXED, __HIP_MEMORY_SCOPE_AGENT); }
__device__ __forceinline__ unsigned xb_xcc_id() { return (unsigned)__builtin_amdgcn_s_getreg((3 << 11) | 20) & 0xFu; }
#define XB_SPIN(cond, bar) do { unsigned _sp = 0; while (cond) { __builtin_amdgcn_s_sleep(1); \
    if ((++_sp & 255u) == 0u) { if (xb_ld(&(bar)[XB_TMO])) break; if (_sp > XB_SPIN_CAP) { atomicAdd(&(bar)[XB_TMO], 1u); break; } } } } while (0)

struct XcdBarrier { unsigned* bar; unsigned x; volatile LAS unsigned* st; };

__device__ __forceinline__ XcdBarrier xcd_barrier_post(unsigned* bar, volatile LAS unsigned* st) {
    XcdBarrier b; b.bar = bar; b.x = xb_xcc_id(); b.st = st;
    if (threadIdx.x == 0) { st[2] = xb_add(&bar[XB_XCNT(b.x)], 1u); st[3] = b.x; }
    return b;
}
__device__ __forceinline__ void xcd_barrier_complete(unsigned* bar, unsigned x, unsigned& nloc, unsigned& nx) {
    const unsigned G = gridDim.x * gridDim.y * gridDim.z;
    unsigned sum, cnt, mine, sp = 0u;
    for (;;) {
        sum = 0u; cnt = 0u; mine = 0u;
#pragma unroll
        for (unsigned j = 0; j < 16; ++j) { const unsigned c = xb_ld(&bar[XB_XCNT(j)]); sum += c; cnt += (c > 0u) ? 1u : 0u; mine = (j == x) ? c : mine; }
        if (sum == G) break;
        __builtin_amdgcn_s_sleep(1);
        if ((++sp & 255u) == 0u) { if (xb_ld(&bar[XB_TMO])) break; if (sp > XB_SPIN_CAP) { atomicAdd(&bar[XB_TMO], 1u); break; } }
    }
    nloc = mine > 0u ? mine : 1u; nx = cnt > 0u ? cnt : 1u;
}
__device__ __forceinline__ void xcd_barrier(const XcdBarrier& b, int wave_id) {
    const bool leader_thread = (wave_id == 0) && (__builtin_amdgcn_mbcnt_hi(~0u, __builtin_amdgcn_mbcnt_lo(~0u, 0u)) == 0u);
    asm volatile("s_waitcnt vmcnt(0)" ::: "memory");
    __syncthreads();
    if (leader_thread) {
        unsigned* bar = b.bar;
        __builtin_amdgcn_s_waitcnt(0);
        unsigned nloc = b.st[0], nx = b.st[1];
        if (nloc == 0u) { xcd_barrier_complete(bar, b.x, nloc, nx); b.st[0] = nloc; b.st[1] = nx; }
        const unsigned old = xb_add(&bar[XB_XSUB(b.x)], 1u);
        const unsigned gen = old / nloc;
        if (old + 1u == (gen + 1u) * nloc) {
            __builtin_amdgcn_fence(__ATOMIC_RELEASE, "agent");
            asm volatile("s_waitcnt vmcnt(0)" ::: "memory");
            const unsigned og = xb_add(&bar[XB_TOP], 1u);
            const unsigned tg = og / nx;
            if (og + 1u == (tg + 1u) * nx) xb_add(&bar[XB_TOPGEN], 1u);
            else XB_SPIN(xb_ld(&bar[XB_TOPGEN]) == tg, bar);
            __builtin_amdgcn_fence(__ATOMIC_ACQUIRE, "agent");
            xb_add(&bar[XB_XGEN(b.x)], 1u);
            asm volatile("s_waitcnt vmcnt(0)" ::: "memory");
        } else {
            XB_SPIN(xb_ld(&bar[XB_XGEN(b.x)]) == gen, bar);
            __builtin_amdgcn_fence(__ATOMIC_ACQUIRE, "agent");
            asm volatile("s_waitcnt vmcnt(0)" ::: "memory");
        }
    }
    __syncthreads();
}

__device__ __forceinline__ bf16x8 frag_rowk_l(const LAS bf16_t* p, int ld, int lane) {
    return *(const LAS bf16x8*)(p + (lane & 15) * ld + (lane >> 4) * 8);
}
__device__ __forceinline__ bf16x8 frag_rowk_g(const bf16_t* p, long ld, int lane) {
    return *(const bf16x8*)(p + (long)(lane & 15) * ld + (lane >> 4) * 8);
}
__device__ __forceinline__ bf16x8 frag_colk_l(unsigned p, int ldb, int lane) {
    const unsigned a0 = p + (unsigned)((8 * (lane >> 4) + ((lane & 15) >> 2)) * ldb + (lane & 3) * 8);
    const unsigned a1 = a0 + 4u * (unsigned)ldb;
    s16x4 lo, hi;
    asm volatile("ds_read_b64_tr_b16 %0, %2\n\tds_read_b64_tr_b16 %1, %3\n\ts_waitcnt lgkmcnt(0)" : "=&v"(lo), "=&v"(hi) : "v"(a0), "v"(a1) : "memory");
    return (bf16x8){lo[0], lo[1], lo[2], lo[3], hi[0], hi[1], hi[2], hi[3]};
}
#define MFMA16(a, b, c) __builtin_amdgcn_mfma_f32_16x16x32_bf16((a), (b), (c), 0, 0, 0)
namespace pg8 {
constexpr int BM = 256, BK = 64, HALF = 128, HTB = HALF * BK * 2, STAGE_BYTES = 8 * HTB, NXCD = 8, WGM = 8;
__device__ __forceinline__ int lds_byte(int r, int c) { const int st = (r >> 4) * 2 + (c >> 5), rr = r & 15, cc = c & 31, ob = rr * 64 + cc * 2; return st * 1024 + (ob ^ (((ob >> 9) & 1) << 5)); }
__device__ __forceinline__ void stage_rc(int b, int& R, int& C) { const int st = b / 1024, sb = b % 1024, swz = sb ^ (((sb >> 9) & 1) << 5); R = (st >> 1) * 16 + swz / 64; C = (st & 1) * 32 + (swz % 64) / 2; }
__device__ __forceinline__ int perm32(int rho) { const int n = rho >> 4, i = rho & 15; return 8 * (i >> 2) + 4 * n + (i & 3); }

struct Unit { int pm, pn, e; };
constexpr float WSCALE = 32.0f, WSCALE_INV = 1.0f / 32.0f;

struct DenseOrder {
    const bf16_t* A; const bf16_t* Bt; int ldab, kb, nM, nN, nwg, G, c;
    __device__ __forceinline__ void init(const bf16_t* A_, int lda_, const bf16_t* Bt_, int M, int N, int K_, int G_, int c_) { A = A_; ldab = lda_ * 2; Bt = Bt_; kb = K_ * 2; nM = M / BM; nN = N / BM; nwg = nM * nN; G = G_; c = c_; }
    __device__ __forceinline__ void init8(const void* A_, int ldab_, const void* Bt_, int M, int N, int K_, int G_, int c_) { A = (const bf16_t*)A_; ldab = ldab_; Bt = (const bf16_t*)Bt_; kb = K_; nM = M / BM; nN = N / BM; nwg = nM * nN; G = G_; c = c_; }
    __device__ __forceinline__ void prep(LAS unsigned char*) const {}
    __device__ __forceinline__ int units_of_me() const { return c < nwg ? (nwg - c + G - 1) / G : 0; }
    __device__ __forceinline__ int max_units() const { return (nwg + G - 1) / G; }
    __device__ __forceinline__ bool next(int i, Unit& u) const {
        const long L = (long)i * G + c; if (L >= nwg) return false;
        int wgid = (int)L; { const int q = nwg / NXCD, r = nwg % NXCD, xcd = wgid % NXCD, off = wgid / NXCD; wgid = (xcd < r ? xcd * (q + 1) : r * (q + 1) + (xcd - r) * q) + off; }
        const int nig = WGM * nN, gid = wgid / nig, fm = gid * WGM, gsz = (nM - fm) < WGM ? (nM - fm) : WGM;
        u.pm = fm + ((wgid % nig) % gsz); u.pn = (wgid % nig) / gsz; u.e = 0; return true;
    }
    __device__ __forceinline__ const char* a_base() const { return (const char*)A; }
    __device__ __forceinline__ unsigned a_off(const Unit& u, int r) const { return (unsigned)(u.pm * BM + r) * (unsigned)ldab; }
    __device__ __forceinline__ const char* b_ptr(const Unit& u) const { return (const char*)Bt + (size_t)u.pn * BM * kb; }
};

template <int MODE  >
struct MoeOrder {
    const void* A; const void* Bt; const int* list; const int* cnt; int ldab, kb, nN, G, c; size_t bstride;
    LAS int* tp; LAS int* cn; LAS int* rb;
    __device__ __forceinline__ void prep(LAS unsigned char* misc, int tid) {
        tp = (LAS int*)(misc + 64); cn = tp + 72; rb = cn + 72;
        if (tid < NEX1) cn[tid] = cnt[tid];
        __syncthreads();
        if (tid == 0) { int s = 0, q = 0; for (int e = 0; e < NEX1; ++e) { tp[e] = s; rb[e] = q; s += (cn[e] + BM - 1) / BM; q += cn[e]; } tp[NEX1] = s; rb[NEX1] = q; }
        __syncthreads();
    }
    __device__ __forceinline__ bool next(int i, Unit& u) const {
        const int total = tp[NEX1]; const long nu = (long)total * nN; const int per = (int)((nu + G - 1) / G);
        (void)per;
        long L = (long)i * G + c;
        if ((G & 7) == 0) L = ((long)i * 8 + (c & 7)) * (G >> 3) + (c >> 3);
        if (L >= nu) return false;
        const int tile = (int)(L / nN); u.pn = (int)(L % nN);
        int e = 0;
        for (int k = 1; k < NEX1; ++k) e += (tp[k] <= tile) ? 1 : 0;
        u.e = e; u.pm = tile - tp[e]; return true;
    }
    __device__ __forceinline__ const char* a_base() const { return (const char*)A; }
    __device__ __forceinline__ unsigned a_off(const Unit& u, int r) const {
        int pos = u.pm * BM + r; const int n = cn[u.e]; pos = pos < n ? pos : n - 1;
        if (MODE == 1) return (unsigned)(rb[u.e] + pos) * (unsigned)ldab;
        const int a = list[u.e * TT + pos];
        const int row = a < 8 * TT ? (a >> 3) : a - 8 * TT;
        return (unsigned)row * (unsigned)ldab;
    }
    __device__ __forceinline__ const char* b_ptr(const Unit& u) const { return (const char*)Bt + (size_t)u.e * bstride + (size_t)u.pn * BM * kb; }
};

typedef int v8i32 __attribute__((ext_vector_type(8)));
typedef int v4i32_ __attribute__((ext_vector_type(4)));
__device__ __forceinline__ v8i32 cat8(bf16x8 a, bf16x8 b) { const u32x4 x = __builtin_bit_cast(u32x4, a), y = __builtin_bit_cast(u32x4, b); return (v8i32){(int)x.x, (int)x.y, (int)x.z, (int)x.w, (int)y.x, (int)y.y, (int)y.z, (int)y.w}; }
template <bool FP8, class Epi, class Sched>
__device__ __forceinline__ void gemm_phase(LAS unsigned char* lds, const Sched& S, const Epi& E, int wave_id) {
    const int wid = wave_id; int lane = (int)__builtin_amdgcn_mbcnt_hi(~0u, __builtin_amdgcn_mbcnt_lo(~0u, 0u)); asm volatile("" : "+v"(lane));
    const int tid = wid * 64 + lane, wr = wid >> 2, wc = wid & 3, fr = lane & 15, fq = lane >> 4;
    const int kb = S.kb; int nt = kb / 128; asm volatile("" : "+s"(nt));
    unsigned voffB[2];
#pragma unroll
    for (int i = 0; i < 2; ++i) { int R, C; stage_rc(tid * 16 + i * 8192, R, C); const int Rb = (R & ~31) + perm32(R & 31);
        voffB[i] = (unsigned)(Rb * kb) + (unsigned)C * 2u; }
#define PG8_AOFF(u, h, i) ({ int _tz = tid; asm volatile("" : "+v"(_tz)); int _R, _C; stage_rc(_tz * 16 + (i) * 8192, _R, _C); S.a_off((u), (h) * HALF + _R) + (unsigned)_C * 2u; })
    const size_t kstep = (size_t)(BK * 2);
    const size_t hstepB = (size_t)HALF * kb;
    const unsigned ldsw = (unsigned)wid * 1024u;
    const int aoff = lds_byte(wr * 64 + fr, fq * 8), boff = lds_byte(wc * 32 + fr, fq * 8);
#define PG8_SA(b, h) (((b) * 2 + (h)) * HTB)
#define PG8_SB(b, h) ((4 + (b) * 2 + (h)) * HTB)
#define PG8_STAGE(bufoff, gbase, v0, v1) do { \
        __builtin_amdgcn_global_load_lds((const unsigned*)((const char*)(gbase) + (v0)), (LAS unsigned*)(lds + (bufoff) + ldsw), 16, 0, 0); \
        __builtin_amdgcn_global_load_lds((const unsigned*)((const char*)(gbase) + (v1)), (LAS unsigned*)(lds + (bufoff) + ldsw + 8192), 16, 0, 0); } while (0)
#define PG8_VOFFB(i) ({ int _tz = tid; asm volatile("" : "+v"(_tz)); int _R, _C; stage_rc(_tz * 16 + (i) * 8192, _R, _C); (unsigned)(((_R & ~31) + perm32(_R & 31)) * kb) + (unsigned)_C * 2u; })
#define PG8_STAGE_B(bufoff, gbase) do { if constexpr (FP8) { const unsigned _v0 = PG8_VOFFB(0), _v1 = PG8_VOFFB(1); PG8_STAGE(bufoff, gbase, _v0, _v1); } else PG8_STAGE(bufoff, gbase, voffB[0], voffB[1]); } while (0)
#define PG8_LD8(off) __builtin_shufflevector(*(const LAS v4i32_*)(lds + (off)), *(const LAS v4i32_*)(lds + (off) + 1024), 0, 1, 2, 3, 4, 5, 6, 7)
#define PG8_LDA(dst, b, h) do { _Pragma("unroll") for (int m = 0; m < 4; ++m) { if constexpr (FP8) dst##8[m] = PG8_LD8(PG8_SA(b, h) + aoff + m * 2048); else { _Pragma("unroll") for (int k = 0; k < 2; ++k) dst[m][k] = *(const LAS bf16x8*)(lds + PG8_SA(b, h) + aoff + m * 2048 + k * 1024); } } } while (0)
#define PG8_LDB(dst, b, h) do { _Pragma("unroll") for (int n = 0; n < 2; ++n) { if constexpr (FP8) dst##8[n] = PG8_LD8(PG8_SB(b, h) + boff + n * 2048); else { _Pragma("unroll") for (int k = 0; k < 2; ++k) dst[n][k] = *(const LAS bf16x8*)(lds + PG8_SB(b, h) + boff + n * 2048 + k * 1024); } } } while (0)
#define PG8_MMA(ai, bj, At, Bt) do { __builtin_amdgcn_s_setprio(1); _Pragma("unroll") for (int m = 0; m < 4; ++m) _Pragma("unroll") for (int n = 0; n < 2; ++n) { \
        if constexpr (FP8) asm volatile("v_mfma_f32_16x16x128_f8f6f4 %0, %1, %2, %0" : "+v"(acc[ai][bj][m][n]) : "v"(Bt##8[n]), "v"(At##8[m])); \
        else { _Pragma("unroll") for (int k = 0; k < 2; ++k) acc[ai][bj][m][n] = __builtin_amdgcn_mfma_f32_16x16x32_bf16(Bt[n][k], At[m][k], acc[ai][bj][m][n], 0, 0, 0); } } \
        __builtin_amdgcn_s_setprio(0); } while (0)
#define PG8_WAIT_V(n) asm volatile("s_waitcnt vmcnt(" #n ")" ::: "memory")
#define PG8_WAIT_L(n) asm volatile("s_waitcnt lgkmcnt(" #n ")" ::: "memory")
#define PG8_BAR __builtin_amdgcn_s_barrier()
#define PG8_SCHED __builtin_amdgcn_sched_barrier(0)
    Unit cur, nxt; int ui = 0;
    if (!S.next(0, cur)) return;
    f32x4 acc[2][2][4][2];
#pragma unroll
    for (int a = 0; a < 2; ++a)
#pragma unroll
        for (int b = 0; b < 2; ++b)
#pragma unroll
            for (int m = 0; m < 4; ++m)
#pragma unroll
                for (int n = 0; n < 2; ++n) acc[a][b][m][n] = (f32x4){0.f, 0.f, 0.f, 0.f};
    bf16x8 At[4][2], B0[2][2], B1[2][2]; v8i32 At8[4], B08[2], B18[2];
    const char* const gA = S.a_base();
    const char* cB = S.b_ptr(cur);
    unsigned oc00, oc01, oc10, oc11;
    oc00 = PG8_AOFF(cur, 0, 0); oc01 = PG8_AOFF(cur, 0, 1); oc10 = PG8_AOFF(cur, 1, 0); oc11 = PG8_AOFF(cur, 1, 1);
    PG8_STAGE_B(PG8_SB(0, 0), cB); PG8_STAGE_B(PG8_SB(0, 1), cB + hstepB); PG8_STAGE(PG8_SA(0, 0), gA, oc00, oc01); PG8_STAGE(PG8_SA(0, 1), gA, oc10, oc11);
    if (wr == 1) PG8_BAR;
    PG8_WAIT_V(2); PG8_BAR;
    PG8_STAGE_B(PG8_SB(1, 0), cB + kstep); PG8_STAGE(PG8_SA(1, 0), gA + kstep, oc00, oc01); PG8_STAGE_B(PG8_SB(1, 1), cB + hstepB + kstep);
    PG8_WAIT_V(6); PG8_BAR;
    for (;;) {
        const bool has_next = S.next(ui + 1, nxt);
        const char* nB = cB;
        {
            u32x4 on = {oc00, oc01, oc10, oc11};
            if (has_next) { on.x = PG8_AOFF(nxt, 0, 0); on.y = PG8_AOFF(nxt, 0, 1); on.z = PG8_AOFF(nxt, 1, 0); on.w = PG8_AOFF(nxt, 1, 1); nB = S.b_ptr(nxt); }
            *(LAS u32x4*)(lds + STAGE_BYTES + tid * 16) = on;
        }
        for (int t = 0; t < nt; t += 2) {
            const bool last = (t == nt - 2);
            const char* a1 = gA + (size_t)(t + 1) * kstep;
            const char* a2 = last ? gA : gA + (size_t)(t + 2) * kstep; const char* b2 = last ? nB : cB + (size_t)(t + 2) * kstep;
            const char* a3 = a2 + kstep; const char* b3 = b2 + kstep;
            unsigned s00 = oc00, s01 = oc01, s10 = oc10, s11 = oc11;
            if (last) { const u32x4 on = *(const LAS u32x4*)(lds + STAGE_BYTES + tid * 16); s00 = on.x; s01 = on.y; s10 = on.z; s11 = on.w; }
            PG8_LDB(B0, 0, 0); PG8_LDB(B1, 0, 1); PG8_SCHED; PG8_LDA(At, 0, 0); PG8_STAGE(PG8_SA(1, 1), a1, oc10, oc11);
            PG8_WAIT_V(8); PG8_WAIT_L(0); PG8_BAR; PG8_MMA(0, 0, At, B0); PG8_MMA(0, 1, At, B1); PG8_BAR; PG8_SCHED;
            PG8_LDA(At, 0, 1); PG8_STAGE_B(PG8_SB(0, 0), b2); PG8_STAGE_B(PG8_SB(0, 1), b2 + hstepB); PG8_STAGE(PG8_SA(0, 0), a2, s00, s01);
            PG8_WAIT_V(8); PG8_WAIT_L(0); PG8_BAR; PG8_MMA(1, 0, At, B0); PG8_MMA(1, 1, At, B1); PG8_BAR; PG8_SCHED;
            PG8_LDB(B0, 1, 0); PG8_LDB(B1, 1, 1); PG8_SCHED; PG8_LDA(At, 1, 0); PG8_STAGE(PG8_SA(0, 1), a2, s10, s11);
            PG8_WAIT_V(8); PG8_WAIT_L(0); PG8_BAR; PG8_MMA(0, 0, At, B0); PG8_MMA(0, 1, At, B1); PG8_BAR; PG8_SCHED;
            PG8_LDA(At, 1, 1); PG8_STAGE_B(PG8_SB(1, 0), b3); PG8_STAGE_B(PG8_SB(1, 1), b3 + hstepB); PG8_STAGE(PG8_SA(1, 0), a3, s00, s01);
            PG8_WAIT_V(8); PG8_WAIT_L(0); PG8_BAR; PG8_MMA(1, 0, At, B0); PG8_MMA(1, 1, At, B1); PG8_BAR; PG8_SCHED;
        }
        if (wr == 0) PG8_BAR;
        E(acc, cur, wr, wc, fr, fq);
        if (!has_next) break;
#pragma unroll
        for (int a = 0; a < 2; ++a)
#pragma unroll
            for (int b = 0; b < 2; ++b)
#pragma unroll
                for (int m = 0; m < 4; ++m)
#pragma unroll
                    for (int n = 0; n < 2; ++n) acc[a][b][m][n] = (f32x4){0.f, 0.f, 0.f, 0.f};
        { const u32x4 on = *(const LAS u32x4*)(lds + STAGE_BYTES + tid * 16); oc00 = on.x; oc01 = on.y; oc10 = on.z; oc11 = on.w; }
        cur = nxt; cB = nB; ++ui;
        if (wr == 1) PG8_BAR;
    }
    PG8_WAIT_V(0);
    PG8_BAR;
#undef PG8_SA
#undef PG8_SB
#undef PG8_STAGE
#undef PG8_STAGE_B
#undef PG8_AOFF
#undef PG8_VOFFB
#undef PG8_LD8
#undef PG8_LDA
#undef PG8_LDB
#undef PG8_MMA
#undef PG8_WAIT_V
#undef PG8_WAIT_L
#undef PG8_BAR
#undef PG8_SCHED
}

struct EpiStore {
    bf16_t* O; int ldc; float scale;
    __device__ __forceinline__ void operator()(const f32x4 (&acc)[2][2][4][2], const Unit& u, int wr, int wc, int fr, int fq) const {
        const int row0 = u.pm * BM + wr * 64 + fr, col0 = u.pn * BM + wc * 32 + 8 * fq;
#pragma unroll
        for (int ai = 0; ai < 2; ++ai)
#pragma unroll
            for (int m = 0; m < 4; ++m) { bf16_t* rowp = O + (size_t)(row0 + ai * HALF + m * 16) * ldc + col0;
#pragma unroll
                for (int bj = 0; bj < 2; ++bj) { const f32x4 v0 = acc[ai][bj][m][0] * scale, v1 = acc[ai][bj][m][1] * scale;
                    u32x4 w; w.x = cvt_pk_bf16(v0[0], v0[1]); w.y = cvt_pk_bf16(v0[2], v0[3]); w.z = cvt_pk_bf16(v1[0], v1[1]); w.w = cvt_pk_bf16(v1[2], v1[3]);
                    *(u32x4*)(rowp + bj * HALF) = w; } }
    }
};
struct EpiGlu {
    const bf16_t* Z; const float* b; bf16_t* MIX;
    __device__ __forceinline__ void operator()(const f32x4 (&acc)[2][2][4][2], const Unit& u, int wr, int wc, int fr, int fq) const {
        const int row0 = u.pm * BM + wr * 64 + fr, col0 = u.pn * BM + wc * 32 + 8 * fq;
#pragma unroll
        for (int bj = 0; bj < 2; ++bj) {
            const f32x4 b0 = *(const f32x4*)(b + col0 + bj * HALF), b1 = *(const f32x4*)(b + col0 + bj * HALF + 4);
#pragma unroll
            for (int ai = 0; ai < 2; ++ai)
#pragma unroll
                for (int m = 0; m < 4; ++m) { const size_t row = (size_t)(row0 + ai * HALF + m * 16);
                    const u32x4 zz = *(const u32x4*)(Z + row * 1024 + col0 + bj * HALF);
                    const f32x4 v0 = acc[ai][bj][m][0] + b0, v1 = acc[ai][bj][m][1] + b1;
                    u32x4 w;
                    w.x = cvt_pk_bf16(bflo(zz.x) * sigmoidf_(v0[0]), bfhi(zz.x) * sigmoidf_(v0[1]));
                    w.y = cvt_pk_bf16(bflo(zz.y) * sigmoidf_(v0[2]), bfhi(zz.y) * sigmoidf_(v0[3]));
                    w.z = cvt_pk_bf16(bflo(zz.z) * sigmoidf_(v1[0]), bfhi(zz.z) * sigmoidf_(v1[1]));
                    w.w = cvt_pk_bf16(bflo(zz.w) * sigmoidf_(v1[2]), bfhi(zz.w) * sigmoidf_(v1[3]));
                    *(u32x4*)(MIX + row * DM + 1024 + col0 + bj * HALF) = w; }
        }
    }
};
struct EpiE1 {
    unsigned char* H; const LAS int* cn; const LAS int* rb;
    __device__ __forceinline__ void operator()(const f32x4 (&acc)[2][2][4][2], const Unit& u, int wr, int wc, int fr, int fq) const {
        const int n = cn[u.e]; const int colh = u.pn * 128 + wc * 32 + 8 * fq;
#pragma unroll
        for (int ai = 0; ai < 2; ++ai)
#pragma unroll
            for (int m = 0; m < 4; ++m) { const int pos = u.pm * BM + ai * HALF + wr * 64 + m * 16 + fr;
                if (pos < n) { const int a = rb[u.e] + pos;
                    float sc = WSCALE_INV; asm volatile("" : "+v"(sc));
                    const f32x4 g0 = acc[ai][0][m][0] * sc, g1 = acc[ai][0][m][1] * sc, u0 = acc[ai][1][m][0] * sc, u1 = acc[ai][1][m][1] * sc;
                    u32x2 w;
                    w.x = (unsigned)__builtin_amdgcn_cvt_pk_fp8_f32(siluf_(g0[0]) * u0[0], siluf_(g0[1]) * u0[1], 0, false);
                    w.x = (unsigned)__builtin_amdgcn_cvt_pk_fp8_f32(siluf_(g0[2]) * u0[2], siluf_(g0[3]) * u0[3], (int)w.x, true);
                    w.y = (unsigned)__builtin_amdgcn_cvt_pk_fp8_f32(siluf_(g1[0]) * u1[0], siluf_(g1[1]) * u1[1], 0, false);
                    w.y = (unsigned)__builtin_amdgcn_cvt_pk_fp8_f32(siluf_(g1[2]) * u1[2], siluf_(g1[3]) * u1[3], (int)w.y, true);
                    *(u32x2*)(H + (size_t)a * EHID + colh) = w; }
                __builtin_amdgcn_sched_barrier(0); }
    }
};
struct EpiE2 {
    unsigned char* Y; const float* wgt; const LAS int* cn; const LAS int* rb;
    __device__ __forceinline__ void operator()(const f32x4 (&acc)[2][2][4][2], const Unit& u, int wr, int wc, int fr, int fq) const {
        const int n = cn[u.e]; const int col0 = u.pn * BM + wc * 32 + 8 * fq;
#pragma unroll
        for (int ai = 0; ai < 2; ++ai)
#pragma unroll
            for (int m = 0; m < 4; ++m) { const int pos = u.pm * BM + ai * HALF + wr * 64 + m * 16 + fr;
                if (pos < n) { const int a = rb[u.e] + pos; float ws = wgt[u.e * TT + pos] * WSCALE_INV; asm volatile("" : "+v"(ws));
                    unsigned char* rowp = Y + (size_t)a * DM + col0;
#pragma unroll
                    for (int bj = 0; bj < 2; ++bj) { const f32x4 v0 = acc[ai][bj][m][0] * ws, v1 = acc[ai][bj][m][1] * ws;
                        u32x2 w;
                        w.x = (unsigned)__builtin_amdgcn_cvt_pk_fp8_f32(v0[0], v0[1], 0, false); w.x = (unsigned)__builtin_amdgcn_cvt_pk_fp8_f32(v0[2], v0[3], (int)w.x, true);
                        w.y = (unsigned)__builtin_amdgcn_cvt_pk_fp8_f32(v1[0], v1[1], 0, false); w.y = (unsigned)__builtin_amdgcn_cvt_pk_fp8_f32(v1[2], v1[3], (int)w.y, true);
                        *(u32x2*)(rowp + bj * HALF) = w; } }
                __builtin_amdgcn_sched_barrier(0); }
    }
};
}
struct KArgs {
    const float* in[34];
    float* out;
    unsigned char* ws;
    int ph_lo, ph_hi;
};
struct Params {
    float* out;
    unsigned char* ws;
    LAS unsigned long long* ptab;
    int ph_lo, ph_hi;
    __device__ __forceinline__ const float* inp(int k) const {
        const unsigned long long v = ptab[k];
        const unsigned lo = __builtin_amdgcn_readfirstlane((unsigned)v), hi = __builtin_amdgcn_readfirstlane((unsigned)(v >> 32));
        return (const float*)(((unsigned long long)hi << 32) | lo);
    }
};
struct Ctx {
    LAS unsigned char* lds;
    int tid, lane, wave, G, bid;
    int gw, ngw;
};

__device__ __forceinline__ void tr_item(const float* W, int N, bf16_t* WT, int ldt, int k0, int n0, int orow0, LAS float* scr, int lane) {
#pragma unroll 8
    for (int i = 0; i < 32; ++i) { const int kk = 2 * i + (lane >> 5); scr[kk * 33 + (lane & 31)] = W[(size_t)(k0 + kk) * N + n0 + (lane & 31)]; }
    LDS_WAIT(); asm volatile("" ::: "memory");
    const int c = lane & 7;
#pragma unroll
    for (int j = 0; j < 4; ++j) { const int n = (lane >> 3) + 8 * j; const LAS float* s = scr + (8 * c) * 33 + n;
        u32x4 o; o.x = cvt_pk_bf16(s[0 * 33], s[1 * 33]); o.y = cvt_pk_bf16(s[2 * 33], s[3 * 33]); o.z = cvt_pk_bf16(s[4 * 33], s[5 * 33]); o.w = cvt_pk_bf16(s[6 * 33], s[7 * 33]);
        *(u32x4*)(WT + (size_t)(orow0 + n) * ldt + k0 + 8 * c) = o; }
    LDS_WAIT(); asm volatile("" ::: "memory");
}
__device__ __forceinline__ void tr_item64(const float* W, int N, bf16_t* WT, int ldt, int k0, int n0, int orow0, LAS float* scr, int lane) {
    f32x4 v[16];
    const float* src = W + (size_t)(k0 + (lane >> 4)) * N + n0 + 4 * (lane & 15);
#pragma unroll
    for (int i = 0; i < 16; ++i) v[i] = __builtin_nontemporal_load((const f32x4*)(src + (size_t)(4 * i) * N));
#pragma unroll
    for (int i = 0; i < 16; ++i) { LAS float* d = scr + (4 * i + (lane >> 4)) * 65 + 4 * (lane & 15); d[0] = v[i][0]; d[1] = v[i][1]; d[2] = v[i][2]; d[3] = v[i][3]; }
    LDS_WAIT(); asm volatile("" ::: "memory");
    const int c = lane & 7;
#pragma unroll
    for (int j = 0; j < 8; ++j) { const int n = (lane >> 3) + 8 * j; const LAS float* s = scr + (8 * c) * 65 + n;
        u32x4 o; o.x = cvt_pk_bf16(s[0 * 65], s[1 * 65]); o.y = cvt_pk_bf16(s[2 * 65], s[3 * 65]); o.z = cvt_pk_bf16(s[4 * 65], s[5 * 65]); o.w = cvt_pk_bf16(s[6 * 65], s[7 * 65]);
        *(u32x4*)(WT + (size_t)(orow0 + n) * ldt + k0 + 8 * c) = o; }
    LDS_WAIT(); asm volatile("" ::: "memory");
}
__device__ __forceinline__ void tr_item64_fp8(const float* W, int N, unsigned char* WT, int ldt, int k0, int n0, int orow0, LAS float* scr, int lane, float wscale = pg8::WSCALE) {
    f32x4 v[16];
    const float* src = W + (size_t)(k0 + (lane >> 4)) * N + n0 + 4 * (lane & 15);
#pragma unroll
    for (int i = 0; i < 16; ++i) v[i] = __builtin_nontemporal_load((const f32x4*)(src + (size_t)(4 * i) * N));
#pragma unroll
    for (int i = 0; i < 16; ++i) { LAS float* d = scr + (4 * i + (lane >> 4)) * 65 + 4 * (lane & 15); d[0] = v[i][0]; d[1] = v[i][1]; d[2] = v[i][2]; d[3] = v[i][3]; }
    LDS_WAIT(); asm volatile("" ::: "memory");
    const int c = lane & 3;
#pragma unroll
    for (int j = 0; j < 4; ++j) { const int n = (lane >> 2) + 16 * j; const LAS float* s = scr + (16 * c) * 65 + n;
        u32x4 o;
        o.x = (unsigned)__builtin_amdgcn_cvt_pk_fp8_f32(s[0 * 65] * wscale, s[1 * 65] * wscale, 0, false);   o.x = (unsigned)__builtin_amdgcn_cvt_pk_fp8_f32(s[2 * 65] * wscale, s[3 * 65] * wscale, (int)o.x, true);
        o.y = (unsigned)__builtin_amdgcn_cvt_pk_fp8_f32(s[4 * 65] * wscale, s[5 * 65] * wscale, 0, false);   o.y = (unsigned)__builtin_amdgcn_cvt_pk_fp8_f32(s[6 * 65] * wscale, s[7 * 65] * wscale, (int)o.y, true);
        o.z = (unsigned)__builtin_amdgcn_cvt_pk_fp8_f32(s[8 * 65] * wscale, s[9 * 65] * wscale, 0, false);   o.z = (unsigned)__builtin_amdgcn_cvt_pk_fp8_f32(s[10 * 65] * wscale, s[11 * 65] * wscale, (int)o.z, true);
        o.w = (unsigned)__builtin_amdgcn_cvt_pk_fp8_f32(s[12 * 65] * wscale, s[13 * 65] * wscale, 0, false); o.w = (unsigned)__builtin_amdgcn_cvt_pk_fp8_f32(s[14 * 65] * wscale, s[15 * 65] * wscale, (int)o.w, true);
        *(u32x4*)(WT + (size_t)(orow0 + n) * ldt + k0 + 16 * c) = o; }
    LDS_WAIT(); asm volatile("" ::: "memory");
}
__device__ __forceinline__ void tr_dense(const float* W, int K, int N, bf16_t* WT, int item, LAS float* scr, int lane) {
    const int nblk = N / 32, kb = item / nblk, nb = item % nblk;
    tr_item(W, N, WT, K, 64 * kb, 32 * nb, 32 * nb, scr, lane);
}

__device__ __forceinline__ void s5_tables(const Params& p, Ctx& C, int dir, int g) {
    LAS f32x2* PW = (LAS f32x2*)C.lds;
    LAS f32x2* BB = PW + 65 * 64;
    LAS f32x2* CX = BB + 64 * 16;
    const float* a_re = p.inp(11); const float* a_im = p.inp(12); const float* log_dt = p.inp(13);
    const float* b_re = p.inp(14); const float* b_im = p.inp(15); const float* c_re = p.inp(16); const float* c_im = p.inp(17);
    const int tid = C.tid;
    if (tid < 64) {
        const int pp = tid;
        const float dt = __expf(log_dt[dir * 64 + g]);
        const float are = a_re[(dir * 64 + g) * 64 + pp], aim = a_im[(dir * 64 + g) * 64 + pp];
        const float zr = are * dt, zi = aim * dt;
        const float mag = __expf(zr);
        double rev = (double)zi * 0.15915494309189535; rev -= floor(rev);
        const float cs = __builtin_amdgcn_cosf((float)rev), sn = __builtin_amdgcn_sinf((float)rev);
        const float abr = mag * cs, abi = mag * sn;
        const float den = are * are + aim * aim, nr = abr - 1.0f, ni = abi;
        const float fre = (nr * are + ni * aim) / den, fim = (ni * are - nr * aim) / den;
        float pr = 1.0f, pi = 0.0f;
#pragma unroll 1
        for (int n = 0; n <= 64; ++n) { PW[n * 64 + pp] = (f32x2){pr, pi}; const float t = pr * abr - pi * abi; pi = pr * abi + pi * abr; pr = t; }
        for (int j = 0; j < 16; ++j) { const float br = b_re[(g * 64 + pp) * 16 + j], bi = b_im[(g * 64 + pp) * 16 + j];
            BB[pp * 16 + j] = (f32x2){fre * br - fim * bi, fre * bi + fim * br}; }
    }
    for (int q = tid; q < 1024; q += NTHR) { const int i = q >> 6, pp = q & 63; CX[i * 64 + pp] = (f32x2){c_re[(g * 16 + i) * 64 + pp], c_im[(g * 16 + i) * 64 + pp]}; }
    __syncthreads();
    bf16_t* KN = (bf16_t*)(p.ws + WS_KN) + (size_t)(dir * 64 + g) * 16 * 1024;
    bf16_t* WTt = (bf16_t*)(p.ws + WS_WT) + (size_t)(dir * 64 + g) * 128 * 1024;
    float* APOW = (float*)(p.ws + WS_APOW) + (size_t)(dir * 64 + g) * 64 * 128;
    float* AL = (float*)(p.ws + WS_AL) + (size_t)(dir * 64 + g) * 128;
#pragma unroll 1
    for (int q = 0; q < 32; ++q) { const int idx = tid + NTHR * q; const int n = idx >> 8, i = (idx >> 4) & 15, j = idx & 15;
        float s = 0.f;
#pragma unroll 4
        for (int pp = 0; pp < 64; ++pp) { const f32x2 c = CX[i * 64 + pp], w = PW[n * 64 + pp], b = BB[pp * 16 + j];
            const float gr = c.x * b.x - c.y * b.y, gi = c.x * b.y + c.y * b.x;
            s += gr * w.x - gi * w.y; }
        KN[(size_t)i * 1024 + n * 16 + j] = f2bf(s); }
#pragma unroll 2
    for (int q = 0; q < 256; ++q) { const int idx = tid + NTHR * q; const int j = idx & 15, s = (idx >> 4) & 63, pq = idx >> 10; const int pp = pq & 63;
        const f32x2 w = PW[(63 - s) * 64 + pp], b = BB[pp * 16 + j];
        const float v = (pq < 64) ? (w.x * b.x - w.y * b.y) : (w.x * b.y + w.y * b.x);
        WTt[(size_t)pq * 1024 + s * 16 + j] = f2bf(v); }
    for (int q = tid; q < 4096; q += NTHR) { const int t = q >> 6, pp = q & 63; const f32x2 w = PW[(t + 1) * 64 + pp]; *(f32x2*)(APOW + (size_t)t * 128 + 2 * pp) = w; }
    if (tid < 64) { const f32x2 w = PW[64 * 64 + tid]; *(f32x2*)(AL + 2 * tid) = w; }
    if (dir == 0) { bf16_t* CCt = (bf16_t*)(p.ws + WS_CC) + (size_t)g * 16 * 128;
        for (int q = tid; q < 2048; q += NTHR) { const int i = q >> 7, pq = q & 127; const f32x2 c = CX[i * 64 + (pq & 63)]; CCt[i * 128 + pq] = f2bf(pq < 64 ? c.x : -c.y); } }
    __syncthreads();
}

__device__ __forceinline__ void phase_p0(const Params& p, Ctx& C) {
    for (int task = C.bid; task < 128; task += C.G) s5_tables(p, C, task >> 6, task & 63);
    {
        const int gt = C.bid * NTHR + C.tid, ngt = C.G * NTHR;
        float* R128 = (float*)(p.ws + WS_ROPE128); float* R64 = (float*)(p.ws + WS_ROPE64);
        for (int q = gt; q < 256 * 64 + 256 * 32; q += ngt) {
            int pos, i, half; float* dst;
            if (q < 256 * 64) { pos = q >> 6; i = q & 63; half = 64; dst = R128 + (size_t)q * 2; }
            else { const int r = q - 256 * 64; pos = r >> 5; i = r & 31; half = 32; dst = R64 + (size_t)r * 2; }
            const float freq = exp2f(-(float)i / (float)half * 13.287712379549449f);
            const float ang = (float)pos * freq;
            double rev = (double)ang * 0.15915494309189535; rev -= floor(rev);
            dst[0] = __builtin_amdgcn_cosf((float)rev); dst[1] = __builtin_amdgcn_sinf((float)rev);
        }
        bf16_t* RWT = (bf16_t*)(p.ws + WS_RWT); const float* rw = p.inp(26);
        for (int q = gt; q < 2 * 64 * DM; q += ngt) { const int L = q / (64 * DM), r = q % (64 * DM), e = r / DM, k = r % DM;
            const float w = rw[((size_t)L * DM + k) * 64 + e]; const bf16_t hi = f2bf(w); const bf16_t lo = f2bf(w - bf2f(hi));
            RWT[((size_t)(L * 2 + 0) * 64 + e) * DM + k] = hi; RWT[((size_t)(L * 2 + 1) * 64 + e) * DM + k] = lo; }
    }
    {
        const float* cvec = p.inp(1); const float* cctx = p.inp(3); const float* mw = p.inp(4);
        float* MODP = (float*)(p.ws + WS_MODP);
        for (int task = C.gw; task < 2 * 32 * 48; task += C.ngw) {
            const int L = task / (32 * 48), r = task % (32 * 48), kb = r / 48, cb = r % 48;
            const float sc = siluf_(cvec[64 * kb + C.lane]), sx = siluf_(cctx[64 * kb + C.lane]);
            f32x4 a0 = {0.f, 0.f, 0.f, 0.f}, a1 = {0.f, 0.f, 0.f, 0.f};
            const float* wp = mw + ((size_t)L * DM + 64 * kb) * 12288 + 256 * cb + 4 * C.lane;
#pragma unroll 8
            for (int kk = 0; kk < 64; ++kk) { const f32x4 w = *(const f32x4*)(wp + (size_t)kk * 12288);
                const float s0 = __shfl(sc, kk), s1 = __shfl(sx, kk);
                a0 += w * s0; a1 += w * s1; }
            *(f32x4*)(MODP + ((size_t)((L * 32 + kb) * 2 + 0)) * 12288 + 256 * cb + 4 * C.lane) = a0;
            *(f32x4*)(MODP + ((size_t)((L * 32 + kb) * 2 + 1)) * 12288 + 256 * cb + 4 * C.lane) = a1;
        }
    }
    {
        LAS float* scr = (LAS float*)(C.lds + C.wave * 17408);
        constexpr int J0 = (DM / 64) * (EV_IN / 64), J3 = (DM / 64) * (OD_IN / 64);
        for (int it = C.gw; it < J0 + J3; it += C.ngw) {
            const bool l1 = it >= J0; const int r = l1 ? it - J0 : it; const int N = l1 ? OD_IN : EV_IN; const int nblk = N / 64, kb = r / nblk, nb = r % nblk;
            tr_item64_fp8(p.inp(l1 ? 21 : 8), N, (unsigned char*)(p.ws + (l1 ? WS_WIN1 : WS_WIN0)), DM, 64 * kb, 64 * nb, 64 * nb, scr, C.lane, 32.0f);
        }
        LAS float* scr2 = (LAS float*)(C.lds + C.wave * 17408);
        constexpr int I1 = (DM / 64) * (DM / 32), I2 = (1024 / 64) * (1024 / 32), I4 = I1;
        for (int it = C.gw; it < I1 + I2 + I4; it += C.ngw) {
            int r = it;
            if (r < I1) { tr_dense(p.inp(9), DM, DM, (bf16_t*)(p.ws + WS_WOUT0), r, scr2, C.lane); continue; } r -= I1;
            if (r < I2) { tr_dense(p.inp(19), 1024, 1024, (bf16_t*)(p.ws + WS_WGLU), r, scr2, C.lane); continue; } r -= I2;
            tr_dense(p.inp(22), DM, DM, (bf16_t*)(p.ws + WS_WOUT1), r, scr2, C.lane);
        }
    }
}
__device__ __forceinline__ void phase_p1(const Params& p, Ctx& C) {
    const float* MODP = (const float*)(p.ws + WS_MODP); float* MODF = (float*)(p.ws + WS_MODF); const float* mb = p.inp(5);
    for (int q = C.bid * NTHR + C.tid; q < 2 * 2 * 12288; q += C.G * NTHR) { const int L = q / (2 * 12288), v = (q / 12288) & 1, col = q % 12288;
        float s = mb[L * 12288 + col];
        for (int kb = 0; kb < 32; ++kb) s += MODP[((size_t)((L * 32 + kb) * 2 + v)) * 12288 + col];
        MODF[q] = s; }
}
__device__ __forceinline__ const float* modv(const Params& p, int L, int v, int k) { return (const float*)(p.ws + WS_MODF) + (size_t)(L * 2 + v) * 12288 + k * DM; }

__device__ __forceinline__ void stage_vec(LAS float* dst, const float* src, int tid) { *(LAS f32x4*)(dst + 4 * tid) = *(const f32x4*)(src + 4 * tid); }
__device__ __forceinline__ void conv_item(const Params& p, Ctx& C, int L, int it) {
    LAS float* scr = (LAS float*)(C.lds + C.wave * 17408);
    unsigned char* GU = (unsigned char*)(p.ws + WS_GU) + (size_t)L * NEX1 * 1024 * DM; unsigned char* DT = (unsigned char*)(p.ws + WS_DT) + (size_t)L * NEX1 * DM * EHID;
    const int e = it / 768, r = it % 768, which = r >> 8, q = r & 255;
    if (which < 2) {
        const float* W = (e < 64) ? p.inp(28 + which) + ((size_t)(L * 64 + e)) * DM * EHID : p.inp(31 + which) + (size_t)L * DM * EHID;
        const int kb = q >> 3, nb = q & 7, n0 = 64 * nb;
        tr_item64_fp8(W, EHID, GU + (size_t)e * 1024 * DM, DM, 64 * kb, n0, 256 * (n0 >> 7) + (n0 & 127) + (which ? 128 : 0), scr, C.lane);
    } else {
        const float* W = (e < 64) ? p.inp(30) + ((size_t)(L * 64 + e)) * EHID * DM : p.inp(33) + (size_t)L * EHID * DM;
        const int kb = q >> 5, nb = q & 31;
        tr_item64_fp8(W, DM, DT + (size_t)e * DM * EHID, EHID, 64 * kb, 64 * nb, 64 * nb, scr, C.lane);
    }
}
__device__ __forceinline__ void conv_queue(const Params& p, Ctx& C, int quota) {
    unsigned* head = (unsigned*)(p.ws + WS_CTL) + CW_QUEUE + 128;
    const int batch = quota < 8 ? quota : 8;
    for (int done = 0; done < quota; done += batch) {
        int it0 = 0; if (C.lane == 0) it0 = (int)atomicAdd(head, (unsigned)batch);
        it0 = __builtin_amdgcn_readfirstlane(it0);
        if (it0 >= NEX1 * 768) break;
        for (int k = 0; k < batch && it0 + k < NEX1 * 768; ++k) conv_item(p, C, 1, it0 + k);
    }
}
__device__ __forceinline__ void phase_modulate(const Params& p, Ctx& C, int L) {
    unsigned char* XA8 = (unsigned char*)(p.ws + WS_XA);
    const float* X2 = (const float*)(p.ws + WS_HX2);
    LAS float* MV = (LAS float*)C.lds;
    for (int v = 0; v < 2; ++v) { stage_vec(MV + (v * 2 + 0) * DM, modv(p, L, v, 0), C.tid); stage_vec(MV + (v * 2 + 1) * DM, modv(p, L, v, 1), C.tid); }
    __syncthreads();
    for (int r = C.gw; r < TT; r += C.ngw) {
        const int v = r < CTXL ? 1 : 0;
        const float* src = (L == 0) ? (r < CTXL ? p.inp(2) + (size_t)r * DM : p.inp(0) + (size_t)(r - CTXL) * DM) : X2 + (size_t)r * DM;
        const LAS float* sh = MV + (v * 2 + 0) * DM; const LAS float* sc = MV + (v * 2 + 1) * DM;
#pragma unroll
        for (int j = 0; j < 8; ++j) { const int c = 4 * (C.lane + 64 * j);
            const f32x4 x = *(const f32x4*)(src + c), a = *(const LAS f32x4*)(sc + c), b = *(const LAS f32x4*)(sh + c);
            const f32x4 y = x * (a + 1.0f) + b;
            unsigned w = (unsigned)__builtin_amdgcn_cvt_pk_fp8_f32(y[0], y[1], 0, false); w = (unsigned)__builtin_amdgcn_cvt_pk_fp8_f32(y[2], y[3], (int)w, true);
            *(unsigned*)(XA8 + (size_t)r * DM + c) = w; }
    }
    __syncthreads();
    if (L == 0) { for (int it = C.gw; it < NEX1 * 768; it += C.ngw) conv_item(p, C, 0, it); }
    else conv_queue(p, C, 1 << 30);
}

__device__ __forceinline__ void phase_rope0(const Params& p, Ctx& C) {
    bf16_t* QKV = (bf16_t*)(p.ws + WS_BIG + BG_QKV);
    const f32x2* R128 = (const f32x2*)(p.ws + WS_ROPE128);
    for (int r = C.gw; r < TT; r += C.ngw) {
        bf16_t* row = QKV + (size_t)r * EV_IN;
        if (r < CTXL) {
#pragma unroll
            for (int j = 0; j < 2; ++j) { u32x4* q = (u32x4*)(row + 8 * (C.lane + 64 * j)); u32x4 w = *q;
                w.x = cvt_pk_bf16(bflo(w.x) * 0.0625f, bfhi(w.x) * 0.0625f); w.y = cvt_pk_bf16(bflo(w.y) * 0.0625f, bfhi(w.y) * 0.0625f);
                w.z = cvt_pk_bf16(bflo(w.z) * 0.0625f, bfhi(w.z) * 0.0625f); w.w = cvt_pk_bf16(bflo(w.w) * 0.0625f, bfhi(w.w) * 0.0625f); *q = w; }
        } else {
            const int l = r - CTXL, rp = l >> 6, cp = l & 63;
#pragma unroll
            for (int qk = 0; qk < 2; ++qk)
#pragma unroll
                for (int m = 0; m < 8; ++m) { const int pi = C.lane + 64 * m, head = pi >> 7, blk = (pi >> 6) & 1, i = pi & 63;
                    bf16_t* b = row + qk * 1024 + head * 256 + blk * 128 + i;
                    const f32x2 cs = R128[(blk ? cp : rp) * 64 + i];
                    const float x1 = bf2f(b[0]), x2 = bf2f(b[64]); const float sc = qk ? 1.0f : 0.0625f;
                    b[0] = f2bf((x1 * cs.x - x2 * cs.y) * sc); b[64] = f2bf((x1 * cs.y + x2 * cs.x) * sc); }
        }
    }
}

__device__ __forceinline__ void phase_normrope1(const Params& p, Ctx& C) {
    bf16_t* QKV = (bf16_t*)(p.ws + WS_BIG + BG_QKV);
    const f32x2* R64 = (const f32x2*)(p.ws + WS_ROPE64);
    const float* qg = p.inp(23);
    unsigned* KMAX = (unsigned*)(p.ws + WS_CTL) + CW_KMAX;
    const int lane = C.lane, i32 = lane & 31; const bool up = lane >= 32;
    const float g00 = qg[lane], g01 = qg[64 + lane], g10 = qg[128 + lane], g11 = qg[128 + 64 + lane];
    for (int r = C.gw; r < TT; r += C.ngw) {
        bf16_t* row = QKV + (size_t)r * OD_IN;
        const bool lat = r >= CTXL; const int l = r - CTXL, rp = lat ? (l >> 6) : 0, cp = lat ? (l & 63) : 0;
        const f32x2 cr = R64[rp * 32 + i32], cc = R64[cp * 32 + i32];
#pragma unroll 2
        for (int h = 0; h < 26; ++h) {
            const int col = h < 8 ? 128 * h : (h < 10 ? 1024 + 128 * (h - 8) : (h < 18 ? 1536 + 128 * (h - 10) : 2560 + 128 * (h - 18)));
            bf16_t* b = row + col;
            float v0 = bf2f(b[lane]), v1 = bf2f(b[64 + lane]);
            if (h < 10) { const float ss = wave_sum(v0 * v0 + v1 * v1); const float rs = rsqrtf(ss * (1.0f / 128.0f) + LN_EPS);
                v0 = bf2f(f2bf(v0 * rs)) * (h < 8 ? g00 : g10); v1 = bf2f(f2bf(v1 * rs)) * (h < 8 ? g01 : g11); }
            if (lat) { const float p0 = __shfl_xor(v0, 32), p1 = __shfl_xor(v1, 32);
                v0 = up ? (p0 * cr.y + v0 * cr.x) : (v0 * cr.x - p0 * cr.y);
                v1 = up ? (p1 * cc.y + v1 * cc.x) : (v1 * cc.x - p1 * cc.y); }
            const bf16_t o0 = f2bf(v0), o1 = f2bf(v1);
            b[lane] = o0; b[64 + lane] = o1;
            if ((h >= 8 && h < 10) || h >= 18) {
                const float w0 = bf2f(o0), w1 = bf2f(o1); const float k2 = wave_sum(w0 * w0 + w1 * w1);
                if (lane == 0) atomicMax(KMAX + 64 * (h < 10 ? h - 8 : h - 16), __float_as_uint(k2)); }
        }
    }
}

__device__ __forceinline__ void phase_merge1(const Params& p, Ctx& C) {
    bf16_t* ATT = (bf16_t*)(p.ws + WS_BIG + BG_ATT);
    const float* dl = p.inp(24); const float* sg = p.inp(25);
    const int lane = C.lane;
    float d0 = dl[lane] * dl[128 + lane] + dl[64 + lane] * dl[128 + 64 + lane];
    float d1 = dl[256 + lane] * dl[384 + lane] + dl[256 + 64 + lane] * dl[384 + 64 + lane];
    const float lam = __expf(wave_sum(d0)) - __expf(wave_sum(d1)) + LAMBDA_INIT;
    const f32x4 gg = *(const f32x4*)(sg + 4 * lane);
    for (int l = C.gw; l < SEQ; l += C.ngw) {
        bf16_t* row = ATT + (size_t)l * 3072;
#pragma unroll
        for (int h = 0; h < 4; ++h) {
            const u32x2 a = *(const u32x2*)(row + 1024 + 256 * h + 4 * lane), b = *(const u32x2*)(row + 2048 + 256 * h + 4 * lane);
            f32x4 o = {bflo(a.x) - lam * bflo(b.x), bfhi(a.x) - lam * bfhi(b.x), bflo(a.y) - lam * bflo(b.y), bfhi(a.y) - lam * bfhi(b.y)};
            const float ss = wave_sum(o[0] * o[0] + o[1] * o[1] + o[2] * o[2] + o[3] * o[3]);
            const float rs = rsqrtf(ss * (1.0f / 256.0f) + LN_EPS) * (1.0f - LAMBDA_INIT);
            o = o * rs * gg;
            u32x2 w; w.x = cvt_pk_bf16(o[0], o[1]); w.y = cvt_pk_bf16(o[2], o[3]);
            *(u32x2*)(row + 1024 + 256 * h + 4 * lane) = w;
        }
    }
}

__device__ __forceinline__ void phase_ln1(const Params& p, Ctx& C, int L) {
    const bf16_t* Y = (const bf16_t*)(p.ws + WS_YMIX); float* X1 = (float*)(p.ws + WS_X1); unsigned char* XA8 = (unsigned char*)(p.ws + WS_XA);
    const float* X2 = (const float*)(p.ws + WS_HX2);
    const float* lg = p.inp(6) + (size_t)(L * 2 + 0) * DM; const float* lb = p.inp(7) + (size_t)(L * 2 + 0) * DM;
    const int r0 = (L == 0) ? 0 : CTXL;
    LAS float* MV = (LAS float*)C.lds; LAS float* LG = MV + 6 * DM; LAS float* LB = LG + DM;
    for (int v = 0; v < 2; ++v) for (int k = 0; k < 3; ++k) stage_vec(MV + (v * 3 + k) * DM, modv(p, L, v, 2 + k), C.tid);
    stage_vec(LG, lg, C.tid); stage_vec(LB, lb, C.tid);
    __syncthreads();
    for (int r = r0 + C.gw; r < TT; r += C.ngw) {
        const int v = r < CTXL ? 1 : 0;
        const float* src = (L == 0) ? (r < CTXL ? p.inp(2) + (size_t)r * DM : p.inp(0) + (size_t)(r - CTXL) * DM) : X2 + (size_t)r * DM;
        const LAS float* g1 = MV + (v * 3 + 0) * DM; const LAS float* sh2 = MV + (v * 3 + 1) * DM; const LAS float* sc2 = MV + (v * 3 + 2) * DM;
        f32x4 t[8]; float s = 0.f;
#pragma unroll
        for (int j = 0; j < 8; ++j) { const int c = 4 * (C.lane + 64 * j);
            const f32x4 x = *(const f32x4*)(src + c), g = *(const LAS f32x4*)(g1 + c); const u32x2 yy = *(const u32x2*)(Y + (size_t)r * DM + c);
            const f32x4 y = {bflo(yy.x), bfhi(yy.x), bflo(yy.y), bfhi(yy.y)};
            t[j] = x * ALPHA + g * y; s += (t[j][0] + t[j][1]) + (t[j][2] + t[j][3]); }
        const float mean = wave_sum(s) * (1.0f / DM); float s2 = 0.f;
#pragma unroll
        for (int j = 0; j < 8; ++j) { t[j] = t[j] - mean; s2 += (t[j][0] * t[j][0] + t[j][1] * t[j][1]) + (t[j][2] * t[j][2] + t[j][3] * t[j][3]); }
        const float rstd = rsqrtf(wave_sum(s2) * (1.0f / DM) + LN_EPS);
#pragma unroll
        for (int j = 0; j < 8; ++j) { const int c = 4 * (C.lane + 64 * j);
            const f32x4 x1 = t[j] * rstd * *(const LAS f32x4*)(LG + c) + *(const LAS f32x4*)(LB + c);
            *(f32x4*)(X1 + (size_t)r * DM + c) = x1;
            const f32x4 z = x1 * (*(const LAS f32x4*)(sc2 + c) + 1.0f) + *(const LAS f32x4*)(sh2 + c);
            unsigned w = (unsigned)__builtin_amdgcn_cvt_pk_fp8_f32(z[0], z[1], 0, false); w = (unsigned)__builtin_amdgcn_cvt_pk_fp8_f32(z[2], z[3], (int)w, true);
            *(unsigned*)(XA8 + (size_t)r * DM + c) = w; }
    }
    __syncthreads();
}

__device__ __forceinline__ void phase_combine(const Params& p, Ctx& C, int L, LAS unsigned char* misc) {
    const unsigned char* YM = (const unsigned char*)(p.ws + WS_BIG + BG_YMOE); const float* X1 = (const float*)(p.ws + WS_X1);
    float* X2 = (float*)(p.ws + WS_HX2);
    const float* lg = p.inp(6) + (size_t)(L * 2 + 1) * DM; const float* lb = p.inp(7) + (size_t)(L * 2 + 1) * DM;
    const unsigned* PK = (const unsigned*)(p.ws + WS_WGT); const int* cnt = (const int*)(p.ws + WS_CTL) + CW_CNT + L * 128;
    const int r0 = (L == 0) ? 0 : CTXL;
    LAS int* rb = (LAS int*)(misc + 64);
    LAS float* MV = (LAS float*)C.lds; LAS float* LG = MV + 2 * DM; LAS float* LB = LG + DM;
    __syncthreads();
    if (C.tid == 0) { int q = 0; for (int e = 0; e < NEX1; ++e) { rb[e] = q; q += cnt[e]; } }
    stage_vec(MV, modv(p, L, 0, 5), C.tid); stage_vec(MV + DM, modv(p, L, 1, 5), C.tid); stage_vec(LG, lg, C.tid); stage_vec(LB, lb, C.tid);
    __syncthreads();
    for (int r = r0 + C.gw; r < TT; r += C.ngw) {
        const int v = r < CTXL ? 1 : 0;
        const LAS float* g2 = MV + v * DM;
        int ln = C.lane; asm volatile("" : "+v"(ln));
        int slot = rb[64] + (r - r0);
        if (ln < 8) { const unsigned pk = PK[(size_t)r * 8 + ln]; slot = rb[pk >> 16] + (int)(pk & 0xffffu); }
        f32x4 t[2][4]; float s = 0.f;
#pragma unroll
        for (int j = 0; j < 2; ++j) { const int c = 16 * (ln + 64 * j);
            u32x4 yy[9];
#pragma unroll
            for (int k = 0; k < 9; ++k) { const size_t a = (size_t)__builtin_amdgcn_readlane(slot, k); yy[k] = __builtin_nontemporal_load((const u32x4*)(YM + a * DM + c)); }
            f32x2 f[8];
#pragma unroll
            for (int q = 0; q < 8; ++q) f[q] = (f32x2){0.f, 0.f};
#pragma unroll
            for (int k = 0; k < 9; ++k) {
                f[0] += __builtin_amdgcn_cvt_pk_f32_fp8((int)yy[k].x, false); f[1] += __builtin_amdgcn_cvt_pk_f32_fp8((int)yy[k].x, true);
                f[2] += __builtin_amdgcn_cvt_pk_f32_fp8((int)yy[k].y, false); f[3] += __builtin_amdgcn_cvt_pk_f32_fp8((int)yy[k].y, true);
                f[4] += __builtin_amdgcn_cvt_pk_f32_fp8((int)yy[k].z, false); f[5] += __builtin_amdgcn_cvt_pk_f32_fp8((int)yy[k].z, true);
                f[6] += __builtin_amdgcn_cvt_pk_f32_fp8((int)yy[k].w, false); f[7] += __builtin_amdgcn_cvt_pk_f32_fp8((int)yy[k].w, true); }
#pragma unroll
            for (int q = 0; q < 4; ++q) { const f32x4 x = *(const f32x4*)(X1 + (size_t)r * DM + c + 4 * q), g = *(const LAS f32x4*)(g2 + c + 4 * q);
                const f32x4 ff = {f[2 * q][0], f[2 * q][1], f[2 * q + 1][0], f[2 * q + 1][1]};
                t[j][q] = x * ALPHA + g * ff; s += (t[j][q][0] + t[j][q][1]) + (t[j][q][2] + t[j][q][3]); } }
        const float mean = wave_sum(s) * (1.0f / DM); float s2 = 0.f;
#pragma unroll
        for (int j = 0; j < 2; ++j)
#pragma unroll
            for (int q = 0; q < 4; ++q) { t[j][q] = t[j][q] - mean; s2 += (t[j][q][0] * t[j][q][0] + t[j][q][1] * t[j][q][1]) + (t[j][q][2] * t[j][q][2] + t[j][q][3] * t[j][q][3]); }
        const float rstd = rsqrtf(wave_sum(s2) * (1.0f / DM) + LN_EPS);
        float* dst = (L == 0) ? X2 + (size_t)r * DM : p.out + (size_t)(r - CTXL) * DM;
#pragma unroll
        for (int j = 0; j < 2; ++j)
#pragma unroll
            for (int q = 0; q < 4; ++q) { const int c = 16 * (ln + 64 * j) + 4 * q;
                *(f32x4*)(dst + c) = t[j][q] * rstd * *(const LAS f32x4*)(LG + c) + *(const LAS f32x4*)(LB + c); }
    }
}
constexpr int RLD = 264;
constexpr int SLD = 136;

template <bool SCALE>
__device__ __forceinline__ void stage_chunk(const bf16_t* QKV, int row0, int col0, LAS bf16_t* dst, int tid, float lg  , int dirb) {
#pragma unroll
    for (int q = 0; q < 8; ++q) { const int idx = tid + NTHR * q, r = idx >> 5, c = idx & 31;
        u32x4 w = *(const u32x4*)(QKV + (size_t)(row0 + r) * EV_IN + col0 + 8 * c);
        if (SCALE) { const float sc = fast_exp((dirb ? (float)r : (float)(127 - r)) * lg);
            w.x = cvt_pk_bf16(bflo(w.x) * sc, bfhi(w.x) * sc); w.y = cvt_pk_bf16(bflo(w.y) * sc, bfhi(w.y) * sc);
            w.z = cvt_pk_bf16(bflo(w.z) * sc, bfhi(w.z) * sc); w.w = cvt_pk_bf16(bflo(w.w) * sc, bfhi(w.w) * sc); }
        *(LAS u32x4*)(dst + r * RLD + 8 * c) = w; }
}

__device__ __forceinline__ void ret_chunk_kv(const Params& p, Ctx& C) {
    const bf16_t* QKV = (const bf16_t*)(p.ws + WS_BIG + BG_QKV); float* CKV = (float*)(p.ws + WS_BIG + BG_CKV);
    const float* rld = p.inp(10);
    LAS bf16_t* Vs = (LAS bf16_t*)C.lds; LAS bf16_t* Ks = Vs + 128 * RLD;
    const int lane = C.lane, w = C.wave;
    for (int unit = C.bid; unit < 130 * 8; unit += C.G) {
        const int u = unit >> 3, h = (unit >> 1) & 3, dir = unit & 1;
        const float lg = rld[dir * 4 + h];
        __syncthreads();
        stage_chunk<false>(QKV, 128 * u, 2048 + 256 * h, Vs, C.tid, 0.f, 0);
        stage_chunk<true>(QKV, 128 * u, 1024 + 256 * h, Ks, C.tid, lg, dir);
        __syncthreads();
        f32x4 acc[2][16];
#pragma unroll
        for (int a = 0; a < 2; ++a)
#pragma unroll
            for (int b = 0; b < 16; ++b) acc[a][b] = (f32x4){0.f, 0.f, 0.f, 0.f};
        const unsigned vbase = (unsigned)(uintptr_t)Vs, kbase = (unsigned)(uintptr_t)Ks;
#pragma unroll 1
        for (int ks = 0; ks < 4; ++ks) {
            bf16x8 af[2];
#pragma unroll
            for (int a = 0; a < 2; ++a) af[a] = frag_colk_l(vbase + (unsigned)((32 * ks) * RLD + 32 * w + 16 * a) * 2u, RLD * 2, lane);
#pragma unroll
            for (int b = 0; b < 16; ++b) { const bf16x8 bf = frag_colk_l(kbase + (unsigned)((32 * ks) * RLD + 16 * b) * 2u, RLD * 2, lane);
                acc[0][b] = MFMA16(af[0], bf, acc[0][b]); acc[1][b] = MFMA16(af[1], bf, acc[1][b]); }
        }
        float* dst = CKV + ((size_t)((dir * 4 + h) * 130 + u)) * 65536;
#pragma unroll
        for (int a = 0; a < 2; ++a)
#pragma unroll
            for (int b = 0; b < 16; ++b)
#pragma unroll
                for (int j = 0; j < 4; ++j) dst[(size_t)(32 * w + 16 * a + 4 * (lane >> 4) + j) * 256 + 16 * b + (lane & 15)] = acc[a][b][j];
    }
    __syncthreads();
}

__device__ __forceinline__ int s5_row(int dir, int c, int s) { return dir == 0 ? 64 * c + s : (c < 4 ? 255 - (64 * c + s) : 16639 - 64 * (c - 4) - s); }

__device__ __forceinline__ void s5_end_states(const Params& p, Ctx& C) {
    const bf16_t* QKV = (const bf16_t*)(p.ws + WS_BIG + BG_QKV); const bf16_t* WTt = (const bf16_t*)(p.ws + WS_WT); float* E = (float*)(p.ws + WS_S5E);
    const int lane = C.lane, kq = lane >> 4;
    for (int task = C.gw; task < 2 * 64 * 17; task += C.ngw) {
        const int dir = task / (64 * 17), r = task % (64 * 17), g = r / 17, ct = r % 17;
        int cc = 16 * ct + (lane & 15); const bool valid = cc < 260; cc = valid ? cc : 259;
        const bf16_t* wt = WTt + (size_t)(dir * 64 + g) * 128 * 1024;
        f32x4 acc[8];
#pragma unroll
        for (int t = 0; t < 8; ++t) acc[t] = (f32x4){0.f, 0.f, 0.f, 0.f};
#pragma unroll 2
        for (int ks = 0; ks < 32; ++ks) {
            const int s = 2 * ks + (kq >> 1);
            const bf16x8 bf = *(const bf16x8*)(QKV + (size_t)s5_row(dir, cc, s) * EV_IN + 4096 + 16 * g + 8 * (kq & 1));
#pragma unroll
            for (int t = 0; t < 8; ++t) { const bf16x8 af = frag_rowk_g(wt + (size_t)(16 * t) * 1024 + 32 * ks, 1024, lane); acc[t] = MFMA16(af, bf, acc[t]); }
        }
        if (valid) { float* dst = E + ((size_t)((dir * 64 + g) * 260 + cc)) * 128;
#pragma unroll
            for (int t = 0; t < 8; ++t) *(f32x4*)(dst + 16 * t + 4 * kq) = acc[t]; }
    }
}

__device__ __forceinline__ void phase_scans(const Params& p, Ctx& C) {
    const float* CKV = (const float*)(p.ws + WS_BIG + BG_CKV); bf16_t* SP = (bf16_t*)(p.ws + WS_BIG + BG_SPREV);
    const float* rld = p.inp(10);
    for (int q = C.bid * NTHR + C.tid; q < 8 * 16384; q += C.G * NTHR) {
        const int dh = q >> 14, el = (q & 16383) * 4, dir = dh >> 2, h = dh & 3;
        const float gch = fast_exp(128.0f * rld[dir * 4 + h]);
        const float* src = CKV + (size_t)dh * 130 * 65536 + el; bf16_t* dst = SP + (size_t)dh * 130 * 65536 + el;
        f32x4 s = {0.f, 0.f, 0.f, 0.f};
        for (int st0 = 0; st0 < 130; st0 += 10) {
            f32x4 kv[10];
#pragma unroll
            for (int k = 0; k < 10; ++k) { const int st = st0 + k; const int u = dir == 0 ? st : (st == 0 ? 1 : (st == 1 ? 0 : 131 - st)); kv[k] = *(const f32x4*)(src + (size_t)u * 65536); }
#pragma unroll
            for (int k = 0; k < 10; ++k) { const int st = st0 + k; const int u = dir == 0 ? st : (st == 0 ? 1 : (st == 1 ? 0 : 131 - st));
                u32x2 w; w.x = cvt_pk_bf16(s[0], s[1]); w.y = cvt_pk_bf16(s[2], s[3]); *(u32x2*)(dst + (size_t)u * 65536) = w;
                s = s * gch + kv[k]; }
        }
    }
    const float* E = (const float*)(p.ws + WS_S5E); float* HST = (float*)(p.ws + WS_HST); const float* AL = (const float*)(p.ws + WS_AL);
    for (int q = C.bid * NTHR + C.tid; q < 2 * 64 * 64; q += C.G * NTHR) {
        const int dg = q >> 6, pp = q & 63;
        const f32x2 al = *(const f32x2*)(AL + (size_t)dg * 128 + 2 * pp);
        const float* e = E + (size_t)dg * 260 * 128; float* hs = HST + (size_t)dg * 260 * 128;
        float hr = 0.f, hi = 0.f;
        for (int c0 = 0; c0 < 260; c0 += 10) {
            float er[10], ei[10];
#pragma unroll
            for (int k = 0; k < 10; ++k) { er[k] = e[(size_t)(c0 + k) * 128 + pp]; ei[k] = e[(size_t)(c0 + k) * 128 + 64 + pp]; }
#pragma unroll
            for (int k = 0; k < 10; ++k) { *(f32x2*)(hs + (size_t)(c0 + k) * 128 + 2 * pp) = (f32x2){hr, hi};
                const float t = al.x * hr - al.y * hi + er[k]; hi = al.x * hi + al.y * hr + ei[k]; hr = t; }
        }
    }
}

__device__ __forceinline__ void ret_output_unit(const Params& p, Ctx& C, int unit) {
    const bf16_t* QKV = (const bf16_t*)(p.ws + WS_BIG + BG_QKV); const bf16_t* SP = (const bf16_t*)(p.ws + WS_BIG + BG_SPREV);
    bf16_t* MIX = (bf16_t*)(p.ws + WS_BIG + BG_MIX);
    const float* rld = p.inp(10);
    LAS bf16_t* RA = (LAS bf16_t*)C.lds; LAS bf16_t* RB = RA + 128 * RLD;
    int tid = C.tid; asm volatile("" : "+v"(tid));
    const int lane = tid & 63, w = C.wave, kq = lane >> 4, fr = lane & 15;
    const int u = unit >> 2, h = unit & 3;
    const float lgf = rld[h], lgb = rld[4 + h];
    stage_chunk<false>(QKV, 128 * u, 256 * h, RA, tid, 0.f, 0);
    int ib = 16 * w + 4 * kq, jb = fr; asm volatile("" : "+v"(ib), "+v"(jb));
    f32x4 acc[16];
#pragma unroll
    for (int t = 0; t < 16; ++t) acc[t] = (f32x4){0.f, 0.f, 0.f, 0.f};
#pragma unroll
    for (int dir = 0; dir < 2; ++dir) {
        const bf16_t* Sd = SP + ((size_t)((dir * 4 + h) * 130 + u)) * 65536;
#pragma unroll
        for (int eh = 0; eh < 2; ++eh) {
            __syncthreads();
#pragma unroll
            for (int q = 0; q < 8; ++q) { const int idx = tid + NTHR * q, rr = idx >> 5, c = idx & 31;
                *(LAS u32x4*)(RB + rr * RLD + 8 * c) = *(const u32x4*)(Sd + (size_t)(128 * eh + rr) * 256 + 8 * c);
                if (q == 3) asm volatile("" ::: "memory"); }
            __syncthreads();
#pragma unroll 1
            for (int ks = 0; ks < 8; ++ks) { const bf16x8 af = frag_rowk_l(RA + (16 * w) * RLD + 32 * ks, RLD, lane);
#pragma unroll
                for (int t = 0; t < 8; ++t) { const bf16x8 bf = frag_rowk_l(RB + (16 * t) * RLD + 32 * ks, RLD, lane); acc[8 * eh + t] = MFMA16(af, bf, acc[8 * eh + t]); } }
        }
#pragma unroll
        for (int r = 0; r < 4; ++r) { const int i = ib + r; const float qd = fast_exp((float)(128 - i) * lgb);
            const float f = (dir == 0) ? fast_exp((float)(i + 1) * lgf) / qd : qd;
#pragma unroll
            for (int t = 0; t < 16; ++t) acc[t][r] *= f; }
    }
    __syncthreads();
    stage_chunk<false>(QKV, 128 * u, 1024 + 256 * h, RB, tid, 0.f, 0);
    __syncthreads();
    f32x4 sc[8];
#pragma unroll
    for (int t = 0; t < 8; ++t) sc[t] = (f32x4){0.f, 0.f, 0.f, 0.f};
#pragma unroll 1
    for (int ks = 0; ks < 8; ++ks) { const bf16x8 af = frag_rowk_l(RA + (16 * w) * RLD + 32 * ks, RLD, lane);
#pragma unroll
        for (int t = 0; t < 8; ++t) { const bf16x8 bf = frag_rowk_l(RB + (16 * t) * RLD + 32 * ks, RLD, lane); sc[t] = MFMA16(af, bf, sc[t]); } }
#pragma unroll
    for (int t = 0; t < 8; ++t)
#pragma unroll
        for (int r = 0; r < 4; ++r) { const int i = ib + r, j = 16 * t + jb; const float d = (float)(i - j);
            const float m = (i >= j ? fast_exp(d * lgf) : 0.f) + (j >= i ? fast_exp(-d * lgb) : 0.f); sc[t][r] *= m; }
    __syncthreads();
    stage_chunk<false>(QKV, 128 * u, 2048 + 256 * h, RA, tid, 0.f, 0);
#pragma unroll
    for (int t = 0; t < 8; ++t)
#pragma unroll
        for (int r = 0; r < 4; ++r) RB[(16 * w + 4 * kq + r) * SLD + 16 * t + fr] = f2bf(sc[t][r]);
    __syncthreads();
    const unsigned vbase = (unsigned)(uintptr_t)RA;
#pragma unroll 1
    for (int ks = 0; ks < 4; ++ks) { const bf16x8 af = frag_rowk_l(RB + (16 * w) * SLD + 32 * ks, SLD, lane);
#pragma unroll
        for (int t = 0; t < 16; ++t) { const bf16x8 bf = frag_colk_l(vbase + (unsigned)((32 * ks) * RLD + 16 * t) * 2u, RLD * 2, lane); acc[t] = MFMA16(af, bf, acc[t]); } }
    __syncthreads();
#pragma unroll
    for (int r = 0; r < 4; ++r) {
        float s = 0.f;
#pragma unroll
        for (int t = 0; t < 16; ++t) s += acc[t][r];
        s += __shfl_xor(s, 1); s += __shfl_xor(s, 2); s += __shfl_xor(s, 4); s += __shfl_xor(s, 8);
        const float mean = s * (1.0f / 256.0f); float q = 0.f;
#pragma unroll
        for (int t = 0; t < 16; ++t) { const float d = acc[t][r] - mean; q += d * d; }
        q += __shfl_xor(q, 1); q += __shfl_xor(q, 2); q += __shfl_xor(q, 4); q += __shfl_xor(q, 8);
        const float rstd = rsqrtf(q * (1.0f / 256.0f) + LN_EPS);
#pragma unroll
        for (int t = 0; t < 16; ++t) RA[(16 * w + 4 * kq + r) * RLD + 16 * t + fr] = f2bf((acc[t][r] - mean) * rstd);
    }
    __syncthreads();
#pragma unroll
    for (int q = 0; q < 8; ++q) { const int idx = tid + NTHR * q, rr = idx >> 5, c = idx & 31; const size_t row = (size_t)(128 * u + rr);
        const u32x4 o = *(const LAS u32x4*)(RA + rr * RLD + 8 * c), g = *(const u32x4*)(QKV + row * EV_IN + 3072 + 256 * h + 8 * c);
        u32x4 w4;
        w4.x = cvt_pk_bf16(bflo(o.x) * siluf_(bflo(g.x)), bfhi(o.x) * siluf_(bfhi(g.x))); w4.y = cvt_pk_bf16(bflo(o.y) * siluf_(bflo(g.y)), bfhi(o.y) * siluf_(bfhi(g.y)));
        w4.z = cvt_pk_bf16(bflo(o.z) * siluf_(bflo(g.z)), bfhi(o.z) * siluf_(bfhi(g.z))); w4.w = cvt_pk_bf16(bflo(o.w) * siluf_(bflo(g.w)), bfhi(o.w) * siluf_(bfhi(g.w)));
        *(u32x4*)(MIX + row * DM + 256 * h + 8 * c) = w4; }
    __syncthreads();
}

constexpr int KLD = 1032;
__device__ __forceinline__ void s5_output_task(const Params& p, Ctx& C, int bt) {
    const bf16_t* QKV = (const bf16_t*)(p.ws + WS_BIG + BG_QKV); bf16_t* Z = (bf16_t*)(p.ws + WS_Z);
    const bf16_t* KN = (const bf16_t*)(p.ws + WS_KN); const bf16_t* CCt = (const bf16_t*)(p.ws + WS_CC);
    const float* APOW = (const float*)(p.ws + WS_APOW); const float* HST = (const float*)(p.ws + WS_HST); const float* dsk = p.inp(18);
    int tid = C.tid; asm volatile("" : "+v"(tid));
    const int lane = tid & 63, kq = lane >> 4, fr = lane & 15;
    LAS bf16_t* KF = (LAS bf16_t*)C.lds; LAS bf16_t* KB = KF + 16 * KLD;
    LAS bf16_t* U = KB + 16 * KLD + C.wave * 3072;
    LAS float* PW0 = (LAS float*)(KB + 16 * KLD + 8 * 3072);
    LAS float* PW16 = PW0 + 2 * 16 * 128;
    {
        const int g = bt >> 3, k0 = (260 * (bt & 7)) >> 3, k1 = (260 * ((bt & 7) + 1)) >> 3;
#pragma unroll
        for (int q = 0; q < 8; ++q) { const int idx = tid + NTHR * q, dir = idx >> 11, rr = (idx >> 7) & 15, c = idx & 127;
            *(LAS u32x4*)((dir ? KB : KF) + rr * KLD + 8 * c) = *(const u32x4*)(KN + ((size_t)(dir * 64 + g) * 16 + rr) * 1024 + 8 * c); }
        for (int q = lane; q < 192 * 2; q += 64) *(LAS u32x4*)(U + 8 * q) = (u32x4){0u, 0u, 0u, 0u};
#pragma unroll
        for (int q = 0; q < 2; ++q) { const int idx = tid + NTHR * q, dir = idx >> 9, f = (idx >> 5) & 15, c4 = idx & 31;
            *(LAS f32x4*)(PW0 + dir * 2048 + f * 128 + 4 * c4) = *(const f32x4*)(APOW + ((size_t)(dir * 64 + g) * 64 + (dir == 0 ? f : 15 - f)) * 128 + 4 * c4); }
        if (tid < 64) { const int dir = tid >> 5, c4 = tid & 31; *(LAS f32x4*)(PW16 + dir * 128 + 4 * c4) = *(const f32x4*)(APOW + ((size_t)(dir * 64 + g) * 64 + 15) * 128 + 4 * c4); }
        __syncthreads();
        const f32x4 dv = *(const f32x4*)(dsk + 16 * g + 4 * kq);
        bf16x8 ccr[2], cci[2];
#pragma unroll
        for (int hb = 0; hb < 2; ++hb) { ccr[hb] = frag_rowk_g(CCt + (size_t)g * 16 * 128 + 32 * hb, 128, lane); cci[hb] = frag_rowk_g(CCt + (size_t)g * 16 * 128 + 64 + 32 * hb, 128, lane); }
        const LAS float* pw0l = PW0 + (size_t)fr * 128 + 16 * kq;
        const LAS float* pw16l = PW16 + 16 * kq;
        for (int k = k0 + C.wave; k < k1; k += 8) {
            LDS_WAIT(); asm volatile("" ::: "memory");
            for (int q = lane; q < 128; q += 64) { const int t = q >> 1, hf = q & 1;
                *(LAS u32x4*)(U + (64 + t) * 16 + 8 * hf) = *(const u32x4*)(QKV + (size_t)(64 * k + t) * EV_IN + 4096 + 16 * g + 8 * hf); }
            LDS_WAIT(); asm volatile("" ::: "memory");
            const int cf = k, cb = k < 4 ? 3 - k : 263 - k;
            f32x4 acc[4];
#pragma unroll
            for (int tt = 0; tt < 4; ++tt) acc[tt] = (f32x4){0.f, 0.f, 0.f, 0.f};
            const LAS bf16_t* ubf = U + (64 + fr - (kq >> 1)) * 16 + 8 * (kq & 1);
            const LAS bf16_t* ubb = U + (64 + fr + (kq >> 1)) * 16 + 8 * (kq & 1);
#pragma unroll
            for (int n0 = 0; n0 < 64; n0 += 2) {
                const bf16x8 af = frag_rowk_l(KF + n0 * 16, KLD, lane), ab = frag_rowk_l(KB + n0 * 16, KLD, lane);
#pragma unroll
                for (int tt = 0; tt < 4; ++tt) {
                    if (n0 <= 16 * tt + 14) acc[tt] = MFMA16(af, *(const LAS bf16x8*)(ubf + (16 * tt - n0) * 16), acc[tt]);
                    if (n0 <= 62 - 16 * tt) acc[tt] = MFMA16(ab, *(const LAS bf16x8*)(ubb + (16 * tt + n0) * 16), acc[tt]);
                }
                asm volatile("" ::: "memory");
            }
#pragma unroll
            for (int dir = 0; dir < 2; ++dir) {
                const float* hp = HST + ((size_t)(dir * 64 + g) * 260 + (dir == 0 ? cf : cb)) * 128;
#pragma unroll
                for (int hb = 0; hb < 2; ++hb) {
                    float xr[8], xi[8];
#pragma unroll
                    for (int e2 = 0; e2 < 4; ++e2) { const f32x4 h4 = *(const f32x4*)(hp + 2 * (32 * hb + 8 * kq) + 4 * e2), b4 = *(const LAS f32x4*)(pw0l + dir * 2048 + hb * 64 + 4 * e2);
                        xr[2 * e2] = b4[0] * h4[0] - b4[1] * h4[1]; xi[2 * e2] = b4[0] * h4[1] + b4[1] * h4[0];
                        xr[2 * e2 + 1] = b4[2] * h4[2] - b4[3] * h4[3]; xi[2 * e2 + 1] = b4[2] * h4[3] + b4[3] * h4[2]; }
#pragma unroll
                    for (int st = 0; st < 4; ++st) {
                        const int tt = dir == 0 ? st : 3 - st;
                        u32x4 br, bi;
                        br.x = cvt_pk_bf16(xr[0], xr[1]); br.y = cvt_pk_bf16(xr[2], xr[3]); br.z = cvt_pk_bf16(xr[4], xr[5]); br.w = cvt_pk_bf16(xr[6], xr[7]);
                        bi.x = cvt_pk_bf16(xi[0], xi[1]); bi.y = cvt_pk_bf16(xi[2], xi[3]); bi.z = cvt_pk_bf16(xi[4], xi[5]); bi.w = cvt_pk_bf16(xi[6], xi[7]);
                        acc[tt] = MFMA16(ccr[hb], __builtin_bit_cast(bf16x8, br), acc[tt]);
                        acc[tt] = MFMA16(cci[hb], __builtin_bit_cast(bf16x8, bi), acc[tt]);
                        if (st < 3) {
#pragma unroll
                            for (int e2 = 0; e2 < 4; ++e2) { const f32x4 a4 = *(const LAS f32x4*)(pw16l + dir * 128 + hb * 64 + 4 * e2);
                                float t0 = xr[2 * e2] * a4[0] - xi[2 * e2] * a4[1]; xi[2 * e2] = xr[2 * e2] * a4[1] + xi[2 * e2] * a4[0]; xr[2 * e2] = t0;
                                t0 = xr[2 * e2 + 1] * a4[2] - xi[2 * e2 + 1] * a4[3]; xi[2 * e2 + 1] = xr[2 * e2 + 1] * a4[3] + xi[2 * e2 + 1] * a4[2]; xr[2 * e2 + 1] = t0; }
                        }
                    }
                }
            }
#pragma unroll
            for (int tt = 0; tt < 4; ++tt) { const int t = 16 * tt + fr;
                const u32x2 uu = *(const LAS u32x2*)(U + (64 + t) * 16 + 4 * kq);
                const float y0 = acc[tt][0] + bflo(uu.x) * dv[0], y1 = acc[tt][1] + bfhi(uu.x) * dv[1], y2 = acc[tt][2] + bflo(uu.y) * dv[2], y3 = acc[tt][3] + bfhi(uu.y) * dv[3];
                u32x2 w; w.x = cvt_pk_bf16(gelu_tanh(y0), gelu_tanh(y1)); w.y = cvt_pk_bf16(gelu_tanh(y2), gelu_tanh(y3));
                *(u32x2*)(Z + (size_t)(64 * k + t) * 1024 + 16 * g + 4 * kq) = w; }
        }
    }
    __syncthreads();
}

__device__ __forceinline__ void phase_ret_s5_outputs(const Params& p, Ctx& C, LAS unsigned char* misc) {
    unsigned* head = (unsigned*)(p.ws + WS_CTL) + CW_QUEUE;
    volatile LAS int* slot = (volatile LAS int*)(misc + 32);
    for (;;) {
        __syncthreads();
        if (C.tid == 0) slot[0] = (int)atomicAdd(head, 1u);
        __syncthreads();
        const int item = __builtin_amdgcn_readfirstlane(slot[0]);
        if (item >= 520) break;
        ret_output_unit(p, C, item);
    }
    for (;;) {
        __syncthreads();
        if (C.tid == 0) slot[0] = (int)atomicAdd(head + 64, 1u);
        __syncthreads();
        const int item = __builtin_amdgcn_readfirstlane(slot[0]);
        if (item >= 512) break;
        s5_output_task(p, C, item);
    }
}
__device__ __forceinline__ void phase_router(const Params& p, Ctx& C, int L) {
    const float* X1 = (const float*)(p.ws + WS_X1);
    const bf16_t* RWh = (const bf16_t*)(p.ws + WS_RWT) + (size_t)(L * 2 + 0) * 64 * DM; const bf16_t* RWl = (const bf16_t*)(p.ws + WS_RWT) + (size_t)(L * 2 + 1) * 64 * DM;
    const float* rbias = p.inp(27) + L * 64;
    int* cnt = (int*)(p.ws + WS_CTL) + CW_CNT + L * 128; int* LIST = (int*)(p.ws + WS_LIST); unsigned* PK = (unsigned*)(p.ws + WS_WGT); float* LW = (float*)(p.ws + WS_LW);
    const int lane = C.lane, kq = lane >> 4, fr = lane & 15;
    LAS float* Lg = (LAS float*)(C.lds + C.wave * 8192);
    const int r0 = (L == 0) ? 0 : CTXL, nrows = TT - r0;
    if (C.bid == 0 && C.tid == 0) cnt[64] = nrows;
    for (int task = C.gw; task < nrows / 16; task += C.ngw) {
        const int rbase = r0 + 16 * task, row = rbase + fr;
        const int v = row < CTXL ? 1 : 0;
        const float* xr = X1 + (size_t)row * DM; const float* sc2 = modv(p, L, v, 4); const float* sh2 = modv(p, L, v, 3);
        f32x4 acc[4];
#pragma unroll
        for (int t = 0; t < 4; ++t) acc[t] = (f32x4){0.f, 0.f, 0.f, 0.f};
#pragma unroll 2
        for (int ks = 0; ks < 64; ++ks) { const int c0 = 32 * ks + 8 * kq;
            const f32x4 x0 = *(const f32x4*)(xr + c0), x1 = *(const f32x4*)(xr + c0 + 4);
            const f32x4 a0 = *(const f32x4*)(sc2 + c0), a1 = *(const f32x4*)(sc2 + c0 + 4), b0 = *(const f32x4*)(sh2 + c0), b1 = *(const f32x4*)(sh2 + c0 + 4);
            const f32x4 y0 = x0 * (a0 + 1.0f) + b0, y1 = x1 * (a1 + 1.0f) + b1;
            u32x4 hi; hi.x = cvt_pk_bf16(y0[0], y0[1]); hi.y = cvt_pk_bf16(y0[2], y0[3]); hi.z = cvt_pk_bf16(y1[0], y1[1]); hi.w = cvt_pk_bf16(y1[2], y1[3]);
            u32x4 lo; lo.x = cvt_pk_bf16(y0[0] - bflo(hi.x), y0[1] - bfhi(hi.x)); lo.y = cvt_pk_bf16(y0[2] - bflo(hi.y), y0[3] - bfhi(hi.y));
            lo.z = cvt_pk_bf16(y1[0] - bflo(hi.z), y1[1] - bfhi(hi.z)); lo.w = cvt_pk_bf16(y1[2] - bflo(hi.w), y1[3] - bfhi(hi.w));
            const bf16x8 ah = __builtin_bit_cast(bf16x8, hi), al = __builtin_bit_cast(bf16x8, lo);
#pragma unroll
            for (int t = 0; t < 4; ++t) { const bf16x8 bh = frag_rowk_g(RWh + (size_t)(16 * t) * DM + 32 * ks, DM, lane), bl = frag_rowk_g(RWl + (size_t)(16 * t) * DM + 32 * ks, DM, lane);
                acc[t] = MFMA16(ah, bh, acc[t]); acc[t] = MFMA16(al, bh, acc[t]); acc[t] = MFMA16(ah, bl, acc[t]); } }
        LDS_WAIT(); asm volatile("" ::: "memory");
#pragma unroll
        for (int t = 0; t < 4; ++t)
#pragma unroll
            for (int r = 0; r < 4; ++r) Lg[(4 * kq + r) * 65 + 16 * t + fr] = acc[t][r];
        LDS_WAIT(); asm volatile("" ::: "memory");
        if (lane < 16) {
            LAS float* sr = Lg + lane * 65; const int trow = rbase + lane;
            float gs[8];
#pragma unroll
            for (int g = 0; g < 8; ++g) { float m1 = -1e30f, m2 = -1e30f;
                for (int j = 0; j < 8; ++j) { const int e = 8 * g + j; const float s = sigmoidf_(sr[e]); sr[e] = s; const float vv = s + rbias[e];
                    if (vv > m1) { m2 = m1; m1 = vv; } else if (vv > m2) m2 = vv; }
                gs[g] = m1 + m2; }
            unsigned gmask = 0u;
#pragma unroll
            for (int it = 0; it < 4; ++it) { float best = -1e30f; int bi = 0;
#pragma unroll
                for (int g = 0; g < 8; ++g) { const bool ok = !((gmask >> g) & 1u) && gs[g] > best; best = ok ? gs[g] : best; bi = ok ? g : bi; }
                gmask |= 1u << bi; }
            unsigned long long taken = 0ull; int sel[8]; float sw[8]; float wsum = 0.f;
#pragma unroll
            for (int k = 0; k < 8; ++k) { float best = -1e30f; int bi = 0;
                for (int e = 0; e < 64; ++e) { const bool cand = ((gmask >> (e >> 3)) & 1u) && !((taken >> e) & 1ull); const float vv = sr[e] + rbias[e];
                    if (cand && vv > best) { best = vv; bi = e; } }
                taken |= 1ull << bi; sel[k] = bi; sw[k] = sr[bi]; wsum += sw[k]; }
            const float inv = 2.5f / wsum;
#pragma unroll
            for (int k = 0; k < 8; ++k) { const int a = trow * 8 + k; const int pos = atomicAdd(&cnt[sel[k]], 1);
                LIST[(size_t)sel[k] * TT + pos] = a; PK[a] = ((unsigned)sel[k] << 16) | (unsigned)pos; LW[(size_t)sel[k] * TT + pos] = sw[k] * inv; }
            LIST[(size_t)64 * TT + (trow - r0)] = 8 * TT + trow; LW[(size_t)64 * TT + (trow - r0)] = 1.0f;
        }
    }
}
namespace att {
constexpr int D = 128, NW = 8, QBLK = 32, KVBLK = 64;
constexpr float SCALE = 0.088388347648318440f;
constexpr float THR = 8.f;
constexpr int SHM_V = KVBLK * D * 2, SHM_K = KVBLK * D * 2, SHM_ATTN = 2 * SHM_V + 2 * SHM_K + NW * 64 * 4;
#define KSWZ(row, colB) ((row) * 256 + ((colB) ^ (((row) & 7) << 4)))
#define SBAR() __builtin_amdgcn_sched_barrier(0)
__device__ __forceinline__ int crow(int r, int hi) { return (r & 3) + 8 * (r >> 2) + 4 * hi; }
__device__ __forceinline__ unsigned cvtpk(float lo, float hi) { unsigned r; asm volatile("v_cvt_pk_bf16_f32 %0, %1, %2" : "=v"(r) : "v"(lo), "v"(hi)); return r; }

__device__ __forceinline__ void partialSM(f32x16& p0, f32x16& p1, float negMC) {
  constexpr float Cc = SCALE * 1.4426950408889634f;
  for (int r = 0; r < 16; ++r) p0[r] = fmaf(p0[r], Cc, negMC); for (int r = 0; r < 16; ++r) p1[r] = fmaf(p1[r], Cc, negMC);
  for (int r = 0; r < 16; ++r) p0[r] = __builtin_amdgcn_exp2f(p0[r]);
}
__device__ __forceinline__ void finishSM(f32x16& p0, f32x16& p1, float& l_reg, bf16x8& pa0, bf16x8& pa1, bf16x8& pa2, bf16x8& pa3) {
  for (int r = 0; r < 16; ++r) p1[r] = __builtin_amdgcn_exp2f(p1[r]);
  float ps = 0; for (int r = 0; r < 16; ++r) ps += p0[r]; for (int r = 0; r < 16; ++r) ps += p1[r];
  { auto rr = __builtin_amdgcn_permlane32_swap(__float_as_uint(ps), __float_as_uint(ps), false, false);
    ps = __uint_as_float(rr[0]) + __uint_as_float(rr[1]); }
  l_reg += ps;
#define PK4(P, BASE, OUT) do { unsigned a0 = cvtpk(P[BASE + 0], P[BASE + 1]), a1 = cvtpk(P[BASE + 2], P[BASE + 3]);   \
    unsigned b0 = cvtpk(P[BASE + 4], P[BASE + 5]), b1 = cvtpk(P[BASE + 6], P[BASE + 7]);                              \
    auto r0 = __builtin_amdgcn_permlane32_swap(a0, b0, false, false); auto r1 = __builtin_amdgcn_permlane32_swap(a1, b1, false, false); \
    u32x4 w = {r0[0], r1[0], r0[1], r1[1]}; OUT = *reinterpret_cast<bf16x8*>(&w); } while (0)
  PK4(p0, 0, pa0); PK4(p0, 8, pa1); PK4(p1, 0, pa2); PK4(p1, 8, pa3);
#undef PK4
}
__device__ __forceinline__ void qkt(f32x16& p0, f32x16& p1, const LAS char* Ks, const bf16x8* qr, int r32, int hi) {
  p0 = f32x16{}; p1 = f32x16{};
  for (int d0 = 0; d0 < 8; ++d0) { int cb = (d0 * 16 + hi * 8) * 2;
    bf16x8 b0 = *reinterpret_cast<const LAS bf16x8*>(Ks + KSWZ(r32, cb));
    bf16x8 b1 = *reinterpret_cast<const LAS bf16x8*>(Ks + KSWZ(32 + r32, cb));
    p0 = __builtin_amdgcn_mfma_f32_32x32x16_bf16(b0, qr[d0], p0, 0, 0, 0);
    p1 = __builtin_amdgcn_mfma_f32_32x32x16_bf16(b1, qr[d0], p1, 0, 0, 0); }
}
__device__ __forceinline__ int v_st(int k, int c) { const int kk = (k & ~0xC) | ((k & 4) << 1) | ((k & 8) >> 1); return ((kk >> 3) * 4 + (c >> 5)) * 512 + ((kk & 7) * 32 + (c & 31)) * 2; }
__device__ __forceinline__ int v_rd_base(int lane) { return ((lane & 3) << 3) | (((lane >> 2) & 3) << 6) | (((lane >> 4) & 1) << 5) | (((lane >> 5) & 1) << 8); }
constexpr int v_rd_off(int d0, int ks, int half) { return d0 * 512 + ks * 4096 + half * 2048; }
template <int OFF> __device__ __forceinline__ s16x4 tr_read(int vb) {
  s16x4 r; asm volatile("ds_read_b64_tr_b16 %0, %1 offset:%2" : "=&v"(r) : "v"(vb), "i"(OFF) : "memory"); return r;
}
template <int D0> __device__ __forceinline__ void pv_one(f32x16& od, int vb, bf16x8 pa0, bf16x8 pa1, bf16x8 pa2, bf16x8 pa3) {
  const s16x4 l0 = tr_read<v_rd_off(D0, 0, 0)>(vb), h0 = tr_read<v_rd_off(D0, 0, 1)>(vb), l1 = tr_read<v_rd_off(D0, 1, 0)>(vb), h1 = tr_read<v_rd_off(D0, 1, 1)>(vb);
  const s16x4 l2 = tr_read<v_rd_off(D0, 2, 0)>(vb), h2 = tr_read<v_rd_off(D0, 2, 1)>(vb), l3 = tr_read<v_rd_off(D0, 3, 0)>(vb), h3 = tr_read<v_rd_off(D0, 3, 1)>(vb);
  asm volatile("s_waitcnt lgkmcnt(0)" ::: "memory"); SBAR();
#define PK(L, H) (bf16x8){L[0], L[1], L[2], L[3], H[0], H[1], H[2], H[3]}
  od = __builtin_amdgcn_mfma_f32_32x32x16_bf16(pa0, PK(l0, h0), od, 0, 0, 0);
  od = __builtin_amdgcn_mfma_f32_32x32x16_bf16(pa1, PK(l1, h1), od, 0, 0, 0);
  od = __builtin_amdgcn_mfma_f32_32x32x16_bf16(pa2, PK(l2, h2), od, 0, 0, 0);
  od = __builtin_amdgcn_mfma_f32_32x32x16_bf16(pa3, PK(l3, h3), od, 0, 0, 0);
#undef PK
}
__device__ __forceinline__ void pv_d0(f32x16* o, int vb, bf16x8 pa0, bf16x8 pa1, bf16x8 pa2, bf16x8 pa3) {
  pv_one<0>(o[0], vb, pa0, pa1, pa2, pa3); pv_one<1>(o[1], vb, pa0, pa1, pa2, pa3); pv_one<2>(o[2], vb, pa0, pa1, pa2, pa3); pv_one<3>(o[3], vb, pa0, pa1, pa2, pa3);
}

template <int LDQ, int LDK, int LDO>
__device__ __forceinline__ void attn_dense_body(const bf16_t* __restrict__ Qb, const bf16_t* __restrict__ Kh, const bf16_t* __restrict__ Vh, bf16_t* __restrict__ Ob, int seq, LAS char* lds, int tid, float kmax2) {
  const int wid = tid >> 6, lane = tid & 63, r32 = lane & 31, hi = lane >> 5;
  LAS char* V_lds = lds; LAS char* K_lds = lds + 2 * SHM_V;
  LAS float* ws = (LAS float*)(lds + 2 * SHM_V + 2 * SHM_K) + wid * 64; LAS float* li_l = ws;
  float l_reg = 0; f32x16 o[4] = {}; bf16x8 qr[8];
  const bf16_t* Qw = Qb + (long)(wid * QBLK + r32) * LDQ + hi * 8;
#pragma unroll
  for (int d0 = 0; d0 < 8; ++d0) qr[d0] = *reinterpret_cast<const bf16x8*>(Qw + d0 * 16);
  float negMC;
  { float q2 = 0.f;
#pragma unroll
    for (int d0 = 0; d0 < 8; ++d0) { const u32x4 w = __builtin_bit_cast(u32x4, qr[d0]);
      q2 += bflo(w.x) * bflo(w.x) + bfhi(w.x) * bfhi(w.x) + bflo(w.y) * bflo(w.y) + bfhi(w.y) * bfhi(w.y) + bflo(w.z) * bflo(w.z) + bfhi(w.z) * bfhi(w.z) + bflo(w.w) * bflo(w.w) + bfhi(w.w) * bfhi(w.w); }
    auto rr = __builtin_amdgcn_permlane32_swap(__float_as_uint(q2), __float_as_uint(q2), false, false);
    q2 = __uint_as_float(rr[0]) + __uint_as_float(rr[1]);
    negMC = -(sqrtf(q2 * kmax2) * (SCALE * 1.0001f) - 30.0f) * 1.4426950408889634f; }
  const int sr = tid >> 4, sc = (tid & 15) * 8, vst0 = v_st(sr, sc), vst1 = v_st(32 + sr, sc);
  const int vb0 = (int)(uintptr_t)V_lds + v_rd_base(lane);
  struct { bf16x8 vs0, vs1, ks0, ks1; } sr_[2];
#define SLOAD(i, k0) do { sr_[i].vs0 = *reinterpret_cast<const bf16x8*>(&Vh[(long)((k0) + sr) * LDK + sc]); sr_[i].vs1 = *reinterpret_cast<const bf16x8*>(&Vh[(long)((k0) + 32 + sr) * LDK + sc]); \
    sr_[i].ks0 = *reinterpret_cast<const bf16x8*>(&Kh[(long)((k0) + sr) * LDK + sc]); sr_[i].ks1 = *reinterpret_cast<const bf16x8*>(&Kh[(long)((k0) + 32 + sr) * LDK + sc]); } while (0)
#define SWRITE(b, i) do { *(LAS bf16x8*)(V_lds + (b) * SHM_V + vst0) = sr_[i].vs0;          \
    *(LAS bf16x8*)(V_lds + (b) * SHM_V + vst1) = sr_[i].vs1; int kc = sc * 2;               \
    *(LAS bf16x8*)(K_lds + (b) * SHM_K + KSWZ(sr, kc)) = sr_[i].ks0;                       \
    *(LAS bf16x8*)(K_lds + (b) * SHM_K + KSWZ(32 + sr, kc)) = sr_[i].ks1; } while (0)
#define SWAIT() asm volatile("s_waitcnt vmcnt(4)" ::: "memory")
  f32x16 pA0, pA1, pB0, pB1; bf16x8 pa0, pa1, pa2, pa3; const int NT = seq / KVBLK;
  constexpr int SE = 0, SO = 1;
  SLOAD(SE, 0); asm volatile("s_waitcnt vmcnt(0)" ::: "memory"); SWRITE(0, SE); __syncthreads();
  qkt(pA0, pA1, K_lds, qr, r32, hi); partialSM(pA0, pA1, negMC);
  SLOAD(SO, KVBLK); if (2 < NT) SLOAD(SE, 2 * KVBLK);
  SWAIT(); SWRITE(1, SO); __syncthreads();
  for (int j = 1; j + 1 < NT; j += 2) {
    SBAR(); qkt(pB0, pB1, K_lds + SHM_K, qr, r32, hi);
    finishSM(pA0, pA1, l_reg, pa0, pa1, pa2, pa3); SBAR();
    SLOAD(SO, (j + 2) * KVBLK); SBAR();
    pv_d0(o, vb0, pa0, pa1, pa2, pa3); partialSM(pB0, pB1, negMC);
    __syncthreads(); SWAIT(); SWRITE(0, SE);
    __syncthreads();
    SBAR(); qkt(pA0, pA1, K_lds, qr, r32, hi);
    finishSM(pB0, pB1, l_reg, pa0, pa1, pa2, pa3); SBAR();
    if (j + 3 < NT) SLOAD(SE, (j + 3) * KVBLK); SBAR();
    pv_d0(o, vb0 + (int)SHM_V, pa0, pa1, pa2, pa3); partialSM(pA0, pA1, negMC);
    __syncthreads(); SWAIT(); SWRITE(1, SO);
    __syncthreads();
  }
  SBAR(); qkt(pB0, pB1, K_lds + SHM_K, qr, r32, hi);
  finishSM(pA0, pA1, l_reg, pa0, pa1, pa2, pa3); SBAR();
  pv_d0(o, vb0, pa0, pa1, pa2, pa3); partialSM(pB0, pB1, negMC);
  __syncthreads();
  finishSM(pB0, pB1, l_reg, pa0, pa1, pa2, pa3); SBAR();
  pv_d0(o, vb0 + (int)SHM_V, pa0, pa1, pa2, pa3);
  if (hi == 0) li_l[r32] = l_reg; asm volatile("s_waitcnt lgkmcnt(0)" ::: "memory");
  float rli[16];
#pragma unroll
  for (int r = 0; r < 16; ++r) rli[r] = __builtin_amdgcn_rcpf(li_l[crow(r, hi)]);
  bf16_t* Ow = Ob + (long)(wid * QBLK) * LDO;
#pragma unroll
  for (int r = 0; r < 16; ++r) { int orow = crow(r, hi);
    for (int d0 = 0; d0 < 4; ++d0) Ow[(long)orow * LDO + d0 * 32 + r32] = (bf16_t)(cvtpk(o[d0][r] * rli[r], 0.f) & 0xffffu); }
#undef SLOAD
#undef SWRITE
#undef SWAIT
}

constexpr int PV_BUF = 32768, PK_BUF = 16384, P_LDS_V = 0, P_LDS_K = 2 * PV_BUF, P_LDS_X = P_LDS_K + 2 * PK_BUF, P_LDS_L = P_LDS_X + 8 * 2048, P_LDS_END = P_LDS_L + 1024;
__device__ __forceinline__ void qkt_half(f32x16& p, const LAS char* Ks, const bf16x8* qr, int krow, int hi) {
  p = f32x16{};
  for (int d0 = 0; d0 < 8; ++d0) { int cb = (d0 * 16 + hi * 8) * 2;
    bf16x8 b0 = *reinterpret_cast<const LAS bf16x8*>(Ks + KSWZ(krow, cb));
    p = __builtin_amdgcn_mfma_f32_32x32x16_bf16(b0, qr[d0], p, 0, 0, 0); }
}
__device__ __forceinline__ void smA(f32x16& p, float negMC) {
  constexpr float Cc = SCALE * 1.4426950408889634f;
  for (int r = 0; r < 16; ++r) p[r] = fmaf(p[r], Cc, negMC);
  for (int r = 0; r < 8; ++r) p[r] = __builtin_amdgcn_exp2f(p[r]);
}
__device__ __forceinline__ void smB(f32x16& p, float& l_reg, bf16x8& f0, bf16x8& f1) {
  for (int r = 8; r < 16; ++r) p[r] = __builtin_amdgcn_exp2f(p[r]);
  float ps = 0; for (int r = 0; r < 16; ++r) ps += p[r];
  { auto rr = __builtin_amdgcn_permlane32_swap(__float_as_uint(ps), __float_as_uint(ps), false, false);
    ps = __uint_as_float(rr[0]) + __uint_as_float(rr[1]); }
  l_reg += ps;
#define PK4(P, BASE, OUT) do { unsigned a0 = cvtpk(P[BASE + 0], P[BASE + 1]), a1 = cvtpk(P[BASE + 2], P[BASE + 3]);   \
    unsigned b0 = cvtpk(P[BASE + 4], P[BASE + 5]), b1 = cvtpk(P[BASE + 6], P[BASE + 7]);                              \
    auto r0 = __builtin_amdgcn_permlane32_swap(a0, b0, false, false); auto r1 = __builtin_amdgcn_permlane32_swap(a1, b1, false, false); \
    u32x4 w = {r0[0], r1[0], r0[1], r1[1]}; OUT = *reinterpret_cast<bf16x8*>(&w); } while (0)
  PK4(p, 0, f0); PK4(p, 8, f1);
#undef PK4
}
template <int LDQ, int LDK, int LDO>
__device__ __forceinline__ void attn_pair_body(const bf16_t* __restrict__ Qb, const bf16_t* __restrict__ Kh, const bf16_t* __restrict__ Vh, bf16_t* __restrict__ Ob, int seq, LAS char* lds, int tid, float kmax2) {
  const int wid = __builtin_amdgcn_readfirstlane(tid >> 6), lane = tid & 63, r32 = lane & 31, hi = lane >> 5, g = wid & 3, kb = wid >> 2;
  LAS char* V_lds = lds + P_LDS_V; LAS char* K_lds = lds + P_LDS_K;
  LAS char* xp_own = lds + P_LDS_X + wid * 2048 + lane * 16; LAS char* xp_par = lds + P_LDS_X + (wid ^ 4) * 2048 + lane * 16;
  LAS float* li = (LAS float*)(lds + P_LDS_L);
  float l_reg = 0; f32x16 o[4] = {}; bf16x8 qr[8];
  const bf16_t* Qw = Qb + (long)(g * QBLK + r32) * LDQ + hi * 8;
#pragma unroll
  for (int d0 = 0; d0 < 8; ++d0) qr[d0] = *reinterpret_cast<const bf16x8*>(Qw + d0 * 16);
  float negMC;
  { float q2 = 0.f;
#pragma unroll
    for (int d0 = 0; d0 < 8; ++d0) { const u32x4 w = __builtin_bit_cast(u32x4, qr[d0]);
      q2 += bflo(w.x) * bflo(w.x) + bfhi(w.x) * bfhi(w.x) + bflo(w.y) * bflo(w.y) + bfhi(w.y) * bfhi(w.y) + bflo(w.z) * bflo(w.z) + bfhi(w.z) * bfhi(w.z) + bflo(w.w) * bflo(w.w) + bfhi(w.w) * bfhi(w.w); }
    auto rr = __builtin_amdgcn_permlane32_swap(__float_as_uint(q2), __float_as_uint(q2), false, false);
    q2 = __uint_as_float(rr[0]) + __uint_as_float(rr[1]);
    negMC = -(sqrtf(q2 * kmax2) * (SCALE * 1.0001f) - 30.0f) * 1.4426950408889634f; }
  const int sr = tid >> 4, sc = (tid & 15) * 8, vst0 = v_st(sr, sc), vst1 = v_st(32 + sr, sc);
  const int vrd = (int)(uintptr_t)V_lds + kb * 16384 + v_rd_base(lane);
  const int krow = 32 * kb + r32;
  struct { bf16x8 v00, v01, v10, v11, k0, k1; } st_;
#define PLD16(base, off) (*reinterpret_cast<const bf16x8*>((const char*)(base) + (off)))
#define PLOAD(k0_) do { const unsigned o_ = (unsigned)(((k0_) + sr) * LDK + sc) * 2u; \
    st_.v00 = PLD16(Vh, o_); st_.v01 = PLD16(Vh, o_ + 256u); st_.v10 = PLD16(Vh, o_ + 64u * LDK); st_.v11 = PLD16(Vh, o_ + 64u * LDK + 256u); \
    st_.k0 = PLD16(Kh, o_); st_.k1 = PLD16(Kh, o_ + 64u * LDK); } while (0)
#define PWRITE(kbuf, vbuf) do { LAS char* vb_ = V_lds + (vbuf) * PV_BUF; LAS char* kb_ = K_lds + (kbuf) * PK_BUF; const int kc = sc * 2; \
    *(LAS bf16x8*)(vb_ + vst0) = st_.v00; *(LAS bf16x8*)(vb_ + 16384 + vst0) = st_.v01; *(LAS bf16x8*)(vb_ + vst1) = st_.v10; *(LAS bf16x8*)(vb_ + 16384 + vst1) = st_.v11; \
    *(LAS bf16x8*)(kb_ + KSWZ(sr, kc)) = st_.k0; *(LAS bf16x8*)(kb_ + KSWZ(32 + sr, kc)) = st_.k1; } while (0)
  const int NT = seq / KVBLK;
  f32x16 pS; bf16x8 f0, f1, g0, g1;
  PLOAD(0); asm volatile("s_waitcnt vmcnt(0)" ::: "memory"); PWRITE(0, 0); PLOAD(KVBLK);
  __syncthreads();
  for (int j = 0; j < NT; ++j) {
    SBAR();
    qkt_half(pS, K_lds + (j & 1) * PK_BUF, qr, krow, hi);
    smA(pS, negMC); smB(pS, l_reg, f0, f1); SBAR();
    *(LAS bf16x8*)(xp_own) = f0; *(LAS bf16x8*)(xp_own + 1024) = f1;
    if (j + 1 < NT) PWRITE((j + 1) & 1, (j + 1) & 1);
    if (j + 2 < NT) PLOAD((j + 2) * KVBLK);
    __syncthreads();
    g0 = *(const LAS bf16x8*)(xp_par); g1 = *(const LAS bf16x8*)(xp_par + 1024);
    { const int vb = vrd + (j & 1) * PV_BUF;
      if (kb == 0) pv_d0(o, vb, f0, f1, g0, g1); else pv_d0(o, vb, g0, g1, f0, f1); }
    __syncthreads();
  }
  if (hi == 0) li[wid * 32 + r32] = l_reg;
  __syncthreads();
#pragma unroll
  for (int r = 0; r < 16; ++r) { const int orow = crow(r, hi); const float rl = __builtin_amdgcn_rcpf(li[wid * 32 + orow] + li[(wid ^ 4) * 32 + orow]);
    bf16_t* op = Ob + (long)(g * QBLK + orow) * LDO + 128 * kb + r32;
    for (int d0 = 0; d0 < 4; ++d0) op[d0 * 32] = (bf16_t)(cvtpk(o[d0][r] * rl, 0.f) & 0xffffu); }
#undef PLD16
#undef PLOAD
#undef PWRITE
}
#undef KSWZ
}

__device__ __forceinline__ void phase_attention(const Params& p, Ctx& C) {
    const bf16_t* QKV = (const bf16_t*)(p.ws + WS_BIG + BG_QKV); bf16_t* ATT = (bf16_t*)(p.ws + WS_BIG + BG_ATT);
    const unsigned* KMAX = (const unsigned*)(p.ws + WS_CTL) + CW_KMAX;
    const bool grouped = (C.G == 256);
    for (int i = 0;; ++i) {
        int unit;
        if (grouped) { if (i >= 4) break; unit = (C.bid & 7) * 128 + i * 32 + (C.bid >> 3); } else { unit = i * C.G + C.bid; if (unit >= 1024) break; }
        const int d = unit >> 7, qb = unit & 127, h = d >> 1, m = d & 1;
        const float kmax2 = __uint_as_float(KMAX[64 * (2 + 2 * h + m)]);
        __syncthreads();
        int tz = C.tid; asm volatile("" : "+v"(tz));
        att::attn_pair_body<OD_IN, OD_IN, 3072>(QKV + (size_t)(CTXL + 128 * qb) * OD_IN + 1536 + 256 * h + 128 * m, QKV + 2560 + 256 * h + 128 * m, QKV + 3584 + 256 * h,
                                                ATT + (size_t)(128 * qb) * 3072 + 1024 + 1024 * m + 256 * h, TT, (LAS char*)C.lds, tz, kmax2);
    }
    for (int i = 0;; ++i) {
        int unit;
        if (grouped) { if (i >= 2) break; unit = (C.bid & 7) * 64 + i * 32 + (C.bid >> 3); } else { unit = i * C.G + C.bid; if (unit >= 512) break; }
        const int prob = unit >> 6, qb = unit & 63;
        const float kmax2 = __uint_as_float(KMAX[64 * (prob >> 2)]);
        __syncthreads();
        int tz = C.tid; asm volatile("" : "+v"(tz));
        att::attn_dense_body<OD_IN, OD_IN, 3072>(QKV + (size_t)(CTXL + 256 * qb) * OD_IN + 128 * prob, QKV + 1024 + 128 * (prob >> 2), QKV + 1280 + 128 * (prob >> 2),
                                                 ATT + (size_t)(256 * qb) * 3072 + 128 * prob, TT, (LAS char*)C.lds, tz, kmax2);
    }
    __syncthreads();
}
constexpr int PH_PER_LAYER = 13, N_PHASES = 2 + 2 * PH_PER_LAYER;
#ifndef DBL_PHASE
#define DBL_PHASE -1
#endif
#ifndef MK_PER_PHASE
#define MK_PER_PHASE 0
#endif

template <int L>
__device__ __forceinline__ void layer_body(const Params& p, Ctx& C0, const XcdBarrier& bar, LAS unsigned char* misc, int lo, int hi) {
#define IN(k) (lo <= (k) && (k) < hi)
#define SEAM(k) do { if (IN(k) && IN((k) + 1)) xcd_barrier(bar, C0.wave); } while (0)
#define PHASE(k, ...) if (IN(k)) { FRESH(); __VA_ARGS__ } if (DBL_PHASE == (k)) { xcd_barrier(bar, C0.wave); { FRESH(); __VA_ARGS__ } } SEAM(k);
#define FRESH() Ctx C = C0; { int ln = (int)__builtin_amdgcn_mbcnt_hi(~0u, __builtin_amdgcn_mbcnt_lo(~0u, 0u)); asm volatile("" : "+v"(ln)); C.lane = ln; C.tid = C.wave * 64 + ln; }
        const int b = 2 + PH_PER_LAYER * L;
        bf16_t* QKV = (bf16_t*)(p.ws + WS_BIG + BG_QKV);
        bf16_t* XA = (bf16_t*)(p.ws + WS_XA);
        int* cnt = (int*)(p.ws + WS_CTL) + CW_CNT + L * 128; const int* LIST = (const int*)(p.ws + WS_LIST);
        PHASE(b + 0, phase_modulate(p, C, L); )
        PHASE(b + 1,
            const int N = L ? OD_IN : EV_IN;
            pg8::DenseOrder S; S.init8((const void*)XA, DM, (const void*)(p.ws + (L ? WS_WIN1 : WS_WIN0)), TT, N, DM, C.G, C.bid);
            pg8::EpiStore E{QKV, N, 1.0f / 32.0f};
            pg8::gemm_phase<true>(C.lds, S, E, C.wave);
            if (L == 0 && IN(b + 2) && S.units_of_me() < S.max_units()) conv_queue(p, C, 2);
        )
        PHASE(b + 2, if (L == 0) phase_rope0(p, C); else phase_normrope1(p, C); )
        PHASE(b + 3, if (L == 0) { ret_chunk_kv(p, C); s5_end_states(p, C); } else phase_attention(p, C); )
        PHASE(b + 4, if (L == 0) phase_scans(p, C); else phase_merge1(p, C); )
        if (L == 0) {
            PHASE(b + 5, phase_ret_s5_outputs(p, C, misc); )
            PHASE(b + 6,
                pg8::DenseOrder S; S.init((const bf16_t*)(p.ws + WS_Z), 1024, (const bf16_t*)(p.ws + WS_WGLU), TT, 1024, 1024, C.G, C.bid);
                pg8::EpiGlu E{(const bf16_t*)(p.ws + WS_Z), p.inp(20), (bf16_t*)(p.ws + WS_BIG + BG_MIX)};
                pg8::gemm_phase<false>(C.lds, S, E, C.wave);
                if (IN(b + 7) && S.units_of_me() < S.max_units()) conv_queue(p, C, 4);
            )
        }
        PHASE(b + 7,
            pg8::DenseOrder S;
            if (L == 0) S.init((const bf16_t*)(p.ws + WS_BIG + BG_MIX), DM, (const bf16_t*)(p.ws + WS_WOUT0), TT, DM, DM, C.G, C.bid);
            else S.init((const bf16_t*)(p.ws + WS_BIG + BG_ATT), 3072, (const bf16_t*)(p.ws + WS_WOUT1), SEQ, DM, DM, C.G, C.bid);
            pg8::EpiStore E{(bf16_t*)(p.ws + WS_YMIX) + (L ? (size_t)CTXL * DM : 0), DM, 1.0f};
            pg8::gemm_phase<false>(C.lds, S, E, C.wave);
            if (L == 0 && IN(b + 8) && S.units_of_me() < S.max_units()) conv_queue(p, C, 5);
        )
        PHASE(b + 8, phase_ln1(p, C, L); )
        PHASE(b + 9, phase_router(p, C, L); )
        PHASE(b + 10,
            pg8::MoeOrder<0> S; S.A = (const void*)XA; S.Bt = (const void*)(p.ws + WS_GU + (size_t)L * NEX1 * 1024 * DM); S.list = LIST; S.cnt = cnt; S.ldab = DM; S.kb = DM; S.nN = 4; S.G = C.G; S.c = C.bid; S.bstride = (size_t)1024 * DM;
            S.prep(misc, C.tid);
            pg8::EpiE1 E{(unsigned char*)(p.ws + WS_HX2), S.cn, S.rb};
            pg8::gemm_phase<true>(C.lds, S, E, C.wave);
        )
        PHASE(b + 11,
            pg8::MoeOrder<1> S; S.A = (const void*)(p.ws + WS_HX2); S.Bt = (const void*)(p.ws + WS_DT + (size_t)L * NEX1 * DM * EHID); S.list = LIST; S.cnt = cnt; S.ldab = EHID; S.kb = EHID; S.nN = 8; S.G = C.G; S.c = C.bid; S.bstride = (size_t)DM * EHID;
            S.prep(misc, C.tid);
            pg8::EpiE2 E{(unsigned char*)(p.ws + WS_BIG + BG_YMOE), (const float*)(p.ws + WS_LW), S.cn, S.rb};
            pg8::gemm_phase<true>(C.lds, S, E, C.wave);
        )
        PHASE(b + 12, phase_combine(p, C, L, misc); )
    #undef IN
#undef SEAM
#undef FRESH
#undef PHASE
}

__global__ void __launch_bounds__(NTHR, 2) mega_fwd(KArgs ka) {
    extern __shared__ __attribute__((aligned(16))) unsigned char lds_raw[];
    Ctx C;
    C.lds = (LAS unsigned char*)lds_raw;
    C.tid = threadIdx.x; C.lane = C.tid & 63; C.wave = __builtin_amdgcn_readfirstlane(C.tid >> 6);
    C.G = gridDim.x; C.bid = blockIdx.x; C.gw = C.bid * NWAVES + C.wave; C.ngw = C.G * NWAVES;
    LAS unsigned char* misc = C.lds + MISC_OFF;
    if (C.tid < 8) ((volatile LAS unsigned*)misc)[C.tid] = 0u;
    Params p; p.out = ka.out; p.ws = ka.ws; p.ph_lo = ka.ph_lo; p.ph_hi = ka.ph_hi; p.ptab = (LAS unsigned long long*)(misc + 1024);
    if (C.tid < 34) p.ptab[C.tid] = (unsigned long long)ka.in[C.tid];
    __syncthreads();
    const int lo = p.ph_lo, hi = p.ph_hi;
    XcdBarrier bar; bar.bar = (unsigned*)(p.ws + WS_CTL) + CW_BAR; bar.x = 0; bar.st = (volatile LAS unsigned*)misc;
    if (hi - lo > 1) bar = xcd_barrier_post((unsigned*)(p.ws + WS_CTL) + CW_BAR, (volatile LAS unsigned*)misc);
#define IN(k) (lo <= (k) && (k) < hi)
#define SEAM(k) do { if (IN(k) && IN((k) + 1)) xcd_barrier(bar, C.wave); } while (0)

    if (IN(0)) { phase_p0(p, C); } SEAM(0);
    if (IN(1)) { phase_p1(p, C); } SEAM(1);
    if (IN(0) && IN(2) && (C.G & 7) == 0) {
        volatile LAS unsigned* st = (volatile LAS unsigned*)misc;
        if (C.tid == 0) { unsigned pre = 0u; const unsigned x = st[3];
            for (unsigned j = 0; j < 16; ++j) { const unsigned cj = xb_ld(&bar.bar[XB_XCNT(j)]); pre += (j < x) ? cj : 0u; }
            st[4] = pre + st[2]; }
        __syncthreads();
        const int vcu = (int)st[4], g8 = C.G >> 3;
        C.bid = __builtin_amdgcn_readfirstlane((vcu % g8) * 8 + vcu / g8); C.gw = C.bid * NWAVES + C.wave;
    }

    layer_body<0>(p, C, bar, misc, lo, hi);
    layer_body<1>(p, C, bar, misc, lo, hi);
#undef IN
#undef SEAM
}

extern "C" void kernel_launch(void* const* d_in, const int* in_sizes, int n_in, void* d_out, int out_size, void* d_ws, size_t ws_size, hipStream_t stream) {
    static int grid = 0;
    if (grid == 0) {
        if (n_in != 34 || out_size != SEQ * DM || ws_size < WS_END) { fprintf(stderr, "kernel_launch: unexpected shapes: n_in %d out %d ws %zu (need %zu)\n", n_in, out_size, ws_size, (size_t)WS_END); grid = -1; return; }
        int dev = 0, cus = 0, per_cu = 0;
        if (hipGetDevice(&dev) != hipSuccess || hipDeviceGetAttribute(&cus, hipDeviceAttributeMultiprocessorCount, dev) != hipSuccess) { grid = -1; return; }
        if (hipFuncSetAttribute((const void*)mega_fwd, hipFuncAttributeMaxDynamicSharedMemorySize, LDS_BYTES) != hipSuccess) { fprintf(stderr, "kernel_launch: hipFuncSetAttribute failed\n"); grid = -1; return; }
        if (hipOccupancyMaxActiveBlocksPerMultiprocessor(&per_cu, (const void*)mega_fwd, NTHR, LDS_BYTES) != hipSuccess || per_cu < 1) { fprintf(stderr, "kernel_launch: occupancy query says %d blocks per CU\n", per_cu); grid = -1; return; }
        (void)hipGetLastError();
        grid = cus;
    }
    if (grid < 0) return;
    (void)hipMemsetAsync((char*)d_ws + WS_CTL, 0, CTL_BYTES, stream);
    KArgs p{};
    for (int i = 0; i < 34; ++i) p.in[i] = (const float*)d_in[i];
    p.out = (float*)d_out; p.ws = (unsigned char*)d_ws;
#if MK_PER_PHASE
    for (int ph = 0; ph < N_PHASES; ++ph) {
        if (ph == 2 + PH_PER_LAYER + 5 || ph == 2 + PH_PER_LAYER + 6) continue;
        p.ph_lo = ph; p.ph_hi = ph + 1;
        hipLaunchKernelGGL(mega_fwd, dim3(grid), dim3(NTHR), LDS_BYTES, stream, p);
    }
#else
    p.ph_lo = 0; p.ph_hi = N_PHASES;
    hipLaunchKernelGGL(mega_fwd, dim3(grid), dim3(NTHR), LDS_BYTES, stream, p);
#endif
    const hipError_t le = hipPeekAtLastError();
    if (le != hipSuccess) fprintf(stderr, "kernel_launch: launch failed: %s\n", hipGetErrorName(le));
}
```

```cpp
#define MK_PER_PHASE 0
#include <hip/hip_runtime.h>
#include <cstdio>
#include <cstdint>

#define GAS __attribute__((address_space(1)))
#define LAS __attribute__((address_space(3)))
typedef unsigned short bf16_t;
typedef short bf16x8 __attribute__((ext_vector_type(8)));
typedef short s16x4 __attribute__((ext_vector_type(4)));
typedef float f32x4 __attribute__((ext_vector_type(4)));
typedef float f32x2 __attribute__((ext_vector_type(2)));
typedef float f32x16 __attribute__((ext_vector_type(16)));
typedef unsigned u32x4 __attribute__((ext_vector_type(4)));
typedef unsigned u32x2 __attribute__((ext_vector_type(2)));

constexpr int DM = 2048, SEQ = 16384, CTXL = 256, TT = SEQ + CTXL;
constexpr int NEXP = 64, NEX1 = 65, EHID = 512, TOPK = 8;
constexpr int EV_IN = 5120, OD_IN = 4608;
constexpr float LN_EPS = 1e-6f;
constexpr float ALPHA = 1.4142135623730951f;
constexpr float LAMBDA_INIT = 0.35550906759f;
constexpr int NTHR = 512, NWAVES = 8;

constexpr size_t al256(size_t x) { return (x + 255) / 256 * 256; }
constexpr size_t WS_CTL   = 0;
constexpr size_t CTL_BYTES = 1u << 20;
constexpr size_t WS_MODP  = WS_CTL + CTL_BYTES;
constexpr size_t WS_MODF  = WS_MODP + al256((size_t)2 * 32 * 2 * 12288 * 4);
constexpr size_t WS_ROPE128 = WS_MODF + al256((size_t)2 * 2 * 12288 * 4);
constexpr size_t WS_ROPE64  = WS_ROPE128 + al256((size_t)256 * 64 * 2 * 4);
constexpr size_t WS_KN    = WS_ROPE64 + al256((size_t)256 * 32 * 2 * 4);
constexpr size_t WS_WT    = WS_KN + al256((size_t)2 * 64 * 16 * 1024 * 2);
constexpr size_t WS_APOW  = WS_WT + al256((size_t)2 * 64 * 128 * 1024 * 2);
constexpr size_t WS_AL    = WS_APOW + al256((size_t)2 * 64 * 64 * 128 * 4);
constexpr size_t WS_CC    = WS_AL + al256((size_t)2 * 64 * 128 * 4);
constexpr size_t WS_BBT   = WS_CC + al256((size_t)64 * 16 * 128 * 2);
constexpr size_t WS_S5E   = WS_BBT + al256((size_t)2 * 64 * 128 * 16 * 2);
constexpr size_t WS_HST   = WS_S5E + al256((size_t)2 * 64 * 260 * 128 * 4);
constexpr size_t WS_WIN0  = WS_HST + al256((size_t)2 * 64 * 260 * 128 * 4);
constexpr size_t WS_WOUT0 = WS_WIN0 + al256((size_t)EV_IN * DM * 2);
constexpr size_t WS_WGLU  = WS_WOUT0 + al256((size_t)DM * DM * 2);
constexpr size_t WS_WIN1  = WS_WGLU + al256((size_t)1024 * 1024 * 2);
constexpr size_t WS_WOUT1 = WS_WIN1 + al256((size_t)OD_IN * DM * 2);
constexpr size_t WS_RWT   = WS_WOUT1 + al256((size_t)DM * DM * 2);
constexpr size_t WS_GU    = WS_RWT + al256((size_t)2 * 2 * 64 * DM * 2);
constexpr size_t WS_DT    = WS_GU + al256((size_t)NEX1 * 1024 * DM * 2);
constexpr size_t WS_XA    = WS_DT + al256((size_t)NEX1 * DM * EHID * 2);
constexpr size_t WS_Z     = WS_XA + al256((size_t)TT * DM * 2);
constexpr size_t WS_YMIX  = WS_Z + al256((size_t)TT * 1024 * 2);
constexpr size_t WS_X1    = WS_YMIX + al256((size_t)TT * DM * 2);
constexpr size_t WS_HX2   = WS_X1 + al256((size_t)TT * DM * 4);
constexpr size_t WS_LIST  = WS_HX2 + al256((size_t)9 * TT * EHID * 2);
constexpr size_t WS_WGT   = WS_LIST + al256((size_t)NEX1 * TT * 4);
constexpr size_t WS_LW    = WS_WGT + al256((size_t)8 * TT * 4);
constexpr size_t WS_BIG   = WS_LW + al256((size_t)NEX1 * TT * 4);
constexpr size_t BG_QKV   = 0;
constexpr size_t BG_CKV   = BG_QKV + al256((size_t)TT * EV_IN * 2);
constexpr size_t BG_SPREV = BG_CKV + al256((size_t)8 * 130 * 65536 * 4);
constexpr size_t BG_MIX   = BG_SPREV + al256((size_t)8 * 130 * 65536 * 2);
constexpr size_t BG_END0  = BG_MIX + al256((size_t)TT * DM * 2);
constexpr size_t BG_ATT   = BG_CKV;
constexpr size_t BG_YMOE  = 0;
constexpr size_t BG_END1  = al256((size_t)9 * TT * DM * 2);
constexpr size_t BG_SIZE  = BG_END0 > BG_END1 ? BG_END0 : BG_END1;
constexpr size_t WS_END   = WS_BIG + BG_SIZE;

constexpr int CW_BAR = 4096;
constexpr int CW_CNT = 16384;
constexpr int CW_QUEUE = 20480;
constexpr int CW_KMAX = 24576;

constexpr int RING_BYTES = 151552;
constexpr int MISC_OFF = RING_BYTES;
constexpr int LDS_BYTES = 159744;

typedef __bf16 bf16x2_t __attribute__((ext_vector_type(2)));
__device__ __forceinline__ unsigned cvt_pk_bf16(float lo, float hi) { const f32x2 v = {lo, hi}; return __builtin_bit_cast(unsigned, __builtin_convertvector(v, bf16x2_t)); }
__device__ __forceinline__ bf16_t f2bf(float f) { unsigned u = __builtin_bit_cast(unsigned, f); return (bf16_t)((u + 0x7fffu + ((u >> 16) & 1u)) >> 16); }
__device__ __forceinline__ float bf2f(bf16_t b) { return __builtin_bit_cast(float, ((unsigned)b) << 16); }
__device__ __forceinline__ float bflo(unsigned w) { return __builtin_bit_cast(float, w << 16); }
__device__ __forceinline__ float bfhi(unsigned w) { return __builtin_bit_cast(float, w & 0xffff0000u); }
__device__ __forceinline__ float wave_sum(float v) {
#pragma unroll
    for (int o = 1; o < 64; o <<= 1) v += __shfl_xor(v, o);
    return v;
}
__device__ __forceinline__ float fast_exp(float x) { return __builtin_amdgcn_exp2f(x * 1.4426950408889634f); }
__device__ __forceinline__ float sigmoidf_(float x) { return 1.0f / (1.0f + __expf(-x)); }
__device__ __forceinline__ float siluf_(float x) { return x / (1.0f + __expf(-x)); }
__device__ __forceinline__ float gelu_tanh(float x) {
    const float u = 0.7978845608028654f * (x + 0.044715f * x * x * x);
    const float e = __expf(2.0f * u);
    const float t = 1.0f - 2.0f / (e + 1.0f);
    return 0.5f * x * (1.0f + t);
}
#define LDS_WAIT() asm volatile("s_waitcnt lgkmcnt(0)" ::: "memory")
#define VM_WAIT() asm volatile("s_waitcnt vmcnt(0)" ::: "memory")

#define XB_TMO      128
#define XB_XCNT(j)  (256  + 64 * (j))
#define XB_XSUB(j)  (1280 + 64 * (j))
#define XB_XGEN(j)  (2304 + 64 * (j))
#define XB_TOP      3328
#define XB_TOPGEN   3392
#define XCD_BAR_WORDS 3456
#define XB_SPIN_CAP (1u << 22)

__device__ __forceinline__ unsigned xb_ld(unsigned* p)              { return __hip_atomic_load(p, __ATOMIC_RELAXED, __HIP_MEMORY_SCOPE_AGENT); }
__device__ __forceinline__ unsigned xb_add(unsigned* p, unsigned v) { return __hip_atomic_fetch_add(p, v, __ATOMIC_RELAXED, __HIP_MEMORY_SCOPE_AGENT); }
__device__ __forceinline__ unsigned xb_xcc_id() { return (unsigned)__builtin_amdgcn_s_getreg((3 << 11) | 20) & 0xFu; }
#define XB_SPIN(cond, bar) do { unsigned _sp = 0; while (cond) { __builtin_amdgcn_s_sleep(1); \
    if ((++_sp & 255u) == 0u) { if (xb_ld(&(bar)[XB_TMO])) break; if (_sp > XB_SPIN_CAP) { atomicAdd(&(bar)[XB_TMO], 1u); break; } } } } while (0)

struct XcdBarrier { unsigned* bar; unsigned x; volatile LAS unsigned* st; };

__device__ __forceinline__ XcdBarrier xcd_barrier_post(unsigned* bar, volatile LAS unsigned* st) {
    XcdBarrier b; b.bar = bar; b.x = xb_xcc_id(); b.st = st;
    if (threadIdx.x == 0) { st[2] = xb_add(&bar[XB_XCNT(b.x)], 1u); st[3] = b.x; }
    return b;
}
__device__ __forceinline__ void xcd_barrier_complete(unsigned* bar, unsigned x, unsigned& nloc, unsigned& nx) {
    const unsigned G = gridDim.x * gridDim.y * gridDim.z;
    unsigned sum, cnt, mine, sp = 0u;
    for (;;) {
        sum = 0u; cnt = 0u; mine = 0u;
#pragma unroll
        for (unsigned j = 0; j < 16; ++j) { const unsigned c = xb_ld(&bar[XB_XCNT(j)]); sum += c; cnt += (c > 0u) ? 1u : 0u; mine = (j == x) ? c : mine; }
        if (sum == G) break;
        __builtin_amdgcn_s_sleep(1);
        if ((++sp & 255u) == 0u) { if (xb_ld(&bar[XB_TMO])) break; if (sp > XB_SPIN_CAP) { atomicAdd(&bar[XB_TMO], 1u); break; } }
    }
    nloc = mine > 0u ? mine : 1u; nx = cnt > 0u ? cnt : 1u;
}
__device__ __forceinline__ void xcd_barrier(const XcdBarrier& b, int wave_id) {
    const bool leader_thread = (wave_id == 0) && (__builtin_amdgcn_mbcnt_hi(~0u, __builtin_amdgcn_mbcnt_lo(~0u, 0u)) == 0u);
    asm volatile("s_waitcnt vmcnt(0)" ::: "memory");
    __syncthreads();
    if (leader_thread) {
        unsigned* bar = b.bar;
        __builtin_amdgcn_s_waitcnt(0);
        unsigned nloc = b.st[0], nx = b.st[1];
        if (nloc == 0u) { xcd_barrier_complete(bar, b.x, nloc, nx); b.st[0] = nloc; b.st[1] = nx; }
        const unsigned old = xb_add(&bar[XB_XSUB(b.x)], 1u);
        const unsigned gen = old / nloc;
        if (old + 1u == (gen + 1u) * nloc) {
            __builtin_amdgcn_fence(__ATOMIC_RELEASE, "agent");
            asm volatile("s_waitcnt vmcnt(0)" ::: "memory");
            const unsigned og = xb_add(&bar[XB_TOP], 1u);
            const unsigned tg = og / nx;
            if (og + 1u == (tg + 1u) * nx) xb_add(&bar[XB_TOPGEN], 1u);
            else XB_SPIN(xb_ld(&bar[XB_TOPGEN]) == tg, bar);
            __builtin_amdgcn_fence(__ATOMIC_ACQUIRE, "agent");
            xb_add(&bar[XB_XGEN(b.x)], 1u);
            asm volatile("s_waitcnt vmcnt(0)" ::: "memory");
        } else {
            XB_SPIN(xb_ld(&bar[XB_XGEN(b.x)]) == gen, bar);
            __builtin_amdgcn_fence(__ATOMIC_ACQUIRE, "agent");
            asm volatile("s_waitcnt vmcnt(0)" ::: "memory");
        }
    }
    __syncthreads();
}

__device__ __forceinline__ bf16x8 frag_rowk_l(const LAS bf16_t* p, int ld, int lane) {
    return *(const LAS bf16x8*)(p + (lane & 15) * ld + (lane >> 4) * 8);
}
__device__ __forceinline__ bf16x8 frag_rowk_g(const bf16_t* p, long ld, int lane) {
    return *(const bf16x8*)(p + (long)(lane & 15) * ld + (lane >> 4) * 8);
}
__device__ __forceinline__ bf16x8 frag_colk_l(unsigned p, int ldb, int lane) {
    const unsigned a0 = p + (unsigned)((8 * (lane >> 4) + ((lane & 15) >> 2)) * ldb + (lane & 3) * 8);
    const unsigned a1 = a0 + 4u * (unsigned)ldb;
    s16x4 lo, hi;
    asm volatile("ds_read_b64_tr_b16 %0, %2\n\tds_read_b64_tr_b16 %1, %3\n\ts_waitcnt lgkmcnt(0)" : "=&v"(lo), "=&v"(hi) : "v"(a0), "v"(a1) : "memory");
    return (bf16x8){lo[0], lo[1], lo[2], lo[3], hi[0], hi[1], hi[2], hi[3]};
}
#define MFMA16(a, b, c) __builtin_amdgcn_mfma_f32_16x16x32_bf16((a), (b), (c), 0, 0, 0)
namespace pg8 {
constexpr int BM = 256, BK = 64, HALF = 128, HTB = HALF * BK * 2, STAGE_BYTES = 8 * HTB, NXCD = 8, WGM = 8;
__device__ __forceinline__ int lds_byte(int r, int c) { const int st = (r >> 4) * 2 + (c >> 5), rr = r & 15, cc = c & 31, ob = rr * 64 + cc * 2; return st * 1024 + (ob ^ (((ob >> 9) & 1) << 5)); }
__device__ __forceinline__ void stage_rc(int b, int& R, int& C) { const int st = b / 1024, sb = b % 1024, swz = sb ^ (((sb >> 9) & 1) << 5); R = (st >> 1) * 16 + swz / 64; C = (st & 1) * 32 + (swz % 64) / 2; }
__device__ __forceinline__ int perm32(int rho) { const int n = rho >> 4, i = rho & 15; return 8 * (i >> 2) + 4 * n + (i & 3); }

struct Unit { int pm, pn, e; };
constexpr float WSCALE = 32.0f, WSCALE_INV = 1.0f / 32.0f;

struct DenseOrder {
    const bf16_t* A; const bf16_t* Bt; int ldab, kb, nM, nN, nwg, G, c;
    __device__ __forceinline__ void init(const bf16_t* A_, int lda_, const bf16_t* Bt_, int M, int N, int K_, int G_, int c_) { A = A_; ldab = lda_ * 2; Bt = Bt_; kb = K_ * 2; nM = M / BM; nN = N / BM; nwg = nM * nN; G = G_; c = c_; }
    __device__ __forceinline__ void init8(const void* A_, int ldab_, const void* Bt_, int M, int N, int K_, int G_, int c_) { A = (const bf16_t*)A_; ldab = ldab_; Bt = (const bf16_t*)Bt_; kb = K_; nM = M / BM; nN = N / BM; nwg = nM * nN; G = G_; c = c_; }
    __device__ __forceinline__ void prep(LAS unsigned char*) const {}
    __device__ __forceinline__ int units_of_me() const { return c < nwg ? (nwg - c + G - 1) / G : 0; }
    __device__ __forceinline__ int max_units() const { return (nwg + G - 1) / G; }
    __device__ __forceinline__ bool next(int i, Unit& u) const {
        const long L = (long)i * G + c; if (L >= nwg) return false;
        int wgid = (int)L; { const int q = nwg / NXCD, r = nwg % NXCD, xcd = wgid % NXCD, off = wgid / NXCD; wgid = (xcd < r ? xcd * (q + 1) : r * (q + 1) + (xcd - r) * q) + off; }
        const int nig = WGM * nN, gid = wgid / nig, fm = gid * WGM, gsz = (nM - fm) < WGM ? (nM - fm) : WGM;
        u.pm = fm + ((wgid % nig) % gsz); u.pn = (wgid % nig) / gsz; u.e = 0; return true;
    }
    __device__ __forceinline__ const char* a_base() const { return (const char*)A; }
    __device__ __forceinline__ unsigned a_off(const Unit& u, int r) const { return (unsigned)(u.pm * BM + r) * (unsigned)ldab; }
    __device__ __forceinline__ const char* b_ptr(const Unit& u) const { return (const char*)Bt + (size_t)u.pn * BM * kb; }
};

template <int MODE  >
struct MoeOrder {
    const void* A; const void* Bt; const int* list; const int* cnt; int ldab, kb, nN, G, c; size_t bstride;
    LAS int* tp; LAS int* cn; LAS int* rb;
    __device__ __forceinline__ void prep(LAS unsigned char* misc, int tid) {
        tp = (LAS int*)(misc + 64); cn = tp + 72; rb = cn + 72;
        if (tid < NEX1) cn[tid] = cnt[tid];
        __syncthreads();
        if (tid == 0) { int s = 0, q = 0; for (int e = 0; e < NEX1; ++e) { tp[e] = s; rb[e] = q; s += (cn[e] + BM - 1) / BM; q += cn[e]; } tp[NEX1] = s; rb[NEX1] = q; }
        __syncthreads();
    }
    __device__ __forceinline__ bool next(int i, Unit& u) const {
        const int total = tp[NEX1]; const long nu = (long)total * nN; const int per = (int)((nu + G - 1) / G);
        (void)per;
        long L = (long)i * G + c;
        if ((G & 7) == 0) L = ((long)i * 8 + (c & 7)) * (G >> 3) + (c >> 3);
        if (L >= nu) return false;
        const int tile = (int)(L / nN); u.pn = (int)(L % nN);
        int e = 0;
        for (int k = 1; k < NEX1; ++k) e += (tp[k] <= tile) ? 1 : 0;
        u.e = e; u.pm = tile - tp[e]; return true;
    }
    __device__ __forceinline__ const char* a_base() const { return (const char*)A; }
    __device__ __forceinline__ unsigned a_off(const Unit& u, int r) const {
        int pos = u.pm * BM + r; const int n = cn[u.e]; pos = pos < n ? pos : n - 1;
        if (MODE == 1) return (unsigned)(rb[u.e] + pos) * (unsigned)ldab;
        const int a = list[u.e * TT + pos];
        const int row = a < 8 * TT ? (a >> 3) : a - 8 * TT;
        return (unsigned)row * (unsigned)ldab;
    }
    __device__ __forceinline__ const char* b_ptr(const Unit& u) const { return (const char*)Bt + (size_t)u.e * bstride + (size_t)u.pn * BM * kb; }
};

typedef int v8i32 __attribute__((ext_vector_type(8)));
typedef int v4i32_ __attribute__((ext_vector_type(4)));
__device__ __forceinline__ v8i32 cat8(bf16x8 a, bf16x8 b) { const u32x4 x = __builtin_bit_cast(u32x4, a), y = __builtin_bit_cast(u32x4, b); return (v8i32){(int)x.x, (int)x.y, (int)x.z, (int)x.w, (int)y.x, (int)y.y, (int)y.z, (int)y.w}; }
template <bool FP8, class Epi, class Sched>
__device__ __forceinline__ void gemm_phase(LAS unsigned char* lds, const Sched& S, const Epi& E, int wave_id) {
    const int wid = wave_id; int lane = (int)__builtin_amdgcn_mbcnt_hi(~0u, __builtin_amdgcn_mbcnt_lo(~0u, 0u)); asm volatile("" : "+v"(lane));
    const int tid = wid * 64 + lane, wr = wid >> 2, wc = wid & 3, fr = lane & 15, fq = lane >> 4;
    const int kb = S.kb; int nt = kb / 128; asm volatile("" : "+s"(nt));
    unsigned voffB[2];
#pragma unroll
    for (int i = 0; i < 2; ++i) { int R, C; stage_rc(tid * 16 + i * 8192, R, C); const int Rb = (R & ~31) + perm32(R & 31);
        voffB[i] = (unsigned)(Rb * kb) + (unsigned)C * 2u; }
#define PG8_AOFF(u, h, i) ({ int _tz = tid; asm volatile("" : "+v"(_tz)); int _R, _C; stage_rc(_tz * 16 + (i) * 8192, _R, _C); S.a_off((u), (h) * HALF + _R) + (unsigned)_C * 2u; })
    const size_t kstep = (size_t)(BK * 2);
    const size_t hstepB = (size_t)HALF * kb;
    const unsigned ldsw = (unsigned)wid * 1024u;
    const int aoff = lds_byte(wr * 64 + fr, fq * 8), boff = lds_byte(wc * 32 + fr, fq * 8);
#define PG8_SA(b, h) (((b) * 2 + (h)) * HTB)
#define PG8_SB(b, h) ((4 + (b) * 2 + (h)) * HTB)
#define PG8_STAGE(bufoff, gbase, v0, v1) do { \
        __builtin_amdgcn_global_load_lds((const unsigned*)((const char*)(gbase) + (v0)), (LAS unsigned*)(lds + (bufoff) + ldsw), 16, 0, 0); \
        __builtin_amdgcn_global_load_lds((const unsigned*)((const char*)(gbase) + (v1)), (LAS unsigned*)(lds + (bufoff) + ldsw + 8192), 16, 0, 0); } while (0)
#define PG8_VOFFB(i) ({ int _tz = tid; asm volatile("" : "+v"(_tz)); int _R, _C; stage_rc(_tz * 16 + (i) * 8192, _R, _C); (unsigned)(((_R & ~31) + perm32(_R & 31)) * kb) + (unsigned)_C * 2u; })
#define PG8_STAGE_B(bufoff, gbase) do { if constexpr (FP8) { const unsigned _v0 = PG8_VOFFB(0), _v1 = PG8_VOFFB(1); PG8_STAGE(bufoff, gbase, _v0, _v1); } else PG8_STAGE(bufoff, gbase, voffB[0], voffB[1]); } while (0)
#define PG8_LD8(off) __builtin_shufflevector(*(const LAS v4i32_*)(lds + (off)), *(const LAS v4i32_*)(lds + (off) + 1024), 0, 1, 2, 3, 4, 5, 6, 7)
#define PG8_LDA(dst, b, h) do { _Pragma("unroll") for (int m = 0; m < 4; ++m) { if constexpr (FP8) dst##8[m] = PG8_LD8(PG8_SA(b, h) + aoff + m * 2048); else { _Pragma("unroll") for (int k = 0; k < 2; ++k) dst[m][k] = *(const LAS bf16x8*)(lds + PG8_SA(b, h) + aoff + m * 2048 + k * 1024); } } } while (0)
#define PG8_LDB(dst, b, h) do { _Pragma("unroll") for (int n = 0; n < 2; ++n) { if constexpr (FP8) dst##8[n] = PG8_LD8(PG8_SB(b, h) + boff + n * 2048); else { _Pragma("unroll") for (int k = 0; k < 2; ++k) dst[n][k] = *(const LAS bf16x8*)(lds + PG8_SB(b, h) + boff + n * 2048 + k * 1024); } } } while (0)
#define PG8_MMA(ai, bj, At, Bt) do { __builtin_amdgcn_s_setprio(1); _Pragma("unroll") for (int m = 0; m < 4; ++m) _Pragma("unroll") for (int n = 0; n < 2; ++n) { \
        if constexpr (FP8) asm volatile("v_mfma_f32_16x16x128_f8f6f4 %0, %1, %2, %0" : "+v"(acc[ai][bj][m][n]) : "v"(Bt##8[n]), "v"(At##8[m])); \
        else { _Pragma("unroll") for (int k = 0; k < 2; ++k) acc[ai][bj][m][n] = __builtin_amdgcn_mfma_f32_16x16x32_bf16(Bt[n][k], At[m][k], acc[ai][bj][m][n], 0, 0, 0); } } \
        __builtin_amdgcn_s_setprio(0); } while (0)
#define PG8_WAIT_V(n) asm volatile("s_waitcnt vmcnt(" #n ")" ::: "memory")
#define PG8_WAIT_L(n) asm volatile("s_waitcnt lgkmcnt(" #n ")" ::: "memory")
#define PG8_BAR __builtin_amdgcn_s_barrier()
#define PG8_SCHED __builtin_amdgcn_sched_barrier(0)
    Unit cur, nxt; int ui = 0;
    if (!S.next(0, cur)) return;
    f32x4 acc[2][2][4][2];
#pragma unroll
    for (int a = 0; a < 2; ++a)
#pragma unroll
        for (int b = 0; b < 2; ++b)
#pragma unroll
            for (int m = 0; m < 4; ++m)
#pragma unroll
                for (int n = 0; n < 2; ++n) acc[a][b][m][n] = (f32x4){0.f, 0.f, 0.f, 0.f};
    bf16x8 At[4][2], B0[2][2], B1[2][2]; v8i32 At8[4], B08[2], B18[2];
    const char* const gA = S.a_base();
    const char* cB = S.b_ptr(cur);
    unsigned oc00, oc01, oc10, oc11;
    oc00 = PG8_AOFF(cur, 0, 0); oc01 = PG8_AOFF(cur, 0, 1); oc10 = PG8_AOFF(cur, 1, 0); oc11 = PG8_AOFF(cur, 1, 1);
    PG8_STAGE_B(PG8_SB(0, 0), cB); PG8_STAGE_B(PG8_SB(0, 1), cB + hstepB); PG8_STAGE(PG8_SA(0, 0), gA, oc00, oc01); PG8_STAGE(PG8_SA(0, 1), gA, oc10, oc11);
    if (wr == 1) PG8_BAR;
    PG8_WAIT_V(2); PG8_BAR;
    PG8_STAGE_B(PG8_SB(1, 0), cB + kstep); PG8_STAGE(PG8_SA(1, 0), gA + kstep, oc00, oc01); PG8_STAGE_B(PG8_SB(1, 1), cB + hstepB + kstep);
    PG8_WAIT_V(6); PG8_BAR;
    for (;;) {
        const bool has_next = S.next(ui + 1, nxt);
        const char* nB = cB;
        {
            u32x4 on = {oc00, oc01, oc10, oc11};
            if (has_next) { on.x = PG8_AOFF(nxt, 0, 0); on.y = PG8_AOFF(nxt, 0, 1); on.z = PG8_AOFF(nxt, 1, 0); on.w = PG8_AOFF(nxt, 1, 1); nB = S.b_ptr(nxt); }
            *(LAS u32x4*)(lds + STAGE_BYTES + tid * 16) = on;
        }
        for (int t = 0; t < nt; t += 2) {
            const bool last = (t == nt - 2);
            const char* a1 = gA + (size_t)(t + 1) * kstep;
            const char* a2 = last ? gA : gA + (size_t)(t + 2) * kstep; const char* b2 = last ? nB : cB + (size_t)(t + 2) * kstep;
            const char* a3 = a2 + kstep; const char* b3 = b2 + kstep;
            unsigned s00 = oc00, s01 = oc01, s10 = oc10, s11 = oc11;
            if (last) { const u32x4 on = *(const LAS u32x4*)(lds + STAGE_BYTES + tid * 16); s00 = on.x; s01 = on.y; s10 = on.z; s11 = on.w; }
            PG8_LDB(B0, 0, 0); PG8_LDB(B1, 0, 1); PG8_SCHED; PG8_LDA(At, 0, 0); PG8_STAGE(PG8_SA(1, 1), a1, oc10, oc11);
            PG8_WAIT_V(8); PG8_WAIT_L(0); PG8_BAR; PG8_MMA(0, 0, At, B0); PG8_MMA(0, 1, At, B1); PG8_BAR; PG8_SCHED;
            PG8_LDA(At, 0, 1); PG8_STAGE_B(PG8_SB(0, 0), b2); PG8_STAGE_B(PG8_SB(0, 1), b2 + hstepB); PG8_STAGE(PG8_SA(0, 0), a2, s00, s01);
            PG8_WAIT_V(8); PG8_WAIT_L(0); PG8_BAR; PG8_MMA(1, 0, At, B0); PG8_MMA(1, 1, At, B1); PG8_BAR; PG8_SCHED;
            PG8_LDB(B0, 1, 0); PG8_LDB(B1, 1, 1); PG8_SCHED; PG8_LDA(At, 1, 0); PG8_STAGE(PG8_SA(0, 1), a2, s10, s11);
            PG8_WAIT_V(8); PG8_WAIT_L(0); PG8_BAR; PG8_MMA(0, 0, At, B0); PG8_MMA(0, 1, At, B1); PG8_BAR; PG8_SCHED;
            PG8_LDA(At, 1, 1); PG8_STAGE_B(PG8_SB(1, 0), b3); PG8_STAGE_B(PG8_SB(1, 1), b3 + hstepB); PG8_STAGE(PG8_SA(1, 0), a3, s00, s01);
            PG8_WAIT_V(8); PG8_WAIT_L(0); PG8_BAR; PG8_MMA(1, 0, At, B0); PG8_MMA(1, 1, At, B1); PG8_BAR; PG8_SCHED;
        }
        if (wr == 0) PG8_BAR;
        E(acc, cur, wr, wc, fr, fq);
        if (!has_next) break;
#pragma unroll
        for (int a = 0; a < 2; ++a)
#pragma unroll
            for (int b = 0; b < 2; ++b)
#pragma unroll
                for (int m = 0; m < 4; ++m)
#pragma unroll
                    for (int n = 0; n < 2; ++n) acc[a][b][m][n] = (f32x4){0.f, 0.f, 0.f, 0.f};
        { const u32x4 on = *(const LAS u32x4*)(lds + STAGE_BYTES + tid * 16); oc00 = on.x; oc01 = on.y; oc10 = on.z; oc11 = on.w; }
        cur = nxt; cB = nB; ++ui;
        if (wr == 1) PG8_BAR;
    }
    PG8_WAIT_V(0);
    PG8_BAR;
#undef PG8_SA
#undef PG8_SB
#undef PG8_STAGE
#undef PG8_STAGE_B
#undef PG8_AOFF
#undef PG8_VOFFB
#undef PG8_LD8
#undef PG8_LDA
#undef PG8_LDB
#undef PG8_MMA
#undef PG8_WAIT_V
#undef PG8_WAIT_L
#undef PG8_BAR
#undef PG8_SCHED
}

struct EpiStore {
    bf16_t* O; int ldc; float scale;
    __device__ __forceinline__ void operator()(const f32x4 (&acc)[2][2][4][2], const Unit& u, int wr, int wc, int fr, int fq) const {
        const int row0 = u.pm * BM + wr * 64 + fr, col0 = u.pn * BM + wc * 32 + 8 * fq;
#pragma unroll
        for (int ai = 0; ai < 2; ++ai)
#pragma unroll
            for (int m = 0; m < 4; ++m) { bf16_t* rowp = O + (size_t)(row0 + ai * HALF + m * 16) * ldc + col0;
#pragma unroll
                for (int bj = 0; bj < 2; ++bj) { const f32x4 v0 = acc[ai][bj][m][0] * scale, v1 = acc[ai][bj][m][1] * scale;
                    u32x4 w; w.x = cvt_pk_bf16(v0[0], v0[1]); w.y = cvt_pk_bf16(v0[2], v0[3]); w.z = cvt_pk_bf16(v1[0], v1[1]); w.w = cvt_pk_bf16(v1[2], v1[3]);
                    *(u32x4*)(rowp + bj * HALF) = w; } }
    }
};
struct EpiGlu {
    const bf16_t* Z; const float* b; bf16_t* MIX;
    __device__ __forceinline__ void operator()(const f32x4 (&acc)[2][2][4][2], const Unit& u, int wr, int wc, int fr, int fq) const {
        const int row0 = u.pm * BM + wr * 64 + fr, col0 = u.pn * BM + wc * 32 + 8 * fq;
#pragma unroll
        for (int bj = 0; bj < 2; ++bj) {
            const f32x4 b0 = *(const f32x4*)(b + col0 + bj * HALF), b1 = *(const f32x4*)(b + col0 + bj * HALF + 4);
#pragma unroll
            for (int ai = 0; ai < 2; ++ai)
#pragma unroll
                for (int m = 0; m < 4; ++m) { const size_t row = (size_t)(row0 + ai * HALF + m * 16);
                    const u32x4 zz = *(const u32x4*)(Z + row * 1024 + col0 + bj * HALF);
                    const f32x4 v0 = acc[ai][bj][m][0] + b0, v1 = acc[ai][bj][m][1] + b1;
                    u32x4 w;
                    w.x = cvt_pk_bf16(bflo(zz.x) * sigmoidf_(v0[0]), bfhi(zz.x) * sigmoidf_(v0[1]));
                    w.y = cvt_pk_bf16(bflo(zz.y) * sigmoidf_(v0[2]), bfhi(zz.y) * sigmoidf_(v0[3]));
                    w.z = cvt_pk_bf16(bflo(zz.z) * sigmoidf_(v1[0]), bfhi(zz.z) * sigmoidf_(v1[1]));
                    w.w = cvt_pk_bf16(bflo(zz.w) * sigmoidf_(v1[2]), bfhi(zz.w) * sigmoidf_(v1[3]));
                    *(u32x4*)(MIX + row * DM + 1024 + col0 + bj * HALF) = w; }
        }
    }
};
struct EpiE1 {
    unsigned char* H; const LAS int* cn; const LAS int* rb;
    __device__ __forceinline__ void operator()(const f32x4 (&acc)[2][2][4][2], const Unit& u, int wr, int wc, int fr, int fq) const {
        const int n = cn[u.e]; const int colh = u.pn * 128 + wc * 32 + 8 * fq;
#pragma unroll
        for (int ai = 0; ai < 2; ++ai)
#pragma unroll
            for (int m = 0; m < 4; ++m) { const int pos = u.pm * BM + ai * HALF + wr * 64 + m * 16 + fr;
                if (pos < n) { const int a = rb[u.e] + pos;
                    float sc = WSCALE_INV; asm volatile("" : "+v"(sc));
                    const f32x4 g0 = acc[ai][0][m][0] * sc, g1 = acc[ai][0][m][1] * sc, u0 = acc[ai][1][m][0] * sc, u1 = acc[ai][1][m][1] * sc;
                    u32x2 w;
                    w.x = (unsigned)__builtin_amdgcn_cvt_pk_fp8_f32(siluf_(g0[0]) * u0[0], siluf_(g0[1]) * u0[1], 0, false);
                    w.x = (unsigned)__builtin_amdgcn_cvt_pk_fp8_f32(siluf_(g0[2]) * u0[2], siluf_(g0[3]) * u0[3], (int)w.x, true);
                    w.y = (unsigned)__builtin_amdgcn_cvt_pk_fp8_f32(siluf_(g1[0]) * u1[0], siluf_(g1[1]) * u1[1], 0, false);
                    w.y = (unsigned)__builtin_amdgcn_cvt_pk_fp8_f32(siluf_(g1[2]) * u1[2], siluf_(g1[3]) * u1[3], (int)w.y, true);
                    *(u32x2*)(H + (size_t)a * EHID + colh) = w; }
                __builtin_amdgcn_sched_barrier(0); }
    }
};
struct EpiE2 {
    unsigned char* Y; const float* wgt; const LAS int* cn; const LAS int* rb;
    __device__ __forceinline__ void operator()(const f32x4 (&acc)[2][2][4][2], const Unit& u, int wr, int wc, int fr, int fq) const {
        const int n = cn[u.e]; const int col0 = u.pn * BM + wc * 32 + 8 * fq;
#pragma unroll
        for (int ai = 0; ai < 2; ++ai)
#pragma unroll
            for (int m = 0; m < 4; ++m) { const int pos = u.pm * BM + ai * HALF + wr * 64 + m * 16 + fr;
                if (pos < n) { const int a = rb[u.e] + pos; float ws = wgt[u.e * TT + pos] * WSCALE_INV; asm volatile("" : "+v"(ws));
                    unsigned char* rowp = Y + (size_t)a * DM + col0;
#pragma unroll
                    for (int bj = 0; bj < 2; ++bj) { const f32x4 v0 = acc[ai][bj][m][0] * ws, v1 = acc[ai][bj][m][1] * ws;
                        u32x2 w;
                        w.x = (unsigned)__builtin_amdgcn_cvt_pk_fp8_f32(v0[0], v0[1], 0, false); w.x = (unsigned)__builtin_amdgcn_cvt_pk_fp8_f32(v0[2], v0[3], (int)w.x, true);
                        w.y = (unsigned)__builtin_amdgcn_cvt_pk_fp8_f32(v1[0], v1[1], 0, false); w.y = (unsigned)__builtin_amdgcn_cvt_pk_fp8_f32(v1[2], v1[3], (int)w.y, true);
                        *(u32x2*)(rowp + bj * HALF) = w; } }
                __builtin_amdgcn_sched_barrier(0); }
    }
};
}
struct KArgs {
    const float* in[34];
    float* out;
    unsigned char* ws;
    int ph_lo, ph_hi;
};
struct Params {
    float* out;
    unsigned char* ws;
    LAS unsigned long long* ptab;
    int ph_lo, ph_hi;
    __device__ __forceinline__ const float* inp(int k) const {
        const unsigned long long v = ptab[k];
        const unsigned lo = __builtin_amdgcn_readfirstlane((unsigned)v), hi = __builtin_amdgcn_readfirstlane((unsigned)(v >> 32));
        return (const float*)(((unsigned long long)hi << 32) | lo);
    }
};
struct Ctx {
    LAS unsigned char* lds;
    int tid, lane, wave, G, bid;
    int gw, ngw;
};

__device__ __forceinline__ void tr_item(const float* W, int N, bf16_t* WT, int ldt, int k0, int n0, int orow0, LAS float* scr, int lane) {
#pragma unroll 8
    for (int i = 0; i < 32; ++i) { const int kk = 2 * i + (lane >> 5); scr[kk * 33 + (lane & 31)] = W[(size_t)(k0 + kk) * N + n0 + (lane & 31)]; }
    LDS_WAIT(); asm volatile("" ::: "memory");
    const int c = lane & 7;
#pragma unroll
    for (int j = 0; j < 4; ++j) { const int n = (lane >> 3) + 8 * j; const LAS float* s = scr + (8 * c) * 33 + n;
        u32x4 o; o.x = cvt_pk_bf16(s[0 * 33], s[1 * 33]); o.y = cvt_pk_bf16(s[2 * 33], s[3 * 33]); o.z = cvt_pk_bf16(s[4 * 33], s[5 * 33]); o.w = cvt_pk_bf16(s[6 * 33], s[7 * 33]);
        *(u32x4*)(WT + (size_t)(orow0 + n) * ldt + k0 + 8 * c) = o; }
    LDS_WAIT(); asm volatile("" ::: "memory");
}
__device__ __forceinline__ void tr_item64(const float* W, int N, bf16_t* WT, int ldt, int k0, int n0, int orow0, LAS float* scr, int lane) {
    f32x4 v[16];
    const float* src = W + (size_t)(k0 + (lane >> 4)) * N + n0 + 4 * (lane & 15);
#pragma unroll
    for (int i = 0; i < 16; ++i) v[i] = __builtin_nontemporal_load((const f32x4*)(src + (size_t)(4 * i) * N));
#pragma unroll
    for (int i = 0; i < 16; ++i) { LAS float* d = scr + (4 * i + (lane >> 4)) * 65 + 4 * (lane & 15); d[0] = v[i][0]; d[1] = v[i][1]; d[2] = v[i][2]; d[3] = v[i][3]; }
    LDS_WAIT(); asm volatile("" ::: "memory");
    const int c = lane & 7;
#pragma unroll
    for (int j = 0; j < 8; ++j) { const int n = (lane >> 3) + 8 * j; const LAS float* s = scr + (8 * c) * 65 + n;
        u32x4 o; o.x = cvt_pk_bf16(s[0 * 65], s[1 * 65]); o.y = cvt_pk_bf16(s[2 * 65], s[3 * 65]); o.z = cvt_pk_bf16(s[4 * 65], s[5 * 65]); o.w = cvt_pk_bf16(s[6 * 65], s[7 * 65]);
        *(u32x4*)(WT + (size_t)(orow0 + n) * ldt + k0 + 8 * c) = o; }
    LDS_WAIT(); asm volatile("" ::: "memory");
}
__device__ __forceinline__ void tr_item64_fp8(const float* W, int N, unsigned char* WT, int ldt, int k0, int n0, int orow0, LAS float* scr, int lane, float wscale = pg8::WSCALE) {
    f32x4 v[16];
    const float* src = W + (size_t)(k0 + (lane >> 4)) * N + n0 + 4 * (lane & 15);
#pragma unroll
    for (int i = 0; i < 16; ++i) v[i] = __builtin_nontemporal_load((const f32x4*)(src + (size_t)(4 * i) * N));
#pragma unroll
    for (int i = 0; i < 16; ++i) { LAS float* d = scr + (4 * i + (lane >> 4)) * 65 + 4 * (lane & 15); d[0] = v[i][0]; d[1] = v[i][1]; d[2] = v[i][2]; d[3] = v[i][3]; }
    LDS_WAIT(); asm volatile("" ::: "memory");
    const int c = lane & 3;
#pragma unroll
    for (int j = 0; j < 4; ++j) { const int n = (lane >> 2) + 16 * j; const LAS float* s = scr + (16 * c) * 65 + n;
        u32x4 o;
        o.x = (unsigned)__builtin_amdgcn_cvt_pk_fp8_f32(s[0 * 65] * wscale, s[1 * 65] * wscale, 0, false);   o.x = (unsigned)__builtin_amdgcn_cvt_pk_fp8_f32(s[2 * 65] * wscale, s[3 * 65] * wscale, (int)o.x, true);
        o.y = (unsigned)__builtin_amdgcn_cvt_pk_fp8_f32(s[4 * 65] * wscale, s[5 * 65] * wscale, 0, false);   o.y = (unsigned)__builtin_amdgcn_cvt_pk_fp8_f32(s[6 * 65] * wscale, s[7 * 65] * wscale, (int)o.y, true);
        o.z = (unsigned)__builtin_amdgcn_cvt_pk_fp8_f32(s[8 * 65] * wscale, s[9 * 65] * wscale, 0, false);   o.z = (unsigned)__builtin_amdgcn_cvt_pk_fp8_f32(s[10 * 65] * wscale, s[11 * 65] * wscale, (int)o.z, true);
        o.w = (unsigned)__builtin_amdgcn_cvt_pk_fp8_f32(s[12 * 65] * wscale, s[13 * 65] * wscale, 0, false); o.w = (unsigned)__builtin_amdgcn_cvt_pk_fp8_f32(s[14 * 65] * wscale, s[15 * 65] * wscale, (int)o.w, true);
        *(u32x4*)(WT + (size_t)(orow0 + n) * ldt + k0 + 16 * c) = o; }
    LDS_WAIT(); asm volatile("" ::: "memory");
}
__device__ __forceinline__ void tr_dense(const float* W, int K, int N, bf16_t* WT, int item, LAS float* scr, int lane) {
    const int nblk = N / 32, kb = item / nblk, nb = item % nblk;
    tr_item(W, N, WT, K, 64 * kb, 32 * nb, 32 * nb, scr, lane);
}

__device__ __forceinline__ void s5_tables(const Params& p, Ctx& C, int dir, int g) {
    LAS f32x2* PW = (LAS f32x2*)C.lds;
    LAS f32x2* BB = PW + 65 * 64;
    LAS f32x2* CX = BB + 64 * 16;
    const float* a_re = p.inp(11); const float* a_im = p.inp(12); const float* log_dt = p.inp(13);
    const float* b_re = p.inp(14); const float* b_im = p.inp(15); const float* c_re = p.inp(16); const float* c_im = p.inp(17);
    const int tid = C.tid;
    if (tid < 64) {
        const int pp = tid;
        const float dt = __expf(log_dt[dir * 64 + g]);
        const float are = a_re[(dir * 64 + g) * 64 + pp], aim = a_im[(dir * 64 + g) * 64 + pp];
        const float zr = are * dt, zi = aim * dt;
        const float mag = __expf(zr);
        double rev = (double)zi * 0.15915494309189535; rev -= floor(rev);
        const float cs = __builtin_amdgcn_cosf((float)rev), sn = __builtin_amdgcn_sinf((float)rev);
        const float abr = mag * cs, abi = mag * sn;
        const float den = are * are + aim * aim, nr = abr - 1.0f, ni = abi;
        const float fre = (nr * are + ni * aim) / den, fim = (ni * are - nr * aim) / den;
        float pr = 1.0f, pi = 0.0f;
#pragma unroll 1
        for (int n = 0; n <= 64; ++n) { PW[n * 64 + pp] = (f32x2){pr, pi}; const float t = pr * abr - pi * abi; pi = pr * abi + pi * abr; pr = t; }
        for (int j = 0; j < 16; ++j) { const float br = b_re[(g * 64 + pp) * 16 + j], bi = b_im[(g * 64 + pp) * 16 + j];
            BB[pp * 16 + j] = (f32x2){fre * br - fim * bi, fre * bi + fim * br}; }
    }
    for (int q = tid; q < 1024; q += NTHR) { const int i = q >> 6, pp = q & 63; CX[i * 64 + pp] = (f32x2){c_re[(g * 16 + i) * 64 + pp], c_im[(g * 16 + i) * 64 + pp]}; }
    __syncthreads();
    bf16_t* KN = (bf16_t*)(p.ws + WS_KN) + (size_t)(dir * 64 + g) * 16 * 1024;
    float* APOW = (float*)(p.ws + WS_APOW) + (size_t)(dir * 64 + g) * 64 * 128;
    float* AL = (float*)(p.ws + WS_AL) + (size_t)(dir * 64 + g) * 128;
#pragma unroll 1
    for (int q = 0; q < 32; ++q) { const int idx = tid + NTHR * q; const int n = idx >> 8, i = (idx >> 4) & 15, j = idx & 15;
        float s = 0.f;
#pragma unroll 4
        for (int pp = 0; pp < 64; ++pp) { const f32x2 c = CX[i * 64 + pp], w = PW[n * 64 + pp], b = BB[pp * 16 + j];
            const float gr = c.x * b.x - c.y * b.y, gi = c.x * b.y + c.y * b.x;
            s += gr * w.x - gi * w.y; }
        KN[(size_t)i * 1024 + n * 16 + j] = f2bf(s); }
    for (int q = tid; q < 4096; q += NTHR) { const int t = q >> 6, pp = q & 63; const f32x2 w = PW[(t + 1) * 64 + pp]; *(f32x2*)(APOW + (size_t)t * 128 + 2 * pp) = w; }
    if (tid < 64) { const f32x2 w = PW[64 * 64 + tid]; *(f32x2*)(AL + 2 * tid) = w; }
    { bf16_t* BBT = (bf16_t*)(p.ws + WS_BBT) + (size_t)(dir * 64 + g) * 128 * 16;
      for (int q = tid; q < 2048; q += NTHR) { const int pq = q >> 4, j = q & 15; const f32x2 b = BB[(pq & 63) * 16 + j]; BBT[q] = f2bf(pq < 64 ? b.x : b.y); } }
    if (dir == 0) { bf16_t* CCt = (bf16_t*)(p.ws + WS_CC) + (size_t)g * 16 * 128;
        for (int q = tid; q < 2048; q += NTHR) { const int i = q >> 7, pq = q & 127; const f32x2 c = CX[i * 64 + (pq & 63)]; CCt[i * 128 + pq] = f2bf(pq < 64 ? c.x : -c.y); } }
    __syncthreads();
}

__device__ __forceinline__ void phase_p0(const Params& p, Ctx& C) {
    for (int task = C.bid; task < 128; task += C.G) s5_tables(p, C, task >> 6, task & 63);
    {
        const int gt = C.bid * NTHR + C.tid, ngt = C.G * NTHR;
        float* R128 = (float*)(p.ws + WS_ROPE128); float* R64 = (float*)(p.ws + WS_ROPE64);
        for (int q = gt; q < 256 * 64 + 256 * 32; q += ngt) {
            int pos, i, half; float* dst;
            if (q < 256 * 64) { pos = q >> 6; i = q & 63; half = 64; dst = R128 + (size_t)q * 2; }
            else { const int r = q - 256 * 64; pos = r >> 5; i = r & 31; half = 32; dst = R64 + (size_t)r * 2; }
            const float freq = exp2f(-(float)i / (float)half * 13.287712379549449f);
            const float ang = (float)pos * freq;
            double rev = (double)ang * 0.15915494309189535; rev -= floor(rev);
            dst[0] = __builtin_amdgcn_cosf((float)rev); dst[1] = __builtin_amdgcn_sinf((float)rev);
        }
        bf16_t* RWT = (bf16_t*)(p.ws + WS_RWT); const float* rw = p.inp(26);
        for (int q = gt; q < 2 * 64 * DM; q += ngt) { const int L = q / (64 * DM), r = q % (64 * DM), e = r / DM, k = r % DM;
            const float w = rw[((size_t)L * DM + k) * 64 + e]; const bf16_t hi = f2bf(w); const bf16_t lo = f2bf(w - bf2f(hi));
            RWT[((size_t)(L * 2 + 0) * 64 + e) * DM + k] = hi; RWT[((size_t)(L * 2 + 1) * 64 + e) * DM + k] = lo; }
    }
    {
        const float* cvec = p.inp(1); const float* cctx = p.inp(3); const float* mw = p.inp(4);
        float* MODP = (float*)(p.ws + WS_MODP);
        for (int task = C.gw; task < 2 * 32 * 48; task += C.ngw) {
            const int L = task / (32 * 48), r = task % (32 * 48), kb = r / 48, cb = r % 48;
            const float sc = siluf_(cvec[64 * kb + C.lane]), sx = siluf_(cctx[64 * kb + C.lane]);
            f32x4 a0 = {0.f, 0.f, 0.f, 0.f}, a1 = {0.f, 0.f, 0.f, 0.f};
            const float* wp = mw + ((size_t)L * DM + 64 * kb) * 12288 + 256 * cb + 4 * C.lane;
#pragma unroll 8
            for (int kk = 0; kk < 64; ++kk) { const f32x4 w = *(const f32x4*)(wp + (size_t)kk * 12288);
                const float s0 = __shfl(sc, kk), s1 = __shfl(sx, kk);
                a0 += w * s0; a1 += w * s1; }
            *(f32x4*)(MODP + ((size_t)((L * 32 + kb) * 2 + 0)) * 12288 + 256 * cb + 4 * C.lane) = a0;
            *(f32x4*)(MODP + ((size_t)((L * 32 + kb) * 2 + 1)) * 12288 + 256 * cb + 4 * C.lane) = a1;
        }
    }
    {
        LAS float* scr = (LAS float*)(C.lds + C.wave * 17408);
        constexpr int J0 = (DM / 64) * (EV_IN / 64), J3 = (DM / 64) * (OD_IN / 64);
        for (int it = C.gw; it < J0 + J3; it += C.ngw) {
            const bool l1 = it >= J0; const int r = l1 ? it - J0 : it; const int N = l1 ? OD_IN : EV_IN; const int nblk = N / 64, kb = r / nblk, nb = r % nblk;
            tr_item64_fp8(p.inp(l1 ? 21 : 8), N, (unsigned char*)(p.ws + (l1 ? WS_WIN1 : WS_WIN0)), DM, 64 * kb, 64 * nb, 64 * nb, scr, C.lane, 32.0f);
        }
        LAS float* scr2 = (LAS float*)(C.lds + C.wave * 17408);
        constexpr int I1 = (DM / 64) * (DM / 32), I2 = (1024 / 64) * (1024 / 32), I4 = I1;
        for (int it = C.gw; it < I1 + I2 + I4; it += C.ngw) {
            int r = it;
            if (r < I1) { tr_dense(p.inp(9), DM, DM, (bf16_t*)(p.ws + WS_WOUT0), r, scr2, C.lane); continue; } r -= I1;
            if (r < I2) { tr_dense(p.inp(19), 1024, 1024, (bf16_t*)(p.ws + WS_WGLU), r, scr2, C.lane); continue; } r -= I2;
            tr_dense(p.inp(22), DM, DM, (bf16_t*)(p.ws + WS_WOUT1), r, scr2, C.lane);
        }
    }
}
__device__ __forceinline__ void phase_p1(const Params& p, Ctx& C) {
    const float* MODP = (const float*)(p.ws + WS_MODP); float* MODF = (float*)(p.ws + WS_MODF); const float* mb = p.inp(5);
    for (int q = C.bid * NTHR + C.tid; q < 2 * 2 * 12288; q += C.G * NTHR) { const int L = q / (2 * 12288), v = (q / 12288) & 1, col = q % 12288;
        float s = mb[L * 12288 + col];
        for (int kb = 0; kb < 32; ++kb) s += MODP[((size_t)((L * 32 + kb) * 2 + v)) * 12288 + col];
        MODF[q] = s; }
}
__device__ __forceinline__ const float* modv(const Params& p, int L, int v, int k) { return (const float*)(p.ws + WS_MODF) + (size_t)(L * 2 + v) * 12288 + k * DM; }

__device__ __forceinline__ void stage_vec(LAS float* dst, const float* src, int tid) { *(LAS f32x4*)(dst + 4 * tid) = *(const f32x4*)(src + 4 * tid); }
__device__ __forceinline__ void conv_item(const Params& p, Ctx& C, int L, int it) {
    LAS float* scr = (LAS float*)(C.lds + C.wave * 17408);
    unsigned char* GU = (unsigned char*)(p.ws + WS_GU) + (size_t)L * NEX1 * 1024 * DM; unsigned char* DT = (unsigned char*)(p.ws + WS_DT) + (size_t)L * NEX1 * DM * EHID;
    const int e = it / 768, r = it % 768, which = r >> 8, q = r & 255;
    if (which < 2) {
        const float* W = (e < 64) ? p.inp(28 + which) + ((size_t)(L * 64 + e)) * DM * EHID : p.inp(31 + which) + (size_t)L * DM * EHID;
        const int kb = q >> 3, nb = q & 7, n0 = 64 * nb;
        tr_item64_fp8(W, EHID, GU + (size_t)e * 1024 * DM, DM, 64 * kb, n0, 256 * (n0 >> 7) + (n0 & 127) + (which ? 128 : 0), scr, C.lane);
    } else {
        const float* W = (e < 64) ? p.inp(30) + ((size_t)(L * 64 + e)) * EHID * DM : p.inp(33) + (size_t)L * EHID * DM;
        const int kb = q >> 5, nb = q & 31;
        tr_item64_fp8(W, DM, DT + (size_t)e * DM * EHID, EHID, 64 * kb, 64 * nb, 64 * nb, scr, C.lane);
    }
}
__device__ __forceinline__ void conv_queue(const Params& p, Ctx& C, int quota) {
    unsigned* head = (unsigned*)(p.ws + WS_CTL) + CW_QUEUE + 128;
    const int batch = quota < 8 ? quota : 8;
    for (int done = 0; done < quota; done += batch) {
        int it0 = 0; if (C.lane == 0) it0 = (int)atomicAdd(head, (unsigned)batch);
        it0 = __builtin_amdgcn_readfirstlane(it0);
        if (it0 >= NEX1 * 768) break;
        for (int k = 0; k < batch && it0 + k < NEX1 * 768; ++k) conv_item(p, C, 1, it0 + k);
    }
}
__device__ __forceinline__ void phase_modulate(const Params& p, Ctx& C, int L) {
    unsigned char* XA8 = (unsigned char*)(p.ws + WS_XA);
    const float* X2 = (const float*)(p.ws + WS_HX2);
    LAS float* MV = (LAS float*)C.lds;
    for (int v = 0; v < 2; ++v) { stage_vec(MV + (v * 2 + 0) * DM, modv(p, L, v, 0), C.tid); stage_vec(MV + (v * 2 + 1) * DM, modv(p, L, v, 1), C.tid); }
    __syncthreads();
    for (int r = C.gw; r < TT; r += C.ngw) {
        const int v = r < CTXL ? 1 : 0;
        const float* src = (L == 0) ? (r < CTXL ? p.inp(2) + (size_t)r * DM : p.inp(0) + (size_t)(r - CTXL) * DM) : X2 + (size_t)r * DM;
        const LAS float* sh = MV + (v * 2 + 0) * DM; const LAS float* sc = MV + (v * 2 + 1) * DM;
#pragma unroll
        for (int j = 0; j < 8; ++j) { const int c = 4 * (C.lane + 64 * j);
            const f32x4 x = *(const f32x4*)(src + c), a = *(const LAS f32x4*)(sc + c), b = *(const LAS f32x4*)(sh + c);
            const f32x4 y = x * (a + 1.0f) + b;
            unsigned w = (unsigned)__builtin_amdgcn_cvt_pk_fp8_f32(y[0], y[1], 0, false); w = (unsigned)__builtin_amdgcn_cvt_pk_fp8_f32(y[2], y[3], (int)w, true);
            *(unsigned*)(XA8 + (size_t)r * DM + c) = w; }
    }
    __syncthreads();
    if (L == 0) { for (int it = C.gw; it < NEX1 * 768; it += C.ngw) conv_item(p, C, 0, it); }
    else conv_queue(p, C, 1 << 30);
}

__device__ __forceinline__ void phase_rope0(const Params& p, Ctx& C) {
    bf16_t* QKV = (bf16_t*)(p.ws + WS_BIG + BG_QKV);
    const f32x2* R128 = (const f32x2*)(p.ws + WS_ROPE128);
    for (int r = C.gw; r < TT; r += C.ngw) {
        bf16_t* row = QKV + (size_t)r * EV_IN;
        if (r < CTXL) {
#pragma unroll
            for (int j = 0; j < 2; ++j) { u32x4* q = (u32x4*)(row + 8 * (C.lane + 64 * j)); u32x4 w = *q;
                w.x = cvt_pk_bf16(bflo(w.x) * 0.0625f, bfhi(w.x) * 0.0625f); w.y = cvt_pk_bf16(bflo(w.y) * 0.0625f, bfhi(w.y) * 0.0625f);
                w.z = cvt_pk_bf16(bflo(w.z) * 0.0625f, bfhi(w.z) * 0.0625f); w.w = cvt_pk_bf16(bflo(w.w) * 0.0625f, bfhi(w.w) * 0.0625f); *q = w; }
        } else {
            const int l = r - CTXL, rp = l >> 6, cp = l & 63;
#pragma unroll
            for (int qk = 0; qk < 2; ++qk)
#pragma unroll
                for (int m = 0; m < 8; ++m) { const int pi = C.lane + 64 * m, head = pi >> 7, blk = (pi >> 6) & 1, i = pi & 63;
                    bf16_t* b = row + qk * 1024 + head * 256 + blk * 128 + i;
                    const f32x2 cs = R128[(blk ? cp : rp) * 64 + i];
                    const float x1 = bf2f(b[0]), x2 = bf2f(b[64]); const float sc = qk ? 1.0f : 0.0625f;
                    b[0] = f2bf((x1 * cs.x - x2 * cs.y) * sc); b[64] = f2bf((x1 * cs.y + x2 * cs.x) * sc); }
        }
    }
}

__device__ __forceinline__ void phase_normrope1(const Params& p, Ctx& C) {
    bf16_t* QKV = (bf16_t*)(p.ws + WS_BIG + BG_QKV);
    const f32x2* R64 = (const f32x2*)(p.ws + WS_ROPE64);
    const float* qg = p.inp(23);
    unsigned* KMAX = (unsigned*)(p.ws + WS_CTL) + CW_KMAX;
    const int lane = C.lane, i32 = lane & 31; const bool up = lane >= 32;
    const float g00 = qg[lane], g01 = qg[64 + lane], g10 = qg[128 + lane], g11 = qg[128 + 64 + lane];
    for (int r = C.gw; r < TT; r += C.ngw) {
        bf16_t* row = QKV + (size_t)r * OD_IN;
        const bool lat = r >= CTXL; const int l = r - CTXL, rp = lat ? (l >> 6) : 0, cp = lat ? (l & 63) : 0;
        const f32x2 cr = R64[rp * 32 + i32], cc = R64[cp * 32 + i32];
#pragma unroll 2
        for (int h = 0; h < 26; ++h) {
            const int col = h < 8 ? 128 * h : (h < 10 ? 1024 + 128 * (h - 8) : (h < 18 ? 1536 + 128 * (h - 10) : 2560 + 128 * (h - 18)));
            bf16_t* b = row + col;
            float v0 = bf2f(b[lane]), v1 = bf2f(b[64 + lane]);
            if (h < 10) { const float ss = wave_sum(v0 * v0 + v1 * v1); const float rs = rsqrtf(ss * (1.0f / 128.0f) + LN_EPS);
                v0 = bf2f(f2bf(v0 * rs)) * (h < 8 ? g00 : g10); v1 = bf2f(f2bf(v1 * rs)) * (h < 8 ? g01 : g11); }
            if (lat) { const float p0 = __shfl_xor(v0, 32), p1 = __shfl_xor(v1, 32);
                v0 = up ? (p0 * cr.y + v0 * cr.x) : (v0 * cr.x - p0 * cr.y);
                v1 = up ? (p1 * cc.y + v1 * cc.x) : (v1 * cc.x - p1 * cc.y); }
            const bf16_t o0 = f2bf(v0), o1 = f2bf(v1);
            b[lane] = o0; b[64 + lane] = o1;
            if ((h >= 8 && h < 10) || h >= 18) {
                const float w0 = bf2f(o0), w1 = bf2f(o1); const float k2 = wave_sum(w0 * w0 + w1 * w1);
                if (lane == 0) atomicMax(KMAX + 64 * (h < 10 ? h - 8 : h - 16), __float_as_uint(k2)); }
        }
    }
}

__device__ __forceinline__ void phase_merge1(const Params& p, Ctx& C) {
    bf16_t* ATT = (bf16_t*)(p.ws + WS_BIG + BG_ATT);
    const float* dl = p.inp(24); const float* sg = p.inp(25);
    const int lane = C.lane;
    float d0 = dl[lane] * dl[128 + lane] + dl[64 + lane] * dl[128 + 64 + lane];
    float d1 = dl[256 + lane] * dl[384 + lane] + dl[256 + 64 + lane] * dl[384 + 64 + lane];
    const float lam = __expf(wave_sum(d0)) - __expf(wave_sum(d1)) + LAMBDA_INIT;
    const f32x4 gg = *(const f32x4*)(sg + 4 * lane);
    for (int l = C.gw; l < SEQ; l += C.ngw) {
        bf16_t* row = ATT + (size_t)l * 3072;
#pragma unroll
        for (int h = 0; h < 4; ++h) {
            const u32x2 a = *(const u32x2*)(row + 1024 + 256 * h + 4 * lane), b = *(const u32x2*)(row + 2048 + 256 * h + 4 * lane);
            f32x4 o = {bflo(a.x) - lam * bflo(b.x), bfhi(a.x) - lam * bfhi(b.x), bflo(a.y) - lam * bflo(b.y), bfhi(a.y) - lam * bfhi(b.y)};
            const float ss = wave_sum(o[0] * o[0] + o[1] * o[1] + o[2] * o[2] + o[3] * o[3]);
            const float rs = rsqrtf(ss * (1.0f / 256.0f) + LN_EPS) * (1.0f - LAMBDA_INIT);
            o = o * rs * gg;
            u32x2 w; w.x = cvt_pk_bf16(o[0], o[1]); w.y = cvt_pk_bf16(o[2], o[3]);
            *(u32x2*)(row + 1024 + 256 * h + 4 * lane) = w;
        }
    }
}

__device__ __forceinline__ void phase_ln1(const Params& p, Ctx& C, int L) {
    const bf16_t* Y = (const bf16_t*)(p.ws + WS_YMIX); float* X1 = (float*)(p.ws + WS_X1); unsigned char* XA8 = (unsigned char*)(p.ws + WS_XA);
    const float* X2 = (const float*)(p.ws + WS_HX2);
    const float* lg = p.inp(6) + (size_t)(L * 2 + 0) * DM; const float* lb = p.inp(7) + (size_t)(L * 2 + 0) * DM;
    const int r0 = (L == 0) ? 0 : CTXL;
    LAS float* MV = (LAS float*)C.lds; LAS float* LG = MV + 6 * DM; LAS float* LB = LG + DM;
    for (int v = 0; v < 2; ++v) for (int k = 0; k < 3; ++k) stage_vec(MV + (v * 3 + k) * DM, modv(p, L, v, 2 + k), C.tid);
    stage_vec(LG, lg, C.tid); stage_vec(LB, lb, C.tid);
    __syncthreads();
    for (int r = r0 + C.gw; r < TT; r += C.ngw) {
        const int v = r < CTXL ? 1 : 0;
        const float* src = (L == 0) ? (r < CTXL ? p.inp(2) + (size_t)r * DM : p.inp(0) + (size_t)(r - CTXL) * DM) : X2 + (size_t)r * DM;
        const LAS float* g1 = MV + (v * 3 + 0) * DM; const LAS float* sh2 = MV + (v * 3 + 1) * DM; const LAS float* sc2 = MV + (v * 3 + 2) * DM;
        f32x4 t[8]; float s = 0.f;
#pragma unroll
        for (int j = 0; j < 8; ++j) { const int c = 4 * (C.lane + 64 * j);
            const f32x4 x = *(const f32x4*)(src + c), g = *(const LAS f32x4*)(g1 + c); const u32x2 yy = *(const u32x2*)(Y + (size_t)r * DM + c);
            const f32x4 y = {bflo(yy.x), bfhi(yy.x), bflo(yy.y), bfhi(yy.y)};
            t[j] = x * ALPHA + g * y; s += (t[j][0] + t[j][1]) + (t[j][2] + t[j][3]); }
        const float mean = wave_sum(s) * (1.0f / DM); float s2 = 0.f;
#pragma unroll
        for (int j = 0; j < 8; ++j) { t[j] = t[j] - mean; s2 += (t[j][0] * t[j][0] + t[j][1] * t[j][1]) + (t[j][2] * t[j][2] + t[j][3] * t[j][3]); }
        const float rstd = rsqrtf(wave_sum(s2) * (1.0f / DM) + LN_EPS);
#pragma unroll
        for (int j = 0; j < 8; ++j) { const int c = 4 * (C.lane + 64 * j);
            const f32x4 x1 = t[j] * rstd * *(const LAS f32x4*)(LG + c) + *(const LAS f32x4*)(LB + c);
            *(f32x4*)(X1 + (size_t)r * DM + c) = x1;
            const f32x4 z = x1 * (*(const LAS f32x4*)(sc2 + c) + 1.0f) + *(const LAS f32x4*)(sh2 + c);
            unsigned w = (unsigned)__builtin_amdgcn_cvt_pk_fp8_f32(z[0], z[1], 0, false); w = (unsigned)__builtin_amdgcn_cvt_pk_fp8_f32(z[2], z[3], (int)w, true);
            *(unsigned*)(XA8 + (size_t)r * DM + c) = w; }
    }
    __syncthreads();
}

__device__ __forceinline__ void phase_combine(const Params& p, Ctx& C, int L, LAS unsigned char* misc) {
    const unsigned char* YM = (const unsigned char*)(p.ws + WS_BIG + BG_YMOE); const float* X1 = (const float*)(p.ws + WS_X1);
    float* X2 = (float*)(p.ws + WS_HX2);
    const float* lg = p.inp(6) + (size_t)(L * 2 + 1) * DM; const float* lb = p.inp(7) + (size_t)(L * 2 + 1) * DM;
    const unsigned* PK = (const unsigned*)(p.ws + WS_WGT); const int* cnt = (const int*)(p.ws + WS_CTL) + CW_CNT + L * 128;
    const int r0 = (L == 0) ? 0 : CTXL;
    LAS int* rb = (LAS int*)(misc + 64);
    LAS float* MV = (LAS float*)C.lds; LAS float* LG = MV + 2 * DM; LAS float* LB = LG + DM;
    __syncthreads();
    if (C.tid == 0) { int q = 0; for (int e = 0; e < NEX1; ++e) { rb[e] = q; q += cnt[e]; } }
    stage_vec(MV, modv(p, L, 0, 5), C.tid); stage_vec(MV + DM, modv(p, L, 1, 5), C.tid); stage_vec(LG, lg, C.tid); stage_vec(LB, lb, C.tid);
    __syncthreads();
    for (int r = r0 + C.gw; r < TT; r += C.ngw) {
        const int v = r < CTXL ? 1 : 0;
        const LAS float* g2 = MV + v * DM;
        int ln = C.lane; asm volatile("" : "+v"(ln));
        int slot = rb[64] + (r - r0);
        if (ln < 8) { const unsigned pk = PK[(size_t)r * 8 + ln]; slot = rb[pk >> 16] + (int)(pk & 0xffffu); }
        f32x4 t[2][4]; float s = 0.f;
#pragma unroll
        for (int j = 0; j < 2; ++j) { const int c = 16 * (ln + 64 * j);
            u32x4 yy[9];
#pragma unroll
            for (int k = 0; k < 9; ++k) { const size_t a = (size_t)__builtin_amdgcn_readlane(slot, k); yy[k] = __builtin_nontemporal_load((const u32x4*)(YM + a * DM + c)); }
            f32x2 f[8];
#pragma unroll
            for (int q = 0; q < 8; ++q) f[q] = (f32x2){0.f, 0.f};
#pragma unroll
            for (int k = 0; k < 9; ++k) {
                f[0] += __builtin_amdgcn_cvt_pk_f32_fp8((int)yy[k].x, false); f[1] += __builtin_amdgcn_cvt_pk_f32_fp8((int)yy[k].x, true);
                f[2] += __builtin_amdgcn_cvt_pk_f32_fp8((int)yy[k].y, false); f[3] += __builtin_amdgcn_cvt_pk_f32_fp8((int)yy[k].y, true);
                f[4] += __builtin_amdgcn_cvt_pk_f32_fp8((int)yy[k].z, false); f[5] += __builtin_amdgcn_cvt_pk_f32_fp8((int)yy[k].z, true);
                f[6] += __builtin_amdgcn_cvt_pk_f32_fp8((int)yy[k].w, false); f[7] += __builtin_amdgcn_cvt_pk_f32_fp8((int)yy[k].w, true); }
#pragma unroll
            for (int q = 0; q < 4; ++q) { const f32x4 x = *(const f32x4*)(X1 + (size_t)r * DM + c + 4 * q), g = *(const LAS f32x4*)(g2 + c + 4 * q);
                const f32x4 ff = {f[2 * q][0], f[2 * q][1], f[2 * q + 1][0], f[2 * q + 1][1]};
                t[j][q] = x * ALPHA + g * ff; s += (t[j][q][0] + t[j][q][1]) + (t[j][q][2] + t[j][q][3]); } }
        const float mean = wave_sum(s) * (1.0f / DM); float s2 = 0.f;
#pragma unroll
        for (int j = 0; j < 2; ++j)
#pragma unroll
            for (int q = 0; q < 4; ++q) { t[j][q] = t[j][q] - mean; s2 += (t[j][q][0] * t[j][q][0] + t[j][q][1] * t[j][q][1]) + (t[j][q][2] * t[j][q][2] + t[j][q][3] * t[j][q][3]); }
        const float rstd = rsqrtf(wave_sum(s2) * (1.0f / DM) + LN_EPS);
        float* dst = (L == 0) ? X2 + (size_t)r * DM : p.out + (size_t)(r - CTXL) * DM;
#pragma unroll
        for (int j = 0; j < 2; ++j)
#pragma unroll
            for (int q = 0; q < 4; ++q) { const int c = 16 * (ln + 64 * j) + 4 * q;
                *(f32x4*)(dst + c) = t[j][q] * rstd * *(const LAS f32x4*)(LG + c) + *(const LAS f32x4*)(LB + c); }
    }
}
constexpr int RLD = 264;
constexpr int SLD = 136;

template <bool SCALE>
__device__ __forceinline__ void stage_chunk(const bf16_t* QKV, int row0, int col0, LAS bf16_t* dst, int tid, float lg  , int dirb) {
#pragma unroll
    for (int q = 0; q < 8; ++q) { const int idx = tid + NTHR * q, r = idx >> 5, c = idx & 31;
        u32x4 w = *(const u32x4*)(QKV + (size_t)(row0 + r) * EV_IN + col0 + 8 * c);
        if (SCALE) { const float sc = fast_exp((dirb ? (float)r : (float)(127 - r)) * lg);
            w.x = cvt_pk_bf16(bflo(w.x) * sc, bfhi(w.x) * sc); w.y = cvt_pk_bf16(bflo(w.y) * sc, bfhi(w.y) * sc);
            w.z = cvt_pk_bf16(bflo(w.z) * sc, bfhi(w.z) * sc); w.w = cvt_pk_bf16(bflo(w.w) * sc, bfhi(w.w) * sc); }
        *(LAS u32x4*)(dst + r * RLD + 8 * c) = w; }
}

__device__ __forceinline__ void ret_chunk_kv(const Params& p, Ctx& C) {
    const bf16_t* QKV = (const bf16_t*)(p.ws + WS_BIG + BG_QKV); float* CKV = (float*)(p.ws + WS_BIG + BG_CKV);
    const float* rld = p.inp(10);
    LAS bf16_t* Vs = (LAS bf16_t*)C.lds; LAS bf16_t* Ks = Vs + 128 * RLD;
    const int lane = C.lane, w = C.wave;
    for (int unit = C.bid; unit < 130 * 8; unit += C.G) {
        const int u = unit >> 3, h = (unit >> 1) & 3, dir = unit & 1;
        const float lg = rld[dir * 4 + h];
        __syncthreads();
        stage_chunk<false>(QKV, 128 * u, 2048 + 256 * h, Vs, C.tid, 0.f, 0);
        stage_chunk<true>(QKV, 128 * u, 1024 + 256 * h, Ks, C.tid, lg, dir);
        __syncthreads();
        f32x4 acc[2][16];
#pragma unroll
        for (int a = 0; a < 2; ++a)
#pragma unroll
            for (int b = 0; b < 16; ++b) acc[a][b] = (f32x4){0.f, 0.f, 0.f, 0.f};
        const unsigned vbase = (unsigned)(uintptr_t)Vs, kbase = (unsigned)(uintptr_t)Ks;
#pragma unroll 1
        for (int ks = 0; ks < 4; ++ks) {
            bf16x8 af[2];
#pragma unroll
            for (int a = 0; a < 2; ++a) af[a] = frag_colk_l(vbase + (unsigned)((32 * ks) * RLD + 32 * w + 16 * a) * 2u, RLD * 2, lane);
#pragma unroll
            for (int b = 0; b < 16; ++b) { const bf16x8 bf = frag_colk_l(kbase + (unsigned)((32 * ks) * RLD + 16 * b) * 2u, RLD * 2, lane);
                acc[0][b] = MFMA16(af[0], bf, acc[0][b]); acc[1][b] = MFMA16(af[1], bf, acc[1][b]); }
        }
        float* dst = CKV + ((size_t)((dir * 4 + h) * 130 + u)) * 65536;
#pragma unroll
        for (int a = 0; a < 2; ++a)
#pragma unroll
            for (int b = 0; b < 16; ++b)
#pragma unroll
                for (int j = 0; j < 4; ++j) dst[(size_t)(32 * w + 16 * a + 4 * (lane >> 4) + j) * 256 + 16 * b + (lane & 15)] = acc[a][b][j];
    }
    __syncthreads();
}

__device__ __forceinline__ int s5_row(int dir, int c, int s) { return dir == 0 ? 64 * c + s : (c < 4 ? 255 - (64 * c + s) : 16639 - 64 * (c - 4) - s); }

__device__ __forceinline__ void s5_end_states(const Params& p, Ctx& C) {
    const bf16_t* QKV = (const bf16_t*)(p.ws + WS_BIG + BG_QKV); const bf16_t* BBT = (const bf16_t*)(p.ws + WS_BBT); float* E = (float*)(p.ws + WS_S5E);
    const float* APOW = (const float*)(p.ws + WS_APOW);
    LAS f32x2* PL = (LAS f32x2*)C.lds;
    for (int bt = C.bid; bt < 256; bt += C.G) {
        int tid = C.tid; asm volatile("" : "+v"(tid));
        const int lane = tid & 63, r32 = lane & 31, hi = lane >> 5;
        const int dg = bt >> 1, dir = dg >> 6, g = dg & 63, c0 = 130 * (bt & 1);
        __syncthreads();
#pragma unroll
        for (int q = 0; q < 8; ++q) { const int idx = tid + NTHR * q, s = idx >> 6, pp = idx & 63;
            PL[idx] = (s == 63) ? (f32x2){1.0f, 0.0f} : *(const f32x2*)(APOW + ((size_t)dg * 64 + (62 - s)) * 128 + 2 * pp); }
        __syncthreads();
        bf16x8 bfr[4];
#pragma unroll
        for (int pt = 0; pt < 4; ++pt) bfr[pt] = *(const bf16x8*)(BBT + ((size_t)dg * 128 + 32 * pt + r32) * 16 + 8 * hi);
        for (int c = c0 + C.wave; c < c0 + 130; c += 8) {
            float er[2] = {0.f, 0.f}, ei[2] = {0.f, 0.f};
#pragma unroll
            for (int st = 0; st < 2; ++st) {
                const bf16x8 a = *(const bf16x8*)(QKV + (size_t)s5_row(dir, c, 32 * st + r32) * EV_IN + 4096 + 16 * g + 8 * hi);
                f32x16 d[4];
#pragma unroll
                for (int pt = 0; pt < 4; ++pt) d[pt] = __builtin_amdgcn_mfma_f32_32x32x16_bf16(a, bfr[pt], (f32x16){}, 0, 0, 0);
#pragma unroll
                for (int r = 0; r < 16; ++r) { const int s = 32 * st + (r & 3) + 8 * (r >> 2) + 4 * hi;
#pragma unroll
                    for (int pt = 0; pt < 2; ++pt) { const f32x2 pw = PL[s * 64 + 32 * pt + r32]; const float br = d[pt][r], bi = d[pt + 2][r];
                        er[pt] += pw.x * br - pw.y * bi; ei[pt] += pw.x * bi + pw.y * br; } }
            }
#pragma unroll
            for (int pt = 0; pt < 2; ++pt) {
                { auto rr = __builtin_amdgcn_permlane32_swap(__float_as_uint(er[pt]), __float_as_uint(er[pt]), false, false); er[pt] = __uint_as_float(rr[0]) + __uint_as_float(rr[1]); }
                { auto rr = __builtin_amdgcn_permlane32_swap(__float_as_uint(ei[pt]), __float_as_uint(ei[pt]), false, false); ei[pt] = __uint_as_float(rr[0]) + __uint_as_float(rr[1]); }
            }
            float* dst = E + ((size_t)dg * 260 + c) * 128;
            if (hi == 0) { dst[r32] = er[0]; dst[32 + r32] = er[1]; dst[64 + r32] = ei[0]; dst[96 + r32] = ei[1]; }
        }
    }
    __syncthreads();
}

__device__ __forceinline__ void phase_scans(const Params& p, Ctx& C) {
    const float* CKV = (const float*)(p.ws + WS_BIG + BG_CKV); bf16_t* SP = (bf16_t*)(p.ws + WS_BIG + BG_SPREV);
    const float* rld = p.inp(10);
    for (int q = C.bid * NTHR + C.tid; q < 8 * 16384; q += C.G * NTHR) {
        const int dh = q >> 14, el = (q & 16383) * 4, dir = dh >> 2, h = dh & 3;
        const float gch = fast_exp(128.0f * rld[dir * 4 + h]);
        const float* src = CKV + (size_t)dh * 130 * 65536 + el; bf16_t* dst = SP + (size_t)dh * 130 * 65536 + el;
        f32x4 s = {0.f, 0.f, 0.f, 0.f};
        for (int st0 = 0; st0 < 130; st0 += 10) {
            f32x4 kv[10];
#pragma unroll
            for (int k = 0; k < 10; ++k) { const int st = st0 + k; const int u = dir == 0 ? st : (st == 0 ? 1 : (st == 1 ? 0 : 131 - st)); kv[k] = *(const f32x4*)(src + (size_t)u * 65536); }
#pragma unroll
            for (int k = 0; k < 10; ++k) { const int st = st0 + k; const int u = dir == 0 ? st : (st == 0 ? 1 : (st == 1 ? 0 : 131 - st));
                u32x2 w; w.x = cvt_pk_bf16(s[0], s[1]); w.y = cvt_pk_bf16(s[2], s[3]); *(u32x2*)(dst + (size_t)u * 65536) = w;
                s = s * gch + kv[k]; }
        }
    }
    const float* E = (const float*)(p.ws + WS_S5E); float* HST = (float*)(p.ws + WS_HST); const float* AL = (const float*)(p.ws + WS_AL);
    for (int q = C.bid * NTHR + C.tid; q < 2 * 64 * 64; q += C.G * NTHR) {
        const int dg = q >> 6, pp = q & 63;
        const f32x2 al = *(const f32x2*)(AL + (size_t)dg * 128 + 2 * pp);
        const float* e = E + (size_t)dg * 260 * 128; float* hs = HST + (size_t)dg * 260 * 128;
        float hr = 0.f, hi = 0.f;
        for (int c0 = 0; c0 < 260; c0 += 10) {
            float er[10], ei[10];
#pragma unroll
            for (int k = 0; k < 10; ++k) { er[k] = e[(size_t)(c0 + k) * 128 + pp]; ei[k] = e[(size_t)(c0 + k) * 128 + 64 + pp]; }
#pragma unroll
            for (int k = 0; k < 10; ++k) { *(f32x2*)(hs + (size_t)(c0 + k) * 128 + 2 * pp) = (f32x2){hr, hi};
                const float t = al.x * hr - al.y * hi + er[k]; hi = al.x * hi + al.y * hr + ei[k]; hr = t; }
        }
    }
}

__device__ __forceinline__ void ret_output_unit(const Params& p, Ctx& C, int unit) {
    const bf16_t* QKV = (const bf16_t*)(p.ws + WS_BIG + BG_QKV); const bf16_t* SP = (const bf16_t*)(p.ws + WS_BIG + BG_SPREV);
    bf16_t* MIX = (bf16_t*)(p.ws + WS_BIG + BG_MIX);
    const float* rld = p.inp(10);
    LAS bf16_t* RA = (LAS bf16_t*)C.lds; LAS bf16_t* RB = RA + 128 * RLD;
    int tid = C.tid; asm volatile("" : "+v"(tid));
    const int lane = tid & 63, w = C.wave, kq = lane >> 4, fr = lane & 15;
    const int u = unit >> 2, h = unit & 3;
    const float lgf = rld[h], lgb = rld[4 + h];
    stage_chunk<false>(QKV, 128 * u, 256 * h, RA, tid, 0.f, 0);
    int ib = 16 * w + 4 * kq, jb = fr; asm volatile("" : "+v"(ib), "+v"(jb));
    f32x4 acc[16];
#pragma unroll
    for (int t = 0; t < 16; ++t) acc[t] = (f32x4){0.f, 0.f, 0.f, 0.f};
#pragma unroll
    for (int dir = 0; dir < 2; ++dir) {
        const bf16_t* Sd = SP + ((size_t)((dir * 4 + h) * 130 + u)) * 65536;
#pragma unroll
        for (int eh = 0; eh < 2; ++eh) {
            __syncthreads();
#pragma unroll
            for (int q = 0; q < 8; ++q) { const int idx = tid + NTHR * q, rr = idx >> 5, c = idx & 31;
                *(LAS u32x4*)(RB + rr * RLD + 8 * c) = *(const u32x4*)(Sd + (size_t)(128 * eh + rr) * 256 + 8 * c);
                if (q == 3) asm volatile("" ::: "memory"); }
            __syncthreads();
#pragma unroll 1
            for (int ks = 0; ks < 8; ++ks) { const bf16x8 af = frag_rowk_l(RA + (16 * w) * RLD + 32 * ks, RLD, lane);
#pragma unroll
                for (int t = 0; t < 8; ++t) { const bf16x8 bf = frag_rowk_l(RB + (16 * t) * RLD + 32 * ks, RLD, lane); acc[8 * eh + t] = MFMA16(af, bf, acc[8 * eh + t]); } }
        }
#pragma unroll
        for (int r = 0; r < 4; ++r) { const int i = ib + r; const float qd = fast_exp((float)(128 - i) * lgb);
            const float f = (dir == 0) ? fast_exp((float)(i + 1) * lgf) / qd : qd;
#pragma unroll
            for (int t = 0; t < 16; ++t) acc[t][r] *= f; }
    }
    __syncthreads();
    stage_chunk<false>(QKV, 128 * u, 1024 + 256 * h, RB, tid, 0.f, 0);
    __syncthreads();
    f32x4 sc[8];
#pragma unroll
    for (int t = 0; t < 8; ++t) sc[t] = (f32x4){0.f, 0.f, 0.f, 0.f};
#pragma unroll 1
    for (int ks = 0; ks < 8; ++ks) { const bf16x8 af = frag_rowk_l(RA + (16 * w) * RLD + 32 * ks, RLD, lane);
#pragma unroll
        for (int t = 0; t < 8; ++t) { const bf16x8 bf = frag_rowk_l(RB + (16 * t) * RLD + 32 * ks, RLD, lane); sc[t] = MFMA16(af, bf, sc[t]); } }
#pragma unroll
    for (int t = 0; t < 8; ++t)
#pragma unroll
        for (int r = 0; r < 4; ++r) { const int i = ib + r, j = 16 * t + jb; const float d = (float)(i - j);
            const float m = (i >= j ? fast_exp(d * lgf) : 0.f) + (j >= i ? fast_exp(-d * lgb) : 0.f); sc[t][r] *= m; }
    __syncthreads();
    stage_chunk<false>(QKV, 128 * u, 2048 + 256 * h, RA, tid, 0.f, 0);
#pragma unroll
    for (int t = 0; t < 8; ++t)
#pragma unroll
        for (int r = 0; r < 4; ++r) RB[(16 * w + 4 * kq + r) * SLD + 16 * t + fr] = f2bf(sc[t][r]);
    __syncthreads();
    const unsigned vbase = (unsigned)(uintptr_t)RA;
#pragma unroll 1
    for (int ks = 0; ks < 4; ++ks) { const bf16x8 af = frag_rowk_l(RB + (16 * w) * SLD + 32 * ks, SLD, lane);
#pragma unroll
        for (int t = 0; t < 16; ++t) { const bf16x8 bf = frag_colk_l(vbase + (unsigned)((32 * ks) * RLD + 16 * t) * 2u, RLD * 2, lane); acc[t] = MFMA16(af, bf, acc[t]); } }
    __syncthreads();
#pragma unroll
    for (int r = 0; r < 4; ++r) {
        float s = 0.f;
#pragma unroll
        for (int t = 0; t < 16; ++t) s += acc[t][r];
        s += __shfl_xor(s, 1); s += __shfl_xor(s, 2); s += __shfl_xor(s, 4); s += __shfl_xor(s, 8);
        const float mean = s * (1.0f / 256.0f); float q = 0.f;
#pragma unroll
        for (int t = 0; t < 16; ++t) { const float d = acc[t][r] - mean; q += d * d; }
        q += __shfl_xor(q, 1); q += __shfl_xor(q, 2); q += __shfl_xor(q, 4); q += __shfl_xor(q, 8);
        const float rstd = rsqrtf(q * (1.0f / 256.0f) + LN_EPS);
#pragma unroll
        for (int t = 0; t < 16; ++t) RA[(16 * w + 4 * kq + r) * RLD + 16 * t + fr] = f2bf((acc[t][r] - mean) * rstd);
    }
    __syncthreads();
#pragma unroll
    for (int q = 0; q < 8; ++q) { const int idx = tid + NTHR * q, rr = idx >> 5, c = idx & 31; const size_t row = (size_t)(128 * u + rr);
        const u32x4 o = *(const LAS u32x4*)(RA + rr * RLD + 8 * c), g = *(const u32x4*)(QKV + row * EV_IN + 3072 + 256 * h + 8 * c);
        u32x4 w4;
        w4.x = cvt_pk_bf16(bflo(o.x) * siluf_(bflo(g.x)), bfhi(o.x) * siluf_(bfhi(g.x))); w4.y = cvt_pk_bf16(bflo(o.y) * siluf_(bflo(g.y)), bfhi(o.y) * siluf_(bfhi(g.y)));
        w4.z = cvt_pk_bf16(bflo(o.z) * siluf_(bflo(g.z)), bfhi(o.z) * siluf_(bfhi(g.z))); w4.w = cvt_pk_bf16(bflo(o.w) * siluf_(bflo(g.w)), bfhi(o.w) * siluf_(bfhi(g.w)));
        *(u32x4*)(MIX + row * DM + 256 * h + 8 * c) = w4; }
    __syncthreads();
}

constexpr int KLD = 1032;
__device__ __forceinline__ void s5_output_task(const Params& p, Ctx& C, int bt) {
    const bf16_t* QKV = (const bf16_t*)(p.ws + WS_BIG + BG_QKV); bf16_t* Z = (bf16_t*)(p.ws + WS_Z);
    const bf16_t* KN = (const bf16_t*)(p.ws + WS_KN); const bf16_t* CCt = (const bf16_t*)(p.ws + WS_CC);
    const float* APOW = (const float*)(p.ws + WS_APOW); const float* HST = (const float*)(p.ws + WS_HST); const float* dsk = p.inp(18);
    int tid = C.tid; asm volatile("" : "+v"(tid));
    const int lane = tid & 63, kq = lane >> 4, fr = lane & 15;
    LAS bf16_t* KF = (LAS bf16_t*)C.lds; LAS bf16_t* KB = KF + 16 * KLD;
    LAS bf16_t* U = KB + 16 * KLD + C.wave * 3072;
    LAS float* PW0 = (LAS float*)(KB + 16 * KLD + 8 * 3072);
    LAS float* PW16 = PW0 + 2 * 16 * 128;
    {
        const int g = bt >> 3, k0 = (260 * (bt & 7)) >> 3, k1 = (260 * ((bt & 7) + 1)) >> 3;
#pragma unroll
        for (int q = 0; q < 8; ++q) { const int idx = tid + NTHR * q, dir = idx >> 11, rr = (idx >> 7) & 15, c = idx & 127;
            *(LAS u32x4*)((dir ? KB : KF) + rr * KLD + 8 * c) = *(const u32x4*)(KN + ((size_t)(dir * 64 + g) * 16 + rr) * 1024 + 8 * c); }
        for (int q = lane; q < 192 * 2; q += 64) *(LAS u32x4*)(U + 8 * q) = (u32x4){0u, 0u, 0u, 0u};
#pragma unroll
        for (int q = 0; q < 2; ++q) { const int idx = tid + NTHR * q, dir = idx >> 9, f = (idx >> 5) & 15, c4 = idx & 31;
            *(LAS f32x4*)(PW0 + dir * 2048 + f * 128 + 4 * c4) = *(const f32x4*)(APOW + ((size_t)(dir * 64 + g) * 64 + (dir == 0 ? f : 15 - f)) * 128 + 4 * c4); }
        if (tid < 64) { const int dir = tid >> 5, c4 = tid & 31; *(LAS f32x4*)(PW16 + dir * 128 + 4 * c4) = *(const f32x4*)(APOW + ((size_t)(dir * 64 + g) * 64 + 15) * 128 + 4 * c4); }
        __syncthreads();
        const f32x4 dv = *(const f32x4*)(dsk + 16 * g + 4 * kq);
        bf16x8 ccr[2], cci[2];
#pragma unroll
        for (int hb = 0; hb < 2; ++hb) { ccr[hb] = frag_rowk_g(CCt + (size_t)g * 16 * 128 + 32 * hb, 128, lane); cci[hb] = frag_rowk_g(CCt + (size_t)g * 16 * 128 + 64 + 32 * hb, 128, lane); }
        const LAS float* pw0l = PW0 + (size_t)fr * 128 + 16 * kq;
        const LAS float* pw16l = PW16 + 16 * kq;
        for (int k = k0 + C.wave; k < k1; k += 8) {
            LDS_WAIT(); asm volatile("" ::: "memory");
            for (int q = lane; q < 128; q += 64) { const int t = q >> 1, hf = q & 1;
                *(LAS u32x4*)(U + (64 + t) * 16 + 8 * hf) = *(const u32x4*)(QKV + (size_t)(64 * k + t) * EV_IN + 4096 + 16 * g + 8 * hf); }
            LDS_WAIT(); asm volatile("" ::: "memory");
            const int cf = k, cb = k < 4 ? 3 - k : 263 - k;
            f32x4 acc[4];
#pragma unroll
            for (int tt = 0; tt < 4; ++tt) acc[tt] = (f32x4){0.f, 0.f, 0.f, 0.f};
            const LAS bf16_t* ubf = U + (64 + fr - (kq >> 1)) * 16 + 8 * (kq & 1);
            const LAS bf16_t* ubb = U + (64 + fr + (kq >> 1)) * 16 + 8 * (kq & 1);
#pragma unroll
            for (int n0 = 0; n0 < 64; n0 += 2) {
                const bf16x8 af = frag_rowk_l(KF + n0 * 16, KLD, lane), ab = frag_rowk_l(KB + n0 * 16, KLD, lane);
#pragma unroll
                for (int tt = 0; tt < 4; ++tt) {
                    if (n0 <= 16 * tt + 14) acc[tt] = MFMA16(af, *(const LAS bf16x8*)(ubf + (16 * tt - n0) * 16), acc[tt]);
                    if (n0 <= 62 - 16 * tt) acc[tt] = MFMA16(ab, *(const LAS bf16x8*)(ubb + (16 * tt + n0) * 16), acc[tt]);
                }
                asm volatile("" ::: "memory");
            }
#pragma unroll
            for (int dir = 0; dir < 2; ++dir) {
                const float* hp = HST + ((size_t)(dir * 64 + g) * 260 + (dir == 0 ? cf : cb)) * 128;
#pragma unroll
                for (int hb = 0; hb < 2; ++hb) {
                    float xr[8], xi[8];
#pragma unroll
                    for (int e2 = 0; e2 < 4; ++e2) { const f32x4 h4 = *(const f32x4*)(hp + 2 * (32 * hb + 8 * kq) + 4 * e2), b4 = *(const LAS f32x4*)(pw0l + dir * 2048 + hb * 64 + 4 * e2);
                        xr[2 * e2] = b4[0] * h4[0] - b4[1] * h4[1]; xi[2 * e2] = b4[0] * h4[1] + b4[1] * h4[0];
                        xr[2 * e2 + 1] = b4[2] * h4[2] - b4[3] * h4[3]; xi[2 * e2 + 1] = b4[2] * h4[3] + b4[3] * h4[2]; }
#pragma unroll
                    for (int st = 0; st < 4; ++st) {
                        const int tt = dir == 0 ? st : 3 - st;
                        u32x4 br, bi;
                        br.x = cvt_pk_bf16(xr[0], xr[1]); br.y = cvt_pk_bf16(xr[2], xr[3]); br.z = cvt_pk_bf16(xr[4], xr[5]); br.w = cvt_pk_bf16(xr[6], xr[7]);
                        bi.x = cvt_pk_bf16(xi[0], xi[1]); bi.y = cvt_pk_bf16(xi[2], xi[3]); bi.z = cvt_pk_bf16(xi[4], xi[5]); bi.w = cvt_pk_bf16(xi[6], xi[7]);
                        acc[tt] = MFMA16(ccr[hb], __builtin_bit_cast(bf16x8, br), acc[tt]);
                        acc[tt] = MFMA16(cci[hb], __builtin_bit_cast(bf16x8, bi), acc[tt]);
                        if (st < 3) {
#pragma unroll
                            for (int e2 = 0; e2 < 4; ++e2) { const f32x4 a4 = *(const LAS f32x4*)(pw16l + dir * 128 + hb * 64 + 4 * e2);
                                float t0 = xr[2 * e2] * a4[0] - xi[2 * e2] * a4[1]; xi[2 * e2] = xr[2 * e2] * a4[1] + xi[2 * e2] * a4[0]; xr[2 * e2] = t0;
                                t0 = xr[2 * e2 + 1] * a4[2] - xi[2 * e2 + 1] * a4[3]; xi[2 * e2 + 1] = xr[2 * e2 + 1] * a4[3] + xi[2 * e2 + 1] * a4[2]; xr[2 * e2 + 1] = t0; }
                        }
                    }
                }
            }
#pragma unroll
            for (int tt = 0; tt < 4; ++tt) { const int t = 16 * tt + fr;
                const u32x2 uu = *(const LAS u32x2*)(U + (64 + t) * 16 + 4 * kq);
                const float y0 = acc[tt][0] + bflo(uu.x) * dv[0], y1 = acc[tt][1] + bfhi(uu.x) * dv[1], y2 = acc[tt][2] + bflo(uu.y) * dv[2], y3 = acc[tt][3] + bfhi(uu.y) * dv[3];
                u32x2 w; w.x = cvt_pk_bf16(gelu_tanh(y0), gelu_tanh(y1)); w.y = cvt_pk_bf16(gelu_tanh(y2), gelu_tanh(y3));
                *(u32x2*)(Z + (size_t)(64 * k + t) * 1024 + 16 * g + 4 * kq) = w; }
        }
    }
    __syncthreads();
}

__device__ __forceinline__ void phase_ret_s5_outputs(const Params& p, Ctx& C, LAS unsigned char* misc) {
    unsigned* head = (unsigned*)(p.ws + WS_CTL) + CW_QUEUE;
    volatile LAS int* slot = (volatile LAS int*)(misc + 32);
    for (;;) {
        __syncthreads();
        if (C.tid == 0) slot[0] = (int)atomicAdd(head, 1u);
        __syncthreads();
        const int item = __builtin_amdgcn_readfirstlane(slot[0]);
        if (item >= 520) break;
        ret_output_unit(p, C, item);
    }
    for (;;) {
        __syncthreads();
        if (C.tid == 0) slot[0] = (int)atomicAdd(head + 64, 1u);
        __syncthreads();
        const int item = __builtin_amdgcn_readfirstlane(slot[0]);
        if (item >= 512) break;
        s5_output_task(p, C, item);
    }
}
__device__ __forceinline__ void phase_router(const Params& p, Ctx& C, int L) {
    const float* X1 = (const float*)(p.ws + WS_X1);
    const bf16_t* RWh = (const bf16_t*)(p.ws + WS_RWT) + (size_t)(L * 2 + 0) * 64 * DM; const bf16_t* RWl = (const bf16_t*)(p.ws + WS_RWT) + (size_t)(L * 2 + 1) * 64 * DM;
    const float* rbias = p.inp(27) + L * 64;
    int* cnt = (int*)(p.ws + WS_CTL) + CW_CNT + L * 128; int* LIST = (int*)(p.ws + WS_LIST); unsigned* PK = (unsigned*)(p.ws + WS_WGT); float* LW = (float*)(p.ws + WS_LW);
    const int lane = C.lane, kq = lane >> 4, fr = lane & 15;
    LAS float* Lg = (LAS float*)(C.lds + C.wave * 8192);
    const int r0 = (L == 0) ? 0 : CTXL, nrows = TT - r0;
    if (C.bid == 0 && C.tid == 0) cnt[64] = nrows;
    for (int task = C.gw; task < nrows / 16; task += C.ngw) {
        const int rbase = r0 + 16 * task, row = rbase + fr;
        const int v = row < CTXL ? 1 : 0;
        const float* xr = X1 + (size_t)row * DM; const float* sc2 = modv(p, L, v, 4); const float* sh2 = modv(p, L, v, 3);
        f32x4 acc[4];
#pragma unroll
        for (int t = 0; t < 4; ++t) acc[t] = (f32x4){0.f, 0.f, 0.f, 0.f};
#pragma unroll 2
        for (int ks = 0; ks < 64; ++ks) { const int c0 = 32 * ks + 8 * kq;
            const f32x4 x0 = *(const f32x4*)(xr + c0), x1 = *(const f32x4*)(xr + c0 + 4);
            const f32x4 a0 = *(const f32x4*)(sc2 + c0), a1 = *(const f32x4*)(sc2 + c0 + 4), b0 = *(const f32x4*)(sh2 + c0), b1 = *(const f32x4*)(sh2 + c0 + 4);
            const f32x4 y0 = x0 * (a0 + 1.0f) + b0, y1 = x1 * (a1 + 1.0f) + b1;
            u32x4 hi; hi.x = cvt_pk_bf16(y0[0], y0[1]); hi.y = cvt_pk_bf16(y0[2], y0[3]); hi.z = cvt_pk_bf16(y1[0], y1[1]); hi.w = cvt_pk_bf16(y1[2], y1[3]);
            u32x4 lo; lo.x = cvt_pk_bf16(y0[0] - bflo(hi.x), y0[1] - bfhi(hi.x)); lo.y = cvt_pk_bf16(y0[2] - bflo(hi.y), y0[3] - bfhi(hi.y));
            lo.z = cvt_pk_bf16(y1[0] - bflo(hi.z), y1[1] - bfhi(hi.z)); lo.w = cvt_pk_bf16(y1[2] - bflo(hi.w), y1[3] - bfhi(hi.w));
            const bf16x8 ah = __builtin_bit_cast(bf16x8, hi), al = __builtin_bit_cast(bf16x8, lo);
#pragma unroll
            for (int t = 0; t < 4; ++t) { const bf16x8 bh = frag_rowk_g(RWh + (size_t)(16 * t) * DM + 32 * ks, DM, lane), bl = frag_rowk_g(RWl + (size_t)(16 * t) * DM + 32 * ks, DM, lane);
                acc[t] = MFMA16(ah, bh, acc[t]); acc[t] = MFMA16(al, bh, acc[t]); acc[t] = MFMA16(ah, bl, acc[t]); } }
        LDS_WAIT(); asm volatile("" ::: "memory");
#pragma unroll
        for (int t = 0; t < 4; ++t)
#pragma unroll
            for (int r = 0; r < 4; ++r) Lg[(4 * kq + r) * 65 + 16 * t + fr] = acc[t][r];
        LDS_WAIT(); asm volatile("" ::: "memory");
        if (lane < 16) {
            LAS float* sr = Lg + lane * 65; const int trow = rbase + lane;
            float gs[8];
#pragma unroll
            for (int g = 0; g < 8; ++g) { float m1 = -1e30f, m2 = -1e30f;
                for (int j = 0; j < 8; ++j) { const int e = 8 * g + j; const float s = sigmoidf_(sr[e]); sr[e] = s; const float vv = s + rbias[e];
                    if (vv > m1) { m2 = m1; m1 = vv; } else if (vv > m2) m2 = vv; }
                gs[g] = m1 + m2; }
            unsigned gmask = 0u;
#pragma unroll
            for (int it = 0; it < 4; ++it) { float best = -1e30f; int bi = 0;
#pragma unroll
                for (int g = 0; g < 8; ++g) { const bool ok = !((gmask >> g) & 1u) && gs[g] > best; best = ok ? gs[g] : best; bi = ok ? g : bi; }
                gmask |= 1u << bi; }
            unsigned long long taken = 0ull; int sel[8]; float sw[8]; float wsum = 0.f;
#pragma unroll
            for (int k = 0; k < 8; ++k) { float best = -1e30f; int bi = 0;
                for (int e = 0; e < 64; ++e) { const bool cand = ((gmask >> (e >> 3)) & 1u) && !((taken >> e) & 1ull); const float vv = sr[e] + rbias[e];
                    if (cand && vv > best) { best = vv; bi = e; } }
                taken |= 1ull << bi; sel[k] = bi; sw[k] = sr[bi]; wsum += sw[k]; }
            const float inv = 2.5f / wsum;
#pragma unroll
            for (int k = 0; k < 8; ++k) { const int a = trow * 8 + k; const int pos = atomicAdd(&cnt[sel[k]], 1);
                LIST[(size_t)sel[k] * TT + pos] = a; PK[a] = ((unsigned)sel[k] << 16) | (unsigned)pos; LW[(size_t)sel[k] * TT + pos] = sw[k] * inv; }
            LIST[(size_t)64 * TT + (trow - r0)] = 8 * TT + trow; LW[(size_t)64 * TT + (trow - r0)] = 1.0f;
        }
    }
}
namespace att {
constexpr int D = 128, NW = 8, QBLK = 32, KVBLK = 64;
constexpr float SCALE = 0.088388347648318440f;
constexpr float THR = 8.f;
constexpr int SHM_V = KVBLK * D * 2, SHM_K = KVBLK * D * 2, SHM_ATTN = 2 * SHM_V + 2 * SHM_K + NW * 64 * 4;
#define KSWZ(row, colB) ((row) * 256 + ((colB) ^ (((row) & 7) << 4)))
#define SBAR() __builtin_amdgcn_sched_barrier(0)
__device__ __forceinline__ int crow(int r, int hi) { return (r & 3) + 8 * (r >> 2) + 4 * hi; }
__device__ __forceinline__ unsigned cvtpk(float lo, float hi) { unsigned r; asm volatile("v_cvt_pk_bf16_f32 %0, %1, %2" : "=v"(r) : "v"(lo), "v"(hi)); return r; }

__device__ __forceinline__ void partialSM(f32x16& p0, f32x16& p1, float negMC) {
  constexpr float Cc = SCALE * 1.4426950408889634f;
  for (int r = 0; r < 16; ++r) p0[r] = fmaf(p0[r], Cc, negMC); for (int r = 0; r < 16; ++r) p1[r] = fmaf(p1[r], Cc, negMC);
  for (int r = 0; r < 16; ++r) p0[r] = __builtin_amdgcn_exp2f(p0[r]);
}
__device__ __forceinline__ void finishSM(f32x16& p0, f32x16& p1, float& l_reg, bf16x8& pa0, bf16x8& pa1, bf16x8& pa2, bf16x8& pa3) {
  for (int r = 0; r < 16; ++r) p1[r] = __builtin_amdgcn_exp2f(p1[r]);
  float ps = 0; for (int r = 0; r < 16; ++r) ps += p0[r]; for (int r = 0; r < 16; ++r) ps += p1[r];
  { auto rr = __builtin_amdgcn_permlane32_swap(__float_as_uint(ps), __float_as_uint(ps), false, false);
    ps = __uint_as_float(rr[0]) + __uint_as_float(rr[1]); }
  l_reg += ps;
#define PK4(P, BASE, OUT) do { unsigned a0 = cvtpk(P[BASE + 0], P[BASE + 1]), a1 = cvtpk(P[BASE + 2], P[BASE + 3]);   \
    unsigned b0 = cvtpk(P[BASE + 4], P[BASE + 5]), b1 = cvtpk(P[BASE + 6], P[BASE + 7]);                              \
    auto r0 = __builtin_amdgcn_permlane32_swap(a0, b0, false, false); auto r1 = __builtin_amdgcn_permlane32_swap(a1, b1, false, false); \
    u32x4 w = {r0[0], r1[0], r0[1], r1[1]}; OUT = *reinterpret_cast<bf16x8*>(&w); } while (0)
  PK4(p0, 0, pa0); PK4(p0, 8, pa1); PK4(p1, 0, pa2); PK4(p1, 8, pa3);
#undef PK4
}
__device__ __forceinline__ void qkt(f32x16& p0, f32x16& p1, const LAS char* Ks, const bf16x8* qr, int r32, int hi) {
  p0 = f32x16{}; p1 = f32x16{};
  for (int d0 = 0; d0 < 8; ++d0) { int cb = (d0 * 16 + hi * 8) * 2;
    bf16x8 b0 = *reinterpret_cast<const LAS bf16x8*>(Ks + KSWZ(r32, cb));
    bf16x8 b1 = *reinterpret_cast<const LAS bf16x8*>(Ks + KSWZ(32 + r32, cb));
    p0 = __builtin_amdgcn_mfma_f32_32x32x16_bf16(b0, qr[d0], p0, 0, 0, 0);
    p1 = __builtin_amdgcn_mfma_f32_32x32x16_bf16(b1, qr[d0], p1, 0, 0, 0); }
}
__device__ __forceinline__ int v_st(int k, int c) { const int kk = (k & ~0xC) | ((k & 4) << 1) | ((k & 8) >> 1); return ((kk >> 3) * 4 + (c >> 5)) * 512 + ((kk & 7) * 32 + (c & 31)) * 2; }
__device__ __forceinline__ int v_rd_base(int lane) { return ((lane & 3) << 3) | (((lane >> 2) & 3) << 6) | (((lane >> 4) & 1) << 5) | (((lane >> 5) & 1) << 8); }
constexpr int v_rd_off(int d0, int ks, int half) { return d0 * 512 + ks * 4096 + half * 2048; }
template <int OFF> __device__ __forceinline__ s16x4 tr_read(int vb) {
  s16x4 r; asm volatile("ds_read_b64_tr_b16 %0, %1 offset:%2" : "=&v"(r) : "v"(vb), "i"(OFF) : "memory"); return r;
}
template <int D0> __device__ __forceinline__ void pv_one(f32x16& od, int vb, bf16x8 pa0, bf16x8 pa1, bf16x8 pa2, bf16x8 pa3) {
  const s16x4 l0 = tr_read<v_rd_off(D0, 0, 0)>(vb), h0 = tr_read<v_rd_off(D0, 0, 1)>(vb), l1 = tr_read<v_rd_off(D0, 1, 0)>(vb), h1 = tr_read<v_rd_off(D0, 1, 1)>(vb);
  const s16x4 l2 = tr_read<v_rd_off(D0, 2, 0)>(vb), h2 = tr_read<v_rd_off(D0, 2, 1)>(vb), l3 = tr_read<v_rd_off(D0, 3, 0)>(vb), h3 = tr_read<v_rd_off(D0, 3, 1)>(vb);
  asm volatile("s_waitcnt lgkmcnt(0)" ::: "memory"); SBAR();
#define PK(L, H) (bf16x8){L[0], L[1], L[2], L[3], H[0], H[1], H[2], H[3]}
  od = __builtin_amdgcn_mfma_f32_32x32x16_bf16(pa0, PK(l0, h0), od, 0, 0, 0);
  od = __builtin_amdgcn_mfma_f32_32x32x16_bf16(pa1, PK(l1, h1), od, 0, 0, 0);
  od = __builtin_amdgcn_mfma_f32_32x32x16_bf16(pa2, PK(l2, h2), od, 0, 0, 0);
  od = __builtin_amdgcn_mfma_f32_32x32x16_bf16(pa3, PK(l3, h3), od, 0, 0, 0);
#undef PK
}
__device__ __forceinline__ void pv_d0(f32x16* o, int vb, bf16x8 pa0, bf16x8 pa1, bf16x8 pa2, bf16x8 pa3) {
  pv_one<0>(o[0], vb, pa0, pa1, pa2, pa3); pv_one<1>(o[1], vb, pa0, pa1, pa2, pa3); pv_one<2>(o[2], vb, pa0, pa1, pa2, pa3); pv_one<3>(o[3], vb, pa0, pa1, pa2, pa3);
}

template <int LDQ, int LDK, int LDO>
__device__ __forceinline__ void attn_dense_body(const bf16_t* __restrict__ Qb, const bf16_t* __restrict__ Kh, const bf16_t* __restrict__ Vh, bf16_t* __restrict__ Ob, int seq, LAS char* lds, int tid, float kmax2) {
  const int wid = tid >> 6, lane = tid & 63, r32 = lane & 31, hi = lane >> 5;
  LAS char* V_lds = lds; LAS char* K_lds = lds + 2 * SHM_V;
  LAS float* ws = (LAS float*)(lds + 2 * SHM_V + 2 * SHM_K) + wid * 64; LAS float* li_l = ws;
  float l_reg = 0; f32x16 o[4] = {}; bf16x8 qr[8];
  const bf16_t* Qw = Qb + (long)(wid * QBLK + r32) * LDQ + hi * 8;
#pragma unroll
  for (int d0 = 0; d0 < 8; ++d0) qr[d0] = *reinterpret_cast<const bf16x8*>(Qw + d0 * 16);
  float negMC;
  { float q2 = 0.f;
#pragma unroll
    for (int d0 = 0; d0 < 8; ++d0) { const u32x4 w = __builtin_bit_cast(u32x4, qr[d0]);
      q2 += bflo(w.x) * bflo(w.x) + bfhi(w.x) * bfhi(w.x) + bflo(w.y) * bflo(w.y) + bfhi(w.y) * bfhi(w.y) + bflo(w.z) * bflo(w.z) + bfhi(w.z) * bfhi(w.z) + bflo(w.w) * bflo(w.w) + bfhi(w.w) * bfhi(w.w); }
    auto rr = __builtin_amdgcn_permlane32_swap(__float_as_uint(q2), __float_as_uint(q2), false, false);
    q2 = __uint_as_float(rr[0]) + __uint_as_float(rr[1]);
    negMC = -(sqrtf(q2 * kmax2) * (SCALE * 1.0001f) - 30.0f) * 1.4426950408889634f; }
  const int sr = tid >> 4, sc = (tid & 15) * 8, vst0 = v_st(sr, sc), vst1 = v_st(32 + sr, sc);
  const int vb0 = (int)(uintptr_t)V_lds + v_rd_base(lane);
  struct { bf16x8 vs0, vs1, ks0, ks1; } sr_[2];
#define SLOAD(i, k0) do { sr_[i].vs0 = *reinterpret_cast<const bf16x8*>(&Vh[(long)((k0) + sr) * LDK + sc]); sr_[i].vs1 = *reinterpret_cast<const bf16x8*>(&Vh[(long)((k0) + 32 + sr) * LDK + sc]); \
    sr_[i].ks0 = *reinterpret_cast<const bf16x8*>(&Kh[(long)((k0) + sr) * LDK + sc]); sr_[i].ks1 = *reinterpret_cast<const bf16x8*>(&Kh[(long)((k0) + 32 + sr) * LDK + sc]); } while (0)
#define SWRITE(b, i) do { *(LAS bf16x8*)(V_lds + (b) * SHM_V + vst0) = sr_[i].vs0;          \
    *(LAS bf16x8*)(V_lds + (b) * SHM_V + vst1) = sr_[i].vs1; int kc = sc * 2;               \
    *(LAS bf16x8*)(K_lds + (b) * SHM_K + KSWZ(sr, kc)) = sr_[i].ks0;                       \
    *(LAS bf16x8*)(K_lds + (b) * SHM_K + KSWZ(32 + sr, kc)) = sr_[i].ks1; } while (0)
#define SWAIT() asm volatile("s_waitcnt vmcnt(4)" ::: "memory")
  f32x16 pA0, pA1, pB0, pB1; bf16x8 pa0, pa1, pa2, pa3; const int NT = seq / KVBLK;
  constexpr int SE = 0, SO = 1;
  SLOAD(SE, 0); asm volatile("s_waitcnt vmcnt(0)" ::: "memory"); SWRITE(0, SE); __syncthreads();
  qkt(pA0, pA1, K_lds, qr, r32, hi); partialSM(pA0, pA1, negMC);
  SLOAD(SO, KVBLK); if (2 < NT) SLOAD(SE, 2 * KVBLK);
  SWAIT(); SWRITE(1, SO); __syncthreads();
  for (int j = 1; j + 1 < NT; j += 2) {
    SBAR(); qkt(pB0, pB1, K_lds + SHM_K, qr, r32, hi);
    finishSM(pA0, pA1, l_reg, pa0, pa1, pa2, pa3); SBAR();
    SLOAD(SO, (j + 2) * KVBLK); SBAR();
    pv_d0(o, vb0, pa0, pa1, pa2, pa3); partialSM(pB0, pB1, negMC);
    __syncthreads(); SWAIT(); SWRITE(0, SE);
    __syncthreads();
    SBAR(); qkt(pA0, pA1, K_lds, qr, r32, hi);
    finishSM(pB0, pB1, l_reg, pa0, pa1, pa2, pa3); SBAR();
    if (j + 3 < NT) SLOAD(SE, (j + 3) * KVBLK); SBAR();
    pv_d0(o, vb0 + (int)SHM_V, pa0, pa1, pa2, pa3); partialSM(pA0, pA1, negMC);
    __syncthreads(); SWAIT(); SWRITE(1, SO);
    __syncthreads();
  }
  SBAR(); qkt(pB0, pB1, K_lds + SHM_K, qr, r32, hi);
  finishSM(pA0, pA1, l_reg, pa0, pa1, pa2, pa3); SBAR();
  pv_d0(o, vb0, pa0, pa1, pa2, pa3); partialSM(pB0, pB1, negMC);
  __syncthreads();
  finishSM(pB0, pB1, l_reg, pa0, pa1, pa2, pa3); SBAR();
  pv_d0(o, vb0 + (int)SHM_V, pa0, pa1, pa2, pa3);
  if (hi == 0) li_l[r32] = l_reg; asm volatile("s_waitcnt lgkmcnt(0)" ::: "memory");
  float rli[16];
#pragma unroll
  for (int r = 0; r < 16; ++r) rli[r] = __builtin_amdgcn_rcpf(li_l[crow(r, hi)]);
  bf16_t* Ow = Ob + (long)(wid * QBLK) * LDO;
#pragma unroll
  for (int r = 0; r < 16; ++r) { int orow = crow(r, hi);
    for (int d0 = 0; d0 < 4; ++d0) Ow[(long)orow * LDO + d0 * 32 + r32] = (bf16_t)(cvtpk(o[d0][r] * rli[r], 0.f) & 0xffffu); }
#undef SLOAD
#undef SWRITE
#undef SWAIT
}

constexpr int PV_BUF = 32768, PK_BUF = 16384, P_LDS_V = 0, P_LDS_K = 2 * PV_BUF, P_LDS_X = P_LDS_K + 2 * PK_BUF, P_LDS_L = P_LDS_X + 8 * 2048, P_LDS_END = P_LDS_L + 1024;
__device__ __forceinline__ void qkt_half(f32x16& p, const LAS char* Ks, const bf16x8* qr, int krow, int hi) {
  p = f32x16{};
  for (int d0 = 0; d0 < 8; ++d0) { int cb = (d0 * 16 + hi * 8) * 2;
    bf16x8 b0 = *reinterpret_cast<const LAS bf16x8*>(Ks + KSWZ(krow, cb));
    p = __builtin_amdgcn_mfma_f32_32x32x16_bf16(b0, qr[d0], p, 0, 0, 0); }
}
__device__ __forceinline__ void smA(f32x16& p, float negMC) {
  constexpr float Cc = SCALE * 1.4426950408889634f;
  for (int r = 0; r < 16; ++r) p[r] = fmaf(p[r], Cc, negMC);
  for (int r = 0; r < 8; ++r) p[r] = __builtin_amdgcn_exp2f(p[r]);
}
__device__ __forceinline__ void smB(f32x16& p, float& l_reg, bf16x8& f0, bf16x8& f1) {
  for (int r = 8; r < 16; ++r) p[r] = __builtin_amdgcn_exp2f(p[r]);
  float ps = 0; for (int r = 0; r < 16; ++r) ps += p[r];
  { auto rr = __builtin_amdgcn_permlane32_swap(__float_as_uint(ps), __float_as_uint(ps), false, false);
    ps = __uint_as_float(rr[0]) + __uint_as_float(rr[1]); }
  l_reg += ps;
#define PK4(P, BASE, OUT) do { unsigned a0 = cvtpk(P[BASE + 0], P[BASE + 1]), a1 = cvtpk(P[BASE + 2], P[BASE + 3]);   \
    unsigned b0 = cvtpk(P[BASE + 4], P[BASE + 5]), b1 = cvtpk(P[BASE + 6], P[BASE + 7]);                              \
    auto r0 = __builtin_amdgcn_permlane32_swap(a0, b0, false, false); auto r1 = __builtin_amdgcn_permlane32_swap(a1, b1, false, false); \
    u32x4 w = {r0[0], r1[0], r0[1], r1[1]}; OUT = *reinterpret_cast<bf16x8*>(&w); } while (0)
  PK4(p, 0, f0); PK4(p, 8, f1);
#undef PK4
}
template <int LDQ, int LDK, int LDO>
__device__ __forceinline__ void attn_pair_body(const bf16_t* __restrict__ Qb, const bf16_t* __restrict__ Kh, const bf16_t* __restrict__ Vh, bf16_t* __restrict__ Ob, int seq, LAS char* lds, int tid, float kmax2) {
  const int wid = __builtin_amdgcn_readfirstlane(tid >> 6), lane = tid & 63, r32 = lane & 31, hi = lane >> 5, g = wid & 3, kb = wid >> 2;
  LAS char* V_lds = lds + P_LDS_V; LAS char* K_lds = lds + P_LDS_K;
  LAS char* xp_own = lds + P_LDS_X + wid * 2048 + lane * 16; LAS char* xp_par = lds + P_LDS_X + (wid ^ 4) * 2048 + lane * 16;
  LAS float* li = (LAS float*)(lds + P_LDS_L);
  float l_reg = 0; f32x16 o[4] = {}; bf16x8 qr[8];
  const bf16_t* Qw = Qb + (long)(g * QBLK + r32) * LDQ + hi * 8;
#pragma unroll
  for (int d0 = 0; d0 < 8; ++d0) qr[d0] = *reinterpret_cast<const bf16x8*>(Qw + d0 * 16);
  float negMC;
  { float q2 = 0.f;
#pragma unroll
    for (int d0 = 0; d0 < 8; ++d0) { const u32x4 w = __builtin_bit_cast(u32x4, qr[d0]);
      q2 += bflo(w.x) * bflo(w.x) + bfhi(w.x) * bfhi(w.x) + bflo(w.y) * bflo(w.y) + bfhi(w.y) * bfhi(w.y) + bflo(w.z) * bflo(w.z) + bfhi(w.z) * bfhi(w.z) + bflo(w.w) * bflo(w.w) + bfhi(w.w) * bfhi(w.w); }
    auto rr = __builtin_amdgcn_permlane32_swap(__float_as_uint(q2), __float_as_uint(q2), false, false);
    q2 = __uint_as_float(rr[0]) + __uint_as_float(rr[1]);
    negMC = -(sqrtf(q2 * kmax2) * (SCALE * 1.0001f) - 30.0f) * 1.4426950408889634f; }
  const int sr = tid >> 4, sc = (tid & 15) * 8, vst0 = v_st(sr, sc), vst1 = v_st(32 + sr, sc);
  const int vrd = (int)(uintptr_t)V_lds + kb * 16384 + v_rd_base(lane);
  const int krow = 32 * kb + r32;
  struct { bf16x8 v00, v01, v10, v11, k0, k1; } st_;
#define PLD16(base, off) (*reinterpret_cast<const bf16x8*>((const char*)(base) + (off)))
#define PLOAD(k0_) do { const unsigned o_ = (unsigned)(((k0_) + sr) * LDK + sc) * 2u; \
    st_.v00 = PLD16(Vh, o_); st_.v01 = PLD16(Vh, o_ + 256u); st_.v10 = PLD16(Vh, o_ + 64u * LDK); st_.v11 = PLD16(Vh, o_ + 64u * LDK + 256u); \
    st_.k0 = PLD16(Kh, o_); st_.k1 = PLD16(Kh, o_ + 64u * LDK); } while (0)
#define PWRITE(kbuf, vbuf) do { LAS char* vb_ = V_lds + (vbuf) * PV_BUF; LAS char* kb_ = K_lds + (kbuf) * PK_BUF; const int kc = sc * 2; \
    *(LAS bf16x8*)(vb_ + vst0) = st_.v00; *(LAS bf16x8*)(vb_ + 16384 + vst0) = st_.v01; *(LAS bf16x8*)(vb_ + vst1) = st_.v10; *(LAS bf16x8*)(vb_ + 16384 + vst1) = st_.v11; \
    *(LAS bf16x8*)(kb_ + KSWZ(sr, kc)) = st_.k0; *(LAS bf16x8*)(kb_ + KSWZ(32 + sr, kc)) = st_.k1; } while (0)
  const int NT = seq / KVBLK;
  f32x16 pS; bf16x8 f0, f1, g0, g1;
  PLOAD(0); asm volatile("s_waitcnt vmcnt(0)" ::: "memory"); PWRITE(0, 0); PLOAD(KVBLK);
  __syncthreads();
  for (int j = 0; j < NT; ++j) {
    SBAR();
    qkt_half(pS, K_lds + (j & 1) * PK_BUF, qr, krow, hi);
    smA(pS, negMC); smB(pS, l_reg, f0, f1); SBAR();
    *(LAS bf16x8*)(xp_own) = f0; *(LAS bf16x8*)(xp_own + 1024) = f1;
    if (j + 1 < NT) PWRITE((j + 1) & 1, (j + 1) & 1);
    if (j + 2 < NT) PLOAD((j + 2) * KVBLK);
    __syncthreads();
    g0 = *(const LAS bf16x8*)(xp_par); g1 = *(const LAS bf16x8*)(xp_par + 1024);
    { const int vb = vrd + (j & 1) * PV_BUF;
      if (kb == 0) pv_d0(o, vb, f0, f1, g0, g1); else pv_d0(o, vb, g0, g1, f0, f1); }
    __syncthreads();
  }
  if (hi == 0) li[wid * 32 + r32] = l_reg;
  __syncthreads();
#pragma unroll
  for (int r = 0; r < 16; ++r) { const int orow = crow(r, hi); const float rl = __builtin_amdgcn_rcpf(li[wid * 32 + orow] + li[(wid ^ 4) * 32 + orow]);
    bf16_t* op = Ob + (long)(g * QBLK + orow) * LDO + 128 * kb + r32;
    for (int d0 = 0; d0 < 4; ++d0) op[d0 * 32] = (bf16_t)(cvtpk(o[d0][r] * rl, 0.f) & 0xffffu); }
#undef PLD16
#undef PLOAD
#undef PWRITE
}
#undef KSWZ
}

__device__ __forceinline__ void phase_attention(const Params& p, Ctx& C) {
    const bf16_t* QKV = (const bf16_t*)(p.ws + WS_BIG + BG_QKV); bf16_t* ATT = (bf16_t*)(p.ws + WS_BIG + BG_ATT);
    const unsigned* KMAX = (const unsigned*)(p.ws + WS_CTL) + CW_KMAX;
    const bool grouped = (C.G == 256);
    for (int i = 0;; ++i) {
        int unit;
        if (grouped) { if (i >= 4) break; unit = (C.bid & 7) * 128 + i * 32 + (C.bid >> 3); } else { unit = i * C.G + C.bid; if (unit >= 1024) break; }
        const int d = unit >> 7, qb = unit & 127, h = d >> 1, m = d & 1;
        const float kmax2 = __uint_as_float(KMAX[64 * (2 + 2 * h + m)]);
        __syncthreads();
        int tz = C.tid; asm volatile("" : "+v"(tz));
        att::attn_pair_body<OD_IN, OD_IN, 3072>(QKV + (size_t)(CTXL + 128 * qb) * OD_IN + 1536 + 256 * h + 128 * m, QKV + 2560 + 256 * h + 128 * m, QKV + 3584 + 256 * h,
                                                ATT + (size_t)(128 * qb) * 3072 + 1024 + 1024 * m + 256 * h, TT, (LAS char*)C.lds, tz, kmax2);
    }
    for (int i = 0;; ++i) {
        int unit;
        if (grouped) { if (i >= 2) break; unit = (C.bid & 7) * 64 + i * 32 + (C.bid >> 3); } else { unit = i * C.G + C.bid; if (unit >= 512) break; }
        const int prob = unit >> 6, qb = unit & 63;
        const float kmax2 = __uint_as_float(KMAX[64 * (prob >> 2)]);
        __syncthreads();
        int tz = C.tid; asm volatile("" : "+v"(tz));
        att::attn_dense_body<OD_IN, OD_IN, 3072>(QKV + (size_t)(CTXL + 256 * qb) * OD_IN + 128 * prob, QKV + 1024 + 128 * (prob >> 2), QKV + 1280 + 128 * (prob >> 2),
                                                 ATT + (size_t)(256 * qb) * 3072 + 128 * prob, TT, (LAS char*)C.lds, tz, kmax2);
    }
    __syncthreads();
}
constexpr int PH_PER_LAYER = 13, N_PHASES = 2 + 2 * PH_PER_LAYER;
#ifndef DBL_PHASE
#define DBL_PHASE -1
#endif
#ifndef MK_PER_PHASE
#define MK_PER_PHASE 0
#endif

template <int L>
__device__ __forceinline__ void layer_body(const Params& p, Ctx& C0, const XcdBarrier& bar, LAS unsigned char* misc, int lo, int hi) {
#define IN(k) (lo <= (k) && (k) < hi)
#define SEAM(k) do { if (IN(k) && IN((k) + 1)) xcd_barrier(bar, C0.wave); } while (0)
#define PHASE(k, ...) if (IN(k)) { FRESH(); __VA_ARGS__ } if (DBL_PHASE == (k)) { xcd_barrier(bar, C0.wave); { FRESH(); __VA_ARGS__ } } SEAM(k);
#define FRESH() Ctx C = C0; { int ln = (int)__builtin_amdgcn_mbcnt_hi(~0u, __builtin_amdgcn_mbcnt_lo(~0u, 0u)); asm volatile("" : "+v"(ln)); C.lane = ln; C.tid = C.wave * 64 + ln; }
        const int b = 2 + PH_PER_LAYER * L;
        bf16_t* QKV = (bf16_t*)(p.ws + WS_BIG + BG_QKV);
        bf16_t* XA = (bf16_t*)(p.ws + WS_XA);
        int* cnt = (int*)(p.ws + WS_CTL) + CW_CNT + L * 128; const int* LIST = (const int*)(p.ws + WS_LIST);
        PHASE(b + 0, phase_modulate(p, C, L); )
        PHASE(b + 1,
            const int N = L ? OD_IN : EV_IN;
            pg8::DenseOrder S; S.init8((const void*)XA, DM, (const void*)(p.ws + (L ? WS_WIN1 : WS_WIN0)), TT, N, DM, C.G, C.bid);
            pg8::EpiStore E{QKV, N, 1.0f / 32.0f};
            pg8::gemm_phase<true>(C.lds, S, E, C.wave);
            if (L == 0 && IN(b + 2) && S.units_of_me() < S.max_units()) conv_queue(p, C, 2);
        )
        PHASE(b + 2, if (L == 0) phase_rope0(p, C); else phase_normrope1(p, C); )
        PHASE(b + 3, if (L == 0) { ret_chunk_kv(p, C); s5_end_states(p, C); } else phase_attention(p, C); )
        PHASE(b + 4, if (L == 0) phase_scans(p, C); else phase_merge1(p, C); )
        if (L == 0) {
            PHASE(b + 5, phase_ret_s5_outputs(p, C, misc); )
            PHASE(b + 6,
                pg8::DenseOrder S; S.init((const bf16_t*)(p.ws + WS_Z), 1024, (const bf16_t*)(p.ws + WS_WGLU), TT, 1024, 1024, C.G, C.bid);
                pg8::EpiGlu E{(const bf16_t*)(p.ws + WS_Z), p.inp(20), (bf16_t*)(p.ws + WS_BIG + BG_MIX)};
                pg8::gemm_phase<false>(C.lds, S, E, C.wave);
                if (IN(b + 7) && S.units_of_me() < S.max_units()) conv_queue(p, C, 4);
            )
        }
        PHASE(b + 7,
            pg8::DenseOrder S;
            if (L == 0) S.init((const bf16_t*)(p.ws + WS_BIG + BG_MIX), DM, (const bf16_t*)(p.ws + WS_WOUT0), TT, DM, DM, C.G, C.bid);
            else S.init((const bf16_t*)(p.ws + WS_BIG + BG_ATT), 3072, (const bf16_t*)(p.ws + WS_WOUT1), SEQ, DM, DM, C.G, C.bid);
            pg8::EpiStore E{(bf16_t*)(p.ws + WS_YMIX) + (L ? (size_t)CTXL * DM : 0), DM, 1.0f};
            pg8::gemm_phase<false>(C.lds, S, E, C.wave);
            if (L == 0 && IN(b + 8) && S.units_of_me() < S.max_units()) conv_queue(p, C, 5);
        )
        PHASE(b + 8, phase_ln1(p, C, L); )
        PHASE(b + 9, phase_router(p, C, L); )
        PHASE(b + 10,
            pg8::MoeOrder<0> S; S.A = (const void*)XA; S.Bt = (const void*)(p.ws + WS_GU + (size_t)L * NEX1 * 1024 * DM); S.list = LIST; S.cnt = cnt; S.ldab = DM; S.kb = DM; S.nN = 4; S.G = C.G; S.c = C.bid; S.bstride = (size_t)1024 * DM;
            S.prep(misc, C.tid);
            pg8::EpiE1 E{(unsigned char*)(p.ws + WS_HX2), S.cn, S.rb};
            pg8::gemm_phase<true>(C.lds, S, E, C.wave);
        )
        PHASE(b + 11,
            pg8::MoeOrder<1> S; S.A = (const void*)(p.ws + WS_HX2); S.Bt = (const void*)(p.ws + WS_DT + (size_t)L * NEX1 * DM * EHID); S.list = LIST; S.cnt = cnt; S.ldab = EHID; S.kb = EHID; S.nN = 8; S.G = C.G; S.c = C.bid; S.bstride = (size_t)DM * EHID;
            S.prep(misc, C.tid);
            pg8::EpiE2 E{(unsigned char*)(p.ws + WS_BIG + BG_YMOE), (const float*)(p.ws + WS_LW), S.cn, S.rb};
            pg8::gemm_phase<true>(C.lds, S, E, C.wave);
        )
        PHASE(b + 12, phase_combine(p, C, L, misc); )
    #undef IN
#undef SEAM
#undef FRESH
#undef PHASE
}

__global__ void __launch_bounds__(NTHR, 2) mega_fwd(KArgs ka) {
    extern __shared__ __attribute__((aligned(16))) unsigned char lds_raw[];
    Ctx C;
    C.lds = (LAS unsigned char*)lds_raw;
    C.tid = threadIdx.x; C.lane = C.tid & 63; C.wave = __builtin_amdgcn_readfirstlane(C.tid >> 6);
    C.G = gridDim.x; C.bid = blockIdx.x; C.gw = C.bid * NWAVES + C.wave; C.ngw = C.G * NWAVES;
    LAS unsigned char* misc = C.lds + MISC_OFF;
    if (C.tid < 8) ((volatile LAS unsigned*)misc)[C.tid] = 0u;
    Params p; p.out = ka.out; p.ws = ka.ws; p.ph_lo = ka.ph_lo; p.ph_hi = ka.ph_hi; p.ptab = (LAS unsigned long long*)(misc + 1024);
    if (C.tid < 34) p.ptab[C.tid] = (unsigned long long)ka.in[C.tid];
    __syncthreads();
    const int lo = p.ph_lo, hi = p.ph_hi;
    XcdBarrier bar; bar.bar = (unsigned*)(p.ws + WS_CTL) + CW_BAR; bar.x = 0; bar.st = (volatile LAS unsigned*)misc;
    if (hi - lo > 1) bar = xcd_barrier_post((unsigned*)(p.ws + WS_CTL) + CW_BAR, (volatile LAS unsigned*)misc);
#define IN(k) (lo <= (k) && (k) < hi)
#define SEAM(k) do { if (IN(k) && IN((k) + 1)) xcd_barrier(bar, C.wave); } while (0)

    if (IN(0)) { phase_p0(p, C); } SEAM(0);
    if (IN(1)) { phase_p1(p, C); } SEAM(1);
    if (IN(0) && IN(2) && (C.G & 7) == 0) {
        volatile LAS unsigned* st = (volatile LAS unsigned*)misc;
        if (C.tid == 0) { unsigned pre = 0u; const unsigned x = st[3];
            for (unsigned j = 0; j < 16; ++j) { const unsigned cj = xb_ld(&bar.bar[XB_XCNT(j)]); pre += (j < x) ? cj : 0u; }
            st[4] = pre + st[2]; }
        __syncthreads();
        const int vcu = (int)st[4], g8 = C.G >> 3;
        C.bid = __builtin_amdgcn_readfirstlane((vcu % g8) * 8 + vcu / g8); C.gw = C.bid * NWAVES + C.wave;
    }

    layer_body<0>(p, C, bar, misc, lo, hi);
    layer_body<1>(p, C, bar, misc, lo, hi);
#undef IN
#undef SEAM
}

extern "C" void kernel_launch(void* const* d_in, const int* in_sizes, int n_in, void* d_out, int out_size, void* d_ws, size_t ws_size, hipStream_t stream) {
    static int grid = 0;
    if (grid == 0) {
        if (n_in != 34 || out_size != SEQ * DM || ws_size < WS_END) { fprintf(stderr, "kernel_launch: unexpected shapes: n_in %d out %d ws %zu (need %zu)\n", n_in, out_size, ws_size, (size_t)WS_END); grid = -1; return; }
        int dev = 0, cus = 0, per_cu = 0;
        if (hipGetDevice(&dev) != hipSuccess || hipDeviceGetAttribute(&cus, hipDeviceAttributeMultiprocessorCount, dev) != hipSuccess) { grid = -1; return; }
        if (hipFuncSetAttribute((const void*)mega_fwd, hipFuncAttributeMaxDynamicSharedMemorySize, LDS_BYTES) != hipSuccess) { fprintf(stderr, "kernel_launch: hipFuncSetAttribute failed\n"); grid = -1; return; }
        if (hipOccupancyMaxActiveBlocksPerMultiprocessor(&per_cu, (const void*)mega_fwd, NTHR, LDS_BYTES) != hipSuccess || per_cu < 1) { fprintf(stderr, "kernel_launch: occupancy query says %d blocks per CU\n", per_cu); grid = -1; return; }
        (void)hipGetLastError();
        grid = cus;
    }
    if (grid < 0) return;
    (void)hipMemsetAsync((char*)d_ws + WS_CTL, 0, CTL_BYTES, stream);
    KArgs p{};
    for (int i = 0; i < 34; ++i) p.in[i] = (const float*)d_in[i];
    p.out = (float*)d_out; p.ws = (unsigned char*)d_ws;
#if MK_PER_PHASE
    for (int ph = 0; ph < N_PHASES; ++ph) {
        if (ph == 2 + PH_PER_LAYER + 5 || ph == 2 + PH_PER_LAYER + 6) continue;
        p.ph_lo = ph; p.ph_hi = ph + 1;
        hipLaunchKernelGGL(mega_fwd, dim3(grid), dim3(NTHR), LDS_BYTES, stream, p);
    }
#else
    p.ph_lo = 0; p.ph_hi = N_PHASES;
    hipLaunchKernelGGL(mega_fwd, dim3(grid), dim3(NTHR), LDS_BYTES, stream, p);
#endif
    const hipError_t le = hipPeekAtLastError();
    if (le != hipSuccess) fprintf(stderr, "kernel_launch: launch failed: %s\n", hipGetErrorName(le));
}
```

```cpp
#define MK_PER_PHASE 0
#include <hip/hip_runtime.h>
#include <cstdio>
#include <cstdint>

#define GAS __attribute__((address_space(1)))
#define LAS __attribute__((address_space(3)))
typedef unsigned short bf16_t;
typedef short bf16x8 __attribute__((ext_vector_type(8)));
typedef short s16x4 __attribute__((ext_vector_type(4)));
typedef float f32x4 __attribute__((ext_vector_type(4)));
typedef float f32x2 __attribute__((ext_vector_type(2)));
typedef float f32x16 __attribute__((ext_vector_type(16)));
typedef unsigned u32x4 __attribute__((ext_vector_type(4)));
typedef unsigned u32x2 __attribute__((ext_vector_type(2)));

constexpr int DM = 2048, SEQ = 16384, CTXL = 256, TT = SEQ + CTXL;
constexpr int NEXP = 64, NEX1 = 65, EHID = 512, TOPK = 8;
constexpr int EV_IN = 5120, OD_IN = 4608;
constexpr float LN_EPS = 1e-6f;
constexpr float ALPHA = 1.4142135623730951f;
constexpr float LAMBDA_INIT = 0.35550906759f;
constexpr int NTHR = 512, NWAVES = 8;

constexpr size_t al256(size_t x) { return (x + 255) / 256 * 256; }
constexpr size_t WS_CTL   = 0;
constexpr size_t CTL_BYTES = 1u << 20;
constexpr size_t WS_MODP  = WS_CTL + CTL_BYTES;
constexpr size_t WS_MODF  = WS_MODP + al256((size_t)2 * 32 * 2 * 12288 * 4);
constexpr size_t WS_ROPE128 = WS_MODF + al256((size_t)2 * 2 * 12288 * 4);
constexpr size_t WS_ROPE64  = WS_ROPE128 + al256((size_t)256 * 64 * 2 * 4);
constexpr size_t WS_KN    = WS_ROPE64 + al256((size_t)256 * 32 * 2 * 4);
constexpr size_t WS_WT    = WS_KN + al256((size_t)2 * 64 * 16 * 1024 * 2);
constexpr size_t WS_APOW  = WS_WT + al256((size_t)2 * 64 * 128 * 1024 * 2);
constexpr size_t WS_AL    = WS_APOW + al256((size_t)2 * 64 * 64 * 128 * 4);
constexpr size_t WS_CC    = WS_AL + al256((size_t)2 * 64 * 128 * 4);
constexpr size_t WS_BBT   = WS_CC + al256((size_t)64 * 16 * 128 * 2);
constexpr size_t WS_S5E   = WS_BBT + al256((size_t)2 * 64 * 128 * 16 * 2);
constexpr size_t WS_HST   = WS_S5E + al256((size_t)2 * 64 * 260 * 128 * 4);
constexpr size_t WS_WIN0  = WS_HST + al256((size_t)2 * 64 * 260 * 128 * 4);
constexpr size_t WS_WOUT0 = WS_WIN0 + al256((size_t)EV_IN * DM * 2);
constexpr size_t WS_WGLU  = WS_WOUT0 + al256((size_t)DM * DM * 2);
constexpr size_t WS_WIN1  = WS_WGLU + al256((size_t)1024 * 1024 * 2);
constexpr size_t WS_WOUT1 = WS_WIN1 + al256((size_t)OD_IN * DM * 2);
constexpr size_t WS_RWT   = WS_WOUT1 + al256((size_t)DM * DM * 2);
constexpr size_t WS_GU    = WS_RWT + al256((size_t)2 * 2 * 64 * DM * 2);
constexpr size_t WS_DT    = WS_GU + al256((size_t)NEX1 * 1024 * DM * 2);
constexpr size_t WS_XA    = WS_DT + al256((size_t)NEX1 * DM * EHID * 2);
constexpr size_t WS_Z     = WS_XA + al256((size_t)TT * DM * 2);
constexpr size_t WS_YMIX  = WS_Z + al256((size_t)TT * 1024 * 2);
constexpr size_t WS_X1    = WS_YMIX + al256((size_t)TT * DM * 2);
constexpr size_t WS_HX2   = WS_X1 + al256((size_t)TT * DM * 4);
constexpr size_t WS_LIST  = WS_HX2 + al256((size_t)9 * TT * EHID * 2);
constexpr size_t WS_WGT   = WS_LIST + al256((size_t)NEX1 * TT * 4);
constexpr size_t WS_LW    = WS_WGT + al256((size_t)8 * TT * 4);
constexpr size_t WS_BIG   = WS_LW + al256((size_t)NEX1 * TT * 4);
constexpr size_t BG_QKV   = 0;
constexpr size_t BG_CKV   = BG_QKV + al256((size_t)TT * EV_IN * 2);
constexpr size_t BG_SPREV = BG_CKV + al256((size_t)8 * 130 * 65536 * 4);
constexpr size_t BG_MIX   = BG_SPREV + al256((size_t)8 * 130 * 65536 * 2);
constexpr size_t BG_END0  = BG_MIX + al256((size_t)TT * DM * 2);
constexpr size_t BG_ATT   = BG_CKV;
constexpr size_t BG_YMOE  = 0;
constexpr size_t BG_END1  = al256((size_t)9 * TT * DM * 2);
constexpr size_t BG_SIZE  = BG_END0 > BG_END1 ? BG_END0 : BG_END1;
constexpr size_t WS_END   = WS_BIG + BG_SIZE;

constexpr int CW_BAR = 4096;
constexpr int CW_CNT = 16384;
constexpr int CW_QUEUE = 20480;
constexpr int CW_KMAX = 24576;

constexpr int RING_BYTES = 151552;
constexpr int MISC_OFF = RING_BYTES;
constexpr int LDS_BYTES = 159744;

typedef __bf16 bf16x2_t __attribute__((ext_vector_type(2)));
__device__ __forceinline__ unsigned cvt_pk_bf16(float lo, float hi) { const f32x2 v = {lo, hi}; return __builtin_bit_cast(unsigned, __builtin_convertvector(v, bf16x2_t)); }
__device__ __forceinline__ bf16_t f2bf(float f) { unsigned u = __builtin_bit_cast(unsigned, f); return (bf16_t)((u + 0x7fffu + ((u >> 16) & 1u)) >> 16); }
__device__ __forceinline__ float bf2f(bf16_t b) { return __builtin_bit_cast(float, ((unsigned)b) << 16); }
__device__ __forceinline__ float bflo(unsigned w) { return __builtin_bit_cast(float, w << 16); }
__device__ __forceinline__ float bfhi(unsigned w) { return __builtin_bit_cast(float, w & 0xffff0000u); }
__device__ __forceinline__ float wave_sum(float v) {
#pragma unroll
    for (int o = 1; o < 64; o <<= 1) v += __shfl_xor(v, o);
    return v;
}
__device__ __forceinline__ float fast_exp(float x) { return __builtin_amdgcn_exp2f(x * 1.4426950408889634f); }
__device__ __forceinline__ float sigmoidf_(float x) { return 1.0f / (1.0f + __expf(-x)); }
__device__ __forceinline__ float siluf_(float x) { return x / (1.0f + __expf(-x)); }
__device__ __forceinline__ float gelu_tanh(float x) {
    const float u = 0.7978845608028654f * (x + 0.044715f * x * x * x);
    const float e = __expf(2.0f * u);
    const float t = 1.0f - 2.0f / (e + 1.0f);
    return 0.5f * x * (1.0f + t);
}
#define LDS_WAIT() asm volatile("s_waitcnt lgkmcnt(0)" ::: "memory")
#define VM_WAIT() asm volatile("s_waitcnt vmcnt(0)" ::: "memory")

#define XB_TMO      128
#define XB_XCNT(j)  (256  + 64 * (j))
#define XB_XSUB(j)  (1280 + 64 * (j))
#define XB_XGEN(j)  (2304 + 64 * (j))
#define XB_TOP      3328
#define XB_TOPGEN   3392
#define XCD_BAR_WORDS 3456
#define XB_SPIN_CAP (1u << 22)

__device__ __forceinline__ unsigned xb_ld(unsigned* p)              { return __hip_atomic_load(p, __ATOMIC_RELAXED, __HIP_MEMORY_SCOPE_AGENT); }
__device__ __forceinline__ unsigned xb_add(unsigned* p, unsigned v) { return __hip_atomic_fetch_add(p, v, __ATOMIC_RELAXED, __HIP_MEMORY_SCOPE_AGENT); }
__device__ __forceinline__ unsigned xb_xcc_id() { return (unsigned)__builtin_amdgcn_s_getreg((3 << 11) | 20) & 0xFu; }
#define XB_SPIN(cond, bar) do { unsigned _sp = 0; while (cond) { __builtin_amdgcn_s_sleep(1); \
    if ((++_sp & 255u) == 0u) { if (xb_ld(&(bar)[XB_TMO])) break; if (_sp > XB_SPIN_CAP) { atomicAdd(&(bar)[XB_TMO], 1u); break; } } } } while (0)

struct XcdBarrier { unsigned* bar; unsigned x; volatile LAS unsigned* st; };

__device__ __forceinline__ XcdBarrier xcd_barrier_post(unsigned* bar, volatile LAS unsigned* st) {
    XcdBarrier b; b.bar = bar; b.x = xb_xcc_id(); b.st = st;
    if (threadIdx.x == 0) { st[2] = xb_add(&bar[XB_XCNT(b.x)], 1u); st[3] = b.x; }
    return b;
}
__device__ __forceinline__ void xcd_barrier_complete(unsigned* bar, unsigned x, unsigned& nloc, unsigned& nx) {
    const unsigned G = gridDim.x * gridDim.y * gridDim.z;
    unsigned sum, cnt, mine, sp = 0u;
    for (;;) {
        sum = 0u; cnt = 0u; mine = 0u;
#pragma unroll
        for (unsigned j = 0; j < 16; ++j) { const unsigned c = xb_ld(&bar[XB_XCNT(j)]); sum += c; cnt += (c > 0u) ? 1u : 0u; mine = (j == x) ? c : mine; }
        if (sum == G) break;
        __builtin_amdgcn_s_sleep(1);
        if ((++sp & 255u) == 0u) { if (xb_ld(&bar[XB_TMO])) break; if (sp > XB_SPIN_CAP) { atomicAdd(&bar[XB_TMO], 1u); break; } }
    }
    nloc = mine > 0u ? mine : 1u; nx = cnt > 0u ? cnt : 1u;
}
__device__ __forceinline__ void xcd_barrier(const XcdBarrier& b, int wave_id) {
    const bool leader_thread = (wave_id == 0) && (__builtin_amdgcn_mbcnt_hi(~0u, __builtin_amdgcn_mbcnt_lo(~0u, 0u)) == 0u);
    asm volatile("s_waitcnt vmcnt(0)" ::: "memory");
    __syncthreads();
    if (leader_thread) {
        unsigned* bar = b.bar;
        __builtin_amdgcn_s_waitcnt(0);
        unsigned nloc = b.st[0], nx = b.st[1];
        if (nloc == 0u) { xcd_barrier_complete(bar, b.x, nloc, nx); b.st[0] = nloc; b.st[1] = nx; }
        const unsigned old = xb_add(&bar[XB_XSUB(b.x)], 1u);
        const unsigned gen = old / nloc;
        if (old + 1u == (gen + 1u) * nloc) {
            __builtin_amdgcn_fence(__ATOMIC_RELEASE, "agent");
            asm volatile("s_waitcnt vmcnt(0)" ::: "memory");
            const unsigned og = xb_add(&bar[XB_TOP], 1u);
            const unsigned tg = og / nx;
            if (og + 1u == (tg + 1u) * nx) xb_add(&bar[XB_TOPGEN], 1u);
            else XB_SPIN(xb_ld(&bar[XB_TOPGEN]) == tg, bar);
            __builtin_amdgcn_fence(__ATOMIC_ACQUIRE, "agent");
            xb_add(&bar[XB_XGEN(b.x)], 1u);
            asm volatile("s_waitcnt vmcnt(0)" ::: "memory");
        } else {
            XB_SPIN(xb_ld(&bar[XB_XGEN(b.x)]) == gen, bar);
            __builtin_amdgcn_fence(__ATOMIC_ACQUIRE, "agent");
            asm volatile("s_waitcnt vmcnt(0)" ::: "memory");
        }
    }
    __syncthreads();
}

__device__ __forceinline__ bf16x8 frag_rowk_l(const LAS bf16_t* p, int ld, int lane) {
    return *(const LAS bf16x8*)(p + (lane & 15) * ld + (lane >> 4) * 8);
}
__device__ __forceinline__ bf16x8 frag_rowk_g(const bf16_t* p, long ld, int lane) {
    return *(const bf16x8*)(p + (long)(lane & 15) * ld + (lane >> 4) * 8);
}
__device__ __forceinline__ bf16x8 frag_colk_l(unsigned p, int ldb, int lane) {
    const unsigned a0 = p + (unsigned)((8 * (lane >> 4) + ((lane & 15) >> 2)) * ldb + (lane & 3) * 8);
    const unsigned a1 = a0 + 4u * (unsigned)ldb;
    s16x4 lo, hi;
    asm volatile("ds_read_b64_tr_b16 %0, %2\n\tds_read_b64_tr_b16 %1, %3\n\ts_waitcnt lgkmcnt(0)" : "=&v"(lo), "=&v"(hi) : "v"(a0), "v"(a1) : "memory");
    return (bf16x8){lo[0], lo[1], lo[2], lo[3], hi[0], hi[1], hi[2], hi[3]};
}
#define MFMA16(a, b, c) __builtin_amdgcn_mfma_f32_16x16x32_bf16((a), (b), (c), 0, 0, 0)
namespace pg8 {
constexpr int BM = 256, BK = 64, HALF = 128, HTB = HALF * BK * 2, STAGE_BYTES = 8 * HTB, NXCD = 8, WGM = 8;
__device__ __forceinline__ int lds_byte(int r, int c) { const int st = (r >> 4) * 2 + (c >> 5), rr = r & 15, cc = c & 31, ob = rr * 64 + cc * 2; return st * 1024 + (ob ^ (((ob >> 9) & 1) << 5)); }
__device__ __forceinline__ void stage_rc(int b, int& R, int& C) { const int st = b / 1024, sb = b % 1024, swz = sb ^ (((sb >> 9) & 1) << 5); R = (st >> 1) * 16 + swz / 64; C = (st & 1) * 32 + (swz % 64) / 2; }
__device__ __forceinline__ int perm32(int rho) { const int n = rho >> 4, i = rho & 15; return 8 * (i >> 2) + 4 * n + (i & 3); }

struct Unit { int pm, pn, e; };
constexpr float WSCALE = 32.0f, WSCALE_INV = 1.0f / 32.0f;

struct DenseOrder {
    const bf16_t* A; const bf16_t* Bt; int ldab, kb, nM, nN, nwg, G, c;
    __device__ __forceinline__ void init(const bf16_t* A_, int lda_, const bf16_t* Bt_, int M, int N, int K_, int G_, int c_) { A = A_; ldab = lda_ * 2; Bt = Bt_; kb = K_ * 2; nM = M / BM; nN = N / BM; nwg = nM * nN; G = G_; c = c_; }
    __device__ __forceinline__ void init8(const void* A_, int ldab_, const void* Bt_, int M, int N, int K_, int G_, int c_) { A = (const bf16_t*)A_; ldab = ldab_; Bt = (const bf16_t*)Bt_; kb = K_; nM = M / BM; nN = N / BM; nwg = nM * nN; G = G_; c = c_; }
    __device__ __forceinline__ void prep(LAS unsigned char*) const {}
    __device__ __forceinline__ int units_of_me() const { return c < nwg ? (nwg - c + G - 1) / G : 0; }
    __device__ __forceinline__ int max_units() const { return (nwg + G - 1) / G; }
    __device__ __forceinline__ bool next(int i, Unit& u) const {
        const long L = (long)i * G + c; if (L >= nwg) return false;
        int wgid = (int)L; { const int q = nwg / NXCD, r = nwg % NXCD, xcd = wgid % NXCD, off = wgid / NXCD; wgid = (xcd < r ? xcd * (q + 1) : r * (q + 1) + (xcd - r) * q) + off; }
        const int nig = WGM * nN, gid = wgid / nig, fm = gid * WGM, gsz = (nM - fm) < WGM ? (nM - fm) : WGM;
        u.pm = fm + ((wgid % nig) % gsz); u.pn = (wgid % nig) / gsz; u.e = 0; return true;
    }
    __device__ __forceinline__ const char* a_base() const { return (const char*)A; }
    __device__ __forceinline__ unsigned a_off(const Unit& u, int r) const { return (unsigned)(u.pm * BM + r) * (unsigned)ldab; }
    __device__ __forceinline__ const char* b_ptr(const Unit& u) const { return (const char*)Bt + (size_t)u.pn * BM * kb; }
};

template <int MODE  >
struct MoeOrder {
    const void* A; const void* Bt; const int* list; const int* cnt; int ldab, kb, nN, G, c; size_t bstride;
    LAS int* tp; LAS int* cn; LAS int* rb;
    __device__ __forceinline__ void prep(LAS unsigned char* misc, int tid) {
        tp = (LAS int*)(misc + 64); cn = tp + 72; rb = cn + 72;
        if (tid < NEX1) cn[tid] = cnt[tid];
        __syncthreads();
        if (tid == 0) { int s = 0, q = 0; for (int e = 0; e < NEX1; ++e) { tp[e] = s; rb[e] = q; s += (cn[e] + BM - 1) / BM; q += cn[e]; } tp[NEX1] = s; rb[NEX1] = q; }
        __syncthreads();
    }
    __device__ __forceinline__ bool next(int i, Unit& u) const {
        const int total = tp[NEX1]; const long nu = (long)total * nN; const int per = (int)((nu + G - 1) / G);
        (void)per;
        long L = (long)i * G + c;
        if ((G & 7) == 0) L = ((long)i * 8 + (c & 7)) * (G >> 3) + (c >> 3);
        if (L >= nu) return false;
        const int tile = (int)(L / nN); u.pn = (int)(L % nN);
        int e = 0;
        for (int k = 1; k < NEX1; ++k) e += (tp[k] <= tile) ? 1 : 0;
        u.e = e; u.pm = tile - tp[e]; return true;
    }
    __device__ __forceinline__ const char* a_base() const { return (const char*)A; }
    __device__ __forceinline__ unsigned a_off(const Unit& u, int r) const {
        int pos = u.pm * BM + r; const int n = cn[u.e]; pos = pos < n ? pos : n - 1;
        if (MODE == 1) return (unsigned)(rb[u.e] + pos) * (unsigned)ldab;
        const int a = list[u.e * TT + pos];
        const int row = a < 8 * TT ? (a >> 3) : a - 8 * TT;
        return (unsigned)row * (unsigned)ldab;
    }
    __device__ __forceinline__ const char* b_ptr(const Unit& u) const { return (const char*)Bt + (size_t)u.e * bstride + (size_t)u.pn * BM * kb; }
};

typedef int v8i32 __attribute__((ext_vector_type(8)));
typedef int v4i32_ __attribute__((ext_vector_type(4)));
__device__ __forceinline__ v8i32 cat8(bf16x8 a, bf16x8 b) { const u32x4 x = __builtin_bit_cast(u32x4, a), y = __builtin_bit_cast(u32x4, b); return (v8i32){(int)x.x, (int)x.y, (int)x.z, (int)x.w, (int)y.x, (int)y.y, (int)y.z, (int)y.w}; }
template <bool FP8, class Epi, class Sched>
__device__ __forceinline__ void gemm_phase(LAS unsigned char* lds, const Sched& S, const Epi& E, int wave_id) {
    const int wid = wave_id; int lane = (int)__builtin_amdgcn_mbcnt_hi(~0u, __builtin_amdgcn_mbcnt_lo(~0u, 0u)); asm volatile("" : "+v"(lane));
    const int tid = wid * 64 + lane, wr = wid >> 2, wc = wid & 3, fr = lane & 15, fq = lane >> 4;
    const int kb = S.kb; int nt = kb / 128; asm volatile("" : "+s"(nt));
    unsigned voffB[2];
#pragma unroll
    for (int i = 0; i < 2; ++i) { int R, C; stage_rc(tid * 16 + i * 8192, R, C); const int Rb = (R & ~31) + perm32(R & 31);
        voffB[i] = (unsigned)(Rb * kb) + (unsigned)C * 2u; }
#define PG8_AOFF(u, h, i) ({ int _tz = tid; asm volatile("" : "+v"(_tz)); int _R, _C; stage_rc(_tz * 16 + (i) * 8192, _R, _C); S.a_off((u), (h) * HALF + _R) + (unsigned)_C * 2u; })
    const size_t kstep = (size_t)(BK * 2);
    const size_t hstepB = (size_t)HALF * kb;
    const unsigned ldsw = (unsigned)wid * 1024u;
    const int aoff = lds_byte(wr * 64 + fr, fq * 8), boff = lds_byte(wc * 32 + fr, fq * 8);
#define PG8_SA(b, h) (((b) * 2 + (h)) * HTB)
#define PG8_SB(b, h) ((4 + (b) * 2 + (h)) * HTB)
#define PG8_STAGE(bufoff, gbase, v0, v1) do { \
        __builtin_amdgcn_global_load_lds((const unsigned*)((const char*)(gbase) + (v0)), (LAS unsigned*)(lds + (bufoff) + ldsw), 16, 0, 0); \
        __builtin_amdgcn_global_load_lds((const unsigned*)((const char*)(gbase) + (v1)), (LAS unsigned*)(lds + (bufoff) + ldsw + 8192), 16, 0, 0); } while (0)
#define PG8_VOFFB(i) ({ int _tz = tid; asm volatile("" : "+v"(_tz)); int _R, _C; stage_rc(_tz * 16 + (i) * 8192, _R, _C); (unsigned)(((_R & ~31) + perm32(_R & 31)) * kb) + (unsigned)_C * 2u; })
#define PG8_STAGE_B(bufoff, gbase) do { if constexpr (FP8) { const unsigned _v0 = PG8_VOFFB(0), _v1 = PG8_VOFFB(1); PG8_STAGE(bufoff, gbase, _v0, _v1); } else PG8_STAGE(bufoff, gbase, voffB[0], voffB[1]); } while (0)
#define PG8_LD8(off) __builtin_shufflevector(*(const LAS v4i32_*)(lds + (off)), *(const LAS v4i32_*)(lds + (off) + 1024), 0, 1, 2, 3, 4, 5, 6, 7)
#define PG8_LDA(dst, b, h) do { _Pragma("unroll") for (int m = 0; m < 4; ++m) { if constexpr (FP8) dst##8[m] = PG8_LD8(PG8_SA(b, h) + aoff + m * 2048); else { _Pragma("unroll") for (int k = 0; k < 2; ++k) dst[m][k] = *(const LAS bf16x8*)(lds + PG8_SA(b, h) + aoff + m * 2048 + k * 1024); } } } while (0)
#define PG8_LDB(dst, b, h) do { _Pragma("unroll") for (int n = 0; n < 2; ++n) { if constexpr (FP8) dst##8[n] = PG8_LD8(PG8_SB(b, h) + boff + n * 2048); else { _Pragma("unroll") for (int k = 0; k < 2; ++k) dst[n][k] = *(const LAS bf16x8*)(lds + PG8_SB(b, h) + boff + n * 2048 + k * 1024); } } } while (0)
#define PG8_MMA(ai, bj, At, Bt) do { __builtin_amdgcn_s_setprio(1); _Pragma("unroll") for (int m = 0; m < 4; ++m) _Pragma("unroll") for (int n = 0; n < 2; ++n) { \
        if constexpr (FP8) asm volatile("v_mfma_f32_16x16x128_f8f6f4 %0, %1, %2, %0" : "+v"(acc[ai][bj][m][n]) : "v"(Bt##8[n]), "v"(At##8[m])); \
        else { _Pragma("unroll") for (int k = 0; k < 2; ++k) acc[ai][bj][m][n] = __builtin_amdgcn_mfma_f32_16x16x32_bf16(Bt[n][k], At[m][k], acc[ai][bj][m][n], 0, 0, 0); } } \
        __builtin_amdgcn_s_setprio(0); } while (0)
#define PG8_WAIT_V(n) asm volatile("s_waitcnt vmcnt(" #n ")" ::: "memory")
#define PG8_WAIT_L(n) asm volatile("s_waitcnt lgkmcnt(" #n ")" ::: "memory")
#define PG8_BAR __builtin_amdgcn_s_barrier()
#define PG8_SCHED __builtin_amdgcn_sched_barrier(0)
    Unit cur, nxt; int ui = 0;
    if (!S.next(0, cur)) return;
    f32x4 acc[2][2][4][2];
#pragma unroll
    for (int a = 0; a < 2; ++a)
#pragma unroll
        for (int b = 0; b < 2; ++b)
#pragma unroll
            for (int m = 0; m < 4; ++m)
#pragma unroll
                for (int n = 0; n < 2; ++n) acc[a][b][m][n] = (f32x4){0.f, 0.f, 0.f, 0.f};
    bf16x8 At[4][2], B0[2][2], B1[2][2]; v8i32 At8[4], B08[2], B18[2];
    const char* const gA = S.a_base();
    const char* cB = S.b_ptr(cur);
    unsigned oc00, oc01, oc10, oc11;
    oc00 = PG8_AOFF(cur, 0, 0); oc01 = PG8_AOFF(cur, 0, 1); oc10 = PG8_AOFF(cur, 1, 0); oc11 = PG8_AOFF(cur, 1, 1);
    PG8_STAGE_B(PG8_SB(0, 0), cB); PG8_STAGE_B(PG8_SB(0, 1), cB + hstepB); PG8_STAGE(PG8_SA(0, 0), gA, oc00, oc01); PG8_STAGE(PG8_SA(0, 1), gA, oc10, oc11);
    if (wr == 1) PG8_BAR;
    PG8_WAIT_V(2); PG8_BAR;
    PG8_STAGE_B(PG8_SB(1, 0), cB + kstep); PG8_STAGE(PG8_SA(1, 0), gA + kstep, oc00, oc01); PG8_STAGE_B(PG8_SB(1, 1), cB + hstepB + kstep);
    PG8_WAIT_V(6); PG8_BAR;
    for (;;) {
        const bool has_next = S.next(ui + 1, nxt);
        const char* nB = cB;
        {
            u32x4 on = {oc00, oc01, oc10, oc11};
            if (has_next) { on.x = PG8_AOFF(nxt, 0, 0); on.y = PG8_AOFF(nxt, 0, 1); on.z = PG8_AOFF(nxt, 1, 0); on.w = PG8_AOFF(nxt, 1, 1); nB = S.b_ptr(nxt); }
            *(LAS u32x4*)(lds + STAGE_BYTES + tid * 16) = on;
        }
        for (int t = 0; t < nt; t += 2) {
            const bool last = (t == nt - 2);
            const char* a1 = gA + (size_t)(t + 1) * kstep;
            const char* a2 = last ? gA : gA + (size_t)(t + 2) * kstep; const char* b2 = last ? nB : cB + (size_t)(t + 2) * kstep;
            const char* a3 = a2 + kstep; const char* b3 = b2 + kstep;
            unsigned s00 = oc00, s01 = oc01, s10 = oc10, s11 = oc11;
            if (last) { const u32x4 on = *(const LAS u32x4*)(lds + STAGE_BYTES + tid * 16); s00 = on.x; s01 = on.y; s10 = on.z; s11 = on.w; }
            PG8_LDB(B0, 0, 0); PG8_LDB(B1, 0, 1); PG8_SCHED; PG8_LDA(At, 0, 0); PG8_STAGE(PG8_SA(1, 1), a1, oc10, oc11);
            PG8_WAIT_V(8); PG8_WAIT_L(0); PG8_BAR; PG8_MMA(0, 0, At, B0); PG8_MMA(0, 1, At, B1); PG8_BAR; PG8_SCHED;
            PG8_LDA(At, 0, 1); PG8_STAGE_B(PG8_SB(0, 0), b2); PG8_STAGE_B(PG8_SB(0, 1), b2 + hstepB); PG8_STAGE(PG8_SA(0, 0), a2, s00, s01);
            PG8_WAIT_V(8); PG8_WAIT_L(0); PG8_BAR; PG8_MMA(1, 0, At, B0); PG8_MMA(1, 1, At, B1); PG8_BAR; PG8_SCHED;
            PG8_LDB(B0, 1, 0); PG8_LDB(B1, 1, 1); PG8_SCHED; PG8_LDA(At, 1, 0); PG8_STAGE(PG8_SA(0, 1), a2, s10, s11);
            PG8_WAIT_V(8); PG8_WAIT_L(0); PG8_BAR; PG8_MMA(0, 0, At, B0); PG8_MMA(0, 1, At, B1); PG8_BAR; PG8_SCHED;
            PG8_LDA(At, 1, 1); PG8_STAGE_B(PG8_SB(1, 0), b3); PG8_STAGE_B(PG8_SB(1, 1), b3 + hstepB); PG8_STAGE(PG8_SA(1, 0), a3, s00, s01);
            PG8_WAIT_V(8); PG8_WAIT_L(0); PG8_BAR; PG8_MMA(1, 0, At, B0); PG8_MMA(1, 1, At, B1); PG8_BAR; PG8_SCHED;
        }
        if (wr == 0) PG8_BAR;
        E(acc, cur, wr, wc, fr, fq);
        if (!has_next) break;
#pragma unroll
        for (int a = 0; a < 2; ++a)
#pragma unroll
            for (int b = 0; b < 2; ++b)
#pragma unroll
                for (int m = 0; m < 4; ++m)
#pragma unroll
                    for (int n = 0; n < 2; ++n) acc[a][b][m][n] = (f32x4){0.f, 0.f, 0.f, 0.f};
        { const u32x4 on = *(const LAS u32x4*)(lds + STAGE_BYTES + tid * 16); oc00 = on.x; oc01 = on.y; oc10 = on.z; oc11 = on.w; }
        cur = nxt; cB = nB; ++ui;
        if (wr == 1) PG8_BAR;
    }
    PG8_WAIT_V(0);
    PG8_BAR;
#undef PG8_SA
#undef PG8_SB
#undef PG8_STAGE
#undef PG8_STAGE_B
#undef PG8_AOFF
#undef PG8_VOFFB
#undef PG8_LD8
#undef PG8_LDA
#undef PG8_LDB
#undef PG8_MMA
#undef PG8_WAIT_V
#undef PG8_WAIT_L
#undef PG8_BAR
#undef PG8_SCHED
}

struct EpiStore {
    bf16_t* O; int ldc; float scale;
    __device__ __forceinline__ void operator()(const f32x4 (&acc)[2][2][4][2], const Unit& u, int wr, int wc, int fr, int fq) const {
        const int row0 = u.pm * BM + wr * 64 + fr, col0 = u.pn * BM + wc * 32 + 8 * fq;
#pragma unroll
        for (int ai = 0; ai < 2; ++ai)
#pragma unroll
            for (int m = 0; m < 4; ++m) { bf16_t* rowp = O + (size_t)(row0 + ai * HALF + m * 16) * ldc + col0;
#pragma unroll
                for (int bj = 0; bj < 2; ++bj) { const f32x4 v0 = acc[ai][bj][m][0] * scale, v1 = acc[ai][bj][m][1] * scale;
                    u32x4 w; w.x = cvt_pk_bf16(v0[0], v0[1]); w.y = cvt_pk_bf16(v0[2], v0[3]); w.z = cvt_pk_bf16(v1[0], v1[1]); w.w = cvt_pk_bf16(v1[2], v1[3]);
                    *(u32x4*)(rowp + bj * HALF) = w; } }
    }
};
struct EpiGlu {
    const bf16_t* Z; const float* b; bf16_t* MIX;
    __device__ __forceinline__ void operator()(const f32x4 (&acc)[2][2][4][2], const Unit& u, int wr, int wc, int fr, int fq) const {
        const int row0 = u.pm * BM + wr * 64 + fr, col0 = u.pn * BM + wc * 32 + 8 * fq;
#pragma unroll
        for (int bj = 0; bj < 2; ++bj) {
            const f32x4 b0 = *(const f32x4*)(b + col0 + bj * HALF), b1 = *(const f32x4*)(b + col0 + bj * HALF + 4);
#pragma unroll
            for (int ai = 0; ai < 2; ++ai)
#pragma unroll
                for (int m = 0; m < 4; ++m) { const size_t row = (size_t)(row0 + ai * HALF + m * 16);
                    const u32x4 zz = *(const u32x4*)(Z + row * 1024 + col0 + bj * HALF);
                    const f32x4 v0 = acc[ai][bj][m][0] + b0, v1 = acc[ai][bj][m][1] + b1;
                    u32x4 w;
                    w.x = cvt_pk_bf16(bflo(zz.x) * sigmoidf_(v0[0]), bfhi(zz.x) * sigmoidf_(v0[1]));
                    w.y = cvt_pk_bf16(bflo(zz.y) * sigmoidf_(v0[2]), bfhi(zz.y) * sigmoidf_(v0[3]));
                    w.z = cvt_pk_bf16(bflo(zz.z) * sigmoidf_(v1[0]), bfhi(zz.z) * sigmoidf_(v1[1]));
                    w.w = cvt_pk_bf16(bflo(zz.w) * sigmoidf_(v1[2]), bfhi(zz.w) * sigmoidf_(v1[3]));
                    *(u32x4*)(MIX + row * DM + 1024 + col0 + bj * HALF) = w; }
        }
    }
};
struct EpiE1 {
    unsigned char* H; const LAS int* cn; const LAS int* rb;
    __device__ __forceinline__ void operator()(const f32x4 (&acc)[2][2][4][2], const Unit& u, int wr, int wc, int fr, int fq) const {
        const int n = cn[u.e]; const int colh = u.pn * 128 + wc * 32 + 8 * fq;
#pragma unroll
        for (int ai = 0; ai < 2; ++ai)
#pragma unroll
            for (int m = 0; m < 4; ++m) { const int pos = u.pm * BM + ai * HALF + wr * 64 + m * 16 + fr;
                if (pos < n) { const int a = rb[u.e] + pos;
                    float sc = WSCALE_INV; asm volatile("" : "+v"(sc));
                    const f32x4 g0 = acc[ai][0][m][0] * sc, g1 = acc[ai][0][m][1] * sc, u0 = acc[ai][1][m][0] * sc, u1 = acc[ai][1][m][1] * sc;
                    u32x2 w;
                    w.x = (unsigned)__builtin_amdgcn_cvt_pk_fp8_f32(siluf_(g0[0]) * u0[0], siluf_(g0[1]) * u0[1], 0, false);
                    w.x = (unsigned)__builtin_amdgcn_cvt_pk_fp8_f32(siluf_(g0[2]) * u0[2], siluf_(g0[3]) * u0[3], (int)w.x, true);
                    w.y = (unsigned)__builtin_amdgcn_cvt_pk_fp8_f32(siluf_(g1[0]) * u1[0], siluf_(g1[1]) * u1[1], 0, false);
                    w.y = (unsigned)__builtin_amdgcn_cvt_pk_fp8_f32(siluf_(g1[2]) * u1[2], siluf_(g1[3]) * u1[3], (int)w.y, true);
                    *(u32x2*)(H + (size_t)a * EHID + colh) = w; }
                __builtin_amdgcn_sched_barrier(0); }
    }
};
struct EpiE2 {
    unsigned char* Y; const float* wgt; const LAS int* cn; const LAS int* rb;
    __device__ __forceinline__ void operator()(const f32x4 (&acc)[2][2][4][2], const Unit& u, int wr, int wc, int fr, int fq) const {
        const int n = cn[u.e]; const int col0 = u.pn * BM + wc * 32 + 8 * fq;
#pragma unroll
        for (int ai = 0; ai < 2; ++ai)
#pragma unroll
            for (int m = 0; m < 4; ++m) { const int pos = u.pm * BM + ai * HALF + wr * 64 + m * 16 + fr;
                if (pos < n) { const int a = rb[u.e] + pos; float ws = wgt[u.e * TT + pos] * WSCALE_INV; asm volatile("" : "+v"(ws));
                    unsigned char* rowp = Y + (size_t)a * DM + col0;
#pragma unroll
                    for (int bj = 0; bj < 2; ++bj) { const f32x4 v0 = acc[ai][bj][m][0] * ws, v1 = acc[ai][bj][m][1] * ws;
                        u32x2 w;
                        w.x = (unsigned)__builtin_amdgcn_cvt_pk_fp8_f32(v0[0], v0[1], 0, false); w.x = (unsigned)__builtin_amdgcn_cvt_pk_fp8_f32(v0[2], v0[3], (int)w.x, true);
                        w.y = (unsigned)__builtin_amdgcn_cvt_pk_fp8_f32(v1[0], v1[1], 0, false); w.y = (unsigned)__builtin_amdgcn_cvt_pk_fp8_f32(v1[2], v1[3], (int)w.y, true);
                        *(u32x2*)(rowp + bj * HALF) = w; } }
                __builtin_amdgcn_sched_barrier(0); }
    }
};
}
struct KArgs {
    const float* in[34];
    float* out;
    unsigned char* ws;
    int ph_lo, ph_hi;
};
struct Params {
    float* out;
    unsigned char* ws;
    LAS unsigned long long* ptab;
    int ph_lo, ph_hi;
    __device__ __forceinline__ const float* inp(int k) const {
        const unsigned long long v = ptab[k];
        const unsigned lo = __builtin_amdgcn_readfirstlane((unsigned)v), hi = __builtin_amdgcn_readfirstlane((unsigned)(v >> 32));
        return (const float*)(((unsigned long long)hi << 32) | lo);
    }
};
struct Ctx {
    LAS unsigned char* lds;
    int tid, lane, wave, G, bid;
    int gw, ngw;
};

__device__ __forceinline__ void tr_item(const float* W, int N, bf16_t* WT, int ldt, int k0, int n0, int orow0, LAS float* scr, int lane) {
#pragma unroll 8
    for (int i = 0; i < 32; ++i) { const int kk = 2 * i + (lane >> 5); scr[kk * 33 + (lane & 31)] = W[(size_t)(k0 + kk) * N + n0 + (lane & 31)]; }
    LDS_WAIT(); asm volatile("" ::: "memory");
    const int c = lane & 7;
#pragma unroll
    for (int j = 0; j < 4; ++j) { const int n = (lane >> 3) + 8 * j; const LAS float* s = scr + (8 * c) * 33 + n;
        u32x4 o; o.x = cvt_pk_bf16(s[0 * 33], s[1 * 33]); o.y = cvt_pk_bf16(s[2 * 33], s[3 * 33]); o.z = cvt_pk_bf16(s[4 * 33], s[5 * 33]); o.w = cvt_pk_bf16(s[6 * 33], s[7 * 33]);
        *(u32x4*)(WT + (size_t)(orow0 + n) * ldt + k0 + 8 * c) = o; }
    LDS_WAIT(); asm volatile("" ::: "memory");
}
__device__ __forceinline__ void tr_item64(const float* W, int N, bf16_t* WT, int ldt, int k0, int n0, int orow0, LAS float* scr, int lane) {
    f32x4 v[16];
    const float* src = W + (size_t)(k0 + (lane >> 4)) * N + n0 + 4 * (lane & 15);
#pragma unroll
    for (int i = 0; i < 16; ++i) v[i] = __builtin_nontemporal_load((const f32x4*)(src + (size_t)(4 * i) * N));
#pragma unroll
    for (int i = 0; i < 16; ++i) { LAS float* d = scr + (4 * i + (lane >> 4)) * 65 + 4 * (lane & 15); d[0] = v[i][0]; d[1] = v[i][1]; d[2] = v[i][2]; d[3] = v[i][3]; }
    LDS_WAIT(); asm volatile("" ::: "memory");
    const int c = lane & 7;
#pragma unroll
    for (int j = 0; j < 8; ++j) { const int n = (lane >> 3) + 8 * j; const LAS float* s = scr + (8 * c) * 65 + n;
        u32x4 o; o.x = cvt_pk_bf16(s[0 * 65], s[1 * 65]); o.y = cvt_pk_bf16(s[2 * 65], s[3 * 65]); o.z = cvt_pk_bf16(s[4 * 65], s[5 * 65]); o.w = cvt_pk_bf16(s[6 * 65], s[7 * 65]);
        *(u32x4*)(WT + (size_t)(orow0 + n) * ldt + k0 + 8 * c) = o; }
    LDS_WAIT(); asm volatile("" ::: "memory");
}
__device__ __forceinline__ void tr_item64_fp8(const float* W, int N, unsigned char* WT, int ldt, int k0, int n0, int orow0, LAS float* scr, int lane, float wscale = pg8::WSCALE) {
    f32x4 v[16];
    const float* src = W + (size_t)(k0 + (lane >> 4)) * N + n0 + 4 * (lane & 15);
#pragma unroll
    for (int i = 0; i < 16; ++i) v[i] = __builtin_nontemporal_load((const f32x4*)(src + (size_t)(4 * i) * N));
#pragma unroll
    for (int i = 0; i < 16; ++i) { LAS float* d = scr + (4 * i + (lane >> 4)) * 65 + 4 * (lane & 15); d[0] = v[i][0]; d[1] = v[i][1]; d[2] = v[i][2]; d[3] = v[i][3]; }
    LDS_WAIT(); asm volatile("" ::: "memory");
    const int c = lane & 3;
#pragma unroll
    for (int j = 0; j < 4; ++j) { const int n = (lane >> 2) + 16 * j; const LAS float* s = scr + (16 * c) * 65 + n;
        u32x4 o;
        o.x = (unsigned)__builtin_amdgcn_cvt_pk_fp8_f32(s[0 * 65] * wscale, s[1 * 65] * wscale, 0, false);   o.x = (unsigned)__builtin_amdgcn_cvt_pk_fp8_f32(s[2 * 65] * wscale, s[3 * 65] * wscale, (int)o.x, true);
        o.y = (unsigned)__builtin_amdgcn_cvt_pk_fp8_f32(s[4 * 65] * wscale, s[5 * 65] * wscale, 0, false);   o.y = (unsigned)__builtin_amdgcn_cvt_pk_fp8_f32(s[6 * 65] * wscale, s[7 * 65] * wscale, (int)o.y, true);
        o.z = (unsigned)__builtin_amdgcn_cvt_pk_fp8_f32(s[8 * 65] * wscale, s[9 * 65] * wscale, 0, false);   o.z = (unsigned)__builtin_amdgcn_cvt_pk_fp8_f32(s[10 * 65] * wscale, s[11 * 65] * wscale, (int)o.z, true);
        o.w = (unsigned)__builtin_amdgcn_cvt_pk_fp8_f32(s[12 * 65] * wscale, s[13 * 65] * wscale, 0, false); o.w = (unsigned)__builtin_amdgcn_cvt_pk_fp8_f32(s[14 * 65] * wscale, s[15 * 65] * wscale, (int)o.w, true);
        *(u32x4*)(WT + (size_t)(orow0 + n) * ldt + k0 + 16 * c) = o; }
    LDS_WAIT(); asm volatile("" ::: "memory");
}
__device__ __forceinline__ void tr_dense(const float* W, int K, int N, bf16_t* WT, int item, LAS float* scr, int lane) {
    const int nblk = N / 32, kb = item / nblk, nb = item % nblk;
    tr_item(W, N, WT, K, 64 * kb, 32 * nb, 32 * nb, scr, lane);
}

__device__ __forceinline__ void s5_tables(const Params& p, Ctx& C, int dir, int g) {
    LAS f32x2* PW = (LAS f32x2*)C.lds;
    LAS f32x2* BB = PW + 65 * 64;
    LAS f32x2* CX = BB + 64 * 16;
    const float* a_re = p.inp(11); const float* a_im = p.inp(12); const float* log_dt = p.inp(13);
    const float* b_re = p.inp(14); const float* b_im = p.inp(15); const float* c_re = p.inp(16); const float* c_im = p.inp(17);
    const int tid = C.tid;
    if (tid < 64) {
        const int pp = tid;
        const float dt = __expf(log_dt[dir * 64 + g]);
        const float are = a_re[(dir * 64 + g) * 64 + pp], aim = a_im[(dir * 64 + g) * 64 + pp];
        const float zr = are * dt, zi = aim * dt;
        const float mag = __expf(zr);
        double rev = (double)zi * 0.15915494309189535; rev -= floor(rev);
        const float cs = __builtin_amdgcn_cosf((float)rev), sn = __builtin_amdgcn_sinf((float)rev);
        const float abr = mag * cs, abi = mag * sn;
        const float den = are * are + aim * aim, nr = abr - 1.0f, ni = abi;
        const float fre = (nr * are + ni * aim) / den, fim = (ni * are - nr * aim) / den;
        float pr = 1.0f, pi = 0.0f;
#pragma unroll 1
        for (int n = 0; n <= 64; ++n) { PW[n * 64 + pp] = (f32x2){pr, pi}; const float t = pr * abr - pi * abi; pi = pr * abi + pi * abr; pr = t; }
        for (int j = 0; j < 16; ++j) { const float br = b_re[(g * 64 + pp) * 16 + j], bi = b_im[(g * 64 + pp) * 16 + j];
            BB[pp * 16 + j] = (f32x2){fre * br - fim * bi, fre * bi + fim * br}; }
    }
    for (int q = tid; q < 1024; q += NTHR) { const int i = q >> 6, pp = q & 63; CX[i * 64 + pp] = (f32x2){c_re[(g * 16 + i) * 64 + pp], c_im[(g * 16 + i) * 64 + pp]}; }
    __syncthreads();
    bf16_t* KN = (bf16_t*)(p.ws + WS_KN) + (size_t)(dir * 64 + g) * 16 * 1024;
    float* APOW = (float*)(p.ws + WS_APOW) + (size_t)(dir * 64 + g) * 64 * 128;
    float* AL = (float*)(p.ws + WS_AL) + (size_t)(dir * 64 + g) * 128;
#pragma unroll 1
    for (int q = 0; q < 32; ++q) { const int idx = tid + NTHR * q; const int n = idx >> 8, i = (idx >> 4) & 15, j = idx & 15;
        float s = 0.f;
#pragma unroll 4
        for (int pp = 0; pp < 64; ++pp) { const f32x2 c = CX[i * 64 + pp], w = PW[n * 64 + pp], b = BB[pp * 16 + j];
            const float gr = c.x * b.x - c.y * b.y, gi = c.x * b.y + c.y * b.x;
            s += gr * w.x - gi * w.y; }
        KN[(size_t)i * 1024 + n * 16 + j] = f2bf(s); }
    for (int q = tid; q < 4096; q += NTHR) { const int t = q >> 6, pp = q & 63; const f32x2 w = PW[(t + 1) * 64 + pp]; *(f32x2*)(APOW + (size_t)t * 128 + 2 * pp) = w; }
    if (tid < 64) { const f32x2 w = PW[64 * 64 + tid]; *(f32x2*)(AL + 2 * tid) = w; }
    { bf16_t* BBT = (bf16_t*)(p.ws + WS_BBT) + (size_t)(dir * 64 + g) * 128 * 16;
      for (int q = tid; q < 2048; q += NTHR) { const int pq = q >> 4, j = q & 15; const f32x2 b = BB[(pq & 63) * 16 + j]; BBT[q] = f2bf(pq < 64 ? b.x : b.y); } }
    if (dir == 0) { bf16_t* CCt = (bf16_t*)(p.ws + WS_CC) + (size_t)g * 16 * 128;
        for (int q = tid; q < 2048; q += NTHR) { const int i = q >> 7, pq = q & 127; const f32x2 c = CX[i * 64 + (pq & 63)]; CCt[i * 128 + pq] = f2bf(pq < 64 ? c.x : -c.y); } }
    __syncthreads();
}

__device__ __forceinline__ void phase_p0(const Params& p, Ctx& C) {
    for (int task = C.bid; task < 128; task += C.G) s5_tables(p, C, task >> 6, task & 63);
    {
        const int gt = C.bid * NTHR + C.tid, ngt = C.G * NTHR;
        float* R128 = (float*)(p.ws + WS_ROPE128); float* R64 = (float*)(p.ws + WS_ROPE64);
        for (int q = gt; q < 256 * 64 + 256 * 32; q += ngt) {
            int pos, i, half; float* dst;
            if (q < 256 * 64) { pos = q >> 6; i = q & 63; half = 64; dst = R128 + (size_t)q * 2; }
            else { const int r = q - 256 * 64; pos = r >> 5; i = r & 31; half = 32; dst = R64 + (size_t)r * 2; }
            const float freq = exp2f(-(float)i / (float)half * 13.287712379549449f);
            const float ang = (float)pos * freq;
            double rev = (double)ang * 0.15915494309189535; rev -= floor(rev);
            dst[0] = __builtin_amdgcn_cosf((float)rev); dst[1] = __builtin_amdgcn_sinf((float)rev);
        }
        bf16_t* RWT = (bf16_t*)(p.ws + WS_RWT); const float* rw = p.inp(26);
        for (int q = gt; q < 2 * 64 * DM; q += ngt) { const int L = q / (64 * DM), r = q % (64 * DM), e = r / DM, k = r % DM;
            const float w = rw[((size_t)L * DM + k) * 64 + e]; const bf16_t hi = f2bf(w); const bf16_t lo = f2bf(w - bf2f(hi));
            RWT[((size_t)(L * 2 + 0) * 64 + e) * DM + k] = hi; RWT[((size_t)(L * 2 + 1) * 64 + e) * DM + k] = lo; }
    }
    {
        const float* cvec = p.inp(1); const float* cctx = p.inp(3); const float* mw = p.inp(4);
        float* MODP = (float*)(p.ws + WS_MODP);
        for (int task = C.gw; task < 2 * 32 * 48; task += C.ngw) {
            const int L = task / (32 * 48), r = task % (32 * 48), kb = r / 48, cb = r % 48;
            const float sc = siluf_(cvec[64 * kb + C.lane]), sx = siluf_(cctx[64 * kb + C.lane]);
            f32x4 a0 = {0.f, 0.f, 0.f, 0.f}, a1 = {0.f, 0.f, 0.f, 0.f};
            const float* wp = mw + ((size_t)L * DM + 64 * kb) * 12288 + 256 * cb + 4 * C.lane;
#pragma unroll 8
            for (int kk = 0; kk < 64; ++kk) { const f32x4 w = *(const f32x4*)(wp + (size_t)kk * 12288);
                const float s0 = __shfl(sc, kk), s1 = __shfl(sx, kk);
                a0 += w * s0; a1 += w * s1; }
            *(f32x4*)(MODP + ((size_t)((L * 32 + kb) * 2 + 0)) * 12288 + 256 * cb + 4 * C.lane) = a0;
            *(f32x4*)(MODP + ((size_t)((L * 32 + kb) * 2 + 1)) * 12288 + 256 * cb + 4 * C.lane) = a1;
        }
    }
    {
        LAS float* scr = (LAS float*)(C.lds + C.wave * 17408);
        constexpr int J0 = (DM / 64) * (EV_IN / 64), J3 = (DM / 64) * (OD_IN / 64);
        for (int it = C.gw; it < J0 + J3; it += C.ngw) {
            const bool l1 = it >= J0; const int r = l1 ? it - J0 : it; const int N = l1 ? OD_IN : EV_IN; const int nblk = N / 64, kb = r / nblk, nb = r % nblk;
            tr_item64_fp8(p.inp(l1 ? 21 : 8), N, (unsigned char*)(p.ws + (l1 ? WS_WIN1 : WS_WIN0)), DM, 64 * kb, 64 * nb, 64 * nb, scr, C.lane, 32.0f);
        }
        LAS float* scr2 = (LAS float*)(C.lds + C.wave * 17408);
        constexpr int I1 = (DM / 64) * (DM / 32), I2 = (1024 / 64) * (1024 / 32), I4 = I1;
        for (int it = C.gw; it < I1 + I2 + I4; it += C.ngw) {
            int r = it;
            if (r < I1) { tr_dense(p.inp(9), DM, DM, (bf16_t*)(p.ws + WS_WOUT0), r, scr2, C.lane); continue; } r -= I1;
            if (r < I2) { tr_dense(p.inp(19), 1024, 1024, (bf16_t*)(p.ws + WS_WGLU), r, scr2, C.lane); continue; } r -= I2;
            tr_dense(p.inp(22), DM, DM, (bf16_t*)(p.ws + WS_WOUT1), r, scr2, C.lane);
        }
    }
}
__device__ __forceinline__ void phase_p1(const Params& p, Ctx& C) {
    const float* MODP = (const float*)(p.ws + WS_MODP); float* MODF = (float*)(p.ws + WS_MODF); const float* mb = p.inp(5);
    for (int q = C.bid * NTHR + C.tid; q < 2 * 2 * 12288; q += C.G * NTHR) { const int L = q / (2 * 12288), v = (q / 12288) & 1, col = q % 12288;
        float s = mb[L * 12288 + col];
        for (int kb = 0; kb < 32; ++kb) s += MODP[((size_t)((L * 32 + kb) * 2 + v)) * 12288 + col];
        MODF[q] = s; }
}
__device__ __forceinline__ const float* modv(const Params& p, int L, int v, int k) { return (const float*)(p.ws + WS_MODF) + (size_t)(L * 2 + v) * 12288 + k * DM; }

__device__ __forceinline__ void stage_vec(LAS float* dst, const float* src, int tid) { *(LAS f32x4*)(dst + 4 * tid) = *(const f32x4*)(src + 4 * tid); }
__device__ __forceinline__ void conv_item(const Params& p, Ctx& C, int L, int it) {
    LAS float* scr = (LAS float*)(C.lds + C.wave * 17408);
    unsigned char* GU = (unsigned char*)(p.ws + WS_GU) + (size_t)L * NEX1 * 1024 * DM; unsigned char* DT = (unsigned char*)(p.ws + WS_DT) + (size_t)L * NEX1 * DM * EHID;
    const int e = it / 768, r = it % 768, which = r >> 8, q = r & 255;
    if (which < 2) {
        const float* W = (e < 64) ? p.inp(28 + which) + ((size_t)(L * 64 + e)) * DM * EHID : p.inp(31 + which) + (size_t)L * DM * EHID;
        const int kb = q >> 3, nb = q & 7, n0 = 64 * nb;
        tr_item64_fp8(W, EHID, GU + (size_t)e * 1024 * DM, DM, 64 * kb, n0, 256 * (n0 >> 7) + (n0 & 127) + (which ? 128 : 0), scr, C.lane);
    } else {
        const float* W = (e < 64) ? p.inp(30) + ((size_t)(L * 64 + e)) * EHID * DM : p.inp(33) + (size_t)L * EHID * DM;
        const int kb = q >> 5, nb = q & 31;
        tr_item64_fp8(W, DM, DT + (size_t)e * DM * EHID, EHID, 64 * kb, 64 * nb, 64 * nb, scr, C.lane);
    }
}
__device__ __forceinline__ void conv_queue(const Params& p, Ctx& C, int quota) {
    unsigned* head = (unsigned*)(p.ws + WS_CTL) + CW_QUEUE + 128;
    const int batch = quota < 8 ? quota : 8;
    for (int done = 0; done < quota; done += batch) {
        int it0 = 0; if (C.lane == 0) it0 = (int)atomicAdd(head, (unsigned)batch);
        it0 = __builtin_amdgcn_readfirstlane(it0);
        if (it0 >= NEX1 * 768) break;
        for (int k = 0; k < batch && it0 + k < NEX1 * 768; ++k) conv_item(p, C, 1, it0 + k);
    }
}
__device__ __forceinline__ void phase_modulate(const Params& p, Ctx& C, int L) {
    unsigned char* XA8 = (unsigned char*)(p.ws + WS_XA);
    const float* X2 = (const float*)(p.ws + WS_HX2);
    LAS float* MV = (LAS float*)C.lds;
    for (int v = 0; v < 2; ++v) { stage_vec(MV + (v * 2 + 0) * DM, modv(p, L, v, 0), C.tid); stage_vec(MV + (v * 2 + 1) * DM, modv(p, L, v, 1), C.tid); }
    __syncthreads();
    for (int r = C.gw; r < TT; r += C.ngw) {
        const int v = r < CTXL ? 1 : 0;
        const float* src = (L == 0) ? (r < CTXL ? p.inp(2) + (size_t)r * DM : p.inp(0) + (size_t)(r - CTXL) * DM) : X2 + (size_t)r * DM;
        const LAS float* sh = MV + (v * 2 + 0) * DM; const LAS float* sc = MV + (v * 2 + 1) * DM;
#pragma unroll
        for (int j = 0; j < 8; ++j) { const int c = 4 * (C.lane + 64 * j);
            const f32x4 x = *(const f32x4*)(src + c), a = *(const LAS f32x4*)(sc + c), b = *(const LAS f32x4*)(sh + c);
            const f32x4 y = x * (a + 1.0f) + b;
            unsigned w = (unsigned)__builtin_amdgcn_cvt_pk_fp8_f32(y[0], y[1], 0, false); w = (unsigned)__builtin_amdgcn_cvt_pk_fp8_f32(y[2], y[3], (int)w, true);
            *(unsigned*)(XA8 + (size_t)r * DM + c) = w; }
    }
    __syncthreads();
    if (L == 0) { for (int it = C.gw; it < NEX1 * 768; it += C.ngw) conv_item(p, C, 0, it); }
    else conv_queue(p, C, 1 << 30);
}

__device__ __forceinline__ void phase_rope0(const Params& p, Ctx& C) {
    bf16_t* QKV = (bf16_t*)(p.ws + WS_BIG + BG_QKV);
    const f32x2* R128 = (const f32x2*)(p.ws + WS_ROPE128);
    for (int r = C.gw; r < TT; r += C.ngw) {
        bf16_t* row = QKV + (size_t)r * EV_IN;
        if (r < CTXL) {
#pragma unroll
            for (int j = 0; j < 2; ++j) { u32x4* q = (u32x4*)(row + 8 * (C.lane + 64 * j)); u32x4 w = *q;
                w.x = cvt_pk_bf16(bflo(w.x) * 0.0625f, bfhi(w.x) * 0.0625f); w.y = cvt_pk_bf16(bflo(w.y) * 0.0625f, bfhi(w.y) * 0.0625f);
                w.z = cvt_pk_bf16(bflo(w.z) * 0.0625f, bfhi(w.z) * 0.0625f); w.w = cvt_pk_bf16(bflo(w.w) * 0.0625f, bfhi(w.w) * 0.0625f); *q = w; }
        } else {
            const int l = r - CTXL, rp = l >> 6, cp = l & 63;
#pragma unroll
            for (int qk = 0; qk < 2; ++qk)
#pragma unroll
                for (int m = 0; m < 8; ++m) { const int pi = C.lane + 64 * m, head = pi >> 7, blk = (pi >> 6) & 1, i = pi & 63;
                    bf16_t* b = row + qk * 1024 + head * 256 + blk * 128 + i;
                    const f32x2 cs = R128[(blk ? cp : rp) * 64 + i];
                    const float x1 = bf2f(b[0]), x2 = bf2f(b[64]); const float sc = qk ? 1.0f : 0.0625f;
                    b[0] = f2bf((x1 * cs.x - x2 * cs.y) * sc); b[64] = f2bf((x1 * cs.y + x2 * cs.x) * sc); }
        }
    }
}

__device__ __forceinline__ void phase_normrope1(const Params& p, Ctx& C) {
    bf16_t* QKV = (bf16_t*)(p.ws + WS_BIG + BG_QKV);
    const f32x2* R64 = (const f32x2*)(p.ws + WS_ROPE64);
    const float* qg = p.inp(23);
    unsigned* KMAX = (unsigned*)(p.ws + WS_CTL) + CW_KMAX;
    const int lane = C.lane, i32 = lane & 31; const bool up = lane >= 32;
    const float g00 = qg[lane], g01 = qg[64 + lane], g10 = qg[128 + lane], g11 = qg[128 + 64 + lane];
    for (int r = C.gw; r < TT; r += C.ngw) {
        bf16_t* row = QKV + (size_t)r * OD_IN;
        const bool lat = r >= CTXL; const int l = r - CTXL, rp = lat ? (l >> 6) : 0, cp = lat ? (l & 63) : 0;
        const f32x2 cr = R64[rp * 32 + i32], cc = R64[cp * 32 + i32];
#pragma unroll 2
        for (int h = 0; h < 26; ++h) {
            const int col = h < 8 ? 128 * h : (h < 10 ? 1024 + 128 * (h - 8) : (h < 18 ? 1536 + 128 * (h - 10) : 2560 + 128 * (h - 18)));
            bf16_t* b = row + col;
            float v0 = bf2f(b[lane]), v1 = bf2f(b[64 + lane]);
            if (h < 10) { const float ss = wave_sum(v0 * v0 + v1 * v1); const float rs = rsqrtf(ss * (1.0f / 128.0f) + LN_EPS);
                v0 = bf2f(f2bf(v0 * rs)) * (h < 8 ? g00 : g10); v1 = bf2f(f2bf(v1 * rs)) * (h < 8 ? g01 : g11); }
            if (lat) { const float p0 = __shfl_xor(v0, 32), p1 = __shfl_xor(v1, 32);
                v0 = up ? (p0 * cr.y + v0 * cr.x) : (v0 * cr.x - p0 * cr.y);
                v1 = up ? (p1 * cc.y + v1 * cc.x) : (v1 * cc.x - p1 * cc.y); }
            const bf16_t o0 = f2bf(v0), o1 = f2bf(v1);
            b[lane] = o0; b[64 + lane] = o1;
            if ((h >= 8 && h < 10) || h >= 18) {
                const float w0 = bf2f(o0), w1 = bf2f(o1); const float k2 = wave_sum(w0 * w0 + w1 * w1);
                if (lane == 0) atomicMax(KMAX + 64 * (h < 10 ? h - 8 : h - 16), __float_as_uint(k2)); }
        }
    }
}

__device__ __forceinline__ void phase_merge1(const Params& p, Ctx& C) {
    bf16_t* ATT = (bf16_t*)(p.ws + WS_BIG + BG_ATT);
    const float* dl = p.inp(24); const float* sg = p.inp(25);
    const int lane = C.lane;
    float d0 = dl[lane] * dl[128 + lane] + dl[64 + lane] * dl[128 + 64 + lane];
    float d1 = dl[256 + lane] * dl[384 + lane] + dl[256 + 64 + lane] * dl[384 + 64 + lane];
    const float lam = __expf(wave_sum(d0)) - __expf(wave_sum(d1)) + LAMBDA_INIT;
    const f32x4 gg = *(const f32x4*)(sg + 4 * lane);
    for (int l = C.gw; l < SEQ; l += C.ngw) {
        bf16_t* row = ATT + (size_t)l * 3072;
#pragma unroll
        for (int h = 0; h < 4; ++h) {
            const u32x2 a = *(const u32x2*)(row + 1024 + 256 * h + 4 * lane), b = *(const u32x2*)(row + 2048 + 256 * h + 4 * lane);
            f32x4 o = {bflo(a.x) - lam * bflo(b.x), bfhi(a.x) - lam * bfhi(b.x), bflo(a.y) - lam * bflo(b.y), bfhi(a.y) - lam * bfhi(b.y)};
            const float ss = wave_sum(o[0] * o[0] + o[1] * o[1] + o[2] * o[2] + o[3] * o[3]);
            const float rs = rsqrtf(ss * (1.0f / 256.0f) + LN_EPS) * (1.0f - LAMBDA_INIT);
            o = o * rs * gg;
            u32x2 w; w.x = cvt_pk_bf16(o[0], o[1]); w.y = cvt_pk_bf16(o[2], o[3]);
            *(u32x2*)(row + 1024 + 256 * h + 4 * lane) = w;
        }
    }
}

__device__ __forceinline__ void phase_ln1(const Params& p, Ctx& C, int L) {
    const bf16_t* Y = (const bf16_t*)(p.ws + WS_YMIX); float* X1 = (float*)(p.ws + WS_X1); unsigned char* XA8 = (unsigned char*)(p.ws + WS_XA);
    const float* X2 = (const float*)(p.ws + WS_HX2);
    const float* lg = p.inp(6) + (size_t)(L * 2 + 0) * DM; const float* lb = p.inp(7) + (size_t)(L * 2 + 0) * DM;
    const int r0 = (L == 0) ? 0 : CTXL;
    LAS float* MV = (LAS float*)C.lds; LAS float* LG = MV + 6 * DM; LAS float* LB = LG + DM;
    for (int v = 0; v < 2; ++v) for (int k = 0; k < 3; ++k) stage_vec(MV + (v * 3 + k) * DM, modv(p, L, v, 2 + k), C.tid);
    stage_vec(LG, lg, C.tid); stage_vec(LB, lb, C.tid);
    __syncthreads();
    for (int r = r0 + C.gw; r < TT; r += C.ngw) {
        const int v = r < CTXL ? 1 : 0;
        const float* src = (L == 0) ? (r < CTXL ? p.inp(2) + (size_t)r * DM : p.inp(0) + (size_t)(r - CTXL) * DM) : X2 + (size_t)r * DM;
        const LAS float* g1 = MV + (v * 3 + 0) * DM; const LAS float* sh2 = MV + (v * 3 + 1) * DM; const LAS float* sc2 = MV + (v * 3 + 2) * DM;
        f32x4 t[8]; float s = 0.f;
#pragma unroll
        for (int j = 0; j < 8; ++j) { const int c = 4 * (C.lane + 64 * j);
            const f32x4 x = *(const f32x4*)(src + c), g = *(const LAS f32x4*)(g1 + c); const u32x2 yy = *(const u32x2*)(Y + (size_t)r * DM + c);
            const f32x4 y = {bflo(yy.x), bfhi(yy.x), bflo(yy.y), bfhi(yy.y)};
            t[j] = x * ALPHA + g * y; s += (t[j][0] + t[j][1]) + (t[j][2] + t[j][3]); }
        const float mean = wave_sum(s) * (1.0f / DM); float s2 = 0.f;
#pragma unroll
        for (int j = 0; j < 8; ++j) { t[j] = t[j] - mean; s2 += (t[j][0] * t[j][0] + t[j][1] * t[j][1]) + (t[j][2] * t[j][2] + t[j][3] * t[j][3]); }
        const float rstd = rsqrtf(wave_sum(s2) * (1.0f / DM) + LN_EPS);
#pragma unroll
        for (int j = 0; j < 8; ++j) { const int c = 4 * (C.lane + 64 * j);
            const f32x4 x1 = t[j] * rstd * *(const LAS f32x4*)(LG + c) + *(const LAS f32x4*)(LB + c);
            *(f32x4*)(X1 + (size_t)r * DM + c) = x1;
            const f32x4 z = x1 * (*(const LAS f32x4*)(sc2 + c) + 1.0f) + *(const LAS f32x4*)(sh2 + c);
            unsigned w = (unsigned)__builtin_amdgcn_cvt_pk_fp8_f32(z[0], z[1], 0, false); w = (unsigned)__builtin_amdgcn_cvt_pk_fp8_f32(z[2], z[3], (int)w, true);
            *(unsigned*)(XA8 + (size_t)r * DM + c) = w; }
    }
    __syncthreads();
}

__device__ __forceinline__ void phase_combine(const Params& p, Ctx& C, int L, LAS unsigned char* misc) {
    const unsigned char* YM = (const unsigned char*)(p.ws + WS_BIG + BG_YMOE); const float* X1 = (const float*)(p.ws + WS_X1);
    float* X2 = (float*)(p.ws + WS_HX2);
    const float* lg = p.inp(6) + (size_t)(L * 2 + 1) * DM; const float* lb = p.inp(7) + (size_t)(L * 2 + 1) * DM;
    const unsigned* PK = (const unsigned*)(p.ws + WS_WGT); const int* cnt = (const int*)(p.ws + WS_CTL) + CW_CNT + L * 128;
    const int r0 = (L == 0) ? 0 : CTXL;
    LAS int* rb = (LAS int*)(misc + 64);
    LAS float* MV = (LAS float*)C.lds; LAS float* LG = MV + 2 * DM; LAS float* LB = LG + DM;
    __syncthreads();
    if (C.tid == 0) { int q = 0; for (int e = 0; e < NEX1; ++e) { rb[e] = q; q += cnt[e]; } }
    stage_vec(MV, modv(p, L, 0, 5), C.tid); stage_vec(MV + DM, modv(p, L, 1, 5), C.tid); stage_vec(LG, lg, C.tid); stage_vec(LB, lb, C.tid);
    __syncthreads();
    for (int r = r0 + C.gw; r < TT; r += C.ngw) {
        const int v = r < CTXL ? 1 : 0;
        const LAS float* g2 = MV + v * DM;
        int ln = C.lane; asm volatile("" : "+v"(ln));
        int slot = rb[64] + (r - r0);
        if (ln < 8) { const unsigned pk = PK[(size_t)r * 8 + ln]; slot = rb[pk >> 16] + (int)(pk & 0xffffu); }
        f32x4 t[2][4]; float s = 0.f;
#pragma unroll
        for (int j = 0; j < 2; ++j) { const int c = 16 * (ln + 64 * j);
            u32x4 yy[9];
#pragma unroll
            for (int k = 0; k < 9; ++k) { const size_t a = (size_t)__builtin_amdgcn_readlane(slot, k); yy[k] = __builtin_nontemporal_load((const u32x4*)(YM + a * DM + c)); }
            f32x2 f[8];
#pragma unroll
            for (int q = 0; q < 8; ++q) f[q] = (f32x2){0.f, 0.f};
#pragma unroll
            for (int k = 0; k < 9; ++k) {
                f[0] += __builtin_amdgcn_cvt_pk_f32_fp8((int)yy[k].x, false); f[1] += __builtin_amdgcn_cvt_pk_f32_fp8((int)yy[k].x, true);
                f[2] += __builtin_amdgcn_cvt_pk_f32_fp8((int)yy[k].y, false); f[3] += __builtin_amdgcn_cvt_pk_f32_fp8((int)yy[k].y, true);
                f[4] += __builtin_amdgcn_cvt_pk_f32_fp8((int)yy[k].z, false); f[5] += __builtin_amdgcn_cvt_pk_f32_fp8((int)yy[k].z, true);
                f[6] += __builtin_amdgcn_cvt_pk_f32_fp8((int)yy[k].w, false); f[7] += __builtin_amdgcn_cvt_pk_f32_fp8((int)yy[k].w, true); }
#pragma unroll
            for (int q = 0; q < 4; ++q) { const f32x4 x = *(const f32x4*)(X1 + (size_t)r * DM + c + 4 * q), g = *(const LAS f32x4*)(g2 + c + 4 * q);
                const f32x4 ff = {f[2 * q][0], f[2 * q][1], f[2 * q + 1][0], f[2 * q + 1][1]};
                t[j][q] = x * ALPHA + g * ff; s += (t[j][q][0] + t[j][q][1]) + (t[j][q][2] + t[j][q][3]); } }
        const float mean = wave_sum(s) * (1.0f / DM); float s2 = 0.f;
#pragma unroll
        for (int j = 0; j < 2; ++j)
#pragma unroll
            for (int q = 0; q < 4; ++q) { t[j][q] = t[j][q] - mean; s2 += (t[j][q][0] * t[j][q][0] + t[j][q][1] * t[j][q][1]) + (t[j][q][2] * t[j][q][2] + t[j][q][3] * t[j][q][3]); }
        const float rstd = rsqrtf(wave_sum(s2) * (1.0f / DM) + LN_EPS);
        float* dst = (L == 0) ? X2 + (size_t)r * DM : p.out + (size_t)(r - CTXL) * DM;
#pragma unroll
        for (int j = 0; j < 2; ++j)
#pragma unroll
            for (int q = 0; q < 4; ++q) { const int c = 16 * (ln + 64 * j) + 4 * q;
                *(f32x4*)(dst + c) = t[j][q] * rstd * *(const LAS f32x4*)(LG + c) + *(const LAS f32x4*)(LB + c); }
    }
}
constexpr int RLD = 264;
constexpr int SLD = 136;

template <bool SCALE>
__device__ __forceinline__ void stage_chunk(const bf16_t* QKV, int row0, int col0, LAS bf16_t* dst, int tid, float lg  , int dirb) {
#pragma unroll
    for (int q = 0; q < 8; ++q) { const int idx = tid + NTHR * q, r = idx >> 5, c = idx & 31;
        u32x4 w = *(const u32x4*)(QKV + (size_t)(row0 + r) * EV_IN + col0 + 8 * c);
        if (SCALE) { const float sc = fast_exp((dirb ? (float)r : (float)(127 - r)) * lg);
            w.x = cvt_pk_bf16(bflo(w.x) * sc, bfhi(w.x) * sc); w.y = cvt_pk_bf16(bflo(w.y) * sc, bfhi(w.y) * sc);
            w.z = cvt_pk_bf16(bflo(w.z) * sc, bfhi(w.z) * sc); w.w = cvt_pk_bf16(bflo(w.w) * sc, bfhi(w.w) * sc); }
        *(LAS u32x4*)(dst + r * RLD + 8 * c) = w; }
}

__device__ __forceinline__ void ret_chunk_kv(const Params& p, Ctx& C) {
    const bf16_t* QKV = (const bf16_t*)(p.ws + WS_BIG + BG_QKV); bf16_t* CKV = (bf16_t*)(p.ws + WS_BIG + BG_CKV);
    const float* rld = p.inp(10);
    LAS bf16_t* Vs = (LAS bf16_t*)C.lds; LAS bf16_t* Ks = Vs + 128 * RLD;
    const int lane = C.lane, w = C.wave;
    for (int unit = C.bid; unit < 130 * 8; unit += C.G) {
        const int u = unit >> 3, h = (unit >> 1) & 3, dir = unit & 1;
        const float lg = rld[dir * 4 + h];
        __syncthreads();
        stage_chunk<false>(QKV, 128 * u, 2048 + 256 * h, Vs, C.tid, 0.f, 0);
        stage_chunk<true>(QKV, 128 * u, 1024 + 256 * h, Ks, C.tid, lg, dir);
        __syncthreads();
        f32x4 acc[2][16];
#pragma unroll
        for (int a = 0; a < 2; ++a)
#pragma unroll
            for (int b = 0; b < 16; ++b) acc[a][b] = (f32x4){0.f, 0.f, 0.f, 0.f};
        const unsigned vbase = (unsigned)(uintptr_t)Vs, kbase = (unsigned)(uintptr_t)Ks;
#pragma unroll 1
        for (int ks = 0; ks < 4; ++ks) {
            bf16x8 af[2];
#pragma unroll
            for (int a = 0; a < 2; ++a) af[a] = frag_colk_l(vbase + (unsigned)((32 * ks) * RLD + 32 * w + 16 * a) * 2u, RLD * 2, lane);
#pragma unroll
            for (int b = 0; b < 16; ++b) { const bf16x8 bf = frag_colk_l(kbase + (unsigned)((32 * ks) * RLD + 16 * b) * 2u, RLD * 2, lane);
                acc[0][b] = MFMA16(bf, af[0], acc[0][b]); acc[1][b] = MFMA16(bf, af[1], acc[1][b]); }
        }
        bf16_t* dst = CKV + ((size_t)((dir * 4 + h) * 130 + u)) * 65536;
#pragma unroll
        for (int a = 0; a < 2; ++a)
#pragma unroll
            for (int b = 0; b < 16; ++b) { u32x2 w2; w2.x = cvt_pk_bf16(acc[a][b][0], acc[a][b][1]); w2.y = cvt_pk_bf16(acc[a][b][2], acc[a][b][3]);
                *(u32x2*)(dst + (size_t)(32 * w + 16 * a + (lane & 15)) * 256 + 16 * b + 4 * (lane >> 4)) = w2; }
    }
    __syncthreads();
}

__device__ __forceinline__ int s5_row(int dir, int c, int s) { return dir == 0 ? 64 * c + s : (c < 4 ? 255 - (64 * c + s) : 16639 - 64 * (c - 4) - s); }

__device__ __forceinline__ void s5_end_states(const Params& p, Ctx& C) {
    const bf16_t* QKV = (const bf16_t*)(p.ws + WS_BIG + BG_QKV); const bf16_t* BBT = (const bf16_t*)(p.ws + WS_BBT); float* E = (float*)(p.ws + WS_S5E);
    const float* APOW = (const float*)(p.ws + WS_APOW);
    LAS f32x2* PL = (LAS f32x2*)C.lds;
    for (int bt = C.bid; bt < 256; bt += C.G) {
        int tid = C.tid; asm volatile("" : "+v"(tid));
        const int lane = tid & 63, r32 = lane & 31, hi = lane >> 5;
        const int dg = bt >> 1, dir = dg >> 6, g = dg & 63, c0 = 130 * (bt & 1);
        __syncthreads();
#pragma unroll
        for (int q = 0; q < 8; ++q) { const int idx = tid + NTHR * q, s = idx >> 6, pp = idx & 63;
            PL[idx] = (s == 63) ? (f32x2){1.0f, 0.0f} : *(const f32x2*)(APOW + ((size_t)dg * 64 + (62 - s)) * 128 + 2 * pp); }
        __syncthreads();
        bf16x8 bfr[4];
#pragma unroll
        for (int pt = 0; pt < 4; ++pt) bfr[pt] = *(const bf16x8*)(BBT + ((size_t)dg * 128 + 32 * pt + r32) * 16 + 8 * hi);
        for (int c = c0 + C.wave; c < c0 + 130; c += 8) {
            float er[2] = {0.f, 0.f}, ei[2] = {0.f, 0.f};
#pragma unroll
            for (int st = 0; st < 2; ++st) {
                const bf16x8 a = *(const bf16x8*)(QKV + (size_t)s5_row(dir, c, 32 * st + r32) * EV_IN + 4096 + 16 * g + 8 * hi);
                f32x16 d[4];
#pragma unroll
                for (int pt = 0; pt < 4; ++pt) d[pt] = __builtin_amdgcn_mfma_f32_32x32x16_bf16(a, bfr[pt], (f32x16){}, 0, 0, 0);
#pragma unroll
                for (int r = 0; r < 16; ++r) { const int s = 32 * st + (r & 3) + 8 * (r >> 2) + 4 * hi;
#pragma unroll
                    for (int pt = 0; pt < 2; ++pt) { const f32x2 pw = PL[s * 64 + 32 * pt + r32]; const float br = d[pt][r], bi = d[pt + 2][r];
                        er[pt] += pw.x * br - pw.y * bi; ei[pt] += pw.x * bi + pw.y * br; } }
            }
#pragma unroll
            for (int pt = 0; pt < 2; ++pt) {
                { auto rr = __builtin_amdgcn_permlane32_swap(__float_as_uint(er[pt]), __float_as_uint(er[pt]), false, false); er[pt] = __uint_as_float(rr[0]) + __uint_as_float(rr[1]); }
                { auto rr = __builtin_amdgcn_permlane32_swap(__float_as_uint(ei[pt]), __float_as_uint(ei[pt]), false, false); ei[pt] = __uint_as_float(rr[0]) + __uint_as_float(rr[1]); }
            }
            float* dst = E + ((size_t)dg * 260 + c) * 128;
            if (hi == 0) { dst[r32] = er[0]; dst[32 + r32] = er[1]; dst[64 + r32] = ei[0]; dst[96 + r32] = ei[1]; }
        }
    }
    __syncthreads();
}

__device__ __forceinline__ void phase_scans(const Params& p, Ctx& C) {
    const bf16_t* CKV = (const bf16_t*)(p.ws + WS_BIG + BG_CKV); bf16_t* SP = (bf16_t*)(p.ws + WS_BIG + BG_SPREV);
    const float* rld = p.inp(10);
    for (int q = C.bid * NTHR + C.tid; q < 8 * 16384; q += C.G * NTHR) {
        const int dh = q >> 14, el = (q & 16383) * 4, dir = dh >> 2, h = dh & 3;
        const float gch = fast_exp(128.0f * rld[dir * 4 + h]);
        const bf16_t* src = CKV + (size_t)dh * 130 * 65536 + el; bf16_t* dst = SP + (size_t)dh * 130 * 65536 + el;
        f32x4 s = {0.f, 0.f, 0.f, 0.f};
        for (int st0 = 0; st0 < 130; st0 += 13) {
            u32x2 kv[13];
#pragma unroll
            for (int k = 0; k < 13; ++k) { const int st = st0 + k; const int u = dir == 0 ? st : (st == 0 ? 1 : (st == 1 ? 0 : 131 - st)); kv[k] = __builtin_nontemporal_load((const u32x2*)(src + (size_t)u * 65536)); }
#pragma unroll
            for (int k = 0; k < 13; ++k) { const int st = st0 + k; const int u = dir == 0 ? st : (st == 0 ? 1 : (st == 1 ? 0 : 131 - st));
                u32x2 w; w.x = cvt_pk_bf16(s[0], s[1]); w.y = cvt_pk_bf16(s[2], s[3]); *(u32x2*)(dst + (size_t)u * 65536) = w;
                s = s * gch + (f32x4){bflo(kv[k].x), bfhi(kv[k].x), bflo(kv[k].y), bfhi(kv[k].y)}; }
        }
    }
    const float* E = (const float*)(p.ws + WS_S5E); float* HST = (float*)(p.ws + WS_HST); const float* AL = (const float*)(p.ws + WS_AL);
    for (int q = C.bid * NTHR + C.tid; q < 2 * 64 * 64; q += C.G * NTHR) {
        const int dg = q >> 6, pp = q & 63;
        const f32x2 al = *(const f32x2*)(AL + (size_t)dg * 128 + 2 * pp);
        const float* e = E + (size_t)dg * 260 * 128; float* hs = HST + (size_t)dg * 260 * 128;
        float hr = 0.f, hi = 0.f;
        for (int c0 = 0; c0 < 260; c0 += 26) {
            float er[26], ei[26];
#pragma unroll
            for (int k = 0; k < 26; ++k) { er[k] = e[(size_t)(c0 + k) * 128 + pp]; ei[k] = e[(size_t)(c0 + k) * 128 + 64 + pp]; }
#pragma unroll
            for (int k = 0; k < 26; ++k) { *(f32x2*)(hs + (size_t)(c0 + k) * 128 + 2 * pp) = (f32x2){hr, hi};
                const float t = al.x * hr - al.y * hi + er[k]; hi = al.x * hi + al.y * hr + ei[k]; hr = t; }
        }
    }
}

__device__ __forceinline__ void ret_output_unit(const Params& p, Ctx& C, int unit) {
    const bf16_t* QKV = (const bf16_t*)(p.ws + WS_BIG + BG_QKV); const bf16_t* SP = (const bf16_t*)(p.ws + WS_BIG + BG_SPREV);
    bf16_t* MIX = (bf16_t*)(p.ws + WS_BIG + BG_MIX);
    const float* rld = p.inp(10);
    LAS bf16_t* RA = (LAS bf16_t*)C.lds; LAS bf16_t* RB = RA + 128 * RLD;
    int tid = C.tid; asm volatile("" : "+v"(tid));
    const int lane = tid & 63, w = C.wave, kq = lane >> 4, fr = lane & 15;
    const int u = unit >> 2, h = unit & 3;
    const float lgf = rld[h], lgb = rld[4 + h];
    stage_chunk<false>(QKV, 128 * u, 256 * h, RA, tid, 0.f, 0);
    int ib = 16 * w + 4 * kq, jb = fr; asm volatile("" : "+v"(ib), "+v"(jb));
    f32x4 acc[16];
#pragma unroll
    for (int t = 0; t < 16; ++t) acc[t] = (f32x4){0.f, 0.f, 0.f, 0.f};
#pragma unroll
    for (int dir = 0; dir < 2; ++dir) {
        const bf16_t* Sd = SP + ((size_t)((dir * 4 + h) * 130 + u)) * 65536;
#pragma unroll
        for (int eh = 0; eh < 2; ++eh) {
            __syncthreads();
#pragma unroll
            for (int q = 0; q < 8; ++q) { const int idx = tid + NTHR * q, rr = idx >> 5, c = idx & 31;
                *(LAS u32x4*)(RB + rr * RLD + 8 * c) = *(const u32x4*)(Sd + (size_t)(128 * eh + rr) * 256 + 8 * c);
                if (q == 3) asm volatile("" ::: "memory"); }
            __syncthreads();
#pragma unroll 1
            for (int ks = 0; ks < 8; ++ks) { const bf16x8 af = frag_rowk_l(RA + (16 * w) * RLD + 32 * ks, RLD, lane);
#pragma unroll
                for (int t = 0; t < 8; ++t) { const bf16x8 bf = frag_rowk_l(RB + (16 * t) * RLD + 32 * ks, RLD, lane); acc[8 * eh + t] = MFMA16(af, bf, acc[8 * eh + t]); } }
        }
#pragma unroll
        for (int r = 0; r < 4; ++r) { const int i = ib + r; const float qd = fast_exp((float)(128 - i) * lgb);
            const float f = (dir == 0) ? fast_exp((float)(i + 1) * lgf) / qd : qd;
#pragma unroll
            for (int t = 0; t < 16; ++t) acc[t][r] *= f; }
    }
    __syncthreads();
    stage_chunk<false>(QKV, 128 * u, 1024 + 256 * h, RB, tid, 0.f, 0);
    __syncthreads();
    f32x4 sc[8];
#pragma unroll
    for (int t = 0; t < 8; ++t) sc[t] = (f32x4){0.f, 0.f, 0.f, 0.f};
#pragma unroll 1
    for (int ks = 0; ks < 8; ++ks) { const bf16x8 af = frag_rowk_l(RA + (16 * w) * RLD + 32 * ks, RLD, lane);
#pragma unroll
        for (int t = 0; t < 8; ++t) { const bf16x8 bf = frag_rowk_l(RB + (16 * t) * RLD + 32 * ks, RLD, lane); sc[t] = MFMA16(af, bf, sc[t]); } }
#pragma unroll
    for (int t = 0; t < 8; ++t)
#pragma unroll
        for (int r = 0; r < 4; ++r) { const int i = ib + r, j = 16 * t + jb; const float d = (float)(i - j);
            const float m = (i >= j ? fast_exp(d * lgf) : 0.f) + (j >= i ? fast_exp(-d * lgb) : 0.f); sc[t][r] *= m; }
    __syncthreads();
    stage_chunk<false>(QKV, 128 * u, 2048 + 256 * h, RA, tid, 0.f, 0);
#pragma unroll
    for (int t = 0; t < 8; ++t)
#pragma unroll
        for (int r = 0; r < 4; ++r) RB[(16 * w + 4 * kq + r) * SLD + 16 * t + fr] = f2bf(sc[t][r]);
    __syncthreads();
    const unsigned vbase = (unsigned)(uintptr_t)RA;
#pragma unroll 1
    for (int ks = 0; ks < 4; ++ks) { const bf16x8 af = frag_rowk_l(RB + (16 * w) * SLD + 32 * ks, SLD, lane);
#pragma unroll
        for (int t = 0; t < 16; ++t) { const bf16x8 bf = frag_colk_l(vbase + (unsigned)((32 * ks) * RLD + 16 * t) * 2u, RLD * 2, lane); acc[t] = MFMA16(af, bf, acc[t]); } }
    __syncthreads();
#pragma unroll
    for (int r = 0; r < 4; ++r) {
        float s = 0.f;
#pragma unroll
        for (int t = 0; t < 16; ++t) s += acc[t][r];
        s += __shfl_xor(s, 1); s += __shfl_xor(s, 2); s += __shfl_xor(s, 4); s += __shfl_xor(s, 8);
        const float mean = s * (1.0f / 256.0f); float q = 0.f;
#pragma unroll
        for (int t = 0; t < 16; ++t) { const float d = acc[t][r] - mean; q += d * d; }
        q += __shfl_xor(q, 1); q += __shfl_xor(q, 2); q += __shfl_xor(q, 4); q += __shfl_xor(q, 8);
        const float rstd = rsqrtf(q * (1.0f / 256.0f) + LN_EPS);
#pragma unroll
        for (int t = 0; t < 16; ++t) RA[(16 * w + 4 * kq + r) * RLD + 16 * t + fr] = f2bf((acc[t][r] - mean) * rstd);
    }
    __syncthreads();
#pragma unroll
    for (int q = 0; q < 8; ++q) { const int idx = tid + NTHR * q, rr = idx >> 5, c = idx & 31; const size_t row = (size_t)(128 * u + rr);
        const u32x4 o = *(const LAS u32x4*)(RA + rr * RLD + 8 * c), g = *(const u32x4*)(QKV + row * EV_IN + 3072 + 256 * h + 8 * c);
        u32x4 w4;
        w4.x = cvt_pk_bf16(bflo(o.x) * siluf_(bflo(g.x)), bfhi(o.x) * siluf_(bfhi(g.x))); w4.y = cvt_pk_bf16(bflo(o.y) * siluf_(bflo(g.y)), bfhi(o.y) * siluf_(bfhi(g.y)));
        w4.z = cvt_pk_bf16(bflo(o.z) * siluf_(bflo(g.z)), bfhi(o.z) * siluf_(bfhi(g.z))); w4.w = cvt_pk_bf16(bflo(o.w) * siluf_(bflo(g.w)), bfhi(o.w) * siluf_(bfhi(g.w)));
        *(u32x4*)(MIX + row * DM + 256 * h + 8 * c) = w4; }
    __syncthreads();
}

constexpr int KLD = 1032;
__device__ __forceinline__ void s5_output_task(const Params& p, Ctx& C, int bt) {
    const bf16_t* QKV = (const bf16_t*)(p.ws + WS_BIG + BG_QKV); bf16_t* Z = (bf16_t*)(p.ws + WS_Z);
    const bf16_t* KN = (const bf16_t*)(p.ws + WS_KN); const bf16_t* CCt = (const bf16_t*)(p.ws + WS_CC);
    const float* APOW = (const float*)(p.ws + WS_APOW); const float* HST = (const float*)(p.ws + WS_HST); const float* dsk = p.inp(18);
    int tid = C.tid; asm volatile("" : "+v"(tid));
    const int lane = tid & 63, kq = lane >> 4, fr = lane & 15;
    LAS bf16_t* KF = (LAS bf16_t*)C.lds; LAS bf16_t* KB = KF + 16 * KLD;
    LAS bf16_t* U = KB + 16 * KLD + C.wave * 3072;
    LAS float* PW0 = (LAS float*)(KB + 16 * KLD + 8 * 3072);
    LAS float* PW16 = PW0 + 2 * 16 * 128;
    {
        const int g = bt >> 3, k0 = (260 * (bt & 7)) >> 3, k1 = (260 * ((bt & 7) + 1)) >> 3;
#pragma unroll
        for (int q = 0; q < 8; ++q) { const int idx = tid + NTHR * q, dir = idx >> 11, rr = (idx >> 7) & 15, c = idx & 127;
            *(LAS u32x4*)((dir ? KB : KF) + rr * KLD + 8 * c) = *(const u32x4*)(KN + ((size_t)(dir * 64 + g) * 16 + rr) * 1024 + 8 * c); }
        for (int q = lane; q < 192 * 2; q += 64) *(LAS u32x4*)(U + 8 * q) = (u32x4){0u, 0u, 0u, 0u};
#pragma unroll
        for (int q = 0; q < 2; ++q) { const int idx = tid + NTHR * q, dir = idx >> 9, f = (idx >> 5) & 15, c4 = idx & 31;
            *(LAS f32x4*)(PW0 + dir * 2048 + f * 128 + 4 * c4) = *(const f32x4*)(APOW + ((size_t)(dir * 64 + g) * 64 + (dir == 0 ? f : 15 - f)) * 128 + 4 * c4); }
        if (tid < 64) { const int dir = tid >> 5, c4 = tid & 31; *(LAS f32x4*)(PW16 + dir * 128 + 4 * c4) = *(const f32x4*)(APOW + ((size_t)(dir * 64 + g) * 64 + 15) * 128 + 4 * c4); }
        __syncthreads();
        const f32x4 dv = *(const f32x4*)(dsk + 16 * g + 4 * kq);
        bf16x8 ccr[2], cci[2];
#pragma unroll
        for (int hb = 0; hb < 2; ++hb) { ccr[hb] = frag_rowk_g(CCt + (size_t)g * 16 * 128 + 32 * hb, 128, lane); cci[hb] = frag_rowk_g(CCt + (size_t)g * 16 * 128 + 64 + 32 * hb, 128, lane); }
        const LAS float* pw0l = PW0 + (size_t)fr * 128 + 16 * kq;
        const LAS float* pw16l = PW16 + 16 * kq;
        for (int k = k0 + C.wave; k < k1; k += 8) {
            LDS_WAIT(); asm volatile("" ::: "memory");
            for (int q = lane; q < 128; q += 64) { const int t = q >> 1, hf = q & 1;
                *(LAS u32x4*)(U + (64 + t) * 16 + 8 * hf) = *(const u32x4*)(QKV + (size_t)(64 * k + t) * EV_IN + 4096 + 16 * g + 8 * hf); }
            LDS_WAIT(); asm volatile("" ::: "memory");
            const int cf = k, cb = k < 4 ? 3 - k : 263 - k;
            f32x4 acc[4];
#pragma unroll
            for (int tt = 0; tt < 4; ++tt) acc[tt] = (f32x4){0.f, 0.f, 0.f, 0.f};
            const LAS bf16_t* ubf = U + (64 + fr - (kq >> 1)) * 16 + 8 * (kq & 1);
            const LAS bf16_t* ubb = U + (64 + fr + (kq >> 1)) * 16 + 8 * (kq & 1);
#pragma unroll
            for (int n0 = 0; n0 < 64; n0 += 2) {
                const bf16x8 af = frag_rowk_l(KF + n0 * 16, KLD, lane), ab = frag_rowk_l(KB + n0 * 16, KLD, lane);
#pragma unroll
                for (int tt = 0; tt < 4; ++tt) {
                    if (n0 <= 16 * tt + 14) acc[tt] = MFMA16(af, *(const LAS bf16x8*)(ubf + (16 * tt - n0) * 16), acc[tt]);
                    if (n0 <= 62 - 16 * tt) acc[tt] = MFMA16(ab, *(const LAS bf16x8*)(ubb + (16 * tt + n0) * 16), acc[tt]);
                }
                asm volatile("" ::: "memory");
            }
#pragma unroll
            for (int dir = 0; dir < 2; ++dir) {
                const float* hp = HST + ((size_t)(dir * 64 + g) * 260 + (dir == 0 ? cf : cb)) * 128;
#pragma unroll
                for (int hb = 0; hb < 2; ++hb) {
                    float xr[8], xi[8];
#pragma unroll
                    for (int e2 = 0; e2 < 4; ++e2) { const f32x4 h4 = *(const f32x4*)(hp + 2 * (32 * hb + 8 * kq) + 4 * e2), b4 = *(const LAS f32x4*)(pw0l + dir * 2048 + hb * 64 + 4 * e2);
                        xr[2 * e2] = b4[0] * h4[0] - b4[1] * h4[1]; xi[2 * e2] = b4[0] * h4[1] + b4[1] * h4[0];
                        xr[2 * e2 + 1] = b4[2] * h4[2] - b4[3] * h4[3]; xi[2 * e2 + 1] = b4[2] * h4[3] + b4[3] * h4[2]; }
#pragma unroll
                    for (int st = 0; st < 4; ++st) {
                        const int tt = dir == 0 ? st : 3 - st;
                        u32x4 br, bi;
                        br.x = cvt_pk_bf16(xr[0], xr[1]); br.y = cvt_pk_bf16(xr[2], xr[3]); br.z = cvt_pk_bf16(xr[4], xr[5]); br.w = cvt_pk_bf16(xr[6], xr[7]);
                        bi.x = cvt_pk_bf16(xi[0], xi[1]); bi.y = cvt_pk_bf16(xi[2], xi[3]); bi.z = cvt_pk_bf16(xi[4], xi[5]); bi.w = cvt_pk_bf16(xi[6], xi[7]);
                        acc[tt] = MFMA16(ccr[hb], __builtin_bit_cast(bf16x8, br), acc[tt]);
                        acc[tt] = MFMA16(cci[hb], __builtin_bit_cast(bf16x8, bi), acc[tt]);
                        if (st < 3) {
#pragma unroll
                            for (int e2 = 0; e2 < 4; ++e2) { const f32x4 a4 = *(const LAS f32x4*)(pw16l + dir * 128 + hb * 64 + 4 * e2);
                                float t0 = xr[2 * e2] * a4[0] - xi[2 * e2] * a4[1]; xi[2 * e2] = xr[2 * e2] * a4[1] + xi[2 * e2] * a4[0]; xr[2 * e2] = t0;
                                t0 = xr[2 * e2 + 1] * a4[2] - xi[2 * e2 + 1] * a4[3]; xi[2 * e2 + 1] = xr[2 * e2 + 1] * a4[3] + xi[2 * e2 + 1] * a4[2]; xr[2 * e2 + 1] = t0; }
                        }
                    }
                }
            }
#pragma unroll
            for (int tt = 0; tt < 4; ++tt) { const int t = 16 * tt + fr;
                const u32x2 uu = *(const LAS u32x2*)(U + (64 + t) * 16 + 4 * kq);
                const float y0 = acc[tt][0] + bflo(uu.x) * dv[0], y1 = acc[tt][1] + bfhi(uu.x) * dv[1], y2 = acc[tt][2] + bflo(uu.y) * dv[2], y3 = acc[tt][3] + bfhi(uu.y) * dv[3];
                u32x2 w; w.x = cvt_pk_bf16(gelu_tanh(y0), gelu_tanh(y1)); w.y = cvt_pk_bf16(gelu_tanh(y2), gelu_tanh(y3));
                *(u32x2*)(Z + (size_t)(64 * k + t) * 1024 + 16 * g + 4 * kq) = w; }
        }
    }
    __syncthreads();
}

__device__ __forceinline__ void phase_ret_s5_outputs(const Params& p, Ctx& C, LAS unsigned char* misc) {
    unsigned* head = (unsigned*)(p.ws + WS_CTL) + CW_QUEUE;
    volatile LAS int* slot = (volatile LAS int*)(misc + 32);
    for (;;) {
        __syncthreads();
        if (C.tid == 0) slot[0] = (int)atomicAdd(head, 1u);
        __syncthreads();
        const int item = __builtin_amdgcn_readfirstlane(slot[0]);
        if (item >= 520) break;
        ret_output_unit(p, C, item);
    }
    for (;;) {
        __syncthreads();
        if (C.tid == 0) slot[0] = (int)atomicAdd(head + 64, 1u);
        __syncthreads();
        const int item = __builtin_amdgcn_readfirstlane(slot[0]);
        if (item >= 512) break;
        s5_output_task(p, C, item);
    }
}
__device__ __forceinline__ void phase_router(const Params& p, Ctx& C, int L) {
    const float* X1 = (const float*)(p.ws + WS_X1);
    const bf16_t* RWh = (const bf16_t*)(p.ws + WS_RWT) + (size_t)(L * 2 + 0) * 64 * DM; const bf16_t* RWl = (const bf16_t*)(p.ws + WS_RWT) + (size_t)(L * 2 + 1) * 64 * DM;
    const float* rbias = p.inp(27) + L * 64;
    int* cnt = (int*)(p.ws + WS_CTL) + CW_CNT + L * 128; int* LIST = (int*)(p.ws + WS_LIST); unsigned* PK = (unsigned*)(p.ws + WS_WGT); float* LW = (float*)(p.ws + WS_LW);
    const int lane = C.lane, kq = lane >> 4, fr = lane & 15;
    LAS float* Lg = (LAS float*)(C.lds + C.wave * 8192);
    const int r0 = (L == 0) ? 0 : CTXL, nrows = TT - r0;
    if (C.bid == 0 && C.tid == 0) cnt[64] = nrows;
    for (int task = C.gw; task < nrows / 16; task += C.ngw) {
        const int rbase = r0 + 16 * task, row = rbase + fr;
        const int v = row < CTXL ? 1 : 0;
        const float* xr = X1 + (size_t)row * DM; const float* sc2 = modv(p, L, v, 4); const float* sh2 = modv(p, L, v, 3);
        f32x4 acc[4];
#pragma unroll
        for (int t = 0; t < 4; ++t) acc[t] = (f32x4){0.f, 0.f, 0.f, 0.f};
#pragma unroll 2
        for (int ks = 0; ks < 64; ++ks) { const int c0 = 32 * ks + 8 * kq;
            const f32x4 x0 = *(const f32x4*)(xr + c0), x1 = *(const f32x4*)(xr + c0 + 4);
            const f32x4 a0 = *(const f32x4*)(sc2 + c0), a1 = *(const f32x4*)(sc2 + c0 + 4), b0 = *(const f32x4*)(sh2 + c0), b1 = *(const f32x4*)(sh2 + c0 + 4);
            const f32x4 y0 = x0 * (a0 + 1.0f) + b0, y1 = x1 * (a1 + 1.0f) + b1;
            u32x4 hi; hi.x = cvt_pk_bf16(y0[0], y0[1]); hi.y = cvt_pk_bf16(y0[2], y0[3]); hi.z = cvt_pk_bf16(y1[0], y1[1]); hi.w = cvt_pk_bf16(y1[2], y1[3]);
            u32x4 lo; lo.x = cvt_pk_bf16(y0[0] - bflo(hi.x), y0[1] - bfhi(hi.x)); lo.y = cvt_pk_bf16(y0[2] - bflo(hi.y), y0[3] - bfhi(hi.y));
            lo.z = cvt_pk_bf16(y1[0] - bflo(hi.z), y1[1] - bfhi(hi.z)); lo.w = cvt_pk_bf16(y1[2] - bflo(hi.w), y1[3] - bfhi(hi.w));
            const bf16x8 ah = __builtin_bit_cast(bf16x8, hi), al = __builtin_bit_cast(bf16x8, lo);
#pragma unroll
            for (int t = 0; t < 4; ++t) { const bf16x8 bh = frag_rowk_g(RWh + (size_t)(16 * t) * DM + 32 * ks, DM, lane), bl = frag_rowk_g(RWl + (size_t)(16 * t) * DM + 32 * ks, DM, lane);
                acc[t] = MFMA16(ah, bh, acc[t]); acc[t] = MFMA16(al, bh, acc[t]); acc[t] = MFMA16(ah, bl, acc[t]); } }
        LDS_WAIT(); asm volatile("" ::: "memory");
#pragma unroll
        for (int t = 0; t < 4; ++t)
#pragma unroll
            for (int r = 0; r < 4; ++r) Lg[(4 * kq + r) * 65 + 16 * t + fr] = acc[t][r];
        LDS_WAIT(); asm volatile("" ::: "memory");
        if (lane < 16) {
            LAS float* sr = Lg + lane * 65; const int trow = rbase + lane;
            float gs[8];
#pragma unroll
            for (int g = 0; g < 8; ++g) { float m1 = -1e30f, m2 = -1e30f;
                for (int j = 0; j < 8; ++j) { const int e = 8 * g + j; const float s = sigmoidf_(sr[e]); sr[e] = s; const float vv = s + rbias[e];
                    if (vv > m1) { m2 = m1; m1 = vv; } else if (vv > m2) m2 = vv; }
                gs[g] = m1 + m2; }
            unsigned gmask = 0u;
#pragma unroll
            for (int it = 0; it < 4; ++it) { float best = -1e30f; int bi = 0;
#pragma unroll
                for (int g = 0; g < 8; ++g) { const bool ok = !((gmask >> g) & 1u) && gs[g] > best; best = ok ? gs[g] : best; bi = ok ? g : bi; }
                gmask |= 1u << bi; }
            unsigned long long taken = 0ull; int sel[8]; float sw[8]; float wsum = 0.f;
#pragma unroll
            for (int k = 0; k < 8; ++k) { float best = -1e30f; int bi = 0;
                for (int e = 0; e < 64; ++e) { const bool cand = ((gmask >> (e >> 3)) & 1u) && !((taken >> e) & 1ull); const float vv = sr[e] + rbias[e];
                    if (cand && vv > best) { best = vv; bi = e; } }
                taken |= 1ull << bi; sel[k] = bi; sw[k] = sr[bi]; wsum += sw[k]; }
            const float inv = 2.5f / wsum;
#pragma unroll
            for (int k = 0; k < 8; ++k) { const int a = trow * 8 + k; const int pos = atomicAdd(&cnt[sel[k]], 1);
                LIST[(size_t)sel[k] * TT + pos] = a; PK[a] = ((unsigned)sel[k] << 16) | (unsigned)pos; LW[(size_t)sel[k] * TT + pos] = sw[k] * inv; }
            LIST[(size_t)64 * TT + (trow - r0)] = 8 * TT + trow; LW[(size_t)64 * TT + (trow - r0)] = 1.0f;
        }
    }
}
namespace att {
constexpr int D = 128, NW = 8, QBLK = 32, KVBLK = 64;
constexpr float SCALE = 0.088388347648318440f;
constexpr float THR = 8.f;
constexpr int SHM_V = KVBLK * D * 2, SHM_K = KVBLK * D * 2, SHM_ATTN = 2 * SHM_V + 2 * SHM_K + NW * 64 * 4;
#define KSWZ(row, colB) ((row) * 256 + ((colB) ^ (((row) & 7) << 4)))
#define SBAR() __builtin_amdgcn_sched_barrier(0)
__device__ __forceinline__ int crow(int r, int hi) { return (r & 3) + 8 * (r >> 2) + 4 * hi; }
__device__ __forceinline__ unsigned cvtpk(float lo, float hi) { unsigned r; asm volatile("v_cvt_pk_bf16_f32 %0, %1, %2" : "=v"(r) : "v"(lo), "v"(hi)); return r; }

__device__ __forceinline__ void partialSM(f32x16& p0, f32x16& p1, float negMC) {
  constexpr float Cc = SCALE * 1.4426950408889634f;
  for (int r = 0; r < 16; ++r) p0[r] = fmaf(p0[r], Cc, negMC); for (int r = 0; r < 16; ++r) p1[r] = fmaf(p1[r], Cc, negMC);
  for (int r = 0; r < 16; ++r) p0[r] = __builtin_amdgcn_exp2f(p0[r]);
}
__device__ __forceinline__ void finishSM(f32x16& p0, f32x16& p1, float& l_reg, bf16x8& pa0, bf16x8& pa1, bf16x8& pa2, bf16x8& pa3) {
  for (int r = 0; r < 16; ++r) p1[r] = __builtin_amdgcn_exp2f(p1[r]);
  float ps = 0; for (int r = 0; r < 16; ++r) ps += p0[r]; for (int r = 0; r < 16; ++r) ps += p1[r];
  { auto rr = __builtin_amdgcn_permlane32_swap(__float_as_uint(ps), __float_as_uint(ps), false, false);
    ps = __uint_as_float(rr[0]) + __uint_as_float(rr[1]); }
  l_reg += ps;
#define PK4(P, BASE, OUT) do { unsigned a0 = cvtpk(P[BASE + 0], P[BASE + 1]), a1 = cvtpk(P[BASE + 2], P[BASE + 3]);   \
    unsigned b0 = cvtpk(P[BASE + 4], P[BASE + 5]), b1 = cvtpk(P[BASE + 6], P[BASE + 7]);                              \
    auto r0 = __builtin_amdgcn_permlane32_swap(a0, b0, false, false); auto r1 = __builtin_amdgcn_permlane32_swap(a1, b1, false, false); \
    u32x4 w = {r0[0], r1[0], r0[1], r1[1]}; OUT = *reinterpret_cast<bf16x8*>(&w); } while (0)
  PK4(p0, 0, pa0); PK4(p0, 8, pa1); PK4(p1, 0, pa2); PK4(p1, 8, pa3);
#undef PK4
}
__device__ __forceinline__ void qkt(f32x16& p0, f32x16& p1, const LAS char* Ks, const bf16x8* qr, int r32, int hi) {
  p0 = f32x16{}; p1 = f32x16{};
  for (int d0 = 0; d0 < 8; ++d0) { int cb = (d0 * 16 + hi * 8) * 2;
    bf16x8 b0 = *reinterpret_cast<const LAS bf16x8*>(Ks + KSWZ(r32, cb));
    bf16x8 b1 = *reinterpret_cast<const LAS bf16x8*>(Ks + KSWZ(32 + r32, cb));
    p0 = __builtin_amdgcn_mfma_f32_32x32x16_bf16(b0, qr[d0], p0, 0, 0, 0);
    p1 = __builtin_amdgcn_mfma_f32_32x32x16_bf16(b1, qr[d0], p1, 0, 0, 0); }
}
__device__ __forceinline__ int v_st(int k, int c) { const int kk = (k & ~0xC) | ((k & 4) << 1) | ((k & 8) >> 1); return ((kk >> 3) * 4 + (c >> 5)) * 512 + ((kk & 7) * 32 + (c & 31)) * 2; }
__device__ __forceinline__ int v_rd_base(int lane) { return ((lane & 3) << 3) | (((lane >> 2) & 3) << 6) | (((lane >> 4) & 1) << 5) | (((lane >> 5) & 1) << 8); }
constexpr int v_rd_off(int d0, int ks, int half) { return d0 * 512 + ks * 4096 + half * 2048; }
template <int OFF> __device__ __forceinline__ s16x4 tr_read(int vb) {
  s16x4 r; asm volatile("ds_read_b64_tr_b16 %0, %1 offset:%2" : "=&v"(r) : "v"(vb), "i"(OFF) : "memory"); return r;
}
template <int D0> __device__ __forceinline__ void pv_one(f32x16& od, int vb, bf16x8 pa0, bf16x8 pa1, bf16x8 pa2, bf16x8 pa3) {
  const s16x4 l0 = tr_read<v_rd_off(D0, 0, 0)>(vb), h0 = tr_read<v_rd_off(D0, 0, 1)>(vb), l1 = tr_read<v_rd_off(D0, 1, 0)>(vb), h1 = tr_read<v_rd_off(D0, 1, 1)>(vb);
  const s16x4 l2 = tr_read<v_rd_off(D0, 2, 0)>(vb), h2 = tr_read<v_rd_off(D0, 2, 1)>(vb), l3 = tr_read<v_rd_off(D0, 3, 0)>(vb), h3 = tr_read<v_rd_off(D0, 3, 1)>(vb);
  asm volatile("s_waitcnt lgkmcnt(0)" ::: "memory"); SBAR();
#define PK(L, H) (bf16x8){L[0], L[1], L[2], L[3], H[0], H[1], H[2], H[3]}
  od = __builtin_amdgcn_mfma_f32_32x32x16_bf16(pa0, PK(l0, h0), od, 0, 0, 0);
  od = __builtin_amdgcn_mfma_f32_32x32x16_bf16(pa1, PK(l1, h1), od, 0, 0, 0);
  od = __builtin_amdgcn_mfma_f32_32x32x16_bf16(pa2, PK(l2, h2), od, 0, 0, 0);
  od = __builtin_amdgcn_mfma_f32_32x32x16_bf16(pa3, PK(l3, h3), od, 0, 0, 0);
#undef PK
}
__device__ __forceinline__ void pv_d0(f32x16* o, int vb, bf16x8 pa0, bf16x8 pa1, bf16x8 pa2, bf16x8 pa3) {
  pv_one<0>(o[0], vb, pa0, pa1, pa2, pa3); pv_one<1>(o[1], vb, pa0, pa1, pa2, pa3); pv_one<2>(o[2], vb, pa0, pa1, pa2, pa3); pv_one<3>(o[3], vb, pa0, pa1, pa2, pa3);
}

template <int LDQ, int LDK, int LDO>
__device__ __forceinline__ void attn_dense_body(const bf16_t* __restrict__ Qb, const bf16_t* __restrict__ Kh, const bf16_t* __restrict__ Vh, bf16_t* __restrict__ Ob, int seq, LAS char* lds, int tid, float kmax2) {
  const int wid = tid >> 6, lane = tid & 63, r32 = lane & 31, hi = lane >> 5;
  LAS char* V_lds = lds; LAS char* K_lds = lds + 2 * SHM_V;
  LAS float* ws = (LAS float*)(lds + 2 * SHM_V + 2 * SHM_K) + wid * 64; LAS float* li_l = ws;
  float l_reg = 0; f32x16 o[4] = {}; bf16x8 qr[8];
  const bf16_t* Qw = Qb + (long)(wid * QBLK + r32) * LDQ + hi * 8;
#pragma unroll
  for (int d0 = 0; d0 < 8; ++d0) qr[d0] = *reinterpret_cast<const bf16x8*>(Qw + d0 * 16);
  float negMC;
  { float q2 = 0.f;
#pragma unroll
    for (int d0 = 0; d0 < 8; ++d0) { const u32x4 w = __builtin_bit_cast(u32x4, qr[d0]);
      q2 += bflo(w.x) * bflo(w.x) + bfhi(w.x) * bfhi(w.x) + bflo(w.y) * bflo(w.y) + bfhi(w.y) * bfhi(w.y) + bflo(w.z) * bflo(w.z) + bfhi(w.z) * bfhi(w.z) + bflo(w.w) * bflo(w.w) + bfhi(w.w) * bfhi(w.w); }
    auto rr = __builtin_amdgcn_permlane32_swap(__float_as_uint(q2), __float_as_uint(q2), false, false);
    q2 = __uint_as_float(rr[0]) + __uint_as_float(rr[1]);
    negMC = -(sqrtf(q2 * kmax2) * (SCALE * 1.0001f) - 30.0f) * 1.4426950408889634f; }
  const int sr = tid >> 4, sc = (tid & 15) * 8, vst0 = v_st(sr, sc), vst1 = v_st(32 + sr, sc);
  const int vb0 = (int)(uintptr_t)V_lds + v_rd_base(lane);
  struct { bf16x8 vs0, vs1, ks0, ks1; } sr_[2];
#define SLOAD(i, k0) do { sr_[i].vs0 = *reinterpret_cast<const bf16x8*>(&Vh[(long)((k0) + sr) * LDK + sc]); sr_[i].vs1 = *reinterpret_cast<const bf16x8*>(&Vh[(long)((k0) + 32 + sr) * LDK + sc]); \
    sr_[i].ks0 = *reinterpret_cast<const bf16x8*>(&Kh[(long)((k0) + sr) * LDK + sc]); sr_[i].ks1 = *reinterpret_cast<const bf16x8*>(&Kh[(long)((k0) + 32 + sr) * LDK + sc]); } while (0)
#define SWRITE(b, i) do { *(LAS bf16x8*)(V_lds + (b) * SHM_V + vst0) = sr_[i].vs0;          \
    *(LAS bf16x8*)(V_lds + (b) * SHM_V + vst1) = sr_[i].vs1; int kc = sc * 2;               \
    *(LAS bf16x8*)(K_lds + (b) * SHM_K + KSWZ(sr, kc)) = sr_[i].ks0;                       \
    *(LAS bf16x8*)(K_lds + (b) * SHM_K + KSWZ(32 + sr, kc)) = sr_[i].ks1; } while (0)
#define SWAIT() asm volatile("s_waitcnt vmcnt(4)" ::: "memory")
  f32x16 pA0, pA1, pB0, pB1; bf16x8 pa0, pa1, pa2, pa3; const int NT = seq / KVBLK;
  constexpr int SE = 0, SO = 1;
  SLOAD(SE, 0); asm volatile("s_waitcnt vmcnt(0)" ::: "memory"); SWRITE(0, SE); __syncthreads();
  qkt(pA0, pA1, K_lds, qr, r32, hi); partialSM(pA0, pA1, negMC);
  SLOAD(SO, KVBLK); if (2 < NT) SLOAD(SE, 2 * KVBLK);
  SWAIT(); SWRITE(1, SO); __syncthreads();
  for (int j = 1; j + 1 < NT; j += 2) {
    SBAR(); qkt(pB0, pB1, K_lds + SHM_K, qr, r32, hi);
    finishSM(pA0, pA1, l_reg, pa0, pa1, pa2, pa3); SBAR();
    SLOAD(SO, (j + 2) * KVBLK); SBAR();
    pv_d0(o, vb0, pa0, pa1, pa2, pa3); partialSM(pB0, pB1, negMC);
    __syncthreads(); SWAIT(); SWRITE(0, SE);
    __syncthreads();
    SBAR(); qkt(pA0, pA1, K_lds, qr, r32, hi);
    finishSM(pB0, pB1, l_reg, pa0, pa1, pa2, pa3); SBAR();
    if (j + 3 < NT) SLOAD(SE, (j + 3) * KVBLK); SBAR();
    pv_d0(o, vb0 + (int)SHM_V, pa0, pa1, pa2, pa3); partialSM(pA0, pA1, negMC);
    __syncthreads(); SWAIT(); SWRITE(1, SO);
    __syncthreads();
  }
  SBAR(); qkt(pB0, pB1, K_lds + SHM_K, qr, r32, hi);
  finishSM(pA0, pA1, l_reg, pa0, pa1, pa2, pa3); SBAR();
  pv_d0(o, vb0, pa0, pa1, pa2, pa3); partialSM(pB0, pB1, negMC);
  __syncthreads();
  finishSM(pB0, pB1, l_reg, pa0, pa1, pa2, pa3); SBAR();
  pv_d0(o, vb0 + (int)SHM_V, pa0, pa1, pa2, pa3);
  if (hi == 0) li_l[r32] = l_reg; asm volatile("s_waitcnt lgkmcnt(0)" ::: "memory");
  float rli[16];
#pragma unroll
  for (int r = 0; r < 16; ++r) rli[r] = __builtin_amdgcn_rcpf(li_l[crow(r, hi)]);
  bf16_t* Ow = Ob + (long)(wid * QBLK) * LDO;
#pragma unroll
  for (int r = 0; r < 16; ++r) { int orow = crow(r, hi);
    for (int d0 = 0; d0 < 4; ++d0) Ow[(long)orow * LDO + d0 * 32 + r32] = (bf16_t)(cvtpk(o[d0][r] * rli[r], 0.f) & 0xffffu); }
#undef SLOAD
#undef SWRITE
#undef SWAIT
}

constexpr int PV_BUF = 32768, PK_BUF = 16384, P_LDS_V = 0, P_LDS_K = 2 * PV_BUF, P_LDS_X = P_LDS_K + 2 * PK_BUF, P_LDS_L = P_LDS_X + 8 * 2048, P_LDS_END = P_LDS_L + 1024;
__device__ __forceinline__ void qkt_half(f32x16& p, const LAS char* Ks, const bf16x8* qr, int krow, int hi) {
  p = f32x16{};
  for (int d0 = 0; d0 < 8; ++d0) { int cb = (d0 * 16 + hi * 8) * 2;
    bf16x8 b0 = *reinterpret_cast<const LAS bf16x8*>(Ks + KSWZ(krow, cb));
    p = __builtin_amdgcn_mfma_f32_32x32x16_bf16(b0, qr[d0], p, 0, 0, 0); }
}
__device__ __forceinline__ void smA(f32x16& p, float negMC) {
  constexpr float Cc = SCALE * 1.4426950408889634f;
  for (int r = 0; r < 16; ++r) p[r] = fmaf(p[r], Cc, negMC);
  for (int r = 0; r < 8; ++r) p[r] = __builtin_amdgcn_exp2f(p[r]);
}
__device__ __forceinline__ void smB(f32x16& p, float& l_reg, bf16x8& f0, bf16x8& f1) {
  for (int r = 8; r < 16; ++r) p[r] = __builtin_amdgcn_exp2f(p[r]);
  float ps = 0; for (int r = 0; r < 16; ++r) ps += p[r];
  { auto rr = __builtin_amdgcn_permlane32_swap(__float_as_uint(ps), __float_as_uint(ps), false, false);
    ps = __uint_as_float(rr[0]) + __uint_as_float(rr[1]); }
  l_reg += ps;
#define PK4(P, BASE, OUT) do { unsigned a0 = cvtpk(P[BASE + 0], P[BASE + 1]), a1 = cvtpk(P[BASE + 2], P[BASE + 3]);   \
    unsigned b0 = cvtpk(P[BASE + 4], P[BASE + 5]), b1 = cvtpk(P[BASE + 6], P[BASE + 7]);                              \
    auto r0 = __builtin_amdgcn_permlane32_swap(a0, b0, false, false); auto r1 = __builtin_amdgcn_permlane32_swap(a1, b1, false, false); \
    u32x4 w = {r0[0], r1[0], r0[1], r1[1]}; OUT = *reinterpret_cast<bf16x8*>(&w); } while (0)
  PK4(p, 0, f0); PK4(p, 8, f1);
#undef PK4
}
template <int LDQ, int LDK, int LDO>
__device__ __forceinline__ void attn_pair_body(const bf16_t* __restrict__ Qb, const bf16_t* __restrict__ Kh, const bf16_t* __restrict__ Vh, bf16_t* __restrict__ Ob, int seq, LAS char* lds, int tid, float kmax2) {
  const int wid = __builtin_amdgcn_readfirstlane(tid >> 6), lane = tid & 63, r32 = lane & 31, hi = lane >> 5, g = wid & 3, kb = wid >> 2;
  LAS char* V_lds = lds + P_LDS_V; LAS char* K_lds = lds + P_LDS_K;
  LAS char* xp_own = lds + P_LDS_X + wid * 2048 + lane * 16; LAS char* xp_par = lds + P_LDS_X + (wid ^ 4) * 2048 + lane * 16;
  LAS float* li = (LAS float*)(lds + P_LDS_L);
  float l_reg = 0; f32x16 o[4] = {}; bf16x8 qr[8];
  const bf16_t* Qw = Qb + (long)(g * QBLK + r32) * LDQ + hi * 8;
#pragma unroll
  for (int d0 = 0; d0 < 8; ++d0) qr[d0] = *reinterpret_cast<const bf16x8*>(Qw + d0 * 16);
  float negMC;
  { float q2 = 0.f;
#pragma unroll
    for (int d0 = 0; d0 < 8; ++d0) { const u32x4 w = __builtin_bit_cast(u32x4, qr[d0]);
      q2 += bflo(w.x) * bflo(w.x) + bfhi(w.x) * bfhi(w.x) + bflo(w.y) * bflo(w.y) + bfhi(w.y) * bfhi(w.y) + bflo(w.z) * bflo(w.z) + bfhi(w.z) * bfhi(w.z) + bflo(w.w) * bflo(w.w) + bfhi(w.w) * bfhi(w.w); }
    auto rr = __builtin_amdgcn_permlane32_swap(__float_as_uint(q2), __float_as_uint(q2), false, false);
    q2 = __uint_as_float(rr[0]) + __uint_as_float(rr[1]);
    negMC = -(sqrtf(q2 * kmax2) * (SCALE * 1.0001f) - 30.0f) * 1.4426950408889634f; }
  const int sr = tid >> 4, sc = (tid & 15) * 8, vst0 = v_st(sr, sc), vst1 = v_st(32 + sr, sc);
  const int vrd = (int)(uintptr_t)V_lds + kb * 16384 + v_rd_base(lane);
  const int krow = 32 * kb + r32;
  struct { bf16x8 v00, v01, v10, v11, k0, k1; } st_;
#define PLD16(base, off) (*reinterpret_cast<const bf16x8*>((const char*)(base) + (off)))
#define PLOAD(k0_) do { const unsigned o_ = (unsigned)(((k0_) + sr) * LDK + sc) * 2u; \
    st_.v00 = PLD16(Vh, o_); st_.v01 = PLD16(Vh, o_ + 256u); st_.v10 = PLD16(Vh, o_ + 64u * LDK); st_.v11 = PLD16(Vh, o_ + 64u * LDK + 256u); \
    st_.k0 = PLD16(Kh, o_); st_.k1 = PLD16(Kh, o_ + 64u * LDK); } while (0)
#define PWRITE(kbuf, vbuf) do { LAS char* vb_ = V_lds + (vbuf) * PV_BUF; LAS char* kb_ = K_lds + (kbuf) * PK_BUF; const int kc = sc * 2; \
    *(LAS bf16x8*)(vb_ + vst0) = st_.v00; *(LAS bf16x8*)(vb_ + 16384 + vst0) = st_.v01; *(LAS bf16x8*)(vb_ + vst1) = st_.v10; *(LAS bf16x8*)(vb_ + 16384 + vst1) = st_.v11; \
    *(LAS bf16x8*)(kb_ + KSWZ(sr, kc)) = st_.k0; *(LAS bf16x8*)(kb_ + KSWZ(32 + sr, kc)) = st_.k1; } while (0)
  const int NT = seq / KVBLK;
  f32x16 pS; bf16x8 f0, f1, g0, g1;
  PLOAD(0); asm volatile("s_waitcnt vmcnt(0)" ::: "memory"); PWRITE(0, 0); PLOAD(KVBLK);
  __syncthreads();
  for (int j = 0; j < NT; ++j) {
    SBAR();
    qkt_half(pS, K_lds + (j & 1) * PK_BUF, qr, krow, hi);
    smA(pS, negMC); smB(pS, l_reg, f0, f1); SBAR();
    *(LAS bf16x8*)(xp_own) = f0; *(LAS bf16x8*)(xp_own + 1024) = f1;
    if (j + 1 < NT) PWRITE((j + 1) & 1, (j + 1) & 1);
    if (j + 2 < NT) PLOAD((j + 2) * KVBLK);
    __syncthreads();
    g0 = *(const LAS bf16x8*)(xp_par); g1 = *(const LAS bf16x8*)(xp_par + 1024);
    { const int vb = vrd + (j & 1) * PV_BUF;
      if (kb == 0) pv_d0(o, vb, f0, f1, g0, g1); else pv_d0(o, vb, g0, g1, f0, f1); }
    __syncthreads();
  }
  if (hi == 0) li[wid * 32 + r32] = l_reg;
  __syncthreads();
#pragma unroll
  for (int r = 0; r < 16; ++r) { const int orow = crow(r, hi); const float rl = __builtin_amdgcn_rcpf(li[wid * 32 + orow] + li[(wid ^ 4) * 32 + orow]);
    bf16_t* op = Ob + (long)(g * QBLK + orow) * LDO + 128 * kb + r32;
    for (int d0 = 0; d0 < 4; ++d0) op[d0 * 32] = (bf16_t)(cvtpk(o[d0][r] * rl, 0.f) & 0xffffu); }
#undef PLD16
#undef PLOAD
#undef PWRITE
}
#undef KSWZ
}

__device__ __forceinline__ void phase_attention(const Params& p, Ctx& C) {
    const bf16_t* QKV = (const bf16_t*)(p.ws + WS_BIG + BG_QKV); bf16_t* ATT = (bf16_t*)(p.ws + WS_BIG + BG_ATT);
    const unsigned* KMAX = (const unsigned*)(p.ws + WS_CTL) + CW_KMAX;
    const bool grouped = (C.G == 256);
    for (int i = 0;; ++i) {
        int unit;
        if (grouped) { if (i >= 4) break; unit = (C.bid & 7) * 128 + i * 32 + (C.bid >> 3); } else { unit = i * C.G + C.bid; if (unit >= 1024) break; }
        const int d = unit >> 7, qb = unit & 127, h = d >> 1, m = d & 1;
        const float kmax2 = __uint_as_float(KMAX[64 * (2 + 2 * h + m)]);
        __syncthreads();
        int tz = C.tid; asm volatile("" : "+v"(tz));
        att::attn_pair_body<OD_IN, OD_IN, 3072>(QKV + (size_t)(CTXL + 128 * qb) * OD_IN + 1536 + 256 * h + 128 * m, QKV + 2560 + 256 * h + 128 * m, QKV + 3584 + 256 * h,
                                                ATT + (size_t)(128 * qb) * 3072 + 1024 + 1024 * m + 256 * h, TT, (LAS char*)C.lds, tz, kmax2);
    }
    for (int i = 0;; ++i) {
        int unit;
        if (grouped) { if (i >= 2) break; unit = (C.bid & 7) * 64 + i * 32 + (C.bid >> 3); } else { unit = i * C.G + C.bid; if (unit >= 512) break; }
        const int prob = unit >> 6, qb = unit & 63;
        const float kmax2 = __uint_as_float(KMAX[64 * (prob >> 2)]);
        __syncthreads();
        int tz = C.tid; asm volatile("" : "+v"(tz));
        att::attn_dense_body<OD_IN, OD_IN, 3072>(QKV + (size_t)(CTXL + 256 * qb) * OD_IN + 128 * prob, QKV + 1024 + 128 * (prob >> 2), QKV + 1280 + 128 * (prob >> 2),
                                                 ATT + (size_t)(256 * qb) * 3072 + 128 * prob, TT, (LAS char*)C.lds, tz, kmax2);
    }
    __syncthreads();
}
constexpr int PH_PER_LAYER = 13, N_PHASES = 2 + 2 * PH_PER_LAYER;
#ifndef DBL_PHASE
#define DBL_PHASE -1
#endif
#ifndef MK_PER_PHASE
#define MK_PER_PHASE 0
#endif

template <int L>
__device__ __forceinline__ void layer_body(const Params& p, Ctx& C0, const XcdBarrier& bar, LAS unsigned char* misc, int lo, int hi) {
#define IN(k) (lo <= (k) && (k) < hi)
#define SEAM(k) do { if (IN(k) && IN((k) + 1)) xcd_barrier(bar, C0.wave); } while (0)
#define PHASE(k, ...) if (IN(k)) { FRESH(); __VA_ARGS__ } if (DBL_PHASE == (k)) { xcd_barrier(bar, C0.wave); { FRESH(); __VA_ARGS__ } } SEAM(k);
#define FRESH() Ctx C = C0; { int ln = (int)__builtin_amdgcn_mbcnt_hi(~0u, __builtin_amdgcn_mbcnt_lo(~0u, 0u)); asm volatile("" : "+v"(ln)); C.lane = ln; C.tid = C.wave * 64 + ln; }
        const int b = 2 + PH_PER_LAYER * L;
        bf16_t* QKV = (bf16_t*)(p.ws + WS_BIG + BG_QKV);
        bf16_t* XA = (bf16_t*)(p.ws + WS_XA);
        int* cnt = (int*)(p.ws + WS_CTL) + CW_CNT + L * 128; const int* LIST = (const int*)(p.ws + WS_LIST);
        PHASE(b + 0, phase_modulate(p, C, L); )
        PHASE(b + 1,
            const int N = L ? OD_IN : EV_IN;
            pg8::DenseOrder S; S.init8((const void*)XA, DM, (const void*)(p.ws + (L ? WS_WIN1 : WS_WIN0)), TT, N, DM, C.G, C.bid);
            pg8::EpiStore E{QKV, N, 1.0f / 32.0f};
            pg8::gemm_phase<true>(C.lds, S, E, C.wave);
            if (L == 0 && IN(b + 2) && S.units_of_me() < S.max_units()) conv_queue(p, C, 2);
        )
        PHASE(b + 2, if (L == 0) phase_rope0(p, C); else phase_normrope1(p, C); )
        PHASE(b + 3, if (L == 0) { ret_chunk_kv(p, C); s5_end_states(p, C); } else phase_attention(p, C); )
        PHASE(b + 4, if (L == 0) phase_scans(p, C); else phase_merge1(p, C); )
        if (L == 0) {
            PHASE(b + 5, phase_ret_s5_outputs(p, C, misc); )
            PHASE(b + 6,
                pg8::DenseOrder S; S.init((const bf16_t*)(p.ws + WS_Z), 1024, (const bf16_t*)(p.ws + WS_WGLU), TT, 1024, 1024, C.G, C.bid);
                pg8::EpiGlu E{(const bf16_t*)(p.ws + WS_Z), p.inp(20), (bf16_t*)(p.ws + WS_BIG + BG_MIX)};
                pg8::gemm_phase<false>(C.lds, S, E, C.wave);
                if (IN(b + 7) && S.units_of_me() < S.max_units()) conv_queue(p, C, 4);
            )
        }
        PHASE(b + 7,
            pg8::DenseOrder S;
            if (L == 0) S.init((const bf16_t*)(p.ws + WS_BIG + BG_MIX), DM, (const bf16_t*)(p.ws + WS_WOUT0), TT, DM, DM, C.G, C.bid);
            else S.init((const bf16_t*)(p.ws + WS_BIG + BG_ATT), 3072, (const bf16_t*)(p.ws + WS_WOUT1), SEQ, DM, DM, C.G, C.bid);
            pg8::EpiStore E{(bf16_t*)(p.ws + WS_YMIX) + (L ? (size_t)CTXL * DM : 0), DM, 1.0f};
            pg8::gemm_phase<false>(C.lds, S, E, C.wave);
            if (L == 0 && IN(b + 8) && S.units_of_me() < S.max_units()) conv_queue(p, C, 5);
        )
        PHASE(b + 8, phase_ln1(p, C, L); )
        PHASE(b + 9, phase_router(p, C, L); )
        PHASE(b + 10,
            pg8::MoeOrder<0> S; S.A = (const void*)XA; S.Bt = (const void*)(p.ws + WS_GU + (size_t)L * NEX1 * 1024 * DM); S.list = LIST; S.cnt = cnt; S.ldab = DM; S.kb = DM; S.nN = 4; S.G = C.G; S.c = C.bid; S.bstride = (size_t)1024 * DM;
            S.prep(misc, C.tid);
            pg8::EpiE1 E{(unsigned char*)(p.ws + WS_HX2), S.cn, S.rb};
            pg8::gemm_phase<true>(C.lds, S, E, C.wave);
        )
        PHASE(b + 11,
            pg8::MoeOrder<1> S; S.A = (const void*)(p.ws + WS_HX2); S.Bt = (const void*)(p.ws + WS_DT + (size_t)L * NEX1 * DM * EHID); S.list = LIST; S.cnt = cnt; S.ldab = EHID; S.kb = EHID; S.nN = 8; S.G = C.G; S.c = C.bid; S.bstride = (size_t)DM * EHID;
            S.prep(misc, C.tid);
            pg8::EpiE2 E{(unsigned char*)(p.ws + WS_BIG + BG_YMOE), (const float*)(p.ws + WS_LW), S.cn, S.rb};
            pg8::gemm_phase<true>(C.lds, S, E, C.wave);
        )
        PHASE(b + 12, phase_combine(p, C, L, misc); )
    #undef IN
#undef SEAM
#undef FRESH
#undef PHASE
}

__global__ void __launch_bounds__(NTHR, 2) mega_fwd(KArgs ka) {
    extern __shared__ __attribute__((aligned(16))) unsigned char lds_raw[];
    Ctx C;
    C.lds = (LAS unsigned char*)lds_raw;
    C.tid = threadIdx.x; C.lane = C.tid & 63; C.wave = __builtin_amdgcn_readfirstlane(C.tid >> 6);
    C.G = gridDim.x; C.bid = blockIdx.x; C.gw = C.bid * NWAVES + C.wave; C.ngw = C.G * NWAVES;
    LAS unsigned char* misc = C.lds + MISC_OFF;
    if (C.tid < 8) ((volatile LAS unsigned*)misc)[C.tid] = 0u;
    Params p; p.out = ka.out; p.ws = ka.ws; p.ph_lo = ka.ph_lo; p.ph_hi = ka.ph_hi; p.ptab = (LAS unsigned long long*)(misc + 1024);
    if (C.tid < 34) p.ptab[C.tid] = (unsigned long long)ka.in[C.tid];
    __syncthreads();
    const int lo = p.ph_lo, hi = p.ph_hi;
    XcdBarrier bar; bar.bar = (unsigned*)(p.ws + WS_CTL) + CW_BAR; bar.x = 0; bar.st = (volatile LAS unsigned*)misc;
    if (hi - lo > 1) bar = xcd_barrier_post((unsigned*)(p.ws + WS_CTL) + CW_BAR, (volatile LAS unsigned*)misc);
#define IN(k) (lo <= (k) && (k) < hi)
#define SEAM(k) do { if (IN(k) && IN((k) + 1)) xcd_barrier(bar, C.wave); } while (0)

    if (IN(0)) { phase_p0(p, C); } SEAM(0);
    if (IN(1)) { phase_p1(p, C); } SEAM(1);
    if (IN(0) && IN(2) && (C.G & 7) == 0) {
        volatile LAS unsigned* st = (volatile LAS unsigned*)misc;
        if (C.tid == 0) { unsigned pre = 0u; const unsigned x = st[3];
            for (unsigned j = 0; j < 16; ++j) { const unsigned cj = xb_ld(&bar.bar[XB_XCNT(j)]); pre += (j < x) ? cj : 0u; }
            st[4] = pre + st[2]; }
        __syncthreads();
        const int vcu = (int)st[4], g8 = C.G >> 3;
        C.bid = __builtin_amdgcn_readfirstlane((vcu % g8) * 8 + vcu / g8); C.gw = C.bid * NWAVES + C.wave;
    }

    layer_body<0>(p, C, bar, misc, lo, hi);
    layer_body<1>(p, C, bar, misc, lo, hi);
#undef IN
#undef SEAM
}

extern "C" void kernel_launch(void* const* d_in, const int* in_sizes, int n_in, void* d_out, int out_size, void* d_ws, size_t ws_size, hipStream_t stream) {
    static int grid = 0;
    if (grid == 0) {
        if (n_in != 34 || out_size != SEQ * DM || ws_size < WS_END) { fprintf(stderr, "kernel_launch: unexpected shapes: n_in %d out %d ws %zu (need %zu)\n", n_in, out_size, ws_size, (size_t)WS_END); grid = -1; return; }
        int dev = 0, cus = 0, per_cu = 0;
        if (hipGetDevice(&dev) != hipSuccess || hipDeviceGetAttribute(&cus, hipDeviceAttributeMultiprocessorCount, dev) != hipSuccess) { grid = -1; return; }
        if (hipFuncSetAttribute((const void*)mega_fwd, hipFuncAttributeMaxDynamicSharedMemorySize, LDS_BYTES) != hipSuccess) { fprintf(stderr, "kernel_launch: hipFuncSetAttribute failed\n"); grid = -1; return; }
        if (hipOccupancyMaxActiveBlocksPerMultiprocessor(&per_cu, (const void*)mega_fwd, NTHR, LDS_BYTES) != hipSuccess || per_cu < 1) { fprintf(stderr, "kernel_launch: occupancy query says %d blocks per CU\n", per_cu); grid = -1; return; }
        (void)hipGetLastError();
        grid = cus;
    }
    if (grid < 0) return;
    (void)hipMemsetAsync((char*)d_ws + WS_CTL, 0, CTL_BYTES, stream);
    KArgs p{};
    for (int i = 0; i < 34; ++i) p.in[i] = (const float*)d_in[i];
    p.out = (float*)d_out; p.ws = (unsigned char*)d_ws;
#if MK_PER_PHASE
    for (int ph = 0; ph < N_PHASES; ++ph) {
        if (ph == 2 + PH_PER_LAYER + 5 || ph == 2 + PH_PER_LAYER + 6) continue;
        p.ph_lo = ph; p.ph_hi = ph + 1;
        hipLaunchKernelGGL(mega_fwd, dim3(grid), dim3(NTHR), LDS_BYTES, stream, p);
    }
#else
    p.ph_lo = 0; p.ph_hi = N_PHASES;
    hipLaunchKernelGGL(mega_fwd, dim3(grid), dim3(NTHR), LDS_BYTES, stream, p);
#endif
    const hipError_t le = hipPeekAtLastError();
    if (le != hipSuccess) fprintf(stderr, "kernel_launch: launch failed: %s\n", hipGetErrorName(le));
}
```

```cpp
#define MK_PER_PHASE 0
#include <hip/hip_runtime.h>
#include <cstdio>
#include <cstdint>

#define GAS __attribute__((address_space(1)))
#define LAS __attribute__((address_space(3)))
typedef unsigned short bf16_t;
typedef short bf16x8 __attribute__((ext_vector_type(8)));
typedef short s16x4 __attribute__((ext_vector_type(4)));
typedef float f32x4 __attribute__((ext_vector_type(4)));
typedef float f32x2 __attribute__((ext_vector_type(2)));
typedef float f32x16 __attribute__((ext_vector_type(16)));
typedef unsigned u32x4 __attribute__((ext_vector_type(4)));
typedef unsigned u32x2 __attribute__((ext_vector_type(2)));

constexpr int DM = 2048, SEQ = 16384, CTXL = 256, TT = SEQ + CTXL;
constexpr int NEXP = 64, NEX1 = 65, EHID = 512, TOPK = 8;
constexpr int EV_IN = 5120, OD_IN = 4608;
constexpr float LN_EPS = 1e-6f;
constexpr float ALPHA = 1.4142135623730951f;
constexpr float LAMBDA_INIT = 0.35550906759f;
constexpr int NTHR = 512, NWAVES = 8;

constexpr size_t al256(size_t x) { return (x + 255) / 256 * 256; }
constexpr size_t WS_CTL   = 0;
constexpr size_t CTL_BYTES = 1u << 20;
constexpr size_t WS_MODP  = WS_CTL + CTL_BYTES;
constexpr size_t WS_MODF  = WS_MODP + al256((size_t)2 * 32 * 2 * 12288 * 4);
constexpr size_t WS_ROPE128 = WS_MODF + al256((size_t)2 * 2 * 12288 * 4);
constexpr size_t WS_ROPE64  = WS_ROPE128 + al256((size_t)256 * 64 * 2 * 4);
constexpr size_t WS_KN    = WS_ROPE64 + al256((size_t)256 * 32 * 2 * 4);
constexpr size_t WS_WT    = WS_KN + al256((size_t)2 * 64 * 16 * 1024 * 2);
constexpr size_t WS_APOW  = WS_WT + al256((size_t)2 * 64 * 128 * 1024 * 2);
constexpr size_t WS_AL    = WS_APOW + al256((size_t)2 * 64 * 64 * 128 * 4);
constexpr size_t WS_CC    = WS_AL + al256((size_t)2 * 64 * 128 * 4);
constexpr size_t WS_BBT   = WS_CC + al256((size_t)64 * 16 * 128 * 2);
constexpr size_t WS_S5E   = WS_BBT + al256((size_t)2 * 64 * 128 * 16 * 2);
constexpr size_t WS_HST   = WS_S5E + al256((size_t)2 * 64 * 260 * 128 * 4);
constexpr size_t WS_WIN0  = WS_HST + al256((size_t)2 * 64 * 260 * 128 * 4);
constexpr size_t WS_WOUT0 = WS_WIN0 + al256((size_t)EV_IN * DM * 2);
constexpr size_t WS_WGLU  = WS_WOUT0 + al256((size_t)DM * DM * 2);
constexpr size_t WS_WIN1  = WS_WGLU + al256((size_t)1024 * 1024 * 2);
constexpr size_t WS_WOUT1 = WS_WIN1 + al256((size_t)OD_IN * DM * 2);
constexpr size_t WS_RWT   = WS_WOUT1 + al256((size_t)DM * DM * 2);
constexpr size_t WS_GU    = WS_RWT + al256((size_t)2 * 2 * 64 * DM * 2);
constexpr size_t WS_DT    = WS_GU + al256((size_t)NEX1 * 1024 * DM * 2);
constexpr size_t WS_XA    = WS_DT + al256((size_t)NEX1 * DM * EHID * 2);
constexpr size_t WS_Z     = WS_XA + al256((size_t)TT * DM * 2);
constexpr size_t WS_YMIX  = WS_Z + al256((size_t)TT * 1024 * 2);
constexpr size_t WS_X1    = WS_YMIX + al256((size_t)TT * DM * 2);
constexpr size_t WS_HX2   = WS_X1 + al256((size_t)TT * DM * 4);
constexpr size_t WS_LIST  = WS_HX2 + al256((size_t)9 * TT * EHID * 2);
constexpr size_t WS_WGT   = WS_LIST + al256((size_t)NEX1 * TT * 4);
constexpr size_t WS_LW    = WS_WGT + al256((size_t)8 * TT * 4);
constexpr size_t WS_BIG   = WS_LW + al256((size_t)NEX1 * TT * 4);
constexpr size_t BG_QKV   = 0;
constexpr size_t BG_CKV   = BG_QKV + al256((size_t)TT * EV_IN * 2);
constexpr size_t BG_SPREV = BG_CKV + al256((size_t)8 * 130 * 65536 * 4);
constexpr size_t BG_MIX   = BG_SPREV + al256((size_t)8 * 130 * 65536 * 2);
constexpr size_t BG_END0  = BG_MIX + al256((size_t)TT * DM * 2);
constexpr size_t BG_ATT   = BG_CKV;
constexpr size_t BG_Q8    = BG_ATT + al256((size_t)SEQ * 3072 * 2);
constexpr size_t BG_K8    = BG_Q8 + al256((size_t)TT * 1024);
constexpr size_t BG_VT8   = BG_K8 + al256((size_t)TT * 256);
constexpr size_t BG_F8END = BG_VT8 + al256((size_t)2 * 260 * 128 * 64);
constexpr size_t BG_YMOE  = 0;
constexpr size_t BG_END1  = al256((size_t)9 * TT * DM * 2);
constexpr size_t BG_SIZE  = BG_END0 > BG_END1 ? BG_END0 : BG_END1;
static_assert(BG_F8END <= BG_SIZE, "fp8 attention operands inside the big region");
constexpr size_t WS_END   = WS_BIG + BG_SIZE;

constexpr int CW_BAR = 4096;
constexpr int CW_CNT = 16384;
constexpr int CW_QUEUE = 20480;
constexpr int CW_KMAX = 24576;

constexpr int RING_BYTES = 151552;
constexpr int MISC_OFF = RING_BYTES;
constexpr int LDS_BYTES = 159744;

typedef __bf16 bf16x2_t __attribute__((ext_vector_type(2)));
__device__ __forceinline__ unsigned cvt_pk_bf16(float lo, float hi) { const f32x2 v = {lo, hi}; return __builtin_bit_cast(unsigned, __builtin_convertvector(v, bf16x2_t)); }
__device__ __forceinline__ bf16_t f2bf(float f) { unsigned u = __builtin_bit_cast(unsigned, f); return (bf16_t)((u + 0x7fffu + ((u >> 16) & 1u)) >> 16); }
__device__ __forceinline__ float bf2f(bf16_t b) { return __builtin_bit_cast(float, ((unsigned)b) << 16); }
__device__ __forceinline__ float bflo(unsigned w) { return __builtin_bit_cast(float, w << 16); }
__device__ __forceinline__ float bfhi(unsigned w) { return __builtin_bit_cast(float, w & 0xffff0000u); }
__device__ __forceinline__ float wave_sum(float v) {
#pragma unroll
    for (int o = 1; o < 64; o <<= 1) v += __shfl_xor(v, o);
    return v;
}
__device__ __forceinline__ float fast_exp(float x) { return __builtin_amdgcn_exp2f(x * 1.4426950408889634f); }
__device__ __forceinline__ float sigmoidf_(float x) { return 1.0f / (1.0f + __expf(-x)); }
__device__ __forceinline__ float siluf_(float x) { return x / (1.0f + __expf(-x)); }
__device__ __forceinline__ float gelu_tanh(float x) {
    const float u = 0.7978845608028654f * (x + 0.044715f * x * x * x);
    const float e = __expf(2.0f * u);
    const float t = 1.0f - 2.0f / (e + 1.0f);
    return 0.5f * x * (1.0f + t);
}
#define LDS_WAIT() asm volatile("s_waitcnt lgkmcnt(0)" ::: "memory")
#define VM_WAIT() asm volatile("s_waitcnt vmcnt(0)" ::: "memory")

#define XB_TMO      128
#define XB_XCNT(j)  (256  + 64 * (j))
#define XB_XSUB(j)  (1280 + 64 * (j))
#define XB_XGEN(j)  (2304 + 64 * (j))
#define XB_TOP      3328
#define XB_TOPGEN   3392
#define XCD_BAR_WORDS 3456
#define XB_SPIN_CAP (1u << 22)

__device__ __forceinline__ unsigned xb_ld(unsigned* p)              { return __hip_atomic_load(p, __ATOMIC_RELAXED, __HIP_MEMORY_SCOPE_AGENT); }
__device__ __forceinline__ unsigned xb_add(unsigned* p, unsigned v) { return __hip_atomic_fetch_add(p, v, __ATOMIC_RELAXED, __HIP_MEMORY_SCOPE_AGENT); }
__device__ __forceinline__ unsigned xb_xcc_id() { return (unsigned)__builtin_amdgcn_s_getreg((3 << 11) | 20) & 0xFu; }
#define XB_SPIN(cond, bar) do { unsigned _sp = 0; while (cond) { __builtin_amdgcn_s_sleep(1); \
    if ((++_sp & 255u) == 0u) { if (xb_ld(&(bar)[XB_TMO])) break; if (_sp > XB_SPIN_CAP) { atomicAdd(&(bar)[XB_TMO], 1u); break; } } } } while (0)

struct XcdBarrier { unsigned* bar; unsigned x; volatile LAS unsigned* st; };

__device__ __forceinline__ XcdBarrier xcd_barrier_post(unsigned* bar, volatile LAS unsigned* st) {
    XcdBarrier b; b.bar = bar; b.x = xb_xcc_id(); b.st = st;
    if (threadIdx.x == 0) { st[2] = xb_add(&bar[XB_XCNT(b.x)], 1u); st[3] = b.x; }
    return b;
}
__device__ __forceinline__ void xcd_barrier_complete(unsigned* bar, unsigned x, unsigned& nloc, unsigned& nx) {
    const unsigned G = gridDim.x * gridDim.y * gridDim.z;
    unsigned sum, cnt, mine, sp = 0u;
    for (;;) {
        sum = 0u; cnt = 0u; mine = 0u;
#pragma unroll
        for (unsigned j = 0; j < 16; ++j) { const unsigned c = xb_ld(&bar[XB_XCNT(j)]); sum += c; cnt += (c > 0u) ? 1u : 0u; mine = (j == x) ? c : mine; }
        if (sum == G) break;
        __builtin_amdgcn_s_sleep(1);
        if ((++sp & 255u) == 0u) { if (xb_ld(&bar[XB_TMO])) break; if (sp > XB_SPIN_CAP) { atomicAdd(&bar[XB_TMO], 1u); break; } }
    }
    nloc = mine > 0u ? mine : 1u; nx = cnt > 0u ? cnt : 1u;
}
__device__ __forceinline__ void xcd_barrier(const XcdBarrier& b, int wave_id) {
    const bool leader_thread = (wave_id == 0) && (__builtin_amdgcn_mbcnt_hi(~0u, __builtin_amdgcn_mbcnt_lo(~0u, 0u)) == 0u);
    asm volatile("s_waitcnt vmcnt(0)" ::: "memory");
    __syncthreads();
    if (leader_thread) {
        unsigned* bar = b.bar;
        __builtin_amdgcn_s_waitcnt(0);
        unsigned nloc = b.st[0], nx = b.st[1];
        if (nloc == 0u) { xcd_barrier_complete(bar, b.x, nloc, nx); b.st[0] = nloc; b.st[1] = nx; }
        const unsigned old = xb_add(&bar[XB_XSUB(b.x)], 1u);
        const unsigned gen = old / nloc;
        if (old + 1u == (gen + 1u) * nloc) {
            __builtin_amdgcn_fence(__ATOMIC_RELEASE, "agent");
            asm volatile("s_waitcnt vmcnt(0)" ::: "memory");
            const unsigned og = xb_add(&bar[XB_TOP], 1u);
            const unsigned tg = og / nx;
            if (og + 1u == (tg + 1u) * nx) xb_add(&bar[XB_TOPGEN], 1u);
            else XB_SPIN(xb_ld(&bar[XB_TOPGEN]) == tg, bar);
            __builtin_amdgcn_fence(__ATOMIC_ACQUIRE, "agent");
            xb_add(&bar[XB_XGEN(b.x)], 1u);
            asm volatile("s_waitcnt vmcnt(0)" ::: "memory");
        } else {
            XB_SPIN(xb_ld(&bar[XB_XGEN(b.x)]) == gen, bar);
            __builtin_amdgcn_fence(__ATOMIC_ACQUIRE, "agent");
            asm volatile("s_waitcnt vmcnt(0)" ::: "memory");
        }
    }
    __syncthreads();
}

__device__ __forceinline__ bf16x8 frag_rowk_l(const LAS bf16_t* p, int ld, int lane) {
    return *(const LAS bf16x8*)(p + (lane & 15) * ld + (lane >> 4) * 8);
}
__device__ __forceinline__ bf16x8 frag_rowk_g(const bf16_t* p, long ld, int lane) {
    return *(const bf16x8*)(p + (long)(lane & 15) * ld + (lane >> 4) * 8);
}
__device__ __forceinline__ bf16x8 frag_colk_l(unsigned p, int ldb, int lane) {
    const unsigned a0 = p + (unsigned)((8 * (lane >> 4) + ((lane & 15) >> 2)) * ldb + (lane & 3) * 8);
    const unsigned a1 = a0 + 4u * (unsigned)ldb;
    s16x4 lo, hi;
    asm volatile("ds_read_b64_tr_b16 %0, %2\n\tds_read_b64_tr_b16 %1, %3\n\ts_waitcnt lgkmcnt(0)" : "=&v"(lo), "=&v"(hi) : "v"(a0), "v"(a1) : "memory");
    return (bf16x8){lo[0], lo[1], lo[2], lo[3], hi[0], hi[1], hi[2], hi[3]};
}
#define MFMA16(a, b, c) __builtin_amdgcn_mfma_f32_16x16x32_bf16((a), (b), (c), 0, 0, 0)
namespace pg8 {
constexpr int BM = 256, BK = 64, HALF = 128, HTB = HALF * BK * 2, STAGE_BYTES = 8 * HTB, NXCD = 8, WGM = 8;
__device__ __forceinline__ int lds_byte(int r, int c) { const int st = (r >> 4) * 2 + (c >> 5), rr = r & 15, cc = c & 31, ob = rr * 64 + cc * 2; return st * 1024 + (ob ^ (((ob >> 9) & 1) << 5)); }
__device__ __forceinline__ void stage_rc(int b, int& R, int& C) { const int st = b / 1024, sb = b % 1024, swz = sb ^ (((sb >> 9) & 1) << 5); R = (st >> 1) * 16 + swz / 64; C = (st & 1) * 32 + (swz % 64) / 2; }
__device__ __forceinline__ int perm32(int rho) { const int n = rho >> 4, i = rho & 15; return 8 * (i >> 2) + 4 * n + (i & 3); }

struct Unit { int pm, pn, e; };
constexpr float WSCALE = 32.0f, WSCALE_INV = 1.0f / 32.0f;

struct DenseOrder {
    const bf16_t* A; const bf16_t* Bt; int ldab, kb, nM, nN, nwg, G, c;
    __device__ __forceinline__ void init(const bf16_t* A_, int lda_, const bf16_t* Bt_, int M, int N, int K_, int G_, int c_) { A = A_; ldab = lda_ * 2; Bt = Bt_; kb = K_ * 2; nM = M / BM; nN = N / BM; nwg = nM * nN; G = G_; c = c_; }
    __device__ __forceinline__ void init8(const void* A_, int ldab_, const void* Bt_, int M, int N, int K_, int G_, int c_) { A = (const bf16_t*)A_; ldab = ldab_; Bt = (const bf16_t*)Bt_; kb = K_; nM = M / BM; nN = N / BM; nwg = nM * nN; G = G_; c = c_; }
    __device__ __forceinline__ void prep(LAS unsigned char*) const {}
    __device__ __forceinline__ int units_of_me() const { return c < nwg ? (nwg - c + G - 1) / G : 0; }
    __device__ __forceinline__ int max_units() const { return (nwg + G - 1) / G; }
    __device__ __forceinline__ bool next(int i, Unit& u) const {
        const long L = (long)i * G + c; if (L >= nwg) return false;
        int wgid = (int)L; { const int q = nwg / NXCD, r = nwg % NXCD, xcd = wgid % NXCD, off = wgid / NXCD; wgid = (xcd < r ? xcd * (q + 1) : r * (q + 1) + (xcd - r) * q) + off; }
        const int nig = WGM * nN, gid = wgid / nig, fm = gid * WGM, gsz = (nM - fm) < WGM ? (nM - fm) : WGM;
        u.pm = fm + ((wgid % nig) % gsz); u.pn = (wgid % nig) / gsz; u.e = 0; return true;
    }
    __device__ __forceinline__ const char* a_base() const { return (const char*)A; }
    __device__ __forceinline__ unsigned a_off(const Unit& u, int r) const { return (unsigned)(u.pm * BM + r) * (unsigned)ldab; }
    __device__ __forceinline__ const char* b_ptr(const Unit& u) const { return (const char*)Bt + (size_t)u.pn * BM * kb; }
};

template <int MODE  >
struct MoeOrder {
    const void* A; const void* Bt; const int* list; const int* cnt; int ldab, kb, nN, G, c; size_t bstride;
    LAS int* tp; LAS int* cn; LAS int* rb;
    __device__ __forceinline__ void prep(LAS unsigned char* misc, int tid) {
        tp = (LAS int*)(misc + 64); cn = tp + 72; rb = cn + 72;
        if (tid < NEX1) cn[tid] = cnt[tid];
        __syncthreads();
        if (tid == 0) { int s = 0, q = 0; for (int e = 0; e < NEX1; ++e) { tp[e] = s; rb[e] = q; s += (cn[e] + BM - 1) / BM; q += cn[e]; } tp[NEX1] = s; rb[NEX1] = q; }
        __syncthreads();
    }
    __device__ __forceinline__ bool next(int i, Unit& u) const {
        const int total = tp[NEX1]; const long nu = (long)total * nN; const int per = (int)((nu + G - 1) / G);
        (void)per;
        long L = (long)i * G + c;
        if ((G & 7) == 0) L = ((long)i * 8 + (c & 7)) * (G >> 3) + (c >> 3);
        if (L >= nu) return false;
        const int tile = (int)(L / nN); u.pn = (int)(L % nN);
        int e = 0;
        for (int k = 1; k < NEX1; ++k) e += (tp[k] <= tile) ? 1 : 0;
        u.e = e; u.pm = tile - tp[e]; return true;
    }
    __device__ __forceinline__ const char* a_base() const { return (const char*)A; }
    __device__ __forceinline__ unsigned a_off(const Unit& u, int r) const {
        int pos = u.pm * BM + r; const int n = cn[u.e]; pos = pos < n ? pos : n - 1;
        if (MODE == 1) return (unsigned)(rb[u.e] + pos) * (unsigned)ldab;
        const int a = list[u.e * TT + pos];
        const int row = a < 8 * TT ? (a >> 3) : a - 8 * TT;
        return (unsigned)row * (unsigned)ldab;
    }
    __device__ __forceinline__ const char* b_ptr(const Unit& u) const { return (const char*)Bt + (size_t)u.e * bstride + (size_t)u.pn * BM * kb; }
};

typedef int v8i32 __attribute__((ext_vector_type(8)));
typedef int v4i32_ __attribute__((ext_vector_type(4)));
__device__ __forceinline__ v8i32 cat8(bf16x8 a, bf16x8 b) { const u32x4 x = __builtin_bit_cast(u32x4, a), y = __builtin_bit_cast(u32x4, b); return (v8i32){(int)x.x, (int)x.y, (int)x.z, (int)x.w, (int)y.x, (int)y.y, (int)y.z, (int)y.w}; }
template <bool FP8, class Epi, class Sched>
__device__ __forceinline__ void gemm_phase(LAS unsigned char* lds, const Sched& S, const Epi& E, int wave_id) {
    const int wid = wave_id; int lane = (int)__builtin_amdgcn_mbcnt_hi(~0u, __builtin_amdgcn_mbcnt_lo(~0u, 0u)); asm volatile("" : "+v"(lane));
    const int tid = wid * 64 + lane, wr = wid >> 2, wc = wid & 3, fr = lane & 15, fq = lane >> 4;
    const int kb = S.kb; int nt = kb / 128; asm volatile("" : "+s"(nt));
    unsigned voffB[2];
#pragma unroll
    for (int i = 0; i < 2; ++i) { int R, C; stage_rc(tid * 16 + i * 8192, R, C); const int Rb = (R & ~31) + perm32(R & 31);
        voffB[i] = (unsigned)(Rb * kb) + (unsigned)C * 2u; }
#define PG8_AOFF(u, h, i) ({ int _tz = tid; asm volatile("" : "+v"(_tz)); int _R, _C; stage_rc(_tz * 16 + (i) * 8192, _R, _C); S.a_off((u), (h) * HALF + _R) + (unsigned)_C * 2u; })
    const size_t kstep = (size_t)(BK * 2);
    const size_t hstepB = (size_t)HALF * kb;
    const unsigned ldsw = (unsigned)wid * 1024u;
    const int aoff = lds_byte(wr * 64 + fr, fq * 8), boff = lds_byte(wc * 32 + fr, fq * 8);
#define PG8_SA(b, h) (((b) * 2 + (h)) * HTB)
#define PG8_SB(b, h) ((4 + (b) * 2 + (h)) * HTB)
#define PG8_STAGE(bufoff, gbase, v0, v1) do { \
        __builtin_amdgcn_global_load_lds((const unsigned*)((const char*)(gbase) + (v0)), (LAS unsigned*)(lds + (bufoff) + ldsw), 16, 0, 0); \
        __builtin_amdgcn_global_load_lds((const unsigned*)((const char*)(gbase) + (v1)), (LAS unsigned*)(lds + (bufoff) + ldsw + 8192), 16, 0, 0); } while (0)
#define PG8_VOFFB(i) ({ int _tz = tid; asm volatile("" : "+v"(_tz)); int _R, _C; stage_rc(_tz * 16 + (i) * 8192, _R, _C); (unsigned)(((_R & ~31) + perm32(_R & 31)) * kb) + (unsigned)_C * 2u; })
#define PG8_STAGE_B(bufoff, gbase) do { if constexpr (FP8) { const unsigned _v0 = PG8_VOFFB(0), _v1 = PG8_VOFFB(1); PG8_STAGE(bufoff, gbase, _v0, _v1); } else PG8_STAGE(bufoff, gbase, voffB[0], voffB[1]); } while (0)
#define PG8_LD8(off) __builtin_shufflevector(*(const LAS v4i32_*)(lds + (off)), *(const LAS v4i32_*)(lds + (off) + 1024), 0, 1, 2, 3, 4, 5, 6, 7)
#define PG8_LDA(dst, b, h) do { _Pragma("unroll") for (int m = 0; m < 4; ++m) { if constexpr (FP8) dst##8[m] = PG8_LD8(PG8_SA(b, h) + aoff + m * 2048); else { _Pragma("unroll") for (int k = 0; k < 2; ++k) dst[m][k] = *(const LAS bf16x8*)(lds + PG8_SA(b, h) + aoff + m * 2048 + k * 1024); } } } while (0)
#define PG8_LDB(dst, b, h) do { _Pragma("unroll") for (int n = 0; n < 2; ++n) { if constexpr (FP8) dst##8[n] = PG8_LD8(PG8_SB(b, h) + boff + n * 2048); else { _Pragma("unroll") for (int k = 0; k < 2; ++k) dst[n][k] = *(const LAS bf16x8*)(lds + PG8_SB(b, h) + boff + n * 2048 + k * 1024); } } } while (0)
#define PG8_MMA(ai, bj, At, Bt) do { __builtin_amdgcn_s_setprio(1); _Pragma("unroll") for (int m = 0; m < 4; ++m) _Pragma("unroll") for (int n = 0; n < 2; ++n) { \
        if constexpr (FP8) asm volatile("v_mfma_f32_16x16x128_f8f6f4 %0, %1, %2, %0" : "+v"(acc[ai][bj][m][n]) : "v"(Bt##8[n]), "v"(At##8[m])); \
        else { _Pragma("unroll") for (int k = 0; k < 2; ++k) acc[ai][bj][m][n] = __builtin_amdgcn_mfma_f32_16x16x32_bf16(Bt[n][k], At[m][k], acc[ai][bj][m][n], 0, 0, 0); } } \
        __builtin_amdgcn_s_setprio(0); } while (0)
#define PG8_WAIT_V(n) asm volatile("s_waitcnt vmcnt(" #n ")" ::: "memory")
#define PG8_WAIT_L(n) asm volatile("s_waitcnt lgkmcnt(" #n ")" ::: "memory")
#define PG8_BAR __builtin_amdgcn_s_barrier()
#define PG8_SCHED __builtin_amdgcn_sched_barrier(0)
    Unit cur, nxt; int ui = 0;
    if (!S.next(0, cur)) return;
    f32x4 acc[2][2][4][2];
#pragma unroll
    for (int a = 0; a < 2; ++a)
#pragma unroll
        for (int b = 0; b < 2; ++b)
#pragma unroll
            for (int m = 0; m < 4; ++m)
#pragma unroll
                for (int n = 0; n < 2; ++n) acc[a][b][m][n] = (f32x4){0.f, 0.f, 0.f, 0.f};
    bf16x8 At[4][2], B0[2][2], B1[2][2]; v8i32 At8[4], B08[2], B18[2];
    const char* const gA = S.a_base();
    const char* cB = S.b_ptr(cur);
    unsigned oc00, oc01, oc10, oc11;
    oc00 = PG8_AOFF(cur, 0, 0); oc01 = PG8_AOFF(cur, 0, 1); oc10 = PG8_AOFF(cur, 1, 0); oc11 = PG8_AOFF(cur, 1, 1);
    PG8_STAGE_B(PG8_SB(0, 0), cB); PG8_STAGE_B(PG8_SB(0, 1), cB + hstepB); PG8_STAGE(PG8_SA(0, 0), gA, oc00, oc01); PG8_STAGE(PG8_SA(0, 1), gA, oc10, oc11);
    if (wr == 1) PG8_BAR;
    PG8_WAIT_V(2); PG8_BAR;
    PG8_STAGE_B(PG8_SB(1, 0), cB + kstep); PG8_STAGE(PG8_SA(1, 0), gA + kstep, oc00, oc01); PG8_STAGE_B(PG8_SB(1, 1), cB + hstepB + kstep);
    PG8_WAIT_V(6); PG8_BAR;
    for (;;) {
        const bool has_next = S.next(ui + 1, nxt);
        const char* nB = cB;
        {
            u32x4 on = {oc00, oc01, oc10, oc11};
            if (has_next) { on.x = PG8_AOFF(nxt, 0, 0); on.y = PG8_AOFF(nxt, 0, 1); on.z = PG8_AOFF(nxt, 1, 0); on.w = PG8_AOFF(nxt, 1, 1); nB = S.b_ptr(nxt); }
            *(LAS u32x4*)(lds + STAGE_BYTES + tid * 16) = on;
        }
        for (int t = 0; t < nt; t += 2) {
            const bool last = (t == nt - 2);
            const char* a1 = gA + (size_t)(t + 1) * kstep;
            const char* a2 = last ? gA : gA + (size_t)(t + 2) * kstep; const char* b2 = last ? nB : cB + (size_t)(t + 2) * kstep;
            const char* a3 = a2 + kstep; const char* b3 = b2 + kstep;
            unsigned s00 = oc00, s01 = oc01, s10 = oc10, s11 = oc11;
            if (last) { const u32x4 on = *(const LAS u32x4*)(lds + STAGE_BYTES + tid * 16); s00 = on.x; s01 = on.y; s10 = on.z; s11 = on.w; }
            PG8_LDB(B0, 0, 0); PG8_LDB(B1, 0, 1); PG8_SCHED; PG8_LDA(At, 0, 0); PG8_STAGE(PG8_SA(1, 1), a1, oc10, oc11);
            PG8_WAIT_V(8); PG8_WAIT_L(0); PG8_BAR; PG8_MMA(0, 0, At, B0); PG8_MMA(0, 1, At, B1); PG8_BAR; PG8_SCHED;
            PG8_LDA(At, 0, 1); PG8_STAGE_B(PG8_SB(0, 0), b2); PG8_STAGE_B(PG8_SB(0, 1), b2 + hstepB); PG8_STAGE(PG8_SA(0, 0), a2, s00, s01);
            PG8_WAIT_V(8); PG8_WAIT_L(0); PG8_BAR; PG8_MMA(1, 0, At, B0); PG8_MMA(1, 1, At, B1); PG8_BAR; PG8_SCHED;
            PG8_LDB(B0, 1, 0); PG8_LDB(B1, 1, 1); PG8_SCHED; PG8_LDA(At, 1, 0); PG8_STAGE(PG8_SA(0, 1), a2, s10, s11);
            PG8_WAIT_V(8); PG8_WAIT_L(0); PG8_BAR; PG8_MMA(0, 0, At, B0); PG8_MMA(0, 1, At, B1); PG8_BAR; PG8_SCHED;
            PG8_LDA(At, 1, 1); PG8_STAGE_B(PG8_SB(1, 0), b3); PG8_STAGE_B(PG8_SB(1, 1), b3 + hstepB); PG8_STAGE(PG8_SA(1, 0), a3, s00, s01);
            PG8_WAIT_V(8); PG8_WAIT_L(0); PG8_BAR; PG8_MMA(1, 0, At, B0); PG8_MMA(1, 1, At, B1); PG8_BAR; PG8_SCHED;
        }
        if (wr == 0) PG8_BAR;
        E(acc, cur, wr, wc, fr, fq);
        if (!has_next) break;
#pragma unroll
        for (int a = 0; a < 2; ++a)
#pragma unroll
            for (int b = 0; b < 2; ++b)
#pragma unroll
                for (int m = 0; m < 4; ++m)
#pragma unroll
                    for (int n = 0; n < 2; ++n) acc[a][b][m][n] = (f32x4){0.f, 0.f, 0.f, 0.f};
        { const u32x4 on = *(const LAS u32x4*)(lds + STAGE_BYTES + tid * 16); oc00 = on.x; oc01 = on.y; oc10 = on.z; oc11 = on.w; }
        cur = nxt; cB = nB; ++ui;
        if (wr == 1) PG8_BAR;
    }
    PG8_WAIT_V(0);
    PG8_BAR;
#undef PG8_SA
#undef PG8_SB
#undef PG8_STAGE
#undef PG8_STAGE_B
#undef PG8_AOFF
#undef PG8_VOFFB
#undef PG8_LD8
#undef PG8_LDA
#undef PG8_LDB
#undef PG8_MMA
#undef PG8_WAIT_V
#undef PG8_WAIT_L
#undef PG8_BAR
#undef PG8_SCHED
}

struct EpiStore {
    bf16_t* O; int ldc; float scale;
    __device__ __forceinline__ void operator()(const f32x4 (&acc)[2][2][4][2], const Unit& u, int wr, int wc, int fr, int fq) const {
        const int row0 = u.pm * BM + wr * 64 + fr, col0 = u.pn * BM + wc * 32 + 8 * fq;
#pragma unroll
        for (int ai = 0; ai < 2; ++ai)
#pragma unroll
            for (int m = 0; m < 4; ++m) { bf16_t* rowp = O + (size_t)(row0 + ai * HALF + m * 16) * ldc + col0;
#pragma unroll
                for (int bj = 0; bj < 2; ++bj) { const f32x4 v0 = acc[ai][bj][m][0] * scale, v1 = acc[ai][bj][m][1] * scale;
                    u32x4 w; w.x = cvt_pk_bf16(v0[0], v0[1]); w.y = cvt_pk_bf16(v0[2], v0[3]); w.z = cvt_pk_bf16(v1[0], v1[1]); w.w = cvt_pk_bf16(v1[2], v1[3]);
                    *(u32x4*)(rowp + bj * HALF) = w; } }
    }
};
struct EpiGlu {
    const bf16_t* Z; const float* b; bf16_t* MIX;
    __device__ __forceinline__ void operator()(const f32x4 (&acc)[2][2][4][2], const Unit& u, int wr, int wc, int fr, int fq) const {
        const int row0 = u.pm * BM + wr * 64 + fr, col0 = u.pn * BM + wc * 32 + 8 * fq;
#pragma unroll
        for (int bj = 0; bj < 2; ++bj) {
            const f32x4 b0 = *(const f32x4*)(b + col0 + bj * HALF), b1 = *(const f32x4*)(b + col0 + bj * HALF + 4);
#pragma unroll
            for (int ai = 0; ai < 2; ++ai)
#pragma unroll
                for (int m = 0; m < 4; ++m) { const size_t row = (size_t)(row0 + ai * HALF + m * 16);
                    const u32x4 zz = *(const u32x4*)(Z + row * 1024 + col0 + bj * HALF);
                    const f32x4 v0 = acc[ai][bj][m][0] + b0, v1 = acc[ai][bj][m][1] + b1;
                    u32x4 w;
                    w.x = cvt_pk_bf16(bflo(zz.x) * sigmoidf_(v0[0]), bfhi(zz.x) * sigmoidf_(v0[1]));
                    w.y = cvt_pk_bf16(bflo(zz.y) * sigmoidf_(v0[2]), bfhi(zz.y) * sigmoidf_(v0[3]));
                    w.z = cvt_pk_bf16(bflo(zz.z) * sigmoidf_(v1[0]), bfhi(zz.z) * sigmoidf_(v1[1]));
                    w.w = cvt_pk_bf16(bflo(zz.w) * sigmoidf_(v1[2]), bfhi(zz.w) * sigmoidf_(v1[3]));
                    *(u32x4*)(MIX + row * DM + 1024 + col0 + bj * HALF) = w; }
        }
    }
};
struct EpiE1 {
    unsigned char* H; const LAS int* cn; const LAS int* rb;
    __device__ __forceinline__ void operator()(const f32x4 (&acc)[2][2][4][2], const Unit& u, int wr, int wc, int fr, int fq) const {
        const int n = cn[u.e]; const int colh = u.pn * 128 + wc * 32 + 8 * fq;
#pragma unroll
        for (int ai = 0; ai < 2; ++ai)
#pragma unroll
            for (int m = 0; m < 4; ++m) { const int pos = u.pm * BM + ai * HALF + wr * 64 + m * 16 + fr;
                if (pos < n) { const int a = rb[u.e] + pos;
                    float sc = WSCALE_INV; asm volatile("" : "+v"(sc));
                    const f32x4 g0 = acc[ai][0][m][0] * sc, g1 = acc[ai][0][m][1] * sc, u0 = acc[ai][1][m][0] * sc, u1 = acc[ai][1][m][1] * sc;
                    u32x2 w;
                    w.x = (unsigned)__builtin_amdgcn_cvt_pk_fp8_f32(siluf_(g0[0]) * u0[0], siluf_(g0[1]) * u0[1], 0, false);
                    w.x = (unsigned)__builtin_amdgcn_cvt_pk_fp8_f32(siluf_(g0[2]) * u0[2], siluf_(g0[3]) * u0[3], (int)w.x, true);
                    w.y = (unsigned)__builtin_amdgcn_cvt_pk_fp8_f32(siluf_(g1[0]) * u1[0], siluf_(g1[1]) * u1[1], 0, false);
                    w.y = (unsigned)__builtin_amdgcn_cvt_pk_fp8_f32(siluf_(g1[2]) * u1[2], siluf_(g1[3]) * u1[3], (int)w.y, true);
                    *(u32x2*)(H + (size_t)a * EHID + colh) = w; }
                __builtin_amdgcn_sched_barrier(0); }
    }
};
struct EpiE2 {
    unsigned char* Y; const float* wgt; const LAS int* cn; const LAS int* rb;
    __device__ __forceinline__ void operator()(const f32x4 (&acc)[2][2][4][2], const Unit& u, int wr, int wc, int fr, int fq) const {
        const int n = cn[u.e]; const int col0 = u.pn * BM + wc * 32 + 8 * fq;
#pragma unroll
        for (int ai = 0; ai < 2; ++ai)
#pragma unroll
            for (int m = 0; m < 4; ++m) { const int pos = u.pm * BM + ai * HALF + wr * 64 + m * 16 + fr;
                if (pos < n) { const int a = rb[u.e] + pos; float ws = wgt[u.e * TT + pos] * WSCALE_INV; asm volatile("" : "+v"(ws));
                    unsigned char* rowp = Y + (size_t)a * DM + col0;
#pragma unroll
                    for (int bj = 0; bj < 2; ++bj) { const f32x4 v0 = acc[ai][bj][m][0] * ws, v1 = acc[ai][bj][m][1] * ws;
                        u32x2 w;
                        w.x = (unsigned)__builtin_amdgcn_cvt_pk_fp8_f32(v0[0], v0[1], 0, false); w.x = (unsigned)__builtin_amdgcn_cvt_pk_fp8_f32(v0[2], v0[3], (int)w.x, true);
                        w.y = (unsigned)__builtin_amdgcn_cvt_pk_fp8_f32(v1[0], v1[1], 0, false); w.y = (unsigned)__builtin_amdgcn_cvt_pk_fp8_f32(v1[2], v1[3], (int)w.y, true);
                        *(u32x2*)(rowp + bj * HALF) = w; } }
                __builtin_amdgcn_sched_barrier(0); }
    }
};
}
struct KArgs {
    const float* in[34];
    float* out;
    unsigned char* ws;
    int ph_lo, ph_hi;
};
struct Params {
    float* out;
    unsigned char* ws;
    LAS unsigned long long* ptab;
    int ph_lo, ph_hi;
    __device__ __forceinline__ const float* inp(int k) const {
        const unsigned long long v = ptab[k];
        const unsigned lo = __builtin_amdgcn_readfirstlane((unsigned)v), hi = __builtin_amdgcn_readfirstlane((unsigned)(v >> 32));
        return (const float*)(((unsigned long long)hi << 32) | lo);
    }
};
struct Ctx {
    LAS unsigned char* lds;
    int tid, lane, wave, G, bid;
    int gw, ngw;
};

__device__ __forceinline__ void tr_item(const float* W, int N, bf16_t* WT, int ldt, int k0, int n0, int orow0, LAS float* scr, int lane) {
#pragma unroll 8
    for (int i = 0; i < 32; ++i) { const int kk = 2 * i + (lane >> 5); scr[kk * 33 + (lane & 31)] = W[(size_t)(k0 + kk) * N + n0 + (lane & 31)]; }
    LDS_WAIT(); asm volatile("" ::: "memory");
    const int c = lane & 7;
#pragma unroll
    for (int j = 0; j < 4; ++j) { const int n = (lane >> 3) + 8 * j; const LAS float* s = scr + (8 * c) * 33 + n;
        u32x4 o; o.x = cvt_pk_bf16(s[0 * 33], s[1 * 33]); o.y = cvt_pk_bf16(s[2 * 33], s[3 * 33]); o.z = cvt_pk_bf16(s[4 * 33], s[5 * 33]); o.w = cvt_pk_bf16(s[6 * 33], s[7 * 33]);
        *(u32x4*)(WT + (size_t)(orow0 + n) * ldt + k0 + 8 * c) = o; }
    LDS_WAIT(); asm volatile("" ::: "memory");
}
__device__ __forceinline__ void tr_item64(const float* W, int N, bf16_t* WT, int ldt, int k0, int n0, int orow0, LAS float* scr, int lane) {
    f32x4 v[16];
    const float* src = W + (size_t)(k0 + (lane >> 4)) * N + n0 + 4 * (lane & 15);
#pragma unroll
    for (int i = 0; i < 16; ++i) v[i] = __builtin_nontemporal_load((const f32x4*)(src + (size_t)(4 * i) * N));
#pragma unroll
    for (int i = 0; i < 16; ++i) { LAS float* d = scr + (4 * i + (lane >> 4)) * 65 + 4 * (lane & 15); d[0] = v[i][0]; d[1] = v[i][1]; d[2] = v[i][2]; d[3] = v[i][3]; }
    LDS_WAIT(); asm volatile("" ::: "memory");
    const int c = lane & 7;
#pragma unroll
    for (int j = 0; j < 8; ++j) { const int n = (lane >> 3) + 8 * j; const LAS float* s = scr + (8 * c) * 65 + n;
        u32x4 o; o.x = cvt_pk_bf16(s[0 * 65], s[1 * 65]); o.y = cvt_pk_bf16(s[2 * 65], s[3 * 65]); o.z = cvt_pk_bf16(s[4 * 65], s[5 * 65]); o.w = cvt_pk_bf16(s[6 * 65], s[7 * 65]);
        *(u32x4*)(WT + (size_t)(orow0 + n) * ldt + k0 + 8 * c) = o; }
    LDS_WAIT(); asm volatile("" ::: "memory");
}
__device__ __forceinline__ void tr_item64_fp8(const float* W, int N, unsigned char* WT, int ldt, int k0, int n0, int orow0, LAS float* scr, int lane, float wscale = pg8::WSCALE) {
    f32x4 v[16];
    const float* src = W + (size_t)(k0 + (lane >> 4)) * N + n0 + 4 * (lane & 15);
#pragma unroll
    for (int i = 0; i < 16; ++i) v[i] = __builtin_nontemporal_load((const f32x4*)(src + (size_t)(4 * i) * N));
#pragma unroll
    for (int i = 0; i < 16; ++i) { LAS float* d = scr + (4 * i + (lane >> 4)) * 65 + 4 * (lane & 15); d[0] = v[i][0]; d[1] = v[i][1]; d[2] = v[i][2]; d[3] = v[i][3]; }
    LDS_WAIT(); asm volatile("" ::: "memory");
    const int c = lane & 3;
#pragma unroll
    for (int j = 0; j < 4; ++j) { const int n = (lane >> 2) + 16 * j; const LAS float* s = scr + (16 * c) * 65 + n;
        u32x4 o;
        o.x = (unsigned)__builtin_amdgcn_cvt_pk_fp8_f32(s[0 * 65] * wscale, s[1 * 65] * wscale, 0, false);   o.x = (unsigned)__builtin_amdgcn_cvt_pk_fp8_f32(s[2 * 65] * wscale, s[3 * 65] * wscale, (int)o.x, true);
        o.y = (unsigned)__builtin_amdgcn_cvt_pk_fp8_f32(s[4 * 65] * wscale, s[5 * 65] * wscale, 0, false);   o.y = (unsigned)__builtin_amdgcn_cvt_pk_fp8_f32(s[6 * 65] * wscale, s[7 * 65] * wscale, (int)o.y, true);
        o.z = (unsigned)__builtin_amdgcn_cvt_pk_fp8_f32(s[8 * 65] * wscale, s[9 * 65] * wscale, 0, false);   o.z = (unsigned)__builtin_amdgcn_cvt_pk_fp8_f32(s[10 * 65] * wscale, s[11 * 65] * wscale, (int)o.z, true);
        o.w = (unsigned)__builtin_amdgcn_cvt_pk_fp8_f32(s[12 * 65] * wscale, s[13 * 65] * wscale, 0, false); o.w = (unsigned)__builtin_amdgcn_cvt_pk_fp8_f32(s[14 * 65] * wscale, s[15 * 65] * wscale, (int)o.w, true);
        *(u32x4*)(WT + (size_t)(orow0 + n) * ldt + k0 + 16 * c) = o; }
    LDS_WAIT(); asm volatile("" ::: "memory");
}
__device__ __forceinline__ void tr_dense(const float* W, int K, int N, bf16_t* WT, int item, LAS float* scr, int lane) {
    const int nblk = N / 32, kb = item / nblk, nb = item % nblk;
    tr_item(W, N, WT, K, 64 * kb, 32 * nb, 32 * nb, scr, lane);
}

__device__ __forceinline__ void s5_tables(const Params& p, Ctx& C, int dir, int g) {
    LAS f32x2* PW = (LAS f32x2*)C.lds;
    LAS f32x2* BB = PW + 65 * 64;
    LAS f32x2* CX = BB + 64 * 16;
    const float* a_re = p.inp(11); const float* a_im = p.inp(12); const float* log_dt = p.inp(13);
    const float* b_re = p.inp(14); const float* b_im = p.inp(15); const float* c_re = p.inp(16); const float* c_im = p.inp(17);
    const int tid = C.tid;
    if (tid < 64) {
        const int pp = tid;
        const float dt = __expf(log_dt[dir * 64 + g]);
        const float are = a_re[(dir * 64 + g) * 64 + pp], aim = a_im[(dir * 64 + g) * 64 + pp];
        const float zr = are * dt, zi = aim * dt;
        const float mag = __expf(zr);
        double rev = (double)zi * 0.15915494309189535; rev -= floor(rev);
        const float cs = __builtin_amdgcn_cosf((float)rev), sn = __builtin_amdgcn_sinf((float)rev);
        const float abr = mag * cs, abi = mag * sn;
        const float den = are * are + aim * aim, nr = abr - 1.0f, ni = abi;
        const float fre = (nr * are + ni * aim) / den, fim = (ni * are - nr * aim) / den;
        float pr = 1.0f, pi = 0.0f;
#pragma unroll 1
        for (int n = 0; n <= 64; ++n) { PW[n * 64 + pp] = (f32x2){pr, pi}; const float t = pr * abr - pi * abi; pi = pr * abi + pi * abr; pr = t; }
        for (int j = 0; j < 16; ++j) { const float br = b_re[(g * 64 + pp) * 16 + j], bi = b_im[(g * 64 + pp) * 16 + j];
            BB[pp * 16 + j] = (f32x2){fre * br - fim * bi, fre * bi + fim * br}; }
    }
    for (int q = tid; q < 1024; q += NTHR) { const int i = q >> 6, pp = q & 63; CX[i * 64 + pp] = (f32x2){c_re[(g * 16 + i) * 64 + pp], c_im[(g * 16 + i) * 64 + pp]}; }
    __syncthreads();
    bf16_t* KN = (bf16_t*)(p.ws + WS_KN) + (size_t)(dir * 64 + g) * 16 * 1024;
    float* APOW = (float*)(p.ws + WS_APOW) + (size_t)(dir * 64 + g) * 64 * 128;
    float* AL = (float*)(p.ws + WS_AL) + (size_t)(dir * 64 + g) * 128;
#pragma unroll 1
    for (int q = 0; q < 32; ++q) { const int idx = tid + NTHR * q; const int n = idx >> 8, i = (idx >> 4) & 15, j = idx & 15;
        float s = 0.f;
#pragma unroll 4
        for (int pp = 0; pp < 64; ++pp) { const f32x2 c = CX[i * 64 + pp], w = PW[n * 64 + pp], b = BB[pp * 16 + j];
            const float gr = c.x * b.x - c.y * b.y, gi = c.x * b.y + c.y * b.x;
            s += gr * w.x - gi * w.y; }
        KN[(size_t)i * 1024 + n * 16 + j] = f2bf(s); }
    for (int q = tid; q < 4096; q += NTHR) { const int t = q >> 6, pp = q & 63; const f32x2 w = PW[(t + 1) * 64 + pp]; *(f32x2*)(APOW + (size_t)t * 128 + 2 * pp) = w; }
    if (tid < 64) { const f32x2 w = PW[64 * 64 + tid]; *(f32x2*)(AL + 2 * tid) = w; }
    { bf16_t* BBT = (bf16_t*)(p.ws + WS_BBT) + (size_t)(dir * 64 + g) * 128 * 16;
      for (int q = tid; q < 2048; q += NTHR) { const int pq = q >> 4, j = q & 15; const f32x2 b = BB[(pq & 63) * 16 + j]; BBT[q] = f2bf(pq < 64 ? b.x : b.y); } }
    if (dir == 0) { bf16_t* CCt = (bf16_t*)(p.ws + WS_CC) + (size_t)g * 16 * 128;
        for (int q = tid; q < 2048; q += NTHR) { const int i = q >> 7, pq = q & 127; const f32x2 c = CX[i * 64 + (pq & 63)]; CCt[i * 128 + pq] = f2bf(pq < 64 ? c.x : -c.y); } }
    __syncthreads();
}

__device__ __forceinline__ void phase_p0(const Params& p, Ctx& C) {
    for (int task = C.bid; task < 128; task += C.G) s5_tables(p, C, task >> 6, task & 63);
    {
        const int gt = C.bid * NTHR + C.tid, ngt = C.G * NTHR;
        float* R128 = (float*)(p.ws + WS_ROPE128); float* R64 = (float*)(p.ws + WS_ROPE64);
        for (int q = gt; q < 256 * 64 + 256 * 32; q += ngt) {
            int pos, i, half; float* dst;
            if (q < 256 * 64) { pos = q >> 6; i = q & 63; half = 64; dst = R128 + (size_t)q * 2; }
            else { const int r = q - 256 * 64; pos = r >> 5; i = r & 31; half = 32; dst = R64 + (size_t)r * 2; }
            const float freq = exp2f(-(float)i / (float)half * 13.287712379549449f);
            const float ang = (float)pos * freq;
            double rev = (double)ang * 0.15915494309189535; rev -= floor(rev);
            dst[0] = __builtin_amdgcn_cosf((float)rev); dst[1] = __builtin_amdgcn_sinf((float)rev);
        }
        bf16_t* RWT = (bf16_t*)(p.ws + WS_RWT); const float* rw = p.inp(26);
        for (int q = gt; q < 2 * 64 * DM; q += ngt) { const int L = q / (64 * DM), r = q % (64 * DM), e = r / DM, k = r % DM;
            const float w = rw[((size_t)L * DM + k) * 64 + e]; const bf16_t hi = f2bf(w); const bf16_t lo = f2bf(w - bf2f(hi));
            RWT[((size_t)(L * 2 + 0) * 64 + e) * DM + k] = hi; RWT[((size_t)(L * 2 + 1) * 64 + e) * DM + k] = lo; }
    }
    {
        const float* cvec = p.inp(1); const float* cctx = p.inp(3); const float* mw = p.inp(4);
        float* MODP = (float*)(p.ws + WS_MODP);
        for (int task = C.gw; task < 2 * 32 * 48; task += C.ngw) {
            const int L = task / (32 * 48), r = task % (32 * 48), kb = r / 48, cb = r % 48;
            const float sc = siluf_(cvec[64 * kb + C.lane]), sx = siluf_(cctx[64 * kb + C.lane]);
            f32x4 a0 = {0.f, 0.f, 0.f, 0.f}, a1 = {0.f, 0.f, 0.f, 0.f};
            const float* wp = mw + ((size_t)L * DM + 64 * kb) * 12288 + 256 * cb + 4 * C.lane;
#pragma unroll 8
            for (int kk = 0; kk < 64; ++kk) { const f32x4 w = *(const f32x4*)(wp + (size_t)kk * 12288);
                const float s0 = __shfl(sc, kk), s1 = __shfl(sx, kk);
                a0 += w * s0; a1 += w * s1; }
            *(f32x4*)(MODP + ((size_t)((L * 32 + kb) * 2 + 0)) * 12288 + 256 * cb + 4 * C.lane) = a0;
            *(f32x4*)(MODP + ((size_t)((L * 32 + kb) * 2 + 1)) * 12288 + 256 * cb + 4 * C.lane) = a1;
        }
    }
    {
        LAS float* scr = (LAS float*)(C.lds + C.wave * 17408);
        constexpr int J0 = (DM / 64) * (EV_IN / 64), J3 = (DM / 64) * (OD_IN / 64);
        for (int it = C.gw; it < J0 + J3; it += C.ngw) {
            const bool l1 = it >= J0; const int r = l1 ? it - J0 : it; const int N = l1 ? OD_IN : EV_IN; const int nblk = N / 64, kb = r / nblk, nb = r % nblk;
            tr_item64_fp8(p.inp(l1 ? 21 : 8), N, (unsigned char*)(p.ws + (l1 ? WS_WIN1 : WS_WIN0)), DM, 64 * kb, 64 * nb, 64 * nb, scr, C.lane, 32.0f);
        }
        LAS float* scr2 = (LAS float*)(C.lds + C.wave * 17408);
        constexpr int I1 = (DM / 64) * (DM / 32), I2 = (1024 / 64) * (1024 / 32), I4 = I1;
        for (int it = C.gw; it < I1 + I2 + I4; it += C.ngw) {
            int r = it;
            if (r < I1) { tr_dense(p.inp(9), DM, DM, (bf16_t*)(p.ws + WS_WOUT0), r, scr2, C.lane); continue; } r -= I1;
            if (r < I2) { tr_dense(p.inp(19), 1024, 1024, (bf16_t*)(p.ws + WS_WGLU), r, scr2, C.lane); continue; } r -= I2;
            tr_dense(p.inp(22), DM, DM, (bf16_t*)(p.ws + WS_WOUT1), r, scr2, C.lane);
        }
    }
}
__device__ __forceinline__ void phase_p1(const Params& p, Ctx& C) {
    const float* MODP = (const float*)(p.ws + WS_MODP); float* MODF = (float*)(p.ws + WS_MODF); const float* mb = p.inp(5);
    for (int q = C.bid * NTHR + C.tid; q < 2 * 2 * 12288; q += C.G * NTHR) { const int L = q / (2 * 12288), v = (q / 12288) & 1, col = q % 12288;
        float s = mb[L * 12288 + col];
        for (int kb = 0; kb < 32; ++kb) s += MODP[((size_t)((L * 32 + kb) * 2 + v)) * 12288 + col];
        MODF[q] = s; }
}
__device__ __forceinline__ const float* modv(const Params& p, int L, int v, int k) { return (const float*)(p.ws + WS_MODF) + (size_t)(L * 2 + v) * 12288 + k * DM; }

__device__ __forceinline__ void stage_vec(LAS float* dst, const float* src, int tid) { *(LAS f32x4*)(dst + 4 * tid) = *(const f32x4*)(src + 4 * tid); }
__device__ __forceinline__ void conv_item(const Params& p, Ctx& C, int L, int it) {
    LAS float* scr = (LAS float*)(C.lds + C.wave * 17408);
    unsigned char* GU = (unsigned char*)(p.ws + WS_GU) + (size_t)L * NEX1 * 1024 * DM; unsigned char* DT = (unsigned char*)(p.ws + WS_DT) + (size_t)L * NEX1 * DM * EHID;
    const int e = it / 768, r = it % 768, which = r >> 8, q = r & 255;
    if (which < 2) {
        const float* W = (e < 64) ? p.inp(28 + which) + ((size_t)(L * 64 + e)) * DM * EHID : p.inp(31 + which) + (size_t)L * DM * EHID;
        const int kb = q >> 3, nb = q & 7, n0 = 64 * nb;
        tr_item64_fp8(W, EHID, GU + (size_t)e * 1024 * DM, DM, 64 * kb, n0, 256 * (n0 >> 7) + (n0 & 127) + (which ? 128 : 0), scr, C.lane);
    } else {
        const float* W = (e < 64) ? p.inp(30) + ((size_t)(L * 64 + e)) * EHID * DM : p.inp(33) + (size_t)L * EHID * DM;
        const int kb = q >> 5, nb = q & 31;
        tr_item64_fp8(W, DM, DT + (size_t)e * DM * EHID, EHID, 64 * kb, 64 * nb, 64 * nb, scr, C.lane);
    }
}
__device__ __forceinline__ void conv_queue(const Params& p, Ctx& C, int quota) {
    unsigned* head = (unsigned*)(p.ws + WS_CTL) + CW_QUEUE + 128;
    const int batch = quota < 8 ? quota : 8;
    for (int done = 0; done < quota; done += batch) {
        int it0 = 0; if (C.lane == 0) it0 = (int)atomicAdd(head, (unsigned)batch);
        it0 = __builtin_amdgcn_readfirstlane(it0);
        if (it0 >= NEX1 * 768) break;
        for (int k = 0; k < batch && it0 + k < NEX1 * 768; ++k) conv_item(p, C, 1, it0 + k);
    }
}
__device__ __forceinline__ void phase_modulate(const Params& p, Ctx& C, int L) {
    unsigned char* XA8 = (unsigned char*)(p.ws + WS_XA);
    const float* X2 = (const float*)(p.ws + WS_HX2);
    LAS float* MV = (LAS float*)C.lds;
    for (int v = 0; v < 2; ++v) { stage_vec(MV + (v * 2 + 0) * DM, modv(p, L, v, 0), C.tid); stage_vec(MV + (v * 2 + 1) * DM, modv(p, L, v, 1), C.tid); }
    __syncthreads();
    for (int r = C.gw; r < TT; r += C.ngw) {
        const int v = r < CTXL ? 1 : 0;
        const float* src = (L == 0) ? (r < CTXL ? p.inp(2) + (size_t)r * DM : p.inp(0) + (size_t)(r - CTXL) * DM) : X2 + (size_t)r * DM;
        const LAS float* sh = MV + (v * 2 + 0) * DM; const LAS float* sc = MV + (v * 2 + 1) * DM;
#pragma unroll
        for (int j = 0; j < 8; ++j) { const int c = 4 * (C.lane + 64 * j);
            const f32x4 x = *(const f32x4*)(src + c), a = *(const LAS f32x4*)(sc + c), b = *(const LAS f32x4*)(sh + c);
            const f32x4 y = x * (a + 1.0f) + b;
            unsigned w = (unsigned)__builtin_amdgcn_cvt_pk_fp8_f32(y[0], y[1], 0, false); w = (unsigned)__builtin_amdgcn_cvt_pk_fp8_f32(y[2], y[3], (int)w, true);
            *(unsigned*)(XA8 + (size_t)r * DM + c) = w; }
    }
    __syncthreads();
    if (L == 0) { for (int it = C.gw; it < NEX1 * 768; it += C.ngw) conv_item(p, C, 0, it); }
    else conv_queue(p, C, 1 << 30);
}

__device__ __forceinline__ void phase_rope0(const Params& p, Ctx& C) {
    bf16_t* QKV = (bf16_t*)(p.ws + WS_BIG + BG_QKV);
    const f32x2* R128 = (const f32x2*)(p.ws + WS_ROPE128);
    for (int r = C.gw; r < TT; r += C.ngw) {
        bf16_t* row = QKV + (size_t)r * EV_IN;
        if (r < CTXL) {
#pragma unroll
            for (int j = 0; j < 2; ++j) { u32x4* q = (u32x4*)(row + 8 * (C.lane + 64 * j)); u32x4 w = *q;
                w.x = cvt_pk_bf16(bflo(w.x) * 0.0625f, bfhi(w.x) * 0.0625f); w.y = cvt_pk_bf16(bflo(w.y) * 0.0625f, bfhi(w.y) * 0.0625f);
                w.z = cvt_pk_bf16(bflo(w.z) * 0.0625f, bfhi(w.z) * 0.0625f); w.w = cvt_pk_bf16(bflo(w.w) * 0.0625f, bfhi(w.w) * 0.0625f); *q = w; }
        } else {
            const int l = r - CTXL, rp = l >> 6, cp = l & 63;
#pragma unroll
            for (int qk = 0; qk < 2; ++qk)
#pragma unroll
                for (int m = 0; m < 8; ++m) { const int pi = C.lane + 64 * m, head = pi >> 7, blk = (pi >> 6) & 1, i = pi & 63;
                    bf16_t* b = row + qk * 1024 + head * 256 + blk * 128 + i;
                    const f32x2 cs = R128[(blk ? cp : rp) * 64 + i];
                    const float x1 = bf2f(b[0]), x2 = bf2f(b[64]); const float sc = qk ? 1.0f : 0.0625f;
                    b[0] = f2bf((x1 * cs.x - x2 * cs.y) * sc); b[64] = f2bf((x1 * cs.y + x2 * cs.x) * sc); }
        }
    }
}

__device__ __forceinline__ void phase_normrope1(const Params& p, Ctx& C) {
    bf16_t* QKV = (bf16_t*)(p.ws + WS_BIG + BG_QKV);
    const f32x2* R64 = (const f32x2*)(p.ws + WS_ROPE64);
    const float* qg = p.inp(23);
    unsigned* KMAX = (unsigned*)(p.ws + WS_CTL) + CW_KMAX;
    unsigned char* Q8 = (unsigned char*)(p.ws + WS_BIG + BG_Q8); unsigned char* K8 = (unsigned char*)(p.ws + WS_BIG + BG_K8); unsigned char* VT8 = (unsigned char*)(p.ws + WS_BIG + BG_VT8);
    const int lane = C.lane, i32 = lane & 31; const bool up = lane >= 32;
    const float g00 = qg[lane], g01 = qg[64 + lane], g10 = qg[128 + lane], g11 = qg[128 + 64 + lane];
    for (int r = C.gw; r < TT; r += C.ngw) {
        bf16_t* row = QKV + (size_t)r * OD_IN;
        const bool lat = r >= CTXL; const int l = r - CTXL, rp = lat ? (l >> 6) : 0, cp = lat ? (l & 63) : 0;
        const f32x2 cr = R64[rp * 32 + i32], cc = R64[cp * 32 + i32];
#pragma unroll 2
        for (int h = 0; h < 26; ++h) {
            const int col = h < 8 ? 128 * h : (h < 10 ? 1024 + 128 * (h - 8) : (h < 18 ? 1536 + 128 * (h - 10) : 2560 + 128 * (h - 18)));
            bf16_t* b = row + col;
            float v0 = bf2f(b[lane]), v1 = bf2f(b[64 + lane]);
            if (h < 10) { const float ss = wave_sum(v0 * v0 + v1 * v1); const float rs = rsqrtf(ss * (1.0f / 128.0f) + LN_EPS);
                v0 = bf2f(f2bf(v0 * rs)) * (h < 8 ? g00 : g10); v1 = bf2f(f2bf(v1 * rs)) * (h < 8 ? g01 : g11); }
            if (lat) { const float p0 = __shfl_xor(v0, 32), p1 = __shfl_xor(v1, 32);
                v0 = up ? (p0 * cr.y + v0 * cr.x) : (v0 * cr.x - p0 * cr.y);
                v1 = up ? (p1 * cc.y + v1 * cc.x) : (v1 * cc.x - p1 * cc.y); }
            const bf16_t o0 = f2bf(v0), o1 = f2bf(v1);
            b[lane] = o0; b[64 + lane] = o1;
            if (h < 10) {
                const float w0 = bf2f(o0), w1 = bf2f(o1);
                float e4[4];
#pragma unroll
                for (int j = 0; j < 4; ++j) { const float a = __shfl(w0, (4 * lane + j) & 63), c2 = __shfl(w1, (4 * lane + j) & 63); e4[j] = lane < 16 ? a : c2; }
                unsigned pk = (unsigned)__builtin_amdgcn_cvt_pk_fp8_f32(e4[0], e4[1], 0, false); pk = (unsigned)__builtin_amdgcn_cvt_pk_fp8_f32(e4[2], e4[3], (int)pk, true);
                unsigned char* dst8 = h < 8 ? Q8 + (size_t)r * 1024 + 128 * h : K8 + (size_t)r * 256 + 128 * (h - 8);
                if (lane < 32) *(unsigned*)(dst8 + 4 * lane) = pk; }
            if ((h >= 8 && h < 10) || h >= 18) {
                const float w0 = bf2f(o0), w1 = bf2f(o1); const float k2 = wave_sum(w0 * w0 + w1 * w1);
                if (lane == 0) atomicMax(KMAX + 64 * (h < 10 ? h - 8 : h - 16), __float_as_uint(k2)); }
        }
    }
    LAS bf16_t* vt = (LAS bf16_t*)(C.lds + C.wave * 17408);
    for (int item = C.gw; item < 2 * 260; item += C.ngw) {
        const int kh = item / 260, T = item % 260;
#pragma unroll
        for (int q = 0; q < 16; ++q) { const int idx = lane + 64 * q, key = idx >> 4, c = idx & 15;
            *(LAS u32x4*)(vt + key * 136 + 8 * c) = *(const u32x4*)(QKV + (size_t)(64 * T + key) * OD_IN + 1280 + 128 * kh + 8 * c); }
        LDS_WAIT(); asm volatile("" ::: "memory");
#pragma unroll
        for (int dd = 0; dd < 2; ++dd) { const int d = lane + 64 * dd;
            unsigned char* dst = VT8 + ((size_t)(kh * 260 + T) * 128 + d) * 64;
#pragma unroll
            for (int cch = 0; cch < 4; ++cch) { u32x4 w;
#pragma unroll
                for (int wd = 0; wd < 4; ++wd) { float f[4];
#pragma unroll
                    for (int e = 0; e < 4; ++e) { const int bb = 16 * cch + 4 * wd + e, hi2 = bb >> 5, blk = (bb >> 4) & 1, j = bb & 15; const int key = 32 * blk + (j & 3) + 8 * (j >> 2) + 4 * hi2;
                        f[e] = bf2f(vt[key * 136 + d]); }
                    unsigned pk = (unsigned)__builtin_amdgcn_cvt_pk_fp8_f32(f[0], f[1], 0, false); pk = (unsigned)__builtin_amdgcn_cvt_pk_fp8_f32(f[2], f[3], (int)pk, true);
                    w[wd] = pk; }
                *(u32x4*)(dst + 16 * cch) = w; } }
        LDS_WAIT(); asm volatile("" ::: "memory");
    }
}

__device__ __forceinline__ void phase_merge1(const Params& p, Ctx& C) {
    bf16_t* ATT = (bf16_t*)(p.ws + WS_BIG + BG_ATT);
    const float* dl = p.inp(24); const float* sg = p.inp(25);
    const int lane = C.lane;
    float d0 = dl[lane] * dl[128 + lane] + dl[64 + lane] * dl[128 + 64 + lane];
    float d1 = dl[256 + lane] * dl[384 + lane] + dl[256 + 64 + lane] * dl[384 + 64 + lane];
    const float lam = __expf(wave_sum(d0)) - __expf(wave_sum(d1)) + LAMBDA_INIT;
    const f32x4 gg = *(const f32x4*)(sg + 4 * lane);
    for (int l = C.gw; l < SEQ; l += C.ngw) {
        bf16_t* row = ATT + (size_t)l * 3072;
#pragma unroll
        for (int h = 0; h < 4; ++h) {
            const u32x2 a = *(const u32x2*)(row + 1024 + 256 * h + 4 * lane), b = *(const u32x2*)(row + 2048 + 256 * h + 4 * lane);
            f32x4 o = {bflo(a.x) - lam * bflo(b.x), bfhi(a.x) - lam * bfhi(b.x), bflo(a.y) - lam * bflo(b.y), bfhi(a.y) - lam * bfhi(b.y)};
            const float ss = wave_sum(o[0] * o[0] + o[1] * o[1] + o[2] * o[2] + o[3] * o[3]);
            const float rs = rsqrtf(ss * (1.0f / 256.0f) + LN_EPS) * (1.0f - LAMBDA_INIT);
            o = o * rs * gg;
            u32x2 w; w.x = cvt_pk_bf16(o[0], o[1]); w.y = cvt_pk_bf16(o[2], o[3]);
            *(u32x2*)(row + 1024 + 256 * h + 4 * lane) = w;
        }
    }
}

__device__ __forceinline__ void phase_ln1(const Params& p, Ctx& C, int L) {
    const bf16_t* Y = (const bf16_t*)(p.ws + WS_YMIX); float* X1 = (float*)(p.ws + WS_X1); unsigned char* XA8 = (unsigned char*)(p.ws + WS_XA);
    const float* X2 = (const float*)(p.ws + WS_HX2);
    const float* lg = p.inp(6) + (size_t)(L * 2 + 0) * DM; const float* lb = p.inp(7) + (size_t)(L * 2 + 0) * DM;
    const int r0 = (L == 0) ? 0 : CTXL;
    LAS float* MV = (LAS float*)C.lds; LAS float* LG = MV + 6 * DM; LAS float* LB = LG + DM;
    for (int v = 0; v < 2; ++v) for (int k = 0; k < 3; ++k) stage_vec(MV + (v * 3 + k) * DM, modv(p, L, v, 2 + k), C.tid);
    stage_vec(LG, lg, C.tid); stage_vec(LB, lb, C.tid);
    __syncthreads();
    for (int r = r0 + C.gw; r < TT; r += C.ngw) {
        const int v = r < CTXL ? 1 : 0;
        const float* src = (L == 0) ? (r < CTXL ? p.inp(2) + (size_t)r * DM : p.inp(0) + (size_t)(r - CTXL) * DM) : X2 + (size_t)r * DM;
        const LAS float* g1 = MV + (v * 3 + 0) * DM; const LAS float* sh2 = MV + (v * 3 + 1) * DM; const LAS float* sc2 = MV + (v * 3 + 2) * DM;
        f32x4 t[8]; float s = 0.f;
#pragma unroll
        for (int j = 0; j < 8; ++j) { const int c = 4 * (C.lane + 64 * j);
            const f32x4 x = *(const f32x4*)(src + c), g = *(const LAS f32x4*)(g1 + c); const u32x2 yy = *(const u32x2*)(Y + (size_t)r * DM + c);
            const f32x4 y = {bflo(yy.x), bfhi(yy.x), bflo(yy.y), bfhi(yy.y)};
            t[j] = x * ALPHA + g * y; s += (t[j][0] + t[j][1]) + (t[j][2] + t[j][3]); }
        const float mean = wave_sum(s) * (1.0f / DM); float s2 = 0.f;
#pragma unroll
        for (int j = 0; j < 8; ++j) { t[j] = t[j] - mean; s2 += (t[j][0] * t[j][0] + t[j][1] * t[j][1]) + (t[j][2] * t[j][2] + t[j][3] * t[j][3]); }
        const float rstd = rsqrtf(wave_sum(s2) * (1.0f / DM) + LN_EPS);
#pragma unroll
        for (int j = 0; j < 8; ++j) { const int c = 4 * (C.lane + 64 * j);
            const f32x4 x1 = t[j] * rstd * *(const LAS f32x4*)(LG + c) + *(const LAS f32x4*)(LB + c);
            *(f32x4*)(X1 + (size_t)r * DM + c) = x1;
            const f32x4 z = x1 * (*(const LAS f32x4*)(sc2 + c) + 1.0f) + *(const LAS f32x4*)(sh2 + c);
            unsigned w = (unsigned)__builtin_amdgcn_cvt_pk_fp8_f32(z[0], z[1], 0, false); w = (unsigned)__builtin_amdgcn_cvt_pk_fp8_f32(z[2], z[3], (int)w, true);
            *(unsigned*)(XA8 + (size_t)r * DM + c) = w; }
    }
    __syncthreads();
}

__device__ __forceinline__ void phase_combine(const Params& p, Ctx& C, int L, LAS unsigned char* misc) {
    const unsigned char* YM = (const unsigned char*)(p.ws + WS_BIG + BG_YMOE); const float* X1 = (const float*)(p.ws + WS_X1);
    float* X2 = (float*)(p.ws + WS_HX2);
    const float* lg = p.inp(6) + (size_t)(L * 2 + 1) * DM; const float* lb = p.inp(7) + (size_t)(L * 2 + 1) * DM;
    const unsigned* PK = (const unsigned*)(p.ws + WS_WGT); const int* cnt = (const int*)(p.ws + WS_CTL) + CW_CNT + L * 128;
    const int r0 = (L == 0) ? 0 : CTXL;
    LAS int* rb = (LAS int*)(misc + 64);
    LAS float* MV = (LAS float*)C.lds; LAS float* LG = MV + 2 * DM; LAS float* LB = LG + DM;
    __syncthreads();
    if (C.tid == 0) { int q = 0; for (int e = 0; e < NEX1; ++e) { rb[e] = q; q += cnt[e]; } }
    stage_vec(MV, modv(p, L, 0, 5), C.tid); stage_vec(MV + DM, modv(p, L, 1, 5), C.tid); stage_vec(LG, lg, C.tid); stage_vec(LB, lb, C.tid);
    __syncthreads();
    for (int r = r0 + C.gw; r < TT; r += C.ngw) {
        const int v = r < CTXL ? 1 : 0;
        const LAS float* g2 = MV + v * DM;
        int ln = C.lane; asm volatile("" : "+v"(ln));
        int slot = rb[64] + (r - r0);
        if (ln < 8) { const unsigned pk = PK[(size_t)r * 8 + ln]; slot = rb[pk >> 16] + (int)(pk & 0xffffu); }
        f32x4 t[2][4]; float s = 0.f;
#pragma unroll
        for (int j = 0; j < 2; ++j) { const int c = 16 * (ln + 64 * j);
            u32x4 yy[9];
#pragma unroll
            for (int k = 0; k < 9; ++k) { const size_t a = (size_t)__builtin_amdgcn_readlane(slot, k); yy[k] = __builtin_nontemporal_load((const u32x4*)(YM + a * DM + c)); }
            f32x2 f[8];
#pragma unroll
            for (int q = 0; q < 8; ++q) f[q] = (f32x2){0.f, 0.f};
#pragma unroll
            for (int k = 0; k < 9; ++k) {
                f[0] += __builtin_amdgcn_cvt_pk_f32_fp8((int)yy[k].x, false); f[1] += __builtin_amdgcn_cvt_pk_f32_fp8((int)yy[k].x, true);
                f[2] += __builtin_amdgcn_cvt_pk_f32_fp8((int)yy[k].y, false); f[3] += __builtin_amdgcn_cvt_pk_f32_fp8((int)yy[k].y, true);
                f[4] += __builtin_amdgcn_cvt_pk_f32_fp8((int)yy[k].z, false); f[5] += __builtin_amdgcn_cvt_pk_f32_fp8((int)yy[k].z, true);
                f[6] += __builtin_amdgcn_cvt_pk_f32_fp8((int)yy[k].w, false); f[7] += __builtin_amdgcn_cvt_pk_f32_fp8((int)yy[k].w, true); }
#pragma unroll
            for (int q = 0; q < 4; ++q) { const f32x4 x = *(const f32x4*)(X1 + (size_t)r * DM + c + 4 * q), g = *(const LAS f32x4*)(g2 + c + 4 * q);
                const f32x4 ff = {f[2 * q][0], f[2 * q][1], f[2 * q + 1][0], f[2 * q + 1][1]};
                t[j][q] = x * ALPHA + g * ff; s += (t[j][q][0] + t[j][q][1]) + (t[j][q][2] + t[j][q][3]); } }
        const float mean = wave_sum(s) * (1.0f / DM); float s2 = 0.f;
#pragma unroll
        for (int j = 0; j < 2; ++j)
#pragma unroll
            for (int q = 0; q < 4; ++q) { t[j][q] = t[j][q] - mean; s2 += (t[j][q][0] * t[j][q][0] + t[j][q][1] * t[j][q][1]) + (t[j][q][2] * t[j][q][2] + t[j][q][3] * t[j][q][3]); }
        const float rstd = rsqrtf(wave_sum(s2) * (1.0f / DM) + LN_EPS);
        float* dst = (L == 0) ? X2 + (size_t)r * DM : p.out + (size_t)(r - CTXL) * DM;
#pragma unroll
        for (int j = 0; j < 2; ++j)
#pragma unroll
            for (int q = 0; q < 4; ++q) { const int c = 16 * (ln + 64 * j) + 4 * q;
                *(f32x4*)(dst + c) = t[j][q] * rstd * *(const LAS f32x4*)(LG + c) + *(const LAS f32x4*)(LB + c); }
    }
}
constexpr int RLD = 264;
constexpr int SLD = 136;

template <bool SCALE>
__device__ __forceinline__ void stage_chunk(const bf16_t* QKV, int row0, int col0, LAS bf16_t* dst, int tid, float lg  , int dirb) {
#pragma unroll
    for (int q = 0; q < 8; ++q) { const int idx = tid + NTHR * q, r = idx >> 5, c = idx & 31;
        u32x4 w = *(const u32x4*)(QKV + (size_t)(row0 + r) * EV_IN + col0 + 8 * c);
        if (SCALE) { const float sc = fast_exp((dirb ? (float)r : (float)(127 - r)) * lg);
            w.x = cvt_pk_bf16(bflo(w.x) * sc, bfhi(w.x) * sc); w.y = cvt_pk_bf16(bflo(w.y) * sc, bfhi(w.y) * sc);
            w.z = cvt_pk_bf16(bflo(w.z) * sc, bfhi(w.z) * sc); w.w = cvt_pk_bf16(bflo(w.w) * sc, bfhi(w.w) * sc); }
        *(LAS u32x4*)(dst + r * RLD + 8 * c) = w; }
}

__device__ __forceinline__ void ret_chunk_kv(const Params& p, Ctx& C) {
    const bf16_t* QKV = (const bf16_t*)(p.ws + WS_BIG + BG_QKV); bf16_t* CKV = (bf16_t*)(p.ws + WS_BIG + BG_CKV);
    const float* rld = p.inp(10);
    LAS bf16_t* Vs = (LAS bf16_t*)C.lds; LAS bf16_t* Ks = Vs + 128 * RLD;
    const int lane = C.lane, w = C.wave;
    for (int unit = C.bid; unit < 130 * 8; unit += C.G) {
        const int u = unit >> 3, h = (unit >> 1) & 3, dir = unit & 1;
        const float lg = rld[dir * 4 + h];
        __syncthreads();
        stage_chunk<false>(QKV, 128 * u, 2048 + 256 * h, Vs, C.tid, 0.f, 0);
        stage_chunk<true>(QKV, 128 * u, 1024 + 256 * h, Ks, C.tid, lg, dir);
        __syncthreads();
        f32x4 acc[2][16];
#pragma unroll
        for (int a = 0; a < 2; ++a)
#pragma unroll
            for (int b = 0; b < 16; ++b) acc[a][b] = (f32x4){0.f, 0.f, 0.f, 0.f};
        const unsigned vbase = (unsigned)(uintptr_t)Vs, kbase = (unsigned)(uintptr_t)Ks;
#pragma unroll 1
        for (int ks = 0; ks < 4; ++ks) {
            bf16x8 af[2];
#pragma unroll
            for (int a = 0; a < 2; ++a) af[a] = frag_colk_l(vbase + (unsigned)((32 * ks) * RLD + 32 * w + 16 * a) * 2u, RLD * 2, lane);
#pragma unroll
            for (int b = 0; b < 16; ++b) { const bf16x8 bf = frag_colk_l(kbase + (unsigned)((32 * ks) * RLD + 16 * b) * 2u, RLD * 2, lane);
                acc[0][b] = MFMA16(bf, af[0], acc[0][b]); acc[1][b] = MFMA16(bf, af[1], acc[1][b]); }
        }
        bf16_t* dst = CKV + ((size_t)((dir * 4 + h) * 130 + u)) * 65536;
#pragma unroll
        for (int a = 0; a < 2; ++a)
#pragma unroll
            for (int b = 0; b < 16; ++b) { u32x2 w2; w2.x = cvt_pk_bf16(acc[a][b][0], acc[a][b][1]); w2.y = cvt_pk_bf16(acc[a][b][2], acc[a][b][3]);
                *(u32x2*)(dst + (size_t)(32 * w + 16 * a + (lane & 15)) * 256 + 16 * b + 4 * (lane >> 4)) = w2; }
    }
    __syncthreads();
}

__device__ __forceinline__ int s5_row(int dir, int c, int s) { return dir == 0 ? 64 * c + s : (c < 4 ? 255 - (64 * c + s) : 16639 - 64 * (c - 4) - s); }

__device__ __forceinline__ void s5_end_states(const Params& p, Ctx& C) {
    const bf16_t* QKV = (const bf16_t*)(p.ws + WS_BIG + BG_QKV); const bf16_t* BBT = (const bf16_t*)(p.ws + WS_BBT); float* E = (float*)(p.ws + WS_S5E);
    const float* APOW = (const float*)(p.ws + WS_APOW);
    LAS f32x2* PL = (LAS f32x2*)C.lds;
    for (int bt = C.bid; bt < 256; bt += C.G) {
        int tid = C.tid; asm volatile("" : "+v"(tid));
        const int lane = tid & 63, r32 = lane & 31, hi = lane >> 5;
        const int dg = bt >> 1, dir = dg >> 6, g = dg & 63, c0 = 130 * (bt & 1);
        __syncthreads();
#pragma unroll
        for (int q = 0; q < 8; ++q) { const int idx = tid + NTHR * q, s = idx >> 6, pp = idx & 63;
            PL[idx] = (s == 63) ? (f32x2){1.0f, 0.0f} : *(const f32x2*)(APOW + ((size_t)dg * 64 + (62 - s)) * 128 + 2 * pp); }
        __syncthreads();
        bf16x8 bfr[4];
#pragma unroll
        for (int pt = 0; pt < 4; ++pt) bfr[pt] = *(const bf16x8*)(BBT + ((size_t)dg * 128 + 32 * pt + r32) * 16 + 8 * hi);
        for (int c = c0 + C.wave; c < c0 + 130; c += 8) {
            float er[2] = {0.f, 0.f}, ei[2] = {0.f, 0.f};
#pragma unroll
            for (int st = 0; st < 2; ++st) {
                const bf16x8 a = *(const bf16x8*)(QKV + (size_t)s5_row(dir, c, 32 * st + r32) * EV_IN + 4096 + 16 * g + 8 * hi);
                f32x16 d[4];
#pragma unroll
                for (int pt = 0; pt < 4; ++pt) d[pt] = __builtin_amdgcn_mfma_f32_32x32x16_bf16(a, bfr[pt], (f32x16){}, 0, 0, 0);
#pragma unroll
                for (int r = 0; r < 16; ++r) { const int s = 32 * st + (r & 3) + 8 * (r >> 2) + 4 * hi;
#pragma unroll
                    for (int pt = 0; pt < 2; ++pt) { const f32x2 pw = PL[s * 64 + 32 * pt + r32]; const float br = d[pt][r], bi = d[pt + 2][r];
                        er[pt] += pw.x * br - pw.y * bi; ei[pt] += pw.x * bi + pw.y * br; } }
            }
#pragma unroll
            for (int pt = 0; pt < 2; ++pt) {
                { auto rr = __builtin_amdgcn_permlane32_swap(__float_as_uint(er[pt]), __float_as_uint(er[pt]), false, false); er[pt] = __uint_as_float(rr[0]) + __uint_as_float(rr[1]); }
                { auto rr = __builtin_amdgcn_permlane32_swap(__float_as_uint(ei[pt]), __float_as_uint(ei[pt]), false, false); ei[pt] = __uint_as_float(rr[0]) + __uint_as_float(rr[1]); }
            }
            float* dst = E + ((size_t)dg * 260 + c) * 128;
            if (hi == 0) { dst[r32] = er[0]; dst[32 + r32] = er[1]; dst[64 + r32] = ei[0]; dst[96 + r32] = ei[1]; }
        }
    }
    __syncthreads();
}

__device__ __forceinline__ void phase_scans(const Params& p, Ctx& C) {
    const bf16_t* CKV = (const bf16_t*)(p.ws + WS_BIG + BG_CKV); bf16_t* SP = (bf16_t*)(p.ws + WS_BIG + BG_SPREV);
    const float* rld = p.inp(10);
    for (int q = C.bid * NTHR + C.tid; q < 8 * 16384; q += C.G * NTHR) {
        const int dh = q >> 14, el = (q & 16383) * 4, dir = dh >> 2, h = dh & 3;
        const float gch = fast_exp(128.0f * rld[dir * 4 + h]);
        const bf16_t* src = CKV + (size_t)dh * 130 * 65536 + el; bf16_t* dst = SP + (size_t)dh * 130 * 65536 + el;
        f32x4 s = {0.f, 0.f, 0.f, 0.f};
        for (int st0 = 0; st0 < 130; st0 += 13) {
            u32x2 kv[13];
#pragma unroll
            for (int k = 0; k < 13; ++k) { const int st = st0 + k; const int u = dir == 0 ? st : (st == 0 ? 1 : (st == 1 ? 0 : 131 - st)); kv[k] = __builtin_nontemporal_load((const u32x2*)(src + (size_t)u * 65536)); }
#pragma unroll
            for (int k = 0; k < 13; ++k) { const int st = st0 + k; const int u = dir == 0 ? st : (st == 0 ? 1 : (st == 1 ? 0 : 131 - st));
                u32x2 w; w.x = cvt_pk_bf16(s[0], s[1]); w.y = cvt_pk_bf16(s[2], s[3]); *(u32x2*)(dst + (size_t)u * 65536) = w;
                s = s * gch + (f32x4){bflo(kv[k].x), bfhi(kv[k].x), bflo(kv[k].y), bfhi(kv[k].y)}; }
        }
    }
    const float* E = (const float*)(p.ws + WS_S5E); float* HST = (float*)(p.ws + WS_HST); const float* AL = (const float*)(p.ws + WS_AL);
    for (int q = C.bid * NTHR + C.tid; q < 2 * 64 * 64; q += C.G * NTHR) {
        const int dg = q >> 6, pp = q & 63;
        const f32x2 al = *(const f32x2*)(AL + (size_t)dg * 128 + 2 * pp);
        const float* e = E + (size_t)dg * 260 * 128; float* hs = HST + (size_t)dg * 260 * 128;
        float hr = 0.f, hi = 0.f;
        for (int c0 = 0; c0 < 260; c0 += 26) {
            float er[26], ei[26];
#pragma unroll
            for (int k = 0; k < 26; ++k) { er[k] = e[(size_t)(c0 + k) * 128 + pp]; ei[k] = e[(size_t)(c0 + k) * 128 + 64 + pp]; }
#pragma unroll
            for (int k = 0; k < 26; ++k) { *(f32x2*)(hs + (size_t)(c0 + k) * 128 + 2 * pp) = (f32x2){hr, hi};
                const float t = al.x * hr - al.y * hi + er[k]; hi = al.x * hi + al.y * hr + ei[k]; hr = t; }
        }
    }
}

__device__ __forceinline__ void ret_output_unit(const Params& p, Ctx& C, int unit) {
    const bf16_t* QKV = (const bf16_t*)(p.ws + WS_BIG + BG_QKV); const bf16_t* SP = (const bf16_t*)(p.ws + WS_BIG + BG_SPREV);
    bf16_t* MIX = (bf16_t*)(p.ws + WS_BIG + BG_MIX);
    const float* rld = p.inp(10);
    LAS bf16_t* RA = (LAS bf16_t*)C.lds; LAS bf16_t* RB = RA + 128 * RLD;
    int tid = C.tid; asm volatile("" : "+v"(tid));
    const int lane = tid & 63, w = C.wave, kq = lane >> 4, fr = lane & 15;
    const int u = unit >> 2, h = unit & 3;
    const float lgf = rld[h], lgb = rld[4 + h];
    stage_chunk<false>(QKV, 128 * u, 256 * h, RA, tid, 0.f, 0);
    int ib = 16 * w + 4 * kq, jb = fr; asm volatile("" : "+v"(ib), "+v"(jb));
    f32x4 acc[16];
#pragma unroll
    for (int t = 0; t < 16; ++t) acc[t] = (f32x4){0.f, 0.f, 0.f, 0.f};
#pragma unroll
    for (int dir = 0; dir < 2; ++dir) {
        const bf16_t* Sd = SP + ((size_t)((dir * 4 + h) * 130 + u)) * 65536;
#pragma unroll
        for (int eh = 0; eh < 2; ++eh) {
            __syncthreads();
#pragma unroll
            for (int q = 0; q < 8; ++q) { const int idx = tid + NTHR * q, rr = idx >> 5, c = idx & 31;
                *(LAS u32x4*)(RB + rr * RLD + 8 * c) = *(const u32x4*)(Sd + (size_t)(128 * eh + rr) * 256 + 8 * c);
                if (q == 3) asm volatile("" ::: "memory"); }
            __syncthreads();
#pragma unroll 1
            for (int ks = 0; ks < 8; ++ks) { const bf16x8 af = frag_rowk_l(RA + (16 * w) * RLD + 32 * ks, RLD, lane);
#pragma unroll
                for (int t = 0; t < 8; ++t) { const bf16x8 bf = frag_rowk_l(RB + (16 * t) * RLD + 32 * ks, RLD, lane); acc[8 * eh + t] = MFMA16(af, bf, acc[8 * eh + t]); } }
        }
#pragma unroll
        for (int r = 0; r < 4; ++r) { const int i = ib + r; const float qd = fast_exp((float)(128 - i) * lgb);
            const float f = (dir == 0) ? fast_exp((float)(i + 1) * lgf) / qd : qd;
#pragma unroll
            for (int t = 0; t < 16; ++t) acc[t][r] *= f; }
    }
    __syncthreads();
    stage_chunk<false>(QKV, 128 * u, 1024 + 256 * h, RB, tid, 0.f, 0);
    __syncthreads();
    f32x4 sc[8];
#pragma unroll
    for (int t = 0; t < 8; ++t) sc[t] = (f32x4){0.f, 0.f, 0.f, 0.f};
#pragma unroll 1
    for (int ks = 0; ks < 8; ++ks) { const bf16x8 af = frag_rowk_l(RA + (16 * w) * RLD + 32 * ks, RLD, lane);
#pragma unroll
        for (int t = 0; t < 8; ++t) { const bf16x8 bf = frag_rowk_l(RB + (16 * t) * RLD + 32 * ks, RLD, lane); sc[t] = MFMA16(af, bf, sc[t]); } }
#pragma unroll
    for (int t = 0; t < 8; ++t)
#pragma unroll
        for (int r = 0; r < 4; ++r) { const int i = ib + r, j = 16 * t + jb; const float d = (float)(i - j);
            const float m = (i >= j ? fast_exp(d * lgf) : 0.f) + (j >= i ? fast_exp(-d * lgb) : 0.f); sc[t][r] *= m; }
    __syncthreads();
    stage_chunk<false>(QKV, 128 * u, 2048 + 256 * h, RA, tid, 0.f, 0);
#pragma unroll
    for (int t = 0; t < 8; ++t)
#pragma unroll
        for (int r = 0; r < 4; ++r) RB[(16 * w + 4 * kq + r) * SLD + 16 * t + fr] = f2bf(sc[t][r]);
    __syncthreads();
    const unsigned vbase = (unsigned)(uintptr_t)RA;
#pragma unroll 1
    for (int ks = 0; ks < 4; ++ks) { const bf16x8 af = frag_rowk_l(RB + (16 * w) * SLD + 32 * ks, SLD, lane);
#pragma unroll
        for (int t = 0; t < 16; ++t) { const bf16x8 bf = frag_colk_l(vbase + (unsigned)((32 * ks) * RLD + 16 * t) * 2u, RLD * 2, lane); acc[t] = MFMA16(af, bf, acc[t]); } }
    __syncthreads();
#pragma unroll
    for (int r = 0; r < 4; ++r) {
        float s = 0.f;
#pragma unroll
        for (int t = 0; t < 16; ++t) s += acc[t][r];
        s += __shfl_xor(s, 1); s += __shfl_xor(s, 2); s += __shfl_xor(s, 4); s += __shfl_xor(s, 8);
        const float mean = s * (1.0f / 256.0f); float q = 0.f;
#pragma unroll
        for (int t = 0; t < 16; ++t) { const float d = acc[t][r] - mean; q += d * d; }
        q += __shfl_xor(q, 1); q += __shfl_xor(q, 2); q += __shfl_xor(q, 4); q += __shfl_xor(q, 8);
        const float rstd = rsqrtf(q * (1.0f / 256.0f) + LN_EPS);
#pragma unroll
        for (int t = 0; t < 16; ++t) RA[(16 * w + 4 * kq + r) * RLD + 16 * t + fr] = f2bf((acc[t][r] - mean) * rstd);
    }
    __syncthreads();
#pragma unroll
    for (int q = 0; q < 8; ++q) { const int idx = tid + NTHR * q, rr = idx >> 5, c = idx & 31; const size_t row = (size_t)(128 * u + rr);
        const u32x4 o = *(const LAS u32x4*)(RA + rr * RLD + 8 * c), g = *(const u32x4*)(QKV + row * EV_IN + 3072 + 256 * h + 8 * c);
        u32x4 w4;
        w4.x = cvt_pk_bf16(bflo(o.x) * siluf_(bflo(g.x)), bfhi(o.x) * siluf_(bfhi(g.x))); w4.y = cvt_pk_bf16(bflo(o.y) * siluf_(bflo(g.y)), bfhi(o.y) * siluf_(bfhi(g.y)));
        w4.z = cvt_pk_bf16(bflo(o.z) * siluf_(bflo(g.z)), bfhi(o.z) * siluf_(bfhi(g.z))); w4.w = cvt_pk_bf16(bflo(o.w) * siluf_(bflo(g.w)), bfhi(o.w) * siluf_(bfhi(g.w)));
        *(u32x4*)(MIX + row * DM + 256 * h + 8 * c) = w4; }
    __syncthreads();
}

constexpr int KLD = 1032;
__device__ __forceinline__ void s5_output_task(const Params& p, Ctx& C, int bt) {
    const bf16_t* QKV = (const bf16_t*)(p.ws + WS_BIG + BG_QKV); bf16_t* Z = (bf16_t*)(p.ws + WS_Z);
    const bf16_t* KN = (const bf16_t*)(p.ws + WS_KN); const bf16_t* CCt = (const bf16_t*)(p.ws + WS_CC);
    const float* APOW = (const float*)(p.ws + WS_APOW); const float* HST = (const float*)(p.ws + WS_HST); const float* dsk = p.inp(18);
    int tid = C.tid; asm volatile("" : "+v"(tid));
    const int lane = tid & 63, kq = lane >> 4, fr = lane & 15;
    LAS bf16_t* KF = (LAS bf16_t*)C.lds; LAS bf16_t* KB = KF + 16 * KLD;
    LAS bf16_t* U = KB + 16 * KLD + C.wave * 3072;
    LAS float* PW0 = (LAS float*)(KB + 16 * KLD + 8 * 3072);
    LAS float* PW16 = PW0 + 2 * 16 * 128;
    {
        const int g = bt >> 3, k0 = (260 * (bt & 7)) >> 3, k1 = (260 * ((bt & 7) + 1)) >> 3;
#pragma unroll
        for (int q = 0; q < 8; ++q) { const int idx = tid + NTHR * q, dir = idx >> 11, rr = (idx >> 7) & 15, c = idx & 127;
            *(LAS u32x4*)((dir ? KB : KF) + rr * KLD + 8 * c) = *(const u32x4*)(KN + ((size_t)(dir * 64 + g) * 16 + rr) * 1024 + 8 * c); }
        for (int q = lane; q < 192 * 2; q += 64) *(LAS u32x4*)(U + 8 * q) = (u32x4){0u, 0u, 0u, 0u};
#pragma unroll
        for (int q = 0; q < 2; ++q) { const int idx = tid + NTHR * q, dir = idx >> 9, f = (idx >> 5) & 15, c4 = idx & 31;
            *(LAS f32x4*)(PW0 + dir * 2048 + f * 128 + 4 * c4) = *(const f32x4*)(APOW + ((size_t)(dir * 64 + g) * 64 + (dir == 0 ? f : 15 - f)) * 128 + 4 * c4); }
        if (tid < 64) { const int dir = tid >> 5, c4 = tid & 31; *(LAS f32x4*)(PW16 + dir * 128 + 4 * c4) = *(const f32x4*)(APOW + ((size_t)(dir * 64 + g) * 64 + 15) * 128 + 4 * c4); }
        __syncthreads();
        const f32x4 dv = *(const f32x4*)(dsk + 16 * g + 4 * kq);
        bf16x8 ccr[2], cci[2];
#pragma unroll
        for (int hb = 0; hb < 2; ++hb) { ccr[hb] = frag_rowk_g(CCt + (size_t)g * 16 * 128 + 32 * hb, 128, lane); cci[hb] = frag_rowk_g(CCt + (size_t)g * 16 * 128 + 64 + 32 * hb, 128, lane); }
        const LAS float* pw0l = PW0 + (size_t)fr * 128 + 16 * kq;
        const LAS float* pw16l = PW16 + 16 * kq;
        for (int k = k0 + C.wave; k < k1; k += 8) {
            LDS_WAIT(); asm volatile("" ::: "memory");
            for (int q = lane; q < 128; q += 64) { const int t = q >> 1, hf = q & 1;
                *(LAS u32x4*)(U + (64 + t) * 16 + 8 * hf) = *(const u32x4*)(QKV + (size_t)(64 * k + t) * EV_IN + 4096 + 16 * g + 8 * hf); }
            LDS_WAIT(); asm volatile("" ::: "memory");
            const int cf = k, cb = k < 4 ? 3 - k : 263 - k;
            f32x4 acc[4];
#pragma unroll
            for (int tt = 0; tt < 4; ++tt) acc[tt] = (f32x4){0.f, 0.f, 0.f, 0.f};
            const LAS bf16_t* ubf = U + (64 + fr - (kq >> 1)) * 16 + 8 * (kq & 1);
            const LAS bf16_t* ubb = U + (64 + fr + (kq >> 1)) * 16 + 8 * (kq & 1);
#pragma unroll
            for (int n0 = 0; n0 < 64; n0 += 2) {
                const bf16x8 af = frag_rowk_l(KF + n0 * 16, KLD, lane), ab = frag_rowk_l(KB + n0 * 16, KLD, lane);
#pragma unroll
                for (int tt = 0; tt < 4; ++tt) {
                    if (n0 <= 16 * tt + 14) acc[tt] = MFMA16(af, *(const LAS bf16x8*)(ubf + (16 * tt - n0) * 16), acc[tt]);
                    if (n0 <= 62 - 16 * tt) acc[tt] = MFMA16(ab, *(const LAS bf16x8*)(ubb + (16 * tt + n0) * 16), acc[tt]);
                }
                asm volatile("" ::: "memory");
            }
#pragma unroll
            for (int dir = 0; dir < 2; ++dir) {
                const float* hp = HST + ((size_t)(dir * 64 + g) * 260 + (dir == 0 ? cf : cb)) * 128;
#pragma unroll
                for (int hb = 0; hb < 2; ++hb) {
                    float xr[8], xi[8];
#pragma unroll
                    for (int e2 = 0; e2 < 4; ++e2) { const f32x4 h4 = *(const f32x4*)(hp + 2 * (32 * hb + 8 * kq) + 4 * e2), b4 = *(const LAS f32x4*)(pw0l + dir * 2048 + hb * 64 + 4 * e2);
                        xr[2 * e2] = b4[0] * h4[0] - b4[1] * h4[1]; xi[2 * e2] = b4[0] * h4[1] + b4[1] * h4[0];
                        xr[2 * e2 + 1] = b4[2] * h4[2] - b4[3] * h4[3]; xi[2 * e2 + 1] = b4[2] * h4[3] + b4[3] * h4[2]; }
#pragma unroll
                    for (int st = 0; st < 4; ++st) {
                        const int tt = dir == 0 ? st : 3 - st;
                        u32x4 br, bi;
                        br.x = cvt_pk_bf16(xr[0], xr[1]); br.y = cvt_pk_bf16(xr[2], xr[3]); br.z = cvt_pk_bf16(xr[4], xr[5]); br.w = cvt_pk_bf16(xr[6], xr[7]);
                        bi.x = cvt_pk_bf16(xi[0], xi[1]); bi.y = cvt_pk_bf16(xi[2], xi[3]); bi.z = cvt_pk_bf16(xi[4], xi[5]); bi.w = cvt_pk_bf16(xi[6], xi[7]);
                        acc[tt] = MFMA16(ccr[hb], __builtin_bit_cast(bf16x8, br), acc[tt]);
                        acc[tt] = MFMA16(cci[hb], __builtin_bit_cast(bf16x8, bi), acc[tt]);
                        if (st < 3) {
#pragma unroll
                            for (int e2 = 0; e2 < 4; ++e2) { const f32x4 a4 = *(const LAS f32x4*)(pw16l + dir * 128 + hb * 64 + 4 * e2);
                                float t0 = xr[2 * e2] * a4[0] - xi[2 * e2] * a4[1]; xi[2 * e2] = xr[2 * e2] * a4[1] + xi[2 * e2] * a4[0]; xr[2 * e2] = t0;
                                t0 = xr[2 * e2 + 1] * a4[2] - xi[2 * e2 + 1] * a4[3]; xi[2 * e2 + 1] = xr[2 * e2 + 1] * a4[3] + xi[2 * e2 + 1] * a4[2]; xr[2 * e2 + 1] = t0; }
                        }
                    }
                }
            }
#pragma unroll
            for (int tt = 0; tt < 4; ++tt) { const int t = 16 * tt + fr;
                const u32x2 uu = *(const LAS u32x2*)(U + (64 + t) * 16 + 4 * kq);
                const float y0 = acc[tt][0] + bflo(uu.x) * dv[0], y1 = acc[tt][1] + bfhi(uu.x) * dv[1], y2 = acc[tt][2] + bflo(uu.y) * dv[2], y3 = acc[tt][3] + bfhi(uu.y) * dv[3];
                u32x2 w; w.x = cvt_pk_bf16(gelu_tanh(y0), gelu_tanh(y1)); w.y = cvt_pk_bf16(gelu_tanh(y2), gelu_tanh(y3));
                *(u32x2*)(Z + (size_t)(64 * k + t) * 1024 + 16 * g + 4 * kq) = w; }
        }
    }
    __syncthreads();
}

__device__ __forceinline__ void phase_ret_s5_outputs(const Params& p, Ctx& C, LAS unsigned char* misc) {
    unsigned* head = (unsigned*)(p.ws + WS_CTL) + CW_QUEUE;
    volatile LAS int* slot = (volatile LAS int*)(misc + 32);
    for (;;) {
        __syncthreads();
        if (C.tid == 0) slot[0] = (int)atomicAdd(head, 1u);
        __syncthreads();
        const int item = __builtin_amdgcn_readfirstlane(slot[0]);
        if (item >= 520) break;
        ret_output_unit(p, C, item);
    }
    for (;;) {
        __syncthreads();
        if (C.tid == 0) slot[0] = (int)atomicAdd(head + 64, 1u);
        __syncthreads();
        const int item = __builtin_amdgcn_readfirstlane(slot[0]);
        if (item >= 512) break;
        s5_output_task(p, C, item);
    }
}
__device__ __forceinline__ void phase_router(const Params& p, Ctx& C, int L) {
    const float* X1 = (const float*)(p.ws + WS_X1);
    const bf16_t* RWh = (const bf16_t*)(p.ws + WS_RWT) + (size_t)(L * 2 + 0) * 64 * DM; const bf16_t* RWl = (const bf16_t*)(p.ws + WS_RWT) + (size_t)(L * 2 + 1) * 64 * DM;
    const float* rbias = p.inp(27) + L * 64;
    int* cnt = (int*)(p.ws + WS_CTL) + CW_CNT + L * 128; int* LIST = (int*)(p.ws + WS_LIST); unsigned* PK = (unsigned*)(p.ws + WS_WGT); float* LW = (float*)(p.ws + WS_LW);
    const int lane = C.lane, kq = lane >> 4, fr = lane & 15;
    LAS float* Lg = (LAS float*)(C.lds + C.wave * 8192);
    const int r0 = (L == 0) ? 0 : CTXL, nrows = TT - r0;
    if (C.bid == 0 && C.tid == 0) cnt[64] = nrows;
    for (int task = C.gw; task < nrows / 16; task += C.ngw) {
        const int rbase = r0 + 16 * task, row = rbase + fr;
        const int v = row < CTXL ? 1 : 0;
        const float* xr = X1 + (size_t)row * DM; const float* sc2 = modv(p, L, v, 4); const float* sh2 = modv(p, L, v, 3);
        f32x4 acc[4];
#pragma unroll
        for (int t = 0; t < 4; ++t) acc[t] = (f32x4){0.f, 0.f, 0.f, 0.f};
#pragma unroll 2
        for (int ks = 0; ks < 64; ++ks) { const int c0 = 32 * ks + 8 * kq;
            const f32x4 x0 = *(const f32x4*)(xr + c0), x1 = *(const f32x4*)(xr + c0 + 4);
            const f32x4 a0 = *(const f32x4*)(sc2 + c0), a1 = *(const f32x4*)(sc2 + c0 + 4), b0 = *(const f32x4*)(sh2 + c0), b1 = *(const f32x4*)(sh2 + c0 + 4);
            const f32x4 y0 = x0 * (a0 + 1.0f) + b0, y1 = x1 * (a1 + 1.0f) + b1;
            u32x4 hi; hi.x = cvt_pk_bf16(y0[0], y0[1]); hi.y = cvt_pk_bf16(y0[2], y0[3]); hi.z = cvt_pk_bf16(y1[0], y1[1]); hi.w = cvt_pk_bf16(y1[2], y1[3]);
            u32x4 lo; lo.x = cvt_pk_bf16(y0[0] - bflo(hi.x), y0[1] - bfhi(hi.x)); lo.y = cvt_pk_bf16(y0[2] - bflo(hi.y), y0[3] - bfhi(hi.y));
            lo.z = cvt_pk_bf16(y1[0] - bflo(hi.z), y1[1] - bfhi(hi.z)); lo.w = cvt_pk_bf16(y1[2] - bflo(hi.w), y1[3] - bfhi(hi.w));
            const bf16x8 ah = __builtin_bit_cast(bf16x8, hi), al = __builtin_bit_cast(bf16x8, lo);
#pragma unroll
            for (int t = 0; t < 4; ++t) { const bf16x8 bh = frag_rowk_g(RWh + (size_t)(16 * t) * DM + 32 * ks, DM, lane), bl = frag_rowk_g(RWl + (size_t)(16 * t) * DM + 32 * ks, DM, lane);
                acc[t] = MFMA16(ah, bh, acc[t]); acc[t] = MFMA16(al, bh, acc[t]); acc[t] = MFMA16(ah, bl, acc[t]); } }
        LDS_WAIT(); asm volatile("" ::: "memory");
#pragma unroll
        for (int t = 0; t < 4; ++t)
#pragma unroll
            for (int r = 0; r < 4; ++r) Lg[(4 * kq + r) * 65 + 16 * t + fr] = acc[t][r];
        LDS_WAIT(); asm volatile("" ::: "memory");
        if (lane < 16) {
            LAS float* sr = Lg + lane * 65; const int trow = rbase + lane;
            float gs[8];
#pragma unroll
            for (int g = 0; g < 8; ++g) { float m1 = -1e30f, m2 = -1e30f;
                for (int j = 0; j < 8; ++j) { const int e = 8 * g + j; const float s = sigmoidf_(sr[e]); sr[e] = s; const float vv = s + rbias[e];
                    if (vv > m1) { m2 = m1; m1 = vv; } else if (vv > m2) m2 = vv; }
                gs[g] = m1 + m2; }
            unsigned gmask = 0u;
#pragma unroll
            for (int it = 0; it < 4; ++it) { float best = -1e30f; int bi = 0;
#pragma unroll
                for (int g = 0; g < 8; ++g) { const bool ok = !((gmask >> g) & 1u) && gs[g] > best; best = ok ? gs[g] : best; bi = ok ? g : bi; }
                gmask |= 1u << bi; }
            unsigned long long taken = 0ull; int sel[8]; float sw[8]; float wsum = 0.f;
#pragma unroll
            for (int k = 0; k < 8; ++k) { float best = -1e30f; int bi = 0;
                for (int e = 0; e < 64; ++e) { const bool cand = ((gmask >> (e >> 3)) & 1u) && !((taken >> e) & 1ull); const float vv = sr[e] + rbias[e];
                    if (cand && vv > best) { best = vv; bi = e; } }
                taken |= 1ull << bi; sel[k] = bi; sw[k] = sr[bi]; wsum += sw[k]; }
            const float inv = 2.5f / wsum;
#pragma unroll
            for (int k = 0; k < 8; ++k) { const int a = trow * 8 + k; const int pos = atomicAdd(&cnt[sel[k]], 1);
                LIST[(size_t)sel[k] * TT + pos] = a; PK[a] = ((unsigned)sel[k] << 16) | (unsigned)pos; LW[(size_t)sel[k] * TT + pos] = sw[k] * inv; }
            LIST[(size_t)64 * TT + (trow - r0)] = 8 * TT + trow; LW[(size_t)64 * TT + (trow - r0)] = 1.0f;
        }
    }
}
namespace att {
constexpr int D = 128, NW = 8, QBLK = 32, KVBLK = 64;
constexpr float SCALE = 0.088388347648318440f;
constexpr float THR = 8.f;
constexpr int SHM_V = KVBLK * D * 2, SHM_K = KVBLK * D * 2, SHM_ATTN = 2 * SHM_V + 2 * SHM_K + NW * 64 * 4;
#define KSWZ(row, colB) ((row) * 256 + ((colB) ^ (((row) & 7) << 4)))
#define SBAR() __builtin_amdgcn_sched_barrier(0)
__device__ __forceinline__ int crow(int r, int hi) { return (r & 3) + 8 * (r >> 2) + 4 * hi; }
__device__ __forceinline__ unsigned cvtpk(float lo, float hi) { unsigned r; asm volatile("v_cvt_pk_bf16_f32 %0, %1, %2" : "=v"(r) : "v"(lo), "v"(hi)); return r; }

__device__ __forceinline__ void partialSM(f32x16& p0, f32x16& p1, float negMC) {
  constexpr float Cc = SCALE * 1.4426950408889634f;
  for (int r = 0; r < 16; ++r) p0[r] = fmaf(p0[r], Cc, negMC); for (int r = 0; r < 16; ++r) p1[r] = fmaf(p1[r], Cc, negMC);
  for (int r = 0; r < 16; ++r) p0[r] = __builtin_amdgcn_exp2f(p0[r]);
}
__device__ __forceinline__ void finishSM(f32x16& p0, f32x16& p1, float& l_reg, bf16x8& pa0, bf16x8& pa1, bf16x8& pa2, bf16x8& pa3) {
  for (int r = 0; r < 16; ++r) p1[r] = __builtin_amdgcn_exp2f(p1[r]);
  float ps = 0; for (int r = 0; r < 16; ++r) ps += p0[r]; for (int r = 0; r < 16; ++r) ps += p1[r];
  { auto rr = __builtin_amdgcn_permlane32_swap(__float_as_uint(ps), __float_as_uint(ps), false, false);
    ps = __uint_as_float(rr[0]) + __uint_as_float(rr[1]); }
  l_reg += ps;
#define PK4(P, BASE, OUT) do { unsigned a0 = cvtpk(P[BASE + 0], P[BASE + 1]), a1 = cvtpk(P[BASE + 2], P[BASE + 3]);   \
    unsigned b0 = cvtpk(P[BASE + 4], P[BASE + 5]), b1 = cvtpk(P[BASE + 6], P[BASE + 7]);                              \
    auto r0 = __builtin_amdgcn_permlane32_swap(a0, b0, false, false); auto r1 = __builtin_amdgcn_permlane32_swap(a1, b1, false, false); \
    u32x4 w = {r0[0], r1[0], r0[1], r1[1]}; OUT = *reinterpret_cast<bf16x8*>(&w); } while (0)
  PK4(p0, 0, pa0); PK4(p0, 8, pa1); PK4(p1, 0, pa2); PK4(p1, 8, pa3);
#undef PK4
}
__device__ __forceinline__ void qkt(f32x16& p0, f32x16& p1, const LAS char* Ks, const bf16x8* qr, int r32, int hi) {
  p0 = f32x16{}; p1 = f32x16{};
  for (int d0 = 0; d0 < 8; ++d0) { int cb = (d0 * 16 + hi * 8) * 2;
    bf16x8 b0 = *reinterpret_cast<const LAS bf16x8*>(Ks + KSWZ(r32, cb));
    bf16x8 b1 = *reinterpret_cast<const LAS bf16x8*>(Ks + KSWZ(32 + r32, cb));
    p0 = __builtin_amdgcn_mfma_f32_32x32x16_bf16(b0, qr[d0], p0, 0, 0, 0);
    p1 = __builtin_amdgcn_mfma_f32_32x32x16_bf16(b1, qr[d0], p1, 0, 0, 0); }
}
__device__ __forceinline__ int v_st(int k, int c) { const int kk = (k & ~0xC) | ((k & 4) << 1) | ((k & 8) >> 1); return ((kk >> 3) * 4 + (c >> 5)) * 512 + ((kk & 7) * 32 + (c & 31)) * 2; }
__device__ __forceinline__ int v_rd_base(int lane) { return ((lane & 3) << 3) | (((lane >> 2) & 3) << 6) | (((lane >> 4) & 1) << 5) | (((lane >> 5) & 1) << 8); }
constexpr int v_rd_off(int d0, int ks, int half) { return d0 * 512 + ks * 4096 + half * 2048; }
template <int OFF> __device__ __forceinline__ s16x4 tr_read(int vb) {
  s16x4 r; asm volatile("ds_read_b64_tr_b16 %0, %1 offset:%2" : "=&v"(r) : "v"(vb), "i"(OFF) : "memory"); return r;
}
template <int D0> __device__ __forceinline__ void pv_one(f32x16& od, int vb, bf16x8 pa0, bf16x8 pa1, bf16x8 pa2, bf16x8 pa3) {
  const s16x4 l0 = tr_read<v_rd_off(D0, 0, 0)>(vb), h0 = tr_read<v_rd_off(D0, 0, 1)>(vb), l1 = tr_read<v_rd_off(D0, 1, 0)>(vb), h1 = tr_read<v_rd_off(D0, 1, 1)>(vb);
  const s16x4 l2 = tr_read<v_rd_off(D0, 2, 0)>(vb), h2 = tr_read<v_rd_off(D0, 2, 1)>(vb), l3 = tr_read<v_rd_off(D0, 3, 0)>(vb), h3 = tr_read<v_rd_off(D0, 3, 1)>(vb);
  asm volatile("s_waitcnt lgkmcnt(0)" ::: "memory"); SBAR();
#define PK(L, H) (bf16x8){L[0], L[1], L[2], L[3], H[0], H[1], H[2], H[3]}
  od = __builtin_amdgcn_mfma_f32_32x32x16_bf16(pa0, PK(l0, h0), od, 0, 0, 0);
  od = __builtin_amdgcn_mfma_f32_32x32x16_bf16(pa1, PK(l1, h1), od, 0, 0, 0);
  od = __builtin_amdgcn_mfma_f32_32x32x16_bf16(pa2, PK(l2, h2), od, 0, 0, 0);
  od = __builtin_amdgcn_mfma_f32_32x32x16_bf16(pa3, PK(l3, h3), od, 0, 0, 0);
#undef PK
}
__device__ __forceinline__ void pv_d0(f32x16* o, int vb, bf16x8 pa0, bf16x8 pa1, bf16x8 pa2, bf16x8 pa3) {
  pv_one<0>(o[0], vb, pa0, pa1, pa2, pa3); pv_one<1>(o[1], vb, pa0, pa1, pa2, pa3); pv_one<2>(o[2], vb, pa0, pa1, pa2, pa3); pv_one<3>(o[3], vb, pa0, pa1, pa2, pa3);
}

template <int LDQ, int LDK, int LDO>
__device__ __forceinline__ void attn_dense_body(const bf16_t* __restrict__ Qb, const bf16_t* __restrict__ Kh, const bf16_t* __restrict__ Vh, bf16_t* __restrict__ Ob, int seq, LAS char* lds, int tid, float kmax2) {
  const int wid = tid >> 6, lane = tid & 63, r32 = lane & 31, hi = lane >> 5;
  LAS char* V_lds = lds; LAS char* K_lds = lds + 2 * SHM_V;
  LAS float* ws = (LAS float*)(lds + 2 * SHM_V + 2 * SHM_K) + wid * 64; LAS float* li_l = ws;
  float l_reg = 0; f32x16 o[4] = {}; bf16x8 qr[8];
  const bf16_t* Qw = Qb + (long)(wid * QBLK + r32) * LDQ + hi * 8;
#pragma unroll
  for (int d0 = 0; d0 < 8; ++d0) qr[d0] = *reinterpret_cast<const bf16x8*>(Qw + d0 * 16);
  float negMC;
  { float q2 = 0.f;
#pragma unroll
    for (int d0 = 0; d0 < 8; ++d0) { const u32x4 w = __builtin_bit_cast(u32x4, qr[d0]);
      q2 += bflo(w.x) * bflo(w.x) + bfhi(w.x) * bfhi(w.x) + bflo(w.y) * bflo(w.y) + bfhi(w.y) * bfhi(w.y) + bflo(w.z) * bflo(w.z) + bfhi(w.z) * bfhi(w.z) + bflo(w.w) * bflo(w.w) + bfhi(w.w) * bfhi(w.w); }
    auto rr = __builtin_amdgcn_permlane32_swap(__float_as_uint(q2), __float_as_uint(q2), false, false);
    q2 = __uint_as_float(rr[0]) + __uint_as_float(rr[1]);
    negMC = -(sqrtf(q2 * kmax2) * (SCALE * 1.0001f) - 30.0f) * 1.4426950408889634f; }
  const int sr = tid >> 4, sc = (tid & 15) * 8, vst0 = v_st(sr, sc), vst1 = v_st(32 + sr, sc);
  const int vb0 = (int)(uintptr_t)V_lds + v_rd_base(lane);
  struct { bf16x8 vs0, vs1, ks0, ks1; } sr_[2];
#define SLOAD(i, k0) do { sr_[i].vs0 = *reinterpret_cast<const bf16x8*>(&Vh[(long)((k0) + sr) * LDK + sc]); sr_[i].vs1 = *reinterpret_cast<const bf16x8*>(&Vh[(long)((k0) + 32 + sr) * LDK + sc]); \
    sr_[i].ks0 = *reinterpret_cast<const bf16x8*>(&Kh[(long)((k0) + sr) * LDK + sc]); sr_[i].ks1 = *reinterpret_cast<const bf16x8*>(&Kh[(long)((k0) + 32 + sr) * LDK + sc]); } while (0)
#define SWRITE(b, i) do { *(LAS bf16x8*)(V_lds + (b) * SHM_V + vst0) = sr_[i].vs0;          \
    *(LAS bf16x8*)(V_lds + (b) * SHM_V + vst1) = sr_[i].vs1; int kc = sc * 2;               \
    *(LAS bf16x8*)(K_lds + (b) * SHM_K + KSWZ(sr, kc)) = sr_[i].ks0;                       \
    *(LAS bf16x8*)(K_lds + (b) * SHM_K + KSWZ(32 + sr, kc)) = sr_[i].ks1; } while (0)
#define SWAIT() asm volatile("s_waitcnt vmcnt(4)" ::: "memory")
  f32x16 pA0, pA1, pB0, pB1; bf16x8 pa0, pa1, pa2, pa3; const int NT = seq / KVBLK;
  constexpr int SE = 0, SO = 1;
  SLOAD(SE, 0); asm volatile("s_waitcnt vmcnt(0)" ::: "memory"); SWRITE(0, SE); __syncthreads();
  qkt(pA0, pA1, K_lds, qr, r32, hi); partialSM(pA0, pA1, negMC);
  SLOAD(SO, KVBLK); if (2 < NT) SLOAD(SE, 2 * KVBLK);
  SWAIT(); SWRITE(1, SO); __syncthreads();
  for (int j = 1; j + 1 < NT; j += 2) {
    SBAR(); qkt(pB0, pB1, K_lds + SHM_K, qr, r32, hi);
    finishSM(pA0, pA1, l_reg, pa0, pa1, pa2, pa3); SBAR();
    SLOAD(SO, (j + 2) * KVBLK); SBAR();
    pv_d0(o, vb0, pa0, pa1, pa2, pa3); partialSM(pB0, pB1, negMC);
    __syncthreads(); SWAIT(); SWRITE(0, SE);
    __syncthreads();
    SBAR(); qkt(pA0, pA1, K_lds, qr, r32, hi);
    finishSM(pB0, pB1, l_reg, pa0, pa1, pa2, pa3); SBAR();
    if (j + 3 < NT) SLOAD(SE, (j + 3) * KVBLK); SBAR();
    pv_d0(o, vb0 + (int)SHM_V, pa0, pa1, pa2, pa3); partialSM(pA0, pA1, negMC);
    __syncthreads(); SWAIT(); SWRITE(1, SO);
    __syncthreads();
  }
  SBAR(); qkt(pB0, pB1, K_lds + SHM_K, qr, r32, hi);
  finishSM(pA0, pA1, l_reg, pa0, pa1, pa2, pa3); SBAR();
  pv_d0(o, vb0, pa0, pa1, pa2, pa3); partialSM(pB0, pB1, negMC);
  __syncthreads();
  finishSM(pB0, pB1, l_reg, pa0, pa1, pa2, pa3); SBAR();
  pv_d0(o, vb0 + (int)SHM_V, pa0, pa1, pa2, pa3);
  if (hi == 0) li_l[r32] = l_reg; asm volatile("s_waitcnt lgkmcnt(0)" ::: "memory");
  float rli[16];
#pragma unroll
  for (int r = 0; r < 16; ++r) rli[r] = __builtin_amdgcn_rcpf(li_l[crow(r, hi)]);
  bf16_t* Ow = Ob + (long)(wid * QBLK) * LDO;
#pragma unroll
  for (int r = 0; r < 16; ++r) { int orow = crow(r, hi);
    for (int d0 = 0; d0 < 4; ++d0) Ow[(long)orow * LDO + d0 * 32 + r32] = (bf16_t)(cvtpk(o[d0][r] * rli[r], 0.f) & 0xffffu); }
#undef SLOAD
#undef SWRITE
#undef SWAIT
}

typedef int v8i32a __attribute__((ext_vector_type(8)));
typedef int v4i32a __attribute__((ext_vector_type(4)));
#define KSW8(row, chunk) ((row) * 128 + ((((chunk) ^ ((row) & 7))) << 4))
#define VSW8(d, chunk) ((d) * 64 + ((((chunk) ^ (((d) >> 2) & 3))) << 4))
#define MFMA8(a, b, c) __builtin_amdgcn_mfma_scale_f32_32x32x64_f8f6f4((a), (b), (c), 0, 0, 0, 0, 0, 0)
__device__ __forceinline__ v8i32a ld32_l(const LAS char* p0, const LAS char* p1) { return __builtin_shufflevector(*(const LAS v4i32a*)p0, *(const LAS v4i32a*)p1, 0, 1, 2, 3, 4, 5, 6, 7); }
__device__ __forceinline__ unsigned pk4f8(float a, float b, float c, float d) { unsigned w = (unsigned)__builtin_amdgcn_cvt_pk_fp8_f32(a, b, 0, false); return (unsigned)__builtin_amdgcn_cvt_pk_fp8_f32(c, d, (int)w, true); }
template <int LDO>
__device__ __forceinline__ void attn_dense8_body(const unsigned char* __restrict__ Q8b, const unsigned char* __restrict__ K8h, const unsigned char* __restrict__ VT8h, bf16_t* __restrict__ Ob, int seq, LAS char* lds, int tid, float kmax2) {
  const int wid = tid >> 6, lane = tid & 63, r32 = lane & 31, hi = lane >> 5;
  LAS char* K_lds = lds; LAS char* V_lds = lds + 16384;
  LAS float* li_l = (LAS float*)(lds + 32768) + wid * 32; LAS float* al_l = (LAS float*)(lds + 32768 + 1024) + wid * 32;
  float l_reg = 0, m_reg = -1e30f; f32x16 o[4] = {}; v8i32a qf[2];
  { const unsigned char* qp = Q8b + (size_t)(wid * QBLK + r32) * 1024 + 32 * hi;
    qf[0] = __builtin_shufflevector(*(const v4i32a*)qp, *(const v4i32a*)(qp + 16), 0, 1, 2, 3, 4, 5, 6, 7);
    qf[1] = __builtin_shufflevector(*(const v4i32a*)(qp + 64), *(const v4i32a*)(qp + 80), 0, 1, 2, 3, 4, 5, 6, 7); }
  (void)kmax2;
  constexpr float THR8 = 1.0f, Cc = SCALE * 1.4426950408889634f;
#define PSM8(P0, P1, AL) do { float pmax = P0[0]; for (int r = 1; r < 16; ++r) pmax = fmaxf(pmax, P0[r]); for (int r = 0; r < 16; ++r) pmax = fmaxf(pmax, P1[r]); \
      { auto rr = __builtin_amdgcn_permlane32_swap(__float_as_uint(pmax), __float_as_uint(pmax), false, false); pmax = fmaxf(__uint_as_float(rr[0]), __uint_as_float(rr[1])); } \
      float mn; if (__builtin_expect(__all(pmax - m_reg <= THR8 / SCALE), 1)) { mn = m_reg; AL = 1.f; } \
      else { mn = fmaxf(m_reg, pmax); AL = __builtin_amdgcn_exp2f((m_reg - mn) * Cc); m_reg = mn; } \
      const float mnC = 7.0f - mn * Cc; \
      for (int r = 0; r < 16; ++r) P0[r] = fmaf(P0[r], Cc, mnC); for (int r = 0; r < 16; ++r) P1[r] = fmaf(P1[r], Cc, mnC); \
      for (int r = 0; r < 16; ++r) P0[r] = __builtin_amdgcn_exp2f(P0[r]); } while (0)
#define RESC8(a) do { if (__any((a) < 1.f)) { if (hi == 0) al_l[r32] = (a); asm volatile("s_waitcnt lgkmcnt(0)" ::: "memory"); \
      for (int d = 0; d < 4; ++d) for (int r = 0; r < 16; ++r) o[d][r] *= al_l[crow(r, hi)]; } } while (0)
  const int krow = tid >> 3, kch = tid & 7, vd = tid >> 2, vch = tid & 3;
  const int kst = KSW8(krow, kch), vst = VSW8(vd, vch);
  struct { v4i32a k, v; } sr_[2];
#define SLOAD8(i, T_) do { sr_[i].k = *(const v4i32a*)(K8h + (size_t)(64 * (T_) + krow) * 256 + 16 * kch); sr_[i].v = *(const v4i32a*)(VT8h + (size_t)(T_) * 8192 + 16 * tid); } while (0)
#define SWRITE8(b, i) do { *(LAS v4i32a*)(K_lds + (b) * 8192 + kst) = sr_[i].k; *(LAS v4i32a*)(V_lds + (b) * 8192 + vst) = sr_[i].v; } while (0)
#define QK8(P0, P1, KB) do { P0 = f32x16{}; P1 = f32x16{}; _Pragma("unroll") for (int s = 0; s < 2; ++s) { \
      const v8i32a k0 = ld32_l((KB) + KSW8(r32, 4 * s + 2 * hi), (KB) + KSW8(r32, 4 * s + 2 * hi + 1)); \
      const v8i32a k1 = ld32_l((KB) + KSW8(32 + r32, 4 * s + 2 * hi), (KB) + KSW8(32 + r32, 4 * s + 2 * hi + 1)); \
      P0 = MFMA8(k0, qf[s], P0); P1 = MFMA8(k1, qf[s], P1); } } while (0)
#define FIN8(P0, P1, AL) do { for (int r = 0; r < 16; ++r) P1[r] = __builtin_amdgcn_exp2f(P1[r]); \
      float ps = 0; for (int r = 0; r < 16; ++r) ps += P0[r]; for (int r = 0; r < 16; ++r) ps += P1[r]; \
      { auto rr = __builtin_amdgcn_permlane32_swap(__float_as_uint(ps), __float_as_uint(ps), false, false); ps = __uint_as_float(rr[0]) + __uint_as_float(rr[1]); } \
      l_reg = l_reg * (AL) + ps; \
      _Pragma("unroll") for (int i = 0; i < 4; ++i) { pa[i] = (int)pk4f8(P0[4 * i], P0[4 * i + 1], P0[4 * i + 2], P0[4 * i + 3]); pa[4 + i] = (int)pk4f8(P1[4 * i], P1[4 * i + 1], P1[4 * i + 2], P1[4 * i + 3]); } } while (0)
#define PV8(VB) do { _Pragma("unroll") for (int d0 = 0; d0 < 4; ++d0) { \
      const v8i32a vf = ld32_l((VB) + VSW8(32 * d0 + r32, 2 * hi), (VB) + VSW8(32 * d0 + r32, 2 * hi + 1)); \
      o[d0] = MFMA8(pa, vf, o[d0]); } } while (0)
  f32x16 pA0, pA1, pB0, pB1; v8i32a pa; float alA, alB; const int NT = seq / KVBLK;
  SLOAD8(0, 0); asm volatile("s_waitcnt vmcnt(0)" ::: "memory"); SWRITE8(0, 0); __syncthreads();
  QK8(pA0, pA1, K_lds); PSM8(pA0, pA1, alA);
  SLOAD8(1, 1); if (2 < NT) SLOAD8(0, 2);
  asm volatile("s_waitcnt vmcnt(2)" ::: "memory"); SWRITE8(1, 1); __syncthreads();
  for (int j = 1; j + 1 < NT; j += 2) {
    SBAR(); QK8(pB0, pB1, K_lds + 8192);
    FIN8(pA0, pA1, alA); SBAR();
    SLOAD8(1, j + 2); SBAR();
    PV8(V_lds); PSM8(pB0, pB1, alB);
    __syncthreads(); asm volatile("s_waitcnt vmcnt(2)" ::: "memory"); SWRITE8(0, 0);
    RESC8(alB); __syncthreads();
    SBAR(); QK8(pA0, pA1, K_lds);
    FIN8(pB0, pB1, alB); SBAR();
    if (j + 3 < NT) SLOAD8(0, j + 3); SBAR();
    PV8(V_lds + 8192); PSM8(pA0, pA1, alA);
    __syncthreads(); asm volatile("s_waitcnt vmcnt(2)" ::: "memory"); SWRITE8(1, 1);
    RESC8(alA); __syncthreads();
  }
  SBAR(); QK8(pB0, pB1, K_lds + 8192);
  FIN8(pA0, pA1, alA); SBAR();
  PV8(V_lds); PSM8(pB0, pB1, alB);
  __syncthreads(); RESC8(alB);
  FIN8(pB0, pB1, alB); SBAR();
  PV8(V_lds + 8192);
  if (hi == 0) li_l[r32] = l_reg; asm volatile("s_waitcnt lgkmcnt(0)" ::: "memory");
  float rli[16];
#pragma unroll
  for (int r = 0; r < 16; ++r) rli[r] = __builtin_amdgcn_rcpf(li_l[crow(r, hi)]);
  bf16_t* Ow = Ob + (long)(wid * QBLK) * LDO;
#pragma unroll
  for (int r = 0; r < 16; ++r) { int orow = crow(r, hi);
    for (int d0 = 0; d0 < 4; ++d0) Ow[(long)orow * LDO + d0 * 32 + r32] = (bf16_t)(cvtpk(o[d0][r] * rli[r], 0.f) & 0xffffu); }
#undef PSM8
#undef RESC8
#undef SLOAD8
#undef SWRITE8
#undef QK8
#undef FIN8
#undef PV8
}

constexpr int PV_BUF = 32768, PK_BUF = 16384, P_LDS_V = 0, P_LDS_K = 2 * PV_BUF, P_LDS_X = P_LDS_K + 2 * PK_BUF, P_LDS_L = P_LDS_X + 8 * 2048, P_LDS_END = P_LDS_L + 1024;
__device__ __forceinline__ void qkt_half(f32x16& p, const LAS char* Ks, const bf16x8* qr, int krow, int hi) {
  p = f32x16{};
  for (int d0 = 0; d0 < 8; ++d0) { int cb = (d0 * 16 + hi * 8) * 2;
    bf16x8 b0 = *reinterpret_cast<const LAS bf16x8*>(Ks + KSWZ(krow, cb));
    p = __builtin_amdgcn_mfma_f32_32x32x16_bf16(b0, qr[d0], p, 0, 0, 0); }
}
__device__ __forceinline__ void smA(f32x16& p, float negMC) {
  constexpr float Cc = SCALE * 1.4426950408889634f;
  for (int r = 0; r < 16; ++r) p[r] = fmaf(p[r], Cc, negMC);
  for (int r = 0; r < 8; ++r) p[r] = __builtin_amdgcn_exp2f(p[r]);
}
__device__ __forceinline__ void smB(f32x16& p, float& l_reg, bf16x8& f0, bf16x8& f1) {
  for (int r = 8; r < 16; ++r) p[r] = __builtin_amdgcn_exp2f(p[r]);
  float ps = 0; for (int r = 0; r < 16; ++r) ps += p[r];
  { auto rr = __builtin_amdgcn_permlane32_swap(__float_as_uint(ps), __float_as_uint(ps), false, false);
    ps = __uint_as_float(rr[0]) + __uint_as_float(rr[1]); }
  l_reg += ps;
#define PK4(P, BASE, OUT) do { unsigned a0 = cvtpk(P[BASE + 0], P[BASE + 1]), a1 = cvtpk(P[BASE + 2], P[BASE + 3]);   \
    unsigned b0 = cvtpk(P[BASE + 4], P[BASE + 5]), b1 = cvtpk(P[BASE + 6], P[BASE + 7]);                              \
    auto r0 = __builtin_amdgcn_permlane32_swap(a0, b0, false, false); auto r1 = __builtin_amdgcn_permlane32_swap(a1, b1, false, false); \
    u32x4 w = {r0[0], r1[0], r0[1], r1[1]}; OUT = *reinterpret_cast<bf16x8*>(&w); } while (0)
  PK4(p, 0, f0); PK4(p, 8, f1);
#undef PK4
}
template <int LDQ, int LDK, int LDO>
__device__ __forceinline__ void attn_pair_body(const bf16_t* __restrict__ Qb, const bf16_t* __restrict__ Kh, const bf16_t* __restrict__ Vh, bf16_t* __restrict__ Ob, int seq, LAS char* lds, int tid, float kmax2) {
  const int wid = __builtin_amdgcn_readfirstlane(tid >> 6), lane = tid & 63, r32 = lane & 31, hi = lane >> 5, g = wid & 3, kb = wid >> 2;
  LAS char* V_lds = lds + P_LDS_V; LAS char* K_lds = lds + P_LDS_K;
  LAS char* xp_own = lds + P_LDS_X + wid * 2048 + lane * 16; LAS char* xp_par = lds + P_LDS_X + (wid ^ 4) * 2048 + lane * 16;
  LAS float* li = (LAS float*)(lds + P_LDS_L);
  float l_reg = 0; f32x16 o[4] = {}; bf16x8 qr[8];
  const bf16_t* Qw = Qb + (long)(g * QBLK + r32) * LDQ + hi * 8;
#pragma unroll
  for (int d0 = 0; d0 < 8; ++d0) qr[d0] = *reinterpret_cast<const bf16x8*>(Qw + d0 * 16);
  float negMC;
  { float q2 = 0.f;
#pragma unroll
    for (int d0 = 0; d0 < 8; ++d0) { const u32x4 w = __builtin_bit_cast(u32x4, qr[d0]);
      q2 += bflo(w.x) * bflo(w.x) + bfhi(w.x) * bfhi(w.x) + bflo(w.y) * bflo(w.y) + bfhi(w.y) * bfhi(w.y) + bflo(w.z) * bflo(w.z) + bfhi(w.z) * bfhi(w.z) + bflo(w.w) * bflo(w.w) + bfhi(w.w) * bfhi(w.w); }
    auto rr = __builtin_amdgcn_permlane32_swap(__float_as_uint(q2), __float_as_uint(q2), false, false);
    q2 = __uint_as_float(rr[0]) + __uint_as_float(rr[1]);
    negMC = -(sqrtf(q2 * kmax2) * (SCALE * 1.0001f) - 30.0f) * 1.4426950408889634f; }
  const int sr = tid >> 4, sc = (tid & 15) * 8, vst0 = v_st(sr, sc), vst1 = v_st(32 + sr, sc);
  const int vrd = (int)(uintptr_t)V_lds + kb * 16384 + v_rd_base(lane);
  const int krow = 32 * kb + r32;
  struct { bf16x8 v00, v01, v10, v11, k0, k1; } st_;
#define PLD16(base, off) (*reinterpret_cast<const bf16x8*>((const char*)(base) + (off)))
#define PLOAD(k0_) do { const unsigned o_ = (unsigned)(((k0_) + sr) * LDK + sc) * 2u; \
    st_.v00 = PLD16(Vh, o_); st_.v01 = PLD16(Vh, o_ + 256u); st_.v10 = PLD16(Vh, o_ + 64u * LDK); st_.v11 = PLD16(Vh, o_ + 64u * LDK + 256u); \
    st_.k0 = PLD16(Kh, o_); st_.k1 = PLD16(Kh, o_ + 64u * LDK); } while (0)
#define PWRITE(kbuf, vbuf) do { LAS char* vb_ = V_lds + (vbuf) * PV_BUF; LAS char* kb_ = K_lds + (kbuf) * PK_BUF; const int kc = sc * 2; \
    *(LAS bf16x8*)(vb_ + vst0) = st_.v00; *(LAS bf16x8*)(vb_ + 16384 + vst0) = st_.v01; *(LAS bf16x8*)(vb_ + vst1) = st_.v10; *(LAS bf16x8*)(vb_ + 16384 + vst1) = st_.v11; \
    *(LAS bf16x8*)(kb_ + KSWZ(sr, kc)) = st_.k0; *(LAS bf16x8*)(kb_ + KSWZ(32 + sr, kc)) = st_.k1; } while (0)
  const int NT = seq / KVBLK;
  f32x16 pS; bf16x8 f0, f1, g0, g1;
  PLOAD(0); asm volatile("s_waitcnt vmcnt(0)" ::: "memory"); PWRITE(0, 0); PLOAD(KVBLK);
  __syncthreads();
  for (int j = 0; j < NT; ++j) {
    SBAR();
    qkt_half(pS, K_lds + (j & 1) * PK_BUF, qr, krow, hi);
    smA(pS, negMC); smB(pS, l_reg, f0, f1); SBAR();
    *(LAS bf16x8*)(xp_own) = f0; *(LAS bf16x8*)(xp_own + 1024) = f1;
    if (j + 1 < NT) PWRITE((j + 1) & 1, (j + 1) & 1);
    if (j + 2 < NT) PLOAD((j + 2) * KVBLK);
    __syncthreads();
    g0 = *(const LAS bf16x8*)(xp_par); g1 = *(const LAS bf16x8*)(xp_par + 1024);
    { const int vb = vrd + (j & 1) * PV_BUF;
      if (kb == 0) pv_d0(o, vb, f0, f1, g0, g1); else pv_d0(o, vb, g0, g1, f0, f1); }
    __syncthreads();
  }
  if (hi == 0) li[wid * 32 + r32] = l_reg;
  __syncthreads();
#pragma unroll
  for (int r = 0; r < 16; ++r) { const int orow = crow(r, hi); const float rl = __builtin_amdgcn_rcpf(li[wid * 32 + orow] + li[(wid ^ 4) * 32 + orow]);
    bf16_t* op = Ob + (long)(g * QBLK + orow) * LDO + 128 * kb + r32;
    for (int d0 = 0; d0 < 4; ++d0) op[d0 * 32] = (bf16_t)(cvtpk(o[d0][r] * rl, 0.f) & 0xffffu); }
#undef PLD16
#undef PLOAD
#undef PWRITE
}
#undef KSWZ
}

__device__ __forceinline__ void phase_attention(const Params& p, Ctx& C) {
    const bf16_t* QKV = (const bf16_t*)(p.ws + WS_BIG + BG_QKV); bf16_t* ATT = (bf16_t*)(p.ws + WS_BIG + BG_ATT);
    const unsigned* KMAX = (const unsigned*)(p.ws + WS_CTL) + CW_KMAX;
    const unsigned char* Q8 = (const unsigned char*)(p.ws + WS_BIG + BG_Q8); const unsigned char* K8 = (const unsigned char*)(p.ws + WS_BIG + BG_K8); const unsigned char* VT8 = (const unsigned char*)(p.ws + WS_BIG + BG_VT8);
    const bool grouped = (C.G == 256);
    for (int i = 0;; ++i) {
        int unit;
        if (grouped) { if (i >= 4) break; unit = (C.bid & 7) * 128 + i * 32 + (C.bid >> 3); } else { unit = i * C.G + C.bid; if (unit >= 1024) break; }
        const int d = unit >> 7, qb = unit & 127, h = d >> 1, m = d & 1;
        const float kmax2 = __uint_as_float(KMAX[64 * (2 + 2 * h + m)]);
        __syncthreads();
        int tz = C.tid; asm volatile("" : "+v"(tz));
        att::attn_pair_body<OD_IN, OD_IN, 3072>(QKV + (size_t)(CTXL + 128 * qb) * OD_IN + 1536 + 256 * h + 128 * m, QKV + 2560 + 256 * h + 128 * m, QKV + 3584 + 256 * h,
                                                ATT + (size_t)(128 * qb) * 3072 + 1024 + 1024 * m + 256 * h, TT, (LAS char*)C.lds, tz, kmax2);
    }
    for (int i = 0;; ++i) {
        int unit;
        if (grouped) { if (i >= 2) break; unit = (C.bid & 7) * 64 + i * 32 + (C.bid >> 3); } else { unit = i * C.G + C.bid; if (unit >= 512) break; }
        const int prob = unit >> 6, qb = unit & 63;
        const float kmax2 = __uint_as_float(KMAX[64 * (prob >> 2)]);
        __syncthreads();
        int tz = C.tid; asm volatile("" : "+v"(tz));
        att::attn_dense8_body<3072>(Q8 + (size_t)(CTXL + 256 * qb) * 1024 + 128 * prob, K8 + 128 * (prob >> 2), VT8 + (size_t)(prob >> 2) * 260 * 8192,
                                    ATT + (size_t)(256 * qb) * 3072 + 128 * prob, TT, (LAS char*)C.lds, tz, kmax2);
    }
    __syncthreads();
}
constexpr int PH_PER_LAYER = 13, N_PHASES = 2 + 2 * PH_PER_LAYER;
#ifndef DBL_PHASE
#define DBL_PHASE -1
#endif
#ifndef MK_PER_PHASE
#define MK_PER_PHASE 0
#endif

template <int L>
__device__ __forceinline__ void layer_body(const Params& p, Ctx& C0, const XcdBarrier& bar, LAS unsigned char* misc, int lo, int hi) {
#define IN(k) (lo <= (k) && (k) < hi)
#define SEAM(k) do { if (IN(k) && IN((k) + 1)) xcd_barrier(bar, C0.wave); } while (0)
#define PHASE(k, ...) if (IN(k)) { FRESH(); __VA_ARGS__ } if (DBL_PHASE == (k)) { xcd_barrier(bar, C0.wave); { FRESH(); __VA_ARGS__ } } SEAM(k);
#define FRESH() Ctx C = C0; { int ln = (int)__builtin_amdgcn_mbcnt_hi(~0u, __builtin_amdgcn_mbcnt_lo(~0u, 0u)); asm volatile("" : "+v"(ln)); C.lane = ln; C.tid = C.wave * 64 + ln; }
        const int b = 2 + PH_PER_LAYER * L;
        bf16_t* QKV = (bf16_t*)(p.ws + WS_BIG + BG_QKV);
        bf16_t* XA = (bf16_t*)(p.ws + WS_XA);
        int* cnt = (int*)(p.ws + WS_CTL) + CW_CNT + L * 128; const int* LIST = (const int*)(p.ws + WS_LIST);
        PHASE(b + 0, phase_modulate(p, C, L); )
        PHASE(b + 1,
            const int N = L ? OD_IN : EV_IN;
            pg8::DenseOrder S; S.init8((const void*)XA, DM, (const void*)(p.ws + (L ? WS_WIN1 : WS_WIN0)), TT, N, DM, C.G, C.bid);
            pg8::EpiStore E{QKV, N, 1.0f / 32.0f};
            pg8::gemm_phase<true>(C.lds, S, E, C.wave);
            if (L == 0 && IN(b + 2) && S.units_of_me() < S.max_units()) conv_queue(p, C, 2);
        )
        PHASE(b + 2, if (L == 0) phase_rope0(p, C); else phase_normrope1(p, C); )
        PHASE(b + 3, if (L == 0) { ret_chunk_kv(p, C); s5_end_states(p, C); } else phase_attention(p, C); )
        PHASE(b + 4, if (L == 0) phase_scans(p, C); else phase_merge1(p, C); )
        if (L == 0) {
            PHASE(b + 5, phase_ret_s5_outputs(p, C, misc); )
            PHASE(b + 6,
                pg8::DenseOrder S; S.init((const bf16_t*)(p.ws + WS_Z), 1024, (const bf16_t*)(p.ws + WS_WGLU), TT, 1024, 1024, C.G, C.bid);
                pg8::EpiGlu E{(const bf16_t*)(p.ws + WS_Z), p.inp(20), (bf16_t*)(p.ws + WS_BIG + BG_MIX)};
                pg8::gemm_phase<false>(C.lds, S, E, C.wave);
                if (IN(b + 7) && S.units_of_me() < S.max_units()) conv_queue(p, C, 4);
            )
        }
        PHASE(b + 7,
            pg8::DenseOrder S;
            if (L == 0) S.init((const bf16_t*)(p.ws + WS_BIG + BG_MIX), DM, (const bf16_t*)(p.ws + WS_WOUT0), TT, DM, DM, C.G, C.bid);
            else S.init((const bf16_t*)(p.ws + WS_BIG + BG_ATT), 3072, (const bf16_t*)(p.ws + WS_WOUT1), SEQ, DM, DM, C.G, C.bid);
            pg8::EpiStore E{(bf16_t*)(p.ws + WS_YMIX) + (L ? (size_t)CTXL * DM : 0), DM, 1.0f};
            pg8::gemm_phase<false>(C.lds, S, E, C.wave);
            if (L == 0 && IN(b + 8) && S.units_of_me() < S.max_units()) conv_queue(p, C, 5);
        )
        PHASE(b + 8, phase_ln1(p, C, L); )
        PHASE(b + 9, phase_router(p, C, L); )
        PHASE(b + 10,
            pg8::MoeOrder<0> S; S.A = (const void*)XA; S.Bt = (const void*)(p.ws + WS_GU + (size_t)L * NEX1 * 1024 * DM); S.list = LIST; S.cnt = cnt; S.ldab = DM; S.kb = DM; S.nN = 4; S.G = C.G; S.c = C.bid; S.bstride = (size_t)1024 * DM;
            S.prep(misc, C.tid);
            pg8::EpiE1 E{(unsigned char*)(p.ws + WS_HX2), S.cn, S.rb};
            pg8::gemm_phase<true>(C.lds, S, E, C.wave);
        )
        PHASE(b + 11,
            pg8::MoeOrder<1> S; S.A = (const void*)(p.ws + WS_HX2); S.Bt = (const void*)(p.ws + WS_DT + (size_t)L * NEX1 * DM * EHID); S.list = LIST; S.cnt = cnt; S.ldab = EHID; S.kb = EHID; S.nN = 8; S.G = C.G; S.c = C.bid; S.bstride = (size_t)DM * EHID;
            S.prep(misc, C.tid);
            pg8::EpiE2 E{(unsigned char*)(p.ws + WS_BIG + BG_YMOE), (const float*)(p.ws + WS_LW), S.cn, S.rb};
            pg8::gemm_phase<true>(C.lds, S, E, C.wave);
        )
        PHASE(b + 12, phase_combine(p, C, L, misc); )
    #undef IN
#undef SEAM
#undef FRESH
#undef PHASE
}

__global__ void __launch_bounds__(NTHR, 2) mega_fwd(KArgs ka) {
    extern __shared__ __attribute__((aligned(16))) unsigned char lds_raw[];
    Ctx C;
    C.lds = (LAS unsigned char*)lds_raw;
    C.tid = threadIdx.x; C.lane = C.tid & 63; C.wave = __builtin_amdgcn_readfirstlane(C.tid >> 6);
    C.G = gridDim.x; C.bid = blockIdx.x; C.gw = C.bid * NWAVES + C.wave; C.ngw = C.G * NWAVES;
    LAS unsigned char* misc = C.lds + MISC_OFF;
    if (C.tid < 8) ((volatile LAS unsigned*)misc)[C.tid] = 0u;
    Params p; p.out = ka.out; p.ws = ka.ws; p.ph_lo = ka.ph_lo; p.ph_hi = ka.ph_hi; p.ptab = (LAS unsigned long long*)(misc + 1024);
    if (C.tid < 34) p.ptab[C.tid] = (unsigned long long)ka.in[C.tid];
    __syncthreads();
    const int lo = p.ph_lo, hi = p.ph_hi;
    XcdBarrier bar; bar.bar = (unsigned*)(p.ws + WS_CTL) + CW_BAR; bar.x = 0; bar.st = (volatile LAS unsigned*)misc;
    if (hi - lo > 1) bar = xcd_barrier_post((unsigned*)(p.ws + WS_CTL) + CW_BAR, (volatile LAS unsigned*)misc);
#define IN(k) (lo <= (k) && (k) < hi)
#define SEAM(k) do { if (IN(k) && IN((k) + 1)) xcd_barrier(bar, C.wave); } while (0)

    if (IN(0)) { phase_p0(p, C); } SEAM(0);
    if (IN(1)) { phase_p1(p, C); } SEAM(1);
    if (IN(0) && IN(2) && (C.G & 7) == 0) {
        volatile LAS unsigned* st = (volatile LAS unsigned*)misc;
        if (C.tid == 0) { unsigned pre = 0u; const unsigned x = st[3];
            for (unsigned j = 0; j < 16; ++j) { const unsigned cj = xb_ld(&bar.bar[XB_XCNT(j)]); pre += (j < x) ? cj : 0u; }
            st[4] = pre + st[2]; }
        __syncthreads();
        const int vcu = (int)st[4], g8 = C.G >> 3;
        C.bid = __builtin_amdgcn_readfirstlane((vcu % g8) * 8 + vcu / g8); C.gw = C.bid * NWAVES + C.wave;
    }

    layer_body<0>(p, C, bar, misc, lo, hi);
    layer_body<1>(p, C, bar, misc, lo, hi);
#undef IN
#undef SEAM
}

extern "C" void kernel_launch(void* const* d_in, const int* in_sizes, int n_in, void* d_out, int out_size, void* d_ws, size_t ws_size, hipStream_t stream) {
    static int grid = 0;
    if (grid == 0) {
        if (n_in != 34 || out_size != SEQ * DM || ws_size < WS_END) { fprintf(stderr, "kernel_launch: unexpected shapes: n_in %d out %d ws %zu (need %zu)\n", n_in, out_size, ws_size, (size_t)WS_END); grid = -1; return; }
        int dev = 0, cus = 0, per_cu = 0;
        if (hipGetDevice(&dev) != hipSuccess || hipDeviceGetAttribute(&cus, hipDeviceAttributeMultiprocessorCount, dev) != hipSuccess) { grid = -1; return; }
        if (hipFuncSetAttribute((const void*)mega_fwd, hipFuncAttributeMaxDynamicSharedMemorySize, LDS_BYTES) != hipSuccess) { fprintf(stderr, "kernel_launch: hipFuncSetAttribute failed\n"); grid = -1; return; }
        if (hipOccupancyMaxActiveBlocksPerMultiprocessor(&per_cu, (const void*)mega_fwd, NTHR, LDS_BYTES) != hipSuccess || per_cu < 1) { fprintf(stderr, "kernel_launch: occupancy query says %d blocks per CU\n", per_cu); grid = -1; return; }
        (void)hipGetLastError();
        grid = cus;
    }
    if (grid < 0) return;
    (void)hipMemsetAsync((char*)d_ws + WS_CTL, 0, CTL_BYTES, stream);
    KArgs p{};
    for (int i = 0; i < 34; ++i) p.in[i] = (const float*)d_in[i];
    p.out = (float*)d_out; p.ws = (unsigned char*)d_ws;
#if MK_PER_PHASE
    for (int ph = 0; ph < N_PHASES; ++ph) {
        if (ph == 2 + PH_PER_LAYER + 5 || ph == 2 + PH_PER_LAYER + 6) continue;
        p.ph_lo = ph; p.ph_hi = ph + 1;
        hipLaunchKernelGGL(mega_fwd, dim3(grid), dim3(NTHR), LDS_BYTES, stream, p);
    }
#else
    p.ph_lo = 0; p.ph_hi = N_PHASES;
    hipLaunchKernelGGL(mega_fwd, dim3(grid), dim3(NTHR), LDS_BYTES, stream, p);
#endif
    const hipError_t le = hipPeekAtLastError();
    if (le != hipSuccess) fprintf(stderr, "kernel_launch: launch failed: %s\n", hipGetErrorName(le));
}
```

```cpp
#define MK_PER_PHASE 0
#include <hip/hip_runtime.h>
#include <cstdio>
#include <cstdint>

#define GAS __attribute__((address_space(1)))
#define LAS __attribute__((address_space(3)))
typedef unsigned short bf16_t;
typedef short bf16x8 __attribute__((ext_vector_type(8)));
typedef short s16x4 __attribute__((ext_vector_type(4)));
typedef float f32x4 __attribute__((ext_vector_type(4)));
typedef float f32x2 __attribute__((ext_vector_type(2)));
typedef float f32x16 __attribute__((ext_vector_type(16)));
typedef unsigned u32x4 __attribute__((ext_vector_type(4)));
typedef unsigned u32x2 __attribute__((ext_vector_type(2)));

constexpr int DM = 2048, SEQ = 16384, CTXL = 256, TT = SEQ + CTXL;
constexpr int NEXP = 64, NEX1 = 65, EHID = 512, TOPK = 8;
constexpr int EV_IN = 5120, OD_IN = 4608;
constexpr float LN_EPS = 1e-6f;
constexpr float ALPHA = 1.4142135623730951f;
constexpr float LAMBDA_INIT = 0.35550906759f;
constexpr int NTHR = 512, NWAVES = 8;

constexpr size_t al256(size_t x) { return (x + 255) / 256 * 256; }
constexpr size_t WS_CTL   = 0;
constexpr size_t CTL_BYTES = 1u << 20;
constexpr size_t WS_MODP  = WS_CTL + CTL_BYTES;
constexpr size_t WS_MODF  = WS_MODP + al256((size_t)2 * 32 * 2 * 12288 * 4);
constexpr size_t WS_ROPE128 = WS_MODF + al256((size_t)2 * 2 * 12288 * 4);
constexpr size_t WS_ROPE64  = WS_ROPE128 + al256((size_t)256 * 64 * 2 * 4);
constexpr size_t WS_KN    = WS_ROPE64 + al256((size_t)256 * 32 * 2 * 4);
constexpr size_t WS_WT    = WS_KN + al256((size_t)2 * 64 * 16 * 1024 * 2);
constexpr size_t WS_APOW  = WS_WT + al256((size_t)2 * 64 * 128 * 1024 * 2);
constexpr size_t WS_AL    = WS_APOW + al256((size_t)2 * 64 * 64 * 128 * 4);
constexpr size_t WS_CC    = WS_AL + al256((size_t)2 * 64 * 128 * 4);
constexpr size_t WS_BBT   = WS_CC + al256((size_t)64 * 16 * 128 * 2);
constexpr size_t WS_S5E   = WS_BBT + al256((size_t)2 * 64 * 128 * 16 * 2);
constexpr size_t WS_HST   = WS_S5E + al256((size_t)2 * 64 * 260 * 128 * 4);
constexpr size_t WS_WIN0  = WS_HST + al256((size_t)2 * 64 * 260 * 128 * 4);
constexpr size_t WS_WOUT0 = WS_WIN0 + al256((size_t)EV_IN * DM * 2);
constexpr size_t WS_WGLU  = WS_WOUT0 + al256((size_t)DM * DM * 2);
constexpr size_t WS_WIN1  = WS_WGLU + al256((size_t)1024 * 1024 * 2);
constexpr size_t WS_WOUT1 = WS_WIN1 + al256((size_t)OD_IN * DM * 2);
constexpr size_t WS_RWT   = WS_WOUT1 + al256((size_t)DM * DM * 2);
constexpr size_t WS_GU    = WS_RWT + al256((size_t)2 * 2 * 64 * DM * 2);
constexpr size_t WS_DT    = WS_GU + al256((size_t)NEX1 * 1024 * DM * 2);
constexpr size_t WS_XA    = WS_DT + al256((size_t)NEX1 * DM * EHID * 2);
constexpr size_t WS_Z     = WS_XA + al256((size_t)TT * DM * 2);
constexpr size_t WS_YMIX  = WS_Z + al256((size_t)TT * 1024 * 2);
constexpr size_t WS_X1    = WS_YMIX + al256((size_t)TT * DM * 2);
constexpr size_t WS_HX2   = WS_X1 + al256((size_t)TT * DM * 4);
constexpr size_t WS_LIST  = WS_HX2 + al256((size_t)9 * TT * EHID * 2);
constexpr size_t WS_WGT   = WS_LIST + al256((size_t)NEX1 * TT * 4);
constexpr size_t WS_LW    = WS_WGT + al256((size_t)8 * TT * 4);
constexpr size_t WS_BIG   = WS_LW + al256((size_t)NEX1 * TT * 4);
constexpr size_t BG_QKV   = 0;
constexpr size_t BG_CKV   = BG_QKV + al256((size_t)TT * EV_IN * 2);
constexpr size_t BG_SPREV = BG_CKV + al256((size_t)8 * 130 * 65536 * 4);
constexpr size_t BG_MIX   = BG_SPREV + al256((size_t)8 * 130 * 65536 * 2);
constexpr size_t BG_END0  = BG_MIX + al256((size_t)TT * DM * 2);
constexpr size_t BG_ATT   = BG_CKV;
constexpr size_t BG_Q8    = BG_ATT + al256((size_t)SEQ * 3072 * 2);
constexpr size_t BG_K8    = BG_Q8 + al256((size_t)TT * 1024);
constexpr size_t BG_VT8   = BG_K8 + al256((size_t)TT * 256);
constexpr size_t BG_Q8D   = BG_VT8 + al256((size_t)2 * 260 * 128 * 64);
constexpr size_t BG_K8D   = BG_Q8D + al256((size_t)TT * 1024);
constexpr size_t BG_VT8D  = BG_K8D + al256((size_t)TT * 1024);
constexpr size_t BG_F8END = BG_VT8D + al256((size_t)8 * 260 * 128 * 64);
constexpr size_t BG_YMOE  = 0;
constexpr size_t BG_END1  = al256((size_t)9 * TT * DM * 2);
constexpr size_t BG_SIZE  = BG_END0 > BG_END1 ? BG_END0 : BG_END1;
static_assert(BG_F8END <= BG_SIZE, "fp8 attention operands inside the big region");
constexpr size_t WS_END   = WS_BIG + BG_SIZE;

constexpr int CW_BAR = 4096;
constexpr int CW_CNT = 16384;
constexpr int CW_QUEUE = 20480;
constexpr int CW_KMAX = 24576;

constexpr int RING_BYTES = 151552;
constexpr int MISC_OFF = RING_BYTES;
constexpr int LDS_BYTES = 159744;

typedef __bf16 bf16x2_t __attribute__((ext_vector_type(2)));
__device__ __forceinline__ unsigned cvt_pk_bf16(float lo, float hi) { const f32x2 v = {lo, hi}; return __builtin_bit_cast(unsigned, __builtin_convertvector(v, bf16x2_t)); }
__device__ __forceinline__ bf16_t f2bf(float f) { unsigned u = __builtin_bit_cast(unsigned, f); return (bf16_t)((u + 0x7fffu + ((u >> 16) & 1u)) >> 16); }
__device__ __forceinline__ float bf2f(bf16_t b) { return __builtin_bit_cast(float, ((unsigned)b) << 16); }
__device__ __forceinline__ float bflo(unsigned w) { return __builtin_bit_cast(float, w << 16); }
__device__ __forceinline__ float bfhi(unsigned w) { return __builtin_bit_cast(float, w & 0xffff0000u); }
__device__ __forceinline__ float wave_sum(float v) {
#pragma unroll
    for (int o = 1; o < 64; o <<= 1) v += __shfl_xor(v, o);
    return v;
}
__device__ __forceinline__ float fast_exp(float x) { return __builtin_amdgcn_exp2f(x * 1.4426950408889634f); }
__device__ __forceinline__ float sigmoidf_(float x) { return 1.0f / (1.0f + __expf(-x)); }
__device__ __forceinline__ float siluf_(float x) { return x / (1.0f + __expf(-x)); }
__device__ __forceinline__ float gelu_tanh(float x) {
    const float u = 0.7978845608028654f * (x + 0.044715f * x * x * x);
    const float e = __expf(2.0f * u);
    const float t = 1.0f - 2.0f / (e + 1.0f);
    return 0.5f * x * (1.0f + t);
}
#define LDS_WAIT() asm volatile("s_waitcnt lgkmcnt(0)" ::: "memory")
#define VM_WAIT() asm volatile("s_waitcnt vmcnt(0)" ::: "memory")

#define XB_TMO      128
#define XB_XCNT(j)  (256  + 64 * (j))
#define XB_XSUB(j)  (1280 + 64 * (j))
#define XB_XGEN(j)  (2304 + 64 * (j))
#define XB_TOP      3328
#define XB_TOPGEN   3392
#define XCD_BAR_WORDS 3456
#define XB_SPIN_CAP (1u << 22)

__device__ __forceinline__ unsigned xb_ld(unsigned* p)              { return __hip_atomic_load(p, __ATOMIC_RELAXED, __HIP_MEMORY_SCOPE_AGENT); }
__device__ __forceinline__ unsigned xb_add(unsigned* p, unsigned v) { return __hip_atomic_fetch_add(p, v, __ATOMIC_RELAXED, __HIP_MEMORY_SCOPE_AGENT); }
__device__ __forceinline__ unsigned xb_xcc_id() { return (unsigned)__builtin_amdgcn_s_getreg((3 << 11) | 20) & 0xFu; }
#define XB_SPIN(cond, bar) do { unsigned _sp = 0; while (cond) { __builtin_amdgcn_s_sleep(1); \
    if ((++_sp & 255u) == 0u) { if (xb_ld(&(bar)[XB_TMO])) break; if (_sp > XB_SPIN_CAP) { atomicAdd(&(bar)[XB_TMO], 1u); break; } } } } while (0)

struct XcdBarrier { unsigned* bar; unsigned x; volatile LAS unsigned* st; };

__device__ __forceinline__ XcdBarrier xcd_barrier_post(unsigned* bar, volatile LAS unsigned* st) {
    XcdBarrier b; b.bar = bar; b.x = xb_xcc_id(); b.st = st;
    if (threadIdx.x == 0) { st[2] = xb_add(&bar[XB_XCNT(b.x)], 1u); st[3] = b.x; }
    return b;
}
__device__ __forceinline__ void xcd_barrier_complete(unsigned* bar, unsigned x, unsigned& nloc, unsigned& nx) {
    const unsigned G = gridDim.x * gridDim.y * gridDim.z;
    unsigned sum, cnt, mine, sp = 0u;
    for (;;) {
        sum = 0u; cnt = 0u; mine = 0u;
#pragma unroll
        for (unsigned j = 0; j < 16; ++j) { const unsigned c = xb_ld(&bar[XB_XCNT(j)]); sum += c; cnt += (c > 0u) ? 1u : 0u; mine = (j == x) ? c : mine; }
        if (sum == G) break;
        __builtin_amdgcn_s_sleep(1);
        if ((++sp & 255u) == 0u) { if (xb_ld(&bar[XB_TMO])) break; if (sp > XB_SPIN_CAP) { atomicAdd(&bar[XB_TMO], 1u); break; } }
    }
    nloc = mine > 0u ? mine : 1u; nx = cnt > 0u ? cnt : 1u;
}
__device__ __forceinline__ void xcd_barrier(const XcdBarrier& b, int wave_id) {
    const bool leader_thread = (wave_id == 0) && (__builtin_amdgcn_mbcnt_hi(~0u, __builtin_amdgcn_mbcnt_lo(~0u, 0u)) == 0u);
    asm volatile("s_waitcnt vmcnt(0)" ::: "memory");
    __syncthreads();
    if (leader_thread) {
        unsigned* bar = b.bar;
        __builtin_amdgcn_s_waitcnt(0);
        unsigned nloc = b.st[0], nx = b.st[1];
        if (nloc == 0u) { xcd_barrier_complete(bar, b.x, nloc, nx); b.st[0] = nloc; b.st[1] = nx; }
        const unsigned old = xb_add(&bar[XB_XSUB(b.x)], 1u);
        const unsigned gen = old / nloc;
        if (old + 1u == (gen + 1u) * nloc) {
            __builtin_amdgcn_fence(__ATOMIC_RELEASE, "agent");
            asm volatile("s_waitcnt vmcnt(0)" ::: "memory");
            const unsigned og = xb_add(&bar[XB_TOP], 1u);
            const unsigned tg = og / nx;
            if (og + 1u == (tg + 1u) * nx) xb_add(&bar[XB_TOPGEN], 1u);
            else XB_SPIN(xb_ld(&bar[XB_TOPGEN]) == tg, bar);
            __builtin_amdgcn_fence(__ATOMIC_ACQUIRE, "agent");
            xb_add(&bar[XB_XGEN(b.x)], 1u);
            asm volatile("s_waitcnt vmcnt(0)" ::: "memory");
        } else {
            XB_SPIN(xb_ld(&bar[XB_XGEN(b.x)]) == gen, bar);
            __builtin_amdgcn_fence(__ATOMIC_ACQUIRE, "agent");
            asm volatile("s_waitcnt vmcnt(0)" ::: "memory");
        }
    }
    __syncthreads();
}

__device__ __forceinline__ bf16x8 frag_rowk_l(const LAS bf16_t* p, int ld, int lane) {
    return *(const LAS bf16x8*)(p + (lane & 15) * ld + (lane >> 4) * 8);
}
__device__ __forceinline__ bf16x8 frag_rowk_g(const bf16_t* p, long ld, int lane) {
    return *(const bf16x8*)(p + (long)(lane & 15) * ld + (lane >> 4) * 8);
}
__device__ __forceinline__ bf16x8 frag_colk_l(unsigned p, int ldb, int lane) {
    const unsigned a0 = p + (unsigned)((8 * (lane >> 4) + ((lane & 15) >> 2)) * ldb + (lane & 3) * 8);
    const unsigned a1 = a0 + 4u * (unsigned)ldb;
    s16x4 lo, hi;
    asm volatile("ds_read_b64_tr_b16 %0, %2\n\tds_read_b64_tr_b16 %1, %3\n\ts_waitcnt lgkmcnt(0)" : "=&v"(lo), "=&v"(hi) : "v"(a0), "v"(a1) : "memory");
    return (bf16x8){lo[0], lo[1], lo[2], lo[3], hi[0], hi[1], hi[2], hi[3]};
}
#define MFMA16(a, b, c) __builtin_amdgcn_mfma_f32_16x16x32_bf16((a), (b), (c), 0, 0, 0)
namespace pg8 {
constexpr int BM = 256, BK = 64, HALF = 128, HTB = HALF * BK * 2, STAGE_BYTES = 8 * HTB, NXCD = 8, WGM = 8;
__device__ __forceinline__ int lds_byte(int r, int c) { const int st = (r >> 4) * 2 + (c >> 5), rr = r & 15, cc = c & 31, ob = rr * 64 + cc * 2; return st * 1024 + (ob ^ (((ob >> 9) & 1) << 5)); }
__device__ __forceinline__ void stage_rc(int b, int& R, int& C) { const int st = b / 1024, sb = b % 1024, swz = sb ^ (((sb >> 9) & 1) << 5); R = (st >> 1) * 16 + swz / 64; C = (st & 1) * 32 + (swz % 64) / 2; }
__device__ __forceinline__ int perm32(int rho) { const int n = rho >> 4, i = rho & 15; return 8 * (i >> 2) + 4 * n + (i & 3); }

struct Unit { int pm, pn, e; };
constexpr float WSCALE = 32.0f, WSCALE_INV = 1.0f / 32.0f;

struct DenseOrder {
    const bf16_t* A; const bf16_t* Bt; int ldab, kb, nM, nN, nwg, G, c;
    __device__ __forceinline__ void init(const bf16_t* A_, int lda_, const bf16_t* Bt_, int M, int N, int K_, int G_, int c_) { A = A_; ldab = lda_ * 2; Bt = Bt_; kb = K_ * 2; nM = M / BM; nN = N / BM; nwg = nM * nN; G = G_; c = c_; }
    __device__ __forceinline__ void init8(const void* A_, int ldab_, const void* Bt_, int M, int N, int K_, int G_, int c_) { A = (const bf16_t*)A_; ldab = ldab_; Bt = (const bf16_t*)Bt_; kb = K_; nM = M / BM; nN = N / BM; nwg = nM * nN; G = G_; c = c_; }
    __device__ __forceinline__ void prep(LAS unsigned char*) const {}
    __device__ __forceinline__ int units_of_me() const { return c < nwg ? (nwg - c + G - 1) / G : 0; }
    __device__ __forceinline__ int max_units() const { return (nwg + G - 1) / G; }
    __device__ __forceinline__ bool next(int i, Unit& u) const {
        const long L = (long)i * G + c; if (L >= nwg) return false;
        int wgid = (int)L; { const int q = nwg / NXCD, r = nwg % NXCD, xcd = wgid % NXCD, off = wgid / NXCD; wgid = (xcd < r ? xcd * (q + 1) : r * (q + 1) + (xcd - r) * q) + off; }
        const int nig = WGM * nN, gid = wgid / nig, fm = gid * WGM, gsz = (nM - fm) < WGM ? (nM - fm) : WGM;
        u.pm = fm + ((wgid % nig) % gsz); u.pn = (wgid % nig) / gsz; u.e = 0; return true;
    }
    __device__ __forceinline__ const char* a_base() const { return (const char*)A; }
    __device__ __forceinline__ unsigned a_off(const Unit& u, int r) const { return (unsigned)(u.pm * BM + r) * (unsigned)ldab; }
    __device__ __forceinline__ const char* b_ptr(const Unit& u) const { return (const char*)Bt + (size_t)u.pn * BM * kb; }
};

template <int MODE  >
struct MoeOrder {
    const void* A; const void* Bt; const int* list; const int* cnt; int ldab, kb, nN, G, c; size_t bstride;
    LAS int* tp; LAS int* cn; LAS int* rb;
    __device__ __forceinline__ void prep(LAS unsigned char* misc, int tid) {
        tp = (LAS int*)(misc + 64); cn = tp + 72; rb = cn + 72;
        if (tid < NEX1) cn[tid] = cnt[tid];
        __syncthreads();
        if (tid == 0) { int s = 0, q = 0; for (int e = 0; e < NEX1; ++e) { tp[e] = s; rb[e] = q; s += (cn[e] + BM - 1) / BM; q += cn[e]; } tp[NEX1] = s; rb[NEX1] = q; }
        __syncthreads();
    }
    __device__ __forceinline__ bool next(int i, Unit& u) const {
        const int total = tp[NEX1]; const long nu = (long)total * nN; const int per = (int)((nu + G - 1) / G);
        (void)per;
        long L = (long)i * G + c;
        if ((G & 7) == 0) L = ((long)i * 8 + (c & 7)) * (G >> 3) + (c >> 3);
        if (L >= nu) return false;
        const int tile = (int)(L / nN); u.pn = (int)(L % nN);
        int e = 0;
        for (int k = 1; k < NEX1; ++k) e += (tp[k] <= tile) ? 1 : 0;
        u.e = e; u.pm = tile - tp[e]; return true;
    }
    __device__ __forceinline__ const char* a_base() const { return (const char*)A; }
    __device__ __forceinline__ unsigned a_off(const Unit& u, int r) const {
        int pos = u.pm * BM + r; const int n = cn[u.e]; pos = pos < n ? pos : n - 1;
        if (MODE == 1) return (unsigned)(rb[u.e] + pos) * (unsigned)ldab;
        const int a = list[u.e * TT + pos];
        const int row = a < 8 * TT ? (a >> 3) : a - 8 * TT;
        return (unsigned)row * (unsigned)ldab;
    }
    __device__ __forceinline__ const char* b_ptr(const Unit& u) const { return (const char*)Bt + (size_t)u.e * bstride + (size_t)u.pn * BM * kb; }
};

typedef int v8i32 __attribute__((ext_vector_type(8)));
typedef int v4i32_ __attribute__((ext_vector_type(4)));
__device__ __forceinline__ v8i32 cat8(bf16x8 a, bf16x8 b) { const u32x4 x = __builtin_bit_cast(u32x4, a), y = __builtin_bit_cast(u32x4, b); return (v8i32){(int)x.x, (int)x.y, (int)x.z, (int)x.w, (int)y.x, (int)y.y, (int)y.z, (int)y.w}; }
template <bool FP8, class Epi, class Sched>
__device__ __forceinline__ void gemm_phase(LAS unsigned char* lds, const Sched& S, const Epi& E, int wave_id) {
    const int wid = wave_id; int lane = (int)__builtin_amdgcn_mbcnt_hi(~0u, __builtin_amdgcn_mbcnt_lo(~0u, 0u)); asm volatile("" : "+v"(lane));
    const int tid = wid * 64 + lane, wr = wid >> 2, wc = wid & 3, fr = lane & 15, fq = lane >> 4;
    const int kb = S.kb; int nt = kb / 128; asm volatile("" : "+s"(nt));
    unsigned voffB[2];
#pragma unroll
    for (int i = 0; i < 2; ++i) { int R, C; stage_rc(tid * 16 + i * 8192, R, C); const int Rb = (R & ~31) + perm32(R & 31);
        voffB[i] = (unsigned)(Rb * kb) + (unsigned)C * 2u; }
#define PG8_AOFF(u, h, i) ({ int _tz = tid; asm volatile("" : "+v"(_tz)); int _R, _C; stage_rc(_tz * 16 + (i) * 8192, _R, _C); S.a_off((u), (h) * HALF + _R) + (unsigned)_C * 2u; })
    const size_t kstep = (size_t)(BK * 2);
    const size_t hstepB = (size_t)HALF * kb;
    const unsigned ldsw = (unsigned)wid * 1024u;
    const int aoff = lds_byte(wr * 64 + fr, fq * 8), boff = lds_byte(wc * 32 + fr, fq * 8);
#define PG8_SA(b, h) (((b) * 2 + (h)) * HTB)
#define PG8_SB(b, h) ((4 + (b) * 2 + (h)) * HTB)
#define PG8_STAGE(bufoff, gbase, v0, v1) do { \
        __builtin_amdgcn_global_load_lds((const unsigned*)((const char*)(gbase) + (v0)), (LAS unsigned*)(lds + (bufoff) + ldsw), 16, 0, 0); \
        __builtin_amdgcn_global_load_lds((const unsigned*)((const char*)(gbase) + (v1)), (LAS unsigned*)(lds + (bufoff) + ldsw + 8192), 16, 0, 0); } while (0)
#define PG8_VOFFB(i) ({ int _tz = tid; asm volatile("" : "+v"(_tz)); int _R, _C; stage_rc(_tz * 16 + (i) * 8192, _R, _C); (unsigned)(((_R & ~31) + perm32(_R & 31)) * kb) + (unsigned)_C * 2u; })
#define PG8_STAGE_B(bufoff, gbase) do { if constexpr (FP8) { const unsigned _v0 = PG8_VOFFB(0), _v1 = PG8_VOFFB(1); PG8_STAGE(bufoff, gbase, _v0, _v1); } else PG8_STAGE(bufoff, gbase, voffB[0], voffB[1]); } while (0)
#define PG8_LD8(off) __builtin_shufflevector(*(const LAS v4i32_*)(lds + (off)), *(const LAS v4i32_*)(lds + (off) + 1024), 0, 1, 2, 3, 4, 5, 6, 7)
#define PG8_LDA(dst, b, h) do { _Pragma("unroll") for (int m = 0; m < 4; ++m) { if constexpr (FP8) dst##8[m] = PG8_LD8(PG8_SA(b, h) + aoff + m * 2048); else { _Pragma("unroll") for (int k = 0; k < 2; ++k) dst[m][k] = *(const LAS bf16x8*)(lds + PG8_SA(b, h) + aoff + m * 2048 + k * 1024); } } } while (0)
#define PG8_LDB(dst, b, h) do { _Pragma("unroll") for (int n = 0; n < 2; ++n) { if constexpr (FP8) dst##8[n] = PG8_LD8(PG8_SB(b, h) + boff + n * 2048); else { _Pragma("unroll") for (int k = 0; k < 2; ++k) dst[n][k] = *(const LAS bf16x8*)(lds + PG8_SB(b, h) + boff + n * 2048 + k * 1024); } } } while (0)
#define PG8_MMA(ai, bj, At, Bt) do { __builtin_amdgcn_s_setprio(1); _Pragma("unroll") for (int m = 0; m < 4; ++m) _Pragma("unroll") for (int n = 0; n < 2; ++n) { \
        if constexpr (FP8) asm volatile("v_mfma_f32_16x16x128_f8f6f4 %0, %1, %2, %0" : "+v"(acc[ai][bj][m][n]) : "v"(Bt##8[n]), "v"(At##8[m])); \
        else { _Pragma("unroll") for (int k = 0; k < 2; ++k) acc[ai][bj][m][n] = __builtin_amdgcn_mfma_f32_16x16x32_bf16(Bt[n][k], At[m][k], acc[ai][bj][m][n], 0, 0, 0); } } \
        __builtin_amdgcn_s_setprio(0); } while (0)
#define PG8_WAIT_V(n) asm volatile("s_waitcnt vmcnt(" #n ")" ::: "memory")
#define PG8_WAIT_L(n) asm volatile("s_waitcnt lgkmcnt(" #n ")" ::: "memory")
#define PG8_BAR __builtin_amdgcn_s_barrier()
#define PG8_SCHED __builtin_amdgcn_sched_barrier(0)
    Unit cur, nxt; int ui = 0;
    if (!S.next(0, cur)) return;
    f32x4 acc[2][2][4][2];
#pragma unroll
    for (int a = 0; a < 2; ++a)
#pragma unroll
        for (int b = 0; b < 2; ++b)
#pragma unroll
            for (int m = 0; m < 4; ++m)
#pragma unroll
                for (int n = 0; n < 2; ++n) acc[a][b][m][n] = (f32x4){0.f, 0.f, 0.f, 0.f};
    bf16x8 At[4][2], B0[2][2], B1[2][2]; v8i32 At8[4], B08[2], B18[2];
    const char* const gA = S.a_base();
    const char* cB = S.b_ptr(cur);
    unsigned oc00, oc01, oc10, oc11;
    oc00 = PG8_AOFF(cur, 0, 0); oc01 = PG8_AOFF(cur, 0, 1); oc10 = PG8_AOFF(cur, 1, 0); oc11 = PG8_AOFF(cur, 1, 1);
    PG8_STAGE_B(PG8_SB(0, 0), cB); PG8_STAGE_B(PG8_SB(0, 1), cB + hstepB); PG8_STAGE(PG8_SA(0, 0), gA, oc00, oc01); PG8_STAGE(PG8_SA(0, 1), gA, oc10, oc11);
    if (wr == 1) PG8_BAR;
    PG8_WAIT_V(2); PG8_BAR;
    PG8_STAGE_B(PG8_SB(1, 0), cB + kstep); PG8_STAGE(PG8_SA(1, 0), gA + kstep, oc00, oc01); PG8_STAGE_B(PG8_SB(1, 1), cB + hstepB + kstep);
    PG8_WAIT_V(6); PG8_BAR;
    for (;;) {
        const bool has_next = S.next(ui + 1, nxt);
        const char* nB = cB;
        {
            u32x4 on = {oc00, oc01, oc10, oc11};
            if (has_next) { on.x = PG8_AOFF(nxt, 0, 0); on.y = PG8_AOFF(nxt, 0, 1); on.z = PG8_AOFF(nxt, 1, 0); on.w = PG8_AOFF(nxt, 1, 1); nB = S.b_ptr(nxt); }
            *(LAS u32x4*)(lds + STAGE_BYTES + tid * 16) = on;
        }
        for (int t = 0; t < nt; t += 2) {
            const bool last = (t == nt - 2);
            const char* a1 = gA + (size_t)(t + 1) * kstep;
            const char* a2 = last ? gA : gA + (size_t)(t + 2) * kstep; const char* b2 = last ? nB : cB + (size_t)(t + 2) * kstep;
            const char* a3 = a2 + kstep; const char* b3 = b2 + kstep;
            unsigned s00 = oc00, s01 = oc01, s10 = oc10, s11 = oc11;
            if (last) { const u32x4 on = *(const LAS u32x4*)(lds + STAGE_BYTES + tid * 16); s00 = on.x; s01 = on.y; s10 = on.z; s11 = on.w; }
            PG8_LDB(B0, 0, 0); PG8_LDB(B1, 0, 1); PG8_SCHED; PG8_LDA(At, 0, 0); PG8_STAGE(PG8_SA(1, 1), a1, oc10, oc11);
            PG8_WAIT_V(8); PG8_WAIT_L(0); PG8_BAR; PG8_MMA(0, 0, At, B0); PG8_MMA(0, 1, At, B1); PG8_BAR; PG8_SCHED;
            PG8_LDA(At, 0, 1); PG8_STAGE_B(PG8_SB(0, 0), b2); PG8_STAGE_B(PG8_SB(0, 1), b2 + hstepB); PG8_STAGE(PG8_SA(0, 0), a2, s00, s01);
            PG8_WAIT_V(8); PG8_WAIT_L(0); PG8_BAR; PG8_MMA(1, 0, At, B0); PG8_MMA(1, 1, At, B1); PG8_BAR; PG8_SCHED;
            PG8_LDB(B0, 1, 0); PG8_LDB(B1, 1, 1); PG8_SCHED; PG8_LDA(At, 1, 0); PG8_STAGE(PG8_SA(0, 1), a2, s10, s11);
            PG8_WAIT_V(8); PG8_WAIT_L(0); PG8_BAR; PG8_MMA(0, 0, At, B0); PG8_MMA(0, 1, At, B1); PG8_BAR; PG8_SCHED;
            PG8_LDA(At, 1, 1); PG8_STAGE_B(PG8_SB(1, 0), b3); PG8_STAGE_B(PG8_SB(1, 1), b3 + hstepB); PG8_STAGE(PG8_SA(1, 0), a3, s00, s01);
            PG8_WAIT_V(8); PG8_WAIT_L(0); PG8_BAR; PG8_MMA(1, 0, At, B0); PG8_MMA(1, 1, At, B1); PG8_BAR; PG8_SCHED;
        }
        if (wr == 0) PG8_BAR;
        E(acc, cur, wr, wc, fr, fq);
        if (!has_next) break;
#pragma unroll
        for (int a = 0; a < 2; ++a)
#pragma unroll
            for (int b = 0; b < 2; ++b)
#pragma unroll
                for (int m = 0; m < 4; ++m)
#pragma unroll
                    for (int n = 0; n < 2; ++n) acc[a][b][m][n] = (f32x4){0.f, 0.f, 0.f, 0.f};
        { const u32x4 on = *(const LAS u32x4*)(lds + STAGE_BYTES + tid * 16); oc00 = on.x; oc01 = on.y; oc10 = on.z; oc11 = on.w; }
        cur = nxt; cB = nB; ++ui;
        if (wr == 1) PG8_BAR;
    }
    PG8_WAIT_V(0);
    PG8_BAR;
#undef PG8_SA
#undef PG8_SB
#undef PG8_STAGE
#undef PG8_STAGE_B
#undef PG8_AOFF
#undef PG8_VOFFB
#undef PG8_LD8
#undef PG8_LDA
#undef PG8_LDB
#undef PG8_MMA
#undef PG8_WAIT_V
#undef PG8_WAIT_L
#undef PG8_BAR
#undef PG8_SCHED
}

struct EpiStore {
    bf16_t* O; int ldc; float scale;
    __device__ __forceinline__ void operator()(const f32x4 (&acc)[2][2][4][2], const Unit& u, int wr, int wc, int fr, int fq) const {
        const int row0 = u.pm * BM + wr * 64 + fr, col0 = u.pn * BM + wc * 32 + 8 * fq;
#pragma unroll
        for (int ai = 0; ai < 2; ++ai)
#pragma unroll
            for (int m = 0; m < 4; ++m) { bf16_t* rowp = O + (size_t)(row0 + ai * HALF + m * 16) * ldc + col0;
#pragma unroll
                for (int bj = 0; bj < 2; ++bj) { const f32x4 v0 = acc[ai][bj][m][0] * scale, v1 = acc[ai][bj][m][1] * scale;
                    u32x4 w; w.x = cvt_pk_bf16(v0[0], v0[1]); w.y = cvt_pk_bf16(v0[2], v0[3]); w.z = cvt_pk_bf16(v1[0], v1[1]); w.w = cvt_pk_bf16(v1[2], v1[3]);
                    *(u32x4*)(rowp + bj * HALF) = w; } }
    }
};
struct EpiGlu {
    const bf16_t* Z; const float* b; bf16_t* MIX;
    __device__ __forceinline__ void operator()(const f32x4 (&acc)[2][2][4][2], const Unit& u, int wr, int wc, int fr, int fq) const {
        const int row0 = u.pm * BM + wr * 64 + fr, col0 = u.pn * BM + wc * 32 + 8 * fq;
#pragma unroll
        for (int bj = 0; bj < 2; ++bj) {
            const f32x4 b0 = *(const f32x4*)(b + col0 + bj * HALF), b1 = *(const f32x4*)(b + col0 + bj * HALF + 4);
#pragma unroll
            for (int ai = 0; ai < 2; ++ai)
#pragma unroll
                for (int m = 0; m < 4; ++m) { const size_t row = (size_t)(row0 + ai * HALF + m * 16);
                    const u32x4 zz = *(const u32x4*)(Z + row * 1024 + col0 + bj * HALF);
                    const f32x4 v0 = acc[ai][bj][m][0] + b0, v1 = acc[ai][bj][m][1] + b1;
                    u32x4 w;
                    w.x = cvt_pk_bf16(bflo(zz.x) * sigmoidf_(v0[0]), bfhi(zz.x) * sigmoidf_(v0[1]));
                    w.y = cvt_pk_bf16(bflo(zz.y) * sigmoidf_(v0[2]), bfhi(zz.y) * sigmoidf_(v0[3]));
                    w.z = cvt_pk_bf16(bflo(zz.z) * sigmoidf_(v1[0]), bfhi(zz.z) * sigmoidf_(v1[1]));
                    w.w = cvt_pk_bf16(bflo(zz.w) * sigmoidf_(v1[2]), bfhi(zz.w) * sigmoidf_(v1[3]));
                    *(u32x4*)(MIX + row * DM + 1024 + col0 + bj * HALF) = w; }
        }
    }
};
struct EpiE1 {
    unsigned char* H; const LAS int* cn; const LAS int* rb;
    __device__ __forceinline__ void operator()(const f32x4 (&acc)[2][2][4][2], const Unit& u, int wr, int wc, int fr, int fq) const {
        const int n = cn[u.e]; const int colh = u.pn * 128 + wc * 32 + 8 * fq;
#pragma unroll
        for (int ai = 0; ai < 2; ++ai)
#pragma unroll
            for (int m = 0; m < 4; ++m) { const int pos = u.pm * BM + ai * HALF + wr * 64 + m * 16 + fr;
                if (pos < n) { const int a = rb[u.e] + pos;
                    float sc = WSCALE_INV; asm volatile("" : "+v"(sc));
                    const f32x4 g0 = acc[ai][0][m][0] * sc, g1 = acc[ai][0][m][1] * sc, u0 = acc[ai][1][m][0] * sc, u1 = acc[ai][1][m][1] * sc;
                    u32x2 w;
                    w.x = (unsigned)__builtin_amdgcn_cvt_pk_fp8_f32(siluf_(g0[0]) * u0[0], siluf_(g0[1]) * u0[1], 0, false);
                    w.x = (unsigned)__builtin_amdgcn_cvt_pk_fp8_f32(siluf_(g0[2]) * u0[2], siluf_(g0[3]) * u0[3], (int)w.x, true);
                    w.y = (unsigned)__builtin_amdgcn_cvt_pk_fp8_f32(siluf_(g1[0]) * u1[0], siluf_(g1[1]) * u1[1], 0, false);
                    w.y = (unsigned)__builtin_amdgcn_cvt_pk_fp8_f32(siluf_(g1[2]) * u1[2], siluf_(g1[3]) * u1[3], (int)w.y, true);
                    *(u32x2*)(H + (size_t)a * EHID + colh) = w; }
                __builtin_amdgcn_sched_barrier(0); }
    }
};
struct EpiE2 {
    unsigned char* Y; const float* wgt; const LAS int* cn; const LAS int* rb;
    __device__ __forceinline__ void operator()(const f32x4 (&acc)[2][2][4][2], const Unit& u, int wr, int wc, int fr, int fq) const {
        const int n = cn[u.e]; const int col0 = u.pn * BM + wc * 32 + 8 * fq;
#pragma unroll
        for (int ai = 0; ai < 2; ++ai)
#pragma unroll
            for (int m = 0; m < 4; ++m) { const int pos = u.pm * BM + ai * HALF + wr * 64 + m * 16 + fr;
                if (pos < n) { const int a = rb[u.e] + pos; float ws = wgt[u.e * TT + pos] * WSCALE_INV; asm volatile("" : "+v"(ws));
                    unsigned char* rowp = Y + (size_t)a * DM + col0;
#pragma unroll
                    for (int bj = 0; bj < 2; ++bj) { const f32x4 v0 = acc[ai][bj][m][0] * ws, v1 = acc[ai][bj][m][1] * ws;
                        u32x2 w;
                        w.x = (unsigned)__builtin_amdgcn_cvt_pk_fp8_f32(v0[0], v0[1], 0, false); w.x = (unsigned)__builtin_amdgcn_cvt_pk_fp8_f32(v0[2], v0[3], (int)w.x, true);
                        w.y = (unsigned)__builtin_amdgcn_cvt_pk_fp8_f32(v1[0], v1[1], 0, false); w.y = (unsigned)__builtin_amdgcn_cvt_pk_fp8_f32(v1[2], v1[3], (int)w.y, true);
                        *(u32x2*)(rowp + bj * HALF) = w; } }
                __builtin_amdgcn_sched_barrier(0); }
    }
};
}
struct KArgs {
    const float* in[34];
    float* out;
    unsigned char* ws;
    int ph_lo, ph_hi;
};
struct Params {
    float* out;
    unsigned char* ws;
    LAS unsigned long long* ptab;
    int ph_lo, ph_hi;
    __device__ __forceinline__ const float* inp(int k) const {
        const unsigned long long v = ptab[k];
        const unsigned lo = __builtin_amdgcn_readfirstlane((unsigned)v), hi = __builtin_amdgcn_readfirstlane((unsigned)(v >> 32));
        return (const float*)(((unsigned long long)hi << 32) | lo);
    }
};
struct Ctx {
    LAS unsigned char* lds;
    int tid, lane, wave, G, bid;
    int gw, ngw;
};

__device__ __forceinline__ void tr_item(const float* W, int N, bf16_t* WT, int ldt, int k0, int n0, int orow0, LAS float* scr, int lane) {
#pragma unroll 8
    for (int i = 0; i < 32; ++i) { const int kk = 2 * i + (lane >> 5); scr[kk * 33 + (lane & 31)] = W[(size_t)(k0 + kk) * N + n0 + (lane & 31)]; }
    LDS_WAIT(); asm volatile("" ::: "memory");
    const int c = lane & 7;
#pragma unroll
    for (int j = 0; j < 4; ++j) { const int n = (lane >> 3) + 8 * j; const LAS float* s = scr + (8 * c) * 33 + n;
        u32x4 o; o.x = cvt_pk_bf16(s[0 * 33], s[1 * 33]); o.y = cvt_pk_bf16(s[2 * 33], s[3 * 33]); o.z = cvt_pk_bf16(s[4 * 33], s[5 * 33]); o.w = cvt_pk_bf16(s[6 * 33], s[7 * 33]);
        *(u32x4*)(WT + (size_t)(orow0 + n) * ldt + k0 + 8 * c) = o; }
    LDS_WAIT(); asm volatile("" ::: "memory");
}
__device__ __forceinline__ void tr_item64(const float* W, int N, bf16_t* WT, int ldt, int k0, int n0, int orow0, LAS float* scr, int lane) {
    f32x4 v[16];
    const float* src = W + (size_t)(k0 + (lane >> 4)) * N + n0 + 4 * (lane & 15);
#pragma unroll
    for (int i = 0; i < 16; ++i) v[i] = __builtin_nontemporal_load((const f32x4*)(src + (size_t)(4 * i) * N));
#pragma unroll
    for (int i = 0; i < 16; ++i) { LAS float* d = scr + (4 * i + (lane >> 4)) * 65 + 4 * (lane & 15); d[0] = v[i][0]; d[1] = v[i][1]; d[2] = v[i][2]; d[3] = v[i][3]; }
    LDS_WAIT(); asm volatile("" ::: "memory");
    const int c = lane & 7;
#pragma unroll
    for (int j = 0; j < 8; ++j) { const int n = (lane >> 3) + 8 * j; const LAS float* s = scr + (8 * c) * 65 + n;
        u32x4 o; o.x = cvt_pk_bf16(s[0 * 65], s[1 * 65]); o.y = cvt_pk_bf16(s[2 * 65], s[3 * 65]); o.z = cvt_pk_bf16(s[4 * 65], s[5 * 65]); o.w = cvt_pk_bf16(s[6 * 65], s[7 * 65]);
        *(u32x4*)(WT + (size_t)(orow0 + n) * ldt + k0 + 8 * c) = o; }
    LDS_WAIT(); asm volatile("" ::: "memory");
}
__device__ __forceinline__ void tr_item64_fp8(const float* W, int N, unsigned char* WT, int ldt, int k0, int n0, int orow0, LAS float* scr, int lane, float wscale = pg8::WSCALE) {
    f32x4 v[16];
    const float* src = W + (size_t)(k0 + (lane >> 4)) * N + n0 + 4 * (lane & 15);
#pragma unroll
    for (int i = 0; i < 16; ++i) v[i] = __builtin_nontemporal_load((const f32x4*)(src + (size_t)(4 * i) * N));
#pragma unroll
    for (int i = 0; i < 16; ++i) { LAS float* d = scr + (4 * i + (lane >> 4)) * 65 + 4 * (lane & 15); d[0] = v[i][0]; d[1] = v[i][1]; d[2] = v[i][2]; d[3] = v[i][3]; }
    LDS_WAIT(); asm volatile("" ::: "memory");
    const int c = lane & 3;
#pragma unroll
    for (int j = 0; j < 4; ++j) { const int n = (lane >> 2) + 16 * j; const LAS float* s = scr + (16 * c) * 65 + n;
        u32x4 o;
        o.x = (unsigned)__builtin_amdgcn_cvt_pk_fp8_f32(s[0 * 65] * wscale, s[1 * 65] * wscale, 0, false);   o.x = (unsigned)__builtin_amdgcn_cvt_pk_fp8_f32(s[2 * 65] * wscale, s[3 * 65] * wscale, (int)o.x, true);
        o.y = (unsigned)__builtin_amdgcn_cvt_pk_fp8_f32(s[4 * 65] * wscale, s[5 * 65] * wscale, 0, false);   o.y = (unsigned)__builtin_amdgcn_cvt_pk_fp8_f32(s[6 * 65] * wscale, s[7 * 65] * wscale, (int)o.y, true);
        o.z = (unsigned)__builtin_amdgcn_cvt_pk_fp8_f32(s[8 * 65] * wscale, s[9 * 65] * wscale, 0, false);   o.z = (unsigned)__builtin_amdgcn_cvt_pk_fp8_f32(s[10 * 65] * wscale, s[11 * 65] * wscale, (int)o.z, true);
        o.w = (unsigned)__builtin_amdgcn_cvt_pk_fp8_f32(s[12 * 65] * wscale, s[13 * 65] * wscale, 0, false); o.w = (unsigned)__builtin_amdgcn_cvt_pk_fp8_f32(s[14 * 65] * wscale, s[15 * 65] * wscale, (int)o.w, true);
        *(u32x4*)(WT + (size_t)(orow0 + n) * ldt + k0 + 16 * c) = o; }
    LDS_WAIT(); asm volatile("" ::: "memory");
}
__device__ __forceinline__ void tr_dense(const float* W, int K, int N, bf16_t* WT, int item, LAS float* scr, int lane) {
    const int nblk = N / 32, kb = item / nblk, nb = item % nblk;
    tr_item(W, N, WT, K, 64 * kb, 32 * nb, 32 * nb, scr, lane);
}

__device__ __forceinline__ void s5_tables(const Params& p, Ctx& C, int dir, int g) {
    LAS f32x2* PW = (LAS f32x2*)C.lds;
    LAS f32x2* BB = PW + 65 * 64;
    LAS f32x2* CX = BB + 64 * 16;
    const float* a_re = p.inp(11); const float* a_im = p.inp(12); const float* log_dt = p.inp(13);
    const float* b_re = p.inp(14); const float* b_im = p.inp(15); const float* c_re = p.inp(16); const float* c_im = p.inp(17);
    const int tid = C.tid;
    if (tid < 64) {
        const int pp = tid;
        const float dt = __expf(log_dt[dir * 64 + g]);
        const float are = a_re[(dir * 64 + g) * 64 + pp], aim = a_im[(dir * 64 + g) * 64 + pp];
        const float zr = are * dt, zi = aim * dt;
        const float mag = __expf(zr);
        double rev = (double)zi * 0.15915494309189535; rev -= floor(rev);
        const float cs = __builtin_amdgcn_cosf((float)rev), sn = __builtin_amdgcn_sinf((float)rev);
        const float abr = mag * cs, abi = mag * sn;
        const float den = are * are + aim * aim, nr = abr - 1.0f, ni = abi;
        const float fre = (nr * are + ni * aim) / den, fim = (ni * are - nr * aim) / den;
        float pr = 1.0f, pi = 0.0f;
#pragma unroll 1
        for (int n = 0; n <= 64; ++n) { PW[n * 64 + pp] = (f32x2){pr, pi}; const float t = pr * abr - pi * abi; pi = pr * abi + pi * abr; pr = t; }
        for (int j = 0; j < 16; ++j) { const float br = b_re[(g * 64 + pp) * 16 + j], bi = b_im[(g * 64 + pp) * 16 + j];
            BB[pp * 16 + j] = (f32x2){fre * br - fim * bi, fre * bi + fim * br}; }
    }
    for (int q = tid; q < 1024; q += NTHR) { const int i = q >> 6, pp = q & 63; CX[i * 64 + pp] = (f32x2){c_re[(g * 16 + i) * 64 + pp], c_im[(g * 16 + i) * 64 + pp]}; }
    __syncthreads();
    bf16_t* KN = (bf16_t*)(p.ws + WS_KN) + (size_t)(dir * 64 + g) * 16 * 1024;
    float* APOW = (float*)(p.ws + WS_APOW) + (size_t)(dir * 64 + g) * 64 * 128;
    float* AL = (float*)(p.ws + WS_AL) + (size_t)(dir * 64 + g) * 128;
#pragma unroll 1
    for (int q = 0; q < 32; ++q) { const int idx = tid + NTHR * q; const int n = idx >> 8, i = (idx >> 4) & 15, j = idx & 15;
        float s = 0.f;
#pragma unroll 4
        for (int pp = 0; pp < 64; ++pp) { const f32x2 c = CX[i * 64 + pp], w = PW[n * 64 + pp], b = BB[pp * 16 + j];
            const float gr = c.x * b.x - c.y * b.y, gi = c.x * b.y + c.y * b.x;
            s += gr * w.x - gi * w.y; }
        KN[(size_t)i * 1024 + n * 16 + j] = f2bf(s); }
    for (int q = tid; q < 4096; q += NTHR) { const int t = q >> 6, pp = q & 63; const f32x2 w = PW[(t + 1) * 64 + pp]; *(f32x2*)(APOW + (size_t)t * 128 + 2 * pp) = w; }
    if (tid < 64) { const f32x2 w = PW[64 * 64 + tid]; *(f32x2*)(AL + 2 * tid) = w; }
    { bf16_t* BBT = (bf16_t*)(p.ws + WS_BBT) + (size_t)(dir * 64 + g) * 128 * 16;
      for (int q = tid; q < 2048; q += NTHR) { const int pq = q >> 4, j = q & 15; const f32x2 b = BB[(pq & 63) * 16 + j]; BBT[q] = f2bf(pq < 64 ? b.x : b.y); } }
    if (dir == 0) { bf16_t* CCt = (bf16_t*)(p.ws + WS_CC) + (size_t)g * 16 * 128;
        for (int q = tid; q < 2048; q += NTHR) { const int i = q >> 7, pq = q & 127; const f32x2 c = CX[i * 64 + (pq & 63)]; CCt[i * 128 + pq] = f2bf(pq < 64 ? c.x : -c.y); } }
    __syncthreads();
}

__device__ __forceinline__ void phase_p0(const Params& p, Ctx& C) {
    for (int task = C.bid; task < 128; task += C.G) s5_tables(p, C, task >> 6, task & 63);
    {
        const int gt = C.bid * NTHR + C.tid, ngt = C.G * NTHR;
        float* R128 = (float*)(p.ws + WS_ROPE128); float* R64 = (float*)(p.ws + WS_ROPE64);
        for (int q = gt; q < 256 * 64 + 256 * 32; q += ngt) {
            int pos, i, half; float* dst;
            if (q < 256 * 64) { pos = q >> 6; i = q & 63; half = 64; dst = R128 + (size_t)q * 2; }
            else { const int r = q - 256 * 64; pos = r >> 5; i = r & 31; half = 32; dst = R64 + (size_t)r * 2; }
            const float freq = exp2f(-(float)i / (float)half * 13.287712379549449f);
            const float ang = (float)pos * freq;
            double rev = (double)ang * 0.15915494309189535; rev -= floor(rev);
            dst[0] = __builtin_amdgcn_cosf((float)rev); dst[1] = __builtin_amdgcn_sinf((float)rev);
        }
        bf16_t* RWT = (bf16_t*)(p.ws + WS_RWT); const float* rw = p.inp(26);
        for (int q = gt; q < 2 * 64 * DM; q += ngt) { const int L = q / (64 * DM), r = q % (64 * DM), e = r / DM, k = r % DM;
            const float w = rw[((size_t)L * DM + k) * 64 + e]; const bf16_t hi = f2bf(w); const bf16_t lo = f2bf(w - bf2f(hi));
            RWT[((size_t)(L * 2 + 0) * 64 + e) * DM + k] = hi; RWT[((size_t)(L * 2 + 1) * 64 + e) * DM + k] = lo; }
    }
    {
        const float* cvec = p.inp(1); const float* cctx = p.inp(3); const float* mw = p.inp(4);
        float* MODP = (float*)(p.ws + WS_MODP);
        for (int task = C.gw; task < 2 * 32 * 48; task += C.ngw) {
            const int L = task / (32 * 48), r = task % (32 * 48), kb = r / 48, cb = r % 48;
            const float sc = siluf_(cvec[64 * kb + C.lane]), sx = siluf_(cctx[64 * kb + C.lane]);
            f32x4 a0 = {0.f, 0.f, 0.f, 0.f}, a1 = {0.f, 0.f, 0.f, 0.f};
            const float* wp = mw + ((size_t)L * DM + 64 * kb) * 12288 + 256 * cb + 4 * C.lane;
#pragma unroll 8
            for (int kk = 0; kk < 64; ++kk) { const f32x4 w = *(const f32x4*)(wp + (size_t)kk * 12288);
                const float s0 = __shfl(sc, kk), s1 = __shfl(sx, kk);
                a0 += w * s0; a1 += w * s1; }
            *(f32x4*)(MODP + ((size_t)((L * 32 + kb) * 2 + 0)) * 12288 + 256 * cb + 4 * C.lane) = a0;
            *(f32x4*)(MODP + ((size_t)((L * 32 + kb) * 2 + 1)) * 12288 + 256 * cb + 4 * C.lane) = a1;
        }
    }
    {
        LAS float* scr = (LAS float*)(C.lds + C.wave * 17408);
        constexpr int J0 = (DM / 64) * (EV_IN / 64), J3 = (DM / 64) * (OD_IN / 64);
        for (int it = C.gw; it < J0 + J3; it += C.ngw) {
            const bool l1 = it >= J0; const int r = l1 ? it - J0 : it; const int N = l1 ? OD_IN : EV_IN; const int nblk = N / 64, kb = r / nblk, nb = r % nblk;
            tr_item64_fp8(p.inp(l1 ? 21 : 8), N, (unsigned char*)(p.ws + (l1 ? WS_WIN1 : WS_WIN0)), DM, 64 * kb, 64 * nb, 64 * nb, scr, C.lane, 32.0f);
        }
        LAS float* scr2 = (LAS float*)(C.lds + C.wave * 17408);
        constexpr int I1 = (DM / 64) * (DM / 32), I2 = (1024 / 64) * (1024 / 32), I4 = I1;
        for (int it = C.gw; it < I1 + I2 + I4; it += C.ngw) {
            int r = it;
            if (r < I1) { tr_dense(p.inp(9), DM, DM, (bf16_t*)(p.ws + WS_WOUT0), r, scr2, C.lane); continue; } r -= I1;
            if (r < I2) { tr_dense(p.inp(19), 1024, 1024, (bf16_t*)(p.ws + WS_WGLU), r, scr2, C.lane); continue; } r -= I2;
            tr_dense(p.inp(22), DM, DM, (bf16_t*)(p.ws + WS_WOUT1), r, scr2, C.lane);
        }
    }
}
__device__ __forceinline__ void phase_p1(const Params& p, Ctx& C) {
    const float* MODP = (const float*)(p.ws + WS_MODP); float* MODF = (float*)(p.ws + WS_MODF); const float* mb = p.inp(5);
    for (int q = C.bid * NTHR + C.tid; q < 2 * 2 * 12288; q += C.G * NTHR) { const int L = q / (2 * 12288), v = (q / 12288) & 1, col = q % 12288;
        float s = mb[L * 12288 + col];
        for (int kb = 0; kb < 32; ++kb) s += MODP[((size_t)((L * 32 + kb) * 2 + v)) * 12288 + col];
        MODF[q] = s; }
}
__device__ __forceinline__ const float* modv(const Params& p, int L, int v, int k) { return (const float*)(p.ws + WS_MODF) + (size_t)(L * 2 + v) * 12288 + k * DM; }

__device__ __forceinline__ void stage_vec(LAS float* dst, const float* src, int tid) { *(LAS f32x4*)(dst + 4 * tid) = *(const f32x4*)(src + 4 * tid); }
__device__ __forceinline__ void conv_item(const Params& p, Ctx& C, int L, int it) {
    LAS float* scr = (LAS float*)(C.lds + C.wave * 17408);
    unsigned char* GU = (unsigned char*)(p.ws + WS_GU) + (size_t)L * NEX1 * 1024 * DM; unsigned char* DT = (unsigned char*)(p.ws + WS_DT) + (size_t)L * NEX1 * DM * EHID;
    const int e = it / 768, r = it % 768, which = r >> 8, q = r & 255;
    if (which < 2) {
        const float* W = (e < 64) ? p.inp(28 + which) + ((size_t)(L * 64 + e)) * DM * EHID : p.inp(31 + which) + (size_t)L * DM * EHID;
        const int kb = q >> 3, nb = q & 7, n0 = 64 * nb;
        tr_item64_fp8(W, EHID, GU + (size_t)e * 1024 * DM, DM, 64 * kb, n0, 256 * (n0 >> 7) + (n0 & 127) + (which ? 128 : 0), scr, C.lane);
    } else {
        const float* W = (e < 64) ? p.inp(30) + ((size_t)(L * 64 + e)) * EHID * DM : p.inp(33) + (size_t)L * EHID * DM;
        const int kb = q >> 5, nb = q & 31;
        tr_item64_fp8(W, DM, DT + (size_t)e * DM * EHID, EHID, 64 * kb, 64 * nb, 64 * nb, scr, C.lane);
    }
}
__device__ __forceinline__ void conv_queue(const Params& p, Ctx& C, int quota) {
    unsigned* head = (unsigned*)(p.ws + WS_CTL) + CW_QUEUE + 128;
    const int batch = quota < 8 ? quota : 8;
    for (int done = 0; done < quota; done += batch) {
        int it0 = 0; if (C.lane == 0) it0 = (int)atomicAdd(head, (unsigned)batch);
        it0 = __builtin_amdgcn_readfirstlane(it0);
        if (it0 >= NEX1 * 768) break;
        for (int k = 0; k < batch && it0 + k < NEX1 * 768; ++k) conv_item(p, C, 1, it0 + k);
    }
}
__device__ __forceinline__ void phase_modulate(const Params& p, Ctx& C, int L) {
    unsigned char* XA8 = (unsigned char*)(p.ws + WS_XA);
    const float* X2 = (const float*)(p.ws + WS_HX2);
    LAS float* MV = (LAS float*)C.lds;
    for (int v = 0; v < 2; ++v) { stage_vec(MV + (v * 2 + 0) * DM, modv(p, L, v, 0), C.tid); stage_vec(MV + (v * 2 + 1) * DM, modv(p, L, v, 1), C.tid); }
    __syncthreads();
    for (int r = C.gw; r < TT; r += C.ngw) {
        const int v = r < CTXL ? 1 : 0;
        const float* src = (L == 0) ? (r < CTXL ? p.inp(2) + (size_t)r * DM : p.inp(0) + (size_t)(r - CTXL) * DM) : X2 + (size_t)r * DM;
        const LAS float* sh = MV + (v * 2 + 0) * DM; const LAS float* sc = MV + (v * 2 + 1) * DM;
#pragma unroll
        for (int j = 0; j < 8; ++j) { const int c = 4 * (C.lane + 64 * j);
            const f32x4 x = *(const f32x4*)(src + c), a = *(const LAS f32x4*)(sc + c), b = *(const LAS f32x4*)(sh + c);
            const f32x4 y = x * (a + 1.0f) + b;
            unsigned w = (unsigned)__builtin_amdgcn_cvt_pk_fp8_f32(y[0], y[1], 0, false); w = (unsigned)__builtin_amdgcn_cvt_pk_fp8_f32(y[2], y[3], (int)w, true);
            *(unsigned*)(XA8 + (size_t)r * DM + c) = w; }
    }
    __syncthreads();
    if (L == 0) { for (int it = C.gw; it < NEX1 * 768; it += C.ngw) conv_item(p, C, 0, it); }
    else conv_queue(p, C, 1 << 30);
}

__device__ __forceinline__ void phase_rope0(const Params& p, Ctx& C) {
    bf16_t* QKV = (bf16_t*)(p.ws + WS_BIG + BG_QKV);
    const f32x2* R128 = (const f32x2*)(p.ws + WS_ROPE128);
    for (int r = C.gw; r < TT; r += C.ngw) {
        bf16_t* row = QKV + (size_t)r * EV_IN;
        if (r < CTXL) {
#pragma unroll
            for (int j = 0; j < 2; ++j) { u32x4* q = (u32x4*)(row + 8 * (C.lane + 64 * j)); u32x4 w = *q;
                w.x = cvt_pk_bf16(bflo(w.x) * 0.0625f, bfhi(w.x) * 0.0625f); w.y = cvt_pk_bf16(bflo(w.y) * 0.0625f, bfhi(w.y) * 0.0625f);
                w.z = cvt_pk_bf16(bflo(w.z) * 0.0625f, bfhi(w.z) * 0.0625f); w.w = cvt_pk_bf16(bflo(w.w) * 0.0625f, bfhi(w.w) * 0.0625f); *q = w; }
        } else {
            const int l = r - CTXL, rp = l >> 6, cp = l & 63;
#pragma unroll
            for (int qk = 0; qk < 2; ++qk)
#pragma unroll
                for (int m = 0; m < 8; ++m) { const int pi = C.lane + 64 * m, head = pi >> 7, blk = (pi >> 6) & 1, i = pi & 63;
                    bf16_t* b = row + qk * 1024 + head * 256 + blk * 128 + i;
                    const f32x2 cs = R128[(blk ? cp : rp) * 64 + i];
                    const float x1 = bf2f(b[0]), x2 = bf2f(b[64]); const float sc = qk ? 1.0f : 0.0625f;
                    b[0] = f2bf((x1 * cs.x - x2 * cs.y) * sc); b[64] = f2bf((x1 * cs.y + x2 * cs.x) * sc); }
        }
    }
}

__device__ __forceinline__ void phase_normrope1(const Params& p, Ctx& C) {
    bf16_t* QKV = (bf16_t*)(p.ws + WS_BIG + BG_QKV);
    const f32x2* R64 = (const f32x2*)(p.ws + WS_ROPE64);
    const float* qg = p.inp(23);
    unsigned* KMAX = (unsigned*)(p.ws + WS_CTL) + CW_KMAX;
    unsigned char* Q8 = (unsigned char*)(p.ws + WS_BIG + BG_Q8); unsigned char* K8 = (unsigned char*)(p.ws + WS_BIG + BG_K8); unsigned char* VT8 = (unsigned char*)(p.ws + WS_BIG + BG_VT8);
    unsigned char* Q8D = (unsigned char*)(p.ws + WS_BIG + BG_Q8D); unsigned char* K8D = (unsigned char*)(p.ws + WS_BIG + BG_K8D); unsigned char* VT8D = (unsigned char*)(p.ws + WS_BIG + BG_VT8D);
    const int lane = C.lane, i32 = lane & 31; const bool up = lane >= 32;
    const float g00 = qg[lane], g01 = qg[64 + lane], g10 = qg[128 + lane], g11 = qg[128 + 64 + lane];
    for (int r = C.gw; r < TT; r += C.ngw) {
        bf16_t* row = QKV + (size_t)r * OD_IN;
        const bool lat = r >= CTXL; const int l = r - CTXL, rp = lat ? (l >> 6) : 0, cp = lat ? (l & 63) : 0;
        const f32x2 cr = R64[rp * 32 + i32], cc = R64[cp * 32 + i32];
#pragma unroll 2
        for (int h = 0; h < 26; ++h) {
            const int col = h < 8 ? 128 * h : (h < 10 ? 1024 + 128 * (h - 8) : (h < 18 ? 1536 + 128 * (h - 10) : 2560 + 128 * (h - 18)));
            bf16_t* b = row + col;
            float v0 = bf2f(b[lane]), v1 = bf2f(b[64 + lane]);
            if (h < 10) { const float ss = wave_sum(v0 * v0 + v1 * v1); const float rs = rsqrtf(ss * (1.0f / 128.0f) + LN_EPS);
                v0 = bf2f(f2bf(v0 * rs)) * (h < 8 ? g00 : g10); v1 = bf2f(f2bf(v1 * rs)) * (h < 8 ? g01 : g11); }
            if (lat) { const float p0 = __shfl_xor(v0, 32), p1 = __shfl_xor(v1, 32);
                v0 = up ? (p0 * cr.y + v0 * cr.x) : (v0 * cr.x - p0 * cr.y);
                v1 = up ? (p1 * cc.y + v1 * cc.x) : (v1 * cc.x - p1 * cc.y); }
            const bf16_t o0 = f2bf(v0), o1 = f2bf(v1);
            b[lane] = o0; b[64 + lane] = o1;
            {
                const float w0 = bf2f(o0), w1 = bf2f(o1);
                float e4[4];
#pragma unroll
                for (int j = 0; j < 4; ++j) { const float a = __shfl(w0, (4 * lane + j) & 63), c2 = __shfl(w1, (4 * lane + j) & 63); e4[j] = lane < 16 ? a : c2; }
                unsigned pk = (unsigned)__builtin_amdgcn_cvt_pk_fp8_f32(e4[0], e4[1], 0, false); pk = (unsigned)__builtin_amdgcn_cvt_pk_fp8_f32(e4[2], e4[3], (int)pk, true);
                unsigned char* dst8 = h < 8 ? Q8 + (size_t)r * 1024 + 128 * h : (h < 10 ? K8 + (size_t)r * 256 + 128 * (h - 8) : (h < 18 ? Q8D + (size_t)r * 1024 + 128 * (h - 10) : K8D + (size_t)r * 1024 + 128 * (h - 18)));
                if (lane < 32) *(unsigned*)(dst8 + 4 * lane) = pk; }
            if ((h >= 8 && h < 10) || h >= 18) {
                const float w0 = bf2f(o0), w1 = bf2f(o1); const float k2 = wave_sum(w0 * w0 + w1 * w1);
                if (lane == 0) atomicMax(KMAX + 64 * (h < 10 ? h - 8 : h - 16), __float_as_uint(k2)); }
        }
    }
    LAS bf16_t* vt = (LAS bf16_t*)(C.lds + C.wave * 17408);
    for (int item = C.gw; item < 10 * 260; item += C.ngw) {
        const int kh = item / 260, T = item % 260;
        const int vcol = kh < 2 ? 1280 + 128 * kh : 3584 + 128 * (kh - 2);
        unsigned char* vout = kh < 2 ? VT8 + (size_t)kh * 260 * 8192 : VT8D + (size_t)(kh - 2) * 260 * 8192;
#pragma unroll
        for (int q = 0; q < 16; ++q) { const int idx = lane + 64 * q, key = idx >> 4, c = idx & 15;
            *(LAS u32x4*)(vt + key * 136 + 8 * c) = *(const u32x4*)(QKV + (size_t)(64 * T + key) * OD_IN + vcol + 8 * c); }
        LDS_WAIT(); asm volatile("" ::: "memory");
#pragma unroll
        for (int dd = 0; dd < 2; ++dd) { const int d = lane + 64 * dd;
            unsigned char* dst = vout + ((size_t)T * 128 + d) * 64;
#pragma unroll
            for (int cch = 0; cch < 4; ++cch) { u32x4 w;
#pragma unroll
                for (int wd = 0; wd < 4; ++wd) { float f[4];
#pragma unroll
                    for (int e = 0; e < 4; ++e) { const int bb = 16 * cch + 4 * wd + e, hi2 = bb >> 5, blk = (bb >> 4) & 1, j = bb & 15; const int key = 32 * blk + (j & 3) + 8 * (j >> 2) + 4 * hi2;
                        f[e] = bf2f(vt[key * 136 + d]); }
                    unsigned pk = (unsigned)__builtin_amdgcn_cvt_pk_fp8_f32(f[0], f[1], 0, false); pk = (unsigned)__builtin_amdgcn_cvt_pk_fp8_f32(f[2], f[3], (int)pk, true);
                    w[wd] = pk; }
                *(u32x4*)(dst + 16 * cch) = w; } }
        LDS_WAIT(); asm volatile("" ::: "memory");
    }
}

__device__ __forceinline__ void phase_merge1(const Params& p, Ctx& C) {
    bf16_t* ATT = (bf16_t*)(p.ws + WS_BIG + BG_ATT);
    const float* dl = p.inp(24); const float* sg = p.inp(25);
    const int lane = C.lane;
    float d0 = dl[lane] * dl[128 + lane] + dl[64 + lane] * dl[128 + 64 + lane];
    float d1 = dl[256 + lane] * dl[384 + lane] + dl[256 + 64 + lane] * dl[384 + 64 + lane];
    const float lam = __expf(wave_sum(d0)) - __expf(wave_sum(d1)) + LAMBDA_INIT;
    const f32x4 gg = *(const f32x4*)(sg + 4 * lane);
    for (int l = C.gw; l < SEQ; l += C.ngw) {
        bf16_t* row = ATT + (size_t)l * 3072;
#pragma unroll
        for (int h = 0; h < 4; ++h) {
            const u32x2 a = *(const u32x2*)(row + 1024 + 256 * h + 4 * lane), b = *(const u32x2*)(row + 2048 + 256 * h + 4 * lane);
            f32x4 o = {bflo(a.x) - lam * bflo(b.x), bfhi(a.x) - lam * bfhi(b.x), bflo(a.y) - lam * bflo(b.y), bfhi(a.y) - lam * bfhi(b.y)};
            const float ss = wave_sum(o[0] * o[0] + o[1] * o[1] + o[2] * o[2] + o[3] * o[3]);
            const float rs = rsqrtf(ss * (1.0f / 256.0f) + LN_EPS) * (1.0f - LAMBDA_INIT);
            o = o * rs * gg;
            u32x2 w; w.x = cvt_pk_bf16(o[0], o[1]); w.y = cvt_pk_bf16(o[2], o[3]);
            *(u32x2*)(row + 1024 + 256 * h + 4 * lane) = w;
        }
    }
}

__device__ __forceinline__ void phase_ln1(const Params& p, Ctx& C, int L) {
    const bf16_t* Y = (const bf16_t*)(p.ws + WS_YMIX); float* X1 = (float*)(p.ws + WS_X1); unsigned char* XA8 = (unsigned char*)(p.ws + WS_XA);
    const float* X2 = (const float*)(p.ws + WS_HX2);
    const float* lg = p.inp(6) + (size_t)(L * 2 + 0) * DM; const float* lb = p.inp(7) + (size_t)(L * 2 + 0) * DM;
    const int r0 = (L == 0) ? 0 : CTXL;
    LAS float* MV = (LAS float*)C.lds; LAS float* LG = MV + 6 * DM; LAS float* LB = LG + DM;
    for (int v = 0; v < 2; ++v) for (int k = 0; k < 3; ++k) stage_vec(MV + (v * 3 + k) * DM, modv(p, L, v, 2 + k), C.tid);
    stage_vec(LG, lg, C.tid); stage_vec(LB, lb, C.tid);
    __syncthreads();
    for (int r = r0 + C.gw; r < TT; r += C.ngw) {
        const int v = r < CTXL ? 1 : 0;
        const float* src = (L == 0) ? (r < CTXL ? p.inp(2) + (size_t)r * DM : p.inp(0) + (size_t)(r - CTXL) * DM) : X2 + (size_t)r * DM;
        const LAS float* g1 = MV + (v * 3 + 0) * DM; const LAS float* sh2 = MV + (v * 3 + 1) * DM; const LAS float* sc2 = MV + (v * 3 + 2) * DM;
        f32x4 t[8]; float s = 0.f;
#pragma unroll
        for (int j = 0; j < 8; ++j) { const int c = 4 * (C.lane + 64 * j);
            const f32x4 x = *(const f32x4*)(src + c), g = *(const LAS f32x4*)(g1 + c); const u32x2 yy = *(const u32x2*)(Y + (size_t)r * DM + c);
            const f32x4 y = {bflo(yy.x), bfhi(yy.x), bflo(yy.y), bfhi(yy.y)};
            t[j] = x * ALPHA + g * y; s += (t[j][0] + t[j][1]) + (t[j][2] + t[j][3]); }
        const float mean = wave_sum(s) * (1.0f / DM); float s2 = 0.f;
#pragma unroll
        for (int j = 0; j < 8; ++j) { t[j] = t[j] - mean; s2 += (t[j][0] * t[j][0] + t[j][1] * t[j][1]) + (t[j][2] * t[j][2] + t[j][3] * t[j][3]); }
        const float rstd = rsqrtf(wave_sum(s2) * (1.0f / DM) + LN_EPS);
#pragma unroll
        for (int j = 0; j < 8; ++j) { const int c = 4 * (C.lane + 64 * j);
            const f32x4 x1 = t[j] * rstd * *(const LAS f32x4*)(LG + c) + *(const LAS f32x4*)(LB + c);
            *(f32x4*)(X1 + (size_t)r * DM + c) = x1;
            const f32x4 z = x1 * (*(const LAS f32x4*)(sc2 + c) + 1.0f) + *(const LAS f32x4*)(sh2 + c);
            unsigned w = (unsigned)__builtin_amdgcn_cvt_pk_fp8_f32(z[0], z[1], 0, false); w = (unsigned)__builtin_amdgcn_cvt_pk_fp8_f32(z[2], z[3], (int)w, true);
            *(unsigned*)(XA8 + (size_t)r * DM + c) = w; }
    }
    __syncthreads();
}

__device__ __forceinline__ void phase_combine(const Params& p, Ctx& C, int L, LAS unsigned char* misc) {
    const unsigned char* YM = (const unsigned char*)(p.ws + WS_BIG + BG_YMOE); const float* X1 = (const float*)(p.ws + WS_X1);
    float* X2 = (float*)(p.ws + WS_HX2);
    const float* lg = p.inp(6) + (size_t)(L * 2 + 1) * DM; const float* lb = p.inp(7) + (size_t)(L * 2 + 1) * DM;
    const unsigned* PK = (const unsigned*)(p.ws + WS_WGT); const int* cnt = (const int*)(p.ws + WS_CTL) + CW_CNT + L * 128;
    const int r0 = (L == 0) ? 0 : CTXL;
    LAS int* rb = (LAS int*)(misc + 64);
    LAS float* MV = (LAS float*)C.lds; LAS float* LG = MV + 2 * DM; LAS float* LB = LG + DM;
    __syncthreads();
    if (C.tid == 0) { int q = 0; for (int e = 0; e < NEX1; ++e) { rb[e] = q; q += cnt[e]; } }
    stage_vec(MV, modv(p, L, 0, 5), C.tid); stage_vec(MV + DM, modv(p, L, 1, 5), C.tid); stage_vec(LG, lg, C.tid); stage_vec(LB, lb, C.tid);
    __syncthreads();
    for (int r = r0 + C.gw; r < TT; r += C.ngw) {
        const int v = r < CTXL ? 1 : 0;
        const LAS float* g2 = MV + v * DM;
        int ln = C.lane; asm volatile("" : "+v"(ln));
        int slot = rb[64] + (r - r0);
        if (ln < 8) { const unsigned pk = PK[(size_t)r * 8 + ln]; slot = rb[pk >> 16] + (int)(pk & 0xffffu); }
        f32x4 t[2][4]; float s = 0.f;
#pragma unroll
        for (int j = 0; j < 2; ++j) { const int c = 16 * (ln + 64 * j);
            u32x4 yy[9];
#pragma unroll
            for (int k = 0; k < 9; ++k) { const size_t a = (size_t)__builtin_amdgcn_readlane(slot, k); yy[k] = __builtin_nontemporal_load((const u32x4*)(YM + a * DM + c)); }
            f32x2 f[8];
#pragma unroll
            for (int q = 0; q < 8; ++q) f[q] = (f32x2){0.f, 0.f};
#pragma unroll
            for (int k = 0; k < 9; ++k) {
                f[0] += __builtin_amdgcn_cvt_pk_f32_fp8((int)yy[k].x, false); f[1] += __builtin_amdgcn_cvt_pk_f32_fp8((int)yy[k].x, true);
                f[2] += __builtin_amdgcn_cvt_pk_f32_fp8((int)yy[k].y, false); f[3] += __builtin_amdgcn_cvt_pk_f32_fp8((int)yy[k].y, true);
                f[4] += __builtin_amdgcn_cvt_pk_f32_fp8((int)yy[k].z, false); f[5] += __builtin_amdgcn_cvt_pk_f32_fp8((int)yy[k].z, true);
                f[6] += __builtin_amdgcn_cvt_pk_f32_fp8((int)yy[k].w, false); f[7] += __builtin_amdgcn_cvt_pk_f32_fp8((int)yy[k].w, true); }
#pragma unroll
            for (int q = 0; q < 4; ++q) { const f32x4 x = *(const f32x4*)(X1 + (size_t)r * DM + c + 4 * q), g = *(const LAS f32x4*)(g2 + c + 4 * q);
                const f32x4 ff = {f[2 * q][0], f[2 * q][1], f[2 * q + 1][0], f[2 * q + 1][1]};
                t[j][q] = x * ALPHA + g * ff; s += (t[j][q][0] + t[j][q][1]) + (t[j][q][2] + t[j][q][3]); } }
        const float mean = wave_sum(s) * (1.0f / DM); float s2 = 0.f;
#pragma unroll
        for (int j = 0; j < 2; ++j)
#pragma unroll
            for (int q = 0; q < 4; ++q) { t[j][q] = t[j][q] - mean; s2 += (t[j][q][0] * t[j][q][0] + t[j][q][1] * t[j][q][1]) + (t[j][q][2] * t[j][q][2] + t[j][q][3] * t[j][q][3]); }
        const float rstd = rsqrtf(wave_sum(s2) * (1.0f / DM) + LN_EPS);
        float* dst = (L == 0) ? X2 + (size_t)r * DM : p.out + (size_t)(r - CTXL) * DM;
#pragma unroll
        for (int j = 0; j < 2; ++j)
#pragma unroll
            for (int q = 0; q < 4; ++q) { const int c = 16 * (ln + 64 * j) + 4 * q;
                *(f32x4*)(dst + c) = t[j][q] * rstd * *(const LAS f32x4*)(LG + c) + *(const LAS f32x4*)(LB + c); }
    }
}
constexpr int RLD = 264;
constexpr int SLD = 136;

template <bool SCALE>
__device__ __forceinline__ void stage_chunk(const bf16_t* QKV, int row0, int col0, LAS bf16_t* dst, int tid, float lg  , int dirb) {
#pragma unroll
    for (int q = 0; q < 8; ++q) { const int idx = tid + NTHR * q, r = idx >> 5, c = idx & 31;
        u32x4 w = *(const u32x4*)(QKV + (size_t)(row0 + r) * EV_IN + col0 + 8 * c);
        if (SCALE) { const float sc = fast_exp((dirb ? (float)r : (float)(127 - r)) * lg);
            w.x = cvt_pk_bf16(bflo(w.x) * sc, bfhi(w.x) * sc); w.y = cvt_pk_bf16(bflo(w.y) * sc, bfhi(w.y) * sc);
            w.z = cvt_pk_bf16(bflo(w.z) * sc, bfhi(w.z) * sc); w.w = cvt_pk_bf16(bflo(w.w) * sc, bfhi(w.w) * sc); }
        *(LAS u32x4*)(dst + r * RLD + 8 * c) = w; }
}

__device__ __forceinline__ void ret_chunk_kv(const Params& p, Ctx& C) {
    const bf16_t* QKV = (const bf16_t*)(p.ws + WS_BIG + BG_QKV); bf16_t* CKV = (bf16_t*)(p.ws + WS_BIG + BG_CKV);
    const float* rld = p.inp(10);
    LAS bf16_t* Vs = (LAS bf16_t*)C.lds; LAS bf16_t* Ks = Vs + 128 * RLD;
    const int lane = C.lane, w = C.wave;
    for (int unit = C.bid; unit < 130 * 8; unit += C.G) {
        const int u = unit >> 3, h = (unit >> 1) & 3, dir = unit & 1;
        const float lg = rld[dir * 4 + h];
        __syncthreads();
        stage_chunk<false>(QKV, 128 * u, 2048 + 256 * h, Vs, C.tid, 0.f, 0);
        stage_chunk<true>(QKV, 128 * u, 1024 + 256 * h, Ks, C.tid, lg, dir);
        __syncthreads();
        f32x4 acc[2][16];
#pragma unroll
        for (int a = 0; a < 2; ++a)
#pragma unroll
            for (int b = 0; b < 16; ++b) acc[a][b] = (f32x4){0.f, 0.f, 0.f, 0.f};
        const unsigned vbase = (unsigned)(uintptr_t)Vs, kbase = (unsigned)(uintptr_t)Ks;
#pragma unroll 1
        for (int ks = 0; ks < 4; ++ks) {
            bf16x8 af[2];
#pragma unroll
            for (int a = 0; a < 2; ++a) af[a] = frag_colk_l(vbase + (unsigned)((32 * ks) * RLD + 32 * w + 16 * a) * 2u, RLD * 2, lane);
#pragma unroll
            for (int b = 0; b < 16; ++b) { const bf16x8 bf = frag_colk_l(kbase + (unsigned)((32 * ks) * RLD + 16 * b) * 2u, RLD * 2, lane);
                acc[0][b] = MFMA16(bf, af[0], acc[0][b]); acc[1][b] = MFMA16(bf, af[1], acc[1][b]); }
        }
        bf16_t* dst = CKV + ((size_t)((dir * 4 + h) * 130 + u)) * 65536;
#pragma unroll
        for (int a = 0; a < 2; ++a)
#pragma unroll
            for (int b = 0; b < 16; ++b) { u32x2 w2; w2.x = cvt_pk_bf16(acc[a][b][0], acc[a][b][1]); w2.y = cvt_pk_bf16(acc[a][b][2], acc[a][b][3]);
                *(u32x2*)(dst + (size_t)(32 * w + 16 * a + (lane & 15)) * 256 + 16 * b + 4 * (lane >> 4)) = w2; }
    }
    __syncthreads();
}

__device__ __forceinline__ int s5_row(int dir, int c, int s) { return dir == 0 ? 64 * c + s : (c < 4 ? 255 - (64 * c + s) : 16639 - 64 * (c - 4) - s); }

__device__ __forceinline__ void s5_end_states(const Params& p, Ctx& C) {
    const bf16_t* QKV = (const bf16_t*)(p.ws + WS_BIG + BG_QKV); const bf16_t* BBT = (const bf16_t*)(p.ws + WS_BBT); float* E = (float*)(p.ws + WS_S5E);
    const float* APOW = (const float*)(p.ws + WS_APOW);
    LAS f32x2* PL = (LAS f32x2*)C.lds;
    for (int bt = C.bid; bt < 256; bt += C.G) {
        int tid = C.tid; asm volatile("" : "+v"(tid));
        const int lane = tid & 63, r32 = lane & 31, hi = lane >> 5;
        const int dg = bt >> 1, dir = dg >> 6, g = dg & 63, c0 = 130 * (bt & 1);
        __syncthreads();
#pragma unroll
        for (int q = 0; q < 8; ++q) { const int idx = tid + NTHR * q, s = idx >> 6, pp = idx & 63;
            PL[idx] = (s == 63) ? (f32x2){1.0f, 0.0f} : *(const f32x2*)(APOW + ((size_t)dg * 64 + (62 - s)) * 128 + 2 * pp); }
        __syncthreads();
        bf16x8 bfr[4];
#pragma unroll
        for (int pt = 0; pt < 4; ++pt) bfr[pt] = *(const bf16x8*)(BBT + ((size_t)dg * 128 + 32 * pt + r32) * 16 + 8 * hi);
        for (int c = c0 + C.wave; c < c0 + 130; c += 8) {
            float er[2] = {0.f, 0.f}, ei[2] = {0.f, 0.f};
#pragma unroll
            for (int st = 0; st < 2; ++st) {
                const bf16x8 a = *(const bf16x8*)(QKV + (size_t)s5_row(dir, c, 32 * st + r32) * EV_IN + 4096 + 16 * g + 8 * hi);
                f32x16 d[4];
#pragma unroll
                for (int pt = 0; pt < 4; ++pt) d[pt] = __builtin_amdgcn_mfma_f32_32x32x16_bf16(a, bfr[pt], (f32x16){}, 0, 0, 0);
#pragma unroll
                for (int r = 0; r < 16; ++r) { const int s = 32 * st + (r & 3) + 8 * (r >> 2) + 4 * hi;
#pragma unroll
                    for (int pt = 0; pt < 2; ++pt) { const f32x2 pw = PL[s * 64 + 32 * pt + r32]; const float br = d[pt][r], bi = d[pt + 2][r];
                        er[pt] += pw.x * br - pw.y * bi; ei[pt] += pw.x * bi + pw.y * br; } }
            }
#pragma unroll
            for (int pt = 0; pt < 2; ++pt) {
                { auto rr = __builtin_amdgcn_permlane32_swap(__float_as_uint(er[pt]), __float_as_uint(er[pt]), false, false); er[pt] = __uint_as_float(rr[0]) + __uint_as_float(rr[1]); }
                { auto rr = __builtin_amdgcn_permlane32_swap(__float_as_uint(ei[pt]), __float_as_uint(ei[pt]), false, false); ei[pt] = __uint_as_float(rr[0]) + __uint_as_float(rr[1]); }
            }
            float* dst = E + ((size_t)dg * 260 + c) * 128;
            if (hi == 0) { dst[r32] = er[0]; dst[32 + r32] = er[1]; dst[64 + r32] = ei[0]; dst[96 + r32] = ei[1]; }
        }
    }
    __syncthreads();
}

__device__ __forceinline__ void phase_scans(const Params& p, Ctx& C) {
    const bf16_t* CKV = (const bf16_t*)(p.ws + WS_BIG + BG_CKV); bf16_t* SP = (bf16_t*)(p.ws + WS_BIG + BG_SPREV);
    const float* rld = p.inp(10);
    for (int q = C.bid * NTHR + C.tid; q < 8 * 16384; q += C.G * NTHR) {
        const int dh = q >> 14, el = (q & 16383) * 4, dir = dh >> 2, h = dh & 3;
        const float gch = fast_exp(128.0f * rld[dir * 4 + h]);
        const bf16_t* src = CKV + (size_t)dh * 130 * 65536 + el; bf16_t* dst = SP + (size_t)dh * 130 * 65536 + el;
        f32x4 s = {0.f, 0.f, 0.f, 0.f};
        for (int st0 = 0; st0 < 130; st0 += 13) {
            u32x2 kv[13];
#pragma unroll
            for (int k = 0; k < 13; ++k) { const int st = st0 + k; const int u = dir == 0 ? st : (st == 0 ? 1 : (st == 1 ? 0 : 131 - st)); kv[k] = __builtin_nontemporal_load((const u32x2*)(src + (size_t)u * 65536)); }
#pragma unroll
            for (int k = 0; k < 13; ++k) { const int st = st0 + k; const int u = dir == 0 ? st : (st == 0 ? 1 : (st == 1 ? 0 : 131 - st));
                u32x2 w; w.x = cvt_pk_bf16(s[0], s[1]); w.y = cvt_pk_bf16(s[2], s[3]); *(u32x2*)(dst + (size_t)u * 65536) = w;
                s = s * gch + (f32x4){bflo(kv[k].x), bfhi(kv[k].x), bflo(kv[k].y), bfhi(kv[k].y)}; }
        }
    }
    const float* E = (const float*)(p.ws + WS_S5E); float* HST = (float*)(p.ws + WS_HST); const float* AL = (const float*)(p.ws + WS_AL);
    for (int q = C.bid * NTHR + C.tid; q < 2 * 64 * 64; q += C.G * NTHR) {
        const int dg = q >> 6, pp = q & 63;
        const f32x2 al = *(const f32x2*)(AL + (size_t)dg * 128 + 2 * pp);
        const float* e = E + (size_t)dg * 260 * 128; float* hs = HST + (size_t)dg * 260 * 128;
        float hr = 0.f, hi = 0.f;
        for (int c0 = 0; c0 < 260; c0 += 26) {
            float er[26], ei[26];
#pragma unroll
            for (int k = 0; k < 26; ++k) { er[k] = e[(size_t)(c0 + k) * 128 + pp]; ei[k] = e[(size_t)(c0 + k) * 128 + 64 + pp]; }
#pragma unroll
            for (int k = 0; k < 26; ++k) { *(f32x2*)(hs + (size_t)(c0 + k) * 128 + 2 * pp) = (f32x2){hr, hi};
                const float t = al.x * hr - al.y * hi + er[k]; hi = al.x * hi + al.y * hr + ei[k]; hr = t; }
        }
    }
}

__device__ __forceinline__ void ret_output_unit(const Params& p, Ctx& C, int unit) {
    const bf16_t* QKV = (const bf16_t*)(p.ws + WS_BIG + BG_QKV); const bf16_t* SP = (const bf16_t*)(p.ws + WS_BIG + BG_SPREV);
    bf16_t* MIX = (bf16_t*)(p.ws + WS_BIG + BG_MIX);
    const float* rld = p.inp(10);
    LAS bf16_t* RA = (LAS bf16_t*)C.lds; LAS bf16_t* RB = RA + 128 * RLD;
    int tid = C.tid; asm volatile("" : "+v"(tid));
    const int lane = tid & 63, w = C.wave, kq = lane >> 4, fr = lane & 15;
    const int u = unit >> 2, h = unit & 3;
    const float lgf = rld[h], lgb = rld[4 + h];
    stage_chunk<false>(QKV, 128 * u, 256 * h, RA, tid, 0.f, 0);
    int ib = 16 * w + 4 * kq, jb = fr; asm volatile("" : "+v"(ib), "+v"(jb));
    f32x4 acc[16];
#pragma unroll
    for (int t = 0; t < 16; ++t) acc[t] = (f32x4){0.f, 0.f, 0.f, 0.f};
#pragma unroll
    for (int dir = 0; dir < 2; ++dir) {
        const bf16_t* Sd = SP + ((size_t)((dir * 4 + h) * 130 + u)) * 65536;
#pragma unroll
        for (int eh = 0; eh < 2; ++eh) {
            __syncthreads();
#pragma unroll
            for (int q = 0; q < 8; ++q) { const int idx = tid + NTHR * q, rr = idx >> 5, c = idx & 31;
                *(LAS u32x4*)(RB + rr * RLD + 8 * c) = *(const u32x4*)(Sd + (size_t)(128 * eh + rr) * 256 + 8 * c);
                if (q == 3) asm volatile("" ::: "memory"); }
            __syncthreads();
#pragma unroll 1
            for (int ks = 0; ks < 8; ++ks) { const bf16x8 af = frag_rowk_l(RA + (16 * w) * RLD + 32 * ks, RLD, lane);
#pragma unroll
                for (int t = 0; t < 8; ++t) { const bf16x8 bf = frag_rowk_l(RB + (16 * t) * RLD + 32 * ks, RLD, lane); acc[8 * eh + t] = MFMA16(af, bf, acc[8 * eh + t]); } }
        }
#pragma unroll
        for (int r = 0; r < 4; ++r) { const int i = ib + r; const float qd = fast_exp((float)(128 - i) * lgb);
            const float f = (dir == 0) ? fast_exp((float)(i + 1) * lgf) / qd : qd;
#pragma unroll
            for (int t = 0; t < 16; ++t) acc[t][r] *= f; }
    }
    __syncthreads();
    stage_chunk<false>(QKV, 128 * u, 1024 + 256 * h, RB, tid, 0.f, 0);
    __syncthreads();
    f32x4 sc[8];
#pragma unroll
    for (int t = 0; t < 8; ++t) sc[t] = (f32x4){0.f, 0.f, 0.f, 0.f};
#pragma unroll 1
    for (int ks = 0; ks < 8; ++ks) { const bf16x8 af = frag_rowk_l(RA + (16 * w) * RLD + 32 * ks, RLD, lane);
#pragma unroll
        for (int t = 0; t < 8; ++t) { const bf16x8 bf = frag_rowk_l(RB + (16 * t) * RLD + 32 * ks, RLD, lane); sc[t] = MFMA16(af, bf, sc[t]); } }
#pragma unroll
    for (int t = 0; t < 8; ++t)
#pragma unroll
        for (int r = 0; r < 4; ++r) { const int i = ib + r, j = 16 * t + jb; const float d = (float)(i - j);
            const float m = (i >= j ? fast_exp(d * lgf) : 0.f) + (j >= i ? fast_exp(-d * lgb) : 0.f); sc[t][r] *= m; }
    __syncthreads();
    stage_chunk<false>(QKV, 128 * u, 2048 + 256 * h, RA, tid, 0.f, 0);
#pragma unroll
    for (int t = 0; t < 8; ++t)
#pragma unroll
        for (int r = 0; r < 4; ++r) RB[(16 * w + 4 * kq + r) * SLD + 16 * t + fr] = f2bf(sc[t][r]);
    __syncthreads();
    const unsigned vbase = (unsigned)(uintptr_t)RA;
#pragma unroll 1
    for (int ks = 0; ks < 4; ++ks) { const bf16x8 af = frag_rowk_l(RB + (16 * w) * SLD + 32 * ks, SLD, lane);
#pragma unroll
        for (int t = 0; t < 16; ++t) { const bf16x8 bf = frag_colk_l(vbase + (unsigned)((32 * ks) * RLD + 16 * t) * 2u, RLD * 2, lane); acc[t] = MFMA16(af, bf, acc[t]); } }
    __syncthreads();
#pragma unroll
    for (int r = 0; r < 4; ++r) {
        float s = 0.f;
#pragma unroll
        for (int t = 0; t < 16; ++t) s += acc[t][r];
        s += __shfl_xor(s, 1); s += __shfl_xor(s, 2); s += __shfl_xor(s, 4); s += __shfl_xor(s, 8);
        const float mean = s * (1.0f / 256.0f); float q = 0.f;
#pragma unroll
        for (int t = 0; t < 16; ++t) { const float d = acc[t][r] - mean; q += d * d; }
        q += __shfl_xor(q, 1); q += __shfl_xor(q, 2); q += __shfl_xor(q, 4); q += __shfl_xor(q, 8);
        const float rstd = rsqrtf(q * (1.0f / 256.0f) + LN_EPS);
#pragma unroll
        for (int t = 0; t < 16; ++t) RA[(16 * w + 4 * kq + r) * RLD + 16 * t + fr] = f2bf((acc[t][r] - mean) * rstd);
    }
    __syncthreads();
#pragma unroll
    for (int q = 0; q < 8; ++q) { const int idx = tid + NTHR * q, rr = idx >> 5, c = idx & 31; const size_t row = (size_t)(128 * u + rr);
        const u32x4 o = *(const LAS u32x4*)(RA + rr * RLD + 8 * c), g = *(const u32x4*)(QKV + row * EV_IN + 3072 + 256 * h + 8 * c);
        u32x4 w4;
        w4.x = cvt_pk_bf16(bflo(o.x) * siluf_(bflo(g.x)), bfhi(o.x) * siluf_(bfhi(g.x))); w4.y = cvt_pk_bf16(bflo(o.y) * siluf_(bflo(g.y)), bfhi(o.y) * siluf_(bfhi(g.y)));
        w4.z = cvt_pk_bf16(bflo(o.z) * siluf_(bflo(g.z)), bfhi(o.z) * siluf_(bfhi(g.z))); w4.w = cvt_pk_bf16(bflo(o.w) * siluf_(bflo(g.w)), bfhi(o.w) * siluf_(bfhi(g.w)));
        *(u32x4*)(MIX + row * DM + 256 * h + 8 * c) = w4; }
    __syncthreads();
}

constexpr int KLD = 1032;
__device__ __forceinline__ void s5_output_task(const Params& p, Ctx& C, int bt) {
    const bf16_t* QKV = (const bf16_t*)(p.ws + WS_BIG + BG_QKV); bf16_t* Z = (bf16_t*)(p.ws + WS_Z);
    const bf16_t* KN = (const bf16_t*)(p.ws + WS_KN); const bf16_t* CCt = (const bf16_t*)(p.ws + WS_CC);
    const float* APOW = (const float*)(p.ws + WS_APOW); const float* HST = (const float*)(p.ws + WS_HST); const float* dsk = p.inp(18);
    int tid = C.tid; asm volatile("" : "+v"(tid));
    const int lane = tid & 63, kq = lane >> 4, fr = lane & 15;
    LAS bf16_t* KF = (LAS bf16_t*)C.lds; LAS bf16_t* KB = KF + 16 * KLD;
    LAS bf16_t* U = KB + 16 * KLD + C.wave * 3072;
    LAS float* PW0 = (LAS float*)(KB + 16 * KLD + 8 * 3072);
    LAS float* PW16 = PW0 + 2 * 16 * 128;
    {
        const int g = bt >> 3, k0 = (260 * (bt & 7)) >> 3, k1 = (260 * ((bt & 7) + 1)) >> 3;
#pragma unroll
        for (int q = 0; q < 8; ++q) { const int idx = tid + NTHR * q, dir = idx >> 11, rr = (idx >> 7) & 15, c = idx & 127;
            *(LAS u32x4*)((dir ? KB : KF) + rr * KLD + 8 * c) = *(const u32x4*)(KN + ((size_t)(dir * 64 + g) * 16 + rr) * 1024 + 8 * c); }
        for (int q = lane; q < 192 * 2; q += 64) *(LAS u32x4*)(U + 8 * q) = (u32x4){0u, 0u, 0u, 0u};
#pragma unroll
        for (int q = 0; q < 2; ++q) { const int idx = tid + NTHR * q, dir = idx >> 9, f = (idx >> 5) & 15, c4 = idx & 31;
            *(LAS f32x4*)(PW0 + dir * 2048 + f * 128 + 4 * c4) = *(const f32x4*)(APOW + ((size_t)(dir * 64 + g) * 64 + (dir == 0 ? f : 15 - f)) * 128 + 4 * c4); }
        if (tid < 64) { const int dir = tid >> 5, c4 = tid & 31; *(LAS f32x4*)(PW16 + dir * 128 + 4 * c4) = *(const f32x4*)(APOW + ((size_t)(dir * 64 + g) * 64 + 15) * 128 + 4 * c4); }
        __syncthreads();
        const f32x4 dv = *(const f32x4*)(dsk + 16 * g + 4 * kq);
        bf16x8 ccr[2], cci[2];
#pragma unroll
        for (int hb = 0; hb < 2; ++hb) { ccr[hb] = frag_rowk_g(CCt + (size_t)g * 16 * 128 + 32 * hb, 128, lane); cci[hb] = frag_rowk_g(CCt + (size_t)g * 16 * 128 + 64 + 32 * hb, 128, lane); }
        const LAS float* pw0l = PW0 + (size_t)fr * 128 + 16 * kq;
        const LAS float* pw16l = PW16 + 16 * kq;
        for (int k = k0 + C.wave; k < k1; k += 8) {
            LDS_WAIT(); asm volatile("" ::: "memory");
            for (int q = lane; q < 128; q += 64) { const int t = q >> 1, hf = q & 1;
                *(LAS u32x4*)(U + (64 + t) * 16 + 8 * hf) = *(const u32x4*)(QKV + (size_t)(64 * k + t) * EV_IN + 4096 + 16 * g + 8 * hf); }
            LDS_WAIT(); asm volatile("" ::: "memory");
            const int cf = k, cb = k < 4 ? 3 - k : 263 - k;
            f32x4 acc[4];
#pragma unroll
            for (int tt = 0; tt < 4; ++tt) acc[tt] = (f32x4){0.f, 0.f, 0.f, 0.f};
            const LAS bf16_t* ubf = U + (64 + fr - (kq >> 1)) * 16 + 8 * (kq & 1);
            const LAS bf16_t* ubb = U + (64 + fr + (kq >> 1)) * 16 + 8 * (kq & 1);
#pragma unroll
            for (int n0 = 0; n0 < 64; n0 += 2) {
                const bf16x8 af = frag_rowk_l(KF + n0 * 16, KLD, lane), ab = frag_rowk_l(KB + n0 * 16, KLD, lane);
#pragma unroll
                for (int tt = 0; tt < 4; ++tt) {
                    if (n0 <= 16 * tt + 14) acc[tt] = MFMA16(af, *(const LAS bf16x8*)(ubf + (16 * tt - n0) * 16), acc[tt]);
                    if (n0 <= 62 - 16 * tt) acc[tt] = MFMA16(ab, *(const LAS bf16x8*)(ubb + (16 * tt + n0) * 16), acc[tt]);
                }
                asm volatile("" ::: "memory");
            }
#pragma unroll
            for (int dir = 0; dir < 2; ++dir) {
                const float* hp = HST + ((size_t)(dir * 64 + g) * 260 + (dir == 0 ? cf : cb)) * 128;
#pragma unroll
                for (int hb = 0; hb < 2; ++hb) {
                    float xr[8], xi[8];
#pragma unroll
                    for (int e2 = 0; e2 < 4; ++e2) { const f32x4 h4 = *(const f32x4*)(hp + 2 * (32 * hb + 8 * kq) + 4 * e2), b4 = *(const LAS f32x4*)(pw0l + dir * 2048 + hb * 64 + 4 * e2);
                        xr[2 * e2] = b4[0] * h4[0] - b4[1] * h4[1]; xi[2 * e2] = b4[0] * h4[1] + b4[1] * h4[0];
                        xr[2 * e2 + 1] = b4[2] * h4[2] - b4[3] * h4[3]; xi[2 * e2 + 1] = b4[2] * h4[3] + b4[3] * h4[2]; }
#pragma unroll
                    for (int st = 0; st < 4; ++st) {
                        const int tt = dir == 0 ? st : 3 - st;
                        u32x4 br, bi;
                        br.x = cvt_pk_bf16(xr[0], xr[1]); br.y = cvt_pk_bf16(xr[2], xr[3]); br.z = cvt_pk_bf16(xr[4], xr[5]); br.w = cvt_pk_bf16(xr[6], xr[7]);
                        bi.x = cvt_pk_bf16(xi[0], xi[1]); bi.y = cvt_pk_bf16(xi[2], xi[3]); bi.z = cvt_pk_bf16(xi[4], xi[5]); bi.w = cvt_pk_bf16(xi[6], xi[7]);
                        acc[tt] = MFMA16(ccr[hb], __builtin_bit_cast(bf16x8, br), acc[tt]);
                        acc[tt] = MFMA16(cci[hb], __builtin_bit_cast(bf16x8, bi), acc[tt]);
                        if (st < 3) {
#pragma unroll
                            for (int e2 = 0; e2 < 4; ++e2) { const f32x4 a4 = *(const LAS f32x4*)(pw16l + dir * 128 + hb * 64 + 4 * e2);
                                float t0 = xr[2 * e2] * a4[0] - xi[2 * e2] * a4[1]; xi[2 * e2] = xr[2 * e2] * a4[1] + xi[2 * e2] * a4[0]; xr[2 * e2] = t0;
                                t0 = xr[2 * e2 + 1] * a4[2] - xi[2 * e2 + 1] * a4[3]; xi[2 * e2 + 1] = xr[2 * e2 + 1] * a4[3] + xi[2 * e2 + 1] * a4[2]; xr[2 * e2 + 1] = t0; }
                        }
                    }
                }
            }
#pragma unroll
            for (int tt = 0; tt < 4; ++tt) { const int t = 16 * tt + fr;
                const u32x2 uu = *(const LAS u32x2*)(U + (64 + t) * 16 + 4 * kq);
                const float y0 = acc[tt][0] + bflo(uu.x) * dv[0], y1 = acc[tt][1] + bfhi(uu.x) * dv[1], y2 = acc[tt][2] + bflo(uu.y) * dv[2], y3 = acc[tt][3] + bfhi(uu.y) * dv[3];
                u32x2 w; w.x = cvt_pk_bf16(gelu_tanh(y0), gelu_tanh(y1)); w.y = cvt_pk_bf16(gelu_tanh(y2), gelu_tanh(y3));
                *(u32x2*)(Z + (size_t)(64 * k + t) * 1024 + 16 * g + 4 * kq) = w; }
        }
    }
    __syncthreads();
}

__device__ __forceinline__ void phase_ret_s5_outputs(const Params& p, Ctx& C, LAS unsigned char* misc) {
    unsigned* head = (unsigned*)(p.ws + WS_CTL) + CW_QUEUE;
    volatile LAS int* slot = (volatile LAS int*)(misc + 32);
    for (;;) {
        __syncthreads();
        if (C.tid == 0) slot[0] = (int)atomicAdd(head, 1u);
        __syncthreads();
        const int item = __builtin_amdgcn_readfirstlane(slot[0]);
        if (item >= 520) break;
        ret_output_unit(p, C, item);
    }
    for (;;) {
        __syncthreads();
        if (C.tid == 0) slot[0] = (int)atomicAdd(head + 64, 1u);
        __syncthreads();
        const int item = __builtin_amdgcn_readfirstlane(slot[0]);
        if (item >= 512) break;
        s5_output_task(p, C, item);
    }
}
__device__ __forceinline__ void phase_router(const Params& p, Ctx& C, int L) {
    const float* X1 = (const float*)(p.ws + WS_X1);
    const bf16_t* RWh = (const bf16_t*)(p.ws + WS_RWT) + (size_t)(L * 2 + 0) * 64 * DM; const bf16_t* RWl = (const bf16_t*)(p.ws + WS_RWT) + (size_t)(L * 2 + 1) * 64 * DM;
    const float* rbias = p.inp(27) + L * 64;
    int* cnt = (int*)(p.ws + WS_CTL) + CW_CNT + L * 128; int* LIST = (int*)(p.ws + WS_LIST); unsigned* PK = (unsigned*)(p.ws + WS_WGT); float* LW = (float*)(p.ws + WS_LW);
    const int lane = C.lane, kq = lane >> 4, fr = lane & 15;
    LAS float* Lg = (LAS float*)(C.lds + C.wave * 8192);
    const int r0 = (L == 0) ? 0 : CTXL, nrows = TT - r0;
    if (C.bid == 0 && C.tid == 0) cnt[64] = nrows;
    for (int task = C.gw; task < nrows / 16; task += C.ngw) {
        const int rbase = r0 + 16 * task, row = rbase + fr;
        const int v = row < CTXL ? 1 : 0;
        const float* xr = X1 + (size_t)row * DM; const float* sc2 = modv(p, L, v, 4); const float* sh2 = modv(p, L, v, 3);
        f32x4 acc[4];
#pragma unroll
        for (int t = 0; t < 4; ++t) acc[t] = (f32x4){0.f, 0.f, 0.f, 0.f};
#pragma unroll 2
        for (int ks = 0; ks < 64; ++ks) { const int c0 = 32 * ks + 8 * kq;
            const f32x4 x0 = *(const f32x4*)(xr + c0), x1 = *(const f32x4*)(xr + c0 + 4);
            const f32x4 a0 = *(const f32x4*)(sc2 + c0), a1 = *(const f32x4*)(sc2 + c0 + 4), b0 = *(const f32x4*)(sh2 + c0), b1 = *(const f32x4*)(sh2 + c0 + 4);
            const f32x4 y0 = x0 * (a0 + 1.0f) + b0, y1 = x1 * (a1 + 1.0f) + b1;
            u32x4 hi; hi.x = cvt_pk_bf16(y0[0], y0[1]); hi.y = cvt_pk_bf16(y0[2], y0[3]); hi.z = cvt_pk_bf16(y1[0], y1[1]); hi.w = cvt_pk_bf16(y1[2], y1[3]);
            u32x4 lo; lo.x = cvt_pk_bf16(y0[0] - bflo(hi.x), y0[1] - bfhi(hi.x)); lo.y = cvt_pk_bf16(y0[2] - bflo(hi.y), y0[3] - bfhi(hi.y));
            lo.z = cvt_pk_bf16(y1[0] - bflo(hi.z), y1[1] - bfhi(hi.z)); lo.w = cvt_pk_bf16(y1[2] - bflo(hi.w), y1[3] - bfhi(hi.w));
            const bf16x8 ah = __builtin_bit_cast(bf16x8, hi), al = __builtin_bit_cast(bf16x8, lo);
#pragma unroll
            for (int t = 0; t < 4; ++t) { const bf16x8 bh = frag_rowk_g(RWh + (size_t)(16 * t) * DM + 32 * ks, DM, lane), bl = frag_rowk_g(RWl + (size_t)(16 * t) * DM + 32 * ks, DM, lane);
                acc[t] = MFMA16(ah, bh, acc[t]); acc[t] = MFMA16(al, bh, acc[t]); acc[t] = MFMA16(ah, bl, acc[t]); } }
        LDS_WAIT(); asm volatile("" ::: "memory");
#pragma unroll
        for (int t = 0; t < 4; ++t)
#pragma unroll
            for (int r = 0; r < 4; ++r) Lg[(4 * kq + r) * 65 + 16 * t + fr] = acc[t][r];
        LDS_WAIT(); asm volatile("" ::: "memory");
        if (lane < 16) {
            LAS float* sr = Lg + lane * 65; const int trow = rbase + lane;
            float gs[8];
#pragma unroll
            for (int g = 0; g < 8; ++g) { float m1 = -1e30f, m2 = -1e30f;
                for (int j = 0; j < 8; ++j) { const int e = 8 * g + j; const float s = sigmoidf_(sr[e]); sr[e] = s; const float vv = s + rbias[e];
                    if (vv > m1) { m2 = m1; m1 = vv; } else if (vv > m2) m2 = vv; }
                gs[g] = m1 + m2; }
            unsigned gmask = 0u;
#pragma unroll
            for (int it = 0; it < 4; ++it) { float best = -1e30f; int bi = 0;
#pragma unroll
                for (int g = 0; g < 8; ++g) { const bool ok = !((gmask >> g) & 1u) && gs[g] > best; best = ok ? gs[g] : best; bi = ok ? g : bi; }
                gmask |= 1u << bi; }
            unsigned long long taken = 0ull; int sel[8]; float sw[8]; float wsum = 0.f;
#pragma unroll
            for (int k = 0; k < 8; ++k) { float best = -1e30f; int bi = 0;
                for (int e = 0; e < 64; ++e) { const bool cand = ((gmask >> (e >> 3)) & 1u) && !((taken >> e) & 1ull); const float vv = sr[e] + rbias[e];
                    if (cand && vv > best) { best = vv; bi = e; } }
                taken |= 1ull << bi; sel[k] = bi; sw[k] = sr[bi]; wsum += sw[k]; }
            const float inv = 2.5f / wsum;
#pragma unroll
            for (int k = 0; k < 8; ++k) { const int a = trow * 8 + k; const int pos = atomicAdd(&cnt[sel[k]], 1);
                LIST[(size_t)sel[k] * TT + pos] = a; PK[a] = ((unsigned)sel[k] << 16) | (unsigned)pos; LW[(size_t)sel[k] * TT + pos] = sw[k] * inv; }
            LIST[(size_t)64 * TT + (trow - r0)] = 8 * TT + trow; LW[(size_t)64 * TT + (trow - r0)] = 1.0f;
        }
    }
}
namespace att {
constexpr int D = 128, NW = 8, QBLK = 32, KVBLK = 64;
constexpr float SCALE = 0.088388347648318440f;
constexpr float THR = 8.f;
constexpr int SHM_V = KVBLK * D * 2, SHM_K = KVBLK * D * 2, SHM_ATTN = 2 * SHM_V + 2 * SHM_K + NW * 64 * 4;
#define KSWZ(row, colB) ((row) * 256 + ((colB) ^ (((row) & 7) << 4)))
#define SBAR() __builtin_amdgcn_sched_barrier(0)
__device__ __forceinline__ int crow(int r, int hi) { return (r & 3) + 8 * (r >> 2) + 4 * hi; }
__device__ __forceinline__ unsigned cvtpk(float lo, float hi) { unsigned r; asm volatile("v_cvt_pk_bf16_f32 %0, %1, %2" : "=v"(r) : "v"(lo), "v"(hi)); return r; }

__device__ __forceinline__ void partialSM(f32x16& p0, f32x16& p1, float negMC) {
  constexpr float Cc = SCALE * 1.4426950408889634f;
  for (int r = 0; r < 16; ++r) p0[r] = fmaf(p0[r], Cc, negMC); for (int r = 0; r < 16; ++r) p1[r] = fmaf(p1[r], Cc, negMC);
  for (int r = 0; r < 16; ++r) p0[r] = __builtin_amdgcn_exp2f(p0[r]);
}
__device__ __forceinline__ void finishSM(f32x16& p0, f32x16& p1, float& l_reg, bf16x8& pa0, bf16x8& pa1, bf16x8& pa2, bf16x8& pa3) {
  for (int r = 0; r < 16; ++r) p1[r] = __builtin_amdgcn_exp2f(p1[r]);
  float ps = 0; for (int r = 0; r < 16; ++r) ps += p0[r]; for (int r = 0; r < 16; ++r) ps += p1[r];
  { auto rr = __builtin_amdgcn_permlane32_swap(__float_as_uint(ps), __float_as_uint(ps), false, false);
    ps = __uint_as_float(rr[0]) + __uint_as_float(rr[1]); }
  l_reg += ps;
#define PK4(P, BASE, OUT) do { unsigned a0 = cvtpk(P[BASE + 0], P[BASE + 1]), a1 = cvtpk(P[BASE + 2], P[BASE + 3]);   \
    unsigned b0 = cvtpk(P[BASE + 4], P[BASE + 5]), b1 = cvtpk(P[BASE + 6], P[BASE + 7]);                              \
    auto r0 = __builtin_amdgcn_permlane32_swap(a0, b0, false, false); auto r1 = __builtin_amdgcn_permlane32_swap(a1, b1, false, false); \
    u32x4 w = {r0[0], r1[0], r0[1], r1[1]}; OUT = *reinterpret_cast<bf16x8*>(&w); } while (0)
  PK4(p0, 0, pa0); PK4(p0, 8, pa1); PK4(p1, 0, pa2); PK4(p1, 8, pa3);
#undef PK4
}
__device__ __forceinline__ void qkt(f32x16& p0, f32x16& p1, const LAS char* Ks, const bf16x8* qr, int r32, int hi) {
  p0 = f32x16{}; p1 = f32x16{};
  for (int d0 = 0; d0 < 8; ++d0) { int cb = (d0 * 16 + hi * 8) * 2;
    bf16x8 b0 = *reinterpret_cast<const LAS bf16x8*>(Ks + KSWZ(r32, cb));
    bf16x8 b1 = *reinterpret_cast<const LAS bf16x8*>(Ks + KSWZ(32 + r32, cb));
    p0 = __builtin_amdgcn_mfma_f32_32x32x16_bf16(b0, qr[d0], p0, 0, 0, 0);
    p1 = __builtin_amdgcn_mfma_f32_32x32x16_bf16(b1, qr[d0], p1, 0, 0, 0); }
}
__device__ __forceinline__ int v_st(int k, int c) { const int kk = (k & ~0xC) | ((k & 4) << 1) | ((k & 8) >> 1); return ((kk >> 3) * 4 + (c >> 5)) * 512 + ((kk & 7) * 32 + (c & 31)) * 2; }
__device__ __forceinline__ int v_rd_base(int lane) { return ((lane & 3) << 3) | (((lane >> 2) & 3) << 6) | (((lane >> 4) & 1) << 5) | (((lane >> 5) & 1) << 8); }
constexpr int v_rd_off(int d0, int ks, int half) { return d0 * 512 + ks * 4096 + half * 2048; }
template <int OFF> __device__ __forceinline__ s16x4 tr_read(int vb) {
  s16x4 r; asm volatile("ds_read_b64_tr_b16 %0, %1 offset:%2" : "=&v"(r) : "v"(vb), "i"(OFF) : "memory"); return r;
}
template <int D0> __device__ __forceinline__ void pv_one(f32x16& od, int vb, bf16x8 pa0, bf16x8 pa1, bf16x8 pa2, bf16x8 pa3) {
  const s16x4 l0 = tr_read<v_rd_off(D0, 0, 0)>(vb), h0 = tr_read<v_rd_off(D0, 0, 1)>(vb), l1 = tr_read<v_rd_off(D0, 1, 0)>(vb), h1 = tr_read<v_rd_off(D0, 1, 1)>(vb);
  const s16x4 l2 = tr_read<v_rd_off(D0, 2, 0)>(vb), h2 = tr_read<v_rd_off(D0, 2, 1)>(vb), l3 = tr_read<v_rd_off(D0, 3, 0)>(vb), h3 = tr_read<v_rd_off(D0, 3, 1)>(vb);
  asm volatile("s_waitcnt lgkmcnt(0)" ::: "memory"); SBAR();
#define PK(L, H) (bf16x8){L[0], L[1], L[2], L[3], H[0], H[1], H[2], H[3]}
  od = __builtin_amdgcn_mfma_f32_32x32x16_bf16(pa0, PK(l0, h0), od, 0, 0, 0);
  od = __builtin_amdgcn_mfma_f32_32x32x16_bf16(pa1, PK(l1, h1), od, 0, 0, 0);
  od = __builtin_amdgcn_mfma_f32_32x32x16_bf16(pa2, PK(l2, h2), od, 0, 0, 0);
  od = __builtin_amdgcn_mfma_f32_32x32x16_bf16(pa3, PK(l3, h3), od, 0, 0, 0);
#undef PK
}
__device__ __forceinline__ void pv_d0(f32x16* o, int vb, bf16x8 pa0, bf16x8 pa1, bf16x8 pa2, bf16x8 pa3) {
  pv_one<0>(o[0], vb, pa0, pa1, pa2, pa3); pv_one<1>(o[1], vb, pa0, pa1, pa2, pa3); pv_one<2>(o[2], vb, pa0, pa1, pa2, pa3); pv_one<3>(o[3], vb, pa0, pa1, pa2, pa3);
}

template <int LDQ, int LDK, int LDO>
__device__ __forceinline__ void attn_dense_body(const bf16_t* __restrict__ Qb, const bf16_t* __restrict__ Kh, const bf16_t* __restrict__ Vh, bf16_t* __restrict__ Ob, int seq, LAS char* lds, int tid, float kmax2) {
  const int wid = tid >> 6, lane = tid & 63, r32 = lane & 31, hi = lane >> 5;
  LAS char* V_lds = lds; LAS char* K_lds = lds + 2 * SHM_V;
  LAS float* ws = (LAS float*)(lds + 2 * SHM_V + 2 * SHM_K) + wid * 64; LAS float* li_l = ws;
  float l_reg = 0; f32x16 o[4] = {}; bf16x8 qr[8];
  const bf16_t* Qw = Qb + (long)(wid * QBLK + r32) * LDQ + hi * 8;
#pragma unroll
  for (int d0 = 0; d0 < 8; ++d0) qr[d0] = *reinterpret_cast<const bf16x8*>(Qw + d0 * 16);
  float negMC;
  { float q2 = 0.f;
#pragma unroll
    for (int d0 = 0; d0 < 8; ++d0) { const u32x4 w = __builtin_bit_cast(u32x4, qr[d0]);
      q2 += bflo(w.x) * bflo(w.x) + bfhi(w.x) * bfhi(w.x) + bflo(w.y) * bflo(w.y) + bfhi(w.y) * bfhi(w.y) + bflo(w.z) * bflo(w.z) + bfhi(w.z) * bfhi(w.z) + bflo(w.w) * bflo(w.w) + bfhi(w.w) * bfhi(w.w); }
    auto rr = __builtin_amdgcn_permlane32_swap(__float_as_uint(q2), __float_as_uint(q2), false, false);
    q2 = __uint_as_float(rr[0]) + __uint_as_float(rr[1]);
    negMC = -(sqrtf(q2 * kmax2) * (SCALE * 1.0001f) - 30.0f) * 1.4426950408889634f; }
  const int sr = tid >> 4, sc = (tid & 15) * 8, vst0 = v_st(sr, sc), vst1 = v_st(32 + sr, sc);
  const int vb0 = (int)(uintptr_t)V_lds + v_rd_base(lane);
  struct { bf16x8 vs0, vs1, ks0, ks1; } sr_[2];
#define SLOAD(i, k0) do { sr_[i].vs0 = *reinterpret_cast<const bf16x8*>(&Vh[(long)((k0) + sr) * LDK + sc]); sr_[i].vs1 = *reinterpret_cast<const bf16x8*>(&Vh[(long)((k0) + 32 + sr) * LDK + sc]); \
    sr_[i].ks0 = *reinterpret_cast<const bf16x8*>(&Kh[(long)((k0) + sr) * LDK + sc]); sr_[i].ks1 = *reinterpret_cast<const bf16x8*>(&Kh[(long)((k0) + 32 + sr) * LDK + sc]); } while (0)
#define SWRITE(b, i) do { *(LAS bf16x8*)(V_lds + (b) * SHM_V + vst0) = sr_[i].vs0;          \
    *(LAS bf16x8*)(V_lds + (b) * SHM_V + vst1) = sr_[i].vs1; int kc = sc * 2;               \
    *(LAS bf16x8*)(K_lds + (b) * SHM_K + KSWZ(sr, kc)) = sr_[i].ks0;                       \
    *(LAS bf16x8*)(K_lds + (b) * SHM_K + KSWZ(32 + sr, kc)) = sr_[i].ks1; } while (0)
#define SWAIT() asm volatile("s_waitcnt vmcnt(4)" ::: "memory")
  f32x16 pA0, pA1, pB0, pB1; bf16x8 pa0, pa1, pa2, pa3; const int NT = seq / KVBLK;
  constexpr int SE = 0, SO = 1;
  SLOAD(SE, 0); asm volatile("s_waitcnt vmcnt(0)" ::: "memory"); SWRITE(0, SE); __syncthreads();
  qkt(pA0, pA1, K_lds, qr, r32, hi); partialSM(pA0, pA1, negMC);
  SLOAD(SO, KVBLK); if (2 < NT) SLOAD(SE, 2 * KVBLK);
  SWAIT(); SWRITE(1, SO); __syncthreads();
  for (int j = 1; j + 1 < NT; j += 2) {
    SBAR(); qkt(pB0, pB1, K_lds + SHM_K, qr, r32, hi);
    finishSM(pA0, pA1, l_reg, pa0, pa1, pa2, pa3); SBAR();
    SLOAD(SO, (j + 2) * KVBLK); SBAR();
    pv_d0(o, vb0, pa0, pa1, pa2, pa3); partialSM(pB0, pB1, negMC);
    __syncthreads(); SWAIT(); SWRITE(0, SE);
    __syncthreads();
    SBAR(); qkt(pA0, pA1, K_lds, qr, r32, hi);
    finishSM(pB0, pB1, l_reg, pa0, pa1, pa2, pa3); SBAR();
    if (j + 3 < NT) SLOAD(SE, (j + 3) * KVBLK); SBAR();
    pv_d0(o, vb0 + (int)SHM_V, pa0, pa1, pa2, pa3); partialSM(pA0, pA1, negMC);
    __syncthreads(); SWAIT(); SWRITE(1, SO);
    __syncthreads();
  }
  SBAR(); qkt(pB0, pB1, K_lds + SHM_K, qr, r32, hi);
  finishSM(pA0, pA1, l_reg, pa0, pa1, pa2, pa3); SBAR();
  pv_d0(o, vb0, pa0, pa1, pa2, pa3); partialSM(pB0, pB1, negMC);
  __syncthreads();
  finishSM(pB0, pB1, l_reg, pa0, pa1, pa2, pa3); SBAR();
  pv_d0(o, vb0 + (int)SHM_V, pa0, pa1, pa2, pa3);
  if (hi == 0) li_l[r32] = l_reg; asm volatile("s_waitcnt lgkmcnt(0)" ::: "memory");
  float rli[16];
#pragma unroll
  for (int r = 0; r < 16; ++r) rli[r] = __builtin_amdgcn_rcpf(li_l[crow(r, hi)]);
  bf16_t* Ow = Ob + (long)(wid * QBLK) * LDO;
#pragma unroll
  for (int r = 0; r < 16; ++r) { int orow = crow(r, hi);
    for (int d0 = 0; d0 < 4; ++d0) Ow[(long)orow * LDO + d0 * 32 + r32] = (bf16_t)(cvtpk(o[d0][r] * rli[r], 0.f) & 0xffffu); }
#undef SLOAD
#undef SWRITE
#undef SWAIT
}

typedef int v8i32a __attribute__((ext_vector_type(8)));
typedef int v4i32a __attribute__((ext_vector_type(4)));
#define KSW8(row, chunk) ((row) * 128 + ((((chunk) ^ ((row) & 7))) << 4))
#define VSW8(d, chunk) ((d) * 64 + ((((chunk) ^ (((d) >> 2) & 3))) << 4))
#define MFMA8(a, b, c) __builtin_amdgcn_mfma_scale_f32_32x32x64_f8f6f4((a), (b), (c), 0, 0, 0, 0, 0, 0)
__device__ __forceinline__ v8i32a ld32_l(const LAS char* p0, const LAS char* p1) { return __builtin_shufflevector(*(const LAS v4i32a*)p0, *(const LAS v4i32a*)p1, 0, 1, 2, 3, 4, 5, 6, 7); }
__device__ __forceinline__ unsigned pk4f8(float a, float b, float c, float d) { unsigned w = (unsigned)__builtin_amdgcn_cvt_pk_fp8_f32(a, b, 0, false); return (unsigned)__builtin_amdgcn_cvt_pk_fp8_f32(c, d, (int)w, true); }
template <int LDO, int KSTR>
__device__ __forceinline__ void attn_dense8_body(const unsigned char* __restrict__ Q8b, const unsigned char* __restrict__ K8h, const unsigned char* __restrict__ VT8h, bf16_t* __restrict__ Ob, int seq, LAS char* lds, int tid, float kmax2) {
  const int wid = tid >> 6, lane = tid & 63, r32 = lane & 31, hi = lane >> 5;
  LAS char* K_lds = lds; LAS char* V_lds = lds + 16384;
  LAS float* li_l = (LAS float*)(lds + 32768) + wid * 32; LAS float* al_l = (LAS float*)(lds + 32768 + 1024) + wid * 32;
  float l_reg = 0, m_reg = -1e30f; f32x16 o[4] = {}; v8i32a qf[2];
  { const unsigned char* qp = Q8b + (size_t)(wid * QBLK + r32) * 1024 + 32 * hi;
    qf[0] = __builtin_shufflevector(*(const v4i32a*)qp, *(const v4i32a*)(qp + 16), 0, 1, 2, 3, 4, 5, 6, 7);
    qf[1] = __builtin_shufflevector(*(const v4i32a*)(qp + 64), *(const v4i32a*)(qp + 80), 0, 1, 2, 3, 4, 5, 6, 7); }
  (void)kmax2;
  constexpr float THR8 = 1.0f, Cc = SCALE * 1.4426950408889634f;
#define PSM8(P0, P1, AL) do { float pmax = P0[0]; for (int r = 1; r < 16; ++r) pmax = fmaxf(pmax, P0[r]); for (int r = 0; r < 16; ++r) pmax = fmaxf(pmax, P1[r]); \
      { auto rr = __builtin_amdgcn_permlane32_swap(__float_as_uint(pmax), __float_as_uint(pmax), false, false); pmax = fmaxf(__uint_as_float(rr[0]), __uint_as_float(rr[1])); } \
      float mn; if (__builtin_expect(__all(pmax - m_reg <= THR8 / SCALE), 1)) { mn = m_reg; AL = 1.f; } \
      else { mn = fmaxf(m_reg, pmax); AL = __builtin_amdgcn_exp2f((m_reg - mn) * Cc); m_reg = mn; } \
      const float mnC = 7.0f - mn * Cc; \
      for (int r = 0; r < 16; ++r) P0[r] = fmaf(P0[r], Cc, mnC); for (int r = 0; r < 16; ++r) P1[r] = fmaf(P1[r], Cc, mnC); \
      for (int r = 0; r < 16; ++r) P0[r] = __builtin_amdgcn_exp2f(P0[r]); } while (0)
#define RESC8(a) do { if (__any((a) < 1.f)) { if (hi == 0) al_l[r32] = (a); asm volatile("s_waitcnt lgkmcnt(0)" ::: "memory"); \
      for (int d = 0; d < 4; ++d) for (int r = 0; r < 16; ++r) o[d][r] *= al_l[crow(r, hi)]; } } while (0)
  const int krow = tid >> 3, kch = tid & 7, vd = tid >> 2, vch = tid & 3;
  const int kst = KSW8(krow, kch), vst = VSW8(vd, vch);
  struct { v4i32a k, v; } sr_[2];
#define SLOAD8(i, T_) do { sr_[i].k = *(const v4i32a*)(K8h + (size_t)(64 * (T_) + krow) * KSTR + 16 * kch); sr_[i].v = *(const v4i32a*)(VT8h + (size_t)(T_) * 8192 + 16 * tid); } while (0)
#define SWRITE8(b, i) do { *(LAS v4i32a*)(K_lds + (b) * 8192 + kst) = sr_[i].k; *(LAS v4i32a*)(V_lds + (b) * 8192 + vst) = sr_[i].v; } while (0)
#define QK8(P0, P1, KB) do { P0 = f32x16{}; P1 = f32x16{}; _Pragma("unroll") for (int s = 0; s < 2; ++s) { \
      const v8i32a k0 = ld32_l((KB) + KSW8(r32, 4 * s + 2 * hi), (KB) + KSW8(r32, 4 * s + 2 * hi + 1)); \
      const v8i32a k1 = ld32_l((KB) + KSW8(32 + r32, 4 * s + 2 * hi), (KB) + KSW8(32 + r32, 4 * s + 2 * hi + 1)); \
      P0 = MFMA8(k0, qf[s], P0); P1 = MFMA8(k1, qf[s], P1); } } while (0)
#define FIN8(P0, P1, AL) do { for (int r = 0; r < 16; ++r) P1[r] = __builtin_amdgcn_exp2f(P1[r]); \
      float ps = 0; for (int r = 0; r < 16; ++r) ps += P0[r]; for (int r = 0; r < 16; ++r) ps += P1[r]; \
      { auto rr = __builtin_amdgcn_permlane32_swap(__float_as_uint(ps), __float_as_uint(ps), false, false); ps = __uint_as_float(rr[0]) + __uint_as_float(rr[1]); } \
      l_reg = l_reg * (AL) + ps; \
      _Pragma("unroll") for (int i = 0; i < 4; ++i) { pa[i] = (int)pk4f8(P0[4 * i], P0[4 * i + 1], P0[4 * i + 2], P0[4 * i + 3]); pa[4 + i] = (int)pk4f8(P1[4 * i], P1[4 * i + 1], P1[4 * i + 2], P1[4 * i + 3]); } } while (0)
#define PV8(VB) do { _Pragma("unroll") for (int d0 = 0; d0 < 4; ++d0) { \
      const v8i32a vf = ld32_l((VB) + VSW8(32 * d0 + r32, 2 * hi), (VB) + VSW8(32 * d0 + r32, 2 * hi + 1)); \
      o[d0] = MFMA8(pa, vf, o[d0]); } } while (0)
  f32x16 pA0, pA1, pB0, pB1; v8i32a pa; float alA, alB; const int NT = seq / KVBLK;
  SLOAD8(0, 0); asm volatile("s_waitcnt vmcnt(0)" ::: "memory"); SWRITE8(0, 0); __syncthreads();
  QK8(pA0, pA1, K_lds); PSM8(pA0, pA1, alA);
  SLOAD8(1, 1); if (2 < NT) SLOAD8(0, 2);
  asm volatile("s_waitcnt vmcnt(2)" ::: "memory"); SWRITE8(1, 1); __syncthreads();
  for (int j = 1; j + 1 < NT; j += 2) {
    SBAR(); QK8(pB0, pB1, K_lds + 8192);
    FIN8(pA0, pA1, alA); SBAR();
    SLOAD8(1, j + 2); SBAR();
    PV8(V_lds); PSM8(pB0, pB1, alB);
    __syncthreads(); asm volatile("s_waitcnt vmcnt(2)" ::: "memory"); SWRITE8(0, 0);
    RESC8(alB); __syncthreads();
    SBAR(); QK8(pA0, pA1, K_lds);
    FIN8(pB0, pB1, alB); SBAR();
    if (j + 3 < NT) SLOAD8(0, j + 3); SBAR();
    PV8(V_lds + 8192); PSM8(pA0, pA1, alA);
    __syncthreads(); asm volatile("s_waitcnt vmcnt(2)" ::: "memory"); SWRITE8(1, 1);
    RESC8(alA); __syncthreads();
  }
  SBAR(); QK8(pB0, pB1, K_lds + 8192);
  FIN8(pA0, pA1, alA); SBAR();
  PV8(V_lds); PSM8(pB0, pB1, alB);
  __syncthreads(); RESC8(alB);
  FIN8(pB0, pB1, alB); SBAR();
  PV8(V_lds + 8192);
  if (hi == 0) li_l[r32] = l_reg; asm volatile("s_waitcnt lgkmcnt(0)" ::: "memory");
  float rli[16];
#pragma unroll
  for (int r = 0; r < 16; ++r) rli[r] = __builtin_amdgcn_rcpf(li_l[crow(r, hi)]);
  bf16_t* Ow = Ob + (long)(wid * QBLK) * LDO;
#pragma unroll
  for (int r = 0; r < 16; ++r) { int orow = crow(r, hi);
    for (int d0 = 0; d0 < 4; ++d0) Ow[(long)orow * LDO + d0 * 32 + r32] = (bf16_t)(cvtpk(o[d0][r] * rli[r], 0.f) & 0xffffu); }
#undef PSM8
#undef RESC8
#undef SLOAD8
#undef SWRITE8
#undef QK8
#undef FIN8
#undef PV8
}

constexpr int PV_BUF = 32768, PK_BUF = 16384, P_LDS_V = 0, P_LDS_K = 2 * PV_BUF, P_LDS_X = P_LDS_K + 2 * PK_BUF, P_LDS_L = P_LDS_X + 8 * 2048, P_LDS_END = P_LDS_L + 1024;
__device__ __forceinline__ void qkt_half(f32x16& p, const LAS char* Ks, const bf16x8* qr, int krow, int hi) {
  p = f32x16{};
  for (int d0 = 0; d0 < 8; ++d0) { int cb = (d0 * 16 + hi * 8) * 2;
    bf16x8 b0 = *reinterpret_cast<const LAS bf16x8*>(Ks + KSWZ(krow, cb));
    p = __builtin_amdgcn_mfma_f32_32x32x16_bf16(b0, qr[d0], p, 0, 0, 0); }
}
__device__ __forceinline__ void smA(f32x16& p, float negMC) {
  constexpr float Cc = SCALE * 1.4426950408889634f;
  for (int r = 0; r < 16; ++r) p[r] = fmaf(p[r], Cc, negMC);
  for (int r = 0; r < 8; ++r) p[r] = __builtin_amdgcn_exp2f(p[r]);
}
__device__ __forceinline__ void smB(f32x16& p, float& l_reg, bf16x8& f0, bf16x8& f1) {
  for (int r = 8; r < 16; ++r) p[r] = __builtin_amdgcn_exp2f(p[r]);
  float ps = 0; for (int r = 0; r < 16; ++r) ps += p[r];
  { auto rr = __builtin_amdgcn_permlane32_swap(__float_as_uint(ps), __float_as_uint(ps), false, false);
    ps = __uint_as_float(rr[0]) + __uint_as_float(rr[1]); }
  l_reg += ps;
#define PK4(P, BASE, OUT) do { unsigned a0 = cvtpk(P[BASE + 0], P[BASE + 1]), a1 = cvtpk(P[BASE + 2], P[BASE + 3]);   \
    unsigned b0 = cvtpk(P[BASE + 4], P[BASE + 5]), b1 = cvtpk(P[BASE + 6], P[BASE + 7]);                              \
    auto r0 = __builtin_amdgcn_permlane32_swap(a0, b0, false, false); auto r1 = __builtin_amdgcn_permlane32_swap(a1, b1, false, false); \
    u32x4 w = {r0[0], r1[0], r0[1], r1[1]}; OUT = *reinterpret_cast<bf16x8*>(&w); } while (0)
  PK4(p, 0, f0); PK4(p, 8, f1);
#undef PK4
}
template <int LDQ, int LDK, int LDO>
__device__ __forceinline__ void attn_pair_body(const bf16_t* __restrict__ Qb, const bf16_t* __restrict__ Kh, const bf16_t* __restrict__ Vh, bf16_t* __restrict__ Ob, int seq, LAS char* lds, int tid, float kmax2) {
  const int wid = __builtin_amdgcn_readfirstlane(tid >> 6), lane = tid & 63, r32 = lane & 31, hi = lane >> 5, g = wid & 3, kb = wid >> 2;
  LAS char* V_lds = lds + P_LDS_V; LAS char* K_lds = lds + P_LDS_K;
  LAS char* xp_own = lds + P_LDS_X + wid * 2048 + lane * 16; LAS char* xp_par = lds + P_LDS_X + (wid ^ 4) * 2048 + lane * 16;
  LAS float* li = (LAS float*)(lds + P_LDS_L);
  float l_reg = 0; f32x16 o[4] = {}; bf16x8 qr[8];
  const bf16_t* Qw = Qb + (long)(g * QBLK + r32) * LDQ + hi * 8;
#pragma unroll
  for (int d0 = 0; d0 < 8; ++d0) qr[d0] = *reinterpret_cast<const bf16x8*>(Qw + d0 * 16);
  float negMC;
  { float q2 = 0.f;
#pragma unroll
    for (int d0 = 0; d0 < 8; ++d0) { const u32x4 w = __builtin_bit_cast(u32x4, qr[d0]);
      q2 += bflo(w.x) * bflo(w.x) + bfhi(w.x) * bfhi(w.x) + bflo(w.y) * bflo(w.y) + bfhi(w.y) * bfhi(w.y) + bflo(w.z) * bflo(w.z) + bfhi(w.z) * bfhi(w.z) + bflo(w.w) * bflo(w.w) + bfhi(w.w) * bfhi(w.w); }
    auto rr = __builtin_amdgcn_permlane32_swap(__float_as_uint(q2), __float_as_uint(q2), false, false);
    q2 = __uint_as_float(rr[0]) + __uint_as_float(rr[1]);
    negMC = -(sqrtf(q2 * kmax2) * (SCALE * 1.0001f) - 30.0f) * 1.4426950408889634f; }
  const int sr = tid >> 4, sc = (tid & 15) * 8, vst0 = v_st(sr, sc), vst1 = v_st(32 + sr, sc);
  const int vrd = (int)(uintptr_t)V_lds + kb * 16384 + v_rd_base(lane);
  const int krow = 32 * kb + r32;
  struct { bf16x8 v00, v01, v10, v11, k0, k1; } st_;
#define PLD16(base, off) (*reinterpret_cast<const bf16x8*>((const char*)(base) + (off)))
#define PLOAD(k0_) do { const unsigned o_ = (unsigned)(((k0_) + sr) * LDK + sc) * 2u; \
    st_.v00 = PLD16(Vh, o_); st_.v01 = PLD16(Vh, o_ + 256u); st_.v10 = PLD16(Vh, o_ + 64u * LDK); st_.v11 = PLD16(Vh, o_ + 64u * LDK + 256u); \
    st_.k0 = PLD16(Kh, o_); st_.k1 = PLD16(Kh, o_ + 64u * LDK); } while (0)
#define PWRITE(kbuf, vbuf) do { LAS char* vb_ = V_lds + (vbuf) * PV_BUF; LAS char* kb_ = K_lds + (kbuf) * PK_BUF; const int kc = sc * 2; \
    *(LAS bf16x8*)(vb_ + vst0) = st_.v00; *(LAS bf16x8*)(vb_ + 16384 + vst0) = st_.v01; *(LAS bf16x8*)(vb_ + vst1) = st_.v10; *(LAS bf16x8*)(vb_ + 16384 + vst1) = st_.v11; \
    *(LAS bf16x8*)(kb_ + KSWZ(sr, kc)) = st_.k0; *(LAS bf16x8*)(kb_ + KSWZ(32 + sr, kc)) = st_.k1; } while (0)
  const int NT = seq / KVBLK;
  f32x16 pS; bf16x8 f0, f1, g0, g1;
  PLOAD(0); asm volatile("s_waitcnt vmcnt(0)" ::: "memory"); PWRITE(0, 0); PLOAD(KVBLK);
  __syncthreads();
  for (int j = 0; j < NT; ++j) {
    SBAR();
    qkt_half(pS, K_lds + (j & 1) * PK_BUF, qr, krow, hi);
    smA(pS, negMC); smB(pS, l_reg, f0, f1); SBAR();
    *(LAS bf16x8*)(xp_own) = f0; *(LAS bf16x8*)(xp_own + 1024) = f1;
    if (j + 1 < NT) PWRITE((j + 1) & 1, (j + 1) & 1);
    if (j + 2 < NT) PLOAD((j + 2) * KVBLK);
    __syncthreads();
    g0 = *(const LAS bf16x8*)(xp_par); g1 = *(const LAS bf16x8*)(xp_par + 1024);
    { const int vb = vrd + (j & 1) * PV_BUF;
      if (kb == 0) pv_d0(o, vb, f0, f1, g0, g1); else pv_d0(o, vb, g0, g1, f0, f1); }
    __syncthreads();
  }
  if (hi == 0) li[wid * 32 + r32] = l_reg;
  __syncthreads();
#pragma unroll
  for (int r = 0; r < 16; ++r) { const int orow = crow(r, hi); const float rl = __builtin_amdgcn_rcpf(li[wid * 32 + orow] + li[(wid ^ 4) * 32 + orow]);
    bf16_t* op = Ob + (long)(g * QBLK + orow) * LDO + 128 * kb + r32;
    for (int d0 = 0; d0 < 4; ++d0) op[d0 * 32] = (bf16_t)(cvtpk(o[d0][r] * rl, 0.f) & 0xffffu); }
#undef PLD16
#undef PLOAD
#undef PWRITE
}
#undef KSWZ
}

__device__ __forceinline__ void phase_attention(const Params& p, Ctx& C) {
    bf16_t* ATT = (bf16_t*)(p.ws + WS_BIG + BG_ATT);
    const unsigned char* Q8 = (const unsigned char*)(p.ws + WS_BIG + BG_Q8); const unsigned char* K8 = (const unsigned char*)(p.ws + WS_BIG + BG_K8); const unsigned char* VT8 = (const unsigned char*)(p.ws + WS_BIG + BG_VT8);
    const unsigned char* Q8D = (const unsigned char*)(p.ws + WS_BIG + BG_Q8D); const unsigned char* K8D = (const unsigned char*)(p.ws + WS_BIG + BG_K8D); const unsigned char* VT8D = (const unsigned char*)(p.ws + WS_BIG + BG_VT8D);
    const int nunits = 24 * 64;
    for (int i = 0;; ++i) {
        int unit;
        if (C.G == 256) { const int xcd = C.bid & 7, slot = C.bid >> 3; if (i >= 6) break; unit = (xcd * 3 + (i >> 1)) * 64 + (i & 1) * 32 + slot; }
        else { unit = i * C.G + C.bid; if (unit >= nunits) break; }
        const int prob = unit >> 6, qb = unit & 63;
        __syncthreads();
        int tz = C.tid; asm volatile("" : "+v"(tz));
        if (prob < 8) {
            att::attn_dense8_body<3072, 256>(Q8 + (size_t)(CTXL + 256 * qb) * 1024 + 128 * prob, K8 + 128 * (prob >> 2), VT8 + (size_t)(prob >> 2) * 260 * 8192,
                                             ATT + (size_t)(256 * qb) * 3072 + 128 * prob, TT, (LAS char*)C.lds, tz, 0.f);
        } else {
            const int d = prob - 8, hh = d >> 2, m = (d >> 1) & 1, vh = d & 1;
            att::attn_dense8_body<3072, 1024>(Q8D + (size_t)(CTXL + 256 * qb) * 1024 + 128 * (2 * hh + m), K8D + 128 * (2 * hh + m), VT8D + (size_t)(2 * hh + vh) * 260 * 8192,
                                              ATT + (size_t)(256 * qb) * 3072 + 1024 + 1024 * m + 256 * hh + 128 * vh, TT, (LAS char*)C.lds, tz, 0.f);
        }
    }
    __syncthreads();
}
constexpr int PH_PER_LAYER = 13, N_PHASES = 2 + 2 * PH_PER_LAYER;
#ifndef DBL_PHASE
#define DBL_PHASE -1
#endif
#ifndef MK_PER_PHASE
#define MK_PER_PHASE 0
#endif

template <int L>
__device__ __forceinline__ void layer_body(const Params& p, Ctx& C0, const XcdBarrier& bar, LAS unsigned char* misc, int lo, int hi) {
#define IN(k) (lo <= (k) && (k) < hi)
#define SEAM(k) do { if (IN(k) && IN((k) + 1)) xcd_barrier(bar, C0.wave); } while (0)
#define PHASE(k, ...) if (IN(k)) { FRESH(); __VA_ARGS__ } if (DBL_PHASE == (k)) { xcd_barrier(bar, C0.wave); { FRESH(); __VA_ARGS__ } } SEAM(k);
#define FRESH() Ctx C = C0; { int ln = (int)__builtin_amdgcn_mbcnt_hi(~0u, __builtin_amdgcn_mbcnt_lo(~0u, 0u)); asm volatile("" : "+v"(ln)); C.lane = ln; C.tid = C.wave * 64 + ln; }
        const int b = 2 + PH_PER_LAYER * L;
        bf16_t* QKV = (bf16_t*)(p.ws + WS_BIG + BG_QKV);
        bf16_t* XA = (bf16_t*)(p.ws + WS_XA);
        int* cnt = (int*)(p.ws + WS_CTL) + CW_CNT + L * 128; const int* LIST = (const int*)(p.ws + WS_LIST);
        PHASE(b + 0, phase_modulate(p, C, L); )
        PHASE(b + 1,
            const int N = L ? OD_IN : EV_IN;
            pg8::DenseOrder S; S.init8((const void*)XA, DM, (const void*)(p.ws + (L ? WS_WIN1 : WS_WIN0)), TT, N, DM, C.G, C.bid);
            pg8::EpiStore E{QKV, N, 1.0f / 32.0f};
            pg8::gemm_phase<true>(C.lds, S, E, C.wave);
            if (L == 0 && IN(b + 2) && S.units_of_me() < S.max_units()) conv_queue(p, C, 2);
        )
        PHASE(b + 2, if (L == 0) phase_rope0(p, C); else phase_normrope1(p, C); )
        PHASE(b + 3, if (L == 0) { ret_chunk_kv(p, C); s5_end_states(p, C); } else phase_attention(p, C); )
        PHASE(b + 4, if (L == 0) phase_scans(p, C); else phase_merge1(p, C); )
        if (L == 0) {
            PHASE(b + 5, phase_ret_s5_outputs(p, C, misc); )
            PHASE(b + 6,
                pg8::DenseOrder S; S.init((const bf16_t*)(p.ws + WS_Z), 1024, (const bf16_t*)(p.ws + WS_WGLU), TT, 1024, 1024, C.G, C.bid);
                pg8::EpiGlu E{(const bf16_t*)(p.ws + WS_Z), p.inp(20), (bf16_t*)(p.ws + WS_BIG + BG_MIX)};
                pg8::gemm_phase<false>(C.lds, S, E, C.wave);
                if (IN(b + 7) && S.units_of_me() < S.max_units()) conv_queue(p, C, 4);
            )
        }
        PHASE(b + 7,
            pg8::DenseOrder S;
            if (L == 0) S.init((const bf16_t*)(p.ws + WS_BIG + BG_MIX), DM, (const bf16_t*)(p.ws + WS_WOUT0), TT, DM, DM, C.G, C.bid);
            else S.init((const bf16_t*)(p.ws + WS_BIG + BG_ATT), 3072, (const bf16_t*)(p.ws + WS_WOUT1), SEQ, DM, DM, C.G, C.bid);
            pg8::EpiStore E{(bf16_t*)(p.ws + WS_YMIX) + (L ? (size_t)CTXL * DM : 0), DM, 1.0f};
            pg8::gemm_phase<false>(C.lds, S, E, C.wave);
            if (L == 0 && IN(b + 8) && S.units_of_me() < S.max_units()) conv_queue(p, C, 5);
        )
        PHASE(b + 8, phase_ln1(p, C, L); )
        PHASE(b + 9, phase_router(p, C, L); )
        PHASE(b + 10,
            pg8::MoeOrder<0> S; S.A = (const void*)XA; S.Bt = (const void*)(p.ws + WS_GU + (size_t)L * NEX1 * 1024 * DM); S.list = LIST; S.cnt = cnt; S.ldab = DM; S.kb = DM; S.nN = 4; S.G = C.G; S.c = C.bid; S.bstride = (size_t)1024 * DM;
            S.prep(misc, C.tid);
            pg8::EpiE1 E{(unsigned char*)(p.ws + WS_HX2), S.cn, S.rb};
            pg8::gemm_phase<true>(C.lds, S, E, C.wave);
        )
        PHASE(b + 11,
            pg8::MoeOrder<1> S; S.A = (const void*)(p.ws + WS_HX2); S.Bt = (const void*)(p.ws + WS_DT + (size_t)L * NEX1 * DM * EHID); S.list = LIST; S.cnt = cnt; S.ldab = EHID; S.kb = EHID; S.nN = 8; S.G = C.G; S.c = C.bid; S.bstride = (size_t)DM * EHID;
            S.prep(misc, C.tid);
            pg8::EpiE2 E{(unsigned char*)(p.ws + WS_BIG + BG_YMOE), (const float*)(p.ws + WS_LW), S.cn, S.rb};
            pg8::gemm_phase<true>(C.lds, S, E, C.wave);
        )
        PHASE(b + 12, phase_combine(p, C, L, misc); )
    #undef IN
#undef SEAM
#undef FRESH
#undef PHASE
}

__global__ void __launch_bounds__(NTHR, 2) mega_fwd(KArgs ka) {
    extern __shared__ __attribute__((aligned(16))) unsigned char lds_raw[];
    Ctx C;
    C.lds = (LAS unsigned char*)lds_raw;
    C.tid = threadIdx.x; C.lane = C.tid & 63; C.wave = __builtin_amdgcn_readfirstlane(C.tid >> 6);
    C.G = gridDim.x; C.bid = blockIdx.x; C.gw = C.bid * NWAVES + C.wave; C.ngw = C.G * NWAVES;
    LAS unsigned char* misc = C.lds + MISC_OFF;
    if (C.tid < 8) ((volatile LAS unsigned*)misc)[C.tid] = 0u;
    Params p; p.out = ka.out; p.ws = ka.ws; p.ph_lo = ka.ph_lo; p.ph_hi = ka.ph_hi; p.ptab = (LAS unsigned long long*)(misc + 1024);
    if (C.tid < 34) p.ptab[C.tid] = (unsigned long long)ka.in[C.tid];
    __syncthreads();
    const int lo = p.ph_lo, hi = p.ph_hi;
    XcdBarrier bar; bar.bar = (unsigned*)(p.ws + WS_CTL) + CW_BAR; bar.x = 0; bar.st = (volatile LAS unsigned*)misc;
    if (hi - lo > 1) bar = xcd_barrier_post((unsigned*)(p.ws + WS_CTL) + CW_BAR, (volatile LAS unsigned*)misc);
#define IN(k) (lo <= (k) && (k) < hi)
#define SEAM(k) do { if (IN(k) && IN((k) + 1)) xcd_barrier(bar, C.wave); } while (0)

    if (IN(0)) { phase_p0(p, C); } SEAM(0);
    if (IN(1)) { phase_p1(p, C); } SEAM(1);
    if (IN(0) && IN(2) && (C.G & 7) == 0) {
        volatile LAS unsigned* st = (volatile LAS unsigned*)misc;
        if (C.tid == 0) { unsigned pre = 0u; const unsigned x = st[3];
            for (unsigned j = 0; j < 16; ++j) { const unsigned cj = xb_ld(&bar.bar[XB_XCNT(j)]); pre += (j < x) ? cj : 0u; }
            st[4] = pre + st[2]; }
        __syncthreads();
        const int vcu = (int)st[4], g8 = C.G >> 3;
        C.bid = __builtin_amdgcn_readfirstlane((vcu % g8) * 8 + vcu / g8); C.gw = C.bid * NWAVES + C.wave;
    }

    layer_body<0>(p, C, bar, misc, lo, hi);
    layer_body<1>(p, C, bar, misc, lo, hi);
#undef IN
#undef SEAM
}

extern "C" void kernel_launch(void* const* d_in, const int* in_sizes, int n_in, void* d_out, int out_size, void* d_ws, size_t ws_size, hipStream_t stream) {
    static int grid = 0;
    if (grid == 0) {
        if (n_in != 34 || out_size != SEQ * DM || ws_size < WS_END) { fprintf(stderr, "kernel_launch: unexpected shapes: n_in %d out %d ws %zu (need %zu)\n", n_in, out_size, ws_size, (size_t)WS_END); grid = -1; return; }
        int dev = 0, cus = 0, per_cu = 0;
        if (hipGetDevice(&dev) != hipSuccess || hipDeviceGetAttribute(&cus, hipDeviceAttributeMultiprocessorCount, dev) != hipSuccess) { grid = -1; return; }
        if (hipFuncSetAttribute((const void*)mega_fwd, hipFuncAttributeMaxDynamicSharedMemorySize, LDS_BYTES) != hipSuccess) { fprintf(stderr, "kernel_launch: hipFuncSetAttribute failed\n"); grid = -1; return; }
        if (hipOccupancyMaxActiveBlocksPerMultiprocessor(&per_cu, (const void*)mega_fwd, NTHR, LDS_BYTES) != hipSuccess || per_cu < 1) { fprintf(stderr, "kernel_launch: occupancy query says %d blocks per CU\n", per_cu); grid = -1; return; }
        (void)hipGetLastError();
        grid = cus;
    }
    if (grid < 0) return;
    (void)hipMemsetAsync((char*)d_ws + WS_CTL, 0, CTL_BYTES, stream);
    KArgs p{};
    for (int i = 0; i < 34; ++i) p.in[i] = (const float*)d_in[i];
    p.out = (float*)d_out; p.ws = (unsigned char*)d_ws;
#if MK_PER_PHASE
    for (int ph = 0; ph < N_PHASES; ++ph) {
        if (ph == 2 + PH_PER_LAYER + 5 || ph == 2 + PH_PER_LAYER + 6) continue;
        p.ph_lo = ph; p.ph_hi = ph + 1;
        hipLaunchKernelGGL(mega_fwd, dim3(grid), dim3(NTHR), LDS_BYTES, stream, p);
    }
#else
    p.ph_lo = 0; p.ph_hi = N_PHASES;
    hipLaunchKernelGGL(mega_fwd, dim3(grid), dim3(NTHR), LDS_BYTES, stream, p);
#endif
    const hipError_t le = hipPeekAtLastError();
    if (le != hipSuccess) fprintf(stderr, "kernel_launch: launch failed: %s\n", hipGetErrorName(le));
}
```

```cpp
#define MK_PER_PHASE 0
#include <hip/hip_runtime.h>
#include <cstdio>
#include <cstdint>

#define GAS __attribute__((address_space(1)))
#define LAS __attribute__((address_space(3)))
typedef unsigned short bf16_t;
typedef short bf16x8 __attribute__((ext_vector_type(8)));
typedef short s16x4 __attribute__((ext_vector_type(4)));
typedef float f32x4 __attribute__((ext_vector_type(4)));
typedef float f32x2 __attribute__((ext_vector_type(2)));
typedef float f32x16 __attribute__((ext_vector_type(16)));
typedef unsigned u32x4 __attribute__((ext_vector_type(4)));
typedef unsigned u32x2 __attribute__((ext_vector_type(2)));

constexpr int DM = 2048, SEQ = 16384, CTXL = 256, TT = SEQ + CTXL;
constexpr int NEXP = 64, NEX1 = 65, EHID = 512, TOPK = 8;
constexpr int EV_IN = 5120, OD_IN = 4608;
constexpr float LN_EPS = 1e-6f;
constexpr float ALPHA = 1.4142135623730951f;
constexpr float LAMBDA_INIT = 0.35550906759f;
constexpr int NTHR = 512, NWAVES = 8;

constexpr size_t al256(size_t x) { return (x + 255) / 256 * 256; }
constexpr size_t WS_CTL   = 0;
constexpr size_t CTL_BYTES = 1u << 20;
constexpr size_t WS_MODP  = WS_CTL + CTL_BYTES;
constexpr size_t WS_MODF  = WS_MODP + al256((size_t)2 * 32 * 2 * 12288 * 4);
constexpr size_t WS_ROPE128 = WS_MODF + al256((size_t)2 * 2 * 12288 * 4);
constexpr size_t WS_ROPE64  = WS_ROPE128 + al256((size_t)256 * 64 * 2 * 4);
constexpr size_t WS_KN    = WS_ROPE64 + al256((size_t)256 * 32 * 2 * 4);
constexpr size_t WS_WT    = WS_KN + al256((size_t)2 * 64 * 16 * 1024 * 2);
constexpr size_t WS_APOW  = WS_WT + al256((size_t)2 * 64 * 128 * 1024 * 2);
constexpr size_t WS_AL    = WS_APOW + al256((size_t)2 * 64 * 64 * 128 * 4);
constexpr size_t WS_CC    = WS_AL + al256((size_t)2 * 64 * 128 * 4);
constexpr size_t WS_BBT   = WS_CC + al256((size_t)64 * 16 * 128 * 2);
constexpr size_t WS_S5E   = WS_BBT + al256((size_t)2 * 64 * 128 * 16 * 2);
constexpr size_t WS_HST   = WS_S5E + al256((size_t)2 * 64 * 260 * 128 * 4);
constexpr size_t WS_WIN0  = WS_HST + al256((size_t)2 * 64 * 260 * 128 * 4);
constexpr size_t WS_WOUT0 = WS_WIN0 + al256((size_t)EV_IN * DM * 2);
constexpr size_t WS_WGLU  = WS_WOUT0 + al256((size_t)DM * DM * 2);
constexpr size_t WS_WIN1  = WS_WGLU + al256((size_t)1024 * 1024 * 2);
constexpr size_t WS_WOUT1 = WS_WIN1 + al256((size_t)OD_IN * DM * 2);
constexpr size_t WS_RWT   = WS_WOUT1 + al256((size_t)DM * DM * 2);
constexpr size_t WS_GU    = WS_RWT + al256((size_t)2 * 2 * 64 * DM * 2);
constexpr size_t WS_DT    = WS_GU + al256((size_t)NEX1 * 1024 * DM * 2);
constexpr size_t WS_XA    = WS_DT + al256((size_t)NEX1 * DM * EHID * 2);
constexpr size_t WS_Z     = WS_XA + al256((size_t)TT * DM * 2);
constexpr size_t WS_YMIX  = WS_Z + al256((size_t)TT * 1024 * 2);
constexpr size_t WS_X1    = WS_YMIX + al256((size_t)TT * DM * 2);
constexpr size_t WS_HX2   = WS_X1 + al256((size_t)TT * DM * 4);
constexpr size_t WS_LIST  = WS_HX2 + al256((size_t)9 * TT * EHID * 2);
constexpr size_t WS_WGT   = WS_LIST + al256((size_t)NEX1 * TT * 4);
constexpr size_t WS_LW    = WS_WGT + al256((size_t)8 * TT * 4);
constexpr size_t WS_BIG   = WS_LW + al256((size_t)NEX1 * TT * 4);
constexpr size_t BG_QKV   = 0;
constexpr size_t BG_CKV   = BG_QKV + al256((size_t)TT * EV_IN * 2);
constexpr size_t BG_SPREV = BG_CKV + al256((size_t)8 * 130 * 65536 * 4);
constexpr size_t BG_MIX   = BG_SPREV + al256((size_t)8 * 130 * 65536 * 2);
constexpr size_t BG_END0  = BG_MIX + al256((size_t)TT * DM * 2);
constexpr size_t BG_ATT   = BG_CKV;
constexpr size_t BG_Q8    = BG_ATT + al256((size_t)SEQ * 3072 * 2);
constexpr size_t BG_K8    = BG_Q8 + al256((size_t)TT * 1024);
constexpr size_t BG_VT8   = BG_K8 + al256((size_t)TT * 256);
constexpr size_t BG_Q8D   = BG_VT8 + al256((size_t)2 * 260 * 128 * 64);
constexpr size_t BG_K8D   = BG_Q8D + al256((size_t)TT * 1024);
constexpr size_t BG_VT8D  = BG_K8D + al256((size_t)TT * 1024);
constexpr size_t BG_F8END = BG_VT8D + al256((size_t)8 * 260 * 128 * 64);
constexpr size_t BG_YMOE  = 0;
constexpr size_t BG_END1  = al256((size_t)9 * TT * DM * 2);
constexpr size_t BG_SIZE  = BG_END0 > BG_END1 ? BG_END0 : BG_END1;
static_assert(BG_F8END <= BG_SIZE, "fp8 attention operands inside the big region");
constexpr size_t WS_END   = WS_BIG + BG_SIZE;

constexpr int CW_BAR = 4096;
constexpr int CW_CNT = 16384;
constexpr int CW_QUEUE = 20480;
constexpr int CW_KMAX = 24576;

constexpr int RING_BYTES = 151552;
constexpr int MISC_OFF = RING_BYTES;
constexpr int LDS_BYTES = 159744;

typedef __bf16 bf16x2_t __attribute__((ext_vector_type(2)));
__device__ __forceinline__ unsigned cvt_pk_bf16(float lo, float hi) { const f32x2 v = {lo, hi}; return __builtin_bit_cast(unsigned, __builtin_convertvector(v, bf16x2_t)); }
__device__ __forceinline__ bf16_t f2bf(float f) { unsigned u = __builtin_bit_cast(unsigned, f); return (bf16_t)((u + 0x7fffu + ((u >> 16) & 1u)) >> 16); }
__device__ __forceinline__ float bf2f(bf16_t b) { return __builtin_bit_cast(float, ((unsigned)b) << 16); }
__device__ __forceinline__ float bflo(unsigned w) { return __builtin_bit_cast(float, w << 16); }
__device__ __forceinline__ float bfhi(unsigned w) { return __builtin_bit_cast(float, w & 0xffff0000u); }
__device__ __forceinline__ float wave_sum(float v) {
#pragma unroll
    for (int o = 1; o < 64; o <<= 1) v += __shfl_xor(v, o);
    return v;
}
__device__ __forceinline__ float fast_exp(float x) { return __builtin_amdgcn_exp2f(x * 1.4426950408889634f); }
__device__ __forceinline__ float sigmoidf_(float x) { return 1.0f / (1.0f + __expf(-x)); }
__device__ __forceinline__ float siluf_(float x) { return x / (1.0f + __expf(-x)); }
__device__ __forceinline__ float gelu_tanh(float x) {
    const float u = 0.7978845608028654f * (x + 0.044715f * x * x * x);
    const float e = __expf(2.0f * u);
    const float t = 1.0f - 2.0f / (e + 1.0f);
    return 0.5f * x * (1.0f + t);
}
#define LDS_WAIT() asm volatile("s_waitcnt lgkmcnt(0)" ::: "memory")
#define VM_WAIT() asm volatile("s_waitcnt vmcnt(0)" ::: "memory")

#define XB_TMO      128
#define XB_XCNT(j)  (256  + 64 * (j))
#define XB_XSUB(j)  (1280 + 64 * (j))
#define XB_XGEN(j)  (2304 + 64 * (j))
#define XB_TOP      3328
#define XB_TOPGEN   3392
#define XCD_BAR_WORDS 3456
#define XB_SPIN_CAP (1u << 22)

__device__ __forceinline__ unsigned xb_ld(unsigned* p)              { return __hip_atomic_load(p, __ATOMIC_RELAXED, __HIP_MEMORY_SCOPE_AGENT); }
__device__ __forceinline__ unsigned xb_add(unsigned* p, unsigned v) { return __hip_atomic_fetch_add(p, v, __ATOMIC_RELAXED, __HIP_MEMORY_SCOPE_AGENT); }
__device__ __forceinline__ unsigned xb_xcc_id() { return (unsigned)__builtin_amdgcn_s_getreg((3 << 11) | 20) & 0xFu; }
#define XB_SPIN(cond, bar) do { unsigned _sp = 0; while (cond) { __builtin_amdgcn_s_sleep(1); \
    if ((++_sp & 255u) == 0u) { if (xb_ld(&(bar)[XB_TMO])) break; if (_sp > XB_SPIN_CAP) { atomicAdd(&(bar)[XB_TMO], 1u); break; } } } } while (0)

struct XcdBarrier { unsigned* bar; unsigned x; volatile LAS unsigned* st; };

__device__ __forceinline__ XcdBarrier xcd_barrier_post(unsigned* bar, volatile LAS unsigned* st) {
    XcdBarrier b; b.bar = bar; b.x = xb_xcc_id(); b.st = st;
    if (threadIdx.x == 0) { st[2] = xb_add(&bar[XB_XCNT(b.x)], 1u); st[3] = b.x; }
    return b;
}
__device__ __forceinline__ void xcd_barrier_complete(unsigned* bar, unsigned x, unsigned& nloc, unsigned& nx) {
    const unsigned G = gridDim.x * gridDim.y * gridDim.z;
    unsigned sum, cnt, mine, sp = 0u;
    for (;;) {
        sum = 0u; cnt = 0u; mine = 0u;
#pragma unroll
        for (unsigned j = 0; j < 16; ++j) { const unsigned c = xb_ld(&bar[XB_XCNT(j)]); sum += c; cnt += (c > 0u) ? 1u : 0u; mine = (j == x) ? c : mine; }
        if (sum == G) break;
        __builtin_amdgcn_s_sleep(1);
        if ((++sp & 255u) == 0u) { if (xb_ld(&bar[XB_TMO])) break; if (sp > XB_SPIN_CAP) { atomicAdd(&bar[XB_TMO], 1u); break; } }
    }
    nloc = mine > 0u ? mine : 1u; nx = cnt > 0u ? cnt : 1u;
}
__device__ __forceinline__ void xcd_barrier(const XcdBarrier& b, int wave_id) {
    const bool leader_thread = (wave_id == 0) && (__builtin_amdgcn_mbcnt_hi(~0u, __builtin_amdgcn_mbcnt_lo(~0u, 0u)) == 0u);
    asm volatile("s_waitcnt vmcnt(0)" ::: "memory");
    __syncthreads();
    if (leader_thread) {
        unsigned* bar = b.bar;
        __builtin_amdgcn_s_waitcnt(0);
        unsigned nloc = b.st[0], nx = b.st[1];
        if (nloc == 0u) { xcd_barrier_complete(bar, b.x, nloc, nx); b.st[0] = nloc; b.st[1] = nx; }
        const unsigned old = xb_add(&bar[XB_XSUB(b.x)], 1u);
        const unsigned gen = old / nloc;
        if (old + 1u == (gen + 1u) * nloc) {
            __builtin_amdgcn_fence(__ATOMIC_RELEASE, "agent");
            asm volatile("s_waitcnt vmcnt(0)" ::: "memory");
            const unsigned og = xb_add(&bar[XB_TOP], 1u);
            const unsigned tg = og / nx;
            if (og + 1u == (tg + 1u) * nx) xb_add(&bar[XB_TOPGEN], 1u);
            else XB_SPIN(xb_ld(&bar[XB_TOPGEN]) == tg, bar);
            __builtin_amdgcn_fence(__ATOMIC_ACQUIRE, "agent");
            xb_add(&bar[XB_XGEN(b.x)], 1u);
            asm volatile("s_waitcnt vmcnt(0)" ::: "memory");
        } else {
            XB_SPIN(xb_ld(&bar[XB_XGEN(b.x)]) == gen, bar);
            __builtin_amdgcn_fence(__ATOMIC_ACQUIRE, "agent");
            asm volatile("s_waitcnt vmcnt(0)" ::: "memory");
        }
    }
    __syncthreads();
}

__device__ __forceinline__ bf16x8 frag_rowk_l(const LAS bf16_t* p, int ld, int lane) {
    return *(const LAS bf16x8*)(p + (lane & 15) * ld + (lane >> 4) * 8);
}
__device__ __forceinline__ bf16x8 frag_rowk_g(const bf16_t* p, long ld, int lane) {
    return *(const bf16x8*)(p + (long)(lane & 15) * ld + (lane >> 4) * 8);
}
__device__ __forceinline__ bf16x8 frag_colk_l(unsigned p, int ldb, int lane) {
    const unsigned a0 = p + (unsigned)((8 * (lane >> 4) + ((lane & 15) >> 2)) * ldb + (lane & 3) * 8);
    const unsigned a1 = a0 + 4u * (unsigned)ldb;
    s16x4 lo, hi;
    asm volatile("ds_read_b64_tr_b16 %0, %2\n\tds_read_b64_tr_b16 %1, %3\n\ts_waitcnt lgkmcnt(0)" : "=&v"(lo), "=&v"(hi) : "v"(a0), "v"(a1) : "memory");
    return (bf16x8){lo[0], lo[1], lo[2], lo[3], hi[0], hi[1], hi[2], hi[3]};
}
#define MFMA16(a, b, c) __builtin_amdgcn_mfma_f32_16x16x32_bf16((a), (b), (c), 0, 0, 0)
namespace pg8 {
constexpr int BM = 256, BK = 64, HALF = 128, HTB = HALF * BK * 2, STAGE_BYTES = 8 * HTB, NXCD = 8, WGM = 8;
__device__ __forceinline__ int lds_byte(int r, int c) { const int st = (r >> 4) * 2 + (c >> 5), rr = r & 15, cc = c & 31, ob = rr * 64 + cc * 2; return st * 1024 + (ob ^ (((ob >> 9) & 1) << 5)); }
__device__ __forceinline__ void stage_rc(int b, int& R, int& C) { const int st = b / 1024, sb = b % 1024, swz = sb ^ (((sb >> 9) & 1) << 5); R = (st >> 1) * 16 + swz / 64; C = (st & 1) * 32 + (swz % 64) / 2; }
__device__ __forceinline__ int perm32(int rho) { const int n = rho >> 4, i = rho & 15; return 8 * (i >> 2) + 4 * n + (i & 3); }

struct Unit { int pm, pn, e; };
constexpr float WSCALE = 32.0f, WSCALE_INV = 1.0f / 32.0f;

struct DenseOrder {
    const bf16_t* A; const bf16_t* Bt; int ldab, kb, nM, nN, nwg, G, c;
    __device__ __forceinline__ void init(const bf16_t* A_, int lda_, const bf16_t* Bt_, int M, int N, int K_, int G_, int c_) { A = A_; ldab = lda_ * 2; Bt = Bt_; kb = K_ * 2; nM = M / BM; nN = N / BM; nwg = nM * nN; G = G_; c = c_; }
    __device__ __forceinline__ void init8(const void* A_, int ldab_, const void* Bt_, int M, int N, int K_, int G_, int c_) { A = (const bf16_t*)A_; ldab = ldab_; Bt = (const bf16_t*)Bt_; kb = K_; nM = M / BM; nN = N / BM; nwg = nM * nN; G = G_; c = c_; }
    __device__ __forceinline__ void prep(LAS unsigned char*) const {}
    __device__ __forceinline__ int units_of_me() const { return c < nwg ? (nwg - c + G - 1) / G : 0; }
    __device__ __forceinline__ int max_units() const { return (nwg + G - 1) / G; }
    __device__ __forceinline__ bool next(int i, Unit& u) const {
        const long L = (long)i * G + c; if (L >= nwg) return false;
        int wgid = (int)L; { const int q = nwg / NXCD, r = nwg % NXCD, xcd = wgid % NXCD, off = wgid / NXCD; wgid = (xcd < r ? xcd * (q + 1) : r * (q + 1) + (xcd - r) * q) + off; }
        const int nig = WGM * nN, gid = wgid / nig, fm = gid * WGM, gsz = (nM - fm) < WGM ? (nM - fm) : WGM;
        u.pm = fm + ((wgid % nig) % gsz); u.pn = (wgid % nig) / gsz; u.e = 0; return true;
    }
    __device__ __forceinline__ const char* a_base() const { return (const char*)A; }
    __device__ __forceinline__ unsigned a_off(const Unit& u, int r) const { return (unsigned)(u.pm * BM + r) * (unsigned)ldab; }
    __device__ __forceinline__ const char* b_ptr(const Unit& u) const { return (const char*)Bt + (size_t)u.pn * BM * kb; }
};

template <int MODE  >
struct MoeOrder {
    const void* A; const void* Bt; const int* list; const int* cnt; int ldab, kb, nN, G, c; size_t bstride;
    LAS int* tp; LAS int* cn; LAS int* rb;
    __device__ __forceinline__ void prep(LAS unsigned char* misc, int tid) {
        tp = (LAS int*)(misc + 64); cn = tp + 72; rb = cn + 72;
        if (tid < NEX1) cn[tid] = cnt[tid];
        __syncthreads();
        if (tid == 0) { int s = 0, q = 0; for (int e = 0; e < NEX1; ++e) { tp[e] = s; rb[e] = q; s += (cn[e] + BM - 1) / BM; q += cn[e]; } tp[NEX1] = s; rb[NEX1] = q; }
        __syncthreads();
    }
    __device__ __forceinline__ bool next(int i, Unit& u) const {
        const int total = tp[NEX1]; const long nu = (long)total * nN; const int per = (int)((nu + G - 1) / G);
        (void)per;
        long L = (long)i * G + c;
        if ((G & 7) == 0) L = ((long)i * 8 + (c & 7)) * (G >> 3) + (c >> 3);
        if (L >= nu) return false;
        const int tile = (int)(L / nN); u.pn = (int)(L % nN);
        int e = 0;
        for (int k = 1; k < NEX1; ++k) e += (tp[k] <= tile) ? 1 : 0;
        u.e = e; u.pm = tile - tp[e]; return true;
    }
    __device__ __forceinline__ const char* a_base() const { return (const char*)A; }
    __device__ __forceinline__ unsigned a_off(const Unit& u, int r) const {
        int pos = u.pm * BM + r; const int n = cn[u.e]; pos = pos < n ? pos : n - 1;
        if (MODE == 1) return (unsigned)(rb[u.e] + pos) * (unsigned)ldab;
        const int a = list[u.e * TT + pos];
        const int row = a < 8 * TT ? (a >> 3) : a - 8 * TT;
        return (unsigned)row * (unsigned)ldab;
    }
    __device__ __forceinline__ const char* b_ptr(const Unit& u) const { return (const char*)Bt + (size_t)u.e * bstride + (size_t)u.pn * BM * kb; }
};

typedef int v8i32 __attribute__((ext_vector_type(8)));
typedef int v4i32_ __attribute__((ext_vector_type(4)));
__device__ __forceinline__ v8i32 cat8(bf16x8 a, bf16x8 b) { const u32x4 x = __builtin_bit_cast(u32x4, a), y = __builtin_bit_cast(u32x4, b); return (v8i32){(int)x.x, (int)x.y, (int)x.z, (int)x.w, (int)y.x, (int)y.y, (int)y.z, (int)y.w}; }
template <bool FP8, class Epi, class Sched>
__device__ __forceinline__ void gemm_phase(LAS unsigned char* lds, const Sched& S, const Epi& E, int wave_id) {
    const int wid = wave_id; int lane = (int)__builtin_amdgcn_mbcnt_hi(~0u, __builtin_amdgcn_mbcnt_lo(~0u, 0u)); asm volatile("" : "+v"(lane));
    const int tid = wid * 64 + lane, wr = wid >> 2, wc = wid & 3, fr = lane & 15, fq = lane >> 4;
    const int kb = S.kb; int nt = kb / 128; asm volatile("" : "+s"(nt));
    unsigned voffB[2];
#pragma unroll
    for (int i = 0; i < 2; ++i) { int R, C; stage_rc(tid * 16 + i * 8192, R, C); const int Rb = (R & ~31) + perm32(R & 31);
        voffB[i] = (unsigned)(Rb * kb) + (unsigned)C * 2u; }
#define PG8_AOFF(u, h, i) ({ int _tz = tid; asm volatile("" : "+v"(_tz)); int _R, _C; stage_rc(_tz * 16 + (i) * 8192, _R, _C); S.a_off((u), (h) * HALF + _R) + (unsigned)_C * 2u; })
    const size_t kstep = (size_t)(BK * 2);
    const size_t hstepB = (size_t)HALF * kb;
    const unsigned ldsw = (unsigned)wid * 1024u;
    const int aoff = lds_byte(wr * 64 + fr, fq * 8), boff = lds_byte(wc * 32 + fr, fq * 8);
#define PG8_SA(b, h) (((b) * 2 + (h)) * HTB)
#define PG8_SB(b, h) ((4 + (b) * 2 + (h)) * HTB)
#define PG8_STAGE(bufoff, gbase, v0, v1) do { \
        __builtin_amdgcn_global_load_lds((const unsigned*)((const char*)(gbase) + (v0)), (LAS unsigned*)(lds + (bufoff) + ldsw), 16, 0, 0); \
        __builtin_amdgcn_global_load_lds((const unsigned*)((const char*)(gbase) + (v1)), (LAS unsigned*)(lds + (bufoff) + ldsw + 8192), 16, 0, 0); } while (0)
#define PG8_VOFFB(i) ({ int _tz = tid; asm volatile("" : "+v"(_tz)); int _R, _C; stage_rc(_tz * 16 + (i) * 8192, _R, _C); (unsigned)(((_R & ~31) + perm32(_R & 31)) * kb) + (unsigned)_C * 2u; })
#define PG8_STAGE_B(bufoff, gbase) do { if constexpr (FP8) { const unsigned _v0 = PG8_VOFFB(0), _v1 = PG8_VOFFB(1); PG8_STAGE(bufoff, gbase, _v0, _v1); } else PG8_STAGE(bufoff, gbase, voffB[0], voffB[1]); } while (0)
#define PG8_LD8(off) __builtin_shufflevector(*(const LAS v4i32_*)(lds + (off)), *(const LAS v4i32_*)(lds + (off) + 1024), 0, 1, 2, 3, 4, 5, 6, 7)
#define PG8_LDA(dst, b, h) do { _Pragma("unroll") for (int m = 0; m < 4; ++m) { if constexpr (FP8) dst##8[m] = PG8_LD8(PG8_SA(b, h) + aoff + m * 2048); else { _Pragma("unroll") for (int k = 0; k < 2; ++k) dst[m][k] = *(const LAS bf16x8*)(lds + PG8_SA(b, h) + aoff + m * 2048 + k * 1024); } } } while (0)
#define PG8_LDB(dst, b, h) do { _Pragma("unroll") for (int n = 0; n < 2; ++n) { if constexpr (FP8) dst##8[n] = PG8_LD8(PG8_SB(b, h) + boff + n * 2048); else { _Pragma("unroll") for (int k = 0; k < 2; ++k) dst[n][k] = *(const LAS bf16x8*)(lds + PG8_SB(b, h) + boff + n * 2048 + k * 1024); } } } while (0)
#define PG8_MMA(ai, bj, At, Bt) do { __builtin_amdgcn_s_setprio(1); _Pragma("unroll") for (int m = 0; m < 4; ++m) _Pragma("unroll") for (int n = 0; n < 2; ++n) { \
        if constexpr (FP8) asm volatile("v_mfma_f32_16x16x128_f8f6f4 %0, %1, %2, %0" : "+v"(acc[ai][bj][m][n]) : "v"(Bt##8[n]), "v"(At##8[m])); \
        else { _Pragma("unroll") for (int k = 0; k < 2; ++k) acc[ai][bj][m][n] = __builtin_amdgcn_mfma_f32_16x16x32_bf16(Bt[n][k], At[m][k], acc[ai][bj][m][n], 0, 0, 0); } } \
        __builtin_amdgcn_s_setprio(0); } while (0)
#define PG8_WAIT_V(n) asm volatile("s_waitcnt vmcnt(" #n ")" ::: "memory")
#define PG8_WAIT_L(n) asm volatile("s_waitcnt lgkmcnt(" #n ")" ::: "memory")
#define PG8_BAR __builtin_amdgcn_s_barrier()
#define PG8_SCHED __builtin_amdgcn_sched_barrier(0)
    Unit cur, nxt; int ui = 0;
    if (!S.next(0, cur)) return;
    f32x4 acc[2][2][4][2];
#pragma unroll
    for (int a = 0; a < 2; ++a)
#pragma unroll
        for (int b = 0; b < 2; ++b)
#pragma unroll
            for (int m = 0; m < 4; ++m)
#pragma unroll
                for (int n = 0; n < 2; ++n) acc[a][b][m][n] = (f32x4){0.f, 0.f, 0.f, 0.f};
    bf16x8 At[4][2], B0[2][2], B1[2][2]; v8i32 At8[4], B08[2], B18[2];
    const char* const gA = S.a_base();
    const char* cB = S.b_ptr(cur);
    unsigned oc00, oc01, oc10, oc11;
    oc00 = PG8_AOFF(cur, 0, 0); oc01 = PG8_AOFF(cur, 0, 1); oc10 = PG8_AOFF(cur, 1, 0); oc11 = PG8_AOFF(cur, 1, 1);
    PG8_STAGE_B(PG8_SB(0, 0), cB); PG8_STAGE_B(PG8_SB(0, 1), cB + hstepB); PG8_STAGE(PG8_SA(0, 0), gA, oc00, oc01); PG8_STAGE(PG8_SA(0, 1), gA, oc10, oc11);
    if (wr == 1) PG8_BAR;
    PG8_WAIT_V(2); PG8_BAR;
    PG8_STAGE_B(PG8_SB(1, 0), cB + kstep); PG8_STAGE(PG8_SA(1, 0), gA + kstep, oc00, oc01); PG8_STAGE_B(PG8_SB(1, 1), cB + hstepB + kstep);
    PG8_WAIT_V(6); PG8_BAR;
    for (;;) {
        const bool has_next = S.next(ui + 1, nxt);
        const char* nB = cB;
        {
            u32x4 on = {oc00, oc01, oc10, oc11};
            if (has_next) { on.x = PG8_AOFF(nxt, 0, 0); on.y = PG8_AOFF(nxt, 0, 1); on.z = PG8_AOFF(nxt, 1, 0); on.w = PG8_AOFF(nxt, 1, 1); nB = S.b_ptr(nxt); }
            *(LAS u32x4*)(lds + STAGE_BYTES + tid * 16) = on;
        }
        for (int t = 0; t < nt; t += 2) {
            const bool last = (t == nt - 2);
            const char* a1 = gA + (size_t)(t + 1) * kstep;
            const char* a2 = last ? gA : gA + (size_t)(t + 2) * kstep; const char* b2 = last ? nB : cB + (size_t)(t + 2) * kstep;
            const char* a3 = a2 + kstep; const char* b3 = b2 + kstep;
            unsigned s00 = oc00, s01 = oc01, s10 = oc10, s11 = oc11;
            if (last) { const u32x4 on = *(const LAS u32x4*)(lds + STAGE_BYTES + tid * 16); s00 = on.x; s01 = on.y; s10 = on.z; s11 = on.w; }
            PG8_LDB(B0, 0, 0); PG8_LDB(B1, 0, 1); PG8_SCHED; PG8_LDA(At, 0, 0); PG8_STAGE(PG8_SA(1, 1), a1, oc10, oc11);
            PG8_WAIT_V(8); PG8_WAIT_L(0); PG8_BAR; PG8_MMA(0, 0, At, B0); PG8_MMA(0, 1, At, B1); PG8_BAR; PG8_SCHED;
            PG8_LDA(At, 0, 1); PG8_STAGE_B(PG8_SB(0, 0), b2); PG8_STAGE_B(PG8_SB(0, 1), b2 + hstepB); PG8_STAGE(PG8_SA(0, 0), a2, s00, s01);
            PG8_WAIT_V(8); PG8_WAIT_L(0); PG8_BAR; PG8_MMA(1, 0, At, B0); PG8_MMA(1, 1, At, B1); PG8_BAR; PG8_SCHED;
            PG8_LDB(B0, 1, 0); PG8_LDB(B1, 1, 1); PG8_SCHED; PG8_LDA(At, 1, 0); PG8_STAGE(PG8_SA(0, 1), a2, s10, s11);
            PG8_WAIT_V(8); PG8_WAIT_L(0); PG8_BAR; PG8_MMA(0, 0, At, B0); PG8_MMA(0, 1, At, B1); PG8_BAR; PG8_SCHED;
            PG8_LDA(At, 1, 1); PG8_STAGE_B(PG8_SB(1, 0), b3); PG8_STAGE_B(PG8_SB(1, 1), b3 + hstepB); PG8_STAGE(PG8_SA(1, 0), a3, s00, s01);
            PG8_WAIT_V(8); PG8_WAIT_L(0); PG8_BAR; PG8_MMA(1, 0, At, B0); PG8_MMA(1, 1, At, B1); PG8_BAR; PG8_SCHED;
        }
        if (wr == 0) PG8_BAR;
        E(acc, cur, wr, wc, fr, fq);
        if (!has_next) break;
#pragma unroll
        for (int a = 0; a < 2; ++a)
#pragma unroll
            for (int b = 0; b < 2; ++b)
#pragma unroll
                for (int m = 0; m < 4; ++m)
#pragma unroll
                    for (int n = 0; n < 2; ++n) acc[a][b][m][n] = (f32x4){0.f, 0.f, 0.f, 0.f};
        { const u32x4 on = *(const LAS u32x4*)(lds + STAGE_BYTES + tid * 16); oc00 = on.x; oc01 = on.y; oc10 = on.z; oc11 = on.w; }
        cur = nxt; cB = nB; ++ui;
        if (wr == 1) PG8_BAR;
    }
    PG8_WAIT_V(0);
    PG8_BAR;
#undef PG8_SA
#undef PG8_SB
#undef PG8_STAGE
#undef PG8_STAGE_B
#undef PG8_AOFF
#undef PG8_VOFFB
#undef PG8_LD8
#undef PG8_LDA
#undef PG8_LDB
#undef PG8_MMA
#undef PG8_WAIT_V
#undef PG8_WAIT_L
#undef PG8_BAR
#undef PG8_SCHED
}

struct EpiStore {
    bf16_t* O; int ldc; float scale;
    __device__ __forceinline__ void operator()(const f32x4 (&acc)[2][2][4][2], const Unit& u, int wr, int wc, int fr, int fq) const {
        const int row0 = u.pm * BM + wr * 64 + fr, col0 = u.pn * BM + wc * 32 + 8 * fq;
#pragma unroll
        for (int ai = 0; ai < 2; ++ai)
#pragma unroll
            for (int m = 0; m < 4; ++m) { bf16_t* rowp = O + (size_t)(row0 + ai * HALF + m * 16) * ldc + col0;
#pragma unroll
                for (int bj = 0; bj < 2; ++bj) { const f32x4 v0 = acc[ai][bj][m][0] * scale, v1 = acc[ai][bj][m][1] * scale;
                    u32x4 w; w.x = cvt_pk_bf16(v0[0], v0[1]); w.y = cvt_pk_bf16(v0[2], v0[3]); w.z = cvt_pk_bf16(v1[0], v1[1]); w.w = cvt_pk_bf16(v1[2], v1[3]);
                    *(u32x4*)(rowp + bj * HALF) = w; } }
    }
};
struct EpiGlu {
    const bf16_t* Z; const float* b; bf16_t* MIX;
    __device__ __forceinline__ void operator()(const f32x4 (&acc)[2][2][4][2], const Unit& u, int wr, int wc, int fr, int fq) const {
        const int row0 = u.pm * BM + wr * 64 + fr, col0 = u.pn * BM + wc * 32 + 8 * fq;
#pragma unroll
        for (int bj = 0; bj < 2; ++bj) {
            const f32x4 b0 = *(const f32x4*)(b + col0 + bj * HALF), b1 = *(const f32x4*)(b + col0 + bj * HALF + 4);
#pragma unroll
            for (int ai = 0; ai < 2; ++ai)
#pragma unroll
                for (int m = 0; m < 4; ++m) { const size_t row = (size_t)(row0 + ai * HALF + m * 16);
                    const u32x4 zz = *(const u32x4*)(Z + row * 1024 + col0 + bj * HALF);
                    const f32x4 v0 = acc[ai][bj][m][0] + b0, v1 = acc[ai][bj][m][1] + b1;
                    u32x4 w;
                    w.x = cvt_pk_bf16(bflo(zz.x) * sigmoidf_(v0[0]), bfhi(zz.x) * sigmoidf_(v0[1]));
                    w.y = cvt_pk_bf16(bflo(zz.y) * sigmoidf_(v0[2]), bfhi(zz.y) * sigmoidf_(v0[3]));
                    w.z = cvt_pk_bf16(bflo(zz.z) * sigmoidf_(v1[0]), bfhi(zz.z) * sigmoidf_(v1[1]));
                    w.w = cvt_pk_bf16(bflo(zz.w) * sigmoidf_(v1[2]), bfhi(zz.w) * sigmoidf_(v1[3]));
                    *(u32x4*)(MIX + row * DM + 1024 + col0 + bj * HALF) = w; }
        }
    }
};
struct EpiE1 {
    unsigned char* H; const LAS int* cn; const LAS int* rb;
    __device__ __forceinline__ void operator()(const f32x4 (&acc)[2][2][4][2], const Unit& u, int wr, int wc, int fr, int fq) const {
        const int n = cn[u.e]; const int colh = u.pn * 128 + wc * 32 + 8 * fq;
#pragma unroll
        for (int ai = 0; ai < 2; ++ai)
#pragma unroll
            for (int m = 0; m < 4; ++m) { const int pos = u.pm * BM + ai * HALF + wr * 64 + m * 16 + fr;
                if (pos < n) { const int a = rb[u.e] + pos;
                    float sc = WSCALE_INV; asm volatile("" : "+v"(sc));
                    const f32x4 g0 = acc[ai][0][m][0] * sc, g1 = acc[ai][0][m][1] * sc, u0 = acc[ai][1][m][0] * sc, u1 = acc[ai][1][m][1] * sc;
                    u32x2 w;
                    w.x = (unsigned)__builtin_amdgcn_cvt_pk_fp8_f32(siluf_(g0[0]) * u0[0], siluf_(g0[1]) * u0[1], 0, false);
                    w.x = (unsigned)__builtin_amdgcn_cvt_pk_fp8_f32(siluf_(g0[2]) * u0[2], siluf_(g0[3]) * u0[3], (int)w.x, true);
                    w.y = (unsigned)__builtin_amdgcn_cvt_pk_fp8_f32(siluf_(g1[0]) * u1[0], siluf_(g1[1]) * u1[1], 0, false);
                    w.y = (unsigned)__builtin_amdgcn_cvt_pk_fp8_f32(siluf_(g1[2]) * u1[2], siluf_(g1[3]) * u1[3], (int)w.y, true);
                    *(u32x2*)(H + (size_t)a * EHID + colh) = w; }
                __builtin_amdgcn_sched_barrier(0); }
    }
};
struct EpiE2 {
    unsigned char* Y; const float* wgt; const LAS int* cn; const LAS int* rb;
    __device__ __forceinline__ void operator()(const f32x4 (&acc)[2][2][4][2], const Unit& u, int wr, int wc, int fr, int fq) const {
        const int n = cn[u.e]; const int col0 = u.pn * BM + wc * 32 + 8 * fq;
#pragma unroll
        for (int ai = 0; ai < 2; ++ai)
#pragma unroll
            for (int m = 0; m < 4; ++m) { const int pos = u.pm * BM + ai * HALF + wr * 64 + m * 16 + fr;
                if (pos < n) { const int a = rb[u.e] + pos; float ws = wgt[u.e * TT + pos] * WSCALE_INV; asm volatile("" : "+v"(ws));
                    unsigned char* rowp = Y + (size_t)a * DM + col0;
#pragma unroll
                    for (int bj = 0; bj < 2; ++bj) { const f32x4 v0 = acc[ai][bj][m][0] * ws, v1 = acc[ai][bj][m][1] * ws;
                        u32x2 w;
                        w.x = (unsigned)__builtin_amdgcn_cvt_pk_fp8_f32(v0[0], v0[1], 0, false); w.x = (unsigned)__builtin_amdgcn_cvt_pk_fp8_f32(v0[2], v0[3], (int)w.x, true);
                        w.y = (unsigned)__builtin_amdgcn_cvt_pk_fp8_f32(v1[0], v1[1], 0, false); w.y = (unsigned)__builtin_amdgcn_cvt_pk_fp8_f32(v1[2], v1[3], (int)w.y, true);
                        *(u32x2*)(rowp + bj * HALF) = w; } }
                __builtin_amdgcn_sched_barrier(0); }
    }
};
}
struct KArgs {
    const float* in[34];
    float* out;
    unsigned char* ws;
    int ph_lo, ph_hi;
};
struct Params {
    float* out;
    unsigned char* ws;
    LAS unsigned long long* ptab;
    int ph_lo, ph_hi;
    __device__ __forceinline__ const float* inp(int k) const {
        const unsigned long long v = ptab[k];
        const unsigned lo = __builtin_amdgcn_readfirstlane((unsigned)v), hi = __builtin_amdgcn_readfirstlane((unsigned)(v >> 32));
        return (const float*)(((unsigned long long)hi << 32) | lo);
    }
};
struct Ctx {
    LAS unsigned char* lds;
    int tid, lane, wave, G, bid;
    int gw, ngw;
};

__device__ __forceinline__ void tr_item(const float* W, int N, bf16_t* WT, int ldt, int k0, int n0, int orow0, LAS float* scr, int lane) {
#pragma unroll 8
    for (int i = 0; i < 32; ++i) { const int kk = 2 * i + (lane >> 5); scr[kk * 33 + (lane & 31)] = W[(size_t)(k0 + kk) * N + n0 + (lane & 31)]; }
    LDS_WAIT(); asm volatile("" ::: "memory");
    const int c = lane & 7;
#pragma unroll
    for (int j = 0; j < 4; ++j) { const int n = (lane >> 3) + 8 * j; const LAS float* s = scr + (8 * c) * 33 + n;
        u32x4 o; o.x = cvt_pk_bf16(s[0 * 33], s[1 * 33]); o.y = cvt_pk_bf16(s[2 * 33], s[3 * 33]); o.z = cvt_pk_bf16(s[4 * 33], s[5 * 33]); o.w = cvt_pk_bf16(s[6 * 33], s[7 * 33]);
        *(u32x4*)(WT + (size_t)(orow0 + n) * ldt + k0 + 8 * c) = o; }
    LDS_WAIT(); asm volatile("" ::: "memory");
}
__device__ __forceinline__ void tr_item64(const float* W, int N, bf16_t* WT, int ldt, int k0, int n0, int orow0, LAS float* scr, int lane) {
    f32x4 v[16];
    const float* src = W + (size_t)(k0 + (lane >> 4)) * N + n0 + 4 * (lane & 15);
#pragma unroll
    for (int i = 0; i < 16; ++i) v[i] = __builtin_nontemporal_load((const f32x4*)(src + (size_t)(4 * i) * N));
#pragma unroll
    for (int i = 0; i < 16; ++i) { LAS float* d = scr + (4 * i + (lane >> 4)) * 65 + 4 * (lane & 15); d[0] = v[i][0]; d[1] = v[i][1]; d[2] = v[i][2]; d[3] = v[i][3]; }
    LDS_WAIT(); asm volatile("" ::: "memory");
    const int c = lane & 7;
#pragma unroll
    for (int j = 0; j < 8; ++j) { const int n = (lane >> 3) + 8 * j; const LAS float* s = scr + (8 * c) * 65 + n;
        u32x4 o; o.x = cvt_pk_bf16(s[0 * 65], s[1 * 65]); o.y = cvt_pk_bf16(s[2 * 65], s[3 * 65]); o.z = cvt_pk_bf16(s[4 * 65], s[5 * 65]); o.w = cvt_pk_bf16(s[6 * 65], s[7 * 65]);
        *(u32x4*)(WT + (size_t)(orow0 + n) * ldt + k0 + 8 * c) = o; }
    LDS_WAIT(); asm volatile("" ::: "memory");
}
__device__ __forceinline__ void tr_item64_fp8(const float* W, int N, unsigned char* WT, int ldt, int k0, int n0, int orow0, LAS float* scr, int lane, float wscale = pg8::WSCALE) {
    f32x4 v[16];
    const float* src = W + (size_t)(k0 + (lane >> 4)) * N + n0 + 4 * (lane & 15);
#pragma unroll
    for (int i = 0; i < 16; ++i) v[i] = __builtin_nontemporal_load((const f32x4*)(src + (size_t)(4 * i) * N));
#pragma unroll
    for (int i = 0; i < 16; ++i) { LAS float* d = scr + (4 * i + (lane >> 4)) * 65 + 4 * (lane & 15); d[0] = v[i][0]; d[1] = v[i][1]; d[2] = v[i][2]; d[3] = v[i][3]; }
    LDS_WAIT(); asm volatile("" ::: "memory");
    const int c = lane & 3;
#pragma unroll
    for (int j = 0; j < 4; ++j) { const int n = (lane >> 2) + 16 * j; const LAS float* s = scr + (16 * c) * 65 + n;
        u32x4 o;
        o.x = (unsigned)__builtin_amdgcn_cvt_pk_fp8_f32(s[0 * 65] * wscale, s[1 * 65] * wscale, 0, false);   o.x = (unsigned)__builtin_amdgcn_cvt_pk_fp8_f32(s[2 * 65] * wscale, s[3 * 65] * wscale, (int)o.x, true);
        o.y = (unsigned)__builtin_amdgcn_cvt_pk_fp8_f32(s[4 * 65] * wscale, s[5 * 65] * wscale, 0, false);   o.y = (unsigned)__builtin_amdgcn_cvt_pk_fp8_f32(s[6 * 65] * wscale, s[7 * 65] * wscale, (int)o.y, true);
        o.z = (unsigned)__builtin_amdgcn_cvt_pk_fp8_f32(s[8 * 65] * wscale, s[9 * 65] * wscale, 0, false);   o.z = (unsigned)__builtin_amdgcn_cvt_pk_fp8_f32(s[10 * 65] * wscale, s[11 * 65] * wscale, (int)o.z, true);
        o.w = (unsigned)__builtin_amdgcn_cvt_pk_fp8_f32(s[12 * 65] * wscale, s[13 * 65] * wscale, 0, false); o.w = (unsigned)__builtin_amdgcn_cvt_pk_fp8_f32(s[14 * 65] * wscale, s[15 * 65] * wscale, (int)o.w, true);
        *(u32x4*)(WT + (size_t)(orow0 + n) * ldt + k0 + 16 * c) = o; }
    LDS_WAIT(); asm volatile("" ::: "memory");
}
__device__ __forceinline__ void tr_dense(const float* W, int K, int N, bf16_t* WT, int item, LAS float* scr, int lane) {
    const int nblk = N / 32, kb = item / nblk, nb = item % nblk;
    tr_item(W, N, WT, K, 64 * kb, 32 * nb, 32 * nb, scr, lane);
}

__device__ __forceinline__ void s5_tables(const Params& p, Ctx& C, int dir, int g) {
    LAS f32x2* PW = (LAS f32x2*)C.lds;
    LAS f32x2* BB = PW + 65 * 64;
    LAS f32x2* CX = BB + 64 * 16;
    const float* a_re = p.inp(11); const float* a_im = p.inp(12); const float* log_dt = p.inp(13);
    const float* b_re = p.inp(14); const float* b_im = p.inp(15); const float* c_re = p.inp(16); const float* c_im = p.inp(17);
    const int tid = C.tid;
    if (tid < 64) {
        const int pp = tid;
        const float dt = __expf(log_dt[dir * 64 + g]);
        const float are = a_re[(dir * 64 + g) * 64 + pp], aim = a_im[(dir * 64 + g) * 64 + pp];
        const float zr = are * dt, zi = aim * dt;
        const float mag = __expf(zr);
        double rev = (double)zi * 0.15915494309189535; rev -= floor(rev);
        const float cs = __builtin_amdgcn_cosf((float)rev), sn = __builtin_amdgcn_sinf((float)rev);
        const float abr = mag * cs, abi = mag * sn;
        const float den = are * are + aim * aim, nr = abr - 1.0f, ni = abi;
        const float fre = (nr * are + ni * aim) / den, fim = (ni * are - nr * aim) / den;
        float pr = 1.0f, pi = 0.0f;
#pragma unroll 1
        for (int n = 0; n <= 64; ++n) { PW[n * 64 + pp] = (f32x2){pr, pi}; const float t = pr * abr - pi * abi; pi = pr * abi + pi * abr; pr = t; }
        for (int j = 0; j < 16; ++j) { const float br = b_re[(g * 64 + pp) * 16 + j], bi = b_im[(g * 64 + pp) * 16 + j];
            BB[pp * 16 + j] = (f32x2){fre * br - fim * bi, fre * bi + fim * br}; }
    }
    for (int q = tid; q < 1024; q += NTHR) { const int i = q >> 6, pp = q & 63; CX[i * 64 + pp] = (f32x2){c_re[(g * 16 + i) * 64 + pp], c_im[(g * 16 + i) * 64 + pp]}; }
    __syncthreads();
    bf16_t* KN = (bf16_t*)(p.ws + WS_KN) + (size_t)(dir * 64 + g) * 16 * 1024;
    float* APOW = (float*)(p.ws + WS_APOW) + (size_t)(dir * 64 + g) * 64 * 128;
    float* AL = (float*)(p.ws + WS_AL) + (size_t)(dir * 64 + g) * 128;
#pragma unroll 1
    for (int q = 0; q < 32; ++q) { const int idx = tid + NTHR * q; const int n = idx >> 8, i = (idx >> 4) & 15, j = idx & 15;
        float s = 0.f;
#pragma unroll 4
        for (int pp = 0; pp < 64; ++pp) { const f32x2 c = CX[i * 64 + pp], w = PW[n * 64 + pp], b = BB[pp * 16 + j];
            const float gr = c.x * b.x - c.y * b.y, gi = c.x * b.y + c.y * b.x;
            s += gr * w.x - gi * w.y; }
        KN[(size_t)i * 1024 + n * 16 + j] = f2bf(s); }
    for (int q = tid; q < 4096; q += NTHR) { const int t = q >> 6, pp = q & 63; const f32x2 w = PW[(t + 1) * 64 + pp]; *(f32x2*)(APOW + (size_t)t * 128 + 2 * pp) = w; }
    if (tid < 64) { const f32x2 w = PW[64 * 64 + tid]; *(f32x2*)(AL + 2 * tid) = w; }
    { bf16_t* BBT = (bf16_t*)(p.ws + WS_BBT) + (size_t)(dir * 64 + g) * 128 * 16;
      for (int q = tid; q < 2048; q += NTHR) { const int pq = q >> 4, j = q & 15; const f32x2 b = BB[(pq & 63) * 16 + j]; BBT[q] = f2bf(pq < 64 ? b.x : b.y); } }
    if (dir == 0) { bf16_t* CCt = (bf16_t*)(p.ws + WS_CC) + (size_t)g * 16 * 128;
        for (int q = tid; q < 2048; q += NTHR) { const int i = q >> 7, pq = q & 127; const f32x2 c = CX[i * 64 + (pq & 63)]; CCt[i * 128 + pq] = f2bf(pq < 64 ? c.x : -c.y); } }
    __syncthreads();
}

__device__ __forceinline__ void phase_p0(const Params& p, Ctx& C) {
    for (int task = C.bid; task < 128; task += C.G) s5_tables(p, C, task >> 6, task & 63);
    {
        const int gt = C.bid * NTHR + C.tid, ngt = C.G * NTHR;
        float* R128 = (float*)(p.ws + WS_ROPE128); float* R64 = (float*)(p.ws + WS_ROPE64);
        for (int q = gt; q < 256 * 64 + 256 * 32; q += ngt) {
            int pos, i, half; float* dst;
            if (q < 256 * 64) { pos = q >> 6; i = q & 63; half = 64; dst = R128 + (size_t)q * 2; }
            else { const int r = q - 256 * 64; pos = r >> 5; i = r & 31; half = 32; dst = R64 + (size_t)r * 2; }
            const float freq = exp2f(-(float)i / (float)half * 13.287712379549449f);
            const float ang = (float)pos * freq;
            double rev = (double)ang * 0.15915494309189535; rev -= floor(rev);
            dst[0] = __builtin_amdgcn_cosf((float)rev); dst[1] = __builtin_amdgcn_sinf((float)rev);
        }
        bf16_t* RWT = (bf16_t*)(p.ws + WS_RWT); const float* rw = p.inp(26);
        for (int q = gt; q < 2 * 64 * DM; q += ngt) { const int L = q / (64 * DM), r = q % (64 * DM), e = r / DM, k = r % DM;
            const float w = rw[((size_t)L * DM + k) * 64 + e]; const bf16_t hi = f2bf(w); const bf16_t lo = f2bf(w - bf2f(hi));
            RWT[((size_t)(L * 2 + 0) * 64 + e) * DM + k] = hi; RWT[((size_t)(L * 2 + 1) * 64 + e) * DM + k] = lo; }
    }
    {
        const float* cvec = p.inp(1); const float* cctx = p.inp(3); const float* mw = p.inp(4);
        float* MODP = (float*)(p.ws + WS_MODP);
        for (int task = C.gw; task < 2 * 32 * 48; task += C.ngw) {
            const int L = task / (32 * 48), r = task % (32 * 48), kb = r / 48, cb = r % 48;
            const float sc = siluf_(cvec[64 * kb + C.lane]), sx = siluf_(cctx[64 * kb + C.lane]);
            f32x4 a0 = {0.f, 0.f, 0.f, 0.f}, a1 = {0.f, 0.f, 0.f, 0.f};
            const float* wp = mw + ((size_t)L * DM + 64 * kb) * 12288 + 256 * cb + 4 * C.lane;
#pragma unroll 8
            for (int kk = 0; kk < 64; ++kk) { const f32x4 w = *(const f32x4*)(wp + (size_t)kk * 12288);
                const float s0 = __shfl(sc, kk), s1 = __shfl(sx, kk);
                a0 += w * s0; a1 += w * s1; }
            *(f32x4*)(MODP + ((size_t)((L * 32 + kb) * 2 + 0)) * 12288 + 256 * cb + 4 * C.lane) = a0;
            *(f32x4*)(MODP + ((size_t)((L * 32 + kb) * 2 + 1)) * 12288 + 256 * cb + 4 * C.lane) = a1;
        }
    }
    {
        LAS float* scr = (LAS float*)(C.lds + C.wave * 17408);
        constexpr int J0 = (DM / 64) * (EV_IN / 64), J3 = (DM / 64) * (OD_IN / 64);
        for (int it = C.gw; it < J0 + J3; it += C.ngw) {
            const bool l1 = it >= J0; const int r = l1 ? it - J0 : it; const int N = l1 ? OD_IN : EV_IN; const int nblk = N / 64, kb = r / nblk, nb = r % nblk;
            tr_item64_fp8(p.inp(l1 ? 21 : 8), N, (unsigned char*)(p.ws + (l1 ? WS_WIN1 : WS_WIN0)), DM, 64 * kb, 64 * nb, 64 * nb, scr, C.lane, 32.0f);
        }
        LAS float* scr2 = (LAS float*)(C.lds + C.wave * 17408);
        constexpr int I1 = (DM / 64) * (DM / 32), I2 = (1024 / 64) * (1024 / 32), I4 = I1;
        for (int it = C.gw; it < I1 + I2 + I4; it += C.ngw) {
            int r = it;
            if (r < I1) { tr_dense(p.inp(9), DM, DM, (bf16_t*)(p.ws + WS_WOUT0), r, scr2, C.lane); continue; } r -= I1;
            if (r < I2) { tr_dense(p.inp(19), 1024, 1024, (bf16_t*)(p.ws + WS_WGLU), r, scr2, C.lane); continue; } r -= I2;
            tr_dense(p.inp(22), DM, DM, (bf16_t*)(p.ws + WS_WOUT1), r, scr2, C.lane);
        }
    }
}
__device__ __forceinline__ void phase_p1(const Params& p, Ctx& C) {
    const float* MODP = (const float*)(p.ws + WS_MODP); float* MODF = (float*)(p.ws + WS_MODF); const float* mb = p.inp(5);
    for (int q = C.bid * NTHR + C.tid; q < 2 * 2 * 12288; q += C.G * NTHR) { const int L = q / (2 * 12288), v = (q / 12288) & 1, col = q % 12288;
        float s = mb[L * 12288 + col];
        for (int kb = 0; kb < 32; ++kb) s += MODP[((size_t)((L * 32 + kb) * 2 + v)) * 12288 + col];
        MODF[q] = s; }
}
__device__ __forceinline__ const float* modv(const Params& p, int L, int v, int k) { return (const float*)(p.ws + WS_MODF) + (size_t)(L * 2 + v) * 12288 + k * DM; }

__device__ __forceinline__ void stage_vec(LAS float* dst, const float* src, int tid) { *(LAS f32x4*)(dst + 4 * tid) = *(const f32x4*)(src + 4 * tid); }
__device__ __forceinline__ void conv_item(const Params& p, Ctx& C, int L, int it) {
    LAS float* scr = (LAS float*)(C.lds + C.wave * 17408);
    unsigned char* GU = (unsigned char*)(p.ws + WS_GU) + (size_t)L * NEX1 * 1024 * DM; unsigned char* DT = (unsigned char*)(p.ws + WS_DT) + (size_t)L * NEX1 * DM * EHID;
    const int e = it / 768, r = it % 768, which = r >> 8, q = r & 255;
    if (which < 2) {
        const float* W = (e < 64) ? p.inp(28 + which) + ((size_t)(L * 64 + e)) * DM * EHID : p.inp(31 + which) + (size_t)L * DM * EHID;
        const int kb = q >> 3, nb = q & 7, n0 = 64 * nb;
        tr_item64_fp8(W, EHID, GU + (size_t)e * 1024 * DM, DM, 64 * kb, n0, 256 * (n0 >> 7) + (n0 & 127) + (which ? 128 : 0), scr, C.lane);
    } else {
        const float* W = (e < 64) ? p.inp(30) + ((size_t)(L * 64 + e)) * EHID * DM : p.inp(33) + (size_t)L * EHID * DM;
        const int kb = q >> 5, nb = q & 31;
        tr_item64_fp8(W, DM, DT + (size_t)e * DM * EHID, EHID, 64 * kb, 64 * nb, 64 * nb, scr, C.lane);
    }
}
__device__ __forceinline__ void conv_queue(const Params& p, Ctx& C, int quota) {
    unsigned* head = (unsigned*)(p.ws + WS_CTL) + CW_QUEUE + 128;
    const int batch = quota < 8 ? quota : 8;
    for (int done = 0; done < quota; done += batch) {
        int it0 = 0; if (C.lane == 0) it0 = (int)atomicAdd(head, (unsigned)batch);
        it0 = __builtin_amdgcn_readfirstlane(it0);
        if (it0 >= NEX1 * 768) break;
        for (int k = 0; k < batch && it0 + k < NEX1 * 768; ++k) conv_item(p, C, 1, it0 + k);
    }
}
__device__ __forceinline__ void phase_modulate(const Params& p, Ctx& C, int L) {
    unsigned char* XA8 = (unsigned char*)(p.ws + WS_XA);
    const float* X2 = (const float*)(p.ws + WS_HX2);
    LAS float* MV = (LAS float*)C.lds;
    for (int v = 0; v < 2; ++v) { stage_vec(MV + (v * 2 + 0) * DM, modv(p, L, v, 0), C.tid); stage_vec(MV + (v * 2 + 1) * DM, modv(p, L, v, 1), C.tid); }
    __syncthreads();
    for (int r = C.gw; r < TT; r += C.ngw) {
        const int v = r < CTXL ? 1 : 0;
        const float* src = (L == 0) ? (r < CTXL ? p.inp(2) + (size_t)r * DM : p.inp(0) + (size_t)(r - CTXL) * DM) : X2 + (size_t)r * DM;
        const LAS float* sh = MV + (v * 2 + 0) * DM; const LAS float* sc = MV + (v * 2 + 1) * DM;
#pragma unroll
        for (int j = 0; j < 8; ++j) { const int c = 4 * (C.lane + 64 * j);
            const f32x4 x = *(const f32x4*)(src + c), a = *(const LAS f32x4*)(sc + c), b = *(const LAS f32x4*)(sh + c);
            const f32x4 y = x * (a + 1.0f) + b;
            unsigned w = (unsigned)__builtin_amdgcn_cvt_pk_fp8_f32(y[0], y[1], 0, false); w = (unsigned)__builtin_amdgcn_cvt_pk_fp8_f32(y[2], y[3], (int)w, true);
            *(unsigned*)(XA8 + (size_t)r * DM + c) = w; }
    }
    __syncthreads();
    if (L == 0) { for (int it = C.gw; it < NEX1 * 768; it += C.ngw) conv_item(p, C, 0, it); }
    else conv_queue(p, C, 1 << 30);
}

__device__ __forceinline__ void phase_rope0(const Params& p, Ctx& C) {
    bf16_t* QKV = (bf16_t*)(p.ws + WS_BIG + BG_QKV);
    const f32x2* R128 = (const f32x2*)(p.ws + WS_ROPE128);
    for (int r = C.gw; r < TT; r += C.ngw) {
        bf16_t* row = QKV + (size_t)r * EV_IN;
        if (r < CTXL) {
#pragma unroll
            for (int j = 0; j < 2; ++j) { u32x4* q = (u32x4*)(row + 8 * (C.lane + 64 * j)); u32x4 w = *q;
                w.x = cvt_pk_bf16(bflo(w.x) * 0.0625f, bfhi(w.x) * 0.0625f); w.y = cvt_pk_bf16(bflo(w.y) * 0.0625f, bfhi(w.y) * 0.0625f);
                w.z = cvt_pk_bf16(bflo(w.z) * 0.0625f, bfhi(w.z) * 0.0625f); w.w = cvt_pk_bf16(bflo(w.w) * 0.0625f, bfhi(w.w) * 0.0625f); *q = w; }
        } else {
            const int l = r - CTXL, rp = l >> 6, cp = l & 63;
#pragma unroll
            for (int qk = 0; qk < 2; ++qk)
#pragma unroll
                for (int m = 0; m < 8; ++m) { const int pi = C.lane + 64 * m, head = pi >> 7, blk = (pi >> 6) & 1, i = pi & 63;
                    bf16_t* b = row + qk * 1024 + head * 256 + blk * 128 + i;
                    const f32x2 cs = R128[(blk ? cp : rp) * 64 + i];
                    const float x1 = bf2f(b[0]), x2 = bf2f(b[64]); const float sc = qk ? 1.0f : 0.0625f;
                    b[0] = f2bf((x1 * cs.x - x2 * cs.y) * sc); b[64] = f2bf((x1 * cs.y + x2 * cs.x) * sc); }
        }
    }
}

__device__ __forceinline__ void phase_normrope1(const Params& p, Ctx& C) {
    bf16_t* QKV = (bf16_t*)(p.ws + WS_BIG + BG_QKV);
    const f32x2* R64 = (const f32x2*)(p.ws + WS_ROPE64);
    const float* qg = p.inp(23);
    unsigned* KMAX = (unsigned*)(p.ws + WS_CTL) + CW_KMAX;
    unsigned char* Q8 = (unsigned char*)(p.ws + WS_BIG + BG_Q8); unsigned char* K8 = (unsigned char*)(p.ws + WS_BIG + BG_K8); unsigned char* VT8 = (unsigned char*)(p.ws + WS_BIG + BG_VT8);
    unsigned char* Q8D = (unsigned char*)(p.ws + WS_BIG + BG_Q8D); unsigned char* K8D = (unsigned char*)(p.ws + WS_BIG + BG_K8D); unsigned char* VT8D = (unsigned char*)(p.ws + WS_BIG + BG_VT8D);
    const int lane = C.lane, i32 = lane & 31; const bool up = lane >= 32;
    const float g00 = qg[lane], g01 = qg[64 + lane], g10 = qg[128 + lane], g11 = qg[128 + 64 + lane];
    for (int r = C.gw; r < TT; r += C.ngw) {
        bf16_t* row = QKV + (size_t)r * OD_IN;
        const bool lat = r >= CTXL; const int l = r - CTXL, rp = lat ? (l >> 6) : 0, cp = lat ? (l & 63) : 0;
        const f32x2 cr = R64[rp * 32 + i32], cc = R64[cp * 32 + i32];
#pragma unroll 2
        for (int h = 0; h < 26; ++h) {
            const int col = h < 8 ? 128 * h : (h < 10 ? 1024 + 128 * (h - 8) : (h < 18 ? 1536 + 128 * (h - 10) : 2560 + 128 * (h - 18)));
            bf16_t* b = row + col;
            float v0 = bf2f(b[lane]), v1 = bf2f(b[64 + lane]);
            if (h < 10) { const float ss = wave_sum(v0 * v0 + v1 * v1); const float rs = rsqrtf(ss * (1.0f / 128.0f) + LN_EPS);
                v0 = bf2f(f2bf(v0 * rs)) * (h < 8 ? g00 : g10); v1 = bf2f(f2bf(v1 * rs)) * (h < 8 ? g01 : g11); }
            if (lat) { const float p0 = __shfl_xor(v0, 32), p1 = __shfl_xor(v1, 32);
                v0 = up ? (p0 * cr.y + v0 * cr.x) : (v0 * cr.x - p0 * cr.y);
                v1 = up ? (p1 * cc.y + v1 * cc.x) : (v1 * cc.x - p1 * cc.y); }
            const bf16_t o0 = f2bf(v0), o1 = f2bf(v1);
            b[lane] = o0; b[64 + lane] = o1;
            {
                const float w0 = bf2f(o0), w1 = bf2f(o1);
                float e4[4];
#pragma unroll
                for (int j = 0; j < 4; ++j) { const float a = __shfl(w0, (4 * lane + j) & 63), c2 = __shfl(w1, (4 * lane + j) & 63); e4[j] = lane < 16 ? a : c2; }
                unsigned pk = (unsigned)__builtin_amdgcn_cvt_pk_fp8_f32(e4[0], e4[1], 0, false); pk = (unsigned)__builtin_amdgcn_cvt_pk_fp8_f32(e4[2], e4[3], (int)pk, true);
                unsigned char* dst8 = h < 8 ? Q8 + (size_t)r * 1024 + 128 * h : (h < 10 ? K8 + (size_t)r * 256 + 128 * (h - 8) : (h < 18 ? Q8D + (size_t)r * 1024 + 128 * (h - 10) : K8D + (size_t)r * 1024 + 128 * (h - 18)));
                if (lane < 32) *(unsigned*)(dst8 + 4 * lane) = pk; }
            if ((h >= 8 && h < 10) || h >= 18) {
                const float w0 = bf2f(o0), w1 = bf2f(o1); const float k2 = wave_sum(w0 * w0 + w1 * w1);
                if (lane == 0) atomicMax(KMAX + 64 * (h < 10 ? h - 8 : h - 16), __float_as_uint(k2)); }
        }
    }
    LAS bf16_t* vt = (LAS bf16_t*)(C.lds + C.wave * 17408);
    for (int item = C.gw; item < 10 * 260; item += C.ngw) {
        const int kh = item / 260, T = item % 260;
        const int vcol = kh < 2 ? 1280 + 128 * kh : 3584 + 128 * (kh - 2);
        unsigned char* vout = kh < 2 ? VT8 + (size_t)kh * 260 * 8192 : VT8D + (size_t)(kh - 2) * 260 * 8192;
#pragma unroll
        for (int q = 0; q < 16; ++q) { const int idx = lane + 64 * q, key = idx >> 4, c = idx & 15;
            *(LAS u32x4*)(vt + key * 136 + 8 * c) = *(const u32x4*)(QKV + (size_t)(64 * T + key) * OD_IN + vcol + 8 * c); }
        LDS_WAIT(); asm volatile("" ::: "memory");
#pragma unroll
        for (int dd = 0; dd < 2; ++dd) { const int d = lane + 64 * dd;
            unsigned char* dst = vout + ((size_t)T * 128 + d) * 64;
#pragma unroll
            for (int cch = 0; cch < 4; ++cch) { u32x4 w;
#pragma unroll
                for (int wd = 0; wd < 4; ++wd) { float f[4];
#pragma unroll
                    for (int e = 0; e < 4; ++e) { const int bb = 16 * cch + 4 * wd + e, hi2 = bb >> 5, blk = (bb >> 4) & 1, j = bb & 15; const int key = 32 * blk + (j & 3) + 8 * (j >> 2) + 4 * hi2;
                        f[e] = bf2f(vt[key * 136 + d]); }
                    unsigned pk = (unsigned)__builtin_amdgcn_cvt_pk_fp8_f32(f[0], f[1], 0, false); pk = (unsigned)__builtin_amdgcn_cvt_pk_fp8_f32(f[2], f[3], (int)pk, true);
                    w[wd] = pk; }
                *(u32x4*)(dst + 16 * cch) = w; } }
        LDS_WAIT(); asm volatile("" ::: "memory");
    }
}

__device__ __forceinline__ void phase_merge1(const Params& p, Ctx& C) {
    bf16_t* ATT = (bf16_t*)(p.ws + WS_BIG + BG_ATT);
    const float* dl = p.inp(24); const float* sg = p.inp(25);
    const int lane = C.lane;
    float d0 = dl[lane] * dl[128 + lane] + dl[64 + lane] * dl[128 + 64 + lane];
    float d1 = dl[256 + lane] * dl[384 + lane] + dl[256 + 64 + lane] * dl[384 + 64 + lane];
    const float lam = __expf(wave_sum(d0)) - __expf(wave_sum(d1)) + LAMBDA_INIT;
    const f32x4 gg = *(const f32x4*)(sg + 4 * lane);
    for (int l = C.gw; l < SEQ; l += C.ngw) {
        bf16_t* row = ATT + (size_t)l * 3072;
#pragma unroll
        for (int h = 0; h < 4; ++h) {
            const u32x2 a = *(const u32x2*)(row + 1024 + 256 * h + 4 * lane), b = *(const u32x2*)(row + 2048 + 256 * h + 4 * lane);
            f32x4 o = {bflo(a.x) - lam * bflo(b.x), bfhi(a.x) - lam * bfhi(b.x), bflo(a.y) - lam * bflo(b.y), bfhi(a.y) - lam * bfhi(b.y)};
            const float ss = wave_sum(o[0] * o[0] + o[1] * o[1] + o[2] * o[2] + o[3] * o[3]);
            const float rs = rsqrtf(ss * (1.0f / 256.0f) + LN_EPS) * (1.0f - LAMBDA_INIT);
            o = o * rs * gg;
            u32x2 w; w.x = cvt_pk_bf16(o[0], o[1]); w.y = cvt_pk_bf16(o[2], o[3]);
            *(u32x2*)(row + 1024 + 256 * h + 4 * lane) = w;
        }
    }
}

__device__ __forceinline__ void phase_ln1(const Params& p, Ctx& C, int L) {
    const bf16_t* Y = (const bf16_t*)(p.ws + WS_YMIX); float* X1 = (float*)(p.ws + WS_X1); unsigned char* XA8 = (unsigned char*)(p.ws + WS_XA);
    const float* X2 = (const float*)(p.ws + WS_HX2);
    const float* lg = p.inp(6) + (size_t)(L * 2 + 0) * DM; const float* lb = p.inp(7) + (size_t)(L * 2 + 0) * DM;
    const int r0 = (L == 0) ? 0 : CTXL;
    LAS float* MV = (LAS float*)C.lds; LAS float* LG = MV + 6 * DM; LAS float* LB = LG + DM;
    for (int v = 0; v < 2; ++v) for (int k = 0; k < 3; ++k) stage_vec(MV + (v * 3 + k) * DM, modv(p, L, v, 2 + k), C.tid);
    stage_vec(LG, lg, C.tid); stage_vec(LB, lb, C.tid);
    __syncthreads();
    for (int r = r0 + C.gw; r < TT; r += C.ngw) {
        const int v = r < CTXL ? 1 : 0;
        const float* src = (L == 0) ? (r < CTXL ? p.inp(2) + (size_t)r * DM : p.inp(0) + (size_t)(r - CTXL) * DM) : X2 + (size_t)r * DM;
        const LAS float* g1 = MV + (v * 3 + 0) * DM; const LAS float* sh2 = MV + (v * 3 + 1) * DM; const LAS float* sc2 = MV + (v * 3 + 2) * DM;
        f32x4 t[8]; float s = 0.f;
#pragma unroll
        for (int j = 0; j < 8; ++j) { const int c = 4 * (C.lane + 64 * j);
            const f32x4 x = *(const f32x4*)(src + c), g = *(const LAS f32x4*)(g1 + c); const u32x2 yy = *(const u32x2*)(Y + (size_t)r * DM + c);
            const f32x4 y = {bflo(yy.x), bfhi(yy.x), bflo(yy.y), bfhi(yy.y)};
            t[j] = x * ALPHA + g * y; s += (t[j][0] + t[j][1]) + (t[j][2] + t[j][3]); }
        const float mean = wave_sum(s) * (1.0f / DM); float s2 = 0.f;
#pragma unroll
        for (int j = 0; j < 8; ++j) { t[j] = t[j] - mean; s2 += (t[j][0] * t[j][0] + t[j][1] * t[j][1]) + (t[j][2] * t[j][2] + t[j][3] * t[j][3]); }
        const float rstd = rsqrtf(wave_sum(s2) * (1.0f / DM) + LN_EPS);
#pragma unroll
        for (int j = 0; j < 8; ++j) { const int c = 4 * (C.lane + 64 * j);
            const f32x4 x1 = t[j] * rstd * *(const LAS f32x4*)(LG + c) + *(const LAS f32x4*)(LB + c);
            *(f32x4*)(X1 + (size_t)r * DM + c) = x1;
            const f32x4 z = x1 * (*(const LAS f32x4*)(sc2 + c) + 1.0f) + *(const LAS f32x4*)(sh2 + c);
            unsigned w = (unsigned)__builtin_amdgcn_cvt_pk_fp8_f32(z[0], z[1], 0, false); w = (unsigned)__builtin_amdgcn_cvt_pk_fp8_f32(z[2], z[3], (int)w, true);
            *(unsigned*)(XA8 + (size_t)r * DM + c) = w; }
    }
    __syncthreads();
}

__device__ __forceinline__ void phase_combine(const Params& p, Ctx& C, int L, LAS unsigned char* misc) {
    const unsigned char* YM = (const unsigned char*)(p.ws + WS_BIG + BG_YMOE); const float* X1 = (const float*)(p.ws + WS_X1);
    float* X2 = (float*)(p.ws + WS_HX2);
    const float* lg = p.inp(6) + (size_t)(L * 2 + 1) * DM; const float* lb = p.inp(7) + (size_t)(L * 2 + 1) * DM;
    const unsigned* PK = (const unsigned*)(p.ws + WS_WGT); const int* cnt = (const int*)(p.ws + WS_CTL) + CW_CNT + L * 128;
    const int r0 = (L == 0) ? 0 : CTXL;
    LAS int* rb = (LAS int*)(misc + 64);
    LAS float* MV = (LAS float*)C.lds; LAS float* LG = MV + 2 * DM; LAS float* LB = LG + DM;
    __syncthreads();
    if (C.tid == 0) { int q = 0; for (int e = 0; e < NEX1; ++e) { rb[e] = q; q += cnt[e]; } }
    stage_vec(MV, modv(p, L, 0, 5), C.tid); stage_vec(MV + DM, modv(p, L, 1, 5), C.tid); stage_vec(LG, lg, C.tid); stage_vec(LB, lb, C.tid);
    __syncthreads();
    for (int r = r0 + C.gw; r < TT; r += C.ngw) {
        const int v = r < CTXL ? 1 : 0;
        const LAS float* g2 = MV + v * DM;
        int ln = C.lane; asm volatile("" : "+v"(ln));
        int slot = rb[64] + (r - r0);
        if (ln < 8) { const unsigned pk = PK[(size_t)r * 8 + ln]; slot = rb[pk >> 16] + (int)(pk & 0xffffu); }
        f32x4 t[2][4]; float s = 0.f;
#pragma unroll
        for (int j = 0; j < 2; ++j) { const int c = 16 * (ln + 64 * j);
            u32x4 yy[9];
#pragma unroll
            for (int k = 0; k < 9; ++k) { const size_t a = (size_t)__builtin_amdgcn_readlane(slot, k); yy[k] = __builtin_nontemporal_load((const u32x4*)(YM + a * DM + c)); }
            f32x2 f[8];
#pragma unroll
            for (int q = 0; q < 8; ++q) f[q] = (f32x2){0.f, 0.f};
#pragma unroll
            for (int k = 0; k < 9; ++k) {
                f[0] += __builtin_amdgcn_cvt_pk_f32_fp8((int)yy[k].x, false); f[1] += __builtin_amdgcn_cvt_pk_f32_fp8((int)yy[k].x, true);
                f[2] += __builtin_amdgcn_cvt_pk_f32_fp8((int)yy[k].y, false); f[3] += __builtin_amdgcn_cvt_pk_f32_fp8((int)yy[k].y, true);
                f[4] += __builtin_amdgcn_cvt_pk_f32_fp8((int)yy[k].z, false); f[5] += __builtin_amdgcn_cvt_pk_f32_fp8((int)yy[k].z, true);
                f[6] += __builtin_amdgcn_cvt_pk_f32_fp8((int)yy[k].w, false); f[7] += __builtin_amdgcn_cvt_pk_f32_fp8((int)yy[k].w, true); }
#pragma unroll
            for (int q = 0; q < 4; ++q) { const f32x4 x = *(const f32x4*)(X1 + (size_t)r * DM + c + 4 * q), g = *(const LAS f32x4*)(g2 + c + 4 * q);
                const f32x4 ff = {f[2 * q][0], f[2 * q][1], f[2 * q + 1][0], f[2 * q + 1][1]};
                t[j][q] = x * ALPHA + g * ff; s += (t[j][q][0] + t[j][q][1]) + (t[j][q][2] + t[j][q][3]); } }
        const float mean = wave_sum(s) * (1.0f / DM); float s2 = 0.f;
#pragma unroll
        for (int j = 0; j < 2; ++j)
#pragma unroll
            for (int q = 0; q < 4; ++q) { t[j][q] = t[j][q] - mean; s2 += (t[j][q][0] * t[j][q][0] + t[j][q][1] * t[j][q][1]) + (t[j][q][2] * t[j][q][2] + t[j][q][3] * t[j][q][3]); }
        const float rstd = rsqrtf(wave_sum(s2) * (1.0f / DM) + LN_EPS);
        float* dst = (L == 0) ? X2 + (size_t)r * DM : p.out + (size_t)(r - CTXL) * DM;
#pragma unroll
        for (int j = 0; j < 2; ++j)
#pragma unroll
            for (int q = 0; q < 4; ++q) { const int c = 16 * (ln + 64 * j) + 4 * q;
                *(f32x4*)(dst + c) = t[j][q] * rstd * *(const LAS f32x4*)(LG + c) + *(const LAS f32x4*)(LB + c); }
    }
}
constexpr int RLD = 264;
constexpr int SLD = 136;

template <bool SCALE>
__device__ __forceinline__ void stage_chunk(const bf16_t* QKV, int row0, int col0, LAS bf16_t* dst, int tid, float lg  , int dirb) {
#pragma unroll
    for (int q = 0; q < 8; ++q) { const int idx = tid + NTHR * q, r = idx >> 5, c = idx & 31;
        u32x4 w = *(const u32x4*)(QKV + (size_t)(row0 + r) * EV_IN + col0 + 8 * c);
        if (SCALE) { const float sc = fast_exp((dirb ? (float)r : (float)(127 - r)) * lg);
            w.x = cvt_pk_bf16(bflo(w.x) * sc, bfhi(w.x) * sc); w.y = cvt_pk_bf16(bflo(w.y) * sc, bfhi(w.y) * sc);
            w.z = cvt_pk_bf16(bflo(w.z) * sc, bfhi(w.z) * sc); w.w = cvt_pk_bf16(bflo(w.w) * sc, bfhi(w.w) * sc); }
        *(LAS u32x4*)(dst + r * RLD + 8 * c) = w; }
}

__device__ __forceinline__ void ret_chunk_kv(const Params& p, Ctx& C) {
    const bf16_t* QKV = (const bf16_t*)(p.ws + WS_BIG + BG_QKV); bf16_t* CKV = (bf16_t*)(p.ws + WS_BIG + BG_CKV);
    const float* rld = p.inp(10);
    LAS bf16_t* Vs = (LAS bf16_t*)C.lds; LAS bf16_t* Ks = Vs + 128 * RLD;
    const int lane = C.lane, w = C.wave;
    for (int unit = C.bid; unit < 130 * 8; unit += C.G) {
        const int u = unit >> 3, h = (unit >> 1) & 3, dir = unit & 1;
        const float lg = rld[dir * 4 + h];
        __syncthreads();
        stage_chunk<false>(QKV, 128 * u, 2048 + 256 * h, Vs, C.tid, 0.f, 0);
        stage_chunk<true>(QKV, 128 * u, 1024 + 256 * h, Ks, C.tid, lg, dir);
        __syncthreads();
        f32x4 acc[2][16];
#pragma unroll
        for (int a = 0; a < 2; ++a)
#pragma unroll
            for (int b = 0; b < 16; ++b) acc[a][b] = (f32x4){0.f, 0.f, 0.f, 0.f};
        const unsigned vbase = (unsigned)(uintptr_t)Vs, kbase = (unsigned)(uintptr_t)Ks;
#pragma unroll 1
        for (int ks = 0; ks < 4; ++ks) {
            bf16x8 af[2];
#pragma unroll
            for (int a = 0; a < 2; ++a) af[a] = frag_colk_l(vbase + (unsigned)((32 * ks) * RLD + 32 * w + 16 * a) * 2u, RLD * 2, lane);
#pragma unroll
            for (int b = 0; b < 16; ++b) { const bf16x8 bf = frag_colk_l(kbase + (unsigned)((32 * ks) * RLD + 16 * b) * 2u, RLD * 2, lane);
                acc[0][b] = MFMA16(bf, af[0], acc[0][b]); acc[1][b] = MFMA16(bf, af[1], acc[1][b]); }
        }
        bf16_t* dst = CKV + ((size_t)((dir * 4 + h) * 130 + u)) * 65536;
#pragma unroll
        for (int a = 0; a < 2; ++a)
#pragma unroll
            for (int b = 0; b < 16; ++b) { u32x2 w2; w2.x = cvt_pk_bf16(acc[a][b][0], acc[a][b][1]); w2.y = cvt_pk_bf16(acc[a][b][2], acc[a][b][3]);
                *(u32x2*)(dst + (size_t)(32 * w + 16 * a + (lane & 15)) * 256 + 16 * b + 4 * (lane >> 4)) = w2; }
    }
    __syncthreads();
}

__device__ __forceinline__ int s5_row(int dir, int c, int s) { return dir == 0 ? 64 * c + s : (c < 4 ? 255 - (64 * c + s) : 16639 - 64 * (c - 4) - s); }

__device__ __forceinline__ void s5_end_states(const Params& p, Ctx& C) {
    const bf16_t* QKV = (const bf16_t*)(p.ws + WS_BIG + BG_QKV); const bf16_t* BBT = (const bf16_t*)(p.ws + WS_BBT); float* E = (float*)(p.ws + WS_S5E);
    const float* APOW = (const float*)(p.ws + WS_APOW);
    LAS f32x2* PL = (LAS f32x2*)C.lds;
    for (int bt = C.bid; bt < 256; bt += C.G) {
        int tid = C.tid; asm volatile("" : "+v"(tid));
        const int lane = tid & 63, r32 = lane & 31, hi = lane >> 5;
        const int dg = bt >> 1, dir = dg >> 6, g = dg & 63, c0 = 130 * (bt & 1);
        __syncthreads();
#pragma unroll
        for (int q = 0; q < 8; ++q) { const int idx = tid + NTHR * q, s = idx >> 6, pp = idx & 63;
            PL[idx] = (s == 63) ? (f32x2){1.0f, 0.0f} : *(const f32x2*)(APOW + ((size_t)dg * 64 + (62 - s)) * 128 + 2 * pp); }
        __syncthreads();
        bf16x8 bfr[4];
#pragma unroll
        for (int pt = 0; pt < 4; ++pt) bfr[pt] = *(const bf16x8*)(BBT + ((size_t)dg * 128 + 32 * pt + r32) * 16 + 8 * hi);
        for (int c = c0 + C.wave; c < c0 + 130; c += 8) {
            float er[2] = {0.f, 0.f}, ei[2] = {0.f, 0.f};
#pragma unroll
            for (int st = 0; st < 2; ++st) {
                const bf16x8 a = *(const bf16x8*)(QKV + (size_t)s5_row(dir, c, 32 * st + r32) * EV_IN + 4096 + 16 * g + 8 * hi);
                f32x16 d[4];
#pragma unroll
                for (int pt = 0; pt < 4; ++pt) d[pt] = __builtin_amdgcn_mfma_f32_32x32x16_bf16(a, bfr[pt], (f32x16){}, 0, 0, 0);
#pragma unroll
                for (int r = 0; r < 16; ++r) { const int s = 32 * st + (r & 3) + 8 * (r >> 2) + 4 * hi;
#pragma unroll
                    for (int pt = 0; pt < 2; ++pt) { const f32x2 pw = PL[s * 64 + 32 * pt + r32]; const float br = d[pt][r], bi = d[pt + 2][r];
                        er[pt] += pw.x * br - pw.y * bi; ei[pt] += pw.x * bi + pw.y * br; } }
            }
#pragma unroll
            for (int pt = 0; pt < 2; ++pt) {
                { auto rr = __builtin_amdgcn_permlane32_swap(__float_as_uint(er[pt]), __float_as_uint(er[pt]), false, false); er[pt] = __uint_as_float(rr[0]) + __uint_as_float(rr[1]); }
                { auto rr = __builtin_amdgcn_permlane32_swap(__float_as_uint(ei[pt]), __float_as_uint(ei[pt]), false, false); ei[pt] = __uint_as_float(rr[0]) + __uint_as_float(rr[1]); }
            }
            float* dst = E + ((size_t)dg * 260 + c) * 128;
            if (hi == 0) { dst[r32] = er[0]; dst[32 + r32] = er[1]; dst[64 + r32] = ei[0]; dst[96 + r32] = ei[1]; }
        }
    }
    __syncthreads();
}

__device__ __forceinline__ void phase_scans(const Params& p, Ctx& C) {
    const bf16_t* CKV = (const bf16_t*)(p.ws + WS_BIG + BG_CKV); bf16_t* SP = (bf16_t*)(p.ws + WS_BIG + BG_SPREV);
    const float* rld = p.inp(10);
    for (int q = C.bid * NTHR + C.tid; q < 8 * 16384; q += C.G * NTHR) {
        const int dh = q >> 14, el = (q & 16383) * 4, dir = dh >> 2, h = dh & 3;
        const float gch = fast_exp(128.0f * rld[dir * 4 + h]);
        const bf16_t* src = CKV + (size_t)dh * 130 * 65536 + el; bf16_t* dst = SP + (size_t)dh * 130 * 65536 + el;
        f32x4 s = {0.f, 0.f, 0.f, 0.f};
        for (int st0 = 0; st0 < 130; st0 += 13) {
            u32x2 kv[13];
#pragma unroll
            for (int k = 0; k < 13; ++k) { const int st = st0 + k; const int u = dir == 0 ? st : (st == 0 ? 1 : (st == 1 ? 0 : 131 - st)); kv[k] = __builtin_nontemporal_load((const u32x2*)(src + (size_t)u * 65536)); }
#pragma unroll
            for (int k = 0; k < 13; ++k) { const int st = st0 + k; const int u = dir == 0 ? st : (st == 0 ? 1 : (st == 1 ? 0 : 131 - st));
                u32x2 w; w.x = cvt_pk_bf16(s[0], s[1]); w.y = cvt_pk_bf16(s[2], s[3]); *(u32x2*)(dst + (size_t)u * 65536) = w;
                s = s * gch + (f32x4){bflo(kv[k].x), bfhi(kv[k].x), bflo(kv[k].y), bfhi(kv[k].y)}; }
        }
    }
    const float* E = (const float*)(p.ws + WS_S5E); float* HST = (float*)(p.ws + WS_HST); const float* AL = (const float*)(p.ws + WS_AL);
    for (int q = C.bid * NTHR + C.tid; q < 2 * 64 * 64; q += C.G * NTHR) {
        const int dg = q >> 6, pp = q & 63;
        const f32x2 al = *(const f32x2*)(AL + (size_t)dg * 128 + 2 * pp);
        const float* e = E + (size_t)dg * 260 * 128; float* hs = HST + (size_t)dg * 260 * 128;
        float hr = 0.f, hi = 0.f;
        for (int c0 = 0; c0 < 260; c0 += 26) {
            float er[26], ei[26];
#pragma unroll
            for (int k = 0; k < 26; ++k) { er[k] = e[(size_t)(c0 + k) * 128 + pp]; ei[k] = e[(size_t)(c0 + k) * 128 + 64 + pp]; }
#pragma unroll
            for (int k = 0; k < 26; ++k) { *(f32x2*)(hs + (size_t)(c0 + k) * 128 + 2 * pp) = (f32x2){hr, hi};
                const float t = al.x * hr - al.y * hi + er[k]; hi = al.x * hi + al.y * hr + ei[k]; hr = t; }
        }
    }
}

__device__ __forceinline__ void ret_output_unit(const Params& p, Ctx& C, int unit) {
    const bf16_t* QKV = (const bf16_t*)(p.ws + WS_BIG + BG_QKV); const bf16_t* SP = (const bf16_t*)(p.ws + WS_BIG + BG_SPREV);
    bf16_t* MIX = (bf16_t*)(p.ws + WS_BIG + BG_MIX);
    const float* rld = p.inp(10);
    LAS bf16_t* RA = (LAS bf16_t*)C.lds; LAS bf16_t* RB = RA + 128 * RLD;
    int tid = C.tid; asm volatile("" : "+v"(tid));
    const int lane = tid & 63, w = C.wave, kq = lane >> 4, fr = lane & 15;
    const int u = unit >> 2, h = unit & 3;
    const float lgf = rld[h], lgb = rld[4 + h];
    stage_chunk<false>(QKV, 128 * u, 256 * h, RA, tid, 0.f, 0);
    int ib = 16 * w + 4 * kq, jb = fr; asm volatile("" : "+v"(ib), "+v"(jb));
    f32x4 acc[16];
#pragma unroll
    for (int t = 0; t < 16; ++t) acc[t] = (f32x4){0.f, 0.f, 0.f, 0.f};
#pragma unroll
    for (int dir = 0; dir < 2; ++dir) {
        const bf16_t* Sd = SP + ((size_t)((dir * 4 + h) * 130 + u)) * 65536;
#pragma unroll
        for (int eh = 0; eh < 2; ++eh) {
            __syncthreads();
#pragma unroll
            for (int q = 0; q < 8; ++q) { const int idx = tid + NTHR * q, rr = idx >> 5, c = idx & 31;
                *(LAS u32x4*)(RB + rr * RLD + 8 * c) = *(const u32x4*)(Sd + (size_t)(128 * eh + rr) * 256 + 8 * c);
                if (q == 3) asm volatile("" ::: "memory"); }
            __syncthreads();
#pragma unroll 1
            for (int ks = 0; ks < 8; ++ks) { const bf16x8 af = frag_rowk_l(RA + (16 * w) * RLD + 32 * ks, RLD, lane);
#pragma unroll
                for (int t = 0; t < 8; ++t) { const bf16x8 bf = frag_rowk_l(RB + (16 * t) * RLD + 32 * ks, RLD, lane); acc[8 * eh + t] = MFMA16(af, bf, acc[8 * eh + t]); } }
        }
#pragma unroll
        for (int r = 0; r < 4; ++r) { const int i = ib + r; const float qd = fast_exp((float)(128 - i) * lgb);
            const float f = (dir == 0) ? fast_exp((float)(i + 1) * lgf) / qd : qd;
#pragma unroll
            for (int t = 0; t < 16; ++t) acc[t][r] *= f; }
    }
    __syncthreads();
    stage_chunk<false>(QKV, 128 * u, 1024 + 256 * h, RB, tid, 0.f, 0);
    __syncthreads();
    f32x4 sc[8];
#pragma unroll
    for (int t = 0; t < 8; ++t) sc[t] = (f32x4){0.f, 0.f, 0.f, 0.f};
#pragma unroll 1
    for (int ks = 0; ks < 8; ++ks) { const bf16x8 af = frag_rowk_l(RA + (16 * w) * RLD + 32 * ks, RLD, lane);
#pragma unroll
        for (int t = 0; t < 8; ++t) { const bf16x8 bf = frag_rowk_l(RB + (16 * t) * RLD + 32 * ks, RLD, lane); sc[t] = MFMA16(af, bf, sc[t]); } }
#pragma unroll
    for (int t = 0; t < 8; ++t)
#pragma unroll
        for (int r = 0; r < 4; ++r) { const int i = ib + r, j = 16 * t + jb; const float d = (float)(i - j);
            const float m = (i >= j ? fast_exp(d * lgf) : 0.f) + (j >= i ? fast_exp(-d * lgb) : 0.f); sc[t][r] *= m; }
    __syncthreads();
    stage_chunk<false>(QKV, 128 * u, 2048 + 256 * h, RA, tid, 0.f, 0);
#pragma unroll
    for (int t = 0; t < 8; ++t)
#pragma unroll
        for (int r = 0; r < 4; ++r) RB[(16 * w + 4 * kq + r) * SLD + 16 * t + fr] = f2bf(sc[t][r]);
    __syncthreads();
    const unsigned vbase = (unsigned)(uintptr_t)RA;
#pragma unroll 1
    for (int ks = 0; ks < 4; ++ks) { const bf16x8 af = frag_rowk_l(RB + (16 * w) * SLD + 32 * ks, SLD, lane);
#pragma unroll
        for (int t = 0; t < 16; ++t) { const bf16x8 bf = frag_colk_l(vbase + (unsigned)((32 * ks) * RLD + 16 * t) * 2u, RLD * 2, lane); acc[t] = MFMA16(af, bf, acc[t]); } }
    __syncthreads();
#pragma unroll
    for (int r = 0; r < 4; ++r) {
        float s = 0.f;
#pragma unroll
        for (int t = 0; t < 16; ++t) s += acc[t][r];
        s += __shfl_xor(s, 1); s += __shfl_xor(s, 2); s += __shfl_xor(s, 4); s += __shfl_xor(s, 8);
        const float mean = s * (1.0f / 256.0f); float q = 0.f;
#pragma unroll
        for (int t = 0; t < 16; ++t) { const float d = acc[t][r] - mean; q += d * d; }
        q += __shfl_xor(q, 1); q += __shfl_xor(q, 2); q += __shfl_xor(q, 4); q += __shfl_xor(q, 8);
        const float rstd = rsqrtf(q * (1.0f / 256.0f) + LN_EPS);
#pragma unroll
        for (int t = 0; t < 16; ++t) RA[(16 * w + 4 * kq + r) * RLD + 16 * t + fr] = f2bf((acc[t][r] - mean) * rstd);
    }
    __syncthreads();
#pragma unroll
    for (int q = 0; q < 8; ++q) { const int idx = tid + NTHR * q, rr = idx >> 5, c = idx & 31; const size_t row = (size_t)(128 * u + rr);
        const u32x4 o = *(const LAS u32x4*)(RA + rr * RLD + 8 * c), g = *(const u32x4*)(QKV + row * EV_IN + 3072 + 256 * h + 8 * c);
        u32x4 w4;
        w4.x = cvt_pk_bf16(bflo(o.x) * siluf_(bflo(g.x)), bfhi(o.x) * siluf_(bfhi(g.x))); w4.y = cvt_pk_bf16(bflo(o.y) * siluf_(bflo(g.y)), bfhi(o.y) * siluf_(bfhi(g.y)));
        w4.z = cvt_pk_bf16(bflo(o.z) * siluf_(bflo(g.z)), bfhi(o.z) * siluf_(bfhi(g.z))); w4.w = cvt_pk_bf16(bflo(o.w) * siluf_(bflo(g.w)), bfhi(o.w) * siluf_(bfhi(g.w)));
        *(u32x4*)(MIX + row * DM + 256 * h + 8 * c) = w4; }
    __syncthreads();
}

constexpr int KLD = 1032;
__device__ __forceinline__ void s5_output_task(const Params& p, Ctx& C, int bt) {
    const bf16_t* QKV = (const bf16_t*)(p.ws + WS_BIG + BG_QKV); bf16_t* Z = (bf16_t*)(p.ws + WS_Z);
    const bf16_t* KN = (const bf16_t*)(p.ws + WS_KN); const bf16_t* CCt = (const bf16_t*)(p.ws + WS_CC);
    const float* APOW = (const float*)(p.ws + WS_APOW); const float* HST = (const float*)(p.ws + WS_HST); const float* dsk = p.inp(18);
    int tid = C.tid; asm volatile("" : "+v"(tid));
    const int lane = tid & 63, kq = lane >> 4, fr = lane & 15;
    LAS bf16_t* KF = (LAS bf16_t*)C.lds; LAS bf16_t* KB = KF + 16 * KLD;
    LAS bf16_t* U = KB + 16 * KLD + C.wave * 3072;
    LAS float* PW0 = (LAS float*)(KB + 16 * KLD + 8 * 3072);
    LAS float* PW16 = PW0 + 2 * 16 * 128;
    {
        const int g = bt >> 3, k0 = (260 * (bt & 7)) >> 3, k1 = (260 * ((bt & 7) + 1)) >> 3;
#pragma unroll
        for (int q = 0; q < 8; ++q) { const int idx = tid + NTHR * q, dir = idx >> 11, rr = (idx >> 7) & 15, c = idx & 127;
            *(LAS u32x4*)((dir ? KB : KF) + rr * KLD + 8 * c) = *(const u32x4*)(KN + ((size_t)(dir * 64 + g) * 16 + rr) * 1024 + 8 * c); }
        for (int q = lane; q < 192 * 2; q += 64) *(LAS u32x4*)(U + 8 * q) = (u32x4){0u, 0u, 0u, 0u};
#pragma unroll
        for (int q = 0; q < 2; ++q) { const int idx = tid + NTHR * q, dir = idx >> 9, f = (idx >> 5) & 15, c4 = idx & 31;
            *(LAS f32x4*)(PW0 + dir * 2048 + f * 128 + 4 * c4) = *(const f32x4*)(APOW + ((size_t)(dir * 64 + g) * 64 + (dir == 0 ? f : 15 - f)) * 128 + 4 * c4); }
        if (tid < 64) { const int dir = tid >> 5, c4 = tid & 31; *(LAS f32x4*)(PW16 + dir * 128 + 4 * c4) = *(const f32x4*)(APOW + ((size_t)(dir * 64 + g) * 64 + 15) * 128 + 4 * c4); }
        __syncthreads();
        const f32x4 dv = *(const f32x4*)(dsk + 16 * g + 4 * kq);
        bf16x8 ccr[2], cci[2];
#pragma unroll
        for (int hb = 0; hb < 2; ++hb) { ccr[hb] = frag_rowk_g(CCt + (size_t)g * 16 * 128 + 32 * hb, 128, lane); cci[hb] = frag_rowk_g(CCt + (size_t)g * 16 * 128 + 64 + 32 * hb, 128, lane); }
        const LAS float* pw0l = PW0 + (size_t)fr * 128 + 16 * kq;
        const LAS float* pw16l = PW16 + 16 * kq;
        for (int k = k0 + C.wave; k < k1; k += 8) {
            LDS_WAIT(); asm volatile("" ::: "memory");
            for (int q = lane; q < 128; q += 64) { const int t = q >> 1, hf = q & 1;
                *(LAS u32x4*)(U + (64 + t) * 16 + 8 * hf) = *(const u32x4*)(QKV + (size_t)(64 * k + t) * EV_IN + 4096 + 16 * g + 8 * hf); }
            LDS_WAIT(); asm volatile("" ::: "memory");
            const int cf = k, cb = k < 4 ? 3 - k : 263 - k;
            f32x4 acc[4];
#pragma unroll
            for (int tt = 0; tt < 4; ++tt) acc[tt] = (f32x4){0.f, 0.f, 0.f, 0.f};
            const LAS bf16_t* ubf = U + (64 + fr - (kq >> 1)) * 16 + 8 * (kq & 1);
            const LAS bf16_t* ubb = U + (64 + fr + (kq >> 1)) * 16 + 8 * (kq & 1);
#pragma unroll
            for (int n0 = 0; n0 < 64; n0 += 2) {
                const bf16x8 af = frag_rowk_l(KF + n0 * 16, KLD, lane), ab = frag_rowk_l(KB + n0 * 16, KLD, lane);
#pragma unroll
                for (int tt = 0; tt < 4; ++tt) {
                    if (n0 <= 16 * tt + 14) acc[tt] = MFMA16(af, *(const LAS bf16x8*)(ubf + (16 * tt - n0) * 16), acc[tt]);
                    if (n0 <= 62 - 16 * tt) acc[tt] = MFMA16(ab, *(const LAS bf16x8*)(ubb + (16 * tt + n0) * 16), acc[tt]);
                }
                asm volatile("" ::: "memory");
            }
#pragma unroll
            for (int dir = 0; dir < 2; ++dir) {
                const float* hp = HST + ((size_t)(dir * 64 + g) * 260 + (dir == 0 ? cf : cb)) * 128;
#pragma unroll
                for (int hb = 0; hb < 2; ++hb) {
                    float xr[8], xi[8];
#pragma unroll
                    for (int e2 = 0; e2 < 4; ++e2) { const f32x4 h4 = *(const f32x4*)(hp + 2 * (32 * hb + 8 * kq) + 4 * e2), b4 = *(const LAS f32x4*)(pw0l + dir * 2048 + hb * 64 + 4 * e2);
                        xr[2 * e2] = b4[0] * h4[0] - b4[1] * h4[1]; xi[2 * e2] = b4[0] * h4[1] + b4[1] * h4[0];
                        xr[2 * e2 + 1] = b4[2] * h4[2] - b4[3] * h4[3]; xi[2 * e2 + 1] = b4[2] * h4[3] + b4[3] * h4[2]; }
#pragma unroll
                    for (int st = 0; st < 4; ++st) {
                        const int tt = dir == 0 ? st : 3 - st;
                        u32x4 br, bi;
                        br.x = cvt_pk_bf16(xr[0], xr[1]); br.y = cvt_pk_bf16(xr[2], xr[3]); br.z = cvt_pk_bf16(xr[4], xr[5]); br.w = cvt_pk_bf16(xr[6], xr[7]);
                        bi.x = cvt_pk_bf16(xi[0], xi[1]); bi.y = cvt_pk_bf16(xi[2], xi[3]); bi.z = cvt_pk_bf16(xi[4], xi[5]); bi.w = cvt_pk_bf16(xi[6], xi[7]);
                        acc[tt] = MFMA16(ccr[hb], __builtin_bit_cast(bf16x8, br), acc[tt]);
                        acc[tt] = MFMA16(cci[hb], __builtin_bit_cast(bf16x8, bi), acc[tt]);
                        if (st < 3) {
#pragma unroll
                            for (int e2 = 0; e2 < 4; ++e2) { const f32x4 a4 = *(const LAS f32x4*)(pw16l + dir * 128 + hb * 64 + 4 * e2);
                                float t0 = xr[2 * e2] * a4[0] - xi[2 * e2] * a4[1]; xi[2 * e2] = xr[2 * e2] * a4[1] + xi[2 * e2] * a4[0]; xr[2 * e2] = t0;
                                t0 = xr[2 * e2 + 1] * a4[2] - xi[2 * e2 + 1] * a4[3]; xi[2 * e2 + 1] = xr[2 * e2 + 1] * a4[3] + xi[2 * e2 + 1] * a4[2]; xr[2 * e2 + 1] = t0; }
                        }
                    }
                }
            }
#pragma unroll
            for (int tt = 0; tt < 4; ++tt) { const int t = 16 * tt + fr;
                const u32x2 uu = *(const LAS u32x2*)(U + (64 + t) * 16 + 4 * kq);
                const float y0 = acc[tt][0] + bflo(uu.x) * dv[0], y1 = acc[tt][1] + bfhi(uu.x) * dv[1], y2 = acc[tt][2] + bflo(uu.y) * dv[2], y3 = acc[tt][3] + bfhi(uu.y) * dv[3];
                u32x2 w; w.x = cvt_pk_bf16(gelu_tanh(y0), gelu_tanh(y1)); w.y = cvt_pk_bf16(gelu_tanh(y2), gelu_tanh(y3));
                *(u32x2*)(Z + (size_t)(64 * k + t) * 1024 + 16 * g + 4 * kq) = w; }
        }
    }
    __syncthreads();
}

__device__ __forceinline__ void phase_ret_s5_outputs(const Params& p, Ctx& C, LAS unsigned char* misc) {
    unsigned* head = (unsigned*)(p.ws + WS_CTL) + CW_QUEUE;
    volatile LAS int* slot = (volatile LAS int*)(misc + 32);
    for (;;) {
        __syncthreads();
        if (C.tid == 0) slot[0] = (int)atomicAdd(head, 1u);
        __syncthreads();
        const int item = __builtin_amdgcn_readfirstlane(slot[0]);
        if (item >= 520) break;
        ret_output_unit(p, C, item);
    }
    for (;;) {
        __syncthreads();
        if (C.tid == 0) slot[0] = (int)atomicAdd(head + 64, 1u);
        __syncthreads();
        const int item = __builtin_amdgcn_readfirstlane(slot[0]);
        if (item >= 512) break;
        s5_output_task(p, C, item);
    }
}
__device__ __forceinline__ void phase_router(const Params& p, Ctx& C, int L) {
    const float* X1 = (const float*)(p.ws + WS_X1);
    const bf16_t* RWh = (const bf16_t*)(p.ws + WS_RWT) + (size_t)(L * 2 + 0) * 64 * DM; const bf16_t* RWl = (const bf16_t*)(p.ws + WS_RWT) + (size_t)(L * 2 + 1) * 64 * DM;
    const float* rbias = p.inp(27) + L * 64;
    int* cnt = (int*)(p.ws + WS_CTL) + CW_CNT + L * 128; int* LIST = (int*)(p.ws + WS_LIST); unsigned* PK = (unsigned*)(p.ws + WS_WGT); float* LW = (float*)(p.ws + WS_LW);
    const int lane = C.lane, kq = lane >> 4, fr = lane & 15;
    LAS float* Lg = (LAS float*)(C.lds + C.wave * 8192);
    const int r0 = (L == 0) ? 0 : CTXL, nrows = TT - r0;
    if (C.bid == 0 && C.tid == 0) cnt[64] = nrows;
    for (int task = C.gw; task < nrows / 16; task += C.ngw) {
        const int rbase = r0 + 16 * task, row = rbase + fr;
        const int v = row < CTXL ? 1 : 0;
        const float* xr = X1 + (size_t)row * DM; const float* sc2 = modv(p, L, v, 4); const float* sh2 = modv(p, L, v, 3);
        f32x4 acc[4];
#pragma unroll
        for (int t = 0; t < 4; ++t) acc[t] = (f32x4){0.f, 0.f, 0.f, 0.f};
#pragma unroll 2
        for (int ks = 0; ks < 64; ++ks) { const int c0 = 32 * ks + 8 * kq;
            const f32x4 x0 = *(const f32x4*)(xr + c0), x1 = *(const f32x4*)(xr + c0 + 4);
            const f32x4 a0 = *(const f32x4*)(sc2 + c0), a1 = *(const f32x4*)(sc2 + c0 + 4), b0 = *(const f32x4*)(sh2 + c0), b1 = *(const f32x4*)(sh2 + c0 + 4);
            const f32x4 y0 = x0 * (a0 + 1.0f) + b0, y1 = x1 * (a1 + 1.0f) + b1;
            u32x4 hi; hi.x = cvt_pk_bf16(y0[0], y0[1]); hi.y = cvt_pk_bf16(y0[2], y0[3]); hi.z = cvt_pk_bf16(y1[0], y1[1]); hi.w = cvt_pk_bf16(y1[2], y1[3]);
            u32x4 lo; lo.x = cvt_pk_bf16(y0[0] - bflo(hi.x), y0[1] - bfhi(hi.x)); lo.y = cvt_pk_bf16(y0[2] - bflo(hi.y), y0[3] - bfhi(hi.y));
            lo.z = cvt_pk_bf16(y1[0] - bflo(hi.z), y1[1] - bfhi(hi.z)); lo.w = cvt_pk_bf16(y1[2] - bflo(hi.w), y1[3] - bfhi(hi.w));
            const bf16x8 ah = __builtin_bit_cast(bf16x8, hi), al = __builtin_bit_cast(bf16x8, lo);
#pragma unroll
            for (int t = 0; t < 4; ++t) { const bf16x8 bh = frag_rowk_g(RWh + (size_t)(16 * t) * DM + 32 * ks, DM, lane), bl = frag_rowk_g(RWl + (size_t)(16 * t) * DM + 32 * ks, DM, lane);
                acc[t] = MFMA16(ah, bh, acc[t]); acc[t] = MFMA16(al, bh, acc[t]); acc[t] = MFMA16(ah, bl, acc[t]); } }
        LDS_WAIT(); asm volatile("" ::: "memory");
#pragma unroll
        for (int t = 0; t < 4; ++t)
#pragma unroll
            for (int r = 0; r < 4; ++r) Lg[(4 * kq + r) * 65 + 16 * t + fr] = acc[t][r];
        LDS_WAIT(); asm volatile("" ::: "memory");
        if (lane < 16) {
            LAS float* sr = Lg + lane * 65; const int trow = rbase + lane;
            float gs[8];
#pragma unroll
            for (int g = 0; g < 8; ++g) { float m1 = -1e30f, m2 = -1e30f;
                for (int j = 0; j < 8; ++j) { const int e = 8 * g + j; const float s = sigmoidf_(sr[e]); sr[e] = s; const float vv = s + rbias[e];
                    if (vv > m1) { m2 = m1; m1 = vv; } else if (vv > m2) m2 = vv; }
                gs[g] = m1 + m2; }
            unsigned gmask = 0u;
#pragma unroll
            for (int it = 0; it < 4; ++it) { float best = -1e30f; int bi = 0;
#pragma unroll
                for (int g = 0; g < 8; ++g) { const bool ok = !((gmask >> g) & 1u) && gs[g] > best; best = ok ? gs[g] : best; bi = ok ? g : bi; }
                gmask |= 1u << bi; }
            unsigned long long taken = 0ull; int sel[8]; float sw[8]; float wsum = 0.f;
#pragma unroll
            for (int k = 0; k < 8; ++k) { float best = -1e30f; int bi = 0;
                for (int e = 0; e < 64; ++e) { const bool cand = ((gmask >> (e >> 3)) & 1u) && !((taken >> e) & 1ull); const float vv = sr[e] + rbias[e];
                    if (cand && vv > best) { best = vv; bi = e; } }
                taken |= 1ull << bi; sel[k] = bi; sw[k] = sr[bi]; wsum += sw[k]; }
            const float inv = 2.5f / wsum;
#pragma unroll
            for (int k = 0; k < 8; ++k) { const int a = trow * 8 + k; const int pos = atomicAdd(&cnt[sel[k]], 1);
                LIST[(size_t)sel[k] * TT + pos] = a; PK[a] = ((unsigned)sel[k] << 16) | (unsigned)pos; LW[(size_t)sel[k] * TT + pos] = sw[k] * inv; }
            LIST[(size_t)64 * TT + (trow - r0)] = 8 * TT + trow; LW[(size_t)64 * TT + (trow - r0)] = 1.0f;
        }
    }
}
namespace att {
constexpr int D = 128, NW = 8, QBLK = 32, KVBLK = 64;
constexpr float SCALE = 0.088388347648318440f;
constexpr float THR = 8.f;
constexpr int SHM_V = KVBLK * D * 2, SHM_K = KVBLK * D * 2, SHM_ATTN = 2 * SHM_V + 2 * SHM_K + NW * 64 * 4;
#define KSWZ(row, colB) ((row) * 256 + ((colB) ^ (((row) & 7) << 4)))
#define SBAR() __builtin_amdgcn_sched_barrier(0)
__device__ __forceinline__ int crow(int r, int hi) { return (r & 3) + 8 * (r >> 2) + 4 * hi; }
__device__ __forceinline__ unsigned cvtpk(float lo, float hi) { unsigned r; asm volatile("v_cvt_pk_bf16_f32 %0, %1, %2" : "=v"(r) : "v"(lo), "v"(hi)); return r; }

__device__ __forceinline__ void partialSM(f32x16& p0, f32x16& p1, float negMC) {
  constexpr float Cc = SCALE * 1.4426950408889634f;
  for (int r = 0; r < 16; ++r) p0[r] = fmaf(p0[r], Cc, negMC); for (int r = 0; r < 16; ++r) p1[r] = fmaf(p1[r], Cc, negMC);
  for (int r = 0; r < 16; ++r) p0[r] = __builtin_amdgcn_exp2f(p0[r]);
}
__device__ __forceinline__ void finishSM(f32x16& p0, f32x16& p1, float& l_reg, bf16x8& pa0, bf16x8& pa1, bf16x8& pa2, bf16x8& pa3) {
  for (int r = 0; r < 16; ++r) p1[r] = __builtin_amdgcn_exp2f(p1[r]);
  float ps = 0; for (int r = 0; r < 16; ++r) ps += p0[r]; for (int r = 0; r < 16; ++r) ps += p1[r];
  { auto rr = __builtin_amdgcn_permlane32_swap(__float_as_uint(ps), __float_as_uint(ps), false, false);
    ps = __uint_as_float(rr[0]) + __uint_as_float(rr[1]); }
  l_reg += ps;
#define PK4(P, BASE, OUT) do { unsigned a0 = cvtpk(P[BASE + 0], P[BASE + 1]), a1 = cvtpk(P[BASE + 2], P[BASE + 3]);   \
    unsigned b0 = cvtpk(P[BASE + 4], P[BASE + 5]), b1 = cvtpk(P[BASE + 6], P[BASE + 7]);                              \
    auto r0 = __builtin_amdgcn_permlane32_swap(a0, b0, false, false); auto r1 = __builtin_amdgcn_permlane32_swap(a1, b1, false, false); \
    u32x4 w = {r0[0], r1[0], r0[1], r1[1]}; OUT = *reinterpret_cast<bf16x8*>(&w); } while (0)
  PK4(p0, 0, pa0); PK4(p0, 8, pa1); PK4(p1, 0, pa2); PK4(p1, 8, pa3);
#undef PK4
}
__device__ __forceinline__ void qkt(f32x16& p0, f32x16& p1, const LAS char* Ks, const bf16x8* qr, int r32, int hi) {
  p0 = f32x16{}; p1 = f32x16{};
  for (int d0 = 0; d0 < 8; ++d0) { int cb = (d0 * 16 + hi * 8) * 2;
    bf16x8 b0 = *reinterpret_cast<const LAS bf16x8*>(Ks + KSWZ(r32, cb));
    bf16x8 b1 = *reinterpret_cast<const LAS bf16x8*>(Ks + KSWZ(32 + r32, cb));
    p0 = __builtin_amdgcn_mfma_f32_32x32x16_bf16(b0, qr[d0], p0, 0, 0, 0);
    p1 = __builtin_amdgcn_mfma_f32_32x32x16_bf16(b1, qr[d0], p1, 0, 0, 0); }
}
__device__ __forceinline__ int v_st(int k, int c) { const int kk = (k & ~0xC) | ((k & 4) << 1) | ((k & 8) >> 1); return ((kk >> 3) * 4 + (c >> 5)) * 512 + ((kk & 7) * 32 + (c & 31)) * 2; }
__device__ __forceinline__ int v_rd_base(int lane) { return ((lane & 3) << 3) | (((lane >> 2) & 3) << 6) | (((lane >> 4) & 1) << 5) | (((lane >> 5) & 1) << 8); }
constexpr int v_rd_off(int d0, int ks, int half) { return d0 * 512 + ks * 4096 + half * 2048; }
template <int OFF> __device__ __forceinline__ s16x4 tr_read(int vb) {
  s16x4 r; asm volatile("ds_read_b64_tr_b16 %0, %1 offset:%2" : "=&v"(r) : "v"(vb), "i"(OFF) : "memory"); return r;
}
template <int D0> __device__ __forceinline__ void pv_one(f32x16& od, int vb, bf16x8 pa0, bf16x8 pa1, bf16x8 pa2, bf16x8 pa3) {
  const s16x4 l0 = tr_read<v_rd_off(D0, 0, 0)>(vb), h0 = tr_read<v_rd_off(D0, 0, 1)>(vb), l1 = tr_read<v_rd_off(D0, 1, 0)>(vb), h1 = tr_read<v_rd_off(D0, 1, 1)>(vb);
  const s16x4 l2 = tr_read<v_rd_off(D0, 2, 0)>(vb), h2 = tr_read<v_rd_off(D0, 2, 1)>(vb), l3 = tr_read<v_rd_off(D0, 3, 0)>(vb), h3 = tr_read<v_rd_off(D0, 3, 1)>(vb);
  asm volatile("s_waitcnt lgkmcnt(0)" ::: "memory"); SBAR();
#define PK(L, H) (bf16x8){L[0], L[1], L[2], L[3], H[0], H[1], H[2], H[3]}
  od = __builtin_amdgcn_mfma_f32_32x32x16_bf16(pa0, PK(l0, h0), od, 0, 0, 0);
  od = __builtin_amdgcn_mfma_f32_32x32x16_bf16(pa1, PK(l1, h1), od, 0, 0, 0);
  od = __builtin_amdgcn_mfma_f32_32x32x16_bf16(pa2, PK(l2, h2), od, 0, 0, 0);
  od = __builtin_amdgcn_mfma_f32_32x32x16_bf16(pa3, PK(l3, h3), od, 0, 0, 0);
#undef PK
}
__device__ __forceinline__ void pv_d0(f32x16* o, int vb, bf16x8 pa0, bf16x8 pa1, bf16x8 pa2, bf16x8 pa3) {
  pv_one<0>(o[0], vb, pa0, pa1, pa2, pa3); pv_one<1>(o[1], vb, pa0, pa1, pa2, pa3); pv_one<2>(o[2], vb, pa0, pa1, pa2, pa3); pv_one<3>(o[3], vb, pa0, pa1, pa2, pa3);
}

template <int LDQ, int LDK, int LDO>
__device__ __forceinline__ void attn_dense_body(const bf16_t* __restrict__ Qb, const bf16_t* __restrict__ Kh, const bf16_t* __restrict__ Vh, bf16_t* __restrict__ Ob, int seq, LAS char* lds, int tid, float kmax2) {
  const int wid = tid >> 6, lane = tid & 63, r32 = lane & 31, hi = lane >> 5;
  LAS char* V_lds = lds; LAS char* K_lds = lds + 2 * SHM_V;
  LAS float* ws = (LAS float*)(lds + 2 * SHM_V + 2 * SHM_K) + wid * 64; LAS float* li_l = ws;
  float l_reg = 0; f32x16 o[4] = {}; bf16x8 qr[8];
  const bf16_t* Qw = Qb + (long)(wid * QBLK + r32) * LDQ + hi * 8;
#pragma unroll
  for (int d0 = 0; d0 < 8; ++d0) qr[d0] = *reinterpret_cast<const bf16x8*>(Qw + d0 * 16);
  float negMC;
  { float q2 = 0.f;
#pragma unroll
    for (int d0 = 0; d0 < 8; ++d0) { const u32x4 w = __builtin_bit_cast(u32x4, qr[d0]);
      q2 += bflo(w.x) * bflo(w.x) + bfhi(w.x) * bfhi(w.x) + bflo(w.y) * bflo(w.y) + bfhi(w.y) * bfhi(w.y) + bflo(w.z) * bflo(w.z) + bfhi(w.z) * bfhi(w.z) + bflo(w.w) * bflo(w.w) + bfhi(w.w) * bfhi(w.w); }
    auto rr = __builtin_amdgcn_permlane32_swap(__float_as_uint(q2), __float_as_uint(q2), false, false);
    q2 = __uint_as_float(rr[0]) + __uint_as_float(rr[1]);
    negMC = -(sqrtf(q2 * kmax2) * (SCALE * 1.0001f) - 30.0f) * 1.4426950408889634f; }
  const int sr = tid >> 4, sc = (tid & 15) * 8, vst0 = v_st(sr, sc), vst1 = v_st(32 + sr, sc);
  const int vb0 = (int)(uintptr_t)V_lds + v_rd_base(lane);
  struct { bf16x8 vs0, vs1, ks0, ks1; } sr_[2];
#define SLOAD(i, k0) do { sr_[i].vs0 = *reinterpret_cast<const bf16x8*>(&Vh[(long)((k0) + sr) * LDK + sc]); sr_[i].vs1 = *reinterpret_cast<const bf16x8*>(&Vh[(long)((k0) + 32 + sr) * LDK + sc]); \
    sr_[i].ks0 = *reinterpret_cast<const bf16x8*>(&Kh[(long)((k0) + sr) * LDK + sc]); sr_[i].ks1 = *reinterpret_cast<const bf16x8*>(&Kh[(long)((k0) + 32 + sr) * LDK + sc]); } while (0)
#define SWRITE(b, i) do { *(LAS bf16x8*)(V_lds + (b) * SHM_V + vst0) = sr_[i].vs0;          \
    *(LAS bf16x8*)(V_lds + (b) * SHM_V + vst1) = sr_[i].vs1; int kc = sc * 2;               \
    *(LAS bf16x8*)(K_lds + (b) * SHM_K + KSWZ(sr, kc)) = sr_[i].ks0;                       \
    *(LAS bf16x8*)(K_lds + (b) * SHM_K + KSWZ(32 + sr, kc)) = sr_[i].ks1; } while (0)
#define SWAIT() asm volatile("s_waitcnt vmcnt(4)" ::: "memory")
  f32x16 pA0, pA1, pB0, pB1; bf16x8 pa0, pa1, pa2, pa3; const int NT = seq / KVBLK;
  constexpr int SE = 0, SO = 1;
  SLOAD(SE, 0); asm volatile("s_waitcnt vmcnt(0)" ::: "memory"); SWRITE(0, SE); __syncthreads();
  qkt(pA0, pA1, K_lds, qr, r32, hi); partialSM(pA0, pA1, negMC);
  SLOAD(SO, KVBLK); if (2 < NT) SLOAD(SE, 2 * KVBLK);
  SWAIT(); SWRITE(1, SO); __syncthreads();
  for (int j = 1; j + 1 < NT; j += 2) {
    SBAR(); qkt(pB0, pB1, K_lds + SHM_K, qr, r32, hi);
    finishSM(pA0, pA1, l_reg, pa0, pa1, pa2, pa3); SBAR();
    SLOAD(SO, (j + 2) * KVBLK); SBAR();
    pv_d0(o, vb0, pa0, pa1, pa2, pa3); partialSM(pB0, pB1, negMC);
    __syncthreads(); SWAIT(); SWRITE(0, SE);
    __syncthreads();
    SBAR(); qkt(pA0, pA1, K_lds, qr, r32, hi);
    finishSM(pB0, pB1, l_reg, pa0, pa1, pa2, pa3); SBAR();
    if (j + 3 < NT) SLOAD(SE, (j + 3) * KVBLK); SBAR();
    pv_d0(o, vb0 + (int)SHM_V, pa0, pa1, pa2, pa3); partialSM(pA0, pA1, negMC);
    __syncthreads(); SWAIT(); SWRITE(1, SO);
    __syncthreads();
  }
  SBAR(); qkt(pB0, pB1, K_lds + SHM_K, qr, r32, hi);
  finishSM(pA0, pA1, l_reg, pa0, pa1, pa2, pa3); SBAR();
  pv_d0(o, vb0, pa0, pa1, pa2, pa3); partialSM(pB0, pB1, negMC);
  __syncthreads();
  finishSM(pB0, pB1, l_reg, pa0, pa1, pa2, pa3); SBAR();
  pv_d0(o, vb0 + (int)SHM_V, pa0, pa1, pa2, pa3);
  if (hi == 0) li_l[r32] = l_reg; asm volatile("s_waitcnt lgkmcnt(0)" ::: "memory");
  float rli[16];
#pragma unroll
  for (int r = 0; r < 16; ++r) rli[r] = __builtin_amdgcn_rcpf(li_l[crow(r, hi)]);
  bf16_t* Ow = Ob + (long)(wid * QBLK) * LDO;
#pragma unroll
  for (int r = 0; r < 16; ++r) { int orow = crow(r, hi);
    for (int d0 = 0; d0 < 4; ++d0) Ow[(long)orow * LDO + d0 * 32 + r32] = (bf16_t)(cvtpk(o[d0][r] * rli[r], 0.f) & 0xffffu); }
#undef SLOAD
#undef SWRITE
#undef SWAIT
}

typedef int v8i32a __attribute__((ext_vector_type(8)));
typedef int v4i32a __attribute__((ext_vector_type(4)));
#define KSW8(row, chunk) ((row) * 128 + ((((chunk) ^ ((row) & 7))) << 4))
#define VSW8(d, chunk) ((d) * 64 + ((((chunk) ^ (((d) >> 2) & 3))) << 4))
#define MFMA8(a, b, c) __builtin_amdgcn_mfma_scale_f32_32x32x64_f8f6f4((a), (b), (c), 0, 0, 0, 0, 0, 0)
__device__ __forceinline__ v8i32a ld32_l(const LAS char* p0, const LAS char* p1) { return __builtin_shufflevector(*(const LAS v4i32a*)p0, *(const LAS v4i32a*)p1, 0, 1, 2, 3, 4, 5, 6, 7); }
__device__ __forceinline__ unsigned pk4f8(float a, float b, float c, float d) { unsigned w = (unsigned)__builtin_amdgcn_cvt_pk_fp8_f32(a, b, 0, false); return (unsigned)__builtin_amdgcn_cvt_pk_fp8_f32(c, d, (int)w, true); }
template <int LDO, int KSTR>
__device__ __forceinline__ void attn_dense8_body(const unsigned char* __restrict__ Q8b, const unsigned char* __restrict__ K8h, const unsigned char* __restrict__ VT8h, bf16_t* __restrict__ Ob, int seq, LAS char* lds, int tid, float kmax2) {
  const int wid = tid >> 6, lane = tid & 63, r32 = lane & 31, hi = lane >> 5;
  LAS char* K_lds = lds; LAS char* V_lds = lds + 16384;
  LAS float* li_l = (LAS float*)(lds + 32768) + wid * 32; LAS float* al_l = (LAS float*)(lds + 32768 + 1024) + wid * 32;
  float l_reg = 0, m_reg = -1e30f; f32x16 o[4] = {}; v8i32a qf[2];
  { const unsigned char* qp = Q8b + (size_t)(wid * QBLK + r32) * 1024 + 32 * hi;
    qf[0] = __builtin_shufflevector(*(const v4i32a*)qp, *(const v4i32a*)(qp + 16), 0, 1, 2, 3, 4, 5, 6, 7);
    qf[1] = __builtin_shufflevector(*(const v4i32a*)(qp + 64), *(const v4i32a*)(qp + 80), 0, 1, 2, 3, 4, 5, 6, 7); }
  (void)kmax2;
  constexpr float THR8 = 1.0f, Cc = SCALE * 1.4426950408889634f;
#define PSM8(P0, P1, AL) do { float pmax = P0[0]; for (int r = 1; r < 16; ++r) pmax = fmaxf(pmax, P0[r]); for (int r = 0; r < 16; ++r) pmax = fmaxf(pmax, P1[r]); \
      { auto rr = __builtin_amdgcn_permlane32_swap(__float_as_uint(pmax), __float_as_uint(pmax), false, false); pmax = fmaxf(__uint_as_float(rr[0]), __uint_as_float(rr[1])); } \
      float mn; if (__builtin_expect(__all(pmax - m_reg <= THR8 / SCALE), 1)) { mn = m_reg; AL = 1.f; } \
      else { mn = fmaxf(m_reg, pmax); AL = __builtin_amdgcn_exp2f((m_reg - mn) * Cc); m_reg = mn; } \
      const float mnC = 7.0f - mn * Cc; \
      for (int r = 0; r < 16; ++r) P0[r] = fmaf(P0[r], Cc, mnC); for (int r = 0; r < 16; ++r) P1[r] = fmaf(P1[r], Cc, mnC); \
      for (int r = 0; r < 16; ++r) P0[r] = __builtin_amdgcn_exp2f(P0[r]); } while (0)
#define RESC8(a) do { if (__any((a) < 1.f)) { if (hi == 0) al_l[r32] = (a); asm volatile("s_waitcnt lgkmcnt(0)" ::: "memory"); \
      for (int d = 0; d < 4; ++d) for (int r = 0; r < 16; ++r) o[d][r] *= al_l[crow(r, hi)]; } } while (0)
  const int krow = tid >> 3, kch = tid & 7, vd = tid >> 2, vch = tid & 3;
  const int kst = KSW8(krow, kch), vst = VSW8(vd, vch);
  struct { v4i32a k, v; } sr_[2];
#define SLOAD8(i, T_) do { sr_[i].k = *(const v4i32a*)(K8h + (size_t)(64 * (T_) + krow) * KSTR + 16 * kch); sr_[i].v = *(const v4i32a*)(VT8h + (size_t)(T_) * 8192 + 16 * tid); } while (0)
#define SWRITE8(b, i) do { *(LAS v4i32a*)(K_lds + (b) * 8192 + kst) = sr_[i].k; *(LAS v4i32a*)(V_lds + (b) * 8192 + vst) = sr_[i].v; } while (0)
#define QK8(P0, P1, KB) do { P0 = f32x16{}; P1 = f32x16{}; _Pragma("unroll") for (int s = 0; s < 2; ++s) { \
      const v8i32a k0 = ld32_l((KB) + KSW8(r32, 4 * s + 2 * hi), (KB) + KSW8(r32, 4 * s + 2 * hi + 1)); \
      const v8i32a k1 = ld32_l((KB) + KSW8(32 + r32, 4 * s + 2 * hi), (KB) + KSW8(32 + r32, 4 * s + 2 * hi + 1)); \
      P0 = MFMA8(k0, qf[s], P0); P1 = MFMA8(k1, qf[s], P1); } } while (0)
#define FIN8(P0, P1, AL) do { for (int r = 0; r < 16; ++r) P1[r] = __builtin_amdgcn_exp2f(P1[r]); \
      float ps = 0; for (int r = 0; r < 16; ++r) ps += P0[r]; for (int r = 0; r < 16; ++r) ps += P1[r]; \
      { auto rr = __builtin_amdgcn_permlane32_swap(__float_as_uint(ps), __float_as_uint(ps), false, false); ps = __uint_as_float(rr[0]) + __uint_as_float(rr[1]); } \
      l_reg = l_reg * (AL) + ps; \
      _Pragma("unroll") for (int i = 0; i < 4; ++i) { pa[i] = (int)pk4f8(P0[4 * i], P0[4 * i + 1], P0[4 * i + 2], P0[4 * i + 3]); pa[4 + i] = (int)pk4f8(P1[4 * i], P1[4 * i + 1], P1[4 * i + 2], P1[4 * i + 3]); } } while (0)
#define PV8(VB) do { _Pragma("unroll") for (int d0 = 0; d0 < 4; ++d0) { \
      const v8i32a vf = ld32_l((VB) + VSW8(32 * d0 + r32, 2 * hi), (VB) + VSW8(32 * d0 + r32, 2 * hi + 1)); \
      o[d0] = MFMA8(pa, vf, o[d0]); } } while (0)
  f32x16 pA0, pA1, pB0, pB1; v8i32a pa; float alA, alB; const int NT = seq / KVBLK;
  SLOAD8(0, 0); asm volatile("s_waitcnt vmcnt(0)" ::: "memory"); SWRITE8(0, 0); __syncthreads();
  QK8(pA0, pA1, K_lds); PSM8(pA0, pA1, alA);
  SLOAD8(1, 1); if (2 < NT) SLOAD8(0, 2);
  asm volatile("s_waitcnt vmcnt(2)" ::: "memory"); SWRITE8(1, 1); __syncthreads();
  for (int j = 1; j + 1 < NT; j += 2) {
    SBAR(); QK8(pB0, pB1, K_lds + 8192);
    FIN8(pA0, pA1, alA); SBAR();
    SLOAD8(1, j + 2); SBAR();
    PV8(V_lds); PSM8(pB0, pB1, alB);
    __syncthreads(); asm volatile("s_waitcnt vmcnt(2)" ::: "memory"); SWRITE8(0, 0);
    RESC8(alB); __syncthreads();
    SBAR(); QK8(pA0, pA1, K_lds);
    FIN8(pB0, pB1, alB); SBAR();
    if (j + 3 < NT) SLOAD8(0, j + 3); SBAR();
    PV8(V_lds + 8192); PSM8(pA0, pA1, alA);
    __syncthreads(); asm volatile("s_waitcnt vmcnt(2)" ::: "memory"); SWRITE8(1, 1);
    RESC8(alA); __syncthreads();
  }
  SBAR(); QK8(pB0, pB1, K_lds + 8192);
  FIN8(pA0, pA1, alA); SBAR();
  PV8(V_lds); PSM8(pB0, pB1, alB);
  __syncthreads(); RESC8(alB);
  FIN8(pB0, pB1, alB); SBAR();
  PV8(V_lds + 8192);
  if (hi == 0) li_l[r32] = l_reg; asm volatile("s_waitcnt lgkmcnt(0)" ::: "memory");
  float rli[16];
#pragma unroll
  for (int r = 0; r < 16; ++r) rli[r] = __builtin_amdgcn_rcpf(li_l[crow(r, hi)]);
  bf16_t* Ow = Ob + (long)(wid * QBLK) * LDO;
#pragma unroll
  for (int r = 0; r < 16; ++r) { int orow = crow(r, hi);
    for (int d0 = 0; d0 < 4; ++d0) Ow[(long)orow * LDO + d0 * 32 + r32] = (bf16_t)(cvtpk(o[d0][r] * rli[r], 0.f) & 0xffffu); }
#undef PSM8
#undef RESC8
#undef SLOAD8
#undef SWRITE8
#undef QK8
#undef FIN8
#undef PV8
}

template <int LDO, int KSTR>
__device__ __forceinline__ void attn_dense8w_body(const unsigned char* __restrict__ Q8b, const unsigned char* __restrict__ K8h, const unsigned char* __restrict__ VT8h0, const unsigned char* __restrict__ VT8h1, bf16_t* __restrict__ Ob, int seq, LAS char* lds, int tid, float kmax2) {
  const int wid = tid >> 6, lane = tid & 63, r32 = lane & 31, hi = lane >> 5;
  LAS char* K_lds = lds; LAS char* V_lds = lds + 16384;
  LAS float* li_l = (LAS float*)(lds + 49152) + wid * 32; LAS float* al_l = (LAS float*)(lds + 49152 + 1024) + wid * 32;
  float l_reg = 0, m_reg = -1e30f; f32x16 o[8] = {}; v8i32a qf[2];
  { const unsigned char* qp = Q8b + (size_t)(wid * QBLK + r32) * 1024 + 32 * hi;
    qf[0] = __builtin_shufflevector(*(const v4i32a*)qp, *(const v4i32a*)(qp + 16), 0, 1, 2, 3, 4, 5, 6, 7);
    qf[1] = __builtin_shufflevector(*(const v4i32a*)(qp + 64), *(const v4i32a*)(qp + 80), 0, 1, 2, 3, 4, 5, 6, 7); }
  (void)kmax2;
  constexpr float THR8 = 1.0f, Cc = SCALE * 1.4426950408889634f;
#define PSM8(P0, P1, AL) do { float pmax = P0[0]; for (int r = 1; r < 16; ++r) pmax = fmaxf(pmax, P0[r]); for (int r = 0; r < 16; ++r) pmax = fmaxf(pmax, P1[r]); \
      { auto rr = __builtin_amdgcn_permlane32_swap(__float_as_uint(pmax), __float_as_uint(pmax), false, false); pmax = fmaxf(__uint_as_float(rr[0]), __uint_as_float(rr[1])); } \
      float mn; if (__builtin_expect(__all(pmax - m_reg <= THR8 / SCALE), 1)) { mn = m_reg; AL = 1.f; } \
      else { mn = fmaxf(m_reg, pmax); AL = __builtin_amdgcn_exp2f((m_reg - mn) * Cc); m_reg = mn; } \
      const float mnC = 7.0f - mn * Cc; \
      for (int r = 0; r < 16; ++r) P0[r] = fmaf(P0[r], Cc, mnC); for (int r = 0; r < 16; ++r) P1[r] = fmaf(P1[r], Cc, mnC); \
      for (int r = 0; r < 16; ++r) P0[r] = __builtin_amdgcn_exp2f(P0[r]); } while (0)
#define RESC8(a) do { if (__any((a) < 1.f)) { if (hi == 0) al_l[r32] = (a); asm volatile("s_waitcnt lgkmcnt(0)" ::: "memory"); \
      for (int d = 0; d < 8; ++d) for (int r = 0; r < 16; ++r) o[d][r] *= al_l[crow(r, hi)]; } } while (0)
  const int krow = tid >> 3, kch = tid & 7, vd = tid >> 2, vch = tid & 3;
  const int kst = KSW8(krow, kch), vst = VSW8(vd, vch);
  struct { v4i32a k, v, v2; } sr_[1];
#define SLOAD8(i, T_) do { sr_[i].k = *(const v4i32a*)(K8h + (size_t)(64 * (T_) + krow) * KSTR + 16 * kch); sr_[i].v = *(const v4i32a*)(VT8h0 + (size_t)(T_) * 8192 + 16 * tid); sr_[i].v2 = *(const v4i32a*)(VT8h1 + (size_t)(T_) * 8192 + 16 * tid); } while (0)
#define SWRITE8(b, i) do { *(LAS v4i32a*)(K_lds + (b) * 8192 + kst) = sr_[i].k; *(LAS v4i32a*)(V_lds + (b) * 16384 + vst) = sr_[i].v; *(LAS v4i32a*)(V_lds + (b) * 16384 + 8192 + vst) = sr_[i].v2; } while (0)
#define QK8(P0, P1, KB) do { P0 = f32x16{}; P1 = f32x16{}; _Pragma("unroll") for (int s = 0; s < 2; ++s) { \
      const v8i32a k0 = ld32_l((KB) + KSW8(r32, 4 * s + 2 * hi), (KB) + KSW8(r32, 4 * s + 2 * hi + 1)); \
      const v8i32a k1 = ld32_l((KB) + KSW8(32 + r32, 4 * s + 2 * hi), (KB) + KSW8(32 + r32, 4 * s + 2 * hi + 1)); \
      P0 = MFMA8(k0, qf[s], P0); P1 = MFMA8(k1, qf[s], P1); } } while (0)
#define FIN8(P0, P1, AL) do { for (int r = 0; r < 16; ++r) P1[r] = __builtin_amdgcn_exp2f(P1[r]); \
      float ps = 0; for (int r = 0; r < 16; ++r) ps += P0[r]; for (int r = 0; r < 16; ++r) ps += P1[r]; \
      { auto rr = __builtin_amdgcn_permlane32_swap(__float_as_uint(ps), __float_as_uint(ps), false, false); ps = __uint_as_float(rr[0]) + __uint_as_float(rr[1]); } \
      l_reg = l_reg * (AL) + ps; \
      _Pragma("unroll") for (int i = 0; i < 4; ++i) { pa[i] = (int)pk4f8(P0[4 * i], P0[4 * i + 1], P0[4 * i + 2], P0[4 * i + 3]); pa[4 + i] = (int)pk4f8(P1[4 * i], P1[4 * i + 1], P1[4 * i + 2], P1[4 * i + 3]); } } while (0)
#define PV8(VB) do { _Pragma("unroll") for (int d0 = 0; d0 < 4; ++d0) { \
      const v8i32a vf = ld32_l((VB) + VSW8(32 * d0 + r32, 2 * hi), (VB) + VSW8(32 * d0 + r32, 2 * hi + 1)); \
      const v8i32a vg = ld32_l((VB) + 8192 + VSW8(32 * d0 + r32, 2 * hi), (VB) + 8192 + VSW8(32 * d0 + r32, 2 * hi + 1)); \
      o[d0] = MFMA8(pa, vf, o[d0]); o[4 + d0] = MFMA8(pa, vg, o[4 + d0]); } } while (0)
  f32x16 pA0, pA1; v8i32a pa; float alA; const int NT = seq / KVBLK;
  SLOAD8(0, 0); asm volatile("s_waitcnt vmcnt(0)" ::: "memory"); SWRITE8(0, 0); __syncthreads();
  SLOAD8(0, 1);
  for (int j = 0; j < NT; j += 2) {
    SBAR(); QK8(pA0, pA1, K_lds); PSM8(pA0, pA1, alA); RESC8(alA); FIN8(pA0, pA1, alA); SBAR(); PV8(V_lds);
    asm volatile("s_waitcnt vmcnt(0)" ::: "memory"); SWRITE8(1, 0); if (j + 2 < NT) SLOAD8(0, j + 2); __syncthreads();
    SBAR(); QK8(pA0, pA1, K_lds + 8192); PSM8(pA0, pA1, alA); RESC8(alA); FIN8(pA0, pA1, alA); SBAR(); PV8(V_lds + 16384);
    if (j + 2 < NT) { asm volatile("s_waitcnt vmcnt(0)" ::: "memory"); SWRITE8(0, 0); if (j + 3 < NT) SLOAD8(0, j + 3); } __syncthreads();
  }
  if (hi == 0) li_l[r32] = l_reg; asm volatile("s_waitcnt lgkmcnt(0)" ::: "memory");
  float rli[16];
#pragma unroll
  for (int r = 0; r < 16; ++r) rli[r] = __builtin_amdgcn_rcpf(li_l[crow(r, hi)]);
  bf16_t* Ow = Ob + (long)(wid * QBLK) * LDO;
#pragma unroll
  for (int r = 0; r < 16; ++r) { int orow = crow(r, hi);
    for (int d0 = 0; d0 < 8; ++d0) Ow[(long)orow * LDO + d0 * 32 + r32] = (bf16_t)(cvtpk(o[d0][r] * rli[r], 0.f) & 0xffffu); }
#undef PSM8
#undef RESC8
#undef SLOAD8
#undef SWRITE8
#undef QK8
#undef FIN8
#undef PV8
}

constexpr int PV_BUF = 32768, PK_BUF = 16384, P_LDS_V = 0, P_LDS_K = 2 * PV_BUF, P_LDS_X = P_LDS_K + 2 * PK_BUF, P_LDS_L = P_LDS_X + 8 * 2048, P_LDS_END = P_LDS_L + 1024;
__device__ __forceinline__ void qkt_half(f32x16& p, const LAS char* Ks, const bf16x8* qr, int krow, int hi) {
  p = f32x16{};
  for (int d0 = 0; d0 < 8; ++d0) { int cb = (d0 * 16 + hi * 8) * 2;
    bf16x8 b0 = *reinterpret_cast<const LAS bf16x8*>(Ks + KSWZ(krow, cb));
    p = __builtin_amdgcn_mfma_f32_32x32x16_bf16(b0, qr[d0], p, 0, 0, 0); }
}
__device__ __forceinline__ void smA(f32x16& p, float negMC) {
  constexpr float Cc = SCALE * 1.4426950408889634f;
  for (int r = 0; r < 16; ++r) p[r] = fmaf(p[r], Cc, negMC);
  for (int r = 0; r < 8; ++r) p[r] = __builtin_amdgcn_exp2f(p[r]);
}
__device__ __forceinline__ void smB(f32x16& p, float& l_reg, bf16x8& f0, bf16x8& f1) {
  for (int r = 8; r < 16; ++r) p[r] = __builtin_amdgcn_exp2f(p[r]);
  float ps = 0; for (int r = 0; r < 16; ++r) ps += p[r];
  { auto rr = __builtin_amdgcn_permlane32_swap(__float_as_uint(ps), __float_as_uint(ps), false, false);
    ps = __uint_as_float(rr[0]) + __uint_as_float(rr[1]); }
  l_reg += ps;
#define PK4(P, BASE, OUT) do { unsigned a0 = cvtpk(P[BASE + 0], P[BASE + 1]), a1 = cvtpk(P[BASE + 2], P[BASE + 3]);   \
    unsigned b0 = cvtpk(P[BASE + 4], P[BASE + 5]), b1 = cvtpk(P[BASE + 6], P[BASE + 7]);                              \
    auto r0 = __builtin_amdgcn_permlane32_swap(a0, b0, false, false); auto r1 = __builtin_amdgcn_permlane32_swap(a1, b1, false, false); \
    u32x4 w = {r0[0], r1[0], r0[1], r1[1]}; OUT = *reinterpret_cast<bf16x8*>(&w); } while (0)
  PK4(p, 0, f0); PK4(p, 8, f1);
#undef PK4
}
template <int LDQ, int LDK, int LDO>
__device__ __forceinline__ void attn_pair_body(const bf16_t* __restrict__ Qb, const bf16_t* __restrict__ Kh, const bf16_t* __restrict__ Vh, bf16_t* __restrict__ Ob, int seq, LAS char* lds, int tid, float kmax2) {
  const int wid = __builtin_amdgcn_readfirstlane(tid >> 6), lane = tid & 63, r32 = lane & 31, hi = lane >> 5, g = wid & 3, kb = wid >> 2;
  LAS char* V_lds = lds + P_LDS_V; LAS char* K_lds = lds + P_LDS_K;
  LAS char* xp_own = lds + P_LDS_X + wid * 2048 + lane * 16; LAS char* xp_par = lds + P_LDS_X + (wid ^ 4) * 2048 + lane * 16;
  LAS float* li = (LAS float*)(lds + P_LDS_L);
  float l_reg = 0; f32x16 o[4] = {}; bf16x8 qr[8];
  const bf16_t* Qw = Qb + (long)(g * QBLK + r32) * LDQ + hi * 8;
#pragma unroll
  for (int d0 = 0; d0 < 8; ++d0) qr[d0] = *reinterpret_cast<const bf16x8*>(Qw + d0 * 16);
  float negMC;
  { float q2 = 0.f;
#pragma unroll
    for (int d0 = 0; d0 < 8; ++d0) { const u32x4 w = __builtin_bit_cast(u32x4, qr[d0]);
      q2 += bflo(w.x) * bflo(w.x) + bfhi(w.x) * bfhi(w.x) + bflo(w.y) * bflo(w.y) + bfhi(w.y) * bfhi(w.y) + bflo(w.z) * bflo(w.z) + bfhi(w.z) * bfhi(w.z) + bflo(w.w) * bflo(w.w) + bfhi(w.w) * bfhi(w.w); }
    auto rr = __builtin_amdgcn_permlane32_swap(__float_as_uint(q2), __float_as_uint(q2), false, false);
    q2 = __uint_as_float(rr[0]) + __uint_as_float(rr[1]);
    negMC = -(sqrtf(q2 * kmax2) * (SCALE * 1.0001f) - 30.0f) * 1.4426950408889634f; }
  const int sr = tid >> 4, sc = (tid & 15) * 8, vst0 = v_st(sr, sc), vst1 = v_st(32 + sr, sc);
  const int vrd = (int)(uintptr_t)V_lds + kb * 16384 + v_rd_base(lane);
  const int krow = 32 * kb + r32;
  struct { bf16x8 v00, v01, v10, v11, k0, k1; } st_;
#define PLD16(base, off) (*reinterpret_cast<const bf16x8*>((const char*)(base) + (off)))
#define PLOAD(k0_) do { const unsigned o_ = (unsigned)(((k0_) + sr) * LDK + sc) * 2u; \
    st_.v00 = PLD16(Vh, o_); st_.v01 = PLD16(Vh, o_ + 256u); st_.v10 = PLD16(Vh, o_ + 64u * LDK); st_.v11 = PLD16(Vh, o_ + 64u * LDK + 256u); \
    st_.k0 = PLD16(Kh, o_); st_.k1 = PLD16(Kh, o_ + 64u * LDK); } while (0)
#define PWRITE(kbuf, vbuf) do { LAS char* vb_ = V_lds + (vbuf) * PV_BUF; LAS char* kb_ = K_lds + (kbuf) * PK_BUF; const int kc = sc * 2; \
    *(LAS bf16x8*)(vb_ + vst0) = st_.v00; *(LAS bf16x8*)(vb_ + 16384 + vst0) = st_.v01; *(LAS bf16x8*)(vb_ + vst1) = st_.v10; *(LAS bf16x8*)(vb_ + 16384 + vst1) = st_.v11; \
    *(LAS bf16x8*)(kb_ + KSWZ(sr, kc)) = st_.k0; *(LAS bf16x8*)(kb_ + KSWZ(32 + sr, kc)) = st_.k1; } while (0)
  const int NT = seq / KVBLK;
  f32x16 pS; bf16x8 f0, f1, g0, g1;
  PLOAD(0); asm volatile("s_waitcnt vmcnt(0)" ::: "memory"); PWRITE(0, 0); PLOAD(KVBLK);
  __syncthreads();
  for (int j = 0; j < NT; ++j) {
    SBAR();
    qkt_half(pS, K_lds + (j & 1) * PK_BUF, qr, krow, hi);
    smA(pS, negMC); smB(pS, l_reg, f0, f1); SBAR();
    *(LAS bf16x8*)(xp_own) = f0; *(LAS bf16x8*)(xp_own + 1024) = f1;
    if (j + 1 < NT) PWRITE((j + 1) & 1, (j + 1) & 1);
    if (j + 2 < NT) PLOAD((j + 2) * KVBLK);
    __syncthreads();
    g0 = *(const LAS bf16x8*)(xp_par); g1 = *(const LAS bf16x8*)(xp_par + 1024);
    { const int vb = vrd + (j & 1) * PV_BUF;
      if (kb == 0) pv_d0(o, vb, f0, f1, g0, g1); else pv_d0(o, vb, g0, g1, f0, f1); }
    __syncthreads();
  }
  if (hi == 0) li[wid * 32 + r32] = l_reg;
  __syncthreads();
#pragma unroll
  for (int r = 0; r < 16; ++r) { const int orow = crow(r, hi); const float rl = __builtin_amdgcn_rcpf(li[wid * 32 + orow] + li[(wid ^ 4) * 32 + orow]);
    bf16_t* op = Ob + (long)(g * QBLK + orow) * LDO + 128 * kb + r32;
    for (int d0 = 0; d0 < 4; ++d0) op[d0 * 32] = (bf16_t)(cvtpk(o[d0][r] * rl, 0.f) & 0xffffu); }
#undef PLD16
#undef PLOAD
#undef PWRITE
}
#undef KSWZ
}

__device__ __forceinline__ void phase_attention(const Params& p, Ctx& C) {
    bf16_t* ATT = (bf16_t*)(p.ws + WS_BIG + BG_ATT);
    const unsigned char* Q8 = (const unsigned char*)(p.ws + WS_BIG + BG_Q8); const unsigned char* K8 = (const unsigned char*)(p.ws + WS_BIG + BG_K8); const unsigned char* VT8 = (const unsigned char*)(p.ws + WS_BIG + BG_VT8);
    const unsigned char* Q8D = (const unsigned char*)(p.ws + WS_BIG + BG_Q8D); const unsigned char* K8D = (const unsigned char*)(p.ws + WS_BIG + BG_K8D); const unsigned char* VT8D = (const unsigned char*)(p.ws + WS_BIG + BG_VT8D);
    for (int i = 0;; ++i) {
        int unit;
        if (C.G == 256) { if (i >= 2) break; unit = (C.bid & 7) * 64 + i * 32 + (C.bid >> 3); } else { unit = i * C.G + C.bid; if (unit >= 512) break; }
        const int d = unit >> 6, qb = unit & 63, hh = d >> 1, m = d & 1;
        __syncthreads();
        int tz = C.tid; asm volatile("" : "+v"(tz));
        att::attn_dense8w_body<3072, 1024>(Q8D + (size_t)(CTXL + 256 * qb) * 1024 + 128 * d, K8D + 128 * d, VT8D + (size_t)(2 * hh) * 260 * 8192, VT8D + (size_t)(2 * hh + 1) * 260 * 8192,
                                           ATT + (size_t)(256 * qb) * 3072 + 1024 + 1024 * m + 256 * hh, TT, (LAS char*)C.lds, tz, 0.f);
    }
    for (int i = 0;; ++i) {
        int unit;
        if (C.G == 256) { if (i >= 2) break; unit = (C.bid & 7) * 64 + i * 32 + (C.bid >> 3); } else { unit = i * C.G + C.bid; if (unit >= 512) break; }
        const int prob = unit >> 6, qb = unit & 63;
        __syncthreads();
        int tz = C.tid; asm volatile("" : "+v"(tz));
        att::attn_dense8_body<3072, 256>(Q8 + (size_t)(CTXL + 256 * qb) * 1024 + 128 * prob, K8 + 128 * (prob >> 2), VT8 + (size_t)(prob >> 2) * 260 * 8192,
                                         ATT + (size_t)(256 * qb) * 3072 + 128 * prob, TT, (LAS char*)C.lds, tz, 0.f);
    }
    __syncthreads();
}
constexpr int PH_PER_LAYER = 13, N_PHASES = 2 + 2 * PH_PER_LAYER;
#ifndef DBL_PHASE
#define DBL_PHASE -1
#endif
#ifndef MK_PER_PHASE
#define MK_PER_PHASE 0
#endif

template <int L>
__device__ __forceinline__ void layer_body(const Params& p, Ctx& C0, const XcdBarrier& bar, LAS unsigned char* misc, int lo, int hi) {
#define IN(k) (lo <= (k) && (k) < hi)
#define SEAM(k) do { if (IN(k) && IN((k) + 1)) xcd_barrier(bar, C0.wave); } while (0)
#define PHASE(k, ...) if (IN(k)) { FRESH(); __VA_ARGS__ } if (DBL_PHASE == (k)) { xcd_barrier(bar, C0.wave); { FRESH(); __VA_ARGS__ } } SEAM(k);
#define FRESH() Ctx C = C0; { int ln = (int)__builtin_amdgcn_mbcnt_hi(~0u, __builtin_amdgcn_mbcnt_lo(~0u, 0u)); asm volatile("" : "+v"(ln)); C.lane = ln; C.tid = C.wave * 64 + ln; }
        const int b = 2 + PH_PER_LAYER * L;
        bf16_t* QKV = (bf16_t*)(p.ws + WS_BIG + BG_QKV);
        bf16_t* XA = (bf16_t*)(p.ws + WS_XA);
        int* cnt = (int*)(p.ws + WS_CTL) + CW_CNT + L * 128; const int* LIST = (const int*)(p.ws + WS_LIST);
        PHASE(b + 0, phase_modulate(p, C, L); )
        PHASE(b + 1,
            const int N = L ? OD_IN : EV_IN;
            pg8::DenseOrder S; S.init8((const void*)XA, DM, (const void*)(p.ws + (L ? WS_WIN1 : WS_WIN0)), TT, N, DM, C.G, C.bid);
            pg8::EpiStore E{QKV, N, 1.0f / 32.0f};
            pg8::gemm_phase<true>(C.lds, S, E, C.wave);
            if (L == 0 && IN(b + 2) && S.units_of_me() < S.max_units()) conv_queue(p, C, 2);
        )
        PHASE(b + 2, if (L == 0) phase_rope0(p, C); else phase_normrope1(p, C); )
        PHASE(b + 3, if (L == 0) { ret_chunk_kv(p, C); s5_end_states(p, C); } else phase_attention(p, C); )
        PHASE(b + 4, if (L == 0) phase_scans(p, C); else phase_merge1(p, C); )
        if (L == 0) {
            PHASE(b + 5, phase_ret_s5_outputs(p, C, misc); )
            PHASE(b + 6,
                pg8::DenseOrder S; S.init((const bf16_t*)(p.ws + WS_Z), 1024, (const bf16_t*)(p.ws + WS_WGLU), TT, 1024, 1024, C.G, C.bid);
                pg8::EpiGlu E{(const bf16_t*)(p.ws + WS_Z), p.inp(20), (bf16_t*)(p.ws + WS_BIG + BG_MIX)};
                pg8::gemm_phase<false>(C.lds, S, E, C.wave);
                if (IN(b + 7) && S.units_of_me() < S.max_units()) conv_queue(p, C, 4);
            )
        }
        PHASE(b + 7,
            pg8::DenseOrder S;
            if (L == 0) S.init((const bf16_t*)(p.ws + WS_BIG + BG_MIX), DM, (const bf16_t*)(p.ws + WS_WOUT0), TT, DM, DM, C.G, C.bid);
            else S.init((const bf16_t*)(p.ws + WS_BIG + BG_ATT), 3072, (const bf16_t*)(p.ws + WS_WOUT1), SEQ, DM, DM, C.G, C.bid);
            pg8::EpiStore E{(bf16_t*)(p.ws + WS_YMIX) + (L ? (size_t)CTXL * DM : 0), DM, 1.0f};
            pg8::gemm_phase<false>(C.lds, S, E, C.wave);
            if (L == 0 && IN(b + 8) && S.units_of_me() < S.max_units()) conv_queue(p, C, 5);
        )
        PHASE(b + 8, phase_ln1(p, C, L); )
        PHASE(b + 9, phase_router(p, C, L); )
        PHASE(b + 10,
            pg8::MoeOrder<0> S; S.A = (const void*)XA; S.Bt = (const void*)(p.ws + WS_GU + (size_t)L * NEX1 * 1024 * DM); S.list = LIST; S.cnt = cnt; S.ldab = DM; S.kb = DM; S.nN = 4; S.G = C.G; S.c = C.bid; S.bstride = (size_t)1024 * DM;
            S.prep(misc, C.tid);
            pg8::EpiE1 E{(unsigned char*)(p.ws + WS_HX2), S.cn, S.rb};
            pg8::gemm_phase<true>(C.lds, S, E, C.wave);
        )
        PHASE(b + 11,
            pg8::MoeOrder<1> S; S.A = (const void*)(p.ws + WS_HX2); S.Bt = (const void*)(p.ws + WS_DT + (size_t)L * NEX1 * DM * EHID); S.list = LIST; S.cnt = cnt; S.ldab = EHID; S.kb = EHID; S.nN = 8; S.G = C.G; S.c = C.bid; S.bstride = (size_t)DM * EHID;
            S.prep(misc, C.tid);
            pg8::EpiE2 E{(unsigned char*)(p.ws + WS_BIG + BG_YMOE), (const float*)(p.ws + WS_LW), S.cn, S.rb};
            pg8::gemm_phase<true>(C.lds, S, E, C.wave);
        )
        PHASE(b + 12, phase_combine(p, C, L, misc); )
    #undef IN
#undef SEAM
#undef FRESH
#undef PHASE
}

__global__ void __launch_bounds__(NTHR, 2) mega_fwd(KArgs ka) {
    extern __shared__ __attribute__((aligned(16))) unsigned char lds_raw[];
    Ctx C;
    C.lds = (LAS unsigned char*)lds_raw;
    C.tid = threadIdx.x; C.lane = C.tid & 63; C.wave = __builtin_amdgcn_readfirstlane(C.tid >> 6);
    C.G = gridDim.x; C.bid = blockIdx.x; C.gw = C.bid * NWAVES + C.wave; C.ngw = C.G * NWAVES;
    LAS unsigned char* misc = C.lds + MISC_OFF;
    if (C.tid < 8) ((volatile LAS unsigned*)misc)[C.tid] = 0u;
    Params p; p.out = ka.out; p.ws = ka.ws; p.ph_lo = ka.ph_lo; p.ph_hi = ka.ph_hi; p.ptab = (LAS unsigned long long*)(misc + 1024);
    if (C.tid < 34) p.ptab[C.tid] = (unsigned long long)ka.in[C.tid];
    __syncthreads();
    const int lo = p.ph_lo, hi = p.ph_hi;
    XcdBarrier bar; bar.bar = (unsigned*)(p.ws + WS_CTL) + CW_BAR; bar.x = 0; bar.st = (volatile LAS unsigned*)misc;
    if (hi - lo > 1) bar = xcd_barrier_post((unsigned*)(p.ws + WS_CTL) + CW_BAR, (volatile LAS unsigned*)misc);
#define IN(k) (lo <= (k) && (k) < hi)
#define SEAM(k) do { if (IN(k) && IN((k) + 1)) xcd_barrier(bar, C.wave); } while (0)

    if (IN(0)) { phase_p0(p, C); } SEAM(0);
    if (IN(1)) { phase_p1(p, C); } SEAM(1);
    if (IN(0) && IN(2) && (C.G & 7) == 0) {
        volatile LAS unsigned* st = (volatile LAS unsigned*)misc;
        if (C.tid == 0) { unsigned pre = 0u; const unsigned x = st[3];
            for (unsigned j = 0; j < 16; ++j) { const unsigned cj = xb_ld(&bar.bar[XB_XCNT(j)]); pre += (j < x) ? cj : 0u; }
            st[4] = pre + st[2]; }
        __syncthreads();
        const int vcu = (int)st[4], g8 = C.G >> 3;
        C.bid = __builtin_amdgcn_readfirstlane((vcu % g8) * 8 + vcu / g8); C.gw = C.bid * NWAVES + C.wave;
    }

    layer_body<0>(p, C, bar, misc, lo, hi);
    layer_body<1>(p, C, bar, misc, lo, hi);
#undef IN
#undef SEAM
}

extern "C" void kernel_launch(void* const* d_in, const int* in_sizes, int n_in, void* d_out, int out_size, void* d_ws, size_t ws_size, hipStream_t stream) {
    static int grid = 0;
    if (grid == 0) {
        if (n_in != 34 || out_size != SEQ * DM || ws_size < WS_END) { fprintf(stderr, "kernel_launch: unexpected shapes: n_in %d out %d ws %zu (need %zu)\n", n_in, out_size, ws_size, (size_t)WS_END); grid = -1; return; }
        int dev = 0, cus = 0, per_cu = 0;
        if (hipGetDevice(&dev) != hipSuccess || hipDeviceGetAttribute(&cus, hipDeviceAttributeMultiprocessorCount, dev) != hipSuccess) { grid = -1; return; }
        if (hipFuncSetAttribute((const void*)mega_fwd, hipFuncAttributeMaxDynamicSharedMemorySize, LDS_BYTES) != hipSuccess) { fprintf(stderr, "kernel_launch: hipFuncSetAttribute failed\n"); grid = -1; return; }
        if (hipOccupancyMaxActiveBlocksPerMultiprocessor(&per_cu, (const void*)mega_fwd, NTHR, LDS_BYTES) != hipSuccess || per_cu < 1) { fprintf(stderr, "kernel_launch: occupancy query says %d blocks per CU\n", per_cu); grid = -1; return; }
        (void)hipGetLastError();
        grid = cus;
    }
    if (grid < 0) return;
    (void)hipMemsetAsync((char*)d_ws + WS_CTL, 0, CTL_BYTES, stream);
    KArgs p{};
    for (int i = 0; i < 34; ++i) p.in[i] = (const float*)d_in[i];
    p.out = (float*)d_out; p.ws = (unsigned char*)d_ws;
#if MK_PER_PHASE
    for (int ph = 0; ph < N_PHASES; ++ph) {
        if (ph == 2 + PH_PER_LAYER + 5 || ph == 2 + PH_PER_LAYER + 6) continue;
        p.ph_lo = ph; p.ph_hi = ph + 1;
        hipLaunchKernelGGL(mega_fwd, dim3(grid), dim3(NTHR), LDS_BYTES, stream, p);
    }
#else
    p.ph_lo = 0; p.ph_hi = N_PHASES;
    hipLaunchKernelGGL(mega_fwd, dim3(grid), dim3(NTHR), LDS_BYTES, stream, p);
#endif
    const hipError_t le = hipPeekAtLastError();
    if (le != hipSuccess) fprintf(stderr, "kernel_launch: launch failed: %s\n", hipGetErrorName(le));
}
```

```cpp
#define MK_PER_PHASE 0
#include <hip/hip_runtime.h>
#include <cstdio>
#include <cstdint>

#define GAS __attribute__((address_space(1)))
#define LAS __attribute__((address_space(3)))
typedef unsigned short bf16_t;
typedef short bf16x8 __attribute__((ext_vector_type(8)));
typedef short s16x4 __attribute__((ext_vector_type(4)));
typedef float f32x4 __attribute__((ext_vector_type(4)));
typedef float f32x2 __attribute__((ext_vector_type(2)));
typedef float f32x16 __attribute__((ext_vector_type(16)));
typedef unsigned u32x4 __attribute__((ext_vector_type(4)));
typedef unsigned u32x2 __attribute__((ext_vector_type(2)));

constexpr int DM = 2048, SEQ = 16384, CTXL = 256, TT = SEQ + CTXL;
constexpr int NEXP = 64, NEX1 = 65, EHID = 512, TOPK = 8;
constexpr int EV_IN = 5120, OD_IN = 4608;
constexpr float LN_EPS = 1e-6f;
constexpr float ALPHA = 1.4142135623730951f;
constexpr float LAMBDA_INIT = 0.35550906759f;
constexpr int NTHR = 512, NWAVES = 8;

constexpr size_t al256(size_t x) { return (x + 255) / 256 * 256; }
constexpr size_t WS_CTL   = 0;
constexpr size_t CTL_BYTES = 1u << 20;
constexpr size_t WS_MODP  = WS_CTL + CTL_BYTES;
constexpr size_t WS_MODF  = WS_MODP + al256((size_t)2 * 32 * 2 * 12288 * 4);
constexpr size_t WS_ROPE128 = WS_MODF + al256((size_t)2 * 2 * 12288 * 4);
constexpr size_t WS_ROPE64  = WS_ROPE128 + al256((size_t)256 * 64 * 2 * 4);
constexpr size_t WS_KN    = WS_ROPE64 + al256((size_t)256 * 32 * 2 * 4);
constexpr size_t WS_WT    = WS_KN + al256((size_t)2 * 64 * 16 * 1024 * 2);
constexpr size_t WS_APOW  = WS_WT + al256((size_t)2 * 64 * 128 * 1024 * 2);
constexpr size_t WS_AL    = WS_APOW + al256((size_t)2 * 64 * 64 * 128 * 4);
constexpr size_t WS_CC    = WS_AL + al256((size_t)2 * 64 * 128 * 4);
constexpr size_t WS_BBT   = WS_CC + al256((size_t)64 * 16 * 128 * 2);
constexpr size_t WS_S5E   = WS_BBT + al256((size_t)2 * 64 * 128 * 16 * 2);
constexpr size_t WS_HST   = WS_S5E + al256((size_t)2 * 64 * 260 * 128 * 4);
constexpr size_t WS_WIN0  = WS_HST + al256((size_t)2 * 64 * 260 * 128 * 4);
constexpr size_t WS_WOUT0 = WS_WIN0 + al256((size_t)EV_IN * DM * 2);
constexpr size_t WS_WGLU  = WS_WOUT0 + al256((size_t)DM * DM * 2);
constexpr size_t WS_WIN1  = WS_WGLU + al256((size_t)1024 * 1024 * 2);
constexpr size_t WS_WOUT1 = WS_WIN1 + al256((size_t)OD_IN * DM * 2);
constexpr size_t WS_RWT   = WS_WOUT1 + al256((size_t)DM * DM * 2);
constexpr size_t WS_GU    = WS_RWT + al256((size_t)2 * 2 * 64 * DM * 2);
constexpr size_t WS_DT    = WS_GU + al256((size_t)NEX1 * 1024 * DM * 2);
constexpr size_t WS_XA    = WS_DT + al256((size_t)NEX1 * DM * EHID * 2);
constexpr size_t WS_Z     = WS_XA + al256((size_t)TT * DM * 2);
constexpr size_t WS_YMIX  = WS_Z + al256((size_t)TT * 1024 * 2);
constexpr size_t WS_X1    = WS_YMIX + al256((size_t)TT * DM * 2);
constexpr size_t WS_HX2   = WS_X1 + al256((size_t)TT * DM * 4);
constexpr size_t WS_LIST  = WS_HX2 + al256((size_t)9 * TT * EHID * 2);
constexpr size_t WS_WGT   = WS_LIST + al256((size_t)NEX1 * TT * 4);
constexpr size_t WS_LW    = WS_WGT + al256((size_t)8 * TT * 4);
constexpr size_t WS_BIG   = WS_LW + al256((size_t)NEX1 * TT * 4);
constexpr size_t BG_QKV   = 0;
constexpr size_t BG_CKV   = BG_QKV + al256((size_t)TT * EV_IN * 2);
constexpr size_t BG_SPREV = BG_CKV + al256((size_t)8 * 130 * 65536 * 4);
constexpr size_t BG_MIX   = BG_SPREV + al256((size_t)8 * 130 * 65536 * 2);
constexpr size_t BG_END0  = BG_MIX + al256((size_t)TT * DM * 2);
constexpr size_t BG_ATT   = BG_CKV;
constexpr size_t BG_Q8    = BG_ATT + al256((size_t)SEQ * 3072 * 2);
constexpr size_t BG_K8    = BG_Q8 + al256((size_t)TT * 1024);
constexpr size_t BG_VT8   = BG_K8 + al256((size_t)TT * 256);
constexpr size_t BG_Q8D   = BG_VT8 + al256((size_t)2 * 260 * 128 * 64);
constexpr size_t BG_K8D   = BG_Q8D + al256((size_t)TT * 1024);
constexpr size_t BG_VT8D  = BG_K8D + al256((size_t)TT * 1024);
constexpr size_t BG_F8END = BG_VT8D + al256((size_t)8 * 260 * 128 * 64);
constexpr size_t BG_YMOE  = 0;
constexpr size_t BG_END1  = al256((size_t)9 * TT * DM * 2);
constexpr size_t BG_SIZE  = BG_END0 > BG_END1 ? BG_END0 : BG_END1;
static_assert(BG_F8END <= BG_SIZE, "fp8 attention operands inside the big region");
constexpr size_t WS_END   = WS_BIG + BG_SIZE;

constexpr int CW_BAR = 4096;
constexpr int CW_CNT = 16384;
constexpr int CW_QUEUE = 20480;
constexpr int CW_KMAX = 24576;

constexpr int RING_BYTES = 151552;
constexpr int MISC_OFF = RING_BYTES;
constexpr int LDS_BYTES = 159744;

typedef __bf16 bf16x2_t __attribute__((ext_vector_type(2)));
__device__ __forceinline__ unsigned cvt_pk_bf16(float lo, float hi) { const f32x2 v = {lo, hi}; return __builtin_bit_cast(unsigned, __builtin_convertvector(v, bf16x2_t)); }
__device__ __forceinline__ bf16_t f2bf(float f) { unsigned u = __builtin_bit_cast(unsigned, f); return (bf16_t)((u + 0x7fffu + ((u >> 16) & 1u)) >> 16); }
__device__ __forceinline__ float bf2f(bf16_t b) { return __builtin_bit_cast(float, ((unsigned)b) << 16); }
__device__ __forceinline__ float bflo(unsigned w) { return __builtin_bit_cast(float, w << 16); }
__device__ __forceinline__ float bfhi(unsigned w) { return __builtin_bit_cast(float, w & 0xffff0000u); }
__device__ __forceinline__ float wave_sum(float v) {
#pragma unroll
    for (int o = 1; o < 64; o <<= 1) v += __shfl_xor(v, o);
    return v;
}
__device__ __forceinline__ float fast_exp(float x) { return __builtin_amdgcn_exp2f(x * 1.4426950408889634f); }
__device__ __forceinline__ float sigmoidf_(float x) { return 1.0f / (1.0f + __expf(-x)); }
__device__ __forceinline__ float siluf_(float x) { return x / (1.0f + __expf(-x)); }
__device__ __forceinline__ float gelu_tanh(float x) {
    const float u = 0.7978845608028654f * (x + 0.044715f * x * x * x);
    const float e = __expf(2.0f * u);
    const float t = 1.0f - 2.0f / (e + 1.0f);
    return 0.5f * x * (1.0f + t);
}
#define LDS_WAIT() asm volatile("s_waitcnt lgkmcnt(0)" ::: "memory")
#define VM_WAIT() asm volatile("s_waitcnt vmcnt(0)" ::: "memory")

#define XB_TMO      128
#define XB_XCNT(j)  (256  + 64 * (j))
#define XB_XSUB(j)  (1280 + 64 * (j))
#define XB_XGEN(j)  (2304 + 64 * (j))
#define XB_TOP      3328
#define XB_TOPGEN   3392
#define XCD_BAR_WORDS 3456
#define XB_SPIN_CAP (1u << 22)

__device__ __forceinline__ unsigned xb_ld(unsigned* p)              { return __hip_atomic_load(p, __ATOMIC_RELAXED, __HIP_MEMORY_SCOPE_AGENT); }
__device__ __forceinline__ unsigned xb_add(unsigned* p, unsigned v) { return __hip_atomic_fetch_add(p, v, __ATOMIC_RELAXED, __HIP_MEMORY_SCOPE_AGENT); }
__device__ __forceinline__ unsigned xb_xcc_id() { return (unsigned)__builtin_amdgcn_s_getreg((3 << 11) | 20) & 0xFu; }
#define XB_SPIN(cond, bar) do { unsigned _sp = 0; while (cond) { __builtin_amdgcn_s_sleep(1); \
    if ((++_sp & 255u) == 0u) { if (xb_ld(&(bar)[XB_TMO])) break; if (_sp > XB_SPIN_CAP) { atomicAdd(&(bar)[XB_TMO], 1u); break; } } } } while (0)

struct XcdBarrier { unsigned* bar; unsigned x; volatile LAS unsigned* st; };

__device__ __forceinline__ XcdBarrier xcd_barrier_post(unsigned* bar, volatile LAS unsigned* st) {
    XcdBarrier b; b.bar = bar; b.x = xb_xcc_id(); b.st = st;
    if (threadIdx.x == 0) { st[2] = xb_add(&bar[XB_XCNT(b.x)], 1u); st[3] = b.x; }
    return b;
}
__device__ __forceinline__ void xcd_barrier_complete(unsigned* bar, unsigned x, unsigned& nloc, unsigned& nx) {
    const unsigned G = gridDim.x * gridDim.y * gridDim.z;
    unsigned sum, cnt, mine, sp = 0u;
    for (;;) {
        sum = 0u; cnt = 0u; mine = 0u;
#pragma unroll
        for (unsigned j = 0; j < 16; ++j) { const unsigned c = xb_ld(&bar[XB_XCNT(j)]); sum += c; cnt += (c > 0u) ? 1u : 0u; mine = (j == x) ? c : mine; }
        if (sum == G) break;
        __builtin_amdgcn_s_sleep(1);
        if ((++sp & 255u) == 0u) { if (xb_ld(&bar[XB_TMO])) break; if (sp > XB_SPIN_CAP) { atomicAdd(&bar[XB_TMO], 1u); break; } }
    }
    nloc = mine > 0u ? mine : 1u; nx = cnt > 0u ? cnt : 1u;
}
__device__ __forceinline__ void xcd_barrier(const XcdBarrier& b, int wave_id) {
    const bool leader_thread = (wave_id == 0) && (__builtin_amdgcn_mbcnt_hi(~0u, __builtin_amdgcn_mbcnt_lo(~0u, 0u)) == 0u);
    asm volatile("s_waitcnt vmcnt(0)" ::: "memory");
    __syncthreads();
    if (leader_thread) {
        unsigned* bar = b.bar;
        __builtin_amdgcn_s_waitcnt(0);
        unsigned nloc = b.st[0], nx = b.st[1];
        if (nloc == 0u) { xcd_barrier_complete(bar, b.x, nloc, nx); b.st[0] = nloc; b.st[1] = nx; }
        const unsigned old = xb_add(&bar[XB_XSUB(b.x)], 1u);
        const unsigned gen = old / nloc;
        if (old + 1u == (gen + 1u) * nloc) {
            __builtin_amdgcn_fence(__ATOMIC_RELEASE, "agent");
            asm volatile("s_waitcnt vmcnt(0)" ::: "memory");
            const unsigned og = xb_add(&bar[XB_TOP], 1u);
            const unsigned tg = og / nx;
            if (og + 1u == (tg + 1u) * nx) xb_add(&bar[XB_TOPGEN], 1u);
            else XB_SPIN(xb_ld(&bar[XB_TOPGEN]) == tg, bar);
            __builtin_amdgcn_fence(__ATOMIC_ACQUIRE, "agent");
            xb_add(&bar[XB_XGEN(b.x)], 1u);
            asm volatile("s_waitcnt vmcnt(0)" ::: "memory");
        } else {
            XB_SPIN(xb_ld(&bar[XB_XGEN(b.x)]) == gen, bar);
            __builtin_amdgcn_fence(__ATOMIC_ACQUIRE, "agent");
            asm volatile("s_waitcnt vmcnt(0)" ::: "memory");
        }
    }
    __syncthreads();
}

__device__ __forceinline__ bf16x8 frag_rowk_l(const LAS bf16_t* p, int ld, int lane) {
    return *(const LAS bf16x8*)(p + (lane & 15) * ld + (lane >> 4) * 8);
}
__device__ __forceinline__ bf16x8 frag_rowk_g(const bf16_t* p, long ld, int lane) {
    return *(const bf16x8*)(p + (long)(lane & 15) * ld + (lane >> 4) * 8);
}
__device__ __forceinline__ bf16x8 frag_colk_l(unsigned p, int ldb, int lane) {
    const unsigned a0 = p + (unsigned)((8 * (lane >> 4) + ((lane & 15) >> 2)) * ldb + (lane & 3) * 8);
    const unsigned a1 = a0 + 4u * (unsigned)ldb;
    s16x4 lo, hi;
    asm volatile("ds_read_b64_tr_b16 %0, %2\n\tds_read_b64_tr_b16 %1, %3\n\ts_waitcnt lgkmcnt(0)" : "=&v"(lo), "=&v"(hi) : "v"(a0), "v"(a1) : "memory");
    return (bf16x8){lo[0], lo[1], lo[2], lo[3], hi[0], hi[1], hi[2], hi[3]};
}
#define MFMA16(a, b, c) __builtin_amdgcn_mfma_f32_16x16x32_bf16((a), (b), (c), 0, 0, 0)
namespace pg8 {
constexpr int BM = 256, BK = 64, HALF = 128, HTB = HALF * BK * 2, STAGE_BYTES = 8 * HTB, NXCD = 8, WGM = 8;
__device__ __forceinline__ int lds_byte(int r, int c) { const int st = (r >> 4) * 2 + (c >> 5), rr = r & 15, cc = c & 31, ob = rr * 64 + cc * 2; return st * 1024 + (ob ^ (((ob >> 9) & 1) << 5)); }
__device__ __forceinline__ void stage_rc(int b, int& R, int& C) { const int st = b / 1024, sb = b % 1024, swz = sb ^ (((sb >> 9) & 1) << 5); R = (st >> 1) * 16 + swz / 64; C = (st & 1) * 32 + (swz % 64) / 2; }
__device__ __forceinline__ int perm32(int rho) { const int n = rho >> 4, i = rho & 15; return 8 * (i >> 2) + 4 * n + (i & 3); }

struct Unit { int pm, pn, e; };
constexpr float WSCALE = 32.0f, WSCALE_INV = 1.0f / 32.0f;

struct DenseOrder {
    const bf16_t* A; const bf16_t* Bt; int ldab, kb, nM, nN, nwg, G, c;
    __device__ __forceinline__ void init(const bf16_t* A_, int lda_, const bf16_t* Bt_, int M, int N, int K_, int G_, int c_) { A = A_; ldab = lda_ * 2; Bt = Bt_; kb = K_ * 2; nM = M / BM; nN = N / BM; nwg = nM * nN; G = G_; c = c_; }
    __device__ __forceinline__ void init8(const void* A_, int ldab_, const void* Bt_, int M, int N, int K_, int G_, int c_) { A = (const bf16_t*)A_; ldab = ldab_; Bt = (const bf16_t*)Bt_; kb = K_; nM = M / BM; nN = N / BM; nwg = nM * nN; G = G_; c = c_; }
    __device__ __forceinline__ void prep(LAS unsigned char*) const {}
    __device__ __forceinline__ int units_of_me() const { return c < nwg ? (nwg - c + G - 1) / G : 0; }
    __device__ __forceinline__ int max_units() const { return (nwg + G - 1) / G; }
    __device__ __forceinline__ bool next(int i, Unit& u) const {
        const long L = (long)i * G + c; if (L >= nwg) return false;
        int wgid = (int)L; { const int q = nwg / NXCD, r = nwg % NXCD, xcd = wgid % NXCD, off = wgid / NXCD; wgid = (xcd < r ? xcd * (q + 1) : r * (q + 1) + (xcd - r) * q) + off; }
        const int nig = WGM * nN, gid = wgid / nig, fm = gid * WGM, gsz = (nM - fm) < WGM ? (nM - fm) : WGM;
        u.pm = fm + ((wgid % nig) % gsz); u.pn = (wgid % nig) / gsz; u.e = 0; return true;
    }
    __device__ __forceinline__ const char* a_base() const { return (const char*)A; }
    __device__ __forceinline__ unsigned a_off(const Unit& u, int r) const { return (unsigned)(u.pm * BM + r) * (unsigned)ldab; }
    __device__ __forceinline__ const char* b_ptr(const Unit& u) const { return (const char*)Bt + (size_t)u.pn * BM * kb; }
};

template <int MODE  >
struct MoeOrder {
    const void* A; const void* Bt; const int* list; const int* cnt; int ldab, kb, nN, G, c; size_t bstride;
    LAS int* tp; LAS int* cn; LAS int* rb;
    __device__ __forceinline__ void prep(LAS unsigned char* misc, int tid) {
        tp = (LAS int*)(misc + 64); cn = tp + 72; rb = cn + 72;
        if (tid < NEX1) cn[tid] = cnt[tid];
        __syncthreads();
        if (tid == 0) { int s = 0, q = 0; for (int e = 0; e < NEX1; ++e) { tp[e] = s; rb[e] = q; s += (cn[e] + BM - 1) / BM; q += cn[e]; } tp[NEX1] = s; rb[NEX1] = q; }
        __syncthreads();
    }
    __device__ __forceinline__ bool next(int i, Unit& u) const {
        const int total = tp[NEX1]; const long nu = (long)total * nN; const int per = (int)((nu + G - 1) / G);
        (void)per;
        long L = (long)i * G + c;
        if ((G & 7) == 0) L = ((long)i * 8 + (c & 7)) * (G >> 3) + (c >> 3);
        if (L >= nu) return false;
        const int tile = (int)(L / nN); u.pn = (int)(L % nN);
        int e = 0;
        for (int k = 1; k < NEX1; ++k) e += (tp[k] <= tile) ? 1 : 0;
        u.e = e; u.pm = tile - tp[e]; return true;
    }
    __device__ __forceinline__ const char* a_base() const { return (const char*)A; }
    __device__ __forceinline__ unsigned a_off(const Unit& u, int r) const {
        int pos = u.pm * BM + r; const int n = cn[u.e]; pos = pos < n ? pos : n - 1;
        if (MODE == 1) return (unsigned)(rb[u.e] + pos) * (unsigned)ldab;
        const int a = list[u.e * TT + pos];
        const int row = a < 8 * TT ? (a >> 3) : a - 8 * TT;
        return (unsigned)row * (unsigned)ldab;
    }
    __device__ __forceinline__ const char* b_ptr(const Unit& u) const { return (const char*)Bt + (size_t)u.e * bstride + (size_t)u.pn * BM * kb; }
};

typedef int v8i32 __attribute__((ext_vector_type(8)));
typedef int v4i32_ __attribute__((ext_vector_type(4)));
__device__ __forceinline__ v8i32 cat8(bf16x8 a, bf16x8 b) { const u32x4 x = __builtin_bit_cast(u32x4, a), y = __builtin_bit_cast(u32x4, b); return (v8i32){(int)x.x, (int)x.y, (int)x.z, (int)x.w, (int)y.x, (int)y.y, (int)y.z, (int)y.w}; }
template <bool FP8, class Epi, class Sched>
__device__ __forceinline__ void gemm_phase(LAS unsigned char* lds, const Sched& S, const Epi& E, int wave_id) {
    const int wid = wave_id; int lane = (int)__builtin_amdgcn_mbcnt_hi(~0u, __builtin_amdgcn_mbcnt_lo(~0u, 0u)); asm volatile("" : "+v"(lane));
    const int tid = wid * 64 + lane, wr = wid >> 2, wc = wid & 3, fr = lane & 15, fq = lane >> 4;
    const int kb = S.kb; int nt = kb / 128; asm volatile("" : "+s"(nt));
    unsigned voffB[2];
#pragma unroll
    for (int i = 0; i < 2; ++i) { int R, C; stage_rc(tid * 16 + i * 8192, R, C); const int Rb = (R & ~31) + perm32(R & 31);
        voffB[i] = (unsigned)(Rb * kb) + (unsigned)C * 2u; }
#define PG8_AOFF(u, h, i) ({ int _tz = tid; asm volatile("" : "+v"(_tz)); int _R, _C; stage_rc(_tz * 16 + (i) * 8192, _R, _C); S.a_off((u), (h) * HALF + _R) + (unsigned)_C * 2u; })
    const size_t kstep = (size_t)(BK * 2);
    const size_t hstepB = (size_t)HALF * kb;
    const unsigned ldsw = (unsigned)wid * 1024u;
    const int aoff = lds_byte(wr * 64 + fr, fq * 8), boff = lds_byte(wc * 32 + fr, fq * 8);
#define PG8_SA(b, h) (((b) * 2 + (h)) * HTB)
#define PG8_SB(b, h) ((4 + (b) * 2 + (h)) * HTB)
#define PG8_STAGE(bufoff, gbase, v0, v1) do { \
        __builtin_amdgcn_global_load_lds((const unsigned*)((const char*)(gbase) + (v0)), (LAS unsigned*)(lds + (bufoff) + ldsw), 16, 0, 0); \
        __builtin_amdgcn_global_load_lds((const unsigned*)((const char*)(gbase) + (v1)), (LAS unsigned*)(lds + (bufoff) + ldsw + 8192), 16, 0, 0); } while (0)
#define PG8_VOFFB(i) ({ int _tz = tid; asm volatile("" : "+v"(_tz)); int _R, _C; stage_rc(_tz * 16 + (i) * 8192, _R, _C); (unsigned)(((_R & ~31) + perm32(_R & 31)) * kb) + (unsigned)_C * 2u; })
#define PG8_STAGE_B(bufoff, gbase) do { if constexpr (FP8) { const unsigned _v0 = PG8_VOFFB(0), _v1 = PG8_VOFFB(1); PG8_STAGE(bufoff, gbase, _v0, _v1); } else PG8_STAGE(bufoff, gbase, voffB[0], voffB[1]); } while (0)
#define PG8_LD8(off) __builtin_shufflevector(*(const LAS v4i32_*)(lds + (off)), *(const LAS v4i32_*)(lds + (off) + 1024), 0, 1, 2, 3, 4, 5, 6, 7)
#define PG8_LDA(dst, b, h) do { _Pragma("unroll") for (int m = 0; m < 4; ++m) { if constexpr (FP8) dst##8[m] = PG8_LD8(PG8_SA(b, h) + aoff + m * 2048); else { _Pragma("unroll") for (int k = 0; k < 2; ++k) dst[m][k] = *(const LAS bf16x8*)(lds + PG8_SA(b, h) + aoff + m * 2048 + k * 1024); } } } while (0)
#define PG8_LDB(dst, b, h) do { _Pragma("unroll") for (int n = 0; n < 2; ++n) { if constexpr (FP8) dst##8[n] = PG8_LD8(PG8_SB(b, h) + boff + n * 2048); else { _Pragma("unroll") for (int k = 0; k < 2; ++k) dst[n][k] = *(const LAS bf16x8*)(lds + PG8_SB(b, h) + boff + n * 2048 + k * 1024); } } } while (0)
#define PG8_MMA(ai, bj, At, Bt) do { __builtin_amdgcn_s_setprio(1); _Pragma("unroll") for (int m = 0; m < 4; ++m) _Pragma("unroll") for (int n = 0; n < 2; ++n) { \
        if constexpr (FP8) asm volatile("v_mfma_f32_16x16x128_f8f6f4 %0, %1, %2, %0" : "+v"(acc[ai][bj][m][n]) : "v"(Bt##8[n]), "v"(At##8[m])); \
        else { _Pragma("unroll") for (int k = 0; k < 2; ++k) acc[ai][bj][m][n] = __builtin_amdgcn_mfma_f32_16x16x32_bf16(Bt[n][k], At[m][k], acc[ai][bj][m][n], 0, 0, 0); } } \
        __builtin_amdgcn_s_setprio(0); } while (0)
#define PG8_WAIT_V(n) asm volatile("s_waitcnt vmcnt(" #n ")" ::: "memory")
#define PG8_WAIT_L(n) asm volatile("s_waitcnt lgkmcnt(" #n ")" ::: "memory")
#define PG8_BAR __builtin_amdgcn_s_barrier()
#define PG8_SCHED __builtin_amdgcn_sched_barrier(0)
    Unit cur, nxt; int ui = 0;
    if (!S.next(0, cur)) return;
    f32x4 acc[2][2][4][2];
#pragma unroll
    for (int a = 0; a < 2; ++a)
#pragma unroll
        for (int b = 0; b < 2; ++b)
#pragma unroll
            for (int m = 0; m < 4; ++m)
#pragma unroll
                for (int n = 0; n < 2; ++n) acc[a][b][m][n] = (f32x4){0.f, 0.f, 0.f, 0.f};
    bf16x8 At[4][2], B0[2][2], B1[2][2]; v8i32 At8[4], B08[2], B18[2];
    const char* const gA = S.a_base();
    const char* cB = S.b_ptr(cur);
    unsigned oc00, oc01, oc10, oc11;
    oc00 = PG8_AOFF(cur, 0, 0); oc01 = PG8_AOFF(cur, 0, 1); oc10 = PG8_AOFF(cur, 1, 0); oc11 = PG8_AOFF(cur, 1, 1);
    PG8_STAGE_B(PG8_SB(0, 0), cB); PG8_STAGE_B(PG8_SB(0, 1), cB + hstepB); PG8_STAGE(PG8_SA(0, 0), gA, oc00, oc01); PG8_STAGE(PG8_SA(0, 1), gA, oc10, oc11);
    if (wr == 1) PG8_BAR;
    PG8_WAIT_V(2); PG8_BAR;
    PG8_STAGE_B(PG8_SB(1, 0), cB + kstep); PG8_STAGE(PG8_SA(1, 0), gA + kstep, oc00, oc01); PG8_STAGE_B(PG8_SB(1, 1), cB + hstepB + kstep);
    PG8_WAIT_V(6); PG8_BAR;
    for (;;) {
        const bool has_next = S.next(ui + 1, nxt);
        const char* nB = cB;
        {
            u32x4 on = {oc00, oc01, oc10, oc11};
            if (has_next) { on.x = PG8_AOFF(nxt, 0, 0); on.y = PG8_AOFF(nxt, 0, 1); on.z = PG8_AOFF(nxt, 1, 0); on.w = PG8_AOFF(nxt, 1, 1); nB = S.b_ptr(nxt); }
            *(LAS u32x4*)(lds + STAGE_BYTES + tid * 16) = on;
        }
        for (int t = 0; t < nt; t += 2) {
            const bool last = (t == nt - 2);
            const char* a1 = gA + (size_t)(t + 1) * kstep;
            const char* a2 = last ? gA : gA + (size_t)(t + 2) * kstep; const char* b2 = last ? nB : cB + (size_t)(t + 2) * kstep;
            const char* a3 = a2 + kstep; const char* b3 = b2 + kstep;
            unsigned s00 = oc00, s01 = oc01, s10 = oc10, s11 = oc11;
            if (last) { const u32x4 on = *(const LAS u32x4*)(lds + STAGE_BYTES + tid * 16); s00 = on.x; s01 = on.y; s10 = on.z; s11 = on.w; }
            PG8_LDB(B0, 0, 0); PG8_LDB(B1, 0, 1); PG8_SCHED; PG8_LDA(At, 0, 0); PG8_STAGE(PG8_SA(1, 1), a1, oc10, oc11);
            PG8_WAIT_V(8); PG8_WAIT_L(0); PG8_BAR; PG8_MMA(0, 0, At, B0); PG8_MMA(0, 1, At, B1); PG8_BAR; PG8_SCHED;
            PG8_LDA(At, 0, 1); PG8_STAGE_B(PG8_SB(0, 0), b2); PG8_STAGE_B(PG8_SB(0, 1), b2 + hstepB); PG8_STAGE(PG8_SA(0, 0), a2, s00, s01);
            PG8_WAIT_V(8); PG8_WAIT_L(0); PG8_BAR; PG8_MMA(1, 0, At, B0); PG8_MMA(1, 1, At, B1); PG8_BAR; PG8_SCHED;
            PG8_LDB(B0, 1, 0); PG8_LDB(B1, 1, 1); PG8_SCHED; PG8_LDA(At, 1, 0); PG8_STAGE(PG8_SA(0, 1), a2, s10, s11);
            PG8_WAIT_V(8); PG8_WAIT_L(0); PG8_BAR; PG8_MMA(0, 0, At, B0); PG8_MMA(0, 1, At, B1); PG8_BAR; PG8_SCHED;
            PG8_LDA(At, 1, 1); PG8_STAGE_B(PG8_SB(1, 0), b3); PG8_STAGE_B(PG8_SB(1, 1), b3 + hstepB); PG8_STAGE(PG8_SA(1, 0), a3, s00, s01);
            PG8_WAIT_V(8); PG8_WAIT_L(0); PG8_BAR; PG8_MMA(1, 0, At, B0); PG8_MMA(1, 1, At, B1); PG8_BAR; PG8_SCHED;
        }
        if (wr == 0) PG8_BAR;
        E(acc, cur, wr, wc, fr, fq);
        if (!has_next) break;
#pragma unroll
        for (int a = 0; a < 2; ++a)
#pragma unroll
            for (int b = 0; b < 2; ++b)
#pragma unroll
                for (int m = 0; m < 4; ++m)
#pragma unroll
                    for (int n = 0; n < 2; ++n) acc[a][b][m][n] = (f32x4){0.f, 0.f, 0.f, 0.f};
        { const u32x4 on = *(const LAS u32x4*)(lds + STAGE_BYTES + tid * 16); oc00 = on.x; oc01 = on.y; oc10 = on.z; oc11 = on.w; }
        cur = nxt; cB = nB; ++ui;
        if (wr == 1) PG8_BAR;
    }
    PG8_WAIT_V(0);
    PG8_BAR;
#undef PG8_SA
#undef PG8_SB
#undef PG8_STAGE
#undef PG8_STAGE_B
#undef PG8_AOFF
#undef PG8_VOFFB
#undef PG8_LD8
#undef PG8_LDA
#undef PG8_LDB
#undef PG8_MMA
#undef PG8_WAIT_V
#undef PG8_WAIT_L
#undef PG8_BAR
#undef PG8_SCHED
}

struct EpiStore {
    bf16_t* O; int ldc; float scale;
    __device__ __forceinline__ void operator()(const f32x4 (&acc)[2][2][4][2], const Unit& u, int wr, int wc, int fr, int fq) const {
        const int row0 = u.pm * BM + wr * 64 + fr, col0 = u.pn * BM + wc * 32 + 8 * fq;
#pragma unroll
        for (int ai = 0; ai < 2; ++ai)
#pragma unroll
            for (int m = 0; m < 4; ++m) { bf16_t* rowp = O + (size_t)(row0 + ai * HALF + m * 16) * ldc + col0;
#pragma unroll
                for (int bj = 0; bj < 2; ++bj) { const f32x4 v0 = acc[ai][bj][m][0] * scale, v1 = acc[ai][bj][m][1] * scale;
                    u32x4 w; w.x = cvt_pk_bf16(v0[0], v0[1]); w.y = cvt_pk_bf16(v0[2], v0[3]); w.z = cvt_pk_bf16(v1[0], v1[1]); w.w = cvt_pk_bf16(v1[2], v1[3]);
                    *(u32x4*)(rowp + bj * HALF) = w; } }
    }
};
struct EpiGlu {
    const bf16_t* Z; const float* b; bf16_t* MIX;
    __device__ __forceinline__ void operator()(const f32x4 (&acc)[2][2][4][2], const Unit& u, int wr, int wc, int fr, int fq) const {
        const int row0 = u.pm * BM + wr * 64 + fr, col0 = u.pn * BM + wc * 32 + 8 * fq;
#pragma unroll
        for (int bj = 0; bj < 2; ++bj) {
            const f32x4 b0 = *(const f32x4*)(b + col0 + bj * HALF), b1 = *(const f32x4*)(b + col0 + bj * HALF + 4);
#pragma unroll
            for (int ai = 0; ai < 2; ++ai)
#pragma unroll
                for (int m = 0; m < 4; ++m) { const size_t row = (size_t)(row0 + ai * HALF + m * 16);
                    const u32x4 zz = *(const u32x4*)(Z + row * 1024 + col0 + bj * HALF);
                    const f32x4 v0 = acc[ai][bj][m][0] + b0, v1 = acc[ai][bj][m][1] + b1;
                    u32x4 w;
                    w.x = cvt_pk_bf16(bflo(zz.x) * sigmoidf_(v0[0]), bfhi(zz.x) * sigmoidf_(v0[1]));
                    w.y = cvt_pk_bf16(bflo(zz.y) * sigmoidf_(v0[2]), bfhi(zz.y) * sigmoidf_(v0[3]));
                    w.z = cvt_pk_bf16(bflo(zz.z) * sigmoidf_(v1[0]), bfhi(zz.z) * sigmoidf_(v1[1]));
                    w.w = cvt_pk_bf16(bflo(zz.w) * sigmoidf_(v1[2]), bfhi(zz.w) * sigmoidf_(v1[3]));
                    *(u32x4*)(MIX + row * DM + 1024 + col0 + bj * HALF) = w; }
        }
    }
};
struct EpiE1 {
    unsigned char* H; const LAS int* cn; const LAS int* rb;
    __device__ __forceinline__ void operator()(const f32x4 (&acc)[2][2][4][2], const Unit& u, int wr, int wc, int fr, int fq) const {
        const int n = cn[u.e]; const int colh = u.pn * 128 + wc * 32 + 8 * fq;
#pragma unroll
        for (int ai = 0; ai < 2; ++ai)
#pragma unroll
            for (int m = 0; m < 4; ++m) { const int pos = u.pm * BM + ai * HALF + wr * 64 + m * 16 + fr;
                if (pos < n) { const int a = rb[u.e] + pos;
                    float sc = WSCALE_INV; asm volatile("" : "+v"(sc));
                    const f32x4 g0 = acc[ai][0][m][0] * sc, g1 = acc[ai][0][m][1] * sc, u0 = acc[ai][1][m][0] * sc, u1 = acc[ai][1][m][1] * sc;
                    u32x2 w;
                    w.x = (unsigned)__builtin_amdgcn_cvt_pk_fp8_f32(siluf_(g0[0]) * u0[0], siluf_(g0[1]) * u0[1], 0, false);
                    w.x = (unsigned)__builtin_amdgcn_cvt_pk_fp8_f32(siluf_(g0[2]) * u0[2], siluf_(g0[3]) * u0[3], (int)w.x, true);
                    w.y = (unsigned)__builtin_amdgcn_cvt_pk_fp8_f32(siluf_(g1[0]) * u1[0], siluf_(g1[1]) * u1[1], 0, false);
                    w.y = (unsigned)__builtin_amdgcn_cvt_pk_fp8_f32(siluf_(g1[2]) * u1[2], siluf_(g1[3]) * u1[3], (int)w.y, true);
                    *(u32x2*)(H + (size_t)a * EHID + colh) = w; }
                __builtin_amdgcn_sched_barrier(0); }
    }
};
struct EpiE2 {
    unsigned char* Y; const float* wgt; const LAS int* cn; const LAS int* rb;
    __device__ __forceinline__ void operator()(const f32x4 (&acc)[2][2][4][2], const Unit& u, int wr, int wc, int fr, int fq) const {
        const int n = cn[u.e]; const int col0 = u.pn * BM + wc * 32 + 8 * fq;
#pragma unroll
        for (int ai = 0; ai < 2; ++ai)
#pragma unroll
            for (int m = 0; m < 4; ++m) { const int pos = u.pm * BM + ai * HALF + wr * 64 + m * 16 + fr;
                if (pos < n) { const int a = rb[u.e] + pos; float ws = wgt[u.e * TT + pos] * WSCALE_INV; asm volatile("" : "+v"(ws));
                    unsigned char* rowp = Y + (size_t)a * DM + col0;
#pragma unroll
                    for (int bj = 0; bj < 2; ++bj) { const f32x4 v0 = acc[ai][bj][m][0] * ws, v1 = acc[ai][bj][m][1] * ws;
                        u32x2 w;
                        w.x = (unsigned)__builtin_amdgcn_cvt_pk_fp8_f32(v0[0], v0[1], 0, false); w.x = (unsigned)__builtin_amdgcn_cvt_pk_fp8_f32(v0[2], v0[3], (int)w.x, true);
                        w.y = (unsigned)__builtin_amdgcn_cvt_pk_fp8_f32(v1[0], v1[1], 0, false); w.y = (unsigned)__builtin_amdgcn_cvt_pk_fp8_f32(v1[2], v1[3], (int)w.y, true);
                        *(u32x2*)(rowp + bj * HALF) = w; } }
                __builtin_amdgcn_sched_barrier(0); }
    }
};
}
struct KArgs {
    const float* in[34];
    float* out;
    unsigned char* ws;
    int ph_lo, ph_hi;
};
struct Params {
    float* out;
    unsigned char* ws;
    LAS unsigned long long* ptab;
    int ph_lo, ph_hi;
    __device__ __forceinline__ const float* inp(int k) const {
        const unsigned long long v = ptab[k];
        const unsigned lo = __builtin_amdgcn_readfirstlane((unsigned)v), hi = __builtin_amdgcn_readfirstlane((unsigned)(v >> 32));
        return (const float*)(((unsigned long long)hi << 32) | lo);
    }
};
struct Ctx {
    LAS unsigned char* lds;
    int tid, lane, wave, G, bid;
    int gw, ngw;
};

__device__ __forceinline__ void tr_item(const float* W, int N, bf16_t* WT, int ldt, int k0, int n0, int orow0, LAS float* scr, int lane) {
#pragma unroll 8
    for (int i = 0; i < 32; ++i) { const int kk = 2 * i + (lane >> 5); scr[kk * 33 + (lane & 31)] = W[(size_t)(k0 + kk) * N + n0 + (lane & 31)]; }
    LDS_WAIT(); asm volatile("" ::: "memory");
    const int c = lane & 7;
#pragma unroll
    for (int j = 0; j < 4; ++j) { const int n = (lane >> 3) + 8 * j; const LAS float* s = scr + (8 * c) * 33 + n;
        u32x4 o; o.x = cvt_pk_bf16(s[0 * 33], s[1 * 33]); o.y = cvt_pk_bf16(s[2 * 33], s[3 * 33]); o.z = cvt_pk_bf16(s[4 * 33], s[5 * 33]); o.w = cvt_pk_bf16(s[6 * 33], s[7 * 33]);
        *(u32x4*)(WT + (size_t)(orow0 + n) * ldt + k0 + 8 * c) = o; }
    LDS_WAIT(); asm volatile("" ::: "memory");
}
__device__ __forceinline__ void tr_item64(const float* W, int N, bf16_t* WT, int ldt, int k0, int n0, int orow0, LAS float* scr, int lane) {
    f32x4 v[16];
    const float* src = W + (size_t)(k0 + (lane >> 4)) * N + n0 + 4 * (lane & 15);
#pragma unroll
    for (int i = 0; i < 16; ++i) v[i] = __builtin_nontemporal_load((const f32x4*)(src + (size_t)(4 * i) * N));
#pragma unroll
    for (int i = 0; i < 16; ++i) { LAS float* d = scr + (4 * i + (lane >> 4)) * 65 + 4 * (lane & 15); d[0] = v[i][0]; d[1] = v[i][1]; d[2] = v[i][2]; d[3] = v[i][3]; }
    LDS_WAIT(); asm volatile("" ::: "memory");
    const int c = lane & 7;
#pragma unroll
    for (int j = 0; j < 8; ++j) { const int n = (lane >> 3) + 8 * j; const LAS float* s = scr + (8 * c) * 65 + n;
        u32x4 o; o.x = cvt_pk_bf16(s[0 * 65], s[1 * 65]); o.y = cvt_pk_bf16(s[2 * 65], s[3 * 65]); o.z = cvt_pk_bf16(s[4 * 65], s[5 * 65]); o.w = cvt_pk_bf16(s[6 * 65], s[7 * 65]);
        *(u32x4*)(WT + (size_t)(orow0 + n) * ldt + k0 + 8 * c) = o; }
    LDS_WAIT(); asm volatile("" ::: "memory");
}
__device__ __forceinline__ void tr_item64_fp8(const float* W, int N, unsigned char* WT, int ldt, int k0, int n0, int orow0, LAS float* scr, int lane, float wscale = pg8::WSCALE) {
    f32x4 v[16];
    const float* src = W + (size_t)(k0 + (lane >> 4)) * N + n0 + 4 * (lane & 15);
#pragma unroll
    for (int i = 0; i < 16; ++i) v[i] = __builtin_nontemporal_load((const f32x4*)(src + (size_t)(4 * i) * N));
#pragma unroll
    for (int i = 0; i < 16; ++i) { LAS float* d = scr + (4 * i + (lane >> 4)) * 65 + 4 * (lane & 15); d[0] = v[i][0]; d[1] = v[i][1]; d[2] = v[i][2]; d[3] = v[i][3]; }
    LDS_WAIT(); asm volatile("" ::: "memory");
    const int c = lane & 3;
#pragma unroll
    for (int j = 0; j < 4; ++j) { const int n = (lane >> 2) + 16 * j; const LAS float* s = scr + (16 * c) * 65 + n;
        u32x4 o;
        o.x = (unsigned)__builtin_amdgcn_cvt_pk_fp8_f32(s[0 * 65] * wscale, s[1 * 65] * wscale, 0, false);   o.x = (unsigned)__builtin_amdgcn_cvt_pk_fp8_f32(s[2 * 65] * wscale, s[3 * 65] * wscale, (int)o.x, true);
        o.y = (unsigned)__builtin_amdgcn_cvt_pk_fp8_f32(s[4 * 65] * wscale, s[5 * 65] * wscale, 0, false);   o.y = (unsigned)__builtin_amdgcn_cvt_pk_fp8_f32(s[6 * 65] * wscale, s[7 * 65] * wscale, (int)o.y, true);
        o.z = (unsigned)__builtin_amdgcn_cvt_pk_fp8_f32(s[8 * 65] * wscale, s[9 * 65] * wscale, 0, false);   o.z = (unsigned)__builtin_amdgcn_cvt_pk_fp8_f32(s[10 * 65] * wscale, s[11 * 65] * wscale, (int)o.z, true);
        o.w = (unsigned)__builtin_amdgcn_cvt_pk_fp8_f32(s[12 * 65] * wscale, s[13 * 65] * wscale, 0, false); o.w = (unsigned)__builtin_amdgcn_cvt_pk_fp8_f32(s[14 * 65] * wscale, s[15 * 65] * wscale, (int)o.w, true);
        *(u32x4*)(WT + (size_t)(orow0 + n) * ldt + k0 + 16 * c) = o; }
    LDS_WAIT(); asm volatile("" ::: "memory");
}
__device__ __forceinline__ void tr_dense(const float* W, int K, int N, bf16_t* WT, int item, LAS float* scr, int lane) {
    const int nblk = N / 32, kb = item / nblk, nb = item % nblk;
    tr_item(W, N, WT, K, 64 * kb, 32 * nb, 32 * nb, scr, lane);
}

__device__ __forceinline__ void s5_tables(const Params& p, Ctx& C, int dir, int g) {
    LAS f32x2* PW = (LAS f32x2*)C.lds;
    LAS f32x2* BB = PW + 65 * 64;
    LAS f32x2* CX = BB + 64 * 16;
    const float* a_re = p.inp(11); const float* a_im = p.inp(12); const float* log_dt = p.inp(13);
    const float* b_re = p.inp(14); const float* b_im = p.inp(15); const float* c_re = p.inp(16); const float* c_im = p.inp(17);
    const int tid = C.tid;
    if (tid < 64) {
        const int pp = tid;
        const float dt = __expf(log_dt[dir * 64 + g]);
        const float are = a_re[(dir * 64 + g) * 64 + pp], aim = a_im[(dir * 64 + g) * 64 + pp];
        const float zr = are * dt, zi = aim * dt;
        const float mag = __expf(zr);
        double rev = (double)zi * 0.15915494309189535; rev -= floor(rev);
        const float cs = __builtin_amdgcn_cosf((float)rev), sn = __builtin_amdgcn_sinf((float)rev);
        const float abr = mag * cs, abi = mag * sn;
        const float den = are * are + aim * aim, nr = abr - 1.0f, ni = abi;
        const float fre = (nr * are + ni * aim) / den, fim = (ni * are - nr * aim) / den;
        float pr = 1.0f, pi = 0.0f;
#pragma unroll 1
        for (int n = 0; n <= 64; ++n) { PW[n * 64 + pp] = (f32x2){pr, pi}; const float t = pr * abr - pi * abi; pi = pr * abi + pi * abr; pr = t; }
        for (int j = 0; j < 16; ++j) { const float br = b_re[(g * 64 + pp) * 16 + j], bi = b_im[(g * 64 + pp) * 16 + j];
            BB[pp * 16 + j] = (f32x2){fre * br - fim * bi, fre * bi + fim * br}; }
    }
    for (int q = tid; q < 1024; q += NTHR) { const int i = q >> 6, pp = q & 63; CX[i * 64 + pp] = (f32x2){c_re[(g * 16 + i) * 64 + pp], c_im[(g * 16 + i) * 64 + pp]}; }
    __syncthreads();
    bf16_t* KN = (bf16_t*)(p.ws + WS_KN) + (size_t)(dir * 64 + g) * 16 * 1024;
    float* APOW = (float*)(p.ws + WS_APOW) + (size_t)(dir * 64 + g) * 64 * 128;
    float* AL = (float*)(p.ws + WS_AL) + (size_t)(dir * 64 + g) * 128;
#pragma unroll 1
    for (int q = 0; q < 32; ++q) { const int idx = tid + NTHR * q; const int n = idx >> 8, i = (idx >> 4) & 15, j = idx & 15;
        float s = 0.f;
#pragma unroll 4
        for (int pp = 0; pp < 64; ++pp) { const f32x2 c = CX[i * 64 + pp], w = PW[n * 64 + pp], b = BB[pp * 16 + j];
            const float gr = c.x * b.x - c.y * b.y, gi = c.x * b.y + c.y * b.x;
            s += gr * w.x - gi * w.y; }
        KN[(size_t)i * 1024 + n * 16 + j] = f2bf(s); }
    for (int q = tid; q < 4096; q += NTHR) { const int t = q >> 6, pp = q & 63; const f32x2 w = PW[(t + 1) * 64 + pp]; *(f32x2*)(APOW + (size_t)t * 128 + 2 * pp) = w; }
    if (tid < 64) { const f32x2 w = PW[64 * 64 + tid]; *(f32x2*)(AL + 2 * tid) = w; }
    { bf16_t* BBT = (bf16_t*)(p.ws + WS_BBT) + (size_t)(dir * 64 + g) * 128 * 16;
      for (int q = tid; q < 2048; q += NTHR) { const int pq = q >> 4, j = q & 15; const f32x2 b = BB[(pq & 63) * 16 + j]; BBT[q] = f2bf(pq < 64 ? b.x : b.y); } }
    if (dir == 0) { bf16_t* CCt = (bf16_t*)(p.ws + WS_CC) + (size_t)g * 16 * 128;
        for (int q = tid; q < 2048; q += NTHR) { const int i = q >> 7, pq = q & 127; const f32x2 c = CX[i * 64 + (pq & 63)]; CCt[i * 128 + pq] = f2bf(pq < 64 ? c.x : -c.y); } }
    __syncthreads();
}

__device__ __forceinline__ void phase_p0(const Params& p, Ctx& C) {
    for (int task = C.bid; task < 128; task += C.G) s5_tables(p, C, task >> 6, task & 63);
    {
        const int gt = C.bid * NTHR + C.tid, ngt = C.G * NTHR;
        float* R128 = (float*)(p.ws + WS_ROPE128); float* R64 = (float*)(p.ws + WS_ROPE64);
        for (int q = gt; q < 256 * 64 + 256 * 32; q += ngt) {
            int pos, i, half; float* dst;
            if (q < 256 * 64) { pos = q >> 6; i = q & 63; half = 64; dst = R128 + (size_t)q * 2; }
            else { const int r = q - 256 * 64; pos = r >> 5; i = r & 31; half = 32; dst = R64 + (size_t)r * 2; }
            const float freq = exp2f(-(float)i / (float)half * 13.287712379549449f);
            const float ang = (float)pos * freq;
            double rev = (double)ang * 0.15915494309189535; rev -= floor(rev);
            dst[0] = __builtin_amdgcn_cosf((float)rev); dst[1] = __builtin_amdgcn_sinf((float)rev);
        }
        bf16_t* RWT = (bf16_t*)(p.ws + WS_RWT); const float* rw = p.inp(26);
        for (int q = gt; q < 2 * 64 * DM; q += ngt) { const int L = q / (64 * DM), r = q % (64 * DM), e = r / DM, k = r % DM;
            const float w = rw[((size_t)L * DM + k) * 64 + e]; const bf16_t hi = f2bf(w); const bf16_t lo = f2bf(w - bf2f(hi));
            RWT[((size_t)(L * 2 + 0) * 64 + e) * DM + k] = hi; RWT[((size_t)(L * 2 + 1) * 64 + e) * DM + k] = lo; }
    }
    {
        const float* cvec = p.inp(1); const float* cctx = p.inp(3); const float* mw = p.inp(4);
        float* MODP = (float*)(p.ws + WS_MODP);
        for (int task = C.gw; task < 2 * 32 * 48; task += C.ngw) {
            const int L = task / (32 * 48), r = task % (32 * 48), kb = r / 48, cb = r % 48;
            const float sc = siluf_(cvec[64 * kb + C.lane]), sx = siluf_(cctx[64 * kb + C.lane]);
            f32x4 a0 = {0.f, 0.f, 0.f, 0.f}, a1 = {0.f, 0.f, 0.f, 0.f};
            const float* wp = mw + ((size_t)L * DM + 64 * kb) * 12288 + 256 * cb + 4 * C.lane;
#pragma unroll 8
            for (int kk = 0; kk < 64; ++kk) { const f32x4 w = *(const f32x4*)(wp + (size_t)kk * 12288);
                const float s0 = __shfl(sc, kk), s1 = __shfl(sx, kk);
                a0 += w * s0; a1 += w * s1; }
            *(f32x4*)(MODP + ((size_t)((L * 32 + kb) * 2 + 0)) * 12288 + 256 * cb + 4 * C.lane) = a0;
            *(f32x4*)(MODP + ((size_t)((L * 32 + kb) * 2 + 1)) * 12288 + 256 * cb + 4 * C.lane) = a1;
        }
    }
    {
        LAS float* scr = (LAS float*)(C.lds + C.wave * 17408);
        constexpr int J0 = (DM / 64) * (EV_IN / 64), J3 = (DM / 64) * (OD_IN / 64);
        for (int it = C.gw; it < J0 + J3; it += C.ngw) {
            const bool l1 = it >= J0; const int r = l1 ? it - J0 : it; const int N = l1 ? OD_IN : EV_IN; const int nblk = N / 64, kb = r / nblk, nb = r % nblk;
            tr_item64_fp8(p.inp(l1 ? 21 : 8), N, (unsigned char*)(p.ws + (l1 ? WS_WIN1 : WS_WIN0)), DM, 64 * kb, 64 * nb, 64 * nb, scr, C.lane, 32.0f);
        }
        LAS float* scr2 = (LAS float*)(C.lds + C.wave * 17408);
        constexpr int I1 = (DM / 64) * (DM / 32), I2 = (1024 / 64) * (1024 / 32), I4 = I1;
        for (int it = C.gw; it < I1 + I2 + I4; it += C.ngw) {
            int r = it;
            if (r < I1) { tr_dense(p.inp(9), DM, DM, (bf16_t*)(p.ws + WS_WOUT0), r, scr2, C.lane); continue; } r -= I1;
            if (r < I2) { tr_dense(p.inp(19), 1024, 1024, (bf16_t*)(p.ws + WS_WGLU), r, scr2, C.lane); continue; } r -= I2;
            tr_dense(p.inp(22), DM, DM, (bf16_t*)(p.ws + WS_WOUT1), r, scr2, C.lane);
        }
    }
}
__device__ __forceinline__ void phase_p1(const Params& p, Ctx& C) {
    const float* MODP = (const float*)(p.ws + WS_MODP); float* MODF = (float*)(p.ws + WS_MODF); const float* mb = p.inp(5);
    for (int q = C.bid * NTHR + C.tid; q < 2 * 2 * 12288; q += C.G * NTHR) { const int L = q / (2 * 12288), v = (q / 12288) & 1, col = q % 12288;
        float s = mb[L * 12288 + col];
        for (int kb = 0; kb < 32; ++kb) s += MODP[((size_t)((L * 32 + kb) * 2 + v)) * 12288 + col];
        MODF[q] = s; }
}
__device__ __forceinline__ const float* modv(const Params& p, int L, int v, int k) { return (const float*)(p.ws + WS_MODF) + (size_t)(L * 2 + v) * 12288 + k * DM; }

__device__ __forceinline__ void stage_vec(LAS float* dst, const float* src, int tid) { *(LAS f32x4*)(dst + 4 * tid) = *(const f32x4*)(src + 4 * tid); }
__device__ __forceinline__ void conv_item(const Params& p, Ctx& C, int L, int it) {
    LAS float* scr = (LAS float*)(C.lds + C.wave * 17408);
    unsigned char* GU = (unsigned char*)(p.ws + WS_GU) + (size_t)L * NEX1 * 1024 * DM; unsigned char* DT = (unsigned char*)(p.ws + WS_DT) + (size_t)L * NEX1 * DM * EHID;
    const int e = it / 768, r = it % 768, which = r >> 8, q = r & 255;
    if (which < 2) {
        const float* W = (e < 64) ? p.inp(28 + which) + ((size_t)(L * 64 + e)) * DM * EHID : p.inp(31 + which) + (size_t)L * DM * EHID;
        const int kb = q >> 3, nb = q & 7, n0 = 64 * nb;
        tr_item64_fp8(W, EHID, GU + (size_t)e * 1024 * DM, DM, 64 * kb, n0, 256 * (n0 >> 7) + (n0 & 127) + (which ? 128 : 0), scr, C.lane);
    } else {
        const float* W = (e < 64) ? p.inp(30) + ((size_t)(L * 64 + e)) * EHID * DM : p.inp(33) + (size_t)L * EHID * DM;
        const int kb = q >> 5, nb = q & 31;
        tr_item64_fp8(W, DM, DT + (size_t)e * DM * EHID, EHID, 64 * kb, 64 * nb, 64 * nb, scr, C.lane);
    }
}
__device__ __forceinline__ void conv_queue(const Params& p, Ctx& C, int quota) {
    unsigned* head = (unsigned*)(p.ws + WS_CTL) + CW_QUEUE + 128;
    const int batch = quota < 8 ? quota : 8;
    for (int done = 0; done < quota; done += batch) {
        int it0 = 0; if (C.lane == 0) it0 = (int)atomicAdd(head, (unsigned)batch);
        it0 = __builtin_amdgcn_readfirstlane(it0);
        if (it0 >= NEX1 * 768) break;
        for (int k = 0; k < batch && it0 + k < NEX1 * 768; ++k) conv_item(p, C, 1, it0 + k);
    }
}
__device__ __forceinline__ void phase_modulate(const Params& p, Ctx& C, int L) {
    unsigned char* XA8 = (unsigned char*)(p.ws + WS_XA);
    const float* X2 = (const float*)(p.ws + WS_HX2);
    LAS float* MV = (LAS float*)C.lds;
    for (int v = 0; v < 2; ++v) { stage_vec(MV + (v * 2 + 0) * DM, modv(p, L, v, 0), C.tid); stage_vec(MV + (v * 2 + 1) * DM, modv(p, L, v, 1), C.tid); }
    __syncthreads();
    for (int r = C.gw; r < TT; r += C.ngw) {
        const int v = r < CTXL ? 1 : 0;
        const float* src = (L == 0) ? (r < CTXL ? p.inp(2) + (size_t)r * DM : p.inp(0) + (size_t)(r - CTXL) * DM) : X2 + (size_t)r * DM;
        const LAS float* sh = MV + (v * 2 + 0) * DM; const LAS float* sc = MV + (v * 2 + 1) * DM;
#pragma unroll
        for (int j = 0; j < 8; ++j) { const int c = 4 * (C.lane + 64 * j);
            const f32x4 x = *(const f32x4*)(src + c), a = *(const LAS f32x4*)(sc + c), b = *(const LAS f32x4*)(sh + c);
            const f32x4 y = x * (a + 1.0f) + b;
            unsigned w = (unsigned)__builtin_amdgcn_cvt_pk_fp8_f32(y[0], y[1], 0, false); w = (unsigned)__builtin_amdgcn_cvt_pk_fp8_f32(y[2], y[3], (int)w, true);
            *(unsigned*)(XA8 + (size_t)r * DM + c) = w; }
    }
    __syncthreads();
    if (L == 0) { for (int it = C.gw; it < NEX1 * 768; it += C.ngw) conv_item(p, C, 0, it); }
    else conv_queue(p, C, 1 << 30);
}

__device__ __forceinline__ void phase_rope0(const Params& p, Ctx& C) {
    bf16_t* QKV = (bf16_t*)(p.ws + WS_BIG + BG_QKV);
    const f32x2* R128 = (const f32x2*)(p.ws + WS_ROPE128);
    for (int r = C.gw; r < TT; r += C.ngw) {
        bf16_t* row = QKV + (size_t)r * EV_IN;
        if (r < CTXL) {
#pragma unroll
            for (int j = 0; j < 2; ++j) { u32x4* q = (u32x4*)(row + 8 * (C.lane + 64 * j)); u32x4 w = *q;
                w.x = cvt_pk_bf16(bflo(w.x) * 0.0625f, bfhi(w.x) * 0.0625f); w.y = cvt_pk_bf16(bflo(w.y) * 0.0625f, bfhi(w.y) * 0.0625f);
                w.z = cvt_pk_bf16(bflo(w.z) * 0.0625f, bfhi(w.z) * 0.0625f); w.w = cvt_pk_bf16(bflo(w.w) * 0.0625f, bfhi(w.w) * 0.0625f); *q = w; }
        } else {
            const int l = r - CTXL, rp = l >> 6, cp = l & 63;
#pragma unroll
            for (int qk = 0; qk < 2; ++qk)
#pragma unroll
                for (int m = 0; m < 8; ++m) { const int pi = C.lane + 64 * m, head = pi >> 7, blk = (pi >> 6) & 1, i = pi & 63;
                    bf16_t* b = row + qk * 1024 + head * 256 + blk * 128 + i;
                    const f32x2 cs = R128[(blk ? cp : rp) * 64 + i];
                    const float x1 = bf2f(b[0]), x2 = bf2f(b[64]); const float sc = qk ? 1.0f : 0.0625f;
                    b[0] = f2bf((x1 * cs.x - x2 * cs.y) * sc); b[64] = f2bf((x1 * cs.y + x2 * cs.x) * sc); }
        }
    }
}

__device__ __forceinline__ void phase_normrope1(const Params& p, Ctx& C) {
    bf16_t* QKV = (bf16_t*)(p.ws + WS_BIG + BG_QKV);
    const f32x2* R64 = (const f32x2*)(p.ws + WS_ROPE64);
    const float* qg = p.inp(23);
    unsigned* KMAX = (unsigned*)(p.ws + WS_CTL) + CW_KMAX;
    unsigned char* Q8 = (unsigned char*)(p.ws + WS_BIG + BG_Q8); unsigned char* K8 = (unsigned char*)(p.ws + WS_BIG + BG_K8); unsigned char* VT8 = (unsigned char*)(p.ws + WS_BIG + BG_VT8);
    unsigned char* Q8D = (unsigned char*)(p.ws + WS_BIG + BG_Q8D); unsigned char* K8D = (unsigned char*)(p.ws + WS_BIG + BG_K8D); unsigned char* VT8D = (unsigned char*)(p.ws + WS_BIG + BG_VT8D);
    const int lane = C.lane, i32 = lane & 31; const bool up = lane >= 32;
    const float g00 = qg[lane], g01 = qg[64 + lane], g10 = qg[128 + lane], g11 = qg[128 + 64 + lane];
    for (int r = C.gw; r < TT; r += C.ngw) {
        bf16_t* row = QKV + (size_t)r * OD_IN;
        const bool lat = r >= CTXL; const int l = r - CTXL, rp = lat ? (l >> 6) : 0, cp = lat ? (l & 63) : 0;
        const f32x2 cr = R64[rp * 32 + i32], cc = R64[cp * 32 + i32];
#pragma unroll 2
        for (int h = 0; h < 26; ++h) {
            const int col = h < 8 ? 128 * h : (h < 10 ? 1024 + 128 * (h - 8) : (h < 18 ? 1536 + 128 * (h - 10) : 2560 + 128 * (h - 18)));
            bf16_t* b = row + col;
            float v0 = bf2f(b[lane]), v1 = bf2f(b[64 + lane]);
            if (h < 10) { const float ss = wave_sum(v0 * v0 + v1 * v1); const float rs = rsqrtf(ss * (1.0f / 128.0f) + LN_EPS);
                v0 = bf2f(f2bf(v0 * rs)) * (h < 8 ? g00 : g10); v1 = bf2f(f2bf(v1 * rs)) * (h < 8 ? g01 : g11); }
            if (lat) { const float p0 = __shfl_xor(v0, 32), p1 = __shfl_xor(v1, 32);
                v0 = up ? (p0 * cr.y + v0 * cr.x) : (v0 * cr.x - p0 * cr.y);
                v1 = up ? (p1 * cc.y + v1 * cc.x) : (v1 * cc.x - p1 * cc.y); }
            const bf16_t o0 = f2bf(v0), o1 = f2bf(v1);
            b[lane] = o0; b[64 + lane] = o1;
            {
                const float qs = (h < 8 || (h >= 10 && h < 18)) ? 0.088388347648318440f * 1.4426950408889634f : 1.0f;
                const float w0 = bf2f(o0) * qs, w1 = bf2f(o1) * qs;
                float e4[4];
#pragma unroll
                for (int j = 0; j < 4; ++j) { const float a = __shfl(w0, (4 * lane + j) & 63), c2 = __shfl(w1, (4 * lane + j) & 63); e4[j] = lane < 16 ? a : c2; }
                unsigned pk = (unsigned)__builtin_amdgcn_cvt_pk_fp8_f32(e4[0], e4[1], 0, false); pk = (unsigned)__builtin_amdgcn_cvt_pk_fp8_f32(e4[2], e4[3], (int)pk, true);
                unsigned char* dst8 = h < 8 ? Q8 + (size_t)r * 1024 + 128 * h : (h < 10 ? K8 + (size_t)r * 256 + 128 * (h - 8) : (h < 18 ? Q8D + (size_t)r * 1024 + 128 * (h - 10) : K8D + (size_t)r * 1024 + 128 * (h - 18)));
                if (lane < 32) *(unsigned*)(dst8 + 4 * lane) = pk; }
            if ((h >= 8 && h < 10) || h >= 18) {
                const float w0 = bf2f(o0), w1 = bf2f(o1); const float k2 = wave_sum(w0 * w0 + w1 * w1);
                if (lane == 0) atomicMax(KMAX + 64 * (h < 10 ? h - 8 : h - 16), __float_as_uint(k2)); }
        }
    }
    LAS bf16_t* vt = (LAS bf16_t*)(C.lds + C.wave * 17408);
    for (int item = C.gw; item < 10 * 260; item += C.ngw) {
        const int kh = item / 260, T = item % 260;
        const int vcol = kh < 2 ? 1280 + 128 * kh : 3584 + 128 * (kh - 2);
        unsigned char* vout = kh < 2 ? VT8 + (size_t)kh * 260 * 8192 : VT8D + (size_t)(kh - 2) * 260 * 8192;
#pragma unroll
        for (int q = 0; q < 16; ++q) { const int idx = lane + 64 * q, key = idx >> 4, c = idx & 15;
            *(LAS u32x4*)(vt + key * 136 + 8 * c) = *(const u32x4*)(QKV + (size_t)(64 * T + key) * OD_IN + vcol + 8 * c); }
        LDS_WAIT(); asm volatile("" ::: "memory");
#pragma unroll
        for (int dd = 0; dd < 2; ++dd) { const int d = lane + 64 * dd;
            unsigned char* dst = vout + ((size_t)T * 128 + d) * 64;
#pragma unroll
            for (int cch = 0; cch < 4; ++cch) { u32x4 w;
#pragma unroll
                for (int wd = 0; wd < 4; ++wd) { float f[4];
#pragma unroll
                    for (int e = 0; e < 4; ++e) { const int bb = 16 * cch + 4 * wd + e, hi2 = bb >> 5, blk = (bb >> 4) & 1, j = bb & 15; const int key = 32 * blk + (j & 3) + 8 * (j >> 2) + 4 * hi2;
                        f[e] = bf2f(vt[key * 136 + d]); }
                    unsigned pk = (unsigned)__builtin_amdgcn_cvt_pk_fp8_f32(f[0], f[1], 0, false); pk = (unsigned)__builtin_amdgcn_cvt_pk_fp8_f32(f[2], f[3], (int)pk, true);
                    w[wd] = pk; }
                *(u32x4*)(dst + 16 * cch) = w; } }
        LDS_WAIT(); asm volatile("" ::: "memory");
    }
}

__device__ __forceinline__ void phase_merge1(const Params& p, Ctx& C) {
    bf16_t* ATT = (bf16_t*)(p.ws + WS_BIG + BG_ATT);
    const float* dl = p.inp(24); const float* sg = p.inp(25);
    const int lane = C.lane;
    float d0 = dl[lane] * dl[128 + lane] + dl[64 + lane] * dl[128 + 64 + lane];
    float d1 = dl[256 + lane] * dl[384 + lane] + dl[256 + 64 + lane] * dl[384 + 64 + lane];
    const float lam = __expf(wave_sum(d0)) - __expf(wave_sum(d1)) + LAMBDA_INIT;
    const f32x4 gg = *(const f32x4*)(sg + 4 * lane);
    for (int l = C.gw; l < SEQ; l += C.ngw) {
        bf16_t* row = ATT + (size_t)l * 3072;
#pragma unroll
        for (int h = 0; h < 4; ++h) {
            const u32x2 a = *(const u32x2*)(row + 1024 + 256 * h + 4 * lane), b = *(const u32x2*)(row + 2048 + 256 * h + 4 * lane);
            f32x4 o = {bflo(a.x) - lam * bflo(b.x), bfhi(a.x) - lam * bfhi(b.x), bflo(a.y) - lam * bflo(b.y), bfhi(a.y) - lam * bfhi(b.y)};
            const float ss = wave_sum(o[0] * o[0] + o[1] * o[1] + o[2] * o[2] + o[3] * o[3]);
            const float rs = rsqrtf(ss * (1.0f / 256.0f) + LN_EPS) * (1.0f - LAMBDA_INIT);
            o = o * rs * gg;
            u32x2 w; w.x = cvt_pk_bf16(o[0], o[1]); w.y = cvt_pk_bf16(o[2], o[3]);
            *(u32x2*)(row + 1024 + 256 * h + 4 * lane) = w;
        }
    }
}

__device__ __forceinline__ void phase_ln1(const Params& p, Ctx& C, int L) {
    const bf16_t* Y = (const bf16_t*)(p.ws + WS_YMIX); float* X1 = (float*)(p.ws + WS_X1); unsigned char* XA8 = (unsigned char*)(p.ws + WS_XA);
    const float* X2 = (const float*)(p.ws + WS_HX2);
    const float* lg = p.inp(6) + (size_t)(L * 2 + 0) * DM; const float* lb = p.inp(7) + (size_t)(L * 2 + 0) * DM;
    const int r0 = (L == 0) ? 0 : CTXL;
    LAS float* MV = (LAS float*)C.lds; LAS float* LG = MV + 6 * DM; LAS float* LB = LG + DM;
    for (int v = 0; v < 2; ++v) for (int k = 0; k < 3; ++k) stage_vec(MV + (v * 3 + k) * DM, modv(p, L, v, 2 + k), C.tid);
    stage_vec(LG, lg, C.tid); stage_vec(LB, lb, C.tid);
    __syncthreads();
    for (int r = r0 + C.gw; r < TT; r += C.ngw) {
        const int v = r < CTXL ? 1 : 0;
        const float* src = (L == 0) ? (r < CTXL ? p.inp(2) + (size_t)r * DM : p.inp(0) + (size_t)(r - CTXL) * DM) : X2 + (size_t)r * DM;
        const LAS float* g1 = MV + (v * 3 + 0) * DM; const LAS float* sh2 = MV + (v * 3 + 1) * DM; const LAS float* sc2 = MV + (v * 3 + 2) * DM;
        f32x4 t[8]; float s = 0.f;
#pragma unroll
        for (int j = 0; j < 8; ++j) { const int c = 4 * (C.lane + 64 * j);
            const f32x4 x = *(const f32x4*)(src + c), g = *(const LAS f32x4*)(g1 + c); const u32x2 yy = *(const u32x2*)(Y + (size_t)r * DM + c);
            const f32x4 y = {bflo(yy.x), bfhi(yy.x), bflo(yy.y), bfhi(yy.y)};
            t[j] = x * ALPHA + g * y; s += (t[j][0] + t[j][1]) + (t[j][2] + t[j][3]); }
        const float mean = wave_sum(s) * (1.0f / DM); float s2 = 0.f;
#pragma unroll
        for (int j = 0; j < 8; ++j) { t[j] = t[j] - mean; s2 += (t[j][0] * t[j][0] + t[j][1] * t[j][1]) + (t[j][2] * t[j][2] + t[j][3] * t[j][3]); }
        const float rstd = rsqrtf(wave_sum(s2) * (1.0f / DM) + LN_EPS);
#pragma unroll
        for (int j = 0; j < 8; ++j) { const int c = 4 * (C.lane + 64 * j);
            const f32x4 x1 = t[j] * rstd * *(const LAS f32x4*)(LG + c) + *(const LAS f32x4*)(LB + c);
            *(f32x4*)(X1 + (size_t)r * DM + c) = x1;
            const f32x4 z = x1 * (*(const LAS f32x4*)(sc2 + c) + 1.0f) + *(const LAS f32x4*)(sh2 + c);
            unsigned w = (unsigned)__builtin_amdgcn_cvt_pk_fp8_f32(z[0], z[1], 0, false); w = (unsigned)__builtin_amdgcn_cvt_pk_fp8_f32(z[2], z[3], (int)w, true);
            *(unsigned*)(XA8 + (size_t)r * DM + c) = w; }
    }
    __syncthreads();
}

__device__ __forceinline__ void phase_combine(const Params& p, Ctx& C, int L, LAS unsigned char* misc) {
    const unsigned char* YM = (const unsigned char*)(p.ws + WS_BIG + BG_YMOE); const float* X1 = (const float*)(p.ws + WS_X1);
    float* X2 = (float*)(p.ws + WS_HX2);
    const float* lg = p.inp(6) + (size_t)(L * 2 + 1) * DM; const float* lb = p.inp(7) + (size_t)(L * 2 + 1) * DM;
    const unsigned* PK = (const unsigned*)(p.ws + WS_WGT); const int* cnt = (const int*)(p.ws + WS_CTL) + CW_CNT + L * 128;
    const int r0 = (L == 0) ? 0 : CTXL;
    LAS int* rb = (LAS int*)(misc + 64);
    LAS float* MV = (LAS float*)C.lds; LAS float* LG = MV + 2 * DM; LAS float* LB = LG + DM;
    __syncthreads();
    if (C.tid == 0) { int q = 0; for (int e = 0; e < NEX1; ++e) { rb[e] = q; q += cnt[e]; } }
    stage_vec(MV, modv(p, L, 0, 5), C.tid); stage_vec(MV + DM, modv(p, L, 1, 5), C.tid); stage_vec(LG, lg, C.tid); stage_vec(LB, lb, C.tid);
    __syncthreads();
    for (int r = r0 + C.gw; r < TT; r += C.ngw) {
        const int v = r < CTXL ? 1 : 0;
        const LAS float* g2 = MV + v * DM;
        int ln = C.lane; asm volatile("" : "+v"(ln));
        int slot = rb[64] + (r - r0);
        if (ln < 8) { const unsigned pk = PK[(size_t)r * 8 + ln]; slot = rb[pk >> 16] + (int)(pk & 0xffffu); }
        f32x4 t[2][4]; float s = 0.f;
#pragma unroll
        for (int j = 0; j < 2; ++j) { const int c = 16 * (ln + 64 * j);
            u32x4 yy[9];
#pragma unroll
            for (int k = 0; k < 9; ++k) { const size_t a = (size_t)__builtin_amdgcn_readlane(slot, k); yy[k] = __builtin_nontemporal_load((const u32x4*)(YM + a * DM + c)); }
            f32x2 f[8];
#pragma unroll
            for (int q = 0; q < 8; ++q) f[q] = (f32x2){0.f, 0.f};
#pragma unroll
            for (int k = 0; k < 9; ++k) {
                f[0] += __builtin_amdgcn_cvt_pk_f32_fp8((int)yy[k].x, false); f[1] += __builtin_amdgcn_cvt_pk_f32_fp8((int)yy[k].x, true);
                f[2] += __builtin_amdgcn_cvt_pk_f32_fp8((int)yy[k].y, false); f[3] += __builtin_amdgcn_cvt_pk_f32_fp8((int)yy[k].y, true);
                f[4] += __builtin_amdgcn_cvt_pk_f32_fp8((int)yy[k].z, false); f[5] += __builtin_amdgcn_cvt_pk_f32_fp8((int)yy[k].z, true);
                f[6] += __builtin_amdgcn_cvt_pk_f32_fp8((int)yy[k].w, false); f[7] += __builtin_amdgcn_cvt_pk_f32_fp8((int)yy[k].w, true); }
#pragma unroll
            for (int q = 0; q < 4; ++q) { const f32x4 x = *(const f32x4*)(X1 + (size_t)r * DM + c + 4 * q), g = *(const LAS f32x4*)(g2 + c + 4 * q);
                const f32x4 ff = {f[2 * q][0], f[2 * q][1], f[2 * q + 1][0], f[2 * q + 1][1]};
                t[j][q] = x * ALPHA + g * ff; s += (t[j][q][0] + t[j][q][1]) + (t[j][q][2] + t[j][q][3]); } }
        const float mean = wave_sum(s) * (1.0f / DM); float s2 = 0.f;
#pragma unroll
        for (int j = 0; j < 2; ++j)
#pragma unroll
            for (int q = 0; q < 4; ++q) { t[j][q] = t[j][q] - mean; s2 += (t[j][q][0] * t[j][q][0] + t[j][q][1] * t[j][q][1]) + (t[j][q][2] * t[j][q][2] + t[j][q][3] * t[j][q][3]); }
        const float rstd = rsqrtf(wave_sum(s2) * (1.0f / DM) + LN_EPS);
        float* dst = (L == 0) ? X2 + (size_t)r * DM : p.out + (size_t)(r - CTXL) * DM;
#pragma unroll
        for (int j = 0; j < 2; ++j)
#pragma unroll
            for (int q = 0; q < 4; ++q) { const int c = 16 * (ln + 64 * j) + 4 * q;
                *(f32x4*)(dst + c) = t[j][q] * rstd * *(const LAS f32x4*)(LG + c) + *(const LAS f32x4*)(LB + c); }
    }
}
constexpr int RLD = 264;
constexpr int SLD = 136;

template <bool SCALE>
__device__ __forceinline__ void stage_chunk(const bf16_t* QKV, int row0, int col0, LAS bf16_t* dst, int tid, float lg  , int dirb) {
#pragma unroll
    for (int q = 0; q < 8; ++q) { const int idx = tid + NTHR * q, r = idx >> 5, c = idx & 31;
        u32x4 w = *(const u32x4*)(QKV + (size_t)(row0 + r) * EV_IN + col0 + 8 * c);
        if (SCALE) { const float sc = fast_exp((dirb ? (float)r : (float)(127 - r)) * lg);
            w.x = cvt_pk_bf16(bflo(w.x) * sc, bfhi(w.x) * sc); w.y = cvt_pk_bf16(bflo(w.y) * sc, bfhi(w.y) * sc);
            w.z = cvt_pk_bf16(bflo(w.z) * sc, bfhi(w.z) * sc); w.w = cvt_pk_bf16(bflo(w.w) * sc, bfhi(w.w) * sc); }
        *(LAS u32x4*)(dst + r * RLD + 8 * c) = w; }
}

__device__ __forceinline__ void ret_chunk_kv(const Params& p, Ctx& C) {
    const bf16_t* QKV = (const bf16_t*)(p.ws + WS_BIG + BG_QKV); bf16_t* CKV = (bf16_t*)(p.ws + WS_BIG + BG_CKV);
    const float* rld = p.inp(10);
    LAS bf16_t* Vs = (LAS bf16_t*)C.lds; LAS bf16_t* Ks = Vs + 128 * RLD;
    const int lane = C.lane, w = C.wave;
    for (int unit = C.bid; unit < 130 * 8; unit += C.G) {
        const int u = unit >> 3, h = (unit >> 1) & 3, dir = unit & 1;
        const float lg = rld[dir * 4 + h];
        __syncthreads();
        stage_chunk<false>(QKV, 128 * u, 2048 + 256 * h, Vs, C.tid, 0.f, 0);
        stage_chunk<true>(QKV, 128 * u, 1024 + 256 * h, Ks, C.tid, lg, dir);
        __syncthreads();
        f32x4 acc[2][16];
#pragma unroll
        for (int a = 0; a < 2; ++a)
#pragma unroll
            for (int b = 0; b < 16; ++b) acc[a][b] = (f32x4){0.f, 0.f, 0.f, 0.f};
        const unsigned vbase = (unsigned)(uintptr_t)Vs, kbase = (unsigned)(uintptr_t)Ks;
#pragma unroll 1
        for (int ks = 0; ks < 4; ++ks) {
            bf16x8 af[2];
#pragma unroll
            for (int a = 0; a < 2; ++a) af[a] = frag_colk_l(vbase + (unsigned)((32 * ks) * RLD + 32 * w + 16 * a) * 2u, RLD * 2, lane);
#pragma unroll
            for (int b = 0; b < 16; ++b) { const bf16x8 bf = frag_colk_l(kbase + (unsigned)((32 * ks) * RLD + 16 * b) * 2u, RLD * 2, lane);
                acc[0][b] = MFMA16(bf, af[0], acc[0][b]); acc[1][b] = MFMA16(bf, af[1], acc[1][b]); }
        }
        bf16_t* dst = CKV + ((size_t)((dir * 4 + h) * 130 + u)) * 65536;
#pragma unroll
        for (int a = 0; a < 2; ++a)
#pragma unroll
            for (int b = 0; b < 16; ++b) { u32x2 w2; w2.x = cvt_pk_bf16(acc[a][b][0], acc[a][b][1]); w2.y = cvt_pk_bf16(acc[a][b][2], acc[a][b][3]);
                *(u32x2*)(dst + (size_t)(32 * w + 16 * a + (lane & 15)) * 256 + 16 * b + 4 * (lane >> 4)) = w2; }
    }
    __syncthreads();
}

__device__ __forceinline__ int s5_row(int dir, int c, int s) { return dir == 0 ? 64 * c + s : (c < 4 ? 255 - (64 * c + s) : 16639 - 64 * (c - 4) - s); }

__device__ __forceinline__ void s5_end_states(const Params& p, Ctx& C) {
    const bf16_t* QKV = (const bf16_t*)(p.ws + WS_BIG + BG_QKV); const bf16_t* BBT = (const bf16_t*)(p.ws + WS_BBT); float* E = (float*)(p.ws + WS_S5E);
    const float* APOW = (const float*)(p.ws + WS_APOW);
    LAS f32x2* PL = (LAS f32x2*)C.lds;
    for (int bt = C.bid; bt < 256; bt += C.G) {
        int tid = C.tid; asm volatile("" : "+v"(tid));
        const int lane = tid & 63, r32 = lane & 31, hi = lane >> 5;
        const int dg = bt >> 1, dir = dg >> 6, g = dg & 63, c0 = 130 * (bt & 1);
        __syncthreads();
#pragma unroll
        for (int q = 0; q < 8; ++q) { const int idx = tid + NTHR * q, s = idx >> 6, pp = idx & 63;
            PL[idx] = (s == 63) ? (f32x2){1.0f, 0.0f} : *(const f32x2*)(APOW + ((size_t)dg * 64 + (62 - s)) * 128 + 2 * pp); }
        __syncthreads();
        bf16x8 bfr[4];
#pragma unroll
        for (int pt = 0; pt < 4; ++pt) bfr[pt] = *(const bf16x8*)(BBT + ((size_t)dg * 128 + 32 * pt + r32) * 16 + 8 * hi);
        for (int c = c0 + C.wave; c < c0 + 130; c += 8) {
            float er[2] = {0.f, 0.f}, ei[2] = {0.f, 0.f};
#pragma unroll
            for (int st = 0; st < 2; ++st) {
                const bf16x8 a = *(const bf16x8*)(QKV + (size_t)s5_row(dir, c, 32 * st + r32) * EV_IN + 4096 + 16 * g + 8 * hi);
                f32x16 d[4];
#pragma unroll
                for (int pt = 0; pt < 4; ++pt) d[pt] = __builtin_amdgcn_mfma_f32_32x32x16_bf16(a, bfr[pt], (f32x16){}, 0, 0, 0);
#pragma unroll
                for (int r = 0; r < 16; ++r) { const int s = 32 * st + (r & 3) + 8 * (r >> 2) + 4 * hi;
#pragma unroll
                    for (int pt = 0; pt < 2; ++pt) { const f32x2 pw = PL[s * 64 + 32 * pt + r32]; const float br = d[pt][r], bi = d[pt + 2][r];
                        er[pt] += pw.x * br - pw.y * bi; ei[pt] += pw.x * bi + pw.y * br; } }
            }
#pragma unroll
            for (int pt = 0; pt < 2; ++pt) {
                { auto rr = __builtin_amdgcn_permlane32_swap(__float_as_uint(er[pt]), __float_as_uint(er[pt]), false, false); er[pt] = __uint_as_float(rr[0]) + __uint_as_float(rr[1]); }
                { auto rr = __builtin_amdgcn_permlane32_swap(__float_as_uint(ei[pt]), __float_as_uint(ei[pt]), false, false); ei[pt] = __uint_as_float(rr[0]) + __uint_as_float(rr[1]); }
            }
            float* dst = E + ((size_t)dg * 260 + c) * 128;
            if (hi == 0) { dst[r32] = er[0]; dst[32 + r32] = er[1]; dst[64 + r32] = ei[0]; dst[96 + r32] = ei[1]; }
        }
    }
    __syncthreads();
}

__device__ __forceinline__ void phase_scans(const Params& p, Ctx& C) {
    const bf16_t* CKV = (const bf16_t*)(p.ws + WS_BIG + BG_CKV); bf16_t* SP = (bf16_t*)(p.ws + WS_BIG + BG_SPREV);
    const float* rld = p.inp(10);
    for (int q = C.bid * NTHR + C.tid; q < 8 * 16384; q += C.G * NTHR) {
        const int dh = q >> 14, el = (q & 16383) * 4, dir = dh >> 2, h = dh & 3;
        const float gch = fast_exp(128.0f * rld[dir * 4 + h]);
        const bf16_t* src = CKV + (size_t)dh * 130 * 65536 + el; bf16_t* dst = SP + (size_t)dh * 130 * 65536 + el;
        f32x4 s = {0.f, 0.f, 0.f, 0.f};
        for (int st0 = 0; st0 < 130; st0 += 13) {
            u32x2 kv[13];
#pragma unroll
            for (int k = 0; k < 13; ++k) { const int st = st0 + k; const int u = dir == 0 ? st : (st == 0 ? 1 : (st == 1 ? 0 : 131 - st)); kv[k] = __builtin_nontemporal_load((const u32x2*)(src + (size_t)u * 65536)); }
#pragma unroll
            for (int k = 0; k < 13; ++k) { const int st = st0 + k; const int u = dir == 0 ? st : (st == 0 ? 1 : (st == 1 ? 0 : 131 - st));
                u32x2 w; w.x = cvt_pk_bf16(s[0], s[1]); w.y = cvt_pk_bf16(s[2], s[3]); *(u32x2*)(dst + (size_t)u * 65536) = w;
                s = s * gch + (f32x4){bflo(kv[k].x), bfhi(kv[k].x), bflo(kv[k].y), bfhi(kv[k].y)}; }
        }
    }
    const float* E = (const float*)(p.ws + WS_S5E); float* HST = (float*)(p.ws + WS_HST); const float* AL = (const float*)(p.ws + WS_AL);
    for (int q = C.bid * NTHR + C.tid; q < 2 * 64 * 64; q += C.G * NTHR) {
        const int dg = q >> 6, pp = q & 63;
        const f32x2 al = *(const f32x2*)(AL + (size_t)dg * 128 + 2 * pp);
        const float* e = E + (size_t)dg * 260 * 128; float* hs = HST + (size_t)dg * 260 * 128;
        float hr = 0.f, hi = 0.f;
        for (int c0 = 0; c0 < 260; c0 += 26) {
            float er[26], ei[26];
#pragma unroll
            for (int k = 0; k < 26; ++k) { er[k] = e[(size_t)(c0 + k) * 128 + pp]; ei[k] = e[(size_t)(c0 + k) * 128 + 64 + pp]; }
#pragma unroll
            for (int k = 0; k < 26; ++k) { *(f32x2*)(hs + (size_t)(c0 + k) * 128 + 2 * pp) = (f32x2){hr, hi};
                const float t = al.x * hr - al.y * hi + er[k]; hi = al.x * hi + al.y * hr + ei[k]; hr = t; }
        }
    }
}

__device__ __forceinline__ void ret_output_unit(const Params& p, Ctx& C, int unit) {
    const bf16_t* QKV = (const bf16_t*)(p.ws + WS_BIG + BG_QKV); const bf16_t* SP = (const bf16_t*)(p.ws + WS_BIG + BG_SPREV);
    bf16_t* MIX = (bf16_t*)(p.ws + WS_BIG + BG_MIX);
    const float* rld = p.inp(10);
    LAS bf16_t* RA = (LAS bf16_t*)C.lds; LAS bf16_t* RB = RA + 128 * RLD;
    int tid = C.tid; asm volatile("" : "+v"(tid));
    const int lane = tid & 63, w = C.wave, kq = lane >> 4, fr = lane & 15;
    const int u = unit >> 2, h = unit & 3;
    const float lgf = rld[h], lgb = rld[4 + h];
    stage_chunk<false>(QKV, 128 * u, 256 * h, RA, tid, 0.f, 0);
    int ib = 16 * w + 4 * kq, jb = fr; asm volatile("" : "+v"(ib), "+v"(jb));
    f32x4 acc[16];
#pragma unroll
    for (int t = 0; t < 16; ++t) acc[t] = (f32x4){0.f, 0.f, 0.f, 0.f};
#pragma unroll
    for (int dir = 0; dir < 2; ++dir) {
        const bf16_t* Sd = SP + ((size_t)((dir * 4 + h) * 130 + u)) * 65536;
#pragma unroll
        for (int eh = 0; eh < 2; ++eh) {
            __syncthreads();
#pragma unroll
            for (int q = 0; q < 8; ++q) { const int idx = tid + NTHR * q, rr = idx >> 5, c = idx & 31;
                *(LAS u32x4*)(RB + rr * RLD + 8 * c) = *(const u32x4*)(Sd + (size_t)(128 * eh + rr) * 256 + 8 * c);
                if (q == 3) asm volatile("" ::: "memory"); }
            __syncthreads();
#pragma unroll 1
            for (int ks = 0; ks < 8; ++ks) { const bf16x8 af = frag_rowk_l(RA + (16 * w) * RLD + 32 * ks, RLD, lane);
#pragma unroll
                for (int t = 0; t < 8; ++t) { const bf16x8 bf = frag_rowk_l(RB + (16 * t) * RLD + 32 * ks, RLD, lane); acc[8 * eh + t] = MFMA16(af, bf, acc[8 * eh + t]); } }
        }
#pragma unroll
        for (int r = 0; r < 4; ++r) { const int i = ib + r; const float qd = fast_exp((float)(128 - i) * lgb);
            const float f = (dir == 0) ? fast_exp((float)(i + 1) * lgf) / qd : qd;
#pragma unroll
            for (int t = 0; t < 16; ++t) acc[t][r] *= f; }
    }
    __syncthreads();
    stage_chunk<false>(QKV, 128 * u, 1024 + 256 * h, RB, tid, 0.f, 0);
    __syncthreads();
    f32x4 sc[8];
#pragma unroll
    for (int t = 0; t < 8; ++t) sc[t] = (f32x4){0.f, 0.f, 0.f, 0.f};
#pragma unroll 1
    for (int ks = 0; ks < 8; ++ks) { const bf16x8 af = frag_rowk_l(RA + (16 * w) * RLD + 32 * ks, RLD, lane);
#pragma unroll
        for (int t = 0; t < 8; ++t) { const bf16x8 bf = frag_rowk_l(RB + (16 * t) * RLD + 32 * ks, RLD, lane); sc[t] = MFMA16(af, bf, sc[t]); } }
#pragma unroll
    for (int t = 0; t < 8; ++t)
#pragma unroll
        for (int r = 0; r < 4; ++r) { const int i = ib + r, j = 16 * t + jb; const float d = (float)(i - j);
            const float m = (i >= j ? fast_exp(d * lgf) : 0.f) + (j >= i ? fast_exp(-d * lgb) : 0.f); sc[t][r] *= m; }
    __syncthreads();
    stage_chunk<false>(QKV, 128 * u, 2048 + 256 * h, RA, tid, 0.f, 0);
#pragma unroll
    for (int t = 0; t < 8; ++t)
#pragma unroll
        for (int r = 0; r < 4; ++r) RB[(16 * w + 4 * kq + r) * SLD + 16 * t + fr] = f2bf(sc[t][r]);
    __syncthreads();
    const unsigned vbase = (unsigned)(uintptr_t)RA;
#pragma unroll 1
    for (int ks = 0; ks < 4; ++ks) { const bf16x8 af = frag_rowk_l(RB + (16 * w) * SLD + 32 * ks, SLD, lane);
#pragma unroll
        for (int t = 0; t < 16; ++t) { const bf16x8 bf = frag_colk_l(vbase + (unsigned)((32 * ks) * RLD + 16 * t) * 2u, RLD * 2, lane); acc[t] = MFMA16(af, bf, acc[t]); } }
    __syncthreads();
#pragma unroll
    for (int r = 0; r < 4; ++r) {
        float s = 0.f;
#pragma unroll
        for (int t = 0; t < 16; ++t) s += acc[t][r];
        s += __shfl_xor(s, 1); s += __shfl_xor(s, 2); s += __shfl_xor(s, 4); s += __shfl_xor(s, 8);
        const float mean = s * (1.0f / 256.0f); float q = 0.f;
#pragma unroll
        for (int t = 0; t < 16; ++t) { const float d = acc[t][r] - mean; q += d * d; }
        q += __shfl_xor(q, 1); q += __shfl_xor(q, 2); q += __shfl_xor(q, 4); q += __shfl_xor(q, 8);
        const float rstd = rsqrtf(q * (1.0f / 256.0f) + LN_EPS);
#pragma unroll
        for (int t = 0; t < 16; ++t) RA[(16 * w + 4 * kq + r) * RLD + 16 * t + fr] = f2bf((acc[t][r] - mean) * rstd);
    }
    __syncthreads();
#pragma unroll
    for (int q = 0; q < 8; ++q) { const int idx = tid + NTHR * q, rr = idx >> 5, c = idx & 31; const size_t row = (size_t)(128 * u + rr);
        const u32x4 o = *(const LAS u32x4*)(RA + rr * RLD + 8 * c), g = *(const u32x4*)(QKV + row * EV_IN + 3072 + 256 * h + 8 * c);
        u32x4 w4;
        w4.x = cvt_pk_bf16(bflo(o.x) * siluf_(bflo(g.x)), bfhi(o.x) * siluf_(bfhi(g.x))); w4.y = cvt_pk_bf16(bflo(o.y) * siluf_(bflo(g.y)), bfhi(o.y) * siluf_(bfhi(g.y)));
        w4.z = cvt_pk_bf16(bflo(o.z) * siluf_(bflo(g.z)), bfhi(o.z) * siluf_(bfhi(g.z))); w4.w = cvt_pk_bf16(bflo(o.w) * siluf_(bflo(g.w)), bfhi(o.w) * siluf_(bfhi(g.w)));
        *(u32x4*)(MIX + row * DM + 256 * h + 8 * c) = w4; }
    __syncthreads();
}

constexpr int KLD = 1032;
__device__ __forceinline__ void s5_output_task(const Params& p, Ctx& C, int bt) {
    const bf16_t* QKV = (const bf16_t*)(p.ws + WS_BIG + BG_QKV); bf16_t* Z = (bf16_t*)(p.ws + WS_Z);
    const bf16_t* KN = (const bf16_t*)(p.ws + WS_KN); const bf16_t* CCt = (const bf16_t*)(p.ws + WS_CC);
    const float* APOW = (const float*)(p.ws + WS_APOW); const float* HST = (const float*)(p.ws + WS_HST); const float* dsk = p.inp(18);
    int tid = C.tid; asm volatile("" : "+v"(tid));
    const int lane = tid & 63, kq = lane >> 4, fr = lane & 15;
    LAS bf16_t* KF = (LAS bf16_t*)C.lds; LAS bf16_t* KB = KF + 16 * KLD;
    LAS bf16_t* U = KB + 16 * KLD + C.wave * 3072;
    LAS float* PW0 = (LAS float*)(KB + 16 * KLD + 8 * 3072);
    LAS float* PW16 = PW0 + 2 * 16 * 128;
    {
        const int g = bt >> 3, k0 = (260 * (bt & 7)) >> 3, k1 = (260 * ((bt & 7) + 1)) >> 3;
#pragma unroll
        for (int q = 0; q < 8; ++q) { const int idx = tid + NTHR * q, dir = idx >> 11, rr = (idx >> 7) & 15, c = idx & 127;
            *(LAS u32x4*)((dir ? KB : KF) + rr * KLD + 8 * c) = *(const u32x4*)(KN + ((size_t)(dir * 64 + g) * 16 + rr) * 1024 + 8 * c); }
        for (int q = lane; q < 192 * 2; q += 64) *(LAS u32x4*)(U + 8 * q) = (u32x4){0u, 0u, 0u, 0u};
#pragma unroll
        for (int q = 0; q < 2; ++q) { const int idx = tid + NTHR * q, dir = idx >> 9, f = (idx >> 5) & 15, c4 = idx & 31;
            *(LAS f32x4*)(PW0 + dir * 2048 + f * 128 + 4 * c4) = *(const f32x4*)(APOW + ((size_t)(dir * 64 + g) * 64 + (dir == 0 ? f : 15 - f)) * 128 + 4 * c4); }
        if (tid < 64) { const int dir = tid >> 5, c4 = tid & 31; *(LAS f32x4*)(PW16 + dir * 128 + 4 * c4) = *(const f32x4*)(APOW + ((size_t)(dir * 64 + g) * 64 + 15) * 128 + 4 * c4); }
        __syncthreads();
        const f32x4 dv = *(const f32x4*)(dsk + 16 * g + 4 * kq);
        bf16x8 ccr[2], cci[2];
#pragma unroll
        for (int hb = 0; hb < 2; ++hb) { ccr[hb] = frag_rowk_g(CCt + (size_t)g * 16 * 128 + 32 * hb, 128, lane); cci[hb] = frag_rowk_g(CCt + (size_t)g * 16 * 128 + 64 + 32 * hb, 128, lane); }
        const LAS float* pw0l = PW0 + (size_t)fr * 128 + 16 * kq;
        const LAS float* pw16l = PW16 + 16 * kq;
        for (int k = k0 + C.wave; k < k1; k += 8) {
            LDS_WAIT(); asm volatile("" ::: "memory");
            for (int q = lane; q < 128; q += 64) { const int t = q >> 1, hf = q & 1;
                *(LAS u32x4*)(U + (64 + t) * 16 + 8 * hf) = *(const u32x4*)(QKV + (size_t)(64 * k + t) * EV_IN + 4096 + 16 * g + 8 * hf); }
            LDS_WAIT(); asm volatile("" ::: "memory");
            const int cf = k, cb = k < 4 ? 3 - k : 263 - k;
            f32x4 acc[4];
#pragma unroll
            for (int tt = 0; tt < 4; ++tt) acc[tt] = (f32x4){0.f, 0.f, 0.f, 0.f};
            const LAS bf16_t* ubf = U + (64 + fr - (kq >> 1)) * 16 + 8 * (kq & 1);
            const LAS bf16_t* ubb = U + (64 + fr + (kq >> 1)) * 16 + 8 * (kq & 1);
#pragma unroll
            for (int n0 = 0; n0 < 64; n0 += 2) {
                const bf16x8 af = frag_rowk_l(KF + n0 * 16, KLD, lane), ab = frag_rowk_l(KB + n0 * 16, KLD, lane);
#pragma unroll
                for (int tt = 0; tt < 4; ++tt) {
                    if (n0 <= 16 * tt + 14) acc[tt] = MFMA16(af, *(const LAS bf16x8*)(ubf + (16 * tt - n0) * 16), acc[tt]);
                    if (n0 <= 62 - 16 * tt) acc[tt] = MFMA16(ab, *(const LAS bf16x8*)(ubb + (16 * tt + n0) * 16), acc[tt]);
                }
                asm volatile("" ::: "memory");
            }
#pragma unroll
            for (int dir = 0; dir < 2; ++dir) {
                const float* hp = HST + ((size_t)(dir * 64 + g) * 260 + (dir == 0 ? cf : cb)) * 128;
#pragma unroll
                for (int hb = 0; hb < 2; ++hb) {
                    float xr[8], xi[8];
#pragma unroll
                    for (int e2 = 0; e2 < 4; ++e2) { const f32x4 h4 = *(const f32x4*)(hp + 2 * (32 * hb + 8 * kq) + 4 * e2), b4 = *(const LAS f32x4*)(pw0l + dir * 2048 + hb * 64 + 4 * e2);
                        xr[2 * e2] = b4[0] * h4[0] - b4[1] * h4[1]; xi[2 * e2] = b4[0] * h4[1] + b4[1] * h4[0];
                        xr[2 * e2 + 1] = b4[2] * h4[2] - b4[3] * h4[3]; xi[2 * e2 + 1] = b4[2] * h4[3] + b4[3] * h4[2]; }
#pragma unroll
                    for (int st = 0; st < 4; ++st) {
                        const int tt = dir == 0 ? st : 3 - st;
                        u32x4 br, bi;
                        br.x = cvt_pk_bf16(xr[0], xr[1]); br.y = cvt_pk_bf16(xr[2], xr[3]); br.z = cvt_pk_bf16(xr[4], xr[5]); br.w = cvt_pk_bf16(xr[6], xr[7]);
                        bi.x = cvt_pk_bf16(xi[0], xi[1]); bi.y = cvt_pk_bf16(xi[2], xi[3]); bi.z = cvt_pk_bf16(xi[4], xi[5]); bi.w = cvt_pk_bf16(xi[6], xi[7]);
                        acc[tt] = MFMA16(ccr[hb], __builtin_bit_cast(bf16x8, br), acc[tt]);
                        acc[tt] = MFMA16(cci[hb], __builtin_bit_cast(bf16x8, bi), acc[tt]);
                        if (st < 3) {
#pragma unroll
                            for (int e2 = 0; e2 < 4; ++e2) { const f32x4 a4 = *(const LAS f32x4*)(pw16l + dir * 128 + hb * 64 + 4 * e2);
                                float t0 = xr[2 * e2] * a4[0] - xi[2 * e2] * a4[1]; xi[2 * e2] = xr[2 * e2] * a4[1] + xi[2 * e2] * a4[0]; xr[2 * e2] = t0;
                                t0 = xr[2 * e2 + 1] * a4[2] - xi[2 * e2 + 1] * a4[3]; xi[2 * e2 + 1] = xr[2 * e2 + 1] * a4[3] + xi[2 * e2 + 1] * a4[2]; xr[2 * e2 + 1] = t0; }
                        }
                    }
                }
            }
#pragma unroll
            for (int tt = 0; tt < 4; ++tt) { const int t = 16 * tt + fr;
                const u32x2 uu = *(const LAS u32x2*)(U + (64 + t) * 16 + 4 * kq);
                const float y0 = acc[tt][0] + bflo(uu.x) * dv[0], y1 = acc[tt][1] + bfhi(uu.x) * dv[1], y2 = acc[tt][2] + bflo(uu.y) * dv[2], y3 = acc[tt][3] + bfhi(uu.y) * dv[3];
                u32x2 w; w.x = cvt_pk_bf16(gelu_tanh(y0), gelu_tanh(y1)); w.y = cvt_pk_bf16(gelu_tanh(y2), gelu_tanh(y3));
                *(u32x2*)(Z + (size_t)(64 * k + t) * 1024 + 16 * g + 4 * kq) = w; }
        }
    }
    __syncthreads();
}

__device__ __forceinline__ void phase_ret_s5_outputs(const Params& p, Ctx& C, LAS unsigned char* misc) {
    unsigned* head = (unsigned*)(p.ws + WS_CTL) + CW_QUEUE;
    volatile LAS int* slot = (volatile LAS int*)(misc + 32);
    for (;;) {
        __syncthreads();
        if (C.tid == 0) slot[0] = (int)atomicAdd(head, 1u);
        __syncthreads();
        const int item = __builtin_amdgcn_readfirstlane(slot[0]);
        if (item >= 520) break;
        ret_output_unit(p, C, item);
    }
    for (;;) {
        __syncthreads();
        if (C.tid == 0) slot[0] = (int)atomicAdd(head + 64, 1u);
        __syncthreads();
        const int item = __builtin_amdgcn_readfirstlane(slot[0]);
        if (item >= 512) break;
        s5_output_task(p, C, item);
    }
}
__device__ __forceinline__ void phase_router(const Params& p, Ctx& C, int L) {
    const float* X1 = (const float*)(p.ws + WS_X1);
    const bf16_t* RWh = (const bf16_t*)(p.ws + WS_RWT) + (size_t)(L * 2 + 0) * 64 * DM; const bf16_t* RWl = (const bf16_t*)(p.ws + WS_RWT) + (size_t)(L * 2 + 1) * 64 * DM;
    const float* rbias = p.inp(27) + L * 64;
    int* cnt = (int*)(p.ws + WS_CTL) + CW_CNT + L * 128; int* LIST = (int*)(p.ws + WS_LIST); unsigned* PK = (unsigned*)(p.ws + WS_WGT); float* LW = (float*)(p.ws + WS_LW);
    const int lane = C.lane, kq = lane >> 4, fr = lane & 15;
    LAS float* Lg = (LAS float*)(C.lds + C.wave * 8192);
    const int r0 = (L == 0) ? 0 : CTXL, nrows = TT - r0;
    if (C.bid == 0 && C.tid == 0) cnt[64] = nrows;
    for (int task = C.gw; task < nrows / 16; task += C.ngw) {
        const int rbase = r0 + 16 * task, row = rbase + fr;
        const int v = row < CTXL ? 1 : 0;
        const float* xr = X1 + (size_t)row * DM; const float* sc2 = modv(p, L, v, 4); const float* sh2 = modv(p, L, v, 3);
        f32x4 acc[4];
#pragma unroll
        for (int t = 0; t < 4; ++t) acc[t] = (f32x4){0.f, 0.f, 0.f, 0.f};
#pragma unroll 2
        for (int ks = 0; ks < 64; ++ks) { const int c0 = 32 * ks + 8 * kq;
            const f32x4 x0 = *(const f32x4*)(xr + c0), x1 = *(const f32x4*)(xr + c0 + 4);
            const f32x4 a0 = *(const f32x4*)(sc2 + c0), a1 = *(const f32x4*)(sc2 + c0 + 4), b0 = *(const f32x4*)(sh2 + c0), b1 = *(const f32x4*)(sh2 + c0 + 4);
            const f32x4 y0 = x0 * (a0 + 1.0f) + b0, y1 = x1 * (a1 + 1.0f) + b1;
            u32x4 hi; hi.x = cvt_pk_bf16(y0[0], y0[1]); hi.y = cvt_pk_bf16(y0[2], y0[3]); hi.z = cvt_pk_bf16(y1[0], y1[1]); hi.w = cvt_pk_bf16(y1[2], y1[3]);
            u32x4 lo; lo.x = cvt_pk_bf16(y0[0] - bflo(hi.x), y0[1] - bfhi(hi.x)); lo.y = cvt_pk_bf16(y0[2] - bflo(hi.y), y0[3] - bfhi(hi.y));
            lo.z = cvt_pk_bf16(y1[0] - bflo(hi.z), y1[1] - bfhi(hi.z)); lo.w = cvt_pk_bf16(y1[2] - bflo(hi.w), y1[3] - bfhi(hi.w));
            const bf16x8 ah = __builtin_bit_cast(bf16x8, hi), al = __builtin_bit_cast(bf16x8, lo);
#pragma unroll
            for (int t = 0; t < 4; ++t) { const bf16x8 bh = frag_rowk_g(RWh + (size_t)(16 * t) * DM + 32 * ks, DM, lane), bl = frag_rowk_g(RWl + (size_t)(16 * t) * DM + 32 * ks, DM, lane);
                acc[t] = MFMA16(ah, bh, acc[t]); acc[t] = MFMA16(al, bh, acc[t]); acc[t] = MFMA16(ah, bl, acc[t]); } }
        LDS_WAIT(); asm volatile("" ::: "memory");
#pragma unroll
        for (int t = 0; t < 4; ++t)
#pragma unroll
            for (int r = 0; r < 4; ++r) Lg[(4 * kq + r) * 65 + 16 * t + fr] = acc[t][r];
        LDS_WAIT(); asm volatile("" ::: "memory");
        if (lane < 16) {
            LAS float* sr = Lg + lane * 65; const int trow = rbase + lane;
            float gs[8];
#pragma unroll
            for (int g = 0; g < 8; ++g) { float m1 = -1e30f, m2 = -1e30f;
                for (int j = 0; j < 8; ++j) { const int e = 8 * g + j; const float s = sigmoidf_(sr[e]); sr[e] = s; const float vv = s + rbias[e];
                    if (vv > m1) { m2 = m1; m1 = vv; } else if (vv > m2) m2 = vv; }
                gs[g] = m1 + m2; }
            unsigned gmask = 0u;
#pragma unroll
            for (int it = 0; it < 4; ++it) { float best = -1e30f; int bi = 0;
#pragma unroll
                for (int g = 0; g < 8; ++g) { const bool ok = !((gmask >> g) & 1u) && gs[g] > best; best = ok ? gs[g] : best; bi = ok ? g : bi; }
                gmask |= 1u << bi; }
            unsigned long long taken = 0ull; int sel[8]; float sw[8]; float wsum = 0.f;
#pragma unroll
            for (int k = 0; k < 8; ++k) { float best = -1e30f; int bi = 0;
                for (int e = 0; e < 64; ++e) { const bool cand = ((gmask >> (e >> 3)) & 1u) && !((taken >> e) & 1ull); const float vv = sr[e] + rbias[e];
                    if (cand && vv > best) { best = vv; bi = e; } }
                taken |= 1ull << bi; sel[k] = bi; sw[k] = sr[bi]; wsum += sw[k]; }
            const float inv = 2.5f / wsum;
#pragma unroll
            for (int k = 0; k < 8; ++k) { const int a = trow * 8 + k; const int pos = atomicAdd(&cnt[sel[k]], 1);
                LIST[(size_t)sel[k] * TT + pos] = a; PK[a] = ((unsigned)sel[k] << 16) | (unsigned)pos; LW[(size_t)sel[k] * TT + pos] = sw[k] * inv; }
            LIST[(size_t)64 * TT + (trow - r0)] = 8 * TT + trow; LW[(size_t)64 * TT + (trow - r0)] = 1.0f;
        }
    }
}
namespace att {
constexpr int D = 128, NW = 8, QBLK = 32, KVBLK = 64;
constexpr float SCALE = 0.088388347648318440f;
constexpr float THR = 8.f;
constexpr int SHM_V = KVBLK * D * 2, SHM_K = KVBLK * D * 2, SHM_ATTN = 2 * SHM_V + 2 * SHM_K + NW * 64 * 4;
#define KSWZ(row, colB) ((row) * 256 + ((colB) ^ (((row) & 7) << 4)))
#define SBAR() __builtin_amdgcn_sched_barrier(0)
__device__ __forceinline__ int crow(int r, int hi) { return (r & 3) + 8 * (r >> 2) + 4 * hi; }
__device__ __forceinline__ unsigned cvtpk(float lo, float hi) { unsigned r; asm volatile("v_cvt_pk_bf16_f32 %0, %1, %2" : "=v"(r) : "v"(lo), "v"(hi)); return r; }

__device__ __forceinline__ void partialSM(f32x16& p0, f32x16& p1, float negMC) {
  constexpr float Cc = SCALE * 1.4426950408889634f;
  for (int r = 0; r < 16; ++r) p0[r] = fmaf(p0[r], Cc, negMC); for (int r = 0; r < 16; ++r) p1[r] = fmaf(p1[r], Cc, negMC);
  for (int r = 0; r < 16; ++r) p0[r] = __builtin_amdgcn_exp2f(p0[r]);
}
__device__ __forceinline__ void finishSM(f32x16& p0, f32x16& p1, float& l_reg, bf16x8& pa0, bf16x8& pa1, bf16x8& pa2, bf16x8& pa3) {
  for (int r = 0; r < 16; ++r) p1[r] = __builtin_amdgcn_exp2f(p1[r]);
  float ps = 0; for (int r = 0; r < 16; ++r) ps += p0[r]; for (int r = 0; r < 16; ++r) ps += p1[r];
  { auto rr = __builtin_amdgcn_permlane32_swap(__float_as_uint(ps), __float_as_uint(ps), false, false);
    ps = __uint_as_float(rr[0]) + __uint_as_float(rr[1]); }
  l_reg += ps;
#define PK4(P, BASE, OUT) do { unsigned a0 = cvtpk(P[BASE + 0], P[BASE + 1]), a1 = cvtpk(P[BASE + 2], P[BASE + 3]);   \
    unsigned b0 = cvtpk(P[BASE + 4], P[BASE + 5]), b1 = cvtpk(P[BASE + 6], P[BASE + 7]);                              \
    auto r0 = __builtin_amdgcn_permlane32_swap(a0, b0, false, false); auto r1 = __builtin_amdgcn_permlane32_swap(a1, b1, false, false); \
    u32x4 w = {r0[0], r1[0], r0[1], r1[1]}; OUT = *reinterpret_cast<bf16x8*>(&w); } while (0)
  PK4(p0, 0, pa0); PK4(p0, 8, pa1); PK4(p1, 0, pa2); PK4(p1, 8, pa3);
#undef PK4
}
__device__ __forceinline__ void qkt(f32x16& p0, f32x16& p1, const LAS char* Ks, const bf16x8* qr, int r32, int hi) {
  p0 = f32x16{}; p1 = f32x16{};
  for (int d0 = 0; d0 < 8; ++d0) { int cb = (d0 * 16 + hi * 8) * 2;
    bf16x8 b0 = *reinterpret_cast<const LAS bf16x8*>(Ks + KSWZ(r32, cb));
    bf16x8 b1 = *reinterpret_cast<const LAS bf16x8*>(Ks + KSWZ(32 + r32, cb));
    p0 = __builtin_amdgcn_mfma_f32_32x32x16_bf16(b0, qr[d0], p0, 0, 0, 0);
    p1 = __builtin_amdgcn_mfma_f32_32x32x16_bf16(b1, qr[d0], p1, 0, 0, 0); }
}
__device__ __forceinline__ int v_st(int k, int c) { const int kk = (k & ~0xC) | ((k & 4) << 1) | ((k & 8) >> 1); return ((kk >> 3) * 4 + (c >> 5)) * 512 + ((kk & 7) * 32 + (c & 31)) * 2; }
__device__ __forceinline__ int v_rd_base(int lane) { return ((lane & 3) << 3) | (((lane >> 2) & 3) << 6) | (((lane >> 4) & 1) << 5) | (((lane >> 5) & 1) << 8); }
constexpr int v_rd_off(int d0, int ks, int half) { return d0 * 512 + ks * 4096 + half * 2048; }
template <int OFF> __device__ __forceinline__ s16x4 tr_read(int vb) {
  s16x4 r; asm volatile("ds_read_b64_tr_b16 %0, %1 offset:%2" : "=&v"(r) : "v"(vb), "i"(OFF) : "memory"); return r;
}
template <int D0> __device__ __forceinline__ void pv_one(f32x16& od, int vb, bf16x8 pa0, bf16x8 pa1, bf16x8 pa2, bf16x8 pa3) {
  const s16x4 l0 = tr_read<v_rd_off(D0, 0, 0)>(vb), h0 = tr_read<v_rd_off(D0, 0, 1)>(vb), l1 = tr_read<v_rd_off(D0, 1, 0)>(vb), h1 = tr_read<v_rd_off(D0, 1, 1)>(vb);
  const s16x4 l2 = tr_read<v_rd_off(D0, 2, 0)>(vb), h2 = tr_read<v_rd_off(D0, 2, 1)>(vb), l3 = tr_read<v_rd_off(D0, 3, 0)>(vb), h3 = tr_read<v_rd_off(D0, 3, 1)>(vb);
  asm volatile("s_waitcnt lgkmcnt(0)" ::: "memory"); SBAR();
#define PK(L, H) (bf16x8){L[0], L[1], L[2], L[3], H[0], H[1], H[2], H[3]}
  od = __builtin_amdgcn_mfma_f32_32x32x16_bf16(pa0, PK(l0, h0), od, 0, 0, 0);
  od = __builtin_amdgcn_mfma_f32_32x32x16_bf16(pa1, PK(l1, h1), od, 0, 0, 0);
  od = __builtin_amdgcn_mfma_f32_32x32x16_bf16(pa2, PK(l2, h2), od, 0, 0, 0);
  od = __builtin_amdgcn_mfma_f32_32x32x16_bf16(pa3, PK(l3, h3), od, 0, 0, 0);
#undef PK
}
__device__ __forceinline__ void pv_d0(f32x16* o, int vb, bf16x8 pa0, bf16x8 pa1, bf16x8 pa2, bf16x8 pa3) {
  pv_one<0>(o[0], vb, pa0, pa1, pa2, pa3); pv_one<1>(o[1], vb, pa0, pa1, pa2, pa3); pv_one<2>(o[2], vb, pa0, pa1, pa2, pa3); pv_one<3>(o[3], vb, pa0, pa1, pa2, pa3);
}

template <int LDQ, int LDK, int LDO>
__device__ __forceinline__ void attn_dense_body(const bf16_t* __restrict__ Qb, const bf16_t* __restrict__ Kh, const bf16_t* __restrict__ Vh, bf16_t* __restrict__ Ob, int seq, LAS char* lds, int tid, float kmax2) {
  const int wid = tid >> 6, lane = tid & 63, r32 = lane & 31, hi = lane >> 5;
  LAS char* V_lds = lds; LAS char* K_lds = lds + 2 * SHM_V;
  LAS float* ws = (LAS float*)(lds + 2 * SHM_V + 2 * SHM_K) + wid * 64; LAS float* li_l = ws;
  float l_reg = 0; f32x16 o[4] = {}; bf16x8 qr[8];
  const bf16_t* Qw = Qb + (long)(wid * QBLK + r32) * LDQ + hi * 8;
#pragma unroll
  for (int d0 = 0; d0 < 8; ++d0) qr[d0] = *reinterpret_cast<const bf16x8*>(Qw + d0 * 16);
  float negMC;
  { float q2 = 0.f;
#pragma unroll
    for (int d0 = 0; d0 < 8; ++d0) { const u32x4 w = __builtin_bit_cast(u32x4, qr[d0]);
      q2 += bflo(w.x) * bflo(w.x) + bfhi(w.x) * bfhi(w.x) + bflo(w.y) * bflo(w.y) + bfhi(w.y) * bfhi(w.y) + bflo(w.z) * bflo(w.z) + bfhi(w.z) * bfhi(w.z) + bflo(w.w) * bflo(w.w) + bfhi(w.w) * bfhi(w.w); }
    auto rr = __builtin_amdgcn_permlane32_swap(__float_as_uint(q2), __float_as_uint(q2), false, false);
    q2 = __uint_as_float(rr[0]) + __uint_as_float(rr[1]);
    negMC = -(sqrtf(q2 * kmax2) * (SCALE * 1.0001f) - 30.0f) * 1.4426950408889634f; }
  const int sr = tid >> 4, sc = (tid & 15) * 8, vst0 = v_st(sr, sc), vst1 = v_st(32 + sr, sc);
  const int vb0 = (int)(uintptr_t)V_lds + v_rd_base(lane);
  struct { bf16x8 vs0, vs1, ks0, ks1; } sr_[2];
#define SLOAD(i, k0) do { sr_[i].vs0 = *reinterpret_cast<const bf16x8*>(&Vh[(long)((k0) + sr) * LDK + sc]); sr_[i].vs1 = *reinterpret_cast<const bf16x8*>(&Vh[(long)((k0) + 32 + sr) * LDK + sc]); \
    sr_[i].ks0 = *reinterpret_cast<const bf16x8*>(&Kh[(long)((k0) + sr) * LDK + sc]); sr_[i].ks1 = *reinterpret_cast<const bf16x8*>(&Kh[(long)((k0) + 32 + sr) * LDK + sc]); } while (0)
#define SWRITE(b, i) do { *(LAS bf16x8*)(V_lds + (b) * SHM_V + vst0) = sr_[i].vs0;          \
    *(LAS bf16x8*)(V_lds + (b) * SHM_V + vst1) = sr_[i].vs1; int kc = sc * 2;               \
    *(LAS bf16x8*)(K_lds + (b) * SHM_K + KSWZ(sr, kc)) = sr_[i].ks0;                       \
    *(LAS bf16x8*)(K_lds + (b) * SHM_K + KSWZ(32 + sr, kc)) = sr_[i].ks1; } while (0)
#define SWAIT() asm volatile("s_waitcnt vmcnt(4)" ::: "memory")
  f32x16 pA0, pA1, pB0, pB1; bf16x8 pa0, pa1, pa2, pa3; const int NT = seq / KVBLK;
  constexpr int SE = 0, SO = 1;
  SLOAD(SE, 0); asm volatile("s_waitcnt vmcnt(0)" ::: "memory"); SWRITE(0, SE); __syncthreads();
  qkt(pA0, pA1, K_lds, qr, r32, hi); partialSM(pA0, pA1, negMC);
  SLOAD(SO, KVBLK); if (2 < NT) SLOAD(SE, 2 * KVBLK);
  SWAIT(); SWRITE(1, SO); __syncthreads();
  for (int j = 1; j + 1 < NT; j += 2) {
    SBAR(); qkt(pB0, pB1, K_lds + SHM_K, qr, r32, hi);
    finishSM(pA0, pA1, l_reg, pa0, pa1, pa2, pa3); SBAR();
    SLOAD(SO, (j + 2) * KVBLK); SBAR();
    pv_d0(o, vb0, pa0, pa1, pa2, pa3); partialSM(pB0, pB1, negMC);
    __syncthreads(); SWAIT(); SWRITE(0, SE);
    __syncthreads();
    SBAR(); qkt(pA0, pA1, K_lds, qr, r32, hi);
    finishSM(pB0, pB1, l_reg, pa0, pa1, pa2, pa3); SBAR();
    if (j + 3 < NT) SLOAD(SE, (j + 3) * KVBLK); SBAR();
    pv_d0(o, vb0 + (int)SHM_V, pa0, pa1, pa2, pa3); partialSM(pA0, pA1, negMC);
    __syncthreads(); SWAIT(); SWRITE(1, SO);
    __syncthreads();
  }
  SBAR(); qkt(pB0, pB1, K_lds + SHM_K, qr, r32, hi);
  finishSM(pA0, pA1, l_reg, pa0, pa1, pa2, pa3); SBAR();
  pv_d0(o, vb0, pa0, pa1, pa2, pa3); partialSM(pB0, pB1, negMC);
  __syncthreads();
  finishSM(pB0, pB1, l_reg, pa0, pa1, pa2, pa3); SBAR();
  pv_d0(o, vb0 + (int)SHM_V, pa0, pa1, pa2, pa3);
  if (hi == 0) li_l[r32] = l_reg; asm volatile("s_waitcnt lgkmcnt(0)" ::: "memory");
  float rli[16];
#pragma unroll
  for (int r = 0; r < 16; ++r) rli[r] = __builtin_amdgcn_rcpf(li_l[crow(r, hi)]);
  bf16_t* Ow = Ob + (long)(wid * QBLK) * LDO;
#pragma unroll
  for (int r = 0; r < 16; ++r) { int orow = crow(r, hi);
    for (int d0 = 0; d0 < 4; ++d0) Ow[(long)orow * LDO + d0 * 32 + r32] = (bf16_t)(cvtpk(o[d0][r] * rli[r], 0.f) & 0xffffu); }
#undef SLOAD
#undef SWRITE
#undef SWAIT
}

typedef int v8i32a __attribute__((ext_vector_type(8)));
typedef int v4i32a __attribute__((ext_vector_type(4)));
#define KSW8(row, chunk) ((row) * 128 + ((((chunk) ^ ((row) & 7))) << 4))
#define VSW8(d, chunk) ((d) * 64 + ((((chunk) ^ (((d) >> 2) & 3))) << 4))
#define MFMA8(a, b, c) __builtin_amdgcn_mfma_scale_f32_32x32x64_f8f6f4((a), (b), (c), 0, 0, 0, 0, 0, 0)
__device__ __forceinline__ v8i32a ld32_l(const LAS char* p0, const LAS char* p1) { return __builtin_shufflevector(*(const LAS v4i32a*)p0, *(const LAS v4i32a*)p1, 0, 1, 2, 3, 4, 5, 6, 7); }
__device__ __forceinline__ unsigned pk4f8(float a, float b, float c, float d) { unsigned w = (unsigned)__builtin_amdgcn_cvt_pk_fp8_f32(a, b, 0, false); return (unsigned)__builtin_amdgcn_cvt_pk_fp8_f32(c, d, (int)w, true); }
template <int LDO, int KSTR>
__device__ __forceinline__ void attn_dense8_body(const unsigned char* __restrict__ Q8b, const unsigned char* __restrict__ K8h, const unsigned char* __restrict__ VT8h, bf16_t* __restrict__ Ob, int seq, LAS char* lds, int tid, float kmax2) {
  const int wid = tid >> 6, lane = tid & 63, r32 = lane & 31, hi = lane >> 5;
  LAS char* K_lds = lds; LAS char* V_lds = lds + 16384;
  LAS float* li_l = (LAS float*)(lds + 32768) + wid * 32; LAS float* al_l = (LAS float*)(lds + 32768 + 1024) + wid * 32;
  f32x16 o[4] = {}; v8i32a qf[2];
  { const unsigned char* qp = Q8b + (size_t)(wid * QBLK + r32) * 1024 + 32 * hi;
    qf[0] = __builtin_shufflevector(*(const v4i32a*)qp, *(const v4i32a*)(qp + 16), 0, 1, 2, 3, 4, 5, 6, 7);
    qf[1] = __builtin_shufflevector(*(const v4i32a*)(qp + 64), *(const v4i32a*)(qp + 80), 0, 1, 2, 3, 4, 5, 6, 7); }
  (void)kmax2;
  constexpr float THR8 = 1.4426950408889634f;
  float c0 = 0.f; f32x16 osum = {}; const v8i32a ones = {0x38383838, 0x38383838, 0x38383838, 0x38383838, 0x38383838, 0x38383838, 0x38383838, 0x38383838};
#define PMAX8(P0, P1) float pmax = P0[0]; for (int r = 1; r < 16; ++r) pmax = fmaxf(pmax, P0[r]); for (int r = 0; r < 16; ++r) pmax = fmaxf(pmax, P1[r]); \
      { auto rr = __builtin_amdgcn_permlane32_swap(__float_as_uint(pmax), __float_as_uint(pmax), false, false); pmax = fmaxf(__uint_as_float(rr[0]), __uint_as_float(rr[1])); }
#define PSM8(P0, P1, AL) do { PMAX8(P0, P1) \
      if (__builtin_expect(__all(pmax <= 7.0f + THR8), 1)) { AL = 1.f; } \
      else { const float dl = fmaxf(pmax - 7.0f, 0.f); AL = __builtin_amdgcn_exp2f(-dl); c0 -= dl; \
        for (int r = 0; r < 16; ++r) P0[r] -= dl; for (int r = 0; r < 16; ++r) P1[r] -= dl; } \
      for (int r = 0; r < 16; ++r) P0[r] = __builtin_amdgcn_exp2f(P0[r]); } while (0)
#define PSM8F(P0, P1, AL) do { PMAX8(P0, P1) const float dl = pmax - 7.0f; AL = 1.f; c0 -= dl; \
      for (int r = 0; r < 16; ++r) P0[r] -= dl; for (int r = 0; r < 16; ++r) P1[r] -= dl; \
      for (int r = 0; r < 16; ++r) P0[r] = __builtin_amdgcn_exp2f(P0[r]); } while (0)
#define RESC8(a) do { if (__any((a) < 1.f)) { if (hi == 0) al_l[r32] = (a); asm volatile("s_waitcnt lgkmcnt(0)" ::: "memory"); \
      for (int d = 0; d < 4; ++d) for (int r = 0; r < 16; ++r) o[d][r] *= al_l[crow(r, hi)]; for (int r = 0; r < 16; ++r) osum[r] *= al_l[crow(r, hi)]; } } while (0)
  const int krow = tid >> 3, kch = tid & 7, vd = tid >> 2, vch = tid & 3;
  const int kst = KSW8(krow, kch), vst = VSW8(vd, vch);
  const unsigned kgo = (unsigned)(krow * KSTR + 16 * kch), vgo = (unsigned)(16 * tid);
  struct { v4i32a k, v; } sr_[2];
#define SLOAD8(i, T_) do { sr_[i].k = *(const v4i32a*)(K8h + (size_t)(T_) * (64 * KSTR) + kgo); sr_[i].v = *(const v4i32a*)(VT8h + (size_t)(T_) * 8192 + vgo); } while (0)
#define SWRITE8(b, i) do { *(LAS v4i32a*)(K_lds + (b) * 8192 + kst) = sr_[i].k; *(LAS v4i32a*)(V_lds + (b) * 8192 + vst) = sr_[i].v; } while (0)
#define QK8(P0, P1, KB) do { for (int r = 0; r < 16; ++r) { P0[r] = c0; P1[r] = c0; } _Pragma("unroll") for (int s = 0; s < 2; ++s) { \
      const v8i32a k0 = ld32_l((KB) + KSW8(r32, 4 * s + 2 * hi), (KB) + KSW8(r32, 4 * s + 2 * hi + 1)); \
      const v8i32a k1 = ld32_l((KB) + KSW8(32 + r32, 4 * s + 2 * hi), (KB) + KSW8(32 + r32, 4 * s + 2 * hi + 1)); \
      P0 = MFMA8(k0, qf[s], P0); P1 = MFMA8(k1, qf[s], P1); } } while (0)
#define FIN8(P0, P1, AL) do { for (int r = 0; r < 16; ++r) P1[r] = __builtin_amdgcn_exp2f(P1[r]); \
      _Pragma("unroll") for (int i = 0; i < 4; ++i) { pa[i] = (int)pk4f8(P0[4 * i], P0[4 * i + 1], P0[4 * i + 2], P0[4 * i + 3]); pa[4 + i] = (int)pk4f8(P1[4 * i], P1[4 * i + 1], P1[4 * i + 2], P1[4 * i + 3]); } } while (0)
#define PV8(VB) do { _Pragma("unroll") for (int d0 = 0; d0 < 4; ++d0) { \
      const v8i32a vf = ld32_l((VB) + VSW8(32 * d0 + r32, 2 * hi), (VB) + VSW8(32 * d0 + r32, 2 * hi + 1)); \
      o[d0] = MFMA8(pa, vf, o[d0]); } osum = MFMA8(pa, ones, osum); } while (0)
  f32x16 pA0, pA1, pB0, pB1; v8i32a pa; float alA, alB; const int NT = seq / KVBLK;
  SLOAD8(0, 0); asm volatile("s_waitcnt vmcnt(0)" ::: "memory"); SWRITE8(0, 0); __syncthreads();
  QK8(pA0, pA1, K_lds); PSM8F(pA0, pA1, alA);
  SLOAD8(1, 1); if (2 < NT) SLOAD8(0, 2);
  asm volatile("s_waitcnt vmcnt(2)" ::: "memory"); SWRITE8(1, 1); __syncthreads();
  for (int j = 1; j + 1 < NT; j += 2) {
    SBAR(); QK8(pB0, pB1, K_lds + 8192);
    FIN8(pA0, pA1, alA); SBAR();
    SLOAD8(1, j + 2); SBAR();
    PV8(V_lds); PSM8(pB0, pB1, alB);
    __syncthreads(); asm volatile("s_waitcnt vmcnt(2)" ::: "memory"); SWRITE8(0, 0);
    RESC8(alB); __syncthreads();
    SBAR(); QK8(pA0, pA1, K_lds);
    FIN8(pB0, pB1, alB); SBAR();
    if (j + 3 < NT) SLOAD8(0, j + 3); SBAR();
    PV8(V_lds + 8192); PSM8(pA0, pA1, alA);
    __syncthreads(); asm volatile("s_waitcnt vmcnt(2)" ::: "memory"); SWRITE8(1, 1);
    RESC8(alA); __syncthreads();
  }
  SBAR(); QK8(pB0, pB1, K_lds + 8192);
  FIN8(pA0, pA1, alA); SBAR();
  PV8(V_lds); PSM8(pB0, pB1, alB);
  __syncthreads(); RESC8(alB);
  FIN8(pB0, pB1, alB); SBAR();
  PV8(V_lds + 8192);
  float rli[16];
#pragma unroll
  for (int r = 0; r < 16; ++r) rli[r] = __builtin_amdgcn_rcpf(osum[r]);
  bf16_t* Ow = Ob + (long)(wid * QBLK) * LDO;
#pragma unroll
  for (int r = 0; r < 16; ++r) { int orow = crow(r, hi);
    for (int d0 = 0; d0 < 4; ++d0) Ow[(long)orow * LDO + d0 * 32 + r32] = (bf16_t)(cvtpk(o[d0][r] * rli[r], 0.f) & 0xffffu); }
#undef PSM8
#undef PSM8F
#undef PMAX8
#undef RESC8
#undef SLOAD8
#undef SWRITE8
#undef QK8
#undef FIN8
#undef PV8
}

template <int LDO, int KSTR>
__device__ __forceinline__ void attn_dense8w_body(const unsigned char* __restrict__ Q8b, const unsigned char* __restrict__ K8h, const unsigned char* __restrict__ VT8h0, const unsigned char* __restrict__ VT8h1, bf16_t* __restrict__ Ob, int seq, LAS char* lds, int tid, float kmax2) {
  const int wid = tid >> 6, lane = tid & 63, r32 = lane & 31, hi = lane >> 5;
  LAS char* K_lds = lds; LAS char* V_lds = lds + 16384;
  LAS float* li_l = (LAS float*)(lds + 49152) + wid * 32; LAS float* al_l = (LAS float*)(lds + 49152 + 1024) + wid * 32;
  float l_reg = 0; f32x16 o[8] = {};
  LAS char* q_l = lds + 51200 + wid * 4096 + lane * 16;
  { const unsigned char* qp = Q8b + (size_t)(wid * QBLK + r32) * 1024 + 32 * hi;
    *(LAS v4i32a*)(q_l) = *(const v4i32a*)qp; *(LAS v4i32a*)(q_l + 1024) = *(const v4i32a*)(qp + 16);
    *(LAS v4i32a*)(q_l + 2048) = *(const v4i32a*)(qp + 64); *(LAS v4i32a*)(q_l + 3072) = *(const v4i32a*)(qp + 80); }
  (void)kmax2;
  constexpr float THR8 = 1.4426950408889634f;
  float c0 = 0.f;
#define PMAX8(P0, P1) float pmax = P0[0]; for (int r = 1; r < 16; ++r) pmax = fmaxf(pmax, P0[r]); for (int r = 0; r < 16; ++r) pmax = fmaxf(pmax, P1[r]); \
      { auto rr = __builtin_amdgcn_permlane32_swap(__float_as_uint(pmax), __float_as_uint(pmax), false, false); pmax = fmaxf(__uint_as_float(rr[0]), __uint_as_float(rr[1])); }
#define PSM8(P0, P1, AL, FIRST) do { PMAX8(P0, P1) \
      if (__builtin_expect(__all(pmax <= 7.0f + THR8) && !(FIRST), 1)) { AL = 1.f; } \
      else { const float dr = pmax - 7.0f, dp = fmaxf(dr, 0.f), dl = (FIRST) ? dr : dp; AL = __builtin_amdgcn_exp2f(-dp); c0 -= dl; \
        for (int r = 0; r < 16; ++r) P0[r] -= dl; for (int r = 0; r < 16; ++r) P1[r] -= dl; } \
      for (int r = 0; r < 16; ++r) P0[r] = __builtin_amdgcn_exp2f(P0[r]); } while (0)
#define PSM8F(P0, P1, AL) do { PMAX8(P0, P1) const float dl = pmax - 7.0f; AL = 1.f; c0 -= dl; \
      for (int r = 0; r < 16; ++r) P0[r] -= dl; for (int r = 0; r < 16; ++r) P1[r] -= dl; \
      for (int r = 0; r < 16; ++r) P0[r] = __builtin_amdgcn_exp2f(P0[r]); } while (0)
#define RESC8(a) do { if (__any((a) < 1.f)) { if (hi == 0) al_l[r32] = (a); asm volatile("s_waitcnt lgkmcnt(0)" ::: "memory"); \
      for (int d = 0; d < 8; ++d) for (int r = 0; r < 16; ++r) o[d][r] *= al_l[crow(r, hi)]; } } while (0)
  const int krow = tid >> 3, kch = tid & 7, vd = tid >> 2, vch = tid & 3;
  const int kst = KSW8(krow, kch), vst = VSW8(vd, vch);
  const unsigned kgo = (unsigned)(krow * KSTR + 16 * kch), vgo = (unsigned)(16 * tid);
  struct { v4i32a k, v, v2; } sr_[1];
#define SLOAD8(i, T_) do { sr_[i].k = *(const v4i32a*)(K8h + (size_t)(T_) * (64 * KSTR) + kgo); sr_[i].v = *(const v4i32a*)(VT8h0 + (size_t)(T_) * 8192 + vgo); sr_[i].v2 = *(const v4i32a*)(VT8h1 + (size_t)(T_) * 8192 + vgo); } while (0)
#define SWRITE8(b, i) do { *(LAS v4i32a*)(K_lds + (b) * 8192 + kst) = sr_[i].k; *(LAS v4i32a*)(V_lds + (b) * 16384 + vst) = sr_[i].v; *(LAS v4i32a*)(V_lds + (b) * 16384 + 8192 + vst) = sr_[i].v2; } while (0)
#define QK8(P0, P1, KB) do { for (int r = 0; r < 16; ++r) { P0[r] = c0; P1[r] = c0; } _Pragma("unroll") for (int s = 0; s < 2; ++s) { \
      const v8i32a k0 = ld32_l((KB) + KSW8(r32, 4 * s + 2 * hi), (KB) + KSW8(r32, 4 * s + 2 * hi + 1)); \
      const v8i32a k1 = ld32_l((KB) + KSW8(32 + r32, 4 * s + 2 * hi), (KB) + KSW8(32 + r32, 4 * s + 2 * hi + 1)); \
      const v8i32a qf_ = ld32_l(q_l + 2048 * s, q_l + 2048 * s + 1024); \
      P0 = MFMA8(k0, qf_, P0); P1 = MFMA8(k1, qf_, P1); } } while (0)
#define FIN8(P0, P1, AL) do { for (int r = 0; r < 16; ++r) P1[r] = __builtin_amdgcn_exp2f(P1[r]); \
      float ps = 0; for (int r = 0; r < 16; ++r) ps += P0[r]; for (int r = 0; r < 16; ++r) ps += P1[r]; \
      { auto rr = __builtin_amdgcn_permlane32_swap(__float_as_uint(ps), __float_as_uint(ps), false, false); ps = __uint_as_float(rr[0]) + __uint_as_float(rr[1]); } \
      l_reg = l_reg * (AL) + ps; \
      _Pragma("unroll") for (int i = 0; i < 4; ++i) { pa[i] = (int)pk4f8(P0[4 * i], P0[4 * i + 1], P0[4 * i + 2], P0[4 * i + 3]); pa[4 + i] = (int)pk4f8(P1[4 * i], P1[4 * i + 1], P1[4 * i + 2], P1[4 * i + 3]); } } while (0)
#define PV8(VB) do { _Pragma("unroll") for (int d0 = 0; d0 < 4; ++d0) { \
      const v8i32a vf = ld32_l((VB) + VSW8(32 * d0 + r32, 2 * hi), (VB) + VSW8(32 * d0 + r32, 2 * hi + 1)); \
      const v8i32a vg = ld32_l((VB) + 8192 + VSW8(32 * d0 + r32, 2 * hi), (VB) + 8192 + VSW8(32 * d0 + r32, 2 * hi + 1)); \
      o[d0] = MFMA8(pa, vf, o[d0]); o[4 + d0] = MFMA8(pa, vg, o[4 + d0]); if (d0 & 1) SBAR(); } } while (0)
  f32x16 pA0, pA1; v8i32a pa; float alA; const int NT = seq / KVBLK;
  SLOAD8(0, 0); asm volatile("s_waitcnt vmcnt(0)" ::: "memory"); SWRITE8(0, 0); __syncthreads();
  SLOAD8(0, 1);
  for (int j = 0; j < NT; j += 2) {
    SBAR(); QK8(pA0, pA1, K_lds); PSM8(pA0, pA1, alA, j == 0); RESC8(alA); FIN8(pA0, pA1, alA); SBAR(); PV8(V_lds);
    asm volatile("s_waitcnt vmcnt(0)" ::: "memory"); SWRITE8(1, 0); if (j + 2 < NT) SLOAD8(0, j + 2); __syncthreads();
    SBAR(); QK8(pA0, pA1, K_lds + 8192); PSM8(pA0, pA1, alA, false); RESC8(alA); FIN8(pA0, pA1, alA); SBAR(); PV8(V_lds + 16384);
    if (j + 2 < NT) { asm volatile("s_waitcnt vmcnt(0)" ::: "memory"); SWRITE8(0, 0); if (j + 3 < NT) SLOAD8(0, j + 3); } __syncthreads();
  }
  int te = tid; asm volatile("" : "+v"(te));
  const int wid_e = te >> 6, r32_e = te & 31, hi_e = (te >> 5) & 1;
  LAS float* li_e = (LAS float*)(lds + 49152) + wid_e * 32;
  if (hi_e == 0) li_e[r32_e] = l_reg; asm volatile("s_waitcnt lgkmcnt(0)" ::: "memory");
  float rli[16];
#pragma unroll
  for (int r = 0; r < 16; ++r) rli[r] = __builtin_amdgcn_rcpf(li_e[crow(r, hi_e)]);
  bf16_t* Ow = Ob + (long)(wid_e * QBLK) * LDO;
#pragma unroll
  for (int r = 0; r < 16; ++r) { int orow = crow(r, hi_e);
    for (int d0 = 0; d0 < 8; ++d0) Ow[(long)orow * LDO + d0 * 32 + r32_e] = (bf16_t)(cvtpk(o[d0][r] * rli[r], 0.f) & 0xffffu); }
#undef PSM8
#undef PSM8F
#undef PMAX8
#undef RESC8
#undef SLOAD8
#undef SWRITE8
#undef QK8
#undef FIN8
#undef PV8
}

constexpr int PV_BUF = 32768, PK_BUF = 16384, P_LDS_V = 0, P_LDS_K = 2 * PV_BUF, P_LDS_X = P_LDS_K + 2 * PK_BUF, P_LDS_L = P_LDS_X + 8 * 2048, P_LDS_END = P_LDS_L + 1024;
__device__ __forceinline__ void qkt_half(f32x16& p, const LAS char* Ks, const bf16x8* qr, int krow, int hi) {
  p = f32x16{};
  for (int d0 = 0; d0 < 8; ++d0) { int cb = (d0 * 16 + hi * 8) * 2;
    bf16x8 b0 = *reinterpret_cast<const LAS bf16x8*>(Ks + KSWZ(krow, cb));
    p = __builtin_amdgcn_mfma_f32_32x32x16_bf16(b0, qr[d0], p, 0, 0, 0); }
}
__device__ __forceinline__ void smA(f32x16& p, float negMC) {
  constexpr float Cc = SCALE * 1.4426950408889634f;
  for (int r = 0; r < 16; ++r) p[r] = fmaf(p[r], Cc, negMC);
  for (int r = 0; r < 8; ++r) p[r] = __builtin_amdgcn_exp2f(p[r]);
}
__device__ __forceinline__ void smB(f32x16& p, float& l_reg, bf16x8& f0, bf16x8& f1) {
  for (int r = 8; r < 16; ++r) p[r] = __builtin_amdgcn_exp2f(p[r]);
  float ps = 0; for (int r = 0; r < 16; ++r) ps += p[r];
  { auto rr = __builtin_amdgcn_permlane32_swap(__float_as_uint(ps), __float_as_uint(ps), false, false);
    ps = __uint_as_float(rr[0]) + __uint_as_float(rr[1]); }
  l_reg += ps;
#define PK4(P, BASE, OUT) do { unsigned a0 = cvtpk(P[BASE + 0], P[BASE + 1]), a1 = cvtpk(P[BASE + 2], P[BASE + 3]);   \
    unsigned b0 = cvtpk(P[BASE + 4], P[BASE + 5]), b1 = cvtpk(P[BASE + 6], P[BASE + 7]);                              \
    auto r0 = __builtin_amdgcn_permlane32_swap(a0, b0, false, false); auto r1 = __builtin_amdgcn_permlane32_swap(a1, b1, false, false); \
    u32x4 w = {r0[0], r1[0], r0[1], r1[1]}; OUT = *reinterpret_cast<bf16x8*>(&w); } while (0)
  PK4(p, 0, f0); PK4(p, 8, f1);
#undef PK4
}
template <int LDQ, int LDK, int LDO>
__device__ __forceinline__ void attn_pair_body(const bf16_t* __restrict__ Qb, const bf16_t* __restrict__ Kh, const bf16_t* __restrict__ Vh, bf16_t* __restrict__ Ob, int seq, LAS char* lds, int tid, float kmax2) {
  const int wid = __builtin_amdgcn_readfirstlane(tid >> 6), lane = tid & 63, r32 = lane & 31, hi = lane >> 5, g = wid & 3, kb = wid >> 2;
  LAS char* V_lds = lds + P_LDS_V; LAS char* K_lds = lds + P_LDS_K;
  LAS char* xp_own = lds + P_LDS_X + wid * 2048 + lane * 16; LAS char* xp_par = lds + P_LDS_X + (wid ^ 4) * 2048 + lane * 16;
  LAS float* li = (LAS float*)(lds + P_LDS_L);
  float l_reg = 0; f32x16 o[4] = {}; bf16x8 qr[8];
  const bf16_t* Qw = Qb + (long)(g * QBLK + r32) * LDQ + hi * 8;
#pragma unroll
  for (int d0 = 0; d0 < 8; ++d0) qr[d0] = *reinterpret_cast<const bf16x8*>(Qw + d0 * 16);
  float negMC;
  { float q2 = 0.f;
#pragma unroll
    for (int d0 = 0; d0 < 8; ++d0) { const u32x4 w = __builtin_bit_cast(u32x4, qr[d0]);
      q2 += bflo(w.x) * bflo(w.x) + bfhi(w.x) * bfhi(w.x) + bflo(w.y) * bflo(w.y) + bfhi(w.y) * bfhi(w.y) + bflo(w.z) * bflo(w.z) + bfhi(w.z) * bfhi(w.z) + bflo(w.w) * bflo(w.w) + bfhi(w.w) * bfhi(w.w); }
    auto rr = __builtin_amdgcn_permlane32_swap(__float_as_uint(q2), __float_as_uint(q2), false, false);
    q2 = __uint_as_float(rr[0]) + __uint_as_float(rr[1]);
    negMC = -(sqrtf(q2 * kmax2) * (SCALE * 1.0001f) - 30.0f) * 1.4426950408889634f; }
  const int sr = tid >> 4, sc = (tid & 15) * 8, vst0 = v_st(sr, sc), vst1 = v_st(32 + sr, sc);
  const int vrd = (int)(uintptr_t)V_lds + kb * 16384 + v_rd_base(lane);
  const int krow = 32 * kb + r32;
  struct { bf16x8 v00, v01, v10, v11, k0, k1; } st_;
#define PLD16(base, off) (*reinterpret_cast<const bf16x8*>((const char*)(base) + (off)))
#define PLOAD(k0_) do { const unsigned o_ = (unsigned)(((k0_) + sr) * LDK + sc) * 2u; \
    st_.v00 = PLD16(Vh, o_); st_.v01 = PLD16(Vh, o_ + 256u); st_.v10 = PLD16(Vh, o_ + 64u * LDK); st_.v11 = PLD16(Vh, o_ + 64u * LDK + 256u); \
    st_.k0 = PLD16(Kh, o_); st_.k1 = PLD16(Kh, o_ + 64u * LDK); } while (0)
#define PWRITE(kbuf, vbuf) do { LAS char* vb_ = V_lds + (vbuf) * PV_BUF; LAS char* kb_ = K_lds + (kbuf) * PK_BUF; const int kc = sc * 2; \
    *(LAS bf16x8*)(vb_ + vst0) = st_.v00; *(LAS bf16x8*)(vb_ + 16384 + vst0) = st_.v01; *(LAS bf16x8*)(vb_ + vst1) = st_.v10; *(LAS bf16x8*)(vb_ + 16384 + vst1) = st_.v11; \
    *(LAS bf16x8*)(kb_ + KSWZ(sr, kc)) = st_.k0; *(LAS bf16x8*)(kb_ + KSWZ(32 + sr, kc)) = st_.k1; } while (0)
  const int NT = seq / KVBLK;
  f32x16 pS; bf16x8 f0, f1, g0, g1;
  PLOAD(0); asm volatile("s_waitcnt vmcnt(0)" ::: "memory"); PWRITE(0, 0); PLOAD(KVBLK);
  __syncthreads();
  for (int j = 0; j < NT; ++j) {
    SBAR();
    qkt_half(pS, K_lds + (j & 1) * PK_BUF, qr, krow, hi);
    smA(pS, negMC); smB(pS, l_reg, f0, f1); SBAR();
    *(LAS bf16x8*)(xp_own) = f0; *(LAS bf16x8*)(xp_own + 1024) = f1;
    if (j + 1 < NT) PWRITE((j + 1) & 1, (j + 1) & 1);
    if (j + 2 < NT) PLOAD((j + 2) * KVBLK);
    __syncthreads();
    g0 = *(const LAS bf16x8*)(xp_par); g1 = *(const LAS bf16x8*)(xp_par + 1024);
    { const int vb = vrd + (j & 1) * PV_BUF;
      if (kb == 0) pv_d0(o, vb, f0, f1, g0, g1); else pv_d0(o, vb, g0, g1, f0, f1); }
    __syncthreads();
  }
  if (hi == 0) li[wid * 32 + r32] = l_reg;
  __syncthreads();
#pragma unroll
  for (int r = 0; r < 16; ++r) { const int orow = crow(r, hi); const float rl = __builtin_amdgcn_rcpf(li[wid * 32 + orow] + li[(wid ^ 4) * 32 + orow]);
    bf16_t* op = Ob + (long)(g * QBLK + orow) * LDO + 128 * kb + r32;
    for (int d0 = 0; d0 < 4; ++d0) op[d0 * 32] = (bf16_t)(cvtpk(o[d0][r] * rl, 0.f) & 0xffffu); }
#undef PLD16
#undef PLOAD
#undef PWRITE
}
#undef KSWZ
}

__device__ __forceinline__ void phase_attention(const Params& p, Ctx& C) {
    bf16_t* ATT = (bf16_t*)(p.ws + WS_BIG + BG_ATT);
    const unsigned char* Q8 = (const unsigned char*)(p.ws + WS_BIG + BG_Q8); const unsigned char* K8 = (const unsigned char*)(p.ws + WS_BIG + BG_K8); const unsigned char* VT8 = (const unsigned char*)(p.ws + WS_BIG + BG_VT8);
    const unsigned char* Q8D = (const unsigned char*)(p.ws + WS_BIG + BG_Q8D); const unsigned char* K8D = (const unsigned char*)(p.ws + WS_BIG + BG_K8D); const unsigned char* VT8D = (const unsigned char*)(p.ws + WS_BIG + BG_VT8D);
    for (int i = 0;; ++i) {
        int unit;
        if (C.G == 256) { if (i >= 2) break; unit = (C.bid & 7) * 64 + i * 32 + (C.bid >> 3); } else { unit = i * C.G + C.bid; if (unit >= 512) break; }
        const int d = unit >> 6, qb = unit & 63, hh = d >> 1, m = d & 1;
        __syncthreads();
        int tz = C.tid; asm volatile("" : "+v"(tz));
        att::attn_dense8w_body<3072, 1024>(Q8D + (size_t)(CTXL + 256 * qb) * 1024 + 128 * d, K8D + 128 * d, VT8D + (size_t)(2 * hh) * 260 * 8192, VT8D + (size_t)(2 * hh + 1) * 260 * 8192,
                                           ATT + (size_t)(256 * qb) * 3072 + 1024 + 1024 * m + 256 * hh, TT, (LAS char*)C.lds, tz, 0.f);
    }
    for (int i = 0;; ++i) {
        int unit;
        if (C.G == 256) { if (i >= 2) break; unit = (C.bid & 7) * 64 + i * 32 + (C.bid >> 3); } else { unit = i * C.G + C.bid; if (unit >= 512) break; }
        const int prob = unit >> 6, qb = unit & 63;
        __syncthreads();
        int tz = C.tid; asm volatile("" : "+v"(tz));
        att::attn_dense8_body<3072, 256>(Q8 + (size_t)(CTXL + 256 * qb) * 1024 + 128 * prob, K8 + 128 * (prob >> 2), VT8 + (size_t)(prob >> 2) * 260 * 8192,
                                         ATT + (size_t)(256 * qb) * 3072 + 128 * prob, TT, (LAS char*)C.lds, tz, 0.f);
    }
    __syncthreads();
}
constexpr int PH_PER_LAYER = 13, N_PHASES = 2 + 2 * PH_PER_LAYER;
#ifndef DBL_PHASE
#define DBL_PHASE -1
#endif
#ifndef MK_PER_PHASE
#define MK_PER_PHASE 0
#endif

template <int L>
__device__ __forceinline__ void layer_body(const Params& p, Ctx& C0, const XcdBarrier& bar, LAS unsigned char* misc, int lo, int hi) {
#define IN(k) (lo <= (k) && (k) < hi)
#define SEAM(k) do { if (IN(k) && IN((k) + 1)) xcd_barrier(bar, C0.wave); } while (0)
#define PHASE(k, ...) if (IN(k)) { FRESH(); __VA_ARGS__ } if (DBL_PHASE == (k)) { xcd_barrier(bar, C0.wave); { FRESH(); __VA_ARGS__ } } SEAM(k);
#define FRESH() Ctx C = C0; { int ln = (int)__builtin_amdgcn_mbcnt_hi(~0u, __builtin_amdgcn_mbcnt_lo(~0u, 0u)); asm volatile("" : "+v"(ln)); C.lane = ln; C.tid = C.wave * 64 + ln; }
        const int b = 2 + PH_PER_LAYER * L;
        bf16_t* QKV = (bf16_t*)(p.ws + WS_BIG + BG_QKV);
        bf16_t* XA = (bf16_t*)(p.ws + WS_XA);
        int* cnt = (int*)(p.ws + WS_CTL) + CW_CNT + L * 128; const int* LIST = (const int*)(p.ws + WS_LIST);
        PHASE(b + 0, phase_modulate(p, C, L); )
        PHASE(b + 1,
            const int N = L ? OD_IN : EV_IN;
            pg8::DenseOrder S; S.init8((const void*)XA, DM, (const void*)(p.ws + (L ? WS_WIN1 : WS_WIN0)), TT, N, DM, C.G, C.bid);
            pg8::EpiStore E{QKV, N, 1.0f / 32.0f};
            pg8::gemm_phase<true>(C.lds, S, E, C.wave);
            if (L == 0 && IN(b + 2) && S.units_of_me() < S.max_units()) conv_queue(p, C, 2);
        )
        PHASE(b + 2, if (L == 0) phase_rope0(p, C); else phase_normrope1(p, C); )
        PHASE(b + 3, if (L == 0) { ret_chunk_kv(p, C); s5_end_states(p, C); } else phase_attention(p, C); )
        PHASE(b + 4, if (L == 0) phase_scans(p, C); else phase_merge1(p, C); )
        if (L == 0) {
            PHASE(b + 5, phase_ret_s5_outputs(p, C, misc); )
            PHASE(b + 6,
                pg8::DenseOrder S; S.init((const bf16_t*)(p.ws + WS_Z), 1024, (const bf16_t*)(p.ws + WS_WGLU), TT, 1024, 1024, C.G, C.bid);
                pg8::EpiGlu E{(const bf16_t*)(p.ws + WS_Z), p.inp(20), (bf16_t*)(p.ws + WS_BIG + BG_MIX)};
                pg8::gemm_phase<false>(C.lds, S, E, C.wave);
                if (IN(b + 7) && S.units_of_me() < S.max_units()) conv_queue(p, C, 4);
            )
        }
        PHASE(b + 7,
            pg8::DenseOrder S;
            if (L == 0) S.init((const bf16_t*)(p.ws + WS_BIG + BG_MIX), DM, (const bf16_t*)(p.ws + WS_WOUT0), TT, DM, DM, C.G, C.bid);
            else S.init((const bf16_t*)(p.ws + WS_BIG + BG_ATT), 3072, (const bf16_t*)(p.ws + WS_WOUT1), SEQ, DM, DM, C.G, C.bid);
            pg8::EpiStore E{(bf16_t*)(p.ws + WS_YMIX) + (L ? (size_t)CTXL * DM : 0), DM, 1.0f};
            pg8::gemm_phase<false>(C.lds, S, E, C.wave);
            if (L == 0 && IN(b + 8) && S.units_of_me() < S.max_units()) conv_queue(p, C, 5);
        )
        PHASE(b + 8, phase_ln1(p, C, L); )
        PHASE(b + 9, phase_router(p, C, L); )
        PHASE(b + 10,
            pg8::MoeOrder<0> S; S.A = (const void*)XA; S.Bt = (const void*)(p.ws + WS_GU + (size_t)L * NEX1 * 1024 * DM); S.list = LIST; S.cnt = cnt; S.ldab = DM; S.kb = DM; S.nN = 4; S.G = C.G; S.c = C.bid; S.bstride = (size_t)1024 * DM;
            S.prep(misc, C.tid);
            pg8::EpiE1 E{(unsigned char*)(p.ws + WS_HX2), S.cn, S.rb};
            pg8::gemm_phase<true>(C.lds, S, E, C.wave);
        )
        PHASE(b + 11,
            pg8::MoeOrder<1> S; S.A = (const void*)(p.ws + WS_HX2); S.Bt = (const void*)(p.ws + WS_DT + (size_t)L * NEX1 * DM * EHID); S.list = LIST; S.cnt = cnt; S.ldab = EHID; S.kb = EHID; S.nN = 8; S.G = C.G; S.c = C.bid; S.bstride = (size_t)DM * EHID;
            S.prep(misc, C.tid);
            pg8::EpiE2 E{(unsigned char*)(p.ws + WS_BIG + BG_YMOE), (const float*)(p.ws + WS_LW), S.cn, S.rb};
            pg8::gemm_phase<true>(C.lds, S, E, C.wave);
        )
        PHASE(b + 12, phase_combine(p, C, L, misc); )
    #undef IN
#undef SEAM
#undef FRESH
#undef PHASE
}

__global__ void __launch_bounds__(NTHR, 2) mega_fwd(KArgs ka) {
    extern __shared__ __attribute__((aligned(16))) unsigned char lds_raw[];
    Ctx C;
    C.lds = (LAS unsigned char*)lds_raw;
    C.tid = threadIdx.x; C.lane = C.tid & 63; C.wave = __builtin_amdgcn_readfirstlane(C.tid >> 6);
    C.G = gridDim.x; C.bid = blockIdx.x; C.gw = C.bid * NWAVES + C.wave; C.ngw = C.G * NWAVES;
    LAS unsigned char* misc = C.lds + MISC_OFF;
    if (C.tid < 8) ((volatile LAS unsigned*)misc)[C.tid] = 0u;
    Params p; p.out = ka.out; p.ws = ka.ws; p.ph_lo = ka.ph_lo; p.ph_hi = ka.ph_hi; p.ptab = (LAS unsigned long long*)(misc + 1024);
    if (C.tid < 34) p.ptab[C.tid] = (unsigned long long)ka.in[C.tid];
    __syncthreads();
    const int lo = p.ph_lo, hi = p.ph_hi;
    XcdBarrier bar; bar.bar = (unsigned*)(p.ws + WS_CTL) + CW_BAR; bar.x = 0; bar.st = (volatile LAS unsigned*)misc;
    if (hi - lo > 1) bar = xcd_barrier_post((unsigned*)(p.ws + WS_CTL) + CW_BAR, (volatile LAS unsigned*)misc);
#define IN(k) (lo <= (k) && (k) < hi)
#define SEAM(k) do { if (IN(k) && IN((k) + 1)) xcd_barrier(bar, C.wave); } while (0)

    if (IN(0)) { phase_p0(p, C); } SEAM(0);
    if (IN(1)) { phase_p1(p, C); } SEAM(1);
    if (IN(0) && IN(2) && (C.G & 7) == 0) {
        volatile LAS unsigned* st = (volatile LAS unsigned*)misc;
        if (C.tid == 0) { unsigned pre = 0u; const unsigned x = st[3];
            for (unsigned j = 0; j < 16; ++j) { const unsigned cj = xb_ld(&bar.bar[XB_XCNT(j)]); pre += (j < x) ? cj : 0u; }
            st[4] = pre + st[2]; }
        __syncthreads();
        const int vcu = (int)st[4], g8 = C.G >> 3;
        C.bid = __builtin_amdgcn_readfirstlane((vcu % g8) * 8 + vcu / g8); C.gw = C.bid * NWAVES + C.wave;
    }

    layer_body<0>(p, C, bar, misc, lo, hi);
    layer_body<1>(p, C, bar, misc, lo, hi);
#undef IN
#undef SEAM
}

extern "C" void kernel_launch(void* const* d_in, const int* in_sizes, int n_in, void* d_out, int out_size, void* d_ws, size_t ws_size, hipStream_t stream) {
    static int grid = 0;
    if (grid == 0) {
        if (n_in != 34 || out_size != SEQ * DM || ws_size < WS_END) { fprintf(stderr, "kernel_launch: unexpected shapes: n_in %d out %d ws %zu (need %zu)\n", n_in, out_size, ws_size, (size_t)WS_END); grid = -1; return; }
        int dev = 0, cus = 0, per_cu = 0;
        if (hipGetDevice(&dev) != hipSuccess || hipDeviceGetAttribute(&cus, hipDeviceAttributeMultiprocessorCount, dev) != hipSuccess) { grid = -1; return; }
        if (hipFuncSetAttribute((const void*)mega_fwd, hipFuncAttributeMaxDynamicSharedMemorySize, LDS_BYTES) != hipSuccess) { fprintf(stderr, "kernel_launch: hipFuncSetAttribute failed\n"); grid = -1; return; }
        if (hipOccupancyMaxActiveBlocksPerMultiprocessor(&per_cu, (const void*)mega_fwd, NTHR, LDS_BYTES) != hipSuccess || per_cu < 1) { fprintf(stderr, "kernel_launch: occupancy query says %d blocks per CU\n", per_cu); grid = -1; return; }
        (void)hipGetLastError();
        grid = cus;
    }
    if (grid < 0) return;
    (void)hipMemsetAsync((char*)d_ws + WS_CTL, 0, CTL_BYTES, stream);
    KArgs p{};
    for (int i = 0; i < 34; ++i) p.in[i] = (const float*)d_in[i];
    p.out = (float*)d_out; p.ws = (unsigned char*)d_ws;
#if MK_PER_PHASE
    for (int ph = 0; ph < N_PHASES; ++ph) {
        if (ph == 2 + PH_PER_LAYER + 5 || ph == 2 + PH_PER_LAYER + 6) continue;
        p.ph_lo = ph; p.ph_hi = ph + 1;
        hipLaunchKernelGGL(mega_fwd, dim3(grid), dim3(NTHR), LDS_BYTES, stream, p);
    }
#else
    p.ph_lo = 0; p.ph_hi = N_PHASES;
    hipLaunchKernelGGL(mega_fwd, dim3(grid), dim3(NTHR), LDS_BYTES, stream, p);
#endif
    const hipError_t le = hipPeekAtLastError();
    if (le != hipSuccess) fprintf(stderr, "kernel_launch: launch failed: %s\n", hipGetErrorName(le));
}
```

```cpp
#define MK_PER_PHASE 0
#include <hip/hip_runtime.h>
#include <cstdio>
#include <cstdint>

#define GAS __attribute__((address_space(1)))
#define LAS __attribute__((address_space(3)))
typedef unsigned short bf16_t;
typedef short bf16x8 __attribute__((ext_vector_type(8)));
typedef short s16x4 __attribute__((ext_vector_type(4)));
typedef float f32x4 __attribute__((ext_vector_type(4)));
typedef float f32x2 __attribute__((ext_vector_type(2)));
typedef float f32x16 __attribute__((ext_vector_type(16)));
typedef unsigned u32x4 __attribute__((ext_vector_type(4)));
typedef unsigned u32x2 __attribute__((ext_vector_type(2)));

constexpr int DM = 2048, SEQ = 16384, CTXL = 256, TT = SEQ + CTXL;
constexpr int NEXP = 64, NEX1 = 65, EHID = 512, TOPK = 8;
constexpr int EV_IN = 5120, OD_IN = 4608;
constexpr float LN_EPS = 1e-6f;
constexpr float ALPHA = 1.4142135623730951f;
constexpr float LAMBDA_INIT = 0.35550906759f;
constexpr int NTHR = 512, NWAVES = 8;

constexpr size_t al256(size_t x) { return (x + 255) / 256 * 256; }
constexpr size_t WS_CTL   = 0;
constexpr size_t CTL_BYTES = 1u << 20;
constexpr size_t WS_MODP  = WS_CTL + CTL_BYTES;
constexpr size_t WS_MODF  = WS_MODP + al256((size_t)2 * 32 * 2 * 12288 * 4);
constexpr size_t WS_ROPE128 = WS_MODF + al256((size_t)2 * 2 * 12288 * 4);
constexpr size_t WS_ROPE64  = WS_ROPE128 + al256((size_t)256 * 64 * 2 * 4);
constexpr size_t WS_KN    = WS_ROPE64 + al256((size_t)256 * 32 * 2 * 4);
constexpr size_t WS_WT    = WS_KN + al256((size_t)2 * 64 * 16 * 1024 * 2);
constexpr size_t WS_APOW  = WS_WT + al256((size_t)2 * 64 * 128 * 1024 * 2);
constexpr size_t WS_AL    = WS_APOW + al256((size_t)2 * 64 * 64 * 128 * 4);
constexpr size_t WS_CC    = WS_AL + al256((size_t)2 * 64 * 128 * 4);
constexpr size_t WS_BBT   = WS_CC + al256((size_t)64 * 16 * 128 * 2);
constexpr size_t WS_S5E   = WS_BBT + al256((size_t)2 * 64 * 128 * 16 * 2);
constexpr size_t WS_HST   = WS_S5E + al256((size_t)2 * 64 * 260 * 128 * 4);
constexpr size_t WS_WIN0  = WS_HST + al256((size_t)2 * 64 * 260 * 128 * 4);
constexpr size_t WS_WOUT0 = WS_WIN0 + al256((size_t)EV_IN * DM * 2);
constexpr size_t WS_WGLU  = WS_WOUT0 + al256((size_t)DM * DM * 2);
constexpr size_t WS_WIN1  = WS_WGLU + al256((size_t)1024 * 1024 * 2);
constexpr size_t WS_WOUT1 = WS_WIN1 + al256((size_t)OD_IN * DM * 2);
constexpr size_t WS_RWT   = WS_WOUT1 + al256((size_t)DM * DM * 2);
constexpr size_t WS_GU    = WS_RWT + al256((size_t)2 * 2 * 64 * DM * 2);
constexpr size_t WS_DT    = WS_GU + al256((size_t)NEX1 * 1024 * DM * 2);
constexpr size_t WS_XA    = WS_DT + al256((size_t)NEX1 * DM * EHID * 2);
constexpr size_t WS_Z     = WS_XA + al256((size_t)TT * DM * 2);
constexpr size_t WS_YMIX  = WS_Z + al256((size_t)TT * 1024 * 2);
constexpr size_t WS_X1    = WS_YMIX + al256((size_t)TT * DM * 2);
constexpr size_t WS_HX2   = WS_X1 + al256((size_t)TT * DM * 4);
constexpr size_t WS_LIST  = WS_HX2 + al256((size_t)9 * TT * EHID * 2);
constexpr size_t WS_WGT   = WS_LIST + al256((size_t)NEX1 * TT * 4);
constexpr size_t WS_LW    = WS_WGT + al256((size_t)8 * TT * 4);
constexpr size_t WS_BIG   = WS_LW + al256((size_t)NEX1 * TT * 4);
constexpr size_t BG_QKV   = 0;
constexpr size_t BG_CKV   = BG_QKV + al256((size_t)TT * EV_IN * 2);
constexpr size_t BG_SPREV = BG_CKV + al256((size_t)8 * 130 * 65536 * 4);
constexpr size_t BG_MIX   = BG_SPREV + al256((size_t)8 * 130 * 65536 * 2);
constexpr size_t BG_END0  = BG_MIX + al256((size_t)TT * DM * 2);
constexpr size_t BG_ATT   = BG_CKV;
constexpr size_t BG_Q8    = BG_ATT + al256((size_t)SEQ * 3072 * 2);
constexpr size_t BG_K8    = BG_Q8 + al256((size_t)TT * 1024);
constexpr size_t BG_VT8   = BG_K8 + al256((size_t)TT * 256);
constexpr size_t BG_Q8D   = BG_VT8 + al256((size_t)2 * 260 * 128 * 64);
constexpr size_t BG_K8D   = BG_Q8D + al256((size_t)TT * 1024);
constexpr size_t BG_VT8D  = BG_K8D + al256((size_t)TT * 1024);
constexpr size_t BG_F8END = BG_VT8D + al256((size_t)8 * 260 * 128 * 64);
constexpr size_t BG_YMOE  = 0;
constexpr size_t BG_END1  = al256((size_t)9 * TT * DM * 2);
constexpr size_t BG_SIZE  = BG_END0 > BG_END1 ? BG_END0 : BG_END1;
static_assert(BG_F8END <= BG_SIZE, "fp8 attention operands inside the big region");
constexpr size_t WS_END   = WS_BIG + BG_SIZE;

constexpr int CW_BAR = 4096;
constexpr int CW_CNT = 16384;
constexpr int CW_QUEUE = 20480;
constexpr int CW_KMAX = 24576;

constexpr int RING_BYTES = 151552;
constexpr int MISC_OFF = RING_BYTES;
constexpr int LDS_BYTES = 159744;

typedef __bf16 bf16x2_t __attribute__((ext_vector_type(2)));
__device__ __forceinline__ unsigned cvt_pk_bf16(float lo, float hi) { const f32x2 v = {lo, hi}; return __builtin_bit_cast(unsigned, __builtin_convertvector(v, bf16x2_t)); }
__device__ __forceinline__ bf16_t f2bf(float f) { unsigned u = __builtin_bit_cast(unsigned, f); return (bf16_t)((u + 0x7fffu + ((u >> 16) & 1u)) >> 16); }
__device__ __forceinline__ float bf2f(bf16_t b) { return __builtin_bit_cast(float, ((unsigned)b) << 16); }
__device__ __forceinline__ float bflo(unsigned w) { return __builtin_bit_cast(float, w << 16); }
__device__ __forceinline__ float bfhi(unsigned w) { return __builtin_bit_cast(float, w & 0xffff0000u); }
__device__ __forceinline__ float wave_sum(float v) {
#pragma unroll
    for (int o = 1; o < 64; o <<= 1) v += __shfl_xor(v, o);
    return v;
}
__device__ __forceinline__ float fast_exp(float x) { return __builtin_amdgcn_exp2f(x * 1.4426950408889634f); }
__device__ __forceinline__ float sigmoidf_(float x) { return 1.0f / (1.0f + __expf(-x)); }
__device__ __forceinline__ float siluf_(float x) { return x / (1.0f + __expf(-x)); }
__device__ __forceinline__ float gelu_tanh(float x) {
    const float u = 0.7978845608028654f * (x + 0.044715f * x * x * x);
    const float e = __expf(2.0f * u);
    const float t = 1.0f - 2.0f / (e + 1.0f);
    return 0.5f * x * (1.0f + t);
}
#define LDS_WAIT() asm volatile("s_waitcnt lgkmcnt(0)" ::: "memory")
#define VM_WAIT() asm volatile("s_waitcnt vmcnt(0)" ::: "memory")

#define XB_TMO      128
#define XB_XCNT(j)  (256  + 64 * (j))
#define XB_XSUB(j)  (1280 + 64 * (j))
#define XB_XGEN(j)  (2304 + 64 * (j))
#define XB_TOP      3328
#define XB_TOPGEN   3392
#define XCD_BAR_WORDS 3456
#define XB_SPIN_CAP (1u << 22)

__device__ __forceinline__ unsigned xb_ld(unsigned* p)              { return __hip_atomic_load(p, __ATOMIC_RELAXED, __HIP_MEMORY_SCOPE_AGENT); }
__device__ __forceinline__ unsigned xb_add(unsigned* p, unsigned v) { return __hip_atomic_fetch_add(p, v, __ATOMIC_RELAXED, __HIP_MEMORY_SCOPE_AGENT); }
__device__ __forceinline__ unsigned xb_xcc_id() { return (unsigned)__builtin_amdgcn_s_getreg((3 << 11) | 20) & 0xFu; }
#define XB_SPIN(cond, bar) do { unsigned _sp = 0; while (cond) { __builtin_amdgcn_s_sleep(1); \
    if ((++_sp & 255u) == 0u) { if (xb_ld(&(bar)[XB_TMO])) break; if (_sp > XB_SPIN_CAP) { atomicAdd(&(bar)[XB_TMO], 1u); break; } } } } while (0)

struct XcdBarrier { unsigned* bar; unsigned x; volatile LAS unsigned* st; };

__device__ __forceinline__ XcdBarrier xcd_barrier_post(unsigned* bar, volatile LAS unsigned* st) {
    XcdBarrier b; b.bar = bar; b.x = xb_xcc_id(); b.st = st;
    if (threadIdx.x == 0) { st[2] = xb_add(&bar[XB_XCNT(b.x)], 1u); st[3] = b.x; }
    return b;
}
__device__ __forceinline__ void xcd_barrier_complete(unsigned* bar, unsigned x, unsigned& nloc, unsigned& nx) {
    const unsigned G = gridDim.x * gridDim.y * gridDim.z;
    unsigned sum, cnt, mine, sp = 0u;
    for (;;) {
        sum = 0u; cnt = 0u; mine = 0u;
#pragma unroll
        for (unsigned j = 0; j < 16; ++j) { const unsigned c = xb_ld(&bar[XB_XCNT(j)]); sum += c; cnt += (c > 0u) ? 1u : 0u; mine = (j == x) ? c : mine; }
        if (sum == G) break;
        __builtin_amdgcn_s_sleep(1);
        if ((++sp & 255u) == 0u) { if (xb_ld(&bar[XB_TMO])) break; if (sp > XB_SPIN_CAP) { atomicAdd(&bar[XB_TMO], 1u); break; } }
    }
    nloc = mine > 0u ? mine : 1u; nx = cnt > 0u ? cnt : 1u;
}
__device__ __forceinline__ void xcd_barrier(const XcdBarrier& b, int wave_id) {
    const bool leader_thread = (wave_id == 0) && (__builtin_amdgcn_mbcnt_hi(~0u, __builtin_amdgcn_mbcnt_lo(~0u, 0u)) == 0u);
    asm volatile("s_waitcnt vmcnt(0)" ::: "memory");
    __syncthreads();
    if (leader_thread) {
        unsigned* bar = b.bar;
        __builtin_amdgcn_s_waitcnt(0);
        unsigned nloc = b.st[0], nx = b.st[1];
        if (nloc == 0u) { xcd_barrier_complete(bar, b.x, nloc, nx); b.st[0] = nloc; b.st[1] = nx; }
        const unsigned old = xb_add(&bar[XB_XSUB(b.x)], 1u);
        const unsigned gen = old / nloc;
        if (old + 1u == (gen + 1u) * nloc) {
            __builtin_amdgcn_fence(__ATOMIC_RELEASE, "agent");
            asm volatile("s_waitcnt vmcnt(0)" ::: "memory");
            const unsigned og = xb_add(&bar[XB_TOP], 1u);
            const unsigned tg = og / nx;
            if (og + 1u == (tg + 1u) * nx) xb_add(&bar[XB_TOPGEN], 1u);
            else XB_SPIN(xb_ld(&bar[XB_TOPGEN]) == tg, bar);
            __builtin_amdgcn_fence(__ATOMIC_ACQUIRE, "agent");
            xb_add(&bar[XB_XGEN(b.x)], 1u);
            asm volatile("s_waitcnt vmcnt(0)" ::: "memory");
        } else {
            XB_SPIN(xb_ld(&bar[XB_XGEN(b.x)]) == gen, bar);
            __builtin_amdgcn_fence(__ATOMIC_ACQUIRE, "agent");
            asm volatile("s_waitcnt vmcnt(0)" ::: "memory");
        }
    }
    __syncthreads();
}

__device__ __forceinline__ bf16x8 frag_rowk_l(const LAS bf16_t* p, int ld, int lane) {
    return *(const LAS bf16x8*)(p + (lane & 15) * ld + (lane >> 4) * 8);
}
__device__ __forceinline__ bf16x8 frag_rowk_g(const bf16_t* p, long ld, int lane) {
    return *(const bf16x8*)(p + (long)(lane & 15) * ld + (lane >> 4) * 8);
}
__device__ __forceinline__ bf16x8 frag_colk_l(unsigned p, int ldb, int lane) {
    const unsigned a0 = p + (unsigned)((8 * (lane >> 4) + ((lane & 15) >> 2)) * ldb + (lane & 3) * 8);
    const unsigned a1 = a0 + 4u * (unsigned)ldb;
    s16x4 lo, hi;
    asm volatile("ds_read_b64_tr_b16 %0, %2\n\tds_read_b64_tr_b16 %1, %3\n\ts_waitcnt lgkmcnt(0)" : "=&v"(lo), "=&v"(hi) : "v"(a0), "v"(a1) : "memory");
    return (bf16x8){lo[0], lo[1], lo[2], lo[3], hi[0], hi[1], hi[2], hi[3]};
}
#define MFMA16(a, b, c) __builtin_amdgcn_mfma_f32_16x16x32_bf16((a), (b), (c), 0, 0, 0)
namespace pg8 {
constexpr int BM = 256, BK = 64, HALF = 128, HTB = HALF * BK * 2, STAGE_BYTES = 8 * HTB, NXCD = 8, WGM = 8;
__device__ __forceinline__ int lds_byte(int r, int c) { const int st = (r >> 4) * 2 + (c >> 5), rr = r & 15, cc = c & 31, ob = rr * 64 + cc * 2; return st * 1024 + (ob ^ (((ob >> 9) & 1) << 5)); }
__device__ __forceinline__ void stage_rc(int b, int& R, int& C) { const int st = b / 1024, sb = b % 1024, swz = sb ^ (((sb >> 9) & 1) << 5); R = (st >> 1) * 16 + swz / 64; C = (st & 1) * 32 + (swz % 64) / 2; }
__device__ __forceinline__ int perm32(int rho) { const int n = rho >> 4, i = rho & 15; return 8 * (i >> 2) + 4 * n + (i & 3); }

struct Unit { int pm, pn, e; };
constexpr float WSCALE = 32.0f, WSCALE_INV = 1.0f / 32.0f;

struct DenseOrder {
    const bf16_t* A; const bf16_t* Bt; int ldab, kb, nM, nN, nwg, G, c;
    __device__ __forceinline__ void init(const bf16_t* A_, int lda_, const bf16_t* Bt_, int M, int N, int K_, int G_, int c_) { A = A_; ldab = lda_ * 2; Bt = Bt_; kb = K_ * 2; nM = M / BM; nN = N / BM; nwg = nM * nN; G = G_; c = c_; }
    __device__ __forceinline__ void init8(const void* A_, int ldab_, const void* Bt_, int M, int N, int K_, int G_, int c_) { A = (const bf16_t*)A_; ldab = ldab_; Bt = (const bf16_t*)Bt_; kb = K_; nM = M / BM; nN = N / BM; nwg = nM * nN; G = G_; c = c_; }
    __device__ __forceinline__ void prep(LAS unsigned char*) const {}
    __device__ __forceinline__ int units_of_me() const { return c < nwg ? (nwg - c + G - 1) / G : 0; }
    __device__ __forceinline__ int max_units() const { return (nwg + G - 1) / G; }
    __device__ __forceinline__ bool next(int i, Unit& u) const {
        const long L = (long)i * G + c; if (L >= nwg) return false;
        int wgid = (int)L; { const int q = nwg / NXCD, r = nwg % NXCD, xcd = wgid % NXCD, off = wgid / NXCD; wgid = (xcd < r ? xcd * (q + 1) : r * (q + 1) + (xcd - r) * q) + off; }
        const int nig = WGM * nN, gid = wgid / nig, fm = gid * WGM, gsz = (nM - fm) < WGM ? (nM - fm) : WGM;
        u.pm = fm + ((wgid % nig) % gsz); u.pn = (wgid % nig) / gsz; u.e = 0; return true;
    }
    __device__ __forceinline__ const char* a_base() const { return (const char*)A; }
    __device__ __forceinline__ unsigned a_off(const Unit& u, int r) const { return (unsigned)(u.pm * BM + r) * (unsigned)ldab; }
    __device__ __forceinline__ const char* b_ptr(const Unit& u) const { return (const char*)Bt + (size_t)u.pn * BM * kb; }
};

template <int MODE  >
struct MoeOrder {
    const void* A; const void* Bt; const int* list; const int* cnt; int ldab, kb, nN, G, c; size_t bstride;
    LAS int* tp; LAS int* cn; LAS int* rb;
    __device__ __forceinline__ void prep(LAS unsigned char* misc, int tid) {
        tp = (LAS int*)(misc + 64); cn = tp + 72; rb = cn + 72;
        if (tid < NEX1) cn[tid] = cnt[tid];
        __syncthreads();
        if (tid == 0) { int s = 0, q = 0; for (int e = 0; e < NEX1; ++e) { tp[e] = s; rb[e] = q; s += (cn[e] + BM - 1) / BM; q += cn[e]; } tp[NEX1] = s; rb[NEX1] = q; }
        __syncthreads();
    }
    __device__ __forceinline__ bool next(int i, Unit& u) const {
        const int total = tp[NEX1]; const long nu = (long)total * nN; const int per = (int)((nu + G - 1) / G);
        (void)per;
        long L = (long)i * G + c;
        if ((G & 7) == 0) L = ((long)i * 8 + (c & 7)) * (G >> 3) + (c >> 3);
        if (L >= nu) return false;
        const int tile = (int)(L / nN); u.pn = (int)(L % nN);
        int e = 0;
        for (int k = 1; k < NEX1; ++k) e += (tp[k] <= tile) ? 1 : 0;
        u.e = e; u.pm = tile - tp[e]; return true;
    }
    __device__ __forceinline__ const char* a_base() const { return (const char*)A; }
    __device__ __forceinline__ unsigned a_off(const Unit& u, int r) const {
        int pos = u.pm * BM + r; const int n = cn[u.e]; pos = pos < n ? pos : n - 1;
        if (MODE == 1) return (unsigned)(rb[u.e] + pos) * (unsigned)ldab;
        const int a = list[u.e * TT + pos];
        const int row = a < 8 * TT ? (a >> 3) : a - 8 * TT;
        return (unsigned)row * (unsigned)ldab;
    }
    __device__ __forceinline__ const char* b_ptr(const Unit& u) const { return (const char*)Bt + (size_t)u.e * bstride + (size_t)u.pn * BM * kb; }
};

typedef int v8i32 __attribute__((ext_vector_type(8)));
typedef int v4i32_ __attribute__((ext_vector_type(4)));
__device__ __forceinline__ v8i32 cat8(bf16x8 a, bf16x8 b) { const u32x4 x = __builtin_bit_cast(u32x4, a), y = __builtin_bit_cast(u32x4, b); return (v8i32){(int)x.x, (int)x.y, (int)x.z, (int)x.w, (int)y.x, (int)y.y, (int)y.z, (int)y.w}; }
template <bool FP8, class Epi, class Sched>
__device__ __forceinline__ void gemm_phase(LAS unsigned char* lds, const Sched& S, const Epi& E, int wave_id) {
    const int wid = wave_id; int lane = (int)__builtin_amdgcn_mbcnt_hi(~0u, __builtin_amdgcn_mbcnt_lo(~0u, 0u)); asm volatile("" : "+v"(lane));
    const int tid = wid * 64 + lane, wr = wid >> 2, wc = wid & 3, fr = lane & 15, fq = lane >> 4;
    const int kb = S.kb; int nt = kb / 128; asm volatile("" : "+s"(nt));
    unsigned voffB[2];
#pragma unroll
    for (int i = 0; i < 2; ++i) { int R, C; stage_rc(tid * 16 + i * 8192, R, C); const int Rb = (R & ~31) + perm32(R & 31);
        voffB[i] = (unsigned)(Rb * kb) + (unsigned)C * 2u; }
#define PG8_AOFF(u, h, i) ({ int _tz = tid; asm volatile("" : "+v"(_tz)); int _R, _C; stage_rc(_tz * 16 + (i) * 8192, _R, _C); S.a_off((u), (h) * HALF + _R) + (unsigned)_C * 2u; })
    const size_t kstep = (size_t)(BK * 2);
    const size_t hstepB = (size_t)HALF * kb;
    const unsigned ldsw = (unsigned)wid * 1024u;
    const int aoff = lds_byte(wr * 64 + fr, fq * 8), boff = lds_byte(wc * 32 + fr, fq * 8);
#define PG8_SA(b, h) (((b) * 2 + (h)) * HTB)
#define PG8_SB(b, h) ((4 + (b) * 2 + (h)) * HTB)
#define PG8_STAGE(bufoff, gbase, v0, v1) do { \
        __builtin_amdgcn_global_load_lds((const unsigned*)((const char*)(gbase) + (v0)), (LAS unsigned*)(lds + (bufoff) + ldsw), 16, 0, 0); \
        __builtin_amdgcn_global_load_lds((const unsigned*)((const char*)(gbase) + (v1)), (LAS unsigned*)(lds + (bufoff) + ldsw + 8192), 16, 0, 0); } while (0)
#define PG8_VOFFB(i) ({ int _tz = tid; asm volatile("" : "+v"(_tz)); int _R, _C; stage_rc(_tz * 16 + (i) * 8192, _R, _C); (unsigned)(((_R & ~31) + perm32(_R & 31)) * kb) + (unsigned)_C * 2u; })
#define PG8_STAGE_B(bufoff, gbase) do { if constexpr (FP8) { const unsigned _v0 = PG8_VOFFB(0), _v1 = PG8_VOFFB(1); PG8_STAGE(bufoff, gbase, _v0, _v1); } else PG8_STAGE(bufoff, gbase, voffB[0], voffB[1]); } while (0)
#define PG8_LD8(off) __builtin_shufflevector(*(const LAS v4i32_*)(lds + (off)), *(const LAS v4i32_*)(lds + (off) + 1024), 0, 1, 2, 3, 4, 5, 6, 7)
#define PG8_LDA(dst, b, h) do { _Pragma("unroll") for (int m = 0; m < 4; ++m) { if constexpr (FP8) dst##8[m] = PG8_LD8(PG8_SA(b, h) + aoff + m * 2048); else { _Pragma("unroll") for (int k = 0; k < 2; ++k) dst[m][k] = *(const LAS bf16x8*)(lds + PG8_SA(b, h) + aoff + m * 2048 + k * 1024); } } } while (0)
#define PG8_LDB(dst, b, h) do { _Pragma("unroll") for (int n = 0; n < 2; ++n) { if constexpr (FP8) dst##8[n] = PG8_LD8(PG8_SB(b, h) + boff + n * 2048); else { _Pragma("unroll") for (int k = 0; k < 2; ++k) dst[n][k] = *(const LAS bf16x8*)(lds + PG8_SB(b, h) + boff + n * 2048 + k * 1024); } } } while (0)
#define PG8_MMA(ai, bj, At, Bt) do { __builtin_amdgcn_s_setprio(1); _Pragma("unroll") for (int m = 0; m < 4; ++m) _Pragma("unroll") for (int n = 0; n < 2; ++n) { \
        if constexpr (FP8) asm volatile("v_mfma_f32_16x16x128_f8f6f4 %0, %1, %2, %0" : "+v"(acc[ai][bj][m][n]) : "v"(Bt##8[n]), "v"(At##8[m])); \
        else { _Pragma("unroll") for (int k = 0; k < 2; ++k) acc[ai][bj][m][n] = __builtin_amdgcn_mfma_f32_16x16x32_bf16(Bt[n][k], At[m][k], acc[ai][bj][m][n], 0, 0, 0); } } \
        __builtin_amdgcn_s_setprio(0); } while (0)
#define PG8_WAIT_V(n) asm volatile("s_waitcnt vmcnt(" #n ")" ::: "memory")
#define PG8_WAIT_L(n) asm volatile("s_waitcnt lgkmcnt(" #n ")" ::: "memory")
#define PG8_BAR __builtin_amdgcn_s_barrier()
#define PG8_SCHED __builtin_amdgcn_sched_barrier(0)
    Unit cur, nxt; int ui = 0;
    if (!S.next(0, cur)) return;
    f32x4 acc[2][2][4][2];
#pragma unroll
    for (int a = 0; a < 2; ++a)
#pragma unroll
        for (int b = 0; b < 2; ++b)
#pragma unroll
            for (int m = 0; m < 4; ++m)
#pragma unroll
                for (int n = 0; n < 2; ++n) acc[a][b][m][n] = (f32x4){0.f, 0.f, 0.f, 0.f};
    bf16x8 At[4][2], B0[2][2], B1[2][2]; v8i32 At8[4], B08[2], B18[2];
    const char* const gA = S.a_base();
    const char* cB = S.b_ptr(cur);
    unsigned oc00, oc01, oc10, oc11;
    oc00 = PG8_AOFF(cur, 0, 0); oc01 = PG8_AOFF(cur, 0, 1); oc10 = PG8_AOFF(cur, 1, 0); oc11 = PG8_AOFF(cur, 1, 1);
    PG8_STAGE_B(PG8_SB(0, 0), cB); PG8_STAGE_B(PG8_SB(0, 1), cB + hstepB); PG8_STAGE(PG8_SA(0, 0), gA, oc00, oc01); PG8_STAGE(PG8_SA(0, 1), gA, oc10, oc11);
    if (wr == 1) PG8_BAR;
    PG8_WAIT_V(2); PG8_BAR;
    PG8_STAGE_B(PG8_SB(1, 0), cB + kstep); PG8_STAGE(PG8_SA(1, 0), gA + kstep, oc00, oc01); PG8_STAGE_B(PG8_SB(1, 1), cB + hstepB + kstep);
    PG8_WAIT_V(6); PG8_BAR;
    for (;;) {
        const bool has_next = S.next(ui + 1, nxt);
        const char* nB = cB;
        {
            u32x4 on = {oc00, oc01, oc10, oc11};
            if (has_next) { on.x = PG8_AOFF(nxt, 0, 0); on.y = PG8_AOFF(nxt, 0, 1); on.z = PG8_AOFF(nxt, 1, 0); on.w = PG8_AOFF(nxt, 1, 1); nB = S.b_ptr(nxt); }
            *(LAS u32x4*)(lds + STAGE_BYTES + tid * 16) = on;
        }
        for (int t = 0; t < nt; t += 2) {
            const bool last = (t == nt - 2);
            const char* a1 = gA + (size_t)(t + 1) * kstep;
            const char* a2 = last ? gA : gA + (size_t)(t + 2) * kstep; const char* b2 = last ? nB : cB + (size_t)(t + 2) * kstep;
            const char* a3 = a2 + kstep; const char* b3 = b2 + kstep;
            unsigned s00 = oc00, s01 = oc01, s10 = oc10, s11 = oc11;
            if (last) { const u32x4 on = *(const LAS u32x4*)(lds + STAGE_BYTES + tid * 16); s00 = on.x; s01 = on.y; s10 = on.z; s11 = on.w; }
            PG8_LDB(B0, 0, 0); PG8_LDB(B1, 0, 1); PG8_SCHED; PG8_LDA(At, 0, 0); PG8_STAGE(PG8_SA(1, 1), a1, oc10, oc11);
            PG8_WAIT_V(8); PG8_WAIT_L(0); PG8_BAR; PG8_MMA(0, 0, At, B0); PG8_MMA(0, 1, At, B1); PG8_BAR; PG8_SCHED;
            PG8_LDA(At, 0, 1); PG8_STAGE_B(PG8_SB(0, 0), b2); PG8_STAGE_B(PG8_SB(0, 1), b2 + hstepB); PG8_STAGE(PG8_SA(0, 0), a2, s00, s01);
            PG8_WAIT_V(8); PG8_WAIT_L(0); PG8_BAR; PG8_MMA(1, 0, At, B0); PG8_MMA(1, 1, At, B1); PG8_BAR; PG8_SCHED;
            PG8_LDB(B0, 1, 0); PG8_LDB(B1, 1, 1); PG8_SCHED; PG8_LDA(At, 1, 0); PG8_STAGE(PG8_SA(0, 1), a2, s10, s11);
            PG8_WAIT_V(8); PG8_WAIT_L(0); PG8_BAR; PG8_MMA(0, 0, At, B0); PG8_MMA(0, 1, At, B1); PG8_BAR; PG8_SCHED;
            PG8_LDA(At, 1, 1); PG8_STAGE_B(PG8_SB(1, 0), b3); PG8_STAGE_B(PG8_SB(1, 1), b3 + hstepB); PG8_STAGE(PG8_SA(1, 0), a3, s00, s01);
            PG8_WAIT_V(8); PG8_WAIT_L(0); PG8_BAR; PG8_MMA(1, 0, At, B0); PG8_MMA(1, 1, At, B1); PG8_BAR; PG8_SCHED;
        }
        if (wr == 0) PG8_BAR;
        E(acc, cur, wr, wc, fr, fq);
        if (!has_next) break;
#pragma unroll
        for (int a = 0; a < 2; ++a)
#pragma unroll
            for (int b = 0; b < 2; ++b)
#pragma unroll
                for (int m = 0; m < 4; ++m)
#pragma unroll
                    for (int n = 0; n < 2; ++n) acc[a][b][m][n] = (f32x4){0.f, 0.f, 0.f, 0.f};
        { const u32x4 on = *(const LAS u32x4*)(lds + STAGE_BYTES + tid * 16); oc00 = on.x; oc01 = on.y; oc10 = on.z; oc11 = on.w; }
        cur = nxt; cB = nB; ++ui;
        if (wr == 1) PG8_BAR;
    }
    PG8_WAIT_V(0);
    PG8_BAR;
#undef PG8_SA
#undef PG8_SB
#undef PG8_STAGE
#undef PG8_STAGE_B
#undef PG8_AOFF
#undef PG8_VOFFB
#undef PG8_LD8
#undef PG8_LDA
#undef PG8_LDB
#undef PG8_MMA
#undef PG8_WAIT_V
#undef PG8_WAIT_L
#undef PG8_BAR
#undef PG8_SCHED
}

struct EpiStore {
    bf16_t* O; int ldc; float scale;
    __device__ __forceinline__ void operator()(const f32x4 (&acc)[2][2][4][2], const Unit& u, int wr, int wc, int fr, int fq) const {
        const int row0 = u.pm * BM + wr * 64 + fr, col0 = u.pn * BM + wc * 32 + 8 * fq;
#pragma unroll
        for (int ai = 0; ai < 2; ++ai)
#pragma unroll
            for (int m = 0; m < 4; ++m) { bf16_t* rowp = O + (size_t)(row0 + ai * HALF + m * 16) * ldc + col0;
#pragma unroll
                for (int bj = 0; bj < 2; ++bj) { const f32x4 v0 = acc[ai][bj][m][0] * scale, v1 = acc[ai][bj][m][1] * scale;
                    u32x4 w; w.x = cvt_pk_bf16(v0[0], v0[1]); w.y = cvt_pk_bf16(v0[2], v0[3]); w.z = cvt_pk_bf16(v1[0], v1[1]); w.w = cvt_pk_bf16(v1[2], v1[3]);
                    *(u32x4*)(rowp + bj * HALF) = w; } }
    }
};
struct EpiGlu {
    const bf16_t* Z; const float* b; bf16_t* MIX;
    __device__ __forceinline__ void operator()(const f32x4 (&acc)[2][2][4][2], const Unit& u, int wr, int wc, int fr, int fq) const {
        const int row0 = u.pm * BM + wr * 64 + fr, col0 = u.pn * BM + wc * 32 + 8 * fq;
#pragma unroll
        for (int bj = 0; bj < 2; ++bj) {
            const f32x4 b0 = *(const f32x4*)(b + col0 + bj * HALF), b1 = *(const f32x4*)(b + col0 + bj * HALF + 4);
#pragma unroll
            for (int ai = 0; ai < 2; ++ai)
#pragma unroll
                for (int m = 0; m < 4; ++m) { const size_t row = (size_t)(row0 + ai * HALF + m * 16);
                    const u32x4 zz = *(const u32x4*)(Z + row * 1024 + col0 + bj * HALF);
                    const f32x4 v0 = acc[ai][bj][m][0] + b0, v1 = acc[ai][bj][m][1] + b1;
                    u32x4 w;
                    w.x = cvt_pk_bf16(bflo(zz.x) * sigmoidf_(v0[0]), bfhi(zz.x) * sigmoidf_(v0[1]));
                    w.y = cvt_pk_bf16(bflo(zz.y) * sigmoidf_(v0[2]), bfhi(zz.y) * sigmoidf_(v0[3]));
                    w.z = cvt_pk_bf16(bflo(zz.z) * sigmoidf_(v1[0]), bfhi(zz.z) * sigmoidf_(v1[1]));
                    w.w = cvt_pk_bf16(bflo(zz.w) * sigmoidf_(v1[2]), bfhi(zz.w) * sigmoidf_(v1[3]));
                    *(u32x4*)(MIX + row * DM + 1024 + col0 + bj * HALF) = w; }
        }
    }
};
struct EpiE1 {
    unsigned char* H; const LAS int* cn; const LAS int* rb;
    __device__ __forceinline__ void operator()(const f32x4 (&acc)[2][2][4][2], const Unit& u, int wr, int wc, int fr, int fq) const {
        const int n = cn[u.e]; const int colh = u.pn * 128 + wc * 32 + 8 * fq;
#pragma unroll
        for (int ai = 0; ai < 2; ++ai)
#pragma unroll
            for (int m = 0; m < 4; ++m) { const int pos = u.pm * BM + ai * HALF + wr * 64 + m * 16 + fr;
                if (pos < n) { const int a = rb[u.e] + pos;
                    float sc = WSCALE_INV; asm volatile("" : "+v"(sc));
                    const f32x4 g0 = acc[ai][0][m][0] * sc, g1 = acc[ai][0][m][1] * sc, u0 = acc[ai][1][m][0] * sc, u1 = acc[ai][1][m][1] * sc;
                    u32x2 w;
                    w.x = (unsigned)__builtin_amdgcn_cvt_pk_fp8_f32(siluf_(g0[0]) * u0[0], siluf_(g0[1]) * u0[1], 0, false);
                    w.x = (unsigned)__builtin_amdgcn_cvt_pk_fp8_f32(siluf_(g0[2]) * u0[2], siluf_(g0[3]) * u0[3], (int)w.x, true);
                    w.y = (unsigned)__builtin_amdgcn_cvt_pk_fp8_f32(siluf_(g1[0]) * u1[0], siluf_(g1[1]) * u1[1], 0, false);
                    w.y = (unsigned)__builtin_amdgcn_cvt_pk_fp8_f32(siluf_(g1[2]) * u1[2], siluf_(g1[3]) * u1[3], (int)w.y, true);
                    *(u32x2*)(H + (size_t)a * EHID + colh) = w; }
                __builtin_amdgcn_sched_barrier(0); }
    }
};
struct EpiE2 {
    unsigned char* Y; const float* wgt; const LAS int* cn; const LAS int* rb;
    __device__ __forceinline__ void operator()(const f32x4 (&acc)[2][2][4][2], const Unit& u, int wr, int wc, int fr, int fq) const {
        const int n = cn[u.e]; const int col0 = u.pn * BM + wc * 32 + 8 * fq;
#pragma unroll
        for (int ai = 0; ai < 2; ++ai)
#pragma unroll
            for (int m = 0; m < 4; ++m) { const int pos = u.pm * BM + ai * HALF + wr * 64 + m * 16 + fr;
                if (pos < n) { const int a = rb[u.e] + pos; float ws = wgt[u.e * TT + pos] * WSCALE_INV; asm volatile("" : "+v"(ws));
                    unsigned char* rowp = Y + (size_t)a * DM + col0;
#pragma unroll
                    for (int bj = 0; bj < 2; ++bj) { const f32x4 v0 = acc[ai][bj][m][0] * ws, v1 = acc[ai][bj][m][1] * ws;
                        u32x2 w;
                        w.x = (unsigned)__builtin_amdgcn_cvt_pk_fp8_f32(v0[0], v0[1], 0, false); w.x = (unsigned)__builtin_amdgcn_cvt_pk_fp8_f32(v0[2], v0[3], (int)w.x, true);
                        w.y = (unsigned)__builtin_amdgcn_cvt_pk_fp8_f32(v1[0], v1[1], 0, false); w.y = (unsigned)__builtin_amdgcn_cvt_pk_fp8_f32(v1[2], v1[3], (int)w.y, true);
                        *(u32x2*)(rowp + bj * HALF) = w; } }
                __builtin_amdgcn_sched_barrier(0); }
    }
};
}
struct KArgs {
    const float* in[34];
    float* out;
    unsigned char* ws;
    int ph_lo, ph_hi;
};
struct Params {
    float* out;
    unsigned char* ws;
    LAS unsigned long long* ptab;
    int ph_lo, ph_hi;
    __device__ __forceinline__ const float* inp(int k) const {
        const unsigned long long v = ptab[k];
        const unsigned lo = __builtin_amdgcn_readfirstlane((unsigned)v), hi = __builtin_amdgcn_readfirstlane((unsigned)(v >> 32));
        return (const float*)(((unsigned long long)hi << 32) | lo);
    }
};
struct Ctx {
    LAS unsigned char* lds;
    int tid, lane, wave, G, bid;
    int gw, ngw;
};

__device__ __forceinline__ void tr_item(const float* W, int N, bf16_t* WT, int ldt, int k0, int n0, int orow0, LAS float* scr, int lane) {
#pragma unroll 8
    for (int i = 0; i < 32; ++i) { const int kk = 2 * i + (lane >> 5); scr[kk * 33 + (lane & 31)] = W[(size_t)(k0 + kk) * N + n0 + (lane & 31)]; }
    LDS_WAIT(); asm volatile("" ::: "memory");
    const int c = lane & 7;
#pragma unroll
    for (int j = 0; j < 4; ++j) { const int n = (lane >> 3) + 8 * j; const LAS float* s = scr + (8 * c) * 33 + n;
        u32x4 o; o.x = cvt_pk_bf16(s[0 * 33], s[1 * 33]); o.y = cvt_pk_bf16(s[2 * 33], s[3 * 33]); o.z = cvt_pk_bf16(s[4 * 33], s[5 * 33]); o.w = cvt_pk_bf16(s[6 * 33], s[7 * 33]);
        *(u32x4*)(WT + (size_t)(orow0 + n) * ldt + k0 + 8 * c) = o; }
    LDS_WAIT(); asm volatile("" ::: "memory");
}
__device__ __forceinline__ void tr_item64(const float* W, int N, bf16_t* WT, int ldt, int k0, int n0, int orow0, LAS float* scr, int lane) {
    f32x4 v[16];
    const float* src = W + (size_t)(k0 + (lane >> 4)) * N + n0 + 4 * (lane & 15);
#pragma unroll
    for (int i = 0; i < 16; ++i) v[i] = __builtin_nontemporal_load((const f32x4*)(src + (size_t)(4 * i) * N));
#pragma unroll
    for (int i = 0; i < 16; ++i) { LAS float* d = scr + (4 * i + (lane >> 4)) * 65 + 4 * (lane & 15); d[0] = v[i][0]; d[1] = v[i][1]; d[2] = v[i][2]; d[3] = v[i][3]; }
    LDS_WAIT(); asm volatile("" ::: "memory");
    const int c = lane & 7;
#pragma unroll
    for (int j = 0; j < 8; ++j) { const int n = (lane >> 3) + 8 * j; const LAS float* s = scr + (8 * c) * 65 + n;
        u32x4 o; o.x = cvt_pk_bf16(s[0 * 65], s[1 * 65]); o.y = cvt_pk_bf16(s[2 * 65], s[3 * 65]); o.z = cvt_pk_bf16(s[4 * 65], s[5 * 65]); o.w = cvt_pk_bf16(s[6 * 65], s[7 * 65]);
        *(u32x4*)(WT + (size_t)(orow0 + n) * ldt + k0 + 8 * c) = o; }
    LDS_WAIT(); asm volatile("" ::: "memory");
}
__device__ __forceinline__ void tr_item64_fp8(const float* W, int N, unsigned char* WT, int ldt, int k0, int n0, int orow0, LAS float* scr, int lane, float wscale = pg8::WSCALE) {
    f32x4 v[16];
    const float* src = W + (size_t)(k0 + (lane >> 4)) * N + n0 + 4 * (lane & 15);
#pragma unroll
    for (int i = 0; i < 16; ++i) v[i] = __builtin_nontemporal_load((const f32x4*)(src + (size_t)(4 * i) * N));
#pragma unroll
    for (int i = 0; i < 16; ++i) { LAS float* d = scr + (4 * i + (lane >> 4)) * 65 + 4 * (lane & 15); d[0] = v[i][0]; d[1] = v[i][1]; d[2] = v[i][2]; d[3] = v[i][3]; }
    LDS_WAIT(); asm volatile("" ::: "memory");
    const int c = lane & 3;
#pragma unroll
    for (int j = 0; j < 4; ++j) { const int n = (lane >> 2) + 16 * j; const LAS float* s = scr + (16 * c) * 65 + n;
        u32x4 o;
        o.x = (unsigned)__builtin_amdgcn_cvt_pk_fp8_f32(s[0 * 65] * wscale, s[1 * 65] * wscale, 0, false);   o.x = (unsigned)__builtin_amdgcn_cvt_pk_fp8_f32(s[2 * 65] * wscale, s[3 * 65] * wscale, (int)o.x, true);
        o.y = (unsigned)__builtin_amdgcn_cvt_pk_fp8_f32(s[4 * 65] * wscale, s[5 * 65] * wscale, 0, false);   o.y = (unsigned)__builtin_amdgcn_cvt_pk_fp8_f32(s[6 * 65] * wscale, s[7 * 65] * wscale, (int)o.y, true);
        o.z = (unsigned)__builtin_amdgcn_cvt_pk_fp8_f32(s[8 * 65] * wscale, s[9 * 65] * wscale, 0, false);   o.z = (unsigned)__builtin_amdgcn_cvt_pk_fp8_f32(s[10 * 65] * wscale, s[11 * 65] * wscale, (int)o.z, true);
        o.w = (unsigned)__builtin_amdgcn_cvt_pk_fp8_f32(s[12 * 65] * wscale, s[13 * 65] * wscale, 0, false); o.w = (unsigned)__builtin_amdgcn_cvt_pk_fp8_f32(s[14 * 65] * wscale, s[15 * 65] * wscale, (int)o.w, true);
        *(u32x4*)(WT + (size_t)(orow0 + n) * ldt + k0 + 16 * c) = o; }
    LDS_WAIT(); asm volatile("" ::: "memory");
}
__device__ __forceinline__ void tr_dense(const float* W, int K, int N, bf16_t* WT, int item, LAS float* scr, int lane) {
    const int nblk = N / 32, kb = item / nblk, nb = item % nblk;
    tr_item(W, N, WT, K, 64 * kb, 32 * nb, 32 * nb, scr, lane);
}

__device__ __forceinline__ void s5_tables(const Params& p, Ctx& C, int dir, int g) {
    LAS f32x2* PW = (LAS f32x2*)C.lds;
    LAS f32x2* BB = PW + 65 * 64;
    LAS f32x2* CX = BB + 64 * 16;
    const float* a_re = p.inp(11); const float* a_im = p.inp(12); const float* log_dt = p.inp(13);
    const float* b_re = p.inp(14); const float* b_im = p.inp(15); const float* c_re = p.inp(16); const float* c_im = p.inp(17);
    const int tid = C.tid;
    if (tid < 64) {
        const int pp = tid;
        const float dt = __expf(log_dt[dir * 64 + g]);
        const float are = a_re[(dir * 64 + g) * 64 + pp], aim = a_im[(dir * 64 + g) * 64 + pp];
        const float zr = are * dt, zi = aim * dt;
        const float mag = __expf(zr);
        double rev = (double)zi * 0.15915494309189535; rev -= floor(rev);
        const float cs = __builtin_amdgcn_cosf((float)rev), sn = __builtin_amdgcn_sinf((float)rev);
        const float abr = mag * cs, abi = mag * sn;
        const float den = are * are + aim * aim, nr = abr - 1.0f, ni = abi;
        const float fre = (nr * are + ni * aim) / den, fim = (ni * are - nr * aim) / den;
        float pr = 1.0f, pi = 0.0f;
#pragma unroll 1
        for (int n = 0; n <= 64; ++n) { PW[n * 64 + pp] = (f32x2){pr, pi}; const float t = pr * abr - pi * abi; pi = pr * abi + pi * abr; pr = t; }
        for (int j = 0; j < 16; ++j) { const float br = b_re[(g * 64 + pp) * 16 + j], bi = b_im[(g * 64 + pp) * 16 + j];
            BB[pp * 16 + j] = (f32x2){fre * br - fim * bi, fre * bi + fim * br}; }
    }
    for (int q = tid; q < 1024; q += NTHR) { const int i = q >> 6, pp = q & 63; CX[i * 64 + pp] = (f32x2){c_re[(g * 16 + i) * 64 + pp], c_im[(g * 16 + i) * 64 + pp]}; }
    __syncthreads();
    bf16_t* KN = (bf16_t*)(p.ws + WS_KN) + (size_t)(dir * 64 + g) * 16 * 1024;
    float* APOW = (float*)(p.ws + WS_APOW) + (size_t)(dir * 64 + g) * 64 * 128;
    float* AL = (float*)(p.ws + WS_AL) + (size_t)(dir * 64 + g) * 128;
#pragma unroll 1
    for (int q = 0; q < 32; ++q) { const int idx = tid + NTHR * q; const int n = idx >> 8, i = (idx >> 4) & 15, j = idx & 15;
        float s = 0.f;
#pragma unroll 4
        for (int pp = 0; pp < 64; ++pp) { const f32x2 c = CX[i * 64 + pp], w = PW[n * 64 + pp], b = BB[pp * 16 + j];
            const float gr = c.x * b.x - c.y * b.y, gi = c.x * b.y + c.y * b.x;
            s += gr * w.x - gi * w.y; }
        KN[(size_t)i * 1024 + n * 16 + j] = f2bf(s); }
    for (int q = tid; q < 4096; q += NTHR) { const int t = q >> 6, pp = q & 63; const f32x2 w = PW[(t + 1) * 64 + pp]; *(f32x2*)(APOW + (size_t)t * 128 + 2 * pp) = w; }
    if (tid < 64) { const f32x2 w = PW[64 * 64 + tid]; *(f32x2*)(AL + 2 * tid) = w; }
    { bf16_t* BBT = (bf16_t*)(p.ws + WS_BBT) + (size_t)(dir * 64 + g) * 128 * 16;
      for (int q = tid; q < 2048; q += NTHR) { const int pq = q >> 4, j = q & 15; const f32x2 b = BB[(pq & 63) * 16 + j]; BBT[q] = f2bf(pq < 64 ? b.x : b.y); } }
    if (dir == 0) { bf16_t* CCt = (bf16_t*)(p.ws + WS_CC) + (size_t)g * 16 * 128;
        for (int q = tid; q < 2048; q += NTHR) { const int i = q >> 7, pq = q & 127; const f32x2 c = CX[i * 64 + (pq & 63)]; CCt[i * 128 + pq] = f2bf(pq < 64 ? c.x : -c.y); } }
    __syncthreads();
}

__device__ __forceinline__ void phase_p0(const Params& p, Ctx& C) {
    for (int task = C.bid; task < 128; task += C.G) s5_tables(p, C, task >> 6, task & 63);
    {
        const int gt = C.bid * NTHR + C.tid, ngt = C.G * NTHR;
        float* R128 = (float*)(p.ws + WS_ROPE128); float* R64 = (float*)(p.ws + WS_ROPE64);
        for (int q = gt; q < 256 * 64 + 256 * 32; q += ngt) {
            int pos, i, half; float* dst;
            if (q < 256 * 64) { pos = q >> 6; i = q & 63; half = 64; dst = R128 + (size_t)q * 2; }
            else { const int r = q - 256 * 64; pos = r >> 5; i = r & 31; half = 32; dst = R64 + (size_t)r * 2; }
            const float freq = exp2f(-(float)i / (float)half * 13.287712379549449f);
            const float ang = (float)pos * freq;
            double rev = (double)ang * 0.15915494309189535; rev -= floor(rev);
            dst[0] = __builtin_amdgcn_cosf((float)rev); dst[1] = __builtin_amdgcn_sinf((float)rev);
        }
        bf16_t* RWT = (bf16_t*)(p.ws + WS_RWT); const float* rw = p.inp(26);
        for (int q = gt; q < 2 * 64 * DM; q += ngt) { const int L = q / (64 * DM), r = q % (64 * DM), e = r / DM, k = r % DM;
            const float w = rw[((size_t)L * DM + k) * 64 + e]; const bf16_t hi = f2bf(w); const bf16_t lo = f2bf(w - bf2f(hi));
            RWT[((size_t)(L * 2 + 0) * 64 + e) * DM + k] = hi; RWT[((size_t)(L * 2 + 1) * 64 + e) * DM + k] = lo; }
    }
    {
        const float* cvec = p.inp(1); const float* cctx = p.inp(3); const float* mw = p.inp(4);
        float* MODP = (float*)(p.ws + WS_MODP);
        for (int task = C.gw; task < 2 * 32 * 48; task += C.ngw) {
            const int L = task / (32 * 48), r = task % (32 * 48), kb = r / 48, cb = r % 48;
            const float sc = siluf_(cvec[64 * kb + C.lane]), sx = siluf_(cctx[64 * kb + C.lane]);
            f32x4 a0 = {0.f, 0.f, 0.f, 0.f}, a1 = {0.f, 0.f, 0.f, 0.f};
            const float* wp = mw + ((size_t)L * DM + 64 * kb) * 12288 + 256 * cb + 4 * C.lane;
#pragma unroll 8
            for (int kk = 0; kk < 64; ++kk) { const f32x4 w = *(const f32x4*)(wp + (size_t)kk * 12288);
                const float s0 = __shfl(sc, kk), s1 = __shfl(sx, kk);
                a0 += w * s0; a1 += w * s1; }
            *(f32x4*)(MODP + ((size_t)((L * 32 + kb) * 2 + 0)) * 12288 + 256 * cb + 4 * C.lane) = a0;
            *(f32x4*)(MODP + ((size_t)((L * 32 + kb) * 2 + 1)) * 12288 + 256 * cb + 4 * C.lane) = a1;
        }
    }
    {
        LAS float* scr = (LAS float*)(C.lds + C.wave * 17408);
        constexpr int J0 = (DM / 64) * (EV_IN / 64), J3 = (DM / 64) * (OD_IN / 64);
        for (int it = C.gw; it < J0 + J3; it += C.ngw) {
            const bool l1 = it >= J0; const int r = l1 ? it - J0 : it; const int N = l1 ? OD_IN : EV_IN; const int nblk = N / 64, kb = r / nblk, nb = r % nblk;
            tr_item64_fp8(p.inp(l1 ? 21 : 8), N, (unsigned char*)(p.ws + (l1 ? WS_WIN1 : WS_WIN0)), DM, 64 * kb, 64 * nb, 64 * nb, scr, C.lane, 32.0f);
        }
        LAS float* scr2 = (LAS float*)(C.lds + C.wave * 17408);
        constexpr int I1 = (DM / 64) * (DM / 32), I2 = (1024 / 64) * (1024 / 32), I4 = I1;
        for (int it = C.gw; it < I1 + I2 + I4; it += C.ngw) {
            int r = it;
            if (r < I1) { tr_dense(p.inp(9), DM, DM, (bf16_t*)(p.ws + WS_WOUT0), r, scr2, C.lane); continue; } r -= I1;
            if (r < I2) { tr_dense(p.inp(19), 1024, 1024, (bf16_t*)(p.ws + WS_WGLU), r, scr2, C.lane); continue; } r -= I2;
            tr_dense(p.inp(22), DM, DM, (bf16_t*)(p.ws + WS_WOUT1), r, scr2, C.lane);
        }
    }
}
__device__ __forceinline__ void phase_p1(const Params& p, Ctx& C) {
    const float* MODP = (const float*)(p.ws + WS_MODP); float* MODF = (float*)(p.ws + WS_MODF); const float* mb = p.inp(5);
    for (int q = C.bid * NTHR + C.tid; q < 2 * 2 * 12288; q += C.G * NTHR) { const int L = q / (2 * 12288), v = (q / 12288) & 1, col = q % 12288;
        float s = mb[L * 12288 + col];
        for (int kb = 0; kb < 32; ++kb) s += MODP[((size_t)((L * 32 + kb) * 2 + v)) * 12288 + col];
        MODF[q] = s; }
}
__device__ __forceinline__ const float* modv(const Params& p, int L, int v, int k) { return (const float*)(p.ws + WS_MODF) + (size_t)(L * 2 + v) * 12288 + k * DM; }

__device__ __forceinline__ void stage_vec(LAS float* dst, const float* src, int tid) { *(LAS f32x4*)(dst + 4 * tid) = *(const f32x4*)(src + 4 * tid); }
__device__ __forceinline__ void conv_item(const Params& p, Ctx& C, int L, int it) {
    LAS float* scr = (LAS float*)(C.lds + C.wave * 17408);
    unsigned char* GU = (unsigned char*)(p.ws + WS_GU) + (size_t)L * NEX1 * 1024 * DM; unsigned char* DT = (unsigned char*)(p.ws + WS_DT) + (size_t)L * NEX1 * DM * EHID;
    const int e = it / 768, r = it % 768, which = r >> 8, q = r & 255;
    if (which < 2) {
        const float* W = (e < 64) ? p.inp(28 + which) + ((size_t)(L * 64 + e)) * DM * EHID : p.inp(31 + which) + (size_t)L * DM * EHID;
        const int kb = q >> 3, nb = q & 7, n0 = 64 * nb;
        tr_item64_fp8(W, EHID, GU + (size_t)e * 1024 * DM, DM, 64 * kb, n0, 256 * (n0 >> 7) + (n0 & 127) + (which ? 128 : 0), scr, C.lane);
    } else {
        const float* W = (e < 64) ? p.inp(30) + ((size_t)(L * 64 + e)) * EHID * DM : p.inp(33) + (size_t)L * EHID * DM;
        const int kb = q >> 5, nb = q & 31;
        tr_item64_fp8(W, DM, DT + (size_t)e * DM * EHID, EHID, 64 * kb, 64 * nb, 64 * nb, scr, C.lane);
    }
}
__device__ __forceinline__ void conv_queue(const Params& p, Ctx& C, int quota) {
    unsigned* head = (unsigned*)(p.ws + WS_CTL) + CW_QUEUE + 128;
    const int batch = quota < 8 ? quota : 8;
    for (int done = 0; done < quota; done += batch) {
        int it0 = 0; if (C.lane == 0) it0 = (int)atomicAdd(head, (unsigned)batch);
        it0 = __builtin_amdgcn_readfirstlane(it0);
        if (it0 >= NEX1 * 768) break;
        for (int k = 0; k < batch && it0 + k < NEX1 * 768; ++k) conv_item(p, C, 1, it0 + k);
    }
}
__device__ __forceinline__ void phase_modulate(const Params& p, Ctx& C, int L) {
    unsigned char* XA8 = (unsigned char*)(p.ws + WS_XA);
    const float* X2 = (const float*)(p.ws + WS_HX2);
    LAS float* MV = (LAS float*)C.lds;
    for (int v = 0; v < 2; ++v) { stage_vec(MV + (v * 2 + 0) * DM, modv(p, L, v, 0), C.tid); stage_vec(MV + (v * 2 + 1) * DM, modv(p, L, v, 1), C.tid); }
    __syncthreads();
    for (int r = C.gw; r < TT; r += C.ngw) {
        const int v = r < CTXL ? 1 : 0;
        const float* src = (L == 0) ? (r < CTXL ? p.inp(2) + (size_t)r * DM : p.inp(0) + (size_t)(r - CTXL) * DM) : X2 + (size_t)r * DM;
        const LAS float* sh = MV + (v * 2 + 0) * DM; const LAS float* sc = MV + (v * 2 + 1) * DM;
#pragma unroll
        for (int j = 0; j < 8; ++j) { const int c = 4 * (C.lane + 64 * j);
            const f32x4 x = *(const f32x4*)(src + c), a = *(const LAS f32x4*)(sc + c), b = *(const LAS f32x4*)(sh + c);
            const f32x4 y = x * (a + 1.0f) + b;
            unsigned w = (unsigned)__builtin_amdgcn_cvt_pk_fp8_f32(y[0], y[1], 0, false); w = (unsigned)__builtin_amdgcn_cvt_pk_fp8_f32(y[2], y[3], (int)w, true);
            *(unsigned*)(XA8 + (size_t)r * DM + c) = w; }
    }
    __syncthreads();
    if (L == 0) { for (int it = C.gw; it < NEX1 * 768; it += C.ngw) conv_item(p, C, 0, it); }
    else conv_queue(p, C, 1 << 30);
}

__device__ __forceinline__ void phase_rope0(const Params& p, Ctx& C) {
    bf16_t* QKV = (bf16_t*)(p.ws + WS_BIG + BG_QKV);
    const f32x2* R128 = (const f32x2*)(p.ws + WS_ROPE128);
    for (int r = C.gw; r < TT; r += C.ngw) {
        bf16_t* row = QKV + (size_t)r * EV_IN;
        if (r < CTXL) {
#pragma unroll
            for (int j = 0; j < 2; ++j) { u32x4* q = (u32x4*)(row + 8 * (C.lane + 64 * j)); u32x4 w = *q;
                w.x = cvt_pk_bf16(bflo(w.x) * 0.0625f, bfhi(w.x) * 0.0625f); w.y = cvt_pk_bf16(bflo(w.y) * 0.0625f, bfhi(w.y) * 0.0625f);
                w.z = cvt_pk_bf16(bflo(w.z) * 0.0625f, bfhi(w.z) * 0.0625f); w.w = cvt_pk_bf16(bflo(w.w) * 0.0625f, bfhi(w.w) * 0.0625f); *q = w; }
        } else {
            const int l = r - CTXL, rp = l >> 6, cp = l & 63;
#pragma unroll
            for (int qk = 0; qk < 2; ++qk)
#pragma unroll
                for (int m = 0; m < 8; ++m) { const int pi = C.lane + 64 * m, head = pi >> 7, blk = (pi >> 6) & 1, i = pi & 63;
                    bf16_t* b = row + qk * 1024 + head * 256 + blk * 128 + i;
                    const f32x2 cs = R128[(blk ? cp : rp) * 64 + i];
                    const float x1 = bf2f(b[0]), x2 = bf2f(b[64]); const float sc = qk ? 1.0f : 0.0625f;
                    b[0] = f2bf((x1 * cs.x - x2 * cs.y) * sc); b[64] = f2bf((x1 * cs.y + x2 * cs.x) * sc); }
        }
    }
}

__device__ __forceinline__ void phase_normrope1(const Params& p, Ctx& C) {
    bf16_t* QKV = (bf16_t*)(p.ws + WS_BIG + BG_QKV);
    const f32x2* R64 = (const f32x2*)(p.ws + WS_ROPE64);
    const float* qg = p.inp(23);
    unsigned* KMAX = (unsigned*)(p.ws + WS_CTL) + CW_KMAX;
    unsigned char* Q8 = (unsigned char*)(p.ws + WS_BIG + BG_Q8); unsigned char* K8 = (unsigned char*)(p.ws + WS_BIG + BG_K8); unsigned char* VT8 = (unsigned char*)(p.ws + WS_BIG + BG_VT8);
    unsigned char* Q8D = (unsigned char*)(p.ws + WS_BIG + BG_Q8D); unsigned char* K8D = (unsigned char*)(p.ws + WS_BIG + BG_K8D); unsigned char* VT8D = (unsigned char*)(p.ws + WS_BIG + BG_VT8D);
    const int lane = C.lane, i32 = lane & 31; const bool up = lane >= 32;
    const float g00 = qg[lane], g01 = qg[64 + lane], g10 = qg[128 + lane], g11 = qg[128 + 64 + lane];
    for (int r = C.gw; r < TT; r += C.ngw) {
        bf16_t* row = QKV + (size_t)r * OD_IN;
        const bool lat = r >= CTXL; const int l = r - CTXL, rp = lat ? (l >> 6) : 0, cp = lat ? (l & 63) : 0;
        const f32x2 cr = R64[rp * 32 + i32], cc = R64[cp * 32 + i32];
#pragma unroll 2
        for (int h = 0; h < 26; ++h) {
            const int col = h < 8 ? 128 * h : (h < 10 ? 1024 + 128 * (h - 8) : (h < 18 ? 1536 + 128 * (h - 10) : 2560 + 128 * (h - 18)));
            bf16_t* b = row + col;
            float v0 = bf2f(b[lane]), v1 = bf2f(b[64 + lane]);
            if (h < 10) { const float ss = wave_sum(v0 * v0 + v1 * v1); const float rs = rsqrtf(ss * (1.0f / 128.0f) + LN_EPS);
                v0 = bf2f(f2bf(v0 * rs)) * (h < 8 ? g00 : g10); v1 = bf2f(f2bf(v1 * rs)) * (h < 8 ? g01 : g11); }
            if (lat) { const float p0 = __shfl_xor(v0, 32), p1 = __shfl_xor(v1, 32);
                v0 = up ? (p0 * cr.y + v0 * cr.x) : (v0 * cr.x - p0 * cr.y);
                v1 = up ? (p1 * cc.y + v1 * cc.x) : (v1 * cc.x - p1 * cc.y); }
            const bf16_t o0 = f2bf(v0), o1 = f2bf(v1);
            b[lane] = o0; b[64 + lane] = o1;
            {
                const float qs = (h < 8 || (h >= 10 && h < 18)) ? 0.088388347648318440f * 1.4426950408889634f : 1.0f;
                const float w0 = bf2f(o0) * qs, w1 = bf2f(o1) * qs;
                float e4[4];
#pragma unroll
                for (int j = 0; j < 4; ++j) { const float a = __shfl(w0, (4 * lane + j) & 63), c2 = __shfl(w1, (4 * lane + j) & 63); e4[j] = lane < 16 ? a : c2; }
                unsigned pk = (unsigned)__builtin_amdgcn_cvt_pk_fp8_f32(e4[0], e4[1], 0, false); pk = (unsigned)__builtin_amdgcn_cvt_pk_fp8_f32(e4[2], e4[3], (int)pk, true);
                unsigned char* dst8 = h < 8 ? Q8 + (size_t)r * 1024 + 128 * h : (h < 10 ? K8 + (size_t)r * 256 + 128 * (h - 8) : (h < 18 ? Q8D + (size_t)r * 1024 + 128 * (h - 10) : K8D + (size_t)r * 1024 + 128 * (h - 18)));
                if (lane < 32) *(unsigned*)(dst8 + 4 * lane) = pk; }
            if ((h >= 8 && h < 10) || h >= 18) {
                const float w0 = bf2f(o0), w1 = bf2f(o1); const float k2 = wave_sum(w0 * w0 + w1 * w1);
                if (lane == 0) atomicMax(KMAX + 64 * (h < 10 ? h - 8 : h - 16), __float_as_uint(k2)); }
        }
    }
    LAS bf16_t* vt = (LAS bf16_t*)(C.lds + C.wave * 17408);
    for (int item = C.gw; item < 10 * 260; item += C.ngw) {
        const int kh = item / 260, T = item % 260;
        const int vcol = kh < 2 ? 1280 + 128 * kh : 3584 + 128 * (kh - 2);
        unsigned char* vout = kh < 2 ? VT8 + (size_t)kh * 260 * 8192 : VT8D + (size_t)(kh - 2) * 260 * 8192;
#pragma unroll
        for (int q = 0; q < 16; ++q) { const int idx = lane + 64 * q, key = idx >> 4, c = idx & 15;
            *(LAS u32x4*)(vt + key * 136 + 8 * c) = *(const u32x4*)(QKV + (size_t)(64 * T + key) * OD_IN + vcol + 8 * c); }
        LDS_WAIT(); asm volatile("" ::: "memory");
#pragma unroll
        for (int dd = 0; dd < 2; ++dd) { const int d = lane + 64 * dd;
            unsigned char* dst = vout + ((size_t)T * 128 + d) * 64;
#pragma unroll
            for (int cch = 0; cch < 4; ++cch) { u32x4 w;
#pragma unroll
                for (int wd = 0; wd < 4; ++wd) { float f[4];
#pragma unroll
                    for (int e = 0; e < 4; ++e) { const int bb = 16 * cch + 4 * wd + e, hi2 = bb >> 5, blk = (bb >> 4) & 1, j = bb & 15; const int key = 32 * blk + (j & 3) + 8 * (j >> 2) + 4 * hi2;
                        f[e] = bf2f(vt[key * 136 + d]); }
                    unsigned pk = (unsigned)__builtin_amdgcn_cvt_pk_fp8_f32(f[0], f[1], 0, false); pk = (unsigned)__builtin_amdgcn_cvt_pk_fp8_f32(f[2], f[3], (int)pk, true);
                    w[wd] = pk; }
                *(u32x4*)(dst + 16 * cch) = w; } }
        LDS_WAIT(); asm volatile("" ::: "memory");
    }
}

__device__ __forceinline__ void phase_merge1(const Params& p, Ctx& C) {
    bf16_t* ATT = (bf16_t*)(p.ws + WS_BIG + BG_ATT);
    const float* dl = p.inp(24); const float* sg = p.inp(25);
    const int lane = C.lane;
    float d0 = dl[lane] * dl[128 + lane] + dl[64 + lane] * dl[128 + 64 + lane];
    float d1 = dl[256 + lane] * dl[384 + lane] + dl[256 + 64 + lane] * dl[384 + 64 + lane];
    const float lam = __expf(wave_sum(d0)) - __expf(wave_sum(d1)) + LAMBDA_INIT;
    const f32x4 gg = *(const f32x4*)(sg + 4 * lane);
    for (int l = C.gw; l < SEQ; l += C.ngw) {
        bf16_t* row = ATT + (size_t)l * 3072;
#pragma unroll
        for (int h = 0; h < 4; ++h) {
            const u32x2 a = *(const u32x2*)(row + 1024 + 256 * h + 4 * lane), b = *(const u32x2*)(row + 2048 + 256 * h + 4 * lane);
            f32x4 o = {bflo(a.x) - lam * bflo(b.x), bfhi(a.x) - lam * bfhi(b.x), bflo(a.y) - lam * bflo(b.y), bfhi(a.y) - lam * bfhi(b.y)};
            const float ss = wave_sum(o[0] * o[0] + o[1] * o[1] + o[2] * o[2] + o[3] * o[3]);
            const float rs = rsqrtf(ss * (1.0f / 256.0f) + LN_EPS) * (1.0f - LAMBDA_INIT);
            o = o * rs * gg;
            u32x2 w; w.x = cvt_pk_bf16(o[0], o[1]); w.y = cvt_pk_bf16(o[2], o[3]);
            *(u32x2*)(row + 1024 + 256 * h + 4 * lane) = w;
        }
    }
}

__device__ __forceinline__ void phase_ln1(const Params& p, Ctx& C, int L) {
    const bf16_t* Y = (const bf16_t*)(p.ws + WS_YMIX); float* X1 = (float*)(p.ws + WS_X1); unsigned char* XA8 = (unsigned char*)(p.ws + WS_XA);
    const float* X2 = (const float*)(p.ws + WS_HX2);
    const float* lg = p.inp(6) + (size_t)(L * 2 + 0) * DM; const float* lb = p.inp(7) + (size_t)(L * 2 + 0) * DM;
    const int r0 = (L == 0) ? 0 : CTXL;
    LAS float* MV = (LAS float*)C.lds; LAS float* LG = MV + 6 * DM; LAS float* LB = LG + DM;
    for (int v = 0; v < 2; ++v) for (int k = 0; k < 3; ++k) stage_vec(MV + (v * 3 + k) * DM, modv(p, L, v, 2 + k), C.tid);
    stage_vec(LG, lg, C.tid); stage_vec(LB, lb, C.tid);
    __syncthreads();
    for (int r = r0 + C.gw; r < TT; r += C.ngw) {
        const int v = r < CTXL ? 1 : 0;
        const float* src = (L == 0) ? (r < CTXL ? p.inp(2) + (size_t)r * DM : p.inp(0) + (size_t)(r - CTXL) * DM) : X2 + (size_t)r * DM;
        const LAS float* g1 = MV + (v * 3 + 0) * DM; const LAS float* sh2 = MV + (v * 3 + 1) * DM; const LAS float* sc2 = MV + (v * 3 + 2) * DM;
        f32x4 t[8]; float s = 0.f;
#pragma unroll
        for (int j = 0; j < 8; ++j) { const int c = 4 * (C.lane + 64 * j);
            const f32x4 x = *(const f32x4*)(src + c), g = *(const LAS f32x4*)(g1 + c); const u32x2 yy = *(const u32x2*)(Y + (size_t)r * DM + c);
            const f32x4 y = {bflo(yy.x), bfhi(yy.x), bflo(yy.y), bfhi(yy.y)};
            t[j] = x * ALPHA + g * y; s += (t[j][0] + t[j][1]) + (t[j][2] + t[j][3]); }
        const float mean = wave_sum(s) * (1.0f / DM); float s2 = 0.f;
#pragma unroll
        for (int j = 0; j < 8; ++j) { t[j] = t[j] - mean; s2 += (t[j][0] * t[j][0] + t[j][1] * t[j][1]) + (t[j][2] * t[j][2] + t[j][3] * t[j][3]); }
        const float rstd = rsqrtf(wave_sum(s2) * (1.0f / DM) + LN_EPS);
#pragma unroll
        for (int j = 0; j < 8; ++j) { const int c = 4 * (C.lane + 64 * j);
            const f32x4 x1 = t[j] * rstd * *(const LAS f32x4*)(LG + c) + *(const LAS f32x4*)(LB + c);
            *(f32x4*)(X1 + (size_t)r * DM + c) = x1;
            const f32x4 z = x1 * (*(const LAS f32x4*)(sc2 + c) + 1.0f) + *(const LAS f32x4*)(sh2 + c);
            unsigned w = (unsigned)__builtin_amdgcn_cvt_pk_fp8_f32(z[0], z[1], 0, false); w = (unsigned)__builtin_amdgcn_cvt_pk_fp8_f32(z[2], z[3], (int)w, true);
            *(unsigned*)(XA8 + (size_t)r * DM + c) = w; }
    }
    __syncthreads();
}

__device__ __forceinline__ void phase_combine(const Params& p, Ctx& C, int L, LAS unsigned char* misc) {
    const unsigned char* YM = (const unsigned char*)(p.ws + WS_BIG + BG_YMOE); const float* X1 = (const float*)(p.ws + WS_X1);
    float* X2 = (float*)(p.ws + WS_HX2);
    const float* lg = p.inp(6) + (size_t)(L * 2 + 1) * DM; const float* lb = p.inp(7) + (size_t)(L * 2 + 1) * DM;
    const unsigned* PK = (const unsigned*)(p.ws + WS_WGT); const int* cnt = (const int*)(p.ws + WS_CTL) + CW_CNT + L * 128;
    const int r0 = (L == 0) ? 0 : CTXL;
    LAS int* rb = (LAS int*)(misc + 64);
    LAS float* MV = (LAS float*)C.lds; LAS float* LG = MV + 2 * DM; LAS float* LB = LG + DM;
    __syncthreads();
    if (C.tid == 0) { int q = 0; for (int e = 0; e < NEX1; ++e) { rb[e] = q; q += cnt[e]; } }
    stage_vec(MV, modv(p, L, 0, 5), C.tid); stage_vec(MV + DM, modv(p, L, 1, 5), C.tid); stage_vec(LG, lg, C.tid); stage_vec(LB, lb, C.tid);
    __syncthreads();
    for (int r = r0 + C.gw; r < TT; r += C.ngw) {
        const int v = r < CTXL ? 1 : 0;
        const LAS float* g2 = MV + v * DM;
        int ln = C.lane; asm volatile("" : "+v"(ln));
        int slot = rb[64] + (r - r0);
        if (ln < 8) { const unsigned pk = PK[(size_t)r * 8 + ln]; slot = rb[pk >> 16] + (int)(pk & 0xffffu); }
        f32x4 t[2][4]; float s = 0.f;
#pragma unroll
        for (int j = 0; j < 2; ++j) { const int c = 16 * (ln + 64 * j);
            u32x4 yy[9];
#pragma unroll
            for (int k = 0; k < 9; ++k) { const size_t a = (size_t)__builtin_amdgcn_readlane(slot, k); yy[k] = __builtin_nontemporal_load((const u32x4*)(YM + a * DM + c)); }
            f32x2 f[8];
#pragma unroll
            for (int q = 0; q < 8; ++q) f[q] = (f32x2){0.f, 0.f};
#pragma unroll
            for (int k = 0; k < 9; ++k) {
                f[0] += __builtin_amdgcn_cvt_pk_f32_fp8((int)yy[k].x, false); f[1] += __builtin_amdgcn_cvt_pk_f32_fp8((int)yy[k].x, true);
                f[2] += __builtin_amdgcn_cvt_pk_f32_fp8((int)yy[k].y, false); f[3] += __builtin_amdgcn_cvt_pk_f32_fp8((int)yy[k].y, true);
                f[4] += __builtin_amdgcn_cvt_pk_f32_fp8((int)yy[k].z, false); f[5] += __builtin_amdgcn_cvt_pk_f32_fp8((int)yy[k].z, true);
                f[6] += __builtin_amdgcn_cvt_pk_f32_fp8((int)yy[k].w, false); f[7] += __builtin_amdgcn_cvt_pk_f32_fp8((int)yy[k].w, true); }
#pragma unroll
            for (int q = 0; q < 4; ++q) { const f32x4 x = *(const f32x4*)(X1 + (size_t)r * DM + c + 4 * q), g = *(const LAS f32x4*)(g2 + c + 4 * q);
                const f32x4 ff = {f[2 * q][0], f[2 * q][1], f[2 * q + 1][0], f[2 * q + 1][1]};
                t[j][q] = x * ALPHA + g * ff; s += (t[j][q][0] + t[j][q][1]) + (t[j][q][2] + t[j][q][3]); } }
        const float mean = wave_sum(s) * (1.0f / DM); float s2 = 0.f;
#pragma unroll
        for (int j = 0; j < 2; ++j)
#pragma unroll
            for (int q = 0; q < 4; ++q) { t[j][q] = t[j][q] - mean; s2 += (t[j][q][0] * t[j][q][0] + t[j][q][1] * t[j][q][1]) + (t[j][q][2] * t[j][q][2] + t[j][q][3] * t[j][q][3]); }
        const float rstd = rsqrtf(wave_sum(s2) * (1.0f / DM) + LN_EPS);
        float* dst = (L == 0) ? X2 + (size_t)r * DM : p.out + (size_t)(r - CTXL) * DM;
#pragma unroll
        for (int j = 0; j < 2; ++j)
#pragma unroll
            for (int q = 0; q < 4; ++q) { const int c = 16 * (ln + 64 * j) + 4 * q;
                *(f32x4*)(dst + c) = t[j][q] * rstd * *(const LAS f32x4*)(LG + c) + *(const LAS f32x4*)(LB + c); }
    }
}
constexpr int RLD = 264;
constexpr int SLD = 136;

template <bool SCALE>
__device__ __forceinline__ void stage_chunk(const bf16_t* QKV, int row0, int col0, LAS bf16_t* dst, int tid, float lg  , int dirb) {
#pragma unroll
    for (int q = 0; q < 8; ++q) { const int idx = tid + NTHR * q, r = idx >> 5, c = idx & 31;
        u32x4 w = *(const u32x4*)(QKV + (size_t)(row0 + r) * EV_IN + col0 + 8 * c);
        if (SCALE) { const float sc = fast_exp((dirb ? (float)r : (float)(127 - r)) * lg);
            w.x = cvt_pk_bf16(bflo(w.x) * sc, bfhi(w.x) * sc); w.y = cvt_pk_bf16(bflo(w.y) * sc, bfhi(w.y) * sc);
            w.z = cvt_pk_bf16(bflo(w.z) * sc, bfhi(w.z) * sc); w.w = cvt_pk_bf16(bflo(w.w) * sc, bfhi(w.w) * sc); }
        *(LAS u32x4*)(dst + r * RLD + 8 * c) = w; }
}

__device__ __forceinline__ void ret_chunk_kv(const Params& p, Ctx& C) {
    const bf16_t* QKV = (const bf16_t*)(p.ws + WS_BIG + BG_QKV); bf16_t* CKV = (bf16_t*)(p.ws + WS_BIG + BG_CKV);
    const float* rld = p.inp(10);
    LAS bf16_t* Vs = (LAS bf16_t*)C.lds; LAS bf16_t* Ks = Vs + 128 * RLD;
    const int lane = C.lane, w = C.wave;
    for (int unit = C.bid; unit < 130 * 8; unit += C.G) {
        const int u = unit >> 3, h = (unit >> 1) & 3, dir = unit & 1;
        const float lg = rld[dir * 4 + h];
        __syncthreads();
        stage_chunk<false>(QKV, 128 * u, 2048 + 256 * h, Vs, C.tid, 0.f, 0);
        stage_chunk<true>(QKV, 128 * u, 1024 + 256 * h, Ks, C.tid, lg, dir);
        __syncthreads();
        f32x4 acc[2][16];
#pragma unroll
        for (int a = 0; a < 2; ++a)
#pragma unroll
            for (int b = 0; b < 16; ++b) acc[a][b] = (f32x4){0.f, 0.f, 0.f, 0.f};
        const unsigned vbase = (unsigned)(uintptr_t)Vs, kbase = (unsigned)(uintptr_t)Ks;
#pragma unroll 1
        for (int ks = 0; ks < 4; ++ks) {
            bf16x8 af[2];
#pragma unroll
            for (int a = 0; a < 2; ++a) af[a] = frag_colk_l(vbase + (unsigned)((32 * ks) * RLD + 32 * w + 16 * a) * 2u, RLD * 2, lane);
#pragma unroll
            for (int b = 0; b < 16; ++b) { const bf16x8 bf = frag_colk_l(kbase + (unsigned)((32 * ks) * RLD + 16 * b) * 2u, RLD * 2, lane);
                acc[0][b] = MFMA16(bf, af[0], acc[0][b]); acc[1][b] = MFMA16(bf, af[1], acc[1][b]); }
        }
        bf16_t* dst = CKV + ((size_t)((dir * 4 + h) * 130 + u)) * 65536;
#pragma unroll
        for (int a = 0; a < 2; ++a)
#pragma unroll
            for (int b = 0; b < 16; ++b) { u32x2 w2; w2.x = cvt_pk_bf16(acc[a][b][0], acc[a][b][1]); w2.y = cvt_pk_bf16(acc[a][b][2], acc[a][b][3]);
                *(u32x2*)(dst + (size_t)(32 * w + 16 * a + (lane & 15)) * 256 + 16 * b + 4 * (lane >> 4)) = w2; }
    }
    __syncthreads();
}

__device__ __forceinline__ int s5_row(int dir, int c, int s) { return dir == 0 ? 64 * c + s : (c < 4 ? 255 - (64 * c + s) : 16639 - 64 * (c - 4) - s); }

__device__ __forceinline__ void s5_end_states(const Params& p, Ctx& C) {
    const bf16_t* QKV = (const bf16_t*)(p.ws + WS_BIG + BG_QKV); const bf16_t* BBT = (const bf16_t*)(p.ws + WS_BBT); float* E = (float*)(p.ws + WS_S5E);
    const float* APOW = (const float*)(p.ws + WS_APOW);
    LAS f32x2* PL = (LAS f32x2*)C.lds;
    for (int bt = C.bid; bt < 256; bt += C.G) {
        int tid = C.tid; asm volatile("" : "+v"(tid));
        const int lane = tid & 63, r32 = lane & 31, hi = lane >> 5;
        const int dg = bt >> 1, dir = dg >> 6, g = dg & 63, c0 = 130 * (bt & 1);
        __syncthreads();
#pragma unroll
        for (int q = 0; q < 8; ++q) { const int idx = tid + NTHR * q, s = idx >> 6, pp = idx & 63;
            PL[idx] = (s == 63) ? (f32x2){1.0f, 0.0f} : *(const f32x2*)(APOW + ((size_t)dg * 64 + (62 - s)) * 128 + 2 * pp); }
        __syncthreads();
        bf16x8 bfr[4];
#pragma unroll
        for (int pt = 0; pt < 4; ++pt) bfr[pt] = *(const bf16x8*)(BBT + ((size_t)dg * 128 + 32 * pt + r32) * 16 + 8 * hi);
        for (int c = c0 + C.wave; c < c0 + 130; c += 8) {
            float er[2] = {0.f, 0.f}, ei[2] = {0.f, 0.f};
#pragma unroll
            for (int st = 0; st < 2; ++st) {
                const bf16x8 a = *(const bf16x8*)(QKV + (size_t)s5_row(dir, c, 32 * st + r32) * EV_IN + 4096 + 16 * g + 8 * hi);
                f32x16 d[4];
#pragma unroll
                for (int pt = 0; pt < 4; ++pt) d[pt] = __builtin_amdgcn_mfma_f32_32x32x16_bf16(a, bfr[pt], (f32x16){}, 0, 0, 0);
#pragma unroll
                for (int r = 0; r < 16; ++r) { const int s = 32 * st + (r & 3) + 8 * (r >> 2) + 4 * hi;
#pragma unroll
                    for (int pt = 0; pt < 2; ++pt) { const f32x2 pw = PL[s * 64 + 32 * pt + r32]; const float br = d[pt][r], bi = d[pt + 2][r];
                        er[pt] += pw.x * br - pw.y * bi; ei[pt] += pw.x * bi + pw.y * br; } }
            }
#pragma unroll
            for (int pt = 0; pt < 2; ++pt) {
                { auto rr = __builtin_amdgcn_permlane32_swap(__float_as_uint(er[pt]), __float_as_uint(er[pt]), false, false); er[pt] = __uint_as_float(rr[0]) + __uint_as_float(rr[1]); }
                { auto rr = __builtin_amdgcn_permlane32_swap(__float_as_uint(ei[pt]), __float_as_uint(ei[pt]), false, false); ei[pt] = __uint_as_float(rr[0]) + __uint_as_float(rr[1]); }
            }
            float* dst = E + ((size_t)dg * 260 + c) * 128;
            if (hi == 0) { dst[r32] = er[0]; dst[32 + r32] = er[1]; dst[64 + r32] = ei[0]; dst[96 + r32] = ei[1]; }
        }
    }
    __syncthreads();
}

__device__ __forceinline__ void phase_scans(const Params& p, Ctx& C) {
    const bf16_t* CKV = (const bf16_t*)(p.ws + WS_BIG + BG_CKV); bf16_t* SP = (bf16_t*)(p.ws + WS_BIG + BG_SPREV);
    const float* rld = p.inp(10);
    for (int q = C.bid * NTHR + C.tid; q < 8 * 16384; q += C.G * NTHR) {
        const int dh = q >> 14, el = (q & 16383) * 4, dir = dh >> 2, h = dh & 3;
        const float gch = fast_exp(128.0f * rld[dir * 4 + h]);
        const bf16_t* src = CKV + (size_t)dh * 130 * 65536 + el; bf16_t* dst = SP + (size_t)dh * 130 * 65536 + el;
        f32x4 s = {0.f, 0.f, 0.f, 0.f};
        for (int st0 = 0; st0 < 130; st0 += 13) {
            u32x2 kv[13];
#pragma unroll
            for (int k = 0; k < 13; ++k) { const int st = st0 + k; const int u = dir == 0 ? st : (st == 0 ? 1 : (st == 1 ? 0 : 131 - st)); kv[k] = __builtin_nontemporal_load((const u32x2*)(src + (size_t)u * 65536)); }
#pragma unroll
            for (int k = 0; k < 13; ++k) { const int st = st0 + k; const int u = dir == 0 ? st : (st == 0 ? 1 : (st == 1 ? 0 : 131 - st));
                u32x2 w; w.x = cvt_pk_bf16(s[0], s[1]); w.y = cvt_pk_bf16(s[2], s[3]); *(u32x2*)(dst + (size_t)u * 65536) = w;
                s = s * gch + (f32x4){bflo(kv[k].x), bfhi(kv[k].x), bflo(kv[k].y), bfhi(kv[k].y)}; }
        }
    }
    const float* E = (const float*)(p.ws + WS_S5E); float* HST = (float*)(p.ws + WS_HST); const float* AL = (const float*)(p.ws + WS_AL);
    for (int q = C.bid * NTHR + C.tid; q < 2 * 64 * 64; q += C.G * NTHR) {
        const int dg = q >> 6, pp = q & 63;
        const f32x2 al = *(const f32x2*)(AL + (size_t)dg * 128 + 2 * pp);
        const float* e = E + (size_t)dg * 260 * 128; float* hs = HST + (size_t)dg * 260 * 128;
        float hr = 0.f, hi = 0.f;
        for (int c0 = 0; c0 < 260; c0 += 26) {
            float er[26], ei[26];
#pragma unroll
            for (int k = 0; k < 26; ++k) { er[k] = e[(size_t)(c0 + k) * 128 + pp]; ei[k] = e[(size_t)(c0 + k) * 128 + 64 + pp]; }
#pragma unroll
            for (int k = 0; k < 26; ++k) { *(f32x2*)(hs + (size_t)(c0 + k) * 128 + 2 * pp) = (f32x2){hr, hi};
                const float t = al.x * hr - al.y * hi + er[k]; hi = al.x * hi + al.y * hr + ei[k]; hr = t; }
        }
    }
}

__device__ __forceinline__ void ret_output_unit(const Params& p, Ctx& C, int unit) {
    const bf16_t* QKV = (const bf16_t*)(p.ws + WS_BIG + BG_QKV); const bf16_t* SP = (const bf16_t*)(p.ws + WS_BIG + BG_SPREV);
    bf16_t* MIX = (bf16_t*)(p.ws + WS_BIG + BG_MIX);
    const float* rld = p.inp(10);
    LAS bf16_t* RA = (LAS bf16_t*)C.lds; LAS bf16_t* RB = RA + 128 * RLD;
    int tid = C.tid; asm volatile("" : "+v"(tid));
    const int lane = tid & 63, w = C.wave, kq = lane >> 4, fr = lane & 15;
    const int u = unit >> 2, h = unit & 3;
    const float lgf = rld[h], lgb = rld[4 + h];
    stage_chunk<false>(QKV, 128 * u, 256 * h, RA, tid, 0.f, 0);
    int ib = 16 * w + 4 * kq, jb = fr; asm volatile("" : "+v"(ib), "+v"(jb));
    f32x4 acc[16];
#pragma unroll
    for (int t = 0; t < 16; ++t) acc[t] = (f32x4){0.f, 0.f, 0.f, 0.f};
#pragma unroll
    for (int dir = 0; dir < 2; ++dir) {
        const bf16_t* Sd = SP + ((size_t)((dir * 4 + h) * 130 + u)) * 65536;
#pragma unroll
        for (int eh = 0; eh < 2; ++eh) {
            __syncthreads();
#pragma unroll
            for (int q = 0; q < 8; ++q) { const int idx = tid + NTHR * q, rr = idx >> 5, c = idx & 31;
                *(LAS u32x4*)(RB + rr * RLD + 8 * c) = *(const u32x4*)(Sd + (size_t)(128 * eh + rr) * 256 + 8 * c);
                if (q == 3) asm volatile("" ::: "memory"); }
            __syncthreads();
#pragma unroll 1
            for (int ks = 0; ks < 8; ++ks) { const bf16x8 af = frag_rowk_l(RA + (16 * w) * RLD + 32 * ks, RLD, lane);
#pragma unroll
                for (int t = 0; t < 8; ++t) { const bf16x8 bf = frag_rowk_l(RB + (16 * t) * RLD + 32 * ks, RLD, lane); acc[8 * eh + t] = MFMA16(af, bf, acc[8 * eh + t]); } }
        }
#pragma unroll
        for (int r = 0; r < 4; ++r) { const int i = ib + r; const float qd = fast_exp((float)(128 - i) * lgb);
            const float f = (dir == 0) ? fast_exp((float)(i + 1) * lgf) / qd : qd;
#pragma unroll
            for (int t = 0; t < 16; ++t) acc[t][r] *= f; }
    }
    __syncthreads();
    stage_chunk<false>(QKV, 128 * u, 1024 + 256 * h, RB, tid, 0.f, 0);
    __syncthreads();
    f32x4 sc[8];
#pragma unroll
    for (int t = 0; t < 8; ++t) sc[t] = (f32x4){0.f, 0.f, 0.f, 0.f};
#pragma unroll 1
    for (int ks = 0; ks < 8; ++ks) { const bf16x8 af = frag_rowk_l(RA + (16 * w) * RLD + 32 * ks, RLD, lane);
#pragma unroll
        for (int t = 0; t < 8; ++t) { const bf16x8 bf = frag_rowk_l(RB + (16 * t) * RLD + 32 * ks, RLD, lane); sc[t] = MFMA16(af, bf, sc[t]); } }
#pragma unroll
    for (int t = 0; t < 8; ++t)
#pragma unroll
        for (int r = 0; r < 4; ++r) { const int i = ib + r, j = 16 * t + jb; const float d = (float)(i - j);
            const float m = (i >= j ? fast_exp(d * lgf) : 0.f) + (j >= i ? fast_exp(-d * lgb) : 0.f); sc[t][r] *= m; }
    __syncthreads();
    stage_chunk<false>(QKV, 128 * u, 2048 + 256 * h, RA, tid, 0.f, 0);
#pragma unroll
    for (int t = 0; t < 8; ++t)
#pragma unroll
        for (int r = 0; r < 4; ++r) RB[(16 * w + 4 * kq + r) * SLD + 16 * t + fr] = f2bf(sc[t][r]);
    __syncthreads();
    const unsigned vbase = (unsigned)(uintptr_t)RA;
#pragma unroll 1
    for (int ks = 0; ks < 4; ++ks) { const bf16x8 af = frag_rowk_l(RB + (16 * w) * SLD + 32 * ks, SLD, lane);
#pragma unroll
        for (int t = 0; t < 16; ++t) { const bf16x8 bf = frag_colk_l(vbase + (unsigned)((32 * ks) * RLD + 16 * t) * 2u, RLD * 2, lane); acc[t] = MFMA16(af, bf, acc[t]); } }
    __syncthreads();
#pragma unroll
    for (int r = 0; r < 4; ++r) {
        float s = 0.f;
#pragma unroll
        for (int t = 0; t < 16; ++t) s += acc[t][r];
        s += __shfl_xor(s, 1); s += __shfl_xor(s, 2); s += __shfl_xor(s, 4); s += __shfl_xor(s, 8);
        const float mean = s * (1.0f / 256.0f); float q = 0.f;
#pragma unroll
        for (int t = 0; t < 16; ++t) { const float d = acc[t][r] - mean; q += d * d; }
        q += __shfl_xor(q, 1); q += __shfl_xor(q, 2); q += __shfl_xor(q, 4); q += __shfl_xor(q, 8);
        const float rstd = rsqrtf(q * (1.0f / 256.0f) + LN_EPS);
#pragma unroll
        for (int t = 0; t < 16; ++t) RA[(16 * w + 4 * kq + r) * RLD + 16 * t + fr] = f2bf((acc[t][r] - mean) * rstd);
    }
    __syncthreads();
#pragma unroll
    for (int q = 0; q < 8; ++q) { const int idx = tid + NTHR * q, rr = idx >> 5, c = idx & 31; const size_t row = (size_t)(128 * u + rr);
        const u32x4 o = *(const LAS u32x4*)(RA + rr * RLD + 8 * c), g = *(const u32x4*)(QKV + row * EV_IN + 3072 + 256 * h + 8 * c);
        u32x4 w4;
        w4.x = cvt_pk_bf16(bflo(o.x) * siluf_(bflo(g.x)), bfhi(o.x) * siluf_(bfhi(g.x))); w4.y = cvt_pk_bf16(bflo(o.y) * siluf_(bflo(g.y)), bfhi(o.y) * siluf_(bfhi(g.y)));
        w4.z = cvt_pk_bf16(bflo(o.z) * siluf_(bflo(g.z)), bfhi(o.z) * siluf_(bfhi(g.z))); w4.w = cvt_pk_bf16(bflo(o.w) * siluf_(bflo(g.w)), bfhi(o.w) * siluf_(bfhi(g.w)));
        *(u32x4*)(MIX + row * DM + 256 * h + 8 * c) = w4; }
    __syncthreads();
}

constexpr int KLD = 1032;
__device__ __forceinline__ void s5_output_task(const Params& p, Ctx& C, int bt) {
    const bf16_t* QKV = (const bf16_t*)(p.ws + WS_BIG + BG_QKV); bf16_t* Z = (bf16_t*)(p.ws + WS_Z);
    const bf16_t* KN = (const bf16_t*)(p.ws + WS_KN); const bf16_t* CCt = (const bf16_t*)(p.ws + WS_CC);
    const float* APOW = (const float*)(p.ws + WS_APOW); const float* HST = (const float*)(p.ws + WS_HST); const float* dsk = p.inp(18);
    int tid = C.tid; asm volatile("" : "+v"(tid));
    const int lane = tid & 63, kq = lane >> 4, fr = lane & 15;
    LAS bf16_t* KF = (LAS bf16_t*)C.lds; LAS bf16_t* KB = KF + 16 * KLD;
    LAS bf16_t* U = KB + 16 * KLD + C.wave * 3072;
    LAS float* PW0 = (LAS float*)(KB + 16 * KLD + 8 * 3072);
    LAS float* PW16 = PW0 + 2 * 16 * 128;
    {
        const int g = bt >> 3, k0 = (260 * (bt & 7)) >> 3, k1 = (260 * ((bt & 7) + 1)) >> 3;
#pragma unroll
        for (int q = 0; q < 8; ++q) { const int idx = tid + NTHR * q, dir = idx >> 11, rr = (idx >> 7) & 15, c = idx & 127;
            *(LAS u32x4*)((dir ? KB : KF) + rr * KLD + 8 * c) = *(const u32x4*)(KN + ((size_t)(dir * 64 + g) * 16 + rr) * 1024 + 8 * c); }
        for (int q = lane; q < 192 * 2; q += 64) *(LAS u32x4*)(U + 8 * q) = (u32x4){0u, 0u, 0u, 0u};
#pragma unroll
        for (int q = 0; q < 2; ++q) { const int idx = tid + NTHR * q, dir = idx >> 9, f = (idx >> 5) & 15, c4 = idx & 31;
            *(LAS f32x4*)(PW0 + dir * 2048 + f * 128 + 4 * c4) = *(const f32x4*)(APOW + ((size_t)(dir * 64 + g) * 64 + (dir == 0 ? f : 15 - f)) * 128 + 4 * c4); }
        if (tid < 64) { const int dir = tid >> 5, c4 = tid & 31; *(LAS f32x4*)(PW16 + dir * 128 + 4 * c4) = *(const f32x4*)(APOW + ((size_t)(dir * 64 + g) * 64 + 15) * 128 + 4 * c4); }
        __syncthreads();
        const f32x4 dv = *(const f32x4*)(dsk + 16 * g + 4 * kq);
        bf16x8 ccr[2], cci[2];
#pragma unroll
        for (int hb = 0; hb < 2; ++hb) { ccr[hb] = frag_rowk_g(CCt + (size_t)g * 16 * 128 + 32 * hb, 128, lane); cci[hb] = frag_rowk_g(CCt + (size_t)g * 16 * 128 + 64 + 32 * hb, 128, lane); }
        const LAS float* pw0l = PW0 + (size_t)fr * 128 + 16 * kq;
        const LAS float* pw16l = PW16 + 16 * kq;
        for (int k = k0 + C.wave; k < k1; k += 8) {
            LDS_WAIT(); asm volatile("" ::: "memory");
            for (int q = lane; q < 128; q += 64) { const int t = q >> 1, hf = q & 1;
                *(LAS u32x4*)(U + (64 + t) * 16 + 8 * hf) = *(const u32x4*)(QKV + (size_t)(64 * k + t) * EV_IN + 4096 + 16 * g + 8 * hf); }
            LDS_WAIT(); asm volatile("" ::: "memory");
            const int cf = k, cb = k < 4 ? 3 - k : 263 - k;
            f32x4 acc[4];
#pragma unroll
            for (int tt = 0; tt < 4; ++tt) acc[tt] = (f32x4){0.f, 0.f, 0.f, 0.f};
            const LAS bf16_t* ubf = U + (64 + fr - (kq >> 1)) * 16 + 8 * (kq & 1);
            const LAS bf16_t* ubb = U + (64 + fr + (kq >> 1)) * 16 + 8 * (kq & 1);
#pragma unroll
            for (int n0 = 0; n0 < 64; n0 += 2) {
                const bf16x8 af = frag_rowk_l(KF + n0 * 16, KLD, lane), ab = frag_rowk_l(KB + n0 * 16, KLD, lane);
#pragma unroll
                for (int tt = 0; tt < 4; ++tt) {
                    if (n0 <= 16 * tt + 14) acc[tt] = MFMA16(af, *(const LAS bf16x8*)(ubf + (16 * tt - n0) * 16), acc[tt]);
                    if (n0 <= 62 - 16 * tt) acc[tt] = MFMA16(ab, *(const LAS bf16x8*)(ubb + (16 * tt + n0) * 16), acc[tt]);
                }
                asm volatile("" ::: "memory");
            }
#pragma unroll
            for (int dir = 0; dir < 2; ++dir) {
                const float* hp = HST + ((size_t)(dir * 64 + g) * 260 + (dir == 0 ? cf : cb)) * 128;
#pragma unroll
                for (int hb = 0; hb < 2; ++hb) {
                    float xr[8], xi[8];
#pragma unroll
                    for (int e2 = 0; e2 < 4; ++e2) { const f32x4 h4 = *(const f32x4*)(hp + 2 * (32 * hb + 8 * kq) + 4 * e2), b4 = *(const LAS f32x4*)(pw0l + dir * 2048 + hb * 64 + 4 * e2);
                        xr[2 * e2] = b4[0] * h4[0] - b4[1] * h4[1]; xi[2 * e2] = b4[0] * h4[1] + b4[1] * h4[0];
                        xr[2 * e2 + 1] = b4[2] * h4[2] - b4[3] * h4[3]; xi[2 * e2 + 1] = b4[2] * h4[3] + b4[3] * h4[2]; }
#pragma unroll
                    for (int st = 0; st < 4; ++st) {
                        const int tt = dir == 0 ? st : 3 - st;
                        u32x4 br, bi;
                        br.x = cvt_pk_bf16(xr[0], xr[1]); br.y = cvt_pk_bf16(xr[2], xr[3]); br.z = cvt_pk_bf16(xr[4], xr[5]); br.w = cvt_pk_bf16(xr[6], xr[7]);
                        bi.x = cvt_pk_bf16(xi[0], xi[1]); bi.y = cvt_pk_bf16(xi[2], xi[3]); bi.z = cvt_pk_bf16(xi[4], xi[5]); bi.w = cvt_pk_bf16(xi[6], xi[7]);
                        acc[tt] = MFMA16(ccr[hb], __builtin_bit_cast(bf16x8, br), acc[tt]);
                        acc[tt] = MFMA16(cci[hb], __builtin_bit_cast(bf16x8, bi), acc[tt]);
                        if (st < 3) {
#pragma unroll
                            for (int e2 = 0; e2 < 4; ++e2) { const f32x4 a4 = *(const LAS f32x4*)(pw16l + dir * 128 + hb * 64 + 4 * e2);
                                float t0 = xr[2 * e2] * a4[0] - xi[2 * e2] * a4[1]; xi[2 * e2] = xr[2 * e2] * a4[1] + xi[2 * e2] * a4[0]; xr[2 * e2] = t0;
                                t0 = xr[2 * e2 + 1] * a4[2] - xi[2 * e2 + 1] * a4[3]; xi[2 * e2 + 1] = xr[2 * e2 + 1] * a4[3] + xi[2 * e2 + 1] * a4[2]; xr[2 * e2 + 1] = t0; }
                        }
                    }
                }
            }
#pragma unroll
            for (int tt = 0; tt < 4; ++tt) { const int t = 16 * tt + fr;
                const u32x2 uu = *(const LAS u32x2*)(U + (64 + t) * 16 + 4 * kq);
                const float y0 = acc[tt][0] + bflo(uu.x) * dv[0], y1 = acc[tt][1] + bfhi(uu.x) * dv[1], y2 = acc[tt][2] + bflo(uu.y) * dv[2], y3 = acc[tt][3] + bfhi(uu.y) * dv[3];
                u32x2 w; w.x = cvt_pk_bf16(gelu_tanh(y0), gelu_tanh(y1)); w.y = cvt_pk_bf16(gelu_tanh(y2), gelu_tanh(y3));
                *(u32x2*)(Z + (size_t)(64 * k + t) * 1024 + 16 * g + 4 * kq) = w; }
        }
    }
    __syncthreads();
}

__device__ __forceinline__ void phase_ret_s5_outputs(const Params& p, Ctx& C, LAS unsigned char* misc) {
    unsigned* head = (unsigned*)(p.ws + WS_CTL) + CW_QUEUE;
    volatile LAS int* slot = (volatile LAS int*)(misc + 32);
    for (;;) {
        __syncthreads();
        if (C.tid == 0) slot[0] = (int)atomicAdd(head, 1u);
        __syncthreads();
        const int item = __builtin_amdgcn_readfirstlane(slot[0]);
        if (item >= 520) break;
        ret_output_unit(p, C, item);
    }
    for (;;) {
        __syncthreads();
        if (C.tid == 0) slot[0] = (int)atomicAdd(head + 64, 1u);
        __syncthreads();
        const int item = __builtin_amdgcn_readfirstlane(slot[0]);
        if (item >= 512) break;
        s5_output_task(p, C, item);
    }
}
__device__ __forceinline__ void phase_router(const Params& p, Ctx& C, int L) {
    const float* X1 = (const float*)(p.ws + WS_X1);
    const bf16_t* RWh = (const bf16_t*)(p.ws + WS_RWT) + (size_t)(L * 2 + 0) * 64 * DM; const bf16_t* RWl = (const bf16_t*)(p.ws + WS_RWT) + (size_t)(L * 2 + 1) * 64 * DM;
    const float* rbias = p.inp(27) + L * 64;
    int* cnt = (int*)(p.ws + WS_CTL) + CW_CNT + L * 128; int* LIST = (int*)(p.ws + WS_LIST); unsigned* PK = (unsigned*)(p.ws + WS_WGT); float* LW = (float*)(p.ws + WS_LW);
    const int lane = C.lane, kq = lane >> 4, fr = lane & 15;
    LAS float* Lg = (LAS float*)(C.lds + C.wave * 8192);
    const int r0 = (L == 0) ? 0 : CTXL, nrows = TT - r0;
    if (C.bid == 0 && C.tid == 0) cnt[64] = nrows;
    for (int task = C.gw; task < nrows / 16; task += C.ngw) {
        const int rbase = r0 + 16 * task, row = rbase + fr;
        const int v = row < CTXL ? 1 : 0;
        const float* xr = X1 + (size_t)row * DM; const float* sc2 = modv(p, L, v, 4); const float* sh2 = modv(p, L, v, 3);
        f32x4 acc[4];
#pragma unroll
        for (int t = 0; t < 4; ++t) acc[t] = (f32x4){0.f, 0.f, 0.f, 0.f};
#pragma unroll 2
        for (int ks = 0; ks < 64; ++ks) { const int c0 = 32 * ks + 8 * kq;
            const f32x4 x0 = *(const f32x4*)(xr + c0), x1 = *(const f32x4*)(xr + c0 + 4);
            const f32x4 a0 = *(const f32x4*)(sc2 + c0), a1 = *(const f32x4*)(sc2 + c0 + 4), b0 = *(const f32x4*)(sh2 + c0), b1 = *(const f32x4*)(sh2 + c0 + 4);
            const f32x4 y0 = x0 * (a0 + 1.0f) + b0, y1 = x1 * (a1 + 1.0f) + b1;
            u32x4 hi; hi.x = cvt_pk_bf16(y0[0], y0[1]); hi.y = cvt_pk_bf16(y0[2], y0[3]); hi.z = cvt_pk_bf16(y1[0], y1[1]); hi.w = cvt_pk_bf16(y1[2], y1[3]);
            u32x4 lo; lo.x = cvt_pk_bf16(y0[0] - bflo(hi.x), y0[1] - bfhi(hi.x)); lo.y = cvt_pk_bf16(y0[2] - bflo(hi.y), y0[3] - bfhi(hi.y));
            lo.z = cvt_pk_bf16(y1[0] - bflo(hi.z), y1[1] - bfhi(hi.z)); lo.w = cvt_pk_bf16(y1[2] - bflo(hi.w), y1[3] - bfhi(hi.w));
            const bf16x8 ah = __builtin_bit_cast(bf16x8, hi), al = __builtin_bit_cast(bf16x8, lo);
#pragma unroll
            for (int t = 0; t < 4; ++t) { const bf16x8 bh = frag_rowk_g(RWh + (size_t)(16 * t) * DM + 32 * ks, DM, lane), bl = frag_rowk_g(RWl + (size_t)(16 * t) * DM + 32 * ks, DM, lane);
                acc[t] = MFMA16(ah, bh, acc[t]); acc[t] = MFMA16(al, bh, acc[t]); acc[t] = MFMA16(ah, bl, acc[t]); } }
        LDS_WAIT(); asm volatile("" ::: "memory");
#pragma unroll
        for (int t = 0; t < 4; ++t)
#pragma unroll
            for (int r = 0; r < 4; ++r) Lg[(4 * kq + r) * 65 + 16 * t + fr] = acc[t][r];
        LDS_WAIT(); asm volatile("" ::: "memory");
        if (lane < 16) {
            LAS float* sr = Lg + lane * 65; const int trow = rbase + lane;
            float gs[8];
#pragma unroll
            for (int g = 0; g < 8; ++g) { float m1 = -1e30f, m2 = -1e30f;
                for (int j = 0; j < 8; ++j) { const int e = 8 * g + j; const float s = sigmoidf_(sr[e]); sr[e] = s; const float vv = s + rbias[e];
                    if (vv > m1) { m2 = m1; m1 = vv; } else if (vv > m2) m2 = vv; }
                gs[g] = m1 + m2; }
            unsigned gmask = 0u;
#pragma unroll
            for (int it = 0; it < 4; ++it) { float best = -1e30f; int bi = 0;
#pragma unroll
                for (int g = 0; g < 8; ++g) { const bool ok = !((gmask >> g) & 1u) && gs[g] > best; best = ok ? gs[g] : best; bi = ok ? g : bi; }
                gmask |= 1u << bi; }
            unsigned long long taken = 0ull; int sel[8]; float sw[8]; float wsum = 0.f;
#pragma unroll
            for (int k = 0; k < 8; ++k) { float best = -1e30f; int bi = 0;
                for (int e = 0; e < 64; ++e) { const bool cand = ((gmask >> (e >> 3)) & 1u) && !((taken >> e) & 1ull); const float vv = sr[e] + rbias[e];
                    if (cand && vv > best) { best = vv; bi = e; } }
                taken |= 1ull << bi; sel[k] = bi; sw[k] = sr[bi]; wsum += sw[k]; }
            const float inv = 2.5f / wsum;
#pragma unroll
            for (int k = 0; k < 8; ++k) { const int a = trow * 8 + k; const int pos = atomicAdd(&cnt[sel[k]], 1);
                LIST[(size_t)sel[k] * TT + pos] = a; PK[a] = ((unsigned)sel[k] << 16) | (unsigned)pos; LW[(size_t)sel[k] * TT + pos] = sw[k] * inv; }
            LIST[(size_t)64 * TT + (trow - r0)] = 8 * TT + trow; LW[(size_t)64 * TT + (trow - r0)] = 1.0f;
        }
    }
}
namespace att {
constexpr int D = 128, NW = 8, QBLK = 32, KVBLK = 64;
constexpr float SCALE = 0.088388347648318440f;
constexpr float THR = 8.f;
constexpr int SHM_V = KVBLK * D * 2, SHM_K = KVBLK * D * 2, SHM_ATTN = 2 * SHM_V + 2 * SHM_K + NW * 64 * 4;
#define KSWZ(row, colB) ((row) * 256 + ((colB) ^ (((row) & 7) << 4)))
#define SBAR() __builtin_amdgcn_sched_barrier(0)
__device__ __forceinline__ int crow(int r, int hi) { return (r & 3) + 8 * (r >> 2) + 4 * hi; }
__device__ __forceinline__ unsigned cvtpk(float lo, float hi) { unsigned r; asm volatile("v_cvt_pk_bf16_f32 %0, %1, %2" : "=v"(r) : "v"(lo), "v"(hi)); return r; }

__device__ __forceinline__ void partialSM(f32x16& p0, f32x16& p1, float negMC) {
  constexpr float Cc = SCALE * 1.4426950408889634f;
  for (int r = 0; r < 16; ++r) p0[r] = fmaf(p0[r], Cc, negMC); for (int r = 0; r < 16; ++r) p1[r] = fmaf(p1[r], Cc, negMC);
  for (int r = 0; r < 16; ++r) p0[r] = __builtin_amdgcn_exp2f(p0[r]);
}
__device__ __forceinline__ void finishSM(f32x16& p0, f32x16& p1, float& l_reg, bf16x8& pa0, bf16x8& pa1, bf16x8& pa2, bf16x8& pa3) {
  for (int r = 0; r < 16; ++r) p1[r] = __builtin_amdgcn_exp2f(p1[r]);
  float ps = 0; for (int r = 0; r < 16; ++r) ps += p0[r]; for (int r = 0; r < 16; ++r) ps += p1[r];
  { auto rr = __builtin_amdgcn_permlane32_swap(__float_as_uint(ps), __float_as_uint(ps), false, false);
    ps = __uint_as_float(rr[0]) + __uint_as_float(rr[1]); }
  l_reg += ps;
#define PK4(P, BASE, OUT) do { unsigned a0 = cvtpk(P[BASE + 0], P[BASE + 1]), a1 = cvtpk(P[BASE + 2], P[BASE + 3]);   \
    unsigned b0 = cvtpk(P[BASE + 4], P[BASE + 5]), b1 = cvtpk(P[BASE + 6], P[BASE + 7]);                              \
    auto r0 = __builtin_amdgcn_permlane32_swap(a0, b0, false, false); auto r1 = __builtin_amdgcn_permlane32_swap(a1, b1, false, false); \
    u32x4 w = {r0[0], r1[0], r0[1], r1[1]}; OUT = *reinterpret_cast<bf16x8*>(&w); } while (0)
  PK4(p0, 0, pa0); PK4(p0, 8, pa1); PK4(p1, 0, pa2); PK4(p1, 8, pa3);
#undef PK4
}
__device__ __forceinline__ void qkt(f32x16& p0, f32x16& p1, const LAS char* Ks, const bf16x8* qr, int r32, int hi) {
  p0 = f32x16{}; p1 = f32x16{};
  for (int d0 = 0; d0 < 8; ++d0) { int cb = (d0 * 16 + hi * 8) * 2;
    bf16x8 b0 = *reinterpret_cast<const LAS bf16x8*>(Ks + KSWZ(r32, cb));
    bf16x8 b1 = *reinterpret_cast<const LAS bf16x8*>(Ks + KSWZ(32 + r32, cb));
    p0 = __builtin_amdgcn_mfma_f32_32x32x16_bf16(b0, qr[d0], p0, 0, 0, 0);
    p1 = __builtin_amdgcn_mfma_f32_32x32x16_bf16(b1, qr[d0], p1, 0, 0, 0); }
}
__device__ __forceinline__ int v_st(int k, int c) { const int kk = (k & ~0xC) | ((k & 4) << 1) | ((k & 8) >> 1); return ((kk >> 3) * 4 + (c >> 5)) * 512 + ((kk & 7) * 32 + (c & 31)) * 2; }
__device__ __forceinline__ int v_rd_base(int lane) { return ((lane & 3) << 3) | (((lane >> 2) & 3) << 6) | (((lane >> 4) & 1) << 5) | (((lane >> 5) & 1) << 8); }
constexpr int v_rd_off(int d0, int ks, int half) { return d0 * 512 + ks * 4096 + half * 2048; }
template <int OFF> __device__ __forceinline__ s16x4 tr_read(int vb) {
  s16x4 r; asm volatile("ds_read_b64_tr_b16 %0, %1 offset:%2" : "=&v"(r) : "v"(vb), "i"(OFF) : "memory"); return r;
}
template <int D0> __device__ __forceinline__ void pv_one(f32x16& od, int vb, bf16x8 pa0, bf16x8 pa1, bf16x8 pa2, bf16x8 pa3) {
  const s16x4 l0 = tr_read<v_rd_off(D0, 0, 0)>(vb), h0 = tr_read<v_rd_off(D0, 0, 1)>(vb), l1 = tr_read<v_rd_off(D0, 1, 0)>(vb), h1 = tr_read<v_rd_off(D0, 1, 1)>(vb);
  const s16x4 l2 = tr_read<v_rd_off(D0, 2, 0)>(vb), h2 = tr_read<v_rd_off(D0, 2, 1)>(vb), l3 = tr_read<v_rd_off(D0, 3, 0)>(vb), h3 = tr_read<v_rd_off(D0, 3, 1)>(vb);
  asm volatile("s_waitcnt lgkmcnt(0)" ::: "memory"); SBAR();
#define PK(L, H) (bf16x8){L[0], L[1], L[2], L[3], H[0], H[1], H[2], H[3]}
  od = __builtin_amdgcn_mfma_f32_32x32x16_bf16(pa0, PK(l0, h0), od, 0, 0, 0);
  od = __builtin_amdgcn_mfma_f32_32x32x16_bf16(pa1, PK(l1, h1), od, 0, 0, 0);
  od = __builtin_amdgcn_mfma_f32_32x32x16_bf16(pa2, PK(l2, h2), od, 0, 0, 0);
  od = __builtin_amdgcn_mfma_f32_32x32x16_bf16(pa3, PK(l3, h3), od, 0, 0, 0);
#undef PK
}
__device__ __forceinline__ void pv_d0(f32x16* o, int vb, bf16x8 pa0, bf16x8 pa1, bf16x8 pa2, bf16x8 pa3) {
  pv_one<0>(o[0], vb, pa0, pa1, pa2, pa3); pv_one<1>(o[1], vb, pa0, pa1, pa2, pa3); pv_one<2>(o[2], vb, pa0, pa1, pa2, pa3); pv_one<3>(o[3], vb, pa0, pa1, pa2, pa3);
}

template <int LDQ, int LDK, int LDO>
__device__ __forceinline__ void attn_dense_body(const bf16_t* __restrict__ Qb, const bf16_t* __restrict__ Kh, const bf16_t* __restrict__ Vh, bf16_t* __restrict__ Ob, int seq, LAS char* lds, int tid, float kmax2) {
  const int wid = tid >> 6, lane = tid & 63, r32 = lane & 31, hi = lane >> 5;
  LAS char* V_lds = lds; LAS char* K_lds = lds + 2 * SHM_V;
  LAS float* ws = (LAS float*)(lds + 2 * SHM_V + 2 * SHM_K) + wid * 64; LAS float* li_l = ws;
  float l_reg = 0; f32x16 o[4] = {}; bf16x8 qr[8];
  const bf16_t* Qw = Qb + (long)(wid * QBLK + r32) * LDQ + hi * 8;
#pragma unroll
  for (int d0 = 0; d0 < 8; ++d0) qr[d0] = *reinterpret_cast<const bf16x8*>(Qw + d0 * 16);
  float negMC;
  { float q2 = 0.f;
#pragma unroll
    for (int d0 = 0; d0 < 8; ++d0) { const u32x4 w = __builtin_bit_cast(u32x4, qr[d0]);
      q2 += bflo(w.x) * bflo(w.x) + bfhi(w.x) * bfhi(w.x) + bflo(w.y) * bflo(w.y) + bfhi(w.y) * bfhi(w.y) + bflo(w.z) * bflo(w.z) + bfhi(w.z) * bfhi(w.z) + bflo(w.w) * bflo(w.w) + bfhi(w.w) * bfhi(w.w); }
    auto rr = __builtin_amdgcn_permlane32_swap(__float_as_uint(q2), __float_as_uint(q2), false, false);
    q2 = __uint_as_float(rr[0]) + __uint_as_float(rr[1]);
    negMC = -(sqrtf(q2 * kmax2) * (SCALE * 1.0001f) - 30.0f) * 1.4426950408889634f; }
  const int sr = tid >> 4, sc = (tid & 15) * 8, vst0 = v_st(sr, sc), vst1 = v_st(32 + sr, sc);
  const int vb0 = (int)(uintptr_t)V_lds + v_rd_base(lane);
  struct { bf16x8 vs0, vs1, ks0, ks1; } sr_[2];
#define SLOAD(i, k0) do { sr_[i].vs0 = *reinterpret_cast<const bf16x8*>(&Vh[(long)((k0) + sr) * LDK + sc]); sr_[i].vs1 = *reinterpret_cast<const bf16x8*>(&Vh[(long)((k0) + 32 + sr) * LDK + sc]); \
    sr_[i].ks0 = *reinterpret_cast<const bf16x8*>(&Kh[(long)((k0) + sr) * LDK + sc]); sr_[i].ks1 = *reinterpret_cast<const bf16x8*>(&Kh[(long)((k0) + 32 + sr) * LDK + sc]); } while (0)
#define SWRITE(b, i) do { *(LAS bf16x8*)(V_lds + (b) * SHM_V + vst0) = sr_[i].vs0;          \
    *(LAS bf16x8*)(V_lds + (b) * SHM_V + vst1) = sr_[i].vs1; int kc = sc * 2;               \
    *(LAS bf16x8*)(K_lds + (b) * SHM_K + KSWZ(sr, kc)) = sr_[i].ks0;                       \
    *(LAS bf16x8*)(K_lds + (b) * SHM_K + KSWZ(32 + sr, kc)) = sr_[i].ks1; } while (0)
#define SWAIT() asm volatile("s_waitcnt vmcnt(4)" ::: "memory")
  f32x16 pA0, pA1, pB0, pB1; bf16x8 pa0, pa1, pa2, pa3; const int NT = seq / KVBLK;
  constexpr int SE = 0, SO = 1;
  SLOAD(SE, 0); asm volatile("s_waitcnt vmcnt(0)" ::: "memory"); SWRITE(0, SE); __syncthreads();
  qkt(pA0, pA1, K_lds, qr, r32, hi); partialSM(pA0, pA1, negMC);
  SLOAD(SO, KVBLK); if (2 < NT) SLOAD(SE, 2 * KVBLK);
  SWAIT(); SWRITE(1, SO); __syncthreads();
  for (int j = 1; j + 1 < NT; j += 2) {
    SBAR(); qkt(pB0, pB1, K_lds + SHM_K, qr, r32, hi);
    finishSM(pA0, pA1, l_reg, pa0, pa1, pa2, pa3); SBAR();
    SLOAD(SO, (j + 2) * KVBLK); SBAR();
    pv_d0(o, vb0, pa0, pa1, pa2, pa3); partialSM(pB0, pB1, negMC);
    __syncthreads(); SWAIT(); SWRITE(0, SE);
    __syncthreads();
    SBAR(); qkt(pA0, pA1, K_lds, qr, r32, hi);
    finishSM(pB0, pB1, l_reg, pa0, pa1, pa2, pa3); SBAR();
    if (j + 3 < NT) SLOAD(SE, (j + 3) * KVBLK); SBAR();
    pv_d0(o, vb0 + (int)SHM_V, pa0, pa1, pa2, pa3); partialSM(pA0, pA1, negMC);
    __syncthreads(); SWAIT(); SWRITE(1, SO);
    __syncthreads();
  }
  SBAR(); qkt(pB0, pB1, K_lds + SHM_K, qr, r32, hi);
  finishSM(pA0, pA1, l_reg, pa0, pa1, pa2, pa3); SBAR();
  pv_d0(o, vb0, pa0, pa1, pa2, pa3); partialSM(pB0, pB1, negMC);
  __syncthreads();
  finishSM(pB0, pB1, l_reg, pa0, pa1, pa2, pa3); SBAR();
  pv_d0(o, vb0 + (int)SHM_V, pa0, pa1, pa2, pa3);
  if (hi == 0) li_l[r32] = l_reg; asm volatile("s_waitcnt lgkmcnt(0)" ::: "memory");
  float rli[16];
#pragma unroll
  for (int r = 0; r < 16; ++r) rli[r] = __builtin_amdgcn_rcpf(li_l[crow(r, hi)]);
  bf16_t* Ow = Ob + (long)(wid * QBLK) * LDO;
#pragma unroll
  for (int r = 0; r < 16; ++r) { int orow = crow(r, hi);
    for (int d0 = 0; d0 < 4; ++d0) Ow[(long)orow * LDO + d0 * 32 + r32] = (bf16_t)(cvtpk(o[d0][r] * rli[r], 0.f) & 0xffffu); }
#undef SLOAD
#undef SWRITE
#undef SWAIT
}

typedef int v8i32a __attribute__((ext_vector_type(8)));
typedef int v4i32a __attribute__((ext_vector_type(4)));
#define KSW8(row, chunk) ((row) * 128 + ((((chunk) ^ (((row) >> 1) & 7))) << 4))
#define VSW8(d, chunk) ((d) * 64 + ((((chunk) ^ (((d) >> 2) & 3))) << 4))
#define MFMA8(a, b, c) __builtin_amdgcn_mfma_scale_f32_32x32x64_f8f6f4((a), (b), (c), 0, 0, 0, 0, 0, 0)
__device__ __forceinline__ v8i32a ld32_l(const LAS char* p0, const LAS char* p1) { return __builtin_shufflevector(*(const LAS v4i32a*)p0, *(const LAS v4i32a*)p1, 0, 1, 2, 3, 4, 5, 6, 7); }
__device__ __forceinline__ unsigned pk4f8(float a, float b, float c, float d) { unsigned w = (unsigned)__builtin_amdgcn_cvt_pk_fp8_f32(a, b, 0, false); return (unsigned)__builtin_amdgcn_cvt_pk_fp8_f32(c, d, (int)w, true); }
template <int LDO, int KSTR>
__device__ __forceinline__ void attn_dense8_body(const unsigned char* __restrict__ Q8b, const unsigned char* __restrict__ K8h, const unsigned char* __restrict__ VT8h, bf16_t* __restrict__ Ob, int seq, LAS char* lds, int tid, float kmax2) {
  const int wid = tid >> 6, lane = tid & 63, r32 = lane & 31, hi = lane >> 5;
  constexpr int RS = 6, PD = 4;
  LAS float* al_l = (LAS float*)(lds + RS * 16384) + wid * 32;
  f32x16 o[4] = {}; v8i32a qf[2];
  { const unsigned char* qp = Q8b + (size_t)(wid * QBLK + r32) * 1024 + 32 * hi;
    qf[0] = __builtin_shufflevector(*(const v4i32a*)qp, *(const v4i32a*)(qp + 16), 0, 1, 2, 3, 4, 5, 6, 7);
    qf[1] = __builtin_shufflevector(*(const v4i32a*)(qp + 64), *(const v4i32a*)(qp + 80), 0, 1, 2, 3, 4, 5, 6, 7); }
  (void)kmax2;
  constexpr float THR8 = 1.4426950408889634f;
  float m_reg = 0.f; f32x16 osum = {}; v8i32a ones = {0x38383838, 0x38383838, 0x38383838, 0x38383838, 0x38383838, 0x38383838, 0x38383838, 0x38383838}; asm volatile("" : "+v"(ones));
#define PSM8(P0, P1, DL, CN, FIRST) do { float pmax = P0[0]; for (int r = 1; r < 16; ++r) pmax = fmaxf(pmax, P0[r]); for (int r = 0; r < 16; ++r) pmax = fmaxf(pmax, P1[r]); \
      { auto rr = __builtin_amdgcn_permlane32_swap(__float_as_uint(pmax), __float_as_uint(pmax), false, false); pmax = fmaxf(__uint_as_float(rr[0]), __uint_as_float(rr[1])); } \
      const float mn = (FIRST) ? pmax : ((pmax - m_reg > THR8) ? pmax : m_reg); DL = (FIRST) ? 0.f : mn - m_reg; m_reg = mn; CN = 7.0f - mn; \
      for (int r = 0; r < 16; ++r) P0[r] = __builtin_amdgcn_exp2f(P0[r] + CN); } while (0)
#define RESC8(DL) do { if (__any((DL) > 0.f)) { if (hi == 0) al_l[r32] = __builtin_amdgcn_exp2f(-(DL)); asm volatile("s_waitcnt lgkmcnt(0)" ::: "memory"); \
      for (int d = 0; d < 4; ++d) for (int r = 0; r < 16; ++r) o[d][r] *= al_l[crow(r, hi)]; for (int r = 0; r < 16; ++r) osum[r] *= al_l[crow(r, hi)]; } } while (0)
  const unsigned kgo = (unsigned)((tid >> 3) * KSTR + 16 * ((tid & 7) ^ ((tid >> 4) & 7))), vgo = (unsigned)((tid >> 2) * 64 + 16 * ((tid & 3) ^ ((tid >> 4) & 3)));
  const unsigned ldw = (unsigned)wid * 1024u;
#define DMA8(slot, T_) do { __builtin_amdgcn_global_load_lds((const unsigned*)(K8h + (size_t)(T_) * (64 * KSTR) + kgo), (LAS unsigned*)(lds + (slot) * 16384 + ldw), 16, 0, 0); \
      __builtin_amdgcn_global_load_lds((const unsigned*)(VT8h + (size_t)(T_) * 8192 + vgo), (LAS unsigned*)(lds + (slot) * 16384 + 8192 + ldw), 16, 0, 0); } while (0)
#define DWAIT8() do { asm volatile("s_waitcnt vmcnt(6)\n\ts_waitcnt lgkmcnt(0)" ::: "memory"); __builtin_amdgcn_s_barrier(); asm volatile("" ::: "memory"); } while (0)
#define QK8(P0, P1, KB) do { P0 = f32x16{}; P1 = f32x16{}; _Pragma("unroll") for (int s = 0; s < 2; ++s) { \
      const v8i32a k0 = ld32_l((KB) + KSW8(r32, 4 * s + 2 * hi), (KB) + KSW8(r32, 4 * s + 2 * hi + 1)); \
      const v8i32a k1 = ld32_l((KB) + KSW8(32 + r32, 4 * s + 2 * hi), (KB) + KSW8(32 + r32, 4 * s + 2 * hi + 1)); \
      P0 = MFMA8(k0, qf[s], P0); P1 = MFMA8(k1, qf[s], P1); } } while (0)
#define FIN8(P0, P1, CN) do { for (int r = 0; r < 16; ++r) P1[r] = __builtin_amdgcn_exp2f(P1[r] + CN); \
      _Pragma("unroll") for (int i = 0; i < 4; ++i) { pa[i] = (int)pk4f8(P0[4 * i], P0[4 * i + 1], P0[4 * i + 2], P0[4 * i + 3]); pa[4 + i] = (int)pk4f8(P1[4 * i], P1[4 * i + 1], P1[4 * i + 2], P1[4 * i + 3]); } } while (0)
#define PV8(VB) do { _Pragma("unroll") for (int d0 = 0; d0 < 4; ++d0) { \
      const v8i32a vf = ld32_l((VB) + VSW8(32 * d0 + r32, 2 * hi), (VB) + VSW8(32 * d0 + r32, 2 * hi + 1)); \
      o[d0] = MFMA8(pa, vf, o[d0]); } osum = MFMA8(pa, ones, osum); } while (0)
#define LDK8(KB, s, half) ld32_l((KB) + KSW8(32 * (half) + r32, 4 * (s) + 2 * hi), (KB) + KSW8(32 * (half) + r32, 4 * (s) + 2 * hi + 1))
#define LDV8(VB, d0) ld32_l((VB) + VSW8(32 * (d0) + r32, 2 * hi), (VB) + VSW8(32 * (d0) + r32, 2 * hi + 1))
#define EXPN(P, r0, n, CN) do { _Pragma("unroll") for (int r = (r0); r < (r0) + (n); ++r) { float e_ = __builtin_amdgcn_exp2f(P[r] + (CN)); asm volatile("" : "+v"(e_)); P[r] = e_; } } while (0)
#define FINP(P0, P1, CN, i) do { EXPN(P1, 4 * (i), 4, CN); \
      { unsigned w_ = (unsigned)__builtin_amdgcn_cvt_pk_fp8_f32(P0[4 * (i)], P0[4 * (i) + 1], pa[i], false); pa[i] = __builtin_amdgcn_cvt_pk_fp8_f32(P0[4 * (i) + 2], P0[4 * (i) + 3], (int)w_, true); } \
      { unsigned w_ = (unsigned)__builtin_amdgcn_cvt_pk_fp8_f32(P1[4 * (i)], P1[4 * (i) + 1], pa[4 + (i)], false); pa[4 + (i)] = __builtin_amdgcn_cvt_pk_fp8_f32(P1[4 * (i) + 2], P1[4 * (i) + 3], (int)w_, true); } } while (0)
#define PINA(x, y) asm volatile("" : "+v"(x), "+v"(y))
#define PIN1(x) asm volatile("" : "+v"(x))
#define PINC(x, y) asm volatile("" :: "v"(x), "v"(y))
#define HSTEP(X0, X1, DLX, CNX, Y0, Y1, CNY, KB, VB, STAGE_LOAD) do { \
      v8i32a ka_ = LDK8(KB, 0, 0), kb_ = LDK8(KB, 0, 1), kc_ = LDK8(KB, 1, 0), kd_ = LDK8(KB, 1, 1); \
      X0 = MFMA8(ka_, qf[0], f32x16{}); PINA(X0, kb_); \
      FINP(Y0, Y1, CNY, 0); PINC(pa[0], pa[4]); PIN1(kb_); \
      X1 = MFMA8(kb_, qf[0], f32x16{}); PINA(X1, kc_); \
      FINP(Y0, Y1, CNY, 1); PINC(pa[1], pa[5]); PIN1(kc_); \
      X0 = MFMA8(kc_, qf[1], X0); PINA(X0, kd_); \
      v8i32a v0_ = LDV8(VB, 0), v1_ = LDV8(VB, 1); \
      FINP(Y0, Y1, CNY, 2); STAGE_LOAD; PINC(pa[2], pa[6]); PIN1(kd_); \
      X1 = MFMA8(kd_, qf[1], X1); PINA(X1, v0_); \
      v8i32a v2_ = LDV8(VB, 2), v3_ = LDV8(VB, 3); \
      FINP(Y0, Y1, CNY, 3); PINC(pa[3], pa[7]); PINA(pa, v0_); \
      o[0] = MFMA8(pa, v0_, o[0]); PINA(o[0], v1_); \
      float pm0_ = X0[0]; _Pragma("unroll") for (int r = 1; r < 16; ++r) pm0_ = fmaxf(pm0_, X0[r]); PINA(pm0_, v1_); \
      o[1] = MFMA8(pa, v1_, o[1]); PINA(o[1], v2_); \
      _Pragma("unroll") for (int r = 0; r < 16; ++r) pm0_ = fmaxf(pm0_, X1[r]); \
      { auto rr = __builtin_amdgcn_permlane32_swap(__float_as_uint(pm0_), __float_as_uint(pm0_), false, false); pm0_ = fmaxf(__uint_as_float(rr[0]), __uint_as_float(rr[1])); } \
      { const float mn = (pm0_ - m_reg > THR8) ? pm0_ : m_reg; DLX = mn - m_reg; m_reg = mn; CNX = 7.0f - mn; } PINA(CNX, v2_); \
      o[2] = MFMA8(pa, v2_, o[2]); PINA(o[2], v3_); \
      EXPN(X0, 0, 5, CNX); PIN1(v3_); \
      o[3] = MFMA8(pa, v3_, o[3]); PINA(o[3], CNX); \
      EXPN(X0, 5, 5, CNX); PIN1(pa); \
      osum = MFMA8(pa, ones, osum); PINA(osum, CNX); \
      EXPN(X0, 10, 6, CNX); } while (0)
  f32x16 pA0, pA1, pB0, pB1; v8i32a pa = {}; float dlA, dlB, cnA, cnB; const int NT = seq / KVBLK;
#define SLOT(s) (lds + (s) * 16384)
#define SADV() do { sv = sk; sk = sk + 1 == RS ? 0 : sk + 1; sd = sd + 1 == RS ? 0 : sd + 1; } while (0)
  int sk = 0, sv = 0, sd = PD;
  DMA8(0, 0); DMA8(1, 1); DMA8(2, 2); DMA8(3, 3);
  DWAIT8();
  QK8(pA0, pA1, SLOT(0)); PSM8(pA0, pA1, dlA, cnA, true);
  DMA8(sd, PD); SADV(); DWAIT8();
  for (int j = 1; j + 1 < NT; j += 2) {
    HSTEP(pB0, pB1, dlB, cnB, pA0, pA1, cnA, SLOT(sk), SLOT(sv) + 8192, DMA8(sd, min(j + PD, NT - 1)));
    RESC8(dlB); SADV(); DWAIT8();
    HSTEP(pA0, pA1, dlA, cnA, pB0, pB1, cnB, SLOT(sk), SLOT(sv) + 8192, DMA8(sd, min(j + 1 + PD, NT - 1)));
    RESC8(dlA); SADV(); DWAIT8();
  }
  HSTEP(pB0, pB1, dlB, cnB, pA0, pA1, cnA, SLOT(sk), SLOT(sv) + 8192, (void)0);
  RESC8(dlB); SADV();
  FIN8(pB0, pB1, cnB); SBAR();
  PV8(SLOT(sv) + 8192);
  asm volatile("s_waitcnt vmcnt(0)" ::: "memory");
  float rli[16];
#pragma unroll
  for (int r = 0; r < 16; ++r) rli[r] = __builtin_amdgcn_rcpf(osum[r]);
  bf16_t* Ow = Ob + (long)(wid * QBLK) * LDO;
#pragma unroll
  for (int r = 0; r < 16; ++r) { int orow = crow(r, hi);
    for (int d0 = 0; d0 < 4; ++d0) Ow[(long)orow * LDO + d0 * 32 + r32] = (bf16_t)(cvtpk(o[d0][r] * rli[r], 0.f) & 0xffffu); }
#undef PSM8
#undef RESC8
#undef DMA8
#undef DWAIT8
#undef SLOT
#undef SADV
#undef QK8
#undef FIN8
#undef PV8
#undef HSTEP
#undef PINA
#undef PIN1
#undef PINC
#undef FINP
#undef EXPN
#undef LDK8
#undef LDV8
}

template <int LDO, int KSTR>
__device__ __forceinline__ void attn_dense8w_body(const unsigned char* __restrict__ Q8b, const unsigned char* __restrict__ K8h, const unsigned char* __restrict__ VT8h0, const unsigned char* __restrict__ VT8h1, bf16_t* __restrict__ Ob, int seq, LAS char* lds, int tid, float kmax2) {
  const int wid = tid >> 6, lane = tid & 63, r32 = lane & 31, hi = lane >> 5;
  constexpr int RS = 4, PD = 2, SB = 24576;
  LAS float* al_l = (LAS float*)(lds + RS * SB) + wid * 32;
  LAS char* q_l = lds + RS * SB + 2048 + wid * 4096 + lane * 16;
  { const unsigned char* qp = Q8b + (size_t)(wid * QBLK + r32) * 1024 + 32 * hi;
    *(LAS v4i32a*)(q_l) = *(const v4i32a*)qp; *(LAS v4i32a*)(q_l + 1024) = *(const v4i32a*)(qp + 16);
    *(LAS v4i32a*)(q_l + 2048) = *(const v4i32a*)(qp + 64); *(LAS v4i32a*)(q_l + 3072) = *(const v4i32a*)(qp + 80); }
  (void)kmax2;
  constexpr float THR8 = 1.4426950408889634f;
  float l_reg = 0.f, m_reg = 0.f; f32x16 o[8] = {};
  const unsigned kgo = (unsigned)((tid >> 3) * KSTR + 16 * ((tid & 7) ^ ((tid >> 4) & 7))), vgo = (unsigned)((tid >> 2) * 64 + 16 * ((tid & 3) ^ ((tid >> 4) & 3)));
  const unsigned ldw = (unsigned)wid * 1024u;
#define DMA8(slot, T_) do { __builtin_amdgcn_global_load_lds((const unsigned*)(K8h + (size_t)(T_) * (64 * KSTR) + kgo), (LAS unsigned*)(lds + (slot) * SB + ldw), 16, 0, 0); \
      __builtin_amdgcn_global_load_lds((const unsigned*)(VT8h0 + (size_t)(T_) * 8192 + vgo), (LAS unsigned*)(lds + (slot) * SB + 8192 + ldw), 16, 0, 0); \
      __builtin_amdgcn_global_load_lds((const unsigned*)(VT8h1 + (size_t)(T_) * 8192 + vgo), (LAS unsigned*)(lds + (slot) * SB + 16384 + ldw), 16, 0, 0); } while (0)
#define DWAIT8() do { asm volatile("s_waitcnt vmcnt(3)\n\ts_waitcnt lgkmcnt(0)" ::: "memory"); __builtin_amdgcn_s_barrier(); asm volatile("" ::: "memory"); } while (0)
#define SLOT(s) (lds + (s) * SB)
#define SADV() do { sv = sk; sk = sk + 1 == RS ? 0 : sk + 1; sd = sd + 1 == RS ? 0 : sd + 1; } while (0)
#define LDK8(KB, s, half) ld32_l((KB) + KSW8(32 * (half) + r32, 4 * (s) + 2 * hi), (KB) + KSW8(32 * (half) + r32, 4 * (s) + 2 * hi + 1))
#define LDV8(VB, d0) ld32_l((VB) + VSW8(32 * (d0) + r32, 2 * hi), (VB) + VSW8(32 * (d0) + r32, 2 * hi + 1))
#define PIN1(x) asm volatile("" : "+v"(x))
#define EXPR(e0, n) do { _Pragma("unroll") for (int e = (e0); e < (e0) + (n); ++e) { float x_ = e < 16 ? X0[e & 15] : X1[e & 15]; float e_ = __builtin_amdgcn_exp2f(x_ + cn); asm volatile("" : "+v"(e_)); ps += e_; \
      if (e < 16) X0[e & 15] = e_; else X1[e & 15] = e_; } } while (0)
#define PKW(PAC, w) do { if ((w) < 4) { unsigned w_ = (unsigned)__builtin_amdgcn_cvt_pk_fp8_f32(X0[4 * ((w) & 3)], X0[4 * ((w) & 3) + 1], PAC[w], false); PAC[w] = __builtin_amdgcn_cvt_pk_fp8_f32(X0[4 * ((w) & 3) + 2], X0[4 * ((w) & 3) + 3], (int)w_, true); } \
      else { unsigned w_ = (unsigned)__builtin_amdgcn_cvt_pk_fp8_f32(X1[4 * ((w) & 3)], X1[4 * ((w) & 3) + 1], PAC[w], false); PAC[w] = __builtin_amdgcn_cvt_pk_fp8_f32(X1[4 * ((w) & 3) + 2], X1[4 * ((w) & 3) + 3], (int)w_, true); } } while (0)
#define PVM(PAP, g) do { PIN1(vv##g); o[4 * ((g) & 1) + ((g) >> 1)] = MFMA8(PAP, vv##g, o[4 * ((g) & 1) + ((g) >> 1)]); asm volatile("" :: "v"(o[4 * ((g) & 1) + ((g) >> 1)])); } while (0)
#define LDVG(g) ({ int o_ = sv * SB + 8192 + 8192 * ((g) & 1); asm volatile("" : "+s"(o_)); LDV8(lds + o_, (g) >> 1); })
#define WSTEP(PAP, PAC, FIRST, TNEXT) do { \
      { const v8i32a ka_ = LDK8(SLOT(sk), 0, 0), kb_ = LDK8(SLOT(sk), 0, 1), kc_ = LDK8(SLOT(sk), 1, 0), kd_ = LDK8(SLOT(sk), 1, 1); \
        const v8i32a q0_ = ld32_l(q_l, q_l + 1024), q1_ = ld32_l(q_l + 2048, q_l + 3072); \
        X0 = MFMA8(ka_, q0_, f32x16{}); X1 = MFMA8(kb_, q0_, f32x16{}); X0 = MFMA8(kc_, q1_, X0); X1 = MFMA8(kd_, q1_, X1); PIN1(X1); } \
      DMA8(sd, TNEXT); \
      v8i32a vv0 = LDVG(0), vv1 = LDVG(1); \
      PVM(PAP, 0); v8i32a vv2 = LDVG(2); \
      float pm_ = X0[0]; _Pragma("unroll") for (int r = 1; r < 16; ++r) pm_ = fmaxf(pm_, X0[r]); PIN1(pm_); \
      PVM(PAP, 1); v8i32a vv3 = LDVG(3); \
      _Pragma("unroll") for (int r = 0; r < 16; ++r) pm_ = fmaxf(pm_, X1[r]); \
      { auto rr = __builtin_amdgcn_permlane32_swap(__float_as_uint(pm_), __float_as_uint(pm_), false, false); pm_ = fmaxf(__uint_as_float(rr[0]), __uint_as_float(rr[1])); } \
      const float mn_ = (FIRST) ? pm_ : ((pm_ - m_reg > THR8) ? pm_ : m_reg); const float dl_ = (FIRST) ? 0.f : mn_ - m_reg; m_reg = mn_; float cn = 7.0f - mn_; float ps = 0.f; PIN1(cn); \
      PVM(PAP, 2); v8i32a vv4 = LDVG(4); EXPR(0, 6); PKW(PAC, 0); \
      PVM(PAP, 3); v8i32a vv5 = LDVG(5); EXPR(6, 6); PKW(PAC, 1); PKW(PAC, 2); \
      PVM(PAP, 4); v8i32a vv6 = LDVG(6); EXPR(12, 5); PKW(PAC, 3); \
      PVM(PAP, 5); v8i32a vv7 = LDVG(7); EXPR(17, 5); PKW(PAC, 4); \
      PVM(PAP, 6); EXPR(22, 5); PKW(PAC, 5); \
      PVM(PAP, 7); EXPR(27, 5); PKW(PAC, 6); PKW(PAC, 7); \
      { auto rr = __builtin_amdgcn_permlane32_swap(__float_as_uint(ps), __float_as_uint(ps), false, false); ps = __uint_as_float(rr[0]) + __uint_as_float(rr[1]); } \
      if (__any(dl_ > 0.f)) { const float al_ = __builtin_amdgcn_exp2f(-dl_); l_reg *= al_; if (hi == 0) al_l[r32] = al_; asm volatile("s_waitcnt lgkmcnt(0)" ::: "memory"); \
        for (int d = 0; d < 8; ++d) for (int r = 0; r < 16; ++r) o[d][r] *= al_l[crow(r, hi)]; } \
      l_reg += ps; \
      SADV(); DWAIT8(); } while (0)
  f32x16 X0, X1; v8i32a paA = {}, paB = {}; const int NT = seq / KVBLK;
  int sk = 0, sv = 0, sd = PD;
  DMA8(0, 0); DMA8(1, 1);
  DWAIT8();
  for (int j = 0; j < NT; j += 2) {
    WSTEP(paB, paA, j == 0, min(j + PD, NT - 1));
    WSTEP(paA, paB, false, min(j + 1 + PD, NT - 1));
  }
  { v8i32a vv0 = LDVG(0), vv1 = LDVG(1), vv2 = LDVG(2), vv3 = LDVG(3); PVM(paB, 0); PVM(paB, 1); PVM(paB, 2); PVM(paB, 3); }
  { v8i32a vv4 = LDVG(4), vv5 = LDVG(5), vv6 = LDVG(6), vv7 = LDVG(7); PVM(paB, 4); PVM(paB, 5); PVM(paB, 6); PVM(paB, 7); }
  asm volatile("s_waitcnt vmcnt(0)" ::: "memory");
  int te = tid; asm volatile("" : "+v"(te));
  const int wid_e = te >> 6, r32_e = te & 31, hi_e = (te >> 5) & 1;
  LAS float* li_e = (LAS float*)(lds + RS * SB + 1024) + wid_e * 32;
  if (hi_e == 0) li_e[r32_e] = l_reg; asm volatile("s_waitcnt lgkmcnt(0)" ::: "memory");
  float rli[16];
#pragma unroll
  for (int r = 0; r < 16; ++r) rli[r] = __builtin_amdgcn_rcpf(li_e[crow(r, hi_e)]);
  bf16_t* Ow = Ob + (long)(wid_e * QBLK) * LDO;
#pragma unroll
  for (int r = 0; r < 16; ++r) { int orow = crow(r, hi_e);
    for (int d0 = 0; d0 < 8; ++d0) Ow[(long)orow * LDO + d0 * 32 + r32_e] = (bf16_t)(cvtpk(o[d0][r] * rli[r], 0.f) & 0xffffu); }
#undef DMA8
#undef DWAIT8
#undef SLOT
#undef SADV
#undef LDK8
#undef LDV8
#undef PIN1
#undef EXPR
#undef PKW
#undef PVM
#undef LDVG
#undef WSTEP
}

constexpr int PV_BUF = 32768, PK_BUF = 16384, P_LDS_V = 0, P_LDS_K = 2 * PV_BUF, P_LDS_X = P_LDS_K + 2 * PK_BUF, P_LDS_L = P_LDS_X + 8 * 2048, P_LDS_END = P_LDS_L + 1024;
__device__ __forceinline__ void qkt_half(f32x16& p, const LAS char* Ks, const bf16x8* qr, int krow, int hi) {
  p = f32x16{};
  for (int d0 = 0; d0 < 8; ++d0) { int cb = (d0 * 16 + hi * 8) * 2;
    bf16x8 b0 = *reinterpret_cast<const LAS bf16x8*>(Ks + KSWZ(krow, cb));
    p = __builtin_amdgcn_mfma_f32_32x32x16_bf16(b0, qr[d0], p, 0, 0, 0); }
}
__device__ __forceinline__ void smA(f32x16& p, float negMC) {
  constexpr float Cc = SCALE * 1.4426950408889634f;
  for (int r = 0; r < 16; ++r) p[r] = fmaf(p[r], Cc, negMC);
  for (int r = 0; r < 8; ++r) p[r] = __builtin_amdgcn_exp2f(p[r]);
}
__device__ __forceinline__ void smB(f32x16& p, float& l_reg, bf16x8& f0, bf16x8& f1) {
  for (int r = 8; r < 16; ++r) p[r] = __builtin_amdgcn_exp2f(p[r]);
  float ps = 0; for (int r = 0; r < 16; ++r) ps += p[r];
  { auto rr = __builtin_amdgcn_permlane32_swap(__float_as_uint(ps), __float_as_uint(ps), false, false);
    ps = __uint_as_float(rr[0]) + __uint_as_float(rr[1]); }
  l_reg += ps;
#define PK4(P, BASE, OUT) do { unsigned a0 = cvtpk(P[BASE + 0], P[BASE + 1]), a1 = cvtpk(P[BASE + 2], P[BASE + 3]);   \
    unsigned b0 = cvtpk(P[BASE + 4], P[BASE + 5]), b1 = cvtpk(P[BASE + 6], P[BASE + 7]);                              \
    auto r0 = __builtin_amdgcn_permlane32_swap(a0, b0, false, false); auto r1 = __builtin_amdgcn_permlane32_swap(a1, b1, false, false); \
    u32x4 w = {r0[0], r1[0], r0[1], r1[1]}; OUT = *reinterpret_cast<bf16x8*>(&w); } while (0)
  PK4(p, 0, f0); PK4(p, 8, f1);
#undef PK4
}
template <int LDQ, int LDK, int LDO>
__device__ __forceinline__ void attn_pair_body(const bf16_t* __restrict__ Qb, const bf16_t* __restrict__ Kh, const bf16_t* __restrict__ Vh, bf16_t* __restrict__ Ob, int seq, LAS char* lds, int tid, float kmax2) {
  const int wid = __builtin_amdgcn_readfirstlane(tid >> 6), lane = tid & 63, r32 = lane & 31, hi = lane >> 5, g = wid & 3, kb = wid >> 2;
  LAS char* V_lds = lds + P_LDS_V; LAS char* K_lds = lds + P_LDS_K;
  LAS char* xp_own = lds + P_LDS_X + wid * 2048 + lane * 16; LAS char* xp_par = lds + P_LDS_X + (wid ^ 4) * 2048 + lane * 16;
  LAS float* li = (LAS float*)(lds + P_LDS_L);
  float l_reg = 0; f32x16 o[4] = {}; bf16x8 qr[8];
  const bf16_t* Qw = Qb + (long)(g * QBLK + r32) * LDQ + hi * 8;
#pragma unroll
  for (int d0 = 0; d0 < 8; ++d0) qr[d0] = *reinterpret_cast<const bf16x8*>(Qw + d0 * 16);
  float negMC;
  { float q2 = 0.f;
#pragma unroll
    for (int d0 = 0; d0 < 8; ++d0) { const u32x4 w = __builtin_bit_cast(u32x4, qr[d0]);
      q2 += bflo(w.x) * bflo(w.x) + bfhi(w.x) * bfhi(w.x) + bflo(w.y) * bflo(w.y) + bfhi(w.y) * bfhi(w.y) + bflo(w.z) * bflo(w.z) + bfhi(w.z) * bfhi(w.z) + bflo(w.w) * bflo(w.w) + bfhi(w.w) * bfhi(w.w); }
    auto rr = __builtin_amdgcn_permlane32_swap(__float_as_uint(q2), __float_as_uint(q2), false, false);
    q2 = __uint_as_float(rr[0]) + __uint_as_float(rr[1]);
    negMC = -(sqrtf(q2 * kmax2) * (SCALE * 1.0001f) - 30.0f) * 1.4426950408889634f; }
  const int sr = tid >> 4, sc = (tid & 15) * 8, vst0 = v_st(sr, sc), vst1 = v_st(32 + sr, sc);
  const int vrd = (int)(uintptr_t)V_lds + kb * 16384 + v_rd_base(lane);
  const int krow = 32 * kb + r32;
  struct { bf16x8 v00, v01, v10, v11, k0, k1; } st_;
#define PLD16(base, off) (*reinterpret_cast<const bf16x8*>((const char*)(base) + (off)))
#define PLOAD(k0_) do { const unsigned o_ = (unsigned)(((k0_) + sr) * LDK + sc) * 2u; \
    st_.v00 = PLD16(Vh, o_); st_.v01 = PLD16(Vh, o_ + 256u); st_.v10 = PLD16(Vh, o_ + 64u * LDK); st_.v11 = PLD16(Vh, o_ + 64u * LDK + 256u); \
    st_.k0 = PLD16(Kh, o_); st_.k1 = PLD16(Kh, o_ + 64u * LDK); } while (0)
#define PWRITE(kbuf, vbuf) do { LAS char* vb_ = V_lds + (vbuf) * PV_BUF; LAS char* kb_ = K_lds + (kbuf) * PK_BUF; const int kc = sc * 2; \
    *(LAS bf16x8*)(vb_ + vst0) = st_.v00; *(LAS bf16x8*)(vb_ + 16384 + vst0) = st_.v01; *(LAS bf16x8*)(vb_ + vst1) = st_.v10; *(LAS bf16x8*)(vb_ + 16384 + vst1) = st_.v11; \
    *(LAS bf16x8*)(kb_ + KSWZ(sr, kc)) = st_.k0; *(LAS bf16x8*)(kb_ + KSWZ(32 + sr, kc)) = st_.k1; } while (0)
  const int NT = seq / KVBLK;
  f32x16 pS; bf16x8 f0, f1, g0, g1;
  PLOAD(0); asm volatile("s_waitcnt vmcnt(0)" ::: "memory"); PWRITE(0, 0); PLOAD(KVBLK);
  __syncthreads();
  for (int j = 0; j < NT; ++j) {
    SBAR();
    qkt_half(pS, K_lds + (j & 1) * PK_BUF, qr, krow, hi);
    smA(pS, negMC); smB(pS, l_reg, f0, f1); SBAR();
    *(LAS bf16x8*)(xp_own) = f0; *(LAS bf16x8*)(xp_own + 1024) = f1;
    if (j + 1 < NT) PWRITE((j + 1) & 1, (j + 1) & 1);
    if (j + 2 < NT) PLOAD((j + 2) * KVBLK);
    __syncthreads();
    g0 = *(const LAS bf16x8*)(xp_par); g1 = *(const LAS bf16x8*)(xp_par + 1024);
    { const int vb = vrd + (j & 1) * PV_BUF;
      if (kb == 0) pv_d0(o, vb, f0, f1, g0, g1); else pv_d0(o, vb, g0, g1, f0, f1); }
    __syncthreads();
  }
  if (hi == 0) li[wid * 32 + r32] = l_reg;
  __syncthreads();
#pragma unroll
  for (int r = 0; r < 16; ++r) { const int orow = crow(r, hi); const float rl = __builtin_amdgcn_rcpf(li[wid * 32 + orow] + li[(wid ^ 4) * 32 + orow]);
    bf16_t* op = Ob + (long)(g * QBLK + orow) * LDO + 128 * kb + r32;
    for (int d0 = 0; d0 < 4; ++d0) op[d0 * 32] = (bf16_t)(cvtpk(o[d0][r] * rl, 0.f) & 0xffffu); }
#undef PLD16
#undef PLOAD
#undef PWRITE
}
#undef KSWZ
}

__device__ __forceinline__ void phase_attention(const Params& p, Ctx& C) {
    bf16_t* ATT = (bf16_t*)(p.ws + WS_BIG + BG_ATT);
    const unsigned char* Q8 = (const unsigned char*)(p.ws + WS_BIG + BG_Q8); const unsigned char* K8 = (const unsigned char*)(p.ws + WS_BIG + BG_K8); const unsigned char* VT8 = (const unsigned char*)(p.ws + WS_BIG + BG_VT8);
    const unsigned char* Q8D = (const unsigned char*)(p.ws + WS_BIG + BG_Q8D); const unsigned char* K8D = (const unsigned char*)(p.ws + WS_BIG + BG_K8D); const unsigned char* VT8D = (const unsigned char*)(p.ws + WS_BIG + BG_VT8D);
    for (int i = 0;; ++i) {
        int unit;
        if (C.G == 256) { if (i >= 2) break; unit = (C.bid & 7) * 64 + i * 32 + (C.bid >> 3); } else { unit = i * C.G + C.bid; if (unit >= 512) break; }
        const int d = unit >> 6, qb = unit & 63, hh = d >> 1, m = d & 1;
        __syncthreads();
        int tz = C.tid; asm volatile("" : "+v"(tz));
        att::attn_dense8w_body<3072, 1024>(Q8D + (size_t)(CTXL + 256 * qb) * 1024 + 128 * d, K8D + 128 * d, VT8D + (size_t)(2 * hh) * 260 * 8192, VT8D + (size_t)(2 * hh + 1) * 260 * 8192,
                                           ATT + (size_t)(256 * qb) * 3072 + 1024 + 1024 * m + 256 * hh, TT, (LAS char*)C.lds, tz, 0.f);
    }
    for (int i = 0;; ++i) {
        int unit;
        if (C.G == 256) { if (i >= 2) break; unit = (C.bid & 7) * 64 + i * 32 + (C.bid >> 3); } else { unit = i * C.G + C.bid; if (unit >= 512) break; }
        const int prob = unit >> 6, qb = unit & 63;
        __syncthreads();
        int tz = C.tid; asm volatile("" : "+v"(tz));
        att::attn_dense8_body<3072, 256>(Q8 + (size_t)(CTXL + 256 * qb) * 1024 + 128 * prob, K8 + 128 * (prob >> 2), VT8 + (size_t)(prob >> 2) * 260 * 8192,
                                         ATT + (size_t)(256 * qb) * 3072 + 128 * prob, TT, (LAS char*)C.lds, tz, 0.f);
    }
    __syncthreads();
}
constexpr int PH_PER_LAYER = 13, N_PHASES = 2 + 2 * PH_PER_LAYER;
#ifndef DBL_PHASE
#define DBL_PHASE -1
#endif
#ifndef MK_PER_PHASE
#define MK_PER_PHASE 0
#endif

template <int L>
__device__ __forceinline__ void layer_body(const Params& p, Ctx& C0, const XcdBarrier& bar, LAS unsigned char* misc, int lo, int hi) {
#define IN(k) (lo <= (k) && (k) < hi)
#define SEAM(k) do { if (IN(k) && IN((k) + 1)) xcd_barrier(bar, C0.wave); } while (0)
#define PHASE(k, ...) if (IN(k)) { FRESH(); __VA_ARGS__ } if (DBL_PHASE == (k)) { xcd_barrier(bar, C0.wave); { FRESH(); __VA_ARGS__ } } SEAM(k);
#define FRESH() Ctx C = C0; { int ln = (int)__builtin_amdgcn_mbcnt_hi(~0u, __builtin_amdgcn_mbcnt_lo(~0u, 0u)); asm volatile("" : "+v"(ln)); C.lane = ln; C.tid = C.wave * 64 + ln; }
        const int b = 2 + PH_PER_LAYER * L;
        bf16_t* QKV = (bf16_t*)(p.ws + WS_BIG + BG_QKV);
        bf16_t* XA = (bf16_t*)(p.ws + WS_XA);
        int* cnt = (int*)(p.ws + WS_CTL) + CW_CNT + L * 128; const int* LIST = (const int*)(p.ws + WS_LIST);
        PHASE(b + 0, phase_modulate(p, C, L); )
        PHASE(b + 1,
            const int N = L ? OD_IN : EV_IN;
            pg8::DenseOrder S; S.init8((const void*)XA, DM, (const void*)(p.ws + (L ? WS_WIN1 : WS_WIN0)), TT, N, DM, C.G, C.bid);
            pg8::EpiStore E{QKV, N, 1.0f / 32.0f};
            pg8::gemm_phase<true>(C.lds, S, E, C.wave);
            if (L == 0 && IN(b + 2) && S.units_of_me() < S.max_units()) conv_queue(p, C, 2);
        )
        PHASE(b + 2, if (L == 0) phase_rope0(p, C); else phase_normrope1(p, C); )
        PHASE(b + 3, if (L == 0) { ret_chunk_kv(p, C); s5_end_states(p, C); } else phase_attention(p, C); )
        PHASE(b + 4, if (L == 0) phase_scans(p, C); else phase_merge1(p, C); )
        if (L == 0) {
            PHASE(b + 5, phase_ret_s5_outputs(p, C, misc); )
            PHASE(b + 6,
                pg8::DenseOrder S; S.init((const bf16_t*)(p.ws + WS_Z), 1024, (const bf16_t*)(p.ws + WS_WGLU), TT, 1024, 1024, C.G, C.bid);
                pg8::EpiGlu E{(const bf16_t*)(p.ws + WS_Z), p.inp(20), (bf16_t*)(p.ws + WS_BIG + BG_MIX)};
                pg8::gemm_phase<false>(C.lds, S, E, C.wave);
                if (IN(b + 7) && S.units_of_me() < S.max_units()) conv_queue(p, C, 4);
            )
        }
        PHASE(b + 7,
            pg8::DenseOrder S;
            if (L == 0) S.init((const bf16_t*)(p.ws + WS_BIG + BG_MIX), DM, (const bf16_t*)(p.ws + WS_WOUT0), TT, DM, DM, C.G, C.bid);
            else S.init((const bf16_t*)(p.ws + WS_BIG + BG_ATT), 3072, (const bf16_t*)(p.ws + WS_WOUT1), SEQ, DM, DM, C.G, C.bid);
            pg8::EpiStore E{(bf16_t*)(p.ws + WS_YMIX) + (L ? (size_t)CTXL * DM : 0), DM, 1.0f};
            pg8::gemm_phase<false>(C.lds, S, E, C.wave);
            if (L == 0 && IN(b + 8) && S.units_of_me() < S.max_units()) conv_queue(p, C, 5);
        )
        PHASE(b + 8, phase_ln1(p, C, L); )
        PHASE(b + 9, phase_router(p, C, L); )
        PHASE(b + 10,
            pg8::MoeOrder<0> S; S.A = (const void*)XA; S.Bt = (const void*)(p.ws + WS_GU + (size_t)L * NEX1 * 1024 * DM); S.list = LIST; S.cnt = cnt; S.ldab = DM; S.kb = DM; S.nN = 4; S.G = C.G; S.c = C.bid; S.bstride = (size_t)1024 * DM;
            S.prep(misc, C.tid);
            pg8::EpiE1 E{(unsigned char*)(p.ws + WS_HX2), S.cn, S.rb};
            pg8::gemm_phase<true>(C.lds, S, E, C.wave);
        )
        PHASE(b + 11,
            pg8::MoeOrder<1> S; S.A = (const void*)(p.ws + WS_HX2); S.Bt = (const void*)(p.ws + WS_DT + (size_t)L * NEX1 * DM * EHID); S.list = LIST; S.cnt = cnt; S.ldab = EHID; S.kb = EHID; S.nN = 8; S.G = C.G; S.c = C.bid; S.bstride = (size_t)DM * EHID;
            S.prep(misc, C.tid);
            pg8::EpiE2 E{(unsigned char*)(p.ws + WS_BIG + BG_YMOE), (const float*)(p.ws + WS_LW), S.cn, S.rb};
            pg8::gemm_phase<true>(C.lds, S, E, C.wave);
        )
        PHASE(b + 12, phase_combine(p, C, L, misc); )
    #undef IN
#undef SEAM
#undef FRESH
#undef PHASE
}

__global__ void __launch_bounds__(NTHR, 2) mega_fwd(KArgs ka) {
    extern __shared__ __attribute__((aligned(16))) unsigned char lds_raw[];
    Ctx C;
    C.lds = (LAS unsigned char*)lds_raw;
    C.tid = threadIdx.x; C.lane = C.tid & 63; C.wave = __builtin_amdgcn_readfirstlane(C.tid >> 6);
    C.G = gridDim.x; C.bid = blockIdx.x; C.gw = C.bid * NWAVES + C.wave; C.ngw = C.G * NWAVES;
    LAS unsigned char* misc = C.lds + MISC_OFF;
    if (C.tid < 8) ((volatile LAS unsigned*)misc)[C.tid] = 0u;
    Params p; p.out = ka.out; p.ws = ka.ws; p.ph_lo = ka.ph_lo; p.ph_hi = ka.ph_hi; p.ptab = (LAS unsigned long long*)(misc + 1024);
    if (C.tid < 34) p.ptab[C.tid] = (unsigned long long)ka.in[C.tid];
    __syncthreads();
    const int lo = p.ph_lo, hi = p.ph_hi;
    XcdBarrier bar; bar.bar = (unsigned*)(p.ws + WS_CTL) + CW_BAR; bar.x = 0; bar.st = (volatile LAS unsigned*)misc;
    if (hi - lo > 1) bar = xcd_barrier_post((unsigned*)(p.ws + WS_CTL) + CW_BAR, (volatile LAS unsigned*)misc);
#define IN(k) (lo <= (k) && (k) < hi)
#define SEAM(k) do { if (IN(k) && IN((k) + 1)) xcd_barrier(bar, C.wave); } while (0)

    if (IN(0)) { phase_p0(p, C); } SEAM(0);
    if (IN(1)) { phase_p1(p, C); } SEAM(1);
    if (IN(0) && IN(2) && (C.G & 7) == 0) {
        volatile LAS unsigned* st = (volatile LAS unsigned*)misc;
        if (C.tid == 0) { unsigned pre = 0u; const unsigned x = st[3];
            for (unsigned j = 0; j < 16; ++j) { const unsigned cj = xb_ld(&bar.bar[XB_XCNT(j)]); pre += (j < x) ? cj : 0u; }
            st[4] = pre + st[2]; }
        __syncthreads();
        const int vcu = (int)st[4], g8 = C.G >> 3;
        C.bid = __builtin_amdgcn_readfirstlane((vcu % g8) * 8 + vcu / g8); C.gw = C.bid * NWAVES + C.wave;
    }

    layer_body<0>(p, C, bar, misc, lo, hi);
    layer_body<1>(p, C, bar, misc, lo, hi);
#undef IN
#undef SEAM
}

extern "C" void kernel_launch(void* const* d_in, const int* in_sizes, int n_in, void* d_out, int out_size, void* d_ws, size_t ws_size, hipStream_t stream) {
    static int grid = 0;
    if (grid == 0) {
        if (n_in != 34 || out_size != SEQ * DM || ws_size < WS_END) { fprintf(stderr, "kernel_launch: unexpected shapes: n_in %d out %d ws %zu (need %zu)\n", n_in, out_size, ws_size, (size_t)WS_END); grid = -1; return; }
        int dev = 0, cus = 0, per_cu = 0;
        if (hipGetDevice(&dev) != hipSuccess || hipDeviceGetAttribute(&cus, hipDeviceAttributeMultiprocessorCount, dev) != hipSuccess) { grid = -1; return; }
        if (hipFuncSetAttribute((const void*)mega_fwd, hipFuncAttributeMaxDynamicSharedMemorySize, LDS_BYTES) != hipSuccess) { fprintf(stderr, "kernel_launch: hipFuncSetAttribute failed\n"); grid = -1; return; }
        if (hipOccupancyMaxActiveBlocksPerMultiprocessor(&per_cu, (const void*)mega_fwd, NTHR, LDS_BYTES) != hipSuccess || per_cu < 1) { fprintf(stderr, "kernel_launch: occupancy query says %d blocks per CU\n", per_cu); grid = -1; return; }
        (void)hipGetLastError();
        grid = cus;
    }
    if (grid < 0) return;
    (void)hipMemsetAsync((char*)d_ws + WS_CTL, 0, CTL_BYTES, stream);
    KArgs p{};
    for (int i = 0; i < 34; ++i) p.in[i] = (const float*)d_in[i];
    p.out = (float*)d_out; p.ws = (unsigned char*)d_ws;
#if MK_PER_PHASE
    for (int ph = 0; ph < N_PHASES; ++ph) {
        if (ph == 2 + PH_PER_LAYER + 5 || ph == 2 + PH_PER_LAYER + 6) continue;
        p.ph_lo = ph; p.ph_hi = ph + 1;
        hipLaunchKernelGGL(mega_fwd, dim3(grid), dim3(NTHR), LDS_BYTES, stream, p);
    }
#else
    p.ph_lo = 0; p.ph_hi = N_PHASES;
    hipLaunchKernelGGL(mega_fwd, dim3(grid), dim3(NTHR), LDS_BYTES, stream, p);
#endif
    const hipError_t le = hipPeekAtLastError();
    if (le != hipSuccess) fprintf(stderr, "kernel_launch: launch failed: %s\n", hipGetErrorName(le));
}
```

```cpp
#define MK_PER_PHASE 0
#include <hip/hip_runtime.h>
#include <cstdio>
#include <cstdint>

#define GAS __attribute__((address_space(1)))
#define LAS __attribute__((address_space(3)))
typedef unsigned short bf16_t;
typedef short bf16x8 __attribute__((ext_vector_type(8)));
typedef short s16x4 __attribute__((ext_vector_type(4)));
typedef float f32x4 __attribute__((ext_vector_type(4)));
typedef float f32x2 __attribute__((ext_vector_type(2)));
typedef float f32x16 __attribute__((ext_vector_type(16)));
typedef unsigned u32x4 __attribute__((ext_vector_type(4)));
typedef unsigned u32x2 __attribute__((ext_vector_type(2)));

constexpr int DM = 2048, SEQ = 16384, CTXL = 256, TT = SEQ + CTXL;
constexpr int NEXP = 64, NEX1 = 65, EHID = 512, TOPK = 8;
constexpr int EV_IN = 5120, OD_IN = 4608;
constexpr float LN_EPS = 1e-6f;
constexpr float ALPHA = 1.4142135623730951f;
constexpr float LAMBDA_INIT = 0.35550906759f;
constexpr int NTHR = 512, NWAVES = 8;

constexpr size_t al256(size_t x) { return (x + 255) / 256 * 256; }
constexpr size_t WS_CTL   = 0;
constexpr size_t CTL_BYTES = 1u << 20;
constexpr size_t WS_MODP  = WS_CTL + CTL_BYTES;
constexpr size_t WS_MODF  = WS_MODP + al256((size_t)2 * 32 * 2 * 12288 * 4);
constexpr size_t WS_ROPE128 = WS_MODF + al256((size_t)2 * 2 * 12288 * 4);
constexpr size_t WS_ROPE64  = WS_ROPE128 + al256((size_t)256 * 64 * 2 * 4);
constexpr size_t WS_KN    = WS_ROPE64 + al256((size_t)256 * 32 * 2 * 4);
constexpr size_t WS_WT    = WS_KN + al256((size_t)2 * 64 * 16 * 1024 * 2);
constexpr size_t WS_APOW  = WS_WT + al256((size_t)2 * 64 * 128 * 1024 * 2);
constexpr size_t WS_AL    = WS_APOW + al256((size_t)2 * 64 * 64 * 128 * 4);
constexpr size_t WS_CC    = WS_AL + al256((size_t)2 * 64 * 128 * 4);
constexpr size_t WS_BBT   = WS_CC + al256((size_t)64 * 16 * 128 * 2);
constexpr size_t WS_S5E   = WS_BBT + al256((size_t)2 * 64 * 128 * 16 * 2);
constexpr size_t WS_HST   = WS_S5E + al256((size_t)2 * 64 * 260 * 128 * 4);
constexpr size_t WS_WIN0  = WS_HST + al256((size_t)2 * 64 * 260 * 128 * 4);
constexpr size_t WS_WOUT0 = WS_WIN0 + al256((size_t)EV_IN * DM * 2);
constexpr size_t WS_WGLU  = WS_WOUT0 + al256((size_t)DM * DM * 2);
constexpr size_t WS_WIN1  = WS_WGLU + al256((size_t)1024 * 1024 * 2);
constexpr size_t WS_WOUT1 = WS_WIN1 + al256((size_t)OD_IN * DM * 2);
constexpr size_t WS_RWT   = WS_WOUT1 + al256((size_t)DM * DM * 2);
constexpr size_t WS_GU    = WS_RWT + al256((size_t)2 * 2 * 64 * DM * 2);
constexpr size_t WS_DT    = WS_GU + al256((size_t)NEX1 * 1024 * DM * 2);
constexpr size_t WS_XA    = WS_DT + al256((size_t)NEX1 * DM * EHID * 2);
constexpr size_t WS_Z     = WS_XA + al256((size_t)TT * DM * 2);
constexpr size_t WS_YMIX  = WS_Z + al256((size_t)TT * 1024 * 2);
constexpr size_t WS_X1    = WS_YMIX + al256((size_t)TT * DM * 2);
constexpr size_t WS_HX2   = WS_X1 + al256((size_t)TT * DM * 4);
constexpr size_t WS_LIST  = WS_HX2 + al256((size_t)9 * TT * EHID * 2);
constexpr size_t WS_WGT   = WS_LIST + al256((size_t)NEX1 * TT * 4);
constexpr size_t WS_LW    = WS_WGT + al256((size_t)8 * TT * 4);
constexpr size_t WS_BIG   = WS_LW + al256((size_t)NEX1 * TT * 4);
constexpr size_t BG_QKV   = 0;
constexpr size_t BG_CKV   = BG_QKV + al256((size_t)TT * EV_IN * 2);
constexpr size_t BG_SPREV = BG_CKV + al256((size_t)8 * 130 * 65536 * 4);
constexpr size_t BG_MIX   = BG_SPREV + al256((size_t)8 * 130 * 65536 * 2);
constexpr size_t BG_END0  = BG_MIX + al256((size_t)TT * DM * 2);
constexpr size_t BG_ATT   = BG_CKV;
constexpr size_t BG_Q8    = BG_ATT + al256((size_t)SEQ * 3072 * 2);
constexpr size_t BG_K8    = BG_Q8 + al256((size_t)TT * 1024);
constexpr size_t BG_VT8   = BG_K8 + al256((size_t)TT * 256);
constexpr size_t BG_Q8D   = BG_VT8 + al256((size_t)2 * 260 * 128 * 64);
constexpr size_t BG_K8D   = BG_Q8D + al256((size_t)TT * 1024);
constexpr size_t BG_VT8D  = BG_K8D + al256((size_t)TT * 1024);
constexpr size_t BG_F8END = BG_VT8D + al256((size_t)8 * 260 * 128 * 64);
constexpr size_t BG_YMOE  = 0;
constexpr size_t BG_END1  = al256((size_t)9 * TT * DM * 2);
constexpr size_t BG_SIZE  = BG_END0 > BG_END1 ? BG_END0 : BG_END1;
static_assert(BG_F8END <= BG_SIZE, "fp8 attention operands inside the big region");
constexpr size_t WS_END   = WS_BIG + BG_SIZE;

constexpr int CW_BAR = 4096;
constexpr int CW_CNT = 16384;
constexpr int CW_QUEUE = 20480;
constexpr int CW_KMAX = 24576;

constexpr int RING_BYTES = 151552;
constexpr int MISC_OFF = RING_BYTES;
constexpr int LDS_BYTES = 159744;

typedef __bf16 bf16x2_t __attribute__((ext_vector_type(2)));
__device__ __forceinline__ unsigned cvt_pk_bf16(float lo, float hi) { const f32x2 v = {lo, hi}; return __builtin_bit_cast(unsigned, __builtin_convertvector(v, bf16x2_t)); }
__device__ __forceinline__ bf16_t f2bf(float f) { unsigned u = __builtin_bit_cast(unsigned, f); return (bf16_t)((u + 0x7fffu + ((u >> 16) & 1u)) >> 16); }
__device__ __forceinline__ float bf2f(bf16_t b) { return __builtin_bit_cast(float, ((unsigned)b) << 16); }
__device__ __forceinline__ float bflo(unsigned w) { return __builtin_bit_cast(float, w << 16); }
__device__ __forceinline__ float bfhi(unsigned w) { return __builtin_bit_cast(float, w & 0xffff0000u); }
__device__ __forceinline__ float wave_sum(float v) {
#pragma unroll
    for (int o = 1; o < 64; o <<= 1) v += __shfl_xor(v, o);
    return v;
}
__device__ __forceinline__ float fast_exp(float x) { return __builtin_amdgcn_exp2f(x * 1.4426950408889634f); }
__device__ __forceinline__ float sigmoidf_(float x) { return 1.0f / (1.0f + __expf(-x)); }
__device__ __forceinline__ float siluf_(float x) { return x / (1.0f + __expf(-x)); }
__device__ __forceinline__ float gelu_tanh(float x) {
    const float u = 0.7978845608028654f * (x + 0.044715f * x * x * x);
    const float e = __expf(2.0f * u);
    const float t = 1.0f - 2.0f / (e + 1.0f);
    return 0.5f * x * (1.0f + t);
}
#define LDS_WAIT() asm volatile("s_waitcnt lgkmcnt(0)" ::: "memory")
#define VM_WAIT() asm volatile("s_waitcnt vmcnt(0)" ::: "memory")

#define XB_TMO      128
#define XB_XCNT(j)  (256  + 64 * (j))
#define XB_XSUB(j)  (1280 + 64 * (j))
#define XB_XGEN(j)  (2304 + 64 * (j))
#define XB_TOP      3328
#define XB_TOPGEN   3392
#define XCD_BAR_WORDS 3456
#define XB_SPIN_CAP (1u << 22)

__device__ __forceinline__ unsigned xb_ld(unsigned* p)              { return __hip_atomic_load(p, __ATOMIC_RELAXED, __HIP_MEMORY_SCOPE_AGENT); }
__device__ __forceinline__ unsigned xb_add(unsigned* p, unsigned v) { return __hip_atomic_fetch_add(p, v, __ATOMIC_RELAXED, __HIP_MEMORY_SCOPE_AGENT); }
__device__ __forceinline__ unsigned xb_xcc_id() { return (unsigned)__builtin_amdgcn_s_getreg((3 << 11) | 20) & 0xFu; }
#define XB_SPIN(cond, bar) do { unsigned _sp = 0; while (cond) { __builtin_amdgcn_s_sleep(1); \
    if ((++_sp & 255u) == 0u) { if (xb_ld(&(bar)[XB_TMO])) break; if (_sp > XB_SPIN_CAP) { atomicAdd(&(bar)[XB_TMO], 1u); break; } } } } while (0)

struct XcdBarrier { unsigned* bar; unsigned x; volatile LAS unsigned* st; };

__device__ __forceinline__ XcdBarrier xcd_barrier_post(unsigned* bar, volatile LAS unsigned* st) {
    XcdBarrier b; b.bar = bar; b.x = xb_xcc_id(); b.st = st;
    if (threadIdx.x == 0) { st[2] = xb_add(&bar[XB_XCNT(b.x)], 1u); st[3] = b.x; }
    return b;
}
__device__ __forceinline__ void xcd_barrier_complete(unsigned* bar, unsigned x, unsigned& nloc, unsigned& nx) {
    const unsigned G = gridDim.x * gridDim.y * gridDim.z;
    unsigned sum, cnt, mine, sp = 0u;
    for (;;) {
        sum = 0u; cnt = 0u; mine = 0u;
#pragma unroll
        for (unsigned j = 0; j < 16; ++j) { const unsigned c = xb_ld(&bar[XB_XCNT(j)]); sum += c; cnt += (c > 0u) ? 1u : 0u; mine = (j == x) ? c : mine; }
        if (sum == G) break;
        __builtin_amdgcn_s_sleep(1);
        if ((++sp & 255u) == 0u) { if (xb_ld(&bar[XB_TMO])) break; if (sp > XB_SPIN_CAP) { atomicAdd(&bar[XB_TMO], 1u); break; } }
    }
    nloc = mine > 0u ? mine : 1u; nx = cnt > 0u ? cnt : 1u;
}
__device__ __forceinline__ void xcd_barrier(const XcdBarrier& b, int wave_id) {
    const bool leader_thread = (wave_id == 0) && (__builtin_amdgcn_mbcnt_hi(~0u, __builtin_amdgcn_mbcnt_lo(~0u, 0u)) == 0u);
    asm volatile("s_waitcnt vmcnt(0)" ::: "memory");
    __syncthreads();
    if (leader_thread) {
        unsigned* bar = b.bar;
        __builtin_amdgcn_s_waitcnt(0);
        unsigned nloc = b.st[0], nx = b.st[1];
        if (nloc == 0u) { xcd_barrier_complete(bar, b.x, nloc, nx); b.st[0] = nloc; b.st[1] = nx; }
        const unsigned old = xb_add(&bar[XB_XSUB(b.x)], 1u);
        const unsigned gen = old / nloc;
        if (old + 1u == (gen + 1u) * nloc) {
            __builtin_amdgcn_fence(__ATOMIC_RELEASE, "agent");
            asm volatile("s_waitcnt vmcnt(0)" ::: "memory");
            const unsigned og = xb_add(&bar[XB_TOP], 1u);
            const unsigned tg = og / nx;
            if (og + 1u == (tg + 1u) * nx) xb_add(&bar[XB_TOPGEN], 1u);
            else XB_SPIN(xb_ld(&bar[XB_TOPGEN]) == tg, bar);
            __builtin_amdgcn_fence(__ATOMIC_ACQUIRE, "agent");
            xb_add(&bar[XB_XGEN(b.x)], 1u);
            asm volatile("s_waitcnt vmcnt(0)" ::: "memory");
        } else {
            XB_SPIN(xb_ld(&bar[XB_XGEN(b.x)]) == gen, bar);
            __builtin_amdgcn_fence(__ATOMIC_ACQUIRE, "agent");
            asm volatile("s_waitcnt vmcnt(0)" ::: "memory");
        }
    }
    __syncthreads();
}

__device__ __forceinline__ bf16x8 frag_rowk_l(const LAS bf16_t* p, int ld, int lane) {
    return *(const LAS bf16x8*)(p + (lane & 15) * ld + (lane >> 4) * 8);
}
__device__ __forceinline__ bf16x8 frag_rowk_g(const bf16_t* p, long ld, int lane) {
    return *(const bf16x8*)(p + (long)(lane & 15) * ld + (lane >> 4) * 8);
}
__device__ __forceinline__ bf16x8 frag_colk_l(unsigned p, int ldb, int lane) {
    const unsigned a0 = p + (unsigned)((8 * (lane >> 4) + ((lane & 15) >> 2)) * ldb + (lane & 3) * 8);
    const unsigned a1 = a0 + 4u * (unsigned)ldb;
    s16x4 lo, hi;
    asm volatile("ds_read_b64_tr_b16 %0, %2\n\tds_read_b64_tr_b16 %1, %3\n\ts_waitcnt lgkmcnt(0)" : "=&v"(lo), "=&v"(hi) : "v"(a0), "v"(a1) : "memory");
    return (bf16x8){lo[0], lo[1], lo[2], lo[3], hi[0], hi[1], hi[2], hi[3]};
}
#define MFMA16(a, b, c) __builtin_amdgcn_mfma_f32_16x16x32_bf16((a), (b), (c), 0, 0, 0)
namespace pg8 {
constexpr int BM = 256, BK = 64, HALF = 128, HTB = HALF * BK * 2, STAGE_BYTES = 8 * HTB, NXCD = 8, WGM = 8;
__device__ __forceinline__ int lds_byte(int r, int c) { const int st = (r >> 4) * 2 + (c >> 5), rr = r & 15, cc = c & 31, ob = rr * 64 + cc * 2; return st * 1024 + (ob ^ (((ob >> 9) & 1) << 5)); }
__device__ __forceinline__ void stage_rc(int b, int& R, int& C) { const int st = b / 1024, sb = b % 1024, swz = sb ^ (((sb >> 9) & 1) << 5); R = (st >> 1) * 16 + swz / 64; C = (st & 1) * 32 + (swz % 64) / 2; }
__device__ __forceinline__ int perm32(int rho) { const int n = rho >> 4, i = rho & 15; return 8 * (i >> 2) + 4 * n + (i & 3); }

struct Unit { int pm, pn, e; };
constexpr float WSCALE = 32.0f, WSCALE_INV = 1.0f / 32.0f;

struct DenseOrder {
    const bf16_t* A; const bf16_t* Bt; int ldab, kb, nM, nN, nwg, G, c;
    __device__ __forceinline__ void init(const bf16_t* A_, int lda_, const bf16_t* Bt_, int M, int N, int K_, int G_, int c_) { A = A_; ldab = lda_ * 2; Bt = Bt_; kb = K_ * 2; nM = M / BM; nN = N / BM; nwg = nM * nN; G = G_; c = c_; }
    __device__ __forceinline__ void init8(const void* A_, int ldab_, const void* Bt_, int M, int N, int K_, int G_, int c_) { A = (const bf16_t*)A_; ldab = ldab_; Bt = (const bf16_t*)Bt_; kb = K_; nM = M / BM; nN = N / BM; nwg = nM * nN; G = G_; c = c_; }
    __device__ __forceinline__ void prep(LAS unsigned char*) const {}
    __device__ __forceinline__ int units_of_me() const { return c < nwg ? (nwg - c + G - 1) / G : 0; }
    __device__ __forceinline__ int max_units() const { return (nwg + G - 1) / G; }
    __device__ __forceinline__ bool next(int i, Unit& u) const {
        const long L = (long)i * G + c; if (L >= nwg) return false;
        int wgid = (int)L; { const int q = nwg / NXCD, r = nwg % NXCD, xcd = wgid % NXCD, off = wgid / NXCD; wgid = (xcd < r ? xcd * (q + 1) : r * (q + 1) + (xcd - r) * q) + off; }
        const int nig = WGM * nN, gid = wgid / nig, fm = gid * WGM, gsz = (nM - fm) < WGM ? (nM - fm) : WGM;
        u.pm = fm + ((wgid % nig) % gsz); u.pn = (wgid % nig) / gsz; u.e = 0; return true;
    }
    __device__ __forceinline__ const char* a_base() const { return (const char*)A; }
    __device__ __forceinline__ unsigned a_off(const Unit& u, int r) const { return (unsigned)(u.pm * BM + r) * (unsigned)ldab; }
    __device__ __forceinline__ const char* b_ptr(const Unit& u) const { return (const char*)Bt + (size_t)u.pn * BM * kb; }
};

template <int MODE  >
struct MoeOrder {
    const void* A; const void* Bt; const int* list; const int* cnt; int ldab, kb, nN, G, c; size_t bstride;
    LAS int* tp; LAS int* cn; LAS int* rb;
    __device__ __forceinline__ void prep(LAS unsigned char* misc, int tid) {
        tp = (LAS int*)(misc + 64); cn = tp + 72; rb = cn + 72;
        if (tid < NEX1) cn[tid] = cnt[tid];
        __syncthreads();
        if (tid == 0) { int s = 0, q = 0; for (int e = 0; e < NEX1; ++e) { tp[e] = s; rb[e] = q; s += (cn[e] + BM - 1) / BM; q += cn[e]; } tp[NEX1] = s; rb[NEX1] = q; }
        __syncthreads();
    }
    __device__ __forceinline__ bool next(int i, Unit& u) const {
        const int total = tp[NEX1]; const long nu = (long)total * nN; const int per = (int)((nu + G - 1) / G);
        (void)per;
        long L = (long)i * G + c;
        if ((G & 7) == 0) L = ((long)i * 8 + (c & 7)) * (G >> 3) + (c >> 3);
        if (L >= nu) return false;
        const int tile = (int)(L / nN); u.pn = (int)(L % nN);
        int e = 0;
        for (int k = 1; k < NEX1; ++k) e += (tp[k] <= tile) ? 1 : 0;
        u.e = e; u.pm = tile - tp[e]; return true;
    }
    __device__ __forceinline__ const char* a_base() const { return (const char*)A; }
    __device__ __forceinline__ unsigned a_off(const Unit& u, int r) const {
        int pos = u.pm * BM + r; const int n = cn[u.e]; pos = pos < n ? pos : n - 1;
        if (MODE == 1) return (unsigned)(rb[u.e] + pos) * (unsigned)ldab;
        const int a = list[u.e * TT + pos];
        const int row = a < 8 * TT ? (a >> 3) : a - 8 * TT;
        return (unsigned)row * (unsigned)ldab;
    }
    __device__ __forceinline__ const char* b_ptr(const Unit& u) const { return (const char*)Bt + (size_t)u.e * bstride + (size_t)u.pn * BM * kb; }
};

typedef int v8i32 __attribute__((ext_vector_type(8)));
typedef int v4i32_ __attribute__((ext_vector_type(4)));
__device__ __forceinline__ v8i32 cat8(bf16x8 a, bf16x8 b) { const u32x4 x = __builtin_bit_cast(u32x4, a), y = __builtin_bit_cast(u32x4, b); return (v8i32){(int)x.x, (int)x.y, (int)x.z, (int)x.w, (int)y.x, (int)y.y, (int)y.z, (int)y.w}; }
template <bool FP8, class Epi, class Sched>
__device__ __forceinline__ void gemm_phase(LAS unsigned char* lds, const Sched& S, const Epi& E, int wave_id) {
    const int wid = wave_id; int lane = (int)__builtin_amdgcn_mbcnt_hi(~0u, __builtin_amdgcn_mbcnt_lo(~0u, 0u)); asm volatile("" : "+v"(lane));
    const int tid = wid * 64 + lane, wr = wid >> 2, wc = wid & 3, fr = lane & 15, fq = lane >> 4;
    const int kb = S.kb; int nt = kb / 128; asm volatile("" : "+s"(nt));
    unsigned voffB[2];
#pragma unroll
    for (int i = 0; i < 2; ++i) { int R, C; stage_rc(tid * 16 + i * 8192, R, C); const int Rb = (R & ~31) + perm32(R & 31);
        voffB[i] = (unsigned)(Rb * kb) + (unsigned)C * 2u; }
#define PG8_AOFF(u, h, i) ({ int _tz = tid; asm volatile("" : "+v"(_tz)); int _R, _C; stage_rc(_tz * 16 + (i) * 8192, _R, _C); S.a_off((u), (h) * HALF + _R) + (unsigned)_C * 2u; })
    const size_t kstep = (size_t)(BK * 2);
    const size_t hstepB = (size_t)HALF * kb;
    const unsigned ldsw = (unsigned)wid * 1024u;
    const int aoff = lds_byte(wr * 64 + fr, fq * 8), boff = lds_byte(wc * 32 + fr, fq * 8);
#define PG8_SA(b, h) (((b) * 2 + (h)) * HTB)
#define PG8_SB(b, h) ((4 + (b) * 2 + (h)) * HTB)
#define PG8_STAGE(bufoff, gbase, v0, v1) do { \
        __builtin_amdgcn_global_load_lds((const unsigned*)((const char*)(gbase) + (v0)), (LAS unsigned*)(lds + (bufoff) + ldsw), 16, 0, 0); \
        __builtin_amdgcn_global_load_lds((const unsigned*)((const char*)(gbase) + (v1)), (LAS unsigned*)(lds + (bufoff) + ldsw + 8192), 16, 0, 0); } while (0)
#define PG8_VOFFB(i) ({ int _tz = tid; asm volatile("" : "+v"(_tz)); int _R, _C; stage_rc(_tz * 16 + (i) * 8192, _R, _C); (unsigned)(((_R & ~31) + perm32(_R & 31)) * kb) + (unsigned)_C * 2u; })
#define PG8_STAGE_B(bufoff, gbase) do { if constexpr (FP8) { int _tz = tid; asm volatile("" : "+v"(_tz)); const u32x2 _vv = *(const LAS u32x2*)(lds + STAGE_BYTES + 8192 + _tz * 8); PG8_STAGE(bufoff, gbase, _vv.x, _vv.y); } else PG8_STAGE(bufoff, gbase, voffB[0], voffB[1]); } while (0)
#define PG8_LD8(off) __builtin_shufflevector(*(const LAS v4i32_*)(lds + (off)), *(const LAS v4i32_*)(lds + (off) + 1024), 0, 1, 2, 3, 4, 5, 6, 7)
#define PG8_LDA(dst, b, h) do { _Pragma("unroll") for (int m = 0; m < 4; ++m) { if constexpr (FP8) dst##8[m] = PG8_LD8(PG8_SA(b, h) + aoff + m * 2048); else { _Pragma("unroll") for (int k = 0; k < 2; ++k) dst[m][k] = *(const LAS bf16x8*)(lds + PG8_SA(b, h) + aoff + m * 2048 + k * 1024); } } } while (0)
#define PG8_LDB(dst, b, h) do { _Pragma("unroll") for (int n = 0; n < 2; ++n) { if constexpr (FP8) dst##8[n] = PG8_LD8(PG8_SB(b, h) + boff + n * 2048); else { _Pragma("unroll") for (int k = 0; k < 2; ++k) dst[n][k] = *(const LAS bf16x8*)(lds + PG8_SB(b, h) + boff + n * 2048 + k * 1024); } } } while (0)
#define PG8_MMA(ai, bj, At, Bt) do { __builtin_amdgcn_s_setprio(1); _Pragma("unroll") for (int m = 0; m < 4; ++m) _Pragma("unroll") for (int n = 0; n < 2; ++n) { \
        if constexpr (FP8) asm volatile("v_mfma_f32_16x16x128_f8f6f4 %0, %1, %2, %0" : "+v"(acc[ai][bj][m][n]) : "v"(Bt##8[n]), "v"(At##8[m])); \
        else { _Pragma("unroll") for (int k = 0; k < 2; ++k) acc[ai][bj][m][n] = __builtin_amdgcn_mfma_f32_16x16x32_bf16(Bt[n][k], At[m][k], acc[ai][bj][m][n], 0, 0, 0); } } \
        __builtin_amdgcn_s_setprio(0); } while (0)
#define PG8_WAIT_V(n) asm volatile("s_waitcnt vmcnt(" #n ")" ::: "memory")
#define PG8_WAIT_L(n) asm volatile("s_waitcnt lgkmcnt(" #n ")" ::: "memory")
#define PG8_BAR __builtin_amdgcn_s_barrier()
#define PG8_SCHED __builtin_amdgcn_sched_barrier(0)
    if constexpr (FP8) { u32x2 _vb; _vb.x = PG8_VOFFB(0); _vb.y = PG8_VOFFB(1); *(LAS u32x2*)(lds + STAGE_BYTES + 8192 + tid * 8) = _vb; }
    Unit cur, nxt; int ui = 0;
    if (!S.next(0, cur)) return;
    f32x4 acc[2][2][4][2];
#pragma unroll
    for (int a = 0; a < 2; ++a)
#pragma unroll
        for (int b = 0; b < 2; ++b)
#pragma unroll
            for (int m = 0; m < 4; ++m)
#pragma unroll
                for (int n = 0; n < 2; ++n) acc[a][b][m][n] = (f32x4){0.f, 0.f, 0.f, 0.f};
    bf16x8 At[4][2], B0[2][2], B1[2][2]; v8i32 At8[4], B08[2], B18[2];
    const char* const gA = S.a_base();
    const char* cB = S.b_ptr(cur);
    unsigned oc00, oc01, oc10, oc11;
    oc00 = PG8_AOFF(cur, 0, 0); oc01 = PG8_AOFF(cur, 0, 1); oc10 = PG8_AOFF(cur, 1, 0); oc11 = PG8_AOFF(cur, 1, 1);
    PG8_STAGE_B(PG8_SB(0, 0), cB); PG8_STAGE_B(PG8_SB(0, 1), cB + hstepB); PG8_STAGE(PG8_SA(0, 0), gA, oc00, oc01); PG8_STAGE(PG8_SA(0, 1), gA, oc10, oc11);
    if (wr == 1) PG8_BAR;
    PG8_WAIT_V(2); PG8_BAR;
    PG8_STAGE_B(PG8_SB(1, 0), cB + kstep); PG8_STAGE(PG8_SA(1, 0), gA + kstep, oc00, oc01); PG8_STAGE_B(PG8_SB(1, 1), cB + hstepB + kstep);
    PG8_WAIT_V(6); PG8_BAR;
    for (;;) {
        const bool has_next = S.next(ui + 1, nxt);
        const char* nB = cB;
        {
            u32x4 on = {oc00, oc01, oc10, oc11};
            if (has_next) { on.x = PG8_AOFF(nxt, 0, 0); on.y = PG8_AOFF(nxt, 0, 1); on.z = PG8_AOFF(nxt, 1, 0); on.w = PG8_AOFF(nxt, 1, 1); nB = S.b_ptr(nxt); }
            *(LAS u32x4*)(lds + STAGE_BYTES + tid * 16) = on;
        }
        for (int t = 0; t < nt; t += 2) {
            const bool last = (t == nt - 2);
            const char* a1 = gA + (size_t)(t + 1) * kstep;
            const char* a2 = last ? gA : gA + (size_t)(t + 2) * kstep; const char* b2 = last ? nB : cB + (size_t)(t + 2) * kstep;
            const char* a3 = a2 + kstep; const char* b3 = b2 + kstep;
            unsigned s00 = oc00, s01 = oc01, s10 = oc10, s11 = oc11;
            if (last) { const u32x4 on = *(const LAS u32x4*)(lds + STAGE_BYTES + tid * 16); s00 = on.x; s01 = on.y; s10 = on.z; s11 = on.w; }
            PG8_LDB(B0, 0, 0); PG8_LDB(B1, 0, 1); PG8_SCHED; PG8_LDA(At, 0, 0); PG8_STAGE(PG8_SA(1, 1), a1, oc10, oc11);
            PG8_WAIT_V(8); PG8_WAIT_L(0); PG8_BAR; PG8_MMA(0, 0, At, B0); PG8_MMA(0, 1, At, B1); PG8_BAR; PG8_SCHED;
            PG8_LDA(At, 0, 1); PG8_STAGE_B(PG8_SB(0, 0), b2); PG8_STAGE_B(PG8_SB(0, 1), b2 + hstepB); PG8_STAGE(PG8_SA(0, 0), a2, s00, s01);
            PG8_WAIT_V(8); PG8_WAIT_L(0); PG8_BAR; PG8_MMA(1, 0, At, B0); PG8_MMA(1, 1, At, B1); PG8_BAR; PG8_SCHED;
            PG8_LDB(B0, 1, 0); PG8_LDB(B1, 1, 1); PG8_SCHED; PG8_LDA(At, 1, 0); PG8_STAGE(PG8_SA(0, 1), a2, s10, s11);
            PG8_WAIT_V(8); PG8_WAIT_L(0); PG8_BAR; PG8_MMA(0, 0, At, B0); PG8_MMA(0, 1, At, B1); PG8_BAR; PG8_SCHED;
            PG8_LDA(At, 1, 1); PG8_STAGE_B(PG8_SB(1, 0), b3); PG8_STAGE_B(PG8_SB(1, 1), b3 + hstepB); PG8_STAGE(PG8_SA(1, 0), a3, s00, s01);
            PG8_WAIT_V(8); PG8_WAIT_L(0); PG8_BAR; PG8_MMA(1, 0, At, B0); PG8_MMA(1, 1, At, B1); PG8_BAR; PG8_SCHED;
        }
        if (wr == 0) PG8_BAR;
        E(acc, cur, wr, wc, fr, fq);
        if (!has_next) break;
#pragma unroll
        for (int a = 0; a < 2; ++a)
#pragma unroll
            for (int b = 0; b < 2; ++b)
#pragma unroll
                for (int m = 0; m < 4; ++m)
#pragma unroll
                    for (int n = 0; n < 2; ++n) acc[a][b][m][n] = (f32x4){0.f, 0.f, 0.f, 0.f};
        { const u32x4 on = *(const LAS u32x4*)(lds + STAGE_BYTES + tid * 16); oc00 = on.x; oc01 = on.y; oc10 = on.z; oc11 = on.w; }
        cur = nxt; cB = nB; ++ui;
        if (wr == 1) PG8_BAR;
    }
    PG8_WAIT_V(0);
    PG8_BAR;
#undef PG8_SA
#undef PG8_SB
#undef PG8_STAGE
#undef PG8_STAGE_B
#undef PG8_AOFF
#undef PG8_VOFFB
#undef PG8_LD8
#undef PG8_LDA
#undef PG8_LDB
#undef PG8_MMA
#undef PG8_WAIT_V
#undef PG8_WAIT_L
#undef PG8_BAR
#undef PG8_SCHED
}

struct EpiStore {
    bf16_t* O; int ldc; float scale;
    __device__ __forceinline__ void operator()(const f32x4 (&acc)[2][2][4][2], const Unit& u, int wr, int wc, int fr, int fq) const {
        const int row0 = u.pm * BM + wr * 64 + fr, col0 = u.pn * BM + wc * 32 + 8 * fq;
#pragma unroll
        for (int ai = 0; ai < 2; ++ai)
#pragma unroll
            for (int m = 0; m < 4; ++m) { bf16_t* rowp = O + (size_t)(row0 + ai * HALF + m * 16) * ldc + col0;
#pragma unroll
                for (int bj = 0; bj < 2; ++bj) { const f32x4 v0 = acc[ai][bj][m][0] * scale, v1 = acc[ai][bj][m][1] * scale;
                    u32x4 w; w.x = cvt_pk_bf16(v0[0], v0[1]); w.y = cvt_pk_bf16(v0[2], v0[3]); w.z = cvt_pk_bf16(v1[0], v1[1]); w.w = cvt_pk_bf16(v1[2], v1[3]);
                    *(u32x4*)(rowp + bj * HALF) = w; } }
    }
};
struct EpiGlu {
    const bf16_t* Z; const float* b; bf16_t* MIX;
    __device__ __forceinline__ void operator()(const f32x4 (&acc)[2][2][4][2], const Unit& u, int wr, int wc, int fr, int fq) const {
        const int row0 = u.pm * BM + wr * 64 + fr, col0 = u.pn * BM + wc * 32 + 8 * fq;
#pragma unroll
        for (int bj = 0; bj < 2; ++bj) {
            const f32x4 b0 = *(const f32x4*)(b + col0 + bj * HALF), b1 = *(const f32x4*)(b + col0 + bj * HALF + 4);
#pragma unroll
            for (int ai = 0; ai < 2; ++ai)
#pragma unroll
                for (int m = 0; m < 4; ++m) { const size_t row = (size_t)(row0 + ai * HALF + m * 16);
                    const u32x4 zz = *(const u32x4*)(Z + row * 1024 + col0 + bj * HALF);
                    const f32x4 v0 = acc[ai][bj][m][0] + b0, v1 = acc[ai][bj][m][1] + b1;
                    u32x4 w;
                    w.x = cvt_pk_bf16(bflo(zz.x) * sigmoidf_(v0[0]), bfhi(zz.x) * sigmoidf_(v0[1]));
                    w.y = cvt_pk_bf16(bflo(zz.y) * sigmoidf_(v0[2]), bfhi(zz.y) * sigmoidf_(v0[3]));
                    w.z = cvt_pk_bf16(bflo(zz.z) * sigmoidf_(v1[0]), bfhi(zz.z) * sigmoidf_(v1[1]));
                    w.w = cvt_pk_bf16(bflo(zz.w) * sigmoidf_(v1[2]), bfhi(zz.w) * sigmoidf_(v1[3]));
                    *(u32x4*)(MIX + row * DM + 1024 + col0 + bj * HALF) = w; }
        }
    }
};
struct EpiE1 {
    unsigned char* H; const LAS int* cn; const LAS int* rb;
    __device__ __forceinline__ void operator()(const f32x4 (&acc)[2][2][4][2], const Unit& u, int wr, int wc, int fr, int fq) const {
        const int n = cn[u.e]; const int colh = u.pn * 128 + wc * 32 + 8 * fq;
#pragma unroll
        for (int ai = 0; ai < 2; ++ai)
#pragma unroll
            for (int m = 0; m < 4; ++m) { const int pos = u.pm * BM + ai * HALF + wr * 64 + m * 16 + fr;
                if (pos < n) { const int a = rb[u.e] + pos;
                    float sc = WSCALE_INV; asm volatile("" : "+v"(sc));
                    const f32x4 g0 = acc[ai][0][m][0] * sc, g1 = acc[ai][0][m][1] * sc, u0 = acc[ai][1][m][0] * sc, u1 = acc[ai][1][m][1] * sc;
                    u32x2 w;
                    w.x = (unsigned)__builtin_amdgcn_cvt_pk_fp8_f32(siluf_(g0[0]) * u0[0], siluf_(g0[1]) * u0[1], 0, false);
                    w.x = (unsigned)__builtin_amdgcn_cvt_pk_fp8_f32(siluf_(g0[2]) * u0[2], siluf_(g0[3]) * u0[3], (int)w.x, true);
                    w.y = (unsigned)__builtin_amdgcn_cvt_pk_fp8_f32(siluf_(g1[0]) * u1[0], siluf_(g1[1]) * u1[1], 0, false);
                    w.y = (unsigned)__builtin_amdgcn_cvt_pk_fp8_f32(siluf_(g1[2]) * u1[2], siluf_(g1[3]) * u1[3], (int)w.y, true);
                    *(u32x2*)(H + (size_t)a * EHID + colh) = w; }
                __builtin_amdgcn_sched_barrier(0); }
    }
};
struct EpiE2 {
    unsigned char* Y; const float* wgt; const LAS int* cn; const LAS int* rb;
    __device__ __forceinline__ void operator()(const f32x4 (&acc)[2][2][4][2], const Unit& u, int wr, int wc, int fr, int fq) const {
        const int n = cn[u.e]; const int col0 = u.pn * BM + wc * 32 + 8 * fq;
#pragma unroll
        for (int ai = 0; ai < 2; ++ai)
#pragma unroll
            for (int m = 0; m < 4; ++m) { const int pos = u.pm * BM + ai * HALF + wr * 64 + m * 16 + fr;
                if (pos < n) { const int a = rb[u.e] + pos; float ws = wgt[u.e * TT + pos] * WSCALE_INV; asm volatile("" : "+v"(ws));
                    unsigned char* rowp = Y + (size_t)a * DM + col0;
#pragma unroll
                    for (int bj = 0; bj < 2; ++bj) { const f32x4 v0 = acc[ai][bj][m][0] * ws, v1 = acc[ai][bj][m][1] * ws;
                        u32x2 w;
                        w.x = (unsigned)__builtin_amdgcn_cvt_pk_fp8_f32(v0[0], v0[1], 0, false); w.x = (unsigned)__builtin_amdgcn_cvt_pk_fp8_f32(v0[2], v0[3], (int)w.x, true);
                        w.y = (unsigned)__builtin_amdgcn_cvt_pk_fp8_f32(v1[0], v1[1], 0, false); w.y = (unsigned)__builtin_amdgcn_cvt_pk_fp8_f32(v1[2], v1[3], (int)w.y, true);
                        *(u32x2*)(rowp + bj * HALF) = w; } }
                __builtin_amdgcn_sched_barrier(0); }
    }
};
}
struct KArgs {
    const float* in[34];
    float* out;
    unsigned char* ws;
    int ph_lo, ph_hi;
};
struct Params {
    float* out;
    unsigned char* ws;
    LAS unsigned long long* ptab;
    int ph_lo, ph_hi;
    __device__ __forceinline__ const float* inp(int k) const {
        const unsigned long long v = ptab[k];
        const unsigned lo = __builtin_amdgcn_readfirstlane((unsigned)v), hi = __builtin_amdgcn_readfirstlane((unsigned)(v >> 32));
        return (const float*)(((unsigned long long)hi << 32) | lo);
    }
};
struct Ctx {
    LAS unsigned char* lds;
    int tid, lane, wave, G, bid;
    int gw, ngw;
};

__device__ __forceinline__ void tr_item(const float* W, int N, bf16_t* WT, int ldt, int k0, int n0, int orow0, LAS float* scr, int lane) {
#pragma unroll 8
    for (int i = 0; i < 32; ++i) { const int kk = 2 * i + (lane >> 5); scr[kk * 33 + (lane & 31)] = W[(size_t)(k0 + kk) * N + n0 + (lane & 31)]; }
    LDS_WAIT(); asm volatile("" ::: "memory");
    const int c = lane & 7;
#pragma unroll
    for (int j = 0; j < 4; ++j) { const int n = (lane >> 3) + 8 * j; const LAS float* s = scr + (8 * c) * 33 + n;
        u32x4 o; o.x = cvt_pk_bf16(s[0 * 33], s[1 * 33]); o.y = cvt_pk_bf16(s[2 * 33], s[3 * 33]); o.z = cvt_pk_bf16(s[4 * 33], s[5 * 33]); o.w = cvt_pk_bf16(s[6 * 33], s[7 * 33]);
        *(u32x4*)(WT + (size_t)(orow0 + n) * ldt + k0 + 8 * c) = o; }
    LDS_WAIT(); asm volatile("" ::: "memory");
}
__device__ __forceinline__ void tr_item64(const float* W, int N, bf16_t* WT, int ldt, int k0, int n0, int orow0, LAS float* scr, int lane) {
    f32x4 v[16];
    const float* src = W + (size_t)(k0 + (lane >> 4)) * N + n0 + 4 * (lane & 15);
#pragma unroll
    for (int i = 0; i < 16; ++i) v[i] = __builtin_nontemporal_load((const f32x4*)(src + (size_t)(4 * i) * N));
#pragma unroll
    for (int i = 0; i < 16; ++i) { LAS float* d = scr + (4 * i + (lane >> 4)) * 65 + 4 * (lane & 15); d[0] = v[i][0]; d[1] = v[i][1]; d[2] = v[i][2]; d[3] = v[i][3]; }
    LDS_WAIT(); asm volatile("" ::: "memory");
    const int c = lane & 7;
#pragma unroll
    for (int j = 0; j < 8; ++j) { const int n = (lane >> 3) + 8 * j; const LAS float* s = scr + (8 * c) * 65 + n;
        u32x4 o; o.x = cvt_pk_bf16(s[0 * 65], s[1 * 65]); o.y = cvt_pk_bf16(s[2 * 65], s[3 * 65]); o.z = cvt_pk_bf16(s[4 * 65], s[5 * 65]); o.w = cvt_pk_bf16(s[6 * 65], s[7 * 65]);
        *(u32x4*)(WT + (size_t)(orow0 + n) * ldt + k0 + 8 * c) = o; }
    LDS_WAIT(); asm volatile("" ::: "memory");
}
__device__ __forceinline__ void tr_item64_fp8(const float* W, int N, unsigned char* WT, int ldt, int k0, int n0, int orow0, LAS float* scr, int lane, float wscale = pg8::WSCALE) {
    f32x4 v[16];
    const float* src = W + (size_t)(k0 + (lane >> 4)) * N + n0 + 4 * (lane & 15);
#pragma unroll
    for (int i = 0; i < 16; ++i) v[i] = __builtin_nontemporal_load((const f32x4*)(src + (size_t)(4 * i) * N));
#pragma unroll
    for (int i = 0; i < 16; ++i) { LAS float* d = scr + (4 * i + (lane >> 4)) * 65 + 4 * (lane & 15); d[0] = v[i][0]; d[1] = v[i][1]; d[2] = v[i][2]; d[3] = v[i][3]; }
    LDS_WAIT(); asm volatile("" ::: "memory");
    const int c = lane & 3;
#pragma unroll
    for (int j = 0; j < 4; ++j) { const int n = (lane >> 2) + 16 * j; const LAS float* s = scr + (16 * c) * 65 + n;
        u32x4 o;
        o.x = (unsigned)__builtin_amdgcn_cvt_pk_fp8_f32(s[0 * 65] * wscale, s[1 * 65] * wscale, 0, false);   o.x = (unsigned)__builtin_amdgcn_cvt_pk_fp8_f32(s[2 * 65] * wscale, s[3 * 65] * wscale, (int)o.x, true);
        o.y = (unsigned)__builtin_amdgcn_cvt_pk_fp8_f32(s[4 * 65] * wscale, s[5 * 65] * wscale, 0, false);   o.y = (unsigned)__builtin_amdgcn_cvt_pk_fp8_f32(s[6 * 65] * wscale, s[7 * 65] * wscale, (int)o.y, true);
        o.z = (unsigned)__builtin_amdgcn_cvt_pk_fp8_f32(s[8 * 65] * wscale, s[9 * 65] * wscale, 0, false);   o.z = (unsigned)__builtin_amdgcn_cvt_pk_fp8_f32(s[10 * 65] * wscale, s[11 * 65] * wscale, (int)o.z, true);
        o.w = (unsigned)__builtin_amdgcn_cvt_pk_fp8_f32(s[12 * 65] * wscale, s[13 * 65] * wscale, 0, false); o.w = (unsigned)__builtin_amdgcn_cvt_pk_fp8_f32(s[14 * 65] * wscale, s[15 * 65] * wscale, (int)o.w, true);
        *(u32x4*)(WT + (size_t)(orow0 + n) * ldt + k0 + 16 * c) = o; }
    LDS_WAIT(); asm volatile("" ::: "memory");
}
__device__ __forceinline__ void tr_dense(const float* W, int K, int N, bf16_t* WT, int item, LAS float* scr, int lane) {
    const int nblk = N / 32, kb = item / nblk, nb = item % nblk;
    tr_item(W, N, WT, K, 64 * kb, 32 * nb, 32 * nb, scr, lane);
}

__device__ __forceinline__ void s5_tables(const Params& p, Ctx& C, int dir, int g) {
    LAS f32x2* PW = (LAS f32x2*)C.lds;
    LAS f32x2* BB = PW + 65 * 64;
    LAS f32x2* CX = BB + 64 * 16;
    const float* a_re = p.inp(11); const float* a_im = p.inp(12); const float* log_dt = p.inp(13);
    const float* b_re = p.inp(14); const float* b_im = p.inp(15); const float* c_re = p.inp(16); const float* c_im = p.inp(17);
    const int tid = C.tid;
    if (tid < 64) {
        const int pp = tid;
        const float dt = __expf(log_dt[dir * 64 + g]);
        const float are = a_re[(dir * 64 + g) * 64 + pp], aim = a_im[(dir * 64 + g) * 64 + pp];
        const float zr = are * dt, zi = aim * dt;
        const float mag = __expf(zr);
        double rev = (double)zi * 0.15915494309189535; rev -= floor(rev);
        const float cs = __builtin_amdgcn_cosf((float)rev), sn = __builtin_amdgcn_sinf((float)rev);
        const float abr = mag * cs, abi = mag * sn;
        const float den = are * are + aim * aim, nr = abr - 1.0f, ni = abi;
        const float fre = (nr * are + ni * aim) / den, fim = (ni * are - nr * aim) / den;
        float pr = 1.0f, pi = 0.0f;
#pragma unroll 1
        for (int n = 0; n <= 64; ++n) { PW[n * 64 + pp] = (f32x2){pr, pi}; const float t = pr * abr - pi * abi; pi = pr * abi + pi * abr; pr = t; }
        for (int j = 0; j < 16; ++j) { const float br = b_re[(g * 64 + pp) * 16 + j], bi = b_im[(g * 64 + pp) * 16 + j];
            BB[pp * 16 + j] = (f32x2){fre * br - fim * bi, fre * bi + fim * br}; }
    }
    for (int q = tid; q < 1024; q += NTHR) { const int i = q >> 6, pp = q & 63; CX[i * 64 + pp] = (f32x2){c_re[(g * 16 + i) * 64 + pp], c_im[(g * 16 + i) * 64 + pp]}; }
    __syncthreads();
    bf16_t* KN = (bf16_t*)(p.ws + WS_KN) + (size_t)(dir * 64 + g) * 16 * 1024;
    float* APOW = (float*)(p.ws + WS_APOW) + (size_t)(dir * 64 + g) * 64 * 128;
    float* AL = (float*)(p.ws + WS_AL) + (size_t)(dir * 64 + g) * 128;
#pragma unroll 1
    for (int q = 0; q < 32; ++q) { const int idx = tid + NTHR * q; const int n = idx >> 8, i = (idx >> 4) & 15, j = idx & 15;
        float s = 0.f;
#pragma unroll 4
        for (int pp = 0; pp < 64; ++pp) { const f32x2 c = CX[i * 64 + pp], w = PW[n * 64 + pp], b = BB[pp * 16 + j];
            const float gr = c.x * b.x - c.y * b.y, gi = c.x * b.y + c.y * b.x;
            s += gr * w.x - gi * w.y; }
        KN[(size_t)i * 1024 + n * 16 + j] = f2bf(s); }
    for (int q = tid; q < 4096; q += NTHR) { const int t = q >> 6, pp = q & 63; const f32x2 w = PW[(t + 1) * 64 + pp]; *(f32x2*)(APOW + (size_t)t * 128 + 2 * pp) = w; }
    if (tid < 64) { const f32x2 w = PW[64 * 64 + tid]; *(f32x2*)(AL + 2 * tid) = w; }
    { bf16_t* BBT = (bf16_t*)(p.ws + WS_BBT) + (size_t)(dir * 64 + g) * 128 * 16;
      for (int q = tid; q < 2048; q += NTHR) { const int pq = q >> 4, j = q & 15; const f32x2 b = BB[(pq & 63) * 16 + j]; BBT[q] = f2bf(pq < 64 ? b.x : b.y); } }
    if (dir == 0) { bf16_t* CCt = (bf16_t*)(p.ws + WS_CC) + (size_t)g * 16 * 128;
        for (int q = tid; q < 2048; q += NTHR) { const int i = q >> 7, pq = q & 127; const f32x2 c = CX[i * 64 + (pq & 63)]; CCt[i * 128 + pq] = f2bf(pq < 64 ? c.x : -c.y); } }
    __syncthreads();
}

__device__ __forceinline__ void phase_p0(const Params& p, Ctx& C) {
    for (int task = C.bid; task < 128; task += C.G) s5_tables(p, C, task >> 6, task & 63);
    {
        const int gt = C.bid * NTHR + C.tid, ngt = C.G * NTHR;
        float* R128 = (float*)(p.ws + WS_ROPE128); float* R64 = (float*)(p.ws + WS_ROPE64);
        for (int q = gt; q < 256 * 64 + 256 * 32; q += ngt) {
            int pos, i, half; float* dst;
            if (q < 256 * 64) { pos = q >> 6; i = q & 63; half = 64; dst = R128 + (size_t)q * 2; }
            else { const int r = q - 256 * 64; pos = r >> 5; i = r & 31; half = 32; dst = R64 + (size_t)r * 2; }
            const float freq = exp2f(-(float)i / (float)half * 13.287712379549449f);
            const float ang = (float)pos * freq;
            double rev = (double)ang * 0.15915494309189535; rev -= floor(rev);
            dst[0] = __builtin_amdgcn_cosf((float)rev); dst[1] = __builtin_amdgcn_sinf((float)rev);
        }
        bf16_t* RWT = (bf16_t*)(p.ws + WS_RWT); const float* rw = p.inp(26);
        for (int q = gt; q < 2 * 64 * DM; q += ngt) { const int L = q / (64 * DM), r = q % (64 * DM), e = r / DM, k = r % DM;
            const float w = rw[((size_t)L * DM + k) * 64 + e]; const bf16_t hi = f2bf(w); const bf16_t lo = f2bf(w - bf2f(hi));
            RWT[((size_t)(L * 2 + 0) * 64 + e) * DM + k] = hi; RWT[((size_t)(L * 2 + 1) * 64 + e) * DM + k] = lo; }
    }
    {
        const float* cvec = p.inp(1); const float* cctx = p.inp(3); const float* mw = p.inp(4);
        float* MODP = (float*)(p.ws + WS_MODP);
        for (int task = C.gw; task < 2 * 32 * 48; task += C.ngw) {
            const int L = task / (32 * 48), r = task % (32 * 48), kb = r / 48, cb = r % 48;
            const float sc = siluf_(cvec[64 * kb + C.lane]), sx = siluf_(cctx[64 * kb + C.lane]);
            f32x4 a0 = {0.f, 0.f, 0.f, 0.f}, a1 = {0.f, 0.f, 0.f, 0.f};
            const float* wp = mw + ((size_t)L * DM + 64 * kb) * 12288 + 256 * cb + 4 * C.lane;
#pragma unroll 8
            for (int kk = 0; kk < 64; ++kk) { const f32x4 w = *(const f32x4*)(wp + (size_t)kk * 12288);
                const float s0 = __shfl(sc, kk), s1 = __shfl(sx, kk);
                a0 += w * s0; a1 += w * s1; }
            *(f32x4*)(MODP + ((size_t)((L * 32 + kb) * 2 + 0)) * 12288 + 256 * cb + 4 * C.lane) = a0;
            *(f32x4*)(MODP + ((size_t)((L * 32 + kb) * 2 + 1)) * 12288 + 256 * cb + 4 * C.lane) = a1;
        }
    }
    {
        LAS float* scr = (LAS float*)(C.lds + C.wave * 17408);
        constexpr int J0 = (DM / 64) * (EV_IN / 64), J3 = (DM / 64) * (OD_IN / 64);
        for (int it = C.gw; it < J0 + J3; it += C.ngw) {
            const bool l1 = it >= J0; const int r = l1 ? it - J0 : it; const int N = l1 ? OD_IN : EV_IN; const int nblk = N / 64, kb = r / nblk, nb = r % nblk;
            tr_item64_fp8(p.inp(l1 ? 21 : 8), N, (unsigned char*)(p.ws + (l1 ? WS_WIN1 : WS_WIN0)), DM, 64 * kb, 64 * nb, 64 * nb, scr, C.lane, 32.0f);
        }
        LAS float* scr2 = (LAS float*)(C.lds + C.wave * 17408);
        constexpr int I1 = (DM / 64) * (DM / 32), I2 = (1024 / 64) * (1024 / 32), I4 = I1;
        for (int it = C.gw; it < I1 + I2 + I4; it += C.ngw) {
            int r = it;
            if (r < I1) { tr_dense(p.inp(9), DM, DM, (bf16_t*)(p.ws + WS_WOUT0), r, scr2, C.lane); continue; } r -= I1;
            if (r < I2) { tr_dense(p.inp(19), 1024, 1024, (bf16_t*)(p.ws + WS_WGLU), r, scr2, C.lane); continue; } r -= I2;
            tr_dense(p.inp(22), DM, DM, (bf16_t*)(p.ws + WS_WOUT1), r, scr2, C.lane);
        }
    }
}
__device__ __forceinline__ void phase_p1(const Params& p, Ctx& C) {
    const float* MODP = (const float*)(p.ws + WS_MODP); float* MODF = (float*)(p.ws + WS_MODF); const float* mb = p.inp(5);
    for (int q = C.bid * NTHR + C.tid; q < 2 * 2 * 12288; q += C.G * NTHR) { const int L = q / (2 * 12288), v = (q / 12288) & 1, col = q % 12288;
        float s = mb[L * 12288 + col];
        for (int kb = 0; kb < 32; ++kb) s += MODP[((size_t)((L * 32 + kb) * 2 + v)) * 12288 + col];
        MODF[q] = s; }
}
__device__ __forceinline__ const float* modv(const Params& p, int L, int v, int k) { return (const float*)(p.ws + WS_MODF) + (size_t)(L * 2 + v) * 12288 + k * DM; }

__device__ __forceinline__ void stage_vec(LAS float* dst, const float* src, int tid) { *(LAS f32x4*)(dst + 4 * tid) = *(const f32x4*)(src + 4 * tid); }
__device__ __forceinline__ void conv_item(const Params& p, Ctx& C, int L, int it) {
    LAS float* scr = (LAS float*)(C.lds + C.wave * 17408);
    unsigned char* GU = (unsigned char*)(p.ws + WS_GU) + (size_t)L * NEX1 * 1024 * DM; unsigned char* DT = (unsigned char*)(p.ws + WS_DT) + (size_t)L * NEX1 * DM * EHID;
    const int e = it / 768, r = it % 768, which = r >> 8, q = r & 255;
    if (which < 2) {
        const float* W = (e < 64) ? p.inp(28 + which) + ((size_t)(L * 64 + e)) * DM * EHID : p.inp(31 + which) + (size_t)L * DM * EHID;
        const int kb = q >> 3, nb = q & 7, n0 = 64 * nb;
        tr_item64_fp8(W, EHID, GU + (size_t)e * 1024 * DM, DM, 64 * kb, n0, 256 * (n0 >> 7) + (n0 & 127) + (which ? 128 : 0), scr, C.lane);
    } else {
        const float* W = (e < 64) ? p.inp(30) + ((size_t)(L * 64 + e)) * EHID * DM : p.inp(33) + (size_t)L * EHID * DM;
        const int kb = q >> 5, nb = q & 31;
        tr_item64_fp8(W, DM, DT + (size_t)e * DM * EHID, EHID, 64 * kb, 64 * nb, 64 * nb, scr, C.lane);
    }
}
__device__ __forceinline__ void conv_queue(const Params& p, Ctx& C, int quota) {
    unsigned* head = (unsigned*)(p.ws + WS_CTL) + CW_QUEUE + 128;
    const int batch = quota < 8 ? quota : 8;
    for (int done = 0; done < quota; done += batch) {
        int it0 = 0; if (C.lane == 0) it0 = (int)atomicAdd(head, (unsigned)batch);
        it0 = __builtin_amdgcn_readfirstlane(it0);
        if (it0 >= NEX1 * 768) break;
        for (int k = 0; k < batch && it0 + k < NEX1 * 768; ++k) conv_item(p, C, 1, it0 + k);
    }
}
__device__ __forceinline__ void phase_modulate(const Params& p, Ctx& C, int L) {
    unsigned char* XA8 = (unsigned char*)(p.ws + WS_XA);
    const float* X2 = (const float*)(p.ws + WS_HX2);
    LAS float* MV = (LAS float*)C.lds;
    for (int v = 0; v < 2; ++v) { stage_vec(MV + (v * 2 + 0) * DM, modv(p, L, v, 0), C.tid); stage_vec(MV + (v * 2 + 1) * DM, modv(p, L, v, 1), C.tid); }
    __syncthreads();
    for (int r = C.gw; r < TT; r += C.ngw) {
        const int v = r < CTXL ? 1 : 0;
        const float* src = (L == 0) ? (r < CTXL ? p.inp(2) + (size_t)r * DM : p.inp(0) + (size_t)(r - CTXL) * DM) : X2 + (size_t)r * DM;
        const LAS float* sh = MV + (v * 2 + 0) * DM; const LAS float* sc = MV + (v * 2 + 1) * DM;
#pragma unroll
        for (int j = 0; j < 8; ++j) { const int c = 4 * (C.lane + 64 * j);
            const f32x4 x = *(const f32x4*)(src + c), a = *(const LAS f32x4*)(sc + c), b = *(const LAS f32x4*)(sh + c);
            const f32x4 y = x * (a + 1.0f) + b;
            unsigned w = (unsigned)__builtin_amdgcn_cvt_pk_fp8_f32(y[0], y[1], 0, false); w = (unsigned)__builtin_amdgcn_cvt_pk_fp8_f32(y[2], y[3], (int)w, true);
            *(unsigned*)(XA8 + (size_t)r * DM + c) = w; }
    }
    __syncthreads();
    if (L == 0) { for (int it = C.gw; it < NEX1 * 768; it += C.ngw) conv_item(p, C, 0, it); }
    else conv_queue(p, C, 1 << 30);
}

__device__ __forceinline__ void phase_rope0(const Params& p, Ctx& C) {
    bf16_t* QKV = (bf16_t*)(p.ws + WS_BIG + BG_QKV);
    const f32x2* R128 = (const f32x2*)(p.ws + WS_ROPE128);
    for (int r = C.gw; r < TT; r += C.ngw) {
        bf16_t* row = QKV + (size_t)r * EV_IN;
        if (r < CTXL) {
#pragma unroll
            for (int j = 0; j < 2; ++j) { u32x4* q = (u32x4*)(row + 8 * (C.lane + 64 * j)); u32x4 w = *q;
                w.x = cvt_pk_bf16(bflo(w.x) * 0.0625f, bfhi(w.x) * 0.0625f); w.y = cvt_pk_bf16(bflo(w.y) * 0.0625f, bfhi(w.y) * 0.0625f);
                w.z = cvt_pk_bf16(bflo(w.z) * 0.0625f, bfhi(w.z) * 0.0625f); w.w = cvt_pk_bf16(bflo(w.w) * 0.0625f, bfhi(w.w) * 0.0625f); *q = w; }
        } else {
            const int l = r - CTXL, rp = l >> 6, cp = l & 63;
#pragma unroll
            for (int qk = 0; qk < 2; ++qk)
#pragma unroll
                for (int m = 0; m < 8; ++m) { const int pi = C.lane + 64 * m, head = pi >> 7, blk = (pi >> 6) & 1, i = pi & 63;
                    bf16_t* b = row + qk * 1024 + head * 256 + blk * 128 + i;
                    const f32x2 cs = R128[(blk ? cp : rp) * 64 + i];
                    const float x1 = bf2f(b[0]), x2 = bf2f(b[64]); const float sc = qk ? 1.0f : 0.0625f;
                    b[0] = f2bf((x1 * cs.x - x2 * cs.y) * sc); b[64] = f2bf((x1 * cs.y + x2 * cs.x) * sc); }
        }
    }
}

__device__ __forceinline__ void phase_normrope1(const Params& p, Ctx& C) {
    bf16_t* QKV = (bf16_t*)(p.ws + WS_BIG + BG_QKV);
    const f32x2* R64 = (const f32x2*)(p.ws + WS_ROPE64);
    const float* qg = p.inp(23);
    unsigned* KMAX = (unsigned*)(p.ws + WS_CTL) + CW_KMAX;
    unsigned char* Q8 = (unsigned char*)(p.ws + WS_BIG + BG_Q8); unsigned char* K8 = (unsigned char*)(p.ws + WS_BIG + BG_K8); unsigned char* VT8 = (unsigned char*)(p.ws + WS_BIG + BG_VT8);
    unsigned char* Q8D = (unsigned char*)(p.ws + WS_BIG + BG_Q8D); unsigned char* K8D = (unsigned char*)(p.ws + WS_BIG + BG_K8D); unsigned char* VT8D = (unsigned char*)(p.ws + WS_BIG + BG_VT8D);
    const int lane = C.lane, i32 = lane & 31; const bool up = lane >= 32;
    const float g00 = qg[lane], g01 = qg[64 + lane], g10 = qg[128 + lane], g11 = qg[128 + 64 + lane];
    for (int r = C.gw; r < TT; r += C.ngw) {
        bf16_t* row = QKV + (size_t)r * OD_IN;
        const bool lat = r >= CTXL; const int l = r - CTXL, rp = lat ? (l >> 6) : 0, cp = lat ? (l & 63) : 0;
        const f32x2 cr = R64[rp * 32 + i32], cc = R64[cp * 32 + i32];
#pragma unroll 2
        for (int h = 0; h < 26; ++h) {
            const int col = h < 8 ? 128 * h : (h < 10 ? 1024 + 128 * (h - 8) : (h < 18 ? 1536 + 128 * (h - 10) : 2560 + 128 * (h - 18)));
            bf16_t* b = row + col;
            float v0 = bf2f(b[lane]), v1 = bf2f(b[64 + lane]);
            if (h < 10) { const float ss = wave_sum(v0 * v0 + v1 * v1); const float rs = rsqrtf(ss * (1.0f / 128.0f) + LN_EPS);
                v0 = bf2f(f2bf(v0 * rs)) * (h < 8 ? g00 : g10); v1 = bf2f(f2bf(v1 * rs)) * (h < 8 ? g01 : g11); }
            if (lat) { const float p0 = __shfl_xor(v0, 32), p1 = __shfl_xor(v1, 32);
                v0 = up ? (p0 * cr.y + v0 * cr.x) : (v0 * cr.x - p0 * cr.y);
                v1 = up ? (p1 * cc.y + v1 * cc.x) : (v1 * cc.x - p1 * cc.y); }
            const bf16_t o0 = f2bf(v0), o1 = f2bf(v1);
            b[lane] = o0; b[64 + lane] = o1;
            {
                const float qs = (h < 8 || (h >= 10 && h < 18)) ? 0.088388347648318440f * 1.4426950408889634f : 1.0f;
                const float w0 = bf2f(o0) * qs, w1 = bf2f(o1) * qs;
                float e4[4];
#pragma unroll
                for (int j = 0; j < 4; ++j) { const float a = __shfl(w0, (4 * lane + j) & 63), c2 = __shfl(w1, (4 * lane + j) & 63); e4[j] = lane < 16 ? a : c2; }
                unsigned pk = (unsigned)__builtin_amdgcn_cvt_pk_fp8_f32(e4[0], e4[1], 0, false); pk = (unsigned)__builtin_amdgcn_cvt_pk_fp8_f32(e4[2], e4[3], (int)pk, true);
                unsigned char* dst8 = h < 8 ? Q8 + (size_t)r * 1024 + 128 * h : (h < 10 ? K8 + (size_t)r * 256 + 128 * (h - 8) : (h < 18 ? Q8D + (size_t)r * 1024 + 128 * (h - 10) : K8D + (size_t)r * 1024 + 128 * (h - 18)));
                if (lane < 32) *(unsigned*)(dst8 + 4 * lane) = pk; }
            if ((h >= 8 && h < 10) || h >= 18) {
                const float w0 = bf2f(o0), w1 = bf2f(o1); const float k2 = wave_sum(w0 * w0 + w1 * w1);
                if (lane == 0) atomicMax(KMAX + 64 * (h < 10 ? h - 8 : h - 16), __float_as_uint(k2)); }
        }
    }
    LAS bf16_t* vt = (LAS bf16_t*)(C.lds + C.wave * 17408);
    for (int item = C.gw; item < 10 * 260; item += C.ngw) {
        const int kh = item / 260, T = item % 260;
        const int vcol = kh < 2 ? 1280 + 128 * kh : 3584 + 128 * (kh - 2);
        unsigned char* vout = kh < 2 ? VT8 + (size_t)kh * 260 * 8192 : VT8D + (size_t)(kh - 2) * 260 * 8192;
#pragma unroll
        for (int q = 0; q < 16; ++q) { const int idx = lane + 64 * q, key = idx >> 4, c = idx & 15;
            *(LAS u32x4*)(vt + key * 136 + 8 * c) = *(const u32x4*)(QKV + (size_t)(64 * T + key) * OD_IN + vcol + 8 * c); }
        LDS_WAIT(); asm volatile("" ::: "memory");
#pragma unroll
        for (int dd = 0; dd < 2; ++dd) { const int d = lane + 64 * dd;
            unsigned char* dst = vout + ((size_t)T * 128 + d) * 64;
#pragma unroll
            for (int cch = 0; cch < 4; ++cch) { u32x4 w;
#pragma unroll
                for (int wd = 0; wd < 4; ++wd) { float f[4];
#pragma unroll
                    for (int e = 0; e < 4; ++e) { const int bb = 16 * cch + 4 * wd + e, hi2 = bb >> 5, blk = (bb >> 4) & 1, j = bb & 15; const int key = 32 * blk + (j & 3) + 8 * (j >> 2) + 4 * hi2;
                        f[e] = bf2f(vt[key * 136 + d]); }
                    unsigned pk = (unsigned)__builtin_amdgcn_cvt_pk_fp8_f32(f[0], f[1], 0, false); pk = (unsigned)__builtin_amdgcn_cvt_pk_fp8_f32(f[2], f[3], (int)pk, true);
                    w[wd] = pk; }
                *(u32x4*)(dst + 16 * cch) = w; } }
        LDS_WAIT(); asm volatile("" ::: "memory");
    }
}

__device__ __forceinline__ void phase_merge1(const Params& p, Ctx& C) {
    bf16_t* ATT = (bf16_t*)(p.ws + WS_BIG + BG_ATT);
    const float* dl = p.inp(24); const float* sg = p.inp(25);
    const int lane = C.lane;
    float d0 = dl[lane] * dl[128 + lane] + dl[64 + lane] * dl[128 + 64 + lane];
    float d1 = dl[256 + lane] * dl[384 + lane] + dl[256 + 64 + lane] * dl[384 + 64 + lane];
    const float lam = __expf(wave_sum(d0)) - __expf(wave_sum(d1)) + LAMBDA_INIT;
    const f32x4 gg = *(const f32x4*)(sg + 4 * lane);
    for (int l = C.gw; l < SEQ; l += C.ngw) {
        bf16_t* row = ATT + (size_t)l * 3072;
#pragma unroll
        for (int h = 0; h < 4; ++h) {
            const u32x2 a = *(const u32x2*)(row + 1024 + 256 * h + 4 * lane), b = *(const u32x2*)(row + 2048 + 256 * h + 4 * lane);
            f32x4 o = {bflo(a.x) - lam * bflo(b.x), bfhi(a.x) - lam * bfhi(b.x), bflo(a.y) - lam * bflo(b.y), bfhi(a.y) - lam * bfhi(b.y)};
            const float ss = wave_sum(o[0] * o[0] + o[1] * o[1] + o[2] * o[2] + o[3] * o[3]);
            const float rs = rsqrtf(ss * (1.0f / 256.0f) + LN_EPS) * (1.0f - LAMBDA_INIT);
            o = o * rs * gg;
            u32x2 w; w.x = cvt_pk_bf16(o[0], o[1]); w.y = cvt_pk_bf16(o[2], o[3]);
            *(u32x2*)(row + 1024 + 256 * h + 4 * lane) = w;
        }
    }
}

__device__ __forceinline__ void phase_ln1(const Params& p, Ctx& C, int L) {
    const bf16_t* Y = (const bf16_t*)(p.ws + WS_YMIX); float* X1 = (float*)(p.ws + WS_X1); unsigned char* XA8 = (unsigned char*)(p.ws + WS_XA);
    const float* X2 = (const float*)(p.ws + WS_HX2);
    const float* lg = p.inp(6) + (size_t)(L * 2 + 0) * DM; const float* lb = p.inp(7) + (size_t)(L * 2 + 0) * DM;
    const int r0 = (L == 0) ? 0 : CTXL;
    LAS float* MV = (LAS float*)C.lds; LAS float* LG = MV + 6 * DM; LAS float* LB = LG + DM;
    for (int v = 0; v < 2; ++v) for (int k = 0; k < 3; ++k) stage_vec(MV + (v * 3 + k) * DM, modv(p, L, v, 2 + k), C.tid);
    stage_vec(LG, lg, C.tid); stage_vec(LB, lb, C.tid);
    __syncthreads();
    for (int r = r0 + C.gw; r < TT; r += C.ngw) {
        const int v = r < CTXL ? 1 : 0;
        const float* src = (L == 0) ? (r < CTXL ? p.inp(2) + (size_t)r * DM : p.inp(0) + (size_t)(r - CTXL) * DM) : X2 + (size_t)r * DM;
        const LAS float* g1 = MV + (v * 3 + 0) * DM; const LAS float* sh2 = MV + (v * 3 + 1) * DM; const LAS float* sc2 = MV + (v * 3 + 2) * DM;
        f32x4 t[8]; float s = 0.f;
#pragma unroll
        for (int j = 0; j < 8; ++j) { const int c = 4 * (C.lane + 64 * j);
            const f32x4 x = *(const f32x4*)(src + c), g = *(const LAS f32x4*)(g1 + c); const u32x2 yy = *(const u32x2*)(Y + (size_t)r * DM + c);
            const f32x4 y = {bflo(yy.x), bfhi(yy.x), bflo(yy.y), bfhi(yy.y)};
            t[j] = x * ALPHA + g * y; s += (t[j][0] + t[j][1]) + (t[j][2] + t[j][3]); }
        const float mean = wave_sum(s) * (1.0f / DM); float s2 = 0.f;
#pragma unroll
        for (int j = 0; j < 8; ++j) { t[j] = t[j] - mean; s2 += (t[j][0] * t[j][0] + t[j][1] * t[j][1]) + (t[j][2] * t[j][2] + t[j][3] * t[j][3]); }
        const float rstd = rsqrtf(wave_sum(s2) * (1.0f / DM) + LN_EPS);
#pragma unroll
        for (int j = 0; j < 8; ++j) { const int c = 4 * (C.lane + 64 * j);
            const f32x4 x1 = t[j] * rstd * *(const LAS f32x4*)(LG + c) + *(const LAS f32x4*)(LB + c);
            *(f32x4*)(X1 + (size_t)r * DM + c) = x1;
            const f32x4 z = x1 * (*(const LAS f32x4*)(sc2 + c) + 1.0f) + *(const LAS f32x4*)(sh2 + c);
            unsigned w = (unsigned)__builtin_amdgcn_cvt_pk_fp8_f32(z[0], z[1], 0, false); w = (unsigned)__builtin_amdgcn_cvt_pk_fp8_f32(z[2], z[3], (int)w, true);
            *(unsigned*)(XA8 + (size_t)r * DM + c) = w; }
    }
    __syncthreads();
}

__device__ __forceinline__ void phase_combine(const Params& p, Ctx& C, int L, LAS unsigned char* misc) {
    const unsigned char* YM = (const unsigned char*)(p.ws + WS_BIG + BG_YMOE); const float* X1 = (const float*)(p.ws + WS_X1);
    float* X2 = (float*)(p.ws + WS_HX2);
    const float* lg = p.inp(6) + (size_t)(L * 2 + 1) * DM; const float* lb = p.inp(7) + (size_t)(L * 2 + 1) * DM;
    const unsigned* PK = (const unsigned*)(p.ws + WS_WGT); const int* cnt = (const int*)(p.ws + WS_CTL) + CW_CNT + L * 128;
    const int r0 = (L == 0) ? 0 : CTXL;
    LAS int* rb = (LAS int*)(misc + 64);
    LAS float* MV = (LAS float*)C.lds; LAS float* LG = MV + 2 * DM; LAS float* LB = LG + DM;
    __syncthreads();
    if (C.tid == 0) { int q = 0; for (int e = 0; e < NEX1; ++e) { rb[e] = q; q += cnt[e]; } }
    stage_vec(MV, modv(p, L, 0, 5), C.tid); stage_vec(MV + DM, modv(p, L, 1, 5), C.tid); stage_vec(LG, lg, C.tid); stage_vec(LB, lb, C.tid);
    LAS float* M1 = LB + DM;
    unsigned char* XA8 = (unsigned char*)(p.ws + WS_XA);
    if (L == 0) { for (int v = 0; v < 2; ++v) { stage_vec(M1 + (v * 2 + 0) * DM, modv(p, 1, v, 0), C.tid); stage_vec(M1 + (v * 2 + 1) * DM, modv(p, 1, v, 1), C.tid); } }
    __syncthreads();
    for (int r = r0 + C.gw; r < TT; r += C.ngw) {
        const int v = r < CTXL ? 1 : 0;
        const LAS float* g2 = MV + v * DM;
        int ln = C.lane; asm volatile("" : "+v"(ln));
        int slot = rb[64] + (r - r0);
        if (ln < 8) { const unsigned pk = PK[(size_t)r * 8 + ln]; slot = rb[pk >> 16] + (int)(pk & 0xffffu); }
        f32x4 t[2][4]; float s = 0.f;
#pragma unroll
        for (int j = 0; j < 2; ++j) { const int c = 16 * (ln + 64 * j);
            u32x4 yy[9];
#pragma unroll
            for (int k = 0; k < 9; ++k) { const size_t a = (size_t)__builtin_amdgcn_readlane(slot, k); yy[k] = __builtin_nontemporal_load((const u32x4*)(YM + a * DM + c)); }
            f32x2 f[8];
#pragma unroll
            for (int q = 0; q < 8; ++q) f[q] = (f32x2){0.f, 0.f};
#pragma unroll
            for (int k = 0; k < 9; ++k) {
                f[0] += __builtin_amdgcn_cvt_pk_f32_fp8((int)yy[k].x, false); f[1] += __builtin_amdgcn_cvt_pk_f32_fp8((int)yy[k].x, true);
                f[2] += __builtin_amdgcn_cvt_pk_f32_fp8((int)yy[k].y, false); f[3] += __builtin_amdgcn_cvt_pk_f32_fp8((int)yy[k].y, true);
                f[4] += __builtin_amdgcn_cvt_pk_f32_fp8((int)yy[k].z, false); f[5] += __builtin_amdgcn_cvt_pk_f32_fp8((int)yy[k].z, true);
                f[6] += __builtin_amdgcn_cvt_pk_f32_fp8((int)yy[k].w, false); f[7] += __builtin_amdgcn_cvt_pk_f32_fp8((int)yy[k].w, true); }
#pragma unroll
            for (int q = 0; q < 4; ++q) { const f32x4 x = *(const f32x4*)(X1 + (size_t)r * DM + c + 4 * q), g = *(const LAS f32x4*)(g2 + c + 4 * q);
                const f32x4 ff = {f[2 * q][0], f[2 * q][1], f[2 * q + 1][0], f[2 * q + 1][1]};
                t[j][q] = x * ALPHA + g * ff; s += (t[j][q][0] + t[j][q][1]) + (t[j][q][2] + t[j][q][3]); } }
        const float mean = wave_sum(s) * (1.0f / DM); float s2 = 0.f;
#pragma unroll
        for (int j = 0; j < 2; ++j)
#pragma unroll
            for (int q = 0; q < 4; ++q) { t[j][q] = t[j][q] - mean; s2 += (t[j][q][0] * t[j][q][0] + t[j][q][1] * t[j][q][1]) + (t[j][q][2] * t[j][q][2] + t[j][q][3] * t[j][q][3]); }
        const float rstd = rsqrtf(wave_sum(s2) * (1.0f / DM) + LN_EPS);
        float* dst = (L == 0) ? X2 + (size_t)r * DM : p.out + (size_t)(r - CTXL) * DM;
#pragma unroll
        for (int j = 0; j < 2; ++j)
#pragma unroll
            for (int q = 0; q < 4; ++q) { const int c = 16 * (ln + 64 * j) + 4 * q;
                const f32x4 xn = t[j][q] * rstd * *(const LAS f32x4*)(LG + c) + *(const LAS f32x4*)(LB + c);
                *(f32x4*)(dst + c) = xn;
                if (L == 0) { const f32x4 y = xn * (*(const LAS f32x4*)(M1 + (v * 2 + 1) * DM + c) + 1.0f) + *(const LAS f32x4*)(M1 + (v * 2 + 0) * DM + c);
                    unsigned w = (unsigned)__builtin_amdgcn_cvt_pk_fp8_f32(y[0], y[1], 0, false); w = (unsigned)__builtin_amdgcn_cvt_pk_fp8_f32(y[2], y[3], (int)w, true);
                    *(unsigned*)(XA8 + (size_t)r * DM + c) = w; } }
    }
    if (L == 0) { __syncthreads(); conv_queue(p, C, 1 << 30); }
}
constexpr int RLD = 264;
constexpr int SLD = 136;

template <bool SCALE>
__device__ __forceinline__ void stage_chunk(const bf16_t* QKV, int row0, int col0, LAS bf16_t* dst, int tid, float lg  , int dirb) {
#pragma unroll
    for (int q = 0; q < 8; ++q) { const int idx = tid + NTHR * q, r = idx >> 5, c = idx & 31;
        u32x4 w = *(const u32x4*)(QKV + (size_t)(row0 + r) * EV_IN + col0 + 8 * c);
        if (SCALE) { const float sc = fast_exp((dirb ? (float)r : (float)(127 - r)) * lg);
            w.x = cvt_pk_bf16(bflo(w.x) * sc, bfhi(w.x) * sc); w.y = cvt_pk_bf16(bflo(w.y) * sc, bfhi(w.y) * sc);
            w.z = cvt_pk_bf16(bflo(w.z) * sc, bfhi(w.z) * sc); w.w = cvt_pk_bf16(bflo(w.w) * sc, bfhi(w.w) * sc); }
        *(LAS u32x4*)(dst + r * RLD + 8 * c) = w; }
}

__device__ __forceinline__ void ret_chunk_kv(const Params& p, Ctx& C) {
    const bf16_t* QKV = (const bf16_t*)(p.ws + WS_BIG + BG_QKV); bf16_t* CKV = (bf16_t*)(p.ws + WS_BIG + BG_CKV);
    const float* rld = p.inp(10);
    LAS bf16_t* Vs = (LAS bf16_t*)C.lds; LAS bf16_t* Ks = Vs + 128 * RLD;
    const int lane = C.lane, w = C.wave;
    for (int unit = C.bid; unit < 130 * 8; unit += C.G) {
        const int u = unit >> 3, h = (unit >> 1) & 3, dir = unit & 1;
        const float lg = rld[dir * 4 + h];
        __syncthreads();
        stage_chunk<false>(QKV, 128 * u, 2048 + 256 * h, Vs, C.tid, 0.f, 0);
        stage_chunk<true>(QKV, 128 * u, 1024 + 256 * h, Ks, C.tid, lg, dir);
        __syncthreads();
        f32x4 acc[2][16];
#pragma unroll
        for (int a = 0; a < 2; ++a)
#pragma unroll
            for (int b = 0; b < 16; ++b) acc[a][b] = (f32x4){0.f, 0.f, 0.f, 0.f};
        const unsigned vbase = (unsigned)(uintptr_t)Vs, kbase = (unsigned)(uintptr_t)Ks;
#pragma unroll 1
        for (int ks = 0; ks < 4; ++ks) {
            bf16x8 af[2];
#pragma unroll
            for (int a = 0; a < 2; ++a) af[a] = frag_colk_l(vbase + (unsigned)((32 * ks) * RLD + 32 * w + 16 * a) * 2u, RLD * 2, lane);
#pragma unroll
            for (int b = 0; b < 16; ++b) { const bf16x8 bf = frag_colk_l(kbase + (unsigned)((32 * ks) * RLD + 16 * b) * 2u, RLD * 2, lane);
                acc[0][b] = MFMA16(bf, af[0], acc[0][b]); acc[1][b] = MFMA16(bf, af[1], acc[1][b]); }
        }
        bf16_t* dst = CKV + ((size_t)((dir * 4 + h) * 130 + u)) * 65536;
#pragma unroll
        for (int a = 0; a < 2; ++a)
#pragma unroll
            for (int b = 0; b < 16; ++b) { u32x2 w2; w2.x = cvt_pk_bf16(acc[a][b][0], acc[a][b][1]); w2.y = cvt_pk_bf16(acc[a][b][2], acc[a][b][3]);
                *(u32x2*)(dst + (size_t)(32 * w + 16 * a + (lane & 15)) * 256 + 16 * b + 4 * (lane >> 4)) = w2; }
    }
    __syncthreads();
}

__device__ __forceinline__ int s5_row(int dir, int c, int s) { return dir == 0 ? 64 * c + s : (c < 4 ? 255 - (64 * c + s) : 16639 - 64 * (c - 4) - s); }

__device__ __forceinline__ void s5_end_states(const Params& p, Ctx& C) {
    const bf16_t* QKV = (const bf16_t*)(p.ws + WS_BIG + BG_QKV); const bf16_t* BBT = (const bf16_t*)(p.ws + WS_BBT); float* E = (float*)(p.ws + WS_S5E);
    const float* APOW = (const float*)(p.ws + WS_APOW);
    LAS f32x2* PL = (LAS f32x2*)C.lds;
    for (int bt = C.bid; bt < 256; bt += C.G) {
        int tid = C.tid; asm volatile("" : "+v"(tid));
        const int lane = tid & 63, r32 = lane & 31, hi = lane >> 5;
        const int dg = bt >> 1, dir = dg >> 6, g = dg & 63, c0 = 130 * (bt & 1);
        __syncthreads();
#pragma unroll
        for (int q = 0; q < 8; ++q) { const int idx = tid + NTHR * q, s = idx >> 6, pp = idx & 63;
            PL[idx] = (s == 63) ? (f32x2){1.0f, 0.0f} : *(const f32x2*)(APOW + ((size_t)dg * 64 + (62 - s)) * 128 + 2 * pp); }
        __syncthreads();
        bf16x8 bfr[4];
#pragma unroll
        for (int pt = 0; pt < 4; ++pt) bfr[pt] = *(const bf16x8*)(BBT + ((size_t)dg * 128 + 32 * pt + r32) * 16 + 8 * hi);
        for (int c = c0 + C.wave; c < c0 + 130; c += 8) {
            float er[2] = {0.f, 0.f}, ei[2] = {0.f, 0.f};
#pragma unroll
            for (int st = 0; st < 2; ++st) {
                const bf16x8 a = *(const bf16x8*)(QKV + (size_t)s5_row(dir, c, 32 * st + r32) * EV_IN + 4096 + 16 * g + 8 * hi);
                f32x16 d[4];
#pragma unroll
                for (int pt = 0; pt < 4; ++pt) d[pt] = __builtin_amdgcn_mfma_f32_32x32x16_bf16(a, bfr[pt], (f32x16){}, 0, 0, 0);
#pragma unroll
                for (int r = 0; r < 16; ++r) { const int s = 32 * st + (r & 3) + 8 * (r >> 2) + 4 * hi;
#pragma unroll
                    for (int pt = 0; pt < 2; ++pt) { const f32x2 pw = PL[s * 64 + 32 * pt + r32]; const float br = d[pt][r], bi = d[pt + 2][r];
                        er[pt] += pw.x * br - pw.y * bi; ei[pt] += pw.x * bi + pw.y * br; } }
            }
#pragma unroll
            for (int pt = 0; pt < 2; ++pt) {
                { auto rr = __builtin_amdgcn_permlane32_swap(__float_as_uint(er[pt]), __float_as_uint(er[pt]), false, false); er[pt] = __uint_as_float(rr[0]) + __uint_as_float(rr[1]); }
                { auto rr = __builtin_amdgcn_permlane32_swap(__float_as_uint(ei[pt]), __float_as_uint(ei[pt]), false, false); ei[pt] = __uint_as_float(rr[0]) + __uint_as_float(rr[1]); }
            }
            float* dst = E + ((size_t)dg * 260 + c) * 128;
            if (hi == 0) { dst[r32] = er[0]; dst[32 + r32] = er[1]; dst[64 + r32] = ei[0]; dst[96 + r32] = ei[1]; }
        }
    }
    __syncthreads();
}

__device__ __forceinline__ void phase_scans(const Params& p, Ctx& C) {
    const bf16_t* CKV = (const bf16_t*)(p.ws + WS_BIG + BG_CKV); bf16_t* SP = (bf16_t*)(p.ws + WS_BIG + BG_SPREV);
    const float* rld = p.inp(10);
    for (int q = C.bid * NTHR + C.tid; q < 8 * 16384; q += C.G * NTHR) {
        const int dh = q >> 14, el = (q & 16383) * 4, dir = dh >> 2, h = dh & 3;
        const float gch = fast_exp(128.0f * rld[dir * 4 + h]);
        const bf16_t* src = CKV + (size_t)dh * 130 * 65536 + el; bf16_t* dst = SP + (size_t)dh * 130 * 65536 + el;
        f32x4 s = {0.f, 0.f, 0.f, 0.f};
        for (int st0 = 0; st0 < 130; st0 += 13) {
            u32x2 kv[13];
#pragma unroll
            for (int k = 0; k < 13; ++k) { const int st = st0 + k; const int u = dir == 0 ? st : (st == 0 ? 1 : (st == 1 ? 0 : 131 - st)); kv[k] = __builtin_nontemporal_load((const u32x2*)(src + (size_t)u * 65536)); }
#pragma unroll
            for (int k = 0; k < 13; ++k) { const int st = st0 + k; const int u = dir == 0 ? st : (st == 0 ? 1 : (st == 1 ? 0 : 131 - st));
                u32x2 w; w.x = cvt_pk_bf16(s[0], s[1]); w.y = cvt_pk_bf16(s[2], s[3]); *(u32x2*)(dst + (size_t)u * 65536) = w;
                s = s * gch + (f32x4){bflo(kv[k].x), bfhi(kv[k].x), bflo(kv[k].y), bfhi(kv[k].y)}; }
        }
    }
    const float* E = (const float*)(p.ws + WS_S5E); float* HST = (float*)(p.ws + WS_HST); const float* AL = (const float*)(p.ws + WS_AL);
    for (int q = C.bid * NTHR + C.tid; q < 2 * 64 * 64; q += C.G * NTHR) {
        const int dg = q >> 6, pp = q & 63;
        const f32x2 al = *(const f32x2*)(AL + (size_t)dg * 128 + 2 * pp);
        const float* e = E + (size_t)dg * 260 * 128; float* hs = HST + (size_t)dg * 260 * 128;
        float hr = 0.f, hi = 0.f;
        for (int c0 = 0; c0 < 260; c0 += 26) {
            float er[26], ei[26];
#pragma unroll
            for (int k = 0; k < 26; ++k) { er[k] = e[(size_t)(c0 + k) * 128 + pp]; ei[k] = e[(size_t)(c0 + k) * 128 + 64 + pp]; }
#pragma unroll
            for (int k = 0; k < 26; ++k) { *(f32x2*)(hs + (size_t)(c0 + k) * 128 + 2 * pp) = (f32x2){hr, hi};
                const float t = al.x * hr - al.y * hi + er[k]; hi = al.x * hi + al.y * hr + ei[k]; hr = t; }
        }
    }
}

__device__ __forceinline__ void ret_output_unit(const Params& p, Ctx& C, int unit) {
    const bf16_t* QKV = (const bf16_t*)(p.ws + WS_BIG + BG_QKV); const bf16_t* SP = (const bf16_t*)(p.ws + WS_BIG + BG_SPREV);
    bf16_t* MIX = (bf16_t*)(p.ws + WS_BIG + BG_MIX);
    const float* rld = p.inp(10);
    LAS bf16_t* RA = (LAS bf16_t*)C.lds; LAS bf16_t* RB = RA + 128 * RLD;
    int tid = C.tid; asm volatile("" : "+v"(tid));
    const int lane = tid & 63, w = C.wave, kq = lane >> 4, fr = lane & 15;
    const int u = unit >> 2, h = unit & 3;
    const float lgf = rld[h], lgb = rld[4 + h];
    stage_chunk<false>(QKV, 128 * u, 256 * h, RA, tid, 0.f, 0);
    int ib = 16 * w + 4 * kq, jb = fr; asm volatile("" : "+v"(ib), "+v"(jb));
    f32x4 acc[16];
#pragma unroll
    for (int t = 0; t < 16; ++t) acc[t] = (f32x4){0.f, 0.f, 0.f, 0.f};
#pragma unroll
    for (int dir = 0; dir < 2; ++dir) {
        const bf16_t* Sd = SP + ((size_t)((dir * 4 + h) * 130 + u)) * 65536;
#pragma unroll
        for (int eh = 0; eh < 2; ++eh) {
            __syncthreads();
#pragma unroll
            for (int q = 0; q < 8; ++q) { const int idx = tid + NTHR * q, rr = idx >> 5, c = idx & 31;
                *(LAS u32x4*)(RB + rr * RLD + 8 * c) = *(const u32x4*)(Sd + (size_t)(128 * eh + rr) * 256 + 8 * c);
                if (q == 3) asm volatile("" ::: "memory"); }
            __syncthreads();
#pragma unroll 1
            for (int ks = 0; ks < 8; ++ks) { const bf16x8 af = frag_rowk_l(RA + (16 * w) * RLD + 32 * ks, RLD, lane);
#pragma unroll
                for (int t = 0; t < 8; ++t) { const bf16x8 bf = frag_rowk_l(RB + (16 * t) * RLD + 32 * ks, RLD, lane); acc[8 * eh + t] = MFMA16(af, bf, acc[8 * eh + t]); } }
        }
#pragma unroll
        for (int r = 0; r < 4; ++r) { const int i = ib + r; const float qd = fast_exp((float)(128 - i) * lgb);
            const float f = (dir == 0) ? fast_exp((float)(i + 1) * lgf) / qd : qd;
#pragma unroll
            for (int t = 0; t < 16; ++t) acc[t][r] *= f; }
    }
    __syncthreads();
    stage_chunk<false>(QKV, 128 * u, 1024 + 256 * h, RB, tid, 0.f, 0);
    __syncthreads();
    f32x4 sc[8];
#pragma unroll
    for (int t = 0; t < 8; ++t) sc[t] = (f32x4){0.f, 0.f, 0.f, 0.f};
#pragma unroll 1
    for (int ks = 0; ks < 8; ++ks) { const bf16x8 af = frag_rowk_l(RA + (16 * w) * RLD + 32 * ks, RLD, lane);
#pragma unroll
        for (int t = 0; t < 8; ++t) { const bf16x8 bf = frag_rowk_l(RB + (16 * t) * RLD + 32 * ks, RLD, lane); sc[t] = MFMA16(af, bf, sc[t]); } }
#pragma unroll
    for (int t = 0; t < 8; ++t)
#pragma unroll
        for (int r = 0; r < 4; ++r) { const int i = ib + r, j = 16 * t + jb; const float d = (float)(i - j);
            const float m = (i >= j ? fast_exp(d * lgf) : 0.f) + (j >= i ? fast_exp(-d * lgb) : 0.f); sc[t][r] *= m; }
    __syncthreads();
    stage_chunk<false>(QKV, 128 * u, 2048 + 256 * h, RA, tid, 0.f, 0);
#pragma unroll
    for (int t = 0; t < 8; ++t)
#pragma unroll
        for (int r = 0; r < 4; ++r) RB[(16 * w + 4 * kq + r) * SLD + 16 * t + fr] = f2bf(sc[t][r]);
    __syncthreads();
    const unsigned vbase = (unsigned)(uintptr_t)RA;
#pragma unroll 1
    for (int ks = 0; ks < 4; ++ks) { const bf16x8 af = frag_rowk_l(RB + (16 * w) * SLD + 32 * ks, SLD, lane);
#pragma unroll
        for (int t = 0; t < 16; ++t) { const bf16x8 bf = frag_colk_l(vbase + (unsigned)((32 * ks) * RLD + 16 * t) * 2u, RLD * 2, lane); acc[t] = MFMA16(af, bf, acc[t]); } }
    __syncthreads();
#pragma unroll
    for (int r = 0; r < 4; ++r) {
        float s = 0.f;
#pragma unroll
        for (int t = 0; t < 16; ++t) s += acc[t][r];
        s += __shfl_xor(s, 1); s += __shfl_xor(s, 2); s += __shfl_xor(s, 4); s += __shfl_xor(s, 8);
        const float mean = s * (1.0f / 256.0f); float q = 0.f;
#pragma unroll
        for (int t = 0; t < 16; ++t) { const float d = acc[t][r] - mean; q += d * d; }
        q += __shfl_xor(q, 1); q += __shfl_xor(q, 2); q += __shfl_xor(q, 4); q += __shfl_xor(q, 8);
        const float rstd = rsqrtf(q * (1.0f / 256.0f) + LN_EPS);
#pragma unroll
        for (int t = 0; t < 16; ++t) RA[(16 * w + 4 * kq + r) * RLD + 16 * t + fr] = f2bf((acc[t][r] - mean) * rstd);
    }
    __syncthreads();
#pragma unroll
    for (int q = 0; q < 8; ++q) { const int idx = tid + NTHR * q, rr = idx >> 5, c = idx & 31; const size_t row = (size_t)(128 * u + rr);
        const u32x4 o = *(const LAS u32x4*)(RA + rr * RLD + 8 * c), g = *(const u32x4*)(QKV + row * EV_IN + 3072 + 256 * h + 8 * c);
        u32x4 w4;
        w4.x = cvt_pk_bf16(bflo(o.x) * siluf_(bflo(g.x)), bfhi(o.x) * siluf_(bfhi(g.x))); w4.y = cvt_pk_bf16(bflo(o.y) * siluf_(bflo(g.y)), bfhi(o.y) * siluf_(bfhi(g.y)));
        w4.z = cvt_pk_bf16(bflo(o.z) * siluf_(bflo(g.z)), bfhi(o.z) * siluf_(bfhi(g.z))); w4.w = cvt_pk_bf16(bflo(o.w) * siluf_(bflo(g.w)), bfhi(o.w) * siluf_(bfhi(g.w)));
        *(u32x4*)(MIX + row * DM + 256 * h + 8 * c) = w4; }
    __syncthreads();
}

constexpr int KLD = 1032;
__device__ __forceinline__ void s5_output_task(const Params& p, Ctx& C, int bt) {
    const bf16_t* QKV = (const bf16_t*)(p.ws + WS_BIG + BG_QKV); bf16_t* Z = (bf16_t*)(p.ws + WS_Z);
    const bf16_t* KN = (const bf16_t*)(p.ws + WS_KN); const bf16_t* CCt = (const bf16_t*)(p.ws + WS_CC);
    const float* APOW = (const float*)(p.ws + WS_APOW); const float* HST = (const float*)(p.ws + WS_HST); const float* dsk = p.inp(18);
    int tid = C.tid; asm volatile("" : "+v"(tid));
    const int lane = tid & 63, kq = lane >> 4, fr = lane & 15;
    LAS bf16_t* KF = (LAS bf16_t*)C.lds; LAS bf16_t* KB = KF + 16 * KLD;
    LAS bf16_t* U = KB + 16 * KLD + C.wave * 3072;
    LAS float* PW0 = (LAS float*)(KB + 16 * KLD + 8 * 3072);
    LAS float* PW16 = PW0 + 2 * 16 * 128;
    {
        const int g = bt >> 3, k0 = (260 * (bt & 7)) >> 3, k1 = (260 * ((bt & 7) + 1)) >> 3;
#pragma unroll
        for (int q = 0; q < 8; ++q) { const int idx = tid + NTHR * q, dir = idx >> 11, rr = (idx >> 7) & 15, c = idx & 127;
            *(LAS u32x4*)((dir ? KB : KF) + rr * KLD + 8 * c) = *(const u32x4*)(KN + ((size_t)(dir * 64 + g) * 16 + rr) * 1024 + 8 * c); }
        for (int q = lane; q < 192 * 2; q += 64) *(LAS u32x4*)(U + 8 * q) = (u32x4){0u, 0u, 0u, 0u};
#pragma unroll
        for (int q = 0; q < 2; ++q) { const int idx = tid + NTHR * q, dir = idx >> 9, f = (idx >> 5) & 15, c4 = idx & 31;
            *(LAS f32x4*)(PW0 + dir * 2048 + f * 128 + 4 * c4) = *(const f32x4*)(APOW + ((size_t)(dir * 64 + g) * 64 + (dir == 0 ? f : 15 - f)) * 128 + 4 * c4); }
        if (tid < 64) { const int dir = tid >> 5, c4 = tid & 31; *(LAS f32x4*)(PW16 + dir * 128 + 4 * c4) = *(const f32x4*)(APOW + ((size_t)(dir * 64 + g) * 64 + 15) * 128 + 4 * c4); }
        __syncthreads();
        const f32x4 dv = *(const f32x4*)(dsk + 16 * g + 4 * kq);
        bf16x8 ccr[2], cci[2];
#pragma unroll
        for (int hb = 0; hb < 2; ++hb) { ccr[hb] = frag_rowk_g(CCt + (size_t)g * 16 * 128 + 32 * hb, 128, lane); cci[hb] = frag_rowk_g(CCt + (size_t)g * 16 * 128 + 64 + 32 * hb, 128, lane); }
        const LAS float* pw0l = PW0 + (size_t)fr * 128 + 16 * kq;
        const LAS float* pw16l = PW16 + 16 * kq;
        for (int k = k0 + C.wave; k < k1; k += 8) {
            LDS_WAIT(); asm volatile("" ::: "memory");
            for (int q = lane; q < 128; q += 64) { const int t = q >> 1, hf = q & 1;
                *(LAS u32x4*)(U + (64 + t) * 16 + 8 * hf) = *(const u32x4*)(QKV + (size_t)(64 * k + t) * EV_IN + 4096 + 16 * g + 8 * hf); }
            LDS_WAIT(); asm volatile("" ::: "memory");
            const int cf = k, cb = k < 4 ? 3 - k : 263 - k;
            f32x4 acc[4];
#pragma unroll
            for (int tt = 0; tt < 4; ++tt) acc[tt] = (f32x4){0.f, 0.f, 0.f, 0.f};
            const LAS bf16_t* ubf = U + (64 + fr - (kq >> 1)) * 16 + 8 * (kq & 1);
            const LAS bf16_t* ubb = U + (64 + fr + (kq >> 1)) * 16 + 8 * (kq & 1);
#pragma unroll
            for (int n0 = 0; n0 < 64; n0 += 2) {
                const bf16x8 af = frag_rowk_l(KF + n0 * 16, KLD, lane), ab = frag_rowk_l(KB + n0 * 16, KLD, lane);
#pragma unroll
                for (int tt = 0; tt < 4; ++tt) {
                    if (n0 <= 16 * tt + 14) acc[tt] = MFMA16(af, *(const LAS bf16x8*)(ubf + (16 * tt - n0) * 16), acc[tt]);
                    if (n0 <= 62 - 16 * tt) acc[tt] = MFMA16(ab, *(const LAS bf16x8*)(ubb + (16 * tt + n0) * 16), acc[tt]);
                }
                asm volatile("" ::: "memory");
            }
#pragma unroll
            for (int dir = 0; dir < 2; ++dir) {
                const float* hp = HST + ((size_t)(dir * 64 + g) * 260 + (dir == 0 ? cf : cb)) * 128;
#pragma unroll
                for (int hb = 0; hb < 2; ++hb) {
                    float xr[8], xi[8];
#pragma unroll
                    for (int e2 = 0; e2 < 4; ++e2) { const f32x4 h4 = *(const f32x4*)(hp + 2 * (32 * hb + 8 * kq) + 4 * e2), b4 = *(const LAS f32x4*)(pw0l + dir * 2048 + hb * 64 + 4 * e2);
                        xr[2 * e2] = b4[0] * h4[0] - b4[1] * h4[1]; xi[2 * e2] = b4[0] * h4[1] + b4[1] * h4[0];
                        xr[2 * e2 + 1] = b4[2] * h4[2] - b4[3] * h4[3]; xi[2 * e2 + 1] = b4[2] * h4[3] + b4[3] * h4[2]; }
#pragma unroll
                    for (int st = 0; st < 4; ++st) {
                        const int tt = dir == 0 ? st : 3 - st;
                        u32x4 br, bi;
                        br.x = cvt_pk_bf16(xr[0], xr[1]); br.y = cvt_pk_bf16(xr[2], xr[3]); br.z = cvt_pk_bf16(xr[4], xr[5]); br.w = cvt_pk_bf16(xr[6], xr[7]);
                        bi.x = cvt_pk_bf16(xi[0], xi[1]); bi.y = cvt_pk_bf16(xi[2], xi[3]); bi.z = cvt_pk_bf16(xi[4], xi[5]); bi.w = cvt_pk_bf16(xi[6], xi[7]);
                        acc[tt] = MFMA16(ccr[hb], __builtin_bit_cast(bf16x8, br), acc[tt]);
                        acc[tt] = MFMA16(cci[hb], __builtin_bit_cast(bf16x8, bi), acc[tt]);
                        if (st < 3) {
#pragma unroll
                            for (int e2 = 0; e2 < 4; ++e2) { const f32x4 a4 = *(const LAS f32x4*)(pw16l + dir * 128 + hb * 64 + 4 * e2);
                                float t0 = xr[2 * e2] * a4[0] - xi[2 * e2] * a4[1]; xi[2 * e2] = xr[2 * e2] * a4[1] + xi[2 * e2] * a4[0]; xr[2 * e2] = t0;
                                t0 = xr[2 * e2 + 1] * a4[2] - xi[2 * e2 + 1] * a4[3]; xi[2 * e2 + 1] = xr[2 * e2 + 1] * a4[3] + xi[2 * e2 + 1] * a4[2]; xr[2 * e2 + 1] = t0; }
                        }
                    }
                }
            }
#pragma unroll
            for (int tt = 0; tt < 4; ++tt) { const int t = 16 * tt + fr;
                const u32x2 uu = *(const LAS u32x2*)(U + (64 + t) * 16 + 4 * kq);
                const float y0 = acc[tt][0] + bflo(uu.x) * dv[0], y1 = acc[tt][1] + bfhi(uu.x) * dv[1], y2 = acc[tt][2] + bflo(uu.y) * dv[2], y3 = acc[tt][3] + bfhi(uu.y) * dv[3];
                u32x2 w; w.x = cvt_pk_bf16(gelu_tanh(y0), gelu_tanh(y1)); w.y = cvt_pk_bf16(gelu_tanh(y2), gelu_tanh(y3));
                *(u32x2*)(Z + (size_t)(64 * k + t) * 1024 + 16 * g + 4 * kq) = w; }
        }
    }
    __syncthreads();
}

__device__ __forceinline__ void phase_ret_s5_outputs(const Params& p, Ctx& C, LAS unsigned char* misc) {
    unsigned* head = (unsigned*)(p.ws + WS_CTL) + CW_QUEUE;
    volatile LAS int* slot = (volatile LAS int*)(misc + 32);
    for (;;) {
        __syncthreads();
        if (C.tid == 0) slot[0] = (int)atomicAdd(head, 1u);
        __syncthreads();
        const int item = __builtin_amdgcn_readfirstlane(slot[0]);
        if (item >= 520) break;
        ret_output_unit(p, C, item);
    }
    for (;;) {
        __syncthreads();
        if (C.tid == 0) slot[0] = (int)atomicAdd(head + 64, 1u);
        __syncthreads();
        const int item = __builtin_amdgcn_readfirstlane(slot[0]);
        if (item >= 512) break;
        s5_output_task(p, C, item);
    }
}
__device__ __forceinline__ void phase_router(const Params& p, Ctx& C, int L) {
    const float* X1 = (const float*)(p.ws + WS_X1);
    const bf16_t* RWh = (const bf16_t*)(p.ws + WS_RWT) + (size_t)(L * 2 + 0) * 64 * DM; const bf16_t* RWl = (const bf16_t*)(p.ws + WS_RWT) + (size_t)(L * 2 + 1) * 64 * DM;
    const float* rbias = p.inp(27) + L * 64;
    int* cnt = (int*)(p.ws + WS_CTL) + CW_CNT + L * 128; int* LIST = (int*)(p.ws + WS_LIST); unsigned* PK = (unsigned*)(p.ws + WS_WGT); float* LW = (float*)(p.ws + WS_LW);
    const int lane = C.lane, kq = lane >> 4, fr = lane & 15;
    LAS float* Lg = (LAS float*)(C.lds + C.wave * 8192);
    const int r0 = (L == 0) ? 0 : CTXL, nrows = TT - r0;
    if (C.bid == 0 && C.tid == 0) cnt[64] = nrows;
    for (int task = C.gw; task < nrows / 16; task += C.ngw) {
        const int rbase = r0 + 16 * task, row = rbase + fr;
        const int v = row < CTXL ? 1 : 0;
        const float* xr = X1 + (size_t)row * DM; const float* sc2 = modv(p, L, v, 4); const float* sh2 = modv(p, L, v, 3);
        f32x4 acc[4];
#pragma unroll
        for (int t = 0; t < 4; ++t) acc[t] = (f32x4){0.f, 0.f, 0.f, 0.f};
#pragma unroll 2
        for (int ks = 0; ks < 64; ++ks) { const int c0 = 32 * ks + 8 * kq;
            const f32x4 x0 = *(const f32x4*)(xr + c0), x1 = *(const f32x4*)(xr + c0 + 4);
            const f32x4 a0 = *(const f32x4*)(sc2 + c0), a1 = *(const f32x4*)(sc2 + c0 + 4), b0 = *(const f32x4*)(sh2 + c0), b1 = *(const f32x4*)(sh2 + c0 + 4);
            const f32x4 y0 = x0 * (a0 + 1.0f) + b0, y1 = x1 * (a1 + 1.0f) + b1;
            u32x4 hi; hi.x = cvt_pk_bf16(y0[0], y0[1]); hi.y = cvt_pk_bf16(y0[2], y0[3]); hi.z = cvt_pk_bf16(y1[0], y1[1]); hi.w = cvt_pk_bf16(y1[2], y1[3]);
            u32x4 lo; lo.x = cvt_pk_bf16(y0[0] - bflo(hi.x), y0[1] - bfhi(hi.x)); lo.y = cvt_pk_bf16(y0[2] - bflo(hi.y), y0[3] - bfhi(hi.y));
            lo.z = cvt_pk_bf16(y1[0] - bflo(hi.z), y1[1] - bfhi(hi.z)); lo.w = cvt_pk_bf16(y1[2] - bflo(hi.w), y1[3] - bfhi(hi.w));
            const bf16x8 ah = __builtin_bit_cast(bf16x8, hi), al = __builtin_bit_cast(bf16x8, lo);
#pragma unroll
            for (int t = 0; t < 4; ++t) { const bf16x8 bh = frag_rowk_g(RWh + (size_t)(16 * t) * DM + 32 * ks, DM, lane), bl = frag_rowk_g(RWl + (size_t)(16 * t) * DM + 32 * ks, DM, lane);
                acc[t] = MFMA16(ah, bh, acc[t]); acc[t] = MFMA16(al, bh, acc[t]); acc[t] = MFMA16(ah, bl, acc[t]); } }
        LDS_WAIT(); asm volatile("" ::: "memory");
#pragma unroll
        for (int t = 0; t < 4; ++t)
#pragma unroll
            for (int r = 0; r < 4; ++r) Lg[(4 * kq + r) * 65 + 16 * t + fr] = acc[t][r];
        LDS_WAIT(); asm volatile("" ::: "memory");
        if (lane < 16) {
            LAS float* sr = Lg + lane * 65; const int trow = rbase + lane;
            float gs[8];
#pragma unroll
            for (int g = 0; g < 8; ++g) { float m1 = -1e30f, m2 = -1e30f;
                for (int j = 0; j < 8; ++j) { const int e = 8 * g + j; const float s = sigmoidf_(sr[e]); sr[e] = s; const float vv = s + rbias[e];
                    if (vv > m1) { m2 = m1; m1 = vv; } else if (vv > m2) m2 = vv; }
                gs[g] = m1 + m2; }
            unsigned gmask = 0u;
#pragma unroll
            for (int it = 0; it < 4; ++it) { float best = -1e30f; int bi = 0;
#pragma unroll
                for (int g = 0; g < 8; ++g) { const bool ok = !((gmask >> g) & 1u) && gs[g] > best; best = ok ? gs[g] : best; bi = ok ? g : bi; }
                gmask |= 1u << bi; }
            unsigned long long taken = 0ull; int sel[8]; float sw[8]; float wsum = 0.f;
#pragma unroll
            for (int k = 0; k < 8; ++k) { float best = -1e30f; int bi = 0;
                for (int e = 0; e < 64; ++e) { const bool cand = ((gmask >> (e >> 3)) & 1u) && !((taken >> e) & 1ull); const float vv = sr[e] + rbias[e];
                    if (cand && vv > best) { best = vv; bi = e; } }
                taken |= 1ull << bi; sel[k] = bi; sw[k] = sr[bi]; wsum += sw[k]; }
            const float inv = 2.5f / wsum;
#pragma unroll
            for (int k = 0; k < 8; ++k) { const int a = trow * 8 + k; const int pos = atomicAdd(&cnt[sel[k]], 1);
                LIST[(size_t)sel[k] * TT + pos] = a; PK[a] = ((unsigned)sel[k] << 16) | (unsigned)pos; LW[(size_t)sel[k] * TT + pos] = sw[k] * inv; }
            LIST[(size_t)64 * TT + (trow - r0)] = 8 * TT + trow; LW[(size_t)64 * TT + (trow - r0)] = 1.0f;
        }
    }
}
namespace att {
constexpr int D = 128, NW = 8, QBLK = 32, KVBLK = 64;
constexpr float SCALE = 0.088388347648318440f;
constexpr float THR = 8.f;
constexpr int SHM_V = KVBLK * D * 2, SHM_K = KVBLK * D * 2, SHM_ATTN = 2 * SHM_V + 2 * SHM_K + NW * 64 * 4;
#define KSWZ(row, colB) ((row) * 256 + ((colB) ^ (((row) & 7) << 4)))
#define SBAR() __builtin_amdgcn_sched_barrier(0)
__device__ __forceinline__ int crow(int r, int hi) { return (r & 3) + 8 * (r >> 2) + 4 * hi; }
__device__ __forceinline__ unsigned cvtpk(float lo, float hi) { unsigned r; asm volatile("v_cvt_pk_bf16_f32 %0, %1, %2" : "=v"(r) : "v"(lo), "v"(hi)); return r; }

__device__ __forceinline__ void partialSM(f32x16& p0, f32x16& p1, float negMC) {
  constexpr float Cc = SCALE * 1.4426950408889634f;
  for (int r = 0; r < 16; ++r) p0[r] = fmaf(p0[r], Cc, negMC); for (int r = 0; r < 16; ++r) p1[r] = fmaf(p1[r], Cc, negMC);
  for (int r = 0; r < 16; ++r) p0[r] = __builtin_amdgcn_exp2f(p0[r]);
}
__device__ __forceinline__ void finishSM(f32x16& p0, f32x16& p1, float& l_reg, bf16x8& pa0, bf16x8& pa1, bf16x8& pa2, bf16x8& pa3) {
  for (int r = 0; r < 16; ++r) p1[r] = __builtin_amdgcn_exp2f(p1[r]);
  float ps = 0; for (int r = 0; r < 16; ++r) ps += p0[r]; for (int r = 0; r < 16; ++r) ps += p1[r];
  { auto rr = __builtin_amdgcn_permlane32_swap(__float_as_uint(ps), __float_as_uint(ps), false, false);
    ps = __uint_as_float(rr[0]) + __uint_as_float(rr[1]); }
  l_reg += ps;
#define PK4(P, BASE, OUT) do { unsigned a0 = cvtpk(P[BASE + 0], P[BASE + 1]), a1 = cvtpk(P[BASE + 2], P[BASE + 3]);   \
    unsigned b0 = cvtpk(P[BASE + 4], P[BASE + 5]), b1 = cvtpk(P[BASE + 6], P[BASE + 7]);                              \
    auto r0 = __builtin_amdgcn_permlane32_swap(a0, b0, false, false); auto r1 = __builtin_amdgcn_permlane32_swap(a1, b1, false, false); \
    u32x4 w = {r0[0], r1[0], r0[1], r1[1]}; OUT = *reinterpret_cast<bf16x8*>(&w); } while (0)
  PK4(p0, 0, pa0); PK4(p0, 8, pa1); PK4(p1, 0, pa2); PK4(p1, 8, pa3);
#undef PK4
}
__device__ __forceinline__ void qkt(f32x16& p0, f32x16& p1, const LAS char* Ks, const bf16x8* qr, int r32, int hi) {
  p0 = f32x16{}; p1 = f32x16{};
  for (int d0 = 0; d0 < 8; ++d0) { int cb = (d0 * 16 + hi * 8) * 2;
    bf16x8 b0 = *reinterpret_cast<const LAS bf16x8*>(Ks + KSWZ(r32, cb));
    bf16x8 b1 = *reinterpret_cast<const LAS bf16x8*>(Ks + KSWZ(32 + r32, cb));
    p0 = __builtin_amdgcn_mfma_f32_32x32x16_bf16(b0, qr[d0], p0, 0, 0, 0);
    p1 = __builtin_amdgcn_mfma_f32_32x32x16_bf16(b1, qr[d0], p1, 0, 0, 0); }
}
__device__ __forceinline__ int v_st(int k, int c) { const int kk = (k & ~0xC) | ((k & 4) << 1) | ((k & 8) >> 1); return ((kk >> 3) * 4 + (c >> 5)) * 512 + ((kk & 7) * 32 + (c & 31)) * 2; }
__device__ __forceinline__ int v_rd_base(int lane) { return ((lane & 3) << 3) | (((lane >> 2) & 3) << 6) | (((lane >> 4) & 1) << 5) | (((lane >> 5) & 1) << 8); }
constexpr int v_rd_off(int d0, int ks, int half) { return d0 * 512 + ks * 4096 + half * 2048; }
template <int OFF> __device__ __forceinline__ s16x4 tr_read(int vb) {
  s16x4 r; asm volatile("ds_read_b64_tr_b16 %0, %1 offset:%2" : "=&v"(r) : "v"(vb), "i"(OFF) : "memory"); return r;
}
template <int D0> __device__ __forceinline__ void pv_one(f32x16& od, int vb, bf16x8 pa0, bf16x8 pa1, bf16x8 pa2, bf16x8 pa3) {
  const s16x4 l0 = tr_read<v_rd_off(D0, 0, 0)>(vb), h0 = tr_read<v_rd_off(D0, 0, 1)>(vb), l1 = tr_read<v_rd_off(D0, 1, 0)>(vb), h1 = tr_read<v_rd_off(D0, 1, 1)>(vb);
  const s16x4 l2 = tr_read<v_rd_off(D0, 2, 0)>(vb), h2 = tr_read<v_rd_off(D0, 2, 1)>(vb), l3 = tr_read<v_rd_off(D0, 3, 0)>(vb), h3 = tr_read<v_rd_off(D0, 3, 1)>(vb);
  asm volatile("s_waitcnt lgkmcnt(0)" ::: "memory"); SBAR();
#define PK(L, H) (bf16x8){L[0], L[1], L[2], L[3], H[0], H[1], H[2], H[3]}
  od = __builtin_amdgcn_mfma_f32_32x32x16_bf16(pa0, PK(l0, h0), od, 0, 0, 0);
  od = __builtin_amdgcn_mfma_f32_32x32x16_bf16(pa1, PK(l1, h1), od, 0, 0, 0);
  od = __builtin_amdgcn_mfma_f32_32x32x16_bf16(pa2, PK(l2, h2), od, 0, 0, 0);
  od = __builtin_amdgcn_mfma_f32_32x32x16_bf16(pa3, PK(l3, h3), od, 0, 0, 0);
#undef PK
}
__device__ __forceinline__ void pv_d0(f32x16* o, int vb, bf16x8 pa0, bf16x8 pa1, bf16x8 pa2, bf16x8 pa3) {
  pv_one<0>(o[0], vb, pa0, pa1, pa2, pa3); pv_one<1>(o[1], vb, pa0, pa1, pa2, pa3); pv_one<2>(o[2], vb, pa0, pa1, pa2, pa3); pv_one<3>(o[3], vb, pa0, pa1, pa2, pa3);
}

template <int LDQ, int LDK, int LDO>
__device__ __forceinline__ void attn_dense_body(const bf16_t* __restrict__ Qb, const bf16_t* __restrict__ Kh, const bf16_t* __restrict__ Vh, bf16_t* __restrict__ Ob, int seq, LAS char* lds, int tid, float kmax2) {
  const int wid = tid >> 6, lane = tid & 63, r32 = lane & 31, hi = lane >> 5;
  LAS char* V_lds = lds; LAS char* K_lds = lds + 2 * SHM_V;
  LAS float* ws = (LAS float*)(lds + 2 * SHM_V + 2 * SHM_K) + wid * 64; LAS float* li_l = ws;
  float l_reg = 0; f32x16 o[4] = {}; bf16x8 qr[8];
  const bf16_t* Qw = Qb + (long)(wid * QBLK + r32) * LDQ + hi * 8;
#pragma unroll
  for (int d0 = 0; d0 < 8; ++d0) qr[d0] = *reinterpret_cast<const bf16x8*>(Qw + d0 * 16);
  float negMC;
  { float q2 = 0.f;
#pragma unroll
    for (int d0 = 0; d0 < 8; ++d0) { const u32x4 w = __builtin_bit_cast(u32x4, qr[d0]);
      q2 += bflo(w.x) * bflo(w.x) + bfhi(w.x) * bfhi(w.x) + bflo(w.y) * bflo(w.y) + bfhi(w.y) * bfhi(w.y) + bflo(w.z) * bflo(w.z) + bfhi(w.z) * bfhi(w.z) + bflo(w.w) * bflo(w.w) + bfhi(w.w) * bfhi(w.w); }
    auto rr = __builtin_amdgcn_permlane32_swap(__float_as_uint(q2), __float_as_uint(q2), false, false);
    q2 = __uint_as_float(rr[0]) + __uint_as_float(rr[1]);
    negMC = -(sqrtf(q2 * kmax2) * (SCALE * 1.0001f) - 30.0f) * 1.4426950408889634f; }
  const int sr = tid >> 4, sc = (tid & 15) * 8, vst0 = v_st(sr, sc), vst1 = v_st(32 + sr, sc);
  const int vb0 = (int)(uintptr_t)V_lds + v_rd_base(lane);
  struct { bf16x8 vs0, vs1, ks0, ks1; } sr_[2];
#define SLOAD(i, k0) do { sr_[i].vs0 = *reinterpret_cast<const bf16x8*>(&Vh[(long)((k0) + sr) * LDK + sc]); sr_[i].vs1 = *reinterpret_cast<const bf16x8*>(&Vh[(long)((k0) + 32 + sr) * LDK + sc]); \
    sr_[i].ks0 = *reinterpret_cast<const bf16x8*>(&Kh[(long)((k0) + sr) * LDK + sc]); sr_[i].ks1 = *reinterpret_cast<const bf16x8*>(&Kh[(long)((k0) + 32 + sr) * LDK + sc]); } while (0)
#define SWRITE(b, i) do { *(LAS bf16x8*)(V_lds + (b) * SHM_V + vst0) = sr_[i].vs0;          \
    *(LAS bf16x8*)(V_lds + (b) * SHM_V + vst1) = sr_[i].vs1; int kc = sc * 2;               \
    *(LAS bf16x8*)(K_lds + (b) * SHM_K + KSWZ(sr, kc)) = sr_[i].ks0;                       \
    *(LAS bf16x8*)(K_lds + (b) * SHM_K + KSWZ(32 + sr, kc)) = sr_[i].ks1; } while (0)
#define SWAIT() asm volatile("s_waitcnt vmcnt(4)" ::: "memory")
  f32x16 pA0, pA1, pB0, pB1; bf16x8 pa0, pa1, pa2, pa3; const int NT = seq / KVBLK;
  constexpr int SE = 0, SO = 1;
  SLOAD(SE, 0); asm volatile("s_waitcnt vmcnt(0)" ::: "memory"); SWRITE(0, SE); __syncthreads();
  qkt(pA0, pA1, K_lds, qr, r32, hi); partialSM(pA0, pA1, negMC);
  SLOAD(SO, KVBLK); if (2 < NT) SLOAD(SE, 2 * KVBLK);
  SWAIT(); SWRITE(1, SO); __syncthreads();
  for (int j = 1; j + 1 < NT; j += 2) {
    SBAR(); qkt(pB0, pB1, K_lds + SHM_K, qr, r32, hi);
    finishSM(pA0, pA1, l_reg, pa0, pa1, pa2, pa3); SBAR();
    SLOAD(SO, (j + 2) * KVBLK); SBAR();
    pv_d0(o, vb0, pa0, pa1, pa2, pa3); partialSM(pB0, pB1, negMC);
    __syncthreads(); SWAIT(); SWRITE(0, SE);
    __syncthreads();
    SBAR(); qkt(pA0, pA1, K_lds, qr, r32, hi);
    finishSM(pB0, pB1, l_reg, pa0, pa1, pa2, pa3); SBAR();
    if (j + 3 < NT) SLOAD(SE, (j + 3) * KVBLK); SBAR();
    pv_d0(o, vb0 + (int)SHM_V, pa0, pa1, pa2, pa3); partialSM(pA0, pA1, negMC);
    __syncthreads(); SWAIT(); SWRITE(1, SO);
    __syncthreads();
  }
  SBAR(); qkt(pB0, pB1, K_lds + SHM_K, qr, r32, hi);
  finishSM(pA0, pA1, l_reg, pa0, pa1, pa2, pa3); SBAR();
  pv_d0(o, vb0, pa0, pa1, pa2, pa3); partialSM(pB0, pB1, negMC);
  __syncthreads();
  finishSM(pB0, pB1, l_reg, pa0, pa1, pa2, pa3); SBAR();
  pv_d0(o, vb0 + (int)SHM_V, pa0, pa1, pa2, pa3);
  if (hi == 0) li_l[r32] = l_reg; asm volatile("s_waitcnt lgkmcnt(0)" ::: "memory");
  float rli[16];
#pragma unroll
  for (int r = 0; r < 16; ++r) rli[r] = __builtin_amdgcn_rcpf(li_l[crow(r, hi)]);
  bf16_t* Ow = Ob + (long)(wid * QBLK) * LDO;
#pragma unroll
  for (int r = 0; r < 16; ++r) { int orow = crow(r, hi);
    for (int d0 = 0; d0 < 4; ++d0) Ow[(long)orow * LDO + d0 * 32 + r32] = (bf16_t)(cvtpk(o[d0][r] * rli[r], 0.f) & 0xffffu); }
#undef SLOAD
#undef SWRITE
#undef SWAIT
}

typedef int v8i32a __attribute__((ext_vector_type(8)));
typedef int v4i32a __attribute__((ext_vector_type(4)));
#define KSW8(row, chunk) ((row) * 128 + ((((chunk) ^ (((row) >> 1) & 7))) << 4))
#define VSW8(d, chunk) ((d) * 64 + ((((chunk) ^ (((d) >> 2) & 3))) << 4))
#define MFMA8(a, b, c) __builtin_amdgcn_mfma_scale_f32_32x32x64_f8f6f4((a), (b), (c), 0, 0, 0, 0, 0, 0)
__device__ __forceinline__ v8i32a ld32_l(const LAS char* p0, const LAS char* p1) { return __builtin_shufflevector(*(const LAS v4i32a*)p0, *(const LAS v4i32a*)p1, 0, 1, 2, 3, 4, 5, 6, 7); }
__device__ __forceinline__ unsigned pk4f8(float a, float b, float c, float d) { unsigned w = (unsigned)__builtin_amdgcn_cvt_pk_fp8_f32(a, b, 0, false); return (unsigned)__builtin_amdgcn_cvt_pk_fp8_f32(c, d, (int)w, true); }
template <int LDO, int KSTR>
__device__ __forceinline__ void attn_dense8_body(const unsigned char* __restrict__ Q8b, const unsigned char* __restrict__ K8h, const unsigned char* __restrict__ VT8h, bf16_t* __restrict__ Ob, int seq, LAS char* lds, int tid, float kmax2) {
  const int wid = tid >> 6, lane = tid & 63, r32 = lane & 31, hi = lane >> 5;
  constexpr int RS = 6, PD = 4;
  LAS float* al_l = (LAS float*)(lds + RS * 16384) + wid * 32;
  f32x16 o[4] = {}; v8i32a qf[2];
  { const unsigned char* qp = Q8b + (size_t)(wid * QBLK + r32) * 1024 + 32 * hi;
    qf[0] = __builtin_shufflevector(*(const v4i32a*)qp, *(const v4i32a*)(qp + 16), 0, 1, 2, 3, 4, 5, 6, 7);
    qf[1] = __builtin_shufflevector(*(const v4i32a*)(qp + 64), *(const v4i32a*)(qp + 80), 0, 1, 2, 3, 4, 5, 6, 7); }
  (void)kmax2;
  constexpr float THR8 = 1.4426950408889634f;
  float m_reg = 0.f; f32x16 osum = {}; v8i32a ones = {0x38383838, 0x38383838, 0x38383838, 0x38383838, 0x38383838, 0x38383838, 0x38383838, 0x38383838}; asm volatile("" : "+v"(ones));
#define PSM8(P0, P1, DL, CN, FIRST) do { float pmax = P0[0]; for (int r = 1; r < 16; ++r) pmax = fmaxf(pmax, P0[r]); for (int r = 0; r < 16; ++r) pmax = fmaxf(pmax, P1[r]); \
      { auto rr = __builtin_amdgcn_permlane32_swap(__float_as_uint(pmax), __float_as_uint(pmax), false, false); pmax = fmaxf(__uint_as_float(rr[0]), __uint_as_float(rr[1])); } \
      const float mn = (FIRST) ? pmax : ((pmax - m_reg > THR8) ? pmax : m_reg); DL = (FIRST) ? 0.f : mn - m_reg; m_reg = mn; CN = 7.0f - mn; \
      for (int r = 0; r < 16; ++r) P0[r] = __builtin_amdgcn_exp2f(P0[r] + CN); } while (0)
#define RESC8(DL) do { if (__any((DL) > 0.f)) { if (hi == 0) al_l[r32] = __builtin_amdgcn_exp2f(-(DL)); asm volatile("s_waitcnt lgkmcnt(0)" ::: "memory"); \
      for (int d = 0; d < 4; ++d) for (int r = 0; r < 16; ++r) o[d][r] *= al_l[crow(r, hi)]; for (int r = 0; r < 16; ++r) osum[r] *= al_l[crow(r, hi)]; } } while (0)
  const unsigned kgo = (unsigned)((tid >> 3) * KSTR + 16 * ((tid & 7) ^ ((tid >> 4) & 7))), vgo = (unsigned)((tid >> 2) * 64 + 16 * ((tid & 3) ^ ((tid >> 4) & 3)));
  const unsigned ldw = (unsigned)wid * 1024u;
#define DMA8(slot, T_) do { __builtin_amdgcn_global_load_lds((const unsigned*)(K8h + (size_t)(T_) * (64 * KSTR) + kgo), (LAS unsigned*)(lds + (slot) * 16384 + ldw), 16, 0, 0); \
      __builtin_amdgcn_global_load_lds((const unsigned*)(VT8h + (size_t)(T_) * 8192 + vgo), (LAS unsigned*)(lds + (slot) * 16384 + 8192 + ldw), 16, 0, 0); } while (0)
#define DWAIT8() do { asm volatile("s_waitcnt vmcnt(6)\n\ts_waitcnt lgkmcnt(0)" ::: "memory"); __builtin_amdgcn_s_barrier(); asm volatile("" ::: "memory"); } while (0)
#define QK8(P0, P1, KB) do { P0 = f32x16{}; P1 = f32x16{}; _Pragma("unroll") for (int s = 0; s < 2; ++s) { \
      const v8i32a k0 = ld32_l((KB) + KSW8(r32, 4 * s + 2 * hi), (KB) + KSW8(r32, 4 * s + 2 * hi + 1)); \
      const v8i32a k1 = ld32_l((KB) + KSW8(32 + r32, 4 * s + 2 * hi), (KB) + KSW8(32 + r32, 4 * s + 2 * hi + 1)); \
      P0 = MFMA8(k0, qf[s], P0); P1 = MFMA8(k1, qf[s], P1); } } while (0)
#define FIN8(P0, P1, CN) do { for (int r = 0; r < 16; ++r) P1[r] = __builtin_amdgcn_exp2f(P1[r] + CN); \
      _Pragma("unroll") for (int i = 0; i < 4; ++i) { pa[i] = (int)pk4f8(P0[4 * i], P0[4 * i + 1], P0[4 * i + 2], P0[4 * i + 3]); pa[4 + i] = (int)pk4f8(P1[4 * i], P1[4 * i + 1], P1[4 * i + 2], P1[4 * i + 3]); } } while (0)
#define PV8(VB) do { _Pragma("unroll") for (int d0 = 0; d0 < 4; ++d0) { \
      const v8i32a vf = ld32_l((VB) + VSW8(32 * d0 + r32, 2 * hi), (VB) + VSW8(32 * d0 + r32, 2 * hi + 1)); \
      o[d0] = MFMA8(pa, vf, o[d0]); } osum = MFMA8(pa, ones, osum); } while (0)
#define LDK8(KB, s, half) ld32_l((KB) + KSW8(32 * (half) + r32, 4 * (s) + 2 * hi), (KB) + KSW8(32 * (half) + r32, 4 * (s) + 2 * hi + 1))
#define LDV8(VB, d0) ld32_l((VB) + VSW8(32 * (d0) + r32, 2 * hi), (VB) + VSW8(32 * (d0) + r32, 2 * hi + 1))
#define EXPN(P, r0, n, CN) do { _Pragma("unroll") for (int r = (r0); r < (r0) + (n); ++r) { float e_ = __builtin_amdgcn_exp2f(P[r] + (CN)); asm volatile("" : "+v"(e_)); P[r] = e_; } } while (0)
#define FINP(P0, P1, CN, i) do { EXPN(P1, 4 * (i), 4, CN); \
      { unsigned w_ = (unsigned)__builtin_amdgcn_cvt_pk_fp8_f32(P0[4 * (i)], P0[4 * (i) + 1], pa[i], false); pa[i] = __builtin_amdgcn_cvt_pk_fp8_f32(P0[4 * (i) + 2], P0[4 * (i) + 3], (int)w_, true); } \
      { unsigned w_ = (unsigned)__builtin_amdgcn_cvt_pk_fp8_f32(P1[4 * (i)], P1[4 * (i) + 1], pa[4 + (i)], false); pa[4 + (i)] = __builtin_amdgcn_cvt_pk_fp8_f32(P1[4 * (i) + 2], P1[4 * (i) + 3], (int)w_, true); } } while (0)
#define PINA(x, y) asm volatile("" : "+v"(x), "+v"(y))
#define PIN1(x) asm volatile("" : "+v"(x))
#define PINC(x, y) asm volatile("" :: "v"(x), "v"(y))
#define HSTEP(X0, X1, DLX, CNX, Y0, Y1, CNY, KB, VB, STAGE_LOAD) do { \
      v8i32a ka_ = LDK8(KB, 0, 0), kb_ = LDK8(KB, 0, 1), kc_ = LDK8(KB, 1, 0), kd_ = LDK8(KB, 1, 1); \
      X0 = MFMA8(ka_, qf[0], f32x16{}); PINA(X0, kb_); \
      FINP(Y0, Y1, CNY, 0); PINC(pa[0], pa[4]); PIN1(kb_); \
      X1 = MFMA8(kb_, qf[0], f32x16{}); PINA(X1, kc_); \
      FINP(Y0, Y1, CNY, 1); PINC(pa[1], pa[5]); PIN1(kc_); \
      X0 = MFMA8(kc_, qf[1], X0); PINA(X0, kd_); \
      v8i32a v0_ = LDV8(VB, 0), v1_ = LDV8(VB, 1); \
      FINP(Y0, Y1, CNY, 2); STAGE_LOAD; PINC(pa[2], pa[6]); PIN1(kd_); \
      X1 = MFMA8(kd_, qf[1], X1); PINA(X1, v0_); \
      v8i32a v2_ = LDV8(VB, 2), v3_ = LDV8(VB, 3); \
      FINP(Y0, Y1, CNY, 3); PINC(pa[3], pa[7]); PINA(pa, v0_); \
      o[0] = MFMA8(pa, v0_, o[0]); PINA(o[0], v1_); \
      float pm0_ = X0[0]; _Pragma("unroll") for (int r = 1; r < 16; ++r) pm0_ = fmaxf(pm0_, X0[r]); PINA(pm0_, v1_); \
      o[1] = MFMA8(pa, v1_, o[1]); PINA(o[1], v2_); \
      _Pragma("unroll") for (int r = 0; r < 16; ++r) pm0_ = fmaxf(pm0_, X1[r]); \
      { auto rr = __builtin_amdgcn_permlane32_swap(__float_as_uint(pm0_), __float_as_uint(pm0_), false, false); pm0_ = fmaxf(__uint_as_float(rr[0]), __uint_as_float(rr[1])); } \
      { const float mn = (pm0_ - m_reg > THR8) ? pm0_ : m_reg; DLX = mn - m_reg; m_reg = mn; CNX = 7.0f - mn; } PINA(CNX, v2_); \
      o[2] = MFMA8(pa, v2_, o[2]); PINA(o[2], v3_); \
      EXPN(X0, 0, 5, CNX); PIN1(v3_); \
      o[3] = MFMA8(pa, v3_, o[3]); PINA(o[3], CNX); \
      EXPN(X0, 5, 5, CNX); PIN1(pa); \
      osum = MFMA8(pa, ones, osum); PINA(osum, CNX); \
      EXPN(X0, 10, 6, CNX); } while (0)
  f32x16 pA0, pA1, pB0, pB1; v8i32a pa = {}; float dlA, dlB, cnA, cnB; const int NT = seq / KVBLK;
#define SLOT(s) (lds + (s) * 16384)
#define SADV() do { sv = sk; sk = sk + 1 == RS ? 0 : sk + 1; sd = sd + 1 == RS ? 0 : sd + 1; } while (0)
  int sk = 0, sv = 0, sd = PD;
  DMA8(0, 0); DMA8(1, 1); DMA8(2, 2); DMA8(3, 3);
  DWAIT8();
  QK8(pA0, pA1, SLOT(0)); PSM8(pA0, pA1, dlA, cnA, true);
  DMA8(sd, PD); SADV(); DWAIT8();
  for (int j = 1; j + 1 < NT; j += 2) {
    HSTEP(pB0, pB1, dlB, cnB, pA0, pA1, cnA, SLOT(sk), SLOT(sv) + 8192, DMA8(sd, min(j + PD, NT - 1)));
    RESC8(dlB); SADV(); DWAIT8();
    HSTEP(pA0, pA1, dlA, cnA, pB0, pB1, cnB, SLOT(sk), SLOT(sv) + 8192, DMA8(sd, min(j + 1 + PD, NT - 1)));
    RESC8(dlA); SADV(); DWAIT8();
  }
  HSTEP(pB0, pB1, dlB, cnB, pA0, pA1, cnA, SLOT(sk), SLOT(sv) + 8192, (void)0);
  RESC8(dlB); SADV();
  FIN8(pB0, pB1, cnB); SBAR();
  PV8(SLOT(sv) + 8192);
  asm volatile("s_waitcnt vmcnt(0)" ::: "memory");
  float rli[16];
#pragma unroll
  for (int r = 0; r < 16; ++r) rli[r] = __builtin_amdgcn_rcpf(osum[r]);
  bf16_t* Ow = Ob + (long)(wid * QBLK) * LDO;
#pragma unroll
  for (int r = 0; r < 16; ++r) { int orow = crow(r, hi);
    for (int d0 = 0; d0 < 4; ++d0) Ow[(long)orow * LDO + d0 * 32 + r32] = (bf16_t)(cvtpk(o[d0][r] * rli[r], 0.f) & 0xffffu); }
#undef PSM8
#undef RESC8
#undef DMA8
#undef DWAIT8
#undef SLOT
#undef SADV
#undef QK8
#undef FIN8
#undef PV8
#undef HSTEP
#undef PINA
#undef PIN1
#undef PINC
#undef FINP
#undef EXPN
#undef LDK8
#undef LDV8
}

template <int LDO, int KSTR>
__device__ __forceinline__ void attn_dense8w_body(const unsigned char* __restrict__ Q8b, const unsigned char* __restrict__ K8h, const unsigned char* __restrict__ VT8h0, const unsigned char* __restrict__ VT8h1, bf16_t* __restrict__ Ob, int seq, LAS char* lds, int tid, float kmax2) {
  const int wid = tid >> 6, lane = tid & 63, r32 = lane & 31, hi = lane >> 5;
  constexpr int RS = 4, PD = 2, SB = 24576;
  LAS float* al_l = (LAS float*)(lds + RS * SB) + wid * 32;
  LAS char* q_l = lds + RS * SB + 2048 + wid * 4096 + lane * 16;
  { const unsigned char* qp = Q8b + (size_t)(wid * QBLK + r32) * 1024 + 32 * hi;
    *(LAS v4i32a*)(q_l) = *(const v4i32a*)qp; *(LAS v4i32a*)(q_l + 1024) = *(const v4i32a*)(qp + 16);
    *(LAS v4i32a*)(q_l + 2048) = *(const v4i32a*)(qp + 64); *(LAS v4i32a*)(q_l + 3072) = *(const v4i32a*)(qp + 80); }
  (void)kmax2;
  constexpr float THR8 = 1.4426950408889634f;
  float l_reg = 0.f, m_reg = 0.f; f32x16 o[8] = {};
  const unsigned kgo = (unsigned)((tid >> 3) * KSTR + 16 * ((tid & 7) ^ ((tid >> 4) & 7))), vgo = (unsigned)((tid >> 2) * 64 + 16 * ((tid & 3) ^ ((tid >> 4) & 3)));
  const unsigned ldw = (unsigned)wid * 1024u;
#define DMA8(slot, T_) do { __builtin_amdgcn_global_load_lds((const unsigned*)(K8h + (size_t)(T_) * (64 * KSTR) + kgo), (LAS unsigned*)(lds + (slot) * SB + ldw), 16, 0, 0); \
      __builtin_amdgcn_global_load_lds((const unsigned*)(VT8h0 + (size_t)(T_) * 8192 + vgo), (LAS unsigned*)(lds + (slot) * SB + 8192 + ldw), 16, 0, 0); \
      __builtin_amdgcn_global_load_lds((const unsigned*)(VT8h1 + (size_t)(T_) * 8192 + vgo), (LAS unsigned*)(lds + (slot) * SB + 16384 + ldw), 16, 0, 0); } while (0)
#define DWAIT8() do { asm volatile("s_waitcnt vmcnt(3)\n\ts_waitcnt lgkmcnt(0)" ::: "memory"); __builtin_amdgcn_s_barrier(); asm volatile("" ::: "memory"); } while (0)
#define SLOT(s) (lds + (s) * SB)
#define SADV() do { sv = sk; sk = sk + 1 == RS ? 0 : sk + 1; sd = sd + 1 == RS ? 0 : sd + 1; } while (0)
#define LDK8(KB, s, half) ld32_l((KB) + KSW8(32 * (half) + r32, 4 * (s) + 2 * hi), (KB) + KSW8(32 * (half) + r32, 4 * (s) + 2 * hi + 1))
#define LDV8(VB, d0) ld32_l((VB) + VSW8(32 * (d0) + r32, 2 * hi), (VB) + VSW8(32 * (d0) + r32, 2 * hi + 1))
#define PIN1(x) asm volatile("" : "+v"(x))
#define EXPR(e0, n) do { _Pragma("unroll") for (int e = (e0); e < (e0) + (n); ++e) { float x_ = e < 16 ? X0[e & 15] : X1[e & 15]; float e_ = __builtin_amdgcn_exp2f(x_ + cn); asm volatile("" : "+v"(e_)); ps += e_; \
      if (e < 16) X0[e & 15] = e_; else X1[e & 15] = e_; } } while (0)
#define PKW(PAC, w) do { if ((w) < 4) { unsigned w_ = (unsigned)__builtin_amdgcn_cvt_pk_fp8_f32(X0[4 * ((w) & 3)], X0[4 * ((w) & 3) + 1], PAC[w], false); PAC[w] = __builtin_amdgcn_cvt_pk_fp8_f32(X0[4 * ((w) & 3) + 2], X0[4 * ((w) & 3) + 3], (int)w_, true); } \
      else { unsigned w_ = (unsigned)__builtin_amdgcn_cvt_pk_fp8_f32(X1[4 * ((w) & 3)], X1[4 * ((w) & 3) + 1], PAC[w], false); PAC[w] = __builtin_amdgcn_cvt_pk_fp8_f32(X1[4 * ((w) & 3) + 2], X1[4 * ((w) & 3) + 3], (int)w_, true); } } while (0)
#define PVM(PAP, g) do { PIN1(vv##g); o[4 * ((g) & 1) + ((g) >> 1)] = MFMA8(PAP, vv##g, o[4 * ((g) & 1) + ((g) >> 1)]); asm volatile("" :: "v"(o[4 * ((g) & 1) + ((g) >> 1)])); } while (0)
#define LDVG(g) ({ int o_ = sv * SB + 8192 + 8192 * ((g) & 1); asm volatile("" : "+s"(o_)); LDV8(lds + o_, (g) >> 1); })
#define WSTEP(PAP, PAC, FIRST, TNEXT) do { \
      { const v8i32a ka_ = LDK8(SLOT(sk), 0, 0), kb_ = LDK8(SLOT(sk), 0, 1), kc_ = LDK8(SLOT(sk), 1, 0), kd_ = LDK8(SLOT(sk), 1, 1); \
        const v8i32a q0_ = ld32_l(q_l, q_l + 1024), q1_ = ld32_l(q_l + 2048, q_l + 3072); \
        X0 = MFMA8(ka_, q0_, f32x16{}); X1 = MFMA8(kb_, q0_, f32x16{}); X0 = MFMA8(kc_, q1_, X0); X1 = MFMA8(kd_, q1_, X1); PIN1(X1); } \
      DMA8(sd, TNEXT); \
      v8i32a vv0 = LDVG(0), vv1 = LDVG(1); \
      PVM(PAP, 0); v8i32a vv2 = LDVG(2); \
      float pm_ = X0[0]; _Pragma("unroll") for (int r = 1; r < 16; ++r) pm_ = fmaxf(pm_, X0[r]); PIN1(pm_); \
      PVM(PAP, 1); v8i32a vv3 = LDVG(3); \
      _Pragma("unroll") for (int r = 0; r < 16; ++r) pm_ = fmaxf(pm_, X1[r]); \
      { auto rr = __builtin_amdgcn_permlane32_swap(__float_as_uint(pm_), __float_as_uint(pm_), false, false); pm_ = fmaxf(__uint_as_float(rr[0]), __uint_as_float(rr[1])); } \
      const float mn_ = (FIRST) ? pm_ : ((pm_ - m_reg > THR8) ? pm_ : m_reg); const float dl_ = (FIRST) ? 0.f : mn_ - m_reg; m_reg = mn_; float cn = 7.0f - mn_; float ps = 0.f; PIN1(cn); \
      PVM(PAP, 2); v8i32a vv4 = LDVG(4); EXPR(0, 6); PKW(PAC, 0); \
      PVM(PAP, 3); v8i32a vv5 = LDVG(5); EXPR(6, 6); PKW(PAC, 1); PKW(PAC, 2); \
      PVM(PAP, 4); v8i32a vv6 = LDVG(6); EXPR(12, 5); PKW(PAC, 3); \
      PVM(PAP, 5); v8i32a vv7 = LDVG(7); EXPR(17, 5); PKW(PAC, 4); \
      PVM(PAP, 6); EXPR(22, 5); PKW(PAC, 5); \
      PVM(PAP, 7); EXPR(27, 5); PKW(PAC, 6); PKW(PAC, 7); \
      { auto rr = __builtin_amdgcn_permlane32_swap(__float_as_uint(ps), __float_as_uint(ps), false, false); ps = __uint_as_float(rr[0]) + __uint_as_float(rr[1]); } \
      if (__any(dl_ > 0.f)) { const float al_ = __builtin_amdgcn_exp2f(-dl_); l_reg *= al_; if (hi == 0) al_l[r32] = al_; asm volatile("s_waitcnt lgkmcnt(0)" ::: "memory"); \
        for (int d = 0; d < 8; ++d) for (int r = 0; r < 16; ++r) o[d][r] *= al_l[crow(r, hi)]; } \
      l_reg += ps; \
      SADV(); DWAIT8(); } while (0)
  f32x16 X0, X1; v8i32a paA = {}, paB = {}; const int NT = seq / KVBLK;
  int sk = 0, sv = 0, sd = PD;
  DMA8(0, 0); DMA8(1, 1);
  DWAIT8();
  for (int j = 0; j < NT; j += 2) {
    WSTEP(paB, paA, j == 0, min(j + PD, NT - 1));
    WSTEP(paA, paB, false, min(j + 1 + PD, NT - 1));
  }
  { v8i32a vv0 = LDVG(0), vv1 = LDVG(1), vv2 = LDVG(2), vv3 = LDVG(3); PVM(paB, 0); PVM(paB, 1); PVM(paB, 2); PVM(paB, 3); }
  { v8i32a vv4 = LDVG(4), vv5 = LDVG(5), vv6 = LDVG(6), vv7 = LDVG(7); PVM(paB, 4); PVM(paB, 5); PVM(paB, 6); PVM(paB, 7); }
  asm volatile("s_waitcnt vmcnt(0)" ::: "memory");
  int te = tid; asm volatile("" : "+v"(te));
  const int wid_e = te >> 6, r32_e = te & 31, hi_e = (te >> 5) & 1;
  LAS float* li_e = (LAS float*)(lds + RS * SB + 1024) + wid_e * 32;
  if (hi_e == 0) li_e[r32_e] = l_reg; asm volatile("s_waitcnt lgkmcnt(0)" ::: "memory");
  float rli[16];
#pragma unroll
  for (int r = 0; r < 16; ++r) rli[r] = __builtin_amdgcn_rcpf(li_e[crow(r, hi_e)]);
  bf16_t* Ow = Ob + (long)(wid_e * QBLK) * LDO;
#pragma unroll
  for (int r = 0; r < 16; ++r) { int orow = crow(r, hi_e);
    for (int d0 = 0; d0 < 8; ++d0) Ow[(long)orow * LDO + d0 * 32 + r32_e] = (bf16_t)(cvtpk(o[d0][r] * rli[r], 0.f) & 0xffffu); }
#undef DMA8
#undef DWAIT8
#undef SLOT
#undef SADV
#undef LDK8
#undef LDV8
#undef PIN1
#undef EXPR
#undef PKW
#undef PVM
#undef LDVG
#undef WSTEP
}

constexpr int PV_BUF = 32768, PK_BUF = 16384, P_LDS_V = 0, P_LDS_K = 2 * PV_BUF, P_LDS_X = P_LDS_K + 2 * PK_BUF, P_LDS_L = P_LDS_X + 8 * 2048, P_LDS_END = P_LDS_L + 1024;
__device__ __forceinline__ void qkt_half(f32x16& p, const LAS char* Ks, const bf16x8* qr, int krow, int hi) {
  p = f32x16{};
  for (int d0 = 0; d0 < 8; ++d0) { int cb = (d0 * 16 + hi * 8) * 2;
    bf16x8 b0 = *reinterpret_cast<const LAS bf16x8*>(Ks + KSWZ(krow, cb));
    p = __builtin_amdgcn_mfma_f32_32x32x16_bf16(b0, qr[d0], p, 0, 0, 0); }
}
__device__ __forceinline__ void smA(f32x16& p, float negMC) {
  constexpr float Cc = SCALE * 1.4426950408889634f;
  for (int r = 0; r < 16; ++r) p[r] = fmaf(p[r], Cc, negMC);
  for (int r = 0; r < 8; ++r) p[r] = __builtin_amdgcn_exp2f(p[r]);
}
__device__ __forceinline__ void smB(f32x16& p, float& l_reg, bf16x8& f0, bf16x8& f1) {
  for (int r = 8; r < 16; ++r) p[r] = __builtin_amdgcn_exp2f(p[r]);
  float ps = 0; for (int r = 0; r < 16; ++r) ps += p[r];
  { auto rr = __builtin_amdgcn_permlane32_swap(__float_as_uint(ps), __float_as_uint(ps), false, false);
    ps = __uint_as_float(rr[0]) + __uint_as_float(rr[1]); }
  l_reg += ps;
#define PK4(P, BASE, OUT) do { unsigned a0 = cvtpk(P[BASE + 0], P[BASE + 1]), a1 = cvtpk(P[BASE + 2], P[BASE + 3]);   \
    unsigned b0 = cvtpk(P[BASE + 4], P[BASE + 5]), b1 = cvtpk(P[BASE + 6], P[BASE + 7]);                              \
    auto r0 = __builtin_amdgcn_permlane32_swap(a0, b0, false, false); auto r1 = __builtin_amdgcn_permlane32_swap(a1, b1, false, false); \
    u32x4 w = {r0[0], r1[0], r0[1], r1[1]}; OUT = *reinterpret_cast<bf16x8*>(&w); } while (0)
  PK4(p, 0, f0); PK4(p, 8, f1);
#undef PK4
}
template <int LDQ, int LDK, int LDO>
__device__ __forceinline__ void attn_pair_body(const bf16_t* __restrict__ Qb, const bf16_t* __restrict__ Kh, const bf16_t* __restrict__ Vh, bf16_t* __restrict__ Ob, int seq, LAS char* lds, int tid, float kmax2) {
  const int wid = __builtin_amdgcn_readfirstlane(tid >> 6), lane = tid & 63, r32 = lane & 31, hi = lane >> 5, g = wid & 3, kb = wid >> 2;
  LAS char* V_lds = lds + P_LDS_V; LAS char* K_lds = lds + P_LDS_K;
  LAS char* xp_own = lds + P_LDS_X + wid * 2048 + lane * 16; LAS char* xp_par = lds + P_LDS_X + (wid ^ 4) * 2048 + lane * 16;
  LAS float* li = (LAS float*)(lds + P_LDS_L);
  float l_reg = 0; f32x16 o[4] = {}; bf16x8 qr[8];
  const bf16_t* Qw = Qb + (long)(g * QBLK + r32) * LDQ + hi * 8;
#pragma unroll
  for (int d0 = 0; d0 < 8; ++d0) qr[d0] = *reinterpret_cast<const bf16x8*>(Qw + d0 * 16);
  float negMC;
  { float q2 = 0.f;
#pragma unroll
    for (int d0 = 0; d0 < 8; ++d0) { const u32x4 w = __builtin_bit_cast(u32x4, qr[d0]);
      q2 += bflo(w.x) * bflo(w.x) + bfhi(w.x) * bfhi(w.x) + bflo(w.y) * bflo(w.y) + bfhi(w.y) * bfhi(w.y) + bflo(w.z) * bflo(w.z) + bfhi(w.z) * bfhi(w.z) + bflo(w.w) * bflo(w.w) + bfhi(w.w) * bfhi(w.w); }
    auto rr = __builtin_amdgcn_permlane32_swap(__float_as_uint(q2), __float_as_uint(q2), false, false);
    q2 = __uint_as_float(rr[0]) + __uint_as_float(rr[1]);
    negMC = -(sqrtf(q2 * kmax2) * (SCALE * 1.0001f) - 30.0f) * 1.4426950408889634f; }
  const int sr = tid >> 4, sc = (tid & 15) * 8, vst0 = v_st(sr, sc), vst1 = v_st(32 + sr, sc);
  const int vrd = (int)(uintptr_t)V_lds + kb * 16384 + v_rd_base(lane);
  const int krow = 32 * kb + r32;
  struct { bf16x8 v00, v01, v10, v11, k0, k1; } st_;
#define PLD16(base, off) (*reinterpret_cast<const bf16x8*>((const char*)(base) + (off)))
#define PLOAD(k0_) do { const unsigned o_ = (unsigned)(((k0_) + sr) * LDK + sc) * 2u; \
    st_.v00 = PLD16(Vh, o_); st_.v01 = PLD16(Vh, o_ + 256u); st_.v10 = PLD16(Vh, o_ + 64u * LDK); st_.v11 = PLD16(Vh, o_ + 64u * LDK + 256u); \
    st_.k0 = PLD16(Kh, o_); st_.k1 = PLD16(Kh, o_ + 64u * LDK); } while (0)
#define PWRITE(kbuf, vbuf) do { LAS char* vb_ = V_lds + (vbuf) * PV_BUF; LAS char* kb_ = K_lds + (kbuf) * PK_BUF; const int kc = sc * 2; \
    *(LAS bf16x8*)(vb_ + vst0) = st_.v00; *(LAS bf16x8*)(vb_ + 16384 + vst0) = st_.v01; *(LAS bf16x8*)(vb_ + vst1) = st_.v10; *(LAS bf16x8*)(vb_ + 16384 + vst1) = st_.v11; \
    *(LAS bf16x8*)(kb_ + KSWZ(sr, kc)) = st_.k0; *(LAS bf16x8*)(kb_ + KSWZ(32 + sr, kc)) = st_.k1; } while (0)
  const int NT = seq / KVBLK;
  f32x16 pS; bf16x8 f0, f1, g0, g1;
  PLOAD(0); asm volatile("s_waitcnt vmcnt(0)" ::: "memory"); PWRITE(0, 0); PLOAD(KVBLK);
  __syncthreads();
  for (int j = 0; j < NT; ++j) {
    SBAR();
    qkt_half(pS, K_lds + (j & 1) * PK_BUF, qr, krow, hi);
    smA(pS, negMC); smB(pS, l_reg, f0, f1); SBAR();
    *(LAS bf16x8*)(xp_own) = f0; *(LAS bf16x8*)(xp_own + 1024) = f1;
    if (j + 1 < NT) PWRITE((j + 1) & 1, (j + 1) & 1);
    if (j + 2 < NT) PLOAD((j + 2) * KVBLK);
    __syncthreads();
    g0 = *(const LAS bf16x8*)(xp_par); g1 = *(const LAS bf16x8*)(xp_par + 1024);
    { const int vb = vrd + (j & 1) * PV_BUF;
      if (kb == 0) pv_d0(o, vb, f0, f1, g0, g1); else pv_d0(o, vb, g0, g1, f0, f1); }
    __syncthreads();
  }
  if (hi == 0) li[wid * 32 + r32] = l_reg;
  __syncthreads();
#pragma unroll
  for (int r = 0; r < 16; ++r) { const int orow = crow(r, hi); const float rl = __builtin_amdgcn_rcpf(li[wid * 32 + orow] + li[(wid ^ 4) * 32 + orow]);
    bf16_t* op = Ob + (long)(g * QBLK + orow) * LDO + 128 * kb + r32;
    for (int d0 = 0; d0 < 4; ++d0) op[d0 * 32] = (bf16_t)(cvtpk(o[d0][r] * rl, 0.f) & 0xffffu); }
#undef PLD16
#undef PLOAD
#undef PWRITE
}
#undef KSWZ
}

__device__ __forceinline__ void phase_attention(const Params& p, Ctx& C) {
    bf16_t* ATT = (bf16_t*)(p.ws + WS_BIG + BG_ATT);
    const unsigned char* Q8 = (const unsigned char*)(p.ws + WS_BIG + BG_Q8); const unsigned char* K8 = (const unsigned char*)(p.ws + WS_BIG + BG_K8); const unsigned char* VT8 = (const unsigned char*)(p.ws + WS_BIG + BG_VT8);
    const unsigned char* Q8D = (const unsigned char*)(p.ws + WS_BIG + BG_Q8D); const unsigned char* K8D = (const unsigned char*)(p.ws + WS_BIG + BG_K8D); const unsigned char* VT8D = (const unsigned char*)(p.ws + WS_BIG + BG_VT8D);
    for (int i = 0;; ++i) {
        int unit;
        if (C.G == 256) { if (i >= 2) break; unit = (C.bid & 7) * 64 + i * 32 + (C.bid >> 3); } else { unit = i * C.G + C.bid; if (unit >= 512) break; }
        const int d = unit >> 6, qb = unit & 63, hh = d >> 1, m = d & 1;
        __syncthreads();
        int tz = C.tid; asm volatile("" : "+v"(tz));
        att::attn_dense8w_body<3072, 1024>(Q8D + (size_t)(CTXL + 256 * qb) * 1024 + 128 * d, K8D + 128 * d, VT8D + (size_t)(2 * hh) * 260 * 8192, VT8D + (size_t)(2 * hh + 1) * 260 * 8192,
                                           ATT + (size_t)(256 * qb) * 3072 + 1024 + 1024 * m + 256 * hh, TT, (LAS char*)C.lds, tz, 0.f);
    }
    for (int i = 0;; ++i) {
        int unit;
        if (C.G == 256) { if (i >= 2) break; unit = (C.bid & 7) * 64 + i * 32 + (C.bid >> 3); } else { unit = i * C.G + C.bid; if (unit >= 512) break; }
        const int prob = unit >> 6, qb = unit & 63;
        __syncthreads();
        int tz = C.tid; asm volatile("" : "+v"(tz));
        att::attn_dense8_body<3072, 256>(Q8 + (size_t)(CTXL + 256 * qb) * 1024 + 128 * prob, K8 + 128 * (prob >> 2), VT8 + (size_t)(prob >> 2) * 260 * 8192,
                                         ATT + (size_t)(256 * qb) * 3072 + 128 * prob, TT, (LAS char*)C.lds, tz, 0.f);
    }
    __syncthreads();
}
constexpr int PH_PER_LAYER = 13, N_PHASES = 2 + 2 * PH_PER_LAYER;
#ifndef DBL_PHASE
#define DBL_PHASE -1
#endif
#ifndef MK_PER_PHASE
#define MK_PER_PHASE 0
#endif

template <int L>
__device__ __forceinline__ void layer_body(const Params& p, Ctx& C0, const XcdBarrier& bar, LAS unsigned char* misc, int lo, int hi) {
#define IN(k) (lo <= (k) && (k) < hi)
#define SEAM(k) do { if (IN(k) && IN((k) + 1)) xcd_barrier(bar, C0.wave); } while (0)
#define PHASE(k, ...) if (DBL_PHASE == (k)) { int nrep_ = 2; asm volatile("" : "+s"(nrep_)); for (int rep_ = 0; rep_ < nrep_; ++rep_) { if (rep_) xcd_barrier(bar, C0.wave); FRESH(); __VA_ARGS__ } } else if (IN(k)) { FRESH(); __VA_ARGS__ } SEAM(k);
#define FRESH() Ctx C = C0; { int ln = (int)__builtin_amdgcn_mbcnt_hi(~0u, __builtin_amdgcn_mbcnt_lo(~0u, 0u)); asm volatile("" : "+v"(ln)); C.lane = ln; C.tid = C.wave * 64 + ln; }
        const int b = 2 + PH_PER_LAYER * L;
        bf16_t* QKV = (bf16_t*)(p.ws + WS_BIG + BG_QKV);
        bf16_t* XA = (bf16_t*)(p.ws + WS_XA);
        int* cnt = (int*)(p.ws + WS_CTL) + CW_CNT + L * 128; const int* LIST = (const int*)(p.ws + WS_LIST);
        if (L == 0) { PHASE(b + 0, phase_modulate(p, C, L); ) }
        PHASE(b + 1,
            const int N = L ? OD_IN : EV_IN;
            pg8::DenseOrder S; S.init8((const void*)XA, DM, (const void*)(p.ws + (L ? WS_WIN1 : WS_WIN0)), TT, N, DM, C.G, C.bid);
            pg8::EpiStore E{QKV, N, 1.0f / 32.0f};
            pg8::gemm_phase<true>(C.lds, S, E, C.wave);
            if (L == 0 && IN(b + 2) && S.units_of_me() < S.max_units()) conv_queue(p, C, 2);
        )
        PHASE(b + 2, if (L == 0) phase_rope0(p, C); else phase_normrope1(p, C); )
        PHASE(b + 3, if (L == 0) { ret_chunk_kv(p, C); s5_end_states(p, C); } else phase_attention(p, C); )
        PHASE(b + 4, if (L == 0) phase_scans(p, C); else phase_merge1(p, C); )
        if (L == 0) {
            PHASE(b + 5, phase_ret_s5_outputs(p, C, misc); )
            PHASE(b + 6,
                pg8::DenseOrder S; S.init((const bf16_t*)(p.ws + WS_Z), 1024, (const bf16_t*)(p.ws + WS_WGLU), TT, 1024, 1024, C.G, C.bid);
                pg8::EpiGlu E{(const bf16_t*)(p.ws + WS_Z), p.inp(20), (bf16_t*)(p.ws + WS_BIG + BG_MIX)};
                pg8::gemm_phase<false>(C.lds, S, E, C.wave);
                if (IN(b + 7) && S.units_of_me() < S.max_units()) conv_queue(p, C, 4);
            )
        }
        PHASE(b + 7,
            pg8::DenseOrder S;
            if (L == 0) S.init((const bf16_t*)(p.ws + WS_BIG + BG_MIX), DM, (const bf16_t*)(p.ws + WS_WOUT0), TT, DM, DM, C.G, C.bid);
            else S.init((const bf16_t*)(p.ws + WS_BIG + BG_ATT), 3072, (const bf16_t*)(p.ws + WS_WOUT1), SEQ, DM, DM, C.G, C.bid);
            pg8::EpiStore E{(bf16_t*)(p.ws + WS_YMIX) + (L ? (size_t)CTXL * DM : 0), DM, 1.0f};
            pg8::gemm_phase<false>(C.lds, S, E, C.wave);
            if (L == 0 && IN(b + 8) && S.units_of_me() < S.max_units()) conv_queue(p, C, 5);
        )
        PHASE(b + 8, phase_ln1(p, C, L); )
        PHASE(b + 9, phase_router(p, C, L); )
        PHASE(b + 10,
            pg8::MoeOrder<0> S; S.A = (const void*)XA; S.Bt = (const void*)(p.ws + WS_GU + (size_t)L * NEX1 * 1024 * DM); S.list = LIST; S.cnt = cnt; S.ldab = DM; S.kb = DM; S.nN = 4; S.G = C.G; S.c = C.bid; S.bstride = (size_t)1024 * DM;
            S.prep(misc, C.tid);
            pg8::EpiE1 E{(unsigned char*)(p.ws + WS_HX2), S.cn, S.rb};
            pg8::gemm_phase<true>(C.lds, S, E, C.wave);
        )
        PHASE(b + 11,
            pg8::MoeOrder<1> S; S.A = (const void*)(p.ws + WS_HX2); S.Bt = (const void*)(p.ws + WS_DT + (size_t)L * NEX1 * DM * EHID); S.list = LIST; S.cnt = cnt; S.ldab = EHID; S.kb = EHID; S.nN = 8; S.G = C.G; S.c = C.bid; S.bstride = (size_t)DM * EHID;
            S.prep(misc, C.tid);
            pg8::EpiE2 E{(unsigned char*)(p.ws + WS_BIG + BG_YMOE), (const float*)(p.ws + WS_LW), S.cn, S.rb};
            pg8::gemm_phase<true>(C.lds, S, E, C.wave);
        )
        PHASE(b + 12, phase_combine(p, C, L, misc); )
    #undef IN
#undef SEAM
#undef FRESH
#undef PHASE
}

__global__ void __launch_bounds__(NTHR, 2) mega_fwd(KArgs ka) {
    extern __shared__ __attribute__((aligned(16))) unsigned char lds_raw[];
    Ctx C;
    C.lds = (LAS unsigned char*)lds_raw;
    C.tid = threadIdx.x; C.lane = C.tid & 63; C.wave = __builtin_amdgcn_readfirstlane(C.tid >> 6);
    C.G = gridDim.x; C.bid = blockIdx.x; C.gw = C.bid * NWAVES + C.wave; C.ngw = C.G * NWAVES;
    LAS unsigned char* misc = C.lds + MISC_OFF;
    if (C.tid < 8) ((volatile LAS unsigned*)misc)[C.tid] = 0u;
    Params p; p.out = ka.out; p.ws = ka.ws; p.ph_lo = ka.ph_lo; p.ph_hi = ka.ph_hi; p.ptab = (LAS unsigned long long*)(misc + 1024);
    if (C.tid < 34) p.ptab[C.tid] = (unsigned long long)ka.in[C.tid];
    __syncthreads();
    const int lo = p.ph_lo, hi = p.ph_hi;
    XcdBarrier bar; bar.bar = (unsigned*)(p.ws + WS_CTL) + CW_BAR; bar.x = 0; bar.st = (volatile LAS unsigned*)misc;
    if (hi - lo > 1) bar = xcd_barrier_post((unsigned*)(p.ws + WS_CTL) + CW_BAR, (volatile LAS unsigned*)misc);
#define IN(k) (lo <= (k) && (k) < hi)
#define SEAM(k) do { if (IN(k) && IN((k) + 1)) xcd_barrier(bar, C.wave); } while (0)

    if (IN(0)) { phase_p0(p, C); } SEAM(0);
    if (IN(1)) { phase_p1(p, C); } SEAM(1);
    if (IN(0) && IN(2) && (C.G & 7) == 0) {
        volatile LAS unsigned* st = (volatile LAS unsigned*)misc;
        if (C.tid == 0) { unsigned pre = 0u; const unsigned x = st[3];
            for (unsigned j = 0; j < 16; ++j) { const unsigned cj = xb_ld(&bar.bar[XB_XCNT(j)]); pre += (j < x) ? cj : 0u; }
            st[4] = pre + st[2]; }
        __syncthreads();
        const int vcu = (int)st[4], g8 = C.G >> 3;
        C.bid = __builtin_amdgcn_readfirstlane((vcu % g8) * 8 + vcu / g8); C.gw = C.bid * NWAVES + C.wave;
    }

    layer_body<0>(p, C, bar, misc, lo, hi);
    layer_body<1>(p, C, bar, misc, lo, hi);
#undef IN
#undef SEAM
}

extern "C" void kernel_launch(void* const* d_in, const int* in_sizes, int n_in, void* d_out, int out_size, void* d_ws, size_t ws_size, hipStream_t stream) {
    static int grid = 0;
    if (grid == 0) {
        if (n_in != 34 || out_size != SEQ * DM || ws_size < WS_END) { fprintf(stderr, "kernel_launch: unexpected shapes: n_in %d out %d ws %zu (need %zu)\n", n_in, out_size, ws_size, (size_t)WS_END); grid = -1; return; }
        int dev = 0, cus = 0, per_cu = 0;
        if (hipGetDevice(&dev) != hipSuccess || hipDeviceGetAttribute(&cus, hipDeviceAttributeMultiprocessorCount, dev) != hipSuccess) { grid = -1; return; }
        if (hipFuncSetAttribute((const void*)mega_fwd, hipFuncAttributeMaxDynamicSharedMemorySize, LDS_BYTES) != hipSuccess) { fprintf(stderr, "kernel_launch: hipFuncSetAttribute failed\n"); grid = -1; return; }
        if (hipOccupancyMaxActiveBlocksPerMultiprocessor(&per_cu, (const void*)mega_fwd, NTHR, LDS_BYTES) != hipSuccess || per_cu < 1) { fprintf(stderr, "kernel_launch: occupancy query says %d blocks per CU\n", per_cu); grid = -1; return; }
        (void)hipGetLastError();
        grid = cus;
    }
    if (grid < 0) return;
    (void)hipMemsetAsync((char*)d_ws + WS_CTL, 0, CTL_BYTES, stream);
    KArgs p{};
    for (int i = 0; i < 34; ++i) p.in[i] = (const float*)d_in[i];
    p.out = (float*)d_out; p.ws = (unsigned char*)d_ws;
#if MK_PER_PHASE
    for (int ph = 0; ph < N_PHASES; ++ph) {
        if (ph == 2 + PH_PER_LAYER + 0 || ph == 2 + PH_PER_LAYER + 5 || ph == 2 + PH_PER_LAYER + 6) continue;
        p.ph_lo = ph; p.ph_hi = ph + 1;
        hipLaunchKernelGGL(mega_fwd, dim3(grid), dim3(NTHR), LDS_BYTES, stream, p);
    }
#else
    p.ph_lo = 0; p.ph_hi = N_PHASES;
    hipLaunchKernelGGL(mega_fwd, dim3(grid), dim3(NTHR), LDS_BYTES, stream, p);
#endif
    const hipError_t le = hipPeekAtLastError();
    if (le != hipSuccess) fprintf(stderr, "kernel_launch: launch failed: %s\n", hipGetErrorName(le));
}
```

```cpp
#define MK_PER_PHASE 0
#include <hip/hip_runtime.h>
#include <cstdio>
#include <cstdint>

#define GAS __attribute__((address_space(1)))
#define LAS __attribute__((address_space(3)))
typedef unsigned short bf16_t;
typedef short bf16x8 __attribute__((ext_vector_type(8)));
typedef short s16x4 __attribute__((ext_vector_type(4)));
typedef float f32x4 __attribute__((ext_vector_type(4)));
typedef float f32x2 __attribute__((ext_vector_type(2)));
typedef float f32x16 __attribute__((ext_vector_type(16)));
typedef unsigned u32x4 __attribute__((ext_vector_type(4)));
typedef unsigned u32x2 __attribute__((ext_vector_type(2)));

constexpr int DM = 2048, SEQ = 16384, CTXL = 256, TT = SEQ + CTXL;
constexpr int NEXP = 64, NEX1 = 65, EHID = 512, TOPK = 8;
constexpr int EV_IN = 5120, OD_IN = 4608;
constexpr float LN_EPS = 1e-6f;
constexpr float ALPHA = 1.4142135623730951f;
constexpr float LAMBDA_INIT = 0.35550906759f;
constexpr int NTHR = 512, NWAVES = 8;

constexpr size_t al256(size_t x) { return (x + 255) / 256 * 256; }
constexpr size_t WS_CTL   = 0;
constexpr size_t CTL_BYTES = 1u << 20;
constexpr size_t WS_MODP  = WS_CTL + CTL_BYTES;
constexpr size_t WS_MODF  = WS_MODP + al256((size_t)2 * 32 * 2 * 12288 * 4);
constexpr size_t WS_ROPE128 = WS_MODF + al256((size_t)2 * 2 * 12288 * 4);
constexpr size_t WS_ROPE64  = WS_ROPE128 + al256((size_t)256 * 64 * 2 * 4);
constexpr size_t WS_KN    = WS_ROPE64 + al256((size_t)256 * 32 * 2 * 4);
constexpr size_t WS_WT    = WS_KN + al256((size_t)2 * 64 * 16 * 1024 * 2);
constexpr size_t WS_APOW  = WS_WT + al256((size_t)2 * 64 * 128 * 1024 * 2);
constexpr size_t WS_AL    = WS_APOW + al256((size_t)2 * 64 * 64 * 128 * 4);
constexpr size_t WS_CC    = WS_AL + al256((size_t)2 * 64 * 128 * 4);
constexpr size_t WS_BBT   = WS_CC + al256((size_t)64 * 16 * 128 * 2);
constexpr size_t WS_S5E   = WS_BBT + al256((size_t)2 * 64 * 128 * 16 * 2);
constexpr size_t WS_HST   = WS_S5E + al256((size_t)2 * 64 * 260 * 128 * 4);
constexpr size_t WS_WIN0  = WS_HST + al256((size_t)2 * 64 * 260 * 128 * 4);
constexpr size_t WS_WOUT0 = WS_WIN0 + al256((size_t)EV_IN * DM * 2);
constexpr size_t WS_WGLU  = WS_WOUT0 + al256((size_t)DM * DM * 2);
constexpr size_t WS_WIN1  = WS_WGLU + al256((size_t)1024 * 1024 * 2);
constexpr size_t WS_WOUT1 = WS_WIN1 + al256((size_t)OD_IN * DM * 2);
constexpr size_t WS_RWT   = WS_WOUT1 + al256((size_t)DM * DM * 2);
constexpr size_t WS_GU    = WS_RWT + al256((size_t)2 * 2 * 64 * DM * 2);
constexpr size_t WS_DT    = WS_GU + al256((size_t)NEX1 * 1024 * DM * 2);
constexpr size_t WS_XA    = WS_DT + al256((size_t)NEX1 * DM * EHID * 2);
constexpr size_t WS_Z     = WS_XA + al256((size_t)TT * DM * 2);
constexpr size_t WS_YMIX  = WS_Z + al256((size_t)TT * 1024 * 2);
constexpr size_t WS_X1    = WS_YMIX + al256((size_t)TT * DM * 2);
constexpr size_t WS_HX2   = WS_X1 + al256((size_t)TT * DM * 4);
constexpr size_t WS_LIST  = WS_HX2 + al256((size_t)9 * TT * EHID * 2);
constexpr size_t WS_WGT   = WS_LIST + al256((size_t)NEX1 * TT * 4);
constexpr size_t WS_LW    = WS_WGT + al256((size_t)8 * TT * 4);
constexpr size_t WS_BIG   = WS_LW + al256((size_t)NEX1 * TT * 4);
constexpr size_t BG_QKV   = 0;
constexpr size_t BG_CKV   = BG_QKV + al256((size_t)TT * EV_IN * 2);
constexpr size_t BG_SPREV = BG_CKV + al256((size_t)8 * 130 * 65536 * 4);
constexpr size_t BG_MIX   = BG_SPREV + al256((size_t)8 * 130 * 65536 * 2);
constexpr size_t BG_END0  = BG_MIX + al256((size_t)TT * DM * 2);
constexpr size_t BG_ATT   = BG_CKV;
constexpr size_t BG_Q8    = BG_ATT + al256((size_t)SEQ * 3072 * 2);
constexpr size_t BG_K8    = BG_Q8 + al256((size_t)TT * 1024);
constexpr size_t BG_VT8   = BG_K8 + al256((size_t)TT * 256);
constexpr size_t BG_Q8D   = BG_VT8 + al256((size_t)2 * 260 * 128 * 64);
constexpr size_t BG_K8D   = BG_Q8D + al256((size_t)TT * 1024);
constexpr size_t BG_VT8D  = BG_K8D + al256((size_t)TT * 1024);
constexpr size_t BG_F8END = BG_VT8D + al256((size_t)8 * 260 * 128 * 64);
constexpr size_t BG_YMOE  = 0;
constexpr size_t BG_END1  = al256((size_t)9 * TT * DM * 2);
constexpr size_t BG_SIZE  = BG_END0 > BG_END1 ? BG_END0 : BG_END1;
static_assert(BG_F8END <= BG_SIZE, "fp8 attention operands inside the big region");
constexpr size_t WS_END   = WS_BIG + BG_SIZE;

constexpr int CW_BAR = 4096;
constexpr int CW_CNT = 16384;
constexpr int CW_QUEUE = 20480;
constexpr int CW_KMAX = 24576;

constexpr int RING_BYTES = 151552;
constexpr int MISC_OFF = RING_BYTES;
constexpr int LDS_BYTES = 159744;

typedef __bf16 bf16x2_t __attribute__((ext_vector_type(2)));
__device__ __forceinline__ unsigned cvt_pk_bf16(float lo, float hi) { const f32x2 v = {lo, hi}; return __builtin_bit_cast(unsigned, __builtin_convertvector(v, bf16x2_t)); }
__device__ __forceinline__ bf16_t f2bf(float f) { unsigned u = __builtin_bit_cast(unsigned, f); return (bf16_t)((u + 0x7fffu + ((u >> 16) & 1u)) >> 16); }
__device__ __forceinline__ float bf2f(bf16_t b) { return __builtin_bit_cast(float, ((unsigned)b) << 16); }
__device__ __forceinline__ float bflo(unsigned w) { return __builtin_bit_cast(float, w << 16); }
__device__ __forceinline__ float bfhi(unsigned w) { return __builtin_bit_cast(float, w & 0xffff0000u); }
__device__ __forceinline__ float wave_sum(float v) {
#pragma unroll
    for (int o = 1; o < 64; o <<= 1) v += __shfl_xor(v, o);
    return v;
}
__device__ __forceinline__ float fast_exp(float x) { return __builtin_amdgcn_exp2f(x * 1.4426950408889634f); }
__device__ __forceinline__ float sigmoidf_(float x) { return 1.0f / (1.0f + __expf(-x)); }
__device__ __forceinline__ float siluf_(float x) { return x / (1.0f + __expf(-x)); }
__device__ __forceinline__ float gelu_tanh(float x) {
    const float u = 0.7978845608028654f * (x + 0.044715f * x * x * x);
    const float e = __expf(2.0f * u);
    const float t = 1.0f - 2.0f / (e + 1.0f);
    return 0.5f * x * (1.0f + t);
}
#define LDS_WAIT() asm volatile("s_waitcnt lgkmcnt(0)" ::: "memory")
#define VM_WAIT() asm volatile("s_waitcnt vmcnt(0)" ::: "memory")

#define XB_TMO      128
#define XB_XCNT(j)  (256  + 64 * (j))
#define XB_XSUB(j)  (1280 + 64 * (j))
#define XB_XGEN(j)  (2304 + 64 * (j))
#define XB_TOP      3328
#define XB_TOPGEN   3392
#define XCD_BAR_WORDS 3456
#define XB_SPIN_CAP (1u << 22)

__device__ __forceinline__ unsigned xb_ld(unsigned* p)              { return __hip_atomic_load(p, __ATOMIC_RELAXED, __HIP_MEMORY_SCOPE_AGENT); }
__device__ __forceinline__ unsigned xb_add(unsigned* p, unsigned v) { return __hip_atomic_fetch_add(p, v, __ATOMIC_RELAXED, __HIP_MEMORY_SCOPE_AGENT); }
__device__ __forceinline__ unsigned xb_xcc_id() { return (unsigned)__builtin_amdgcn_s_getreg((3 << 11) | 20) & 0xFu; }
#define XB_SPIN(cond, bar) do { unsigned _sp = 0; while (cond) { __builtin_amdgcn_s_sleep(1); \
    if ((++_sp & 255u) == 0u) { if (xb_ld(&(bar)[XB_TMO])) break; if (_sp > XB_SPIN_CAP) { atomicAdd(&(bar)[XB_TMO], 1u); break; } } } } while (0)

struct XcdBarrier { unsigned* bar; unsigned x; volatile LAS unsigned* st; };

__device__ __forceinline__ XcdBarrier xcd_barrier_post(unsigned* bar, volatile LAS unsigned* st) {
    XcdBarrier b; b.bar = bar; b.x = xb_xcc_id(); b.st = st;
    if (threadIdx.x == 0) { st[2] = xb_add(&bar[XB_XCNT(b.x)], 1u); st[3] = b.x; }
    return b;
}
__device__ __forceinline__ void xcd_barrier_complete(unsigned* bar, unsigned x, unsigned& nloc, unsigned& nx) {
    const unsigned G = gridDim.x * gridDim.y * gridDim.z;
    unsigned sum, cnt, mine, sp = 0u;
    for (;;) {
        sum = 0u; cnt = 0u; mine = 0u;
#pragma unroll
        for (unsigned j = 0; j < 16; ++j) { const unsigned c = xb_ld(&bar[XB_XCNT(j)]); sum += c; cnt += (c > 0u) ? 1u : 0u; mine = (j == x) ? c : mine; }
        if (sum == G) break;
        __builtin_amdgcn_s_sleep(1);
        if ((++sp & 255u) == 0u) { if (xb_ld(&bar[XB_TMO])) break; if (sp > XB_SPIN_CAP) { atomicAdd(&bar[XB_TMO], 1u); break; } }
    }
    nloc = mine > 0u ? mine : 1u; nx = cnt > 0u ? cnt : 1u;
}
__device__ __forceinline__ void xcd_barrier(const XcdBarrier& b, int wave_id) {
    const bool leader_thread = (wave_id == 0) && (__builtin_amdgcn_mbcnt_hi(~0u, __builtin_amdgcn_mbcnt_lo(~0u, 0u)) == 0u);
    asm volatile("s_waitcnt vmcnt(0)" ::: "memory");
    __syncthreads();
    if (leader_thread) {
        unsigned* bar = b.bar;
        __builtin_amdgcn_s_waitcnt(0);
        unsigned nloc = b.st[0], nx = b.st[1];
        if (nloc == 0u) { xcd_barrier_complete(bar, b.x, nloc, nx); b.st[0] = nloc; b.st[1] = nx; }
        const unsigned old = xb_add(&bar[XB_XSUB(b.x)], 1u);
        const unsigned gen = old / nloc;
        if (old + 1u == (gen + 1u) * nloc) {
            __builtin_amdgcn_fence(__ATOMIC_RELEASE, "agent");
            asm volatile("s_waitcnt vmcnt(0)" ::: "memory");
            const unsigned og = xb_add(&bar[XB_TOP], 1u);
            const unsigned tg = og / nx;
            if (og + 1u == (tg + 1u) * nx) xb_add(&bar[XB_TOPGEN], 1u);
            else XB_SPIN(xb_ld(&bar[XB_TOPGEN]) == tg, bar);
            __builtin_amdgcn_fence(__ATOMIC_ACQUIRE, "agent");
            xb_add(&bar[XB_XGEN(b.x)], 1u);
            asm volatile("s_waitcnt vmcnt(0)" ::: "memory");
        } else {
            XB_SPIN(xb_ld(&bar[XB_XGEN(b.x)]) == gen, bar);
            __builtin_amdgcn_fence(__ATOMIC_ACQUIRE, "agent");
            asm volatile("s_waitcnt vmcnt(0)" ::: "memory");
        }
    }
    __syncthreads();
}

__device__ __forceinline__ bf16x8 frag_rowk_l(const LAS bf16_t* p, int ld, int lane) {
    return *(const LAS bf16x8*)(p + (lane & 15) * ld + (lane >> 4) * 8);
}
__device__ __forceinline__ bf16x8 frag_rowk_g(const bf16_t* p, long ld, int lane) {
    return *(const bf16x8*)(p + (long)(lane & 15) * ld + (lane >> 4) * 8);
}
__device__ __forceinline__ bf16x8 frag_colk_l(unsigned p, int ldb, int lane) {
    const unsigned a0 = p + (unsigned)((8 * (lane >> 4) + ((lane & 15) >> 2)) * ldb + (lane & 3) * 8);
    const unsigned a1 = a0 + 4u * (unsigned)ldb;
    s16x4 lo, hi;
    asm volatile("ds_read_b64_tr_b16 %0, %2\n\tds_read_b64_tr_b16 %1, %3\n\ts_waitcnt lgkmcnt(0)" : "=&v"(lo), "=&v"(hi) : "v"(a0), "v"(a1) : "memory");
    return (bf16x8){lo[0], lo[1], lo[2], lo[3], hi[0], hi[1], hi[2], hi[3]};
}
#define MFMA16(a, b, c) __builtin_amdgcn_mfma_f32_16x16x32_bf16((a), (b), (c), 0, 0, 0)
namespace pg8 {
constexpr int BM = 256, BK = 64, HALF = 128, HTB = HALF * BK * 2, STAGE_BYTES = 8 * HTB, NXCD = 8, WGM = 8;
__device__ __forceinline__ int lds_byte(int r, int c) { const int st = (r >> 4) * 2 + (c >> 5), rr = r & 15, cc = c & 31, ob = rr * 64 + cc * 2; return st * 1024 + (ob ^ (((ob >> 9) & 1) << 5)); }
__device__ __forceinline__ void stage_rc(int b, int& R, int& C) { const int st = b / 1024, sb = b % 1024, swz = sb ^ (((sb >> 9) & 1) << 5); R = (st >> 1) * 16 + swz / 64; C = (st & 1) * 32 + (swz % 64) / 2; }
__device__ __forceinline__ int perm32(int rho) { const int n = rho >> 4, i = rho & 15; return 8 * (i >> 2) + 4 * n + (i & 3); }

struct Unit { int pm, pn, e; };
constexpr float WSCALE = 32.0f, WSCALE_INV = 1.0f / 32.0f;

struct DenseOrder {
    const bf16_t* A; const bf16_t* Bt; int ldab, kb, nM, nN, nwg, G, c;
    __device__ __forceinline__ void init(const bf16_t* A_, int lda_, const bf16_t* Bt_, int M, int N, int K_, int G_, int c_) { A = A_; ldab = lda_ * 2; Bt = Bt_; kb = K_ * 2; nM = M / BM; nN = N / BM; nwg = nM * nN; G = G_; c = c_; }
    __device__ __forceinline__ void init8(const void* A_, int ldab_, const void* Bt_, int M, int N, int K_, int G_, int c_) { A = (const bf16_t*)A_; ldab = ldab_; Bt = (const bf16_t*)Bt_; kb = K_; nM = M / BM; nN = N / BM; nwg = nM * nN; G = G_; c = c_; }
    __device__ __forceinline__ void prep(LAS unsigned char*) const {}
    __device__ __forceinline__ int units_of_me() const { return c < nwg ? (nwg - c + G - 1) / G : 0; }
    __device__ __forceinline__ int max_units() const { return (nwg + G - 1) / G; }
    __device__ __forceinline__ bool next(int i, Unit& u) const {
        const long L = (long)i * G + c; if (L >= nwg) return false;
        int wgid = (int)L; { const int q = nwg / NXCD, r = nwg % NXCD, xcd = wgid % NXCD, off = wgid / NXCD; wgid = (xcd < r ? xcd * (q + 1) : r * (q + 1) + (xcd - r) * q) + off; }
        const int nig = WGM * nN, gid = wgid / nig, fm = gid * WGM, gsz = (nM - fm) < WGM ? (nM - fm) : WGM;
        u.pm = fm + ((wgid % nig) % gsz); u.pn = (wgid % nig) / gsz; u.e = 0; return true;
    }
    __device__ __forceinline__ const char* a_base() const { return (const char*)A; }
    __device__ __forceinline__ unsigned a_off(const Unit& u, int r) const { return (unsigned)(u.pm * BM + r) * (unsigned)ldab; }
    __device__ __forceinline__ const char* b_ptr(const Unit& u) const { return (const char*)Bt + (size_t)u.pn * BM * kb; }
};

template <int MODE  >
struct MoeOrder {
    const void* A; const void* Bt; const int* list; const int* cnt; int ldab, kb, nN, G, c; size_t bstride;
    LAS int* tp; LAS int* cn; LAS int* rb;
    __device__ __forceinline__ void prep(LAS unsigned char* misc, int tid) {
        tp = (LAS int*)(misc + 64); cn = tp + 72; rb = cn + 72;
        if (tid < NEX1) cn[tid] = cnt[tid];
        __syncthreads();
        if (tid == 0) { int s = 0, q = 0; for (int e = 0; e < NEX1; ++e) { tp[e] = s; rb[e] = q; s += (cn[e] + BM - 1) / BM; q += cn[e]; } tp[NEX1] = s; rb[NEX1] = q; }
        __syncthreads();
    }
    __device__ __forceinline__ bool next(int i, Unit& u) const {
        const int total = tp[NEX1]; const long nu = (long)total * nN; const int per = (int)((nu + G - 1) / G);
        (void)per;
        long L = (long)i * G + c;
        if ((G & 7) == 0) L = ((long)i * 8 + (c & 7)) * (G >> 3) + (c >> 3);
        if (L >= nu) return false;
        const int tile = (int)(L / nN); u.pn = (int)(L % nN);
        int e = 0;
        for (int k = 1; k < NEX1; ++k) e += (tp[k] <= tile) ? 1 : 0;
        u.e = e; u.pm = tile - tp[e]; return true;
    }
    __device__ __forceinline__ const char* a_base() const { return (const char*)A; }
    __device__ __forceinline__ unsigned a_off(const Unit& u, int r) const {
        int pos = u.pm * BM + r; const int n = cn[u.e]; pos = pos < n ? pos : n - 1;
        if (MODE == 1) return (unsigned)(rb[u.e] + pos) * (unsigned)ldab;
        const int a = list[u.e * TT + pos];
        const int row = a < 8 * TT ? (a >> 3) : a - 8 * TT;
        return (unsigned)row * (unsigned)ldab;
    }
    __device__ __forceinline__ const char* b_ptr(const Unit& u) const { return (const char*)Bt + (size_t)u.e * bstride + (size_t)u.pn * BM * kb; }
};

typedef int v8i32 __attribute__((ext_vector_type(8)));
typedef int v4i32_ __attribute__((ext_vector_type(4)));
__device__ __forceinline__ v8i32 cat8(bf16x8 a, bf16x8 b) { const u32x4 x = __builtin_bit_cast(u32x4, a), y = __builtin_bit_cast(u32x4, b); return (v8i32){(int)x.x, (int)x.y, (int)x.z, (int)x.w, (int)y.x, (int)y.y, (int)y.z, (int)y.w}; }
template <bool FP8, class Epi, class Sched>
__device__ __forceinline__ void gemm_phase(LAS unsigned char* lds, const Sched& S, const Epi& E, int wave_id) {
    const int wid = wave_id; int lane = (int)__builtin_amdgcn_mbcnt_hi(~0u, __builtin_amdgcn_mbcnt_lo(~0u, 0u)); asm volatile("" : "+v"(lane));
    const int tid = wid * 64 + lane, wr = wid >> 2, wc = wid & 3, fr = lane & 15, fq = lane >> 4;
    const int kb = S.kb; int nt = kb / 128; asm volatile("" : "+s"(nt));
    unsigned voffB[2];
#pragma unroll
    for (int i = 0; i < 2; ++i) { int R, C; stage_rc(tid * 16 + i * 8192, R, C); const int Rb = (R & ~31) + perm32(R & 31);
        voffB[i] = (unsigned)(Rb * kb) + (unsigned)C * 2u; }
#define PG8_AOFF(u, h, i) ({ int _tz = tid; asm volatile("" : "+v"(_tz)); int _R, _C; stage_rc(_tz * 16 + (i) * 8192, _R, _C); S.a_off((u), (h) * HALF + _R) + (unsigned)_C * 2u; })
    const size_t kstep = (size_t)(BK * 2);
    const size_t hstepB = (size_t)HALF * kb;
    const unsigned ldsw = (unsigned)wid * 1024u;
    const int aoff = lds_byte(wr * 64 + fr, fq * 8), boff = lds_byte(wc * 32 + fr, fq * 8);
#define PG8_SA(b, h) (((b) * 2 + (h)) * HTB)
#define PG8_SB(b, h) ((4 + (b) * 2 + (h)) * HTB)
#define PG8_STAGE(bufoff, gbase, v0, v1) do { \
        __builtin_amdgcn_global_load_lds((const unsigned*)((const char*)(gbase) + (v0)), (LAS unsigned*)(lds + (bufoff) + ldsw), 16, 0, 0); \
        __builtin_amdgcn_global_load_lds((const unsigned*)((const char*)(gbase) + (v1)), (LAS unsigned*)(lds + (bufoff) + ldsw + 8192), 16, 0, 0); } while (0)
#define PG8_VOFFB(i) ({ int _tz = tid; asm volatile("" : "+v"(_tz)); int _R, _C; stage_rc(_tz * 16 + (i) * 8192, _R, _C); (unsigned)(((_R & ~31) + perm32(_R & 31)) * kb) + (unsigned)_C * 2u; })
#define PG8_STAGE_B(bufoff, gbase) do { if constexpr (FP8) { int _tz = tid; asm volatile("" : "+v"(_tz)); const u32x2 _vv = *(const LAS u32x2*)(lds + STAGE_BYTES + 8192 + _tz * 8); PG8_STAGE(bufoff, gbase, _vv.x, _vv.y); } else PG8_STAGE(bufoff, gbase, voffB[0], voffB[1]); } while (0)
#define PG8_LD8(off) __builtin_shufflevector(*(const LAS v4i32_*)(lds + (off)), *(const LAS v4i32_*)(lds + (off) + 1024), 0, 1, 2, 3, 4, 5, 6, 7)
#define PG8_LDA(dst, b, h) do { _Pragma("unroll") for (int m = 0; m < 4; ++m) { if constexpr (FP8) dst##8[m] = PG8_LD8(PG8_SA(b, h) + aoff + m * 2048); else { _Pragma("unroll") for (int k = 0; k < 2; ++k) dst[m][k] = *(const LAS bf16x8*)(lds + PG8_SA(b, h) + aoff + m * 2048 + k * 1024); } } } while (0)
#define PG8_LDB(dst, b, h) do { _Pragma("unroll") for (int n = 0; n < 2; ++n) { if constexpr (FP8) dst##8[n] = PG8_LD8(PG8_SB(b, h) + boff + n * 2048); else { _Pragma("unroll") for (int k = 0; k < 2; ++k) dst[n][k] = *(const LAS bf16x8*)(lds + PG8_SB(b, h) + boff + n * 2048 + k * 1024); } } } while (0)
#define PG8_MMA(ai, bj, At, Bt) do { __builtin_amdgcn_s_setprio(1); _Pragma("unroll") for (int m = 0; m < 4; ++m) _Pragma("unroll") for (int n = 0; n < 2; ++n) { \
        if constexpr (FP8) asm volatile("v_mfma_f32_16x16x128_f8f6f4 %0, %1, %2, %0" : "+v"(acc[ai][bj][m][n]) : "v"(Bt##8[n]), "v"(At##8[m])); \
        else { _Pragma("unroll") for (int k = 0; k < 2; ++k) acc[ai][bj][m][n] = __builtin_amdgcn_mfma_f32_16x16x32_bf16(Bt[n][k], At[m][k], acc[ai][bj][m][n], 0, 0, 0); } } \
        __builtin_amdgcn_s_setprio(0); } while (0)
#define PG8_WAIT_V(n) asm volatile("s_waitcnt vmcnt(" #n ")" ::: "memory")
#define PG8_WAIT_L(n) asm volatile("s_waitcnt lgkmcnt(" #n ")" ::: "memory")
#define PG8_BAR __builtin_amdgcn_s_barrier()
#define PG8_SCHED __builtin_amdgcn_sched_barrier(0)
    if constexpr (FP8) { u32x2 _vb; _vb.x = PG8_VOFFB(0); _vb.y = PG8_VOFFB(1); *(LAS u32x2*)(lds + STAGE_BYTES + 8192 + tid * 8) = _vb; }
    Unit cur, nxt; int ui = 0;
    if (!S.next(0, cur)) return;
    f32x4 acc[2][2][4][2];
#pragma unroll
    for (int a = 0; a < 2; ++a)
#pragma unroll
        for (int b = 0; b < 2; ++b)
#pragma unroll
            for (int m = 0; m < 4; ++m)
#pragma unroll
                for (int n = 0; n < 2; ++n) acc[a][b][m][n] = (f32x4){0.f, 0.f, 0.f, 0.f};
    bf16x8 At[4][2], B0[2][2], B1[2][2]; v8i32 At8[4], B08[2], B18[2];
    const char* const gA = S.a_base();
    const char* cB = S.b_ptr(cur);
    unsigned oc00, oc01, oc10, oc11;
    oc00 = PG8_AOFF(cur, 0, 0); oc01 = PG8_AOFF(cur, 0, 1); oc10 = PG8_AOFF(cur, 1, 0); oc11 = PG8_AOFF(cur, 1, 1);
    PG8_STAGE_B(PG8_SB(0, 0), cB); PG8_STAGE_B(PG8_SB(0, 1), cB + hstepB); PG8_STAGE(PG8_SA(0, 0), gA, oc00, oc01); PG8_STAGE(PG8_SA(0, 1), gA, oc10, oc11);
    if (wr == 1) PG8_BAR;
    PG8_WAIT_V(2); PG8_BAR;
    PG8_STAGE_B(PG8_SB(1, 0), cB + kstep); PG8_STAGE(PG8_SA(1, 0), gA + kstep, oc00, oc01); PG8_STAGE_B(PG8_SB(1, 1), cB + hstepB + kstep);
    PG8_WAIT_V(6); PG8_BAR;
    for (;;) {
        const bool has_next = S.next(ui + 1, nxt);
        const char* nB = cB;
        {
            u32x4 on = {oc00, oc01, oc10, oc11};
            if (has_next) { on.x = PG8_AOFF(nxt, 0, 0); on.y = PG8_AOFF(nxt, 0, 1); on.z = PG8_AOFF(nxt, 1, 0); on.w = PG8_AOFF(nxt, 1, 1); nB = S.b_ptr(nxt); }
            *(LAS u32x4*)(lds + STAGE_BYTES + tid * 16) = on;
        }
        for (int t = 0; t < nt; t += 2) {
            const bool last = (t == nt - 2);
            const char* a1 = gA + (size_t)(t + 1) * kstep;
            const char* a2 = last ? gA : gA + (size_t)(t + 2) * kstep; const char* b2 = last ? nB : cB + (size_t)(t + 2) * kstep;
            const char* a3 = a2 + kstep; const char* b3 = b2 + kstep;
            unsigned s00 = oc00, s01 = oc01, s10 = oc10, s11 = oc11;
            if (last) { const u32x4 on = *(const LAS u32x4*)(lds + STAGE_BYTES + tid * 16); s00 = on.x; s01 = on.y; s10 = on.z; s11 = on.w; }
            PG8_LDB(B0, 0, 0); PG8_LDB(B1, 0, 1); PG8_SCHED; PG8_LDA(At, 0, 0); PG8_STAGE(PG8_SA(1, 1), a1, oc10, oc11);
            PG8_WAIT_V(8); PG8_WAIT_L(0); PG8_BAR; PG8_MMA(0, 0, At, B0); PG8_MMA(0, 1, At, B1); PG8_BAR; PG8_SCHED;
            PG8_LDA(At, 0, 1); PG8_STAGE_B(PG8_SB(0, 0), b2); PG8_STAGE_B(PG8_SB(0, 1), b2 + hstepB); PG8_STAGE(PG8_SA(0, 0), a2, s00, s01);
            PG8_WAIT_V(8); PG8_WAIT_L(0); PG8_BAR; PG8_MMA(1, 0, At, B0); PG8_MMA(1, 1, At, B1); PG8_BAR; PG8_SCHED;
            PG8_LDB(B0, 1, 0); PG8_LDB(B1, 1, 1); PG8_SCHED; PG8_LDA(At, 1, 0); PG8_STAGE(PG8_SA(0, 1), a2, s10, s11);
            PG8_WAIT_V(8); PG8_WAIT_L(0); PG8_BAR; PG8_MMA(0, 0, At, B0); PG8_MMA(0, 1, At, B1); PG8_BAR; PG8_SCHED;
            PG8_LDA(At, 1, 1); PG8_STAGE_B(PG8_SB(1, 0), b3); PG8_STAGE_B(PG8_SB(1, 1), b3 + hstepB); PG8_STAGE(PG8_SA(1, 0), a3, s00, s01);
            PG8_WAIT_V(8); PG8_WAIT_L(0); PG8_BAR; PG8_MMA(1, 0, At, B0); PG8_MMA(1, 1, At, B1); PG8_BAR; PG8_SCHED;
        }
        if (wr == 0) PG8_BAR;
        E(acc, cur, wr, wc, fr, fq);
        if (!has_next) break;
#pragma unroll
        for (int a = 0; a < 2; ++a)
#pragma unroll
            for (int b = 0; b < 2; ++b)
#pragma unroll
                for (int m = 0; m < 4; ++m)
#pragma unroll
                    for (int n = 0; n < 2; ++n) acc[a][b][m][n] = (f32x4){0.f, 0.f, 0.f, 0.f};
        { const u32x4 on = *(const LAS u32x4*)(lds + STAGE_BYTES + tid * 16); oc00 = on.x; oc01 = on.y; oc10 = on.z; oc11 = on.w; }
        cur = nxt; cB = nB; ++ui;
        if (wr == 1) PG8_BAR;
    }
    PG8_WAIT_V(0);
    PG8_BAR;
#undef PG8_SA
#undef PG8_SB
#undef PG8_STAGE
#undef PG8_STAGE_B
#undef PG8_AOFF
#undef PG8_VOFFB
#undef PG8_LD8
#undef PG8_LDA
#undef PG8_LDB
#undef PG8_MMA
#undef PG8_WAIT_V
#undef PG8_WAIT_L
#undef PG8_BAR
#undef PG8_SCHED
}

struct EpiStore {
    bf16_t* O; int ldc; float scale;
    __device__ __forceinline__ void operator()(const f32x4 (&acc)[2][2][4][2], const Unit& u, int wr, int wc, int fr, int fq) const {
        const int row0 = u.pm * BM + wr * 64 + fr, col0 = u.pn * BM + wc * 32 + 8 * fq;
#pragma unroll
        for (int ai = 0; ai < 2; ++ai)
#pragma unroll
            for (int m = 0; m < 4; ++m) { bf16_t* rowp = O + (size_t)(row0 + ai * HALF + m * 16) * ldc + col0;
#pragma unroll
                for (int bj = 0; bj < 2; ++bj) { const f32x4 v0 = acc[ai][bj][m][0] * scale, v1 = acc[ai][bj][m][1] * scale;
                    u32x4 w; w.x = cvt_pk_bf16(v0[0], v0[1]); w.y = cvt_pk_bf16(v0[2], v0[3]); w.z = cvt_pk_bf16(v1[0], v1[1]); w.w = cvt_pk_bf16(v1[2], v1[3]);
                    *(u32x4*)(rowp + bj * HALF) = w; } }
    }
};
struct EpiGlu {
    const bf16_t* Z; const float* b; bf16_t* MIX;
    __device__ __forceinline__ void operator()(const f32x4 (&acc)[2][2][4][2], const Unit& u, int wr, int wc, int fr, int fq) const {
        const int row0 = u.pm * BM + wr * 64 + fr, col0 = u.pn * BM + wc * 32 + 8 * fq;
#pragma unroll
        for (int bj = 0; bj < 2; ++bj) {
            const f32x4 b0 = *(const f32x4*)(b + col0 + bj * HALF), b1 = *(const f32x4*)(b + col0 + bj * HALF + 4);
#pragma unroll
            for (int ai = 0; ai < 2; ++ai)
#pragma unroll
                for (int m = 0; m < 4; ++m) { const size_t row = (size_t)(row0 + ai * HALF + m * 16);
                    const u32x4 zz = *(const u32x4*)(Z + row * 1024 + col0 + bj * HALF);
                    const f32x4 v0 = acc[ai][bj][m][0] + b0, v1 = acc[ai][bj][m][1] + b1;
                    u32x4 w;
                    w.x = cvt_pk_bf16(bflo(zz.x) * sigmoidf_(v0[0]), bfhi(zz.x) * sigmoidf_(v0[1]));
                    w.y = cvt_pk_bf16(bflo(zz.y) * sigmoidf_(v0[2]), bfhi(zz.y) * sigmoidf_(v0[3]));
                    w.z = cvt_pk_bf16(bflo(zz.z) * sigmoidf_(v1[0]), bfhi(zz.z) * sigmoidf_(v1[1]));
                    w.w = cvt_pk_bf16(bflo(zz.w) * sigmoidf_(v1[2]), bfhi(zz.w) * sigmoidf_(v1[3]));
                    *(u32x4*)(MIX + row * DM + 1024 + col0 + bj * HALF) = w; }
        }
    }
};
struct EpiE1 {
    unsigned char* H; const LAS int* cn; const LAS int* rb;
    __device__ __forceinline__ void operator()(const f32x4 (&acc)[2][2][4][2], const Unit& u, int wr, int wc, int fr, int fq) const {
        const int n = cn[u.e]; const int colh = u.pn * 128 + wc * 32 + 8 * fq;
#pragma unroll
        for (int ai = 0; ai < 2; ++ai)
#pragma unroll
            for (int m = 0; m < 4; ++m) { const int pos = u.pm * BM + ai * HALF + wr * 64 + m * 16 + fr;
                if (pos < n) { const int a = rb[u.e] + pos;
                    float sc = WSCALE_INV; asm volatile("" : "+v"(sc));
                    const f32x4 g0 = acc[ai][0][m][0] * sc, g1 = acc[ai][0][m][1] * sc, u0 = acc[ai][1][m][0] * sc, u1 = acc[ai][1][m][1] * sc;
                    u32x2 w;
                    w.x = (unsigned)__builtin_amdgcn_cvt_pk_fp8_f32(siluf_(g0[0]) * u0[0], siluf_(g0[1]) * u0[1], 0, false);
                    w.x = (unsigned)__builtin_amdgcn_cvt_pk_fp8_f32(siluf_(g0[2]) * u0[2], siluf_(g0[3]) * u0[3], (int)w.x, true);
                    w.y = (unsigned)__builtin_amdgcn_cvt_pk_fp8_f32(siluf_(g1[0]) * u1[0], siluf_(g1[1]) * u1[1], 0, false);
                    w.y = (unsigned)__builtin_amdgcn_cvt_pk_fp8_f32(siluf_(g1[2]) * u1[2], siluf_(g1[3]) * u1[3], (int)w.y, true);
                    *(u32x2*)(H + (size_t)a * EHID + colh) = w; }
                __builtin_amdgcn_sched_barrier(0); }
    }
};
struct EpiE2 {
    unsigned char* Y; const float* wgt; const LAS int* cn; const LAS int* rb;
    __device__ __forceinline__ void operator()(const f32x4 (&acc)[2][2][4][2], const Unit& u, int wr, int wc, int fr, int fq) const {
        const int n = cn[u.e]; const int col0 = u.pn * BM + wc * 32 + 8 * fq;
        float wsv[8];
#pragma unroll
        for (int i = 0; i < 8; ++i) { const int pos = u.pm * BM + (i >> 2) * HALF + wr * 64 + (i & 3) * 16 + fr; wsv[i] = pos < n ? wgt[u.e * TT + pos] : 0.f; }
#pragma unroll
        for (int ai = 0; ai < 2; ++ai)
#pragma unroll
            for (int m = 0; m < 4; ++m) { const int pos = u.pm * BM + ai * HALF + wr * 64 + m * 16 + fr;
                if (pos < n) { const int a = rb[u.e] + pos; float ws = wsv[ai * 4 + m] * WSCALE_INV; asm volatile("" : "+v"(ws));
                    unsigned char* rowp = Y + (size_t)a * DM + col0;
#pragma unroll
                    for (int bj = 0; bj < 2; ++bj) { const f32x4 v0 = acc[ai][bj][m][0] * ws, v1 = acc[ai][bj][m][1] * ws;
                        u32x2 w;
                        w.x = (unsigned)__builtin_amdgcn_cvt_pk_fp8_f32(v0[0], v0[1], 0, false); w.x = (unsigned)__builtin_amdgcn_cvt_pk_fp8_f32(v0[2], v0[3], (int)w.x, true);
                        w.y = (unsigned)__builtin_amdgcn_cvt_pk_fp8_f32(v1[0], v1[1], 0, false); w.y = (unsigned)__builtin_amdgcn_cvt_pk_fp8_f32(v1[2], v1[3], (int)w.y, true);
                        *(u32x2*)(rowp + bj * HALF) = w; } }
                __builtin_amdgcn_sched_barrier(0); }
    }
};
}
struct KArgs {
    const float* in[34];
    float* out;
    unsigned char* ws;
    int ph_lo, ph_hi;
};
struct Params {
    float* out;
    unsigned char* ws;
    LAS unsigned long long* ptab;
    int ph_lo, ph_hi;
    __device__ __forceinline__ const float* inp(int k) const {
        const unsigned long long v = ptab[k];
        const unsigned lo = __builtin_amdgcn_readfirstlane((unsigned)v), hi = __builtin_amdgcn_readfirstlane((unsigned)(v >> 32));
        return (const float*)(((unsigned long long)hi << 32) | lo);
    }
};
struct Ctx {
    LAS unsigned char* lds;
    int tid, lane, wave, G, bid;
    int gw, ngw;
};

__device__ __forceinline__ void tr_item(const float* W, int N, bf16_t* WT, int ldt, int k0, int n0, int orow0, LAS float* scr, int lane) {
#pragma unroll 8
    for (int i = 0; i < 32; ++i) { const int kk = 2 * i + (lane >> 5); scr[kk * 33 + (lane & 31)] = W[(size_t)(k0 + kk) * N + n0 + (lane & 31)]; }
    LDS_WAIT(); asm volatile("" ::: "memory");
    const int c = lane & 7;
#pragma unroll
    for (int j = 0; j < 4; ++j) { const int n = (lane >> 3) + 8 * j; const LAS float* s = scr + (8 * c) * 33 + n;
        u32x4 o; o.x = cvt_pk_bf16(s[0 * 33], s[1 * 33]); o.y = cvt_pk_bf16(s[2 * 33], s[3 * 33]); o.z = cvt_pk_bf16(s[4 * 33], s[5 * 33]); o.w = cvt_pk_bf16(s[6 * 33], s[7 * 33]);
        *(u32x4*)(WT + (size_t)(orow0 + n) * ldt + k0 + 8 * c) = o; }
    LDS_WAIT(); asm volatile("" ::: "memory");
}
__device__ __forceinline__ void tr_item64(const float* W, int N, bf16_t* WT, int ldt, int k0, int n0, int orow0, LAS float* scr, int lane) {
    f32x4 v[16];
    const float* src = W + (size_t)(k0 + (lane >> 4)) * N + n0 + 4 * (lane & 15);
#pragma unroll
    for (int i = 0; i < 16; ++i) v[i] = __builtin_nontemporal_load((const f32x4*)(src + (size_t)(4 * i) * N));
#pragma unroll
    for (int i = 0; i < 16; ++i) { LAS float* d = scr + (4 * i + (lane >> 4)) * 65 + 4 * (lane & 15); d[0] = v[i][0]; d[1] = v[i][1]; d[2] = v[i][2]; d[3] = v[i][3]; }
    LDS_WAIT(); asm volatile("" ::: "memory");
    const int c = lane & 7;
#pragma unroll
    for (int j = 0; j < 8; ++j) { const int n = (lane >> 3) + 8 * j; const LAS float* s = scr + (8 * c) * 65 + n;
        u32x4 o; o.x = cvt_pk_bf16(s[0 * 65], s[1 * 65]); o.y = cvt_pk_bf16(s[2 * 65], s[3 * 65]); o.z = cvt_pk_bf16(s[4 * 65], s[5 * 65]); o.w = cvt_pk_bf16(s[6 * 65], s[7 * 65]);
        *(u32x4*)(WT + (size_t)(orow0 + n) * ldt + k0 + 8 * c) = o; }
    LDS_WAIT(); asm volatile("" ::: "memory");
}
__device__ __forceinline__ void tr_item64_fp8(const float* W, int N, unsigned char* WT, int ldt, int k0, int n0, int orow0, LAS float* scr, int lane, float wscale = pg8::WSCALE) {
    f32x4 v[16];
    const float* src = W + (size_t)(k0 + (lane >> 4)) * N + n0 + 4 * (lane & 15);
#pragma unroll
    for (int i = 0; i < 16; ++i) v[i] = __builtin_nontemporal_load((const f32x4*)(src + (size_t)(4 * i) * N));
#pragma unroll
    for (int i = 0; i < 16; ++i) { LAS float* d = scr + (4 * i + (lane >> 4)) * 65 + 4 * (lane & 15); d[0] = v[i][0]; d[1] = v[i][1]; d[2] = v[i][2]; d[3] = v[i][3]; }
    LDS_WAIT(); asm volatile("" ::: "memory");
    const int c = lane & 3;
#pragma unroll
    for (int j = 0; j < 4; ++j) { const int n = (lane >> 2) + 16 * j; const LAS float* s = scr + (16 * c) * 65 + n;
        u32x4 o;
        o.x = (unsigned)__builtin_amdgcn_cvt_pk_fp8_f32(s[0 * 65] * wscale, s[1 * 65] * wscale, 0, false);   o.x = (unsigned)__builtin_amdgcn_cvt_pk_fp8_f32(s[2 * 65] * wscale, s[3 * 65] * wscale, (int)o.x, true);
        o.y = (unsigned)__builtin_amdgcn_cvt_pk_fp8_f32(s[4 * 65] * wscale, s[5 * 65] * wscale, 0, false);   o.y = (unsigned)__builtin_amdgcn_cvt_pk_fp8_f32(s[6 * 65] * wscale, s[7 * 65] * wscale, (int)o.y, true);
        o.z = (unsigned)__builtin_amdgcn_cvt_pk_fp8_f32(s[8 * 65] * wscale, s[9 * 65] * wscale, 0, false);   o.z = (unsigned)__builtin_amdgcn_cvt_pk_fp8_f32(s[10 * 65] * wscale, s[11 * 65] * wscale, (int)o.z, true);
        o.w = (unsigned)__builtin_amdgcn_cvt_pk_fp8_f32(s[12 * 65] * wscale, s[13 * 65] * wscale, 0, false); o.w = (unsigned)__builtin_amdgcn_cvt_pk_fp8_f32(s[14 * 65] * wscale, s[15 * 65] * wscale, (int)o.w, true);
        *(u32x4*)(WT + (size_t)(orow0 + n) * ldt + k0 + 16 * c) = o; }
    LDS_WAIT(); asm volatile("" ::: "memory");
}
__device__ __forceinline__ void tr_dense(const float* W, int K, int N, bf16_t* WT, int item, LAS float* scr, int lane) {
    const int nblk = N / 32, kb = item / nblk, nb = item % nblk;
    tr_item(W, N, WT, K, 64 * kb, 32 * nb, 32 * nb, scr, lane);
}

__device__ __forceinline__ void s5_tables(const Params& p, Ctx& C, int dir, int g) {
    LAS f32x2* PW = (LAS f32x2*)C.lds;
    LAS f32x2* BB = PW + 65 * 64;
    LAS f32x2* CX = BB + 64 * 16;
    const float* a_re = p.inp(11); const float* a_im = p.inp(12); const float* log_dt = p.inp(13);
    const float* b_re = p.inp(14); const float* b_im = p.inp(15); const float* c_re = p.inp(16); const float* c_im = p.inp(17);
    const int tid = C.tid;
    if (tid < 64) {
        const int pp = tid;
        const float dt = __expf(log_dt[dir * 64 + g]);
        const float are = a_re[(dir * 64 + g) * 64 + pp], aim = a_im[(dir * 64 + g) * 64 + pp];
        const float zr = are * dt, zi = aim * dt;
        const float mag = __expf(zr);
        double rev = (double)zi * 0.15915494309189535; rev -= floor(rev);
        const float cs = __builtin_amdgcn_cosf((float)rev), sn = __builtin_amdgcn_sinf((float)rev);
        const float abr = mag * cs, abi = mag * sn;
        const float den = are * are + aim * aim, nr = abr - 1.0f, ni = abi;
        const float fre = (nr * are + ni * aim) / den, fim = (ni * are - nr * aim) / den;
        float pr = 1.0f, pi = 0.0f;
#pragma unroll 1
        for (int n = 0; n <= 64; ++n) { PW[n * 64 + pp] = (f32x2){pr, pi}; const float t = pr * abr - pi * abi; pi = pr * abi + pi * abr; pr = t; }
        for (int j = 0; j < 16; ++j) { const float br = b_re[(g * 64 + pp) * 16 + j], bi = b_im[(g * 64 + pp) * 16 + j];
            BB[pp * 16 + j] = (f32x2){fre * br - fim * bi, fre * bi + fim * br}; }
    }
    for (int q = tid; q < 1024; q += NTHR) { const int i = q >> 6, pp = q & 63; CX[i * 64 + pp] = (f32x2){c_re[(g * 16 + i) * 64 + pp], c_im[(g * 16 + i) * 64 + pp]}; }
    __syncthreads();
    bf16_t* KN = (bf16_t*)(p.ws + WS_KN) + (size_t)(dir * 64 + g) * 16 * 1024;
    float* APOW = (float*)(p.ws + WS_APOW) + (size_t)(dir * 64 + g) * 64 * 128;
    float* AL = (float*)(p.ws + WS_AL) + (size_t)(dir * 64 + g) * 128;
#pragma unroll 1
    for (int q = 0; q < 32; ++q) { const int idx = tid + NTHR * q; const int n = idx >> 8, i = (idx >> 4) & 15, j = idx & 15;
        float s = 0.f;
#pragma unroll 4
        for (int pp = 0; pp < 64; ++pp) { const f32x2 c = CX[i * 64 + pp], w = PW[n * 64 + pp], b = BB[pp * 16 + j];
            const float gr = c.x * b.x - c.y * b.y, gi = c.x * b.y + c.y * b.x;
            s += gr * w.x - gi * w.y; }
        KN[(size_t)i * 1024 + n * 16 + j] = f2bf(s); }
    for (int q = tid; q < 4096; q += NTHR) { const int t = q >> 6, pp = q & 63; const f32x2 w = PW[(t + 1) * 64 + pp]; *(f32x2*)(APOW + (size_t)t * 128 + 2 * pp) = w; }
    if (tid < 64) { const f32x2 w = PW[64 * 64 + tid]; *(f32x2*)(AL + 2 * tid) = w; }
    { bf16_t* BBT = (bf16_t*)(p.ws + WS_BBT) + (size_t)(dir * 64 + g) * 128 * 16;
      for (int q = tid; q < 2048; q += NTHR) { const int pq = q >> 4, j = q & 15; const f32x2 b = BB[(pq & 63) * 16 + j]; BBT[q] = f2bf(pq < 64 ? b.x : b.y); } }
    if (dir == 0) { bf16_t* CCt = (bf16_t*)(p.ws + WS_CC) + (size_t)g * 16 * 128;
        for (int q = tid; q < 2048; q += NTHR) { const int i = q >> 7, pq = q & 127; const f32x2 c = CX[i * 64 + (pq & 63)]; CCt[i * 128 + pq] = f2bf(pq < 64 ? c.x : -c.y); } }
    __syncthreads();
}

__device__ __forceinline__ void phase_p0(const Params& p, Ctx& C) {
    for (int task = C.bid; task < 128; task += C.G) s5_tables(p, C, task >> 6, task & 63);
    {
        const int gt = C.bid * NTHR + C.tid, ngt = C.G * NTHR;
        float* R128 = (float*)(p.ws + WS_ROPE128); float* R64 = (float*)(p.ws + WS_ROPE64);
        for (int q = gt; q < 256 * 64 + 256 * 32; q += ngt) {
            int pos, i, half; float* dst;
            if (q < 256 * 64) { pos = q >> 6; i = q & 63; half = 64; dst = R128 + (size_t)q * 2; }
            else { const int r = q - 256 * 64; pos = r >> 5; i = r & 31; half = 32; dst = R64 + (size_t)r * 2; }
            const float freq = exp2f(-(float)i / (float)half * 13.287712379549449f);
            const float ang = (float)pos * freq;
            double rev = (double)ang * 0.15915494309189535; rev -= floor(rev);
            dst[0] = __builtin_amdgcn_cosf((float)rev); dst[1] = __builtin_amdgcn_sinf((float)rev);
        }
        bf16_t* RWT = (bf16_t*)(p.ws + WS_RWT); const float* rw = p.inp(26);
        for (int q = gt; q < 2 * 64 * DM; q += ngt) { const int L = q / (64 * DM), r = q % (64 * DM), e = r / DM, k = r % DM;
            const float w = rw[((size_t)L * DM + k) * 64 + e]; const bf16_t hi = f2bf(w); const bf16_t lo = f2bf(w - bf2f(hi));
            RWT[((size_t)(L * 2 + 0) * 64 + e) * DM + k] = hi; RWT[((size_t)(L * 2 + 1) * 64 + e) * DM + k] = lo; }
    }
    {
        const float* cvec = p.inp(1); const float* cctx = p.inp(3); const float* mw = p.inp(4);
        float* MODP = (float*)(p.ws + WS_MODP);
        for (int task = C.gw; task < 2 * 32 * 48; task += C.ngw) {
            const int L = task / (32 * 48), r = task % (32 * 48), kb = r / 48, cb = r % 48;
            const float sc = siluf_(cvec[64 * kb + C.lane]), sx = siluf_(cctx[64 * kb + C.lane]);
            f32x4 a0 = {0.f, 0.f, 0.f, 0.f}, a1 = {0.f, 0.f, 0.f, 0.f};
            const float* wp = mw + ((size_t)L * DM + 64 * kb) * 12288 + 256 * cb + 4 * C.lane;
#pragma unroll 8
            for (int kk = 0; kk < 64; ++kk) { const f32x4 w = *(const f32x4*)(wp + (size_t)kk * 12288);
                const float s0 = __shfl(sc, kk), s1 = __shfl(sx, kk);
                a0 += w * s0; a1 += w * s1; }
            *(f32x4*)(MODP + ((size_t)((L * 32 + kb) * 2 + 0)) * 12288 + 256 * cb + 4 * C.lane) = a0;
            *(f32x4*)(MODP + ((size_t)((L * 32 + kb) * 2 + 1)) * 12288 + 256 * cb + 4 * C.lane) = a1;
        }
    }
    {
        LAS float* scr = (LAS float*)(C.lds + C.wave * 17408);
        constexpr int J0 = (DM / 64) * (EV_IN / 64), J3 = (DM / 64) * (OD_IN / 64);
        for (int it = C.gw; it < J0 + J3; it += C.ngw) {
            const bool l1 = it >= J0; const int r = l1 ? it - J0 : it; const int N = l1 ? OD_IN : EV_IN; const int nblk = N / 64, kb = r / nblk, nb = r % nblk;
            tr_item64_fp8(p.inp(l1 ? 21 : 8), N, (unsigned char*)(p.ws + (l1 ? WS_WIN1 : WS_WIN0)), DM, 64 * kb, 64 * nb, 64 * nb, scr, C.lane, 32.0f);
        }
        LAS float* scr2 = (LAS float*)(C.lds + C.wave * 17408);
        constexpr int I1 = (DM / 64) * (DM / 32), I2 = (1024 / 64) * (1024 / 32), I4 = I1;
        for (int it = C.gw; it < I1 + I2 + I4; it += C.ngw) {
            int r = it;
            if (r < I1) { tr_dense(p.inp(9), DM, DM, (bf16_t*)(p.ws + WS_WOUT0), r, scr2, C.lane); continue; } r -= I1;
            if (r < I2) { tr_dense(p.inp(19), 1024, 1024, (bf16_t*)(p.ws + WS_WGLU), r, scr2, C.lane); continue; } r -= I2;
            tr_dense(p.inp(22), DM, DM, (bf16_t*)(p.ws + WS_WOUT1), r, scr2, C.lane);
        }
    }
}
__device__ __forceinline__ void phase_p1(const Params& p, Ctx& C) {
    const float* MODP = (const float*)(p.ws + WS_MODP); float* MODF = (float*)(p.ws + WS_MODF); const float* mb = p.inp(5);
    for (int q = C.bid * NTHR + C.tid; q < 2 * 2 * 12288; q += C.G * NTHR) { const int L = q / (2 * 12288), v = (q / 12288) & 1, col = q % 12288;
        float s = mb[L * 12288 + col];
        for (int kb = 0; kb < 32; ++kb) s += MODP[((size_t)((L * 32 + kb) * 2 + v)) * 12288 + col];
        MODF[q] = s; }
}
__device__ __forceinline__ const float* modv(const Params& p, int L, int v, int k) { return (const float*)(p.ws + WS_MODF) + (size_t)(L * 2 + v) * 12288 + k * DM; }

__device__ __forceinline__ void stage_vec(LAS float* dst, const float* src, int tid) { *(LAS f32x4*)(dst + 4 * tid) = *(const f32x4*)(src + 4 * tid); }
__device__ __forceinline__ void conv_item(const Params& p, Ctx& C, int L, int it) {
    LAS float* scr = (LAS float*)(C.lds + C.wave * 17408);
    unsigned char* GU = (unsigned char*)(p.ws + WS_GU) + (size_t)L * NEX1 * 1024 * DM; unsigned char* DT = (unsigned char*)(p.ws + WS_DT) + (size_t)L * NEX1 * DM * EHID;
    const int e = it / 768, r = it % 768, which = r >> 8, q = r & 255;
    if (which < 2) {
        const float* W = (e < 64) ? p.inp(28 + which) + ((size_t)(L * 64 + e)) * DM * EHID : p.inp(31 + which) + (size_t)L * DM * EHID;
        const int kb = q >> 3, nb = q & 7, n0 = 64 * nb;
        tr_item64_fp8(W, EHID, GU + (size_t)e * 1024 * DM, DM, 64 * kb, n0, 256 * (n0 >> 7) + (n0 & 127) + (which ? 128 : 0), scr, C.lane);
    } else {
        const float* W = (e < 64) ? p.inp(30) + ((size_t)(L * 64 + e)) * EHID * DM : p.inp(33) + (size_t)L * EHID * DM;
        const int kb = q >> 5, nb = q & 31;
        tr_item64_fp8(W, DM, DT + (size_t)e * DM * EHID, EHID, 64 * kb, 64 * nb, 64 * nb, scr, C.lane);
    }
}
__device__ __forceinline__ void conv_queue(const Params& p, Ctx& C, int quota) {
    unsigned* head = (unsigned*)(p.ws + WS_CTL) + CW_QUEUE + 128;
    const int batch = quota < 8 ? quota : 8;
    for (int done = 0; done < quota; done += batch) {
        int it0 = 0; if (C.lane == 0) it0 = (int)atomicAdd(head, (unsigned)batch);
        it0 = __builtin_amdgcn_readfirstlane(it0);
        if (it0 >= NEX1 * 768) break;
        for (int k = 0; k < batch && it0 + k < NEX1 * 768; ++k) conv_item(p, C, 1, it0 + k);
    }
}
__device__ __forceinline__ void phase_modulate(const Params& p, Ctx& C, int L) {
    unsigned char* XA8 = (unsigned char*)(p.ws + WS_XA);
    const float* X2 = (const float*)(p.ws + WS_HX2);
    LAS float* MV = (LAS float*)C.lds;
    for (int v = 0; v < 2; ++v) { stage_vec(MV + (v * 2 + 0) * DM, modv(p, L, v, 0), C.tid); stage_vec(MV + (v * 2 + 1) * DM, modv(p, L, v, 1), C.tid); }
    __syncthreads();
    for (int r = C.gw; r < TT; r += C.ngw) {
        const int v = r < CTXL ? 1 : 0;
        const float* src = (L == 0) ? (r < CTXL ? p.inp(2) + (size_t)r * DM : p.inp(0) + (size_t)(r - CTXL) * DM) : X2 + (size_t)r * DM;
        const LAS float* sh = MV + (v * 2 + 0) * DM; const LAS float* sc = MV + (v * 2 + 1) * DM;
#pragma unroll
        for (int j = 0; j < 8; ++j) { const int c = 4 * (C.lane + 64 * j);
            const f32x4 x = *(const f32x4*)(src + c), a = *(const LAS f32x4*)(sc + c), b = *(const LAS f32x4*)(sh + c);
            const f32x4 y = x * (a + 1.0f) + b;
            unsigned w = (unsigned)__builtin_amdgcn_cvt_pk_fp8_f32(y[0], y[1], 0, false); w = (unsigned)__builtin_amdgcn_cvt_pk_fp8_f32(y[2], y[3], (int)w, true);
            *(unsigned*)(XA8 + (size_t)r * DM + c) = w; }
    }
    __syncthreads();
    if (L == 0) { for (int it = C.gw; it < NEX1 * 768; it += C.ngw) conv_item(p, C, 0, it); }
    else conv_queue(p, C, 1 << 30);
}

__device__ __forceinline__ void phase_rope0(const Params& p, Ctx& C) {
    bf16_t* QKV = (bf16_t*)(p.ws + WS_BIG + BG_QKV);
    const f32x2* R128 = (const f32x2*)(p.ws + WS_ROPE128);
    for (int r = C.gw; r < TT; r += C.ngw) {
        bf16_t* row = QKV + (size_t)r * EV_IN;
        if (r < CTXL) {
#pragma unroll
            for (int j = 0; j < 2; ++j) { u32x4* q = (u32x4*)(row + 8 * (C.lane + 64 * j)); u32x4 w = *q;
                w.x = cvt_pk_bf16(bflo(w.x) * 0.0625f, bfhi(w.x) * 0.0625f); w.y = cvt_pk_bf16(bflo(w.y) * 0.0625f, bfhi(w.y) * 0.0625f);
                w.z = cvt_pk_bf16(bflo(w.z) * 0.0625f, bfhi(w.z) * 0.0625f); w.w = cvt_pk_bf16(bflo(w.w) * 0.0625f, bfhi(w.w) * 0.0625f); *q = w; }
        } else {
            const int l = r - CTXL, rp = l >> 6, cp = l & 63;
#pragma unroll
            for (int qk = 0; qk < 2; ++qk)
#pragma unroll
                for (int m = 0; m < 8; ++m) { const int pi = C.lane + 64 * m, head = pi >> 7, blk = (pi >> 6) & 1, i = pi & 63;
                    bf16_t* b = row + qk * 1024 + head * 256 + blk * 128 + i;
                    const f32x2 cs = R128[(blk ? cp : rp) * 64 + i];
                    const float x1 = bf2f(b[0]), x2 = bf2f(b[64]); const float sc = qk ? 1.0f : 0.0625f;
                    b[0] = f2bf((x1 * cs.x - x2 * cs.y) * sc); b[64] = f2bf((x1 * cs.y + x2 * cs.x) * sc); }
        }
    }
}

__device__ __forceinline__ void phase_normrope1(const Params& p, Ctx& C) {
    bf16_t* QKV = (bf16_t*)(p.ws + WS_BIG + BG_QKV);
    const f32x2* R64 = (const f32x2*)(p.ws + WS_ROPE64);
    const float* qg = p.inp(23);
    unsigned* KMAX = (unsigned*)(p.ws + WS_CTL) + CW_KMAX;
    unsigned char* Q8 = (unsigned char*)(p.ws + WS_BIG + BG_Q8); unsigned char* K8 = (unsigned char*)(p.ws + WS_BIG + BG_K8); unsigned char* VT8 = (unsigned char*)(p.ws + WS_BIG + BG_VT8);
    unsigned char* Q8D = (unsigned char*)(p.ws + WS_BIG + BG_Q8D); unsigned char* K8D = (unsigned char*)(p.ws + WS_BIG + BG_K8D); unsigned char* VT8D = (unsigned char*)(p.ws + WS_BIG + BG_VT8D);
    const int lane = C.lane, i32 = lane & 31; const bool up = lane >= 32;
    const float g00 = qg[lane], g01 = qg[64 + lane], g10 = qg[128 + lane], g11 = qg[128 + 64 + lane];
    for (int r = C.gw; r < TT; r += C.ngw) {
        bf16_t* row = QKV + (size_t)r * OD_IN;
        const bool lat = r >= CTXL; const int l = r - CTXL, rp = lat ? (l >> 6) : 0, cp = lat ? (l & 63) : 0;
        const f32x2 cr = R64[rp * 32 + i32], cc = R64[cp * 32 + i32];
#pragma unroll 2
        for (int h = 0; h < 26; ++h) {
            const int col = h < 8 ? 128 * h : (h < 10 ? 1024 + 128 * (h - 8) : (h < 18 ? 1536 + 128 * (h - 10) : 2560 + 128 * (h - 18)));
            bf16_t* b = row + col;
            float v0 = bf2f(b[lane]), v1 = bf2f(b[64 + lane]);
            if (h < 10) { const float ss = wave_sum(v0 * v0 + v1 * v1); const float rs = rsqrtf(ss * (1.0f / 128.0f) + LN_EPS);
                v0 = bf2f(f2bf(v0 * rs)) * (h < 8 ? g00 : g10); v1 = bf2f(f2bf(v1 * rs)) * (h < 8 ? g01 : g11); }
            if (lat) { const float p0 = __shfl_xor(v0, 32), p1 = __shfl_xor(v1, 32);
                v0 = up ? (p0 * cr.y + v0 * cr.x) : (v0 * cr.x - p0 * cr.y);
                v1 = up ? (p1 * cc.y + v1 * cc.x) : (v1 * cc.x - p1 * cc.y); }
            const bf16_t o0 = f2bf(v0), o1 = f2bf(v1);
            b[lane] = o0; b[64 + lane] = o1;
            {
                const float qs = (h < 8 || (h >= 10 && h < 18)) ? 0.088388347648318440f * 1.4426950408889634f : 1.0f;
                const float w0 = bf2f(o0) * qs, w1 = bf2f(o1) * qs;
                float e4[4];
#pragma unroll
                for (int j = 0; j < 4; ++j) { const float a = __shfl(w0, (4 * lane + j) & 63), c2 = __shfl(w1, (4 * lane + j) & 63); e4[j] = lane < 16 ? a : c2; }
                unsigned pk = (unsigned)__builtin_amdgcn_cvt_pk_fp8_f32(e4[0], e4[1], 0, false); pk = (unsigned)__builtin_amdgcn_cvt_pk_fp8_f32(e4[2], e4[3], (int)pk, true);
                unsigned char* dst8 = h < 8 ? Q8 + (size_t)r * 1024 + 128 * h : (h < 10 ? K8 + (size_t)r * 256 + 128 * (h - 8) : (h < 18 ? Q8D + (size_t)r * 1024 + 128 * (h - 10) : K8D + (size_t)r * 1024 + 128 * (h - 18)));
                if (lane < 32) *(unsigned*)(dst8 + 4 * lane) = pk; }
            if ((h >= 8 && h < 10) || h >= 18) {
                const float w0 = bf2f(o0), w1 = bf2f(o1); const float k2 = wave_sum(w0 * w0 + w1 * w1);
                if (lane == 0) atomicMax(KMAX + 64 * (h < 10 ? h - 8 : h - 16), __float_as_uint(k2)); }
        }
    }
    LAS bf16_t* vt = (LAS bf16_t*)(C.lds + C.wave * 17408);
    for (int item = C.gw; item < 10 * 260; item += C.ngw) {
        const int kh = item / 260, T = item % 260;
        const int vcol = kh < 2 ? 1280 + 128 * kh : 3584 + 128 * (kh - 2);
        unsigned char* vout = kh < 2 ? VT8 + (size_t)kh * 260 * 8192 : VT8D + (size_t)(kh - 2) * 260 * 8192;
#pragma unroll
        for (int q = 0; q < 16; ++q) { const int idx = lane + 64 * q, key = idx >> 4, c = idx & 15;
            *(LAS u32x4*)(vt + key * 136 + 8 * c) = *(const u32x4*)(QKV + (size_t)(64 * T + key) * OD_IN + vcol + 8 * c); }
        LDS_WAIT(); asm volatile("" ::: "memory");
#pragma unroll
        for (int dd = 0; dd < 2; ++dd) { const int d = lane + 64 * dd;
            unsigned char* dst = vout + ((size_t)T * 128 + d) * 64;
#pragma unroll
            for (int cch = 0; cch < 4; ++cch) { u32x4 w;
#pragma unroll
                for (int wd = 0; wd < 4; ++wd) { float f[4];
#pragma unroll
                    for (int e = 0; e < 4; ++e) { const int bb = 16 * cch + 4 * wd + e, hi2 = bb >> 5, blk = (bb >> 4) & 1, j = bb & 15; const int key = 32 * blk + (j & 3) + 8 * (j >> 2) + 4 * hi2;
                        f[e] = bf2f(vt[key * 136 + d]); }
                    unsigned pk = (unsigned)__builtin_amdgcn_cvt_pk_fp8_f32(f[0], f[1], 0, false); pk = (unsigned)__builtin_amdgcn_cvt_pk_fp8_f32(f[2], f[3], (int)pk, true);
                    w[wd] = pk; }
                *(u32x4*)(dst + 16 * cch) = w; } }
        LDS_WAIT(); asm volatile("" ::: "memory");
    }
}

__device__ __forceinline__ void phase_merge1(const Params& p, Ctx& C) {
    bf16_t* ATT = (bf16_t*)(p.ws + WS_BIG + BG_ATT);
    const float* dl = p.inp(24); const float* sg = p.inp(25);
    const int lane = C.lane;
    float d0 = dl[lane] * dl[128 + lane] + dl[64 + lane] * dl[128 + 64 + lane];
    float d1 = dl[256 + lane] * dl[384 + lane] + dl[256 + 64 + lane] * dl[384 + 64 + lane];
    const float lam = __expf(wave_sum(d0)) - __expf(wave_sum(d1)) + LAMBDA_INIT;
    const f32x4 gg = *(const f32x4*)(sg + 4 * lane);
    for (int l = C.gw; l < SEQ; l += C.ngw) {
        bf16_t* row = ATT + (size_t)l * 3072;
#pragma unroll
        for (int h = 0; h < 4; ++h) {
            const u32x2 a = *(const u32x2*)(row + 1024 + 256 * h + 4 * lane), b = *(const u32x2*)(row + 2048 + 256 * h + 4 * lane);
            f32x4 o = {bflo(a.x) - lam * bflo(b.x), bfhi(a.x) - lam * bfhi(b.x), bflo(a.y) - lam * bflo(b.y), bfhi(a.y) - lam * bfhi(b.y)};
            const float ss = wave_sum(o[0] * o[0] + o[1] * o[1] + o[2] * o[2] + o[3] * o[3]);
            const float rs = rsqrtf(ss * (1.0f / 256.0f) + LN_EPS) * (1.0f - LAMBDA_INIT);
            o = o * rs * gg;
            u32x2 w; w.x = cvt_pk_bf16(o[0], o[1]); w.y = cvt_pk_bf16(o[2], o[3]);
            *(u32x2*)(row + 1024 + 256 * h + 4 * lane) = w;
        }
    }
}

__device__ __forceinline__ void phase_ln1(const Params& p, Ctx& C, int L) {
    const bf16_t* Y = (const bf16_t*)(p.ws + WS_YMIX); float* X1 = (float*)(p.ws + WS_X1); unsigned char* XA8 = (unsigned char*)(p.ws + WS_XA);
    const float* X2 = (const float*)(p.ws + WS_HX2);
    const float* lg = p.inp(6) + (size_t)(L * 2 + 0) * DM; const float* lb = p.inp(7) + (size_t)(L * 2 + 0) * DM;
    const int r0 = (L == 0) ? 0 : CTXL;
    LAS float* MV = (LAS float*)C.lds; LAS float* LG = MV + 6 * DM; LAS float* LB = LG + DM;
    for (int v = 0; v < 2; ++v) for (int k = 0; k < 3; ++k) stage_vec(MV + (v * 3 + k) * DM, modv(p, L, v, 2 + k), C.tid);
    stage_vec(LG, lg, C.tid); stage_vec(LB, lb, C.tid);
    __syncthreads();
    for (int r = r0 + C.gw; r < TT; r += C.ngw) {
        const int v = r < CTXL ? 1 : 0;
        const float* src = (L == 0) ? (r < CTXL ? p.inp(2) + (size_t)r * DM : p.inp(0) + (size_t)(r - CTXL) * DM) : X2 + (size_t)r * DM;
        const LAS float* g1 = MV + (v * 3 + 0) * DM; const LAS float* sh2 = MV + (v * 3 + 1) * DM; const LAS float* sc2 = MV + (v * 3 + 2) * DM;
        f32x4 t[8]; float s = 0.f;
#pragma unroll
        for (int j = 0; j < 8; ++j) { const int c = 4 * (C.lane + 64 * j);
            const f32x4 x = *(const f32x4*)(src + c), g = *(const LAS f32x4*)(g1 + c); const u32x2 yy = *(const u32x2*)(Y + (size_t)r * DM + c);
            const f32x4 y = {bflo(yy.x), bfhi(yy.x), bflo(yy.y), bfhi(yy.y)};
            t[j] = x * ALPHA + g * y; s += (t[j][0] + t[j][1]) + (t[j][2] + t[j][3]); }
        const float mean = wave_sum(s) * (1.0f / DM); float s2 = 0.f;
#pragma unroll
        for (int j = 0; j < 8; ++j) { t[j] = t[j] - mean; s2 += (t[j][0] * t[j][0] + t[j][1] * t[j][1]) + (t[j][2] * t[j][2] + t[j][3] * t[j][3]); }
        const float rstd = rsqrtf(wave_sum(s2) * (1.0f / DM) + LN_EPS);
#pragma unroll
        for (int j = 0; j < 8; ++j) { const int c = 4 * (C.lane + 64 * j);
            const f32x4 x1 = t[j] * rstd * *(const LAS f32x4*)(LG + c) + *(const LAS f32x4*)(LB + c);
            *(f32x4*)(X1 + (size_t)r * DM + c) = x1;
            const f32x4 z = x1 * (*(const LAS f32x4*)(sc2 + c) + 1.0f) + *(const LAS f32x4*)(sh2 + c);
            unsigned w = (unsigned)__builtin_amdgcn_cvt_pk_fp8_f32(z[0], z[1], 0, false); w = (unsigned)__builtin_amdgcn_cvt_pk_fp8_f32(z[2], z[3], (int)w, true);
            *(unsigned*)(XA8 + (size_t)r * DM + c) = w; }
    }
    __syncthreads();
}

__device__ __forceinline__ void phase_combine(const Params& p, Ctx& C, int L, LAS unsigned char* misc) {
    const unsigned char* YM = (const unsigned char*)(p.ws + WS_BIG + BG_YMOE); const float* X1 = (const float*)(p.ws + WS_X1);
    float* X2 = (float*)(p.ws + WS_HX2);
    const float* lg = p.inp(6) + (size_t)(L * 2 + 1) * DM; const float* lb = p.inp(7) + (size_t)(L * 2 + 1) * DM;
    const unsigned* PK = (const unsigned*)(p.ws + WS_WGT); const int* cnt = (const int*)(p.ws + WS_CTL) + CW_CNT + L * 128;
    const int r0 = (L == 0) ? 0 : CTXL;
    LAS int* rb = (LAS int*)(misc + 64);
    LAS float* MV = (LAS float*)C.lds; LAS float* LG = MV + 2 * DM; LAS float* LB = LG + DM;
    __syncthreads();
    if (C.tid == 0) { int q = 0; for (int e = 0; e < NEX1; ++e) { rb[e] = q; q += cnt[e]; } }
    stage_vec(MV, modv(p, L, 0, 5), C.tid); stage_vec(MV + DM, modv(p, L, 1, 5), C.tid); stage_vec(LG, lg, C.tid); stage_vec(LB, lb, C.tid);
    LAS float* M1 = LB + DM;
    unsigned char* XA8 = (unsigned char*)(p.ws + WS_XA);
    if (L == 0) { for (int v = 0; v < 2; ++v) { stage_vec(M1 + (v * 2 + 0) * DM, modv(p, 1, v, 0), C.tid); stage_vec(M1 + (v * 2 + 1) * DM, modv(p, 1, v, 1), C.tid); } }
    __syncthreads();
    for (int r = r0 + C.gw; r < TT; r += C.ngw) {
        const int v = r < CTXL ? 1 : 0;
        const LAS float* g2 = MV + v * DM;
        int ln = C.lane; asm volatile("" : "+v"(ln));
        int slot = rb[64] + (r - r0);
        if (ln < 8) { const unsigned pk = PK[(size_t)r * 8 + ln]; slot = rb[pk >> 16] + (int)(pk & 0xffffu); }
        f32x4 t[2][4]; float s = 0.f;
#pragma unroll
        for (int j = 0; j < 2; ++j) { const int c = 16 * (ln + 64 * j);
            u32x4 yy[9];
#pragma unroll
            for (int k = 0; k < 9; ++k) { const size_t a = (size_t)__builtin_amdgcn_readlane(slot, k); yy[k] = __builtin_nontemporal_load((const u32x4*)(YM + a * DM + c)); }
            f32x2 f[8];
#pragma unroll
            for (int q = 0; q < 8; ++q) f[q] = (f32x2){0.f, 0.f};
#pragma unroll
            for (int k = 0; k < 9; ++k) {
                f[0] += __builtin_amdgcn_cvt_pk_f32_fp8((int)yy[k].x, false); f[1] += __builtin_amdgcn_cvt_pk_f32_fp8((int)yy[k].x, true);
                f[2] += __builtin_amdgcn_cvt_pk_f32_fp8((int)yy[k].y, false); f[3] += __builtin_amdgcn_cvt_pk_f32_fp8((int)yy[k].y, true);
                f[4] += __builtin_amdgcn_cvt_pk_f32_fp8((int)yy[k].z, false); f[5] += __builtin_amdgcn_cvt_pk_f32_fp8((int)yy[k].z, true);
                f[6] += __builtin_amdgcn_cvt_pk_f32_fp8((int)yy[k].w, false); f[7] += __builtin_amdgcn_cvt_pk_f32_fp8((int)yy[k].w, true); }
#pragma unroll
            for (int q = 0; q < 4; ++q) { const f32x4 x = *(const f32x4*)(X1 + (size_t)r * DM + c + 4 * q), g = *(const LAS f32x4*)(g2 + c + 4 * q);
                const f32x4 ff = {f[2 * q][0], f[2 * q][1], f[2 * q + 1][0], f[2 * q + 1][1]};
                t[j][q] = x * ALPHA + g * ff; s += (t[j][q][0] + t[j][q][1]) + (t[j][q][2] + t[j][q][3]); } }
        const float mean = wave_sum(s) * (1.0f / DM); float s2 = 0.f;
#pragma unroll
        for (int j = 0; j < 2; ++j)
#pragma unroll
            for (int q = 0; q < 4; ++q) { t[j][q] = t[j][q] - mean; s2 += (t[j][q][0] * t[j][q][0] + t[j][q][1] * t[j][q][1]) + (t[j][q][2] * t[j][q][2] + t[j][q][3] * t[j][q][3]); }
        const float rstd = rsqrtf(wave_sum(s2) * (1.0f / DM) + LN_EPS);
        float* dst = (L == 0) ? X2 + (size_t)r * DM : p.out + (size_t)(r - CTXL) * DM;
#pragma unroll
        for (int j = 0; j < 2; ++j)
#pragma unroll
            for (int q = 0; q < 4; ++q) { const int c = 16 * (ln + 64 * j) + 4 * q;
                const f32x4 xn = t[j][q] * rstd * *(const LAS f32x4*)(LG + c) + *(const LAS f32x4*)(LB + c);
                *(f32x4*)(dst + c) = xn;
                if (L == 0) { const f32x4 y = xn * (*(const LAS f32x4*)(M1 + (v * 2 + 1) * DM + c) + 1.0f) + *(const LAS f32x4*)(M1 + (v * 2 + 0) * DM + c);
                    unsigned w = (unsigned)__builtin_amdgcn_cvt_pk_fp8_f32(y[0], y[1], 0, false); w = (unsigned)__builtin_amdgcn_cvt_pk_fp8_f32(y[2], y[3], (int)w, true);
                    *(unsigned*)(XA8 + (size_t)r * DM + c) = w; } }
    }
    if (L == 0) { __syncthreads(); conv_queue(p, C, 1 << 30); }
}
constexpr int RLD = 264;
constexpr int SLD = 136;

template <bool SCALE>
__device__ __forceinline__ void stage_chunk(const bf16_t* QKV, int row0, int col0, LAS bf16_t* dst, int tid, float lg  , int dirb) {
#pragma unroll
    for (int q = 0; q < 8; ++q) { const int idx = tid + NTHR * q, r = idx >> 5, c = idx & 31;
        u32x4 w = *(const u32x4*)(QKV + (size_t)(row0 + r) * EV_IN + col0 + 8 * c);
        if (SCALE) { const float sc = fast_exp((dirb ? (float)r : (float)(127 - r)) * lg);
            w.x = cvt_pk_bf16(bflo(w.x) * sc, bfhi(w.x) * sc); w.y = cvt_pk_bf16(bflo(w.y) * sc, bfhi(w.y) * sc);
            w.z = cvt_pk_bf16(bflo(w.z) * sc, bfhi(w.z) * sc); w.w = cvt_pk_bf16(bflo(w.w) * sc, bfhi(w.w) * sc); }
        *(LAS u32x4*)(dst + r * RLD + 8 * c) = w; }
}

__device__ __forceinline__ void ret_chunk_kv(const Params& p, Ctx& C) {
    const bf16_t* QKV = (const bf16_t*)(p.ws + WS_BIG + BG_QKV); bf16_t* CKV = (bf16_t*)(p.ws + WS_BIG + BG_CKV);
    const float* rld = p.inp(10);
    LAS bf16_t* Vs = (LAS bf16_t*)C.lds; LAS bf16_t* Ks = Vs + 128 * RLD;
    const int lane = C.lane, w = C.wave;
    for (int unit = C.bid; unit < 130 * 8; unit += C.G) {
        const int u = unit >> 3, h = (unit >> 1) & 3, dir = unit & 1;
        const float lg = rld[dir * 4 + h];
        __syncthreads();
        stage_chunk<false>(QKV, 128 * u, 2048 + 256 * h, Vs, C.tid, 0.f, 0);
        stage_chunk<true>(QKV, 128 * u, 1024 + 256 * h, Ks, C.tid, lg, dir);
        __syncthreads();
        f32x4 acc[2][16];
#pragma unroll
        for (int a = 0; a < 2; ++a)
#pragma unroll
            for (int b = 0; b < 16; ++b) acc[a][b] = (f32x4){0.f, 0.f, 0.f, 0.f};
        const unsigned vbase = (unsigned)(uintptr_t)Vs, kbase = (unsigned)(uintptr_t)Ks;
#pragma unroll 1
        for (int ks = 0; ks < 4; ++ks) {
            bf16x8 af[2];
#pragma unroll
            for (int a = 0; a < 2; ++a) af[a] = frag_colk_l(vbase + (unsigned)((32 * ks) * RLD + 32 * w + 16 * a) * 2u, RLD * 2, lane);
#pragma unroll
            for (int b = 0; b < 16; ++b) { const bf16x8 bf = frag_colk_l(kbase + (unsigned)((32 * ks) * RLD + 16 * b) * 2u, RLD * 2, lane);
                acc[0][b] = MFMA16(bf, af[0], acc[0][b]); acc[1][b] = MFMA16(bf, af[1], acc[1][b]); }
        }
        bf16_t* dst = CKV + ((size_t)((dir * 4 + h) * 130 + u)) * 65536;
#pragma unroll
        for (int a = 0; a < 2; ++a)
#pragma unroll
            for (int b = 0; b < 16; ++b) { u32x2 w2; w2.x = cvt_pk_bf16(acc[a][b][0], acc[a][b][1]); w2.y = cvt_pk_bf16(acc[a][b][2], acc[a][b][3]);
                *(u32x2*)(dst + (size_t)(32 * w + 16 * a + (lane & 15)) * 256 + 16 * b + 4 * (lane >> 4)) = w2; }
    }
    __syncthreads();
}

__device__ __forceinline__ int s5_row(int dir, int c, int s) { return dir == 0 ? 64 * c + s : (c < 4 ? 255 - (64 * c + s) : 16639 - 64 * (c - 4) - s); }

__device__ __forceinline__ void s5_end_states(const Params& p, Ctx& C) {
    const bf16_t* QKV = (const bf16_t*)(p.ws + WS_BIG + BG_QKV); const bf16_t* BBT = (const bf16_t*)(p.ws + WS_BBT); float* E = (float*)(p.ws + WS_S5E);
    const float* APOW = (const float*)(p.ws + WS_APOW);
    LAS f32x2* PL = (LAS f32x2*)C.lds;
    for (int bt = C.bid; bt < 256; bt += C.G) {
        int tid = C.tid; asm volatile("" : "+v"(tid));
        const int lane = tid & 63, r32 = lane & 31, hi = lane >> 5;
        const int dg = bt >> 1, dir = dg >> 6, g = dg & 63, c0 = 130 * (bt & 1);
        __syncthreads();
#pragma unroll
        for (int q = 0; q < 8; ++q) { const int idx = tid + NTHR * q, s = idx >> 6, pp = idx & 63;
            PL[idx] = (s == 63) ? (f32x2){1.0f, 0.0f} : *(const f32x2*)(APOW + ((size_t)dg * 64 + (62 - s)) * 128 + 2 * pp); }
        __syncthreads();
        bf16x8 bfr[4];
#pragma unroll
        for (int pt = 0; pt < 4; ++pt) bfr[pt] = *(const bf16x8*)(BBT + ((size_t)dg * 128 + 32 * pt + r32) * 16 + 8 * hi);
        for (int c = c0 + C.wave; c < c0 + 130; c += 8) {
            float er[2] = {0.f, 0.f}, ei[2] = {0.f, 0.f};
#pragma unroll
            for (int st = 0; st < 2; ++st) {
                const bf16x8 a = *(const bf16x8*)(QKV + (size_t)s5_row(dir, c, 32 * st + r32) * EV_IN + 4096 + 16 * g + 8 * hi);
                f32x16 d[4];
#pragma unroll
                for (int pt = 0; pt < 4; ++pt) d[pt] = __builtin_amdgcn_mfma_f32_32x32x16_bf16(a, bfr[pt], (f32x16){}, 0, 0, 0);
#pragma unroll
                for (int r = 0; r < 16; ++r) { const int s = 32 * st + (r & 3) + 8 * (r >> 2) + 4 * hi;
#pragma unroll
                    for (int pt = 0; pt < 2; ++pt) { const f32x2 pw = PL[s * 64 + 32 * pt + r32]; const float br = d[pt][r], bi = d[pt + 2][r];
                        er[pt] += pw.x * br - pw.y * bi; ei[pt] += pw.x * bi + pw.y * br; } }
            }
#pragma unroll
            for (int pt = 0; pt < 2; ++pt) {
                { auto rr = __builtin_amdgcn_permlane32_swap(__float_as_uint(er[pt]), __float_as_uint(er[pt]), false, false); er[pt] = __uint_as_float(rr[0]) + __uint_as_float(rr[1]); }
                { auto rr = __builtin_amdgcn_permlane32_swap(__float_as_uint(ei[pt]), __float_as_uint(ei[pt]), false, false); ei[pt] = __uint_as_float(rr[0]) + __uint_as_float(rr[1]); }
            }
            float* dst = E + ((size_t)dg * 260 + c) * 128;
            if (hi == 0) { dst[r32] = er[0]; dst[32 + r32] = er[1]; dst[64 + r32] = ei[0]; dst[96 + r32] = ei[1]; }
        }
    }
    __syncthreads();
}

__device__ __forceinline__ void phase_scans(const Params& p, Ctx& C) {
    const bf16_t* CKV = (const bf16_t*)(p.ws + WS_BIG + BG_CKV); bf16_t* SP = (bf16_t*)(p.ws + WS_BIG + BG_SPREV);
    const float* rld = p.inp(10);
    for (int q = C.bid * NTHR + C.tid; q < 8 * 16384; q += C.G * NTHR) {
        const int dh = q >> 14, el = (q & 16383) * 4, dir = dh >> 2, h = dh & 3;
        const float gch = fast_exp(128.0f * rld[dir * 4 + h]);
        const bf16_t* src = CKV + (size_t)dh * 130 * 65536 + el; bf16_t* dst = SP + (size_t)dh * 130 * 65536 + el;
        f32x4 s = {0.f, 0.f, 0.f, 0.f};
        for (int st0 = 0; st0 < 130; st0 += 13) {
            u32x2 kv[13];
#pragma unroll
            for (int k = 0; k < 13; ++k) { const int st = st0 + k; const int u = dir == 0 ? st : (st == 0 ? 1 : (st == 1 ? 0 : 131 - st)); kv[k] = __builtin_nontemporal_load((const u32x2*)(src + (size_t)u * 65536)); }
#pragma unroll
            for (int k = 0; k < 13; ++k) { const int st = st0 + k; const int u = dir == 0 ? st : (st == 0 ? 1 : (st == 1 ? 0 : 131 - st));
                u32x2 w; w.x = cvt_pk_bf16(s[0], s[1]); w.y = cvt_pk_bf16(s[2], s[3]); *(u32x2*)(dst + (size_t)u * 65536) = w;
                s = s * gch + (f32x4){bflo(kv[k].x), bfhi(kv[k].x), bflo(kv[k].y), bfhi(kv[k].y)}; }
        }
    }
    const float* E = (const float*)(p.ws + WS_S5E); float* HST = (float*)(p.ws + WS_HST); const float* AL = (const float*)(p.ws + WS_AL);
    for (int q = C.bid * NTHR + C.tid; q < 2 * 64 * 64; q += C.G * NTHR) {
        const int dg = q >> 6, pp = q & 63;
        const f32x2 al = *(const f32x2*)(AL + (size_t)dg * 128 + 2 * pp);
        const float* e = E + (size_t)dg * 260 * 128; float* hs = HST + (size_t)dg * 260 * 128;
        float hr = 0.f, hi = 0.f;
        for (int c0 = 0; c0 < 260; c0 += 26) {
            float er[26], ei[26];
#pragma unroll
            for (int k = 0; k < 26; ++k) { er[k] = e[(size_t)(c0 + k) * 128 + pp]; ei[k] = e[(size_t)(c0 + k) * 128 + 64 + pp]; }
#pragma unroll
            for (int k = 0; k < 26; ++k) { *(f32x2*)(hs + (size_t)(c0 + k) * 128 + 2 * pp) = (f32x2){hr, hi};
                const float t = al.x * hr - al.y * hi + er[k]; hi = al.x * hi + al.y * hr + ei[k]; hr = t; }
        }
    }
}

__device__ __forceinline__ void ret_output_unit(const Params& p, Ctx& C, int unit) {
    const bf16_t* QKV = (const bf16_t*)(p.ws + WS_BIG + BG_QKV); const bf16_t* SP = (const bf16_t*)(p.ws + WS_BIG + BG_SPREV);
    bf16_t* MIX = (bf16_t*)(p.ws + WS_BIG + BG_MIX);
    const float* rld = p.inp(10);
    LAS bf16_t* RA = (LAS bf16_t*)C.lds; LAS bf16_t* RB = RA + 128 * RLD;
    int tid = C.tid; asm volatile("" : "+v"(tid));
    const int lane = tid & 63, w = C.wave, kq = lane >> 4, fr = lane & 15;
    const int u = unit >> 2, h = unit & 3;
    const float lgf = rld[h], lgb = rld[4 + h];
    stage_chunk<false>(QKV, 128 * u, 256 * h, RA, tid, 0.f, 0);
    int ib = 16 * w + 4 * kq, jb = fr; asm volatile("" : "+v"(ib), "+v"(jb));
    f32x4 acc[16];
#pragma unroll
    for (int t = 0; t < 16; ++t) acc[t] = (f32x4){0.f, 0.f, 0.f, 0.f};
#pragma unroll
    for (int dir = 0; dir < 2; ++dir) {
        const bf16_t* Sd = SP + ((size_t)((dir * 4 + h) * 130 + u)) * 65536;
#pragma unroll
        for (int eh = 0; eh < 2; ++eh) {
            __syncthreads();
#pragma unroll
            for (int q = 0; q < 8; ++q) { const int idx = tid + NTHR * q, rr = idx >> 5, c = idx & 31;
                *(LAS u32x4*)(RB + rr * RLD + 8 * c) = *(const u32x4*)(Sd + (size_t)(128 * eh + rr) * 256 + 8 * c);
                if (q == 3) asm volatile("" ::: "memory"); }
            __syncthreads();
#pragma unroll 1
            for (int ks = 0; ks < 8; ++ks) { const bf16x8 af = frag_rowk_l(RA + (16 * w) * RLD + 32 * ks, RLD, lane);
#pragma unroll
                for (int t = 0; t < 8; ++t) { const bf16x8 bf = frag_rowk_l(RB + (16 * t) * RLD + 32 * ks, RLD, lane); acc[8 * eh + t] = MFMA16(af, bf, acc[8 * eh + t]); } }
        }
#pragma unroll
        for (int r = 0; r < 4; ++r) { const int i = ib + r; const float qd = fast_exp((float)(128 - i) * lgb);
            const float f = (dir == 0) ? fast_exp((float)(i + 1) * lgf) / qd : qd;
#pragma unroll
            for (int t = 0; t < 16; ++t) acc[t][r] *= f; }
    }
    __syncthreads();
    stage_chunk<false>(QKV, 128 * u, 1024 + 256 * h, RB, tid, 0.f, 0);
    __syncthreads();
    f32x4 sc[8];
#pragma unroll
    for (int t = 0; t < 8; ++t) sc[t] = (f32x4){0.f, 0.f, 0.f, 0.f};
#pragma unroll 1
    for (int ks = 0; ks < 8; ++ks) { const bf16x8 af = frag_rowk_l(RA + (16 * w) * RLD + 32 * ks, RLD, lane);
#pragma unroll
        for (int t = 0; t < 8; ++t) { const bf16x8 bf = frag_rowk_l(RB + (16 * t) * RLD + 32 * ks, RLD, lane); sc[t] = MFMA16(af, bf, sc[t]); } }
#pragma unroll
    for (int t = 0; t < 8; ++t)
#pragma unroll
        for (int r = 0; r < 4; ++r) { const int i = ib + r, j = 16 * t + jb; const float d = (float)(i - j);
            const float m = (i >= j ? fast_exp(d * lgf) : 0.f) + (j >= i ? fast_exp(-d * lgb) : 0.f); sc[t][r] *= m; }
    __syncthreads();
    stage_chunk<false>(QKV, 128 * u, 2048 + 256 * h, RA, tid, 0.f, 0);
#pragma unroll
    for (int t = 0; t < 8; ++t)
#pragma unroll
        for (int r = 0; r < 4; ++r) RB[(16 * w + 4 * kq + r) * SLD + 16 * t + fr] = f2bf(sc[t][r]);
    __syncthreads();
    const unsigned vbase = (unsigned)(uintptr_t)RA;
#pragma unroll 1
    for (int ks = 0; ks < 4; ++ks) { const bf16x8 af = frag_rowk_l(RB + (16 * w) * SLD + 32 * ks, SLD, lane);
#pragma unroll
        for (int t = 0; t < 16; ++t) { const bf16x8 bf = frag_colk_l(vbase + (unsigned)((32 * ks) * RLD + 16 * t) * 2u, RLD * 2, lane); acc[t] = MFMA16(af, bf, acc[t]); } }
    __syncthreads();
#pragma unroll
    for (int r = 0; r < 4; ++r) {
        float s = 0.f;
#pragma unroll
        for (int t = 0; t < 16; ++t) s += acc[t][r];
        s += __shfl_xor(s, 1); s += __shfl_xor(s, 2); s += __shfl_xor(s, 4); s += __shfl_xor(s, 8);
        const float mean = s * (1.0f / 256.0f); float q = 0.f;
#pragma unroll
        for (int t = 0; t < 16; ++t) { const float d = acc[t][r] - mean; q += d * d; }
        q += __shfl_xor(q, 1); q += __shfl_xor(q, 2); q += __shfl_xor(q, 4); q += __shfl_xor(q, 8);
        const float rstd = rsqrtf(q * (1.0f / 256.0f) + LN_EPS);
#pragma unroll
        for (int t = 0; t < 16; ++t) RA[(16 * w + 4 * kq + r) * RLD + 16 * t + fr] = f2bf((acc[t][r] - mean) * rstd);
    }
    __syncthreads();
#pragma unroll
    for (int q = 0; q < 8; ++q) { const int idx = tid + NTHR * q, rr = idx >> 5, c = idx & 31; const size_t row = (size_t)(128 * u + rr);
        const u32x4 o = *(const LAS u32x4*)(RA + rr * RLD + 8 * c), g = *(const u32x4*)(QKV + row * EV_IN + 3072 + 256 * h + 8 * c);
        u32x4 w4;
        w4.x = cvt_pk_bf16(bflo(o.x) * siluf_(bflo(g.x)), bfhi(o.x) * siluf_(bfhi(g.x))); w4.y = cvt_pk_bf16(bflo(o.y) * siluf_(bflo(g.y)), bfhi(o.y) * siluf_(bfhi(g.y)));
        w4.z = cvt_pk_bf16(bflo(o.z) * siluf_(bflo(g.z)), bfhi(o.z) * siluf_(bfhi(g.z))); w4.w = cvt_pk_bf16(bflo(o.w) * siluf_(bflo(g.w)), bfhi(o.w) * siluf_(bfhi(g.w)));
        *(u32x4*)(MIX + row * DM + 256 * h + 8 * c) = w4; }
    __syncthreads();
}

constexpr int KLD = 1032;
__device__ __forceinline__ void s5_output_task(const Params& p, Ctx& C, int bt) {
    const bf16_t* QKV = (const bf16_t*)(p.ws + WS_BIG + BG_QKV); bf16_t* Z = (bf16_t*)(p.ws + WS_Z);
    const bf16_t* KN = (const bf16_t*)(p.ws + WS_KN); const bf16_t* CCt = (const bf16_t*)(p.ws + WS_CC);
    const float* APOW = (const float*)(p.ws + WS_APOW); const float* HST = (const float*)(p.ws + WS_HST); const float* dsk = p.inp(18);
    int tid = C.tid; asm volatile("" : "+v"(tid));
    const int lane = tid & 63, kq = lane >> 4, fr = lane & 15;
    LAS bf16_t* KF = (LAS bf16_t*)C.lds; LAS bf16_t* KB = KF + 16 * KLD;
    LAS bf16_t* U = KB + 16 * KLD + C.wave * 3072;
    LAS float* PW0 = (LAS float*)(KB + 16 * KLD + 8 * 3072);
    LAS float* PW16 = PW0 + 2 * 16 * 128;
    {
        const int g = bt >> 3, k0 = (260 * (bt & 7)) >> 3, k1 = (260 * ((bt & 7) + 1)) >> 3;
#pragma unroll
        for (int q = 0; q < 8; ++q) { const int idx = tid + NTHR * q, dir = idx >> 11, rr = (idx >> 7) & 15, c = idx & 127;
            *(LAS u32x4*)((dir ? KB : KF) + rr * KLD + 8 * c) = *(const u32x4*)(KN + ((size_t)(dir * 64 + g) * 16 + rr) * 1024 + 8 * c); }
        for (int q = lane; q < 192 * 2; q += 64) *(LAS u32x4*)(U + 8 * q) = (u32x4){0u, 0u, 0u, 0u};
#pragma unroll
        for (int q = 0; q < 2; ++q) { const int idx = tid + NTHR * q, dir = idx >> 9, f = (idx >> 5) & 15, c4 = idx & 31;
            *(LAS f32x4*)(PW0 + dir * 2048 + f * 128 + 4 * c4) = *(const f32x4*)(APOW + ((size_t)(dir * 64 + g) * 64 + (dir == 0 ? f : 15 - f)) * 128 + 4 * c4); }
        if (tid < 64) { const int dir = tid >> 5, c4 = tid & 31; *(LAS f32x4*)(PW16 + dir * 128 + 4 * c4) = *(const f32x4*)(APOW + ((size_t)(dir * 64 + g) * 64 + 15) * 128 + 4 * c4); }
        __syncthreads();
        const f32x4 dv = *(const f32x4*)(dsk + 16 * g + 4 * kq);
        bf16x8 ccr[2], cci[2];
#pragma unroll
        for (int hb = 0; hb < 2; ++hb) { ccr[hb] = frag_rowk_g(CCt + (size_t)g * 16 * 128 + 32 * hb, 128, lane); cci[hb] = frag_rowk_g(CCt + (size_t)g * 16 * 128 + 64 + 32 * hb, 128, lane); }
        const LAS float* pw0l = PW0 + (size_t)fr * 128 + 16 * kq;
        const LAS float* pw16l = PW16 + 16 * kq;
        for (int k = k0 + C.wave; k < k1; k += 8) {
            LDS_WAIT(); asm volatile("" ::: "memory");
            for (int q = lane; q < 128; q += 64) { const int t = q >> 1, hf = q & 1;
                *(LAS u32x4*)(U + (64 + t) * 16 + 8 * hf) = *(const u32x4*)(QKV + (size_t)(64 * k + t) * EV_IN + 4096 + 16 * g + 8 * hf); }
            LDS_WAIT(); asm volatile("" ::: "memory");
            const int cf = k, cb = k < 4 ? 3 - k : 263 - k;
            f32x4 acc[4];
#pragma unroll
            for (int tt = 0; tt < 4; ++tt) acc[tt] = (f32x4){0.f, 0.f, 0.f, 0.f};
            const LAS bf16_t* ubf = U + (64 + fr - (kq >> 1)) * 16 + 8 * (kq & 1);
            const LAS bf16_t* ubb = U + (64 + fr + (kq >> 1)) * 16 + 8 * (kq & 1);
#pragma unroll
            for (int n0 = 0; n0 < 64; n0 += 2) {
                const bf16x8 af = frag_rowk_l(KF + n0 * 16, KLD, lane), ab = frag_rowk_l(KB + n0 * 16, KLD, lane);
#pragma unroll
                for (int tt = 0; tt < 4; ++tt) {
                    if (n0 <= 16 * tt + 14) acc[tt] = MFMA16(af, *(const LAS bf16x8*)(ubf + (16 * tt - n0) * 16), acc[tt]);
                    if (n0 <= 62 - 16 * tt) acc[tt] = MFMA16(ab, *(const LAS bf16x8*)(ubb + (16 * tt + n0) * 16), acc[tt]);
                }
                asm volatile("" ::: "memory");
            }
#pragma unroll
            for (int dir = 0; dir < 2; ++dir) {
                const float* hp = HST + ((size_t)(dir * 64 + g) * 260 + (dir == 0 ? cf : cb)) * 128;
#pragma unroll
                for (int hb = 0; hb < 2; ++hb) {
                    float xr[8], xi[8];
#pragma unroll
                    for (int e2 = 0; e2 < 4; ++e2) { const f32x4 h4 = *(const f32x4*)(hp + 2 * (32 * hb + 8 * kq) + 4 * e2), b4 = *(const LAS f32x4*)(pw0l + dir * 2048 + hb * 64 + 4 * e2);
                        xr[2 * e2] = b4[0] * h4[0] - b4[1] * h4[1]; xi[2 * e2] = b4[0] * h4[1] + b4[1] * h4[0];
                        xr[2 * e2 + 1] = b4[2] * h4[2] - b4[3] * h4[3]; xi[2 * e2 + 1] = b4[2] * h4[3] + b4[3] * h4[2]; }
#pragma unroll
                    for (int st = 0; st < 4; ++st) {
                        const int tt = dir == 0 ? st : 3 - st;
                        u32x4 br, bi;
                        br.x = cvt_pk_bf16(xr[0], xr[1]); br.y = cvt_pk_bf16(xr[2], xr[3]); br.z = cvt_pk_bf16(xr[4], xr[5]); br.w = cvt_pk_bf16(xr[6], xr[7]);
                        bi.x = cvt_pk_bf16(xi[0], xi[1]); bi.y = cvt_pk_bf16(xi[2], xi[3]); bi.z = cvt_pk_bf16(xi[4], xi[5]); bi.w = cvt_pk_bf16(xi[6], xi[7]);
                        acc[tt] = MFMA16(ccr[hb], __builtin_bit_cast(bf16x8, br), acc[tt]);
                        acc[tt] = MFMA16(cci[hb], __builtin_bit_cast(bf16x8, bi), acc[tt]);
                        if (st < 3) {
#pragma unroll
                            for (int e2 = 0; e2 < 4; ++e2) { const f32x4 a4 = *(const LAS f32x4*)(pw16l + dir * 128 + hb * 64 + 4 * e2);
                                float t0 = xr[2 * e2] * a4[0] - xi[2 * e2] * a4[1]; xi[2 * e2] = xr[2 * e2] * a4[1] + xi[2 * e2] * a4[0]; xr[2 * e2] = t0;
                                t0 = xr[2 * e2 + 1] * a4[2] - xi[2 * e2 + 1] * a4[3]; xi[2 * e2 + 1] = xr[2 * e2 + 1] * a4[3] + xi[2 * e2 + 1] * a4[2]; xr[2 * e2 + 1] = t0; }
                        }
                    }
                }
            }
#pragma unroll
            for (int tt = 0; tt < 4; ++tt) { const int t = 16 * tt + fr;
                const u32x2 uu = *(const LAS u32x2*)(U + (64 + t) * 16 + 4 * kq);
                const float y0 = acc[tt][0] + bflo(uu.x) * dv[0], y1 = acc[tt][1] + bfhi(uu.x) * dv[1], y2 = acc[tt][2] + bflo(uu.y) * dv[2], y3 = acc[tt][3] + bfhi(uu.y) * dv[3];
                u32x2 w; w.x = cvt_pk_bf16(gelu_tanh(y0), gelu_tanh(y1)); w.y = cvt_pk_bf16(gelu_tanh(y2), gelu_tanh(y3));
                *(u32x2*)(Z + (size_t)(64 * k + t) * 1024 + 16 * g + 4 * kq) = w; }
        }
    }
    __syncthreads();
}

__device__ __forceinline__ void phase_ret_s5_outputs(const Params& p, Ctx& C, LAS unsigned char* misc) {
    unsigned* head = (unsigned*)(p.ws + WS_CTL) + CW_QUEUE;
    volatile LAS int* slot = (volatile LAS int*)(misc + 32);
    for (;;) {
        __syncthreads();
        if (C.tid == 0) slot[0] = (int)atomicAdd(head, 1u);
        __syncthreads();
        const int item = __builtin_amdgcn_readfirstlane(slot[0]);
        if (item >= 520) break;
        ret_output_unit(p, C, item);
    }
    for (;;) {
        __syncthreads();
        if (C.tid == 0) slot[0] = (int)atomicAdd(head + 64, 1u);
        __syncthreads();
        const int item = __builtin_amdgcn_readfirstlane(slot[0]);
        if (item >= 512) break;
        s5_output_task(p, C, item);
    }
}
__device__ __forceinline__ void phase_router(const Params& p, Ctx& C, int L) {
    const float* X1 = (const float*)(p.ws + WS_X1);
    const bf16_t* RWh = (const bf16_t*)(p.ws + WS_RWT) + (size_t)(L * 2 + 0) * 64 * DM; const bf16_t* RWl = (const bf16_t*)(p.ws + WS_RWT) + (size_t)(L * 2 + 1) * 64 * DM;
    const float* rbias = p.inp(27) + L * 64;
    int* cnt = (int*)(p.ws + WS_CTL) + CW_CNT + L * 128; int* LIST = (int*)(p.ws + WS_LIST); unsigned* PK = (unsigned*)(p.ws + WS_WGT); float* LW = (float*)(p.ws + WS_LW);
    const int lane = C.lane, kq = lane >> 4, fr = lane & 15;
    LAS float* Lg = (LAS float*)(C.lds + C.wave * 8192);
    const int r0 = (L == 0) ? 0 : CTXL, nrows = TT - r0;
    if (C.bid == 0 && C.tid == 0) cnt[64] = nrows;
    for (int task = C.gw; task < nrows / 16; task += C.ngw) {
        const int rbase = r0 + 16 * task, row = rbase + fr;
        const int v = row < CTXL ? 1 : 0;
        const float* xr = X1 + (size_t)row * DM; const float* sc2 = modv(p, L, v, 4); const float* sh2 = modv(p, L, v, 3);
        f32x4 acc[4];
#pragma unroll
        for (int t = 0; t < 4; ++t) acc[t] = (f32x4){0.f, 0.f, 0.f, 0.f};
#pragma unroll 2
        for (int ks = 0; ks < 64; ++ks) { const int c0 = 32 * ks + 8 * kq;
            const f32x4 x0 = *(const f32x4*)(xr + c0), x1 = *(const f32x4*)(xr + c0 + 4);
            const f32x4 a0 = *(const f32x4*)(sc2 + c0), a1 = *(const f32x4*)(sc2 + c0 + 4), b0 = *(const f32x4*)(sh2 + c0), b1 = *(const f32x4*)(sh2 + c0 + 4);
            const f32x4 y0 = x0 * (a0 + 1.0f) + b0, y1 = x1 * (a1 + 1.0f) + b1;
            u32x4 hi; hi.x = cvt_pk_bf16(y0[0], y0[1]); hi.y = cvt_pk_bf16(y0[2], y0[3]); hi.z = cvt_pk_bf16(y1[0], y1[1]); hi.w = cvt_pk_bf16(y1[2], y1[3]);
            u32x4 lo; lo.x = cvt_pk_bf16(y0[0] - bflo(hi.x), y0[1] - bfhi(hi.x)); lo.y = cvt_pk_bf16(y0[2] - bflo(hi.y), y0[3] - bfhi(hi.y));
            lo.z = cvt_pk_bf16(y1[0] - bflo(hi.z), y1[1] - bfhi(hi.z)); lo.w = cvt_pk_bf16(y1[2] - bflo(hi.w), y1[3] - bfhi(hi.w));
            const bf16x8 ah = __builtin_bit_cast(bf16x8, hi), al = __builtin_bit_cast(bf16x8, lo);
#pragma unroll
            for (int t = 0; t < 4; ++t) { const bf16x8 bh = frag_rowk_g(RWh + (size_t)(16 * t) * DM + 32 * ks, DM, lane), bl = frag_rowk_g(RWl + (size_t)(16 * t) * DM + 32 * ks, DM, lane);
                acc[t] = MFMA16(ah, bh, acc[t]); acc[t] = MFMA16(al, bh, acc[t]); acc[t] = MFMA16(ah, bl, acc[t]); } }
        LDS_WAIT(); asm volatile("" ::: "memory");
#pragma unroll
        for (int t = 0; t < 4; ++t)
#pragma unroll
            for (int r = 0; r < 4; ++r) Lg[(4 * kq + r) * 65 + 16 * t + fr] = acc[t][r];
        LDS_WAIT(); asm volatile("" ::: "memory");
        if (lane < 16) {
            LAS float* sr = Lg + lane * 65; const int trow = rbase + lane;
            float gs[8];
#pragma unroll
            for (int g = 0; g < 8; ++g) { float m1 = -1e30f, m2 = -1e30f;
                for (int j = 0; j < 8; ++j) { const int e = 8 * g + j; const float s = sigmoidf_(sr[e]); sr[e] = s; const float vv = s + rbias[e];
                    if (vv > m1) { m2 = m1; m1 = vv; } else if (vv > m2) m2 = vv; }
                gs[g] = m1 + m2; }
            unsigned gmask = 0u;
#pragma unroll
            for (int it = 0; it < 4; ++it) { float best = -1e30f; int bi = 0;
#pragma unroll
                for (int g = 0; g < 8; ++g) { const bool ok = !((gmask >> g) & 1u) && gs[g] > best; best = ok ? gs[g] : best; bi = ok ? g : bi; }
                gmask |= 1u << bi; }
            unsigned long long taken = 0ull; int sel[8]; float sw[8]; float wsum = 0.f;
#pragma unroll
            for (int k = 0; k < 8; ++k) { float best = -1e30f; int bi = 0;
                for (int e = 0; e < 64; ++e) { const bool cand = ((gmask >> (e >> 3)) & 1u) && !((taken >> e) & 1ull); const float vv = sr[e] + rbias[e];
                    if (cand && vv > best) { best = vv; bi = e; } }
                taken |= 1ull << bi; sel[k] = bi; sw[k] = sr[bi]; wsum += sw[k]; }
            const float inv = 2.5f / wsum;
#pragma unroll
            for (int k = 0; k < 8; ++k) { const int a = trow * 8 + k; const int pos = atomicAdd(&cnt[sel[k]], 1);
                LIST[(size_t)sel[k] * TT + pos] = a; PK[a] = ((unsigned)sel[k] << 16) | (unsigned)pos; LW[(size_t)sel[k] * TT + pos] = sw[k] * inv; }
            LIST[(size_t)64 * TT + (trow - r0)] = 8 * TT + trow; LW[(size_t)64 * TT + (trow - r0)] = 1.0f;
        }
    }
}
namespace att {
constexpr int D = 128, NW = 8, QBLK = 32, KVBLK = 64;
constexpr float SCALE = 0.088388347648318440f;
constexpr float THR = 8.f;
constexpr int SHM_V = KVBLK * D * 2, SHM_K = KVBLK * D * 2, SHM_ATTN = 2 * SHM_V + 2 * SHM_K + NW * 64 * 4;
#define KSWZ(row, colB) ((row) * 256 + ((colB) ^ (((row) & 7) << 4)))
#define SBAR() __builtin_amdgcn_sched_barrier(0)
__device__ __forceinline__ int crow(int r, int hi) { return (r & 3) + 8 * (r >> 2) + 4 * hi; }
__device__ __forceinline__ unsigned cvtpk(float lo, float hi) { unsigned r; asm volatile("v_cvt_pk_bf16_f32 %0, %1, %2" : "=v"(r) : "v"(lo), "v"(hi)); return r; }

__device__ __forceinline__ void partialSM(f32x16& p0, f32x16& p1, float negMC) {
  constexpr float Cc = SCALE * 1.4426950408889634f;
  for (int r = 0; r < 16; ++r) p0[r] = fmaf(p0[r], Cc, negMC); for (int r = 0; r < 16; ++r) p1[r] = fmaf(p1[r], Cc, negMC);
  for (int r = 0; r < 16; ++r) p0[r] = __builtin_amdgcn_exp2f(p0[r]);
}
__device__ __forceinline__ void finishSM(f32x16& p0, f32x16& p1, float& l_reg, bf16x8& pa0, bf16x8& pa1, bf16x8& pa2, bf16x8& pa3) {
  for (int r = 0; r < 16; ++r) p1[r] = __builtin_amdgcn_exp2f(p1[r]);
  float ps = 0; for (int r = 0; r < 16; ++r) ps += p0[r]; for (int r = 0; r < 16; ++r) ps += p1[r];
  { auto rr = __builtin_amdgcn_permlane32_swap(__float_as_uint(ps), __float_as_uint(ps), false, false);
    ps = __uint_as_float(rr[0]) + __uint_as_float(rr[1]); }
  l_reg += ps;
#define PK4(P, BASE, OUT) do { unsigned a0 = cvtpk(P[BASE + 0], P[BASE + 1]), a1 = cvtpk(P[BASE + 2], P[BASE + 3]);   \
    unsigned b0 = cvtpk(P[BASE + 4], P[BASE + 5]), b1 = cvtpk(P[BASE + 6], P[BASE + 7]);                              \
    auto r0 = __builtin_amdgcn_permlane32_swap(a0, b0, false, false); auto r1 = __builtin_amdgcn_permlane32_swap(a1, b1, false, false); \
    u32x4 w = {r0[0], r1[0], r0[1], r1[1]}; OUT = *reinterpret_cast<bf16x8*>(&w); } while (0)
  PK4(p0, 0, pa0); PK4(p0, 8, pa1); PK4(p1, 0, pa2); PK4(p1, 8, pa3);
#undef PK4
}
__device__ __forceinline__ void qkt(f32x16& p0, f32x16& p1, const LAS char* Ks, const bf16x8* qr, int r32, int hi) {
  p0 = f32x16{}; p1 = f32x16{};
  for (int d0 = 0; d0 < 8; ++d0) { int cb = (d0 * 16 + hi * 8) * 2;
    bf16x8 b0 = *reinterpret_cast<const LAS bf16x8*>(Ks + KSWZ(r32, cb));
    bf16x8 b1 = *reinterpret_cast<const LAS bf16x8*>(Ks + KSWZ(32 + r32, cb));
    p0 = __builtin_amdgcn_mfma_f32_32x32x16_bf16(b0, qr[d0], p0, 0, 0, 0);
    p1 = __builtin_amdgcn_mfma_f32_32x32x16_bf16(b1, qr[d0], p1, 0, 0, 0); }
}
__device__ __forceinline__ int v_st(int k, int c) { const int kk = (k & ~0xC) | ((k & 4) << 1) | ((k & 8) >> 1); return ((kk >> 3) * 4 + (c >> 5)) * 512 + ((kk & 7) * 32 + (c & 31)) * 2; }
__device__ __forceinline__ int v_rd_base(int lane) { return ((lane & 3) << 3) | (((lane >> 2) & 3) << 6) | (((lane >> 4) & 1) << 5) | (((lane >> 5) & 1) << 8); }
constexpr int v_rd_off(int d0, int ks, int half) { return d0 * 512 + ks * 4096 + half * 2048; }
template <int OFF> __device__ __forceinline__ s16x4 tr_read(int vb) {
  s16x4 r; asm volatile("ds_read_b64_tr_b16 %0, %1 offset:%2" : "=&v"(r) : "v"(vb), "i"(OFF) : "memory"); return r;
}
template <int D0> __device__ __forceinline__ void pv_one(f32x16& od, int vb, bf16x8 pa0, bf16x8 pa1, bf16x8 pa2, bf16x8 pa3) {
  const s16x4 l0 = tr_read<v_rd_off(D0, 0, 0)>(vb), h0 = tr_read<v_rd_off(D0, 0, 1)>(vb), l1 = tr_read<v_rd_off(D0, 1, 0)>(vb), h1 = tr_read<v_rd_off(D0, 1, 1)>(vb);
  const s16x4 l2 = tr_read<v_rd_off(D0, 2, 0)>(vb), h2 = tr_read<v_rd_off(D0, 2, 1)>(vb), l3 = tr_read<v_rd_off(D0, 3, 0)>(vb), h3 = tr_read<v_rd_off(D0, 3, 1)>(vb);
  asm volatile("s_waitcnt lgkmcnt(0)" ::: "memory"); SBAR();
#define PK(L, H) (bf16x8){L[0], L[1], L[2], L[3], H[0], H[1], H[2], H[3]}
  od = __builtin_amdgcn_mfma_f32_32x32x16_bf16(pa0, PK(l0, h0), od, 0, 0, 0);
  od = __builtin_amdgcn_mfma_f32_32x32x16_bf16(pa1, PK(l1, h1), od, 0, 0, 0);
  od = __builtin_amdgcn_mfma_f32_32x32x16_bf16(pa2, PK(l2, h2), od, 0, 0, 0);
  od = __builtin_amdgcn_mfma_f32_32x32x16_bf16(pa3, PK(l3, h3), od, 0, 0, 0);
#undef PK
}
__device__ __forceinline__ void pv_d0(f32x16* o, int vb, bf16x8 pa0, bf16x8 pa1, bf16x8 pa2, bf16x8 pa3) {
  pv_one<0>(o[0], vb, pa0, pa1, pa2, pa3); pv_one<1>(o[1], vb, pa0, pa1, pa2, pa3); pv_one<2>(o[2], vb, pa0, pa1, pa2, pa3); pv_one<3>(o[3], vb, pa0, pa1, pa2, pa3);
}

template <int LDQ, int LDK, int LDO>
__device__ __forceinline__ void attn_dense_body(const bf16_t* __restrict__ Qb, const bf16_t* __restrict__ Kh, const bf16_t* __restrict__ Vh, bf16_t* __restrict__ Ob, int seq, LAS char* lds, int tid, float kmax2) {
  const int wid = tid >> 6, lane = tid & 63, r32 = lane & 31, hi = lane >> 5;
  LAS char* V_lds = lds; LAS char* K_lds = lds + 2 * SHM_V;
  LAS float* ws = (LAS float*)(lds + 2 * SHM_V + 2 * SHM_K) + wid * 64; LAS float* li_l = ws;
  float l_reg = 0; f32x16 o[4] = {}; bf16x8 qr[8];
  const bf16_t* Qw = Qb + (long)(wid * QBLK + r32) * LDQ + hi * 8;
#pragma unroll
  for (int d0 = 0; d0 < 8; ++d0) qr[d0] = *reinterpret_cast<const bf16x8*>(Qw + d0 * 16);
  float negMC;
  { float q2 = 0.f;
#pragma unroll
    for (int d0 = 0; d0 < 8; ++d0) { const u32x4 w = __builtin_bit_cast(u32x4, qr[d0]);
      q2 += bflo(w.x) * bflo(w.x) + bfhi(w.x) * bfhi(w.x) + bflo(w.y) * bflo(w.y) + bfhi(w.y) * bfhi(w.y) + bflo(w.z) * bflo(w.z) + bfhi(w.z) * bfhi(w.z) + bflo(w.w) * bflo(w.w) + bfhi(w.w) * bfhi(w.w); }
    auto rr = __builtin_amdgcn_permlane32_swap(__float_as_uint(q2), __float_as_uint(q2), false, false);
    q2 = __uint_as_float(rr[0]) + __uint_as_float(rr[1]);
    negMC = -(sqrtf(q2 * kmax2) * (SCALE * 1.0001f) - 30.0f) * 1.4426950408889634f; }
  const int sr = tid >> 4, sc = (tid & 15) * 8, vst0 = v_st(sr, sc), vst1 = v_st(32 + sr, sc);
  const int vb0 = (int)(uintptr_t)V_lds + v_rd_base(lane);
  struct { bf16x8 vs0, vs1, ks0, ks1; } sr_[2];
#define SLOAD(i, k0) do { sr_[i].vs0 = *reinterpret_cast<const bf16x8*>(&Vh[(long)((k0) + sr) * LDK + sc]); sr_[i].vs1 = *reinterpret_cast<const bf16x8*>(&Vh[(long)((k0) + 32 + sr) * LDK + sc]); \
    sr_[i].ks0 = *reinterpret_cast<const bf16x8*>(&Kh[(long)((k0) + sr) * LDK + sc]); sr_[i].ks1 = *reinterpret_cast<const bf16x8*>(&Kh[(long)((k0) + 32 + sr) * LDK + sc]); } while (0)
#define SWRITE(b, i) do { *(LAS bf16x8*)(V_lds + (b) * SHM_V + vst0) = sr_[i].vs0;          \
    *(LAS bf16x8*)(V_lds + (b) * SHM_V + vst1) = sr_[i].vs1; int kc = sc * 2;               \
    *(LAS bf16x8*)(K_lds + (b) * SHM_K + KSWZ(sr, kc)) = sr_[i].ks0;                       \
    *(LAS bf16x8*)(K_lds + (b) * SHM_K + KSWZ(32 + sr, kc)) = sr_[i].ks1; } while (0)
#define SWAIT() asm volatile("s_waitcnt vmcnt(4)" ::: "memory")
  f32x16 pA0, pA1, pB0, pB1; bf16x8 pa0, pa1, pa2, pa3; const int NT = seq / KVBLK;
  constexpr int SE = 0, SO = 1;
  SLOAD(SE, 0); asm volatile("s_waitcnt vmcnt(0)" ::: "memory"); SWRITE(0, SE); __syncthreads();
  qkt(pA0, pA1, K_lds, qr, r32, hi); partialSM(pA0, pA1, negMC);
  SLOAD(SO, KVBLK); if (2 < NT) SLOAD(SE, 2 * KVBLK);
  SWAIT(); SWRITE(1, SO); __syncthreads();
  for (int j = 1; j + 1 < NT; j += 2) {
    SBAR(); qkt(pB0, pB1, K_lds + SHM_K, qr, r32, hi);
    finishSM(pA0, pA1, l_reg, pa0, pa1, pa2, pa3); SBAR();
    SLOAD(SO, (j + 2) * KVBLK); SBAR();
    pv_d0(o, vb0, pa0, pa1, pa2, pa3); partialSM(pB0, pB1, negMC);
    __syncthreads(); SWAIT(); SWRITE(0, SE);
    __syncthreads();
    SBAR(); qkt(pA0, pA1, K_lds, qr, r32, hi);
    finishSM(pB0, pB1, l_reg, pa0, pa1, pa2, pa3); SBAR();
    if (j + 3 < NT) SLOAD(SE, (j + 3) * KVBLK); SBAR();
    pv_d0(o, vb0 + (int)SHM_V, pa0, pa1, pa2, pa3); partialSM(pA0, pA1, negMC);
    __syncthreads(); SWAIT(); SWRITE(1, SO);
    __syncthreads();
  }
  SBAR(); qkt(pB0, pB1, K_lds + SHM_K, qr, r32, hi);
  finishSM(pA0, pA1, l_reg, pa0, pa1, pa2, pa3); SBAR();
  pv_d0(o, vb0, pa0, pa1, pa2, pa3); partialSM(pB0, pB1, negMC);
  __syncthreads();
  finishSM(pB0, pB1, l_reg, pa0, pa1, pa2, pa3); SBAR();
  pv_d0(o, vb0 + (int)SHM_V, pa0, pa1, pa2, pa3);
  if (hi == 0) li_l[r32] = l_reg; asm volatile("s_waitcnt lgkmcnt(0)" ::: "memory");
  float rli[16];
#pragma unroll
  for (int r = 0; r < 16; ++r) rli[r] = __builtin_amdgcn_rcpf(li_l[crow(r, hi)]);
  bf16_t* Ow = Ob + (long)(wid * QBLK) * LDO;
#pragma unroll
  for (int r = 0; r < 16; ++r) { int orow = crow(r, hi);
    for (int d0 = 0; d0 < 4; ++d0) Ow[(long)orow * LDO + d0 * 32 + r32] = (bf16_t)(cvtpk(o[d0][r] * rli[r], 0.f) & 0xffffu); }
#undef SLOAD
#undef SWRITE
#undef SWAIT
}

typedef int v8i32a __attribute__((ext_vector_type(8)));
typedef int v4i32a __attribute__((ext_vector_type(4)));
#define KSW8(row, chunk) ((row) * 128 + ((((chunk) ^ (((row) >> 1) & 7))) << 4))
#define VSW8(d, chunk) ((d) * 64 + ((((chunk) ^ (((d) >> 2) & 3))) << 4))
#define MFMA8(a, b, c) __builtin_amdgcn_mfma_scale_f32_32x32x64_f8f6f4((a), (b), (c), 0, 0, 0, 0, 0, 0)
__device__ __forceinline__ v8i32a ld32_l(const LAS char* p0, const LAS char* p1) { return __builtin_shufflevector(*(const LAS v4i32a*)p0, *(const LAS v4i32a*)p1, 0, 1, 2, 3, 4, 5, 6, 7); }
__device__ __forceinline__ unsigned pk4f8(float a, float b, float c, float d) { unsigned w = (unsigned)__builtin_amdgcn_cvt_pk_fp8_f32(a, b, 0, false); return (unsigned)__builtin_amdgcn_cvt_pk_fp8_f32(c, d, (int)w, true); }
template <int LDO, int KSTR>
__device__ __forceinline__ void attn_dense8_body(const unsigned char* __restrict__ Q8b, const unsigned char* __restrict__ K8h, const unsigned char* __restrict__ VT8h, bf16_t* __restrict__ Ob, int seq, LAS char* lds, int tid, float kmax2) {
  const int wid = tid >> 6, lane = tid & 63, r32 = lane & 31, hi = lane >> 5;
  constexpr int RS = 6, PD = 4;
  LAS float* al_l = (LAS float*)(lds + RS * 16384) + wid * 32;
  f32x16 o[4] = {}; v8i32a qf[2];
  { const unsigned char* qp = Q8b + (size_t)(wid * QBLK + r32) * 1024 + 32 * hi;
    qf[0] = __builtin_shufflevector(*(const v4i32a*)qp, *(const v4i32a*)(qp + 16), 0, 1, 2, 3, 4, 5, 6, 7);
    qf[1] = __builtin_shufflevector(*(const v4i32a*)(qp + 64), *(const v4i32a*)(qp + 80), 0, 1, 2, 3, 4, 5, 6, 7); }
  (void)kmax2;
  constexpr float THR8 = 1.4426950408889634f;
  float m_reg = 0.f; f32x16 osum = {}; v8i32a ones = {0x38383838, 0x38383838, 0x38383838, 0x38383838, 0x38383838, 0x38383838, 0x38383838, 0x38383838}; asm volatile("" : "+v"(ones));
#define PSM8(P0, P1, DL, CN, FIRST) do { float pmax = P0[0]; for (int r = 1; r < 16; ++r) pmax = fmaxf(pmax, P0[r]); for (int r = 0; r < 16; ++r) pmax = fmaxf(pmax, P1[r]); \
      { auto rr = __builtin_amdgcn_permlane32_swap(__float_as_uint(pmax), __float_as_uint(pmax), false, false); pmax = fmaxf(__uint_as_float(rr[0]), __uint_as_float(rr[1])); } \
      const float mn = (FIRST) ? pmax : ((pmax - m_reg > THR8) ? pmax : m_reg); DL = (FIRST) ? 0.f : mn - m_reg; m_reg = mn; CN = 7.0f - mn; \
      for (int r = 0; r < 16; ++r) P0[r] = __builtin_amdgcn_exp2f(P0[r] + CN); } while (0)
#define RESC8(DL) do { if (__any((DL) > 0.f)) { if (hi == 0) al_l[r32] = __builtin_amdgcn_exp2f(-(DL)); asm volatile("s_waitcnt lgkmcnt(0)" ::: "memory"); \
      for (int d = 0; d < 4; ++d) for (int r = 0; r < 16; ++r) o[d][r] *= al_l[crow(r, hi)]; for (int r = 0; r < 16; ++r) osum[r] *= al_l[crow(r, hi)]; } } while (0)
  const unsigned kgo = (unsigned)((tid >> 3) * KSTR + 16 * ((tid & 7) ^ ((tid >> 4) & 7))), vgo = (unsigned)((tid >> 2) * 64 + 16 * ((tid & 3) ^ ((tid >> 4) & 3)));
  const unsigned ldw = (unsigned)wid * 1024u;
#define DMA8(slot, T_) do { __builtin_amdgcn_global_load_lds((const unsigned*)(K8h + (size_t)(T_) * (64 * KSTR) + kgo), (LAS unsigned*)(lds + (slot) * 16384 + ldw), 16, 0, 0); \
      __builtin_amdgcn_global_load_lds((const unsigned*)(VT8h + (size_t)(T_) * 8192 + vgo), (LAS unsigned*)(lds + (slot) * 16384 + 8192 + ldw), 16, 0, 0); } while (0)
#define DWAIT8() do { asm volatile("s_waitcnt vmcnt(6)\n\ts_waitcnt lgkmcnt(0)" ::: "memory"); __builtin_amdgcn_s_barrier(); asm volatile("" ::: "memory"); } while (0)
#define QK8(P0, P1, KB) do { P0 = f32x16{}; P1 = f32x16{}; _Pragma("unroll") for (int s = 0; s < 2; ++s) { \
      const v8i32a k0 = ld32_l((KB) + KSW8(r32, 4 * s + 2 * hi), (KB) + KSW8(r32, 4 * s + 2 * hi + 1)); \
      const v8i32a k1 = ld32_l((KB) + KSW8(32 + r32, 4 * s + 2 * hi), (KB) + KSW8(32 + r32, 4 * s + 2 * hi + 1)); \
      P0 = MFMA8(k0, qf[s], P0); P1 = MFMA8(k1, qf[s], P1); } } while (0)
#define FIN8(P0, P1, CN) do { for (int r = 0; r < 16; ++r) P1[r] = __builtin_amdgcn_exp2f(P1[r] + CN); \
      _Pragma("unroll") for (int i = 0; i < 4; ++i) { pa[i] = (int)pk4f8(P0[4 * i], P0[4 * i + 1], P0[4 * i + 2], P0[4 * i + 3]); pa[4 + i] = (int)pk4f8(P1[4 * i], P1[4 * i + 1], P1[4 * i + 2], P1[4 * i + 3]); } } while (0)
#define PV8(VB) do { _Pragma("unroll") for (int d0 = 0; d0 < 4; ++d0) { \
      const v8i32a vf = ld32_l((VB) + VSW8(32 * d0 + r32, 2 * hi), (VB) + VSW8(32 * d0 + r32, 2 * hi + 1)); \
      o[d0] = MFMA8(pa, vf, o[d0]); } osum = MFMA8(pa, ones, osum); } while (0)
#define LDK8(KB, s, half) ld32_l((KB) + KSW8(32 * (half) + r32, 4 * (s) + 2 * hi), (KB) + KSW8(32 * (half) + r32, 4 * (s) + 2 * hi + 1))
#define LDV8(VB, d0) ld32_l((VB) + VSW8(32 * (d0) + r32, 2 * hi), (VB) + VSW8(32 * (d0) + r32, 2 * hi + 1))
#define EXPN(P, r0, n, CN) do { _Pragma("unroll") for (int r = (r0); r < (r0) + (n); ++r) { float e_ = __builtin_amdgcn_exp2f(P[r] + (CN)); asm volatile("" : "+v"(e_)); P[r] = e_; } } while (0)
#define FINP(P0, P1, CN, i) do { EXPN(P1, 4 * (i), 4, CN); \
      { unsigned w_ = (unsigned)__builtin_amdgcn_cvt_pk_fp8_f32(P0[4 * (i)], P0[4 * (i) + 1], pa[i], false); pa[i] = __builtin_amdgcn_cvt_pk_fp8_f32(P0[4 * (i) + 2], P0[4 * (i) + 3], (int)w_, true); } \
      { unsigned w_ = (unsigned)__builtin_amdgcn_cvt_pk_fp8_f32(P1[4 * (i)], P1[4 * (i) + 1], pa[4 + (i)], false); pa[4 + (i)] = __builtin_amdgcn_cvt_pk_fp8_f32(P1[4 * (i) + 2], P1[4 * (i) + 3], (int)w_, true); } } while (0)
#define PINA(x, y) asm volatile("" : "+v"(x), "+v"(y))
#define PIN1(x) asm volatile("" : "+v"(x))
#define PINC(x, y) asm volatile("" :: "v"(x), "v"(y))
#define HSTEP(X0, X1, DLX, CNX, Y0, Y1, CNY, KB, VB, STAGE_LOAD) do { \
      v8i32a ka_ = LDK8(KB, 0, 0), kb_ = LDK8(KB, 0, 1), kc_ = LDK8(KB, 1, 0), kd_ = LDK8(KB, 1, 1); \
      X0 = MFMA8(ka_, qf[0], f32x16{}); PINA(X0, kb_); \
      FINP(Y0, Y1, CNY, 0); PINC(pa[0], pa[4]); PIN1(kb_); \
      X1 = MFMA8(kb_, qf[0], f32x16{}); PINA(X1, kc_); \
      FINP(Y0, Y1, CNY, 1); PINC(pa[1], pa[5]); PIN1(kc_); \
      X0 = MFMA8(kc_, qf[1], X0); PINA(X0, kd_); \
      v8i32a v0_ = LDV8(VB, 0), v1_ = LDV8(VB, 1); \
      FINP(Y0, Y1, CNY, 2); STAGE_LOAD; PINC(pa[2], pa[6]); PIN1(kd_); \
      X1 = MFMA8(kd_, qf[1], X1); PINA(X1, v0_); \
      v8i32a v2_ = LDV8(VB, 2), v3_ = LDV8(VB, 3); \
      FINP(Y0, Y1, CNY, 3); PINC(pa[3], pa[7]); PINA(pa, v0_); \
      o[0] = MFMA8(pa, v0_, o[0]); PINA(o[0], v1_); \
      float pm0_ = X0[0]; _Pragma("unroll") for (int r = 1; r < 16; ++r) pm0_ = fmaxf(pm0_, X0[r]); PINA(pm0_, v1_); \
      o[1] = MFMA8(pa, v1_, o[1]); PINA(o[1], v2_); \
      _Pragma("unroll") for (int r = 0; r < 16; ++r) pm0_ = fmaxf(pm0_, X1[r]); \
      { auto rr = __builtin_amdgcn_permlane32_swap(__float_as_uint(pm0_), __float_as_uint(pm0_), false, false); pm0_ = fmaxf(__uint_as_float(rr[0]), __uint_as_float(rr[1])); } \
      { const float mn = (pm0_ - m_reg > THR8) ? pm0_ : m_reg; DLX = mn - m_reg; m_reg = mn; CNX = 7.0f - mn; } PINA(CNX, v2_); \
      o[2] = MFMA8(pa, v2_, o[2]); PINA(o[2], v3_); \
      EXPN(X0, 0, 5, CNX); PIN1(v3_); \
      o[3] = MFMA8(pa, v3_, o[3]); PINA(o[3], CNX); \
      EXPN(X0, 5, 5, CNX); PIN1(pa); \
      osum = MFMA8(pa, ones, osum); PINA(osum, CNX); \
      EXPN(X0, 10, 6, CNX); } while (0)
  f32x16 pA0, pA1, pB0, pB1; v8i32a pa = {}; float dlA, dlB, cnA, cnB; const int NT = seq / KVBLK;
#define SLOT(s) (lds + (s) * 16384)
#define SADV() do { sv = sk; sk = sk + 1 == RS ? 0 : sk + 1; sd = sd + 1 == RS ? 0 : sd + 1; } while (0)
  int sk = 0, sv = 0, sd = PD;
  DMA8(0, 0); DMA8(1, 1); DMA8(2, 2); DMA8(3, 3);
  DWAIT8();
  QK8(pA0, pA1, SLOT(0)); PSM8(pA0, pA1, dlA, cnA, true);
  DMA8(sd, PD); SADV(); DWAIT8();
  for (int j = 1; j + 1 < NT; j += 2) {
    HSTEP(pB0, pB1, dlB, cnB, pA0, pA1, cnA, SLOT(sk), SLOT(sv) + 8192, DMA8(sd, min(j + PD, NT - 1)));
    RESC8(dlB); SADV(); DWAIT8();
    HSTEP(pA0, pA1, dlA, cnA, pB0, pB1, cnB, SLOT(sk), SLOT(sv) + 8192, DMA8(sd, min(j + 1 + PD, NT - 1)));
    RESC8(dlA); SADV(); DWAIT8();
  }
  HSTEP(pB0, pB1, dlB, cnB, pA0, pA1, cnA, SLOT(sk), SLOT(sv) + 8192, (void)0);
  RESC8(dlB); SADV();
  FIN8(pB0, pB1, cnB); SBAR();
  PV8(SLOT(sv) + 8192);
  asm volatile("s_waitcnt vmcnt(0)" ::: "memory");
  float rli[16];
#pragma unroll
  for (int r = 0; r < 16; ++r) rli[r] = __builtin_amdgcn_rcpf(osum[r]);
  bf16_t* Ow = Ob + (long)(wid * QBLK) * LDO;
#pragma unroll
  for (int r = 0; r < 16; ++r) { int orow = crow(r, hi);
    for (int d0 = 0; d0 < 4; ++d0) Ow[(long)orow * LDO + d0 * 32 + r32] = (bf16_t)(cvtpk(o[d0][r] * rli[r], 0.f) & 0xffffu); }
#undef PSM8
#undef RESC8
#undef DMA8
#undef DWAIT8
#undef SLOT
#undef SADV
#undef QK8
#undef FIN8
#undef PV8
#undef HSTEP
#undef PINA
#undef PIN1
#undef PINC
#undef FINP
#undef EXPN
#undef LDK8
#undef LDV8
}

template <int LDO, int KSTR>
__device__ __forceinline__ void attn_dense8w_body(const unsigned char* __restrict__ Q8b, const unsigned char* __restrict__ K8h, const unsigned char* __restrict__ VT8h0, const unsigned char* __restrict__ VT8h1, bf16_t* __restrict__ Ob, int seq, LAS char* lds, int tid, float kmax2) {
  const int wid = tid >> 6, lane = tid & 63, r32 = lane & 31, hi = lane >> 5;
  constexpr int RS = 4, PD = 2, SB = 24576;
  LAS float* al_l = (LAS float*)(lds + RS * SB) + wid * 32;
  LAS char* q_l = lds + RS * SB + 2048 + wid * 4096 + lane * 16;
  { const unsigned char* qp = Q8b + (size_t)(wid * QBLK + r32) * 1024 + 32 * hi;
    *(LAS v4i32a*)(q_l) = *(const v4i32a*)qp; *(LAS v4i32a*)(q_l + 1024) = *(const v4i32a*)(qp + 16);
    *(LAS v4i32a*)(q_l + 2048) = *(const v4i32a*)(qp + 64); *(LAS v4i32a*)(q_l + 3072) = *(const v4i32a*)(qp + 80); }
  (void)kmax2;
  constexpr float THR8 = 1.4426950408889634f;
  float l_reg = 0.f, m_reg = 0.f; f32x16 o[8] = {};
  const unsigned kgo = (unsigned)((tid >> 3) * KSTR + 16 * ((tid & 7) ^ ((tid >> 4) & 7))), vgo = (unsigned)((tid >> 2) * 64 + 16 * ((tid & 3) ^ ((tid >> 4) & 3)));
  const unsigned ldw = (unsigned)wid * 1024u;
#define DMA8(slot, T_) do { __builtin_amdgcn_global_load_lds((const unsigned*)(K8h + (size_t)(T_) * (64 * KSTR) + kgo), (LAS unsigned*)(lds + (slot) * SB + ldw), 16, 0, 0); \
      __builtin_amdgcn_global_load_lds((const unsigned*)(VT8h0 + (size_t)(T_) * 8192 + vgo), (LAS unsigned*)(lds + (slot) * SB + 8192 + ldw), 16, 0, 0); \
      __builtin_amdgcn_global_load_lds((const unsigned*)(VT8h1 + (size_t)(T_) * 8192 + vgo), (LAS unsigned*)(lds + (slot) * SB + 16384 + ldw), 16, 0, 0); } while (0)
#define DWAIT8() do { asm volatile("s_waitcnt vmcnt(3)\n\ts_waitcnt lgkmcnt(0)" ::: "memory"); __builtin_amdgcn_s_barrier(); asm volatile("" ::: "memory"); } while (0)
#define SLOT(s) (lds + (s) * SB)
#define SADV() do { sv = sk; sk = sk + 1 == RS ? 0 : sk + 1; sd = sd + 1 == RS ? 0 : sd + 1; } while (0)
#define LDK8(KB, s, half) ld32_l((KB) + KSW8(32 * (half) + r32, 4 * (s) + 2 * hi), (KB) + KSW8(32 * (half) + r32, 4 * (s) + 2 * hi + 1))
#define LDV8(VB, d0) ld32_l((VB) + VSW8(32 * (d0) + r32, 2 * hi), (VB) + VSW8(32 * (d0) + r32, 2 * hi + 1))
#define PIN1(x) asm volatile("" : "+v"(x))
#define EXPR(e0, n) do { _Pragma("unroll") for (int e = (e0); e < (e0) + (n); ++e) { float x_ = e < 16 ? X0[e & 15] : X1[e & 15]; float e_ = __builtin_amdgcn_exp2f(x_ + cn); asm volatile("" : "+v"(e_)); ps += e_; \
      if (e < 16) X0[e & 15] = e_; else X1[e & 15] = e_; } } while (0)
#define PKW(PAC, w) do { if ((w) < 4) { unsigned w_ = (unsigned)__builtin_amdgcn_cvt_pk_fp8_f32(X0[4 * ((w) & 3)], X0[4 * ((w) & 3) + 1], PAC[w], false); PAC[w] = __builtin_amdgcn_cvt_pk_fp8_f32(X0[4 * ((w) & 3) + 2], X0[4 * ((w) & 3) + 3], (int)w_, true); } \
      else { unsigned w_ = (unsigned)__builtin_amdgcn_cvt_pk_fp8_f32(X1[4 * ((w) & 3)], X1[4 * ((w) & 3) + 1], PAC[w], false); PAC[w] = __builtin_amdgcn_cvt_pk_fp8_f32(X1[4 * ((w) & 3) + 2], X1[4 * ((w) & 3) + 3], (int)w_, true); } } while (0)
#define PVM(PAP, g) do { PIN1(vv##g); o[4 * ((g) & 1) + ((g) >> 1)] = MFMA8(PAP, vv##g, o[4 * ((g) & 1) + ((g) >> 1)]); asm volatile("" :: "v"(o[4 * ((g) & 1) + ((g) >> 1)])); } while (0)
#define LDVG(g) ({ int o_ = sv * SB + 8192 + 8192 * ((g) & 1); asm volatile("" : "+s"(o_)); LDV8(lds + o_, (g) >> 1); })
#define WSTEP(PAP, PAC, FIRST, TNEXT) do { \
      { const v8i32a ka_ = LDK8(SLOT(sk), 0, 0), kb_ = LDK8(SLOT(sk), 0, 1), kc_ = LDK8(SLOT(sk), 1, 0), kd_ = LDK8(SLOT(sk), 1, 1); \
        const v8i32a q0_ = ld32_l(q_l, q_l + 1024), q1_ = ld32_l(q_l + 2048, q_l + 3072); \
        X0 = MFMA8(ka_, q0_, f32x16{}); X1 = MFMA8(kb_, q0_, f32x16{}); X0 = MFMA8(kc_, q1_, X0); X1 = MFMA8(kd_, q1_, X1); PIN1(X1); } \
      DMA8(sd, TNEXT); \
      v8i32a vv0 = LDVG(0), vv1 = LDVG(1); \
      PVM(PAP, 0); v8i32a vv2 = LDVG(2); \
      float pm_ = X0[0]; _Pragma("unroll") for (int r = 1; r < 16; ++r) pm_ = fmaxf(pm_, X0[r]); PIN1(pm_); \
      PVM(PAP, 1); v8i32a vv3 = LDVG(3); \
      _Pragma("unroll") for (int r = 0; r < 16; ++r) pm_ = fmaxf(pm_, X1[r]); \
      { auto rr = __builtin_amdgcn_permlane32_swap(__float_as_uint(pm_), __float_as_uint(pm_), false, false); pm_ = fmaxf(__uint_as_float(rr[0]), __uint_as_float(rr[1])); } \
      const float mn_ = (FIRST) ? pm_ : ((pm_ - m_reg > THR8) ? pm_ : m_reg); const float dl_ = (FIRST) ? 0.f : mn_ - m_reg; m_reg = mn_; float cn = 7.0f - mn_; float ps = 0.f; PIN1(cn); \
      PVM(PAP, 2); v8i32a vv4 = LDVG(4); EXPR(0, 6); PKW(PAC, 0); \
      PVM(PAP, 3); v8i32a vv5 = LDVG(5); EXPR(6, 6); PKW(PAC, 1); PKW(PAC, 2); \
      PVM(PAP, 4); v8i32a vv6 = LDVG(6); EXPR(12, 5); PKW(PAC, 3); \
      PVM(PAP, 5); v8i32a vv7 = LDVG(7); EXPR(17, 5); PKW(PAC, 4); \
      PVM(PAP, 6); EXPR(22, 5); PKW(PAC, 5); \
      PVM(PAP, 7); EXPR(27, 5); PKW(PAC, 6); PKW(PAC, 7); \
      { auto rr = __builtin_amdgcn_permlane32_swap(__float_as_uint(ps), __float_as_uint(ps), false, false); ps = __uint_as_float(rr[0]) + __uint_as_float(rr[1]); } \
      if (__any(dl_ > 0.f)) { const float al_ = __builtin_amdgcn_exp2f(-dl_); l_reg *= al_; if (hi == 0) al_l[r32] = al_; asm volatile("s_waitcnt lgkmcnt(0)" ::: "memory"); \
        for (int d = 0; d < 8; ++d) for (int r = 0; r < 16; ++r) o[d][r] *= al_l[crow(r, hi)]; } \
      l_reg += ps; \
      SADV(); DWAIT8(); } while (0)
  f32x16 X0, X1; v8i32a paA = {}, paB = {}; const int NT = seq / KVBLK;
  int sk = 0, sv = 0, sd = PD;
  DMA8(0, 0); DMA8(1, 1);
  DWAIT8();
  for (int j = 0; j < NT; j += 2) {
    WSTEP(paB, paA, j == 0, min(j + PD, NT - 1));
    WSTEP(paA, paB, false, min(j + 1 + PD, NT - 1));
  }
  { v8i32a vv0 = LDVG(0), vv1 = LDVG(1), vv2 = LDVG(2), vv3 = LDVG(3); PVM(paB, 0); PVM(paB, 1); PVM(paB, 2); PVM(paB, 3); }
  { v8i32a vv4 = LDVG(4), vv5 = LDVG(5), vv6 = LDVG(6), vv7 = LDVG(7); PVM(paB, 4); PVM(paB, 5); PVM(paB, 6); PVM(paB, 7); }
  asm volatile("s_waitcnt vmcnt(0)" ::: "memory");
  int te = tid; asm volatile("" : "+v"(te));
  const int wid_e = te >> 6, r32_e = te & 31, hi_e = (te >> 5) & 1;
  LAS float* li_e = (LAS float*)(lds + RS * SB + 1024) + wid_e * 32;
  if (hi_e == 0) li_e[r32_e] = l_reg; asm volatile("s_waitcnt lgkmcnt(0)" ::: "memory");
  float rli[16];
#pragma unroll
  for (int r = 0; r < 16; ++r) rli[r] = __builtin_amdgcn_rcpf(li_e[crow(r, hi_e)]);
  bf16_t* Ow = Ob + (long)(wid_e * QBLK) * LDO;
#pragma unroll
  for (int r = 0; r < 16; ++r) { int orow = crow(r, hi_e);
    for (int d0 = 0; d0 < 8; ++d0) Ow[(long)orow * LDO + d0 * 32 + r32_e] = (bf16_t)(cvtpk(o[d0][r] * rli[r], 0.f) & 0xffffu); }
#undef DMA8
#undef DWAIT8
#undef SLOT
#undef SADV
#undef LDK8
#undef LDV8
#undef PIN1
#undef EXPR
#undef PKW
#undef PVM
#undef LDVG
#undef WSTEP
}

constexpr int PV_BUF = 32768, PK_BUF = 16384, P_LDS_V = 0, P_LDS_K = 2 * PV_BUF, P_LDS_X = P_LDS_K + 2 * PK_BUF, P_LDS_L = P_LDS_X + 8 * 2048, P_LDS_END = P_LDS_L + 1024;
__device__ __forceinline__ void qkt_half(f32x16& p, const LAS char* Ks, const bf16x8* qr, int krow, int hi) {
  p = f32x16{};
  for (int d0 = 0; d0 < 8; ++d0) { int cb = (d0 * 16 + hi * 8) * 2;
    bf16x8 b0 = *reinterpret_cast<const LAS bf16x8*>(Ks + KSWZ(krow, cb));
    p = __builtin_amdgcn_mfma_f32_32x32x16_bf16(b0, qr[d0], p, 0, 0, 0); }
}
__device__ __forceinline__ void smA(f32x16& p, float negMC) {
  constexpr float Cc = SCALE * 1.4426950408889634f;
  for (int r = 0; r < 16; ++r) p[r] = fmaf(p[r], Cc, negMC);
  for (int r = 0; r < 8; ++r) p[r] = __builtin_amdgcn_exp2f(p[r]);
}
__device__ __forceinline__ void smB(f32x16& p, float& l_reg, bf16x8& f0, bf16x8& f1) {
  for (int r = 8; r < 16; ++r) p[r] = __builtin_amdgcn_exp2f(p[r]);
  float ps = 0; for (int r = 0; r < 16; ++r) ps += p[r];
  { auto rr = __builtin_amdgcn_permlane32_swap(__float_as_uint(ps), __float_as_uint(ps), false, false);
    ps = __uint_as_float(rr[0]) + __uint_as_float(rr[1]); }
  l_reg += ps;
#define PK4(P, BASE, OUT) do { unsigned a0 = cvtpk(P[BASE + 0], P[BASE + 1]), a1 = cvtpk(P[BASE + 2], P[BASE + 3]);   \
    unsigned b0 = cvtpk(P[BASE + 4], P[BASE + 5]), b1 = cvtpk(P[BASE + 6], P[BASE + 7]);                              \
    auto r0 = __builtin_amdgcn_permlane32_swap(a0, b0, false, false); auto r1 = __builtin_amdgcn_permlane32_swap(a1, b1, false, false); \
    u32x4 w = {r0[0], r1[0], r0[1], r1[1]}; OUT = *reinterpret_cast<bf16x8*>(&w); } while (0)
  PK4(p, 0, f0); PK4(p, 8, f1);
#undef PK4
}
template <int LDQ, int LDK, int LDO>
__device__ __forceinline__ void attn_pair_body(const bf16_t* __restrict__ Qb, const bf16_t* __restrict__ Kh, const bf16_t* __restrict__ Vh, bf16_t* __restrict__ Ob, int seq, LAS char* lds, int tid, float kmax2) {
  const int wid = __builtin_amdgcn_readfirstlane(tid >> 6), lane = tid & 63, r32 = lane & 31, hi = lane >> 5, g = wid & 3, kb = wid >> 2;
  LAS char* V_lds = lds + P_LDS_V; LAS char* K_lds = lds + P_LDS_K;
  LAS char* xp_own = lds + P_LDS_X + wid * 2048 + lane * 16; LAS char* xp_par = lds + P_LDS_X + (wid ^ 4) * 2048 + lane * 16;
  LAS float* li = (LAS float*)(lds + P_LDS_L);
  float l_reg = 0; f32x16 o[4] = {}; bf16x8 qr[8];
  const bf16_t* Qw = Qb + (long)(g * QBLK + r32) * LDQ + hi * 8;
#pragma unroll
  for (int d0 = 0; d0 < 8; ++d0) qr[d0] = *reinterpret_cast<const bf16x8*>(Qw + d0 * 16);
  float negMC;
  { float q2 = 0.f;
#pragma unroll
    for (int d0 = 0; d0 < 8; ++d0) { const u32x4 w = __builtin_bit_cast(u32x4, qr[d0]);
      q2 += bflo(w.x) * bflo(w.x) + bfhi(w.x) * bfhi(w.x) + bflo(w.y) * bflo(w.y) + bfhi(w.y) * bfhi(w.y) + bflo(w.z) * bflo(w.z) + bfhi(w.z) * bfhi(w.z) + bflo(w.w) * bflo(w.w) + bfhi(w.w) * bfhi(w.w); }
    auto rr = __builtin_amdgcn_permlane32_swap(__float_as_uint(q2), __float_as_uint(q2), false, false);
    q2 = __uint_as_float(rr[0]) + __uint_as_float(rr[1]);
    negMC = -(sqrtf(q2 * kmax2) * (SCALE * 1.0001f) - 30.0f) * 1.4426950408889634f; }
  const int sr = tid >> 4, sc = (tid & 15) * 8, vst0 = v_st(sr, sc), vst1 = v_st(32 + sr, sc);
  const int vrd = (int)(uintptr_t)V_lds + kb * 16384 + v_rd_base(lane);
  const int krow = 32 * kb + r32;
  struct { bf16x8 v00, v01, v10, v11, k0, k1; } st_;
#define PLD16(base, off) (*reinterpret_cast<const bf16x8*>((const char*)(base) + (off)))
#define PLOAD(k0_) do { const unsigned o_ = (unsigned)(((k0_) + sr) * LDK + sc) * 2u; \
    st_.v00 = PLD16(Vh, o_); st_.v01 = PLD16(Vh, o_ + 256u); st_.v10 = PLD16(Vh, o_ + 64u * LDK); st_.v11 = PLD16(Vh, o_ + 64u * LDK + 256u); \
    st_.k0 = PLD16(Kh, o_); st_.k1 = PLD16(Kh, o_ + 64u * LDK); } while (0)
#define PWRITE(kbuf, vbuf) do { LAS char* vb_ = V_lds + (vbuf) * PV_BUF; LAS char* kb_ = K_lds + (kbuf) * PK_BUF; const int kc = sc * 2; \
    *(LAS bf16x8*)(vb_ + vst0) = st_.v00; *(LAS bf16x8*)(vb_ + 16384 + vst0) = st_.v01; *(LAS bf16x8*)(vb_ + vst1) = st_.v10; *(LAS bf16x8*)(vb_ + 16384 + vst1) = st_.v11; \
    *(LAS bf16x8*)(kb_ + KSWZ(sr, kc)) = st_.k0; *(LAS bf16x8*)(kb_ + KSWZ(32 + sr, kc)) = st_.k1; } while (0)
  const int NT = seq / KVBLK;
  f32x16 pS; bf16x8 f0, f1, g0, g1;
  PLOAD(0); asm volatile("s_waitcnt vmcnt(0)" ::: "memory"); PWRITE(0, 0); PLOAD(KVBLK);
  __syncthreads();
  for (int j = 0; j < NT; ++j) {
    SBAR();
    qkt_half(pS, K_lds + (j & 1) * PK_BUF, qr, krow, hi);
    smA(pS, negMC); smB(pS, l_reg, f0, f1); SBAR();
    *(LAS bf16x8*)(xp_own) = f0; *(LAS bf16x8*)(xp_own + 1024) = f1;
    if (j + 1 < NT) PWRITE((j + 1) & 1, (j + 1) & 1);
    if (j + 2 < NT) PLOAD((j + 2) * KVBLK);
    __syncthreads();
    g0 = *(const LAS bf16x8*)(xp_par); g1 = *(const LAS bf16x8*)(xp_par + 1024);
    { const int vb = vrd + (j & 1) * PV_BUF;
      if (kb == 0) pv_d0(o, vb, f0, f1, g0, g1); else pv_d0(o, vb, g0, g1, f0, f1); }
    __syncthreads();
  }
  if (hi == 0) li[wid * 32 + r32] = l_reg;
  __syncthreads();
#pragma unroll
  for (int r = 0; r < 16; ++r) { const int orow = crow(r, hi); const float rl = __builtin_amdgcn_rcpf(li[wid * 32 + orow] + li[(wid ^ 4) * 32 + orow]);
    bf16_t* op = Ob + (long)(g * QBLK + orow) * LDO + 128 * kb + r32;
    for (int d0 = 0; d0 < 4; ++d0) op[d0 * 32] = (bf16_t)(cvtpk(o[d0][r] * rl, 0.f) & 0xffffu); }
#undef PLD16
#undef PLOAD
#undef PWRITE
}
#undef KSWZ
}

__device__ __forceinline__ void phase_attention(const Params& p, Ctx& C) {
    bf16_t* ATT = (bf16_t*)(p.ws + WS_BIG + BG_ATT);
    const unsigned char* Q8 = (const unsigned char*)(p.ws + WS_BIG + BG_Q8); const unsigned char* K8 = (const unsigned char*)(p.ws + WS_BIG + BG_K8); const unsigned char* VT8 = (const unsigned char*)(p.ws + WS_BIG + BG_VT8);
    const unsigned char* Q8D = (const unsigned char*)(p.ws + WS_BIG + BG_Q8D); const unsigned char* K8D = (const unsigned char*)(p.ws + WS_BIG + BG_K8D); const unsigned char* VT8D = (const unsigned char*)(p.ws + WS_BIG + BG_VT8D);
    for (int i = 0;; ++i) {
        int unit;
        if (C.G == 256) { if (i >= 2) break; unit = (C.bid & 7) * 64 + i * 32 + (C.bid >> 3); } else { unit = i * C.G + C.bid; if (unit >= 512) break; }
        const int d = unit >> 6, qb = unit & 63, hh = d >> 1, m = d & 1;
        __syncthreads();
        int tz = C.tid; asm volatile("" : "+v"(tz));
        att::attn_dense8w_body<3072, 1024>(Q8D + (size_t)(CTXL + 256 * qb) * 1024 + 128 * d, K8D + 128 * d, VT8D + (size_t)(2 * hh) * 260 * 8192, VT8D + (size_t)(2 * hh + 1) * 260 * 8192,
                                           ATT + (size_t)(256 * qb) * 3072 + 1024 + 1024 * m + 256 * hh, TT, (LAS char*)C.lds, tz, 0.f);
    }
    for (int i = 0;; ++i) {
        int unit;
        if (C.G == 256) { if (i >= 2) break; unit = (C.bid & 7) * 64 + i * 32 + (C.bid >> 3); } else { unit = i * C.G + C.bid; if (unit >= 512) break; }
        const int prob = unit >> 6, qb = unit & 63;
        __syncthreads();
        int tz = C.tid; asm volatile("" : "+v"(tz));
        att::attn_dense8_body<3072, 256>(Q8 + (size_t)(CTXL + 256 * qb) * 1024 + 128 * prob, K8 + 128 * (prob >> 2), VT8 + (size_t)(prob >> 2) * 260 * 8192,
                                         ATT + (size_t)(256 * qb) * 3072 + 128 * prob, TT, (LAS char*)C.lds, tz, 0.f);
    }
    __syncthreads();
}
constexpr int PH_PER_LAYER = 13, N_PHASES = 2 + 2 * PH_PER_LAYER;
#ifndef DBL_PHASE
#define DBL_PHASE -1
#endif
#ifndef MK_PER_PHASE
#define MK_PER_PHASE 0
#endif

template <int L>
__device__ __forceinline__ void layer_body(const Params& p, Ctx& C0, const XcdBarrier& bar, LAS unsigned char* misc, int lo, int hi) {
#define IN(k) (lo <= (k) && (k) < hi)
#define SEAM(k) do { if (IN(k) && IN((k) + 1)) xcd_barrier(bar, C0.wave); } while (0)
#define PHASE(k, ...) if (DBL_PHASE == (k)) { int nrep_ = 2; asm volatile("" : "+s"(nrep_)); for (int rep_ = 0; rep_ < nrep_; ++rep_) { if (rep_) xcd_barrier(bar, C0.wave); FRESH(); __VA_ARGS__ } } else if (IN(k)) { FRESH(); __VA_ARGS__ } SEAM(k);
#define FRESH() Ctx C = C0; { int ln = (int)__builtin_amdgcn_mbcnt_hi(~0u, __builtin_amdgcn_mbcnt_lo(~0u, 0u)); asm volatile("" : "+v"(ln)); C.lane = ln; C.tid = C.wave * 64 + ln; }
        const int b = 2 + PH_PER_LAYER * L;
        bf16_t* QKV = (bf16_t*)(p.ws + WS_BIG + BG_QKV);
        bf16_t* XA = (bf16_t*)(p.ws + WS_XA);
        int* cnt = (int*)(p.ws + WS_CTL) + CW_CNT + L * 128; const int* LIST = (const int*)(p.ws + WS_LIST);
        if (L == 0) { PHASE(b + 0, phase_modulate(p, C, L); ) }
        PHASE(b + 1,
            const int N = L ? OD_IN : EV_IN;
            pg8::DenseOrder S; S.init8((const void*)XA, DM, (const void*)(p.ws + (L ? WS_WIN1 : WS_WIN0)), TT, N, DM, C.G, C.bid);
            pg8::EpiStore E{QKV, N, 1.0f / 32.0f};
            pg8::gemm_phase<true>(C.lds, S, E, C.wave);
            if (L == 0 && IN(b + 2) && S.units_of_me() < S.max_units()) conv_queue(p, C, 2);
        )
        PHASE(b + 2, if (L == 0) phase_rope0(p, C); else phase_normrope1(p, C); )
        PHASE(b + 3, if (L == 0) { ret_chunk_kv(p, C); s5_end_states(p, C); } else phase_attention(p, C); )
        PHASE(b + 4, if (L == 0) phase_scans(p, C); else phase_merge1(p, C); )
        if (L == 0) {
            PHASE(b + 5, phase_ret_s5_outputs(p, C, misc); )
            PHASE(b + 6,
                pg8::DenseOrder S; S.init((const bf16_t*)(p.ws + WS_Z), 1024, (const bf16_t*)(p.ws + WS_WGLU), TT, 1024, 1024, C.G, C.bid);
                pg8::EpiGlu E{(const bf16_t*)(p.ws + WS_Z), p.inp(20), (bf16_t*)(p.ws + WS_BIG + BG_MIX)};
                pg8::gemm_phase<false>(C.lds, S, E, C.wave);
                if (IN(b + 7) && S.units_of_me() < S.max_units()) conv_queue(p, C, 4);
            )
        }
        PHASE(b + 7,
            pg8::DenseOrder S;
            if (L == 0) S.init((const bf16_t*)(p.ws + WS_BIG + BG_MIX), DM, (const bf16_t*)(p.ws + WS_WOUT0), TT, DM, DM, C.G, C.bid);
            else S.init((const bf16_t*)(p.ws + WS_BIG + BG_ATT), 3072, (const bf16_t*)(p.ws + WS_WOUT1), SEQ, DM, DM, C.G, C.bid);
            pg8::EpiStore E{(bf16_t*)(p.ws + WS_YMIX) + (L ? (size_t)CTXL * DM : 0), DM, 1.0f};
            pg8::gemm_phase<false>(C.lds, S, E, C.wave);
            if (L == 0 && IN(b + 8) && S.units_of_me() < S.max_units()) conv_queue(p, C, 5);
        )
        PHASE(b + 8, phase_ln1(p, C, L); )
        PHASE(b + 9, phase_router(p, C, L); )
        PHASE(b + 10,
            pg8::MoeOrder<0> S; S.A = (const void*)XA; S.Bt = (const void*)(p.ws + WS_GU + (size_t)L * NEX1 * 1024 * DM); S.list = LIST; S.cnt = cnt; S.ldab = DM; S.kb = DM; S.nN = 4; S.G = C.G; S.c = C.bid; S.bstride = (size_t)1024 * DM;
            S.prep(misc, C.tid);
            pg8::EpiE1 E{(unsigned char*)(p.ws + WS_HX2), S.cn, S.rb};
            pg8::gemm_phase<true>(C.lds, S, E, C.wave);
        )
        PHASE(b + 11,
            pg8::MoeOrder<1> S; S.A = (const void*)(p.ws + WS_HX2); S.Bt = (const void*)(p.ws + WS_DT + (size_t)L * NEX1 * DM * EHID); S.list = LIST; S.cnt = cnt; S.ldab = EHID; S.kb = EHID; S.nN = 8; S.G = C.G; S.c = C.bid; S.bstride = (size_t)DM * EHID;
            S.prep(misc, C.tid);
            pg8::EpiE2 E{(unsigned char*)(p.ws + WS_BIG + BG_YMOE), (const float*)(p.ws + WS_LW), S.cn, S.rb};
            pg8::gemm_phase<true>(C.lds, S, E, C.wave);
        )
        PHASE(b + 12, phase_combine(p, C, L, misc); )
    #undef IN
#undef SEAM
#undef FRESH
#undef PHASE
}

__global__ void __launch_bounds__(NTHR, 2) mega_fwd(KArgs ka) {
    extern __shared__ __attribute__((aligned(16))) unsigned char lds_raw[];
    Ctx C;
    C.lds = (LAS unsigned char*)lds_raw;
    C.tid = threadIdx.x; C.lane = C.tid & 63; C.wave = __builtin_amdgcn_readfirstlane(C.tid >> 6);
    C.G = gridDim.x; C.bid = blockIdx.x; C.gw = C.bid * NWAVES + C.wave; C.ngw = C.G * NWAVES;
    LAS unsigned char* misc = C.lds + MISC_OFF;
    if (C.tid < 8) ((volatile LAS unsigned*)misc)[C.tid] = 0u;
    Params p; p.out = ka.out; p.ws = ka.ws; p.ph_lo = ka.ph_lo; p.ph_hi = ka.ph_hi; p.ptab = (LAS unsigned long long*)(misc + 1024);
    if (C.tid < 34) p.ptab[C.tid] = (unsigned long long)ka.in[C.tid];
    __syncthreads();
    const int lo = p.ph_lo, hi = p.ph_hi;
    XcdBarrier bar; bar.bar = (unsigned*)(p.ws + WS_CTL) + CW_BAR; bar.x = 0; bar.st = (volatile LAS unsigned*)misc;
    if (hi - lo > 1) bar = xcd_barrier_post((unsigned*)(p.ws + WS_CTL) + CW_BAR, (volatile LAS unsigned*)misc);
#define IN(k) (lo <= (k) && (k) < hi)
#define SEAM(k) do { if (IN(k) && IN((k) + 1)) xcd_barrier(bar, C.wave); } while (0)

    if (IN(0)) { phase_p0(p, C); } SEAM(0);
    if (IN(1)) { phase_p1(p, C); } SEAM(1);
    if (IN(0) && IN(2) && (C.G & 7) == 0) {
        volatile LAS unsigned* st = (volatile LAS unsigned*)misc;
        if (C.tid == 0) { unsigned pre = 0u; const unsigned x = st[3];
            for (unsigned j = 0; j < 16; ++j) { const unsigned cj = xb_ld(&bar.bar[XB_XCNT(j)]); pre += (j < x) ? cj : 0u; }
            st[4] = pre + st[2]; }
        __syncthreads();
        const int vcu = (int)st[4], g8 = C.G >> 3;
        C.bid = __builtin_amdgcn_readfirstlane((vcu % g8) * 8 + vcu / g8); C.gw = C.bid * NWAVES + C.wave;
    }

    layer_body<0>(p, C, bar, misc, lo, hi);
    layer_body<1>(p, C, bar, misc, lo, hi);
#undef IN
#undef SEAM
}

extern "C" void kernel_launch(void* const* d_in, const int* in_sizes, int n_in, void* d_out, int out_size, void* d_ws, size_t ws_size, hipStream_t stream) {
    static int grid = 0;
    if (grid == 0) {
        if (n_in != 34 || out_size != SEQ * DM || ws_size < WS_END) { fprintf(stderr, "kernel_launch: unexpected shapes: n_in %d out %d ws %zu (need %zu)\n", n_in, out_size, ws_size, (size_t)WS_END); grid = -1; return; }
        int dev = 0, cus = 0, per_cu = 0;
        if (hipGetDevice(&dev) != hipSuccess || hipDeviceGetAttribute(&cus, hipDeviceAttributeMultiprocessorCount, dev) != hipSuccess) { grid = -1; return; }
        if (hipFuncSetAttribute((const void*)mega_fwd, hipFuncAttributeMaxDynamicSharedMemorySize, LDS_BYTES) != hipSuccess) { fprintf(stderr, "kernel_launch: hipFuncSetAttribute failed\n"); grid = -1; return; }
        if (hipOccupancyMaxActiveBlocksPerMultiprocessor(&per_cu, (const void*)mega_fwd, NTHR, LDS_BYTES) != hipSuccess || per_cu < 1) { fprintf(stderr, "kernel_launch: occupancy query says %d blocks per CU\n", per_cu); grid = -1; return; }
        (void)hipGetLastError();
        grid = cus;
    }
    if (grid < 0) return;
    (void)hipMemsetAsync((char*)d_ws + WS_CTL, 0, CTL_BYTES, stream);
    KArgs p{};
    for (int i = 0; i < 34; ++i) p.in[i] = (const float*)d_in[i];
    p.out = (float*)d_out; p.ws = (unsigned char*)d_ws;
#if MK_PER_PHASE
    for (int ph = 0; ph < N_PHASES; ++ph) {
        if (ph == 2 + PH_PER_LAYER + 0 || ph == 2 + PH_PER_LAYER + 5 || ph == 2 + PH_PER_LAYER + 6) continue;
        p.ph_lo = ph; p.ph_hi = ph + 1;
        hipLaunchKernelGGL(mega_fwd, dim3(grid), dim3(NTHR), LDS_BYTES, stream, p);
    }
#else
    p.ph_lo = 0; p.ph_hi = N_PHASES;
    hipLaunchKernelGGL(mega_fwd, dim3(grid), dim3(NTHR), LDS_BYTES, stream, p);
#endif
    const hipError_t le = hipPeekAtLastError();
    if (le != hipSuccess) fprintf(stderr, "kernel_launch: launch failed: %s\n", hipGetErrorName(le));
}
```

```cpp
#define MK_PER_PHASE 0
#include <hip/hip_runtime.h>
#include <cstdio>
#include <cstdint>

#define GAS __attribute__((address_space(1)))
#define LAS __attribute__((address_space(3)))
typedef unsigned short bf16_t;
typedef short bf16x8 __attribute__((ext_vector_type(8)));
typedef short s16x4 __attribute__((ext_vector_type(4)));
typedef float f32x4 __attribute__((ext_vector_type(4)));
typedef float f32x2 __attribute__((ext_vector_type(2)));
typedef float f32x16 __attribute__((ext_vector_type(16)));
typedef unsigned u32x4 __attribute__((ext_vector_type(4)));
typedef unsigned u32x2 __attribute__((ext_vector_type(2)));

constexpr int DM = 2048, SEQ = 16384, CTXL = 256, TT = SEQ + CTXL;
constexpr int NEXP = 64, NEX1 = 65, EHID = 512, TOPK = 8;
constexpr int EV_IN = 5120, OD_IN = 4608;
constexpr float LN_EPS = 1e-6f;
constexpr float ALPHA = 1.4142135623730951f;
constexpr float LAMBDA_INIT = 0.35550906759f;
constexpr int NTHR = 512, NWAVES = 8;

constexpr size_t al256(size_t x) { return (x + 255) / 256 * 256; }
constexpr size_t WS_CTL   = 0;
constexpr size_t CTL_BYTES = 1u << 20;
constexpr size_t WS_MODP  = WS_CTL + CTL_BYTES;
constexpr size_t WS_MODF  = WS_MODP + al256((size_t)2 * 32 * 2 * 12288 * 4);
constexpr size_t WS_ROPE128 = WS_MODF + al256((size_t)2 * 2 * 12288 * 4);
constexpr size_t WS_ROPE64  = WS_ROPE128 + al256((size_t)256 * 64 * 2 * 4);
constexpr size_t WS_KN    = WS_ROPE64 + al256((size_t)256 * 32 * 2 * 4);
constexpr size_t WS_WT    = WS_KN + al256((size_t)2 * 64 * 16 * 1024 * 2);
constexpr size_t WS_APOW  = WS_WT + al256((size_t)2 * 64 * 128 * 1024 * 2);
constexpr size_t WS_AL    = WS_APOW + al256((size_t)2 * 64 * 64 * 128 * 4);
constexpr size_t WS_CC    = WS_AL + al256((size_t)2 * 64 * 128 * 4);
constexpr size_t WS_BBT   = WS_CC + al256((size_t)64 * 16 * 128 * 2);
constexpr size_t WS_S5E   = WS_BBT + al256((size_t)2 * 64 * 128 * 16 * 2);
constexpr size_t WS_HST   = WS_S5E + al256((size_t)2 * 64 * 260 * 128 * 4);
constexpr size_t WS_WIN0  = WS_HST + al256((size_t)2 * 64 * 260 * 128 * 4);
constexpr size_t WS_WOUT0 = WS_WIN0 + al256((size_t)EV_IN * DM * 2);
constexpr size_t WS_WGLU  = WS_WOUT0 + al256((size_t)DM * DM * 2);
constexpr size_t WS_WIN1  = WS_WGLU + al256((size_t)1024 * 1024 * 2);
constexpr size_t WS_WOUT1 = WS_WIN1 + al256((size_t)OD_IN * DM * 2);
constexpr size_t WS_RWT   = WS_WOUT1 + al256((size_t)DM * DM * 2);
constexpr size_t WS_GU    = WS_RWT + al256((size_t)2 * 2 * 64 * DM * 2);
constexpr size_t WS_DT    = WS_GU + al256((size_t)NEX1 * 1024 * DM * 2);
constexpr size_t WS_XA    = WS_DT + al256((size_t)NEX1 * DM * EHID * 2);
constexpr size_t WS_Z     = WS_XA + al256((size_t)TT * DM * 2);
constexpr size_t WS_YMIX  = WS_Z + al256((size_t)TT * 1024 * 2);
constexpr size_t WS_X1    = WS_YMIX + al256((size_t)TT * DM * 2);
constexpr size_t WS_HX2   = WS_X1 + al256((size_t)TT * DM * 4);
constexpr size_t WS_LIST  = WS_HX2 + al256((size_t)9 * TT * EHID * 2);
constexpr size_t WS_WGT   = WS_LIST + al256((size_t)NEX1 * TT * 4);
constexpr size_t WS_LW    = WS_WGT + al256((size_t)8 * TT * 4);
constexpr size_t WS_BIG   = WS_LW + al256((size_t)NEX1 * TT * 4);
constexpr size_t BG_QKV   = 0;
constexpr size_t BG_CKV   = BG_QKV + al256((size_t)TT * EV_IN * 2);
constexpr size_t BG_SPREV = BG_CKV + al256((size_t)8 * 130 * 65536 * 4);
constexpr size_t BG_MIX   = BG_SPREV + al256((size_t)8 * 130 * 65536 * 2);
constexpr size_t BG_END0  = BG_MIX + al256((size_t)TT * DM * 2);
constexpr size_t BG_ATT   = BG_CKV;
constexpr size_t BG_Q8    = BG_ATT + al256((size_t)SEQ * 3072 * 2);
constexpr size_t BG_K8    = BG_Q8 + al256((size_t)TT * 1024);
constexpr size_t BG_VT8   = BG_K8 + al256((size_t)TT * 256);
constexpr size_t BG_Q8D   = BG_VT8 + al256((size_t)2 * 260 * 128 * 64);
constexpr size_t BG_K8D   = BG_Q8D + al256((size_t)TT * 1024);
constexpr size_t BG_VT8D  = BG_K8D + al256((size_t)TT * 1024);
constexpr size_t BG_F8END = BG_VT8D + al256((size_t)8 * 260 * 128 * 64);
constexpr size_t BG_YMOE  = 0;
constexpr size_t BG_END1  = al256((size_t)9 * TT * DM * 2);
constexpr size_t BG_SIZE  = BG_END0 > BG_END1 ? BG_END0 : BG_END1;
static_assert(BG_F8END <= BG_SIZE, "fp8 attention operands inside the big region");
constexpr size_t WS_END   = WS_BIG + BG_SIZE;

constexpr int CW_BAR = 4096;
constexpr int CW_CNT = 16384;
constexpr int CW_QUEUE = 20480;
constexpr int CW_KMAX = 24576;

constexpr int RING_BYTES = 151552;
constexpr int MISC_OFF = RING_BYTES;
constexpr int LDS_BYTES = 159744;

typedef __bf16 bf16x2_t __attribute__((ext_vector_type(2)));
__device__ __forceinline__ unsigned cvt_pk_bf16(float lo, float hi) { const f32x2 v = {lo, hi}; return __builtin_bit_cast(unsigned, __builtin_convertvector(v, bf16x2_t)); }
__device__ __forceinline__ bf16_t f2bf(float f) { unsigned u = __builtin_bit_cast(unsigned, f); return (bf16_t)((u + 0x7fffu + ((u >> 16) & 1u)) >> 16); }
__device__ __forceinline__ float bf2f(bf16_t b) { return __builtin_bit_cast(float, ((unsigned)b) << 16); }
__device__ __forceinline__ float bflo(unsigned w) { return __builtin_bit_cast(float, w << 16); }
__device__ __forceinline__ float bfhi(unsigned w) { return __builtin_bit_cast(float, w & 0xffff0000u); }
__device__ __forceinline__ float wave_sum(float v) {
#pragma unroll
    for (int o = 1; o < 64; o <<= 1) v += __shfl_xor(v, o);
    return v;
}
__device__ __forceinline__ float fast_exp(float x) { return __builtin_amdgcn_exp2f(x * 1.4426950408889634f); }
__device__ __forceinline__ float sigmoidf_(float x) { return 1.0f / (1.0f + __expf(-x)); }
__device__ __forceinline__ float siluf_(float x) { return x / (1.0f + __expf(-x)); }
__device__ __forceinline__ float gelu_tanh(float x) {
    const float u = 0.7978845608028654f * (x + 0.044715f * x * x * x);
    const float e = __expf(2.0f * u);
    const float t = 1.0f - 2.0f / (e + 1.0f);
    return 0.5f * x * (1.0f + t);
}
#define LDS_WAIT() asm volatile("s_waitcnt lgkmcnt(0)" ::: "memory")
#define VM_WAIT() asm volatile("s_waitcnt vmcnt(0)" ::: "memory")

#define XB_TMO      128
#define XB_XCNT(j)  (256  + 64 * (j))
#define XB_XSUB(j)  (1280 + 64 * (j))
#define XB_XGEN(j)  (2304 + 64 * (j))
#define XB_TOP      3328
#define XB_TOPGEN   3392
#define XCD_BAR_WORDS 3456
#define XB_SPIN_CAP (1u << 22)

__device__ __forceinline__ unsigned xb_ld(unsigned* p)              { return __hip_atomic_load(p, __ATOMIC_RELAXED, __HIP_MEMORY_SCOPE_AGENT); }
__device__ __forceinline__ unsigned xb_add(unsigned* p, unsigned v) { return __hip_atomic_fetch_add(p, v, __ATOMIC_RELAXED, __HIP_MEMORY_SCOPE_AGENT); }
__device__ __forceinline__ unsigned xb_xcc_id() { return (unsigned)__builtin_amdgcn_s_getreg((3 << 11) | 20) & 0xFu; }
#define XB_SPIN(cond, bar) do { unsigned _sp = 0; while (cond) { __builtin_amdgcn_s_sleep(1); \
    if ((++_sp & 255u) == 0u) { if (xb_ld(&(bar)[XB_TMO])) break; if (_sp > XB_SPIN_CAP) { atomicAdd(&(bar)[XB_TMO], 1u); break; } } } } while (0)

struct XcdBarrier { unsigned* bar; unsigned x; volatile LAS unsigned* st; };

__device__ __forceinline__ XcdBarrier xcd_barrier_post(unsigned* bar, volatile LAS unsigned* st) {
    XcdBarrier b; b.bar = bar; b.x = xb_xcc_id(); b.st = st;
    if (threadIdx.x == 0) { st[2] = xb_add(&bar[XB_XCNT(b.x)], 1u); st[3] = b.x; }
    return b;
}
__device__ __forceinline__ void xcd_barrier_complete(unsigned* bar, unsigned x, unsigned& nloc, unsigned& nx) {
    const unsigned G = gridDim.x * gridDim.y * gridDim.z;
    unsigned sum, cnt, mine, sp = 0u;
    for (;;) {
        sum = 0u; cnt = 0u; mine = 0u;
#pragma unroll
        for (unsigned j = 0; j < 16; ++j) { const unsigned c = xb_ld(&bar[XB_XCNT(j)]); sum += c; cnt += (c > 0u) ? 1u : 0u; mine = (j == x) ? c : mine; }
        if (sum == G) break;
        __builtin_amdgcn_s_sleep(1);
        if ((++sp & 255u) == 0u) { if (xb_ld(&bar[XB_TMO])) break; if (sp > XB_SPIN_CAP) { atomicAdd(&bar[XB_TMO], 1u); break; } }
    }
    nloc = mine > 0u ? mine : 1u; nx = cnt > 0u ? cnt : 1u;
}
__device__ __forceinline__ void xcd_barrier(const XcdBarrier& b, int wave_id) {
    const bool leader_thread = (wave_id == 0) && (__builtin_amdgcn_mbcnt_hi(~0u, __builtin_amdgcn_mbcnt_lo(~0u, 0u)) == 0u);
    asm volatile("s_waitcnt vmcnt(0)" ::: "memory");
    __syncthreads();
    if (leader_thread) {
        unsigned* bar = b.bar;
        __builtin_amdgcn_s_waitcnt(0);
        unsigned nloc = b.st[0], nx = b.st[1];
        if (nloc == 0u) { xcd_barrier_complete(bar, b.x, nloc, nx); b.st[0] = nloc; b.st[1] = nx; }
        const unsigned old = xb_add(&bar[XB_XSUB(b.x)], 1u);
        const unsigned gen = old / nloc;
        if (old + 1u == (gen + 1u) * nloc) {
            __builtin_amdgcn_fence(__ATOMIC_RELEASE, "agent");
            asm volatile("s_waitcnt vmcnt(0)" ::: "memory");
            const unsigned og = xb_add(&bar[XB_TOP], 1u);
            const unsigned tg = og / nx;
            if (og + 1u == (tg + 1u) * nx) xb_add(&bar[XB_TOPGEN], 1u);
            else XB_SPIN(xb_ld(&bar[XB_TOPGEN]) == tg, bar);
            __builtin_amdgcn_fence(__ATOMIC_ACQUIRE, "agent");
            xb_add(&bar[XB_XGEN(b.x)], 1u);
            asm volatile("s_waitcnt vmcnt(0)" ::: "memory");
        } else {
            XB_SPIN(xb_ld(&bar[XB_XGEN(b.x)]) == gen, bar);
            __builtin_amdgcn_fence(__ATOMIC_ACQUIRE, "agent");
            asm volatile("s_waitcnt vmcnt(0)" ::: "memory");
        }
    }
    __syncthreads();
}

__device__ __forceinline__ bf16x8 frag_rowk_l(const LAS bf16_t* p, int ld, int lane) {
    return *(const LAS bf16x8*)(p + (lane & 15) * ld + (lane >> 4) * 8);
}
__device__ __forceinline__ bf16x8 frag_rowk_g(const bf16_t* p, long ld, int lane) {
    return *(const bf16x8*)(p + (long)(lane & 15) * ld + (lane >> 4) * 8);
}
__device__ __forceinline__ bf16x8 frag_colk_l(unsigned p, int ldb, int lane) {
    const unsigned a0 = p + (unsigned)((8 * (lane >> 4) + ((lane & 15) >> 2)) * ldb + (lane & 3) * 8);
    const unsigned a1 = a0 + 4u * (unsigned)ldb;
    s16x4 lo, hi;
    asm volatile("ds_read_b64_tr_b16 %0, %2\n\tds_read_b64_tr_b16 %1, %3\n\ts_waitcnt lgkmcnt(0)" : "=&v"(lo), "=&v"(hi) : "v"(a0), "v"(a1) : "memory");
    return (bf16x8){lo[0], lo[1], lo[2], lo[3], hi[0], hi[1], hi[2], hi[3]};
}
#define MFMA16(a, b, c) __builtin_amdgcn_mfma_f32_16x16x32_bf16((a), (b), (c), 0, 0, 0)
namespace pg8 {
constexpr int BM = 256, BK = 64, HALF = 128, HTB = HALF * BK * 2, STAGE_BYTES = 8 * HTB, NXCD = 8, WGM = 8;
__device__ __forceinline__ int lds_byte(int r, int c) { const int st = (r >> 4) * 2 + (c >> 5), rr = r & 15, cc = c & 31, ob = rr * 64 + cc * 2; return st * 1024 + (ob ^ (((ob >> 9) & 1) << 5)); }
__device__ __forceinline__ void stage_rc(int b, int& R, int& C) { const int st = b / 1024, sb = b % 1024, swz = sb ^ (((sb >> 9) & 1) << 5); R = (st >> 1) * 16 + swz / 64; C = (st & 1) * 32 + (swz % 64) / 2; }
__device__ __forceinline__ int perm32(int rho) { const int n = rho >> 4, i = rho & 15; return 8 * (i >> 2) + 4 * n + (i & 3); }

struct Unit { int pm, pn, e; };
constexpr float WSCALE = 32.0f, WSCALE_INV = 1.0f / 32.0f;

struct DenseOrder {
    const bf16_t* A; const bf16_t* Bt; int ldab, kb, nM, nN, nwg, G, c;
    __device__ __forceinline__ void init(const bf16_t* A_, int lda_, const bf16_t* Bt_, int M, int N, int K_, int G_, int c_) { A = A_; ldab = lda_ * 2; Bt = Bt_; kb = K_ * 2; nM = M / BM; nN = N / BM; nwg = nM * nN; G = G_; c = c_; }
    __device__ __forceinline__ void init8(const void* A_, int ldab_, const void* Bt_, int M, int N, int K_, int G_, int c_) { A = (const bf16_t*)A_; ldab = ldab_; Bt = (const bf16_t*)Bt_; kb = K_; nM = M / BM; nN = N / BM; nwg = nM * nN; G = G_; c = c_; }
    __device__ __forceinline__ void prep(LAS unsigned char*) const {}
    __device__ __forceinline__ int units_of_me() const { return c < nwg ? (nwg - c + G - 1) / G : 0; }
    __device__ __forceinline__ int max_units() const { return (nwg + G - 1) / G; }
    __device__ __forceinline__ bool next(int i, Unit& u) const {
        const long L = (long)i * G + c; if (L >= nwg) return false;
        int wgid = (int)L; { const int q = nwg / NXCD, r = nwg % NXCD, xcd = wgid % NXCD, off = wgid / NXCD; wgid = (xcd < r ? xcd * (q + 1) : r * (q + 1) + (xcd - r) * q) + off; }
        const int nig = WGM * nN, gid = wgid / nig, fm = gid * WGM, gsz = (nM - fm) < WGM ? (nM - fm) : WGM;
        u.pm = fm + ((wgid % nig) % gsz); u.pn = (wgid % nig) / gsz; u.e = 0; return true;
    }
    __device__ __forceinline__ const char* a_base() const { return (const char*)A; }
    __device__ __forceinline__ unsigned a_off(const Unit& u, int r) const { return (unsigned)(u.pm * BM + r) * (unsigned)ldab; }
    __device__ __forceinline__ const char* b_ptr(const Unit& u) const { return (const char*)Bt + (size_t)u.pn * BM * kb; }
};

template <int MODE  >
struct MoeOrder {
    const void* A; const void* Bt; const int* list; const int* cnt; int ldab, kb, nN, G, c; size_t bstride;
    LAS int* tp; LAS int* cn; LAS int* rb;
    __device__ __forceinline__ void prep(LAS unsigned char* misc, int tid) {
        tp = (LAS int*)(misc + 64); cn = tp + 72; rb = cn + 72;
        if (tid < NEX1) cn[tid] = cnt[tid];
        __syncthreads();
        if (tid == 0) { int s = 0, q = 0; for (int e = 0; e < NEX1; ++e) { tp[e] = s; rb[e] = q; s += (cn[e] + BM - 1) / BM; q += cn[e]; } tp[NEX1] = s; rb[NEX1] = q; }
        __syncthreads();
    }
    __device__ __forceinline__ bool next(int i, Unit& u) const {
        const int total = tp[NEX1]; const long nu = (long)total * nN; const int per = (int)((nu + G - 1) / G);
        (void)per;
        long L = (long)i * G + c;
        if ((G & 7) == 0) L = ((long)i * 8 + (c & 7)) * (G >> 3) + (c >> 3);
        if (L >= nu) return false;
        const int tile = (int)(L / nN); u.pn = (int)(L % nN);
        int e = 0;
        for (int k = 1; k < NEX1; ++k) e += (tp[k] <= tile) ? 1 : 0;
        u.e = e; u.pm = tile - tp[e]; return true;
    }
    __device__ __forceinline__ const char* a_base() const { return (const char*)A; }
    __device__ __forceinline__ unsigned a_off(const Unit& u, int r) const {
        int pos = u.pm * BM + r; const int n = cn[u.e]; pos = pos < n ? pos : n - 1;
        if (MODE == 1) return (unsigned)(rb[u.e] + pos) * (unsigned)ldab;
        const int a = list[u.e * TT + pos];
        const int row = a < 8 * TT ? (a >> 3) : a - 8 * TT;
        return (unsigned)row * (unsigned)ldab;
    }
    __device__ __forceinline__ const char* b_ptr(const Unit& u) const { return (const char*)Bt + (size_t)u.e * bstride + (size_t)u.pn * BM * kb; }
};

typedef int v8i32 __attribute__((ext_vector_type(8)));
typedef int v4i32_ __attribute__((ext_vector_type(4)));
__device__ __forceinline__ v8i32 cat8(bf16x8 a, bf16x8 b) { const u32x4 x = __builtin_bit_cast(u32x4, a), y = __builtin_bit_cast(u32x4, b); return (v8i32){(int)x.x, (int)x.y, (int)x.z, (int)x.w, (int)y.x, (int)y.y, (int)y.z, (int)y.w}; }
template <bool FP8, class Epi, class Sched>
__device__ __forceinline__ void gemm_phase(LAS unsigned char* lds, const Sched& S, const Epi& E, int wave_id) {
    const int wid = wave_id; int lane = (int)__builtin_amdgcn_mbcnt_hi(~0u, __builtin_amdgcn_mbcnt_lo(~0u, 0u)); asm volatile("" : "+v"(lane));
    const int tid = wid * 64 + lane, wr = wid >> 2, wc = wid & 3, fr = lane & 15, fq = lane >> 4;
    const int kb = S.kb; int nt = kb / 128; asm volatile("" : "+s"(nt));
    unsigned voffB[2];
#pragma unroll
    for (int i = 0; i < 2; ++i) { int R, C; stage_rc(tid * 16 + i * 8192, R, C); const int Rb = (R & ~31) + perm32(R & 31);
        voffB[i] = (unsigned)(Rb * kb) + (unsigned)C * 2u; }
#define PG8_AOFF(u, h, i) ({ int _tz = tid; asm volatile("" : "+v"(_tz)); int _R, _C; stage_rc(_tz * 16 + (i) * 8192, _R, _C); S.a_off((u), (h) * HALF + _R) + (unsigned)_C * 2u; })
    const size_t kstep = (size_t)(BK * 2);
    const size_t hstepB = (size_t)HALF * kb;
    const unsigned ldsw = (unsigned)wid * 1024u;
    const int aoff = lds_byte(wr * 64 + fr, fq * 8), boff = lds_byte(wc * 32 + fr, fq * 8);
#define PG8_SA(b, h) (((b) * 2 + (h)) * HTB)
#define PG8_SB(b, h) ((4 + (b) * 2 + (h)) * HTB)
#define PG8_STAGE(bufoff, gbase, v0, v1) do { \
        __builtin_amdgcn_global_load_lds((const unsigned*)((const char*)(gbase) + (v0)), (LAS unsigned*)(lds + (bufoff) + ldsw), 16, 0, 0); \
        __builtin_amdgcn_global_load_lds((const unsigned*)((const char*)(gbase) + (v1)), (LAS unsigned*)(lds + (bufoff) + ldsw + 8192), 16, 0, 0); } while (0)
#define PG8_VOFFB(i) ({ int _tz = tid; asm volatile("" : "+v"(_tz)); int _R, _C; stage_rc(_tz * 16 + (i) * 8192, _R, _C); (unsigned)(((_R & ~31) + perm32(_R & 31)) * kb) + (unsigned)_C * 2u; })
#define PG8_STAGE_B(bufoff, gbase) do { if constexpr (FP8) { int _tz = tid; asm volatile("" : "+v"(_tz)); const u32x2 _vv = *(const LAS u32x2*)(lds + STAGE_BYTES + 8192 + _tz * 8); PG8_STAGE(bufoff, gbase, _vv.x, _vv.y); } else PG8_STAGE(bufoff, gbase, voffB[0], voffB[1]); } while (0)
#define PG8_LD8(off) __builtin_shufflevector(*(const LAS v4i32_*)(lds + (off)), *(const LAS v4i32_*)(lds + (off) + 1024), 0, 1, 2, 3, 4, 5, 6, 7)
#define PG8_LDA(dst, b, h) do { _Pragma("unroll") for (int m = 0; m < 4; ++m) { if constexpr (FP8) dst##8[m] = PG8_LD8(PG8_SA(b, h) + aoff + m * 2048); else { _Pragma("unroll") for (int k = 0; k < 2; ++k) dst[m][k] = *(const LAS bf16x8*)(lds + PG8_SA(b, h) + aoff + m * 2048 + k * 1024); } } } while (0)
#define PG8_LDB(dst, b, h) do { _Pragma("unroll") for (int n = 0; n < 2; ++n) { if constexpr (FP8) dst##8[n] = PG8_LD8(PG8_SB(b, h) + boff + n * 2048); else { _Pragma("unroll") for (int k = 0; k < 2; ++k) dst[n][k] = *(const LAS bf16x8*)(lds + PG8_SB(b, h) + boff + n * 2048 + k * 1024); } } } while (0)
#define PG8_MMA(ai, bj, At, Bt) do { __builtin_amdgcn_s_setprio(1); _Pragma("unroll") for (int m = 0; m < 4; ++m) _Pragma("unroll") for (int n = 0; n < 2; ++n) { \
        if constexpr (FP8) asm volatile("v_mfma_f32_16x16x128_f8f6f4 %0, %1, %2, %0" : "+v"(acc[ai][bj][m][n]) : "v"(Bt##8[n]), "v"(At##8[m])); \
        else { _Pragma("unroll") for (int k = 0; k < 2; ++k) acc[ai][bj][m][n] = __builtin_amdgcn_mfma_f32_16x16x32_bf16(Bt[n][k], At[m][k], acc[ai][bj][m][n], 0, 0, 0); } } \
        __builtin_amdgcn_s_setprio(0); } while (0)
#define PG8_WAIT_V(n) asm volatile("s_waitcnt vmcnt(" #n ")" ::: "memory")
#define PG8_WAIT_L(n) asm volatile("s_waitcnt lgkmcnt(" #n ")" ::: "memory")
#define PG8_BAR __builtin_amdgcn_s_barrier()
#define PG8_SCHED __builtin_amdgcn_sched_barrier(0)
    if constexpr (FP8) { u32x2 _vb; _vb.x = PG8_VOFFB(0); _vb.y = PG8_VOFFB(1); *(LAS u32x2*)(lds + STAGE_BYTES + 8192 + tid * 8) = _vb; }
    Unit cur, nxt; int ui = 0;
    if (!S.next(0, cur)) return;
    f32x4 acc[2][2][4][2];
#pragma unroll
    for (int a = 0; a < 2; ++a)
#pragma unroll
        for (int b = 0; b < 2; ++b)
#pragma unroll
            for (int m = 0; m < 4; ++m)
#pragma unroll
                for (int n = 0; n < 2; ++n) acc[a][b][m][n] = (f32x4){0.f, 0.f, 0.f, 0.f};
    bf16x8 At[4][2], B0[2][2], B1[2][2]; v8i32 At8[4], B08[2], B18[2];
    const char* const gA = S.a_base();
    const char* cB = S.b_ptr(cur);
    unsigned oc00, oc01, oc10, oc11;
    oc00 = PG8_AOFF(cur, 0, 0); oc01 = PG8_AOFF(cur, 0, 1); oc10 = PG8_AOFF(cur, 1, 0); oc11 = PG8_AOFF(cur, 1, 1);
    PG8_STAGE_B(PG8_SB(0, 0), cB); PG8_STAGE_B(PG8_SB(0, 1), cB + hstepB); PG8_STAGE(PG8_SA(0, 0), gA, oc00, oc01); PG8_STAGE(PG8_SA(0, 1), gA, oc10, oc11);
    if (wr == 1) PG8_BAR;
    PG8_WAIT_V(2); PG8_BAR;
    PG8_STAGE_B(PG8_SB(1, 0), cB + kstep); PG8_STAGE(PG8_SA(1, 0), gA + kstep, oc00, oc01); PG8_STAGE_B(PG8_SB(1, 1), cB + hstepB + kstep);
    PG8_WAIT_V(6); PG8_BAR;
    for (;;) {
        const bool has_next = S.next(ui + 1, nxt);
        const char* nB = cB;
        {
            u32x4 on = {oc00, oc01, oc10, oc11};
            if (has_next) { on.x = PG8_AOFF(nxt, 0, 0); on.y = PG8_AOFF(nxt, 0, 1); on.z = PG8_AOFF(nxt, 1, 0); on.w = PG8_AOFF(nxt, 1, 1); nB = S.b_ptr(nxt); }
            *(LAS u32x4*)(lds + STAGE_BYTES + tid * 16) = on;
        }
        for (int t = 0; t < nt; t += 2) {
            const bool last = (t == nt - 2);
            const char* a1 = gA + (size_t)(t + 1) * kstep;
            const char* a2 = last ? gA : gA + (size_t)(t + 2) * kstep; const char* b2 = last ? nB : cB + (size_t)(t + 2) * kstep;
            const char* a3 = a2 + kstep; const char* b3 = b2 + kstep;
            unsigned s00 = oc00, s01 = oc01, s10 = oc10, s11 = oc11;
            if (last) { const u32x4 on = *(const LAS u32x4*)(lds + STAGE_BYTES + tid * 16); s00 = on.x; s01 = on.y; s10 = on.z; s11 = on.w; }
            PG8_LDB(B0, 0, 0); PG8_LDB(B1, 0, 1); PG8_SCHED; PG8_LDA(At, 0, 0); PG8_STAGE(PG8_SA(1, 1), a1, oc10, oc11);
            PG8_WAIT_V(8); PG8_WAIT_L(0); PG8_BAR; PG8_MMA(0, 0, At, B0); PG8_MMA(0, 1, At, B1); PG8_BAR; PG8_SCHED;
            PG8_LDA(At, 0, 1); PG8_STAGE_B(PG8_SB(0, 0), b2); PG8_STAGE_B(PG8_SB(0, 1), b2 + hstepB); PG8_STAGE(PG8_SA(0, 0), a2, s00, s01);
            PG8_WAIT_V(8); PG8_WAIT_L(0); PG8_BAR; PG8_MMA(1, 0, At, B0); PG8_MMA(1, 1, At, B1); PG8_BAR; PG8_SCHED;
            PG8_LDB(B0, 1, 0); PG8_LDB(B1, 1, 1); PG8_SCHED; PG8_LDA(At, 1, 0); PG8_STAGE(PG8_SA(0, 1), a2, s10, s11);
            PG8_WAIT_V(8); PG8_WAIT_L(0); PG8_BAR; PG8_MMA(0, 0, At, B0); PG8_MMA(0, 1, At, B1); PG8_BAR; PG8_SCHED;
            PG8_LDA(At, 1, 1); PG8_STAGE_B(PG8_SB(1, 0), b3); PG8_STAGE_B(PG8_SB(1, 1), b3 + hstepB); PG8_STAGE(PG8_SA(1, 0), a3, s00, s01);
            PG8_WAIT_V(8); PG8_WAIT_L(0); PG8_BAR; PG8_MMA(1, 0, At, B0); PG8_MMA(1, 1, At, B1); PG8_BAR; PG8_SCHED;
        }
        if (wr == 0) PG8_BAR;
        E(acc, cur, wr, wc, fr, fq);
        if (!has_next) break;
#pragma unroll
        for (int a = 0; a < 2; ++a)
#pragma unroll
            for (int b = 0; b < 2; ++b)
#pragma unroll
                for (int m = 0; m < 4; ++m)
#pragma unroll
                    for (int n = 0; n < 2; ++n) acc[a][b][m][n] = (f32x4){0.f, 0.f, 0.f, 0.f};
        { const u32x4 on = *(const LAS u32x4*)(lds + STAGE_BYTES + tid * 16); oc00 = on.x; oc01 = on.y; oc10 = on.z; oc11 = on.w; }
        cur = nxt; cB = nB; ++ui;
        if (wr == 1) PG8_BAR;
    }
    PG8_WAIT_V(0);
    PG8_BAR;
#undef PG8_SA
#undef PG8_SB
#undef PG8_STAGE
#undef PG8_STAGE_B
#undef PG8_AOFF
#undef PG8_VOFFB
#undef PG8_LD8
#undef PG8_LDA
#undef PG8_LDB
#undef PG8_MMA
#undef PG8_WAIT_V
#undef PG8_WAIT_L
#undef PG8_BAR
#undef PG8_SCHED
}

struct EpiStore {
    bf16_t* O; int ldc; float scale;
    __device__ __forceinline__ void operator()(const f32x4 (&acc)[2][2][4][2], const Unit& u, int wr, int wc, int fr, int fq) const {
        const int row0 = u.pm * BM + wr * 64 + fr, col0 = u.pn * BM + wc * 32 + 8 * fq;
#pragma unroll
        for (int ai = 0; ai < 2; ++ai)
#pragma unroll
            for (int m = 0; m < 4; ++m) { bf16_t* rowp = O + (size_t)(row0 + ai * HALF + m * 16) * ldc + col0;
#pragma unroll
                for (int bj = 0; bj < 2; ++bj) { const f32x4 v0 = acc[ai][bj][m][0] * scale, v1 = acc[ai][bj][m][1] * scale;
                    u32x4 w; w.x = cvt_pk_bf16(v0[0], v0[1]); w.y = cvt_pk_bf16(v0[2], v0[3]); w.z = cvt_pk_bf16(v1[0], v1[1]); w.w = cvt_pk_bf16(v1[2], v1[3]);
                    *(u32x4*)(rowp + bj * HALF) = w; } }
    }
};
struct EpiGlu {
    const bf16_t* Z; const float* b; bf16_t* MIX;
    __device__ __forceinline__ void operator()(const f32x4 (&acc)[2][2][4][2], const Unit& u, int wr, int wc, int fr, int fq) const {
        const int row0 = u.pm * BM + wr * 64 + fr, col0 = u.pn * BM + wc * 32 + 8 * fq;
#pragma unroll
        for (int bj = 0; bj < 2; ++bj) {
            const f32x4 b0 = *(const f32x4*)(b + col0 + bj * HALF), b1 = *(const f32x4*)(b + col0 + bj * HALF + 4);
#pragma unroll
            for (int ai = 0; ai < 2; ++ai)
#pragma unroll
                for (int m = 0; m < 4; ++m) { const size_t row = (size_t)(row0 + ai * HALF + m * 16);
                    const u32x4 zz = *(const u32x4*)(Z + row * 1024 + col0 + bj * HALF);
                    const f32x4 v0 = acc[ai][bj][m][0] + b0, v1 = acc[ai][bj][m][1] + b1;
                    u32x4 w;
                    w.x = cvt_pk_bf16(bflo(zz.x) * sigmoidf_(v0[0]), bfhi(zz.x) * sigmoidf_(v0[1]));
                    w.y = cvt_pk_bf16(bflo(zz.y) * sigmoidf_(v0[2]), bfhi(zz.y) * sigmoidf_(v0[3]));
                    w.z = cvt_pk_bf16(bflo(zz.z) * sigmoidf_(v1[0]), bfhi(zz.z) * sigmoidf_(v1[1]));
                    w.w = cvt_pk_bf16(bflo(zz.w) * sigmoidf_(v1[2]), bfhi(zz.w) * sigmoidf_(v1[3]));
                    *(u32x4*)(MIX + row * DM + 1024 + col0 + bj * HALF) = w; }
        }
    }
};
struct EpiE1 {
    unsigned char* H; const LAS int* cn; const LAS int* rb;
    __device__ __forceinline__ void operator()(const f32x4 (&acc)[2][2][4][2], const Unit& u, int wr, int wc, int fr, int fq) const {
        const int n = cn[u.e]; const int colh = u.pn * 128 + wc * 32 + 8 * fq;
#pragma unroll
        for (int ai = 0; ai < 2; ++ai)
#pragma unroll
            for (int m = 0; m < 4; ++m) { const int pos = u.pm * BM + ai * HALF + wr * 64 + m * 16 + fr;
                if (pos < n) { const int a = rb[u.e] + pos;
                    float sc = WSCALE_INV; asm volatile("" : "+v"(sc));
                    const f32x4 g0 = acc[ai][0][m][0] * sc, g1 = acc[ai][0][m][1] * sc, u0 = acc[ai][1][m][0] * sc, u1 = acc[ai][1][m][1] * sc;
                    u32x2 w;
                    w.x = (unsigned)__builtin_amdgcn_cvt_pk_fp8_f32(siluf_(g0[0]) * u0[0], siluf_(g0[1]) * u0[1], 0, false);
                    w.x = (unsigned)__builtin_amdgcn_cvt_pk_fp8_f32(siluf_(g0[2]) * u0[2], siluf_(g0[3]) * u0[3], (int)w.x, true);
                    w.y = (unsigned)__builtin_amdgcn_cvt_pk_fp8_f32(siluf_(g1[0]) * u1[0], siluf_(g1[1]) * u1[1], 0, false);
                    w.y = (unsigned)__builtin_amdgcn_cvt_pk_fp8_f32(siluf_(g1[2]) * u1[2], siluf_(g1[3]) * u1[3], (int)w.y, true);
                    *(u32x2*)(H + (size_t)a * EHID + colh) = w; }
                __builtin_amdgcn_sched_barrier(0); }
    }
};
struct EpiE2 {
    unsigned char* Y; const float* wgt; const LAS int* cn; const LAS int* rb;
    __device__ __forceinline__ void operator()(const f32x4 (&acc)[2][2][4][2], const Unit& u, int wr, int wc, int fr, int fq) const {
        const int n = cn[u.e]; const int col0 = u.pn * BM + wc * 32 + 8 * fq;
#pragma unroll
        for (int ai = 0; ai < 2; ++ai)
#pragma unroll
            for (int m = 0; m < 4; ++m) { const int pos = u.pm * BM + ai * HALF + wr * 64 + m * 16 + fr;
                if (pos < n) { const int a = rb[u.e] + pos; float ws = WSCALE_INV * 0.25f; asm volatile("" : "+v"(ws));
                    unsigned char* rowp = Y + (size_t)a * DM + col0;
#pragma unroll
                    for (int bj = 0; bj < 2; ++bj) { const f32x4 v0 = acc[ai][bj][m][0] * ws, v1 = acc[ai][bj][m][1] * ws;
                        u32x2 w;
                        w.x = (unsigned)__builtin_amdgcn_cvt_pk_fp8_f32(v0[0], v0[1], 0, false); w.x = (unsigned)__builtin_amdgcn_cvt_pk_fp8_f32(v0[2], v0[3], (int)w.x, true);
                        w.y = (unsigned)__builtin_amdgcn_cvt_pk_fp8_f32(v1[0], v1[1], 0, false); w.y = (unsigned)__builtin_amdgcn_cvt_pk_fp8_f32(v1[2], v1[3], (int)w.y, true);
                        *(u32x2*)(rowp + bj * HALF) = w; } }
                __builtin_amdgcn_sched_barrier(0); }
    }
};
}
struct KArgs {
    const float* in[34];
    float* out;
    unsigned char* ws;
    int ph_lo, ph_hi;
};
struct Params {
    float* out;
    unsigned char* ws;
    LAS unsigned long long* ptab;
    int ph_lo, ph_hi;
    __device__ __forceinline__ const float* inp(int k) const {
        const unsigned long long v = ptab[k];
        const unsigned lo = __builtin_amdgcn_readfirstlane((unsigned)v), hi = __builtin_amdgcn_readfirstlane((unsigned)(v >> 32));
        return (const float*)(((unsigned long long)hi << 32) | lo);
    }
};
struct Ctx {
    LAS unsigned char* lds;
    int tid, lane, wave, G, bid;
    int gw, ngw;
};

__device__ __forceinline__ void tr_item(const float* W, int N, bf16_t* WT, int ldt, int k0, int n0, int orow0, LAS float* scr, int lane) {
#pragma unroll 8
    for (int i = 0; i < 32; ++i) { const int kk = 2 * i + (lane >> 5); scr[kk * 33 + (lane & 31)] = W[(size_t)(k0 + kk) * N + n0 + (lane & 31)]; }
    LDS_WAIT(); asm volatile("" ::: "memory");
    const int c = lane & 7;
#pragma unroll
    for (int j = 0; j < 4; ++j) { const int n = (lane >> 3) + 8 * j; const LAS float* s = scr + (8 * c) * 33 + n;
        u32x4 o; o.x = cvt_pk_bf16(s[0 * 33], s[1 * 33]); o.y = cvt_pk_bf16(s[2 * 33], s[3 * 33]); o.z = cvt_pk_bf16(s[4 * 33], s[5 * 33]); o.w = cvt_pk_bf16(s[6 * 33], s[7 * 33]);
        *(u32x4*)(WT + (size_t)(orow0 + n) * ldt + k0 + 8 * c) = o; }
    LDS_WAIT(); asm volatile("" ::: "memory");
}
__device__ __forceinline__ void tr_item64(const float* W, int N, bf16_t* WT, int ldt, int k0, int n0, int orow0, LAS float* scr, int lane) {
    f32x4 v[16];
    const float* src = W + (size_t)(k0 + (lane >> 4)) * N + n0 + 4 * (lane & 15);
#pragma unroll
    for (int i = 0; i < 16; ++i) v[i] = __builtin_nontemporal_load((const f32x4*)(src + (size_t)(4 * i) * N));
#pragma unroll
    for (int i = 0; i < 16; ++i) { LAS float* d = scr + (4 * i + (lane >> 4)) * 65 + 4 * (lane & 15); d[0] = v[i][0]; d[1] = v[i][1]; d[2] = v[i][2]; d[3] = v[i][3]; }
    LDS_WAIT(); asm volatile("" ::: "memory");
    const int c = lane & 7;
#pragma unroll
    for (int j = 0; j < 8; ++j) { const int n = (lane >> 3) + 8 * j; const LAS float* s = scr + (8 * c) * 65 + n;
        u32x4 o; o.x = cvt_pk_bf16(s[0 * 65], s[1 * 65]); o.y = cvt_pk_bf16(s[2 * 65], s[3 * 65]); o.z = cvt_pk_bf16(s[4 * 65], s[5 * 65]); o.w = cvt_pk_bf16(s[6 * 65], s[7 * 65]);
        *(u32x4*)(WT + (size_t)(orow0 + n) * ldt + k0 + 8 * c) = o; }
    LDS_WAIT(); asm volatile("" ::: "memory");
}
__device__ __forceinline__ void tr_item64_fp8(const float* W, int N, unsigned char* WT, int ldt, int k0, int n0, int orow0, LAS float* scr, int lane, float wscale = pg8::WSCALE) {
    f32x4 v[16];
    const float* src = W + (size_t)(k0 + (lane >> 4)) * N + n0 + 4 * (lane & 15);
#pragma unroll
    for (int i = 0; i < 16; ++i) v[i] = __builtin_nontemporal_load((const f32x4*)(src + (size_t)(4 * i) * N));
#pragma unroll
    for (int i = 0; i < 16; ++i) { LAS float* d = scr + (4 * i + (lane >> 4)) * 65 + 4 * (lane & 15); d[0] = v[i][0]; d[1] = v[i][1]; d[2] = v[i][2]; d[3] = v[i][3]; }
    LDS_WAIT(); asm volatile("" ::: "memory");
    const int c = lane & 3;
#pragma unroll
    for (int j = 0; j < 4; ++j) { const int n = (lane >> 2) + 16 * j; const LAS float* s = scr + (16 * c) * 65 + n;
        u32x4 o;
        o.x = (unsigned)__builtin_amdgcn_cvt_pk_fp8_f32(s[0 * 65] * wscale, s[1 * 65] * wscale, 0, false);   o.x = (unsigned)__builtin_amdgcn_cvt_pk_fp8_f32(s[2 * 65] * wscale, s[3 * 65] * wscale, (int)o.x, true);
        o.y = (unsigned)__builtin_amdgcn_cvt_pk_fp8_f32(s[4 * 65] * wscale, s[5 * 65] * wscale, 0, false);   o.y = (unsigned)__builtin_amdgcn_cvt_pk_fp8_f32(s[6 * 65] * wscale, s[7 * 65] * wscale, (int)o.y, true);
        o.z = (unsigned)__builtin_amdgcn_cvt_pk_fp8_f32(s[8 * 65] * wscale, s[9 * 65] * wscale, 0, false);   o.z = (unsigned)__builtin_amdgcn_cvt_pk_fp8_f32(s[10 * 65] * wscale, s[11 * 65] * wscale, (int)o.z, true);
        o.w = (unsigned)__builtin_amdgcn_cvt_pk_fp8_f32(s[12 * 65] * wscale, s[13 * 65] * wscale, 0, false); o.w = (unsigned)__builtin_amdgcn_cvt_pk_fp8_f32(s[14 * 65] * wscale, s[15 * 65] * wscale, (int)o.w, true);
        *(u32x4*)(WT + (size_t)(orow0 + n) * ldt + k0 + 16 * c) = o; }
    LDS_WAIT(); asm volatile("" ::: "memory");
}
__device__ __forceinline__ void tr_dense(const float* W, int K, int N, bf16_t* WT, int item, LAS float* scr, int lane) {
    const int nblk = N / 32, kb = item / nblk, nb = item % nblk;
    tr_item(W, N, WT, K, 64 * kb, 32 * nb, 32 * nb, scr, lane);
}

__device__ __forceinline__ void s5_tables(const Params& p, Ctx& C, int dir, int g) {
    LAS f32x2* PW = (LAS f32x2*)C.lds;
    LAS f32x2* BB = PW + 65 * 64;
    LAS f32x2* CX = BB + 64 * 16;
    const float* a_re = p.inp(11); const float* a_im = p.inp(12); const float* log_dt = p.inp(13);
    const float* b_re = p.inp(14); const float* b_im = p.inp(15); const float* c_re = p.inp(16); const float* c_im = p.inp(17);
    const int tid = C.tid;
    if (tid < 64) {
        const int pp = tid;
        const float dt = __expf(log_dt[dir * 64 + g]);
        const float are = a_re[(dir * 64 + g) * 64 + pp], aim = a_im[(dir * 64 + g) * 64 + pp];
        const float zr = are * dt, zi = aim * dt;
        const float mag = __expf(zr);
        double rev = (double)zi * 0.15915494309189535; rev -= floor(rev);
        const float cs = __builtin_amdgcn_cosf((float)rev), sn = __builtin_amdgcn_sinf((float)rev);
        const float abr = mag * cs, abi = mag * sn;
        const float den = are * are + aim * aim, nr = abr - 1.0f, ni = abi;
        const float fre = (nr * are + ni * aim) / den, fim = (ni * are - nr * aim) / den;
        float pr = 1.0f, pi = 0.0f;
#pragma unroll 1
        for (int n = 0; n <= 64; ++n) { PW[n * 64 + pp] = (f32x2){pr, pi}; const float t = pr * abr - pi * abi; pi = pr * abi + pi * abr; pr = t; }
        for (int j = 0; j < 16; ++j) { const float br = b_re[(g * 64 + pp) * 16 + j], bi = b_im[(g * 64 + pp) * 16 + j];
            BB[pp * 16 + j] = (f32x2){fre * br - fim * bi, fre * bi + fim * br}; }
    }
    for (int q = tid; q < 1024; q += NTHR) { const int i = q >> 6, pp = q & 63; CX[i * 64 + pp] = (f32x2){c_re[(g * 16 + i) * 64 + pp], c_im[(g * 16 + i) * 64 + pp]}; }
    __syncthreads();
    bf16_t* KN = (bf16_t*)(p.ws + WS_KN) + (size_t)(dir * 64 + g) * 16 * 1024;
    float* APOW = (float*)(p.ws + WS_APOW) + (size_t)(dir * 64 + g) * 64 * 128;
    float* AL = (float*)(p.ws + WS_AL) + (size_t)(dir * 64 + g) * 128;
#pragma unroll 1
    for (int q = 0; q < 32; ++q) { const int idx = tid + NTHR * q; const int n = idx >> 8, i = (idx >> 4) & 15, j = idx & 15;
        float s = 0.f;
#pragma unroll 4
        for (int pp = 0; pp < 64; ++pp) { const f32x2 c = CX[i * 64 + pp], w = PW[n * 64 + pp], b = BB[pp * 16 + j];
            const float gr = c.x * b.x - c.y * b.y, gi = c.x * b.y + c.y * b.x;
            s += gr * w.x - gi * w.y; }
        KN[(size_t)i * 1024 + n * 16 + j] = f2bf(s); }
    for (int q = tid; q < 4096; q += NTHR) { const int t = q >> 6, pp = q & 63; const f32x2 w = PW[(t + 1) * 64 + pp]; *(f32x2*)(APOW + (size_t)t * 128 + 2 * pp) = w; }
    if (tid < 64) { const f32x2 w = PW[64 * 64 + tid]; *(f32x2*)(AL + 2 * tid) = w; }
    { bf16_t* BBT = (bf16_t*)(p.ws + WS_BBT) + (size_t)(dir * 64 + g) * 128 * 16;
      for (int q = tid; q < 2048; q += NTHR) { const int pq = q >> 4, j = q & 15; const f32x2 b = BB[(pq & 63) * 16 + j]; BBT[q] = f2bf(pq < 64 ? b.x : b.y); } }
    if (dir == 0) { bf16_t* CCt = (bf16_t*)(p.ws + WS_CC) + (size_t)g * 16 * 128;
        for (int q = tid; q < 2048; q += NTHR) { const int i = q >> 7, pq = q & 127; const f32x2 c = CX[i * 64 + (pq & 63)]; CCt[i * 128 + pq] = f2bf(pq < 64 ? c.x : -c.y); } }
    __syncthreads();
}

__device__ __forceinline__ void phase_p0(const Params& p, Ctx& C) {
    for (int task = C.bid; task < 128; task += C.G) s5_tables(p, C, task >> 6, task & 63);
    {
        const int gt = C.bid * NTHR + C.tid, ngt = C.G * NTHR;
        float* R128 = (float*)(p.ws + WS_ROPE128); float* R64 = (float*)(p.ws + WS_ROPE64);
        for (int q = gt; q < 256 * 64 + 256 * 32; q += ngt) {
            int pos, i, half; float* dst;
            if (q < 256 * 64) { pos = q >> 6; i = q & 63; half = 64; dst = R128 + (size_t)q * 2; }
            else { const int r = q - 256 * 64; pos = r >> 5; i = r & 31; half = 32; dst = R64 + (size_t)r * 2; }
            const float freq = exp2f(-(float)i / (float)half * 13.287712379549449f);
            const float ang = (float)pos * freq;
            double rev = (double)ang * 0.15915494309189535; rev -= floor(rev);
            dst[0] = __builtin_amdgcn_cosf((float)rev); dst[1] = __builtin_amdgcn_sinf((float)rev);
        }
        bf16_t* RWT = (bf16_t*)(p.ws + WS_RWT); const float* rw = p.inp(26);
        for (int q = gt; q < 2 * 64 * DM; q += ngt) { const int L = q / (64 * DM), r = q % (64 * DM), e = r / DM, k = r % DM;
            const float w = rw[((size_t)L * DM + k) * 64 + e]; const bf16_t hi = f2bf(w); const bf16_t lo = f2bf(w - bf2f(hi));
            RWT[((size_t)(L * 2 + 0) * 64 + e) * DM + k] = hi; RWT[((size_t)(L * 2 + 1) * 64 + e) * DM + k] = lo; }
    }
    {
        const float* cvec = p.inp(1); const float* cctx = p.inp(3); const float* mw = p.inp(4);
        float* MODP = (float*)(p.ws + WS_MODP);
        for (int task = C.gw; task < 2 * 32 * 48; task += C.ngw) {
            const int L = task / (32 * 48), r = task % (32 * 48), kb = r / 48, cb = r % 48;
            const float sc = siluf_(cvec[64 * kb + C.lane]), sx = siluf_(cctx[64 * kb + C.lane]);
            f32x4 a0 = {0.f, 0.f, 0.f, 0.f}, a1 = {0.f, 0.f, 0.f, 0.f};
            const float* wp = mw + ((size_t)L * DM + 64 * kb) * 12288 + 256 * cb + 4 * C.lane;
#pragma unroll 8
            for (int kk = 0; kk < 64; ++kk) { const f32x4 w = *(const f32x4*)(wp + (size_t)kk * 12288);
                const float s0 = __shfl(sc, kk), s1 = __shfl(sx, kk);
                a0 += w * s0; a1 += w * s1; }
            *(f32x4*)(MODP + ((size_t)((L * 32 + kb) * 2 + 0)) * 12288 + 256 * cb + 4 * C.lane) = a0;
            *(f32x4*)(MODP + ((size_t)((L * 32 + kb) * 2 + 1)) * 12288 + 256 * cb + 4 * C.lane) = a1;
        }
    }
    {
        LAS float* scr = (LAS float*)(C.lds + C.wave * 17408);
        constexpr int J0 = (DM / 64) * (EV_IN / 64), J3 = (DM / 64) * (OD_IN / 64);
        for (int it = C.gw; it < J0 + J3; it += C.ngw) {
            const bool l1 = it >= J0; const int r = l1 ? it - J0 : it; const int N = l1 ? OD_IN : EV_IN; const int nblk = N / 64, kb = r / nblk, nb = r % nblk;
            tr_item64_fp8(p.inp(l1 ? 21 : 8), N, (unsigned char*)(p.ws + (l1 ? WS_WIN1 : WS_WIN0)), DM, 64 * kb, 64 * nb, 64 * nb, scr, C.lane, 32.0f);
        }
        LAS float* scr2 = (LAS float*)(C.lds + C.wave * 17408);
        constexpr int I1 = (DM / 64) * (DM / 32), I2 = (1024 / 64) * (1024 / 32), I4 = I1;
        for (int it = C.gw; it < I1 + I2 + I4; it += C.ngw) {
            int r = it;
            if (r < I1) { tr_dense(p.inp(9), DM, DM, (bf16_t*)(p.ws + WS_WOUT0), r, scr2, C.lane); continue; } r -= I1;
            if (r < I2) { tr_dense(p.inp(19), 1024, 1024, (bf16_t*)(p.ws + WS_WGLU), r, scr2, C.lane); continue; } r -= I2;
            tr_dense(p.inp(22), DM, DM, (bf16_t*)(p.ws + WS_WOUT1), r, scr2, C.lane);
        }
    }
}
__device__ __forceinline__ void phase_p1(const Params& p, Ctx& C) {
    const float* MODP = (const float*)(p.ws + WS_MODP); float* MODF = (float*)(p.ws + WS_MODF); const float* mb = p.inp(5);
    for (int q = C.bid * NTHR + C.tid; q < 2 * 2 * 12288; q += C.G * NTHR) { const int L = q / (2 * 12288), v = (q / 12288) & 1, col = q % 12288;
        float s = mb[L * 12288 + col];
        for (int kb = 0; kb < 32; ++kb) s += MODP[((size_t)((L * 32 + kb) * 2 + v)) * 12288 + col];
        MODF[q] = s; }
}
__device__ __forceinline__ const float* modv(const Params& p, int L, int v, int k) { return (const float*)(p.ws + WS_MODF) + (size_t)(L * 2 + v) * 12288 + k * DM; }

__device__ __forceinline__ void stage_vec(LAS float* dst, const float* src, int tid) { *(LAS f32x4*)(dst + 4 * tid) = *(const f32x4*)(src + 4 * tid); }
__device__ __forceinline__ void conv_item(const Params& p, Ctx& C, int L, int it) {
    LAS float* scr = (LAS float*)(C.lds + C.wave * 17408);
    unsigned char* GU = (unsigned char*)(p.ws + WS_GU) + (size_t)L * NEX1 * 1024 * DM; unsigned char* DT = (unsigned char*)(p.ws + WS_DT) + (size_t)L * NEX1 * DM * EHID;
    const int e = it / 768, r = it % 768, which = r >> 8, q = r & 255;
    if (which < 2) {
        const float* W = (e < 64) ? p.inp(28 + which) + ((size_t)(L * 64 + e)) * DM * EHID : p.inp(31 + which) + (size_t)L * DM * EHID;
        const int kb = q >> 3, nb = q & 7, n0 = 64 * nb;
        tr_item64_fp8(W, EHID, GU + (size_t)e * 1024 * DM, DM, 64 * kb, n0, 256 * (n0 >> 7) + (n0 & 127) + (which ? 128 : 0), scr, C.lane);
    } else {
        const float* W = (e < 64) ? p.inp(30) + ((size_t)(L * 64 + e)) * EHID * DM : p.inp(33) + (size_t)L * EHID * DM;
        const int kb = q >> 5, nb = q & 31;
        tr_item64_fp8(W, DM, DT + (size_t)e * DM * EHID, EHID, 64 * kb, 64 * nb, 64 * nb, scr, C.lane);
    }
}
__device__ __forceinline__ void conv_queue(const Params& p, Ctx& C, int quota) {
    unsigned* head = (unsigned*)(p.ws + WS_CTL) + CW_QUEUE + 128;
    const int batch = quota < 8 ? quota : 8;
    for (int done = 0; done < quota; done += batch) {
        int it0 = 0; if (C.lane == 0) it0 = (int)atomicAdd(head, (unsigned)batch);
        it0 = __builtin_amdgcn_readfirstlane(it0);
        if (it0 >= NEX1 * 768) break;
        for (int k = 0; k < batch && it0 + k < NEX1 * 768; ++k) conv_item(p, C, 1, it0 + k);
    }
}
__device__ __forceinline__ void phase_modulate(const Params& p, Ctx& C, int L) {
    unsigned char* XA8 = (unsigned char*)(p.ws + WS_XA);
    const float* X2 = (const float*)(p.ws + WS_HX2);
    LAS float* MV = (LAS float*)C.lds;
    for (int v = 0; v < 2; ++v) { stage_vec(MV + (v * 2 + 0) * DM, modv(p, L, v, 0), C.tid); stage_vec(MV + (v * 2 + 1) * DM, modv(p, L, v, 1), C.tid); }
    __syncthreads();
    for (int r = C.gw; r < TT; r += C.ngw) {
        const int v = r < CTXL ? 1 : 0;
        const float* src = (L == 0) ? (r < CTXL ? p.inp(2) + (size_t)r * DM : p.inp(0) + (size_t)(r - CTXL) * DM) : X2 + (size_t)r * DM;
        const LAS float* sh = MV + (v * 2 + 0) * DM; const LAS float* sc = MV + (v * 2 + 1) * DM;
#pragma unroll
        for (int j = 0; j < 8; ++j) { const int c = 4 * (C.lane + 64 * j);
            const f32x4 x = *(const f32x4*)(src + c), a = *(const LAS f32x4*)(sc + c), b = *(const LAS f32x4*)(sh + c);
            const f32x4 y = x * (a + 1.0f) + b;
            unsigned w = (unsigned)__builtin_amdgcn_cvt_pk_fp8_f32(y[0], y[1], 0, false); w = (unsigned)__builtin_amdgcn_cvt_pk_fp8_f32(y[2], y[3], (int)w, true);
            *(unsigned*)(XA8 + (size_t)r * DM + c) = w; }
    }
    __syncthreads();
    if (L == 0) { for (int it = C.gw; it < NEX1 * 768; it += C.ngw) conv_item(p, C, 0, it); }
    else conv_queue(p, C, 1 << 30);
}

__device__ __forceinline__ void phase_rope0(const Params& p, Ctx& C) {
    bf16_t* QKV = (bf16_t*)(p.ws + WS_BIG + BG_QKV);
    const f32x2* R128 = (const f32x2*)(p.ws + WS_ROPE128);
    for (int r = C.gw; r < TT; r += C.ngw) {
        bf16_t* row = QKV + (size_t)r * EV_IN;
        if (r < CTXL) {
#pragma unroll
            for (int j = 0; j < 2; ++j) { u32x4* q = (u32x4*)(row + 8 * (C.lane + 64 * j)); u32x4 w = *q;
                w.x = cvt_pk_bf16(bflo(w.x) * 0.0625f, bfhi(w.x) * 0.0625f); w.y = cvt_pk_bf16(bflo(w.y) * 0.0625f, bfhi(w.y) * 0.0625f);
                w.z = cvt_pk_bf16(bflo(w.z) * 0.0625f, bfhi(w.z) * 0.0625f); w.w = cvt_pk_bf16(bflo(w.w) * 0.0625f, bfhi(w.w) * 0.0625f); *q = w; }
        } else {
            const int l = r - CTXL, rp = l >> 6, cp = l & 63;
#pragma unroll
            for (int qk = 0; qk < 2; ++qk)
#pragma unroll
                for (int m = 0; m < 8; ++m) { const int pi = C.lane + 64 * m, head = pi >> 7, blk = (pi >> 6) & 1, i = pi & 63;
                    bf16_t* b = row + qk * 1024 + head * 256 + blk * 128 + i;
                    const f32x2 cs = R128[(blk ? cp : rp) * 64 + i];
                    const float x1 = bf2f(b[0]), x2 = bf2f(b[64]); const float sc = qk ? 1.0f : 0.0625f;
                    b[0] = f2bf((x1 * cs.x - x2 * cs.y) * sc); b[64] = f2bf((x1 * cs.y + x2 * cs.x) * sc); }
        }
    }
}

__device__ __forceinline__ void phase_normrope1(const Params& p, Ctx& C) {
    bf16_t* QKV = (bf16_t*)(p.ws + WS_BIG + BG_QKV);
    const f32x2* R64 = (const f32x2*)(p.ws + WS_ROPE64);
    const float* qg = p.inp(23);
    unsigned* KMAX = (unsigned*)(p.ws + WS_CTL) + CW_KMAX;
    unsigned char* Q8 = (unsigned char*)(p.ws + WS_BIG + BG_Q8); unsigned char* K8 = (unsigned char*)(p.ws + WS_BIG + BG_K8); unsigned char* VT8 = (unsigned char*)(p.ws + WS_BIG + BG_VT8);
    unsigned char* Q8D = (unsigned char*)(p.ws + WS_BIG + BG_Q8D); unsigned char* K8D = (unsigned char*)(p.ws + WS_BIG + BG_K8D); unsigned char* VT8D = (unsigned char*)(p.ws + WS_BIG + BG_VT8D);
    const int lane = C.lane, i32 = lane & 31; const bool up = lane >= 32;
    const float g00 = qg[lane], g01 = qg[64 + lane], g10 = qg[128 + lane], g11 = qg[128 + 64 + lane];
    for (int r = C.gw; r < TT; r += C.ngw) {
        bf16_t* row = QKV + (size_t)r * OD_IN;
        const bool lat = r >= CTXL; const int l = r - CTXL, rp = lat ? (l >> 6) : 0, cp = lat ? (l & 63) : 0;
        const f32x2 cr = R64[rp * 32 + i32], cc = R64[cp * 32 + i32];
#pragma unroll 2
        for (int h = 0; h < 26; ++h) {
            const int col = h < 8 ? 128 * h : (h < 10 ? 1024 + 128 * (h - 8) : (h < 18 ? 1536 + 128 * (h - 10) : 2560 + 128 * (h - 18)));
            bf16_t* b = row + col;
            float v0 = bf2f(b[lane]), v1 = bf2f(b[64 + lane]);
            if (h < 10) { const float ss = wave_sum(v0 * v0 + v1 * v1); const float rs = rsqrtf(ss * (1.0f / 128.0f) + LN_EPS);
                v0 = bf2f(f2bf(v0 * rs)) * (h < 8 ? g00 : g10); v1 = bf2f(f2bf(v1 * rs)) * (h < 8 ? g01 : g11); }
            if (lat) { const float p0 = __shfl_xor(v0, 32), p1 = __shfl_xor(v1, 32);
                v0 = up ? (p0 * cr.y + v0 * cr.x) : (v0 * cr.x - p0 * cr.y);
                v1 = up ? (p1 * cc.y + v1 * cc.x) : (v1 * cc.x - p1 * cc.y); }
            const bf16_t o0 = f2bf(v0), o1 = f2bf(v1);
            b[lane] = o0; b[64 + lane] = o1;
            {
                const float qs = (h < 8 || (h >= 10 && h < 18)) ? 0.088388347648318440f * 1.4426950408889634f : 1.0f;
                const float w0 = bf2f(o0) * qs, w1 = bf2f(o1) * qs;
                float e4[4];
#pragma unroll
                for (int j = 0; j < 4; ++j) { const float a = __shfl(w0, (4 * lane + j) & 63), c2 = __shfl(w1, (4 * lane + j) & 63); e4[j] = lane < 16 ? a : c2; }
                unsigned pk = (unsigned)__builtin_amdgcn_cvt_pk_fp8_f32(e4[0], e4[1], 0, false); pk = (unsigned)__builtin_amdgcn_cvt_pk_fp8_f32(e4[2], e4[3], (int)pk, true);
                unsigned char* dst8 = h < 8 ? Q8 + (size_t)r * 1024 + 128 * h : (h < 10 ? K8 + (size_t)r * 256 + 128 * (h - 8) : (h < 18 ? Q8D + (size_t)r * 1024 + 128 * (h - 10) : K8D + (size_t)r * 1024 + 128 * (h - 18)));
                if (lane < 32) *(unsigned*)(dst8 + 4 * lane) = pk; }
            if ((h >= 8 && h < 10) || h >= 18) {
                const float w0 = bf2f(o0), w1 = bf2f(o1); const float k2 = wave_sum(w0 * w0 + w1 * w1);
                if (lane == 0) atomicMax(KMAX + 64 * (h < 10 ? h - 8 : h - 16), __float_as_uint(k2)); }
        }
    }
    LAS bf16_t* vt = (LAS bf16_t*)(C.lds + C.wave * 17408);
    for (int item = C.gw; item < 10 * 260; item += C.ngw) {
        const int kh = item / 260, T = item % 260;
        const int vcol = kh < 2 ? 1280 + 128 * kh : 3584 + 128 * (kh - 2);
        unsigned char* vout = kh < 2 ? VT8 + (size_t)kh * 260 * 8192 : VT8D + (size_t)(kh - 2) * 260 * 8192;
#pragma unroll
        for (int q = 0; q < 16; ++q) { const int idx = lane + 64 * q, key = idx >> 4, c = idx & 15;
            *(LAS u32x4*)(vt + key * 136 + 8 * c) = *(const u32x4*)(QKV + (size_t)(64 * T + key) * OD_IN + vcol + 8 * c); }
        LDS_WAIT(); asm volatile("" ::: "memory");
#pragma unroll
        for (int dd = 0; dd < 2; ++dd) { const int d = lane + 64 * dd;
            unsigned char* dst = vout + ((size_t)T * 128 + d) * 64;
#pragma unroll
            for (int cch = 0; cch < 4; ++cch) { u32x4 w;
#pragma unroll
                for (int wd = 0; wd < 4; ++wd) { float f[4];
#pragma unroll
                    for (int e = 0; e < 4; ++e) { const int bb = 16 * cch + 4 * wd + e, hi2 = bb >> 5, blk = (bb >> 4) & 1, j = bb & 15; const int key = 32 * blk + (j & 3) + 8 * (j >> 2) + 4 * hi2;
                        f[e] = bf2f(vt[key * 136 + d]); }
                    unsigned pk = (unsigned)__builtin_amdgcn_cvt_pk_fp8_f32(f[0], f[1], 0, false); pk = (unsigned)__builtin_amdgcn_cvt_pk_fp8_f32(f[2], f[3], (int)pk, true);
                    w[wd] = pk; }
                *(u32x4*)(dst + 16 * cch) = w; } }
        LDS_WAIT(); asm volatile("" ::: "memory");
    }
}

__device__ __forceinline__ void phase_merge1(const Params& p, Ctx& C) {
    bf16_t* ATT = (bf16_t*)(p.ws + WS_BIG + BG_ATT);
    const float* dl = p.inp(24); const float* sg = p.inp(25);
    const int lane = C.lane;
    float d0 = dl[lane] * dl[128 + lane] + dl[64 + lane] * dl[128 + 64 + lane];
    float d1 = dl[256 + lane] * dl[384 + lane] + dl[256 + 64 + lane] * dl[384 + 64 + lane];
    const float lam = __expf(wave_sum(d0)) - __expf(wave_sum(d1)) + LAMBDA_INIT;
    const f32x4 gg = *(const f32x4*)(sg + 4 * lane);
    for (int l = C.gw; l < SEQ; l += C.ngw) {
        bf16_t* row = ATT + (size_t)l * 3072;
#pragma unroll
        for (int h = 0; h < 4; ++h) {
            const u32x2 a = *(const u32x2*)(row + 1024 + 256 * h + 4 * lane), b = *(const u32x2*)(row + 2048 + 256 * h + 4 * lane);
            f32x4 o = {bflo(a.x) - lam * bflo(b.x), bfhi(a.x) - lam * bfhi(b.x), bflo(a.y) - lam * bflo(b.y), bfhi(a.y) - lam * bfhi(b.y)};
            const float ss = wave_sum(o[0] * o[0] + o[1] * o[1] + o[2] * o[2] + o[3] * o[3]);
            const float rs = rsqrtf(ss * (1.0f / 256.0f) + LN_EPS) * (1.0f - LAMBDA_INIT);
            o = o * rs * gg;
            u32x2 w; w.x = cvt_pk_bf16(o[0], o[1]); w.y = cvt_pk_bf16(o[2], o[3]);
            *(u32x2*)(row + 1024 + 256 * h + 4 * lane) = w;
        }
    }
}

__device__ __forceinline__ void phase_ln1(const Params& p, Ctx& C, int L) {
    const bf16_t* Y = (const bf16_t*)(p.ws + WS_YMIX); float* X1 = (float*)(p.ws + WS_X1); unsigned char* XA8 = (unsigned char*)(p.ws + WS_XA);
    const float* X2 = (const float*)(p.ws + WS_HX2);
    const float* lg = p.inp(6) + (size_t)(L * 2 + 0) * DM; const float* lb = p.inp(7) + (size_t)(L * 2 + 0) * DM;
    const int r0 = (L == 0) ? 0 : CTXL;
    LAS float* MV = (LAS float*)C.lds; LAS float* LG = MV + 6 * DM; LAS float* LB = LG + DM;
    for (int v = 0; v < 2; ++v) for (int k = 0; k < 3; ++k) stage_vec(MV + (v * 3 + k) * DM, modv(p, L, v, 2 + k), C.tid);
    stage_vec(LG, lg, C.tid); stage_vec(LB, lb, C.tid);
    __syncthreads();
    for (int r = r0 + C.gw; r < TT; r += C.ngw) {
        const int v = r < CTXL ? 1 : 0;
        const float* src = (L == 0) ? (r < CTXL ? p.inp(2) + (size_t)r * DM : p.inp(0) + (size_t)(r - CTXL) * DM) : X2 + (size_t)r * DM;
        const LAS float* g1 = MV + (v * 3 + 0) * DM; const LAS float* sh2 = MV + (v * 3 + 1) * DM; const LAS float* sc2 = MV + (v * 3 + 2) * DM;
        f32x4 t[8]; float s = 0.f;
#pragma unroll
        for (int j = 0; j < 8; ++j) { const int c = 4 * (C.lane + 64 * j);
            const f32x4 x = *(const f32x4*)(src + c), g = *(const LAS f32x4*)(g1 + c); const u32x2 yy = *(const u32x2*)(Y + (size_t)r * DM + c);
            const f32x4 y = {bflo(yy.x), bfhi(yy.x), bflo(yy.y), bfhi(yy.y)};
            t[j] = x * ALPHA + g * y; s += (t[j][0] + t[j][1]) + (t[j][2] + t[j][3]); }
        const float mean = wave_sum(s) * (1.0f / DM); float s2 = 0.f;
#pragma unroll
        for (int j = 0; j < 8; ++j) { t[j] = t[j] - mean; s2 += (t[j][0] * t[j][0] + t[j][1] * t[j][1]) + (t[j][2] * t[j][2] + t[j][3] * t[j][3]); }
        const float rstd = rsqrtf(wave_sum(s2) * (1.0f / DM) + LN_EPS);
#pragma unroll
        for (int j = 0; j < 8; ++j) { const int c = 4 * (C.lane + 64 * j);
            const f32x4 x1 = t[j] * rstd * *(const LAS f32x4*)(LG + c) + *(const LAS f32x4*)(LB + c);
            *(f32x4*)(X1 + (size_t)r * DM + c) = x1;
            const f32x4 z = x1 * (*(const LAS f32x4*)(sc2 + c) + 1.0f) + *(const LAS f32x4*)(sh2 + c);
            unsigned w = (unsigned)__builtin_amdgcn_cvt_pk_fp8_f32(z[0], z[1], 0, false); w = (unsigned)__builtin_amdgcn_cvt_pk_fp8_f32(z[2], z[3], (int)w, true);
            *(unsigned*)(XA8 + (size_t)r * DM + c) = w; }
    }
    __syncthreads();
}

__device__ __forceinline__ void phase_combine(const Params& p, Ctx& C, int L, LAS unsigned char* misc) {
    const unsigned char* YM = (const unsigned char*)(p.ws + WS_BIG + BG_YMOE); const float* X1 = (const float*)(p.ws + WS_X1);
    float* X2 = (float*)(p.ws + WS_HX2);
    const float* lg = p.inp(6) + (size_t)(L * 2 + 1) * DM; const float* lb = p.inp(7) + (size_t)(L * 2 + 1) * DM;
    const unsigned* PK = (const unsigned*)(p.ws + WS_WGT); const int* cnt = (const int*)(p.ws + WS_CTL) + CW_CNT + L * 128; const float* LWT = (const float*)(p.ws + WS_LW);
    const int r0 = (L == 0) ? 0 : CTXL;
    LAS int* rb = (LAS int*)(misc + 64);
    LAS float* MV = (LAS float*)C.lds; LAS float* LG = MV + 2 * DM; LAS float* LB = LG + DM;
    __syncthreads();
    if (C.tid == 0) { int q = 0; for (int e = 0; e < NEX1; ++e) { rb[e] = q; q += cnt[e]; } }
    stage_vec(MV, modv(p, L, 0, 5), C.tid); stage_vec(MV + DM, modv(p, L, 1, 5), C.tid); stage_vec(LG, lg, C.tid); stage_vec(LB, lb, C.tid);
    LAS float* M1 = LB + DM;
    unsigned char* XA8 = (unsigned char*)(p.ws + WS_XA);
    if (L == 0) { for (int v = 0; v < 2; ++v) { stage_vec(M1 + (v * 2 + 0) * DM, modv(p, 1, v, 0), C.tid); stage_vec(M1 + (v * 2 + 1) * DM, modv(p, 1, v, 1), C.tid); } }
    __syncthreads();
    for (int r = r0 + C.gw; r < TT; r += C.ngw) {
        const int v = r < CTXL ? 1 : 0;
        const LAS float* g2 = MV + v * DM;
        int ln = C.lane; asm volatile("" : "+v"(ln));
        int slot = rb[64] + (r - r0);
        float wk = 4.0f;
        if (ln < 8) { const unsigned pk = PK[(size_t)r * 8 + ln]; wk = LWT[(size_t)r * 8 + ln]; slot = rb[pk >> 16] + (int)(pk & 0xffffu); }
        f32x4 t[2][4]; float s = 0.f;
#pragma unroll
        for (int j = 0; j < 2; ++j) { const int c = 16 * (ln + 64 * j);
            u32x4 yy[9];
#pragma unroll
            for (int k = 0; k < 9; ++k) { const size_t a = (size_t)__builtin_amdgcn_readlane(slot, k); yy[k] = __builtin_nontemporal_load((const u32x4*)(YM + a * DM + c)); }
            f32x2 f[8];
#pragma unroll
            for (int q = 0; q < 8; ++q) f[q] = (f32x2){0.f, 0.f};
#pragma unroll
            for (int k = 0; k < 9; ++k) { const float wq = __int_as_float(__builtin_amdgcn_readlane(__float_as_int(wk), k));
                f[0] += wq * __builtin_amdgcn_cvt_pk_f32_fp8((int)yy[k].x, false); f[1] += wq * __builtin_amdgcn_cvt_pk_f32_fp8((int)yy[k].x, true);
                f[2] += wq * __builtin_amdgcn_cvt_pk_f32_fp8((int)yy[k].y, false); f[3] += wq * __builtin_amdgcn_cvt_pk_f32_fp8((int)yy[k].y, true);
                f[4] += wq * __builtin_amdgcn_cvt_pk_f32_fp8((int)yy[k].z, false); f[5] += wq * __builtin_amdgcn_cvt_pk_f32_fp8((int)yy[k].z, true);
                f[6] += wq * __builtin_amdgcn_cvt_pk_f32_fp8((int)yy[k].w, false); f[7] += wq * __builtin_amdgcn_cvt_pk_f32_fp8((int)yy[k].w, true); }
#pragma unroll
            for (int q = 0; q < 4; ++q) { const f32x4 x = *(const f32x4*)(X1 + (size_t)r * DM + c + 4 * q), g = *(const LAS f32x4*)(g2 + c + 4 * q);
                const f32x4 ff = {f[2 * q][0], f[2 * q][1], f[2 * q + 1][0], f[2 * q + 1][1]};
                t[j][q] = x * ALPHA + g * ff; s += (t[j][q][0] + t[j][q][1]) + (t[j][q][2] + t[j][q][3]); } }
        const float mean = wave_sum(s) * (1.0f / DM); float s2 = 0.f;
#pragma unroll
        for (int j = 0; j < 2; ++j)
#pragma unroll
            for (int q = 0; q < 4; ++q) { t[j][q] = t[j][q] - mean; s2 += (t[j][q][0] * t[j][q][0] + t[j][q][1] * t[j][q][1]) + (t[j][q][2] * t[j][q][2] + t[j][q][3] * t[j][q][3]); }
        const float rstd = rsqrtf(wave_sum(s2) * (1.0f / DM) + LN_EPS);
        float* dst = (L == 0) ? X2 + (size_t)r * DM : p.out + (size_t)(r - CTXL) * DM;
#pragma unroll
        for (int j = 0; j < 2; ++j)
#pragma unroll
            for (int q = 0; q < 4; ++q) { const int c = 16 * (ln + 64 * j) + 4 * q;
                const f32x4 xn = t[j][q] * rstd * *(const LAS f32x4*)(LG + c) + *(const LAS f32x4*)(LB + c);
                *(f32x4*)(dst + c) = xn;
                if (L == 0) { const f32x4 y = xn * (*(const LAS f32x4*)(M1 + (v * 2 + 1) * DM + c) + 1.0f) + *(const LAS f32x4*)(M1 + (v * 2 + 0) * DM + c);
                    unsigned w = (unsigned)__builtin_amdgcn_cvt_pk_fp8_f32(y[0], y[1], 0, false); w = (unsigned)__builtin_amdgcn_cvt_pk_fp8_f32(y[2], y[3], (int)w, true);
                    *(unsigned*)(XA8 + (size_t)r * DM + c) = w; } }
    }
    if (L == 0) { __syncthreads(); conv_queue(p, C, 1 << 30); }
}
constexpr int RLD = 264;
constexpr int SLD = 136;

template <bool SCALE>
__device__ __forceinline__ void stage_chunk(const bf16_t* QKV, int row0, int col0, LAS bf16_t* dst, int tid, float lg  , int dirb) {
#pragma unroll
    for (int q = 0; q < 8; ++q) { const int idx = tid + NTHR * q, r = idx >> 5, c = idx & 31;
        u32x4 w = *(const u32x4*)(QKV + (size_t)(row0 + r) * EV_IN + col0 + 8 * c);
        if (SCALE) { const float sc = fast_exp((dirb ? (float)r : (float)(127 - r)) * lg);
            w.x = cvt_pk_bf16(bflo(w.x) * sc, bfhi(w.x) * sc); w.y = cvt_pk_bf16(bflo(w.y) * sc, bfhi(w.y) * sc);
            w.z = cvt_pk_bf16(bflo(w.z) * sc, bfhi(w.z) * sc); w.w = cvt_pk_bf16(bflo(w.w) * sc, bfhi(w.w) * sc); }
        *(LAS u32x4*)(dst + r * RLD + 8 * c) = w; }
}

__device__ __forceinline__ void ret_chunk_kv(const Params& p, Ctx& C) {
    const bf16_t* QKV = (const bf16_t*)(p.ws + WS_BIG + BG_QKV); bf16_t* CKV = (bf16_t*)(p.ws + WS_BIG + BG_CKV);
    const float* rld = p.inp(10);
    LAS bf16_t* Vs = (LAS bf16_t*)C.lds; LAS bf16_t* Ks = Vs + 128 * RLD;
    const int lane = C.lane, w = C.wave;
    for (int unit = C.bid; unit < 130 * 8; unit += C.G) {
        const int u = unit >> 3, h = (unit >> 1) & 3, dir = unit & 1;
        const float lg = rld[dir * 4 + h];
        __syncthreads();
        stage_chunk<false>(QKV, 128 * u, 2048 + 256 * h, Vs, C.tid, 0.f, 0);
        stage_chunk<true>(QKV, 128 * u, 1024 + 256 * h, Ks, C.tid, lg, dir);
        __syncthreads();
        f32x4 acc[2][16];
#pragma unroll
        for (int a = 0; a < 2; ++a)
#pragma unroll
            for (int b = 0; b < 16; ++b) acc[a][b] = (f32x4){0.f, 0.f, 0.f, 0.f};
        const unsigned vbase = (unsigned)(uintptr_t)Vs, kbase = (unsigned)(uintptr_t)Ks;
#pragma unroll 1
        for (int ks = 0; ks < 4; ++ks) {
            bf16x8 af[2];
#pragma unroll
            for (int a = 0; a < 2; ++a) af[a] = frag_colk_l(vbase + (unsigned)((32 * ks) * RLD + 32 * w + 16 * a) * 2u, RLD * 2, lane);
#pragma unroll
            for (int b = 0; b < 16; ++b) { const bf16x8 bf = frag_colk_l(kbase + (unsigned)((32 * ks) * RLD + 16 * b) * 2u, RLD * 2, lane);
                acc[0][b] = MFMA16(bf, af[0], acc[0][b]); acc[1][b] = MFMA16(bf, af[1], acc[1][b]); }
        }
        bf16_t* dst = CKV + ((size_t)((dir * 4 + h) * 130 + u)) * 65536;
#pragma unroll
        for (int a = 0; a < 2; ++a)
#pragma unroll
            for (int b = 0; b < 16; ++b) { u32x2 w2; w2.x = cvt_pk_bf16(acc[a][b][0], acc[a][b][1]); w2.y = cvt_pk_bf16(acc[a][b][2], acc[a][b][3]);
                *(u32x2*)(dst + (size_t)(32 * w + 16 * a + (lane & 15)) * 256 + 16 * b + 4 * (lane >> 4)) = w2; }
    }
    __syncthreads();
}

__device__ __forceinline__ int s5_row(int dir, int c, int s) { return dir == 0 ? 64 * c + s : (c < 4 ? 255 - (64 * c + s) : 16639 - 64 * (c - 4) - s); }

__device__ __forceinline__ void s5_end_states(const Params& p, Ctx& C) {
    const bf16_t* QKV = (const bf16_t*)(p.ws + WS_BIG + BG_QKV); const bf16_t* BBT = (const bf16_t*)(p.ws + WS_BBT); float* E = (float*)(p.ws + WS_S5E);
    const float* APOW = (const float*)(p.ws + WS_APOW);
    LAS f32x2* PL = (LAS f32x2*)C.lds;
    for (int bt = C.bid; bt < 256; bt += C.G) {
        int tid = C.tid; asm volatile("" : "+v"(tid));
        const int lane = tid & 63, r32 = lane & 31, hi = lane >> 5;
        const int dg = bt >> 1, dir = dg >> 6, g = dg & 63, c0 = 130 * (bt & 1);
        __syncthreads();
#pragma unroll
        for (int q = 0; q < 8; ++q) { const int idx = tid + NTHR * q, s = idx >> 6, pp = idx & 63;
            PL[idx] = (s == 63) ? (f32x2){1.0f, 0.0f} : *(const f32x2*)(APOW + ((size_t)dg * 64 + (62 - s)) * 128 + 2 * pp); }
        __syncthreads();
        bf16x8 bfr[4];
#pragma unroll
        for (int pt = 0; pt < 4; ++pt) bfr[pt] = *(const bf16x8*)(BBT + ((size_t)dg * 128 + 32 * pt + r32) * 16 + 8 * hi);
        for (int c = c0 + C.wave; c < c0 + 130; c += 8) {
            float er[2] = {0.f, 0.f}, ei[2] = {0.f, 0.f};
#pragma unroll
            for (int st = 0; st < 2; ++st) {
                const bf16x8 a = *(const bf16x8*)(QKV + (size_t)s5_row(dir, c, 32 * st + r32) * EV_IN + 4096 + 16 * g + 8 * hi);
                f32x16 d[4];
#pragma unroll
                for (int pt = 0; pt < 4; ++pt) d[pt] = __builtin_amdgcn_mfma_f32_32x32x16_bf16(a, bfr[pt], (f32x16){}, 0, 0, 0);
#pragma unroll
                for (int r = 0; r < 16; ++r) { const int s = 32 * st + (r & 3) + 8 * (r >> 2) + 4 * hi;
#pragma unroll
                    for (int pt = 0; pt < 2; ++pt) { const f32x2 pw = PL[s * 64 + 32 * pt + r32]; const float br = d[pt][r], bi = d[pt + 2][r];
                        er[pt] += pw.x * br - pw.y * bi; ei[pt] += pw.x * bi + pw.y * br; } }
            }
#pragma unroll
            for (int pt = 0; pt < 2; ++pt) {
                { auto rr = __builtin_amdgcn_permlane32_swap(__float_as_uint(er[pt]), __float_as_uint(er[pt]), false, false); er[pt] = __uint_as_float(rr[0]) + __uint_as_float(rr[1]); }
                { auto rr = __builtin_amdgcn_permlane32_swap(__float_as_uint(ei[pt]), __float_as_uint(ei[pt]), false, false); ei[pt] = __uint_as_float(rr[0]) + __uint_as_float(rr[1]); }
            }
            float* dst = E + ((size_t)dg * 260 + c) * 128;
            if (hi == 0) { dst[r32] = er[0]; dst[32 + r32] = er[1]; dst[64 + r32] = ei[0]; dst[96 + r32] = ei[1]; }
        }
    }
    __syncthreads();
}

__device__ __forceinline__ void phase_scans(const Params& p, Ctx& C) {
    const bf16_t* CKV = (const bf16_t*)(p.ws + WS_BIG + BG_CKV); bf16_t* SP = (bf16_t*)(p.ws + WS_BIG + BG_SPREV);
    const float* rld = p.inp(10);
    for (int q = C.bid * NTHR + C.tid; q < 8 * 16384; q += C.G * NTHR) {
        const int dh = q >> 14, el = (q & 16383) * 4, dir = dh >> 2, h = dh & 3;
        const float gch = fast_exp(128.0f * rld[dir * 4 + h]);
        const bf16_t* src = CKV + (size_t)dh * 130 * 65536 + el; bf16_t* dst = SP + (size_t)dh * 130 * 65536 + el;
        f32x4 s = {0.f, 0.f, 0.f, 0.f};
        for (int st0 = 0; st0 < 130; st0 += 13) {
            u32x2 kv[13];
#pragma unroll
            for (int k = 0; k < 13; ++k) { const int st = st0 + k; const int u = dir == 0 ? st : (st == 0 ? 1 : (st == 1 ? 0 : 131 - st)); kv[k] = __builtin_nontemporal_load((const u32x2*)(src + (size_t)u * 65536)); }
#pragma unroll
            for (int k = 0; k < 13; ++k) { const int st = st0 + k; const int u = dir == 0 ? st : (st == 0 ? 1 : (st == 1 ? 0 : 131 - st));
                u32x2 w; w.x = cvt_pk_bf16(s[0], s[1]); w.y = cvt_pk_bf16(s[2], s[3]); *(u32x2*)(dst + (size_t)u * 65536) = w;
                s = s * gch + (f32x4){bflo(kv[k].x), bfhi(kv[k].x), bflo(kv[k].y), bfhi(kv[k].y)}; }
        }
    }
    const float* E = (const float*)(p.ws + WS_S5E); float* HST = (float*)(p.ws + WS_HST); const float* AL = (const float*)(p.ws + WS_AL);
    for (int q = C.bid * NTHR + C.tid; q < 2 * 64 * 64; q += C.G * NTHR) {
        const int dg = q >> 6, pp = q & 63;
        const f32x2 al = *(const f32x2*)(AL + (size_t)dg * 128 + 2 * pp);
        const float* e = E + (size_t)dg * 260 * 128; float* hs = HST + (size_t)dg * 260 * 128;
        float hr = 0.f, hi = 0.f;
        for (int c0 = 0; c0 < 260; c0 += 26) {
            float er[26], ei[26];
#pragma unroll
            for (int k = 0; k < 26; ++k) { er[k] = e[(size_t)(c0 + k) * 128 + pp]; ei[k] = e[(size_t)(c0 + k) * 128 + 64 + pp]; }
#pragma unroll
            for (int k = 0; k < 26; ++k) { *(f32x2*)(hs + (size_t)(c0 + k) * 128 + 2 * pp) = (f32x2){hr, hi};
                const float t = al.x * hr - al.y * hi + er[k]; hi = al.x * hi + al.y * hr + ei[k]; hr = t; }
        }
    }
}

__device__ __forceinline__ void ret_output_unit(const Params& p, Ctx& C, int unit) {
    const bf16_t* QKV = (const bf16_t*)(p.ws + WS_BIG + BG_QKV); const bf16_t* SP = (const bf16_t*)(p.ws + WS_BIG + BG_SPREV);
    bf16_t* MIX = (bf16_t*)(p.ws + WS_BIG + BG_MIX);
    const float* rld = p.inp(10);
    LAS bf16_t* RA = (LAS bf16_t*)C.lds; LAS bf16_t* RB = RA + 128 * RLD;
    int tid = C.tid; asm volatile("" : "+v"(tid));
    const int lane = tid & 63, w = C.wave, kq = lane >> 4, fr = lane & 15;
    const int u = unit >> 2, h = unit & 3;
    const float lgf = rld[h], lgb = rld[4 + h];
    stage_chunk<false>(QKV, 128 * u, 256 * h, RA, tid, 0.f, 0);
    int ib = 16 * w + 4 * kq, jb = fr; asm volatile("" : "+v"(ib), "+v"(jb));
    f32x4 acc[16];
#pragma unroll
    for (int t = 0; t < 16; ++t) acc[t] = (f32x4){0.f, 0.f, 0.f, 0.f};
#pragma unroll
    for (int dir = 0; dir < 2; ++dir) {
        const bf16_t* Sd = SP + ((size_t)((dir * 4 + h) * 130 + u)) * 65536;
#pragma unroll
        for (int eh = 0; eh < 2; ++eh) {
            __syncthreads();
#pragma unroll
            for (int q = 0; q < 8; ++q) { const int idx = tid + NTHR * q, rr = idx >> 5, c = idx & 31;
                *(LAS u32x4*)(RB + rr * RLD + 8 * c) = *(const u32x4*)(Sd + (size_t)(128 * eh + rr) * 256 + 8 * c);
                if (q == 3) asm volatile("" ::: "memory"); }
            __syncthreads();
#pragma unroll 1
            for (int ks = 0; ks < 8; ++ks) { const bf16x8 af = frag_rowk_l(RA + (16 * w) * RLD + 32 * ks, RLD, lane);
#pragma unroll
                for (int t = 0; t < 8; ++t) { const bf16x8 bf = frag_rowk_l(RB + (16 * t) * RLD + 32 * ks, RLD, lane); acc[8 * eh + t] = MFMA16(af, bf, acc[8 * eh + t]); } }
        }
#pragma unroll
        for (int r = 0; r < 4; ++r) { const int i = ib + r; const float qd = fast_exp((float)(128 - i) * lgb);
            const float f = (dir == 0) ? fast_exp((float)(i + 1) * lgf) / qd : qd;
#pragma unroll
            for (int t = 0; t < 16; ++t) acc[t][r] *= f; }
    }
    __syncthreads();
    stage_chunk<false>(QKV, 128 * u, 1024 + 256 * h, RB, tid, 0.f, 0);
    __syncthreads();
    f32x4 sc[8];
#pragma unroll
    for (int t = 0; t < 8; ++t) sc[t] = (f32x4){0.f, 0.f, 0.f, 0.f};
#pragma unroll 1
    for (int ks = 0; ks < 8; ++ks) { const bf16x8 af = frag_rowk_l(RA + (16 * w) * RLD + 32 * ks, RLD, lane);
#pragma unroll
        for (int t = 0; t < 8; ++t) { const bf16x8 bf = frag_rowk_l(RB + (16 * t) * RLD + 32 * ks, RLD, lane); sc[t] = MFMA16(af, bf, sc[t]); } }
#pragma unroll
    for (int t = 0; t < 8; ++t)
#pragma unroll
        for (int r = 0; r < 4; ++r) { const int i = ib + r, j = 16 * t + jb; const float d = (float)(i - j);
            const float m = (i >= j ? fast_exp(d * lgf) : 0.f) + (j >= i ? fast_exp(-d * lgb) : 0.f); sc[t][r] *= m; }
    __syncthreads();
    stage_chunk<false>(QKV, 128 * u, 2048 + 256 * h, RA, tid, 0.f, 0);
#pragma unroll
    for (int t = 0; t < 8; ++t)
#pragma unroll
        for (int r = 0; r < 4; ++r) RB[(16 * w + 4 * kq + r) * SLD + 16 * t + fr] = f2bf(sc[t][r]);
    __syncthreads();
    const unsigned vbase = (unsigned)(uintptr_t)RA;
#pragma unroll 1
    for (int ks = 0; ks < 4; ++ks) { const bf16x8 af = frag_rowk_l(RB + (16 * w) * SLD + 32 * ks, SLD, lane);
#pragma unroll
        for (int t = 0; t < 16; ++t) { const bf16x8 bf = frag_colk_l(vbase + (unsigned)((32 * ks) * RLD + 16 * t) * 2u, RLD * 2, lane); acc[t] = MFMA16(af, bf, acc[t]); } }
    __syncthreads();
#pragma unroll
    for (int r = 0; r < 4; ++r) {
        float s = 0.f;
#pragma unroll
        for (int t = 0; t < 16; ++t) s += acc[t][r];
        s += __shfl_xor(s, 1); s += __shfl_xor(s, 2); s += __shfl_xor(s, 4); s += __shfl_xor(s, 8);
        const float mean = s * (1.0f / 256.0f); float q = 0.f;
#pragma unroll
        for (int t = 0; t < 16; ++t) { const float d = acc[t][r] - mean; q += d * d; }
        q += __shfl_xor(q, 1); q += __shfl_xor(q, 2); q += __shfl_xor(q, 4); q += __shfl_xor(q, 8);
        const float rstd = rsqrtf(q * (1.0f / 256.0f) + LN_EPS);
#pragma unroll
        for (int t = 0; t < 16; ++t) RA[(16 * w + 4 * kq + r) * RLD + 16 * t + fr] = f2bf((acc[t][r] - mean) * rstd);
    }
    __syncthreads();
#pragma unroll
    for (int q = 0; q < 8; ++q) { const int idx = tid + NTHR * q, rr = idx >> 5, c = idx & 31; const size_t row = (size_t)(128 * u + rr);
        const u32x4 o = *(const LAS u32x4*)(RA + rr * RLD + 8 * c), g = *(const u32x4*)(QKV + row * EV_IN + 3072 + 256 * h + 8 * c);
        u32x4 w4;
        w4.x = cvt_pk_bf16(bflo(o.x) * siluf_(bflo(g.x)), bfhi(o.x) * siluf_(bfhi(g.x))); w4.y = cvt_pk_bf16(bflo(o.y) * siluf_(bflo(g.y)), bfhi(o.y) * siluf_(bfhi(g.y)));
        w4.z = cvt_pk_bf16(bflo(o.z) * siluf_(bflo(g.z)), bfhi(o.z) * siluf_(bfhi(g.z))); w4.w = cvt_pk_bf16(bflo(o.w) * siluf_(bflo(g.w)), bfhi(o.w) * siluf_(bfhi(g.w)));
        *(u32x4*)(MIX + row * DM + 256 * h + 8 * c) = w4; }
    __syncthreads();
}

constexpr int KLD = 1032;
__device__ __forceinline__ void s5_output_task(const Params& p, Ctx& C, int bt) {
    const bf16_t* QKV = (const bf16_t*)(p.ws + WS_BIG + BG_QKV); bf16_t* Z = (bf16_t*)(p.ws + WS_Z);
    const bf16_t* KN = (const bf16_t*)(p.ws + WS_KN); const bf16_t* CCt = (const bf16_t*)(p.ws + WS_CC);
    const float* APOW = (const float*)(p.ws + WS_APOW); const float* HST = (const float*)(p.ws + WS_HST); const float* dsk = p.inp(18);
    int tid = C.tid; asm volatile("" : "+v"(tid));
    const int lane = tid & 63, kq = lane >> 4, fr = lane & 15;
    LAS bf16_t* KF = (LAS bf16_t*)C.lds; LAS bf16_t* KB = KF + 16 * KLD;
    LAS bf16_t* U = KB + 16 * KLD + C.wave * 3072;
    LAS float* PW0 = (LAS float*)(KB + 16 * KLD + 8 * 3072);
    LAS float* PW16 = PW0 + 2 * 16 * 128;
    {
        const int g = bt >> 3, k0 = (260 * (bt & 7)) >> 3, k1 = (260 * ((bt & 7) + 1)) >> 3;
#pragma unroll
        for (int q = 0; q < 8; ++q) { const int idx = tid + NTHR * q, dir = idx >> 11, rr = (idx >> 7) & 15, c = idx & 127;
            *(LAS u32x4*)((dir ? KB : KF) + rr * KLD + 8 * c) = *(const u32x4*)(KN + ((size_t)(dir * 64 + g) * 16 + rr) * 1024 + 8 * c); }
        for (int q = lane; q < 192 * 2; q += 64) *(LAS u32x4*)(U + 8 * q) = (u32x4){0u, 0u, 0u, 0u};
#pragma unroll
        for (int q = 0; q < 2; ++q) { const int idx = tid + NTHR * q, dir = idx >> 9, f = (idx >> 5) & 15, c4 = idx & 31;
            *(LAS f32x4*)(PW0 + dir * 2048 + f * 128 + 4 * c4) = *(const f32x4*)(APOW + ((size_t)(dir * 64 + g) * 64 + (dir == 0 ? f : 15 - f)) * 128 + 4 * c4); }
        if (tid < 64) { const int dir = tid >> 5, c4 = tid & 31; *(LAS f32x4*)(PW16 + dir * 128 + 4 * c4) = *(const f32x4*)(APOW + ((size_t)(dir * 64 + g) * 64 + 15) * 128 + 4 * c4); }
        __syncthreads();
        const f32x4 dv = *(const f32x4*)(dsk + 16 * g + 4 * kq);
        bf16x8 ccr[2], cci[2];
#pragma unroll
        for (int hb = 0; hb < 2; ++hb) { ccr[hb] = frag_rowk_g(CCt + (size_t)g * 16 * 128 + 32 * hb, 128, lane); cci[hb] = frag_rowk_g(CCt + (size_t)g * 16 * 128 + 64 + 32 * hb, 128, lane); }
        const LAS float* pw0l = PW0 + (size_t)fr * 128 + 16 * kq;
        const LAS float* pw16l = PW16 + 16 * kq;
        for (int k = k0 + C.wave; k < k1; k += 8) {
            LDS_WAIT(); asm volatile("" ::: "memory");
            for (int q = lane; q < 128; q += 64) { const int t = q >> 1, hf = q & 1;
                *(LAS u32x4*)(U + (64 + t) * 16 + 8 * hf) = *(const u32x4*)(QKV + (size_t)(64 * k + t) * EV_IN + 4096 + 16 * g + 8 * hf); }
            LDS_WAIT(); asm volatile("" ::: "memory");
            const int cf = k, cb = k < 4 ? 3 - k : 263 - k;
            f32x4 acc[4];
#pragma unroll
            for (int tt = 0; tt < 4; ++tt) acc[tt] = (f32x4){0.f, 0.f, 0.f, 0.f};
            const LAS bf16_t* ubf = U + (64 + fr - (kq >> 1)) * 16 + 8 * (kq & 1);
            const LAS bf16_t* ubb = U + (64 + fr + (kq >> 1)) * 16 + 8 * (kq & 1);
#pragma unroll
            for (int n0 = 0; n0 < 64; n0 += 2) {
                const bf16x8 af = frag_rowk_l(KF + n0 * 16, KLD, lane), ab = frag_rowk_l(KB + n0 * 16, KLD, lane);
#pragma unroll
                for (int tt = 0; tt < 4; ++tt) {
                    if (n0 <= 16 * tt + 14) acc[tt] = MFMA16(af, *(const LAS bf16x8*)(ubf + (16 * tt - n0) * 16), acc[tt]);
                    if (n0 <= 62 - 16 * tt) acc[tt] = MFMA16(ab, *(const LAS bf16x8*)(ubb + (16 * tt + n0) * 16), acc[tt]);
                }
                asm volatile("" ::: "memory");
            }
#pragma unroll
            for (int dir = 0; dir < 2; ++dir) {
                const float* hp = HST + ((size_t)(dir * 64 + g) * 260 + (dir == 0 ? cf : cb)) * 128;
#pragma unroll
                for (int hb = 0; hb < 2; ++hb) {
                    float xr[8], xi[8];
#pragma unroll
                    for (int e2 = 0; e2 < 4; ++e2) { const f32x4 h4 = *(const f32x4*)(hp + 2 * (32 * hb + 8 * kq) + 4 * e2), b4 = *(const LAS f32x4*)(pw0l + dir * 2048 + hb * 64 + 4 * e2);
                        xr[2 * e2] = b4[0] * h4[0] - b4[1] * h4[1]; xi[2 * e2] = b4[0] * h4[1] + b4[1] * h4[0];
                        xr[2 * e2 + 1] = b4[2] * h4[2] - b4[3] * h4[3]; xi[2 * e2 + 1] = b4[2] * h4[3] + b4[3] * h4[2]; }
#pragma unroll
                    for (int st = 0; st < 4; ++st) {
                        const int tt = dir == 0 ? st : 3 - st;
                        u32x4 br, bi;
                        br.x = cvt_pk_bf16(xr[0], xr[1]); br.y = cvt_pk_bf16(xr[2], xr[3]); br.z = cvt_pk_bf16(xr[4], xr[5]); br.w = cvt_pk_bf16(xr[6], xr[7]);
                        bi.x = cvt_pk_bf16(xi[0], xi[1]); bi.y = cvt_pk_bf16(xi[2], xi[3]); bi.z = cvt_pk_bf16(xi[4], xi[5]); bi.w = cvt_pk_bf16(xi[6], xi[7]);
                        acc[tt] = MFMA16(ccr[hb], __builtin_bit_cast(bf16x8, br), acc[tt]);
                        acc[tt] = MFMA16(cci[hb], __builtin_bit_cast(bf16x8, bi), acc[tt]);
                        if (st < 3) {
#pragma unroll
                            for (int e2 = 0; e2 < 4; ++e2) { const f32x4 a4 = *(const LAS f32x4*)(pw16l + dir * 128 + hb * 64 + 4 * e2);
                                float t0 = xr[2 * e2] * a4[0] - xi[2 * e2] * a4[1]; xi[2 * e2] = xr[2 * e2] * a4[1] + xi[2 * e2] * a4[0]; xr[2 * e2] = t0;
                                t0 = xr[2 * e2 + 1] * a4[2] - xi[2 * e2 + 1] * a4[3]; xi[2 * e2 + 1] = xr[2 * e2 + 1] * a4[3] + xi[2 * e2 + 1] * a4[2]; xr[2 * e2 + 1] = t0; }
                        }
                    }
                }
            }
#pragma unroll
            for (int tt = 0; tt < 4; ++tt) { const int t = 16 * tt + fr;
                const u32x2 uu = *(const LAS u32x2*)(U + (64 + t) * 16 + 4 * kq);
                const float y0 = acc[tt][0] + bflo(uu.x) * dv[0], y1 = acc[tt][1] + bfhi(uu.x) * dv[1], y2 = acc[tt][2] + bflo(uu.y) * dv[2], y3 = acc[tt][3] + bfhi(uu.y) * dv[3];
                u32x2 w; w.x = cvt_pk_bf16(gelu_tanh(y0), gelu_tanh(y1)); w.y = cvt_pk_bf16(gelu_tanh(y2), gelu_tanh(y3));
                *(u32x2*)(Z + (size_t)(64 * k + t) * 1024 + 16 * g + 4 * kq) = w; }
        }
    }
    __syncthreads();
}

__device__ __forceinline__ void phase_ret_s5_outputs(const Params& p, Ctx& C, LAS unsigned char* misc) {
    unsigned* head = (unsigned*)(p.ws + WS_CTL) + CW_QUEUE;
    volatile LAS int* slot = (volatile LAS int*)(misc + 32);
    for (;;) {
        __syncthreads();
        if (C.tid == 0) slot[0] = (int)atomicAdd(head, 1u);
        __syncthreads();
        const int item = __builtin_amdgcn_readfirstlane(slot[0]);
        if (item >= 520) break;
        ret_output_unit(p, C, item);
    }
    for (;;) {
        __syncthreads();
        if (C.tid == 0) slot[0] = (int)atomicAdd(head + 64, 1u);
        __syncthreads();
        const int item = __builtin_amdgcn_readfirstlane(slot[0]);
        if (item >= 512) break;
        s5_output_task(p, C, item);
    }
}
__device__ __forceinline__ void phase_router(const Params& p, Ctx& C, int L) {
    const float* X1 = (const float*)(p.ws + WS_X1);
    const bf16_t* RWh = (const bf16_t*)(p.ws + WS_RWT) + (size_t)(L * 2 + 0) * 64 * DM; const bf16_t* RWl = (const bf16_t*)(p.ws + WS_RWT) + (size_t)(L * 2 + 1) * 64 * DM;
    const float* rbias = p.inp(27) + L * 64;
    int* cnt = (int*)(p.ws + WS_CTL) + CW_CNT + L * 128; int* LIST = (int*)(p.ws + WS_LIST); unsigned* PK = (unsigned*)(p.ws + WS_WGT); float* LW = (float*)(p.ws + WS_LW);
    const int lane = C.lane, kq = lane >> 4, fr = lane & 15;
    LAS float* Lg = (LAS float*)(C.lds + C.wave * 8192);
    const int r0 = (L == 0) ? 0 : CTXL, nrows = TT - r0;
    if (C.bid == 0 && C.tid == 0) cnt[64] = nrows;
    for (int task = C.gw; task < nrows / 16; task += C.ngw) {
        const int rbase = r0 + 16 * task, row = rbase + fr;
        const int v = row < CTXL ? 1 : 0;
        const float* xr = X1 + (size_t)row * DM; const float* sc2 = modv(p, L, v, 4); const float* sh2 = modv(p, L, v, 3);
        f32x4 acc[4];
#pragma unroll
        for (int t = 0; t < 4; ++t) acc[t] = (f32x4){0.f, 0.f, 0.f, 0.f};
#pragma unroll 2
        for (int ks = 0; ks < 64; ++ks) { const int c0 = 32 * ks + 8 * kq;
            const f32x4 x0 = *(const f32x4*)(xr + c0), x1 = *(const f32x4*)(xr + c0 + 4);
            const f32x4 a0 = *(const f32x4*)(sc2 + c0), a1 = *(const f32x4*)(sc2 + c0 + 4), b0 = *(const f32x4*)(sh2 + c0), b1 = *(const f32x4*)(sh2 + c0 + 4);
            const f32x4 y0 = x0 * (a0 + 1.0f) + b0, y1 = x1 * (a1 + 1.0f) + b1;
            u32x4 hi; hi.x = cvt_pk_bf16(y0[0], y0[1]); hi.y = cvt_pk_bf16(y0[2], y0[3]); hi.z = cvt_pk_bf16(y1[0], y1[1]); hi.w = cvt_pk_bf16(y1[2], y1[3]);
            u32x4 lo; lo.x = cvt_pk_bf16(y0[0] - bflo(hi.x), y0[1] - bfhi(hi.x)); lo.y = cvt_pk_bf16(y0[2] - bflo(hi.y), y0[3] - bfhi(hi.y));
            lo.z = cvt_pk_bf16(y1[0] - bflo(hi.z), y1[1] - bfhi(hi.z)); lo.w = cvt_pk_bf16(y1[2] - bflo(hi.w), y1[3] - bfhi(hi.w));
            const bf16x8 ah = __builtin_bit_cast(bf16x8, hi), al = __builtin_bit_cast(bf16x8, lo);
#pragma unroll
            for (int t = 0; t < 4; ++t) { const bf16x8 bh = frag_rowk_g(RWh + (size_t)(16 * t) * DM + 32 * ks, DM, lane), bl = frag_rowk_g(RWl + (size_t)(16 * t) * DM + 32 * ks, DM, lane);
                acc[t] = MFMA16(ah, bh, acc[t]); acc[t] = MFMA16(al, bh, acc[t]); acc[t] = MFMA16(ah, bl, acc[t]); } }
        LDS_WAIT(); asm volatile("" ::: "memory");
#pragma unroll
        for (int t = 0; t < 4; ++t)
#pragma unroll
            for (int r = 0; r < 4; ++r) Lg[(4 * kq + r) * 65 + 16 * t + fr] = acc[t][r];
        LDS_WAIT(); asm volatile("" ::: "memory");
        if (lane < 16) {
            LAS float* sr = Lg + lane * 65; const int trow = rbase + lane;
            float gs[8];
#pragma unroll
            for (int g = 0; g < 8; ++g) { float m1 = -1e30f, m2 = -1e30f;
                for (int j = 0; j < 8; ++j) { const int e = 8 * g + j; const float s = sigmoidf_(sr[e]); sr[e] = s; const float vv = s + rbias[e];
                    if (vv > m1) { m2 = m1; m1 = vv; } else if (vv > m2) m2 = vv; }
                gs[g] = m1 + m2; }
            unsigned gmask = 0u;
#pragma unroll
            for (int it = 0; it < 4; ++it) { float best = -1e30f; int bi = 0;
#pragma unroll
                for (int g = 0; g < 8; ++g) { const bool ok = !((gmask >> g) & 1u) && gs[g] > best; best = ok ? gs[g] : best; bi = ok ? g : bi; }
                gmask |= 1u << bi; }
            unsigned long long taken = 0ull; int sel[8]; float sw[8]; float wsum = 0.f;
#pragma unroll
            for (int k = 0; k < 8; ++k) { float best = -1e30f; int bi = 0;
                for (int e = 0; e < 64; ++e) { const bool cand = ((gmask >> (e >> 3)) & 1u) && !((taken >> e) & 1ull); const float vv = sr[e] + rbias[e];
                    if (cand && vv > best) { best = vv; bi = e; } }
                taken |= 1ull << bi; sel[k] = bi; sw[k] = sr[bi]; wsum += sw[k]; }
            const float inv = 2.5f / wsum;
#pragma unroll
            for (int k = 0; k < 8; ++k) { const int a = trow * 8 + k; const int pos = atomicAdd(&cnt[sel[k]], 1);
                LIST[(size_t)sel[k] * TT + pos] = a; PK[a] = ((unsigned)sel[k] << 16) | (unsigned)pos; LW[a] = sw[k] * inv * 4.0f; }
            LIST[(size_t)64 * TT + (trow - r0)] = 8 * TT + trow;
        }
    }
}
namespace att {
constexpr int D = 128, NW = 8, QBLK = 32, KVBLK = 64;
constexpr float SCALE = 0.088388347648318440f;
constexpr float THR = 8.f;
constexpr int SHM_V = KVBLK * D * 2, SHM_K = KVBLK * D * 2, SHM_ATTN = 2 * SHM_V + 2 * SHM_K + NW * 64 * 4;
#define KSWZ(row, colB) ((row) * 256 + ((colB) ^ (((row) & 7) << 4)))
#define SBAR() __builtin_amdgcn_sched_barrier(0)
__device__ __forceinline__ int crow(int r, int hi) { return (r & 3) + 8 * (r >> 2) + 4 * hi; }
__device__ __forceinline__ unsigned cvtpk(float lo, float hi) { unsigned r; asm volatile("v_cvt_pk_bf16_f32 %0, %1, %2" : "=v"(r) : "v"(lo), "v"(hi)); return r; }

__device__ __forceinline__ void partialSM(f32x16& p0, f32x16& p1, float negMC) {
  constexpr float Cc = SCALE * 1.4426950408889634f;
  for (int r = 0; r < 16; ++r) p0[r] = fmaf(p0[r], Cc, negMC); for (int r = 0; r < 16; ++r) p1[r] = fmaf(p1[r], Cc, negMC);
  for (int r = 0; r < 16; ++r) p0[r] = __builtin_amdgcn_exp2f(p0[r]);
}
__device__ __forceinline__ void finishSM(f32x16& p0, f32x16& p1, float& l_reg, bf16x8& pa0, bf16x8& pa1, bf16x8& pa2, bf16x8& pa3) {
  for (int r = 0; r < 16; ++r) p1[r] = __builtin_amdgcn_exp2f(p1[r]);
  float ps = 0; for (int r = 0; r < 16; ++r) ps += p0[r]; for (int r = 0; r < 16; ++r) ps += p1[r];
  { auto rr = __builtin_amdgcn_permlane32_swap(__float_as_uint(ps), __float_as_uint(ps), false, false);
    ps = __uint_as_float(rr[0]) + __uint_as_float(rr[1]); }
  l_reg += ps;
#define PK4(P, BASE, OUT) do { unsigned a0 = cvtpk(P[BASE + 0], P[BASE + 1]), a1 = cvtpk(P[BASE + 2], P[BASE + 3]);   \
    unsigned b0 = cvtpk(P[BASE + 4], P[BASE + 5]), b1 = cvtpk(P[BASE + 6], P[BASE + 7]);                              \
    auto r0 = __builtin_amdgcn_permlane32_swap(a0, b0, false, false); auto r1 = __builtin_amdgcn_permlane32_swap(a1, b1, false, false); \
    u32x4 w = {r0[0], r1[0], r0[1], r1[1]}; OUT = *reinterpret_cast<bf16x8*>(&w); } while (0)
  PK4(p0, 0, pa0); PK4(p0, 8, pa1); PK4(p1, 0, pa2); PK4(p1, 8, pa3);
#undef PK4
}
__device__ __forceinline__ void qkt(f32x16& p0, f32x16& p1, const LAS char* Ks, const bf16x8* qr, int r32, int hi) {
  p0 = f32x16{}; p1 = f32x16{};
  for (int d0 = 0; d0 < 8; ++d0) { int cb = (d0 * 16 + hi * 8) * 2;
    bf16x8 b0 = *reinterpret_cast<const LAS bf16x8*>(Ks + KSWZ(r32, cb));
    bf16x8 b1 = *reinterpret_cast<const LAS bf16x8*>(Ks + KSWZ(32 + r32, cb));
    p0 = __builtin_amdgcn_mfma_f32_32x32x16_bf16(b0, qr[d0], p0, 0, 0, 0);
    p1 = __builtin_amdgcn_mfma_f32_32x32x16_bf16(b1, qr[d0], p1, 0, 0, 0); }
}
__device__ __forceinline__ int v_st(int k, int c) { const int kk = (k & ~0xC) | ((k & 4) << 1) | ((k & 8) >> 1); return ((kk >> 3) * 4 + (c >> 5)) * 512 + ((kk & 7) * 32 + (c & 31)) * 2; }
__device__ __forceinline__ int v_rd_base(int lane) { return ((lane & 3) << 3) | (((lane >> 2) & 3) << 6) | (((lane >> 4) & 1) << 5) | (((lane >> 5) & 1) << 8); }
constexpr int v_rd_off(int d0, int ks, int half) { return d0 * 512 + ks * 4096 + half * 2048; }
template <int OFF> __device__ __forceinline__ s16x4 tr_read(int vb) {
  s16x4 r; asm volatile("ds_read_b64_tr_b16 %0, %1 offset:%2" : "=&v"(r) : "v"(vb), "i"(OFF) : "memory"); return r;
}
template <int D0> __device__ __forceinline__ void pv_one(f32x16& od, int vb, bf16x8 pa0, bf16x8 pa1, bf16x8 pa2, bf16x8 pa3) {
  const s16x4 l0 = tr_read<v_rd_off(D0, 0, 0)>(vb), h0 = tr_read<v_rd_off(D0, 0, 1)>(vb), l1 = tr_read<v_rd_off(D0, 1, 0)>(vb), h1 = tr_read<v_rd_off(D0, 1, 1)>(vb);
  const s16x4 l2 = tr_read<v_rd_off(D0, 2, 0)>(vb), h2 = tr_read<v_rd_off(D0, 2, 1)>(vb), l3 = tr_read<v_rd_off(D0, 3, 0)>(vb), h3 = tr_read<v_rd_off(D0, 3, 1)>(vb);
  asm volatile("s_waitcnt lgkmcnt(0)" ::: "memory"); SBAR();
#define PK(L, H) (bf16x8){L[0], L[1], L[2], L[3], H[0], H[1], H[2], H[3]}
  od = __builtin_amdgcn_mfma_f32_32x32x16_bf16(pa0, PK(l0, h0), od, 0, 0, 0);
  od = __builtin_amdgcn_mfma_f32_32x32x16_bf16(pa1, PK(l1, h1), od, 0, 0, 0);
  od = __builtin_amdgcn_mfma_f32_32x32x16_bf16(pa2, PK(l2, h2), od, 0, 0, 0);
  od = __builtin_amdgcn_mfma_f32_32x32x16_bf16(pa3, PK(l3, h3), od, 0, 0, 0);
#undef PK
}
__device__ __forceinline__ void pv_d0(f32x16* o, int vb, bf16x8 pa0, bf16x8 pa1, bf16x8 pa2, bf16x8 pa3) {
  pv_one<0>(o[0], vb, pa0, pa1, pa2, pa3); pv_one<1>(o[1], vb, pa0, pa1, pa2, pa3); pv_one<2>(o[2], vb, pa0, pa1, pa2, pa3); pv_one<3>(o[3], vb, pa0, pa1, pa2, pa3);
}

template <int LDQ, int LDK, int LDO>
__device__ __forceinline__ void attn_dense_body(const bf16_t* __restrict__ Qb, const bf16_t* __restrict__ Kh, const bf16_t* __restrict__ Vh, bf16_t* __restrict__ Ob, int seq, LAS char* lds, int tid, float kmax2) {
  const int wid = tid >> 6, lane = tid & 63, r32 = lane & 31, hi = lane >> 5;
  LAS char* V_lds = lds; LAS char* K_lds = lds + 2 * SHM_V;
  LAS float* ws = (LAS float*)(lds + 2 * SHM_V + 2 * SHM_K) + wid * 64; LAS float* li_l = ws;
  float l_reg = 0; f32x16 o[4] = {}; bf16x8 qr[8];
  const bf16_t* Qw = Qb + (long)(wid * QBLK + r32) * LDQ + hi * 8;
#pragma unroll
  for (int d0 = 0; d0 < 8; ++d0) qr[d0] = *reinterpret_cast<const bf16x8*>(Qw + d0 * 16);
  float negMC;
  { float q2 = 0.f;
#pragma unroll
    for (int d0 = 0; d0 < 8; ++d0) { const u32x4 w = __builtin_bit_cast(u32x4, qr[d0]);
      q2 += bflo(w.x) * bflo(w.x) + bfhi(w.x) * bfhi(w.x) + bflo(w.y) * bflo(w.y) + bfhi(w.y) * bfhi(w.y) + bflo(w.z) * bflo(w.z) + bfhi(w.z) * bfhi(w.z) + bflo(w.w) * bflo(w.w) + bfhi(w.w) * bfhi(w.w); }
    auto rr = __builtin_amdgcn_permlane32_swap(__float_as_uint(q2), __float_as_uint(q2), false, false);
    q2 = __uint_as_float(rr[0]) + __uint_as_float(rr[1]);
    negMC = -(sqrtf(q2 * kmax2) * (SCALE * 1.0001f) - 30.0f) * 1.4426950408889634f; }
  const int sr = tid >> 4, sc = (tid & 15) * 8, vst0 = v_st(sr, sc), vst1 = v_st(32 + sr, sc);
  const int vb0 = (int)(uintptr_t)V_lds + v_rd_base(lane);
  struct { bf16x8 vs0, vs1, ks0, ks1; } sr_[2];
#define SLOAD(i, k0) do { sr_[i].vs0 = *reinterpret_cast<const bf16x8*>(&Vh[(long)((k0) + sr) * LDK + sc]); sr_[i].vs1 = *reinterpret_cast<const bf16x8*>(&Vh[(long)((k0) + 32 + sr) * LDK + sc]); \
    sr_[i].ks0 = *reinterpret_cast<const bf16x8*>(&Kh[(long)((k0) + sr) * LDK + sc]); sr_[i].ks1 = *reinterpret_cast<const bf16x8*>(&Kh[(long)((k0) + 32 + sr) * LDK + sc]); } while (0)
#define SWRITE(b, i) do { *(LAS bf16x8*)(V_lds + (b) * SHM_V + vst0) = sr_[i].vs0;          \
    *(LAS bf16x8*)(V_lds + (b) * SHM_V + vst1) = sr_[i].vs1; int kc = sc * 2;               \
    *(LAS bf16x8*)(K_lds + (b) * SHM_K + KSWZ(sr, kc)) = sr_[i].ks0;                       \
    *(LAS bf16x8*)(K_lds + (b) * SHM_K + KSWZ(32 + sr, kc)) = sr_[i].ks1; } while (0)
#define SWAIT() asm volatile("s_waitcnt vmcnt(4)" ::: "memory")
  f32x16 pA0, pA1, pB0, pB1; bf16x8 pa0, pa1, pa2, pa3; const int NT = seq / KVBLK;
  constexpr int SE = 0, SO = 1;
  SLOAD(SE, 0); asm volatile("s_waitcnt vmcnt(0)" ::: "memory"); SWRITE(0, SE); __syncthreads();
  qkt(pA0, pA1, K_lds, qr, r32, hi); partialSM(pA0, pA1, negMC);
  SLOAD(SO, KVBLK); if (2 < NT) SLOAD(SE, 2 * KVBLK);
  SWAIT(); SWRITE(1, SO); __syncthreads();
  for (int j = 1; j + 1 < NT; j += 2) {
    SBAR(); qkt(pB0, pB1, K_lds + SHM_K, qr, r32, hi);
    finishSM(pA0, pA1, l_reg, pa0, pa1, pa2, pa3); SBAR();
    SLOAD(SO, (j + 2) * KVBLK); SBAR();
    pv_d0(o, vb0, pa0, pa1, pa2, pa3); partialSM(pB0, pB1, negMC);
    __syncthreads(); SWAIT(); SWRITE(0, SE);
    __syncthreads();
    SBAR(); qkt(pA0, pA1, K_lds, qr, r32, hi);
    finishSM(pB0, pB1, l_reg, pa0, pa1, pa2, pa3); SBAR();
    if (j + 3 < NT) SLOAD(SE, (j + 3) * KVBLK); SBAR();
    pv_d0(o, vb0 + (int)SHM_V, pa0, pa1, pa2, pa3); partialSM(pA0, pA1, negMC);
    __syncthreads(); SWAIT(); SWRITE(1, SO);
    __syncthreads();
  }
  SBAR(); qkt(pB0, pB1, K_lds + SHM_K, qr, r32, hi);
  finishSM(pA0, pA1, l_reg, pa0, pa1, pa2, pa3); SBAR();
  pv_d0(o, vb0, pa0, pa1, pa2, pa3); partialSM(pB0, pB1, negMC);
  __syncthreads();
  finishSM(pB0, pB1, l_reg, pa0, pa1, pa2, pa3); SBAR();
  pv_d0(o, vb0 + (int)SHM_V, pa0, pa1, pa2, pa3);
  if (hi == 0) li_l[r32] = l_reg; asm volatile("s_waitcnt lgkmcnt(0)" ::: "memory");
  float rli[16];
#pragma unroll
  for (int r = 0; r < 16; ++r) rli[r] = __builtin_amdgcn_rcpf(li_l[crow(r, hi)]);
  bf16_t* Ow = Ob + (long)(wid * QBLK) * LDO;
#pragma unroll
  for (int r = 0; r < 16; ++r) { int orow = crow(r, hi);
    for (int d0 = 0; d0 < 4; ++d0) Ow[(long)orow * LDO + d0 * 32 + r32] = (bf16_t)(cvtpk(o[d0][r] * rli[r], 0.f) & 0xffffu); }
#undef SLOAD
#undef SWRITE
#undef SWAIT
}

typedef int v8i32a __attribute__((ext_vector_type(8)));
typedef int v4i32a __attribute__((ext_vector_type(4)));
#define KSW8(row, chunk) ((row) * 128 + ((((chunk) ^ (((row) >> 1) & 7))) << 4))
#define VSW8(d, chunk) ((d) * 64 + ((((chunk) ^ (((d) >> 2) & 3))) << 4))
#define MFMA8(a, b, c) __builtin_amdgcn_mfma_scale_f32_32x32x64_f8f6f4((a), (b), (c), 0, 0, 0, 0, 0, 0)
__device__ __forceinline__ v8i32a ld32_l(const LAS char* p0, const LAS char* p1) { return __builtin_shufflevector(*(const LAS v4i32a*)p0, *(const LAS v4i32a*)p1, 0, 1, 2, 3, 4, 5, 6, 7); }
__device__ __forceinline__ unsigned pk4f8(float a, float b, float c, float d) { unsigned w = (unsigned)__builtin_amdgcn_cvt_pk_fp8_f32(a, b, 0, false); return (unsigned)__builtin_amdgcn_cvt_pk_fp8_f32(c, d, (int)w, true); }
template <int LDO, int KSTR>
__device__ __forceinline__ void attn_dense8_body(const unsigned char* __restrict__ Q8b, const unsigned char* __restrict__ K8h, const unsigned char* __restrict__ VT8h, bf16_t* __restrict__ Ob, int seq, LAS char* lds, int tid, float kmax2) {
  const int wid = tid >> 6, lane = tid & 63, r32 = lane & 31, hi = lane >> 5;
  constexpr int RS = 6, PD = 4;
  LAS float* al_l = (LAS float*)(lds + RS * 16384) + wid * 32;
  f32x16 o[4] = {}; v8i32a qf[2];
  { const unsigned char* qp = Q8b + (size_t)(wid * QBLK + r32) * 1024 + 32 * hi;
    qf[0] = __builtin_shufflevector(*(const v4i32a*)qp, *(const v4i32a*)(qp + 16), 0, 1, 2, 3, 4, 5, 6, 7);
    qf[1] = __builtin_shufflevector(*(const v4i32a*)(qp + 64), *(const v4i32a*)(qp + 80), 0, 1, 2, 3, 4, 5, 6, 7); }
  (void)kmax2;
  constexpr float THR8 = 1.4426950408889634f;
  float m_reg = 0.f; f32x16 osum = {}; v8i32a ones = {0x38383838, 0x38383838, 0x38383838, 0x38383838, 0x38383838, 0x38383838, 0x38383838, 0x38383838}; asm volatile("" : "+v"(ones));
#define PSM8(P0, P1, DL, CN, FIRST) do { float pmax = P0[0]; for (int r = 1; r < 16; ++r) pmax = fmaxf(pmax, P0[r]); for (int r = 0; r < 16; ++r) pmax = fmaxf(pmax, P1[r]); \
      { auto rr = __builtin_amdgcn_permlane32_swap(__float_as_uint(pmax), __float_as_uint(pmax), false, false); pmax = fmaxf(__uint_as_float(rr[0]), __uint_as_float(rr[1])); } \
      const float mn = (FIRST) ? pmax : ((pmax - m_reg > THR8) ? pmax : m_reg); DL = (FIRST) ? 0.f : mn - m_reg; m_reg = mn; CN = 7.0f - mn; \
      for (int r = 0; r < 16; ++r) P0[r] = __builtin_amdgcn_exp2f(P0[r] + CN); } while (0)
#define RESC8(DL) do { if (__any((DL) > 0.f)) { if (hi == 0) al_l[r32] = __builtin_amdgcn_exp2f(-(DL)); asm volatile("s_waitcnt lgkmcnt(0)" ::: "memory"); \
      for (int d = 0; d < 4; ++d) for (int r = 0; r < 16; ++r) o[d][r] *= al_l[crow(r, hi)]; for (int r = 0; r < 16; ++r) osum[r] *= al_l[crow(r, hi)]; } } while (0)
  const unsigned kgo = (unsigned)((tid >> 3) * KSTR + 16 * ((tid & 7) ^ ((tid >> 4) & 7))), vgo = (unsigned)((tid >> 2) * 64 + 16 * ((tid & 3) ^ ((tid >> 4) & 3)));
  const unsigned ldw = (unsigned)wid * 1024u;
#define DMA8(slot, T_) do { __builtin_amdgcn_global_load_lds((const unsigned*)(K8h + (size_t)(T_) * (64 * KSTR) + kgo), (LAS unsigned*)(lds + (slot) * 16384 + ldw), 16, 0, 0); \
      __builtin_amdgcn_global_load_lds((const unsigned*)(VT8h + (size_t)(T_) * 8192 + vgo), (LAS unsigned*)(lds + (slot) * 16384 + 8192 + ldw), 16, 0, 0); } while (0)
#define DWAIT8() do { asm volatile("s_waitcnt vmcnt(6)\n\ts_waitcnt lgkmcnt(0)" ::: "memory"); __builtin_amdgcn_s_barrier(); asm volatile("" ::: "memory"); } while (0)
#define QK8(P0, P1, KB) do { P0 = f32x16{}; P1 = f32x16{}; _Pragma("unroll") for (int s = 0; s < 2; ++s) { \
      const v8i32a k0 = ld32_l((KB) + KSW8(r32, 4 * s + 2 * hi), (KB) + KSW8(r32, 4 * s + 2 * hi + 1)); \
      const v8i32a k1 = ld32_l((KB) + KSW8(32 + r32, 4 * s + 2 * hi), (KB) + KSW8(32 + r32, 4 * s + 2 * hi + 1)); \
      P0 = MFMA8(k0, qf[s], P0); P1 = MFMA8(k1, qf[s], P1); } } while (0)
#define FIN8(P0, P1, CN) do { for (int r = 0; r < 16; ++r) P1[r] = __builtin_amdgcn_exp2f(P1[r] + CN); \
      _Pragma("unroll") for (int i = 0; i < 4; ++i) { pa[i] = (int)pk4f8(P0[4 * i], P0[4 * i + 1], P0[4 * i + 2], P0[4 * i + 3]); pa[4 + i] = (int)pk4f8(P1[4 * i], P1[4 * i + 1], P1[4 * i + 2], P1[4 * i + 3]); } } while (0)
#define PV8(VB) do { _Pragma("unroll") for (int d0 = 0; d0 < 4; ++d0) { \
      const v8i32a vf = ld32_l((VB) + VSW8(32 * d0 + r32, 2 * hi), (VB) + VSW8(32 * d0 + r32, 2 * hi + 1)); \
      o[d0] = MFMA8(pa, vf, o[d0]); } osum = MFMA8(pa, ones, osum); } while (0)
#define LDK8(KB, s, half) ld32_l((KB) + KSW8(32 * (half) + r32, 4 * (s) + 2 * hi), (KB) + KSW8(32 * (half) + r32, 4 * (s) + 2 * hi + 1))
#define LDV8(VB, d0) ld32_l((VB) + VSW8(32 * (d0) + r32, 2 * hi), (VB) + VSW8(32 * (d0) + r32, 2 * hi + 1))
#define EXPN(P, r0, n, CN) do { _Pragma("unroll") for (int r = (r0); r < (r0) + (n); ++r) { float e_ = __builtin_amdgcn_exp2f(P[r] + (CN)); asm volatile("" : "+v"(e_)); P[r] = e_; } } while (0)
#define FINP(P0, P1, CN, i) do { EXPN(P1, 4 * (i), 4, CN); \
      { unsigned w_ = (unsigned)__builtin_amdgcn_cvt_pk_fp8_f32(P0[4 * (i)], P0[4 * (i) + 1], pa[i], false); pa[i] = __builtin_amdgcn_cvt_pk_fp8_f32(P0[4 * (i) + 2], P0[4 * (i) + 3], (int)w_, true); } \
      { unsigned w_ = (unsigned)__builtin_amdgcn_cvt_pk_fp8_f32(P1[4 * (i)], P1[4 * (i) + 1], pa[4 + (i)], false); pa[4 + (i)] = __builtin_amdgcn_cvt_pk_fp8_f32(P1[4 * (i) + 2], P1[4 * (i) + 3], (int)w_, true); } } while (0)
#define PINA(x, y) asm volatile("" : "+v"(x), "+v"(y))
#define PIN1(x) asm volatile("" : "+v"(x))
#define PINC(x, y) asm volatile("" :: "v"(x), "v"(y))
#define HSTEP(X0, X1, DLX, CNX, Y0, Y1, CNY, KB, VB, STAGE_LOAD) do { \
      v8i32a ka_ = LDK8(KB, 0, 0), kb_ = LDK8(KB, 0, 1), kc_ = LDK8(KB, 1, 0), kd_ = LDK8(KB, 1, 1); \
      X0 = MFMA8(ka_, qf[0], f32x16{}); PINA(X0, kb_); \
      FINP(Y0, Y1, CNY, 0); PINC(pa[0], pa[4]); PIN1(kb_); \
      X1 = MFMA8(kb_, qf[0], f32x16{}); PINA(X1, kc_); \
      FINP(Y0, Y1, CNY, 1); PINC(pa[1], pa[5]); PIN1(kc_); \
      X0 = MFMA8(kc_, qf[1], X0); PINA(X0, kd_); \
      v8i32a v0_ = LDV8(VB, 0), v1_ = LDV8(VB, 1); \
      FINP(Y0, Y1, CNY, 2); STAGE_LOAD; PINC(pa[2], pa[6]); PIN1(kd_); \
      X1 = MFMA8(kd_, qf[1], X1); PINA(X1, v0_); \
      v8i32a v2_ = LDV8(VB, 2), v3_ = LDV8(VB, 3); \
      FINP(Y0, Y1, CNY, 3); PINC(pa[3], pa[7]); PINA(pa, v0_); \
      o[0] = MFMA8(pa, v0_, o[0]); PINA(o[0], v1_); \
      float pm0_ = X0[0]; _Pragma("unroll") for (int r = 1; r < 16; ++r) pm0_ = fmaxf(pm0_, X0[r]); PINA(pm0_, v1_); \
      o[1] = MFMA8(pa, v1_, o[1]); PINA(o[1], v2_); \
      _Pragma("unroll") for (int r = 0; r < 16; ++r) pm0_ = fmaxf(pm0_, X1[r]); \
      { auto rr = __builtin_amdgcn_permlane32_swap(__float_as_uint(pm0_), __float_as_uint(pm0_), false, false); pm0_ = fmaxf(__uint_as_float(rr[0]), __uint_as_float(rr[1])); } \
      { const float mn = (pm0_ - m_reg > THR8) ? pm0_ : m_reg; DLX = mn - m_reg; m_reg = mn; CNX = 7.0f - mn; } PINA(CNX, v2_); \
      o[2] = MFMA8(pa, v2_, o[2]); PINA(o[2], v3_); \
      EXPN(X0, 0, 5, CNX); PIN1(v3_); \
      o[3] = MFMA8(pa, v3_, o[3]); PINA(o[3], CNX); \
      EXPN(X0, 5, 5, CNX); PIN1(pa); \
      osum = MFMA8(pa, ones, osum); PINA(osum, CNX); \
      EXPN(X0, 10, 6, CNX); } while (0)
  f32x16 pA0, pA1, pB0, pB1; v8i32a pa = {}; float dlA, dlB, cnA, cnB; const int NT = seq / KVBLK;
#define SLOT(s) (lds + (s) * 16384)
#define SADV() do { sv = sk; sk = sk + 1 == RS ? 0 : sk + 1; sd = sd + 1 == RS ? 0 : sd + 1; } while (0)
  int sk = 0, sv = 0, sd = PD;
  DMA8(0, 0); DMA8(1, 1); DMA8(2, 2); DMA8(3, 3);
  DWAIT8();
  QK8(pA0, pA1, SLOT(0)); PSM8(pA0, pA1, dlA, cnA, true);
  DMA8(sd, PD); SADV(); DWAIT8();
  for (int j = 1; j + 1 < NT; j += 2) {
    HSTEP(pB0, pB1, dlB, cnB, pA0, pA1, cnA, SLOT(sk), SLOT(sv) + 8192, DMA8(sd, min(j + PD, NT - 1)));
    RESC8(dlB); SADV(); DWAIT8();
    HSTEP(pA0, pA1, dlA, cnA, pB0, pB1, cnB, SLOT(sk), SLOT(sv) + 8192, DMA8(sd, min(j + 1 + PD, NT - 1)));
    RESC8(dlA); SADV(); DWAIT8();
  }
  HSTEP(pB0, pB1, dlB, cnB, pA0, pA1, cnA, SLOT(sk), SLOT(sv) + 8192, (void)0);
  RESC8(dlB); SADV();
  FIN8(pB0, pB1, cnB); SBAR();
  PV8(SLOT(sv) + 8192);
  asm volatile("s_waitcnt vmcnt(0)" ::: "memory");
  float rli[16];
#pragma unroll
  for (int r = 0; r < 16; ++r) rli[r] = __builtin_amdgcn_rcpf(osum[r]);
  bf16_t* Ow = Ob + (long)(wid * QBLK) * LDO;
#pragma unroll
  for (int r = 0; r < 16; ++r) { int orow = crow(r, hi);
    for (int d0 = 0; d0 < 4; ++d0) Ow[(long)orow * LDO + d0 * 32 + r32] = (bf16_t)(cvtpk(o[d0][r] * rli[r], 0.f) & 0xffffu); }
#undef PSM8
#undef RESC8
#undef DMA8
#undef DWAIT8
#undef SLOT
#undef SADV
#undef QK8
#undef FIN8
#undef PV8
#undef HSTEP
#undef PINA
#undef PIN1
#undef PINC
#undef FINP
#undef EXPN
#undef LDK8
#undef LDV8
}

template <int LDO, int KSTR>
__device__ __forceinline__ void attn_dense8w_body(const unsigned char* __restrict__ Q8b, const unsigned char* __restrict__ K8h, const unsigned char* __restrict__ VT8h0, const unsigned char* __restrict__ VT8h1, bf16_t* __restrict__ Ob, int seq, LAS char* lds, int tid, float kmax2) {
  const int wid = tid >> 6, lane = tid & 63, r32 = lane & 31, hi = lane >> 5;
  constexpr int RS = 4, PD = 2, SB = 24576;
  LAS float* al_l = (LAS float*)(lds + RS * SB) + wid * 32;
  LAS char* q_l = lds + RS * SB + 2048 + wid * 4096 + lane * 16;
  { const unsigned char* qp = Q8b + (size_t)(wid * QBLK + r32) * 1024 + 32 * hi;
    *(LAS v4i32a*)(q_l) = *(const v4i32a*)qp; *(LAS v4i32a*)(q_l + 1024) = *(const v4i32a*)(qp + 16);
    *(LAS v4i32a*)(q_l + 2048) = *(const v4i32a*)(qp + 64); *(LAS v4i32a*)(q_l + 3072) = *(const v4i32a*)(qp + 80); }
  (void)kmax2;
  constexpr float THR8 = 1.4426950408889634f;
  float l_reg = 0.f, m_reg = 0.f; f32x16 o[8] = {};
  const unsigned kgo = (unsigned)((tid >> 3) * KSTR + 16 * ((tid & 7) ^ ((tid >> 4) & 7))), vgo = (unsigned)((tid >> 2) * 64 + 16 * ((tid & 3) ^ ((tid >> 4) & 3)));
  const unsigned ldw = (unsigned)wid * 1024u;
#define DMA8(slot, T_) do { __builtin_amdgcn_global_load_lds((const unsigned*)(K8h + (size_t)(T_) * (64 * KSTR) + kgo), (LAS unsigned*)(lds + (slot) * SB + ldw), 16, 0, 0); \
      __builtin_amdgcn_global_load_lds((const unsigned*)(VT8h0 + (size_t)(T_) * 8192 + vgo), (LAS unsigned*)(lds + (slot) * SB + 8192 + ldw), 16, 0, 0); \
      __builtin_amdgcn_global_load_lds((const unsigned*)(VT8h1 + (size_t)(T_) * 8192 + vgo), (LAS unsigned*)(lds + (slot) * SB + 16384 + ldw), 16, 0, 0); } while (0)
#define DWAIT8() do { asm volatile("s_waitcnt vmcnt(3)\n\ts_waitcnt lgkmcnt(0)" ::: "memory"); __builtin_amdgcn_s_barrier(); asm volatile("" ::: "memory"); } while (0)
#define SLOT(s) (lds + (s) * SB)
#define SADV() do { sv = sk; sk = sk + 1 == RS ? 0 : sk + 1; sd = sd + 1 == RS ? 0 : sd + 1; } while (0)
#define LDK8(KB, s, half) ld32_l((KB) + KSW8(32 * (half) + r32, 4 * (s) + 2 * hi), (KB) + KSW8(32 * (half) + r32, 4 * (s) + 2 * hi + 1))
#define LDV8(VB, d0) ld32_l((VB) + VSW8(32 * (d0) + r32, 2 * hi), (VB) + VSW8(32 * (d0) + r32, 2 * hi + 1))
#define PIN1(x) asm volatile("" : "+v"(x))
#define EXPR(e0, n) do { _Pragma("unroll") for (int e = (e0); e < (e0) + (n); ++e) { float x_ = e < 16 ? X0[e & 15] : X1[e & 15]; float e_ = __builtin_amdgcn_exp2f(x_ + cn); asm volatile("" : "+v"(e_)); ps += e_; \
      if (e < 16) X0[e & 15] = e_; else X1[e & 15] = e_; } } while (0)
#define PKW(PAC, w) do { if ((w) < 4) { unsigned w_ = (unsigned)__builtin_amdgcn_cvt_pk_fp8_f32(X0[4 * ((w) & 3)], X0[4 * ((w) & 3) + 1], PAC[w], false); PAC[w] = __builtin_amdgcn_cvt_pk_fp8_f32(X0[4 * ((w) & 3) + 2], X0[4 * ((w) & 3) + 3], (int)w_, true); } \
      else { unsigned w_ = (unsigned)__builtin_amdgcn_cvt_pk_fp8_f32(X1[4 * ((w) & 3)], X1[4 * ((w) & 3) + 1], PAC[w], false); PAC[w] = __builtin_amdgcn_cvt_pk_fp8_f32(X1[4 * ((w) & 3) + 2], X1[4 * ((w) & 3) + 3], (int)w_, true); } } while (0)
#define PVM(PAP, g) do { PIN1(vv##g); o[4 * ((g) & 1) + ((g) >> 1)] = MFMA8(PAP, vv##g, o[4 * ((g) & 1) + ((g) >> 1)]); asm volatile("" :: "v"(o[4 * ((g) & 1) + ((g) >> 1)])); } while (0)
#define LDVG(g) ({ int o_ = sv * SB + 8192 + 8192 * ((g) & 1); asm volatile("" : "+s"(o_)); LDV8(lds + o_, (g) >> 1); })
#define WSTEP(PAP, PAC, FIRST, TNEXT) do { \
      { const v8i32a ka_ = LDK8(SLOT(sk), 0, 0), kb_ = LDK8(SLOT(sk), 0, 1), kc_ = LDK8(SLOT(sk), 1, 0), kd_ = LDK8(SLOT(sk), 1, 1); \
        const v8i32a q0_ = ld32_l(q_l, q_l + 1024), q1_ = ld32_l(q_l + 2048, q_l + 3072); \
        X0 = MFMA8(ka_, q0_, f32x16{}); X1 = MFMA8(kb_, q0_, f32x16{}); X0 = MFMA8(kc_, q1_, X0); X1 = MFMA8(kd_, q1_, X1); PIN1(X1); } \
      DMA8(sd, TNEXT); \
      v8i32a vv0 = LDVG(0), vv1 = LDVG(1); \
      PVM(PAP, 0); v8i32a vv2 = LDVG(2); \
      float pm_ = X0[0]; _Pragma("unroll") for (int r = 1; r < 16; ++r) pm_ = fmaxf(pm_, X0[r]); PIN1(pm_); \
      PVM(PAP, 1); v8i32a vv3 = LDVG(3); \
      _Pragma("unroll") for (int r = 0; r < 16; ++r) pm_ = fmaxf(pm_, X1[r]); \
      { auto rr = __builtin_amdgcn_permlane32_swap(__float_as_uint(pm_), __float_as_uint(pm_), false, false); pm_ = fmaxf(__uint_as_float(rr[0]), __uint_as_float(rr[1])); } \
      const float mn_ = (FIRST) ? pm_ : ((pm_ - m_reg > THR8) ? pm_ : m_reg); const float dl_ = (FIRST) ? 0.f : mn_ - m_reg; m_reg = mn_; float cn = 7.0f - mn_; float ps = 0.f; PIN1(cn); \
      PVM(PAP, 2); v8i32a vv4 = LDVG(4); EXPR(0, 6); PKW(PAC, 0); \
      PVM(PAP, 3); v8i32a vv5 = LDVG(5); EXPR(6, 6); PKW(PAC, 1); PKW(PAC, 2); \
      PVM(PAP, 4); v8i32a vv6 = LDVG(6); EXPR(12, 5); PKW(PAC, 3); \
      PVM(PAP, 5); v8i32a vv7 = LDVG(7); EXPR(17, 5); PKW(PAC, 4); \
      PVM(PAP, 6); EXPR(22, 5); PKW(PAC, 5); \
      PVM(PAP, 7); EXPR(27, 5); PKW(PAC, 6); PKW(PAC, 7); \
      { auto rr = __builtin_amdgcn_permlane32_swap(__float_as_uint(ps), __float_as_uint(ps), false, false); ps = __uint_as_float(rr[0]) + __uint_as_float(rr[1]); } \
      if (__any(dl_ > 0.f)) { const float al_ = __builtin_amdgcn_exp2f(-dl_); l_reg *= al_; if (hi == 0) al_l[r32] = al_; asm volatile("s_waitcnt lgkmcnt(0)" ::: "memory"); \
        for (int d = 0; d < 8; ++d) for (int r = 0; r < 16; ++r) o[d][r] *= al_l[crow(r, hi)]; } \
      l_reg += ps; \
      SADV(); DWAIT8(); } while (0)
  f32x16 X0, X1; v8i32a paA = {}, paB = {}; const int NT = seq / KVBLK;
  int sk = 0, sv = 0, sd = PD;
  DMA8(0, 0); DMA8(1, 1);
  DWAIT8();
  for (int j = 0; j < NT; j += 2) {
    WSTEP(paB, paA, j == 0, min(j + PD, NT - 1));
    WSTEP(paA, paB, false, min(j + 1 + PD, NT - 1));
  }
  { v8i32a vv0 = LDVG(0), vv1 = LDVG(1), vv2 = LDVG(2), vv3 = LDVG(3); PVM(paB, 0); PVM(paB, 1); PVM(paB, 2); PVM(paB, 3); }
  { v8i32a vv4 = LDVG(4), vv5 = LDVG(5), vv6 = LDVG(6), vv7 = LDVG(7); PVM(paB, 4); PVM(paB, 5); PVM(paB, 6); PVM(paB, 7); }
  asm volatile("s_waitcnt vmcnt(0)" ::: "memory");
  int te = tid; asm volatile("" : "+v"(te));
  const int wid_e = te >> 6, r32_e = te & 31, hi_e = (te >> 5) & 1;
  LAS float* li_e = (LAS float*)(lds + RS * SB + 1024) + wid_e * 32;
  if (hi_e == 0) li_e[r32_e] = l_reg; asm volatile("s_waitcnt lgkmcnt(0)" ::: "memory");
  float rli[16];
#pragma unroll
  for (int r = 0; r < 16; ++r) rli[r] = __builtin_amdgcn_rcpf(li_e[crow(r, hi_e)]);
  bf16_t* Ow = Ob + (long)(wid_e * QBLK) * LDO;
#pragma unroll
  for (int r = 0; r < 16; ++r) { int orow = crow(r, hi_e);
    for (int d0 = 0; d0 < 8; ++d0) Ow[(long)orow * LDO + d0 * 32 + r32_e] = (bf16_t)(cvtpk(o[d0][r] * rli[r], 0.f) & 0xffffu); }
#undef DMA8
#undef DWAIT8
#undef SLOT
#undef SADV
#undef LDK8
#undef LDV8
#undef PIN1
#undef EXPR
#undef PKW
#undef PVM
#undef LDVG
#undef WSTEP
}

constexpr int PV_BUF = 32768, PK_BUF = 16384, P_LDS_V = 0, P_LDS_K = 2 * PV_BUF, P_LDS_X = P_LDS_K + 2 * PK_BUF, P_LDS_L = P_LDS_X + 8 * 2048, P_LDS_END = P_LDS_L + 1024;
__device__ __forceinline__ void qkt_half(f32x16& p, const LAS char* Ks, const bf16x8* qr, int krow, int hi) {
  p = f32x16{};
  for (int d0 = 0; d0 < 8; ++d0) { int cb = (d0 * 16 + hi * 8) * 2;
    bf16x8 b0 = *reinterpret_cast<const LAS bf16x8*>(Ks + KSWZ(krow, cb));
    p = __builtin_amdgcn_mfma_f32_32x32x16_bf16(b0, qr[d0], p, 0, 0, 0); }
}
__device__ __forceinline__ void smA(f32x16& p, float negMC) {
  constexpr float Cc = SCALE * 1.4426950408889634f;
  for (int r = 0; r < 16; ++r) p[r] = fmaf(p[r], Cc, negMC);
  for (int r = 0; r < 8; ++r) p[r] = __builtin_amdgcn_exp2f(p[r]);
}
__device__ __forceinline__ void smB(f32x16& p, float& l_reg, bf16x8& f0, bf16x8& f1) {
  for (int r = 8; r < 16; ++r) p[r] = __builtin_amdgcn_exp2f(p[r]);
  float ps = 0; for (int r = 0; r < 16; ++r) ps += p[r];
  { auto rr = __builtin_amdgcn_permlane32_swap(__float_as_uint(ps), __float_as_uint(ps), false, false);
    ps = __uint_as_float(rr[0]) + __uint_as_float(rr[1]); }
  l_reg += ps;
#define PK4(P, BASE, OUT) do { unsigned a0 = cvtpk(P[BASE + 0], P[BASE + 1]), a1 = cvtpk(P[BASE + 2], P[BASE + 3]);   \
    unsigned b0 = cvtpk(P[BASE + 4], P[BASE + 5]), b1 = cvtpk(P[BASE + 6], P[BASE + 7]);                              \
    auto r0 = __builtin_amdgcn_permlane32_swap(a0, b0, false, false); auto r1 = __builtin_amdgcn_permlane32_swap(a1, b1, false, false); \
    u32x4 w = {r0[0], r1[0], r0[1], r1[1]}; OUT = *reinterpret_cast<bf16x8*>(&w); } while (0)
  PK4(p, 0, f0); PK4(p, 8, f1);
#undef PK4
}
template <int LDQ, int LDK, int LDO>
__device__ __forceinline__ void attn_pair_body(const bf16_t* __restrict__ Qb, const bf16_t* __restrict__ Kh, const bf16_t* __restrict__ Vh, bf16_t* __restrict__ Ob, int seq, LAS char* lds, int tid, float kmax2) {
  const int wid = __builtin_amdgcn_readfirstlane(tid >> 6), lane = tid & 63, r32 = lane & 31, hi = lane >> 5, g = wid & 3, kb = wid >> 2;
  LAS char* V_lds = lds + P_LDS_V; LAS char* K_lds = lds + P_LDS_K;
  LAS char* xp_own = lds + P_LDS_X + wid * 2048 + lane * 16; LAS char* xp_par = lds + P_LDS_X + (wid ^ 4) * 2048 + lane * 16;
  LAS float* li = (LAS float*)(lds + P_LDS_L);
  float l_reg = 0; f32x16 o[4] = {}; bf16x8 qr[8];
  const bf16_t* Qw = Qb + (long)(g * QBLK + r32) * LDQ + hi * 8;
#pragma unroll
  for (int d0 = 0; d0 < 8; ++d0) qr[d0] = *reinterpret_cast<const bf16x8*>(Qw + d0 * 16);
  float negMC;
  { float q2 = 0.f;
#pragma unroll
    for (int d0 = 0; d0 < 8; ++d0) { const u32x4 w = __builtin_bit_cast(u32x4, qr[d0]);
      q2 += bflo(w.x) * bflo(w.x) + bfhi(w.x) * bfhi(w.x) + bflo(w.y) * bflo(w.y) + bfhi(w.y) * bfhi(w.y) + bflo(w.z) * bflo(w.z) + bfhi(w.z) * bfhi(w.z) + bflo(w.w) * bflo(w.w) + bfhi(w.w) * bfhi(w.w); }
    auto rr = __builtin_amdgcn_permlane32_swap(__float_as_uint(q2), __float_as_uint(q2), false, false);
    q2 = __uint_as_float(rr[0]) + __uint_as_float(rr[1]);
    negMC = -(sqrtf(q2 * kmax2) * (SCALE * 1.0001f) - 30.0f) * 1.4426950408889634f; }
  const int sr = tid >> 4, sc = (tid & 15) * 8, vst0 = v_st(sr, sc), vst1 = v_st(32 + sr, sc);
  const int vrd = (int)(uintptr_t)V_lds + kb * 16384 + v_rd_base(lane);
  const int krow = 32 * kb + r32;
  struct { bf16x8 v00, v01, v10, v11, k0, k1; } st_;
#define PLD16(base, off) (*reinterpret_cast<const bf16x8*>((const char*)(base) + (off)))
#define PLOAD(k0_) do { const unsigned o_ = (unsigned)(((k0_) + sr) * LDK + sc) * 2u; \
    st_.v00 = PLD16(Vh, o_); st_.v01 = PLD16(Vh, o_ + 256u); st_.v10 = PLD16(Vh, o_ + 64u * LDK); st_.v11 = PLD16(Vh, o_ + 64u * LDK + 256u); \
    st_.k0 = PLD16(Kh, o_); st_.k1 = PLD16(Kh, o_ + 64u * LDK); } while (0)
#define PWRITE(kbuf, vbuf) do { LAS char* vb_ = V_lds + (vbuf) * PV_BUF; LAS char* kb_ = K_lds + (kbuf) * PK_BUF; const int kc = sc * 2; \
    *(LAS bf16x8*)(vb_ + vst0) = st_.v00; *(LAS bf16x8*)(vb_ + 16384 + vst0) = st_.v01; *(LAS bf16x8*)(vb_ + vst1) = st_.v10; *(LAS bf16x8*)(vb_ + 16384 + vst1) = st_.v11; \
    *(LAS bf16x8*)(kb_ + KSWZ(sr, kc)) = st_.k0; *(LAS bf16x8*)(kb_ + KSWZ(32 + sr, kc)) = st_.k1; } while (0)
  const int NT = seq / KVBLK;
  f32x16 pS; bf16x8 f0, f1, g0, g1;
  PLOAD(0); asm volatile("s_waitcnt vmcnt(0)" ::: "memory"); PWRITE(0, 0); PLOAD(KVBLK);
  __syncthreads();
  for (int j = 0; j < NT; ++j) {
    SBAR();
    qkt_half(pS, K_lds + (j & 1) * PK_BUF, qr, krow, hi);
    smA(pS, negMC); smB(pS, l_reg, f0, f1); SBAR();
    *(LAS bf16x8*)(xp_own) = f0; *(LAS bf16x8*)(xp_own + 1024) = f1;
    if (j + 1 < NT) PWRITE((j + 1) & 1, (j + 1) & 1);
    if (j + 2 < NT) PLOAD((j + 2) * KVBLK);
    __syncthreads();
    g0 = *(const LAS bf16x8*)(xp_par); g1 = *(const LAS bf16x8*)(xp_par + 1024);
    { const int vb = vrd + (j & 1) * PV_BUF;
      if (kb == 0) pv_d0(o, vb, f0, f1, g0, g1); else pv_d0(o, vb, g0, g1, f0, f1); }
    __syncthreads();
  }
  if (hi == 0) li[wid * 32 + r32] = l_reg;
  __syncthreads();
#pragma unroll
  for (int r = 0; r < 16; ++r) { const int orow = crow(r, hi); const float rl = __builtin_amdgcn_rcpf(li[wid * 32 + orow] + li[(wid ^ 4) * 32 + orow]);
    bf16_t* op = Ob + (long)(g * QBLK + orow) * LDO + 128 * kb + r32;
    for (int d0 = 0; d0 < 4; ++d0) op[d0 * 32] = (bf16_t)(cvtpk(o[d0][r] * rl, 0.f) & 0xffffu); }
#undef PLD16
#undef PLOAD
#undef PWRITE
}
#undef KSWZ
}

__device__ __forceinline__ void phase_attention(const Params& p, Ctx& C) {
    bf16_t* ATT = (bf16_t*)(p.ws + WS_BIG + BG_ATT);
    const unsigned char* Q8 = (const unsigned char*)(p.ws + WS_BIG + BG_Q8); const unsigned char* K8 = (const unsigned char*)(p.ws + WS_BIG + BG_K8); const unsigned char* VT8 = (const unsigned char*)(p.ws + WS_BIG + BG_VT8);
    const unsigned char* Q8D = (const unsigned char*)(p.ws + WS_BIG + BG_Q8D); const unsigned char* K8D = (const unsigned char*)(p.ws + WS_BIG + BG_K8D); const unsigned char* VT8D = (const unsigned char*)(p.ws + WS_BIG + BG_VT8D);
    for (int i = 0;; ++i) {
        int unit;
        if (C.G == 256) { if (i >= 2) break; unit = (C.bid & 7) * 64 + i * 32 + (C.bid >> 3); } else { unit = i * C.G + C.bid; if (unit >= 512) break; }
        const int d = unit >> 6, qb = unit & 63, hh = d >> 1, m = d & 1;
        __syncthreads();
        int tz = C.tid; asm volatile("" : "+v"(tz));
        att::attn_dense8w_body<3072, 1024>(Q8D + (size_t)(CTXL + 256 * qb) * 1024 + 128 * d, K8D + 128 * d, VT8D + (size_t)(2 * hh) * 260 * 8192, VT8D + (size_t)(2 * hh + 1) * 260 * 8192,
                                           ATT + (size_t)(256 * qb) * 3072 + 1024 + 1024 * m + 256 * hh, TT, (LAS char*)C.lds, tz, 0.f);
    }
    for (int i = 0;; ++i) {
        int unit;
        if (C.G == 256) { if (i >= 2) break; unit = (C.bid & 7) * 64 + i * 32 + (C.bid >> 3); } else { unit = i * C.G + C.bid; if (unit >= 512) break; }
        const int prob = unit >> 6, qb = unit & 63;
        __syncthreads();
        int tz = C.tid; asm volatile("" : "+v"(tz));
        att::attn_dense8_body<3072, 256>(Q8 + (size_t)(CTXL + 256 * qb) * 1024 + 128 * prob, K8 + 128 * (prob >> 2), VT8 + (size_t)(prob >> 2) * 260 * 8192,
                                         ATT + (size_t)(256 * qb) * 3072 + 128 * prob, TT, (LAS char*)C.lds, tz, 0.f);
    }
    __syncthreads();
}
constexpr int PH_PER_LAYER = 13, N_PHASES = 2 + 2 * PH_PER_LAYER;
#ifndef DBL_PHASE
#define DBL_PHASE -1
#endif
#ifndef MK_PER_PHASE
#define MK_PER_PHASE 0
#endif

template <int L>
__device__ __forceinline__ void layer_body(const Params& p, Ctx& C0, const XcdBarrier& bar, LAS unsigned char* misc, int lo, int hi) {
#define IN(k) (lo <= (k) && (k) < hi)
#define SEAM(k) do { if (IN(k) && IN((k) + 1)) xcd_barrier(bar, C0.wave); } while (0)
#define PHASE(k, ...) if (DBL_PHASE == (k)) { int nrep_ = 2; asm volatile("" : "+s"(nrep_)); for (int rep_ = 0; rep_ < nrep_; ++rep_) { if (rep_) xcd_barrier(bar, C0.wave); FRESH(); __VA_ARGS__ } } else if (IN(k)) { FRESH(); __VA_ARGS__ } SEAM(k);
#define FRESH() Ctx C = C0; { int ln = (int)__builtin_amdgcn_mbcnt_hi(~0u, __builtin_amdgcn_mbcnt_lo(~0u, 0u)); asm volatile("" : "+v"(ln)); C.lane = ln; C.tid = C.wave * 64 + ln; }
        const int b = 2 + PH_PER_LAYER * L;
        bf16_t* QKV = (bf16_t*)(p.ws + WS_BIG + BG_QKV);
        bf16_t* XA = (bf16_t*)(p.ws + WS_XA);
        int* cnt = (int*)(p.ws + WS_CTL) + CW_CNT + L * 128; const int* LIST = (const int*)(p.ws + WS_LIST);
        if (L == 0) { PHASE(b + 0, phase_modulate(p, C, L); ) }
        PHASE(b + 1,
            const int N = L ? OD_IN : EV_IN;
            pg8::DenseOrder S; S.init8((const void*)XA, DM, (const void*)(p.ws + (L ? WS_WIN1 : WS_WIN0)), TT, N, DM, C.G, C.bid);
            pg8::EpiStore E{QKV, N, 1.0f / 32.0f};
            pg8::gemm_phase<true>(C.lds, S, E, C.wave);
            if (L == 0 && IN(b + 2) && S.units_of_me() < S.max_units()) conv_queue(p, C, 2);
        )
        PHASE(b + 2, if (L == 0) phase_rope0(p, C); else phase_normrope1(p, C); )
        PHASE(b + 3, if (L == 0) { ret_chunk_kv(p, C); s5_end_states(p, C); } else phase_attention(p, C); )
        PHASE(b + 4, if (L == 0) phase_scans(p, C); else phase_merge1(p, C); )
        if (L == 0) {
            PHASE(b + 5, phase_ret_s5_outputs(p, C, misc); )
            PHASE(b + 6,
                pg8::DenseOrder S; S.init((const bf16_t*)(p.ws + WS_Z), 1024, (const bf16_t*)(p.ws + WS_WGLU), TT, 1024, 1024, C.G, C.bid);
                pg8::EpiGlu E{(const bf16_t*)(p.ws + WS_Z), p.inp(20), (bf16_t*)(p.ws + WS_BIG + BG_MIX)};
                pg8::gemm_phase<false>(C.lds, S, E, C.wave);
                if (IN(b + 7) && S.units_of_me() < S.max_units()) conv_queue(p, C, 4);
            )
        }
        PHASE(b + 7,
            pg8::DenseOrder S;
            if (L == 0) S.init((const bf16_t*)(p.ws + WS_BIG + BG_MIX), DM, (const bf16_t*)(p.ws + WS_WOUT0), TT, DM, DM, C.G, C.bid);
            else S.init((const bf16_t*)(p.ws + WS_BIG + BG_ATT), 3072, (const bf16_t*)(p.ws + WS_WOUT1), SEQ, DM, DM, C.G, C.bid);
            pg8::EpiStore E{(bf16_t*)(p.ws + WS_YMIX) + (L ? (size_t)CTXL * DM : 0), DM, 1.0f};
            pg8::gemm_phase<false>(C.lds, S, E, C.wave);
            if (L == 0 && IN(b + 8) && S.units_of_me() < S.max_units()) conv_queue(p, C, 5);
        )
        PHASE(b + 8, phase_ln1(p, C, L); )
        PHASE(b + 9, phase_router(p, C, L); )
        PHASE(b + 10,
            pg8::MoeOrder<0> S; S.A = (const void*)XA; S.Bt = (const void*)(p.ws + WS_GU + (size_t)L * NEX1 * 1024 * DM); S.list = LIST; S.cnt = cnt; S.ldab = DM; S.kb = DM; S.nN = 4; S.G = C.G; S.c = C.bid; S.bstride = (size_t)1024 * DM;
            S.prep(misc, C.tid);
            pg8::EpiE1 E{(unsigned char*)(p.ws + WS_HX2), S.cn, S.rb};
            pg8::gemm_phase<true>(C.lds, S, E, C.wave);
        )
        PHASE(b + 11,
            pg8::MoeOrder<1> S; S.A = (const void*)(p.ws + WS_HX2); S.Bt = (const void*)(p.ws + WS_DT + (size_t)L * NEX1 * DM * EHID); S.list = LIST; S.cnt = cnt; S.ldab = EHID; S.kb = EHID; S.nN = 8; S.G = C.G; S.c = C.bid; S.bstride = (size_t)DM * EHID;
            S.prep(misc, C.tid);
            pg8::EpiE2 E{(unsigned char*)(p.ws + WS_BIG + BG_YMOE), (const float*)(p.ws + WS_LW), S.cn, S.rb};
            pg8::gemm_phase<true>(C.lds, S, E, C.wave);
        )
        PHASE(b + 12, phase_combine(p, C, L, misc); )
    #undef IN
#undef SEAM
#undef FRESH
#undef PHASE
}

__global__ void __launch_bounds__(NTHR, 2) mega_fwd(KArgs ka) {
    extern __shared__ __attribute__((aligned(16))) unsigned char lds_raw[];
    Ctx C;
    C.lds = (LAS unsigned char*)lds_raw;
    C.tid = threadIdx.x; C.lane = C.tid & 63; C.wave = __builtin_amdgcn_readfirstlane(C.tid >> 6);
    C.G = gridDim.x; C.bid = blockIdx.x; C.gw = C.bid * NWAVES + C.wave; C.ngw = C.G * NWAVES;
    LAS unsigned char* misc = C.lds + MISC_OFF;
    if (C.tid < 8) ((volatile LAS unsigned*)misc)[C.tid] = 0u;
    Params p; p.out = ka.out; p.ws = ka.ws; p.ph_lo = ka.ph_lo; p.ph_hi = ka.ph_hi; p.ptab = (LAS unsigned long long*)(misc + 1024);
    if (C.tid < 34) p.ptab[C.tid] = (unsigned long long)ka.in[C.tid];
    __syncthreads();
    const int lo = p.ph_lo, hi = p.ph_hi;
    XcdBarrier bar; bar.bar = (unsigned*)(p.ws + WS_CTL) + CW_BAR; bar.x = 0; bar.st = (volatile LAS unsigned*)misc;
    if (hi - lo > 1) bar = xcd_barrier_post((unsigned*)(p.ws + WS_CTL) + CW_BAR, (volatile LAS unsigned*)misc);
#define IN(k) (lo <= (k) && (k) < hi)
#define SEAM(k) do { if (IN(k) && IN((k) + 1)) xcd_barrier(bar, C.wave); } while (0)

    if (IN(0)) { phase_p0(p, C); } SEAM(0);
    if (IN(1)) { phase_p1(p, C); } SEAM(1);
    if (IN(0) && IN(2) && (C.G & 7) == 0) {
        volatile LAS unsigned* st = (volatile LAS unsigned*)misc;
        if (C.tid == 0) { unsigned pre = 0u; const unsigned x = st[3];
            for (unsigned j = 0; j < 16; ++j) { const unsigned cj = xb_ld(&bar.bar[XB_XCNT(j)]); pre += (j < x) ? cj : 0u; }
            st[4] = pre + st[2]; }
        __syncthreads();
        const int vcu = (int)st[4], g8 = C.G >> 3;
        C.bid = __builtin_amdgcn_readfirstlane((vcu % g8) * 8 + vcu / g8); C.gw = C.bid * NWAVES + C.wave;
    }

    layer_body<0>(p, C, bar, misc, lo, hi);
    layer_body<1>(p, C, bar, misc, lo, hi);
#undef IN
#undef SEAM
}

extern "C" void kernel_launch(void* const* d_in, const int* in_sizes, int n_in, void* d_out, int out_size, void* d_ws, size_t ws_size, hipStream_t stream) {
    static int grid = 0;
    if (grid == 0) {
        if (n_in != 34 || out_size != SEQ * DM || ws_size < WS_END) { fprintf(stderr, "kernel_launch: unexpected shapes: n_in %d out %d ws %zu (need %zu)\n", n_in, out_size, ws_size, (size_t)WS_END); grid = -1; return; }
        int dev = 0, cus = 0, per_cu = 0;
        if (hipGetDevice(&dev) != hipSuccess || hipDeviceGetAttribute(&cus, hipDeviceAttributeMultiprocessorCount, dev) != hipSuccess) { grid = -1; return; }
        if (hipFuncSetAttribute((const void*)mega_fwd, hipFuncAttributeMaxDynamicSharedMemorySize, LDS_BYTES) != hipSuccess) { fprintf(stderr, "kernel_launch: hipFuncSetAttribute failed\n"); grid = -1; return; }
        if (hipOccupancyMaxActiveBlocksPerMultiprocessor(&per_cu, (const void*)mega_fwd, NTHR, LDS_BYTES) != hipSuccess || per_cu < 1) { fprintf(stderr, "kernel_launch: occupancy query says %d blocks per CU\n", per_cu); grid = -1; return; }
        (void)hipGetLastError();
        grid = cus;
    }
    if (grid < 0) return;
    (void)hipMemsetAsync((char*)d_ws + WS_CTL, 0, CTL_BYTES, stream);
    KArgs p{};
    for (int i = 0; i < 34; ++i) p.in[i] = (const float*)d_in[i];
    p.out = (float*)d_out; p.ws = (unsigned char*)d_ws;
#if MK_PER_PHASE
    for (int ph = 0; ph < N_PHASES; ++ph) {
        if (ph == 2 + PH_PER_LAYER + 0 || ph == 2 + PH_PER_LAYER + 5 || ph == 2 + PH_PER_LAYER + 6) continue;
        p.ph_lo = ph; p.ph_hi = ph + 1;
        hipLaunchKernelGGL(mega_fwd, dim3(grid), dim3(NTHR), LDS_BYTES, stream, p);
    }
#else
    p.ph_lo = 0; p.ph_hi = N_PHASES;
    hipLaunchKernelGGL(mega_fwd, dim3(grid), dim3(NTHR), LDS_BYTES, stream, p);
#endif
    const hipError_t le = hipPeekAtLastError();
    if (le != hipSuccess) fprintf(stderr, "kernel_launch: launch failed: %s\n", hipGetErrorName(le));
}
```

```cpp
#define MK_PER_PHASE 0
#include <hip/hip_runtime.h>
#include <cstdio>
#include <cstdint>

#define GAS __attribute__((address_space(1)))
#define LAS __attribute__((address_space(3)))
typedef unsigned short bf16_t;
typedef short bf16x8 __attribute__((ext_vector_type(8)));
typedef short s16x4 __attribute__((ext_vector_type(4)));
typedef float f32x4 __attribute__((ext_vector_type(4)));
typedef float f32x2 __attribute__((ext_vector_type(2)));
typedef float f32x16 __attribute__((ext_vector_type(16)));
typedef unsigned u32x4 __attribute__((ext_vector_type(4)));
typedef unsigned u32x2 __attribute__((ext_vector_type(2)));

constexpr int DM = 2048, SEQ = 16384, CTXL = 256, TT = SEQ + CTXL;
constexpr int NEXP = 64, NEX1 = 65, EHID = 512, TOPK = 8;
constexpr int EV_IN = 5120, OD_IN = 4608;
constexpr float LN_EPS = 1e-6f;
constexpr float ALPHA = 1.4142135623730951f;
constexpr float LAMBDA_INIT = 0.35550906759f;
constexpr int NTHR = 512, NWAVES = 8;

constexpr size_t al256(size_t x) { return (x + 255) / 256 * 256; }
constexpr size_t WS_CTL   = 0;
constexpr size_t CTL_BYTES = 1u << 20;
constexpr size_t WS_MODP  = WS_CTL + CTL_BYTES;
constexpr size_t WS_MODF  = WS_MODP + al256((size_t)2 * 32 * 2 * 12288 * 4);
constexpr size_t WS_ROPE128 = WS_MODF + al256((size_t)2 * 2 * 12288 * 4);
constexpr size_t WS_ROPE64  = WS_ROPE128 + al256((size_t)256 * 64 * 2 * 4);
constexpr size_t WS_KN    = WS_ROPE64 + al256((size_t)256 * 32 * 2 * 4);
constexpr size_t WS_WT    = WS_KN + al256((size_t)2 * 64 * 16 * 1024 * 2);
constexpr size_t WS_APOW  = WS_WT + al256((size_t)2 * 64 * 128 * 1024 * 2);
constexpr size_t WS_AL    = WS_APOW + al256((size_t)2 * 64 * 64 * 128 * 4);
constexpr size_t WS_CC    = WS_AL + al256((size_t)2 * 64 * 128 * 4);
constexpr size_t WS_BBT   = WS_CC + al256((size_t)64 * 16 * 128 * 2);
constexpr size_t WS_S5E   = WS_BBT + al256((size_t)2 * 64 * 128 * 16 * 2);
constexpr size_t WS_HST   = WS_S5E + al256((size_t)2 * 64 * 260 * 128 * 4);
constexpr size_t WS_WIN0  = WS_HST + al256((size_t)2 * 64 * 260 * 128 * 4);
constexpr size_t WS_WOUT0 = WS_WIN0 + al256((size_t)EV_IN * DM * 2);
constexpr size_t WS_WGLU  = WS_WOUT0 + al256((size_t)DM * DM * 2);
constexpr size_t WS_WIN1  = WS_WGLU + al256((size_t)1024 * 1024 * 2);
constexpr size_t WS_WOUT1 = WS_WIN1 + al256((size_t)OD_IN * DM * 2);
constexpr size_t WS_RWT   = WS_WOUT1 + al256((size_t)DM * DM * 2);
constexpr size_t WS_GU    = WS_RWT + al256((size_t)2 * 2 * 64 * DM * 2);
constexpr size_t WS_DT    = WS_GU + al256((size_t)NEX1 * 1024 * DM * 2);
constexpr size_t WS_XA    = WS_DT + al256((size_t)NEX1 * DM * EHID * 2);
constexpr size_t WS_Z     = WS_XA + al256((size_t)TT * DM * 2);
constexpr size_t WS_YMIX  = WS_Z + al256((size_t)TT * 1024 * 2);
constexpr size_t WS_X1    = WS_YMIX + al256((size_t)TT * DM * 2);
constexpr size_t WS_HX2   = WS_X1 + al256((size_t)TT * DM * 4);
constexpr size_t WS_LIST  = WS_HX2 + al256((size_t)9 * TT * EHID * 2);
constexpr size_t WS_WGT   = WS_LIST + al256((size_t)NEX1 * TT * 4);
constexpr size_t WS_LW    = WS_WGT + al256((size_t)8 * TT * 4);
constexpr size_t WS_BIG   = WS_LW + al256((size_t)NEX1 * TT * 4);
constexpr size_t BG_QKV   = 0;
constexpr size_t BG_CKV   = BG_QKV + al256((size_t)TT * EV_IN * 2);
constexpr size_t BG_SPREV = BG_CKV + al256((size_t)8 * 130 * 65536 * 4);
constexpr size_t BG_MIX   = BG_SPREV + al256((size_t)8 * 130 * 65536 * 2);
constexpr size_t BG_END0  = BG_MIX + al256((size_t)TT * DM * 2);
constexpr size_t BG_ATT   = BG_CKV;
constexpr size_t BG_Q8    = BG_ATT + al256((size_t)SEQ * 3072 * 2);
constexpr size_t BG_K8    = BG_Q8 + al256((size_t)TT * 1024);
constexpr size_t BG_VT8   = BG_K8 + al256((size_t)TT * 256);
constexpr size_t BG_Q8D   = BG_VT8 + al256((size_t)2 * 260 * 128 * 64);
constexpr size_t BG_K8D   = BG_Q8D + al256((size_t)TT * 1024);
constexpr size_t BG_VT8D  = BG_K8D + al256((size_t)TT * 1024);
constexpr size_t BG_F8END = BG_VT8D + al256((size_t)8 * 260 * 128 * 64);
constexpr size_t BG_YMOE  = 0;
constexpr size_t BG_END1  = al256((size_t)9 * TT * DM * 2);
constexpr size_t BG_SIZE  = BG_END0 > BG_END1 ? BG_END0 : BG_END1;
static_assert(BG_F8END <= BG_SIZE, "fp8 attention operands inside the big region");
constexpr size_t WS_END   = WS_BIG + BG_SIZE;

constexpr int CW_BAR = 4096;
constexpr int CW_CNT = 16384;
constexpr int CW_QUEUE = 20480;
constexpr int CW_KMAX = 24576;

constexpr int RING_BYTES = 151552;
constexpr int MISC_OFF = RING_BYTES;
constexpr int LDS_BYTES = 159744;

typedef __bf16 bf16x2_t __attribute__((ext_vector_type(2)));
__device__ __forceinline__ unsigned cvt_pk_bf16(float lo, float hi) { const f32x2 v = {lo, hi}; return __builtin_bit_cast(unsigned, __builtin_convertvector(v, bf16x2_t)); }
__device__ __forceinline__ bf16_t f2bf(float f) { unsigned u = __builtin_bit_cast(unsigned, f); return (bf16_t)((u + 0x7fffu + ((u >> 16) & 1u)) >> 16); }
__device__ __forceinline__ float bf2f(bf16_t b) { return __builtin_bit_cast(float, ((unsigned)b) << 16); }
__device__ __forceinline__ float bflo(unsigned w) { return __builtin_bit_cast(float, w << 16); }
__device__ __forceinline__ float bfhi(unsigned w) { return __builtin_bit_cast(float, w & 0xffff0000u); }
__device__ __forceinline__ float wave_sum(float v) {
#pragma unroll
    for (int o = 1; o < 64; o <<= 1) v += __shfl_xor(v, o);
    return v;
}
__device__ __forceinline__ float fast_exp(float x) { return __builtin_amdgcn_exp2f(x * 1.4426950408889634f); }
__device__ __forceinline__ float sigmoidf_(float x) { return 1.0f / (1.0f + __expf(-x)); }
__device__ __forceinline__ float siluf_(float x) { return x / (1.0f + __expf(-x)); }
__device__ __forceinline__ float gelu_tanh(float x) {
    const float u = 0.7978845608028654f * (x + 0.044715f * x * x * x);
    const float e = __expf(2.0f * u);
    const float t = 1.0f - 2.0f / (e + 1.0f);
    return 0.5f * x * (1.0f + t);
}
#define LDS_WAIT() asm volatile("s_waitcnt lgkmcnt(0)" ::: "memory")
#define VM_WAIT() asm volatile("s_waitcnt vmcnt(0)" ::: "memory")

#define XB_TMO      128
#define XB_XCNT(j)  (256  + 64 * (j))
#define XB_XSUB(j)  (1280 + 64 * (j))
#define XB_XGEN(j)  (2304 + 64 * (j))
#define XB_TOP      3328
#define XB_TOPGEN   3392
#define XCD_BAR_WORDS 3456
#define XB_SPIN_CAP (1u << 22)

__device__ __forceinline__ unsigned xb_ld(unsigned* p)              { return __hip_atomic_load(p, __ATOMIC_RELAXED, __HIP_MEMORY_SCOPE_AGENT); }
__device__ __forceinline__ unsigned xb_add(unsigned* p, unsigned v) { return __hip_atomic_fetch_add(p, v, __ATOMIC_RELAXED, __HIP_MEMORY_SCOPE_AGENT); }
__device__ __forceinline__ unsigned xb_xcc_id() { return (unsigned)__builtin_amdgcn_s_getreg((3 << 11) | 20) & 0xFu; }
#define XB_SPIN(cond, bar) do { unsigned _sp = 0; while (cond) { __builtin_amdgcn_s_sleep(1); \
    if ((++_sp & 255u) == 0u) { if (xb_ld(&(bar)[XB_TMO])) break; if (_sp > XB_SPIN_CAP) { atomicAdd(&(bar)[XB_TMO], 1u); break; } } } } while (0)

struct XcdBarrier { unsigned* bar; unsigned x; volatile LAS unsigned* st; };

__device__ __forceinline__ XcdBarrier xcd_barrier_post(unsigned* bar, volatile LAS unsigned* st) {
    XcdBarrier b; b.bar = bar; b.x = xb_xcc_id(); b.st = st;
    if (threadIdx.x == 0) { st[2] = xb_add(&bar[XB_XCNT(b.x)], 1u); st[3] = b.x; }
    return b;
}
__device__ __forceinline__ void xcd_barrier_complete(unsigned* bar, unsigned x, unsigned& nloc, unsigned& nx) {
    const unsigned G = gridDim.x * gridDim.y * gridDim.z;
    unsigned sum, cnt, mine, sp = 0u;
    for (;;) {
        sum = 0u; cnt = 0u; mine = 0u;
#pragma unroll
        for (unsigned j = 0; j < 16; ++j) { const unsigned c = xb_ld(&bar[XB_XCNT(j)]); sum += c; cnt += (c > 0u) ? 1u : 0u; mine = (j == x) ? c : mine; }
        if (sum == G) break;
        __builtin_amdgcn_s_sleep(1);
        if ((++sp & 255u) == 0u) { if (xb_ld(&bar[XB_TMO])) break; if (sp > XB_SPIN_CAP) { atomicAdd(&bar[XB_TMO], 1u); break; } }
    }
    nloc = mine > 0u ? mine : 1u; nx = cnt > 0u ? cnt : 1u;
}
__device__ __forceinline__ void xcd_barrier(const XcdBarrier& b, int wave_id) {
    const bool leader_thread = (wave_id == 0) && (__builtin_amdgcn_mbcnt_hi(~0u, __builtin_amdgcn_mbcnt_lo(~0u, 0u)) == 0u);
    asm volatile("s_waitcnt vmcnt(0)" ::: "memory");
    __syncthreads();
    if (leader_thread) {
        unsigned* bar = b.bar;
        __builtin_amdgcn_s_waitcnt(0);
        unsigned nloc = b.st[0], nx = b.st[1];
        if (nloc == 0u) { xcd_barrier_complete(bar, b.x, nloc, nx); b.st[0] = nloc; b.st[1] = nx; }
        const unsigned old = xb_add(&bar[XB_XSUB(b.x)], 1u);
        const unsigned gen = old / nloc;
        if (old + 1u == (gen + 1u) * nloc) {
            __builtin_amdgcn_fence(__ATOMIC_RELEASE, "agent");
            asm volatile("s_waitcnt vmcnt(0)" ::: "memory");
            const unsigned og = xb_add(&bar[XB_TOP], 1u);
            const unsigned tg = og / nx;
            if (og + 1u == (tg + 1u) * nx) xb_add(&bar[XB_TOPGEN], 1u);
            else XB_SPIN(xb_ld(&bar[XB_TOPGEN]) == tg, bar);
            __builtin_amdgcn_fence(__ATOMIC_ACQUIRE, "agent");
            xb_add(&bar[XB_XGEN(b.x)], 1u);
            asm volatile("s_waitcnt vmcnt(0)" ::: "memory");
        } else {
            XB_SPIN(xb_ld(&bar[XB_XGEN(b.x)]) == gen, bar);
            __builtin_amdgcn_fence(__ATOMIC_ACQUIRE, "agent");
            asm volatile("s_waitcnt vmcnt(0)" ::: "memory");
        }
    }
    __syncthreads();
}

__device__ __forceinline__ bf16x8 frag_rowk_l(const LAS bf16_t* p, int ld, int lane) {
    return *(const LAS bf16x8*)(p + (lane & 15) * ld + (lane >> 4) * 8);
}
__device__ __forceinline__ bf16x8 frag_rowk_g(const bf16_t* p, long ld, int lane) {
    return *(const bf16x8*)(p + (long)(lane & 15) * ld + (lane >> 4) * 8);
}
__device__ __forceinline__ bf16x8 frag_colk_l(unsigned p, int ldb, int lane) {
    const unsigned a0 = p + (unsigned)((8 * (lane >> 4) + ((lane & 15) >> 2)) * ldb + (lane & 3) * 8);
    const unsigned a1 = a0 + 4u * (unsigned)ldb;
    s16x4 lo, hi;
    asm volatile("ds_read_b64_tr_b16 %0, %2\n\tds_read_b64_tr_b16 %1, %3\n\ts_waitcnt lgkmcnt(0)" : "=&v"(lo), "=&v"(hi) : "v"(a0), "v"(a1) : "memory");
    return (bf16x8){lo[0], lo[1], lo[2], lo[3], hi[0], hi[1], hi[2], hi[3]};
}
#define MFMA16(a, b, c) __builtin_amdgcn_mfma_f32_16x16x32_bf16((a), (b), (c), 0, 0, 0)
namespace pg8 {
constexpr int BM = 256, BK = 64, HALF = 128, HTB = HALF * BK * 2, STAGE_BYTES = 8 * HTB, NXCD = 8, WGM = 8;
__device__ __forceinline__ int lds_byte(int r, int c) { const int st = (r >> 4) * 2 + (c >> 5), rr = r & 15, cc = c & 31, ob = rr * 64 + cc * 2; return st * 1024 + (ob ^ (((ob >> 9) & 1) << 5)); }
__device__ __forceinline__ void stage_rc(int b, int& R, int& C) { const int st = b / 1024, sb = b % 1024, swz = sb ^ (((sb >> 9) & 1) << 5); R = (st >> 1) * 16 + swz / 64; C = (st & 1) * 32 + (swz % 64) / 2; }
__device__ __forceinline__ int perm32(int rho) { const int n = rho >> 4, i = rho & 15; return 8 * (i >> 2) + 4 * n + (i & 3); }

struct Unit { int pm, pn, e; };
constexpr float WSCALE = 32.0f, WSCALE_INV = 1.0f / 32.0f;

struct DenseOrder {
    const bf16_t* A; const bf16_t* Bt; int ldab, kb, nM, nN, nwg, G, c;
    __device__ __forceinline__ void init(const bf16_t* A_, int lda_, const bf16_t* Bt_, int M, int N, int K_, int G_, int c_) { A = A_; ldab = lda_ * 2; Bt = Bt_; kb = K_ * 2; nM = M / BM; nN = N / BM; nwg = nM * nN; G = G_; c = c_; }
    __device__ __forceinline__ void init8(const void* A_, int ldab_, const void* Bt_, int M, int N, int K_, int G_, int c_) { A = (const bf16_t*)A_; ldab = ldab_; Bt = (const bf16_t*)Bt_; kb = K_; nM = M / BM; nN = N / BM; nwg = nM * nN; G = G_; c = c_; }
    __device__ __forceinline__ void prep(LAS unsigned char*) const {}
    __device__ __forceinline__ int units_of_me() const { return c < nwg ? (nwg - c + G - 1) / G : 0; }
    __device__ __forceinline__ int max_units() const { return (nwg + G - 1) / G; }
    __device__ __forceinline__ bool next(int i, Unit& u) const {
        const long L = (long)i * G + c; if (L >= nwg) return false;
        int wgid = (int)L; { const int q = nwg / NXCD, r = nwg % NXCD, xcd = wgid % NXCD, off = wgid / NXCD; wgid = (xcd < r ? xcd * (q + 1) : r * (q + 1) + (xcd - r) * q) + off; }
        const int nig = WGM * nN, gid = wgid / nig, fm = gid * WGM, gsz = (nM - fm) < WGM ? (nM - fm) : WGM;
        u.pm = fm + ((wgid % nig) % gsz); u.pn = (wgid % nig) / gsz; u.e = 0; return true;
    }
    __device__ __forceinline__ const char* a_base() const { return (const char*)A; }
    __device__ __forceinline__ unsigned a_off(const Unit& u, int r) const { return (unsigned)(u.pm * BM + r) * (unsigned)ldab; }
    __device__ __forceinline__ void a_off4(const Unit& u, int r0, int r1, int half, u32x4& o) const { o.x = a_off(u, r0); o.y = a_off(u, r1); o.z = a_off(u, half + r0); o.w = a_off(u, half + r1); }
    __device__ __forceinline__ const char* b_ptr(const Unit& u) const { return (const char*)Bt + (size_t)u.pn * BM * kb; }
};

template <int MODE  >
struct MoeOrder {
    const void* A; const void* Bt; const int* list; const int* cnt; int ldab, kb, nN, G, c; size_t bstride;
    LAS int* tp; LAS int* cn; LAS int* rb;
    __device__ __forceinline__ void prep(LAS unsigned char* misc, int tid) {
        tp = (LAS int*)(misc + 64); cn = tp + 72; rb = cn + 72;
        if (tid < NEX1) cn[tid] = cnt[tid];
        __syncthreads();
        if (tid == 0) { int s = 0, q = 0; for (int e = 0; e < NEX1; ++e) { tp[e] = s; rb[e] = q; s += (cn[e] + BM - 1) / BM; q += cn[e]; } tp[NEX1] = s; rb[NEX1] = q; }
        __syncthreads();
    }
    __device__ __forceinline__ bool next(int i, Unit& u) const {
        const int total = tp[NEX1]; const long nu = (long)total * nN; const int per = (int)((nu + G - 1) / G);
        (void)per;
        long L = (long)i * G + c;
        if ((G & 7) == 0) L = ((long)i * 8 + (c & 7)) * (G >> 3) + (c >> 3);
        if (L >= nu) return false;
        const int tile = (int)(L / nN); u.pn = (int)(L % nN);
        const int ln_ = (int)__builtin_amdgcn_mbcnt_hi(~0u, __builtin_amdgcn_mbcnt_lo(~0u, 0u));
        const int e = __builtin_popcountll(__ballot(tp[ln_ + 1] <= tile));
        u.e = e; u.pm = tile - tp[e]; return true;
    }
    __device__ __forceinline__ const char* a_base() const { return (const char*)A; }
    __device__ __forceinline__ unsigned a_off(const Unit& u, int r) const {
        int pos = u.pm * BM + r; const int n = cn[u.e]; pos = pos < n ? pos : n - 1;
        if (MODE == 1) return (unsigned)(rb[u.e] + pos) * (unsigned)ldab;
        const int a = list[u.e * TT + pos];
        const int row = a < 8 * TT ? (a >> 3) : a - 8 * TT;
        return (unsigned)row * (unsigned)ldab;
    }
    __device__ __forceinline__ void a_off4(const Unit& u, int r0, int r1, int half, u32x4& o) const {
        if (MODE == 1) { o.x = a_off(u, r0); o.y = a_off(u, r1); o.z = a_off(u, half + r0); o.w = a_off(u, half + r1); return; }
        const int n = cn[u.e], pb = u.pm * BM; const int* lp = list + u.e * TT;
        const int a0 = lp[min(pb + r0, n - 1)], a1 = lp[min(pb + r1, n - 1)], a2 = lp[min(pb + half + r0, n - 1)], a3 = lp[min(pb + half + r1, n - 1)];
        o.x = (unsigned)(a0 < 8 * TT ? (a0 >> 3) : a0 - 8 * TT) * (unsigned)ldab; o.y = (unsigned)(a1 < 8 * TT ? (a1 >> 3) : a1 - 8 * TT) * (unsigned)ldab;
        o.z = (unsigned)(a2 < 8 * TT ? (a2 >> 3) : a2 - 8 * TT) * (unsigned)ldab; o.w = (unsigned)(a3 < 8 * TT ? (a3 >> 3) : a3 - 8 * TT) * (unsigned)ldab;
    }
    __device__ __forceinline__ const char* b_ptr(const Unit& u) const { return (const char*)Bt + (size_t)u.e * bstride + (size_t)u.pn * BM * kb; }
};

typedef int v8i32 __attribute__((ext_vector_type(8)));
typedef int v4i32_ __attribute__((ext_vector_type(4)));
__device__ __forceinline__ v8i32 cat8(bf16x8 a, bf16x8 b) { const u32x4 x = __builtin_bit_cast(u32x4, a), y = __builtin_bit_cast(u32x4, b); return (v8i32){(int)x.x, (int)x.y, (int)x.z, (int)x.w, (int)y.x, (int)y.y, (int)y.z, (int)y.w}; }
template <bool FP8, class Epi, class Sched>
__device__ __forceinline__ void gemm_phase(LAS unsigned char* lds, const Sched& S, const Epi& E, int wave_id) {
    const int wid = wave_id; int lane = (int)__builtin_amdgcn_mbcnt_hi(~0u, __builtin_amdgcn_mbcnt_lo(~0u, 0u)); asm volatile("" : "+v"(lane));
    const int tid = wid * 64 + lane, wr = wid >> 2, wc = wid & 3, fr = lane & 15, fq = lane >> 4;
    const int kb = S.kb; int nt = kb / 128; asm volatile("" : "+s"(nt));
    unsigned voffB[2];
#pragma unroll
    for (int i = 0; i < 2; ++i) { int R, C; stage_rc(tid * 16 + i * 8192, R, C); const int Rb = (R & ~31) + perm32(R & 31);
        voffB[i] = (unsigned)(Rb * kb) + (unsigned)C * 2u; }
#define PG8_AOFF(u, h, i) ({ int _tz = tid; asm volatile("" : "+v"(_tz)); int _R, _C; stage_rc(_tz * 16 + (i) * 8192, _R, _C); S.a_off((u), (h) * HALF + _R) + (unsigned)_C * 2u; })
    const size_t kstep = (size_t)(BK * 2);
    const size_t hstepB = (size_t)HALF * kb;
    const unsigned ldsw = (unsigned)wid * 1024u;
    const int aoff = lds_byte(wr * 64 + fr, fq * 8), boff = lds_byte(wc * 32 + fr, fq * 8);
#define PG8_SA(b, h) (((b) * 2 + (h)) * HTB)
#define PG8_SB(b, h) ((4 + (b) * 2 + (h)) * HTB)
#define PG8_STAGE(bufoff, gbase, v0, v1) do { \
        __builtin_amdgcn_global_load_lds((const unsigned*)((const char*)(gbase) + (v0)), (LAS unsigned*)(lds + (bufoff) + ldsw), 16, 0, 0); \
        __builtin_amdgcn_global_load_lds((const unsigned*)((const char*)(gbase) + (v1)), (LAS unsigned*)(lds + (bufoff) + ldsw + 8192), 16, 0, 0); } while (0)
#define PG8_VOFFB(i) ({ int _tz = tid; asm volatile("" : "+v"(_tz)); int _R, _C; stage_rc(_tz * 16 + (i) * 8192, _R, _C); (unsigned)(((_R & ~31) + perm32(_R & 31)) * kb) + (unsigned)_C * 2u; })
#define PG8_STAGE_B(bufoff, gbase) do { if constexpr (FP8) { int _tz = tid; asm volatile("" : "+v"(_tz)); const u32x2 _vv = *(const LAS u32x2*)(lds + STAGE_BYTES + 8192 + _tz * 8); PG8_STAGE(bufoff, gbase, _vv.x, _vv.y); } else PG8_STAGE(bufoff, gbase, voffB[0], voffB[1]); } while (0)
#define PG8_LD8(off) __builtin_shufflevector(*(const LAS v4i32_*)(lds + (off)), *(const LAS v4i32_*)(lds + (off) + 1024), 0, 1, 2, 3, 4, 5, 6, 7)
#define PG8_LDA(dst, b, h) do { _Pragma("unroll") for (int m = 0; m < 4; ++m) { if constexpr (FP8) dst##8[m] = PG8_LD8(PG8_SA(b, h) + aoff + m * 2048); else { _Pragma("unroll") for (int k = 0; k < 2; ++k) dst[m][k] = *(const LAS bf16x8*)(lds + PG8_SA(b, h) + aoff + m * 2048 + k * 1024); } } } while (0)
#define PG8_LDB(dst, b, h) do { _Pragma("unroll") for (int n = 0; n < 2; ++n) { if constexpr (FP8) dst##8[n] = PG8_LD8(PG8_SB(b, h) + boff + n * 2048); else { _Pragma("unroll") for (int k = 0; k < 2; ++k) dst[n][k] = *(const LAS bf16x8*)(lds + PG8_SB(b, h) + boff + n * 2048 + k * 1024); } } } while (0)
#define PG8_MMA(ai, bj, At, Bt) do { __builtin_amdgcn_s_setprio(1); _Pragma("unroll") for (int m = 0; m < 4; ++m) _Pragma("unroll") for (int n = 0; n < 2; ++n) { \
        if constexpr (FP8) asm volatile("v_mfma_f32_16x16x128_f8f6f4 %0, %1, %2, %0" : "+v"(acc[ai][bj][m][n]) : "v"(Bt##8[n]), "v"(At##8[m])); \
        else { _Pragma("unroll") for (int k = 0; k < 2; ++k) acc[ai][bj][m][n] = __builtin_amdgcn_mfma_f32_16x16x32_bf16(Bt[n][k], At[m][k], acc[ai][bj][m][n], 0, 0, 0); } } \
        __builtin_amdgcn_s_setprio(0); } while (0)
#define PG8_WAIT_V(n) asm volatile("s_waitcnt vmcnt(" #n ")" ::: "memory")
#define PG8_WAIT_L(n) asm volatile("s_waitcnt lgkmcnt(" #n ")" ::: "memory")
#define PG8_BAR __builtin_amdgcn_s_barrier()
#define PG8_SCHED __builtin_amdgcn_sched_barrier(0)
    if constexpr (FP8) { u32x2 _vb; _vb.x = PG8_VOFFB(0); _vb.y = PG8_VOFFB(1); *(LAS u32x2*)(lds + STAGE_BYTES + 8192 + tid * 8) = _vb; }
    Unit cur, nxt; int ui = 0;
    if (!S.next(0, cur)) return;
    f32x4 acc[2][2][4][2];
#pragma unroll
    for (int a = 0; a < 2; ++a)
#pragma unroll
        for (int b = 0; b < 2; ++b)
#pragma unroll
            for (int m = 0; m < 4; ++m)
#pragma unroll
                for (int n = 0; n < 2; ++n) acc[a][b][m][n] = (f32x4){0.f, 0.f, 0.f, 0.f};
    bf16x8 At[4][2], B0[2][2], B1[2][2]; v8i32 At8[4], B08[2], B18[2];
    const char* const gA = S.a_base();
    const char* cB = S.b_ptr(cur);
    unsigned oc00, oc01, oc10, oc11;
    oc00 = PG8_AOFF(cur, 0, 0); oc01 = PG8_AOFF(cur, 0, 1); oc10 = PG8_AOFF(cur, 1, 0); oc11 = PG8_AOFF(cur, 1, 1);
    PG8_STAGE_B(PG8_SB(0, 0), cB); PG8_STAGE_B(PG8_SB(0, 1), cB + hstepB); PG8_STAGE(PG8_SA(0, 0), gA, oc00, oc01); PG8_STAGE(PG8_SA(0, 1), gA, oc10, oc11);
    if (wr == 1) PG8_BAR;
    PG8_WAIT_V(2); PG8_BAR;
    PG8_STAGE_B(PG8_SB(1, 0), cB + kstep); PG8_STAGE(PG8_SA(1, 0), gA + kstep, oc00, oc01); PG8_STAGE_B(PG8_SB(1, 1), cB + hstepB + kstep);
    PG8_WAIT_V(6); PG8_BAR;
    for (;;) {
        const bool has_next = S.next(ui + 1, nxt);
        const char* nB = cB;
        {
            u32x4 on = {oc00, oc01, oc10, oc11};
            if (has_next) {
                int _tz = tid; asm volatile("" : "+v"(_tz)); int _R0, _C0, _R1, _C1; stage_rc(_tz * 16, _R0, _C0); stage_rc(_tz * 16 + 8192, _R1, _C1);
                S.a_off4(nxt, _R0, _R1, HALF, on); on.x += (unsigned)_C0 * 2u; on.y += (unsigned)_C1 * 2u; on.z += (unsigned)_C0 * 2u; on.w += (unsigned)_C1 * 2u; nB = S.b_ptr(nxt); }
            *(LAS u32x4*)(lds + STAGE_BYTES + tid * 16) = on;
        }
        for (int t = 0; t < nt; t += 2) {
            const bool last = (t == nt - 2);
            const char* a1 = gA + (size_t)(t + 1) * kstep;
            const char* a2 = last ? gA : gA + (size_t)(t + 2) * kstep; const char* b2 = last ? nB : cB + (size_t)(t + 2) * kstep;
            const char* a3 = a2 + kstep; const char* b3 = b2 + kstep;
            unsigned s00 = oc00, s01 = oc01, s10 = oc10, s11 = oc11;
            if (last) { const u32x4 on = *(const LAS u32x4*)(lds + STAGE_BYTES + tid * 16); s00 = on.x; s01 = on.y; s10 = on.z; s11 = on.w; }
            PG8_LDB(B0, 0, 0); PG8_LDB(B1, 0, 1); PG8_SCHED; PG8_LDA(At, 0, 0); PG8_STAGE(PG8_SA(1, 1), a1, oc10, oc11);
            PG8_WAIT_V(8); PG8_WAIT_L(0); PG8_BAR; PG8_MMA(0, 0, At, B0); PG8_MMA(0, 1, At, B1); PG8_BAR; PG8_SCHED;
            PG8_LDA(At, 0, 1); PG8_STAGE_B(PG8_SB(0, 0), b2); PG8_STAGE_B(PG8_SB(0, 1), b2 + hstepB); PG8_STAGE(PG8_SA(0, 0), a2, s00, s01);
            PG8_WAIT_V(8); PG8_WAIT_L(0); PG8_BAR; PG8_MMA(1, 0, At, B0); PG8_MMA(1, 1, At, B1); PG8_BAR; PG8_SCHED;
            PG8_LDB(B0, 1, 0); PG8_LDB(B1, 1, 1); PG8_SCHED; PG8_LDA(At, 1, 0); PG8_STAGE(PG8_SA(0, 1), a2, s10, s11);
            PG8_WAIT_V(8); PG8_WAIT_L(0); PG8_BAR; PG8_MMA(0, 0, At, B0); PG8_MMA(0, 1, At, B1); PG8_BAR; PG8_SCHED;
            PG8_LDA(At, 1, 1); PG8_STAGE_B(PG8_SB(1, 0), b3); PG8_STAGE_B(PG8_SB(1, 1), b3 + hstepB); PG8_STAGE(PG8_SA(1, 0), a3, s00, s01);
            PG8_WAIT_V(8); PG8_WAIT_L(0); PG8_BAR; PG8_MMA(1, 0, At, B0); PG8_MMA(1, 1, At, B1); PG8_BAR; PG8_SCHED;
        }
        if (wr == 0) PG8_BAR;
        E(acc, cur, wr, wc, fr, fq);
        if (!has_next) break;
#pragma unroll
        for (int a = 0; a < 2; ++a)
#pragma unroll
            for (int b = 0; b < 2; ++b)
#pragma unroll
                for (int m = 0; m < 4; ++m)
#pragma unroll
                    for (int n = 0; n < 2; ++n) acc[a][b][m][n] = (f32x4){0.f, 0.f, 0.f, 0.f};
        { const u32x4 on = *(const LAS u32x4*)(lds + STAGE_BYTES + tid * 16); oc00 = on.x; oc01 = on.y; oc10 = on.z; oc11 = on.w; }
        cur = nxt; cB = nB; ++ui;
        if (wr == 1) PG8_BAR;
    }
    PG8_WAIT_V(0);
    PG8_BAR;
#undef PG8_SA
#undef PG8_SB
#undef PG8_STAGE
#undef PG8_STAGE_B
#undef PG8_AOFF
#undef PG8_VOFFB
#undef PG8_LD8
#undef PG8_LDA
#undef PG8_LDB
#undef PG8_MMA
#undef PG8_WAIT_V
#undef PG8_WAIT_L
#undef PG8_BAR
#undef PG8_SCHED
}

struct EpiStore {
    bf16_t* O; int ldc; float scale;
    __device__ __forceinline__ void operator()(const f32x4 (&acc)[2][2][4][2], const Unit& u, int wr, int wc, int fr, int fq) const {
        const int row0 = u.pm * BM + wr * 64 + fr, col0 = u.pn * BM + wc * 32 + 8 * fq;
#pragma unroll
        for (int ai = 0; ai < 2; ++ai)
#pragma unroll
            for (int m = 0; m < 4; ++m) { bf16_t* rowp = O + (size_t)(row0 + ai * HALF + m * 16) * ldc + col0;
#pragma unroll
                for (int bj = 0; bj < 2; ++bj) { const f32x4 v0 = acc[ai][bj][m][0] * scale, v1 = acc[ai][bj][m][1] * scale;
                    u32x4 w; w.x = cvt_pk_bf16(v0[0], v0[1]); w.y = cvt_pk_bf16(v0[2], v0[3]); w.z = cvt_pk_bf16(v1[0], v1[1]); w.w = cvt_pk_bf16(v1[2], v1[3]);
                    *(u32x4*)(rowp + bj * HALF) = w; } }
    }
};
struct EpiGlu {
    const bf16_t* Z; const float* b; bf16_t* MIX;
    __device__ __forceinline__ void operator()(const f32x4 (&acc)[2][2][4][2], const Unit& u, int wr, int wc, int fr, int fq) const {
        const int row0 = u.pm * BM + wr * 64 + fr, col0 = u.pn * BM + wc * 32 + 8 * fq;
#pragma unroll
        for (int bj = 0; bj < 2; ++bj) {
            const f32x4 b0 = *(const f32x4*)(b + col0 + bj * HALF), b1 = *(const f32x4*)(b + col0 + bj * HALF + 4);
#pragma unroll
            for (int ai = 0; ai < 2; ++ai)
#pragma unroll
                for (int m = 0; m < 4; ++m) { const size_t row = (size_t)(row0 + ai * HALF + m * 16);
                    const u32x4 zz = *(const u32x4*)(Z + row * 1024 + col0 + bj * HALF);
                    const f32x4 v0 = acc[ai][bj][m][0] + b0, v1 = acc[ai][bj][m][1] + b1;
                    u32x4 w;
                    w.x = cvt_pk_bf16(bflo(zz.x) * sigmoidf_(v0[0]), bfhi(zz.x) * sigmoidf_(v0[1]));
                    w.y = cvt_pk_bf16(bflo(zz.y) * sigmoidf_(v0[2]), bfhi(zz.y) * sigmoidf_(v0[3]));
                    w.z = cvt_pk_bf16(bflo(zz.z) * sigmoidf_(v1[0]), bfhi(zz.z) * sigmoidf_(v1[1]));
                    w.w = cvt_pk_bf16(bflo(zz.w) * sigmoidf_(v1[2]), bfhi(zz.w) * sigmoidf_(v1[3]));
                    *(u32x4*)(MIX + row * DM + 1024 + col0 + bj * HALF) = w; }
        }
    }
};
struct EpiE1 {
    unsigned char* H; const LAS int* cn; const LAS int* rb;
    __device__ __forceinline__ void operator()(const f32x4 (&acc)[2][2][4][2], const Unit& u, int wr, int wc, int fr, int fq) const {
        const int n = cn[u.e]; const int colh = u.pn * 128 + wc * 32 + 8 * fq;
#pragma unroll
        for (int ai = 0; ai < 2; ++ai)
#pragma unroll
            for (int m = 0; m < 4; ++m) { const int pos = u.pm * BM + ai * HALF + wr * 64 + m * 16 + fr;
                if (pos < n) { const int a = rb[u.e] + pos;
                    float sc = WSCALE_INV; asm volatile("" : "+v"(sc));
                    const f32x4 g0 = acc[ai][0][m][0] * sc, g1 = acc[ai][0][m][1] * sc, u0 = acc[ai][1][m][0] * sc, u1 = acc[ai][1][m][1] * sc;
                    u32x2 w;
                    w.x = (unsigned)__builtin_amdgcn_cvt_pk_fp8_f32(siluf_(g0[0]) * u0[0], siluf_(g0[1]) * u0[1], 0, false);
                    w.x = (unsigned)__builtin_amdgcn_cvt_pk_fp8_f32(siluf_(g0[2]) * u0[2], siluf_(g0[3]) * u0[3], (int)w.x, true);
                    w.y = (unsigned)__builtin_amdgcn_cvt_pk_fp8_f32(siluf_(g1[0]) * u1[0], siluf_(g1[1]) * u1[1], 0, false);
                    w.y = (unsigned)__builtin_amdgcn_cvt_pk_fp8_f32(siluf_(g1[2]) * u1[2], siluf_(g1[3]) * u1[3], (int)w.y, true);
                    *(u32x2*)(H + (size_t)a * EHID + colh) = w; }
                __builtin_amdgcn_sched_barrier(0); }
    }
};
struct EpiE2 {
    unsigned char* Y; const float* wgt; const LAS int* cn; const LAS int* rb;
    __device__ __forceinline__ void operator()(const f32x4 (&acc)[2][2][4][2], const Unit& u, int wr, int wc, int fr, int fq) const {
        const int n = cn[u.e]; const int col0 = u.pn * BM + wc * 32 + 8 * fq;
#pragma unroll
        for (int ai = 0; ai < 2; ++ai)
#pragma unroll
            for (int m = 0; m < 4; ++m) { const int pos = u.pm * BM + ai * HALF + wr * 64 + m * 16 + fr;
                if (pos < n) { const int a = rb[u.e] + pos; float ws = WSCALE_INV * 0.25f; asm volatile("" : "+v"(ws));
                    unsigned char* rowp = Y + (size_t)a * DM + col0;
#pragma unroll
                    for (int bj = 0; bj < 2; ++bj) { const f32x4 v0 = acc[ai][bj][m][0] * ws, v1 = acc[ai][bj][m][1] * ws;
                        u32x2 w;
                        w.x = (unsigned)__builtin_amdgcn_cvt_pk_fp8_f32(v0[0], v0[1], 0, false); w.x = (unsigned)__builtin_amdgcn_cvt_pk_fp8_f32(v0[2], v0[3], (int)w.x, true);
                        w.y = (unsigned)__builtin_amdgcn_cvt_pk_fp8_f32(v1[0], v1[1], 0, false); w.y = (unsigned)__builtin_amdgcn_cvt_pk_fp8_f32(v1[2], v1[3], (int)w.y, true);
                        *(u32x2*)(rowp + bj * HALF) = w; } }
                __builtin_amdgcn_sched_barrier(0); }
    }
};
}
struct KArgs {
    const float* in[34];
    float* out;
    unsigned char* ws;
    int ph_lo, ph_hi;
};
struct Params {
    float* out;
    unsigned char* ws;
    LAS unsigned long long* ptab;
    int ph_lo, ph_hi;
    __device__ __forceinline__ const float* inp(int k) const {
        const unsigned long long v = ptab[k];
        const unsigned lo = __builtin_amdgcn_readfirstlane((unsigned)v), hi = __builtin_amdgcn_readfirstlane((unsigned)(v >> 32));
        return (const float*)(((unsigned long long)hi << 32) | lo);
    }
};
struct Ctx {
    LAS unsigned char* lds;
    int tid, lane, wave, G, bid;
    int gw, ngw;
};

__device__ __forceinline__ void tr_item(const float* W, int N, bf16_t* WT, int ldt, int k0, int n0, int orow0, LAS float* scr, int lane) {
#pragma unroll 8
    for (int i = 0; i < 32; ++i) { const int kk = 2 * i + (lane >> 5); scr[kk * 33 + (lane & 31)] = W[(size_t)(k0 + kk) * N + n0 + (lane & 31)]; }
    LDS_WAIT(); asm volatile("" ::: "memory");
    const int c = lane & 7;
#pragma unroll
    for (int j = 0; j < 4; ++j) { const int n = (lane >> 3) + 8 * j; const LAS float* s = scr + (8 * c) * 33 + n;
        u32x4 o; o.x = cvt_pk_bf16(s[0 * 33], s[1 * 33]); o.y = cvt_pk_bf16(s[2 * 33], s[3 * 33]); o.z = cvt_pk_bf16(s[4 * 33], s[5 * 33]); o.w = cvt_pk_bf16(s[6 * 33], s[7 * 33]);
        *(u32x4*)(WT + (size_t)(orow0 + n) * ldt + k0 + 8 * c) = o; }
    LDS_WAIT(); asm volatile("" ::: "memory");
}
__device__ __forceinline__ void tr_item64(const float* W, int N, bf16_t* WT, int ldt, int k0, int n0, int orow0, LAS float* scr, int lane) {
    f32x4 v[16];
    const float* src = W + (size_t)(k0 + (lane >> 4)) * N + n0 + 4 * (lane & 15);
#pragma unroll
    for (int i = 0; i < 16; ++i) v[i] = __builtin_nontemporal_load((const f32x4*)(src + (size_t)(4 * i) * N));
#pragma unroll
    for (int i = 0; i < 16; ++i) { LAS float* d = scr + (4 * i + (lane >> 4)) * 65 + 4 * (lane & 15); d[0] = v[i][0]; d[1] = v[i][1]; d[2] = v[i][2]; d[3] = v[i][3]; }
    LDS_WAIT(); asm volatile("" ::: "memory");
    const int c = lane & 7;
#pragma unroll
    for (int j = 0; j < 8; ++j) { const int n = (lane >> 3) + 8 * j; const LAS float* s = scr + (8 * c) * 65 + n;
        u32x4 o; o.x = cvt_pk_bf16(s[0 * 65], s[1 * 65]); o.y = cvt_pk_bf16(s[2 * 65], s[3 * 65]); o.z = cvt_pk_bf16(s[4 * 65], s[5 * 65]); o.w = cvt_pk_bf16(s[6 * 65], s[7 * 65]);
        *(u32x4*)(WT + (size_t)(orow0 + n) * ldt + k0 + 8 * c) = o; }
    LDS_WAIT(); asm volatile("" ::: "memory");
}
__device__ __forceinline__ void tr_item64_fp8(const float* W, int N, unsigned char* WT, int ldt, int k0, int n0, int orow0, LAS float* scr, int lane, float wscale = pg8::WSCALE) {
    f32x4 v[16];
    const float* src = W + (size_t)(k0 + (lane >> 4)) * N + n0 + 4 * (lane & 15);
#pragma unroll
    for (int i = 0; i < 16; ++i) v[i] = __builtin_nontemporal_load((const f32x4*)(src + (size_t)(4 * i) * N));
#pragma unroll
    for (int i = 0; i < 16; ++i) { LAS float* d = scr + (4 * i + (lane >> 4)) * 65 + 4 * (lane & 15); d[0] = v[i][0]; d[1] = v[i][1]; d[2] = v[i][2]; d[3] = v[i][3]; }
    LDS_WAIT(); asm volatile("" ::: "memory");
    const int c = lane & 3;
#pragma unroll
    for (int j = 0; j < 4; ++j) { const int n = (lane >> 2) + 16 * j; const LAS float* s = scr + (16 * c) * 65 + n;
        u32x4 o;
        o.x = (unsigned)__builtin_amdgcn_cvt_pk_fp8_f32(s[0 * 65] * wscale, s[1 * 65] * wscale, 0, false);   o.x = (unsigned)__builtin_amdgcn_cvt_pk_fp8_f32(s[2 * 65] * wscale, s[3 * 65] * wscale, (int)o.x, true);
        o.y = (unsigned)__builtin_amdgcn_cvt_pk_fp8_f32(s[4 * 65] * wscale, s[5 * 65] * wscale, 0, false);   o.y = (unsigned)__builtin_amdgcn_cvt_pk_fp8_f32(s[6 * 65] * wscale, s[7 * 65] * wscale, (int)o.y, true);
        o.z = (unsigned)__builtin_amdgcn_cvt_pk_fp8_f32(s[8 * 65] * wscale, s[9 * 65] * wscale, 0, false);   o.z = (unsigned)__builtin_amdgcn_cvt_pk_fp8_f32(s[10 * 65] * wscale, s[11 * 65] * wscale, (int)o.z, true);
        o.w = (unsigned)__builtin_amdgcn_cvt_pk_fp8_f32(s[12 * 65] * wscale, s[13 * 65] * wscale, 0, false); o.w = (unsigned)__builtin_amdgcn_cvt_pk_fp8_f32(s[14 * 65] * wscale, s[15 * 65] * wscale, (int)o.w, true);
        *(u32x4*)(WT + (size_t)(orow0 + n) * ldt + k0 + 16 * c) = o; }
    LDS_WAIT(); asm volatile("" ::: "memory");
}
__device__ __forceinline__ void tr_dense(const float* W, int K, int N, bf16_t* WT, int item, LAS float* scr, int lane) {
    const int nblk = N / 32, kb = item / nblk, nb = item % nblk;
    tr_item(W, N, WT, K, 64 * kb, 32 * nb, 32 * nb, scr, lane);
}

__device__ __forceinline__ void s5_tables(const Params& p, Ctx& C, int dir, int g) {
    LAS f32x2* PW = (LAS f32x2*)C.lds;
    LAS f32x2* BB = PW + 65 * 64;
    LAS f32x2* CX = BB + 64 * 16;
    const float* a_re = p.inp(11); const float* a_im = p.inp(12); const float* log_dt = p.inp(13);
    const float* b_re = p.inp(14); const float* b_im = p.inp(15); const float* c_re = p.inp(16); const float* c_im = p.inp(17);
    const int tid = C.tid;
    if (tid < 64) {
        const int pp = tid;
        const float dt = __expf(log_dt[dir * 64 + g]);
        const float are = a_re[(dir * 64 + g) * 64 + pp], aim = a_im[(dir * 64 + g) * 64 + pp];
        const float zr = are * dt, zi = aim * dt;
        const float mag = __expf(zr);
        double rev = (double)zi * 0.15915494309189535; rev -= floor(rev);
        const float cs = __builtin_amdgcn_cosf((float)rev), sn = __builtin_amdgcn_sinf((float)rev);
        const float abr = mag * cs, abi = mag * sn;
        const float den = are * are + aim * aim, nr = abr - 1.0f, ni = abi;
        const float fre = (nr * are + ni * aim) / den, fim = (ni * are - nr * aim) / den;
        float pr = 1.0f, pi = 0.0f;
#pragma unroll 1
        for (int n = 0; n <= 64; ++n) { PW[n * 64 + pp] = (f32x2){pr, pi}; const float t = pr * abr - pi * abi; pi = pr * abi + pi * abr; pr = t; }
        for (int j = 0; j < 16; ++j) { const float br = b_re[(g * 64 + pp) * 16 + j], bi = b_im[(g * 64 + pp) * 16 + j];
            BB[pp * 16 + j] = (f32x2){fre * br - fim * bi, fre * bi + fim * br}; }
    }
    for (int q = tid; q < 1024; q += NTHR) { const int i = q >> 6, pp = q & 63; CX[i * 64 + pp] = (f32x2){c_re[(g * 16 + i) * 64 + pp], c_im[(g * 16 + i) * 64 + pp]}; }
    __syncthreads();
    bf16_t* KN = (bf16_t*)(p.ws + WS_KN) + (size_t)(dir * 64 + g) * 16 * 1024;
    float* APOW = (float*)(p.ws + WS_APOW) + (size_t)(dir * 64 + g) * 64 * 128;
    float* AL = (float*)(p.ws + WS_AL) + (size_t)(dir * 64 + g) * 128;
#pragma unroll 1
    for (int q = 0; q < 32; ++q) { const int idx = tid + NTHR * q; const int n = idx >> 8, i = (idx >> 4) & 15, j = idx & 15;
        float s = 0.f;
#pragma unroll 4
        for (int pp = 0; pp < 64; ++pp) { const f32x2 c = CX[i * 64 + pp], w = PW[n * 64 + pp], b = BB[pp * 16 + j];
            const float gr = c.x * b.x - c.y * b.y, gi = c.x * b.y + c.y * b.x;
            s += gr * w.x - gi * w.y; }
        KN[(size_t)i * 1024 + n * 16 + j] = f2bf(s); }
    for (int q = tid; q < 4096; q += NTHR) { const int t = q >> 6, pp = q & 63; const f32x2 w = PW[(t + 1) * 64 + pp]; *(f32x2*)(APOW + (size_t)t * 128 + 2 * pp) = w; }
    if (tid < 64) { const f32x2 w = PW[64 * 64 + tid]; *(f32x2*)(AL + 2 * tid) = w; }
    { bf16_t* BBT = (bf16_t*)(p.ws + WS_BBT) + (size_t)(dir * 64 + g) * 128 * 16;
      for (int q = tid; q < 2048; q += NTHR) { const int pq = q >> 4, j = q & 15; const f32x2 b = BB[(pq & 63) * 16 + j]; BBT[q] = f2bf(pq < 64 ? b.x : b.y); } }
    if (dir == 0) { bf16_t* CCt = (bf16_t*)(p.ws + WS_CC) + (size_t)g * 16 * 128;
        for (int q = tid; q < 2048; q += NTHR) { const int i = q >> 7, pq = q & 127; const f32x2 c = CX[i * 64 + (pq & 63)]; CCt[i * 128 + pq] = f2bf(pq < 64 ? c.x : -c.y); } }
    __syncthreads();
}

__device__ __forceinline__ void phase_p0(const Params& p, Ctx& C) {
    for (int task = C.bid; task < 128; task += C.G) s5_tables(p, C, task >> 6, task & 63);
    {
        const int gt = C.bid * NTHR + C.tid, ngt = C.G * NTHR;
        float* R128 = (float*)(p.ws + WS_ROPE128); float* R64 = (float*)(p.ws + WS_ROPE64);
        for (int q = gt; q < 256 * 64 + 256 * 32; q += ngt) {
            int pos, i, half; float* dst;
            if (q < 256 * 64) { pos = q >> 6; i = q & 63; half = 64; dst = R128 + (size_t)q * 2; }
            else { const int r = q - 256 * 64; pos = r >> 5; i = r & 31; half = 32; dst = R64 + (size_t)r * 2; }
            const float freq = exp2f(-(float)i / (float)half * 13.287712379549449f);
            const float ang = (float)pos * freq;
            double rev = (double)ang * 0.15915494309189535; rev -= floor(rev);
            dst[0] = __builtin_amdgcn_cosf((float)rev); dst[1] = __builtin_amdgcn_sinf((float)rev);
        }
        bf16_t* RWT = (bf16_t*)(p.ws + WS_RWT); const float* rw = p.inp(26);
        for (int q = gt; q < 2 * 64 * DM; q += ngt) { const int L = q / (64 * DM), r = q % (64 * DM), e = r / DM, k = r % DM;
            const float w = rw[((size_t)L * DM + k) * 64 + e]; const bf16_t hi = f2bf(w); const bf16_t lo = f2bf(w - bf2f(hi));
            RWT[((size_t)(L * 2 + 0) * 64 + e) * DM + k] = hi; RWT[((size_t)(L * 2 + 1) * 64 + e) * DM + k] = lo; }
    }
    {
        const float* cvec = p.inp(1); const float* cctx = p.inp(3); const float* mw = p.inp(4);
        float* MODP = (float*)(p.ws + WS_MODP);
        for (int task = C.gw; task < 2 * 32 * 48; task += C.ngw) {
            const int L = task / (32 * 48), r = task % (32 * 48), kb = r / 48, cb = r % 48;
            const float sc = siluf_(cvec[64 * kb + C.lane]), sx = siluf_(cctx[64 * kb + C.lane]);
            f32x4 a0 = {0.f, 0.f, 0.f, 0.f}, a1 = {0.f, 0.f, 0.f, 0.f};
            const float* wp = mw + ((size_t)L * DM + 64 * kb) * 12288 + 256 * cb + 4 * C.lane;
#pragma unroll 8
            for (int kk = 0; kk < 64; ++kk) { const f32x4 w = *(const f32x4*)(wp + (size_t)kk * 12288);
                const float s0 = __shfl(sc, kk), s1 = __shfl(sx, kk);
                a0 += w * s0; a1 += w * s1; }
            *(f32x4*)(MODP + ((size_t)((L * 32 + kb) * 2 + 0)) * 12288 + 256 * cb + 4 * C.lane) = a0;
            *(f32x4*)(MODP + ((size_t)((L * 32 + kb) * 2 + 1)) * 12288 + 256 * cb + 4 * C.lane) = a1;
        }
    }
    {
        LAS float* scr = (LAS float*)(C.lds + C.wave * 17408);
        constexpr int J0 = (DM / 64) * (EV_IN / 64), J3 = (DM / 64) * (OD_IN / 64);
        for (int it = C.gw; it < J0 + J3; it += C.ngw) {
            const bool l1 = it >= J0; const int r = l1 ? it - J0 : it; const int N = l1 ? OD_IN : EV_IN; const int nblk = N / 64, kb = r / nblk, nb = r % nblk;
            tr_item64_fp8(p.inp(l1 ? 21 : 8), N, (unsigned char*)(p.ws + (l1 ? WS_WIN1 : WS_WIN0)), DM, 64 * kb, 64 * nb, 64 * nb, scr, C.lane, 32.0f);
        }
        LAS float* scr2 = (LAS float*)(C.lds + C.wave * 17408);
        constexpr int I1 = (DM / 64) * (DM / 32), I2 = (1024 / 64) * (1024 / 32), I4 = I1;
        for (int it = C.gw; it < I1 + I2 + I4; it += C.ngw) {
            int r = it;
            if (r < I1) { tr_dense(p.inp(9), DM, DM, (bf16_t*)(p.ws + WS_WOUT0), r, scr2, C.lane); continue; } r -= I1;
            if (r < I2) { tr_dense(p.inp(19), 1024, 1024, (bf16_t*)(p.ws + WS_WGLU), r, scr2, C.lane); continue; } r -= I2;
            tr_dense(p.inp(22), DM, DM, (bf16_t*)(p.ws + WS_WOUT1), r, scr2, C.lane);
        }
    }
}
__device__ __forceinline__ void phase_p1(const Params& p, Ctx& C) {
    const float* MODP = (const float*)(p.ws + WS_MODP); float* MODF = (float*)(p.ws + WS_MODF); const float* mb = p.inp(5);
    for (int q = C.bid * NTHR + C.tid; q < 2 * 2 * 12288; q += C.G * NTHR) { const int L = q / (2 * 12288), v = (q / 12288) & 1, col = q % 12288;
        float s = mb[L * 12288 + col];
        for (int kb = 0; kb < 32; ++kb) s += MODP[((size_t)((L * 32 + kb) * 2 + v)) * 12288 + col];
        MODF[q] = s; }
}
__device__ __forceinline__ const float* modv(const Params& p, int L, int v, int k) { return (const float*)(p.ws + WS_MODF) + (size_t)(L * 2 + v) * 12288 + k * DM; }

__device__ __forceinline__ void stage_vec(LAS float* dst, const float* src, int tid) { *(LAS f32x4*)(dst + 4 * tid) = *(const f32x4*)(src + 4 * tid); }
__device__ __forceinline__ void conv_item(const Params& p, Ctx& C, int L, int it) {
    LAS float* scr = (LAS float*)(C.lds + C.wave * 17408);
    unsigned char* GU = (unsigned char*)(p.ws + WS_GU) + (size_t)L * NEX1 * 1024 * DM; unsigned char* DT = (unsigned char*)(p.ws + WS_DT) + (size_t)L * NEX1 * DM * EHID;
    const int e = it / 768, r = it % 768, which = r >> 8, q = r & 255;
    if (which < 2) {
        const float* W = (e < 64) ? p.inp(28 + which) + ((size_t)(L * 64 + e)) * DM * EHID : p.inp(31 + which) + (size_t)L * DM * EHID;
        const int kb = q >> 3, nb = q & 7, n0 = 64 * nb;
        tr_item64_fp8(W, EHID, GU + (size_t)e * 1024 * DM, DM, 64 * kb, n0, 256 * (n0 >> 7) + (n0 & 127) + (which ? 128 : 0), scr, C.lane);
    } else {
        const float* W = (e < 64) ? p.inp(30) + ((size_t)(L * 64 + e)) * EHID * DM : p.inp(33) + (size_t)L * EHID * DM;
        const int kb = q >> 5, nb = q & 31;
        tr_item64_fp8(W, DM, DT + (size_t)e * DM * EHID, EHID, 64 * kb, 64 * nb, 64 * nb, scr, C.lane);
    }
}
__device__ __forceinline__ void conv_queue(const Params& p, Ctx& C, int quota) {
    unsigned* head = (unsigned*)(p.ws + WS_CTL) + CW_QUEUE + 128;
    const int batch = quota < 8 ? quota : 8;
    for (int done = 0; done < quota; done += batch) {
        int it0 = 0; if (C.lane == 0) it0 = (int)atomicAdd(head, (unsigned)batch);
        it0 = __builtin_amdgcn_readfirstlane(it0);
        if (it0 >= NEX1 * 768) break;
        for (int k = 0; k < batch && it0 + k < NEX1 * 768; ++k) conv_item(p, C, 1, it0 + k);
    }
}
__device__ __forceinline__ void phase_modulate(const Params& p, Ctx& C, int L) {
    unsigned char* XA8 = (unsigned char*)(p.ws + WS_XA);
    const float* X2 = (const float*)(p.ws + WS_HX2);
    LAS float* MV = (LAS float*)C.lds;
    for (int v = 0; v < 2; ++v) { stage_vec(MV + (v * 2 + 0) * DM, modv(p, L, v, 0), C.tid); stage_vec(MV + (v * 2 + 1) * DM, modv(p, L, v, 1), C.tid); }
    __syncthreads();
    for (int r = C.gw; r < TT; r += C.ngw) {
        const int v = r < CTXL ? 1 : 0;
        const float* src = (L == 0) ? (r < CTXL ? p.inp(2) + (size_t)r * DM : p.inp(0) + (size_t)(r - CTXL) * DM) : X2 + (size_t)r * DM;
        const LAS float* sh = MV + (v * 2 + 0) * DM; const LAS float* sc = MV + (v * 2 + 1) * DM;
#pragma unroll
        for (int j = 0; j < 8; ++j) { const int c = 4 * (C.lane + 64 * j);
            const f32x4 x = *(const f32x4*)(src + c), a = *(const LAS f32x4*)(sc + c), b = *(const LAS f32x4*)(sh + c);
            const f32x4 y = x * (a + 1.0f) + b;
            unsigned w = (unsigned)__builtin_amdgcn_cvt_pk_fp8_f32(y[0], y[1], 0, false); w = (unsigned)__builtin_amdgcn_cvt_pk_fp8_f32(y[2], y[3], (int)w, true);
            *(unsigned*)(XA8 + (size_t)r * DM + c) = w; }
    }
    __syncthreads();
    if (L == 0) { for (int it = C.gw; it < NEX1 * 768; it += C.ngw) conv_item(p, C, 0, it); }
    else conv_queue(p, C, 1 << 30);
}

__device__ __forceinline__ void phase_rope0(const Params& p, Ctx& C) {
    bf16_t* QKV = (bf16_t*)(p.ws + WS_BIG + BG_QKV);
    const f32x2* R128 = (const f32x2*)(p.ws + WS_ROPE128);
    for (int r = C.gw; r < TT; r += C.ngw) {
        bf16_t* row = QKV + (size_t)r * EV_IN;
        if (r < CTXL) {
#pragma unroll
            for (int j = 0; j < 2; ++j) { u32x4* q = (u32x4*)(row + 8 * (C.lane + 64 * j)); u32x4 w = *q;
                w.x = cvt_pk_bf16(bflo(w.x) * 0.0625f, bfhi(w.x) * 0.0625f); w.y = cvt_pk_bf16(bflo(w.y) * 0.0625f, bfhi(w.y) * 0.0625f);
                w.z = cvt_pk_bf16(bflo(w.z) * 0.0625f, bfhi(w.z) * 0.0625f); w.w = cvt_pk_bf16(bflo(w.w) * 0.0625f, bfhi(w.w) * 0.0625f); *q = w; }
        } else {
            const int l = r - CTXL, rp = l >> 6, cp = l & 63;
#pragma unroll
            for (int qk = 0; qk < 2; ++qk)
#pragma unroll
                for (int m = 0; m < 8; ++m) { const int pi = C.lane + 64 * m, head = pi >> 7, blk = (pi >> 6) & 1, i = pi & 63;
                    bf16_t* b = row + qk * 1024 + head * 256 + blk * 128 + i;
                    const f32x2 cs = R128[(blk ? cp : rp) * 64 + i];
                    const float x1 = bf2f(b[0]), x2 = bf2f(b[64]); const float sc = qk ? 1.0f : 0.0625f;
                    b[0] = f2bf((x1 * cs.x - x2 * cs.y) * sc); b[64] = f2bf((x1 * cs.y + x2 * cs.x) * sc); }
        }
    }
}

__device__ __forceinline__ void phase_normrope1(const Params& p, Ctx& C) {
    bf16_t* QKV = (bf16_t*)(p.ws + WS_BIG + BG_QKV);
    const f32x2* R64 = (const f32x2*)(p.ws + WS_ROPE64);
    const float* qg = p.inp(23);
    unsigned* KMAX = (unsigned*)(p.ws + WS_CTL) + CW_KMAX;
    unsigned char* Q8 = (unsigned char*)(p.ws + WS_BIG + BG_Q8); unsigned char* K8 = (unsigned char*)(p.ws + WS_BIG + BG_K8); unsigned char* VT8 = (unsigned char*)(p.ws + WS_BIG + BG_VT8);
    unsigned char* Q8D = (unsigned char*)(p.ws + WS_BIG + BG_Q8D); unsigned char* K8D = (unsigned char*)(p.ws + WS_BIG + BG_K8D); unsigned char* VT8D = (unsigned char*)(p.ws + WS_BIG + BG_VT8D);
    const int lane = C.lane, i32 = lane & 31; const bool up = lane >= 32;
    const float g00 = qg[lane], g01 = qg[64 + lane], g10 = qg[128 + lane], g11 = qg[128 + 64 + lane];
    for (int r = C.gw; r < TT; r += C.ngw) {
        bf16_t* row = QKV + (size_t)r * OD_IN;
        const bool lat = r >= CTXL; const int l = r - CTXL, rp = lat ? (l >> 6) : 0, cp = lat ? (l & 63) : 0;
        const f32x2 cr = R64[rp * 32 + i32], cc = R64[cp * 32 + i32];
#pragma unroll 2
        for (int h = 0; h < 26; ++h) {
            const int col = h < 8 ? 128 * h : (h < 10 ? 1024 + 128 * (h - 8) : (h < 18 ? 1536 + 128 * (h - 10) : 2560 + 128 * (h - 18)));
            bf16_t* b = row + col;
            float v0 = bf2f(b[lane]), v1 = bf2f(b[64 + lane]);
            if (h < 10) { const float ss = wave_sum(v0 * v0 + v1 * v1); const float rs = rsqrtf(ss * (1.0f / 128.0f) + LN_EPS);
                v0 = bf2f(f2bf(v0 * rs)) * (h < 8 ? g00 : g10); v1 = bf2f(f2bf(v1 * rs)) * (h < 8 ? g01 : g11); }
            if (lat) { const float p0 = __shfl_xor(v0, 32), p1 = __shfl_xor(v1, 32);
                v0 = up ? (p0 * cr.y + v0 * cr.x) : (v0 * cr.x - p0 * cr.y);
                v1 = up ? (p1 * cc.y + v1 * cc.x) : (v1 * cc.x - p1 * cc.y); }
            const bf16_t o0 = f2bf(v0), o1 = f2bf(v1);
            b[lane] = o0; b[64 + lane] = o1;
            {
                const float qs = (h < 8 || (h >= 10 && h < 18)) ? 0.088388347648318440f * 1.4426950408889634f : 1.0f;
                const float w0 = bf2f(o0) * qs, w1 = bf2f(o1) * qs;
                float e4[4];
#pragma unroll
                for (int j = 0; j < 4; ++j) { const float a = __shfl(w0, (4 * lane + j) & 63), c2 = __shfl(w1, (4 * lane + j) & 63); e4[j] = lane < 16 ? a : c2; }
                unsigned pk = (unsigned)__builtin_amdgcn_cvt_pk_fp8_f32(e4[0], e4[1], 0, false); pk = (unsigned)__builtin_amdgcn_cvt_pk_fp8_f32(e4[2], e4[3], (int)pk, true);
                unsigned char* dst8 = h < 8 ? Q8 + (size_t)r * 1024 + 128 * h : (h < 10 ? K8 + (size_t)r * 256 + 128 * (h - 8) : (h < 18 ? Q8D + (size_t)r * 1024 + 128 * (h - 10) : K8D + (size_t)r * 1024 + 128 * (h - 18)));
                if (lane < 32) *(unsigned*)(dst8 + 4 * lane) = pk; }
            if ((h >= 8 && h < 10) || h >= 18) {
                const float w0 = bf2f(o0), w1 = bf2f(o1); const float k2 = wave_sum(w0 * w0 + w1 * w1);
                if (lane == 0) atomicMax(KMAX + 64 * (h < 10 ? h - 8 : h - 16), __float_as_uint(k2)); }
        }
    }
    LAS bf16_t* vt = (LAS bf16_t*)(C.lds + C.wave * 17408);
    for (int item = C.gw; item < 10 * 260; item += C.ngw) {
        const int kh = item / 260, T = item % 260;
        const int vcol = kh < 2 ? 1280 + 128 * kh : 3584 + 128 * (kh - 2);
        unsigned char* vout = kh < 2 ? VT8 + (size_t)kh * 260 * 8192 : VT8D + (size_t)(kh - 2) * 260 * 8192;
#pragma unroll
        for (int q = 0; q < 16; ++q) { const int idx = lane + 64 * q, key = idx >> 4, c = idx & 15;
            *(LAS u32x4*)(vt + key * 136 + 8 * c) = *(const u32x4*)(QKV + (size_t)(64 * T + key) * OD_IN + vcol + 8 * c); }
        LDS_WAIT(); asm volatile("" ::: "memory");
#pragma unroll
        for (int dd = 0; dd < 2; ++dd) { const int d = lane + 64 * dd;
            unsigned char* dst = vout + ((size_t)T * 128 + d) * 64;
#pragma unroll
            for (int cch = 0; cch < 4; ++cch) { u32x4 w;
#pragma unroll
                for (int wd = 0; wd < 4; ++wd) { float f[4];
#pragma unroll
                    for (int e = 0; e < 4; ++e) { const int bb = 16 * cch + 4 * wd + e, hi2 = bb >> 5, blk = (bb >> 4) & 1, j = bb & 15; const int key = 32 * blk + (j & 3) + 8 * (j >> 2) + 4 * hi2;
                        f[e] = bf2f(vt[key * 136 + d]); }
                    unsigned pk = (unsigned)__builtin_amdgcn_cvt_pk_fp8_f32(f[0], f[1], 0, false); pk = (unsigned)__builtin_amdgcn_cvt_pk_fp8_f32(f[2], f[3], (int)pk, true);
                    w[wd] = pk; }
                *(u32x4*)(dst + 16 * cch) = w; } }
        LDS_WAIT(); asm volatile("" ::: "memory");
    }
}

__device__ __forceinline__ void phase_merge1(const Params& p, Ctx& C) {
    bf16_t* ATT = (bf16_t*)(p.ws + WS_BIG + BG_ATT);
    const float* dl = p.inp(24); const float* sg = p.inp(25);
    const int lane = C.lane;
    float d0 = dl[lane] * dl[128 + lane] + dl[64 + lane] * dl[128 + 64 + lane];
    float d1 = dl[256 + lane] * dl[384 + lane] + dl[256 + 64 + lane] * dl[384 + 64 + lane];
    const float lam = __expf(wave_sum(d0)) - __expf(wave_sum(d1)) + LAMBDA_INIT;
    const f32x4 gg = *(const f32x4*)(sg + 4 * lane);
    for (int l = C.gw; l < SEQ; l += C.ngw) {
        bf16_t* row = ATT + (size_t)l * 3072;
#pragma unroll
        for (int h = 0; h < 4; ++h) {
            const u32x2 a = *(const u32x2*)(row + 1024 + 256 * h + 4 * lane), b = *(const u32x2*)(row + 2048 + 256 * h + 4 * lane);
            f32x4 o = {bflo(a.x) - lam * bflo(b.x), bfhi(a.x) - lam * bfhi(b.x), bflo(a.y) - lam * bflo(b.y), bfhi(a.y) - lam * bfhi(b.y)};
            const float ss = wave_sum(o[0] * o[0] + o[1] * o[1] + o[2] * o[2] + o[3] * o[3]);
            const float rs = rsqrtf(ss * (1.0f / 256.0f) + LN_EPS) * (1.0f - LAMBDA_INIT);
            o = o * rs * gg;
            u32x2 w; w.x = cvt_pk_bf16(o[0], o[1]); w.y = cvt_pk_bf16(o[2], o[3]);
            *(u32x2*)(row + 1024 + 256 * h + 4 * lane) = w;
        }
    }
}

__device__ __forceinline__ void phase_ln1(const Params& p, Ctx& C, int L) {
    const bf16_t* Y = (const bf16_t*)(p.ws + WS_YMIX); float* X1 = (float*)(p.ws + WS_X1); unsigned char* XA8 = (unsigned char*)(p.ws + WS_XA);
    const float* X2 = (const float*)(p.ws + WS_HX2);
    const float* lg = p.inp(6) + (size_t)(L * 2 + 0) * DM; const float* lb = p.inp(7) + (size_t)(L * 2 + 0) * DM;
    const int r0 = (L == 0) ? 0 : CTXL;
    LAS float* MV = (LAS float*)C.lds; LAS float* LG = MV + 6 * DM; LAS float* LB = LG + DM;
    for (int v = 0; v < 2; ++v) for (int k = 0; k < 3; ++k) stage_vec(MV + (v * 3 + k) * DM, modv(p, L, v, 2 + k), C.tid);
    stage_vec(LG, lg, C.tid); stage_vec(LB, lb, C.tid);
    __syncthreads();
    for (int r = r0 + C.gw; r < TT; r += C.ngw) {
        const int v = r < CTXL ? 1 : 0;
        const float* src = (L == 0) ? (r < CTXL ? p.inp(2) + (size_t)r * DM : p.inp(0) + (size_t)(r - CTXL) * DM) : X2 + (size_t)r * DM;
        const LAS float* g1 = MV + (v * 3 + 0) * DM; const LAS float* sh2 = MV + (v * 3 + 1) * DM; const LAS float* sc2 = MV + (v * 3 + 2) * DM;
        f32x4 t[8]; float s = 0.f;
#pragma unroll
        for (int j = 0; j < 8; ++j) { const int c = 4 * (C.lane + 64 * j);
            const f32x4 x = *(const f32x4*)(src + c), g = *(const LAS f32x4*)(g1 + c); const u32x2 yy = *(const u32x2*)(Y + (size_t)r * DM + c);
            const f32x4 y = {bflo(yy.x), bfhi(yy.x), bflo(yy.y), bfhi(yy.y)};
            t[j] = x * ALPHA + g * y; s += (t[j][0] + t[j][1]) + (t[j][2] + t[j][3]); }
        const float mean = wave_sum(s) * (1.0f / DM); float s2 = 0.f;
#pragma unroll
        for (int j = 0; j < 8; ++j) { t[j] = t[j] - mean; s2 += (t[j][0] * t[j][0] + t[j][1] * t[j][1]) + (t[j][2] * t[j][2] + t[j][3] * t[j][3]); }
        const float rstd = rsqrtf(wave_sum(s2) * (1.0f / DM) + LN_EPS);
#pragma unroll
        for (int j = 0; j < 8; ++j) { const int c = 4 * (C.lane + 64 * j);
            const f32x4 x1 = t[j] * rstd * *(const LAS f32x4*)(LG + c) + *(const LAS f32x4*)(LB + c);
            *(f32x4*)(X1 + (size_t)r * DM + c) = x1;
            const f32x4 z = x1 * (*(const LAS f32x4*)(sc2 + c) + 1.0f) + *(const LAS f32x4*)(sh2 + c);
            unsigned w = (unsigned)__builtin_amdgcn_cvt_pk_fp8_f32(z[0], z[1], 0, false); w = (unsigned)__builtin_amdgcn_cvt_pk_fp8_f32(z[2], z[3], (int)w, true);
            *(unsigned*)(XA8 + (size_t)r * DM + c) = w; }
    }
    __syncthreads();
}

__device__ __forceinline__ void phase_combine(const Params& p, Ctx& C, int L, LAS unsigned char* misc) {
    const unsigned char* YM = (const unsigned char*)(p.ws + WS_BIG + BG_YMOE); const float* X1 = (const float*)(p.ws + WS_X1);
    float* X2 = (float*)(p.ws + WS_HX2);
    const float* lg = p.inp(6) + (size_t)(L * 2 + 1) * DM; const float* lb = p.inp(7) + (size_t)(L * 2 + 1) * DM;
    const unsigned* PK = (const unsigned*)(p.ws + WS_WGT); const int* cnt = (const int*)(p.ws + WS_CTL) + CW_CNT + L * 128; const float* LWT = (const float*)(p.ws + WS_LW);
    const int r0 = (L == 0) ? 0 : CTXL;
    LAS int* rb = (LAS int*)(misc + 64);
    LAS float* MV = (LAS float*)C.lds; LAS float* LG = MV + 2 * DM; LAS float* LB = LG + DM;
    __syncthreads();
    if (C.tid == 0) { int q = 0; for (int e = 0; e < NEX1; ++e) { rb[e] = q; q += cnt[e]; } }
    stage_vec(MV, modv(p, L, 0, 5), C.tid); stage_vec(MV + DM, modv(p, L, 1, 5), C.tid); stage_vec(LG, lg, C.tid); stage_vec(LB, lb, C.tid);
    LAS float* M1 = LB + DM;
    unsigned char* XA8 = (unsigned char*)(p.ws + WS_XA);
    if (L == 0) { for (int v = 0; v < 2; ++v) { stage_vec(M1 + (v * 2 + 0) * DM, modv(p, 1, v, 0), C.tid); stage_vec(M1 + (v * 2 + 1) * DM, modv(p, 1, v, 1), C.tid); } }
    __syncthreads();
    for (int r = r0 + C.gw; r < TT; r += C.ngw) {
        const int v = r < CTXL ? 1 : 0;
        const LAS float* g2 = MV + v * DM;
        int ln = C.lane; asm volatile("" : "+v"(ln));
        int slot = rb[64] + (r - r0);
        float wk = 4.0f;
        if (ln < 8) { const unsigned pk = PK[(size_t)r * 8 + ln]; wk = LWT[(size_t)r * 8 + ln]; slot = rb[pk >> 16] + (int)(pk & 0xffffu); }
        f32x4 t[2][4]; float s = 0.f;
#pragma unroll
        for (int j = 0; j < 2; ++j) { const int c = 16 * (ln + 64 * j);
            u32x4 yy[9];
#pragma unroll
            for (int k = 0; k < 9; ++k) { const size_t a = (size_t)__builtin_amdgcn_readlane(slot, k); yy[k] = __builtin_nontemporal_load((const u32x4*)(YM + a * DM + c)); }
            f32x2 f[8];
#pragma unroll
            for (int q = 0; q < 8; ++q) f[q] = (f32x2){0.f, 0.f};
#pragma unroll
            for (int k = 0; k < 9; ++k) { const float wq = __int_as_float(__builtin_amdgcn_readlane(__float_as_int(wk), k));
                f[0] += wq * __builtin_amdgcn_cvt_pk_f32_fp8((int)yy[k].x, false); f[1] += wq * __builtin_amdgcn_cvt_pk_f32_fp8((int)yy[k].x, true);
                f[2] += wq * __builtin_amdgcn_cvt_pk_f32_fp8((int)yy[k].y, false); f[3] += wq * __builtin_amdgcn_cvt_pk_f32_fp8((int)yy[k].y, true);
                f[4] += wq * __builtin_amdgcn_cvt_pk_f32_fp8((int)yy[k].z, false); f[5] += wq * __builtin_amdgcn_cvt_pk_f32_fp8((int)yy[k].z, true);
                f[6] += wq * __builtin_amdgcn_cvt_pk_f32_fp8((int)yy[k].w, false); f[7] += wq * __builtin_amdgcn_cvt_pk_f32_fp8((int)yy[k].w, true); }
#pragma unroll
            for (int q = 0; q < 4; ++q) { const f32x4 x = *(const f32x4*)(X1 + (size_t)r * DM + c + 4 * q), g = *(const LAS f32x4*)(g2 + c + 4 * q);
                const f32x4 ff = {f[2 * q][0], f[2 * q][1], f[2 * q + 1][0], f[2 * q + 1][1]};
                t[j][q] = x * ALPHA + g * ff; s += (t[j][q][0] + t[j][q][1]) + (t[j][q][2] + t[j][q][3]); } }
        const float mean = wave_sum(s) * (1.0f / DM); float s2 = 0.f;
#pragma unroll
        for (int j = 0; j < 2; ++j)
#pragma unroll
            for (int q = 0; q < 4; ++q) { t[j][q] = t[j][q] - mean; s2 += (t[j][q][0] * t[j][q][0] + t[j][q][1] * t[j][q][1]) + (t[j][q][2] * t[j][q][2] + t[j][q][3] * t[j][q][3]); }
        const float rstd = rsqrtf(wave_sum(s2) * (1.0f / DM) + LN_EPS);
        float* dst = (L == 0) ? X2 + (size_t)r * DM : p.out + (size_t)(r - CTXL) * DM;
#pragma unroll
        for (int j = 0; j < 2; ++j)
#pragma unroll
            for (int q = 0; q < 4; ++q) { const int c = 16 * (ln + 64 * j) + 4 * q;
                const f32x4 xn = t[j][q] * rstd * *(const LAS f32x4*)(LG + c) + *(const LAS f32x4*)(LB + c);
                *(f32x4*)(dst + c) = xn;
                if (L == 0) { const f32x4 y = xn * (*(const LAS f32x4*)(M1 + (v * 2 + 1) * DM + c) + 1.0f) + *(const LAS f32x4*)(M1 + (v * 2 + 0) * DM + c);
                    unsigned w = (unsigned)__builtin_amdgcn_cvt_pk_fp8_f32(y[0], y[1], 0, false); w = (unsigned)__builtin_amdgcn_cvt_pk_fp8_f32(y[2], y[3], (int)w, true);
                    *(unsigned*)(XA8 + (size_t)r * DM + c) = w; } }
    }
    if (L == 0) { __syncthreads(); conv_queue(p, C, 1 << 30); }
}
constexpr int RLD = 264;
constexpr int SLD = 136;

template <bool SCALE>
__device__ __forceinline__ void stage_chunk(const bf16_t* QKV, int row0, int col0, LAS bf16_t* dst, int tid, float lg  , int dirb) {
#pragma unroll
    for (int q = 0; q < 8; ++q) { const int idx = tid + NTHR * q, r = idx >> 5, c = idx & 31;
        u32x4 w = *(const u32x4*)(QKV + (size_t)(row0 + r) * EV_IN + col0 + 8 * c);
        if (SCALE) { const float sc = fast_exp((dirb ? (float)r : (float)(127 - r)) * lg);
            w.x = cvt_pk_bf16(bflo(w.x) * sc, bfhi(w.x) * sc); w.y = cvt_pk_bf16(bflo(w.y) * sc, bfhi(w.y) * sc);
            w.z = cvt_pk_bf16(bflo(w.z) * sc, bfhi(w.z) * sc); w.w = cvt_pk_bf16(bflo(w.w) * sc, bfhi(w.w) * sc); }
        *(LAS u32x4*)(dst + r * RLD + 8 * c) = w; }
}

__device__ __forceinline__ void ret_chunk_kv(const Params& p, Ctx& C) {
    const bf16_t* QKV = (const bf16_t*)(p.ws + WS_BIG + BG_QKV); bf16_t* CKV = (bf16_t*)(p.ws + WS_BIG + BG_CKV);
    const float* rld = p.inp(10);
    LAS bf16_t* Vs = (LAS bf16_t*)C.lds; LAS bf16_t* Ks = Vs + 128 * RLD;
    const int lane = C.lane, w = C.wave;
    for (int unit = C.bid; unit < 130 * 8; unit += C.G) {
        const int u = unit >> 3, h = (unit >> 1) & 3, dir = unit & 1;
        const float lg = rld[dir * 4 + h];
        __syncthreads();
        stage_chunk<false>(QKV, 128 * u, 2048 + 256 * h, Vs, C.tid, 0.f, 0);
        stage_chunk<true>(QKV, 128 * u, 1024 + 256 * h, Ks, C.tid, lg, dir);
        __syncthreads();
        f32x4 acc[2][16];
#pragma unroll
        for (int a = 0; a < 2; ++a)
#pragma unroll
            for (int b = 0; b < 16; ++b) acc[a][b] = (f32x4){0.f, 0.f, 0.f, 0.f};
        const unsigned vbase = (unsigned)(uintptr_t)Vs, kbase = (unsigned)(uintptr_t)Ks;
#pragma unroll 1
        for (int ks = 0; ks < 4; ++ks) {
            bf16x8 af[2];
#pragma unroll
            for (int a = 0; a < 2; ++a) af[a] = frag_colk_l(vbase + (unsigned)((32 * ks) * RLD + 32 * w + 16 * a) * 2u, RLD * 2, lane);
#pragma unroll
            for (int b = 0; b < 16; ++b) { const bf16x8 bf = frag_colk_l(kbase + (unsigned)((32 * ks) * RLD + 16 * b) * 2u, RLD * 2, lane);
                acc[0][b] = MFMA16(bf, af[0], acc[0][b]); acc[1][b] = MFMA16(bf, af[1], acc[1][b]); }
        }
        bf16_t* dst = CKV + ((size_t)((dir * 4 + h) * 130 + u)) * 65536;
#pragma unroll
        for (int a = 0; a < 2; ++a)
#pragma unroll
            for (int b = 0; b < 16; ++b) { u32x2 w2; w2.x = cvt_pk_bf16(acc[a][b][0], acc[a][b][1]); w2.y = cvt_pk_bf16(acc[a][b][2], acc[a][b][3]);
                *(u32x2*)(dst + (size_t)(32 * w + 16 * a + (lane & 15)) * 256 + 16 * b + 4 * (lane >> 4)) = w2; }
    }
    __syncthreads();
}

__device__ __forceinline__ int s5_row(int dir, int c, int s) { return dir == 0 ? 64 * c + s : (c < 4 ? 255 - (64 * c + s) : 16639 - 64 * (c - 4) - s); }

__device__ __forceinline__ void s5_end_states(const Params& p, Ctx& C) {
    const bf16_t* QKV = (const bf16_t*)(p.ws + WS_BIG + BG_QKV); const bf16_t* BBT = (const bf16_t*)(p.ws + WS_BBT); float* E = (float*)(p.ws + WS_S5E);
    const float* APOW = (const float*)(p.ws + WS_APOW);
    LAS f32x2* PL = (LAS f32x2*)C.lds;
    for (int bt = C.bid; bt < 256; bt += C.G) {
        int tid = C.tid; asm volatile("" : "+v"(tid));
        const int lane = tid & 63, r32 = lane & 31, hi = lane >> 5;
        const int dg = bt >> 1, dir = dg >> 6, g = dg & 63, c0 = 130 * (bt & 1);
        __syncthreads();
#pragma unroll
        for (int q = 0; q < 8; ++q) { const int idx = tid + NTHR * q, s = idx >> 6, pp = idx & 63;
            PL[idx] = (s == 63) ? (f32x2){1.0f, 0.0f} : *(const f32x2*)(APOW + ((size_t)dg * 64 + (62 - s)) * 128 + 2 * pp); }
        __syncthreads();
        bf16x8 bfr[4];
#pragma unroll
        for (int pt = 0; pt < 4; ++pt) bfr[pt] = *(const bf16x8*)(BBT + ((size_t)dg * 128 + 32 * pt + r32) * 16 + 8 * hi);
        for (int c = c0 + C.wave; c < c0 + 130; c += 8) {
            float er[2] = {0.f, 0.f}, ei[2] = {0.f, 0.f};
#pragma unroll
            for (int st = 0; st < 2; ++st) {
                const bf16x8 a = *(const bf16x8*)(QKV + (size_t)s5_row(dir, c, 32 * st + r32) * EV_IN + 4096 + 16 * g + 8 * hi);
                f32x16 d[4];
#pragma unroll
                for (int pt = 0; pt < 4; ++pt) d[pt] = __builtin_amdgcn_mfma_f32_32x32x16_bf16(a, bfr[pt], (f32x16){}, 0, 0, 0);
#pragma unroll
                for (int r = 0; r < 16; ++r) { const int s = 32 * st + (r & 3) + 8 * (r >> 2) + 4 * hi;
#pragma unroll
                    for (int pt = 0; pt < 2; ++pt) { const f32x2 pw = PL[s * 64 + 32 * pt + r32]; const float br = d[pt][r], bi = d[pt + 2][r];
                        er[pt] += pw.x * br - pw.y * bi; ei[pt] += pw.x * bi + pw.y * br; } }
            }
#pragma unroll
            for (int pt = 0; pt < 2; ++pt) {
                { auto rr = __builtin_amdgcn_permlane32_swap(__float_as_uint(er[pt]), __float_as_uint(er[pt]), false, false); er[pt] = __uint_as_float(rr[0]) + __uint_as_float(rr[1]); }
                { auto rr = __builtin_amdgcn_permlane32_swap(__float_as_uint(ei[pt]), __float_as_uint(ei[pt]), false, false); ei[pt] = __uint_as_float(rr[0]) + __uint_as_float(rr[1]); }
            }
            float* dst = E + ((size_t)dg * 260 + c) * 128;
            if (hi == 0) { dst[r32] = er[0]; dst[32 + r32] = er[1]; dst[64 + r32] = ei[0]; dst[96 + r32] = ei[1]; }
        }
    }
    __syncthreads();
}

__device__ __forceinline__ void phase_scans(const Params& p, Ctx& C) {
    const bf16_t* CKV = (const bf16_t*)(p.ws + WS_BIG + BG_CKV); bf16_t* SP = (bf16_t*)(p.ws + WS_BIG + BG_SPREV);
    const float* rld = p.inp(10);
    for (int q = C.bid * NTHR + C.tid; q < 8 * 16384; q += C.G * NTHR) {
        const int dh = q >> 14, el = (q & 16383) * 4, dir = dh >> 2, h = dh & 3;
        const float gch = fast_exp(128.0f * rld[dir * 4 + h]);
        const bf16_t* src = CKV + (size_t)dh * 130 * 65536 + el; bf16_t* dst = SP + (size_t)dh * 130 * 65536 + el;
        f32x4 s = {0.f, 0.f, 0.f, 0.f};
        for (int st0 = 0; st0 < 130; st0 += 13) {
            u32x2 kv[13];
#pragma unroll
            for (int k = 0; k < 13; ++k) { const int st = st0 + k; const int u = dir == 0 ? st : (st == 0 ? 1 : (st == 1 ? 0 : 131 - st)); kv[k] = __builtin_nontemporal_load((const u32x2*)(src + (size_t)u * 65536)); }
#pragma unroll
            for (int k = 0; k < 13; ++k) { const int st = st0 + k; const int u = dir == 0 ? st : (st == 0 ? 1 : (st == 1 ? 0 : 131 - st));
                u32x2 w; w.x = cvt_pk_bf16(s[0], s[1]); w.y = cvt_pk_bf16(s[2], s[3]); *(u32x2*)(dst + (size_t)u * 65536) = w;
                s = s * gch + (f32x4){bflo(kv[k].x), bfhi(kv[k].x), bflo(kv[k].y), bfhi(kv[k].y)}; }
        }
    }
    const float* E = (const float*)(p.ws + WS_S5E); float* HST = (float*)(p.ws + WS_HST); const float* AL = (const float*)(p.ws + WS_AL);
    for (int q = C.bid * NTHR + C.tid; q < 2 * 64 * 64; q += C.G * NTHR) {
        const int dg = q >> 6, pp = q & 63;
        const f32x2 al = *(const f32x2*)(AL + (size_t)dg * 128 + 2 * pp);
        const float* e = E + (size_t)dg * 260 * 128; float* hs = HST + (size_t)dg * 260 * 128;
        float hr = 0.f, hi = 0.f;
        for (int c0 = 0; c0 < 260; c0 += 26) {
            float er[26], ei[26];
#pragma unroll
            for (int k = 0; k < 26; ++k) { er[k] = e[(size_t)(c0 + k) * 128 + pp]; ei[k] = e[(size_t)(c0 + k) * 128 + 64 + pp]; }
#pragma unroll
            for (int k = 0; k < 26; ++k) { *(f32x2*)(hs + (size_t)(c0 + k) * 128 + 2 * pp) = (f32x2){hr, hi};
                const float t = al.x * hr - al.y * hi + er[k]; hi = al.x * hi + al.y * hr + ei[k]; hr = t; }
        }
    }
}

__device__ __forceinline__ void ret_output_unit(const Params& p, Ctx& C, int unit) {
    const bf16_t* QKV = (const bf16_t*)(p.ws + WS_BIG + BG_QKV); const bf16_t* SP = (const bf16_t*)(p.ws + WS_BIG + BG_SPREV);
    bf16_t* MIX = (bf16_t*)(p.ws + WS_BIG + BG_MIX);
    const float* rld = p.inp(10);
    LAS bf16_t* RA = (LAS bf16_t*)C.lds; LAS bf16_t* RB = RA + 128 * RLD;
    int tid = C.tid; asm volatile("" : "+v"(tid));
    const int lane = tid & 63, w = C.wave, kq = lane >> 4, fr = lane & 15;
    const int u = unit >> 2, h = unit & 3;
    const float lgf = rld[h], lgb = rld[4 + h];
    stage_chunk<false>(QKV, 128 * u, 256 * h, RA, tid, 0.f, 0);
    int ib = 16 * w + 4 * kq, jb = fr; asm volatile("" : "+v"(ib), "+v"(jb));
    f32x4 acc[16];
#pragma unroll
    for (int t = 0; t < 16; ++t) acc[t] = (f32x4){0.f, 0.f, 0.f, 0.f};
#pragma unroll
    for (int dir = 0; dir < 2; ++dir) {
        const bf16_t* Sd = SP + ((size_t)((dir * 4 + h) * 130 + u)) * 65536;
#pragma unroll
        for (int eh = 0; eh < 2; ++eh) {
            __syncthreads();
#pragma unroll
            for (int q = 0; q < 8; ++q) { const int idx = tid + NTHR * q, rr = idx >> 5, c = idx & 31;
                *(LAS u32x4*)(RB + rr * RLD + 8 * c) = *(const u32x4*)(Sd + (size_t)(128 * eh + rr) * 256 + 8 * c);
                if (q == 3) asm volatile("" ::: "memory"); }
            __syncthreads();
#pragma unroll 1
            for (int ks = 0; ks < 8; ++ks) { const bf16x8 af = frag_rowk_l(RA + (16 * w) * RLD + 32 * ks, RLD, lane);
#pragma unroll
                for (int t = 0; t < 8; ++t) { const bf16x8 bf = frag_rowk_l(RB + (16 * t) * RLD + 32 * ks, RLD, lane); acc[8 * eh + t] = MFMA16(af, bf, acc[8 * eh + t]); } }
        }
#pragma unroll
        for (int r = 0; r < 4; ++r) { const int i = ib + r; const float qd = fast_exp((float)(128 - i) * lgb);
            const float f = (dir == 0) ? fast_exp((float)(i + 1) * lgf) / qd : qd;
#pragma unroll
            for (int t = 0; t < 16; ++t) acc[t][r] *= f; }
    }
    __syncthreads();
    stage_chunk<false>(QKV, 128 * u, 1024 + 256 * h, RB, tid, 0.f, 0);
    __syncthreads();
    f32x4 sc[8];
#pragma unroll
    for (int t = 0; t < 8; ++t) sc[t] = (f32x4){0.f, 0.f, 0.f, 0.f};
#pragma unroll 1
    for (int ks = 0; ks < 8; ++ks) { const bf16x8 af = frag_rowk_l(RA + (16 * w) * RLD + 32 * ks, RLD, lane);
#pragma unroll
        for (int t = 0; t < 8; ++t) { const bf16x8 bf = frag_rowk_l(RB + (16 * t) * RLD + 32 * ks, RLD, lane); sc[t] = MFMA16(af, bf, sc[t]); } }
#pragma unroll
    for (int t = 0; t < 8; ++t)
#pragma unroll
        for (int r = 0; r < 4; ++r) { const int i = ib + r, j = 16 * t + jb; const float d = (float)(i - j);
            const float m = (i >= j ? fast_exp(d * lgf) : 0.f) + (j >= i ? fast_exp(-d * lgb) : 0.f); sc[t][r] *= m; }
    __syncthreads();
    stage_chunk<false>(QKV, 128 * u, 2048 + 256 * h, RA, tid, 0.f, 0);
#pragma unroll
    for (int t = 0; t < 8; ++t)
#pragma unroll
        for (int r = 0; r < 4; ++r) RB[(16 * w + 4 * kq + r) * SLD + 16 * t + fr] = f2bf(sc[t][r]);
    __syncthreads();
    const unsigned vbase = (unsigned)(uintptr_t)RA;
#pragma unroll 1
    for (int ks = 0; ks < 4; ++ks) { const bf16x8 af = frag_rowk_l(RB + (16 * w) * SLD + 32 * ks, SLD, lane);
#pragma unroll
        for (int t = 0; t < 16; ++t) { const bf16x8 bf = frag_colk_l(vbase + (unsigned)((32 * ks) * RLD + 16 * t) * 2u, RLD * 2, lane); acc[t] = MFMA16(af, bf, acc[t]); } }
    __syncthreads();
#pragma unroll
    for (int r = 0; r < 4; ++r) {
        float s = 0.f;
#pragma unroll
        for (int t = 0; t < 16; ++t) s += acc[t][r];
        s += __shfl_xor(s, 1); s += __shfl_xor(s, 2); s += __shfl_xor(s, 4); s += __shfl_xor(s, 8);
        const float mean = s * (1.0f / 256.0f); float q = 0.f;
#pragma unroll
        for (int t = 0; t < 16; ++t) { const float d = acc[t][r] - mean; q += d * d; }
        q += __shfl_xor(q, 1); q += __shfl_xor(q, 2); q += __shfl_xor(q, 4); q += __shfl_xor(q, 8);
        const float rstd = rsqrtf(q * (1.0f / 256.0f) + LN_EPS);
#pragma unroll
        for (int t = 0; t < 16; ++t) RA[(16 * w + 4 * kq + r) * RLD + 16 * t + fr] = f2bf((acc[t][r] - mean) * rstd);
    }
    __syncthreads();
#pragma unroll
    for (int q = 0; q < 8; ++q) { const int idx = tid + NTHR * q, rr = idx >> 5, c = idx & 31; const size_t row = (size_t)(128 * u + rr);
        const u32x4 o = *(const LAS u32x4*)(RA + rr * RLD + 8 * c), g = *(const u32x4*)(QKV + row * EV_IN + 3072 + 256 * h + 8 * c);
        u32x4 w4;
        w4.x = cvt_pk_bf16(bflo(o.x) * siluf_(bflo(g.x)), bfhi(o.x) * siluf_(bfhi(g.x))); w4.y = cvt_pk_bf16(bflo(o.y) * siluf_(bflo(g.y)), bfhi(o.y) * siluf_(bfhi(g.y)));
        w4.z = cvt_pk_bf16(bflo(o.z) * siluf_(bflo(g.z)), bfhi(o.z) * siluf_(bfhi(g.z))); w4.w = cvt_pk_bf16(bflo(o.w) * siluf_(bflo(g.w)), bfhi(o.w) * siluf_(bfhi(g.w)));
        *(u32x4*)(MIX + row * DM + 256 * h + 8 * c) = w4; }
    __syncthreads();
}

constexpr int KLD = 1032;
__device__ __forceinline__ void s5_output_task(const Params& p, Ctx& C, int bt) {
    const bf16_t* QKV = (const bf16_t*)(p.ws + WS_BIG + BG_QKV); bf16_t* Z = (bf16_t*)(p.ws + WS_Z);
    const bf16_t* KN = (const bf16_t*)(p.ws + WS_KN); const bf16_t* CCt = (const bf16_t*)(p.ws + WS_CC);
    const float* APOW = (const float*)(p.ws + WS_APOW); const float* HST = (const float*)(p.ws + WS_HST); const float* dsk = p.inp(18);
    int tid = C.tid; asm volatile("" : "+v"(tid));
    const int lane = tid & 63, kq = lane >> 4, fr = lane & 15;
    LAS bf16_t* KF = (LAS bf16_t*)C.lds; LAS bf16_t* KB = KF + 16 * KLD;
    LAS bf16_t* U = KB + 16 * KLD + C.wave * 3072;
    LAS float* PW0 = (LAS float*)(KB + 16 * KLD + 8 * 3072);
    LAS float* PW16 = PW0 + 2 * 16 * 128;
    {
        const int g = bt >> 3, k0 = (260 * (bt & 7)) >> 3, k1 = (260 * ((bt & 7) + 1)) >> 3;
#pragma unroll
        for (int q = 0; q < 8; ++q) { const int idx = tid + NTHR * q, dir = idx >> 11, rr = (idx >> 7) & 15, c = idx & 127;
            *(LAS u32x4*)((dir ? KB : KF) + rr * KLD + 8 * c) = *(const u32x4*)(KN + ((size_t)(dir * 64 + g) * 16 + rr) * 1024 + 8 * c); }
        for (int q = lane; q < 192 * 2; q += 64) *(LAS u32x4*)(U + 8 * q) = (u32x4){0u, 0u, 0u, 0u};
#pragma unroll
        for (int q = 0; q < 2; ++q) { const int idx = tid + NTHR * q, dir = idx >> 9, f = (idx >> 5) & 15, c4 = idx & 31;
            *(LAS f32x4*)(PW0 + dir * 2048 + f * 128 + 4 * c4) = *(const f32x4*)(APOW + ((size_t)(dir * 64 + g) * 64 + (dir == 0 ? f : 15 - f)) * 128 + 4 * c4); }
        if (tid < 64) { const int dir = tid >> 5, c4 = tid & 31; *(LAS f32x4*)(PW16 + dir * 128 + 4 * c4) = *(const f32x4*)(APOW + ((size_t)(dir * 64 + g) * 64 + 15) * 128 + 4 * c4); }
        __syncthreads();
        const f32x4 dv = *(const f32x4*)(dsk + 16 * g + 4 * kq);
        bf16x8 ccr[2], cci[2];
#pragma unroll
        for (int hb = 0; hb < 2; ++hb) { ccr[hb] = frag_rowk_g(CCt + (size_t)g * 16 * 128 + 32 * hb, 128, lane); cci[hb] = frag_rowk_g(CCt + (size_t)g * 16 * 128 + 64 + 32 * hb, 128, lane); }
        const LAS float* pw0l = PW0 + (size_t)fr * 128 + 16 * kq;
        const LAS float* pw16l = PW16 + 16 * kq;
        for (int k = k0 + C.wave; k < k1; k += 8) {
            LDS_WAIT(); asm volatile("" ::: "memory");
            for (int q = lane; q < 128; q += 64) { const int t = q >> 1, hf = q & 1;
                *(LAS u32x4*)(U + (64 + t) * 16 + 8 * hf) = *(const u32x4*)(QKV + (size_t)(64 * k + t) * EV_IN + 4096 + 16 * g + 8 * hf); }
            LDS_WAIT(); asm volatile("" ::: "memory");
            const int cf = k, cb = k < 4 ? 3 - k : 263 - k;
            f32x4 acc[4];
#pragma unroll
            for (int tt = 0; tt < 4; ++tt) acc[tt] = (f32x4){0.f, 0.f, 0.f, 0.f};
            const LAS bf16_t* ubf = U + (64 + fr - (kq >> 1)) * 16 + 8 * (kq & 1);
            const LAS bf16_t* ubb = U + (64 + fr + (kq >> 1)) * 16 + 8 * (kq & 1);
#pragma unroll
            for (int n0 = 0; n0 < 64; n0 += 2) {
                const bf16x8 af = frag_rowk_l(KF + n0 * 16, KLD, lane), ab = frag_rowk_l(KB + n0 * 16, KLD, lane);
#pragma unroll
                for (int tt = 0; tt < 4; ++tt) {
                    if (n0 <= 16 * tt + 14) acc[tt] = MFMA16(af, *(const LAS bf16x8*)(ubf + (16 * tt - n0) * 16), acc[tt]);
                    if (n0 <= 62 - 16 * tt) acc[tt] = MFMA16(ab, *(const LAS bf16x8*)(ubb + (16 * tt + n0) * 16), acc[tt]);
                }
                asm volatile("" ::: "memory");
            }
#pragma unroll
            for (int dir = 0; dir < 2; ++dir) {
                const float* hp = HST + ((size_t)(dir * 64 + g) * 260 + (dir == 0 ? cf : cb)) * 128;
#pragma unroll
                for (int hb = 0; hb < 2; ++hb) {
                    float xr[8], xi[8];
#pragma unroll
                    for (int e2 = 0; e2 < 4; ++e2) { const f32x4 h4 = *(const f32x4*)(hp + 2 * (32 * hb + 8 * kq) + 4 * e2), b4 = *(const LAS f32x4*)(pw0l + dir * 2048 + hb * 64 + 4 * e2);
                        xr[2 * e2] = b4[0] * h4[0] - b4[1] * h4[1]; xi[2 * e2] = b4[0] * h4[1] + b4[1] * h4[0];
                        xr[2 * e2 + 1] = b4[2] * h4[2] - b4[3] * h4[3]; xi[2 * e2 + 1] = b4[2] * h4[3] + b4[3] * h4[2]; }
#pragma unroll
                    for (int st = 0; st < 4; ++st) {
                        const int tt = dir == 0 ? st : 3 - st;
                        u32x4 br, bi;
                        br.x = cvt_pk_bf16(xr[0], xr[1]); br.y = cvt_pk_bf16(xr[2], xr[3]); br.z = cvt_pk_bf16(xr[4], xr[5]); br.w = cvt_pk_bf16(xr[6], xr[7]);
                        bi.x = cvt_pk_bf16(xi[0], xi[1]); bi.y = cvt_pk_bf16(xi[2], xi[3]); bi.z = cvt_pk_bf16(xi[4], xi[5]); bi.w = cvt_pk_bf16(xi[6], xi[7]);
                        acc[tt] = MFMA16(ccr[hb], __builtin_bit_cast(bf16x8, br), acc[tt]);
                        acc[tt] = MFMA16(cci[hb], __builtin_bit_cast(bf16x8, bi), acc[tt]);
                        if (st < 3) {
#pragma unroll
                            for (int e2 = 0; e2 < 4; ++e2) { const f32x4 a4 = *(const LAS f32x4*)(pw16l + dir * 128 + hb * 64 + 4 * e2);
                                float t0 = xr[2 * e2] * a4[0] - xi[2 * e2] * a4[1]; xi[2 * e2] = xr[2 * e2] * a4[1] + xi[2 * e2] * a4[0]; xr[2 * e2] = t0;
                                t0 = xr[2 * e2 + 1] * a4[2] - xi[2 * e2 + 1] * a4[3]; xi[2 * e2 + 1] = xr[2 * e2 + 1] * a4[3] + xi[2 * e2 + 1] * a4[2]; xr[2 * e2 + 1] = t0; }
                        }
                    }
                }
            }
#pragma unroll
            for (int tt = 0; tt < 4; ++tt) { const int t = 16 * tt + fr;
                const u32x2 uu = *(const LAS u32x2*)(U + (64 + t) * 16 + 4 * kq);
                const float y0 = acc[tt][0] + bflo(uu.x) * dv[0], y1 = acc[tt][1] + bfhi(uu.x) * dv[1], y2 = acc[tt][2] + bflo(uu.y) * dv[2], y3 = acc[tt][3] + bfhi(uu.y) * dv[3];
                u32x2 w; w.x = cvt_pk_bf16(gelu_tanh(y0), gelu_tanh(y1)); w.y = cvt_pk_bf16(gelu_tanh(y2), gelu_tanh(y3));
                *(u32x2*)(Z + (size_t)(64 * k + t) * 1024 + 16 * g + 4 * kq) = w; }
        }
    }
    __syncthreads();
}

__device__ __forceinline__ void phase_ret_s5_outputs(const Params& p, Ctx& C, LAS unsigned char* misc) {
    unsigned* head = (unsigned*)(p.ws + WS_CTL) + CW_QUEUE;
    volatile LAS int* slot = (volatile LAS int*)(misc + 32);
    for (;;) {
        __syncthreads();
        if (C.tid == 0) slot[0] = (int)atomicAdd(head, 1u);
        __syncthreads();
        const int item = __builtin_amdgcn_readfirstlane(slot[0]);
        if (item >= 520) break;
        ret_output_unit(p, C, item);
    }
    for (;;) {
        __syncthreads();
        if (C.tid == 0) slot[0] = (int)atomicAdd(head + 64, 1u);
        __syncthreads();
        const int item = __builtin_amdgcn_readfirstlane(slot[0]);
        if (item >= 512) break;
        s5_output_task(p, C, item);
    }
}
__device__ __forceinline__ void phase_router(const Params& p, Ctx& C, int L) {
    const float* X1 = (const float*)(p.ws + WS_X1);
    const bf16_t* RWh = (const bf16_t*)(p.ws + WS_RWT) + (size_t)(L * 2 + 0) * 64 * DM; const bf16_t* RWl = (const bf16_t*)(p.ws + WS_RWT) + (size_t)(L * 2 + 1) * 64 * DM;
    const float* rbias = p.inp(27) + L * 64;
    int* cnt = (int*)(p.ws + WS_CTL) + CW_CNT + L * 128; int* LIST = (int*)(p.ws + WS_LIST); unsigned* PK = (unsigned*)(p.ws + WS_WGT); float* LW = (float*)(p.ws + WS_LW);
    const int lane = C.lane, kq = lane >> 4, fr = lane & 15;
    LAS float* Lg = (LAS float*)(C.lds + C.wave * 8192);
    const int r0 = (L == 0) ? 0 : CTXL, nrows = TT - r0;
    if (C.bid == 0 && C.tid == 0) cnt[64] = nrows;
    for (int task = C.gw; task < nrows / 16; task += C.ngw) {
        const int rbase = r0 + 16 * task, row = rbase + fr;
        const int v = row < CTXL ? 1 : 0;
        const float* xr = X1 + (size_t)row * DM; const float* sc2 = modv(p, L, v, 4); const float* sh2 = modv(p, L, v, 3);
        f32x4 acc[4];
#pragma unroll
        for (int t = 0; t < 4; ++t) acc[t] = (f32x4){0.f, 0.f, 0.f, 0.f};
#pragma unroll 2
        for (int ks = 0; ks < 64; ++ks) { const int c0 = 32 * ks + 8 * kq;
            const f32x4 x0 = *(const f32x4*)(xr + c0), x1 = *(const f32x4*)(xr + c0 + 4);
            const f32x4 a0 = *(const f32x4*)(sc2 + c0), a1 = *(const f32x4*)(sc2 + c0 + 4), b0 = *(const f32x4*)(sh2 + c0), b1 = *(const f32x4*)(sh2 + c0 + 4);
            const f32x4 y0 = x0 * (a0 + 1.0f) + b0, y1 = x1 * (a1 + 1.0f) + b1;
            u32x4 hi; hi.x = cvt_pk_bf16(y0[0], y0[1]); hi.y = cvt_pk_bf16(y0[2], y0[3]); hi.z = cvt_pk_bf16(y1[0], y1[1]); hi.w = cvt_pk_bf16(y1[2], y1[3]);
            u32x4 lo; lo.x = cvt_pk_bf16(y0[0] - bflo(hi.x), y0[1] - bfhi(hi.x)); lo.y = cvt_pk_bf16(y0[2] - bflo(hi.y), y0[3] - bfhi(hi.y));
            lo.z = cvt_pk_bf16(y1[0] - bflo(hi.z), y1[1] - bfhi(hi.z)); lo.w = cvt_pk_bf16(y1[2] - bflo(hi.w), y1[3] - bfhi(hi.w));
            const bf16x8 ah = __builtin_bit_cast(bf16x8, hi), al = __builtin_bit_cast(bf16x8, lo);
#pragma unroll
            for (int t = 0; t < 4; ++t) { const bf16x8 bh = frag_rowk_g(RWh + (size_t)(16 * t) * DM + 32 * ks, DM, lane), bl = frag_rowk_g(RWl + (size_t)(16 * t) * DM + 32 * ks, DM, lane);
                acc[t] = MFMA16(ah, bh, acc[t]); acc[t] = MFMA16(al, bh, acc[t]); acc[t] = MFMA16(ah, bl, acc[t]); } }
        LDS_WAIT(); asm volatile("" ::: "memory");
#pragma unroll
        for (int t = 0; t < 4; ++t)
#pragma unroll
            for (int r = 0; r < 4; ++r) Lg[(4 * kq + r) * 65 + 16 * t + fr] = acc[t][r];
        LDS_WAIT(); asm volatile("" ::: "memory");
        if (lane < 16) {
            LAS float* sr = Lg + lane * 65; const int trow = rbase + lane;
            float gs[8];
#pragma unroll
            for (int g = 0; g < 8; ++g) { float m1 = -1e30f, m2 = -1e30f;
                for (int j = 0; j < 8; ++j) { const int e = 8 * g + j; const float s = sigmoidf_(sr[e]); sr[e] = s; const float vv = s + rbias[e];
                    if (vv > m1) { m2 = m1; m1 = vv; } else if (vv > m2) m2 = vv; }
                gs[g] = m1 + m2; }
            unsigned gmask = 0u;
#pragma unroll
            for (int it = 0; it < 4; ++it) { float best = -1e30f; int bi = 0;
#pragma unroll
                for (int g = 0; g < 8; ++g) { const bool ok = !((gmask >> g) & 1u) && gs[g] > best; best = ok ? gs[g] : best; bi = ok ? g : bi; }
                gmask |= 1u << bi; }
            unsigned long long taken = 0ull; int sel[8]; float sw[8]; float wsum = 0.f;
#pragma unroll
            for (int k = 0; k < 8; ++k) { float best = -1e30f; int bi = 0;
                for (int e = 0; e < 64; ++e) { const bool cand = ((gmask >> (e >> 3)) & 1u) && !((taken >> e) & 1ull); const float vv = sr[e] + rbias[e];
                    if (cand && vv > best) { best = vv; bi = e; } }
                taken |= 1ull << bi; sel[k] = bi; sw[k] = sr[bi]; wsum += sw[k]; }
            const float inv = 2.5f / wsum;
#pragma unroll
            for (int k = 0; k < 8; ++k) { const int a = trow * 8 + k; const int pos = atomicAdd(&cnt[sel[k]], 1);
                LIST[(size_t)sel[k] * TT + pos] = a; PK[a] = ((unsigned)sel[k] << 16) | (unsigned)pos; LW[a] = sw[k] * inv * 4.0f; }
            LIST[(size_t)64 * TT + (trow - r0)] = 8 * TT + trow;
        }
    }
}
namespace att {
constexpr int D = 128, NW = 8, QBLK = 32, KVBLK = 64;
constexpr float SCALE = 0.088388347648318440f;
constexpr float THR = 8.f;
constexpr int SHM_V = KVBLK * D * 2, SHM_K = KVBLK * D * 2, SHM_ATTN = 2 * SHM_V + 2 * SHM_K + NW * 64 * 4;
#define KSWZ(row, colB) ((row) * 256 + ((colB) ^ (((row) & 7) << 4)))
#define SBAR() __builtin_amdgcn_sched_barrier(0)
__device__ __forceinline__ int crow(int r, int hi) { return (r & 3) + 8 * (r >> 2) + 4 * hi; }
__device__ __forceinline__ unsigned cvtpk(float lo, float hi) { unsigned r; asm volatile("v_cvt_pk_bf16_f32 %0, %1, %2" : "=v"(r) : "v"(lo), "v"(hi)); return r; }

__device__ __forceinline__ void partialSM(f32x16& p0, f32x16& p1, float negMC) {
  constexpr float Cc = SCALE * 1.4426950408889634f;
  for (int r = 0; r < 16; ++r) p0[r] = fmaf(p0[r], Cc, negMC); for (int r = 0; r < 16; ++r) p1[r] = fmaf(p1[r], Cc, negMC);
  for (int r = 0; r < 16; ++r) p0[r] = __builtin_amdgcn_exp2f(p0[r]);
}
__device__ __forceinline__ void finishSM(f32x16& p0, f32x16& p1, float& l_reg, bf16x8& pa0, bf16x8& pa1, bf16x8& pa2, bf16x8& pa3) {
  for (int r = 0; r < 16; ++r) p1[r] = __builtin_amdgcn_exp2f(p1[r]);
  float ps = 0; for (int r = 0; r < 16; ++r) ps += p0[r]; for (int r = 0; r < 16; ++r) ps += p1[r];
  { auto rr = __builtin_amdgcn_permlane32_swap(__float_as_uint(ps), __float_as_uint(ps), false, false);
    ps = __uint_as_float(rr[0]) + __uint_as_float(rr[1]); }
  l_reg += ps;
#define PK4(P, BASE, OUT) do { unsigned a0 = cvtpk(P[BASE + 0], P[BASE + 1]), a1 = cvtpk(P[BASE + 2], P[BASE + 3]);   \
    unsigned b0 = cvtpk(P[BASE + 4], P[BASE + 5]), b1 = cvtpk(P[BASE + 6], P[BASE + 7]);                              \
    auto r0 = __builtin_amdgcn_permlane32_swap(a0, b0, false, false); auto r1 = __builtin_amdgcn_permlane32_swap(a1, b1, false, false); \
    u32x4 w = {r0[0], r1[0], r0[1], r1[1]}; OUT = *reinterpret_cast<bf16x8*>(&w); } while (0)
  PK4(p0, 0, pa0); PK4(p0, 8, pa1); PK4(p1, 0, pa2); PK4(p1, 8, pa3);
#undef PK4
}
__device__ __forceinline__ void qkt(f32x16& p0, f32x16& p1, const LAS char* Ks, const bf16x8* qr, int r32, int hi) {
  p0 = f32x16{}; p1 = f32x16{};
  for (int d0 = 0; d0 < 8; ++d0) { int cb = (d0 * 16 + hi * 8) * 2;
    bf16x8 b0 = *reinterpret_cast<const LAS bf16x8*>(Ks + KSWZ(r32, cb));
    bf16x8 b1 = *reinterpret_cast<const LAS bf16x8*>(Ks + KSWZ(32 + r32, cb));
    p0 = __builtin_amdgcn_mfma_f32_32x32x16_bf16(b0, qr[d0], p0, 0, 0, 0);
    p1 = __builtin_amdgcn_mfma_f32_32x32x16_bf16(b1, qr[d0], p1, 0, 0, 0); }
}
__device__ __forceinline__ int v_st(int k, int c) { const int kk = (k & ~0xC) | ((k & 4) << 1) | ((k & 8) >> 1); return ((kk >> 3) * 4 + (c >> 5)) * 512 + ((kk & 7) * 32 + (c & 31)) * 2; }
__device__ __forceinline__ int v_rd_base(int lane) { return ((lane & 3) << 3) | (((lane >> 2) & 3) << 6) | (((lane >> 4) & 1) << 5) | (((lane >> 5) & 1) << 8); }
constexpr int v_rd_off(int d0, int ks, int half) { return d0 * 512 + ks * 4096 + half * 2048; }
template <int OFF> __device__ __forceinline__ s16x4 tr_read(int vb) {
  s16x4 r; asm volatile("ds_read_b64_tr_b16 %0, %1 offset:%2" : "=&v"(r) : "v"(vb), "i"(OFF) : "memory"); return r;
}
template <int D0> __device__ __forceinline__ void pv_one(f32x16& od, int vb, bf16x8 pa0, bf16x8 pa1, bf16x8 pa2, bf16x8 pa3) {
  const s16x4 l0 = tr_read<v_rd_off(D0, 0, 0)>(vb), h0 = tr_read<v_rd_off(D0, 0, 1)>(vb), l1 = tr_read<v_rd_off(D0, 1, 0)>(vb), h1 = tr_read<v_rd_off(D0, 1, 1)>(vb);
  const s16x4 l2 = tr_read<v_rd_off(D0, 2, 0)>(vb), h2 = tr_read<v_rd_off(D0, 2, 1)>(vb), l3 = tr_read<v_rd_off(D0, 3, 0)>(vb), h3 = tr_read<v_rd_off(D0, 3, 1)>(vb);
  asm volatile("s_waitcnt lgkmcnt(0)" ::: "memory"); SBAR();
#define PK(L, H) (bf16x8){L[0], L[1], L[2], L[3], H[0], H[1], H[2], H[3]}
  od = __builtin_amdgcn_mfma_f32_32x32x16_bf16(pa0, PK(l0, h0), od, 0, 0, 0);
  od = __builtin_amdgcn_mfma_f32_32x32x16_bf16(pa1, PK(l1, h1), od, 0, 0, 0);
  od = __builtin_amdgcn_mfma_f32_32x32x16_bf16(pa2, PK(l2, h2), od, 0, 0, 0);
  od = __builtin_amdgcn_mfma_f32_32x32x16_bf16(pa3, PK(l3, h3), od, 0, 0, 0);
#undef PK
}
__device__ __forceinline__ void pv_d0(f32x16* o, int vb, bf16x8 pa0, bf16x8 pa1, bf16x8 pa2, bf16x8 pa3) {
  pv_one<0>(o[0], vb, pa0, pa1, pa2, pa3); pv_one<1>(o[1], vb, pa0, pa1, pa2, pa3); pv_one<2>(o[2], vb, pa0, pa1, pa2, pa3); pv_one<3>(o[3], vb, pa0, pa1, pa2, pa3);
}

template <int LDQ, int LDK, int LDO>
__device__ __forceinline__ void attn_dense_body(const bf16_t* __restrict__ Qb, const bf16_t* __restrict__ Kh, const bf16_t* __restrict__ Vh, bf16_t* __restrict__ Ob, int seq, LAS char* lds, int tid, float kmax2) {
  const int wid = tid >> 6, lane = tid & 63, r32 = lane & 31, hi = lane >> 5;
  LAS char* V_lds = lds; LAS char* K_lds = lds + 2 * SHM_V;
  LAS float* ws = (LAS float*)(lds + 2 * SHM_V + 2 * SHM_K) + wid * 64; LAS float* li_l = ws;
  float l_reg = 0; f32x16 o[4] = {}; bf16x8 qr[8];
  const bf16_t* Qw = Qb + (long)(wid * QBLK + r32) * LDQ + hi * 8;
#pragma unroll
  for (int d0 = 0; d0 < 8; ++d0) qr[d0] = *reinterpret_cast<const bf16x8*>(Qw + d0 * 16);
  float negMC;
  { float q2 = 0.f;
#pragma unroll
    for (int d0 = 0; d0 < 8; ++d0) { const u32x4 w = __builtin_bit_cast(u32x4, qr[d0]);
      q2 += bflo(w.x) * bflo(w.x) + bfhi(w.x) * bfhi(w.x) + bflo(w.y) * bflo(w.y) + bfhi(w.y) * bfhi(w.y) + bflo(w.z) * bflo(w.z) + bfhi(w.z) * bfhi(w.z) + bflo(w.w) * bflo(w.w) + bfhi(w.w) * bfhi(w.w); }
    auto rr = __builtin_amdgcn_permlane32_swap(__float_as_uint(q2), __float_as_uint(q2), false, false);
    q2 = __uint_as_float(rr[0]) + __uint_as_float(rr[1]);
    negMC = -(sqrtf(q2 * kmax2) * (SCALE * 1.0001f) - 30.0f) * 1.4426950408889634f; }
  const int sr = tid >> 4, sc = (tid & 15) * 8, vst0 = v_st(sr, sc), vst1 = v_st(32 + sr, sc);
  const int vb0 = (int)(uintptr_t)V_lds + v_rd_base(lane);
  struct { bf16x8 vs0, vs1, ks0, ks1; } sr_[2];
#define SLOAD(i, k0) do { sr_[i].vs0 = *reinterpret_cast<const bf16x8*>(&Vh[(long)((k0) + sr) * LDK + sc]); sr_[i].vs1 = *reinterpret_cast<const bf16x8*>(&Vh[(long)((k0) + 32 + sr) * LDK + sc]); \
    sr_[i].ks0 = *reinterpret_cast<const bf16x8*>(&Kh[(long)((k0) + sr) * LDK + sc]); sr_[i].ks1 = *reinterpret_cast<const bf16x8*>(&Kh[(long)((k0) + 32 + sr) * LDK + sc]); } while (0)
#define SWRITE(b, i) do { *(LAS bf16x8*)(V_lds + (b) * SHM_V + vst0) = sr_[i].vs0;          \
    *(LAS bf16x8*)(V_lds + (b) * SHM_V + vst1) = sr_[i].vs1; int kc = sc * 2;               \
    *(LAS bf16x8*)(K_lds + (b) * SHM_K + KSWZ(sr, kc)) = sr_[i].ks0;                       \
    *(LAS bf16x8*)(K_lds + (b) * SHM_K + KSWZ(32 + sr, kc)) = sr_[i].ks1; } while (0)
#define SWAIT() asm volatile("s_waitcnt vmcnt(4)" ::: "memory")
  f32x16 pA0, pA1, pB0, pB1; bf16x8 pa0, pa1, pa2, pa3; const int NT = seq / KVBLK;
  constexpr int SE = 0, SO = 1;
  SLOAD(SE, 0); asm volatile("s_waitcnt vmcnt(0)" ::: "memory"); SWRITE(0, SE); __syncthreads();
  qkt(pA0, pA1, K_lds, qr, r32, hi); partialSM(pA0, pA1, negMC);
  SLOAD(SO, KVBLK); if (2 < NT) SLOAD(SE, 2 * KVBLK);
  SWAIT(); SWRITE(1, SO); __syncthreads();
  for (int j = 1; j + 1 < NT; j += 2) {
    SBAR(); qkt(pB0, pB1, K_lds + SHM_K, qr, r32, hi);
    finishSM(pA0, pA1, l_reg, pa0, pa1, pa2, pa3); SBAR();
    SLOAD(SO, (j + 2) * KVBLK); SBAR();
    pv_d0(o, vb0, pa0, pa1, pa2, pa3); partialSM(pB0, pB1, negMC);
    __syncthreads(); SWAIT(); SWRITE(0, SE);
    __syncthreads();
    SBAR(); qkt(pA0, pA1, K_lds, qr, r32, hi);
    finishSM(pB0, pB1, l_reg, pa0, pa1, pa2, pa3); SBAR();
    if (j + 3 < NT) SLOAD(SE, (j + 3) * KVBLK); SBAR();
    pv_d0(o, vb0 + (int)SHM_V, pa0, pa1, pa2, pa3); partialSM(pA0, pA1, negMC);
    __syncthreads(); SWAIT(); SWRITE(1, SO);
    __syncthreads();
  }
  SBAR(); qkt(pB0, pB1, K_lds + SHM_K, qr, r32, hi);
  finishSM(pA0, pA1, l_reg, pa0, pa1, pa2, pa3); SBAR();
  pv_d0(o, vb0, pa0, pa1, pa2, pa3); partialSM(pB0, pB1, negMC);
  __syncthreads();
  finishSM(pB0, pB1, l_reg, pa0, pa1, pa2, pa3); SBAR();
  pv_d0(o, vb0 + (int)SHM_V, pa0, pa1, pa2, pa3);
  if (hi == 0) li_l[r32] = l_reg; asm volatile("s_waitcnt lgkmcnt(0)" ::: "memory");
  float rli[16];
#pragma unroll
  for (int r = 0; r < 16; ++r) rli[r] = __builtin_amdgcn_rcpf(li_l[crow(r, hi)]);
  bf16_t* Ow = Ob + (long)(wid * QBLK) * LDO;
#pragma unroll
  for (int r = 0; r < 16; ++r) { int orow = crow(r, hi);
    for (int d0 = 0; d0 < 4; ++d0) Ow[(long)orow * LDO + d0 * 32 + r32] = (bf16_t)(cvtpk(o[d0][r] * rli[r], 0.f) & 0xffffu); }
#undef SLOAD
#undef SWRITE
#undef SWAIT
}

typedef int v8i32a __attribute__((ext_vector_type(8)));
typedef int v4i32a __attribute__((ext_vector_type(4)));
#define KSW8(row, chunk) ((row) * 128 + ((((chunk) ^ (((row) >> 1) & 7))) << 4))
#define VSW8(d, chunk) ((d) * 64 + ((((chunk) ^ (((d) >> 2) & 3))) << 4))
#define MFMA8(a, b, c) __builtin_amdgcn_mfma_scale_f32_32x32x64_f8f6f4((a), (b), (c), 0, 0, 0, 0, 0, 0)
__device__ __forceinline__ v8i32a ld32_l(const LAS char* p0, const LAS char* p1) { return __builtin_shufflevector(*(const LAS v4i32a*)p0, *(const LAS v4i32a*)p1, 0, 1, 2, 3, 4, 5, 6, 7); }
__device__ __forceinline__ unsigned pk4f8(float a, float b, float c, float d) { unsigned w = (unsigned)__builtin_amdgcn_cvt_pk_fp8_f32(a, b, 0, false); return (unsigned)__builtin_amdgcn_cvt_pk_fp8_f32(c, d, (int)w, true); }
template <int LDO, int KSTR>
__device__ __forceinline__ void attn_dense8_body(const unsigned char* __restrict__ Q8b, const unsigned char* __restrict__ K8h, const unsigned char* __restrict__ VT8h, bf16_t* __restrict__ Ob, int seq, LAS char* lds, int tid, float kmax2) {
  const int wid = tid >> 6, lane = tid & 63, r32 = lane & 31, hi = lane >> 5;
  constexpr int RS = 6, PD = 4;
  LAS float* al_l = (LAS float*)(lds + RS * 16384) + wid * 32;
  f32x16 o[4] = {}; v8i32a qf[2];
  { const unsigned char* qp = Q8b + (size_t)(wid * QBLK + r32) * 1024 + 32 * hi;
    qf[0] = __builtin_shufflevector(*(const v4i32a*)qp, *(const v4i32a*)(qp + 16), 0, 1, 2, 3, 4, 5, 6, 7);
    qf[1] = __builtin_shufflevector(*(const v4i32a*)(qp + 64), *(const v4i32a*)(qp + 80), 0, 1, 2, 3, 4, 5, 6, 7); }
  (void)kmax2;
  constexpr float THR8 = 1.4426950408889634f;
  float m_reg = 0.f; f32x16 osum = {}; v8i32a ones = {0x38383838, 0x38383838, 0x38383838, 0x38383838, 0x38383838, 0x38383838, 0x38383838, 0x38383838}; asm volatile("" : "+v"(ones));
#define PSM8(P0, P1, DL, CN, FIRST) do { float pmax = P0[0]; for (int r = 1; r < 16; ++r) pmax = fmaxf(pmax, P0[r]); for (int r = 0; r < 16; ++r) pmax = fmaxf(pmax, P1[r]); \
      { auto rr = __builtin_amdgcn_permlane32_swap(__float_as_uint(pmax), __float_as_uint(pmax), false, false); pmax = fmaxf(__uint_as_float(rr[0]), __uint_as_float(rr[1])); } \
      const float mn = (FIRST) ? pmax : ((pmax - m_reg > THR8) ? pmax : m_reg); DL = (FIRST) ? 0.f : mn - m_reg; m_reg = mn; CN = 7.0f - mn; \
      for (int r = 0; r < 16; ++r) P0[r] = __builtin_amdgcn_exp2f(P0[r] + CN); } while (0)
#define RESC8(DL) do { if (__any((DL) > 0.f)) { if (hi == 0) al_l[r32] = __builtin_amdgcn_exp2f(-(DL)); asm volatile("s_waitcnt lgkmcnt(0)" ::: "memory"); \
      for (int d = 0; d < 4; ++d) for (int r = 0; r < 16; ++r) o[d][r] *= al_l[crow(r, hi)]; for (int r = 0; r < 16; ++r) osum[r] *= al_l[crow(r, hi)]; } } while (0)
  const unsigned kgo = (unsigned)((tid >> 3) * KSTR + 16 * ((tid & 7) ^ ((tid >> 4) & 7))), vgo = (unsigned)((tid >> 2) * 64 + 16 * ((tid & 3) ^ ((tid >> 4) & 3)));
  const unsigned ldw = (unsigned)wid * 1024u;
#define DMA8(slot, T_) do { __builtin_amdgcn_global_load_lds((const unsigned*)(K8h + (size_t)(T_) * (64 * KSTR) + kgo), (LAS unsigned*)(lds + (slot) * 16384 + ldw), 16, 0, 0); \
      __builtin_amdgcn_global_load_lds((const unsigned*)(VT8h + (size_t)(T_) * 8192 + vgo), (LAS unsigned*)(lds + (slot) * 16384 + 8192 + ldw), 16, 0, 0); } while (0)
#define DWAIT8() do { asm volatile("s_waitcnt vmcnt(6)\n\ts_waitcnt lgkmcnt(0)" ::: "memory"); __builtin_amdgcn_s_barrier(); asm volatile("" ::: "memory"); } while (0)
#define QK8(P0, P1, KB) do { P0 = f32x16{}; P1 = f32x16{}; _Pragma("unroll") for (int s = 0; s < 2; ++s) { \
      const v8i32a k0 = ld32_l((KB) + KSW8(r32, 4 * s + 2 * hi), (KB) + KSW8(r32, 4 * s + 2 * hi + 1)); \
      const v8i32a k1 = ld32_l((KB) + KSW8(32 + r32, 4 * s + 2 * hi), (KB) + KSW8(32 + r32, 4 * s + 2 * hi + 1)); \
      P0 = MFMA8(k0, qf[s], P0); P1 = MFMA8(k1, qf[s], P1); } } while (0)
#define FIN8(P0, P1, CN) do { for (int r = 0; r < 16; ++r) P1[r] = __builtin_amdgcn_exp2f(P1[r] + CN); \
      _Pragma("unroll") for (int i = 0; i < 4; ++i) { pa[i] = (int)pk4f8(P0[4 * i], P0[4 * i + 1], P0[4 * i + 2], P0[4 * i + 3]); pa[4 + i] = (int)pk4f8(P1[4 * i], P1[4 * i + 1], P1[4 * i + 2], P1[4 * i + 3]); } } while (0)
#define PV8(VB) do { _Pragma("unroll") for (int d0 = 0; d0 < 4; ++d0) { \
      const v8i32a vf = ld32_l((VB) + VSW8(32 * d0 + r32, 2 * hi), (VB) + VSW8(32 * d0 + r32, 2 * hi + 1)); \
      o[d0] = MFMA8(pa, vf, o[d0]); } osum = MFMA8(pa, ones, osum); } while (0)
#define LDK8(KB, s, half) ld32_l((KB) + KSW8(32 * (half) + r32, 4 * (s) + 2 * hi), (KB) + KSW8(32 * (half) + r32, 4 * (s) + 2 * hi + 1))
#define LDV8(VB, d0) ld32_l((VB) + VSW8(32 * (d0) + r32, 2 * hi), (VB) + VSW8(32 * (d0) + r32, 2 * hi + 1))
#define EXPN(P, r0, n, CN) do { _Pragma("unroll") for (int r = (r0); r < (r0) + (n); ++r) { float e_ = __builtin_amdgcn_exp2f(P[r] + (CN)); asm volatile("" : "+v"(e_)); P[r] = e_; } } while (0)
#define FINP(P0, P1, CN, i) do { EXPN(P1, 4 * (i), 4, CN); \
      { unsigned w_ = (unsigned)__builtin_amdgcn_cvt_pk_fp8_f32(P0[4 * (i)], P0[4 * (i) + 1], pa[i], false); pa[i] = __builtin_amdgcn_cvt_pk_fp8_f32(P0[4 * (i) + 2], P0[4 * (i) + 3], (int)w_, true); } \
      { unsigned w_ = (unsigned)__builtin_amdgcn_cvt_pk_fp8_f32(P1[4 * (i)], P1[4 * (i) + 1], pa[4 + (i)], false); pa[4 + (i)] = __builtin_amdgcn_cvt_pk_fp8_f32(P1[4 * (i) + 2], P1[4 * (i) + 3], (int)w_, true); } } while (0)
#define PINA(x, y) asm volatile("" : "+v"(x), "+v"(y))
#define PIN1(x) asm volatile("" : "+v"(x))
#define PINC(x, y) asm volatile("" :: "v"(x), "v"(y))
#define HSTEP(X0, X1, DLX, CNX, Y0, Y1, CNY, KB, VB, STAGE_LOAD) do { \
      v8i32a ka_ = LDK8(KB, 0, 0), kb_ = LDK8(KB, 0, 1), kc_ = LDK8(KB, 1, 0), kd_ = LDK8(KB, 1, 1); \
      X0 = MFMA8(ka_, qf[0], f32x16{}); PINA(X0, kb_); \
      FINP(Y0, Y1, CNY, 0); PINC(pa[0], pa[4]); PIN1(kb_); \
      X1 = MFMA8(kb_, qf[0], f32x16{}); PINA(X1, kc_); \
      FINP(Y0, Y1, CNY, 1); PINC(pa[1], pa[5]); PIN1(kc_); \
      X0 = MFMA8(kc_, qf[1], X0); PINA(X0, kd_); \
      v8i32a v0_ = LDV8(VB, 0), v1_ = LDV8(VB, 1); \
      FINP(Y0, Y1, CNY, 2); STAGE_LOAD; PINC(pa[2], pa[6]); PIN1(kd_); \
      X1 = MFMA8(kd_, qf[1], X1); PINA(X1, v0_); \
      v8i32a v2_ = LDV8(VB, 2), v3_ = LDV8(VB, 3); \
      FINP(Y0, Y1, CNY, 3); PINC(pa[3], pa[7]); PINA(pa, v0_); \
      o[0] = MFMA8(pa, v0_, o[0]); PINA(o[0], v1_); \
      float pm0_ = X0[0]; _Pragma("unroll") for (int r = 1; r < 16; ++r) pm0_ = fmaxf(pm0_, X0[r]); PINA(pm0_, v1_); \
      o[1] = MFMA8(pa, v1_, o[1]); PINA(o[1], v2_); \
      _Pragma("unroll") for (int r = 0; r < 16; ++r) pm0_ = fmaxf(pm0_, X1[r]); \
      { auto rr = __builtin_amdgcn_permlane32_swap(__float_as_uint(pm0_), __float_as_uint(pm0_), false, false); pm0_ = fmaxf(__uint_as_float(rr[0]), __uint_as_float(rr[1])); } \
      { const float mn = (pm0_ - m_reg > THR8) ? pm0_ : m_reg; DLX = mn - m_reg; m_reg = mn; CNX = 7.0f - mn; } PINA(CNX, v2_); \
      o[2] = MFMA8(pa, v2_, o[2]); PINA(o[2], v3_); \
      EXPN(X0, 0, 5, CNX); PIN1(v3_); \
      o[3] = MFMA8(pa, v3_, o[3]); PINA(o[3], CNX); \
      EXPN(X0, 5, 5, CNX); PIN1(pa); \
      osum = MFMA8(pa, ones, osum); PINA(osum, CNX); \
      EXPN(X0, 10, 6, CNX); } while (0)
  f32x16 pA0, pA1, pB0, pB1; v8i32a pa = {}; float dlA, dlB, cnA, cnB; const int NT = seq / KVBLK;
#define SLOT(s) (lds + (s) * 16384)
#define SADV() do { sv = sk; sk = sk + 1 == RS ? 0 : sk + 1; sd = sd + 1 == RS ? 0 : sd + 1; } while (0)
  int sk = 0, sv = 0, sd = PD;
  DMA8(0, 0); DMA8(1, 1); DMA8(2, 2); DMA8(3, 3);
  DWAIT8();
  QK8(pA0, pA1, SLOT(0)); PSM8(pA0, pA1, dlA, cnA, true);
  DMA8(sd, PD); SADV(); DWAIT8();
  for (int j = 1; j + 1 < NT; j += 2) {
    HSTEP(pB0, pB1, dlB, cnB, pA0, pA1, cnA, SLOT(sk), SLOT(sv) + 8192, DMA8(sd, min(j + PD, NT - 1)));
    RESC8(dlB); SADV(); DWAIT8();
    HSTEP(pA0, pA1, dlA, cnA, pB0, pB1, cnB, SLOT(sk), SLOT(sv) + 8192, DMA8(sd, min(j + 1 + PD, NT - 1)));
    RESC8(dlA); SADV(); DWAIT8();
  }
  HSTEP(pB0, pB1, dlB, cnB, pA0, pA1, cnA, SLOT(sk), SLOT(sv) + 8192, (void)0);
  RESC8(dlB); SADV();
  FIN8(pB0, pB1, cnB); SBAR();
  PV8(SLOT(sv) + 8192);
  asm volatile("s_waitcnt vmcnt(0)" ::: "memory");
  float rli[16];
#pragma unroll
  for (int r = 0; r < 16; ++r) rli[r] = __builtin_amdgcn_rcpf(osum[r]);
  bf16_t* Ow = Ob + (long)(wid * QBLK) * LDO;
#pragma unroll
  for (int r = 0; r < 16; ++r) { int orow = crow(r, hi);
    for (int d0 = 0; d0 < 4; ++d0) Ow[(long)orow * LDO + d0 * 32 + r32] = (bf16_t)(cvtpk(o[d0][r] * rli[r], 0.f) & 0xffffu); }
#undef PSM8
#undef RESC8
#undef DMA8
#undef DWAIT8
#undef SLOT
#undef SADV
#undef QK8
#undef FIN8
#undef PV8
#undef HSTEP
#undef PINA
#undef PIN1
#undef PINC
#undef FINP
#undef EXPN
#undef LDK8
#undef LDV8
}

template <int LDO, int KSTR>
__device__ __forceinline__ void attn_dense8w_body(const unsigned char* __restrict__ Q8b, const unsigned char* __restrict__ K8h, const unsigned char* __restrict__ VT8h0, const unsigned char* __restrict__ VT8h1, bf16_t* __restrict__ Ob, int seq, LAS char* lds, int tid, float kmax2) {
  const int wid = tid >> 6, lane = tid & 63, r32 = lane & 31, hi = lane >> 5;
  constexpr int RS = 4, PD = 2, SB = 24576;
  LAS float* al_l = (LAS float*)(lds + RS * SB) + wid * 32;
  LAS char* q_l = lds + RS * SB + 2048 + wid * 4096 + lane * 16;
  { const unsigned char* qp = Q8b + (size_t)(wid * QBLK + r32) * 1024 + 32 * hi;
    *(LAS v4i32a*)(q_l) = *(const v4i32a*)qp; *(LAS v4i32a*)(q_l + 1024) = *(const v4i32a*)(qp + 16);
    *(LAS v4i32a*)(q_l + 2048) = *(const v4i32a*)(qp + 64); *(LAS v4i32a*)(q_l + 3072) = *(const v4i32a*)(qp + 80); }
  (void)kmax2;
  constexpr float THR8 = 1.4426950408889634f;
  float l_reg = 0.f, m_reg = 0.f; f32x16 o[8] = {};
  const unsigned kgo = (unsigned)((tid >> 3) * KSTR + 16 * ((tid & 7) ^ ((tid >> 4) & 7))), vgo = (unsigned)((tid >> 2) * 64 + 16 * ((tid & 3) ^ ((tid >> 4) & 3)));
  const unsigned ldw = (unsigned)wid * 1024u;
#define DMA8(slot, T_) do { __builtin_amdgcn_global_load_lds((const unsigned*)(K8h + (size_t)(T_) * (64 * KSTR) + kgo), (LAS unsigned*)(lds + (slot) * SB + ldw), 16, 0, 0); \
      __builtin_amdgcn_global_load_lds((const unsigned*)(VT8h0 + (size_t)(T_) * 8192 + vgo), (LAS unsigned*)(lds + (slot) * SB + 8192 + ldw), 16, 0, 0); \
      __builtin_amdgcn_global_load_lds((const unsigned*)(VT8h1 + (size_t)(T_) * 8192 + vgo), (LAS unsigned*)(lds + (slot) * SB + 16384 + ldw), 16, 0, 0); } while (0)
#define DWAIT8() do { asm volatile("s_waitcnt vmcnt(3)\n\ts_waitcnt lgkmcnt(0)" ::: "memory"); __builtin_amdgcn_s_barrier(); asm volatile("" ::: "memory"); } while (0)
#define SLOT(s) (lds + (s) * SB)
#define SADV() do { sv = sk; sk = sk + 1 == RS ? 0 : sk + 1; sd = sd + 1 == RS ? 0 : sd + 1; } while (0)
#define LDK8(KB, s, half) ld32_l((KB) + KSW8(32 * (half) + r32, 4 * (s) + 2 * hi), (KB) + KSW8(32 * (half) + r32, 4 * (s) + 2 * hi + 1))
#define LDV8(VB, d0) ld32_l((VB) + VSW8(32 * (d0) + r32, 2 * hi), (VB) + VSW8(32 * (d0) + r32, 2 * hi + 1))
#define PIN1(x) asm volatile("" : "+v"(x))
#define EXPR(e0, n) do { _Pragma("unroll") for (int e = (e0); e < (e0) + (n); ++e) { float x_ = e < 16 ? X0[e & 15] : X1[e & 15]; float e_ = __builtin_amdgcn_exp2f(x_ + cn); asm volatile("" : "+v"(e_)); ps += e_; \
      if (e < 16) X0[e & 15] = e_; else X1[e & 15] = e_; } } while (0)
#define PKW(PAC, w) do { if ((w) < 4) { unsigned w_ = (unsigned)__builtin_amdgcn_cvt_pk_fp8_f32(X0[4 * ((w) & 3)], X0[4 * ((w) & 3) + 1], PAC[w], false); PAC[w] = __builtin_amdgcn_cvt_pk_fp8_f32(X0[4 * ((w) & 3) + 2], X0[4 * ((w) & 3) + 3], (int)w_, true); } \
      else { unsigned w_ = (unsigned)__builtin_amdgcn_cvt_pk_fp8_f32(X1[4 * ((w) & 3)], X1[4 * ((w) & 3) + 1], PAC[w], false); PAC[w] = __builtin_amdgcn_cvt_pk_fp8_f32(X1[4 * ((w) & 3) + 2], X1[4 * ((w) & 3) + 3], (int)w_, true); } } while (0)
#define PVM(PAP, g) do { PIN1(vv##g); o[4 * ((g) & 1) + ((g) >> 1)] = MFMA8(PAP, vv##g, o[4 * ((g) & 1) + ((g) >> 1)]); asm volatile("" :: "v"(o[4 * ((g) & 1) + ((g) >> 1)])); } while (0)
#define LDVG(g) ({ int o_ = sv * SB + 8192 + 8192 * ((g) & 1); asm volatile("" : "+s"(o_)); LDV8(lds + o_, (g) >> 1); })
#define WSTEP(PAP, PAC, FIRST, TNEXT) do { \
      { const v8i32a ka_ = LDK8(SLOT(sk), 0, 0), kb_ = LDK8(SLOT(sk), 0, 1), kc_ = LDK8(SLOT(sk), 1, 0), kd_ = LDK8(SLOT(sk), 1, 1); \
        const v8i32a q0_ = ld32_l(q_l, q_l + 1024), q1_ = ld32_l(q_l + 2048, q_l + 3072); \
        X0 = MFMA8(ka_, q0_, f32x16{}); X1 = MFMA8(kb_, q0_, f32x16{}); X0 = MFMA8(kc_, q1_, X0); X1 = MFMA8(kd_, q1_, X1); PIN1(X1); } \
      DMA8(sd, TNEXT); \
      v8i32a vv0 = LDVG(0), vv1 = LDVG(1); \
      PVM(PAP, 0); v8i32a vv2 = LDVG(2); \
      float pm_ = X0[0]; _Pragma("unroll") for (int r = 1; r < 16; ++r) pm_ = fmaxf(pm_, X0[r]); PIN1(pm_); \
      PVM(PAP, 1); v8i32a vv3 = LDVG(3); \
      _Pragma("unroll") for (int r = 0; r < 16; ++r) pm_ = fmaxf(pm_, X1[r]); \
      { auto rr = __builtin_amdgcn_permlane32_swap(__float_as_uint(pm_), __float_as_uint(pm_), false, false); pm_ = fmaxf(__uint_as_float(rr[0]), __uint_as_float(rr[1])); } \
      const float mn_ = (FIRST) ? pm_ : ((pm_ - m_reg > THR8) ? pm_ : m_reg); const float dl_ = (FIRST) ? 0.f : mn_ - m_reg; m_reg = mn_; float cn = 7.0f - mn_; float ps = 0.f; PIN1(cn); \
      PVM(PAP, 2); v8i32a vv4 = LDVG(4); EXPR(0, 6); PKW(PAC, 0); \
      PVM(PAP, 3); v8i32a vv5 = LDVG(5); EXPR(6, 6); PKW(PAC, 1); PKW(PAC, 2); \
      PVM(PAP, 4); v8i32a vv6 = LDVG(6); EXPR(12, 5); PKW(PAC, 3); \
      PVM(PAP, 5); v8i32a vv7 = LDVG(7); EXPR(17, 5); PKW(PAC, 4); \
      PVM(PAP, 6); EXPR(22, 5); PKW(PAC, 5); \
      PVM(PAP, 7); EXPR(27, 5); PKW(PAC, 6); PKW(PAC, 7); \
      { auto rr = __builtin_amdgcn_permlane32_swap(__float_as_uint(ps), __float_as_uint(ps), false, false); ps = __uint_as_float(rr[0]) + __uint_as_float(rr[1]); } \
      if (__any(dl_ > 0.f)) { const float al_ = __builtin_amdgcn_exp2f(-dl_); l_reg *= al_; if (hi == 0) al_l[r32] = al_; asm volatile("s_waitcnt lgkmcnt(0)" ::: "memory"); \
        for (int d = 0; d < 8; ++d) for (int r = 0; r < 16; ++r) o[d][r] *= al_l[crow(r, hi)]; } \
      l_reg += ps; \
      SADV(); DWAIT8(); } while (0)
  f32x16 X0, X1; v8i32a paA = {}, paB = {}; const int NT = seq / KVBLK;
  int sk = 0, sv = 0, sd = PD;
  DMA8(0, 0); DMA8(1, 1);
  DWAIT8();
  for (int j = 0; j < NT; j += 2) {
    WSTEP(paB, paA, j == 0, min(j + PD, NT - 1));
    WSTEP(paA, paB, false, min(j + 1 + PD, NT - 1));
  }
  { v8i32a vv0 = LDVG(0), vv1 = LDVG(1), vv2 = LDVG(2), vv3 = LDVG(3); PVM(paB, 0); PVM(paB, 1); PVM(paB, 2); PVM(paB, 3); }
  { v8i32a vv4 = LDVG(4), vv5 = LDVG(5), vv6 = LDVG(6), vv7 = LDVG(7); PVM(paB, 4); PVM(paB, 5); PVM(paB, 6); PVM(paB, 7); }
  asm volatile("s_waitcnt vmcnt(0)" ::: "memory");
  int te = tid; asm volatile("" : "+v"(te));
  const int wid_e = te >> 6, r32_e = te & 31, hi_e = (te >> 5) & 1;
  LAS float* li_e = (LAS float*)(lds + RS * SB + 1024) + wid_e * 32;
  if (hi_e == 0) li_e[r32_e] = l_reg; asm volatile("s_waitcnt lgkmcnt(0)" ::: "memory");
  float rli[16];
#pragma unroll
  for (int r = 0; r < 16; ++r) rli[r] = __builtin_amdgcn_rcpf(li_e[crow(r, hi_e)]);
  bf16_t* Ow = Ob + (long)(wid_e * QBLK) * LDO;
#pragma unroll
  for (int r = 0; r < 16; ++r) { int orow = crow(r, hi_e);
    for (int d0 = 0; d0 < 8; ++d0) Ow[(long)orow * LDO + d0 * 32 + r32_e] = (bf16_t)(cvtpk(o[d0][r] * rli[r], 0.f) & 0xffffu); }
#undef DMA8
#undef DWAIT8
#undef SLOT
#undef SADV
#undef LDK8
#undef LDV8
#undef PIN1
#undef EXPR
#undef PKW
#undef PVM
#undef LDVG
#undef WSTEP
}

constexpr int PV_BUF = 32768, PK_BUF = 16384, P_LDS_V = 0, P_LDS_K = 2 * PV_BUF, P_LDS_X = P_LDS_K + 2 * PK_BUF, P_LDS_L = P_LDS_X + 8 * 2048, P_LDS_END = P_LDS_L + 1024;
__device__ __forceinline__ void qkt_half(f32x16& p, const LAS char* Ks, const bf16x8* qr, int krow, int hi) {
  p = f32x16{};
  for (int d0 = 0; d0 < 8; ++d0) { int cb = (d0 * 16 + hi * 8) * 2;
    bf16x8 b0 = *reinterpret_cast<const LAS bf16x8*>(Ks + KSWZ(krow, cb));
    p = __builtin_amdgcn_mfma_f32_32x32x16_bf16(b0, qr[d0], p, 0, 0, 0); }
}
__device__ __forceinline__ void smA(f32x16& p, float negMC) {
  constexpr float Cc = SCALE * 1.4426950408889634f;
  for (int r = 0; r < 16; ++r) p[r] = fmaf(p[r], Cc, negMC);
  for (int r = 0; r < 8; ++r) p[r] = __builtin_amdgcn_exp2f(p[r]);
}
__device__ __forceinline__ void smB(f32x16& p, float& l_reg, bf16x8& f0, bf16x8& f1) {
  for (int r = 8; r < 16; ++r) p[r] = __builtin_amdgcn_exp2f(p[r]);
  float ps = 0; for (int r = 0; r < 16; ++r) ps += p[r];
  { auto rr = __builtin_amdgcn_permlane32_swap(__float_as_uint(ps), __float_as_uint(ps), false, false);
    ps = __uint_as_float(rr[0]) + __uint_as_float(rr[1]); }
  l_reg += ps;
#define PK4(P, BASE, OUT) do { unsigned a0 = cvtpk(P[BASE + 0], P[BASE + 1]), a1 = cvtpk(P[BASE + 2], P[BASE + 3]);   \
    unsigned b0 = cvtpk(P[BASE + 4], P[BASE + 5]), b1 = cvtpk(P[BASE + 6], P[BASE + 7]);                              \
    auto r0 = __builtin_amdgcn_permlane32_swap(a0, b0, false, false); auto r1 = __builtin_amdgcn_permlane32_swap(a1, b1, false, false); \
    u32x4 w = {r0[0], r1[0], r0[1], r1[1]}; OUT = *reinterpret_cast<bf16x8*>(&w); } while (0)
  PK4(p, 0, f0); PK4(p, 8, f1);
#undef PK4
}
template <int LDQ, int LDK, int LDO>
__device__ __forceinline__ void attn_pair_body(const bf16_t* __restrict__ Qb, const bf16_t* __restrict__ Kh, const bf16_t* __restrict__ Vh, bf16_t* __restrict__ Ob, int seq, LAS char* lds, int tid, float kmax2) {
  const int wid = __builtin_amdgcn_readfirstlane(tid >> 6), lane = tid & 63, r32 = lane & 31, hi = lane >> 5, g = wid & 3, kb = wid >> 2;
  LAS char* V_lds = lds + P_LDS_V; LAS char* K_lds = lds + P_LDS_K;
  LAS char* xp_own = lds + P_LDS_X + wid * 2048 + lane * 16; LAS char* xp_par = lds + P_LDS_X + (wid ^ 4) * 2048 + lane * 16;
  LAS float* li = (LAS float*)(lds + P_LDS_L);
  float l_reg = 0; f32x16 o[4] = {}; bf16x8 qr[8];
  const bf16_t* Qw = Qb + (long)(g * QBLK + r32) * LDQ + hi * 8;
#pragma unroll
  for (int d0 = 0; d0 < 8; ++d0) qr[d0] = *reinterpret_cast<const bf16x8*>(Qw + d0 * 16);
  float negMC;
  { float q2 = 0.f;
#pragma unroll
    for (int d0 = 0; d0 < 8; ++d0) { const u32x4 w = __builtin_bit_cast(u32x4, qr[d0]);
      q2 += bflo(w.x) * bflo(w.x) + bfhi(w.x) * bfhi(w.x) + bflo(w.y) * bflo(w.y) + bfhi(w.y) * bfhi(w.y) + bflo(w.z) * bflo(w.z) + bfhi(w.z) * bfhi(w.z) + bflo(w.w) * bflo(w.w) + bfhi(w.w) * bfhi(w.w); }
    auto rr = __builtin_amdgcn_permlane32_swap(__float_as_uint(q2), __float_as_uint(q2), false, false);
    q2 = __uint_as_float(rr[0]) + __uint_as_float(rr[1]);
    negMC = -(sqrtf(q2 * kmax2) * (SCALE * 1.0001f) - 30.0f) * 1.4426950408889634f; }
  const int sr = tid >> 4, sc = (tid & 15) * 8, vst0 = v_st(sr, sc), vst1 = v_st(32 + sr, sc);
  const int vrd = (int)(uintptr_t)V_lds + kb * 16384 + v_rd_base(lane);
  const int krow = 32 * kb + r32;
  struct { bf16x8 v00, v01, v10, v11, k0, k1; } st_;
#define PLD16(base, off) (*reinterpret_cast<const bf16x8*>((const char*)(base) + (off)))
#define PLOAD(k0_) do { const unsigned o_ = (unsigned)(((k0_) + sr) * LDK + sc) * 2u; \
    st_.v00 = PLD16(Vh, o_); st_.v01 = PLD16(Vh, o_ + 256u); st_.v10 = PLD16(Vh, o_ + 64u * LDK); st_.v11 = PLD16(Vh, o_ + 64u * LDK + 256u); \
    st_.k0 = PLD16(Kh, o_); st_.k1 = PLD16(Kh, o_ + 64u * LDK); } while (0)
#define PWRITE(kbuf, vbuf) do { LAS char* vb_ = V_lds + (vbuf) * PV_BUF; LAS char* kb_ = K_lds + (kbuf) * PK_BUF; const int kc = sc * 2; \
    *(LAS bf16x8*)(vb_ + vst0) = st_.v00; *(LAS bf16x8*)(vb_ + 16384 + vst0) = st_.v01; *(LAS bf16x8*)(vb_ + vst1) = st_.v10; *(LAS bf16x8*)(vb_ + 16384 + vst1) = st_.v11; \
    *(LAS bf16x8*)(kb_ + KSWZ(sr, kc)) = st_.k0; *(LAS bf16x8*)(kb_ + KSWZ(32 + sr, kc)) = st_.k1; } while (0)
  const int NT = seq / KVBLK;
  f32x16 pS; bf16x8 f0, f1, g0, g1;
  PLOAD(0); asm volatile("s_waitcnt vmcnt(0)" ::: "memory"); PWRITE(0, 0); PLOAD(KVBLK);
  __syncthreads();
  for (int j = 0; j < NT; ++j) {
    SBAR();
    qkt_half(pS, K_lds + (j & 1) * PK_BUF, qr, krow, hi);
    smA(pS, negMC); smB(pS, l_reg, f0, f1); SBAR();
    *(LAS bf16x8*)(xp_own) = f0; *(LAS bf16x8*)(xp_own + 1024) = f1;
    if (j + 1 < NT) PWRITE((j + 1) & 1, (j + 1) & 1);
    if (j + 2 < NT) PLOAD((j + 2) * KVBLK);
    __syncthreads();
    g0 = *(const LAS bf16x8*)(xp_par); g1 = *(const LAS bf16x8*)(xp_par + 1024);
    { const int vb = vrd + (j & 1) * PV_BUF;
      if (kb == 0) pv_d0(o, vb, f0, f1, g0, g1); else pv_d0(o, vb, g0, g1, f0, f1); }
    __syncthreads();
  }
  if (hi == 0) li[wid * 32 + r32] = l_reg;
  __syncthreads();
#pragma unroll
  for (int r = 0; r < 16; ++r) { const int orow = crow(r, hi); const float rl = __builtin_amdgcn_rcpf(li[wid * 32 + orow] + li[(wid ^ 4) * 32 + orow]);
    bf16_t* op = Ob + (long)(g * QBLK + orow) * LDO + 128 * kb + r32;
    for (int d0 = 0; d0 < 4; ++d0) op[d0 * 32] = (bf16_t)(cvtpk(o[d0][r] * rl, 0.f) & 0xffffu); }
#undef PLD16
#undef PLOAD
#undef PWRITE
}
#undef KSWZ
}

__device__ __forceinline__ void phase_attention(const Params& p, Ctx& C) {
    bf16_t* ATT = (bf16_t*)(p.ws + WS_BIG + BG_ATT);
    const unsigned char* Q8 = (const unsigned char*)(p.ws + WS_BIG + BG_Q8); const unsigned char* K8 = (const unsigned char*)(p.ws + WS_BIG + BG_K8); const unsigned char* VT8 = (const unsigned char*)(p.ws + WS_BIG + BG_VT8);
    const unsigned char* Q8D = (const unsigned char*)(p.ws + WS_BIG + BG_Q8D); const unsigned char* K8D = (const unsigned char*)(p.ws + WS_BIG + BG_K8D); const unsigned char* VT8D = (const unsigned char*)(p.ws + WS_BIG + BG_VT8D);
    for (int i = 0;; ++i) {
        int unit;
        if (C.G == 256) { if (i >= 2) break; unit = (C.bid & 7) * 64 + i * 32 + (C.bid >> 3); } else { unit = i * C.G + C.bid; if (unit >= 512) break; }
        const int d = unit >> 6, qb = unit & 63, hh = d >> 1, m = d & 1;
        __syncthreads();
        int tz = C.tid; asm volatile("" : "+v"(tz));
        att::attn_dense8w_body<3072, 1024>(Q8D + (size_t)(CTXL + 256 * qb) * 1024 + 128 * d, K8D + 128 * d, VT8D + (size_t)(2 * hh) * 260 * 8192, VT8D + (size_t)(2 * hh + 1) * 260 * 8192,
                                           ATT + (size_t)(256 * qb) * 3072 + 1024 + 1024 * m + 256 * hh, TT, (LAS char*)C.lds, tz, 0.f);
    }
    for (int i = 0;; ++i) {
        int unit;
        if (C.G == 256) { if (i >= 2) break; unit = (C.bid & 7) * 64 + i * 32 + (C.bid >> 3); } else { unit = i * C.G + C.bid; if (unit >= 512) break; }
        const int prob = unit >> 6, qb = unit & 63;
        __syncthreads();
        int tz = C.tid; asm volatile("" : "+v"(tz));
        att::attn_dense8_body<3072, 256>(Q8 + (size_t)(CTXL + 256 * qb) * 1024 + 128 * prob, K8 + 128 * (prob >> 2), VT8 + (size_t)(prob >> 2) * 260 * 8192,
                                         ATT + (size_t)(256 * qb) * 3072 + 128 * prob, TT, (LAS char*)C.lds, tz, 0.f);
    }
    __syncthreads();
}
constexpr int PH_PER_LAYER = 13, N_PHASES = 2 + 2 * PH_PER_LAYER;
#ifndef DBL_PHASE
#define DBL_PHASE -1
#endif
#ifndef MK_PER_PHASE
#define MK_PER_PHASE 0
#endif

template <int L>
__device__ __forceinline__ void layer_body(const Params& p, Ctx& C0, const XcdBarrier& bar, LAS unsigned char* misc, int lo, int hi) {
#define IN(k) (lo <= (k) && (k) < hi)
#define SEAM(k) do { if (IN(k) && IN((k) + 1)) xcd_barrier(bar, C0.wave); } while (0)
#define PHASE(k, ...) if (DBL_PHASE == (k)) { int nrep_ = 2; asm volatile("" : "+s"(nrep_)); for (int rep_ = 0; rep_ < nrep_; ++rep_) { if (rep_) xcd_barrier(bar, C0.wave); FRESH(); __VA_ARGS__ } } else if (IN(k)) { FRESH(); __VA_ARGS__ } SEAM(k);
#define FRESH() Ctx C = C0; { int ln = (int)__builtin_amdgcn_mbcnt_hi(~0u, __builtin_amdgcn_mbcnt_lo(~0u, 0u)); asm volatile("" : "+v"(ln)); C.lane = ln; C.tid = C.wave * 64 + ln; }
        const int b = 2 + PH_PER_LAYER * L;
        bf16_t* QKV = (bf16_t*)(p.ws + WS_BIG + BG_QKV);
        bf16_t* XA = (bf16_t*)(p.ws + WS_XA);
        int* cnt = (int*)(p.ws + WS_CTL) + CW_CNT + L * 128; const int* LIST = (const int*)(p.ws + WS_LIST);
        if (L == 0) { PHASE(b + 0, phase_modulate(p, C, L); ) }
        PHASE(b + 1,
            const int N = L ? OD_IN : EV_IN;
            pg8::DenseOrder S; S.init8((const void*)XA, DM, (const void*)(p.ws + (L ? WS_WIN1 : WS_WIN0)), TT, N, DM, C.G, C.bid);
            pg8::EpiStore E{QKV, N, 1.0f / 32.0f};
            pg8::gemm_phase<true>(C.lds, S, E, C.wave);
            if (L == 0 && IN(b + 2) && S.units_of_me() < S.max_units()) conv_queue(p, C, 2);
        )
        PHASE(b + 2, if (L == 0) phase_rope0(p, C); else phase_normrope1(p, C); )
        PHASE(b + 3, if (L == 0) { ret_chunk_kv(p, C); s5_end_states(p, C); } else phase_attention(p, C); )
        PHASE(b + 4, if (L == 0) phase_scans(p, C); else phase_merge1(p, C); )
        if (L == 0) {
            PHASE(b + 5, phase_ret_s5_outputs(p, C, misc); )
            PHASE(b + 6,
                pg8::DenseOrder S; S.init((const bf16_t*)(p.ws + WS_Z), 1024, (const bf16_t*)(p.ws + WS_WGLU), TT, 1024, 1024, C.G, C.bid);
                pg8::EpiGlu E{(const bf16_t*)(p.ws + WS_Z), p.inp(20), (bf16_t*)(p.ws + WS_BIG + BG_MIX)};
                pg8::gemm_phase<false>(C.lds, S, E, C.wave);
                if (IN(b + 7) && S.units_of_me() < S.max_units()) conv_queue(p, C, 4);
            )
        }
        PHASE(b + 7,
            pg8::DenseOrder S;
            if (L == 0) S.init((const bf16_t*)(p.ws + WS_BIG + BG_MIX), DM, (const bf16_t*)(p.ws + WS_WOUT0), TT, DM, DM, C.G, C.bid);
            else S.init((const bf16_t*)(p.ws + WS_BIG + BG_ATT), 3072, (const bf16_t*)(p.ws + WS_WOUT1), SEQ, DM, DM, C.G, C.bid);
            pg8::EpiStore E{(bf16_t*)(p.ws + WS_YMIX) + (L ? (size_t)CTXL * DM : 0), DM, 1.0f};
            pg8::gemm_phase<false>(C.lds, S, E, C.wave);
            if (L == 0 && IN(b + 8) && S.units_of_me() < S.max_units()) conv_queue(p, C, 5);
        )
        PHASE(b + 8, phase_ln1(p, C, L); )
        PHASE(b + 9, phase_router(p, C, L); )
        PHASE(b + 10,
            pg8::MoeOrder<0> S; S.A = (const void*)XA; S.Bt = (const void*)(p.ws + WS_GU + (size_t)L * NEX1 * 1024 * DM); S.list = LIST; S.cnt = cnt; S.ldab = DM; S.kb = DM; S.nN = 4; S.G = C.G; S.c = C.bid; S.bstride = (size_t)1024 * DM;
            S.prep(misc, C.tid);
            pg8::EpiE1 E{(unsigned char*)(p.ws + WS_HX2), S.cn, S.rb};
            pg8::gemm_phase<true>(C.lds, S, E, C.wave);
        )
        PHASE(b + 11,
            pg8::MoeOrder<1> S; S.A = (const void*)(p.ws + WS_HX2); S.Bt = (const void*)(p.ws + WS_DT + (size_t)L * NEX1 * DM * EHID); S.list = LIST; S.cnt = cnt; S.ldab = EHID; S.kb = EHID; S.nN = 8; S.G = C.G; S.c = C.bid; S.bstride = (size_t)DM * EHID;
            S.prep(misc, C.tid);
            pg8::EpiE2 E{(unsigned char*)(p.ws + WS_BIG + BG_YMOE), (const float*)(p.ws + WS_LW), S.cn, S.rb};
            pg8::gemm_phase<true>(C.lds, S, E, C.wave);
        )
        PHASE(b + 12, phase_combine(p, C, L, misc); )
    #undef IN
#undef SEAM
#undef FRESH
#undef PHASE
}

__global__ void __launch_bounds__(NTHR, 2) mega_fwd(KArgs ka) {
    extern __shared__ __attribute__((aligned(16))) unsigned char lds_raw[];
    Ctx C;
    C.lds = (LAS unsigned char*)lds_raw;
    C.tid = threadIdx.x; C.lane = C.tid & 63; C.wave = __builtin_amdgcn_readfirstlane(C.tid >> 6);
    C.G = gridDim.x; C.bid = blockIdx.x; C.gw = C.bid * NWAVES + C.wave; C.ngw = C.G * NWAVES;
    LAS unsigned char* misc = C.lds + MISC_OFF;
    if (C.tid < 8) ((volatile LAS unsigned*)misc)[C.tid] = 0u;
    Params p; p.out = ka.out; p.ws = ka.ws; p.ph_lo = ka.ph_lo; p.ph_hi = ka.ph_hi; p.ptab = (LAS unsigned long long*)(misc + 1024);
    if (C.tid < 34) p.ptab[C.tid] = (unsigned long long)ka.in[C.tid];
    __syncthreads();
    const int lo = p.ph_lo, hi = p.ph_hi;
    XcdBarrier bar; bar.bar = (unsigned*)(p.ws + WS_CTL) + CW_BAR; bar.x = 0; bar.st = (volatile LAS unsigned*)misc;
    if (hi - lo > 1) bar = xcd_barrier_post((unsigned*)(p.ws + WS_CTL) + CW_BAR, (volatile LAS unsigned*)misc);
#define IN(k) (lo <= (k) && (k) < hi)
#define SEAM(k) do { if (IN(k) && IN((k) + 1)) xcd_barrier(bar, C.wave); } while (0)

    if (IN(0)) { phase_p0(p, C); } SEAM(0);
    if (IN(1)) { phase_p1(p, C); } SEAM(1);
    if (IN(0) && IN(2) && (C.G & 7) == 0) {
        volatile LAS unsigned* st = (volatile LAS unsigned*)misc;
        if (C.tid == 0) { unsigned pre = 0u; const unsigned x = st[3];
            for (unsigned j = 0; j < 16; ++j) { const unsigned cj = xb_ld(&bar.bar[XB_XCNT(j)]); pre += (j < x) ? cj : 0u; }
            st[4] = pre + st[2]; }
        __syncthreads();
        const int vcu = (int)st[4], g8 = C.G >> 3;
        C.bid = __builtin_amdgcn_readfirstlane((vcu % g8) * 8 + vcu / g8); C.gw = C.bid * NWAVES + C.wave;
    }

    layer_body<0>(p, C, bar, misc, lo, hi);
    layer_body<1>(p, C, bar, misc, lo, hi);
#undef IN
#undef SEAM
}

extern "C" void kernel_launch(void* const* d_in, const int* in_sizes, int n_in, void* d_out, int out_size, void* d_ws, size_t ws_size, hipStream_t stream) {
    static int grid = 0;
    if (grid == 0) {
        if (n_in != 34 || out_size != SEQ * DM || ws_size < WS_END) { fprintf(stderr, "kernel_launch: unexpected shapes: n_in %d out %d ws %zu (need %zu)\n", n_in, out_size, ws_size, (size_t)WS_END); grid = -1; return; }
        int dev = 0, cus = 0, per_cu = 0;
        if (hipGetDevice(&dev) != hipSuccess || hipDeviceGetAttribute(&cus, hipDeviceAttributeMultiprocessorCount, dev) != hipSuccess) { grid = -1; return; }
        if (hipFuncSetAttribute((const void*)mega_fwd, hipFuncAttributeMaxDynamicSharedMemorySize, LDS_BYTES) != hipSuccess) { fprintf(stderr, "kernel_launch: hipFuncSetAttribute failed\n"); grid = -1; return; }
        if (hipOccupancyMaxActiveBlocksPerMultiprocessor(&per_cu, (const void*)mega_fwd, NTHR, LDS_BYTES) != hipSuccess || per_cu < 1) { fprintf(stderr, "kernel_launch: occupancy query says %d blocks per CU\n", per_cu); grid = -1; return; }
        (void)hipGetLastError();
        grid = cus;
    }
    if (grid < 0) return;
    (void)hipMemsetAsync((char*)d_ws + WS_CTL, 0, CTL_BYTES, stream);
    KArgs p{};
    for (int i = 0; i < 34; ++i) p.in[i] = (const float*)d_in[i];
    p.out = (float*)d_out; p.ws = (unsigned char*)d_ws;
#if MK_PER_PHASE
    for (int ph = 0; ph < N_PHASES; ++ph) {
        if (ph == 2 + PH_PER_LAYER + 0 || ph == 2 + PH_PER_LAYER + 5 || ph == 2 + PH_PER_LAYER + 6) continue;
        p.ph_lo = ph; p.ph_hi = ph + 1;
        hipLaunchKernelGGL(mega_fwd, dim3(grid), dim3(NTHR), LDS_BYTES, stream, p);
    }
#else
    p.ph_lo = 0; p.ph_hi = N_PHASES;
    hipLaunchKernelGGL(mega_fwd, dim3(grid), dim3(NTHR), LDS_BYTES, stream, p);
#endif
    const hipError_t le = hipPeekAtLastError();
    if (le != hipSuccess) fprintf(stderr, "kernel_launch: launch failed: %s\n", hipGetErrorName(le));
}
```

```cpp
#define MK_PER_PHASE 0
#include <hip/hip_runtime.h>
#include <cstdio>
#include <cstdint>

#define GAS __attribute__((address_space(1)))
#define LAS __attribute__((address_space(3)))
typedef unsigned short bf16_t;
typedef short bf16x8 __attribute__((ext_vector_type(8)));
typedef short s16x4 __attribute__((ext_vector_type(4)));
typedef float f32x4 __attribute__((ext_vector_type(4)));
typedef float f32x2 __attribute__((ext_vector_type(2)));
typedef float f32x16 __attribute__((ext_vector_type(16)));
typedef unsigned u32x4 __attribute__((ext_vector_type(4)));
typedef unsigned u32x2 __attribute__((ext_vector_type(2)));

constexpr int DM = 2048, SEQ = 16384, CTXL = 256, TT = SEQ + CTXL;
constexpr int NEXP = 64, NEX1 = 65, EHID = 512, TOPK = 8;
constexpr int EV_IN = 5120, OD_IN = 4608;
constexpr float LN_EPS = 1e-6f;
constexpr float ALPHA = 1.4142135623730951f;
constexpr float LAMBDA_INIT = 0.35550906759f;
constexpr int NTHR = 512, NWAVES = 8;

constexpr size_t al256(size_t x) { return (x + 255) / 256 * 256; }
constexpr size_t WS_CTL   = 0;
constexpr size_t CTL_BYTES = 1u << 20;
constexpr size_t WS_MODP  = WS_CTL + CTL_BYTES;
constexpr size_t WS_MODF  = WS_MODP + al256((size_t)2 * 32 * 2 * 12288 * 4);
constexpr size_t WS_ROPE128 = WS_MODF + al256((size_t)2 * 2 * 12288 * 4);
constexpr size_t WS_ROPE64  = WS_ROPE128 + al256((size_t)256 * 64 * 2 * 4);
constexpr size_t WS_KN    = WS_ROPE64 + al256((size_t)256 * 32 * 2 * 4);
constexpr size_t WS_WT    = WS_KN + al256((size_t)2 * 64 * 16 * 1024 * 2);
constexpr size_t WS_APOW  = WS_WT + al256((size_t)2 * 64 * 128 * 1024 * 2);
constexpr size_t WS_AL    = WS_APOW + al256((size_t)2 * 64 * 64 * 128 * 4);
constexpr size_t WS_CC    = WS_AL + al256((size_t)2 * 64 * 128 * 4);
constexpr size_t WS_BBT   = WS_CC + al256((size_t)64 * 16 * 128 * 2);
constexpr size_t WS_S5E   = WS_BBT + al256((size_t)2 * 64 * 128 * 16 * 2);
constexpr size_t WS_HST   = WS_S5E + al256((size_t)2 * 64 * 260 * 128 * 4);
constexpr size_t WS_WIN0  = WS_HST + al256((size_t)2 * 64 * 260 * 128 * 4);
constexpr size_t WS_WOUT0 = WS_WIN0 + al256((size_t)EV_IN * DM * 2);
constexpr size_t WS_WGLU  = WS_WOUT0 + al256((size_t)DM * DM * 2);
constexpr size_t WS_WIN1  = WS_WGLU + al256((size_t)1024 * 1024 * 2);
constexpr size_t WS_WOUT1 = WS_WIN1 + al256((size_t)OD_IN * DM * 2);
constexpr size_t WS_RWT   = WS_WOUT1 + al256((size_t)DM * DM * 2);
constexpr size_t WS_GU    = WS_RWT + al256((size_t)2 * 2 * 64 * DM * 2);
constexpr size_t WS_DT    = WS_GU + al256((size_t)NEX1 * 1024 * DM * 2);
constexpr size_t WS_XA    = WS_DT + al256((size_t)NEX1 * DM * EHID * 2);
constexpr size_t WS_Z     = WS_XA + al256((size_t)TT * DM * 2);
constexpr size_t WS_YMIX  = WS_Z + al256((size_t)TT * 1024 * 2);
constexpr size_t WS_X1    = WS_YMIX + al256((size_t)TT * DM * 2);
constexpr size_t WS_HX2   = WS_X1 + al256((size_t)TT * DM * 4);
constexpr size_t WS_LIST  = WS_HX2 + al256((size_t)9 * TT * EHID * 2);
constexpr size_t WS_WGT   = WS_LIST + al256((size_t)NEX1 * TT * 4);
constexpr size_t WS_LW    = WS_WGT + al256((size_t)8 * TT * 4);
constexpr size_t WS_BIG   = WS_LW + al256((size_t)NEX1 * TT * 4);
constexpr size_t BG_QKV   = 0;
constexpr size_t BG_CKV   = BG_QKV + al256((size_t)TT * EV_IN * 2);
constexpr size_t BG_SPREV = BG_CKV + al256((size_t)8 * 130 * 65536 * 4);
constexpr size_t BG_MIX   = BG_SPREV + al256((size_t)8 * 130 * 65536 * 2);
constexpr size_t BG_END0  = BG_MIX + al256((size_t)TT * DM * 2);
constexpr size_t BG_ATT   = BG_CKV;
constexpr size_t BG_Q8    = BG_ATT + al256((size_t)SEQ * 3072 * 2);
constexpr size_t BG_K8    = BG_Q8 + al256((size_t)TT * 1024);
constexpr size_t BG_VT8   = BG_K8 + al256((size_t)TT * 256);
constexpr size_t BG_Q8D   = BG_VT8 + al256((size_t)2 * 260 * 128 * 64);
constexpr size_t BG_K8D   = BG_Q8D + al256((size_t)TT * 1024);
constexpr size_t BG_VT8D  = BG_K8D + al256((size_t)TT * 1024);
constexpr size_t BG_F8END = BG_VT8D + al256((size_t)8 * 260 * 128 * 64);
constexpr size_t BG_YMOE  = 0;
constexpr size_t BG_END1  = al256((size_t)9 * TT * DM * 2);
constexpr size_t BG_SIZE  = BG_END0 > BG_END1 ? BG_END0 : BG_END1;
static_assert(BG_F8END <= BG_SIZE, "fp8 attention operands inside the big region");
constexpr size_t WS_END   = WS_BIG + BG_SIZE;

constexpr int CW_BAR = 4096;
constexpr int CW_CNT = 16384;
constexpr int CW_QUEUE = 20480;
constexpr int CW_KMAX = 24576;

constexpr int RING_BYTES = 151552;
constexpr int MISC_OFF = RING_BYTES;
constexpr int LDS_BYTES = 159744;

typedef __bf16 bf16x2_t __attribute__((ext_vector_type(2)));
__device__ __forceinline__ unsigned cvt_pk_bf16(float lo, float hi) { const f32x2 v = {lo, hi}; return __builtin_bit_cast(unsigned, __builtin_convertvector(v, bf16x2_t)); }
__device__ __forceinline__ bf16_t f2bf(float f) { unsigned u = __builtin_bit_cast(unsigned, f); return (bf16_t)((u + 0x7fffu + ((u >> 16) & 1u)) >> 16); }
__device__ __forceinline__ float bf2f(bf16_t b) { return __builtin_bit_cast(float, ((unsigned)b) << 16); }
__device__ __forceinline__ float bflo(unsigned w) { return __builtin_bit_cast(float, w << 16); }
__device__ __forceinline__ float bfhi(unsigned w) { return __builtin_bit_cast(float, w & 0xffff0000u); }
__device__ __forceinline__ float wave_sum(float v) {
#pragma unroll
    for (int o = 1; o < 64; o <<= 1) v += __shfl_xor(v, o);
    return v;
}
__device__ __forceinline__ float fast_exp(float x) { return __builtin_amdgcn_exp2f(x * 1.4426950408889634f); }
__device__ __forceinline__ float sigmoidf_(float x) { return 1.0f / (1.0f + __expf(-x)); }
__device__ __forceinline__ float siluf_(float x) { return x / (1.0f + __expf(-x)); }
__device__ __forceinline__ float gelu_tanh(float x) {
    const float u = 0.7978845608028654f * (x + 0.044715f * x * x * x);
    const float e = __expf(2.0f * u);
    const float t = 1.0f - 2.0f / (e + 1.0f);
    return 0.5f * x * (1.0f + t);
}
#define LDS_WAIT() asm volatile("s_waitcnt lgkmcnt(0)" ::: "memory")
#define VM_WAIT() asm volatile("s_waitcnt vmcnt(0)" ::: "memory")

#define XB_TMO      128
#define XB_XCNT(j)  (256  + 64 * (j))
#define XB_XSUB(j)  (1280 + 64 * (j))
#define XB_XGEN(j)  (2304 + 64 * (j))
#define XB_TOP      3328
#define XB_TOPGEN   3392
#define XCD_BAR_WORDS 3456
#define XB_SPIN_CAP (1u << 22)

__device__ __forceinline__ unsigned xb_ld(unsigned* p)              { return __hip_atomic_load(p, __ATOMIC_RELAXED, __HIP_MEMORY_SCOPE_AGENT); }
__device__ __forceinline__ unsigned xb_add(unsigned* p, unsigned v) { return __hip_atomic_fetch_add(p, v, __ATOMIC_RELAXED, __HIP_MEMORY_SCOPE_AGENT); }
__device__ __forceinline__ unsigned xb_xcc_id() { return (unsigned)__builtin_amdgcn_s_getreg((3 << 11) | 20) & 0xFu; }
#define XB_SPIN(cond, bar) do { unsigned _sp = 0; while (cond) { __builtin_amdgcn_s_sleep(1); \
    if ((++_sp & 255u) == 0u) { if (xb_ld(&(bar)[XB_TMO])) break; if (_sp > XB_SPIN_CAP) { atomicAdd(&(bar)[XB_TMO], 1u); break; } } } } while (0)

struct XcdBarrier { unsigned* bar; unsigned x; volatile LAS unsigned* st; };

__device__ __forceinline__ XcdBarrier xcd_barrier_post(unsigned* bar, volatile LAS unsigned* st) {
    XcdBarrier b; b.bar = bar; b.x = xb_xcc_id(); b.st = st;
    if (threadIdx.x == 0) { st[2] = xb_add(&bar[XB_XCNT(b.x)], 1u); st[3] = b.x; }
    return b;
}
__device__ __forceinline__ void xcd_barrier_complete(unsigned* bar, unsigned x, unsigned& nloc, unsigned& nx) {
    const unsigned G = gridDim.x * gridDim.y * gridDim.z;
    unsigned sum, cnt, mine, sp = 0u;
    for (;;) {
        sum = 0u; cnt = 0u; mine = 0u;
#pragma unroll
        for (unsigned j = 0; j < 16; ++j) { const unsigned c = xb_ld(&bar[XB_XCNT(j)]); sum += c; cnt += (c > 0u) ? 1u : 0u; mine = (j == x) ? c : mine; }
        if (sum == G) break;
        __builtin_amdgcn_s_sleep(1);
        if ((++sp & 255u) == 0u) { if (xb_ld(&bar[XB_TMO])) break; if (sp > XB_SPIN_CAP) { atomicAdd(&bar[XB_TMO], 1u); break; } }
    }
    nloc = mine > 0u ? mine : 1u; nx = cnt > 0u ? cnt : 1u;
}
__device__ __forceinline__ void xcd_barrier(const XcdBarrier& b, int wave_id) {
    const bool leader_thread = (wave_id == 0) && (__builtin_amdgcn_mbcnt_hi(~0u, __builtin_amdgcn_mbcnt_lo(~0u, 0u)) == 0u);
    asm volatile("s_waitcnt vmcnt(0)" ::: "memory");
    __syncthreads();
    if (leader_thread) {
        unsigned* bar = b.bar;
        __builtin_amdgcn_s_waitcnt(0);
        unsigned nloc = b.st[0], nx = b.st[1];
        if (nloc == 0u) { xcd_barrier_complete(bar, b.x, nloc, nx); b.st[0] = nloc; b.st[1] = nx; }
        const unsigned old = xb_add(&bar[XB_XSUB(b.x)], 1u);
        const unsigned gen = old / nloc;
        if (old + 1u == (gen + 1u) * nloc) {
            __builtin_amdgcn_fence(__ATOMIC_RELEASE, "agent");
            asm volatile("s_waitcnt vmcnt(0)" ::: "memory");
            const unsigned og = xb_add(&bar[XB_TOP], 1u);
            const unsigned tg = og / nx;
            if (og + 1u == (tg + 1u) * nx) xb_add(&bar[XB_TOPGEN], 1u);
            else XB_SPIN(xb_ld(&bar[XB_TOPGEN]) == tg, bar);
            __builtin_amdgcn_fence(__ATOMIC_ACQUIRE, "agent");
            xb_add(&bar[XB_XGEN(b.x)], 1u);
            asm volatile("s_waitcnt vmcnt(0)" ::: "memory");
        } else {
            XB_SPIN(xb_ld(&bar[XB_XGEN(b.x)]) == gen, bar);
            __builtin_amdgcn_fence(__ATOMIC_ACQUIRE, "agent");
            asm volatile("s_waitcnt vmcnt(0)" ::: "memory");
        }
    }
    __syncthreads();
}

__device__ __forceinline__ bf16x8 frag_rowk_l(const LAS bf16_t* p, int ld, int lane) {
    return *(const LAS bf16x8*)(p + (lane & 15) * ld + (lane >> 4) * 8);
}
__device__ __forceinline__ bf16x8 frag_rowk_g(const bf16_t* p, long ld, int lane) {
    return *(const bf16x8*)(p + (long)(lane & 15) * ld + (lane >> 4) * 8);
}
__device__ __forceinline__ bf16x8 frag_colk_l(unsigned p, int ldb, int lane) {
    const unsigned a0 = p + (unsigned)((8 * (lane >> 4) + ((lane & 15) >> 2)) * ldb + (lane & 3) * 8);
    const unsigned a1 = a0 + 4u * (unsigned)ldb;
    s16x4 lo, hi;
    asm volatile("ds_read_b64_tr_b16 %0, %2\n\tds_read_b64_tr_b16 %1, %3\n\ts_waitcnt lgkmcnt(0)" : "=&v"(lo), "=&v"(hi) : "v"(a0), "v"(a1) : "memory");
    return (bf16x8){lo[0], lo[1], lo[2], lo[3], hi[0], hi[1], hi[2], hi[3]};
}
#define MFMA16(a, b, c) __builtin_amdgcn_mfma_f32_16x16x32_bf16((a), (b), (c), 0, 0, 0)
namespace pg8 {
constexpr int BM = 256, BK = 64, HALF = 128, HTB = HALF * BK * 2, STAGE_BYTES = 8 * HTB, NXCD = 8, WGM = 8;
__device__ __forceinline__ int lds_byte(int r, int c) { const int st = (r >> 4) * 2 + (c >> 5), rr = r & 15, cc = c & 31, ob = rr * 64 + cc * 2; return st * 1024 + (ob ^ (((ob >> 9) & 1) << 5)); }
__device__ __forceinline__ void stage_rc(int b, int& R, int& C) { const int st = b / 1024, sb = b % 1024, swz = sb ^ (((sb >> 9) & 1) << 5); R = (st >> 1) * 16 + swz / 64; C = (st & 1) * 32 + (swz % 64) / 2; }
__device__ __forceinline__ int perm32(int rho) { const int n = rho >> 4, i = rho & 15; return 8 * (i >> 2) + 4 * n + (i & 3); }

struct Unit { int pm, pn, e; };
constexpr float WSCALE = 32.0f, WSCALE_INV = 1.0f / 32.0f;

struct DenseOrder {
    const bf16_t* A; const bf16_t* Bt; int ldab, kb, nM, nN, nwg, G, c;
    __device__ __forceinline__ void init(const bf16_t* A_, int lda_, const bf16_t* Bt_, int M, int N, int K_, int G_, int c_) { A = A_; ldab = lda_ * 2; Bt = Bt_; kb = K_ * 2; nM = M / BM; nN = N / BM; nwg = nM * nN; G = G_; c = c_; }
    __device__ __forceinline__ void init8(const void* A_, int ldab_, const void* Bt_, int M, int N, int K_, int G_, int c_) { A = (const bf16_t*)A_; ldab = ldab_; Bt = (const bf16_t*)Bt_; kb = K_; nM = M / BM; nN = N / BM; nwg = nM * nN; G = G_; c = c_; }
    __device__ __forceinline__ void prep(LAS unsigned char*) const {}
    __device__ __forceinline__ int units_of_me() const { return c < nwg ? (nwg - c + G - 1) / G : 0; }
    __device__ __forceinline__ int max_units() const { return (nwg + G - 1) / G; }
    __device__ __forceinline__ bool next(int i, Unit& u) const {
        const long L = (long)i * G + c; if (L >= nwg) return false;
        int wgid = (int)L; { const int q = nwg / NXCD, r = nwg % NXCD, xcd = wgid % NXCD, off = wgid / NXCD; wgid = (xcd < r ? xcd * (q + 1) : r * (q + 1) + (xcd - r) * q) + off; }
        const int nig = WGM * nN, gid = wgid / nig, fm = gid * WGM, gsz = (nM - fm) < WGM ? (nM - fm) : WGM;
        u.pm = fm + ((wgid % nig) % gsz); u.pn = (wgid % nig) / gsz; u.e = 0; return true;
    }
    __device__ __forceinline__ const char* a_base() const { return (const char*)A; }
    __device__ __forceinline__ unsigned a_off(const Unit& u, int r) const { return (unsigned)(u.pm * BM + r) * (unsigned)ldab; }
    __device__ __forceinline__ void a_off4(const Unit& u, int r0, int r1, int half, u32x4& o) const { o.x = a_off(u, r0); o.y = a_off(u, r1); o.z = a_off(u, half + r0); o.w = a_off(u, half + r1); }
    __device__ __forceinline__ const char* b_ptr(const Unit& u) const { return (const char*)Bt + (size_t)u.pn * BM * kb; }
};

template <int MODE  >
struct MoeOrder {
    const void* A; const void* Bt; const int* list; const int* cnt; int ldab, kb, nN, G, c; size_t bstride;
    LAS int* tp; LAS int* cn; LAS int* rb;
    __device__ __forceinline__ void prep(LAS unsigned char* misc, int tid) {
        tp = (LAS int*)(misc + 64); cn = tp + 72; rb = cn + 72;
        if (tid < NEX1) cn[tid] = cnt[tid];
        __syncthreads();
        if (tid == 0) { int s = 0, q = 0; for (int e = 0; e < NEX1; ++e) { tp[e] = s; rb[e] = q; s += (cn[e] + BM - 1) / BM; q += cn[e]; } tp[NEX1] = s; rb[NEX1] = q; }
        __syncthreads();
    }
    __device__ __forceinline__ bool next(int i, Unit& u) const {
        const int total = tp[NEX1]; const long nu = (long)total * nN; const int per = (int)((nu + G - 1) / G);
        (void)per;
        long L = (long)i * G + c;
        if ((G & 7) == 0) L = ((long)i * 8 + (c & 7)) * (G >> 3) + (c >> 3);
        if (L >= nu) return false;
        const int tile = (int)(L / nN); u.pn = (int)(L % nN);
        const int ln_ = (int)__builtin_amdgcn_mbcnt_hi(~0u, __builtin_amdgcn_mbcnt_lo(~0u, 0u));
        const int e = __builtin_popcountll(__ballot(tp[ln_ + 1] <= tile));
        u.e = e; u.pm = tile - tp[e]; return true;
    }
    __device__ __forceinline__ const char* a_base() const { return (const char*)A; }
    __device__ __forceinline__ unsigned a_off(const Unit& u, int r) const {
        int pos = u.pm * BM + r; const int n = cn[u.e]; pos = pos < n ? pos : n - 1;
        if (MODE == 1) return (unsigned)(rb[u.e] + pos) * (unsigned)ldab;
        const int a = list[u.e * TT + pos];
        const int row = a < 8 * TT ? (a >> 3) : a - 8 * TT;
        return (unsigned)row * (unsigned)ldab;
    }
    __device__ __forceinline__ void a_off4(const Unit& u, int r0, int r1, int half, u32x4& o) const {
        if (MODE == 1) { o.x = a_off(u, r0); o.y = a_off(u, r1); o.z = a_off(u, half + r0); o.w = a_off(u, half + r1); return; }
        const int n = cn[u.e], pb = u.pm * BM; const int* lp = list + u.e * TT;
        const int a0 = lp[min(pb + r0, n - 1)], a1 = lp[min(pb + r1, n - 1)], a2 = lp[min(pb + half + r0, n - 1)], a3 = lp[min(pb + half + r1, n - 1)];
        o.x = (unsigned)(a0 < 8 * TT ? (a0 >> 3) : a0 - 8 * TT) * (unsigned)ldab; o.y = (unsigned)(a1 < 8 * TT ? (a1 >> 3) : a1 - 8 * TT) * (unsigned)ldab;
        o.z = (unsigned)(a2 < 8 * TT ? (a2 >> 3) : a2 - 8 * TT) * (unsigned)ldab; o.w = (unsigned)(a3 < 8 * TT ? (a3 >> 3) : a3 - 8 * TT) * (unsigned)ldab;
    }
    __device__ __forceinline__ const char* b_ptr(const Unit& u) const { return (const char*)Bt + (size_t)u.e * bstride + (size_t)u.pn * BM * kb; }
};

typedef int v8i32 __attribute__((ext_vector_type(8)));
typedef int v4i32_ __attribute__((ext_vector_type(4)));
__device__ __forceinline__ v8i32 cat8(bf16x8 a, bf16x8 b) { const u32x4 x = __builtin_bit_cast(u32x4, a), y = __builtin_bit_cast(u32x4, b); return (v8i32){(int)x.x, (int)x.y, (int)x.z, (int)x.w, (int)y.x, (int)y.y, (int)y.z, (int)y.w}; }
template <bool FP8, class Epi, class Sched>
__device__ __forceinline__ void gemm_phase(LAS unsigned char* lds, const Sched& S, const Epi& E, int wave_id) {
    const int wid = wave_id; int lane = (int)__builtin_amdgcn_mbcnt_hi(~0u, __builtin_amdgcn_mbcnt_lo(~0u, 0u)); asm volatile("" : "+v"(lane));
    const int tid = wid * 64 + lane, wr = wid >> 2, wc = wid & 3, fr = lane & 15, fq = lane >> 4;
    const int kb = S.kb; int nt = kb / 128; asm volatile("" : "+s"(nt));
    unsigned voffB[2];
#pragma unroll
    for (int i = 0; i < 2; ++i) { int R, C; stage_rc(tid * 16 + i * 8192, R, C); const int Rb = (R & ~31) + perm32(R & 31);
        voffB[i] = (unsigned)(Rb * kb) + (unsigned)C * 2u; }
#define PG8_AOFF(u, h, i) ({ int _tz = tid; asm volatile("" : "+v"(_tz)); int _R, _C; stage_rc(_tz * 16 + (i) * 8192, _R, _C); S.a_off((u), (h) * HALF + _R) + (unsigned)_C * 2u; })
    const size_t kstep = (size_t)(BK * 2);
    const size_t hstepB = (size_t)HALF * kb;
    const unsigned ldsw = (unsigned)wid * 1024u;
    const int aoff = lds_byte(wr * 64 + fr, fq * 8), boff = lds_byte(wc * 32 + fr, fq * 8);
#define PG8_SA(b, h) (((b) * 2 + (h)) * HTB)
#define PG8_SB(b, h) ((4 + (b) * 2 + (h)) * HTB)
#define PG8_STAGE(bufoff, gbase, v0, v1) do { \
        __builtin_amdgcn_global_load_lds((const unsigned*)((const char*)(gbase) + (v0)), (LAS unsigned*)(lds + (bufoff) + ldsw), 16, 0, 0); \
        __builtin_amdgcn_global_load_lds((const unsigned*)((const char*)(gbase) + (v1)), (LAS unsigned*)(lds + (bufoff) + ldsw + 8192), 16, 0, 0); } while (0)
#define PG8_VOFFB(i) ({ int _tz = tid; asm volatile("" : "+v"(_tz)); int _R, _C; stage_rc(_tz * 16 + (i) * 8192, _R, _C); (unsigned)(((_R & ~31) + perm32(_R & 31)) * kb) + (unsigned)_C * 2u; })
#define PG8_STAGE_B(bufoff, gbase) do { if constexpr (FP8) { int _tz = tid; asm volatile("" : "+v"(_tz)); const u32x2 _vv = *(const LAS u32x2*)(lds + STAGE_BYTES + 8192 + _tz * 8); PG8_STAGE(bufoff, gbase, _vv.x, _vv.y); } else PG8_STAGE(bufoff, gbase, voffB[0], voffB[1]); } while (0)
#define PG8_LD8(off) __builtin_shufflevector(*(const LAS v4i32_*)(lds + (off)), *(const LAS v4i32_*)(lds + (off) + 1024), 0, 1, 2, 3, 4, 5, 6, 7)
#define PG8_LDA(dst, b, h) do { _Pragma("unroll") for (int m = 0; m < 4; ++m) { if constexpr (FP8) dst##8[m] = PG8_LD8(PG8_SA(b, h) + aoff + m * 2048); else { _Pragma("unroll") for (int k = 0; k < 2; ++k) dst[m][k] = *(const LAS bf16x8*)(lds + PG8_SA(b, h) + aoff + m * 2048 + k * 1024); } } } while (0)
#define PG8_LDB(dst, b, h) do { _Pragma("unroll") for (int n = 0; n < 2; ++n) { if constexpr (FP8) dst##8[n] = PG8_LD8(PG8_SB(b, h) + boff + n * 2048); else { _Pragma("unroll") for (int k = 0; k < 2; ++k) dst[n][k] = *(const LAS bf16x8*)(lds + PG8_SB(b, h) + boff + n * 2048 + k * 1024); } } } while (0)
#define PG8_MMA(ai, bj, At, Bt) do { __builtin_amdgcn_s_setprio(1); _Pragma("unroll") for (int m = 0; m < 4; ++m) _Pragma("unroll") for (int n = 0; n < 2; ++n) { \
        if constexpr (FP8) asm volatile("v_mfma_f32_16x16x128_f8f6f4 %0, %1, %2, %0" : "+v"(acc[ai][bj][m][n]) : "v"(Bt##8[n]), "v"(At##8[m])); \
        else { _Pragma("unroll") for (int k = 0; k < 2; ++k) acc[ai][bj][m][n] = __builtin_amdgcn_mfma_f32_16x16x32_bf16(Bt[n][k], At[m][k], acc[ai][bj][m][n], 0, 0, 0); } } \
        __builtin_amdgcn_s_setprio(0); } while (0)
#define PG8_WAIT_V(n) asm volatile("s_waitcnt vmcnt(" #n ")" ::: "memory")
#define PG8_WAIT_L(n) asm volatile("s_waitcnt lgkmcnt(" #n ")" ::: "memory")
#define PG8_BAR __builtin_amdgcn_s_barrier()
#define PG8_SCHED __builtin_amdgcn_sched_barrier(0)
    if constexpr (FP8) { u32x2 _vb; _vb.x = PG8_VOFFB(0); _vb.y = PG8_VOFFB(1); *(LAS u32x2*)(lds + STAGE_BYTES + 8192 + tid * 8) = _vb; }
    Unit cur, nxt; int ui = 0;
    if (!S.next(0, cur)) return;
    f32x4 acc[2][2][4][2];
#pragma unroll
    for (int a = 0; a < 2; ++a)
#pragma unroll
        for (int b = 0; b < 2; ++b)
#pragma unroll
            for (int m = 0; m < 4; ++m)
#pragma unroll
                for (int n = 0; n < 2; ++n) acc[a][b][m][n] = (f32x4){0.f, 0.f, 0.f, 0.f};
    bf16x8 At[4][2], B0[2][2], B1[2][2]; v8i32 At8[4], B08[2], B18[2];
    const char* const gA = S.a_base();
    const char* cB = S.b_ptr(cur);
    unsigned oc00, oc01, oc10, oc11;
    oc00 = PG8_AOFF(cur, 0, 0); oc01 = PG8_AOFF(cur, 0, 1); oc10 = PG8_AOFF(cur, 1, 0); oc11 = PG8_AOFF(cur, 1, 1);
    PG8_STAGE_B(PG8_SB(0, 0), cB); PG8_STAGE_B(PG8_SB(0, 1), cB + hstepB); PG8_STAGE(PG8_SA(0, 0), gA, oc00, oc01); PG8_STAGE(PG8_SA(0, 1), gA, oc10, oc11);
    if (wr == 1) PG8_BAR;
    PG8_WAIT_V(2); PG8_BAR;
    PG8_STAGE_B(PG8_SB(1, 0), cB + kstep); PG8_STAGE(PG8_SA(1, 0), gA + kstep, oc00, oc01); PG8_STAGE_B(PG8_SB(1, 1), cB + hstepB + kstep);
    PG8_WAIT_V(6); PG8_BAR;
    for (;;) {
        const bool has_next = S.next(ui + 1, nxt);
        const char* nB = cB;
        {
            u32x4 on = {oc00, oc01, oc10, oc11};
            if (has_next) {
                int _tz = tid; asm volatile("" : "+v"(_tz)); int _R0, _C0, _R1, _C1; stage_rc(_tz * 16, _R0, _C0); stage_rc(_tz * 16 + 8192, _R1, _C1);
                S.a_off4(nxt, _R0, _R1, HALF, on); on.x += (unsigned)_C0 * 2u; on.y += (unsigned)_C1 * 2u; on.z += (unsigned)_C0 * 2u; on.w += (unsigned)_C1 * 2u; nB = S.b_ptr(nxt); }
            *(LAS u32x4*)(lds + STAGE_BYTES + tid * 16) = on;
        }
        for (int t = 0; t < nt; t += 2) {
            const bool last = (t == nt - 2);
            const char* a1 = gA + (size_t)(t + 1) * kstep;
            const char* a2 = last ? gA : gA + (size_t)(t + 2) * kstep; const char* b2 = last ? nB : cB + (size_t)(t + 2) * kstep;
            const char* a3 = a2 + kstep; const char* b3 = b2 + kstep;
            unsigned s00 = oc00, s01 = oc01, s10 = oc10, s11 = oc11;
            if (last) { const u32x4 on = *(const LAS u32x4*)(lds + STAGE_BYTES + tid * 16); s00 = on.x; s01 = on.y; s10 = on.z; s11 = on.w; }
            PG8_LDB(B0, 0, 0); PG8_LDB(B1, 0, 1); PG8_SCHED; PG8_LDA(At, 0, 0); PG8_STAGE(PG8_SA(1, 1), a1, oc10, oc11);
            PG8_WAIT_V(8); PG8_WAIT_L(0); PG8_BAR; PG8_MMA(0, 0, At, B0); PG8_MMA(0, 1, At, B1); PG8_BAR; PG8_SCHED;
            PG8_LDA(At, 0, 1); PG8_STAGE_B(PG8_SB(0, 0), b2); PG8_STAGE_B(PG8_SB(0, 1), b2 + hstepB); PG8_STAGE(PG8_SA(0, 0), a2, s00, s01);
            PG8_WAIT_V(8); PG8_WAIT_L(0); PG8_BAR; PG8_MMA(1, 0, At, B0); PG8_MMA(1, 1, At, B1); PG8_BAR; PG8_SCHED;
            PG8_LDB(B0, 1, 0); PG8_LDB(B1, 1, 1); PG8_SCHED; PG8_LDA(At, 1, 0); PG8_STAGE(PG8_SA(0, 1), a2, s10, s11);
            PG8_WAIT_V(8); PG8_WAIT_L(0); PG8_BAR; PG8_MMA(0, 0, At, B0); PG8_MMA(0, 1, At, B1); PG8_BAR; PG8_SCHED;
            PG8_LDA(At, 1, 1); PG8_STAGE_B(PG8_SB(1, 0), b3); PG8_STAGE_B(PG8_SB(1, 1), b3 + hstepB); PG8_STAGE(PG8_SA(1, 0), a3, s00, s01);
            PG8_WAIT_V(8); PG8_WAIT_L(0); PG8_BAR; PG8_MMA(1, 0, At, B0); PG8_MMA(1, 1, At, B1); PG8_BAR; PG8_SCHED;
        }
        if (wr == 0) PG8_BAR;
        E(acc, cur, wr, wc, fr, fq);
        if (!has_next) break;
#pragma unroll
        for (int a = 0; a < 2; ++a)
#pragma unroll
            for (int b = 0; b < 2; ++b)
#pragma unroll
                for (int m = 0; m < 4; ++m)
#pragma unroll
                    for (int n = 0; n < 2; ++n) acc[a][b][m][n] = (f32x4){0.f, 0.f, 0.f, 0.f};
        { const u32x4 on = *(const LAS u32x4*)(lds + STAGE_BYTES + tid * 16); oc00 = on.x; oc01 = on.y; oc10 = on.z; oc11 = on.w; }
        cur = nxt; cB = nB; ++ui;
        if (wr == 1) PG8_BAR;
    }
    PG8_WAIT_V(0);
    PG8_BAR;
#undef PG8_SA
#undef PG8_SB
#undef PG8_STAGE
#undef PG8_STAGE_B
#undef PG8_AOFF
#undef PG8_VOFFB
#undef PG8_LD8
#undef PG8_LDA
#undef PG8_LDB
#undef PG8_MMA
#undef PG8_WAIT_V
#undef PG8_WAIT_L
#undef PG8_BAR
#undef PG8_SCHED
}

struct EpiStore {
    bf16_t* O; int ldc; float scale;
    __device__ __forceinline__ void operator()(const f32x4 (&acc)[2][2][4][2], const Unit& u, int wr, int wc, int fr, int fq) const {
        const int row0 = u.pm * BM + wr * 64 + fr, col0 = u.pn * BM + wc * 32 + 8 * fq;
#pragma unroll
        for (int ai = 0; ai < 2; ++ai)
#pragma unroll
            for (int m = 0; m < 4; ++m) { bf16_t* rowp = O + (size_t)(row0 + ai * HALF + m * 16) * ldc + col0;
#pragma unroll
                for (int bj = 0; bj < 2; ++bj) { const f32x4 v0 = acc[ai][bj][m][0] * scale, v1 = acc[ai][bj][m][1] * scale;
                    u32x4 w; w.x = cvt_pk_bf16(v0[0], v0[1]); w.y = cvt_pk_bf16(v0[2], v0[3]); w.z = cvt_pk_bf16(v1[0], v1[1]); w.w = cvt_pk_bf16(v1[2], v1[3]);
                    *(u32x4*)(rowp + bj * HALF) = w; } }
    }
};
struct EpiGlu {
    const bf16_t* Z; const float* b; bf16_t* MIX;
    __device__ __forceinline__ void operator()(const f32x4 (&acc)[2][2][4][2], const Unit& u, int wr, int wc, int fr, int fq) const {
        const int row0 = u.pm * BM + wr * 64 + fr, col0 = u.pn * BM + wc * 32 + 8 * fq;
#pragma unroll
        for (int bj = 0; bj < 2; ++bj) {
            const f32x4 b0 = *(const f32x4*)(b + col0 + bj * HALF), b1 = *(const f32x4*)(b + col0 + bj * HALF + 4);
#pragma unroll
            for (int ai = 0; ai < 2; ++ai)
#pragma unroll
                for (int m = 0; m < 4; ++m) { const size_t row = (size_t)(row0 + ai * HALF + m * 16);
                    const u32x4 zz = *(const u32x4*)(Z + row * 1024 + col0 + bj * HALF);
                    const f32x4 v0 = acc[ai][bj][m][0] + b0, v1 = acc[ai][bj][m][1] + b1;
                    u32x4 w;
                    w.x = cvt_pk_bf16(bflo(zz.x) * sigmoidf_(v0[0]), bfhi(zz.x) * sigmoidf_(v0[1]));
                    w.y = cvt_pk_bf16(bflo(zz.y) * sigmoidf_(v0[2]), bfhi(zz.y) * sigmoidf_(v0[3]));
                    w.z = cvt_pk_bf16(bflo(zz.z) * sigmoidf_(v1[0]), bfhi(zz.z) * sigmoidf_(v1[1]));
                    w.w = cvt_pk_bf16(bflo(zz.w) * sigmoidf_(v1[2]), bfhi(zz.w) * sigmoidf_(v1[3]));
                    *(u32x4*)(MIX + row * DM + 1024 + col0 + bj * HALF) = w; }
        }
    }
};
struct EpiE1 {
    unsigned char* H; const LAS int* cn; const LAS int* rb;
    __device__ __forceinline__ void operator()(const f32x4 (&acc)[2][2][4][2], const Unit& u, int wr, int wc, int fr, int fq) const {
        const int n = cn[u.e]; const int colh = u.pn * 128 + wc * 32 + 8 * fq;
#pragma unroll
        for (int ai = 0; ai < 2; ++ai)
#pragma unroll
            for (int m = 0; m < 4; ++m) { const int pos = u.pm * BM + ai * HALF + wr * 64 + m * 16 + fr;
                if (pos < n) { const int a = rb[u.e] + pos;
                    float sc = WSCALE_INV; asm volatile("" : "+v"(sc));
                    const f32x4 g0 = acc[ai][0][m][0] * sc, g1 = acc[ai][0][m][1] * sc, u0 = acc[ai][1][m][0] * sc, u1 = acc[ai][1][m][1] * sc;
                    u32x2 w;
                    w.x = (unsigned)__builtin_amdgcn_cvt_pk_fp8_f32(siluf_(g0[0]) * u0[0], siluf_(g0[1]) * u0[1], 0, false);
                    w.x = (unsigned)__builtin_amdgcn_cvt_pk_fp8_f32(siluf_(g0[2]) * u0[2], siluf_(g0[3]) * u0[3], (int)w.x, true);
                    w.y = (unsigned)__builtin_amdgcn_cvt_pk_fp8_f32(siluf_(g1[0]) * u1[0], siluf_(g1[1]) * u1[1], 0, false);
                    w.y = (unsigned)__builtin_amdgcn_cvt_pk_fp8_f32(siluf_(g1[2]) * u1[2], siluf_(g1[3]) * u1[3], (int)w.y, true);
                    *(u32x2*)(H + (size_t)a * EHID + colh) = w; }
                __builtin_amdgcn_sched_barrier(0); }
    }
};
struct EpiE2 {
    unsigned char* Y; const float* wgt; const LAS int* cn; const LAS int* rb;
    __device__ __forceinline__ void operator()(const f32x4 (&acc)[2][2][4][2], const Unit& u, int wr, int wc, int fr, int fq) const {
        const int n = cn[u.e]; const int col0 = u.pn * BM + wc * 32 + 8 * fq;
#pragma unroll
        for (int ai = 0; ai < 2; ++ai)
#pragma unroll
            for (int m = 0; m < 4; ++m) { const int pos = u.pm * BM + ai * HALF + wr * 64 + m * 16 + fr;
                if (pos < n) { const int a = rb[u.e] + pos; float ws = WSCALE_INV * 0.25f; asm volatile("" : "+v"(ws));
                    unsigned char* rowp = Y + (size_t)a * DM + col0;
#pragma unroll
                    for (int bj = 0; bj < 2; ++bj) { const f32x4 v0 = acc[ai][bj][m][0] * ws, v1 = acc[ai][bj][m][1] * ws;
                        u32x2 w;
                        w.x = (unsigned)__builtin_amdgcn_cvt_pk_fp8_f32(v0[0], v0[1], 0, false); w.x = (unsigned)__builtin_amdgcn_cvt_pk_fp8_f32(v0[2], v0[3], (int)w.x, true);
                        w.y = (unsigned)__builtin_amdgcn_cvt_pk_fp8_f32(v1[0], v1[1], 0, false); w.y = (unsigned)__builtin_amdgcn_cvt_pk_fp8_f32(v1[2], v1[3], (int)w.y, true);
                        *(u32x2*)(rowp + bj * HALF) = w; } }
                __builtin_amdgcn_sched_barrier(0); }
    }
};
}
struct KArgs {
    const float* in[34];
    float* out;
    unsigned char* ws;
    int ph_lo, ph_hi;
};
struct Params {
    float* out;
    unsigned char* ws;
    LAS unsigned long long* ptab;
    int ph_lo, ph_hi;
    __device__ __forceinline__ const float* inp(int k) const {
        const unsigned long long v = ptab[k];
        const unsigned lo = __builtin_amdgcn_readfirstlane((unsigned)v), hi = __builtin_amdgcn_readfirstlane((unsigned)(v >> 32));
        return (const float*)(((unsigned long long)hi << 32) | lo);
    }
};
struct Ctx {
    LAS unsigned char* lds;
    int tid, lane, wave, G, bid;
    int gw, ngw;
};

__device__ __forceinline__ void tr_item(const float* W, int N, bf16_t* WT, int ldt, int k0, int n0, int orow0, LAS float* scr, int lane) {
#pragma unroll 8
    for (int i = 0; i < 32; ++i) { const int kk = 2 * i + (lane >> 5); scr[kk * 33 + (lane & 31)] = W[(size_t)(k0 + kk) * N + n0 + (lane & 31)]; }
    LDS_WAIT(); asm volatile("" ::: "memory");
    const int c = lane & 7;
#pragma unroll
    for (int j = 0; j < 4; ++j) { const int n = (lane >> 3) + 8 * j; const LAS float* s = scr + (8 * c) * 33 + n;
        u32x4 o; o.x = cvt_pk_bf16(s[0 * 33], s[1 * 33]); o.y = cvt_pk_bf16(s[2 * 33], s[3 * 33]); o.z = cvt_pk_bf16(s[4 * 33], s[5 * 33]); o.w = cvt_pk_bf16(s[6 * 33], s[7 * 33]);
        *(u32x4*)(WT + (size_t)(orow0 + n) * ldt + k0 + 8 * c) = o; }
    LDS_WAIT(); asm volatile("" ::: "memory");
}
__device__ __forceinline__ void tr_item64(const float* W, int N, bf16_t* WT, int ldt, int k0, int n0, int orow0, LAS float* scr, int lane) {
    f32x4 v[16];
    const float* src = W + (size_t)(k0 + (lane >> 4)) * N + n0 + 4 * (lane & 15);
#pragma unroll
    for (int i = 0; i < 16; ++i) v[i] = __builtin_nontemporal_load((const f32x4*)(src + (size_t)(4 * i) * N));
#pragma unroll
    for (int i = 0; i < 16; ++i) { LAS float* d = scr + (4 * i + (lane >> 4)) * 65 + 4 * (lane & 15); d[0] = v[i][0]; d[1] = v[i][1]; d[2] = v[i][2]; d[3] = v[i][3]; }
    LDS_WAIT(); asm volatile("" ::: "memory");
    const int c = lane & 7;
#pragma unroll
    for (int j = 0; j < 8; ++j) { const int n = (lane >> 3) + 8 * j; const LAS float* s = scr + (8 * c) * 65 + n;
        u32x4 o; o.x = cvt_pk_bf16(s[0 * 65], s[1 * 65]); o.y = cvt_pk_bf16(s[2 * 65], s[3 * 65]); o.z = cvt_pk_bf16(s[4 * 65], s[5 * 65]); o.w = cvt_pk_bf16(s[6 * 65], s[7 * 65]);
        *(u32x4*)(WT + (size_t)(orow0 + n) * ldt + k0 + 8 * c) = o; }
    LDS_WAIT(); asm volatile("" ::: "memory");
}
__device__ __forceinline__ void tr_item64_fp8(const float* W, int N, unsigned char* WT, int ldt, int k0, int n0, int orow0, LAS float* scr, int lane, float wscale = pg8::WSCALE) {
    f32x4 v[16];
    const float* src = W + (size_t)(k0 + (lane >> 4)) * N + n0 + 4 * (lane & 15);
#pragma unroll
    for (int i = 0; i < 16; ++i) v[i] = __builtin_nontemporal_load((const f32x4*)(src + (size_t)(4 * i) * N));
#pragma unroll
    for (int i = 0; i < 16; ++i) { LAS float* d = scr + (4 * i + (lane >> 4)) * 65 + 4 * (lane & 15); d[0] = v[i][0]; d[1] = v[i][1]; d[2] = v[i][2]; d[3] = v[i][3]; }
    LDS_WAIT(); asm volatile("" ::: "memory");
    const int c = lane & 3;
#pragma unroll
    for (int j = 0; j < 4; ++j) { const int n = (lane >> 2) + 16 * j; const LAS float* s = scr + (16 * c) * 65 + n;
        u32x4 o;
        o.x = (unsigned)__builtin_amdgcn_cvt_pk_fp8_f32(s[0 * 65] * wscale, s[1 * 65] * wscale, 0, false);   o.x = (unsigned)__builtin_amdgcn_cvt_pk_fp8_f32(s[2 * 65] * wscale, s[3 * 65] * wscale, (int)o.x, true);
        o.y = (unsigned)__builtin_amdgcn_cvt_pk_fp8_f32(s[4 * 65] * wscale, s[5 * 65] * wscale, 0, false);   o.y = (unsigned)__builtin_amdgcn_cvt_pk_fp8_f32(s[6 * 65] * wscale, s[7 * 65] * wscale, (int)o.y, true);
        o.z = (unsigned)__builtin_amdgcn_cvt_pk_fp8_f32(s[8 * 65] * wscale, s[9 * 65] * wscale, 0, false);   o.z = (unsigned)__builtin_amdgcn_cvt_pk_fp8_f32(s[10 * 65] * wscale, s[11 * 65] * wscale, (int)o.z, true);
        o.w = (unsigned)__builtin_amdgcn_cvt_pk_fp8_f32(s[12 * 65] * wscale, s[13 * 65] * wscale, 0, false); o.w = (unsigned)__builtin_amdgcn_cvt_pk_fp8_f32(s[14 * 65] * wscale, s[15 * 65] * wscale, (int)o.w, true);
        *(u32x4*)(WT + (size_t)(orow0 + n) * ldt + k0 + 16 * c) = o; }
    LDS_WAIT(); asm volatile("" ::: "memory");
}
__device__ __forceinline__ void tr_dense(const float* W, int K, int N, bf16_t* WT, int item, LAS float* scr, int lane) {
    const int nblk = N / 32, kb = item / nblk, nb = item % nblk;
    tr_item(W, N, WT, K, 64 * kb, 32 * nb, 32 * nb, scr, lane);
}

__device__ __forceinline__ void s5_tables(const Params& p, Ctx& C, int dir, int g) {
    LAS f32x2* PW = (LAS f32x2*)C.lds;
    LAS f32x2* BB = PW + 65 * 64;
    LAS f32x2* CX = BB + 64 * 16;
    const float* a_re = p.inp(11); const float* a_im = p.inp(12); const float* log_dt = p.inp(13);
    const float* b_re = p.inp(14); const float* b_im = p.inp(15); const float* c_re = p.inp(16); const float* c_im = p.inp(17);
    const int tid = C.tid;
    if (tid < 64) {
        const int pp = tid;
        const float dt = __expf(log_dt[dir * 64 + g]);
        const float are = a_re[(dir * 64 + g) * 64 + pp], aim = a_im[(dir * 64 + g) * 64 + pp];
        const float zr = are * dt, zi = aim * dt;
        const float mag = __expf(zr);
        double rev = (double)zi * 0.15915494309189535; rev -= floor(rev);
        const float cs = __builtin_amdgcn_cosf((float)rev), sn = __builtin_amdgcn_sinf((float)rev);
        const float abr = mag * cs, abi = mag * sn;
        const float den = are * are + aim * aim, nr = abr - 1.0f, ni = abi;
        const float fre = (nr * are + ni * aim) / den, fim = (ni * are - nr * aim) / den;
        float pr = 1.0f, pi = 0.0f;
#pragma unroll 1
        for (int n = 0; n <= 64; ++n) { PW[n * 64 + pp] = (f32x2){pr, pi}; const float t = pr * abr - pi * abi; pi = pr * abi + pi * abr; pr = t; }
        for (int j = 0; j < 16; ++j) { const float br = b_re[(g * 64 + pp) * 16 + j], bi = b_im[(g * 64 + pp) * 16 + j];
            BB[pp * 16 + j] = (f32x2){fre * br - fim * bi, fre * bi + fim * br}; }
    }
    for (int q = tid; q < 1024; q += NTHR) { const int i = q >> 6, pp = q & 63; CX[i * 64 + pp] = (f32x2){c_re[(g * 16 + i) * 64 + pp], c_im[(g * 16 + i) * 64 + pp]}; }
    __syncthreads();
    bf16_t* KN = (bf16_t*)(p.ws + WS_KN) + (size_t)(dir * 64 + g) * 16 * 1024;
    float* APOW = (float*)(p.ws + WS_APOW) + (size_t)(dir * 64 + g) * 64 * 128;
    float* AL = (float*)(p.ws + WS_AL) + (size_t)(dir * 64 + g) * 128;
#pragma unroll 1
    for (int q = 0; q < 32; ++q) { const int idx = tid + NTHR * q; const int n = idx >> 8, i = (idx >> 4) & 15, j = idx & 15;
        float s = 0.f;
#pragma unroll 4
        for (int pp = 0; pp < 64; ++pp) { const f32x2 c = CX[i * 64 + pp], w = PW[n * 64 + pp], b = BB[pp * 16 + j];
            const float gr = c.x * b.x - c.y * b.y, gi = c.x * b.y + c.y * b.x;
            s += gr * w.x - gi * w.y; }
        KN[(size_t)i * 1024 + n * 16 + j] = f2bf(s); }
    for (int q = tid; q < 4096; q += NTHR) { const int t = q >> 6, pp = q & 63; const f32x2 w = PW[(t + 1) * 64 + pp]; *(f32x2*)(APOW + (size_t)t * 128 + 2 * pp) = w; }
    if (tid < 64) { const f32x2 w = PW[64 * 64 + tid]; *(f32x2*)(AL + 2 * tid) = w; }
    { bf16_t* BBT = (bf16_t*)(p.ws + WS_BBT) + (size_t)(dir * 64 + g) * 128 * 16;
      for (int q = tid; q < 2048; q += NTHR) { const int pq = q >> 4, j = q & 15; const f32x2 b = BB[(pq & 63) * 16 + j]; BBT[q] = f2bf(pq < 64 ? b.x : b.y); } }
    if (dir == 0) { bf16_t* CCt = (bf16_t*)(p.ws + WS_CC) + (size_t)g * 16 * 128;
        for (int q = tid; q < 2048; q += NTHR) { const int i = q >> 7, pq = q & 127; const f32x2 c = CX[i * 64 + (pq & 63)]; CCt[i * 128 + pq] = f2bf(pq < 64 ? c.x : -c.y); } }
    __syncthreads();
}

__device__ __forceinline__ void phase_p0(const Params& p, Ctx& C) {
    for (int task = C.bid; task < 128; task += C.G) s5_tables(p, C, task >> 6, task & 63);
    {
        const int gt = C.bid * NTHR + C.tid, ngt = C.G * NTHR;
        float* R128 = (float*)(p.ws + WS_ROPE128); float* R64 = (float*)(p.ws + WS_ROPE64);
        for (int q = gt; q < 256 * 64 + 256 * 32; q += ngt) {
            int pos, i, half; float* dst;
            if (q < 256 * 64) { pos = q >> 6; i = q & 63; half = 64; dst = R128 + (size_t)q * 2; }
            else { const int r = q - 256 * 64; pos = r >> 5; i = r & 31; half = 32; dst = R64 + (size_t)r * 2; }
            const float freq = exp2f(-(float)i / (float)half * 13.287712379549449f);
            const float ang = (float)pos * freq;
            double rev = (double)ang * 0.15915494309189535; rev -= floor(rev);
            dst[0] = __builtin_amdgcn_cosf((float)rev); dst[1] = __builtin_amdgcn_sinf((float)rev);
        }
        bf16_t* RWT = (bf16_t*)(p.ws + WS_RWT); const float* rw = p.inp(26);
        for (int q = gt; q < 2 * 64 * DM; q += ngt) { const int L = q / (64 * DM), r = q % (64 * DM), e = r / DM, k = r % DM;
            const float w = rw[((size_t)L * DM + k) * 64 + e]; const bf16_t hi = f2bf(w); const bf16_t lo = f2bf(w - bf2f(hi));
            RWT[((size_t)(L * 2 + 0) * 64 + e) * DM + k] = hi; RWT[((size_t)(L * 2 + 1) * 64 + e) * DM + k] = lo; }
    }
    {
        const float* cvec = p.inp(1); const float* cctx = p.inp(3); const float* mw = p.inp(4);
        float* MODP = (float*)(p.ws + WS_MODP);
        for (int task = C.gw; task < 2 * 32 * 48; task += C.ngw) {
            const int L = task / (32 * 48), r = task % (32 * 48), kb = r / 48, cb = r % 48;
            const float sc = siluf_(cvec[64 * kb + C.lane]), sx = siluf_(cctx[64 * kb + C.lane]);
            f32x4 a0 = {0.f, 0.f, 0.f, 0.f}, a1 = {0.f, 0.f, 0.f, 0.f};
            const float* wp = mw + ((size_t)L * DM + 64 * kb) * 12288 + 256 * cb + 4 * C.lane;
#pragma unroll 8
            for (int kk = 0; kk < 64; ++kk) { const f32x4 w = *(const f32x4*)(wp + (size_t)kk * 12288);
                const float s0 = __shfl(sc, kk), s1 = __shfl(sx, kk);
                a0 += w * s0; a1 += w * s1; }
            *(f32x4*)(MODP + ((size_t)((L * 32 + kb) * 2 + 0)) * 12288 + 256 * cb + 4 * C.lane) = a0;
            *(f32x4*)(MODP + ((size_t)((L * 32 + kb) * 2 + 1)) * 12288 + 256 * cb + 4 * C.lane) = a1;
        }
    }
    {
        LAS float* scr = (LAS float*)(C.lds + C.wave * 17408);
        constexpr int J0 = (DM / 64) * (EV_IN / 64), J3 = (DM / 64) * (OD_IN / 64);
        for (int it = C.gw; it < J0 + J3; it += C.ngw) {
            const bool l1 = it >= J0; const int r = l1 ? it - J0 : it; const int N = l1 ? OD_IN : EV_IN; const int nblk = N / 64, kb = r / nblk, nb = r % nblk;
            tr_item64_fp8(p.inp(l1 ? 21 : 8), N, (unsigned char*)(p.ws + (l1 ? WS_WIN1 : WS_WIN0)), DM, 64 * kb, 64 * nb, 64 * nb, scr, C.lane, 32.0f);
        }
        LAS float* scr2 = (LAS float*)(C.lds + C.wave * 17408);
        constexpr int I1 = (DM / 64) * (DM / 32), I2 = (1024 / 64) * (1024 / 32), I4 = I1;
        for (int it = C.gw; it < I1 + I2 + I4; it += C.ngw) {
            int r = it;
            if (r < I1) { tr_dense(p.inp(9), DM, DM, (bf16_t*)(p.ws + WS_WOUT0), r, scr2, C.lane); continue; } r -= I1;
            if (r < I2) { tr_dense(p.inp(19), 1024, 1024, (bf16_t*)(p.ws + WS_WGLU), r, scr2, C.lane); continue; } r -= I2;
            tr_dense(p.inp(22), DM, DM, (bf16_t*)(p.ws + WS_WOUT1), r, scr2, C.lane);
        }
    }
}
__device__ __forceinline__ void phase_p1(const Params& p, Ctx& C) {
    const float* MODP = (const float*)(p.ws + WS_MODP); float* MODF = (float*)(p.ws + WS_MODF); const float* mb = p.inp(5);
    for (int q = C.bid * NTHR + C.tid; q < 2 * 2 * 12288; q += C.G * NTHR) { const int L = q / (2 * 12288), v = (q / 12288) & 1, col = q % 12288;
        float s = mb[L * 12288 + col];
        for (int kb = 0; kb < 32; ++kb) s += MODP[((size_t)((L * 32 + kb) * 2 + v)) * 12288 + col];
        MODF[q] = s; }
}
__device__ __forceinline__ const float* modv(const Params& p, int L, int v, int k) { return (const float*)(p.ws + WS_MODF) + (size_t)(L * 2 + v) * 12288 + k * DM; }

__device__ __forceinline__ void stage_vec(LAS float* dst, const float* src, int tid) { *(LAS f32x4*)(dst + 4 * tid) = *(const f32x4*)(src + 4 * tid); }
__device__ __forceinline__ void conv_item(const Params& p, Ctx& C, int L, int it) {
    LAS float* scr = (LAS float*)(C.lds + C.wave * 17408);
    unsigned char* GU = (unsigned char*)(p.ws + WS_GU) + (size_t)L * NEX1 * 1024 * DM; unsigned char* DT = (unsigned char*)(p.ws + WS_DT) + (size_t)L * NEX1 * DM * EHID;
    const int e = it / 768, r = it % 768, which = r >> 8, q = r & 255;
    if (which < 2) {
        const float* W = (e < 64) ? p.inp(28 + which) + ((size_t)(L * 64 + e)) * DM * EHID : p.inp(31 + which) + (size_t)L * DM * EHID;
        const int kb = q >> 3, nb = q & 7, n0 = 64 * nb;
        tr_item64_fp8(W, EHID, GU + (size_t)e * 1024 * DM, DM, 64 * kb, n0, 256 * (n0 >> 7) + (n0 & 127) + (which ? 128 : 0), scr, C.lane);
    } else {
        const float* W = (e < 64) ? p.inp(30) + ((size_t)(L * 64 + e)) * EHID * DM : p.inp(33) + (size_t)L * EHID * DM;
        const int kb = q >> 5, nb = q & 31;
        tr_item64_fp8(W, DM, DT + (size_t)e * DM * EHID, EHID, 64 * kb, 64 * nb, 64 * nb, scr, C.lane);
    }
}
__device__ __forceinline__ void conv_queue(const Params& p, Ctx& C, int quota) {
    unsigned* head = (unsigned*)(p.ws + WS_CTL) + CW_QUEUE + 128;
    const int batch = quota < 8 ? quota : 8;
    for (int done = 0; done < quota; done += batch) {
        int it0 = 0; if (C.lane == 0) it0 = (int)atomicAdd(head, (unsigned)batch);
        it0 = __builtin_amdgcn_readfirstlane(it0);
        if (it0 >= NEX1 * 768) break;
        for (int k = 0; k < batch && it0 + k < NEX1 * 768; ++k) conv_item(p, C, 1, it0 + k);
    }
}
__device__ __forceinline__ void phase_modulate(const Params& p, Ctx& C, int L) {
    unsigned char* XA8 = (unsigned char*)(p.ws + WS_XA);
    const float* X2 = (const float*)(p.ws + WS_HX2);
    LAS float* MV = (LAS float*)C.lds;
    for (int v = 0; v < 2; ++v) { stage_vec(MV + (v * 2 + 0) * DM, modv(p, L, v, 0), C.tid); stage_vec(MV + (v * 2 + 1) * DM, modv(p, L, v, 1), C.tid); }
    __syncthreads();
    for (int r = C.gw; r < TT; r += C.ngw) {
        const int v = r < CTXL ? 1 : 0;
        const float* src = (L == 0) ? (r < CTXL ? p.inp(2) + (size_t)r * DM : p.inp(0) + (size_t)(r - CTXL) * DM) : X2 + (size_t)r * DM;
        const LAS float* sh = MV + (v * 2 + 0) * DM; const LAS float* sc = MV + (v * 2 + 1) * DM;
#pragma unroll
        for (int j = 0; j < 8; ++j) { const int c = 4 * (C.lane + 64 * j);
            const f32x4 x = *(const f32x4*)(src + c), a = *(const LAS f32x4*)(sc + c), b = *(const LAS f32x4*)(sh + c);
            const f32x4 y = x * (a + 1.0f) + b;
            unsigned w = (unsigned)__builtin_amdgcn_cvt_pk_fp8_f32(y[0], y[1], 0, false); w = (unsigned)__builtin_amdgcn_cvt_pk_fp8_f32(y[2], y[3], (int)w, true);
            *(unsigned*)(XA8 + (size_t)r * DM + c) = w; }
    }
    __syncthreads();
    if (L == 0) { for (int it = C.gw; it < NEX1 * 768; it += C.ngw) conv_item(p, C, 0, it); }
    else conv_queue(p, C, 1 << 30);
}

__device__ __forceinline__ void phase_rope0(const Params& p, Ctx& C) {
    bf16_t* QKV = (bf16_t*)(p.ws + WS_BIG + BG_QKV);
    const f32x2* R128 = (const f32x2*)(p.ws + WS_ROPE128);
    for (int r = C.gw; r < TT; r += C.ngw) {
        bf16_t* row = QKV + (size_t)r * EV_IN;
        if (r < CTXL) {
#pragma unroll
            for (int j = 0; j < 2; ++j) { u32x4* q = (u32x4*)(row + 8 * (C.lane + 64 * j)); u32x4 w = *q;
                w.x = cvt_pk_bf16(bflo(w.x) * 0.0625f, bfhi(w.x) * 0.0625f); w.y = cvt_pk_bf16(bflo(w.y) * 0.0625f, bfhi(w.y) * 0.0625f);
                w.z = cvt_pk_bf16(bflo(w.z) * 0.0625f, bfhi(w.z) * 0.0625f); w.w = cvt_pk_bf16(bflo(w.w) * 0.0625f, bfhi(w.w) * 0.0625f); *q = w; }
        } else {
            const int l = r - CTXL, rp = l >> 6, cp = l & 63;
#pragma unroll
            for (int qk = 0; qk < 2; ++qk)
#pragma unroll
                for (int m = 0; m < 8; ++m) { const int pi = C.lane + 64 * m, head = pi >> 7, blk = (pi >> 6) & 1, i = pi & 63;
                    bf16_t* b = row + qk * 1024 + head * 256 + blk * 128 + i;
                    const f32x2 cs = R128[(blk ? cp : rp) * 64 + i];
                    const float x1 = bf2f(b[0]), x2 = bf2f(b[64]); const float sc = qk ? 1.0f : 0.0625f;
                    b[0] = f2bf((x1 * cs.x - x2 * cs.y) * sc); b[64] = f2bf((x1 * cs.y + x2 * cs.x) * sc); }
        }
    }
}

__device__ __forceinline__ void phase_normrope1(const Params& p, Ctx& C) {
    bf16_t* QKV = (bf16_t*)(p.ws + WS_BIG + BG_QKV);
    const f32x2* R64 = (const f32x2*)(p.ws + WS_ROPE64);
    const float* qg = p.inp(23);
    unsigned* KMAX = (unsigned*)(p.ws + WS_CTL) + CW_KMAX;
    unsigned char* Q8 = (unsigned char*)(p.ws + WS_BIG + BG_Q8); unsigned char* K8 = (unsigned char*)(p.ws + WS_BIG + BG_K8); unsigned char* VT8 = (unsigned char*)(p.ws + WS_BIG + BG_VT8);
    unsigned char* Q8D = (unsigned char*)(p.ws + WS_BIG + BG_Q8D); unsigned char* K8D = (unsigned char*)(p.ws + WS_BIG + BG_K8D); unsigned char* VT8D = (unsigned char*)(p.ws + WS_BIG + BG_VT8D);
    const int lane = C.lane, i32 = lane & 31; const bool up = lane >= 32;
    const float g00 = qg[lane], g01 = qg[64 + lane], g10 = qg[128 + lane], g11 = qg[128 + 64 + lane];
    for (int r = C.gw; r < TT; r += C.ngw) {
        bf16_t* row = QKV + (size_t)r * OD_IN;
        const bool lat = r >= CTXL; const int l = r - CTXL, rp = lat ? (l >> 6) : 0, cp = lat ? (l & 63) : 0;
        const f32x2 cr = R64[rp * 32 + i32], cc = R64[cp * 32 + i32];
#pragma unroll 2
        for (int h = 0; h < 26; ++h) {
            const int col = h < 8 ? 128 * h : (h < 10 ? 1024 + 128 * (h - 8) : (h < 18 ? 1536 + 128 * (h - 10) : 2560 + 128 * (h - 18)));
            bf16_t* b = row + col;
            float v0 = bf2f(b[lane]), v1 = bf2f(b[64 + lane]);
            if (h < 10) { const float ss = wave_sum(v0 * v0 + v1 * v1); const float rs = rsqrtf(ss * (1.0f / 128.0f) + LN_EPS);
                v0 = bf2f(f2bf(v0 * rs)) * (h < 8 ? g00 : g10); v1 = bf2f(f2bf(v1 * rs)) * (h < 8 ? g01 : g11); }
            if (lat) { const float p0 = __shfl_xor(v0, 32), p1 = __shfl_xor(v1, 32);
                v0 = up ? (p0 * cr.y + v0 * cr.x) : (v0 * cr.x - p0 * cr.y);
                v1 = up ? (p1 * cc.y + v1 * cc.x) : (v1 * cc.x - p1 * cc.y); }
            const bf16_t o0 = f2bf(v0), o1 = f2bf(v1);
            b[lane] = o0; b[64 + lane] = o1;
            {
                const float qs = (h < 8 || (h >= 10 && h < 18)) ? 0.088388347648318440f * 1.4426950408889634f : 1.0f;
                const float w0 = bf2f(o0) * qs, w1 = bf2f(o1) * qs;
                float e4[4];
#pragma unroll
                for (int j = 0; j < 4; ++j) { const float a = __shfl(w0, (4 * lane + j) & 63), c2 = __shfl(w1, (4 * lane + j) & 63); e4[j] = lane < 16 ? a : c2; }
                unsigned pk = (unsigned)__builtin_amdgcn_cvt_pk_fp8_f32(e4[0], e4[1], 0, false); pk = (unsigned)__builtin_amdgcn_cvt_pk_fp8_f32(e4[2], e4[3], (int)pk, true);
                unsigned char* dst8 = h < 8 ? Q8 + (size_t)r * 1024 + 128 * h : (h < 10 ? K8 + (size_t)r * 256 + 128 * (h - 8) : (h < 18 ? Q8D + (size_t)r * 1024 + 128 * (h - 10) : K8D + (size_t)r * 1024 + 128 * (h - 18)));
                if (lane < 32) *(unsigned*)(dst8 + 4 * lane) = pk; }
            if ((h >= 8 && h < 10) || h >= 18) {
                const float w0 = bf2f(o0), w1 = bf2f(o1); const float k2 = wave_sum(w0 * w0 + w1 * w1);
                if (lane == 0) atomicMax(KMAX + 64 * (h < 10 ? h - 8 : h - 16), __float_as_uint(k2)); }
        }
    }
    LAS bf16_t* vt = (LAS bf16_t*)(C.lds + C.wave * 17408);
    for (int item = C.gw; item < 10 * 260; item += C.ngw) {
        const int kh = item / 260, T = item % 260;
        const int vcol = kh < 2 ? 1280 + 128 * kh : 3584 + 128 * (kh - 2);
        unsigned char* vout = kh < 2 ? VT8 + (size_t)kh * 260 * 8192 : VT8D + (size_t)(kh - 2) * 260 * 8192;
#pragma unroll
        for (int q = 0; q < 16; ++q) { const int idx = lane + 64 * q, key = idx >> 4, c = idx & 15;
            *(LAS u32x4*)(vt + key * 136 + 8 * c) = *(const u32x4*)(QKV + (size_t)(64 * T + key) * OD_IN + vcol + 8 * c); }
        LDS_WAIT(); asm volatile("" ::: "memory");
#pragma unroll
        for (int dd = 0; dd < 2; ++dd) { const int d = lane + 64 * dd;
            unsigned char* dst = vout + ((size_t)T * 128 + d) * 64;
#pragma unroll
            for (int cch = 0; cch < 4; ++cch) { u32x4 w;
#pragma unroll
                for (int wd = 0; wd < 4; ++wd) { float f[4];
#pragma unroll
                    for (int e = 0; e < 4; ++e) { const int bb = 16 * cch + 4 * wd + e, hi2 = bb >> 5, blk = (bb >> 4) & 1, j = bb & 15; const int key = 32 * blk + (j & 3) + 8 * (j >> 2) + 4 * hi2;
                        f[e] = bf2f(vt[key * 136 + d]); }
                    unsigned pk = (unsigned)__builtin_amdgcn_cvt_pk_fp8_f32(f[0], f[1], 0, false); pk = (unsigned)__builtin_amdgcn_cvt_pk_fp8_f32(f[2], f[3], (int)pk, true);
                    w[wd] = pk; }
                *(u32x4*)(dst + 16 * cch) = w; } }
        LDS_WAIT(); asm volatile("" ::: "memory");
    }
}

__device__ __forceinline__ void phase_merge1(const Params& p, Ctx& C) {
    bf16_t* ATT = (bf16_t*)(p.ws + WS_BIG + BG_ATT);
    const float* dl = p.inp(24); const float* sg = p.inp(25);
    const int lane = C.lane;
    float d0 = dl[lane] * dl[128 + lane] + dl[64 + lane] * dl[128 + 64 + lane];
    float d1 = dl[256 + lane] * dl[384 + lane] + dl[256 + 64 + lane] * dl[384 + 64 + lane];
    const float lam = __expf(wave_sum(d0)) - __expf(wave_sum(d1)) + LAMBDA_INIT;
    const f32x4 gg = *(const f32x4*)(sg + 4 * lane);
    for (int l = C.gw; l < SEQ; l += C.ngw) {
        bf16_t* row = ATT + (size_t)l * 3072;
#pragma unroll
        for (int h = 0; h < 4; ++h) {
            const u32x2 a = *(const u32x2*)(row + 1024 + 256 * h + 4 * lane), b = *(const u32x2*)(row + 2048 + 256 * h + 4 * lane);
            f32x4 o = {bflo(a.x) - lam * bflo(b.x), bfhi(a.x) - lam * bfhi(b.x), bflo(a.y) - lam * bflo(b.y), bfhi(a.y) - lam * bfhi(b.y)};
            const float ss = wave_sum(o[0] * o[0] + o[1] * o[1] + o[2] * o[2] + o[3] * o[3]);
            const float rs = rsqrtf(ss * (1.0f / 256.0f) + LN_EPS) * (1.0f - LAMBDA_INIT);
            o = o * rs * gg;
            u32x2 w; w.x = cvt_pk_bf16(o[0], o[1]); w.y = cvt_pk_bf16(o[2], o[3]);
            *(u32x2*)(row + 1024 + 256 * h + 4 * lane) = w;
        }
    }
}

__device__ __forceinline__ void phase_ln1(const Params& p, Ctx& C, int L) {
    const bf16_t* Y = (const bf16_t*)(p.ws + WS_YMIX); float* X1 = (float*)(p.ws + WS_X1); unsigned char* XA8 = (unsigned char*)(p.ws + WS_XA);
    const float* X2 = (const float*)(p.ws + WS_HX2);
    const float* lg = p.inp(6) + (size_t)(L * 2 + 0) * DM; const float* lb = p.inp(7) + (size_t)(L * 2 + 0) * DM;
    const int r0 = (L == 0) ? 0 : CTXL;
    LAS float* MV = (LAS float*)C.lds; LAS float* LG = MV + 6 * DM; LAS float* LB = LG + DM;
    for (int v = 0; v < 2; ++v) for (int k = 0; k < 3; ++k) stage_vec(MV + (v * 3 + k) * DM, modv(p, L, v, 2 + k), C.tid);
    stage_vec(LG, lg, C.tid); stage_vec(LB, lb, C.tid);
    __syncthreads();
    for (int r = r0 + C.gw; r < TT; r += C.ngw) {
        const int v = r < CTXL ? 1 : 0;
        const float* src = (L == 0) ? (r < CTXL ? p.inp(2) + (size_t)r * DM : p.inp(0) + (size_t)(r - CTXL) * DM) : X2 + (size_t)r * DM;
        const LAS float* g1 = MV + (v * 3 + 0) * DM; const LAS float* sh2 = MV + (v * 3 + 1) * DM; const LAS float* sc2 = MV + (v * 3 + 2) * DM;
        f32x4 t[8]; float s = 0.f;
#pragma unroll
        for (int j = 0; j < 8; ++j) { const int c = 4 * (C.lane + 64 * j);
            const f32x4 x = *(const f32x4*)(src + c), g = *(const LAS f32x4*)(g1 + c); const u32x2 yy = *(const u32x2*)(Y + (size_t)r * DM + c);
            const f32x4 y = {bflo(yy.x), bfhi(yy.x), bflo(yy.y), bfhi(yy.y)};
            t[j] = x * ALPHA + g * y; s += (t[j][0] + t[j][1]) + (t[j][2] + t[j][3]); }
        const float mean = wave_sum(s) * (1.0f / DM); float s2 = 0.f;
#pragma unroll
        for (int j = 0; j < 8; ++j) { t[j] = t[j] - mean; s2 += (t[j][0] * t[j][0] + t[j][1] * t[j][1]) + (t[j][2] * t[j][2] + t[j][3] * t[j][3]); }
        const float rstd = rsqrtf(wave_sum(s2) * (1.0f / DM) + LN_EPS);
#pragma unroll
        for (int j = 0; j < 8; ++j) { const int c = 4 * (C.lane + 64 * j);
            const f32x4 x1 = t[j] * rstd * *(const LAS f32x4*)(LG + c) + *(const LAS f32x4*)(LB + c);
            *(f32x4*)(X1 + (size_t)r * DM + c) = x1;
            const f32x4 z = x1 * (*(const LAS f32x4*)(sc2 + c) + 1.0f) + *(const LAS f32x4*)(sh2 + c);
            unsigned w = (unsigned)__builtin_amdgcn_cvt_pk_fp8_f32(z[0], z[1], 0, false); w = (unsigned)__builtin_amdgcn_cvt_pk_fp8_f32(z[2], z[3], (int)w, true);
            *(unsigned*)(XA8 + (size_t)r * DM + c) = w; }
    }
    __syncthreads();
}

__device__ __forceinline__ void phase_combine(const Params& p, Ctx& C, int L, LAS unsigned char* misc) {
    const unsigned char* YM = (const unsigned char*)(p.ws + WS_BIG + BG_YMOE); const float* X1 = (const float*)(p.ws + WS_X1);
    float* X2 = (float*)(p.ws + WS_HX2);
    const float* lg = p.inp(6) + (size_t)(L * 2 + 1) * DM; const float* lb = p.inp(7) + (size_t)(L * 2 + 1) * DM;
    const unsigned* PK = (const unsigned*)(p.ws + WS_WGT); const int* cnt = (const int*)(p.ws + WS_CTL) + CW_CNT + L * 128; const float* LWT = (const float*)(p.ws + WS_LW);
    const int r0 = (L == 0) ? 0 : CTXL;
    LAS int* rb = (LAS int*)(misc + 64);
    LAS float* MV = (LAS float*)C.lds; LAS float* LG = MV + 2 * DM; LAS float* LB = LG + DM;
    __syncthreads();
    if (C.tid == 0) { int q = 0; for (int e = 0; e < NEX1; ++e) { rb[e] = q; q += cnt[e]; } }
    stage_vec(MV, modv(p, L, 0, 5), C.tid); stage_vec(MV + DM, modv(p, L, 1, 5), C.tid); stage_vec(LG, lg, C.tid); stage_vec(LB, lb, C.tid);
    LAS float* M1 = LB + DM;
    unsigned char* XA8 = (unsigned char*)(p.ws + WS_XA);
    if (L == 0) { for (int v = 0; v < 2; ++v) { stage_vec(M1 + (v * 2 + 0) * DM, modv(p, 1, v, 0), C.tid); stage_vec(M1 + (v * 2 + 1) * DM, modv(p, 1, v, 1), C.tid); } }
    __syncthreads();
    for (int r = r0 + C.gw; r < TT; r += C.ngw) {
        const int v = r < CTXL ? 1 : 0;
        const LAS float* g2 = MV + v * DM;
        int ln = C.lane; asm volatile("" : "+v"(ln));
        int slot = rb[64] + (r - r0);
        float wk = 4.0f;
        if (ln < 8) { const unsigned pk = PK[(size_t)r * 8 + ln]; wk = LWT[(size_t)r * 8 + ln]; slot = rb[pk >> 16] + (int)(pk & 0xffffu); }
        f32x4 t[2][4]; float s = 0.f;
#pragma unroll
        for (int j = 0; j < 2; ++j) { const int c = 16 * (ln + 64 * j);
            u32x4 yy[9];
#pragma unroll
            for (int k = 0; k < 9; ++k) { const size_t a = (size_t)__builtin_amdgcn_readlane(slot, k); yy[k] = __builtin_nontemporal_load((const u32x4*)(YM + a * DM + c)); }
            f32x2 f[8];
#pragma unroll
            for (int q = 0; q < 8; ++q) f[q] = (f32x2){0.f, 0.f};
#pragma unroll
            for (int k = 0; k < 9; ++k) { const float wq = __int_as_float(__builtin_amdgcn_readlane(__float_as_int(wk), k));
                f[0] += wq * __builtin_amdgcn_cvt_pk_f32_fp8((int)yy[k].x, false); f[1] += wq * __builtin_amdgcn_cvt_pk_f32_fp8((int)yy[k].x, true);
                f[2] += wq * __builtin_amdgcn_cvt_pk_f32_fp8((int)yy[k].y, false); f[3] += wq * __builtin_amdgcn_cvt_pk_f32_fp8((int)yy[k].y, true);
                f[4] += wq * __builtin_amdgcn_cvt_pk_f32_fp8((int)yy[k].z, false); f[5] += wq * __builtin_amdgcn_cvt_pk_f32_fp8((int)yy[k].z, true);
                f[6] += wq * __builtin_amdgcn_cvt_pk_f32_fp8((int)yy[k].w, false); f[7] += wq * __builtin_amdgcn_cvt_pk_f32_fp8((int)yy[k].w, true); }
#pragma unroll
            for (int q = 0; q < 4; ++q) { const f32x4 x = *(const f32x4*)(X1 + (size_t)r * DM + c + 4 * q), g = *(const LAS f32x4*)(g2 + c + 4 * q);
                const f32x4 ff = {f[2 * q][0], f[2 * q][1], f[2 * q + 1][0], f[2 * q + 1][1]};
                t[j][q] = x * ALPHA + g * ff; s += (t[j][q][0] + t[j][q][1]) + (t[j][q][2] + t[j][q][3]); } }
        const float mean = wave_sum(s) * (1.0f / DM); float s2 = 0.f;
#pragma unroll
        for (int j = 0; j < 2; ++j)
#pragma unroll
            for (int q = 0; q < 4; ++q) { t[j][q] = t[j][q] - mean; s2 += (t[j][q][0] * t[j][q][0] + t[j][q][1] * t[j][q][1]) + (t[j][q][2] * t[j][q][2] + t[j][q][3] * t[j][q][3]); }
        const float rstd = rsqrtf(wave_sum(s2) * (1.0f / DM) + LN_EPS);
        float* dst = (L == 0) ? X2 + (size_t)r * DM : p.out + (size_t)(r - CTXL) * DM;
#pragma unroll
        for (int j = 0; j < 2; ++j)
#pragma unroll
            for (int q = 0; q < 4; ++q) { const int c = 16 * (ln + 64 * j) + 4 * q;
                const f32x4 xn = t[j][q] * rstd * *(const LAS f32x4*)(LG + c) + *(const LAS f32x4*)(LB + c);
                *(f32x4*)(dst + c) = xn;
                if (L == 0) { const f32x4 y = xn * (*(const LAS f32x4*)(M1 + (v * 2 + 1) * DM + c) + 1.0f) + *(const LAS f32x4*)(M1 + (v * 2 + 0) * DM + c);
                    unsigned w = (unsigned)__builtin_amdgcn_cvt_pk_fp8_f32(y[0], y[1], 0, false); w = (unsigned)__builtin_amdgcn_cvt_pk_fp8_f32(y[2], y[3], (int)w, true);
                    *(unsigned*)(XA8 + (size_t)r * DM + c) = w; } }
    }
    if (L == 0) { __syncthreads(); conv_queue(p, C, 1 << 30); }
}
constexpr int RLD = 264;
constexpr int SLD = 136;

template <bool SCALE>
__device__ __forceinline__ void stage_chunk(const bf16_t* QKV, int row0, int col0, LAS bf16_t* dst, int tid, float lg  , int dirb) {
#pragma unroll
    for (int q = 0; q < 8; ++q) { const int idx = tid + NTHR * q, r = idx >> 5, c = idx & 31;
        u32x4 w = *(const u32x4*)(QKV + (size_t)(row0 + r) * EV_IN + col0 + 8 * c);
        if (SCALE) { const float sc = fast_exp((dirb ? (float)r : (float)(127 - r)) * lg);
            w.x = cvt_pk_bf16(bflo(w.x) * sc, bfhi(w.x) * sc); w.y = cvt_pk_bf16(bflo(w.y) * sc, bfhi(w.y) * sc);
            w.z = cvt_pk_bf16(bflo(w.z) * sc, bfhi(w.z) * sc); w.w = cvt_pk_bf16(bflo(w.w) * sc, bfhi(w.w) * sc); }
        *(LAS u32x4*)(dst + r * RLD + 8 * c) = w; }
}

__device__ __forceinline__ void ret_chunk_kv(const Params& p, Ctx& C) {
    const bf16_t* QKV = (const bf16_t*)(p.ws + WS_BIG + BG_QKV); bf16_t* CKV = (bf16_t*)(p.ws + WS_BIG + BG_CKV);
    const float* rld = p.inp(10);
    LAS bf16_t* Vs = (LAS bf16_t*)C.lds; LAS bf16_t* Ks = Vs + 128 * RLD;
    const int lane = C.lane, w = C.wave;
    for (int unit = C.bid; unit < 130 * 8; unit += C.G) {
        const int u = unit >> 3, h = (unit >> 1) & 3, dir = unit & 1;
        const float lg = rld[dir * 4 + h];
        __syncthreads();
        stage_chunk<false>(QKV, 128 * u, 2048 + 256 * h, Vs, C.tid, 0.f, 0);
        stage_chunk<true>(QKV, 128 * u, 1024 + 256 * h, Ks, C.tid, lg, dir);
        __syncthreads();
        f32x4 acc[2][16];
#pragma unroll
        for (int a = 0; a < 2; ++a)
#pragma unroll
            for (int b = 0; b < 16; ++b) acc[a][b] = (f32x4){0.f, 0.f, 0.f, 0.f};
        const unsigned vbase = (unsigned)(uintptr_t)Vs, kbase = (unsigned)(uintptr_t)Ks;
#pragma unroll 1
        for (int ks = 0; ks < 4; ++ks) {
            bf16x8 af[2];
#pragma unroll
            for (int a = 0; a < 2; ++a) af[a] = frag_colk_l(vbase + (unsigned)((32 * ks) * RLD + 32 * w + 16 * a) * 2u, RLD * 2, lane);
#pragma unroll
            for (int b = 0; b < 16; ++b) { const bf16x8 bf = frag_colk_l(kbase + (unsigned)((32 * ks) * RLD + 16 * b) * 2u, RLD * 2, lane);
                acc[0][b] = MFMA16(bf, af[0], acc[0][b]); acc[1][b] = MFMA16(bf, af[1], acc[1][b]); }
        }
        bf16_t* dst = CKV + ((size_t)((dir * 4 + h) * 130 + u)) * 65536;
#pragma unroll
        for (int a = 0; a < 2; ++a)
#pragma unroll
            for (int b = 0; b < 16; ++b) { u32x2 w2; w2.x = cvt_pk_bf16(acc[a][b][0], acc[a][b][1]); w2.y = cvt_pk_bf16(acc[a][b][2], acc[a][b][3]);
                *(u32x2*)(dst + (size_t)(32 * w + 16 * a + (lane & 15)) * 256 + 16 * b + 4 * (lane >> 4)) = w2; }
    }
    __syncthreads();
}

__device__ __forceinline__ int s5_row(int dir, int c, int s) { return dir == 0 ? 64 * c + s : (c < 4 ? 255 - (64 * c + s) : 16639 - 64 * (c - 4) - s); }

__device__ __forceinline__ void s5_end_states(const Params& p, Ctx& C) {
    const bf16_t* QKV = (const bf16_t*)(p.ws + WS_BIG + BG_QKV); const bf16_t* BBT = (const bf16_t*)(p.ws + WS_BBT); float* E = (float*)(p.ws + WS_S5E);
    const float* APOW = (const float*)(p.ws + WS_APOW);
    LAS f32x2* PL = (LAS f32x2*)C.lds;
    for (int bt = C.bid; bt < 256; bt += C.G) {
        int tid = C.tid; asm volatile("" : "+v"(tid));
        const int lane = tid & 63, r32 = lane & 31, hi = lane >> 5;
        const int dg = bt >> 1, dir = dg >> 6, g = dg & 63, c0 = 130 * (bt & 1);
        __syncthreads();
#pragma unroll
        for (int q = 0; q < 8; ++q) { const int idx = tid + NTHR * q, s = idx >> 6, pp = idx & 63;
            PL[idx] = (s == 63) ? (f32x2){1.0f, 0.0f} : *(const f32x2*)(APOW + ((size_t)dg * 64 + (62 - s)) * 128 + 2 * pp); }
        __syncthreads();
        bf16x8 bfr[4];
#pragma unroll
        for (int pt = 0; pt < 4; ++pt) bfr[pt] = *(const bf16x8*)(BBT + ((size_t)dg * 128 + 32 * pt + r32) * 16 + 8 * hi);
        for (int c = c0 + C.wave; c < c0 + 130; c += 8) {
            float er[2] = {0.f, 0.f}, ei[2] = {0.f, 0.f};
#pragma unroll
            for (int st = 0; st < 2; ++st) {
                const bf16x8 a = *(const bf16x8*)(QKV + (size_t)s5_row(dir, c, 32 * st + r32) * EV_IN + 4096 + 16 * g + 8 * hi);
                f32x16 d[4];
#pragma unroll
                for (int pt = 0; pt < 4; ++pt) d[pt] = __builtin_amdgcn_mfma_f32_32x32x16_bf16(a, bfr[pt], (f32x16){}, 0, 0, 0);
#pragma unroll
                for (int r = 0; r < 16; ++r) { const int s = 32 * st + (r & 3) + 8 * (r >> 2) + 4 * hi;
#pragma unroll
                    for (int pt = 0; pt < 2; ++pt) { const f32x2 pw = PL[s * 64 + 32 * pt + r32]; const float br = d[pt][r], bi = d[pt + 2][r];
                        er[pt] += pw.x * br - pw.y * bi; ei[pt] += pw.x * bi + pw.y * br; } }
            }
#pragma unroll
            for (int pt = 0; pt < 2; ++pt) {
                { auto rr = __builtin_amdgcn_permlane32_swap(__float_as_uint(er[pt]), __float_as_uint(er[pt]), false, false); er[pt] = __uint_as_float(rr[0]) + __uint_as_float(rr[1]); }
                { auto rr = __builtin_amdgcn_permlane32_swap(__float_as_uint(ei[pt]), __float_as_uint(ei[pt]), false, false); ei[pt] = __uint_as_float(rr[0]) + __uint_as_float(rr[1]); }
            }
            float* dst = E + ((size_t)dg * 260 + c) * 128;
            if (hi == 0) { dst[r32] = er[0]; dst[32 + r32] = er[1]; dst[64 + r32] = ei[0]; dst[96 + r32] = ei[1]; }
        }
    }
    __syncthreads();
}

__device__ __forceinline__ void phase_scans(const Params& p, Ctx& C) {
    const bf16_t* CKV = (const bf16_t*)(p.ws + WS_BIG + BG_CKV); bf16_t* SP = (bf16_t*)(p.ws + WS_BIG + BG_SPREV);
    const float* rld = p.inp(10);
    for (int q = C.bid * NTHR + C.tid; q < 8 * 16384; q += C.G * NTHR) {
        const int dh = q >> 14, el = (q & 16383) * 4, dir = dh >> 2, h = dh & 3;
        const float gch = fast_exp(128.0f * rld[dir * 4 + h]);
        const bf16_t* src = CKV + (size_t)dh * 130 * 65536 + el; bf16_t* dst = SP + (size_t)dh * 130 * 65536 + el;
        f32x4 s = {0.f, 0.f, 0.f, 0.f};
        for (int st0 = 0; st0 < 130; st0 += 13) {
            u32x2 kv[13];
#pragma unroll
            for (int k = 0; k < 13; ++k) { const int st = st0 + k; const int u = dir == 0 ? st : (st == 0 ? 1 : (st == 1 ? 0 : 131 - st)); kv[k] = __builtin_nontemporal_load((const u32x2*)(src + (size_t)u * 65536)); }
#pragma unroll
            for (int k = 0; k < 13; ++k) { const int st = st0 + k; const int u = dir == 0 ? st : (st == 0 ? 1 : (st == 1 ? 0 : 131 - st));
                u32x2 w; w.x = cvt_pk_bf16(s[0], s[1]); w.y = cvt_pk_bf16(s[2], s[3]); *(u32x2*)(dst + (size_t)u * 65536) = w;
                s = s * gch + (f32x4){bflo(kv[k].x), bfhi(kv[k].x), bflo(kv[k].y), bfhi(kv[k].y)}; }
        }
    }
    const float* E = (const float*)(p.ws + WS_S5E); float* HST = (float*)(p.ws + WS_HST); const float* AL = (const float*)(p.ws + WS_AL);
    for (int q = C.bid * NTHR + C.tid; q < 2 * 64 * 64; q += C.G * NTHR) {
        const int dg = q >> 6, pp = q & 63;
        const f32x2 al = *(const f32x2*)(AL + (size_t)dg * 128 + 2 * pp);
        const float* e = E + (size_t)dg * 260 * 128; float* hs = HST + (size_t)dg * 260 * 128;
        float hr = 0.f, hi = 0.f;
        for (int c0 = 0; c0 < 260; c0 += 26) {
            float er[26], ei[26];
#pragma unroll
            for (int k = 0; k < 26; ++k) { er[k] = e[(size_t)(c0 + k) * 128 + pp]; ei[k] = e[(size_t)(c0 + k) * 128 + 64 + pp]; }
#pragma unroll
            for (int k = 0; k < 26; ++k) { *(f32x2*)(hs + (size_t)(c0 + k) * 128 + 2 * pp) = (f32x2){hr, hi};
                const float t = al.x * hr - al.y * hi + er[k]; hi = al.x * hi + al.y * hr + ei[k]; hr = t; }
        }
    }
}

__device__ __forceinline__ void ret_output_unit(const Params& p, Ctx& C, int unit) {
    const bf16_t* QKV = (const bf16_t*)(p.ws + WS_BIG + BG_QKV); const bf16_t* SP = (const bf16_t*)(p.ws + WS_BIG + BG_SPREV);
    bf16_t* MIX = (bf16_t*)(p.ws + WS_BIG + BG_MIX);
    const float* rld = p.inp(10);
    LAS bf16_t* RA = (LAS bf16_t*)C.lds; LAS bf16_t* RB = RA + 128 * RLD;
    int tid = C.tid; asm volatile("" : "+v"(tid));
    const int lane = tid & 63, w = C.wave, kq = lane >> 4, fr = lane & 15;
    const int u = unit >> 2, h = unit & 3;
    const float lgf = rld[h], lgb = rld[4 + h];
    stage_chunk<false>(QKV, 128 * u, 256 * h, RA, tid, 0.f, 0);
    int ib = 16 * w + 4 * kq, jb = fr; asm volatile("" : "+v"(ib), "+v"(jb));
    f32x4 acc[16];
#pragma unroll
    for (int t = 0; t < 16; ++t) acc[t] = (f32x4){0.f, 0.f, 0.f, 0.f};
#pragma unroll
    for (int dir = 0; dir < 2; ++dir) {
        const bf16_t* Sd = SP + ((size_t)((dir * 4 + h) * 130 + u)) * 65536;
#pragma unroll
        for (int eh = 0; eh < 2; ++eh) {
            __syncthreads();
#pragma unroll
            for (int q = 0; q < 8; ++q) { const int idx = tid + NTHR * q, rr = idx >> 5, c = idx & 31;
                *(LAS u32x4*)(RB + rr * RLD + 8 * c) = *(const u32x4*)(Sd + (size_t)(128 * eh + rr) * 256 + 8 * c);
                if (q == 3) asm volatile("" ::: "memory"); }
            __syncthreads();
#pragma unroll 1
            for (int ks = 0; ks < 8; ++ks) { const bf16x8 af = frag_rowk_l(RA + (16 * w) * RLD + 32 * ks, RLD, lane);
#pragma unroll
                for (int t = 0; t < 8; ++t) { const bf16x8 bf = frag_rowk_l(RB + (16 * t) * RLD + 32 * ks, RLD, lane); acc[8 * eh + t] = MFMA16(af, bf, acc[8 * eh + t]); } }
        }
#pragma unroll
        for (int r = 0; r < 4; ++r) { const int i = ib + r; const float qd = fast_exp((float)(128 - i) * lgb);
            const float f = (dir == 0) ? fast_exp((float)(i + 1) * lgf) / qd : qd;
#pragma unroll
            for (int t = 0; t < 16; ++t) acc[t][r] *= f; }
    }
    __syncthreads();
    stage_chunk<false>(QKV, 128 * u, 1024 + 256 * h, RB, tid, 0.f, 0);
    __syncthreads();
    f32x4 sc[8];
#pragma unroll
    for (int t = 0; t < 8; ++t) sc[t] = (f32x4){0.f, 0.f, 0.f, 0.f};
#pragma unroll 1
    for (int ks = 0; ks < 8; ++ks) { const bf16x8 af = frag_rowk_l(RA + (16 * w) * RLD + 32 * ks, RLD, lane);
#pragma unroll
        for (int t = 0; t < 8; ++t) { const bf16x8 bf = frag_rowk_l(RB + (16 * t) * RLD + 32 * ks, RLD, lane); sc[t] = MFMA16(af, bf, sc[t]); } }
#pragma unroll
    for (int t = 0; t < 8; ++t)
#pragma unroll
        for (int r = 0; r < 4; ++r) { const int i = ib + r, j = 16 * t + jb; const float d = (float)(i - j);
            const float m = (i >= j ? fast_exp(d * lgf) : 0.f) + (j >= i ? fast_exp(-d * lgb) : 0.f); sc[t][r] *= m; }
    __syncthreads();
    stage_chunk<false>(QKV, 128 * u, 2048 + 256 * h, RA, tid, 0.f, 0);
#pragma unroll
    for (int t = 0; t < 8; ++t)
#pragma unroll
        for (int r = 0; r < 4; ++r) RB[(16 * w + 4 * kq + r) * SLD + 16 * t + fr] = f2bf(sc[t][r]);
    __syncthreads();
    const unsigned vbase = (unsigned)(uintptr_t)RA;
#pragma unroll 1
    for (int ks = 0; ks < 4; ++ks) { const bf16x8 af = frag_rowk_l(RB + (16 * w) * SLD + 32 * ks, SLD, lane);
#pragma unroll
        for (int t = 0; t < 16; ++t) { const bf16x8 bf = frag_colk_l(vbase + (unsigned)((32 * ks) * RLD + 16 * t) * 2u, RLD * 2, lane); acc[t] = MFMA16(af, bf, acc[t]); } }
    __syncthreads();
#pragma unroll
    for (int r = 0; r < 4; ++r) {
        float s = 0.f;
#pragma unroll
        for (int t = 0; t < 16; ++t) s += acc[t][r];
        s += __shfl_xor(s, 1); s += __shfl_xor(s, 2); s += __shfl_xor(s, 4); s += __shfl_xor(s, 8);
        const float mean = s * (1.0f / 256.0f); float q = 0.f;
#pragma unroll
        for (int t = 0; t < 16; ++t) { const float d = acc[t][r] - mean; q += d * d; }
        q += __shfl_xor(q, 1); q += __shfl_xor(q, 2); q += __shfl_xor(q, 4); q += __shfl_xor(q, 8);
        const float rstd = rsqrtf(q * (1.0f / 256.0f) + LN_EPS);
#pragma unroll
        for (int t = 0; t < 16; ++t) RA[(16 * w + 4 * kq + r) * RLD + 16 * t + fr] = f2bf((acc[t][r] - mean) * rstd);
    }
    __syncthreads();
#pragma unroll
    for (int q = 0; q < 8; ++q) { const int idx = tid + NTHR * q, rr = idx >> 5, c = idx & 31; const size_t row = (size_t)(128 * u + rr);
        const u32x4 o = *(const LAS u32x4*)(RA + rr * RLD + 8 * c), g = *(const u32x4*)(QKV + row * EV_IN + 3072 + 256 * h + 8 * c);
        u32x4 w4;
        w4.x = cvt_pk_bf16(bflo(o.x) * siluf_(bflo(g.x)), bfhi(o.x) * siluf_(bfhi(g.x))); w4.y = cvt_pk_bf16(bflo(o.y) * siluf_(bflo(g.y)), bfhi(o.y) * siluf_(bfhi(g.y)));
        w4.z = cvt_pk_bf16(bflo(o.z) * siluf_(bflo(g.z)), bfhi(o.z) * siluf_(bfhi(g.z))); w4.w = cvt_pk_bf16(bflo(o.w) * siluf_(bflo(g.w)), bfhi(o.w) * siluf_(bfhi(g.w)));
        *(u32x4*)(MIX + row * DM + 256 * h + 8 * c) = w4; }
    __syncthreads();
}

constexpr int KLD = 1032;
__device__ __forceinline__ void s5_output_task(const Params& p, Ctx& C, int bt) {
    const bf16_t* QKV = (const bf16_t*)(p.ws + WS_BIG + BG_QKV); bf16_t* Z = (bf16_t*)(p.ws + WS_Z);
    const bf16_t* KN = (const bf16_t*)(p.ws + WS_KN); const bf16_t* CCt = (const bf16_t*)(p.ws + WS_CC);
    const float* APOW = (const float*)(p.ws + WS_APOW); const float* HST = (const float*)(p.ws + WS_HST); const float* dsk = p.inp(18);
    int tid = C.tid; asm volatile("" : "+v"(tid));
    const int lane = tid & 63, kq = lane >> 4, fr = lane & 15;
    LAS bf16_t* KF = (LAS bf16_t*)C.lds; LAS bf16_t* KB = KF + 16 * KLD;
    LAS bf16_t* U = KB + 16 * KLD + C.wave * 3072;
    LAS float* PW0 = (LAS float*)(KB + 16 * KLD + 8 * 3072);
    LAS float* PW16 = PW0 + 2 * 16 * 128;
    {
        const int g = bt >> 3, k0 = (260 * (bt & 7)) >> 3, k1 = (260 * ((bt & 7) + 1)) >> 3;
#pragma unroll
        for (int q = 0; q < 8; ++q) { const int idx = tid + NTHR * q, dir = idx >> 11, rr = (idx >> 7) & 15, c = idx & 127;
            *(LAS u32x4*)((dir ? KB : KF) + rr * KLD + 8 * c) = *(const u32x4*)(KN + ((size_t)(dir * 64 + g) * 16 + rr) * 1024 + 8 * c); }
        for (int q = lane; q < 192 * 2; q += 64) *(LAS u32x4*)(U + 8 * q) = (u32x4){0u, 0u, 0u, 0u};
#pragma unroll
        for (int q = 0; q < 2; ++q) { const int idx = tid + NTHR * q, dir = idx >> 9, f = (idx >> 5) & 15, c4 = idx & 31;
            *(LAS f32x4*)(PW0 + dir * 2048 + f * 128 + 4 * c4) = *(const f32x4*)(APOW + ((size_t)(dir * 64 + g) * 64 + (dir == 0 ? f : 15 - f)) * 128 + 4 * c4); }
        if (tid < 64) { const int dir = tid >> 5, c4 = tid & 31; *(LAS f32x4*)(PW16 + dir * 128 + 4 * c4) = *(const f32x4*)(APOW + ((size_t)(dir * 64 + g) * 64 + 15) * 128 + 4 * c4); }
        __syncthreads();
        const f32x4 dv = *(const f32x4*)(dsk + 16 * g + 4 * kq);
        bf16x8 ccr[2], cci[2];
#pragma unroll
        for (int hb = 0; hb < 2; ++hb) { ccr[hb] = frag_rowk_g(CCt + (size_t)g * 16 * 128 + 32 * hb, 128, lane); cci[hb] = frag_rowk_g(CCt + (size_t)g * 16 * 128 + 64 + 32 * hb, 128, lane); }
        const LAS float* pw0l = PW0 + (size_t)fr * 128 + 16 * kq;
        const LAS float* pw16l = PW16 + 16 * kq;
        for (int k = k0 + C.wave; k < k1; k += 8) {
            LDS_WAIT(); asm volatile("" ::: "memory");
            for (int q = lane; q < 128; q += 64) { const int t = q >> 1, hf = q & 1;
                *(LAS u32x4*)(U + (64 + t) * 16 + 8 * hf) = *(const u32x4*)(QKV + (size_t)(64 * k + t) * EV_IN + 4096 + 16 * g + 8 * hf); }
            LDS_WAIT(); asm volatile("" ::: "memory");
            const int cf = k, cb = k < 4 ? 3 - k : 263 - k;
            f32x4 acc[4];
#pragma unroll
            for (int tt = 0; tt < 4; ++tt) acc[tt] = (f32x4){0.f, 0.f, 0.f, 0.f};
            const LAS bf16_t* ubf = U + (64 + fr - (kq >> 1)) * 16 + 8 * (kq & 1);
            const LAS bf16_t* ubb = U + (64 + fr + (kq >> 1)) * 16 + 8 * (kq & 1);
#pragma unroll
            for (int n0 = 0; n0 < 64; n0 += 2) {
                const bf16x8 af = frag_rowk_l(KF + n0 * 16, KLD, lane), ab = frag_rowk_l(KB + n0 * 16, KLD, lane);
#pragma unroll
                for (int tt = 0; tt < 4; ++tt) {
                    if (n0 <= 16 * tt + 14) acc[tt] = MFMA16(af, *(const LAS bf16x8*)(ubf + (16 * tt - n0) * 16), acc[tt]);
                    if (n0 <= 62 - 16 * tt) acc[tt] = MFMA16(ab, *(const LAS bf16x8*)(ubb + (16 * tt + n0) * 16), acc[tt]);
                }
                asm volatile("" ::: "memory");
            }
#pragma unroll
            for (int dir = 0; dir < 2; ++dir) {
                const float* hp = HST + ((size_t)(dir * 64 + g) * 260 + (dir == 0 ? cf : cb)) * 128;
#pragma unroll
                for (int hb = 0; hb < 2; ++hb) {
                    float xr[8], xi[8];
#pragma unroll
                    for (int e2 = 0; e2 < 4; ++e2) { const f32x4 h4 = *(const f32x4*)(hp + 2 * (32 * hb + 8 * kq) + 4 * e2), b4 = *(const LAS f32x4*)(pw0l + dir * 2048 + hb * 64 + 4 * e2);
                        xr[2 * e2] = b4[0] * h4[0] - b4[1] * h4[1]; xi[2 * e2] = b4[0] * h4[1] + b4[1] * h4[0];
                        xr[2 * e2 + 1] = b4[2] * h4[2] - b4[3] * h4[3]; xi[2 * e2 + 1] = b4[2] * h4[3] + b4[3] * h4[2]; }
#pragma unroll
                    for (int st = 0; st < 4; ++st) {
                        const int tt = dir == 0 ? st : 3 - st;
                        u32x4 br, bi;
                        br.x = cvt_pk_bf16(xr[0], xr[1]); br.y = cvt_pk_bf16(xr[2], xr[3]); br.z = cvt_pk_bf16(xr[4], xr[5]); br.w = cvt_pk_bf16(xr[6], xr[7]);
                        bi.x = cvt_pk_bf16(xi[0], xi[1]); bi.y = cvt_pk_bf16(xi[2], xi[3]); bi.z = cvt_pk_bf16(xi[4], xi[5]); bi.w = cvt_pk_bf16(xi[6], xi[7]);
                        acc[tt] = MFMA16(ccr[hb], __builtin_bit_cast(bf16x8, br), acc[tt]);
                        acc[tt] = MFMA16(cci[hb], __builtin_bit_cast(bf16x8, bi), acc[tt]);
                        if (st < 3) {
#pragma unroll
                            for (int e2 = 0; e2 < 4; ++e2) { const f32x4 a4 = *(const LAS f32x4*)(pw16l + dir * 128 + hb * 64 + 4 * e2);
                                float t0 = xr[2 * e2] * a4[0] - xi[2 * e2] * a4[1]; xi[2 * e2] = xr[2 * e2] * a4[1] + xi[2 * e2] * a4[0]; xr[2 * e2] = t0;
                                t0 = xr[2 * e2 + 1] * a4[2] - xi[2 * e2 + 1] * a4[3]; xi[2 * e2 + 1] = xr[2 * e2 + 1] * a4[3] + xi[2 * e2 + 1] * a4[2]; xr[2 * e2 + 1] = t0; }
                        }
                    }
                }
            }
#pragma unroll
            for (int tt = 0; tt < 4; ++tt) { const int t = 16 * tt + fr;
                const u32x2 uu = *(const LAS u32x2*)(U + (64 + t) * 16 + 4 * kq);
                const float y0 = acc[tt][0] + bflo(uu.x) * dv[0], y1 = acc[tt][1] + bfhi(uu.x) * dv[1], y2 = acc[tt][2] + bflo(uu.y) * dv[2], y3 = acc[tt][3] + bfhi(uu.y) * dv[3];
                u32x2 w; w.x = cvt_pk_bf16(gelu_tanh(y0), gelu_tanh(y1)); w.y = cvt_pk_bf16(gelu_tanh(y2), gelu_tanh(y3));
                *(u32x2*)(Z + (size_t)(64 * k + t) * 1024 + 16 * g + 4 * kq) = w; }
        }
    }
    __syncthreads();
}

__device__ __forceinline__ void phase_ret_s5_outputs(const Params& p, Ctx& C, LAS unsigned char* misc) {
    unsigned* head = (unsigned*)(p.ws + WS_CTL) + CW_QUEUE;
    volatile LAS int* slot = (volatile LAS int*)(misc + 32);
    for (;;) {
        __syncthreads();
        if (C.tid == 0) slot[0] = (int)atomicAdd(head, 1u);
        __syncthreads();
        const int item = __builtin_amdgcn_readfirstlane(slot[0]);
        if (item >= 520) break;
        ret_output_unit(p, C, item);
    }
    for (;;) {
        __syncthreads();
        if (C.tid == 0) slot[0] = (int)atomicAdd(head + 64, 1u);
        __syncthreads();
        const int item = __builtin_amdgcn_readfirstlane(slot[0]);
        if (item >= 512) break;
        s5_output_task(p, C, item);
    }
}
__device__ __forceinline__ void phase_router(const Params& p, Ctx& C, int L) {
    const float* X1 = (const float*)(p.ws + WS_X1);
    const bf16_t* RWh = (const bf16_t*)(p.ws + WS_RWT) + (size_t)(L * 2 + 0) * 64 * DM; const bf16_t* RWl = (const bf16_t*)(p.ws + WS_RWT) + (size_t)(L * 2 + 1) * 64 * DM;
    const float* rbias = p.inp(27) + L * 64;
    int* cnt = (int*)(p.ws + WS_CTL) + CW_CNT + L * 128; int* LIST = (int*)(p.ws + WS_LIST); unsigned* PK = (unsigned*)(p.ws + WS_WGT); float* LW = (float*)(p.ws + WS_LW);
    const int lane = C.lane, kq = lane >> 4, fr = lane & 15;
    LAS float* Lg = (LAS float*)(C.lds + C.wave * 8192);
    const int r0 = (L == 0) ? 0 : CTXL, nrows = TT - r0;
    if (C.bid == 0 && C.tid == 0) cnt[64] = nrows;
    const int quad = C.wave >> 2, kw = C.wave & 3, ntask = nrows / 16;
    for (int tb = C.bid * 2; tb < ntask; tb += C.G * 2) {
        const int task = tb + quad;
        const int rbase = r0 + 16 * task, row = rbase + fr;
        const int v = row < CTXL ? 1 : 0;
        const float* xr = X1 + (size_t)row * DM; const float* sc2 = modv(p, L, v, 4); const float* sh2 = modv(p, L, v, 3);
        f32x4 acc[4];
#pragma unroll
        for (int t = 0; t < 4; ++t) acc[t] = (f32x4){0.f, 0.f, 0.f, 0.f};
#pragma unroll 2
        for (int ks = 16 * kw; ks < 16 * kw + 16; ++ks) { const int c0 = 32 * ks + 8 * kq;
            const f32x4 x0 = *(const f32x4*)(xr + c0), x1 = *(const f32x4*)(xr + c0 + 4);
            const f32x4 a0 = *(const f32x4*)(sc2 + c0), a1 = *(const f32x4*)(sc2 + c0 + 4), b0 = *(const f32x4*)(sh2 + c0), b1 = *(const f32x4*)(sh2 + c0 + 4);
            const f32x4 y0 = x0 * (a0 + 1.0f) + b0, y1 = x1 * (a1 + 1.0f) + b1;
            u32x4 hi; hi.x = cvt_pk_bf16(y0[0], y0[1]); hi.y = cvt_pk_bf16(y0[2], y0[3]); hi.z = cvt_pk_bf16(y1[0], y1[1]); hi.w = cvt_pk_bf16(y1[2], y1[3]);
            u32x4 lo; lo.x = cvt_pk_bf16(y0[0] - bflo(hi.x), y0[1] - bfhi(hi.x)); lo.y = cvt_pk_bf16(y0[2] - bflo(hi.y), y0[3] - bfhi(hi.y));
            lo.z = cvt_pk_bf16(y1[0] - bflo(hi.z), y1[1] - bfhi(hi.z)); lo.w = cvt_pk_bf16(y1[2] - bflo(hi.w), y1[3] - bfhi(hi.w));
            const bf16x8 ah = __builtin_bit_cast(bf16x8, hi), al = __builtin_bit_cast(bf16x8, lo);
#pragma unroll
            for (int t = 0; t < 4; ++t) { const bf16x8 bh = frag_rowk_g(RWh + (size_t)(16 * t) * DM + 32 * ks, DM, lane), bl = frag_rowk_g(RWl + (size_t)(16 * t) * DM + 32 * ks, DM, lane);
                acc[t] = MFMA16(ah, bh, acc[t]); acc[t] = MFMA16(al, bh, acc[t]); acc[t] = MFMA16(ah, bl, acc[t]); } }
        LDS_WAIT(); asm volatile("" ::: "memory");
#pragma unroll
        for (int t = 0; t < 4; ++t)
#pragma unroll
            for (int r = 0; r < 4; ++r) Lg[(4 * kq + r) * 65 + 16 * t + fr] = acc[t][r];
        LDS_WAIT(); asm volatile("" ::: "memory");
        __syncthreads();
        if (kw == 0) { for (int i = lane; i < 16 * 65; i += 64) Lg[i] += (Lg[2048 + i] + Lg[4096 + i]) + Lg[6144 + i]; }
        LDS_WAIT(); asm volatile("" ::: "memory");
        if (kw == 0 && lane < 16) {
            LAS float* sr = Lg + lane * 65; const int trow = rbase + lane;
            float gs[8];
#pragma unroll
            for (int g = 0; g < 8; ++g) { float m1 = -1e30f, m2 = -1e30f;
                for (int j = 0; j < 8; ++j) { const int e = 8 * g + j; const float s = sigmoidf_(sr[e]); sr[e] = s; const float vv = s + rbias[e];
                    if (vv > m1) { m2 = m1; m1 = vv; } else if (vv > m2) m2 = vv; }
                gs[g] = m1 + m2; }
            unsigned gmask = 0u;
#pragma unroll
            for (int it = 0; it < 4; ++it) { float best = -1e30f; int bi = 0;
#pragma unroll
                for (int g = 0; g < 8; ++g) { const bool ok = !((gmask >> g) & 1u) && gs[g] > best; best = ok ? gs[g] : best; bi = ok ? g : bi; }
                gmask |= 1u << bi; }
            unsigned long long taken = 0ull; int sel[8]; float sw[8]; float wsum = 0.f;
#pragma unroll
            for (int k = 0; k < 8; ++k) { float best = -1e30f; int bi = 0;
                for (int e = 0; e < 64; ++e) { const bool cand = ((gmask >> (e >> 3)) & 1u) && !((taken >> e) & 1ull); const float vv = sr[e] + rbias[e];
                    if (cand && vv > best) { best = vv; bi = e; } }
                taken |= 1ull << bi; sel[k] = bi; sw[k] = sr[bi]; wsum += sw[k]; }
            const float inv = 2.5f / wsum;
#pragma unroll
            for (int k = 0; k < 8; ++k) { const int a = trow * 8 + k; const int pos = atomicAdd(&cnt[sel[k]], 1);
                LIST[(size_t)sel[k] * TT + pos] = a; PK[a] = ((unsigned)sel[k] << 16) | (unsigned)pos; LW[a] = sw[k] * inv * 4.0f; }
            LIST[(size_t)64 * TT + (trow - r0)] = 8 * TT + trow;
        }
        __syncthreads();
    }
}
namespace att {
constexpr int D = 128, NW = 8, QBLK = 32, KVBLK = 64;
constexpr float SCALE = 0.088388347648318440f;
constexpr float THR = 8.f;
constexpr int SHM_V = KVBLK * D * 2, SHM_K = KVBLK * D * 2, SHM_ATTN = 2 * SHM_V + 2 * SHM_K + NW * 64 * 4;
#define KSWZ(row, colB) ((row) * 256 + ((colB) ^ (((row) & 7) << 4)))
#define SBAR() __builtin_amdgcn_sched_barrier(0)
__device__ __forceinline__ int crow(int r, int hi) { return (r & 3) + 8 * (r >> 2) + 4 * hi; }
__device__ __forceinline__ unsigned cvtpk(float lo, float hi) { unsigned r; asm volatile("v_cvt_pk_bf16_f32 %0, %1, %2" : "=v"(r) : "v"(lo), "v"(hi)); return r; }

__device__ __forceinline__ void partialSM(f32x16& p0, f32x16& p1, float negMC) {
  constexpr float Cc = SCALE * 1.4426950408889634f;
  for (int r = 0; r < 16; ++r) p0[r] = fmaf(p0[r], Cc, negMC); for (int r = 0; r < 16; ++r) p1[r] = fmaf(p1[r], Cc, negMC);
  for (int r = 0; r < 16; ++r) p0[r] = __builtin_amdgcn_exp2f(p0[r]);
}
__device__ __forceinline__ void finishSM(f32x16& p0, f32x16& p1, float& l_reg, bf16x8& pa0, bf16x8& pa1, bf16x8& pa2, bf16x8& pa3) {
  for (int r = 0; r < 16; ++r) p1[r] = __builtin_amdgcn_exp2f(p1[r]);
  float ps = 0; for (int r = 0; r < 16; ++r) ps += p0[r]; for (int r = 0; r < 16; ++r) ps += p1[r];
  { auto rr = __builtin_amdgcn_permlane32_swap(__float_as_uint(ps), __float_as_uint(ps), false, false);
    ps = __uint_as_float(rr[0]) + __uint_as_float(rr[1]); }
  l_reg += ps;
#define PK4(P, BASE, OUT) do { unsigned a0 = cvtpk(P[BASE + 0], P[BASE + 1]), a1 = cvtpk(P[BASE + 2], P[BASE + 3]);   \
    unsigned b0 = cvtpk(P[BASE + 4], P[BASE + 5]), b1 = cvtpk(P[BASE + 6], P[BASE + 7]);                              \
    auto r0 = __builtin_amdgcn_permlane32_swap(a0, b0, false, false); auto r1 = __builtin_amdgcn_permlane32_swap(a1, b1, false, false); \
    u32x4 w = {r0[0], r1[0], r0[1], r1[1]}; OUT = *reinterpret_cast<bf16x8*>(&w); } while (0)
  PK4(p0, 0, pa0); PK4(p0, 8, pa1); PK4(p1, 0, pa2); PK4(p1, 8, pa3);
#undef PK4
}
__device__ __forceinline__ void qkt(f32x16& p0, f32x16& p1, const LAS char* Ks, const bf16x8* qr, int r32, int hi) {
  p0 = f32x16{}; p1 = f32x16{};
  for (int d0 = 0; d0 < 8; ++d0) { int cb = (d0 * 16 + hi * 8) * 2;
    bf16x8 b0 = *reinterpret_cast<const LAS bf16x8*>(Ks + KSWZ(r32, cb));
    bf16x8 b1 = *reinterpret_cast<const LAS bf16x8*>(Ks + KSWZ(32 + r32, cb));
    p0 = __builtin_amdgcn_mfma_f32_32x32x16_bf16(b0, qr[d0], p0, 0, 0, 0);
    p1 = __builtin_amdgcn_mfma_f32_32x32x16_bf16(b1, qr[d0], p1, 0, 0, 0); }
}
__device__ __forceinline__ int v_st(int k, int c) { const int kk = (k & ~0xC) | ((k & 4) << 1) | ((k & 8) >> 1); return ((kk >> 3) * 4 + (c >> 5)) * 512 + ((kk & 7) * 32 + (c & 31)) * 2; }
__device__ __forceinline__ int v_rd_base(int lane) { return ((lane & 3) << 3) | (((lane >> 2) & 3) << 6) | (((lane >> 4) & 1) << 5) | (((lane >> 5) & 1) << 8); }
constexpr int v_rd_off(int d0, int ks, int half) { return d0 * 512 + ks * 4096 + half * 2048; }
template <int OFF> __device__ __forceinline__ s16x4 tr_read(int vb) {
  s16x4 r; asm volatile("ds_read_b64_tr_b16 %0, %1 offset:%2" : "=&v"(r) : "v"(vb), "i"(OFF) : "memory"); return r;
}
template <int D0> __device__ __forceinline__ void pv_one(f32x16& od, int vb, bf16x8 pa0, bf16x8 pa1, bf16x8 pa2, bf16x8 pa3) {
  const s16x4 l0 = tr_read<v_rd_off(D0, 0, 0)>(vb), h0 = tr_read<v_rd_off(D0, 0, 1)>(vb), l1 = tr_read<v_rd_off(D0, 1, 0)>(vb), h1 = tr_read<v_rd_off(D0, 1, 1)>(vb);
  const s16x4 l2 = tr_read<v_rd_off(D0, 2, 0)>(vb), h2 = tr_read<v_rd_off(D0, 2, 1)>(vb), l3 = tr_read<v_rd_off(D0, 3, 0)>(vb), h3 = tr_read<v_rd_off(D0, 3, 1)>(vb);
  asm volatile("s_waitcnt lgkmcnt(0)" ::: "memory"); SBAR();
#define PK(L, H) (bf16x8){L[0], L[1], L[2], L[3], H[0], H[1], H[2], H[3]}
  od = __builtin_amdgcn_mfma_f32_32x32x16_bf16(pa0, PK(l0, h0), od, 0, 0, 0);
  od = __builtin_amdgcn_mfma_f32_32x32x16_bf16(pa1, PK(l1, h1), od, 0, 0, 0);
  od = __builtin_amdgcn_mfma_f32_32x32x16_bf16(pa2, PK(l2, h2), od, 0, 0, 0);
  od = __builtin_amdgcn_mfma_f32_32x32x16_bf16(pa3, PK(l3, h3), od, 0, 0, 0);
#undef PK
}
__device__ __forceinline__ void pv_d0(f32x16* o, int vb, bf16x8 pa0, bf16x8 pa1, bf16x8 pa2, bf16x8 pa3) {
  pv_one<0>(o[0], vb, pa0, pa1, pa2, pa3); pv_one<1>(o[1], vb, pa0, pa1, pa2, pa3); pv_one<2>(o[2], vb, pa0, pa1, pa2, pa3); pv_one<3>(o[3], vb, pa0, pa1, pa2, pa3);
}

template <int LDQ, int LDK, int LDO>
__device__ __forceinline__ void attn_dense_body(const bf16_t* __restrict__ Qb, const bf16_t* __restrict__ Kh, const bf16_t* __restrict__ Vh, bf16_t* __restrict__ Ob, int seq, LAS char* lds, int tid, float kmax2) {
  const int wid = tid >> 6, lane = tid & 63, r32 = lane & 31, hi = lane >> 5;
  LAS char* V_lds = lds; LAS char* K_lds = lds + 2 * SHM_V;
  LAS float* ws = (LAS float*)(lds + 2 * SHM_V + 2 * SHM_K) + wid * 64; LAS float* li_l = ws;
  float l_reg = 0; f32x16 o[4] = {}; bf16x8 qr[8];
  const bf16_t* Qw = Qb + (long)(wid * QBLK + r32) * LDQ + hi * 8;
#pragma unroll
  for (int d0 = 0; d0 < 8; ++d0) qr[d0] = *reinterpret_cast<const bf16x8*>(Qw + d0 * 16);
  float negMC;
  { float q2 = 0.f;
#pragma unroll
    for (int d0 = 0; d0 < 8; ++d0) { const u32x4 w = __builtin_bit_cast(u32x4, qr[d0]);
      q2 += bflo(w.x) * bflo(w.x) + bfhi(w.x) * bfhi(w.x) + bflo(w.y) * bflo(w.y) + bfhi(w.y) * bfhi(w.y) + bflo(w.z) * bflo(w.z) + bfhi(w.z) * bfhi(w.z) + bflo(w.w) * bflo(w.w) + bfhi(w.w) * bfhi(w.w); }
    auto rr = __builtin_amdgcn_permlane32_swap(__float_as_uint(q2), __float_as_uint(q2), false, false);
    q2 = __uint_as_float(rr[0]) + __uint_as_float(rr[1]);
    negMC = -(sqrtf(q2 * kmax2) * (SCALE * 1.0001f) - 30.0f) * 1.4426950408889634f; }
  const int sr = tid >> 4, sc = (tid & 15) * 8, vst0 = v_st(sr, sc), vst1 = v_st(32 + sr, sc);
  const int vb0 = (int)(uintptr_t)V_lds + v_rd_base(lane);
  struct { bf16x8 vs0, vs1, ks0, ks1; } sr_[2];
#define SLOAD(i, k0) do { sr_[i].vs0 = *reinterpret_cast<const bf16x8*>(&Vh[(long)((k0) + sr) * LDK + sc]); sr_[i].vs1 = *reinterpret_cast<const bf16x8*>(&Vh[(long)((k0) + 32 + sr) * LDK + sc]); \
    sr_[i].ks0 = *reinterpret_cast<const bf16x8*>(&Kh[(long)((k0) + sr) * LDK + sc]); sr_[i].ks1 = *reinterpret_cast<const bf16x8*>(&Kh[(long)((k0) + 32 + sr) * LDK + sc]); } while (0)
#define SWRITE(b, i) do { *(LAS bf16x8*)(V_lds + (b) * SHM_V + vst0) = sr_[i].vs0;          \
    *(LAS bf16x8*)(V_lds + (b) * SHM_V + vst1) = sr_[i].vs1; int kc = sc * 2;               \
    *(LAS bf16x8*)(K_lds + (b) * SHM_K + KSWZ(sr, kc)) = sr_[i].ks0;                       \
    *(LAS bf16x8*)(K_lds + (b) * SHM_K + KSWZ(32 + sr, kc)) = sr_[i].ks1; } while (0)
#define SWAIT() asm volatile("s_waitcnt vmcnt(4)" ::: "memory")
  f32x16 pA0, pA1, pB0, pB1; bf16x8 pa0, pa1, pa2, pa3; const int NT = seq / KVBLK;
  constexpr int SE = 0, SO = 1;
  SLOAD(SE, 0); asm volatile("s_waitcnt vmcnt(0)" ::: "memory"); SWRITE(0, SE); __syncthreads();
  qkt(pA0, pA1, K_lds, qr, r32, hi); partialSM(pA0, pA1, negMC);
  SLOAD(SO, KVBLK); if (2 < NT) SLOAD(SE, 2 * KVBLK);
  SWAIT(); SWRITE(1, SO); __syncthreads();
  for (int j = 1; j + 1 < NT; j += 2) {
    SBAR(); qkt(pB0, pB1, K_lds + SHM_K, qr, r32, hi);
    finishSM(pA0, pA1, l_reg, pa0, pa1, pa2, pa3); SBAR();
    SLOAD(SO, (j + 2) * KVBLK); SBAR();
    pv_d0(o, vb0, pa0, pa1, pa2, pa3); partialSM(pB0, pB1, negMC);
    __syncthreads(); SWAIT(); SWRITE(0, SE);
    __syncthreads();
    SBAR(); qkt(pA0, pA1, K_lds, qr, r32, hi);
    finishSM(pB0, pB1, l_reg, pa0, pa1, pa2, pa3); SBAR();
    if (j + 3 < NT) SLOAD(SE, (j + 3) * KVBLK); SBAR();
    pv_d0(o, vb0 + (int)SHM_V, pa0, pa1, pa2, pa3); partialSM(pA0, pA1, negMC);
    __syncthreads(); SWAIT(); SWRITE(1, SO);
    __syncthreads();
  }
  SBAR(); qkt(pB0, pB1, K_lds + SHM_K, qr, r32, hi);
  finishSM(pA0, pA1, l_reg, pa0, pa1, pa2, pa3); SBAR();
  pv_d0(o, vb0, pa0, pa1, pa2, pa3); partialSM(pB0, pB1, negMC);
  __syncthreads();
  finishSM(pB0, pB1, l_reg, pa0, pa1, pa2, pa3); SBAR();
  pv_d0(o, vb0 + (int)SHM_V, pa0, pa1, pa2, pa3);
  if (hi == 0) li_l[r32] = l_reg; asm volatile("s_waitcnt lgkmcnt(0)" ::: "memory");
  float rli[16];
#pragma unroll
  for (int r = 0; r < 16; ++r) rli[r] = __builtin_amdgcn_rcpf(li_l[crow(r, hi)]);
  bf16_t* Ow = Ob + (long)(wid * QBLK) * LDO;
#pragma unroll
  for (int r = 0; r < 16; ++r) { int orow = crow(r, hi);
    for (int d0 = 0; d0 < 4; ++d0) Ow[(long)orow * LDO + d0 * 32 + r32] = (bf16_t)(cvtpk(o[d0][r] * rli[r], 0.f) & 0xffffu); }
#undef SLOAD
#undef SWRITE
#undef SWAIT
}

typedef int v8i32a __attribute__((ext_vector_type(8)));
typedef int v4i32a __attribute__((ext_vector_type(4)));
#define KSW8(row, chunk) ((row) * 128 + ((((chunk) ^ (((row) >> 1) & 7))) << 4))
#define VSW8(d, chunk) ((d) * 64 + ((((chunk) ^ (((d) >> 2) & 3))) << 4))
#define MFMA8(a, b, c) __builtin_amdgcn_mfma_scale_f32_32x32x64_f8f6f4((a), (b), (c), 0, 0, 0, 0, 0, 0)
__device__ __forceinline__ v8i32a ld32_l(const LAS char* p0, const LAS char* p1) { return __builtin_shufflevector(*(const LAS v4i32a*)p0, *(const LAS v4i32a*)p1, 0, 1, 2, 3, 4, 5, 6, 7); }
__device__ __forceinline__ unsigned pk4f8(float a, float b, float c, float d) { unsigned w = (unsigned)__builtin_amdgcn_cvt_pk_fp8_f32(a, b, 0, false); return (unsigned)__builtin_amdgcn_cvt_pk_fp8_f32(c, d, (int)w, true); }
template <int LDO, int KSTR>
__device__ __forceinline__ void attn_dense8_body(const unsigned char* __restrict__ Q8b, const unsigned char* __restrict__ K8h, const unsigned char* __restrict__ VT8h, bf16_t* __restrict__ Ob, int seq, LAS char* lds, int tid, float kmax2) {
  const int wid = tid >> 6, lane = tid & 63, r32 = lane & 31, hi = lane >> 5;
  constexpr int RS = 6, PD = 4;
  LAS float* al_l = (LAS float*)(lds + RS * 16384) + wid * 32;
  f32x16 o[4] = {}; v8i32a qf[2];
  { const unsigned char* qp = Q8b + (size_t)(wid * QBLK + r32) * 1024 + 32 * hi;
    qf[0] = __builtin_shufflevector(*(const v4i32a*)qp, *(const v4i32a*)(qp + 16), 0, 1, 2, 3, 4, 5, 6, 7);
    qf[1] = __builtin_shufflevector(*(const v4i32a*)(qp + 64), *(const v4i32a*)(qp + 80), 0, 1, 2, 3, 4, 5, 6, 7); }
  (void)kmax2;
  constexpr float THR8 = 1.4426950408889634f;
  float m_reg = 0.f; f32x16 osum = {}; v8i32a ones = {0x38383838, 0x38383838, 0x38383838, 0x38383838, 0x38383838, 0x38383838, 0x38383838, 0x38383838}; asm volatile("" : "+v"(ones));
#define PSM8(P0, P1, DL, CN, FIRST) do { float pmax = P0[0]; for (int r = 1; r < 16; ++r) pmax = fmaxf(pmax, P0[r]); for (int r = 0; r < 16; ++r) pmax = fmaxf(pmax, P1[r]); \
      { auto rr = __builtin_amdgcn_permlane32_swap(__float_as_uint(pmax), __float_as_uint(pmax), false, false); pmax = fmaxf(__uint_as_float(rr[0]), __uint_as_float(rr[1])); } \
      const float mn = (FIRST) ? pmax : ((pmax - m_reg > THR8) ? pmax : m_reg); DL = (FIRST) ? 0.f : mn - m_reg; m_reg = mn; CN = 7.0f - mn; \
      for (int r = 0; r < 16; ++r) P0[r] = __builtin_amdgcn_exp2f(P0[r] + CN); } while (0)
#define RESC8(DL) do { if (__any((DL) > 0.f)) { if (hi == 0) al_l[r32] = __builtin_amdgcn_exp2f(-(DL)); asm volatile("s_waitcnt lgkmcnt(0)" ::: "memory"); \
      for (int d = 0; d < 4; ++d) for (int r = 0; r < 16; ++r) o[d][r] *= al_l[crow(r, hi)]; for (int r = 0; r < 16; ++r) osum[r] *= al_l[crow(r, hi)]; } } while (0)
  const unsigned kgo = (unsigned)((tid >> 3) * KSTR + 16 * ((tid & 7) ^ ((tid >> 4) & 7))), vgo = (unsigned)((tid >> 2) * 64 + 16 * ((tid & 3) ^ ((tid >> 4) & 3)));
  const unsigned ldw = (unsigned)wid * 1024u;
#define DMA8(slot, T_) do { __builtin_amdgcn_global_load_lds((const unsigned*)(K8h + (size_t)(T_) * (64 * KSTR) + kgo), (LAS unsigned*)(lds + (slot) * 16384 + ldw), 16, 0, 0); \
      __builtin_amdgcn_global_load_lds((const unsigned*)(VT8h + (size_t)(T_) * 8192 + vgo), (LAS unsigned*)(lds + (slot) * 16384 + 8192 + ldw), 16, 0, 0); } while (0)
#define DWAIT8() do { asm volatile("s_waitcnt vmcnt(6)\n\ts_waitcnt lgkmcnt(0)" ::: "memory"); __builtin_amdgcn_s_barrier(); asm volatile("" ::: "memory"); } while (0)
#define QK8(P0, P1, KB) do { P0 = f32x16{}; P1 = f32x16{}; _Pragma("unroll") for (int s = 0; s < 2; ++s) { \
      const v8i32a k0 = ld32_l((KB) + KSW8(r32, 4 * s + 2 * hi), (KB) + KSW8(r32, 4 * s + 2 * hi + 1)); \
      const v8i32a k1 = ld32_l((KB) + KSW8(32 + r32, 4 * s + 2 * hi), (KB) + KSW8(32 + r32, 4 * s + 2 * hi + 1)); \
      P0 = MFMA8(k0, qf[s], P0); P1 = MFMA8(k1, qf[s], P1); } } while (0)
#define FIN8(P0, P1, CN) do { for (int r = 0; r < 16; ++r) P1[r] = __builtin_amdgcn_exp2f(P1[r] + CN); \
      _Pragma("unroll") for (int i = 0; i < 4; ++i) { pa[i] = (int)pk4f8(P0[4 * i], P0[4 * i + 1], P0[4 * i + 2], P0[4 * i + 3]); pa[4 + i] = (int)pk4f8(P1[4 * i], P1[4 * i + 1], P1[4 * i + 2], P1[4 * i + 3]); } } while (0)
#define PV8(VB) do { _Pragma("unroll") for (int d0 = 0; d0 < 4; ++d0) { \
      const v8i32a vf = ld32_l((VB) + VSW8(32 * d0 + r32, 2 * hi), (VB) + VSW8(32 * d0 + r32, 2 * hi + 1)); \
      o[d0] = MFMA8(pa, vf, o[d0]); } osum = MFMA8(pa, ones, osum); } while (0)
#define LDK8(KB, s, half) ld32_l((KB) + KSW8(32 * (half) + r32, 4 * (s) + 2 * hi), (KB) + KSW8(32 * (half) + r32, 4 * (s) + 2 * hi + 1))
#define LDV8(VB, d0) ld32_l((VB) + VSW8(32 * (d0) + r32, 2 * hi), (VB) + VSW8(32 * (d0) + r32, 2 * hi + 1))
#define EXPN(P, r0, n, CN) do { _Pragma("unroll") for (int r = (r0); r < (r0) + (n); ++r) { float e_ = __builtin_amdgcn_exp2f(P[r] + (CN)); asm volatile("" : "+v"(e_)); P[r] = e_; } } while (0)
#define FINP(P0, P1, CN, i) do { EXPN(P1, 4 * (i), 4, CN); \
      { unsigned w_ = (unsigned)__builtin_amdgcn_cvt_pk_fp8_f32(P0[4 * (i)], P0[4 * (i) + 1], pa[i], false); pa[i] = __builtin_amdgcn_cvt_pk_fp8_f32(P0[4 * (i) + 2], P0[4 * (i) + 3], (int)w_, true); } \
      { unsigned w_ = (unsigned)__builtin_amdgcn_cvt_pk_fp8_f32(P1[4 * (i)], P1[4 * (i) + 1], pa[4 + (i)], false); pa[4 + (i)] = __builtin_amdgcn_cvt_pk_fp8_f32(P1[4 * (i) + 2], P1[4 * (i) + 3], (int)w_, true); } } while (0)
#define PINA(x, y) asm volatile("" : "+v"(x), "+v"(y))
#define PIN1(x) asm volatile("" : "+v"(x))
#define PINC(x, y) asm volatile("" :: "v"(x), "v"(y))
#define HSTEP(X0, X1, DLX, CNX, Y0, Y1, CNY, KB, VB, STAGE_LOAD) do { \
      v8i32a ka_ = LDK8(KB, 0, 0), kb_ = LDK8(KB, 0, 1), kc_ = LDK8(KB, 1, 0), kd_ = LDK8(KB, 1, 1); \
      X0 = MFMA8(ka_, qf[0], f32x16{}); PINA(X0, kb_); \
      FINP(Y0, Y1, CNY, 0); PINC(pa[0], pa[4]); PIN1(kb_); \
      X1 = MFMA8(kb_, qf[0], f32x16{}); PINA(X1, kc_); \
      FINP(Y0, Y1, CNY, 1); PINC(pa[1], pa[5]); PIN1(kc_); \
      X0 = MFMA8(kc_, qf[1], X0); PINA(X0, kd_); \
      v8i32a v0_ = LDV8(VB, 0), v1_ = LDV8(VB, 1); \
      FINP(Y0, Y1, CNY, 2); STAGE_LOAD; PINC(pa[2], pa[6]); PIN1(kd_); \
      X1 = MFMA8(kd_, qf[1], X1); PINA(X1, v0_); \
      v8i32a v2_ = LDV8(VB, 2), v3_ = LDV8(VB, 3); \
      FINP(Y0, Y1, CNY, 3); PINC(pa[3], pa[7]); PINA(pa, v0_); \
      o[0] = MFMA8(pa, v0_, o[0]); PINA(o[0], v1_); \
      float pm0_ = X0[0]; _Pragma("unroll") for (int r = 1; r < 16; ++r) pm0_ = fmaxf(pm0_, X0[r]); PINA(pm0_, v1_); \
      o[1] = MFMA8(pa, v1_, o[1]); PINA(o[1], v2_); \
      _Pragma("unroll") for (int r = 0; r < 16; ++r) pm0_ = fmaxf(pm0_, X1[r]); \
      { auto rr = __builtin_amdgcn_permlane32_swap(__float_as_uint(pm0_), __float_as_uint(pm0_), false, false); pm0_ = fmaxf(__uint_as_float(rr[0]), __uint_as_float(rr[1])); } \
      { const float mn = (pm0_ - m_reg > THR8) ? pm0_ : m_reg; DLX = mn - m_reg; m_reg = mn; CNX = 7.0f - mn; } PINA(CNX, v2_); \
      o[2] = MFMA8(pa, v2_, o[2]); PINA(o[2], v3_); \
      EXPN(X0, 0, 5, CNX); PIN1(v3_); \
      o[3] = MFMA8(pa, v3_, o[3]); PINA(o[3], CNX); \
      EXPN(X0, 5, 5, CNX); PIN1(pa); \
      osum = MFMA8(pa, ones, osum); PINA(osum, CNX); \
      EXPN(X0, 10, 6, CNX); } while (0)
  f32x16 pA0, pA1, pB0, pB1; v8i32a pa = {}; float dlA, dlB, cnA, cnB; const int NT = seq / KVBLK;
#define SLOT(s) (lds + (s) * 16384)
#define SADV() do { sv = sk; sk = sk + 1 == RS ? 0 : sk + 1; sd = sd + 1 == RS ? 0 : sd + 1; } while (0)
  int sk = 0, sv = 0, sd = PD;
  DMA8(0, 0); DMA8(1, 1); DMA8(2, 2); DMA8(3, 3);
  DWAIT8();
  QK8(pA0, pA1, SLOT(0)); PSM8(pA0, pA1, dlA, cnA, true);
  DMA8(sd, PD); SADV(); DWAIT8();
  for (int j = 1; j + 1 < NT; j += 2) {
    HSTEP(pB0, pB1, dlB, cnB, pA0, pA1, cnA, SLOT(sk), SLOT(sv) + 8192, DMA8(sd, min(j + PD, NT - 1)));
    RESC8(dlB); SADV(); DWAIT8();
    HSTEP(pA0, pA1, dlA, cnA, pB0, pB1, cnB, SLOT(sk), SLOT(sv) + 8192, DMA8(sd, min(j + 1 + PD, NT - 1)));
    RESC8(dlA); SADV(); DWAIT8();
  }
  HSTEP(pB0, pB1, dlB, cnB, pA0, pA1, cnA, SLOT(sk), SLOT(sv) + 8192, (void)0);
  RESC8(dlB); SADV();
  FIN8(pB0, pB1, cnB); SBAR();
  PV8(SLOT(sv) + 8192);
  asm volatile("s_waitcnt vmcnt(0)" ::: "memory");
  float rli[16];
#pragma unroll
  for (int r = 0; r < 16; ++r) rli[r] = __builtin_amdgcn_rcpf(osum[r]);
  bf16_t* Ow = Ob + (long)(wid * QBLK) * LDO;
#pragma unroll
  for (int r = 0; r < 16; ++r) { int orow = crow(r, hi);
    for (int d0 = 0; d0 < 4; ++d0) Ow[(long)orow * LDO + d0 * 32 + r32] = (bf16_t)(cvtpk(o[d0][r] * rli[r], 0.f) & 0xffffu); }
#undef PSM8
#undef RESC8
#undef DMA8
#undef DWAIT8
#undef SLOT
#undef SADV
#undef QK8
#undef FIN8
#undef PV8
#undef HSTEP
#undef PINA
#undef PIN1
#undef PINC
#undef FINP
#undef EXPN
#undef LDK8
#undef LDV8
}

template <int LDO, int KSTR>
__device__ __forceinline__ void attn_dense8w_body(const unsigned char* __restrict__ Q8b, const unsigned char* __restrict__ K8h, const unsigned char* __restrict__ VT8h0, const unsigned char* __restrict__ VT8h1, bf16_t* __restrict__ Ob, int seq, LAS char* lds, int tid, float kmax2) {
  const int wid = tid >> 6, lane = tid & 63, r32 = lane & 31, hi = lane >> 5;
  constexpr int RS = 4, PD = 2, SB = 24576;
  LAS float* al_l = (LAS float*)(lds + RS * SB) + wid * 32;
  LAS char* q_l = lds + RS * SB + 2048 + wid * 4096 + lane * 16;
  { const unsigned char* qp = Q8b + (size_t)(wid * QBLK + r32) * 1024 + 32 * hi;
    *(LAS v4i32a*)(q_l) = *(const v4i32a*)qp; *(LAS v4i32a*)(q_l + 1024) = *(const v4i32a*)(qp + 16);
    *(LAS v4i32a*)(q_l + 2048) = *(const v4i32a*)(qp + 64); *(LAS v4i32a*)(q_l + 3072) = *(const v4i32a*)(qp + 80); }
  (void)kmax2;
  constexpr float THR8 = 1.4426950408889634f;
  float l_reg = 0.f, m_reg = 0.f; f32x16 o[8] = {};
  const unsigned kgo = (unsigned)((tid >> 3) * KSTR + 16 * ((tid & 7) ^ ((tid >> 4) & 7))), vgo = (unsigned)((tid >> 2) * 64 + 16 * ((tid & 3) ^ ((tid >> 4) & 3)));
  const unsigned ldw = (unsigned)wid * 1024u;
#define DMA8(slot, T_) do { __builtin_amdgcn_global_load_lds((const unsigned*)(K8h + (size_t)(T_) * (64 * KSTR) + kgo), (LAS unsigned*)(lds + (slot) * SB + ldw), 16, 0, 0); \
      __builtin_amdgcn_global_load_lds((const unsigned*)(VT8h0 + (size_t)(T_) * 8192 + vgo), (LAS unsigned*)(lds + (slot) * SB + 8192 + ldw), 16, 0, 0); \
      __builtin_amdgcn_global_load_lds((const unsigned*)(VT8h1 + (size_t)(T_) * 8192 + vgo), (LAS unsigned*)(lds + (slot) * SB + 16384 + ldw), 16, 0, 0); } while (0)
#define DWAIT8() do { asm volatile("s_waitcnt vmcnt(3)\n\ts_waitcnt lgkmcnt(0)" ::: "memory"); __builtin_amdgcn_s_barrier(); asm volatile("" ::: "memory"); } while (0)
#define SLOT(s) (lds + (s) * SB)
#define SADV() do { sv = sk; sk = sk + 1 == RS ? 0 : sk + 1; sd = sd + 1 == RS ? 0 : sd + 1; } while (0)
#define LDK8(KB, s, half) ld32_l((KB) + KSW8(32 * (half) + r32, 4 * (s) + 2 * hi), (KB) + KSW8(32 * (half) + r32, 4 * (s) + 2 * hi + 1))
#define LDV8(VB, d0) ld32_l((VB) + VSW8(32 * (d0) + r32, 2 * hi), (VB) + VSW8(32 * (d0) + r32, 2 * hi + 1))
#define PIN1(x) asm volatile("" : "+v"(x))
#define EXPR(e0, n) do { _Pragma("unroll") for (int e = (e0); e < (e0) + (n); ++e) { float x_ = e < 16 ? X0[e & 15] : X1[e & 15]; float e_ = __builtin_amdgcn_exp2f(x_ + cn); asm volatile("" : "+v"(e_)); ps += e_; \
      if (e < 16) X0[e & 15] = e_; else X1[e & 15] = e_; } } while (0)
#define PKW(PAC, w) do { if ((w) < 4) { unsigned w_ = (unsigned)__builtin_amdgcn_cvt_pk_fp8_f32(X0[4 * ((w) & 3)], X0[4 * ((w) & 3) + 1], PAC[w], false); PAC[w] = __builtin_amdgcn_cvt_pk_fp8_f32(X0[4 * ((w) & 3) + 2], X0[4 * ((w) & 3) + 3], (int)w_, true); } \
      else { unsigned w_ = (unsigned)__builtin_amdgcn_cvt_pk_fp8_f32(X1[4 * ((w) & 3)], X1[4 * ((w) & 3) + 1], PAC[w], false); PAC[w] = __builtin_amdgcn_cvt_pk_fp8_f32(X1[4 * ((w) & 3) + 2], X1[4 * ((w) & 3) + 3], (int)w_, true); } } while (0)
#define PVM(PAP, g) do { PIN1(vv##g); o[4 * ((g) & 1) + ((g) >> 1)] = MFMA8(PAP, vv##g, o[4 * ((g) & 1) + ((g) >> 1)]); asm volatile("" :: "v"(o[4 * ((g) & 1) + ((g) >> 1)])); } while (0)
#define LDVG(g) ({ int o_ = sv * SB + 8192 + 8192 * ((g) & 1); asm volatile("" : "+s"(o_)); LDV8(lds + o_, (g) >> 1); })
#define WSTEP(PAP, PAC, FIRST, TNEXT) do { \
      { const v8i32a ka_ = LDK8(SLOT(sk), 0, 0), kb_ = LDK8(SLOT(sk), 0, 1), kc_ = LDK8(SLOT(sk), 1, 0), kd_ = LDK8(SLOT(sk), 1, 1); \
        const v8i32a q0_ = ld32_l(q_l, q_l + 1024), q1_ = ld32_l(q_l + 2048, q_l + 3072); \
        X0 = MFMA8(ka_, q0_, f32x16{}); X1 = MFMA8(kb_, q0_, f32x16{}); X0 = MFMA8(kc_, q1_, X0); X1 = MFMA8(kd_, q1_, X1); PIN1(X1); } \
      DMA8(sd, TNEXT); \
      v8i32a vv0 = LDVG(0), vv1 = LDVG(1); \
      PVM(PAP, 0); v8i32a vv2 = LDVG(2); \
      float pm_ = X0[0]; _Pragma("unroll") for (int r = 1; r < 16; ++r) pm_ = fmaxf(pm_, X0[r]); PIN1(pm_); \
      PVM(PAP, 1); v8i32a vv3 = LDVG(3); \
      _Pragma("unroll") for (int r = 0; r < 16; ++r) pm_ = fmaxf(pm_, X1[r]); \
      { auto rr = __builtin_amdgcn_permlane32_swap(__float_as_uint(pm_), __float_as_uint(pm_), false, false); pm_ = fmaxf(__uint_as_float(rr[0]), __uint_as_float(rr[1])); } \
      const float mn_ = (FIRST) ? pm_ : ((pm_ - m_reg > THR8) ? pm_ : m_reg); const float dl_ = (FIRST) ? 0.f : mn_ - m_reg; m_reg = mn_; float cn = 7.0f - mn_; float ps = 0.f; PIN1(cn); \
      PVM(PAP, 2); v8i32a vv4 = LDVG(4); EXPR(0, 6); PKW(PAC, 0); \
      PVM(PAP, 3); v8i32a vv5 = LDVG(5); EXPR(6, 6); PKW(PAC, 1); PKW(PAC, 2); \
      PVM(PAP, 4); v8i32a vv6 = LDVG(6); EXPR(12, 5); PKW(PAC, 3); \
      PVM(PAP, 5); v8i32a vv7 = LDVG(7); EXPR(17, 5); PKW(PAC, 4); \
      PVM(PAP, 6); EXPR(22, 5); PKW(PAC, 5); \
      PVM(PAP, 7); EXPR(27, 5); PKW(PAC, 6); PKW(PAC, 7); \
      { auto rr = __builtin_amdgcn_permlane32_swap(__float_as_uint(ps), __float_as_uint(ps), false, false); ps = __uint_as_float(rr[0]) + __uint_as_float(rr[1]); } \
      if (__any(dl_ > 0.f)) { const float al_ = __builtin_amdgcn_exp2f(-dl_); l_reg *= al_; if (hi == 0) al_l[r32] = al_; asm volatile("s_waitcnt lgkmcnt(0)" ::: "memory"); \
        for (int d = 0; d < 8; ++d) for (int r = 0; r < 16; ++r) o[d][r] *= al_l[crow(r, hi)]; } \
      l_reg += ps; \
      SADV(); DWAIT8(); } while (0)
  f32x16 X0, X1; v8i32a paA = {}, paB = {}; const int NT = seq / KVBLK;
  int sk = 0, sv = 0, sd = PD;
  DMA8(0, 0); DMA8(1, 1);
  DWAIT8();
  for (int j = 0; j < NT; j += 2) {
    WSTEP(paB, paA, j == 0, min(j + PD, NT - 1));
    WSTEP(paA, paB, false, min(j + 1 + PD, NT - 1));
  }
  { v8i32a vv0 = LDVG(0), vv1 = LDVG(1), vv2 = LDVG(2), vv3 = LDVG(3); PVM(paB, 0); PVM(paB, 1); PVM(paB, 2); PVM(paB, 3); }
  { v8i32a vv4 = LDVG(4), vv5 = LDVG(5), vv6 = LDVG(6), vv7 = LDVG(7); PVM(paB, 4); PVM(paB, 5); PVM(paB, 6); PVM(paB, 7); }
  asm volatile("s_waitcnt vmcnt(0)" ::: "memory");
  int te = tid; asm volatile("" : "+v"(te));
  const int wid_e = te >> 6, r32_e = te & 31, hi_e = (te >> 5) & 1;
  LAS float* li_e = (LAS float*)(lds + RS * SB + 1024) + wid_e * 32;
  if (hi_e == 0) li_e[r32_e] = l_reg; asm volatile("s_waitcnt lgkmcnt(0)" ::: "memory");
  float rli[16];
#pragma unroll
  for (int r = 0; r < 16; ++r) rli[r] = __builtin_amdgcn_rcpf(li_e[crow(r, hi_e)]);
  bf16_t* Ow = Ob + (long)(wid_e * QBLK) * LDO;
#pragma unroll
  for (int r = 0; r < 16; ++r) { int orow = crow(r, hi_e);
    for (int d0 = 0; d0 < 8; ++d0) Ow[(long)orow * LDO + d0 * 32 + r32_e] = (bf16_t)(cvtpk(o[d0][r] * rli[r], 0.f) & 0xffffu); }
#undef DMA8
#undef DWAIT8
#undef SLOT
#undef SADV
#undef LDK8
#undef LDV8
#undef PIN1
#undef EXPR
#undef PKW
#undef PVM
#undef LDVG
#undef WSTEP
}

constexpr int PV_BUF = 32768, PK_BUF = 16384, P_LDS_V = 0, P_LDS_K = 2 * PV_BUF, P_LDS_X = P_LDS_K + 2 * PK_BUF, P_LDS_L = P_LDS_X + 8 * 2048, P_LDS_END = P_LDS_L + 1024;
__device__ __forceinline__ void qkt_half(f32x16& p, const LAS char* Ks, const bf16x8* qr, int krow, int hi) {
  p = f32x16{};
  for (int d0 = 0; d0 < 8; ++d0) { int cb = (d0 * 16 + hi * 8) * 2;
    bf16x8 b0 = *reinterpret_cast<const LAS bf16x8*>(Ks + KSWZ(krow, cb));
    p = __builtin_amdgcn_mfma_f32_32x32x16_bf16(b0, qr[d0], p, 0, 0, 0); }
}
__device__ __forceinline__ void smA(f32x16& p, float negMC) {
  constexpr float Cc = SCALE * 1.4426950408889634f;
  for (int r = 0; r < 16; ++r) p[r] = fmaf(p[r], Cc, negMC);
  for (int r = 0; r < 8; ++r) p[r] = __builtin_amdgcn_exp2f(p[r]);
}
__device__ __forceinline__ void smB(f32x16& p, float& l_reg, bf16x8& f0, bf16x8& f1) {
  for (int r = 8; r < 16; ++r) p[r] = __builtin_amdgcn_exp2f(p[r]);
  float ps = 0; for (int r = 0; r < 16; ++r) ps += p[r];
  { auto rr = __builtin_amdgcn_permlane32_swap(__float_as_uint(ps), __float_as_uint(ps), false, false);
    ps = __uint_as_float(rr[0]) + __uint_as_float(rr[1]); }
  l_reg += ps;
#define PK4(P, BASE, OUT) do { unsigned a0 = cvtpk(P[BASE + 0], P[BASE + 1]), a1 = cvtpk(P[BASE + 2], P[BASE + 3]);   \
    unsigned b0 = cvtpk(P[BASE + 4], P[BASE + 5]), b1 = cvtpk(P[BASE + 6], P[BASE + 7]);                              \
    auto r0 = __builtin_amdgcn_permlane32_swap(a0, b0, false, false); auto r1 = __builtin_amdgcn_permlane32_swap(a1, b1, false, false); \
    u32x4 w = {r0[0], r1[0], r0[1], r1[1]}; OUT = *reinterpret_cast<bf16x8*>(&w); } while (0)
  PK4(p, 0, f0); PK4(p, 8, f1);
#undef PK4
}
template <int LDQ, int LDK, int LDO>
__device__ __forceinline__ void attn_pair_body(const bf16_t* __restrict__ Qb, const bf16_t* __restrict__ Kh, const bf16_t* __restrict__ Vh, bf16_t* __restrict__ Ob, int seq, LAS char* lds, int tid, float kmax2) {
  const int wid = __builtin_amdgcn_readfirstlane(tid >> 6), lane = tid & 63, r32 = lane & 31, hi = lane >> 5, g = wid & 3, kb = wid >> 2;
  LAS char* V_lds = lds + P_LDS_V; LAS char* K_lds = lds + P_LDS_K;
  LAS char* xp_own = lds + P_LDS_X + wid * 2048 + lane * 16; LAS char* xp_par = lds + P_LDS_X + (wid ^ 4) * 2048 + lane * 16;
  LAS float* li = (LAS float*)(lds + P_LDS_L);
  float l_reg = 0; f32x16 o[4] = {}; bf16x8 qr[8];
  const bf16_t* Qw = Qb + (long)(g * QBLK + r32) * LDQ + hi * 8;
#pragma unroll
  for (int d0 = 0; d0 < 8; ++d0) qr[d0] = *reinterpret_cast<const bf16x8*>(Qw + d0 * 16);
  float negMC;
  { float q2 = 0.f;
#pragma unroll
    for (int d0 = 0; d0 < 8; ++d0) { const u32x4 w = __builtin_bit_cast(u32x4, qr[d0]);
      q2 += bflo(w.x) * bflo(w.x) + bfhi(w.x) * bfhi(w.x) + bflo(w.y) * bflo(w.y) + bfhi(w.y) * bfhi(w.y) + bflo(w.z) * bflo(w.z) + bfhi(w.z) * bfhi(w.z) + bflo(w.w) * bflo(w.w) + bfhi(w.w) * bfhi(w.w); }
    auto rr = __builtin_amdgcn_permlane32_swap(__float_as_uint(q2), __float_as_uint(q2), false, false);
    q2 = __uint_as_float(rr[0]) + __uint_as_float(rr[1]);
    negMC = -(sqrtf(q2 * kmax2) * (SCALE * 1.0001f) - 30.0f) * 1.4426950408889634f; }
  const int sr = tid >> 4, sc = (tid & 15) * 8, vst0 = v_st(sr, sc), vst1 = v_st(32 + sr, sc);
  const int vrd = (int)(uintptr_t)V_lds + kb * 16384 + v_rd_base(lane);
  const int krow = 32 * kb + r32;
  struct { bf16x8 v00, v01, v10, v11, k0, k1; } st_;
#define PLD16(base, off) (*reinterpret_cast<const bf16x8*>((const char*)(base) + (off)))
#define PLOAD(k0_) do { const unsigned o_ = (unsigned)(((k0_) + sr) * LDK + sc) * 2u; \
    st_.v00 = PLD16(Vh, o_); st_.v01 = PLD16(Vh, o_ + 256u); st_.v10 = PLD16(Vh, o_ + 64u * LDK); st_.v11 = PLD16(Vh, o_ + 64u * LDK + 256u); \
    st_.k0 = PLD16(Kh, o_); st_.k1 = PLD16(Kh, o_ + 64u * LDK); } while (0)
#define PWRITE(kbuf, vbuf) do { LAS char* vb_ = V_lds + (vbuf) * PV_BUF; LAS char* kb_ = K_lds + (kbuf) * PK_BUF; const int kc = sc * 2; \
    *(LAS bf16x8*)(vb_ + vst0) = st_.v00; *(LAS bf16x8*)(vb_ + 16384 + vst0) = st_.v01; *(LAS bf16x8*)(vb_ + vst1) = st_.v10; *(LAS bf16x8*)(vb_ + 16384 + vst1) = st_.v11; \
    *(LAS bf16x8*)(kb_ + KSWZ(sr, kc)) = st_.k0; *(LAS bf16x8*)(kb_ + KSWZ(32 + sr, kc)) = st_.k1; } while (0)
  const int NT = seq / KVBLK;
  f32x16 pS; bf16x8 f0, f1, g0, g1;
  PLOAD(0); asm volatile("s_waitcnt vmcnt(0)" ::: "memory"); PWRITE(0, 0); PLOAD(KVBLK);
  __syncthreads();
  for (int j = 0; j < NT; ++j) {
    SBAR();
    qkt_half(pS, K_lds + (j & 1) * PK_BUF, qr, krow, hi);
    smA(pS, negMC); smB(pS, l_reg, f0, f1); SBAR();
    *(LAS bf16x8*)(xp_own) = f0; *(LAS bf16x8*)(xp_own + 1024) = f1;
    if (j + 1 < NT) PWRITE((j + 1) & 1, (j + 1) & 1);
    if (j + 2 < NT) PLOAD((j + 2) * KVBLK);
    __syncthreads();
    g0 = *(const LAS bf16x8*)(xp_par); g1 = *(const LAS bf16x8*)(xp_par + 1024);
    { const int vb = vrd + (j & 1) * PV_BUF;
      if (kb == 0) pv_d0(o, vb, f0, f1, g0, g1); else pv_d0(o, vb, g0, g1, f0, f1); }
    __syncthreads();
  }
  if (hi == 0) li[wid * 32 + r32] = l_reg;
  __syncthreads();
#pragma unroll
  for (int r = 0; r < 16; ++r) { const int orow = crow(r, hi); const float rl = __builtin_amdgcn_rcpf(li[wid * 32 + orow] + li[(wid ^ 4) * 32 + orow]);
    bf16_t* op = Ob + (long)(g * QBLK + orow) * LDO + 128 * kb + r32;
    for (int d0 = 0; d0 < 4; ++d0) op[d0 * 32] = (bf16_t)(cvtpk(o[d0][r] * rl, 0.f) & 0xffffu); }
#undef PLD16
#undef PLOAD
#undef PWRITE
}
#undef KSWZ
}

__device__ __forceinline__ void phase_attention(const Params& p, Ctx& C) {
    bf16_t* ATT = (bf16_t*)(p.ws + WS_BIG + BG_ATT);
    const unsigned char* Q8 = (const unsigned char*)(p.ws + WS_BIG + BG_Q8); const unsigned char* K8 = (const unsigned char*)(p.ws + WS_BIG + BG_K8); const unsigned char* VT8 = (const unsigned char*)(p.ws + WS_BIG + BG_VT8);
    const unsigned char* Q8D = (const unsigned char*)(p.ws + WS_BIG + BG_Q8D); const unsigned char* K8D = (const unsigned char*)(p.ws + WS_BIG + BG_K8D); const unsigned char* VT8D = (const unsigned char*)(p.ws + WS_BIG + BG_VT8D);
    for (int i = 0;; ++i) {
        int unit;
        if (C.G == 256) { if (i >= 2) break; unit = (C.bid & 7) * 64 + i * 32 + (C.bid >> 3); } else { unit = i * C.G + C.bid; if (unit >= 512) break; }
        const int d = unit >> 6, qb = unit & 63, hh = d >> 1, m = d & 1;
        __syncthreads();
        int tz = C.tid; asm volatile("" : "+v"(tz));
        att::attn_dense8w_body<3072, 1024>(Q8D + (size_t)(CTXL + 256 * qb) * 1024 + 128 * d, K8D + 128 * d, VT8D + (size_t)(2 * hh) * 260 * 8192, VT8D + (size_t)(2 * hh + 1) * 260 * 8192,
                                           ATT + (size_t)(256 * qb) * 3072 + 1024 + 1024 * m + 256 * hh, TT, (LAS char*)C.lds, tz, 0.f);
    }
    for (int i = 0;; ++i) {
        int unit;
        if (C.G == 256) { if (i >= 2) break; unit = (C.bid & 7) * 64 + i * 32 + (C.bid >> 3); } else { unit = i * C.G + C.bid; if (unit >= 512) break; }
        const int prob = unit >> 6, qb = unit & 63;
        __syncthreads();
        int tz = C.tid; asm volatile("" : "+v"(tz));
        att::attn_dense8_body<3072, 256>(Q8 + (size_t)(CTXL + 256 * qb) * 1024 + 128 * prob, K8 + 128 * (prob >> 2), VT8 + (size_t)(prob >> 2) * 260 * 8192,
                                         ATT + (size_t)(256 * qb) * 3072 + 128 * prob, TT, (LAS char*)C.lds, tz, 0.f);
    }
    __syncthreads();
}
constexpr int PH_PER_LAYER = 13, N_PHASES = 2 + 2 * PH_PER_LAYER;
#ifndef DBL_PHASE
#define DBL_PHASE -1
#endif
#ifndef MK_PER_PHASE
#define MK_PER_PHASE 0
#endif

template <int L>
__device__ __forceinline__ void layer_body(const Params& p, Ctx& C0, const XcdBarrier& bar, LAS unsigned char* misc, int lo, int hi) {
#define IN(k) (lo <= (k) && (k) < hi)
#define SEAM(k) do { if (IN(k) && IN((k) + 1)) xcd_barrier(bar, C0.wave); } while (0)
#define PHASE(k, ...) if (DBL_PHASE == (k)) { int nrep_ = 2; asm volatile("" : "+s"(nrep_)); for (int rep_ = 0; rep_ < nrep_; ++rep_) { if (rep_) xcd_barrier(bar, C0.wave); FRESH(); __VA_ARGS__ } } else if (IN(k)) { FRESH(); __VA_ARGS__ } SEAM(k);
#define FRESH() Ctx C = C0; { int ln = (int)__builtin_amdgcn_mbcnt_hi(~0u, __builtin_amdgcn_mbcnt_lo(~0u, 0u)); asm volatile("" : "+v"(ln)); C.lane = ln; C.tid = C.wave * 64 + ln; }
        const int b = 2 + PH_PER_LAYER * L;
        bf16_t* QKV = (bf16_t*)(p.ws + WS_BIG + BG_QKV);
        bf16_t* XA = (bf16_t*)(p.ws + WS_XA);
        int* cnt = (int*)(p.ws + WS_CTL) + CW_CNT + L * 128; const int* LIST = (const int*)(p.ws + WS_LIST);
        if (L == 0) { PHASE(b + 0, phase_modulate(p, C, L); ) }
        PHASE(b + 1,
            const int N = L ? OD_IN : EV_IN;
            pg8::DenseOrder S; S.init8((const void*)XA, DM, (const void*)(p.ws + (L ? WS_WIN1 : WS_WIN0)), TT, N, DM, C.G, C.bid);
            pg8::EpiStore E{QKV, N, 1.0f / 32.0f};
            pg8::gemm_phase<true>(C.lds, S, E, C.wave);
            if (L == 0 && IN(b + 2) && S.units_of_me() < S.max_units()) conv_queue(p, C, 2);
        )
        PHASE(b + 2, if (L == 0) phase_rope0(p, C); else phase_normrope1(p, C); )
        PHASE(b + 3, if (L == 0) { ret_chunk_kv(p, C); s5_end_states(p, C); } else phase_attention(p, C); )
        PHASE(b + 4, if (L == 0) phase_scans(p, C); else phase_merge1(p, C); )
        if (L == 0) {
            PHASE(b + 5, phase_ret_s5_outputs(p, C, misc); )
            PHASE(b + 6,
                pg8::DenseOrder S; S.init((const bf16_t*)(p.ws + WS_Z), 1024, (const bf16_t*)(p.ws + WS_WGLU), TT, 1024, 1024, C.G, C.bid);
                pg8::EpiGlu E{(const bf16_t*)(p.ws + WS_Z), p.inp(20), (bf16_t*)(p.ws + WS_BIG + BG_MIX)};
                pg8::gemm_phase<false>(C.lds, S, E, C.wave);
                if (IN(b + 7) && S.units_of_me() < S.max_units()) conv_queue(p, C, 4);
            )
        }
        PHASE(b + 7,
            pg8::DenseOrder S;
            if (L == 0) S.init((const bf16_t*)(p.ws + WS_BIG + BG_MIX), DM, (const bf16_t*)(p.ws + WS_WOUT0), TT, DM, DM, C.G, C.bid);
            else S.init((const bf16_t*)(p.ws + WS_BIG + BG_ATT), 3072, (const bf16_t*)(p.ws + WS_WOUT1), SEQ, DM, DM, C.G, C.bid);
            pg8::EpiStore E{(bf16_t*)(p.ws + WS_YMIX) + (L ? (size_t)CTXL * DM : 0), DM, 1.0f};
            pg8::gemm_phase<false>(C.lds, S, E, C.wave);
            if (L == 0 && IN(b + 8) && S.units_of_me() < S.max_units()) conv_queue(p, C, 5);
        )
        PHASE(b + 8, phase_ln1(p, C, L); )
        PHASE(b + 9, phase_router(p, C, L); )
        PHASE(b + 10,
            pg8::MoeOrder<0> S; S.A = (const void*)XA; S.Bt = (const void*)(p.ws + WS_GU + (size_t)L * NEX1 * 1024 * DM); S.list = LIST; S.cnt = cnt; S.ldab = DM; S.kb = DM; S.nN = 4; S.G = C.G; S.c = C.bid; S.bstride = (size_t)1024 * DM;
            S.prep(misc, C.tid);
            pg8::EpiE1 E{(unsigned char*)(p.ws + WS_HX2), S.cn, S.rb};
            pg8::gemm_phase<true>(C.lds, S, E, C.wave);
        )
        PHASE(b + 11,
            pg8::MoeOrder<1> S; S.A = (const void*)(p.ws + WS_HX2); S.Bt = (const void*)(p.ws + WS_DT + (size_t)L * NEX1 * DM * EHID); S.list = LIST; S.cnt = cnt; S.ldab = EHID; S.kb = EHID; S.nN = 8; S.G = C.G; S.c = C.bid; S.bstride = (size_t)DM * EHID;
            S.prep(misc, C.tid);
            pg8::EpiE2 E{(unsigned char*)(p.ws + WS_BIG + BG_YMOE), (const float*)(p.ws + WS_LW), S.cn, S.rb};
            pg8::gemm_phase<true>(C.lds, S, E, C.wave);
        )
        PHASE(b + 12, phase_combine(p, C, L, misc); )
    #undef IN
#undef SEAM
#undef FRESH
#undef PHASE
}

__global__ void __launch_bounds__(NTHR, 2) mega_fwd(KArgs ka) {
    extern __shared__ __attribute__((aligned(16))) unsigned char lds_raw[];
    Ctx C;
    C.lds = (LAS unsigned char*)lds_raw;
    C.tid = threadIdx.x; C.lane = C.tid & 63; C.wave = __builtin_amdgcn_readfirstlane(C.tid >> 6);
    C.G = gridDim.x; C.bid = blockIdx.x; C.gw = C.bid * NWAVES + C.wave; C.ngw = C.G * NWAVES;
    LAS unsigned char* misc = C.lds + MISC_OFF;
    if (C.tid < 8) ((volatile LAS unsigned*)misc)[C.tid] = 0u;
    Params p; p.out = ka.out; p.ws = ka.ws; p.ph_lo = ka.ph_lo; p.ph_hi = ka.ph_hi; p.ptab = (LAS unsigned long long*)(misc + 1024);
    if (C.tid < 34) p.ptab[C.tid] = (unsigned long long)ka.in[C.tid];
    __syncthreads();
    const int lo = p.ph_lo, hi = p.ph_hi;
    XcdBarrier bar; bar.bar = (unsigned*)(p.ws + WS_CTL) + CW_BAR; bar.x = 0; bar.st = (volatile LAS unsigned*)misc;
    if (hi - lo > 1) bar = xcd_barrier_post((unsigned*)(p.ws + WS_CTL) + CW_BAR, (volatile LAS unsigned*)misc);
#define IN(k) (lo <= (k) && (k) < hi)
#define SEAM(k) do { if (IN(k) && IN((k) + 1)) xcd_barrier(bar, C.wave); } while (0)

    if (IN(0)) { phase_p0(p, C); } SEAM(0);
    if (IN(1)) { phase_p1(p, C); } SEAM(1);
    if (IN(0) && IN(2) && (C.G & 7) == 0) {
        volatile LAS unsigned* st = (volatile LAS unsigned*)misc;
        if (C.tid == 0) { unsigned pre = 0u; const unsigned x = st[3];
            for (unsigned j = 0; j < 16; ++j) { const unsigned cj = xb_ld(&bar.bar[XB_XCNT(j)]); pre += (j < x) ? cj : 0u; }
            st[4] = pre + st[2]; }
        __syncthreads();
        const int vcu = (int)st[4], g8 = C.G >> 3;
        C.bid = __builtin_amdgcn_readfirstlane((vcu % g8) * 8 + vcu / g8); C.gw = C.bid * NWAVES + C.wave;
    }

    layer_body<0>(p, C, bar, misc, lo, hi);
    layer_body<1>(p, C, bar, misc, lo, hi);
#undef IN
#undef SEAM
}

extern "C" void kernel_launch(void* const* d_in, const int* in_sizes, int n_in, void* d_out, int out_size, void* d_ws, size_t ws_size, hipStream_t stream) {
    static int grid = 0;
    if (grid == 0) {
        if (n_in != 34 || out_size != SEQ * DM || ws_size < WS_END) { fprintf(stderr, "kernel_launch: unexpected shapes: n_in %d out %d ws %zu (need %zu)\n", n_in, out_size, ws_size, (size_t)WS_END); grid = -1; return; }
        int dev = 0, cus = 0, per_cu = 0;
        if (hipGetDevice(&dev) != hipSuccess || hipDeviceGetAttribute(&cus, hipDeviceAttributeMultiprocessorCount, dev) != hipSuccess) { grid = -1; return; }
        if (hipFuncSetAttribute((const void*)mega_fwd, hipFuncAttributeMaxDynamicSharedMemorySize, LDS_BYTES) != hipSuccess) { fprintf(stderr, "kernel_launch: hipFuncSetAttribute failed\n"); grid = -1; return; }
        if (hipOccupancyMaxActiveBlocksPerMultiprocessor(&per_cu, (const void*)mega_fwd, NTHR, LDS_BYTES) != hipSuccess || per_cu < 1) { fprintf(stderr, "kernel_launch: occupancy query says %d blocks per CU\n", per_cu); grid = -1; return; }
        (void)hipGetLastError();
        grid = cus;
    }
    if (grid < 0) return;
    (void)hipMemsetAsync((char*)d_ws + WS_CTL, 0, CTL_BYTES, stream);
    KArgs p{};
    for (int i = 0; i < 34; ++i) p.in[i] = (const float*)d_in[i];
    p.out = (float*)d_out; p.ws = (unsigned char*)d_ws;
#if MK_PER_PHASE
    for (int ph = 0; ph < N_PHASES; ++ph) {
        if (ph == 2 + PH_PER_LAYER + 0 || ph == 2 + PH_PER_LAYER + 5 || ph == 2 + PH_PER_LAYER + 6) continue;
        p.ph_lo = ph; p.ph_hi = ph + 1;
        hipLaunchKernelGGL(mega_fwd, dim3(grid), dim3(NTHR), LDS_BYTES, stream, p);
    }
#else
    p.ph_lo = 0; p.ph_hi = N_PHASES;
    hipLaunchKernelGGL(mega_fwd, dim3(grid), dim3(NTHR), LDS_BYTES, stream, p);
#endif
    const hipError_t le = hipPeekAtLastError();
    if (le != hipSuccess) fprintf(stderr, "kernel_launch: launch failed: %s\n", hipGetErrorName(le));
}
```

```cpp
#define MK_PER_PHASE 0
#include <hip/hip_runtime.h>
#include <cstdio>
#include <cstdint>

#define GAS __attribute__((address_space(1)))
#define LAS __attribute__((address_space(3)))
typedef unsigned short bf16_t;
typedef short bf16x8 __attribute__((ext_vector_type(8)));
typedef short s16x4 __attribute__((ext_vector_type(4)));
typedef float f32x4 __attribute__((ext_vector_type(4)));
typedef float f32x2 __attribute__((ext_vector_type(2)));
typedef float f32x16 __attribute__((ext_vector_type(16)));
typedef unsigned u32x4 __attribute__((ext_vector_type(4)));
typedef unsigned u32x2 __attribute__((ext_vector_type(2)));

constexpr int DM = 2048, SEQ = 16384, CTXL = 256, TT = SEQ + CTXL;
constexpr int NEXP = 64, NEX1 = 65, EHID = 512, TOPK = 8;
constexpr int EV_IN = 5120, OD_IN = 4608;
constexpr float LN_EPS = 1e-6f;
constexpr float ALPHA = 1.4142135623730951f;
constexpr float LAMBDA_INIT = 0.35550906759f;
constexpr int NTHR = 512, NWAVES = 8;

constexpr size_t al256(size_t x) { return (x + 255) / 256 * 256; }
constexpr size_t WS_CTL   = 0;
constexpr size_t CTL_BYTES = 1u << 20;
constexpr size_t WS_MODP  = WS_CTL + CTL_BYTES;
constexpr size_t WS_MODF  = WS_MODP + al256((size_t)2 * 32 * 2 * 12288 * 4);
constexpr size_t WS_ROPE128 = WS_MODF + al256((size_t)2 * 2 * 12288 * 4);
constexpr size_t WS_ROPE64  = WS_ROPE128 + al256((size_t)256 * 64 * 2 * 4);
constexpr size_t WS_KN    = WS_ROPE64 + al256((size_t)256 * 32 * 2 * 4);
constexpr size_t WS_WT    = WS_KN + al256((size_t)2 * 64 * 16 * 1024 * 2);
constexpr size_t WS_APOW  = WS_WT + al256((size_t)2 * 64 * 128 * 1024 * 2);
constexpr size_t WS_AL    = WS_APOW + al256((size_t)2 * 64 * 64 * 128 * 4);
constexpr size_t WS_CC    = WS_AL + al256((size_t)2 * 64 * 128 * 4);
constexpr size_t WS_BBT   = WS_CC + al256((size_t)64 * 16 * 128 * 2);
constexpr size_t WS_S5E   = WS_BBT + al256((size_t)2 * 64 * 128 * 16 * 2);
constexpr size_t WS_HST   = WS_S5E + al256((size_t)2 * 64 * 260 * 128 * 4);
constexpr size_t WS_WIN0  = WS_HST + al256((size_t)2 * 64 * 260 * 128 * 4);
constexpr size_t WS_WOUT0 = WS_WIN0 + al256((size_t)EV_IN * DM * 2);
constexpr size_t WS_WGLU  = WS_WOUT0 + al256((size_t)DM * DM * 2);
constexpr size_t WS_WIN1  = WS_WGLU + al256((size_t)1024 * 1024 * 2);
constexpr size_t WS_WOUT1 = WS_WIN1 + al256((size_t)OD_IN * DM * 2);
constexpr size_t WS_RWT   = WS_WOUT1 + al256((size_t)DM * DM * 2);
constexpr size_t WS_GU    = WS_RWT + al256((size_t)2 * 2 * 64 * DM * 2);
constexpr size_t WS_DT    = WS_GU + al256((size_t)NEX1 * 1024 * DM * 2);
constexpr size_t WS_XA    = WS_DT + al256((size_t)NEX1 * DM * EHID * 2);
constexpr size_t WS_Z     = WS_XA + al256((size_t)TT * DM * 2);
constexpr size_t WS_YMIX  = WS_Z + al256((size_t)TT * 1024 * 2);
constexpr size_t WS_X1    = WS_YMIX + al256((size_t)TT * DM * 2);
constexpr size_t WS_HX2   = WS_X1 + al256((size_t)TT * DM * 4);
constexpr size_t WS_LIST  = WS_HX2 + al256((size_t)9 * TT * EHID * 2);
constexpr size_t WS_WGT   = WS_LIST + al256((size_t)NEX1 * TT * 4);
constexpr size_t WS_LW    = WS_WGT + al256((size_t)8 * TT * 4);
constexpr size_t WS_BIG   = WS_LW + al256((size_t)NEX1 * TT * 4);
constexpr size_t BG_QKV   = 0;
constexpr size_t BG_CKV   = BG_QKV + al256((size_t)TT * EV_IN * 2);
constexpr size_t BG_SPREV = BG_CKV + al256((size_t)8 * 130 * 65536 * 4);
constexpr size_t BG_MIX   = BG_SPREV + al256((size_t)8 * 130 * 65536 * 2);
constexpr size_t BG_END0  = BG_MIX + al256((size_t)TT * DM * 2);
constexpr size_t BG_ATT   = BG_CKV;
constexpr size_t BG_Q8    = BG_ATT + al256((size_t)SEQ * 3072 * 2);
constexpr size_t BG_K8    = BG_Q8 + al256((size_t)TT * 1024);
constexpr size_t BG_VT8   = BG_K8 + al256((size_t)TT * 256);
constexpr size_t BG_Q8D   = BG_VT8 + al256((size_t)2 * 260 * 128 * 64);
constexpr size_t BG_K8D   = BG_Q8D + al256((size_t)TT * 1024);
constexpr size_t BG_VT8D  = BG_K8D + al256((size_t)TT * 1024);
constexpr size_t BG_F8END = BG_VT8D + al256((size_t)8 * 260 * 128 * 64);
constexpr size_t BG_YMOE  = 0;
constexpr size_t BG_END1  = al256((size_t)9 * TT * DM * 2);
constexpr size_t BG_SIZE  = BG_END0 > BG_END1 ? BG_END0 : BG_END1;
static_assert(BG_F8END <= BG_SIZE, "fp8 attention operands inside the big region");
constexpr size_t WS_END   = WS_BIG + BG_SIZE;

constexpr int CW_BAR = 4096;
constexpr int CW_CNT = 16384;
constexpr int CW_QUEUE = 20480;
constexpr int CW_KMAX = 24576;

constexpr int RING_BYTES = 151552;
constexpr int MISC_OFF = RING_BYTES;
constexpr int LDS_BYTES = 159744;

typedef __bf16 bf16x2_t __attribute__((ext_vector_type(2)));
__device__ __forceinline__ unsigned cvt_pk_bf16(float lo, float hi) { const f32x2 v = {lo, hi}; return __builtin_bit_cast(unsigned, __builtin_convertvector(v, bf16x2_t)); }
__device__ __forceinline__ bf16_t f2bf(float f) { unsigned u = __builtin_bit_cast(unsigned, f); return (bf16_t)((u + 0x7fffu + ((u >> 16) & 1u)) >> 16); }
__device__ __forceinline__ float bf2f(bf16_t b) { return __builtin_bit_cast(float, ((unsigned)b) << 16); }
__device__ __forceinline__ float bflo(unsigned w) { return __builtin_bit_cast(float, w << 16); }
__device__ __forceinline__ float bfhi(unsigned w) { return __builtin_bit_cast(float, w & 0xffff0000u); }
__device__ __forceinline__ float wave_sum(float v) {
#pragma unroll
    for (int o = 1; o < 64; o <<= 1) v += __shfl_xor(v, o);
    return v;
}
__device__ __forceinline__ float fast_exp(float x) { return __builtin_amdgcn_exp2f(x * 1.4426950408889634f); }
__device__ __forceinline__ float sigmoidf_(float x) { return 1.0f / (1.0f + __expf(-x)); }
__device__ __forceinline__ float siluf_(float x) { return x / (1.0f + __expf(-x)); }
__device__ __forceinline__ float gelu_tanh(float x) {
    const float u = 0.7978845608028654f * (x + 0.044715f * x * x * x);
    const float e = __expf(2.0f * u);
    const float t = 1.0f - 2.0f / (e + 1.0f);
    return 0.5f * x * (1.0f + t);
}
#define LDS_WAIT() asm volatile("s_waitcnt lgkmcnt(0)" ::: "memory")
#define VM_WAIT() asm volatile("s_waitcnt vmcnt(0)" ::: "memory")

#define XB_TMO      128
#define XB_XCNT(j)  (256  + 64 * (j))
#define XB_XSUB(j)  (1280 + 64 * (j))
#define XB_XGEN(j)  (2304 + 64 * (j))
#define XB_TOP      3328
#define XB_TOPGEN   3392
#define XCD_BAR_WORDS 3456
#define XB_SPIN_CAP (1u << 22)

__device__ __forceinline__ unsigned xb_ld(unsigned* p)              { return __hip_atomic_load(p, __ATOMIC_RELAXED, __HIP_MEMORY_SCOPE_AGENT); }
__device__ __forceinline__ unsigned xb_add(unsigned* p, unsigned v) { return __hip_atomic_fetch_add(p, v, __ATOMIC_RELAXED, __HIP_MEMORY_SCOPE_AGENT); }
__device__ __forceinline__ unsigned xb_xcc_id() { return (unsigned)__builtin_amdgcn_s_getreg((3 << 11) | 20) & 0xFu; }
#define XB_SPIN(cond, bar) do { unsigned _sp = 0; while (cond) { __builtin_amdgcn_s_sleep(1); \
    if ((++_sp & 255u) == 0u) { if (xb_ld(&(bar)[XB_TMO])) break; if (_sp > XB_SPIN_CAP) { atomicAdd(&(bar)[XB_TMO], 1u); break; } } } } while (0)

struct XcdBarrier { unsigned* bar; unsigned x; volatile LAS unsigned* st; };

__device__ __forceinline__ XcdBarrier xcd_barrier_post(unsigned* bar, volatile LAS unsigned* st) {
    XcdBarrier b; b.bar = bar; b.x = xb_xcc_id(); b.st = st;
    if (threadIdx.x == 0) { st[2] = xb_add(&bar[XB_XCNT(b.x)], 1u); st[3] = b.x; }
    return b;
}
__device__ __forceinline__ void xcd_barrier_complete(unsigned* bar, unsigned x, unsigned& nloc, unsigned& nx) {
    const unsigned G = gridDim.x * gridDim.y * gridDim.z;
    unsigned sum, cnt, mine, sp = 0u;
    for (;;) {
        sum = 0u; cnt = 0u; mine = 0u;
#pragma unroll
        for (unsigned j = 0; j < 16; ++j) { const unsigned c = xb_ld(&bar[XB_XCNT(j)]); sum += c; cnt += (c > 0u) ? 1u : 0u; mine = (j == x) ? c : mine; }
        if (sum == G) break;
        __builtin_amdgcn_s_sleep(1);
        if ((++sp & 255u) == 0u) { if (xb_ld(&bar[XB_TMO])) break; if (sp > XB_SPIN_CAP) { atomicAdd(&bar[XB_TMO], 1u); break; } }
    }
    nloc = mine > 0u ? mine : 1u; nx = cnt > 0u ? cnt : 1u;
}
__device__ __forceinline__ void xcd_barrier(const XcdBarrier& b, int wave_id) {
    const bool leader_thread = (wave_id == 0) && (__builtin_amdgcn_mbcnt_hi(~0u, __builtin_amdgcn_mbcnt_lo(~0u, 0u)) == 0u);
    asm volatile("s_waitcnt vmcnt(0)" ::: "memory");
    __syncthreads();
    if (leader_thread) {
        unsigned* bar = b.bar;
        __builtin_amdgcn_s_waitcnt(0);
        unsigned nloc = b.st[0], nx = b.st[1];
        if (nloc == 0u) { xcd_barrier_complete(bar, b.x, nloc, nx); b.st[0] = nloc; b.st[1] = nx; }
        const unsigned old = xb_add(&bar[XB_XSUB(b.x)], 1u);
        const unsigned gen = old / nloc;
        if (old + 1u == (gen + 1u) * nloc) {
            __builtin_amdgcn_fence(__ATOMIC_RELEASE, "agent");
            asm volatile("s_waitcnt vmcnt(0)" ::: "memory");
            const unsigned og = xb_add(&bar[XB_TOP], 1u);
            const unsigned tg = og / nx;
            if (og + 1u == (tg + 1u) * nx) xb_add(&bar[XB_TOPGEN], 1u);
            else XB_SPIN(xb_ld(&bar[XB_TOPGEN]) == tg, bar);
            __builtin_amdgcn_fence(__ATOMIC_ACQUIRE, "agent");
            xb_add(&bar[XB_XGEN(b.x)], 1u);
            asm volatile("s_waitcnt vmcnt(0)" ::: "memory");
        } else {
            XB_SPIN(xb_ld(&bar[XB_XGEN(b.x)]) == gen, bar);
            __builtin_amdgcn_fence(__ATOMIC_ACQUIRE, "agent");
            asm volatile("s_waitcnt vmcnt(0)" ::: "memory");
        }
    }
    __syncthreads();
}

__device__ __forceinline__ bf16x8 frag_rowk_l(const LAS bf16_t* p, int ld, int lane) {
    return *(const LAS bf16x8*)(p + (lane & 15) * ld + (lane >> 4) * 8);
}
__device__ __forceinline__ bf16x8 frag_rowk_g(const bf16_t* p, long ld, int lane) {
    return *(const bf16x8*)(p + (long)(lane & 15) * ld + (lane >> 4) * 8);
}
__device__ __forceinline__ bf16x8 frag_colk_l(unsigned p, int ldb, int lane) {
    const unsigned a0 = p + (unsigned)((8 * (lane >> 4) + ((lane & 15) >> 2)) * ldb + (lane & 3) * 8);
    const unsigned a1 = a0 + 4u * (unsigned)ldb;
    s16x4 lo, hi;
    asm volatile("ds_read_b64_tr_b16 %0, %2\n\tds_read_b64_tr_b16 %1, %3\n\ts_waitcnt lgkmcnt(0)" : "=&v"(lo), "=&v"(hi) : "v"(a0), "v"(a1) : "memory");
    return (bf16x8){lo[0], lo[1], lo[2], lo[3], hi[0], hi[1], hi[2], hi[3]};
}
#define MFMA16(a, b, c) __builtin_amdgcn_mfma_f32_16x16x32_bf16((a), (b), (c), 0, 0, 0)
namespace pg8 {
constexpr int BM = 256, BK = 64, HALF = 128, HTB = HALF * BK * 2, STAGE_BYTES = 8 * HTB, NXCD = 8, WGM = 8;
__device__ __forceinline__ int lds_byte(int r, int c) { const int st = (r >> 4) * 2 + (c >> 5), rr = r & 15, cc = c & 31, ob = rr * 64 + cc * 2; return st * 1024 + (ob ^ (((ob >> 9) & 1) << 5)); }
__device__ __forceinline__ void stage_rc(int b, int& R, int& C) { const int st = b / 1024, sb = b % 1024, swz = sb ^ (((sb >> 9) & 1) << 5); R = (st >> 1) * 16 + swz / 64; C = (st & 1) * 32 + (swz % 64) / 2; }
__device__ __forceinline__ int perm32(int rho) { const int n = rho >> 4, i = rho & 15; return 8 * (i >> 2) + 4 * n + (i & 3); }

struct Unit { int pm, pn, e; };
constexpr float WSCALE = 32.0f, WSCALE_INV = 1.0f / 32.0f;

struct DenseOrder {
    const bf16_t* A; const bf16_t* Bt; int ldab, kb, nM, nN, nwg, G, c;
    __device__ __forceinline__ void init(const bf16_t* A_, int lda_, const bf16_t* Bt_, int M, int N, int K_, int G_, int c_) { A = A_; ldab = lda_ * 2; Bt = Bt_; kb = K_ * 2; nM = M / BM; nN = N / BM; nwg = nM * nN; G = G_; c = c_; }
    __device__ __forceinline__ void init8(const void* A_, int ldab_, const void* Bt_, int M, int N, int K_, int G_, int c_) { A = (const bf16_t*)A_; ldab = ldab_; Bt = (const bf16_t*)Bt_; kb = K_; nM = M / BM; nN = N / BM; nwg = nM * nN; G = G_; c = c_; }
    __device__ __forceinline__ void prep(LAS unsigned char*) const {}
    __device__ __forceinline__ int units_of_me() const { return c < nwg ? (nwg - c + G - 1) / G : 0; }
    __device__ __forceinline__ int max_units() const { return (nwg + G - 1) / G; }
    __device__ __forceinline__ bool next(int i, Unit& u) const {
        const long L = (long)i * G + c; if (L >= nwg) return false;
        int wgid = (int)L; { const int q = nwg / NXCD, r = nwg % NXCD, xcd = wgid % NXCD, off = wgid / NXCD; wgid = (xcd < r ? xcd * (q + 1) : r * (q + 1) + (xcd - r) * q) + off; }
        const int nig = WGM * nN, gid = wgid / nig, fm = gid * WGM, gsz = (nM - fm) < WGM ? (nM - fm) : WGM;
        u.pm = fm + ((wgid % nig) % gsz); u.pn = (wgid % nig) / gsz; u.e = 0; return true;
    }
    __device__ __forceinline__ const char* a_base() const { return (const char*)A; }
    __device__ __forceinline__ unsigned a_off(const Unit& u, int r) const { return (unsigned)(u.pm * BM + r) * (unsigned)ldab; }
    __device__ __forceinline__ void a_off4(const Unit& u, int r0, int r1, int half, u32x4& o) const { o.x = a_off(u, r0); o.y = a_off(u, r1); o.z = a_off(u, half + r0); o.w = a_off(u, half + r1); }
    __device__ __forceinline__ const char* b_ptr(const Unit& u) const { return (const char*)Bt + (size_t)u.pn * BM * kb; }
};

template <int MODE  >
struct MoeOrder {
    const void* A; const void* Bt; const int* list; const int* cnt; int ldab, kb, nN, G, c; size_t bstride;
    LAS int* tp; LAS int* cn; LAS int* rb;
    __device__ __forceinline__ void prep(LAS unsigned char* misc, int tid) {
        tp = (LAS int*)(misc + 64); cn = tp + 72; rb = cn + 72;
        if (tid < NEX1) cn[tid] = cnt[tid];
        __syncthreads();
        if (tid == 0) { int s = 0, q = 0; for (int e = 0; e < NEX1; ++e) { tp[e] = s; rb[e] = q; s += (cn[e] + BM - 1) / BM; q += cn[e]; } tp[NEX1] = s; rb[NEX1] = q; }
        __syncthreads();
    }
    __device__ __forceinline__ bool next(int i, Unit& u) const {
        const int total = tp[NEX1]; const long nu = (long)total * nN; const int per = (int)((nu + G - 1) / G);
        (void)per;
        long L = (long)i * G + c;
        if ((G & 7) == 0) L = ((long)i * 8 + (c & 7)) * (G >> 3) + (c >> 3);
        if (L >= nu) return false;
        const int tile = (int)(L / nN); u.pn = (int)(L % nN);
        const int ln_ = (int)__builtin_amdgcn_mbcnt_hi(~0u, __builtin_amdgcn_mbcnt_lo(~0u, 0u));
        const int e = __builtin_popcountll(__ballot(tp[ln_ + 1] <= tile));
        u.e = e; u.pm = tile - tp[e]; return true;
    }
    __device__ __forceinline__ const char* a_base() const { return (const char*)A; }
    __device__ __forceinline__ unsigned a_off(const Unit& u, int r) const {
        int pos = u.pm * BM + r; const int n = cn[u.e]; pos = pos < n ? pos : n - 1;
        if (MODE == 1) return (unsigned)(rb[u.e] + pos) * (unsigned)ldab;
        const int a = list[u.e * TT + pos];
        const int row = a < 8 * TT ? (a >> 3) : a - 8 * TT;
        return (unsigned)row * (unsigned)ldab;
    }
    __device__ __forceinline__ void a_off4(const Unit& u, int r0, int r1, int half, u32x4& o) const {
        if (MODE == 1) { o.x = a_off(u, r0); o.y = a_off(u, r1); o.z = a_off(u, half + r0); o.w = a_off(u, half + r1); return; }
        const int n = cn[u.e], pb = u.pm * BM; const int* lp = list + u.e * TT;
        const int a0 = lp[min(pb + r0, n - 1)], a1 = lp[min(pb + r1, n - 1)], a2 = lp[min(pb + half + r0, n - 1)], a3 = lp[min(pb + half + r1, n - 1)];
        o.x = (unsigned)(a0 < 8 * TT ? (a0 >> 3) : a0 - 8 * TT) * (unsigned)ldab; o.y = (unsigned)(a1 < 8 * TT ? (a1 >> 3) : a1 - 8 * TT) * (unsigned)ldab;
        o.z = (unsigned)(a2 < 8 * TT ? (a2 >> 3) : a2 - 8 * TT) * (unsigned)ldab; o.w = (unsigned)(a3 < 8 * TT ? (a3 >> 3) : a3 - 8 * TT) * (unsigned)ldab;
    }
    __device__ __forceinline__ const char* b_ptr(const Unit& u) const { return (const char*)Bt + (size_t)u.e * bstride + (size_t)u.pn * BM * kb; }
};

typedef int v8i32 __attribute__((ext_vector_type(8)));
typedef int v4i32_ __attribute__((ext_vector_type(4)));
__device__ __forceinline__ v8i32 cat8(bf16x8 a, bf16x8 b) { const u32x4 x = __builtin_bit_cast(u32x4, a), y = __builtin_bit_cast(u32x4, b); return (v8i32){(int)x.x, (int)x.y, (int)x.z, (int)x.w, (int)y.x, (int)y.y, (int)y.z, (int)y.w}; }
template <bool FP8, class Epi, class Sched>
__device__ __forceinline__ void gemm_phase(LAS unsigned char* lds, const Sched& S, const Epi& E, int wave_id) {
    const int wid = wave_id; int lane = (int)__builtin_amdgcn_mbcnt_hi(~0u, __builtin_amdgcn_mbcnt_lo(~0u, 0u)); asm volatile("" : "+v"(lane));
    const int tid = wid * 64 + lane, wr = wid >> 2, wc = wid & 3, fr = lane & 15, fq = lane >> 4;
    const int kb = S.kb; int nt = kb / 128; asm volatile("" : "+s"(nt));
    unsigned voffB[2];
#pragma unroll
    for (int i = 0; i < 2; ++i) { int R, C; stage_rc(tid * 16 + i * 8192, R, C); const int Rb = (R & ~31) + perm32(R & 31);
        voffB[i] = (unsigned)(Rb * kb) + (unsigned)C * 2u; }
#define PG8_AOFF(u, h, i) ({ int _tz = tid; asm volatile("" : "+v"(_tz)); int _R, _C; stage_rc(_tz * 16 + (i) * 8192, _R, _C); S.a_off((u), (h) * HALF + _R) + (unsigned)_C * 2u; })
    const size_t kstep = (size_t)(BK * 2);
    const size_t hstepB = (size_t)HALF * kb;
    const unsigned ldsw = (unsigned)wid * 1024u;
    const int aoff = lds_byte(wr * 64 + fr, fq * 8), boff = lds_byte(wc * 32 + fr, fq * 8);
#define PG8_SA(b, h) (((b) * 2 + (h)) * HTB)
#define PG8_SB(b, h) ((4 + (b) * 2 + (h)) * HTB)
#define PG8_STAGE(bufoff, gbase, v0, v1) do { \
        __builtin_amdgcn_global_load_lds((const unsigned*)((const char*)(gbase) + (v0)), (LAS unsigned*)(lds + (bufoff) + ldsw), 16, 0, 0); \
        __builtin_amdgcn_global_load_lds((const unsigned*)((const char*)(gbase) + (v1)), (LAS unsigned*)(lds + (bufoff) + ldsw + 8192), 16, 0, 0); } while (0)
#define PG8_VOFFB(i) ({ int _tz = tid; asm volatile("" : "+v"(_tz)); int _R, _C; stage_rc(_tz * 16 + (i) * 8192, _R, _C); (unsigned)(((_R & ~31) + perm32(_R & 31)) * kb) + (unsigned)_C * 2u; })
#define PG8_STAGE_B(bufoff, gbase) do { if constexpr (FP8) { int _tz = tid; asm volatile("" : "+v"(_tz)); const u32x2 _vv = *(const LAS u32x2*)(lds + STAGE_BYTES + 8192 + _tz * 8); PG8_STAGE(bufoff, gbase, _vv.x, _vv.y); } else PG8_STAGE(bufoff, gbase, voffB[0], voffB[1]); } while (0)
#define PG8_LD8(off) __builtin_shufflevector(*(const LAS v4i32_*)(lds + (off)), *(const LAS v4i32_*)(lds + (off) + 1024), 0, 1, 2, 3, 4, 5, 6, 7)
#define PG8_LDA(dst, b, h) do { _Pragma("unroll") for (int m = 0; m < 4; ++m) { if constexpr (FP8) dst##8[m] = PG8_LD8(PG8_SA(b, h) + aoff + m * 2048); else { _Pragma("unroll") for (int k = 0; k < 2; ++k) dst[m][k] = *(const LAS bf16x8*)(lds + PG8_SA(b, h) + aoff + m * 2048 + k * 1024); } } } while (0)
#define PG8_LDB(dst, b, h) do { _Pragma("unroll") for (int n = 0; n < 2; ++n) { if constexpr (FP8) dst##8[n] = PG8_LD8(PG8_SB(b, h) + boff + n * 2048); else { _Pragma("unroll") for (int k = 0; k < 2; ++k) dst[n][k] = *(const LAS bf16x8*)(lds + PG8_SB(b, h) + boff + n * 2048 + k * 1024); } } } while (0)
#define PG8_MMA(ai, bj, At, Bt) do { __builtin_amdgcn_s_setprio(1); _Pragma("unroll") for (int m = 0; m < 4; ++m) _Pragma("unroll") for (int n = 0; n < 2; ++n) { \
        if constexpr (FP8) asm volatile("v_mfma_f32_16x16x128_f8f6f4 %0, %1, %2, %0" : "+v"(acc[ai][bj][m][n]) : "v"(Bt##8[n]), "v"(At##8[m])); \
        else { _Pragma("unroll") for (int k = 0; k < 2; ++k) acc[ai][bj][m][n] = __builtin_amdgcn_mfma_f32_16x16x32_bf16(Bt[n][k], At[m][k], acc[ai][bj][m][n], 0, 0, 0); } } \
        __builtin_amdgcn_s_setprio(0); } while (0)
#define PG8_WAIT_V(n) asm volatile("s_waitcnt vmcnt(" #n ")" ::: "memory")
#define PG8_WAIT_L(n) asm volatile("s_waitcnt lgkmcnt(" #n ")" ::: "memory")
#define PG8_BAR __builtin_amdgcn_s_barrier()
#define PG8_SCHED __builtin_amdgcn_sched_barrier(0)
    if constexpr (FP8) { u32x2 _vb; _vb.x = PG8_VOFFB(0); _vb.y = PG8_VOFFB(1); *(LAS u32x2*)(lds + STAGE_BYTES + 8192 + tid * 8) = _vb; }
    Unit cur, nxt; int ui = 0;
    if (!S.next(0, cur)) return;
    f32x4 acc[2][2][4][2];
#pragma unroll
    for (int a = 0; a < 2; ++a)
#pragma unroll
        for (int b = 0; b < 2; ++b)
#pragma unroll
            for (int m = 0; m < 4; ++m)
#pragma unroll
                for (int n = 0; n < 2; ++n) acc[a][b][m][n] = (f32x4){0.f, 0.f, 0.f, 0.f};
    bf16x8 At[4][2], B0[2][2], B1[2][2]; v8i32 At8[4], B08[2], B18[2];
    const char* const gA = S.a_base();
    const char* cB = S.b_ptr(cur);
    unsigned oc00, oc01, oc10, oc11;
    oc00 = PG8_AOFF(cur, 0, 0); oc01 = PG8_AOFF(cur, 0, 1); oc10 = PG8_AOFF(cur, 1, 0); oc11 = PG8_AOFF(cur, 1, 1);
    PG8_STAGE_B(PG8_SB(0, 0), cB); PG8_STAGE_B(PG8_SB(0, 1), cB + hstepB); PG8_STAGE(PG8_SA(0, 0), gA, oc00, oc01); PG8_STAGE(PG8_SA(0, 1), gA, oc10, oc11);
    if (wr == 1) PG8_BAR;
    PG8_WAIT_V(2); PG8_BAR;
    PG8_STAGE_B(PG8_SB(1, 0), cB + kstep); PG8_STAGE(PG8_SA(1, 0), gA + kstep, oc00, oc01); PG8_STAGE_B(PG8_SB(1, 1), cB + hstepB + kstep);
    PG8_WAIT_V(6); PG8_BAR;
    for (;;) {
        const bool has_next = S.next(ui + 1, nxt);
        const char* nB = cB;
        {
            u32x4 on = {oc00, oc01, oc10, oc11};
            if (has_next) {
                int _tz = tid; asm volatile("" : "+v"(_tz)); int _R0, _C0, _R1, _C1; stage_rc(_tz * 16, _R0, _C0); stage_rc(_tz * 16 + 8192, _R1, _C1);
                S.a_off4(nxt, _R0, _R1, HALF, on); on.x += (unsigned)_C0 * 2u; on.y += (unsigned)_C1 * 2u; on.z += (unsigned)_C0 * 2u; on.w += (unsigned)_C1 * 2u; nB = S.b_ptr(nxt); }
            *(LAS u32x4*)(lds + STAGE_BYTES + tid * 16) = on;
        }
        for (int t = 0; t < nt; t += 2) {
            const bool last = (t == nt - 2);
            const char* a1 = gA + (size_t)(t + 1) * kstep;
            const char* a2 = last ? gA : gA + (size_t)(t + 2) * kstep; const char* b2 = last ? nB : cB + (size_t)(t + 2) * kstep;
            const char* a3 = a2 + kstep; const char* b3 = b2 + kstep;
            unsigned s00 = oc00, s01 = oc01, s10 = oc10, s11 = oc11;
            if (last) { const u32x4 on = *(const LAS u32x4*)(lds + STAGE_BYTES + tid * 16); s00 = on.x; s01 = on.y; s10 = on.z; s11 = on.w; }
            PG8_LDB(B0, 0, 0); PG8_LDB(B1, 0, 1); PG8_SCHED; PG8_LDA(At, 0, 0); PG8_STAGE(PG8_SA(1, 1), a1, oc10, oc11);
            PG8_WAIT_V(8); PG8_WAIT_L(0); PG8_BAR; PG8_MMA(0, 0, At, B0); PG8_MMA(0, 1, At, B1); PG8_BAR; PG8_SCHED;
            PG8_LDA(At, 0, 1); PG8_STAGE_B(PG8_SB(0, 0), b2); PG8_STAGE_B(PG8_SB(0, 1), b2 + hstepB); PG8_STAGE(PG8_SA(0, 0), a2, s00, s01);
            PG8_WAIT_V(8); PG8_WAIT_L(0); PG8_BAR; PG8_MMA(1, 0, At, B0); PG8_MMA(1, 1, At, B1); PG8_BAR; PG8_SCHED;
            PG8_LDB(B0, 1, 0); PG8_LDB(B1, 1, 1); PG8_SCHED; PG8_LDA(At, 1, 0); PG8_STAGE(PG8_SA(0, 1), a2, s10, s11);
            PG8_WAIT_V(8); PG8_WAIT_L(0); PG8_BAR; PG8_MMA(0, 0, At, B0); PG8_MMA(0, 1, At, B1); PG8_BAR; PG8_SCHED;
            PG8_LDA(At, 1, 1); PG8_STAGE_B(PG8_SB(1, 0), b3); PG8_STAGE_B(PG8_SB(1, 1), b3 + hstepB); PG8_STAGE(PG8_SA(1, 0), a3, s00, s01);
            PG8_WAIT_V(8); PG8_WAIT_L(0); PG8_BAR; PG8_MMA(1, 0, At, B0); PG8_MMA(1, 1, At, B1); PG8_BAR; PG8_SCHED;
        }
        if (wr == 0) PG8_BAR;
        E(acc, cur, wr, wc, fr, fq);
        if (!has_next) break;
#pragma unroll
        for (int a = 0; a < 2; ++a)
#pragma unroll
            for (int b = 0; b < 2; ++b)
#pragma unroll
                for (int m = 0; m < 4; ++m)
#pragma unroll
                    for (int n = 0; n < 2; ++n) acc[a][b][m][n] = (f32x4){0.f, 0.f, 0.f, 0.f};
        { const u32x4 on = *(const LAS u32x4*)(lds + STAGE_BYTES + tid * 16); oc00 = on.x; oc01 = on.y; oc10 = on.z; oc11 = on.w; }
        cur = nxt; cB = nB; ++ui;
        if (wr == 1) PG8_BAR;
    }
    PG8_WAIT_V(0);
    PG8_BAR;
#undef PG8_SA
#undef PG8_SB
#undef PG8_STAGE
#undef PG8_STAGE_B
#undef PG8_AOFF
#undef PG8_VOFFB
#undef PG8_LD8
#undef PG8_LDA
#undef PG8_LDB
#undef PG8_MMA
#undef PG8_WAIT_V
#undef PG8_WAIT_L
#undef PG8_BAR
#undef PG8_SCHED
}

struct EpiStore {
    bf16_t* O; int ldc; float scale;
    __device__ __forceinline__ void operator()(const f32x4 (&acc)[2][2][4][2], const Unit& u, int wr, int wc, int fr, int fq) const {
        const int row0 = u.pm * BM + wr * 64 + fr, col0 = u.pn * BM + wc * 32 + 8 * fq;
#pragma unroll
        for (int ai = 0; ai < 2; ++ai)
#pragma unroll
            for (int m = 0; m < 4; ++m) { bf16_t* rowp = O + (size_t)(row0 + ai * HALF + m * 16) * ldc + col0;
#pragma unroll
                for (int bj = 0; bj < 2; ++bj) { const f32x4 v0 = acc[ai][bj][m][0] * scale, v1 = acc[ai][bj][m][1] * scale;
                    u32x4 w; w.x = cvt_pk_bf16(v0[0], v0[1]); w.y = cvt_pk_bf16(v0[2], v0[3]); w.z = cvt_pk_bf16(v1[0], v1[1]); w.w = cvt_pk_bf16(v1[2], v1[3]);
                    *(u32x4*)(rowp + bj * HALF) = w; } }
    }
};
struct EpiGlu {
    const bf16_t* Z; const float* b; bf16_t* MIX;
    __device__ __forceinline__ void operator()(const f32x4 (&acc)[2][2][4][2], const Unit& u, int wr, int wc, int fr, int fq) const {
        const int row0 = u.pm * BM + wr * 64 + fr, col0 = u.pn * BM + wc * 32 + 8 * fq;
#pragma unroll
        for (int bj = 0; bj < 2; ++bj) {
            const f32x4 b0 = *(const f32x4*)(b + col0 + bj * HALF), b1 = *(const f32x4*)(b + col0 + bj * HALF + 4);
#pragma unroll
            for (int ai = 0; ai < 2; ++ai)
#pragma unroll
                for (int m = 0; m < 4; ++m) { const size_t row = (size_t)(row0 + ai * HALF + m * 16);
                    const u32x4 zz = *(const u32x4*)(Z + row * 1024 + col0 + bj * HALF);
                    const f32x4 v0 = acc[ai][bj][m][0] + b0, v1 = acc[ai][bj][m][1] + b1;
                    u32x4 w;
                    w.x = cvt_pk_bf16(bflo(zz.x) * sigmoidf_(v0[0]), bfhi(zz.x) * sigmoidf_(v0[1]));
                    w.y = cvt_pk_bf16(bflo(zz.y) * sigmoidf_(v0[2]), bfhi(zz.y) * sigmoidf_(v0[3]));
                    w.z = cvt_pk_bf16(bflo(zz.z) * sigmoidf_(v1[0]), bfhi(zz.z) * sigmoidf_(v1[1]));
                    w.w = cvt_pk_bf16(bflo(zz.w) * sigmoidf_(v1[2]), bfhi(zz.w) * sigmoidf_(v1[3]));
                    *(u32x4*)(MIX + row * DM + 1024 + col0 + bj * HALF) = w; }
        }
    }
};
struct EpiE1 {
    unsigned char* H; const LAS int* cn; const LAS int* rb;
    __device__ __forceinline__ void operator()(const f32x4 (&acc)[2][2][4][2], const Unit& u, int wr, int wc, int fr, int fq) const {
        const int n = cn[u.e]; const int colh = u.pn * 128 + wc * 32 + 8 * fq;
#pragma unroll
        for (int ai = 0; ai < 2; ++ai)
#pragma unroll
            for (int m = 0; m < 4; ++m) { const int pos = u.pm * BM + ai * HALF + wr * 64 + m * 16 + fr;
                if (pos < n) { const int a = rb[u.e] + pos;
                    float sc = WSCALE_INV; asm volatile("" : "+v"(sc));
                    const f32x4 g0 = acc[ai][0][m][0] * sc, g1 = acc[ai][0][m][1] * sc, u0 = acc[ai][1][m][0] * sc, u1 = acc[ai][1][m][1] * sc;
                    u32x2 w;
                    w.x = (unsigned)__builtin_amdgcn_cvt_pk_fp8_f32(siluf_(g0[0]) * u0[0], siluf_(g0[1]) * u0[1], 0, false);
                    w.x = (unsigned)__builtin_amdgcn_cvt_pk_fp8_f32(siluf_(g0[2]) * u0[2], siluf_(g0[3]) * u0[3], (int)w.x, true);
                    w.y = (unsigned)__builtin_amdgcn_cvt_pk_fp8_f32(siluf_(g1[0]) * u1[0], siluf_(g1[1]) * u1[1], 0, false);
                    w.y = (unsigned)__builtin_amdgcn_cvt_pk_fp8_f32(siluf_(g1[2]) * u1[2], siluf_(g1[3]) * u1[3], (int)w.y, true);
                    *(u32x2*)(H + (size_t)a * EHID + colh) = w; }
                __builtin_amdgcn_sched_barrier(0); }
    }
};
struct EpiE2 {
    unsigned char* Y; const float* wgt; const LAS int* cn; const LAS int* rb;
    __device__ __forceinline__ void operator()(const f32x4 (&acc)[2][2][4][2], const Unit& u, int wr, int wc, int fr, int fq) const {
        const int n = cn[u.e]; const int col0 = u.pn * BM + wc * 32 + 8 * fq;
#pragma unroll
        for (int ai = 0; ai < 2; ++ai)
#pragma unroll
            for (int m = 0; m < 4; ++m) { const int pos = u.pm * BM + ai * HALF + wr * 64 + m * 16 + fr;
                if (pos < n) { const int a = rb[u.e] + pos; float ws = WSCALE_INV * 0.25f; asm volatile("" : "+v"(ws));
                    unsigned char* rowp = Y + (size_t)a * DM + col0;
#pragma unroll
                    for (int bj = 0; bj < 2; ++bj) { const f32x4 v0 = acc[ai][bj][m][0] * ws, v1 = acc[ai][bj][m][1] * ws;
                        u32x2 w;
                        w.x = (unsigned)__builtin_amdgcn_cvt_pk_fp8_f32(v0[0], v0[1], 0, false); w.x = (unsigned)__builtin_amdgcn_cvt_pk_fp8_f32(v0[2], v0[3], (int)w.x, true);
                        w.y = (unsigned)__builtin_amdgcn_cvt_pk_fp8_f32(v1[0], v1[1], 0, false); w.y = (unsigned)__builtin_amdgcn_cvt_pk_fp8_f32(v1[2], v1[3], (int)w.y, true);
                        *(u32x2*)(rowp + bj * HALF) = w; } }
                __builtin_amdgcn_sched_barrier(0); }
    }
};
}
struct KArgs {
    const float* in[34];
    float* out;
    unsigned char* ws;
    int ph_lo, ph_hi;
};
struct Params {
    float* out;
    unsigned char* ws;
    LAS unsigned long long* ptab;
    int ph_lo, ph_hi;
    __device__ __forceinline__ const float* inp(int k) const {
        const unsigned long long v = ptab[k];
        const unsigned lo = __builtin_amdgcn_readfirstlane((unsigned)v), hi = __builtin_amdgcn_readfirstlane((unsigned)(v >> 32));
        return (const float*)(((unsigned long long)hi << 32) | lo);
    }
};
struct Ctx {
    LAS unsigned char* lds;
    int tid, lane, wave, G, bid;
    int gw, ngw;
};

__device__ __forceinline__ void tr_item(const float* W, int N, bf16_t* WT, int ldt, int k0, int n0, int orow0, LAS float* scr, int lane) {
#pragma unroll 8
    for (int i = 0; i < 32; ++i) { const int kk = 2 * i + (lane >> 5); scr[kk * 33 + (lane & 31)] = W[(size_t)(k0 + kk) * N + n0 + (lane & 31)]; }
    LDS_WAIT(); asm volatile("" ::: "memory");
    const int c = lane & 7;
#pragma unroll
    for (int j = 0; j < 4; ++j) { const int n = (lane >> 3) + 8 * j; const LAS float* s = scr + (8 * c) * 33 + n;
        u32x4 o; o.x = cvt_pk_bf16(s[0 * 33], s[1 * 33]); o.y = cvt_pk_bf16(s[2 * 33], s[3 * 33]); o.z = cvt_pk_bf16(s[4 * 33], s[5 * 33]); o.w = cvt_pk_bf16(s[6 * 33], s[7 * 33]);
        *(u32x4*)(WT + (size_t)(orow0 + n) * ldt + k0 + 8 * c) = o; }
    LDS_WAIT(); asm volatile("" ::: "memory");
}
__device__ __forceinline__ void tr_item64(const float* W, int N, bf16_t* WT, int ldt, int k0, int n0, int orow0, LAS float* scr, int lane) {
    f32x4 v[16];
    const float* src = W + (size_t)(k0 + (lane >> 4)) * N + n0 + 4 * (lane & 15);
#pragma unroll
    for (int i = 0; i < 16; ++i) v[i] = __builtin_nontemporal_load((const f32x4*)(src + (size_t)(4 * i) * N));
#pragma unroll
    for (int i = 0; i < 16; ++i) { LAS float* d = scr + (4 * i + (lane >> 4)) * 65 + 4 * (lane & 15); d[0] = v[i][0]; d[1] = v[i][1]; d[2] = v[i][2]; d[3] = v[i][3]; }
    LDS_WAIT(); asm volatile("" ::: "memory");
    const int c = lane & 7;
#pragma unroll
    for (int j = 0; j < 8; ++j) { const int n = (lane >> 3) + 8 * j; const LAS float* s = scr + (8 * c) * 65 + n;
        u32x4 o; o.x = cvt_pk_bf16(s[0 * 65], s[1 * 65]); o.y = cvt_pk_bf16(s[2 * 65], s[3 * 65]); o.z = cvt_pk_bf16(s[4 * 65], s[5 * 65]); o.w = cvt_pk_bf16(s[6 * 65], s[7 * 65]);
        *(u32x4*)(WT + (size_t)(orow0 + n) * ldt + k0 + 8 * c) = o; }
    LDS_WAIT(); asm volatile("" ::: "memory");
}
__device__ __forceinline__ void tr_item64_fp8(const float* W, int N, unsigned char* WT, int ldt, int k0, int n0, int orow0, LAS float* scr, int lane, float wscale = pg8::WSCALE) {
    f32x4 v[16];
    const float* src = W + (size_t)(k0 + (lane >> 4)) * N + n0 + 4 * (lane & 15);
#pragma unroll
    for (int i = 0; i < 16; ++i) v[i] = __builtin_nontemporal_load((const f32x4*)(src + (size_t)(4 * i) * N));
#pragma unroll
    for (int i = 0; i < 16; ++i) { LAS float* d = scr + (4 * i + (lane >> 4)) * 65 + 4 * (lane & 15); d[0] = v[i][0]; d[1] = v[i][1]; d[2] = v[i][2]; d[3] = v[i][3]; }
    LDS_WAIT(); asm volatile("" ::: "memory");
    const int c = lane & 3;
#pragma unroll
    for (int j = 0; j < 4; ++j) { const int n = (lane >> 2) + 16 * j; const LAS float* s = scr + (16 * c) * 65 + n;
        u32x4 o;
        o.x = (unsigned)__builtin_amdgcn_cvt_pk_fp8_f32(s[0 * 65] * wscale, s[1 * 65] * wscale, 0, false);   o.x = (unsigned)__builtin_amdgcn_cvt_pk_fp8_f32(s[2 * 65] * wscale, s[3 * 65] * wscale, (int)o.x, true);
        o.y = (unsigned)__builtin_amdgcn_cvt_pk_fp8_f32(s[4 * 65] * wscale, s[5 * 65] * wscale, 0, false);   o.y = (unsigned)__builtin_amdgcn_cvt_pk_fp8_f32(s[6 * 65] * wscale, s[7 * 65] * wscale, (int)o.y, true);
        o.z = (unsigned)__builtin_amdgcn_cvt_pk_fp8_f32(s[8 * 65] * wscale, s[9 * 65] * wscale, 0, false);   o.z = (unsigned)__builtin_amdgcn_cvt_pk_fp8_f32(s[10 * 65] * wscale, s[11 * 65] * wscale, (int)o.z, true);
        o.w = (unsigned)__builtin_amdgcn_cvt_pk_fp8_f32(s[12 * 65] * wscale, s[13 * 65] * wscale, 0, false); o.w = (unsigned)__builtin_amdgcn_cvt_pk_fp8_f32(s[14 * 65] * wscale, s[15 * 65] * wscale, (int)o.w, true);
        *(u32x4*)(WT + (size_t)(orow0 + n) * ldt + k0 + 16 * c) = o; }
    LDS_WAIT(); asm volatile("" ::: "memory");
}
__device__ __forceinline__ void tr_dense(const float* W, int K, int N, bf16_t* WT, int item, LAS float* scr, int lane) {
    const int nblk = N / 32, kb = item / nblk, nb = item % nblk;
    tr_item(W, N, WT, K, 64 * kb, 32 * nb, 32 * nb, scr, lane);
}

__device__ __forceinline__ void s5_tables(const Params& p, Ctx& C, int dir, int g) {
    LAS f32x2* PW = (LAS f32x2*)C.lds;
    LAS f32x2* BB = PW + 65 * 64;
    LAS f32x2* CX = BB + 64 * 16;
    const float* a_re = p.inp(11); const float* a_im = p.inp(12); const float* log_dt = p.inp(13);
    const float* b_re = p.inp(14); const float* b_im = p.inp(15); const float* c_re = p.inp(16); const float* c_im = p.inp(17);
    const int tid = C.tid;
    if (tid < 64) {
        const int pp = tid;
        const float dt = __expf(log_dt[dir * 64 + g]);
        const float are = a_re[(dir * 64 + g) * 64 + pp], aim = a_im[(dir * 64 + g) * 64 + pp];
        const float zr = are * dt, zi = aim * dt;
        const float mag = __expf(zr);
        double rev = (double)zi * 0.15915494309189535; rev -= floor(rev);
        const float cs = __builtin_amdgcn_cosf((float)rev), sn = __builtin_amdgcn_sinf((float)rev);
        const float abr = mag * cs, abi = mag * sn;
        const float den = are * are + aim * aim, nr = abr - 1.0f, ni = abi;
        const float fre = (nr * are + ni * aim) / den, fim = (ni * are - nr * aim) / den;
        float pr = 1.0f, pi = 0.0f;
#pragma unroll 1
        for (int n = 0; n <= 64; ++n) { PW[n * 64 + pp] = (f32x2){pr, pi}; const float t = pr * abr - pi * abi; pi = pr * abi + pi * abr; pr = t; }
        for (int j = 0; j < 16; ++j) { const float br = b_re[(g * 64 + pp) * 16 + j], bi = b_im[(g * 64 + pp) * 16 + j];
            BB[pp * 16 + j] = (f32x2){fre * br - fim * bi, fre * bi + fim * br}; }
    }
    for (int q = tid; q < 1024; q += NTHR) { const int i = q >> 6, pp = q & 63; CX[i * 64 + pp] = (f32x2){c_re[(g * 16 + i) * 64 + pp], c_im[(g * 16 + i) * 64 + pp]}; }
    __syncthreads();
    bf16_t* KN = (bf16_t*)(p.ws + WS_KN) + (size_t)(dir * 64 + g) * 16 * 1024;
    float* APOW = (float*)(p.ws + WS_APOW) + (size_t)(dir * 64 + g) * 64 * 128;
    float* AL = (float*)(p.ws + WS_AL) + (size_t)(dir * 64 + g) * 128;
#pragma unroll 1
    for (int q = 0; q < 32; ++q) { const int idx = tid + NTHR * q; const int n = idx >> 8, i = (idx >> 4) & 15, j = idx & 15;
        float s = 0.f;
#pragma unroll 4
        for (int pp = 0; pp < 64; ++pp) { const f32x2 c = CX[i * 64 + pp], w = PW[n * 64 + pp], b = BB[pp * 16 + j];
            const float gr = c.x * b.x - c.y * b.y, gi = c.x * b.y + c.y * b.x;
            s += gr * w.x - gi * w.y; }
        KN[(size_t)i * 1024 + n * 16 + j] = f2bf(s); }
    for (int q = tid; q < 4096; q += NTHR) { const int t = q >> 6, pp = q & 63; const f32x2 w = PW[(t + 1) * 64 + pp]; *(f32x2*)(APOW + (size_t)t * 128 + 2 * pp) = w; }
    if (tid < 64) { const f32x2 w = PW[64 * 64 + tid]; *(f32x2*)(AL + 2 * tid) = w; }
    { bf16_t* BBT = (bf16_t*)(p.ws + WS_BBT) + (size_t)(dir * 64 + g) * 128 * 16;
      for (int q = tid; q < 2048; q += NTHR) { const int pq = q >> 4, j = q & 15; const f32x2 b = BB[(pq & 63) * 16 + j]; BBT[q] = f2bf(pq < 64 ? b.x : b.y); } }
    if (dir == 0) { bf16_t* CCt = (bf16_t*)(p.ws + WS_CC) + (size_t)g * 16 * 128;
        for (int q = tid; q < 2048; q += NTHR) { const int i = q >> 7, pq = q & 127; const f32x2 c = CX[i * 64 + (pq & 63)]; CCt[i * 128 + pq] = f2bf(pq < 64 ? c.x : -c.y); } }
    __syncthreads();
}

__device__ __forceinline__ void phase_p0(const Params& p, Ctx& C) {
    for (int task = C.bid; task < 128; task += C.G) s5_tables(p, C, task >> 6, task & 63);
    {
        const int gt = C.bid * NTHR + C.tid, ngt = C.G * NTHR;
        float* R128 = (float*)(p.ws + WS_ROPE128); float* R64 = (float*)(p.ws + WS_ROPE64);
        for (int q = gt; q < 256 * 64 + 256 * 32; q += ngt) {
            int pos, i, half; float* dst;
            if (q < 256 * 64) { pos = q >> 6; i = q & 63; half = 64; dst = R128 + (size_t)q * 2; }
            else { const int r = q - 256 * 64; pos = r >> 5; i = r & 31; half = 32; dst = R64 + (size_t)r * 2; }
            const float freq = exp2f(-(float)i / (float)half * 13.287712379549449f);
            const float ang = (float)pos * freq;
            double rev = (double)ang * 0.15915494309189535; rev -= floor(rev);
            dst[0] = __builtin_amdgcn_cosf((float)rev); dst[1] = __builtin_amdgcn_sinf((float)rev);
        }
        bf16_t* RWT = (bf16_t*)(p.ws + WS_RWT); const float* rw = p.inp(26);
        for (int q = gt; q < 2 * 64 * DM; q += ngt) { const int L = q / (64 * DM), r = q % (64 * DM), e = r / DM, k = r % DM;
            const float w = rw[((size_t)L * DM + k) * 64 + e]; const bf16_t hi = f2bf(w); const bf16_t lo = f2bf(w - bf2f(hi));
            RWT[((size_t)(L * 2 + 0) * 64 + e) * DM + k] = hi; RWT[((size_t)(L * 2 + 1) * 64 + e) * DM + k] = lo; }
    }
    {
        const float* cvec = p.inp(1); const float* cctx = p.inp(3); const float* mw = p.inp(4);
        float* MODP = (float*)(p.ws + WS_MODP);
        for (int task = C.gw; task < 2 * 32 * 48; task += C.ngw) {
            const int L = task / (32 * 48), r = task % (32 * 48), kb = r / 48, cb = r % 48;
            const float sc = siluf_(cvec[64 * kb + C.lane]), sx = siluf_(cctx[64 * kb + C.lane]);
            f32x4 a0 = {0.f, 0.f, 0.f, 0.f}, a1 = {0.f, 0.f, 0.f, 0.f};
            const float* wp = mw + ((size_t)L * DM + 64 * kb) * 12288 + 256 * cb + 4 * C.lane;
#pragma unroll 8
            for (int kk = 0; kk < 64; ++kk) { const f32x4 w = *(const f32x4*)(wp + (size_t)kk * 12288);
                const float s0 = __shfl(sc, kk), s1 = __shfl(sx, kk);
                a0 += w * s0; a1 += w * s1; }
            *(f32x4*)(MODP + ((size_t)((L * 32 + kb) * 2 + 0)) * 12288 + 256 * cb + 4 * C.lane) = a0;
            *(f32x4*)(MODP + ((size_t)((L * 32 + kb) * 2 + 1)) * 12288 + 256 * cb + 4 * C.lane) = a1;
        }
    }
    {
        LAS float* scr = (LAS float*)(C.lds + C.wave * 17408);
        constexpr int J0 = (DM / 64) * (EV_IN / 64), J3 = (DM / 64) * (OD_IN / 64);
        for (int it = C.gw; it < J0 + J3; it += C.ngw) {
            const bool l1 = it >= J0; const int r = l1 ? it - J0 : it; const int N = l1 ? OD_IN : EV_IN; const int nblk = N / 64, kb = r / nblk, nb = r % nblk;
            tr_item64_fp8(p.inp(l1 ? 21 : 8), N, (unsigned char*)(p.ws + (l1 ? WS_WIN1 : WS_WIN0)), DM, 64 * kb, 64 * nb, 64 * nb, scr, C.lane, 32.0f);
        }
        LAS float* scr2 = (LAS float*)(C.lds + C.wave * 17408);
        constexpr int I1 = (DM / 64) * (DM / 32), I2 = (1024 / 64) * (1024 / 32), I4 = I1;
        for (int it = C.gw; it < I1 + I2 + I4; it += C.ngw) {
            int r = it;
            if (r < I1) { tr_dense(p.inp(9), DM, DM, (bf16_t*)(p.ws + WS_WOUT0), r, scr2, C.lane); continue; } r -= I1;
            if (r < I2) { tr_dense(p.inp(19), 1024, 1024, (bf16_t*)(p.ws + WS_WGLU), r, scr2, C.lane); continue; } r -= I2;
            tr_dense(p.inp(22), DM, DM, (bf16_t*)(p.ws + WS_WOUT1), r, scr2, C.lane);
        }
    }
}
__device__ __forceinline__ void phase_p1(const Params& p, Ctx& C) {
    const float* MODP = (const float*)(p.ws + WS_MODP); float* MODF = (float*)(p.ws + WS_MODF); const float* mb = p.inp(5);
    for (int q = C.bid * NTHR + C.tid; q < 2 * 2 * 12288; q += C.G * NTHR) { const int L = q / (2 * 12288), v = (q / 12288) & 1, col = q % 12288;
        float s = mb[L * 12288 + col];
        for (int kb = 0; kb < 32; ++kb) s += MODP[((size_t)((L * 32 + kb) * 2 + v)) * 12288 + col];
        MODF[q] = s; }
}
__device__ __forceinline__ const float* modv(const Params& p, int L, int v, int k) { return (const float*)(p.ws + WS_MODF) + (size_t)(L * 2 + v) * 12288 + k * DM; }

__device__ __forceinline__ void stage_vec(LAS float* dst, const float* src, int tid) { *(LAS f32x4*)(dst + 4 * tid) = *(const f32x4*)(src + 4 * tid); }
__device__ __forceinline__ void conv_item(const Params& p, Ctx& C, int L, int it) {
    LAS float* scr = (LAS float*)(C.lds + C.wave * 17408);
    unsigned char* GU = (unsigned char*)(p.ws + WS_GU) + (size_t)L * NEX1 * 1024 * DM; unsigned char* DT = (unsigned char*)(p.ws + WS_DT) + (size_t)L * NEX1 * DM * EHID;
    const int e = it / 768, r = it % 768, which = r >> 8, q = r & 255;
    if (which < 2) {
        const float* W = (e < 64) ? p.inp(28 + which) + ((size_t)(L * 64 + e)) * DM * EHID : p.inp(31 + which) + (size_t)L * DM * EHID;
        const int kb = q >> 3, nb = q & 7, n0 = 64 * nb;
        tr_item64_fp8(W, EHID, GU + (size_t)e * 1024 * DM, DM, 64 * kb, n0, 256 * (n0 >> 7) + (n0 & 127) + (which ? 128 : 0), scr, C.lane);
    } else {
        const float* W = (e < 64) ? p.inp(30) + ((size_t)(L * 64 + e)) * EHID * DM : p.inp(33) + (size_t)L * EHID * DM;
        const int kb = q >> 5, nb = q & 31;
        tr_item64_fp8(W, DM, DT + (size_t)e * DM * EHID, EHID, 64 * kb, 64 * nb, 64 * nb, scr, C.lane);
    }
}
__device__ __forceinline__ void conv_queue(const Params& p, Ctx& C, int quota) {
    unsigned* head = (unsigned*)(p.ws + WS_CTL) + CW_QUEUE + 128;
    const int batch = quota < 8 ? quota : 8;
    for (int done = 0; done < quota; done += batch) {
        int it0 = 0; if (C.lane == 0) it0 = (int)atomicAdd(head, (unsigned)batch);
        it0 = __builtin_amdgcn_readfirstlane(it0);
        if (it0 >= NEX1 * 768) break;
        for (int k = 0; k < batch && it0 + k < NEX1 * 768; ++k) conv_item(p, C, 1, it0 + k);
    }
}
__device__ __forceinline__ void phase_modulate(const Params& p, Ctx& C, int L) {
    unsigned char* XA8 = (unsigned char*)(p.ws + WS_XA);
    const float* X2 = (const float*)(p.ws + WS_HX2);
    LAS float* MV = (LAS float*)C.lds;
    for (int v = 0; v < 2; ++v) { stage_vec(MV + (v * 2 + 0) * DM, modv(p, L, v, 0), C.tid); stage_vec(MV + (v * 2 + 1) * DM, modv(p, L, v, 1), C.tid); }
    __syncthreads();
    for (int r = C.gw; r < TT; r += C.ngw) {
        const int v = r < CTXL ? 1 : 0;
        const float* src = (L == 0) ? (r < CTXL ? p.inp(2) + (size_t)r * DM : p.inp(0) + (size_t)(r - CTXL) * DM) : X2 + (size_t)r * DM;
        const LAS float* sh = MV + (v * 2 + 0) * DM; const LAS float* sc = MV + (v * 2 + 1) * DM;
#pragma unroll
        for (int j = 0; j < 8; ++j) { const int c = 4 * (C.lane + 64 * j);
            const f32x4 x = *(const f32x4*)(src + c), a = *(const LAS f32x4*)(sc + c), b = *(const LAS f32x4*)(sh + c);
            const f32x4 y = x * (a + 1.0f) + b;
            unsigned w = (unsigned)__builtin_amdgcn_cvt_pk_fp8_f32(y[0], y[1], 0, false); w = (unsigned)__builtin_amdgcn_cvt_pk_fp8_f32(y[2], y[3], (int)w, true);
            *(unsigned*)(XA8 + (size_t)r * DM + c) = w; }
    }
    __syncthreads();
    if (L == 0) { for (int it = C.gw; it < NEX1 * 768; it += C.ngw) conv_item(p, C, 0, it); }
    else conv_queue(p, C, 1 << 30);
}

__device__ __forceinline__ void phase_rope0(const Params& p, Ctx& C) {
    bf16_t* QKV = (bf16_t*)(p.ws + WS_BIG + BG_QKV);
    const f32x2* R128 = (const f32x2*)(p.ws + WS_ROPE128);
    for (int r = C.gw; r < TT; r += C.ngw) {
        bf16_t* row = QKV + (size_t)r * EV_IN;
        if (r < CTXL) {
#pragma unroll
            for (int j = 0; j < 2; ++j) { u32x4* q = (u32x4*)(row + 8 * (C.lane + 64 * j)); u32x4 w = *q;
                w.x = cvt_pk_bf16(bflo(w.x) * 0.0625f, bfhi(w.x) * 0.0625f); w.y = cvt_pk_bf16(bflo(w.y) * 0.0625f, bfhi(w.y) * 0.0625f);
                w.z = cvt_pk_bf16(bflo(w.z) * 0.0625f, bfhi(w.z) * 0.0625f); w.w = cvt_pk_bf16(bflo(w.w) * 0.0625f, bfhi(w.w) * 0.0625f); *q = w; }
        } else {
            const int l = r - CTXL, rp = l >> 6, cp = l & 63;
#pragma unroll
            for (int qk = 0; qk < 2; ++qk)
#pragma unroll
                for (int m = 0; m < 8; ++m) { const int pi = C.lane + 64 * m, head = pi >> 7, blk = (pi >> 6) & 1, i = pi & 63;
                    bf16_t* b = row + qk * 1024 + head * 256 + blk * 128 + i;
                    const f32x2 cs = R128[(blk ? cp : rp) * 64 + i];
                    const float x1 = bf2f(b[0]), x2 = bf2f(b[64]); const float sc = qk ? 1.0f : 0.0625f;
                    b[0] = f2bf((x1 * cs.x - x2 * cs.y) * sc); b[64] = f2bf((x1 * cs.y + x2 * cs.x) * sc); }
        }
    }
}

__device__ __forceinline__ void phase_normrope1(const Params& p, Ctx& C) {
    bf16_t* QKV = (bf16_t*)(p.ws + WS_BIG + BG_QKV);
    const f32x2* R64 = (const f32x2*)(p.ws + WS_ROPE64);
    const float* qg = p.inp(23);
    unsigned* KMAX = (unsigned*)(p.ws + WS_CTL) + CW_KMAX;
    unsigned char* Q8 = (unsigned char*)(p.ws + WS_BIG + BG_Q8); unsigned char* K8 = (unsigned char*)(p.ws + WS_BIG + BG_K8); unsigned char* VT8 = (unsigned char*)(p.ws + WS_BIG + BG_VT8);
    unsigned char* Q8D = (unsigned char*)(p.ws + WS_BIG + BG_Q8D); unsigned char* K8D = (unsigned char*)(p.ws + WS_BIG + BG_K8D); unsigned char* VT8D = (unsigned char*)(p.ws + WS_BIG + BG_VT8D);
    const int lane = C.lane, i32 = lane & 31; const bool up = lane >= 32;
    const float g00 = qg[lane], g01 = qg[64 + lane], g10 = qg[128 + lane], g11 = qg[128 + 64 + lane];
    for (int r = C.gw; r < TT; r += C.ngw) {
        bf16_t* row = QKV + (size_t)r * OD_IN;
        const bool lat = r >= CTXL; const int l = r - CTXL, rp = lat ? (l >> 6) : 0, cp = lat ? (l & 63) : 0;
        const f32x2 cr = R64[rp * 32 + i32], cc = R64[cp * 32 + i32];
#pragma unroll 2
        for (int h = 0; h < 26; ++h) {
            const int col = h < 8 ? 128 * h : (h < 10 ? 1024 + 128 * (h - 8) : (h < 18 ? 1536 + 128 * (h - 10) : 2560 + 128 * (h - 18)));
            bf16_t* b = row + col;
            float v0 = bf2f(b[lane]), v1 = bf2f(b[64 + lane]);
            if (h < 10) { const float ss = wave_sum(v0 * v0 + v1 * v1); const float rs = rsqrtf(ss * (1.0f / 128.0f) + LN_EPS);
                v0 = bf2f(f2bf(v0 * rs)) * (h < 8 ? g00 : g10); v1 = bf2f(f2bf(v1 * rs)) * (h < 8 ? g01 : g11); }
            if (lat) { const float p0 = __shfl_xor(v0, 32), p1 = __shfl_xor(v1, 32);
                v0 = up ? (p0 * cr.y + v0 * cr.x) : (v0 * cr.x - p0 * cr.y);
                v1 = up ? (p1 * cc.y + v1 * cc.x) : (v1 * cc.x - p1 * cc.y); }
            const bf16_t o0 = f2bf(v0), o1 = f2bf(v1);
            b[lane] = o0; b[64 + lane] = o1;
            {
                const float qs = (h < 8 || (h >= 10 && h < 18)) ? 0.088388347648318440f * 1.4426950408889634f : 1.0f;
                const float w0 = bf2f(o0) * qs, w1 = bf2f(o1) * qs;
                float e4[4];
#pragma unroll
                for (int j = 0; j < 4; ++j) { const float a = __shfl(w0, (4 * lane + j) & 63), c2 = __shfl(w1, (4 * lane + j) & 63); e4[j] = lane < 16 ? a : c2; }
                unsigned pk = (unsigned)__builtin_amdgcn_cvt_pk_fp8_f32(e4[0], e4[1], 0, false); pk = (unsigned)__builtin_amdgcn_cvt_pk_fp8_f32(e4[2], e4[3], (int)pk, true);
                unsigned char* dst8 = h < 8 ? Q8 + (size_t)r * 1024 + 128 * h : (h < 10 ? K8 + (size_t)r * 256 + 128 * (h - 8) : (h < 18 ? Q8D + (size_t)r * 1024 + 128 * (h - 10) : K8D + (size_t)r * 1024 + 128 * (h - 18)));
                if (lane < 32) *(unsigned*)(dst8 + 4 * lane) = pk; }
            if ((h >= 8 && h < 10) || h >= 18) {
                const float w0 = bf2f(o0), w1 = bf2f(o1); const float k2 = wave_sum(w0 * w0 + w1 * w1);
                if (lane == 0) atomicMax(KMAX + 64 * (h < 10 ? h - 8 : h - 16), __float_as_uint(k2)); }
        }
    }
    LAS bf16_t* vt = (LAS bf16_t*)(C.lds + C.wave * 17408);
    for (int item = C.gw; item < 10 * 260; item += C.ngw) {
        const int kh = item / 260, T = item % 260;
        const int vcol = kh < 2 ? 1280 + 128 * kh : 3584 + 128 * (kh - 2);
        unsigned char* vout = kh < 2 ? VT8 + (size_t)kh * 260 * 8192 : VT8D + (size_t)(kh - 2) * 260 * 8192;
#pragma unroll
        for (int q = 0; q < 16; ++q) { const int idx = lane + 64 * q, key = idx >> 4, c = idx & 15;
            *(LAS u32x4*)(vt + key * 136 + 8 * c) = *(const u32x4*)(QKV + (size_t)(64 * T + key) * OD_IN + vcol + 8 * c); }
        LDS_WAIT(); asm volatile("" ::: "memory");
#pragma unroll
        for (int dd = 0; dd < 2; ++dd) { const int d = lane + 64 * dd;
            unsigned char* dst = vout + ((size_t)T * 128 + d) * 64;
#pragma unroll
            for (int cch = 0; cch < 4; ++cch) { u32x4 w;
#pragma unroll
                for (int wd = 0; wd < 4; ++wd) { float f[4];
#pragma unroll
                    for (int e = 0; e < 4; ++e) { const int bb = 16 * cch + 4 * wd + e, hi2 = bb >> 5, blk = (bb >> 4) & 1, j = bb & 15; const int key = 32 * blk + (j & 3) + 8 * (j >> 2) + 4 * hi2;
                        f[e] = bf2f(vt[key * 136 + d]); }
                    unsigned pk = (unsigned)__builtin_amdgcn_cvt_pk_fp8_f32(f[0], f[1], 0, false); pk = (unsigned)__builtin_amdgcn_cvt_pk_fp8_f32(f[2], f[3], (int)pk, true);
                    w[wd] = pk; }
                *(u32x4*)(dst + 16 * cch) = w; } }
        LDS_WAIT(); asm volatile("" ::: "memory");
    }
}

__device__ __forceinline__ void phase_merge1(const Params& p, Ctx& C) {
    bf16_t* ATT = (bf16_t*)(p.ws + WS_BIG + BG_ATT);
    const float* dl = p.inp(24); const float* sg = p.inp(25);
    const int lane = C.lane;
    float d0 = dl[lane] * dl[128 + lane] + dl[64 + lane] * dl[128 + 64 + lane];
    float d1 = dl[256 + lane] * dl[384 + lane] + dl[256 + 64 + lane] * dl[384 + 64 + lane];
    const float lam = __expf(wave_sum(d0)) - __expf(wave_sum(d1)) + LAMBDA_INIT;
    const f32x4 gg = *(const f32x4*)(sg + 4 * lane);
    for (int l = C.gw; l < SEQ; l += C.ngw) {
        bf16_t* row = ATT + (size_t)l * 3072;
#pragma unroll
        for (int h = 0; h < 4; ++h) {
            const u32x2 a = *(const u32x2*)(row + 1024 + 256 * h + 4 * lane), b = *(const u32x2*)(row + 2048 + 256 * h + 4 * lane);
            f32x4 o = {bflo(a.x) - lam * bflo(b.x), bfhi(a.x) - lam * bfhi(b.x), bflo(a.y) - lam * bflo(b.y), bfhi(a.y) - lam * bfhi(b.y)};
            const float ss = wave_sum(o[0] * o[0] + o[1] * o[1] + o[2] * o[2] + o[3] * o[3]);
            const float rs = rsqrtf(ss * (1.0f / 256.0f) + LN_EPS) * (1.0f - LAMBDA_INIT);
            o = o * rs * gg;
            u32x2 w; w.x = cvt_pk_bf16(o[0], o[1]); w.y = cvt_pk_bf16(o[2], o[3]);
            *(u32x2*)(row + 1024 + 256 * h + 4 * lane) = w;
        }
    }
}

__device__ __forceinline__ void phase_ln1(const Params& p, Ctx& C, int L) {
    const bf16_t* Y = (const bf16_t*)(p.ws + WS_YMIX); float* X1 = (float*)(p.ws + WS_X1); unsigned char* XA8 = (unsigned char*)(p.ws + WS_XA);
    const float* X2 = (const float*)(p.ws + WS_HX2);
    const float* lg = p.inp(6) + (size_t)(L * 2 + 0) * DM; const float* lb = p.inp(7) + (size_t)(L * 2 + 0) * DM;
    const int r0 = (L == 0) ? 0 : CTXL;
    LAS float* MV = (LAS float*)C.lds; LAS float* LG = MV + 6 * DM; LAS float* LB = LG + DM;
    for (int v = 0; v < 2; ++v) for (int k = 0; k < 3; ++k) stage_vec(MV + (v * 3 + k) * DM, modv(p, L, v, 2 + k), C.tid);
    stage_vec(LG, lg, C.tid); stage_vec(LB, lb, C.tid);
    __syncthreads();
    for (int r = r0 + C.gw; r < TT; r += C.ngw) {
        const int v = r < CTXL ? 1 : 0;
        const float* src = (L == 0) ? (r < CTXL ? p.inp(2) + (size_t)r * DM : p.inp(0) + (size_t)(r - CTXL) * DM) : X2 + (size_t)r * DM;
        const LAS float* g1 = MV + (v * 3 + 0) * DM; const LAS float* sh2 = MV + (v * 3 + 1) * DM; const LAS float* sc2 = MV + (v * 3 + 2) * DM;
        f32x4 t[8]; float s = 0.f;
#pragma unroll
        for (int j = 0; j < 8; ++j) { const int c = 4 * (C.lane + 64 * j);
            const f32x4 x = *(const f32x4*)(src + c), g = *(const LAS f32x4*)(g1 + c); const u32x2 yy = *(const u32x2*)(Y + (size_t)r * DM + c);
            const f32x4 y = {bflo(yy.x), bfhi(yy.x), bflo(yy.y), bfhi(yy.y)};
            t[j] = x * ALPHA + g * y; s += (t[j][0] + t[j][1]) + (t[j][2] + t[j][3]); }
        const float mean = wave_sum(s) * (1.0f / DM); float s2 = 0.f;
#pragma unroll
        for (int j = 0; j < 8; ++j) { t[j] = t[j] - mean; s2 += (t[j][0] * t[j][0] + t[j][1] * t[j][1]) + (t[j][2] * t[j][2] + t[j][3] * t[j][3]); }
        const float rstd = rsqrtf(wave_sum(s2) * (1.0f / DM) + LN_EPS);
#pragma unroll
        for (int j = 0; j < 8; ++j) { const int c = 4 * (C.lane + 64 * j);
            const f32x4 x1 = t[j] * rstd * *(const LAS f32x4*)(LG + c) + *(const LAS f32x4*)(LB + c);
            *(f32x4*)(X1 + (size_t)r * DM + c) = x1;
            const f32x4 z = x1 * (*(const LAS f32x4*)(sc2 + c) + 1.0f) + *(const LAS f32x4*)(sh2 + c);
            unsigned w = (unsigned)__builtin_amdgcn_cvt_pk_fp8_f32(z[0], z[1], 0, false); w = (unsigned)__builtin_amdgcn_cvt_pk_fp8_f32(z[2], z[3], (int)w, true);
            *(unsigned*)(XA8 + (size_t)r * DM + c) = w; }
    }
    __syncthreads();
}

__device__ __forceinline__ void phase_combine(const Params& p, Ctx& C, int L, LAS unsigned char* misc) {
    const unsigned char* YM = (const unsigned char*)(p.ws + WS_BIG + BG_YMOE); const float* X1 = (const float*)(p.ws + WS_X1);
    float* X2 = (float*)(p.ws + WS_HX2);
    const float* lg = p.inp(6) + (size_t)(L * 2 + 1) * DM; const float* lb = p.inp(7) + (size_t)(L * 2 + 1) * DM;
    const unsigned* PK = (const unsigned*)(p.ws + WS_WGT); const int* cnt = (const int*)(p.ws + WS_CTL) + CW_CNT + L * 128; const float* LWT = (const float*)(p.ws + WS_LW);
    const int r0 = (L == 0) ? 0 : CTXL;
    LAS int* rb = (LAS int*)(misc + 64);
    LAS float* MV = (LAS float*)C.lds; LAS float* LG = MV + 2 * DM; LAS float* LB = LG + DM;
    __syncthreads();
    if (C.tid == 0) { int q = 0; for (int e = 0; e < NEX1; ++e) { rb[e] = q; q += cnt[e]; } }
    stage_vec(MV, modv(p, L, 0, 5), C.tid); stage_vec(MV + DM, modv(p, L, 1, 5), C.tid); stage_vec(LG, lg, C.tid); stage_vec(LB, lb, C.tid);
    LAS float* M1 = LB + DM;
    unsigned char* XA8 = (unsigned char*)(p.ws + WS_XA);
    if (L == 0) { for (int v = 0; v < 2; ++v) { stage_vec(M1 + (v * 2 + 0) * DM, modv(p, 1, v, 0), C.tid); stage_vec(M1 + (v * 2 + 1) * DM, modv(p, 1, v, 1), C.tid); } }
    __syncthreads();
    for (int r = r0 + C.gw; r < TT; r += C.ngw) {
        const int v = r < CTXL ? 1 : 0;
        const LAS float* g2 = MV + v * DM;
        int ln = C.lane; asm volatile("" : "+v"(ln));
        int slot = rb[64] + (r - r0);
        float wk = 4.0f;
        if (ln < 8) { const unsigned pk = PK[(size_t)r * 8 + ln]; wk = LWT[(size_t)r * 8 + ln]; slot = rb[pk >> 16] + (int)(pk & 0xffffu); }
        f32x4 t[2][4]; float s = 0.f;
#pragma unroll
        for (int j = 0; j < 2; ++j) { const int c = 16 * (ln + 64 * j);
            u32x4 yy[9];
#pragma unroll
            for (int k = 0; k < 9; ++k) { const size_t a = (size_t)__builtin_amdgcn_readlane(slot, k); yy[k] = __builtin_nontemporal_load((const u32x4*)(YM + a * DM + c)); }
            f32x2 f[8];
#pragma unroll
            for (int q = 0; q < 8; ++q) f[q] = (f32x2){0.f, 0.f};
#pragma unroll
            for (int k = 0; k < 9; ++k) { const float wq = __int_as_float(__builtin_amdgcn_readlane(__float_as_int(wk), k));
                f[0] += wq * __builtin_amdgcn_cvt_pk_f32_fp8((int)yy[k].x, false); f[1] += wq * __builtin_amdgcn_cvt_pk_f32_fp8((int)yy[k].x, true);
                f[2] += wq * __builtin_amdgcn_cvt_pk_f32_fp8((int)yy[k].y, false); f[3] += wq * __builtin_amdgcn_cvt_pk_f32_fp8((int)yy[k].y, true);
                f[4] += wq * __builtin_amdgcn_cvt_pk_f32_fp8((int)yy[k].z, false); f[5] += wq * __builtin_amdgcn_cvt_pk_f32_fp8((int)yy[k].z, true);
                f[6] += wq * __builtin_amdgcn_cvt_pk_f32_fp8((int)yy[k].w, false); f[7] += wq * __builtin_amdgcn_cvt_pk_f32_fp8((int)yy[k].w, true); }
#pragma unroll
            for (int q = 0; q < 4; ++q) { const f32x4 x = *(const f32x4*)(X1 + (size_t)r * DM + c + 4 * q), g = *(const LAS f32x4*)(g2 + c + 4 * q);
                const f32x4 ff = {f[2 * q][0], f[2 * q][1], f[2 * q + 1][0], f[2 * q + 1][1]};
                t[j][q] = x * ALPHA + g * ff; s += (t[j][q][0] + t[j][q][1]) + (t[j][q][2] + t[j][q][3]); } }
        const float mean = wave_sum(s) * (1.0f / DM); float s2 = 0.f;
#pragma unroll
        for (int j = 0; j < 2; ++j)
#pragma unroll
            for (int q = 0; q < 4; ++q) { t[j][q] = t[j][q] - mean; s2 += (t[j][q][0] * t[j][q][0] + t[j][q][1] * t[j][q][1]) + (t[j][q][2] * t[j][q][2] + t[j][q][3] * t[j][q][3]); }
        const float rstd = rsqrtf(wave_sum(s2) * (1.0f / DM) + LN_EPS);
        float* dst = (L == 0) ? X2 + (size_t)r * DM : p.out + (size_t)(r - CTXL) * DM;
#pragma unroll
        for (int j = 0; j < 2; ++j)
#pragma unroll
            for (int q = 0; q < 4; ++q) { const int c = 16 * (ln + 64 * j) + 4 * q;
                const f32x4 xn = t[j][q] * rstd * *(const LAS f32x4*)(LG + c) + *(const LAS f32x4*)(LB + c);
                *(f32x4*)(dst + c) = xn;
                if (L == 0) { const f32x4 y = xn * (*(const LAS f32x4*)(M1 + (v * 2 + 1) * DM + c) + 1.0f) + *(const LAS f32x4*)(M1 + (v * 2 + 0) * DM + c);
                    unsigned w = (unsigned)__builtin_amdgcn_cvt_pk_fp8_f32(y[0], y[1], 0, false); w = (unsigned)__builtin_amdgcn_cvt_pk_fp8_f32(y[2], y[3], (int)w, true);
                    *(unsigned*)(XA8 + (size_t)r * DM + c) = w; } }
    }
    if (L == 0) { __syncthreads(); conv_queue(p, C, 1 << 30); }
}
constexpr int RLD = 264;
constexpr int SLD = 136;

template <bool SCALE>
__device__ __forceinline__ void stage_chunk(const bf16_t* QKV, int row0, int col0, LAS bf16_t* dst, int tid, float lg  , int dirb) {
#pragma unroll
    for (int q = 0; q < 8; ++q) { const int idx = tid + NTHR * q, r = idx >> 5, c = idx & 31;
        u32x4 w = *(const u32x4*)(QKV + (size_t)(row0 + r) * EV_IN + col0 + 8 * c);
        if (SCALE) { const float sc = fast_exp((dirb ? (float)r : (float)(127 - r)) * lg);
            w.x = cvt_pk_bf16(bflo(w.x) * sc, bfhi(w.x) * sc); w.y = cvt_pk_bf16(bflo(w.y) * sc, bfhi(w.y) * sc);
            w.z = cvt_pk_bf16(bflo(w.z) * sc, bfhi(w.z) * sc); w.w = cvt_pk_bf16(bflo(w.w) * sc, bfhi(w.w) * sc); }
        *(LAS u32x4*)(dst + r * RLD + 8 * c) = w; }
}

__device__ __forceinline__ void ret_chunk_kv(const Params& p, Ctx& C) {
    const bf16_t* QKV = (const bf16_t*)(p.ws + WS_BIG + BG_QKV); bf16_t* CKV = (bf16_t*)(p.ws + WS_BIG + BG_CKV);
    const float* rld = p.inp(10);
    LAS bf16_t* Vs = (LAS bf16_t*)C.lds; LAS bf16_t* Ks = Vs + 128 * RLD;
    const int lane = C.lane, w = C.wave;
    for (int unit = C.bid; unit < 130 * 8; unit += C.G) {
        const int u = unit >> 3, h = (unit >> 1) & 3, dir = unit & 1;
        const float lg = rld[dir * 4 + h];
        __syncthreads();
        stage_chunk<false>(QKV, 128 * u, 2048 + 256 * h, Vs, C.tid, 0.f, 0);
        stage_chunk<true>(QKV, 128 * u, 1024 + 256 * h, Ks, C.tid, lg, dir);
        __syncthreads();
        f32x4 acc[2][16];
#pragma unroll
        for (int a = 0; a < 2; ++a)
#pragma unroll
            for (int b = 0; b < 16; ++b) acc[a][b] = (f32x4){0.f, 0.f, 0.f, 0.f};
        const unsigned vbase = (unsigned)(uintptr_t)Vs, kbase = (unsigned)(uintptr_t)Ks;
#pragma unroll 1
        for (int ks = 0; ks < 4; ++ks) {
            bf16x8 af[2];
#pragma unroll
            for (int a = 0; a < 2; ++a) af[a] = frag_colk_l(vbase + (unsigned)((32 * ks) * RLD + 32 * w + 16 * a) * 2u, RLD * 2, lane);
#pragma unroll
            for (int b = 0; b < 16; ++b) { const bf16x8 bf = frag_colk_l(kbase + (unsigned)((32 * ks) * RLD + 16 * b) * 2u, RLD * 2, lane);
                acc[0][b] = MFMA16(bf, af[0], acc[0][b]); acc[1][b] = MFMA16(bf, af[1], acc[1][b]); }
        }
        bf16_t* dst = CKV + ((size_t)((dir * 4 + h) * 130 + u)) * 65536;
#pragma unroll
        for (int a = 0; a < 2; ++a)
#pragma unroll
            for (int b = 0; b < 16; ++b) { u32x2 w2; w2.x = cvt_pk_bf16(acc[a][b][0], acc[a][b][1]); w2.y = cvt_pk_bf16(acc[a][b][2], acc[a][b][3]);
                *(u32x2*)(dst + (size_t)(32 * w + 16 * a + (lane & 15)) * 256 + 16 * b + 4 * (lane >> 4)) = w2; }
    }
    __syncthreads();
}

__device__ __forceinline__ int s5_row(int dir, int c, int s) { return dir == 0 ? 64 * c + s : (c < 4 ? 255 - (64 * c + s) : 16639 - 64 * (c - 4) - s); }

__device__ __forceinline__ void s5_end_states(const Params& p, Ctx& C) {
    const bf16_t* QKV = (const bf16_t*)(p.ws + WS_BIG + BG_QKV); const bf16_t* BBT = (const bf16_t*)(p.ws + WS_BBT); float* E = (float*)(p.ws + WS_S5E);
    const float* APOW = (const float*)(p.ws + WS_APOW);
    LAS f32x2* PL = (LAS f32x2*)C.lds;
    for (int bt = C.bid; bt < 256; bt += C.G) {
        int tid = C.tid; asm volatile("" : "+v"(tid));
        const int lane = tid & 63, r32 = lane & 31, hi = lane >> 5;
        const int dg = bt >> 1, dir = dg >> 6, g = dg & 63, c0 = 130 * (bt & 1);
        __syncthreads();
#pragma unroll
        for (int q = 0; q < 8; ++q) { const int idx = tid + NTHR * q, s = idx >> 6, pp = idx & 63;
            PL[idx] = (s == 63) ? (f32x2){1.0f, 0.0f} : *(const f32x2*)(APOW + ((size_t)dg * 64 + (62 - s)) * 128 + 2 * pp); }
        __syncthreads();
        bf16x8 bfr[4];
#pragma unroll
        for (int pt = 0; pt < 4; ++pt) bfr[pt] = *(const bf16x8*)(BBT + ((size_t)dg * 128 + 32 * pt + r32) * 16 + 8 * hi);
        for (int c = c0 + C.wave; c < c0 + 130; c += 8) {
            float er[2] = {0.f, 0.f}, ei[2] = {0.f, 0.f};
#pragma unroll
            for (int st = 0; st < 2; ++st) {
                const bf16x8 a = *(const bf16x8*)(QKV + (size_t)s5_row(dir, c, 32 * st + r32) * EV_IN + 4096 + 16 * g + 8 * hi);
                f32x16 d[4];
#pragma unroll
                for (int pt = 0; pt < 4; ++pt) d[pt] = __builtin_amdgcn_mfma_f32_32x32x16_bf16(a, bfr[pt], (f32x16){}, 0, 0, 0);
#pragma unroll
                for (int r = 0; r < 16; ++r) { const int s = 32 * st + (r & 3) + 8 * (r >> 2) + 4 * hi;
#pragma unroll
                    for (int pt = 0; pt < 2; ++pt) { const f32x2 pw = PL[s * 64 + 32 * pt + r32]; const float br = d[pt][r], bi = d[pt + 2][r];
                        er[pt] += pw.x * br - pw.y * bi; ei[pt] += pw.x * bi + pw.y * br; } }
            }
#pragma unroll
            for (int pt = 0; pt < 2; ++pt) {
                { auto rr = __builtin_amdgcn_permlane32_swap(__float_as_uint(er[pt]), __float_as_uint(er[pt]), false, false); er[pt] = __uint_as_float(rr[0]) + __uint_as_float(rr[1]); }
                { auto rr = __builtin_amdgcn_permlane32_swap(__float_as_uint(ei[pt]), __float_as_uint(ei[pt]), false, false); ei[pt] = __uint_as_float(rr[0]) + __uint_as_float(rr[1]); }
            }
            float* dst = E + ((size_t)dg * 260 + c) * 128;
            if (hi == 0) { dst[r32] = er[0]; dst[32 + r32] = er[1]; dst[64 + r32] = ei[0]; dst[96 + r32] = ei[1]; }
        }
    }
    __syncthreads();
}

__device__ __forceinline__ void phase_scans(const Params& p, Ctx& C) {
    const bf16_t* CKV = (const bf16_t*)(p.ws + WS_BIG + BG_CKV); bf16_t* SP = (bf16_t*)(p.ws + WS_BIG + BG_SPREV);
    const float* rld = p.inp(10);
    for (int q = C.bid * NTHR + C.tid; q < 8 * 16384; q += C.G * NTHR) {
        const int dh = q >> 14, el = (q & 16383) * 4, dir = dh >> 2, h = dh & 3;
        const float gch = fast_exp(128.0f * rld[dir * 4 + h]);
        const bf16_t* src = CKV + (size_t)dh * 130 * 65536 + el; bf16_t* dst = SP + (size_t)dh * 130 * 65536 + el;
        f32x4 s = {0.f, 0.f, 0.f, 0.f};
        for (int st0 = 0; st0 < 130; st0 += 13) {
            u32x2 kv[13];
#pragma unroll
            for (int k = 0; k < 13; ++k) { const int st = st0 + k; const int u = dir == 0 ? st : (st == 0 ? 1 : (st == 1 ? 0 : 131 - st)); kv[k] = __builtin_nontemporal_load((const u32x2*)(src + (size_t)u * 65536)); }
#pragma unroll
            for (int k = 0; k < 13; ++k) { const int st = st0 + k; const int u = dir == 0 ? st : (st == 0 ? 1 : (st == 1 ? 0 : 131 - st));
                u32x2 w; w.x = cvt_pk_bf16(s[0], s[1]); w.y = cvt_pk_bf16(s[2], s[3]); *(u32x2*)(dst + (size_t)u * 65536) = w;
                s = s * gch + (f32x4){bflo(kv[k].x), bfhi(kv[k].x), bflo(kv[k].y), bfhi(kv[k].y)}; }
        }
    }
    const float* E = (const float*)(p.ws + WS_S5E); float* HST = (float*)(p.ws + WS_HST); const float* AL = (const float*)(p.ws + WS_AL);
    for (int q = C.bid * NTHR + C.tid; q < 2 * 64 * 64; q += C.G * NTHR) {
        const int dg = q >> 6, pp = q & 63;
        const f32x2 al = *(const f32x2*)(AL + (size_t)dg * 128 + 2 * pp);
        const float* e = E + (size_t)dg * 260 * 128; float* hs = HST + (size_t)dg * 260 * 128;
        float hr = 0.f, hi = 0.f;
        for (int c0 = 0; c0 < 260; c0 += 26) {
            float er[26], ei[26];
#pragma unroll
            for (int k = 0; k < 26; ++k) { er[k] = e[(size_t)(c0 + k) * 128 + pp]; ei[k] = e[(size_t)(c0 + k) * 128 + 64 + pp]; }
#pragma unroll
            for (int k = 0; k < 26; ++k) { *(f32x2*)(hs + (size_t)(c0 + k) * 128 + 2 * pp) = (f32x2){hr, hi};
                const float t = al.x * hr - al.y * hi + er[k]; hi = al.x * hi + al.y * hr + ei[k]; hr = t; }
        }
    }
}

__device__ __forceinline__ void ret_output_unit(const Params& p, Ctx& C, int unit) {
    const bf16_t* QKV = (const bf16_t*)(p.ws + WS_BIG + BG_QKV); const bf16_t* SP = (const bf16_t*)(p.ws + WS_BIG + BG_SPREV);
    bf16_t* MIX = (bf16_t*)(p.ws + WS_BIG + BG_MIX);
    const float* rld = p.inp(10);
    LAS bf16_t* RA = (LAS bf16_t*)C.lds; LAS bf16_t* RB = RA + 128 * RLD;
    int tid = C.tid; asm volatile("" : "+v"(tid));
    const int lane = tid & 63, w = C.wave, kq = lane >> 4, fr = lane & 15;
    const int u = unit >> 2, h = unit & 3;
    const float lgf = rld[h], lgb = rld[4 + h];
    stage_chunk<false>(QKV, 128 * u, 256 * h, RA, tid, 0.f, 0);
    int ib = 16 * w + 4 * kq, jb = fr; asm volatile("" : "+v"(ib), "+v"(jb));
    f32x4 acc[16];
#pragma unroll
    for (int t = 0; t < 16; ++t) acc[t] = (f32x4){0.f, 0.f, 0.f, 0.f};
#pragma unroll
    for (int dir = 0; dir < 2; ++dir) {
        const bf16_t* Sd = SP + ((size_t)((dir * 4 + h) * 130 + u)) * 65536;
#pragma unroll
        for (int eh = 0; eh < 2; ++eh) {
            __syncthreads();
#pragma unroll
            for (int q = 0; q < 8; ++q) { const int idx = tid + NTHR * q, rr = idx >> 5, c = idx & 31;
                *(LAS u32x4*)(RB + rr * RLD + 8 * c) = *(const u32x4*)(Sd + (size_t)(128 * eh + rr) * 256 + 8 * c);
                if (q == 3) asm volatile("" ::: "memory"); }
            __syncthreads();
#pragma unroll 1
            for (int ks = 0; ks < 8; ++ks) { const bf16x8 af = frag_rowk_l(RA + (16 * w) * RLD + 32 * ks, RLD, lane);
#pragma unroll
                for (int t = 0; t < 8; ++t) { const bf16x8 bf = frag_rowk_l(RB + (16 * t) * RLD + 32 * ks, RLD, lane); acc[8 * eh + t] = MFMA16(af, bf, acc[8 * eh + t]); } }
        }
#pragma unroll
        for (int r = 0; r < 4; ++r) { const int i = ib + r; const float qd = fast_exp((float)(128 - i) * lgb);
            const float f = (dir == 0) ? fast_exp((float)(i + 1) * lgf) / qd : qd;
#pragma unroll
            for (int t = 0; t < 16; ++t) acc[t][r] *= f; }
    }
    __syncthreads();
    stage_chunk<false>(QKV, 128 * u, 1024 + 256 * h, RB, tid, 0.f, 0);
    __syncthreads();
    f32x4 sc[8];
#pragma unroll
    for (int t = 0; t < 8; ++t) sc[t] = (f32x4){0.f, 0.f, 0.f, 0.f};
#pragma unroll 1
    for (int ks = 0; ks < 8; ++ks) { const bf16x8 af = frag_rowk_l(RA + (16 * w) * RLD + 32 * ks, RLD, lane);
#pragma unroll
        for (int t = 0; t < 8; ++t) { const bf16x8 bf = frag_rowk_l(RB + (16 * t) * RLD + 32 * ks, RLD, lane); sc[t] = MFMA16(af, bf, sc[t]); } }
#pragma unroll
    for (int t = 0; t < 8; ++t)
#pragma unroll
        for (int r = 0; r < 4; ++r) { const int i = ib + r, j = 16 * t + jb; const float d = (float)(i - j);
            const float m = (i >= j ? fast_exp(d * lgf) : 0.f) + (j >= i ? fast_exp(-d * lgb) : 0.f); sc[t][r] *= m; }
    __syncthreads();
    stage_chunk<false>(QKV, 128 * u, 2048 + 256 * h, RA, tid, 0.f, 0);
#pragma unroll
    for (int t = 0; t < 8; ++t)
#pragma unroll
        for (int r = 0; r < 4; ++r) RB[(16 * w + 4 * kq + r) * SLD + 16 * t + fr] = f2bf(sc[t][r]);
    __syncthreads();
    const unsigned vbase = (unsigned)(uintptr_t)RA;
#pragma unroll 1
    for (int ks = 0; ks < 4; ++ks) { const bf16x8 af = frag_rowk_l(RB + (16 * w) * SLD + 32 * ks, SLD, lane);
#pragma unroll
        for (int t = 0; t < 16; ++t) { const bf16x8 bf = frag_colk_l(vbase + (unsigned)((32 * ks) * RLD + 16 * t) * 2u, RLD * 2, lane); acc[t] = MFMA16(af, bf, acc[t]); } }
    __syncthreads();
#pragma unroll
    for (int r = 0; r < 4; ++r) {
        float s = 0.f;
#pragma unroll
        for (int t = 0; t < 16; ++t) s += acc[t][r];
        s += __shfl_xor(s, 1); s += __shfl_xor(s, 2); s += __shfl_xor(s, 4); s += __shfl_xor(s, 8);
        const float mean = s * (1.0f / 256.0f); float q = 0.f;
#pragma unroll
        for (int t = 0; t < 16; ++t) { const float d = acc[t][r] - mean; q += d * d; }
        q += __shfl_xor(q, 1); q += __shfl_xor(q, 2); q += __shfl_xor(q, 4); q += __shfl_xor(q, 8);
        const float rstd = rsqrtf(q * (1.0f / 256.0f) + LN_EPS);
#pragma unroll
        for (int t = 0; t < 16; ++t) RA[(16 * w + 4 * kq + r) * RLD + 16 * t + fr] = f2bf((acc[t][r] - mean) * rstd);
    }
    __syncthreads();
#pragma unroll
    for (int q = 0; q < 8; ++q) { const int idx = tid + NTHR * q, rr = idx >> 5, c = idx & 31; const size_t row = (size_t)(128 * u + rr);
        const u32x4 o = *(const LAS u32x4*)(RA + rr * RLD + 8 * c), g = *(const u32x4*)(QKV + row * EV_IN + 3072 + 256 * h + 8 * c);
        u32x4 w4;
        w4.x = cvt_pk_bf16(bflo(o.x) * siluf_(bflo(g.x)), bfhi(o.x) * siluf_(bfhi(g.x))); w4.y = cvt_pk_bf16(bflo(o.y) * siluf_(bflo(g.y)), bfhi(o.y) * siluf_(bfhi(g.y)));
        w4.z = cvt_pk_bf16(bflo(o.z) * siluf_(bflo(g.z)), bfhi(o.z) * siluf_(bfhi(g.z))); w4.w = cvt_pk_bf16(bflo(o.w) * siluf_(bflo(g.w)), bfhi(o.w) * siluf_(bfhi(g.w)));
        *(u32x4*)(MIX + row * DM + 256 * h + 8 * c) = w4; }
    __syncthreads();
}

constexpr int KLD = 1032;
__device__ __forceinline__ void s5_output_task(const Params& p, Ctx& C, int bt) {
    const bf16_t* QKV = (const bf16_t*)(p.ws + WS_BIG + BG_QKV); bf16_t* Z = (bf16_t*)(p.ws + WS_Z);
    const bf16_t* KN = (const bf16_t*)(p.ws + WS_KN); const bf16_t* CCt = (const bf16_t*)(p.ws + WS_CC);
    const float* APOW = (const float*)(p.ws + WS_APOW); const float* HST = (const float*)(p.ws + WS_HST); const float* dsk = p.inp(18);
    int tid = C.tid; asm volatile("" : "+v"(tid));
    const int lane = tid & 63, kq = lane >> 4, fr = lane & 15;
    LAS bf16_t* KF = (LAS bf16_t*)C.lds; LAS bf16_t* KB = KF + 16 * KLD;
    LAS bf16_t* U = KB + 16 * KLD + C.wave * 3072;
    LAS float* PW0 = (LAS float*)(KB + 16 * KLD + 8 * 3072);
    LAS float* PW16 = PW0 + 2 * 16 * 128;
    {
        const int g = bt >> 3, k0 = (260 * (bt & 7)) >> 3, k1 = (260 * ((bt & 7) + 1)) >> 3;
#pragma unroll
        for (int q = 0; q < 8; ++q) { const int idx = tid + NTHR * q, dir = idx >> 11, rr = (idx >> 7) & 15, c = idx & 127;
            *(LAS u32x4*)((dir ? KB : KF) + rr * KLD + 8 * c) = *(const u32x4*)(KN + ((size_t)(dir * 64 + g) * 16 + rr) * 1024 + 8 * c); }
        for (int q = lane; q < 192 * 2; q += 64) *(LAS u32x4*)(U + 8 * q) = (u32x4){0u, 0u, 0u, 0u};
#pragma unroll
        for (int q = 0; q < 2; ++q) { const int idx = tid + NTHR * q, dir = idx >> 9, f = (idx >> 5) & 15, c4 = idx & 31;
            *(LAS f32x4*)(PW0 + dir * 2048 + f * 128 + 4 * c4) = *(const f32x4*)(APOW + ((size_t)(dir * 64 + g) * 64 + (dir == 0 ? f : 15 - f)) * 128 + 4 * c4); }
        if (tid < 64) { const int dir = tid >> 5, c4 = tid & 31; *(LAS f32x4*)(PW16 + dir * 128 + 4 * c4) = *(const f32x4*)(APOW + ((size_t)(dir * 64 + g) * 64 + 15) * 128 + 4 * c4); }
        __syncthreads();
        const f32x4 dv = *(const f32x4*)(dsk + 16 * g + 4 * kq);
        bf16x8 ccr[2], cci[2];
#pragma unroll
        for (int hb = 0; hb < 2; ++hb) { ccr[hb] = frag_rowk_g(CCt + (size_t)g * 16 * 128 + 32 * hb, 128, lane); cci[hb] = frag_rowk_g(CCt + (size_t)g * 16 * 128 + 64 + 32 * hb, 128, lane); }
        const LAS float* pw0l = PW0 + (size_t)fr * 128 + 16 * kq;
        const LAS float* pw16l = PW16 + 16 * kq;
        for (int k = k0 + C.wave; k < k1; k += 8) {
            LDS_WAIT(); asm volatile("" ::: "memory");
            for (int q = lane; q < 128; q += 64) { const int t = q >> 1, hf = q & 1;
                *(LAS u32x4*)(U + (64 + t) * 16 + 8 * hf) = *(const u32x4*)(QKV + (size_t)(64 * k + t) * EV_IN + 4096 + 16 * g + 8 * hf); }
            LDS_WAIT(); asm volatile("" ::: "memory");
            const int cf = k, cb = k < 4 ? 3 - k : 263 - k;
            f32x4 acc[4];
#pragma unroll
            for (int tt = 0; tt < 4; ++tt) acc[tt] = (f32x4){0.f, 0.f, 0.f, 0.f};
            const LAS bf16_t* ubf = U + (64 + fr - (kq >> 1)) * 16 + 8 * (kq & 1);
            const LAS bf16_t* ubb = U + (64 + fr + (kq >> 1)) * 16 + 8 * (kq & 1);
#pragma unroll
            for (int n0 = 0; n0 < 64; n0 += 2) {
                const bf16x8 af = frag_rowk_l(KF + n0 * 16, KLD, lane), ab = frag_rowk_l(KB + n0 * 16, KLD, lane);
#pragma unroll
                for (int tt = 0; tt < 4; ++tt) {
                    if (n0 <= 16 * tt + 14) acc[tt] = MFMA16(af, *(const LAS bf16x8*)(ubf + (16 * tt - n0) * 16), acc[tt]);
                    if (n0 <= 62 - 16 * tt) acc[tt] = MFMA16(ab, *(const LAS bf16x8*)(ubb + (16 * tt + n0) * 16), acc[tt]);
                }
                asm volatile("" ::: "memory");
            }
#pragma unroll
            for (int dir = 0; dir < 2; ++dir) {
                const float* hp = HST + ((size_t)(dir * 64 + g) * 260 + (dir == 0 ? cf : cb)) * 128;
#pragma unroll
                for (int hb = 0; hb < 2; ++hb) {
                    float xr[8], xi[8];
#pragma unroll
                    for (int e2 = 0; e2 < 4; ++e2) { const f32x4 h4 = *(const f32x4*)(hp + 2 * (32 * hb + 8 * kq) + 4 * e2), b4 = *(const LAS f32x4*)(pw0l + dir * 2048 + hb * 64 + 4 * e2);
                        xr[2 * e2] = b4[0] * h4[0] - b4[1] * h4[1]; xi[2 * e2] = b4[0] * h4[1] + b4[1] * h4[0];
                        xr[2 * e2 + 1] = b4[2] * h4[2] - b4[3] * h4[3]; xi[2 * e2 + 1] = b4[2] * h4[3] + b4[3] * h4[2]; }
#pragma unroll
                    for (int st = 0; st < 4; ++st) {
                        const int tt = dir == 0 ? st : 3 - st;
                        u32x4 br, bi;
                        br.x = cvt_pk_bf16(xr[0], xr[1]); br.y = cvt_pk_bf16(xr[2], xr[3]); br.z = cvt_pk_bf16(xr[4], xr[5]); br.w = cvt_pk_bf16(xr[6], xr[7]);
                        bi.x = cvt_pk_bf16(xi[0], xi[1]); bi.y = cvt_pk_bf16(xi[2], xi[3]); bi.z = cvt_pk_bf16(xi[4], xi[5]); bi.w = cvt_pk_bf16(xi[6], xi[7]);
                        acc[tt] = MFMA16(ccr[hb], __builtin_bit_cast(bf16x8, br), acc[tt]);
                        acc[tt] = MFMA16(cci[hb], __builtin_bit_cast(bf16x8, bi), acc[tt]);
                        if (st < 3) {
#pragma unroll
                            for (int e2 = 0; e2 < 4; ++e2) { const f32x4 a4 = *(const LAS f32x4*)(pw16l + dir * 128 + hb * 64 + 4 * e2);
                                float t0 = xr[2 * e2] * a4[0] - xi[2 * e2] * a4[1]; xi[2 * e2] = xr[2 * e2] * a4[1] + xi[2 * e2] * a4[0]; xr[2 * e2] = t0;
                                t0 = xr[2 * e2 + 1] * a4[2] - xi[2 * e2 + 1] * a4[3]; xi[2 * e2 + 1] = xr[2 * e2 + 1] * a4[3] + xi[2 * e2 + 1] * a4[2]; xr[2 * e2 + 1] = t0; }
                        }
                    }
                }
            }
#pragma unroll
            for (int tt = 0; tt < 4; ++tt) { const int t = 16 * tt + fr;
                const u32x2 uu = *(const LAS u32x2*)(U + (64 + t) * 16 + 4 * kq);
                const float y0 = acc[tt][0] + bflo(uu.x) * dv[0], y1 = acc[tt][1] + bfhi(uu.x) * dv[1], y2 = acc[tt][2] + bflo(uu.y) * dv[2], y3 = acc[tt][3] + bfhi(uu.y) * dv[3];
                u32x2 w; w.x = cvt_pk_bf16(gelu_tanh(y0), gelu_tanh(y1)); w.y = cvt_pk_bf16(gelu_tanh(y2), gelu_tanh(y3));
                *(u32x2*)(Z + (size_t)(64 * k + t) * 1024 + 16 * g + 4 * kq) = w; }
        }
    }
    __syncthreads();
}

__device__ __forceinline__ void phase_ret_s5_outputs(const Params& p, Ctx& C, LAS unsigned char* misc) {
    unsigned* head = (unsigned*)(p.ws + WS_CTL) + CW_QUEUE;
    volatile LAS int* slot = (volatile LAS int*)(misc + 32);
    for (;;) {
        __syncthreads();
        if (C.tid == 0) slot[0] = (int)atomicAdd(head, 1u);
        __syncthreads();
        const int item = __builtin_amdgcn_readfirstlane(slot[0]);
        if (item >= 520) break;
        ret_output_unit(p, C, item);
    }
    for (;;) {
        __syncthreads();
        if (C.tid == 0) slot[0] = (int)atomicAdd(head + 64, 1u);
        __syncthreads();
        const int item = __builtin_amdgcn_readfirstlane(slot[0]);
        if (item >= 512) break;
        s5_output_task(p, C, item);
    }
}
__device__ __forceinline__ void phase_router(const Params& p, Ctx& C, int L) {
    const float* X1 = (const float*)(p.ws + WS_X1);
    const bf16_t* RWh = (const bf16_t*)(p.ws + WS_RWT) + (size_t)(L * 2 + 0) * 64 * DM; const bf16_t* RWl = (const bf16_t*)(p.ws + WS_RWT) + (size_t)(L * 2 + 1) * 64 * DM;
    const float* rbias = p.inp(27) + L * 64;
    int* cnt = (int*)(p.ws + WS_CTL) + CW_CNT + L * 128; int* LIST = (int*)(p.ws + WS_LIST); unsigned* PK = (unsigned*)(p.ws + WS_WGT); float* LW = (float*)(p.ws + WS_LW);
    const int lane = C.lane, kq = lane >> 4, fr = lane & 15;
    LAS float* Lw = (LAS float*)(C.lds + C.wave * 16640);
    const int r0 = (L == 0) ? 0 : CTXL, nrows = TT - r0;
    if (C.bid == 0 && C.tid == 0) cnt[64] = nrows;
    const int quad = C.wave >> 2, kw = C.wave & 3, ntask = nrows / 64;
    for (int tb = C.bid * 2; tb < ntask; tb += C.G * 2) {
        const int task = tb + quad;
        const int rbase = r0 + 64 * task;
        const int v = rbase < CTXL ? 1 : 0;
        const float* xr = X1 + (size_t)(rbase + fr) * DM; const float* sc2 = modv(p, L, v, 4); const float* sh2 = modv(p, L, v, 3);
        f32x4 acc[4][4];
#pragma unroll
        for (int b = 0; b < 4; ++b)
#pragma unroll
            for (int t = 0; t < 4; ++t) acc[b][t] = (f32x4){0.f, 0.f, 0.f, 0.f};
#pragma unroll 1
        for (int ks = 16 * kw; ks < 16 * kw + 16; ++ks) { const int c0 = 32 * ks + 8 * kq;
            const f32x4 a0 = *(const f32x4*)(sc2 + c0), a1 = *(const f32x4*)(sc2 + c0 + 4), b0 = *(const f32x4*)(sh2 + c0), b1 = *(const f32x4*)(sh2 + c0 + 4);
            bf16x8 ah[4], al[4];
#pragma unroll
            for (int b = 0; b < 4; ++b) {
                const f32x4 x0 = *(const f32x4*)(xr + (size_t)(16 * b) * DM + c0), x1 = *(const f32x4*)(xr + (size_t)(16 * b) * DM + c0 + 4);
                const f32x4 y0 = x0 * (a0 + 1.0f) + b0, y1 = x1 * (a1 + 1.0f) + b1;
                u32x4 hi; hi.x = cvt_pk_bf16(y0[0], y0[1]); hi.y = cvt_pk_bf16(y0[2], y0[3]); hi.z = cvt_pk_bf16(y1[0], y1[1]); hi.w = cvt_pk_bf16(y1[2], y1[3]);
                u32x4 lo; lo.x = cvt_pk_bf16(y0[0] - bflo(hi.x), y0[1] - bfhi(hi.x)); lo.y = cvt_pk_bf16(y0[2] - bflo(hi.y), y0[3] - bfhi(hi.y));
                lo.z = cvt_pk_bf16(y1[0] - bflo(hi.z), y1[1] - bfhi(hi.z)); lo.w = cvt_pk_bf16(y1[2] - bflo(hi.w), y1[3] - bfhi(hi.w));
                ah[b] = __builtin_bit_cast(bf16x8, hi); al[b] = __builtin_bit_cast(bf16x8, lo); }
#pragma unroll
            for (int t = 0; t < 4; ++t) { const bf16x8 bh = frag_rowk_g(RWh + (size_t)(16 * t) * DM + 32 * ks, DM, lane), bl = frag_rowk_g(RWl + (size_t)(16 * t) * DM + 32 * ks, DM, lane);
#pragma unroll
                for (int b = 0; b < 4; ++b) { acc[b][t] = MFMA16(ah[b], bh, acc[b][t]); acc[b][t] = MFMA16(al[b], bh, acc[b][t]); acc[b][t] = MFMA16(ah[b], bl, acc[b][t]); } } }
        LDS_WAIT(); asm volatile("" ::: "memory");
#pragma unroll
        for (int b = 0; b < 4; ++b)
#pragma unroll
            for (int t = 0; t < 4; ++t)
#pragma unroll
                for (int r = 0; r < 4; ++r) Lw[b * 1040 + (4 * kq + r) * 65 + 16 * t + fr] = acc[b][t][r];
        LDS_WAIT(); asm volatile("" ::: "memory");
        __syncthreads();
        LAS float* Lg = Lw + kw * 1040;
        { const LAS float* q0 = (const LAS float*)(C.lds + (4 * quad) * 16640) + kw * 1040;
          for (int i = lane; i < 16 * 65; i += 64) Lg[i] = (q0[i] + q0[4160 + i]) + (q0[8320 + i] + q0[12480 + i]); }
        LDS_WAIT(); asm volatile("" ::: "memory");
        if (lane < 16) {
            LAS float* sr = Lg + lane * 65; const int trow = rbase + 16 * kw + lane;
            float gs[8];
#pragma unroll
            for (int g = 0; g < 8; ++g) { float m1 = -1e30f, m2 = -1e30f;
                for (int j = 0; j < 8; ++j) { const int e = 8 * g + j; const float s = sigmoidf_(sr[e]); sr[e] = s; const float vv = s + rbias[e];
                    if (vv > m1) { m2 = m1; m1 = vv; } else if (vv > m2) m2 = vv; }
                gs[g] = m1 + m2; }
            unsigned gmask = 0u;
#pragma unroll
            for (int it = 0; it < 4; ++it) { float best = -1e30f; int bi = 0;
#pragma unroll
                for (int g = 0; g < 8; ++g) { const bool ok = !((gmask >> g) & 1u) && gs[g] > best; best = ok ? gs[g] : best; bi = ok ? g : bi; }
                gmask |= 1u << bi; }
            unsigned long long taken = 0ull; int sel[8]; float sw[8]; float wsum = 0.f;
#pragma unroll
            for (int k = 0; k < 8; ++k) { float best = -1e30f; int bi = 0;
                for (int e = 0; e < 64; ++e) { const bool cand = ((gmask >> (e >> 3)) & 1u) && !((taken >> e) & 1ull); const float vv = sr[e] + rbias[e];
                    if (cand && vv > best) { best = vv; bi = e; } }
                taken |= 1ull << bi; sel[k] = bi; sw[k] = sr[bi]; wsum += sw[k]; }
            const float inv = 2.5f / wsum;
#pragma unroll
            for (int k = 0; k < 8; ++k) { const int a = trow * 8 + k; const int pos = atomicAdd(&cnt[sel[k]], 1);
                LIST[(size_t)sel[k] * TT + pos] = a; PK[a] = ((unsigned)sel[k] << 16) | (unsigned)pos; LW[a] = sw[k] * inv * 4.0f; }
            LIST[(size_t)64 * TT + (trow - r0)] = 8 * TT + trow;
        }
        __syncthreads();
    }
}
namespace att {
constexpr int D = 128, NW = 8, QBLK = 32, KVBLK = 64;
constexpr float SCALE = 0.088388347648318440f;
constexpr float THR = 8.f;
constexpr int SHM_V = KVBLK * D * 2, SHM_K = KVBLK * D * 2, SHM_ATTN = 2 * SHM_V + 2 * SHM_K + NW * 64 * 4;
#define KSWZ(row, colB) ((row) * 256 + ((colB) ^ (((row) & 7) << 4)))
#define SBAR() __builtin_amdgcn_sched_barrier(0)
__device__ __forceinline__ int crow(int r, int hi) { return (r & 3) + 8 * (r >> 2) + 4 * hi; }
__device__ __forceinline__ unsigned cvtpk(float lo, float hi) { unsigned r; asm volatile("v_cvt_pk_bf16_f32 %0, %1, %2" : "=v"(r) : "v"(lo), "v"(hi)); return r; }

__device__ __forceinline__ void partialSM(f32x16& p0, f32x16& p1, float negMC) {
  constexpr float Cc = SCALE * 1.4426950408889634f;
  for (int r = 0; r < 16; ++r) p0[r] = fmaf(p0[r], Cc, negMC); for (int r = 0; r < 16; ++r) p1[r] = fmaf(p1[r], Cc, negMC);
  for (int r = 0; r < 16; ++r) p0[r] = __builtin_amdgcn_exp2f(p0[r]);
}
__device__ __forceinline__ void finishSM(f32x16& p0, f32x16& p1, float& l_reg, bf16x8& pa0, bf16x8& pa1, bf16x8& pa2, bf16x8& pa3) {
  for (int r = 0; r < 16; ++r) p1[r] = __builtin_amdgcn_exp2f(p1[r]);
  float ps = 0; for (int r = 0; r < 16; ++r) ps += p0[r]; for (int r = 0; r < 16; ++r) ps += p1[r];
  { auto rr = __builtin_amdgcn_permlane32_swap(__float_as_uint(ps), __float_as_uint(ps), false, false);
    ps = __uint_as_float(rr[0]) + __uint_as_float(rr[1]); }
  l_reg += ps;
#define PK4(P, BASE, OUT) do { unsigned a0 = cvtpk(P[BASE + 0], P[BASE + 1]), a1 = cvtpk(P[BASE + 2], P[BASE + 3]);   \
    unsigned b0 = cvtpk(P[BASE + 4], P[BASE + 5]), b1 = cvtpk(P[BASE + 6], P[BASE + 7]);                              \
    auto r0 = __builtin_amdgcn_permlane32_swap(a0, b0, false, false); auto r1 = __builtin_amdgcn_permlane32_swap(a1, b1, false, false); \
    u32x4 w = {r0[0], r1[0], r0[1], r1[1]}; OUT = *reinterpret_cast<bf16x8*>(&w); } while (0)
  PK4(p0, 0, pa0); PK4(p0, 8, pa1); PK4(p1, 0, pa2); PK4(p1, 8, pa3);
#undef PK4
}
__device__ __forceinline__ void qkt(f32x16& p0, f32x16& p1, const LAS char* Ks, const bf16x8* qr, int r32, int hi) {
  p0 = f32x16{}; p1 = f32x16{};
  for (int d0 = 0; d0 < 8; ++d0) { int cb = (d0 * 16 + hi * 8) * 2;
    bf16x8 b0 = *reinterpret_cast<const LAS bf16x8*>(Ks + KSWZ(r32, cb));
    bf16x8 b1 = *reinterpret_cast<const LAS bf16x8*>(Ks + KSWZ(32 + r32, cb));
    p0 = __builtin_amdgcn_mfma_f32_32x32x16_bf16(b0, qr[d0], p0, 0, 0, 0);
    p1 = __builtin_amdgcn_mfma_f32_32x32x16_bf16(b1, qr[d0], p1, 0, 0, 0); }
}
__device__ __forceinline__ int v_st(int k, int c) { const int kk = (k & ~0xC) | ((k & 4) << 1) | ((k & 8) >> 1); return ((kk >> 3) * 4 + (c >> 5)) * 512 + ((kk & 7) * 32 + (c & 31)) * 2; }
__device__ __forceinline__ int v_rd_base(int lane) { return ((lane & 3) << 3) | (((lane >> 2) & 3) << 6) | (((lane >> 4) & 1) << 5) | (((lane >> 5) & 1) << 8); }
constexpr int v_rd_off(int d0, int ks, int half) { return d0 * 512 + ks * 4096 + half * 2048; }
template <int OFF> __device__ __forceinline__ s16x4 tr_read(int vb) {
  s16x4 r; asm volatile("ds_read_b64_tr_b16 %0, %1 offset:%2" : "=&v"(r) : "v"(vb), "i"(OFF) : "memory"); return r;
}
template <int D0> __device__ __forceinline__ void pv_one(f32x16& od, int vb, bf16x8 pa0, bf16x8 pa1, bf16x8 pa2, bf16x8 pa3) {
  const s16x4 l0 = tr_read<v_rd_off(D0, 0, 0)>(vb), h0 = tr_read<v_rd_off(D0, 0, 1)>(vb), l1 = tr_read<v_rd_off(D0, 1, 0)>(vb), h1 = tr_read<v_rd_off(D0, 1, 1)>(vb);
  const s16x4 l2 = tr_read<v_rd_off(D0, 2, 0)>(vb), h2 = tr_read<v_rd_off(D0, 2, 1)>(vb), l3 = tr_read<v_rd_off(D0, 3, 0)>(vb), h3 = tr_read<v_rd_off(D0, 3, 1)>(vb);
  asm volatile("s_waitcnt lgkmcnt(0)" ::: "memory"); SBAR();
#define PK(L, H) (bf16x8){L[0], L[1], L[2], L[3], H[0], H[1], H[2], H[3]}
  od = __builtin_amdgcn_mfma_f32_32x32x16_bf16(pa0, PK(l0, h0), od, 0, 0, 0);
  od = __builtin_amdgcn_mfma_f32_32x32x16_bf16(pa1, PK(l1, h1), od, 0, 0, 0);
  od = __builtin_amdgcn_mfma_f32_32x32x16_bf16(pa2, PK(l2, h2), od, 0, 0, 0);
  od = __builtin_amdgcn_mfma_f32_32x32x16_bf16(pa3, PK(l3, h3), od, 0, 0, 0);
#undef PK
}
__device__ __forceinline__ void pv_d0(f32x16* o, int vb, bf16x8 pa0, bf16x8 pa1, bf16x8 pa2, bf16x8 pa3) {
  pv_one<0>(o[0], vb, pa0, pa1, pa2, pa3); pv_one<1>(o[1], vb, pa0, pa1, pa2, pa3); pv_one<2>(o[2], vb, pa0, pa1, pa2, pa3); pv_one<3>(o[3], vb, pa0, pa1, pa2, pa3);
}

template <int LDQ, int LDK, int LDO>
__device__ __forceinline__ void attn_dense_body(const bf16_t* __restrict__ Qb, const bf16_t* __restrict__ Kh, const bf16_t* __restrict__ Vh, bf16_t* __restrict__ Ob, int seq, LAS char* lds, int tid, float kmax2) {
  const int wid = tid >> 6, lane = tid & 63, r32 = lane & 31, hi = lane >> 5;
  LAS char* V_lds = lds; LAS char* K_lds = lds + 2 * SHM_V;
  LAS float* ws = (LAS float*)(lds + 2 * SHM_V + 2 * SHM_K) + wid * 64; LAS float* li_l = ws;
  float l_reg = 0; f32x16 o[4] = {}; bf16x8 qr[8];
  const bf16_t* Qw = Qb + (long)(wid * QBLK + r32) * LDQ + hi * 8;
#pragma unroll
  for (int d0 = 0; d0 < 8; ++d0) qr[d0] = *reinterpret_cast<const bf16x8*>(Qw + d0 * 16);
  float negMC;
  { float q2 = 0.f;
#pragma unroll
    for (int d0 = 0; d0 < 8; ++d0) { const u32x4 w = __builtin_bit_cast(u32x4, qr[d0]);
      q2 += bflo(w.x) * bflo(w.x) + bfhi(w.x) * bfhi(w.x) + bflo(w.y) * bflo(w.y) + bfhi(w.y) * bfhi(w.y) + bflo(w.z) * bflo(w.z) + bfhi(w.z) * bfhi(w.z) + bflo(w.w) * bflo(w.w) + bfhi(w.w) * bfhi(w.w); }
    auto rr = __builtin_amdgcn_permlane32_swap(__float_as_uint(q2), __float_as_uint(q2), false, false);
    q2 = __uint_as_float(rr[0]) + __uint_as_float(rr[1]);
    negMC = -(sqrtf(q2 * kmax2) * (SCALE * 1.0001f) - 30.0f) * 1.4426950408889634f; }
  const int sr = tid >> 4, sc = (tid & 15) * 8, vst0 = v_st(sr, sc), vst1 = v_st(32 + sr, sc);
  const int vb0 = (int)(uintptr_t)V_lds + v_rd_base(lane);
  struct { bf16x8 vs0, vs1, ks0, ks1; } sr_[2];
#define SLOAD(i, k0) do { sr_[i].vs0 = *reinterpret_cast<const bf16x8*>(&Vh[(long)((k0) + sr) * LDK + sc]); sr_[i].vs1 = *reinterpret_cast<const bf16x8*>(&Vh[(long)((k0) + 32 + sr) * LDK + sc]); \
    sr_[i].ks0 = *reinterpret_cast<const bf16x8*>(&Kh[(long)((k0) + sr) * LDK + sc]); sr_[i].ks1 = *reinterpret_cast<const bf16x8*>(&Kh[(long)((k0) + 32 + sr) * LDK + sc]); } while (0)
#define SWRITE(b, i) do { *(LAS bf16x8*)(V_lds + (b) * SHM_V + vst0) = sr_[i].vs0;          \
    *(LAS bf16x8*)(V_lds + (b) * SHM_V + vst1) = sr_[i].vs1; int kc = sc * 2;               \
    *(LAS bf16x8*)(K_lds + (b) * SHM_K + KSWZ(sr, kc)) = sr_[i].ks0;                       \
    *(LAS bf16x8*)(K_lds + (b) * SHM_K + KSWZ(32 + sr, kc)) = sr_[i].ks1; } while (0)
#define SWAIT() asm volatile("s_waitcnt vmcnt(4)" ::: "memory")
  f32x16 pA0, pA1, pB0, pB1; bf16x8 pa0, pa1, pa2, pa3; const int NT = seq / KVBLK;
  constexpr int SE = 0, SO = 1;
  SLOAD(SE, 0); asm volatile("s_waitcnt vmcnt(0)" ::: "memory"); SWRITE(0, SE); __syncthreads();
  qkt(pA0, pA1, K_lds, qr, r32, hi); partialSM(pA0, pA1, negMC);
  SLOAD(SO, KVBLK); if (2 < NT) SLOAD(SE, 2 * KVBLK);
  SWAIT(); SWRITE(1, SO); __syncthreads();
  for (int j = 1; j + 1 < NT; j += 2) {
    SBAR(); qkt(pB0, pB1, K_lds + SHM_K, qr, r32, hi);
    finishSM(pA0, pA1, l_reg, pa0, pa1, pa2, pa3); SBAR();
    SLOAD(SO, (j + 2) * KVBLK); SBAR();
    pv_d0(o, vb0, pa0, pa1, pa2, pa3); partialSM(pB0, pB1, negMC);
    __syncthreads(); SWAIT(); SWRITE(0, SE);
    __syncthreads();
    SBAR(); qkt(pA0, pA1, K_lds, qr, r32, hi);
    finishSM(pB0, pB1, l_reg, pa0, pa1, pa2, pa3); SBAR();
    if (j + 3 < NT) SLOAD(SE, (j + 3) * KVBLK); SBAR();
    pv_d0(o, vb0 + (int)SHM_V, pa0, pa1, pa2, pa3); partialSM(pA0, pA1, negMC);
    __syncthreads(); SWAIT(); SWRITE(1, SO);
    __syncthreads();
  }
  SBAR(); qkt(pB0, pB1, K_lds + SHM_K, qr, r32, hi);
  finishSM(pA0, pA1, l_reg, pa0, pa1, pa2, pa3); SBAR();
  pv_d0(o, vb0, pa0, pa1, pa2, pa3); partialSM(pB0, pB1, negMC);
  __syncthreads();
  finishSM(pB0, pB1, l_reg, pa0, pa1, pa2, pa3); SBAR();
  pv_d0(o, vb0 + (int)SHM_V, pa0, pa1, pa2, pa3);
  if (hi == 0) li_l[r32] = l_reg; asm volatile("s_waitcnt lgkmcnt(0)" ::: "memory");
  float rli[16];
#pragma unroll
  for (int r = 0; r < 16; ++r) rli[r] = __builtin_amdgcn_rcpf(li_l[crow(r, hi)]);
  bf16_t* Ow = Ob + (long)(wid * QBLK) * LDO;
#pragma unroll
  for (int r = 0; r < 16; ++r) { int orow = crow(r, hi);
    for (int d0 = 0; d0 < 4; ++d0) Ow[(long)orow * LDO + d0 * 32 + r32] = (bf16_t)(cvtpk(o[d0][r] * rli[r], 0.f) & 0xffffu); }
#undef SLOAD
#undef SWRITE
#undef SWAIT
}

typedef int v8i32a __attribute__((ext_vector_type(8)));
typedef int v4i32a __attribute__((ext_vector_type(4)));
#define KSW8(row, chunk) ((row) * 128 + ((((chunk) ^ (((row) >> 1) & 7))) << 4))
#define VSW8(d, chunk) ((d) * 64 + ((((chunk) ^ (((d) >> 2) & 3))) << 4))
#define MFMA8(a, b, c) __builtin_amdgcn_mfma_scale_f32_32x32x64_f8f6f4((a), (b), (c), 0, 0, 0, 0, 0, 0)
__device__ __forceinline__ v8i32a ld32_l(const LAS char* p0, const LAS char* p1) { return __builtin_shufflevector(*(const LAS v4i32a*)p0, *(const LAS v4i32a*)p1, 0, 1, 2, 3, 4, 5, 6, 7); }
__device__ __forceinline__ unsigned pk4f8(float a, float b, float c, float d) { unsigned w = (unsigned)__builtin_amdgcn_cvt_pk_fp8_f32(a, b, 0, false); return (unsigned)__builtin_amdgcn_cvt_pk_fp8_f32(c, d, (int)w, true); }
template <int LDO, int KSTR>
__device__ __forceinline__ void attn_dense8_body(const unsigned char* __restrict__ Q8b, const unsigned char* __restrict__ K8h, const unsigned char* __restrict__ VT8h, bf16_t* __restrict__ Ob, int seq, LAS char* lds, int tid, float kmax2) {
  const int wid = tid >> 6, lane = tid & 63, r32 = lane & 31, hi = lane >> 5;
  constexpr int RS = 6, PD = 4;
  LAS float* al_l = (LAS float*)(lds + RS * 16384) + wid * 32;
  f32x16 o[4] = {}; v8i32a qf[2];
  { const unsigned char* qp = Q8b + (size_t)(wid * QBLK + r32) * 1024 + 32 * hi;
    qf[0] = __builtin_shufflevector(*(const v4i32a*)qp, *(const v4i32a*)(qp + 16), 0, 1, 2, 3, 4, 5, 6, 7);
    qf[1] = __builtin_shufflevector(*(const v4i32a*)(qp + 64), *(const v4i32a*)(qp + 80), 0, 1, 2, 3, 4, 5, 6, 7); }
  (void)kmax2;
  constexpr float THR8 = 1.4426950408889634f;
  float m_reg = 0.f; f32x16 osum = {}; v8i32a ones = {0x38383838, 0x38383838, 0x38383838, 0x38383838, 0x38383838, 0x38383838, 0x38383838, 0x38383838}; asm volatile("" : "+v"(ones));
#define PSM8(P0, P1, DL, CN, FIRST) do { float pmax = P0[0]; for (int r = 1; r < 16; ++r) pmax = fmaxf(pmax, P0[r]); for (int r = 0; r < 16; ++r) pmax = fmaxf(pmax, P1[r]); \
      { auto rr = __builtin_amdgcn_permlane32_swap(__float_as_uint(pmax), __float_as_uint(pmax), false, false); pmax = fmaxf(__uint_as_float(rr[0]), __uint_as_float(rr[1])); } \
      const float mn = (FIRST) ? pmax : ((pmax - m_reg > THR8) ? pmax : m_reg); DL = (FIRST) ? 0.f : mn - m_reg; m_reg = mn; CN = 7.0f - mn; \
      for (int r = 0; r < 16; ++r) P0[r] = __builtin_amdgcn_exp2f(P0[r] + CN); } while (0)
#define RESC8(DL) do { if (__any((DL) > 0.f)) { if (hi == 0) al_l[r32] = __builtin_amdgcn_exp2f(-(DL)); asm volatile("s_waitcnt lgkmcnt(0)" ::: "memory"); \
      for (int d = 0; d < 4; ++d) for (int r = 0; r < 16; ++r) o[d][r] *= al_l[crow(r, hi)]; for (int r = 0; r < 16; ++r) osum[r] *= al_l[crow(r, hi)]; } } while (0)
  const unsigned kgo = (unsigned)((tid >> 3) * KSTR + 16 * ((tid & 7) ^ ((tid >> 4) & 7))), vgo = (unsigned)((tid >> 2) * 64 + 16 * ((tid & 3) ^ ((tid >> 4) & 3)));
  const unsigned ldw = (unsigned)wid * 1024u;
#define DMA8(slot, T_) do { __builtin_amdgcn_global_load_lds((const unsigned*)(K8h + (size_t)(T_) * (64 * KSTR) + kgo), (LAS unsigned*)(lds + (slot) * 16384 + ldw), 16, 0, 0); \
      __builtin_amdgcn_global_load_lds((const unsigned*)(VT8h + (size_t)(T_) * 8192 + vgo), (LAS unsigned*)(lds + (slot) * 16384 + 8192 + ldw), 16, 0, 0); } while (0)
#define DWAIT8() do { asm volatile("s_waitcnt vmcnt(6)\n\ts_waitcnt lgkmcnt(0)" ::: "memory"); __builtin_amdgcn_s_barrier(); asm volatile("" ::: "memory"); } while (0)
#define QK8(P0, P1, KB) do { P0 = f32x16{}; P1 = f32x16{}; _Pragma("unroll") for (int s = 0; s < 2; ++s) { \
      const v8i32a k0 = ld32_l((KB) + KSW8(r32, 4 * s + 2 * hi), (KB) + KSW8(r32, 4 * s + 2 * hi + 1)); \
      const v8i32a k1 = ld32_l((KB) + KSW8(32 + r32, 4 * s + 2 * hi), (KB) + KSW8(32 + r32, 4 * s + 2 * hi + 1)); \
      P0 = MFMA8(k0, qf[s], P0); P1 = MFMA8(k1, qf[s], P1); } } while (0)
#define FIN8(P0, P1, CN) do { for (int r = 0; r < 16; ++r) P1[r] = __builtin_amdgcn_exp2f(P1[r] + CN); \
      _Pragma("unroll") for (int i = 0; i < 4; ++i) { pa[i] = (int)pk4f8(P0[4 * i], P0[4 * i + 1], P0[4 * i + 2], P0[4 * i + 3]); pa[4 + i] = (int)pk4f8(P1[4 * i], P1[4 * i + 1], P1[4 * i + 2], P1[4 * i + 3]); } } while (0)
#define PV8(VB) do { _Pragma("unroll") for (int d0 = 0; d0 < 4; ++d0) { \
      const v8i32a vf = ld32_l((VB) + VSW8(32 * d0 + r32, 2 * hi), (VB) + VSW8(32 * d0 + r32, 2 * hi + 1)); \
      o[d0] = MFMA8(pa, vf, o[d0]); } osum = MFMA8(pa, ones, osum); } while (0)
#define LDK8(KB, s, half) ld32_l((KB) + KSW8(32 * (half) + r32, 4 * (s) + 2 * hi), (KB) + KSW8(32 * (half) + r32, 4 * (s) + 2 * hi + 1))
#define LDV8(VB, d0) ld32_l((VB) + VSW8(32 * (d0) + r32, 2 * hi), (VB) + VSW8(32 * (d0) + r32, 2 * hi + 1))
#define EXPN(P, r0, n, CN) do { _Pragma("unroll") for (int r = (r0); r < (r0) + (n); ++r) { float e_ = __builtin_amdgcn_exp2f(P[r] + (CN)); asm volatile("" : "+v"(e_)); P[r] = e_; } } while (0)
#define FINP(P0, P1, CN, i) do { EXPN(P1, 4 * (i), 4, CN); \
      { unsigned w_ = (unsigned)__builtin_amdgcn_cvt_pk_fp8_f32(P0[4 * (i)], P0[4 * (i) + 1], pa[i], false); pa[i] = __builtin_amdgcn_cvt_pk_fp8_f32(P0[4 * (i) + 2], P0[4 * (i) + 3], (int)w_, true); } \
      { unsigned w_ = (unsigned)__builtin_amdgcn_cvt_pk_fp8_f32(P1[4 * (i)], P1[4 * (i) + 1], pa[4 + (i)], false); pa[4 + (i)] = __builtin_amdgcn_cvt_pk_fp8_f32(P1[4 * (i) + 2], P1[4 * (i) + 3], (int)w_, true); } } while (0)
#define PINA(x, y) asm volatile("" : "+v"(x), "+v"(y))
#define PIN1(x) asm volatile("" : "+v"(x))
#define PINC(x, y) asm volatile("" :: "v"(x), "v"(y))
#define HSTEP(X0, X1, DLX, CNX, Y0, Y1, CNY, KB, VB, STAGE_LOAD) do { \
      v8i32a ka_ = LDK8(KB, 0, 0), kb_ = LDK8(KB, 0, 1), kc_ = LDK8(KB, 1, 0), kd_ = LDK8(KB, 1, 1); \
      X0 = MFMA8(ka_, qf[0], f32x16{}); PINA(X0, kb_); \
      FINP(Y0, Y1, CNY, 0); PINC(pa[0], pa[4]); PIN1(kb_); \
      X1 = MFMA8(kb_, qf[0], f32x16{}); PINA(X1, kc_); \
      FINP(Y0, Y1, CNY, 1); PINC(pa[1], pa[5]); PIN1(kc_); \
      X0 = MFMA8(kc_, qf[1], X0); PINA(X0, kd_); \
      v8i32a v0_ = LDV8(VB, 0), v1_ = LDV8(VB, 1); \
      FINP(Y0, Y1, CNY, 2); STAGE_LOAD; PINC(pa[2], pa[6]); PIN1(kd_); \
      X1 = MFMA8(kd_, qf[1], X1); PINA(X1, v0_); \
      v8i32a v2_ = LDV8(VB, 2), v3_ = LDV8(VB, 3); \
      FINP(Y0, Y1, CNY, 3); PINC(pa[3], pa[7]); PINA(pa, v0_); \
      o[0] = MFMA8(pa, v0_, o[0]); PINA(o[0], v1_); \
      float pm0_ = X0[0]; _Pragma("unroll") for (int r = 1; r < 16; ++r) pm0_ = fmaxf(pm0_, X0[r]); PINA(pm0_, v1_); \
      o[1] = MFMA8(pa, v1_, o[1]); PINA(o[1], v2_); \
      _Pragma("unroll") for (int r = 0; r < 16; ++r) pm0_ = fmaxf(pm0_, X1[r]); \
      { auto rr = __builtin_amdgcn_permlane32_swap(__float_as_uint(pm0_), __float_as_uint(pm0_), false, false); pm0_ = fmaxf(__uint_as_float(rr[0]), __uint_as_float(rr[1])); } \
      { const float mn = (pm0_ - m_reg > THR8) ? pm0_ : m_reg; DLX = mn - m_reg; m_reg = mn; CNX = 7.0f - mn; } PINA(CNX, v2_); \
      o[2] = MFMA8(pa, v2_, o[2]); PINA(o[2], v3_); \
      EXPN(X0, 0, 5, CNX); PIN1(v3_); \
      o[3] = MFMA8(pa, v3_, o[3]); PINA(o[3], CNX); \
      EXPN(X0, 5, 5, CNX); PIN1(pa); \
      osum = MFMA8(pa, ones, osum); PINA(osum, CNX); \
      EXPN(X0, 10, 6, CNX); } while (0)
  f32x16 pA0, pA1, pB0, pB1; v8i32a pa = {}; float dlA, dlB, cnA, cnB; const int NT = seq / KVBLK;
#define SLOT(s) (lds + (s) * 16384)
#define SADV() do { sv = sk; sk = sk + 1 == RS ? 0 : sk + 1; sd = sd + 1 == RS ? 0 : sd + 1; } while (0)
  int sk = 0, sv = 0, sd = PD;
  DMA8(0, 0); DMA8(1, 1); DMA8(2, 2); DMA8(3, 3);
  DWAIT8();
  QK8(pA0, pA1, SLOT(0)); PSM8(pA0, pA1, dlA, cnA, true);
  DMA8(sd, PD); SADV(); DWAIT8();
  for (int j = 1; j + 1 < NT; j += 2) {
    HSTEP(pB0, pB1, dlB, cnB, pA0, pA1, cnA, SLOT(sk), SLOT(sv) + 8192, DMA8(sd, min(j + PD, NT - 1)));
    RESC8(dlB); SADV(); DWAIT8();
    HSTEP(pA0, pA1, dlA, cnA, pB0, pB1, cnB, SLOT(sk), SLOT(sv) + 8192, DMA8(sd, min(j + 1 + PD, NT - 1)));
    RESC8(dlA); SADV(); DWAIT8();
  }
  HSTEP(pB0, pB1, dlB, cnB, pA0, pA1, cnA, SLOT(sk), SLOT(sv) + 8192, (void)0);
  RESC8(dlB); SADV();
  FIN8(pB0, pB1, cnB); SBAR();
  PV8(SLOT(sv) + 8192);
  asm volatile("s_waitcnt vmcnt(0)" ::: "memory");
  float rli[16];
#pragma unroll
  for (int r = 0; r < 16; ++r) rli[r] = __builtin_amdgcn_rcpf(osum[r]);
  bf16_t* Ow = Ob + (long)(wid * QBLK) * LDO;
#pragma unroll
  for (int r = 0; r < 16; ++r) { int orow = crow(r, hi);
    for (int d0 = 0; d0 < 4; ++d0) Ow[(long)orow * LDO + d0 * 32 + r32] = (bf16_t)(cvtpk(o[d0][r] * rli[r], 0.f) & 0xffffu); }
#undef PSM8
#undef RESC8
#undef DMA8
#undef DWAIT8
#undef SLOT
#undef SADV
#undef QK8
#undef FIN8
#undef PV8
#undef HSTEP
#undef PINA
#undef PIN1
#undef PINC
#undef FINP
#undef EXPN
#undef LDK8
#undef LDV8
}

template <int LDO, int KSTR>
__device__ __forceinline__ void attn_dense8w_body(const unsigned char* __restrict__ Q8b, const unsigned char* __restrict__ K8h, const unsigned char* __restrict__ VT8h0, const unsigned char* __restrict__ VT8h1, bf16_t* __restrict__ Ob, int seq, LAS char* lds, int tid, float kmax2) {
  const int wid = tid >> 6, lane = tid & 63, r32 = lane & 31, hi = lane >> 5;
  constexpr int RS = 4, PD = 2, SB = 24576;
  LAS float* al_l = (LAS float*)(lds + RS * SB) + wid * 32;
  LAS char* q_l = lds + RS * SB + 2048 + wid * 4096 + lane * 16;
  { const unsigned char* qp = Q8b + (size_t)(wid * QBLK + r32) * 1024 + 32 * hi;
    *(LAS v4i32a*)(q_l) = *(const v4i32a*)qp; *(LAS v4i32a*)(q_l + 1024) = *(const v4i32a*)(qp + 16);
    *(LAS v4i32a*)(q_l + 2048) = *(const v4i32a*)(qp + 64); *(LAS v4i32a*)(q_l + 3072) = *(const v4i32a*)(qp + 80); }
  (void)kmax2;
  constexpr float THR8 = 1.4426950408889634f;
  float l_reg = 0.f, m_reg = 0.f; f32x16 o[8] = {};
  const unsigned kgo = (unsigned)((tid >> 3) * KSTR + 16 * ((tid & 7) ^ ((tid >> 4) & 7))), vgo = (unsigned)((tid >> 2) * 64 + 16 * ((tid & 3) ^ ((tid >> 4) & 3)));
  const unsigned ldw = (unsigned)wid * 1024u;
#define DMA8(slot, T_) do { __builtin_amdgcn_global_load_lds((const unsigned*)(K8h + (size_t)(T_) * (64 * KSTR) + kgo), (LAS unsigned*)(lds + (slot) * SB + ldw), 16, 0, 0); \
      __builtin_amdgcn_global_load_lds((const unsigned*)(VT8h0 + (size_t)(T_) * 8192 + vgo), (LAS unsigned*)(lds + (slot) * SB + 8192 + ldw), 16, 0, 0); \
      __builtin_amdgcn_global_load_lds((const unsigned*)(VT8h1 + (size_t)(T_) * 8192 + vgo), (LAS unsigned*)(lds + (slot) * SB + 16384 + ldw), 16, 0, 0); } while (0)
#define DWAIT8() do { asm volatile("s_waitcnt vmcnt(3)\n\ts_waitcnt lgkmcnt(0)" ::: "memory"); __builtin_amdgcn_s_barrier(); asm volatile("" ::: "memory"); } while (0)
#define SLOT(s) (lds + (s) * SB)
#define SADV() do { sv = sk; sk = sk + 1 == RS ? 0 : sk + 1; sd = sd + 1 == RS ? 0 : sd + 1; } while (0)
#define LDK8(KB, s, half) ld32_l((KB) + KSW8(32 * (half) + r32, 4 * (s) + 2 * hi), (KB) + KSW8(32 * (half) + r32, 4 * (s) + 2 * hi + 1))
#define LDV8(VB, d0) ld32_l((VB) + VSW8(32 * (d0) + r32, 2 * hi), (VB) + VSW8(32 * (d0) + r32, 2 * hi + 1))
#define PIN1(x) asm volatile("" : "+v"(x))
#define EXPR(e0, n) do { _Pragma("unroll") for (int e = (e0); e < (e0) + (n); ++e) { float x_ = e < 16 ? X0[e & 15] : X1[e & 15]; float e_ = __builtin_amdgcn_exp2f(x_ + cn); asm volatile("" : "+v"(e_)); ps += e_; \
      if (e < 16) X0[e & 15] = e_; else X1[e & 15] = e_; } } while (0)
#define PKW(PAC, w) do { if ((w) < 4) { unsigned w_ = (unsigned)__builtin_amdgcn_cvt_pk_fp8_f32(X0[4 * ((w) & 3)], X0[4 * ((w) & 3) + 1], PAC[w], false); PAC[w] = __builtin_amdgcn_cvt_pk_fp8_f32(X0[4 * ((w) & 3) + 2], X0[4 * ((w) & 3) + 3], (int)w_, true); } \
      else { unsigned w_ = (unsigned)__builtin_amdgcn_cvt_pk_fp8_f32(X1[4 * ((w) & 3)], X1[4 * ((w) & 3) + 1], PAC[w], false); PAC[w] = __builtin_amdgcn_cvt_pk_fp8_f32(X1[4 * ((w) & 3) + 2], X1[4 * ((w) & 3) + 3], (int)w_, true); } } while (0)
#define PVM(PAP, g) do { PIN1(vv##g); o[4 * ((g) & 1) + ((g) >> 1)] = MFMA8(PAP, vv##g, o[4 * ((g) & 1) + ((g) >> 1)]); asm volatile("" :: "v"(o[4 * ((g) & 1) + ((g) >> 1)])); } while (0)
#define LDVG(g) ({ int o_ = sv * SB + 8192 + 8192 * ((g) & 1); asm volatile("" : "+s"(o_)); LDV8(lds + o_, (g) >> 1); })
#define WSTEP(PAP, PAC, FIRST, TNEXT) do { \
      { const v8i32a ka_ = LDK8(SLOT(sk), 0, 0), kb_ = LDK8(SLOT(sk), 0, 1), kc_ = LDK8(SLOT(sk), 1, 0), kd_ = LDK8(SLOT(sk), 1, 1); \
        const v8i32a q0_ = ld32_l(q_l, q_l + 1024), q1_ = ld32_l(q_l + 2048, q_l + 3072); \
        X0 = MFMA8(ka_, q0_, f32x16{}); X1 = MFMA8(kb_, q0_, f32x16{}); X0 = MFMA8(kc_, q1_, X0); X1 = MFMA8(kd_, q1_, X1); PIN1(X1); } \
      DMA8(sd, TNEXT); \
      v8i32a vv0 = LDVG(0), vv1 = LDVG(1); \
      PVM(PAP, 0); v8i32a vv2 = LDVG(2); \
      float pm_ = X0[0]; _Pragma("unroll") for (int r = 1; r < 16; ++r) pm_ = fmaxf(pm_, X0[r]); PIN1(pm_); \
      PVM(PAP, 1); v8i32a vv3 = LDVG(3); \
      _Pragma("unroll") for (int r = 0; r < 16; ++r) pm_ = fmaxf(pm_, X1[r]); \
      { auto rr = __builtin_amdgcn_permlane32_swap(__float_as_uint(pm_), __float_as_uint(pm_), false, false); pm_ = fmaxf(__uint_as_float(rr[0]), __uint_as_float(rr[1])); } \
      const float mn_ = (FIRST) ? pm_ : ((pm_ - m_reg > THR8) ? pm_ : m_reg); const float dl_ = (FIRST) ? 0.f : mn_ - m_reg; m_reg = mn_; float cn = 7.0f - mn_; float ps = 0.f; PIN1(cn); \
      PVM(PAP, 2); v8i32a vv4 = LDVG(4); EXPR(0, 6); PKW(PAC, 0); \
      PVM(PAP, 3); v8i32a vv5 = LDVG(5); EXPR(6, 6); PKW(PAC, 1); PKW(PAC, 2); \
      PVM(PAP, 4); v8i32a vv6 = LDVG(6); EXPR(12, 5); PKW(PAC, 3); \
      PVM(PAP, 5); v8i32a vv7 = LDVG(7); EXPR(17, 5); PKW(PAC, 4); \
      PVM(PAP, 6); EXPR(22, 5); PKW(PAC, 5); \
      PVM(PAP, 7); EXPR(27, 5); PKW(PAC, 6); PKW(PAC, 7); \
      { auto rr = __builtin_amdgcn_permlane32_swap(__float_as_uint(ps), __float_as_uint(ps), false, false); ps = __uint_as_float(rr[0]) + __uint_as_float(rr[1]); } \
      if (__any(dl_ > 0.f)) { const float al_ = __builtin_amdgcn_exp2f(-dl_); l_reg *= al_; if (hi == 0) al_l[r32] = al_; asm volatile("s_waitcnt lgkmcnt(0)" ::: "memory"); \
        for (int d = 0; d < 8; ++d) for (int r = 0; r < 16; ++r) o[d][r] *= al_l[crow(r, hi)]; } \
      l_reg += ps; \
      SADV(); DWAIT8(); } while (0)
  f32x16 X0, X1; v8i32a paA = {}, paB = {}; const int NT = seq / KVBLK;
  int sk = 0, sv = 0, sd = PD;
  DMA8(0, 0); DMA8(1, 1);
  DWAIT8();
  for (int j = 0; j < NT; j += 2) {
    WSTEP(paB, paA, j == 0, min(j + PD, NT - 1));
    WSTEP(paA, paB, false, min(j + 1 + PD, NT - 1));
  }
  { v8i32a vv0 = LDVG(0), vv1 = LDVG(1), vv2 = LDVG(2), vv3 = LDVG(3); PVM(paB, 0); PVM(paB, 1); PVM(paB, 2); PVM(paB, 3); }
  { v8i32a vv4 = LDVG(4), vv5 = LDVG(5), vv6 = LDVG(6), vv7 = LDVG(7); PVM(paB, 4); PVM(paB, 5); PVM(paB, 6); PVM(paB, 7); }
  asm volatile("s_waitcnt vmcnt(0)" ::: "memory");
  int te = tid; asm volatile("" : "+v"(te));
  const int wid_e = te >> 6, r32_e = te & 31, hi_e = (te >> 5) & 1;
  LAS float* li_e = (LAS float*)(lds + RS * SB + 1024) + wid_e * 32;
  if (hi_e == 0) li_e[r32_e] = l_reg; asm volatile("s_waitcnt lgkmcnt(0)" ::: "memory");
  float rli[16];
#pragma unroll
  for (int r = 0; r < 16; ++r) rli[r] = __builtin_amdgcn_rcpf(li_e[crow(r, hi_e)]);
  bf16_t* Ow = Ob + (long)(wid_e * QBLK) * LDO;
#pragma unroll
  for (int r = 0; r < 16; ++r) { int orow = crow(r, hi_e);
    for (int d0 = 0; d0 < 8; ++d0) Ow[(long)orow * LDO + d0 * 32 + r32_e] = (bf16_t)(cvtpk(o[d0][r] * rli[r], 0.f) & 0xffffu); }
#undef DMA8
#undef DWAIT8
#undef SLOT
#undef SADV
#undef LDK8
#undef LDV8
#undef PIN1
#undef EXPR
#undef PKW
#undef PVM
#undef LDVG
#undef WSTEP
}

constexpr int PV_BUF = 32768, PK_BUF = 16384, P_LDS_V = 0, P_LDS_K = 2 * PV_BUF, P_LDS_X = P_LDS_K + 2 * PK_BUF, P_LDS_L = P_LDS_X + 8 * 2048, P_LDS_END = P_LDS_L + 1024;
__device__ __forceinline__ void qkt_half(f32x16& p, const LAS char* Ks, const bf16x8* qr, int krow, int hi) {
  p = f32x16{};
  for (int d0 = 0; d0 < 8; ++d0) { int cb = (d0 * 16 + hi * 8) * 2;
    bf16x8 b0 = *reinterpret_cast<const LAS bf16x8*>(Ks + KSWZ(krow, cb));
    p = __builtin_amdgcn_mfma_f32_32x32x16_bf16(b0, qr[d0], p, 0, 0, 0); }
}
__device__ __forceinline__ void smA(f32x16& p, float negMC) {
  constexpr float Cc = SCALE * 1.4426950408889634f;
  for (int r = 0; r < 16; ++r) p[r] = fmaf(p[r], Cc, negMC);
  for (int r = 0; r < 8; ++r) p[r] = __builtin_amdgcn_exp2f(p[r]);
}
__device__ __forceinline__ void smB(f32x16& p, float& l_reg, bf16x8& f0, bf16x8& f1) {
  for (int r = 8; r < 16; ++r) p[r] = __builtin_amdgcn_exp2f(p[r]);
  float ps = 0; for (int r = 0; r < 16; ++r) ps += p[r];
  { auto rr = __builtin_amdgcn_permlane32_swap(__float_as_uint(ps), __float_as_uint(ps), false, false);
    ps = __uint_as_float(rr[0]) + __uint_as_float(rr[1]); }
  l_reg += ps;
#define PK4(P, BASE, OUT) do { unsigned a0 = cvtpk(P[BASE + 0], P[BASE + 1]), a1 = cvtpk(P[BASE + 2], P[BASE + 3]);   \
    unsigned b0 = cvtpk(P[BASE + 4], P[BASE + 5]), b1 = cvtpk(P[BASE + 6], P[BASE + 7]);                              \
    auto r0 = __builtin_amdgcn_permlane32_swap(a0, b0, false, false); auto r1 = __builtin_amdgcn_permlane32_swap(a1, b1, false, false); \
    u32x4 w = {r0[0], r1[0], r0[1], r1[1]}; OUT = *reinterpret_cast<bf16x8*>(&w); } while (0)
  PK4(p, 0, f0); PK4(p, 8, f1);
#undef PK4
}
template <int LDQ, int LDK, int LDO>
__device__ __forceinline__ void attn_pair_body(const bf16_t* __restrict__ Qb, const bf16_t* __restrict__ Kh, const bf16_t* __restrict__ Vh, bf16_t* __restrict__ Ob, int seq, LAS char* lds, int tid, float kmax2) {
  const int wid = __builtin_amdgcn_readfirstlane(tid >> 6), lane = tid & 63, r32 = lane & 31, hi = lane >> 5, g = wid & 3, kb = wid >> 2;
  LAS char* V_lds = lds + P_LDS_V; LAS char* K_lds = lds + P_LDS_K;
  LAS char* xp_own = lds + P_LDS_X + wid * 2048 + lane * 16; LAS char* xp_par = lds + P_LDS_X + (wid ^ 4) * 2048 + lane * 16;
  LAS float* li = (LAS float*)(lds + P_LDS_L);
  float l_reg = 0; f32x16 o[4] = {}; bf16x8 qr[8];
  const bf16_t* Qw = Qb + (long)(g * QBLK + r32) * LDQ + hi * 8;
#pragma unroll
  for (int d0 = 0; d0 < 8; ++d0) qr[d0] = *reinterpret_cast<const bf16x8*>(Qw + d0 * 16);
  float negMC;
  { float q2 = 0.f;
#pragma unroll
    for (int d0 = 0; d0 < 8; ++d0) { const u32x4 w = __builtin_bit_cast(u32x4, qr[d0]);
      q2 += bflo(w.x) * bflo(w.x) + bfhi(w.x) * bfhi(w.x) + bflo(w.y) * bflo(w.y) + bfhi(w.y) * bfhi(w.y) + bflo(w.z) * bflo(w.z) + bfhi(w.z) * bfhi(w.z) + bflo(w.w) * bflo(w.w) + bfhi(w.w) * bfhi(w.w); }
    auto rr = __builtin_amdgcn_permlane32_swap(__float_as_uint(q2), __float_as_uint(q2), false, false);
    q2 = __uint_as_float(rr[0]) + __uint_as_float(rr[1]);
    negMC = -(sqrtf(q2 * kmax2) * (SCALE * 1.0001f) - 30.0f) * 1.4426950408889634f; }
  const int sr = tid >> 4, sc = (tid & 15) * 8, vst0 = v_st(sr, sc), vst1 = v_st(32 + sr, sc);
  const int vrd = (int)(uintptr_t)V_lds + kb * 16384 + v_rd_base(lane);
  const int krow = 32 * kb + r32;
  struct { bf16x8 v00, v01, v10, v11, k0, k1; } st_;
#define PLD16(base, off) (*reinterpret_cast<const bf16x8*>((const char*)(base) + (off)))
#define PLOAD(k0_) do { const unsigned o_ = (unsigned)(((k0_) + sr) * LDK + sc) * 2u; \
    st_.v00 = PLD16(Vh, o_); st_.v01 = PLD16(Vh, o_ + 256u); st_.v10 = PLD16(Vh, o_ + 64u * LDK); st_.v11 = PLD16(Vh, o_ + 64u * LDK + 256u); \
    st_.k0 = PLD16(Kh, o_); st_.k1 = PLD16(Kh, o_ + 64u * LDK); } while (0)
#define PWRITE(kbuf, vbuf) do { LAS char* vb_ = V_lds + (vbuf) * PV_BUF; LAS char* kb_ = K_lds + (kbuf) * PK_BUF; const int kc = sc * 2; \
    *(LAS bf16x8*)(vb_ + vst0) = st_.v00; *(LAS bf16x8*)(vb_ + 16384 + vst0) = st_.v01; *(LAS bf16x8*)(vb_ + vst1) = st_.v10; *(LAS bf16x8*)(vb_ + 16384 + vst1) = st_.v11; \
    *(LAS bf16x8*)(kb_ + KSWZ(sr, kc)) = st_.k0; *(LAS bf16x8*)(kb_ + KSWZ(32 + sr, kc)) = st_.k1; } while (0)
  const int NT = seq / KVBLK;
  f32x16 pS; bf16x8 f0, f1, g0, g1;
  PLOAD(0); asm volatile("s_waitcnt vmcnt(0)" ::: "memory"); PWRITE(0, 0); PLOAD(KVBLK);
  __syncthreads();
  for (int j = 0; j < NT; ++j) {
    SBAR();
    qkt_half(pS, K_lds + (j & 1) * PK_BUF, qr, krow, hi);
    smA(pS, negMC); smB(pS, l_reg, f0, f1); SBAR();
    *(LAS bf16x8*)(xp_own) = f0; *(LAS bf16x8*)(xp_own + 1024) = f1;
    if (j + 1 < NT) PWRITE((j + 1) & 1, (j + 1) & 1);
    if (j + 2 < NT) PLOAD((j + 2) * KVBLK);
    __syncthreads();
    g0 = *(const LAS bf16x8*)(xp_par); g1 = *(const LAS bf16x8*)(xp_par + 1024);
    { const int vb = vrd + (j & 1) * PV_BUF;
      if (kb == 0) pv_d0(o, vb, f0, f1, g0, g1); else pv_d0(o, vb, g0, g1, f0, f1); }
    __syncthreads();
  }
  if (hi == 0) li[wid * 32 + r32] = l_reg;
  __syncthreads();
#pragma unroll
  for (int r = 0; r < 16; ++r) { const int orow = crow(r, hi); const float rl = __builtin_amdgcn_rcpf(li[wid * 32 + orow] + li[(wid ^ 4) * 32 + orow]);
    bf16_t* op = Ob + (long)(g * QBLK + orow) * LDO + 128 * kb + r32;
    for (int d0 = 0; d0 < 4; ++d0) op[d0 * 32] = (bf16_t)(cvtpk(o[d0][r] * rl, 0.f) & 0xffffu); }
#undef PLD16
#undef PLOAD
#undef PWRITE
}
#undef KSWZ
}

__device__ __forceinline__ void phase_attention(const Params& p, Ctx& C) {
    bf16_t* ATT = (bf16_t*)(p.ws + WS_BIG + BG_ATT);
    const unsigned char* Q8 = (const unsigned char*)(p.ws + WS_BIG + BG_Q8); const unsigned char* K8 = (const unsigned char*)(p.ws + WS_BIG + BG_K8); const unsigned char* VT8 = (const unsigned char*)(p.ws + WS_BIG + BG_VT8);
    const unsigned char* Q8D = (const unsigned char*)(p.ws + WS_BIG + BG_Q8D); const unsigned char* K8D = (const unsigned char*)(p.ws + WS_BIG + BG_K8D); const unsigned char* VT8D = (const unsigned char*)(p.ws + WS_BIG + BG_VT8D);
    for (int i = 0;; ++i) {
        int unit;
        if (C.G == 256) { if (i >= 2) break; unit = (C.bid & 7) * 64 + i * 32 + (C.bid >> 3); } else { unit = i * C.G + C.bid; if (unit >= 512) break; }
        const int d = unit >> 6, qb = unit & 63, hh = d >> 1, m = d & 1;
        __syncthreads();
        int tz = C.tid; asm volatile("" : "+v"(tz));
        att::attn_dense8w_body<3072, 1024>(Q8D + (size_t)(CTXL + 256 * qb) * 1024 + 128 * d, K8D + 128 * d, VT8D + (size_t)(2 * hh) * 260 * 8192, VT8D + (size_t)(2 * hh + 1) * 260 * 8192,
                                           ATT + (size_t)(256 * qb) * 3072 + 1024 + 1024 * m + 256 * hh, TT, (LAS char*)C.lds, tz, 0.f);
    }
    for (int i = 0;; ++i) {
        int unit;
        if (C.G == 256) { if (i >= 2) break; unit = (C.bid & 7) * 64 + i * 32 + (C.bid >> 3); } else { unit = i * C.G + C.bid; if (unit >= 512) break; }
        const int prob = unit >> 6, qb = unit & 63;
        __syncthreads();
        int tz = C.tid; asm volatile("" : "+v"(tz));
        att::attn_dense8_body<3072, 256>(Q8 + (size_t)(CTXL + 256 * qb) * 1024 + 128 * prob, K8 + 128 * (prob >> 2), VT8 + (size_t)(prob >> 2) * 260 * 8192,
                                         ATT + (size_t)(256 * qb) * 3072 + 128 * prob, TT, (LAS char*)C.lds, tz, 0.f);
    }
    __syncthreads();
}
constexpr int PH_PER_LAYER = 13, N_PHASES = 2 + 2 * PH_PER_LAYER;
#ifndef DBL_PHASE
#define DBL_PHASE -1
#endif
#ifndef MK_PER_PHASE
#define MK_PER_PHASE 0
#endif

template <int L>
__device__ __forceinline__ void layer_body(const Params& p, Ctx& C0, const XcdBarrier& bar, LAS unsigned char* misc, int lo, int hi) {
#define IN(k) (lo <= (k) && (k) < hi)
#define SEAM(k) do { if (IN(k) && IN((k) + 1)) xcd_barrier(bar, C0.wave); } while (0)
#define PHASE(k, ...) if (DBL_PHASE == (k)) { int nrep_ = 2; asm volatile("" : "+s"(nrep_)); for (int rep_ = 0; rep_ < nrep_; ++rep_) { if (rep_) xcd_barrier(bar, C0.wave); FRESH(); __VA_ARGS__ } } else if (IN(k)) { FRESH(); __VA_ARGS__ } SEAM(k);
#define FRESH() Ctx C = C0; { int ln = (int)__builtin_amdgcn_mbcnt_hi(~0u, __builtin_amdgcn_mbcnt_lo(~0u, 0u)); asm volatile("" : "+v"(ln)); C.lane = ln; C.tid = C.wave * 64 + ln; }
        const int b = 2 + PH_PER_LAYER * L;
        bf16_t* QKV = (bf16_t*)(p.ws + WS_BIG + BG_QKV);
        bf16_t* XA = (bf16_t*)(p.ws + WS_XA);
        int* cnt = (int*)(p.ws + WS_CTL) + CW_CNT + L * 128; const int* LIST = (const int*)(p.ws + WS_LIST);
        if (L == 0) { PHASE(b + 0, phase_modulate(p, C, L); ) }
        PHASE(b + 1,
            const int N = L ? OD_IN : EV_IN;
            pg8::DenseOrder S; S.init8((const void*)XA, DM, (const void*)(p.ws + (L ? WS_WIN1 : WS_WIN0)), TT, N, DM, C.G, C.bid);
            pg8::EpiStore E{QKV, N, 1.0f / 32.0f};
            pg8::gemm_phase<true>(C.lds, S, E, C.wave);
            if (L == 0 && IN(b + 2) && S.units_of_me() < S.max_units()) conv_queue(p, C, 2);
        )
        PHASE(b + 2, if (L == 0) phase_rope0(p, C); else phase_normrope1(p, C); )
        PHASE(b + 3, if (L == 0) { ret_chunk_kv(p, C); s5_end_states(p, C); } else phase_attention(p, C); )
        PHASE(b + 4, if (L == 0) phase_scans(p, C); else phase_merge1(p, C); )
        if (L == 0) {
            PHASE(b + 5, phase_ret_s5_outputs(p, C, misc); )
            PHASE(b + 6,
                pg8::DenseOrder S; S.init((const bf16_t*)(p.ws + WS_Z), 1024, (const bf16_t*)(p.ws + WS_WGLU), TT, 1024, 1024, C.G, C.bid);
                pg8::EpiGlu E{(const bf16_t*)(p.ws + WS_Z), p.inp(20), (bf16_t*)(p.ws + WS_BIG + BG_MIX)};
                pg8::gemm_phase<false>(C.lds, S, E, C.wave);
                if (IN(b + 7) && S.units_of_me() < S.max_units()) conv_queue(p, C, 4);
            )
        }
        PHASE(b + 7,
            pg8::DenseOrder S;
            if (L == 0) S.init((const bf16_t*)(p.ws + WS_BIG + BG_MIX), DM, (const bf16_t*)(p.ws + WS_WOUT0), TT, DM, DM, C.G, C.bid);
            else S.init((const bf16_t*)(p.ws + WS_BIG + BG_ATT), 3072, (const bf16_t*)(p.ws + WS_WOUT1), SEQ, DM, DM, C.G, C.bid);
            pg8::EpiStore E{(bf16_t*)(p.ws + WS_YMIX) + (L ? (size_t)CTXL * DM : 0), DM, 1.0f};
            pg8::gemm_phase<false>(C.lds, S, E, C.wave);
            if (L == 0 && IN(b + 8) && S.units_of_me() < S.max_units()) conv_queue(p, C, 5);
        )
        PHASE(b + 8, phase_ln1(p, C, L); )
        PHASE(b + 9, phase_router(p, C, L); )
        PHASE(b + 10,
            pg8::MoeOrder<0> S; S.A = (const void*)XA; S.Bt = (const void*)(p.ws + WS_GU + (size_t)L * NEX1 * 1024 * DM); S.list = LIST; S.cnt = cnt; S.ldab = DM; S.kb = DM; S.nN = 4; S.G = C.G; S.c = C.bid; S.bstride = (size_t)1024 * DM;
            S.prep(misc, C.tid);
            pg8::EpiE1 E{(unsigned char*)(p.ws + WS_HX2), S.cn, S.rb};
            pg8::gemm_phase<true>(C.lds, S, E, C.wave);
        )
        PHASE(b + 11,
            pg8::MoeOrder<1> S; S.A = (const void*)(p.ws + WS_HX2); S.Bt = (const void*)(p.ws + WS_DT + (size_t)L * NEX1 * DM * EHID); S.list = LIST; S.cnt = cnt; S.ldab = EHID; S.kb = EHID; S.nN = 8; S.G = C.G; S.c = C.bid; S.bstride = (size_t)DM * EHID;
            S.prep(misc, C.tid);
            pg8::EpiE2 E{(unsigned char*)(p.ws + WS_BIG + BG_YMOE), (const float*)(p.ws + WS_LW), S.cn, S.rb};
            pg8::gemm_phase<true>(C.lds, S, E, C.wave);
        )
        PHASE(b + 12, phase_combine(p, C, L, misc); )
    #undef IN
#undef SEAM
#undef FRESH
#undef PHASE
}

__global__ void __launch_bounds__(NTHR, 2) mega_fwd(KArgs ka) {
    extern __shared__ __attribute__((aligned(16))) unsigned char lds_raw[];
    Ctx C;
    C.lds = (LAS unsigned char*)lds_raw;
    C.tid = threadIdx.x; C.lane = C.tid & 63; C.wave = __builtin_amdgcn_readfirstlane(C.tid >> 6);
    C.G = gridDim.x; C.bid = blockIdx.x; C.gw = C.bid * NWAVES + C.wave; C.ngw = C.G * NWAVES;
    LAS unsigned char* misc = C.lds + MISC_OFF;
    if (C.tid < 8) ((volatile LAS unsigned*)misc)[C.tid] = 0u;
    Params p; p.out = ka.out; p.ws = ka.ws; p.ph_lo = ka.ph_lo; p.ph_hi = ka.ph_hi; p.ptab = (LAS unsigned long long*)(misc + 1024);
    if (C.tid < 34) p.ptab[C.tid] = (unsigned long long)ka.in[C.tid];
    __syncthreads();
    const int lo = p.ph_lo, hi = p.ph_hi;
    XcdBarrier bar; bar.bar = (unsigned*)(p.ws + WS_CTL) + CW_BAR; bar.x = 0; bar.st = (volatile LAS unsigned*)misc;
    if (hi - lo > 1) bar = xcd_barrier_post((unsigned*)(p.ws + WS_CTL) + CW_BAR, (volatile LAS unsigned*)misc);
#define IN(k) (lo <= (k) && (k) < hi)
#define SEAM(k) do { if (IN(k) && IN((k) + 1)) xcd_barrier(bar, C.wave); } while (0)

    if (IN(0)) { phase_p0(p, C); } SEAM(0);
    if (IN(1)) { phase_p1(p, C); } SEAM(1);
    if (IN(0) && IN(2) && (C.G & 7) == 0) {
        volatile LAS unsigned* st = (volatile LAS unsigned*)misc;
        if (C.tid == 0) { unsigned pre = 0u; const unsigned x = st[3];
            for (unsigned j = 0; j < 16; ++j) { const unsigned cj = xb_ld(&bar.bar[XB_XCNT(j)]); pre += (j < x) ? cj : 0u; }
            st[4] = pre + st[2]; }
        __syncthreads();
        const int vcu = (int)st[4], g8 = C.G >> 3;
        C.bid = __builtin_amdgcn_readfirstlane((vcu % g8) * 8 + vcu / g8); C.gw = C.bid * NWAVES + C.wave;
    }

    layer_body<0>(p, C, bar, misc, lo, hi);
    layer_body<1>(p, C, bar, misc, lo, hi);
#undef IN
#undef SEAM
}

extern "C" void kernel_launch(void* const* d_in, const int* in_sizes, int n_in, void* d_out, int out_size, void* d_ws, size_t ws_size, hipStream_t stream) {
    static int grid = 0;
    if (grid == 0) {
        if (n_in != 34 || out_size != SEQ * DM || ws_size < WS_END) { fprintf(stderr, "kernel_launch: unexpected shapes: n_in %d out %d ws %zu (need %zu)\n", n_in, out_size, ws_size, (size_t)WS_END); grid = -1; return; }
        int dev = 0, cus = 0, per_cu = 0;
        if (hipGetDevice(&dev) != hipSuccess || hipDeviceGetAttribute(&cus, hipDeviceAttributeMultiprocessorCount, dev) != hipSuccess) { grid = -1; return; }
        if (hipFuncSetAttribute((const void*)mega_fwd, hipFuncAttributeMaxDynamicSharedMemorySize, LDS_BYTES) != hipSuccess) { fprintf(stderr, "kernel_launch: hipFuncSetAttribute failed\n"); grid = -1; return; }
        if (hipOccupancyMaxActiveBlocksPerMultiprocessor(&per_cu, (const void*)mega_fwd, NTHR, LDS_BYTES) != hipSuccess || per_cu < 1) { fprintf(stderr, "kernel_launch: occupancy query says %d blocks per CU\n", per_cu); grid = -1; return; }
        (void)hipGetLastError();
        grid = cus;
    }
    if (grid < 0) return;
    (void)hipMemsetAsync((char*)d_ws + WS_CTL, 0, CTL_BYTES, stream);
    KArgs p{};
    for (int i = 0; i < 34; ++i) p.in[i] = (const float*)d_in[i];
    p.out = (float*)d_out; p.ws = (unsigned char*)d_ws;
#if MK_PER_PHASE
    for (int ph = 0; ph < N_PHASES; ++ph) {
        if (ph == 2 + PH_PER_LAYER + 0 || ph == 2 + PH_PER_LAYER + 5 || ph == 2 + PH_PER_LAYER + 6) continue;
        p.ph_lo = ph; p.ph_hi = ph + 1;
        hipLaunchKernelGGL(mega_fwd, dim3(grid), dim3(NTHR), LDS_BYTES, stream, p);
    }
#else
    p.ph_lo = 0; p.ph_hi = N_PHASES;
    hipLaunchKernelGGL(mega_fwd, dim3(grid), dim3(NTHR), LDS_BYTES, stream, p);
#endif
    const hipError_t le = hipPeekAtLastError();
    if (le != hipSuccess) fprintf(stderr, "kernel_launch: launch failed: %s\n", hipGetErrorName(le));
}
```

```cpp
#define MK_PER_PHASE 0
#include <hip/hip_runtime.h>
#include <cstdio>
#include <cstdint>

#define GAS __attribute__((address_space(1)))
#define LAS __attribute__((address_space(3)))
typedef unsigned short bf16_t;
typedef short bf16x8 __attribute__((ext_vector_type(8)));
typedef short s16x4 __attribute__((ext_vector_type(4)));
typedef float f32x4 __attribute__((ext_vector_type(4)));
typedef float f32x2 __attribute__((ext_vector_type(2)));
typedef float f32x16 __attribute__((ext_vector_type(16)));
typedef unsigned u32x4 __attribute__((ext_vector_type(4)));
typedef unsigned u32x2 __attribute__((ext_vector_type(2)));

constexpr int DM = 2048, SEQ = 16384, CTXL = 256, TT = SEQ + CTXL;
constexpr int NEXP = 64, NEX1 = 65, EHID = 512, TOPK = 8;
constexpr int EV_IN = 5120, OD_IN = 4608;
constexpr float LN_EPS = 1e-6f;
constexpr float ALPHA = 1.4142135623730951f;
constexpr float LAMBDA_INIT = 0.35550906759f;
constexpr int NTHR = 512, NWAVES = 8;

constexpr size_t al256(size_t x) { return (x + 255) / 256 * 256; }
constexpr size_t WS_CTL   = 0;
constexpr size_t CTL_BYTES = 1u << 20;
constexpr size_t WS_MODP  = WS_CTL + CTL_BYTES;
constexpr size_t WS_MODF  = WS_MODP + al256((size_t)2 * 32 * 2 * 12288 * 4);
constexpr size_t WS_ROPE128 = WS_MODF + al256((size_t)2 * 2 * 12288 * 4);
constexpr size_t WS_ROPE64  = WS_ROPE128 + al256((size_t)256 * 64 * 2 * 4);
constexpr size_t WS_KN    = WS_ROPE64 + al256((size_t)256 * 32 * 2 * 4);
constexpr size_t WS_WT    = WS_KN + al256((size_t)2 * 64 * 16 * 1024 * 2);
constexpr size_t WS_APOW  = WS_WT + al256((size_t)2 * 64 * 128 * 1024 * 2);
constexpr size_t WS_AL    = WS_APOW + al256((size_t)2 * 64 * 64 * 128 * 4);
constexpr size_t WS_CC    = WS_AL + al256((size_t)2 * 64 * 128 * 4);
constexpr size_t WS_BBT   = WS_CC + al256((size_t)64 * 16 * 128 * 2);
constexpr size_t WS_S5E   = WS_BBT + al256((size_t)2 * 64 * 128 * 16 * 2);
constexpr size_t WS_HST   = WS_S5E + al256((size_t)2 * 64 * 260 * 128 * 4);
constexpr size_t WS_WIN0  = WS_HST + al256((size_t)2 * 64 * 260 * 128 * 4);
constexpr size_t WS_WOUT0 = WS_WIN0 + al256((size_t)EV_IN * DM * 2);
constexpr size_t WS_WGLU  = WS_WOUT0 + al256((size_t)DM * DM * 2);
constexpr size_t WS_WIN1  = WS_WGLU + al256((size_t)1024 * 1024 * 2);
constexpr size_t WS_WOUT1 = WS_WIN1 + al256((size_t)OD_IN * DM * 2);
constexpr size_t WS_RWT   = WS_WOUT1 + al256((size_t)DM * DM * 2);
constexpr size_t WS_GU    = WS_RWT + al256((size_t)2 * 2 * 64 * DM * 2);
constexpr size_t WS_DT    = WS_GU + al256((size_t)NEX1 * 1024 * DM * 2);
constexpr size_t WS_XA    = WS_DT + al256((size_t)NEX1 * DM * EHID * 2);
constexpr size_t WS_Z     = WS_XA + al256((size_t)TT * DM * 2);
constexpr size_t WS_YMIX  = WS_Z + al256((size_t)TT * 1024 * 2);
constexpr size_t WS_X1    = WS_YMIX + al256((size_t)TT * DM * 2);
constexpr size_t WS_HX2   = WS_X1 + al256((size_t)TT * DM * 4);
constexpr size_t WS_LIST  = WS_HX2 + al256((size_t)9 * TT * EHID * 2);
constexpr size_t WS_WGT   = WS_LIST + al256((size_t)NEX1 * TT * 4);
constexpr size_t WS_LW    = WS_WGT + al256((size_t)8 * TT * 4);
constexpr size_t WS_BIG   = WS_LW + al256((size_t)NEX1 * TT * 4);
constexpr size_t BG_QKV   = 0;
constexpr size_t BG_CKV   = BG_QKV + al256((size_t)TT * EV_IN * 2);
constexpr size_t BG_SPREV = BG_CKV + al256((size_t)8 * 130 * 65536 * 4);
constexpr size_t BG_MIX   = BG_SPREV + al256((size_t)8 * 130 * 65536 * 2);
constexpr size_t BG_END0  = BG_MIX + al256((size_t)TT * DM * 2);
constexpr size_t BG_ATT   = BG_CKV;
constexpr size_t BG_Q8    = BG_ATT + al256((size_t)SEQ * 3072 * 2);
constexpr size_t BG_K8    = BG_Q8 + al256((size_t)TT * 1024);
constexpr size_t BG_VT8   = BG_K8 + al256((size_t)TT * 256);
constexpr size_t BG_Q8D   = BG_VT8 + al256((size_t)2 * 260 * 128 * 64);
constexpr size_t BG_K8D   = BG_Q8D + al256((size_t)TT * 1024);
constexpr size_t BG_VT8D  = BG_K8D + al256((size_t)TT * 1024);
constexpr size_t BG_F8END = BG_VT8D + al256((size_t)8 * 260 * 128 * 64);
constexpr size_t BG_YMOE  = 0;
constexpr size_t BG_END1  = al256((size_t)9 * TT * DM * 2);
constexpr size_t BG_SIZE  = BG_END0 > BG_END1 ? BG_END0 : BG_END1;
static_assert(BG_F8END <= BG_SIZE, "fp8 attention operands inside the big region");
constexpr size_t WS_END   = WS_BIG + BG_SIZE;

constexpr int CW_BAR = 4096;
constexpr int CW_CNT = 16384;
constexpr int CW_QUEUE = 20480;
constexpr int CW_KMAX = 24576;

constexpr int RING_BYTES = 151552;
constexpr int MISC_OFF = RING_BYTES;
constexpr int LDS_BYTES = 159744;

typedef __bf16 bf16x2_t __attribute__((ext_vector_type(2)));
__device__ __forceinline__ unsigned cvt_pk_bf16(float lo, float hi) { const f32x2 v = {lo, hi}; return __builtin_bit_cast(unsigned, __builtin_convertvector(v, bf16x2_t)); }
__device__ __forceinline__ bf16_t f2bf(float f) { unsigned u = __builtin_bit_cast(unsigned, f); return (bf16_t)((u + 0x7fffu + ((u >> 16) & 1u)) >> 16); }
__device__ __forceinline__ float bf2f(bf16_t b) { return __builtin_bit_cast(float, ((unsigned)b) << 16); }
__device__ __forceinline__ float bflo(unsigned w) { return __builtin_bit_cast(float, w << 16); }
__device__ __forceinline__ float bfhi(unsigned w) { return __builtin_bit_cast(float, w & 0xffff0000u); }
__device__ __forceinline__ float wave_sum(float v) {
#pragma unroll
    for (int o = 1; o < 64; o <<= 1) v += __shfl_xor(v, o);
    return v;
}
__device__ __forceinline__ float fast_exp(float x) { return __builtin_amdgcn_exp2f(x * 1.4426950408889634f); }
__device__ __forceinline__ float sigmoidf_(float x) { return 1.0f / (1.0f + __expf(-x)); }
__device__ __forceinline__ float siluf_(float x) { return x / (1.0f + __expf(-x)); }
__device__ __forceinline__ float gelu_tanh(float x) {
    const float u = 0.7978845608028654f * (x + 0.044715f * x * x * x);
    const float e = __expf(2.0f * u);
    const float t = 1.0f - 2.0f / (e + 1.0f);
    return 0.5f * x * (1.0f + t);
}
#define LDS_WAIT() asm volatile("s_waitcnt lgkmcnt(0)" ::: "memory")
#define VM_WAIT() asm volatile("s_waitcnt vmcnt(0)" ::: "memory")

#define XB_TMO      128
#define XB_XCNT(j)  (256  + 64 * (j))
#define XB_XSUB(j)  (1280 + 64 * (j))
#define XB_XGEN(j)  (2304 + 64 * (j))
#define XB_TOP      3328
#define XB_TOPGEN   3392
#define XCD_BAR_WORDS 3456
#define XB_SPIN_CAP (1u << 22)

__device__ __forceinline__ unsigned xb_ld(unsigned* p)              { return __hip_atomic_load(p, __ATOMIC_RELAXED, __HIP_MEMORY_SCOPE_AGENT); }
__device__ __forceinline__ unsigned xb_add(unsigned* p, unsigned v) { return __hip_atomic_fetch_add(p, v, __ATOMIC_RELAXED, __HIP_MEMORY_SCOPE_AGENT); }
__device__ __forceinline__ unsigned xb_xcc_id() { return (unsigned)__builtin_amdgcn_s_getreg((3 << 11) | 20) & 0xFu; }
#define XB_SPIN(cond, bar) do { unsigned _sp = 0; while (cond) { __builtin_amdgcn_s_sleep(1); \
    if ((++_sp & 255u) == 0u) { if (xb_ld(&(bar)[XB_TMO])) break; if (_sp > XB_SPIN_CAP) { atomicAdd(&(bar)[XB_TMO], 1u); break; } } } } while (0)

struct XcdBarrier { unsigned* bar; unsigned x; volatile LAS unsigned* st; };

__device__ __forceinline__ XcdBarrier xcd_barrier_post(unsigned* bar, volatile LAS unsigned* st) {
    XcdBarrier b; b.bar = bar; b.x = xb_xcc_id(); b.st = st;
    if (threadIdx.x == 0) { st[2] = xb_add(&bar[XB_XCNT(b.x)], 1u); st[3] = b.x; }
    return b;
}
__device__ __forceinline__ void xcd_barrier_complete(unsigned* bar, unsigned x, unsigned& nloc, unsigned& nx) {
    const unsigned G = gridDim.x * gridDim.y * gridDim.z;
    unsigned sum, cnt, mine, sp = 0u;
    for (;;) {
        sum = 0u; cnt = 0u; mine = 0u;
#pragma unroll
        for (unsigned j = 0; j < 16; ++j) { const unsigned c = xb_ld(&bar[XB_XCNT(j)]); sum += c; cnt += (c > 0u) ? 1u : 0u; mine = (j == x) ? c : mine; }
        if (sum == G) break;
        __builtin_amdgcn_s_sleep(1);
        if ((++sp & 255u) == 0u) { if (xb_ld(&bar[XB_TMO])) break; if (sp > XB_SPIN_CAP) { atomicAdd(&bar[XB_TMO], 1u); break; } }
    }
    nloc = mine > 0u ? mine : 1u; nx = cnt > 0u ? cnt : 1u;
}
__device__ __forceinline__ void xcd_barrier(const XcdBarrier& b, int wave_id) {
    const bool leader_thread = (wave_id == 0) && (__builtin_amdgcn_mbcnt_hi(~0u, __builtin_amdgcn_mbcnt_lo(~0u, 0u)) == 0u);
    asm volatile("s_waitcnt vmcnt(0)" ::: "memory");
    __syncthreads();
    if (leader_thread) {
        unsigned* bar = b.bar;
        __builtin_amdgcn_s_waitcnt(0);
        unsigned nloc = b.st[0], nx = b.st[1];
        if (nloc == 0u) { xcd_barrier_complete(bar, b.x, nloc, nx); b.st[0] = nloc; b.st[1] = nx; }
        const unsigned old = xb_add(&bar[XB_XSUB(b.x)], 1u);
        const unsigned gen = old / nloc;
        if (old + 1u == (gen + 1u) * nloc) {
            __builtin_amdgcn_fence(__ATOMIC_RELEASE, "agent");
            asm volatile("s_waitcnt vmcnt(0)" ::: "memory");
            const unsigned og = xb_add(&bar[XB_TOP], 1u);
            const unsigned tg = og / nx;
            if (og + 1u == (tg + 1u) * nx) xb_add(&bar[XB_TOPGEN], 1u);
            else XB_SPIN(xb_ld(&bar[XB_TOPGEN]) == tg, bar);
            __builtin_amdgcn_fence(__ATOMIC_ACQUIRE, "agent");
            xb_add(&bar[XB_XGEN(b.x)], 1u);
            asm volatile("s_waitcnt vmcnt(0)" ::: "memory");
        } else {
            XB_SPIN(xb_ld(&bar[XB_XGEN(b.x)]) == gen, bar);
            __builtin_amdgcn_fence(__ATOMIC_ACQUIRE, "agent");
            asm volatile("s_waitcnt vmcnt(0)" ::: "memory");
        }
    }
    __syncthreads();
}

__device__ __forceinline__ bf16x8 frag_rowk_l(const LAS bf16_t* p, int ld, int lane) {
    return *(const LAS bf16x8*)(p + (lane & 15) * ld + (lane >> 4) * 8);
}
__device__ __forceinline__ bf16x8 frag_rowk_g(const bf16_t* p, long ld, int lane) {
    return *(const bf16x8*)(p + (long)(lane & 15) * ld + (lane >> 4) * 8);
}
__device__ __forceinline__ bf16x8 frag_colk_l(unsigned p, int ldb, int lane) {
    const unsigned a0 = p + (unsigned)((8 * (lane >> 4) + ((lane & 15) >> 2)) * ldb + (lane & 3) * 8);
    const unsigned a1 = a0 + 4u * (unsigned)ldb;
    s16x4 lo, hi;
    asm volatile("ds_read_b64_tr_b16 %0, %2\n\tds_read_b64_tr_b16 %1, %3\n\ts_waitcnt lgkmcnt(0)" : "=&v"(lo), "=&v"(hi) : "v"(a0), "v"(a1) : "memory");
    return (bf16x8){lo[0], lo[1], lo[2], lo[3], hi[0], hi[1], hi[2], hi[3]};
}
#define MFMA16(a, b, c) __builtin_amdgcn_mfma_f32_16x16x32_bf16((a), (b), (c), 0, 0, 0)
namespace pg8 {
constexpr int BM = 256, BK = 64, HALF = 128, HTB = HALF * BK * 2, STAGE_BYTES = 8 * HTB, NXCD = 8, WGM = 8;
__device__ __forceinline__ int lds_byte(int r, int c) { const int st = (r >> 4) * 2 + (c >> 5), rr = r & 15, cc = c & 31, ob = rr * 64 + cc * 2; return st * 1024 + (ob ^ (((ob >> 9) & 1) << 5)); }
__device__ __forceinline__ void stage_rc(int b, int& R, int& C) { const int st = b / 1024, sb = b % 1024, swz = sb ^ (((sb >> 9) & 1) << 5); R = (st >> 1) * 16 + swz / 64; C = (st & 1) * 32 + (swz % 64) / 2; }
__device__ __forceinline__ int perm32(int rho) { const int n = rho >> 4, i = rho & 15; return 8 * (i >> 2) + 4 * n + (i & 3); }

struct Unit { int pm, pn, e; };
constexpr float WSCALE = 32.0f, WSCALE_INV = 1.0f / 32.0f;

struct DenseOrder {
    const bf16_t* A; const bf16_t* Bt; int ldab, kb, nM, nN, nwg, G, c;
    __device__ __forceinline__ void init(const bf16_t* A_, int lda_, const bf16_t* Bt_, int M, int N, int K_, int G_, int c_) { A = A_; ldab = lda_ * 2; Bt = Bt_; kb = K_ * 2; nM = M / BM; nN = N / BM; nwg = nM * nN; G = G_; c = c_; }
    __device__ __forceinline__ void init8(const void* A_, int ldab_, const void* Bt_, int M, int N, int K_, int G_, int c_) { A = (const bf16_t*)A_; ldab = ldab_; Bt = (const bf16_t*)Bt_; kb = K_; nM = M / BM; nN = N / BM; nwg = nM * nN; G = G_; c = c_; }
    __device__ __forceinline__ void prep(LAS unsigned char*) const {}
    __device__ __forceinline__ int units_of_me() const { return c < nwg ? (nwg - c + G - 1) / G : 0; }
    __device__ __forceinline__ int max_units() const { return (nwg + G - 1) / G; }
    __device__ __forceinline__ bool next(int i, Unit& u) const {
        const long L = (long)i * G + c; if (L >= nwg) return false;
        int wgid = (int)L; { const int q = nwg / NXCD, r = nwg % NXCD, xcd = wgid % NXCD, off = wgid / NXCD; wgid = (xcd < r ? xcd * (q + 1) : r * (q + 1) + (xcd - r) * q) + off; }
        const int nig = WGM * nN, gid = wgid / nig, fm = gid * WGM, gsz = (nM - fm) < WGM ? (nM - fm) : WGM;
        u.pm = fm + ((wgid % nig) % gsz); u.pn = (wgid % nig) / gsz; u.e = 0; return true;
    }
    __device__ __forceinline__ const char* a_base() const { return (const char*)A; }
    __device__ __forceinline__ unsigned a_off(const Unit& u, int r) const { return (unsigned)(u.pm * BM + r) * (unsigned)ldab; }
    __device__ __forceinline__ void a_off4(const Unit& u, int r0, int r1, int half, u32x4& o) const { o.x = a_off(u, r0); o.y = a_off(u, r1); o.z = a_off(u, half + r0); o.w = a_off(u, half + r1); }
    __device__ __forceinline__ const char* b_ptr(const Unit& u) const { return (const char*)Bt + (size_t)u.pn * BM * kb; }
};

template <int MODE  >
struct MoeOrder {
    const void* A; const void* Bt; const int* list; const int* cnt; int ldab, kb, nN, G, c; size_t bstride;
    LAS int* tp; LAS int* cn; LAS int* rb;
    __device__ __forceinline__ void prep(LAS unsigned char* misc, int tid) {
        tp = (LAS int*)(misc + 64); cn = tp + 72; rb = cn + 72;
        if (tid < NEX1) cn[tid] = cnt[tid];
        __syncthreads();
        if (tid == 0) { int s = 0, q = 0; for (int e = 0; e < NEX1; ++e) { tp[e] = s; rb[e] = q; s += (cn[e] + BM - 1) / BM; q += cn[e]; } tp[NEX1] = s; rb[NEX1] = q; }
        __syncthreads();
    }
    __device__ __forceinline__ bool next(int i, Unit& u) const {
        const int total = tp[NEX1]; const long nu = (long)total * nN; const int per = (int)((nu + G - 1) / G);
        (void)per;
        long L = (long)i * G + c;
        if ((G & 7) == 0) L = ((long)i * 8 + (c & 7)) * (G >> 3) + (c >> 3);
        if (L >= nu) return false;
        const int tile = (int)(L / nN); u.pn = (int)(L % nN);
        const int ln_ = (int)__builtin_amdgcn_mbcnt_hi(~0u, __builtin_amdgcn_mbcnt_lo(~0u, 0u));
        const int e = __builtin_popcountll(__ballot(tp[ln_ + 1] <= tile));
        u.e = e; u.pm = tile - tp[e]; return true;
    }
    __device__ __forceinline__ const char* a_base() const { return (const char*)A; }
    __device__ __forceinline__ unsigned a_off(const Unit& u, int r) const {
        int pos = u.pm * BM + r; const int n = cn[u.e]; pos = pos < n ? pos : n - 1;
        if (MODE == 1) return (unsigned)(rb[u.e] + pos) * (unsigned)ldab;
        const int a = list[u.e * TT + pos];
        const int row = a < 8 * TT ? (a >> 3) : a - 8 * TT;
        return (unsigned)row * (unsigned)ldab;
    }
    __device__ __forceinline__ void a_off4(const Unit& u, int r0, int r1, int half, u32x4& o) const {
        if (MODE == 1) { o.x = a_off(u, r0); o.y = a_off(u, r1); o.z = a_off(u, half + r0); o.w = a_off(u, half + r1); return; }
        const int n = cn[u.e], pb = u.pm * BM; const int* lp = list + u.e * TT;
        const int a0 = lp[min(pb + r0, n - 1)], a1 = lp[min(pb + r1, n - 1)], a2 = lp[min(pb + half + r0, n - 1)], a3 = lp[min(pb + half + r1, n - 1)];
        o.x = (unsigned)(a0 < 8 * TT ? (a0 >> 3) : a0 - 8 * TT) * (unsigned)ldab; o.y = (unsigned)(a1 < 8 * TT ? (a1 >> 3) : a1 - 8 * TT) * (unsigned)ldab;
        o.z = (unsigned)(a2 < 8 * TT ? (a2 >> 3) : a2 - 8 * TT) * (unsigned)ldab; o.w = (unsigned)(a3 < 8 * TT ? (a3 >> 3) : a3 - 8 * TT) * (unsigned)ldab;
    }
    __device__ __forceinline__ const char* b_ptr(const Unit& u) const { return (const char*)Bt + (size_t)u.e * bstride + (size_t)u.pn * BM * kb; }
};

typedef int v8i32 __attribute__((ext_vector_type(8)));
typedef int v4i32_ __attribute__((ext_vector_type(4)));
__device__ __forceinline__ v8i32 cat8(bf16x8 a, bf16x8 b) { const u32x4 x = __builtin_bit_cast(u32x4, a), y = __builtin_bit_cast(u32x4, b); return (v8i32){(int)x.x, (int)x.y, (int)x.z, (int)x.w, (int)y.x, (int)y.y, (int)y.z, (int)y.w}; }
template <bool FP8, class Epi, class Sched>
__device__ __forceinline__ void gemm_phase(LAS unsigned char* lds, const Sched& S, const Epi& E, int wave_id) {
    const int wid = wave_id; int lane = (int)__builtin_amdgcn_mbcnt_hi(~0u, __builtin_amdgcn_mbcnt_lo(~0u, 0u)); asm volatile("" : "+v"(lane));
    const int tid = wid * 64 + lane, wr = wid >> 2, wc = wid & 3, fr = lane & 15, fq = lane >> 4;
    const int kb = S.kb; int nt = kb / 128; asm volatile("" : "+s"(nt));
    unsigned voffB[2];
#pragma unroll
    for (int i = 0; i < 2; ++i) { int R, C; stage_rc(tid * 16 + i * 8192, R, C); const int Rb = (R & ~31) + perm32(R & 31);
        voffB[i] = (unsigned)(Rb * kb) + (unsigned)C * 2u; }
#define PG8_AOFF(u, h, i) ({ int _tz = tid; asm volatile("" : "+v"(_tz)); int _R, _C; stage_rc(_tz * 16 + (i) * 8192, _R, _C); S.a_off((u), (h) * HALF + _R) + (unsigned)_C * 2u; })
    const size_t kstep = (size_t)(BK * 2);
    const size_t hstepB = (size_t)HALF * kb;
    const unsigned ldsw = (unsigned)wid * 1024u;
    const int aoff = lds_byte(wr * 64 + fr, fq * 8), boff = lds_byte(wc * 32 + fr, fq * 8);
#define PG8_SA(b, h) (((b) * 2 + (h)) * HTB)
#define PG8_SB(b, h) ((4 + (b) * 2 + (h)) * HTB)
#define PG8_STAGE(bufoff, gbase, v0, v1) do { \
        __builtin_amdgcn_global_load_lds((const unsigned*)((const char*)(gbase) + (v0)), (LAS unsigned*)(lds + (bufoff) + ldsw), 16, 0, 0); \
        __builtin_amdgcn_global_load_lds((const unsigned*)((const char*)(gbase) + (v1)), (LAS unsigned*)(lds + (bufoff) + ldsw + 8192), 16, 0, 0); } while (0)
#define PG8_VOFFB(i) ({ int _tz = tid; asm volatile("" : "+v"(_tz)); int _R, _C; stage_rc(_tz * 16 + (i) * 8192, _R, _C); (unsigned)(((_R & ~31) + perm32(_R & 31)) * kb) + (unsigned)_C * 2u; })
#define PG8_STAGE_B(bufoff, gbase) do { if constexpr (FP8) { int _tz = tid; asm volatile("" : "+v"(_tz)); const u32x2 _vv = *(const LAS u32x2*)(lds + STAGE_BYTES + 8192 + _tz * 8); PG8_STAGE(bufoff, gbase, _vv.x, _vv.y); } else PG8_STAGE(bufoff, gbase, voffB[0], voffB[1]); } while (0)
#define PG8_LD8(off) __builtin_shufflevector(*(const LAS v4i32_*)(lds + (off)), *(const LAS v4i32_*)(lds + (off) + 1024), 0, 1, 2, 3, 4, 5, 6, 7)
#define PG8_LDA(dst, b, h) do { _Pragma("unroll") for (int m = 0; m < 4; ++m) { if constexpr (FP8) dst##8[m] = PG8_LD8(PG8_SA(b, h) + aoff + m * 2048); else { _Pragma("unroll") for (int k = 0; k < 2; ++k) dst[m][k] = *(const LAS bf16x8*)(lds + PG8_SA(b, h) + aoff + m * 2048 + k * 1024); } } } while (0)
#define PG8_LDB(dst, b, h) do { _Pragma("unroll") for (int n = 0; n < 2; ++n) { if constexpr (FP8) dst##8[n] = PG8_LD8(PG8_SB(b, h) + boff + n * 2048); else { _Pragma("unroll") for (int k = 0; k < 2; ++k) dst[n][k] = *(const LAS bf16x8*)(lds + PG8_SB(b, h) + boff + n * 2048 + k * 1024); } } } while (0)
#define PG8_MMA(ai, bj, At, Bt) do { __builtin_amdgcn_s_setprio(1); _Pragma("unroll") for (int m = 0; m < 4; ++m) _Pragma("unroll") for (int n = 0; n < 2; ++n) { \
        if constexpr (FP8) asm volatile("v_mfma_f32_16x16x128_f8f6f4 %0, %1, %2, %0" : "+v"(acc[ai][bj][m][n]) : "v"(Bt##8[n]), "v"(At##8[m])); \
        else { _Pragma("unroll") for (int k = 0; k < 2; ++k) acc[ai][bj][m][n] = __builtin_amdgcn_mfma_f32_16x16x32_bf16(Bt[n][k], At[m][k], acc[ai][bj][m][n], 0, 0, 0); } } \
        __builtin_amdgcn_s_setprio(0); } while (0)
#define PG8_WAIT_V(n) asm volatile("s_waitcnt vmcnt(" #n ")" ::: "memory")
#define PG8_WAIT_L(n) asm volatile("s_waitcnt lgkmcnt(" #n ")" ::: "memory")
#define PG8_BAR __builtin_amdgcn_s_barrier()
#define PG8_SCHED __builtin_amdgcn_sched_barrier(0)
    if constexpr (FP8) { u32x2 _vb; _vb.x = PG8_VOFFB(0); _vb.y = PG8_VOFFB(1); *(LAS u32x2*)(lds + STAGE_BYTES + 8192 + tid * 8) = _vb; }
    Unit cur, nxt; int ui = 0;
    if (!S.next(0, cur)) return;
    f32x4 acc[2][2][4][2];
#pragma unroll
    for (int a = 0; a < 2; ++a)
#pragma unroll
        for (int b = 0; b < 2; ++b)
#pragma unroll
            for (int m = 0; m < 4; ++m)
#pragma unroll
                for (int n = 0; n < 2; ++n) acc[a][b][m][n] = (f32x4){0.f, 0.f, 0.f, 0.f};
    bf16x8 At[4][2], B0[2][2], B1[2][2]; v8i32 At8[4], B08[2], B18[2];
    const char* const gA = S.a_base();
    const char* cB = S.b_ptr(cur);
    unsigned oc00, oc01, oc10, oc11;
    oc00 = PG8_AOFF(cur, 0, 0); oc01 = PG8_AOFF(cur, 0, 1); oc10 = PG8_AOFF(cur, 1, 0); oc11 = PG8_AOFF(cur, 1, 1);
    PG8_STAGE_B(PG8_SB(0, 0), cB); PG8_STAGE_B(PG8_SB(0, 1), cB + hstepB); PG8_STAGE(PG8_SA(0, 0), gA, oc00, oc01); PG8_STAGE(PG8_SA(0, 1), gA, oc10, oc11);
    if (wr == 1) PG8_BAR;
    PG8_WAIT_V(2); PG8_BAR;
    PG8_STAGE_B(PG8_SB(1, 0), cB + kstep); PG8_STAGE(PG8_SA(1, 0), gA + kstep, oc00, oc01); PG8_STAGE_B(PG8_SB(1, 1), cB + hstepB + kstep);
    PG8_WAIT_V(6); PG8_BAR;
    for (;;) {
        const bool has_next = S.next(ui + 1, nxt);
        const char* nB = cB;
        {
            u32x4 on = {oc00, oc01, oc10, oc11};
            if (has_next) {
                int _tz = tid; asm volatile("" : "+v"(_tz)); int _R0, _C0, _R1, _C1; stage_rc(_tz * 16, _R0, _C0); stage_rc(_tz * 16 + 8192, _R1, _C1);
                S.a_off4(nxt, _R0, _R1, HALF, on); on.x += (unsigned)_C0 * 2u; on.y += (unsigned)_C1 * 2u; on.z += (unsigned)_C0 * 2u; on.w += (unsigned)_C1 * 2u; nB = S.b_ptr(nxt); }
            *(LAS u32x4*)(lds + STAGE_BYTES + tid * 16) = on;
        }
        for (int t = 0; t < nt; t += 2) {
            const bool last = (t == nt - 2);
            const char* a1 = gA + (size_t)(t + 1) * kstep;
            const char* a2 = last ? gA : gA + (size_t)(t + 2) * kstep; const char* b2 = last ? nB : cB + (size_t)(t + 2) * kstep;
            const char* a3 = a2 + kstep; const char* b3 = b2 + kstep;
            unsigned s00 = oc00, s01 = oc01, s10 = oc10, s11 = oc11;
            if (last) { const u32x4 on = *(const LAS u32x4*)(lds + STAGE_BYTES + tid * 16); s00 = on.x; s01 = on.y; s10 = on.z; s11 = on.w; }
            PG8_LDB(B0, 0, 0); PG8_LDB(B1, 0, 1); PG8_SCHED; PG8_LDA(At, 0, 0); PG8_STAGE(PG8_SA(1, 1), a1, oc10, oc11);
            PG8_WAIT_V(8); PG8_WAIT_L(0); PG8_BAR; PG8_MMA(0, 0, At, B0); PG8_MMA(0, 1, At, B1); PG8_BAR; PG8_SCHED;
            PG8_LDA(At, 0, 1); PG8_STAGE_B(PG8_SB(0, 0), b2); PG8_STAGE_B(PG8_SB(0, 1), b2 + hstepB); PG8_STAGE(PG8_SA(0, 0), a2, s00, s01);
            PG8_WAIT_V(8); PG8_WAIT_L(0); PG8_BAR; PG8_MMA(1, 0, At, B0); PG8_MMA(1, 1, At, B1); PG8_BAR; PG8_SCHED;
            PG8_LDB(B0, 1, 0); PG8_LDB(B1, 1, 1); PG8_SCHED; PG8_LDA(At, 1, 0); PG8_STAGE(PG8_SA(0, 1), a2, s10, s11);
            PG8_WAIT_V(8); PG8_WAIT_L(0); PG8_BAR; PG8_MMA(0, 0, At, B0); PG8_MMA(0, 1, At, B1); PG8_BAR; PG8_SCHED;
            PG8_LDA(At, 1, 1); PG8_STAGE_B(PG8_SB(1, 0), b3); PG8_STAGE_B(PG8_SB(1, 1), b3 + hstepB); PG8_STAGE(PG8_SA(1, 0), a3, s00, s01);
            PG8_WAIT_V(8); PG8_WAIT_L(0); PG8_BAR; PG8_MMA(1, 0, At, B0); PG8_MMA(1, 1, At, B1); PG8_BAR; PG8_SCHED;
        }
        if (wr == 0) PG8_BAR;
        E(acc, cur, wr, wc, fr, fq);
        if (!has_next) break;
#pragma unroll
        for (int a = 0; a < 2; ++a)
#pragma unroll
            for (int b = 0; b < 2; ++b)
#pragma unroll
                for (int m = 0; m < 4; ++m)
#pragma unroll
                    for (int n = 0; n < 2; ++n) acc[a][b][m][n] = (f32x4){0.f, 0.f, 0.f, 0.f};
        { const u32x4 on = *(const LAS u32x4*)(lds + STAGE_BYTES + tid * 16); oc00 = on.x; oc01 = on.y; oc10 = on.z; oc11 = on.w; }
        cur = nxt; cB = nB; ++ui;
        if (wr == 1) PG8_BAR;
    }
    PG8_WAIT_V(0);
    PG8_BAR;
#undef PG8_SA
#undef PG8_SB
#undef PG8_STAGE
#undef PG8_STAGE_B
#undef PG8_AOFF
#undef PG8_VOFFB
#undef PG8_LD8
#undef PG8_LDA
#undef PG8_LDB
#undef PG8_MMA
#undef PG8_WAIT_V
#undef PG8_WAIT_L
#undef PG8_BAR
#undef PG8_SCHED
}

struct EpiStore {
    bf16_t* O; int ldc; float scale;
    __device__ __forceinline__ void operator()(const f32x4 (&acc)[2][2][4][2], const Unit& u, int wr, int wc, int fr, int fq) const {
        const int row0 = u.pm * BM + wr * 64 + fr, col0 = u.pn * BM + wc * 32 + 8 * fq;
#pragma unroll
        for (int ai = 0; ai < 2; ++ai)
#pragma unroll
            for (int m = 0; m < 4; ++m) { bf16_t* rowp = O + (size_t)(row0 + ai * HALF + m * 16) * ldc + col0;
#pragma unroll
                for (int bj = 0; bj < 2; ++bj) { const f32x4 v0 = acc[ai][bj][m][0] * scale, v1 = acc[ai][bj][m][1] * scale;
                    u32x4 w; w.x = cvt_pk_bf16(v0[0], v0[1]); w.y = cvt_pk_bf16(v0[2], v0[3]); w.z = cvt_pk_bf16(v1[0], v1[1]); w.w = cvt_pk_bf16(v1[2], v1[3]);
                    *(u32x4*)(rowp + bj * HALF) = w; } }
    }
};
struct EpiGlu {
    const bf16_t* Z; const float* b; bf16_t* MIX;
    __device__ __forceinline__ void operator()(const f32x4 (&acc)[2][2][4][2], const Unit& u, int wr, int wc, int fr, int fq) const {
        const int row0 = u.pm * BM + wr * 64 + fr, col0 = u.pn * BM + wc * 32 + 8 * fq;
#pragma unroll
        for (int bj = 0; bj < 2; ++bj) {
            const f32x4 b0 = *(const f32x4*)(b + col0 + bj * HALF), b1 = *(const f32x4*)(b + col0 + bj * HALF + 4);
#pragma unroll
            for (int ai = 0; ai < 2; ++ai)
#pragma unroll
                for (int m = 0; m < 4; ++m) { const size_t row = (size_t)(row0 + ai * HALF + m * 16);
                    const u32x4 zz = *(const u32x4*)(Z + row * 1024 + col0 + bj * HALF);
                    const f32x4 v0 = acc[ai][bj][m][0] + b0, v1 = acc[ai][bj][m][1] + b1;
                    u32x4 w;
                    w.x = cvt_pk_bf16(bflo(zz.x) * sigmoidf_(v0[0]), bfhi(zz.x) * sigmoidf_(v0[1]));
                    w.y = cvt_pk_bf16(bflo(zz.y) * sigmoidf_(v0[2]), bfhi(zz.y) * sigmoidf_(v0[3]));
                    w.z = cvt_pk_bf16(bflo(zz.z) * sigmoidf_(v1[0]), bfhi(zz.z) * sigmoidf_(v1[1]));
                    w.w = cvt_pk_bf16(bflo(zz.w) * sigmoidf_(v1[2]), bfhi(zz.w) * sigmoidf_(v1[3]));
                    *(u32x4*)(MIX + row * DM + 1024 + col0 + bj * HALF) = w; }
        }
    }
};
struct EpiE1 {
    unsigned char* H; const LAS int* cn; const LAS int* rb;
    __device__ __forceinline__ void operator()(const f32x4 (&acc)[2][2][4][2], const Unit& u, int wr, int wc, int fr, int fq) const {
        const int n = cn[u.e]; const int colh = u.pn * 128 + wc * 32 + 8 * fq;
#pragma unroll
        for (int ai = 0; ai < 2; ++ai)
#pragma unroll
            for (int m = 0; m < 4; ++m) { const int pos = u.pm * BM + ai * HALF + wr * 64 + m * 16 + fr;
                if (pos < n) { const int a = rb[u.e] + pos;
                    float sc = WSCALE_INV; asm volatile("" : "+v"(sc));
                    const f32x4 g0 = acc[ai][0][m][0] * sc, g1 = acc[ai][0][m][1] * sc, u0 = acc[ai][1][m][0] * sc, u1 = acc[ai][1][m][1] * sc;
                    u32x2 w;
                    w.x = (unsigned)__builtin_amdgcn_cvt_pk_fp8_f32(siluf_(g0[0]) * u0[0], siluf_(g0[1]) * u0[1], 0, false);
                    w.x = (unsigned)__builtin_amdgcn_cvt_pk_fp8_f32(siluf_(g0[2]) * u0[2], siluf_(g0[3]) * u0[3], (int)w.x, true);
                    w.y = (unsigned)__builtin_amdgcn_cvt_pk_fp8_f32(siluf_(g1[0]) * u1[0], siluf_(g1[1]) * u1[1], 0, false);
                    w.y = (unsigned)__builtin_amdgcn_cvt_pk_fp8_f32(siluf_(g1[2]) * u1[2], siluf_(g1[3]) * u1[3], (int)w.y, true);
                    *(u32x2*)(H + (size_t)a * EHID + colh) = w; }
                __builtin_amdgcn_sched_barrier(0); }
    }
};
struct EpiE2 {
    unsigned char* Y; const float* wgt; const LAS int* cn; const LAS int* rb;
    __device__ __forceinline__ void operator()(const f32x4 (&acc)[2][2][4][2], const Unit& u, int wr, int wc, int fr, int fq) const {
        const int n = cn[u.e]; const int col0 = u.pn * BM + wc * 32 + 8 * fq;
#pragma unroll
        for (int ai = 0; ai < 2; ++ai)
#pragma unroll
            for (int m = 0; m < 4; ++m) { const int pos = u.pm * BM + ai * HALF + wr * 64 + m * 16 + fr;
                if (pos < n) { const int a = rb[u.e] + pos; float ws = WSCALE_INV * 0.25f; asm volatile("" : "+v"(ws));
                    unsigned char* rowp = Y + (size_t)a * DM + col0;
#pragma unroll
                    for (int bj = 0; bj < 2; ++bj) { const f32x4 v0 = acc[ai][bj][m][0] * ws, v1 = acc[ai][bj][m][1] * ws;
                        u32x2 w;
                        w.x = (unsigned)__builtin_amdgcn_cvt_pk_fp8_f32(v0[0], v0[1], 0, false); w.x = (unsigned)__builtin_amdgcn_cvt_pk_fp8_f32(v0[2], v0[3], (int)w.x, true);
                        w.y = (unsigned)__builtin_amdgcn_cvt_pk_fp8_f32(v1[0], v1[1], 0, false); w.y = (unsigned)__builtin_amdgcn_cvt_pk_fp8_f32(v1[2], v1[3], (int)w.y, true);
                        *(u32x2*)(rowp + bj * HALF) = w; } }
                __builtin_amdgcn_sched_barrier(0); }
    }
};
}
struct KArgs {
    const float* in[34];
    float* out;
    unsigned char* ws;
    int ph_lo, ph_hi;
};
struct Params {
    float* out;
    unsigned char* ws;
    LAS unsigned long long* ptab;
    int ph_lo, ph_hi;
    __device__ __forceinline__ const float* inp(int k) const {
        const unsigned long long v = ptab[k];
        const unsigned lo = __builtin_amdgcn_readfirstlane((unsigned)v), hi = __builtin_amdgcn_readfirstlane((unsigned)(v >> 32));
        return (const float*)(((unsigned long long)hi << 32) | lo);
    }
};
struct Ctx {
    LAS unsigned char* lds;
    int tid, lane, wave, G, bid;
    int gw, ngw;
};

__device__ __forceinline__ void tr_item(const float* W, int N, bf16_t* WT, int ldt, int k0, int n0, int orow0, LAS float* scr, int lane) {
#pragma unroll 8
    for (int i = 0; i < 32; ++i) { const int kk = 2 * i + (lane >> 5); scr[kk * 33 + (lane & 31)] = W[(size_t)(k0 + kk) * N + n0 + (lane & 31)]; }
    LDS_WAIT(); asm volatile("" ::: "memory");
    const int c = lane & 7;
#pragma unroll
    for (int j = 0; j < 4; ++j) { const int n = (lane >> 3) + 8 * j; const LAS float* s = scr + (8 * c) * 33 + n;
        u32x4 o; o.x = cvt_pk_bf16(s[0 * 33], s[1 * 33]); o.y = cvt_pk_bf16(s[2 * 33], s[3 * 33]); o.z = cvt_pk_bf16(s[4 * 33], s[5 * 33]); o.w = cvt_pk_bf16(s[6 * 33], s[7 * 33]);
        *(u32x4*)(WT + (size_t)(orow0 + n) * ldt + k0 + 8 * c) = o; }
    LDS_WAIT(); asm volatile("" ::: "memory");
}
__device__ __forceinline__ void tr_item64(const float* W, int N, bf16_t* WT, int ldt, int k0, int n0, int orow0, LAS float* scr, int lane) {
    f32x4 v[16];
    const float* src = W + (size_t)(k0 + (lane >> 4)) * N + n0 + 4 * (lane & 15);
#pragma unroll
    for (int i = 0; i < 16; ++i) v[i] = __builtin_nontemporal_load((const f32x4*)(src + (size_t)(4 * i) * N));
#pragma unroll
    for (int i = 0; i < 16; ++i) { LAS float* d = scr + (4 * i + (lane >> 4)) * 65 + 4 * (lane & 15); d[0] = v[i][0]; d[1] = v[i][1]; d[2] = v[i][2]; d[3] = v[i][3]; }
    LDS_WAIT(); asm volatile("" ::: "memory");
    const int c = lane & 7;
#pragma unroll
    for (int j = 0; j < 8; ++j) { const int n = (lane >> 3) + 8 * j; const LAS float* s = scr + (8 * c) * 65 + n;
        u32x4 o; o.x = cvt_pk_bf16(s[0 * 65], s[1 * 65]); o.y = cvt_pk_bf16(s[2 * 65], s[3 * 65]); o.z = cvt_pk_bf16(s[4 * 65], s[5 * 65]); o.w = cvt_pk_bf16(s[6 * 65], s[7 * 65]);
        *(u32x4*)(WT + (size_t)(orow0 + n) * ldt + k0 + 8 * c) = o; }
    LDS_WAIT(); asm volatile("" ::: "memory");
}
__device__ __forceinline__ void tr_item64_fp8(const float* W, int N, unsigned char* WT, int ldt, int k0, int n0, int orow0, LAS float* scr, int lane, float wscale = pg8::WSCALE) {
    f32x4 v[16];
    const float* src = W + (size_t)(k0 + (lane >> 4)) * N + n0 + 4 * (lane & 15);
#pragma unroll
    for (int i = 0; i < 16; ++i) v[i] = __builtin_nontemporal_load((const f32x4*)(src + (size_t)(4 * i) * N));
#pragma unroll
    for (int i = 0; i < 16; ++i) { LAS float* d = scr + (4 * i + (lane >> 4)) * 65 + 4 * (lane & 15); d[0] = v[i][0]; d[1] = v[i][1]; d[2] = v[i][2]; d[3] = v[i][3]; }
    LDS_WAIT(); asm volatile("" ::: "memory");
    const int c = lane & 3;
#pragma unroll
    for (int j = 0; j < 4; ++j) { const int n = (lane >> 2) + 16 * j; const LAS float* s = scr + (16 * c) * 65 + n;
        u32x4 o;
        o.x = (unsigned)__builtin_amdgcn_cvt_pk_fp8_f32(s[0 * 65] * wscale, s[1 * 65] * wscale, 0, false);   o.x = (unsigned)__builtin_amdgcn_cvt_pk_fp8_f32(s[2 * 65] * wscale, s[3 * 65] * wscale, (int)o.x, true);
        o.y = (unsigned)__builtin_amdgcn_cvt_pk_fp8_f32(s[4 * 65] * wscale, s[5 * 65] * wscale, 0, false);   o.y = (unsigned)__builtin_amdgcn_cvt_pk_fp8_f32(s[6 * 65] * wscale, s[7 * 65] * wscale, (int)o.y, true);
        o.z = (unsigned)__builtin_amdgcn_cvt_pk_fp8_f32(s[8 * 65] * wscale, s[9 * 65] * wscale, 0, false);   o.z = (unsigned)__builtin_amdgcn_cvt_pk_fp8_f32(s[10 * 65] * wscale, s[11 * 65] * wscale, (int)o.z, true);
        o.w = (unsigned)__builtin_amdgcn_cvt_pk_fp8_f32(s[12 * 65] * wscale, s[13 * 65] * wscale, 0, false); o.w = (unsigned)__builtin_amdgcn_cvt_pk_fp8_f32(s[14 * 65] * wscale, s[15 * 65] * wscale, (int)o.w, true);
        *(u32x4*)(WT + (size_t)(orow0 + n) * ldt + k0 + 16 * c) = o; }
    LDS_WAIT(); asm volatile("" ::: "memory");
}
__device__ __forceinline__ void tr_dense(const float* W, int K, int N, bf16_t* WT, int item, LAS float* scr, int lane) {
    const int nblk = N / 32, kb = item / nblk, nb = item % nblk;
    tr_item(W, N, WT, K, 64 * kb, 32 * nb, 32 * nb, scr, lane);
}

__device__ __forceinline__ void s5_tables(const Params& p, Ctx& C, int dir, int g) {
    LAS f32x2* PW = (LAS f32x2*)C.lds;
    LAS f32x2* BB = PW + 65 * 64;
    LAS f32x2* CX = BB + 64 * 16;
    const float* a_re = p.inp(11); const float* a_im = p.inp(12); const float* log_dt = p.inp(13);
    const float* b_re = p.inp(14); const float* b_im = p.inp(15); const float* c_re = p.inp(16); const float* c_im = p.inp(17);
    const int tid = C.tid;
    if (tid < 64) {
        const int pp = tid;
        const float dt = __expf(log_dt[dir * 64 + g]);
        const float are = a_re[(dir * 64 + g) * 64 + pp], aim = a_im[(dir * 64 + g) * 64 + pp];
        const float zr = are * dt, zi = aim * dt;
        const float mag = __expf(zr);
        double rev = (double)zi * 0.15915494309189535; rev -= floor(rev);
        const float cs = __builtin_amdgcn_cosf((float)rev), sn = __builtin_amdgcn_sinf((float)rev);
        const float abr = mag * cs, abi = mag * sn;
        const float den = are * are + aim * aim, nr = abr - 1.0f, ni = abi;
        const float fre = (nr * are + ni * aim) / den, fim = (ni * are - nr * aim) / den;
        float pr = 1.0f, pi = 0.0f;
#pragma unroll 1
        for (int n = 0; n <= 64; ++n) { PW[n * 64 + pp] = (f32x2){pr, pi}; const float t = pr * abr - pi * abi; pi = pr * abi + pi * abr; pr = t; }
        for (int j = 0; j < 16; ++j) { const float br = b_re[(g * 64 + pp) * 16 + j], bi = b_im[(g * 64 + pp) * 16 + j];
            BB[pp * 16 + j] = (f32x2){fre * br - fim * bi, fre * bi + fim * br}; }
    }
    for (int q = tid; q < 1024; q += NTHR) { const int i = q >> 6, pp = q & 63; CX[i * 64 + pp] = (f32x2){c_re[(g * 16 + i) * 64 + pp], c_im[(g * 16 + i) * 64 + pp]}; }
    __syncthreads();
    bf16_t* KN = (bf16_t*)(p.ws + WS_KN) + (size_t)(dir * 64 + g) * 16 * 1024;
    float* APOW = (float*)(p.ws + WS_APOW) + (size_t)(dir * 64 + g) * 64 * 128;
    float* AL = (float*)(p.ws + WS_AL) + (size_t)(dir * 64 + g) * 128;
#pragma unroll 1
    for (int q = 0; q < 32; ++q) { const int idx = tid + NTHR * q; const int n = idx >> 8, i = (idx >> 4) & 15, j = idx & 15;
        float s = 0.f;
#pragma unroll 4
        for (int pp = 0; pp < 64; ++pp) { const f32x2 c = CX[i * 64 + pp], w = PW[n * 64 + pp], b = BB[pp * 16 + j];
            const float gr = c.x * b.x - c.y * b.y, gi = c.x * b.y + c.y * b.x;
            s += gr * w.x - gi * w.y; }
        KN[(size_t)i * 1024 + n * 16 + j] = f2bf(s); }
    for (int q = tid; q < 4096; q += NTHR) { const int t = q >> 6, pp = q & 63; const f32x2 w = PW[(t + 1) * 64 + pp]; *(f32x2*)(APOW + (size_t)t * 128 + 2 * pp) = w; }
    if (tid < 64) { const f32x2 w = PW[64 * 64 + tid]; *(f32x2*)(AL + 2 * tid) = w; }
    { bf16_t* BBT = (bf16_t*)(p.ws + WS_BBT) + (size_t)(dir * 64 + g) * 128 * 16;
      for (int q = tid; q < 2048; q += NTHR) { const int pq = q >> 4, j = q & 15; const f32x2 b = BB[(pq & 63) * 16 + j]; BBT[q] = f2bf(pq < 64 ? b.x : b.y); } }
    if (dir == 0) { bf16_t* CCt = (bf16_t*)(p.ws + WS_CC) + (size_t)g * 16 * 128;
        for (int q = tid; q < 2048; q += NTHR) { const int i = q >> 7, pq = q & 127; const f32x2 c = CX[i * 64 + (pq & 63)]; CCt[i * 128 + pq] = f2bf(pq < 64 ? c.x : -c.y); } }
    __syncthreads();
}

__device__ __forceinline__ void phase_p0(const Params& p, Ctx& C) {
    for (int task = C.bid; task < 128; task += C.G) s5_tables(p, C, task >> 6, task & 63);
    {
        const int gt = C.bid * NTHR + C.tid, ngt = C.G * NTHR;
        float* R128 = (float*)(p.ws + WS_ROPE128); float* R64 = (float*)(p.ws + WS_ROPE64);
        for (int q = gt; q < 256 * 64 + 256 * 32; q += ngt) {
            int pos, i, half; float* dst;
            if (q < 256 * 64) { pos = q >> 6; i = q & 63; half = 64; dst = R128 + (size_t)q * 2; }
            else { const int r = q - 256 * 64; pos = r >> 5; i = r & 31; half = 32; dst = R64 + (size_t)r * 2; }
            const float freq = exp2f(-(float)i / (float)half * 13.287712379549449f);
            const float ang = (float)pos * freq;
            double rev = (double)ang * 0.15915494309189535; rev -= floor(rev);
            dst[0] = __builtin_amdgcn_cosf((float)rev); dst[1] = __builtin_amdgcn_sinf((float)rev);
        }
        bf16_t* RWT = (bf16_t*)(p.ws + WS_RWT); const float* rw = p.inp(26);
        for (int q = gt; q < 2 * 64 * DM; q += ngt) { const int L = q / (64 * DM), r = q % (64 * DM), e = r / DM, k = r % DM;
            const float w = rw[((size_t)L * DM + k) * 64 + e]; const bf16_t hi = f2bf(w); const bf16_t lo = f2bf(w - bf2f(hi));
            RWT[((size_t)(L * 2 + 0) * 64 + e) * DM + k] = hi; RWT[((size_t)(L * 2 + 1) * 64 + e) * DM + k] = lo; }
    }
    {
        const float* cvec = p.inp(1); const float* cctx = p.inp(3); const float* mw = p.inp(4);
        float* MODP = (float*)(p.ws + WS_MODP);
        for (int task = C.gw; task < 2 * 32 * 48; task += C.ngw) {
            const int L = task / (32 * 48), r = task % (32 * 48), kb = r / 48, cb = r % 48;
            const float sc = siluf_(cvec[64 * kb + C.lane]), sx = siluf_(cctx[64 * kb + C.lane]);
            f32x4 a0 = {0.f, 0.f, 0.f, 0.f}, a1 = {0.f, 0.f, 0.f, 0.f};
            const float* wp = mw + ((size_t)L * DM + 64 * kb) * 12288 + 256 * cb + 4 * C.lane;
#pragma unroll 8
            for (int kk = 0; kk < 64; ++kk) { const f32x4 w = *(const f32x4*)(wp + (size_t)kk * 12288);
                const float s0 = __shfl(sc, kk), s1 = __shfl(sx, kk);
                a0 += w * s0; a1 += w * s1; }
            *(f32x4*)(MODP + ((size_t)((L * 32 + kb) * 2 + 0)) * 12288 + 256 * cb + 4 * C.lane) = a0;
            *(f32x4*)(MODP + ((size_t)((L * 32 + kb) * 2 + 1)) * 12288 + 256 * cb + 4 * C.lane) = a1;
        }
    }
    {
        LAS float* scr = (LAS float*)(C.lds + C.wave * 17408);
        constexpr int J0 = (DM / 64) * (EV_IN / 64), J3 = (DM / 64) * (OD_IN / 64);
        for (int it = C.gw; it < J0 + J3; it += C.ngw) {
            const bool l1 = it >= J0; const int r = l1 ? it - J0 : it; const int N = l1 ? OD_IN : EV_IN; const int nblk = N / 64, kb = r / nblk, nb = r % nblk;
            tr_item64_fp8(p.inp(l1 ? 21 : 8), N, (unsigned char*)(p.ws + (l1 ? WS_WIN1 : WS_WIN0)), DM, 64 * kb, 64 * nb, 64 * nb, scr, C.lane, 32.0f);
        }
        LAS float* scr2 = (LAS float*)(C.lds + C.wave * 17408);
        constexpr int I1 = (DM / 64) * (DM / 32), I2 = (1024 / 64) * (1024 / 32), I4 = I1;
        for (int it = C.gw; it < I1 + I2 + I4; it += C.ngw) {
            int r = it;
            if (r < I1) { tr_dense(p.inp(9), DM, DM, (bf16_t*)(p.ws + WS_WOUT0), r, scr2, C.lane); continue; } r -= I1;
            if (r < I2) { tr_dense(p.inp(19), 1024, 1024, (bf16_t*)(p.ws + WS_WGLU), r, scr2, C.lane); continue; } r -= I2;
            tr_dense(p.inp(22), DM, DM, (bf16_t*)(p.ws + WS_WOUT1), r, scr2, C.lane);
        }
    }
}
__device__ __forceinline__ void phase_p1(const Params& p, Ctx& C) {
    const float* MODP = (const float*)(p.ws + WS_MODP); float* MODF = (float*)(p.ws + WS_MODF); const float* mb = p.inp(5);
    for (int q = C.bid * NTHR + C.tid; q < 2 * 2 * 12288; q += C.G * NTHR) { const int L = q / (2 * 12288), v = (q / 12288) & 1, col = q % 12288;
        float s = mb[L * 12288 + col];
        for (int kb = 0; kb < 32; ++kb) s += MODP[((size_t)((L * 32 + kb) * 2 + v)) * 12288 + col];
        MODF[q] = s; }
}
__device__ __forceinline__ const float* modv(const Params& p, int L, int v, int k) { return (const float*)(p.ws + WS_MODF) + (size_t)(L * 2 + v) * 12288 + k * DM; }

__device__ __forceinline__ void stage_vec(LAS float* dst, const float* src, int tid) { *(LAS f32x4*)(dst + 4 * tid) = *(const f32x4*)(src + 4 * tid); }
__device__ __forceinline__ void conv_item(const Params& p, Ctx& C, int L, int it) {
    LAS float* scr = (LAS float*)(C.lds + C.wave * 17408);
    unsigned char* GU = (unsigned char*)(p.ws + WS_GU) + (size_t)L * NEX1 * 1024 * DM; unsigned char* DT = (unsigned char*)(p.ws + WS_DT) + (size_t)L * NEX1 * DM * EHID;
    const int e = it / 768, r = it % 768, which = r >> 8, q = r & 255;
    if (which < 2) {
        const float* W = (e < 64) ? p.inp(28 + which) + ((size_t)(L * 64 + e)) * DM * EHID : p.inp(31 + which) + (size_t)L * DM * EHID;
        const int kb = q >> 3, nb = q & 7, n0 = 64 * nb;
        tr_item64_fp8(W, EHID, GU + (size_t)e * 1024 * DM, DM, 64 * kb, n0, 256 * (n0 >> 7) + (n0 & 127) + (which ? 128 : 0), scr, C.lane);
    } else {
        const float* W = (e < 64) ? p.inp(30) + ((size_t)(L * 64 + e)) * EHID * DM : p.inp(33) + (size_t)L * EHID * DM;
        const int kb = q >> 5, nb = q & 31;
        tr_item64_fp8(W, DM, DT + (size_t)e * DM * EHID, EHID, 64 * kb, 64 * nb, 64 * nb, scr, C.lane);
    }
}
__device__ __forceinline__ void conv_queue(const Params& p, Ctx& C, int quota) {
    unsigned* head = (unsigned*)(p.ws + WS_CTL) + CW_QUEUE + 128;
    const int batch = quota < 8 ? quota : 8;
    for (int done = 0; done < quota; done += batch) {
        int it0 = 0; if (C.lane == 0) it0 = (int)atomicAdd(head, (unsigned)batch);
        it0 = __builtin_amdgcn_readfirstlane(it0);
        if (it0 >= NEX1 * 768) break;
        for (int k = 0; k < batch && it0 + k < NEX1 * 768; ++k) conv_item(p, C, 1, it0 + k);
    }
}
__device__ __forceinline__ void phase_modulate(const Params& p, Ctx& C, int L) {
    unsigned char* XA8 = (unsigned char*)(p.ws + WS_XA);
    const float* X2 = (const float*)(p.ws + WS_HX2);
    LAS float* MV = (LAS float*)C.lds;
    for (int v = 0; v < 2; ++v) { stage_vec(MV + (v * 2 + 0) * DM, modv(p, L, v, 0), C.tid); stage_vec(MV + (v * 2 + 1) * DM, modv(p, L, v, 1), C.tid); }
    __syncthreads();
    for (int r = C.gw; r < TT; r += C.ngw) {
        const int v = r < CTXL ? 1 : 0;
        const float* src = (L == 0) ? (r < CTXL ? p.inp(2) + (size_t)r * DM : p.inp(0) + (size_t)(r - CTXL) * DM) : X2 + (size_t)r * DM;
        const LAS float* sh = MV + (v * 2 + 0) * DM; const LAS float* sc = MV + (v * 2 + 1) * DM;
#pragma unroll
        for (int j = 0; j < 8; ++j) { const int c = 4 * (C.lane + 64 * j);
            const f32x4 x = *(const f32x4*)(src + c), a = *(const LAS f32x4*)(sc + c), b = *(const LAS f32x4*)(sh + c);
            const f32x4 y = x * (a + 1.0f) + b;
            unsigned w = (unsigned)__builtin_amdgcn_cvt_pk_fp8_f32(y[0], y[1], 0, false); w = (unsigned)__builtin_amdgcn_cvt_pk_fp8_f32(y[2], y[3], (int)w, true);
            *(unsigned*)(XA8 + (size_t)r * DM + c) = w; }
    }
    __syncthreads();
    if (L == 0) { for (int it = C.gw; it < NEX1 * 768; it += C.ngw) conv_item(p, C, 0, it); }
    else conv_queue(p, C, 1 << 30);
}

__device__ __forceinline__ void phase_rope0(const Params& p, Ctx& C) {
    bf16_t* QKV = (bf16_t*)(p.ws + WS_BIG + BG_QKV);
    const f32x2* R128 = (const f32x2*)(p.ws + WS_ROPE128);
    for (int r = C.gw; r < TT; r += C.ngw) {
        bf16_t* row = QKV + (size_t)r * EV_IN;
        if (r < CTXL) {
#pragma unroll
            for (int j = 0; j < 2; ++j) { u32x4* q = (u32x4*)(row + 8 * (C.lane + 64 * j)); u32x4 w = *q;
                w.x = cvt_pk_bf16(bflo(w.x) * 0.0625f, bfhi(w.x) * 0.0625f); w.y = cvt_pk_bf16(bflo(w.y) * 0.0625f, bfhi(w.y) * 0.0625f);
                w.z = cvt_pk_bf16(bflo(w.z) * 0.0625f, bfhi(w.z) * 0.0625f); w.w = cvt_pk_bf16(bflo(w.w) * 0.0625f, bfhi(w.w) * 0.0625f); *q = w; }
        } else {
            const int l = r - CTXL, rp = l >> 6, cp = l & 63;
            float xa[16], xc[16]; f32x2 csv[8];
#pragma unroll
            for (int m = 0; m < 8; ++m) { const int pi = C.lane + 64 * m, blk = (pi >> 6) & 1, i = pi & 63; csv[m] = R128[(blk ? cp : rp) * 64 + i]; }
#pragma unroll
            for (int qk = 0; qk < 2; ++qk)
#pragma unroll
                for (int m = 0; m < 8; ++m) { const int pi = C.lane + 64 * m, head = pi >> 7, blk = (pi >> 6) & 1, i = pi & 63;
                    const bf16_t* b = row + qk * 1024 + head * 256 + blk * 128 + i; xa[qk * 8 + m] = bf2f(b[0]); xc[qk * 8 + m] = bf2f(b[64]); }
#pragma unroll
            for (int qk = 0; qk < 2; ++qk)
#pragma unroll
                for (int m = 0; m < 8; ++m) { const int pi = C.lane + 64 * m, head = pi >> 7, blk = (pi >> 6) & 1, i = pi & 63;
                    bf16_t* b = row + qk * 1024 + head * 256 + blk * 128 + i;
                    const f32x2 cs = csv[m];
                    const float x1 = xa[qk * 8 + m], x2 = xc[qk * 8 + m]; const float sc = qk ? 1.0f : 0.0625f;
                    b[0] = f2bf((x1 * cs.x - x2 * cs.y) * sc); b[64] = f2bf((x1 * cs.y + x2 * cs.x) * sc); }
        }
    }
}

__device__ __forceinline__ void phase_normrope1(const Params& p, Ctx& C) {
    bf16_t* QKV = (bf16_t*)(p.ws + WS_BIG + BG_QKV);
    const f32x2* R64 = (const f32x2*)(p.ws + WS_ROPE64);
    const float* qg = p.inp(23);
    unsigned char* Q8 = (unsigned char*)(p.ws + WS_BIG + BG_Q8); unsigned char* K8 = (unsigned char*)(p.ws + WS_BIG + BG_K8); unsigned char* VT8 = (unsigned char*)(p.ws + WS_BIG + BG_VT8);
    unsigned char* Q8D = (unsigned char*)(p.ws + WS_BIG + BG_Q8D); unsigned char* K8D = (unsigned char*)(p.ws + WS_BIG + BG_K8D); unsigned char* VT8D = (unsigned char*)(p.ws + WS_BIG + BG_VT8D);
    const int lane = C.lane, i32 = lane & 31; const bool up = lane >= 32;
    const float g00 = qg[lane], g01 = qg[64 + lane], g10 = qg[128 + lane], g11 = qg[128 + 64 + lane];
    for (int r = C.gw; r < TT; r += C.ngw) {
        bf16_t* row = QKV + (size_t)r * OD_IN;
        const bool lat = r >= CTXL; const int l = r - CTXL, rp = lat ? (l >> 6) : 0, cp = lat ? (l & 63) : 0;
        const f32x2 cr = R64[rp * 32 + i32], cc = R64[cp * 32 + i32];
        float rv0[26], rv1[26];
#pragma unroll
        for (int h = 0; h < 26; ++h) {
            const int col = h < 8 ? 128 * h : (h < 10 ? 1024 + 128 * (h - 8) : (h < 18 ? 1536 + 128 * (h - 10) : 2560 + 128 * (h - 18)));
            rv0[h] = bf2f(row[col + lane]); rv1[h] = bf2f(row[col + 64 + lane]); }
#pragma unroll
        for (int h = 0; h < 26; ++h) {
            const int col = h < 8 ? 128 * h : (h < 10 ? 1024 + 128 * (h - 8) : (h < 18 ? 1536 + 128 * (h - 10) : 2560 + 128 * (h - 18)));
            bf16_t* b = row + col;
            float v0 = rv0[h], v1 = rv1[h];
            if (h < 10) { const float ss = wave_sum(v0 * v0 + v1 * v1); const float rs = rsqrtf(ss * (1.0f / 128.0f) + LN_EPS);
                v0 = bf2f(f2bf(v0 * rs)) * (h < 8 ? g00 : g10); v1 = bf2f(f2bf(v1 * rs)) * (h < 8 ? g01 : g11); }
            if (lat) { const float p0 = __shfl_xor(v0, 32), p1 = __shfl_xor(v1, 32);
                v0 = up ? (p0 * cr.y + v0 * cr.x) : (v0 * cr.x - p0 * cr.y);
                v1 = up ? (p1 * cc.y + v1 * cc.x) : (v1 * cc.x - p1 * cc.y); }
            const bf16_t o0 = f2bf(v0), o1 = f2bf(v1);
            b[lane] = o0; b[64 + lane] = o1;
            {
                const float qs = (h < 8 || (h >= 10 && h < 18)) ? 0.088388347648318440f * 1.4426950408889634f : 1.0f;
                const float w0 = bf2f(o0) * qs, w1 = bf2f(o1) * qs;
                float e4[4];
#pragma unroll
                for (int j = 0; j < 4; ++j) { const float a = __shfl(w0, (4 * lane + j) & 63), c2 = __shfl(w1, (4 * lane + j) & 63); e4[j] = lane < 16 ? a : c2; }
                unsigned pk = (unsigned)__builtin_amdgcn_cvt_pk_fp8_f32(e4[0], e4[1], 0, false); pk = (unsigned)__builtin_amdgcn_cvt_pk_fp8_f32(e4[2], e4[3], (int)pk, true);
                unsigned char* dst8 = h < 8 ? Q8 + (size_t)r * 1024 + 128 * h : (h < 10 ? K8 + (size_t)r * 256 + 128 * (h - 8) : (h < 18 ? Q8D + (size_t)r * 1024 + 128 * (h - 10) : K8D + (size_t)r * 1024 + 128 * (h - 18)));
                if (lane < 32) *(unsigned*)(dst8 + 4 * lane) = pk; }
        }
    }
    LAS bf16_t* vt = (LAS bf16_t*)(C.lds + C.wave * 17408);
    for (int item = C.gw; item < 10 * 260; item += C.ngw) {
        const int kh = item / 260, T = item % 260;
        const int vcol = kh < 2 ? 1280 + 128 * kh : 3584 + 128 * (kh - 2);
        unsigned char* vout = kh < 2 ? VT8 + (size_t)kh * 260 * 8192 : VT8D + (size_t)(kh - 2) * 260 * 8192;
#pragma unroll
        for (int q = 0; q < 16; ++q) { const int idx = lane + 64 * q, key = idx >> 4, c = idx & 15;
            *(LAS u32x4*)(vt + key * 136 + 8 * c) = *(const u32x4*)(QKV + (size_t)(64 * T + key) * OD_IN + vcol + 8 * c); }
        LDS_WAIT(); asm volatile("" ::: "memory");
#pragma unroll
        for (int dd = 0; dd < 2; ++dd) { const int d = lane + 64 * dd;
            unsigned char* dst = vout + ((size_t)T * 128 + d) * 64;
#pragma unroll
            for (int cch = 0; cch < 4; ++cch) { u32x4 w;
#pragma unroll
                for (int wd = 0; wd < 4; ++wd) { float f[4];
#pragma unroll
                    for (int e = 0; e < 4; ++e) { const int bb = 16 * cch + 4 * wd + e, hi2 = bb >> 5, blk = (bb >> 4) & 1, j = bb & 15; const int key = 32 * blk + (j & 3) + 8 * (j >> 2) + 4 * hi2;
                        f[e] = bf2f(vt[key * 136 + d]); }
                    unsigned pk = (unsigned)__builtin_amdgcn_cvt_pk_fp8_f32(f[0], f[1], 0, false); pk = (unsigned)__builtin_amdgcn_cvt_pk_fp8_f32(f[2], f[3], (int)pk, true);
                    w[wd] = pk; }
                *(u32x4*)(dst + 16 * cch) = w; } }
        LDS_WAIT(); asm volatile("" ::: "memory");
    }
}

__device__ __forceinline__ void phase_merge1(const Params& p, Ctx& C) {
    bf16_t* ATT = (bf16_t*)(p.ws + WS_BIG + BG_ATT);
    const float* dl = p.inp(24); const float* sg = p.inp(25);
    const int lane = C.lane;
    float d0 = dl[lane] * dl[128 + lane] + dl[64 + lane] * dl[128 + 64 + lane];
    float d1 = dl[256 + lane] * dl[384 + lane] + dl[256 + 64 + lane] * dl[384 + 64 + lane];
    const float lam = __expf(wave_sum(d0)) - __expf(wave_sum(d1)) + LAMBDA_INIT;
    const f32x4 gg = *(const f32x4*)(sg + 4 * lane);
    for (int l = C.gw; l < SEQ; l += C.ngw) {
        bf16_t* row = ATT + (size_t)l * 3072;
        u32x2 av[4], bv[4];
#pragma unroll
        for (int h = 0; h < 4; ++h) { av[h] = *(const u32x2*)(row + 1024 + 256 * h + 4 * lane); bv[h] = *(const u32x2*)(row + 2048 + 256 * h + 4 * lane); }
#pragma unroll
        for (int h = 0; h < 4; ++h) {
            const u32x2 a = av[h], b = bv[h];
            f32x4 o = {bflo(a.x) - lam * bflo(b.x), bfhi(a.x) - lam * bfhi(b.x), bflo(a.y) - lam * bflo(b.y), bfhi(a.y) - lam * bfhi(b.y)};
            const float ss = wave_sum(o[0] * o[0] + o[1] * o[1] + o[2] * o[2] + o[3] * o[3]);
            const float rs = rsqrtf(ss * (1.0f / 256.0f) + LN_EPS) * (1.0f - LAMBDA_INIT);
            o = o * rs * gg;
            u32x2 w; w.x = cvt_pk_bf16(o[0], o[1]); w.y = cvt_pk_bf16(o[2], o[3]);
            *(u32x2*)(row + 1024 + 256 * h + 4 * lane) = w;
        }
    }
}

__device__ __forceinline__ void phase_ln1(const Params& p, Ctx& C, int L) {
    const bf16_t* Y = (const bf16_t*)(p.ws + WS_YMIX); float* X1 = (float*)(p.ws + WS_X1); unsigned char* XA8 = (unsigned char*)(p.ws + WS_XA);
    const float* X2 = (const float*)(p.ws + WS_HX2);
    const float* lg = p.inp(6) + (size_t)(L * 2 + 0) * DM; const float* lb = p.inp(7) + (size_t)(L * 2 + 0) * DM;
    const int r0 = (L == 0) ? 0 : CTXL;
    LAS float* MV = (LAS float*)C.lds; LAS float* LG = MV + 6 * DM; LAS float* LB = LG + DM;
    for (int v = 0; v < 2; ++v) for (int k = 0; k < 3; ++k) stage_vec(MV + (v * 3 + k) * DM, modv(p, L, v, 2 + k), C.tid);
    stage_vec(LG, lg, C.tid); stage_vec(LB, lb, C.tid);
    __syncthreads();
    for (int r = r0 + C.gw; r < TT; r += C.ngw) {
        const int v = r < CTXL ? 1 : 0;
        const float* src = (L == 0) ? (r < CTXL ? p.inp(2) + (size_t)r * DM : p.inp(0) + (size_t)(r - CTXL) * DM) : X2 + (size_t)r * DM;
        const LAS float* g1 = MV + (v * 3 + 0) * DM; const LAS float* sh2 = MV + (v * 3 + 1) * DM; const LAS float* sc2 = MV + (v * 3 + 2) * DM;
        f32x4 t[8]; float s = 0.f;
#pragma unroll
        for (int j = 0; j < 8; ++j) { const int c = 4 * (C.lane + 64 * j);
            const f32x4 x = *(const f32x4*)(src + c), g = *(const LAS f32x4*)(g1 + c); const u32x2 yy = *(const u32x2*)(Y + (size_t)r * DM + c);
            const f32x4 y = {bflo(yy.x), bfhi(yy.x), bflo(yy.y), bfhi(yy.y)};
            t[j] = x * ALPHA + g * y; s += (t[j][0] + t[j][1]) + (t[j][2] + t[j][3]); }
        const float mean = wave_sum(s) * (1.0f / DM); float s2 = 0.f;
#pragma unroll
        for (int j = 0; j < 8; ++j) { t[j] = t[j] - mean; s2 += (t[j][0] * t[j][0] + t[j][1] * t[j][1]) + (t[j][2] * t[j][2] + t[j][3] * t[j][3]); }
        const float rstd = rsqrtf(wave_sum(s2) * (1.0f / DM) + LN_EPS);
#pragma unroll
        for (int j = 0; j < 8; ++j) { const int c = 4 * (C.lane + 64 * j);
            const f32x4 x1 = t[j] * rstd * *(const LAS f32x4*)(LG + c) + *(const LAS f32x4*)(LB + c);
            *(f32x4*)(X1 + (size_t)r * DM + c) = x1;
            const f32x4 z = x1 * (*(const LAS f32x4*)(sc2 + c) + 1.0f) + *(const LAS f32x4*)(sh2 + c);
            unsigned w = (unsigned)__builtin_amdgcn_cvt_pk_fp8_f32(z[0], z[1], 0, false); w = (unsigned)__builtin_amdgcn_cvt_pk_fp8_f32(z[2], z[3], (int)w, true);
            *(unsigned*)(XA8 + (size_t)r * DM + c) = w; }
    }
    __syncthreads();
}

__device__ __forceinline__ void phase_combine(const Params& p, Ctx& C, int L, LAS unsigned char* misc) {
    const unsigned char* YM = (const unsigned char*)(p.ws + WS_BIG + BG_YMOE); const float* X1 = (const float*)(p.ws + WS_X1);
    float* X2 = (float*)(p.ws + WS_HX2);
    const float* lg = p.inp(6) + (size_t)(L * 2 + 1) * DM; const float* lb = p.inp(7) + (size_t)(L * 2 + 1) * DM;
    const unsigned* PK = (const unsigned*)(p.ws + WS_WGT); const int* cnt = (const int*)(p.ws + WS_CTL) + CW_CNT + L * 128; const float* LWT = (const float*)(p.ws + WS_LW);
    const int r0 = (L == 0) ? 0 : CTXL;
    LAS int* rb = (LAS int*)(misc + 64);
    LAS float* MV = (LAS float*)C.lds; LAS float* LG = MV + 2 * DM; LAS float* LB = LG + DM;
    __syncthreads();
    if (C.tid == 0) { int q = 0; for (int e = 0; e < NEX1; ++e) { rb[e] = q; q += cnt[e]; } }
    stage_vec(MV, modv(p, L, 0, 5), C.tid); stage_vec(MV + DM, modv(p, L, 1, 5), C.tid); stage_vec(LG, lg, C.tid); stage_vec(LB, lb, C.tid);
    LAS float* M1 = LB + DM;
    unsigned char* XA8 = (unsigned char*)(p.ws + WS_XA);
    if (L == 0) { for (int v = 0; v < 2; ++v) { stage_vec(M1 + (v * 2 + 0) * DM, modv(p, 1, v, 0), C.tid); stage_vec(M1 + (v * 2 + 1) * DM, modv(p, 1, v, 1), C.tid); } }
    __syncthreads();
    for (int r = r0 + C.gw; r < TT; r += C.ngw) {
        const int v = r < CTXL ? 1 : 0;
        const LAS float* g2 = MV + v * DM;
        int ln = C.lane; asm volatile("" : "+v"(ln));
        int slot = rb[64] + (r - r0);
        float wk = 4.0f;
        if (ln < 8) { const unsigned pk = PK[(size_t)r * 8 + ln]; wk = LWT[(size_t)r * 8 + ln]; slot = rb[pk >> 16] + (int)(pk & 0xffffu); }
        f32x4 t[2][4]; float s = 0.f;
#pragma unroll
        for (int j = 0; j < 2; ++j) { const int c = 16 * (ln + 64 * j);
            u32x4 yy[9];
#pragma unroll
            for (int k = 0; k < 9; ++k) { const size_t a = (size_t)__builtin_amdgcn_readlane(slot, k); yy[k] = __builtin_nontemporal_load((const u32x4*)(YM + a * DM + c)); }
            f32x2 f[8];
#pragma unroll
            for (int q = 0; q < 8; ++q) f[q] = (f32x2){0.f, 0.f};
#pragma unroll
            for (int k = 0; k < 9; ++k) { const float wq = __int_as_float(__builtin_amdgcn_readlane(__float_as_int(wk), k));
                f[0] += wq * __builtin_amdgcn_cvt_pk_f32_fp8((int)yy[k].x, false); f[1] += wq * __builtin_amdgcn_cvt_pk_f32_fp8((int)yy[k].x, true);
                f[2] += wq * __builtin_amdgcn_cvt_pk_f32_fp8((int)yy[k].y, false); f[3] += wq * __builtin_amdgcn_cvt_pk_f32_fp8((int)yy[k].y, true);
                f[4] += wq * __builtin_amdgcn_cvt_pk_f32_fp8((int)yy[k].z, false); f[5] += wq * __builtin_amdgcn_cvt_pk_f32_fp8((int)yy[k].z, true);
                f[6] += wq * __builtin_amdgcn_cvt_pk_f32_fp8((int)yy[k].w, false); f[7] += wq * __builtin_amdgcn_cvt_pk_f32_fp8((int)yy[k].w, true); }
#pragma unroll
            for (int q = 0; q < 4; ++q) { const f32x4 x = *(const f32x4*)(X1 + (size_t)r * DM + c + 4 * q), g = *(const LAS f32x4*)(g2 + c + 4 * q);
                const f32x4 ff = {f[2 * q][0], f[2 * q][1], f[2 * q + 1][0], f[2 * q + 1][1]};
                t[j][q] = x * ALPHA + g * ff; s += (t[j][q][0] + t[j][q][1]) + (t[j][q][2] + t[j][q][3]); } }
        const float mean = wave_sum(s) * (1.0f / DM); float s2 = 0.f;
#pragma unroll
        for (int j = 0; j < 2; ++j)
#pragma unroll
            for (int q = 0; q < 4; ++q) { t[j][q] = t[j][q] - mean; s2 += (t[j][q][0] * t[j][q][0] + t[j][q][1] * t[j][q][1]) + (t[j][q][2] * t[j][q][2] + t[j][q][3] * t[j][q][3]); }
        const float rstd = rsqrtf(wave_sum(s2) * (1.0f / DM) + LN_EPS);
        float* dst = (L == 0) ? X2 + (size_t)r * DM : p.out + (size_t)(r - CTXL) * DM;
#pragma unroll
        for (int j = 0; j < 2; ++j)
#pragma unroll
            for (int q = 0; q < 4; ++q) { const int c = 16 * (ln + 64 * j) + 4 * q;
                const f32x4 xn = t[j][q] * rstd * *(const LAS f32x4*)(LG + c) + *(const LAS f32x4*)(LB + c);
                *(f32x4*)(dst + c) = xn;
                if (L == 0) { const f32x4 y = xn * (*(const LAS f32x4*)(M1 + (v * 2 + 1) * DM + c) + 1.0f) + *(const LAS f32x4*)(M1 + (v * 2 + 0) * DM + c);
                    unsigned w = (unsigned)__builtin_amdgcn_cvt_pk_fp8_f32(y[0], y[1], 0, false); w = (unsigned)__builtin_amdgcn_cvt_pk_fp8_f32(y[2], y[3], (int)w, true);
                    *(unsigned*)(XA8 + (size_t)r * DM + c) = w; } }
    }
    if (L == 0) { __syncthreads(); conv_queue(p, C, 1 << 30); }
}
constexpr int RLD = 264;
constexpr int SLD = 136;

template <bool SCALE>
__device__ __forceinline__ void stage_chunk(const bf16_t* QKV, int row0, int col0, LAS bf16_t* dst, int tid, float lg  , int dirb) {
#pragma unroll
    for (int q = 0; q < 8; ++q) { const int idx = tid + NTHR * q, r = idx >> 5, c = idx & 31;
        u32x4 w = *(const u32x4*)(QKV + (size_t)(row0 + r) * EV_IN + col0 + 8 * c);
        if (SCALE) { const float sc = fast_exp((dirb ? (float)r : (float)(127 - r)) * lg);
            w.x = cvt_pk_bf16(bflo(w.x) * sc, bfhi(w.x) * sc); w.y = cvt_pk_bf16(bflo(w.y) * sc, bfhi(w.y) * sc);
            w.z = cvt_pk_bf16(bflo(w.z) * sc, bfhi(w.z) * sc); w.w = cvt_pk_bf16(bflo(w.w) * sc, bfhi(w.w) * sc); }
        *(LAS u32x4*)(dst + r * RLD + 8 * c) = w; }
}

__device__ __forceinline__ void ret_chunk_kv(const Params& p, Ctx& C) {
    const bf16_t* QKV = (const bf16_t*)(p.ws + WS_BIG + BG_QKV); bf16_t* CKV = (bf16_t*)(p.ws + WS_BIG + BG_CKV);
    const float* rld = p.inp(10);
    LAS bf16_t* Vs = (LAS bf16_t*)C.lds; LAS bf16_t* Ks = Vs + 128 * RLD;
    const int lane = C.lane, w = C.wave;
    for (int unit = C.bid; unit < 130 * 8; unit += C.G) {
        const int u = unit >> 3, h = (unit >> 1) & 3, dir = unit & 1;
        const float lg = rld[dir * 4 + h];
        __syncthreads();
        stage_chunk<false>(QKV, 128 * u, 2048 + 256 * h, Vs, C.tid, 0.f, 0);
        stage_chunk<true>(QKV, 128 * u, 1024 + 256 * h, Ks, C.tid, lg, dir);
        __syncthreads();
        f32x4 acc[2][16];
#pragma unroll
        for (int a = 0; a < 2; ++a)
#pragma unroll
            for (int b = 0; b < 16; ++b) acc[a][b] = (f32x4){0.f, 0.f, 0.f, 0.f};
        const unsigned vbase = (unsigned)(uintptr_t)Vs, kbase = (unsigned)(uintptr_t)Ks;
#pragma unroll 1
        for (int ks = 0; ks < 4; ++ks) {
            bf16x8 af[2];
#pragma unroll
            for (int a = 0; a < 2; ++a) af[a] = frag_colk_l(vbase + (unsigned)((32 * ks) * RLD + 32 * w + 16 * a) * 2u, RLD * 2, lane);
#pragma unroll
            for (int b = 0; b < 16; ++b) { const bf16x8 bf = frag_colk_l(kbase + (unsigned)((32 * ks) * RLD + 16 * b) * 2u, RLD * 2, lane);
                acc[0][b] = MFMA16(bf, af[0], acc[0][b]); acc[1][b] = MFMA16(bf, af[1], acc[1][b]); }
        }
        bf16_t* dst = CKV + ((size_t)((dir * 4 + h) * 130 + u)) * 65536;
#pragma unroll
        for (int a = 0; a < 2; ++a)
#pragma unroll
            for (int b = 0; b < 16; ++b) { u32x2 w2; w2.x = cvt_pk_bf16(acc[a][b][0], acc[a][b][1]); w2.y = cvt_pk_bf16(acc[a][b][2], acc[a][b][3]);
                *(u32x2*)(dst + (size_t)(32 * w + 16 * a + (lane & 15)) * 256 + 16 * b + 4 * (lane >> 4)) = w2; }
    }
    __syncthreads();
}

__device__ __forceinline__ int s5_row(int dir, int c, int s) { return dir == 0 ? 64 * c + s : (c < 4 ? 255 - (64 * c + s) : 16639 - 64 * (c - 4) - s); }

__device__ __forceinline__ void s5_end_states(const Params& p, Ctx& C) {
    const bf16_t* QKV = (const bf16_t*)(p.ws + WS_BIG + BG_QKV); const bf16_t* BBT = (const bf16_t*)(p.ws + WS_BBT); float* E = (float*)(p.ws + WS_S5E);
    const float* APOW = (const float*)(p.ws + WS_APOW);
    LAS f32x2* PL = (LAS f32x2*)C.lds;
    for (int bt = C.bid; bt < 256; bt += C.G) {
        int tid = C.tid; asm volatile("" : "+v"(tid));
        const int lane = tid & 63, r32 = lane & 31, hi = lane >> 5;
        const int dg = bt >> 1, dir = dg >> 6, g = dg & 63, c0 = 130 * (bt & 1);
        __syncthreads();
#pragma unroll
        for (int q = 0; q < 8; ++q) { const int idx = tid + NTHR * q, s = idx >> 6, pp = idx & 63;
            PL[idx] = (s == 63) ? (f32x2){1.0f, 0.0f} : *(const f32x2*)(APOW + ((size_t)dg * 64 + (62 - s)) * 128 + 2 * pp); }
        __syncthreads();
        bf16x8 bfr[4];
#pragma unroll
        for (int pt = 0; pt < 4; ++pt) bfr[pt] = *(const bf16x8*)(BBT + ((size_t)dg * 128 + 32 * pt + r32) * 16 + 8 * hi);
        for (int c = c0 + C.wave; c < c0 + 130; c += 8) {
            float er[2] = {0.f, 0.f}, ei[2] = {0.f, 0.f};
#pragma unroll
            for (int st = 0; st < 2; ++st) {
                const bf16x8 a = *(const bf16x8*)(QKV + (size_t)s5_row(dir, c, 32 * st + r32) * EV_IN + 4096 + 16 * g + 8 * hi);
                f32x16 d[4];
#pragma unroll
                for (int pt = 0; pt < 4; ++pt) d[pt] = __builtin_amdgcn_mfma_f32_32x32x16_bf16(a, bfr[pt], (f32x16){}, 0, 0, 0);
#pragma unroll
                for (int r = 0; r < 16; ++r) { const int s = 32 * st + (r & 3) + 8 * (r >> 2) + 4 * hi;
#pragma unroll
                    for (int pt = 0; pt < 2; ++pt) { const f32x2 pw = PL[s * 64 + 32 * pt + r32]; const float br = d[pt][r], bi = d[pt + 2][r];
                        er[pt] += pw.x * br - pw.y * bi; ei[pt] += pw.x * bi + pw.y * br; } }
            }
#pragma unroll
            for (int pt = 0; pt < 2; ++pt) {
                { auto rr = __builtin_amdgcn_permlane32_swap(__float_as_uint(er[pt]), __float_as_uint(er[pt]), false, false); er[pt] = __uint_as_float(rr[0]) + __uint_as_float(rr[1]); }
                { auto rr = __builtin_amdgcn_permlane32_swap(__float_as_uint(ei[pt]), __float_as_uint(ei[pt]), false, false); ei[pt] = __uint_as_float(rr[0]) + __uint_as_float(rr[1]); }
            }
            float* dst = E + ((size_t)dg * 260 + c) * 128;
            if (hi == 0) { dst[r32] = er[0]; dst[32 + r32] = er[1]; dst[64 + r32] = ei[0]; dst[96 + r32] = ei[1]; }
        }
    }
    __syncthreads();
}

__device__ __forceinline__ void phase_scans(const Params& p, Ctx& C) {
    const bf16_t* CKV = (const bf16_t*)(p.ws + WS_BIG + BG_CKV); bf16_t* SP = (bf16_t*)(p.ws + WS_BIG + BG_SPREV);
    const float* rld = p.inp(10);
    for (int q = C.bid * NTHR + C.tid; q < 8 * 16384; q += C.G * NTHR) {
        const int dh = q >> 14, el = (q & 16383) * 4, dir = dh >> 2, h = dh & 3;
        const float gch = fast_exp(128.0f * rld[dir * 4 + h]);
        const bf16_t* src = CKV + (size_t)dh * 130 * 65536 + el; bf16_t* dst = SP + (size_t)dh * 130 * 65536 + el;
        f32x4 s = {0.f, 0.f, 0.f, 0.f};
        for (int st0 = 0; st0 < 130; st0 += 13) {
            u32x2 kv[13];
#pragma unroll
            for (int k = 0; k < 13; ++k) { const int st = st0 + k; const int u = dir == 0 ? st : (st == 0 ? 1 : (st == 1 ? 0 : 131 - st)); kv[k] = __builtin_nontemporal_load((const u32x2*)(src + (size_t)u * 65536)); }
#pragma unroll
            for (int k = 0; k < 13; ++k) { const int st = st0 + k; const int u = dir == 0 ? st : (st == 0 ? 1 : (st == 1 ? 0 : 131 - st));
                u32x2 w; w.x = cvt_pk_bf16(s[0], s[1]); w.y = cvt_pk_bf16(s[2], s[3]); *(u32x2*)(dst + (size_t)u * 65536) = w;
                s = s * gch + (f32x4){bflo(kv[k].x), bfhi(kv[k].x), bflo(kv[k].y), bfhi(kv[k].y)}; }
        }
    }
    const float* E = (const float*)(p.ws + WS_S5E); float* HST = (float*)(p.ws + WS_HST); const float* AL = (const float*)(p.ws + WS_AL);
    for (int q = C.bid * NTHR + C.tid; q < 2 * 64 * 64; q += C.G * NTHR) {
        const int dg = q >> 6, pp = q & 63;
        const f32x2 al = *(const f32x2*)(AL + (size_t)dg * 128 + 2 * pp);
        const float* e = E + (size_t)dg * 260 * 128; float* hs = HST + (size_t)dg * 260 * 128;
        float hr = 0.f, hi = 0.f;
        for (int c0 = 0; c0 < 260; c0 += 26) {
            float er[26], ei[26];
#pragma unroll
            for (int k = 0; k < 26; ++k) { er[k] = e[(size_t)(c0 + k) * 128 + pp]; ei[k] = e[(size_t)(c0 + k) * 128 + 64 + pp]; }
#pragma unroll
            for (int k = 0; k < 26; ++k) { *(f32x2*)(hs + (size_t)(c0 + k) * 128 + 2 * pp) = (f32x2){hr, hi};
                const float t = al.x * hr - al.y * hi + er[k]; hi = al.x * hi + al.y * hr + ei[k]; hr = t; }
        }
    }
}

__device__ __forceinline__ void ret_output_unit(const Params& p, Ctx& C, int unit) {
    const bf16_t* QKV = (const bf16_t*)(p.ws + WS_BIG + BG_QKV); const bf16_t* SP = (const bf16_t*)(p.ws + WS_BIG + BG_SPREV);
    bf16_t* MIX = (bf16_t*)(p.ws + WS_BIG + BG_MIX);
    const float* rld = p.inp(10);
    LAS bf16_t* RA = (LAS bf16_t*)C.lds; LAS bf16_t* RB = RA + 128 * RLD;
    int tid = C.tid; asm volatile("" : "+v"(tid));
    const int lane = tid & 63, w = C.wave, kq = lane >> 4, fr = lane & 15;
    const int u = unit >> 2, h = unit & 3;
    const float lgf = rld[h], lgb = rld[4 + h];
    stage_chunk<false>(QKV, 128 * u, 256 * h, RA, tid, 0.f, 0);
    int ib = 16 * w + 4 * kq, jb = fr; asm volatile("" : "+v"(ib), "+v"(jb));
    f32x4 acc[16];
#pragma unroll
    for (int t = 0; t < 16; ++t) acc[t] = (f32x4){0.f, 0.f, 0.f, 0.f};
#pragma unroll
    for (int dir = 0; dir < 2; ++dir) {
        const bf16_t* Sd = SP + ((size_t)((dir * 4 + h) * 130 + u)) * 65536;
#pragma unroll
        for (int eh = 0; eh < 2; ++eh) {
            __syncthreads();
#pragma unroll
            for (int q = 0; q < 8; ++q) { const int idx = tid + NTHR * q, rr = idx >> 5, c = idx & 31;
                *(LAS u32x4*)(RB + rr * RLD + 8 * c) = *(const u32x4*)(Sd + (size_t)(128 * eh + rr) * 256 + 8 * c);
                if (q == 3) asm volatile("" ::: "memory"); }
            __syncthreads();
#pragma unroll 1
            for (int ks = 0; ks < 8; ++ks) { const bf16x8 af = frag_rowk_l(RA + (16 * w) * RLD + 32 * ks, RLD, lane);
#pragma unroll
                for (int t = 0; t < 8; ++t) { const bf16x8 bf = frag_rowk_l(RB + (16 * t) * RLD + 32 * ks, RLD, lane); acc[8 * eh + t] = MFMA16(af, bf, acc[8 * eh + t]); } }
        }
#pragma unroll
        for (int r = 0; r < 4; ++r) { const int i = ib + r; const float qd = fast_exp((float)(128 - i) * lgb);
            const float f = (dir == 0) ? fast_exp((float)(i + 1) * lgf) / qd : qd;
#pragma unroll
            for (int t = 0; t < 16; ++t) acc[t][r] *= f; }
    }
    __syncthreads();
    stage_chunk<false>(QKV, 128 * u, 1024 + 256 * h, RB, tid, 0.f, 0);
    __syncthreads();
    f32x4 sc[8];
#pragma unroll
    for (int t = 0; t < 8; ++t) sc[t] = (f32x4){0.f, 0.f, 0.f, 0.f};
#pragma unroll 1
    for (int ks = 0; ks < 8; ++ks) { const bf16x8 af = frag_rowk_l(RA + (16 * w) * RLD + 32 * ks, RLD, lane);
#pragma unroll
        for (int t = 0; t < 8; ++t) { const bf16x8 bf = frag_rowk_l(RB + (16 * t) * RLD + 32 * ks, RLD, lane); sc[t] = MFMA16(af, bf, sc[t]); } }
#pragma unroll
    for (int t = 0; t < 8; ++t)
#pragma unroll
        for (int r = 0; r < 4; ++r) { const int i = ib + r, j = 16 * t + jb; const float d = (float)(i - j);
            const float m = (i >= j ? fast_exp(d * lgf) : 0.f) + (j >= i ? fast_exp(-d * lgb) : 0.f); sc[t][r] *= m; }
    __syncthreads();
    stage_chunk<false>(QKV, 128 * u, 2048 + 256 * h, RA, tid, 0.f, 0);
#pragma unroll
    for (int t = 0; t < 8; ++t)
#pragma unroll
        for (int r = 0; r < 4; ++r) RB[(16 * w + 4 * kq + r) * SLD + 16 * t + fr] = f2bf(sc[t][r]);
    __syncthreads();
    const unsigned vbase = (unsigned)(uintptr_t)RA;
#pragma unroll 1
    for (int ks = 0; ks < 4; ++ks) { const bf16x8 af = frag_rowk_l(RB + (16 * w) * SLD + 32 * ks, SLD, lane);
#pragma unroll
        for (int t = 0; t < 16; ++t) { const bf16x8 bf = frag_colk_l(vbase + (unsigned)((32 * ks) * RLD + 16 * t) * 2u, RLD * 2, lane); acc[t] = MFMA16(af, bf, acc[t]); } }
    __syncthreads();
#pragma unroll
    for (int r = 0; r < 4; ++r) {
        float s = 0.f;
#pragma unroll
        for (int t = 0; t < 16; ++t) s += acc[t][r];
        s += __shfl_xor(s, 1); s += __shfl_xor(s, 2); s += __shfl_xor(s, 4); s += __shfl_xor(s, 8);
        const float mean = s * (1.0f / 256.0f); float q = 0.f;
#pragma unroll
        for (int t = 0; t < 16; ++t) { const float d = acc[t][r] - mean; q += d * d; }
        q += __shfl_xor(q, 1); q += __shfl_xor(q, 2); q += __shfl_xor(q, 4); q += __shfl_xor(q, 8);
        const float rstd = rsqrtf(q * (1.0f / 256.0f) + LN_EPS);
#pragma unroll
        for (int t = 0; t < 16; ++t) RA[(16 * w + 4 * kq + r) * RLD + 16 * t + fr] = f2bf((acc[t][r] - mean) * rstd);
    }
    __syncthreads();
#pragma unroll
    for (int q = 0; q < 8; ++q) { const int idx = tid + NTHR * q, rr = idx >> 5, c = idx & 31; const size_t row = (size_t)(128 * u + rr);
        const u32x4 o = *(const LAS u32x4*)(RA + rr * RLD + 8 * c), g = *(const u32x4*)(QKV + row * EV_IN + 3072 + 256 * h + 8 * c);
        u32x4 w4;
        w4.x = cvt_pk_bf16(bflo(o.x) * siluf_(bflo(g.x)), bfhi(o.x) * siluf_(bfhi(g.x))); w4.y = cvt_pk_bf16(bflo(o.y) * siluf_(bflo(g.y)), bfhi(o.y) * siluf_(bfhi(g.y)));
        w4.z = cvt_pk_bf16(bflo(o.z) * siluf_(bflo(g.z)), bfhi(o.z) * siluf_(bfhi(g.z))); w4.w = cvt_pk_bf16(bflo(o.w) * siluf_(bflo(g.w)), bfhi(o.w) * siluf_(bfhi(g.w)));
        *(u32x4*)(MIX + row * DM + 256 * h + 8 * c) = w4; }
    __syncthreads();
}

constexpr int KLD = 1032;
__device__ __forceinline__ void s5_output_task(const Params& p, Ctx& C, int bt) {
    const bf16_t* QKV = (const bf16_t*)(p.ws + WS_BIG + BG_QKV); bf16_t* Z = (bf16_t*)(p.ws + WS_Z);
    const bf16_t* KN = (const bf16_t*)(p.ws + WS_KN); const bf16_t* CCt = (const bf16_t*)(p.ws + WS_CC);
    const float* APOW = (const float*)(p.ws + WS_APOW); const float* HST = (const float*)(p.ws + WS_HST); const float* dsk = p.inp(18);
    int tid = C.tid; asm volatile("" : "+v"(tid));
    const int lane = tid & 63, kq = lane >> 4, fr = lane & 15;
    LAS bf16_t* KF = (LAS bf16_t*)C.lds; LAS bf16_t* KB = KF + 16 * KLD;
    LAS bf16_t* U = KB + 16 * KLD + C.wave * 3072;
    LAS float* PW0 = (LAS float*)(KB + 16 * KLD + 8 * 3072);
    LAS float* PW16 = PW0 + 2 * 16 * 128;
    {
        const int g = bt >> 3, k0 = (260 * (bt & 7)) >> 3, k1 = (260 * ((bt & 7) + 1)) >> 3;
#pragma unroll
        for (int q = 0; q < 8; ++q) { const int idx = tid + NTHR * q, dir = idx >> 11, rr = (idx >> 7) & 15, c = idx & 127;
            *(LAS u32x4*)((dir ? KB : KF) + rr * KLD + 8 * c) = *(const u32x4*)(KN + ((size_t)(dir * 64 + g) * 16 + rr) * 1024 + 8 * c); }
        for (int q = lane; q < 192 * 2; q += 64) *(LAS u32x4*)(U + 8 * q) = (u32x4){0u, 0u, 0u, 0u};
#pragma unroll
        for (int q = 0; q < 2; ++q) { const int idx = tid + NTHR * q, dir = idx >> 9, f = (idx >> 5) & 15, c4 = idx & 31;
            *(LAS f32x4*)(PW0 + dir * 2048 + f * 128 + 4 * c4) = *(const f32x4*)(APOW + ((size_t)(dir * 64 + g) * 64 + (dir == 0 ? f : 15 - f)) * 128 + 4 * c4); }
        if (tid < 64) { const int dir = tid >> 5, c4 = tid & 31; *(LAS f32x4*)(PW16 + dir * 128 + 4 * c4) = *(const f32x4*)(APOW + ((size_t)(dir * 64 + g) * 64 + 15) * 128 + 4 * c4); }
        __syncthreads();
        const f32x4 dv = *(const f32x4*)(dsk + 16 * g + 4 * kq);
        bf16x8 ccr[2], cci[2];
#pragma unroll
        for (int hb = 0; hb < 2; ++hb) { ccr[hb] = frag_rowk_g(CCt + (size_t)g * 16 * 128 + 32 * hb, 128, lane); cci[hb] = frag_rowk_g(CCt + (size_t)g * 16 * 128 + 64 + 32 * hb, 128, lane); }
        const LAS float* pw0l = PW0 + (size_t)fr * 128 + 16 * kq;
        const LAS float* pw16l = PW16 + 16 * kq;
        for (int k = k0 + C.wave; k < k1; k += 8) {
            LDS_WAIT(); asm volatile("" ::: "memory");
            for (int q = lane; q < 128; q += 64) { const int t = q >> 1, hf = q & 1;
                *(LAS u32x4*)(U + (64 + t) * 16 + 8 * hf) = *(const u32x4*)(QKV + (size_t)(64 * k + t) * EV_IN + 4096 + 16 * g + 8 * hf); }
            LDS_WAIT(); asm volatile("" ::: "memory");
            const int cf = k, cb = k < 4 ? 3 - k : 263 - k;
            f32x4 acc[4];
#pragma unroll
            for (int tt = 0; tt < 4; ++tt) acc[tt] = (f32x4){0.f, 0.f, 0.f, 0.f};
            const LAS bf16_t* ubf = U + (64 + fr - (kq >> 1)) * 16 + 8 * (kq & 1);
            const LAS bf16_t* ubb = U + (64 + fr + (kq >> 1)) * 16 + 8 * (kq & 1);
#pragma unroll
            for (int n0 = 0; n0 < 64; n0 += 2) {
                const bf16x8 af = frag_rowk_l(KF + n0 * 16, KLD, lane), ab = frag_rowk_l(KB + n0 * 16, KLD, lane);
#pragma unroll
                for (int tt = 0; tt < 4; ++tt) {
                    if (n0 <= 16 * tt + 14) acc[tt] = MFMA16(af, *(const LAS bf16x8*)(ubf + (16 * tt - n0) * 16), acc[tt]);
                    if (n0 <= 62 - 16 * tt) acc[tt] = MFMA16(ab, *(const LAS bf16x8*)(ubb + (16 * tt + n0) * 16), acc[tt]);
                }
                asm volatile("" ::: "memory");
            }
#pragma unroll
            for (int dir = 0; dir < 2; ++dir) {
                const float* hp = HST + ((size_t)(dir * 64 + g) * 260 + (dir == 0 ? cf : cb)) * 128;
#pragma unroll
                for (int hb = 0; hb < 2; ++hb) {
                    float xr[8], xi[8];
#pragma unroll
                    for (int e2 = 0; e2 < 4; ++e2) { const f32x4 h4 = *(const f32x4*)(hp + 2 * (32 * hb + 8 * kq) + 4 * e2), b4 = *(const LAS f32x4*)(pw0l + dir * 2048 + hb * 64 + 4 * e2);
                        xr[2 * e2] = b4[0] * h4[0] - b4[1] * h4[1]; xi[2 * e2] = b4[0] * h4[1] + b4[1] * h4[0];
                        xr[2 * e2 + 1] = b4[2] * h4[2] - b4[3] * h4[3]; xi[2 * e2 + 1] = b4[2] * h4[3] + b4[3] * h4[2]; }
#pragma unroll
                    for (int st = 0; st < 4; ++st) {
                        const int tt = dir == 0 ? st : 3 - st;
                        u32x4 br, bi;
                        br.x = cvt_pk_bf16(xr[0], xr[1]); br.y = cvt_pk_bf16(xr[2], xr[3]); br.z = cvt_pk_bf16(xr[4], xr[5]); br.w = cvt_pk_bf16(xr[6], xr[7]);
                        bi.x = cvt_pk_bf16(xi[0], xi[1]); bi.y = cvt_pk_bf16(xi[2], xi[3]); bi.z = cvt_pk_bf16(xi[4], xi[5]); bi.w = cvt_pk_bf16(xi[6], xi[7]);
                        acc[tt] = MFMA16(ccr[hb], __builtin_bit_cast(bf16x8, br), acc[tt]);
                        acc[tt] = MFMA16(cci[hb], __builtin_bit_cast(bf16x8, bi), acc[tt]);
                        if (st < 3) {
#pragma unroll
                            for (int e2 = 0; e2 < 4; ++e2) { const f32x4 a4 = *(const LAS f32x4*)(pw16l + dir * 128 + hb * 64 + 4 * e2);
                                float t0 = xr[2 * e2] * a4[0] - xi[2 * e2] * a4[1]; xi[2 * e2] = xr[2 * e2] * a4[1] + xi[2 * e2] * a4[0]; xr[2 * e2] = t0;
                                t0 = xr[2 * e2 + 1] * a4[2] - xi[2 * e2 + 1] * a4[3]; xi[2 * e2 + 1] = xr[2 * e2 + 1] * a4[3] + xi[2 * e2 + 1] * a4[2]; xr[2 * e2 + 1] = t0; }
                        }
                    }
                }
            }
#pragma unroll
            for (int tt = 0; tt < 4; ++tt) { const int t = 16 * tt + fr;
                const u32x2 uu = *(const LAS u32x2*)(U + (64 + t) * 16 + 4 * kq);
                const float y0 = acc[tt][0] + bflo(uu.x) * dv[0], y1 = acc[tt][1] + bfhi(uu.x) * dv[1], y2 = acc[tt][2] + bflo(uu.y) * dv[2], y3 = acc[tt][3] + bfhi(uu.y) * dv[3];
                u32x2 w; w.x = cvt_pk_bf16(gelu_tanh(y0), gelu_tanh(y1)); w.y = cvt_pk_bf16(gelu_tanh(y2), gelu_tanh(y3));
                *(u32x2*)(Z + (size_t)(64 * k + t) * 1024 + 16 * g + 4 * kq) = w; }
        }
    }
    __syncthreads();
}

__device__ __forceinline__ void phase_ret_s5_outputs(const Params& p, Ctx& C, LAS unsigned char* misc) {
    unsigned* head = (unsigned*)(p.ws + WS_CTL) + CW_QUEUE;
    volatile LAS int* slot = (volatile LAS int*)(misc + 32);
    for (;;) {
        __syncthreads();
        if (C.tid == 0) slot[0] = (int)atomicAdd(head, 1u);
        __syncthreads();
        const int item = __builtin_amdgcn_readfirstlane(slot[0]);
        if (item >= 520) break;
        ret_output_unit(p, C, item);
    }
    for (;;) {
        __syncthreads();
        if (C.tid == 0) slot[0] = (int)atomicAdd(head + 64, 1u);
        __syncthreads();
        const int item = __builtin_amdgcn_readfirstlane(slot[0]);
        if (item >= 512) break;
        s5_output_task(p, C, item);
    }
}
__device__ __forceinline__ void phase_router(const Params& p, Ctx& C, int L) {
    const float* X1 = (const float*)(p.ws + WS_X1);
    const bf16_t* RWh = (const bf16_t*)(p.ws + WS_RWT) + (size_t)(L * 2 + 0) * 64 * DM; const bf16_t* RWl = (const bf16_t*)(p.ws + WS_RWT) + (size_t)(L * 2 + 1) * 64 * DM;
    const float* rbias = p.inp(27) + L * 64;
    int* cnt = (int*)(p.ws + WS_CTL) + CW_CNT + L * 128; int* LIST = (int*)(p.ws + WS_LIST); unsigned* PK = (unsigned*)(p.ws + WS_WGT); float* LW = (float*)(p.ws + WS_LW);
    const int lane = C.lane, kq = lane >> 4, fr = lane & 15;
    LAS float* Lw = (LAS float*)(C.lds + C.wave * 16640);
    const int r0 = (L == 0) ? 0 : CTXL, nrows = TT - r0;
    if (C.bid == 0 && C.tid == 0) cnt[64] = nrows;
    const int quad = C.wave >> 2, kw = C.wave & 3, ntask = nrows / 64;
    for (int tb = C.bid * 2; tb < ntask; tb += C.G * 2) {
        const int task = tb + quad;
        const int rbase = r0 + 64 * task;
        const int v = rbase < CTXL ? 1 : 0;
        const float* xr = X1 + (size_t)(rbase + fr) * DM; const float* sc2 = modv(p, L, v, 4); const float* sh2 = modv(p, L, v, 3);
        f32x4 acc[4][4];
#pragma unroll
        for (int b = 0; b < 4; ++b)
#pragma unroll
            for (int t = 0; t < 4; ++t) acc[b][t] = (f32x4){0.f, 0.f, 0.f, 0.f};
#pragma unroll 1
        for (int ks = 16 * kw; ks < 16 * kw + 16; ++ks) { const int c0 = 32 * ks + 8 * kq;
            const f32x4 a0 = *(const f32x4*)(sc2 + c0), a1 = *(const f32x4*)(sc2 + c0 + 4), b0 = *(const f32x4*)(sh2 + c0), b1 = *(const f32x4*)(sh2 + c0 + 4);
            bf16x8 ah[4], al[4];
#pragma unroll
            for (int b = 0; b < 4; ++b) {
                const f32x4 x0 = *(const f32x4*)(xr + (size_t)(16 * b) * DM + c0), x1 = *(const f32x4*)(xr + (size_t)(16 * b) * DM + c0 + 4);
                const f32x4 y0 = x0 * (a0 + 1.0f) + b0, y1 = x1 * (a1 + 1.0f) + b1;
                u32x4 hi; hi.x = cvt_pk_bf16(y0[0], y0[1]); hi.y = cvt_pk_bf16(y0[2], y0[3]); hi.z = cvt_pk_bf16(y1[0], y1[1]); hi.w = cvt_pk_bf16(y1[2], y1[3]);
                u32x4 lo; lo.x = cvt_pk_bf16(y0[0] - bflo(hi.x), y0[1] - bfhi(hi.x)); lo.y = cvt_pk_bf16(y0[2] - bflo(hi.y), y0[3] - bfhi(hi.y));
                lo.z = cvt_pk_bf16(y1[0] - bflo(hi.z), y1[1] - bfhi(hi.z)); lo.w = cvt_pk_bf16(y1[2] - bflo(hi.w), y1[3] - bfhi(hi.w));
                ah[b] = __builtin_bit_cast(bf16x8, hi); al[b] = __builtin_bit_cast(bf16x8, lo); }
#pragma unroll
            for (int t = 0; t < 4; ++t) { const bf16x8 bh = frag_rowk_g(RWh + (size_t)(16 * t) * DM + 32 * ks, DM, lane), bl = frag_rowk_g(RWl + (size_t)(16 * t) * DM + 32 * ks, DM, lane);
#pragma unroll
                for (int b = 0; b < 4; ++b) { acc[b][t] = MFMA16(ah[b], bh, acc[b][t]); acc[b][t] = MFMA16(al[b], bh, acc[b][t]); acc[b][t] = MFMA16(ah[b], bl, acc[b][t]); } } }
        LDS_WAIT(); asm volatile("" ::: "memory");
#pragma unroll
        for (int b = 0; b < 4; ++b)
#pragma unroll
            for (int t = 0; t < 4; ++t)
#pragma unroll
                for (int r = 0; r < 4; ++r) Lw[b * 1040 + (4 * kq + r) * 65 + 16 * t + fr] = acc[b][t][r];
        LDS_WAIT(); asm volatile("" ::: "memory");
        __syncthreads();
        LAS float* Lg = Lw + kw * 1040;
        { const LAS float* q0 = (const LAS float*)(C.lds + (4 * quad) * 16640) + kw * 1040;
          for (int i = lane; i < 16 * 65; i += 64) Lg[i] = (q0[i] + q0[4160 + i]) + (q0[8320 + i] + q0[12480 + i]); }
        LDS_WAIT(); asm volatile("" ::: "memory");
        if (lane < 16) {
            LAS float* sr = Lg + lane * 65; const int trow = rbase + 16 * kw + lane;
            float gs[8];
#pragma unroll
            for (int g = 0; g < 8; ++g) { float m1 = -1e30f, m2 = -1e30f;
                for (int j = 0; j < 8; ++j) { const int e = 8 * g + j; const float s = sigmoidf_(sr[e]); sr[e] = s; const float vv = s + rbias[e];
                    if (vv > m1) { m2 = m1; m1 = vv; } else if (vv > m2) m2 = vv; }
                gs[g] = m1 + m2; }
            unsigned gmask = 0u;
#pragma unroll
            for (int it = 0; it < 4; ++it) { float best = -1e30f; int bi = 0;
#pragma unroll
                for (int g = 0; g < 8; ++g) { const bool ok = !((gmask >> g) & 1u) && gs[g] > best; best = ok ? gs[g] : best; bi = ok ? g : bi; }
                gmask |= 1u << bi; }
            unsigned long long taken = 0ull; int sel[8]; float sw[8]; float wsum = 0.f;
#pragma unroll
            for (int k = 0; k < 8; ++k) { float best = -1e30f; int bi = 0;
                for (int e = 0; e < 64; ++e) { const bool cand = ((gmask >> (e >> 3)) & 1u) && !((taken >> e) & 1ull); const float vv = sr[e] + rbias[e];
                    if (cand && vv > best) { best = vv; bi = e; } }
                taken |= 1ull << bi; sel[k] = bi; sw[k] = sr[bi]; wsum += sw[k]; }
            const float inv = 2.5f / wsum;
#pragma unroll
            for (int k = 0; k < 8; ++k) { const int a = trow * 8 + k; const int pos = atomicAdd(&cnt[sel[k]], 1);
                LIST[(size_t)sel[k] * TT + pos] = a; PK[a] = ((unsigned)sel[k] << 16) | (unsigned)pos; LW[a] = sw[k] * inv * 4.0f; }
            LIST[(size_t)64 * TT + (trow - r0)] = 8 * TT + trow;
        }
        __syncthreads();
    }
}
namespace att {
constexpr int D = 128, NW = 8, QBLK = 32, KVBLK = 64;
constexpr float SCALE = 0.088388347648318440f;
constexpr float THR = 8.f;
constexpr int SHM_V = KVBLK * D * 2, SHM_K = KVBLK * D * 2, SHM_ATTN = 2 * SHM_V + 2 * SHM_K + NW * 64 * 4;
#define KSWZ(row, colB) ((row) * 256 + ((colB) ^ (((row) & 7) << 4)))
#define SBAR() __builtin_amdgcn_sched_barrier(0)
__device__ __forceinline__ int crow(int r, int hi) { return (r & 3) + 8 * (r >> 2) + 4 * hi; }
__device__ __forceinline__ unsigned cvtpk(float lo, float hi) { unsigned r; asm volatile("v_cvt_pk_bf16_f32 %0, %1, %2" : "=v"(r) : "v"(lo), "v"(hi)); return r; }

__device__ __forceinline__ void partialSM(f32x16& p0, f32x16& p1, float negMC) {
  constexpr float Cc = SCALE * 1.4426950408889634f;
  for (int r = 0; r < 16; ++r) p0[r] = fmaf(p0[r], Cc, negMC); for (int r = 0; r < 16; ++r) p1[r] = fmaf(p1[r], Cc, negMC);
  for (int r = 0; r < 16; ++r) p0[r] = __builtin_amdgcn_exp2f(p0[r]);
}
__device__ __forceinline__ void finishSM(f32x16& p0, f32x16& p1, float& l_reg, bf16x8& pa0, bf16x8& pa1, bf16x8& pa2, bf16x8& pa3) {
  for (int r = 0; r < 16; ++r) p1[r] = __builtin_amdgcn_exp2f(p1[r]);
  float ps = 0; for (int r = 0; r < 16; ++r) ps += p0[r]; for (int r = 0; r < 16; ++r) ps += p1[r];
  { auto rr = __builtin_amdgcn_permlane32_swap(__float_as_uint(ps), __float_as_uint(ps), false, false);
    ps = __uint_as_float(rr[0]) + __uint_as_float(rr[1]); }
  l_reg += ps;
#define PK4(P, BASE, OUT) do { unsigned a0 = cvtpk(P[BASE + 0], P[BASE + 1]), a1 = cvtpk(P[BASE + 2], P[BASE + 3]);   \
    unsigned b0 = cvtpk(P[BASE + 4], P[BASE + 5]), b1 = cvtpk(P[BASE + 6], P[BASE + 7]);                              \
    auto r0 = __builtin_amdgcn_permlane32_swap(a0, b0, false, false); auto r1 = __builtin_amdgcn_permlane32_swap(a1, b1, false, false); \
    u32x4 w = {r0[0], r1[0], r0[1], r1[1]}; OUT = *reinterpret_cast<bf16x8*>(&w); } while (0)
  PK4(p0, 0, pa0); PK4(p0, 8, pa1); PK4(p1, 0, pa2); PK4(p1, 8, pa3);
#undef PK4
}
__device__ __forceinline__ void qkt(f32x16& p0, f32x16& p1, const LAS char* Ks, const bf16x8* qr, int r32, int hi) {
  p0 = f32x16{}; p1 = f32x16{};
  for (int d0 = 0; d0 < 8; ++d0) { int cb = (d0 * 16 + hi * 8) * 2;
    bf16x8 b0 = *reinterpret_cast<const LAS bf16x8*>(Ks + KSWZ(r32, cb));
    bf16x8 b1 = *reinterpret_cast<const LAS bf16x8*>(Ks + KSWZ(32 + r32, cb));
    p0 = __builtin_amdgcn_mfma_f32_32x32x16_bf16(b0, qr[d0], p0, 0, 0, 0);
    p1 = __builtin_amdgcn_mfma_f32_32x32x16_bf16(b1, qr[d0], p1, 0, 0, 0); }
}
__device__ __forceinline__ int v_st(int k, int c) { const int kk = (k & ~0xC) | ((k & 4) << 1) | ((k & 8) >> 1); return ((kk >> 3) * 4 + (c >> 5)) * 512 + ((kk & 7) * 32 + (c & 31)) * 2; }
__device__ __forceinline__ int v_rd_base(int lane) { return ((lane & 3) << 3) | (((lane >> 2) & 3) << 6) | (((lane >> 4) & 1) << 5) | (((lane >> 5) & 1) << 8); }
constexpr int v_rd_off(int d0, int ks, int half) { return d0 * 512 + ks * 4096 + half * 2048; }
template <int OFF> __device__ __forceinline__ s16x4 tr_read(int vb) {
  s16x4 r; asm volatile("ds_read_b64_tr_b16 %0, %1 offset:%2" : "=&v"(r) : "v"(vb), "i"(OFF) : "memory"); return r;
}
template <int D0> __device__ __forceinline__ void pv_one(f32x16& od, int vb, bf16x8 pa0, bf16x8 pa1, bf16x8 pa2, bf16x8 pa3) {
  const s16x4 l0 = tr_read<v_rd_off(D0, 0, 0)>(vb), h0 = tr_read<v_rd_off(D0, 0, 1)>(vb), l1 = tr_read<v_rd_off(D0, 1, 0)>(vb), h1 = tr_read<v_rd_off(D0, 1, 1)>(vb);
  const s16x4 l2 = tr_read<v_rd_off(D0, 2, 0)>(vb), h2 = tr_read<v_rd_off(D0, 2, 1)>(vb), l3 = tr_read<v_rd_off(D0, 3, 0)>(vb), h3 = tr_read<v_rd_off(D0, 3, 1)>(vb);
  asm volatile("s_waitcnt lgkmcnt(0)" ::: "memory"); SBAR();
#define PK(L, H) (bf16x8){L[0], L[1], L[2], L[3], H[0], H[1], H[2], H[3]}
  od = __builtin_amdgcn_mfma_f32_32x32x16_bf16(pa0, PK(l0, h0), od, 0, 0, 0);
  od = __builtin_amdgcn_mfma_f32_32x32x16_bf16(pa1, PK(l1, h1), od, 0, 0, 0);
  od = __builtin_amdgcn_mfma_f32_32x32x16_bf16(pa2, PK(l2, h2), od, 0, 0, 0);
  od = __builtin_amdgcn_mfma_f32_32x32x16_bf16(pa3, PK(l3, h3), od, 0, 0, 0);
#undef PK
}
__device__ __forceinline__ void pv_d0(f32x16* o, int vb, bf16x8 pa0, bf16x8 pa1, bf16x8 pa2, bf16x8 pa3) {
  pv_one<0>(o[0], vb, pa0, pa1, pa2, pa3); pv_one<1>(o[1], vb, pa0, pa1, pa2, pa3); pv_one<2>(o[2], vb, pa0, pa1, pa2, pa3); pv_one<3>(o[3], vb, pa0, pa1, pa2, pa3);
}

template <int LDQ, int LDK, int LDO>
__device__ __forceinline__ void attn_dense_body(const bf16_t* __restrict__ Qb, const bf16_t* __restrict__ Kh, const bf16_t* __restrict__ Vh, bf16_t* __restrict__ Ob, int seq, LAS char* lds, int tid, float kmax2) {
  const int wid = tid >> 6, lane = tid & 63, r32 = lane & 31, hi = lane >> 5;
  LAS char* V_lds = lds; LAS char* K_lds = lds + 2 * SHM_V;
  LAS float* ws = (LAS float*)(lds + 2 * SHM_V + 2 * SHM_K) + wid * 64; LAS float* li_l = ws;
  float l_reg = 0; f32x16 o[4] = {}; bf16x8 qr[8];
  const bf16_t* Qw = Qb + (long)(wid * QBLK + r32) * LDQ + hi * 8;
#pragma unroll
  for (int d0 = 0; d0 < 8; ++d0) qr[d0] = *reinterpret_cast<const bf16x8*>(Qw + d0 * 16);
  float negMC;
  { float q2 = 0.f;
#pragma unroll
    for (int d0 = 0; d0 < 8; ++d0) { const u32x4 w = __builtin_bit_cast(u32x4, qr[d0]);
      q2 += bflo(w.x) * bflo(w.x) + bfhi(w.x) * bfhi(w.x) + bflo(w.y) * bflo(w.y) + bfhi(w.y) * bfhi(w.y) + bflo(w.z) * bflo(w.z) + bfhi(w.z) * bfhi(w.z) + bflo(w.w) * bflo(w.w) + bfhi(w.w) * bfhi(w.w); }
    auto rr = __builtin_amdgcn_permlane32_swap(__float_as_uint(q2), __float_as_uint(q2), false, false);
    q2 = __uint_as_float(rr[0]) + __uint_as_float(rr[1]);
    negMC = -(sqrtf(q2 * kmax2) * (SCALE * 1.0001f) - 30.0f) * 1.4426950408889634f; }
  const int sr = tid >> 4, sc = (tid & 15) * 8, vst0 = v_st(sr, sc), vst1 = v_st(32 + sr, sc);
  const int vb0 = (int)(uintptr_t)V_lds + v_rd_base(lane);
  struct { bf16x8 vs0, vs1, ks0, ks1; } sr_[2];
#define SLOAD(i, k0) do { sr_[i].vs0 = *reinterpret_cast<const bf16x8*>(&Vh[(long)((k0) + sr) * LDK + sc]); sr_[i].vs1 = *reinterpret_cast<const bf16x8*>(&Vh[(long)((k0) + 32 + sr) * LDK + sc]); \
    sr_[i].ks0 = *reinterpret_cast<const bf16x8*>(&Kh[(long)((k0) + sr) * LDK + sc]); sr_[i].ks1 = *reinterpret_cast<const bf16x8*>(&Kh[(long)((k0) + 32 + sr) * LDK + sc]); } while (0)
#define SWRITE(b, i) do { *(LAS bf16x8*)(V_lds + (b) * SHM_V + vst0) = sr_[i].vs0;          \
    *(LAS bf16x8*)(V_lds + (b) * SHM_V + vst1) = sr_[i].vs1; int kc = sc * 2;               \
    *(LAS bf16x8*)(K_lds + (b) * SHM_K + KSWZ(sr, kc)) = sr_[i].ks0;                       \
    *(LAS bf16x8*)(K_lds + (b) * SHM_K + KSWZ(32 + sr, kc)) = sr_[i].ks1; } while (0)
#define SWAIT() asm volatile("s_waitcnt vmcnt(4)" ::: "memory")
  f32x16 pA0, pA1, pB0, pB1; bf16x8 pa0, pa1, pa2, pa3; const int NT = seq / KVBLK;
  constexpr int SE = 0, SO = 1;
  SLOAD(SE, 0); asm volatile("s_waitcnt vmcnt(0)" ::: "memory"); SWRITE(0, SE); __syncthreads();
  qkt(pA0, pA1, K_lds, qr, r32, hi); partialSM(pA0, pA1, negMC);
  SLOAD(SO, KVBLK); if (2 < NT) SLOAD(SE, 2 * KVBLK);
  SWAIT(); SWRITE(1, SO); __syncthreads();
  for (int j = 1; j + 1 < NT; j += 2) {
    SBAR(); qkt(pB0, pB1, K_lds + SHM_K, qr, r32, hi);
    finishSM(pA0, pA1, l_reg, pa0, pa1, pa2, pa3); SBAR();
    SLOAD(SO, (j + 2) * KVBLK); SBAR();
    pv_d0(o, vb0, pa0, pa1, pa2, pa3); partialSM(pB0, pB1, negMC);
    __syncthreads(); SWAIT(); SWRITE(0, SE);
    __syncthreads();
    SBAR(); qkt(pA0, pA1, K_lds, qr, r32, hi);
    finishSM(pB0, pB1, l_reg, pa0, pa1, pa2, pa3); SBAR();
    if (j + 3 < NT) SLOAD(SE, (j + 3) * KVBLK); SBAR();
    pv_d0(o, vb0 + (int)SHM_V, pa0, pa1, pa2, pa3); partialSM(pA0, pA1, negMC);
    __syncthreads(); SWAIT(); SWRITE(1, SO);
    __syncthreads();
  }
  SBAR(); qkt(pB0, pB1, K_lds + SHM_K, qr, r32, hi);
  finishSM(pA0, pA1, l_reg, pa0, pa1, pa2, pa3); SBAR();
  pv_d0(o, vb0, pa0, pa1, pa2, pa3); partialSM(pB0, pB1, negMC);
  __syncthreads();
  finishSM(pB0, pB1, l_reg, pa0, pa1, pa2, pa3); SBAR();
  pv_d0(o, vb0 + (int)SHM_V, pa0, pa1, pa2, pa3);
  if (hi == 0) li_l[r32] = l_reg; asm volatile("s_waitcnt lgkmcnt(0)" ::: "memory");
  float rli[16];
#pragma unroll
  for (int r = 0; r < 16; ++r) rli[r] = __builtin_amdgcn_rcpf(li_l[crow(r, hi)]);
  bf16_t* Ow = Ob + (long)(wid * QBLK) * LDO;
#pragma unroll
  for (int r = 0; r < 16; ++r) { int orow = crow(r, hi);
    for (int d0 = 0; d0 < 4; ++d0) Ow[(long)orow * LDO + d0 * 32 + r32] = (bf16_t)(cvtpk(o[d0][r] * rli[r], 0.f) & 0xffffu); }
#undef SLOAD
#undef SWRITE
#undef SWAIT
}

typedef int v8i32a __attribute__((ext_vector_type(8)));
typedef int v4i32a __attribute__((ext_vector_type(4)));
#define KSW8(row, chunk) ((row) * 128 + ((((chunk) ^ (((row) >> 1) & 7))) << 4))
#define VSW8(d, chunk) ((d) * 64 + ((((chunk) ^ (((d) >> 2) & 3))) << 4))
#define MFMA8(a, b, c) __builtin_amdgcn_mfma_scale_f32_32x32x64_f8f6f4((a), (b), (c), 0, 0, 0, 0, 0, 0)
__device__ __forceinline__ v8i32a ld32_l(const LAS char* p0, const LAS char* p1) { return __builtin_shufflevector(*(const LAS v4i32a*)p0, *(const LAS v4i32a*)p1, 0, 1, 2, 3, 4, 5, 6, 7); }
__device__ __forceinline__ unsigned pk4f8(float a, float b, float c, float d) { unsigned w = (unsigned)__builtin_amdgcn_cvt_pk_fp8_f32(a, b, 0, false); return (unsigned)__builtin_amdgcn_cvt_pk_fp8_f32(c, d, (int)w, true); }
template <int LDO, int KSTR>
__device__ __forceinline__ void attn_dense8_body(const unsigned char* __restrict__ Q8b, const unsigned char* __restrict__ K8h, const unsigned char* __restrict__ VT8h, bf16_t* __restrict__ Ob, int seq, LAS char* lds, int tid, float kmax2) {
  const int wid = tid >> 6, lane = tid & 63, r32 = lane & 31, hi = lane >> 5;
  constexpr int RS = 6, PD = 4;
  LAS float* al_l = (LAS float*)(lds + RS * 16384) + wid * 32;
  f32x16 o[4] = {}; v8i32a qf[2];
  { const unsigned char* qp = Q8b + (size_t)(wid * QBLK + r32) * 1024 + 32 * hi;
    qf[0] = __builtin_shufflevector(*(const v4i32a*)qp, *(const v4i32a*)(qp + 16), 0, 1, 2, 3, 4, 5, 6, 7);
    qf[1] = __builtin_shufflevector(*(const v4i32a*)(qp + 64), *(const v4i32a*)(qp + 80), 0, 1, 2, 3, 4, 5, 6, 7); }
  (void)kmax2;
  constexpr float THR8 = 1.4426950408889634f;
  float m_reg = 0.f; f32x16 osum = {}; v8i32a ones = {0x38383838, 0x38383838, 0x38383838, 0x38383838, 0x38383838, 0x38383838, 0x38383838, 0x38383838}; asm volatile("" : "+v"(ones));
#define PSM8(P0, P1, DL, CN, FIRST) do { float pmax = P0[0]; for (int r = 1; r < 16; ++r) pmax = fmaxf(pmax, P0[r]); for (int r = 0; r < 16; ++r) pmax = fmaxf(pmax, P1[r]); \
      { auto rr = __builtin_amdgcn_permlane32_swap(__float_as_uint(pmax), __float_as_uint(pmax), false, false); pmax = fmaxf(__uint_as_float(rr[0]), __uint_as_float(rr[1])); } \
      const float mn = (FIRST) ? pmax : ((pmax - m_reg > THR8) ? pmax : m_reg); DL = (FIRST) ? 0.f : mn - m_reg; m_reg = mn; CN = 7.0f - mn; \
      for (int r = 0; r < 16; ++r) P0[r] = __builtin_amdgcn_exp2f(P0[r] + CN); } while (0)
#define RESC8(DL) do { if (__any((DL) > 0.f)) { if (hi == 0) al_l[r32] = __builtin_amdgcn_exp2f(-(DL)); asm volatile("s_waitcnt lgkmcnt(0)" ::: "memory"); \
      for (int d = 0; d < 4; ++d) for (int r = 0; r < 16; ++r) o[d][r] *= al_l[crow(r, hi)]; for (int r = 0; r < 16; ++r) osum[r] *= al_l[crow(r, hi)]; } } while (0)
  const unsigned kgo = (unsigned)((tid >> 3) * KSTR + 16 * ((tid & 7) ^ ((tid >> 4) & 7))), vgo = (unsigned)((tid >> 2) * 64 + 16 * ((tid & 3) ^ ((tid >> 4) & 3)));
  const unsigned ldw = (unsigned)wid * 1024u;
#define DMA8(slot, T_) do { __builtin_amdgcn_global_load_lds((const unsigned*)(K8h + (size_t)(T_) * (64 * KSTR) + kgo), (LAS unsigned*)(lds + (slot) * 16384 + ldw), 16, 0, 0); \
      __builtin_amdgcn_global_load_lds((const unsigned*)(VT8h + (size_t)(T_) * 8192 + vgo), (LAS unsigned*)(lds + (slot) * 16384 + 8192 + ldw), 16, 0, 0); } while (0)
#define DWAIT8() do { asm volatile("s_waitcnt vmcnt(6)\n\ts_waitcnt lgkmcnt(0)" ::: "memory"); __builtin_amdgcn_s_barrier(); asm volatile("" ::: "memory"); } while (0)
#define QK8(P0, P1, KB) do { P0 = f32x16{}; P1 = f32x16{}; _Pragma("unroll") for (int s = 0; s < 2; ++s) { \
      const v8i32a k0 = ld32_l((KB) + KSW8(r32, 4 * s + 2 * hi), (KB) + KSW8(r32, 4 * s + 2 * hi + 1)); \
      const v8i32a k1 = ld32_l((KB) + KSW8(32 + r32, 4 * s + 2 * hi), (KB) + KSW8(32 + r32, 4 * s + 2 * hi + 1)); \
      P0 = MFMA8(k0, qf[s], P0); P1 = MFMA8(k1, qf[s], P1); } } while (0)
#define FIN8(P0, P1, CN) do { for (int r = 0; r < 16; ++r) P1[r] = __builtin_amdgcn_exp2f(P1[r] + CN); \
      _Pragma("unroll") for (int i = 0; i < 4; ++i) { pa[i] = (int)pk4f8(P0[4 * i], P0[4 * i + 1], P0[4 * i + 2], P0[4 * i + 3]); pa[4 + i] = (int)pk4f8(P1[4 * i], P1[4 * i + 1], P1[4 * i + 2], P1[4 * i + 3]); } } while (0)
#define PV8(VB) do { _Pragma("unroll") for (int d0 = 0; d0 < 4; ++d0) { \
      const v8i32a vf = ld32_l((VB) + VSW8(32 * d0 + r32, 2 * hi), (VB) + VSW8(32 * d0 + r32, 2 * hi + 1)); \
      o[d0] = MFMA8(pa, vf, o[d0]); } osum = MFMA8(pa, ones, osum); } while (0)
#define LDK8(KB, s, half) ld32_l((KB) + KSW8(32 * (half) + r32, 4 * (s) + 2 * hi), (KB) + KSW8(32 * (half) + r32, 4 * (s) + 2 * hi + 1))
#define LDV8(VB, d0) ld32_l((VB) + VSW8(32 * (d0) + r32, 2 * hi), (VB) + VSW8(32 * (d0) + r32, 2 * hi + 1))
#define EXPN(P, r0, n, CN) do { _Pragma("unroll") for (int r = (r0); r < (r0) + (n); ++r) { float e_ = __builtin_amdgcn_exp2f(P[r] + (CN)); asm volatile("" : "+v"(e_)); P[r] = e_; } } while (0)
#define FINP(P0, P1, CN, i) do { EXPN(P1, 4 * (i), 4, CN); \
      { unsigned w_ = (unsigned)__builtin_amdgcn_cvt_pk_fp8_f32(P0[4 * (i)], P0[4 * (i) + 1], pa[i], false); pa[i] = __builtin_amdgcn_cvt_pk_fp8_f32(P0[4 * (i) + 2], P0[4 * (i) + 3], (int)w_, true); } \
      { unsigned w_ = (unsigned)__builtin_amdgcn_cvt_pk_fp8_f32(P1[4 * (i)], P1[4 * (i) + 1], pa[4 + (i)], false); pa[4 + (i)] = __builtin_amdgcn_cvt_pk_fp8_f32(P1[4 * (i) + 2], P1[4 * (i) + 3], (int)w_, true); } } while (0)
#define PINA(x, y) asm volatile("" : "+v"(x), "+v"(y))
#define PIN1(x) asm volatile("" : "+v"(x))
#define PINC(x, y) asm volatile("" :: "v"(x), "v"(y))
#define HSTEP(X0, X1, DLX, CNX, Y0, Y1, CNY, KB, VB, STAGE_LOAD) do { \
      v8i32a ka_ = LDK8(KB, 0, 0), kb_ = LDK8(KB, 0, 1), kc_ = LDK8(KB, 1, 0), kd_ = LDK8(KB, 1, 1); \
      X0 = MFMA8(ka_, qf[0], f32x16{}); PINA(X0, kb_); \
      FINP(Y0, Y1, CNY, 0); PINC(pa[0], pa[4]); PIN1(kb_); \
      X1 = MFMA8(kb_, qf[0], f32x16{}); PINA(X1, kc_); \
      FINP(Y0, Y1, CNY, 1); PINC(pa[1], pa[5]); PIN1(kc_); \
      X0 = MFMA8(kc_, qf[1], X0); PINA(X0, kd_); \
      v8i32a v0_ = LDV8(VB, 0), v1_ = LDV8(VB, 1); \
      FINP(Y0, Y1, CNY, 2); STAGE_LOAD; PINC(pa[2], pa[6]); PIN1(kd_); \
      X1 = MFMA8(kd_, qf[1], X1); PINA(X1, v0_); \
      v8i32a v2_ = LDV8(VB, 2), v3_ = LDV8(VB, 3); \
      FINP(Y0, Y1, CNY, 3); PINC(pa[3], pa[7]); PINA(pa, v0_); \
      o[0] = MFMA8(pa, v0_, o[0]); PINA(o[0], v1_); \
      float pm0_ = X0[0]; _Pragma("unroll") for (int r = 1; r < 16; ++r) pm0_ = fmaxf(pm0_, X0[r]); PINA(pm0_, v1_); \
      o[1] = MFMA8(pa, v1_, o[1]); PINA(o[1], v2_); \
      _Pragma("unroll") for (int r = 0; r < 16; ++r) pm0_ = fmaxf(pm0_, X1[r]); \
      { auto rr = __builtin_amdgcn_permlane32_swap(__float_as_uint(pm0_), __float_as_uint(pm0_), false, false); pm0_ = fmaxf(__uint_as_float(rr[0]), __uint_as_float(rr[1])); } \
      { const float mn = (pm0_ - m_reg > THR8) ? pm0_ : m_reg; DLX = mn - m_reg; m_reg = mn; CNX = 7.0f - mn; } PINA(CNX, v2_); \
      o[2] = MFMA8(pa, v2_, o[2]); PINA(o[2], v3_); \
      EXPN(X0, 0, 5, CNX); PIN1(v3_); \
      o[3] = MFMA8(pa, v3_, o[3]); PINA(o[3], CNX); \
      EXPN(X0, 5, 5, CNX); PIN1(pa); \
      osum = MFMA8(pa, ones, osum); PINA(osum, CNX); \
      EXPN(X0, 10, 6, CNX); } while (0)
  f32x16 pA0, pA1, pB0, pB1; v8i32a pa = {}; float dlA, dlB, cnA, cnB; const int NT = seq / KVBLK;
#define SLOT(s) (lds + (s) * 16384)
#define SADV() do { sv = sk; sk = sk + 1 == RS ? 0 : sk + 1; sd = sd + 1 == RS ? 0 : sd + 1; } while (0)
  int sk = 0, sv = 0, sd = PD;
  DMA8(0, 0); DMA8(1, 1); DMA8(2, 2); DMA8(3, 3);
  DWAIT8();
  QK8(pA0, pA1, SLOT(0)); PSM8(pA0, pA1, dlA, cnA, true);
  DMA8(sd, PD); SADV(); DWAIT8();
  for (int j = 1; j + 1 < NT; j += 2) {
    HSTEP(pB0, pB1, dlB, cnB, pA0, pA1, cnA, SLOT(sk), SLOT(sv) + 8192, DMA8(sd, min(j + PD, NT - 1)));
    RESC8(dlB); SADV(); DWAIT8();
    HSTEP(pA0, pA1, dlA, cnA, pB0, pB1, cnB, SLOT(sk), SLOT(sv) + 8192, DMA8(sd, min(j + 1 + PD, NT - 1)));
    RESC8(dlA); SADV(); DWAIT8();
  }
  HSTEP(pB0, pB1, dlB, cnB, pA0, pA1, cnA, SLOT(sk), SLOT(sv) + 8192, (void)0);
  RESC8(dlB); SADV();
  FIN8(pB0, pB1, cnB); SBAR();
  PV8(SLOT(sv) + 8192);
  asm volatile("s_waitcnt vmcnt(0)" ::: "memory");
  float rli[16];
#pragma unroll
  for (int r = 0; r < 16; ++r) rli[r] = __builtin_amdgcn_rcpf(osum[r]);
  bf16_t* Ow = Ob + (long)(wid * QBLK) * LDO;
#pragma unroll
  for (int r = 0; r < 16; ++r) { int orow = crow(r, hi);
    for (int d0 = 0; d0 < 4; ++d0) Ow[(long)orow * LDO + d0 * 32 + r32] = (bf16_t)(cvtpk(o[d0][r] * rli[r], 0.f) & 0xffffu); }
#undef PSM8
#undef RESC8
#undef DMA8
#undef DWAIT8
#undef SLOT
#undef SADV
#undef QK8
#undef FIN8
#undef PV8
#undef HSTEP
#undef PINA
#undef PIN1
#undef PINC
#undef FINP
#undef EXPN
#undef LDK8
#undef LDV8
}

template <int LDO, int KSTR>
__device__ __forceinline__ void attn_dense8w_body(const unsigned char* __restrict__ Q8b, const unsigned char* __restrict__ K8h, const unsigned char* __restrict__ VT8h0, const unsigned char* __restrict__ VT8h1, bf16_t* __restrict__ Ob, int seq, LAS char* lds, int tid, float kmax2) {
  const int wid = tid >> 6, lane = tid & 63, r32 = lane & 31, hi = lane >> 5;
  constexpr int RS = 4, PD = 2, SB = 24576;
  LAS float* al_l = (LAS float*)(lds + RS * SB) + wid * 32;
  LAS char* q_l = lds + RS * SB + 2048 + wid * 4096 + lane * 16;
  { const unsigned char* qp = Q8b + (size_t)(wid * QBLK + r32) * 1024 + 32 * hi;
    *(LAS v4i32a*)(q_l) = *(const v4i32a*)qp; *(LAS v4i32a*)(q_l + 1024) = *(const v4i32a*)(qp + 16);
    *(LAS v4i32a*)(q_l + 2048) = *(const v4i32a*)(qp + 64); *(LAS v4i32a*)(q_l + 3072) = *(const v4i32a*)(qp + 80); }
  (void)kmax2;
  constexpr float THR8 = 1.4426950408889634f;
  float l_reg = 0.f, m_reg = 0.f; f32x16 o[8] = {};
  const unsigned kgo = (unsigned)((tid >> 3) * KSTR + 16 * ((tid & 7) ^ ((tid >> 4) & 7))), vgo = (unsigned)((tid >> 2) * 64 + 16 * ((tid & 3) ^ ((tid >> 4) & 3)));
  const unsigned ldw = (unsigned)wid * 1024u;
#define DMA8(slot, T_) do { __builtin_amdgcn_global_load_lds((const unsigned*)(K8h + (size_t)(T_) * (64 * KSTR) + kgo), (LAS unsigned*)(lds + (slot) * SB + ldw), 16, 0, 0); \
      __builtin_amdgcn_global_load_lds((const unsigned*)(VT8h0 + (size_t)(T_) * 8192 + vgo), (LAS unsigned*)(lds + (slot) * SB + 8192 + ldw), 16, 0, 0); \
      __builtin_amdgcn_global_load_lds((const unsigned*)(VT8h1 + (size_t)(T_) * 8192 + vgo), (LAS unsigned*)(lds + (slot) * SB + 16384 + ldw), 16, 0, 0); } while (0)
#define DWAIT8() do { asm volatile("s_waitcnt vmcnt(3)\n\ts_waitcnt lgkmcnt(0)" ::: "memory"); __builtin_amdgcn_s_barrier(); asm volatile("" ::: "memory"); } while (0)
#define SLOT(s) (lds + (s) * SB)
#define SADV() do { sv = sk; sk = sk + 1 == RS ? 0 : sk + 1; sd = sd + 1 == RS ? 0 : sd + 1; } while (0)
#define LDK8(KB, s, half) ld32_l((KB) + KSW8(32 * (half) + r32, 4 * (s) + 2 * hi), (KB) + KSW8(32 * (half) + r32, 4 * (s) + 2 * hi + 1))
#define LDV8(VB, d0) ld32_l((VB) + VSW8(32 * (d0) + r32, 2 * hi), (VB) + VSW8(32 * (d0) + r32, 2 * hi + 1))
#define PIN1(x) asm volatile("" : "+v"(x))
#define EXPR(e0, n) do { _Pragma("unroll") for (int e = (e0); e < (e0) + (n); ++e) { float x_ = e < 16 ? X0[e & 15] : X1[e & 15]; float e_ = __builtin_amdgcn_exp2f(x_ + cn); asm volatile("" : "+v"(e_)); ps += e_; \
      if (e < 16) X0[e & 15] = e_; else X1[e & 15] = e_; } } while (0)
#define PKW(PAC, w) do { if ((w) < 4) { unsigned w_ = (unsigned)__builtin_amdgcn_cvt_pk_fp8_f32(X0[4 * ((w) & 3)], X0[4 * ((w) & 3) + 1], PAC[w], false); PAC[w] = __builtin_amdgcn_cvt_pk_fp8_f32(X0[4 * ((w) & 3) + 2], X0[4 * ((w) & 3) + 3], (int)w_, true); } \
      else { unsigned w_ = (unsigned)__builtin_amdgcn_cvt_pk_fp8_f32(X1[4 * ((w) & 3)], X1[4 * ((w) & 3) + 1], PAC[w], false); PAC[w] = __builtin_amdgcn_cvt_pk_fp8_f32(X1[4 * ((w) & 3) + 2], X1[4 * ((w) & 3) + 3], (int)w_, true); } } while (0)
#define PVM(PAP, g) do { PIN1(vv##g); o[4 * ((g) & 1) + ((g) >> 1)] = MFMA8(PAP, vv##g, o[4 * ((g) & 1) + ((g) >> 1)]); asm volatile("" :: "v"(o[4 * ((g) & 1) + ((g) >> 1)])); } while (0)
#define LDVG(g) ({ int o_ = sv * SB + 8192 + 8192 * ((g) & 1); asm volatile("" : "+s"(o_)); LDV8(lds + o_, (g) >> 1); })
#define WSTEP(PAP, PAC, FIRST, TNEXT) do { \
      { const v8i32a ka_ = LDK8(SLOT(sk), 0, 0), kb_ = LDK8(SLOT(sk), 0, 1), kc_ = LDK8(SLOT(sk), 1, 0), kd_ = LDK8(SLOT(sk), 1, 1); \
        const v8i32a q0_ = ld32_l(q_l, q_l + 1024), q1_ = ld32_l(q_l + 2048, q_l + 3072); \
        X0 = MFMA8(ka_, q0_, f32x16{}); X1 = MFMA8(kb_, q0_, f32x16{}); X0 = MFMA8(kc_, q1_, X0); X1 = MFMA8(kd_, q1_, X1); PIN1(X1); } \
      DMA8(sd, TNEXT); \
      v8i32a vv0 = LDVG(0), vv1 = LDVG(1); \
      PVM(PAP, 0); v8i32a vv2 = LDVG(2); \
      float pm_ = X0[0]; _Pragma("unroll") for (int r = 1; r < 16; ++r) pm_ = fmaxf(pm_, X0[r]); PIN1(pm_); \
      PVM(PAP, 1); v8i32a vv3 = LDVG(3); \
      _Pragma("unroll") for (int r = 0; r < 16; ++r) pm_ = fmaxf(pm_, X1[r]); \
      { auto rr = __builtin_amdgcn_permlane32_swap(__float_as_uint(pm_), __float_as_uint(pm_), false, false); pm_ = fmaxf(__uint_as_float(rr[0]), __uint_as_float(rr[1])); } \
      const float mn_ = (FIRST) ? pm_ : ((pm_ - m_reg > THR8) ? pm_ : m_reg); const float dl_ = (FIRST) ? 0.f : mn_ - m_reg; m_reg = mn_; float cn = 7.0f - mn_; float ps = 0.f; PIN1(cn); \
      PVM(PAP, 2); v8i32a vv4 = LDVG(4); EXPR(0, 6); PKW(PAC, 0); \
      PVM(PAP, 3); v8i32a vv5 = LDVG(5); EXPR(6, 6); PKW(PAC, 1); PKW(PAC, 2); \
      PVM(PAP, 4); v8i32a vv6 = LDVG(6); EXPR(12, 5); PKW(PAC, 3); \
      PVM(PAP, 5); v8i32a vv7 = LDVG(7); EXPR(17, 5); PKW(PAC, 4); \
      PVM(PAP, 6); EXPR(22, 5); PKW(PAC, 5); \
      PVM(PAP, 7); EXPR(27, 5); PKW(PAC, 6); PKW(PAC, 7); \
      { auto rr = __builtin_amdgcn_permlane32_swap(__float_as_uint(ps), __float_as_uint(ps), false, false); ps = __uint_as_float(rr[0]) + __uint_as_float(rr[1]); } \
      if (__any(dl_ > 0.f)) { const float al_ = __builtin_amdgcn_exp2f(-dl_); l_reg *= al_; if (hi == 0) al_l[r32] = al_; asm volatile("s_waitcnt lgkmcnt(0)" ::: "memory"); \
        for (int d = 0; d < 8; ++d) for (int r = 0; r < 16; ++r) o[d][r] *= al_l[crow(r, hi)]; } \
      l_reg += ps; \
      SADV(); DWAIT8(); } while (0)
  f32x16 X0, X1; v8i32a paA = {}, paB = {}; const int NT = seq / KVBLK;
  int sk = 0, sv = 0, sd = PD;
  DMA8(0, 0); DMA8(1, 1);
  DWAIT8();
  for (int j = 0; j < NT; j += 2) {
    WSTEP(paB, paA, j == 0, min(j + PD, NT - 1));
    WSTEP(paA, paB, false, min(j + 1 + PD, NT - 1));
  }
  { v8i32a vv0 = LDVG(0), vv1 = LDVG(1), vv2 = LDVG(2), vv3 = LDVG(3); PVM(paB, 0); PVM(paB, 1); PVM(paB, 2); PVM(paB, 3); }
  { v8i32a vv4 = LDVG(4), vv5 = LDVG(5), vv6 = LDVG(6), vv7 = LDVG(7); PVM(paB, 4); PVM(paB, 5); PVM(paB, 6); PVM(paB, 7); }
  asm volatile("s_waitcnt vmcnt(0)" ::: "memory");
  int te = tid; asm volatile("" : "+v"(te));
  const int wid_e = te >> 6, r32_e = te & 31, hi_e = (te >> 5) & 1;
  LAS float* li_e = (LAS float*)(lds + RS * SB + 1024) + wid_e * 32;
  if (hi_e == 0) li_e[r32_e] = l_reg; asm volatile("s_waitcnt lgkmcnt(0)" ::: "memory");
  float rli[16];
#pragma unroll
  for (int r = 0; r < 16; ++r) rli[r] = __builtin_amdgcn_rcpf(li_e[crow(r, hi_e)]);
  bf16_t* Ow = Ob + (long)(wid_e * QBLK) * LDO;
#pragma unroll
  for (int r = 0; r < 16; ++r) { int orow = crow(r, hi_e);
    for (int d0 = 0; d0 < 8; ++d0) Ow[(long)orow * LDO + d0 * 32 + r32_e] = (bf16_t)(cvtpk(o[d0][r] * rli[r], 0.f) & 0xffffu); }
#undef DMA8
#undef DWAIT8
#undef SLOT
#undef SADV
#undef LDK8
#undef LDV8
#undef PIN1
#undef EXPR
#undef PKW
#undef PVM
#undef LDVG
#undef WSTEP
}

constexpr int PV_BUF = 32768, PK_BUF = 16384, P_LDS_V = 0, P_LDS_K = 2 * PV_BUF, P_LDS_X = P_LDS_K + 2 * PK_BUF, P_LDS_L = P_LDS_X + 8 * 2048, P_LDS_END = P_LDS_L + 1024;
__device__ __forceinline__ void qkt_half(f32x16& p, const LAS char* Ks, const bf16x8* qr, int krow, int hi) {
  p = f32x16{};
  for (int d0 = 0; d0 < 8; ++d0) { int cb = (d0 * 16 + hi * 8) * 2;
    bf16x8 b0 = *reinterpret_cast<const LAS bf16x8*>(Ks + KSWZ(krow, cb));
    p = __builtin_amdgcn_mfma_f32_32x32x16_bf16(b0, qr[d0], p, 0, 0, 0); }
}
__device__ __forceinline__ void smA(f32x16& p, float negMC) {
  constexpr float Cc = SCALE * 1.4426950408889634f;
  for (int r = 0; r < 16; ++r) p[r] = fmaf(p[r], Cc, negMC);
  for (int r = 0; r < 8; ++r) p[r] = __builtin_amdgcn_exp2f(p[r]);
}
__device__ __forceinline__ void smB(f32x16& p, float& l_reg, bf16x8& f0, bf16x8& f1) {
  for (int r = 8; r < 16; ++r) p[r] = __builtin_amdgcn_exp2f(p[r]);
  float ps = 0; for (int r = 0; r < 16; ++r) ps += p[r];
  { auto rr = __builtin_amdgcn_permlane32_swap(__float_as_uint(ps), __float_as_uint(ps), false, false);
    ps = __uint_as_float(rr[0]) + __uint_as_float(rr[1]); }
  l_reg += ps;
#define PK4(P, BASE, OUT) do { unsigned a0 = cvtpk(P[BASE + 0], P[BASE + 1]), a1 = cvtpk(P[BASE + 2], P[BASE + 3]);   \
    unsigned b0 = cvtpk(P[BASE + 4], P[BASE + 5]), b1 = cvtpk(P[BASE + 6], P[BASE + 7]);                              \
    auto r0 = __builtin_amdgcn_permlane32_swap(a0, b0, false, false); auto r1 = __builtin_amdgcn_permlane32_swap(a1, b1, false, false); \
    u32x4 w = {r0[0], r1[0], r0[1], r1[1]}; OUT = *reinterpret_cast<bf16x8*>(&w); } while (0)
  PK4(p, 0, f0); PK4(p, 8, f1);
#undef PK4
}
template <int LDQ, int LDK, int LDO>
__device__ __forceinline__ void attn_pair_body(const bf16_t* __restrict__ Qb, const bf16_t* __restrict__ Kh, const bf16_t* __restrict__ Vh, bf16_t* __restrict__ Ob, int seq, LAS char* lds, int tid, float kmax2) {
  const int wid = __builtin_amdgcn_readfirstlane(tid >> 6), lane = tid & 63, r32 = lane & 31, hi = lane >> 5, g = wid & 3, kb = wid >> 2;
  LAS char* V_lds = lds + P_LDS_V; LAS char* K_lds = lds + P_LDS_K;
  LAS char* xp_own = lds + P_LDS_X + wid * 2048 + lane * 16; LAS char* xp_par = lds + P_LDS_X + (wid ^ 4) * 2048 + lane * 16;
  LAS float* li = (LAS float*)(lds + P_LDS_L);
  float l_reg = 0; f32x16 o[4] = {}; bf16x8 qr[8];
  const bf16_t* Qw = Qb + (long)(g * QBLK + r32) * LDQ + hi * 8;
#pragma unroll
  for (int d0 = 0; d0 < 8; ++d0) qr[d0] = *reinterpret_cast<const bf16x8*>(Qw + d0 * 16);
  float negMC;
  { float q2 = 0.f;
#pragma unroll
    for (int d0 = 0; d0 < 8; ++d0) { const u32x4 w = __builtin_bit_cast(u32x4, qr[d0]);
      q2 += bflo(w.x) * bflo(w.x) + bfhi(w.x) * bfhi(w.x) + bflo(w.y) * bflo(w.y) + bfhi(w.y) * bfhi(w.y) + bflo(w.z) * bflo(w.z) + bfhi(w.z) * bfhi(w.z) + bflo(w.w) * bflo(w.w) + bfhi(w.w) * bfhi(w.w); }
    auto rr = __builtin_amdgcn_permlane32_swap(__float_as_uint(q2), __float_as_uint(q2), false, false);
    q2 = __uint_as_float(rr[0]) + __uint_as_float(rr[1]);
    negMC = -(sqrtf(q2 * kmax2) * (SCALE * 1.0001f) - 30.0f) * 1.4426950408889634f; }
  const int sr = tid >> 4, sc = (tid & 15) * 8, vst0 = v_st(sr, sc), vst1 = v_st(32 + sr, sc);
  const int vrd = (int)(uintptr_t)V_lds + kb * 16384 + v_rd_base(lane);
  const int krow = 32 * kb + r32;
  struct { bf16x8 v00, v01, v10, v11, k0, k1; } st_;
#define PLD16(base, off) (*reinterpret_cast<const bf16x8*>((const char*)(base) + (off)))
#define PLOAD(k0_) do { const unsigned o_ = (unsigned)(((k0_) + sr) * LDK + sc) * 2u; \
    st_.v00 = PLD16(Vh, o_); st_.v01 = PLD16(Vh, o_ + 256u); st_.v10 = PLD16(Vh, o_ + 64u * LDK); st_.v11 = PLD16(Vh, o_ + 64u * LDK + 256u); \
    st_.k0 = PLD16(Kh, o_); st_.k1 = PLD16(Kh, o_ + 64u * LDK); } while (0)
#define PWRITE(kbuf, vbuf) do { LAS char* vb_ = V_lds + (vbuf) * PV_BUF; LAS char* kb_ = K_lds + (kbuf) * PK_BUF; const int kc = sc * 2; \
    *(LAS bf16x8*)(vb_ + vst0) = st_.v00; *(LAS bf16x8*)(vb_ + 16384 + vst0) = st_.v01; *(LAS bf16x8*)(vb_ + vst1) = st_.v10; *(LAS bf16x8*)(vb_ + 16384 + vst1) = st_.v11; \
    *(LAS bf16x8*)(kb_ + KSWZ(sr, kc)) = st_.k0; *(LAS bf16x8*)(kb_ + KSWZ(32 + sr, kc)) = st_.k1; } while (0)
  const int NT = seq / KVBLK;
  f32x16 pS; bf16x8 f0, f1, g0, g1;
  PLOAD(0); asm volatile("s_waitcnt vmcnt(0)" ::: "memory"); PWRITE(0, 0); PLOAD(KVBLK);
  __syncthreads();
  for (int j = 0; j < NT; ++j) {
    SBAR();
    qkt_half(pS, K_lds + (j & 1) * PK_BUF, qr, krow, hi);
    smA(pS, negMC); smB(pS, l_reg, f0, f1); SBAR();
    *(LAS bf16x8*)(xp_own) = f0; *(LAS bf16x8*)(xp_own + 1024) = f1;
    if (j + 1 < NT) PWRITE((j + 1) & 1, (j + 1) & 1);
    if (j + 2 < NT) PLOAD((j + 2) * KVBLK);
    __syncthreads();
    g0 = *(const LAS bf16x8*)(xp_par); g1 = *(const LAS bf16x8*)(xp_par + 1024);
    { const int vb = vrd + (j & 1) * PV_BUF;
      if (kb == 0) pv_d0(o, vb, f0, f1, g0, g1); else pv_d0(o, vb, g0, g1, f0, f1); }
    __syncthreads();
  }
  if (hi == 0) li[wid * 32 + r32] = l_reg;
  __syncthreads();
#pragma unroll
  for (int r = 0; r < 16; ++r) { const int orow = crow(r, hi); const float rl = __builtin_amdgcn_rcpf(li[wid * 32 + orow] + li[(wid ^ 4) * 32 + orow]);
    bf16_t* op = Ob + (long)(g * QBLK + orow) * LDO + 128 * kb + r32;
    for (int d0 = 0; d0 < 4; ++d0) op[d0 * 32] = (bf16_t)(cvtpk(o[d0][r] * rl, 0.f) & 0xffffu); }
#undef PLD16
#undef PLOAD
#undef PWRITE
}
#undef KSWZ
}

__device__ __forceinline__ void phase_attention(const Params& p, Ctx& C) {
    bf16_t* ATT = (bf16_t*)(p.ws + WS_BIG + BG_ATT);
    const unsigned char* Q8 = (const unsigned char*)(p.ws + WS_BIG + BG_Q8); const unsigned char* K8 = (const unsigned char*)(p.ws + WS_BIG + BG_K8); const unsigned char* VT8 = (const unsigned char*)(p.ws + WS_BIG + BG_VT8);
    const unsigned char* Q8D = (const unsigned char*)(p.ws + WS_BIG + BG_Q8D); const unsigned char* K8D = (const unsigned char*)(p.ws + WS_BIG + BG_K8D); const unsigned char* VT8D = (const unsigned char*)(p.ws + WS_BIG + BG_VT8D);
    for (int i = 0;; ++i) {
        int unit;
        if (C.G == 256) { if (i >= 2) break; unit = (C.bid & 7) * 64 + i * 32 + (C.bid >> 3); } else { unit = i * C.G + C.bid; if (unit >= 512) break; }
        const int d = unit >> 6, qb = unit & 63, hh = d >> 1, m = d & 1;
        __syncthreads();
        int tz = C.tid; asm volatile("" : "+v"(tz));
        att::attn_dense8w_body<3072, 1024>(Q8D + (size_t)(CTXL + 256 * qb) * 1024 + 128 * d, K8D + 128 * d, VT8D + (size_t)(2 * hh) * 260 * 8192, VT8D + (size_t)(2 * hh + 1) * 260 * 8192,
                                           ATT + (size_t)(256 * qb) * 3072 + 1024 + 1024 * m + 256 * hh, TT, (LAS char*)C.lds, tz, 0.f);
    }
    for (int i = 0;; ++i) {
        int unit;
        if (C.G == 256) { if (i >= 2) break; unit = (C.bid & 7) * 64 + i * 32 + (C.bid >> 3); } else { unit = i * C.G + C.bid; if (unit >= 512) break; }
        const int prob = unit >> 6, qb = unit & 63;
        __syncthreads();
        int tz = C.tid; asm volatile("" : "+v"(tz));
        att::attn_dense8_body<3072, 256>(Q8 + (size_t)(CTXL + 256 * qb) * 1024 + 128 * prob, K8 + 128 * (prob >> 2), VT8 + (size_t)(prob >> 2) * 260 * 8192,
                                         ATT + (size_t)(256 * qb) * 3072 + 128 * prob, TT, (LAS char*)C.lds, tz, 0.f);
    }
    __syncthreads();
}
constexpr int PH_PER_LAYER = 13, N_PHASES = 2 + 2 * PH_PER_LAYER;
#ifndef DBL_PHASE
#define DBL_PHASE -1
#endif
#ifndef MK_PER_PHASE
#define MK_PER_PHASE 0
#endif

template <int L>
__device__ __forceinline__ void layer_body(const Params& p, Ctx& C0, const XcdBarrier& bar, LAS unsigned char* misc, int lo, int hi) {
#define IN(k) (lo <= (k) && (k) < hi)
#define SEAM(k) do { if (IN(k) && IN((k) + 1)) xcd_barrier(bar, C0.wave); } while (0)
#define PHASE(k, ...) if (DBL_PHASE == (k)) { int nrep_ = 2; asm volatile("" : "+s"(nrep_)); for (int rep_ = 0; rep_ < nrep_; ++rep_) { if (rep_) xcd_barrier(bar, C0.wave); FRESH(); __VA_ARGS__ } } else if (IN(k)) { FRESH(); __VA_ARGS__ } SEAM(k);
#define FRESH() Ctx C = C0; { int ln = (int)__builtin_amdgcn_mbcnt_hi(~0u, __builtin_amdgcn_mbcnt_lo(~0u, 0u)); asm volatile("" : "+v"(ln)); C.lane = ln; C.tid = C.wave * 64 + ln; }
        const int b = 2 + PH_PER_LAYER * L;
        bf16_t* QKV = (bf16_t*)(p.ws + WS_BIG + BG_QKV);
        bf16_t* XA = (bf16_t*)(p.ws + WS_XA);
        int* cnt = (int*)(p.ws + WS_CTL) + CW_CNT + L * 128; const int* LIST = (const int*)(p.ws + WS_LIST);
        if (L == 0) { PHASE(b + 0, phase_modulate(p, C, L); ) }
        PHASE(b + 1,
            const int N = L ? OD_IN : EV_IN;
            pg8::DenseOrder S; S.init8((const void*)XA, DM, (const void*)(p.ws + (L ? WS_WIN1 : WS_WIN0)), TT, N, DM, C.G, C.bid);
            pg8::EpiStore E{QKV, N, 1.0f / 32.0f};
            pg8::gemm_phase<true>(C.lds, S, E, C.wave);
            if (L == 0 && IN(b + 2) && S.units_of_me() < S.max_units()) conv_queue(p, C, 2);
        )
        PHASE(b + 2, if (L == 0) phase_rope0(p, C); else phase_normrope1(p, C); )
        PHASE(b + 3, if (L == 0) { ret_chunk_kv(p, C); s5_end_states(p, C); } else phase_attention(p, C); )
        PHASE(b + 4, if (L == 0) phase_scans(p, C); else phase_merge1(p, C); )
        if (L == 0) {
            PHASE(b + 5, phase_ret_s5_outputs(p, C, misc); )
            PHASE(b + 6,
                pg8::DenseOrder S; S.init((const bf16_t*)(p.ws + WS_Z), 1024, (const bf16_t*)(p.ws + WS_WGLU), TT, 1024, 1024, C.G, C.bid);
                pg8::EpiGlu E{(const bf16_t*)(p.ws + WS_Z), p.inp(20), (bf16_t*)(p.ws + WS_BIG + BG_MIX)};
                pg8::gemm_phase<false>(C.lds, S, E, C.wave);
                if (IN(b + 7) && S.units_of_me() < S.max_units()) conv_queue(p, C, 4);
            )
        }
        PHASE(b + 7,
            pg8::DenseOrder S;
            if (L == 0) S.init((const bf16_t*)(p.ws + WS_BIG + BG_MIX), DM, (const bf16_t*)(p.ws + WS_WOUT0), TT, DM, DM, C.G, C.bid);
            else S.init((const bf16_t*)(p.ws + WS_BIG + BG_ATT), 3072, (const bf16_t*)(p.ws + WS_WOUT1), SEQ, DM, DM, C.G, C.bid);
            pg8::EpiStore E{(bf16_t*)(p.ws + WS_YMIX) + (L ? (size_t)CTXL * DM : 0), DM, 1.0f};
            pg8::gemm_phase<false>(C.lds, S, E, C.wave);
            if (L == 0 && IN(b + 8) && S.units_of_me() < S.max_units()) conv_queue(p, C, 5);
        )
        PHASE(b + 8, phase_ln1(p, C, L); )
        PHASE(b + 9, phase_router(p, C, L); )
        PHASE(b + 10,
            pg8::MoeOrder<0> S; S.A = (const void*)XA; S.Bt = (const void*)(p.ws + WS_GU + (size_t)L * NEX1 * 1024 * DM); S.list = LIST; S.cnt = cnt; S.ldab = DM; S.kb = DM; S.nN = 4; S.G = C.G; S.c = C.bid; S.bstride = (size_t)1024 * DM;
            S.prep(misc, C.tid);
            pg8::EpiE1 E{(unsigned char*)(p.ws + WS_HX2), S.cn, S.rb};
            pg8::gemm_phase<true>(C.lds, S, E, C.wave);
        )
        PHASE(b + 11,
            pg8::MoeOrder<1> S; S.A = (const void*)(p.ws + WS_HX2); S.Bt = (const void*)(p.ws + WS_DT + (size_t)L * NEX1 * DM * EHID); S.list = LIST; S.cnt = cnt; S.ldab = EHID; S.kb = EHID; S.nN = 8; S.G = C.G; S.c = C.bid; S.bstride = (size_t)DM * EHID;
            S.prep(misc, C.tid);
            pg8::EpiE2 E{(unsigned char*)(p.ws + WS_BIG + BG_YMOE), (const float*)(p.ws + WS_LW), S.cn, S.rb};
            pg8::gemm_phase<true>(C.lds, S, E, C.wave);
        )
        PHASE(b + 12, phase_combine(p, C, L, misc); )
    #undef IN
#undef SEAM
#undef FRESH
#undef PHASE
}

__global__ void __launch_bounds__(NTHR, 2) mega_fwd(KArgs ka) {
    extern __shared__ __attribute__((aligned(16))) unsigned char lds_raw[];
    Ctx C;
    C.lds = (LAS unsigned char*)lds_raw;
    C.tid = threadIdx.x; C.lane = C.tid & 63; C.wave = __builtin_amdgcn_readfirstlane(C.tid >> 6);
    C.G = gridDim.x; C.bid = blockIdx.x; C.gw = C.bid * NWAVES + C.wave; C.ngw = C.G * NWAVES;
    LAS unsigned char* misc = C.lds + MISC_OFF;
    if (C.tid < 8) ((volatile LAS unsigned*)misc)[C.tid] = 0u;
    Params p; p.out = ka.out; p.ws = ka.ws; p.ph_lo = ka.ph_lo; p.ph_hi = ka.ph_hi; p.ptab = (LAS unsigned long long*)(misc + 1024);
    if (C.tid < 34) p.ptab[C.tid] = (unsigned long long)ka.in[C.tid];
    __syncthreads();
    const int lo = p.ph_lo, hi = p.ph_hi;
    XcdBarrier bar; bar.bar = (unsigned*)(p.ws + WS_CTL) + CW_BAR; bar.x = 0; bar.st = (volatile LAS unsigned*)misc;
    if (hi - lo > 1) bar = xcd_barrier_post((unsigned*)(p.ws + WS_CTL) + CW_BAR, (volatile LAS unsigned*)misc);
#define IN(k) (lo <= (k) && (k) < hi)
#define SEAM(k) do { if (IN(k) && IN((k) + 1)) xcd_barrier(bar, C.wave); } while (0)

    if (IN(0)) { phase_p0(p, C); } SEAM(0);
    if (IN(1)) { phase_p1(p, C); } SEAM(1);
    if (IN(0) && IN(2) && (C.G & 7) == 0) {
        volatile LAS unsigned* st = (volatile LAS unsigned*)misc;
        if (C.tid == 0) { unsigned pre = 0u; const unsigned x = st[3];
            for (unsigned j = 0; j < 16; ++j) { const unsigned cj = xb_ld(&bar.bar[XB_XCNT(j)]); pre += (j < x) ? cj : 0u; }
            st[4] = pre + st[2]; }
        __syncthreads();
        const int vcu = (int)st[4], g8 = C.G >> 3;
        C.bid = __builtin_amdgcn_readfirstlane((vcu % g8) * 8 + vcu / g8); C.gw = C.bid * NWAVES + C.wave;
    }

    layer_body<0>(p, C, bar, misc, lo, hi);
    layer_body<1>(p, C, bar, misc, lo, hi);
#undef IN
#undef SEAM
}

extern "C" void kernel_launch(void* const* d_in, const int* in_sizes, int n_in, void* d_out, int out_size, void* d_ws, size_t ws_size, hipStream_t stream) {
    static int grid = 0;
    if (grid == 0) {
        if (n_in != 34 || out_size != SEQ * DM || ws_size < WS_END) { fprintf(stderr, "kernel_launch: unexpected shapes: n_in %d out %d ws %zu (need %zu)\n", n_in, out_size, ws_size, (size_t)WS_END); grid = -1; return; }
        int dev = 0, cus = 0, per_cu = 0;
        if (hipGetDevice(&dev) != hipSuccess || hipDeviceGetAttribute(&cus, hipDeviceAttributeMultiprocessorCount, dev) != hipSuccess) { grid = -1; return; }
        if (hipFuncSetAttribute((const void*)mega_fwd, hipFuncAttributeMaxDynamicSharedMemorySize, LDS_BYTES) != hipSuccess) { fprintf(stderr, "kernel_launch: hipFuncSetAttribute failed\n"); grid = -1; return; }
        if (hipOccupancyMaxActiveBlocksPerMultiprocessor(&per_cu, (const void*)mega_fwd, NTHR, LDS_BYTES) != hipSuccess || per_cu < 1) { fprintf(stderr, "kernel_launch: occupancy query says %d blocks per CU\n", per_cu); grid = -1; return; }
        (void)hipGetLastError();
        grid = cus;
    }
    if (grid < 0) return;
    (void)hipMemsetAsync((char*)d_ws + WS_CTL, 0, CTL_BYTES, stream);
    KArgs p{};
    for (int i = 0; i < 34; ++i) p.in[i] = (const float*)d_in[i];
    p.out = (float*)d_out; p.ws = (unsigned char*)d_ws;
#if MK_PER_PHASE
    for (int ph = 0; ph < N_PHASES; ++ph) {
        if (ph == 2 + PH_PER_LAYER + 0 || ph == 2 + PH_PER_LAYER + 5 || ph == 2 + PH_PER_LAYER + 6) continue;
        p.ph_lo = ph; p.ph_hi = ph + 1;
        hipLaunchKernelGGL(mega_fwd, dim3(grid), dim3(NTHR), LDS_BYTES, stream, p);
    }
#else
    p.ph_lo = 0; p.ph_hi = N_PHASES;
    hipLaunchKernelGGL(mega_fwd, dim3(grid), dim3(NTHR), LDS_BYTES, stream, p);
#endif
    const hipError_t le = hipPeekAtLastError();
    if (le != hipSuccess) fprintf(stderr, "kernel_launch: launch failed: %s\n", hipGetErrorName(le));
}
```

```cpp
#define MK_PER_PHASE 0
#include <hip/hip_runtime.h>
#include <cstdio>
#include <cstdint>

#define GAS __attribute__((address_space(1)))
#define LAS __attribute__((address_space(3)))
typedef unsigned short bf16_t;
typedef short bf16x8 __attribute__((ext_vector_type(8)));
typedef short s16x4 __attribute__((ext_vector_type(4)));
typedef float f32x4 __attribute__((ext_vector_type(4)));
typedef float f32x2 __attribute__((ext_vector_type(2)));
typedef float f32x16 __attribute__((ext_vector_type(16)));
typedef unsigned u32x4 __attribute__((ext_vector_type(4)));
typedef unsigned u32x2 __attribute__((ext_vector_type(2)));

constexpr int DM = 2048, SEQ = 16384, CTXL = 256, TT = SEQ + CTXL;
constexpr int NEXP = 64, NEX1 = 65, EHID = 512, TOPK = 8;
constexpr int EV_IN = 5120, OD_IN = 4608;
constexpr float LN_EPS = 1e-6f;
constexpr float ALPHA = 1.4142135623730951f;
constexpr float LAMBDA_INIT = 0.35550906759f;
constexpr int NTHR = 512, NWAVES = 8;

constexpr size_t al256(size_t x) { return (x + 255) / 256 * 256; }
constexpr size_t WS_CTL   = 0;
constexpr size_t CTL_BYTES = 1u << 20;
constexpr size_t WS_MODP  = WS_CTL + CTL_BYTES;
constexpr size_t WS_MODF  = WS_MODP + al256((size_t)2 * 32 * 2 * 12288 * 4);
constexpr size_t WS_ROPE128 = WS_MODF + al256((size_t)2 * 2 * 12288 * 4);
constexpr size_t WS_ROPE64  = WS_ROPE128 + al256((size_t)256 * 64 * 2 * 4);
constexpr size_t WS_KN    = WS_ROPE64 + al256((size_t)256 * 32 * 2 * 4);
constexpr size_t WS_WT    = WS_KN + al256((size_t)2 * 64 * 16 * 1024 * 2);
constexpr size_t WS_APOW  = WS_WT + al256((size_t)2 * 64 * 128 * 1024 * 2);
constexpr size_t WS_AL    = WS_APOW + al256((size_t)2 * 64 * 64 * 128 * 4);
constexpr size_t WS_CC    = WS_AL + al256((size_t)2 * 64 * 128 * 4);
constexpr size_t WS_BBT   = WS_CC + al256((size_t)64 * 16 * 128 * 2);
constexpr size_t WS_S5E   = WS_BBT + al256((size_t)2 * 64 * 128 * 16 * 2);
constexpr size_t WS_HST   = WS_S5E + al256((size_t)2 * 64 * 260 * 128 * 4);
constexpr size_t WS_WIN0  = WS_HST + al256((size_t)2 * 64 * 260 * 128 * 4);
constexpr size_t WS_WOUT0 = WS_WIN0 + al256((size_t)EV_IN * DM * 2);
constexpr size_t WS_WGLU  = WS_WOUT0 + al256((size_t)DM * DM * 2);
constexpr size_t WS_WIN1  = WS_WGLU + al256((size_t)1024 * 1024 * 2);
constexpr size_t WS_WOUT1 = WS_WIN1 + al256((size_t)OD_IN * DM * 2);
constexpr size_t WS_RWT   = WS_WOUT1 + al256((size_t)DM * DM * 2);
constexpr size_t WS_GU    = WS_RWT + al256((size_t)2 * 2 * 64 * DM * 2);
constexpr size_t WS_DT    = WS_GU + al256((size_t)NEX1 * 1024 * DM * 2);
constexpr size_t WS_XA    = WS_DT + al256((size_t)NEX1 * DM * EHID * 2);
constexpr size_t WS_Z     = WS_XA + al256((size_t)TT * DM * 2);
constexpr size_t WS_YMIX  = WS_Z + al256((size_t)TT * 1024 * 2);
constexpr size_t WS_X1    = WS_YMIX + al256((size_t)TT * DM * 2);
constexpr size_t WS_HX2   = WS_X1 + al256((size_t)TT * DM * 4);
constexpr size_t WS_LIST  = WS_HX2 + al256((size_t)9 * TT * EHID * 2);
constexpr size_t WS_WGT   = WS_LIST + al256((size_t)NEX1 * TT * 4);
constexpr size_t WS_LW    = WS_WGT + al256((size_t)8 * TT * 4);
constexpr size_t WS_BIG   = WS_LW + al256((size_t)NEX1 * TT * 4);
constexpr size_t BG_QKV   = 0;
constexpr size_t BG_CKV   = BG_QKV + al256((size_t)TT * EV_IN * 2);
constexpr size_t BG_SPREV = BG_CKV + al256((size_t)8 * 130 * 65536 * 4);
constexpr size_t BG_MIX   = BG_SPREV + al256((size_t)8 * 130 * 65536 * 2);
constexpr size_t BG_END0  = BG_MIX + al256((size_t)TT * DM * 2);
constexpr size_t BG_ATT   = BG_CKV;
constexpr size_t BG_Q8    = BG_ATT + al256((size_t)SEQ * 3072 * 2);
constexpr size_t BG_K8    = BG_Q8 + al256((size_t)TT * 1024);
constexpr size_t BG_VT8   = BG_K8 + al256((size_t)TT * 256);
constexpr size_t BG_Q8D   = BG_VT8 + al256((size_t)2 * 260 * 128 * 64);
constexpr size_t BG_K8D   = BG_Q8D + al256((size_t)TT * 1024);
constexpr size_t BG_VT8D  = BG_K8D + al256((size_t)TT * 1024);
constexpr size_t BG_F8END = BG_VT8D + al256((size_t)8 * 260 * 128 * 64);
constexpr size_t BG_YMOE  = 0;
constexpr size_t BG_END1  = al256((size_t)9 * TT * DM * 2);
constexpr size_t BG_SIZE  = BG_END0 > BG_END1 ? BG_END0 : BG_END1;
static_assert(BG_F8END <= BG_SIZE, "fp8 attention operands inside the big region");
constexpr size_t WS_END   = WS_BIG + BG_SIZE;

constexpr int CW_BAR = 4096;
constexpr int CW_CNT = 16384;
constexpr int CW_QUEUE = 20480;
constexpr int CW_KMAX = 24576;

constexpr int RING_BYTES = 151552;
constexpr int MISC_OFF = RING_BYTES;
constexpr int LDS_BYTES = 159744;

typedef __bf16 bf16x2_t __attribute__((ext_vector_type(2)));
__device__ __forceinline__ unsigned cvt_pk_bf16(float lo, float hi) { const f32x2 v = {lo, hi}; return __builtin_bit_cast(unsigned, __builtin_convertvector(v, bf16x2_t)); }
__device__ __forceinline__ bf16_t f2bf(float f) { unsigned u = __builtin_bit_cast(unsigned, f); return (bf16_t)((u + 0x7fffu + ((u >> 16) & 1u)) >> 16); }
__device__ __forceinline__ float bf2f(bf16_t b) { return __builtin_bit_cast(float, ((unsigned)b) << 16); }
__device__ __forceinline__ float bflo(unsigned w) { return __builtin_bit_cast(float, w << 16); }
__device__ __forceinline__ float bfhi(unsigned w) { return __builtin_bit_cast(float, w & 0xffff0000u); }
__device__ __forceinline__ float wave_sum(float v) {
#pragma unroll
    for (int o = 1; o < 64; o <<= 1) v += __shfl_xor(v, o);
    return v;
}
__device__ __forceinline__ float fast_exp(float x) { return __builtin_amdgcn_exp2f(x * 1.4426950408889634f); }
__device__ __forceinline__ float sigmoidf_(float x) { return 1.0f / (1.0f + __expf(-x)); }
__device__ __forceinline__ float siluf_(float x) { return x / (1.0f + __expf(-x)); }
__device__ __forceinline__ float gelu_tanh(float x) {
    const float u = 0.7978845608028654f * (x + 0.044715f * x * x * x);
    const float e = __expf(2.0f * u);
    const float t = 1.0f - 2.0f / (e + 1.0f);
    return 0.5f * x * (1.0f + t);
}
#define LDS_WAIT() asm volatile("s_waitcnt lgkmcnt(0)" ::: "memory")
#define VM_WAIT() asm volatile("s_waitcnt vmcnt(0)" ::: "memory")

#define XB_TMO      128
#define XB_XCNT(j)  (256  + 64 * (j))
#define XB_XSUB(j)  (1280 + 64 * (j))
#define XB_XGEN(j)  (2304 + 64 * (j))
#define XB_TOP      3328
#define XB_TOPGEN   3392
#define XCD_BAR_WORDS 3456
#define XB_SPIN_CAP (1u << 22)

__device__ __forceinline__ unsigned xb_ld(unsigned* p)              { return __hip_atomic_load(p, __ATOMIC_RELAXED, __HIP_MEMORY_SCOPE_AGENT); }
__device__ __forceinline__ unsigned xb_add(unsigned* p, unsigned v) { return __hip_atomic_fetch_add(p, v, __ATOMIC_RELAXED, __HIP_MEMORY_SCOPE_AGENT); }
__device__ __forceinline__ unsigned xb_xcc_id() { return (unsigned)__builtin_amdgcn_s_getreg((3 << 11) | 20) & 0xFu; }
#define XB_SPIN(cond, bar) do { unsigned _sp = 0; while (cond) { __builtin_amdgcn_s_sleep(1); \
    if ((++_sp & 255u) == 0u) { if (xb_ld(&(bar)[XB_TMO])) break; if (_sp > XB_SPIN_CAP) { atomicAdd(&(bar)[XB_TMO], 1u); break; } } } } while (0)

struct XcdBarrier { unsigned* bar; unsigned x; volatile LAS unsigned* st; };

__device__ __forceinline__ XcdBarrier xcd_barrier_post(unsigned* bar, volatile LAS unsigned* st) {
    XcdBarrier b; b.bar = bar; b.x = xb_xcc_id(); b.st = st;
    if (threadIdx.x == 0) { st[2] = xb_add(&bar[XB_XCNT(b.x)], 1u); st[3] = b.x; }
    return b;
}
__device__ __forceinline__ void xcd_barrier_complete(unsigned* bar, unsigned x, unsigned& nloc, unsigned& nx) {
    const unsigned G = gridDim.x * gridDim.y * gridDim.z;
    unsigned sum, cnt, mine, sp = 0u;
    for (;;) {
        sum = 0u; cnt = 0u; mine = 0u;
#pragma unroll
        for (unsigned j = 0; j < 16; ++j) { const unsigned c = xb_ld(&bar[XB_XCNT(j)]); sum += c; cnt += (c > 0u) ? 1u : 0u; mine = (j == x) ? c : mine; }
        if (sum == G) break;
        __builtin_amdgcn_s_sleep(1);
        if ((++sp & 255u) == 0u) { if (xb_ld(&bar[XB_TMO])) break; if (sp > XB_SPIN_CAP) { atomicAdd(&bar[XB_TMO], 1u); break; } }
    }
    nloc = mine > 0u ? mine : 1u; nx = cnt > 0u ? cnt : 1u;
}
__device__ __forceinline__ void xcd_barrier(const XcdBarrier& b, int wave_id) {
    const bool leader_thread = (wave_id == 0) && (__builtin_amdgcn_mbcnt_hi(~0u, __builtin_amdgcn_mbcnt_lo(~0u, 0u)) == 0u);
    asm volatile("s_waitcnt vmcnt(0)" ::: "memory");
    __syncthreads();
    if (leader_thread) {
        unsigned* bar = b.bar;
        __builtin_amdgcn_s_waitcnt(0);
        unsigned nloc = b.st[0], nx = b.st[1];
        if (nloc == 0u) { xcd_barrier_complete(bar, b.x, nloc, nx); b.st[0] = nloc; b.st[1] = nx; }
        const unsigned old = xb_add(&bar[XB_XSUB(b.x)], 1u);
        const unsigned gen = old / nloc;
        if (old + 1u == (gen + 1u) * nloc) {
            __builtin_amdgcn_fence(__ATOMIC_RELEASE, "agent");
            asm volatile("s_waitcnt vmcnt(0)" ::: "memory");
            const unsigned og = xb_add(&bar[XB_TOP], 1u);
            const unsigned tg = og / nx;
            if (og + 1u == (tg + 1u) * nx) xb_add(&bar[XB_TOPGEN], 1u);
            else XB_SPIN(xb_ld(&bar[XB_TOPGEN]) == tg, bar);
            __builtin_amdgcn_fence(__ATOMIC_ACQUIRE, "agent");
            xb_add(&bar[XB_XGEN(b.x)], 1u);
            asm volatile("s_waitcnt vmcnt(0)" ::: "memory");
        } else {
            XB_SPIN(xb_ld(&bar[XB_XGEN(b.x)]) == gen, bar);
            __builtin_amdgcn_fence(__ATOMIC_ACQUIRE, "agent");
            asm volatile("s_waitcnt vmcnt(0)" ::: "memory");
        }
    }
    __syncthreads();
}

__device__ __forceinline__ bf16x8 frag_rowk_l(const LAS bf16_t* p, int ld, int lane) {
    return *(const LAS bf16x8*)(p + (lane & 15) * ld + (lane >> 4) * 8);
}
__device__ __forceinline__ bf16x8 frag_rowk_g(const bf16_t* p, long ld, int lane) {
    return *(const bf16x8*)(p + (long)(lane & 15) * ld + (lane >> 4) * 8);
}
__device__ __forceinline__ bf16x8 frag_colk_l(unsigned p, int ldb, int lane) {
    const unsigned a0 = p + (unsigned)((8 * (lane >> 4) + ((lane & 15) >> 2)) * ldb + (lane & 3) * 8);
    const unsigned a1 = a0 + 4u * (unsigned)ldb;
    s16x4 lo, hi;
    asm volatile("ds_read_b64_tr_b16 %0, %2\n\tds_read_b64_tr_b16 %1, %3\n\ts_waitcnt lgkmcnt(0)" : "=&v"(lo), "=&v"(hi) : "v"(a0), "v"(a1) : "memory");
    return (bf16x8){lo[0], lo[1], lo[2], lo[3], hi[0], hi[1], hi[2], hi[3]};
}
#define MFMA16(a, b, c) __builtin_amdgcn_mfma_f32_16x16x32_bf16((a), (b), (c), 0, 0, 0)
namespace pg8 {
constexpr int BM = 256, BK = 64, HALF = 128, HTB = HALF * BK * 2, STAGE_BYTES = 8 * HTB, NXCD = 8, WGM = 8;
__device__ __forceinline__ int lds_byte(int r, int c) { const int st = (r >> 4) * 2 + (c >> 5), rr = r & 15, cc = c & 31, ob = rr * 64 + cc * 2; return st * 1024 + (ob ^ (((ob >> 9) & 1) << 5)); }
__device__ __forceinline__ void stage_rc(int b, int& R, int& C) { const int st = b / 1024, sb = b % 1024, swz = sb ^ (((sb >> 9) & 1) << 5); R = (st >> 1) * 16 + swz / 64; C = (st & 1) * 32 + (swz % 64) / 2; }
__device__ __forceinline__ int perm32(int rho) { const int n = rho >> 4, i = rho & 15; return 8 * (i >> 2) + 4 * n + (i & 3); }

struct Unit { int pm, pn, e; };
constexpr float WSCALE = 32.0f, WSCALE_INV = 1.0f / 32.0f;

struct DenseOrder {
    const bf16_t* A; const bf16_t* Bt; int ldab, kb, nM, nN, nwg, G, c;
    __device__ __forceinline__ void init(const bf16_t* A_, int lda_, const bf16_t* Bt_, int M, int N, int K_, int G_, int c_) { A = A_; ldab = lda_ * 2; Bt = Bt_; kb = K_ * 2; nM = M / BM; nN = N / BM; nwg = nM * nN; G = G_; c = c_; }
    __device__ __forceinline__ void init8(const void* A_, int ldab_, const void* Bt_, int M, int N, int K_, int G_, int c_) { A = (const bf16_t*)A_; ldab = ldab_; Bt = (const bf16_t*)Bt_; kb = K_; nM = M / BM; nN = N / BM; nwg = nM * nN; G = G_; c = c_; }
    __device__ __forceinline__ void prep(LAS unsigned char*) const {}
    __device__ __forceinline__ int units_of_me() const { return c < nwg ? (nwg - c + G - 1) / G : 0; }
    __device__ __forceinline__ int max_units() const { return (nwg + G - 1) / G; }
    __device__ __forceinline__ bool next(int i, Unit& u) const {
        const long L = (long)i * G + c; if (L >= nwg) return false;
        int wgid = (int)L; { const int q = nwg / NXCD, r = nwg % NXCD, xcd = wgid % NXCD, off = wgid / NXCD; wgid = (xcd < r ? xcd * (q + 1) : r * (q + 1) + (xcd - r) * q) + off; }
        const int nig = WGM * nN, gid = wgid / nig, fm = gid * WGM, gsz = (nM - fm) < WGM ? (nM - fm) : WGM;
        u.pm = fm + ((wgid % nig) % gsz); u.pn = (wgid % nig) / gsz; u.e = 0; return true;
    }
    __device__ __forceinline__ const char* a_base() const { return (const char*)A; }
    __device__ __forceinline__ unsigned a_off(const Unit& u, int r) const { return (unsigned)(u.pm * BM + r) * (unsigned)ldab; }
    __device__ __forceinline__ void a_off4(const Unit& u, int r0, int r1, int half, u32x4& o) const { o.x = a_off(u, r0); o.y = a_off(u, r1); o.z = a_off(u, half + r0); o.w = a_off(u, half + r1); }
    __device__ __forceinline__ const char* b_ptr(const Unit& u) const { return (const char*)Bt + (size_t)u.pn * BM * kb; }
};

template <int MODE  >
struct MoeOrder {
    const void* A; const void* Bt; const int* list; const int* cnt; int ldab, kb, nN, G, c; size_t bstride;
    LAS int* tp; LAS int* cn; LAS int* rb;
    __device__ __forceinline__ void prep(LAS unsigned char* misc, int tid) {
        tp = (LAS int*)(misc + 64); cn = tp + 72; rb = cn + 72;
        if (tid < NEX1) cn[tid] = cnt[tid];
        __syncthreads();
        if (tid == 0) { int s = 0, q = 0; for (int e = 0; e < NEX1; ++e) { tp[e] = s; rb[e] = q; s += (cn[e] + BM - 1) / BM; q += cn[e]; } tp[NEX1] = s; rb[NEX1] = q; }
        __syncthreads();
    }
    __device__ __forceinline__ bool next(int i, Unit& u) const {
        const int total = tp[NEX1]; const long nu = (long)total * nN; const int per = (int)((nu + G - 1) / G);
        (void)per;
        long L = (long)i * G + c;
        if ((G & 7) == 0) L = ((long)i * 8 + (c & 7)) * (G >> 3) + (c >> 3);
        if (L >= nu) return false;
        const int tile = (int)(L / nN); u.pn = (int)(L % nN);
        const int ln_ = (int)__builtin_amdgcn_mbcnt_hi(~0u, __builtin_amdgcn_mbcnt_lo(~0u, 0u));
        const int e = __builtin_popcountll(__ballot(tp[ln_ + 1] <= tile));
        u.e = e; u.pm = tile - tp[e]; return true;
    }
    __device__ __forceinline__ const char* a_base() const { return (const char*)A; }
    __device__ __forceinline__ unsigned a_off(const Unit& u, int r) const {
        int pos = u.pm * BM + r; const int n = cn[u.e]; pos = pos < n ? pos : n - 1;
        if (MODE == 1) return (unsigned)(rb[u.e] + pos) * (unsigned)ldab;
        const int a = list[u.e * TT + pos];
        const int row = a < 8 * TT ? (a >> 3) : a - 8 * TT;
        return (unsigned)row * (unsigned)ldab;
    }
    __device__ __forceinline__ void a_off4(const Unit& u, int r0, int r1, int half, u32x4& o) const {
        if (MODE == 1) { o.x = a_off(u, r0); o.y = a_off(u, r1); o.z = a_off(u, half + r0); o.w = a_off(u, half + r1); return; }
        const int n = cn[u.e], pb = u.pm * BM; const int* lp = list + u.e * TT;
        const int a0 = lp[min(pb + r0, n - 1)], a1 = lp[min(pb + r1, n - 1)], a2 = lp[min(pb + half + r0, n - 1)], a3 = lp[min(pb + half + r1, n - 1)];
        o.x = (unsigned)(a0 < 8 * TT ? (a0 >> 3) : a0 - 8 * TT) * (unsigned)ldab; o.y = (unsigned)(a1 < 8 * TT ? (a1 >> 3) : a1 - 8 * TT) * (unsigned)ldab;
        o.z = (unsigned)(a2 < 8 * TT ? (a2 >> 3) : a2 - 8 * TT) * (unsigned)ldab; o.w = (unsigned)(a3 < 8 * TT ? (a3 >> 3) : a3 - 8 * TT) * (unsigned)ldab;
    }
    __device__ __forceinline__ const char* b_ptr(const Unit& u) const { return (const char*)Bt + (size_t)u.e * bstride + (size_t)u.pn * BM * kb; }
};

typedef int v8i32 __attribute__((ext_vector_type(8)));
typedef int v4i32_ __attribute__((ext_vector_type(4)));
__device__ __forceinline__ v8i32 cat8(bf16x8 a, bf16x8 b) { const u32x4 x = __builtin_bit_cast(u32x4, a), y = __builtin_bit_cast(u32x4, b); return (v8i32){(int)x.x, (int)x.y, (int)x.z, (int)x.w, (int)y.x, (int)y.y, (int)y.z, (int)y.w}; }
template <bool FP8, class Epi, class Sched>
__device__ __forceinline__ void gemm_phase(LAS unsigned char* lds, const Sched& S, const Epi& E, int wave_id) {
    const int wid = wave_id; int lane = (int)__builtin_amdgcn_mbcnt_hi(~0u, __builtin_amdgcn_mbcnt_lo(~0u, 0u)); asm volatile("" : "+v"(lane));
    const int tid = wid * 64 + lane, wr = wid >> 2, wc = wid & 3, fr = lane & 15, fq = lane >> 4;
    const int kb = S.kb; int nt = kb / 128; asm volatile("" : "+s"(nt));
    unsigned voffB[2];
#pragma unroll
    for (int i = 0; i < 2; ++i) { int R, C; stage_rc(tid * 16 + i * 8192, R, C); const int Rb = (R & ~31) + perm32(R & 31);
        voffB[i] = (unsigned)(Rb * kb) + (unsigned)C * 2u; }
#define PG8_AOFF(u, h, i) ({ int _tz = tid; asm volatile("" : "+v"(_tz)); int _R, _C; stage_rc(_tz * 16 + (i) * 8192, _R, _C); S.a_off((u), (h) * HALF + _R) + (unsigned)_C * 2u; })
    const size_t kstep = (size_t)(BK * 2);
    const size_t hstepB = (size_t)HALF * kb;
    const unsigned ldsw = (unsigned)wid * 1024u;
    const int aoff = lds_byte(wr * 64 + fr, fq * 8), boff = lds_byte(wc * 32 + fr, fq * 8);
#define PG8_SA(b, h) (((b) * 2 + (h)) * HTB)
#define PG8_SB(b, h) ((4 + (b) * 2 + (h)) * HTB)
#define PG8_STAGE(bufoff, gbase, v0, v1) do { \
        __builtin_amdgcn_global_load_lds((const unsigned*)((const char*)(gbase) + (v0)), (LAS unsigned*)(lds + (bufoff) + ldsw), 16, 0, 0); \
        __builtin_amdgcn_global_load_lds((const unsigned*)((const char*)(gbase) + (v1)), (LAS unsigned*)(lds + (bufoff) + ldsw + 8192), 16, 0, 0); } while (0)
#define PG8_VOFFB(i) ({ int _tz = tid; asm volatile("" : "+v"(_tz)); int _R, _C; stage_rc(_tz * 16 + (i) * 8192, _R, _C); (unsigned)(((_R & ~31) + perm32(_R & 31)) * kb) + (unsigned)_C * 2u; })
#define PG8_STAGE_B(bufoff, gbase) do { if constexpr (FP8) { int _tz = tid; asm volatile("" : "+v"(_tz)); const u32x2 _vv = *(const LAS u32x2*)(lds + STAGE_BYTES + 8192 + _tz * 8); PG8_STAGE(bufoff, gbase, _vv.x, _vv.y); } else PG8_STAGE(bufoff, gbase, voffB[0], voffB[1]); } while (0)
#define PG8_LD8(off) __builtin_shufflevector(*(const LAS v4i32_*)(lds + (off)), *(const LAS v4i32_*)(lds + (off) + 1024), 0, 1, 2, 3, 4, 5, 6, 7)
#define PG8_LDA(dst, b, h) do { _Pragma("unroll") for (int m = 0; m < 4; ++m) { if constexpr (FP8) dst##8[m] = PG8_LD8(PG8_SA(b, h) + aoff + m * 2048); else { _Pragma("unroll") for (int k = 0; k < 2; ++k) dst[m][k] = *(const LAS bf16x8*)(lds + PG8_SA(b, h) + aoff + m * 2048 + k * 1024); } } } while (0)
#define PG8_LDB(dst, b, h) do { _Pragma("unroll") for (int n = 0; n < 2; ++n) { if constexpr (FP8) dst##8[n] = PG8_LD8(PG8_SB(b, h) + boff + n * 2048); else { _Pragma("unroll") for (int k = 0; k < 2; ++k) dst[n][k] = *(const LAS bf16x8*)(lds + PG8_SB(b, h) + boff + n * 2048 + k * 1024); } } } while (0)
#define PG8_MMA(ai, bj, At, Bt) do { __builtin_amdgcn_s_setprio(1); _Pragma("unroll") for (int m = 0; m < 4; ++m) _Pragma("unroll") for (int n = 0; n < 2; ++n) { \
        if constexpr (FP8) asm volatile("v_mfma_f32_16x16x128_f8f6f4 %0, %1, %2, %0" : "+v"(acc[ai][bj][m][n]) : "v"(Bt##8[n]), "v"(At##8[m])); \
        else { _Pragma("unroll") for (int k = 0; k < 2; ++k) acc[ai][bj][m][n] = __builtin_amdgcn_mfma_f32_16x16x32_bf16(Bt[n][k], At[m][k], acc[ai][bj][m][n], 0, 0, 0); } } \
        __builtin_amdgcn_s_setprio(0); } while (0)
#define PG8_WAIT_V(n) asm volatile("s_waitcnt vmcnt(" #n ")" ::: "memory")
#define PG8_WAIT_L(n) asm volatile("s_waitcnt lgkmcnt(" #n ")" ::: "memory")
#define PG8_BAR __builtin_amdgcn_s_barrier()
#define PG8_SCHED __builtin_amdgcn_sched_barrier(0)
    if constexpr (FP8) { u32x2 _vb; _vb.x = PG8_VOFFB(0); _vb.y = PG8_VOFFB(1); *(LAS u32x2*)(lds + STAGE_BYTES + 8192 + tid * 8) = _vb; }
    Unit cur, nxt; int ui = 0;
    if (!S.next(0, cur)) return;
    f32x4 acc[2][2][4][2];
#pragma unroll
    for (int a = 0; a < 2; ++a)
#pragma unroll
        for (int b = 0; b < 2; ++b)
#pragma unroll
            for (int m = 0; m < 4; ++m)
#pragma unroll
                for (int n = 0; n < 2; ++n) acc[a][b][m][n] = (f32x4){0.f, 0.f, 0.f, 0.f};
    bf16x8 At[4][2], B0[2][2], B1[2][2]; v8i32 At8[4], B08[2], B18[2];
    const char* const gA = S.a_base();
    const char* cB = S.b_ptr(cur);
    unsigned oc00, oc01, oc10, oc11;
    oc00 = PG8_AOFF(cur, 0, 0); oc01 = PG8_AOFF(cur, 0, 1); oc10 = PG8_AOFF(cur, 1, 0); oc11 = PG8_AOFF(cur, 1, 1);
    PG8_STAGE_B(PG8_SB(0, 0), cB); PG8_STAGE_B(PG8_SB(0, 1), cB + hstepB); PG8_STAGE(PG8_SA(0, 0), gA, oc00, oc01); PG8_STAGE(PG8_SA(0, 1), gA, oc10, oc11);
    if (wr == 1) PG8_BAR;
    PG8_WAIT_V(2); PG8_BAR;
    PG8_STAGE_B(PG8_SB(1, 0), cB + kstep); PG8_STAGE(PG8_SA(1, 0), gA + kstep, oc00, oc01); PG8_STAGE_B(PG8_SB(1, 1), cB + hstepB + kstep);
    PG8_WAIT_V(6); PG8_BAR;
    for (;;) {
        const bool has_next = S.next(ui + 1, nxt);
        const char* nB = cB;
        {
            u32x4 on = {oc00, oc01, oc10, oc11};
            if (has_next) {
                int _tz = tid; asm volatile("" : "+v"(_tz)); int _R0, _C0, _R1, _C1; stage_rc(_tz * 16, _R0, _C0); stage_rc(_tz * 16 + 8192, _R1, _C1);
                S.a_off4(nxt, _R0, _R1, HALF, on); on.x += (unsigned)_C0 * 2u; on.y += (unsigned)_C1 * 2u; on.z += (unsigned)_C0 * 2u; on.w += (unsigned)_C1 * 2u; nB = S.b_ptr(nxt); }
            *(LAS u32x4*)(lds + STAGE_BYTES + tid * 16) = on;
        }
        for (int t = 0; t < nt; t += 2) {
            const bool last = (t == nt - 2);
            const char* a1 = gA + (size_t)(t + 1) * kstep;
            const char* a2 = last ? gA : gA + (size_t)(t + 2) * kstep; const char* b2 = last ? nB : cB + (size_t)(t + 2) * kstep;
            const char* a3 = a2 + kstep; const char* b3 = b2 + kstep;
            unsigned s00 = oc00, s01 = oc01, s10 = oc10, s11 = oc11;
            if (last) { const u32x4 on = *(const LAS u32x4*)(lds + STAGE_BYTES + tid * 16); s00 = on.x; s01 = on.y; s10 = on.z; s11 = on.w; }
            PG8_LDB(B0, 0, 0); PG8_LDB(B1, 0, 1); PG8_SCHED; PG8_LDA(At, 0, 0); PG8_STAGE(PG8_SA(1, 1), a1, oc10, oc11);
            PG8_WAIT_V(8); PG8_WAIT_L(0); PG8_BAR; PG8_MMA(0, 0, At, B0); PG8_MMA(0, 1, At, B1); PG8_BAR; PG8_SCHED;
            PG8_LDA(At, 0, 1); PG8_STAGE_B(PG8_SB(0, 0), b2); PG8_STAGE_B(PG8_SB(0, 1), b2 + hstepB); PG8_STAGE(PG8_SA(0, 0), a2, s00, s01);
            PG8_WAIT_V(8); PG8_WAIT_L(0); PG8_BAR; PG8_MMA(1, 0, At, B0); PG8_MMA(1, 1, At, B1); PG8_BAR; PG8_SCHED;
            PG8_LDB(B0, 1, 0); PG8_LDB(B1, 1, 1); PG8_SCHED; PG8_LDA(At, 1, 0); PG8_STAGE(PG8_SA(0, 1), a2, s10, s11);
            PG8_WAIT_V(8); PG8_WAIT_L(0); PG8_BAR; PG8_MMA(0, 0, At, B0); PG8_MMA(0, 1, At, B1); PG8_BAR; PG8_SCHED;
            PG8_LDA(At, 1, 1); PG8_STAGE_B(PG8_SB(1, 0), b3); PG8_STAGE_B(PG8_SB(1, 1), b3 + hstepB); PG8_STAGE(PG8_SA(1, 0), a3, s00, s01);
            PG8_WAIT_V(8); PG8_WAIT_L(0); PG8_BAR; PG8_MMA(1, 0, At, B0); PG8_MMA(1, 1, At, B1); PG8_BAR; PG8_SCHED;
        }
        if (wr == 0) PG8_BAR;
        E(acc, cur, wr, wc, fr, fq);
        if (!has_next) break;
#pragma unroll
        for (int a = 0; a < 2; ++a)
#pragma unroll
            for (int b = 0; b < 2; ++b)
#pragma unroll
                for (int m = 0; m < 4; ++m)
#pragma unroll
                    for (int n = 0; n < 2; ++n) acc[a][b][m][n] = (f32x4){0.f, 0.f, 0.f, 0.f};
        { const u32x4 on = *(const LAS u32x4*)(lds + STAGE_BYTES + tid * 16); oc00 = on.x; oc01 = on.y; oc10 = on.z; oc11 = on.w; }
        cur = nxt; cB = nB; ++ui;
        if (wr == 1) PG8_BAR;
    }
    PG8_WAIT_V(0);
    PG8_BAR;
#undef PG8_SA
#undef PG8_SB
#undef PG8_STAGE
#undef PG8_STAGE_B
#undef PG8_AOFF
#undef PG8_VOFFB
#undef PG8_LD8
#undef PG8_LDA
#undef PG8_LDB
#undef PG8_MMA
#undef PG8_WAIT_V
#undef PG8_WAIT_L
#undef PG8_BAR
#undef PG8_SCHED
}

struct EpiStore {
    bf16_t* O; int ldc; float scale;
    __device__ __forceinline__ void operator()(const f32x4 (&acc)[2][2][4][2], const Unit& u, int wr, int wc, int fr, int fq) const {
        const int row0 = u.pm * BM + wr * 64 + fr, col0 = u.pn * BM + wc * 32 + 8 * fq;
#pragma unroll
        for (int ai = 0; ai < 2; ++ai)
#pragma unroll
            for (int m = 0; m < 4; ++m) { bf16_t* rowp = O + (size_t)(row0 + ai * HALF + m * 16) * ldc + col0;
#pragma unroll
                for (int bj = 0; bj < 2; ++bj) { const f32x4 v0 = acc[ai][bj][m][0] * scale, v1 = acc[ai][bj][m][1] * scale;
                    u32x4 w; w.x = cvt_pk_bf16(v0[0], v0[1]); w.y = cvt_pk_bf16(v0[2], v0[3]); w.z = cvt_pk_bf16(v1[0], v1[1]); w.w = cvt_pk_bf16(v1[2], v1[3]);
                    *(u32x4*)(rowp + bj * HALF) = w; } }
    }
};
struct EpiGlu {
    const bf16_t* Z; const float* b; bf16_t* MIX;
    __device__ __forceinline__ void operator()(const f32x4 (&acc)[2][2][4][2], const Unit& u, int wr, int wc, int fr, int fq) const {
        const int row0 = u.pm * BM + wr * 64 + fr, col0 = u.pn * BM + wc * 32 + 8 * fq;
#pragma unroll
        for (int bj = 0; bj < 2; ++bj) {
            const f32x4 b0 = *(const f32x4*)(b + col0 + bj * HALF), b1 = *(const f32x4*)(b + col0 + bj * HALF + 4);
#pragma unroll
            for (int ai = 0; ai < 2; ++ai)
#pragma unroll
                for (int m = 0; m < 4; ++m) { const size_t row = (size_t)(row0 + ai * HALF + m * 16);
                    const u32x4 zz = *(const u32x4*)(Z + row * 1024 + col0 + bj * HALF);
                    const f32x4 v0 = acc[ai][bj][m][0] + b0, v1 = acc[ai][bj][m][1] + b1;
                    u32x4 w;
                    w.x = cvt_pk_bf16(bflo(zz.x) * sigmoidf_(v0[0]), bfhi(zz.x) * sigmoidf_(v0[1]));
                    w.y = cvt_pk_bf16(bflo(zz.y) * sigmoidf_(v0[2]), bfhi(zz.y) * sigmoidf_(v0[3]));
                    w.z = cvt_pk_bf16(bflo(zz.z) * sigmoidf_(v1[0]), bfhi(zz.z) * sigmoidf_(v1[1]));
                    w.w = cvt_pk_bf16(bflo(zz.w) * sigmoidf_(v1[2]), bfhi(zz.w) * sigmoidf_(v1[3]));
                    *(u32x4*)(MIX + row * DM + 1024 + col0 + bj * HALF) = w; }
        }
    }
};
struct EpiE1 {
    unsigned char* H; const LAS int* cn; const LAS int* rb;
    __device__ __forceinline__ void operator()(const f32x4 (&acc)[2][2][4][2], const Unit& u, int wr, int wc, int fr, int fq) const {
        const int n = cn[u.e]; const int colh = u.pn * 128 + wc * 32 + 8 * fq;
#pragma unroll
        for (int ai = 0; ai < 2; ++ai)
#pragma unroll
            for (int m = 0; m < 4; ++m) { const int pos = u.pm * BM + ai * HALF + wr * 64 + m * 16 + fr;
                if (pos < n) { const int a = rb[u.e] + pos;
                    float sc = WSCALE_INV; asm volatile("" : "+v"(sc));
                    const f32x4 g0 = acc[ai][0][m][0] * sc, g1 = acc[ai][0][m][1] * sc, u0 = acc[ai][1][m][0] * sc, u1 = acc[ai][1][m][1] * sc;
                    u32x2 w;
                    w.x = (unsigned)__builtin_amdgcn_cvt_pk_fp8_f32(siluf_(g0[0]) * u0[0], siluf_(g0[1]) * u0[1], 0, false);
                    w.x = (unsigned)__builtin_amdgcn_cvt_pk_fp8_f32(siluf_(g0[2]) * u0[2], siluf_(g0[3]) * u0[3], (int)w.x, true);
                    w.y = (unsigned)__builtin_amdgcn_cvt_pk_fp8_f32(siluf_(g1[0]) * u1[0], siluf_(g1[1]) * u1[1], 0, false);
                    w.y = (unsigned)__builtin_amdgcn_cvt_pk_fp8_f32(siluf_(g1[2]) * u1[2], siluf_(g1[3]) * u1[3], (int)w.y, true);
                    *(u32x2*)(H + (size_t)a * EHID + colh) = w; }
                __builtin_amdgcn_sched_barrier(0); }
    }
};
struct EpiE2 {
    unsigned char* Y; const float* wgt; const LAS int* cn; const LAS int* rb;
    __device__ __forceinline__ void operator()(const f32x4 (&acc)[2][2][4][2], const Unit& u, int wr, int wc, int fr, int fq) const {
        const int n = cn[u.e]; const int col0 = u.pn * BM + wc * 32 + 8 * fq;
#pragma unroll
        for (int ai = 0; ai < 2; ++ai)
#pragma unroll
            for (int m = 0; m < 4; ++m) { const int pos = u.pm * BM + ai * HALF + wr * 64 + m * 16 + fr;
                if (pos < n) { const int a = rb[u.e] + pos; float ws = WSCALE_INV * 0.25f; asm volatile("" : "+v"(ws));
                    unsigned char* rowp = Y + (size_t)a * DM + col0;
#pragma unroll
                    for (int bj = 0; bj < 2; ++bj) { const f32x4 v0 = acc[ai][bj][m][0] * ws, v1 = acc[ai][bj][m][1] * ws;
                        u32x2 w;
                        w.x = (unsigned)__builtin_amdgcn_cvt_pk_fp8_f32(v0[0], v0[1], 0, false); w.x = (unsigned)__builtin_amdgcn_cvt_pk_fp8_f32(v0[2], v0[3], (int)w.x, true);
                        w.y = (unsigned)__builtin_amdgcn_cvt_pk_fp8_f32(v1[0], v1[1], 0, false); w.y = (unsigned)__builtin_amdgcn_cvt_pk_fp8_f32(v1[2], v1[3], (int)w.y, true);
                        *(u32x2*)(rowp + bj * HALF) = w; } }
                __builtin_amdgcn_sched_barrier(0); }
    }
};
}
struct KArgs {
    const float* in[34];
    float* out;
    unsigned char* ws;
    int ph_lo, ph_hi;
};
struct Params {
    float* out;
    unsigned char* ws;
    LAS unsigned long long* ptab;
    int ph_lo, ph_hi;
    __device__ __forceinline__ const float* inp(int k) const {
        const unsigned long long v = ptab[k];
        const unsigned lo = __builtin_amdgcn_readfirstlane((unsigned)v), hi = __builtin_amdgcn_readfirstlane((unsigned)(v >> 32));
        return (const float*)(((unsigned long long)hi << 32) | lo);
    }
};
struct Ctx {
    LAS unsigned char* lds;
    int tid, lane, wave, G, bid;
    int gw, ngw;
};

__device__ __forceinline__ void tr_item(const float* W, int N, bf16_t* WT, int ldt, int k0, int n0, int orow0, LAS float* scr, int lane) {
#pragma unroll 8
    for (int i = 0; i < 32; ++i) { const int kk = 2 * i + (lane >> 5); scr[kk * 33 + (lane & 31)] = W[(size_t)(k0 + kk) * N + n0 + (lane & 31)]; }
    LDS_WAIT(); asm volatile("" ::: "memory");
    const int c = lane & 7;
#pragma unroll
    for (int j = 0; j < 4; ++j) { const int n = (lane >> 3) + 8 * j; const LAS float* s = scr + (8 * c) * 33 + n;
        u32x4 o; o.x = cvt_pk_bf16(s[0 * 33], s[1 * 33]); o.y = cvt_pk_bf16(s[2 * 33], s[3 * 33]); o.z = cvt_pk_bf16(s[4 * 33], s[5 * 33]); o.w = cvt_pk_bf16(s[6 * 33], s[7 * 33]);
        *(u32x4*)(WT + (size_t)(orow0 + n) * ldt + k0 + 8 * c) = o; }
    LDS_WAIT(); asm volatile("" ::: "memory");
}
__device__ __forceinline__ void tr_item64(const float* W, int N, bf16_t* WT, int ldt, int k0, int n0, int orow0, LAS float* scr, int lane) {
    f32x4 v[16];
    const float* src = W + (size_t)(k0 + (lane >> 4)) * N + n0 + 4 * (lane & 15);
#pragma unroll
    for (int i = 0; i < 16; ++i) v[i] = __builtin_nontemporal_load((const f32x4*)(src + (size_t)(4 * i) * N));
#pragma unroll
    for (int i = 0; i < 16; ++i) { LAS float* d = scr + (4 * i + (lane >> 4)) * 65 + 4 * (lane & 15); d[0] = v[i][0]; d[1] = v[i][1]; d[2] = v[i][2]; d[3] = v[i][3]; }
    LDS_WAIT(); asm volatile("" ::: "memory");
    const int c = lane & 7;
#pragma unroll
    for (int j = 0; j < 8; ++j) { const int n = (lane >> 3) + 8 * j; const LAS float* s = scr + (8 * c) * 65 + n;
        u32x4 o; o.x = cvt_pk_bf16(s[0 * 65], s[1 * 65]); o.y = cvt_pk_bf16(s[2 * 65], s[3 * 65]); o.z = cvt_pk_bf16(s[4 * 65], s[5 * 65]); o.w = cvt_pk_bf16(s[6 * 65], s[7 * 65]);
        *(u32x4*)(WT + (size_t)(orow0 + n) * ldt + k0 + 8 * c) = o; }
    LDS_WAIT(); asm volatile("" ::: "memory");
}
__device__ __forceinline__ void tr_item64_fp8(const float* W, int N, unsigned char* WT, int ldt, int k0, int n0, int orow0, LAS float* scr, int lane, float wscale = pg8::WSCALE) {
    f32x4 v[16];
    const float* src = W + (size_t)(k0 + (lane >> 4)) * N + n0 + 4 * (lane & 15);
#pragma unroll
    for (int i = 0; i < 16; ++i) v[i] = __builtin_nontemporal_load((const f32x4*)(src + (size_t)(4 * i) * N));
#pragma unroll
    for (int i = 0; i < 16; ++i) { LAS float* d = scr + (4 * i + (lane >> 4)) * 65 + 4 * (lane & 15); d[0] = v[i][0]; d[1] = v[i][1]; d[2] = v[i][2]; d[3] = v[i][3]; }
    LDS_WAIT(); asm volatile("" ::: "memory");
    const int c = lane & 3;
#pragma unroll
    for (int j = 0; j < 4; ++j) { const int n = (lane >> 2) + 16 * j; const LAS float* s = scr + (16 * c) * 65 + n;
        u32x4 o;
        o.x = (unsigned)__builtin_amdgcn_cvt_pk_fp8_f32(s[0 * 65] * wscale, s[1 * 65] * wscale, 0, false);   o.x = (unsigned)__builtin_amdgcn_cvt_pk_fp8_f32(s[2 * 65] * wscale, s[3 * 65] * wscale, (int)o.x, true);
        o.y = (unsigned)__builtin_amdgcn_cvt_pk_fp8_f32(s[4 * 65] * wscale, s[5 * 65] * wscale, 0, false);   o.y = (unsigned)__builtin_amdgcn_cvt_pk_fp8_f32(s[6 * 65] * wscale, s[7 * 65] * wscale, (int)o.y, true);
        o.z = (unsigned)__builtin_amdgcn_cvt_pk_fp8_f32(s[8 * 65] * wscale, s[9 * 65] * wscale, 0, false);   o.z = (unsigned)__builtin_amdgcn_cvt_pk_fp8_f32(s[10 * 65] * wscale, s[11 * 65] * wscale, (int)o.z, true);
        o.w = (unsigned)__builtin_amdgcn_cvt_pk_fp8_f32(s[12 * 65] * wscale, s[13 * 65] * wscale, 0, false); o.w = (unsigned)__builtin_amdgcn_cvt_pk_fp8_f32(s[14 * 65] * wscale, s[15 * 65] * wscale, (int)o.w, true);
        *(u32x4*)(WT + (size_t)(orow0 + n) * ldt + k0 + 16 * c) = o; }
    LDS_WAIT(); asm volatile("" ::: "memory");
}
__device__ __forceinline__ void tr_dense(const float* W, int K, int N, bf16_t* WT, int item, LAS float* scr, int lane) {
    const int nblk = N / 32, kb = item / nblk, nb = item % nblk;
    tr_item(W, N, WT, K, 64 * kb, 32 * nb, 32 * nb, scr, lane);
}

__device__ __forceinline__ void s5_tables(const Params& p, Ctx& C, int dir, int g) {
    LAS f32x2* PW = (LAS f32x2*)C.lds;
    LAS f32x2* BB = PW + 65 * 64;
    LAS f32x2* CX = BB + 64 * 16;
    const float* a_re = p.inp(11); const float* a_im = p.inp(12); const float* log_dt = p.inp(13);
    const float* b_re = p.inp(14); const float* b_im = p.inp(15); const float* c_re = p.inp(16); const float* c_im = p.inp(17);
    const int tid = C.tid;
    if (tid < 64) {
        const int pp = tid;
        const float dt = __expf(log_dt[dir * 64 + g]);
        const float are = a_re[(dir * 64 + g) * 64 + pp], aim = a_im[(dir * 64 + g) * 64 + pp];
        const float zr = are * dt, zi = aim * dt;
        const float mag = __expf(zr);
        double rev = (double)zi * 0.15915494309189535; rev -= floor(rev);
        const float cs = __builtin_amdgcn_cosf((float)rev), sn = __builtin_amdgcn_sinf((float)rev);
        const float abr = mag * cs, abi = mag * sn;
        const float den = are * are + aim * aim, nr = abr - 1.0f, ni = abi;
        const float fre = (nr * are + ni * aim) / den, fim = (ni * are - nr * aim) / den;
        float pr = 1.0f, pi = 0.0f;
#pragma unroll 1
        for (int n = 0; n <= 64; ++n) { PW[n * 64 + pp] = (f32x2){pr, pi}; const float t = pr * abr - pi * abi; pi = pr * abi + pi * abr; pr = t; }
        for (int j = 0; j < 16; ++j) { const float br = b_re[(g * 64 + pp) * 16 + j], bi = b_im[(g * 64 + pp) * 16 + j];
            BB[pp * 16 + j] = (f32x2){fre * br - fim * bi, fre * bi + fim * br}; }
    }
    for (int q = tid; q < 1024; q += NTHR) { const int i = q >> 6, pp = q & 63; CX[i * 64 + pp] = (f32x2){c_re[(g * 16 + i) * 64 + pp], c_im[(g * 16 + i) * 64 + pp]}; }
    __syncthreads();
    bf16_t* KN = (bf16_t*)(p.ws + WS_KN) + (size_t)(dir * 64 + g) * 16 * 1024;
    float* APOW = (float*)(p.ws + WS_APOW) + (size_t)(dir * 64 + g) * 64 * 128;
    float* AL = (float*)(p.ws + WS_AL) + (size_t)(dir * 64 + g) * 128;
#pragma unroll 1
    for (int q = 0; q < 32; ++q) { const int idx = tid + NTHR * q; const int n = idx >> 8, i = (idx >> 4) & 15, j = idx & 15;
        float s = 0.f;
#pragma unroll 4
        for (int pp = 0; pp < 64; ++pp) { const f32x2 c = CX[i * 64 + pp], w = PW[n * 64 + pp], b = BB[pp * 16 + j];
            const float gr = c.x * b.x - c.y * b.y, gi = c.x * b.y + c.y * b.x;
            s += gr * w.x - gi * w.y; }
        KN[(size_t)i * 1024 + n * 16 + j] = f2bf(s); }
    for (int q = tid; q < 4096; q += NTHR) { const int t = q >> 6, pp = q & 63; const f32x2 w = PW[(t + 1) * 64 + pp]; *(f32x2*)(APOW + (size_t)t * 128 + 2 * pp) = w; }
    if (tid < 64) { const f32x2 w = PW[64 * 64 + tid]; *(f32x2*)(AL + 2 * tid) = w; }
    { bf16_t* BBT = (bf16_t*)(p.ws + WS_BBT) + (size_t)(dir * 64 + g) * 128 * 16;
      for (int q = tid; q < 2048; q += NTHR) { const int pq = q >> 4, j = q & 15; const f32x2 b = BB[(pq & 63) * 16 + j]; BBT[q] = f2bf(pq < 64 ? b.x : b.y); } }
    if (dir == 0) { bf16_t* CCt = (bf16_t*)(p.ws + WS_CC) + (size_t)g * 16 * 128;
        for (int q = tid; q < 2048; q += NTHR) { const int i = q >> 7, pq = q & 127; const f32x2 c = CX[i * 64 + (pq & 63)]; CCt[i * 128 + pq] = f2bf(pq < 64 ? c.x : -c.y); } }
    __syncthreads();
}

__device__ __forceinline__ void phase_p0(const Params& p, Ctx& C) {
    for (int task = C.bid; task < 128; task += C.G) s5_tables(p, C, task >> 6, task & 63);
    {
        const int gt = C.bid * NTHR + C.tid, ngt = C.G * NTHR;
        float* R128 = (float*)(p.ws + WS_ROPE128); float* R64 = (float*)(p.ws + WS_ROPE64);
        for (int q = gt; q < 256 * 64 + 256 * 32; q += ngt) {
            int pos, i, half; float* dst;
            if (q < 256 * 64) { pos = q >> 6; i = q & 63; half = 64; dst = R128 + (size_t)q * 2; }
            else { const int r = q - 256 * 64; pos = r >> 5; i = r & 31; half = 32; dst = R64 + (size_t)r * 2; }
            const float freq = exp2f(-(float)i / (float)half * 13.287712379549449f);
            const float ang = (float)pos * freq;
            double rev = (double)ang * 0.15915494309189535; rev -= floor(rev);
            dst[0] = __builtin_amdgcn_cosf((float)rev); dst[1] = __builtin_amdgcn_sinf((float)rev);
        }
        bf16_t* RWT = (bf16_t*)(p.ws + WS_RWT); const float* rw = p.inp(26);
        for (int q = gt; q < 2 * 64 * DM; q += ngt) { const int L = q / (64 * DM), r = q % (64 * DM), e = r / DM, k = r % DM;
            const float w = rw[((size_t)L * DM + k) * 64 + e]; const bf16_t hi = f2bf(w); const bf16_t lo = f2bf(w - bf2f(hi));
            RWT[((size_t)(L * 2 + 0) * 64 + e) * DM + k] = hi; RWT[((size_t)(L * 2 + 1) * 64 + e) * DM + k] = lo; }
    }
    {
        const float* cvec = p.inp(1); const float* cctx = p.inp(3); const float* mw = p.inp(4);
        float* MODP = (float*)(p.ws + WS_MODP);
        for (int task = C.gw; task < 2 * 32 * 48; task += C.ngw) {
            const int L = task / (32 * 48), r = task % (32 * 48), kb = r / 48, cb = r % 48;
            const float sc = siluf_(cvec[64 * kb + C.lane]), sx = siluf_(cctx[64 * kb + C.lane]);
            f32x4 a0 = {0.f, 0.f, 0.f, 0.f}, a1 = {0.f, 0.f, 0.f, 0.f};
            const float* wp = mw + ((size_t)L * DM + 64 * kb) * 12288 + 256 * cb + 4 * C.lane;
#pragma unroll 8
            for (int kk = 0; kk < 64; ++kk) { const f32x4 w = *(const f32x4*)(wp + (size_t)kk * 12288);
                const float s0 = __shfl(sc, kk), s1 = __shfl(sx, kk);
                a0 += w * s0; a1 += w * s1; }
            *(f32x4*)(MODP + ((size_t)((L * 32 + kb) * 2 + 0)) * 12288 + 256 * cb + 4 * C.lane) = a0;
            *(f32x4*)(MODP + ((size_t)((L * 32 + kb) * 2 + 1)) * 12288 + 256 * cb + 4 * C.lane) = a1;
        }
    }
    {
        LAS float* scr = (LAS float*)(C.lds + C.wave * 17408);
        constexpr int J0 = (DM / 64) * (EV_IN / 64), J3 = (DM / 64) * (OD_IN / 64);
        for (int it = C.gw; it < J0 + J3; it += C.ngw) {
            const bool l1 = it >= J0; const int r = l1 ? it - J0 : it; const int N = l1 ? OD_IN : EV_IN; const int nblk = N / 64, kb = r / nblk, nb = r % nblk;
            tr_item64_fp8(p.inp(l1 ? 21 : 8), N, (unsigned char*)(p.ws + (l1 ? WS_WIN1 : WS_WIN0)), DM, 64 * kb, 64 * nb, 64 * nb, scr, C.lane, 32.0f);
        }
        LAS float* scr2 = (LAS float*)(C.lds + C.wave * 17408);
        constexpr int I1 = (DM / 64) * (DM / 32), I2 = (1024 / 64) * (1024 / 32), I4 = I1;
        for (int it = C.gw; it < I1 + I2 + I4; it += C.ngw) {
            int r = it;
            if (r < I1) { tr_dense(p.inp(9), DM, DM, (bf16_t*)(p.ws + WS_WOUT0), r, scr2, C.lane); continue; } r -= I1;
            if (r < I2) { tr_dense(p.inp(19), 1024, 1024, (bf16_t*)(p.ws + WS_WGLU), r, scr2, C.lane); continue; } r -= I2;
            tr_dense(p.inp(22), DM, DM, (bf16_t*)(p.ws + WS_WOUT1), r, scr2, C.lane);
        }
    }
}
__device__ __forceinline__ void phase_p1(const Params& p, Ctx& C) {
    const float* MODP = (const float*)(p.ws + WS_MODP); float* MODF = (float*)(p.ws + WS_MODF); const float* mb = p.inp(5);
    for (int q = C.bid * NTHR + C.tid; q < 2 * 2 * 12288; q += C.G * NTHR) { const int L = q / (2 * 12288), v = (q / 12288) & 1, col = q % 12288;
        float s = mb[L * 12288 + col];
        float pv[32];
#pragma unroll
        for (int kb = 0; kb < 32; ++kb) pv[kb] = MODP[((size_t)((L * 32 + kb) * 2 + v)) * 12288 + col];
#pragma unroll
        for (int kb = 0; kb < 32; ++kb) s += pv[kb];
        MODF[q] = s; }
}
__device__ __forceinline__ const float* modv(const Params& p, int L, int v, int k) { return (const float*)(p.ws + WS_MODF) + (size_t)(L * 2 + v) * 12288 + k * DM; }

__device__ __forceinline__ void stage_vec(LAS float* dst, const float* src, int tid) { *(LAS f32x4*)(dst + 4 * tid) = *(const f32x4*)(src + 4 * tid); }
__device__ __forceinline__ void conv_item(const Params& p, Ctx& C, int L, int it) {
    LAS float* scr = (LAS float*)(C.lds + C.wave * 17408);
    unsigned char* GU = (unsigned char*)(p.ws + WS_GU) + (size_t)L * NEX1 * 1024 * DM; unsigned char* DT = (unsigned char*)(p.ws + WS_DT) + (size_t)L * NEX1 * DM * EHID;
    const int e = it / 768, r = it % 768, which = r >> 8, q = r & 255;
    if (which < 2) {
        const float* W = (e < 64) ? p.inp(28 + which) + ((size_t)(L * 64 + e)) * DM * EHID : p.inp(31 + which) + (size_t)L * DM * EHID;
        const int kb = q >> 3, nb = q & 7, n0 = 64 * nb;
        tr_item64_fp8(W, EHID, GU + (size_t)e * 1024 * DM, DM, 64 * kb, n0, 256 * (n0 >> 7) + (n0 & 127) + (which ? 128 : 0), scr, C.lane);
    } else {
        const float* W = (e < 64) ? p.inp(30) + ((size_t)(L * 64 + e)) * EHID * DM : p.inp(33) + (size_t)L * EHID * DM;
        const int kb = q >> 5, nb = q & 31;
        tr_item64_fp8(W, DM, DT + (size_t)e * DM * EHID, EHID, 64 * kb, 64 * nb, 64 * nb, scr, C.lane);
    }
}
__device__ __forceinline__ void conv_queue(const Params& p, Ctx& C, int quota) {
    unsigned* head = (unsigned*)(p.ws + WS_CTL) + CW_QUEUE + 128;
    const int batch = quota < 8 ? quota : 8;
    for (int done = 0; done < quota; done += batch) {
        int it0 = 0; if (C.lane == 0) it0 = (int)atomicAdd(head, (unsigned)batch);
        it0 = __builtin_amdgcn_readfirstlane(it0);
        if (it0 >= NEX1 * 768) break;
        for (int k = 0; k < batch && it0 + k < NEX1 * 768; ++k) conv_item(p, C, 1, it0 + k);
    }
}
__device__ __forceinline__ void phase_modulate(const Params& p, Ctx& C, int L) {
    unsigned char* XA8 = (unsigned char*)(p.ws + WS_XA);
    const float* X2 = (const float*)(p.ws + WS_HX2);
    LAS float* MV = (LAS float*)C.lds;
    for (int v = 0; v < 2; ++v) { stage_vec(MV + (v * 2 + 0) * DM, modv(p, L, v, 0), C.tid); stage_vec(MV + (v * 2 + 1) * DM, modv(p, L, v, 1), C.tid); }
    __syncthreads();
    for (int r = C.gw; r < TT; r += C.ngw) {
        const int v = r < CTXL ? 1 : 0;
        const float* src = (L == 0) ? (r < CTXL ? p.inp(2) + (size_t)r * DM : p.inp(0) + (size_t)(r - CTXL) * DM) : X2 + (size_t)r * DM;
        const LAS float* sh = MV + (v * 2 + 0) * DM; const LAS float* sc = MV + (v * 2 + 1) * DM;
#pragma unroll
        for (int j = 0; j < 8; ++j) { const int c = 4 * (C.lane + 64 * j);
            const f32x4 x = *(const f32x4*)(src + c), a = *(const LAS f32x4*)(sc + c), b = *(const LAS f32x4*)(sh + c);
            const f32x4 y = x * (a + 1.0f) + b;
            unsigned w = (unsigned)__builtin_amdgcn_cvt_pk_fp8_f32(y[0], y[1], 0, false); w = (unsigned)__builtin_amdgcn_cvt_pk_fp8_f32(y[2], y[3], (int)w, true);
            *(unsigned*)(XA8 + (size_t)r * DM + c) = w; }
    }
    __syncthreads();
    if (L == 0) { for (int it = C.gw; it < NEX1 * 768; it += C.ngw) conv_item(p, C, 0, it); }
    else conv_queue(p, C, 1 << 30);
}

__device__ __forceinline__ void phase_rope0(const Params& p, Ctx& C) {
    bf16_t* QKV = (bf16_t*)(p.ws + WS_BIG + BG_QKV);
    const f32x2* R128 = (const f32x2*)(p.ws + WS_ROPE128);
    for (int r = C.gw; r < TT; r += C.ngw) {
        bf16_t* row = QKV + (size_t)r * EV_IN;
        if (r < CTXL) {
#pragma unroll
            for (int j = 0; j < 2; ++j) { u32x4* q = (u32x4*)(row + 8 * (C.lane + 64 * j)); u32x4 w = *q;
                w.x = cvt_pk_bf16(bflo(w.x) * 0.0625f, bfhi(w.x) * 0.0625f); w.y = cvt_pk_bf16(bflo(w.y) * 0.0625f, bfhi(w.y) * 0.0625f);
                w.z = cvt_pk_bf16(bflo(w.z) * 0.0625f, bfhi(w.z) * 0.0625f); w.w = cvt_pk_bf16(bflo(w.w) * 0.0625f, bfhi(w.w) * 0.0625f); *q = w; }
        } else {
            const int l = r - CTXL, rp = l >> 6, cp = l & 63;
            float xa[16], xc[16]; f32x2 csv[8];
#pragma unroll
            for (int m = 0; m < 8; ++m) { const int pi = C.lane + 64 * m, blk = (pi >> 6) & 1, i = pi & 63; csv[m] = R128[(blk ? cp : rp) * 64 + i]; }
#pragma unroll
            for (int qk = 0; qk < 2; ++qk)
#pragma unroll
                for (int m = 0; m < 8; ++m) { const int pi = C.lane + 64 * m, head = pi >> 7, blk = (pi >> 6) & 1, i = pi & 63;
                    const bf16_t* b = row + qk * 1024 + head * 256 + blk * 128 + i; xa[qk * 8 + m] = bf2f(b[0]); xc[qk * 8 + m] = bf2f(b[64]); }
#pragma unroll
            for (int qk = 0; qk < 2; ++qk)
#pragma unroll
                for (int m = 0; m < 8; ++m) { const int pi = C.lane + 64 * m, head = pi >> 7, blk = (pi >> 6) & 1, i = pi & 63;
                    bf16_t* b = row + qk * 1024 + head * 256 + blk * 128 + i;
                    const f32x2 cs = csv[m];
                    const float x1 = xa[qk * 8 + m], x2 = xc[qk * 8 + m]; const float sc = qk ? 1.0f : 0.0625f;
                    b[0] = f2bf((x1 * cs.x - x2 * cs.y) * sc); b[64] = f2bf((x1 * cs.y + x2 * cs.x) * sc); }
        }
    }
}

__device__ __forceinline__ void phase_normrope1(const Params& p, Ctx& C) {
    bf16_t* QKV = (bf16_t*)(p.ws + WS_BIG + BG_QKV);
    const f32x2* R64 = (const f32x2*)(p.ws + WS_ROPE64);
    const float* qg = p.inp(23);
    unsigned char* Q8 = (unsigned char*)(p.ws + WS_BIG + BG_Q8); unsigned char* K8 = (unsigned char*)(p.ws + WS_BIG + BG_K8); unsigned char* VT8 = (unsigned char*)(p.ws + WS_BIG + BG_VT8);
    unsigned char* Q8D = (unsigned char*)(p.ws + WS_BIG + BG_Q8D); unsigned char* K8D = (unsigned char*)(p.ws + WS_BIG + BG_K8D); unsigned char* VT8D = (unsigned char*)(p.ws + WS_BIG + BG_VT8D);
    const int lane = C.lane, i32 = lane & 31; const bool up = lane >= 32;
    const float g00 = qg[lane], g01 = qg[64 + lane], g10 = qg[128 + lane], g11 = qg[128 + 64 + lane];
    for (int r = C.gw; r < TT; r += C.ngw) {
        bf16_t* row = QKV + (size_t)r * OD_IN;
        const bool lat = r >= CTXL; const int l = r - CTXL, rp = lat ? (l >> 6) : 0, cp = lat ? (l & 63) : 0;
        const f32x2 cr = R64[rp * 32 + i32], cc = R64[cp * 32 + i32];
        float rv0[26], rv1[26];
#pragma unroll
        for (int h = 0; h < 26; ++h) {
            const int col = h < 8 ? 128 * h : (h < 10 ? 1024 + 128 * (h - 8) : (h < 18 ? 1536 + 128 * (h - 10) : 2560 + 128 * (h - 18)));
            rv0[h] = bf2f(row[col + lane]); rv1[h] = bf2f(row[col + 64 + lane]); }
#pragma unroll
        for (int h = 0; h < 26; ++h) {
            const int col = h < 8 ? 128 * h : (h < 10 ? 1024 + 128 * (h - 8) : (h < 18 ? 1536 + 128 * (h - 10) : 2560 + 128 * (h - 18)));
            bf16_t* b = row + col;
            float v0 = rv0[h], v1 = rv1[h];
            if (h < 10) { const float ss = wave_sum(v0 * v0 + v1 * v1); const float rs = rsqrtf(ss * (1.0f / 128.0f) + LN_EPS);
                v0 = bf2f(f2bf(v0 * rs)) * (h < 8 ? g00 : g10); v1 = bf2f(f2bf(v1 * rs)) * (h < 8 ? g01 : g11); }
            if (lat) { const float p0 = __shfl_xor(v0, 32), p1 = __shfl_xor(v1, 32);
                v0 = up ? (p0 * cr.y + v0 * cr.x) : (v0 * cr.x - p0 * cr.y);
                v1 = up ? (p1 * cc.y + v1 * cc.x) : (v1 * cc.x - p1 * cc.y); }
            const bf16_t o0 = f2bf(v0), o1 = f2bf(v1);
            b[lane] = o0; b[64 + lane] = o1;
            {
                const float qs = (h < 8 || (h >= 10 && h < 18)) ? 0.088388347648318440f * 1.4426950408889634f : 1.0f;
                const float w0 = bf2f(o0) * qs, w1 = bf2f(o1) * qs;
                float e4[4];
#pragma unroll
                for (int j = 0; j < 4; ++j) { const float a = __shfl(w0, (4 * lane + j) & 63), c2 = __shfl(w1, (4 * lane + j) & 63); e4[j] = lane < 16 ? a : c2; }
                unsigned pk = (unsigned)__builtin_amdgcn_cvt_pk_fp8_f32(e4[0], e4[1], 0, false); pk = (unsigned)__builtin_amdgcn_cvt_pk_fp8_f32(e4[2], e4[3], (int)pk, true);
                unsigned char* dst8 = h < 8 ? Q8 + (size_t)r * 1024 + 128 * h : (h < 10 ? K8 + (size_t)r * 256 + 128 * (h - 8) : (h < 18 ? Q8D + (size_t)r * 1024 + 128 * (h - 10) : K8D + (size_t)r * 1024 + 128 * (h - 18)));
                if (lane < 32) *(unsigned*)(dst8 + 4 * lane) = pk; }
        }
    }
    LAS bf16_t* vt = (LAS bf16_t*)(C.lds + C.wave * 17408);
    for (int item = C.gw; item < 10 * 260; item += C.ngw) {
        const int kh = item / 260, T = item % 260;
        const int vcol = kh < 2 ? 1280 + 128 * kh : 3584 + 128 * (kh - 2);
        unsigned char* vout = kh < 2 ? VT8 + (size_t)kh * 260 * 8192 : VT8D + (size_t)(kh - 2) * 260 * 8192;
#pragma unroll
        for (int q = 0; q < 16; ++q) { const int idx = lane + 64 * q, key = idx >> 4, c = idx & 15;
            *(LAS u32x4*)(vt + key * 136 + 8 * c) = *(const u32x4*)(QKV + (size_t)(64 * T + key) * OD_IN + vcol + 8 * c); }
        LDS_WAIT(); asm volatile("" ::: "memory");
#pragma unroll
        for (int dd = 0; dd < 2; ++dd) { const int d = lane + 64 * dd;
            unsigned char* dst = vout + ((size_t)T * 128 + d) * 64;
#pragma unroll
            for (int cch = 0; cch < 4; ++cch) { u32x4 w;
#pragma unroll
                for (int wd = 0; wd < 4; ++wd) { float f[4];
#pragma unroll
                    for (int e = 0; e < 4; ++e) { const int bb = 16 * cch + 4 * wd + e, hi2 = bb >> 5, blk = (bb >> 4) & 1, j = bb & 15; const int key = 32 * blk + (j & 3) + 8 * (j >> 2) + 4 * hi2;
                        f[e] = bf2f(vt[key * 136 + d]); }
                    unsigned pk = (unsigned)__builtin_amdgcn_cvt_pk_fp8_f32(f[0], f[1], 0, false); pk = (unsigned)__builtin_amdgcn_cvt_pk_fp8_f32(f[2], f[3], (int)pk, true);
                    w[wd] = pk; }
                *(u32x4*)(dst + 16 * cch) = w; } }
        LDS_WAIT(); asm volatile("" ::: "memory");
    }
}

__device__ __forceinline__ void phase_merge1(const Params& p, Ctx& C) {
    bf16_t* ATT = (bf16_t*)(p.ws + WS_BIG + BG_ATT);
    const float* dl = p.inp(24); const float* sg = p.inp(25);
    const int lane = C.lane;
    float d0 = dl[lane] * dl[128 + lane] + dl[64 + lane] * dl[128 + 64 + lane];
    float d1 = dl[256 + lane] * dl[384 + lane] + dl[256 + 64 + lane] * dl[384 + 64 + lane];
    const float lam = __expf(wave_sum(d0)) - __expf(wave_sum(d1)) + LAMBDA_INIT;
    const f32x4 gg = *(const f32x4*)(sg + 4 * lane);
    for (int l = C.gw; l < SEQ; l += C.ngw) {
        bf16_t* row = ATT + (size_t)l * 3072;
        u32x2 av[4], bv[4];
#pragma unroll
        for (int h = 0; h < 4; ++h) { av[h] = *(const u32x2*)(row + 1024 + 256 * h + 4 * lane); bv[h] = *(const u32x2*)(row + 2048 + 256 * h + 4 * lane); }
#pragma unroll
        for (int h = 0; h < 4; ++h) {
            const u32x2 a = av[h], b = bv[h];
            f32x4 o = {bflo(a.x) - lam * bflo(b.x), bfhi(a.x) - lam * bfhi(b.x), bflo(a.y) - lam * bflo(b.y), bfhi(a.y) - lam * bfhi(b.y)};
            const float ss = wave_sum(o[0] * o[0] + o[1] * o[1] + o[2] * o[2] + o[3] * o[3]);
            const float rs = rsqrtf(ss * (1.0f / 256.0f) + LN_EPS) * (1.0f - LAMBDA_INIT);
            o = o * rs * gg;
            u32x2 w; w.x = cvt_pk_bf16(o[0], o[1]); w.y = cvt_pk_bf16(o[2], o[3]);
            *(u32x2*)(row + 1024 + 256 * h + 4 * lane) = w;
        }
    }
}

__device__ __forceinline__ void phase_ln1(const Params& p, Ctx& C, int L) {
    const bf16_t* Y = (const bf16_t*)(p.ws + WS_YMIX); float* X1 = (float*)(p.ws + WS_X1); unsigned char* XA8 = (unsigned char*)(p.ws + WS_XA);
    const float* X2 = (const float*)(p.ws + WS_HX2);
    const float* lg = p.inp(6) + (size_t)(L * 2 + 0) * DM; const float* lb = p.inp(7) + (size_t)(L * 2 + 0) * DM;
    const int r0 = (L == 0) ? 0 : CTXL;
    LAS float* MV = (LAS float*)C.lds; LAS float* LG = MV + 6 * DM; LAS float* LB = LG + DM;
    for (int v = 0; v < 2; ++v) for (int k = 0; k < 3; ++k) stage_vec(MV + (v * 3 + k) * DM, modv(p, L, v, 2 + k), C.tid);
    stage_vec(LG, lg, C.tid); stage_vec(LB, lb, C.tid);
    __syncthreads();
    for (int r = r0 + C.gw; r < TT; r += C.ngw) {
        const int v = r < CTXL ? 1 : 0;
        const float* src = (L == 0) ? (r < CTXL ? p.inp(2) + (size_t)r * DM : p.inp(0) + (size_t)(r - CTXL) * DM) : X2 + (size_t)r * DM;
        const LAS float* g1 = MV + (v * 3 + 0) * DM; const LAS float* sh2 = MV + (v * 3 + 1) * DM; const LAS float* sc2 = MV + (v * 3 + 2) * DM;
        f32x4 t[8]; float s = 0.f;
#pragma unroll
        for (int j = 0; j < 8; ++j) { const int c = 4 * (C.lane + 64 * j);
            const f32x4 x = *(const f32x4*)(src + c), g = *(const LAS f32x4*)(g1 + c); const u32x2 yy = *(const u32x2*)(Y + (size_t)r * DM + c);
            const f32x4 y = {bflo(yy.x), bfhi(yy.x), bflo(yy.y), bfhi(yy.y)};
            t[j] = x * ALPHA + g * y; s += (t[j][0] + t[j][1]) + (t[j][2] + t[j][3]); }
        const float mean = wave_sum(s) * (1.0f / DM); float s2 = 0.f;
#pragma unroll
        for (int j = 0; j < 8; ++j) { t[j] = t[j] - mean; s2 += (t[j][0] * t[j][0] + t[j][1] * t[j][1]) + (t[j][2] * t[j][2] + t[j][3] * t[j][3]); }
        const float rstd = rsqrtf(wave_sum(s2) * (1.0f / DM) + LN_EPS);
#pragma unroll
        for (int j = 0; j < 8; ++j) { const int c = 4 * (C.lane + 64 * j);
            const f32x4 x1 = t[j] * rstd * *(const LAS f32x4*)(LG + c) + *(const LAS f32x4*)(LB + c);
            *(f32x4*)(X1 + (size_t)r * DM + c) = x1;
            const f32x4 z = x1 * (*(const LAS f32x4*)(sc2 + c) + 1.0f) + *(const LAS f32x4*)(sh2 + c);
            unsigned w = (unsigned)__builtin_amdgcn_cvt_pk_fp8_f32(z[0], z[1], 0, false); w = (unsigned)__builtin_amdgcn_cvt_pk_fp8_f32(z[2], z[3], (int)w, true);
            *(unsigned*)(XA8 + (size_t)r * DM + c) = w; }
    }
    __syncthreads();
}

__device__ __forceinline__ void phase_combine(const Params& p, Ctx& C, int L, LAS unsigned char* misc) {
    const unsigned char* YM = (const unsigned char*)(p.ws + WS_BIG + BG_YMOE); const float* X1 = (const float*)(p.ws + WS_X1);
    float* X2 = (float*)(p.ws + WS_HX2);
    const float* lg = p.inp(6) + (size_t)(L * 2 + 1) * DM; const float* lb = p.inp(7) + (size_t)(L * 2 + 1) * DM;
    const unsigned* PK = (const unsigned*)(p.ws + WS_WGT); const int* cnt = (const int*)(p.ws + WS_CTL) + CW_CNT + L * 128; const float* LWT = (const float*)(p.ws + WS_LW);
    const int r0 = (L == 0) ? 0 : CTXL;
    LAS int* rb = (LAS int*)(misc + 64);
    LAS float* MV = (LAS float*)C.lds; LAS float* LG = MV + 2 * DM; LAS float* LB = LG + DM;
    __syncthreads();
    if (C.tid == 0) { int q = 0; for (int e = 0; e < NEX1; ++e) { rb[e] = q; q += cnt[e]; } }
    stage_vec(MV, modv(p, L, 0, 5), C.tid); stage_vec(MV + DM, modv(p, L, 1, 5), C.tid); stage_vec(LG, lg, C.tid); stage_vec(LB, lb, C.tid);
    LAS float* M1 = LB + DM;
    unsigned char* XA8 = (unsigned char*)(p.ws + WS_XA);
    if (L == 0) { for (int v = 0; v < 2; ++v) { stage_vec(M1 + (v * 2 + 0) * DM, modv(p, 1, v, 0), C.tid); stage_vec(M1 + (v * 2 + 1) * DM, modv(p, 1, v, 1), C.tid); } }
    __syncthreads();
    for (int r = r0 + C.gw; r < TT; r += C.ngw) {
        const int v = r < CTXL ? 1 : 0;
        const LAS float* g2 = MV + v * DM;
        int ln = C.lane; asm volatile("" : "+v"(ln));
        int slot = rb[64] + (r - r0);
        float wk = 4.0f;
        if (ln < 8) { const unsigned pk = PK[(size_t)r * 8 + ln]; wk = LWT[(size_t)r * 8 + ln]; slot = rb[pk >> 16] + (int)(pk & 0xffffu); }
        f32x4 t[2][4]; float s = 0.f;
#pragma unroll
        for (int j = 0; j < 2; ++j) { const int c = 16 * (ln + 64 * j);
            u32x4 yy[9];
#pragma unroll
            for (int k = 0; k < 9; ++k) { const size_t a = (size_t)__builtin_amdgcn_readlane(slot, k); yy[k] = __builtin_nontemporal_load((const u32x4*)(YM + a * DM + c)); }
            f32x2 f[8];
#pragma unroll
            for (int q = 0; q < 8; ++q) f[q] = (f32x2){0.f, 0.f};
#pragma unroll
            for (int k = 0; k < 9; ++k) { const float wq = __int_as_float(__builtin_amdgcn_readlane(__float_as_int(wk), k));
                f[0] += wq * __builtin_amdgcn_cvt_pk_f32_fp8((int)yy[k].x, false); f[1] += wq * __builtin_amdgcn_cvt_pk_f32_fp8((int)yy[k].x, true);
                f[2] += wq * __builtin_amdgcn_cvt_pk_f32_fp8((int)yy[k].y, false); f[3] += wq * __builtin_amdgcn_cvt_pk_f32_fp8((int)yy[k].y, true);
                f[4] += wq * __builtin_amdgcn_cvt_pk_f32_fp8((int)yy[k].z, false); f[5] += wq * __builtin_amdgcn_cvt_pk_f32_fp8((int)yy[k].z, true);
                f[6] += wq * __builtin_amdgcn_cvt_pk_f32_fp8((int)yy[k].w, false); f[7] += wq * __builtin_amdgcn_cvt_pk_f32_fp8((int)yy[k].w, true); }
#pragma unroll
            for (int q = 0; q < 4; ++q) { const f32x4 x = *(const f32x4*)(X1 + (size_t)r * DM + c + 4 * q), g = *(const LAS f32x4*)(g2 + c + 4 * q);
                const f32x4 ff = {f[2 * q][0], f[2 * q][1], f[2 * q + 1][0], f[2 * q + 1][1]};
                t[j][q] = x * ALPHA + g * ff; s += (t[j][q][0] + t[j][q][1]) + (t[j][q][2] + t[j][q][3]); } }
        const float mean = wave_sum(s) * (1.0f / DM); float s2 = 0.f;
#pragma unroll
        for (int j = 0; j < 2; ++j)
#pragma unroll
            for (int q = 0; q < 4; ++q) { t[j][q] = t[j][q] - mean; s2 += (t[j][q][0] * t[j][q][0] + t[j][q][1] * t[j][q][1]) + (t[j][q][2] * t[j][q][2] + t[j][q][3] * t[j][q][3]); }
        const float rstd = rsqrtf(wave_sum(s2) * (1.0f / DM) + LN_EPS);
        float* dst = (L == 0) ? X2 + (size_t)r * DM : p.out + (size_t)(r - CTXL) * DM;
#pragma unroll
        for (int j = 0; j < 2; ++j)
#pragma unroll
            for (int q = 0; q < 4; ++q) { const int c = 16 * (ln + 64 * j) + 4 * q;
                const f32x4 xn = t[j][q] * rstd * *(const LAS f32x4*)(LG + c) + *(const LAS f32x4*)(LB + c);
                *(f32x4*)(dst + c) = xn;
                if (L == 0) { const f32x4 y = xn * (*(const LAS f32x4*)(M1 + (v * 2 + 1) * DM + c) + 1.0f) + *(const LAS f32x4*)(M1 + (v * 2 + 0) * DM + c);
                    unsigned w = (unsigned)__builtin_amdgcn_cvt_pk_fp8_f32(y[0], y[1], 0, false); w = (unsigned)__builtin_amdgcn_cvt_pk_fp8_f32(y[2], y[3], (int)w, true);
                    *(unsigned*)(XA8 + (size_t)r * DM + c) = w; } }
    }
    if (L == 0) { __syncthreads(); conv_queue(p, C, 1 << 30); }
}
constexpr int RLD = 264;
constexpr int SLD = 136;

template <bool SCALE>
__device__ __forceinline__ void stage_chunk(const bf16_t* QKV, int row0, int col0, LAS bf16_t* dst, int tid, float lg  , int dirb) {
#pragma unroll
    for (int q = 0; q < 8; ++q) { const int idx = tid + NTHR * q, r = idx >> 5, c = idx & 31;
        u32x4 w = *(const u32x4*)(QKV + (size_t)(row0 + r) * EV_IN + col0 + 8 * c);
        if (SCALE) { const float sc = fast_exp((dirb ? (float)r : (float)(127 - r)) * lg);
            w.x = cvt_pk_bf16(bflo(w.x) * sc, bfhi(w.x) * sc); w.y = cvt_pk_bf16(bflo(w.y) * sc, bfhi(w.y) * sc);
            w.z = cvt_pk_bf16(bflo(w.z) * sc, bfhi(w.z) * sc); w.w = cvt_pk_bf16(bflo(w.w) * sc, bfhi(w.w) * sc); }
        *(LAS u32x4*)(dst + r * RLD + 8 * c) = w; }
}

__device__ __forceinline__ void ret_chunk_kv(const Params& p, Ctx& C) {
    const bf16_t* QKV = (const bf16_t*)(p.ws + WS_BIG + BG_QKV); bf16_t* CKV = (bf16_t*)(p.ws + WS_BIG + BG_CKV);
    const float* rld = p.inp(10);
    LAS bf16_t* Vs = (LAS bf16_t*)C.lds; LAS bf16_t* Ks = Vs + 128 * RLD;
    const int lane = C.lane, w = C.wave;
    for (int unit = C.bid; unit < 130 * 8; unit += C.G) {
        const int u = unit >> 3, h = (unit >> 1) & 3, dir = unit & 1;
        const float lg = rld[dir * 4 + h];
        __syncthreads();
        stage_chunk<false>(QKV, 128 * u, 2048 + 256 * h, Vs, C.tid, 0.f, 0);
        stage_chunk<true>(QKV, 128 * u, 1024 + 256 * h, Ks, C.tid, lg, dir);
        __syncthreads();
        f32x4 acc[2][16];
#pragma unroll
        for (int a = 0; a < 2; ++a)
#pragma unroll
            for (int b = 0; b < 16; ++b) acc[a][b] = (f32x4){0.f, 0.f, 0.f, 0.f};
        const unsigned vbase = (unsigned)(uintptr_t)Vs, kbase = (unsigned)(uintptr_t)Ks;
#pragma unroll 1
        for (int ks = 0; ks < 4; ++ks) {
            bf16x8 af[2];
#pragma unroll
            for (int a = 0; a < 2; ++a) af[a] = frag_colk_l(vbase + (unsigned)((32 * ks) * RLD + 32 * w + 16 * a) * 2u, RLD * 2, lane);
#pragma unroll
            for (int b = 0; b < 16; ++b) { const bf16x8 bf = frag_colk_l(kbase + (unsigned)((32 * ks) * RLD + 16 * b) * 2u, RLD * 2, lane);
                acc[0][b] = MFMA16(bf, af[0], acc[0][b]); acc[1][b] = MFMA16(bf, af[1], acc[1][b]); }
        }
        bf16_t* dst = CKV + ((size_t)((dir * 4 + h) * 130 + u)) * 65536;
#pragma unroll
        for (int a = 0; a < 2; ++a)
#pragma unroll
            for (int b = 0; b < 16; ++b) { u32x2 w2; w2.x = cvt_pk_bf16(acc[a][b][0], acc[a][b][1]); w2.y = cvt_pk_bf16(acc[a][b][2], acc[a][b][3]);
                *(u32x2*)(dst + (size_t)(32 * w + 16 * a + (lane & 15)) * 256 + 16 * b + 4 * (lane >> 4)) = w2; }
    }
    __syncthreads();
}

__device__ __forceinline__ int s5_row(int dir, int c, int s) { return dir == 0 ? 64 * c + s : (c < 4 ? 255 - (64 * c + s) : 16639 - 64 * (c - 4) - s); }

__device__ __forceinline__ void s5_end_states(const Params& p, Ctx& C) {
    const bf16_t* QKV = (const bf16_t*)(p.ws + WS_BIG + BG_QKV); const bf16_t* BBT = (const bf16_t*)(p.ws + WS_BBT); float* E = (float*)(p.ws + WS_S5E);
    const float* APOW = (const float*)(p.ws + WS_APOW);
    LAS f32x2* PL = (LAS f32x2*)C.lds;
    for (int bt = C.bid; bt < 256; bt += C.G) {
        int tid = C.tid; asm volatile("" : "+v"(tid));
        const int lane = tid & 63, r32 = lane & 31, hi = lane >> 5;
        const int dg = bt >> 1, dir = dg >> 6, g = dg & 63, c0 = 130 * (bt & 1);
        __syncthreads();
#pragma unroll
        for (int q = 0; q < 8; ++q) { const int idx = tid + NTHR * q, s = idx >> 6, pp = idx & 63;
            PL[idx] = (s == 63) ? (f32x2){1.0f, 0.0f} : *(const f32x2*)(APOW + ((size_t)dg * 64 + (62 - s)) * 128 + 2 * pp); }
        __syncthreads();
        bf16x8 bfr[4];
#pragma unroll
        for (int pt = 0; pt < 4; ++pt) bfr[pt] = *(const bf16x8*)(BBT + ((size_t)dg * 128 + 32 * pt + r32) * 16 + 8 * hi);
        for (int c = c0 + C.wave; c < c0 + 130; c += 8) {
            float er[2] = {0.f, 0.f}, ei[2] = {0.f, 0.f};
#pragma unroll
            for (int st = 0; st < 2; ++st) {
                const bf16x8 a = *(const bf16x8*)(QKV + (size_t)s5_row(dir, c, 32 * st + r32) * EV_IN + 4096 + 16 * g + 8 * hi);
                f32x16 d[4];
#pragma unroll
                for (int pt = 0; pt < 4; ++pt) d[pt] = __builtin_amdgcn_mfma_f32_32x32x16_bf16(a, bfr[pt], (f32x16){}, 0, 0, 0);
#pragma unroll
                for (int r = 0; r < 16; ++r) { const int s = 32 * st + (r & 3) + 8 * (r >> 2) + 4 * hi;
#pragma unroll
                    for (int pt = 0; pt < 2; ++pt) { const f32x2 pw = PL[s * 64 + 32 * pt + r32]; const float br = d[pt][r], bi = d[pt + 2][r];
                        er[pt] += pw.x * br - pw.y * bi; ei[pt] += pw.x * bi + pw.y * br; } }
            }
#pragma unroll
            for (int pt = 0; pt < 2; ++pt) {
                { auto rr = __builtin_amdgcn_permlane32_swap(__float_as_uint(er[pt]), __float_as_uint(er[pt]), false, false); er[pt] = __uint_as_float(rr[0]) + __uint_as_float(rr[1]); }
                { auto rr = __builtin_amdgcn_permlane32_swap(__float_as_uint(ei[pt]), __float_as_uint(ei[pt]), false, false); ei[pt] = __uint_as_float(rr[0]) + __uint_as_float(rr[1]); }
            }
            float* dst = E + ((size_t)dg * 260 + c) * 128;
            if (hi == 0) { dst[r32] = er[0]; dst[32 + r32] = er[1]; dst[64 + r32] = ei[0]; dst[96 + r32] = ei[1]; }
        }
    }
    __syncthreads();
}

__device__ __forceinline__ void phase_scans(const Params& p, Ctx& C) {
    const bf16_t* CKV = (const bf16_t*)(p.ws + WS_BIG + BG_CKV); bf16_t* SP = (bf16_t*)(p.ws + WS_BIG + BG_SPREV);
    const float* rld = p.inp(10);
    for (int q = C.bid * NTHR + C.tid; q < 8 * 16384; q += C.G * NTHR) {
        const int dh = q >> 14, el = (q & 16383) * 4, dir = dh >> 2, h = dh & 3;
        const float gch = fast_exp(128.0f * rld[dir * 4 + h]);
        const bf16_t* src = CKV + (size_t)dh * 130 * 65536 + el; bf16_t* dst = SP + (size_t)dh * 130 * 65536 + el;
        f32x4 s = {0.f, 0.f, 0.f, 0.f};
        for (int st0 = 0; st0 < 130; st0 += 13) {
            u32x2 kv[13];
#pragma unroll
            for (int k = 0; k < 13; ++k) { const int st = st0 + k; const int u = dir == 0 ? st : (st == 0 ? 1 : (st == 1 ? 0 : 131 - st)); kv[k] = __builtin_nontemporal_load((const u32x2*)(src + (size_t)u * 65536)); }
#pragma unroll
            for (int k = 0; k < 13; ++k) { const int st = st0 + k; const int u = dir == 0 ? st : (st == 0 ? 1 : (st == 1 ? 0 : 131 - st));
                u32x2 w; w.x = cvt_pk_bf16(s[0], s[1]); w.y = cvt_pk_bf16(s[2], s[3]); *(u32x2*)(dst + (size_t)u * 65536) = w;
                s = s * gch + (f32x4){bflo(kv[k].x), bfhi(kv[k].x), bflo(kv[k].y), bfhi(kv[k].y)}; }
        }
    }
    const float* E = (const float*)(p.ws + WS_S5E); float* HST = (float*)(p.ws + WS_HST); const float* AL = (const float*)(p.ws + WS_AL);
    for (int q = C.bid * NTHR + C.tid; q < 2 * 64 * 64; q += C.G * NTHR) {
        const int dg = q >> 6, pp = q & 63;
        const f32x2 al = *(const f32x2*)(AL + (size_t)dg * 128 + 2 * pp);
        const float* e = E + (size_t)dg * 260 * 128; float* hs = HST + (size_t)dg * 260 * 128;
        float hr = 0.f, hi = 0.f;
        for (int c0 = 0; c0 < 260; c0 += 26) {
            float er[26], ei[26];
#pragma unroll
            for (int k = 0; k < 26; ++k) { er[k] = e[(size_t)(c0 + k) * 128 + pp]; ei[k] = e[(size_t)(c0 + k) * 128 + 64 + pp]; }
#pragma unroll
            for (int k = 0; k < 26; ++k) { *(f32x2*)(hs + (size_t)(c0 + k) * 128 + 2 * pp) = (f32x2){hr, hi};
                const float t = al.x * hr - al.y * hi + er[k]; hi = al.x * hi + al.y * hr + ei[k]; hr = t; }
        }
    }
}

__device__ __forceinline__ void ret_output_unit(const Params& p, Ctx& C, int unit) {
    const bf16_t* QKV = (const bf16_t*)(p.ws + WS_BIG + BG_QKV); const bf16_t* SP = (const bf16_t*)(p.ws + WS_BIG + BG_SPREV);
    bf16_t* MIX = (bf16_t*)(p.ws + WS_BIG + BG_MIX);
    const float* rld = p.inp(10);
    LAS bf16_t* RA = (LAS bf16_t*)C.lds; LAS bf16_t* RB = RA + 128 * RLD;
    int tid = C.tid; asm volatile("" : "+v"(tid));
    const int lane = tid & 63, w = C.wave, kq = lane >> 4, fr = lane & 15;
    const int u = unit >> 2, h = unit & 3;
    const float lgf = rld[h], lgb = rld[4 + h];
    stage_chunk<false>(QKV, 128 * u, 256 * h, RA, tid, 0.f, 0);
    int ib = 16 * w + 4 * kq, jb = fr; asm volatile("" : "+v"(ib), "+v"(jb));
    f32x4 acc[16];
#pragma unroll
    for (int t = 0; t < 16; ++t) acc[t] = (f32x4){0.f, 0.f, 0.f, 0.f};
#pragma unroll
    for (int dir = 0; dir < 2; ++dir) {
        const bf16_t* Sd = SP + ((size_t)((dir * 4 + h) * 130 + u)) * 65536;
#pragma unroll
        for (int eh = 0; eh < 2; ++eh) {
            __syncthreads();
#pragma unroll
            for (int q = 0; q < 8; ++q) { const int idx = tid + NTHR * q, rr = idx >> 5, c = idx & 31;
                *(LAS u32x4*)(RB + rr * RLD + 8 * c) = *(const u32x4*)(Sd + (size_t)(128 * eh + rr) * 256 + 8 * c);
                if (q == 3) asm volatile("" ::: "memory"); }
            __syncthreads();
#pragma unroll 1
            for (int ks = 0; ks < 8; ++ks) { const bf16x8 af = frag_rowk_l(RA + (16 * w) * RLD + 32 * ks, RLD, lane);
#pragma unroll
                for (int t = 0; t < 8; ++t) { const bf16x8 bf = frag_rowk_l(RB + (16 * t) * RLD + 32 * ks, RLD, lane); acc[8 * eh + t] = MFMA16(af, bf, acc[8 * eh + t]); } }
        }
#pragma unroll
        for (int r = 0; r < 4; ++r) { const int i = ib + r; const float qd = fast_exp((float)(128 - i) * lgb);
            const float f = (dir == 0) ? fast_exp((float)(i + 1) * lgf) / qd : qd;
#pragma unroll
            for (int t = 0; t < 16; ++t) acc[t][r] *= f; }
    }
    __syncthreads();
    stage_chunk<false>(QKV, 128 * u, 1024 + 256 * h, RB, tid, 0.f, 0);
    __syncthreads();
    f32x4 sc[8];
#pragma unroll
    for (int t = 0; t < 8; ++t) sc[t] = (f32x4){0.f, 0.f, 0.f, 0.f};
#pragma unroll 1
    for (int ks = 0; ks < 8; ++ks) { const bf16x8 af = frag_rowk_l(RA + (16 * w) * RLD + 32 * ks, RLD, lane);
#pragma unroll
        for (int t = 0; t < 8; ++t) { const bf16x8 bf = frag_rowk_l(RB + (16 * t) * RLD + 32 * ks, RLD, lane); sc[t] = MFMA16(af, bf, sc[t]); } }
#pragma unroll
    for (int t = 0; t < 8; ++t)
#pragma unroll
        for (int r = 0; r < 4; ++r) { const int i = ib + r, j = 16 * t + jb; const float d = (float)(i - j);
            const float m = (i >= j ? fast_exp(d * lgf) : 0.f) + (j >= i ? fast_exp(-d * lgb) : 0.f); sc[t][r] *= m; }
    __syncthreads();
    stage_chunk<false>(QKV, 128 * u, 2048 + 256 * h, RA, tid, 0.f, 0);
#pragma unroll
    for (int t = 0; t < 8; ++t)
#pragma unroll
        for (int r = 0; r < 4; ++r) RB[(16 * w + 4 * kq + r) * SLD + 16 * t + fr] = f2bf(sc[t][r]);
    __syncthreads();
    const unsigned vbase = (unsigned)(uintptr_t)RA;
#pragma unroll 1
    for (int ks = 0; ks < 4; ++ks) { const bf16x8 af = frag_rowk_l(RB + (16 * w) * SLD + 32 * ks, SLD, lane);
#pragma unroll
        for (int t = 0; t < 16; ++t) { const bf16x8 bf = frag_colk_l(vbase + (unsigned)((32 * ks) * RLD + 16 * t) * 2u, RLD * 2, lane); acc[t] = MFMA16(af, bf, acc[t]); } }
    __syncthreads();
#pragma unroll
    for (int r = 0; r < 4; ++r) {
        float s = 0.f;
#pragma unroll
        for (int t = 0; t < 16; ++t) s += acc[t][r];
        s += __shfl_xor(s, 1); s += __shfl_xor(s, 2); s += __shfl_xor(s, 4); s += __shfl_xor(s, 8);
        const float mean = s * (1.0f / 256.0f); float q = 0.f;
#pragma unroll
        for (int t = 0; t < 16; ++t) { const float d = acc[t][r] - mean; q += d * d; }
        q += __shfl_xor(q, 1); q += __shfl_xor(q, 2); q += __shfl_xor(q, 4); q += __shfl_xor(q, 8);
        const float rstd = rsqrtf(q * (1.0f / 256.0f) + LN_EPS);
#pragma unroll
        for (int t = 0; t < 16; ++t) RA[(16 * w + 4 * kq + r) * RLD + 16 * t + fr] = f2bf((acc[t][r] - mean) * rstd);
    }
    __syncthreads();
#pragma unroll
    for (int q = 0; q < 8; ++q) { const int idx = tid + NTHR * q, rr = idx >> 5, c = idx & 31; const size_t row = (size_t)(128 * u + rr);
        const u32x4 o = *(const LAS u32x4*)(RA + rr * RLD + 8 * c), g = *(const u32x4*)(QKV + row * EV_IN + 3072 + 256 * h + 8 * c);
        u32x4 w4;
        w4.x = cvt_pk_bf16(bflo(o.x) * siluf_(bflo(g.x)), bfhi(o.x) * siluf_(bfhi(g.x))); w4.y = cvt_pk_bf16(bflo(o.y) * siluf_(bflo(g.y)), bfhi(o.y) * siluf_(bfhi(g.y)));
        w4.z = cvt_pk_bf16(bflo(o.z) * siluf_(bflo(g.z)), bfhi(o.z) * siluf_(bfhi(g.z))); w4.w = cvt_pk_bf16(bflo(o.w) * siluf_(bflo(g.w)), bfhi(o.w) * siluf_(bfhi(g.w)));
        *(u32x4*)(MIX + row * DM + 256 * h + 8 * c) = w4; }
    __syncthreads();
}

constexpr int KLD = 1032;
__device__ __forceinline__ void s5_output_task(const Params& p, Ctx& C, int bt) {
    const bf16_t* QKV = (const bf16_t*)(p.ws + WS_BIG + BG_QKV); bf16_t* Z = (bf16_t*)(p.ws + WS_Z);
    const bf16_t* KN = (const bf16_t*)(p.ws + WS_KN); const bf16_t* CCt = (const bf16_t*)(p.ws + WS_CC);
    const float* APOW = (const float*)(p.ws + WS_APOW); const float* HST = (const float*)(p.ws + WS_HST); const float* dsk = p.inp(18);
    int tid = C.tid; asm volatile("" : "+v"(tid));
    const int lane = tid & 63, kq = lane >> 4, fr = lane & 15;
    LAS bf16_t* KF = (LAS bf16_t*)C.lds; LAS bf16_t* KB = KF + 16 * KLD;
    LAS bf16_t* U = KB + 16 * KLD + C.wave * 3072;
    LAS float* PW0 = (LAS float*)(KB + 16 * KLD + 8 * 3072);
    LAS float* PW16 = PW0 + 2 * 16 * 128;
    {
        const int g = bt >> 3, k0 = (260 * (bt & 7)) >> 3, k1 = (260 * ((bt & 7) + 1)) >> 3;
#pragma unroll
        for (int q = 0; q < 8; ++q) { const int idx = tid + NTHR * q, dir = idx >> 11, rr = (idx >> 7) & 15, c = idx & 127;
            *(LAS u32x4*)((dir ? KB : KF) + rr * KLD + 8 * c) = *(const u32x4*)(KN + ((size_t)(dir * 64 + g) * 16 + rr) * 1024 + 8 * c); }
        for (int q = lane; q < 192 * 2; q += 64) *(LAS u32x4*)(U + 8 * q) = (u32x4){0u, 0u, 0u, 0u};
#pragma unroll
        for (int q = 0; q < 2; ++q) { const int idx = tid + NTHR * q, dir = idx >> 9, f = (idx >> 5) & 15, c4 = idx & 31;
            *(LAS f32x4*)(PW0 + dir * 2048 + f * 128 + 4 * c4) = *(const f32x4*)(APOW + ((size_t)(dir * 64 + g) * 64 + (dir == 0 ? f : 15 - f)) * 128 + 4 * c4); }
        if (tid < 64) { const int dir = tid >> 5, c4 = tid & 31; *(LAS f32x4*)(PW16 + dir * 128 + 4 * c4) = *(const f32x4*)(APOW + ((size_t)(dir * 64 + g) * 64 + 15) * 128 + 4 * c4); }
        __syncthreads();
        const f32x4 dv = *(const f32x4*)(dsk + 16 * g + 4 * kq);
        bf16x8 ccr[2], cci[2];
#pragma unroll
        for (int hb = 0; hb < 2; ++hb) { ccr[hb] = frag_rowk_g(CCt + (size_t)g * 16 * 128 + 32 * hb, 128, lane); cci[hb] = frag_rowk_g(CCt + (size_t)g * 16 * 128 + 64 + 32 * hb, 128, lane); }
        const LAS float* pw0l = PW0 + (size_t)fr * 128 + 16 * kq;
        const LAS float* pw16l = PW16 + 16 * kq;
        for (int k = k0 + C.wave; k < k1; k += 8) {
            LDS_WAIT(); asm volatile("" ::: "memory");
            for (int q = lane; q < 128; q += 64) { const int t = q >> 1, hf = q & 1;
                *(LAS u32x4*)(U + (64 + t) * 16 + 8 * hf) = *(const u32x4*)(QKV + (size_t)(64 * k + t) * EV_IN + 4096 + 16 * g + 8 * hf); }
            LDS_WAIT(); asm volatile("" ::: "memory");
            const int cf = k, cb = k < 4 ? 3 - k : 263 - k;
            f32x4 acc[4];
#pragma unroll
            for (int tt = 0; tt < 4; ++tt) acc[tt] = (f32x4){0.f, 0.f, 0.f, 0.f};
            const LAS bf16_t* ubf = U + (64 + fr - (kq >> 1)) * 16 + 8 * (kq & 1);
            const LAS bf16_t* ubb = U + (64 + fr + (kq >> 1)) * 16 + 8 * (kq & 1);
#pragma unroll
            for (int n0 = 0; n0 < 64; n0 += 2) {
                const bf16x8 af = frag_rowk_l(KF + n0 * 16, KLD, lane), ab = frag_rowk_l(KB + n0 * 16, KLD, lane);
#pragma unroll
                for (int tt = 0; tt < 4; ++tt) {
                    if (n0 <= 16 * tt + 14) acc[tt] = MFMA16(af, *(const LAS bf16x8*)(ubf + (16 * tt - n0) * 16), acc[tt]);
                    if (n0 <= 62 - 16 * tt) acc[tt] = MFMA16(ab, *(const LAS bf16x8*)(ubb + (16 * tt + n0) * 16), acc[tt]);
                }
                asm volatile("" ::: "memory");
            }
#pragma unroll
            for (int dir = 0; dir < 2; ++dir) {
                const float* hp = HST + ((size_t)(dir * 64 + g) * 260 + (dir == 0 ? cf : cb)) * 128;
#pragma unroll
                for (int hb = 0; hb < 2; ++hb) {
                    float xr[8], xi[8];
#pragma unroll
                    for (int e2 = 0; e2 < 4; ++e2) { const f32x4 h4 = *(const f32x4*)(hp + 2 * (32 * hb + 8 * kq) + 4 * e2), b4 = *(const LAS f32x4*)(pw0l + dir * 2048 + hb * 64 + 4 * e2);
                        xr[2 * e2] = b4[0] * h4[0] - b4[1] * h4[1]; xi[2 * e2] = b4[0] * h4[1] + b4[1] * h4[0];
                        xr[2 * e2 + 1] = b4[2] * h4[2] - b4[3] * h4[3]; xi[2 * e2 + 1] = b4[2] * h4[3] + b4[3] * h4[2]; }
#pragma unroll
                    for (int st = 0; st < 4; ++st) {
                        const int tt = dir == 0 ? st : 3 - st;
                        u32x4 br, bi;
                        br.x = cvt_pk_bf16(xr[0], xr[1]); br.y = cvt_pk_bf16(xr[2], xr[3]); br.z = cvt_pk_bf16(xr[4], xr[5]); br.w = cvt_pk_bf16(xr[6], xr[7]);
                        bi.x = cvt_pk_bf16(xi[0], xi[1]); bi.y = cvt_pk_bf16(xi[2], xi[3]); bi.z = cvt_pk_bf16(xi[4], xi[5]); bi.w = cvt_pk_bf16(xi[6], xi[7]);
                        acc[tt] = MFMA16(ccr[hb], __builtin_bit_cast(bf16x8, br), acc[tt]);
                        acc[tt] = MFMA16(cci[hb], __builtin_bit_cast(bf16x8, bi), acc[tt]);
                        if (st < 3) {
#pragma unroll
                            for (int e2 = 0; e2 < 4; ++e2) { const f32x4 a4 = *(const LAS f32x4*)(pw16l + dir * 128 + hb * 64 + 4 * e2);
                                float t0 = xr[2 * e2] * a4[0] - xi[2 * e2] * a4[1]; xi[2 * e2] = xr[2 * e2] * a4[1] + xi[2 * e2] * a4[0]; xr[2 * e2] = t0;
                                t0 = xr[2 * e2 + 1] * a4[2] - xi[2 * e2 + 1] * a4[3]; xi[2 * e2 + 1] = xr[2 * e2 + 1] * a4[3] + xi[2 * e2 + 1] * a4[2]; xr[2 * e2 + 1] = t0; }
                        }
                    }
                }
            }
#pragma unroll
            for (int tt = 0; tt < 4; ++tt) { const int t = 16 * tt + fr;
                const u32x2 uu = *(const LAS u32x2*)(U + (64 + t) * 16 + 4 * kq);
                const float y0 = acc[tt][0] + bflo(uu.x) * dv[0], y1 = acc[tt][1] + bfhi(uu.x) * dv[1], y2 = acc[tt][2] + bflo(uu.y) * dv[2], y3 = acc[tt][3] + bfhi(uu.y) * dv[3];
                u32x2 w; w.x = cvt_pk_bf16(gelu_tanh(y0), gelu_tanh(y1)); w.y = cvt_pk_bf16(gelu_tanh(y2), gelu_tanh(y3));
                *(u32x2*)(Z + (size_t)(64 * k + t) * 1024 + 16 * g + 4 * kq) = w; }
        }
    }
    __syncthreads();
}

__device__ __forceinline__ void phase_ret_s5_outputs(const Params& p, Ctx& C, LAS unsigned char* misc) {
    unsigned* head = (unsigned*)(p.ws + WS_CTL) + CW_QUEUE;
    volatile LAS int* slot = (volatile LAS int*)(misc + 32);
    for (;;) {
        __syncthreads();
        if (C.tid == 0) slot[0] = (int)atomicAdd(head, 1u);
        __syncthreads();
        const int item = __builtin_amdgcn_readfirstlane(slot[0]);
        if (item >= 520) break;
        ret_output_unit(p, C, item);
    }
    for (;;) {
        __syncthreads();
        if (C.tid == 0) slot[0] = (int)atomicAdd(head + 64, 1u);
        __syncthreads();
        const int item = __builtin_amdgcn_readfirstlane(slot[0]);
        if (item >= 512) break;
        s5_output_task(p, C, item);
    }
}
__device__ __forceinline__ void phase_router(const Params& p, Ctx& C, int L) {
    const float* X1 = (const float*)(p.ws + WS_X1);
    const bf16_t* RWh = (const bf16_t*)(p.ws + WS_RWT) + (size_t)(L * 2 + 0) * 64 * DM; const bf16_t* RWl = (const bf16_t*)(p.ws + WS_RWT) + (size_t)(L * 2 + 1) * 64 * DM;
    const float* rbias = p.inp(27) + L * 64;
    int* cnt = (int*)(p.ws + WS_CTL) + CW_CNT + L * 128; int* LIST = (int*)(p.ws + WS_LIST); unsigned* PK = (unsigned*)(p.ws + WS_WGT); float* LW = (float*)(p.ws + WS_LW);
    const int lane = C.lane, kq = lane >> 4, fr = lane & 15;
    LAS float* Lw = (LAS float*)(C.lds + C.wave * 16640);
    const int r0 = (L == 0) ? 0 : CTXL, nrows = TT - r0;
    if (C.bid == 0 && C.tid == 0) cnt[64] = nrows;
    const int quad = C.wave >> 2, kw = C.wave & 3, ntask = nrows / 64;
    for (int tb = C.bid * 2; tb < ntask; tb += C.G * 2) {
        const int task = tb + quad;
        const int rbase = r0 + 64 * task;
        const int v = rbase < CTXL ? 1 : 0;
        const float* xr = X1 + (size_t)(rbase + fr) * DM; const float* sc2 = modv(p, L, v, 4); const float* sh2 = modv(p, L, v, 3);
        f32x4 acc[4][4];
#pragma unroll
        for (int b = 0; b < 4; ++b)
#pragma unroll
            for (int t = 0; t < 4; ++t) acc[b][t] = (f32x4){0.f, 0.f, 0.f, 0.f};
#pragma unroll 1
        for (int ks = 16 * kw; ks < 16 * kw + 16; ++ks) { const int c0 = 32 * ks + 8 * kq;
            const f32x4 a0 = *(const f32x4*)(sc2 + c0), a1 = *(const f32x4*)(sc2 + c0 + 4), b0 = *(const f32x4*)(sh2 + c0), b1 = *(const f32x4*)(sh2 + c0 + 4);
            bf16x8 ah[4], al[4];
#pragma unroll
            for (int b = 0; b < 4; ++b) {
                const f32x4 x0 = *(const f32x4*)(xr + (size_t)(16 * b) * DM + c0), x1 = *(const f32x4*)(xr + (size_t)(16 * b) * DM + c0 + 4);
                const f32x4 y0 = x0 * (a0 + 1.0f) + b0, y1 = x1 * (a1 + 1.0f) + b1;
                u32x4 hi; hi.x = cvt_pk_bf16(y0[0], y0[1]); hi.y = cvt_pk_bf16(y0[2], y0[3]); hi.z = cvt_pk_bf16(y1[0], y1[1]); hi.w = cvt_pk_bf16(y1[2], y1[3]);
                u32x4 lo; lo.x = cvt_pk_bf16(y0[0] - bflo(hi.x), y0[1] - bfhi(hi.x)); lo.y = cvt_pk_bf16(y0[2] - bflo(hi.y), y0[3] - bfhi(hi.y));
                lo.z = cvt_pk_bf16(y1[0] - bflo(hi.z), y1[1] - bfhi(hi.z)); lo.w = cvt_pk_bf16(y1[2] - bflo(hi.w), y1[3] - bfhi(hi.w));
                ah[b] = __builtin_bit_cast(bf16x8, hi); al[b] = __builtin_bit_cast(bf16x8, lo); }
#pragma unroll
            for (int t = 0; t < 4; ++t) { const bf16x8 bh = frag_rowk_g(RWh + (size_t)(16 * t) * DM + 32 * ks, DM, lane), bl = frag_rowk_g(RWl + (size_t)(16 * t) * DM + 32 * ks, DM, lane);
#pragma unroll
                for (int b = 0; b < 4; ++b) { acc[b][t] = MFMA16(ah[b], bh, acc[b][t]); acc[b][t] = MFMA16(al[b], bh, acc[b][t]); acc[b][t] = MFMA16(ah[b], bl, acc[b][t]); } } }
        LDS_WAIT(); asm volatile("" ::: "memory");
#pragma unroll
        for (int b = 0; b < 4; ++b)
#pragma unroll
            for (int t = 0; t < 4; ++t)
#pragma unroll
                for (int r = 0; r < 4; ++r) Lw[b * 1040 + (4 * kq + r) * 65 + 16 * t + fr] = acc[b][t][r];
        LDS_WAIT(); asm volatile("" ::: "memory");
        __syncthreads();
        LAS float* Lg = Lw + kw * 1040;
        { const LAS float* q0 = (const LAS float*)(C.lds + (4 * quad) * 16640) + kw * 1040;
          for (int i = lane; i < 16 * 65; i += 64) Lg[i] = (q0[i] + q0[4160 + i]) + (q0[8320 + i] + q0[12480 + i]); }
        LDS_WAIT(); asm volatile("" ::: "memory");
        if (lane < 16) {
            LAS float* sr = Lg + lane * 65; const int trow = rbase + 16 * kw + lane;
            float gs[8];
#pragma unroll
            for (int g = 0; g < 8; ++g) { float m1 = -1e30f, m2 = -1e30f;
                for (int j = 0; j < 8; ++j) { const int e = 8 * g + j; const float s = sigmoidf_(sr[e]); sr[e] = s; const float vv = s + rbias[e];
                    if (vv > m1) { m2 = m1; m1 = vv; } else if (vv > m2) m2 = vv; }
                gs[g] = m1 + m2; }
            unsigned gmask = 0u;
#pragma unroll
            for (int it = 0; it < 4; ++it) { float best = -1e30f; int bi = 0;
#pragma unroll
                for (int g = 0; g < 8; ++g) { const bool ok = !((gmask >> g) & 1u) && gs[g] > best; best = ok ? gs[g] : best; bi = ok ? g : bi; }
                gmask |= 1u << bi; }
            unsigned long long taken = 0ull; int sel[8]; float sw[8]; float wsum = 0.f;
#pragma unroll
            for (int k = 0; k < 8; ++k) { float best = -1e30f; int bi = 0;
                for (int e = 0; e < 64; ++e) { const bool cand = ((gmask >> (e >> 3)) & 1u) && !((taken >> e) & 1ull); const float vv = sr[e] + rbias[e];
                    if (cand && vv > best) { best = vv; bi = e; } }
                taken |= 1ull << bi; sel[k] = bi; sw[k] = sr[bi]; wsum += sw[k]; }
            const float inv = 2.5f / wsum;
#pragma unroll
            for (int k = 0; k < 8; ++k) { const int a = trow * 8 + k; const int pos = atomicAdd(&cnt[sel[k]], 1);
                LIST[(size_t)sel[k] * TT + pos] = a; PK[a] = ((unsigned)sel[k] << 16) | (unsigned)pos; LW[a] = sw[k] * inv * 4.0f; }
            LIST[(size_t)64 * TT + (trow - r0)] = 8 * TT + trow;
        }
        __syncthreads();
    }
}
namespace att {
constexpr int D = 128, NW = 8, QBLK = 32, KVBLK = 64;
constexpr float SCALE = 0.088388347648318440f;
constexpr float THR = 8.f;
constexpr int SHM_V = KVBLK * D * 2, SHM_K = KVBLK * D * 2, SHM_ATTN = 2 * SHM_V + 2 * SHM_K + NW * 64 * 4;
#define KSWZ(row, colB) ((row) * 256 + ((colB) ^ (((row) & 7) << 4)))
#define SBAR() __builtin_amdgcn_sched_barrier(0)
__device__ __forceinline__ int crow(int r, int hi) { return (r & 3) + 8 * (r >> 2) + 4 * hi; }
__device__ __forceinline__ unsigned cvtpk(float lo, float hi) { unsigned r; asm volatile("v_cvt_pk_bf16_f32 %0, %1, %2" : "=v"(r) : "v"(lo), "v"(hi)); return r; }

__device__ __forceinline__ void partialSM(f32x16& p0, f32x16& p1, float negMC) {
  constexpr float Cc = SCALE * 1.4426950408889634f;
  for (int r = 0; r < 16; ++r) p0[r] = fmaf(p0[r], Cc, negMC); for (int r = 0; r < 16; ++r) p1[r] = fmaf(p1[r], Cc, negMC);
  for (int r = 0; r < 16; ++r) p0[r] = __builtin_amdgcn_exp2f(p0[r]);
}
__device__ __forceinline__ void finishSM(f32x16& p0, f32x16& p1, float& l_reg, bf16x8& pa0, bf16x8& pa1, bf16x8& pa2, bf16x8& pa3) {
  for (int r = 0; r < 16; ++r) p1[r] = __builtin_amdgcn_exp2f(p1[r]);
  float ps = 0; for (int r = 0; r < 16; ++r) ps += p0[r]; for (int r = 0; r < 16; ++r) ps += p1[r];
  { auto rr = __builtin_amdgcn_permlane32_swap(__float_as_uint(ps), __float_as_uint(ps), false, false);
    ps = __uint_as_float(rr[0]) + __uint_as_float(rr[1]); }
  l_reg += ps;
#define PK4(P, BASE, OUT) do { unsigned a0 = cvtpk(P[BASE + 0], P[BASE + 1]), a1 = cvtpk(P[BASE + 2], P[BASE + 3]);   \
    unsigned b0 = cvtpk(P[BASE + 4], P[BASE + 5]), b1 = cvtpk(P[BASE + 6], P[BASE + 7]);                              \
    auto r0 = __builtin_amdgcn_permlane32_swap(a0, b0, false, false); auto r1 = __builtin_amdgcn_permlane32_swap(a1, b1, false, false); \
    u32x4 w = {r0[0], r1[0], r0[1], r1[1]}; OUT = *reinterpret_cast<bf16x8*>(&w); } while (0)
  PK4(p0, 0, pa0); PK4(p0, 8, pa1); PK4(p1, 0, pa2); PK4(p1, 8, pa3);
#undef PK4
}
__device__ __forceinline__ void qkt(f32x16& p0, f32x16& p1, const LAS char* Ks, const bf16x8* qr, int r32, int hi) {
  p0 = f32x16{}; p1 = f32x16{};
  for (int d0 = 0; d0 < 8; ++d0) { int cb = (d0 * 16 + hi * 8) * 2;
    bf16x8 b0 = *reinterpret_cast<const LAS bf16x8*>(Ks + KSWZ(r32, cb));
    bf16x8 b1 = *reinterpret_cast<const LAS bf16x8*>(Ks + KSWZ(32 + r32, cb));
    p0 = __builtin_amdgcn_mfma_f32_32x32x16_bf16(b0, qr[d0], p0, 0, 0, 0);
    p1 = __builtin_amdgcn_mfma_f32_32x32x16_bf16(b1, qr[d0], p1, 0, 0, 0); }
}
__device__ __forceinline__ int v_st(int k, int c) { const int kk = (k & ~0xC) | ((k & 4) << 1) | ((k & 8) >> 1); return ((kk >> 3) * 4 + (c >> 5)) * 512 + ((kk & 7) * 32 + (c & 31)) * 2; }
__device__ __forceinline__ int v_rd_base(int lane) { return ((lane & 3) << 3) | (((lane >> 2) & 3) << 6) | (((lane >> 4) & 1) << 5) | (((lane >> 5) & 1) << 8); }
constexpr int v_rd_off(int d0, int ks, int half) { return d0 * 512 + ks * 4096 + half * 2048; }
template <int OFF> __device__ __forceinline__ s16x4 tr_read(int vb) {
  s16x4 r; asm volatile("ds_read_b64_tr_b16 %0, %1 offset:%2" : "=&v"(r) : "v"(vb), "i"(OFF) : "memory"); return r;
}
template <int D0> __device__ __forceinline__ void pv_one(f32x16& od, int vb, bf16x8 pa0, bf16x8 pa1, bf16x8 pa2, bf16x8 pa3) {
  const s16x4 l0 = tr_read<v_rd_off(D0, 0, 0)>(vb), h0 = tr_read<v_rd_off(D0, 0, 1)>(vb), l1 = tr_read<v_rd_off(D0, 1, 0)>(vb), h1 = tr_read<v_rd_off(D0, 1, 1)>(vb);
  const s16x4 l2 = tr_read<v_rd_off(D0, 2, 0)>(vb), h2 = tr_read<v_rd_off(D0, 2, 1)>(vb), l3 = tr_read<v_rd_off(D0, 3, 0)>(vb), h3 = tr_read<v_rd_off(D0, 3, 1)>(vb);
  asm volatile("s_waitcnt lgkmcnt(0)" ::: "memory"); SBAR();
#define PK(L, H) (bf16x8){L[0], L[1], L[2], L[3], H[0], H[1], H[2], H[3]}
  od = __builtin_amdgcn_mfma_f32_32x32x16_bf16(pa0, PK(l0, h0), od, 0, 0, 0);
  od = __builtin_amdgcn_mfma_f32_32x32x16_bf16(pa1, PK(l1, h1), od, 0, 0, 0);
  od = __builtin_amdgcn_mfma_f32_32x32x16_bf16(pa2, PK(l2, h2), od, 0, 0, 0);
  od = __builtin_amdgcn_mfma_f32_32x32x16_bf16(pa3, PK(l3, h3), od, 0, 0, 0);
#undef PK
}
__device__ __forceinline__ void pv_d0(f32x16* o, int vb, bf16x8 pa0, bf16x8 pa1, bf16x8 pa2, bf16x8 pa3) {
  pv_one<0>(o[0], vb, pa0, pa1, pa2, pa3); pv_one<1>(o[1], vb, pa0, pa1, pa2, pa3); pv_one<2>(o[2], vb, pa0, pa1, pa2, pa3); pv_one<3>(o[3], vb, pa0, pa1, pa2, pa3);
}

template <int LDQ, int LDK, int LDO>
__device__ __forceinline__ void attn_dense_body(const bf16_t* __restrict__ Qb, const bf16_t* __restrict__ Kh, const bf16_t* __restrict__ Vh, bf16_t* __restrict__ Ob, int seq, LAS char* lds, int tid, float kmax2) {
  const int wid = tid >> 6, lane = tid & 63, r32 = lane & 31, hi = lane >> 5;
  LAS char* V_lds = lds; LAS char* K_lds = lds + 2 * SHM_V;
  LAS float* ws = (LAS float*)(lds + 2 * SHM_V + 2 * SHM_K) + wid * 64; LAS float* li_l = ws;
  float l_reg = 0; f32x16 o[4] = {}; bf16x8 qr[8];
  const bf16_t* Qw = Qb + (long)(wid * QBLK + r32) * LDQ + hi * 8;
#pragma unroll
  for (int d0 = 0; d0 < 8; ++d0) qr[d0] = *reinterpret_cast<const bf16x8*>(Qw + d0 * 16);
  float negMC;
  { float q2 = 0.f;
#pragma unroll
    for (int d0 = 0; d0 < 8; ++d0) { const u32x4 w = __builtin_bit_cast(u32x4, qr[d0]);
      q2 += bflo(w.x) * bflo(w.x) + bfhi(w.x) * bfhi(w.x) + bflo(w.y) * bflo(w.y) + bfhi(w.y) * bfhi(w.y) + bflo(w.z) * bflo(w.z) + bfhi(w.z) * bfhi(w.z) + bflo(w.w) * bflo(w.w) + bfhi(w.w) * bfhi(w.w); }
    auto rr = __builtin_amdgcn_permlane32_swap(__float_as_uint(q2), __float_as_uint(q2), false, false);
    q2 = __uint_as_float(rr[0]) + __uint_as_float(rr[1]);
    negMC = -(sqrtf(q2 * kmax2) * (SCALE * 1.0001f) - 30.0f) * 1.4426950408889634f; }
  const int sr = tid >> 4, sc = (tid & 15) * 8, vst0 = v_st(sr, sc), vst1 = v_st(32 + sr, sc);
  const int vb0 = (int)(uintptr_t)V_lds + v_rd_base(lane);
  struct { bf16x8 vs0, vs1, ks0, ks1; } sr_[2];
#define SLOAD(i, k0) do { sr_[i].vs0 = *reinterpret_cast<const bf16x8*>(&Vh[(long)((k0) + sr) * LDK + sc]); sr_[i].vs1 = *reinterpret_cast<const bf16x8*>(&Vh[(long)((k0) + 32 + sr) * LDK + sc]); \
    sr_[i].ks0 = *reinterpret_cast<const bf16x8*>(&Kh[(long)((k0) + sr) * LDK + sc]); sr_[i].ks1 = *reinterpret_cast<const bf16x8*>(&Kh[(long)((k0) + 32 + sr) * LDK + sc]); } while (0)
#define SWRITE(b, i) do { *(LAS bf16x8*)(V_lds + (b) * SHM_V + vst0) = sr_[i].vs0;          \
    *(LAS bf16x8*)(V_lds + (b) * SHM_V + vst1) = sr_[i].vs1; int kc = sc * 2;               \
    *(LAS bf16x8*)(K_lds + (b) * SHM_K + KSWZ(sr, kc)) = sr_[i].ks0;                       \
    *(LAS bf16x8*)(K_lds + (b) * SHM_K + KSWZ(32 + sr, kc)) = sr_[i].ks1; } while (0)
#define SWAIT() asm volatile("s_waitcnt vmcnt(4)" ::: "memory")
  f32x16 pA0, pA1, pB0, pB1; bf16x8 pa0, pa1, pa2, pa3; const int NT = seq / KVBLK;
  constexpr int SE = 0, SO = 1;
  SLOAD(SE, 0); asm volatile("s_waitcnt vmcnt(0)" ::: "memory"); SWRITE(0, SE); __syncthreads();
  qkt(pA0, pA1, K_lds, qr, r32, hi); partialSM(pA0, pA1, negMC);
  SLOAD(SO, KVBLK); if (2 < NT) SLOAD(SE, 2 * KVBLK);
  SWAIT(); SWRITE(1, SO); __syncthreads();
  for (int j = 1; j + 1 < NT; j += 2) {
    SBAR(); qkt(pB0, pB1, K_lds + SHM_K, qr, r32, hi);
    finishSM(pA0, pA1, l_reg, pa0, pa1, pa2, pa3); SBAR();
    SLOAD(SO, (j + 2) * KVBLK); SBAR();
    pv_d0(o, vb0, pa0, pa1, pa2, pa3); partialSM(pB0, pB1, negMC);
    __syncthreads(); SWAIT(); SWRITE(0, SE);
    __syncthreads();
    SBAR(); qkt(pA0, pA1, K_lds, qr, r32, hi);
    finishSM(pB0, pB1, l_reg, pa0, pa1, pa2, pa3); SBAR();
    if (j + 3 < NT) SLOAD(SE, (j + 3) * KVBLK); SBAR();
    pv_d0(o, vb0 + (int)SHM_V, pa0, pa1, pa2, pa3); partialSM(pA0, pA1, negMC);
    __syncthreads(); SWAIT(); SWRITE(1, SO);
    __syncthreads();
  }
  SBAR(); qkt(pB0, pB1, K_lds + SHM_K, qr, r32, hi);
  finishSM(pA0, pA1, l_reg, pa0, pa1, pa2, pa3); SBAR();
  pv_d0(o, vb0, pa0, pa1, pa2, pa3); partialSM(pB0, pB1, negMC);
  __syncthreads();
  finishSM(pB0, pB1, l_reg, pa0, pa1, pa2, pa3); SBAR();
  pv_d0(o, vb0 + (int)SHM_V, pa0, pa1, pa2, pa3);
  if (hi == 0) li_l[r32] = l_reg; asm volatile("s_waitcnt lgkmcnt(0)" ::: "memory");
  float rli[16];
#pragma unroll
  for (int r = 0; r < 16; ++r) rli[r] = __builtin_amdgcn_rcpf(li_l[crow(r, hi)]);
  bf16_t* Ow = Ob + (long)(wid * QBLK) * LDO;
#pragma unroll
  for (int r = 0; r < 16; ++r) { int orow = crow(r, hi);
    for (int d0 = 0; d0 < 4; ++d0) Ow[(long)orow * LDO + d0 * 32 + r32] = (bf16_t)(cvtpk(o[d0][r] * rli[r], 0.f) & 0xffffu); }
#undef SLOAD
#undef SWRITE
#undef SWAIT
}

typedef int v8i32a __attribute__((ext_vector_type(8)));
typedef int v4i32a __attribute__((ext_vector_type(4)));
#define KSW8(row, chunk) ((row) * 128 + ((((chunk) ^ (((row) >> 1) & 7))) << 4))
#define VSW8(d, chunk) ((d) * 64 + ((((chunk) ^ (((d) >> 2) & 3))) << 4))
#define MFMA8(a, b, c) __builtin_amdgcn_mfma_scale_f32_32x32x64_f8f6f4((a), (b), (c), 0, 0, 0, 0, 0, 0)
__device__ __forceinline__ v8i32a ld32_l(const LAS char* p0, const LAS char* p1) { return __builtin_shufflevector(*(const LAS v4i32a*)p0, *(const LAS v4i32a*)p1, 0, 1, 2, 3, 4, 5, 6, 7); }
__device__ __forceinline__ unsigned pk4f8(float a, float b, float c, float d) { unsigned w = (unsigned)__builtin_amdgcn_cvt_pk_fp8_f32(a, b, 0, false); return (unsigned)__builtin_amdgcn_cvt_pk_fp8_f32(c, d, (int)w, true); }
typedef short v2s16 __attribute__((ext_vector_type(2)));
__device__ __forceinline__ int pk4f8s(float a, float b, float c, float d, int old, float sc) {
    v2s16 w = __builtin_bit_cast(v2s16, old); w = __builtin_amdgcn_cvt_scalef32_pk_fp8_f32(w, a, b, sc, false); w = __builtin_amdgcn_cvt_scalef32_pk_fp8_f32(w, c, d, sc, true); return __builtin_bit_cast(int, w); }
template <int LDO, int KSTR>
__device__ __forceinline__ void attn_dense8_body(const unsigned char* __restrict__ Q8b, const unsigned char* __restrict__ K8h, const unsigned char* __restrict__ VT8h, bf16_t* __restrict__ Ob, int seq, LAS char* lds, int tid, float kmax2) {
  const int wid = tid >> 6, lane = tid & 63, r32 = lane & 31, hi = lane >> 5;
  constexpr int RS = 6, PD = 4;
  LAS float* al_l = (LAS float*)(lds + RS * 16384) + wid * 32;
  f32x16 o[4] = {}; v8i32a qf[2];
  { const unsigned char* qp = Q8b + (size_t)(wid * QBLK + r32) * 1024 + 32 * hi;
    qf[0] = __builtin_shufflevector(*(const v4i32a*)qp, *(const v4i32a*)(qp + 16), 0, 1, 2, 3, 4, 5, 6, 7);
    qf[1] = __builtin_shufflevector(*(const v4i32a*)(qp + 64), *(const v4i32a*)(qp + 80), 0, 1, 2, 3, 4, 5, 6, 7); }
  (void)kmax2;
  float m_reg = 0.f; f32x16 osum = {}; v8i32a ones = {0x38383838, 0x38383838, 0x38383838, 0x38383838, 0x38383838, 0x38383838, 0x38383838, 0x38383838}; asm volatile("" : "+v"(ones));
#define PSM8(P0, P1, DL, CN, FIRST) do { float pmax = P0[0]; for (int r = 1; r < 16; ++r) pmax = fmaxf(pmax, P0[r]); for (int r = 0; r < 16; ++r) pmax = fmaxf(pmax, P1[r]); \
      { auto rr = __builtin_amdgcn_permlane32_swap(__float_as_uint(pmax), __float_as_uint(pmax), false, false); pmax = fmaxf(__uint_as_float(rr[0]), __uint_as_float(rr[1])); } \
      const float mf_ = floorf(pmax); const float mn = (FIRST) ? mf_ : (mf_ > m_reg ? mf_ : m_reg); DL = (FIRST) ? 0.f : mn - m_reg; m_reg = mn; CN = __builtin_amdgcn_exp2f(mn - 7.0f); \
      for (int r = 0; r < 16; ++r) P0[r] = __builtin_amdgcn_exp2f(P0[r]); } while (0)
#define RESC8(DL) do { if (__any((DL) > 0.f)) { if (hi == 0) al_l[r32] = __builtin_amdgcn_exp2f(-(DL)); asm volatile("s_waitcnt lgkmcnt(0)" ::: "memory"); \
      for (int d = 0; d < 4; ++d) for (int r = 0; r < 16; ++r) o[d][r] *= al_l[crow(r, hi)]; for (int r = 0; r < 16; ++r) osum[r] *= al_l[crow(r, hi)]; } } while (0)
  const unsigned kgo = (unsigned)((tid >> 3) * KSTR + 16 * ((tid & 7) ^ ((tid >> 4) & 7))), vgo = (unsigned)((tid >> 2) * 64 + 16 * ((tid & 3) ^ ((tid >> 4) & 3)));
  const unsigned ldw = (unsigned)wid * 1024u;
#define DMA8(slot, T_) do { __builtin_amdgcn_global_load_lds((const unsigned*)(K8h + (size_t)(T_) * (64 * KSTR) + kgo), (LAS unsigned*)(lds + (slot) * 16384 + ldw), 16, 0, 0); \
      __builtin_amdgcn_global_load_lds((const unsigned*)(VT8h + (size_t)(T_) * 8192 + vgo), (LAS unsigned*)(lds + (slot) * 16384 + 8192 + ldw), 16, 0, 0); } while (0)
#define DWAIT8() do { asm volatile("s_waitcnt vmcnt(6)\n\ts_waitcnt lgkmcnt(0)" ::: "memory"); __builtin_amdgcn_s_barrier(); asm volatile("" ::: "memory"); } while (0)
#define QK8(P0, P1, KB) do { P0 = f32x16{}; P1 = f32x16{}; _Pragma("unroll") for (int s = 0; s < 2; ++s) { \
      const v8i32a k0 = ld32_l((KB) + KSW8(r32, 4 * s + 2 * hi), (KB) + KSW8(r32, 4 * s + 2 * hi + 1)); \
      const v8i32a k1 = ld32_l((KB) + KSW8(32 + r32, 4 * s + 2 * hi), (KB) + KSW8(32 + r32, 4 * s + 2 * hi + 1)); \
      P0 = MFMA8(k0, qf[s], P0); P1 = MFMA8(k1, qf[s], P1); } } while (0)
#define FIN8(P0, P1, CN) do { for (int r = 0; r < 16; ++r) P1[r] = __builtin_amdgcn_exp2f(P1[r]); \
      _Pragma("unroll") for (int i = 0; i < 4; ++i) { pa[i] = pk4f8s(P0[4 * i], P0[4 * i + 1], P0[4 * i + 2], P0[4 * i + 3], pa[i], CN); pa[4 + i] = pk4f8s(P1[4 * i], P1[4 * i + 1], P1[4 * i + 2], P1[4 * i + 3], pa[4 + i], CN); } } while (0)
#define PV8(VB) do { _Pragma("unroll") for (int d0 = 0; d0 < 4; ++d0) { \
      const v8i32a vf = ld32_l((VB) + VSW8(32 * d0 + r32, 2 * hi), (VB) + VSW8(32 * d0 + r32, 2 * hi + 1)); \
      o[d0] = MFMA8(pa, vf, o[d0]); } osum = MFMA8(pa, ones, osum); } while (0)
#define LDK8(KB, s, half) ld32_l((KB) + KSW8(32 * (half) + r32, 4 * (s) + 2 * hi), (KB) + KSW8(32 * (half) + r32, 4 * (s) + 2 * hi + 1))
#define LDV8(VB, d0) ld32_l((VB) + VSW8(32 * (d0) + r32, 2 * hi), (VB) + VSW8(32 * (d0) + r32, 2 * hi + 1))
#define EXPN(P, r0, n, CN) do { _Pragma("unroll") for (int r = (r0); r < (r0) + (n); ++r) { float e_ = __builtin_amdgcn_exp2f(P[r]); asm volatile("" : "+v"(e_)); P[r] = e_; } } while (0)
#define FINP(P0, P1, CN, i) do { EXPN(P1, 4 * (i), 4, CN); \
      pa[i] = pk4f8s(P0[4 * (i)], P0[4 * (i) + 1], P0[4 * (i) + 2], P0[4 * (i) + 3], pa[i], CN); \
      pa[4 + (i)] = pk4f8s(P1[4 * (i)], P1[4 * (i) + 1], P1[4 * (i) + 2], P1[4 * (i) + 3], pa[4 + (i)], CN); } while (0)
#define PINA(x, y) asm volatile("" : "+v"(x), "+v"(y))
#define PIN1(x) asm volatile("" : "+v"(x))
#define PINC(x, y) asm volatile("" :: "v"(x), "v"(y))
#define HSTEP(X0, X1, DLX, CNX, Y0, Y1, CNY, KB, VB, STAGE_LOAD) do { \
      v8i32a ka_ = LDK8(KB, 0, 0), kb_ = LDK8(KB, 0, 1), kc_ = LDK8(KB, 1, 0), kd_ = LDK8(KB, 1, 1); \
      X0 = MFMA8(ka_, qf[0], f32x16{}); PINA(X0, kb_); \
      FINP(Y0, Y1, CNY, 0); PINC(pa[0], pa[4]); PIN1(kb_); \
      X1 = MFMA8(kb_, qf[0], f32x16{}); PINA(X1, kc_); \
      FINP(Y0, Y1, CNY, 1); PINC(pa[1], pa[5]); PIN1(kc_); \
      X0 = MFMA8(kc_, qf[1], X0); PINA(X0, kd_); \
      v8i32a v0_ = LDV8(VB, 0), v1_ = LDV8(VB, 1); \
      FINP(Y0, Y1, CNY, 2); STAGE_LOAD; PINC(pa[2], pa[6]); PIN1(kd_); \
      X1 = MFMA8(kd_, qf[1], X1); PINA(X1, v0_); \
      v8i32a v2_ = LDV8(VB, 2), v3_ = LDV8(VB, 3); \
      FINP(Y0, Y1, CNY, 3); PINC(pa[3], pa[7]); PINA(pa, v0_); \
      o[0] = MFMA8(pa, v0_, o[0]); PINA(o[0], v1_); \
      float pm0_ = X0[0]; _Pragma("unroll") for (int r = 1; r < 16; ++r) pm0_ = fmaxf(pm0_, X0[r]); PINA(pm0_, v1_); \
      o[1] = MFMA8(pa, v1_, o[1]); PINA(o[1], v2_); \
      _Pragma("unroll") for (int r = 0; r < 16; ++r) pm0_ = fmaxf(pm0_, X1[r]); \
      { auto rr = __builtin_amdgcn_permlane32_swap(__float_as_uint(pm0_), __float_as_uint(pm0_), false, false); pm0_ = fmaxf(__uint_as_float(rr[0]), __uint_as_float(rr[1])); } \
      { const float mf_ = floorf(pm0_); const float mn = mf_ > m_reg ? mf_ : m_reg; DLX = mn - m_reg; m_reg = mn; CNX = __builtin_amdgcn_exp2f(mn - 7.0f); } PINA(CNX, v2_); \
      o[2] = MFMA8(pa, v2_, o[2]); PINA(o[2], v3_); \
      EXPN(X0, 0, 5, CNX); PIN1(v3_); \
      o[3] = MFMA8(pa, v3_, o[3]); PINA(o[3], CNX); \
      EXPN(X0, 5, 5, CNX); PIN1(pa); \
      osum = MFMA8(pa, ones, osum); PINA(osum, CNX); \
      EXPN(X0, 10, 6, CNX); } while (0)
  f32x16 pA0, pA1, pB0, pB1; v8i32a pa = {}; float dlA, dlB, cnA, cnB; const int NT = seq / KVBLK;
#define SLOT(s) (lds + (s) * 16384)
#define SADV() do { sv = sk; sk = sk + 1 == RS ? 0 : sk + 1; sd = sd + 1 == RS ? 0 : sd + 1; } while (0)
  int sk = 0, sv = 0, sd = PD;
  DMA8(0, 0); DMA8(1, 1); DMA8(2, 2); DMA8(3, 3);
  DWAIT8();
  QK8(pA0, pA1, SLOT(0)); PSM8(pA0, pA1, dlA, cnA, true);
  DMA8(sd, PD); SADV(); DWAIT8();
  for (int j = 1; j + 1 < NT; j += 2) {
    HSTEP(pB0, pB1, dlB, cnB, pA0, pA1, cnA, SLOT(sk), SLOT(sv) + 8192, DMA8(sd, min(j + PD, NT - 1)));
    RESC8(dlB); SADV(); DWAIT8();
    HSTEP(pA0, pA1, dlA, cnA, pB0, pB1, cnB, SLOT(sk), SLOT(sv) + 8192, DMA8(sd, min(j + 1 + PD, NT - 1)));
    RESC8(dlA); SADV(); DWAIT8();
  }
  HSTEP(pB0, pB1, dlB, cnB, pA0, pA1, cnA, SLOT(sk), SLOT(sv) + 8192, (void)0);
  RESC8(dlB); SADV();
  FIN8(pB0, pB1, cnB); SBAR();
  PV8(SLOT(sv) + 8192);
  asm volatile("s_waitcnt vmcnt(0)" ::: "memory");
  float rli[16];
#pragma unroll
  for (int r = 0; r < 16; ++r) rli[r] = __builtin_amdgcn_rcpf(osum[r]);
  bf16_t* Ow = Ob + (long)(wid * QBLK) * LDO;
#pragma unroll
  for (int r = 0; r < 16; ++r) { int orow = crow(r, hi);
    for (int d0 = 0; d0 < 4; ++d0) Ow[(long)orow * LDO + d0 * 32 + r32] = (bf16_t)(cvtpk(o[d0][r] * rli[r], 0.f) & 0xffffu); }
#undef PSM8
#undef RESC8
#undef DMA8
#undef DWAIT8
#undef SLOT
#undef SADV
#undef QK8
#undef FIN8
#undef PV8
#undef HSTEP
#undef PINA
#undef PIN1
#undef PINC
#undef FINP
#undef EXPN
#undef LDK8
#undef LDV8
}

template <int LDO, int KSTR>
__device__ __forceinline__ void attn_dense8w_body(const unsigned char* __restrict__ Q8b, const unsigned char* __restrict__ K8h, const unsigned char* __restrict__ VT8h0, const unsigned char* __restrict__ VT8h1, bf16_t* __restrict__ Ob, int seq, LAS char* lds, int tid, float kmax2) {
  const int wid = tid >> 6, lane = tid & 63, r32 = lane & 31, hi = lane >> 5;
  constexpr int RS = 4, PD = 2, SB = 24576;
  LAS float* al_l = (LAS float*)(lds + RS * SB) + wid * 32;
  LAS char* q_l = lds + RS * SB + 2048 + wid * 4096 + lane * 16;
  { const unsigned char* qp = Q8b + (size_t)(wid * QBLK + r32) * 1024 + 32 * hi;
    *(LAS v4i32a*)(q_l) = *(const v4i32a*)qp; *(LAS v4i32a*)(q_l + 1024) = *(const v4i32a*)(qp + 16);
    *(LAS v4i32a*)(q_l + 2048) = *(const v4i32a*)(qp + 64); *(LAS v4i32a*)(q_l + 3072) = *(const v4i32a*)(qp + 80); }
  (void)kmax2;
  float l_reg = 0.f, m_reg = 0.f; f32x16 o[8] = {};
  const unsigned kgo = (unsigned)((tid >> 3) * KSTR + 16 * ((tid & 7) ^ ((tid >> 4) & 7))), vgo = (unsigned)((tid >> 2) * 64 + 16 * ((tid & 3) ^ ((tid >> 4) & 3)));
  const unsigned ldw = (unsigned)wid * 1024u;
#define DMA8(slot, T_) do { __builtin_amdgcn_global_load_lds((const unsigned*)(K8h + (size_t)(T_) * (64 * KSTR) + kgo), (LAS unsigned*)(lds + (slot) * SB + ldw), 16, 0, 0); \
      __builtin_amdgcn_global_load_lds((const unsigned*)(VT8h0 + (size_t)(T_) * 8192 + vgo), (LAS unsigned*)(lds + (slot) * SB + 8192 + ldw), 16, 0, 0); \
      __builtin_amdgcn_global_load_lds((const unsigned*)(VT8h1 + (size_t)(T_) * 8192 + vgo), (LAS unsigned*)(lds + (slot) * SB + 16384 + ldw), 16, 0, 0); } while (0)
#define DWAIT8() do { asm volatile("s_waitcnt vmcnt(3)\n\ts_waitcnt lgkmcnt(0)" ::: "memory"); __builtin_amdgcn_s_barrier(); asm volatile("" ::: "memory"); } while (0)
#define SLOT(s) (lds + (s) * SB)
#define SADV() do { sv = sk; sk = sk + 1 == RS ? 0 : sk + 1; sd = sd + 1 == RS ? 0 : sd + 1; } while (0)
#define LDK8(KB, s, half) ld32_l((KB) + KSW8(32 * (half) + r32, 4 * (s) + 2 * hi), (KB) + KSW8(32 * (half) + r32, 4 * (s) + 2 * hi + 1))
#define LDV8(VB, d0) ld32_l((VB) + VSW8(32 * (d0) + r32, 2 * hi), (VB) + VSW8(32 * (d0) + r32, 2 * hi + 1))
#define PIN1(x) asm volatile("" : "+v"(x))
#define EXPR(e0, n) do { _Pragma("unroll") for (int e = (e0); e < (e0) + (n); ++e) { float x_ = e < 16 ? X0[e & 15] : X1[e & 15]; float e_ = __builtin_amdgcn_exp2f(x_); asm volatile("" : "+v"(e_)); ps += e_; \
      if (e < 16) X0[e & 15] = e_; else X1[e & 15] = e_; } } while (0)
#define PKW(PAC, w) do { if ((w) < 4) PAC[w] = pk4f8s(X0[4 * ((w) & 3)], X0[4 * ((w) & 3) + 1], X0[4 * ((w) & 3) + 2], X0[4 * ((w) & 3) + 3], PAC[w], cn); \
      else PAC[w] = pk4f8s(X1[4 * ((w) & 3)], X1[4 * ((w) & 3) + 1], X1[4 * ((w) & 3) + 2], X1[4 * ((w) & 3) + 3], PAC[w], cn); } while (0)
#define PVM(PAP, g) do { PIN1(vv##g); o[4 * ((g) & 1) + ((g) >> 1)] = MFMA8(PAP, vv##g, o[4 * ((g) & 1) + ((g) >> 1)]); asm volatile("" :: "v"(o[4 * ((g) & 1) + ((g) >> 1)])); } while (0)
#define LDVG(g) ({ int o_ = sv * SB + 8192 + 8192 * ((g) & 1); asm volatile("" : "+s"(o_)); LDV8(lds + o_, (g) >> 1); })
#define WSTEP(PAP, PAC, FIRST, TNEXT) do { \
      { const v8i32a ka_ = LDK8(SLOT(sk), 0, 0), kb_ = LDK8(SLOT(sk), 0, 1), kc_ = LDK8(SLOT(sk), 1, 0), kd_ = LDK8(SLOT(sk), 1, 1); \
        const v8i32a q0_ = ld32_l(q_l, q_l + 1024), q1_ = ld32_l(q_l + 2048, q_l + 3072); \
        X0 = MFMA8(ka_, q0_, f32x16{}); X1 = MFMA8(kb_, q0_, f32x16{}); X0 = MFMA8(kc_, q1_, X0); X1 = MFMA8(kd_, q1_, X1); PIN1(X1); } \
      DMA8(sd, TNEXT); \
      v8i32a vv0 = LDVG(0), vv1 = LDVG(1); \
      PVM(PAP, 0); v8i32a vv2 = LDVG(2); \
      float pm_ = X0[0]; _Pragma("unroll") for (int r = 1; r < 16; ++r) pm_ = fmaxf(pm_, X0[r]); PIN1(pm_); \
      PVM(PAP, 1); v8i32a vv3 = LDVG(3); \
      _Pragma("unroll") for (int r = 0; r < 16; ++r) pm_ = fmaxf(pm_, X1[r]); \
      { auto rr = __builtin_amdgcn_permlane32_swap(__float_as_uint(pm_), __float_as_uint(pm_), false, false); pm_ = fmaxf(__uint_as_float(rr[0]), __uint_as_float(rr[1])); } \
      const float mf_ = floorf(pm_); const float mn_ = (FIRST) ? mf_ : (mf_ > m_reg ? mf_ : m_reg); const float dl_ = (FIRST) ? 0.f : mn_ - m_reg; m_reg = mn_; \
      float cn = __builtin_amdgcn_exp2f(mn_ - 7.0f); const float isc_ = __builtin_amdgcn_exp2f(7.0f - mn_); float ps = 0.f; PIN1(cn);        \
      PVM(PAP, 2); v8i32a vv4 = LDVG(4); EXPR(0, 6); PKW(PAC, 0); \
      PVM(PAP, 3); v8i32a vv5 = LDVG(5); EXPR(6, 6); PKW(PAC, 1); PKW(PAC, 2); \
      PVM(PAP, 4); v8i32a vv6 = LDVG(6); EXPR(12, 5); PKW(PAC, 3); \
      PVM(PAP, 5); v8i32a vv7 = LDVG(7); EXPR(17, 5); PKW(PAC, 4); \
      PVM(PAP, 6); EXPR(22, 5); PKW(PAC, 5); \
      PVM(PAP, 7); EXPR(27, 5); PKW(PAC, 6); PKW(PAC, 7); \
      { auto rr = __builtin_amdgcn_permlane32_swap(__float_as_uint(ps), __float_as_uint(ps), false, false); ps = __uint_as_float(rr[0]) + __uint_as_float(rr[1]); } \
      if (__any(dl_ > 0.f)) { const float al_ = __builtin_amdgcn_exp2f(-dl_); l_reg *= al_; if (hi == 0) al_l[r32] = al_; asm volatile("s_waitcnt lgkmcnt(0)" ::: "memory"); \
        for (int d = 0; d < 8; ++d) for (int r = 0; r < 16; ++r) o[d][r] *= al_l[crow(r, hi)]; } \
      l_reg += ps * isc_;                    \
      SADV(); DWAIT8(); } while (0)
  f32x16 X0, X1; v8i32a paA = {}, paB = {}; const int NT = seq / KVBLK;
  int sk = 0, sv = 0, sd = PD;
  DMA8(0, 0); DMA8(1, 1);
  DWAIT8();
  for (int j = 0; j < NT; j += 2) {
    WSTEP(paB, paA, j == 0, min(j + PD, NT - 1));
    WSTEP(paA, paB, false, min(j + 1 + PD, NT - 1));
  }
  { v8i32a vv0 = LDVG(0), vv1 = LDVG(1), vv2 = LDVG(2), vv3 = LDVG(3); PVM(paB, 0); PVM(paB, 1); PVM(paB, 2); PVM(paB, 3); }
  { v8i32a vv4 = LDVG(4), vv5 = LDVG(5), vv6 = LDVG(6), vv7 = LDVG(7); PVM(paB, 4); PVM(paB, 5); PVM(paB, 6); PVM(paB, 7); }
  asm volatile("s_waitcnt vmcnt(0)" ::: "memory");
  int te = tid; asm volatile("" : "+v"(te));
  const int wid_e = te >> 6, r32_e = te & 31, hi_e = (te >> 5) & 1;
  LAS float* li_e = (LAS float*)(lds + RS * SB + 1024) + wid_e * 32;
  if (hi_e == 0) li_e[r32_e] = l_reg; asm volatile("s_waitcnt lgkmcnt(0)" ::: "memory");
  float rli[16];
#pragma unroll
  for (int r = 0; r < 16; ++r) rli[r] = __builtin_amdgcn_rcpf(li_e[crow(r, hi_e)]);
  bf16_t* Ow = Ob + (long)(wid_e * QBLK) * LDO;
#pragma unroll
  for (int r = 0; r < 16; ++r) { int orow = crow(r, hi_e);
    for (int d0 = 0; d0 < 8; ++d0) Ow[(long)orow * LDO + d0 * 32 + r32_e] = (bf16_t)(cvtpk(o[d0][r] * rli[r], 0.f) & 0xffffu); }
#undef DMA8
#undef DWAIT8
#undef SLOT
#undef SADV
#undef LDK8
#undef LDV8
#undef PIN1
#undef EXPR
#undef PKW
#undef PVM
#undef LDVG
#undef WSTEP
}

constexpr int PV_BUF = 32768, PK_BUF = 16384, P_LDS_V = 0, P_LDS_K = 2 * PV_BUF, P_LDS_X = P_LDS_K + 2 * PK_BUF, P_LDS_L = P_LDS_X + 8 * 2048, P_LDS_END = P_LDS_L + 1024;
__device__ __forceinline__ void qkt_half(f32x16& p, const LAS char* Ks, const bf16x8* qr, int krow, int hi) {
  p = f32x16{};
  for (int d0 = 0; d0 < 8; ++d0) { int cb = (d0 * 16 + hi * 8) * 2;
    bf16x8 b0 = *reinterpret_cast<const LAS bf16x8*>(Ks + KSWZ(krow, cb));
    p = __builtin_amdgcn_mfma_f32_32x32x16_bf16(b0, qr[d0], p, 0, 0, 0); }
}
__device__ __forceinline__ void smA(f32x16& p, float negMC) {
  constexpr float Cc = SCALE * 1.4426950408889634f;
  for (int r = 0; r < 16; ++r) p[r] = fmaf(p[r], Cc, negMC);
  for (int r = 0; r < 8; ++r) p[r] = __builtin_amdgcn_exp2f(p[r]);
}
__device__ __forceinline__ void smB(f32x16& p, float& l_reg, bf16x8& f0, bf16x8& f1) {
  for (int r = 8; r < 16; ++r) p[r] = __builtin_amdgcn_exp2f(p[r]);
  float ps = 0; for (int r = 0; r < 16; ++r) ps += p[r];
  { auto rr = __builtin_amdgcn_permlane32_swap(__float_as_uint(ps), __float_as_uint(ps), false, false);
    ps = __uint_as_float(rr[0]) + __uint_as_float(rr[1]); }
  l_reg += ps;
#define PK4(P, BASE, OUT) do { unsigned a0 = cvtpk(P[BASE + 0], P[BASE + 1]), a1 = cvtpk(P[BASE + 2], P[BASE + 3]);   \
    unsigned b0 = cvtpk(P[BASE + 4], P[BASE + 5]), b1 = cvtpk(P[BASE + 6], P[BASE + 7]);                              \
    auto r0 = __builtin_amdgcn_permlane32_swap(a0, b0, false, false); auto r1 = __builtin_amdgcn_permlane32_swap(a1, b1, false, false); \
    u32x4 w = {r0[0], r1[0], r0[1], r1[1]}; OUT = *reinterpret_cast<bf16x8*>(&w); } while (0)
  PK4(p, 0, f0); PK4(p, 8, f1);
#undef PK4
}
template <int LDQ, int LDK, int LDO>
__device__ __forceinline__ void attn_pair_body(const bf16_t* __restrict__ Qb, const bf16_t* __restrict__ Kh, const bf16_t* __restrict__ Vh, bf16_t* __restrict__ Ob, int seq, LAS char* lds, int tid, float kmax2) {
  const int wid = __builtin_amdgcn_readfirstlane(tid >> 6), lane = tid & 63, r32 = lane & 31, hi = lane >> 5, g = wid & 3, kb = wid >> 2;
  LAS char* V_lds = lds + P_LDS_V; LAS char* K_lds = lds + P_LDS_K;
  LAS char* xp_own = lds + P_LDS_X + wid * 2048 + lane * 16; LAS char* xp_par = lds + P_LDS_X + (wid ^ 4) * 2048 + lane * 16;
  LAS float* li = (LAS float*)(lds + P_LDS_L);
  float l_reg = 0; f32x16 o[4] = {}; bf16x8 qr[8];
  const bf16_t* Qw = Qb + (long)(g * QBLK + r32) * LDQ + hi * 8;
#pragma unroll
  for (int d0 = 0; d0 < 8; ++d0) qr[d0] = *reinterpret_cast<const bf16x8*>(Qw + d0 * 16);
  float negMC;
  { float q2 = 0.f;
#pragma unroll
    for (int d0 = 0; d0 < 8; ++d0) { const u32x4 w = __builtin_bit_cast(u32x4, qr[d0]);
      q2 += bflo(w.x) * bflo(w.x) + bfhi(w.x) * bfhi(w.x) + bflo(w.y) * bflo(w.y) + bfhi(w.y) * bfhi(w.y) + bflo(w.z) * bflo(w.z) + bfhi(w.z) * bfhi(w.z) + bflo(w.w) * bflo(w.w) + bfhi(w.w) * bfhi(w.w); }
    auto rr = __builtin_amdgcn_permlane32_swap(__float_as_uint(q2), __float_as_uint(q2), false, false);
    q2 = __uint_as_float(rr[0]) + __uint_as_float(rr[1]);
    negMC = -(sqrtf(q2 * kmax2) * (SCALE * 1.0001f) - 30.0f) * 1.4426950408889634f; }
  const int sr = tid >> 4, sc = (tid & 15) * 8, vst0 = v_st(sr, sc), vst1 = v_st(32 + sr, sc);
  const int vrd = (int)(uintptr_t)V_lds + kb * 16384 + v_rd_base(lane);
  const int krow = 32 * kb + r32;
  struct { bf16x8 v00, v01, v10, v11, k0, k1; } st_;
#define PLD16(base, off) (*reinterpret_cast<const bf16x8*>((const char*)(base) + (off)))
#define PLOAD(k0_) do { const unsigned o_ = (unsigned)(((k0_) + sr) * LDK + sc) * 2u; \
    st_.v00 = PLD16(Vh, o_); st_.v01 = PLD16(Vh, o_ + 256u); st_.v10 = PLD16(Vh, o_ + 64u * LDK); st_.v11 = PLD16(Vh, o_ + 64u * LDK + 256u); \
    st_.k0 = PLD16(Kh, o_); st_.k1 = PLD16(Kh, o_ + 64u * LDK); } while (0)
#define PWRITE(kbuf, vbuf) do { LAS char* vb_ = V_lds + (vbuf) * PV_BUF; LAS char* kb_ = K_lds + (kbuf) * PK_BUF; const int kc = sc * 2; \
    *(LAS bf16x8*)(vb_ + vst0) = st_.v00; *(LAS bf16x8*)(vb_ + 16384 + vst0) = st_.v01; *(LAS bf16x8*)(vb_ + vst1) = st_.v10; *(LAS bf16x8*)(vb_ + 16384 + vst1) = st_.v11; \
    *(LAS bf16x8*)(kb_ + KSWZ(sr, kc)) = st_.k0; *(LAS bf16x8*)(kb_ + KSWZ(32 + sr, kc)) = st_.k1; } while (0)
  const int NT = seq / KVBLK;
  f32x16 pS; bf16x8 f0, f1, g0, g1;
  PLOAD(0); asm volatile("s_waitcnt vmcnt(0)" ::: "memory"); PWRITE(0, 0); PLOAD(KVBLK);
  __syncthreads();
  for (int j = 0; j < NT; ++j) {
    SBAR();
    qkt_half(pS, K_lds + (j & 1) * PK_BUF, qr, krow, hi);
    smA(pS, negMC); smB(pS, l_reg, f0, f1); SBAR();
    *(LAS bf16x8*)(xp_own) = f0; *(LAS bf16x8*)(xp_own + 1024) = f1;
    if (j + 1 < NT) PWRITE((j + 1) & 1, (j + 1) & 1);
    if (j + 2 < NT) PLOAD((j + 2) * KVBLK);
    __syncthreads();
    g0 = *(const LAS bf16x8*)(xp_par); g1 = *(const LAS bf16x8*)(xp_par + 1024);
    { const int vb = vrd + (j & 1) * PV_BUF;
      if (kb == 0) pv_d0(o, vb, f0, f1, g0, g1); else pv_d0(o, vb, g0, g1, f0, f1); }
    __syncthreads();
  }
  if (hi == 0) li[wid * 32 + r32] = l_reg;
  __syncthreads();
#pragma unroll
  for (int r = 0; r < 16; ++r) { const int orow = crow(r, hi); const float rl = __builtin_amdgcn_rcpf(li[wid * 32 + orow] + li[(wid ^ 4) * 32 + orow]);
    bf16_t* op = Ob + (long)(g * QBLK + orow) * LDO + 128 * kb + r32;
    for (int d0 = 0; d0 < 4; ++d0) op[d0 * 32] = (bf16_t)(cvtpk(o[d0][r] * rl, 0.f) & 0xffffu); }
#undef PLD16
#undef PLOAD
#undef PWRITE
}
#undef KSWZ
}

__device__ __forceinline__ void phase_attention(const Params& p, Ctx& C) {
    bf16_t* ATT = (bf16_t*)(p.ws + WS_BIG + BG_ATT);
    const unsigned char* Q8 = (const unsigned char*)(p.ws + WS_BIG + BG_Q8); const unsigned char* K8 = (const unsigned char*)(p.ws + WS_BIG + BG_K8); const unsigned char* VT8 = (const unsigned char*)(p.ws + WS_BIG + BG_VT8);
    const unsigned char* Q8D = (const unsigned char*)(p.ws + WS_BIG + BG_Q8D); const unsigned char* K8D = (const unsigned char*)(p.ws + WS_BIG + BG_K8D); const unsigned char* VT8D = (const unsigned char*)(p.ws + WS_BIG + BG_VT8D);
    for (int i = 0;; ++i) {
        int unit;
        if (C.G == 256) { if (i >= 2) break; unit = (C.bid & 7) * 64 + i * 32 + (C.bid >> 3); } else { unit = i * C.G + C.bid; if (unit >= 512) break; }
        const int d = unit >> 6, qb = unit & 63, hh = d >> 1, m = d & 1;
        __syncthreads();
        int tz = C.tid; asm volatile("" : "+v"(tz));
        att::attn_dense8w_body<3072, 1024>(Q8D + (size_t)(CTXL + 256 * qb) * 1024 + 128 * d, K8D + 128 * d, VT8D + (size_t)(2 * hh) * 260 * 8192, VT8D + (size_t)(2 * hh + 1) * 260 * 8192,
                                           ATT + (size_t)(256 * qb) * 3072 + 1024 + 1024 * m + 256 * hh, TT, (LAS char*)C.lds, tz, 0.f);
    }
    for (int i = 0;; ++i) {
        int unit;
        if (C.G == 256) { if (i >= 2) break; unit = (C.bid & 7) * 64 + i * 32 + (C.bid >> 3); } else { unit = i * C.G + C.bid; if (unit >= 512) break; }
        const int prob = unit >> 6, qb = unit & 63;
        __syncthreads();
        int tz = C.tid; asm volatile("" : "+v"(tz));
        att::attn_dense8_body<3072, 256>(Q8 + (size_t)(CTXL + 256 * qb) * 1024 + 128 * prob, K8 + 128 * (prob >> 2), VT8 + (size_t)(prob >> 2) * 260 * 8192,
                                         ATT + (size_t)(256 * qb) * 3072 + 128 * prob, TT, (LAS char*)C.lds, tz, 0.f);
    }
    __syncthreads();
}
constexpr int PH_PER_LAYER = 13, N_PHASES = 2 + 2 * PH_PER_LAYER;
#ifndef DBL_PHASE
#define DBL_PHASE -1
#endif
#ifndef MK_PER_PHASE
#define MK_PER_PHASE 0
#endif

template <int L>
__device__ __forceinline__ void layer_body(const Params& p, Ctx& C0, const XcdBarrier& bar, LAS unsigned char* misc, int lo, int hi) {
#define IN(k) (lo <= (k) && (k) < hi)
#define SEAM(k) do { if (IN(k) && IN((k) + 1)) xcd_barrier(bar, C0.wave); } while (0)
#define PHASE(k, ...) if (DBL_PHASE == (k)) { int nrep_ = 2; asm volatile("" : "+s"(nrep_)); for (int rep_ = 0; rep_ < nrep_; ++rep_) { if (rep_) xcd_barrier(bar, C0.wave); FRESH(); __VA_ARGS__ } } else if (IN(k)) { FRESH(); __VA_ARGS__ } SEAM(k);
#define FRESH() Ctx C = C0; { int ln = (int)__builtin_amdgcn_mbcnt_hi(~0u, __builtin_amdgcn_mbcnt_lo(~0u, 0u)); asm volatile("" : "+v"(ln)); C.lane = ln; C.tid = C.wave * 64 + ln; }
        const int b = 2 + PH_PER_LAYER * L;
        bf16_t* QKV = (bf16_t*)(p.ws + WS_BIG + BG_QKV);
        bf16_t* XA = (bf16_t*)(p.ws + WS_XA);
        int* cnt = (int*)(p.ws + WS_CTL) + CW_CNT + L * 128; const int* LIST = (const int*)(p.ws + WS_LIST);
        if (L == 0) { PHASE(b + 0, phase_modulate(p, C, L); ) }
        PHASE(b + 1,
            const int N = L ? OD_IN : EV_IN;
            pg8::DenseOrder S; S.init8((const void*)XA, DM, (const void*)(p.ws + (L ? WS_WIN1 : WS_WIN0)), TT, N, DM, C.G, C.bid);
            pg8::EpiStore E{QKV, N, 1.0f / 32.0f};
            pg8::gemm_phase<true>(C.lds, S, E, C.wave);
            if (L == 0 && IN(b + 2) && S.units_of_me() < S.max_units()) conv_queue(p, C, 2);
        )
        PHASE(b + 2, if (L == 0) phase_rope0(p, C); else phase_normrope1(p, C); )
        PHASE(b + 3, if (L == 0) { ret_chunk_kv(p, C); s5_end_states(p, C); } else phase_attention(p, C); )
        PHASE(b + 4, if (L == 0) phase_scans(p, C); else phase_merge1(p, C); )
        if (L == 0) {
            PHASE(b + 5, phase_ret_s5_outputs(p, C, misc); )
            PHASE(b + 6,
                pg8::DenseOrder S; S.init((const bf16_t*)(p.ws + WS_Z), 1024, (const bf16_t*)(p.ws + WS_WGLU), TT, 1024, 1024, C.G, C.bid);
                pg8::EpiGlu E{(const bf16_t*)(p.ws + WS_Z), p.inp(20), (bf16_t*)(p.ws + WS_BIG + BG_MIX)};
                pg8::gemm_phase<false>(C.lds, S, E, C.wave);
                if (IN(b + 7) && S.units_of_me() < S.max_units()) conv_queue(p, C, 4);
            )
        }
        PHASE(b + 7,
            pg8::DenseOrder S;
            if (L == 0) S.init((const bf16_t*)(p.ws + WS_BIG + BG_MIX), DM, (const bf16_t*)(p.ws + WS_WOUT0), TT, DM, DM, C.G, C.bid);
            else S.init((const bf16_t*)(p.ws + WS_BIG + BG_ATT), 3072, (const bf16_t*)(p.ws + WS_WOUT1), SEQ, DM, DM, C.G, C.bid);
            pg8::EpiStore E{(bf16_t*)(p.ws + WS_YMIX) + (L ? (size_t)CTXL * DM : 0), DM, 1.0f};
            pg8::gemm_phase<false>(C.lds, S, E, C.wave);
            if (L == 0 && IN(b + 8) && S.units_of_me() < S.max_units()) conv_queue(p, C, 5);
        )
        PHASE(b + 8, phase_ln1(p, C, L); )
        PHASE(b + 9, phase_router(p, C, L); )
        PHASE(b + 10,
            pg8::MoeOrder<0> S; S.A = (const void*)XA; S.Bt = (const void*)(p.ws + WS_GU + (size_t)L * NEX1 * 1024 * DM); S.list = LIST; S.cnt = cnt; S.ldab = DM; S.kb = DM; S.nN = 4; S.G = C.G; S.c = C.bid; S.bstride = (size_t)1024 * DM;
            S.prep(misc, C.tid);
            pg8::EpiE1 E{(unsigned char*)(p.ws + WS_HX2), S.cn, S.rb};
            pg8::gemm_phase<true>(C.lds, S, E, C.wave);
        )
        PHASE(b + 11,
            pg8::MoeOrder<1> S; S.A = (const void*)(p.ws + WS_HX2); S.Bt = (const void*)(p.ws + WS_DT + (size_t)L * NEX1 * DM * EHID); S.list = LIST; S.cnt = cnt; S.ldab = EHID; S.kb = EHID; S.nN = 8; S.G = C.G; S.c = C.bid; S.bstride = (size_t)DM * EHID;
            S.prep(misc, C.tid);
            pg8::EpiE2 E{(unsigned char*)(p.ws + WS_BIG + BG_YMOE), (const float*)(p.ws + WS_LW), S.cn, S.rb};
            pg8::gemm_phase<true>(C.lds, S, E, C.wave);
        )
        PHASE(b + 12, phase_combine(p, C, L, misc); )
    #undef IN
#undef SEAM
#undef FRESH
#undef PHASE
}

__global__ void __launch_bounds__(NTHR, 2) mega_fwd(KArgs ka) {
    extern __shared__ __attribute__((aligned(16))) unsigned char lds_raw[];
    Ctx C;
    C.lds = (LAS unsigned char*)lds_raw;
    C.tid = threadIdx.x; C.lane = C.tid & 63; C.wave = __builtin_amdgcn_readfirstlane(C.tid >> 6);
    C.G = gridDim.x; C.bid = blockIdx.x; C.gw = C.bid * NWAVES + C.wave; C.ngw = C.G * NWAVES;
    LAS unsigned char* misc = C.lds + MISC_OFF;
    if (C.tid < 8) ((volatile LAS unsigned*)misc)[C.tid] = 0u;
    Params p; p.out = ka.out; p.ws = ka.ws; p.ph_lo = ka.ph_lo; p.ph_hi = ka.ph_hi; p.ptab = (LAS unsigned long long*)(misc + 1024);
    if (C.tid < 34) p.ptab[C.tid] = (unsigned long long)ka.in[C.tid];
    __syncthreads();
    const int lo = p.ph_lo, hi = p.ph_hi;
    XcdBarrier bar; bar.bar = (unsigned*)(p.ws + WS_CTL) + CW_BAR; bar.x = 0; bar.st = (volatile LAS unsigned*)misc;
    if (hi - lo > 1) bar = xcd_barrier_post((unsigned*)(p.ws + WS_CTL) + CW_BAR, (volatile LAS unsigned*)misc);
#define IN(k) (lo <= (k) && (k) < hi)
#define SEAM(k) do { if (IN(k) && IN((k) + 1)) xcd_barrier(bar, C.wave); } while (0)

    if (IN(0)) { phase_p0(p, C); } SEAM(0);
    if (IN(1)) { phase_p1(p, C); } SEAM(1);
    if (IN(0) && IN(2) && (C.G & 7) == 0) {
        volatile LAS unsigned* st = (volatile LAS unsigned*)misc;
        if (C.tid == 0) { unsigned pre = 0u; const unsigned x = st[3];
            for (unsigned j = 0; j < 16; ++j) { const unsigned cj = xb_ld(&bar.bar[XB_XCNT(j)]); pre += (j < x) ? cj : 0u; }
            st[4] = pre + st[2]; }
        __syncthreads();
        const int vcu = (int)st[4], g8 = C.G >> 3;
        C.bid = __builtin_amdgcn_readfirstlane((vcu % g8) * 8 + vcu / g8); C.gw = C.bid * NWAVES + C.wave;
    }

    layer_body<0>(p, C, bar, misc, lo, hi);
    layer_body<1>(p, C, bar, misc, lo, hi);
#undef IN
#undef SEAM
}

extern "C" void kernel_launch(void* const* d_in, const int* in_sizes, int n_in, void* d_out, int out_size, void* d_ws, size_t ws_size, hipStream_t stream) {
    static int grid = 0;
    if (grid == 0) {
        if (n_in != 34 || out_size != SEQ * DM || ws_size < WS_END) { fprintf(stderr, "kernel_launch: unexpected shapes: n_in %d out %d ws %zu (need %zu)\n", n_in, out_size, ws_size, (size_t)WS_END); grid = -1; return; }
        int dev = 0, cus = 0, per_cu = 0;
        if (hipGetDevice(&dev) != hipSuccess || hipDeviceGetAttribute(&cus, hipDeviceAttributeMultiprocessorCount, dev) != hipSuccess) { grid = -1; return; }
        if (hipFuncSetAttribute((const void*)mega_fwd, hipFuncAttributeMaxDynamicSharedMemorySize, LDS_BYTES) != hipSuccess) { fprintf(stderr, "kernel_launch: hipFuncSetAttribute failed\n"); grid = -1; return; }
        if (hipOccupancyMaxActiveBlocksPerMultiprocessor(&per_cu, (const void*)mega_fwd, NTHR, LDS_BYTES) != hipSuccess || per_cu < 1) { fprintf(stderr, "kernel_launch: occupancy query says %d blocks per CU\n", per_cu); grid = -1; return; }
        (void)hipGetLastError();
        grid = cus;
    }
    if (grid < 0) return;
    (void)hipMemsetAsync((char*)d_ws + WS_CTL, 0, CTL_BYTES, stream);
    KArgs p{};
    for (int i = 0; i < 34; ++i) p.in[i] = (const float*)d_in[i];
    p.out = (float*)d_out; p.ws = (unsigned char*)d_ws;
#if MK_PER_PHASE
    for (int ph = 0; ph < N_PHASES; ++ph) {
        if (ph == 2 + PH_PER_LAYER + 0 || ph == 2 + PH_PER_LAYER + 5 || ph == 2 + PH_PER_LAYER + 6) continue;
        p.ph_lo = ph; p.ph_hi = ph + 1;
        hipLaunchKernelGGL(mega_fwd, dim3(grid), dim3(NTHR), LDS_BYTES, stream, p);
    }
#else
    p.ph_lo = 0; p.ph_hi = N_PHASES;
    hipLaunchKernelGGL(mega_fwd, dim3(grid), dim3(NTHR), LDS_BYTES, stream, p);
#endif
    const hipError_t le = hipPeekAtLastError();
    if (le != hipSuccess) fprintf(stderr, "kernel_launch: launch failed: %s\n", hipGetErrorName(le));
}
```

```cpp
#define MK_PER_PHASE 0
#include <hip/hip_runtime.h>
#include <cstdio>
#include <cstdint>

#define GAS __attribute__((address_space(1)))
#define LAS __attribute__((address_space(3)))
typedef unsigned short bf16_t;
typedef short bf16x8 __attribute__((ext_vector_type(8)));
typedef short s16x4 __attribute__((ext_vector_type(4)));
typedef float f32x4 __attribute__((ext_vector_type(4)));
typedef float f32x2 __attribute__((ext_vector_type(2)));
typedef float f32x16 __attribute__((ext_vector_type(16)));
typedef unsigned u32x4 __attribute__((ext_vector_type(4)));
typedef unsigned u32x2 __attribute__((ext_vector_type(2)));

constexpr int DM = 2048, SEQ = 16384, CTXL = 256, TT = SEQ + CTXL;
constexpr int NEXP = 64, NEX1 = 65, EHID = 512, TOPK = 8;
constexpr int EV_IN = 5120, OD_IN = 4608;
constexpr float LN_EPS = 1e-6f;
constexpr float ALPHA = 1.4142135623730951f;
constexpr float LAMBDA_INIT = 0.35550906759f;
constexpr int NTHR = 512, NWAVES = 8;

constexpr size_t al256(size_t x) { return (x + 255) / 256 * 256; }
constexpr size_t WS_CTL   = 0;
constexpr size_t CTL_BYTES = 1u << 20;
constexpr size_t WS_MODP  = WS_CTL + CTL_BYTES;
constexpr size_t WS_MODF  = WS_MODP + al256((size_t)2 * 32 * 2 * 12288 * 4);
constexpr size_t WS_ROPE128 = WS_MODF + al256((size_t)2 * 2 * 12288 * 4);
constexpr size_t WS_ROPE64  = WS_ROPE128 + al256((size_t)256 * 64 * 2 * 4);
constexpr size_t WS_KN    = WS_ROPE64 + al256((size_t)256 * 32 * 2 * 4);
constexpr size_t WS_WT    = WS_KN + al256((size_t)2 * 64 * 16 * 1024 * 2);
constexpr size_t WS_APOW  = WS_WT + al256((size_t)2 * 64 * 128 * 1024 * 2);
constexpr size_t WS_AL    = WS_APOW + al256((size_t)2 * 64 * 64 * 128 * 4);
constexpr size_t WS_CC    = WS_AL + al256((size_t)2 * 64 * 128 * 4);
constexpr size_t WS_BBT   = WS_CC + al256((size_t)64 * 16 * 128 * 2);
constexpr size_t WS_S5E   = WS_BBT + al256((size_t)2 * 64 * 128 * 16 * 2);
constexpr size_t WS_HST   = WS_S5E + al256((size_t)2 * 64 * 260 * 128 * 4);
constexpr size_t WS_WIN0  = WS_HST + al256((size_t)2 * 64 * 260 * 128 * 4);
constexpr size_t WS_WOUT0 = WS_WIN0 + al256((size_t)EV_IN * DM * 2);
constexpr size_t WS_WGLU  = WS_WOUT0 + al256((size_t)DM * DM * 2);
constexpr size_t WS_WIN1  = WS_WGLU + al256((size_t)1024 * 1024 * 2);
constexpr size_t WS_WOUT1 = WS_WIN1 + al256((size_t)OD_IN * DM * 2);
constexpr size_t WS_RWT   = WS_WOUT1 + al256((size_t)DM * DM * 2);
constexpr size_t WS_GU    = WS_RWT + al256((size_t)2 * 2 * 64 * DM * 2);
constexpr size_t WS_DT    = WS_GU + al256((size_t)NEX1 * 1024 * DM * 2);
constexpr size_t WS_XA    = WS_DT + al256((size_t)NEX1 * DM * EHID * 2);
constexpr size_t WS_Z     = WS_XA + al256((size_t)TT * DM * 2);
constexpr size_t WS_YMIX  = WS_Z + al256((size_t)TT * 1024 * 2);
constexpr size_t WS_X1    = WS_YMIX + al256((size_t)TT * DM * 2);
constexpr size_t WS_HX2   = WS_X1 + al256((size_t)TT * DM * 4);
constexpr size_t WS_LIST  = WS_HX2 + al256((size_t)9 * TT * EHID * 2);
constexpr size_t WS_WGT   = WS_LIST + al256((size_t)NEX1 * TT * 4);
constexpr size_t WS_LW    = WS_WGT + al256((size_t)8 * TT * 4);
constexpr size_t WS_BIG   = WS_LW + al256((size_t)NEX1 * TT * 4);
constexpr size_t BG_QKV   = 0;
constexpr size_t BG_CKV   = BG_QKV + al256((size_t)TT * EV_IN * 2);
constexpr size_t BG_SPREV = BG_CKV + al256((size_t)8 * 130 * 65536 * 4);
constexpr size_t BG_MIX   = BG_SPREV + al256((size_t)8 * 130 * 65536 * 2);
constexpr size_t BG_END0  = BG_MIX + al256((size_t)TT * DM * 2);
constexpr size_t BG_ATT   = BG_CKV;
constexpr size_t BG_Q8    = BG_ATT + al256((size_t)SEQ * 3072 * 2);
constexpr size_t BG_K8    = BG_Q8 + al256((size_t)TT * 1024);
constexpr size_t BG_VT8   = BG_K8 + al256((size_t)TT * 256);
constexpr size_t BG_Q8D   = BG_VT8 + al256((size_t)2 * 260 * 128 * 64);
constexpr size_t BG_K8D   = BG_Q8D + al256((size_t)TT * 1024);
constexpr size_t BG_VT8D  = BG_K8D + al256((size_t)TT * 1024);
constexpr size_t BG_F8END = BG_VT8D + al256((size_t)8 * 260 * 128 * 64);
constexpr size_t BG_YMOE  = 0;
constexpr size_t BG_END1  = al256((size_t)9 * TT * DM * 2);
constexpr size_t BG_SIZE  = BG_END0 > BG_END1 ? BG_END0 : BG_END1;
static_assert(BG_F8END <= BG_SIZE, "fp8 attention operands inside the big region");
constexpr size_t WS_END   = WS_BIG + BG_SIZE;

constexpr int CW_BAR = 4096;
constexpr int CW_CNT = 16384;
constexpr int CW_QUEUE = 20480;
constexpr int CW_KMAX = 24576;

constexpr int RING_BYTES = 151552;
constexpr int MISC_OFF = RING_BYTES;
constexpr int LDS_BYTES = 159744;

typedef __bf16 bf16x2_t __attribute__((ext_vector_type(2)));
__device__ __forceinline__ unsigned cvt_pk_bf16(float lo, float hi) { const f32x2 v = {lo, hi}; return __builtin_bit_cast(unsigned, __builtin_convertvector(v, bf16x2_t)); }
__device__ __forceinline__ bf16_t f2bf(float f) { unsigned u = __builtin_bit_cast(unsigned, f); return (bf16_t)((u + 0x7fffu + ((u >> 16) & 1u)) >> 16); }
__device__ __forceinline__ float bf2f(bf16_t b) { return __builtin_bit_cast(float, ((unsigned)b) << 16); }
__device__ __forceinline__ float bflo(unsigned w) { return __builtin_bit_cast(float, w << 16); }
__device__ __forceinline__ float bfhi(unsigned w) { return __builtin_bit_cast(float, w & 0xffff0000u); }
__device__ __forceinline__ float wave_sum(float v) {
#pragma unroll
    for (int o = 1; o < 64; o <<= 1) v += __shfl_xor(v, o);
    return v;
}
__device__ __forceinline__ float fast_exp(float x) { return __builtin_amdgcn_exp2f(x * 1.4426950408889634f); }
__device__ __forceinline__ float sigmoidf_(float x) { return 1.0f / (1.0f + __expf(-x)); }
__device__ __forceinline__ float siluf_(float x) { return x / (1.0f + __expf(-x)); }
__device__ __forceinline__ float gelu_tanh(float x) {
    const float u = 0.7978845608028654f * (x + 0.044715f * x * x * x);
    const float e = __expf(2.0f * u);
    const float t = 1.0f - 2.0f / (e + 1.0f);
    return 0.5f * x * (1.0f + t);
}
#define LDS_WAIT() asm volatile("s_waitcnt lgkmcnt(0)" ::: "memory")
#define VM_WAIT() asm volatile("s_waitcnt vmcnt(0)" ::: "memory")

#define XB_TMO      128
#define XB_XCNT(j)  (256  + 64 * (j))
#define XB_XSUB(j)  (1280 + 64 * (j))
#define XB_XGEN(j)  (2304 + 64 * (j))
#define XB_TOP      3328
#define XB_TOPGEN   3392
#define XCD_BAR_WORDS 3456
#define XB_SPIN_CAP (1u << 22)

__device__ __forceinline__ unsigned xb_ld(unsigned* p)              { return __hip_atomic_load(p, __ATOMIC_RELAXED, __HIP_MEMORY_SCOPE_AGENT); }
__device__ __forceinline__ unsigned xb_add(unsigned* p, unsigned v) { return __hip_atomic_fetch_add(p, v, __ATOMIC_RELAXED, __HIP_MEMORY_SCOPE_AGENT); }
__device__ __forceinline__ unsigned xb_xcc_id() { return (unsigned)__builtin_amdgcn_s_getreg((3 << 11) | 20) & 0xFu; }
#define XB_SPIN(cond, bar) do { unsigned _sp = 0; while (cond) { __builtin_amdgcn_s_sleep(1); \
    if ((++_sp & 255u) == 0u) { if (xb_ld(&(bar)[XB_TMO])) break; if (_sp > XB_SPIN_CAP) { atomicAdd(&(bar)[XB_TMO], 1u); break; } } } } while (0)

struct XcdBarrier { unsigned* bar; unsigned x; volatile LAS unsigned* st; };

__device__ __forceinline__ XcdBarrier xcd_barrier_post(unsigned* bar, volatile LAS unsigned* st) {
    XcdBarrier b; b.bar = bar; b.x = xb_xcc_id(); b.st = st;
    if (threadIdx.x == 0) { st[2] = xb_add(&bar[XB_XCNT(b.x)], 1u); st[3] = b.x; }
    return b;
}
__device__ __forceinline__ void xcd_barrier_complete(unsigned* bar, unsigned x, unsigned& nloc, unsigned& nx) {
    const unsigned G = gridDim.x * gridDim.y * gridDim.z;
    unsigned sum, cnt, mine, sp = 0u;
    for (;;) {
        sum = 0u; cnt = 0u; mine = 0u;
#pragma unroll
        for (unsigned j = 0; j < 16; ++j) { const unsigned c = xb_ld(&bar[XB_XCNT(j)]); sum += c; cnt += (c > 0u) ? 1u : 0u; mine = (j == x) ? c : mine; }
        if (sum == G) break;
        __builtin_amdgcn_s_sleep(1);
        if ((++sp & 255u) == 0u) { if (xb_ld(&bar[XB_TMO])) break; if (sp > XB_SPIN_CAP) { atomicAdd(&bar[XB_TMO], 1u); break; } }
    }
    nloc = mine > 0u ? mine : 1u; nx = cnt > 0u ? cnt : 1u;
}
__device__ __forceinline__ void xcd_barrier(const XcdBarrier& b, int wave_id) {
    const bool leader_thread = (wave_id == 0) && (__builtin_amdgcn_mbcnt_hi(~0u, __builtin_amdgcn_mbcnt_lo(~0u, 0u)) == 0u);
    asm volatile("s_waitcnt vmcnt(0)" ::: "memory");
    __syncthreads();
    if (leader_thread) {
        unsigned* bar = b.bar;
        __builtin_amdgcn_s_waitcnt(0);
        unsigned nloc = b.st[0], nx = b.st[1];
        if (nloc == 0u) { xcd_barrier_complete(bar, b.x, nloc, nx); b.st[0] = nloc; b.st[1] = nx; }
        const unsigned old = xb_add(&bar[XB_XSUB(b.x)], 1u);
        const unsigned gen = old / nloc;
        if (old + 1u == (gen + 1u) * nloc) {
            __builtin_amdgcn_fence(__ATOMIC_RELEASE, "agent");
            asm volatile("s_waitcnt vmcnt(0)" ::: "memory");
            const unsigned og = xb_add(&bar[XB_TOP], 1u);
            const unsigned tg = og / nx;
            if (og + 1u == (tg + 1u) * nx) xb_add(&bar[XB_TOPGEN], 1u);
            else XB_SPIN(xb_ld(&bar[XB_TOPGEN]) == tg, bar);
            __builtin_amdgcn_fence(__ATOMIC_ACQUIRE, "agent");
            xb_add(&bar[XB_XGEN(b.x)], 1u);
            asm volatile("s_waitcnt vmcnt(0)" ::: "memory");
        } else {
            XB_SPIN(xb_ld(&bar[XB_XGEN(b.x)]) == gen, bar);
            __builtin_amdgcn_fence(__ATOMIC_ACQUIRE, "agent");
            asm volatile("s_waitcnt vmcnt(0)" ::: "memory");
        }
    }
    __syncthreads();
}

__device__ __forceinline__ bf16x8 frag_rowk_l(const LAS bf16_t* p, int ld, int lane) {
    return *(const LAS bf16x8*)(p + (lane & 15) * ld + (lane >> 4) * 8);
}
__device__ __forceinline__ bf16x8 frag_rowk_g(const bf16_t* p, long ld, int lane) {
    return *(const bf16x8*)(p + (long)(lane & 15) * ld + (lane >> 4) * 8);
}
__device__ __forceinline__ bf16x8 frag_colk_l(unsigned p, int ldb, int lane) {
    const unsigned a0 = p + (unsigned)((8 * (lane >> 4) + ((lane & 15) >> 2)) * ldb + (lane & 3) * 8);
    const unsigned a1 = a0 + 4u * (unsigned)ldb;
    s16x4 lo, hi;
    asm volatile("ds_read_b64_tr_b16 %0, %2\n\tds_read_b64_tr_b16 %1, %3\n\ts_waitcnt lgkmcnt(0)" : "=&v"(lo), "=&v"(hi) : "v"(a0), "v"(a1) : "memory");
    return (bf16x8){lo[0], lo[1], lo[2], lo[3], hi[0], hi[1], hi[2], hi[3]};
}
#define MFMA16(a, b, c) __builtin_amdgcn_mfma_f32_16x16x32_bf16((a), (b), (c), 0, 0, 0)
namespace pg8 {
constexpr int BM = 256, BK = 64, HALF = 128, HTB = HALF * BK * 2, STAGE_BYTES = 8 * HTB, NXCD = 8, WGM = 8;
__device__ __forceinline__ int lds_byte(int r, int c) { const int st = (r >> 4) * 2 + (c >> 5), rr = r & 15, cc = c & 31, ob = rr * 64 + cc * 2; return st * 1024 + (ob ^ (((ob >> 9) & 1) << 5)); }
__device__ __forceinline__ void stage_rc(int b, int& R, int& C) { const int st = b / 1024, sb = b % 1024, swz = sb ^ (((sb >> 9) & 1) << 5); R = (st >> 1) * 16 + swz / 64; C = (st & 1) * 32 + (swz % 64) / 2; }
__device__ __forceinline__ int perm32(int rho) { const int n = rho >> 4, i = rho & 15; return 8 * (i >> 2) + 4 * n + (i & 3); }

struct Unit { int pm, pn, e; };
constexpr float WSCALE = 32.0f, WSCALE_INV = 1.0f / 32.0f;

struct DenseOrder {
    const bf16_t* A; const bf16_t* Bt; int ldab, kb, nM, nN, nwg, G, c;
    __device__ __forceinline__ void init(const bf16_t* A_, int lda_, const bf16_t* Bt_, int M, int N, int K_, int G_, int c_) { A = A_; ldab = lda_ * 2; Bt = Bt_; kb = K_ * 2; nM = M / BM; nN = N / BM; nwg = nM * nN; G = G_; c = c_; }
    __device__ __forceinline__ void init8(const void* A_, int ldab_, const void* Bt_, int M, int N, int K_, int G_, int c_) { A = (const bf16_t*)A_; ldab = ldab_; Bt = (const bf16_t*)Bt_; kb = K_; nM = M / BM; nN = N / BM; nwg = nM * nN; G = G_; c = c_; }
    __device__ __forceinline__ void prep(LAS unsigned char*) const {}
    __device__ __forceinline__ int units_of_me() const { return c < nwg ? (nwg - c + G - 1) / G : 0; }
    __device__ __forceinline__ int max_units() const { return (nwg + G - 1) / G; }
    __device__ __forceinline__ bool next(int i, Unit& u) const {
        const long L = (long)i * G + c; if (L >= nwg) return false;
        int wgid = (int)L; { const int q = nwg / NXCD, r = nwg % NXCD, xcd = wgid % NXCD, off = wgid / NXCD; wgid = (xcd < r ? xcd * (q + 1) : r * (q + 1) + (xcd - r) * q) + off; }
        const int nig = WGM * nN, gid = wgid / nig, fm = gid * WGM, gsz = (nM - fm) < WGM ? (nM - fm) : WGM;
        u.pm = fm + ((wgid % nig) % gsz); u.pn = (wgid % nig) / gsz; u.e = 0; return true;
    }
    __device__ __forceinline__ const char* a_base() const { return (const char*)A; }
    __device__ __forceinline__ unsigned a_off(const Unit& u, int r) const { return (unsigned)(u.pm * BM + r) * (unsigned)ldab; }
    __device__ __forceinline__ void a_off4(const Unit& u, int r0, int r1, int half, u32x4& o) const { o.x = a_off(u, r0); o.y = a_off(u, r1); o.z = a_off(u, half + r0); o.w = a_off(u, half + r1); }
    __device__ __forceinline__ const char* b_ptr(const Unit& u) const { return (const char*)Bt + (size_t)u.pn * BM * kb; }
};

template <int MODE  >
struct MoeOrder {
    const void* A; const void* Bt; const int* list; const int* cnt; int ldab, kb, nN, G, c; size_t bstride;
    LAS int* tp; LAS int* cn; LAS int* rb;
    __device__ __forceinline__ void prep(LAS unsigned char* misc, int tid) {
        tp = (LAS int*)(misc + 64); cn = tp + 72; rb = cn + 72;
        if (tid < NEX1) cn[tid] = cnt[tid];
        __syncthreads();
        if (tid == 0) { int s = 0, q = 0; for (int e = 0; e < NEX1; ++e) { tp[e] = s; rb[e] = q; s += (cn[e] + BM - 1) / BM; q += cn[e]; } tp[NEX1] = s; rb[NEX1] = q; }
        __syncthreads();
    }
    __device__ __forceinline__ bool next(int i, Unit& u) const {
        const int total = tp[NEX1]; const long nu = (long)total * nN; const int per = (int)((nu + G - 1) / G);
        (void)per;
        long L = (long)i * G + c;
        if ((G & 7) == 0) L = ((long)i * 8 + (c & 7)) * (G >> 3) + (c >> 3);
        if (L >= nu) return false;
        const int tile = (int)(L / nN); u.pn = (int)(L % nN);
        const int ln_ = (int)__builtin_amdgcn_mbcnt_hi(~0u, __builtin_amdgcn_mbcnt_lo(~0u, 0u));
        const int e = __builtin_popcountll(__ballot(tp[ln_ + 1] <= tile));
        u.e = e; u.pm = tile - tp[e]; return true;
    }
    __device__ __forceinline__ const char* a_base() const { return (const char*)A; }
    __device__ __forceinline__ unsigned a_off(const Unit& u, int r) const {
        int pos = u.pm * BM + r; const int n = cn[u.e]; pos = pos < n ? pos : n - 1;
        if (MODE == 1) return (unsigned)(rb[u.e] + pos) * (unsigned)ldab;
        const int a = list[u.e * TT + pos];
        const int row = a < 8 * TT ? (a >> 3) : a - 8 * TT;
        return (unsigned)row * (unsigned)ldab;
    }
    __device__ __forceinline__ void a_off4(const Unit& u, int r0, int r1, int half, u32x4& o) const {
        if (MODE == 1) { o.x = a_off(u, r0); o.y = a_off(u, r1); o.z = a_off(u, half + r0); o.w = a_off(u, half + r1); return; }
        const int n = cn[u.e], pb = u.pm * BM; const int* lp = list + u.e * TT;
        const int a0 = lp[min(pb + r0, n - 1)], a1 = lp[min(pb + r1, n - 1)], a2 = lp[min(pb + half + r0, n - 1)], a3 = lp[min(pb + half + r1, n - 1)];
        o.x = (unsigned)(a0 < 8 * TT ? (a0 >> 3) : a0 - 8 * TT) * (unsigned)ldab; o.y = (unsigned)(a1 < 8 * TT ? (a1 >> 3) : a1 - 8 * TT) * (unsigned)ldab;
        o.z = (unsigned)(a2 < 8 * TT ? (a2 >> 3) : a2 - 8 * TT) * (unsigned)ldab; o.w = (unsigned)(a3 < 8 * TT ? (a3 >> 3) : a3 - 8 * TT) * (unsigned)ldab;
    }
    __device__ __forceinline__ const char* b_ptr(const Unit& u) const { return (const char*)Bt + (size_t)u.e * bstride + (size_t)u.pn * BM * kb; }
};

typedef int v8i32 __attribute__((ext_vector_type(8)));
typedef int v4i32_ __attribute__((ext_vector_type(4)));
__device__ __forceinline__ v8i32 cat8(bf16x8 a, bf16x8 b) { const u32x4 x = __builtin_bit_cast(u32x4, a), y = __builtin_bit_cast(u32x4, b); return (v8i32){(int)x.x, (int)x.y, (int)x.z, (int)x.w, (int)y.x, (int)y.y, (int)y.z, (int)y.w}; }
template <bool FP8, class Epi, class Sched>
__device__ __forceinline__ void gemm_phase(LAS unsigned char* lds, const Sched& S, const Epi& E, int wave_id) {
    const int wid = wave_id; int lane = (int)__builtin_amdgcn_mbcnt_hi(~0u, __builtin_amdgcn_mbcnt_lo(~0u, 0u)); asm volatile("" : "+v"(lane));
    const int tid = wid * 64 + lane, wr = wid >> 2, wc = wid & 3, fr = lane & 15, fq = lane >> 4;
    const int kb = S.kb; int nt = kb / 128; asm volatile("" : "+s"(nt));
    unsigned voffB[2];
#pragma unroll
    for (int i = 0; i < 2; ++i) { int R, C; stage_rc(tid * 16 + i * 8192, R, C); const int Rb = (R & ~31) + perm32(R & 31);
        voffB[i] = (unsigned)(Rb * kb) + (unsigned)C * 2u; }
#define PG8_AOFF(u, h, i) ({ int _tz = tid; asm volatile("" : "+v"(_tz)); int _R, _C; stage_rc(_tz * 16 + (i) * 8192, _R, _C); S.a_off((u), (h) * HALF + _R) + (unsigned)_C * 2u; })
    const size_t kstep = (size_t)(BK * 2);
    const size_t hstepB = (size_t)HALF * kb;
    const unsigned ldsw = (unsigned)wid * 1024u;
    const int aoff = lds_byte(wr * 64 + fr, fq * 8), boff = lds_byte(wc * 32 + fr, fq * 8);
#define PG8_SA(b, h) (((b) * 2 + (h)) * HTB)
#define PG8_SB(b, h) ((4 + (b) * 2 + (h)) * HTB)
#define PG8_STAGE(bufoff, gbase, v0, v1) do { \
        __builtin_amdgcn_global_load_lds((const unsigned*)((const char*)(gbase) + (v0)), (LAS unsigned*)(lds + (bufoff) + ldsw), 16, 0, 0); \
        __builtin_amdgcn_global_load_lds((const unsigned*)((const char*)(gbase) + (v1)), (LAS unsigned*)(lds + (bufoff) + ldsw + 8192), 16, 0, 0); } while (0)
#define PG8_VOFFB(i) ({ int _tz = tid; asm volatile("" : "+v"(_tz)); int _R, _C; stage_rc(_tz * 16 + (i) * 8192, _R, _C); (unsigned)(((_R & ~31) + perm32(_R & 31)) * kb) + (unsigned)_C * 2u; })
#define PG8_STAGE_B(bufoff, gbase) do { if constexpr (FP8) { int _tz = tid; asm volatile("" : "+v"(_tz)); const u32x2 _vv = *(const LAS u32x2*)(lds + STAGE_BYTES + 8192 + _tz * 8); PG8_STAGE(bufoff, gbase, _vv.x, _vv.y); } else PG8_STAGE(bufoff, gbase, voffB[0], voffB[1]); } while (0)
#define PG8_LD8(off) __builtin_shufflevector(*(const LAS v4i32_*)(lds + (off)), *(const LAS v4i32_*)(lds + (off) + 1024), 0, 1, 2, 3, 4, 5, 6, 7)
#define PG8_LDA(dst, b, h) do { _Pragma("unroll") for (int m = 0; m < 4; ++m) { if constexpr (FP8) dst##8[m] = PG8_LD8(PG8_SA(b, h) + aoff + m * 2048); else { _Pragma("unroll") for (int k = 0; k < 2; ++k) dst[m][k] = *(const LAS bf16x8*)(lds + PG8_SA(b, h) + aoff + m * 2048 + k * 1024); } } } while (0)
#define PG8_LDB(dst, b, h) do { _Pragma("unroll") for (int n = 0; n < 2; ++n) { if constexpr (FP8) dst##8[n] = PG8_LD8(PG8_SB(b, h) + boff + n * 2048); else { _Pragma("unroll") for (int k = 0; k < 2; ++k) dst[n][k] = *(const LAS bf16x8*)(lds + PG8_SB(b, h) + boff + n * 2048 + k * 1024); } } } while (0)
#define PG8_MMA(ai, bj, At, Bt) do { __builtin_amdgcn_s_setprio(1); _Pragma("unroll") for (int m = 0; m < 4; ++m) _Pragma("unroll") for (int n = 0; n < 2; ++n) { \
        if constexpr (FP8) asm volatile("v_mfma_f32_16x16x128_f8f6f4 %0, %1, %2, %0" : "+v"(acc[ai][bj][m][n]) : "v"(Bt##8[n]), "v"(At##8[m])); \
        else { _Pragma("unroll") for (int k = 0; k < 2; ++k) acc[ai][bj][m][n] = __builtin_amdgcn_mfma_f32_16x16x32_bf16(Bt[n][k], At[m][k], acc[ai][bj][m][n], 0, 0, 0); } } \
        __builtin_amdgcn_s_setprio(0); } while (0)
#define PG8_WAIT_V(n) asm volatile("s_waitcnt vmcnt(" #n ")" ::: "memory")
#define PG8_WAIT_L(n) asm volatile("s_waitcnt lgkmcnt(" #n ")" ::: "memory")
#define PG8_BAR __builtin_amdgcn_s_barrier()
#define PG8_SCHED __builtin_amdgcn_sched_barrier(0)
    if constexpr (FP8) { u32x2 _vb; _vb.x = PG8_VOFFB(0); _vb.y = PG8_VOFFB(1); *(LAS u32x2*)(lds + STAGE_BYTES + 8192 + tid * 8) = _vb; }
    Unit cur, nxt; int ui = 0;
    if (!S.next(0, cur)) return;
    f32x4 acc[2][2][4][2];
#pragma unroll
    for (int a = 0; a < 2; ++a)
#pragma unroll
        for (int b = 0; b < 2; ++b)
#pragma unroll
            for (int m = 0; m < 4; ++m)
#pragma unroll
                for (int n = 0; n < 2; ++n) acc[a][b][m][n] = (f32x4){0.f, 0.f, 0.f, 0.f};
    bf16x8 At[4][2], B0[2][2], B1[2][2]; v8i32 At8[4], B08[2], B18[2];
    const char* const gA = S.a_base();
    const char* cB = S.b_ptr(cur);
    unsigned oc00, oc01, oc10, oc11;
    oc00 = PG8_AOFF(cur, 0, 0); oc01 = PG8_AOFF(cur, 0, 1); oc10 = PG8_AOFF(cur, 1, 0); oc11 = PG8_AOFF(cur, 1, 1);
    PG8_STAGE_B(PG8_SB(0, 0), cB); PG8_STAGE_B(PG8_SB(0, 1), cB + hstepB); PG8_STAGE(PG8_SA(0, 0), gA, oc00, oc01); PG8_STAGE(PG8_SA(0, 1), gA, oc10, oc11);
    if (wr == 1) PG8_BAR;
    PG8_WAIT_V(2); PG8_BAR;
    PG8_STAGE_B(PG8_SB(1, 0), cB + kstep); PG8_STAGE(PG8_SA(1, 0), gA + kstep, oc00, oc01); PG8_STAGE_B(PG8_SB(1, 1), cB + hstepB + kstep);
    PG8_WAIT_V(6); PG8_BAR;
    for (;;) {
        const bool has_next = S.next(ui + 1, nxt);
        const char* nB = cB;
        {
            u32x4 on = {oc00, oc01, oc10, oc11};
            if (has_next) {
                int _tz = tid; asm volatile("" : "+v"(_tz)); int _R0, _C0, _R1, _C1; stage_rc(_tz * 16, _R0, _C0); stage_rc(_tz * 16 + 8192, _R1, _C1);
                S.a_off4(nxt, _R0, _R1, HALF, on); on.x += (unsigned)_C0 * 2u; on.y += (unsigned)_C1 * 2u; on.z += (unsigned)_C0 * 2u; on.w += (unsigned)_C1 * 2u; nB = S.b_ptr(nxt); }
            *(LAS u32x4*)(lds + STAGE_BYTES + tid * 16) = on;
        }
        for (int t = 0; t < nt; t += 2) {
            const bool last = (t == nt - 2);
            const char* a1 = gA + (size_t)(t + 1) * kstep;
            const char* a2 = last ? gA : gA + (size_t)(t + 2) * kstep; const char* b2 = last ? nB : cB + (size_t)(t + 2) * kstep;
            const char* a3 = a2 + kstep; const char* b3 = b2 + kstep;
            unsigned s00 = oc00, s01 = oc01, s10 = oc10, s11 = oc11;
            if (last) { const u32x4 on = *(const LAS u32x4*)(lds + STAGE_BYTES + tid * 16); s00 = on.x; s01 = on.y; s10 = on.z; s11 = on.w; }
            PG8_LDB(B0, 0, 0); PG8_LDB(B1, 0, 1); PG8_SCHED; PG8_LDA(At, 0, 0); PG8_STAGE(PG8_SA(1, 1), a1, oc10, oc11);
            PG8_WAIT_V(8); PG8_WAIT_L(0); PG8_BAR; PG8_MMA(0, 0, At, B0); PG8_MMA(0, 1, At, B1); PG8_BAR; PG8_SCHED;
            PG8_LDA(At, 0, 1); PG8_STAGE_B(PG8_SB(0, 0), b2); PG8_STAGE_B(PG8_SB(0, 1), b2 + hstepB); PG8_STAGE(PG8_SA(0, 0), a2, s00, s01);
            PG8_WAIT_V(8); PG8_WAIT_L(0); PG8_BAR; PG8_MMA(1, 0, At, B0); PG8_MMA(1, 1, At, B1); PG8_BAR; PG8_SCHED;
            PG8_LDB(B0, 1, 0); PG8_LDB(B1, 1, 1); PG8_SCHED; PG8_LDA(At, 1, 0); PG8_STAGE(PG8_SA(0, 1), a2, s10, s11);
            PG8_WAIT_V(8); PG8_WAIT_L(0); PG8_BAR; PG8_MMA(0, 0, At, B0); PG8_MMA(0, 1, At, B1); PG8_BAR; PG8_SCHED;
            PG8_LDA(At, 1, 1); PG8_STAGE_B(PG8_SB(1, 0), b3); PG8_STAGE_B(PG8_SB(1, 1), b3 + hstepB); PG8_STAGE(PG8_SA(1, 0), a3, s00, s01);
            PG8_WAIT_V(8); PG8_WAIT_L(0); PG8_BAR; PG8_MMA(1, 0, At, B0); PG8_MMA(1, 1, At, B1); PG8_BAR; PG8_SCHED;
        }
        if (wr == 0) PG8_BAR;
        E(acc, cur, wr, wc, fr, fq);
        if (!has_next) break;
#pragma unroll
        for (int a = 0; a < 2; ++a)
#pragma unroll
            for (int b = 0; b < 2; ++b)
#pragma unroll
                for (int m = 0; m < 4; ++m)
#pragma unroll
                    for (int n = 0; n < 2; ++n) acc[a][b][m][n] = (f32x4){0.f, 0.f, 0.f, 0.f};
        { const u32x4 on = *(const LAS u32x4*)(lds + STAGE_BYTES + tid * 16); oc00 = on.x; oc01 = on.y; oc10 = on.z; oc11 = on.w; }
        cur = nxt; cB = nB; ++ui;
        if (wr == 1) PG8_BAR;
    }
    PG8_WAIT_V(0);
    PG8_BAR;
#undef PG8_SA
#undef PG8_SB
#undef PG8_STAGE
#undef PG8_STAGE_B
#undef PG8_AOFF
#undef PG8_VOFFB
#undef PG8_LD8
#undef PG8_LDA
#undef PG8_LDB
#undef PG8_MMA
#undef PG8_WAIT_V
#undef PG8_WAIT_L
#undef PG8_BAR
#undef PG8_SCHED
}

struct EpiStore {
    bf16_t* O; int ldc; float scale;
    __device__ __forceinline__ void operator()(const f32x4 (&acc)[2][2][4][2], const Unit& u, int wr, int wc, int fr, int fq) const {
        const int row0 = u.pm * BM + wr * 64 + fr, col0 = u.pn * BM + wc * 32 + 8 * fq;
#pragma unroll
        for (int ai = 0; ai < 2; ++ai)
#pragma unroll
            for (int m = 0; m < 4; ++m) { bf16_t* rowp = O + (size_t)(row0 + ai * HALF + m * 16) * ldc + col0;
#pragma unroll
                for (int bj = 0; bj < 2; ++bj) { const f32x4 v0 = acc[ai][bj][m][0] * scale, v1 = acc[ai][bj][m][1] * scale;
                    u32x4 w; w.x = cvt_pk_bf16(v0[0], v0[1]); w.y = cvt_pk_bf16(v0[2], v0[3]); w.z = cvt_pk_bf16(v1[0], v1[1]); w.w = cvt_pk_bf16(v1[2], v1[3]);
                    *(u32x4*)(rowp + bj * HALF) = w; } }
    }
};
struct EpiGlu {
    const bf16_t* Z; const float* b; bf16_t* MIX;
    __device__ __forceinline__ void operator()(const f32x4 (&acc)[2][2][4][2], const Unit& u, int wr, int wc, int fr, int fq) const {
        const int row0 = u.pm * BM + wr * 64 + fr, col0 = u.pn * BM + wc * 32 + 8 * fq;
#pragma unroll
        for (int bj = 0; bj < 2; ++bj) {
            const f32x4 b0 = *(const f32x4*)(b + col0 + bj * HALF), b1 = *(const f32x4*)(b + col0 + bj * HALF + 4);
#pragma unroll
            for (int ai = 0; ai < 2; ++ai)
#pragma unroll
                for (int m = 0; m < 4; ++m) { const size_t row = (size_t)(row0 + ai * HALF + m * 16);
                    const u32x4 zz = *(const u32x4*)(Z + row * 1024 + col0 + bj * HALF);
                    const f32x4 v0 = acc[ai][bj][m][0] + b0, v1 = acc[ai][bj][m][1] + b1;
                    u32x4 w;
                    w.x = cvt_pk_bf16(bflo(zz.x) * sigmoidf_(v0[0]), bfhi(zz.x) * sigmoidf_(v0[1]));
                    w.y = cvt_pk_bf16(bflo(zz.y) * sigmoidf_(v0[2]), bfhi(zz.y) * sigmoidf_(v0[3]));
                    w.z = cvt_pk_bf16(bflo(zz.z) * sigmoidf_(v1[0]), bfhi(zz.z) * sigmoidf_(v1[1]));
                    w.w = cvt_pk_bf16(bflo(zz.w) * sigmoidf_(v1[2]), bfhi(zz.w) * sigmoidf_(v1[3]));
                    *(u32x4*)(MIX + row * DM + 1024 + col0 + bj * HALF) = w; }
        }
    }
};
struct EpiE1 {
    unsigned char* H; const LAS int* cn; const LAS int* rb;
    __device__ __forceinline__ void operator()(const f32x4 (&acc)[2][2][4][2], const Unit& u, int wr, int wc, int fr, int fq) const {
        const int n = cn[u.e]; const int colh = u.pn * 128 + wc * 32 + 8 * fq;
#pragma unroll
        for (int ai = 0; ai < 2; ++ai)
#pragma unroll
            for (int m = 0; m < 4; ++m) { const int pos = u.pm * BM + ai * HALF + wr * 64 + m * 16 + fr;
                if (pos < n) { const int a = rb[u.e] + pos;
                    float sc = WSCALE_INV; asm volatile("" : "+v"(sc));
                    const f32x4 g0 = acc[ai][0][m][0] * sc, g1 = acc[ai][0][m][1] * sc, u0 = acc[ai][1][m][0] * sc, u1 = acc[ai][1][m][1] * sc;
                    u32x2 w;
                    w.x = (unsigned)__builtin_amdgcn_cvt_pk_fp8_f32(siluf_(g0[0]) * u0[0], siluf_(g0[1]) * u0[1], 0, false);
                    w.x = (unsigned)__builtin_amdgcn_cvt_pk_fp8_f32(siluf_(g0[2]) * u0[2], siluf_(g0[3]) * u0[3], (int)w.x, true);
                    w.y = (unsigned)__builtin_amdgcn_cvt_pk_fp8_f32(siluf_(g1[0]) * u1[0], siluf_(g1[1]) * u1[1], 0, false);
                    w.y = (unsigned)__builtin_amdgcn_cvt_pk_fp8_f32(siluf_(g1[2]) * u1[2], siluf_(g1[3]) * u1[3], (int)w.y, true);
                    *(u32x2*)(H + (size_t)a * EHID + colh) = w; }
                __builtin_amdgcn_sched_barrier(0); }
    }
};
struct EpiE2 {
    unsigned char* Y; const float* wgt; const LAS int* cn; const LAS int* rb;
    __device__ __forceinline__ void operator()(const f32x4 (&acc)[2][2][4][2], const Unit& u, int wr, int wc, int fr, int fq) const {
        const int n = cn[u.e]; const int col0 = u.pn * BM + wc * 32 + 8 * fq;
#pragma unroll
        for (int ai = 0; ai < 2; ++ai)
#pragma unroll
            for (int m = 0; m < 4; ++m) { const int pos = u.pm * BM + ai * HALF + wr * 64 + m * 16 + fr;
                if (pos < n) { const int a = rb[u.e] + pos; float ws = WSCALE_INV * 0.25f; asm volatile("" : "+v"(ws));
                    unsigned char* rowp = Y + (size_t)a * DM + col0;
#pragma unroll
                    for (int bj = 0; bj < 2; ++bj) { const f32x4 v0 = acc[ai][bj][m][0] * ws, v1 = acc[ai][bj][m][1] * ws;
                        u32x2 w;
                        w.x = (unsigned)__builtin_amdgcn_cvt_pk_fp8_f32(v0[0], v0[1], 0, false); w.x = (unsigned)__builtin_amdgcn_cvt_pk_fp8_f32(v0[2], v0[3], (int)w.x, true);
                        w.y = (unsigned)__builtin_amdgcn_cvt_pk_fp8_f32(v1[0], v1[1], 0, false); w.y = (unsigned)__builtin_amdgcn_cvt_pk_fp8_f32(v1[2], v1[3], (int)w.y, true);
                        *(u32x2*)(rowp + bj * HALF) = w; } }
                __builtin_amdgcn_sched_barrier(0); }
    }
};
}
struct KArgs {
    const float* in[34];
    float* out;
    unsigned char* ws;
    int ph_lo, ph_hi;
};
struct Params {
    float* out;
    unsigned char* ws;
    LAS unsigned long long* ptab;
    int ph_lo, ph_hi;
    __device__ __forceinline__ const float* inp(int k) const {
        const unsigned long long v = ptab[k];
        const unsigned lo = __builtin_amdgcn_readfirstlane((unsigned)v), hi = __builtin_amdgcn_readfirstlane((unsigned)(v >> 32));
        return (const float*)(((unsigned long long)hi << 32) | lo);
    }
};
struct Ctx {
    LAS unsigned char* lds;
    int tid, lane, wave, G, bid;
    int gw, ngw;
};

__device__ __forceinline__ void tr_item(const float* W, int N, bf16_t* WT, int ldt, int k0, int n0, int orow0, LAS float* scr, int lane) {
#pragma unroll 8
    for (int i = 0; i < 32; ++i) { const int kk = 2 * i + (lane >> 5); scr[kk * 33 + (lane & 31)] = W[(size_t)(k0 + kk) * N + n0 + (lane & 31)]; }
    LDS_WAIT(); asm volatile("" ::: "memory");
    const int c = lane & 7;
#pragma unroll
    for (int j = 0; j < 4; ++j) { const int n = (lane >> 3) + 8 * j; const LAS float* s = scr + (8 * c) * 33 + n;
        u32x4 o; o.x = cvt_pk_bf16(s[0 * 33], s[1 * 33]); o.y = cvt_pk_bf16(s[2 * 33], s[3 * 33]); o.z = cvt_pk_bf16(s[4 * 33], s[5 * 33]); o.w = cvt_pk_bf16(s[6 * 33], s[7 * 33]);
        *(u32x4*)(WT + (size_t)(orow0 + n) * ldt + k0 + 8 * c) = o; }
    LDS_WAIT(); asm volatile("" ::: "memory");
}
__device__ __forceinline__ void tr_item64(const float* W, int N, bf16_t* WT, int ldt, int k0, int n0, int orow0, LAS float* scr, int lane) {
    f32x4 v[16];
    const float* src = W + (size_t)(k0 + (lane >> 4)) * N + n0 + 4 * (lane & 15);
#pragma unroll
    for (int i = 0; i < 16; ++i) v[i] = __builtin_nontemporal_load((const f32x4*)(src + (size_t)(4 * i) * N));
#pragma unroll
    for (int i = 0; i < 16; ++i) { LAS float* d = scr + (4 * i + (lane >> 4)) * 65 + 4 * (lane & 15); d[0] = v[i][0]; d[1] = v[i][1]; d[2] = v[i][2]; d[3] = v[i][3]; }
    LDS_WAIT(); asm volatile("" ::: "memory");
    const int c = lane & 7;
#pragma unroll
    for (int j = 0; j < 8; ++j) { const int n = (lane >> 3) + 8 * j; const LAS float* s = scr + (8 * c) * 65 + n;
        u32x4 o; o.x = cvt_pk_bf16(s[0 * 65], s[1 * 65]); o.y = cvt_pk_bf16(s[2 * 65], s[3 * 65]); o.z = cvt_pk_bf16(s[4 * 65], s[5 * 65]); o.w = cvt_pk_bf16(s[6 * 65], s[7 * 65]);
        *(u32x4*)(WT + (size_t)(orow0 + n) * ldt + k0 + 8 * c) = o; }
    LDS_WAIT(); asm volatile("" ::: "memory");
}
__device__ __forceinline__ void tr_item64_fp8(const float* W, int N, unsigned char* WT, int ldt, int k0, int n0, int orow0, LAS float* scr, int lane, float wscale = pg8::WSCALE) {
    f32x4 v[16];
    const float* src = W + (size_t)(k0 + (lane >> 4)) * N + n0 + 4 * (lane & 15);
#pragma unroll
    for (int i = 0; i < 16; ++i) v[i] = __builtin_nontemporal_load((const f32x4*)(src + (size_t)(4 * i) * N));
#pragma unroll
    for (int i = 0; i < 16; ++i) { LAS float* d = scr + (4 * i + (lane >> 4)) * 65 + 4 * (lane & 15); d[0] = v[i][0]; d[1] = v[i][1]; d[2] = v[i][2]; d[3] = v[i][3]; }
    LDS_WAIT(); asm volatile("" ::: "memory");
    const int c = lane & 3;
#pragma unroll
    for (int j = 0; j < 4; ++j) { const int n = (lane >> 2) + 16 * j; const LAS float* s = scr + (16 * c) * 65 + n;
        u32x4 o;
        o.x = (unsigned)__builtin_amdgcn_cvt_pk_fp8_f32(s[0 * 65] * wscale, s[1 * 65] * wscale, 0, false);   o.x = (unsigned)__builtin_amdgcn_cvt_pk_fp8_f32(s[2 * 65] * wscale, s[3 * 65] * wscale, (int)o.x, true);
        o.y = (unsigned)__builtin_amdgcn_cvt_pk_fp8_f32(s[4 * 65] * wscale, s[5 * 65] * wscale, 0, false);   o.y = (unsigned)__builtin_amdgcn_cvt_pk_fp8_f32(s[6 * 65] * wscale, s[7 * 65] * wscale, (int)o.y, true);
        o.z = (unsigned)__builtin_amdgcn_cvt_pk_fp8_f32(s[8 * 65] * wscale, s[9 * 65] * wscale, 0, false);   o.z = (unsigned)__builtin_amdgcn_cvt_pk_fp8_f32(s[10 * 65] * wscale, s[11 * 65] * wscale, (int)o.z, true);
        o.w = (unsigned)__builtin_amdgcn_cvt_pk_fp8_f32(s[12 * 65] * wscale, s[13 * 65] * wscale, 0, false); o.w = (unsigned)__builtin_amdgcn_cvt_pk_fp8_f32(s[14 * 65] * wscale, s[15 * 65] * wscale, (int)o.w, true);
        *(u32x4*)(WT + (size_t)(orow0 + n) * ldt + k0 + 16 * c) = o; }
    LDS_WAIT(); asm volatile("" ::: "memory");
}
__device__ __forceinline__ void tr_dense(const float* W, int K, int N, bf16_t* WT, int item, LAS float* scr, int lane) {
    const int nblk = N / 32, kb = item / nblk, nb = item % nblk;
    tr_item(W, N, WT, K, 64 * kb, 32 * nb, 32 * nb, scr, lane);
}

__device__ __forceinline__ void s5_tables(const Params& p, Ctx& C, int dir, int g) {
    LAS f32x2* PW = (LAS f32x2*)C.lds;
    LAS f32x2* BB = PW + 65 * 64;
    LAS f32x2* CX = BB + 64 * 16;
    const float* a_re = p.inp(11); const float* a_im = p.inp(12); const float* log_dt = p.inp(13);
    const float* b_re = p.inp(14); const float* b_im = p.inp(15); const float* c_re = p.inp(16); const float* c_im = p.inp(17);
    const int tid = C.tid;
    if (tid < 64) {
        const int pp = tid;
        const float dt = __expf(log_dt[dir * 64 + g]);
        const float are = a_re[(dir * 64 + g) * 64 + pp], aim = a_im[(dir * 64 + g) * 64 + pp];
        const float zr = are * dt, zi = aim * dt;
        const float mag = __expf(zr);
        double rev = (double)zi * 0.15915494309189535; rev -= floor(rev);
        const float cs = __builtin_amdgcn_cosf((float)rev), sn = __builtin_amdgcn_sinf((float)rev);
        const float abr = mag * cs, abi = mag * sn;
        const float den = are * are + aim * aim, nr = abr - 1.0f, ni = abi;
        const float fre = (nr * are + ni * aim) / den, fim = (ni * are - nr * aim) / den;
        float pr = 1.0f, pi = 0.0f;
#pragma unroll 1
        for (int n = 0; n <= 64; ++n) { PW[n * 64 + pp] = (f32x2){pr, pi}; const float t = pr * abr - pi * abi; pi = pr * abi + pi * abr; pr = t; }
        for (int j = 0; j < 16; ++j) { const float br = b_re[(g * 64 + pp) * 16 + j], bi = b_im[(g * 64 + pp) * 16 + j];
            BB[pp * 16 + j] = (f32x2){fre * br - fim * bi, fre * bi + fim * br}; }
    }
    for (int q = tid; q < 1024; q += NTHR) { const int i = q >> 6, pp = q & 63; CX[i * 64 + pp] = (f32x2){c_re[(g * 16 + i) * 64 + pp], c_im[(g * 16 + i) * 64 + pp]}; }
    __syncthreads();
    bf16_t* KN = (bf16_t*)(p.ws + WS_KN) + (size_t)(dir * 64 + g) * 16 * 1024;
    float* APOW = (float*)(p.ws + WS_APOW) + (size_t)(dir * 64 + g) * 64 * 128;
    float* AL = (float*)(p.ws + WS_AL) + (size_t)(dir * 64 + g) * 128;
#pragma unroll 1
    for (int q = 0; q < 32; ++q) { const int idx = tid + NTHR * q; const int n = idx >> 8, i = (idx >> 4) & 15, j = idx & 15;
        float s = 0.f;
#pragma unroll 4
        for (int pp = 0; pp < 64; ++pp) { const f32x2 c = CX[i * 64 + pp], w = PW[n * 64 + pp], b = BB[pp * 16 + j];
            const float gr = c.x * b.x - c.y * b.y, gi = c.x * b.y + c.y * b.x;
            s += gr * w.x - gi * w.y; }
        KN[(size_t)i * 1024 + n * 16 + j] = f2bf(s); }
    for (int q = tid; q < 4096; q += NTHR) { const int t = q >> 6, pp = q & 63; const f32x2 w = PW[(t + 1) * 64 + pp]; *(f32x2*)(APOW + (size_t)t * 128 + 2 * pp) = w; }
    if (tid < 64) { const f32x2 w = PW[64 * 64 + tid]; *(f32x2*)(AL + 2 * tid) = w; }
    { bf16_t* BBT = (bf16_t*)(p.ws + WS_BBT) + (size_t)(dir * 64 + g) * 128 * 16;
      for (int q = tid; q < 2048; q += NTHR) { const int pq = q >> 4, j = q & 15; const f32x2 b = BB[(pq & 63) * 16 + j]; BBT[q] = f2bf(pq < 64 ? b.x : b.y); } }
    if (dir == 0) { bf16_t* CCt = (bf16_t*)(p.ws + WS_CC) + (size_t)g * 16 * 128;
        for (int q = tid; q < 2048; q += NTHR) { const int i = q >> 7, pq = q & 127; const f32x2 c = CX[i * 64 + (pq & 63)]; CCt[i * 128 + pq] = f2bf(pq < 64 ? c.x : -c.y); } }
    __syncthreads();
}

__device__ __forceinline__ void phase_p0(const Params& p, Ctx& C) {
    for (int task = C.bid; task < 128; task += C.G) s5_tables(p, C, task >> 6, task & 63);
    {
        const int gt = C.bid * NTHR + C.tid, ngt = C.G * NTHR;
        float* R128 = (float*)(p.ws + WS_ROPE128); float* R64 = (float*)(p.ws + WS_ROPE64);
        for (int q = gt; q < 256 * 64 + 256 * 32; q += ngt) {
            int pos, i, half; float* dst;
            if (q < 256 * 64) { pos = q >> 6; i = q & 63; half = 64; dst = R128 + (size_t)q * 2; }
            else { const int r = q - 256 * 64; pos = r >> 5; i = r & 31; half = 32; dst = R64 + (size_t)r * 2; }
            const float freq = exp2f(-(float)i / (float)half * 13.287712379549449f);
            const float ang = (float)pos * freq;
            double rev = (double)ang * 0.15915494309189535; rev -= floor(rev);
            dst[0] = __builtin_amdgcn_cosf((float)rev); dst[1] = __builtin_amdgcn_sinf((float)rev);
        }
        bf16_t* RWT = (bf16_t*)(p.ws + WS_RWT); const float* rw = p.inp(26);
        for (int q = gt; q < 2 * 64 * DM; q += ngt) { const int L = q / (64 * DM), r = q % (64 * DM), e = r / DM, k = r % DM;
            const float w = rw[((size_t)L * DM + k) * 64 + e]; const bf16_t hi = f2bf(w); const bf16_t lo = f2bf(w - bf2f(hi));
            RWT[((size_t)(L * 2 + 0) * 64 + e) * DM + k] = hi; RWT[((size_t)(L * 2 + 1) * 64 + e) * DM + k] = lo; }
    }
    {
        const float* cvec = p.inp(1); const float* cctx = p.inp(3); const float* mw = p.inp(4);
        float* MODP = (float*)(p.ws + WS_MODP);
        for (int task = C.gw; task < 2 * 32 * 48; task += C.ngw) {
            const int L = task / (32 * 48), r = task % (32 * 48), kb = r / 48, cb = r % 48;
            const float sc = siluf_(cvec[64 * kb + C.lane]), sx = siluf_(cctx[64 * kb + C.lane]);
            f32x4 a0 = {0.f, 0.f, 0.f, 0.f}, a1 = {0.f, 0.f, 0.f, 0.f};
            const float* wp = mw + ((size_t)L * DM + 64 * kb) * 12288 + 256 * cb + 4 * C.lane;
#pragma unroll 8
            for (int kk = 0; kk < 64; ++kk) { const f32x4 w = *(const f32x4*)(wp + (size_t)kk * 12288);
                const float s0 = __shfl(sc, kk), s1 = __shfl(sx, kk);
                a0 += w * s0; a1 += w * s1; }
            *(f32x4*)(MODP + ((size_t)((L * 32 + kb) * 2 + 0)) * 12288 + 256 * cb + 4 * C.lane) = a0;
            *(f32x4*)(MODP + ((size_t)((L * 32 + kb) * 2 + 1)) * 12288 + 256 * cb + 4 * C.lane) = a1;
        }
    }
    {
        LAS float* scr = (LAS float*)(C.lds + C.wave * 17408);
        constexpr int J0 = (DM / 64) * (EV_IN / 64), J3 = (DM / 64) * (OD_IN / 64);
        for (int it = C.gw; it < J0 + J3; it += C.ngw) {
            const bool l1 = it >= J0; const int r = l1 ? it - J0 : it; const int N = l1 ? OD_IN : EV_IN; const int nblk = N / 64, kb = r / nblk, nb = r % nblk;
            tr_item64_fp8(p.inp(l1 ? 21 : 8), N, (unsigned char*)(p.ws + (l1 ? WS_WIN1 : WS_WIN0)), DM, 64 * kb, 64 * nb, 64 * nb, scr, C.lane, 32.0f);
        }
        LAS float* scr2 = (LAS float*)(C.lds + C.wave * 17408);
        constexpr int I1 = (DM / 64) * (DM / 32), I2 = (1024 / 64) * (1024 / 32), I4 = I1;
        for (int it = C.gw; it < I1 + I2 + I4; it += C.ngw) {
            int r = it;
            if (r < I1) { tr_dense(p.inp(9), DM, DM, (bf16_t*)(p.ws + WS_WOUT0), r, scr2, C.lane); continue; } r -= I1;
            if (r < I2) { tr_dense(p.inp(19), 1024, 1024, (bf16_t*)(p.ws + WS_WGLU), r, scr2, C.lane); continue; } r -= I2;
            tr_dense(p.inp(22), DM, DM, (bf16_t*)(p.ws + WS_WOUT1), r, scr2, C.lane);
        }
    }
}
__device__ __forceinline__ void phase_p1(const Params& p, Ctx& C) {
    const float* MODP = (const float*)(p.ws + WS_MODP); float* MODF = (float*)(p.ws + WS_MODF); const float* mb = p.inp(5);
    for (int q = C.bid * NTHR + C.tid; q < 2 * 2 * 12288; q += C.G * NTHR) { const int L = q / (2 * 12288), v = (q / 12288) & 1, col = q % 12288;
        float s = mb[L * 12288 + col];
        float pv[32];
#pragma unroll
        for (int kb = 0; kb < 32; ++kb) pv[kb] = MODP[((size_t)((L * 32 + kb) * 2 + v)) * 12288 + col];
#pragma unroll
        for (int kb = 0; kb < 32; ++kb) s += pv[kb];
        MODF[q] = s; }
}
__device__ __forceinline__ const float* modv(const Params& p, int L, int v, int k) { return (const float*)(p.ws + WS_MODF) + (size_t)(L * 2 + v) * 12288 + k * DM; }

__device__ __forceinline__ void stage_vec(LAS float* dst, const float* src, int tid) { *(LAS f32x4*)(dst + 4 * tid) = *(const f32x4*)(src + 4 * tid); }
__device__ __forceinline__ void conv_item(const Params& p, Ctx& C, int L, int it) {
    LAS float* scr = (LAS float*)(C.lds + C.wave * 17408);
    unsigned char* GU = (unsigned char*)(p.ws + WS_GU) + (size_t)L * NEX1 * 1024 * DM; unsigned char* DT = (unsigned char*)(p.ws + WS_DT) + (size_t)L * NEX1 * DM * EHID;
    const int e = it / 768, r = it % 768, which = r >> 8, q = r & 255;
    if (which < 2) {
        const float* W = (e < 64) ? p.inp(28 + which) + ((size_t)(L * 64 + e)) * DM * EHID : p.inp(31 + which) + (size_t)L * DM * EHID;
        const int kb = q >> 3, nb = q & 7, n0 = 64 * nb;
        tr_item64_fp8(W, EHID, GU + (size_t)e * 1024 * DM, DM, 64 * kb, n0, 256 * (n0 >> 7) + (n0 & 127) + (which ? 128 : 0), scr, C.lane);
    } else {
        const float* W = (e < 64) ? p.inp(30) + ((size_t)(L * 64 + e)) * EHID * DM : p.inp(33) + (size_t)L * EHID * DM;
        const int kb = q >> 5, nb = q & 31;
        tr_item64_fp8(W, DM, DT + (size_t)e * DM * EHID, EHID, 64 * kb, 64 * nb, 64 * nb, scr, C.lane);
    }
}
__device__ __forceinline__ void conv_queue(const Params& p, Ctx& C, int quota) {
    unsigned* head = (unsigned*)(p.ws + WS_CTL) + CW_QUEUE + 128;
    const int batch = quota < 8 ? quota : 8;
    for (int done = 0; done < quota; done += batch) {
        int it0 = 0; if (C.lane == 0) it0 = (int)atomicAdd(head, (unsigned)batch);
        it0 = __builtin_amdgcn_readfirstlane(it0);
        if (it0 >= NEX1 * 768) break;
        for (int k = 0; k < batch && it0 + k < NEX1 * 768; ++k) conv_item(p, C, 1, it0 + k);
    }
}
__device__ __forceinline__ void phase_modulate(const Params& p, Ctx& C, int L) {
    unsigned char* XA8 = (unsigned char*)(p.ws + WS_XA);
    const float* X2 = (const float*)(p.ws + WS_HX2);
    LAS float* MV = (LAS float*)C.lds;
    for (int v = 0; v < 2; ++v) { stage_vec(MV + (v * 2 + 0) * DM, modv(p, L, v, 0), C.tid); stage_vec(MV + (v * 2 + 1) * DM, modv(p, L, v, 1), C.tid); }
    __syncthreads();
    for (int r = C.gw; r < TT; r += C.ngw) {
        const int v = r < CTXL ? 1 : 0;
        const float* src = (L == 0) ? (r < CTXL ? p.inp(2) + (size_t)r * DM : p.inp(0) + (size_t)(r - CTXL) * DM) : X2 + (size_t)r * DM;
        const LAS float* sh = MV + (v * 2 + 0) * DM; const LAS float* sc = MV + (v * 2 + 1) * DM;
        f32x4 xv[8];
#pragma unroll
        for (int j = 0; j < 8; ++j) xv[j] = *(const f32x4*)(src + 4 * (C.lane + 64 * j));
#pragma unroll
        for (int j = 0; j < 8; ++j) { const int c = 4 * (C.lane + 64 * j);
            const f32x4 x = xv[j], a = *(const LAS f32x4*)(sc + c), b = *(const LAS f32x4*)(sh + c);
            const f32x4 y = x * (a + 1.0f) + b;
            unsigned w = (unsigned)__builtin_amdgcn_cvt_pk_fp8_f32(y[0], y[1], 0, false); w = (unsigned)__builtin_amdgcn_cvt_pk_fp8_f32(y[2], y[3], (int)w, true);
            *(unsigned*)(XA8 + (size_t)r * DM + c) = w; }
    }
    __syncthreads();
    if (L == 0) { for (int it = C.gw; it < NEX1 * 768; it += C.ngw) conv_item(p, C, 0, it); }
    else conv_queue(p, C, 1 << 30);
}

__device__ __forceinline__ void phase_rope0(const Params& p, Ctx& C) {
    bf16_t* QKV = (bf16_t*)(p.ws + WS_BIG + BG_QKV);
    const f32x2* R128 = (const f32x2*)(p.ws + WS_ROPE128);
    for (int r = C.gw; r < TT; r += C.ngw) {
        bf16_t* row = QKV + (size_t)r * EV_IN;
        if (r < CTXL) {
#pragma unroll
            for (int j = 0; j < 2; ++j) { u32x4* q = (u32x4*)(row + 8 * (C.lane + 64 * j)); u32x4 w = *q;
                w.x = cvt_pk_bf16(bflo(w.x) * 0.0625f, bfhi(w.x) * 0.0625f); w.y = cvt_pk_bf16(bflo(w.y) * 0.0625f, bfhi(w.y) * 0.0625f);
                w.z = cvt_pk_bf16(bflo(w.z) * 0.0625f, bfhi(w.z) * 0.0625f); w.w = cvt_pk_bf16(bflo(w.w) * 0.0625f, bfhi(w.w) * 0.0625f); *q = w; }
        } else {
            const int l = r - CTXL, rp = l >> 6, cp = l & 63;
            float xa[16], xc[16]; f32x2 csv[8];
#pragma unroll
            for (int m = 0; m < 8; ++m) { const int pi = C.lane + 64 * m, blk = (pi >> 6) & 1, i = pi & 63; csv[m] = R128[(blk ? cp : rp) * 64 + i]; }
#pragma unroll
            for (int qk = 0; qk < 2; ++qk)
#pragma unroll
                for (int m = 0; m < 8; ++m) { const int pi = C.lane + 64 * m, head = pi >> 7, blk = (pi >> 6) & 1, i = pi & 63;
                    const bf16_t* b = row + qk * 1024 + head * 256 + blk * 128 + i; xa[qk * 8 + m] = bf2f(b[0]); xc[qk * 8 + m] = bf2f(b[64]); }
#pragma unroll
            for (int qk = 0; qk < 2; ++qk)
#pragma unroll
                for (int m = 0; m < 8; ++m) { const int pi = C.lane + 64 * m, head = pi >> 7, blk = (pi >> 6) & 1, i = pi & 63;
                    bf16_t* b = row + qk * 1024 + head * 256 + blk * 128 + i;
                    const f32x2 cs = csv[m];
                    const float x1 = xa[qk * 8 + m], x2 = xc[qk * 8 + m]; const float sc = qk ? 1.0f : 0.0625f;
                    b[0] = f2bf((x1 * cs.x - x2 * cs.y) * sc); b[64] = f2bf((x1 * cs.y + x2 * cs.x) * sc); }
        }
    }
}

__device__ __forceinline__ void phase_normrope1(const Params& p, Ctx& C) {
    bf16_t* QKV = (bf16_t*)(p.ws + WS_BIG + BG_QKV);
    const f32x2* R64 = (const f32x2*)(p.ws + WS_ROPE64);
    const float* qg = p.inp(23);
    unsigned char* Q8 = (unsigned char*)(p.ws + WS_BIG + BG_Q8); unsigned char* K8 = (unsigned char*)(p.ws + WS_BIG + BG_K8); unsigned char* VT8 = (unsigned char*)(p.ws + WS_BIG + BG_VT8);
    unsigned char* Q8D = (unsigned char*)(p.ws + WS_BIG + BG_Q8D); unsigned char* K8D = (unsigned char*)(p.ws + WS_BIG + BG_K8D); unsigned char* VT8D = (unsigned char*)(p.ws + WS_BIG + BG_VT8D);
    const int lane = C.lane, i32 = lane & 31; const bool up = lane >= 32;
    const float g00 = qg[lane], g01 = qg[64 + lane], g10 = qg[128 + lane], g11 = qg[128 + 64 + lane];
    for (int r = C.gw; r < TT; r += C.ngw) {
        bf16_t* row = QKV + (size_t)r * OD_IN;
        const bool lat = r >= CTXL; const int l = r - CTXL, rp = lat ? (l >> 6) : 0, cp = lat ? (l & 63) : 0;
        const f32x2 cr = R64[rp * 32 + i32], cc = R64[cp * 32 + i32];
        float rv0[26], rv1[26];
#pragma unroll
        for (int h = 0; h < 26; ++h) {
            const int col = h < 8 ? 128 * h : (h < 10 ? 1024 + 128 * (h - 8) : (h < 18 ? 1536 + 128 * (h - 10) : 2560 + 128 * (h - 18)));
            rv0[h] = bf2f(row[col + lane]); rv1[h] = bf2f(row[col + 64 + lane]); }
#pragma unroll
        for (int h = 0; h < 26; ++h) {
            const int col = h < 8 ? 128 * h : (h < 10 ? 1024 + 128 * (h - 8) : (h < 18 ? 1536 + 128 * (h - 10) : 2560 + 128 * (h - 18)));
            bf16_t* b = row + col;
            float v0 = rv0[h], v1 = rv1[h];
            if (h < 10) { const float ss = wave_sum(v0 * v0 + v1 * v1); const float rs = rsqrtf(ss * (1.0f / 128.0f) + LN_EPS);
                v0 = bf2f(f2bf(v0 * rs)) * (h < 8 ? g00 : g10); v1 = bf2f(f2bf(v1 * rs)) * (h < 8 ? g01 : g11); }
            if (lat) { const float p0 = __shfl_xor(v0, 32), p1 = __shfl_xor(v1, 32);
                v0 = up ? (p0 * cr.y + v0 * cr.x) : (v0 * cr.x - p0 * cr.y);
                v1 = up ? (p1 * cc.y + v1 * cc.x) : (v1 * cc.x - p1 * cc.y); }
            const bf16_t o0 = f2bf(v0), o1 = f2bf(v1);
            b[lane] = o0; b[64 + lane] = o1;
            {
                const float qs = (h < 8 || (h >= 10 && h < 18)) ? 0.088388347648318440f * 1.4426950408889634f : 1.0f;
                const float w0 = bf2f(o0) * qs, w1 = bf2f(o1) * qs;
                float e4[4];
#pragma unroll
                for (int j = 0; j < 4; ++j) { const float a = __shfl(w0, (4 * lane + j) & 63), c2 = __shfl(w1, (4 * lane + j) & 63); e4[j] = lane < 16 ? a : c2; }
                unsigned pk = (unsigned)__builtin_amdgcn_cvt_pk_fp8_f32(e4[0], e4[1], 0, false); pk = (unsigned)__builtin_amdgcn_cvt_pk_fp8_f32(e4[2], e4[3], (int)pk, true);
                unsigned char* dst8 = h < 8 ? Q8 + (size_t)r * 1024 + 128 * h : (h < 10 ? K8 + (size_t)r * 256 + 128 * (h - 8) : (h < 18 ? Q8D + (size_t)r * 1024 + 128 * (h - 10) : K8D + (size_t)r * 1024 + 128 * (h - 18)));
                if (lane < 32) *(unsigned*)(dst8 + 4 * lane) = pk; }
        }
    }
    LAS bf16_t* vt = (LAS bf16_t*)(C.lds + C.wave * 17408);
    for (int item = C.gw; item < 10 * 260; item += C.ngw) {
        const int kh = item / 260, T = item % 260;
        const int vcol = kh < 2 ? 1280 + 128 * kh : 3584 + 128 * (kh - 2);
        unsigned char* vout = kh < 2 ? VT8 + (size_t)kh * 260 * 8192 : VT8D + (size_t)(kh - 2) * 260 * 8192;
#pragma unroll
        for (int q = 0; q < 16; ++q) { const int idx = lane + 64 * q, key = idx >> 4, c = idx & 15;
            *(LAS u32x4*)(vt + key * 136 + 8 * c) = *(const u32x4*)(QKV + (size_t)(64 * T + key) * OD_IN + vcol + 8 * c); }
        LDS_WAIT(); asm volatile("" ::: "memory");
#pragma unroll
        for (int dd = 0; dd < 2; ++dd) { const int d = lane + 64 * dd;
            unsigned char* dst = vout + ((size_t)T * 128 + d) * 64;
#pragma unroll
            for (int cch = 0; cch < 4; ++cch) { u32x4 w;
#pragma unroll
                for (int wd = 0; wd < 4; ++wd) { float f[4];
#pragma unroll
                    for (int e = 0; e < 4; ++e) { const int bb = 16 * cch + 4 * wd + e, hi2 = bb >> 5, blk = (bb >> 4) & 1, j = bb & 15; const int key = 32 * blk + (j & 3) + 8 * (j >> 2) + 4 * hi2;
                        f[e] = bf2f(vt[key * 136 + d]); }
                    unsigned pk = (unsigned)__builtin_amdgcn_cvt_pk_fp8_f32(f[0], f[1], 0, false); pk = (unsigned)__builtin_amdgcn_cvt_pk_fp8_f32(f[2], f[3], (int)pk, true);
                    w[wd] = pk; }
                *(u32x4*)(dst + 16 * cch) = w; } }
        LDS_WAIT(); asm volatile("" ::: "memory");
    }
}

__device__ __forceinline__ void phase_merge1(const Params& p, Ctx& C) {
    bf16_t* ATT = (bf16_t*)(p.ws + WS_BIG + BG_ATT);
    const float* dl = p.inp(24); const float* sg = p.inp(25);
    const int lane = C.lane;
    float d0 = dl[lane] * dl[128 + lane] + dl[64 + lane] * dl[128 + 64 + lane];
    float d1 = dl[256 + lane] * dl[384 + lane] + dl[256 + 64 + lane] * dl[384 + 64 + lane];
    const float lam = __expf(wave_sum(d0)) - __expf(wave_sum(d1)) + LAMBDA_INIT;
    const f32x4 gg = *(const f32x4*)(sg + 4 * lane);
    for (int l = C.gw; l < SEQ; l += C.ngw) {
        bf16_t* row = ATT + (size_t)l * 3072;
        u32x2 av[4], bv[4];
#pragma unroll
        for (int h = 0; h < 4; ++h) { av[h] = *(const u32x2*)(row + 1024 + 256 * h + 4 * lane); bv[h] = *(const u32x2*)(row + 2048 + 256 * h + 4 * lane); }
#pragma unroll
        for (int h = 0; h < 4; ++h) {
            const u32x2 a = av[h], b = bv[h];
            f32x4 o = {bflo(a.x) - lam * bflo(b.x), bfhi(a.x) - lam * bfhi(b.x), bflo(a.y) - lam * bflo(b.y), bfhi(a.y) - lam * bfhi(b.y)};
            const float ss = wave_sum(o[0] * o[0] + o[1] * o[1] + o[2] * o[2] + o[3] * o[3]);
            const float rs = rsqrtf(ss * (1.0f / 256.0f) + LN_EPS) * (1.0f - LAMBDA_INIT);
            o = o * rs * gg;
            u32x2 w; w.x = cvt_pk_bf16(o[0], o[1]); w.y = cvt_pk_bf16(o[2], o[3]);
            *(u32x2*)(row + 1024 + 256 * h + 4 * lane) = w;
        }
    }
}

__device__ __forceinline__ void phase_ln1(const Params& p, Ctx& C, int L) {
    const bf16_t* Y = (const bf16_t*)(p.ws + WS_YMIX); float* X1 = (float*)(p.ws + WS_X1); unsigned char* XA8 = (unsigned char*)(p.ws + WS_XA);
    const float* X2 = (const float*)(p.ws + WS_HX2);
    const float* lg = p.inp(6) + (size_t)(L * 2 + 0) * DM; const float* lb = p.inp(7) + (size_t)(L * 2 + 0) * DM;
    const int r0 = (L == 0) ? 0 : CTXL;
    LAS float* MV = (LAS float*)C.lds; LAS float* LG = MV + 6 * DM; LAS float* LB = LG + DM;
    for (int v = 0; v < 2; ++v) for (int k = 0; k < 3; ++k) stage_vec(MV + (v * 3 + k) * DM, modv(p, L, v, 2 + k), C.tid);
    stage_vec(LG, lg, C.tid); stage_vec(LB, lb, C.tid);
    __syncthreads();
    for (int r = r0 + C.gw; r < TT; r += C.ngw) {
        const int v = r < CTXL ? 1 : 0;
        const float* src = (L == 0) ? (r < CTXL ? p.inp(2) + (size_t)r * DM : p.inp(0) + (size_t)(r - CTXL) * DM) : X2 + (size_t)r * DM;
        const LAS float* g1 = MV + (v * 3 + 0) * DM; const LAS float* sh2 = MV + (v * 3 + 1) * DM; const LAS float* sc2 = MV + (v * 3 + 2) * DM;
        f32x4 t[8]; float s = 0.f;
#pragma unroll
        for (int j = 0; j < 8; ++j) { const int c = 4 * (C.lane + 64 * j);
            const f32x4 x = *(const f32x4*)(src + c), g = *(const LAS f32x4*)(g1 + c); const u32x2 yy = *(const u32x2*)(Y + (size_t)r * DM + c);
            const f32x4 y = {bflo(yy.x), bfhi(yy.x), bflo(yy.y), bfhi(yy.y)};
            t[j] = x * ALPHA + g * y; s += (t[j][0] + t[j][1]) + (t[j][2] + t[j][3]); }
        const float mean = wave_sum(s) * (1.0f / DM); float s2 = 0.f;
#pragma unroll
        for (int j = 0; j < 8; ++j) { t[j] = t[j] - mean; s2 += (t[j][0] * t[j][0] + t[j][1] * t[j][1]) + (t[j][2] * t[j][2] + t[j][3] * t[j][3]); }
        const float rstd = rsqrtf(wave_sum(s2) * (1.0f / DM) + LN_EPS);
#pragma unroll
        for (int j = 0; j < 8; ++j) { const int c = 4 * (C.lane + 64 * j);
            const f32x4 x1 = t[j] * rstd * *(const LAS f32x4*)(LG + c) + *(const LAS f32x4*)(LB + c);
            *(f32x4*)(X1 + (size_t)r * DM + c) = x1;
            const f32x4 z = x1 * (*(const LAS f32x4*)(sc2 + c) + 1.0f) + *(const LAS f32x4*)(sh2 + c);
            unsigned w = (unsigned)__builtin_amdgcn_cvt_pk_fp8_f32(z[0], z[1], 0, false); w = (unsigned)__builtin_amdgcn_cvt_pk_fp8_f32(z[2], z[3], (int)w, true);
            *(unsigned*)(XA8 + (size_t)r * DM + c) = w; }
    }
    __syncthreads();
}

__device__ __forceinline__ void phase_combine(const Params& p, Ctx& C, int L, LAS unsigned char* misc) {
    const unsigned char* YM = (const unsigned char*)(p.ws + WS_BIG + BG_YMOE); const float* X1 = (const float*)(p.ws + WS_X1);
    float* X2 = (float*)(p.ws + WS_HX2);
    const float* lg = p.inp(6) + (size_t)(L * 2 + 1) * DM; const float* lb = p.inp(7) + (size_t)(L * 2 + 1) * DM;
    const unsigned* PK = (const unsigned*)(p.ws + WS_WGT); const int* cnt = (const int*)(p.ws + WS_CTL) + CW_CNT + L * 128; const float* LWT = (const float*)(p.ws + WS_LW);
    const int r0 = (L == 0) ? 0 : CTXL;
    LAS int* rb = (LAS int*)(misc + 64);
    LAS float* MV = (LAS float*)C.lds; LAS float* LG = MV + 2 * DM; LAS float* LB = LG + DM;
    __syncthreads();
    if (C.tid == 0) { int q = 0; for (int e = 0; e < NEX1; ++e) { rb[e] = q; q += cnt[e]; } }
    stage_vec(MV, modv(p, L, 0, 5), C.tid); stage_vec(MV + DM, modv(p, L, 1, 5), C.tid); stage_vec(LG, lg, C.tid); stage_vec(LB, lb, C.tid);
    LAS float* M1 = LB + DM;
    unsigned char* XA8 = (unsigned char*)(p.ws + WS_XA);
    if (L == 0) { for (int v = 0; v < 2; ++v) { stage_vec(M1 + (v * 2 + 0) * DM, modv(p, 1, v, 0), C.tid); stage_vec(M1 + (v * 2 + 1) * DM, modv(p, 1, v, 1), C.tid); } }
    __syncthreads();
    for (int r = r0 + C.gw; r < TT; r += C.ngw) {
        const int v = r < CTXL ? 1 : 0;
        const LAS float* g2 = MV + v * DM;
        int ln = C.lane; asm volatile("" : "+v"(ln));
        int slot = rb[64] + (r - r0);
        float wk = 4.0f;
        if (ln < 8) { const unsigned pk = PK[(size_t)r * 8 + ln]; wk = LWT[(size_t)r * 8 + ln]; slot = rb[pk >> 16] + (int)(pk & 0xffffu); }
        f32x4 t[2][4]; float s = 0.f;
#pragma unroll
        for (int j = 0; j < 2; ++j) { const int c = 16 * (ln + 64 * j);
            u32x4 yy[9];
#pragma unroll
            for (int k = 0; k < 9; ++k) { const size_t a = (size_t)__builtin_amdgcn_readlane(slot, k); yy[k] = __builtin_nontemporal_load((const u32x4*)(YM + a * DM + c)); }
            f32x2 f[8];
#pragma unroll
            for (int q = 0; q < 8; ++q) f[q] = (f32x2){0.f, 0.f};
#pragma unroll
            for (int k = 0; k < 9; ++k) { const float wq = __int_as_float(__builtin_amdgcn_readlane(__float_as_int(wk), k));
                f[0] += wq * __builtin_amdgcn_cvt_pk_f32_fp8((int)yy[k].x, false); f[1] += wq * __builtin_amdgcn_cvt_pk_f32_fp8((int)yy[k].x, true);
                f[2] += wq * __builtin_amdgcn_cvt_pk_f32_fp8((int)yy[k].y, false); f[3] += wq * __builtin_amdgcn_cvt_pk_f32_fp8((int)yy[k].y, true);
                f[4] += wq * __builtin_amdgcn_cvt_pk_f32_fp8((int)yy[k].z, false); f[5] += wq * __builtin_amdgcn_cvt_pk_f32_fp8((int)yy[k].z, true);
                f[6] += wq * __builtin_amdgcn_cvt_pk_f32_fp8((int)yy[k].w, false); f[7] += wq * __builtin_amdgcn_cvt_pk_f32_fp8((int)yy[k].w, true); }
#pragma unroll
            for (int q = 0; q < 4; ++q) { const f32x4 x = *(const f32x4*)(X1 + (size_t)r * DM + c + 4 * q), g = *(const LAS f32x4*)(g2 + c + 4 * q);
                const f32x4 ff = {f[2 * q][0], f[2 * q][1], f[2 * q + 1][0], f[2 * q + 1][1]};
                t[j][q] = x * ALPHA + g * ff; s += (t[j][q][0] + t[j][q][1]) + (t[j][q][2] + t[j][q][3]); } }
        const float mean = wave_sum(s) * (1.0f / DM); float s2 = 0.f;
#pragma unroll
        for (int j = 0; j < 2; ++j)
#pragma unroll
            for (int q = 0; q < 4; ++q) { t[j][q] = t[j][q] - mean; s2 += (t[j][q][0] * t[j][q][0] + t[j][q][1] * t[j][q][1]) + (t[j][q][2] * t[j][q][2] + t[j][q][3] * t[j][q][3]); }
        const float rstd = rsqrtf(wave_sum(s2) * (1.0f / DM) + LN_EPS);
        float* dst = (L == 0) ? X2 + (size_t)r * DM : p.out + (size_t)(r - CTXL) * DM;
#pragma unroll
        for (int j = 0; j < 2; ++j)
#pragma unroll
            for (int q = 0; q < 4; ++q) { const int c = 16 * (ln + 64 * j) + 4 * q;
                const f32x4 xn = t[j][q] * rstd * *(const LAS f32x4*)(LG + c) + *(const LAS f32x4*)(LB + c);
                *(f32x4*)(dst + c) = xn;
                if (L == 0) { const f32x4 y = xn * (*(const LAS f32x4*)(M1 + (v * 2 + 1) * DM + c) + 1.0f) + *(const LAS f32x4*)(M1 + (v * 2 + 0) * DM + c);
                    unsigned w = (unsigned)__builtin_amdgcn_cvt_pk_fp8_f32(y[0], y[1], 0, false); w = (unsigned)__builtin_amdgcn_cvt_pk_fp8_f32(y[2], y[3], (int)w, true);
                    *(unsigned*)(XA8 + (size_t)r * DM + c) = w; } }
    }
    if (L == 0) { __syncthreads(); conv_queue(p, C, 1 << 30); }
}
constexpr int RLD = 264;
constexpr int SLD = 136;

template <bool SCALE>
__device__ __forceinline__ void stage_chunk(const bf16_t* QKV, int row0, int col0, LAS bf16_t* dst, int tid, float lg  , int dirb) {
#pragma unroll
    for (int q = 0; q < 8; ++q) { const int idx = tid + NTHR * q, r = idx >> 5, c = idx & 31;
        u32x4 w = *(const u32x4*)(QKV + (size_t)(row0 + r) * EV_IN + col0 + 8 * c);
        if (SCALE) { const float sc = fast_exp((dirb ? (float)r : (float)(127 - r)) * lg);
            w.x = cvt_pk_bf16(bflo(w.x) * sc, bfhi(w.x) * sc); w.y = cvt_pk_bf16(bflo(w.y) * sc, bfhi(w.y) * sc);
            w.z = cvt_pk_bf16(bflo(w.z) * sc, bfhi(w.z) * sc); w.w = cvt_pk_bf16(bflo(w.w) * sc, bfhi(w.w) * sc); }
        *(LAS u32x4*)(dst + r * RLD + 8 * c) = w; }
}

__device__ __forceinline__ void ret_chunk_kv(const Params& p, Ctx& C) {
    const bf16_t* QKV = (const bf16_t*)(p.ws + WS_BIG + BG_QKV); bf16_t* CKV = (bf16_t*)(p.ws + WS_BIG + BG_CKV);
    const float* rld = p.inp(10);
    LAS bf16_t* Vs = (LAS bf16_t*)C.lds; LAS bf16_t* Ks = Vs + 128 * RLD;
    const int lane = C.lane, w = C.wave;
    for (int unit = C.bid; unit < 130 * 8; unit += C.G) {
        const int u = unit >> 3, h = (unit >> 1) & 3, dir = unit & 1;
        const float lg = rld[dir * 4 + h];
        __syncthreads();
        stage_chunk<false>(QKV, 128 * u, 2048 + 256 * h, Vs, C.tid, 0.f, 0);
        stage_chunk<true>(QKV, 128 * u, 1024 + 256 * h, Ks, C.tid, lg, dir);
        __syncthreads();
        f32x4 acc[2][16];
#pragma unroll
        for (int a = 0; a < 2; ++a)
#pragma unroll
            for (int b = 0; b < 16; ++b) acc[a][b] = (f32x4){0.f, 0.f, 0.f, 0.f};
        const unsigned vbase = (unsigned)(uintptr_t)Vs, kbase = (unsigned)(uintptr_t)Ks;
#pragma unroll 1
        for (int ks = 0; ks < 4; ++ks) {
            bf16x8 af[2];
#pragma unroll
            for (int a = 0; a < 2; ++a) af[a] = frag_colk_l(vbase + (unsigned)((32 * ks) * RLD + 32 * w + 16 * a) * 2u, RLD * 2, lane);
#pragma unroll
            for (int b = 0; b < 16; ++b) { const bf16x8 bf = frag_colk_l(kbase + (unsigned)((32 * ks) * RLD + 16 * b) * 2u, RLD * 2, lane);
                acc[0][b] = MFMA16(bf, af[0], acc[0][b]); acc[1][b] = MFMA16(bf, af[1], acc[1][b]); }
        }
        bf16_t* dst = CKV + ((size_t)((dir * 4 + h) * 130 + u)) * 65536;
#pragma unroll
        for (int a = 0; a < 2; ++a)
#pragma unroll
            for (int b = 0; b < 16; ++b) { u32x2 w2; w2.x = cvt_pk_bf16(acc[a][b][0], acc[a][b][1]); w2.y = cvt_pk_bf16(acc[a][b][2], acc[a][b][3]);
                *(u32x2*)(dst + (size_t)(32 * w + 16 * a + (lane & 15)) * 256 + 16 * b + 4 * (lane >> 4)) = w2; }
    }
    __syncthreads();
}

__device__ __forceinline__ int s5_row(int dir, int c, int s) { return dir == 0 ? 64 * c + s : (c < 4 ? 255 - (64 * c + s) : 16639 - 64 * (c - 4) - s); }

__device__ __forceinline__ void s5_end_states(const Params& p, Ctx& C) {
    const bf16_t* QKV = (const bf16_t*)(p.ws + WS_BIG + BG_QKV); const bf16_t* BBT = (const bf16_t*)(p.ws + WS_BBT); float* E = (float*)(p.ws + WS_S5E);
    const float* APOW = (const float*)(p.ws + WS_APOW);
    LAS f32x2* PL = (LAS f32x2*)C.lds;
    for (int bt = C.bid; bt < 256; bt += C.G) {
        int tid = C.tid; asm volatile("" : "+v"(tid));
        const int lane = tid & 63, r32 = lane & 31, hi = lane >> 5;
        const int dg = bt >> 1, dir = dg >> 6, g = dg & 63, c0 = 130 * (bt & 1);
        __syncthreads();
#pragma unroll
        for (int q = 0; q < 8; ++q) { const int idx = tid + NTHR * q, s = idx >> 6, pp = idx & 63;
            PL[idx] = (s == 63) ? (f32x2){1.0f, 0.0f} : *(const f32x2*)(APOW + ((size_t)dg * 64 + (62 - s)) * 128 + 2 * pp); }
        __syncthreads();
        bf16x8 bfr[4];
#pragma unroll
        for (int pt = 0; pt < 4; ++pt) bfr[pt] = *(const bf16x8*)(BBT + ((size_t)dg * 128 + 32 * pt + r32) * 16 + 8 * hi);
        for (int c = c0 + C.wave; c < c0 + 130; c += 8) {
            float er[2] = {0.f, 0.f}, ei[2] = {0.f, 0.f};
#pragma unroll
            for (int st = 0; st < 2; ++st) {
                const bf16x8 a = *(const bf16x8*)(QKV + (size_t)s5_row(dir, c, 32 * st + r32) * EV_IN + 4096 + 16 * g + 8 * hi);
                f32x16 d[4];
#pragma unroll
                for (int pt = 0; pt < 4; ++pt) d[pt] = __builtin_amdgcn_mfma_f32_32x32x16_bf16(a, bfr[pt], (f32x16){}, 0, 0, 0);
#pragma unroll
                for (int r = 0; r < 16; ++r) { const int s = 32 * st + (r & 3) + 8 * (r >> 2) + 4 * hi;
#pragma unroll
                    for (int pt = 0; pt < 2; ++pt) { const f32x2 pw = PL[s * 64 + 32 * pt + r32]; const float br = d[pt][r], bi = d[pt + 2][r];
                        er[pt] += pw.x * br - pw.y * bi; ei[pt] += pw.x * bi + pw.y * br; } }
            }
#pragma unroll
            for (int pt = 0; pt < 2; ++pt) {
                { auto rr = __builtin_amdgcn_permlane32_swap(__float_as_uint(er[pt]), __float_as_uint(er[pt]), false, false); er[pt] = __uint_as_float(rr[0]) + __uint_as_float(rr[1]); }
                { auto rr = __builtin_amdgcn_permlane32_swap(__float_as_uint(ei[pt]), __float_as_uint(ei[pt]), false, false); ei[pt] = __uint_as_float(rr[0]) + __uint_as_float(rr[1]); }
            }
            float* dst = E + ((size_t)dg * 260 + c) * 128;
            if (hi == 0) { dst[r32] = er[0]; dst[32 + r32] = er[1]; dst[64 + r32] = ei[0]; dst[96 + r32] = ei[1]; }
        }
    }
    __syncthreads();
}

__device__ __forceinline__ void phase_scans(const Params& p, Ctx& C) {
    const bf16_t* CKV = (const bf16_t*)(p.ws + WS_BIG + BG_CKV); bf16_t* SP = (bf16_t*)(p.ws + WS_BIG + BG_SPREV);
    const float* rld = p.inp(10);
    for (int q = C.bid * NTHR + C.tid; q < 8 * 16384; q += C.G * NTHR) {
        const int dh = q >> 14, el = (q & 16383) * 4, dir = dh >> 2, h = dh & 3;
        const float gch = fast_exp(128.0f * rld[dir * 4 + h]);
        const bf16_t* src = CKV + (size_t)dh * 130 * 65536 + el; bf16_t* dst = SP + (size_t)dh * 130 * 65536 + el;
        f32x4 s = {0.f, 0.f, 0.f, 0.f};
        for (int st0 = 0; st0 < 130; st0 += 13) {
            u32x2 kv[13];
#pragma unroll
            for (int k = 0; k < 13; ++k) { const int st = st0 + k; const int u = dir == 0 ? st : (st == 0 ? 1 : (st == 1 ? 0 : 131 - st)); kv[k] = __builtin_nontemporal_load((const u32x2*)(src + (size_t)u * 65536)); }
#pragma unroll
            for (int k = 0; k < 13; ++k) { const int st = st0 + k; const int u = dir == 0 ? st : (st == 0 ? 1 : (st == 1 ? 0 : 131 - st));
                u32x2 w; w.x = cvt_pk_bf16(s[0], s[1]); w.y = cvt_pk_bf16(s[2], s[3]); *(u32x2*)(dst + (size_t)u * 65536) = w;
                s = s * gch + (f32x4){bflo(kv[k].x), bfhi(kv[k].x), bflo(kv[k].y), bfhi(kv[k].y)}; }
        }
    }
    const float* E = (const float*)(p.ws + WS_S5E); float* HST = (float*)(p.ws + WS_HST); const float* AL = (const float*)(p.ws + WS_AL);
    for (int q = C.bid * NTHR + C.tid; q < 2 * 64 * 64; q += C.G * NTHR) {
        const int dg = q >> 6, pp = q & 63;
        const f32x2 al = *(const f32x2*)(AL + (size_t)dg * 128 + 2 * pp);
        const float* e = E + (size_t)dg * 260 * 128; float* hs = HST + (size_t)dg * 260 * 128;
        float hr = 0.f, hi = 0.f;
        for (int c0 = 0; c0 < 260; c0 += 26) {
            float er[26], ei[26];
#pragma unroll
            for (int k = 0; k < 26; ++k) { er[k] = e[(size_t)(c0 + k) * 128 + pp]; ei[k] = e[(size_t)(c0 + k) * 128 + 64 + pp]; }
#pragma unroll
            for (int k = 0; k < 26; ++k) { *(f32x2*)(hs + (size_t)(c0 + k) * 128 + 2 * pp) = (f32x2){hr, hi};
                const float t = al.x * hr - al.y * hi + er[k]; hi = al.x * hi + al.y * hr + ei[k]; hr = t; }
        }
    }
}

__device__ __forceinline__ void ret_output_unit(const Params& p, Ctx& C, int unit) {
    const bf16_t* QKV = (const bf16_t*)(p.ws + WS_BIG + BG_QKV); const bf16_t* SP = (const bf16_t*)(p.ws + WS_BIG + BG_SPREV);
    bf16_t* MIX = (bf16_t*)(p.ws + WS_BIG + BG_MIX);
    const float* rld = p.inp(10);
    LAS bf16_t* RA = (LAS bf16_t*)C.lds; LAS bf16_t* RB = RA + 128 * RLD;
    int tid = C.tid; asm volatile("" : "+v"(tid));
    const int lane = tid & 63, w = C.wave, kq = lane >> 4, fr = lane & 15;
    const int u = unit >> 2, h = unit & 3;
    const float lgf = rld[h], lgb = rld[4 + h];
    stage_chunk<false>(QKV, 128 * u, 256 * h, RA, tid, 0.f, 0);
    int ib = 16 * w + 4 * kq, jb = fr; asm volatile("" : "+v"(ib), "+v"(jb));
    f32x4 acc[16];
#pragma unroll
    for (int t = 0; t < 16; ++t) acc[t] = (f32x4){0.f, 0.f, 0.f, 0.f};
#pragma unroll
    for (int dir = 0; dir < 2; ++dir) {
        const bf16_t* Sd = SP + ((size_t)((dir * 4 + h) * 130 + u)) * 65536;
#pragma unroll
        for (int eh = 0; eh < 2; ++eh) {
            __syncthreads();
#pragma unroll
            for (int q = 0; q < 8; ++q) { const int idx = tid + NTHR * q, rr = idx >> 5, c = idx & 31;
                *(LAS u32x4*)(RB + rr * RLD + 8 * c) = *(const u32x4*)(Sd + (size_t)(128 * eh + rr) * 256 + 8 * c);
                if (q == 3) asm volatile("" ::: "memory"); }
            __syncthreads();
#pragma unroll 1
            for (int ks = 0; ks < 8; ++ks) { const bf16x8 af = frag_rowk_l(RA + (16 * w) * RLD + 32 * ks, RLD, lane);
#pragma unroll
                for (int t = 0; t < 8; ++t) { const bf16x8 bf = frag_rowk_l(RB + (16 * t) * RLD + 32 * ks, RLD, lane); acc[8 * eh + t] = MFMA16(af, bf, acc[8 * eh + t]); } }
        }
#pragma unroll
        for (int r = 0; r < 4; ++r) { const int i = ib + r; const float qd = fast_exp((float)(128 - i) * lgb);
            const float f = (dir == 0) ? fast_exp((float)(i + 1) * lgf) / qd : qd;
#pragma unroll
            for (int t = 0; t < 16; ++t) acc[t][r] *= f; }
    }
    __syncthreads();
    stage_chunk<false>(QKV, 128 * u, 1024 + 256 * h, RB, tid, 0.f, 0);
    __syncthreads();
    f32x4 sc[8];
#pragma unroll
    for (int t = 0; t < 8; ++t) sc[t] = (f32x4){0.f, 0.f, 0.f, 0.f};
#pragma unroll 1
    for (int ks = 0; ks < 8; ++ks) { const bf16x8 af = frag_rowk_l(RA + (16 * w) * RLD + 32 * ks, RLD, lane);
#pragma unroll
        for (int t = 0; t < 8; ++t) { const bf16x8 bf = frag_rowk_l(RB + (16 * t) * RLD + 32 * ks, RLD, lane); sc[t] = MFMA16(af, bf, sc[t]); } }
#pragma unroll
    for (int t = 0; t < 8; ++t)
#pragma unroll
        for (int r = 0; r < 4; ++r) { const int i = ib + r, j = 16 * t + jb; const float d = (float)(i - j);
            const float m = (i >= j ? fast_exp(d * lgf) : 0.f) + (j >= i ? fast_exp(-d * lgb) : 0.f); sc[t][r] *= m; }
    __syncthreads();
    stage_chunk<false>(QKV, 128 * u, 2048 + 256 * h, RA, tid, 0.f, 0);
#pragma unroll
    for (int t = 0; t < 8; ++t)
#pragma unroll
        for (int r = 0; r < 4; ++r) RB[(16 * w + 4 * kq + r) * SLD + 16 * t + fr] = f2bf(sc[t][r]);
    __syncthreads();
    const unsigned vbase = (unsigned)(uintptr_t)RA;
#pragma unroll 1
    for (int ks = 0; ks < 4; ++ks) { const bf16x8 af = frag_rowk_l(RB + (16 * w) * SLD + 32 * ks, SLD, lane);
#pragma unroll
        for (int t = 0; t < 16; ++t) { const bf16x8 bf = frag_colk_l(vbase + (unsigned)((32 * ks) * RLD + 16 * t) * 2u, RLD * 2, lane); acc[t] = MFMA16(af, bf, acc[t]); } }
    __syncthreads();
#pragma unroll
    for (int r = 0; r < 4; ++r) {
        float s = 0.f;
#pragma unroll
        for (int t = 0; t < 16; ++t) s += acc[t][r];
        s += __shfl_xor(s, 1); s += __shfl_xor(s, 2); s += __shfl_xor(s, 4); s += __shfl_xor(s, 8);
        const float mean = s * (1.0f / 256.0f); float q = 0.f;
#pragma unroll
        for (int t = 0; t < 16; ++t) { const float d = acc[t][r] - mean; q += d * d; }
        q += __shfl_xor(q, 1); q += __shfl_xor(q, 2); q += __shfl_xor(q, 4); q += __shfl_xor(q, 8);
        const float rstd = rsqrtf(q * (1.0f / 256.0f) + LN_EPS);
#pragma unroll
        for (int t = 0; t < 16; ++t) RA[(16 * w + 4 * kq + r) * RLD + 16 * t + fr] = f2bf((acc[t][r] - mean) * rstd);
    }
    __syncthreads();
#pragma unroll
    for (int q = 0; q < 8; ++q) { const int idx = tid + NTHR * q, rr = idx >> 5, c = idx & 31; const size_t row = (size_t)(128 * u + rr);
        const u32x4 o = *(const LAS u32x4*)(RA + rr * RLD + 8 * c), g = *(const u32x4*)(QKV + row * EV_IN + 3072 + 256 * h + 8 * c);
        u32x4 w4;
        w4.x = cvt_pk_bf16(bflo(o.x) * siluf_(bflo(g.x)), bfhi(o.x) * siluf_(bfhi(g.x))); w4.y = cvt_pk_bf16(bflo(o.y) * siluf_(bflo(g.y)), bfhi(o.y) * siluf_(bfhi(g.y)));
        w4.z = cvt_pk_bf16(bflo(o.z) * siluf_(bflo(g.z)), bfhi(o.z) * siluf_(bfhi(g.z))); w4.w = cvt_pk_bf16(bflo(o.w) * siluf_(bflo(g.w)), bfhi(o.w) * siluf_(bfhi(g.w)));
        *(u32x4*)(MIX + row * DM + 256 * h + 8 * c) = w4; }
    __syncthreads();
}

constexpr int KLD = 1032;
__device__ __forceinline__ void s5_output_task(const Params& p, Ctx& C, int bt) {
    const bf16_t* QKV = (const bf16_t*)(p.ws + WS_BIG + BG_QKV); bf16_t* Z = (bf16_t*)(p.ws + WS_Z);
    const bf16_t* KN = (const bf16_t*)(p.ws + WS_KN); const bf16_t* CCt = (const bf16_t*)(p.ws + WS_CC);
    const float* APOW = (const float*)(p.ws + WS_APOW); const float* HST = (const float*)(p.ws + WS_HST); const float* dsk = p.inp(18);
    int tid = C.tid; asm volatile("" : "+v"(tid));
    const int lane = tid & 63, kq = lane >> 4, fr = lane & 15;
    LAS bf16_t* KF = (LAS bf16_t*)C.lds; LAS bf16_t* KB = KF + 16 * KLD;
    LAS bf16_t* U = KB + 16 * KLD + C.wave * 3072;
    LAS float* PW0 = (LAS float*)(KB + 16 * KLD + 8 * 3072);
    LAS float* PW16 = PW0 + 2 * 16 * 128;
    {
        const int g = bt >> 3, k0 = (260 * (bt & 7)) >> 3, k1 = (260 * ((bt & 7) + 1)) >> 3;
#pragma unroll
        for (int q = 0; q < 8; ++q) { const int idx = tid + NTHR * q, dir = idx >> 11, rr = (idx >> 7) & 15, c = idx & 127;
            *(LAS u32x4*)((dir ? KB : KF) + rr * KLD + 8 * c) = *(const u32x4*)(KN + ((size_t)(dir * 64 + g) * 16 + rr) * 1024 + 8 * c); }
        for (int q = lane; q < 192 * 2; q += 64) *(LAS u32x4*)(U + 8 * q) = (u32x4){0u, 0u, 0u, 0u};
#pragma unroll
        for (int q = 0; q < 2; ++q) { const int idx = tid + NTHR * q, dir = idx >> 9, f = (idx >> 5) & 15, c4 = idx & 31;
            *(LAS f32x4*)(PW0 + dir * 2048 + f * 128 + 4 * c4) = *(const f32x4*)(APOW + ((size_t)(dir * 64 + g) * 64 + (dir == 0 ? f : 15 - f)) * 128 + 4 * c4); }
        if (tid < 64) { const int dir = tid >> 5, c4 = tid & 31; *(LAS f32x4*)(PW16 + dir * 128 + 4 * c4) = *(const f32x4*)(APOW + ((size_t)(dir * 64 + g) * 64 + 15) * 128 + 4 * c4); }
        __syncthreads();
        const f32x4 dv = *(const f32x4*)(dsk + 16 * g + 4 * kq);
        bf16x8 ccr[2], cci[2];
#pragma unroll
        for (int hb = 0; hb < 2; ++hb) { ccr[hb] = frag_rowk_g(CCt + (size_t)g * 16 * 128 + 32 * hb, 128, lane); cci[hb] = frag_rowk_g(CCt + (size_t)g * 16 * 128 + 64 + 32 * hb, 128, lane); }
        const LAS float* pw0l = PW0 + (size_t)fr * 128 + 16 * kq;
        const LAS float* pw16l = PW16 + 16 * kq;
        for (int k = k0 + C.wave; k < k1; k += 8) {
            LDS_WAIT(); asm volatile("" ::: "memory");
            for (int q = lane; q < 128; q += 64) { const int t = q >> 1, hf = q & 1;
                *(LAS u32x4*)(U + (64 + t) * 16 + 8 * hf) = *(const u32x4*)(QKV + (size_t)(64 * k + t) * EV_IN + 4096 + 16 * g + 8 * hf); }
            LDS_WAIT(); asm volatile("" ::: "memory");
            const int cf = k, cb = k < 4 ? 3 - k : 263 - k;
            f32x4 acc[4];
#pragma unroll
            for (int tt = 0; tt < 4; ++tt) acc[tt] = (f32x4){0.f, 0.f, 0.f, 0.f};
            const LAS bf16_t* ubf = U + (64 + fr - (kq >> 1)) * 16 + 8 * (kq & 1);
            const LAS bf16_t* ubb = U + (64 + fr + (kq >> 1)) * 16 + 8 * (kq & 1);
#pragma unroll
            for (int n0 = 0; n0 < 64; n0 += 2) {
                const bf16x8 af = frag_rowk_l(KF + n0 * 16, KLD, lane), ab = frag_rowk_l(KB + n0 * 16, KLD, lane);
#pragma unroll
                for (int tt = 0; tt < 4; ++tt) {
                    if (n0 <= 16 * tt + 14) acc[tt] = MFMA16(af, *(const LAS bf16x8*)(ubf + (16 * tt - n0) * 16), acc[tt]);
                    if (n0 <= 62 - 16 * tt) acc[tt] = MFMA16(ab, *(const LAS bf16x8*)(ubb + (16 * tt + n0) * 16), acc[tt]);
                }
                asm volatile("" ::: "memory");
            }
#pragma unroll
            for (int dir = 0; dir < 2; ++dir) {
                const float* hp = HST + ((size_t)(dir * 64 + g) * 260 + (dir == 0 ? cf : cb)) * 128;
#pragma unroll
                for (int hb = 0; hb < 2; ++hb) {
                    float xr[8], xi[8];
#pragma unroll
                    for (int e2 = 0; e2 < 4; ++e2) { const f32x4 h4 = *(const f32x4*)(hp + 2 * (32 * hb + 8 * kq) + 4 * e2), b4 = *(const LAS f32x4*)(pw0l + dir * 2048 + hb * 64 + 4 * e2);
                        xr[2 * e2] = b4[0] * h4[0] - b4[1] * h4[1]; xi[2 * e2] = b4[0] * h4[1] + b4[1] * h4[0];
                        xr[2 * e2 + 1] = b4[2] * h4[2] - b4[3] * h4[3]; xi[2 * e2 + 1] = b4[2] * h4[3] + b4[3] * h4[2]; }
#pragma unroll
                    for (int st = 0; st < 4; ++st) {
                        const int tt = dir == 0 ? st : 3 - st;
                        u32x4 br, bi;
                        br.x = cvt_pk_bf16(xr[0], xr[1]); br.y = cvt_pk_bf16(xr[2], xr[3]); br.z = cvt_pk_bf16(xr[4], xr[5]); br.w = cvt_pk_bf16(xr[6], xr[7]);
                        bi.x = cvt_pk_bf16(xi[0], xi[1]); bi.y = cvt_pk_bf16(xi[2], xi[3]); bi.z = cvt_pk_bf16(xi[4], xi[5]); bi.w = cvt_pk_bf16(xi[6], xi[7]);
                        acc[tt] = MFMA16(ccr[hb], __builtin_bit_cast(bf16x8, br), acc[tt]);
                        acc[tt] = MFMA16(cci[hb], __builtin_bit_cast(bf16x8, bi), acc[tt]);
                        if (st < 3) {
#pragma unroll
                            for (int e2 = 0; e2 < 4; ++e2) { const f32x4 a4 = *(const LAS f32x4*)(pw16l + dir * 128 + hb * 64 + 4 * e2);
                                float t0 = xr[2 * e2] * a4[0] - xi[2 * e2] * a4[1]; xi[2 * e2] = xr[2 * e2] * a4[1] + xi[2 * e2] * a4[0]; xr[2 * e2] = t0;
                                t0 = xr[2 * e2 + 1] * a4[2] - xi[2 * e2 + 1] * a4[3]; xi[2 * e2 + 1] = xr[2 * e2 + 1] * a4[3] + xi[2 * e2 + 1] * a4[2]; xr[2 * e2 + 1] = t0; }
                        }
                    }
                }
            }
#pragma unroll
            for (int tt = 0; tt < 4; ++tt) { const int t = 16 * tt + fr;
                const u32x2 uu = *(const LAS u32x2*)(U + (64 + t) * 16 + 4 * kq);
                const float y0 = acc[tt][0] + bflo(uu.x) * dv[0], y1 = acc[tt][1] + bfhi(uu.x) * dv[1], y2 = acc[tt][2] + bflo(uu.y) * dv[2], y3 = acc[tt][3] + bfhi(uu.y) * dv[3];
                u32x2 w; w.x = cvt_pk_bf16(gelu_tanh(y0), gelu_tanh(y1)); w.y = cvt_pk_bf16(gelu_tanh(y2), gelu_tanh(y3));
                *(u32x2*)(Z + (size_t)(64 * k + t) * 1024 + 16 * g + 4 * kq) = w; }
        }
    }
    __syncthreads();
}

__device__ __forceinline__ void phase_ret_s5_outputs(const Params& p, Ctx& C, LAS unsigned char* misc) {
    unsigned* head = (unsigned*)(p.ws + WS_CTL) + CW_QUEUE;
    volatile LAS int* slot = (volatile LAS int*)(misc + 32);
    for (;;) {
        __syncthreads();
        if (C.tid == 0) slot[0] = (int)atomicAdd(head, 1u);
        __syncthreads();
        const int item = __builtin_amdgcn_readfirstlane(slot[0]);
        if (item >= 520) break;
        ret_output_unit(p, C, item);
    }
    for (;;) {
        __syncthreads();
        if (C.tid == 0) slot[0] = (int)atomicAdd(head + 64, 1u);
        __syncthreads();
        const int item = __builtin_amdgcn_readfirstlane(slot[0]);
        if (item >= 512) break;
        s5_output_task(p, C, item);
    }
}
__device__ __forceinline__ void phase_router(const Params& p, Ctx& C, int L) {
    const float* X1 = (const float*)(p.ws + WS_X1);
    const bf16_t* RWh = (const bf16_t*)(p.ws + WS_RWT) + (size_t)(L * 2 + 0) * 64 * DM; const bf16_t* RWl = (const bf16_t*)(p.ws + WS_RWT) + (size_t)(L * 2 + 1) * 64 * DM;
    const float* rbias = p.inp(27) + L * 64;
    int* cnt = (int*)(p.ws + WS_CTL) + CW_CNT + L * 128; int* LIST = (int*)(p.ws + WS_LIST); unsigned* PK = (unsigned*)(p.ws + WS_WGT); float* LW = (float*)(p.ws + WS_LW);
    const int lane = C.lane, kq = lane >> 4, fr = lane & 15;
    LAS float* Lw = (LAS float*)(C.lds + C.wave * 16640);
    const int r0 = (L == 0) ? 0 : CTXL, nrows = TT - r0;
    if (C.bid == 0 && C.tid == 0) cnt[64] = nrows;
    const int quad = C.wave >> 2, kw = C.wave & 3, ntask = nrows / 64;
    for (int tb = C.bid * 2; tb < ntask; tb += C.G * 2) {
        const int task = tb + quad;
        const int rbase = r0 + 64 * task;
        const int v = rbase < CTXL ? 1 : 0;
        const float* xr = X1 + (size_t)(rbase + fr) * DM; const float* sc2 = modv(p, L, v, 4); const float* sh2 = modv(p, L, v, 3);
        f32x4 acc[4][4];
#pragma unroll
        for (int b = 0; b < 4; ++b)
#pragma unroll
            for (int t = 0; t < 4; ++t) acc[b][t] = (f32x4){0.f, 0.f, 0.f, 0.f};
#pragma unroll 1
        for (int ks = 16 * kw; ks < 16 * kw + 16; ++ks) { const int c0 = 32 * ks + 8 * kq;
            const f32x4 a0 = *(const f32x4*)(sc2 + c0), a1 = *(const f32x4*)(sc2 + c0 + 4), b0 = *(const f32x4*)(sh2 + c0), b1 = *(const f32x4*)(sh2 + c0 + 4);
            bf16x8 ah[4], al[4];
#pragma unroll
            for (int b = 0; b < 4; ++b) {
                const f32x4 x0 = *(const f32x4*)(xr + (size_t)(16 * b) * DM + c0), x1 = *(const f32x4*)(xr + (size_t)(16 * b) * DM + c0 + 4);
                const f32x4 y0 = x0 * (a0 + 1.0f) + b0, y1 = x1 * (a1 + 1.0f) + b1;
                u32x4 hi; hi.x = cvt_pk_bf16(y0[0], y0[1]); hi.y = cvt_pk_bf16(y0[2], y0[3]); hi.z = cvt_pk_bf16(y1[0], y1[1]); hi.w = cvt_pk_bf16(y1[2], y1[3]);
                u32x4 lo; lo.x = cvt_pk_bf16(y0[0] - bflo(hi.x), y0[1] - bfhi(hi.x)); lo.y = cvt_pk_bf16(y0[2] - bflo(hi.y), y0[3] - bfhi(hi.y));
                lo.z = cvt_pk_bf16(y1[0] - bflo(hi.z), y1[1] - bfhi(hi.z)); lo.w = cvt_pk_bf16(y1[2] - bflo(hi.w), y1[3] - bfhi(hi.w));
                ah[b] = __builtin_bit_cast(bf16x8, hi); al[b] = __builtin_bit_cast(bf16x8, lo); }
#pragma unroll
            for (int t = 0; t < 4; ++t) { const bf16x8 bh = frag_rowk_g(RWh + (size_t)(16 * t) * DM + 32 * ks, DM, lane), bl = frag_rowk_g(RWl + (size_t)(16 * t) * DM + 32 * ks, DM, lane);
#pragma unroll
                for (int b = 0; b < 4; ++b) { acc[b][t] = MFMA16(ah[b], bh, acc[b][t]); acc[b][t] = MFMA16(al[b], bh, acc[b][t]); acc[b][t] = MFMA16(ah[b], bl, acc[b][t]); } } }
        LDS_WAIT(); asm volatile("" ::: "memory");
#pragma unroll
        for (int b = 0; b < 4; ++b)
#pragma unroll
            for (int t = 0; t < 4; ++t)
#pragma unroll
                for (int r = 0; r < 4; ++r) Lw[b * 1040 + (4 * kq + r) * 65 + 16 * t + fr] = acc[b][t][r];
        LDS_WAIT(); asm volatile("" ::: "memory");
        __syncthreads();
        LAS float* Lg = Lw + kw * 1040;
        { const LAS float* q0 = (const LAS float*)(C.lds + (4 * quad) * 16640) + kw * 1040;
          for (int i = lane; i < 16 * 65; i += 64) Lg[i] = (q0[i] + q0[4160 + i]) + (q0[8320 + i] + q0[12480 + i]); }
        LDS_WAIT(); asm volatile("" ::: "memory");
        if (lane < 16) {
            LAS float* sr = Lg + lane * 65; const int trow = rbase + 16 * kw + lane;
            float gs[8];
#pragma unroll
            for (int g = 0; g < 8; ++g) { float m1 = -1e30f, m2 = -1e30f;
                for (int j = 0; j < 8; ++j) { const int e = 8 * g + j; const float s = sigmoidf_(sr[e]); sr[e] = s; const float vv = s + rbias[e];
                    if (vv > m1) { m2 = m1; m1 = vv; } else if (vv > m2) m2 = vv; }
                gs[g] = m1 + m2; }
            unsigned gmask = 0u;
#pragma unroll
            for (int it = 0; it < 4; ++it) { float best = -1e30f; int bi = 0;
#pragma unroll
                for (int g = 0; g < 8; ++g) { const bool ok = !((gmask >> g) & 1u) && gs[g] > best; best = ok ? gs[g] : best; bi = ok ? g : bi; }
                gmask |= 1u << bi; }
            unsigned long long taken = 0ull; int sel[8]; float sw[8]; float wsum = 0.f;
#pragma unroll
            for (int k = 0; k < 8; ++k) { float best = -1e30f; int bi = 0;
                for (int e = 0; e < 64; ++e) { const bool cand = ((gmask >> (e >> 3)) & 1u) && !((taken >> e) & 1ull); const float vv = sr[e] + rbias[e];
                    if (cand && vv > best) { best = vv; bi = e; } }
                taken |= 1ull << bi; sel[k] = bi; sw[k] = sr[bi]; wsum += sw[k]; }
            const float inv = 2.5f / wsum;
#pragma unroll
            for (int k = 0; k < 8; ++k) { const int a = trow * 8 + k; const int pos = atomicAdd(&cnt[sel[k]], 1);
                LIST[(size_t)sel[k] * TT + pos] = a; PK[a] = ((unsigned)sel[k] << 16) | (unsigned)pos; LW[a] = sw[k] * inv * 4.0f; }
            LIST[(size_t)64 * TT + (trow - r0)] = 8 * TT + trow;
        }
        __syncthreads();
    }
}
namespace att {
constexpr int D = 128, NW = 8, QBLK = 32, KVBLK = 64;
constexpr float SCALE = 0.088388347648318440f;
constexpr float THR = 8.f;
constexpr int SHM_V = KVBLK * D * 2, SHM_K = KVBLK * D * 2, SHM_ATTN = 2 * SHM_V + 2 * SHM_K + NW * 64 * 4;
#define KSWZ(row, colB) ((row) * 256 + ((colB) ^ (((row) & 7) << 4)))
#define SBAR() __builtin_amdgcn_sched_barrier(0)
__device__ __forceinline__ int crow(int r, int hi) { return (r & 3) + 8 * (r >> 2) + 4 * hi; }
__device__ __forceinline__ unsigned cvtpk(float lo, float hi) { unsigned r; asm volatile("v_cvt_pk_bf16_f32 %0, %1, %2" : "=v"(r) : "v"(lo), "v"(hi)); return r; }

__device__ __forceinline__ void partialSM(f32x16& p0, f32x16& p1, float negMC) {
  constexpr float Cc = SCALE * 1.4426950408889634f;
  for (int r = 0; r < 16; ++r) p0[r] = fmaf(p0[r], Cc, negMC); for (int r = 0; r < 16; ++r) p1[r] = fmaf(p1[r], Cc, negMC);
  for (int r = 0; r < 16; ++r) p0[r] = __builtin_amdgcn_exp2f(p0[r]);
}
__device__ __forceinline__ void finishSM(f32x16& p0, f32x16& p1, float& l_reg, bf16x8& pa0, bf16x8& pa1, bf16x8& pa2, bf16x8& pa3) {
  for (int r = 0; r < 16; ++r) p1[r] = __builtin_amdgcn_exp2f(p1[r]);
  float ps = 0; for (int r = 0; r < 16; ++r) ps += p0[r]; for (int r = 0; r < 16; ++r) ps += p1[r];
  { auto rr = __builtin_amdgcn_permlane32_swap(__float_as_uint(ps), __float_as_uint(ps), false, false);
    ps = __uint_as_float(rr[0]) + __uint_as_float(rr[1]); }
  l_reg += ps;
#define PK4(P, BASE, OUT) do { unsigned a0 = cvtpk(P[BASE + 0], P[BASE + 1]), a1 = cvtpk(P[BASE + 2], P[BASE + 3]);   \
    unsigned b0 = cvtpk(P[BASE + 4], P[BASE + 5]), b1 = cvtpk(P[BASE + 6], P[BASE + 7]);                              \
    auto r0 = __builtin_amdgcn_permlane32_swap(a0, b0, false, false); auto r1 = __builtin_amdgcn_permlane32_swap(a1, b1, false, false); \
    u32x4 w = {r0[0], r1[0], r0[1], r1[1]}; OUT = *reinterpret_cast<bf16x8*>(&w); } while (0)
  PK4(p0, 0, pa0); PK4(p0, 8, pa1); PK4(p1, 0, pa2); PK4(p1, 8, pa3);
#undef PK4
}
__device__ __forceinline__ void qkt(f32x16& p0, f32x16& p1, const LAS char* Ks, const bf16x8* qr, int r32, int hi) {
  p0 = f32x16{}; p1 = f32x16{};
  for (int d0 = 0; d0 < 8; ++d0) { int cb = (d0 * 16 + hi * 8) * 2;
    bf16x8 b0 = *reinterpret_cast<const LAS bf16x8*>(Ks + KSWZ(r32, cb));
    bf16x8 b1 = *reinterpret_cast<const LAS bf16x8*>(Ks + KSWZ(32 + r32, cb));
    p0 = __builtin_amdgcn_mfma_f32_32x32x16_bf16(b0, qr[d0], p0, 0, 0, 0);
    p1 = __builtin_amdgcn_mfma_f32_32x32x16_bf16(b1, qr[d0], p1, 0, 0, 0); }
}
__device__ __forceinline__ int v_st(int k, int c) { const int kk = (k & ~0xC) | ((k & 4) << 1) | ((k & 8) >> 1); return ((kk >> 3) * 4 + (c >> 5)) * 512 + ((kk & 7) * 32 + (c & 31)) * 2; }
__device__ __forceinline__ int v_rd_base(int lane) { return ((lane & 3) << 3) | (((lane >> 2) & 3) << 6) | (((lane >> 4) & 1) << 5) | (((lane >> 5) & 1) << 8); }
constexpr int v_rd_off(int d0, int ks, int half) { return d0 * 512 + ks * 4096 + half * 2048; }
template <int OFF> __device__ __forceinline__ s16x4 tr_read(int vb) {
  s16x4 r; asm volatile("ds_read_b64_tr_b16 %0, %1 offset:%2" : "=&v"(r) : "v"(vb), "i"(OFF) : "memory"); return r;
}
template <int D0> __device__ __forceinline__ void pv_one(f32x16& od, int vb, bf16x8 pa0, bf16x8 pa1, bf16x8 pa2, bf16x8 pa3) {
  const s16x4 l0 = tr_read<v_rd_off(D0, 0, 0)>(vb), h0 = tr_read<v_rd_off(D0, 0, 1)>(vb), l1 = tr_read<v_rd_off(D0, 1, 0)>(vb), h1 = tr_read<v_rd_off(D0, 1, 1)>(vb);
  const s16x4 l2 = tr_read<v_rd_off(D0, 2, 0)>(vb), h2 = tr_read<v_rd_off(D0, 2, 1)>(vb), l3 = tr_read<v_rd_off(D0, 3, 0)>(vb), h3 = tr_read<v_rd_off(D0, 3, 1)>(vb);
  asm volatile("s_waitcnt lgkmcnt(0)" ::: "memory"); SBAR();
#define PK(L, H) (bf16x8){L[0], L[1], L[2], L[3], H[0], H[1], H[2], H[3]}
  od = __builtin_amdgcn_mfma_f32_32x32x16_bf16(pa0, PK(l0, h0), od, 0, 0, 0);
  od = __builtin_amdgcn_mfma_f32_32x32x16_bf16(pa1, PK(l1, h1), od, 0, 0, 0);
  od = __builtin_amdgcn_mfma_f32_32x32x16_bf16(pa2, PK(l2, h2), od, 0, 0, 0);
  od = __builtin_amdgcn_mfma_f32_32x32x16_bf16(pa3, PK(l3, h3), od, 0, 0, 0);
#undef PK
}
__device__ __forceinline__ void pv_d0(f32x16* o, int vb, bf16x8 pa0, bf16x8 pa1, bf16x8 pa2, bf16x8 pa3) {
  pv_one<0>(o[0], vb, pa0, pa1, pa2, pa3); pv_one<1>(o[1], vb, pa0, pa1, pa2, pa3); pv_one<2>(o[2], vb, pa0, pa1, pa2, pa3); pv_one<3>(o[3], vb, pa0, pa1, pa2, pa3);
}

template <int LDQ, int LDK, int LDO>
__device__ __forceinline__ void attn_dense_body(const bf16_t* __restrict__ Qb, const bf16_t* __restrict__ Kh, const bf16_t* __restrict__ Vh, bf16_t* __restrict__ Ob, int seq, LAS char* lds, int tid, float kmax2) {
  const int wid = tid >> 6, lane = tid & 63, r32 = lane & 31, hi = lane >> 5;
  LAS char* V_lds = lds; LAS char* K_lds = lds + 2 * SHM_V;
  LAS float* ws = (LAS float*)(lds + 2 * SHM_V + 2 * SHM_K) + wid * 64; LAS float* li_l = ws;
  float l_reg = 0; f32x16 o[4] = {}; bf16x8 qr[8];
  const bf16_t* Qw = Qb + (long)(wid * QBLK + r32) * LDQ + hi * 8;
#pragma unroll
  for (int d0 = 0; d0 < 8; ++d0) qr[d0] = *reinterpret_cast<const bf16x8*>(Qw + d0 * 16);
  float negMC;
  { float q2 = 0.f;
#pragma unroll
    for (int d0 = 0; d0 < 8; ++d0) { const u32x4 w = __builtin_bit_cast(u32x4, qr[d0]);
      q2 += bflo(w.x) * bflo(w.x) + bfhi(w.x) * bfhi(w.x) + bflo(w.y) * bflo(w.y) + bfhi(w.y) * bfhi(w.y) + bflo(w.z) * bflo(w.z) + bfhi(w.z) * bfhi(w.z) + bflo(w.w) * bflo(w.w) + bfhi(w.w) * bfhi(w.w); }
    auto rr = __builtin_amdgcn_permlane32_swap(__float_as_uint(q2), __float_as_uint(q2), false, false);
    q2 = __uint_as_float(rr[0]) + __uint_as_float(rr[1]);
    negMC = -(sqrtf(q2 * kmax2) * (SCALE * 1.0001f) - 30.0f) * 1.4426950408889634f; }
  const int sr = tid >> 4, sc = (tid & 15) * 8, vst0 = v_st(sr, sc), vst1 = v_st(32 + sr, sc);
  const int vb0 = (int)(uintptr_t)V_lds + v_rd_base(lane);
  struct { bf16x8 vs0, vs1, ks0, ks1; } sr_[2];
#define SLOAD(i, k0) do { sr_[i].vs0 = *reinterpret_cast<const bf16x8*>(&Vh[(long)((k0) + sr) * LDK + sc]); sr_[i].vs1 = *reinterpret_cast<const bf16x8*>(&Vh[(long)((k0) + 32 + sr) * LDK + sc]); \
    sr_[i].ks0 = *reinterpret_cast<const bf16x8*>(&Kh[(long)((k0) + sr) * LDK + sc]); sr_[i].ks1 = *reinterpret_cast<const bf16x8*>(&Kh[(long)((k0) + 32 + sr) * LDK + sc]); } while (0)
#define SWRITE(b, i) do { *(LAS bf16x8*)(V_lds + (b) * SHM_V + vst0) = sr_[i].vs0;          \
    *(LAS bf16x8*)(V_lds + (b) * SHM_V + vst1) = sr_[i].vs1; int kc = sc * 2;               \
    *(LAS bf16x8*)(K_lds + (b) * SHM_K + KSWZ(sr, kc)) = sr_[i].ks0;                       \
    *(LAS bf16x8*)(K_lds + (b) * SHM_K + KSWZ(32 + sr, kc)) = sr_[i].ks1; } while (0)
#define SWAIT() asm volatile("s_waitcnt vmcnt(4)" ::: "memory")
  f32x16 pA0, pA1, pB0, pB1; bf16x8 pa0, pa1, pa2, pa3; const int NT = seq / KVBLK;
  constexpr int SE = 0, SO = 1;
  SLOAD(SE, 0); asm volatile("s_waitcnt vmcnt(0)" ::: "memory"); SWRITE(0, SE); __syncthreads();
  qkt(pA0, pA1, K_lds, qr, r32, hi); partialSM(pA0, pA1, negMC);
  SLOAD(SO, KVBLK); if (2 < NT) SLOAD(SE, 2 * KVBLK);
  SWAIT(); SWRITE(1, SO); __syncthreads();
  for (int j = 1; j + 1 < NT; j += 2) {
    SBAR(); qkt(pB0, pB1, K_lds + SHM_K, qr, r32, hi);
    finishSM(pA0, pA1, l_reg, pa0, pa1, pa2, pa3); SBAR();
    SLOAD(SO, (j + 2) * KVBLK); SBAR();
    pv_d0(o, vb0, pa0, pa1, pa2, pa3); partialSM(pB0, pB1, negMC);
    __syncthreads(); SWAIT(); SWRITE(0, SE);
    __syncthreads();
    SBAR(); qkt(pA0, pA1, K_lds, qr, r32, hi);
    finishSM(pB0, pB1, l_reg, pa0, pa1, pa2, pa3); SBAR();
    if (j + 3 < NT) SLOAD(SE, (j + 3) * KVBLK); SBAR();
    pv_d0(o, vb0 + (int)SHM_V, pa0, pa1, pa2, pa3); partialSM(pA0, pA1, negMC);
    __syncthreads(); SWAIT(); SWRITE(1, SO);
    __syncthreads();
  }
  SBAR(); qkt(pB0, pB1, K_lds + SHM_K, qr, r32, hi);
  finishSM(pA0, pA1, l_reg, pa0, pa1, pa2, pa3); SBAR();
  pv_d0(o, vb0, pa0, pa1, pa2, pa3); partialSM(pB0, pB1, negMC);
  __syncthreads();
  finishSM(pB0, pB1, l_reg, pa0, pa1, pa2, pa3); SBAR();
  pv_d0(o, vb0 + (int)SHM_V, pa0, pa1, pa2, pa3);
  if (hi == 0) li_l[r32] = l_reg; asm volatile("s_waitcnt lgkmcnt(0)" ::: "memory");
  float rli[16];
#pragma unroll
  for (int r = 0; r < 16; ++r) rli[r] = __builtin_amdgcn_rcpf(li_l[crow(r, hi)]);
  bf16_t* Ow = Ob + (long)(wid * QBLK) * LDO;
#pragma unroll
  for (int r = 0; r < 16; ++r) { int orow = crow(r, hi);
    for (int d0 = 0; d0 < 4; ++d0) Ow[(long)orow * LDO + d0 * 32 + r32] = (bf16_t)(cvtpk(o[d0][r] * rli[r], 0.f) & 0xffffu); }
#undef SLOAD
#undef SWRITE
#undef SWAIT
}

typedef int v8i32a __attribute__((ext_vector_type(8)));
typedef int v4i32a __attribute__((ext_vector_type(4)));
#define KSW8(row, chunk) ((row) * 128 + ((((chunk) ^ (((row) >> 1) & 7))) << 4))
#define VSW8(d, chunk) ((d) * 64 + ((((chunk) ^ (((d) >> 2) & 3))) << 4))
#define MFMA8(a, b, c) __builtin_amdgcn_mfma_scale_f32_32x32x64_f8f6f4((a), (b), (c), 0, 0, 0, 0, 0, 0)
__device__ __forceinline__ v8i32a ld32_l(const LAS char* p0, const LAS char* p1) { return __builtin_shufflevector(*(const LAS v4i32a*)p0, *(const LAS v4i32a*)p1, 0, 1, 2, 3, 4, 5, 6, 7); }
__device__ __forceinline__ unsigned pk4f8(float a, float b, float c, float d) { unsigned w = (unsigned)__builtin_amdgcn_cvt_pk_fp8_f32(a, b, 0, false); return (unsigned)__builtin_amdgcn_cvt_pk_fp8_f32(c, d, (int)w, true); }
typedef short v2s16 __attribute__((ext_vector_type(2)));
__device__ __forceinline__ int pk4f8s(float a, float b, float c, float d, int old, float sc) {
    v2s16 w = __builtin_bit_cast(v2s16, old); w = __builtin_amdgcn_cvt_scalef32_pk_fp8_f32(w, a, b, sc, false); w = __builtin_amdgcn_cvt_scalef32_pk_fp8_f32(w, c, d, sc, true); return __builtin_bit_cast(int, w); }
template <int LDO, int KSTR>
__device__ __forceinline__ void attn_dense8_body(const unsigned char* __restrict__ Q8b, const unsigned char* __restrict__ K8h, const unsigned char* __restrict__ VT8h, bf16_t* __restrict__ Ob, int seq, LAS char* lds, int tid, float kmax2) {
  const int wid = tid >> 6, lane = tid & 63, r32 = lane & 31, hi = lane >> 5;
  constexpr int RS = 6, PD = 4;
  LAS float* al_l = (LAS float*)(lds + RS * 16384) + wid * 32;
  f32x16 o[4] = {}; v8i32a qf[2];
  { const unsigned char* qp = Q8b + (size_t)(wid * QBLK + r32) * 1024 + 32 * hi;
    qf[0] = __builtin_shufflevector(*(const v4i32a*)qp, *(const v4i32a*)(qp + 16), 0, 1, 2, 3, 4, 5, 6, 7);
    qf[1] = __builtin_shufflevector(*(const v4i32a*)(qp + 64), *(const v4i32a*)(qp + 80), 0, 1, 2, 3, 4, 5, 6, 7); }
  (void)kmax2;
  float m_reg = 0.f; f32x16 osum = {}; v8i32a ones = {0x38383838, 0x38383838, 0x38383838, 0x38383838, 0x38383838, 0x38383838, 0x38383838, 0x38383838}; asm volatile("" : "+v"(ones));
#define PSM8(P0, P1, DL, CN, FIRST) do { float pmax = P0[0]; for (int r = 1; r < 16; ++r) pmax = fmaxf(pmax, P0[r]); for (int r = 0; r < 16; ++r) pmax = fmaxf(pmax, P1[r]); \
      { auto rr = __builtin_amdgcn_permlane32_swap(__float_as_uint(pmax), __float_as_uint(pmax), false, false); pmax = fmaxf(__uint_as_float(rr[0]), __uint_as_float(rr[1])); } \
      const float mf_ = floorf(pmax); const float mn = (FIRST) ? mf_ : (mf_ > m_reg ? mf_ : m_reg); DL = (FIRST) ? 0.f : mn - m_reg; m_reg = mn; CN = __builtin_amdgcn_exp2f(mn - 7.0f); \
      for (int r = 0; r < 16; ++r) P0[r] = __builtin_amdgcn_exp2f(P0[r]); } while (0)
#define RESC8(DL) do { if (__any((DL) > 0.f)) { if (hi == 0) al_l[r32] = __builtin_amdgcn_exp2f(-(DL)); asm volatile("s_waitcnt lgkmcnt(0)" ::: "memory"); \
      for (int d = 0; d < 4; ++d) for (int r = 0; r < 16; ++r) o[d][r] *= al_l[crow(r, hi)]; for (int r = 0; r < 16; ++r) osum[r] *= al_l[crow(r, hi)]; } } while (0)
  const unsigned kgo = (unsigned)((tid >> 3) * KSTR + 16 * ((tid & 7) ^ ((tid >> 4) & 7))), vgo = (unsigned)((tid >> 2) * 64 + 16 * ((tid & 3) ^ ((tid >> 4) & 3)));
  const unsigned ldw = (unsigned)wid * 1024u;
#define DMA8(slot, T_) do { __builtin_amdgcn_global_load_lds((const unsigned*)(K8h + (size_t)(T_) * (64 * KSTR) + kgo), (LAS unsigned*)(lds + (slot) * 16384 + ldw), 16, 0, 0); \
      __builtin_amdgcn_global_load_lds((const unsigned*)(VT8h + (size_t)(T_) * 8192 + vgo), (LAS unsigned*)(lds + (slot) * 16384 + 8192 + ldw), 16, 0, 0); } while (0)
#define DWAIT8() do { asm volatile("s_waitcnt vmcnt(6)\n\ts_waitcnt lgkmcnt(0)" ::: "memory"); __builtin_amdgcn_s_barrier(); asm volatile("" ::: "memory"); } while (0)
#define QK8(P0, P1, KB) do { P0 = f32x16{}; P1 = f32x16{}; _Pragma("unroll") for (int s = 0; s < 2; ++s) { \
      const v8i32a k0 = ld32_l((KB) + KSW8(r32, 4 * s + 2 * hi), (KB) + KSW8(r32, 4 * s + 2 * hi + 1)); \
      const v8i32a k1 = ld32_l((KB) + KSW8(32 + r32, 4 * s + 2 * hi), (KB) + KSW8(32 + r32, 4 * s + 2 * hi + 1)); \
      P0 = MFMA8(k0, qf[s], P0); P1 = MFMA8(k1, qf[s], P1); } } while (0)
#define FIN8(P0, P1, CN) do { for (int r = 0; r < 16; ++r) P1[r] = __builtin_amdgcn_exp2f(P1[r]); \
      _Pragma("unroll") for (int i = 0; i < 4; ++i) { pa[i] = pk4f8s(P0[4 * i], P0[4 * i + 1], P0[4 * i + 2], P0[4 * i + 3], pa[i], CN); pa[4 + i] = pk4f8s(P1[4 * i], P1[4 * i + 1], P1[4 * i + 2], P1[4 * i + 3], pa[4 + i], CN); } } while (0)
#define PV8(VB) do { _Pragma("unroll") for (int d0 = 0; d0 < 4; ++d0) { \
      const v8i32a vf = ld32_l((VB) + VSW8(32 * d0 + r32, 2 * hi), (VB) + VSW8(32 * d0 + r32, 2 * hi + 1)); \
      o[d0] = MFMA8(pa, vf, o[d0]); } osum = MFMA8(pa, ones, osum); } while (0)
#define LDK8(KB, s, half) ld32_l((KB) + KSW8(32 * (half) + r32, 4 * (s) + 2 * hi), (KB) + KSW8(32 * (half) + r32, 4 * (s) + 2 * hi + 1))
#define LDV8(VB, d0) ld32_l((VB) + VSW8(32 * (d0) + r32, 2 * hi), (VB) + VSW8(32 * (d0) + r32, 2 * hi + 1))
#define EXPN(P, r0, n, CN) do { _Pragma("unroll") for (int r = (r0); r < (r0) + (n); ++r) { float e_ = __builtin_amdgcn_exp2f(P[r]); asm volatile("" : "+v"(e_)); P[r] = e_; } } while (0)
#define FINP(P0, P1, CN, i) do { EXPN(P1, 4 * (i), 4, CN); \
      pa[i] = pk4f8s(P0[4 * (i)], P0[4 * (i) + 1], P0[4 * (i) + 2], P0[4 * (i) + 3], pa[i], CN); \
      pa[4 + (i)] = pk4f8s(P1[4 * (i)], P1[4 * (i) + 1], P1[4 * (i) + 2], P1[4 * (i) + 3], pa[4 + (i)], CN); } while (0)
#define PINA(x, y) asm volatile("" : "+v"(x), "+v"(y))
#define PIN1(x) asm volatile("" : "+v"(x))
#define PINC(x, y) asm volatile("" :: "v"(x), "v"(y))
#define HSTEP(X0, X1, DLX, CNX, Y0, Y1, CNY, KB, VB, STAGE_LOAD) do { \
      v8i32a ka_ = LDK8(KB, 0, 0), kb_ = LDK8(KB, 0, 1), kc_ = LDK8(KB, 1, 0), kd_ = LDK8(KB, 1, 1); \
      X0 = MFMA8(ka_, qf[0], f32x16{}); PINA(X0, kb_); \
      FINP(Y0, Y1, CNY, 0); PINC(pa[0], pa[4]); PIN1(kb_); \
      X1 = MFMA8(kb_, qf[0], f32x16{}); PINA(X1, kc_); \
      FINP(Y0, Y1, CNY, 1); PINC(pa[1], pa[5]); PIN1(kc_); \
      X0 = MFMA8(kc_, qf[1], X0); PINA(X0, kd_); \
      v8i32a v0_ = LDV8(VB, 0), v1_ = LDV8(VB, 1); \
      FINP(Y0, Y1, CNY, 2); STAGE_LOAD; PINC(pa[2], pa[6]); PIN1(kd_); \
      X1 = MFMA8(kd_, qf[1], X1); PINA(X1, v0_); \
      v8i32a v2_ = LDV8(VB, 2), v3_ = LDV8(VB, 3); \
      FINP(Y0, Y1, CNY, 3); PINC(pa[3], pa[7]); PINA(pa, v0_); \
      o[0] = MFMA8(pa, v0_, o[0]); PINA(o[0], v1_); \
      float pm0_ = X0[0]; _Pragma("unroll") for (int r = 1; r < 16; ++r) pm0_ = fmaxf(pm0_, X0[r]); PINA(pm0_, v1_); \
      o[1] = MFMA8(pa, v1_, o[1]); PINA(o[1], v2_); \
      _Pragma("unroll") for (int r = 0; r < 16; ++r) pm0_ = fmaxf(pm0_, X1[r]); \
      { auto rr = __builtin_amdgcn_permlane32_swap(__float_as_uint(pm0_), __float_as_uint(pm0_), false, false); pm0_ = fmaxf(__uint_as_float(rr[0]), __uint_as_float(rr[1])); } \
      { const float mf_ = floorf(pm0_); const float mn = mf_ > m_reg ? mf_ : m_reg; DLX = mn - m_reg; m_reg = mn; CNX = __builtin_amdgcn_exp2f(mn - 7.0f); } PINA(CNX, v2_); \
      o[2] = MFMA8(pa, v2_, o[2]); PINA(o[2], v3_); \
      EXPN(X0, 0, 5, CNX); PIN1(v3_); \
      o[3] = MFMA8(pa, v3_, o[3]); PINA(o[3], CNX); \
      EXPN(X0, 5, 5, CNX); PIN1(pa); \
      osum = MFMA8(pa, ones, osum); PINA(osum, CNX); \
      EXPN(X0, 10, 6, CNX); } while (0)
  f32x16 pA0, pA1, pB0, pB1; v8i32a pa = {}; float dlA, dlB, cnA, cnB; const int NT = seq / KVBLK;
#define SLOT(s) (lds + (s) * 16384)
#define SADV() do { sv = sk; sk = sk + 1 == RS ? 0 : sk + 1; sd = sd + 1 == RS ? 0 : sd + 1; } while (0)
  int sk = 0, sv = 0, sd = PD;
  DMA8(0, 0); DMA8(1, 1); DMA8(2, 2); DMA8(3, 3);
  DWAIT8();
  QK8(pA0, pA1, SLOT(0)); PSM8(pA0, pA1, dlA, cnA, true);
  DMA8(sd, PD); SADV(); DWAIT8();
  for (int j = 1; j + 1 < NT; j += 2) {
    HSTEP(pB0, pB1, dlB, cnB, pA0, pA1, cnA, SLOT(sk), SLOT(sv) + 8192, DMA8(sd, min(j + PD, NT - 1)));
    RESC8(dlB); SADV(); DWAIT8();
    HSTEP(pA0, pA1, dlA, cnA, pB0, pB1, cnB, SLOT(sk), SLOT(sv) + 8192, DMA8(sd, min(j + 1 + PD, NT - 1)));
    RESC8(dlA); SADV(); DWAIT8();
  }
  HSTEP(pB0, pB1, dlB, cnB, pA0, pA1, cnA, SLOT(sk), SLOT(sv) + 8192, (void)0);
  RESC8(dlB); SADV();
  FIN8(pB0, pB1, cnB); SBAR();
  PV8(SLOT(sv) + 8192);
  asm volatile("s_waitcnt vmcnt(0)" ::: "memory");
  float rli[16];
#pragma unroll
  for (int r = 0; r < 16; ++r) rli[r] = __builtin_amdgcn_rcpf(osum[r]);
  bf16_t* Ow = Ob + (long)(wid * QBLK) * LDO;
#pragma unroll
  for (int r = 0; r < 16; ++r) { int orow = crow(r, hi);
    for (int d0 = 0; d0 < 4; ++d0) Ow[(long)orow * LDO + d0 * 32 + r32] = (bf16_t)(cvtpk(o[d0][r] * rli[r], 0.f) & 0xffffu); }
#undef PSM8
#undef RESC8
#undef DMA8
#undef DWAIT8
#undef SLOT
#undef SADV
#undef QK8
#undef FIN8
#undef PV8
#undef HSTEP
#undef PINA
#undef PIN1
#undef PINC
#undef FINP
#undef EXPN
#undef LDK8
#undef LDV8
}

template <int LDO, int KSTR>
__device__ __forceinline__ void attn_dense8w_body(const unsigned char* __restrict__ Q8b, const unsigned char* __restrict__ K8h, const unsigned char* __restrict__ VT8h0, const unsigned char* __restrict__ VT8h1, bf16_t* __restrict__ Ob, int seq, LAS char* lds, int tid, float kmax2) {
  const int wid = tid >> 6, lane = tid & 63, r32 = lane & 31, hi = lane >> 5;
  constexpr int RS = 4, PD = 2, SB = 24576;
  LAS float* al_l = (LAS float*)(lds + RS * SB) + wid * 32;
  LAS char* q_l = lds + RS * SB + 2048 + wid * 4096 + lane * 16;
  { const unsigned char* qp = Q8b + (size_t)(wid * QBLK + r32) * 1024 + 32 * hi;
    *(LAS v4i32a*)(q_l) = *(const v4i32a*)qp; *(LAS v4i32a*)(q_l + 1024) = *(const v4i32a*)(qp + 16);
    *(LAS v4i32a*)(q_l + 2048) = *(const v4i32a*)(qp + 64); *(LAS v4i32a*)(q_l + 3072) = *(const v4i32a*)(qp + 80); }
  (void)kmax2;
  float l_reg = 0.f, m_reg = 0.f; f32x16 o[8] = {};
  const unsigned kgo = (unsigned)((tid >> 3) * KSTR + 16 * ((tid & 7) ^ ((tid >> 4) & 7))), vgo = (unsigned)((tid >> 2) * 64 + 16 * ((tid & 3) ^ ((tid >> 4) & 3)));
  const unsigned ldw = (unsigned)wid * 1024u;
#define DMA8(slot, T_) do { __builtin_amdgcn_global_load_lds((const unsigned*)(K8h + (size_t)(T_) * (64 * KSTR) + kgo), (LAS unsigned*)(lds + (slot) * SB + ldw), 16, 0, 0); \
      __builtin_amdgcn_global_load_lds((const unsigned*)(VT8h0 + (size_t)(T_) * 8192 + vgo), (LAS unsigned*)(lds + (slot) * SB + 8192 + ldw), 16, 0, 0); \
      __builtin_amdgcn_global_load_lds((const unsigned*)(VT8h1 + (size_t)(T_) * 8192 + vgo), (LAS unsigned*)(lds + (slot) * SB + 16384 + ldw), 16, 0, 0); } while (0)
#define DWAIT8() do { asm volatile("s_waitcnt vmcnt(3)\n\ts_waitcnt lgkmcnt(0)" ::: "memory"); __builtin_amdgcn_s_barrier(); asm volatile("" ::: "memory"); } while (0)
#define SLOT(s) (lds + (s) * SB)
#define SADV() do { sv = sk; sk = sk + 1 == RS ? 0 : sk + 1; sd = sd + 1 == RS ? 0 : sd + 1; } while (0)
#define LDK8(KB, s, half) ld32_l((KB) + KSW8(32 * (half) + r32, 4 * (s) + 2 * hi), (KB) + KSW8(32 * (half) + r32, 4 * (s) + 2 * hi + 1))
#define LDV8(VB, d0) ld32_l((VB) + VSW8(32 * (d0) + r32, 2 * hi), (VB) + VSW8(32 * (d0) + r32, 2 * hi + 1))
#define PIN1(x) asm volatile("" : "+v"(x))
#define EXPR(e0, n) do { _Pragma("unroll") for (int e = (e0); e < (e0) + (n); ++e) { float x_ = e < 16 ? X0[e & 15] : X1[e & 15]; float e_ = __builtin_amdgcn_exp2f(x_); asm volatile("" : "+v"(e_)); ps += e_; \
      if (e < 16) X0[e & 15] = e_; else X1[e & 15] = e_; } } while (0)
#define PKW(PAC, w) do { if ((w) < 4) PAC[w] = pk4f8s(X0[4 * ((w) & 3)], X0[4 * ((w) & 3) + 1], X0[4 * ((w) & 3) + 2], X0[4 * ((w) & 3) + 3], PAC[w], cn); \
      else PAC[w] = pk4f8s(X1[4 * ((w) & 3)], X1[4 * ((w) & 3) + 1], X1[4 * ((w) & 3) + 2], X1[4 * ((w) & 3) + 3], PAC[w], cn); } while (0)
#define PVM(PAP, g) do { PIN1(vv##g); o[4 * ((g) & 1) + ((g) >> 1)] = MFMA8(PAP, vv##g, o[4 * ((g) & 1) + ((g) >> 1)]); asm volatile("" :: "v"(o[4 * ((g) & 1) + ((g) >> 1)])); } while (0)
#define LDVG(g) ({ int o_ = sv * SB + 8192 + 8192 * ((g) & 1); asm volatile("" : "+s"(o_)); LDV8(lds + o_, (g) >> 1); })
#define WSTEP(PAP, PAC, FIRST, TNEXT) do { \
      { const v8i32a ka_ = LDK8(SLOT(sk), 0, 0), kb_ = LDK8(SLOT(sk), 0, 1), kc_ = LDK8(SLOT(sk), 1, 0), kd_ = LDK8(SLOT(sk), 1, 1); \
        const v8i32a q0_ = ld32_l(q_l, q_l + 1024), q1_ = ld32_l(q_l + 2048, q_l + 3072); \
        X0 = MFMA8(ka_, q0_, f32x16{}); X1 = MFMA8(kb_, q0_, f32x16{}); X0 = MFMA8(kc_, q1_, X0); X1 = MFMA8(kd_, q1_, X1); PIN1(X1); } \
      DMA8(sd, TNEXT); \
      v8i32a vv0 = LDVG(0), vv1 = LDVG(1); \
      PVM(PAP, 0); v8i32a vv2 = LDVG(2); \
      float pm_ = X0[0]; _Pragma("unroll") for (int r = 1; r < 16; ++r) pm_ = fmaxf(pm_, X0[r]); PIN1(pm_); \
      PVM(PAP, 1); v8i32a vv3 = LDVG(3); \
      _Pragma("unroll") for (int r = 0; r < 16; ++r) pm_ = fmaxf(pm_, X1[r]); \
      { auto rr = __builtin_amdgcn_permlane32_swap(__float_as_uint(pm_), __float_as_uint(pm_), false, false); pm_ = fmaxf(__uint_as_float(rr[0]), __uint_as_float(rr[1])); } \
      const float mf_ = floorf(pm_); const float mn_ = (FIRST) ? mf_ : (mf_ > m_reg ? mf_ : m_reg); const float dl_ = (FIRST) ? 0.f : mn_ - m_reg; m_reg = mn_; \
      float cn = __builtin_amdgcn_exp2f(mn_ - 7.0f); const float isc_ = __builtin_amdgcn_exp2f(7.0f - mn_); float ps = 0.f; PIN1(cn);        \
      PVM(PAP, 2); v8i32a vv4 = LDVG(4); EXPR(0, 6); PKW(PAC, 0); \
      PVM(PAP, 3); v8i32a vv5 = LDVG(5); EXPR(6, 6); PKW(PAC, 1); PKW(PAC, 2); \
      PVM(PAP, 4); v8i32a vv6 = LDVG(6); EXPR(12, 5); PKW(PAC, 3); \
      PVM(PAP, 5); v8i32a vv7 = LDVG(7); EXPR(17, 5); PKW(PAC, 4); \
      PVM(PAP, 6); EXPR(22, 5); PKW(PAC, 5); \
      PVM(PAP, 7); EXPR(27, 5); PKW(PAC, 6); PKW(PAC, 7); \
      { auto rr = __builtin_amdgcn_permlane32_swap(__float_as_uint(ps), __float_as_uint(ps), false, false); ps = __uint_as_float(rr[0]) + __uint_as_float(rr[1]); } \
      if (__any(dl_ > 0.f)) { const float al_ = __builtin_amdgcn_exp2f(-dl_); l_reg *= al_; if (hi == 0) al_l[r32] = al_; asm volatile("s_waitcnt lgkmcnt(0)" ::: "memory"); \
        for (int d = 0; d < 8; ++d) for (int r = 0; r < 16; ++r) o[d][r] *= al_l[crow(r, hi)]; } \
      l_reg += ps * isc_;                    \
      SADV(); DWAIT8(); } while (0)
  f32x16 X0, X1; v8i32a paA = {}, paB = {}; const int NT = seq / KVBLK;
  int sk = 0, sv = 0, sd = PD;
  DMA8(0, 0); DMA8(1, 1);
  DWAIT8();
  for (int j = 0; j < NT; j += 2) {
    WSTEP(paB, paA, j == 0, min(j + PD, NT - 1));
    WSTEP(paA, paB, false, min(j + 1 + PD, NT - 1));
  }
  { v8i32a vv0 = LDVG(0), vv1 = LDVG(1), vv2 = LDVG(2), vv3 = LDVG(3); PVM(paB, 0); PVM(paB, 1); PVM(paB, 2); PVM(paB, 3); }
  { v8i32a vv4 = LDVG(4), vv5 = LDVG(5), vv6 = LDVG(6), vv7 = LDVG(7); PVM(paB, 4); PVM(paB, 5); PVM(paB, 6); PVM(paB, 7); }
  asm volatile("s_waitcnt vmcnt(0)" ::: "memory");
  int te = tid; asm volatile("" : "+v"(te));
  const int wid_e = te >> 6, r32_e = te & 31, hi_e = (te >> 5) & 1;
  LAS float* li_e = (LAS float*)(lds + RS * SB + 1024) + wid_e * 32;
  if (hi_e == 0) li_e[r32_e] = l_reg; asm volatile("s_waitcnt lgkmcnt(0)" ::: "memory");
  float rli[16];
#pragma unroll
  for (int r = 0; r < 16; ++r) rli[r] = __builtin_amdgcn_rcpf(li_e[crow(r, hi_e)]);
  bf16_t* Ow = Ob + (long)(wid_e * QBLK) * LDO;
#pragma unroll
  for (int r = 0; r < 16; ++r) { int orow = crow(r, hi_e);
    for (int d0 = 0; d0 < 8; ++d0) Ow[(long)orow * LDO + d0 * 32 + r32_e] = (bf16_t)(cvtpk(o[d0][r] * rli[r], 0.f) & 0xffffu); }
#undef DMA8
#undef DWAIT8
#undef SLOT
#undef SADV
#undef LDK8
#undef LDV8
#undef PIN1
#undef EXPR
#undef PKW
#undef PVM
#undef LDVG
#undef WSTEP
}

constexpr int PV_BUF = 32768, PK_BUF = 16384, P_LDS_V = 0, P_LDS_K = 2 * PV_BUF, P_LDS_X = P_LDS_K + 2 * PK_BUF, P_LDS_L = P_LDS_X + 8 * 2048, P_LDS_END = P_LDS_L + 1024;
__device__ __forceinline__ void qkt_half(f32x16& p, const LAS char* Ks, const bf16x8* qr, int krow, int hi) {
  p = f32x16{};
  for (int d0 = 0; d0 < 8; ++d0) { int cb = (d0 * 16 + hi * 8) * 2;
    bf16x8 b0 = *reinterpret_cast<const LAS bf16x8*>(Ks + KSWZ(krow, cb));
    p = __builtin_amdgcn_mfma_f32_32x32x16_bf16(b0, qr[d0], p, 0, 0, 0); }
}
__device__ __forceinline__ void smA(f32x16& p, float negMC) {
  constexpr float Cc = SCALE * 1.4426950408889634f;
  for (int r = 0; r < 16; ++r) p[r] = fmaf(p[r], Cc, negMC);
  for (int r = 0; r < 8; ++r) p[r] = __builtin_amdgcn_exp2f(p[r]);
}
__device__ __forceinline__ void smB(f32x16& p, float& l_reg, bf16x8& f0, bf16x8& f1) {
  for (int r = 8; r < 16; ++r) p[r] = __builtin_amdgcn_exp2f(p[r]);
  float ps = 0; for (int r = 0; r < 16; ++r) ps += p[r];
  { auto rr = __builtin_amdgcn_permlane32_swap(__float_as_uint(ps), __float_as_uint(ps), false, false);
    ps = __uint_as_float(rr[0]) + __uint_as_float(rr[1]); }
  l_reg += ps;
#define PK4(P, BASE, OUT) do { unsigned a0 = cvtpk(P[BASE + 0], P[BASE + 1]), a1 = cvtpk(P[BASE + 2], P[BASE + 3]);   \
    unsigned b0 = cvtpk(P[BASE + 4], P[BASE + 5]), b1 = cvtpk(P[BASE + 6], P[BASE + 7]);                              \
    auto r0 = __builtin_amdgcn_permlane32_swap(a0, b0, false, false); auto r1 = __builtin_amdgcn_permlane32_swap(a1, b1, false, false); \
    u32x4 w = {r0[0], r1[0], r0[1], r1[1]}; OUT = *reinterpret_cast<bf16x8*>(&w); } while (0)
  PK4(p, 0, f0); PK4(p, 8, f1);
#undef PK4
}
template <int LDQ, int LDK, int LDO>
__device__ __forceinline__ void attn_pair_body(const bf16_t* __restrict__ Qb, const bf16_t* __restrict__ Kh, const bf16_t* __restrict__ Vh, bf16_t* __restrict__ Ob, int seq, LAS char* lds, int tid, float kmax2) {
  const int wid = __builtin_amdgcn_readfirstlane(tid >> 6), lane = tid & 63, r32 = lane & 31, hi = lane >> 5, g = wid & 3, kb = wid >> 2;
  LAS char* V_lds = lds + P_LDS_V; LAS char* K_lds = lds + P_LDS_K;
  LAS char* xp_own = lds + P_LDS_X + wid * 2048 + lane * 16; LAS char* xp_par = lds + P_LDS_X + (wid ^ 4) * 2048 + lane * 16;
  LAS float* li = (LAS float*)(lds + P_LDS_L);
  float l_reg = 0; f32x16 o[4] = {}; bf16x8 qr[8];
  const bf16_t* Qw = Qb + (long)(g * QBLK + r32) * LDQ + hi * 8;
#pragma unroll
  for (int d0 = 0; d0 < 8; ++d0) qr[d0] = *reinterpret_cast<const bf16x8*>(Qw + d0 * 16);
  float negMC;
  { float q2 = 0.f;
#pragma unroll
    for (int d0 = 0; d0 < 8; ++d0) { const u32x4 w = __builtin_bit_cast(u32x4, qr[d0]);
      q2 += bflo(w.x) * bflo(w.x) + bfhi(w.x) * bfhi(w.x) + bflo(w.y) * bflo(w.y) + bfhi(w.y) * bfhi(w.y) + bflo(w.z) * bflo(w.z) + bfhi(w.z) * bfhi(w.z) + bflo(w.w) * bflo(w.w) + bfhi(w.w) * bfhi(w.w); }
    auto rr = __builtin_amdgcn_permlane32_swap(__float_as_uint(q2), __float_as_uint(q2), false, false);
    q2 = __uint_as_float(rr[0]) + __uint_as_float(rr[1]);
    negMC = -(sqrtf(q2 * kmax2) * (SCALE * 1.0001f) - 30.0f) * 1.4426950408889634f; }
  const int sr = tid >> 4, sc = (tid & 15) * 8, vst0 = v_st(sr, sc), vst1 = v_st(32 + sr, sc);
  const int vrd = (int)(uintptr_t)V_lds + kb * 16384 + v_rd_base(lane);
  const int krow = 32 * kb + r32;
  struct { bf16x8 v00, v01, v10, v11, k0, k1; } st_;
#define PLD16(base, off) (*reinterpret_cast<const bf16x8*>((const char*)(base) + (off)))
#define PLOAD(k0_) do { const unsigned o_ = (unsigned)(((k0_) + sr) * LDK + sc) * 2u; \
    st_.v00 = PLD16(Vh, o_); st_.v01 = PLD16(Vh, o_ + 256u); st_.v10 = PLD16(Vh, o_ + 64u * LDK); st_.v11 = PLD16(Vh, o_ + 64u * LDK + 256u); \
    st_.k0 = PLD16(Kh, o_); st_.k1 = PLD16(Kh, o_ + 64u * LDK); } while (0)
#define PWRITE(kbuf, vbuf) do { LAS char* vb_ = V_lds + (vbuf) * PV_BUF; LAS char* kb_ = K_lds + (kbuf) * PK_BUF; const int kc = sc * 2; \
    *(LAS bf16x8*)(vb_ + vst0) = st_.v00; *(LAS bf16x8*)(vb_ + 16384 + vst0) = st_.v01; *(LAS bf16x8*)(vb_ + vst1) = st_.v10; *(LAS bf16x8*)(vb_ + 16384 + vst1) = st_.v11; \
    *(LAS bf16x8*)(kb_ + KSWZ(sr, kc)) = st_.k0; *(LAS bf16x8*)(kb_ + KSWZ(32 + sr, kc)) = st_.k1; } while (0)
  const int NT = seq / KVBLK;
  f32x16 pS; bf16x8 f0, f1, g0, g1;
  PLOAD(0); asm volatile("s_waitcnt vmcnt(0)" ::: "memory"); PWRITE(0, 0); PLOAD(KVBLK);
  __syncthreads();
  for (int j = 0; j < NT; ++j) {
    SBAR();
    qkt_half(pS, K_lds + (j & 1) * PK_BUF, qr, krow, hi);
    smA(pS, negMC); smB(pS, l_reg, f0, f1); SBAR();
    *(LAS bf16x8*)(xp_own) = f0; *(LAS bf16x8*)(xp_own + 1024) = f1;
    if (j + 1 < NT) PWRITE((j + 1) & 1, (j + 1) & 1);
    if (j + 2 < NT) PLOAD((j + 2) * KVBLK);
    __syncthreads();
    g0 = *(const LAS bf16x8*)(xp_par); g1 = *(const LAS bf16x8*)(xp_par + 1024);
    { const int vb = vrd + (j & 1) * PV_BUF;
      if (kb == 0) pv_d0(o, vb, f0, f1, g0, g1); else pv_d0(o, vb, g0, g1, f0, f1); }
    __syncthreads();
  }
  if (hi == 0) li[wid * 32 + r32] = l_reg;
  __syncthreads();
#pragma unroll
  for (int r = 0; r < 16; ++r) { const int orow = crow(r, hi); const float rl = __builtin_amdgcn_rcpf(li[wid * 32 + orow] + li[(wid ^ 4) * 32 + orow]);
    bf16_t* op = Ob + (long)(g * QBLK + orow) * LDO + 128 * kb + r32;
    for (int d0 = 0; d0 < 4; ++d0) op[d0 * 32] = (bf16_t)(cvtpk(o[d0][r] * rl, 0.f) & 0xffffu); }
#undef PLD16
#undef PLOAD
#undef PWRITE
}
#undef KSWZ
}

__device__ __forceinline__ void phase_attention(const Params& p, Ctx& C) {
    bf16_t* ATT = (bf16_t*)(p.ws + WS_BIG + BG_ATT);
    const unsigned char* Q8 = (const unsigned char*)(p.ws + WS_BIG + BG_Q8); const unsigned char* K8 = (const unsigned char*)(p.ws + WS_BIG + BG_K8); const unsigned char* VT8 = (const unsigned char*)(p.ws + WS_BIG + BG_VT8);
    const unsigned char* Q8D = (const unsigned char*)(p.ws + WS_BIG + BG_Q8D); const unsigned char* K8D = (const unsigned char*)(p.ws + WS_BIG + BG_K8D); const unsigned char* VT8D = (const unsigned char*)(p.ws + WS_BIG + BG_VT8D);
    for (int i = 0;; ++i) {
        int unit;
        if (C.G == 256) { if (i >= 2) break; unit = (C.bid & 7) * 64 + i * 32 + (C.bid >> 3); } else { unit = i * C.G + C.bid; if (unit >= 512) break; }
        const int d = unit >> 6, qb = unit & 63, hh = d >> 1, m = d & 1;
        __syncthreads();
        int tz = C.tid; asm volatile("" : "+v"(tz));
        att::attn_dense8w_body<3072, 1024>(Q8D + (size_t)(CTXL + 256 * qb) * 1024 + 128 * d, K8D + 128 * d, VT8D + (size_t)(2 * hh) * 260 * 8192, VT8D + (size_t)(2 * hh + 1) * 260 * 8192,
                                           ATT + (size_t)(256 * qb) * 3072 + 1024 + 1024 * m + 256 * hh, TT, (LAS char*)C.lds, tz, 0.f);
    }
    for (int i = 0;; ++i) {
        int unit;
        if (C.G == 256) { if (i >= 2) break; unit = (C.bid & 7) * 64 + i * 32 + (C.bid >> 3); } else { unit = i * C.G + C.bid; if (unit >= 512) break; }
        const int prob = unit >> 6, qb = unit & 63;
        __syncthreads();
        int tz = C.tid; asm volatile("" : "+v"(tz));
        att::attn_dense8_body<3072, 256>(Q8 + (size_t)(CTXL + 256 * qb) * 1024 + 128 * prob, K8 + 128 * (prob >> 2), VT8 + (size_t)(prob >> 2) * 260 * 8192,
                                         ATT + (size_t)(256 * qb) * 3072 + 128 * prob, TT, (LAS char*)C.lds, tz, 0.f);
    }
    __syncthreads();
}
constexpr int PH_PER_LAYER = 13, N_PHASES = 2 + 2 * PH_PER_LAYER;
#ifndef DBL_PHASE
#define DBL_PHASE -1
#endif
#ifndef MK_PER_PHASE
#define MK_PER_PHASE 0
#endif

template <int L>
__device__ __forceinline__ void layer_body(const Params& p, Ctx& C0, const XcdBarrier& bar, LAS unsigned char* misc, int lo, int hi) {
#define IN(k) (lo <= (k) && (k) < hi)
#define SEAM(k) do { if (IN(k) && IN((k) + 1)) xcd_barrier(bar, C0.wave); } while (0)
#define PHASE(k, ...) if (DBL_PHASE == (k)) { int nrep_ = 2; asm volatile("" : "+s"(nrep_)); for (int rep_ = 0; rep_ < nrep_; ++rep_) { if (rep_) xcd_barrier(bar, C0.wave); FRESH(); __VA_ARGS__ } } else if (IN(k)) { FRESH(); __VA_ARGS__ } SEAM(k);
#define FRESH() Ctx C = C0; { int ln = (int)__builtin_amdgcn_mbcnt_hi(~0u, __builtin_amdgcn_mbcnt_lo(~0u, 0u)); asm volatile("" : "+v"(ln)); C.lane = ln; C.tid = C.wave * 64 + ln; }
        const int b = 2 + PH_PER_LAYER * L;
        bf16_t* QKV = (bf16_t*)(p.ws + WS_BIG + BG_QKV);
        bf16_t* XA = (bf16_t*)(p.ws + WS_XA);
        int* cnt = (int*)(p.ws + WS_CTL) + CW_CNT + L * 128; const int* LIST = (const int*)(p.ws + WS_LIST);
        if (L == 0) { PHASE(b + 0, phase_modulate(p, C, L); ) }
        PHASE(b + 1,
            const int N = L ? OD_IN : EV_IN;
            pg8::DenseOrder S; S.init8((const void*)XA, DM, (const void*)(p.ws + (L ? WS_WIN1 : WS_WIN0)), TT, N, DM, C.G, C.bid);
            pg8::EpiStore E{QKV, N, 1.0f / 32.0f};
            pg8::gemm_phase<true>(C.lds, S, E, C.wave);
            if (L == 0 && IN(b + 2) && S.units_of_me() < S.max_units()) conv_queue(p, C, 2);
        )
        PHASE(b + 2, if (L == 0) phase_rope0(p, C); else phase_normrope1(p, C); )
        PHASE(b + 3, if (L == 0) { ret_chunk_kv(p, C); s5_end_states(p, C); } else phase_attention(p, C); )
        PHASE(b + 4, if (L == 0) phase_scans(p, C); else phase_merge1(p, C); )
        if (L == 0) {
            PHASE(b + 5, phase_ret_s5_outputs(p, C, misc); )
            PHASE(b + 6,
                pg8::DenseOrder S; S.init((const bf16_t*)(p.ws + WS_Z), 1024, (const bf16_t*)(p.ws + WS_WGLU), TT, 1024, 1024, C.G, C.bid);
                pg8::EpiGlu E{(const bf16_t*)(p.ws + WS_Z), p.inp(20), (bf16_t*)(p.ws + WS_BIG + BG_MIX)};
                pg8::gemm_phase<false>(C.lds, S, E, C.wave);
                if (IN(b + 7) && S.units_of_me() < S.max_units()) conv_queue(p, C, 4);
            )
        }
        PHASE(b + 7,
            pg8::DenseOrder S;
            if (L == 0) S.init((const bf16_t*)(p.ws + WS_BIG + BG_MIX), DM, (const bf16_t*)(p.ws + WS_WOUT0), TT, DM, DM, C.G, C.bid);
            else S.init((const bf16_t*)(p.ws + WS_BIG + BG_ATT), 3072, (const bf16_t*)(p.ws + WS_WOUT1), SEQ, DM, DM, C.G, C.bid);
            pg8::EpiStore E{(bf16_t*)(p.ws + WS_YMIX) + (L ? (size_t)CTXL * DM : 0), DM, 1.0f};
            pg8::gemm_phase<false>(C.lds, S, E, C.wave);
            if (L == 0 && IN(b + 8) && S.units_of_me() < S.max_units()) conv_queue(p, C, 5);
        )
        PHASE(b + 8, phase_ln1(p, C, L); )
        PHASE(b + 9, phase_router(p, C, L); )
        PHASE(b + 10,
            pg8::MoeOrder<0> S; S.A = (const void*)XA; S.Bt = (const void*)(p.ws + WS_GU + (size_t)L * NEX1 * 1024 * DM); S.list = LIST; S.cnt = cnt; S.ldab = DM; S.kb = DM; S.nN = 4; S.G = C.G; S.c = C.bid; S.bstride = (size_t)1024 * DM;
            S.prep(misc, C.tid);
            pg8::EpiE1 E{(unsigned char*)(p.ws + WS_HX2), S.cn, S.rb};
            pg8::gemm_phase<true>(C.lds, S, E, C.wave);
        )
        PHASE(b + 11,
            pg8::MoeOrder<1> S; S.A = (const void*)(p.ws + WS_HX2); S.Bt = (const void*)(p.ws + WS_DT + (size_t)L * NEX1 * DM * EHID); S.list = LIST; S.cnt = cnt; S.ldab = EHID; S.kb = EHID; S.nN = 8; S.G = C.G; S.c = C.bid; S.bstride = (size_t)DM * EHID;
            S.prep(misc, C.tid);
            pg8::EpiE2 E{(unsigned char*)(p.ws + WS_BIG + BG_YMOE), (const float*)(p.ws + WS_LW), S.cn, S.rb};
            pg8::gemm_phase<true>(C.lds, S, E, C.wave);
        )
        PHASE(b + 12, phase_combine(p, C, L, misc); )
    #undef IN
#undef SEAM
#undef FRESH
#undef PHASE
}

__global__ void __launch_bounds__(NTHR, 2) mega_fwd(KArgs ka) {
    extern __shared__ __attribute__((aligned(16))) unsigned char lds_raw[];
    Ctx C;
    C.lds = (LAS unsigned char*)lds_raw;
    C.tid = threadIdx.x; C.lane = C.tid & 63; C.wave = __builtin_amdgcn_readfirstlane(C.tid >> 6);
    C.G = gridDim.x; C.bid = blockIdx.x; C.gw = C.bid * NWAVES + C.wave; C.ngw = C.G * NWAVES;
    LAS unsigned char* misc = C.lds + MISC_OFF;
    if (C.tid < 8) ((volatile LAS unsigned*)misc)[C.tid] = 0u;
    Params p; p.out = ka.out; p.ws = ka.ws; p.ph_lo = ka.ph_lo; p.ph_hi = ka.ph_hi; p.ptab = (LAS unsigned long long*)(misc + 1024);
    if (C.tid < 34) p.ptab[C.tid] = (unsigned long long)ka.in[C.tid];
    __syncthreads();
    const int lo = p.ph_lo, hi = p.ph_hi;
    XcdBarrier bar; bar.bar = (unsigned*)(p.ws + WS_CTL) + CW_BAR; bar.x = 0; bar.st = (volatile LAS unsigned*)misc;
    if (hi - lo > 1) bar = xcd_barrier_post((unsigned*)(p.ws + WS_CTL) + CW_BAR, (volatile LAS unsigned*)misc);
#define IN(k) (lo <= (k) && (k) < hi)
#define SEAM(k) do { if (IN(k) && IN((k) + 1)) xcd_barrier(bar, C.wave); } while (0)

    if (IN(0)) { phase_p0(p, C); } SEAM(0);
    if (IN(1)) { phase_p1(p, C); } SEAM(1);
    if (IN(0) && IN(2) && (C.G & 7) == 0) {
        volatile LAS unsigned* st = (volatile LAS unsigned*)misc;
        if (C.tid == 0) { unsigned pre = 0u; const unsigned x = st[3];
            for (unsigned j = 0; j < 16; ++j) { const unsigned cj = xb_ld(&bar.bar[XB_XCNT(j)]); pre += (j < x) ? cj : 0u; }
            st[4] = pre + st[2]; }
        __syncthreads();
        const int vcu = (int)st[4], g8 = C.G >> 3;
        C.bid = __builtin_amdgcn_readfirstlane((vcu % g8) * 8 + vcu / g8); C.gw = C.bid * NWAVES + C.wave;
    }

    layer_body<0>(p, C, bar, misc, lo, hi);
    layer_body<1>(p, C, bar, misc, lo, hi);
#undef IN
#undef SEAM
}

extern "C" void kernel_launch(void* const* d_in, const int* in_sizes, int n_in, void* d_out, int out_size, void* d_ws, size_t ws_size, hipStream_t stream) {
    static int grid = 0;
    if (grid == 0) {
        if (n_in != 34 || out_size != SEQ * DM || ws_size < WS_END) { fprintf(stderr, "kernel_launch: unexpected shapes: n_in %d out %d ws %zu (need %zu)\n", n_in, out_size, ws_size, (size_t)WS_END); grid = -1; return; }
        int dev = 0, cus = 0, per_cu = 0;
        if (hipGetDevice(&dev) != hipSuccess || hipDeviceGetAttribute(&cus, hipDeviceAttributeMultiprocessorCount, dev) != hipSuccess) { grid = -1; return; }
        if (hipFuncSetAttribute((const void*)mega_fwd, hipFuncAttributeMaxDynamicSharedMemorySize, LDS_BYTES) != hipSuccess) { fprintf(stderr, "kernel_launch: hipFuncSetAttribute failed\n"); grid = -1; return; }
        if (hipOccupancyMaxActiveBlocksPerMultiprocessor(&per_cu, (const void*)mega_fwd, NTHR, LDS_BYTES) != hipSuccess || per_cu < 1) { fprintf(stderr, "kernel_launch: occupancy query says %d blocks per CU\n", per_cu); grid = -1; return; }
        (void)hipGetLastError();
        grid = cus;
    }
    if (grid < 0) return;
    (void)hipMemsetAsync((char*)d_ws + WS_CTL, 0, CTL_BYTES, stream);
    KArgs p{};
    for (int i = 0; i < 34; ++i) p.in[i] = (const float*)d_in[i];
    p.out = (float*)d_out; p.ws = (unsigned char*)d_ws;
#if MK_PER_PHASE
    for (int ph = 0; ph < N_PHASES; ++ph) {
        if (ph == 2 + PH_PER_LAYER + 0 || ph == 2 + PH_PER_LAYER + 5 || ph == 2 + PH_PER_LAYER + 6) continue;
        p.ph_lo = ph; p.ph_hi = ph + 1;
        hipLaunchKernelGGL(mega_fwd, dim3(grid), dim3(NTHR), LDS_BYTES, stream, p);
    }
#else
    p.ph_lo = 0; p.ph_hi = N_PHASES;
    hipLaunchKernelGGL(mega_fwd, dim3(grid), dim3(NTHR), LDS_BYTES, stream, p);
#endif
    const hipError_t le = hipPeekAtLastError();
    if (le != hipSuccess) fprintf(stderr, "kernel_launch: launch failed: %s\n", hipGetErrorName(le));
}
```
